# Optimizing an MI355X kernel written in HIP

```python
import math
import jax, jax.numpy as jnp
from jax import lax
import numpy as np

D_MODEL = 2048
BATCH = 16
SEQ = 2048
DEPTH = 2

N_MEM = 256
GRID_W = 64
HEAD_DIM = 64
EPS = 1e-6
NEG = -1e30
A_HEADS = 12
A_KV_HEADS = 4
A_WINDOW = 128
A_BLOCK = 128
B_HEADS = 8
NA_MAX_KH = 8
NA_KW = 16
NA_QCB = 16
NA_KCB = 32
C_HEADS = 12
C_KV_HEADS = 4
C_BLOCK = 128
ROPE_THETA = 10000.0
REL_BUCKETS = 32
REL_MAX_DIST = 128
MEM_HEADS = 4
MEM_HEAD_DIM = 128
MEM_W = MEM_HEADS * MEM_HEAD_DIM
PEER_HEADS = 8
PEER_NKEYS = 128
PEER_N = PEER_NKEYS * PEER_NKEYS
PEER_DKEY = 256
PEER_TOPK = 16
PEER_CHUNK = 128
A_Q = A_HEADS * HEAD_DIM
A_KV = A_KV_HEADS * HEAD_DIM
B_W = B_HEADS * HEAD_DIM
C_Q = C_HEADS * HEAD_DIM
C_KV = C_KV_HEADS * HEAD_DIM
D_MIX = A_Q + B_W + C_Q
D_IN = A_Q + 2 * A_KV + 3 * B_W + C_Q + 2 * C_KV

kernel_name = "hybrid_parallel_heads_peer_encoder"


def rmsnorm(x, g):
    xf = x.astype(jnp.float32)
    y = xf * lax.rsqrt(jnp.mean(xf * xf, axis=-1, keepdims=True) + EPS)
    return (y * g.astype(jnp.float32)).astype(x.dtype)


def t5_buckets(rel):
    nb = REL_BUCKETS // 2
    max_exact = nb // 2
    n = np.abs(rel)
    large = max_exact + (np.log(np.maximum(n, 1) / max_exact) / np.log(REL_MAX_DIST / max_exact)
                         * (nb - max_exact)).astype(np.int64)
    large = np.minimum(large, nb - 1)
    return np.where(rel > 0, nb, 0) + np.where(n < max_exact, n, large)


def window_attention(q, k, v, sink, rel_bias):
    b, s, _, dh = q.shape
    g = A_HEADS // A_KV_HEADS
    nb = s // A_BLOCK
    span = A_BLOCK + 2 * A_WINDOW
    kp = jnp.pad(k, ((0, 0), (A_WINDOW, A_WINDOW), (0, 0), (0, 0)))
    vp = jnp.pad(v, ((0, 0), (A_WINDOW, A_WINDOW), (0, 0), (0, 0)))
    rel = (np.arange(span)[None, :] - A_WINDOW) - np.arange(A_BLOCK)[:, None]
    in_window = np.abs(rel) <= A_WINDOW
    bias = rel_bias.astype(jnp.float32)[t5_buckets(rel)]
    bias = jnp.transpose(bias, (2, 0, 1)).reshape(A_KV_HEADS, g, A_BLOCK, span)
    sink_f = sink.astype(jnp.float32).reshape(A_KV_HEADS, g)
    qb = q.reshape(b, nb, A_BLOCK, A_KV_HEADS, g, dh).transpose(1, 0, 2, 3, 4, 5)
    scale = dh ** -0.5

    def block(args):
        qblk, bi = args
        start = bi * A_BLOCK
        kb = lax.dynamic_slice_in_dim(kp, start, span, axis=1)
        vb = lax.dynamic_slice_in_dim(vp, start, span, axis=1)
        logits = jnp.einsum('bqhgd,bkhd->bhgqk', qblk, kb).astype(jnp.float32) * scale + bias
        kpos = start - A_WINDOW + jnp.arange(span)
        valid = jnp.asarray(in_window) & (kpos >= 0)[None, :] & (kpos < s)[None, :]
        logits = jnp.where(valid, logits, NEG)
        sk = jnp.broadcast_to(sink_f[None, :, :, None, None], logits.shape[:-1] + (1,))
        p = jax.nn.softmax(jnp.concatenate([logits, sk], axis=-1), axis=-1)[..., :span]
        return jnp.einsum('bhgqk,bkhd->bqhgd', p.astype(v.dtype), vb)

    out = lax.map(block, (qb, jnp.arange(nb)))
    return out.transpose(1, 0, 2, 3, 4, 5).reshape(b, s, A_HEADS * dh)


def neighborhood_attention(q, k, v, rpb):
    b, s, h, dh = q.shape
    rows = s // GRID_W
    kh = min(NA_MAX_KH, rows)
    n_cb = GRID_W // NA_QCB
    slab = np.clip(np.arange(n_cb) * NA_QCB - NA_KW // 2, 0, GRID_W - NA_KCB)
    key_col = slab[:, None] + np.arange(NA_KCB)[None, :]
    q_col = np.arange(n_cb)[:, None] * NA_QCB + np.arange(NA_QCB)[None, :]
    c_start = np.clip(q_col - NA_KW // 2, 0, GRID_W - NA_KW)
    kc = key_col[:, None, :]
    col_ok = (kc >= c_start[:, :, None]) & (kc < c_start[:, :, None] + NA_KW)
    dc_idx = np.clip(kc - q_col[:, :, None] + NA_KW - 1, 0, 2 * NA_KW - 2)
    bias_c = rpb.astype(jnp.float32)[:, :, dc_idx]
    col_ok_b = jnp.asarray(col_ok[:, :, None, :])
    qg = q.reshape(b, rows, GRID_W, h, dh)
    kg = k.reshape(b, rows, GRID_W, h, dh)
    vg = v.reshape(b, rows, GRID_W, h, dh)
    scale = dh ** -0.5

    def one_row(r):
        r0 = jnp.clip(r - kh // 2, 0, rows - kh)
        qr = lax.dynamic_index_in_dim(qg, r, axis=1, keepdims=False).reshape(b, n_cb, NA_QCB, h, dh)
        kr = jnp.take(lax.dynamic_slice_in_dim(kg, r0, kh, axis=1), key_col, axis=2)
        vr = jnp.take(lax.dynamic_slice_in_dim(vg, r0, kh, axis=1), key_col, axis=2)
        logits = jnp.einsum('bcqhd,bickhd->bhcqik', qr, kr).astype(jnp.float32) * scale
        dr = r0 + jnp.arange(kh) - r + NA_MAX_KH - 1
        bias = jnp.take(bias_c, dr, axis=1).transpose(0, 2, 3, 1, 4)
        logits = jnp.where(col_ok_b, logits + bias[None], NEG)
        p = jax.nn.softmax(logits, axis=(-2, -1))
        o = jnp.einsum('bhcqik,bickhd->bcqhd', p.astype(v.dtype), vr)
        return o.reshape(b, GRID_W, h, dh)

    out = lax.map(one_row, jnp.arange(rows))
    return out.transpose(1, 0, 2, 3, 4).reshape(b, s, h * dh)


def rope_half(x, pos):
    n = x.shape[-1]
    nf = n // 2
    inv = jnp.asarray((ROPE_THETA ** (-np.arange(nf) * 2.0 / n)).astype(np.float32))
    ang = pos.astype(jnp.float32)[:, None] * inv[None, :]
    cos = jnp.cos(ang)[None, :, None, :]
    sin = jnp.sin(ang)[None, :, None, :]
    xf = x.astype(jnp.float32)
    x1, x2 = xf[..., :nf], xf[..., nf:]
    return jnp.concatenate([x1 * cos - x2 * sin, x1 * sin + x2 * cos], axis=-1).astype(x.dtype)


def axial_rope(x, row, col):
    half = x.shape[-1] // 2
    return jnp.concatenate([rope_half(x[..., :half], row), rope_half(x[..., half:], col)], axis=-1)


def dense_gqa(q, k, v):
    b, s, h, dh = q.shape
    hk = k.shape[2]
    g = h // hk
    nb = s // C_BLOCK
    qb = q.reshape(b, nb, C_BLOCK, hk, g, dh).transpose(1, 0, 2, 3, 4, 5)
    scale = dh ** -0.5

    def block(qblk):
        logits = jnp.einsum('bqhgd,bkhd->bhgqk', qblk, k).astype(jnp.float32) * scale
        p = jax.nn.softmax(logits, axis=-1)
        return jnp.einsum('bhgqk,bkhd->bqhgd', p.astype(v.dtype), v)

    out = lax.map(block, qb)
    return out.transpose(1, 0, 2, 3, 4, 5).reshape(b, s, h * dh)


def memory_attention(h, mem, w_q, w_kv, qk_g, w_o):
    b, s, _ = h.shape
    q = rmsnorm((h @ w_q).reshape(b, s, MEM_HEADS, MEM_HEAD_DIM), qk_g[0])
    kv = (mem @ w_kv).reshape(b, mem.shape[1], 2, MEM_HEADS, MEM_HEAD_DIM)
    k = rmsnorm(kv[:, :, 0], qk_g[1])
    vv = kv[:, :, 1]
    logits = jnp.einsum('bshd,bmhd->bhsm', q, k).astype(jnp.float32) * MEM_HEAD_DIM ** -0.5
    p = jax.nn.softmax(logits, axis=-1)
    o = jnp.einsum('bhsm,bmhd->bshd', p.astype(vv.dtype), vv)
    return o.reshape(b, s, MEM_W) @ w_o


def peer_ffn(h, w_q, sub_keys, u, v):
    b, s, d = h.shape
    nc = (b * s) // PEER_CHUNK

    def chunk(xc):
        q = (xc @ w_q).reshape(PEER_CHUNK, PEER_HEADS, 2, PEER_DKEY // 2)
        sc = jnp.einsum('chpd,hpnd->chpn', q, sub_keys).astype(jnp.float32)
        top_s, top_i = lax.top_k(sc, PEER_TOPK)
        cand_s = (top_s[:, :, 0, :, None] + top_s[:, :, 1, None, :]).reshape(PEER_CHUNK, PEER_HEADS, PEER_TOPK * PEER_TOPK)
        cand_i = (top_i[:, :, 0, :, None] * PEER_NKEYS + top_i[:, :, 1, None, :]).reshape(PEER_CHUNK, PEER_HEADS, PEER_TOPK * PEER_TOPK)
        best_s, pos = lax.top_k(cand_s, PEER_TOPK)
        expert = jnp.take_along_axis(cand_i, pos, axis=-1)
        gate = jax.nn.softmax(best_s, axis=-1)
        pre = jnp.einsum('cd,chkd->chk', xc, jnp.take(u, expert, axis=0)).astype(jnp.float32)
        w = (gate * jax.nn.gelu(pre, approximate=False)).astype(v.dtype)
        return jnp.einsum('chk,chkd->cd', w, jnp.take(v, expert, axis=0))

    y = lax.map(chunk, h.reshape(nc, PEER_CHUNK, d))
    return y.reshape(b, s, d)


def setup_inputs(seed: int = 0) -> dict:
    key = jax.random.key(seed)
    ks = jax.random.split(key, 24)
    nrm = lambda k, shape, scale: jax.random.normal(k, shape, jnp.float32) * scale
    gain = lambda k, shape: 1.0 + 0.02 * jax.random.normal(k, shape, jnp.float32)
    L = DEPTH
    return {
        "x": nrm(ks[0], (BATCH, SEQ, D_MODEL), 1.0),
        "mem": nrm(ks[1], (BATCH, N_MEM, D_MODEL), 1.0),
        "t5_rel_bias": nrm(ks[2], (REL_BUCKETS, A_HEADS), 0.1),
        "norm_mix": gain(ks[3], (L, D_MODEL)),
        "w_in": nrm(ks[4], (L, D_MODEL, D_IN), D_MODEL ** -0.5),
        "qk_norm_a": gain(ks[5], (L, 2, HEAD_DIM)),
        "sink_a": nrm(ks[6], (L, A_HEADS), 0.5),
        "qk_norm_b": gain(ks[7], (L, 2, HEAD_DIM)),
        "rpb_b": nrm(ks[8], (L, B_HEADS, 2 * NA_MAX_KH - 1, 2 * NA_KW - 1), 0.1),
        "qk_norm_c": gain(ks[9], (L, 2, HEAD_DIM)),
        "out_norm": gain(ks[10], (L, D_MIX)),
        "w_out": nrm(ks[11], (L, D_MIX, D_MODEL), D_MIX ** -0.5),
        "norm_mem": gain(ks[12], (L, D_MODEL)),
        "norm_mem_kv": gain(ks[13], (L, D_MODEL)),
        "w_mem_q": nrm(ks[14], (L, D_MODEL, MEM_W), D_MODEL ** -0.5),
        "w_mem_kv": nrm(ks[15], (L, D_MODEL, 2 * MEM_W), D_MODEL ** -0.5),
        "qk_norm_mem": gain(ks[16], (L, 2, MEM_HEAD_DIM)),
        "w_mem_o": nrm(ks[17], (L, MEM_W, D_MODEL), MEM_W ** -0.5),
        "norm_ffn": gain(ks[18], (L, D_MODEL)),
        "peer_w_q": nrm(ks[19], (L, D_MODEL, PEER_HEADS * PEER_DKEY), D_MODEL ** -0.5),
        "peer_keys": nrm(ks[20], (L, PEER_HEADS, 2, PEER_NKEYS, PEER_DKEY // 2), (PEER_DKEY // 2) ** -0.5),
        "peer_u": nrm(ks[21], (L, PEER_N, D_MODEL), D_MODEL ** -0.5),
        "peer_v": nrm(ks[22], (L, PEER_N, D_MODEL), PEER_HEADS ** -0.5),
    }


def reference(x, mem, t5_rel_bias, norm_mix, w_in, qk_norm_a, sink_a, qk_norm_b, rpb_b, qk_norm_c,
              out_norm, w_out, norm_mem, norm_mem_kv, w_mem_q, w_mem_kv, qk_norm_mem, w_mem_o,
              norm_ffn, peer_w_q, peer_keys, peer_u, peer_v):
    b, s, _ = x.shape
    t = jnp.arange(s)
    row, col = t // GRID_W, t % GRID_W
    splits = list(np.cumsum([A_Q, A_KV, A_KV, B_W, B_W, B_W, C_Q, C_KV]))
    heads = lambda z, n: z.reshape(b, s, n, HEAD_DIM)
    for l in range(DEPTH):
        hn = rmsnorm(x, norm_mix[l])
        qa, ka, va, qb, kb, vb, qc, kc, vc = jnp.split(hn @ w_in[l], splits, axis=-1)
        oa = window_attention(rmsnorm(heads(qa, A_HEADS), qk_norm_a[l, 0]),
                              rmsnorm(heads(ka, A_KV_HEADS), qk_norm_a[l, 1]),
                              heads(va, A_KV_HEADS), sink_a[l], t5_rel_bias)
        ob = neighborhood_attention(rmsnorm(heads(qb, B_HEADS), qk_norm_b[l, 0]),
                                    rmsnorm(heads(kb, B_HEADS), qk_norm_b[l, 1]),
                                    heads(vb, B_HEADS), rpb_b[l])
        oc = dense_gqa(axial_rope(rmsnorm(heads(qc, C_HEADS), qk_norm_c[l, 0]), row, col),
                       axial_rope(rmsnorm(heads(kc, C_KV_HEADS), qk_norm_c[l, 1]), row, col),
                       heads(vc, C_KV_HEADS))
        g_out = out_norm[l]
        mixed = jnp.concatenate([rmsnorm(oa, g_out[:A_Q]),
                                 rmsnorm(ob, g_out[A_Q:A_Q + B_W]),
                                 rmsnorm(oc, g_out[A_Q + B_W:])], axis=-1)
        x = x + mixed @ w_out[l]
        x = x + memory_attention(rmsnorm(x, norm_mem[l]), rmsnorm(mem, norm_mem_kv[l]),
                                 w_mem_q[l], w_mem_kv[l], qk_norm_mem[l], w_mem_o[l])
        x = x + peer_ffn(rmsnorm(x, norm_ffn[l]), peer_w_q[l], peer_keys[l], peer_u[l], peer_v[l])
    return x
```

```cpp
#include <hip/hip_runtime.h>
#include <cstdio>
#include <cstdint>
#include <cmath>
__device__ __forceinline__ float shx(float v, int k, int lane);
namespace pg8 {
#define PG8_LAS __attribute__((address_space(3)))
typedef unsigned short bf16_t;
typedef short bf16x8 __attribute__((ext_vector_type(8)));
typedef float f32x4 __attribute__((ext_vector_type(4)));
typedef unsigned u32x4 __attribute__((ext_vector_type(4)));
constexpr int BM = 256, BK = 64, HALF = 128, HTB = HALF * BK * 2  , STAGE_BYTES = 8 * HTB, NXCD = 8, WGM = 8;

__host__ __device__ __forceinline__ int lds_byte(int r, int c) { const int st = (r >> 4) * 2 + (c >> 5), rr = r & 15, cc = c & 31, ob = rr * 64 + cc * 2; return st * 1024 + (ob ^ (((ob >> 9) & 1) << 5)); }
__host__ __device__ __forceinline__ void stage_rc(int b, int& R, int& C) { const int st = b / 1024, sb = b % 1024, swz = sb ^ (((sb >> 9) & 1) << 5); R = (st >> 1) * 16 + swz / 64; C = (st & 1) * 32 + (swz % 64) / 2; }
__host__ __device__ __forceinline__ int perm32(int rho) { const int n = rho >> 4, i = rho & 15; return 8 * (i >> 2) + 4 * n + (i & 3); }

struct Unit { int pm, pn; };
struct Gemm { const bf16_t* A; const bf16_t* Bt; int M, N, K; };

struct StaticOrder {
    int nM, nN, nwg, G, c;
    __host__ __device__ void init(int M, int N, int G_, int c_) { nM = M / BM; nN = N / BM; nwg = nM * nN; G = G_; c = c_; }
    __host__ __device__ bool next(int i, Unit& u) const {
        const long L = (long)i * G + c; if (L >= nwg) return false;
        int wgid = (int)L; { const int q = nwg / NXCD, r = nwg % NXCD, xcd = wgid % NXCD, off = wgid / NXCD; wgid = (xcd < r ? xcd * (q + 1) : r * (q + 1) + (xcd - r) * q) + off; }
        const int nig = WGM * nN, gid = wgid / nig, fm = gid * WGM, gsz = (nM - fm) < WGM ? (nM - fm) : WGM;
        u.pm = fm + ((wgid % nig) % gsz); u.pn = (wgid % nig) / gsz; return true;
    }
    __device__ __forceinline__ void a_ready(const Unit&) const {}
    __device__ __forceinline__ void done(const Unit&) const {}
};

__device__ __forceinline__ unsigned cvt_pk_bf16(float lo, float hi) { unsigned r; asm volatile("v_cvt_pk_bf16_f32 %0, %1, %2" : "=v"(r) : "v"(lo), "v"(hi)); return r; }
typedef float f32x2 __attribute__((ext_vector_type(2)));
__device__ __forceinline__ f32x2 gelu_pk(f32x2 v) {
    const f32x2 av = __builtin_elementwise_abs(v), d = av * 0.2316418882f + 1.0f;
    f32x2 t; t.x = __builtin_amdgcn_rcpf(d.x); t.y = __builtin_amdgcn_rcpf(d.y);
    f32x2 q = t * 0.5307027145f + (-0.7265760135f); q = q * t + 0.7107068705f; q = q * t + (-0.142248368f); q = q * t + 0.127414796f; q = q * t;
    const f32x2 s = (v * v) * (-0.72134752044f);
    f32x2 e; e.x = __builtin_amdgcn_exp2f(s.x); e.y = __builtin_amdgcn_exp2f(s.y);
    const f32x2 m = v * (q * e), r = v - m;
    f32x2 o; o.x = v.x < 0.f ? m.x : r.x; o.y = v.y < 0.f ? m.y : r.y; return o;
}

template <int ACT  > struct EpiBf16 {
    static constexpr bool PERM = true, AFTER_DRAIN = false; static_assert(ACT == 0 || ACT == 1, "EpiBf16: ACT is 0 (none) or 1 (gelu_pk)");
    bf16_t* O; int ldc; const float* bias; int split_cols; size_t split_stride; float scale0;
    __device__ __forceinline__ void operator()(const f32x4 (&acc)[2][2][4][2], const Unit& u, int wr, int wc, int fr, int fq) const {
        const int row0 = u.pm * BM + wr * 64 + fr; int colt = u.pn * BM; bf16_t* base = O;
        float sc = 1.f; if (split_cols) { const int t = colt / split_cols; base += (size_t)t * split_stride; colt -= t * split_cols; if (t == 0) sc = scale0; }
        const int col0 = colt + wc * 32 + 8 * fq, bcol0 = u.pn * BM + wc * 32 + 8 * fq;
        f32x4 bv[2][2];
#pragma unroll
        for (int bj = 0; bj < 2; ++bj)
#pragma unroll
            for (int n = 0; n < 2; ++n) bv[bj][n] = bias ? *(const f32x4*)(bias + bcol0 + bj * HALF + 4 * n) : (f32x4){0.f, 0.f, 0.f, 0.f};
#pragma unroll
        for (int ai = 0; ai < 2; ++ai)
#pragma unroll
            for (int m = 0; m < 4; ++m) { bf16_t* rowp = base + (size_t)(row0 + ai * HALF + m * 16) * ldc + col0;
#pragma unroll
                for (int bj = 0; bj < 2; ++bj) { f32x4 v0 = acc[ai][bj][m][0] + bv[bj][0], v1 = acc[ai][bj][m][1] + bv[bj][1];
                    if (ACT == 1) { f32x2 a = gelu_pk((f32x2){v0[0], v0[1]}), b = gelu_pk((f32x2){v0[2], v0[3]}), c = gelu_pk((f32x2){v1[0], v1[1]}), d = gelu_pk((f32x2){v1[2], v1[3]});
                        v0 = (f32x4){a.x, a.y, b.x, b.y}; v1 = (f32x4){c.x, c.y, d.x, d.y}; }
                    v0 = v0 * sc; v1 = v1 * sc; u32x4 w; w.x = cvt_pk_bf16(v0[0], v0[1]); w.y = cvt_pk_bf16(v0[2], v0[3]); w.z = cvt_pk_bf16(v1[0], v1[1]); w.w = cvt_pk_bf16(v1[2], v1[3]);
                    *(u32x4*)(rowp + bj * HALF) = w; } }
    }
};

typedef unsigned u32x2 __attribute__((ext_vector_type(2)));
struct EpiResid {
    static constexpr bool PERM = false, AFTER_DRAIN = false;
    const float* base; float* out; int ldc;
    __device__ __forceinline__ void operator()(const f32x4 (&acc)[2][2][4][2], const Unit& u, int wr, int wc, int fr, int fq) const {
        const int col0 = u.pn * BM + wc * 32 + 4 * fq;
#pragma unroll
        for (int ai = 0; ai < 2; ++ai)
#pragma unroll
            for (int m = 0; m < 4; ++m) { const size_t off = (size_t)(u.pm * BM + ai * HALF + wr * 64 + m * 16 + fr) * ldc + col0;
#pragma unroll
                for (int bj = 0; bj < 2; ++bj)
#pragma unroll
                    for (int n = 0; n < 2; ++n) { const f32x4 bs = *(const f32x4*)(base + off + bj * HALF + n * 16); *(f32x4*)(out + off + bj * HALF + n * 16) = bs + acc[ai][bj][m][n]; } }
    }
};
struct EpiQKV {
    static constexpr bool PERM = false, AFTER_DRAIN = false;
    bf16_t* O; const float* ga; const float* gb; const float* gc; const float* rope;
    __device__ __forceinline__ void operator()(const f32x4 (&acc)[2][2][4][2], const Unit& u, int wr, int wc, int fr, int fq) const {
        const int hg = u.pn * 4 + wc;
        const float* g = nullptr; bool isq = false, dorope = false;
        if (hg < 12) { g = ga; isq = true; } else if (hg < 16) { g = ga + 64; } else if (hg < 20) { }
        else if (hg < 28) { g = gb; isq = true; } else if (hg < 36) { g = gb + 64; } else if (hg < 44) { }
        else if (hg < 56) { g = gc; isq = true; dorope = true; } else if (hg < 60) { g = gc + 64; dorope = true; }
        const float qs = isq ? 0.125f : 1.0f;
#pragma unroll
        for (int ai = 0; ai < 2; ++ai)
#pragma unroll
            for (int m = 0; m < 4; ++m) {
                const int row = u.pm * BM + ai * HALF + wr * 64 + m * 16 + fr;
                f32x4 v[2][2];
#pragma unroll
                for (int bj = 0; bj < 2; ++bj)
#pragma unroll
                    for (int n = 0; n < 2; ++n) v[bj][n] = acc[ai][bj][m][n];
                if (g) {
                    float ss = 0.f;
#pragma unroll
                    for (int bj = 0; bj < 2; ++bj)
#pragma unroll
                        for (int n = 0; n < 2; ++n) { const f32x4 x = v[bj][n]; ss += (x[0] * x[0] + x[1] * x[1]) + (x[2] * x[2] + x[3] * x[3]); }
                    ss += shx(ss, 16, fr + 16 * fq); ss += shx(ss, 32, fr + 16 * fq);
                    const float r = qs / sqrtf(ss * (1.0f / 64.0f) + 1e-6f);
#pragma unroll
                    for (int bj = 0; bj < 2; ++bj)
#pragma unroll
                        for (int n = 0; n < 2; ++n) v[bj][n] = v[bj][n] * *(const f32x4*)(g + 32 * bj + 16 * n + 4 * fq) * r;
                }
                if (dorope) {
                    const int t = row & 2047, pr = t >> 6, pc = t & 63;
#pragma unroll
                    for (int bj = 0; bj < 2; ++bj) {
                        const int pos = bj ? pc : pr;
                        const float* rp = rope + (size_t)(pos * 16 + 4 * fq) * 2;
                        const f32x4 c01 = *(const f32x4*)rp, c23 = *(const f32x4*)(rp + 4);
                        const f32x4 cs = (f32x4){c01[0], c01[2], c23[0], c23[2]}, sn = (f32x4){c01[1], c01[3], c23[1], c23[3]};
                        const f32x4 x1 = v[bj][0], x2 = v[bj][1];
                        v[bj][0] = x1 * cs - x2 * sn; v[bj][1] = x1 * sn + x2 * cs;
                    }
                }
                bf16_t* rowp = O + (size_t)row * 4096 + hg * 64 + 4 * fq;
#pragma unroll
                for (int bj = 0; bj < 2; ++bj)
#pragma unroll
                    for (int n = 0; n < 2; ++n) { u32x2 w; w.x = cvt_pk_bf16(v[bj][n][0], v[bj][n][1]); w.y = cvt_pk_bf16(v[bj][n][2], v[bj][n][3]); *(u32x2*)(rowp + 32 * bj + 16 * n) = w; }
                asm volatile("" ::: "memory");
            }
    }
};
template <class Epi, class Sched, bool ALIGN_EPI = false, bool SP2 = false>
__device__ __forceinline__ void gemm_phase(PG8_LAS unsigned char* lds, const Gemm g, const Sched& S, const Epi& E, const int tid) {
    const int wid = __builtin_amdgcn_readfirstlane(tid >> 6), lane = tid & 63, wr = wid >> 2, wc = wid & 3, fr = lane & 15, fq = lane >> 4;
    const int K = g.K, nt = K / BK;
    unsigned voffA[2], voffB[2];
#pragma unroll
    for (int i = 0; i < 2; ++i) { int R, C; stage_rc(tid * 16 + i * 8192, R, C); const int Rb = Epi::PERM ? ((R & ~31) + perm32(R & 31)) : R;
        voffA[i] = (unsigned)(R * K + C) * 2u; voffB[i] = (unsigned)(Rb * K + C) * 2u; }
    const size_t kstep = (size_t)(BK * 2);
    const size_t hstep = (size_t)HALF * K * 2;
    const size_t tstep = 2 * hstep;
    const unsigned ldsw = (unsigned)wid * 1024u;
    const int aoff = lds_byte(wr * 64 + fr, fq * 8), boff = lds_byte(wc * 32 + fr, fq * 8);
#define PG8_SA(b, h) (((b) * 2 + (h)) * HTB)
#define PG8_SB(b, h) ((4 + (b) * 2 + (h)) * HTB)
#define PG8_STAGE(bufoff, gbase, voff) do { _Pragma("unroll") for (int _i = 0; _i < 2; ++_i) \
        __builtin_amdgcn_global_load_lds((const unsigned*)((const char*)(gbase) + (voff)[_i]), (PG8_LAS unsigned*)(lds + (bufoff) + ldsw + _i * 8192), 16, 0, 0); } while (0)
#define PG8_LDA(dst, b, h) do { _Pragma("unroll") for (int m = 0; m < 4; ++m) _Pragma("unroll") for (int k = 0; k < 2; ++k) dst[m][k] = *(const PG8_LAS bf16x8*)(lds + PG8_SA(b, h) + aoff + m * 2048 + k * 1024); } while (0)
#define PG8_LDB(dst, b, h) do { _Pragma("unroll") for (int n = 0; n < 2; ++n) _Pragma("unroll") for (int k = 0; k < 2; ++k) dst[n][k] = *(const PG8_LAS bf16x8*)(lds + PG8_SB(b, h) + boff + n * 2048 + k * 1024); } while (0)
#define PG8_MMA(ai, bj, At, Bt) do { __builtin_amdgcn_s_setprio(1); _Pragma("unroll") for (int m = 0; m < 4; ++m) _Pragma("unroll") for (int n = 0; n < 2; ++n) _Pragma("unroll") for (int k = 0; k < 2; ++k) \
        acc[ai][bj][m][n] = __builtin_amdgcn_mfma_f32_16x16x32_bf16(Bt[n][k], At[m][k], acc[ai][bj][m][n], 0, 0, 0); __builtin_amdgcn_s_setprio(0); } while (0)
#define PG8_WAIT_V(n) asm volatile("s_waitcnt vmcnt(" #n ")" ::: "memory")
#define PG8_WAIT_L(n) asm volatile("s_waitcnt lgkmcnt(" #n ")" ::: "memory")
#define PG8_BAR __builtin_amdgcn_s_barrier()
#define PG8_SCHED __builtin_amdgcn_sched_barrier(0)
    Unit cur, nxt; int ui = 0;
    if (!S.next(0, cur)) return;
    f32x4 acc[2][2][4][2];
#pragma unroll
    for (int a = 0; a < 2; ++a)
#pragma unroll
        for (int b = 0; b < 2; ++b)
#pragma unroll
            for (int m = 0; m < 4; ++m)
#pragma unroll
                for (int n = 0; n < 2; ++n) acc[a][b][m][n] = (f32x4){0.f, 0.f, 0.f, 0.f};
    bf16x8 At[4][2], B0[2][2], B1[2][2];
    const char* cA = (const char*)g.A + (size_t)cur.pm * tstep; const char* cB = (const char*)g.Bt + (size_t)cur.pn * tstep;
    S.a_ready(cur);
    if constexpr (SP2) {
        PG8_STAGE(PG8_SB(0, 0), cB, voffB); PG8_STAGE(PG8_SB(0, 1), cB + hstep, voffB); PG8_STAGE(PG8_SA(0, 0), cA, voffA); PG8_STAGE(PG8_SA(0, 1), cA + hstep, voffA);
        if (wr == 1) PG8_BAR;
        PG8_WAIT_V(2); PG8_BAR;
        PG8_STAGE(PG8_SB(1, 0), cB + kstep, voffB); PG8_STAGE(PG8_SA(1, 0), cA + kstep, voffA); PG8_STAGE(PG8_SB(1, 1), cB + hstep + kstep, voffB);
        PG8_WAIT_V(6); PG8_BAR;
    } else {
        PG8_STAGE(PG8_SB(0, 0), cB, voffB); PG8_STAGE(PG8_SA(0, 0), cA, voffA); PG8_STAGE(PG8_SB(0, 1), cB + hstep, voffB); PG8_STAGE(PG8_SA(0, 1), cA + hstep, voffA);
        if (wr == 1) PG8_BAR;
        PG8_WAIT_V(4); PG8_BAR;
        PG8_STAGE(PG8_SB(1, 0), cB + kstep, voffB); PG8_STAGE(PG8_SA(1, 0), cA + kstep, voffA); PG8_STAGE(PG8_SB(1, 1), cB + hstep + kstep, voffB);
        PG8_WAIT_V(6); PG8_BAR;
    }
    for (;;) {
        const bool has_next = S.next(ui + 1, nxt);
        const char* nA = has_next ? (const char*)g.A + (size_t)nxt.pm * tstep : cA; const char* nB = has_next ? (const char*)g.Bt + (size_t)nxt.pn * tstep : cB;
        for (int t = 0; t < nt; t += 2) {
            const bool last = (t == nt - 2);
            const char* a1 = cA + (size_t)(t + 1) * kstep;
            const char* a2 = last ? nA : cA + (size_t)(t + 2) * kstep; const char* b2 = last ? nB : cB + (size_t)(t + 2) * kstep;
            const char* a3 = a2 + kstep; const char* b3 = b2 + kstep;
            if (last && has_next) S.a_ready(nxt);
            if constexpr (SP2) {
            PG8_LDB(B0, 0, 0); PG8_LDB(B1, 0, 1); PG8_SCHED; PG8_LDA(At, 0, 0); PG8_STAGE(PG8_SA(1, 1), a1 + hstep, voffA);
            PG8_WAIT_V(8); PG8_WAIT_L(0); PG8_BAR; PG8_MMA(0, 0, At, B0); PG8_MMA(0, 1, At, B1); PG8_BAR; PG8_SCHED;
            PG8_LDA(At, 0, 1); PG8_STAGE(PG8_SB(0, 0), b2, voffB); PG8_STAGE(PG8_SB(0, 1), b2 + hstep, voffB); PG8_STAGE(PG8_SA(0, 0), a2, voffA);
            PG8_WAIT_V(8); PG8_WAIT_L(0); PG8_BAR; PG8_MMA(1, 0, At, B0); PG8_MMA(1, 1, At, B1); PG8_BAR; PG8_SCHED;
            PG8_LDB(B0, 1, 0); PG8_LDB(B1, 1, 1); PG8_SCHED; PG8_LDA(At, 1, 0); PG8_STAGE(PG8_SA(0, 1), a2 + hstep, voffA);
            PG8_WAIT_V(8); PG8_WAIT_L(0); PG8_BAR; PG8_MMA(0, 0, At, B0); PG8_MMA(0, 1, At, B1); PG8_BAR; PG8_SCHED;
            PG8_LDA(At, 1, 1); PG8_STAGE(PG8_SB(1, 0), b3, voffB); PG8_STAGE(PG8_SB(1, 1), b3 + hstep, voffB); PG8_STAGE(PG8_SA(1, 0), a3, voffA);
            PG8_WAIT_V(8); PG8_WAIT_L(0); PG8_BAR; PG8_MMA(1, 0, At, B0); PG8_MMA(1, 1, At, B1); PG8_BAR; PG8_SCHED;
            } else {
            PG8_LDB(B0, 0, 0); PG8_SCHED; PG8_LDA(At, 0, 0); PG8_STAGE(PG8_SA(1, 1), a1 + hstep, voffA);
            PG8_WAIT_L(8); PG8_BAR; PG8_WAIT_L(0); PG8_MMA(0, 0, At, B0); PG8_BAR; PG8_SCHED;
            PG8_LDB(B1, 0, 1); PG8_STAGE(PG8_SB(0, 0), b2, voffB);
            PG8_BAR; PG8_WAIT_L(0); PG8_MMA(0, 1, At, B1); PG8_BAR;
            PG8_LDA(At, 0, 1); PG8_STAGE(PG8_SA(0, 0), a2, voffA);
            PG8_BAR; PG8_WAIT_L(0); PG8_MMA(1, 0, At, B0); PG8_BAR; PG8_SCHED;
            PG8_STAGE(PG8_SB(0, 1), b2 + hstep, voffB);
            PG8_WAIT_V(6); PG8_BAR; PG8_MMA(1, 1, At, B1); PG8_BAR;
            PG8_LDB(B0, 1, 0); PG8_SCHED; PG8_LDA(At, 1, 0); PG8_STAGE(PG8_SA(0, 1), a2 + hstep, voffA);
            PG8_WAIT_L(8); PG8_BAR; PG8_WAIT_L(0); PG8_MMA(0, 0, At, B0); PG8_BAR; PG8_SCHED;
            PG8_LDB(B1, 1, 1); PG8_STAGE(PG8_SB(1, 0), b3, voffB);
            PG8_BAR; PG8_WAIT_L(0); PG8_MMA(0, 1, At, B1); PG8_BAR;
            PG8_LDA(At, 1, 1); PG8_STAGE(PG8_SA(1, 0), a3, voffA);
            PG8_BAR; PG8_WAIT_L(0); PG8_MMA(1, 0, At, B0); PG8_BAR; PG8_SCHED;
            PG8_STAGE(PG8_SB(1, 1), b3 + hstep, voffB);
            PG8_WAIT_V(6); PG8_BAR; PG8_MMA(1, 1, At, B1); PG8_BAR;
            }
        }
        if constexpr (ALIGN_EPI) { if (wr == 0) PG8_BAR; }
        if constexpr (!Epi::AFTER_DRAIN) { E(acc, cur, wr, wc, fr, fq); S.done(cur); }
        if (!has_next) break;
#pragma unroll
        for (int a = 0; a < 2; ++a)
#pragma unroll
            for (int b = 0; b < 2; ++b)
#pragma unroll
                for (int m = 0; m < 4; ++m)
#pragma unroll
                    for (int n = 0; n < 2; ++n) acc[a][b][m][n] = (f32x4){0.f, 0.f, 0.f, 0.f};
        cur = nxt; cA = nA; cB = nB; ++ui;
        if constexpr (ALIGN_EPI) { if (wr == 1) PG8_BAR; }
    }
    PG8_WAIT_V(0);
    if constexpr (!ALIGN_EPI) { if (wr == 0) PG8_BAR; }
    PG8_BAR;
    if constexpr (Epi::AFTER_DRAIN) { E.fused(acc, cur, wr, wc, fr, fq, lds, wid, lane); S.done(cur); }
#undef PG8_SA
#undef PG8_SB
#undef PG8_STAGE
#undef PG8_LDA
#undef PG8_LDB
#undef PG8_MMA
#undef PG8_WAIT_V
#undef PG8_WAIT_L
#undef PG8_BAR
#undef PG8_SCHED
}
}

constexpr int BATCH = 16, SEQ = 2048, DM = 2048, T = BATCH * SEQ, DEPTH = 2;
constexpr int NMEM = 256, DIN = 4096, MEMW = 512;
constexpr int PEER_H = 8, PEER_N = 16384;
constexpr int NWAVES = 8, NTHREADS = NWAVES * 64;
constexpr float EPS = 1e-6f;
constexpr int QA = 0, KA = 768, VA = 1024, QB = 1280, KB = 1792, VB = 2304, QC = 2816, KC = 3584, VC = 3840;
constexpr int OA = 0, OB = 768, OC = 1280;

constexpr size_t MiB = 1u << 20;
constexpr size_t WS_CTL = 0, CTL_ZERO_BYTES = 1 * MiB;
constexpr size_t WS_ROPE = 1 * MiB, WS_BIASA = 1 * MiB + 16384;
constexpr size_t WS_WIN = 2 * MiB, WS_WOUT = 34 * MiB, WS_WMQ = 50 * MiB, WS_WMKV = 54 * MiB, WS_WMO = 62 * MiB, WS_WPQ = 66 * MiB, WS_PKEYS = 82 * MiB;
constexpr size_t WS_MEMN = 84 * MiB, WS_KVM = 116 * MiB, WS_PU = 132 * MiB, WS_PV = 260 * MiB, WS_XN = 388 * MiB, WS_QKV = 516 * MiB, WS_ATT = 772 * MiB;
constexpr size_t WS_QM = 900 * MiB, WS_OM = 932 * MiB, WS_END = 964 * MiB;
constexpr size_t WS_QP = WS_QKV, WS_PIDX = WS_QKV + 128 * MiB, WS_PGATE = WS_QKV + 144 * MiB;
constexpr int CW_BAR = 4096;

constexpr int RING_OFF = 0, RING_BYTES = 131072;
constexpr int LDSCTL_OFF = RING_BYTES, MISC_OFF = LDSCTL_OFF + 320;
constexpr int LDS_BYTES = 147456;

#define GAS __attribute__((address_space(1)))
#define LAS __attribute__((address_space(3)))
typedef unsigned short bf16;
typedef unsigned v4u __attribute__((ext_vector_type(4)));
typedef unsigned v2u __attribute__((ext_vector_type(2)));
typedef float f32x4 __attribute__((ext_vector_type(4)));
typedef float f32x16 __attribute__((ext_vector_type(16)));
typedef short bf16x8 __attribute__((ext_vector_type(8)));
typedef GAS unsigned gu32;
#define LDS_WAIT() asm volatile("s_waitcnt lgkmcnt(0)" ::: "memory")
#define VM_WAIT() asm volatile("s_waitcnt vmcnt(0)" ::: "memory")
__device__ __forceinline__ unsigned f2bf(float f) { unsigned u = __builtin_bit_cast(unsigned, f); return (u + 0x7fffu + ((u >> 16) & 1u)) >> 16; }
__device__ __forceinline__ unsigned pk2(float lo, float hi) { return f2bf(lo) | (f2bf(hi) << 16); }
__device__ __forceinline__ float bflo(unsigned w) { return __builtin_bit_cast(float, w << 16); }
__device__ __forceinline__ float bfhi(unsigned w) { return __builtin_bit_cast(float, w & 0xffff0000u); }

__device__ __forceinline__ float shx(float v, int k, int lane) { return __builtin_bit_cast(float, __builtin_amdgcn_ds_bpermute((lane ^ k) << 2, __builtin_bit_cast(int, v))); }
#define XB_TMO      128
#define XB_XCNT(j)  (256  + 64 * (j))
#define XB_XSUB(j)  (1280 + 64 * (j))
#define XB_XGEN(j)  (2304 + 64 * (j))
#define XB_TOP      3328
#define XB_TOPGEN   3392
#define XCD_BAR_WORDS 3456
#define XB_SPIN_CAP (1u << 18)

__device__ __forceinline__ unsigned xb_ld(unsigned* p)              { return __hip_atomic_load(p, __ATOMIC_RELAXED, __HIP_MEMORY_SCOPE_AGENT); }
__device__ __forceinline__ unsigned xb_add(unsigned* p, unsigned v) { return __hip_atomic_fetch_add(p, v, __ATOMIC_RELAXED, __HIP_MEMORY_SCOPE_AGENT); }
__device__ __forceinline__ unsigned xb_xcc_id() { return (unsigned)__builtin_amdgcn_s_getreg((3 << 11) | 20) & 0xFu; }
#define XB_SPIN(cond, bar) do { unsigned _sp = 0; while (cond) { __builtin_amdgcn_s_sleep(1); \
    if ((++_sp & 255u) == 0u) { if (xb_ld(&(bar)[XB_TMO])) break; if (_sp > XB_SPIN_CAP) { atomicAdd(&(bar)[XB_TMO], 1u); break; } } } } while (0)

struct XcdBarrier {
    unsigned* bar; unsigned x;
    volatile LAS unsigned* st;
};

__device__ __forceinline__ XcdBarrier xcd_barrier_post(unsigned* bar, volatile LAS unsigned* st) {
    XcdBarrier b; b.bar = bar; b.x = xb_xcc_id(); b.st = st;
    if (threadIdx.x == 0) (void)xb_add(&bar[XB_XCNT(b.x)], 1u);
    return b;
}
__device__ __forceinline__ void xcd_barrier_complete(unsigned* bar, unsigned x, unsigned& nloc, unsigned& nx) {
    const unsigned G = gridDim.x * gridDim.y * gridDim.z;
    unsigned sum, cnt, mine, sp = 0u;
    for (;;) {
        sum = 0u; cnt = 0u; mine = 0u;
#pragma unroll
        for (unsigned j = 0; j < 16; ++j) { const unsigned c = xb_ld(&bar[XB_XCNT(j)]); sum += c; cnt += (c > 0u) ? 1u : 0u; mine = (j == x) ? c : mine; }
        if (sum == G) break;
        __builtin_amdgcn_s_sleep(1);
        if ((++sp & 255u) == 0u) { if (xb_ld(&bar[XB_TMO])) break; if (sp > XB_SPIN_CAP) { atomicAdd(&bar[XB_TMO], 1u); break; } }
    }
    nloc = mine > 0u ? mine : 1u; nx = cnt > 0u ? cnt : 1u;
}

__device__ __forceinline__ void xcd_barrier(const XcdBarrier& b) {
    asm volatile("s_waitcnt vmcnt(0)" ::: "memory");
    __syncthreads();
    if (threadIdx.x == 0) {
        unsigned* bar = b.bar;
        __builtin_amdgcn_s_waitcnt(0);
        unsigned nloc = b.st[0], nx = b.st[1];
        if (nloc == 0u) { xcd_barrier_complete(bar, b.x, nloc, nx); b.st[0] = nloc; b.st[1] = nx; }
        const unsigned old = xb_add(&bar[XB_XSUB(b.x)], 1u);
        const unsigned gen = old / nloc;
        if (old + 1u == (gen + 1u) * nloc) {
            __builtin_amdgcn_fence(__ATOMIC_RELEASE, "agent");
            asm volatile("s_waitcnt vmcnt(0)" ::: "memory");
            const unsigned og = xb_add(&bar[XB_TOP], 1u);
            const unsigned tg = og / nx;
            if (og + 1u == (tg + 1u) * nx) xb_add(&bar[XB_TOPGEN], 1u);
            else XB_SPIN(xb_ld(&bar[XB_TOPGEN]) == tg, bar);
            __builtin_amdgcn_fence(__ATOMIC_ACQUIRE, "agent");
            xb_add(&bar[XB_XGEN(b.x)], 1u);
            asm volatile("s_waitcnt vmcnt(0)" ::: "memory");
        } else {
            XB_SPIN(xb_ld(&bar[XB_XGEN(b.x)]) == gen, bar);
            __builtin_amdgcn_fence(__ATOMIC_ACQUIRE, "agent");
            asm volatile("s_waitcnt vmcnt(0)" ::: "memory");
        }
    }
    __syncthreads();
}

__device__ __forceinline__ float wave_sum(float v, int lane) {
#pragma unroll
    for (int o = 1; o < 64; o <<= 1) v += shx(v, o, lane);
    return v;
}
__device__ __forceinline__ void* ldptr(LAS unsigned char* lds, int i) {
    const unsigned long long v = ((const LAS unsigned long long*)(lds + LDSCTL_OFF + 1024))[i];
    const unsigned lo = __builtin_amdgcn_readfirstlane((unsigned)v), hi = __builtin_amdgcn_readfirstlane((unsigned)(v >> 32));
    return (void*)(((unsigned long long)hi << 32) | lo);
}
struct OffsetOrder {
    pg8::StaticOrder S;
    __device__ void init(int M, int N, int G, int c, int off) { S.init(M, N, G, (c + G - off % G) % G); }
    __device__ bool next(int i, pg8::Unit& u) const { return S.next(i, u); }
    __device__ __forceinline__ void a_ready(const pg8::Unit&) const {}
    __device__ __forceinline__ void done(const pg8::Unit&) const {}
};

template <bool PERMQKV>
__device__ __forceinline__ void transpose_item(const float* W, int K, int N, bf16* WT, LAS float* scr, int item, int lane) {
    const int nblk = N / 32, kb = item / nblk, nb = item % nblk, k0 = 64 * kb, n0 = 32 * nb;
    int d0 = n0;
    if (PERMQKV) { const int within = n0 & 255; d0 = (n0 & ~255) + 128 * ((within >> 5) & 1) + 32 * (within >> 6); }
#pragma unroll 8
    for (int i = 0; i < 32; ++i) { const int kk = 2 * i + (lane >> 5); scr[kk * 33 + (lane & 31)] = W[(size_t)(k0 + kk) * N + n0 + (lane & 31)]; }
    LDS_WAIT(); asm volatile("" ::: "memory");
    const int c = lane & 7;
#pragma unroll
    for (int j = 0; j < 4; ++j) { const int n = (lane >> 3) + 8 * j; const LAS float* s = scr + (8 * c) * 33 + n;
        v4u o; o.x = pk2(s[0 * 33], s[1 * 33]); o.y = pk2(s[2 * 33], s[3 * 33]); o.z = pk2(s[4 * 33], s[5 * 33]); o.w = pk2(s[6 * 33], s[7 * 33]);
        *(GAS v4u*)(WT + (size_t)(d0 + n) * K + k0 + 8 * c) = o; }
    LDS_WAIT(); asm volatile("" ::: "memory");
}
__device__ __forceinline__ void convert_bf16(const float* src, bf16* dst, size_t n, size_t gtid, size_t nthreads) {
    for (size_t i = gtid * 8; i < n; i += nthreads * 8) {
        const f32x4 a = *(const GAS f32x4*)(src + i), b = *(const GAS f32x4*)(src + i + 4);
        v4u o; o.x = pk2(a[0], a[1]); o.y = pk2(a[2], a[3]); o.z = pk2(b[0], b[1]); o.w = pk2(b[2], b[3]);
        *(GAS v4u*)(dst + i) = o;
    }
}
__device__ __forceinline__ int t5_bucket(int rel) {
    const int n = rel < 0 ? -rel : rel;
    const int b = n < 8 ? n : n < 12 ? 8 : n < 16 ? 9 : n < 23 ? 10 : n < 32 ? 11 : n < 46 ? 12 : n < 64 ? 13 : n < 91 ? 14 : 15;
    return b + (rel > 0 ? 16 : 0);
}
__constant__ float ROPE_INV[16] = {1.000000000e+00f, 5.623413324e-01f, 3.162277639e-01f, 1.778279394e-01f, 1.000000015e-01f, 5.623413250e-02f, 3.162277490e-02f, 1.778279431e-02f,
                                   9.999999776e-03f, 5.623413250e-03f, 3.162277630e-03f, 1.778279431e-03f, 1.000000047e-03f, 5.623413017e-04f, 3.162277571e-04f, 1.778279402e-04f};

__device__ __forceinline__ void rms_row_to_bf16(const float* xrow, const float* g0, bf16* o0, const float* g1, bf16* o1, int lane) {
    const GAS f32x4* xr = (const GAS f32x4*)xrow + lane;
    f32x4 v[8]; float s = 0.f;
#pragma unroll
    for (int j = 0; j < 8; ++j) { v[j] = xr[64 * j]; s += (v[j].x * v[j].x + v[j].y * v[j].y) + (v[j].z * v[j].z + v[j].w * v[j].w); }
    const float rstd = 1.f / sqrtf(wave_sum(s, lane) * (1.f / DM) + EPS);
    {   const GAS f32x4* gr = (const GAS f32x4*)g0 + lane; GAS v2u* o8 = (GAS v2u*)o0 + lane;
#pragma unroll
        for (int j = 0; j < 8; ++j) { const f32x4 gg = gr[64 * j]; v2u w; w.x = pk2(v[j].x * rstd * gg.x, v[j].y * rstd * gg.y); w.y = pk2(v[j].z * rstd * gg.z, v[j].w * rstd * gg.w); o8[64 * j] = w; } }
    if (g1) { const GAS f32x4* gr = (const GAS f32x4*)g1 + lane; GAS v2u* o8 = (GAS v2u*)o1 + lane;
#pragma unroll
        for (int j = 0; j < 8; ++j) { const f32x4 gg = gr[64 * j]; v2u w; w.x = pk2(v[j].x * rstd * gg.x, v[j].y * rstd * gg.y); w.y = pk2(v[j].z * rstd * gg.z, v[j].w * rstd * gg.w); o8[64 * j] = w; } }
}
__device__ __forceinline__ void norm_rows(const float* X, const float* g, bf16* XN, int gw, int NGW, int lane) {
    for (int m = gw; m < T; m += NGW) rms_row_to_bf16(X + (size_t)m * DM, g, XN + (size_t)m * DM, nullptr, nullptr, lane);
}

template <int TYPE>
__device__ __forceinline__ void naive_attn_item(const bf16* QKV, bf16* ATT, int b, int grow, int head, int lane, const float* biasA, const float* sink, const float* rpb) {
    const int tpos = grow * 64 + lane; const size_t trow = (size_t)b * SEQ + tpos;
    int qcol, kcol, vcol, ocol;
    if (TYPE == 0) { qcol = QA + head * 64; kcol = KA + (head / 3) * 64; vcol = VA + (head / 3) * 64; ocol = OA + head * 64; }
    else if (TYPE == 1) { qcol = QB + head * 64; kcol = KB + head * 64; vcol = VB + head * 64; ocol = OB + head * 64; }
    else { qcol = QC + head * 64; kcol = KC + (head / 3) * 64; vcol = VC + (head / 3) * 64; ocol = OC + head * 64; }
    float q[64], o[64];
#pragma unroll
    for (int c = 0; c < 8; ++c) { const v4u w = *(const GAS v4u*)(QKV + trow * DIN + qcol + 8 * c);
        q[8 * c + 0] = bflo(w.x); q[8 * c + 1] = bfhi(w.x); q[8 * c + 2] = bflo(w.y); q[8 * c + 3] = bfhi(w.y); q[8 * c + 4] = bflo(w.z); q[8 * c + 5] = bfhi(w.z); q[8 * c + 6] = bflo(w.w); q[8 * c + 7] = bfhi(w.w); }
#pragma unroll
    for (int d = 0; d < 64; ++d) o[d] = 0.f;
    float m = -1e30f, l = 0.f;
    int j0, j1;
    if (TYPE == 0) { j0 = grow * 64 - 128; if (j0 < 0) j0 = 0; j1 = grow * 64 + 63 + 128; if (j1 > SEQ - 1) j1 = SEQ - 1; }
    else if (TYPE == 1) { int r0 = grow - 4; r0 = r0 < 0 ? 0 : (r0 > 24 ? 24 : r0); j0 = r0 * 64; j1 = j0 + 511; }
    else { j0 = 0; j1 = SEQ - 1; }
    int c0 = lane - 8; c0 = c0 < 0 ? 0 : (c0 > 48 ? 48 : c0);
#pragma unroll 1
    for (int j = j0; j <= j1; ++j) {
        const bf16* krow = QKV + ((size_t)b * SEQ + j) * DIN;
        float s = 0.f;
#pragma unroll
        for (int c = 0; c < 8; ++c) { const v4u w = *(const GAS v4u*)(krow + kcol + 8 * c);
            s += q[8 * c + 0] * bflo(w.x) + q[8 * c + 1] * bfhi(w.x) + q[8 * c + 2] * bflo(w.y) + q[8 * c + 3] * bfhi(w.y) + q[8 * c + 4] * bflo(w.z) + q[8 * c + 5] * bfhi(w.z) + q[8 * c + 6] * bflo(w.w) + q[8 * c + 7] * bfhi(w.w); }
        bool valid = true;
        if (TYPE == 0) { const int rel = j - tpos; valid = (rel >= -128 && rel <= 128); if (valid) s += biasA[head * 257 + rel + 128]; }
        if (TYPE == 1) { const int kr = j >> 6, kc = j & 63; valid = (kc >= c0 && kc < c0 + 16); if (valid) s += rpb[(head * 15 + (kr - grow + 7)) * 31 + (kc - lane + 15)]; }
        const float mn = valid ? fmaxf(m, s) : m;
        const float a = __expf(m - mn);
        const float p = valid ? __expf(s - mn) : 0.f;
        l = l * a + p; m = mn;
#pragma unroll
        for (int c = 0; c < 8; ++c) { const v4u w = *(const GAS v4u*)(krow + vcol + 8 * c);
            o[8 * c + 0] = o[8 * c + 0] * a + p * bflo(w.x); o[8 * c + 1] = o[8 * c + 1] * a + p * bfhi(w.x); o[8 * c + 2] = o[8 * c + 2] * a + p * bflo(w.y); o[8 * c + 3] = o[8 * c + 3] * a + p * bfhi(w.y);
            o[8 * c + 4] = o[8 * c + 4] * a + p * bflo(w.z); o[8 * c + 5] = o[8 * c + 5] * a + p * bfhi(w.z); o[8 * c + 6] = o[8 * c + 6] * a + p * bflo(w.w); o[8 * c + 7] = o[8 * c + 7] * a + p * bfhi(w.w); }
    }
    if (TYPE == 0) l += __expf(sink[head] - m);
    const float inv = 1.f / l;
#pragma unroll
    for (int c = 0; c < 8; ++c) { v4u w; w.x = pk2(o[8 * c + 0] * inv, o[8 * c + 1] * inv); w.y = pk2(o[8 * c + 2] * inv, o[8 * c + 3] * inv); w.z = pk2(o[8 * c + 4] * inv, o[8 * c + 5] * inv); w.w = pk2(o[8 * c + 6] * inv, o[8 * c + 7] * inv);
        *(GAS v4u*)(ATT + trow * DM + ocol + 8 * c) = w; }
}
__device__ __forceinline__ float rdl(float v, int l) { return __builtin_bit_cast(float, __builtin_amdgcn_readlane(__builtin_bit_cast(int, v), l)); }
__device__ __forceinline__ void naive_mem_item(const bf16* QM, const bf16* KVM, bf16* OM, const float* gq, size_t trow, int b, int head, int lane) {
    const unsigned qw = *(const GAS unsigned*)(QM + trow * MEMW + head * 128 + 2 * lane);
    float q0 = bflo(qw), q1 = bfhi(qw);
    const float ss = wave_sum(q0 * q0 + q1 * q1, lane);
    const float r = 0.08838834764831845f / sqrtf(ss * (1.f / 128.f) + EPS);
    q0 *= r * gq[2 * lane]; q1 *= r * gq[2 * lane + 1];
    const bf16* kbase = KVM + ((size_t)b * NMEM + lane) * 1024 + head * 128;
    float s[4] = {0.f, 0.f, 0.f, 0.f};
#pragma unroll 1
    for (int c = 0; c < 16; ++c) {
        float qa[8];
#pragma unroll
        for (int e = 0; e < 4; ++e) { qa[2 * e] = rdl(q0, 4 * c + e); qa[2 * e + 1] = rdl(q1, 4 * c + e); }
#pragma unroll
        for (int i = 0; i < 4; ++i) { const v4u w = *(const GAS v4u*)(kbase + (size_t)i * 64 * 1024 + 8 * c);
            s[i] += qa[0] * bflo(w.x) + qa[1] * bfhi(w.x) + qa[2] * bflo(w.y) + qa[3] * bfhi(w.y) + qa[4] * bflo(w.z) + qa[5] * bfhi(w.z) + qa[6] * bflo(w.w) + qa[7] * bfhi(w.w); }
    }
    float m = fmaxf(fmaxf(s[0], s[1]), fmaxf(s[2], s[3]));
#pragma unroll
    for (int o = 1; o < 64; o <<= 1) m = fmaxf(m, shx(m, o, lane));
    float p[4]; float l = 0.f;
#pragma unroll
    for (int i = 0; i < 4; ++i) { p[i] = __expf(s[i] - m); l += p[i]; }
    l = wave_sum(l, lane);
    const bf16* vbase = KVM + ((size_t)b * NMEM) * 1024 + 512 + head * 128 + 2 * lane;
    float o0 = 0.f, o1 = 0.f;
#pragma unroll
    for (int i = 0; i < 4; ++i) {
#pragma unroll 4
        for (int jj = 0; jj < 64; ++jj) { const float pj = rdl(p[i], jj); const unsigned w = *(const GAS unsigned*)(vbase + (size_t)(64 * i + jj) * 1024); o0 += pj * bflo(w); o1 += pj * bfhi(w); }
    }
    const float inv = 1.f / l;
    *(GAS unsigned*)(OM + trow * MEMW + head * 128 + 2 * lane) = pk2(o0 * inv, o1 * inv);
}
__device__ __forceinline__ void mixnorm_rows(bf16* ATT, const float* g, int gw, int NGW, int lane) {
    for (int m = gw; m < T; m += NGW) {
        GAS v4u* p = (GAS v4u*)(ATT + (size_t)m * DM + 32 * lane);
        v4u w[4]; float f[32]; float ss = 0.f;
#pragma unroll
        for (int c = 0; c < 4; ++c) { w[c] = p[c];
            f[8 * c + 0] = bflo(w[c].x); f[8 * c + 1] = bfhi(w[c].x); f[8 * c + 2] = bflo(w[c].y); f[8 * c + 3] = bfhi(w[c].y); f[8 * c + 4] = bflo(w[c].z); f[8 * c + 5] = bfhi(w[c].z); f[8 * c + 6] = bflo(w[c].w); f[8 * c + 7] = bfhi(w[c].w); }
#pragma unroll
        for (int i = 0; i < 32; ++i) ss += f[i] * f[i];
        const int grp = lane < 24 ? 0 : (lane < 40 ? 1 : 2);
        const float sa = wave_sum(grp == 0 ? ss : 0.f, lane), sb = wave_sum(grp == 1 ? ss : 0.f, lane), sc = wave_sum(grp == 2 ? ss : 0.f, lane);
        const float r = grp == 0 ? 1.f / sqrtf(sa * (1.f / 768.f) + EPS) : (grp == 1 ? 1.f / sqrtf(sb * (1.f / 512.f) + EPS) : 1.f / sqrtf(sc * (1.f / 768.f) + EPS));
        const float* gg = g + 32 * lane;
#pragma unroll
        for (int c = 0; c < 4; ++c) { const f32x4 g0 = *(const GAS f32x4*)(gg + 8 * c), g1 = *(const GAS f32x4*)(gg + 8 * c + 4);
            v4u o; o.x = pk2(f[8 * c + 0] * r * g0[0], f[8 * c + 1] * r * g0[1]); o.y = pk2(f[8 * c + 2] * r * g0[2], f[8 * c + 3] * r * g0[3]);
            o.z = pk2(f[8 * c + 4] * r * g1[0], f[8 * c + 5] * r * g1[1]); o.w = pk2(f[8 * c + 6] * r * g1[2], f[8 * c + 7] * r * g1[3]); p[c] = o; }
    }
}

#ifndef PEER_HD
#define PEER_HD __device__ __forceinline__
#define PEER_EXP(x) __expf(x)
#endif
template <int N> PEER_HD void bitonic_sort_desc(float* v) {
#pragma unroll
    for (int k = 2; k <= N; k <<= 1)
#pragma unroll
        for (int j = k >> 1; j > 0; j >>= 1)
#pragma unroll
            for (int i = 0; i < N; ++i) { const int l = i ^ j; if (l > i) { const bool desc = ((i & k) == 0); const float a = v[i], b = v[l]; const float hi = fmaxf(a, b), lo = fminf(a, b);
                v[i] = desc ? hi : lo; v[l] = desc ? lo : hi; } }
}
PEER_HD void merge_top16(float* a, const float* b) {
    float c[16];
#pragma unroll
    for (int i = 0; i < 16; ++i) c[i] = fmaxf(a[i], b[15 - i]);
#pragma unroll
    for (int j = 8; j > 0; j >>= 1)
#pragma unroll
        for (int i = 0; i < 16; ++i) { const int l = i ^ j; if (l > i) { const float x = c[i], y = c[l]; c[i] = fmaxf(x, y); c[l] = fminf(x, y); } }
#pragma unroll
    for (int i = 0; i < 16; ++i) a[i] = c[i];
}
PEER_HD void top16_of_64(float (&v)[64]) {
    bitonic_sort_desc<16>(&v[0]); bitonic_sort_desc<16>(&v[16]); bitonic_sort_desc<16>(&v[32]); bitonic_sort_desc<16>(&v[48]);
    merge_top16(&v[0], &v[16]); merge_top16(&v[32], &v[48]); merge_top16(&v[0], &v[32]);
}
PEER_HD float pack_idx(float s, unsigned idx, unsigned mask) { return __builtin_bit_cast(float, (__builtin_bit_cast(unsigned, s) & ~mask) | idx); }
PEER_HD unsigned low_bits(float s, unsigned mask) { return __builtin_bit_cast(unsigned, s) & mask; }
PEER_HD unsigned pick16(const float* a, unsigned i, unsigned mask) {
    unsigned r = 0;
#pragma unroll
    for (unsigned k = 0; k < 16; ++k) r = (i == k) ? low_bits(a[k], mask) : r;
    return r;
}
PEER_HD void peer_candidates(const float* a, const float* b, int* e, float* gate) {
    float c[64]; int n = 0;
#pragma unroll
    for (int i = 0; i < 16; ++i)
#pragma unroll
        for (int j = 0; j < 16; ++j) if ((i + 1) * (j + 1) <= 16) { c[n] = pack_idx(a[i] + b[j], (unsigned)(i * 16 + j), 0xffu); ++n; }
#pragma unroll
    for (int k = 50; k < 64; ++k) c[k] = -3.0e38f;
    top16_of_64(c);
    float mx = c[0], den = 0.f;
#pragma unroll
    for (int k = 0; k < 16; ++k) { const unsigned id = low_bits(c[k], 0xffu); const unsigned n0 = pick16(a, id >> 4, 0x7fu), n1 = pick16(b, id & 15u, 0x7fu);
        e[k] = (int)(n0 * 128u + n1); gate[k] = PEER_EXP(c[k] - mx); den += gate[k]; }
    const float inv = 1.f / den;
#pragma unroll
    for (int k = 0; k < 16; ++k) gate[k] *= inv;
}

__device__ __forceinline__ void peer_select_unit(const bf16* QP, const bf16* PK, int* PIDX, float* PGATE, int tb, int h, int wave, int lane) {
    const int hh = lane >> 5, tl = lane & 31; const size_t t = (size_t)tb * 256 + wave * 32 + tl;
    float ab[2][16];
#pragma unroll
    for (int p = 0; p < 2; ++p) {
        bf16x8 bq[8];
#pragma unroll
        for (int s = 0; s < 8; ++s) bq[s] = *(const GAS bf16x8*)(QP + t * DM + 256 * h + 128 * p + 16 * s + 8 * hh);
        float v[64];
#pragma unroll
        for (int nb = 0; nb < 4; ++nb) {
            f32x16 acc;
#pragma unroll
            for (int r = 0; r < 16; ++r) acc[r] = 0.f;
            const bf16* kp = PK + ((size_t)((h * 2 + p) * 128 + 32 * nb + tl)) * 128 + 8 * hh;
#pragma unroll
            for (int s = 0; s < 8; ++s) { const bf16x8 ak = *(const GAS bf16x8*)(kp + 16 * s); acc = __builtin_amdgcn_mfma_f32_32x32x16_bf16(ak, bq[s], acc, 0, 0, 0); }
#pragma unroll
            for (int r = 0; r < 16; ++r) v[16 * nb + r] = pack_idx(acc[r], (unsigned)(32 * nb + 8 * (r >> 2) + 4 * hh + (r & 3)), 0x7fu);
        }
        top16_of_64(v);
        float pv[16];
#pragma unroll
        for (int i = 0; i < 16; ++i) pv[i] = shx(v[i], 32, lane);
        merge_top16(&v[0], pv);
#pragma unroll
        for (int i = 0; i < 16; ++i) ab[p][i] = v[i];
    }
    int e[16]; float gate[16];
    peer_candidates(ab[0], ab[1], e, gate);
    if (hh == 0) { GAS v4u* o = (GAS v4u*)(PIDX + t * 128 + h * 16);
#pragma unroll
        for (int c = 0; c < 4; ++c) o[c] = (v4u){(unsigned)e[4 * c], (unsigned)e[4 * c + 1], (unsigned)e[4 * c + 2], (unsigned)e[4 * c + 3]}; }
    else { GAS f32x4* o = (GAS f32x4*)(PGATE + t * 128 + h * 16);
#pragma unroll
        for (int c = 0; c < 4; ++c) o[c] = (f32x4){gate[4 * c], gate[4 * c + 1], gate[4 * c + 2], gate[4 * c + 3]}; }
}

__device__ __forceinline__ float dot8(const v4u& x, const v4u& u) {
    return bflo(x.x) * bflo(u.x) + bfhi(x.x) * bfhi(u.x) + bflo(x.y) * bflo(u.y) + bfhi(x.y) * bfhi(u.y) + bflo(x.z) * bflo(u.z) + bfhi(x.z) * bfhi(u.z) + bflo(x.w) * bflo(u.w) + bfhi(x.w) * bfhi(u.w);
}
__device__ __forceinline__ void axpy8(float* y, float w, const v4u& v) {
    y[0] += w * bflo(v.x); y[1] += w * bfhi(v.x); y[2] += w * bflo(v.y); y[3] += w * bfhi(v.y); y[4] += w * bflo(v.z); y[5] += w * bfhi(v.z); y[6] += w * bflo(v.w); y[7] += w * bfhi(v.w);
}
__device__ __forceinline__ void peer_gather(const bf16* XN, const bf16* PU, const bf16* PV, const int* PIDX, const float* PGATE, float* X, int gw, int NGW, int lane) {
    for (int t = gw; t < T; t += NGW) {
        v4u xv[4];
#pragma unroll
        for (int j = 0; j < 4; ++j) xv[j] = *(const GAS v4u*)(XN + (size_t)t * DM + 8 * lane + 512 * j);
        float y[32];
#pragma unroll
        for (int i = 0; i < 32; ++i) y[i] = 0.f;
        for (int k = 0; k < 128; k += 2) {
            const int e0 = __builtin_amdgcn_readfirstlane(PIDX[(size_t)t * 128 + k]), e1 = __builtin_amdgcn_readfirstlane(PIDX[(size_t)t * 128 + k + 1]);
            const float g0 = PGATE[(size_t)t * 128 + k], g1 = PGATE[(size_t)t * 128 + k + 1];
            v4u u0[4], u1[4], v0[4], v1[4];
#pragma unroll
            for (int j = 0; j < 4; ++j) { u0[j] = *(const GAS v4u*)(PU + (size_t)e0 * DM + 8 * lane + 512 * j); u1[j] = *(const GAS v4u*)(PU + (size_t)e1 * DM + 8 * lane + 512 * j); }
#pragma unroll
            for (int j = 0; j < 4; ++j) { v0[j] = *(const GAS v4u*)(PV + (size_t)e0 * DM + 8 * lane + 512 * j); v1[j] = *(const GAS v4u*)(PV + (size_t)e1 * DM + 8 * lane + 512 * j); }
            float d0 = 0.f, d1 = 0.f;
#pragma unroll
            for (int j = 0; j < 4; ++j) { d0 += dot8(xv[j], u0[j]); d1 += dot8(xv[j], u1[j]); }
            d0 = wave_sum(d0, lane); d1 = wave_sum(d1, lane);
            const float w0 = g0 * 0.5f * d0 * (1.f + erff(d0 * 0.70710678118654752f)), w1 = g1 * 0.5f * d1 * (1.f + erff(d1 * 0.70710678118654752f));
#pragma unroll
            for (int j = 0; j < 4; ++j) { axpy8(&y[8 * j], w0, v0[j]); axpy8(&y[8 * j], w1, v1[j]); }
        }
#pragma unroll
        for (int j = 0; j < 4; ++j) { GAS f32x4* xp = (GAS f32x4*)(X + (size_t)t * DM + 8 * lane + 512 * j);
            f32x4 a = xp[0], b = xp[1]; a += (f32x4){y[8 * j], y[8 * j + 1], y[8 * j + 2], y[8 * j + 3]}; b += (f32x4){y[8 * j + 4], y[8 * j + 5], y[8 * j + 6], y[8 * j + 7]}; xp[0] = a; xp[1] = b; }
    }
}

struct Args { const float* in[23]; float* out; unsigned char* ws; int ph_lo, ph_hi, use_bar, pad; };
#ifndef MK_OFF
#define MK_OFF 0u
#endif
#define PHON(k) (!((MK_OFF >> (k)) & 1u))
constexpr int PH_PER_LAYER = 13, PH_BASE = 3, N_PHASES = PH_BASE + DEPTH * PH_PER_LAYER;
constexpr int PTAB_OFF = LDSCTL_OFF + 1024;

__global__ void __launch_bounds__(NTHREADS, 2) mega(Args a) {
    extern __shared__ __attribute__((aligned(16))) unsigned char lds_raw[];
    LAS unsigned char* lds = (LAS unsigned char*)lds_raw;
    {   const int tid0 = threadIdx.x;
        for (int u = tid0; u < (LDS_BYTES - LDSCTL_OFF) / 4; u += NTHREADS) ((LAS unsigned*)(lds + LDSCTL_OFF))[u] = 0u;
        __syncthreads();
        if (tid0 < 23) ((LAS unsigned long long*)(lds + PTAB_OFF))[tid0] = (unsigned long long)a.in[tid0];
        if (tid0 == 23) ((LAS unsigned long long*)(lds + PTAB_OFF))[23] = (unsigned long long)a.out;
        if (tid0 == 24) ((LAS unsigned long long*)(lds + PTAB_OFF))[24] = (unsigned long long)a.ws;
        __syncthreads();
    }
    volatile LAS unsigned* MISC = (volatile LAS unsigned*)(lds + MISC_OFF);
    const int G = gridDim.x, bid = blockIdx.x, NGW = G * NWAVES;
    const int use_bar = a.use_bar;
    XcdBarrier bar; bar.bar = (unsigned*)(a.ws + WS_CTL) + CW_BAR; bar.x = 0; bar.st = MISC + 8;
    if (use_bar) bar = xcd_barrier_post((unsigned*)(a.ws + WS_CTL) + CW_BAR, MISC + 8);
    const int lo = a.ph_lo, hi = a.ph_hi;
#define IN(k) (lo <= (k) && (k) < hi)
#define SEAM(k) do { if (use_bar && IN(k) && IN((k) + 1)) xcd_barrier(bar); } while (0)
#define PHL() int tid_ = threadIdx.x; asm volatile("" : "+v"(tid_)); const int lane_ = tid_ & 63, wave_ = __builtin_amdgcn_readfirstlane(tid_ >> 6), gw_ = bid * NWAVES + wave_; (void)lane_; (void)gw_; \
              int pz_ = 0; asm volatile("" : "+s"(pz_))
#define PTR(i) ((const float*)ldptr(lds, (i) + pz_))
#define WSP() ((unsigned char*)ldptr(lds, 24 + pz_))
#define OUTP() ((float*)ldptr(lds, 23 + pz_))

    if (IN(0) && PHON(0)) {
        PHL(); unsigned char* ws = WSP();
        LAS float* scr = (LAS float*)(lds + RING_OFF + wave_ * 16384);
        constexpr int I_IN = 32 * 128, I_OUT = 32 * 64, I_MQ = 32 * 16, I_MKV = 32 * 32, I_MO = 8 * 64, I_PQ = 32 * 64, I_L = I_IN + I_OUT + I_MQ + I_MKV + I_MO + I_PQ;
        for (int it = gw_; it < DEPTH * I_L; it += NGW) {
            const int l = it / I_L; int r = it % I_L;
            if (r < I_IN) { transpose_item<true>(PTR(4) + (size_t)l * DM * DIN, DM, DIN, (bf16*)(ws + WS_WIN) + (size_t)l * DIN * DM, scr, r, lane_); continue; } r -= I_IN;
            if (r < I_OUT) { transpose_item<false>(PTR(11) + (size_t)l * DM * DM, DM, DM, (bf16*)(ws + WS_WOUT) + (size_t)l * DM * DM, scr, r, lane_); continue; } r -= I_OUT;
            if (r < I_MQ) { transpose_item<false>(PTR(14) + (size_t)l * DM * MEMW, DM, MEMW, (bf16*)(ws + WS_WMQ) + (size_t)l * MEMW * DM, scr, r, lane_); continue; } r -= I_MQ;
            if (r < I_MKV) { transpose_item<false>(PTR(15) + (size_t)l * DM * 1024, DM, 1024, (bf16*)(ws + WS_WMKV) + (size_t)l * 1024 * DM, scr, r, lane_); continue; } r -= I_MKV;
            if (r < I_MO) { transpose_item<false>(PTR(17) + (size_t)l * MEMW * DM, MEMW, DM, (bf16*)(ws + WS_WMO) + (size_t)l * DM * MEMW, scr, r, lane_); continue; } r -= I_MO;
            transpose_item<false>(PTR(19) + (size_t)l * DM * DM, DM, DM, (bf16*)(ws + WS_WPQ) + (size_t)l * DM * DM, scr, r, lane_);
        }
        const size_t gtid = (size_t)bid * NTHREADS + tid_, nth = (size_t)G * NTHREADS;
        convert_bf16(PTR(20), (bf16*)(ws + WS_PKEYS), (size_t)DEPTH * 8 * 2 * 128 * 128, gtid, nth);
        convert_bf16(PTR(21), (bf16*)(ws + WS_PU), (size_t)DEPTH * PEER_N * DM, gtid, nth);
        convert_bf16(PTR(22), (bf16*)(ws + WS_PV), (size_t)DEPTH * PEER_N * DM, gtid, nth);
        {   const float* mem = PTR(1); const float* gkv = PTR(13); bf16* MEMN = (bf16*)(ws + WS_MEMN);
            for (int m = gw_; m < BATCH * NMEM; m += NGW)
                rms_row_to_bf16(mem + (size_t)m * DM, gkv, MEMN + (size_t)m * DM, gkv + DM, MEMN + (size_t)(BATCH * NMEM + m) * DM, lane_); }
        float* rope = (float*)(ws + WS_ROPE); float* biasA = (float*)(ws + WS_BIASA);
        if (gtid < 64 * 16) { const int pos = (int)gtid >> 4, i = (int)gtid & 15; const float ang = (float)pos * ROPE_INV[i]; rope[gtid * 2] = cosf(ang); rope[gtid * 2 + 1] = sinf(ang); }
        if (gtid < 12 * 257) { const int h = (int)gtid / 257, rel = (int)gtid % 257 - 128; biasA[gtid] = PTR(2)[t5_bucket(rel) * 12 + h]; }
    }
    SEAM(0);
    if (IN(1) && PHON(1)) {
#pragma unroll 1
        for (int l = 0; l < DEPTH; ++l) {
            PHL(); unsigned char* ws = WSP();
            pg8::Gemm g{(bf16*)(ws + WS_MEMN) + (size_t)l * BATCH * NMEM * DM, (bf16*)(ws + WS_WMKV) + (size_t)l * 1024 * DM, BATCH * NMEM, 1024, DM};
            OffsetOrder S; S.init(BATCH * NMEM, 1024, G, bid, 64 * l);
            pg8::EpiBf16<0> E{(bf16*)(ws + WS_KVM) + (size_t)l * BATCH * NMEM * 1024, 1024, nullptr, 0, 0, 1.f};
            pg8::gemm_phase<pg8::EpiBf16<0>, OffsetOrder, true, true>(lds + RING_OFF, g, S, E, tid_);
            __syncthreads();
        }
    }
    SEAM(1);
    if (IN(2) && PHON(2)) {
        PHL(); unsigned char* ws = WSP(); bf16* KVM = (bf16*)(ws + WS_KVM); const float* gm = PTR(16);
        for (int m = gw_; m < DEPTH * BATCH * NMEM; m += NGW) {
            const int l = m / (BATCH * NMEM);
            GAS v4u* p = (GAS v4u*)(KVM + (size_t)m * 1024 + 8 * lane_);
            const v4u w = *p;
            float f[8] = {bflo(w.x), bfhi(w.x), bflo(w.y), bfhi(w.y), bflo(w.z), bfhi(w.z), bflo(w.w), bfhi(w.w)};
            float ss = 0.f;
#pragma unroll
            for (int i = 0; i < 8; ++i) ss += f[i] * f[i];
            ss += shx(ss, 1, lane_); ss += shx(ss, 2, lane_); ss += shx(ss, 4, lane_); ss += shx(ss, 8, lane_);
            const float r = 1.f / sqrtf(ss * (1.f / 128.f) + EPS);
            const float* gk = gm + (size_t)l * 256 + 128 + 8 * (lane_ & 15);
            v4u o; o.x = pk2(f[0] * r * gk[0], f[1] * r * gk[1]); o.y = pk2(f[2] * r * gk[2], f[3] * r * gk[3]); o.z = pk2(f[4] * r * gk[4], f[5] * r * gk[5]); o.w = pk2(f[6] * r * gk[6], f[7] * r * gk[7]);
            *p = o;
        }
    }
    SEAM(2);

#pragma unroll 1
    for (int l = 0; l < DEPTH; ++l) {
        const int pb = PH_BASE + PH_PER_LAYER * l;
        if (IN(pb + 0) && PHON(3)) { PHL(); unsigned char* ws = WSP(); const float* xin = (l == 0) ? PTR(0) : (const float*)OUTP();
            norm_rows(xin, PTR(3) + (size_t)l * DM, (bf16*)(ws + WS_XN), gw_, NGW, lane_); }
        SEAM(pb + 0);
        if (IN(pb + 1) && PHON(4)) { PHL(); unsigned char* ws = WSP();
            pg8::Gemm g{(bf16*)(ws + WS_XN), (bf16*)(ws + WS_WIN) + (size_t)l * DIN * DM, T, DIN, DM}; pg8::StaticOrder S; S.init(T, DIN, G, bid);
            pg8::EpiQKV E{(bf16*)(ws + WS_QKV), PTR(5) + (size_t)l * 128, PTR(7) + (size_t)l * 128, PTR(9) + (size_t)l * 128, (const float*)(ws + WS_ROPE)};
            pg8::gemm_phase<pg8::EpiQKV, pg8::StaticOrder, true, true>(lds + RING_OFF, g, S, E, tid_);
        }
        SEAM(pb + 1);
        if (IN(pb + 2) && PHON(5)) { PHL(); unsigned char* ws = WSP();
            const float* sink = PTR(6) + (size_t)l * 12; const float* rpb = PTR(8) + (size_t)l * 8 * 15 * 31; const float* biasA = (const float*)(ws + WS_BIASA);
            const bf16* QKV = (const bf16*)(ws + WS_QKV); bf16* ATT = (bf16*)(ws + WS_ATT);
            for (int it = gw_; it < BATCH * 32 * 32; it += NGW) {
                const int slot = it >> 9, br = it & 511, b = br >> 5, grow = br & 31;
                if (slot < 12) naive_attn_item<0>(QKV, ATT, b, grow, slot, lane_, biasA, sink, rpb);
                else if (slot < 20) naive_attn_item<1>(QKV, ATT, b, grow, slot - 12, lane_, biasA, sink, rpb);
                else naive_attn_item<2>(QKV, ATT, b, grow, slot - 20, lane_, biasA, sink, rpb);
            }
        }
        SEAM(pb + 2);
        if (IN(pb + 3) && PHON(6)) { PHL(); unsigned char* ws = WSP(); mixnorm_rows((bf16*)(ws + WS_ATT), PTR(10) + (size_t)l * DM, gw_, NGW, lane_); }
        SEAM(pb + 3);
        if (IN(pb + 4) && PHON(7)) { PHL(); unsigned char* ws = WSP(); const float* xin = (l == 0) ? PTR(0) : (const float*)OUTP();
            pg8::Gemm g{(bf16*)(ws + WS_ATT), (bf16*)(ws + WS_WOUT) + (size_t)l * DM * DM, T, DM, DM}; pg8::StaticOrder S; S.init(T, DM, G, bid);
            pg8::EpiResid E{xin, OUTP(), DM};
            pg8::gemm_phase<pg8::EpiResid, pg8::StaticOrder, true, true>(lds + RING_OFF, g, S, E, tid_);
        }
        SEAM(pb + 4);
        if (IN(pb + 5) && PHON(8)) { PHL(); unsigned char* ws = WSP(); norm_rows(OUTP(), PTR(12) + (size_t)l * DM, (bf16*)(ws + WS_XN), gw_, NGW, lane_); }
        SEAM(pb + 5);
        if (IN(pb + 6) && PHON(9)) { PHL(); unsigned char* ws = WSP();
            pg8::Gemm g{(bf16*)(ws + WS_XN), (bf16*)(ws + WS_WMQ) + (size_t)l * MEMW * DM, T, MEMW, DM}; pg8::StaticOrder S; S.init(T, MEMW, G, bid);
            pg8::EpiBf16<0> E{(bf16*)(ws + WS_QM), MEMW, nullptr, 0, 0, 1.f};
            pg8::gemm_phase<pg8::EpiBf16<0>, pg8::StaticOrder, true, true>(lds + RING_OFF, g, S, E, tid_);
        }
        SEAM(pb + 6);
        if (IN(pb + 7) && PHON(10)) { PHL(); unsigned char* ws = WSP();
            const bf16* kvm = (const bf16*)(ws + WS_KVM) + (size_t)l * BATCH * NMEM * 1024; const float* gq = PTR(16) + (size_t)l * 256;
            for (int it = gw_; it < T * 4; it += NGW) { const int t = it >> 2, head = it & 3; naive_mem_item((const bf16*)(ws + WS_QM), kvm, (bf16*)(ws + WS_OM), gq, (size_t)t, t >> 11, head, lane_); }
        }
        SEAM(pb + 7);
        if (IN(pb + 8) && PHON(11)) { PHL(); unsigned char* ws = WSP();
            pg8::Gemm g{(bf16*)(ws + WS_OM), (bf16*)(ws + WS_WMO) + (size_t)l * DM * MEMW, T, DM, MEMW}; pg8::StaticOrder S; S.init(T, DM, G, bid);
            pg8::EpiResid E{OUTP(), OUTP(), DM};
            pg8::gemm_phase<pg8::EpiResid, pg8::StaticOrder, true, true>(lds + RING_OFF, g, S, E, tid_);
        }
        SEAM(pb + 8);
        if (IN(pb + 9) && PHON(12)) { PHL(); unsigned char* ws = WSP(); norm_rows(OUTP(), PTR(18) + (size_t)l * DM, (bf16*)(ws + WS_XN), gw_, NGW, lane_); }
        SEAM(pb + 9);
        if (IN(pb + 10) && PHON(13)) { PHL(); unsigned char* ws = WSP();
            pg8::Gemm g{(bf16*)(ws + WS_XN), (bf16*)(ws + WS_WPQ) + (size_t)l * DM * DM, T, DM, DM}; pg8::StaticOrder S; S.init(T, DM, G, bid);
            pg8::EpiBf16<0> E{(bf16*)(ws + WS_QP), DM, nullptr, 0, 0, 1.f};
            pg8::gemm_phase<pg8::EpiBf16<0>, pg8::StaticOrder, true, true>(lds + RING_OFF, g, S, E, tid_);
        }
        SEAM(pb + 10);
        if (IN(pb + 11) && PHON(14)) { PHL(); unsigned char* ws = WSP();
            const bf16* pk = (const bf16*)(ws + WS_PKEYS) + (size_t)l * 8 * 2 * 128 * 128;
            for (int u = bid; u < (T / 256) * PEER_H; u += G) peer_select_unit((const bf16*)(ws + WS_QP), pk, (int*)(ws + WS_PIDX), (float*)(ws + WS_PGATE), u >> 3, u & 7, wave_, lane_);
        }
        SEAM(pb + 11);
        if (IN(pb + 12) && PHON(15)) { PHL(); unsigned char* ws = WSP();
            peer_gather((const bf16*)(ws + WS_XN), (const bf16*)(ws + WS_PU) + (size_t)l * PEER_N * DM, (const bf16*)(ws + WS_PV) + (size_t)l * PEER_N * DM, (const int*)(ws + WS_PIDX), (const float*)(ws + WS_PGATE), OUTP(), gw_, NGW, lane_); }
        SEAM(pb + 12);
    }
#undef IN
#undef SEAM
}

#ifndef MK_MULTI_LAUNCH
#define MK_MULTI_LAUNCH 0
#endif
extern "C" void kernel_launch(void* const* d_in, const int* in_sizes, int n_in, void* d_out, int out_size, void* d_ws, size_t ws_size, hipStream_t stream) {
    static int grid = 0;
    if (grid == 0) {
        if (n_in != 23 || out_size != T * DM || ws_size < WS_END) { fprintf(stderr, "kernel_launch: unexpected shapes (n_in %d, out %d, ws %zu)\n", n_in, out_size, ws_size); grid = -1; return; }
        int dev = 0, cus = 0, per_cu = 0;
        if (hipGetDevice(&dev) != hipSuccess || hipDeviceGetAttribute(&cus, hipDeviceAttributeMultiprocessorCount, dev) != hipSuccess) { grid = -1; return; }
        if (hipFuncSetAttribute((const void*)mega, hipFuncAttributeMaxDynamicSharedMemorySize, LDS_BYTES) != hipSuccess) { fprintf(stderr, "kernel_launch: hipFuncSetAttribute failed\n"); grid = -1; return; }
        if (hipOccupancyMaxActiveBlocksPerMultiprocessor(&per_cu, (const void*)mega, NTHREADS, LDS_BYTES) != hipSuccess || per_cu < 1) { fprintf(stderr, "kernel_launch: occupancy query says %d\n", per_cu); }
        (void)hipGetLastError();
        grid = cus;
    }
    if (grid < 0) return;
    (void)hipMemsetAsync((char*)d_ws + WS_CTL, 0, CTL_ZERO_BYTES, stream);
    Args a{};
    for (int i = 0; i < 23; ++i) a.in[i] = (const float*)d_in[i];
    a.out = (float*)d_out; a.ws = (unsigned char*)d_ws;
#if MK_MULTI_LAUNCH
    for (int p = 0; p < N_PHASES; ++p) { a.ph_lo = p; a.ph_hi = p + 1; a.use_bar = 0; a.pad = 0; hipLaunchKernelGGL(mega, dim3(grid), dim3(NTHREADS), LDS_BYTES, stream, a); }
#else
    a.ph_lo = 0; a.ph_hi = N_PHASES; a.use_bar = 1; a.pad = 0;
    hipLaunchKernelGGL(mega, dim3(grid), dim3(NTHREADS), LDS_BYTES, stream, a);
#endif
    const hipError_t le = hipPeekAtLastError();
    if (le != hipSuccess) fprintf(stderr, "kernel_launch: launch failed: %s\n", hipGetErrorName(le));
}
```

```cpp
#include <hip/hip_runtime.h>
#include <cstdio>
#include <cstdint>
#include <cmath>
__device__ __forceinline__ float shx(float v, int k, int lane);
namespace pg8 {
#define PG8_LAS __attribute__((address_space(3)))
typedef unsigned short bf16_t;
typedef short bf16x8 __attribute__((ext_vector_type(8)));
typedef float f32x4 __attribute__((ext_vector_type(4)));
typedef unsigned u32x4 __attribute__((ext_vector_type(4)));
constexpr int BM = 256, BK = 64, HALF = 128, HTB = HALF * BK * 2  , STAGE_BYTES = 8 * HTB, NXCD = 8, WGM = 8;

__host__ __device__ __forceinline__ int lds_byte(int r, int c) { const int st = (r >> 4) * 2 + (c >> 5), rr = r & 15, cc = c & 31, ob = rr * 64 + cc * 2; return st * 1024 + (ob ^ (((ob >> 9) & 1) << 5)); }
__host__ __device__ __forceinline__ void stage_rc(int b, int& R, int& C) { const int st = b / 1024, sb = b % 1024, swz = sb ^ (((sb >> 9) & 1) << 5); R = (st >> 1) * 16 + swz / 64; C = (st & 1) * 32 + (swz % 64) / 2; }
__host__ __device__ __forceinline__ int perm32(int rho) { const int n = rho >> 4, i = rho & 15; return 8 * (i >> 2) + 4 * n + (i & 3); }

struct Unit { int pm, pn; };
struct Gemm { const bf16_t* A; const bf16_t* Bt; int M, N, K; };

struct StaticOrder {
    int nM, nN, nwg, G, c;
    __host__ __device__ void init(int M, int N, int G_, int c_) { nM = M / BM; nN = N / BM; nwg = nM * nN; G = G_; c = c_; }
    __host__ __device__ bool next(int i, Unit& u) const {
        const long L = (long)i * G + c; if (L >= nwg) return false;
        int wgid = (int)L; { const int q = nwg / NXCD, r = nwg % NXCD, xcd = wgid % NXCD, off = wgid / NXCD; wgid = (xcd < r ? xcd * (q + 1) : r * (q + 1) + (xcd - r) * q) + off; }
        const int nig = WGM * nN, gid = wgid / nig, fm = gid * WGM, gsz = (nM - fm) < WGM ? (nM - fm) : WGM;
        u.pm = fm + ((wgid % nig) % gsz); u.pn = (wgid % nig) / gsz; return true;
    }
    __device__ __forceinline__ void a_ready(const Unit&) const {}
    __device__ __forceinline__ void done(const Unit&) const {}
};

__device__ __forceinline__ unsigned cvt_pk_bf16(float lo, float hi) { unsigned r; asm volatile("v_cvt_pk_bf16_f32 %0, %1, %2" : "=v"(r) : "v"(lo), "v"(hi)); return r; }
typedef float f32x2 __attribute__((ext_vector_type(2)));
__device__ __forceinline__ f32x2 gelu_pk(f32x2 v) {
    const f32x2 av = __builtin_elementwise_abs(v), d = av * 0.2316418882f + 1.0f;
    f32x2 t; t.x = __builtin_amdgcn_rcpf(d.x); t.y = __builtin_amdgcn_rcpf(d.y);
    f32x2 q = t * 0.5307027145f + (-0.7265760135f); q = q * t + 0.7107068705f; q = q * t + (-0.142248368f); q = q * t + 0.127414796f; q = q * t;
    const f32x2 s = (v * v) * (-0.72134752044f);
    f32x2 e; e.x = __builtin_amdgcn_exp2f(s.x); e.y = __builtin_amdgcn_exp2f(s.y);
    const f32x2 m = v * (q * e), r = v - m;
    f32x2 o; o.x = v.x < 0.f ? m.x : r.x; o.y = v.y < 0.f ? m.y : r.y; return o;
}

template <int ACT  > struct EpiBf16 {
    static constexpr bool PERM = true, AFTER_DRAIN = false; static_assert(ACT == 0 || ACT == 1, "EpiBf16: ACT is 0 (none) or 1 (gelu_pk)");
    bf16_t* O; int ldc; const float* bias; int split_cols; size_t split_stride; float scale0;
    __device__ __forceinline__ void operator()(const f32x4 (&acc)[2][2][4][2], const Unit& u, int wr, int wc, int fr, int fq) const {
        const int row0 = u.pm * BM + wr * 64 + fr; int colt = u.pn * BM; bf16_t* base = O;
        float sc = 1.f; if (split_cols) { const int t = colt / split_cols; base += (size_t)t * split_stride; colt -= t * split_cols; if (t == 0) sc = scale0; }
        const int col0 = colt + wc * 32 + 8 * fq, bcol0 = u.pn * BM + wc * 32 + 8 * fq;
        f32x4 bv[2][2];
#pragma unroll
        for (int bj = 0; bj < 2; ++bj)
#pragma unroll
            for (int n = 0; n < 2; ++n) bv[bj][n] = bias ? *(const f32x4*)(bias + bcol0 + bj * HALF + 4 * n) : (f32x4){0.f, 0.f, 0.f, 0.f};
#pragma unroll
        for (int ai = 0; ai < 2; ++ai)
#pragma unroll
            for (int m = 0; m < 4; ++m) { bf16_t* rowp = base + (size_t)(row0 + ai * HALF + m * 16) * ldc + col0;
#pragma unroll
                for (int bj = 0; bj < 2; ++bj) { f32x4 v0 = acc[ai][bj][m][0] + bv[bj][0], v1 = acc[ai][bj][m][1] + bv[bj][1];
                    if (ACT == 1) { f32x2 a = gelu_pk((f32x2){v0[0], v0[1]}), b = gelu_pk((f32x2){v0[2], v0[3]}), c = gelu_pk((f32x2){v1[0], v1[1]}), d = gelu_pk((f32x2){v1[2], v1[3]});
                        v0 = (f32x4){a.x, a.y, b.x, b.y}; v1 = (f32x4){c.x, c.y, d.x, d.y}; }
                    v0 = v0 * sc; v1 = v1 * sc; u32x4 w; w.x = cvt_pk_bf16(v0[0], v0[1]); w.y = cvt_pk_bf16(v0[2], v0[3]); w.z = cvt_pk_bf16(v1[0], v1[1]); w.w = cvt_pk_bf16(v1[2], v1[3]);
                    *(u32x4*)(rowp + bj * HALF) = w; } }
    }
};

typedef unsigned u32x2 __attribute__((ext_vector_type(2)));
struct EpiResid {
    static constexpr bool PERM = false, AFTER_DRAIN = false;
    const float* base; float* out; int ldc;
    __device__ __forceinline__ void operator()(const f32x4 (&acc)[2][2][4][2], const Unit& u, int wr, int wc, int fr, int fq) const {
        const int col0 = u.pn * BM + wc * 32 + 4 * fq;
#pragma unroll
        for (int ai = 0; ai < 2; ++ai)
#pragma unroll
            for (int m = 0; m < 4; ++m) { const size_t off = (size_t)(u.pm * BM + ai * HALF + wr * 64 + m * 16 + fr) * ldc + col0;
#pragma unroll
                for (int bj = 0; bj < 2; ++bj)
#pragma unroll
                    for (int n = 0; n < 2; ++n) { const f32x4 bs = *(const f32x4*)(base + off + bj * HALF + n * 16); *(f32x4*)(out + off + bj * HALF + n * 16) = bs + acc[ai][bj][m][n]; } }
    }
};
struct EpiQKV {
    static constexpr bool PERM = false, AFTER_DRAIN = false;
    bf16_t* O; const float* ga; const float* gb; const float* gc; const float* rope;
    __device__ __forceinline__ void operator()(const f32x4 (&acc)[2][2][4][2], const Unit& u, int wr, int wc, int fr, int fq) const {
        const int hg = u.pn * 4 + wc;
        const float* g = nullptr; bool isq = false, dorope = false;
        if (hg < 12) { g = ga; isq = true; } else if (hg < 16) { g = ga + 64; } else if (hg < 20) { }
        else if (hg < 28) { g = gb; isq = true; } else if (hg < 36) { g = gb + 64; } else if (hg < 44) { }
        else if (hg < 56) { g = gc; isq = true; dorope = true; } else if (hg < 60) { g = gc + 64; dorope = true; }
        const float qs = isq ? 0.125f : 1.0f;
#pragma unroll
        for (int ai = 0; ai < 2; ++ai)
#pragma unroll
            for (int m = 0; m < 4; ++m) {
                const int row = u.pm * BM + ai * HALF + wr * 64 + m * 16 + fr;
                f32x4 v[2][2];
#pragma unroll
                for (int bj = 0; bj < 2; ++bj)
#pragma unroll
                    for (int n = 0; n < 2; ++n) v[bj][n] = acc[ai][bj][m][n];
                if (g) {
                    float ss = 0.f;
#pragma unroll
                    for (int bj = 0; bj < 2; ++bj)
#pragma unroll
                        for (int n = 0; n < 2; ++n) { const f32x4 x = v[bj][n]; ss += (x[0] * x[0] + x[1] * x[1]) + (x[2] * x[2] + x[3] * x[3]); }
                    ss += shx(ss, 16, fr + 16 * fq); ss += shx(ss, 32, fr + 16 * fq);
                    const float r = qs / sqrtf(ss * (1.0f / 64.0f) + 1e-6f);
#pragma unroll
                    for (int bj = 0; bj < 2; ++bj)
#pragma unroll
                        for (int n = 0; n < 2; ++n) v[bj][n] = v[bj][n] * *(const f32x4*)(g + 32 * bj + 16 * n + 4 * fq) * r;
                }
                if (dorope) {
                    const int t = row & 2047, pr = t >> 6, pc = t & 63;
#pragma unroll
                    for (int bj = 0; bj < 2; ++bj) {
                        const int pos = bj ? pc : pr;
                        const float* rp = rope + (size_t)(pos * 16 + 4 * fq) * 2;
                        const f32x4 c01 = *(const f32x4*)rp, c23 = *(const f32x4*)(rp + 4);
                        const f32x4 cs = (f32x4){c01[0], c01[2], c23[0], c23[2]}, sn = (f32x4){c01[1], c01[3], c23[1], c23[3]};
                        const f32x4 x1 = v[bj][0], x2 = v[bj][1];
                        v[bj][0] = x1 * cs - x2 * sn; v[bj][1] = x1 * sn + x2 * cs;
                    }
                }
                bf16_t* rowp = O + (size_t)row * 4096 + hg * 64 + 4 * fq;
#pragma unroll
                for (int bj = 0; bj < 2; ++bj)
#pragma unroll
                    for (int n = 0; n < 2; ++n) { u32x2 w; w.x = cvt_pk_bf16(v[bj][n][0], v[bj][n][1]); w.y = cvt_pk_bf16(v[bj][n][2], v[bj][n][3]); *(u32x2*)(rowp + 32 * bj + 16 * n) = w; }
                asm volatile("" ::: "memory");
            }
    }
};
template <class Epi, class Sched, bool ALIGN_EPI = false, bool SP2 = false>
__device__ __forceinline__ void gemm_phase(PG8_LAS unsigned char* lds, const Gemm g, const Sched& S, const Epi& E, const int tid) {
    const int wid = __builtin_amdgcn_readfirstlane(tid >> 6), lane = tid & 63, wr = wid >> 2, wc = wid & 3, fr = lane & 15, fq = lane >> 4;
    const int K = g.K, nt = K / BK;
    unsigned voffA[2], voffB[2];
#pragma unroll
    for (int i = 0; i < 2; ++i) { int R, C; stage_rc(tid * 16 + i * 8192, R, C); const int Rb = Epi::PERM ? ((R & ~31) + perm32(R & 31)) : R;
        voffA[i] = (unsigned)(R * K + C) * 2u; voffB[i] = (unsigned)(Rb * K + C) * 2u; }
    const size_t kstep = (size_t)(BK * 2);
    const size_t hstep = (size_t)HALF * K * 2;
    const size_t tstep = 2 * hstep;
    const unsigned ldsw = (unsigned)wid * 1024u;
    const int aoff = lds_byte(wr * 64 + fr, fq * 8), boff = lds_byte(wc * 32 + fr, fq * 8);
#define PG8_SA(b, h) (((b) * 2 + (h)) * HTB)
#define PG8_SB(b, h) ((4 + (b) * 2 + (h)) * HTB)
#define PG8_STAGE(bufoff, gbase, voff) do { _Pragma("unroll") for (int _i = 0; _i < 2; ++_i) \
        __builtin_amdgcn_global_load_lds((const unsigned*)((const char*)(gbase) + (voff)[_i]), (PG8_LAS unsigned*)(lds + (bufoff) + ldsw + _i * 8192), 16, 0, 0); } while (0)
#define PG8_LDA(dst, b, h) do { _Pragma("unroll") for (int m = 0; m < 4; ++m) _Pragma("unroll") for (int k = 0; k < 2; ++k) dst[m][k] = *(const PG8_LAS bf16x8*)(lds + PG8_SA(b, h) + aoff + m * 2048 + k * 1024); } while (0)
#define PG8_LDB(dst, b, h) do { _Pragma("unroll") for (int n = 0; n < 2; ++n) _Pragma("unroll") for (int k = 0; k < 2; ++k) dst[n][k] = *(const PG8_LAS bf16x8*)(lds + PG8_SB(b, h) + boff + n * 2048 + k * 1024); } while (0)
#define PG8_MMA(ai, bj, At, Bt) do { __builtin_amdgcn_s_setprio(1); _Pragma("unroll") for (int m = 0; m < 4; ++m) _Pragma("unroll") for (int n = 0; n < 2; ++n) _Pragma("unroll") for (int k = 0; k < 2; ++k) \
        acc[ai][bj][m][n] = __builtin_amdgcn_mfma_f32_16x16x32_bf16(Bt[n][k], At[m][k], acc[ai][bj][m][n], 0, 0, 0); __builtin_amdgcn_s_setprio(0); } while (0)
#define PG8_WAIT_V(n) asm volatile("s_waitcnt vmcnt(" #n ")" ::: "memory")
#define PG8_WAIT_L(n) asm volatile("s_waitcnt lgkmcnt(" #n ")" ::: "memory")
#define PG8_BAR __builtin_amdgcn_s_barrier()
#define PG8_SCHED __builtin_amdgcn_sched_barrier(0)
    Unit cur, nxt; int ui = 0;
    if (!S.next(0, cur)) return;
    f32x4 acc[2][2][4][2];
#pragma unroll
    for (int a = 0; a < 2; ++a)
#pragma unroll
        for (int b = 0; b < 2; ++b)
#pragma unroll
            for (int m = 0; m < 4; ++m)
#pragma unroll
                for (int n = 0; n < 2; ++n) acc[a][b][m][n] = (f32x4){0.f, 0.f, 0.f, 0.f};
    bf16x8 At[4][2], B0[2][2], B1[2][2];
    const char* cA = (const char*)g.A + (size_t)cur.pm * tstep; const char* cB = (const char*)g.Bt + (size_t)cur.pn * tstep;
    S.a_ready(cur);
    if constexpr (SP2) {
        PG8_STAGE(PG8_SB(0, 0), cB, voffB); PG8_STAGE(PG8_SB(0, 1), cB + hstep, voffB); PG8_STAGE(PG8_SA(0, 0), cA, voffA); PG8_STAGE(PG8_SA(0, 1), cA + hstep, voffA);
        if (wr == 1) PG8_BAR;
        PG8_WAIT_V(2); PG8_BAR;
        PG8_STAGE(PG8_SB(1, 0), cB + kstep, voffB); PG8_STAGE(PG8_SA(1, 0), cA + kstep, voffA); PG8_STAGE(PG8_SB(1, 1), cB + hstep + kstep, voffB);
        PG8_WAIT_V(6); PG8_BAR;
    } else {
        PG8_STAGE(PG8_SB(0, 0), cB, voffB); PG8_STAGE(PG8_SA(0, 0), cA, voffA); PG8_STAGE(PG8_SB(0, 1), cB + hstep, voffB); PG8_STAGE(PG8_SA(0, 1), cA + hstep, voffA);
        if (wr == 1) PG8_BAR;
        PG8_WAIT_V(4); PG8_BAR;
        PG8_STAGE(PG8_SB(1, 0), cB + kstep, voffB); PG8_STAGE(PG8_SA(1, 0), cA + kstep, voffA); PG8_STAGE(PG8_SB(1, 1), cB + hstep + kstep, voffB);
        PG8_WAIT_V(6); PG8_BAR;
    }
    for (;;) {
        const bool has_next = S.next(ui + 1, nxt);
        const char* nA = has_next ? (const char*)g.A + (size_t)nxt.pm * tstep : cA; const char* nB = has_next ? (const char*)g.Bt + (size_t)nxt.pn * tstep : cB;
        for (int t = 0; t < nt; t += 2) {
            const bool last = (t == nt - 2);
            const char* a1 = cA + (size_t)(t + 1) * kstep;
            const char* a2 = last ? nA : cA + (size_t)(t + 2) * kstep; const char* b2 = last ? nB : cB + (size_t)(t + 2) * kstep;
            const char* a3 = a2 + kstep; const char* b3 = b2 + kstep;
            if (last && has_next) S.a_ready(nxt);
            if constexpr (SP2) {
            PG8_LDB(B0, 0, 0); PG8_LDB(B1, 0, 1); PG8_SCHED; PG8_LDA(At, 0, 0); PG8_STAGE(PG8_SA(1, 1), a1 + hstep, voffA);
            PG8_WAIT_V(8); PG8_WAIT_L(0); PG8_BAR; PG8_MMA(0, 0, At, B0); PG8_MMA(0, 1, At, B1); PG8_BAR; PG8_SCHED;
            PG8_LDA(At, 0, 1); PG8_STAGE(PG8_SB(0, 0), b2, voffB); PG8_STAGE(PG8_SB(0, 1), b2 + hstep, voffB); PG8_STAGE(PG8_SA(0, 0), a2, voffA);
            PG8_WAIT_V(8); PG8_WAIT_L(0); PG8_BAR; PG8_MMA(1, 0, At, B0); PG8_MMA(1, 1, At, B1); PG8_BAR; PG8_SCHED;
            PG8_LDB(B0, 1, 0); PG8_LDB(B1, 1, 1); PG8_SCHED; PG8_LDA(At, 1, 0); PG8_STAGE(PG8_SA(0, 1), a2 + hstep, voffA);
            PG8_WAIT_V(8); PG8_WAIT_L(0); PG8_BAR; PG8_MMA(0, 0, At, B0); PG8_MMA(0, 1, At, B1); PG8_BAR; PG8_SCHED;
            PG8_LDA(At, 1, 1); PG8_STAGE(PG8_SB(1, 0), b3, voffB); PG8_STAGE(PG8_SB(1, 1), b3 + hstep, voffB); PG8_STAGE(PG8_SA(1, 0), a3, voffA);
            PG8_WAIT_V(8); PG8_WAIT_L(0); PG8_BAR; PG8_MMA(1, 0, At, B0); PG8_MMA(1, 1, At, B1); PG8_BAR; PG8_SCHED;
            } else {
            PG8_LDB(B0, 0, 0); PG8_SCHED; PG8_LDA(At, 0, 0); PG8_STAGE(PG8_SA(1, 1), a1 + hstep, voffA);
            PG8_WAIT_L(8); PG8_BAR; PG8_WAIT_L(0); PG8_MMA(0, 0, At, B0); PG8_BAR; PG8_SCHED;
            PG8_LDB(B1, 0, 1); PG8_STAGE(PG8_SB(0, 0), b2, voffB);
            PG8_BAR; PG8_WAIT_L(0); PG8_MMA(0, 1, At, B1); PG8_BAR;
            PG8_LDA(At, 0, 1); PG8_STAGE(PG8_SA(0, 0), a2, voffA);
            PG8_BAR; PG8_WAIT_L(0); PG8_MMA(1, 0, At, B0); PG8_BAR; PG8_SCHED;
            PG8_STAGE(PG8_SB(0, 1), b2 + hstep, voffB);
            PG8_WAIT_V(6); PG8_BAR; PG8_MMA(1, 1, At, B1); PG8_BAR;
            PG8_LDB(B0, 1, 0); PG8_SCHED; PG8_LDA(At, 1, 0); PG8_STAGE(PG8_SA(0, 1), a2 + hstep, voffA);
            PG8_WAIT_L(8); PG8_BAR; PG8_WAIT_L(0); PG8_MMA(0, 0, At, B0); PG8_BAR; PG8_SCHED;
            PG8_LDB(B1, 1, 1); PG8_STAGE(PG8_SB(1, 0), b3, voffB);
            PG8_BAR; PG8_WAIT_L(0); PG8_MMA(0, 1, At, B1); PG8_BAR;
            PG8_LDA(At, 1, 1); PG8_STAGE(PG8_SA(1, 0), a3, voffA);
            PG8_BAR; PG8_WAIT_L(0); PG8_MMA(1, 0, At, B0); PG8_BAR; PG8_SCHED;
            PG8_STAGE(PG8_SB(1, 1), b3 + hstep, voffB);
            PG8_WAIT_V(6); PG8_BAR; PG8_MMA(1, 1, At, B1); PG8_BAR;
            }
        }
        if constexpr (ALIGN_EPI) { if (wr == 0) PG8_BAR; }
        if constexpr (!Epi::AFTER_DRAIN) { E(acc, cur, wr, wc, fr, fq); S.done(cur); }
        if (!has_next) break;
#pragma unroll
        for (int a = 0; a < 2; ++a)
#pragma unroll
            for (int b = 0; b < 2; ++b)
#pragma unroll
                for (int m = 0; m < 4; ++m)
#pragma unroll
                    for (int n = 0; n < 2; ++n) acc[a][b][m][n] = (f32x4){0.f, 0.f, 0.f, 0.f};
        cur = nxt; cA = nA; cB = nB; ++ui;
        if constexpr (ALIGN_EPI) { if (wr == 1) PG8_BAR; }
    }
    PG8_WAIT_V(0);
    if constexpr (!ALIGN_EPI) { if (wr == 0) PG8_BAR; }
    PG8_BAR;
    if constexpr (Epi::AFTER_DRAIN) { E.fused(acc, cur, wr, wc, fr, fq, lds, wid, lane); S.done(cur); }
#undef PG8_SA
#undef PG8_SB
#undef PG8_STAGE
#undef PG8_LDA
#undef PG8_LDB
#undef PG8_MMA
#undef PG8_WAIT_V
#undef PG8_WAIT_L
#undef PG8_BAR
#undef PG8_SCHED
}
}

constexpr int BATCH = 16, SEQ = 2048, DM = 2048, T = BATCH * SEQ, DEPTH = 2;
constexpr int NMEM = 256, DIN = 4096, MEMW = 512;
constexpr int PEER_H = 8, PEER_N = 16384;
constexpr int NWAVES = 8, NTHREADS = NWAVES * 64;
constexpr float EPS = 1e-6f;
constexpr int QA = 0, KA = 768, VA = 1024, QB = 1280, KB = 1792, VB = 2304, QC = 2816, KC = 3584, VC = 3840;
constexpr int OA = 0, OB = 768, OC = 1280;

constexpr size_t MiB = 1u << 20;
constexpr size_t WS_CTL = 0, CTL_ZERO_BYTES = 1 * MiB;
constexpr size_t WS_ROPE = 1 * MiB, WS_BIASA = 1 * MiB + 16384;
constexpr size_t WS_WIN = 2 * MiB, WS_WOUT = 34 * MiB, WS_WMQ = 50 * MiB, WS_WMKV = 54 * MiB, WS_WMO = 62 * MiB, WS_WPQ = 66 * MiB, WS_PKEYS = 82 * MiB;
constexpr size_t WS_MEMN = 84 * MiB, WS_KVM = 116 * MiB, WS_PU = 132 * MiB, WS_PV = 260 * MiB, WS_XN = 388 * MiB, WS_QKV = 516 * MiB, WS_ATT = 772 * MiB;
constexpr size_t WS_QM = 900 * MiB, WS_OM = 932 * MiB, WS_END = 964 * MiB;
constexpr size_t WS_QP = WS_QKV, WS_PIDX = WS_QKV + 128 * MiB, WS_PGATE = WS_QKV + 144 * MiB;
constexpr int CW_BAR = 4096;

constexpr int RING_OFF = 0, RING_BYTES = 131072;
constexpr int LDSCTL_OFF = RING_BYTES, MISC_OFF = LDSCTL_OFF + 320;
constexpr int LDS_BYTES = 147456;

#define GAS __attribute__((address_space(1)))
#define LAS __attribute__((address_space(3)))
typedef unsigned short bf16;
typedef unsigned v4u __attribute__((ext_vector_type(4)));
typedef unsigned v2u __attribute__((ext_vector_type(2)));
typedef float f32x4 __attribute__((ext_vector_type(4)));
typedef float f32x16 __attribute__((ext_vector_type(16)));
typedef short bf16x8 __attribute__((ext_vector_type(8)));
typedef GAS unsigned gu32;
#define LDS_WAIT() asm volatile("s_waitcnt lgkmcnt(0)" ::: "memory")
#define VM_WAIT() asm volatile("s_waitcnt vmcnt(0)" ::: "memory")
__device__ __forceinline__ unsigned f2bf(float f) { unsigned u = __builtin_bit_cast(unsigned, f); return (u + 0x7fffu + ((u >> 16) & 1u)) >> 16; }
__device__ __forceinline__ unsigned pk2(float lo, float hi) { return f2bf(lo) | (f2bf(hi) << 16); }
__device__ __forceinline__ float bflo(unsigned w) { return __builtin_bit_cast(float, w << 16); }
__device__ __forceinline__ float bfhi(unsigned w) { return __builtin_bit_cast(float, w & 0xffff0000u); }

__device__ __forceinline__ float shx(float v, int k, int lane) { return __builtin_bit_cast(float, __builtin_amdgcn_ds_bpermute((lane ^ k) << 2, __builtin_bit_cast(int, v))); }
#define XB_TMO      128
#define XB_XCNT(j)  (256  + 64 * (j))
#define XB_XSUB(j)  (1280 + 64 * (j))
#define XB_XGEN(j)  (2304 + 64 * (j))
#define XB_TOP      3328
#define XB_TOPGEN   3392
#define XCD_BAR_WORDS 3456
#define XB_SPIN_CAP (1u << 18)

__device__ __forceinline__ unsigned xb_ld(unsigned* p)              { return __hip_atomic_load(p, __ATOMIC_RELAXED, __HIP_MEMORY_SCOPE_AGENT); }
__device__ __forceinline__ unsigned xb_add(unsigned* p, unsigned v) { return __hip_atomic_fetch_add(p, v, __ATOMIC_RELAXED, __HIP_MEMORY_SCOPE_AGENT); }
__device__ __forceinline__ unsigned xb_xcc_id() { return (unsigned)__builtin_amdgcn_s_getreg((3 << 11) | 20) & 0xFu; }
#define XB_SPIN(cond, bar) do { unsigned _sp = 0; while (cond) { __builtin_amdgcn_s_sleep(1); \
    if ((++_sp & 255u) == 0u) { if (xb_ld(&(bar)[XB_TMO])) break; if (_sp > XB_SPIN_CAP) { atomicAdd(&(bar)[XB_TMO], 1u); break; } } } } while (0)

struct XcdBarrier {
    unsigned* bar; unsigned x;
    volatile LAS unsigned* st;
};

__device__ __forceinline__ XcdBarrier xcd_barrier_post(unsigned* bar, volatile LAS unsigned* st) {
    XcdBarrier b; b.bar = bar; b.x = xb_xcc_id(); b.st = st;
    if (threadIdx.x == 0) (void)xb_add(&bar[XB_XCNT(b.x)], 1u);
    return b;
}
__device__ __forceinline__ void xcd_barrier_complete(unsigned* bar, unsigned x, unsigned& nloc, unsigned& nx) {
    const unsigned G = gridDim.x * gridDim.y * gridDim.z;
    unsigned sum, cnt, mine, sp = 0u;
    for (;;) {
        sum = 0u; cnt = 0u; mine = 0u;
#pragma unroll
        for (unsigned j = 0; j < 16; ++j) { const unsigned c = xb_ld(&bar[XB_XCNT(j)]); sum += c; cnt += (c > 0u) ? 1u : 0u; mine = (j == x) ? c : mine; }
        if (sum == G) break;
        __builtin_amdgcn_s_sleep(1);
        if ((++sp & 255u) == 0u) { if (xb_ld(&bar[XB_TMO])) break; if (sp > XB_SPIN_CAP) { atomicAdd(&bar[XB_TMO], 1u); break; } }
    }
    nloc = mine > 0u ? mine : 1u; nx = cnt > 0u ? cnt : 1u;
}

__device__ __forceinline__ void xcd_barrier(const XcdBarrier& b) {
    asm volatile("s_waitcnt vmcnt(0)" ::: "memory");
    __syncthreads();
    if (threadIdx.x == 0) {
        unsigned* bar = b.bar;
        __builtin_amdgcn_s_waitcnt(0);
        unsigned nloc = b.st[0], nx = b.st[1];
        if (nloc == 0u) { xcd_barrier_complete(bar, b.x, nloc, nx); b.st[0] = nloc; b.st[1] = nx; }
        const unsigned old = xb_add(&bar[XB_XSUB(b.x)], 1u);
        const unsigned gen = old / nloc;
        if (old + 1u == (gen + 1u) * nloc) {
            __builtin_amdgcn_fence(__ATOMIC_RELEASE, "agent");
            asm volatile("s_waitcnt vmcnt(0)" ::: "memory");
            const unsigned og = xb_add(&bar[XB_TOP], 1u);
            const unsigned tg = og / nx;
            if (og + 1u == (tg + 1u) * nx) xb_add(&bar[XB_TOPGEN], 1u);
            else XB_SPIN(xb_ld(&bar[XB_TOPGEN]) == tg, bar);
            __builtin_amdgcn_fence(__ATOMIC_ACQUIRE, "agent");
            xb_add(&bar[XB_XGEN(b.x)], 1u);
            asm volatile("s_waitcnt vmcnt(0)" ::: "memory");
        } else {
            XB_SPIN(xb_ld(&bar[XB_XGEN(b.x)]) == gen, bar);
            __builtin_amdgcn_fence(__ATOMIC_ACQUIRE, "agent");
            asm volatile("s_waitcnt vmcnt(0)" ::: "memory");
        }
    }
    __syncthreads();
}

__device__ __forceinline__ float wave_sum(float v, int lane) {
#pragma unroll
    for (int o = 1; o < 64; o <<= 1) v += shx(v, o, lane);
    return v;
}
__device__ __forceinline__ void* ldptr(LAS unsigned char* lds, int i) {
    const unsigned long long v = ((const LAS unsigned long long*)(lds + LDSCTL_OFF + 1024))[i];
    const unsigned lo = __builtin_amdgcn_readfirstlane((unsigned)v), hi = __builtin_amdgcn_readfirstlane((unsigned)(v >> 32));
    return (void*)(((unsigned long long)hi << 32) | lo);
}
struct OffsetOrder {
    pg8::StaticOrder S;
    __device__ void init(int M, int N, int G, int c, int off) { S.init(M, N, G, (c + G - off % G) % G); }
    __device__ bool next(int i, pg8::Unit& u) const { return S.next(i, u); }
    __device__ __forceinline__ void a_ready(const pg8::Unit&) const {}
    __device__ __forceinline__ void done(const pg8::Unit&) const {}
};

template <bool PERMQKV>
__device__ __forceinline__ void transpose_item(const float* W, int K, int N, bf16* WT, LAS float* scr, int item, int lane) {
    const int nblk = N / 32, kb = item / nblk, nb = item % nblk, k0 = 64 * kb, n0 = 32 * nb;
    int d0 = n0;
    if (PERMQKV) { const int within = n0 & 255; d0 = (n0 & ~255) + 128 * ((within >> 5) & 1) + 32 * (within >> 6); }
#pragma unroll 8
    for (int i = 0; i < 32; ++i) { const int kk = 2 * i + (lane >> 5); scr[kk * 33 + (lane & 31)] = W[(size_t)(k0 + kk) * N + n0 + (lane & 31)]; }
    LDS_WAIT(); asm volatile("" ::: "memory");
    const int c = lane & 7;
#pragma unroll
    for (int j = 0; j < 4; ++j) { const int n = (lane >> 3) + 8 * j; const LAS float* s = scr + (8 * c) * 33 + n;
        v4u o; o.x = pk2(s[0 * 33], s[1 * 33]); o.y = pk2(s[2 * 33], s[3 * 33]); o.z = pk2(s[4 * 33], s[5 * 33]); o.w = pk2(s[6 * 33], s[7 * 33]);
        *(GAS v4u*)(WT + (size_t)(d0 + n) * K + k0 + 8 * c) = o; }
    LDS_WAIT(); asm volatile("" ::: "memory");
}
__device__ __forceinline__ void convert_bf16(const float* src, bf16* dst, size_t n, size_t gtid, size_t nthreads) {
    for (size_t i = gtid * 8; i < n; i += nthreads * 8) {
        const f32x4 a = *(const GAS f32x4*)(src + i), b = *(const GAS f32x4*)(src + i + 4);
        v4u o; o.x = pk2(a[0], a[1]); o.y = pk2(a[2], a[3]); o.z = pk2(b[0], b[1]); o.w = pk2(b[2], b[3]);
        *(GAS v4u*)(dst + i) = o;
    }
}
__device__ __forceinline__ int t5_bucket(int rel) {
    const int n = rel < 0 ? -rel : rel;
    const int b = n < 8 ? n : n < 12 ? 8 : n < 16 ? 9 : n < 23 ? 10 : n < 32 ? 11 : n < 46 ? 12 : n < 64 ? 13 : n < 91 ? 14 : 15;
    return b + (rel > 0 ? 16 : 0);
}
__constant__ float ROPE_INV[16] = {1.000000000e+00f, 5.623413324e-01f, 3.162277639e-01f, 1.778279394e-01f, 1.000000015e-01f, 5.623413250e-02f, 3.162277490e-02f, 1.778279431e-02f,
                                   9.999999776e-03f, 5.623413250e-03f, 3.162277630e-03f, 1.778279431e-03f, 1.000000047e-03f, 5.623413017e-04f, 3.162277571e-04f, 1.778279402e-04f};

__device__ __forceinline__ void rms_row_to_bf16(const float* xrow, const float* g0, bf16* o0, const float* g1, bf16* o1, int lane) {
    const GAS f32x4* xr = (const GAS f32x4*)xrow + lane;
    f32x4 v[8]; float s = 0.f;
#pragma unroll
    for (int j = 0; j < 8; ++j) { v[j] = xr[64 * j]; s += (v[j].x * v[j].x + v[j].y * v[j].y) + (v[j].z * v[j].z + v[j].w * v[j].w); }
    const float rstd = 1.f / sqrtf(wave_sum(s, lane) * (1.f / DM) + EPS);
    {   const GAS f32x4* gr = (const GAS f32x4*)g0 + lane; GAS v2u* o8 = (GAS v2u*)o0 + lane;
#pragma unroll
        for (int j = 0; j < 8; ++j) { const f32x4 gg = gr[64 * j]; v2u w; w.x = pk2(v[j].x * rstd * gg.x, v[j].y * rstd * gg.y); w.y = pk2(v[j].z * rstd * gg.z, v[j].w * rstd * gg.w); o8[64 * j] = w; } }
    if (g1) { const GAS f32x4* gr = (const GAS f32x4*)g1 + lane; GAS v2u* o8 = (GAS v2u*)o1 + lane;
#pragma unroll
        for (int j = 0; j < 8; ++j) { const f32x4 gg = gr[64 * j]; v2u w; w.x = pk2(v[j].x * rstd * gg.x, v[j].y * rstd * gg.y); w.y = pk2(v[j].z * rstd * gg.z, v[j].w * rstd * gg.w); o8[64 * j] = w; } }
}
__device__ __forceinline__ void norm_rows(const float* X, const float* g, bf16* XN, int gw, int NGW, int lane) {
    for (int m = gw; m < T; m += NGW) rms_row_to_bf16(X + (size_t)m * DM, g, XN + (size_t)m * DM, nullptr, nullptr, lane);
}

template <int TYPE>
__device__ __forceinline__ void naive_attn_item(const bf16* QKV, bf16* ATT, int b, int grow, int head, int lane, const float* biasA, const float* sink, const float* rpb) {
    const int tpos = grow * 64 + lane; const size_t trow = (size_t)b * SEQ + tpos;
    int qcol, kcol, vcol, ocol;
    if (TYPE == 0) { qcol = QA + head * 64; kcol = KA + (head / 3) * 64; vcol = VA + (head / 3) * 64; ocol = OA + head * 64; }
    else if (TYPE == 1) { qcol = QB + head * 64; kcol = KB + head * 64; vcol = VB + head * 64; ocol = OB + head * 64; }
    else { qcol = QC + head * 64; kcol = KC + (head / 3) * 64; vcol = VC + (head / 3) * 64; ocol = OC + head * 64; }
    float q[64], o[64];
#pragma unroll
    for (int c = 0; c < 8; ++c) { const v4u w = *(const GAS v4u*)(QKV + trow * DIN + qcol + 8 * c);
        q[8 * c + 0] = bflo(w.x); q[8 * c + 1] = bfhi(w.x); q[8 * c + 2] = bflo(w.y); q[8 * c + 3] = bfhi(w.y); q[8 * c + 4] = bflo(w.z); q[8 * c + 5] = bfhi(w.z); q[8 * c + 6] = bflo(w.w); q[8 * c + 7] = bfhi(w.w); }
#pragma unroll
    for (int d = 0; d < 64; ++d) o[d] = 0.f;
    float m = -1e30f, l = 0.f;
    int j0, j1;
    if (TYPE == 0) { j0 = grow * 64 - 128; if (j0 < 0) j0 = 0; j1 = grow * 64 + 63 + 128; if (j1 > SEQ - 1) j1 = SEQ - 1; }
    else if (TYPE == 1) { int r0 = grow - 4; r0 = r0 < 0 ? 0 : (r0 > 24 ? 24 : r0); j0 = r0 * 64; j1 = j0 + 511; }
    else { j0 = 0; j1 = SEQ - 1; }
    int c0 = lane - 8; c0 = c0 < 0 ? 0 : (c0 > 48 ? 48 : c0);
#pragma unroll 1
    for (int j = j0; j <= j1; ++j) {
        const bf16* krow = QKV + ((size_t)b * SEQ + j) * DIN;
        float s = 0.f;
#pragma unroll
        for (int c = 0; c < 8; ++c) { const v4u w = *(const GAS v4u*)(krow + kcol + 8 * c);
            s += q[8 * c + 0] * bflo(w.x) + q[8 * c + 1] * bfhi(w.x) + q[8 * c + 2] * bflo(w.y) + q[8 * c + 3] * bfhi(w.y) + q[8 * c + 4] * bflo(w.z) + q[8 * c + 5] * bfhi(w.z) + q[8 * c + 6] * bflo(w.w) + q[8 * c + 7] * bfhi(w.w); }
        bool valid = true;
        if (TYPE == 0) { const int rel = j - tpos; valid = (rel >= -128 && rel <= 128); if (valid) s += biasA[head * 257 + rel + 128]; }
        if (TYPE == 1) { const int kr = j >> 6, kc = j & 63; valid = (kc >= c0 && kc < c0 + 16); if (valid) s += rpb[(head * 15 + (kr - grow + 7)) * 31 + (kc - lane + 15)]; }
        const float mn = valid ? fmaxf(m, s) : m;
        const float a = __expf(m - mn);
        const float p = valid ? __expf(s - mn) : 0.f;
        l = l * a + p; m = mn;
#pragma unroll
        for (int c = 0; c < 8; ++c) { const v4u w = *(const GAS v4u*)(krow + vcol + 8 * c);
            o[8 * c + 0] = o[8 * c + 0] * a + p * bflo(w.x); o[8 * c + 1] = o[8 * c + 1] * a + p * bfhi(w.x); o[8 * c + 2] = o[8 * c + 2] * a + p * bflo(w.y); o[8 * c + 3] = o[8 * c + 3] * a + p * bfhi(w.y);
            o[8 * c + 4] = o[8 * c + 4] * a + p * bflo(w.z); o[8 * c + 5] = o[8 * c + 5] * a + p * bfhi(w.z); o[8 * c + 6] = o[8 * c + 6] * a + p * bflo(w.w); o[8 * c + 7] = o[8 * c + 7] * a + p * bfhi(w.w); }
    }
    if (TYPE == 0) l += __expf(sink[head] - m);
    const float inv = 1.f / l;
#pragma unroll
    for (int c = 0; c < 8; ++c) { v4u w; w.x = pk2(o[8 * c + 0] * inv, o[8 * c + 1] * inv); w.y = pk2(o[8 * c + 2] * inv, o[8 * c + 3] * inv); w.z = pk2(o[8 * c + 4] * inv, o[8 * c + 5] * inv); w.w = pk2(o[8 * c + 6] * inv, o[8 * c + 7] * inv);
        *(GAS v4u*)(ATT + trow * DM + ocol + 8 * c) = w; }
}
__device__ __forceinline__ float rdl(float v, int l) { return __builtin_bit_cast(float, __builtin_amdgcn_readlane(__builtin_bit_cast(int, v), l)); }
__device__ __forceinline__ void naive_mem_item(const bf16* QM, const bf16* KVM, bf16* OM, const float* gq, size_t trow, int b, int head, int lane) {
    const unsigned qw = *(const GAS unsigned*)(QM + trow * MEMW + head * 128 + 2 * lane);
    float q0 = bflo(qw), q1 = bfhi(qw);
    const float ss = wave_sum(q0 * q0 + q1 * q1, lane);
    const float r = 0.08838834764831845f / sqrtf(ss * (1.f / 128.f) + EPS);
    q0 *= r * gq[2 * lane]; q1 *= r * gq[2 * lane + 1];
    const bf16* kbase = KVM + ((size_t)b * NMEM + lane) * 1024 + head * 128;
    float s[4] = {0.f, 0.f, 0.f, 0.f};
#pragma unroll 1
    for (int c = 0; c < 16; ++c) {
        float qa[8];
#pragma unroll
        for (int e = 0; e < 4; ++e) { qa[2 * e] = rdl(q0, 4 * c + e); qa[2 * e + 1] = rdl(q1, 4 * c + e); }
#pragma unroll
        for (int i = 0; i < 4; ++i) { const v4u w = *(const GAS v4u*)(kbase + (size_t)i * 64 * 1024 + 8 * c);
            s[i] += qa[0] * bflo(w.x) + qa[1] * bfhi(w.x) + qa[2] * bflo(w.y) + qa[3] * bfhi(w.y) + qa[4] * bflo(w.z) + qa[5] * bfhi(w.z) + qa[6] * bflo(w.w) + qa[7] * bfhi(w.w); }
    }
    float m = fmaxf(fmaxf(s[0], s[1]), fmaxf(s[2], s[3]));
#pragma unroll
    for (int o = 1; o < 64; o <<= 1) m = fmaxf(m, shx(m, o, lane));
    float p[4]; float l = 0.f;
#pragma unroll
    for (int i = 0; i < 4; ++i) { p[i] = __expf(s[i] - m); l += p[i]; }
    l = wave_sum(l, lane);
    const bf16* vbase = KVM + ((size_t)b * NMEM) * 1024 + 512 + head * 128 + 2 * lane;
    float o0 = 0.f, o1 = 0.f;
#pragma unroll
    for (int i = 0; i < 4; ++i) {
#pragma unroll 4
        for (int jj = 0; jj < 64; ++jj) { const float pj = rdl(p[i], jj); const unsigned w = *(const GAS unsigned*)(vbase + (size_t)(64 * i + jj) * 1024); o0 += pj * bflo(w); o1 += pj * bfhi(w); }
    }
    const float inv = 1.f / l;
    *(GAS unsigned*)(OM + trow * MEMW + head * 128 + 2 * lane) = pk2(o0 * inv, o1 * inv);
}
__device__ __forceinline__ void mixnorm_rows(bf16* ATT, const float* g, int gw, int NGW, int lane) {
    for (int m = gw; m < T; m += NGW) {
        GAS v4u* p = (GAS v4u*)(ATT + (size_t)m * DM + 32 * lane);
        v4u w[4]; float f[32]; float ss = 0.f;
#pragma unroll
        for (int c = 0; c < 4; ++c) { w[c] = p[c];
            f[8 * c + 0] = bflo(w[c].x); f[8 * c + 1] = bfhi(w[c].x); f[8 * c + 2] = bflo(w[c].y); f[8 * c + 3] = bfhi(w[c].y); f[8 * c + 4] = bflo(w[c].z); f[8 * c + 5] = bfhi(w[c].z); f[8 * c + 6] = bflo(w[c].w); f[8 * c + 7] = bfhi(w[c].w); }
#pragma unroll
        for (int i = 0; i < 32; ++i) ss += f[i] * f[i];
        const int grp = lane < 24 ? 0 : (lane < 40 ? 1 : 2);
        const float sa = wave_sum(grp == 0 ? ss : 0.f, lane), sb = wave_sum(grp == 1 ? ss : 0.f, lane), sc = wave_sum(grp == 2 ? ss : 0.f, lane);
        const float r = grp == 0 ? 1.f / sqrtf(sa * (1.f / 768.f) + EPS) : (grp == 1 ? 1.f / sqrtf(sb * (1.f / 512.f) + EPS) : 1.f / sqrtf(sc * (1.f / 768.f) + EPS));
        const float* gg = g + 32 * lane;
#pragma unroll
        for (int c = 0; c < 4; ++c) { const f32x4 g0 = *(const GAS f32x4*)(gg + 8 * c), g1 = *(const GAS f32x4*)(gg + 8 * c + 4);
            v4u o; o.x = pk2(f[8 * c + 0] * r * g0[0], f[8 * c + 1] * r * g0[1]); o.y = pk2(f[8 * c + 2] * r * g0[2], f[8 * c + 3] * r * g0[3]);
            o.z = pk2(f[8 * c + 4] * r * g1[0], f[8 * c + 5] * r * g1[1]); o.w = pk2(f[8 * c + 6] * r * g1[2], f[8 * c + 7] * r * g1[3]); p[c] = o; }
    }
}

#ifndef PEER_HD
#define PEER_HD __device__ __forceinline__
#define PEER_EXP(x) __expf(x)
#endif
template <int N> PEER_HD void bitonic_sort_desc(float* v) {
#pragma unroll
    for (int k = 2; k <= N; k <<= 1)
#pragma unroll
        for (int j = k >> 1; j > 0; j >>= 1)
#pragma unroll
            for (int i = 0; i < N; ++i) { const int l = i ^ j; if (l > i) { const bool desc = ((i & k) == 0); const float a = v[i], b = v[l]; const float hi = fmaxf(a, b), lo = fminf(a, b);
                v[i] = desc ? hi : lo; v[l] = desc ? lo : hi; } }
}
PEER_HD void merge_top16(float* a, const float* b) {
    float c[16];
#pragma unroll
    for (int i = 0; i < 16; ++i) c[i] = fmaxf(a[i], b[15 - i]);
#pragma unroll
    for (int j = 8; j > 0; j >>= 1)
#pragma unroll
        for (int i = 0; i < 16; ++i) { const int l = i ^ j; if (l > i) { const float x = c[i], y = c[l]; c[i] = fmaxf(x, y); c[l] = fminf(x, y); } }
#pragma unroll
    for (int i = 0; i < 16; ++i) a[i] = c[i];
}
PEER_HD void top16_of_64(float (&v)[64]) {
    bitonic_sort_desc<16>(&v[0]); bitonic_sort_desc<16>(&v[16]); bitonic_sort_desc<16>(&v[32]); bitonic_sort_desc<16>(&v[48]);
    merge_top16(&v[0], &v[16]); merge_top16(&v[32], &v[48]); merge_top16(&v[0], &v[32]);
}
PEER_HD float pack_idx(float s, unsigned idx, unsigned mask) { return __builtin_bit_cast(float, (__builtin_bit_cast(unsigned, s) & ~mask) | idx); }
PEER_HD unsigned low_bits(float s, unsigned mask) { return __builtin_bit_cast(unsigned, s) & mask; }
PEER_HD unsigned pick16(const float* a, unsigned i, unsigned mask) {
    unsigned r = 0;
#pragma unroll
    for (unsigned k = 0; k < 16; ++k) r = (i == k) ? low_bits(a[k], mask) : r;
    return r;
}
PEER_HD void peer_candidates(const float* a, const float* b, int* e, float* gate) {
    float c[64]; int n = 0;
#pragma unroll
    for (int i = 0; i < 16; ++i)
#pragma unroll
        for (int j = 0; j < 16; ++j) if ((i + 1) * (j + 1) <= 16) { c[n] = pack_idx(a[i] + b[j], (unsigned)(i * 16 + j), 0xffu); ++n; }
#pragma unroll
    for (int k = 50; k < 64; ++k) c[k] = -3.0e38f;
    top16_of_64(c);
    float mx = c[0], den = 0.f;
#pragma unroll
    for (int k = 0; k < 16; ++k) { const unsigned id = low_bits(c[k], 0xffu); const unsigned n0 = pick16(a, id >> 4, 0x7fu), n1 = pick16(b, id & 15u, 0x7fu);
        e[k] = (int)(n0 * 128u + n1); gate[k] = PEER_EXP(c[k] - mx); den += gate[k]; }
    const float inv = 1.f / den;
#pragma unroll
    for (int k = 0; k < 16; ++k) gate[k] *= inv;
}

__device__ __forceinline__ void peer_select_unit(const bf16* QP, const bf16* PK, int* PIDX, float* PGATE, int tb, int h, int wave, int lane) {
    const int hh = lane >> 5, tl = lane & 31; const size_t t = (size_t)tb * 256 + wave * 32 + tl;
    float ab[2][16];
#pragma unroll
    for (int p = 0; p < 2; ++p) {
        bf16x8 bq[8];
#pragma unroll
        for (int s = 0; s < 8; ++s) bq[s] = *(const GAS bf16x8*)(QP + t * DM + 256 * h + 128 * p + 16 * s + 8 * hh);
        float v[64];
#pragma unroll
        for (int nb = 0; nb < 4; ++nb) {
            f32x16 acc;
#pragma unroll
            for (int r = 0; r < 16; ++r) acc[r] = 0.f;
            const bf16* kp = PK + ((size_t)((h * 2 + p) * 128 + 32 * nb + tl)) * 128 + 8 * hh;
#pragma unroll
            for (int s = 0; s < 8; ++s) { const bf16x8 ak = *(const GAS bf16x8*)(kp + 16 * s); acc = __builtin_amdgcn_mfma_f32_32x32x16_bf16(ak, bq[s], acc, 0, 0, 0); }
#pragma unroll
            for (int r = 0; r < 16; ++r) v[16 * nb + r] = pack_idx(acc[r], (unsigned)(32 * nb + 8 * (r >> 2) + 4 * hh + (r & 3)), 0x7fu);
        }
        top16_of_64(v);
        float pv[16];
#pragma unroll
        for (int i = 0; i < 16; ++i) pv[i] = shx(v[i], 32, lane);
        merge_top16(&v[0], pv);
#pragma unroll
        for (int i = 0; i < 16; ++i) ab[p][i] = v[i];
    }
    int e[16]; float gate[16];
    peer_candidates(ab[0], ab[1], e, gate);
    if (hh == 0) { GAS v4u* o = (GAS v4u*)(PIDX + t * 128 + h * 16);
#pragma unroll
        for (int c = 0; c < 4; ++c) o[c] = (v4u){(unsigned)e[4 * c], (unsigned)e[4 * c + 1], (unsigned)e[4 * c + 2], (unsigned)e[4 * c + 3]}; }
    else { GAS f32x4* o = (GAS f32x4*)(PGATE + t * 128 + h * 16);
#pragma unroll
        for (int c = 0; c < 4; ++c) o[c] = (f32x4){gate[4 * c], gate[4 * c + 1], gate[4 * c + 2], gate[4 * c + 3]}; }
}

__device__ __forceinline__ float dot8(const v4u& x, const v4u& u) {
    return bflo(x.x) * bflo(u.x) + bfhi(x.x) * bfhi(u.x) + bflo(x.y) * bflo(u.y) + bfhi(x.y) * bfhi(u.y) + bflo(x.z) * bflo(u.z) + bfhi(x.z) * bfhi(u.z) + bflo(x.w) * bflo(u.w) + bfhi(x.w) * bfhi(u.w);
}
__device__ __forceinline__ void axpy8(float* y, float w, const v4u& v) {
    y[0] += w * bflo(v.x); y[1] += w * bfhi(v.x); y[2] += w * bflo(v.y); y[3] += w * bfhi(v.y); y[4] += w * bflo(v.z); y[5] += w * bfhi(v.z); y[6] += w * bflo(v.w); y[7] += w * bfhi(v.w);
}
__device__ __forceinline__ void peer_gather(const bf16* XN, const bf16* PU, const bf16* PV, const int* PIDX, const float* PGATE, float* X, int gw, int NGW, int lane) {
    for (int t = gw; t < T; t += NGW) {
        v4u xv[4];
#pragma unroll
        for (int j = 0; j < 4; ++j) xv[j] = *(const GAS v4u*)(XN + (size_t)t * DM + 8 * lane + 512 * j);
        float y[32];
#pragma unroll
        for (int i = 0; i < 32; ++i) y[i] = 0.f;
        for (int k = 0; k < 128; k += 2) {
            const int e0 = __builtin_amdgcn_readfirstlane(PIDX[(size_t)t * 128 + k]), e1 = __builtin_amdgcn_readfirstlane(PIDX[(size_t)t * 128 + k + 1]);
            const float g0 = PGATE[(size_t)t * 128 + k], g1 = PGATE[(size_t)t * 128 + k + 1];
            v4u u0[4], u1[4], v0[4], v1[4];
#pragma unroll
            for (int j = 0; j < 4; ++j) { u0[j] = *(const GAS v4u*)(PU + (size_t)e0 * DM + 8 * lane + 512 * j); u1[j] = *(const GAS v4u*)(PU + (size_t)e1 * DM + 8 * lane + 512 * j); }
#pragma unroll
            for (int j = 0; j < 4; ++j) { v0[j] = *(const GAS v4u*)(PV + (size_t)e0 * DM + 8 * lane + 512 * j); v1[j] = *(const GAS v4u*)(PV + (size_t)e1 * DM + 8 * lane + 512 * j); }
            float d0 = 0.f, d1 = 0.f;
#pragma unroll
            for (int j = 0; j < 4; ++j) { d0 += dot8(xv[j], u0[j]); d1 += dot8(xv[j], u1[j]); }
            d0 = wave_sum(d0, lane); d1 = wave_sum(d1, lane);
            const float w0 = g0 * 0.5f * d0 * (1.f + erff(d0 * 0.70710678118654752f)), w1 = g1 * 0.5f * d1 * (1.f + erff(d1 * 0.70710678118654752f));
#pragma unroll
            for (int j = 0; j < 4; ++j) { axpy8(&y[8 * j], w0, v0[j]); axpy8(&y[8 * j], w1, v1[j]); }
        }
#pragma unroll
        for (int j = 0; j < 4; ++j) { GAS f32x4* xp = (GAS f32x4*)(X + (size_t)t * DM + 8 * lane + 512 * j);
            f32x4 a = xp[0], b = xp[1]; a += (f32x4){y[8 * j], y[8 * j + 1], y[8 * j + 2], y[8 * j + 3]}; b += (f32x4){y[8 * j + 4], y[8 * j + 5], y[8 * j + 6], y[8 * j + 7]}; xp[0] = a; xp[1] = b; }
    }
}


typedef float f32x2 __attribute__((ext_vector_type(2)));
constexpr float PU_SCALE = 256.f, PV_SCALE = 16.f;
__device__ __forceinline__ void convert_fp8(const float* src, unsigned char* dst, size_t n, float scale, size_t gtid, size_t nthreads) {
    for (size_t i = gtid * 16; i < n; i += nthreads * 16) {
        v4u o;
#pragma unroll
        for (int c = 0; c < 4; ++c) { f32x4 a = *(const GAS f32x4*)(src + i + 4 * c) * scale;
#pragma unroll
            for (int e = 0; e < 4; ++e) a[e] = fminf(fmaxf(a[e], -448.f), 448.f);
            int p = 0; p = __builtin_amdgcn_cvt_pk_fp8_f32(a[0], a[1], p, false); p = __builtin_amdgcn_cvt_pk_fp8_f32(a[2], a[3], p, true); o[c] = (unsigned)p; }
        *(GAS v4u*)(dst + i) = o;
    }
}
__device__ __forceinline__ void dot16_fp8(f32x2& acc, const v4u& w, const f32x2* x) {
#pragma unroll
    for (int c = 0; c < 4; ++c) { acc += __builtin_amdgcn_cvt_pk_f32_fp8((int)w[c], false) * x[2 * c]; acc += __builtin_amdgcn_cvt_pk_f32_fp8((int)w[c], true) * x[2 * c + 1]; }
}
__device__ __forceinline__ void axpy16_fp8(f32x2* y, const f32x2 wv, const v4u& w) {
#pragma unroll
    for (int c = 0; c < 4; ++c) { y[2 * c] += __builtin_amdgcn_cvt_pk_f32_fp8((int)w[c], false) * wv; y[2 * c + 1] += __builtin_amdgcn_cvt_pk_f32_fp8((int)w[c], true) * wv; }
}
#define PG_R 4
#define PG_LOAD(buf, tab, idlo, idhi, g) do { _Pragma("unroll") for (int i_ = 0; i_ < PG_R; ++i_) { const int k_ = (g) * PG_R + i_; \
        const int e_ = __builtin_amdgcn_readlane(k_ < 64 ? idlo : idhi, k_ & 63); const unsigned char* rp_ = (tab) + (size_t)(unsigned)e_ * 2048u; \
        buf[i_][0] = *(const GAS v4u*)(rp_ + voff); buf[i_][1] = *(const GAS v4u*)(rp_ + voff + 1024); } } while (0)
#define PG_DOT(buf, g) do { float p_[4]; _Pragma("unroll") for (int i_ = 0; i_ < 4; ++i_) { f32x2 a_ = {0.f, 0.f}; dot16_fp8(a_, buf[i_][0], &x[0]); dot16_fp8(a_, buf[i_][1], &x[8]); p_[i_] = a_.x + a_.y; __builtin_amdgcn_sched_barrier(0); } \
        float r_[2]; _Pragma("unroll") for (int i_ = 0; i_ < 2; ++i_) { const float keep_ = b5 ? p_[i_ + 2] : p_[i_], send_ = b5 ? p_[i_] : p_[i_ + 2]; r_[i_] = keep_ + shx(send_, 32, lane); } \
        float s_; { const float keep_ = b4 ? r_[1] : r_[0], send_ = b4 ? r_[0] : r_[1]; s_ = keep_ + shx(send_, 16, lane); } \
        s_ += shx(s_, 8, lane); s_ += shx(s_, 4, lane); s_ += shx(s_, 2, lane); s_ += shx(s_, 1, lane); \
        if ((lane & 15) == 0) wl[(g) * 4 + (lane >> 4)] = s_; } while (0)
#define PG_AXPY(buf, g) do { _Pragma("unroll") for (int i_ = 0; i_ < PG_R; ++i_) { const float w_ = wl[(g) * PG_R + i_]; const f32x2 wv_ = {w_, w_}; axpy16_fp8(&y[0], wv_, buf[i_][0]); axpy16_fp8(&y[8], wv_, buf[i_][1]); __builtin_amdgcn_sched_barrier(0); } } while (0)
__device__ __forceinline__ void peer_gather8(const bf16* XN, const unsigned char* PU8, const unsigned char* PV8, const int* PIDX, const float* PGATE, float* X, LAS float* wl, int gw, int NGW, int lane) {
    const bool b5 = (lane >> 5) & 1, b4 = (lane >> 4) & 1; const unsigned voff = 16u * (unsigned)lane;
    for (int t = gw; t < T; t += NGW) {
        const unsigned l4 = 4u * (unsigned)lane; const char* pidx_t = (const char*)(PIDX + (size_t)t * 128); const char* pgate_t = (const char*)(PGATE + (size_t)t * 128);
        const int idlo = *(const GAS int*)(pidx_t + l4), idhi = *(const GAS int*)(pidx_t + l4 + 256);
        v4u A[PG_R][2], B[PG_R][2];
        PG_LOAD(A, PU8, idlo, idhi, 0);
        f32x2 x[16];
        {   const char* xr = (const char*)(XN + (size_t)t * DM); const unsigned l32 = 32u * (unsigned)lane;
            const v4u a0 = *(const GAS v4u*)(xr + l32), a1 = *(const GAS v4u*)(xr + l32 + 16), c0 = *(const GAS v4u*)(xr + l32 + 2048), c1 = *(const GAS v4u*)(xr + l32 + 2064);
#pragma unroll
            for (int c = 0; c < 4; ++c) { x[c] = (f32x2){bflo(a0[c]), bfhi(a0[c])} * (1.f / PU_SCALE); x[4 + c] = (f32x2){bflo(a1[c]), bfhi(a1[c])} * (1.f / PU_SCALE);
                                          x[8 + c] = (f32x2){bflo(c0[c]), bfhi(c0[c])} * (1.f / PU_SCALE); x[12 + c] = (f32x2){bflo(c1[c]), bfhi(c1[c])} * (1.f / PU_SCALE); } }
#pragma unroll 1
        for (int g = 0; g < 128 / PG_R; g += 2) {
            PG_LOAD(B, PU8, idlo, idhi, g + 1);
            PG_DOT(A, g);
            if (g + 2 < 128 / PG_R) PG_LOAD(A, PU8, idlo, idhi, g + 2); else PG_LOAD(A, PV8, idlo, idhi, 0);
            PG_DOT(B, g + 1);
        }
        LDS_WAIT();
        {
            const float g0 = *(const GAS float*)(pgate_t + l4), g1 = *(const GAS float*)(pgate_t + l4 + 256);
            const float d0 = wl[lane], d1 = wl[64 + lane];
            const float w0 = g0 * 0.5f * d0 * (1.f + erff(d0 * 0.70710678118654752f)) * (1.f / PV_SCALE), w1 = g1 * 0.5f * d1 * (1.f + erff(d1 * 0.70710678118654752f)) * (1.f / PV_SCALE);
            LDS_WAIT(); asm volatile("" ::: "memory");
            wl[lane] = w0; wl[64 + lane] = w1;
            LDS_WAIT(); asm volatile("" ::: "memory");
        }
        f32x2 y[16];
#pragma unroll
        for (int i = 0; i < 16; ++i) y[i] = (f32x2){0.f, 0.f};
#pragma unroll 1
        for (int g = 0; g < 128 / PG_R; g += 2) {
            PG_LOAD(B, PV8, idlo, idhi, g + 1);
            PG_AXPY(A, g);
            if (g + 2 < 128 / PG_R) PG_LOAD(A, PV8, idlo, idhi, g + 2);
            PG_AXPY(B, g + 1);
        }
        {   char* xo = (char*)(X + (size_t)t * DM); const unsigned l64 = 64u * (unsigned)lane;
#pragma unroll
            for (int h = 0; h < 2; ++h)
#pragma unroll
                for (int c = 0; c < 4; ++c) { GAS f32x4* p = (GAS f32x4*)(xo + l64 + 4096 * h + 16 * c); f32x4 v = *p; v += (f32x4){y[8 * h + 2 * c].x, y[8 * h + 2 * c].y, y[8 * h + 2 * c + 1].x, y[8 * h + 2 * c + 1].y}; *p = v; } }
        LDS_WAIT(); asm volatile("" ::: "memory");
    }
}

struct Args { const float* in[23]; float* out; unsigned char* ws; int ph_lo, ph_hi, use_bar, pad; };
#ifndef MK_OFF
#define MK_OFF 0u
#endif
#define PHON(k) (!((MK_OFF >> (k)) & 1u))
constexpr int PH_PER_LAYER = 13, PH_BASE = 3, N_PHASES = PH_BASE + DEPTH * PH_PER_LAYER;
constexpr int PTAB_OFF = LDSCTL_OFF + 1024;

__global__ void __launch_bounds__(NTHREADS, 2) mega(Args a) {
    extern __shared__ __attribute__((aligned(16))) unsigned char lds_raw[];
    LAS unsigned char* lds = (LAS unsigned char*)lds_raw;
    {   const int tid0 = threadIdx.x;
        for (int u = tid0; u < (LDS_BYTES - LDSCTL_OFF) / 4; u += NTHREADS) ((LAS unsigned*)(lds + LDSCTL_OFF))[u] = 0u;
        __syncthreads();
        if (tid0 < 23) ((LAS unsigned long long*)(lds + PTAB_OFF))[tid0] = (unsigned long long)a.in[tid0];
        if (tid0 == 23) ((LAS unsigned long long*)(lds + PTAB_OFF))[23] = (unsigned long long)a.out;
        if (tid0 == 24) ((LAS unsigned long long*)(lds + PTAB_OFF))[24] = (unsigned long long)a.ws;
        __syncthreads();
    }
    volatile LAS unsigned* MISC = (volatile LAS unsigned*)(lds + MISC_OFF);
    const int G = gridDim.x, bid = blockIdx.x, NGW = G * NWAVES;
    const int use_bar = a.use_bar;
    XcdBarrier bar; bar.bar = (unsigned*)(a.ws + WS_CTL) + CW_BAR; bar.x = 0; bar.st = MISC + 8;
    if (use_bar) bar = xcd_barrier_post((unsigned*)(a.ws + WS_CTL) + CW_BAR, MISC + 8);
    const int lo = a.ph_lo, hi = a.ph_hi;
#define IN(k) (lo <= (k) && (k) < hi)
#define SEAM(k) do { if (use_bar && IN(k) && IN((k) + 1)) xcd_barrier(bar); } while (0)
#define PHL() int tid_ = threadIdx.x; asm volatile("" : "+v"(tid_)); const int lane_ = tid_ & 63, wave_ = __builtin_amdgcn_readfirstlane(tid_ >> 6), gw_ = bid * NWAVES + wave_; (void)lane_; (void)gw_; \
              int pz_ = 0; asm volatile("" : "+s"(pz_))
#define PTR(i) ((const float*)ldptr(lds, (i) + pz_))
#define WSP() ((unsigned char*)ldptr(lds, 24 + pz_))
#define OUTP() ((float*)ldptr(lds, 23 + pz_))

    if (IN(0) && PHON(0)) {
        PHL(); unsigned char* ws = WSP();
        LAS float* scr = (LAS float*)(lds + RING_OFF + wave_ * 16384);
        constexpr int I_IN = 32 * 128, I_OUT = 32 * 64, I_MQ = 32 * 16, I_MKV = 32 * 32, I_MO = 8 * 64, I_PQ = 32 * 64, I_L = I_IN + I_OUT + I_MQ + I_MKV + I_MO + I_PQ;
        for (int it = gw_; it < DEPTH * I_L; it += NGW) {
            const int l = it / I_L; int r = it % I_L;
            if (r < I_IN) { transpose_item<true>(PTR(4) + (size_t)l * DM * DIN, DM, DIN, (bf16*)(ws + WS_WIN) + (size_t)l * DIN * DM, scr, r, lane_); continue; } r -= I_IN;
            if (r < I_OUT) { transpose_item<false>(PTR(11) + (size_t)l * DM * DM, DM, DM, (bf16*)(ws + WS_WOUT) + (size_t)l * DM * DM, scr, r, lane_); continue; } r -= I_OUT;
            if (r < I_MQ) { transpose_item<false>(PTR(14) + (size_t)l * DM * MEMW, DM, MEMW, (bf16*)(ws + WS_WMQ) + (size_t)l * MEMW * DM, scr, r, lane_); continue; } r -= I_MQ;
            if (r < I_MKV) { transpose_item<false>(PTR(15) + (size_t)l * DM * 1024, DM, 1024, (bf16*)(ws + WS_WMKV) + (size_t)l * 1024 * DM, scr, r, lane_); continue; } r -= I_MKV;
            if (r < I_MO) { transpose_item<false>(PTR(17) + (size_t)l * MEMW * DM, MEMW, DM, (bf16*)(ws + WS_WMO) + (size_t)l * DM * MEMW, scr, r, lane_); continue; } r -= I_MO;
            transpose_item<false>(PTR(19) + (size_t)l * DM * DM, DM, DM, (bf16*)(ws + WS_WPQ) + (size_t)l * DM * DM, scr, r, lane_);
        }
        const size_t gtid = (size_t)bid * NTHREADS + tid_, nth = (size_t)G * NTHREADS;
        convert_bf16(PTR(20), (bf16*)(ws + WS_PKEYS), (size_t)DEPTH * 8 * 2 * 128 * 128, gtid, nth);
        convert_fp8(PTR(21), ws + WS_PU, (size_t)DEPTH * PEER_N * DM, PU_SCALE, gtid, nth);
        convert_fp8(PTR(22), ws + WS_PV, (size_t)DEPTH * PEER_N * DM, PV_SCALE, gtid, nth);
        {   const float* mem = PTR(1); const float* gkv = PTR(13); bf16* MEMN = (bf16*)(ws + WS_MEMN);
            for (int m = gw_; m < BATCH * NMEM; m += NGW)
                rms_row_to_bf16(mem + (size_t)m * DM, gkv, MEMN + (size_t)m * DM, gkv + DM, MEMN + (size_t)(BATCH * NMEM + m) * DM, lane_); }
        float* rope = (float*)(ws + WS_ROPE); float* biasA = (float*)(ws + WS_BIASA);
        if (gtid < 64 * 16) { const int pos = (int)gtid >> 4, i = (int)gtid & 15; const float ang = (float)pos * ROPE_INV[i]; rope[gtid * 2] = cosf(ang); rope[gtid * 2 + 1] = sinf(ang); }
        if (gtid < 12 * 257) { const int h = (int)gtid / 257, rel = (int)gtid % 257 - 128; biasA[gtid] = PTR(2)[t5_bucket(rel) * 12 + h]; }
    }
    SEAM(0);
    if (IN(1) && PHON(1)) {
#pragma unroll 1
        for (int l = 0; l < DEPTH; ++l) {
            PHL(); unsigned char* ws = WSP();
            pg8::Gemm g{(bf16*)(ws + WS_MEMN) + (size_t)l * BATCH * NMEM * DM, (bf16*)(ws + WS_WMKV) + (size_t)l * 1024 * DM, BATCH * NMEM, 1024, DM};
            OffsetOrder S; S.init(BATCH * NMEM, 1024, G, bid, 64 * l);
            pg8::EpiBf16<0> E{(bf16*)(ws + WS_KVM) + (size_t)l * BATCH * NMEM * 1024, 1024, nullptr, 0, 0, 1.f};
            pg8::gemm_phase<pg8::EpiBf16<0>, OffsetOrder, true, true>(lds + RING_OFF, g, S, E, tid_);
            __syncthreads();
        }
    }
    SEAM(1);
    if (IN(2) && PHON(2)) {
        PHL(); unsigned char* ws = WSP(); bf16* KVM = (bf16*)(ws + WS_KVM); const float* gm = PTR(16);
        for (int m = gw_; m < DEPTH * BATCH * NMEM; m += NGW) {
            const int l = m / (BATCH * NMEM);
            GAS v4u* p = (GAS v4u*)(KVM + (size_t)m * 1024 + 8 * lane_);
            const v4u w = *p;
            float f[8] = {bflo(w.x), bfhi(w.x), bflo(w.y), bfhi(w.y), bflo(w.z), bfhi(w.z), bflo(w.w), bfhi(w.w)};
            float ss = 0.f;
#pragma unroll
            for (int i = 0; i < 8; ++i) ss += f[i] * f[i];
            ss += shx(ss, 1, lane_); ss += shx(ss, 2, lane_); ss += shx(ss, 4, lane_); ss += shx(ss, 8, lane_);
            const float r = 1.f / sqrtf(ss * (1.f / 128.f) + EPS);
            const float* gk = gm + (size_t)l * 256 + 128 + 8 * (lane_ & 15);
            v4u o; o.x = pk2(f[0] * r * gk[0], f[1] * r * gk[1]); o.y = pk2(f[2] * r * gk[2], f[3] * r * gk[3]); o.z = pk2(f[4] * r * gk[4], f[5] * r * gk[5]); o.w = pk2(f[6] * r * gk[6], f[7] * r * gk[7]);
            *p = o;
        }
    }
    SEAM(2);

#pragma unroll 1
    for (int l = 0; l < DEPTH; ++l) {
        const int pb = PH_BASE + PH_PER_LAYER * l;
        if (IN(pb + 0) && PHON(3)) { PHL(); unsigned char* ws = WSP(); const float* xin = (l == 0) ? PTR(0) : (const float*)OUTP();
            norm_rows(xin, PTR(3) + (size_t)l * DM, (bf16*)(ws + WS_XN), gw_, NGW, lane_); }
        SEAM(pb + 0);
        if (IN(pb + 1) && PHON(4)) { PHL(); unsigned char* ws = WSP();
            pg8::Gemm g{(bf16*)(ws + WS_XN), (bf16*)(ws + WS_WIN) + (size_t)l * DIN * DM, T, DIN, DM}; pg8::StaticOrder S; S.init(T, DIN, G, bid);
            pg8::EpiQKV E{(bf16*)(ws + WS_QKV), PTR(5) + (size_t)l * 128, PTR(7) + (size_t)l * 128, PTR(9) + (size_t)l * 128, (const float*)(ws + WS_ROPE)};
            pg8::gemm_phase<pg8::EpiQKV, pg8::StaticOrder, true, true>(lds + RING_OFF, g, S, E, tid_);
        }
        SEAM(pb + 1);
        if (IN(pb + 2) && PHON(5)) { PHL(); unsigned char* ws = WSP();
            const float* sink = PTR(6) + (size_t)l * 12; const float* rpb = PTR(8) + (size_t)l * 8 * 15 * 31; const float* biasA = (const float*)(ws + WS_BIASA);
            const bf16* QKV = (const bf16*)(ws + WS_QKV); bf16* ATT = (bf16*)(ws + WS_ATT);
            for (int it = gw_; it < BATCH * 32 * 32; it += NGW) {
                const int slot = it >> 9, br = it & 511, b = br >> 5, grow = br & 31;
                if (slot < 12) naive_attn_item<0>(QKV, ATT, b, grow, slot, lane_, biasA, sink, rpb);
                else if (slot < 20) naive_attn_item<1>(QKV, ATT, b, grow, slot - 12, lane_, biasA, sink, rpb);
                else naive_attn_item<2>(QKV, ATT, b, grow, slot - 20, lane_, biasA, sink, rpb);
            }
        }
        SEAM(pb + 2);
        if (IN(pb + 3) && PHON(6)) { PHL(); unsigned char* ws = WSP(); mixnorm_rows((bf16*)(ws + WS_ATT), PTR(10) + (size_t)l * DM, gw_, NGW, lane_); }
        SEAM(pb + 3);
        if (IN(pb + 4) && PHON(7)) { PHL(); unsigned char* ws = WSP(); const float* xin = (l == 0) ? PTR(0) : (const float*)OUTP();
            pg8::Gemm g{(bf16*)(ws + WS_ATT), (bf16*)(ws + WS_WOUT) + (size_t)l * DM * DM, T, DM, DM}; pg8::StaticOrder S; S.init(T, DM, G, bid);
            pg8::EpiResid E{xin, OUTP(), DM};
            pg8::gemm_phase<pg8::EpiResid, pg8::StaticOrder, true, true>(lds + RING_OFF, g, S, E, tid_);
        }
        SEAM(pb + 4);
        if (IN(pb + 5) && PHON(8)) { PHL(); unsigned char* ws = WSP(); norm_rows(OUTP(), PTR(12) + (size_t)l * DM, (bf16*)(ws + WS_XN), gw_, NGW, lane_); }
        SEAM(pb + 5);
        if (IN(pb + 6) && PHON(9)) { PHL(); unsigned char* ws = WSP();
            pg8::Gemm g{(bf16*)(ws + WS_XN), (bf16*)(ws + WS_WMQ) + (size_t)l * MEMW * DM, T, MEMW, DM}; pg8::StaticOrder S; S.init(T, MEMW, G, bid);
            pg8::EpiBf16<0> E{(bf16*)(ws + WS_QM), MEMW, nullptr, 0, 0, 1.f};
            pg8::gemm_phase<pg8::EpiBf16<0>, pg8::StaticOrder, true, true>(lds + RING_OFF, g, S, E, tid_);
        }
        SEAM(pb + 6);
        if (IN(pb + 7) && PHON(10)) { PHL(); unsigned char* ws = WSP();
            const bf16* kvm = (const bf16*)(ws + WS_KVM) + (size_t)l * BATCH * NMEM * 1024; const float* gq = PTR(16) + (size_t)l * 256;
            for (int it = gw_; it < T * 4; it += NGW) { const int t = it >> 2, head = it & 3; naive_mem_item((const bf16*)(ws + WS_QM), kvm, (bf16*)(ws + WS_OM), gq, (size_t)t, t >> 11, head, lane_); }
        }
        SEAM(pb + 7);
        if (IN(pb + 8) && PHON(11)) { PHL(); unsigned char* ws = WSP();
            pg8::Gemm g{(bf16*)(ws + WS_OM), (bf16*)(ws + WS_WMO) + (size_t)l * DM * MEMW, T, DM, MEMW}; pg8::StaticOrder S; S.init(T, DM, G, bid);
            pg8::EpiResid E{OUTP(), OUTP(), DM};
            pg8::gemm_phase<pg8::EpiResid, pg8::StaticOrder, true, true>(lds + RING_OFF, g, S, E, tid_);
        }
        SEAM(pb + 8);
        if (IN(pb + 9) && PHON(12)) { PHL(); unsigned char* ws = WSP(); norm_rows(OUTP(), PTR(18) + (size_t)l * DM, (bf16*)(ws + WS_XN), gw_, NGW, lane_); }
        SEAM(pb + 9);
        if (IN(pb + 10) && PHON(13)) { PHL(); unsigned char* ws = WSP();
            pg8::Gemm g{(bf16*)(ws + WS_XN), (bf16*)(ws + WS_WPQ) + (size_t)l * DM * DM, T, DM, DM}; pg8::StaticOrder S; S.init(T, DM, G, bid);
            pg8::EpiBf16<0> E{(bf16*)(ws + WS_QP), DM, nullptr, 0, 0, 1.f};
            pg8::gemm_phase<pg8::EpiBf16<0>, pg8::StaticOrder, true, true>(lds + RING_OFF, g, S, E, tid_);
        }
        SEAM(pb + 10);
        if (IN(pb + 11) && PHON(14)) { PHL(); unsigned char* ws = WSP();
            const bf16* pk = (const bf16*)(ws + WS_PKEYS) + (size_t)l * 8 * 2 * 128 * 128;
            for (int u = bid; u < (T / 256) * PEER_H; u += G) peer_select_unit((const bf16*)(ws + WS_QP), pk, (int*)(ws + WS_PIDX), (float*)(ws + WS_PGATE), u >> 3, u & 7, wave_, lane_);
        }
        SEAM(pb + 11);
        if (IN(pb + 12) && PHON(15)) { PHL(); unsigned char* ws = WSP();
            peer_gather8((const bf16*)(ws + WS_XN), ws + WS_PU + (size_t)l * PEER_N * DM, ws + WS_PV + (size_t)l * PEER_N * DM, (const int*)(ws + WS_PIDX), (const float*)(ws + WS_PGATE), OUTP(), (LAS float*)(lds + RING_OFF + wave_ * 1024), gw_, NGW, lane_); }
        SEAM(pb + 12);
    }
#undef IN
#undef SEAM
}

#ifndef MK_MULTI_LAUNCH
#define MK_MULTI_LAUNCH 0
#endif
extern "C" void kernel_launch(void* const* d_in, const int* in_sizes, int n_in, void* d_out, int out_size, void* d_ws, size_t ws_size, hipStream_t stream) {
    static int grid = 0;
    if (grid == 0) {
        if (n_in != 23 || out_size != T * DM || ws_size < WS_END) { fprintf(stderr, "kernel_launch: unexpected shapes (n_in %d, out %d, ws %zu)\n", n_in, out_size, ws_size); grid = -1; return; }
        int dev = 0, cus = 0, per_cu = 0;
        if (hipGetDevice(&dev) != hipSuccess || hipDeviceGetAttribute(&cus, hipDeviceAttributeMultiprocessorCount, dev) != hipSuccess) { grid = -1; return; }
        if (hipFuncSetAttribute((const void*)mega, hipFuncAttributeMaxDynamicSharedMemorySize, LDS_BYTES) != hipSuccess) { fprintf(stderr, "kernel_launch: hipFuncSetAttribute failed\n"); grid = -1; return; }
        if (hipOccupancyMaxActiveBlocksPerMultiprocessor(&per_cu, (const void*)mega, NTHREADS, LDS_BYTES) != hipSuccess || per_cu < 1) { fprintf(stderr, "kernel_launch: occupancy query says %d\n", per_cu); }
        (void)hipGetLastError();
        grid = cus;
    }
    if (grid < 0) return;
    (void)hipMemsetAsync((char*)d_ws + WS_CTL, 0, CTL_ZERO_BYTES, stream);
    Args a{};
    for (int i = 0; i < 23; ++i) a.in[i] = (const float*)d_in[i];
    a.out = (float*)d_out; a.ws = (unsigned char*)d_ws;
#if MK_MULTI_LAUNCH
    for (int p = 0; p < N_PHASES; ++p) { a.ph_lo = p; a.ph_hi = p + 1; a.use_bar = 0; a.pad = 0; hipLaunchKernelGGL(mega, dim3(grid), dim3(NTHREADS), LDS_BYTES, stream, a); }
#else
    a.ph_lo = 0; a.ph_hi = N_PHASES; a.use_bar = 1; a.pad = 0;
    hipLaunchKernelGGL(mega, dim3(grid), dim3(NTHREADS), LDS_BYTES, stream, a);
#endif
    const hipError_t le = hipPeekAtLastError();
    if (le != hipSuccess) fprintf(stderr, "kernel_launch: launch failed: %s\n", hipGetErrorName(le));
}
```

```cpp
#include <hip/hip_runtime.h>
#include <cstdio>
#include <cstdint>
#include <cmath>
__device__ __forceinline__ float shx(float v, int k, int lane);
namespace pg8 {
#define PG8_LAS __attribute__((address_space(3)))
typedef unsigned short bf16_t;
typedef short bf16x8 __attribute__((ext_vector_type(8)));
typedef float f32x4 __attribute__((ext_vector_type(4)));
typedef unsigned u32x4 __attribute__((ext_vector_type(4)));
constexpr int BM = 256, BK = 64, HALF = 128, HTB = HALF * BK * 2  , STAGE_BYTES = 8 * HTB, NXCD = 8, WGM = 8;

__host__ __device__ __forceinline__ int lds_byte(int r, int c) { const int st = (r >> 4) * 2 + (c >> 5), rr = r & 15, cc = c & 31, ob = rr * 64 + cc * 2; return st * 1024 + (ob ^ (((ob >> 9) & 1) << 5)); }
__host__ __device__ __forceinline__ void stage_rc(int b, int& R, int& C) { const int st = b / 1024, sb = b % 1024, swz = sb ^ (((sb >> 9) & 1) << 5); R = (st >> 1) * 16 + swz / 64; C = (st & 1) * 32 + (swz % 64) / 2; }
__host__ __device__ __forceinline__ int perm32(int rho) { const int n = rho >> 4, i = rho & 15; return 8 * (i >> 2) + 4 * n + (i & 3); }

struct Unit { int pm, pn; };
struct Gemm { const bf16_t* A; const bf16_t* Bt; int M, N, K; };

struct StaticOrder {
    int nM, nN, nwg, G, c;
    __host__ __device__ void init(int M, int N, int G_, int c_) { nM = M / BM; nN = N / BM; nwg = nM * nN; G = G_; c = c_; }
    __host__ __device__ bool next(int i, Unit& u) const {
        const long L = (long)i * G + c; if (L >= nwg) return false;
        int wgid = (int)L; { const int q = nwg / NXCD, r = nwg % NXCD, xcd = wgid % NXCD, off = wgid / NXCD; wgid = (xcd < r ? xcd * (q + 1) : r * (q + 1) + (xcd - r) * q) + off; }
        const int nig = WGM * nN, gid = wgid / nig, fm = gid * WGM, gsz = (nM - fm) < WGM ? (nM - fm) : WGM;
        u.pm = fm + ((wgid % nig) % gsz); u.pn = (wgid % nig) / gsz; return true;
    }
    __device__ __forceinline__ void a_ready(const Unit&) const {}
    __device__ __forceinline__ void done(const Unit&) const {}
};

__device__ __forceinline__ unsigned cvt_pk_bf16(float lo, float hi) { unsigned r; asm volatile("v_cvt_pk_bf16_f32 %0, %1, %2" : "=v"(r) : "v"(lo), "v"(hi)); return r; }
typedef float f32x2 __attribute__((ext_vector_type(2)));
__device__ __forceinline__ f32x2 gelu_pk(f32x2 v) {
    const f32x2 av = __builtin_elementwise_abs(v), d = av * 0.2316418882f + 1.0f;
    f32x2 t; t.x = __builtin_amdgcn_rcpf(d.x); t.y = __builtin_amdgcn_rcpf(d.y);
    f32x2 q = t * 0.5307027145f + (-0.7265760135f); q = q * t + 0.7107068705f; q = q * t + (-0.142248368f); q = q * t + 0.127414796f; q = q * t;
    const f32x2 s = (v * v) * (-0.72134752044f);
    f32x2 e; e.x = __builtin_amdgcn_exp2f(s.x); e.y = __builtin_amdgcn_exp2f(s.y);
    const f32x2 m = v * (q * e), r = v - m;
    f32x2 o; o.x = v.x < 0.f ? m.x : r.x; o.y = v.y < 0.f ? m.y : r.y; return o;
}

template <int ACT  > struct EpiBf16 {
    static constexpr bool PERM = true, AFTER_DRAIN = false; static_assert(ACT == 0 || ACT == 1, "EpiBf16: ACT is 0 (none) or 1 (gelu_pk)");
    bf16_t* O; int ldc; const float* bias; int split_cols; size_t split_stride; float scale0;
    __device__ __forceinline__ void operator()(const f32x4 (&acc)[2][2][4][2], const Unit& u, int wr, int wc, int fr, int fq) const {
        const int row0 = u.pm * BM + wr * 64 + fr; int colt = u.pn * BM; bf16_t* base = O;
        float sc = 1.f; if (split_cols) { const int t = colt / split_cols; base += (size_t)t * split_stride; colt -= t * split_cols; if (t == 0) sc = scale0; }
        const int col0 = colt + wc * 32 + 8 * fq, bcol0 = u.pn * BM + wc * 32 + 8 * fq;
        f32x4 bv[2][2];
#pragma unroll
        for (int bj = 0; bj < 2; ++bj)
#pragma unroll
            for (int n = 0; n < 2; ++n) bv[bj][n] = bias ? *(const f32x4*)(bias + bcol0 + bj * HALF + 4 * n) : (f32x4){0.f, 0.f, 0.f, 0.f};
#pragma unroll
        for (int ai = 0; ai < 2; ++ai)
#pragma unroll
            for (int m = 0; m < 4; ++m) { bf16_t* rowp = base + (size_t)(row0 + ai * HALF + m * 16) * ldc + col0;
#pragma unroll
                for (int bj = 0; bj < 2; ++bj) { f32x4 v0 = acc[ai][bj][m][0] + bv[bj][0], v1 = acc[ai][bj][m][1] + bv[bj][1];
                    if (ACT == 1) { f32x2 a = gelu_pk((f32x2){v0[0], v0[1]}), b = gelu_pk((f32x2){v0[2], v0[3]}), c = gelu_pk((f32x2){v1[0], v1[1]}), d = gelu_pk((f32x2){v1[2], v1[3]});
                        v0 = (f32x4){a.x, a.y, b.x, b.y}; v1 = (f32x4){c.x, c.y, d.x, d.y}; }
                    v0 = v0 * sc; v1 = v1 * sc; u32x4 w; w.x = cvt_pk_bf16(v0[0], v0[1]); w.y = cvt_pk_bf16(v0[2], v0[3]); w.z = cvt_pk_bf16(v1[0], v1[1]); w.w = cvt_pk_bf16(v1[2], v1[3]);
                    *(u32x4*)(rowp + bj * HALF) = w; } }
    }
};

typedef unsigned u32x2 __attribute__((ext_vector_type(2)));
struct EpiResid {
    static constexpr bool PERM = false, AFTER_DRAIN = false;
    const float* base; float* out; int ldc;
    __device__ __forceinline__ void operator()(const f32x4 (&acc)[2][2][4][2], const Unit& u, int wr, int wc, int fr, int fq) const {
        const int col0 = u.pn * BM + wc * 32 + 4 * fq;
#pragma unroll
        for (int ai = 0; ai < 2; ++ai)
#pragma unroll
            for (int m = 0; m < 4; ++m) { const size_t off = (size_t)(u.pm * BM + ai * HALF + wr * 64 + m * 16 + fr) * ldc + col0;
#pragma unroll
                for (int bj = 0; bj < 2; ++bj)
#pragma unroll
                    for (int n = 0; n < 2; ++n) { const f32x4 bs = *(const f32x4*)(base + off + bj * HALF + n * 16); *(f32x4*)(out + off + bj * HALF + n * 16) = bs + acc[ai][bj][m][n]; } }
    }
};
struct EpiQKV {
    static constexpr bool PERM = false, AFTER_DRAIN = false;
    bf16_t* O; const float* ga; const float* gb; const float* gc; const float* rope;
    __device__ __forceinline__ void operator()(const f32x4 (&acc)[2][2][4][2], const Unit& u, int wr, int wc, int fr, int fq) const {
        const int hg = u.pn * 4 + wc;
        const float* g = nullptr; bool isq = false, dorope = false;
        if (hg < 12) { g = ga; isq = true; } else if (hg < 16) { g = ga + 64; } else if (hg < 20) { }
        else if (hg < 28) { g = gb; isq = true; } else if (hg < 36) { g = gb + 64; } else if (hg < 44) { }
        else if (hg < 56) { g = gc; isq = true; dorope = true; } else if (hg < 60) { g = gc + 64; dorope = true; }
        const float qs = isq ? 0.125f : 1.0f;
#pragma unroll
        for (int ai = 0; ai < 2; ++ai)
#pragma unroll
            for (int m = 0; m < 4; ++m) {
                const int row = u.pm * BM + ai * HALF + wr * 64 + m * 16 + fr;
                f32x4 v[2][2];
#pragma unroll
                for (int bj = 0; bj < 2; ++bj)
#pragma unroll
                    for (int n = 0; n < 2; ++n) v[bj][n] = acc[ai][bj][m][n];
                if (g) {
                    float ss = 0.f;
#pragma unroll
                    for (int bj = 0; bj < 2; ++bj)
#pragma unroll
                        for (int n = 0; n < 2; ++n) { const f32x4 x = v[bj][n]; ss += (x[0] * x[0] + x[1] * x[1]) + (x[2] * x[2] + x[3] * x[3]); }
                    ss += shx(ss, 16, fr + 16 * fq); ss += shx(ss, 32, fr + 16 * fq);
                    const float r = qs / sqrtf(ss * (1.0f / 64.0f) + 1e-6f);
#pragma unroll
                    for (int bj = 0; bj < 2; ++bj)
#pragma unroll
                        for (int n = 0; n < 2; ++n) v[bj][n] = v[bj][n] * *(const f32x4*)(g + 32 * bj + 16 * n + 4 * fq) * r;
                }
                if (dorope) {
                    const int t = row & 2047, pr = t >> 6, pc = t & 63;
#pragma unroll
                    for (int bj = 0; bj < 2; ++bj) {
                        const int pos = bj ? pc : pr;
                        const float* rp = rope + (size_t)(pos * 16 + 4 * fq) * 2;
                        const f32x4 c01 = *(const f32x4*)rp, c23 = *(const f32x4*)(rp + 4);
                        const f32x4 cs = (f32x4){c01[0], c01[2], c23[0], c23[2]}, sn = (f32x4){c01[1], c01[3], c23[1], c23[3]};
                        const f32x4 x1 = v[bj][0], x2 = v[bj][1];
                        v[bj][0] = x1 * cs - x2 * sn; v[bj][1] = x1 * sn + x2 * cs;
                    }
                }
                bf16_t* rowp = O + (size_t)row * 4096 + hg * 64 + 4 * fq;
#pragma unroll
                for (int bj = 0; bj < 2; ++bj)
#pragma unroll
                    for (int n = 0; n < 2; ++n) { u32x2 w; w.x = cvt_pk_bf16(v[bj][n][0], v[bj][n][1]); w.y = cvt_pk_bf16(v[bj][n][2], v[bj][n][3]); *(u32x2*)(rowp + 32 * bj + 16 * n) = w; }
                asm volatile("" ::: "memory");
            }
    }
};
template <class Epi, class Sched, bool ALIGN_EPI = false, bool SP2 = false>
__device__ __forceinline__ void gemm_phase(PG8_LAS unsigned char* lds, const Gemm g, const Sched& S, const Epi& E, const int tid) {
    const int wid = __builtin_amdgcn_readfirstlane(tid >> 6), lane = tid & 63, wr = wid >> 2, wc = wid & 3, fr = lane & 15, fq = lane >> 4;
    const int K = g.K, nt = K / BK;
    unsigned voffA[2], voffB[2];
#pragma unroll
    for (int i = 0; i < 2; ++i) { int R, C; stage_rc(tid * 16 + i * 8192, R, C); const int Rb = Epi::PERM ? ((R & ~31) + perm32(R & 31)) : R;
        voffA[i] = (unsigned)(R * K + C) * 2u; voffB[i] = (unsigned)(Rb * K + C) * 2u; }
    const size_t kstep = (size_t)(BK * 2);
    const size_t hstep = (size_t)HALF * K * 2;
    const size_t tstep = 2 * hstep;
    const unsigned ldsw = (unsigned)wid * 1024u;
    const int aoff = lds_byte(wr * 64 + fr, fq * 8), boff = lds_byte(wc * 32 + fr, fq * 8);
#define PG8_SA(b, h) (((b) * 2 + (h)) * HTB)
#define PG8_SB(b, h) ((4 + (b) * 2 + (h)) * HTB)
#define PG8_STAGE(bufoff, gbase, voff) do { _Pragma("unroll") for (int _i = 0; _i < 2; ++_i) \
        __builtin_amdgcn_global_load_lds((const unsigned*)((const char*)(gbase) + (voff)[_i]), (PG8_LAS unsigned*)(lds + (bufoff) + ldsw + _i * 8192), 16, 0, 0); } while (0)
#define PG8_LDA(dst, b, h) do { _Pragma("unroll") for (int m = 0; m < 4; ++m) _Pragma("unroll") for (int k = 0; k < 2; ++k) dst[m][k] = *(const PG8_LAS bf16x8*)(lds + PG8_SA(b, h) + aoff + m * 2048 + k * 1024); } while (0)
#define PG8_LDB(dst, b, h) do { _Pragma("unroll") for (int n = 0; n < 2; ++n) _Pragma("unroll") for (int k = 0; k < 2; ++k) dst[n][k] = *(const PG8_LAS bf16x8*)(lds + PG8_SB(b, h) + boff + n * 2048 + k * 1024); } while (0)
#define PG8_MMA(ai, bj, At, Bt) do { __builtin_amdgcn_s_setprio(1); _Pragma("unroll") for (int m = 0; m < 4; ++m) _Pragma("unroll") for (int n = 0; n < 2; ++n) _Pragma("unroll") for (int k = 0; k < 2; ++k) \
        acc[ai][bj][m][n] = __builtin_amdgcn_mfma_f32_16x16x32_bf16(Bt[n][k], At[m][k], acc[ai][bj][m][n], 0, 0, 0); __builtin_amdgcn_s_setprio(0); } while (0)
#define PG8_WAIT_V(n) asm volatile("s_waitcnt vmcnt(" #n ")" ::: "memory")
#define PG8_WAIT_L(n) asm volatile("s_waitcnt lgkmcnt(" #n ")" ::: "memory")
#define PG8_BAR __builtin_amdgcn_s_barrier()
#define PG8_SCHED __builtin_amdgcn_sched_barrier(0)
    Unit cur, nxt; int ui = 0;
    if (!S.next(0, cur)) return;
    f32x4 acc[2][2][4][2];
#pragma unroll
    for (int a = 0; a < 2; ++a)
#pragma unroll
        for (int b = 0; b < 2; ++b)
#pragma unroll
            for (int m = 0; m < 4; ++m)
#pragma unroll
                for (int n = 0; n < 2; ++n) acc[a][b][m][n] = (f32x4){0.f, 0.f, 0.f, 0.f};
    bf16x8 At[4][2], B0[2][2], B1[2][2];
    const char* cA = (const char*)g.A + (size_t)cur.pm * tstep; const char* cB = (const char*)g.Bt + (size_t)cur.pn * tstep;
    S.a_ready(cur);
    if constexpr (SP2) {
        PG8_STAGE(PG8_SB(0, 0), cB, voffB); PG8_STAGE(PG8_SB(0, 1), cB + hstep, voffB); PG8_STAGE(PG8_SA(0, 0), cA, voffA); PG8_STAGE(PG8_SA(0, 1), cA + hstep, voffA);
        if (wr == 1) PG8_BAR;
        PG8_WAIT_V(2); PG8_BAR;
        PG8_STAGE(PG8_SB(1, 0), cB + kstep, voffB); PG8_STAGE(PG8_SA(1, 0), cA + kstep, voffA); PG8_STAGE(PG8_SB(1, 1), cB + hstep + kstep, voffB);
        PG8_WAIT_V(6); PG8_BAR;
    } else {
        PG8_STAGE(PG8_SB(0, 0), cB, voffB); PG8_STAGE(PG8_SA(0, 0), cA, voffA); PG8_STAGE(PG8_SB(0, 1), cB + hstep, voffB); PG8_STAGE(PG8_SA(0, 1), cA + hstep, voffA);
        if (wr == 1) PG8_BAR;
        PG8_WAIT_V(4); PG8_BAR;
        PG8_STAGE(PG8_SB(1, 0), cB + kstep, voffB); PG8_STAGE(PG8_SA(1, 0), cA + kstep, voffA); PG8_STAGE(PG8_SB(1, 1), cB + hstep + kstep, voffB);
        PG8_WAIT_V(6); PG8_BAR;
    }
    for (;;) {
        const bool has_next = S.next(ui + 1, nxt);
        const char* nA = has_next ? (const char*)g.A + (size_t)nxt.pm * tstep : cA; const char* nB = has_next ? (const char*)g.Bt + (size_t)nxt.pn * tstep : cB;
        for (int t = 0; t < nt; t += 2) {
            const bool last = (t == nt - 2);
            const char* a1 = cA + (size_t)(t + 1) * kstep;
            const char* a2 = last ? nA : cA + (size_t)(t + 2) * kstep; const char* b2 = last ? nB : cB + (size_t)(t + 2) * kstep;
            const char* a3 = a2 + kstep; const char* b3 = b2 + kstep;
            if (last && has_next) S.a_ready(nxt);
            if constexpr (SP2) {
            PG8_LDB(B0, 0, 0); PG8_LDB(B1, 0, 1); PG8_SCHED; PG8_LDA(At, 0, 0); PG8_STAGE(PG8_SA(1, 1), a1 + hstep, voffA);
            PG8_WAIT_V(8); PG8_WAIT_L(0); PG8_BAR; PG8_MMA(0, 0, At, B0); PG8_MMA(0, 1, At, B1); PG8_BAR; PG8_SCHED;
            PG8_LDA(At, 0, 1); PG8_STAGE(PG8_SB(0, 0), b2, voffB); PG8_STAGE(PG8_SB(0, 1), b2 + hstep, voffB); PG8_STAGE(PG8_SA(0, 0), a2, voffA);
            PG8_WAIT_V(8); PG8_WAIT_L(0); PG8_BAR; PG8_MMA(1, 0, At, B0); PG8_MMA(1, 1, At, B1); PG8_BAR; PG8_SCHED;
            PG8_LDB(B0, 1, 0); PG8_LDB(B1, 1, 1); PG8_SCHED; PG8_LDA(At, 1, 0); PG8_STAGE(PG8_SA(0, 1), a2 + hstep, voffA);
            PG8_WAIT_V(8); PG8_WAIT_L(0); PG8_BAR; PG8_MMA(0, 0, At, B0); PG8_MMA(0, 1, At, B1); PG8_BAR; PG8_SCHED;
            PG8_LDA(At, 1, 1); PG8_STAGE(PG8_SB(1, 0), b3, voffB); PG8_STAGE(PG8_SB(1, 1), b3 + hstep, voffB); PG8_STAGE(PG8_SA(1, 0), a3, voffA);
            PG8_WAIT_V(8); PG8_WAIT_L(0); PG8_BAR; PG8_MMA(1, 0, At, B0); PG8_MMA(1, 1, At, B1); PG8_BAR; PG8_SCHED;
            } else {
            PG8_LDB(B0, 0, 0); PG8_SCHED; PG8_LDA(At, 0, 0); PG8_STAGE(PG8_SA(1, 1), a1 + hstep, voffA);
            PG8_WAIT_L(8); PG8_BAR; PG8_WAIT_L(0); PG8_MMA(0, 0, At, B0); PG8_BAR; PG8_SCHED;
            PG8_LDB(B1, 0, 1); PG8_STAGE(PG8_SB(0, 0), b2, voffB);
            PG8_BAR; PG8_WAIT_L(0); PG8_MMA(0, 1, At, B1); PG8_BAR;
            PG8_LDA(At, 0, 1); PG8_STAGE(PG8_SA(0, 0), a2, voffA);
            PG8_BAR; PG8_WAIT_L(0); PG8_MMA(1, 0, At, B0); PG8_BAR; PG8_SCHED;
            PG8_STAGE(PG8_SB(0, 1), b2 + hstep, voffB);
            PG8_WAIT_V(6); PG8_BAR; PG8_MMA(1, 1, At, B1); PG8_BAR;
            PG8_LDB(B0, 1, 0); PG8_SCHED; PG8_LDA(At, 1, 0); PG8_STAGE(PG8_SA(0, 1), a2 + hstep, voffA);
            PG8_WAIT_L(8); PG8_BAR; PG8_WAIT_L(0); PG8_MMA(0, 0, At, B0); PG8_BAR; PG8_SCHED;
            PG8_LDB(B1, 1, 1); PG8_STAGE(PG8_SB(1, 0), b3, voffB);
            PG8_BAR; PG8_WAIT_L(0); PG8_MMA(0, 1, At, B1); PG8_BAR;
            PG8_LDA(At, 1, 1); PG8_STAGE(PG8_SA(1, 0), a3, voffA);
            PG8_BAR; PG8_WAIT_L(0); PG8_MMA(1, 0, At, B0); PG8_BAR; PG8_SCHED;
            PG8_STAGE(PG8_SB(1, 1), b3 + hstep, voffB);
            PG8_WAIT_V(6); PG8_BAR; PG8_MMA(1, 1, At, B1); PG8_BAR;
            }
        }
        if constexpr (ALIGN_EPI) { if (wr == 0) PG8_BAR; }
        if constexpr (!Epi::AFTER_DRAIN) { E(acc, cur, wr, wc, fr, fq); S.done(cur); }
        if (!has_next) break;
#pragma unroll
        for (int a = 0; a < 2; ++a)
#pragma unroll
            for (int b = 0; b < 2; ++b)
#pragma unroll
                for (int m = 0; m < 4; ++m)
#pragma unroll
                    for (int n = 0; n < 2; ++n) acc[a][b][m][n] = (f32x4){0.f, 0.f, 0.f, 0.f};
        cur = nxt; cA = nA; cB = nB; ++ui;
        if constexpr (ALIGN_EPI) { if (wr == 1) PG8_BAR; }
    }
    PG8_WAIT_V(0);
    if constexpr (!ALIGN_EPI) { if (wr == 0) PG8_BAR; }
    PG8_BAR;
    if constexpr (Epi::AFTER_DRAIN) { E.fused(acc, cur, wr, wc, fr, fq, lds, wid, lane); S.done(cur); }
#undef PG8_SA
#undef PG8_SB
#undef PG8_STAGE
#undef PG8_LDA
#undef PG8_LDB
#undef PG8_MMA
#undef PG8_WAIT_V
#undef PG8_WAIT_L
#undef PG8_BAR
#undef PG8_SCHED
}
}

constexpr int BATCH = 16, SEQ = 2048, DM = 2048, T = BATCH * SEQ, DEPTH = 2;
constexpr int NMEM = 256, DIN = 4096, MEMW = 512;
constexpr int PEER_H = 8, PEER_N = 16384;
constexpr int NWAVES = 8, NTHREADS = NWAVES * 64;
constexpr float EPS = 1e-6f;
constexpr int QA = 0, KA = 768, VA = 1024, QB = 1280, KB = 1792, VB = 2304, QC = 2816, KC = 3584, VC = 3840;
constexpr int OA = 0, OB = 768, OC = 1280;

constexpr size_t MiB = 1u << 20;
constexpr size_t WS_CTL = 0, CTL_ZERO_BYTES = 1 * MiB;
constexpr size_t WS_ROPE = 1 * MiB, WS_BIASA = 1 * MiB + 16384;
constexpr size_t WS_WIN = 2 * MiB, WS_WOUT = 34 * MiB, WS_WMQ = 50 * MiB, WS_WMKV = 54 * MiB, WS_WMO = 62 * MiB, WS_WPQ = 66 * MiB, WS_PKEYS = 82 * MiB;
constexpr size_t WS_MEMN = 84 * MiB, WS_KVM = 116 * MiB, WS_PU = 132 * MiB, WS_PV = 260 * MiB, WS_XN = 388 * MiB, WS_QKV = 516 * MiB, WS_ATT = 772 * MiB;
constexpr size_t WS_QM = 900 * MiB, WS_OM = 932 * MiB, WS_END = 964 * MiB;
constexpr size_t WS_QP = WS_QKV, WS_PIDX = WS_QKV + 128 * MiB, WS_PGATE = WS_QKV + 144 * MiB;
constexpr int CW_BAR = 4096;

constexpr int RING_OFF = 0, RING_BYTES = 131072;
constexpr int LDSCTL_OFF = RING_BYTES, MISC_OFF = LDSCTL_OFF + 320;
constexpr int LDS_BYTES = 147456;

#define GAS __attribute__((address_space(1)))
#define LAS __attribute__((address_space(3)))
typedef unsigned short bf16;
typedef unsigned v4u __attribute__((ext_vector_type(4)));
typedef unsigned v2u __attribute__((ext_vector_type(2)));
typedef float f32x4 __attribute__((ext_vector_type(4)));
typedef float f32x16 __attribute__((ext_vector_type(16)));
typedef short bf16x8 __attribute__((ext_vector_type(8)));
typedef GAS unsigned gu32;
#define LDS_WAIT() asm volatile("s_waitcnt lgkmcnt(0)" ::: "memory")
#define VM_WAIT() asm volatile("s_waitcnt vmcnt(0)" ::: "memory")
__device__ __forceinline__ unsigned f2bf(float f) { unsigned u = __builtin_bit_cast(unsigned, f); return (u + 0x7fffu + ((u >> 16) & 1u)) >> 16; }
__device__ __forceinline__ unsigned pk2(float lo, float hi) { return f2bf(lo) | (f2bf(hi) << 16); }
__device__ __forceinline__ float bflo(unsigned w) { return __builtin_bit_cast(float, w << 16); }
__device__ __forceinline__ float bfhi(unsigned w) { return __builtin_bit_cast(float, w & 0xffff0000u); }

__device__ __forceinline__ float shx(float v, int k, int lane) { return __builtin_bit_cast(float, __builtin_amdgcn_ds_bpermute((lane ^ k) << 2, __builtin_bit_cast(int, v))); }
#define XB_TMO      128
#define XB_XCNT(j)  (256  + 64 * (j))
#define XB_XSUB(j)  (1280 + 64 * (j))
#define XB_XGEN(j)  (2304 + 64 * (j))
#define XB_TOP      3328
#define XB_TOPGEN   3392
#define XCD_BAR_WORDS 3456
#define XB_SPIN_CAP (1u << 18)

__device__ __forceinline__ unsigned xb_ld(unsigned* p)              { return __hip_atomic_load(p, __ATOMIC_RELAXED, __HIP_MEMORY_SCOPE_AGENT); }
__device__ __forceinline__ unsigned xb_add(unsigned* p, unsigned v) { return __hip_atomic_fetch_add(p, v, __ATOMIC_RELAXED, __HIP_MEMORY_SCOPE_AGENT); }
__device__ __forceinline__ unsigned xb_xcc_id() { return (unsigned)__builtin_amdgcn_s_getreg((3 << 11) | 20) & 0xFu; }
#define XB_SPIN(cond, bar) do { unsigned _sp = 0; while (cond) { __builtin_amdgcn_s_sleep(1); \
    if ((++_sp & 255u) == 0u) { if (xb_ld(&(bar)[XB_TMO])) break; if (_sp > XB_SPIN_CAP) { atomicAdd(&(bar)[XB_TMO], 1u); break; } } } } while (0)

struct XcdBarrier {
    unsigned* bar; unsigned x;
    volatile LAS unsigned* st;
};

__device__ __forceinline__ XcdBarrier xcd_barrier_post(unsigned* bar, volatile LAS unsigned* st) {
    XcdBarrier b; b.bar = bar; b.x = xb_xcc_id(); b.st = st;
    if (threadIdx.x == 0) (void)xb_add(&bar[XB_XCNT(b.x)], 1u);
    return b;
}
__device__ __forceinline__ void xcd_barrier_complete(unsigned* bar, unsigned x, unsigned& nloc, unsigned& nx) {
    const unsigned G = gridDim.x * gridDim.y * gridDim.z;
    unsigned sum, cnt, mine, sp = 0u;
    for (;;) {
        sum = 0u; cnt = 0u; mine = 0u;
#pragma unroll
        for (unsigned j = 0; j < 16; ++j) { const unsigned c = xb_ld(&bar[XB_XCNT(j)]); sum += c; cnt += (c > 0u) ? 1u : 0u; mine = (j == x) ? c : mine; }
        if (sum == G) break;
        __builtin_amdgcn_s_sleep(1);
        if ((++sp & 255u) == 0u) { if (xb_ld(&bar[XB_TMO])) break; if (sp > XB_SPIN_CAP) { atomicAdd(&bar[XB_TMO], 1u); break; } }
    }
    nloc = mine > 0u ? mine : 1u; nx = cnt > 0u ? cnt : 1u;
}

__device__ __forceinline__ void xcd_barrier(const XcdBarrier& b) {
    asm volatile("s_waitcnt vmcnt(0)" ::: "memory");
    __syncthreads();
    if (threadIdx.x == 0) {
        unsigned* bar = b.bar;
        __builtin_amdgcn_s_waitcnt(0);
        unsigned nloc = b.st[0], nx = b.st[1];
        if (nloc == 0u) { xcd_barrier_complete(bar, b.x, nloc, nx); b.st[0] = nloc; b.st[1] = nx; }
        const unsigned old = xb_add(&bar[XB_XSUB(b.x)], 1u);
        const unsigned gen = old / nloc;
        if (old + 1u == (gen + 1u) * nloc) {
            __builtin_amdgcn_fence(__ATOMIC_RELEASE, "agent");
            asm volatile("s_waitcnt vmcnt(0)" ::: "memory");
            const unsigned og = xb_add(&bar[XB_TOP], 1u);
            const unsigned tg = og / nx;
            if (og + 1u == (tg + 1u) * nx) xb_add(&bar[XB_TOPGEN], 1u);
            else XB_SPIN(xb_ld(&bar[XB_TOPGEN]) == tg, bar);
            __builtin_amdgcn_fence(__ATOMIC_ACQUIRE, "agent");
            xb_add(&bar[XB_XGEN(b.x)], 1u);
            asm volatile("s_waitcnt vmcnt(0)" ::: "memory");
        } else {
            XB_SPIN(xb_ld(&bar[XB_XGEN(b.x)]) == gen, bar);
            __builtin_amdgcn_fence(__ATOMIC_ACQUIRE, "agent");
            asm volatile("s_waitcnt vmcnt(0)" ::: "memory");
        }
    }
    __syncthreads();
}

__device__ __forceinline__ float wave_sum(float v, int lane) {
#pragma unroll
    for (int o = 1; o < 64; o <<= 1) v += shx(v, o, lane);
    return v;
}
__device__ __forceinline__ void* ldptr(LAS unsigned char* lds, int i) {
    const unsigned long long v = ((const LAS unsigned long long*)(lds + LDSCTL_OFF + 1024))[i];
    const unsigned lo = __builtin_amdgcn_readfirstlane((unsigned)v), hi = __builtin_amdgcn_readfirstlane((unsigned)(v >> 32));
    return (void*)(((unsigned long long)hi << 32) | lo);
}
struct OffsetOrder {
    pg8::StaticOrder S;
    __device__ void init(int M, int N, int G, int c, int off) { S.init(M, N, G, (c + G - off % G) % G); }
    __device__ bool next(int i, pg8::Unit& u) const { return S.next(i, u); }
    __device__ __forceinline__ void a_ready(const pg8::Unit&) const {}
    __device__ __forceinline__ void done(const pg8::Unit&) const {}
};

template <bool PERMQKV>
__device__ __forceinline__ void transpose_item(const float* W, int K, int N, bf16* WT, LAS float* scr, int item, int lane) {
    const int nblk = N / 32, kb = item / nblk, nb = item % nblk, k0 = 64 * kb, n0 = 32 * nb;
    int d0 = n0;
    if (PERMQKV) { const int within = n0 & 255; d0 = (n0 & ~255) + 128 * ((within >> 5) & 1) + 32 * (within >> 6); }
#pragma unroll 8
    for (int i = 0; i < 32; ++i) { const int kk = 2 * i + (lane >> 5); scr[kk * 33 + (lane & 31)] = W[(size_t)(k0 + kk) * N + n0 + (lane & 31)]; }
    LDS_WAIT(); asm volatile("" ::: "memory");
    const int c = lane & 7;
#pragma unroll
    for (int j = 0; j < 4; ++j) { const int n = (lane >> 3) + 8 * j; const LAS float* s = scr + (8 * c) * 33 + n;
        v4u o; o.x = pk2(s[0 * 33], s[1 * 33]); o.y = pk2(s[2 * 33], s[3 * 33]); o.z = pk2(s[4 * 33], s[5 * 33]); o.w = pk2(s[6 * 33], s[7 * 33]);
        *(GAS v4u*)(WT + (size_t)(d0 + n) * K + k0 + 8 * c) = o; }
    LDS_WAIT(); asm volatile("" ::: "memory");
}
__device__ __forceinline__ void convert_bf16(const float* src, bf16* dst, size_t n, size_t gtid, size_t nthreads) {
    for (size_t i = gtid * 8; i < n; i += nthreads * 8) {
        const f32x4 a = *(const GAS f32x4*)(src + i), b = *(const GAS f32x4*)(src + i + 4);
        v4u o; o.x = pk2(a[0], a[1]); o.y = pk2(a[2], a[3]); o.z = pk2(b[0], b[1]); o.w = pk2(b[2], b[3]);
        *(GAS v4u*)(dst + i) = o;
    }
}
__device__ __forceinline__ int t5_bucket(int rel) {
    const int n = rel < 0 ? -rel : rel;
    const int b = n < 8 ? n : n < 12 ? 8 : n < 16 ? 9 : n < 23 ? 10 : n < 32 ? 11 : n < 46 ? 12 : n < 64 ? 13 : n < 91 ? 14 : 15;
    return b + (rel > 0 ? 16 : 0);
}
__constant__ float ROPE_INV[16] = {1.000000000e+00f, 5.623413324e-01f, 3.162277639e-01f, 1.778279394e-01f, 1.000000015e-01f, 5.623413250e-02f, 3.162277490e-02f, 1.778279431e-02f,
                                   9.999999776e-03f, 5.623413250e-03f, 3.162277630e-03f, 1.778279431e-03f, 1.000000047e-03f, 5.623413017e-04f, 3.162277571e-04f, 1.778279402e-04f};

__device__ __forceinline__ void rms_row_to_bf16(const float* xrow, const float* g0, bf16* o0, const float* g1, bf16* o1, int lane) {
    const GAS f32x4* xr = (const GAS f32x4*)xrow + lane;
    f32x4 v[8]; float s = 0.f;
#pragma unroll
    for (int j = 0; j < 8; ++j) { v[j] = xr[64 * j]; s += (v[j].x * v[j].x + v[j].y * v[j].y) + (v[j].z * v[j].z + v[j].w * v[j].w); }
    const float rstd = 1.f / sqrtf(wave_sum(s, lane) * (1.f / DM) + EPS);
    {   const GAS f32x4* gr = (const GAS f32x4*)g0 + lane; GAS v2u* o8 = (GAS v2u*)o0 + lane;
#pragma unroll
        for (int j = 0; j < 8; ++j) { const f32x4 gg = gr[64 * j]; v2u w; w.x = pk2(v[j].x * rstd * gg.x, v[j].y * rstd * gg.y); w.y = pk2(v[j].z * rstd * gg.z, v[j].w * rstd * gg.w); o8[64 * j] = w; } }
    if (g1) { const GAS f32x4* gr = (const GAS f32x4*)g1 + lane; GAS v2u* o8 = (GAS v2u*)o1 + lane;
#pragma unroll
        for (int j = 0; j < 8; ++j) { const f32x4 gg = gr[64 * j]; v2u w; w.x = pk2(v[j].x * rstd * gg.x, v[j].y * rstd * gg.y); w.y = pk2(v[j].z * rstd * gg.z, v[j].w * rstd * gg.w); o8[64 * j] = w; } }
}
__device__ __forceinline__ void norm_rows(const float* X, const float* g, bf16* XN, int gw, int NGW, int lane) {
    for (int m = gw; m < T; m += NGW) rms_row_to_bf16(X + (size_t)m * DM, g, XN + (size_t)m * DM, nullptr, nullptr, lane);
}

template <int TYPE>
__device__ __forceinline__ void naive_attn_item(const bf16* QKV, bf16* ATT, int b, int grow, int head, int lane, const float* biasA, const float* sink, const float* rpb) {
    const int tpos = grow * 64 + lane; const size_t trow = (size_t)b * SEQ + tpos;
    int qcol, kcol, vcol, ocol;
    if (TYPE == 0) { qcol = QA + head * 64; kcol = KA + (head / 3) * 64; vcol = VA + (head / 3) * 64; ocol = OA + head * 64; }
    else if (TYPE == 1) { qcol = QB + head * 64; kcol = KB + head * 64; vcol = VB + head * 64; ocol = OB + head * 64; }
    else { qcol = QC + head * 64; kcol = KC + (head / 3) * 64; vcol = VC + (head / 3) * 64; ocol = OC + head * 64; }
    float q[64], o[64];
#pragma unroll
    for (int c = 0; c < 8; ++c) { const v4u w = *(const GAS v4u*)(QKV + trow * DIN + qcol + 8 * c);
        q[8 * c + 0] = bflo(w.x); q[8 * c + 1] = bfhi(w.x); q[8 * c + 2] = bflo(w.y); q[8 * c + 3] = bfhi(w.y); q[8 * c + 4] = bflo(w.z); q[8 * c + 5] = bfhi(w.z); q[8 * c + 6] = bflo(w.w); q[8 * c + 7] = bfhi(w.w); }
#pragma unroll
    for (int d = 0; d < 64; ++d) o[d] = 0.f;
    float m = -1e30f, l = 0.f;
    int j0, j1;
    if (TYPE == 0) { j0 = grow * 64 - 128; if (j0 < 0) j0 = 0; j1 = grow * 64 + 63 + 128; if (j1 > SEQ - 1) j1 = SEQ - 1; }
    else if (TYPE == 1) { int r0 = grow - 4; r0 = r0 < 0 ? 0 : (r0 > 24 ? 24 : r0); j0 = r0 * 64; j1 = j0 + 511; }
    else { j0 = 0; j1 = SEQ - 1; }
    int c0 = lane - 8; c0 = c0 < 0 ? 0 : (c0 > 48 ? 48 : c0);
#pragma unroll 1
    for (int j = j0; j <= j1; ++j) {
        const bf16* krow = QKV + ((size_t)b * SEQ + j) * DIN;
        float s = 0.f;
#pragma unroll
        for (int c = 0; c < 8; ++c) { const v4u w = *(const GAS v4u*)(krow + kcol + 8 * c);
            s += q[8 * c + 0] * bflo(w.x) + q[8 * c + 1] * bfhi(w.x) + q[8 * c + 2] * bflo(w.y) + q[8 * c + 3] * bfhi(w.y) + q[8 * c + 4] * bflo(w.z) + q[8 * c + 5] * bfhi(w.z) + q[8 * c + 6] * bflo(w.w) + q[8 * c + 7] * bfhi(w.w); }
        bool valid = true;
        if (TYPE == 0) { const int rel = j - tpos; valid = (rel >= -128 && rel <= 128); if (valid) s += biasA[head * 257 + rel + 128]; }
        if (TYPE == 1) { const int kr = j >> 6, kc = j & 63; valid = (kc >= c0 && kc < c0 + 16); if (valid) s += rpb[(head * 15 + (kr - grow + 7)) * 31 + (kc - lane + 15)]; }
        const float mn = valid ? fmaxf(m, s) : m;
        const float a = __expf(m - mn);
        const float p = valid ? __expf(s - mn) : 0.f;
        l = l * a + p; m = mn;
#pragma unroll
        for (int c = 0; c < 8; ++c) { const v4u w = *(const GAS v4u*)(krow + vcol + 8 * c);
            o[8 * c + 0] = o[8 * c + 0] * a + p * bflo(w.x); o[8 * c + 1] = o[8 * c + 1] * a + p * bfhi(w.x); o[8 * c + 2] = o[8 * c + 2] * a + p * bflo(w.y); o[8 * c + 3] = o[8 * c + 3] * a + p * bfhi(w.y);
            o[8 * c + 4] = o[8 * c + 4] * a + p * bflo(w.z); o[8 * c + 5] = o[8 * c + 5] * a + p * bfhi(w.z); o[8 * c + 6] = o[8 * c + 6] * a + p * bflo(w.w); o[8 * c + 7] = o[8 * c + 7] * a + p * bfhi(w.w); }
    }
    if (TYPE == 0) l += __expf(sink[head] - m);
    const float inv = 1.f / l;
#pragma unroll
    for (int c = 0; c < 8; ++c) { v4u w; w.x = pk2(o[8 * c + 0] * inv, o[8 * c + 1] * inv); w.y = pk2(o[8 * c + 2] * inv, o[8 * c + 3] * inv); w.z = pk2(o[8 * c + 4] * inv, o[8 * c + 5] * inv); w.w = pk2(o[8 * c + 6] * inv, o[8 * c + 7] * inv);
        *(GAS v4u*)(ATT + trow * DM + ocol + 8 * c) = w; }
}
__device__ __forceinline__ float rdl(float v, int l) { return __builtin_bit_cast(float, __builtin_amdgcn_readlane(__builtin_bit_cast(int, v), l)); }
__device__ __forceinline__ void naive_mem_item(const bf16* QM, const bf16* KVM, bf16* OM, const float* gq, size_t trow, int b, int head, int lane) {
    const unsigned qw = *(const GAS unsigned*)(QM + trow * MEMW + head * 128 + 2 * lane);
    float q0 = bflo(qw), q1 = bfhi(qw);
    const float ss = wave_sum(q0 * q0 + q1 * q1, lane);
    const float r = 0.08838834764831845f / sqrtf(ss * (1.f / 128.f) + EPS);
    q0 *= r * gq[2 * lane]; q1 *= r * gq[2 * lane + 1];
    const bf16* kbase = KVM + ((size_t)b * NMEM + lane) * 1024 + head * 128;
    float s[4] = {0.f, 0.f, 0.f, 0.f};
#pragma unroll 1
    for (int c = 0; c < 16; ++c) {
        float qa[8];
#pragma unroll
        for (int e = 0; e < 4; ++e) { qa[2 * e] = rdl(q0, 4 * c + e); qa[2 * e + 1] = rdl(q1, 4 * c + e); }
#pragma unroll
        for (int i = 0; i < 4; ++i) { const v4u w = *(const GAS v4u*)(kbase + (size_t)i * 64 * 1024 + 8 * c);
            s[i] += qa[0] * bflo(w.x) + qa[1] * bfhi(w.x) + qa[2] * bflo(w.y) + qa[3] * bfhi(w.y) + qa[4] * bflo(w.z) + qa[5] * bfhi(w.z) + qa[6] * bflo(w.w) + qa[7] * bfhi(w.w); }
    }
    float m = fmaxf(fmaxf(s[0], s[1]), fmaxf(s[2], s[3]));
#pragma unroll
    for (int o = 1; o < 64; o <<= 1) m = fmaxf(m, shx(m, o, lane));
    float p[4]; float l = 0.f;
#pragma unroll
    for (int i = 0; i < 4; ++i) { p[i] = __expf(s[i] - m); l += p[i]; }
    l = wave_sum(l, lane);
    const bf16* vbase = KVM + ((size_t)b * NMEM) * 1024 + 512 + head * 128 + 2 * lane;
    float o0 = 0.f, o1 = 0.f;
#pragma unroll
    for (int i = 0; i < 4; ++i) {
#pragma unroll 4
        for (int jj = 0; jj < 64; ++jj) { const float pj = rdl(p[i], jj); const unsigned w = *(const GAS unsigned*)(vbase + (size_t)(64 * i + jj) * 1024); o0 += pj * bflo(w); o1 += pj * bfhi(w); }
    }
    const float inv = 1.f / l;
    *(GAS unsigned*)(OM + trow * MEMW + head * 128 + 2 * lane) = pk2(o0 * inv, o1 * inv);
}
__device__ __forceinline__ void mixnorm_rows(bf16* ATT, const float* g, int gw, int NGW, int lane) {
    for (int m = gw; m < T; m += NGW) {
        GAS v4u* p = (GAS v4u*)(ATT + (size_t)m * DM + 32 * lane);
        v4u w[4]; float f[32]; float ss = 0.f;
#pragma unroll
        for (int c = 0; c < 4; ++c) { w[c] = p[c];
            f[8 * c + 0] = bflo(w[c].x); f[8 * c + 1] = bfhi(w[c].x); f[8 * c + 2] = bflo(w[c].y); f[8 * c + 3] = bfhi(w[c].y); f[8 * c + 4] = bflo(w[c].z); f[8 * c + 5] = bfhi(w[c].z); f[8 * c + 6] = bflo(w[c].w); f[8 * c + 7] = bfhi(w[c].w); }
#pragma unroll
        for (int i = 0; i < 32; ++i) ss += f[i] * f[i];
        const int grp = lane < 24 ? 0 : (lane < 40 ? 1 : 2);
        const float sa = wave_sum(grp == 0 ? ss : 0.f, lane), sb = wave_sum(grp == 1 ? ss : 0.f, lane), sc = wave_sum(grp == 2 ? ss : 0.f, lane);
        const float r = grp == 0 ? 1.f / sqrtf(sa * (1.f / 768.f) + EPS) : (grp == 1 ? 1.f / sqrtf(sb * (1.f / 512.f) + EPS) : 1.f / sqrtf(sc * (1.f / 768.f) + EPS));
        const float* gg = g + 32 * lane;
#pragma unroll
        for (int c = 0; c < 4; ++c) { const f32x4 g0 = *(const GAS f32x4*)(gg + 8 * c), g1 = *(const GAS f32x4*)(gg + 8 * c + 4);
            v4u o; o.x = pk2(f[8 * c + 0] * r * g0[0], f[8 * c + 1] * r * g0[1]); o.y = pk2(f[8 * c + 2] * r * g0[2], f[8 * c + 3] * r * g0[3]);
            o.z = pk2(f[8 * c + 4] * r * g1[0], f[8 * c + 5] * r * g1[1]); o.w = pk2(f[8 * c + 6] * r * g1[2], f[8 * c + 7] * r * g1[3]); p[c] = o; }
    }
}

#ifndef PEER_HD
#define PEER_HD __device__ __forceinline__
#define PEER_EXP(x) __expf(x)
#endif
template <int N> PEER_HD void bitonic_sort_desc(float* v) {
#pragma unroll
    for (int k = 2; k <= N; k <<= 1)
#pragma unroll
        for (int j = k >> 1; j > 0; j >>= 1)
#pragma unroll
            for (int i = 0; i < N; ++i) { const int l = i ^ j; if (l > i) { const bool desc = ((i & k) == 0); const float a = v[i], b = v[l]; const float hi = fmaxf(a, b), lo = fminf(a, b);
                v[i] = desc ? hi : lo; v[l] = desc ? lo : hi; } }
}
PEER_HD void merge_top16(float* a, const float* b) {
    float c[16];
#pragma unroll
    for (int i = 0; i < 16; ++i) c[i] = fmaxf(a[i], b[15 - i]);
#pragma unroll
    for (int j = 8; j > 0; j >>= 1)
#pragma unroll
        for (int i = 0; i < 16; ++i) { const int l = i ^ j; if (l > i) { const float x = c[i], y = c[l]; c[i] = fmaxf(x, y); c[l] = fminf(x, y); } }
#pragma unroll
    for (int i = 0; i < 16; ++i) a[i] = c[i];
}
PEER_HD void top16_of_64(float (&v)[64]) {
    bitonic_sort_desc<16>(&v[0]); bitonic_sort_desc<16>(&v[16]); bitonic_sort_desc<16>(&v[32]); bitonic_sort_desc<16>(&v[48]);
    merge_top16(&v[0], &v[16]); merge_top16(&v[32], &v[48]); merge_top16(&v[0], &v[32]);
}
PEER_HD float pack_idx(float s, unsigned idx, unsigned mask) { return __builtin_bit_cast(float, (__builtin_bit_cast(unsigned, s) & ~mask) | idx); }
PEER_HD unsigned low_bits(float s, unsigned mask) { return __builtin_bit_cast(unsigned, s) & mask; }
PEER_HD unsigned pick16(const float* a, unsigned i, unsigned mask) {
    unsigned r = 0;
#pragma unroll
    for (unsigned k = 0; k < 16; ++k) r = (i == k) ? low_bits(a[k], mask) : r;
    return r;
}
PEER_HD void peer_candidates(const float* a, const float* b, int* e, float* gate) {
    float c[64]; int n = 0;
#pragma unroll
    for (int i = 0; i < 16; ++i)
#pragma unroll
        for (int j = 0; j < 16; ++j) if ((i + 1) * (j + 1) <= 16) { c[n] = pack_idx(a[i] + b[j], (unsigned)(i * 16 + j), 0xffu); ++n; }
#pragma unroll
    for (int k = 50; k < 64; ++k) c[k] = -3.0e38f;
    top16_of_64(c);
    float mx = c[0], den = 0.f;
#pragma unroll
    for (int k = 0; k < 16; ++k) { const unsigned id = low_bits(c[k], 0xffu); const unsigned n0 = pick16(a, id >> 4, 0x7fu), n1 = pick16(b, id & 15u, 0x7fu);
        e[k] = (int)(n0 * 128u + n1); gate[k] = PEER_EXP(c[k] - mx); den += gate[k]; }
    const float inv = 1.f / den;
#pragma unroll
    for (int k = 0; k < 16; ++k) gate[k] *= inv;
}

__device__ __forceinline__ void peer_select_unit(const bf16* QP, const bf16* PK, int* PIDX, float* PGATE, int tb, int h, int wave, int lane) {
    const int hh = lane >> 5, tl = lane & 31; const size_t t = (size_t)tb * 256 + wave * 32 + tl;
    float ab[2][16];
#pragma unroll
    for (int p = 0; p < 2; ++p) {
        bf16x8 bq[8];
#pragma unroll
        for (int s = 0; s < 8; ++s) bq[s] = *(const GAS bf16x8*)(QP + t * DM + 256 * h + 128 * p + 16 * s + 8 * hh);
        float v[64];
#pragma unroll
        for (int nb = 0; nb < 4; ++nb) {
            f32x16 acc;
#pragma unroll
            for (int r = 0; r < 16; ++r) acc[r] = 0.f;
            const bf16* kp = PK + ((size_t)((h * 2 + p) * 128 + 32 * nb + tl)) * 128 + 8 * hh;
#pragma unroll
            for (int s = 0; s < 8; ++s) { const bf16x8 ak = *(const GAS bf16x8*)(kp + 16 * s); acc = __builtin_amdgcn_mfma_f32_32x32x16_bf16(ak, bq[s], acc, 0, 0, 0); }
#pragma unroll
            for (int r = 0; r < 16; ++r) v[16 * nb + r] = pack_idx(acc[r], (unsigned)(32 * nb + 8 * (r >> 2) + 4 * hh + (r & 3)), 0x7fu);
        }
        top16_of_64(v);
        float pv[16];
#pragma unroll
        for (int i = 0; i < 16; ++i) pv[i] = shx(v[i], 32, lane);
        merge_top16(&v[0], pv);
#pragma unroll
        for (int i = 0; i < 16; ++i) ab[p][i] = v[i];
    }
    int e[16]; float gate[16];
    peer_candidates(ab[0], ab[1], e, gate);
    if (hh == 0) { GAS v4u* o = (GAS v4u*)(PIDX + t * 128 + h * 16);
#pragma unroll
        for (int c = 0; c < 4; ++c) o[c] = (v4u){(unsigned)e[4 * c], (unsigned)e[4 * c + 1], (unsigned)e[4 * c + 2], (unsigned)e[4 * c + 3]}; }
    else { GAS f32x4* o = (GAS f32x4*)(PGATE + t * 128 + h * 16);
#pragma unroll
        for (int c = 0; c < 4; ++c) o[c] = (f32x4){gate[4 * c], gate[4 * c + 1], gate[4 * c + 2], gate[4 * c + 3]}; }
}

__device__ __forceinline__ float dot8(const v4u& x, const v4u& u) {
    return bflo(x.x) * bflo(u.x) + bfhi(x.x) * bfhi(u.x) + bflo(x.y) * bflo(u.y) + bfhi(x.y) * bfhi(u.y) + bflo(x.z) * bflo(u.z) + bfhi(x.z) * bfhi(u.z) + bflo(x.w) * bflo(u.w) + bfhi(x.w) * bfhi(u.w);
}
__device__ __forceinline__ void axpy8(float* y, float w, const v4u& v) {
    y[0] += w * bflo(v.x); y[1] += w * bfhi(v.x); y[2] += w * bflo(v.y); y[3] += w * bfhi(v.y); y[4] += w * bflo(v.z); y[5] += w * bfhi(v.z); y[6] += w * bflo(v.w); y[7] += w * bfhi(v.w);
}
__device__ __forceinline__ void peer_gather(const bf16* XN, const bf16* PU, const bf16* PV, const int* PIDX, const float* PGATE, float* X, int gw, int NGW, int lane) {
    for (int t = gw; t < T; t += NGW) {
        v4u xv[4];
#pragma unroll
        for (int j = 0; j < 4; ++j) xv[j] = *(const GAS v4u*)(XN + (size_t)t * DM + 8 * lane + 512 * j);
        float y[32];
#pragma unroll
        for (int i = 0; i < 32; ++i) y[i] = 0.f;
        for (int k = 0; k < 128; k += 2) {
            const int e0 = __builtin_amdgcn_readfirstlane(PIDX[(size_t)t * 128 + k]), e1 = __builtin_amdgcn_readfirstlane(PIDX[(size_t)t * 128 + k + 1]);
            const float g0 = PGATE[(size_t)t * 128 + k], g1 = PGATE[(size_t)t * 128 + k + 1];
            v4u u0[4], u1[4], v0[4], v1[4];
#pragma unroll
            for (int j = 0; j < 4; ++j) { u0[j] = *(const GAS v4u*)(PU + (size_t)e0 * DM + 8 * lane + 512 * j); u1[j] = *(const GAS v4u*)(PU + (size_t)e1 * DM + 8 * lane + 512 * j); }
#pragma unroll
            for (int j = 0; j < 4; ++j) { v0[j] = *(const GAS v4u*)(PV + (size_t)e0 * DM + 8 * lane + 512 * j); v1[j] = *(const GAS v4u*)(PV + (size_t)e1 * DM + 8 * lane + 512 * j); }
            float d0 = 0.f, d1 = 0.f;
#pragma unroll
            for (int j = 0; j < 4; ++j) { d0 += dot8(xv[j], u0[j]); d1 += dot8(xv[j], u1[j]); }
            d0 = wave_sum(d0, lane); d1 = wave_sum(d1, lane);
            const float w0 = g0 * 0.5f * d0 * (1.f + erff(d0 * 0.70710678118654752f)), w1 = g1 * 0.5f * d1 * (1.f + erff(d1 * 0.70710678118654752f));
#pragma unroll
            for (int j = 0; j < 4; ++j) { axpy8(&y[8 * j], w0, v0[j]); axpy8(&y[8 * j], w1, v1[j]); }
        }
#pragma unroll
        for (int j = 0; j < 4; ++j) { GAS f32x4* xp = (GAS f32x4*)(X + (size_t)t * DM + 8 * lane + 512 * j);
            f32x4 a = xp[0], b = xp[1]; a += (f32x4){y[8 * j], y[8 * j + 1], y[8 * j + 2], y[8 * j + 3]}; b += (f32x4){y[8 * j + 4], y[8 * j + 5], y[8 * j + 6], y[8 * j + 7]}; xp[0] = a; xp[1] = b; }
    }
}


typedef float f32x2 __attribute__((ext_vector_type(2)));
constexpr float PU_SCALE = 256.f, PV_SCALE = 16.f;
__device__ __forceinline__ void convert_fp8(const float* src, unsigned char* dst, size_t n, float scale, size_t gtid, size_t nthreads) {
    for (size_t i = gtid * 16; i < n; i += nthreads * 16) {
        v4u o;
#pragma unroll
        for (int c = 0; c < 4; ++c) { f32x4 a = *(const GAS f32x4*)(src + i + 4 * c) * scale;
#pragma unroll
            for (int e = 0; e < 4; ++e) a[e] = fminf(fmaxf(a[e], -448.f), 448.f);
            int p = 0; p = __builtin_amdgcn_cvt_pk_fp8_f32(a[0], a[1], p, false); p = __builtin_amdgcn_cvt_pk_fp8_f32(a[2], a[3], p, true); o[c] = (unsigned)p; }
        *(GAS v4u*)(dst + i) = o;
    }
}
__device__ __forceinline__ void dot16_fp8(f32x2& acc, const v4u& w, const f32x2* x) {
#pragma unroll
    for (int c = 0; c < 4; ++c) { acc += __builtin_amdgcn_cvt_pk_f32_fp8((int)w[c], false) * x[2 * c]; acc += __builtin_amdgcn_cvt_pk_f32_fp8((int)w[c], true) * x[2 * c + 1]; }
}
__device__ __forceinline__ void axpy16_fp8(f32x2* y, const f32x2 wv, const v4u& w) {
#pragma unroll
    for (int c = 0; c < 4; ++c) { y[2 * c] += __builtin_amdgcn_cvt_pk_f32_fp8((int)w[c], false) * wv; y[2 * c + 1] += __builtin_amdgcn_cvt_pk_f32_fp8((int)w[c], true) * wv; }
}
#define PG_R 4
#define PG_LOAD(buf, tab, idlo, idhi, g) do { _Pragma("unroll") for (int i_ = 0; i_ < PG_R; ++i_) { const int k_ = (g) * PG_R + i_; \
        const int e_ = __builtin_amdgcn_readlane(k_ < 64 ? idlo : idhi, k_ & 63); const unsigned char* rp_ = (tab) + (size_t)(unsigned)e_ * 2048u; \
        buf[i_][0] = *(const GAS v4u*)(rp_ + voff); buf[i_][1] = *(const GAS v4u*)(rp_ + voff + 1024); } } while (0)
#define PG_DOT(buf, g) do { float p_[4]; _Pragma("unroll") for (int i_ = 0; i_ < 4; ++i_) { f32x2 a_ = {0.f, 0.f}; dot16_fp8(a_, buf[i_][0], &x[0]); dot16_fp8(a_, buf[i_][1], &x[8]); p_[i_] = a_.x + a_.y; __builtin_amdgcn_sched_barrier(0); } \
        float r_[2]; _Pragma("unroll") for (int i_ = 0; i_ < 2; ++i_) { const float keep_ = b5 ? p_[i_ + 2] : p_[i_], send_ = b5 ? p_[i_] : p_[i_ + 2]; r_[i_] = keep_ + shx(send_, 32, lane); } \
        float s_; { const float keep_ = b4 ? r_[1] : r_[0], send_ = b4 ? r_[0] : r_[1]; s_ = keep_ + shx(send_, 16, lane); } \
        s_ += shx(s_, 8, lane); s_ += shx(s_, 4, lane); s_ += shx(s_, 2, lane); s_ += shx(s_, 1, lane); \
        if ((lane & 15) == 0) wl[(g) * 4 + (lane >> 4)] = s_; } while (0)
#define PG_AXPY(buf, g) do { _Pragma("unroll") for (int i_ = 0; i_ < PG_R; ++i_) { const float w_ = wl[(g) * PG_R + i_]; const f32x2 wv_ = {w_, w_}; axpy16_fp8(&y[0], wv_, buf[i_][0]); axpy16_fp8(&y[8], wv_, buf[i_][1]); __builtin_amdgcn_sched_barrier(0); } } while (0)
__device__ __forceinline__ void peer_gather8(const bf16* XN, const unsigned char* PU8, const unsigned char* PV8, const int* PIDX, const float* PGATE, float* X, LAS float* wl, int gw, int NGW, int lane) {
    const bool b5 = (lane >> 5) & 1, b4 = (lane >> 4) & 1; const unsigned voff = 16u * (unsigned)lane;
    for (int t = gw; t < T; t += NGW) {
        const unsigned l4 = 4u * (unsigned)lane; const char* pidx_t = (const char*)(PIDX + (size_t)t * 128); const char* pgate_t = (const char*)(PGATE + (size_t)t * 128);
        const int idlo = *(const GAS int*)(pidx_t + l4), idhi = *(const GAS int*)(pidx_t + l4 + 256);
        v4u A[PG_R][2], B[PG_R][2];
        PG_LOAD(A, PU8, idlo, idhi, 0);
        f32x2 x[16];
        {   const char* xr = (const char*)(XN + (size_t)t * DM); const unsigned l32 = 32u * (unsigned)lane;
            const v4u a0 = *(const GAS v4u*)(xr + l32), a1 = *(const GAS v4u*)(xr + l32 + 16), c0 = *(const GAS v4u*)(xr + l32 + 2048), c1 = *(const GAS v4u*)(xr + l32 + 2064);
#pragma unroll
            for (int c = 0; c < 4; ++c) { x[c] = (f32x2){bflo(a0[c]), bfhi(a0[c])} * (1.f / PU_SCALE); x[4 + c] = (f32x2){bflo(a1[c]), bfhi(a1[c])} * (1.f / PU_SCALE);
                                          x[8 + c] = (f32x2){bflo(c0[c]), bfhi(c0[c])} * (1.f / PU_SCALE); x[12 + c] = (f32x2){bflo(c1[c]), bfhi(c1[c])} * (1.f / PU_SCALE); } }
#pragma unroll 1
        for (int g = 0; g < 128 / PG_R; g += 2) {
            PG_LOAD(B, PU8, idlo, idhi, g + 1);
            PG_DOT(A, g);
            if (g + 2 < 128 / PG_R) PG_LOAD(A, PU8, idlo, idhi, g + 2); else PG_LOAD(A, PV8, idlo, idhi, 0);
            PG_DOT(B, g + 1);
        }
        LDS_WAIT();
        {
            const float g0 = *(const GAS float*)(pgate_t + l4), g1 = *(const GAS float*)(pgate_t + l4 + 256);
            const float d0 = wl[lane], d1 = wl[64 + lane];
            const float w0 = g0 * 0.5f * d0 * (1.f + erff(d0 * 0.70710678118654752f)) * (1.f / PV_SCALE), w1 = g1 * 0.5f * d1 * (1.f + erff(d1 * 0.70710678118654752f)) * (1.f / PV_SCALE);
            LDS_WAIT(); asm volatile("" ::: "memory");
            wl[lane] = w0; wl[64 + lane] = w1;
            LDS_WAIT(); asm volatile("" ::: "memory");
        }
        f32x2 y[16];
#pragma unroll
        for (int i = 0; i < 16; ++i) y[i] = (f32x2){0.f, 0.f};
#pragma unroll 1
        for (int g = 0; g < 128 / PG_R; g += 2) {
            PG_LOAD(B, PV8, idlo, idhi, g + 1);
            PG_AXPY(A, g);
            if (g + 2 < 128 / PG_R) PG_LOAD(A, PV8, idlo, idhi, g + 2);
            PG_AXPY(B, g + 1);
        }
        {   char* xo = (char*)(X + (size_t)t * DM); const unsigned l64 = 64u * (unsigned)lane;
#pragma unroll
            for (int h = 0; h < 2; ++h)
#pragma unroll
                for (int c = 0; c < 4; ++c) { GAS f32x4* p = (GAS f32x4*)(xo + l64 + 4096 * h + 16 * c); f32x4 v = *p; v += (f32x4){y[8 * h + 2 * c].x, y[8 * h + 2 * c].y, y[8 * h + 2 * c + 1].x, y[8 * h + 2 * c + 1].y}; *p = v; } }
        LDS_WAIT(); asm volatile("" ::: "memory");
    }
}


typedef short s16x4 __attribute__((ext_vector_type(4)));
typedef __attribute__((address_space(3))) const char* lds_cptr;
__device__ __forceinline__ s16x4 vtr(lds_cptr p) { return __builtin_bit_cast(s16x4, __builtin_amdgcn_ds_read_tr16_b64_v4i16((__attribute__((address_space(3))) s16x4*)p)); }
__device__ __forceinline__ unsigned cvtpk(float lo, float hi) { unsigned r; asm("v_cvt_pk_bf16_f32 %0, %1, %2" : "=v"(r) : "v"(lo), "v"(hi)); return r; }
constexpr int AT_K0 = 0, AT_V0 = 16384, AT_TAB = 32768;
constexpr float LOG2E = 1.4426950408889634f;
template <int TYPE>
__device__ __forceinline__ void attn_unit(LAS unsigned char* lds, const bf16* QKV, bf16* ATT, int b, int head, int qb, const float* tabsrc, float Cl2, float sinkl2, int tid) {
    const int lane = tid & 63, w = __builtin_amdgcn_readfirstlane(tid >> 6), hh = lane >> 5, l31 = lane & 31;
    int qcol, kcol, vcol, ocol;
    if (TYPE == 0) { qcol = QA + head * 64; kcol = KA + (head / 3) * 64; vcol = VA + (head / 3) * 64; ocol = OA + head * 64; }
    else if (TYPE == 1) { qcol = QB + head * 64; kcol = KB + head * 64; vcol = VB + head * 64; ocol = OB + head * 64; }
    else { qcol = QC + head * 64; kcol = KC + (head / 3) * 64; vcol = VC + (head / 3) * 64; ocol = OC + head * 64; }
    const int q0 = 256 * qb + 32 * w, qpos = q0 + l31;
    int t_begin, t_end;
    if (TYPE == 0) { t_begin = 4 * qb - 2; if (t_begin < 0) t_begin = 0; t_end = 4 * qb + 6; if (t_end > 32) t_end = 32; }
    else if (TYPE == 1) { int a = 4 * qb - 4; a = a < 0 ? 0 : (a > 24 ? 24 : a); int e = 4 * qb - 1; e = e < 0 ? 0 : (e > 24 ? 24 : e); t_begin = a; t_end = e + 8; }
    else { t_begin = 0; t_end = 32; }
    LAS float* tab = (LAS float*)(lds + AT_TAB);
    if (TYPE == 0) { for (int i = tid; i < 1024; i += NTHREADS) { const int rel = i - 448; tab[i] = (rel >= -128 && rel <= 128) ? tabsrc[head * 257 + rel + 128] * LOG2E - Cl2 : -1e30f; } }
    if (TYPE == 1) { for (int i = tid; i < 15 * 31; i += NTHREADS) tab[i] = tabsrc[head * 465 + i] * LOG2E - Cl2; }
    bf16x8 qf[4];
    {   const bf16* qp = QKV + ((size_t)b * SEQ + qpos) * DIN + qcol + 8 * hh;
#pragma unroll
        for (int s = 0; s < 4; ++s) qf[s] = *(const GAS bf16x8*)(qp + 16 * s); }
    const int srow = tid >> 3, sch = tid & 7;
    const bf16* kg = QKV + ((size_t)b * SEQ + srow) * DIN + kcol + sch * 8;
    const bf16* vg = QKV + ((size_t)b * SEQ + srow) * DIN + vcol + sch * 8;
    const int kst = srow * 128 + ((sch ^ ((srow >> 1) & 7)) * 16);
    const int vst = srow * 128 + (((sch >> 2) ^ ((srow >> 1) & 1)) * 64) + (sch & 3) * 16;
    int kread[4], vread[2];
#pragma unroll
    for (int s = 0; s < 4; ++s) kread[s] = l31 * 128 + (((2 * s + hh) ^ ((lane >> 1) & 7)) * 16);
#pragma unroll
    for (int db = 0; db < 2; ++db) vread[db] = (4 * hh + ((lane >> 2) & 3)) * 128 + ((db ^ ((lane >> 3) & 1)) * 64) + 32 * ((lane >> 4) & 1) + 8 * (lane & 3);
    f32x16 O0, O1;
#pragma unroll
    for (int r = 0; r < 16; ++r) { O0[r] = 0.f; O1[r] = 0.f; }
    float lsum = 0.f;
    const int rw = 4 * qb + (w >> 1), cq = 32 * (w & 1) + l31;
    int r0w = rw - 4; r0w = r0w < 0 ? 0 : (r0w > 24 ? 24 : r0w);
    int c0 = cq - 8; c0 = c0 < 0 ? 0 : (c0 > 48 ? 48 : c0);
    {   const v4u kr = *(const GAS v4u*)(kg + (size_t)t_begin * 64 * DIN), vr = *(const GAS v4u*)(vg + (size_t)t_begin * 64 * DIN);
        *(LAS v4u*)(lds + AT_K0 + kst) = kr; *(LAS v4u*)(lds + AT_V0 + vst) = vr; }
    __syncthreads();
    for (int t = t_begin; t < t_end; ++t) {
        const int cur = (t - t_begin) & 1;
        v4u kr, vr;
        if (t + 1 < t_end) { kr = *(const GAS v4u*)(kg + (size_t)(t + 1) * 64 * DIN); vr = *(const GAS v4u*)(vg + (size_t)(t + 1) * 64 * DIN); }
        bool need = true;
        if (TYPE == 0) need = (64 * t <= q0 + 31 + 128) && (64 * t + 63 >= q0 - 128);
        if (TYPE == 1) need = (t >= r0w) && (t < r0w + 8);
        if (need) {
            const lds_cptr kb_ = (lds_cptr)(lds + AT_K0 + cur * 8192), vb_ = (lds_cptr)(lds + AT_V0 + cur * 8192);
            f32x16 S0, S1;
#pragma unroll
            for (int r = 0; r < 16; ++r) { S0[r] = 0.f; S1[r] = 0.f; }
#pragma unroll
            for (int s = 0; s < 4; ++s) { const bf16x8 k0 = *(const LAS bf16x8*)(kb_ + kread[s]), k1 = *(const LAS bf16x8*)(kb_ + kread[s] + 4096);
                S0 = __builtin_amdgcn_mfma_f32_32x32x16_bf16(k0, qf[s], S0, 0, 0, 0); S1 = __builtin_amdgcn_mfma_f32_32x32x16_bf16(k1, qf[s], S1, 0, 0, 0); }
            if (TYPE == 2) {
#pragma unroll
                for (int r = 0; r < 16; ++r) { S0[r] = __builtin_amdgcn_exp2f(S0[r] * LOG2E - Cl2); S1[r] = __builtin_amdgcn_exp2f(S1[r] * LOG2E - Cl2); }
            } else if (TYPE == 0) {
                const LAS float* tb = tab + (64 * t - qpos + 448 + 4 * hh);
#pragma unroll
                for (int r = 0; r < 16; ++r) { S0[r] = __builtin_amdgcn_exp2f(S0[r] * LOG2E + tb[8 * (r >> 2) + (r & 3)]); S1[r] = __builtin_amdgcn_exp2f(S1[r] * LOG2E + tb[32 + 8 * (r >> 2) + (r & 3)]); }
            } else {
                const LAS float* tb = tab + ((t - rw + 7) * 31 - cq + 15 + 4 * hh);
                const int kc0 = 4 * hh - c0;
#pragma unroll
                for (int r = 0; r < 16; ++r) { const int ka = 8 * (r >> 2) + (r & 3), kb2 = 32 + ka;
                    const float p0 = __builtin_amdgcn_exp2f(S0[r] * LOG2E + tb[ka]), p1 = __builtin_amdgcn_exp2f(S1[r] * LOG2E + tb[kb2]);
                    S0[r] = ((unsigned)(ka + kc0) < 16u) ? p0 : 0.f; S1[r] = ((unsigned)(kb2 + kc0) < 16u) ? p1 : 0.f; }
            }
#pragma unroll
            for (int r = 0; r < 16; ++r) lsum += S0[r] + S1[r];
            bf16x8 pb[4];
#pragma unroll
            for (int hf = 0; hf < 2; ++hf) {
                v4u a, c;
#pragma unroll
                for (int j = 0; j < 4; ++j) { a[j] = cvtpk(S0[8 * hf + 2 * j], S0[8 * hf + 2 * j + 1]); c[j] = cvtpk(S1[8 * hf + 2 * j], S1[8 * hf + 2 * j + 1]); }
                pb[hf] = __builtin_bit_cast(bf16x8, a); pb[2 + hf] = __builtin_bit_cast(bf16x8, c);
            }
#pragma unroll
            for (int ks = 0; ks < 4; ++ks) {
                const s16x4 a0 = vtr(vb_ + vread[0] + (16 * ks) * 128), a1 = vtr(vb_ + vread[0] + (16 * ks + 8) * 128);
                const s16x4 b0 = vtr(vb_ + vread[1] + (16 * ks) * 128), b1 = vtr(vb_ + vread[1] + (16 * ks + 8) * 128);
                const bf16x8 va = __builtin_shufflevector(a0, a1, 0, 1, 2, 3, 4, 5, 6, 7), vb2 = __builtin_shufflevector(b0, b1, 0, 1, 2, 3, 4, 5, 6, 7);
                O0 = __builtin_amdgcn_mfma_f32_32x32x16_bf16(va, pb[ks], O0, 0, 0, 0); O1 = __builtin_amdgcn_mfma_f32_32x32x16_bf16(vb2, pb[ks], O1, 0, 0, 0);
            }
        }
        if (t + 1 < t_end) { *(LAS v4u*)(lds + AT_K0 + (cur ^ 1) * 8192 + kst) = kr; *(LAS v4u*)(lds + AT_V0 + (cur ^ 1) * 8192 + vst) = vr; }
        __syncthreads();
    }
    lsum += shx(lsum, 32, lane);
    if (TYPE == 0) lsum += __builtin_amdgcn_exp2f(sinkl2 - Cl2);
    const float inv = 1.f / lsum;
    bf16* op = ATT + ((size_t)b * SEQ + qpos) * DM + ocol + 4 * hh;
#pragma unroll
    for (int g4 = 0; g4 < 4; ++g4) {
        v2u o0, o1; o0.x = cvtpk(O0[4 * g4] * inv, O0[4 * g4 + 1] * inv); o0.y = cvtpk(O0[4 * g4 + 2] * inv, O0[4 * g4 + 3] * inv);
        o1.x = cvtpk(O1[4 * g4] * inv, O1[4 * g4 + 1] * inv); o1.y = cvtpk(O1[4 * g4 + 2] * inv, O1[4 * g4 + 3] * inv);
        *(GAS v2u*)(op + 8 * g4) = o0; *(GAS v2u*)(op + 32 + 8 * g4) = o1;
    }
}

__device__ __forceinline__ float wave_max(float v, int lane) {
#pragma unroll
    for (int o = 1; o < 64; o <<= 1) v = fmaxf(v, shx(v, o, lane));
    return v;
}
struct Args { const float* in[23]; float* out; unsigned char* ws; int ph_lo, ph_hi, use_bar, pad; };
#ifndef MK_OFF
#define MK_OFF 0u
#endif
#define PHON(k) (!((MK_OFF >> (k)) & 1u))
constexpr int PH_PER_LAYER = 13, PH_BASE = 3, N_PHASES = PH_BASE + DEPTH * PH_PER_LAYER;
constexpr int PTAB_OFF = LDSCTL_OFF + 1024;

__global__ void __launch_bounds__(NTHREADS, 2) mega(Args a) {
    extern __shared__ __attribute__((aligned(16))) unsigned char lds_raw[];
    LAS unsigned char* lds = (LAS unsigned char*)lds_raw;
    {   const int tid0 = threadIdx.x;
        for (int u = tid0; u < (LDS_BYTES - LDSCTL_OFF) / 4; u += NTHREADS) ((LAS unsigned*)(lds + LDSCTL_OFF))[u] = 0u;
        __syncthreads();
        if (tid0 < 23) ((LAS unsigned long long*)(lds + PTAB_OFF))[tid0] = (unsigned long long)a.in[tid0];
        if (tid0 == 23) ((LAS unsigned long long*)(lds + PTAB_OFF))[23] = (unsigned long long)a.out;
        if (tid0 == 24) ((LAS unsigned long long*)(lds + PTAB_OFF))[24] = (unsigned long long)a.ws;
        __syncthreads();
    }
    volatile LAS unsigned* MISC = (volatile LAS unsigned*)(lds + MISC_OFF);
    const int G = gridDim.x, bid = blockIdx.x, NGW = G * NWAVES;
    const int use_bar = a.use_bar;
    XcdBarrier bar; bar.bar = (unsigned*)(a.ws + WS_CTL) + CW_BAR; bar.x = 0; bar.st = MISC + 8;
    if (use_bar) bar = xcd_barrier_post((unsigned*)(a.ws + WS_CTL) + CW_BAR, MISC + 8);
    const int lo = a.ph_lo, hi = a.ph_hi;
#define IN(k) (lo <= (k) && (k) < hi)
#define SEAM(k) do { if (use_bar && IN(k) && IN((k) + 1)) xcd_barrier(bar); } while (0)
#define PHL() int tid_ = threadIdx.x; asm volatile("" : "+v"(tid_)); const int lane_ = tid_ & 63, wave_ = __builtin_amdgcn_readfirstlane(tid_ >> 6), gw_ = bid * NWAVES + wave_; (void)lane_; (void)gw_; \
              int pz_ = 0; asm volatile("" : "+s"(pz_))
#define PTR(i) ((const float*)ldptr(lds, (i) + pz_))
#define WSP() ((unsigned char*)ldptr(lds, 24 + pz_))
#define OUTP() ((float*)ldptr(lds, 23 + pz_))

    if (IN(0) && PHON(0)) {
        PHL(); unsigned char* ws = WSP();
        LAS float* scr = (LAS float*)(lds + RING_OFF + wave_ * 16384);
        constexpr int I_IN = 32 * 128, I_OUT = 32 * 64, I_MQ = 32 * 16, I_MKV = 32 * 32, I_MO = 8 * 64, I_PQ = 32 * 64, I_L = I_IN + I_OUT + I_MQ + I_MKV + I_MO + I_PQ;
        for (int it = gw_; it < DEPTH * I_L; it += NGW) {
            const int l = it / I_L; int r = it % I_L;
            if (r < I_IN) { transpose_item<true>(PTR(4) + (size_t)l * DM * DIN, DM, DIN, (bf16*)(ws + WS_WIN) + (size_t)l * DIN * DM, scr, r, lane_); continue; } r -= I_IN;
            if (r < I_OUT) { transpose_item<false>(PTR(11) + (size_t)l * DM * DM, DM, DM, (bf16*)(ws + WS_WOUT) + (size_t)l * DM * DM, scr, r, lane_); continue; } r -= I_OUT;
            if (r < I_MQ) { transpose_item<false>(PTR(14) + (size_t)l * DM * MEMW, DM, MEMW, (bf16*)(ws + WS_WMQ) + (size_t)l * MEMW * DM, scr, r, lane_); continue; } r -= I_MQ;
            if (r < I_MKV) { transpose_item<false>(PTR(15) + (size_t)l * DM * 1024, DM, 1024, (bf16*)(ws + WS_WMKV) + (size_t)l * 1024 * DM, scr, r, lane_); continue; } r -= I_MKV;
            if (r < I_MO) { transpose_item<false>(PTR(17) + (size_t)l * MEMW * DM, MEMW, DM, (bf16*)(ws + WS_WMO) + (size_t)l * DM * MEMW, scr, r, lane_); continue; } r -= I_MO;
            transpose_item<false>(PTR(19) + (size_t)l * DM * DM, DM, DM, (bf16*)(ws + WS_WPQ) + (size_t)l * DM * DM, scr, r, lane_);
        }
        const size_t gtid = (size_t)bid * NTHREADS + tid_, nth = (size_t)G * NTHREADS;
        convert_bf16(PTR(20), (bf16*)(ws + WS_PKEYS), (size_t)DEPTH * 8 * 2 * 128 * 128, gtid, nth);
        convert_fp8(PTR(21), ws + WS_PU, (size_t)DEPTH * PEER_N * DM, PU_SCALE, gtid, nth);
        convert_fp8(PTR(22), ws + WS_PV, (size_t)DEPTH * PEER_N * DM, PV_SCALE, gtid, nth);
        {   const float* mem = PTR(1); const float* gkv = PTR(13); bf16* MEMN = (bf16*)(ws + WS_MEMN);
            for (int m = gw_; m < BATCH * NMEM; m += NGW)
                rms_row_to_bf16(mem + (size_t)m * DM, gkv, MEMN + (size_t)m * DM, gkv + DM, MEMN + (size_t)(BATCH * NMEM + m) * DM, lane_); }
        float* rope = (float*)(ws + WS_ROPE); float* biasA = (float*)(ws + WS_BIASA);
        if (gtid < 64 * 16) { const int pos = (int)gtid >> 4, i = (int)gtid & 15; const float ang = (float)pos * ROPE_INV[i]; rope[gtid * 2] = cosf(ang); rope[gtid * 2 + 1] = sinf(ang); }
        if (gtid < 12 * 257) { const int h = (int)gtid / 257, rel = (int)gtid % 257 - 128; biasA[gtid] = PTR(2)[t5_bucket(rel) * 12 + h]; }
    }
    SEAM(0);
    if (IN(1) && PHON(1)) {
#pragma unroll 1
        for (int l = 0; l < DEPTH; ++l) {
            PHL(); unsigned char* ws = WSP();
            pg8::Gemm g{(bf16*)(ws + WS_MEMN) + (size_t)l * BATCH * NMEM * DM, (bf16*)(ws + WS_WMKV) + (size_t)l * 1024 * DM, BATCH * NMEM, 1024, DM};
            OffsetOrder S; S.init(BATCH * NMEM, 1024, G, bid, 64 * l);
            pg8::EpiBf16<0> E{(bf16*)(ws + WS_KVM) + (size_t)l * BATCH * NMEM * 1024, 1024, nullptr, 0, 0, 1.f};
            pg8::gemm_phase<pg8::EpiBf16<0>, OffsetOrder, true, true>(lds + RING_OFF, g, S, E, tid_);
            __syncthreads();
        }
    }
    SEAM(1);
    if (IN(2) && PHON(2)) {
        PHL(); unsigned char* ws = WSP(); bf16* KVM = (bf16*)(ws + WS_KVM); const float* gm = PTR(16);
        for (int m = gw_; m < DEPTH * BATCH * NMEM; m += NGW) {
            const int l = m / (BATCH * NMEM);
            GAS v4u* p = (GAS v4u*)(KVM + (size_t)m * 1024 + 8 * lane_);
            const v4u w = *p;
            float f[8] = {bflo(w.x), bfhi(w.x), bflo(w.y), bfhi(w.y), bflo(w.z), bfhi(w.z), bflo(w.w), bfhi(w.w)};
            float ss = 0.f;
#pragma unroll
            for (int i = 0; i < 8; ++i) ss += f[i] * f[i];
            ss += shx(ss, 1, lane_); ss += shx(ss, 2, lane_); ss += shx(ss, 4, lane_); ss += shx(ss, 8, lane_);
            const float r = 1.f / sqrtf(ss * (1.f / 128.f) + EPS);
            const float* gk = gm + (size_t)l * 256 + 128 + 8 * (lane_ & 15);
            v4u o; o.x = pk2(f[0] * r * gk[0], f[1] * r * gk[1]); o.y = pk2(f[2] * r * gk[2], f[3] * r * gk[3]); o.z = pk2(f[4] * r * gk[4], f[5] * r * gk[5]); o.w = pk2(f[6] * r * gk[6], f[7] * r * gk[7]);
            *p = o;
        }
    }
    SEAM(2);

#pragma unroll 1
    for (int l = 0; l < DEPTH; ++l) {
        const int pb = PH_BASE + PH_PER_LAYER * l;
        if (IN(pb + 0) && PHON(3)) { PHL(); unsigned char* ws = WSP(); const float* xin = (l == 0) ? PTR(0) : (const float*)OUTP();
            norm_rows(xin, PTR(3) + (size_t)l * DM, (bf16*)(ws + WS_XN), gw_, NGW, lane_); }
        SEAM(pb + 0);
        if (IN(pb + 1) && PHON(4)) { PHL(); unsigned char* ws = WSP();
            pg8::Gemm g{(bf16*)(ws + WS_XN), (bf16*)(ws + WS_WIN) + (size_t)l * DIN * DM, T, DIN, DM}; pg8::StaticOrder S; S.init(T, DIN, G, bid);
            pg8::EpiQKV E{(bf16*)(ws + WS_QKV), PTR(5) + (size_t)l * 128, PTR(7) + (size_t)l * 128, PTR(9) + (size_t)l * 128, (const float*)(ws + WS_ROPE)};
            pg8::gemm_phase<pg8::EpiQKV, pg8::StaticOrder, true, true>(lds + RING_OFF, g, S, E, tid_);
        }
        SEAM(pb + 1);
        if (IN(pb + 2) && PHON(5)) { PHL(); unsigned char* ws = WSP();
            const float* sink = PTR(6) + (size_t)l * 12; const float* rpb = PTR(8) + (size_t)l * 8 * 15 * 31; const float* biasA = (const float*)(ws + WS_BIASA);
            const bf16* QKV = (const bf16*)(ws + WS_QKV); bf16* ATT = (bf16*)(ws + WS_ATT);
            const float* ga = PTR(5) + (size_t)l * 128; const float* gb = PTR(7) + (size_t)l * 128; const float* gc = PTR(9) + (size_t)l * 128;
            const float CaL2 = 8.f * wave_max(fabsf(ga[lane_]), lane_) * wave_max(fabsf(ga[64 + lane_]), lane_) * LOG2E;
            const float CbL2 = 8.f * wave_max(fabsf(gb[lane_]), lane_) * wave_max(fabsf(gb[64 + lane_]), lane_) * LOG2E;
            const float CcL2 = 8.f * wave_max(fabsf(gc[lane_]), lane_) * wave_max(fabsf(gc[64 + lane_]), lane_) * LOG2E;
            const int vc = (G % 8 == 0) ? (bid % 8) * (G / 8) + bid / 8 : bid;
            for (int u = vc; u < BATCH * 12 * 8; u += G) attn_unit<2>(lds, QKV, ATT, u / 96, (u >> 3) % 12, u & 7, nullptr, CcL2, 0.f, tid_);
            for (int u = vc; u < BATCH * 8 * 8; u += G) attn_unit<1>(lds, QKV, ATT, u >> 6, (u >> 3) & 7, u & 7, rpb, CbL2, 0.f, tid_);
            for (int u = vc; u < BATCH * 12 * 8; u += G) { const int head = (u >> 3) % 12; attn_unit<0>(lds, QKV, ATT, u / 96, head, u & 7, biasA, CaL2, sink[head] * LOG2E, tid_); }
        }
        SEAM(pb + 2);
        if (IN(pb + 3) && PHON(6)) { PHL(); unsigned char* ws = WSP(); mixnorm_rows((bf16*)(ws + WS_ATT), PTR(10) + (size_t)l * DM, gw_, NGW, lane_); }
        SEAM(pb + 3);
        if (IN(pb + 4) && PHON(7)) { PHL(); unsigned char* ws = WSP(); const float* xin = (l == 0) ? PTR(0) : (const float*)OUTP();
            pg8::Gemm g{(bf16*)(ws + WS_ATT), (bf16*)(ws + WS_WOUT) + (size_t)l * DM * DM, T, DM, DM}; pg8::StaticOrder S; S.init(T, DM, G, bid);
            pg8::EpiResid E{xin, OUTP(), DM};
            pg8::gemm_phase<pg8::EpiResid, pg8::StaticOrder, true, true>(lds + RING_OFF, g, S, E, tid_);
        }
        SEAM(pb + 4);
        if (IN(pb + 5) && PHON(8)) { PHL(); unsigned char* ws = WSP(); norm_rows(OUTP(), PTR(12) + (size_t)l * DM, (bf16*)(ws + WS_XN), gw_, NGW, lane_); }
        SEAM(pb + 5);
        if (IN(pb + 6) && PHON(9)) { PHL(); unsigned char* ws = WSP();
            pg8::Gemm g{(bf16*)(ws + WS_XN), (bf16*)(ws + WS_WMQ) + (size_t)l * MEMW * DM, T, MEMW, DM}; pg8::StaticOrder S; S.init(T, MEMW, G, bid);
            pg8::EpiBf16<0> E{(bf16*)(ws + WS_QM), MEMW, nullptr, 0, 0, 1.f};
            pg8::gemm_phase<pg8::EpiBf16<0>, pg8::StaticOrder, true, true>(lds + RING_OFF, g, S, E, tid_);
        }
        SEAM(pb + 6);
        if (IN(pb + 7) && PHON(10)) { PHL(); unsigned char* ws = WSP();
            const bf16* kvm = (const bf16*)(ws + WS_KVM) + (size_t)l * BATCH * NMEM * 1024; const float* gq = PTR(16) + (size_t)l * 256;
            for (int it = gw_; it < T * 4; it += NGW) { const int t = it >> 2, head = it & 3; naive_mem_item((const bf16*)(ws + WS_QM), kvm, (bf16*)(ws + WS_OM), gq, (size_t)t, t >> 11, head, lane_); }
        }
        SEAM(pb + 7);
        if (IN(pb + 8) && PHON(11)) { PHL(); unsigned char* ws = WSP();
            pg8::Gemm g{(bf16*)(ws + WS_OM), (bf16*)(ws + WS_WMO) + (size_t)l * DM * MEMW, T, DM, MEMW}; pg8::StaticOrder S; S.init(T, DM, G, bid);
            pg8::EpiResid E{OUTP(), OUTP(), DM};
            pg8::gemm_phase<pg8::EpiResid, pg8::StaticOrder, true, true>(lds + RING_OFF, g, S, E, tid_);
        }
        SEAM(pb + 8);
        if (IN(pb + 9) && PHON(12)) { PHL(); unsigned char* ws = WSP(); norm_rows(OUTP(), PTR(18) + (size_t)l * DM, (bf16*)(ws + WS_XN), gw_, NGW, lane_); }
        SEAM(pb + 9);
        if (IN(pb + 10) && PHON(13)) { PHL(); unsigned char* ws = WSP();
            pg8::Gemm g{(bf16*)(ws + WS_XN), (bf16*)(ws + WS_WPQ) + (size_t)l * DM * DM, T, DM, DM}; pg8::StaticOrder S; S.init(T, DM, G, bid);
            pg8::EpiBf16<0> E{(bf16*)(ws + WS_QP), DM, nullptr, 0, 0, 1.f};
            pg8::gemm_phase<pg8::EpiBf16<0>, pg8::StaticOrder, true, true>(lds + RING_OFF, g, S, E, tid_);
        }
        SEAM(pb + 10);
        if (IN(pb + 11) && PHON(14)) { PHL(); unsigned char* ws = WSP();
            const bf16* pk = (const bf16*)(ws + WS_PKEYS) + (size_t)l * 8 * 2 * 128 * 128;
            for (int u = bid; u < (T / 256) * PEER_H; u += G) peer_select_unit((const bf16*)(ws + WS_QP), pk, (int*)(ws + WS_PIDX), (float*)(ws + WS_PGATE), u >> 3, u & 7, wave_, lane_);
        }
        SEAM(pb + 11);
        if (IN(pb + 12) && PHON(15)) { PHL(); unsigned char* ws = WSP();
            peer_gather8((const bf16*)(ws + WS_XN), ws + WS_PU + (size_t)l * PEER_N * DM, ws + WS_PV + (size_t)l * PEER_N * DM, (const int*)(ws + WS_PIDX), (const float*)(ws + WS_PGATE), OUTP(), (LAS float*)(lds + RING_OFF + wave_ * 1024), gw_, NGW, lane_); }
        SEAM(pb + 12);
    }
#undef IN
#undef SEAM
}

#ifndef MK_MULTI_LAUNCH
#define MK_MULTI_LAUNCH 0
#endif
extern "C" void kernel_launch(void* const* d_in, const int* in_sizes, int n_in, void* d_out, int out_size, void* d_ws, size_t ws_size, hipStream_t stream) {
    static int grid = 0;
    if (grid == 0) {
        if (n_in != 23 || out_size != T * DM || ws_size < WS_END) { fprintf(stderr, "kernel_launch: unexpected shapes (n_in %d, out %d, ws %zu)\n", n_in, out_size, ws_size); grid = -1; return; }
        int dev = 0, cus = 0, per_cu = 0;
        if (hipGetDevice(&dev) != hipSuccess || hipDeviceGetAttribute(&cus, hipDeviceAttributeMultiprocessorCount, dev) != hipSuccess) { grid = -1; return; }
        if (hipFuncSetAttribute((const void*)mega, hipFuncAttributeMaxDynamicSharedMemorySize, LDS_BYTES) != hipSuccess) { fprintf(stderr, "kernel_launch: hipFuncSetAttribute failed\n"); grid = -1; return; }
        if (hipOccupancyMaxActiveBlocksPerMultiprocessor(&per_cu, (const void*)mega, NTHREADS, LDS_BYTES) != hipSuccess || per_cu < 1) { fprintf(stderr, "kernel_launch: occupancy query says %d\n", per_cu); }
        (void)hipGetLastError();
        grid = cus;
    }
    if (grid < 0) return;
    (void)hipMemsetAsync((char*)d_ws + WS_CTL, 0, CTL_ZERO_BYTES, stream);
    Args a{};
    for (int i = 0; i < 23; ++i) a.in[i] = (const float*)d_in[i];
    a.out = (float*)d_out; a.ws = (unsigned char*)d_ws;
#if MK_MULTI_LAUNCH
    for (int p = 0; p < N_PHASES; ++p) { a.ph_lo = p; a.ph_hi = p + 1; a.use_bar = 0; a.pad = 0; hipLaunchKernelGGL(mega, dim3(grid), dim3(NTHREADS), LDS_BYTES, stream, a); }
#else
    a.ph_lo = 0; a.ph_hi = N_PHASES; a.use_bar = 1; a.pad = 0;
    hipLaunchKernelGGL(mega, dim3(grid), dim3(NTHREADS), LDS_BYTES, stream, a);
#endif
    const hipError_t le = hipPeekAtLastError();
    if (le != hipSuccess) fprintf(stderr, "kernel_launch: launch failed: %s\n", hipGetErrorName(le));
}
```

```cpp
#include <hip/hip_runtime.h>
#include <cstdio>
#include <cstdint>
#include <cmath>
__device__ __forceinline__ float shx(float v, int k, int lane);
namespace pg8 {
#define PG8_LAS __attribute__((address_space(3)))
typedef unsigned short bf16_t;
typedef short bf16x8 __attribute__((ext_vector_type(8)));
typedef float f32x4 __attribute__((ext_vector_type(4)));
typedef unsigned u32x4 __attribute__((ext_vector_type(4)));
constexpr int BM = 256, BK = 64, HALF = 128, HTB = HALF * BK * 2  , STAGE_BYTES = 8 * HTB, NXCD = 8, WGM = 8;

__host__ __device__ __forceinline__ int lds_byte(int r, int c) { const int st = (r >> 4) * 2 + (c >> 5), rr = r & 15, cc = c & 31, ob = rr * 64 + cc * 2; return st * 1024 + (ob ^ (((ob >> 9) & 1) << 5)); }
__host__ __device__ __forceinline__ void stage_rc(int b, int& R, int& C) { const int st = b / 1024, sb = b % 1024, swz = sb ^ (((sb >> 9) & 1) << 5); R = (st >> 1) * 16 + swz / 64; C = (st & 1) * 32 + (swz % 64) / 2; }
__host__ __device__ __forceinline__ int perm32(int rho) { const int n = rho >> 4, i = rho & 15; return 8 * (i >> 2) + 4 * n + (i & 3); }

struct Unit { int pm, pn; };
struct Gemm { const bf16_t* A; const bf16_t* Bt; int M, N, K; };

struct StaticOrder {
    int nM, nN, nwg, G, c;
    __host__ __device__ void init(int M, int N, int G_, int c_) { nM = M / BM; nN = N / BM; nwg = nM * nN; G = G_; c = c_; }
    __host__ __device__ bool next(int i, Unit& u) const {
        const long L = (long)i * G + c; if (L >= nwg) return false;
        int wgid = (int)L; { const int q = nwg / NXCD, r = nwg % NXCD, xcd = wgid % NXCD, off = wgid / NXCD; wgid = (xcd < r ? xcd * (q + 1) : r * (q + 1) + (xcd - r) * q) + off; }
        const int nig = WGM * nN, gid = wgid / nig, fm = gid * WGM, gsz = (nM - fm) < WGM ? (nM - fm) : WGM;
        u.pm = fm + ((wgid % nig) % gsz); u.pn = (wgid % nig) / gsz; return true;
    }
    __device__ __forceinline__ void a_ready(const Unit&) const {}
    __device__ __forceinline__ void done(const Unit&) const {}
};

__device__ __forceinline__ unsigned cvt_pk_bf16(float lo, float hi) { unsigned r; asm volatile("v_cvt_pk_bf16_f32 %0, %1, %2" : "=v"(r) : "v"(lo), "v"(hi)); return r; }
typedef float f32x2 __attribute__((ext_vector_type(2)));
__device__ __forceinline__ f32x2 gelu_pk(f32x2 v) {
    const f32x2 av = __builtin_elementwise_abs(v), d = av * 0.2316418882f + 1.0f;
    f32x2 t; t.x = __builtin_amdgcn_rcpf(d.x); t.y = __builtin_amdgcn_rcpf(d.y);
    f32x2 q = t * 0.5307027145f + (-0.7265760135f); q = q * t + 0.7107068705f; q = q * t + (-0.142248368f); q = q * t + 0.127414796f; q = q * t;
    const f32x2 s = (v * v) * (-0.72134752044f);
    f32x2 e; e.x = __builtin_amdgcn_exp2f(s.x); e.y = __builtin_amdgcn_exp2f(s.y);
    const f32x2 m = v * (q * e), r = v - m;
    f32x2 o; o.x = v.x < 0.f ? m.x : r.x; o.y = v.y < 0.f ? m.y : r.y; return o;
}

template <int ACT  > struct EpiBf16 {
    static constexpr bool PERM = true, AFTER_DRAIN = false; static_assert(ACT == 0 || ACT == 1, "EpiBf16: ACT is 0 (none) or 1 (gelu_pk)");
    bf16_t* O; int ldc; const float* bias; int split_cols; size_t split_stride; float scale0;
    __device__ __forceinline__ void operator()(const f32x4 (&acc)[2][2][4][2], const Unit& u, int wr, int wc, int fr, int fq) const {
        const int row0 = u.pm * BM + wr * 64 + fr; int colt = u.pn * BM; bf16_t* base = O;
        float sc = 1.f; if (split_cols) { const int t = colt / split_cols; base += (size_t)t * split_stride; colt -= t * split_cols; if (t == 0) sc = scale0; }
        const int col0 = colt + wc * 32 + 8 * fq, bcol0 = u.pn * BM + wc * 32 + 8 * fq;
        f32x4 bv[2][2];
#pragma unroll
        for (int bj = 0; bj < 2; ++bj)
#pragma unroll
            for (int n = 0; n < 2; ++n) bv[bj][n] = bias ? *(const f32x4*)(bias + bcol0 + bj * HALF + 4 * n) : (f32x4){0.f, 0.f, 0.f, 0.f};
#pragma unroll
        for (int ai = 0; ai < 2; ++ai)
#pragma unroll
            for (int m = 0; m < 4; ++m) { bf16_t* rowp = base + (size_t)(row0 + ai * HALF + m * 16) * ldc + col0;
#pragma unroll
                for (int bj = 0; bj < 2; ++bj) { f32x4 v0 = acc[ai][bj][m][0] + bv[bj][0], v1 = acc[ai][bj][m][1] + bv[bj][1];
                    if (ACT == 1) { f32x2 a = gelu_pk((f32x2){v0[0], v0[1]}), b = gelu_pk((f32x2){v0[2], v0[3]}), c = gelu_pk((f32x2){v1[0], v1[1]}), d = gelu_pk((f32x2){v1[2], v1[3]});
                        v0 = (f32x4){a.x, a.y, b.x, b.y}; v1 = (f32x4){c.x, c.y, d.x, d.y}; }
                    v0 = v0 * sc; v1 = v1 * sc; u32x4 w; w.x = cvt_pk_bf16(v0[0], v0[1]); w.y = cvt_pk_bf16(v0[2], v0[3]); w.z = cvt_pk_bf16(v1[0], v1[1]); w.w = cvt_pk_bf16(v1[2], v1[3]);
                    *(u32x4*)(rowp + bj * HALF) = w; } }
    }
};

typedef unsigned u32x2 __attribute__((ext_vector_type(2)));
struct EpiResid {
    static constexpr bool PERM = false, AFTER_DRAIN = false;
    const float* base; float* out; int ldc;
    __device__ __forceinline__ void operator()(const f32x4 (&acc)[2][2][4][2], const Unit& u, int wr, int wc, int fr, int fq) const {
        const int col0 = u.pn * BM + wc * 32 + 4 * fq;
#pragma unroll
        for (int ai = 0; ai < 2; ++ai)
#pragma unroll
            for (int m = 0; m < 4; ++m) { const size_t off = (size_t)(u.pm * BM + ai * HALF + wr * 64 + m * 16 + fr) * ldc + col0;
#pragma unroll
                for (int bj = 0; bj < 2; ++bj)
#pragma unroll
                    for (int n = 0; n < 2; ++n) { const f32x4 bs = *(const f32x4*)(base + off + bj * HALF + n * 16); *(f32x4*)(out + off + bj * HALF + n * 16) = bs + acc[ai][bj][m][n]; } }
    }
};
struct EpiQKV {
    static constexpr bool PERM = false, AFTER_DRAIN = false;
    bf16_t* O; const float* ga; const float* gb; const float* gc; const float* rope;
    __device__ __forceinline__ void operator()(const f32x4 (&acc)[2][2][4][2], const Unit& u, int wr, int wc, int fr, int fq) const {
        const int hg = u.pn * 4 + wc;
        const float* g = nullptr; bool isq = false, dorope = false;
        if (hg < 12) { g = ga; isq = true; } else if (hg < 16) { g = ga + 64; } else if (hg < 20) { }
        else if (hg < 28) { g = gb; isq = true; } else if (hg < 36) { g = gb + 64; } else if (hg < 44) { }
        else if (hg < 56) { g = gc; isq = true; dorope = true; } else if (hg < 60) { g = gc + 64; dorope = true; }
        const float qs = isq ? 0.125f : 1.0f;
#pragma unroll
        for (int ai = 0; ai < 2; ++ai)
#pragma unroll
            for (int m = 0; m < 4; ++m) {
                const int row = u.pm * BM + ai * HALF + wr * 64 + m * 16 + fr;
                f32x4 v[2][2];
#pragma unroll
                for (int bj = 0; bj < 2; ++bj)
#pragma unroll
                    for (int n = 0; n < 2; ++n) v[bj][n] = acc[ai][bj][m][n];
                if (g) {
                    float ss = 0.f;
#pragma unroll
                    for (int bj = 0; bj < 2; ++bj)
#pragma unroll
                        for (int n = 0; n < 2; ++n) { const f32x4 x = v[bj][n]; ss += (x[0] * x[0] + x[1] * x[1]) + (x[2] * x[2] + x[3] * x[3]); }
                    ss += shx(ss, 16, fr + 16 * fq); ss += shx(ss, 32, fr + 16 * fq);
                    const float r = qs / sqrtf(ss * (1.0f / 64.0f) + 1e-6f);
#pragma unroll
                    for (int bj = 0; bj < 2; ++bj)
#pragma unroll
                        for (int n = 0; n < 2; ++n) v[bj][n] = v[bj][n] * *(const f32x4*)(g + 32 * bj + 16 * n + 4 * fq) * r;
                }
                if (dorope) {
                    const int t = row & 2047, pr = t >> 6, pc = t & 63;
#pragma unroll
                    for (int bj = 0; bj < 2; ++bj) {
                        const int pos = bj ? pc : pr;
                        const float* rp = rope + (size_t)(pos * 16 + 4 * fq) * 2;
                        const f32x4 c01 = *(const f32x4*)rp, c23 = *(const f32x4*)(rp + 4);
                        const f32x4 cs = (f32x4){c01[0], c01[2], c23[0], c23[2]}, sn = (f32x4){c01[1], c01[3], c23[1], c23[3]};
                        const f32x4 x1 = v[bj][0], x2 = v[bj][1];
                        v[bj][0] = x1 * cs - x2 * sn; v[bj][1] = x1 * sn + x2 * cs;
                    }
                }
                bf16_t* rowp = O + (size_t)row * 4096 + hg * 64 + 4 * fq;
#pragma unroll
                for (int bj = 0; bj < 2; ++bj)
#pragma unroll
                    for (int n = 0; n < 2; ++n) { u32x2 w; w.x = cvt_pk_bf16(v[bj][n][0], v[bj][n][1]); w.y = cvt_pk_bf16(v[bj][n][2], v[bj][n][3]); *(u32x2*)(rowp + 32 * bj + 16 * n) = w; }
                asm volatile("" ::: "memory");
            }
    }
};
template <class Epi, class Sched, bool ALIGN_EPI = false, bool SP2 = false>
__device__ __forceinline__ void gemm_phase(PG8_LAS unsigned char* lds, const Gemm g, const Sched& S, const Epi& E, const int tid) {
    const int wid = __builtin_amdgcn_readfirstlane(tid >> 6), lane = tid & 63, wr = wid >> 2, wc = wid & 3, fr = lane & 15, fq = lane >> 4;
    const int K = g.K, nt = K / BK;
    unsigned voffA[2], voffB[2];
#pragma unroll
    for (int i = 0; i < 2; ++i) { int R, C; stage_rc(tid * 16 + i * 8192, R, C); const int Rb = Epi::PERM ? ((R & ~31) + perm32(R & 31)) : R;
        voffA[i] = (unsigned)(R * K + C) * 2u; voffB[i] = (unsigned)(Rb * K + C) * 2u; }
    const size_t kstep = (size_t)(BK * 2);
    const size_t hstep = (size_t)HALF * K * 2;
    const size_t tstep = 2 * hstep;
    const unsigned ldsw = (unsigned)wid * 1024u;
    const int aoff = lds_byte(wr * 64 + fr, fq * 8), boff = lds_byte(wc * 32 + fr, fq * 8);
#define PG8_SA(b, h) (((b) * 2 + (h)) * HTB)
#define PG8_SB(b, h) ((4 + (b) * 2 + (h)) * HTB)
#define PG8_STAGE(bufoff, gbase, voff) do { _Pragma("unroll") for (int _i = 0; _i < 2; ++_i) \
        __builtin_amdgcn_global_load_lds((const unsigned*)((const char*)(gbase) + (voff)[_i]), (PG8_LAS unsigned*)(lds + (bufoff) + ldsw + _i * 8192), 16, 0, 0); } while (0)
#define PG8_LDA(dst, b, h) do { _Pragma("unroll") for (int m = 0; m < 4; ++m) _Pragma("unroll") for (int k = 0; k < 2; ++k) dst[m][k] = *(const PG8_LAS bf16x8*)(lds + PG8_SA(b, h) + aoff + m * 2048 + k * 1024); } while (0)
#define PG8_LDB(dst, b, h) do { _Pragma("unroll") for (int n = 0; n < 2; ++n) _Pragma("unroll") for (int k = 0; k < 2; ++k) dst[n][k] = *(const PG8_LAS bf16x8*)(lds + PG8_SB(b, h) + boff + n * 2048 + k * 1024); } while (0)
#define PG8_MMA(ai, bj, At, Bt) do { __builtin_amdgcn_s_setprio(1); _Pragma("unroll") for (int m = 0; m < 4; ++m) _Pragma("unroll") for (int n = 0; n < 2; ++n) _Pragma("unroll") for (int k = 0; k < 2; ++k) \
        acc[ai][bj][m][n] = __builtin_amdgcn_mfma_f32_16x16x32_bf16(Bt[n][k], At[m][k], acc[ai][bj][m][n], 0, 0, 0); __builtin_amdgcn_s_setprio(0); } while (0)
#define PG8_WAIT_V(n) asm volatile("s_waitcnt vmcnt(" #n ")" ::: "memory")
#define PG8_WAIT_L(n) asm volatile("s_waitcnt lgkmcnt(" #n ")" ::: "memory")
#define PG8_BAR __builtin_amdgcn_s_barrier()
#define PG8_SCHED __builtin_amdgcn_sched_barrier(0)
    Unit cur, nxt; int ui = 0;
    if (!S.next(0, cur)) return;
    f32x4 acc[2][2][4][2];
#pragma unroll
    for (int a = 0; a < 2; ++a)
#pragma unroll
        for (int b = 0; b < 2; ++b)
#pragma unroll
            for (int m = 0; m < 4; ++m)
#pragma unroll
                for (int n = 0; n < 2; ++n) acc[a][b][m][n] = (f32x4){0.f, 0.f, 0.f, 0.f};
    bf16x8 At[4][2], B0[2][2], B1[2][2];
    const char* cA = (const char*)g.A + (size_t)cur.pm * tstep; const char* cB = (const char*)g.Bt + (size_t)cur.pn * tstep;
    S.a_ready(cur);
    if constexpr (SP2) {
        PG8_STAGE(PG8_SB(0, 0), cB, voffB); PG8_STAGE(PG8_SB(0, 1), cB + hstep, voffB); PG8_STAGE(PG8_SA(0, 0), cA, voffA); PG8_STAGE(PG8_SA(0, 1), cA + hstep, voffA);
        if (wr == 1) PG8_BAR;
        PG8_WAIT_V(2); PG8_BAR;
        PG8_STAGE(PG8_SB(1, 0), cB + kstep, voffB); PG8_STAGE(PG8_SA(1, 0), cA + kstep, voffA); PG8_STAGE(PG8_SB(1, 1), cB + hstep + kstep, voffB);
        PG8_WAIT_V(6); PG8_BAR;
    } else {
        PG8_STAGE(PG8_SB(0, 0), cB, voffB); PG8_STAGE(PG8_SA(0, 0), cA, voffA); PG8_STAGE(PG8_SB(0, 1), cB + hstep, voffB); PG8_STAGE(PG8_SA(0, 1), cA + hstep, voffA);
        if (wr == 1) PG8_BAR;
        PG8_WAIT_V(4); PG8_BAR;
        PG8_STAGE(PG8_SB(1, 0), cB + kstep, voffB); PG8_STAGE(PG8_SA(1, 0), cA + kstep, voffA); PG8_STAGE(PG8_SB(1, 1), cB + hstep + kstep, voffB);
        PG8_WAIT_V(6); PG8_BAR;
    }
    for (;;) {
        const bool has_next = S.next(ui + 1, nxt);
        const char* nA = has_next ? (const char*)g.A + (size_t)nxt.pm * tstep : cA; const char* nB = has_next ? (const char*)g.Bt + (size_t)nxt.pn * tstep : cB;
        for (int t = 0; t < nt; t += 2) {
            const bool last = (t == nt - 2);
            const char* a1 = cA + (size_t)(t + 1) * kstep;
            const char* a2 = last ? nA : cA + (size_t)(t + 2) * kstep; const char* b2 = last ? nB : cB + (size_t)(t + 2) * kstep;
            const char* a3 = a2 + kstep; const char* b3 = b2 + kstep;
            if (last && has_next) S.a_ready(nxt);
            if constexpr (SP2) {
            PG8_LDB(B0, 0, 0); PG8_LDB(B1, 0, 1); PG8_SCHED; PG8_LDA(At, 0, 0); PG8_STAGE(PG8_SA(1, 1), a1 + hstep, voffA);
            PG8_WAIT_V(8); PG8_WAIT_L(0); PG8_BAR; PG8_MMA(0, 0, At, B0); PG8_MMA(0, 1, At, B1); PG8_BAR; PG8_SCHED;
            PG8_LDA(At, 0, 1); PG8_STAGE(PG8_SB(0, 0), b2, voffB); PG8_STAGE(PG8_SB(0, 1), b2 + hstep, voffB); PG8_STAGE(PG8_SA(0, 0), a2, voffA);
            PG8_WAIT_V(8); PG8_WAIT_L(0); PG8_BAR; PG8_MMA(1, 0, At, B0); PG8_MMA(1, 1, At, B1); PG8_BAR; PG8_SCHED;
            PG8_LDB(B0, 1, 0); PG8_LDB(B1, 1, 1); PG8_SCHED; PG8_LDA(At, 1, 0); PG8_STAGE(PG8_SA(0, 1), a2 + hstep, voffA);
            PG8_WAIT_V(8); PG8_WAIT_L(0); PG8_BAR; PG8_MMA(0, 0, At, B0); PG8_MMA(0, 1, At, B1); PG8_BAR; PG8_SCHED;
            PG8_LDA(At, 1, 1); PG8_STAGE(PG8_SB(1, 0), b3, voffB); PG8_STAGE(PG8_SB(1, 1), b3 + hstep, voffB); PG8_STAGE(PG8_SA(1, 0), a3, voffA);
            PG8_WAIT_V(8); PG8_WAIT_L(0); PG8_BAR; PG8_MMA(1, 0, At, B0); PG8_MMA(1, 1, At, B1); PG8_BAR; PG8_SCHED;
            } else {
            PG8_LDB(B0, 0, 0); PG8_SCHED; PG8_LDA(At, 0, 0); PG8_STAGE(PG8_SA(1, 1), a1 + hstep, voffA);
            PG8_WAIT_L(8); PG8_BAR; PG8_WAIT_L(0); PG8_MMA(0, 0, At, B0); PG8_BAR; PG8_SCHED;
            PG8_LDB(B1, 0, 1); PG8_STAGE(PG8_SB(0, 0), b2, voffB);
            PG8_BAR; PG8_WAIT_L(0); PG8_MMA(0, 1, At, B1); PG8_BAR;
            PG8_LDA(At, 0, 1); PG8_STAGE(PG8_SA(0, 0), a2, voffA);
            PG8_BAR; PG8_WAIT_L(0); PG8_MMA(1, 0, At, B0); PG8_BAR; PG8_SCHED;
            PG8_STAGE(PG8_SB(0, 1), b2 + hstep, voffB);
            PG8_WAIT_V(6); PG8_BAR; PG8_MMA(1, 1, At, B1); PG8_BAR;
            PG8_LDB(B0, 1, 0); PG8_SCHED; PG8_LDA(At, 1, 0); PG8_STAGE(PG8_SA(0, 1), a2 + hstep, voffA);
            PG8_WAIT_L(8); PG8_BAR; PG8_WAIT_L(0); PG8_MMA(0, 0, At, B0); PG8_BAR; PG8_SCHED;
            PG8_LDB(B1, 1, 1); PG8_STAGE(PG8_SB(1, 0), b3, voffB);
            PG8_BAR; PG8_WAIT_L(0); PG8_MMA(0, 1, At, B1); PG8_BAR;
            PG8_LDA(At, 1, 1); PG8_STAGE(PG8_SA(1, 0), a3, voffA);
            PG8_BAR; PG8_WAIT_L(0); PG8_MMA(1, 0, At, B0); PG8_BAR; PG8_SCHED;
            PG8_STAGE(PG8_SB(1, 1), b3 + hstep, voffB);
            PG8_WAIT_V(6); PG8_BAR; PG8_MMA(1, 1, At, B1); PG8_BAR;
            }
        }
        if constexpr (ALIGN_EPI) { if (wr == 0) PG8_BAR; }
        if constexpr (!Epi::AFTER_DRAIN) { E(acc, cur, wr, wc, fr, fq); S.done(cur); }
        if (!has_next) break;
#pragma unroll
        for (int a = 0; a < 2; ++a)
#pragma unroll
            for (int b = 0; b < 2; ++b)
#pragma unroll
                for (int m = 0; m < 4; ++m)
#pragma unroll
                    for (int n = 0; n < 2; ++n) acc[a][b][m][n] = (f32x4){0.f, 0.f, 0.f, 0.f};
        cur = nxt; cA = nA; cB = nB; ++ui;
        if constexpr (ALIGN_EPI) { if (wr == 1) PG8_BAR; }
    }
    PG8_WAIT_V(0);
    if constexpr (!ALIGN_EPI) { if (wr == 0) PG8_BAR; }
    PG8_BAR;
    if constexpr (Epi::AFTER_DRAIN) { E.fused(acc, cur, wr, wc, fr, fq, lds, wid, lane); S.done(cur); }
#undef PG8_SA
#undef PG8_SB
#undef PG8_STAGE
#undef PG8_LDA
#undef PG8_LDB
#undef PG8_MMA
#undef PG8_WAIT_V
#undef PG8_WAIT_L
#undef PG8_BAR
#undef PG8_SCHED
}
}

constexpr int BATCH = 16, SEQ = 2048, DM = 2048, T = BATCH * SEQ, DEPTH = 2;
constexpr int NMEM = 256, DIN = 4096, MEMW = 512;
constexpr int PEER_H = 8, PEER_N = 16384;
constexpr int NWAVES = 8, NTHREADS = NWAVES * 64;
constexpr float EPS = 1e-6f;
constexpr int QA = 0, KA = 768, VA = 1024, QB = 1280, KB = 1792, VB = 2304, QC = 2816, KC = 3584, VC = 3840;
constexpr int OA = 0, OB = 768, OC = 1280;

constexpr size_t MiB = 1u << 20;
constexpr size_t WS_CTL = 0, CTL_ZERO_BYTES = 1 * MiB;
constexpr size_t WS_ROPE = 1 * MiB, WS_BIASA = 1 * MiB + 16384;
constexpr size_t WS_WIN = 2 * MiB, WS_WOUT = 34 * MiB, WS_WMQ = 50 * MiB, WS_WMKV = 54 * MiB, WS_WMO = 62 * MiB, WS_WPQ = 66 * MiB, WS_PKEYS = 82 * MiB;
constexpr size_t WS_MEMN = 84 * MiB, WS_KVM = 116 * MiB, WS_PU = 132 * MiB, WS_PV = 260 * MiB, WS_XN = 388 * MiB, WS_QKV = 516 * MiB, WS_ATT = 772 * MiB;
constexpr size_t WS_QM = 900 * MiB, WS_OM = 932 * MiB, WS_END = 964 * MiB;
constexpr size_t WS_QP = WS_QKV, WS_PIDX = WS_QKV + 128 * MiB, WS_PGATE = WS_QKV + 144 * MiB;
constexpr int CW_BAR = 4096;

constexpr int RING_OFF = 0, RING_BYTES = 131072;
constexpr int LDSCTL_OFF = RING_BYTES, MISC_OFF = LDSCTL_OFF + 320;
constexpr int LDS_BYTES = 147456;

#define GAS __attribute__((address_space(1)))
#define LAS __attribute__((address_space(3)))
typedef unsigned short bf16;
typedef unsigned v4u __attribute__((ext_vector_type(4)));
typedef unsigned v2u __attribute__((ext_vector_type(2)));
typedef float f32x4 __attribute__((ext_vector_type(4)));
typedef float f32x16 __attribute__((ext_vector_type(16)));
typedef short bf16x8 __attribute__((ext_vector_type(8)));
typedef GAS unsigned gu32;
#define LDS_WAIT() asm volatile("s_waitcnt lgkmcnt(0)" ::: "memory")
#define VM_WAIT() asm volatile("s_waitcnt vmcnt(0)" ::: "memory")
__device__ __forceinline__ unsigned f2bf(float f) { unsigned u = __builtin_bit_cast(unsigned, f); return (u + 0x7fffu + ((u >> 16) & 1u)) >> 16; }
__device__ __forceinline__ unsigned pk2(float lo, float hi) { return f2bf(lo) | (f2bf(hi) << 16); }
__device__ __forceinline__ float bflo(unsigned w) { return __builtin_bit_cast(float, w << 16); }
__device__ __forceinline__ float bfhi(unsigned w) { return __builtin_bit_cast(float, w & 0xffff0000u); }

__device__ __forceinline__ float shx(float v, int k, int lane) { return __builtin_bit_cast(float, __builtin_amdgcn_ds_bpermute((lane ^ k) << 2, __builtin_bit_cast(int, v))); }
#define XB_TMO      128
#define XB_XCNT(j)  (256  + 64 * (j))
#define XB_XSUB(j)  (1280 + 64 * (j))
#define XB_XGEN(j)  (2304 + 64 * (j))
#define XB_TOP      3328
#define XB_TOPGEN   3392
#define XCD_BAR_WORDS 3456
#define XB_SPIN_CAP (1u << 18)

__device__ __forceinline__ unsigned xb_ld(unsigned* p)              { return __hip_atomic_load(p, __ATOMIC_RELAXED, __HIP_MEMORY_SCOPE_AGENT); }
__device__ __forceinline__ unsigned xb_add(unsigned* p, unsigned v) { return __hip_atomic_fetch_add(p, v, __ATOMIC_RELAXED, __HIP_MEMORY_SCOPE_AGENT); }
__device__ __forceinline__ unsigned xb_xcc_id() { return (unsigned)__builtin_amdgcn_s_getreg((3 << 11) | 20) & 0xFu; }
#define XB_SPIN(cond, bar) do { unsigned _sp = 0; while (cond) { __builtin_amdgcn_s_sleep(1); \
    if ((++_sp & 255u) == 0u) { if (xb_ld(&(bar)[XB_TMO])) break; if (_sp > XB_SPIN_CAP) { atomicAdd(&(bar)[XB_TMO], 1u); break; } } } } while (0)

struct XcdBarrier {
    unsigned* bar; unsigned x;
    volatile LAS unsigned* st;
};

__device__ __forceinline__ XcdBarrier xcd_barrier_post(unsigned* bar, volatile LAS unsigned* st) {
    XcdBarrier b; b.bar = bar; b.x = xb_xcc_id(); b.st = st;
    if (threadIdx.x == 0) (void)xb_add(&bar[XB_XCNT(b.x)], 1u);
    return b;
}
__device__ __forceinline__ void xcd_barrier_complete(unsigned* bar, unsigned x, unsigned& nloc, unsigned& nx) {
    const unsigned G = gridDim.x * gridDim.y * gridDim.z;
    unsigned sum, cnt, mine, sp = 0u;
    for (;;) {
        sum = 0u; cnt = 0u; mine = 0u;
#pragma unroll
        for (unsigned j = 0; j < 16; ++j) { const unsigned c = xb_ld(&bar[XB_XCNT(j)]); sum += c; cnt += (c > 0u) ? 1u : 0u; mine = (j == x) ? c : mine; }
        if (sum == G) break;
        __builtin_amdgcn_s_sleep(1);
        if ((++sp & 255u) == 0u) { if (xb_ld(&bar[XB_TMO])) break; if (sp > XB_SPIN_CAP) { atomicAdd(&bar[XB_TMO], 1u); break; } }
    }
    nloc = mine > 0u ? mine : 1u; nx = cnt > 0u ? cnt : 1u;
}

__device__ __forceinline__ void xcd_barrier(const XcdBarrier& b) {
    asm volatile("s_waitcnt vmcnt(0)" ::: "memory");
    __syncthreads();
    if (threadIdx.x == 0) {
        unsigned* bar = b.bar;
        __builtin_amdgcn_s_waitcnt(0);
        unsigned nloc = b.st[0], nx = b.st[1];
        if (nloc == 0u) { xcd_barrier_complete(bar, b.x, nloc, nx); b.st[0] = nloc; b.st[1] = nx; }
        const unsigned old = xb_add(&bar[XB_XSUB(b.x)], 1u);
        const unsigned gen = old / nloc;
        if (old + 1u == (gen + 1u) * nloc) {
            __builtin_amdgcn_fence(__ATOMIC_RELEASE, "agent");
            asm volatile("s_waitcnt vmcnt(0)" ::: "memory");
            const unsigned og = xb_add(&bar[XB_TOP], 1u);
            const unsigned tg = og / nx;
            if (og + 1u == (tg + 1u) * nx) xb_add(&bar[XB_TOPGEN], 1u);
            else XB_SPIN(xb_ld(&bar[XB_TOPGEN]) == tg, bar);
            __builtin_amdgcn_fence(__ATOMIC_ACQUIRE, "agent");
            xb_add(&bar[XB_XGEN(b.x)], 1u);
            asm volatile("s_waitcnt vmcnt(0)" ::: "memory");
        } else {
            XB_SPIN(xb_ld(&bar[XB_XGEN(b.x)]) == gen, bar);
            __builtin_amdgcn_fence(__ATOMIC_ACQUIRE, "agent");
            asm volatile("s_waitcnt vmcnt(0)" ::: "memory");
        }
    }
    __syncthreads();
}

__device__ __forceinline__ float wave_sum(float v, int lane) {
#pragma unroll
    for (int o = 1; o < 64; o <<= 1) v += shx(v, o, lane);
    return v;
}
__device__ __forceinline__ void* ldptr(LAS unsigned char* lds, int i) {
    const unsigned long long v = ((const LAS unsigned long long*)(lds + LDSCTL_OFF + 1024))[i];
    const unsigned lo = __builtin_amdgcn_readfirstlane((unsigned)v), hi = __builtin_amdgcn_readfirstlane((unsigned)(v >> 32));
    return (void*)(((unsigned long long)hi << 32) | lo);
}
struct OffsetOrder {
    pg8::StaticOrder S;
    __device__ void init(int M, int N, int G, int c, int off) { S.init(M, N, G, (c + G - off % G) % G); }
    __device__ bool next(int i, pg8::Unit& u) const { return S.next(i, u); }
    __device__ __forceinline__ void a_ready(const pg8::Unit&) const {}
    __device__ __forceinline__ void done(const pg8::Unit&) const {}
};

template <bool PERMQKV>
__device__ __forceinline__ void transpose_item(const float* W, int K, int N, bf16* WT, LAS float* scr, int item, int lane) {
    const int nblk = N / 32, kb = item / nblk, nb = item % nblk, k0 = 64 * kb, n0 = 32 * nb;
    int d0 = n0;
    if (PERMQKV) { const int within = n0 & 255; d0 = (n0 & ~255) + 128 * ((within >> 5) & 1) + 32 * (within >> 6); }
#pragma unroll 8
    for (int i = 0; i < 32; ++i) { const int kk = 2 * i + (lane >> 5); scr[kk * 33 + (lane & 31)] = W[(size_t)(k0 + kk) * N + n0 + (lane & 31)]; }
    LDS_WAIT(); asm volatile("" ::: "memory");
    const int c = lane & 7;
#pragma unroll
    for (int j = 0; j < 4; ++j) { const int n = (lane >> 3) + 8 * j; const LAS float* s = scr + (8 * c) * 33 + n;
        v4u o; o.x = pk2(s[0 * 33], s[1 * 33]); o.y = pk2(s[2 * 33], s[3 * 33]); o.z = pk2(s[4 * 33], s[5 * 33]); o.w = pk2(s[6 * 33], s[7 * 33]);
        *(GAS v4u*)(WT + (size_t)(d0 + n) * K + k0 + 8 * c) = o; }
    LDS_WAIT(); asm volatile("" ::: "memory");
}
__device__ __forceinline__ void convert_bf16(const float* src, bf16* dst, size_t n, size_t gtid, size_t nthreads) {
    for (size_t i = gtid * 8; i < n; i += nthreads * 8) {
        const f32x4 a = *(const GAS f32x4*)(src + i), b = *(const GAS f32x4*)(src + i + 4);
        v4u o; o.x = pk2(a[0], a[1]); o.y = pk2(a[2], a[3]); o.z = pk2(b[0], b[1]); o.w = pk2(b[2], b[3]);
        *(GAS v4u*)(dst + i) = o;
    }
}
__device__ __forceinline__ int t5_bucket(int rel) {
    const int n = rel < 0 ? -rel : rel;
    const int b = n < 8 ? n : n < 12 ? 8 : n < 16 ? 9 : n < 23 ? 10 : n < 32 ? 11 : n < 46 ? 12 : n < 64 ? 13 : n < 91 ? 14 : 15;
    return b + (rel > 0 ? 16 : 0);
}
__constant__ float ROPE_INV[16] = {1.000000000e+00f, 5.623413324e-01f, 3.162277639e-01f, 1.778279394e-01f, 1.000000015e-01f, 5.623413250e-02f, 3.162277490e-02f, 1.778279431e-02f,
                                   9.999999776e-03f, 5.623413250e-03f, 3.162277630e-03f, 1.778279431e-03f, 1.000000047e-03f, 5.623413017e-04f, 3.162277571e-04f, 1.778279402e-04f};

__device__ __forceinline__ void rms_row_to_bf16(const float* xrow, const float* g0, bf16* o0, const float* g1, bf16* o1, int lane) {
    const GAS f32x4* xr = (const GAS f32x4*)xrow + lane;
    f32x4 v[8]; float s = 0.f;
#pragma unroll
    for (int j = 0; j < 8; ++j) { v[j] = xr[64 * j]; s += (v[j].x * v[j].x + v[j].y * v[j].y) + (v[j].z * v[j].z + v[j].w * v[j].w); }
    const float rstd = 1.f / sqrtf(wave_sum(s, lane) * (1.f / DM) + EPS);
    {   const GAS f32x4* gr = (const GAS f32x4*)g0 + lane; GAS v2u* o8 = (GAS v2u*)o0 + lane;
#pragma unroll
        for (int j = 0; j < 8; ++j) { const f32x4 gg = gr[64 * j]; v2u w; w.x = pk2(v[j].x * rstd * gg.x, v[j].y * rstd * gg.y); w.y = pk2(v[j].z * rstd * gg.z, v[j].w * rstd * gg.w); o8[64 * j] = w; } }
    if (g1) { const GAS f32x4* gr = (const GAS f32x4*)g1 + lane; GAS v2u* o8 = (GAS v2u*)o1 + lane;
#pragma unroll
        for (int j = 0; j < 8; ++j) { const f32x4 gg = gr[64 * j]; v2u w; w.x = pk2(v[j].x * rstd * gg.x, v[j].y * rstd * gg.y); w.y = pk2(v[j].z * rstd * gg.z, v[j].w * rstd * gg.w); o8[64 * j] = w; } }
}
__device__ __forceinline__ void norm_rows(const float* X, const float* g, bf16* XN, int gw, int NGW, int lane) {
    for (int m = gw; m < T; m += NGW) rms_row_to_bf16(X + (size_t)m * DM, g, XN + (size_t)m * DM, nullptr, nullptr, lane);
}

template <int TYPE>
__device__ __forceinline__ void naive_attn_item(const bf16* QKV, bf16* ATT, int b, int grow, int head, int lane, const float* biasA, const float* sink, const float* rpb) {
    const int tpos = grow * 64 + lane; const size_t trow = (size_t)b * SEQ + tpos;
    int qcol, kcol, vcol, ocol;
    if (TYPE == 0) { qcol = QA + head * 64; kcol = KA + (head / 3) * 64; vcol = VA + (head / 3) * 64; ocol = OA + head * 64; }
    else if (TYPE == 1) { qcol = QB + head * 64; kcol = KB + head * 64; vcol = VB + head * 64; ocol = OB + head * 64; }
    else { qcol = QC + head * 64; kcol = KC + (head / 3) * 64; vcol = VC + (head / 3) * 64; ocol = OC + head * 64; }
    float q[64], o[64];
#pragma unroll
    for (int c = 0; c < 8; ++c) { const v4u w = *(const GAS v4u*)(QKV + trow * DIN + qcol + 8 * c);
        q[8 * c + 0] = bflo(w.x); q[8 * c + 1] = bfhi(w.x); q[8 * c + 2] = bflo(w.y); q[8 * c + 3] = bfhi(w.y); q[8 * c + 4] = bflo(w.z); q[8 * c + 5] = bfhi(w.z); q[8 * c + 6] = bflo(w.w); q[8 * c + 7] = bfhi(w.w); }
#pragma unroll
    for (int d = 0; d < 64; ++d) o[d] = 0.f;
    float m = -1e30f, l = 0.f;
    int j0, j1;
    if (TYPE == 0) { j0 = grow * 64 - 128; if (j0 < 0) j0 = 0; j1 = grow * 64 + 63 + 128; if (j1 > SEQ - 1) j1 = SEQ - 1; }
    else if (TYPE == 1) { int r0 = grow - 4; r0 = r0 < 0 ? 0 : (r0 > 24 ? 24 : r0); j0 = r0 * 64; j1 = j0 + 511; }
    else { j0 = 0; j1 = SEQ - 1; }
    int c0 = lane - 8; c0 = c0 < 0 ? 0 : (c0 > 48 ? 48 : c0);
#pragma unroll 1
    for (int j = j0; j <= j1; ++j) {
        const bf16* krow = QKV + ((size_t)b * SEQ + j) * DIN;
        float s = 0.f;
#pragma unroll
        for (int c = 0; c < 8; ++c) { const v4u w = *(const GAS v4u*)(krow + kcol + 8 * c);
            s += q[8 * c + 0] * bflo(w.x) + q[8 * c + 1] * bfhi(w.x) + q[8 * c + 2] * bflo(w.y) + q[8 * c + 3] * bfhi(w.y) + q[8 * c + 4] * bflo(w.z) + q[8 * c + 5] * bfhi(w.z) + q[8 * c + 6] * bflo(w.w) + q[8 * c + 7] * bfhi(w.w); }
        bool valid = true;
        if (TYPE == 0) { const int rel = j - tpos; valid = (rel >= -128 && rel <= 128); if (valid) s += biasA[head * 257 + rel + 128]; }
        if (TYPE == 1) { const int kr = j >> 6, kc = j & 63; valid = (kc >= c0 && kc < c0 + 16); if (valid) s += rpb[(head * 15 + (kr - grow + 7)) * 31 + (kc - lane + 15)]; }
        const float mn = valid ? fmaxf(m, s) : m;
        const float a = __expf(m - mn);
        const float p = valid ? __expf(s - mn) : 0.f;
        l = l * a + p; m = mn;
#pragma unroll
        for (int c = 0; c < 8; ++c) { const v4u w = *(const GAS v4u*)(krow + vcol + 8 * c);
            o[8 * c + 0] = o[8 * c + 0] * a + p * bflo(w.x); o[8 * c + 1] = o[8 * c + 1] * a + p * bfhi(w.x); o[8 * c + 2] = o[8 * c + 2] * a + p * bflo(w.y); o[8 * c + 3] = o[8 * c + 3] * a + p * bfhi(w.y);
            o[8 * c + 4] = o[8 * c + 4] * a + p * bflo(w.z); o[8 * c + 5] = o[8 * c + 5] * a + p * bfhi(w.z); o[8 * c + 6] = o[8 * c + 6] * a + p * bflo(w.w); o[8 * c + 7] = o[8 * c + 7] * a + p * bfhi(w.w); }
    }
    if (TYPE == 0) l += __expf(sink[head] - m);
    const float inv = 1.f / l;
#pragma unroll
    for (int c = 0; c < 8; ++c) { v4u w; w.x = pk2(o[8 * c + 0] * inv, o[8 * c + 1] * inv); w.y = pk2(o[8 * c + 2] * inv, o[8 * c + 3] * inv); w.z = pk2(o[8 * c + 4] * inv, o[8 * c + 5] * inv); w.w = pk2(o[8 * c + 6] * inv, o[8 * c + 7] * inv);
        *(GAS v4u*)(ATT + trow * DM + ocol + 8 * c) = w; }
}
__device__ __forceinline__ float rdl(float v, int l) { return __builtin_bit_cast(float, __builtin_amdgcn_readlane(__builtin_bit_cast(int, v), l)); }
__device__ __forceinline__ void naive_mem_item(const bf16* QM, const bf16* KVM, bf16* OM, const float* gq, size_t trow, int b, int head, int lane) {
    const unsigned qw = *(const GAS unsigned*)(QM + trow * MEMW + head * 128 + 2 * lane);
    float q0 = bflo(qw), q1 = bfhi(qw);
    const float ss = wave_sum(q0 * q0 + q1 * q1, lane);
    const float r = 0.08838834764831845f / sqrtf(ss * (1.f / 128.f) + EPS);
    q0 *= r * gq[2 * lane]; q1 *= r * gq[2 * lane + 1];
    const bf16* kbase = KVM + ((size_t)b * NMEM + lane) * 1024 + head * 128;
    float s[4] = {0.f, 0.f, 0.f, 0.f};
#pragma unroll 1
    for (int c = 0; c < 16; ++c) {
        float qa[8];
#pragma unroll
        for (int e = 0; e < 4; ++e) { qa[2 * e] = rdl(q0, 4 * c + e); qa[2 * e + 1] = rdl(q1, 4 * c + e); }
#pragma unroll
        for (int i = 0; i < 4; ++i) { const v4u w = *(const GAS v4u*)(kbase + (size_t)i * 64 * 1024 + 8 * c);
            s[i] += qa[0] * bflo(w.x) + qa[1] * bfhi(w.x) + qa[2] * bflo(w.y) + qa[3] * bfhi(w.y) + qa[4] * bflo(w.z) + qa[5] * bfhi(w.z) + qa[6] * bflo(w.w) + qa[7] * bfhi(w.w); }
    }
    float m = fmaxf(fmaxf(s[0], s[1]), fmaxf(s[2], s[3]));
#pragma unroll
    for (int o = 1; o < 64; o <<= 1) m = fmaxf(m, shx(m, o, lane));
    float p[4]; float l = 0.f;
#pragma unroll
    for (int i = 0; i < 4; ++i) { p[i] = __expf(s[i] - m); l += p[i]; }
    l = wave_sum(l, lane);
    const bf16* vbase = KVM + ((size_t)b * NMEM) * 1024 + 512 + head * 128 + 2 * lane;
    float o0 = 0.f, o1 = 0.f;
#pragma unroll
    for (int i = 0; i < 4; ++i) {
#pragma unroll 4
        for (int jj = 0; jj < 64; ++jj) { const float pj = rdl(p[i], jj); const unsigned w = *(const GAS unsigned*)(vbase + (size_t)(64 * i + jj) * 1024); o0 += pj * bflo(w); o1 += pj * bfhi(w); }
    }
    const float inv = 1.f / l;
    *(GAS unsigned*)(OM + trow * MEMW + head * 128 + 2 * lane) = pk2(o0 * inv, o1 * inv);
}
__device__ __forceinline__ void mixnorm_rows(bf16* ATT, const float* g, int gw, int NGW, int lane) {
    for (int m = gw; m < T; m += NGW) {
        GAS v4u* p = (GAS v4u*)(ATT + (size_t)m * DM + 32 * lane);
        v4u w[4]; float f[32]; float ss = 0.f;
#pragma unroll
        for (int c = 0; c < 4; ++c) { w[c] = p[c];
            f[8 * c + 0] = bflo(w[c].x); f[8 * c + 1] = bfhi(w[c].x); f[8 * c + 2] = bflo(w[c].y); f[8 * c + 3] = bfhi(w[c].y); f[8 * c + 4] = bflo(w[c].z); f[8 * c + 5] = bfhi(w[c].z); f[8 * c + 6] = bflo(w[c].w); f[8 * c + 7] = bfhi(w[c].w); }
#pragma unroll
        for (int i = 0; i < 32; ++i) ss += f[i] * f[i];
        const int grp = lane < 24 ? 0 : (lane < 40 ? 1 : 2);
        const float sa = wave_sum(grp == 0 ? ss : 0.f, lane), sb = wave_sum(grp == 1 ? ss : 0.f, lane), sc = wave_sum(grp == 2 ? ss : 0.f, lane);
        const float r = grp == 0 ? 1.f / sqrtf(sa * (1.f / 768.f) + EPS) : (grp == 1 ? 1.f / sqrtf(sb * (1.f / 512.f) + EPS) : 1.f / sqrtf(sc * (1.f / 768.f) + EPS));
        const float* gg = g + 32 * lane;
#pragma unroll
        for (int c = 0; c < 4; ++c) { const f32x4 g0 = *(const GAS f32x4*)(gg + 8 * c), g1 = *(const GAS f32x4*)(gg + 8 * c + 4);
            v4u o; o.x = pk2(f[8 * c + 0] * r * g0[0], f[8 * c + 1] * r * g0[1]); o.y = pk2(f[8 * c + 2] * r * g0[2], f[8 * c + 3] * r * g0[3]);
            o.z = pk2(f[8 * c + 4] * r * g1[0], f[8 * c + 5] * r * g1[1]); o.w = pk2(f[8 * c + 6] * r * g1[2], f[8 * c + 7] * r * g1[3]); p[c] = o; }
    }
}

#ifndef PEER_HD
#define PEER_HD __device__ __forceinline__
#define PEER_EXP(x) __expf(x)
#endif
template <int N> PEER_HD void bitonic_sort_desc(float* v) {
#pragma unroll
    for (int k = 2; k <= N; k <<= 1)
#pragma unroll
        for (int j = k >> 1; j > 0; j >>= 1)
#pragma unroll
            for (int i = 0; i < N; ++i) { const int l = i ^ j; if (l > i) { const bool desc = ((i & k) == 0); const float a = v[i], b = v[l]; const float hi = fmaxf(a, b), lo = fminf(a, b);
                v[i] = desc ? hi : lo; v[l] = desc ? lo : hi; } }
}
PEER_HD void merge_top16(float* a, const float* b) {
    float c[16];
#pragma unroll
    for (int i = 0; i < 16; ++i) c[i] = fmaxf(a[i], b[15 - i]);
#pragma unroll
    for (int j = 8; j > 0; j >>= 1)
#pragma unroll
        for (int i = 0; i < 16; ++i) { const int l = i ^ j; if (l > i) { const float x = c[i], y = c[l]; c[i] = fmaxf(x, y); c[l] = fminf(x, y); } }
#pragma unroll
    for (int i = 0; i < 16; ++i) a[i] = c[i];
}
PEER_HD void top16_of_64(float (&v)[64]) {
    bitonic_sort_desc<16>(&v[0]); bitonic_sort_desc<16>(&v[16]); bitonic_sort_desc<16>(&v[32]); bitonic_sort_desc<16>(&v[48]);
    merge_top16(&v[0], &v[16]); merge_top16(&v[32], &v[48]); merge_top16(&v[0], &v[32]);
}
PEER_HD float pack_idx(float s, unsigned idx, unsigned mask) { return __builtin_bit_cast(float, (__builtin_bit_cast(unsigned, s) & ~mask) | idx); }
PEER_HD unsigned low_bits(float s, unsigned mask) { return __builtin_bit_cast(unsigned, s) & mask; }
PEER_HD unsigned pick16(const float* a, unsigned i, unsigned mask) {
    unsigned r = 0;
#pragma unroll
    for (unsigned k = 0; k < 16; ++k) r = (i == k) ? low_bits(a[k], mask) : r;
    return r;
}
PEER_HD void peer_candidates(const float* a, const float* b, int* e, float* gate) {
    float c[64]; int n = 0;
#pragma unroll
    for (int i = 0; i < 16; ++i)
#pragma unroll
        for (int j = 0; j < 16; ++j) if ((i + 1) * (j + 1) <= 16) { c[n] = pack_idx(a[i] + b[j], (unsigned)(i * 16 + j), 0xffu); ++n; }
#pragma unroll
    for (int k = 50; k < 64; ++k) c[k] = -3.0e38f;
    top16_of_64(c);
    float mx = c[0], den = 0.f;
#pragma unroll
    for (int k = 0; k < 16; ++k) { const unsigned id = low_bits(c[k], 0xffu); const unsigned n0 = pick16(a, id >> 4, 0x7fu), n1 = pick16(b, id & 15u, 0x7fu);
        e[k] = (int)(n0 * 128u + n1); gate[k] = PEER_EXP(c[k] - mx); den += gate[k]; }
    const float inv = 1.f / den;
#pragma unroll
    for (int k = 0; k < 16; ++k) gate[k] *= inv;
}

__device__ __forceinline__ void peer_select_unit(const bf16* QP, const bf16* PK, int* PIDX, float* PGATE, int tb, int h, int wave, int lane) {
    const int hh = lane >> 5, tl = lane & 31; const size_t t = (size_t)tb * 256 + wave * 32 + tl;
    float ab[2][16];
#pragma unroll
    for (int p = 0; p < 2; ++p) {
        bf16x8 bq[8];
#pragma unroll
        for (int s = 0; s < 8; ++s) bq[s] = *(const GAS bf16x8*)(QP + t * DM + 256 * h + 128 * p + 16 * s + 8 * hh);
        float v[64];
#pragma unroll
        for (int nb = 0; nb < 4; ++nb) {
            f32x16 acc;
#pragma unroll
            for (int r = 0; r < 16; ++r) acc[r] = 0.f;
            const bf16* kp = PK + ((size_t)((h * 2 + p) * 128 + 32 * nb + tl)) * 128 + 8 * hh;
#pragma unroll
            for (int s = 0; s < 8; ++s) { const bf16x8 ak = *(const GAS bf16x8*)(kp + 16 * s); acc = __builtin_amdgcn_mfma_f32_32x32x16_bf16(ak, bq[s], acc, 0, 0, 0); }
#pragma unroll
            for (int r = 0; r < 16; ++r) v[16 * nb + r] = pack_idx(acc[r], (unsigned)(32 * nb + 8 * (r >> 2) + 4 * hh + (r & 3)), 0x7fu);
        }
        top16_of_64(v);
        float pv[16];
#pragma unroll
        for (int i = 0; i < 16; ++i) pv[i] = shx(v[i], 32, lane);
        merge_top16(&v[0], pv);
#pragma unroll
        for (int i = 0; i < 16; ++i) ab[p][i] = v[i];
    }
    int e[16]; float gate[16];
    peer_candidates(ab[0], ab[1], e, gate);
    if (hh == 0) { GAS v4u* o = (GAS v4u*)(PIDX + t * 128 + h * 16);
#pragma unroll
        for (int c = 0; c < 4; ++c) o[c] = (v4u){(unsigned)e[4 * c], (unsigned)e[4 * c + 1], (unsigned)e[4 * c + 2], (unsigned)e[4 * c + 3]}; }
    else { GAS f32x4* o = (GAS f32x4*)(PGATE + t * 128 + h * 16);
#pragma unroll
        for (int c = 0; c < 4; ++c) o[c] = (f32x4){gate[4 * c], gate[4 * c + 1], gate[4 * c + 2], gate[4 * c + 3]}; }
}

__device__ __forceinline__ float dot8(const v4u& x, const v4u& u) {
    return bflo(x.x) * bflo(u.x) + bfhi(x.x) * bfhi(u.x) + bflo(x.y) * bflo(u.y) + bfhi(x.y) * bfhi(u.y) + bflo(x.z) * bflo(u.z) + bfhi(x.z) * bfhi(u.z) + bflo(x.w) * bflo(u.w) + bfhi(x.w) * bfhi(u.w);
}
__device__ __forceinline__ void axpy8(float* y, float w, const v4u& v) {
    y[0] += w * bflo(v.x); y[1] += w * bfhi(v.x); y[2] += w * bflo(v.y); y[3] += w * bfhi(v.y); y[4] += w * bflo(v.z); y[5] += w * bfhi(v.z); y[6] += w * bflo(v.w); y[7] += w * bfhi(v.w);
}
__device__ __forceinline__ void peer_gather(const bf16* XN, const bf16* PU, const bf16* PV, const int* PIDX, const float* PGATE, float* X, int gw, int NGW, int lane) {
    for (int t = gw; t < T; t += NGW) {
        v4u xv[4];
#pragma unroll
        for (int j = 0; j < 4; ++j) xv[j] = *(const GAS v4u*)(XN + (size_t)t * DM + 8 * lane + 512 * j);
        float y[32];
#pragma unroll
        for (int i = 0; i < 32; ++i) y[i] = 0.f;
        for (int k = 0; k < 128; k += 2) {
            const int e0 = __builtin_amdgcn_readfirstlane(PIDX[(size_t)t * 128 + k]), e1 = __builtin_amdgcn_readfirstlane(PIDX[(size_t)t * 128 + k + 1]);
            const float g0 = PGATE[(size_t)t * 128 + k], g1 = PGATE[(size_t)t * 128 + k + 1];
            v4u u0[4], u1[4], v0[4], v1[4];
#pragma unroll
            for (int j = 0; j < 4; ++j) { u0[j] = *(const GAS v4u*)(PU + (size_t)e0 * DM + 8 * lane + 512 * j); u1[j] = *(const GAS v4u*)(PU + (size_t)e1 * DM + 8 * lane + 512 * j); }
#pragma unroll
            for (int j = 0; j < 4; ++j) { v0[j] = *(const GAS v4u*)(PV + (size_t)e0 * DM + 8 * lane + 512 * j); v1[j] = *(const GAS v4u*)(PV + (size_t)e1 * DM + 8 * lane + 512 * j); }
            float d0 = 0.f, d1 = 0.f;
#pragma unroll
            for (int j = 0; j < 4; ++j) { d0 += dot8(xv[j], u0[j]); d1 += dot8(xv[j], u1[j]); }
            d0 = wave_sum(d0, lane); d1 = wave_sum(d1, lane);
            const float w0 = g0 * 0.5f * d0 * (1.f + erff(d0 * 0.70710678118654752f)), w1 = g1 * 0.5f * d1 * (1.f + erff(d1 * 0.70710678118654752f));
#pragma unroll
            for (int j = 0; j < 4; ++j) { axpy8(&y[8 * j], w0, v0[j]); axpy8(&y[8 * j], w1, v1[j]); }
        }
#pragma unroll
        for (int j = 0; j < 4; ++j) { GAS f32x4* xp = (GAS f32x4*)(X + (size_t)t * DM + 8 * lane + 512 * j);
            f32x4 a = xp[0], b = xp[1]; a += (f32x4){y[8 * j], y[8 * j + 1], y[8 * j + 2], y[8 * j + 3]}; b += (f32x4){y[8 * j + 4], y[8 * j + 5], y[8 * j + 6], y[8 * j + 7]}; xp[0] = a; xp[1] = b; }
    }
}


typedef float f32x2 __attribute__((ext_vector_type(2)));
constexpr float PU_SCALE = 256.f, PV_SCALE = 16.f;
__device__ __forceinline__ void convert_fp8(const float* src, unsigned char* dst, size_t n, float scale, size_t gtid, size_t nthreads) {
    for (size_t i = gtid * 16; i < n; i += nthreads * 16) {
        v4u o;
#pragma unroll
        for (int c = 0; c < 4; ++c) { f32x4 a = *(const GAS f32x4*)(src + i + 4 * c) * scale;
#pragma unroll
            for (int e = 0; e < 4; ++e) a[e] = fminf(fmaxf(a[e], -448.f), 448.f);
            int p = 0; p = __builtin_amdgcn_cvt_pk_fp8_f32(a[0], a[1], p, false); p = __builtin_amdgcn_cvt_pk_fp8_f32(a[2], a[3], p, true); o[c] = (unsigned)p; }
        *(GAS v4u*)(dst + i) = o;
    }
}
__device__ __forceinline__ void dot16_fp8(f32x2& acc, const v4u& w, const f32x2* x) {
#pragma unroll
    for (int c = 0; c < 4; ++c) { acc += __builtin_amdgcn_cvt_pk_f32_fp8((int)w[c], false) * x[2 * c]; acc += __builtin_amdgcn_cvt_pk_f32_fp8((int)w[c], true) * x[2 * c + 1]; }
}
__device__ __forceinline__ void axpy16_fp8(f32x2* y, const f32x2 wv, const v4u& w) {
#pragma unroll
    for (int c = 0; c < 4; ++c) { y[2 * c] += __builtin_amdgcn_cvt_pk_f32_fp8((int)w[c], false) * wv; y[2 * c + 1] += __builtin_amdgcn_cvt_pk_f32_fp8((int)w[c], true) * wv; }
}
#define PG_R 4
#define PG_LOAD(buf, tab, idlo, idhi, g) do { _Pragma("unroll") for (int i_ = 0; i_ < PG_R; ++i_) { const int k_ = (g) * PG_R + i_; \
        const int e_ = __builtin_amdgcn_readlane(k_ < 64 ? idlo : idhi, k_ & 63); const unsigned char* rp_ = (tab) + (size_t)(unsigned)e_ * 2048u; \
        buf[i_][0] = *(const GAS v4u*)(rp_ + voff); buf[i_][1] = *(const GAS v4u*)(rp_ + voff + 1024); } } while (0)
#define PG_DOT(buf, g) do { float p_[4]; _Pragma("unroll") for (int i_ = 0; i_ < 4; ++i_) { f32x2 a_ = {0.f, 0.f}; dot16_fp8(a_, buf[i_][0], &x[0]); dot16_fp8(a_, buf[i_][1], &x[8]); p_[i_] = a_.x + a_.y; __builtin_amdgcn_sched_barrier(0); } \
        float r_[2]; _Pragma("unroll") for (int i_ = 0; i_ < 2; ++i_) { const float keep_ = b5 ? p_[i_ + 2] : p_[i_], send_ = b5 ? p_[i_] : p_[i_ + 2]; r_[i_] = keep_ + shx(send_, 32, lane); } \
        float s_; { const float keep_ = b4 ? r_[1] : r_[0], send_ = b4 ? r_[0] : r_[1]; s_ = keep_ + shx(send_, 16, lane); } \
        s_ += shx(s_, 8, lane); s_ += shx(s_, 4, lane); s_ += shx(s_, 2, lane); s_ += shx(s_, 1, lane); \
        if ((lane & 15) == 0) wl[(g) * 4 + (lane >> 4)] = s_; } while (0)
#define PG_AXPY(buf, g) do { _Pragma("unroll") for (int i_ = 0; i_ < PG_R; ++i_) { const float w_ = wl[(g) * PG_R + i_]; const f32x2 wv_ = {w_, w_}; axpy16_fp8(&y[0], wv_, buf[i_][0]); axpy16_fp8(&y[8], wv_, buf[i_][1]); __builtin_amdgcn_sched_barrier(0); } } while (0)
__device__ __forceinline__ void peer_gather8(const bf16* XN, const unsigned char* PU8, const unsigned char* PV8, const int* PIDX, const float* PGATE, float* X, LAS float* wl, int gw, int NGW, int lane) {
    const bool b5 = (lane >> 5) & 1, b4 = (lane >> 4) & 1; const unsigned voff = 16u * (unsigned)lane;
    for (int t = gw; t < T; t += NGW) {
        const unsigned l4 = 4u * (unsigned)lane; const char* pidx_t = (const char*)(PIDX + (size_t)t * 128); const char* pgate_t = (const char*)(PGATE + (size_t)t * 128);
        const int idlo = *(const GAS int*)(pidx_t + l4), idhi = *(const GAS int*)(pidx_t + l4 + 256);
        v4u A[PG_R][2], B[PG_R][2];
        PG_LOAD(A, PU8, idlo, idhi, 0);
        f32x2 x[16];
        {   const char* xr = (const char*)(XN + (size_t)t * DM); const unsigned l32 = 32u * (unsigned)lane;
            const v4u a0 = *(const GAS v4u*)(xr + l32), a1 = *(const GAS v4u*)(xr + l32 + 16), c0 = *(const GAS v4u*)(xr + l32 + 2048), c1 = *(const GAS v4u*)(xr + l32 + 2064);
#pragma unroll
            for (int c = 0; c < 4; ++c) { x[c] = (f32x2){bflo(a0[c]), bfhi(a0[c])} * (1.f / PU_SCALE); x[4 + c] = (f32x2){bflo(a1[c]), bfhi(a1[c])} * (1.f / PU_SCALE);
                                          x[8 + c] = (f32x2){bflo(c0[c]), bfhi(c0[c])} * (1.f / PU_SCALE); x[12 + c] = (f32x2){bflo(c1[c]), bfhi(c1[c])} * (1.f / PU_SCALE); } }
#pragma unroll 1
        for (int g = 0; g < 128 / PG_R; g += 2) {
            PG_LOAD(B, PU8, idlo, idhi, g + 1);
            PG_DOT(A, g);
            if (g + 2 < 128 / PG_R) PG_LOAD(A, PU8, idlo, idhi, g + 2); else PG_LOAD(A, PV8, idlo, idhi, 0);
            PG_DOT(B, g + 1);
        }
        LDS_WAIT();
        {
            const float g0 = *(const GAS float*)(pgate_t + l4), g1 = *(const GAS float*)(pgate_t + l4 + 256);
            const float d0 = wl[lane], d1 = wl[64 + lane];
            const float w0 = g0 * 0.5f * d0 * (1.f + erff(d0 * 0.70710678118654752f)) * (1.f / PV_SCALE), w1 = g1 * 0.5f * d1 * (1.f + erff(d1 * 0.70710678118654752f)) * (1.f / PV_SCALE);
            LDS_WAIT(); asm volatile("" ::: "memory");
            wl[lane] = w0; wl[64 + lane] = w1;
            LDS_WAIT(); asm volatile("" ::: "memory");
        }
        f32x2 y[16];
#pragma unroll
        for (int i = 0; i < 16; ++i) y[i] = (f32x2){0.f, 0.f};
#pragma unroll 1
        for (int g = 0; g < 128 / PG_R; g += 2) {
            PG_LOAD(B, PV8, idlo, idhi, g + 1);
            PG_AXPY(A, g);
            if (g + 2 < 128 / PG_R) PG_LOAD(A, PV8, idlo, idhi, g + 2);
            PG_AXPY(B, g + 1);
        }
        {   char* xo = (char*)(X + (size_t)t * DM); const unsigned l64 = 64u * (unsigned)lane;
#pragma unroll
            for (int h = 0; h < 2; ++h)
#pragma unroll
                for (int c = 0; c < 4; ++c) { GAS f32x4* p = (GAS f32x4*)(xo + l64 + 4096 * h + 16 * c); f32x4 v = *p; v += (f32x4){y[8 * h + 2 * c].x, y[8 * h + 2 * c].y, y[8 * h + 2 * c + 1].x, y[8 * h + 2 * c + 1].y}; *p = v; } }
        LDS_WAIT(); asm volatile("" ::: "memory");
    }
}


typedef short s16x4 __attribute__((ext_vector_type(4)));
typedef __attribute__((address_space(3))) const char* lds_cptr;
__device__ __forceinline__ s16x4 vtr(lds_cptr p) { return __builtin_bit_cast(s16x4, __builtin_amdgcn_ds_read_tr16_b64_v4i16((__attribute__((address_space(3))) s16x4*)p)); }
__device__ __forceinline__ unsigned cvtpk(float lo, float hi) { unsigned r; asm("v_cvt_pk_bf16_f32 %0, %1, %2" : "=v"(r) : "v"(lo), "v"(hi)); return r; }
constexpr int AT_K0 = 0, AT_V0 = 16384, AT_TAB = 32768;
constexpr float LOG2E = 1.4426950408889634f;
template <int TYPE>
__device__ __forceinline__ void attn_unit(LAS unsigned char* lds, const bf16* QKV, bf16* ATT, int b, int head, int qb, const float* tabsrc, float Cl2, float sinkl2, int tid) {
    const int lane = tid & 63, w = __builtin_amdgcn_readfirstlane(tid >> 6), hh = lane >> 5, l31 = lane & 31;
    int qcol, kcol, vcol, ocol;
    if (TYPE == 0) { qcol = QA + head * 64; kcol = KA + (head / 3) * 64; vcol = VA + (head / 3) * 64; ocol = OA + head * 64; }
    else if (TYPE == 1) { qcol = QB + head * 64; kcol = KB + head * 64; vcol = VB + head * 64; ocol = OB + head * 64; }
    else { qcol = QC + head * 64; kcol = KC + (head / 3) * 64; vcol = VC + (head / 3) * 64; ocol = OC + head * 64; }
    const int q0 = 256 * qb + 32 * w, qpos = q0 + l31;
    int t_begin, t_end;
    if (TYPE == 0) { t_begin = 4 * qb - 2; if (t_begin < 0) t_begin = 0; t_end = 4 * qb + 6; if (t_end > 32) t_end = 32; }
    else if (TYPE == 1) { int a = 4 * qb - 4; a = a < 0 ? 0 : (a > 24 ? 24 : a); int e = 4 * qb - 1; e = e < 0 ? 0 : (e > 24 ? 24 : e); t_begin = a; t_end = e + 8; }
    else { t_begin = 0; t_end = 32; }
    LAS float* tab = (LAS float*)(lds + AT_TAB);
    if (TYPE == 0) { for (int i = tid; i < 1024; i += NTHREADS) { const int rel = i - 448; tab[i] = (rel >= -128 && rel <= 128) ? tabsrc[head * 257 + rel + 128] * LOG2E - Cl2 : -1e30f; } }
    if (TYPE == 1) { for (int i = tid; i < 15 * 31; i += NTHREADS) tab[i] = tabsrc[head * 465 + i] * LOG2E - Cl2; }
    bf16x8 qf[4];
    {   const bf16* qp = QKV + ((size_t)b * SEQ + qpos) * DIN + qcol + 8 * hh;
#pragma unroll
        for (int s = 0; s < 4; ++s) qf[s] = *(const GAS bf16x8*)(qp + 16 * s); }
    const int srow = tid >> 3, sch = tid & 7;
    const bf16* kg = QKV + ((size_t)b * SEQ + srow) * DIN + kcol + sch * 8;
    const bf16* vg = QKV + ((size_t)b * SEQ + srow) * DIN + vcol + sch * 8;
    const int kst = srow * 128 + ((sch ^ ((srow >> 1) & 7)) * 16);
    const int vst = srow * 128 + (((sch >> 2) ^ ((srow >> 1) & 1)) * 64) + (sch & 3) * 16;
    int kread[4], vread[2];
#pragma unroll
    for (int s = 0; s < 4; ++s) kread[s] = l31 * 128 + (((2 * s + hh) ^ ((lane >> 1) & 7)) * 16);
#pragma unroll
    for (int db = 0; db < 2; ++db) vread[db] = (4 * hh + ((lane >> 2) & 3)) * 128 + ((db ^ ((lane >> 3) & 1)) * 64) + 32 * ((lane >> 4) & 1) + 8 * (lane & 3);
    f32x16 O0, O1;
#pragma unroll
    for (int r = 0; r < 16; ++r) { O0[r] = 0.f; O1[r] = 0.f; }
    float lsum = 0.f;
    const int rw = 4 * qb + (w >> 1), cq = 32 * (w & 1) + l31;
    int r0w = rw - 4; r0w = r0w < 0 ? 0 : (r0w > 24 ? 24 : r0w);
    int c0 = cq - 8; c0 = c0 < 0 ? 0 : (c0 > 48 ? 48 : c0);
    {   const v4u kr = *(const GAS v4u*)(kg + (size_t)t_begin * 64 * DIN), vr = *(const GAS v4u*)(vg + (size_t)t_begin * 64 * DIN);
        *(LAS v4u*)(lds + AT_K0 + kst) = kr; *(LAS v4u*)(lds + AT_V0 + vst) = vr; }
    __syncthreads();
    for (int t = t_begin; t < t_end; ++t) {
        const int cur = (t - t_begin) & 1;
        v4u kr, vr;
        if (t + 1 < t_end) { kr = *(const GAS v4u*)(kg + (size_t)(t + 1) * 64 * DIN); vr = *(const GAS v4u*)(vg + (size_t)(t + 1) * 64 * DIN); }
        bool need = true;
        if (TYPE == 0) need = (64 * t <= q0 + 31 + 128) && (64 * t + 63 >= q0 - 128);
        if (TYPE == 1) need = (t >= r0w) && (t < r0w + 8);
        if (need) {
            const lds_cptr kb_ = (lds_cptr)(lds + AT_K0 + cur * 8192), vb_ = (lds_cptr)(lds + AT_V0 + cur * 8192);
            f32x16 S0, S1;
#pragma unroll
            for (int r = 0; r < 16; ++r) { S0[r] = 0.f; S1[r] = 0.f; }
#pragma unroll
            for (int s = 0; s < 4; ++s) { const bf16x8 k0 = *(const LAS bf16x8*)(kb_ + kread[s]), k1 = *(const LAS bf16x8*)(kb_ + kread[s] + 4096);
                S0 = __builtin_amdgcn_mfma_f32_32x32x16_bf16(k0, qf[s], S0, 0, 0, 0); S1 = __builtin_amdgcn_mfma_f32_32x32x16_bf16(k1, qf[s], S1, 0, 0, 0); }
            if (TYPE == 2) {
#pragma unroll
                for (int r = 0; r < 16; ++r) { S0[r] = __builtin_amdgcn_exp2f(S0[r] * LOG2E - Cl2); S1[r] = __builtin_amdgcn_exp2f(S1[r] * LOG2E - Cl2); }
            } else if (TYPE == 0) {
                const LAS float* tb = tab + (64 * t - qpos + 448 + 4 * hh);
#pragma unroll
                for (int r = 0; r < 16; ++r) { S0[r] = __builtin_amdgcn_exp2f(S0[r] * LOG2E + tb[8 * (r >> 2) + (r & 3)]); S1[r] = __builtin_amdgcn_exp2f(S1[r] * LOG2E + tb[32 + 8 * (r >> 2) + (r & 3)]); }
            } else {
                const LAS float* tb = tab + ((t - rw + 7) * 31 - cq + 15 + 4 * hh);
                const int kc0 = 4 * hh - c0;
#pragma unroll
                for (int r = 0; r < 16; ++r) { const int ka = 8 * (r >> 2) + (r & 3), kb2 = 32 + ka;
                    const float p0 = __builtin_amdgcn_exp2f(S0[r] * LOG2E + tb[ka]), p1 = __builtin_amdgcn_exp2f(S1[r] * LOG2E + tb[kb2]);
                    S0[r] = ((unsigned)(ka + kc0) < 16u) ? p0 : 0.f; S1[r] = ((unsigned)(kb2 + kc0) < 16u) ? p1 : 0.f; }
            }
#pragma unroll
            for (int r = 0; r < 16; ++r) lsum += S0[r] + S1[r];
            bf16x8 pb[4];
#pragma unroll
            for (int hf = 0; hf < 2; ++hf) {
                v4u a, c;
#pragma unroll
                for (int j = 0; j < 4; ++j) { a[j] = cvtpk(S0[8 * hf + 2 * j], S0[8 * hf + 2 * j + 1]); c[j] = cvtpk(S1[8 * hf + 2 * j], S1[8 * hf + 2 * j + 1]); }
                pb[hf] = __builtin_bit_cast(bf16x8, a); pb[2 + hf] = __builtin_bit_cast(bf16x8, c);
            }
#pragma unroll
            for (int ks = 0; ks < 4; ++ks) {
                const s16x4 a0 = vtr(vb_ + vread[0] + (16 * ks) * 128), a1 = vtr(vb_ + vread[0] + (16 * ks + 8) * 128);
                const s16x4 b0 = vtr(vb_ + vread[1] + (16 * ks) * 128), b1 = vtr(vb_ + vread[1] + (16 * ks + 8) * 128);
                const bf16x8 va = __builtin_shufflevector(a0, a1, 0, 1, 2, 3, 4, 5, 6, 7), vb2 = __builtin_shufflevector(b0, b1, 0, 1, 2, 3, 4, 5, 6, 7);
                O0 = __builtin_amdgcn_mfma_f32_32x32x16_bf16(va, pb[ks], O0, 0, 0, 0); O1 = __builtin_amdgcn_mfma_f32_32x32x16_bf16(vb2, pb[ks], O1, 0, 0, 0);
            }
        }
        if (t + 1 < t_end) { *(LAS v4u*)(lds + AT_K0 + (cur ^ 1) * 8192 + kst) = kr; *(LAS v4u*)(lds + AT_V0 + (cur ^ 1) * 8192 + vst) = vr; }
        __syncthreads();
    }
    lsum += shx(lsum, 32, lane);
    if (TYPE == 0) lsum += __builtin_amdgcn_exp2f(sinkl2 - Cl2);
    const float inv = 1.f / lsum;
    bf16* op = ATT + ((size_t)b * SEQ + qpos) * DM + ocol + 4 * hh;
#pragma unroll
    for (int g4 = 0; g4 < 4; ++g4) {
        v2u o0, o1; o0.x = cvtpk(O0[4 * g4] * inv, O0[4 * g4 + 1] * inv); o0.y = cvtpk(O0[4 * g4 + 2] * inv, O0[4 * g4 + 3] * inv);
        o1.x = cvtpk(O1[4 * g4] * inv, O1[4 * g4 + 1] * inv); o1.y = cvtpk(O1[4 * g4 + 2] * inv, O1[4 * g4 + 3] * inv);
        *(GAS v2u*)(op + 8 * g4) = o0; *(GAS v2u*)(op + 32 + 8 * g4) = o1;
    }
}


constexpr int MA_K0 = 0, MA_V0 = 32768;
__device__ __forceinline__ void mem_unit(LAS unsigned char* lds, const bf16* QM, const bf16* KVM, bf16* OM, const float* gq, int tb, int head, float Cl2, int tid) {
    const int lane = tid & 63, w = __builtin_amdgcn_readfirstlane(tid >> 6), hh = lane >> 5, l31 = lane & 31;
    const size_t trow = (size_t)tb * 256 + 32 * w + l31; const int b = tb >> 3;
    bf16x8 qf[8];
    {   const bf16* qp = QM + trow * MEMW + head * 128 + 8 * hh;
#pragma unroll
        for (int s = 0; s < 8; ++s) qf[s] = *(const GAS bf16x8*)(qp + 16 * s);
        float ss = 0.f;
#pragma unroll
        for (int s = 0; s < 8; ++s)
#pragma unroll
            for (int j = 0; j < 8; ++j) { const float f = __builtin_bit_cast(float, (unsigned)(unsigned short)qf[s][j] << 16); ss += f * f; }
        ss += shx(ss, 32, lane);
        const float r = 0.08838834764831845f / sqrtf(ss * (1.f / 128.f) + EPS);
#pragma unroll
        for (int s = 0; s < 8; ++s) { const f32x4 g0 = *(const GAS f32x4*)(gq + 16 * s + 8 * hh), g1 = *(const GAS f32x4*)(gq + 16 * s + 8 * hh + 4);
            v4u o;
#pragma unroll
            for (int j = 0; j < 4; ++j) { const float f0 = __builtin_bit_cast(float, (unsigned)(unsigned short)qf[s][2 * j] << 16), f1 = __builtin_bit_cast(float, (unsigned)(unsigned short)qf[s][2 * j + 1] << 16);
                const float ga = (2 * j < 4) ? g0[2 * j] : g1[2 * j - 4], gb2 = (2 * j + 1 < 4) ? g0[2 * j + 1] : g1[2 * j + 1 - 4];
                o[j] = cvtpk(f0 * r * ga, f1 * r * gb2); }
            qf[s] = __builtin_bit_cast(bf16x8, o); }
    }
    const int srow = tid >> 3, sch = tid & 7;
    const bf16* kg = KVM + ((size_t)b * NMEM + srow) * 1024 + head * 128 + sch * 8;
    const bf16* vg = kg + 512;
    const int kst0 = srow * 256 + ((sch ^ (srow & 15)) * 16), kst1 = srow * 256 + (((sch + 8) ^ (srow & 15)) * 16);
    const int vst0 = srow * 256 + ((((sch) >> 2) ^ (srow & 3)) * 64) + (sch & 3) * 16, vst1 = srow * 256 + ((((sch + 8) >> 2) ^ (srow & 3)) * 64) + (sch & 3) * 16;
    int kread[8], vread[4];
#pragma unroll
    for (int s = 0; s < 8; ++s) kread[s] = l31 * 256 + (((2 * s + hh) ^ (l31 & 15)) * 16);
#pragma unroll
    for (int db = 0; db < 4; ++db) vread[db] = (4 * hh + ((lane >> 2) & 3)) * 256 + ((db ^ ((lane >> 2) & 3)) * 64) + 32 * ((lane >> 4) & 1) + 8 * (lane & 3);
    f32x16 O[4];
#pragma unroll
    for (int db = 0; db < 4; ++db)
#pragma unroll
        for (int r = 0; r < 16; ++r) O[db][r] = 0.f;
    float lsum = 0.f;
    {   const v4u k0 = *(const GAS v4u*)kg, k1 = *(const GAS v4u*)(kg + 64), v0 = *(const GAS v4u*)vg, v1 = *(const GAS v4u*)(vg + 64);
        *(LAS v4u*)(lds + MA_K0 + kst0) = k0; *(LAS v4u*)(lds + MA_K0 + kst1) = k1; *(LAS v4u*)(lds + MA_V0 + vst0) = v0; *(LAS v4u*)(lds + MA_V0 + vst1) = v1; }
    __syncthreads();
#pragma unroll 1
    for (int t = 0; t < 4; ++t) {
        const int cur = t & 1;
        v4u k0, k1, v0, v1;
        if (t + 1 < 4) { const bf16* kn = kg + (size_t)(t + 1) * 64 * 1024; k0 = *(const GAS v4u*)kn; k1 = *(const GAS v4u*)(kn + 64); v0 = *(const GAS v4u*)(kn + 512); v1 = *(const GAS v4u*)(kn + 576); }
        const lds_cptr kb_ = (lds_cptr)(lds + MA_K0 + cur * 16384), vb_ = (lds_cptr)(lds + MA_V0 + cur * 16384);
        f32x16 S0, S1;
#pragma unroll
        for (int r = 0; r < 16; ++r) { S0[r] = 0.f; S1[r] = 0.f; }
#pragma unroll
        for (int s = 0; s < 8; ++s) { const bf16x8 a0 = *(const LAS bf16x8*)(kb_ + kread[s]), a1 = *(const LAS bf16x8*)(kb_ + kread[s] + 8192);
            S0 = __builtin_amdgcn_mfma_f32_32x32x16_bf16(a0, qf[s], S0, 0, 0, 0); S1 = __builtin_amdgcn_mfma_f32_32x32x16_bf16(a1, qf[s], S1, 0, 0, 0); }
#pragma unroll
        for (int r = 0; r < 16; ++r) { S0[r] = __builtin_amdgcn_exp2f(S0[r] * LOG2E - Cl2); S1[r] = __builtin_amdgcn_exp2f(S1[r] * LOG2E - Cl2); lsum += S0[r] + S1[r]; }
        bf16x8 pb[4];
#pragma unroll
        for (int hf = 0; hf < 2; ++hf) {
            v4u a, c;
#pragma unroll
            for (int j = 0; j < 4; ++j) { a[j] = cvtpk(S0[8 * hf + 2 * j], S0[8 * hf + 2 * j + 1]); c[j] = cvtpk(S1[8 * hf + 2 * j], S1[8 * hf + 2 * j + 1]); }
            pb[hf] = __builtin_bit_cast(bf16x8, a); pb[2 + hf] = __builtin_bit_cast(bf16x8, c);
        }
#pragma unroll
        for (int ks = 0; ks < 4; ++ks)
#pragma unroll
            for (int db = 0; db < 4; ++db) {
                const s16x4 a0 = vtr(vb_ + vread[db] + (16 * ks) * 256), a1 = vtr(vb_ + vread[db] + (16 * ks + 8) * 256);
                const bf16x8 va = __builtin_shufflevector(a0, a1, 0, 1, 2, 3, 4, 5, 6, 7);
                O[db] = __builtin_amdgcn_mfma_f32_32x32x16_bf16(va, pb[ks], O[db], 0, 0, 0);
            }
        if (t + 1 < 4) { LAS unsigned char* kn = lds + MA_K0 + (cur ^ 1) * 16384; LAS unsigned char* vn = lds + MA_V0 + (cur ^ 1) * 16384;
            *(LAS v4u*)(kn + kst0) = k0; *(LAS v4u*)(kn + kst1) = k1; *(LAS v4u*)(vn + vst0) = v0; *(LAS v4u*)(vn + vst1) = v1; }
        __syncthreads();
    }
    lsum += shx(lsum, 32, lane);
    const float inv = 1.f / lsum;
    bf16* op = OM + trow * MEMW + head * 128 + 4 * hh;
#pragma unroll
    for (int db = 0; db < 4; ++db)
#pragma unroll
        for (int g4 = 0; g4 < 4; ++g4) { v2u o; o.x = cvtpk(O[db][4 * g4] * inv, O[db][4 * g4 + 1] * inv); o.y = cvtpk(O[db][4 * g4 + 2] * inv, O[db][4 * g4 + 3] * inv); *(GAS v2u*)(op + 32 * db + 8 * g4) = o; }
}

__device__ __forceinline__ float wave_max(float v, int lane) {
#pragma unroll
    for (int o = 1; o < 64; o <<= 1) v = fmaxf(v, shx(v, o, lane));
    return v;
}
struct Args { const float* in[23]; float* out; unsigned char* ws; int ph_lo, ph_hi, use_bar, pad; };
#ifndef MK_OFF
#define MK_OFF 0u
#endif
#define PHON(k) (!((MK_OFF >> (k)) & 1u))
constexpr int PH_PER_LAYER = 13, PH_BASE = 3, N_PHASES = PH_BASE + DEPTH * PH_PER_LAYER;
constexpr int PTAB_OFF = LDSCTL_OFF + 1024;

__global__ void __launch_bounds__(NTHREADS, 2) mega(Args a) {
    extern __shared__ __attribute__((aligned(16))) unsigned char lds_raw[];
    LAS unsigned char* lds = (LAS unsigned char*)lds_raw;
    {   const int tid0 = threadIdx.x;
        for (int u = tid0; u < (LDS_BYTES - LDSCTL_OFF) / 4; u += NTHREADS) ((LAS unsigned*)(lds + LDSCTL_OFF))[u] = 0u;
        __syncthreads();
        if (tid0 < 23) ((LAS unsigned long long*)(lds + PTAB_OFF))[tid0] = (unsigned long long)a.in[tid0];
        if (tid0 == 23) ((LAS unsigned long long*)(lds + PTAB_OFF))[23] = (unsigned long long)a.out;
        if (tid0 == 24) ((LAS unsigned long long*)(lds + PTAB_OFF))[24] = (unsigned long long)a.ws;
        __syncthreads();
    }
    volatile LAS unsigned* MISC = (volatile LAS unsigned*)(lds + MISC_OFF);
    const int G = gridDim.x, bid = blockIdx.x, NGW = G * NWAVES;
    const int use_bar = a.use_bar;
    XcdBarrier bar; bar.bar = (unsigned*)(a.ws + WS_CTL) + CW_BAR; bar.x = 0; bar.st = MISC + 8;
    if (use_bar) bar = xcd_barrier_post((unsigned*)(a.ws + WS_CTL) + CW_BAR, MISC + 8);
    const int lo = a.ph_lo, hi = a.ph_hi;
#define IN(k) (lo <= (k) && (k) < hi)
#define SEAM(k) do { if (use_bar && IN(k) && IN((k) + 1)) xcd_barrier(bar); } while (0)
#define PHL() int tid_ = threadIdx.x; asm volatile("" : "+v"(tid_)); const int lane_ = tid_ & 63, wave_ = __builtin_amdgcn_readfirstlane(tid_ >> 6), gw_ = bid * NWAVES + wave_; (void)lane_; (void)gw_; \
              int pz_ = 0; asm volatile("" : "+s"(pz_))
#define PTR(i) ((const float*)ldptr(lds, (i) + pz_))
#define WSP() ((unsigned char*)ldptr(lds, 24 + pz_))
#define OUTP() ((float*)ldptr(lds, 23 + pz_))

    if (IN(0) && PHON(0)) {
        PHL(); unsigned char* ws = WSP();
        LAS float* scr = (LAS float*)(lds + RING_OFF + wave_ * 16384);
        constexpr int I_IN = 32 * 128, I_OUT = 32 * 64, I_MQ = 32 * 16, I_MKV = 32 * 32, I_MO = 8 * 64, I_PQ = 32 * 64, I_L = I_IN + I_OUT + I_MQ + I_MKV + I_MO + I_PQ;
        for (int it = gw_; it < DEPTH * I_L; it += NGW) {
            const int l = it / I_L; int r = it % I_L;
            if (r < I_IN) { transpose_item<true>(PTR(4) + (size_t)l * DM * DIN, DM, DIN, (bf16*)(ws + WS_WIN) + (size_t)l * DIN * DM, scr, r, lane_); continue; } r -= I_IN;
            if (r < I_OUT) { transpose_item<false>(PTR(11) + (size_t)l * DM * DM, DM, DM, (bf16*)(ws + WS_WOUT) + (size_t)l * DM * DM, scr, r, lane_); continue; } r -= I_OUT;
            if (r < I_MQ) { transpose_item<false>(PTR(14) + (size_t)l * DM * MEMW, DM, MEMW, (bf16*)(ws + WS_WMQ) + (size_t)l * MEMW * DM, scr, r, lane_); continue; } r -= I_MQ;
            if (r < I_MKV) { transpose_item<false>(PTR(15) + (size_t)l * DM * 1024, DM, 1024, (bf16*)(ws + WS_WMKV) + (size_t)l * 1024 * DM, scr, r, lane_); continue; } r -= I_MKV;
            if (r < I_MO) { transpose_item<false>(PTR(17) + (size_t)l * MEMW * DM, MEMW, DM, (bf16*)(ws + WS_WMO) + (size_t)l * DM * MEMW, scr, r, lane_); continue; } r -= I_MO;
            transpose_item<false>(PTR(19) + (size_t)l * DM * DM, DM, DM, (bf16*)(ws + WS_WPQ) + (size_t)l * DM * DM, scr, r, lane_);
        }
        const size_t gtid = (size_t)bid * NTHREADS + tid_, nth = (size_t)G * NTHREADS;
        convert_bf16(PTR(20), (bf16*)(ws + WS_PKEYS), (size_t)DEPTH * 8 * 2 * 128 * 128, gtid, nth);
        convert_fp8(PTR(21), ws + WS_PU, (size_t)DEPTH * PEER_N * DM, PU_SCALE, gtid, nth);
        convert_fp8(PTR(22), ws + WS_PV, (size_t)DEPTH * PEER_N * DM, PV_SCALE, gtid, nth);
        {   const float* mem = PTR(1); const float* gkv = PTR(13); bf16* MEMN = (bf16*)(ws + WS_MEMN);
            for (int m = gw_; m < BATCH * NMEM; m += NGW)
                rms_row_to_bf16(mem + (size_t)m * DM, gkv, MEMN + (size_t)m * DM, gkv + DM, MEMN + (size_t)(BATCH * NMEM + m) * DM, lane_); }
        float* rope = (float*)(ws + WS_ROPE); float* biasA = (float*)(ws + WS_BIASA);
        if (gtid < 64 * 16) { const int pos = (int)gtid >> 4, i = (int)gtid & 15; const float ang = (float)pos * ROPE_INV[i]; rope[gtid * 2] = cosf(ang); rope[gtid * 2 + 1] = sinf(ang); }
        if (gtid < 12 * 257) { const int h = (int)gtid / 257, rel = (int)gtid % 257 - 128; biasA[gtid] = PTR(2)[t5_bucket(rel) * 12 + h]; }
    }
    SEAM(0);
    if (IN(1) && PHON(1)) {
#pragma unroll 1
        for (int l = 0; l < DEPTH; ++l) {
            PHL(); unsigned char* ws = WSP();
            pg8::Gemm g{(bf16*)(ws + WS_MEMN) + (size_t)l * BATCH * NMEM * DM, (bf16*)(ws + WS_WMKV) + (size_t)l * 1024 * DM, BATCH * NMEM, 1024, DM};
            OffsetOrder S; S.init(BATCH * NMEM, 1024, G, bid, 64 * l);
            pg8::EpiBf16<0> E{(bf16*)(ws + WS_KVM) + (size_t)l * BATCH * NMEM * 1024, 1024, nullptr, 0, 0, 1.f};
            pg8::gemm_phase<pg8::EpiBf16<0>, OffsetOrder, true, true>(lds + RING_OFF, g, S, E, tid_);
            __syncthreads();
        }
    }
    SEAM(1);
    if (IN(2) && PHON(2)) {
        PHL(); unsigned char* ws = WSP(); bf16* KVM = (bf16*)(ws + WS_KVM); const float* gm = PTR(16);
        for (int m = gw_; m < DEPTH * BATCH * NMEM; m += NGW) {
            const int l = m / (BATCH * NMEM);
            GAS v4u* p = (GAS v4u*)(KVM + (size_t)m * 1024 + 8 * lane_);
            const v4u w = *p;
            float f[8] = {bflo(w.x), bfhi(w.x), bflo(w.y), bfhi(w.y), bflo(w.z), bfhi(w.z), bflo(w.w), bfhi(w.w)};
            float ss = 0.f;
#pragma unroll
            for (int i = 0; i < 8; ++i) ss += f[i] * f[i];
            ss += shx(ss, 1, lane_); ss += shx(ss, 2, lane_); ss += shx(ss, 4, lane_); ss += shx(ss, 8, lane_);
            const float r = 1.f / sqrtf(ss * (1.f / 128.f) + EPS);
            const float* gk = gm + (size_t)l * 256 + 128 + 8 * (lane_ & 15);
            v4u o; o.x = pk2(f[0] * r * gk[0], f[1] * r * gk[1]); o.y = pk2(f[2] * r * gk[2], f[3] * r * gk[3]); o.z = pk2(f[4] * r * gk[4], f[5] * r * gk[5]); o.w = pk2(f[6] * r * gk[6], f[7] * r * gk[7]);
            *p = o;
        }
    }
    SEAM(2);

#pragma unroll 1
    for (int l = 0; l < DEPTH; ++l) {
        const int pb = PH_BASE + PH_PER_LAYER * l;
        if (IN(pb + 0) && PHON(3)) { PHL(); unsigned char* ws = WSP(); const float* xin = (l == 0) ? PTR(0) : (const float*)OUTP();
            norm_rows(xin, PTR(3) + (size_t)l * DM, (bf16*)(ws + WS_XN), gw_, NGW, lane_); }
        SEAM(pb + 0);
        if (IN(pb + 1) && PHON(4)) { PHL(); unsigned char* ws = WSP();
            pg8::Gemm g{(bf16*)(ws + WS_XN), (bf16*)(ws + WS_WIN) + (size_t)l * DIN * DM, T, DIN, DM}; pg8::StaticOrder S; S.init(T, DIN, G, bid);
            pg8::EpiQKV E{(bf16*)(ws + WS_QKV), PTR(5) + (size_t)l * 128, PTR(7) + (size_t)l * 128, PTR(9) + (size_t)l * 128, (const float*)(ws + WS_ROPE)};
            pg8::gemm_phase<pg8::EpiQKV, pg8::StaticOrder, true, true>(lds + RING_OFF, g, S, E, tid_);
        }
        SEAM(pb + 1);
        if (IN(pb + 2) && PHON(5)) { PHL(); unsigned char* ws = WSP();
            const float* sink = PTR(6) + (size_t)l * 12; const float* rpb = PTR(8) + (size_t)l * 8 * 15 * 31; const float* biasA = (const float*)(ws + WS_BIASA);
            const bf16* QKV = (const bf16*)(ws + WS_QKV); bf16* ATT = (bf16*)(ws + WS_ATT);
            const float* ga = PTR(5) + (size_t)l * 128; const float* gb = PTR(7) + (size_t)l * 128; const float* gc = PTR(9) + (size_t)l * 128;
            const float CaL2 = 8.f * wave_max(fabsf(ga[lane_]), lane_) * wave_max(fabsf(ga[64 + lane_]), lane_) * LOG2E;
            const float CbL2 = 8.f * wave_max(fabsf(gb[lane_]), lane_) * wave_max(fabsf(gb[64 + lane_]), lane_) * LOG2E;
            const float CcL2 = 8.f * wave_max(fabsf(gc[lane_]), lane_) * wave_max(fabsf(gc[64 + lane_]), lane_) * LOG2E;
            const int vc = (G % 8 == 0) ? (bid % 8) * (G / 8) + bid / 8 : bid;
            for (int u = vc; u < BATCH * 12 * 8; u += G) attn_unit<2>(lds, QKV, ATT, u / 96, (u >> 3) % 12, u & 7, nullptr, CcL2, 0.f, tid_);
            for (int u = vc; u < BATCH * 8 * 8; u += G) attn_unit<1>(lds, QKV, ATT, u >> 6, (u >> 3) & 7, u & 7, rpb, CbL2, 0.f, tid_);
            for (int u = vc; u < BATCH * 12 * 8; u += G) { const int head = (u >> 3) % 12; attn_unit<0>(lds, QKV, ATT, u / 96, head, u & 7, biasA, CaL2, sink[head] * LOG2E, tid_); }
        }
        SEAM(pb + 2);
        if (IN(pb + 3) && PHON(6)) { PHL(); unsigned char* ws = WSP(); mixnorm_rows((bf16*)(ws + WS_ATT), PTR(10) + (size_t)l * DM, gw_, NGW, lane_); }
        SEAM(pb + 3);
        if (IN(pb + 4) && PHON(7)) { PHL(); unsigned char* ws = WSP(); const float* xin = (l == 0) ? PTR(0) : (const float*)OUTP();
            pg8::Gemm g{(bf16*)(ws + WS_ATT), (bf16*)(ws + WS_WOUT) + (size_t)l * DM * DM, T, DM, DM}; pg8::StaticOrder S; S.init(T, DM, G, bid);
            pg8::EpiResid E{xin, OUTP(), DM};
            pg8::gemm_phase<pg8::EpiResid, pg8::StaticOrder, true, true>(lds + RING_OFF, g, S, E, tid_);
        }
        SEAM(pb + 4);
        if (IN(pb + 5) && PHON(8)) { PHL(); unsigned char* ws = WSP(); norm_rows(OUTP(), PTR(12) + (size_t)l * DM, (bf16*)(ws + WS_XN), gw_, NGW, lane_); }
        SEAM(pb + 5);
        if (IN(pb + 6) && PHON(9)) { PHL(); unsigned char* ws = WSP();
            pg8::Gemm g{(bf16*)(ws + WS_XN), (bf16*)(ws + WS_WMQ) + (size_t)l * MEMW * DM, T, MEMW, DM}; pg8::StaticOrder S; S.init(T, MEMW, G, bid);
            pg8::EpiBf16<0> E{(bf16*)(ws + WS_QM), MEMW, nullptr, 0, 0, 1.f};
            pg8::gemm_phase<pg8::EpiBf16<0>, pg8::StaticOrder, true, true>(lds + RING_OFF, g, S, E, tid_);
        }
        SEAM(pb + 6);
        if (IN(pb + 7) && PHON(10)) { PHL(); unsigned char* ws = WSP();
            const bf16* kvm = (const bf16*)(ws + WS_KVM) + (size_t)l * BATCH * NMEM * 1024; const float* gq = PTR(16) + (size_t)l * 256;
            const float CmL2 = 11.313708498984761f * wave_max(fmaxf(fabsf(gq[lane_]), fabsf(gq[64 + lane_])), lane_) * wave_max(fmaxf(fabsf(gq[128 + lane_]), fabsf(gq[192 + lane_])), lane_) * LOG2E;
            for (int u = bid; u < (T / 256) * 4; u += G) mem_unit(lds, (const bf16*)(ws + WS_QM), kvm, (bf16*)(ws + WS_OM), gq, u >> 2, u & 3, CmL2, tid_);
        }
        SEAM(pb + 7);
        if (IN(pb + 8) && PHON(11)) { PHL(); unsigned char* ws = WSP();
            pg8::Gemm g{(bf16*)(ws + WS_OM), (bf16*)(ws + WS_WMO) + (size_t)l * DM * MEMW, T, DM, MEMW}; pg8::StaticOrder S; S.init(T, DM, G, bid);
            pg8::EpiResid E{OUTP(), OUTP(), DM};
            pg8::gemm_phase<pg8::EpiResid, pg8::StaticOrder, true, true>(lds + RING_OFF, g, S, E, tid_);
        }
        SEAM(pb + 8);
        if (IN(pb + 9) && PHON(12)) { PHL(); unsigned char* ws = WSP(); norm_rows(OUTP(), PTR(18) + (size_t)l * DM, (bf16*)(ws + WS_XN), gw_, NGW, lane_); }
        SEAM(pb + 9);
        if (IN(pb + 10) && PHON(13)) { PHL(); unsigned char* ws = WSP();
            pg8::Gemm g{(bf16*)(ws + WS_XN), (bf16*)(ws + WS_WPQ) + (size_t)l * DM * DM, T, DM, DM}; pg8::StaticOrder S; S.init(T, DM, G, bid);
            pg8::EpiBf16<0> E{(bf16*)(ws + WS_QP), DM, nullptr, 0, 0, 1.f};
            pg8::gemm_phase<pg8::EpiBf16<0>, pg8::StaticOrder, true, true>(lds + RING_OFF, g, S, E, tid_);
        }
        SEAM(pb + 10);
        if (IN(pb + 11) && PHON(14)) { PHL(); unsigned char* ws = WSP();
            const bf16* pk = (const bf16*)(ws + WS_PKEYS) + (size_t)l * 8 * 2 * 128 * 128;
            for (int u = bid; u < (T / 256) * PEER_H; u += G) peer_select_unit((const bf16*)(ws + WS_QP), pk, (int*)(ws + WS_PIDX), (float*)(ws + WS_PGATE), u >> 3, u & 7, wave_, lane_);
        }
        SEAM(pb + 11);
        if (IN(pb + 12) && PHON(15)) { PHL(); unsigned char* ws = WSP();
            peer_gather8((const bf16*)(ws + WS_XN), ws + WS_PU + (size_t)l * PEER_N * DM, ws + WS_PV + (size_t)l * PEER_N * DM, (const int*)(ws + WS_PIDX), (const float*)(ws + WS_PGATE), OUTP(), (LAS float*)(lds + RING_OFF + wave_ * 1024), gw_, NGW, lane_); }
        SEAM(pb + 12);
    }
#undef IN
#undef SEAM
}

#ifndef MK_MULTI_LAUNCH
#define MK_MULTI_LAUNCH 0
#endif
extern "C" void kernel_launch(void* const* d_in, const int* in_sizes, int n_in, void* d_out, int out_size, void* d_ws, size_t ws_size, hipStream_t stream) {
    static int grid = 0;
    if (grid == 0) {
        if (n_in != 23 || out_size != T * DM || ws_size < WS_END) { fprintf(stderr, "kernel_launch: unexpected shapes (n_in %d, out %d, ws %zu)\n", n_in, out_size, ws_size); grid = -1; return; }
        int dev = 0, cus = 0, per_cu = 0;
        if (hipGetDevice(&dev) != hipSuccess || hipDeviceGetAttribute(&cus, hipDeviceAttributeMultiprocessorCount, dev) != hipSuccess) { grid = -1; return; }
        if (hipFuncSetAttribute((const void*)mega, hipFuncAttributeMaxDynamicSharedMemorySize, LDS_BYTES) != hipSuccess) { fprintf(stderr, "kernel_launch: hipFuncSetAttribute failed\n"); grid = -1; return; }
        if (hipOccupancyMaxActiveBlocksPerMultiprocessor(&per_cu, (const void*)mega, NTHREADS, LDS_BYTES) != hipSuccess || per_cu < 1) { fprintf(stderr, "kernel_launch: occupancy query says %d\n", per_cu); }
        (void)hipGetLastError();
        grid = cus;
    }
    if (grid < 0) return;
    (void)hipMemsetAsync((char*)d_ws + WS_CTL, 0, CTL_ZERO_BYTES, stream);
    Args a{};
    for (int i = 0; i < 23; ++i) a.in[i] = (const float*)d_in[i];
    a.out = (float*)d_out; a.ws = (unsigned char*)d_ws;
#if MK_MULTI_LAUNCH
    for (int p = 0; p < N_PHASES; ++p) { a.ph_lo = p; a.ph_hi = p + 1; a.use_bar = 0; a.pad = 0; hipLaunchKernelGGL(mega, dim3(grid), dim3(NTHREADS), LDS_BYTES, stream, a); }
#else
    a.ph_lo = 0; a.ph_hi = N_PHASES; a.use_bar = 1; a.pad = 0;
    hipLaunchKernelGGL(mega, dim3(grid), dim3(NTHREADS), LDS_BYTES, stream, a);
#endif
    const hipError_t le = hipPeekAtLastError();
    if (le != hipSuccess) fprintf(stderr, "kernel_launch: launch failed: %s\n", hipGetErrorName(le));
}
```

```cpp
#include <hip/hip_runtime.h>
#include <cstdio>
#include <cstdint>
#include <cmath>
__device__ __forceinline__ float shx(float v, int k, int lane);
namespace pg8 {
#define PG8_LAS __attribute__((address_space(3)))
typedef unsigned short bf16_t;
typedef short bf16x8 __attribute__((ext_vector_type(8)));
typedef float f32x4 __attribute__((ext_vector_type(4)));
typedef unsigned u32x4 __attribute__((ext_vector_type(4)));
constexpr int BM = 256, BK = 64, HALF = 128, HTB = HALF * BK * 2  , STAGE_BYTES = 8 * HTB, NXCD = 8, WGM = 8;

__host__ __device__ __forceinline__ int lds_byte(int r, int c) { const int st = (r >> 4) * 2 + (c >> 5), rr = r & 15, cc = c & 31, ob = rr * 64 + cc * 2; return st * 1024 + (ob ^ (((ob >> 9) & 1) << 5)); }
__host__ __device__ __forceinline__ void stage_rc(int b, int& R, int& C) { const int st = b / 1024, sb = b % 1024, swz = sb ^ (((sb >> 9) & 1) << 5); R = (st >> 1) * 16 + swz / 64; C = (st & 1) * 32 + (swz % 64) / 2; }
__host__ __device__ __forceinline__ int perm32(int rho) { const int n = rho >> 4, i = rho & 15; return 8 * (i >> 2) + 4 * n + (i & 3); }

struct Unit { int pm, pn; };
struct Gemm { const bf16_t* A; const bf16_t* Bt; int M, N, K; };

struct StaticOrder {
    int nM, nN, nwg, G, c;
    __host__ __device__ void init(int M, int N, int G_, int c_) { nM = M / BM; nN = N / BM; nwg = nM * nN; G = G_; c = c_; }
    __host__ __device__ bool next(int i, Unit& u) const {
        const long L = (long)i * G + c; if (L >= nwg) return false;
        int wgid = (int)L; { const int q = nwg / NXCD, r = nwg % NXCD, xcd = wgid % NXCD, off = wgid / NXCD; wgid = (xcd < r ? xcd * (q + 1) : r * (q + 1) + (xcd - r) * q) + off; }
        const int nig = WGM * nN, gid = wgid / nig, fm = gid * WGM, gsz = (nM - fm) < WGM ? (nM - fm) : WGM;
        u.pm = fm + ((wgid % nig) % gsz); u.pn = (wgid % nig) / gsz; return true;
    }
    __device__ __forceinline__ void a_ready(const Unit&) const {}
    __device__ __forceinline__ void done(const Unit&) const {}
};

__device__ __forceinline__ unsigned cvt_pk_bf16(float lo, float hi) { unsigned r; asm volatile("v_cvt_pk_bf16_f32 %0, %1, %2" : "=v"(r) : "v"(lo), "v"(hi)); return r; }
typedef float f32x2 __attribute__((ext_vector_type(2)));
__device__ __forceinline__ f32x2 gelu_pk(f32x2 v) {
    const f32x2 av = __builtin_elementwise_abs(v), d = av * 0.2316418882f + 1.0f;
    f32x2 t; t.x = __builtin_amdgcn_rcpf(d.x); t.y = __builtin_amdgcn_rcpf(d.y);
    f32x2 q = t * 0.5307027145f + (-0.7265760135f); q = q * t + 0.7107068705f; q = q * t + (-0.142248368f); q = q * t + 0.127414796f; q = q * t;
    const f32x2 s = (v * v) * (-0.72134752044f);
    f32x2 e; e.x = __builtin_amdgcn_exp2f(s.x); e.y = __builtin_amdgcn_exp2f(s.y);
    const f32x2 m = v * (q * e), r = v - m;
    f32x2 o; o.x = v.x < 0.f ? m.x : r.x; o.y = v.y < 0.f ? m.y : r.y; return o;
}

template <int ACT  > struct EpiBf16 {
    static constexpr bool PERM = true, AFTER_DRAIN = false; static_assert(ACT == 0 || ACT == 1, "EpiBf16: ACT is 0 (none) or 1 (gelu_pk)");
    bf16_t* O; int ldc; const float* bias; int split_cols; size_t split_stride; float scale0;
    __device__ __forceinline__ void operator()(const f32x4 (&acc)[2][2][4][2], const Unit& u, int wr, int wc, int fr, int fq) const {
        const int row0 = u.pm * BM + wr * 64 + fr; int colt = u.pn * BM; bf16_t* base = O;
        float sc = 1.f; if (split_cols) { const int t = colt / split_cols; base += (size_t)t * split_stride; colt -= t * split_cols; if (t == 0) sc = scale0; }
        const int col0 = colt + wc * 32 + 8 * fq, bcol0 = u.pn * BM + wc * 32 + 8 * fq;
        f32x4 bv[2][2];
#pragma unroll
        for (int bj = 0; bj < 2; ++bj)
#pragma unroll
            for (int n = 0; n < 2; ++n) bv[bj][n] = bias ? *(const f32x4*)(bias + bcol0 + bj * HALF + 4 * n) : (f32x4){0.f, 0.f, 0.f, 0.f};
#pragma unroll
        for (int ai = 0; ai < 2; ++ai)
#pragma unroll
            for (int m = 0; m < 4; ++m) { bf16_t* rowp = base + (size_t)(row0 + ai * HALF + m * 16) * ldc + col0;
#pragma unroll
                for (int bj = 0; bj < 2; ++bj) { f32x4 v0 = acc[ai][bj][m][0] + bv[bj][0], v1 = acc[ai][bj][m][1] + bv[bj][1];
                    if (ACT == 1) { f32x2 a = gelu_pk((f32x2){v0[0], v0[1]}), b = gelu_pk((f32x2){v0[2], v0[3]}), c = gelu_pk((f32x2){v1[0], v1[1]}), d = gelu_pk((f32x2){v1[2], v1[3]});
                        v0 = (f32x4){a.x, a.y, b.x, b.y}; v1 = (f32x4){c.x, c.y, d.x, d.y}; }
                    v0 = v0 * sc; v1 = v1 * sc; u32x4 w; w.x = cvt_pk_bf16(v0[0], v0[1]); w.y = cvt_pk_bf16(v0[2], v0[3]); w.z = cvt_pk_bf16(v1[0], v1[1]); w.w = cvt_pk_bf16(v1[2], v1[3]);
                    *(u32x4*)(rowp + bj * HALF) = w; } }
    }
};

typedef unsigned u32x2 __attribute__((ext_vector_type(2)));
struct EpiResid {
    static constexpr bool PERM = false, AFTER_DRAIN = false;
    const float* base; float* out; int ldc;
    __device__ __forceinline__ void operator()(const f32x4 (&acc)[2][2][4][2], const Unit& u, int wr, int wc, int fr, int fq) const {
        const int col0 = u.pn * BM + wc * 32 + 4 * fq;
#pragma unroll
        for (int ai = 0; ai < 2; ++ai)
#pragma unroll
            for (int m = 0; m < 4; ++m) { const size_t off = (size_t)(u.pm * BM + ai * HALF + wr * 64 + m * 16 + fr) * ldc + col0;
#pragma unroll
                for (int bj = 0; bj < 2; ++bj)
#pragma unroll
                    for (int n = 0; n < 2; ++n) { const f32x4 bs = *(const f32x4*)(base + off + bj * HALF + n * 16); *(f32x4*)(out + off + bj * HALF + n * 16) = bs + acc[ai][bj][m][n]; } }
    }
};
struct EpiQKV {
    static constexpr bool PERM = false, AFTER_DRAIN = false;
    bf16_t* O; const float* ga; const float* gb; const float* gc; const float* rope;
    __device__ __forceinline__ void operator()(const f32x4 (&acc)[2][2][4][2], const Unit& u, int wr, int wc, int fr, int fq) const {
        const int hg = u.pn * 4 + wc;
        const float* g = nullptr; bool isq = false, dorope = false;
        if (hg < 12) { g = ga; isq = true; } else if (hg < 16) { g = ga + 64; } else if (hg < 20) { }
        else if (hg < 28) { g = gb; isq = true; } else if (hg < 36) { g = gb + 64; } else if (hg < 44) { }
        else if (hg < 56) { g = gc; isq = true; dorope = true; } else if (hg < 60) { g = gc + 64; dorope = true; }
        const float qs = isq ? 0.125f : 1.0f;
#pragma unroll
        for (int ai = 0; ai < 2; ++ai)
#pragma unroll
            for (int m = 0; m < 4; ++m) {
                const int row = u.pm * BM + ai * HALF + wr * 64 + m * 16 + fr;
                f32x4 v[2][2];
#pragma unroll
                for (int bj = 0; bj < 2; ++bj)
#pragma unroll
                    for (int n = 0; n < 2; ++n) v[bj][n] = acc[ai][bj][m][n];
                if (g) {
                    float ss = 0.f;
#pragma unroll
                    for (int bj = 0; bj < 2; ++bj)
#pragma unroll
                        for (int n = 0; n < 2; ++n) { const f32x4 x = v[bj][n]; ss += (x[0] * x[0] + x[1] * x[1]) + (x[2] * x[2] + x[3] * x[3]); }
                    ss += shx(ss, 16, fr + 16 * fq); ss += shx(ss, 32, fr + 16 * fq);
                    const float r = qs / sqrtf(ss * (1.0f / 64.0f) + 1e-6f);
#pragma unroll
                    for (int bj = 0; bj < 2; ++bj)
#pragma unroll
                        for (int n = 0; n < 2; ++n) v[bj][n] = v[bj][n] * *(const f32x4*)(g + 32 * bj + 16 * n + 4 * fq) * r;
                }
                if (dorope) {
                    const int t = row & 2047, pr = t >> 6, pc = t & 63;
#pragma unroll
                    for (int bj = 0; bj < 2; ++bj) {
                        const int pos = bj ? pc : pr;
                        const float* rp = rope + (size_t)(pos * 16 + 4 * fq) * 2;
                        const f32x4 c01 = *(const f32x4*)rp, c23 = *(const f32x4*)(rp + 4);
                        const f32x4 cs = (f32x4){c01[0], c01[2], c23[0], c23[2]}, sn = (f32x4){c01[1], c01[3], c23[1], c23[3]};
                        const f32x4 x1 = v[bj][0], x2 = v[bj][1];
                        v[bj][0] = x1 * cs - x2 * sn; v[bj][1] = x1 * sn + x2 * cs;
                    }
                }
                bf16_t* rowp = O + (size_t)row * 4096 + hg * 64 + 4 * fq;
#pragma unroll
                for (int bj = 0; bj < 2; ++bj)
#pragma unroll
                    for (int n = 0; n < 2; ++n) { u32x2 w; w.x = cvt_pk_bf16(v[bj][n][0], v[bj][n][1]); w.y = cvt_pk_bf16(v[bj][n][2], v[bj][n][3]); *(u32x2*)(rowp + 32 * bj + 16 * n) = w; }
                asm volatile("" ::: "memory");
            }
    }
};
template <class Epi, class Sched, bool ALIGN_EPI = false, bool SP2 = false>
__device__ __forceinline__ void gemm_phase(PG8_LAS unsigned char* lds, const Gemm g, const Sched& S, const Epi& E, const int tid) {
    const int wid = __builtin_amdgcn_readfirstlane(tid >> 6), lane = tid & 63, wr = wid >> 2, wc = wid & 3, fr = lane & 15, fq = lane >> 4;
    const int K = g.K, nt = K / BK;
    unsigned voffA[2], voffB[2];
#pragma unroll
    for (int i = 0; i < 2; ++i) { int R, C; stage_rc(tid * 16 + i * 8192, R, C); const int Rb = Epi::PERM ? ((R & ~31) + perm32(R & 31)) : R;
        voffA[i] = (unsigned)(R * K + C) * 2u; voffB[i] = (unsigned)(Rb * K + C) * 2u; }
    const size_t kstep = (size_t)(BK * 2);
    const size_t hstep = (size_t)HALF * K * 2;
    const size_t tstep = 2 * hstep;
    const unsigned ldsw = (unsigned)wid * 1024u;
    const int aoff = lds_byte(wr * 64 + fr, fq * 8), boff = lds_byte(wc * 32 + fr, fq * 8);
#define PG8_SA(b, h) (((b) * 2 + (h)) * HTB)
#define PG8_SB(b, h) ((4 + (b) * 2 + (h)) * HTB)
#define PG8_STAGE(bufoff, gbase, voff) do { _Pragma("unroll") for (int _i = 0; _i < 2; ++_i) \
        __builtin_amdgcn_global_load_lds((const unsigned*)((const char*)(gbase) + (voff)[_i]), (PG8_LAS unsigned*)(lds + (bufoff) + ldsw + _i * 8192), 16, 0, 0); } while (0)
#define PG8_LDA(dst, b, h) do { _Pragma("unroll") for (int m = 0; m < 4; ++m) _Pragma("unroll") for (int k = 0; k < 2; ++k) dst[m][k] = *(const PG8_LAS bf16x8*)(lds + PG8_SA(b, h) + aoff + m * 2048 + k * 1024); } while (0)
#define PG8_LDB(dst, b, h) do { _Pragma("unroll") for (int n = 0; n < 2; ++n) _Pragma("unroll") for (int k = 0; k < 2; ++k) dst[n][k] = *(const PG8_LAS bf16x8*)(lds + PG8_SB(b, h) + boff + n * 2048 + k * 1024); } while (0)
#define PG8_MMA(ai, bj, At, Bt) do { __builtin_amdgcn_s_setprio(1); _Pragma("unroll") for (int m = 0; m < 4; ++m) _Pragma("unroll") for (int n = 0; n < 2; ++n) _Pragma("unroll") for (int k = 0; k < 2; ++k) \
        acc[ai][bj][m][n] = __builtin_amdgcn_mfma_f32_16x16x32_bf16(Bt[n][k], At[m][k], acc[ai][bj][m][n], 0, 0, 0); __builtin_amdgcn_s_setprio(0); } while (0)
#define PG8_WAIT_V(n) asm volatile("s_waitcnt vmcnt(" #n ")" ::: "memory")
#define PG8_WAIT_L(n) asm volatile("s_waitcnt lgkmcnt(" #n ")" ::: "memory")
#define PG8_BAR __builtin_amdgcn_s_barrier()
#define PG8_SCHED __builtin_amdgcn_sched_barrier(0)
    Unit cur, nxt; int ui = 0;
    if (!S.next(0, cur)) return;
    f32x4 acc[2][2][4][2];
#pragma unroll
    for (int a = 0; a < 2; ++a)
#pragma unroll
        for (int b = 0; b < 2; ++b)
#pragma unroll
            for (int m = 0; m < 4; ++m)
#pragma unroll
                for (int n = 0; n < 2; ++n) acc[a][b][m][n] = (f32x4){0.f, 0.f, 0.f, 0.f};
    bf16x8 At[4][2], B0[2][2], B1[2][2];
    const char* cA = (const char*)g.A + (size_t)cur.pm * tstep; const char* cB = (const char*)g.Bt + (size_t)cur.pn * tstep;
    S.a_ready(cur);
    if constexpr (SP2) {
        PG8_STAGE(PG8_SB(0, 0), cB, voffB); PG8_STAGE(PG8_SB(0, 1), cB + hstep, voffB); PG8_STAGE(PG8_SA(0, 0), cA, voffA); PG8_STAGE(PG8_SA(0, 1), cA + hstep, voffA);
        if (wr == 1) PG8_BAR;
        PG8_WAIT_V(2); PG8_BAR;
        PG8_STAGE(PG8_SB(1, 0), cB + kstep, voffB); PG8_STAGE(PG8_SA(1, 0), cA + kstep, voffA); PG8_STAGE(PG8_SB(1, 1), cB + hstep + kstep, voffB);
        PG8_WAIT_V(6); PG8_BAR;
    } else {
        PG8_STAGE(PG8_SB(0, 0), cB, voffB); PG8_STAGE(PG8_SA(0, 0), cA, voffA); PG8_STAGE(PG8_SB(0, 1), cB + hstep, voffB); PG8_STAGE(PG8_SA(0, 1), cA + hstep, voffA);
        if (wr == 1) PG8_BAR;
        PG8_WAIT_V(4); PG8_BAR;
        PG8_STAGE(PG8_SB(1, 0), cB + kstep, voffB); PG8_STAGE(PG8_SA(1, 0), cA + kstep, voffA); PG8_STAGE(PG8_SB(1, 1), cB + hstep + kstep, voffB);
        PG8_WAIT_V(6); PG8_BAR;
    }
    for (;;) {
        const bool has_next = S.next(ui + 1, nxt);
        const char* nA = has_next ? (const char*)g.A + (size_t)nxt.pm * tstep : cA; const char* nB = has_next ? (const char*)g.Bt + (size_t)nxt.pn * tstep : cB;
        for (int t = 0; t < nt; t += 2) {
            const bool last = (t == nt - 2);
            const char* a1 = cA + (size_t)(t + 1) * kstep;
            const char* a2 = last ? nA : cA + (size_t)(t + 2) * kstep; const char* b2 = last ? nB : cB + (size_t)(t + 2) * kstep;
            const char* a3 = a2 + kstep; const char* b3 = b2 + kstep;
            if (last && has_next) S.a_ready(nxt);
            if constexpr (SP2) {
            PG8_LDB(B0, 0, 0); PG8_LDB(B1, 0, 1); PG8_SCHED; PG8_LDA(At, 0, 0); PG8_STAGE(PG8_SA(1, 1), a1 + hstep, voffA);
            PG8_WAIT_V(8); PG8_WAIT_L(0); PG8_BAR; PG8_MMA(0, 0, At, B0); PG8_MMA(0, 1, At, B1); PG8_BAR; PG8_SCHED;
            PG8_LDA(At, 0, 1); PG8_STAGE(PG8_SB(0, 0), b2, voffB); PG8_STAGE(PG8_SB(0, 1), b2 + hstep, voffB); PG8_STAGE(PG8_SA(0, 0), a2, voffA);
            PG8_WAIT_V(8); PG8_WAIT_L(0); PG8_BAR; PG8_MMA(1, 0, At, B0); PG8_MMA(1, 1, At, B1); PG8_BAR; PG8_SCHED;
            PG8_LDB(B0, 1, 0); PG8_LDB(B1, 1, 1); PG8_SCHED; PG8_LDA(At, 1, 0); PG8_STAGE(PG8_SA(0, 1), a2 + hstep, voffA);
            PG8_WAIT_V(8); PG8_WAIT_L(0); PG8_BAR; PG8_MMA(0, 0, At, B0); PG8_MMA(0, 1, At, B1); PG8_BAR; PG8_SCHED;
            PG8_LDA(At, 1, 1); PG8_STAGE(PG8_SB(1, 0), b3, voffB); PG8_STAGE(PG8_SB(1, 1), b3 + hstep, voffB); PG8_STAGE(PG8_SA(1, 0), a3, voffA);
            PG8_WAIT_V(8); PG8_WAIT_L(0); PG8_BAR; PG8_MMA(1, 0, At, B0); PG8_MMA(1, 1, At, B1); PG8_BAR; PG8_SCHED;
            } else {
            PG8_LDB(B0, 0, 0); PG8_SCHED; PG8_LDA(At, 0, 0); PG8_STAGE(PG8_SA(1, 1), a1 + hstep, voffA);
            PG8_WAIT_L(8); PG8_BAR; PG8_WAIT_L(0); PG8_MMA(0, 0, At, B0); PG8_BAR; PG8_SCHED;
            PG8_LDB(B1, 0, 1); PG8_STAGE(PG8_SB(0, 0), b2, voffB);
            PG8_BAR; PG8_WAIT_L(0); PG8_MMA(0, 1, At, B1); PG8_BAR;
            PG8_LDA(At, 0, 1); PG8_STAGE(PG8_SA(0, 0), a2, voffA);
            PG8_BAR; PG8_WAIT_L(0); PG8_MMA(1, 0, At, B0); PG8_BAR; PG8_SCHED;
            PG8_STAGE(PG8_SB(0, 1), b2 + hstep, voffB);
            PG8_WAIT_V(6); PG8_BAR; PG8_MMA(1, 1, At, B1); PG8_BAR;
            PG8_LDB(B0, 1, 0); PG8_SCHED; PG8_LDA(At, 1, 0); PG8_STAGE(PG8_SA(0, 1), a2 + hstep, voffA);
            PG8_WAIT_L(8); PG8_BAR; PG8_WAIT_L(0); PG8_MMA(0, 0, At, B0); PG8_BAR; PG8_SCHED;
            PG8_LDB(B1, 1, 1); PG8_STAGE(PG8_SB(1, 0), b3, voffB);
            PG8_BAR; PG8_WAIT_L(0); PG8_MMA(0, 1, At, B1); PG8_BAR;
            PG8_LDA(At, 1, 1); PG8_STAGE(PG8_SA(1, 0), a3, voffA);
            PG8_BAR; PG8_WAIT_L(0); PG8_MMA(1, 0, At, B0); PG8_BAR; PG8_SCHED;
            PG8_STAGE(PG8_SB(1, 1), b3 + hstep, voffB);
            PG8_WAIT_V(6); PG8_BAR; PG8_MMA(1, 1, At, B1); PG8_BAR;
            }
        }
        if constexpr (ALIGN_EPI) { if (wr == 0) PG8_BAR; }
        if constexpr (!Epi::AFTER_DRAIN) { E(acc, cur, wr, wc, fr, fq); S.done(cur); }
        if (!has_next) break;
#pragma unroll
        for (int a = 0; a < 2; ++a)
#pragma unroll
            for (int b = 0; b < 2; ++b)
#pragma unroll
                for (int m = 0; m < 4; ++m)
#pragma unroll
                    for (int n = 0; n < 2; ++n) acc[a][b][m][n] = (f32x4){0.f, 0.f, 0.f, 0.f};
        cur = nxt; cA = nA; cB = nB; ++ui;
        if constexpr (ALIGN_EPI) { if (wr == 1) PG8_BAR; }
    }
    PG8_WAIT_V(0);
    if constexpr (!ALIGN_EPI) { if (wr == 0) PG8_BAR; }
    PG8_BAR;
    if constexpr (Epi::AFTER_DRAIN) { E.fused(acc, cur, wr, wc, fr, fq, lds, wid, lane); S.done(cur); }
#undef PG8_SA
#undef PG8_SB
#undef PG8_STAGE
#undef PG8_LDA
#undef PG8_LDB
#undef PG8_MMA
#undef PG8_WAIT_V
#undef PG8_WAIT_L
#undef PG8_BAR
#undef PG8_SCHED
}
}

constexpr int BATCH = 16, SEQ = 2048, DM = 2048, T = BATCH * SEQ, DEPTH = 2;
constexpr int NMEM = 256, DIN = 4096, MEMW = 512;
constexpr int PEER_H = 8, PEER_N = 16384;
constexpr int NWAVES = 8, NTHREADS = NWAVES * 64;
constexpr float EPS = 1e-6f;
constexpr int QA = 0, KA = 768, VA = 1024, QB = 1280, KB = 1792, VB = 2304, QC = 2816, KC = 3584, VC = 3840;
constexpr int OA = 0, OB = 768, OC = 1280;

constexpr size_t MiB = 1u << 20;
constexpr size_t WS_CTL = 0, CTL_ZERO_BYTES = 1 * MiB;
constexpr size_t WS_ROPE = 1 * MiB, WS_BIASA = 1 * MiB + 16384;
constexpr size_t WS_WIN = 2 * MiB, WS_WOUT = 34 * MiB, WS_WMQ = 50 * MiB, WS_WMKV = 54 * MiB, WS_WMO = 62 * MiB, WS_WPQ = 66 * MiB, WS_PKEYS = 82 * MiB;
constexpr size_t WS_MEMN = 84 * MiB, WS_KVM = 116 * MiB, WS_PU = 132 * MiB, WS_PV = 260 * MiB, WS_XN = 388 * MiB, WS_QKV = 516 * MiB, WS_ATT = 772 * MiB;
constexpr size_t WS_QM = 900 * MiB, WS_OM = 932 * MiB, WS_END = 964 * MiB;
constexpr size_t WS_QP = WS_QKV, WS_PIDX = WS_QKV + 128 * MiB, WS_PGATE = WS_QKV + 144 * MiB;
constexpr int CW_BAR = 4096;

constexpr int RING_OFF = 0, RING_BYTES = 131072;
constexpr int LDSCTL_OFF = RING_BYTES, MISC_OFF = LDSCTL_OFF + 320;
constexpr int LDS_BYTES = 147456;

#define GAS __attribute__((address_space(1)))
#define LAS __attribute__((address_space(3)))
typedef unsigned short bf16;
typedef unsigned v4u __attribute__((ext_vector_type(4)));
typedef unsigned v2u __attribute__((ext_vector_type(2)));
typedef float f32x4 __attribute__((ext_vector_type(4)));
typedef float f32x16 __attribute__((ext_vector_type(16)));
typedef short bf16x8 __attribute__((ext_vector_type(8)));
typedef GAS unsigned gu32;
#define LDS_WAIT() asm volatile("s_waitcnt lgkmcnt(0)" ::: "memory")
#define VM_WAIT() asm volatile("s_waitcnt vmcnt(0)" ::: "memory")
__device__ __forceinline__ unsigned f2bf(float f) { unsigned u = __builtin_bit_cast(unsigned, f); return (u + 0x7fffu + ((u >> 16) & 1u)) >> 16; }
__device__ __forceinline__ unsigned pk2(float lo, float hi) { return f2bf(lo) | (f2bf(hi) << 16); }
__device__ __forceinline__ float bflo(unsigned w) { return __builtin_bit_cast(float, w << 16); }
__device__ __forceinline__ float bfhi(unsigned w) { return __builtin_bit_cast(float, w & 0xffff0000u); }

__device__ __forceinline__ float shx(float v, int k, int lane) { return __builtin_bit_cast(float, __builtin_amdgcn_ds_bpermute((lane ^ k) << 2, __builtin_bit_cast(int, v))); }
#define XB_TMO      128
#define XB_XCNT(j)  (256  + 64 * (j))
#define XB_XSUB(j)  (1280 + 64 * (j))
#define XB_XGEN(j)  (2304 + 64 * (j))
#define XB_TOP      3328
#define XB_TOPGEN   3392
#define XCD_BAR_WORDS 3456
#define XB_SPIN_CAP (1u << 18)

__device__ __forceinline__ unsigned xb_ld(unsigned* p)              { return __hip_atomic_load(p, __ATOMIC_RELAXED, __HIP_MEMORY_SCOPE_AGENT); }
__device__ __forceinline__ unsigned xb_add(unsigned* p, unsigned v) { return __hip_atomic_fetch_add(p, v, __ATOMIC_RELAXED, __HIP_MEMORY_SCOPE_AGENT); }
__device__ __forceinline__ unsigned xb_xcc_id() { return (unsigned)__builtin_amdgcn_s_getreg((3 << 11) | 20) & 0xFu; }
#define XB_SPIN(cond, bar) do { unsigned _sp = 0; while (cond) { __builtin_amdgcn_s_sleep(1); \
    if ((++_sp & 255u) == 0u) { if (xb_ld(&(bar)[XB_TMO])) break; if (_sp > XB_SPIN_CAP) { atomicAdd(&(bar)[XB_TMO], 1u); break; } } } } while (0)

struct XcdBarrier {
    unsigned* bar; unsigned x;
    volatile LAS unsigned* st;
};

__device__ __forceinline__ XcdBarrier xcd_barrier_post(unsigned* bar, volatile LAS unsigned* st) {
    XcdBarrier b; b.bar = bar; b.x = xb_xcc_id(); b.st = st;
    if (threadIdx.x == 0) (void)xb_add(&bar[XB_XCNT(b.x)], 1u);
    return b;
}
__device__ __forceinline__ void xcd_barrier_complete(unsigned* bar, unsigned x, unsigned& nloc, unsigned& nx) {
    const unsigned G = gridDim.x * gridDim.y * gridDim.z;
    unsigned sum, cnt, mine, sp = 0u;
    for (;;) {
        sum = 0u; cnt = 0u; mine = 0u;
#pragma unroll
        for (unsigned j = 0; j < 16; ++j) { const unsigned c = xb_ld(&bar[XB_XCNT(j)]); sum += c; cnt += (c > 0u) ? 1u : 0u; mine = (j == x) ? c : mine; }
        if (sum == G) break;
        __builtin_amdgcn_s_sleep(1);
        if ((++sp & 255u) == 0u) { if (xb_ld(&bar[XB_TMO])) break; if (sp > XB_SPIN_CAP) { atomicAdd(&bar[XB_TMO], 1u); break; } }
    }
    nloc = mine > 0u ? mine : 1u; nx = cnt > 0u ? cnt : 1u;
}

__device__ __forceinline__ void xcd_barrier(const XcdBarrier& b) {
    asm volatile("s_waitcnt vmcnt(0)" ::: "memory");
    __syncthreads();
    if (threadIdx.x == 0) {
        unsigned* bar = b.bar;
        __builtin_amdgcn_s_waitcnt(0);
        unsigned nloc = b.st[0], nx = b.st[1];
        if (nloc == 0u) { xcd_barrier_complete(bar, b.x, nloc, nx); b.st[0] = nloc; b.st[1] = nx; }
        const unsigned old = xb_add(&bar[XB_XSUB(b.x)], 1u);
        const unsigned gen = old / nloc;
        if (old + 1u == (gen + 1u) * nloc) {
            __builtin_amdgcn_fence(__ATOMIC_RELEASE, "agent");
            asm volatile("s_waitcnt vmcnt(0)" ::: "memory");
            const unsigned og = xb_add(&bar[XB_TOP], 1u);
            const unsigned tg = og / nx;
            if (og + 1u == (tg + 1u) * nx) xb_add(&bar[XB_TOPGEN], 1u);
            else XB_SPIN(xb_ld(&bar[XB_TOPGEN]) == tg, bar);
            __builtin_amdgcn_fence(__ATOMIC_ACQUIRE, "agent");
            xb_add(&bar[XB_XGEN(b.x)], 1u);
            asm volatile("s_waitcnt vmcnt(0)" ::: "memory");
        } else {
            XB_SPIN(xb_ld(&bar[XB_XGEN(b.x)]) == gen, bar);
            __builtin_amdgcn_fence(__ATOMIC_ACQUIRE, "agent");
            asm volatile("s_waitcnt vmcnt(0)" ::: "memory");
        }
    }
    __syncthreads();
}

__device__ __forceinline__ float wave_sum(float v, int lane) {
#pragma unroll
    for (int o = 1; o < 64; o <<= 1) v += shx(v, o, lane);
    return v;
}
__device__ __forceinline__ void* ldptr(LAS unsigned char* lds, int i) {
    const unsigned long long v = ((const LAS unsigned long long*)(lds + LDSCTL_OFF + 1024))[i];
    const unsigned lo = __builtin_amdgcn_readfirstlane((unsigned)v), hi = __builtin_amdgcn_readfirstlane((unsigned)(v >> 32));
    return (void*)(((unsigned long long)hi << 32) | lo);
}
struct OffsetOrder {
    pg8::StaticOrder S;
    __device__ void init(int M, int N, int G, int c, int off) { S.init(M, N, G, (c + G - off % G) % G); }
    __device__ bool next(int i, pg8::Unit& u) const { return S.next(i, u); }
    __device__ __forceinline__ void a_ready(const pg8::Unit&) const {}
    __device__ __forceinline__ void done(const pg8::Unit&) const {}
};

template <bool PERMQKV>
__device__ __forceinline__ void transpose_item(const float* W, int K, int N, bf16* WT, LAS float* scr, int item, int lane) {
    const int nblk = N / 32, kb = item / nblk, nb = item % nblk, k0 = 64 * kb, n0 = 32 * nb;
    int d0 = n0;
    if (PERMQKV) { const int within = n0 & 255; d0 = (n0 & ~255) + 128 * ((within >> 5) & 1) + 32 * (within >> 6); }
#pragma unroll 8
    for (int i = 0; i < 32; ++i) { const int kk = 2 * i + (lane >> 5); scr[kk * 33 + (lane & 31)] = W[(size_t)(k0 + kk) * N + n0 + (lane & 31)]; }
    LDS_WAIT(); asm volatile("" ::: "memory");
    const int c = lane & 7;
#pragma unroll
    for (int j = 0; j < 4; ++j) { const int n = (lane >> 3) + 8 * j; const LAS float* s = scr + (8 * c) * 33 + n;
        v4u o; o.x = pk2(s[0 * 33], s[1 * 33]); o.y = pk2(s[2 * 33], s[3 * 33]); o.z = pk2(s[4 * 33], s[5 * 33]); o.w = pk2(s[6 * 33], s[7 * 33]);
        *(GAS v4u*)(WT + (size_t)(d0 + n) * K + k0 + 8 * c) = o; }
    LDS_WAIT(); asm volatile("" ::: "memory");
}
__device__ __forceinline__ void convert_bf16(const float* src, bf16* dst, size_t n, size_t gtid, size_t nthreads) {
    for (size_t i = gtid * 8; i < n; i += nthreads * 8) {
        const f32x4 a = *(const GAS f32x4*)(src + i), b = *(const GAS f32x4*)(src + i + 4);
        v4u o; o.x = pk2(a[0], a[1]); o.y = pk2(a[2], a[3]); o.z = pk2(b[0], b[1]); o.w = pk2(b[2], b[3]);
        *(GAS v4u*)(dst + i) = o;
    }
}
__device__ __forceinline__ int t5_bucket(int rel) {
    const int n = rel < 0 ? -rel : rel;
    const int b = n < 8 ? n : n < 12 ? 8 : n < 16 ? 9 : n < 23 ? 10 : n < 32 ? 11 : n < 46 ? 12 : n < 64 ? 13 : n < 91 ? 14 : 15;
    return b + (rel > 0 ? 16 : 0);
}
__constant__ float ROPE_INV[16] = {1.000000000e+00f, 5.623413324e-01f, 3.162277639e-01f, 1.778279394e-01f, 1.000000015e-01f, 5.623413250e-02f, 3.162277490e-02f, 1.778279431e-02f,
                                   9.999999776e-03f, 5.623413250e-03f, 3.162277630e-03f, 1.778279431e-03f, 1.000000047e-03f, 5.623413017e-04f, 3.162277571e-04f, 1.778279402e-04f};

__device__ __forceinline__ void rms_row_to_bf16(const float* xrow, const float* g0, bf16* o0, const float* g1, bf16* o1, int lane) {
    const GAS f32x4* xr = (const GAS f32x4*)xrow + lane;
    f32x4 v[8]; float s = 0.f;
#pragma unroll
    for (int j = 0; j < 8; ++j) { v[j] = xr[64 * j]; s += (v[j].x * v[j].x + v[j].y * v[j].y) + (v[j].z * v[j].z + v[j].w * v[j].w); }
    const float rstd = 1.f / sqrtf(wave_sum(s, lane) * (1.f / DM) + EPS);
    {   const GAS f32x4* gr = (const GAS f32x4*)g0 + lane; GAS v2u* o8 = (GAS v2u*)o0 + lane;
#pragma unroll
        for (int j = 0; j < 8; ++j) { const f32x4 gg = gr[64 * j]; v2u w; w.x = pk2(v[j].x * rstd * gg.x, v[j].y * rstd * gg.y); w.y = pk2(v[j].z * rstd * gg.z, v[j].w * rstd * gg.w); o8[64 * j] = w; } }
    if (g1) { const GAS f32x4* gr = (const GAS f32x4*)g1 + lane; GAS v2u* o8 = (GAS v2u*)o1 + lane;
#pragma unroll
        for (int j = 0; j < 8; ++j) { const f32x4 gg = gr[64 * j]; v2u w; w.x = pk2(v[j].x * rstd * gg.x, v[j].y * rstd * gg.y); w.y = pk2(v[j].z * rstd * gg.z, v[j].w * rstd * gg.w); o8[64 * j] = w; } }
}
__device__ __forceinline__ void norm_rows(const float* X, const float* g, bf16* XN, int gw, int NGW, int lane) {
    for (int m = gw; m < T; m += NGW) rms_row_to_bf16(X + (size_t)m * DM, g, XN + (size_t)m * DM, nullptr, nullptr, lane);
}

template <int TYPE>
__device__ __forceinline__ void naive_attn_item(const bf16* QKV, bf16* ATT, int b, int grow, int head, int lane, const float* biasA, const float* sink, const float* rpb) {
    const int tpos = grow * 64 + lane; const size_t trow = (size_t)b * SEQ + tpos;
    int qcol, kcol, vcol, ocol;
    if (TYPE == 0) { qcol = QA + head * 64; kcol = KA + (head / 3) * 64; vcol = VA + (head / 3) * 64; ocol = OA + head * 64; }
    else if (TYPE == 1) { qcol = QB + head * 64; kcol = KB + head * 64; vcol = VB + head * 64; ocol = OB + head * 64; }
    else { qcol = QC + head * 64; kcol = KC + (head / 3) * 64; vcol = VC + (head / 3) * 64; ocol = OC + head * 64; }
    float q[64], o[64];
#pragma unroll
    for (int c = 0; c < 8; ++c) { const v4u w = *(const GAS v4u*)(QKV + trow * DIN + qcol + 8 * c);
        q[8 * c + 0] = bflo(w.x); q[8 * c + 1] = bfhi(w.x); q[8 * c + 2] = bflo(w.y); q[8 * c + 3] = bfhi(w.y); q[8 * c + 4] = bflo(w.z); q[8 * c + 5] = bfhi(w.z); q[8 * c + 6] = bflo(w.w); q[8 * c + 7] = bfhi(w.w); }
#pragma unroll
    for (int d = 0; d < 64; ++d) o[d] = 0.f;
    float m = -1e30f, l = 0.f;
    int j0, j1;
    if (TYPE == 0) { j0 = grow * 64 - 128; if (j0 < 0) j0 = 0; j1 = grow * 64 + 63 + 128; if (j1 > SEQ - 1) j1 = SEQ - 1; }
    else if (TYPE == 1) { int r0 = grow - 4; r0 = r0 < 0 ? 0 : (r0 > 24 ? 24 : r0); j0 = r0 * 64; j1 = j0 + 511; }
    else { j0 = 0; j1 = SEQ - 1; }
    int c0 = lane - 8; c0 = c0 < 0 ? 0 : (c0 > 48 ? 48 : c0);
#pragma unroll 1
    for (int j = j0; j <= j1; ++j) {
        const bf16* krow = QKV + ((size_t)b * SEQ + j) * DIN;
        float s = 0.f;
#pragma unroll
        for (int c = 0; c < 8; ++c) { const v4u w = *(const GAS v4u*)(krow + kcol + 8 * c);
            s += q[8 * c + 0] * bflo(w.x) + q[8 * c + 1] * bfhi(w.x) + q[8 * c + 2] * bflo(w.y) + q[8 * c + 3] * bfhi(w.y) + q[8 * c + 4] * bflo(w.z) + q[8 * c + 5] * bfhi(w.z) + q[8 * c + 6] * bflo(w.w) + q[8 * c + 7] * bfhi(w.w); }
        bool valid = true;
        if (TYPE == 0) { const int rel = j - tpos; valid = (rel >= -128 && rel <= 128); if (valid) s += biasA[head * 257 + rel + 128]; }
        if (TYPE == 1) { const int kr = j >> 6, kc = j & 63; valid = (kc >= c0 && kc < c0 + 16); if (valid) s += rpb[(head * 15 + (kr - grow + 7)) * 31 + (kc - lane + 15)]; }
        const float mn = valid ? fmaxf(m, s) : m;
        const float a = __expf(m - mn);
        const float p = valid ? __expf(s - mn) : 0.f;
        l = l * a + p; m = mn;
#pragma unroll
        for (int c = 0; c < 8; ++c) { const v4u w = *(const GAS v4u*)(krow + vcol + 8 * c);
            o[8 * c + 0] = o[8 * c + 0] * a + p * bflo(w.x); o[8 * c + 1] = o[8 * c + 1] * a + p * bfhi(w.x); o[8 * c + 2] = o[8 * c + 2] * a + p * bflo(w.y); o[8 * c + 3] = o[8 * c + 3] * a + p * bfhi(w.y);
            o[8 * c + 4] = o[8 * c + 4] * a + p * bflo(w.z); o[8 * c + 5] = o[8 * c + 5] * a + p * bfhi(w.z); o[8 * c + 6] = o[8 * c + 6] * a + p * bflo(w.w); o[8 * c + 7] = o[8 * c + 7] * a + p * bfhi(w.w); }
    }
    if (TYPE == 0) l += __expf(sink[head] - m);
    const float inv = 1.f / l;
#pragma unroll
    for (int c = 0; c < 8; ++c) { v4u w; w.x = pk2(o[8 * c + 0] * inv, o[8 * c + 1] * inv); w.y = pk2(o[8 * c + 2] * inv, o[8 * c + 3] * inv); w.z = pk2(o[8 * c + 4] * inv, o[8 * c + 5] * inv); w.w = pk2(o[8 * c + 6] * inv, o[8 * c + 7] * inv);
        *(GAS v4u*)(ATT + trow * DM + ocol + 8 * c) = w; }
}
__device__ __forceinline__ float rdl(float v, int l) { return __builtin_bit_cast(float, __builtin_amdgcn_readlane(__builtin_bit_cast(int, v), l)); }
__device__ __forceinline__ void naive_mem_item(const bf16* QM, const bf16* KVM, bf16* OM, const float* gq, size_t trow, int b, int head, int lane) {
    const unsigned qw = *(const GAS unsigned*)(QM + trow * MEMW + head * 128 + 2 * lane);
    float q0 = bflo(qw), q1 = bfhi(qw);
    const float ss = wave_sum(q0 * q0 + q1 * q1, lane);
    const float r = 0.08838834764831845f / sqrtf(ss * (1.f / 128.f) + EPS);
    q0 *= r * gq[2 * lane]; q1 *= r * gq[2 * lane + 1];
    const bf16* kbase = KVM + ((size_t)b * NMEM + lane) * 1024 + head * 128;
    float s[4] = {0.f, 0.f, 0.f, 0.f};
#pragma unroll 1
    for (int c = 0; c < 16; ++c) {
        float qa[8];
#pragma unroll
        for (int e = 0; e < 4; ++e) { qa[2 * e] = rdl(q0, 4 * c + e); qa[2 * e + 1] = rdl(q1, 4 * c + e); }
#pragma unroll
        for (int i = 0; i < 4; ++i) { const v4u w = *(const GAS v4u*)(kbase + (size_t)i * 64 * 1024 + 8 * c);
            s[i] += qa[0] * bflo(w.x) + qa[1] * bfhi(w.x) + qa[2] * bflo(w.y) + qa[3] * bfhi(w.y) + qa[4] * bflo(w.z) + qa[5] * bfhi(w.z) + qa[6] * bflo(w.w) + qa[7] * bfhi(w.w); }
    }
    float m = fmaxf(fmaxf(s[0], s[1]), fmaxf(s[2], s[3]));
#pragma unroll
    for (int o = 1; o < 64; o <<= 1) m = fmaxf(m, shx(m, o, lane));
    float p[4]; float l = 0.f;
#pragma unroll
    for (int i = 0; i < 4; ++i) { p[i] = __expf(s[i] - m); l += p[i]; }
    l = wave_sum(l, lane);
    const bf16* vbase = KVM + ((size_t)b * NMEM) * 1024 + 512 + head * 128 + 2 * lane;
    float o0 = 0.f, o1 = 0.f;
#pragma unroll
    for (int i = 0; i < 4; ++i) {
#pragma unroll 4
        for (int jj = 0; jj < 64; ++jj) { const float pj = rdl(p[i], jj); const unsigned w = *(const GAS unsigned*)(vbase + (size_t)(64 * i + jj) * 1024); o0 += pj * bflo(w); o1 += pj * bfhi(w); }
    }
    const float inv = 1.f / l;
    *(GAS unsigned*)(OM + trow * MEMW + head * 128 + 2 * lane) = pk2(o0 * inv, o1 * inv);
}
__device__ __forceinline__ void mixnorm_rows(bf16* ATT, const float* g, int gw, int NGW, int lane) {
    for (int m = gw; m < T; m += NGW) {
        GAS v4u* p = (GAS v4u*)(ATT + (size_t)m * DM + 32 * lane);
        v4u w[4]; float f[32]; float ss = 0.f;
#pragma unroll
        for (int c = 0; c < 4; ++c) { w[c] = p[c];
            f[8 * c + 0] = bflo(w[c].x); f[8 * c + 1] = bfhi(w[c].x); f[8 * c + 2] = bflo(w[c].y); f[8 * c + 3] = bfhi(w[c].y); f[8 * c + 4] = bflo(w[c].z); f[8 * c + 5] = bfhi(w[c].z); f[8 * c + 6] = bflo(w[c].w); f[8 * c + 7] = bfhi(w[c].w); }
#pragma unroll
        for (int i = 0; i < 32; ++i) ss += f[i] * f[i];
        const int grp = lane < 24 ? 0 : (lane < 40 ? 1 : 2);
        const float sa = wave_sum(grp == 0 ? ss : 0.f, lane), sb = wave_sum(grp == 1 ? ss : 0.f, lane), sc = wave_sum(grp == 2 ? ss : 0.f, lane);
        const float r = grp == 0 ? 1.f / sqrtf(sa * (1.f / 768.f) + EPS) : (grp == 1 ? 1.f / sqrtf(sb * (1.f / 512.f) + EPS) : 1.f / sqrtf(sc * (1.f / 768.f) + EPS));
        const float* gg = g + 32 * lane;
#pragma unroll
        for (int c = 0; c < 4; ++c) { const f32x4 g0 = *(const GAS f32x4*)(gg + 8 * c), g1 = *(const GAS f32x4*)(gg + 8 * c + 4);
            v4u o; o.x = pk2(f[8 * c + 0] * r * g0[0], f[8 * c + 1] * r * g0[1]); o.y = pk2(f[8 * c + 2] * r * g0[2], f[8 * c + 3] * r * g0[3]);
            o.z = pk2(f[8 * c + 4] * r * g1[0], f[8 * c + 5] * r * g1[1]); o.w = pk2(f[8 * c + 6] * r * g1[2], f[8 * c + 7] * r * g1[3]); p[c] = o; }
    }
}

#ifndef PEER_HD
#define PEER_HD __device__ __forceinline__
#define PEER_EXP(x) __expf(x)
#endif
template <int N> PEER_HD void bitonic_sort_desc(float* v) {
#pragma unroll
    for (int k = 2; k <= N; k <<= 1)
#pragma unroll
        for (int j = k >> 1; j > 0; j >>= 1)
#pragma unroll
            for (int i = 0; i < N; ++i) { const int l = i ^ j; if (l > i) { const bool desc = ((i & k) == 0); const float a = v[i], b = v[l]; const float hi = fmaxf(a, b), lo = fminf(a, b);
                v[i] = desc ? hi : lo; v[l] = desc ? lo : hi; } }
}
PEER_HD void merge_top16(float* a, const float* b) {
    float c[16];
#pragma unroll
    for (int i = 0; i < 16; ++i) c[i] = fmaxf(a[i], b[15 - i]);
#pragma unroll
    for (int j = 8; j > 0; j >>= 1)
#pragma unroll
        for (int i = 0; i < 16; ++i) { const int l = i ^ j; if (l > i) { const float x = c[i], y = c[l]; c[i] = fmaxf(x, y); c[l] = fminf(x, y); } }
#pragma unroll
    for (int i = 0; i < 16; ++i) a[i] = c[i];
}
PEER_HD void top16_of_64(float (&v)[64]) {
    bitonic_sort_desc<16>(&v[0]); bitonic_sort_desc<16>(&v[16]); bitonic_sort_desc<16>(&v[32]); bitonic_sort_desc<16>(&v[48]);
    merge_top16(&v[0], &v[16]); merge_top16(&v[32], &v[48]); merge_top16(&v[0], &v[32]);
}
PEER_HD float pack_idx(float s, unsigned idx, unsigned mask) { return __builtin_bit_cast(float, (__builtin_bit_cast(unsigned, s) & ~mask) | idx); }
PEER_HD unsigned low_bits(float s, unsigned mask) { return __builtin_bit_cast(unsigned, s) & mask; }
PEER_HD unsigned pick16(const float* a, unsigned i, unsigned mask) {
    unsigned r = 0;
#pragma unroll
    for (unsigned k = 0; k < 16; ++k) r = (i == k) ? low_bits(a[k], mask) : r;
    return r;
}
PEER_HD void peer_candidates(const float* a, const float* b, int* e, float* gate) {
    float c[64]; int n = 0;
#pragma unroll
    for (int i = 0; i < 16; ++i)
#pragma unroll
        for (int j = 0; j < 16; ++j) if ((i + 1) * (j + 1) <= 16) { c[n] = pack_idx(a[i] + b[j], (unsigned)(i * 16 + j), 0xffu); ++n; }
#pragma unroll
    for (int k = 50; k < 64; ++k) c[k] = -3.0e38f;
    top16_of_64(c);
    float mx = c[0], den = 0.f;
#pragma unroll
    for (int k = 0; k < 16; ++k) { const unsigned id = low_bits(c[k], 0xffu); const unsigned n0 = pick16(a, id >> 4, 0x7fu), n1 = pick16(b, id & 15u, 0x7fu);
        e[k] = (int)(n0 * 128u + n1); gate[k] = PEER_EXP(c[k] - mx); den += gate[k]; }
    const float inv = 1.f / den;
#pragma unroll
    for (int k = 0; k < 16; ++k) gate[k] *= inv;
}

__device__ __forceinline__ void peer_select_unit(const bf16* QP, const bf16* PK, int* PIDX, float* PGATE, int tb, int h, int wave, int lane) {
    const int hh = lane >> 5, tl = lane & 31; const size_t t = (size_t)tb * 256 + wave * 32 + tl;
    float ab[2][16];
#pragma unroll
    for (int p = 0; p < 2; ++p) {
        bf16x8 bq[8];
#pragma unroll
        for (int s = 0; s < 8; ++s) bq[s] = *(const GAS bf16x8*)(QP + t * DM + 256 * h + 128 * p + 16 * s + 8 * hh);
        float v[64];
#pragma unroll
        for (int nb = 0; nb < 4; ++nb) {
            f32x16 acc;
#pragma unroll
            for (int r = 0; r < 16; ++r) acc[r] = 0.f;
            const bf16* kp = PK + ((size_t)((h * 2 + p) * 128 + 32 * nb + tl)) * 128 + 8 * hh;
#pragma unroll
            for (int s = 0; s < 8; ++s) { const bf16x8 ak = *(const GAS bf16x8*)(kp + 16 * s); acc = __builtin_amdgcn_mfma_f32_32x32x16_bf16(ak, bq[s], acc, 0, 0, 0); }
#pragma unroll
            for (int r = 0; r < 16; ++r) v[16 * nb + r] = pack_idx(acc[r], (unsigned)(32 * nb + 8 * (r >> 2) + 4 * hh + (r & 3)), 0x7fu);
        }
        top16_of_64(v);
        float pv[16];
#pragma unroll
        for (int i = 0; i < 16; ++i) pv[i] = shx(v[i], 32, lane);
        merge_top16(&v[0], pv);
#pragma unroll
        for (int i = 0; i < 16; ++i) ab[p][i] = v[i];
    }
    int e[16]; float gate[16];
    peer_candidates(ab[0], ab[1], e, gate);
    if (hh == 0) { GAS v4u* o = (GAS v4u*)(PIDX + t * 128 + h * 16);
#pragma unroll
        for (int c = 0; c < 4; ++c) o[c] = (v4u){(unsigned)e[4 * c], (unsigned)e[4 * c + 1], (unsigned)e[4 * c + 2], (unsigned)e[4 * c + 3]}; }
    else { GAS f32x4* o = (GAS f32x4*)(PGATE + t * 128 + h * 16);
#pragma unroll
        for (int c = 0; c < 4; ++c) o[c] = (f32x4){gate[4 * c], gate[4 * c + 1], gate[4 * c + 2], gate[4 * c + 3]}; }
}

__device__ __forceinline__ float dot8(const v4u& x, const v4u& u) {
    return bflo(x.x) * bflo(u.x) + bfhi(x.x) * bfhi(u.x) + bflo(x.y) * bflo(u.y) + bfhi(x.y) * bfhi(u.y) + bflo(x.z) * bflo(u.z) + bfhi(x.z) * bfhi(u.z) + bflo(x.w) * bflo(u.w) + bfhi(x.w) * bfhi(u.w);
}
__device__ __forceinline__ void axpy8(float* y, float w, const v4u& v) {
    y[0] += w * bflo(v.x); y[1] += w * bfhi(v.x); y[2] += w * bflo(v.y); y[3] += w * bfhi(v.y); y[4] += w * bflo(v.z); y[5] += w * bfhi(v.z); y[6] += w * bflo(v.w); y[7] += w * bfhi(v.w);
}
__device__ __forceinline__ void peer_gather(const bf16* XN, const bf16* PU, const bf16* PV, const int* PIDX, const float* PGATE, float* X, int gw, int NGW, int lane) {
    for (int t = gw; t < T; t += NGW) {
        v4u xv[4];
#pragma unroll
        for (int j = 0; j < 4; ++j) xv[j] = *(const GAS v4u*)(XN + (size_t)t * DM + 8 * lane + 512 * j);
        float y[32];
#pragma unroll
        for (int i = 0; i < 32; ++i) y[i] = 0.f;
        for (int k = 0; k < 128; k += 2) {
            const int e0 = __builtin_amdgcn_readfirstlane(PIDX[(size_t)t * 128 + k]), e1 = __builtin_amdgcn_readfirstlane(PIDX[(size_t)t * 128 + k + 1]);
            const float g0 = PGATE[(size_t)t * 128 + k], g1 = PGATE[(size_t)t * 128 + k + 1];
            v4u u0[4], u1[4], v0[4], v1[4];
#pragma unroll
            for (int j = 0; j < 4; ++j) { u0[j] = *(const GAS v4u*)(PU + (size_t)e0 * DM + 8 * lane + 512 * j); u1[j] = *(const GAS v4u*)(PU + (size_t)e1 * DM + 8 * lane + 512 * j); }
#pragma unroll
            for (int j = 0; j < 4; ++j) { v0[j] = *(const GAS v4u*)(PV + (size_t)e0 * DM + 8 * lane + 512 * j); v1[j] = *(const GAS v4u*)(PV + (size_t)e1 * DM + 8 * lane + 512 * j); }
            float d0 = 0.f, d1 = 0.f;
#pragma unroll
            for (int j = 0; j < 4; ++j) { d0 += dot8(xv[j], u0[j]); d1 += dot8(xv[j], u1[j]); }
            d0 = wave_sum(d0, lane); d1 = wave_sum(d1, lane);
            const float w0 = g0 * 0.5f * d0 * (1.f + erff(d0 * 0.70710678118654752f)), w1 = g1 * 0.5f * d1 * (1.f + erff(d1 * 0.70710678118654752f));
#pragma unroll
            for (int j = 0; j < 4; ++j) { axpy8(&y[8 * j], w0, v0[j]); axpy8(&y[8 * j], w1, v1[j]); }
        }
#pragma unroll
        for (int j = 0; j < 4; ++j) { GAS f32x4* xp = (GAS f32x4*)(X + (size_t)t * DM + 8 * lane + 512 * j);
            f32x4 a = xp[0], b = xp[1]; a += (f32x4){y[8 * j], y[8 * j + 1], y[8 * j + 2], y[8 * j + 3]}; b += (f32x4){y[8 * j + 4], y[8 * j + 5], y[8 * j + 6], y[8 * j + 7]}; xp[0] = a; xp[1] = b; }
    }
}


typedef float f32x2 __attribute__((ext_vector_type(2)));
constexpr float PU_SCALE = 256.f, PV_SCALE = 16.f;
__device__ __forceinline__ void convert_fp8(const float* src, unsigned char* dst, size_t n, float scale, size_t gtid, size_t nthreads) {
    for (size_t i = gtid * 16; i < n; i += nthreads * 16) {
        v4u o;
#pragma unroll
        for (int c = 0; c < 4; ++c) { f32x4 a = *(const GAS f32x4*)(src + i + 4 * c) * scale;
#pragma unroll
            for (int e = 0; e < 4; ++e) a[e] = fminf(fmaxf(a[e], -448.f), 448.f);
            int p = 0; p = __builtin_amdgcn_cvt_pk_fp8_f32(a[0], a[1], p, false); p = __builtin_amdgcn_cvt_pk_fp8_f32(a[2], a[3], p, true); o[c] = (unsigned)p; }
        *(GAS v4u*)(dst + i) = o;
    }
}
__device__ __forceinline__ void dot16_fp8(f32x2& acc, const v4u& w, const f32x2* x) {
#pragma unroll
    for (int c = 0; c < 4; ++c) { acc += __builtin_amdgcn_cvt_pk_f32_fp8((int)w[c], false) * x[2 * c]; acc += __builtin_amdgcn_cvt_pk_f32_fp8((int)w[c], true) * x[2 * c + 1]; }
}
__device__ __forceinline__ void axpy16_fp8(f32x2* y, const f32x2 wv, const v4u& w) {
#pragma unroll
    for (int c = 0; c < 4; ++c) { y[2 * c] += __builtin_amdgcn_cvt_pk_f32_fp8((int)w[c], false) * wv; y[2 * c + 1] += __builtin_amdgcn_cvt_pk_f32_fp8((int)w[c], true) * wv; }
}
#define PG_R 4
#define PG_LOAD(buf, tab, idlo, idhi, g) do { _Pragma("unroll") for (int i_ = 0; i_ < PG_R; ++i_) { const int k_ = (g) * PG_R + i_; \
        const int e_ = __builtin_amdgcn_readlane(k_ < 64 ? idlo : idhi, k_ & 63); const unsigned char* rp_ = (tab) + (size_t)(unsigned)e_ * 2048u; \
        buf[i_][0] = *(const GAS v4u*)(rp_ + voff); buf[i_][1] = *(const GAS v4u*)(rp_ + voff + 1024); } } while (0)
#define PG_DOT(buf, g) do { float p_[4]; _Pragma("unroll") for (int i_ = 0; i_ < 4; ++i_) { f32x2 a_ = {0.f, 0.f}; dot16_fp8(a_, buf[i_][0], &x[0]); dot16_fp8(a_, buf[i_][1], &x[8]); p_[i_] = a_.x + a_.y; __builtin_amdgcn_sched_barrier(0); } \
        float r_[2]; _Pragma("unroll") for (int i_ = 0; i_ < 2; ++i_) { const float keep_ = b5 ? p_[i_ + 2] : p_[i_], send_ = b5 ? p_[i_] : p_[i_ + 2]; r_[i_] = keep_ + shx(send_, 32, lane); } \
        float s_; { const float keep_ = b4 ? r_[1] : r_[0], send_ = b4 ? r_[0] : r_[1]; s_ = keep_ + shx(send_, 16, lane); } \
        s_ += shx(s_, 8, lane); s_ += shx(s_, 4, lane); s_ += shx(s_, 2, lane); s_ += shx(s_, 1, lane); \
        if ((lane & 15) == 0) wl[(g) * 4 + (lane >> 4)] = s_; } while (0)
#define PG_AXPY(buf, g) do { _Pragma("unroll") for (int i_ = 0; i_ < PG_R; ++i_) { const float w_ = wl[(g) * PG_R + i_]; const f32x2 wv_ = {w_, w_}; axpy16_fp8(&y[0], wv_, buf[i_][0]); axpy16_fp8(&y[8], wv_, buf[i_][1]); __builtin_amdgcn_sched_barrier(0); } } while (0)
__device__ __forceinline__ void peer_gather8(const bf16* XN, const unsigned char* PU8, const unsigned char* PV8, const int* PIDX, const float* PGATE, float* X, LAS float* wl, int gw, int NGW, int lane) {
    const bool b5 = (lane >> 5) & 1, b4 = (lane >> 4) & 1; const unsigned voff = 16u * (unsigned)lane;
    for (int t = gw; t < T; t += NGW) {
        const unsigned l4 = 4u * (unsigned)lane; const char* pidx_t = (const char*)(PIDX + (size_t)t * 128); const char* pgate_t = (const char*)(PGATE + (size_t)t * 128);
        const int idlo = *(const GAS int*)(pidx_t + l4), idhi = *(const GAS int*)(pidx_t + l4 + 256);
        v4u A[PG_R][2], B[PG_R][2];
        PG_LOAD(A, PU8, idlo, idhi, 0);
        f32x2 x[16];
        {   const char* xr = (const char*)(XN + (size_t)t * DM); const unsigned l32 = 32u * (unsigned)lane;
            const v4u a0 = *(const GAS v4u*)(xr + l32), a1 = *(const GAS v4u*)(xr + l32 + 16), c0 = *(const GAS v4u*)(xr + l32 + 2048), c1 = *(const GAS v4u*)(xr + l32 + 2064);
#pragma unroll
            for (int c = 0; c < 4; ++c) { x[c] = (f32x2){bflo(a0[c]), bfhi(a0[c])} * (1.f / PU_SCALE); x[4 + c] = (f32x2){bflo(a1[c]), bfhi(a1[c])} * (1.f / PU_SCALE);
                                          x[8 + c] = (f32x2){bflo(c0[c]), bfhi(c0[c])} * (1.f / PU_SCALE); x[12 + c] = (f32x2){bflo(c1[c]), bfhi(c1[c])} * (1.f / PU_SCALE); } }
#pragma unroll 1
        for (int g = 0; g < 128 / PG_R; g += 2) {
            PG_LOAD(B, PU8, idlo, idhi, g + 1);
            PG_DOT(A, g);
            if (g + 2 < 128 / PG_R) PG_LOAD(A, PU8, idlo, idhi, g + 2); else PG_LOAD(A, PV8, idlo, idhi, 0);
            PG_DOT(B, g + 1);
        }
        LDS_WAIT();
        {
            const float g0 = *(const GAS float*)(pgate_t + l4), g1 = *(const GAS float*)(pgate_t + l4 + 256);
            const float d0 = wl[lane], d1 = wl[64 + lane];
            const float w0 = g0 * 0.5f * d0 * (1.f + erff(d0 * 0.70710678118654752f)) * (1.f / PV_SCALE), w1 = g1 * 0.5f * d1 * (1.f + erff(d1 * 0.70710678118654752f)) * (1.f / PV_SCALE);
            LDS_WAIT(); asm volatile("" ::: "memory");
            wl[lane] = w0; wl[64 + lane] = w1;
            LDS_WAIT(); asm volatile("" ::: "memory");
        }
        f32x2 y[16];
#pragma unroll
        for (int i = 0; i < 16; ++i) y[i] = (f32x2){0.f, 0.f};
#pragma unroll 1
        for (int g = 0; g < 128 / PG_R; g += 2) {
            PG_LOAD(B, PV8, idlo, idhi, g + 1);
            PG_AXPY(A, g);
            if (g + 2 < 128 / PG_R) PG_LOAD(A, PV8, idlo, idhi, g + 2);
            PG_AXPY(B, g + 1);
        }
        {   char* xo = (char*)(X + (size_t)t * DM); const unsigned l64 = 64u * (unsigned)lane;
#pragma unroll
            for (int h = 0; h < 2; ++h)
#pragma unroll
                for (int c = 0; c < 4; ++c) { GAS f32x4* p = (GAS f32x4*)(xo + l64 + 4096 * h + 16 * c); f32x4 v = *p; v += (f32x4){y[8 * h + 2 * c].x, y[8 * h + 2 * c].y, y[8 * h + 2 * c + 1].x, y[8 * h + 2 * c + 1].y}; *p = v; } }
        LDS_WAIT(); asm volatile("" ::: "memory");
    }
}


typedef unsigned v6u __attribute__((ext_vector_type(6)));
typedef float v32f __attribute__((ext_vector_type(32)));
typedef v4u __attribute__((aligned(8))) v4u_a8;
constexpr float PU_SCALE6 = 90.0f, PV_SCALE6 = 5.65f;
__device__ __forceinline__ unsigned enc_e2m3(float v) {
    const float a = fminf(fabsf(v), 7.5f);
    unsigned code;
    if (a < 1.0f) code = (unsigned)__builtin_rintf(a * 8.f);
    else { const unsigned b = __builtin_bit_cast(unsigned, a) - 0x3F800000u; code = ((b + 0x7FFFFu + ((b >> 20) & 1u)) >> 20) + 8u; }
    return code | (v < 0.f ? 32u : 0u);
}
__device__ __forceinline__ void convert_fp6_rows(const float* src, unsigned char* dst, int nrows, float scale, int gw, int NGW, int lane) {
    for (int r = gw; r < nrows; r += NGW) {
        const float* sp = src + (size_t)r * DM + 4 * lane;
        unsigned w[6] = {0u, 0u, 0u, 0u, 0u, 0u};
#pragma unroll
        for (int j = 0; j < 8; ++j) { const f32x4 a = *(const GAS f32x4*)(sp + 256 * j) * scale;
#pragma unroll
            for (int e = 0; e < 4; ++e) { const unsigned code = enc_e2m3(a[e]); const int bp = 6 * (4 * j + e), wi = bp >> 5, sh = bp & 31;
                w[wi] |= code << sh; if (sh > 26) w[wi + 1] |= code >> (32 - sh); } }
        unsigned char* dp = dst + (size_t)r * 1536 + 24 * lane;
        *(GAS v4u_a8*)dp = (v4u){w[0], w[1], w[2], w[3]}; *(GAS v2u*)(dp + 16) = (v2u){w[4], w[5]};
    }
}
#ifndef PG6_R
#define PG6_R 8
#endif
#define PG6_LOAD(buf, tab, idlo, idhi, g) do { _Pragma("unroll") for (int i_ = 0; i_ < PG6_R; ++i_) { const int k_ = (g) * PG6_R + i_; \
        const int e_ = __builtin_amdgcn_readlane(k_ < 64 ? idlo : idhi, k_ & 63); const unsigned char* rp_ = (tab) + (size_t)(unsigned)e_ * 1536u; \
        const v4u a_ = *(const GAS v4u_a8*)(rp_ + voff); const v2u b_ = *(const GAS v2u*)(rp_ + voff + 16); buf[i_] = (v6u){a_.x, a_.y, a_.z, a_.w, b_.x, b_.y}; } } while (0)
#define PG6_DOT1(buf, i_, dst) do { const v32f f_ = __builtin_amdgcn_cvt_scalef32_pk32_f32_fp6(buf[i_], 1.0f); f32x2 a_ = {0.f, 0.f}; \
        _Pragma("unroll") for (int c_ = 0; c_ < 16; ++c_) a_ += (f32x2){f_[2 * c_], f_[2 * c_ + 1]} * x[c_]; dst = a_.x + a_.y; __builtin_amdgcn_sched_barrier(0); } while (0)
#if PG6_R == 8
#define PG6_DOT(buf, g) do { float p_[8]; _Pragma("unroll") for (int i_ = 0; i_ < 8; ++i_) PG6_DOT1(buf, i_, p_[i_]); \
        float q_[4]; _Pragma("unroll") for (int i_ = 0; i_ < 4; ++i_) { const float keep_ = b5 ? p_[i_ + 4] : p_[i_], send_ = b5 ? p_[i_] : p_[i_ + 4]; q_[i_] = keep_ + shx(send_, 32, lane); } \
        float r_[2]; _Pragma("unroll") for (int i_ = 0; i_ < 2; ++i_) { const float keep_ = b4 ? q_[i_ + 2] : q_[i_], send_ = b4 ? q_[i_] : q_[i_ + 2]; r_[i_] = keep_ + shx(send_, 16, lane); } \
        float s_; { const float keep_ = b3 ? r_[1] : r_[0], send_ = b3 ? r_[0] : r_[1]; s_ = keep_ + shx(send_, 8, lane); } \
        s_ += shx(s_, 4, lane); s_ += shx(s_, 2, lane); s_ += shx(s_, 1, lane); \
        if ((lane & 7) == 0) wl[(g) * 8 + (lane >> 3)] = s_; } while (0)
#else
#define PG6_DOT(buf, g) do { float p_[4]; _Pragma("unroll") for (int i_ = 0; i_ < 4; ++i_) PG6_DOT1(buf, i_, p_[i_]); \
        float r_[2]; _Pragma("unroll") for (int i_ = 0; i_ < 2; ++i_) { const float keep_ = b5 ? p_[i_ + 2] : p_[i_], send_ = b5 ? p_[i_] : p_[i_ + 2]; r_[i_] = keep_ + shx(send_, 32, lane); } \
        float s_; { const float keep_ = b4 ? r_[1] : r_[0], send_ = b4 ? r_[0] : r_[1]; s_ = keep_ + shx(send_, 16, lane); } \
        s_ += shx(s_, 8, lane); s_ += shx(s_, 4, lane); s_ += shx(s_, 2, lane); s_ += shx(s_, 1, lane); \
        if ((lane & 15) == 0) wl[(g) * 4 + (lane >> 4)] = s_; } while (0)
#endif
#define PG6_AXPY(buf, g) do { _Pragma("unroll") for (int i_ = 0; i_ < PG6_R; ++i_) { const float w_ = wl[(g) * PG6_R + i_]; const f32x2 wv_ = {w_, w_}; \
        const v32f f_ = __builtin_amdgcn_cvt_scalef32_pk32_f32_fp6(buf[i_], 1.0f); _Pragma("unroll") for (int c_ = 0; c_ < 16; ++c_) y[c_] += (f32x2){f_[2 * c_], f_[2 * c_ + 1]} * wv_; __builtin_amdgcn_sched_barrier(0); } } while (0)
__device__ __forceinline__ void peer_gather6(const bf16* XN, const unsigned char* PU6, const unsigned char* PV6, const int* PIDX, const float* PGATE, float* X, LAS float* wl, int gw, int NGW, int lane) {
    const bool b5 = (lane >> 5) & 1, b4 = (lane >> 4) & 1, b3 = (lane >> 3) & 1; (void)b3;
    const unsigned voff = 24u * (unsigned)lane, l4 = 4u * (unsigned)lane, l8 = 8u * (unsigned)lane, l16 = 16u * (unsigned)lane;
    constexpr int NG = 128 / PG6_R;
    for (int t = gw; t < T; t += NGW) {
        const char* pidx_t = (const char*)(PIDX + (size_t)t * 128); const char* pgate_t = (const char*)(PGATE + (size_t)t * 128);
        const int idlo = *(const GAS int*)(pidx_t + l4), idhi = *(const GAS int*)(pidx_t + l4 + 256);
        v6u A[PG6_R], B[PG6_R];
        PG6_LOAD(A, PU6, idlo, idhi, 0);
        f32x2 x[16];
        {   const char* xr = (const char*)(XN + (size_t)t * DM);
#pragma unroll
            for (int j = 0; j < 8; ++j) { const v2u a = *(const GAS v2u*)(xr + l8 + 512 * j); x[2 * j] = (f32x2){bflo(a.x), bfhi(a.x)} * (1.f / PU_SCALE6); x[2 * j + 1] = (f32x2){bflo(a.y), bfhi(a.y)} * (1.f / PU_SCALE6); } }
#pragma unroll 1
        for (int g = 0; g < NG; g += 2) {
            PG6_LOAD(B, PU6, idlo, idhi, g + 1);
            PG6_DOT(A, g);
            if (g + 2 < NG) PG6_LOAD(A, PU6, idlo, idhi, g + 2); else PG6_LOAD(A, PV6, idlo, idhi, 0);
            PG6_DOT(B, g + 1);
        }
        LDS_WAIT();
        {   const float g0 = *(const GAS float*)(pgate_t + l4), g1 = *(const GAS float*)(pgate_t + l4 + 256);
            const float d0 = wl[lane], d1 = wl[64 + lane];
            const float w0 = g0 * 0.5f * d0 * (1.f + erff(d0 * 0.70710678118654752f)) * (1.f / PV_SCALE6), w1 = g1 * 0.5f * d1 * (1.f + erff(d1 * 0.70710678118654752f)) * (1.f / PV_SCALE6);
            LDS_WAIT(); asm volatile("" ::: "memory");
            wl[lane] = w0; wl[64 + lane] = w1;
            LDS_WAIT(); asm volatile("" ::: "memory");
        }
        f32x2 y[16];
#pragma unroll
        for (int i = 0; i < 16; ++i) y[i] = (f32x2){0.f, 0.f};
#pragma unroll 1
        for (int g = 0; g < NG; g += 2) {
            PG6_LOAD(B, PV6, idlo, idhi, g + 1);
            PG6_AXPY(A, g);
            if (g + 2 < NG) PG6_LOAD(A, PV6, idlo, idhi, g + 2);
            PG6_AXPY(B, g + 1);
        }
        {   char* xo = (char*)(X + (size_t)t * DM);
#pragma unroll
            for (int j = 0; j < 8; ++j) { GAS f32x4* p = (GAS f32x4*)(xo + l16 + 1024 * j); f32x4 v = *p; v += (f32x4){y[2 * j].x, y[2 * j].y, y[2 * j + 1].x, y[2 * j + 1].y}; *p = v; } }
        LDS_WAIT(); asm volatile("" ::: "memory");
    }
}

typedef short s16x4 __attribute__((ext_vector_type(4)));
typedef __attribute__((address_space(3))) const char* lds_cptr;
__device__ __forceinline__ s16x4 vtr(lds_cptr p) { return __builtin_bit_cast(s16x4, __builtin_amdgcn_ds_read_tr16_b64_v4i16((__attribute__((address_space(3))) s16x4*)p)); }
__device__ __forceinline__ unsigned cvtpk(float lo, float hi) { unsigned r; asm("v_cvt_pk_bf16_f32 %0, %1, %2" : "=v"(r) : "v"(lo), "v"(hi)); return r; }
constexpr int AT_K0 = 0, AT_V0 = 16384, AT_TAB = 32768;
constexpr float LOG2E = 1.4426950408889634f;
template <int TYPE>
__device__ __forceinline__ void attn_unit(LAS unsigned char* lds, const bf16* QKV, bf16* ATT, int b, int head, int qb, const float* tabsrc, float Cl2, float sinkl2, int tid) {
    const int lane = tid & 63, w = __builtin_amdgcn_readfirstlane(tid >> 6), hh = lane >> 5, l31 = lane & 31;
    int qcol, kcol, vcol, ocol;
    if (TYPE == 0) { qcol = QA + head * 64; kcol = KA + (head / 3) * 64; vcol = VA + (head / 3) * 64; ocol = OA + head * 64; }
    else if (TYPE == 1) { qcol = QB + head * 64; kcol = KB + head * 64; vcol = VB + head * 64; ocol = OB + head * 64; }
    else { qcol = QC + head * 64; kcol = KC + (head / 3) * 64; vcol = VC + (head / 3) * 64; ocol = OC + head * 64; }
    const int q0 = 256 * qb + 32 * w, qpos = q0 + l31;
    int t_begin, t_end;
    if (TYPE == 0) { t_begin = 4 * qb - 2; if (t_begin < 0) t_begin = 0; t_end = 4 * qb + 6; if (t_end > 32) t_end = 32; }
    else if (TYPE == 1) { int a = 4 * qb - 4; a = a < 0 ? 0 : (a > 24 ? 24 : a); int e = 4 * qb - 1; e = e < 0 ? 0 : (e > 24 ? 24 : e); t_begin = a; t_end = e + 8; }
    else { t_begin = 0; t_end = 32; }
    LAS float* tab = (LAS float*)(lds + AT_TAB);
    if (TYPE == 0) { for (int i = tid; i < 1024; i += NTHREADS) { const int rel = i - 448; tab[i] = (rel >= -128 && rel <= 128) ? tabsrc[head * 257 + rel + 128] * LOG2E - Cl2 : -1e30f; } }
    if (TYPE == 1) { for (int i = tid; i < 15 * 31; i += NTHREADS) tab[i] = tabsrc[head * 465 + i] * LOG2E - Cl2; }
    bf16x8 qf[4];
    {   const bf16* qp = QKV + ((size_t)b * SEQ + qpos) * DIN + qcol + 8 * hh;
#pragma unroll
        for (int s = 0; s < 4; ++s) qf[s] = *(const GAS bf16x8*)(qp + 16 * s); }
    const int srow = tid >> 3, sch = tid & 7;
    const bf16* kg = QKV + ((size_t)b * SEQ + srow) * DIN + kcol + sch * 8;
    const bf16* vg = QKV + ((size_t)b * SEQ + srow) * DIN + vcol + sch * 8;
    const int kst = srow * 128 + ((sch ^ ((srow >> 1) & 7)) * 16);
    const int vst = srow * 128 + (((sch >> 2) ^ ((srow >> 1) & 1)) * 64) + (sch & 3) * 16;
    int kread[4], vread[2];
#pragma unroll
    for (int s = 0; s < 4; ++s) kread[s] = l31 * 128 + (((2 * s + hh) ^ ((lane >> 1) & 7)) * 16);
#pragma unroll
    for (int db = 0; db < 2; ++db) vread[db] = (4 * hh + ((lane >> 2) & 3)) * 128 + ((db ^ ((lane >> 3) & 1)) * 64) + 32 * ((lane >> 4) & 1) + 8 * (lane & 3);
    f32x16 O0, O1;
#pragma unroll
    for (int r = 0; r < 16; ++r) { O0[r] = 0.f; O1[r] = 0.f; }
    float lsum = 0.f;
    const int rw = 4 * qb + (w >> 1), cq = 32 * (w & 1) + l31;
    int r0w = rw - 4; r0w = r0w < 0 ? 0 : (r0w > 24 ? 24 : r0w);
    int c0 = cq - 8; c0 = c0 < 0 ? 0 : (c0 > 48 ? 48 : c0);
    {   const v4u kr = *(const GAS v4u*)(kg + (size_t)t_begin * 64 * DIN), vr = *(const GAS v4u*)(vg + (size_t)t_begin * 64 * DIN);
        *(LAS v4u*)(lds + AT_K0 + kst) = kr; *(LAS v4u*)(lds + AT_V0 + vst) = vr; }
    __syncthreads();
    for (int t = t_begin; t < t_end; ++t) {
        const int cur = (t - t_begin) & 1;
        v4u kr, vr;
        if (t + 1 < t_end) { kr = *(const GAS v4u*)(kg + (size_t)(t + 1) * 64 * DIN); vr = *(const GAS v4u*)(vg + (size_t)(t + 1) * 64 * DIN); }
        bool need = true;
        if (TYPE == 0) need = (64 * t <= q0 + 31 + 128) && (64 * t + 63 >= q0 - 128);
        if (TYPE == 1) need = (t >= r0w) && (t < r0w + 8);
        if (need) {
            const lds_cptr kb_ = (lds_cptr)(lds + AT_K0 + cur * 8192), vb_ = (lds_cptr)(lds + AT_V0 + cur * 8192);
            f32x16 S0, S1;
#pragma unroll
            for (int r = 0; r < 16; ++r) { S0[r] = 0.f; S1[r] = 0.f; }
#pragma unroll
            for (int s = 0; s < 4; ++s) { const bf16x8 k0 = *(const LAS bf16x8*)(kb_ + kread[s]), k1 = *(const LAS bf16x8*)(kb_ + kread[s] + 4096);
                S0 = __builtin_amdgcn_mfma_f32_32x32x16_bf16(k0, qf[s], S0, 0, 0, 0); S1 = __builtin_amdgcn_mfma_f32_32x32x16_bf16(k1, qf[s], S1, 0, 0, 0); }
            if (TYPE == 2) {
#pragma unroll
                for (int r = 0; r < 16; ++r) { S0[r] = __builtin_amdgcn_exp2f(S0[r] * LOG2E - Cl2); S1[r] = __builtin_amdgcn_exp2f(S1[r] * LOG2E - Cl2); }
            } else if (TYPE == 0) {
                const LAS float* tb = tab + (64 * t - qpos + 448 + 4 * hh);
#pragma unroll
                for (int r = 0; r < 16; ++r) { S0[r] = __builtin_amdgcn_exp2f(S0[r] * LOG2E + tb[8 * (r >> 2) + (r & 3)]); S1[r] = __builtin_amdgcn_exp2f(S1[r] * LOG2E + tb[32 + 8 * (r >> 2) + (r & 3)]); }
            } else {
                const LAS float* tb = tab + ((t - rw + 7) * 31 - cq + 15 + 4 * hh);
                const int kc0 = 4 * hh - c0;
#pragma unroll
                for (int r = 0; r < 16; ++r) { const int ka = 8 * (r >> 2) + (r & 3), kb2 = 32 + ka;
                    const float p0 = __builtin_amdgcn_exp2f(S0[r] * LOG2E + tb[ka]), p1 = __builtin_amdgcn_exp2f(S1[r] * LOG2E + tb[kb2]);
                    S0[r] = ((unsigned)(ka + kc0) < 16u) ? p0 : 0.f; S1[r] = ((unsigned)(kb2 + kc0) < 16u) ? p1 : 0.f; }
            }
#pragma unroll
            for (int r = 0; r < 16; ++r) lsum += S0[r] + S1[r];
            bf16x8 pb[4];
#pragma unroll
            for (int hf = 0; hf < 2; ++hf) {
                v4u a, c;
#pragma unroll
                for (int j = 0; j < 4; ++j) { a[j] = cvtpk(S0[8 * hf + 2 * j], S0[8 * hf + 2 * j + 1]); c[j] = cvtpk(S1[8 * hf + 2 * j], S1[8 * hf + 2 * j + 1]); }
                pb[hf] = __builtin_bit_cast(bf16x8, a); pb[2 + hf] = __builtin_bit_cast(bf16x8, c);
            }
#pragma unroll
            for (int ks = 0; ks < 4; ++ks) {
                const s16x4 a0 = vtr(vb_ + vread[0] + (16 * ks) * 128), a1 = vtr(vb_ + vread[0] + (16 * ks + 8) * 128);
                const s16x4 b0 = vtr(vb_ + vread[1] + (16 * ks) * 128), b1 = vtr(vb_ + vread[1] + (16 * ks + 8) * 128);
                const bf16x8 va = __builtin_shufflevector(a0, a1, 0, 1, 2, 3, 4, 5, 6, 7), vb2 = __builtin_shufflevector(b0, b1, 0, 1, 2, 3, 4, 5, 6, 7);
                O0 = __builtin_amdgcn_mfma_f32_32x32x16_bf16(va, pb[ks], O0, 0, 0, 0); O1 = __builtin_amdgcn_mfma_f32_32x32x16_bf16(vb2, pb[ks], O1, 0, 0, 0);
            }
        }
        if (t + 1 < t_end) { *(LAS v4u*)(lds + AT_K0 + (cur ^ 1) * 8192 + kst) = kr; *(LAS v4u*)(lds + AT_V0 + (cur ^ 1) * 8192 + vst) = vr; }
        __syncthreads();
    }
    lsum += shx(lsum, 32, lane);
    if (TYPE == 0) lsum += __builtin_amdgcn_exp2f(sinkl2 - Cl2);
    const float inv = 1.f / lsum;
    bf16* op = ATT + ((size_t)b * SEQ + qpos) * DM + ocol + 4 * hh;
#pragma unroll
    for (int g4 = 0; g4 < 4; ++g4) {
        v2u o0, o1; o0.x = cvtpk(O0[4 * g4] * inv, O0[4 * g4 + 1] * inv); o0.y = cvtpk(O0[4 * g4 + 2] * inv, O0[4 * g4 + 3] * inv);
        o1.x = cvtpk(O1[4 * g4] * inv, O1[4 * g4 + 1] * inv); o1.y = cvtpk(O1[4 * g4 + 2] * inv, O1[4 * g4 + 3] * inv);
        *(GAS v2u*)(op + 8 * g4) = o0; *(GAS v2u*)(op + 32 + 8 * g4) = o1;
    }
}


constexpr int MA_K0 = 0, MA_V0 = 32768;
__device__ __forceinline__ void mem_unit(LAS unsigned char* lds, const bf16* QM, const bf16* KVM, bf16* OM, const float* gq, int tb, int head, float Cl2, int tid) {
    const int lane = tid & 63, w = __builtin_amdgcn_readfirstlane(tid >> 6), hh = lane >> 5, l31 = lane & 31;
    const size_t trow = (size_t)tb * 256 + 32 * w + l31; const int b = tb >> 3;
    bf16x8 qf[8];
    {   const bf16* qp = QM + trow * MEMW + head * 128 + 8 * hh;
#pragma unroll
        for (int s = 0; s < 8; ++s) qf[s] = *(const GAS bf16x8*)(qp + 16 * s);
        float ss = 0.f;
#pragma unroll
        for (int s = 0; s < 8; ++s)
#pragma unroll
            for (int j = 0; j < 8; ++j) { const float f = __builtin_bit_cast(float, (unsigned)(unsigned short)qf[s][j] << 16); ss += f * f; }
        ss += shx(ss, 32, lane);
        const float r = 0.08838834764831845f / sqrtf(ss * (1.f / 128.f) + EPS);
#pragma unroll
        for (int s = 0; s < 8; ++s) { const f32x4 g0 = *(const GAS f32x4*)(gq + 16 * s + 8 * hh), g1 = *(const GAS f32x4*)(gq + 16 * s + 8 * hh + 4);
            v4u o;
#pragma unroll
            for (int j = 0; j < 4; ++j) { const float f0 = __builtin_bit_cast(float, (unsigned)(unsigned short)qf[s][2 * j] << 16), f1 = __builtin_bit_cast(float, (unsigned)(unsigned short)qf[s][2 * j + 1] << 16);
                const float ga = (2 * j < 4) ? g0[2 * j] : g1[2 * j - 4], gb2 = (2 * j + 1 < 4) ? g0[2 * j + 1] : g1[2 * j + 1 - 4];
                o[j] = cvtpk(f0 * r * ga, f1 * r * gb2); }
            qf[s] = __builtin_bit_cast(bf16x8, o); }
    }
    const int srow = tid >> 3, sch = tid & 7;
    const bf16* kg = KVM + ((size_t)b * NMEM + srow) * 1024 + head * 128 + sch * 8;
    const bf16* vg = kg + 512;
    const int kst0 = srow * 256 + ((sch ^ (srow & 15)) * 16), kst1 = srow * 256 + (((sch + 8) ^ (srow & 15)) * 16);
    const int vst0 = srow * 256 + ((((sch) >> 2) ^ (srow & 3)) * 64) + (sch & 3) * 16, vst1 = srow * 256 + ((((sch + 8) >> 2) ^ (srow & 3)) * 64) + (sch & 3) * 16;
    int kread[8], vread[4];
#pragma unroll
    for (int s = 0; s < 8; ++s) kread[s] = l31 * 256 + (((2 * s + hh) ^ (l31 & 15)) * 16);
#pragma unroll
    for (int db = 0; db < 4; ++db) vread[db] = (4 * hh + ((lane >> 2) & 3)) * 256 + ((db ^ ((lane >> 2) & 3)) * 64) + 32 * ((lane >> 4) & 1) + 8 * (lane & 3);
    f32x16 O[4];
#pragma unroll
    for (int db = 0; db < 4; ++db)
#pragma unroll
        for (int r = 0; r < 16; ++r) O[db][r] = 0.f;
    float lsum = 0.f;
    {   const v4u k0 = *(const GAS v4u*)kg, k1 = *(const GAS v4u*)(kg + 64), v0 = *(const GAS v4u*)vg, v1 = *(const GAS v4u*)(vg + 64);
        *(LAS v4u*)(lds + MA_K0 + kst0) = k0; *(LAS v4u*)(lds + MA_K0 + kst1) = k1; *(LAS v4u*)(lds + MA_V0 + vst0) = v0; *(LAS v4u*)(lds + MA_V0 + vst1) = v1; }
    __syncthreads();
#pragma unroll 1
    for (int t = 0; t < 4; ++t) {
        const int cur = t & 1;
        v4u k0, k1, v0, v1;
        if (t + 1 < 4) { const bf16* kn = kg + (size_t)(t + 1) * 64 * 1024; k0 = *(const GAS v4u*)kn; k1 = *(const GAS v4u*)(kn + 64); v0 = *(const GAS v4u*)(kn + 512); v1 = *(const GAS v4u*)(kn + 576); }
        const lds_cptr kb_ = (lds_cptr)(lds + MA_K0 + cur * 16384), vb_ = (lds_cptr)(lds + MA_V0 + cur * 16384);
        f32x16 S0, S1;
#pragma unroll
        for (int r = 0; r < 16; ++r) { S0[r] = 0.f; S1[r] = 0.f; }
#pragma unroll
        for (int s = 0; s < 8; ++s) { const bf16x8 a0 = *(const LAS bf16x8*)(kb_ + kread[s]), a1 = *(const LAS bf16x8*)(kb_ + kread[s] + 8192);
            S0 = __builtin_amdgcn_mfma_f32_32x32x16_bf16(a0, qf[s], S0, 0, 0, 0); S1 = __builtin_amdgcn_mfma_f32_32x32x16_bf16(a1, qf[s], S1, 0, 0, 0); }
#pragma unroll
        for (int r = 0; r < 16; ++r) { S0[r] = __builtin_amdgcn_exp2f(S0[r] * LOG2E - Cl2); S1[r] = __builtin_amdgcn_exp2f(S1[r] * LOG2E - Cl2); lsum += S0[r] + S1[r]; }
        bf16x8 pb[4];
#pragma unroll
        for (int hf = 0; hf < 2; ++hf) {
            v4u a, c;
#pragma unroll
            for (int j = 0; j < 4; ++j) { a[j] = cvtpk(S0[8 * hf + 2 * j], S0[8 * hf + 2 * j + 1]); c[j] = cvtpk(S1[8 * hf + 2 * j], S1[8 * hf + 2 * j + 1]); }
            pb[hf] = __builtin_bit_cast(bf16x8, a); pb[2 + hf] = __builtin_bit_cast(bf16x8, c);
        }
#pragma unroll
        for (int ks = 0; ks < 4; ++ks)
#pragma unroll
            for (int db = 0; db < 4; ++db) {
                const s16x4 a0 = vtr(vb_ + vread[db] + (16 * ks) * 256), a1 = vtr(vb_ + vread[db] + (16 * ks + 8) * 256);
                const bf16x8 va = __builtin_shufflevector(a0, a1, 0, 1, 2, 3, 4, 5, 6, 7);
                O[db] = __builtin_amdgcn_mfma_f32_32x32x16_bf16(va, pb[ks], O[db], 0, 0, 0);
            }
        if (t + 1 < 4) { LAS unsigned char* kn = lds + MA_K0 + (cur ^ 1) * 16384; LAS unsigned char* vn = lds + MA_V0 + (cur ^ 1) * 16384;
            *(LAS v4u*)(kn + kst0) = k0; *(LAS v4u*)(kn + kst1) = k1; *(LAS v4u*)(vn + vst0) = v0; *(LAS v4u*)(vn + vst1) = v1; }
        __syncthreads();
    }
    lsum += shx(lsum, 32, lane);
    const float inv = 1.f / lsum;
    bf16* op = OM + trow * MEMW + head * 128 + 4 * hh;
#pragma unroll
    for (int db = 0; db < 4; ++db)
#pragma unroll
        for (int g4 = 0; g4 < 4; ++g4) { v2u o; o.x = cvtpk(O[db][4 * g4] * inv, O[db][4 * g4 + 1] * inv); o.y = cvtpk(O[db][4 * g4 + 2] * inv, O[db][4 * g4 + 3] * inv); *(GAS v2u*)(op + 32 * db + 8 * g4) = o; }
}

__device__ __forceinline__ float wave_max(float v, int lane) {
#pragma unroll
    for (int o = 1; o < 64; o <<= 1) v = fmaxf(v, shx(v, o, lane));
    return v;
}
struct Args { const float* in[23]; float* out; unsigned char* ws; int ph_lo, ph_hi, use_bar, pad; };
#ifndef MK_OFF
#define MK_OFF 0u
#endif
#ifndef REP_ATT
#define REP_ATT 1
#endif
#ifndef REP_GEMM
#define REP_GEMM 1
#endif
#ifndef REP_NORM
#define REP_NORM 1
#endif
#ifndef REP_SEL
#define REP_SEL 1
#endif
#ifndef REP_MEM
#define REP_MEM 1
#endif
#define PHON(k) (!((MK_OFF >> (k)) & 1u))
constexpr int PH_PER_LAYER = 13, PH_BASE = 3, N_PHASES = PH_BASE + DEPTH * PH_PER_LAYER;
constexpr int PTAB_OFF = LDSCTL_OFF + 1024;

__global__ void __launch_bounds__(NTHREADS, 2) mega(Args a) {
    extern __shared__ __attribute__((aligned(16))) unsigned char lds_raw[];
    LAS unsigned char* lds = (LAS unsigned char*)lds_raw;
    {   const int tid0 = threadIdx.x;
        for (int u = tid0; u < (LDS_BYTES - LDSCTL_OFF) / 4; u += NTHREADS) ((LAS unsigned*)(lds + LDSCTL_OFF))[u] = 0u;
        __syncthreads();
        if (tid0 < 23) ((LAS unsigned long long*)(lds + PTAB_OFF))[tid0] = (unsigned long long)a.in[tid0];
        if (tid0 == 23) ((LAS unsigned long long*)(lds + PTAB_OFF))[23] = (unsigned long long)a.out;
        if (tid0 == 24) ((LAS unsigned long long*)(lds + PTAB_OFF))[24] = (unsigned long long)a.ws;
        __syncthreads();
    }
    volatile LAS unsigned* MISC = (volatile LAS unsigned*)(lds + MISC_OFF);
    const int G = gridDim.x, bid = blockIdx.x, NGW = G * NWAVES;
    const int use_bar = a.use_bar;
    XcdBarrier bar; bar.bar = (unsigned*)(a.ws + WS_CTL) + CW_BAR; bar.x = 0; bar.st = MISC + 8;
    if (use_bar) bar = xcd_barrier_post((unsigned*)(a.ws + WS_CTL) + CW_BAR, MISC + 8);
    const int lo = a.ph_lo, hi = a.ph_hi;
#define IN(k) (lo <= (k) && (k) < hi)
#define SEAM(k) do { if (use_bar && IN(k) && IN((k) + 1)) xcd_barrier(bar); } while (0)
#define PHL() int tid_ = threadIdx.x; asm volatile("" : "+v"(tid_)); const int lane_ = tid_ & 63, wave_ = __builtin_amdgcn_readfirstlane(tid_ >> 6), gw_ = bid * NWAVES + wave_; (void)lane_; (void)gw_; \
              int pz_ = 0; asm volatile("" : "+s"(pz_))
#define PTR(i) ((const float*)ldptr(lds, (i) + pz_))
#define WSP() ((unsigned char*)ldptr(lds, 24 + pz_))
#define OUTP() ((float*)ldptr(lds, 23 + pz_))

    if (IN(0) && PHON(0)) {
        PHL(); unsigned char* ws = WSP();
        LAS float* scr = (LAS float*)(lds + RING_OFF + wave_ * 16384);
        constexpr int I_IN = 32 * 128, I_OUT = 32 * 64, I_MQ = 32 * 16, I_MKV = 32 * 32, I_MO = 8 * 64, I_PQ = 32 * 64, I_L = I_IN + I_OUT + I_MQ + I_MKV + I_MO + I_PQ;
        for (int it = gw_; it < DEPTH * I_L; it += NGW) {
            const int l = it / I_L; int r = it % I_L;
            if (r < I_IN) { transpose_item<true>(PTR(4) + (size_t)l * DM * DIN, DM, DIN, (bf16*)(ws + WS_WIN) + (size_t)l * DIN * DM, scr, r, lane_); continue; } r -= I_IN;
            if (r < I_OUT) { transpose_item<false>(PTR(11) + (size_t)l * DM * DM, DM, DM, (bf16*)(ws + WS_WOUT) + (size_t)l * DM * DM, scr, r, lane_); continue; } r -= I_OUT;
            if (r < I_MQ) { transpose_item<false>(PTR(14) + (size_t)l * DM * MEMW, DM, MEMW, (bf16*)(ws + WS_WMQ) + (size_t)l * MEMW * DM, scr, r, lane_); continue; } r -= I_MQ;
            if (r < I_MKV) { transpose_item<false>(PTR(15) + (size_t)l * DM * 1024, DM, 1024, (bf16*)(ws + WS_WMKV) + (size_t)l * 1024 * DM, scr, r, lane_); continue; } r -= I_MKV;
            if (r < I_MO) { transpose_item<false>(PTR(17) + (size_t)l * MEMW * DM, MEMW, DM, (bf16*)(ws + WS_WMO) + (size_t)l * DM * MEMW, scr, r, lane_); continue; } r -= I_MO;
            transpose_item<false>(PTR(19) + (size_t)l * DM * DM, DM, DM, (bf16*)(ws + WS_WPQ) + (size_t)l * DM * DM, scr, r, lane_);
        }
        const size_t gtid = (size_t)bid * NTHREADS + tid_, nth = (size_t)G * NTHREADS;
        convert_bf16(PTR(20), (bf16*)(ws + WS_PKEYS), (size_t)DEPTH * 8 * 2 * 128 * 128, gtid, nth);
        convert_fp6_rows(PTR(21), ws + WS_PU, DEPTH * PEER_N, PU_SCALE6, gw_, NGW, lane_);
        convert_fp6_rows(PTR(22), ws + WS_PV, DEPTH * PEER_N, PV_SCALE6, gw_, NGW, lane_);
        {   const float* mem = PTR(1); const float* gkv = PTR(13); bf16* MEMN = (bf16*)(ws + WS_MEMN);
            for (int m = gw_; m < BATCH * NMEM; m += NGW)
                rms_row_to_bf16(mem + (size_t)m * DM, gkv, MEMN + (size_t)m * DM, gkv + DM, MEMN + (size_t)(BATCH * NMEM + m) * DM, lane_); }
        float* rope = (float*)(ws + WS_ROPE); float* biasA = (float*)(ws + WS_BIASA);
        if (gtid < 64 * 16) { const int pos = (int)gtid >> 4, i = (int)gtid & 15; const float ang = (float)pos * ROPE_INV[i]; rope[gtid * 2] = cosf(ang); rope[gtid * 2 + 1] = sinf(ang); }
        if (gtid < 12 * 257) { const int h = (int)gtid / 257, rel = (int)gtid % 257 - 128; biasA[gtid] = PTR(2)[t5_bucket(rel) * 12 + h]; }
    }
    SEAM(0);
    if (IN(1) && PHON(1)) {
#pragma unroll 1
        for (int l = 0; l < DEPTH; ++l) {
            PHL(); unsigned char* ws = WSP();
            pg8::Gemm g{(bf16*)(ws + WS_MEMN) + (size_t)l * BATCH * NMEM * DM, (bf16*)(ws + WS_WMKV) + (size_t)l * 1024 * DM, BATCH * NMEM, 1024, DM};
            OffsetOrder S; S.init(BATCH * NMEM, 1024, G, bid, 64 * l);
            pg8::EpiBf16<0> E{(bf16*)(ws + WS_KVM) + (size_t)l * BATCH * NMEM * 1024, 1024, nullptr, 0, 0, 1.f};
            pg8::gemm_phase<pg8::EpiBf16<0>, OffsetOrder, true, true>(lds + RING_OFF, g, S, E, tid_);
            __syncthreads();
        }
    }
    SEAM(1);
    if (IN(2) && PHON(2)) {
        PHL(); unsigned char* ws = WSP(); bf16* KVM = (bf16*)(ws + WS_KVM); const float* gm = PTR(16);
        for (int m = gw_; m < DEPTH * BATCH * NMEM; m += NGW) {
            const int l = m / (BATCH * NMEM);
            GAS v4u* p = (GAS v4u*)(KVM + (size_t)m * 1024 + 8 * lane_);
            const v4u w = *p;
            float f[8] = {bflo(w.x), bfhi(w.x), bflo(w.y), bfhi(w.y), bflo(w.z), bfhi(w.z), bflo(w.w), bfhi(w.w)};
            float ss = 0.f;
#pragma unroll
            for (int i = 0; i < 8; ++i) ss += f[i] * f[i];
            ss += shx(ss, 1, lane_); ss += shx(ss, 2, lane_); ss += shx(ss, 4, lane_); ss += shx(ss, 8, lane_);
            const float r = 1.f / sqrtf(ss * (1.f / 128.f) + EPS);
            const float* gk = gm + (size_t)l * 256 + 128 + 8 * (lane_ & 15);
            v4u o; o.x = pk2(f[0] * r * gk[0], f[1] * r * gk[1]); o.y = pk2(f[2] * r * gk[2], f[3] * r * gk[3]); o.z = pk2(f[4] * r * gk[4], f[5] * r * gk[5]); o.w = pk2(f[6] * r * gk[6], f[7] * r * gk[7]);
            *p = o;
        }
    }
    SEAM(2);

#pragma unroll 1
    for (int l = 0; l < DEPTH; ++l) {
        const int pb = PH_BASE + PH_PER_LAYER * l;
        if (IN(pb + 0) && PHON(3)) for (int rep_ = 0; rep_ < REP_NORM; ++rep_) { PHL(); unsigned char* ws = WSP(); const float* xin = (l == 0) ? PTR(0) : (const float*)OUTP();
            norm_rows(xin, PTR(3) + (size_t)l * DM, (bf16*)(ws + WS_XN), gw_, NGW, lane_); }
        SEAM(pb + 0);
        if (IN(pb + 1) && PHON(4)) for (int rep_ = 0; rep_ < REP_GEMM; ++rep_) { PHL(); unsigned char* ws = WSP();
            pg8::Gemm g{(bf16*)(ws + WS_XN), (bf16*)(ws + WS_WIN) + (size_t)l * DIN * DM, T, DIN, DM}; pg8::StaticOrder S; S.init(T, DIN, G, bid);
            pg8::EpiQKV E{(bf16*)(ws + WS_QKV), PTR(5) + (size_t)l * 128, PTR(7) + (size_t)l * 128, PTR(9) + (size_t)l * 128, (const float*)(ws + WS_ROPE)};
            pg8::gemm_phase<pg8::EpiQKV, pg8::StaticOrder, true, true>(lds + RING_OFF, g, S, E, tid_);
        }
        SEAM(pb + 1);
        if (IN(pb + 2) && PHON(5)) for (int rep_ = 0; rep_ < REP_ATT; ++rep_) { PHL(); unsigned char* ws = WSP();
            const float* sink = PTR(6) + (size_t)l * 12; const float* rpb = PTR(8) + (size_t)l * 8 * 15 * 31; const float* biasA = (const float*)(ws + WS_BIASA);
            const bf16* QKV = (const bf16*)(ws + WS_QKV); bf16* ATT = (bf16*)(ws + WS_ATT);
            const float* ga = PTR(5) + (size_t)l * 128; const float* gb = PTR(7) + (size_t)l * 128; const float* gc = PTR(9) + (size_t)l * 128;
            const float CaL2 = 8.f * wave_max(fabsf(ga[lane_]), lane_) * wave_max(fabsf(ga[64 + lane_]), lane_) * LOG2E;
            const float CbL2 = 8.f * wave_max(fabsf(gb[lane_]), lane_) * wave_max(fabsf(gb[64 + lane_]), lane_) * LOG2E;
            const float CcL2 = 8.f * wave_max(fabsf(gc[lane_]), lane_) * wave_max(fabsf(gc[64 + lane_]), lane_) * LOG2E;
            const int vc = (G % 8 == 0) ? (bid % 8) * (G / 8) + bid / 8 : bid;
            for (int u = vc; u < BATCH * 12 * 8; u += G) attn_unit<2>(lds, QKV, ATT, u / 96, (u >> 3) % 12, u & 7, nullptr, CcL2, 0.f, tid_);
            for (int u = vc; u < BATCH * 8 * 8; u += G) attn_unit<1>(lds, QKV, ATT, u >> 6, (u >> 3) & 7, u & 7, rpb, CbL2, 0.f, tid_);
            for (int u = vc; u < BATCH * 12 * 8; u += G) { const int head = (u >> 3) % 12; attn_unit<0>(lds, QKV, ATT, u / 96, head, u & 7, biasA, CaL2, sink[head] * LOG2E, tid_); }
        }
        SEAM(pb + 2);
        if (IN(pb + 3) && PHON(6)) { PHL(); unsigned char* ws = WSP(); mixnorm_rows((bf16*)(ws + WS_ATT), PTR(10) + (size_t)l * DM, gw_, NGW, lane_); }
        SEAM(pb + 3);
        if (IN(pb + 4) && PHON(7)) { PHL(); unsigned char* ws = WSP(); const float* xin = (l == 0) ? PTR(0) : (const float*)OUTP();
            pg8::Gemm g{(bf16*)(ws + WS_ATT), (bf16*)(ws + WS_WOUT) + (size_t)l * DM * DM, T, DM, DM}; pg8::StaticOrder S; S.init(T, DM, G, bid);
            pg8::EpiResid E{xin, OUTP(), DM};
            pg8::gemm_phase<pg8::EpiResid, pg8::StaticOrder, true, true>(lds + RING_OFF, g, S, E, tid_);
        }
        SEAM(pb + 4);
        if (IN(pb + 5) && PHON(8)) for (int rep_ = 0; rep_ < REP_NORM; ++rep_) { PHL(); unsigned char* ws = WSP(); norm_rows(OUTP(), PTR(12) + (size_t)l * DM, (bf16*)(ws + WS_XN), gw_, NGW, lane_); }
        SEAM(pb + 5);
        if (IN(pb + 6) && PHON(9)) for (int rep_ = 0; rep_ < REP_GEMM; ++rep_) { PHL(); unsigned char* ws = WSP();
            pg8::Gemm g{(bf16*)(ws + WS_XN), (bf16*)(ws + WS_WMQ) + (size_t)l * MEMW * DM, T, MEMW, DM}; pg8::StaticOrder S; S.init(T, MEMW, G, bid);
            pg8::EpiBf16<0> E{(bf16*)(ws + WS_QM), MEMW, nullptr, 0, 0, 1.f};
            pg8::gemm_phase<pg8::EpiBf16<0>, pg8::StaticOrder, true, true>(lds + RING_OFF, g, S, E, tid_);
        }
        SEAM(pb + 6);
        if (IN(pb + 7) && PHON(10)) for (int rep_ = 0; rep_ < REP_MEM; ++rep_) { PHL(); unsigned char* ws = WSP();
            const bf16* kvm = (const bf16*)(ws + WS_KVM) + (size_t)l * BATCH * NMEM * 1024; const float* gq = PTR(16) + (size_t)l * 256;
            const float CmL2 = 11.313708498984761f * wave_max(fmaxf(fabsf(gq[lane_]), fabsf(gq[64 + lane_])), lane_) * wave_max(fmaxf(fabsf(gq[128 + lane_]), fabsf(gq[192 + lane_])), lane_) * LOG2E;
            for (int u = bid; u < (T / 256) * 4; u += G) mem_unit(lds, (const bf16*)(ws + WS_QM), kvm, (bf16*)(ws + WS_OM), gq, u >> 2, u & 3, CmL2, tid_);
        }
        SEAM(pb + 7);
        if (IN(pb + 8) && PHON(11)) { PHL(); unsigned char* ws = WSP();
            pg8::Gemm g{(bf16*)(ws + WS_OM), (bf16*)(ws + WS_WMO) + (size_t)l * DM * MEMW, T, DM, MEMW}; pg8::StaticOrder S; S.init(T, DM, G, bid);
            pg8::EpiResid E{OUTP(), OUTP(), DM};
            pg8::gemm_phase<pg8::EpiResid, pg8::StaticOrder, true, true>(lds + RING_OFF, g, S, E, tid_);
        }
        SEAM(pb + 8);
        if (IN(pb + 9) && PHON(12)) for (int rep_ = 0; rep_ < REP_NORM; ++rep_) { PHL(); unsigned char* ws = WSP(); norm_rows(OUTP(), PTR(18) + (size_t)l * DM, (bf16*)(ws + WS_XN), gw_, NGW, lane_); }
        SEAM(pb + 9);
        if (IN(pb + 10) && PHON(13)) for (int rep_ = 0; rep_ < REP_GEMM; ++rep_) { PHL(); unsigned char* ws = WSP();
            pg8::Gemm g{(bf16*)(ws + WS_XN), (bf16*)(ws + WS_WPQ) + (size_t)l * DM * DM, T, DM, DM}; pg8::StaticOrder S; S.init(T, DM, G, bid);
            pg8::EpiBf16<0> E{(bf16*)(ws + WS_QP), DM, nullptr, 0, 0, 1.f};
            pg8::gemm_phase<pg8::EpiBf16<0>, pg8::StaticOrder, true, true>(lds + RING_OFF, g, S, E, tid_);
        }
        SEAM(pb + 10);
        if (IN(pb + 11) && PHON(14)) for (int rep_ = 0; rep_ < REP_SEL; ++rep_) { PHL(); unsigned char* ws = WSP();
            const bf16* pk = (const bf16*)(ws + WS_PKEYS) + (size_t)l * 8 * 2 * 128 * 128;
            for (int u = bid; u < (T / 256) * PEER_H; u += G) peer_select_unit((const bf16*)(ws + WS_QP), pk, (int*)(ws + WS_PIDX), (float*)(ws + WS_PGATE), u >> 3, u & 7, wave_, lane_);
        }
        SEAM(pb + 11);
        if (IN(pb + 12) && PHON(15)) { PHL(); unsigned char* ws = WSP();
            peer_gather6((const bf16*)(ws + WS_XN), ws + WS_PU + (size_t)l * PEER_N * 1536, ws + WS_PV + (size_t)l * PEER_N * 1536, (const int*)(ws + WS_PIDX), (const float*)(ws + WS_PGATE), OUTP(), (LAS float*)(lds + RING_OFF + wave_ * 1024), gw_, NGW, lane_); }
        SEAM(pb + 12);
    }
#undef IN
#undef SEAM
}

#ifndef MK_MULTI_LAUNCH
#define MK_MULTI_LAUNCH 0
#endif
extern "C" void kernel_launch(void* const* d_in, const int* in_sizes, int n_in, void* d_out, int out_size, void* d_ws, size_t ws_size, hipStream_t stream) {
    static int grid = 0;
    if (grid == 0) {
        if (n_in != 23 || out_size != T * DM || ws_size < WS_END) { fprintf(stderr, "kernel_launch: unexpected shapes (n_in %d, out %d, ws %zu)\n", n_in, out_size, ws_size); grid = -1; return; }
        int dev = 0, cus = 0, per_cu = 0;
        if (hipGetDevice(&dev) != hipSuccess || hipDeviceGetAttribute(&cus, hipDeviceAttributeMultiprocessorCount, dev) != hipSuccess) { grid = -1; return; }
        if (hipFuncSetAttribute((const void*)mega, hipFuncAttributeMaxDynamicSharedMemorySize, LDS_BYTES) != hipSuccess) { fprintf(stderr, "kernel_launch: hipFuncSetAttribute failed\n"); grid = -1; return; }
        if (hipOccupancyMaxActiveBlocksPerMultiprocessor(&per_cu, (const void*)mega, NTHREADS, LDS_BYTES) != hipSuccess || per_cu < 1) { fprintf(stderr, "kernel_launch: occupancy query says %d\n", per_cu); }
        (void)hipGetLastError();
        grid = cus;
    }
    if (grid < 0) return;
    (void)hipMemsetAsync((char*)d_ws + WS_CTL, 0, CTL_ZERO_BYTES, stream);
    Args a{};
    for (int i = 0; i < 23; ++i) a.in[i] = (const float*)d_in[i];
    a.out = (float*)d_out; a.ws = (unsigned char*)d_ws;
#if MK_MULTI_LAUNCH
    for (int p = 0; p < N_PHASES; ++p) { a.ph_lo = p; a.ph_hi = p + 1; a.use_bar = 0; a.pad = 0; hipLaunchKernelGGL(mega, dim3(grid), dim3(NTHREADS), LDS_BYTES, stream, a); }
#else
    a.ph_lo = 0; a.ph_hi = N_PHASES; a.use_bar = 1; a.pad = 0;
    hipLaunchKernelGGL(mega, dim3(grid), dim3(NTHREADS), LDS_BYTES, stream, a);
#endif
    const hipError_t le = hipPeekAtLastError();
    if (le != hipSuccess) fprintf(stderr, "kernel_launch: launch failed: %s\n", hipGetErrorName(le));
}
```

```cpp
#include <hip/hip_runtime.h>
#include <cstdio>
#include <cstdint>
#include <cmath>
__device__ __forceinline__ float shx(float v, int k, int lane);
typedef unsigned long long u64_t;
__device__ __forceinline__ float rowsq_rs(const u64_t* rowsq, int row) { return 1.0f / sqrtf((float)rowsq[row] * (5.9604644775390625e-08f / 2048.0f) + 1e-6f); }
__device__ __forceinline__ u64_t rowsq_fx(float ss) { return (u64_t)(ss * 16777216.0f + 0.5f); }
namespace pg8 {
#define PG8_LAS __attribute__((address_space(3)))
typedef unsigned short bf16_t;
typedef short bf16x8 __attribute__((ext_vector_type(8)));
typedef float f32x4 __attribute__((ext_vector_type(4)));
typedef unsigned u32x4 __attribute__((ext_vector_type(4)));
constexpr int BM = 256, BK = 64, HALF = 128, HTB = HALF * BK * 2  , STAGE_BYTES = 8 * HTB, NXCD = 8, WGM = 8;

__host__ __device__ __forceinline__ int lds_byte(int r, int c) { const int st = (r >> 4) * 2 + (c >> 5), rr = r & 15, cc = c & 31, ob = rr * 64 + cc * 2; return st * 1024 + (ob ^ (((ob >> 9) & 1) << 5)); }
__host__ __device__ __forceinline__ void stage_rc(int b, int& R, int& C) { const int st = b / 1024, sb = b % 1024, swz = sb ^ (((sb >> 9) & 1) << 5); R = (st >> 1) * 16 + swz / 64; C = (st & 1) * 32 + (swz % 64) / 2; }
__host__ __device__ __forceinline__ int perm32(int rho) { const int n = rho >> 4, i = rho & 15; return 8 * (i >> 2) + 4 * n + (i & 3); }

struct Unit { int pm, pn; };
struct Gemm { const bf16_t* A; const bf16_t* Bt; int M, N, K; };

struct StaticOrder {
    int nM, nN, nwg, G, c;
    __host__ __device__ void init(int M, int N, int G_, int c_) { nM = M / BM; nN = N / BM; nwg = nM * nN; G = G_; c = c_; }
    __host__ __device__ bool next(int i, Unit& u) const {
        const long L = (long)i * G + c; if (L >= nwg) return false;
        int wgid = (int)L; { const int q = nwg / NXCD, r = nwg % NXCD, xcd = wgid % NXCD, off = wgid / NXCD; wgid = (xcd < r ? xcd * (q + 1) : r * (q + 1) + (xcd - r) * q) + off; }
        const int nig = WGM * nN, gid = wgid / nig, fm = gid * WGM, gsz = (nM - fm) < WGM ? (nM - fm) : WGM;
        u.pm = fm + ((wgid % nig) % gsz); u.pn = (wgid % nig) / gsz; return true;
    }
    __device__ __forceinline__ void a_ready(const Unit&) const {}
    __device__ __forceinline__ void done(const Unit&) const {}
};

__device__ __forceinline__ unsigned cvt_pk_bf16(float lo, float hi) { unsigned r; asm volatile("v_cvt_pk_bf16_f32 %0, %1, %2" : "=v"(r) : "v"(lo), "v"(hi)); return r; }
typedef float f32x2 __attribute__((ext_vector_type(2)));
__device__ __forceinline__ f32x2 gelu_pk(f32x2 v) {
    const f32x2 av = __builtin_elementwise_abs(v), d = av * 0.2316418882f + 1.0f;
    f32x2 t; t.x = __builtin_amdgcn_rcpf(d.x); t.y = __builtin_amdgcn_rcpf(d.y);
    f32x2 q = t * 0.5307027145f + (-0.7265760135f); q = q * t + 0.7107068705f; q = q * t + (-0.142248368f); q = q * t + 0.127414796f; q = q * t;
    const f32x2 s = (v * v) * (-0.72134752044f);
    f32x2 e; e.x = __builtin_amdgcn_exp2f(s.x); e.y = __builtin_amdgcn_exp2f(s.y);
    const f32x2 m = v * (q * e), r = v - m;
    f32x2 o; o.x = v.x < 0.f ? m.x : r.x; o.y = v.y < 0.f ? m.y : r.y; return o;
}

template <int ACT  > struct EpiBf16 {
    static constexpr bool PERM = true, AFTER_DRAIN = false; static_assert(ACT == 0 || ACT == 1, "EpiBf16: ACT is 0 (none) or 1 (gelu_pk)");
    bf16_t* O; int ldc; const float* bias; int split_cols; size_t split_stride; float scale0;
    __device__ __forceinline__ void operator()(const f32x4 (&acc)[2][2][4][2], const Unit& u, int wr, int wc, int fr, int fq) const {
        const int row0 = u.pm * BM + wr * 64 + fr; int colt = u.pn * BM; bf16_t* base = O;
        float sc = 1.f; if (split_cols) { const int t = colt / split_cols; base += (size_t)t * split_stride; colt -= t * split_cols; if (t == 0) sc = scale0; }
        const int col0 = colt + wc * 32 + 8 * fq, bcol0 = u.pn * BM + wc * 32 + 8 * fq;
        f32x4 bv[2][2];
#pragma unroll
        for (int bj = 0; bj < 2; ++bj)
#pragma unroll
            for (int n = 0; n < 2; ++n) bv[bj][n] = bias ? *(const f32x4*)(bias + bcol0 + bj * HALF + 4 * n) : (f32x4){0.f, 0.f, 0.f, 0.f};
#pragma unroll
        for (int ai = 0; ai < 2; ++ai)
#pragma unroll
            for (int m = 0; m < 4; ++m) { bf16_t* rowp = base + (size_t)(row0 + ai * HALF + m * 16) * ldc + col0;
#pragma unroll
                for (int bj = 0; bj < 2; ++bj) { f32x4 v0 = acc[ai][bj][m][0] + bv[bj][0], v1 = acc[ai][bj][m][1] + bv[bj][1];
                    if (ACT == 1) { f32x2 a = gelu_pk((f32x2){v0[0], v0[1]}), b = gelu_pk((f32x2){v0[2], v0[3]}), c = gelu_pk((f32x2){v1[0], v1[1]}), d = gelu_pk((f32x2){v1[2], v1[3]});
                        v0 = (f32x4){a.x, a.y, b.x, b.y}; v1 = (f32x4){c.x, c.y, d.x, d.y}; }
                    v0 = v0 * sc; v1 = v1 * sc; u32x4 w; w.x = cvt_pk_bf16(v0[0], v0[1]); w.y = cvt_pk_bf16(v0[2], v0[3]); w.z = cvt_pk_bf16(v1[0], v1[1]); w.w = cvt_pk_bf16(v1[2], v1[3]);
                    *(u32x4*)(rowp + bj * HALF) = w; } }
    }
};

typedef unsigned u32x2 __attribute__((ext_vector_type(2)));
struct EpiResid {
    static constexpr bool PERM = false, AFTER_DRAIN = false;
    const float* base; float* out; int ldc; bf16_t* xb; u64_t* rowsq;
    __device__ __forceinline__ void operator()(const f32x4 (&acc)[2][2][4][2], const Unit& u, int wr, int wc, int fr, int fq) const {
        const int col0 = u.pn * BM + wc * 32 + 4 * fq;
#pragma unroll
        for (int ai = 0; ai < 2; ++ai)
#pragma unroll
            for (int m = 0; m < 4; ++m) { const int row = u.pm * BM + ai * HALF + wr * 64 + m * 16 + fr; const size_t off = (size_t)row * ldc + col0; float ss = 0.f;
#pragma unroll
                for (int bj = 0; bj < 2; ++bj)
#pragma unroll
                    for (int n = 0; n < 2; ++n) { const f32x4 bs = *(const f32x4*)(base + off + bj * HALF + n * 16); const f32x4 o = bs + acc[ai][bj][m][n]; *(f32x4*)(out + off + bj * HALF + n * 16) = o;
                        ss += (o[0] * o[0] + o[1] * o[1]) + (o[2] * o[2] + o[3] * o[3]);
                        u32x2 w; w.x = cvt_pk_bf16(o[0], o[1]); w.y = cvt_pk_bf16(o[2], o[3]); *(u32x2*)(xb + off + bj * HALF + n * 16) = w; }
                ss += shx(ss, 16, fr + 16 * fq); ss += shx(ss, 32, fr + 16 * fq);
                if (fq == 0) atomicAdd(rowsq + row, rowsq_fx(ss)); }
    }
};
struct EpiBf16Row {
    static constexpr bool PERM = true, AFTER_DRAIN = false;
    bf16_t* O; int ldc; const u64_t* rowsq;
    __device__ __forceinline__ void operator()(const f32x4 (&acc)[2][2][4][2], const Unit& u, int wr, int wc, int fr, int fq) const {
        const int row0 = u.pm * BM + wr * 64 + fr, col0 = u.pn * BM + wc * 32 + 8 * fq;
#pragma unroll
        for (int ai = 0; ai < 2; ++ai)
#pragma unroll
            for (int m = 0; m < 4; ++m) { const int row = row0 + ai * HALF + m * 16; const float rs = rowsq_rs(rowsq, row); bf16_t* rowp = O + (size_t)row * ldc + col0;
#pragma unroll
                for (int bj = 0; bj < 2; ++bj) { const f32x4 v0 = acc[ai][bj][m][0] * rs, v1 = acc[ai][bj][m][1] * rs; u32x4 w; w.x = cvt_pk_bf16(v0[0], v0[1]); w.y = cvt_pk_bf16(v0[2], v0[3]); w.z = cvt_pk_bf16(v1[0], v1[1]); w.w = cvt_pk_bf16(v1[2], v1[3]);
                    *(u32x4*)(rowp + bj * HALF) = w; } }
    }
};
struct EpiQKV {
    static constexpr bool PERM = false, AFTER_DRAIN = false;
    bf16_t* O; const float* ga; const float* gb; const float* gc; const float* rope; const u64_t* rowsq;
    __device__ __forceinline__ void operator()(const f32x4 (&acc)[2][2][4][2], const Unit& u, int wr, int wc, int fr, int fq) const {
        const int hg = u.pn * 4 + wc;
        const float* g = nullptr; bool isq = false, dorope = false;
        if (hg < 12) { g = ga; isq = true; } else if (hg < 16) { g = ga + 64; } else if (hg < 20) { }
        else if (hg < 28) { g = gb; isq = true; } else if (hg < 36) { g = gb + 64; } else if (hg < 44) { }
        else if (hg < 56) { g = gc; isq = true; dorope = true; } else if (hg < 60) { g = gc + 64; dorope = true; }
        const float qs = isq ? 0.125f : 1.0f;
#pragma unroll
        for (int ai = 0; ai < 2; ++ai)
#pragma unroll
            for (int m = 0; m < 4; ++m) {
                const int row = u.pm * BM + ai * HALF + wr * 64 + m * 16 + fr;
                f32x4 v[2][2];
                const float rsx = rowsq_rs(rowsq, row);
#pragma unroll
                for (int bj = 0; bj < 2; ++bj)
#pragma unroll
                    for (int n = 0; n < 2; ++n) v[bj][n] = acc[ai][bj][m][n] * rsx;
                if (g) {
                    float ss = 0.f;
#pragma unroll
                    for (int bj = 0; bj < 2; ++bj)
#pragma unroll
                        for (int n = 0; n < 2; ++n) { const f32x4 x = v[bj][n]; ss += (x[0] * x[0] + x[1] * x[1]) + (x[2] * x[2] + x[3] * x[3]); }
                    ss += shx(ss, 16, fr + 16 * fq); ss += shx(ss, 32, fr + 16 * fq);
                    const float r = qs / sqrtf(ss * (1.0f / 64.0f) + 1e-6f);
#pragma unroll
                    for (int bj = 0; bj < 2; ++bj)
#pragma unroll
                        for (int n = 0; n < 2; ++n) v[bj][n] = v[bj][n] * *(const f32x4*)(g + 32 * bj + 16 * n + 4 * fq) * r;
                }
                if (dorope) {
                    const int t = row & 2047, pr = t >> 6, pc = t & 63;
#pragma unroll
                    for (int bj = 0; bj < 2; ++bj) {
                        const int pos = bj ? pc : pr;
                        const float* rp = rope + (size_t)(pos * 16 + 4 * fq) * 2;
                        const f32x4 c01 = *(const f32x4*)rp, c23 = *(const f32x4*)(rp + 4);
                        const f32x4 cs = (f32x4){c01[0], c01[2], c23[0], c23[2]}, sn = (f32x4){c01[1], c01[3], c23[1], c23[3]};
                        const f32x4 x1 = v[bj][0], x2 = v[bj][1];
                        v[bj][0] = x1 * cs - x2 * sn; v[bj][1] = x1 * sn + x2 * cs;
                    }
                }
                bf16_t* rowp = O + (size_t)row * 4096 + hg * 64 + 4 * fq;
#pragma unroll
                for (int bj = 0; bj < 2; ++bj)
#pragma unroll
                    for (int n = 0; n < 2; ++n) { u32x2 w; w.x = cvt_pk_bf16(v[bj][n][0], v[bj][n][1]); w.y = cvt_pk_bf16(v[bj][n][2], v[bj][n][3]); *(u32x2*)(rowp + 32 * bj + 16 * n) = w; }
                asm volatile("" ::: "memory");
            }
    }
};
template <class Epi, class Sched, bool ALIGN_EPI = false, bool SP2 = false>
__device__ __forceinline__ void gemm_phase(PG8_LAS unsigned char* lds, const Gemm g, const Sched& S, const Epi& E, const int tid) {
    const int wid = __builtin_amdgcn_readfirstlane(tid >> 6), lane = tid & 63, wr = wid >> 2, wc = wid & 3, fr = lane & 15, fq = lane >> 4;
    const int K = g.K, nt = K / BK;
    unsigned voffA[2], voffB[2];
#pragma unroll
    for (int i = 0; i < 2; ++i) { int R, C; stage_rc(tid * 16 + i * 8192, R, C); const int Rb = Epi::PERM ? ((R & ~31) + perm32(R & 31)) : R;
        voffA[i] = (unsigned)(R * K + C) * 2u; voffB[i] = (unsigned)(Rb * K + C) * 2u; }
    const size_t kstep = (size_t)(BK * 2);
    const size_t hstep = (size_t)HALF * K * 2;
    const size_t tstep = 2 * hstep;
    const unsigned ldsw = (unsigned)wid * 1024u;
    const int aoff = lds_byte(wr * 64 + fr, fq * 8), boff = lds_byte(wc * 32 + fr, fq * 8);
#define PG8_SA(b, h) (((b) * 2 + (h)) * HTB)
#define PG8_SB(b, h) ((4 + (b) * 2 + (h)) * HTB)
#define PG8_STAGE(bufoff, gbase, voff) do { _Pragma("unroll") for (int _i = 0; _i < 2; ++_i) \
        __builtin_amdgcn_global_load_lds((const unsigned*)((const char*)(gbase) + (voff)[_i]), (PG8_LAS unsigned*)(lds + (bufoff) + ldsw + _i * 8192), 16, 0, 0); } while (0)
#define PG8_LDA(dst, b, h) do { _Pragma("unroll") for (int m = 0; m < 4; ++m) _Pragma("unroll") for (int k = 0; k < 2; ++k) dst[m][k] = *(const PG8_LAS bf16x8*)(lds + PG8_SA(b, h) + aoff + m * 2048 + k * 1024); } while (0)
#define PG8_LDB(dst, b, h) do { _Pragma("unroll") for (int n = 0; n < 2; ++n) _Pragma("unroll") for (int k = 0; k < 2; ++k) dst[n][k] = *(const PG8_LAS bf16x8*)(lds + PG8_SB(b, h) + boff + n * 2048 + k * 1024); } while (0)
#define PG8_MMA(ai, bj, At, Bt) do { __builtin_amdgcn_s_setprio(1); _Pragma("unroll") for (int m = 0; m < 4; ++m) _Pragma("unroll") for (int n = 0; n < 2; ++n) _Pragma("unroll") for (int k = 0; k < 2; ++k) \
        acc[ai][bj][m][n] = __builtin_amdgcn_mfma_f32_16x16x32_bf16(Bt[n][k], At[m][k], acc[ai][bj][m][n], 0, 0, 0); __builtin_amdgcn_s_setprio(0); } while (0)
#define PG8_WAIT_V(n) asm volatile("s_waitcnt vmcnt(" #n ")" ::: "memory")
#define PG8_WAIT_L(n) asm volatile("s_waitcnt lgkmcnt(" #n ")" ::: "memory")
#define PG8_BAR __builtin_amdgcn_s_barrier()
#define PG8_SCHED __builtin_amdgcn_sched_barrier(0)
    Unit cur, nxt; int ui = 0;
    if (!S.next(0, cur)) return;
    f32x4 acc[2][2][4][2];
#pragma unroll
    for (int a = 0; a < 2; ++a)
#pragma unroll
        for (int b = 0; b < 2; ++b)
#pragma unroll
            for (int m = 0; m < 4; ++m)
#pragma unroll
                for (int n = 0; n < 2; ++n) acc[a][b][m][n] = (f32x4){0.f, 0.f, 0.f, 0.f};
    bf16x8 At[4][2], B0[2][2], B1[2][2];
    const char* cA = (const char*)g.A + (size_t)cur.pm * tstep; const char* cB = (const char*)g.Bt + (size_t)cur.pn * tstep;
    S.a_ready(cur);
    if constexpr (SP2) {
        PG8_STAGE(PG8_SB(0, 0), cB, voffB); PG8_STAGE(PG8_SB(0, 1), cB + hstep, voffB); PG8_STAGE(PG8_SA(0, 0), cA, voffA); PG8_STAGE(PG8_SA(0, 1), cA + hstep, voffA);
        if (wr == 1) PG8_BAR;
        PG8_WAIT_V(2); PG8_BAR;
        PG8_STAGE(PG8_SB(1, 0), cB + kstep, voffB); PG8_STAGE(PG8_SA(1, 0), cA + kstep, voffA); PG8_STAGE(PG8_SB(1, 1), cB + hstep + kstep, voffB);
        PG8_WAIT_V(6); PG8_BAR;
    } else {
        PG8_STAGE(PG8_SB(0, 0), cB, voffB); PG8_STAGE(PG8_SA(0, 0), cA, voffA); PG8_STAGE(PG8_SB(0, 1), cB + hstep, voffB); PG8_STAGE(PG8_SA(0, 1), cA + hstep, voffA);
        if (wr == 1) PG8_BAR;
        PG8_WAIT_V(4); PG8_BAR;
        PG8_STAGE(PG8_SB(1, 0), cB + kstep, voffB); PG8_STAGE(PG8_SA(1, 0), cA + kstep, voffA); PG8_STAGE(PG8_SB(1, 1), cB + hstep + kstep, voffB);
        PG8_WAIT_V(6); PG8_BAR;
    }
    for (;;) {
        const bool has_next = S.next(ui + 1, nxt);
        const char* nA = has_next ? (const char*)g.A + (size_t)nxt.pm * tstep : cA; const char* nB = has_next ? (const char*)g.Bt + (size_t)nxt.pn * tstep : cB;
        for (int t = 0; t < nt; t += 2) {
            const bool last = (t == nt - 2);
            const char* a1 = cA + (size_t)(t + 1) * kstep;
            const char* a2 = last ? nA : cA + (size_t)(t + 2) * kstep; const char* b2 = last ? nB : cB + (size_t)(t + 2) * kstep;
            const char* a3 = a2 + kstep; const char* b3 = b2 + kstep;
            if (last && has_next) S.a_ready(nxt);
            if constexpr (SP2) {
            PG8_LDB(B0, 0, 0); PG8_LDB(B1, 0, 1); PG8_SCHED; PG8_LDA(At, 0, 0); PG8_STAGE(PG8_SA(1, 1), a1 + hstep, voffA);
            PG8_WAIT_V(8); PG8_WAIT_L(0); PG8_BAR; PG8_MMA(0, 0, At, B0); PG8_MMA(0, 1, At, B1); PG8_BAR; PG8_SCHED;
            PG8_LDA(At, 0, 1); PG8_STAGE(PG8_SB(0, 0), b2, voffB); PG8_STAGE(PG8_SB(0, 1), b2 + hstep, voffB); PG8_STAGE(PG8_SA(0, 0), a2, voffA);
            PG8_WAIT_V(8); PG8_WAIT_L(0); PG8_BAR; PG8_MMA(1, 0, At, B0); PG8_MMA(1, 1, At, B1); PG8_BAR; PG8_SCHED;
            PG8_LDB(B0, 1, 0); PG8_LDB(B1, 1, 1); PG8_SCHED; PG8_LDA(At, 1, 0); PG8_STAGE(PG8_SA(0, 1), a2 + hstep, voffA);
            PG8_WAIT_V(8); PG8_WAIT_L(0); PG8_BAR; PG8_MMA(0, 0, At, B0); PG8_MMA(0, 1, At, B1); PG8_BAR; PG8_SCHED;
            PG8_LDA(At, 1, 1); PG8_STAGE(PG8_SB(1, 0), b3, voffB); PG8_STAGE(PG8_SB(1, 1), b3 + hstep, voffB); PG8_STAGE(PG8_SA(1, 0), a3, voffA);
            PG8_WAIT_V(8); PG8_WAIT_L(0); PG8_BAR; PG8_MMA(1, 0, At, B0); PG8_MMA(1, 1, At, B1); PG8_BAR; PG8_SCHED;
            } else {
            PG8_LDB(B0, 0, 0); PG8_SCHED; PG8_LDA(At, 0, 0); PG8_STAGE(PG8_SA(1, 1), a1 + hstep, voffA);
            PG8_WAIT_L(8); PG8_BAR; PG8_WAIT_L(0); PG8_MMA(0, 0, At, B0); PG8_BAR; PG8_SCHED;
            PG8_LDB(B1, 0, 1); PG8_STAGE(PG8_SB(0, 0), b2, voffB);
            PG8_BAR; PG8_WAIT_L(0); PG8_MMA(0, 1, At, B1); PG8_BAR;
            PG8_LDA(At, 0, 1); PG8_STAGE(PG8_SA(0, 0), a2, voffA);
            PG8_BAR; PG8_WAIT_L(0); PG8_MMA(1, 0, At, B0); PG8_BAR; PG8_SCHED;
            PG8_STAGE(PG8_SB(0, 1), b2 + hstep, voffB);
            PG8_WAIT_V(6); PG8_BAR; PG8_MMA(1, 1, At, B1); PG8_BAR;
            PG8_LDB(B0, 1, 0); PG8_SCHED; PG8_LDA(At, 1, 0); PG8_STAGE(PG8_SA(0, 1), a2 + hstep, voffA);
            PG8_WAIT_L(8); PG8_BAR; PG8_WAIT_L(0); PG8_MMA(0, 0, At, B0); PG8_BAR; PG8_SCHED;
            PG8_LDB(B1, 1, 1); PG8_STAGE(PG8_SB(1, 0), b3, voffB);
            PG8_BAR; PG8_WAIT_L(0); PG8_MMA(0, 1, At, B1); PG8_BAR;
            PG8_LDA(At, 1, 1); PG8_STAGE(PG8_SA(1, 0), a3, voffA);
            PG8_BAR; PG8_WAIT_L(0); PG8_MMA(1, 0, At, B0); PG8_BAR; PG8_SCHED;
            PG8_STAGE(PG8_SB(1, 1), b3 + hstep, voffB);
            PG8_WAIT_V(6); PG8_BAR; PG8_MMA(1, 1, At, B1); PG8_BAR;
            }
        }
        if constexpr (ALIGN_EPI) { if (wr == 0) PG8_BAR; }
        if constexpr (!Epi::AFTER_DRAIN) { E(acc, cur, wr, wc, fr, fq); S.done(cur); }
        if (!has_next) break;
#pragma unroll
        for (int a = 0; a < 2; ++a)
#pragma unroll
            for (int b = 0; b < 2; ++b)
#pragma unroll
                for (int m = 0; m < 4; ++m)
#pragma unroll
                    for (int n = 0; n < 2; ++n) acc[a][b][m][n] = (f32x4){0.f, 0.f, 0.f, 0.f};
        cur = nxt; cA = nA; cB = nB; ++ui;
        if constexpr (ALIGN_EPI) { if (wr == 1) PG8_BAR; }
    }
    PG8_WAIT_V(0);
    if constexpr (!ALIGN_EPI) { if (wr == 0) PG8_BAR; }
    PG8_BAR;
    if constexpr (Epi::AFTER_DRAIN) { E.fused(acc, cur, wr, wc, fr, fq, lds, wid, lane); S.done(cur); }
#undef PG8_SA
#undef PG8_SB
#undef PG8_STAGE
#undef PG8_LDA
#undef PG8_LDB
#undef PG8_MMA
#undef PG8_WAIT_V
#undef PG8_WAIT_L
#undef PG8_BAR
#undef PG8_SCHED
}
}

constexpr int BATCH = 16, SEQ = 2048, DM = 2048, T = BATCH * SEQ, DEPTH = 2;
constexpr int NMEM = 256, DIN = 4096, MEMW = 512;
constexpr int PEER_H = 8, PEER_N = 16384;
constexpr int NWAVES = 8, NTHREADS = NWAVES * 64;
constexpr float EPS = 1e-6f;
constexpr int QA = 0, KA = 768, VA = 1024, QB = 1280, KB = 1792, VB = 2304, QC = 2816, KC = 3584, VC = 3840;
constexpr int OA = 0, OB = 768, OC = 1280;

constexpr size_t MiB = 1u << 20;
constexpr size_t WS_CTL = 0, CTL_ZERO_BYTES = 2 * MiB;
constexpr size_t WS_ROWSQ = 256 * 1024;
constexpr size_t WS_ROPE = 83 * MiB, WS_BIASA = 83 * MiB + 16384;
constexpr size_t WS_WIN = 2 * MiB, WS_WOUT = 34 * MiB, WS_WMQ = 50 * MiB, WS_WMKV = 54 * MiB, WS_WMO = 62 * MiB, WS_WPQ = 66 * MiB, WS_PKEYS = 82 * MiB;
constexpr size_t WS_MEMN = 84 * MiB, WS_KVM = 116 * MiB, WS_PU = 132 * MiB, WS_PV = 260 * MiB, WS_XN = 388 * MiB, WS_QKV = 516 * MiB, WS_ATT = 772 * MiB;
constexpr size_t WS_QM = 900 * MiB, WS_OM = 932 * MiB, WS_END = 964 * MiB;
constexpr size_t WS_QP = WS_QKV, WS_PIDX = WS_QKV + 128 * MiB, WS_PGATE = WS_QKV + 144 * MiB;
constexpr int CW_BAR = 4096;

constexpr int RING_OFF = 0, RING_BYTES = 131072;
constexpr int LDSCTL_OFF = RING_BYTES, MISC_OFF = LDSCTL_OFF + 320;
constexpr int LDS_BYTES = 147456;

#define GAS __attribute__((address_space(1)))
#define LAS __attribute__((address_space(3)))
typedef unsigned short bf16;
typedef unsigned v4u __attribute__((ext_vector_type(4)));
typedef unsigned v2u __attribute__((ext_vector_type(2)));
typedef float f32x4 __attribute__((ext_vector_type(4)));
typedef float f32x16 __attribute__((ext_vector_type(16)));
typedef short bf16x8 __attribute__((ext_vector_type(8)));
typedef GAS unsigned gu32;
#define LDS_WAIT() asm volatile("s_waitcnt lgkmcnt(0)" ::: "memory")
#define VM_WAIT() asm volatile("s_waitcnt vmcnt(0)" ::: "memory")
__device__ __forceinline__ unsigned f2bf(float f) { unsigned u = __builtin_bit_cast(unsigned, f); return (u + 0x7fffu + ((u >> 16) & 1u)) >> 16; }
__device__ __forceinline__ unsigned pk2(float lo, float hi) { return f2bf(lo) | (f2bf(hi) << 16); }
__device__ __forceinline__ float bflo(unsigned w) { return __builtin_bit_cast(float, w << 16); }
__device__ __forceinline__ float bfhi(unsigned w) { return __builtin_bit_cast(float, w & 0xffff0000u); }

__device__ __forceinline__ float shx(float v, int k, int lane) { return __builtin_bit_cast(float, __builtin_amdgcn_ds_bpermute((lane ^ k) << 2, __builtin_bit_cast(int, v))); }
#define XB_TMO      128
#define XB_XCNT(j)  (256  + 64 * (j))
#define XB_XSUB(j)  (1280 + 64 * (j))
#define XB_XGEN(j)  (2304 + 64 * (j))
#define XB_TOP      3328
#define XB_TOPGEN   3392
#define XCD_BAR_WORDS 3456
#define XB_SPIN_CAP (1u << 18)

__device__ __forceinline__ unsigned xb_ld(unsigned* p)              { return __hip_atomic_load(p, __ATOMIC_RELAXED, __HIP_MEMORY_SCOPE_AGENT); }
__device__ __forceinline__ unsigned xb_add(unsigned* p, unsigned v) { return __hip_atomic_fetch_add(p, v, __ATOMIC_RELAXED, __HIP_MEMORY_SCOPE_AGENT); }
__device__ __forceinline__ unsigned xb_xcc_id() { return (unsigned)__builtin_amdgcn_s_getreg((3 << 11) | 20) & 0xFu; }
#define XB_SPIN(cond, bar) do { unsigned _sp = 0; while (cond) { __builtin_amdgcn_s_sleep(1); \
    if ((++_sp & 255u) == 0u) { if (xb_ld(&(bar)[XB_TMO])) break; if (_sp > XB_SPIN_CAP) { atomicAdd(&(bar)[XB_TMO], 1u); break; } } } } while (0)

struct XcdBarrier {
    unsigned* bar; unsigned x;
    volatile LAS unsigned* st;
};

__device__ __forceinline__ XcdBarrier xcd_barrier_post(unsigned* bar, volatile LAS unsigned* st) {
    XcdBarrier b; b.bar = bar; b.x = xb_xcc_id(); b.st = st;
    if (threadIdx.x == 0) (void)xb_add(&bar[XB_XCNT(b.x)], 1u);
    return b;
}
__device__ __forceinline__ void xcd_barrier_complete(unsigned* bar, unsigned x, unsigned& nloc, unsigned& nx) {
    const unsigned G = gridDim.x * gridDim.y * gridDim.z;
    unsigned sum, cnt, mine, sp = 0u;
    for (;;) {
        sum = 0u; cnt = 0u; mine = 0u;
#pragma unroll
        for (unsigned j = 0; j < 16; ++j) { const unsigned c = xb_ld(&bar[XB_XCNT(j)]); sum += c; cnt += (c > 0u) ? 1u : 0u; mine = (j == x) ? c : mine; }
        if (sum == G) break;
        __builtin_amdgcn_s_sleep(1);
        if ((++sp & 255u) == 0u) { if (xb_ld(&bar[XB_TMO])) break; if (sp > XB_SPIN_CAP) { atomicAdd(&bar[XB_TMO], 1u); break; } }
    }
    nloc = mine > 0u ? mine : 1u; nx = cnt > 0u ? cnt : 1u;
}

__device__ __forceinline__ void xcd_barrier(const XcdBarrier& b) {
    asm volatile("s_waitcnt vmcnt(0)" ::: "memory");
    __syncthreads();
    if (threadIdx.x == 0) {
        unsigned* bar = b.bar;
        __builtin_amdgcn_s_waitcnt(0);
        unsigned nloc = b.st[0], nx = b.st[1];
        if (nloc == 0u) { xcd_barrier_complete(bar, b.x, nloc, nx); b.st[0] = nloc; b.st[1] = nx; }
        const unsigned old = xb_add(&bar[XB_XSUB(b.x)], 1u);
        const unsigned gen = old / nloc;
        if (old + 1u == (gen + 1u) * nloc) {
            __builtin_amdgcn_fence(__ATOMIC_RELEASE, "agent");
            asm volatile("s_waitcnt vmcnt(0)" ::: "memory");
            const unsigned og = xb_add(&bar[XB_TOP], 1u);
            const unsigned tg = og / nx;
            if (og + 1u == (tg + 1u) * nx) xb_add(&bar[XB_TOPGEN], 1u);
            else XB_SPIN(xb_ld(&bar[XB_TOPGEN]) == tg, bar);
            __builtin_amdgcn_fence(__ATOMIC_ACQUIRE, "agent");
            xb_add(&bar[XB_XGEN(b.x)], 1u);
            asm volatile("s_waitcnt vmcnt(0)" ::: "memory");
        } else {
            XB_SPIN(xb_ld(&bar[XB_XGEN(b.x)]) == gen, bar);
            __builtin_amdgcn_fence(__ATOMIC_ACQUIRE, "agent");
            asm volatile("s_waitcnt vmcnt(0)" ::: "memory");
        }
    }
    __syncthreads();
}

__device__ __forceinline__ float wave_sum(float v, int lane) {
#pragma unroll
    for (int o = 1; o < 64; o <<= 1) v += shx(v, o, lane);
    return v;
}
__device__ __forceinline__ void* ldptr(LAS unsigned char* lds, int i) {
    const unsigned long long v = ((const LAS unsigned long long*)(lds + LDSCTL_OFF + 1024))[i];
    const unsigned lo = __builtin_amdgcn_readfirstlane((unsigned)v), hi = __builtin_amdgcn_readfirstlane((unsigned)(v >> 32));
    return (void*)(((unsigned long long)hi << 32) | lo);
}
struct OffsetOrder {
    pg8::StaticOrder S;
    __device__ void init(int M, int N, int G, int c, int off) { S.init(M, N, G, (c + G - off % G) % G); }
    __device__ bool next(int i, pg8::Unit& u) const { return S.next(i, u); }
    __device__ __forceinline__ void a_ready(const pg8::Unit&) const {}
    __device__ __forceinline__ void done(const pg8::Unit&) const {}
};

template <bool PERMQKV>
__device__ __forceinline__ void transpose_item(const float* W, int K, int N, bf16* WT, LAS float* scr, int item, int lane, const float* gk = nullptr) {
    const int nblk = N / 32, kb = item / nblk, nb = item % nblk, k0 = 64 * kb, n0 = 32 * nb;
    int d0 = n0;
    if (PERMQKV) { const int within = n0 & 255; d0 = (n0 & ~255) + 128 * ((within >> 5) & 1) + 32 * (within >> 6); }
#pragma unroll 8
    for (int i = 0; i < 32; ++i) { const int kk = 2 * i + (lane >> 5); scr[kk * 33 + (lane & 31)] = W[(size_t)(k0 + kk) * N + n0 + (lane & 31)] * (gk ? gk[k0 + kk] : 1.f); }
    LDS_WAIT(); asm volatile("" ::: "memory");
    const int c = lane & 7;
#pragma unroll
    for (int j = 0; j < 4; ++j) { const int n = (lane >> 3) + 8 * j; const LAS float* s = scr + (8 * c) * 33 + n;
        v4u o; o.x = pk2(s[0 * 33], s[1 * 33]); o.y = pk2(s[2 * 33], s[3 * 33]); o.z = pk2(s[4 * 33], s[5 * 33]); o.w = pk2(s[6 * 33], s[7 * 33]);
        *(GAS v4u*)(WT + (size_t)(d0 + n) * K + k0 + 8 * c) = o; }
    LDS_WAIT(); asm volatile("" ::: "memory");
}
__device__ __forceinline__ void convert_bf16(const float* src, bf16* dst, size_t n, size_t gtid, size_t nthreads) {
    for (size_t i = gtid * 8; i < n; i += nthreads * 8) {
        const f32x4 a = *(const GAS f32x4*)(src + i), b = *(const GAS f32x4*)(src + i + 4);
        v4u o; o.x = pk2(a[0], a[1]); o.y = pk2(a[2], a[3]); o.z = pk2(b[0], b[1]); o.w = pk2(b[2], b[3]);
        *(GAS v4u*)(dst + i) = o;
    }
}
__device__ __forceinline__ int t5_bucket(int rel) {
    const int n = rel < 0 ? -rel : rel;
    const int b = n < 8 ? n : n < 12 ? 8 : n < 16 ? 9 : n < 23 ? 10 : n < 32 ? 11 : n < 46 ? 12 : n < 64 ? 13 : n < 91 ? 14 : 15;
    return b + (rel > 0 ? 16 : 0);
}
__constant__ float ROPE_INV[16] = {1.000000000e+00f, 5.623413324e-01f, 3.162277639e-01f, 1.778279394e-01f, 1.000000015e-01f, 5.623413250e-02f, 3.162277490e-02f, 1.778279431e-02f,
                                   9.999999776e-03f, 5.623413250e-03f, 3.162277630e-03f, 1.778279431e-03f, 1.000000047e-03f, 5.623413017e-04f, 3.162277571e-04f, 1.778279402e-04f};

__device__ __forceinline__ void rms_row_to_bf16(const float* xrow, const float* g0, bf16* o0, const float* g1, bf16* o1, int lane) {
    const GAS f32x4* xr = (const GAS f32x4*)xrow + lane;
    f32x4 v[8]; float s = 0.f;
#pragma unroll
    for (int j = 0; j < 8; ++j) { v[j] = xr[64 * j]; s += (v[j].x * v[j].x + v[j].y * v[j].y) + (v[j].z * v[j].z + v[j].w * v[j].w); }
    const float rstd = 1.f / sqrtf(wave_sum(s, lane) * (1.f / DM) + EPS);
    {   const GAS f32x4* gr = (const GAS f32x4*)g0 + lane; GAS v2u* o8 = (GAS v2u*)o0 + lane;
#pragma unroll
        for (int j = 0; j < 8; ++j) { const f32x4 gg = gr[64 * j]; v2u w; w.x = pk2(v[j].x * rstd * gg.x, v[j].y * rstd * gg.y); w.y = pk2(v[j].z * rstd * gg.z, v[j].w * rstd * gg.w); o8[64 * j] = w; } }
    if (g1) { const GAS f32x4* gr = (const GAS f32x4*)g1 + lane; GAS v2u* o8 = (GAS v2u*)o1 + lane;
#pragma unroll
        for (int j = 0; j < 8; ++j) { const f32x4 gg = gr[64 * j]; v2u w; w.x = pk2(v[j].x * rstd * gg.x, v[j].y * rstd * gg.y); w.y = pk2(v[j].z * rstd * gg.z, v[j].w * rstd * gg.w); o8[64 * j] = w; } }
}
__device__ __forceinline__ void prep_row(const float* xrow, bf16* orow, u64_t* sq, int lane) {
    const GAS f32x4* xr = (const GAS f32x4*)xrow + lane; GAS v2u* o8 = (GAS v2u*)orow + lane; float s = 0.f;
#pragma unroll
    for (int j = 0; j < 8; ++j) { const f32x4 v = xr[64 * j]; s += (v.x * v.x + v.y * v.y) + (v.z * v.z + v.w * v.w); v2u w; w.x = pk2(v.x, v.y); w.y = pk2(v.z, v.w); o8[64 * j] = w; }
    s = wave_sum(s, lane);
    if (lane == 0) *sq = rowsq_fx(s);
}
__device__ __forceinline__ void norm_rows(const float* X, const float* g, bf16* XN, int gw, int NGW, int lane) {
    for (int m = gw; m < T; m += NGW) rms_row_to_bf16(X + (size_t)m * DM, g, XN + (size_t)m * DM, nullptr, nullptr, lane);
}

template <int TYPE>
__device__ __forceinline__ void naive_attn_item(const bf16* QKV, bf16* ATT, int b, int grow, int head, int lane, const float* biasA, const float* sink, const float* rpb) {
    const int tpos = grow * 64 + lane; const size_t trow = (size_t)b * SEQ + tpos;
    int qcol, kcol, vcol, ocol;
    if (TYPE == 0) { qcol = QA + head * 64; kcol = KA + (head / 3) * 64; vcol = VA + (head / 3) * 64; ocol = OA + head * 64; }
    else if (TYPE == 1) { qcol = QB + head * 64; kcol = KB + head * 64; vcol = VB + head * 64; ocol = OB + head * 64; }
    else { qcol = QC + head * 64; kcol = KC + (head / 3) * 64; vcol = VC + (head / 3) * 64; ocol = OC + head * 64; }
    float q[64], o[64];
#pragma unroll
    for (int c = 0; c < 8; ++c) { const v4u w = *(const GAS v4u*)(QKV + trow * DIN + qcol + 8 * c);
        q[8 * c + 0] = bflo(w.x); q[8 * c + 1] = bfhi(w.x); q[8 * c + 2] = bflo(w.y); q[8 * c + 3] = bfhi(w.y); q[8 * c + 4] = bflo(w.z); q[8 * c + 5] = bfhi(w.z); q[8 * c + 6] = bflo(w.w); q[8 * c + 7] = bfhi(w.w); }
#pragma unroll
    for (int d = 0; d < 64; ++d) o[d] = 0.f;
    float m = -1e30f, l = 0.f;
    int j0, j1;
    if (TYPE == 0) { j0 = grow * 64 - 128; if (j0 < 0) j0 = 0; j1 = grow * 64 + 63 + 128; if (j1 > SEQ - 1) j1 = SEQ - 1; }
    else if (TYPE == 1) { int r0 = grow - 4; r0 = r0 < 0 ? 0 : (r0 > 24 ? 24 : r0); j0 = r0 * 64; j1 = j0 + 511; }
    else { j0 = 0; j1 = SEQ - 1; }
    int c0 = lane - 8; c0 = c0 < 0 ? 0 : (c0 > 48 ? 48 : c0);
#pragma unroll 1
    for (int j = j0; j <= j1; ++j) {
        const bf16* krow = QKV + ((size_t)b * SEQ + j) * DIN;
        float s = 0.f;
#pragma unroll
        for (int c = 0; c < 8; ++c) { const v4u w = *(const GAS v4u*)(krow + kcol + 8 * c);
            s += q[8 * c + 0] * bflo(w.x) + q[8 * c + 1] * bfhi(w.x) + q[8 * c + 2] * bflo(w.y) + q[8 * c + 3] * bfhi(w.y) + q[8 * c + 4] * bflo(w.z) + q[8 * c + 5] * bfhi(w.z) + q[8 * c + 6] * bflo(w.w) + q[8 * c + 7] * bfhi(w.w); }
        bool valid = true;
        if (TYPE == 0) { const int rel = j - tpos; valid = (rel >= -128 && rel <= 128); if (valid) s += biasA[head * 257 + rel + 128]; }
        if (TYPE == 1) { const int kr = j >> 6, kc = j & 63; valid = (kc >= c0 && kc < c0 + 16); if (valid) s += rpb[(head * 15 + (kr - grow + 7)) * 31 + (kc - lane + 15)]; }
        const float mn = valid ? fmaxf(m, s) : m;
        const float a = __expf(m - mn);
        const float p = valid ? __expf(s - mn) : 0.f;
        l = l * a + p; m = mn;
#pragma unroll
        for (int c = 0; c < 8; ++c) { const v4u w = *(const GAS v4u*)(krow + vcol + 8 * c);
            o[8 * c + 0] = o[8 * c + 0] * a + p * bflo(w.x); o[8 * c + 1] = o[8 * c + 1] * a + p * bfhi(w.x); o[8 * c + 2] = o[8 * c + 2] * a + p * bflo(w.y); o[8 * c + 3] = o[8 * c + 3] * a + p * bfhi(w.y);
            o[8 * c + 4] = o[8 * c + 4] * a + p * bflo(w.z); o[8 * c + 5] = o[8 * c + 5] * a + p * bfhi(w.z); o[8 * c + 6] = o[8 * c + 6] * a + p * bflo(w.w); o[8 * c + 7] = o[8 * c + 7] * a + p * bfhi(w.w); }
    }
    if (TYPE == 0) l += __expf(sink[head] - m);
    const float inv = 1.f / l;
#pragma unroll
    for (int c = 0; c < 8; ++c) { v4u w; w.x = pk2(o[8 * c + 0] * inv, o[8 * c + 1] * inv); w.y = pk2(o[8 * c + 2] * inv, o[8 * c + 3] * inv); w.z = pk2(o[8 * c + 4] * inv, o[8 * c + 5] * inv); w.w = pk2(o[8 * c + 6] * inv, o[8 * c + 7] * inv);
        *(GAS v4u*)(ATT + trow * DM + ocol + 8 * c) = w; }
}
__device__ __forceinline__ float rdl(float v, int l) { return __builtin_bit_cast(float, __builtin_amdgcn_readlane(__builtin_bit_cast(int, v), l)); }
__device__ __forceinline__ void naive_mem_item(const bf16* QM, const bf16* KVM, bf16* OM, const float* gq, size_t trow, int b, int head, int lane) {
    const unsigned qw = *(const GAS unsigned*)(QM + trow * MEMW + head * 128 + 2 * lane);
    float q0 = bflo(qw), q1 = bfhi(qw);
    const float ss = wave_sum(q0 * q0 + q1 * q1, lane);
    const float r = 0.08838834764831845f / sqrtf(ss * (1.f / 128.f) + EPS);
    q0 *= r * gq[2 * lane]; q1 *= r * gq[2 * lane + 1];
    const bf16* kbase = KVM + ((size_t)b * NMEM + lane) * 1024 + head * 128;
    float s[4] = {0.f, 0.f, 0.f, 0.f};
#pragma unroll 1
    for (int c = 0; c < 16; ++c) {
        float qa[8];
#pragma unroll
        for (int e = 0; e < 4; ++e) { qa[2 * e] = rdl(q0, 4 * c + e); qa[2 * e + 1] = rdl(q1, 4 * c + e); }
#pragma unroll
        for (int i = 0; i < 4; ++i) { const v4u w = *(const GAS v4u*)(kbase + (size_t)i * 64 * 1024 + 8 * c);
            s[i] += qa[0] * bflo(w.x) + qa[1] * bfhi(w.x) + qa[2] * bflo(w.y) + qa[3] * bfhi(w.y) + qa[4] * bflo(w.z) + qa[5] * bfhi(w.z) + qa[6] * bflo(w.w) + qa[7] * bfhi(w.w); }
    }
    float m = fmaxf(fmaxf(s[0], s[1]), fmaxf(s[2], s[3]));
#pragma unroll
    for (int o = 1; o < 64; o <<= 1) m = fmaxf(m, shx(m, o, lane));
    float p[4]; float l = 0.f;
#pragma unroll
    for (int i = 0; i < 4; ++i) { p[i] = __expf(s[i] - m); l += p[i]; }
    l = wave_sum(l, lane);
    const bf16* vbase = KVM + ((size_t)b * NMEM) * 1024 + 512 + head * 128 + 2 * lane;
    float o0 = 0.f, o1 = 0.f;
#pragma unroll
    for (int i = 0; i < 4; ++i) {
#pragma unroll 4
        for (int jj = 0; jj < 64; ++jj) { const float pj = rdl(p[i], jj); const unsigned w = *(const GAS unsigned*)(vbase + (size_t)(64 * i + jj) * 1024); o0 += pj * bflo(w); o1 += pj * bfhi(w); }
    }
    const float inv = 1.f / l;
    *(GAS unsigned*)(OM + trow * MEMW + head * 128 + 2 * lane) = pk2(o0 * inv, o1 * inv);
}
__device__ __forceinline__ void mixnorm_rows(bf16* ATT, const float* g, int gw, int NGW, int lane) {
    for (int m = gw; m < T; m += NGW) {
        GAS v4u* p = (GAS v4u*)(ATT + (size_t)m * DM + 32 * lane);
        v4u w[4]; float f[32]; float ss = 0.f;
#pragma unroll
        for (int c = 0; c < 4; ++c) { w[c] = p[c];
            f[8 * c + 0] = bflo(w[c].x); f[8 * c + 1] = bfhi(w[c].x); f[8 * c + 2] = bflo(w[c].y); f[8 * c + 3] = bfhi(w[c].y); f[8 * c + 4] = bflo(w[c].z); f[8 * c + 5] = bfhi(w[c].z); f[8 * c + 6] = bflo(w[c].w); f[8 * c + 7] = bfhi(w[c].w); }
#pragma unroll
        for (int i = 0; i < 32; ++i) ss += f[i] * f[i];
        const int grp = lane < 24 ? 0 : (lane < 40 ? 1 : 2);
        const float sa = wave_sum(grp == 0 ? ss : 0.f, lane), sb = wave_sum(grp == 1 ? ss : 0.f, lane), sc = wave_sum(grp == 2 ? ss : 0.f, lane);
        const float r = grp == 0 ? 1.f / sqrtf(sa * (1.f / 768.f) + EPS) : (grp == 1 ? 1.f / sqrtf(sb * (1.f / 512.f) + EPS) : 1.f / sqrtf(sc * (1.f / 768.f) + EPS));
        const float* gg = g + 32 * lane;
#pragma unroll
        for (int c = 0; c < 4; ++c) { const f32x4 g0 = *(const GAS f32x4*)(gg + 8 * c), g1 = *(const GAS f32x4*)(gg + 8 * c + 4);
            v4u o; o.x = pk2(f[8 * c + 0] * r * g0[0], f[8 * c + 1] * r * g0[1]); o.y = pk2(f[8 * c + 2] * r * g0[2], f[8 * c + 3] * r * g0[3]);
            o.z = pk2(f[8 * c + 4] * r * g1[0], f[8 * c + 5] * r * g1[1]); o.w = pk2(f[8 * c + 6] * r * g1[2], f[8 * c + 7] * r * g1[3]); p[c] = o; }
    }
}

#ifndef PEER_HD
#define PEER_HD __device__ __forceinline__
#define PEER_EXP(x) __expf(x)
#endif
template <int N> PEER_HD void bitonic_sort_desc(float* v) {
#pragma unroll
    for (int k = 2; k <= N; k <<= 1)
#pragma unroll
        for (int j = k >> 1; j > 0; j >>= 1)
#pragma unroll
            for (int i = 0; i < N; ++i) { const int l = i ^ j; if (l > i) { const bool desc = ((i & k) == 0); const float a = v[i], b = v[l]; const float hi = fmaxf(a, b), lo = fminf(a, b);
                v[i] = desc ? hi : lo; v[l] = desc ? lo : hi; } }
}
PEER_HD void merge_top16(float* a, const float* b) {
    float c[16];
#pragma unroll
    for (int i = 0; i < 16; ++i) c[i] = fmaxf(a[i], b[15 - i]);
#pragma unroll
    for (int j = 8; j > 0; j >>= 1)
#pragma unroll
        for (int i = 0; i < 16; ++i) { const int l = i ^ j; if (l > i) { const float x = c[i], y = c[l]; c[i] = fmaxf(x, y); c[l] = fminf(x, y); } }
#pragma unroll
    for (int i = 0; i < 16; ++i) a[i] = c[i];
}
PEER_HD void top16_of_64(float (&v)[64]) {
    bitonic_sort_desc<16>(&v[0]); bitonic_sort_desc<16>(&v[16]); bitonic_sort_desc<16>(&v[32]); bitonic_sort_desc<16>(&v[48]);
    merge_top16(&v[0], &v[16]); merge_top16(&v[32], &v[48]); merge_top16(&v[0], &v[32]);
}
PEER_HD float pack_idx(float s, unsigned idx, unsigned mask) { return __builtin_bit_cast(float, (__builtin_bit_cast(unsigned, s) & ~mask) | idx); }
PEER_HD unsigned low_bits(float s, unsigned mask) { return __builtin_bit_cast(unsigned, s) & mask; }
PEER_HD unsigned pick16(const float* a, unsigned i, unsigned mask) {
    unsigned r = 0;
#pragma unroll
    for (unsigned k = 0; k < 16; ++k) r = (i == k) ? low_bits(a[k], mask) : r;
    return r;
}
PEER_HD void peer_candidates(const float* a, const float* b, int* e, float* gate) {
    float c[64]; int n = 0;
#pragma unroll
    for (int i = 0; i < 16; ++i)
#pragma unroll
        for (int j = 0; j < 16; ++j) if ((i + 1) * (j + 1) <= 16) { c[n] = pack_idx(a[i] + b[j], (unsigned)(i * 16 + j), 0xffu); ++n; }
#pragma unroll
    for (int k = 50; k < 64; ++k) c[k] = -3.0e38f;
    top16_of_64(c);
    float mx = c[0], den = 0.f;
#pragma unroll
    for (int k = 0; k < 16; ++k) { const unsigned id = low_bits(c[k], 0xffu); const unsigned n0 = pick16(a, id >> 4, 0x7fu), n1 = pick16(b, id & 15u, 0x7fu);
        e[k] = (int)(n0 * 128u + n1); gate[k] = PEER_EXP(c[k] - mx); den += gate[k]; }
    const float inv = 1.f / den;
#pragma unroll
    for (int k = 0; k < 16; ++k) gate[k] *= inv;
}

__device__ __forceinline__ void peer_select_unit(const bf16* QP, const bf16* PK, int* PIDX, float* PGATE, int tb, int h, int wave, int lane) {
    const int hh = lane >> 5, tl = lane & 31; const size_t t = (size_t)tb * 256 + wave * 32 + tl;
    float ab[2][16];
#pragma unroll
    for (int p = 0; p < 2; ++p) {
        bf16x8 bq[8];
#pragma unroll
        for (int s = 0; s < 8; ++s) bq[s] = *(const GAS bf16x8*)(QP + t * DM + 256 * h + 128 * p + 16 * s + 8 * hh);
        float v[64];
#pragma unroll
        for (int nb = 0; nb < 4; ++nb) {
            f32x16 acc;
#pragma unroll
            for (int r = 0; r < 16; ++r) acc[r] = 0.f;
            const bf16* kp = PK + ((size_t)((h * 2 + p) * 128 + 32 * nb + tl)) * 128 + 8 * hh;
#pragma unroll
            for (int s = 0; s < 8; ++s) { const bf16x8 ak = *(const GAS bf16x8*)(kp + 16 * s); acc = __builtin_amdgcn_mfma_f32_32x32x16_bf16(ak, bq[s], acc, 0, 0, 0); }
#pragma unroll
            for (int r = 0; r < 16; ++r) v[16 * nb + r] = pack_idx(acc[r], (unsigned)(32 * nb + 8 * (r >> 2) + 4 * hh + (r & 3)), 0x7fu);
        }
        top16_of_64(v);
        float pv[16];
#pragma unroll
        for (int i = 0; i < 16; ++i) pv[i] = shx(v[i], 32, lane);
        merge_top16(&v[0], pv);
#pragma unroll
        for (int i = 0; i < 16; ++i) ab[p][i] = v[i];
    }
    int e[16]; float gate[16];
    peer_candidates(ab[0], ab[1], e, gate);
    if (hh == 0) { GAS v4u* o = (GAS v4u*)(PIDX + t * 128 + h * 16);
#pragma unroll
        for (int c = 0; c < 4; ++c) o[c] = (v4u){(unsigned)e[4 * c], (unsigned)e[4 * c + 1], (unsigned)e[4 * c + 2], (unsigned)e[4 * c + 3]}; }
    else { GAS f32x4* o = (GAS f32x4*)(PGATE + t * 128 + h * 16);
#pragma unroll
        for (int c = 0; c < 4; ++c) o[c] = (f32x4){gate[4 * c], gate[4 * c + 1], gate[4 * c + 2], gate[4 * c + 3]}; }
}

__device__ __forceinline__ float dot8(const v4u& x, const v4u& u) {
    return bflo(x.x) * bflo(u.x) + bfhi(x.x) * bfhi(u.x) + bflo(x.y) * bflo(u.y) + bfhi(x.y) * bfhi(u.y) + bflo(x.z) * bflo(u.z) + bfhi(x.z) * bfhi(u.z) + bflo(x.w) * bflo(u.w) + bfhi(x.w) * bfhi(u.w);
}
__device__ __forceinline__ void axpy8(float* y, float w, const v4u& v) {
    y[0] += w * bflo(v.x); y[1] += w * bfhi(v.x); y[2] += w * bflo(v.y); y[3] += w * bfhi(v.y); y[4] += w * bflo(v.z); y[5] += w * bfhi(v.z); y[6] += w * bflo(v.w); y[7] += w * bfhi(v.w);
}
__device__ __forceinline__ void peer_gather(const bf16* XN, const bf16* PU, const bf16* PV, const int* PIDX, const float* PGATE, float* X, int gw, int NGW, int lane) {
    for (int t = gw; t < T; t += NGW) {
        v4u xv[4];
#pragma unroll
        for (int j = 0; j < 4; ++j) xv[j] = *(const GAS v4u*)(XN + (size_t)t * DM + 8 * lane + 512 * j);
        float y[32];
#pragma unroll
        for (int i = 0; i < 32; ++i) y[i] = 0.f;
        for (int k = 0; k < 128; k += 2) {
            const int e0 = __builtin_amdgcn_readfirstlane(PIDX[(size_t)t * 128 + k]), e1 = __builtin_amdgcn_readfirstlane(PIDX[(size_t)t * 128 + k + 1]);
            const float g0 = PGATE[(size_t)t * 128 + k], g1 = PGATE[(size_t)t * 128 + k + 1];
            v4u u0[4], u1[4], v0[4], v1[4];
#pragma unroll
            for (int j = 0; j < 4; ++j) { u0[j] = *(const GAS v4u*)(PU + (size_t)e0 * DM + 8 * lane + 512 * j); u1[j] = *(const GAS v4u*)(PU + (size_t)e1 * DM + 8 * lane + 512 * j); }
#pragma unroll
            for (int j = 0; j < 4; ++j) { v0[j] = *(const GAS v4u*)(PV + (size_t)e0 * DM + 8 * lane + 512 * j); v1[j] = *(const GAS v4u*)(PV + (size_t)e1 * DM + 8 * lane + 512 * j); }
            float d0 = 0.f, d1 = 0.f;
#pragma unroll
            for (int j = 0; j < 4; ++j) { d0 += dot8(xv[j], u0[j]); d1 += dot8(xv[j], u1[j]); }
            d0 = wave_sum(d0, lane); d1 = wave_sum(d1, lane);
            const float w0 = g0 * 0.5f * d0 * (1.f + erff(d0 * 0.70710678118654752f)), w1 = g1 * 0.5f * d1 * (1.f + erff(d1 * 0.70710678118654752f));
#pragma unroll
            for (int j = 0; j < 4; ++j) { axpy8(&y[8 * j], w0, v0[j]); axpy8(&y[8 * j], w1, v1[j]); }
        }
#pragma unroll
        for (int j = 0; j < 4; ++j) { GAS f32x4* xp = (GAS f32x4*)(X + (size_t)t * DM + 8 * lane + 512 * j);
            f32x4 a = xp[0], b = xp[1]; a += (f32x4){y[8 * j], y[8 * j + 1], y[8 * j + 2], y[8 * j + 3]}; b += (f32x4){y[8 * j + 4], y[8 * j + 5], y[8 * j + 6], y[8 * j + 7]}; xp[0] = a; xp[1] = b; }
    }
}


typedef float f32x2 __attribute__((ext_vector_type(2)));
constexpr float PU_SCALE = 256.f, PV_SCALE = 16.f;
__device__ __forceinline__ void convert_fp8(const float* src, unsigned char* dst, size_t n, float scale, size_t gtid, size_t nthreads) {
    for (size_t i = gtid * 16; i < n; i += nthreads * 16) {
        v4u o;
#pragma unroll
        for (int c = 0; c < 4; ++c) { f32x4 a = *(const GAS f32x4*)(src + i + 4 * c) * scale;
#pragma unroll
            for (int e = 0; e < 4; ++e) a[e] = fminf(fmaxf(a[e], -448.f), 448.f);
            int p = 0; p = __builtin_amdgcn_cvt_pk_fp8_f32(a[0], a[1], p, false); p = __builtin_amdgcn_cvt_pk_fp8_f32(a[2], a[3], p, true); o[c] = (unsigned)p; }
        *(GAS v4u*)(dst + i) = o;
    }
}
__device__ __forceinline__ void dot16_fp8(f32x2& acc, const v4u& w, const f32x2* x) {
#pragma unroll
    for (int c = 0; c < 4; ++c) { acc += __builtin_amdgcn_cvt_pk_f32_fp8((int)w[c], false) * x[2 * c]; acc += __builtin_amdgcn_cvt_pk_f32_fp8((int)w[c], true) * x[2 * c + 1]; }
}
__device__ __forceinline__ void axpy16_fp8(f32x2* y, const f32x2 wv, const v4u& w) {
#pragma unroll
    for (int c = 0; c < 4; ++c) { y[2 * c] += __builtin_amdgcn_cvt_pk_f32_fp8((int)w[c], false) * wv; y[2 * c + 1] += __builtin_amdgcn_cvt_pk_f32_fp8((int)w[c], true) * wv; }
}
#define PG_R 4
#define PG_LOAD(buf, tab, idlo, idhi, g) do { _Pragma("unroll") for (int i_ = 0; i_ < PG_R; ++i_) { const int k_ = (g) * PG_R + i_; \
        const int e_ = __builtin_amdgcn_readlane(k_ < 64 ? idlo : idhi, k_ & 63); const unsigned char* rp_ = (tab) + (size_t)(unsigned)e_ * 2048u; \
        buf[i_][0] = *(const GAS v4u*)(rp_ + voff); buf[i_][1] = *(const GAS v4u*)(rp_ + voff + 1024); } } while (0)
#define PG_DOT(buf, g) do { float p_[4]; _Pragma("unroll") for (int i_ = 0; i_ < 4; ++i_) { f32x2 a_ = {0.f, 0.f}; dot16_fp8(a_, buf[i_][0], &x[0]); dot16_fp8(a_, buf[i_][1], &x[8]); p_[i_] = a_.x + a_.y; __builtin_amdgcn_sched_barrier(0); } \
        float r_[2]; _Pragma("unroll") for (int i_ = 0; i_ < 2; ++i_) { const float keep_ = b5 ? p_[i_ + 2] : p_[i_], send_ = b5 ? p_[i_] : p_[i_ + 2]; r_[i_] = keep_ + shx(send_, 32, lane); } \
        float s_; { const float keep_ = b4 ? r_[1] : r_[0], send_ = b4 ? r_[0] : r_[1]; s_ = keep_ + shx(send_, 16, lane); } \
        s_ += shx(s_, 8, lane); s_ += shx(s_, 4, lane); s_ += shx(s_, 2, lane); s_ += shx(s_, 1, lane); \
        if ((lane & 15) == 0) wl[(g) * 4 + (lane >> 4)] = s_; } while (0)
#define PG_AXPY(buf, g) do { _Pragma("unroll") for (int i_ = 0; i_ < PG_R; ++i_) { const float w_ = wl[(g) * PG_R + i_]; const f32x2 wv_ = {w_, w_}; axpy16_fp8(&y[0], wv_, buf[i_][0]); axpy16_fp8(&y[8], wv_, buf[i_][1]); __builtin_amdgcn_sched_barrier(0); } } while (0)
__device__ __forceinline__ void peer_gather8(const bf16* XN, const unsigned char* PU8, const unsigned char* PV8, const int* PIDX, const float* PGATE, float* X, LAS float* wl, int gw, int NGW, int lane) {
    const bool b5 = (lane >> 5) & 1, b4 = (lane >> 4) & 1; const unsigned voff = 16u * (unsigned)lane;
    for (int t = gw; t < T; t += NGW) {
        const unsigned l4 = 4u * (unsigned)lane; const char* pidx_t = (const char*)(PIDX + (size_t)t * 128); const char* pgate_t = (const char*)(PGATE + (size_t)t * 128);
        const int idlo = *(const GAS int*)(pidx_t + l4), idhi = *(const GAS int*)(pidx_t + l4 + 256);
        v4u A[PG_R][2], B[PG_R][2];
        PG_LOAD(A, PU8, idlo, idhi, 0);
        f32x2 x[16];
        {   const char* xr = (const char*)(XN + (size_t)t * DM); const unsigned l32 = 32u * (unsigned)lane;
            const v4u a0 = *(const GAS v4u*)(xr + l32), a1 = *(const GAS v4u*)(xr + l32 + 16), c0 = *(const GAS v4u*)(xr + l32 + 2048), c1 = *(const GAS v4u*)(xr + l32 + 2064);
#pragma unroll
            for (int c = 0; c < 4; ++c) { x[c] = (f32x2){bflo(a0[c]), bfhi(a0[c])} * (1.f / PU_SCALE); x[4 + c] = (f32x2){bflo(a1[c]), bfhi(a1[c])} * (1.f / PU_SCALE);
                                          x[8 + c] = (f32x2){bflo(c0[c]), bfhi(c0[c])} * (1.f / PU_SCALE); x[12 + c] = (f32x2){bflo(c1[c]), bfhi(c1[c])} * (1.f / PU_SCALE); } }
#pragma unroll 1
        for (int g = 0; g < 128 / PG_R; g += 2) {
            PG_LOAD(B, PU8, idlo, idhi, g + 1);
            PG_DOT(A, g);
            if (g + 2 < 128 / PG_R) PG_LOAD(A, PU8, idlo, idhi, g + 2); else PG_LOAD(A, PV8, idlo, idhi, 0);
            PG_DOT(B, g + 1);
        }
        LDS_WAIT();
        {
            const float g0 = *(const GAS float*)(pgate_t + l4), g1 = *(const GAS float*)(pgate_t + l4 + 256);
            const float d0 = wl[lane], d1 = wl[64 + lane];
            const float w0 = g0 * 0.5f * d0 * (1.f + erff(d0 * 0.70710678118654752f)) * (1.f / PV_SCALE), w1 = g1 * 0.5f * d1 * (1.f + erff(d1 * 0.70710678118654752f)) * (1.f / PV_SCALE);
            LDS_WAIT(); asm volatile("" ::: "memory");
            wl[lane] = w0; wl[64 + lane] = w1;
            LDS_WAIT(); asm volatile("" ::: "memory");
        }
        f32x2 y[16];
#pragma unroll
        for (int i = 0; i < 16; ++i) y[i] = (f32x2){0.f, 0.f};
#pragma unroll 1
        for (int g = 0; g < 128 / PG_R; g += 2) {
            PG_LOAD(B, PV8, idlo, idhi, g + 1);
            PG_AXPY(A, g);
            if (g + 2 < 128 / PG_R) PG_LOAD(A, PV8, idlo, idhi, g + 2);
            PG_AXPY(B, g + 1);
        }
        {   char* xo = (char*)(X + (size_t)t * DM); const unsigned l64 = 64u * (unsigned)lane;
#pragma unroll
            for (int h = 0; h < 2; ++h)
#pragma unroll
                for (int c = 0; c < 4; ++c) { GAS f32x4* p = (GAS f32x4*)(xo + l64 + 4096 * h + 16 * c); f32x4 v = *p; v += (f32x4){y[8 * h + 2 * c].x, y[8 * h + 2 * c].y, y[8 * h + 2 * c + 1].x, y[8 * h + 2 * c + 1].y}; *p = v; } }
        LDS_WAIT(); asm volatile("" ::: "memory");
    }
}


typedef unsigned v6u __attribute__((ext_vector_type(6)));
typedef float v32f __attribute__((ext_vector_type(32)));
typedef v4u __attribute__((aligned(8))) v4u_a8;
constexpr float PU_SCALE6 = 90.0f, PV_SCALE6 = 5.65f;
__device__ __forceinline__ unsigned enc_e2m3(float v) {
    const float a = fminf(fabsf(v), 7.5f);
    unsigned code;
    if (a < 1.0f) code = (unsigned)__builtin_rintf(a * 8.f);
    else { const unsigned b = __builtin_bit_cast(unsigned, a) - 0x3F800000u; code = ((b + 0x7FFFFu + ((b >> 20) & 1u)) >> 20) + 8u; }
    return code | (v < 0.f ? 32u : 0u);
}
__device__ __forceinline__ void convert_fp6_rows(const float* src, unsigned char* dst, int nrows, float scale, const float* gain, int gw, int NGW, int lane) {
    for (int r = gw; r < nrows; r += NGW) {
        const float* sp = src + (size_t)r * DM + 4 * lane; const float* gp = gain ? gain + (size_t)(r / PEER_N) * DM + 4 * lane : nullptr;
        unsigned w[6] = {0u, 0u, 0u, 0u, 0u, 0u};
#pragma unroll
        for (int j = 0; j < 8; ++j) { f32x4 a = *(const GAS f32x4*)(sp + 256 * j) * scale; if (gp) a = a * *(const GAS f32x4*)(gp + 256 * j);
#pragma unroll
            for (int e = 0; e < 4; ++e) { const unsigned code = enc_e2m3(a[e]); const int bp = 6 * (4 * j + e), wi = bp >> 5, sh = bp & 31;
                w[wi] |= code << sh; if (sh > 26) w[wi + 1] |= code >> (32 - sh); } }
        unsigned char* dp = dst + (size_t)r * 1536 + 24 * lane;
        *(GAS v4u_a8*)dp = (v4u){w[0], w[1], w[2], w[3]}; *(GAS v2u*)(dp + 16) = (v2u){w[4], w[5]};
    }
}
#ifndef PG6_R
#define PG6_R 8
#endif
#define PG6_LOAD(buf, tab, idlo, idhi, g) do { _Pragma("unroll") for (int i_ = 0; i_ < PG6_R; ++i_) { const int k_ = (g) * PG6_R + i_; \
        const int e_ = __builtin_amdgcn_readlane(k_ < 64 ? idlo : idhi, k_ & 63); const unsigned char* rp_ = (tab) + (size_t)(unsigned)e_ * 1536u; \
        const v4u a_ = *(const GAS v4u_a8*)(rp_ + voff); const v2u b_ = *(const GAS v2u*)(rp_ + voff + 16); buf[i_] = (v6u){a_.x, a_.y, a_.z, a_.w, b_.x, b_.y}; } } while (0)
#define PG6_DOT1(buf, i_, dst) do { const v32f f_ = __builtin_amdgcn_cvt_scalef32_pk32_f32_fp6(buf[i_], 1.0f); f32x2 a_ = {0.f, 0.f}; \
        _Pragma("unroll") for (int c_ = 0; c_ < 16; ++c_) a_ += (f32x2){f_[2 * c_], f_[2 * c_ + 1]} * x[c_]; dst = a_.x + a_.y; __builtin_amdgcn_sched_barrier(0); } while (0)
#if PG6_R == 8
#define PG6_DOT(buf, g) do { float p_[8]; _Pragma("unroll") for (int i_ = 0; i_ < 8; ++i_) PG6_DOT1(buf, i_, p_[i_]); \
        float q_[4]; _Pragma("unroll") for (int i_ = 0; i_ < 4; ++i_) { const float keep_ = b5 ? p_[i_ + 4] : p_[i_], send_ = b5 ? p_[i_] : p_[i_ + 4]; q_[i_] = keep_ + shx(send_, 32, lane); } \
        float r_[2]; _Pragma("unroll") for (int i_ = 0; i_ < 2; ++i_) { const float keep_ = b4 ? q_[i_ + 2] : q_[i_], send_ = b4 ? q_[i_] : q_[i_ + 2]; r_[i_] = keep_ + shx(send_, 16, lane); } \
        float s_; { const float keep_ = b3 ? r_[1] : r_[0], send_ = b3 ? r_[0] : r_[1]; s_ = keep_ + shx(send_, 8, lane); } \
        s_ += shx(s_, 4, lane); s_ += shx(s_, 2, lane); s_ += shx(s_, 1, lane); \
        if ((lane & 7) == 0) wl[(g) * 8 + (lane >> 3)] = s_; } while (0)
#else
#define PG6_DOT(buf, g) do { float p_[4]; _Pragma("unroll") for (int i_ = 0; i_ < 4; ++i_) PG6_DOT1(buf, i_, p_[i_]); \
        float r_[2]; _Pragma("unroll") for (int i_ = 0; i_ < 2; ++i_) { const float keep_ = b5 ? p_[i_ + 2] : p_[i_], send_ = b5 ? p_[i_] : p_[i_ + 2]; r_[i_] = keep_ + shx(send_, 32, lane); } \
        float s_; { const float keep_ = b4 ? r_[1] : r_[0], send_ = b4 ? r_[0] : r_[1]; s_ = keep_ + shx(send_, 16, lane); } \
        s_ += shx(s_, 8, lane); s_ += shx(s_, 4, lane); s_ += shx(s_, 2, lane); s_ += shx(s_, 1, lane); \
        if ((lane & 15) == 0) wl[(g) * 4 + (lane >> 4)] = s_; } while (0)
#endif
#define PG6_AXPY(buf, g) do { _Pragma("unroll") for (int i_ = 0; i_ < PG6_R; ++i_) { const float w_ = wl[(g) * PG6_R + i_]; const f32x2 wv_ = {w_, w_}; \
        const v32f f_ = __builtin_amdgcn_cvt_scalef32_pk32_f32_fp6(buf[i_], 1.0f); _Pragma("unroll") for (int c_ = 0; c_ < 16; ++c_) y[c_] += (f32x2){f_[2 * c_], f_[2 * c_ + 1]} * wv_; __builtin_amdgcn_sched_barrier(0); } } while (0)
__device__ __forceinline__ void peer_gather6(bf16* XN, const unsigned char* PU6, const unsigned char* PV6, const int* PIDX, const float* PGATE, float* X, const u64_t* rowsq_in, u64_t* rowsq_out, LAS float* wl, int gw, int NGW, int lane) {
    const bool b5 = (lane >> 5) & 1, b4 = (lane >> 4) & 1, b3 = (lane >> 3) & 1; (void)b3;
    const unsigned voff = 24u * (unsigned)lane, l4 = 4u * (unsigned)lane, l8 = 8u * (unsigned)lane, l16 = 16u * (unsigned)lane;
    constexpr int NG = 128 / PG6_R;
    for (int t = gw; t < T; t += NGW) {
        const char* pidx_t = (const char*)(PIDX + (size_t)t * 128); const char* pgate_t = (const char*)(PGATE + (size_t)t * 128);
        const int idlo = *(const GAS int*)(pidx_t + l4), idhi = *(const GAS int*)(pidx_t + l4 + 256);
        v6u A[PG6_R], B[PG6_R];
        PG6_LOAD(A, PU6, idlo, idhi, 0);
        f32x2 x[16];
        {   const char* xr = (const char*)(XN + (size_t)t * DM); const float xs = (1.f / PU_SCALE6) * rowsq_rs(rowsq_in, t);
#pragma unroll
            for (int j = 0; j < 8; ++j) { const v2u a = *(const GAS v2u*)(xr + l8 + 512 * j); x[2 * j] = (f32x2){bflo(a.x), bfhi(a.x)} * xs; x[2 * j + 1] = (f32x2){bflo(a.y), bfhi(a.y)} * xs; } }
#pragma unroll 1
        for (int g = 0; g < NG; g += 2) {
            PG6_LOAD(B, PU6, idlo, idhi, g + 1);
            PG6_DOT(A, g);
            if (g + 2 < NG) PG6_LOAD(A, PU6, idlo, idhi, g + 2); else PG6_LOAD(A, PV6, idlo, idhi, 0);
            PG6_DOT(B, g + 1);
        }
        LDS_WAIT();
        {   const float g0 = *(const GAS float*)(pgate_t + l4), g1 = *(const GAS float*)(pgate_t + l4 + 256);
            const float d0 = wl[lane], d1 = wl[64 + lane];
            const float w0 = g0 * 0.5f * d0 * (1.f + erff(d0 * 0.70710678118654752f)) * (1.f / PV_SCALE6), w1 = g1 * 0.5f * d1 * (1.f + erff(d1 * 0.70710678118654752f)) * (1.f / PV_SCALE6);
            LDS_WAIT(); asm volatile("" ::: "memory");
            wl[lane] = w0; wl[64 + lane] = w1;
            LDS_WAIT(); asm volatile("" ::: "memory");
        }
        f32x2 y[16];
#pragma unroll
        for (int i = 0; i < 16; ++i) y[i] = (f32x2){0.f, 0.f};
#pragma unroll 1
        for (int g = 0; g < NG; g += 2) {
            PG6_LOAD(B, PV6, idlo, idhi, g + 1);
            PG6_AXPY(A, g);
            if (g + 2 < NG) PG6_LOAD(A, PV6, idlo, idhi, g + 2);
            PG6_AXPY(B, g + 1);
        }
        {   char* xo = (char*)(X + (size_t)t * DM);
            char* xbo = (char*)(XN + (size_t)t * DM); float ss = 0.f;
#pragma unroll
            for (int j = 0; j < 8; ++j) { GAS f32x4* p = (GAS f32x4*)(xo + l16 + 1024 * j); f32x4 v = *p; v += (f32x4){y[2 * j].x, y[2 * j].y, y[2 * j + 1].x, y[2 * j + 1].y}; *p = v;
                ss += (v[0] * v[0] + v[1] * v[1]) + (v[2] * v[2] + v[3] * v[3]); *(GAS v2u*)(xbo + l8 + 512 * j) = (v2u){pk2(v[0], v[1]), pk2(v[2], v[3])}; }
            if (rowsq_out) { ss = wave_sum(ss, lane); if (lane == 0) rowsq_out[t] = rowsq_fx(ss); } }
        LDS_WAIT(); asm volatile("" ::: "memory");
    }
}

typedef short s16x4 __attribute__((ext_vector_type(4)));
typedef __attribute__((address_space(3))) const char* lds_cptr;
__device__ __forceinline__ s16x4 vtr(lds_cptr p) { return __builtin_bit_cast(s16x4, __builtin_amdgcn_ds_read_tr16_b64_v4i16((__attribute__((address_space(3))) s16x4*)p)); }
__device__ __forceinline__ unsigned cvtpk(float lo, float hi) { unsigned r; asm("v_cvt_pk_bf16_f32 %0, %1, %2" : "=v"(r) : "v"(lo), "v"(hi)); return r; }
constexpr int AT_K0 = 0, AT_V0 = 16384, AT_TAB = 32768;
constexpr float LOG2E = 1.4426950408889634f;
template <int TYPE>
__device__ __forceinline__ void attn_unit(LAS unsigned char* lds, const bf16* QKV, bf16* ATT, int b, int head, int qb, const float* tabsrc, float Cl2, float sinkl2, int tid) {
    const int lane = tid & 63, w = __builtin_amdgcn_readfirstlane(tid >> 6), hh = lane >> 5, l31 = lane & 31;
    int qcol, kcol, vcol, ocol;
    if (TYPE == 0) { qcol = QA + head * 64; kcol = KA + (head / 3) * 64; vcol = VA + (head / 3) * 64; ocol = OA + head * 64; }
    else if (TYPE == 1) { qcol = QB + head * 64; kcol = KB + head * 64; vcol = VB + head * 64; ocol = OB + head * 64; }
    else { qcol = QC + head * 64; kcol = KC + (head / 3) * 64; vcol = VC + (head / 3) * 64; ocol = OC + head * 64; }
    const int q0 = 256 * qb + 32 * w, qpos = q0 + l31;
    int t_begin, t_end;
    if (TYPE == 0) { t_begin = 4 * qb - 2; if (t_begin < 0) t_begin = 0; t_end = 4 * qb + 6; if (t_end > 32) t_end = 32; }
    else if (TYPE == 1) { int a = 4 * qb - 4; a = a < 0 ? 0 : (a > 24 ? 24 : a); int e = 4 * qb - 1; e = e < 0 ? 0 : (e > 24 ? 24 : e); t_begin = a; t_end = e + 8; }
    else { t_begin = 0; t_end = 32; }
    LAS float* tab = (LAS float*)(lds + AT_TAB);
    if (TYPE == 0) { for (int i = tid; i < 1024; i += NTHREADS) { const int rel = i - 448; tab[i] = (rel >= -128 && rel <= 128) ? tabsrc[head * 257 + rel + 128] * LOG2E - Cl2 : -1e30f; } }
    if (TYPE == 1) { for (int i = tid; i < 15 * 31; i += NTHREADS) tab[i] = tabsrc[head * 465 + i] * LOG2E - Cl2; }
    bf16x8 qf[4];
    {   const bf16* qp = QKV + ((size_t)b * SEQ + qpos) * DIN + qcol + 8 * hh;
#pragma unroll
        for (int s = 0; s < 4; ++s) qf[s] = *(const GAS bf16x8*)(qp + 16 * s); }
    const int srow = tid >> 3, sch = tid & 7;
    const bf16* kg = QKV + ((size_t)b * SEQ + srow) * DIN + kcol + sch * 8;
    const bf16* vg = QKV + ((size_t)b * SEQ + srow) * DIN + vcol + sch * 8;
    const int kst = srow * 128 + ((sch ^ ((srow >> 1) & 7)) * 16);
    const int vst = srow * 128 + (((sch >> 2) ^ ((srow >> 1) & 1)) * 64) + (sch & 3) * 16;
    int kread[4], vread[2];
#pragma unroll
    for (int s = 0; s < 4; ++s) kread[s] = l31 * 128 + (((2 * s + hh) ^ ((lane >> 1) & 7)) * 16);
#pragma unroll
    for (int db = 0; db < 2; ++db) vread[db] = (4 * hh + ((lane >> 2) & 3)) * 128 + ((db ^ ((lane >> 3) & 1)) * 64) + 32 * ((lane >> 4) & 1) + 8 * (lane & 3);
    f32x16 O0, O1;
#pragma unroll
    for (int r = 0; r < 16; ++r) { O0[r] = 0.f; O1[r] = 0.f; }
    float lsum = 0.f;
    const int rw = 4 * qb + (w >> 1), cq = 32 * (w & 1) + l31;
    int r0w = rw - 4; r0w = r0w < 0 ? 0 : (r0w > 24 ? 24 : r0w);
    int c0 = cq - 8; c0 = c0 < 0 ? 0 : (c0 > 48 ? 48 : c0);
    {   const v4u kr = *(const GAS v4u*)(kg + (size_t)t_begin * 64 * DIN), vr = *(const GAS v4u*)(vg + (size_t)t_begin * 64 * DIN);
        *(LAS v4u*)(lds + AT_K0 + kst) = kr; *(LAS v4u*)(lds + AT_V0 + vst) = vr; }
    __syncthreads();
    for (int t = t_begin; t < t_end; ++t) {
        const int cur = (t - t_begin) & 1;
        v4u kr, vr;
        if (t + 1 < t_end) { kr = *(const GAS v4u*)(kg + (size_t)(t + 1) * 64 * DIN); vr = *(const GAS v4u*)(vg + (size_t)(t + 1) * 64 * DIN); }
        bool need = true;
        if (TYPE == 0) need = (64 * t <= q0 + 31 + 128) && (64 * t + 63 >= q0 - 128);
        if (TYPE == 1) need = (t >= r0w) && (t < r0w + 8);
        if (need) {
            const lds_cptr kb_ = (lds_cptr)(lds + AT_K0 + cur * 8192), vb_ = (lds_cptr)(lds + AT_V0 + cur * 8192);
            f32x16 S0, S1;
#pragma unroll
            for (int r = 0; r < 16; ++r) { S0[r] = 0.f; S1[r] = 0.f; }
#pragma unroll
            for (int s = 0; s < 4; ++s) { const bf16x8 k0 = *(const LAS bf16x8*)(kb_ + kread[s]), k1 = *(const LAS bf16x8*)(kb_ + kread[s] + 4096);
                S0 = __builtin_amdgcn_mfma_f32_32x32x16_bf16(k0, qf[s], S0, 0, 0, 0); S1 = __builtin_amdgcn_mfma_f32_32x32x16_bf16(k1, qf[s], S1, 0, 0, 0); }
            if (TYPE == 2) {
#pragma unroll
                for (int r = 0; r < 16; ++r) { S0[r] = __builtin_amdgcn_exp2f(S0[r] * LOG2E - Cl2); S1[r] = __builtin_amdgcn_exp2f(S1[r] * LOG2E - Cl2); }
            } else if (TYPE == 0) {
                const LAS float* tb = tab + (64 * t - qpos + 448 + 4 * hh);
#pragma unroll
                for (int r = 0; r < 16; ++r) { S0[r] = __builtin_amdgcn_exp2f(S0[r] * LOG2E + tb[8 * (r >> 2) + (r & 3)]); S1[r] = __builtin_amdgcn_exp2f(S1[r] * LOG2E + tb[32 + 8 * (r >> 2) + (r & 3)]); }
            } else {
                const LAS float* tb = tab + ((t - rw + 7) * 31 - cq + 15 + 4 * hh);
                const int kc0 = 4 * hh - c0;
#pragma unroll
                for (int r = 0; r < 16; ++r) { const int ka = 8 * (r >> 2) + (r & 3), kb2 = 32 + ka;
                    const float p0 = __builtin_amdgcn_exp2f(S0[r] * LOG2E + tb[ka]), p1 = __builtin_amdgcn_exp2f(S1[r] * LOG2E + tb[kb2]);
                    S0[r] = ((unsigned)(ka + kc0) < 16u) ? p0 : 0.f; S1[r] = ((unsigned)(kb2 + kc0) < 16u) ? p1 : 0.f; }
            }
#pragma unroll
            for (int r = 0; r < 16; ++r) lsum += S0[r] + S1[r];
            bf16x8 pb[4];
#pragma unroll
            for (int hf = 0; hf < 2; ++hf) {
                v4u a, c;
#pragma unroll
                for (int j = 0; j < 4; ++j) { a[j] = cvtpk(S0[8 * hf + 2 * j], S0[8 * hf + 2 * j + 1]); c[j] = cvtpk(S1[8 * hf + 2 * j], S1[8 * hf + 2 * j + 1]); }
                pb[hf] = __builtin_bit_cast(bf16x8, a); pb[2 + hf] = __builtin_bit_cast(bf16x8, c);
            }
#pragma unroll
            for (int ks = 0; ks < 4; ++ks) {
                const s16x4 a0 = vtr(vb_ + vread[0] + (16 * ks) * 128), a1 = vtr(vb_ + vread[0] + (16 * ks + 8) * 128);
                const s16x4 b0 = vtr(vb_ + vread[1] + (16 * ks) * 128), b1 = vtr(vb_ + vread[1] + (16 * ks + 8) * 128);
                const bf16x8 va = __builtin_shufflevector(a0, a1, 0, 1, 2, 3, 4, 5, 6, 7), vb2 = __builtin_shufflevector(b0, b1, 0, 1, 2, 3, 4, 5, 6, 7);
                O0 = __builtin_amdgcn_mfma_f32_32x32x16_bf16(va, pb[ks], O0, 0, 0, 0); O1 = __builtin_amdgcn_mfma_f32_32x32x16_bf16(vb2, pb[ks], O1, 0, 0, 0);
            }
        }
        if (t + 1 < t_end) { *(LAS v4u*)(lds + AT_K0 + (cur ^ 1) * 8192 + kst) = kr; *(LAS v4u*)(lds + AT_V0 + (cur ^ 1) * 8192 + vst) = vr; }
        __syncthreads();
    }
    lsum += shx(lsum, 32, lane);
    if (TYPE == 0) lsum += __builtin_amdgcn_exp2f(sinkl2 - Cl2);
    const float inv = 1.f / lsum;
    bf16* op = ATT + ((size_t)b * SEQ + qpos) * DM + ocol + 4 * hh;
#pragma unroll
    for (int g4 = 0; g4 < 4; ++g4) {
        v2u o0, o1; o0.x = cvtpk(O0[4 * g4] * inv, O0[4 * g4 + 1] * inv); o0.y = cvtpk(O0[4 * g4 + 2] * inv, O0[4 * g4 + 3] * inv);
        o1.x = cvtpk(O1[4 * g4] * inv, O1[4 * g4 + 1] * inv); o1.y = cvtpk(O1[4 * g4 + 2] * inv, O1[4 * g4 + 3] * inv);
        *(GAS v2u*)(op + 8 * g4) = o0; *(GAS v2u*)(op + 32 + 8 * g4) = o1;
    }
}


constexpr int MA_K0 = 0, MA_V0 = 32768;
__device__ __forceinline__ void mem_unit(LAS unsigned char* lds, const bf16* QM, const bf16* KVM, bf16* OM, const float* gq, int tb, int head, float Cl2, int tid) {
    const int lane = tid & 63, w = __builtin_amdgcn_readfirstlane(tid >> 6), hh = lane >> 5, l31 = lane & 31;
    const size_t trow = (size_t)tb * 256 + 32 * w + l31; const int b = tb >> 3;
    bf16x8 qf[8];
    {   const bf16* qp = QM + trow * MEMW + head * 128 + 8 * hh;
#pragma unroll
        for (int s = 0; s < 8; ++s) qf[s] = *(const GAS bf16x8*)(qp + 16 * s);
        float ss = 0.f;
#pragma unroll
        for (int s = 0; s < 8; ++s)
#pragma unroll
            for (int j = 0; j < 8; ++j) { const float f = __builtin_bit_cast(float, (unsigned)(unsigned short)qf[s][j] << 16); ss += f * f; }
        ss += shx(ss, 32, lane);
        const float r = 0.08838834764831845f / sqrtf(ss * (1.f / 128.f) + EPS);
#pragma unroll
        for (int s = 0; s < 8; ++s) { const f32x4 g0 = *(const GAS f32x4*)(gq + 16 * s + 8 * hh), g1 = *(const GAS f32x4*)(gq + 16 * s + 8 * hh + 4);
            v4u o;
#pragma unroll
            for (int j = 0; j < 4; ++j) { const float f0 = __builtin_bit_cast(float, (unsigned)(unsigned short)qf[s][2 * j] << 16), f1 = __builtin_bit_cast(float, (unsigned)(unsigned short)qf[s][2 * j + 1] << 16);
                const float ga = (2 * j < 4) ? g0[2 * j] : g1[2 * j - 4], gb2 = (2 * j + 1 < 4) ? g0[2 * j + 1] : g1[2 * j + 1 - 4];
                o[j] = cvtpk(f0 * r * ga, f1 * r * gb2); }
            qf[s] = __builtin_bit_cast(bf16x8, o); }
    }
    const int srow = tid >> 3, sch = tid & 7;
    const bf16* kg = KVM + ((size_t)b * NMEM + srow) * 1024 + head * 128 + sch * 8;
    const bf16* vg = kg + 512;
    const int kst0 = srow * 256 + ((sch ^ (srow & 15)) * 16), kst1 = srow * 256 + (((sch + 8) ^ (srow & 15)) * 16);
    const int vst0 = srow * 256 + ((((sch) >> 2) ^ (srow & 3)) * 64) + (sch & 3) * 16, vst1 = srow * 256 + ((((sch + 8) >> 2) ^ (srow & 3)) * 64) + (sch & 3) * 16;
    int kread[8], vread[4];
#pragma unroll
    for (int s = 0; s < 8; ++s) kread[s] = l31 * 256 + (((2 * s + hh) ^ (l31 & 15)) * 16);
#pragma unroll
    for (int db = 0; db < 4; ++db) vread[db] = (4 * hh + ((lane >> 2) & 3)) * 256 + ((db ^ ((lane >> 2) & 3)) * 64) + 32 * ((lane >> 4) & 1) + 8 * (lane & 3);
    f32x16 O[4];
#pragma unroll
    for (int db = 0; db < 4; ++db)
#pragma unroll
        for (int r = 0; r < 16; ++r) O[db][r] = 0.f;
    float lsum = 0.f;
    {   const v4u k0 = *(const GAS v4u*)kg, k1 = *(const GAS v4u*)(kg + 64), v0 = *(const GAS v4u*)vg, v1 = *(const GAS v4u*)(vg + 64);
        *(LAS v4u*)(lds + MA_K0 + kst0) = k0; *(LAS v4u*)(lds + MA_K0 + kst1) = k1; *(LAS v4u*)(lds + MA_V0 + vst0) = v0; *(LAS v4u*)(lds + MA_V0 + vst1) = v1; }
    __syncthreads();
#pragma unroll 1
    for (int t = 0; t < 4; ++t) {
        const int cur = t & 1;
        v4u k0, k1, v0, v1;
        if (t + 1 < 4) { const bf16* kn = kg + (size_t)(t + 1) * 64 * 1024; k0 = *(const GAS v4u*)kn; k1 = *(const GAS v4u*)(kn + 64); v0 = *(const GAS v4u*)(kn + 512); v1 = *(const GAS v4u*)(kn + 576); }
        const lds_cptr kb_ = (lds_cptr)(lds + MA_K0 + cur * 16384), vb_ = (lds_cptr)(lds + MA_V0 + cur * 16384);
        f32x16 S0, S1;
#pragma unroll
        for (int r = 0; r < 16; ++r) { S0[r] = 0.f; S1[r] = 0.f; }
#pragma unroll
        for (int s = 0; s < 8; ++s) { const bf16x8 a0 = *(const LAS bf16x8*)(kb_ + kread[s]), a1 = *(const LAS bf16x8*)(kb_ + kread[s] + 8192);
            S0 = __builtin_amdgcn_mfma_f32_32x32x16_bf16(a0, qf[s], S0, 0, 0, 0); S1 = __builtin_amdgcn_mfma_f32_32x32x16_bf16(a1, qf[s], S1, 0, 0, 0); }
#pragma unroll
        for (int r = 0; r < 16; ++r) { S0[r] = __builtin_amdgcn_exp2f(S0[r] * LOG2E - Cl2); S1[r] = __builtin_amdgcn_exp2f(S1[r] * LOG2E - Cl2); lsum += S0[r] + S1[r]; }
        bf16x8 pb[4];
#pragma unroll
        for (int hf = 0; hf < 2; ++hf) {
            v4u a, c;
#pragma unroll
            for (int j = 0; j < 4; ++j) { a[j] = cvtpk(S0[8 * hf + 2 * j], S0[8 * hf + 2 * j + 1]); c[j] = cvtpk(S1[8 * hf + 2 * j], S1[8 * hf + 2 * j + 1]); }
            pb[hf] = __builtin_bit_cast(bf16x8, a); pb[2 + hf] = __builtin_bit_cast(bf16x8, c);
        }
#pragma unroll
        for (int ks = 0; ks < 4; ++ks)
#pragma unroll
            for (int db = 0; db < 4; ++db) {
                const s16x4 a0 = vtr(vb_ + vread[db] + (16 * ks) * 256), a1 = vtr(vb_ + vread[db] + (16 * ks + 8) * 256);
                const bf16x8 va = __builtin_shufflevector(a0, a1, 0, 1, 2, 3, 4, 5, 6, 7);
                O[db] = __builtin_amdgcn_mfma_f32_32x32x16_bf16(va, pb[ks], O[db], 0, 0, 0);
            }
        if (t + 1 < 4) { LAS unsigned char* kn = lds + MA_K0 + (cur ^ 1) * 16384; LAS unsigned char* vn = lds + MA_V0 + (cur ^ 1) * 16384;
            *(LAS v4u*)(kn + kst0) = k0; *(LAS v4u*)(kn + kst1) = k1; *(LAS v4u*)(vn + vst0) = v0; *(LAS v4u*)(vn + vst1) = v1; }
        __syncthreads();
    }
    lsum += shx(lsum, 32, lane);
    const float inv = 1.f / lsum;
    bf16* op = OM + trow * MEMW + head * 128 + 4 * hh;
#pragma unroll
    for (int db = 0; db < 4; ++db)
#pragma unroll
        for (int g4 = 0; g4 < 4; ++g4) { v2u o; o.x = cvtpk(O[db][4 * g4] * inv, O[db][4 * g4 + 1] * inv); o.y = cvtpk(O[db][4 * g4 + 2] * inv, O[db][4 * g4 + 3] * inv); *(GAS v2u*)(op + 32 * db + 8 * g4) = o; }
}

__device__ __forceinline__ float wave_max(float v, int lane) {
#pragma unroll
    for (int o = 1; o < 64; o <<= 1) v = fmaxf(v, shx(v, o, lane));
    return v;
}
struct Args { const float* in[23]; float* out; unsigned char* ws; int ph_lo, ph_hi, use_bar, pad; };
#ifndef MK_OFF
#define MK_OFF 0u
#endif
#ifndef REP_ATT
#define REP_ATT 1
#endif
#ifndef REP_GEMM
#define REP_GEMM 1
#endif
#ifndef REP_NORM
#define REP_NORM 1
#endif
#ifndef REP_SEL
#define REP_SEL 1
#endif
#ifndef REP_MEM
#define REP_MEM 1
#endif
#define PHON(k) (!((MK_OFF >> (k)) & 1u))
constexpr int PH_PER_LAYER = 10, PH_BASE = 3, N_PHASES = PH_BASE + DEPTH * PH_PER_LAYER;
constexpr int PTAB_OFF = LDSCTL_OFF + 1024;

__global__ void __launch_bounds__(NTHREADS, 2) mega(Args a) {
    extern __shared__ __attribute__((aligned(16))) unsigned char lds_raw[];
    LAS unsigned char* lds = (LAS unsigned char*)lds_raw;
    {   const int tid0 = threadIdx.x;
        for (int u = tid0; u < (LDS_BYTES - LDSCTL_OFF) / 4; u += NTHREADS) ((LAS unsigned*)(lds + LDSCTL_OFF))[u] = 0u;
        __syncthreads();
        if (tid0 < 23) ((LAS unsigned long long*)(lds + PTAB_OFF))[tid0] = (unsigned long long)a.in[tid0];
        if (tid0 == 23) ((LAS unsigned long long*)(lds + PTAB_OFF))[23] = (unsigned long long)a.out;
        if (tid0 == 24) ((LAS unsigned long long*)(lds + PTAB_OFF))[24] = (unsigned long long)a.ws;
        __syncthreads();
    }
    volatile LAS unsigned* MISC = (volatile LAS unsigned*)(lds + MISC_OFF);
    const int G = gridDim.x, bid = blockIdx.x, NGW = G * NWAVES;
    const int use_bar = a.use_bar;
    XcdBarrier bar; bar.bar = (unsigned*)(a.ws + WS_CTL) + CW_BAR; bar.x = 0; bar.st = MISC + 8;
    if (use_bar) bar = xcd_barrier_post((unsigned*)(a.ws + WS_CTL) + CW_BAR, MISC + 8);
    const int lo = a.ph_lo, hi = a.ph_hi;
#define IN(k) (lo <= (k) && (k) < hi)
#define SEAM(k) do { if (use_bar && IN(k) && IN((k) + 1)) xcd_barrier(bar); } while (0)
#define PHL() int tid_ = threadIdx.x; asm volatile("" : "+v"(tid_)); const int lane_ = tid_ & 63, wave_ = __builtin_amdgcn_readfirstlane(tid_ >> 6), gw_ = bid * NWAVES + wave_; (void)lane_; (void)gw_; \
              int pz_ = 0; asm volatile("" : "+s"(pz_))
#define PTR(i) ((const float*)ldptr(lds, (i) + pz_))
#define WSP() ((unsigned char*)ldptr(lds, 24 + pz_))
#define OUTP() ((float*)ldptr(lds, 23 + pz_))

    if (IN(0) && PHON(0)) {
        PHL(); unsigned char* ws = WSP();
        LAS float* scr = (LAS float*)(lds + RING_OFF + wave_ * 16384);
        constexpr int I_IN = 32 * 128, I_OUT = 32 * 64, I_MQ = 32 * 16, I_MKV = 32 * 32, I_MO = 8 * 64, I_PQ = 32 * 64, I_L = I_IN + I_OUT + I_MQ + I_MKV + I_MO + I_PQ;
        for (int it = gw_; it < DEPTH * I_L; it += NGW) {
            const int l = it / I_L; int r = it % I_L;
            if (r < I_IN) { transpose_item<true>(PTR(4) + (size_t)l * DM * DIN, DM, DIN, (bf16*)(ws + WS_WIN) + (size_t)l * DIN * DM, scr, r, lane_, PTR(3) + (size_t)l * DM); continue; } r -= I_IN;
            if (r < I_OUT) { transpose_item<false>(PTR(11) + (size_t)l * DM * DM, DM, DM, (bf16*)(ws + WS_WOUT) + (size_t)l * DM * DM, scr, r, lane_); continue; } r -= I_OUT;
            if (r < I_MQ) { transpose_item<false>(PTR(14) + (size_t)l * DM * MEMW, DM, MEMW, (bf16*)(ws + WS_WMQ) + (size_t)l * MEMW * DM, scr, r, lane_, PTR(12) + (size_t)l * DM); continue; } r -= I_MQ;
            if (r < I_MKV) { transpose_item<false>(PTR(15) + (size_t)l * DM * 1024, DM, 1024, (bf16*)(ws + WS_WMKV) + (size_t)l * 1024 * DM, scr, r, lane_); continue; } r -= I_MKV;
            if (r < I_MO) { transpose_item<false>(PTR(17) + (size_t)l * MEMW * DM, MEMW, DM, (bf16*)(ws + WS_WMO) + (size_t)l * DM * MEMW, scr, r, lane_); continue; } r -= I_MO;
            transpose_item<false>(PTR(19) + (size_t)l * DM * DM, DM, DM, (bf16*)(ws + WS_WPQ) + (size_t)l * DM * DM, scr, r, lane_, PTR(18) + (size_t)l * DM);
        }
        const size_t gtid = (size_t)bid * NTHREADS + tid_, nth = (size_t)G * NTHREADS;
        convert_bf16(PTR(20), (bf16*)(ws + WS_PKEYS), (size_t)DEPTH * 8 * 2 * 128 * 128, gtid, nth);
        convert_fp6_rows(PTR(21), ws + WS_PU, DEPTH * PEER_N, PU_SCALE6, PTR(18), gw_, NGW, lane_);
        convert_fp6_rows(PTR(22), ws + WS_PV, DEPTH * PEER_N, PV_SCALE6, nullptr, gw_, NGW, lane_);
        {   const float* x0 = PTR(0); bf16* XN = (bf16*)(ws + WS_XN); u64_t* rsq = (u64_t*)(ws + WS_ROWSQ);
            for (int m = gw_; m < T; m += NGW) prep_row(x0 + (size_t)m * DM, XN + (size_t)m * DM, rsq + m, lane_); }
        {   const float* mem = PTR(1); const float* gkv = PTR(13); bf16* MEMN = (bf16*)(ws + WS_MEMN);
            for (int m = gw_; m < BATCH * NMEM; m += NGW)
                rms_row_to_bf16(mem + (size_t)m * DM, gkv, MEMN + (size_t)m * DM, gkv + DM, MEMN + (size_t)(BATCH * NMEM + m) * DM, lane_); }
        float* rope = (float*)(ws + WS_ROPE); float* biasA = (float*)(ws + WS_BIASA);
        if (gtid < 64 * 16) { const int pos = (int)gtid >> 4, i = (int)gtid & 15; const float ang = (float)pos * ROPE_INV[i]; rope[gtid * 2] = cosf(ang); rope[gtid * 2 + 1] = sinf(ang); }
        if (gtid < 12 * 257) { const int h = (int)gtid / 257, rel = (int)gtid % 257 - 128; biasA[gtid] = PTR(2)[t5_bucket(rel) * 12 + h]; }
    }
    SEAM(0);
    if (IN(1) && PHON(1)) {
#pragma unroll 1
        for (int l = 0; l < DEPTH; ++l) {
            PHL(); unsigned char* ws = WSP();
            pg8::Gemm g{(bf16*)(ws + WS_MEMN) + (size_t)l * BATCH * NMEM * DM, (bf16*)(ws + WS_WMKV) + (size_t)l * 1024 * DM, BATCH * NMEM, 1024, DM};
            OffsetOrder S; S.init(BATCH * NMEM, 1024, G, bid, 64 * l);
            pg8::EpiBf16<0> E{(bf16*)(ws + WS_KVM) + (size_t)l * BATCH * NMEM * 1024, 1024, nullptr, 0, 0, 1.f};
            pg8::gemm_phase<pg8::EpiBf16<0>, OffsetOrder, true, true>(lds + RING_OFF, g, S, E, tid_);
            __syncthreads();
        }
    }
    SEAM(1);
    if (IN(2) && PHON(2)) {
        PHL(); unsigned char* ws = WSP(); bf16* KVM = (bf16*)(ws + WS_KVM); const float* gm = PTR(16);
        for (int m = gw_; m < DEPTH * BATCH * NMEM; m += NGW) {
            const int l = m / (BATCH * NMEM);
            GAS v4u* p = (GAS v4u*)(KVM + (size_t)m * 1024 + 8 * lane_);
            const v4u w = *p;
            float f[8] = {bflo(w.x), bfhi(w.x), bflo(w.y), bfhi(w.y), bflo(w.z), bfhi(w.z), bflo(w.w), bfhi(w.w)};
            float ss = 0.f;
#pragma unroll
            for (int i = 0; i < 8; ++i) ss += f[i] * f[i];
            ss += shx(ss, 1, lane_); ss += shx(ss, 2, lane_); ss += shx(ss, 4, lane_); ss += shx(ss, 8, lane_);
            const float r = 1.f / sqrtf(ss * (1.f / 128.f) + EPS);
            const float* gk = gm + (size_t)l * 256 + 128 + 8 * (lane_ & 15);
            v4u o; o.x = pk2(f[0] * r * gk[0], f[1] * r * gk[1]); o.y = pk2(f[2] * r * gk[2], f[3] * r * gk[3]); o.z = pk2(f[4] * r * gk[4], f[5] * r * gk[5]); o.w = pk2(f[6] * r * gk[6], f[7] * r * gk[7]);
            *p = o;
        }
    }
    SEAM(2);

#pragma unroll 1
    for (int l = 0; l < DEPTH; ++l) {
        const int pb = PH_BASE + PH_PER_LAYER * l;
        if (IN(pb + 0) && PHON(3)) for (int rep_ = 0; rep_ < REP_GEMM; ++rep_) { PHL(); unsigned char* ws = WSP();
            pg8::Gemm g{(bf16*)(ws + WS_XN), (bf16*)(ws + WS_WIN) + (size_t)l * DIN * DM, T, DIN, DM}; pg8::StaticOrder S; S.init(T, DIN, G, bid);
            pg8::EpiQKV E{(bf16*)(ws + WS_QKV), PTR(5) + (size_t)l * 128, PTR(7) + (size_t)l * 128, PTR(9) + (size_t)l * 128, (const float*)(ws + WS_ROPE), (const u64_t*)(ws + WS_ROWSQ) + (size_t)(l * 3 + 0) * T};
            pg8::gemm_phase<pg8::EpiQKV, pg8::StaticOrder, true, true>(lds + RING_OFF, g, S, E, tid_);
        }
        SEAM(pb + 0);
        if (IN(pb + 1) && PHON(4)) for (int rep_ = 0; rep_ < REP_ATT; ++rep_) { PHL(); unsigned char* ws = WSP();
            const float* sink = PTR(6) + (size_t)l * 12; const float* rpb = PTR(8) + (size_t)l * 8 * 15 * 31; const float* biasA = (const float*)(ws + WS_BIASA);
            const bf16* QKV = (const bf16*)(ws + WS_QKV); bf16* ATT = (bf16*)(ws + WS_ATT);
            const float* ga = PTR(5) + (size_t)l * 128; const float* gb = PTR(7) + (size_t)l * 128; const float* gc = PTR(9) + (size_t)l * 128;
            const float CaL2 = 8.f * wave_max(fabsf(ga[lane_]), lane_) * wave_max(fabsf(ga[64 + lane_]), lane_) * LOG2E;
            const float CbL2 = 8.f * wave_max(fabsf(gb[lane_]), lane_) * wave_max(fabsf(gb[64 + lane_]), lane_) * LOG2E;
            const float CcL2 = 8.f * wave_max(fabsf(gc[lane_]), lane_) * wave_max(fabsf(gc[64 + lane_]), lane_) * LOG2E;
            const int vc = (G % 8 == 0) ? (bid % 8) * (G / 8) + bid / 8 : bid;
            for (int u = vc; u < BATCH * 12 * 8; u += G) attn_unit<2>(lds, QKV, ATT, u / 96, (u >> 3) % 12, u & 7, nullptr, CcL2, 0.f, tid_);
            for (int u = vc; u < BATCH * 8 * 8; u += G) attn_unit<1>(lds, QKV, ATT, u >> 6, (u >> 3) & 7, u & 7, rpb, CbL2, 0.f, tid_);
            for (int u = vc; u < BATCH * 12 * 8; u += G) { const int head = (u >> 3) % 12; attn_unit<0>(lds, QKV, ATT, u / 96, head, u & 7, biasA, CaL2, sink[head] * LOG2E, tid_); }
        }
        SEAM(pb + 1);
        if (IN(pb + 2) && PHON(5)) { PHL(); unsigned char* ws = WSP(); mixnorm_rows((bf16*)(ws + WS_ATT), PTR(10) + (size_t)l * DM, gw_, NGW, lane_); }
        SEAM(pb + 2);
        if (IN(pb + 3) && PHON(6)) { PHL(); unsigned char* ws = WSP(); const float* xin = (l == 0) ? PTR(0) : (const float*)OUTP();
            pg8::Gemm g{(bf16*)(ws + WS_ATT), (bf16*)(ws + WS_WOUT) + (size_t)l * DM * DM, T, DM, DM}; pg8::StaticOrder S; S.init(T, DM, G, bid);
            pg8::EpiResid E{xin, OUTP(), DM, (bf16*)(ws + WS_XN), (u64_t*)(ws + WS_ROWSQ) + (size_t)(l * 3 + 1) * T};
            pg8::gemm_phase<pg8::EpiResid, pg8::StaticOrder, true, true>(lds + RING_OFF, g, S, E, tid_);
        }
        SEAM(pb + 3);
        if (IN(pb + 4) && PHON(7)) for (int rep_ = 0; rep_ < REP_GEMM; ++rep_) { PHL(); unsigned char* ws = WSP();
            pg8::Gemm g{(bf16*)(ws + WS_XN), (bf16*)(ws + WS_WMQ) + (size_t)l * MEMW * DM, T, MEMW, DM}; pg8::StaticOrder S; S.init(T, MEMW, G, bid);
            pg8::EpiBf16Row E{(bf16*)(ws + WS_QM), MEMW, (const u64_t*)(ws + WS_ROWSQ) + (size_t)(l * 3 + 1) * T};
            pg8::gemm_phase<pg8::EpiBf16Row, pg8::StaticOrder, true, true>(lds + RING_OFF, g, S, E, tid_);
        }
        SEAM(pb + 4);
        if (IN(pb + 5) && PHON(8)) for (int rep_ = 0; rep_ < REP_MEM; ++rep_) { PHL(); unsigned char* ws = WSP();
            const bf16* kvm = (const bf16*)(ws + WS_KVM) + (size_t)l * BATCH * NMEM * 1024; const float* gq = PTR(16) + (size_t)l * 256;
            const float CmL2 = 11.313708498984761f * wave_max(fmaxf(fabsf(gq[lane_]), fabsf(gq[64 + lane_])), lane_) * wave_max(fmaxf(fabsf(gq[128 + lane_]), fabsf(gq[192 + lane_])), lane_) * LOG2E;
            for (int u = bid; u < (T / 256) * 4; u += G) mem_unit(lds, (const bf16*)(ws + WS_QM), kvm, (bf16*)(ws + WS_OM), gq, u >> 2, u & 3, CmL2, tid_);
        }
        SEAM(pb + 5);
        if (IN(pb + 6) && PHON(9)) { PHL(); unsigned char* ws = WSP();
            pg8::Gemm g{(bf16*)(ws + WS_OM), (bf16*)(ws + WS_WMO) + (size_t)l * DM * MEMW, T, DM, MEMW}; pg8::StaticOrder S; S.init(T, DM, G, bid);
            pg8::EpiResid E{OUTP(), OUTP(), DM, (bf16*)(ws + WS_XN), (u64_t*)(ws + WS_ROWSQ) + (size_t)(l * 3 + 2) * T};
            pg8::gemm_phase<pg8::EpiResid, pg8::StaticOrder, true, true>(lds + RING_OFF, g, S, E, tid_);
        }
        SEAM(pb + 6);
        if (IN(pb + 7) && PHON(10)) for (int rep_ = 0; rep_ < REP_GEMM; ++rep_) { PHL(); unsigned char* ws = WSP();
            pg8::Gemm g{(bf16*)(ws + WS_XN), (bf16*)(ws + WS_WPQ) + (size_t)l * DM * DM, T, DM, DM}; pg8::StaticOrder S; S.init(T, DM, G, bid);
            pg8::EpiBf16Row E{(bf16*)(ws + WS_QP), DM, (const u64_t*)(ws + WS_ROWSQ) + (size_t)(l * 3 + 2) * T};
            pg8::gemm_phase<pg8::EpiBf16Row, pg8::StaticOrder, true, true>(lds + RING_OFF, g, S, E, tid_);
        }
        SEAM(pb + 7);
        if (IN(pb + 8) && PHON(11)) for (int rep_ = 0; rep_ < REP_SEL; ++rep_) { PHL(); unsigned char* ws = WSP();
            const bf16* pk = (const bf16*)(ws + WS_PKEYS) + (size_t)l * 8 * 2 * 128 * 128;
            for (int u = bid; u < (T / 256) * PEER_H; u += G) peer_select_unit((const bf16*)(ws + WS_QP), pk, (int*)(ws + WS_PIDX), (float*)(ws + WS_PGATE), u >> 3, u & 7, wave_, lane_);
        }
        SEAM(pb + 8);
        if (IN(pb + 9) && PHON(12)) { PHL(); unsigned char* ws = WSP();
            peer_gather6((bf16*)(ws + WS_XN), ws + WS_PU + (size_t)l * PEER_N * 1536, ws + WS_PV + (size_t)l * PEER_N * 1536, (const int*)(ws + WS_PIDX), (const float*)(ws + WS_PGATE), OUTP(),
                         (const u64_t*)(ws + WS_ROWSQ) + (size_t)(l * 3 + 2) * T, (l + 1 < DEPTH) ? (u64_t*)(ws + WS_ROWSQ) + (size_t)((l + 1) * 3 + 0) * T : (u64_t*)nullptr,
                         (LAS float*)(lds + RING_OFF + wave_ * 1024), gw_, NGW, lane_); }
        SEAM(pb + 9);
    }
#undef IN
#undef SEAM
}

#ifndef MK_MULTI_LAUNCH
#define MK_MULTI_LAUNCH 0
#endif
extern "C" void kernel_launch(void* const* d_in, const int* in_sizes, int n_in, void* d_out, int out_size, void* d_ws, size_t ws_size, hipStream_t stream) {
    static int grid = 0;
    if (grid == 0) {
        if (n_in != 23 || out_size != T * DM || ws_size < WS_END) { fprintf(stderr, "kernel_launch: unexpected shapes (n_in %d, out %d, ws %zu)\n", n_in, out_size, ws_size); grid = -1; return; }
        int dev = 0, cus = 0, per_cu = 0;
        if (hipGetDevice(&dev) != hipSuccess || hipDeviceGetAttribute(&cus, hipDeviceAttributeMultiprocessorCount, dev) != hipSuccess) { grid = -1; return; }
        if (hipFuncSetAttribute((const void*)mega, hipFuncAttributeMaxDynamicSharedMemorySize, LDS_BYTES) != hipSuccess) { fprintf(stderr, "kernel_launch: hipFuncSetAttribute failed\n"); grid = -1; return; }
        if (hipOccupancyMaxActiveBlocksPerMultiprocessor(&per_cu, (const void*)mega, NTHREADS, LDS_BYTES) != hipSuccess || per_cu < 1) { fprintf(stderr, "kernel_launch: occupancy query says %d\n", per_cu); }
        (void)hipGetLastError();
        grid = cus;
    }
    if (grid < 0) return;
    (void)hipMemsetAsync((char*)d_ws + WS_CTL, 0, CTL_ZERO_BYTES, stream);
    Args a{};
    for (int i = 0; i < 23; ++i) a.in[i] = (const float*)d_in[i];
    a.out = (float*)d_out; a.ws = (unsigned char*)d_ws;
#if MK_MULTI_LAUNCH
    for (int p = 0; p < N_PHASES; ++p) { a.ph_lo = p; a.ph_hi = p + 1; a.use_bar = 0; a.pad = 0; hipLaunchKernelGGL(mega, dim3(grid), dim3(NTHREADS), LDS_BYTES, stream, a); }
#else
    a.ph_lo = 0; a.ph_hi = N_PHASES; a.use_bar = 1; a.pad = 0;
    hipLaunchKernelGGL(mega, dim3(grid), dim3(NTHREADS), LDS_BYTES, stream, a);
#endif
    const hipError_t le = hipPeekAtLastError();
    if (le != hipSuccess) fprintf(stderr, "kernel_launch: launch failed: %s\n", hipGetErrorName(le));
}
```

```cpp
#include <hip/hip_runtime.h>
#include <cstdio>
#include <cstdint>
#include <cmath>
__device__ __forceinline__ float shx(float v, int k, int lane);
typedef unsigned long long u64_t;
__device__ __forceinline__ float rowsq_rs(const u64_t* rowsq, int row) { return 1.0f / sqrtf((float)rowsq[row] * (5.9604644775390625e-08f / 2048.0f) + 1e-6f); }
__device__ __forceinline__ u64_t rowsq_fx(float ss) { return (u64_t)(ss * 16777216.0f + 0.5f); }
namespace pg8 {
#define PG8_LAS __attribute__((address_space(3)))
typedef unsigned short bf16_t;
typedef short bf16x8 __attribute__((ext_vector_type(8)));
typedef float f32x4 __attribute__((ext_vector_type(4)));
typedef unsigned u32x4 __attribute__((ext_vector_type(4)));
constexpr int BM = 256, BK = 64, HALF = 128, HTB = HALF * BK * 2  , STAGE_BYTES = 8 * HTB, NXCD = 8, WGM = 8;

__host__ __device__ __forceinline__ int lds_byte(int r, int c) { const int st = (r >> 4) * 2 + (c >> 5), rr = r & 15, cc = c & 31, ob = rr * 64 + cc * 2; return st * 1024 + (ob ^ (((ob >> 9) & 1) << 5)); }
__host__ __device__ __forceinline__ void stage_rc(int b, int& R, int& C) { const int st = b / 1024, sb = b % 1024, swz = sb ^ (((sb >> 9) & 1) << 5); R = (st >> 1) * 16 + swz / 64; C = (st & 1) * 32 + (swz % 64) / 2; }
__host__ __device__ __forceinline__ int perm32(int rho) { const int n = rho >> 4, i = rho & 15; return 8 * (i >> 2) + 4 * n + (i & 3); }

struct Unit { int pm, pn; };
struct Gemm { const bf16_t* A; const bf16_t* Bt; int M, N, K; };

struct StaticOrder {
    int nM, nN, nwg, G, c;
    __host__ __device__ void init(int M, int N, int G_, int c_) { nM = M / BM; nN = N / BM; nwg = nM * nN; G = G_; c = c_; }
    __host__ __device__ bool next(int i, Unit& u) const {
        const long L = (long)i * G + c; if (L >= nwg) return false;
        int wgid = (int)L; { const int q = nwg / NXCD, r = nwg % NXCD, xcd = wgid % NXCD, off = wgid / NXCD; wgid = (xcd < r ? xcd * (q + 1) : r * (q + 1) + (xcd - r) * q) + off; }
        const int nig = WGM * nN, gid = wgid / nig, fm = gid * WGM, gsz = (nM - fm) < WGM ? (nM - fm) : WGM;
        u.pm = fm + ((wgid % nig) % gsz); u.pn = (wgid % nig) / gsz; return true;
    }
    __device__ __forceinline__ void a_ready(const Unit&) const {}
    __device__ __forceinline__ void done(const Unit&) const {}
};

__device__ __forceinline__ unsigned cvt_pk_bf16(float lo, float hi) { unsigned r; asm volatile("v_cvt_pk_bf16_f32 %0, %1, %2" : "=v"(r) : "v"(lo), "v"(hi)); return r; }
typedef float f32x2 __attribute__((ext_vector_type(2)));
__device__ __forceinline__ f32x2 gelu_pk(f32x2 v) {
    const f32x2 av = __builtin_elementwise_abs(v), d = av * 0.2316418882f + 1.0f;
    f32x2 t; t.x = __builtin_amdgcn_rcpf(d.x); t.y = __builtin_amdgcn_rcpf(d.y);
    f32x2 q = t * 0.5307027145f + (-0.7265760135f); q = q * t + 0.7107068705f; q = q * t + (-0.142248368f); q = q * t + 0.127414796f; q = q * t;
    const f32x2 s = (v * v) * (-0.72134752044f);
    f32x2 e; e.x = __builtin_amdgcn_exp2f(s.x); e.y = __builtin_amdgcn_exp2f(s.y);
    const f32x2 m = v * (q * e), r = v - m;
    f32x2 o; o.x = v.x < 0.f ? m.x : r.x; o.y = v.y < 0.f ? m.y : r.y; return o;
}

template <int ACT  > struct EpiBf16 {
    static constexpr bool PERM = true, AFTER_DRAIN = false; static_assert(ACT == 0 || ACT == 1, "EpiBf16: ACT is 0 (none) or 1 (gelu_pk)");
    bf16_t* O; int ldc; const float* bias; int split_cols; size_t split_stride; float scale0;
    __device__ __forceinline__ void operator()(const f32x4 (&acc)[2][2][4][2], const Unit& u, int wr, int wc, int fr, int fq) const {
        const int row0 = u.pm * BM + wr * 64 + fr; int colt = u.pn * BM; bf16_t* base = O;
        float sc = 1.f; if (split_cols) { const int t = colt / split_cols; base += (size_t)t * split_stride; colt -= t * split_cols; if (t == 0) sc = scale0; }
        const int col0 = colt + wc * 32 + 8 * fq, bcol0 = u.pn * BM + wc * 32 + 8 * fq;
        f32x4 bv[2][2];
#pragma unroll
        for (int bj = 0; bj < 2; ++bj)
#pragma unroll
            for (int n = 0; n < 2; ++n) bv[bj][n] = bias ? *(const f32x4*)(bias + bcol0 + bj * HALF + 4 * n) : (f32x4){0.f, 0.f, 0.f, 0.f};
#pragma unroll
        for (int ai = 0; ai < 2; ++ai)
#pragma unroll
            for (int m = 0; m < 4; ++m) { bf16_t* rowp = base + (size_t)(row0 + ai * HALF + m * 16) * ldc + col0;
#pragma unroll
                for (int bj = 0; bj < 2; ++bj) { f32x4 v0 = acc[ai][bj][m][0] + bv[bj][0], v1 = acc[ai][bj][m][1] + bv[bj][1];
                    if (ACT == 1) { f32x2 a = gelu_pk((f32x2){v0[0], v0[1]}), b = gelu_pk((f32x2){v0[2], v0[3]}), c = gelu_pk((f32x2){v1[0], v1[1]}), d = gelu_pk((f32x2){v1[2], v1[3]});
                        v0 = (f32x4){a.x, a.y, b.x, b.y}; v1 = (f32x4){c.x, c.y, d.x, d.y}; }
                    v0 = v0 * sc; v1 = v1 * sc; u32x4 w; w.x = cvt_pk_bf16(v0[0], v0[1]); w.y = cvt_pk_bf16(v0[2], v0[3]); w.z = cvt_pk_bf16(v1[0], v1[1]); w.w = cvt_pk_bf16(v1[2], v1[3]);
                    *(u32x4*)(rowp + bj * HALF) = w; } }
    }
};

typedef unsigned u32x2 __attribute__((ext_vector_type(2)));
struct EpiResid {
    static constexpr bool PERM = false, AFTER_DRAIN = false;
    bf16_t* s; int ldc; u64_t* rowsq;
    __device__ __forceinline__ void operator()(const f32x4 (&acc)[2][2][4][2], const Unit& u, int wr, int wc, int fr, int fq) const {
        const int col0 = u.pn * BM + wc * 32 + 4 * fq;
#pragma unroll
        for (int ai = 0; ai < 2; ++ai)
#pragma unroll
            for (int m = 0; m < 4; ++m) { const int row = u.pm * BM + ai * HALF + wr * 64 + m * 16 + fr; bf16_t* sp = s + (size_t)row * ldc + col0; float ss = 0.f;
                u32x2 in[2][2];
#pragma unroll
                for (int bj = 0; bj < 2; ++bj)
#pragma unroll
                    for (int n = 0; n < 2; ++n) in[bj][n] = *(const u32x2*)(sp + bj * HALF + n * 16);
#pragma unroll
                for (int bj = 0; bj < 2; ++bj)
#pragma unroll
                    for (int n = 0; n < 2; ++n) { const u32x2 w0 = in[bj][n];
                        const f32x4 bs = (f32x4){__builtin_bit_cast(float, w0.x << 16), __builtin_bit_cast(float, w0.x & 0xffff0000u), __builtin_bit_cast(float, w0.y << 16), __builtin_bit_cast(float, w0.y & 0xffff0000u)};
                        const f32x4 o = bs + acc[ai][bj][m][n]; ss += (o[0] * o[0] + o[1] * o[1]) + (o[2] * o[2] + o[3] * o[3]);
                        u32x2 w; w.x = cvt_pk_bf16(o[0], o[1]); w.y = cvt_pk_bf16(o[2], o[3]); *(u32x2*)(sp + bj * HALF + n * 16) = w; }
                ss += shx(ss, 16, fr + 16 * fq); ss += shx(ss, 32, fr + 16 * fq);
                if (fq == 0) atomicAdd(rowsq + row, rowsq_fx(ss)); }
    }
};
struct EpiBf16Row {
    static constexpr bool PERM = true, AFTER_DRAIN = false;
    bf16_t* O; int ldc; const u64_t* rowsq;
    __device__ __forceinline__ void operator()(const f32x4 (&acc)[2][2][4][2], const Unit& u, int wr, int wc, int fr, int fq) const {
        const int row0 = u.pm * BM + wr * 64 + fr, col0 = u.pn * BM + wc * 32 + 8 * fq;
#pragma unroll
        for (int ai = 0; ai < 2; ++ai)
#pragma unroll
            for (int m = 0; m < 4; ++m) { const int row = row0 + ai * HALF + m * 16; const float rs = rowsq_rs(rowsq, row); bf16_t* rowp = O + (size_t)row * ldc + col0;
#pragma unroll
                for (int bj = 0; bj < 2; ++bj) { const f32x4 v0 = acc[ai][bj][m][0] * rs, v1 = acc[ai][bj][m][1] * rs; u32x4 w; w.x = cvt_pk_bf16(v0[0], v0[1]); w.y = cvt_pk_bf16(v0[2], v0[3]); w.z = cvt_pk_bf16(v1[0], v1[1]); w.w = cvt_pk_bf16(v1[2], v1[3]);
                    *(u32x4*)(rowp + bj * HALF) = w; } }
    }
};
struct EpiQKV {
    static constexpr bool PERM = false, AFTER_DRAIN = false;
    bf16_t* O; const float* ga; const float* gb; const float* gc; const float* rope; const u64_t* rowsq;
    __device__ __forceinline__ void operator()(const f32x4 (&acc)[2][2][4][2], const Unit& u, int wr, int wc, int fr, int fq) const {
        const int hg = u.pn * 4 + wc;
        const float* g = nullptr; bool isq = false, dorope = false;
        if (hg < 12) { g = ga; isq = true; } else if (hg < 16) { g = ga + 64; } else if (hg < 20) { }
        else if (hg < 28) { g = gb; isq = true; } else if (hg < 36) { g = gb + 64; } else if (hg < 44) { }
        else if (hg < 56) { g = gc; isq = true; dorope = true; } else if (hg < 60) { g = gc + 64; dorope = true; }
        const float qs = isq ? 0.125f : 1.0f;
#pragma unroll
        for (int ai = 0; ai < 2; ++ai)
#pragma unroll
            for (int m = 0; m < 4; ++m) {
                const int row = u.pm * BM + ai * HALF + wr * 64 + m * 16 + fr;
                f32x4 v[2][2];
                const float rsx = rowsq_rs(rowsq, row);
#pragma unroll
                for (int bj = 0; bj < 2; ++bj)
#pragma unroll
                    for (int n = 0; n < 2; ++n) v[bj][n] = acc[ai][bj][m][n] * rsx;
                if (g) {
                    float ss = 0.f;
#pragma unroll
                    for (int bj = 0; bj < 2; ++bj)
#pragma unroll
                        for (int n = 0; n < 2; ++n) { const f32x4 x = v[bj][n]; ss += (x[0] * x[0] + x[1] * x[1]) + (x[2] * x[2] + x[3] * x[3]); }
                    ss += shx(ss, 16, fr + 16 * fq); ss += shx(ss, 32, fr + 16 * fq);
                    const float r = qs / sqrtf(ss * (1.0f / 64.0f) + 1e-6f);
#pragma unroll
                    for (int bj = 0; bj < 2; ++bj)
#pragma unroll
                        for (int n = 0; n < 2; ++n) v[bj][n] = v[bj][n] * *(const f32x4*)(g + 32 * bj + 16 * n + 4 * fq) * r;
                }
                if (dorope) {
                    const int t = row & 2047, pr = t >> 6, pc = t & 63;
#pragma unroll
                    for (int bj = 0; bj < 2; ++bj) {
                        const int pos = bj ? pc : pr;
                        const float* rp = rope + (size_t)(pos * 16 + 4 * fq) * 2;
                        const f32x4 c01 = *(const f32x4*)rp, c23 = *(const f32x4*)(rp + 4);
                        const f32x4 cs = (f32x4){c01[0], c01[2], c23[0], c23[2]}, sn = (f32x4){c01[1], c01[3], c23[1], c23[3]};
                        const f32x4 x1 = v[bj][0], x2 = v[bj][1];
                        v[bj][0] = x1 * cs - x2 * sn; v[bj][1] = x1 * sn + x2 * cs;
                    }
                }
                bf16_t* rowp = O + (size_t)row * 4096 + hg * 64 + 4 * fq;
#pragma unroll
                for (int bj = 0; bj < 2; ++bj)
#pragma unroll
                    for (int n = 0; n < 2; ++n) { u32x2 w; w.x = cvt_pk_bf16(v[bj][n][0], v[bj][n][1]); w.y = cvt_pk_bf16(v[bj][n][2], v[bj][n][3]); *(u32x2*)(rowp + 32 * bj + 16 * n) = w; }
                asm volatile("" ::: "memory");
            }
    }
};
template <class Epi, class Sched, bool ALIGN_EPI = false, bool SP2 = false>
__device__ __forceinline__ void gemm_phase(PG8_LAS unsigned char* lds, const Gemm g, const Sched& S, const Epi& E, const int tid) {
    const int wid = __builtin_amdgcn_readfirstlane(tid >> 6), lane = tid & 63, wr = wid >> 2, wc = wid & 3, fr = lane & 15, fq = lane >> 4;
    const int K = g.K, nt = K / BK;
    unsigned voffA[2], voffB[2];
#pragma unroll
    for (int i = 0; i < 2; ++i) { int R, C; stage_rc(tid * 16 + i * 8192, R, C); const int Rb = Epi::PERM ? ((R & ~31) + perm32(R & 31)) : R;
        voffA[i] = (unsigned)(R * K + C) * 2u; voffB[i] = (unsigned)(Rb * K + C) * 2u; }
    const size_t kstep = (size_t)(BK * 2);
    const size_t hstep = (size_t)HALF * K * 2;
    const size_t tstep = 2 * hstep;
    const unsigned ldsw = (unsigned)wid * 1024u;
    const int aoff = lds_byte(wr * 64 + fr, fq * 8), boff = lds_byte(wc * 32 + fr, fq * 8);
#define PG8_SA(b, h) (((b) * 2 + (h)) * HTB)
#define PG8_SB(b, h) ((4 + (b) * 2 + (h)) * HTB)
#define PG8_STAGE(bufoff, gbase, voff) do { _Pragma("unroll") for (int _i = 0; _i < 2; ++_i) \
        __builtin_amdgcn_global_load_lds((const unsigned*)((const char*)(gbase) + (voff)[_i]), (PG8_LAS unsigned*)(lds + (bufoff) + ldsw + _i * 8192), 16, 0, 0); } while (0)
#define PG8_LDA(dst, b, h) do { _Pragma("unroll") for (int m = 0; m < 4; ++m) _Pragma("unroll") for (int k = 0; k < 2; ++k) dst[m][k] = *(const PG8_LAS bf16x8*)(lds + PG8_SA(b, h) + aoff + m * 2048 + k * 1024); } while (0)
#define PG8_LDB(dst, b, h) do { _Pragma("unroll") for (int n = 0; n < 2; ++n) _Pragma("unroll") for (int k = 0; k < 2; ++k) dst[n][k] = *(const PG8_LAS bf16x8*)(lds + PG8_SB(b, h) + boff + n * 2048 + k * 1024); } while (0)
#define PG8_MMA(ai, bj, At, Bt) do { __builtin_amdgcn_s_setprio(1); _Pragma("unroll") for (int m = 0; m < 4; ++m) _Pragma("unroll") for (int n = 0; n < 2; ++n) _Pragma("unroll") for (int k = 0; k < 2; ++k) \
        acc[ai][bj][m][n] = __builtin_amdgcn_mfma_f32_16x16x32_bf16(Bt[n][k], At[m][k], acc[ai][bj][m][n], 0, 0, 0); __builtin_amdgcn_s_setprio(0); } while (0)
#define PG8_WAIT_V(n) asm volatile("s_waitcnt vmcnt(" #n ")" ::: "memory")
#define PG8_WAIT_L(n) asm volatile("s_waitcnt lgkmcnt(" #n ")" ::: "memory")
#define PG8_BAR __builtin_amdgcn_s_barrier()
#define PG8_SCHED __builtin_amdgcn_sched_barrier(0)
    Unit cur, nxt; int ui = 0;
    if (!S.next(0, cur)) return;
    f32x4 acc[2][2][4][2];
#pragma unroll
    for (int a = 0; a < 2; ++a)
#pragma unroll
        for (int b = 0; b < 2; ++b)
#pragma unroll
            for (int m = 0; m < 4; ++m)
#pragma unroll
                for (int n = 0; n < 2; ++n) acc[a][b][m][n] = (f32x4){0.f, 0.f, 0.f, 0.f};
    bf16x8 At[4][2], B0[2][2], B1[2][2];
    const char* cA = (const char*)g.A + (size_t)cur.pm * tstep; const char* cB = (const char*)g.Bt + (size_t)cur.pn * tstep;
    S.a_ready(cur);
    if constexpr (SP2) {
        PG8_STAGE(PG8_SB(0, 0), cB, voffB); PG8_STAGE(PG8_SB(0, 1), cB + hstep, voffB); PG8_STAGE(PG8_SA(0, 0), cA, voffA); PG8_STAGE(PG8_SA(0, 1), cA + hstep, voffA);
        if (wr == 1) PG8_BAR;
        PG8_WAIT_V(2); PG8_BAR;
        PG8_STAGE(PG8_SB(1, 0), cB + kstep, voffB); PG8_STAGE(PG8_SA(1, 0), cA + kstep, voffA); PG8_STAGE(PG8_SB(1, 1), cB + hstep + kstep, voffB);
        PG8_WAIT_V(6); PG8_BAR;
    } else {
        PG8_STAGE(PG8_SB(0, 0), cB, voffB); PG8_STAGE(PG8_SA(0, 0), cA, voffA); PG8_STAGE(PG8_SB(0, 1), cB + hstep, voffB); PG8_STAGE(PG8_SA(0, 1), cA + hstep, voffA);
        if (wr == 1) PG8_BAR;
        PG8_WAIT_V(4); PG8_BAR;
        PG8_STAGE(PG8_SB(1, 0), cB + kstep, voffB); PG8_STAGE(PG8_SA(1, 0), cA + kstep, voffA); PG8_STAGE(PG8_SB(1, 1), cB + hstep + kstep, voffB);
        PG8_WAIT_V(6); PG8_BAR;
    }
    for (;;) {
        const bool has_next = S.next(ui + 1, nxt);
        const char* nA = has_next ? (const char*)g.A + (size_t)nxt.pm * tstep : cA; const char* nB = has_next ? (const char*)g.Bt + (size_t)nxt.pn * tstep : cB;
        for (int t = 0; t < nt; t += 2) {
            const bool last = (t == nt - 2);
            const char* a1 = cA + (size_t)(t + 1) * kstep;
            const char* a2 = last ? nA : cA + (size_t)(t + 2) * kstep; const char* b2 = last ? nB : cB + (size_t)(t + 2) * kstep;
            const char* a3 = a2 + kstep; const char* b3 = b2 + kstep;
            if (last && has_next) S.a_ready(nxt);
            if constexpr (SP2) {
            PG8_LDB(B0, 0, 0); PG8_LDB(B1, 0, 1); PG8_SCHED; PG8_LDA(At, 0, 0); PG8_STAGE(PG8_SA(1, 1), a1 + hstep, voffA);
            PG8_WAIT_V(8); PG8_WAIT_L(0); PG8_BAR; PG8_MMA(0, 0, At, B0); PG8_MMA(0, 1, At, B1); PG8_BAR; PG8_SCHED;
            PG8_LDA(At, 0, 1); PG8_STAGE(PG8_SB(0, 0), b2, voffB); PG8_STAGE(PG8_SB(0, 1), b2 + hstep, voffB); PG8_STAGE(PG8_SA(0, 0), a2, voffA);
            PG8_WAIT_V(8); PG8_WAIT_L(0); PG8_BAR; PG8_MMA(1, 0, At, B0); PG8_MMA(1, 1, At, B1); PG8_BAR; PG8_SCHED;
            PG8_LDB(B0, 1, 0); PG8_LDB(B1, 1, 1); PG8_SCHED; PG8_LDA(At, 1, 0); PG8_STAGE(PG8_SA(0, 1), a2 + hstep, voffA);
            PG8_WAIT_V(8); PG8_WAIT_L(0); PG8_BAR; PG8_MMA(0, 0, At, B0); PG8_MMA(0, 1, At, B1); PG8_BAR; PG8_SCHED;
            PG8_LDA(At, 1, 1); PG8_STAGE(PG8_SB(1, 0), b3, voffB); PG8_STAGE(PG8_SB(1, 1), b3 + hstep, voffB); PG8_STAGE(PG8_SA(1, 0), a3, voffA);
            PG8_WAIT_V(8); PG8_WAIT_L(0); PG8_BAR; PG8_MMA(1, 0, At, B0); PG8_MMA(1, 1, At, B1); PG8_BAR; PG8_SCHED;
            } else {
            PG8_LDB(B0, 0, 0); PG8_SCHED; PG8_LDA(At, 0, 0); PG8_STAGE(PG8_SA(1, 1), a1 + hstep, voffA);
            PG8_WAIT_L(8); PG8_BAR; PG8_WAIT_L(0); PG8_MMA(0, 0, At, B0); PG8_BAR; PG8_SCHED;
            PG8_LDB(B1, 0, 1); PG8_STAGE(PG8_SB(0, 0), b2, voffB);
            PG8_BAR; PG8_WAIT_L(0); PG8_MMA(0, 1, At, B1); PG8_BAR;
            PG8_LDA(At, 0, 1); PG8_STAGE(PG8_SA(0, 0), a2, voffA);
            PG8_BAR; PG8_WAIT_L(0); PG8_MMA(1, 0, At, B0); PG8_BAR; PG8_SCHED;
            PG8_STAGE(PG8_SB(0, 1), b2 + hstep, voffB);
            PG8_WAIT_V(6); PG8_BAR; PG8_MMA(1, 1, At, B1); PG8_BAR;
            PG8_LDB(B0, 1, 0); PG8_SCHED; PG8_LDA(At, 1, 0); PG8_STAGE(PG8_SA(0, 1), a2 + hstep, voffA);
            PG8_WAIT_L(8); PG8_BAR; PG8_WAIT_L(0); PG8_MMA(0, 0, At, B0); PG8_BAR; PG8_SCHED;
            PG8_LDB(B1, 1, 1); PG8_STAGE(PG8_SB(1, 0), b3, voffB);
            PG8_BAR; PG8_WAIT_L(0); PG8_MMA(0, 1, At, B1); PG8_BAR;
            PG8_LDA(At, 1, 1); PG8_STAGE(PG8_SA(1, 0), a3, voffA);
            PG8_BAR; PG8_WAIT_L(0); PG8_MMA(1, 0, At, B0); PG8_BAR; PG8_SCHED;
            PG8_STAGE(PG8_SB(1, 1), b3 + hstep, voffB);
            PG8_WAIT_V(6); PG8_BAR; PG8_MMA(1, 1, At, B1); PG8_BAR;
            }
        }
        if constexpr (ALIGN_EPI) { if (wr == 0) PG8_BAR; }
        if constexpr (!Epi::AFTER_DRAIN) { E(acc, cur, wr, wc, fr, fq); S.done(cur); }
        if (!has_next) break;
#pragma unroll
        for (int a = 0; a < 2; ++a)
#pragma unroll
            for (int b = 0; b < 2; ++b)
#pragma unroll
                for (int m = 0; m < 4; ++m)
#pragma unroll
                    for (int n = 0; n < 2; ++n) acc[a][b][m][n] = (f32x4){0.f, 0.f, 0.f, 0.f};
        cur = nxt; cA = nA; cB = nB; ++ui;
        if constexpr (ALIGN_EPI) { if (wr == 1) PG8_BAR; }
    }
    PG8_WAIT_V(0);
    if constexpr (!ALIGN_EPI) { if (wr == 0) PG8_BAR; }
    PG8_BAR;
    if constexpr (Epi::AFTER_DRAIN) { E.fused(acc, cur, wr, wc, fr, fq, lds, wid, lane); S.done(cur); }
#undef PG8_SA
#undef PG8_SB
#undef PG8_STAGE
#undef PG8_LDA
#undef PG8_LDB
#undef PG8_MMA
#undef PG8_WAIT_V
#undef PG8_WAIT_L
#undef PG8_BAR
#undef PG8_SCHED
}
}

constexpr int BATCH = 16, SEQ = 2048, DM = 2048, T = BATCH * SEQ, DEPTH = 2;
constexpr int NMEM = 256, DIN = 4096, MEMW = 512;
constexpr int PEER_H = 8, PEER_N = 16384;
constexpr int NWAVES = 8, NTHREADS = NWAVES * 64;
constexpr float EPS = 1e-6f;
constexpr int QA = 0, KA = 768, VA = 1024, QB = 1280, KB = 1792, VB = 2304, QC = 2816, KC = 3584, VC = 3840;
constexpr int OA = 0, OB = 768, OC = 1280;

constexpr size_t MiB = 1u << 20;
constexpr size_t WS_CTL = 0, CTL_ZERO_BYTES = 2 * MiB;
constexpr size_t WS_ROWSQ = 256 * 1024;
constexpr size_t WS_ROPE = 83 * MiB, WS_BIASA = 83 * MiB + 16384;
constexpr size_t WS_WIN = 2 * MiB, WS_WOUT = 34 * MiB, WS_WMQ = 50 * MiB, WS_WMKV = 54 * MiB, WS_WMO = 62 * MiB, WS_WPQ = 66 * MiB, WS_PKEYS = 82 * MiB;
constexpr size_t WS_MEMN = 84 * MiB, WS_KVM = 116 * MiB, WS_PU = 132 * MiB, WS_PV = 260 * MiB, WS_XN = 388 * MiB, WS_QKV = 516 * MiB, WS_ATT = 772 * MiB;
constexpr size_t WS_QM = 900 * MiB, WS_OM = 932 * MiB, WS_END = 964 * MiB;
constexpr size_t WS_QP = WS_QKV, WS_PIDX = WS_QKV + 128 * MiB, WS_PGATE = WS_QKV + 144 * MiB;
constexpr int CW_BAR = 4096;

constexpr int RING_OFF = 0, RING_BYTES = 131072;
constexpr int LDSCTL_OFF = RING_BYTES, MISC_OFF = LDSCTL_OFF + 320;
constexpr int LDS_BYTES = 147456;

#define GAS __attribute__((address_space(1)))
#define LAS __attribute__((address_space(3)))
typedef unsigned short bf16;
typedef unsigned v4u __attribute__((ext_vector_type(4)));
typedef unsigned v2u __attribute__((ext_vector_type(2)));
typedef float f32x4 __attribute__((ext_vector_type(4)));
typedef float f32x16 __attribute__((ext_vector_type(16)));
typedef short bf16x8 __attribute__((ext_vector_type(8)));
typedef GAS unsigned gu32;
#define LDS_WAIT() asm volatile("s_waitcnt lgkmcnt(0)" ::: "memory")
#define VM_WAIT() asm volatile("s_waitcnt vmcnt(0)" ::: "memory")
__device__ __forceinline__ unsigned f2bf(float f) { unsigned u = __builtin_bit_cast(unsigned, f); return (u + 0x7fffu + ((u >> 16) & 1u)) >> 16; }
__device__ __forceinline__ unsigned pk2(float lo, float hi) { return f2bf(lo) | (f2bf(hi) << 16); }
__device__ __forceinline__ float bflo(unsigned w) { return __builtin_bit_cast(float, w << 16); }
__device__ __forceinline__ float bfhi(unsigned w) { return __builtin_bit_cast(float, w & 0xffff0000u); }

__device__ __forceinline__ float shx(float v, int k, int lane) { return __builtin_bit_cast(float, __builtin_amdgcn_ds_bpermute((lane ^ k) << 2, __builtin_bit_cast(int, v))); }
#define XB_TMO      128
#define XB_XCNT(j)  (256  + 64 * (j))
#define XB_XSUB(j)  (1280 + 64 * (j))
#define XB_XGEN(j)  (2304 + 64 * (j))
#define XB_TOP      3328
#define XB_TOPGEN   3392
#define XCD_BAR_WORDS 3456
#define XB_SPIN_CAP (1u << 18)

__device__ __forceinline__ unsigned xb_ld(unsigned* p)              { return __hip_atomic_load(p, __ATOMIC_RELAXED, __HIP_MEMORY_SCOPE_AGENT); }
__device__ __forceinline__ unsigned xb_add(unsigned* p, unsigned v) { return __hip_atomic_fetch_add(p, v, __ATOMIC_RELAXED, __HIP_MEMORY_SCOPE_AGENT); }
__device__ __forceinline__ unsigned xb_xcc_id() { return (unsigned)__builtin_amdgcn_s_getreg((3 << 11) | 20) & 0xFu; }
#define XB_SPIN(cond, bar) do { unsigned _sp = 0; while (cond) { __builtin_amdgcn_s_sleep(1); \
    if ((++_sp & 255u) == 0u) { if (xb_ld(&(bar)[XB_TMO])) break; if (_sp > XB_SPIN_CAP) { atomicAdd(&(bar)[XB_TMO], 1u); break; } } } } while (0)

struct XcdBarrier {
    unsigned* bar; unsigned x;
    volatile LAS unsigned* st;
};

__device__ __forceinline__ XcdBarrier xcd_barrier_post(unsigned* bar, volatile LAS unsigned* st) {
    XcdBarrier b; b.bar = bar; b.x = xb_xcc_id(); b.st = st;
    if (threadIdx.x == 0) (void)xb_add(&bar[XB_XCNT(b.x)], 1u);
    return b;
}
__device__ __forceinline__ void xcd_barrier_complete(unsigned* bar, unsigned x, unsigned& nloc, unsigned& nx) {
    const unsigned G = gridDim.x * gridDim.y * gridDim.z;
    unsigned sum, cnt, mine, sp = 0u;
    for (;;) {
        sum = 0u; cnt = 0u; mine = 0u;
#pragma unroll
        for (unsigned j = 0; j < 16; ++j) { const unsigned c = xb_ld(&bar[XB_XCNT(j)]); sum += c; cnt += (c > 0u) ? 1u : 0u; mine = (j == x) ? c : mine; }
        if (sum == G) break;
        __builtin_amdgcn_s_sleep(1);
        if ((++sp & 255u) == 0u) { if (xb_ld(&bar[XB_TMO])) break; if (sp > XB_SPIN_CAP) { atomicAdd(&bar[XB_TMO], 1u); break; } }
    }
    nloc = mine > 0u ? mine : 1u; nx = cnt > 0u ? cnt : 1u;
}

__device__ __forceinline__ void xcd_barrier(const XcdBarrier& b) {
    asm volatile("s_waitcnt vmcnt(0)" ::: "memory");
    __syncthreads();
    if (threadIdx.x == 0) {
        unsigned* bar = b.bar;
        __builtin_amdgcn_s_waitcnt(0);
        unsigned nloc = b.st[0], nx = b.st[1];
        if (nloc == 0u) { xcd_barrier_complete(bar, b.x, nloc, nx); b.st[0] = nloc; b.st[1] = nx; }
        const unsigned old = xb_add(&bar[XB_XSUB(b.x)], 1u);
        const unsigned gen = old / nloc;
        if (old + 1u == (gen + 1u) * nloc) {
            __builtin_amdgcn_fence(__ATOMIC_RELEASE, "agent");
            asm volatile("s_waitcnt vmcnt(0)" ::: "memory");
            const unsigned og = xb_add(&bar[XB_TOP], 1u);
            const unsigned tg = og / nx;
            if (og + 1u == (tg + 1u) * nx) xb_add(&bar[XB_TOPGEN], 1u);
            else XB_SPIN(xb_ld(&bar[XB_TOPGEN]) == tg, bar);
            __builtin_amdgcn_fence(__ATOMIC_ACQUIRE, "agent");
            xb_add(&bar[XB_XGEN(b.x)], 1u);
            asm volatile("s_waitcnt vmcnt(0)" ::: "memory");
        } else {
            XB_SPIN(xb_ld(&bar[XB_XGEN(b.x)]) == gen, bar);
            __builtin_amdgcn_fence(__ATOMIC_ACQUIRE, "agent");
            asm volatile("s_waitcnt vmcnt(0)" ::: "memory");
        }
    }
    __syncthreads();
}

__device__ __forceinline__ float wave_sum(float v, int lane) {
#pragma unroll
    for (int o = 1; o < 64; o <<= 1) v += shx(v, o, lane);
    return v;
}
__device__ __forceinline__ void* ldptr(LAS unsigned char* lds, int i) {
    const unsigned long long v = ((const LAS unsigned long long*)(lds + LDSCTL_OFF + 1024))[i];
    const unsigned lo = __builtin_amdgcn_readfirstlane((unsigned)v), hi = __builtin_amdgcn_readfirstlane((unsigned)(v >> 32));
    return (void*)(((unsigned long long)hi << 32) | lo);
}
struct OffsetOrder {
    pg8::StaticOrder S;
    __device__ void init(int M, int N, int G, int c, int off) { S.init(M, N, G, (c + G - off % G) % G); }
    __device__ bool next(int i, pg8::Unit& u) const { return S.next(i, u); }
    __device__ __forceinline__ void a_ready(const pg8::Unit&) const {}
    __device__ __forceinline__ void done(const pg8::Unit&) const {}
};

template <bool PERMQKV>
__device__ __forceinline__ void transpose_item(const float* W, int K, int N, bf16* WT, LAS float* scr, int item, int lane, const float* gk = nullptr) {
    const int nblk = N / 32, kb = item / nblk, nb = item % nblk, k0 = 64 * kb, n0 = 32 * nb;
    int d0 = n0;
    if (PERMQKV) { const int within = n0 & 255; d0 = (n0 & ~255) + 128 * ((within >> 5) & 1) + 32 * (within >> 6); }
#pragma unroll 8
    for (int i = 0; i < 32; ++i) { const int kk = 2 * i + (lane >> 5); scr[kk * 33 + (lane & 31)] = W[(size_t)(k0 + kk) * N + n0 + (lane & 31)] * (gk ? gk[k0 + kk] : 1.f); }
    LDS_WAIT(); asm volatile("" ::: "memory");
    const int c = lane & 7;
#pragma unroll
    for (int j = 0; j < 4; ++j) { const int n = (lane >> 3) + 8 * j; const LAS float* s = scr + (8 * c) * 33 + n;
        v4u o; o.x = pk2(s[0 * 33], s[1 * 33]); o.y = pk2(s[2 * 33], s[3 * 33]); o.z = pk2(s[4 * 33], s[5 * 33]); o.w = pk2(s[6 * 33], s[7 * 33]);
        *(GAS v4u*)(WT + (size_t)(d0 + n) * K + k0 + 8 * c) = o; }
    LDS_WAIT(); asm volatile("" ::: "memory");
}
__device__ __forceinline__ void convert_bf16(const float* src, bf16* dst, size_t n, size_t gtid, size_t nthreads) {
    for (size_t i = gtid * 8; i < n; i += nthreads * 8) {
        const f32x4 a = *(const GAS f32x4*)(src + i), b = *(const GAS f32x4*)(src + i + 4);
        v4u o; o.x = pk2(a[0], a[1]); o.y = pk2(a[2], a[3]); o.z = pk2(b[0], b[1]); o.w = pk2(b[2], b[3]);
        *(GAS v4u*)(dst + i) = o;
    }
}
__device__ __forceinline__ int t5_bucket(int rel) {
    const int n = rel < 0 ? -rel : rel;
    const int b = n < 8 ? n : n < 12 ? 8 : n < 16 ? 9 : n < 23 ? 10 : n < 32 ? 11 : n < 46 ? 12 : n < 64 ? 13 : n < 91 ? 14 : 15;
    return b + (rel > 0 ? 16 : 0);
}
__constant__ float ROPE_INV[16] = {1.000000000e+00f, 5.623413324e-01f, 3.162277639e-01f, 1.778279394e-01f, 1.000000015e-01f, 5.623413250e-02f, 3.162277490e-02f, 1.778279431e-02f,
                                   9.999999776e-03f, 5.623413250e-03f, 3.162277630e-03f, 1.778279431e-03f, 1.000000047e-03f, 5.623413017e-04f, 3.162277571e-04f, 1.778279402e-04f};

__device__ __forceinline__ void rms_row_to_bf16(const float* xrow, const float* g0, bf16* o0, const float* g1, bf16* o1, int lane) {
    const GAS f32x4* xr = (const GAS f32x4*)xrow + lane;
    f32x4 v[8]; float s = 0.f;
#pragma unroll
    for (int j = 0; j < 8; ++j) { v[j] = xr[64 * j]; s += (v[j].x * v[j].x + v[j].y * v[j].y) + (v[j].z * v[j].z + v[j].w * v[j].w); }
    const float rstd = 1.f / sqrtf(wave_sum(s, lane) * (1.f / DM) + EPS);
    {   const GAS f32x4* gr = (const GAS f32x4*)g0 + lane; GAS v2u* o8 = (GAS v2u*)o0 + lane;
#pragma unroll
        for (int j = 0; j < 8; ++j) { const f32x4 gg = gr[64 * j]; v2u w; w.x = pk2(v[j].x * rstd * gg.x, v[j].y * rstd * gg.y); w.y = pk2(v[j].z * rstd * gg.z, v[j].w * rstd * gg.w); o8[64 * j] = w; } }
    if (g1) { const GAS f32x4* gr = (const GAS f32x4*)g1 + lane; GAS v2u* o8 = (GAS v2u*)o1 + lane;
#pragma unroll
        for (int j = 0; j < 8; ++j) { const f32x4 gg = gr[64 * j]; v2u w; w.x = pk2(v[j].x * rstd * gg.x, v[j].y * rstd * gg.y); w.y = pk2(v[j].z * rstd * gg.z, v[j].w * rstd * gg.w); o8[64 * j] = w; } }
}
__device__ __forceinline__ void prep_row(const float* xrow, bf16* orow, u64_t* sq, int lane) {
    const GAS f32x4* xr = (const GAS f32x4*)xrow + lane; GAS v2u* o8 = (GAS v2u*)orow + lane; float s = 0.f;
#pragma unroll
    for (int j = 0; j < 8; ++j) { const f32x4 v = xr[64 * j]; s += (v.x * v.x + v.y * v.y) + (v.z * v.z + v.w * v.w); v2u w; w.x = pk2(v.x, v.y); w.y = pk2(v.z, v.w); o8[64 * j] = w; }
    s = wave_sum(s, lane);
    if (lane == 0) *sq = rowsq_fx(s);
}
__device__ __forceinline__ void norm_rows(const float* X, const float* g, bf16* XN, int gw, int NGW, int lane) {
    for (int m = gw; m < T; m += NGW) rms_row_to_bf16(X + (size_t)m * DM, g, XN + (size_t)m * DM, nullptr, nullptr, lane);
}

template <int TYPE>
__device__ __forceinline__ void naive_attn_item(const bf16* QKV, bf16* ATT, int b, int grow, int head, int lane, const float* biasA, const float* sink, const float* rpb) {
    const int tpos = grow * 64 + lane; const size_t trow = (size_t)b * SEQ + tpos;
    int qcol, kcol, vcol, ocol;
    if (TYPE == 0) { qcol = QA + head * 64; kcol = KA + (head / 3) * 64; vcol = VA + (head / 3) * 64; ocol = OA + head * 64; }
    else if (TYPE == 1) { qcol = QB + head * 64; kcol = KB + head * 64; vcol = VB + head * 64; ocol = OB + head * 64; }
    else { qcol = QC + head * 64; kcol = KC + (head / 3) * 64; vcol = VC + (head / 3) * 64; ocol = OC + head * 64; }
    float q[64], o[64];
#pragma unroll
    for (int c = 0; c < 8; ++c) { const v4u w = *(const GAS v4u*)(QKV + trow * DIN + qcol + 8 * c);
        q[8 * c + 0] = bflo(w.x); q[8 * c + 1] = bfhi(w.x); q[8 * c + 2] = bflo(w.y); q[8 * c + 3] = bfhi(w.y); q[8 * c + 4] = bflo(w.z); q[8 * c + 5] = bfhi(w.z); q[8 * c + 6] = bflo(w.w); q[8 * c + 7] = bfhi(w.w); }
#pragma unroll
    for (int d = 0; d < 64; ++d) o[d] = 0.f;
    float m = -1e30f, l = 0.f;
    int j0, j1;
    if (TYPE == 0) { j0 = grow * 64 - 128; if (j0 < 0) j0 = 0; j1 = grow * 64 + 63 + 128; if (j1 > SEQ - 1) j1 = SEQ - 1; }
    else if (TYPE == 1) { int r0 = grow - 4; r0 = r0 < 0 ? 0 : (r0 > 24 ? 24 : r0); j0 = r0 * 64; j1 = j0 + 511; }
    else { j0 = 0; j1 = SEQ - 1; }
    int c0 = lane - 8; c0 = c0 < 0 ? 0 : (c0 > 48 ? 48 : c0);
#pragma unroll 1
    for (int j = j0; j <= j1; ++j) {
        const bf16* krow = QKV + ((size_t)b * SEQ + j) * DIN;
        float s = 0.f;
#pragma unroll
        for (int c = 0; c < 8; ++c) { const v4u w = *(const GAS v4u*)(krow + kcol + 8 * c);
            s += q[8 * c + 0] * bflo(w.x) + q[8 * c + 1] * bfhi(w.x) + q[8 * c + 2] * bflo(w.y) + q[8 * c + 3] * bfhi(w.y) + q[8 * c + 4] * bflo(w.z) + q[8 * c + 5] * bfhi(w.z) + q[8 * c + 6] * bflo(w.w) + q[8 * c + 7] * bfhi(w.w); }
        bool valid = true;
        if (TYPE == 0) { const int rel = j - tpos; valid = (rel >= -128 && rel <= 128); if (valid) s += biasA[head * 257 + rel + 128]; }
        if (TYPE == 1) { const int kr = j >> 6, kc = j & 63; valid = (kc >= c0 && kc < c0 + 16); if (valid) s += rpb[(head * 15 + (kr - grow + 7)) * 31 + (kc - lane + 15)]; }
        const float mn = valid ? fmaxf(m, s) : m;
        const float a = __expf(m - mn);
        const float p = valid ? __expf(s - mn) : 0.f;
        l = l * a + p; m = mn;
#pragma unroll
        for (int c = 0; c < 8; ++c) { const v4u w = *(const GAS v4u*)(krow + vcol + 8 * c);
            o[8 * c + 0] = o[8 * c + 0] * a + p * bflo(w.x); o[8 * c + 1] = o[8 * c + 1] * a + p * bfhi(w.x); o[8 * c + 2] = o[8 * c + 2] * a + p * bflo(w.y); o[8 * c + 3] = o[8 * c + 3] * a + p * bfhi(w.y);
            o[8 * c + 4] = o[8 * c + 4] * a + p * bflo(w.z); o[8 * c + 5] = o[8 * c + 5] * a + p * bfhi(w.z); o[8 * c + 6] = o[8 * c + 6] * a + p * bflo(w.w); o[8 * c + 7] = o[8 * c + 7] * a + p * bfhi(w.w); }
    }
    if (TYPE == 0) l += __expf(sink[head] - m);
    const float inv = 1.f / l;
#pragma unroll
    for (int c = 0; c < 8; ++c) { v4u w; w.x = pk2(o[8 * c + 0] * inv, o[8 * c + 1] * inv); w.y = pk2(o[8 * c + 2] * inv, o[8 * c + 3] * inv); w.z = pk2(o[8 * c + 4] * inv, o[8 * c + 5] * inv); w.w = pk2(o[8 * c + 6] * inv, o[8 * c + 7] * inv);
        *(GAS v4u*)(ATT + trow * DM + ocol + 8 * c) = w; }
}
__device__ __forceinline__ float rdl(float v, int l) { return __builtin_bit_cast(float, __builtin_amdgcn_readlane(__builtin_bit_cast(int, v), l)); }
__device__ __forceinline__ void naive_mem_item(const bf16* QM, const bf16* KVM, bf16* OM, const float* gq, size_t trow, int b, int head, int lane) {
    const unsigned qw = *(const GAS unsigned*)(QM + trow * MEMW + head * 128 + 2 * lane);
    float q0 = bflo(qw), q1 = bfhi(qw);
    const float ss = wave_sum(q0 * q0 + q1 * q1, lane);
    const float r = 0.08838834764831845f / sqrtf(ss * (1.f / 128.f) + EPS);
    q0 *= r * gq[2 * lane]; q1 *= r * gq[2 * lane + 1];
    const bf16* kbase = KVM + ((size_t)b * NMEM + lane) * 1024 + head * 128;
    float s[4] = {0.f, 0.f, 0.f, 0.f};
#pragma unroll 1
    for (int c = 0; c < 16; ++c) {
        float qa[8];
#pragma unroll
        for (int e = 0; e < 4; ++e) { qa[2 * e] = rdl(q0, 4 * c + e); qa[2 * e + 1] = rdl(q1, 4 * c + e); }
#pragma unroll
        for (int i = 0; i < 4; ++i) { const v4u w = *(const GAS v4u*)(kbase + (size_t)i * 64 * 1024 + 8 * c);
            s[i] += qa[0] * bflo(w.x) + qa[1] * bfhi(w.x) + qa[2] * bflo(w.y) + qa[3] * bfhi(w.y) + qa[4] * bflo(w.z) + qa[5] * bfhi(w.z) + qa[6] * bflo(w.w) + qa[7] * bfhi(w.w); }
    }
    float m = fmaxf(fmaxf(s[0], s[1]), fmaxf(s[2], s[3]));
#pragma unroll
    for (int o = 1; o < 64; o <<= 1) m = fmaxf(m, shx(m, o, lane));
    float p[4]; float l = 0.f;
#pragma unroll
    for (int i = 0; i < 4; ++i) { p[i] = __expf(s[i] - m); l += p[i]; }
    l = wave_sum(l, lane);
    const bf16* vbase = KVM + ((size_t)b * NMEM) * 1024 + 512 + head * 128 + 2 * lane;
    float o0 = 0.f, o1 = 0.f;
#pragma unroll
    for (int i = 0; i < 4; ++i) {
#pragma unroll 4
        for (int jj = 0; jj < 64; ++jj) { const float pj = rdl(p[i], jj); const unsigned w = *(const GAS unsigned*)(vbase + (size_t)(64 * i + jj) * 1024); o0 += pj * bflo(w); o1 += pj * bfhi(w); }
    }
    const float inv = 1.f / l;
    *(GAS unsigned*)(OM + trow * MEMW + head * 128 + 2 * lane) = pk2(o0 * inv, o1 * inv);
}
__device__ __forceinline__ void mixnorm_rows(bf16* ATT, const float* g, int gw, int NGW, int lane) {
    for (int m = gw; m < T; m += NGW) {
        GAS v4u* p = (GAS v4u*)(ATT + (size_t)m * DM + 32 * lane);
        v4u w[4]; float f[32]; float ss = 0.f;
#pragma unroll
        for (int c = 0; c < 4; ++c) { w[c] = p[c];
            f[8 * c + 0] = bflo(w[c].x); f[8 * c + 1] = bfhi(w[c].x); f[8 * c + 2] = bflo(w[c].y); f[8 * c + 3] = bfhi(w[c].y); f[8 * c + 4] = bflo(w[c].z); f[8 * c + 5] = bfhi(w[c].z); f[8 * c + 6] = bflo(w[c].w); f[8 * c + 7] = bfhi(w[c].w); }
#pragma unroll
        for (int i = 0; i < 32; ++i) ss += f[i] * f[i];
        const int grp = lane < 24 ? 0 : (lane < 40 ? 1 : 2);
        const float sa = wave_sum(grp == 0 ? ss : 0.f, lane), sb = wave_sum(grp == 1 ? ss : 0.f, lane), sc = wave_sum(grp == 2 ? ss : 0.f, lane);
        const float r = grp == 0 ? 1.f / sqrtf(sa * (1.f / 768.f) + EPS) : (grp == 1 ? 1.f / sqrtf(sb * (1.f / 512.f) + EPS) : 1.f / sqrtf(sc * (1.f / 768.f) + EPS));
        const float* gg = g + 32 * lane;
#pragma unroll
        for (int c = 0; c < 4; ++c) { const f32x4 g0 = *(const GAS f32x4*)(gg + 8 * c), g1 = *(const GAS f32x4*)(gg + 8 * c + 4);
            v4u o; o.x = pk2(f[8 * c + 0] * r * g0[0], f[8 * c + 1] * r * g0[1]); o.y = pk2(f[8 * c + 2] * r * g0[2], f[8 * c + 3] * r * g0[3]);
            o.z = pk2(f[8 * c + 4] * r * g1[0], f[8 * c + 5] * r * g1[1]); o.w = pk2(f[8 * c + 6] * r * g1[2], f[8 * c + 7] * r * g1[3]); p[c] = o; }
    }
}

#ifndef PEER_HD
#define PEER_HD __device__ __forceinline__
#define PEER_EXP(x) __expf(x)
#endif
template <int N> PEER_HD void bitonic_sort_desc(float* v) {
#pragma unroll
    for (int k = 2; k <= N; k <<= 1)
#pragma unroll
        for (int j = k >> 1; j > 0; j >>= 1)
#pragma unroll
            for (int i = 0; i < N; ++i) { const int l = i ^ j; if (l > i) { const bool desc = ((i & k) == 0); const float a = v[i], b = v[l]; const float hi = fmaxf(a, b), lo = fminf(a, b);
                v[i] = desc ? hi : lo; v[l] = desc ? lo : hi; } }
}
PEER_HD void merge_top16(float* a, const float* b) {
    float c[16];
#pragma unroll
    for (int i = 0; i < 16; ++i) c[i] = fmaxf(a[i], b[15 - i]);
#pragma unroll
    for (int j = 8; j > 0; j >>= 1)
#pragma unroll
        for (int i = 0; i < 16; ++i) { const int l = i ^ j; if (l > i) { const float x = c[i], y = c[l]; c[i] = fmaxf(x, y); c[l] = fminf(x, y); } }
#pragma unroll
    for (int i = 0; i < 16; ++i) a[i] = c[i];
}
PEER_HD void top16_of_64(float (&v)[64]) {
    bitonic_sort_desc<16>(&v[0]); bitonic_sort_desc<16>(&v[16]); bitonic_sort_desc<16>(&v[32]); bitonic_sort_desc<16>(&v[48]);
    merge_top16(&v[0], &v[16]); merge_top16(&v[32], &v[48]); merge_top16(&v[0], &v[32]);
}
PEER_HD float pack_idx(float s, unsigned idx, unsigned mask) { return __builtin_bit_cast(float, (__builtin_bit_cast(unsigned, s) & ~mask) | idx); }
PEER_HD unsigned low_bits(float s, unsigned mask) { return __builtin_bit_cast(unsigned, s) & mask; }
PEER_HD unsigned pick16(const float* a, unsigned i, unsigned mask) {
    unsigned r = 0;
#pragma unroll
    for (unsigned k = 0; k < 16; ++k) r = (i == k) ? low_bits(a[k], mask) : r;
    return r;
}
PEER_HD void peer_candidates(const float* a, const float* b, int* e, float* gate) {
    float c[64]; int n = 0;
#pragma unroll
    for (int i = 0; i < 16; ++i)
#pragma unroll
        for (int j = 0; j < 16; ++j) if ((i + 1) * (j + 1) <= 16) { c[n] = pack_idx(a[i] + b[j], (unsigned)(i * 16 + j), 0xffu); ++n; }
#pragma unroll
    for (int k = 50; k < 64; ++k) c[k] = -3.0e38f;
    top16_of_64(c);
    float mx = c[0], den = 0.f;
#pragma unroll
    for (int k = 0; k < 16; ++k) { const unsigned id = low_bits(c[k], 0xffu); const unsigned n0 = pick16(a, id >> 4, 0x7fu), n1 = pick16(b, id & 15u, 0x7fu);
        e[k] = (int)(n0 * 128u + n1); gate[k] = PEER_EXP(c[k] - mx); den += gate[k]; }
    const float inv = 1.f / den;
#pragma unroll
    for (int k = 0; k < 16; ++k) gate[k] *= inv;
}

__device__ __forceinline__ void peer_select_unit(const bf16* QP, const bf16* PK, int* PIDX, float* PGATE, int tb, int h, int wave, int lane) {
    const int hh = lane >> 5, tl = lane & 31; const size_t t = (size_t)tb * 256 + wave * 32 + tl;
    float ab[2][16];
#pragma unroll
    for (int p = 0; p < 2; ++p) {
        bf16x8 bq[8];
#pragma unroll
        for (int s = 0; s < 8; ++s) bq[s] = *(const GAS bf16x8*)(QP + t * DM + 256 * h + 128 * p + 16 * s + 8 * hh);
        float v[64];
#pragma unroll
        for (int nb = 0; nb < 4; ++nb) {
            f32x16 acc;
#pragma unroll
            for (int r = 0; r < 16; ++r) acc[r] = 0.f;
            const bf16* kp = PK + ((size_t)((h * 2 + p) * 128 + 32 * nb + tl)) * 128 + 8 * hh;
#pragma unroll
            for (int s = 0; s < 8; ++s) { const bf16x8 ak = *(const GAS bf16x8*)(kp + 16 * s); acc = __builtin_amdgcn_mfma_f32_32x32x16_bf16(ak, bq[s], acc, 0, 0, 0); }
#pragma unroll
            for (int r = 0; r < 16; ++r) v[16 * nb + r] = pack_idx(acc[r], (unsigned)(32 * nb + 8 * (r >> 2) + 4 * hh + (r & 3)), 0x7fu);
        }
        top16_of_64(v);
        float pv[16];
#pragma unroll
        for (int i = 0; i < 16; ++i) pv[i] = shx(v[i], 32, lane);
        merge_top16(&v[0], pv);
#pragma unroll
        for (int i = 0; i < 16; ++i) ab[p][i] = v[i];
    }
    int e[16]; float gate[16];
    peer_candidates(ab[0], ab[1], e, gate);
    if (hh == 0) { GAS v4u* o = (GAS v4u*)(PIDX + t * 128 + h * 16);
#pragma unroll
        for (int c = 0; c < 4; ++c) o[c] = (v4u){(unsigned)e[4 * c], (unsigned)e[4 * c + 1], (unsigned)e[4 * c + 2], (unsigned)e[4 * c + 3]}; }
    else { GAS f32x4* o = (GAS f32x4*)(PGATE + t * 128 + h * 16);
#pragma unroll
        for (int c = 0; c < 4; ++c) o[c] = (f32x4){gate[4 * c], gate[4 * c + 1], gate[4 * c + 2], gate[4 * c + 3]}; }
}

__device__ __forceinline__ float dot8(const v4u& x, const v4u& u) {
    return bflo(x.x) * bflo(u.x) + bfhi(x.x) * bfhi(u.x) + bflo(x.y) * bflo(u.y) + bfhi(x.y) * bfhi(u.y) + bflo(x.z) * bflo(u.z) + bfhi(x.z) * bfhi(u.z) + bflo(x.w) * bflo(u.w) + bfhi(x.w) * bfhi(u.w);
}
__device__ __forceinline__ void axpy8(float* y, float w, const v4u& v) {
    y[0] += w * bflo(v.x); y[1] += w * bfhi(v.x); y[2] += w * bflo(v.y); y[3] += w * bfhi(v.y); y[4] += w * bflo(v.z); y[5] += w * bfhi(v.z); y[6] += w * bflo(v.w); y[7] += w * bfhi(v.w);
}
__device__ __forceinline__ void peer_gather(const bf16* XN, const bf16* PU, const bf16* PV, const int* PIDX, const float* PGATE, float* X, int gw, int NGW, int lane) {
    for (int t = gw; t < T; t += NGW) {
        v4u xv[4];
#pragma unroll
        for (int j = 0; j < 4; ++j) xv[j] = *(const GAS v4u*)(XN + (size_t)t * DM + 8 * lane + 512 * j);
        float y[32];
#pragma unroll
        for (int i = 0; i < 32; ++i) y[i] = 0.f;
        for (int k = 0; k < 128; k += 2) {
            const int e0 = __builtin_amdgcn_readfirstlane(PIDX[(size_t)t * 128 + k]), e1 = __builtin_amdgcn_readfirstlane(PIDX[(size_t)t * 128 + k + 1]);
            const float g0 = PGATE[(size_t)t * 128 + k], g1 = PGATE[(size_t)t * 128 + k + 1];
            v4u u0[4], u1[4], v0[4], v1[4];
#pragma unroll
            for (int j = 0; j < 4; ++j) { u0[j] = *(const GAS v4u*)(PU + (size_t)e0 * DM + 8 * lane + 512 * j); u1[j] = *(const GAS v4u*)(PU + (size_t)e1 * DM + 8 * lane + 512 * j); }
#pragma unroll
            for (int j = 0; j < 4; ++j) { v0[j] = *(const GAS v4u*)(PV + (size_t)e0 * DM + 8 * lane + 512 * j); v1[j] = *(const GAS v4u*)(PV + (size_t)e1 * DM + 8 * lane + 512 * j); }
            float d0 = 0.f, d1 = 0.f;
#pragma unroll
            for (int j = 0; j < 4; ++j) { d0 += dot8(xv[j], u0[j]); d1 += dot8(xv[j], u1[j]); }
            d0 = wave_sum(d0, lane); d1 = wave_sum(d1, lane);
            const float w0 = g0 * 0.5f * d0 * (1.f + erff(d0 * 0.70710678118654752f)), w1 = g1 * 0.5f * d1 * (1.f + erff(d1 * 0.70710678118654752f));
#pragma unroll
            for (int j = 0; j < 4; ++j) { axpy8(&y[8 * j], w0, v0[j]); axpy8(&y[8 * j], w1, v1[j]); }
        }
#pragma unroll
        for (int j = 0; j < 4; ++j) { GAS f32x4* xp = (GAS f32x4*)(X + (size_t)t * DM + 8 * lane + 512 * j);
            f32x4 a = xp[0], b = xp[1]; a += (f32x4){y[8 * j], y[8 * j + 1], y[8 * j + 2], y[8 * j + 3]}; b += (f32x4){y[8 * j + 4], y[8 * j + 5], y[8 * j + 6], y[8 * j + 7]}; xp[0] = a; xp[1] = b; }
    }
}


typedef float f32x2 __attribute__((ext_vector_type(2)));
constexpr float PU_SCALE = 256.f, PV_SCALE = 16.f;
__device__ __forceinline__ void convert_fp8(const float* src, unsigned char* dst, size_t n, float scale, size_t gtid, size_t nthreads) {
    for (size_t i = gtid * 16; i < n; i += nthreads * 16) {
        v4u o;
#pragma unroll
        for (int c = 0; c < 4; ++c) { f32x4 a = *(const GAS f32x4*)(src + i + 4 * c) * scale;
#pragma unroll
            for (int e = 0; e < 4; ++e) a[e] = fminf(fmaxf(a[e], -448.f), 448.f);
            int p = 0; p = __builtin_amdgcn_cvt_pk_fp8_f32(a[0], a[1], p, false); p = __builtin_amdgcn_cvt_pk_fp8_f32(a[2], a[3], p, true); o[c] = (unsigned)p; }
        *(GAS v4u*)(dst + i) = o;
    }
}
__device__ __forceinline__ void dot16_fp8(f32x2& acc, const v4u& w, const f32x2* x) {
#pragma unroll
    for (int c = 0; c < 4; ++c) { acc += __builtin_amdgcn_cvt_pk_f32_fp8((int)w[c], false) * x[2 * c]; acc += __builtin_amdgcn_cvt_pk_f32_fp8((int)w[c], true) * x[2 * c + 1]; }
}
__device__ __forceinline__ void axpy16_fp8(f32x2* y, const f32x2 wv, const v4u& w) {
#pragma unroll
    for (int c = 0; c < 4; ++c) { y[2 * c] += __builtin_amdgcn_cvt_pk_f32_fp8((int)w[c], false) * wv; y[2 * c + 1] += __builtin_amdgcn_cvt_pk_f32_fp8((int)w[c], true) * wv; }
}
#define PG_R 4
#define PG_LOAD(buf, tab, idlo, idhi, g) do { _Pragma("unroll") for (int i_ = 0; i_ < PG_R; ++i_) { const int k_ = (g) * PG_R + i_; \
        const int e_ = __builtin_amdgcn_readlane(k_ < 64 ? idlo : idhi, k_ & 63); const unsigned char* rp_ = (tab) + (size_t)(unsigned)e_ * 2048u; \
        buf[i_][0] = *(const GAS v4u*)(rp_ + voff); buf[i_][1] = *(const GAS v4u*)(rp_ + voff + 1024); } } while (0)
#define PG_DOT(buf, g) do { float p_[4]; _Pragma("unroll") for (int i_ = 0; i_ < 4; ++i_) { f32x2 a_ = {0.f, 0.f}; dot16_fp8(a_, buf[i_][0], &x[0]); dot16_fp8(a_, buf[i_][1], &x[8]); p_[i_] = a_.x + a_.y; __builtin_amdgcn_sched_barrier(0); } \
        float r_[2]; _Pragma("unroll") for (int i_ = 0; i_ < 2; ++i_) { const float keep_ = b5 ? p_[i_ + 2] : p_[i_], send_ = b5 ? p_[i_] : p_[i_ + 2]; r_[i_] = keep_ + shx(send_, 32, lane); } \
        float s_; { const float keep_ = b4 ? r_[1] : r_[0], send_ = b4 ? r_[0] : r_[1]; s_ = keep_ + shx(send_, 16, lane); } \
        s_ += shx(s_, 8, lane); s_ += shx(s_, 4, lane); s_ += shx(s_, 2, lane); s_ += shx(s_, 1, lane); \
        if ((lane & 15) == 0) wl[(g) * 4 + (lane >> 4)] = s_; } while (0)
#define PG_AXPY(buf, g) do { _Pragma("unroll") for (int i_ = 0; i_ < PG_R; ++i_) { const float w_ = wl[(g) * PG_R + i_]; const f32x2 wv_ = {w_, w_}; axpy16_fp8(&y[0], wv_, buf[i_][0]); axpy16_fp8(&y[8], wv_, buf[i_][1]); __builtin_amdgcn_sched_barrier(0); } } while (0)
__device__ __forceinline__ void peer_gather8(const bf16* XN, const unsigned char* PU8, const unsigned char* PV8, const int* PIDX, const float* PGATE, float* X, LAS float* wl, int gw, int NGW, int lane) {
    const bool b5 = (lane >> 5) & 1, b4 = (lane >> 4) & 1; const unsigned voff = 16u * (unsigned)lane;
    for (int t = gw; t < T; t += NGW) {
        const unsigned l4 = 4u * (unsigned)lane; const char* pidx_t = (const char*)(PIDX + (size_t)t * 128); const char* pgate_t = (const char*)(PGATE + (size_t)t * 128);
        const int idlo = *(const GAS int*)(pidx_t + l4), idhi = *(const GAS int*)(pidx_t + l4 + 256);
        v4u A[PG_R][2], B[PG_R][2];
        PG_LOAD(A, PU8, idlo, idhi, 0);
        f32x2 x[16];
        {   const char* xr = (const char*)(XN + (size_t)t * DM); const unsigned l32 = 32u * (unsigned)lane;
            const v4u a0 = *(const GAS v4u*)(xr + l32), a1 = *(const GAS v4u*)(xr + l32 + 16), c0 = *(const GAS v4u*)(xr + l32 + 2048), c1 = *(const GAS v4u*)(xr + l32 + 2064);
#pragma unroll
            for (int c = 0; c < 4; ++c) { x[c] = (f32x2){bflo(a0[c]), bfhi(a0[c])} * (1.f / PU_SCALE); x[4 + c] = (f32x2){bflo(a1[c]), bfhi(a1[c])} * (1.f / PU_SCALE);
                                          x[8 + c] = (f32x2){bflo(c0[c]), bfhi(c0[c])} * (1.f / PU_SCALE); x[12 + c] = (f32x2){bflo(c1[c]), bfhi(c1[c])} * (1.f / PU_SCALE); } }
#pragma unroll 1
        for (int g = 0; g < 128 / PG_R; g += 2) {
            PG_LOAD(B, PU8, idlo, idhi, g + 1);
            PG_DOT(A, g);
            if (g + 2 < 128 / PG_R) PG_LOAD(A, PU8, idlo, idhi, g + 2); else PG_LOAD(A, PV8, idlo, idhi, 0);
            PG_DOT(B, g + 1);
        }
        LDS_WAIT();
        {
            const float g0 = *(const GAS float*)(pgate_t + l4), g1 = *(const GAS float*)(pgate_t + l4 + 256);
            const float d0 = wl[lane], d1 = wl[64 + lane];
            const float w0 = g0 * 0.5f * d0 * (1.f + erff(d0 * 0.70710678118654752f)) * (1.f / PV_SCALE), w1 = g1 * 0.5f * d1 * (1.f + erff(d1 * 0.70710678118654752f)) * (1.f / PV_SCALE);
            LDS_WAIT(); asm volatile("" ::: "memory");
            wl[lane] = w0; wl[64 + lane] = w1;
            LDS_WAIT(); asm volatile("" ::: "memory");
        }
        f32x2 y[16];
#pragma unroll
        for (int i = 0; i < 16; ++i) y[i] = (f32x2){0.f, 0.f};
#pragma unroll 1
        for (int g = 0; g < 128 / PG_R; g += 2) {
            PG_LOAD(B, PV8, idlo, idhi, g + 1);
            PG_AXPY(A, g);
            if (g + 2 < 128 / PG_R) PG_LOAD(A, PV8, idlo, idhi, g + 2);
            PG_AXPY(B, g + 1);
        }
        {   char* xo = (char*)(X + (size_t)t * DM); const unsigned l64 = 64u * (unsigned)lane;
#pragma unroll
            for (int h = 0; h < 2; ++h)
#pragma unroll
                for (int c = 0; c < 4; ++c) { GAS f32x4* p = (GAS f32x4*)(xo + l64 + 4096 * h + 16 * c); f32x4 v = *p; v += (f32x4){y[8 * h + 2 * c].x, y[8 * h + 2 * c].y, y[8 * h + 2 * c + 1].x, y[8 * h + 2 * c + 1].y}; *p = v; } }
        LDS_WAIT(); asm volatile("" ::: "memory");
    }
}


typedef unsigned v6u __attribute__((ext_vector_type(6)));
typedef float v32f __attribute__((ext_vector_type(32)));
typedef v4u __attribute__((aligned(8))) v4u_a8;
constexpr float PU_SCALE6 = 90.0f, PV_SCALE6 = 5.65f;
__device__ __forceinline__ unsigned enc_e2m3(float v) {
    const float a = fminf(fabsf(v), 7.5f);
    unsigned code;
    if (a < 1.0f) code = (unsigned)__builtin_rintf(a * 8.f);
    else { const unsigned b = __builtin_bit_cast(unsigned, a) - 0x3F800000u; code = ((b + 0x7FFFFu + ((b >> 20) & 1u)) >> 20) + 8u; }
    return code | (v < 0.f ? 32u : 0u);
}
__device__ __forceinline__ void convert_fp6_rows(const float* src, unsigned char* dst, int nrows, float scale, const float* gain, int gw, int NGW, int lane) {
    for (int r = gw; r < nrows; r += NGW) {
        const float* sp = src + (size_t)r * DM + 4 * lane; const float* gp = gain ? gain + (size_t)(r / PEER_N) * DM + 4 * lane : nullptr;
        unsigned w[6] = {0u, 0u, 0u, 0u, 0u, 0u};
#pragma unroll
        for (int j = 0; j < 8; ++j) { f32x4 a = *(const GAS f32x4*)(sp + 256 * j) * scale; if (gp) a = a * *(const GAS f32x4*)(gp + 256 * j);
#pragma unroll
            for (int e = 0; e < 4; ++e) { const unsigned code = enc_e2m3(a[e]); const int bp = 6 * (4 * j + e), wi = bp >> 5, sh = bp & 31;
                w[wi] |= code << sh; if (sh > 26) w[wi + 1] |= code >> (32 - sh); } }
        unsigned char* dp = dst + (size_t)r * 1536 + 24 * lane;
        *(GAS v4u_a8*)dp = (v4u){w[0], w[1], w[2], w[3]}; *(GAS v2u*)(dp + 16) = (v2u){w[4], w[5]};
    }
}
#ifndef PG6_R
#define PG6_R 8
#endif
#define PG6_LOAD(buf, tab, idlo, idhi, g) do { _Pragma("unroll") for (int i_ = 0; i_ < PG6_R; ++i_) { const int k_ = (g) * PG6_R + i_; \
        const int e_ = __builtin_amdgcn_readlane(k_ < 64 ? idlo : idhi, k_ & 63); const unsigned char* rp_ = (tab) + (size_t)(unsigned)e_ * 1536u; \
        const v4u a_ = *(const GAS v4u_a8*)(rp_ + voff); const v2u b_ = *(const GAS v2u*)(rp_ + voff + 16); buf[i_] = (v6u){a_.x, a_.y, a_.z, a_.w, b_.x, b_.y}; } } while (0)
#define PG6_DOT1(buf, i_, dst) do { const v32f f_ = __builtin_amdgcn_cvt_scalef32_pk32_f32_fp6(buf[i_], 1.0f); f32x2 a_ = {0.f, 0.f}; \
        _Pragma("unroll") for (int c_ = 0; c_ < 16; ++c_) a_ += (f32x2){f_[2 * c_], f_[2 * c_ + 1]} * x[c_]; dst = a_.x + a_.y; __builtin_amdgcn_sched_barrier(0); } while (0)
#if PG6_R == 8
#define PG6_DOT(buf, g) do { float p_[8]; _Pragma("unroll") for (int i_ = 0; i_ < 8; ++i_) PG6_DOT1(buf, i_, p_[i_]); \
        float q_[4]; _Pragma("unroll") for (int i_ = 0; i_ < 4; ++i_) { const float keep_ = b5 ? p_[i_ + 4] : p_[i_], send_ = b5 ? p_[i_] : p_[i_ + 4]; q_[i_] = keep_ + shx(send_, 32, lane); } \
        float r_[2]; _Pragma("unroll") for (int i_ = 0; i_ < 2; ++i_) { const float keep_ = b4 ? q_[i_ + 2] : q_[i_], send_ = b4 ? q_[i_] : q_[i_ + 2]; r_[i_] = keep_ + shx(send_, 16, lane); } \
        float s_; { const float keep_ = b3 ? r_[1] : r_[0], send_ = b3 ? r_[0] : r_[1]; s_ = keep_ + shx(send_, 8, lane); } \
        s_ += shx(s_, 4, lane); s_ += shx(s_, 2, lane); s_ += shx(s_, 1, lane); \
        if ((lane & 7) == 0) wl[(g) * 8 + (lane >> 3)] = s_; } while (0)
#else
#define PG6_DOT(buf, g) do { float p_[4]; _Pragma("unroll") for (int i_ = 0; i_ < 4; ++i_) PG6_DOT1(buf, i_, p_[i_]); \
        float r_[2]; _Pragma("unroll") for (int i_ = 0; i_ < 2; ++i_) { const float keep_ = b5 ? p_[i_ + 2] : p_[i_], send_ = b5 ? p_[i_] : p_[i_ + 2]; r_[i_] = keep_ + shx(send_, 32, lane); } \
        float s_; { const float keep_ = b4 ? r_[1] : r_[0], send_ = b4 ? r_[0] : r_[1]; s_ = keep_ + shx(send_, 16, lane); } \
        s_ += shx(s_, 8, lane); s_ += shx(s_, 4, lane); s_ += shx(s_, 2, lane); s_ += shx(s_, 1, lane); \
        if ((lane & 15) == 0) wl[(g) * 4 + (lane >> 4)] = s_; } while (0)
#endif
#define PG6_AXPY(buf, g) do { _Pragma("unroll") for (int i_ = 0; i_ < PG6_R; ++i_) { const float w_ = wl[(g) * PG6_R + i_]; const f32x2 wv_ = {w_, w_}; \
        const v32f f_ = __builtin_amdgcn_cvt_scalef32_pk32_f32_fp6(buf[i_], 1.0f); _Pragma("unroll") for (int c_ = 0; c_ < 16; ++c_) y[c_] += (f32x2){f_[2 * c_], f_[2 * c_ + 1]} * wv_; __builtin_amdgcn_sched_barrier(0); } } while (0)
__device__ __forceinline__ void peer_gather6(bf16* XN, const unsigned char* PU6, const unsigned char* PV6, const int* PIDX, const float* PGATE, float* X, const u64_t* rowsq_in, u64_t* rowsq_out, LAS float* wl, int gw, int NGW, int lane) {
    const bool b5 = (lane >> 5) & 1, b4 = (lane >> 4) & 1, b3 = (lane >> 3) & 1; (void)b3;
    const unsigned voff = 24u * (unsigned)lane, l4 = 4u * (unsigned)lane, l8 = 8u * (unsigned)lane, l16 = 16u * (unsigned)lane;
    constexpr int NG = 128 / PG6_R;
    for (int t = gw; t < T; t += NGW) {
        const char* pidx_t = (const char*)(PIDX + (size_t)t * 128); const char* pgate_t = (const char*)(PGATE + (size_t)t * 128);
        const int idlo = *(const GAS int*)(pidx_t + l4), idhi = *(const GAS int*)(pidx_t + l4 + 256);
        v6u A[PG6_R], B[PG6_R];
        PG6_LOAD(A, PU6, idlo, idhi, 0);
        f32x2 x[16];
        {   const char* xr = (const char*)(XN + (size_t)t * DM); const float xs = (1.f / PU_SCALE6) * rowsq_rs(rowsq_in, t);
#pragma unroll
            for (int j = 0; j < 8; ++j) { const v2u a = *(const GAS v2u*)(xr + l8 + 512 * j); x[2 * j] = (f32x2){bflo(a.x), bfhi(a.x)} * xs; x[2 * j + 1] = (f32x2){bflo(a.y), bfhi(a.y)} * xs; } }
#pragma unroll 1
        for (int g = 0; g < NG; g += 2) {
            PG6_LOAD(B, PU6, idlo, idhi, g + 1);
            PG6_DOT(A, g);
            if (g + 2 < NG) PG6_LOAD(A, PU6, idlo, idhi, g + 2); else PG6_LOAD(A, PV6, idlo, idhi, 0);
            PG6_DOT(B, g + 1);
        }
        LDS_WAIT();
        {   const float g0 = *(const GAS float*)(pgate_t + l4), g1 = *(const GAS float*)(pgate_t + l4 + 256);
            const float d0 = wl[lane], d1 = wl[64 + lane];
            const float w0 = g0 * 0.5f * d0 * (1.f + erff(d0 * 0.70710678118654752f)) * (1.f / PV_SCALE6), w1 = g1 * 0.5f * d1 * (1.f + erff(d1 * 0.70710678118654752f)) * (1.f / PV_SCALE6);
            LDS_WAIT(); asm volatile("" ::: "memory");
            wl[lane] = w0; wl[64 + lane] = w1;
            LDS_WAIT(); asm volatile("" ::: "memory");
        }
        f32x2 y[16];
#pragma unroll
        for (int i = 0; i < 16; ++i) y[i] = (f32x2){0.f, 0.f};
#pragma unroll 1
        for (int g = 0; g < NG; g += 2) {
            PG6_LOAD(B, PV6, idlo, idhi, g + 1);
            PG6_AXPY(A, g);
            if (g + 2 < NG) PG6_LOAD(A, PV6, idlo, idhi, g + 2);
            PG6_AXPY(B, g + 1);
        }
        {   char* xo = (char*)(X + (size_t)t * DM);
            char* xbo = (char*)(XN + (size_t)t * DM); float ss = 0.f;
#pragma unroll
            for (int j = 0; j < 8; ++j) { const v2u a = *(const GAS v2u*)(xbo + l8 + 512 * j); f32x4 v = (f32x4){bflo(a.x), bfhi(a.x), bflo(a.y), bfhi(a.y)}; v += (f32x4){y[2 * j].x, y[2 * j].y, y[2 * j + 1].x, y[2 * j + 1].y};
                if (X) *(GAS f32x4*)(xo + l16 + 1024 * j) = v;
                ss += (v[0] * v[0] + v[1] * v[1]) + (v[2] * v[2] + v[3] * v[3]); *(GAS v2u*)(xbo + l8 + 512 * j) = (v2u){pk2(v[0], v[1]), pk2(v[2], v[3])}; }
            if (rowsq_out) { ss = wave_sum(ss, lane); if (lane == 0) rowsq_out[t] = rowsq_fx(ss); } }
        LDS_WAIT(); asm volatile("" ::: "memory");
    }
}

typedef short s16x4 __attribute__((ext_vector_type(4)));
typedef __attribute__((address_space(3))) const char* lds_cptr;
__device__ __forceinline__ s16x4 vtr(lds_cptr p) { return __builtin_bit_cast(s16x4, __builtin_amdgcn_ds_read_tr16_b64_v4i16((__attribute__((address_space(3))) s16x4*)p)); }
__device__ __forceinline__ unsigned cvtpk(float lo, float hi) { unsigned r; asm("v_cvt_pk_bf16_f32 %0, %1, %2" : "=v"(r) : "v"(lo), "v"(hi)); return r; }
constexpr int AT_K0 = 0, AT_V0 = 16384, AT_TAB = 32768;
constexpr float LOG2E = 1.4426950408889634f;
template <int TYPE>
__device__ __forceinline__ void attn_unit(LAS unsigned char* lds, const bf16* QKV, bf16* ATT, int b, int head, int qb, const float* tabsrc, float Cl2, float sinkl2, int tid) {
    const int lane = tid & 63, w = __builtin_amdgcn_readfirstlane(tid >> 6), hh = lane >> 5, l31 = lane & 31;
    int qcol, kcol, vcol, ocol;
    if (TYPE == 0) { qcol = QA + head * 64; kcol = KA + (head / 3) * 64; vcol = VA + (head / 3) * 64; ocol = OA + head * 64; }
    else if (TYPE == 1) { qcol = QB + head * 64; kcol = KB + head * 64; vcol = VB + head * 64; ocol = OB + head * 64; }
    else { qcol = QC + head * 64; kcol = KC + (head / 3) * 64; vcol = VC + (head / 3) * 64; ocol = OC + head * 64; }
    const int q0 = 256 * qb + 32 * w, qpos = q0 + l31;
    int t_begin, t_end;
    if (TYPE == 0) { t_begin = 4 * qb - 2; if (t_begin < 0) t_begin = 0; t_end = 4 * qb + 6; if (t_end > 32) t_end = 32; }
    else if (TYPE == 1) { int a = 4 * qb - 4; a = a < 0 ? 0 : (a > 24 ? 24 : a); int e = 4 * qb - 1; e = e < 0 ? 0 : (e > 24 ? 24 : e); t_begin = a; t_end = e + 8; }
    else { t_begin = 0; t_end = 32; }
    LAS float* tab = (LAS float*)(lds + AT_TAB);
    if (TYPE == 0) { for (int i = tid; i < 1024; i += NTHREADS) { const int rel = i - 448; tab[i] = (rel >= -128 && rel <= 128) ? tabsrc[head * 257 + rel + 128] * LOG2E - Cl2 : -1e30f; } }
    if (TYPE == 1) { for (int i = tid; i < 15 * 31; i += NTHREADS) tab[i] = tabsrc[head * 465 + i] * LOG2E - Cl2; }
    bf16x8 qf[4];
    {   const bf16* qp = QKV + ((size_t)b * SEQ + qpos) * DIN + qcol + 8 * hh;
#pragma unroll
        for (int s = 0; s < 4; ++s) qf[s] = *(const GAS bf16x8*)(qp + 16 * s); }
    const int srow = tid >> 3, sch = tid & 7;
    const bf16* kg = QKV + ((size_t)b * SEQ + srow) * DIN + kcol + sch * 8;
    const bf16* vg = QKV + ((size_t)b * SEQ + srow) * DIN + vcol + sch * 8;
    const int kst = srow * 128 + ((sch ^ ((srow >> 1) & 7)) * 16);
    const int vst = srow * 128 + (((sch >> 2) ^ ((srow >> 1) & 1)) * 64) + (sch & 3) * 16;
    int kread[4], vread[2];
#pragma unroll
    for (int s = 0; s < 4; ++s) kread[s] = l31 * 128 + (((2 * s + hh) ^ ((lane >> 1) & 7)) * 16);
#pragma unroll
    for (int db = 0; db < 2; ++db) vread[db] = (4 * hh + ((lane >> 2) & 3)) * 128 + ((db ^ ((lane >> 3) & 1)) * 64) + 32 * ((lane >> 4) & 1) + 8 * (lane & 3);
    f32x16 O0, O1;
#pragma unroll
    for (int r = 0; r < 16; ++r) { O0[r] = 0.f; O1[r] = 0.f; }
    float lsum = 0.f;
    const int rw = 4 * qb + (w >> 1), cq = 32 * (w & 1) + l31;
    int r0w = rw - 4; r0w = r0w < 0 ? 0 : (r0w > 24 ? 24 : r0w);
    int c0 = cq - 8; c0 = c0 < 0 ? 0 : (c0 > 48 ? 48 : c0);
    {   const v4u kr = *(const GAS v4u*)(kg + (size_t)t_begin * 64 * DIN), vr = *(const GAS v4u*)(vg + (size_t)t_begin * 64 * DIN);
        *(LAS v4u*)(lds + AT_K0 + kst) = kr; *(LAS v4u*)(lds + AT_V0 + vst) = vr; }
    __syncthreads();
    for (int t = t_begin; t < t_end; ++t) {
        const int cur = (t - t_begin) & 1;
        v4u kr, vr;
        if (t + 1 < t_end) { kr = *(const GAS v4u*)(kg + (size_t)(t + 1) * 64 * DIN); vr = *(const GAS v4u*)(vg + (size_t)(t + 1) * 64 * DIN); }
        bool need = true;
        if (TYPE == 0) need = (64 * t <= q0 + 31 + 128) && (64 * t + 63 >= q0 - 128);
        if (TYPE == 1) need = (t >= r0w) && (t < r0w + 8);
        if (need) {
            const lds_cptr kb_ = (lds_cptr)(lds + AT_K0 + cur * 8192), vb_ = (lds_cptr)(lds + AT_V0 + cur * 8192);
            f32x16 S0, S1;
#pragma unroll
            for (int r = 0; r < 16; ++r) { S0[r] = 0.f; S1[r] = 0.f; }
#pragma unroll
            for (int s = 0; s < 4; ++s) { const bf16x8 k0 = *(const LAS bf16x8*)(kb_ + kread[s]), k1 = *(const LAS bf16x8*)(kb_ + kread[s] + 4096);
                S0 = __builtin_amdgcn_mfma_f32_32x32x16_bf16(k0, qf[s], S0, 0, 0, 0); S1 = __builtin_amdgcn_mfma_f32_32x32x16_bf16(k1, qf[s], S1, 0, 0, 0); }
            if (TYPE == 2) {
#pragma unroll
                for (int r = 0; r < 16; ++r) { S0[r] = __builtin_amdgcn_exp2f(S0[r] * LOG2E - Cl2); S1[r] = __builtin_amdgcn_exp2f(S1[r] * LOG2E - Cl2); }
            } else if (TYPE == 0) {
                const LAS float* tb = tab + (64 * t - qpos + 448 + 4 * hh);
#pragma unroll
                for (int r = 0; r < 16; ++r) { S0[r] = __builtin_amdgcn_exp2f(S0[r] * LOG2E + tb[8 * (r >> 2) + (r & 3)]); S1[r] = __builtin_amdgcn_exp2f(S1[r] * LOG2E + tb[32 + 8 * (r >> 2) + (r & 3)]); }
            } else {
                const LAS float* tb = tab + ((t - rw + 7) * 31 - cq + 15 + 4 * hh);
                const int kc0 = 4 * hh - c0;
#pragma unroll
                for (int r = 0; r < 16; ++r) { const int ka = 8 * (r >> 2) + (r & 3), kb2 = 32 + ka;
                    const float p0 = __builtin_amdgcn_exp2f(S0[r] * LOG2E + tb[ka]), p1 = __builtin_amdgcn_exp2f(S1[r] * LOG2E + tb[kb2]);
                    S0[r] = ((unsigned)(ka + kc0) < 16u) ? p0 : 0.f; S1[r] = ((unsigned)(kb2 + kc0) < 16u) ? p1 : 0.f; }
            }
#pragma unroll
            for (int r = 0; r < 16; ++r) lsum += S0[r] + S1[r];
            bf16x8 pb[4];
#pragma unroll
            for (int hf = 0; hf < 2; ++hf) {
                v4u a, c;
#pragma unroll
                for (int j = 0; j < 4; ++j) { a[j] = cvtpk(S0[8 * hf + 2 * j], S0[8 * hf + 2 * j + 1]); c[j] = cvtpk(S1[8 * hf + 2 * j], S1[8 * hf + 2 * j + 1]); }
                pb[hf] = __builtin_bit_cast(bf16x8, a); pb[2 + hf] = __builtin_bit_cast(bf16x8, c);
            }
#pragma unroll
            for (int ks = 0; ks < 4; ++ks) {
                const s16x4 a0 = vtr(vb_ + vread[0] + (16 * ks) * 128), a1 = vtr(vb_ + vread[0] + (16 * ks + 8) * 128);
                const s16x4 b0 = vtr(vb_ + vread[1] + (16 * ks) * 128), b1 = vtr(vb_ + vread[1] + (16 * ks + 8) * 128);
                const bf16x8 va = __builtin_shufflevector(a0, a1, 0, 1, 2, 3, 4, 5, 6, 7), vb2 = __builtin_shufflevector(b0, b1, 0, 1, 2, 3, 4, 5, 6, 7);
                O0 = __builtin_amdgcn_mfma_f32_32x32x16_bf16(va, pb[ks], O0, 0, 0, 0); O1 = __builtin_amdgcn_mfma_f32_32x32x16_bf16(vb2, pb[ks], O1, 0, 0, 0);
            }
        }
        if (t + 1 < t_end) { *(LAS v4u*)(lds + AT_K0 + (cur ^ 1) * 8192 + kst) = kr; *(LAS v4u*)(lds + AT_V0 + (cur ^ 1) * 8192 + vst) = vr; }
        __syncthreads();
    }
    lsum += shx(lsum, 32, lane);
    if (TYPE == 0) lsum += __builtin_amdgcn_exp2f(sinkl2 - Cl2);
    const float inv = 1.f / lsum;
    bf16* op = ATT + ((size_t)b * SEQ + qpos) * DM + ocol + 4 * hh;
#pragma unroll
    for (int g4 = 0; g4 < 4; ++g4) {
        v2u o0, o1; o0.x = cvtpk(O0[4 * g4] * inv, O0[4 * g4 + 1] * inv); o0.y = cvtpk(O0[4 * g4 + 2] * inv, O0[4 * g4 + 3] * inv);
        o1.x = cvtpk(O1[4 * g4] * inv, O1[4 * g4 + 1] * inv); o1.y = cvtpk(O1[4 * g4 + 2] * inv, O1[4 * g4 + 3] * inv);
        *(GAS v2u*)(op + 8 * g4) = o0; *(GAS v2u*)(op + 32 + 8 * g4) = o1;
    }
}


constexpr int MA_K0 = 0, MA_V0 = 32768;
__device__ __forceinline__ void mem_unit(LAS unsigned char* lds, const bf16* QM, const bf16* KVM, bf16* OM, const float* gq, int tb, int head, float Cl2, int tid) {
    const int lane = tid & 63, w = __builtin_amdgcn_readfirstlane(tid >> 6), hh = lane >> 5, l31 = lane & 31;
    const size_t trow = (size_t)tb * 256 + 32 * w + l31; const int b = tb >> 3;
    bf16x8 qf[8];
    {   const bf16* qp = QM + trow * MEMW + head * 128 + 8 * hh;
#pragma unroll
        for (int s = 0; s < 8; ++s) qf[s] = *(const GAS bf16x8*)(qp + 16 * s);
        float ss = 0.f;
#pragma unroll
        for (int s = 0; s < 8; ++s)
#pragma unroll
            for (int j = 0; j < 8; ++j) { const float f = __builtin_bit_cast(float, (unsigned)(unsigned short)qf[s][j] << 16); ss += f * f; }
        ss += shx(ss, 32, lane);
        const float r = 0.08838834764831845f / sqrtf(ss * (1.f / 128.f) + EPS);
#pragma unroll
        for (int s = 0; s < 8; ++s) { const f32x4 g0 = *(const GAS f32x4*)(gq + 16 * s + 8 * hh), g1 = *(const GAS f32x4*)(gq + 16 * s + 8 * hh + 4);
            v4u o;
#pragma unroll
            for (int j = 0; j < 4; ++j) { const float f0 = __builtin_bit_cast(float, (unsigned)(unsigned short)qf[s][2 * j] << 16), f1 = __builtin_bit_cast(float, (unsigned)(unsigned short)qf[s][2 * j + 1] << 16);
                const float ga = (2 * j < 4) ? g0[2 * j] : g1[2 * j - 4], gb2 = (2 * j + 1 < 4) ? g0[2 * j + 1] : g1[2 * j + 1 - 4];
                o[j] = cvtpk(f0 * r * ga, f1 * r * gb2); }
            qf[s] = __builtin_bit_cast(bf16x8, o); }
    }
    const int srow = tid >> 3, sch = tid & 7;
    const bf16* kg = KVM + ((size_t)b * NMEM + srow) * 1024 + head * 128 + sch * 8;
    const bf16* vg = kg + 512;
    const int kst0 = srow * 256 + ((sch ^ (srow & 15)) * 16), kst1 = srow * 256 + (((sch + 8) ^ (srow & 15)) * 16);
    const int vst0 = srow * 256 + ((((sch) >> 2) ^ (srow & 3)) * 64) + (sch & 3) * 16, vst1 = srow * 256 + ((((sch + 8) >> 2) ^ (srow & 3)) * 64) + (sch & 3) * 16;
    int kread[8], vread[4];
#pragma unroll
    for (int s = 0; s < 8; ++s) kread[s] = l31 * 256 + (((2 * s + hh) ^ (l31 & 15)) * 16);
#pragma unroll
    for (int db = 0; db < 4; ++db) vread[db] = (4 * hh + ((lane >> 2) & 3)) * 256 + ((db ^ ((lane >> 2) & 3)) * 64) + 32 * ((lane >> 4) & 1) + 8 * (lane & 3);
    f32x16 O[4];
#pragma unroll
    for (int db = 0; db < 4; ++db)
#pragma unroll
        for (int r = 0; r < 16; ++r) O[db][r] = 0.f;
    float lsum = 0.f;
    {   const v4u k0 = *(const GAS v4u*)kg, k1 = *(const GAS v4u*)(kg + 64), v0 = *(const GAS v4u*)vg, v1 = *(const GAS v4u*)(vg + 64);
        *(LAS v4u*)(lds + MA_K0 + kst0) = k0; *(LAS v4u*)(lds + MA_K0 + kst1) = k1; *(LAS v4u*)(lds + MA_V0 + vst0) = v0; *(LAS v4u*)(lds + MA_V0 + vst1) = v1; }
    __syncthreads();
#pragma unroll 1
    for (int t = 0; t < 4; ++t) {
        const int cur = t & 1;
        v4u k0, k1, v0, v1;
        if (t + 1 < 4) { const bf16* kn = kg + (size_t)(t + 1) * 64 * 1024; k0 = *(const GAS v4u*)kn; k1 = *(const GAS v4u*)(kn + 64); v0 = *(const GAS v4u*)(kn + 512); v1 = *(const GAS v4u*)(kn + 576); }
        const lds_cptr kb_ = (lds_cptr)(lds + MA_K0 + cur * 16384), vb_ = (lds_cptr)(lds + MA_V0 + cur * 16384);
        f32x16 S0, S1;
#pragma unroll
        for (int r = 0; r < 16; ++r) { S0[r] = 0.f; S1[r] = 0.f; }
#pragma unroll
        for (int s = 0; s < 8; ++s) { const bf16x8 a0 = *(const LAS bf16x8*)(kb_ + kread[s]), a1 = *(const LAS bf16x8*)(kb_ + kread[s] + 8192);
            S0 = __builtin_amdgcn_mfma_f32_32x32x16_bf16(a0, qf[s], S0, 0, 0, 0); S1 = __builtin_amdgcn_mfma_f32_32x32x16_bf16(a1, qf[s], S1, 0, 0, 0); }
#pragma unroll
        for (int r = 0; r < 16; ++r) { S0[r] = __builtin_amdgcn_exp2f(S0[r] * LOG2E - Cl2); S1[r] = __builtin_amdgcn_exp2f(S1[r] * LOG2E - Cl2); lsum += S0[r] + S1[r]; }
        bf16x8 pb[4];
#pragma unroll
        for (int hf = 0; hf < 2; ++hf) {
            v4u a, c;
#pragma unroll
            for (int j = 0; j < 4; ++j) { a[j] = cvtpk(S0[8 * hf + 2 * j], S0[8 * hf + 2 * j + 1]); c[j] = cvtpk(S1[8 * hf + 2 * j], S1[8 * hf + 2 * j + 1]); }
            pb[hf] = __builtin_bit_cast(bf16x8, a); pb[2 + hf] = __builtin_bit_cast(bf16x8, c);
        }
#pragma unroll
        for (int ks = 0; ks < 4; ++ks)
#pragma unroll
            for (int db = 0; db < 4; ++db) {
                const s16x4 a0 = vtr(vb_ + vread[db] + (16 * ks) * 256), a1 = vtr(vb_ + vread[db] + (16 * ks + 8) * 256);
                const bf16x8 va = __builtin_shufflevector(a0, a1, 0, 1, 2, 3, 4, 5, 6, 7);
                O[db] = __builtin_amdgcn_mfma_f32_32x32x16_bf16(va, pb[ks], O[db], 0, 0, 0);
            }
        if (t + 1 < 4) { LAS unsigned char* kn = lds + MA_K0 + (cur ^ 1) * 16384; LAS unsigned char* vn = lds + MA_V0 + (cur ^ 1) * 16384;
            *(LAS v4u*)(kn + kst0) = k0; *(LAS v4u*)(kn + kst1) = k1; *(LAS v4u*)(vn + vst0) = v0; *(LAS v4u*)(vn + vst1) = v1; }
        __syncthreads();
    }
    lsum += shx(lsum, 32, lane);
    const float inv = 1.f / lsum;
    bf16* op = OM + trow * MEMW + head * 128 + 4 * hh;
#pragma unroll
    for (int db = 0; db < 4; ++db)
#pragma unroll
        for (int g4 = 0; g4 < 4; ++g4) { v2u o; o.x = cvtpk(O[db][4 * g4] * inv, O[db][4 * g4 + 1] * inv); o.y = cvtpk(O[db][4 * g4 + 2] * inv, O[db][4 * g4 + 3] * inv); *(GAS v2u*)(op + 32 * db + 8 * g4) = o; }
}

__device__ __forceinline__ float wave_max(float v, int lane) {
#pragma unroll
    for (int o = 1; o < 64; o <<= 1) v = fmaxf(v, shx(v, o, lane));
    return v;
}
struct Args { const float* in[23]; float* out; unsigned char* ws; int ph_lo, ph_hi, use_bar, pad; };
#ifndef MK_OFF
#define MK_OFF 0u
#endif
#ifndef REP_ATT
#define REP_ATT 1
#endif
#ifndef REP_GEMM
#define REP_GEMM 1
#endif
#ifndef REP_NORM
#define REP_NORM 1
#endif
#ifndef REP_SEL
#define REP_SEL 1
#endif
#ifndef REP_MEM
#define REP_MEM 1
#endif
#define PHON(k) (!((MK_OFF >> (k)) & 1u))
constexpr int PH_PER_LAYER = 10, PH_BASE = 3, N_PHASES = PH_BASE + DEPTH * PH_PER_LAYER;
constexpr int PTAB_OFF = LDSCTL_OFF + 1024;

__global__ void __launch_bounds__(NTHREADS, 2) mega(Args a) {
    extern __shared__ __attribute__((aligned(16))) unsigned char lds_raw[];
    LAS unsigned char* lds = (LAS unsigned char*)lds_raw;
    {   const int tid0 = threadIdx.x;
        for (int u = tid0; u < (LDS_BYTES - LDSCTL_OFF) / 4; u += NTHREADS) ((LAS unsigned*)(lds + LDSCTL_OFF))[u] = 0u;
        __syncthreads();
        if (tid0 < 23) ((LAS unsigned long long*)(lds + PTAB_OFF))[tid0] = (unsigned long long)a.in[tid0];
        if (tid0 == 23) ((LAS unsigned long long*)(lds + PTAB_OFF))[23] = (unsigned long long)a.out;
        if (tid0 == 24) ((LAS unsigned long long*)(lds + PTAB_OFF))[24] = (unsigned long long)a.ws;
        __syncthreads();
    }
    volatile LAS unsigned* MISC = (volatile LAS unsigned*)(lds + MISC_OFF);
    const int G = gridDim.x, bid = blockIdx.x, NGW = G * NWAVES;
    const int use_bar = a.use_bar;
    XcdBarrier bar; bar.bar = (unsigned*)(a.ws + WS_CTL) + CW_BAR; bar.x = 0; bar.st = MISC + 8;
    if (use_bar) bar = xcd_barrier_post((unsigned*)(a.ws + WS_CTL) + CW_BAR, MISC + 8);
    const int lo = a.ph_lo, hi = a.ph_hi;
#define IN(k) (lo <= (k) && (k) < hi)
#define SEAM(k) do { if (use_bar && IN(k) && IN((k) + 1)) xcd_barrier(bar); } while (0)
#define PHL() int tid_ = threadIdx.x; asm volatile("" : "+v"(tid_)); const int lane_ = tid_ & 63, wave_ = __builtin_amdgcn_readfirstlane(tid_ >> 6), gw_ = bid * NWAVES + wave_; (void)lane_; (void)gw_; \
              int pz_ = 0; asm volatile("" : "+s"(pz_))
#define PTR(i) ((const float*)ldptr(lds, (i) + pz_))
#define WSP() ((unsigned char*)ldptr(lds, 24 + pz_))
#define OUTP() ((float*)ldptr(lds, 23 + pz_))

    if (IN(0) && PHON(0)) {
        PHL(); unsigned char* ws = WSP();
        LAS float* scr = (LAS float*)(lds + RING_OFF + wave_ * 16384);
        constexpr int I_IN = 32 * 128, I_OUT = 32 * 64, I_MQ = 32 * 16, I_MKV = 32 * 32, I_MO = 8 * 64, I_PQ = 32 * 64, I_L = I_IN + I_OUT + I_MQ + I_MKV + I_MO + I_PQ;
        for (int it = gw_; it < DEPTH * I_L; it += NGW) {
            const int l = it / I_L; int r = it % I_L;
            if (r < I_IN) { transpose_item<true>(PTR(4) + (size_t)l * DM * DIN, DM, DIN, (bf16*)(ws + WS_WIN) + (size_t)l * DIN * DM, scr, r, lane_, PTR(3) + (size_t)l * DM); continue; } r -= I_IN;
            if (r < I_OUT) { transpose_item<false>(PTR(11) + (size_t)l * DM * DM, DM, DM, (bf16*)(ws + WS_WOUT) + (size_t)l * DM * DM, scr, r, lane_); continue; } r -= I_OUT;
            if (r < I_MQ) { transpose_item<false>(PTR(14) + (size_t)l * DM * MEMW, DM, MEMW, (bf16*)(ws + WS_WMQ) + (size_t)l * MEMW * DM, scr, r, lane_, PTR(12) + (size_t)l * DM); continue; } r -= I_MQ;
            if (r < I_MKV) { transpose_item<false>(PTR(15) + (size_t)l * DM * 1024, DM, 1024, (bf16*)(ws + WS_WMKV) + (size_t)l * 1024 * DM, scr, r, lane_); continue; } r -= I_MKV;
            if (r < I_MO) { transpose_item<false>(PTR(17) + (size_t)l * MEMW * DM, MEMW, DM, (bf16*)(ws + WS_WMO) + (size_t)l * DM * MEMW, scr, r, lane_); continue; } r -= I_MO;
            transpose_item<false>(PTR(19) + (size_t)l * DM * DM, DM, DM, (bf16*)(ws + WS_WPQ) + (size_t)l * DM * DM, scr, r, lane_, PTR(18) + (size_t)l * DM);
        }
        const size_t gtid = (size_t)bid * NTHREADS + tid_, nth = (size_t)G * NTHREADS;
        convert_bf16(PTR(20), (bf16*)(ws + WS_PKEYS), (size_t)DEPTH * 8 * 2 * 128 * 128, gtid, nth);
        convert_fp6_rows(PTR(21), ws + WS_PU, DEPTH * PEER_N, PU_SCALE6, PTR(18), gw_, NGW, lane_);
        convert_fp6_rows(PTR(22), ws + WS_PV, DEPTH * PEER_N, PV_SCALE6, nullptr, gw_, NGW, lane_);
        {   const float* x0 = PTR(0); bf16* XN = (bf16*)(ws + WS_XN); u64_t* rsq = (u64_t*)(ws + WS_ROWSQ);
            for (int m = gw_; m < T; m += NGW) prep_row(x0 + (size_t)m * DM, XN + (size_t)m * DM, rsq + m, lane_); }
        {   const float* mem = PTR(1); const float* gkv = PTR(13); bf16* MEMN = (bf16*)(ws + WS_MEMN);
            for (int m = gw_; m < BATCH * NMEM; m += NGW)
                rms_row_to_bf16(mem + (size_t)m * DM, gkv, MEMN + (size_t)m * DM, gkv + DM, MEMN + (size_t)(BATCH * NMEM + m) * DM, lane_); }
        float* rope = (float*)(ws + WS_ROPE); float* biasA = (float*)(ws + WS_BIASA);
        if (gtid < 64 * 16) { const int pos = (int)gtid >> 4, i = (int)gtid & 15; const float ang = (float)pos * ROPE_INV[i]; rope[gtid * 2] = cosf(ang); rope[gtid * 2 + 1] = sinf(ang); }
        if (gtid < 12 * 257) { const int h = (int)gtid / 257, rel = (int)gtid % 257 - 128; biasA[gtid] = PTR(2)[t5_bucket(rel) * 12 + h]; }
    }
    SEAM(0);
    if (IN(1) && PHON(1)) {
#pragma unroll 1
        for (int l = 0; l < DEPTH; ++l) {
            PHL(); unsigned char* ws = WSP();
            pg8::Gemm g{(bf16*)(ws + WS_MEMN) + (size_t)l * BATCH * NMEM * DM, (bf16*)(ws + WS_WMKV) + (size_t)l * 1024 * DM, BATCH * NMEM, 1024, DM};
            OffsetOrder S; S.init(BATCH * NMEM, 1024, G, bid, 64 * l);
            pg8::EpiBf16<0> E{(bf16*)(ws + WS_KVM) + (size_t)l * BATCH * NMEM * 1024, 1024, nullptr, 0, 0, 1.f};
            pg8::gemm_phase<pg8::EpiBf16<0>, OffsetOrder, true, true>(lds + RING_OFF, g, S, E, tid_);
            __syncthreads();
        }
    }
    SEAM(1);
    if (IN(2) && PHON(2)) {
        PHL(); unsigned char* ws = WSP(); bf16* KVM = (bf16*)(ws + WS_KVM); const float* gm = PTR(16);
        for (int m = gw_; m < DEPTH * BATCH * NMEM; m += NGW) {
            const int l = m / (BATCH * NMEM);
            GAS v4u* p = (GAS v4u*)(KVM + (size_t)m * 1024 + 8 * lane_);
            const v4u w = *p;
            float f[8] = {bflo(w.x), bfhi(w.x), bflo(w.y), bfhi(w.y), bflo(w.z), bfhi(w.z), bflo(w.w), bfhi(w.w)};
            float ss = 0.f;
#pragma unroll
            for (int i = 0; i < 8; ++i) ss += f[i] * f[i];
            ss += shx(ss, 1, lane_); ss += shx(ss, 2, lane_); ss += shx(ss, 4, lane_); ss += shx(ss, 8, lane_);
            const float r = 1.f / sqrtf(ss * (1.f / 128.f) + EPS);
            const float* gk = gm + (size_t)l * 256 + 128 + 8 * (lane_ & 15);
            v4u o; o.x = pk2(f[0] * r * gk[0], f[1] * r * gk[1]); o.y = pk2(f[2] * r * gk[2], f[3] * r * gk[3]); o.z = pk2(f[4] * r * gk[4], f[5] * r * gk[5]); o.w = pk2(f[6] * r * gk[6], f[7] * r * gk[7]);
            *p = o;
        }
    }
    SEAM(2);

#pragma unroll 1
    for (int l = 0; l < DEPTH; ++l) {
        const int pb = PH_BASE + PH_PER_LAYER * l;
        if (IN(pb + 0) && PHON(3)) for (int rep_ = 0; rep_ < REP_GEMM; ++rep_) { PHL(); unsigned char* ws = WSP();
            pg8::Gemm g{(bf16*)(ws + WS_XN), (bf16*)(ws + WS_WIN) + (size_t)l * DIN * DM, T, DIN, DM}; pg8::StaticOrder S; S.init(T, DIN, G, bid);
            pg8::EpiQKV E{(bf16*)(ws + WS_QKV), PTR(5) + (size_t)l * 128, PTR(7) + (size_t)l * 128, PTR(9) + (size_t)l * 128, (const float*)(ws + WS_ROPE), (const u64_t*)(ws + WS_ROWSQ) + (size_t)(l * 3 + 0) * T};
            pg8::gemm_phase<pg8::EpiQKV, pg8::StaticOrder, true, true>(lds + RING_OFF, g, S, E, tid_);
        }
        SEAM(pb + 0);
        if (IN(pb + 1) && PHON(4)) for (int rep_ = 0; rep_ < REP_ATT; ++rep_) { PHL(); unsigned char* ws = WSP();
            const float* sink = PTR(6) + (size_t)l * 12; const float* rpb = PTR(8) + (size_t)l * 8 * 15 * 31; const float* biasA = (const float*)(ws + WS_BIASA);
            const bf16* QKV = (const bf16*)(ws + WS_QKV); bf16* ATT = (bf16*)(ws + WS_ATT);
            const float* ga = PTR(5) + (size_t)l * 128; const float* gb = PTR(7) + (size_t)l * 128; const float* gc = PTR(9) + (size_t)l * 128;
            const float CaL2 = 8.f * wave_max(fabsf(ga[lane_]), lane_) * wave_max(fabsf(ga[64 + lane_]), lane_) * LOG2E;
            const float CbL2 = 8.f * wave_max(fabsf(gb[lane_]), lane_) * wave_max(fabsf(gb[64 + lane_]), lane_) * LOG2E;
            const float CcL2 = 8.f * wave_max(fabsf(gc[lane_]), lane_) * wave_max(fabsf(gc[64 + lane_]), lane_) * LOG2E;
            const int vc = (G % 8 == 0) ? (bid % 8) * (G / 8) + bid / 8 : bid;
            for (int u = vc; u < BATCH * 12 * 8; u += G) attn_unit<2>(lds, QKV, ATT, u / 96, (u >> 3) % 12, u & 7, nullptr, CcL2, 0.f, tid_);
            for (int u = vc; u < BATCH * 8 * 8; u += G) attn_unit<1>(lds, QKV, ATT, u >> 6, (u >> 3) & 7, u & 7, rpb, CbL2, 0.f, tid_);
            for (int u = vc; u < BATCH * 12 * 8; u += G) { const int head = (u >> 3) % 12; attn_unit<0>(lds, QKV, ATT, u / 96, head, u & 7, biasA, CaL2, sink[head] * LOG2E, tid_); }
        }
        SEAM(pb + 1);
        if (IN(pb + 2) && PHON(5)) { PHL(); unsigned char* ws = WSP(); mixnorm_rows((bf16*)(ws + WS_ATT), PTR(10) + (size_t)l * DM, gw_, NGW, lane_); }
        SEAM(pb + 2);
        if (IN(pb + 3) && PHON(6)) { PHL(); unsigned char* ws = WSP();
            pg8::Gemm g{(bf16*)(ws + WS_ATT), (bf16*)(ws + WS_WOUT) + (size_t)l * DM * DM, T, DM, DM}; pg8::StaticOrder S; S.init(T, DM, G, bid);
            pg8::EpiResid E{(bf16*)(ws + WS_XN), DM, (u64_t*)(ws + WS_ROWSQ) + (size_t)(l * 3 + 1) * T};
            pg8::gemm_phase<pg8::EpiResid, pg8::StaticOrder, true, true>(lds + RING_OFF, g, S, E, tid_);
        }
        SEAM(pb + 3);
        if (IN(pb + 4) && PHON(7)) for (int rep_ = 0; rep_ < REP_GEMM; ++rep_) { PHL(); unsigned char* ws = WSP();
            pg8::Gemm g{(bf16*)(ws + WS_XN), (bf16*)(ws + WS_WMQ) + (size_t)l * MEMW * DM, T, MEMW, DM}; pg8::StaticOrder S; S.init(T, MEMW, G, bid);
            pg8::EpiBf16Row E{(bf16*)(ws + WS_QM), MEMW, (const u64_t*)(ws + WS_ROWSQ) + (size_t)(l * 3 + 1) * T};
            pg8::gemm_phase<pg8::EpiBf16Row, pg8::StaticOrder, true, true>(lds + RING_OFF, g, S, E, tid_);
        }
        SEAM(pb + 4);
        if (IN(pb + 5) && PHON(8)) for (int rep_ = 0; rep_ < REP_MEM; ++rep_) { PHL(); unsigned char* ws = WSP();
            const bf16* kvm = (const bf16*)(ws + WS_KVM) + (size_t)l * BATCH * NMEM * 1024; const float* gq = PTR(16) + (size_t)l * 256;
            const float CmL2 = 11.313708498984761f * wave_max(fmaxf(fabsf(gq[lane_]), fabsf(gq[64 + lane_])), lane_) * wave_max(fmaxf(fabsf(gq[128 + lane_]), fabsf(gq[192 + lane_])), lane_) * LOG2E;
            for (int u = bid; u < (T / 256) * 4; u += G) mem_unit(lds, (const bf16*)(ws + WS_QM), kvm, (bf16*)(ws + WS_OM), gq, u >> 2, u & 3, CmL2, tid_);
        }
        SEAM(pb + 5);
        if (IN(pb + 6) && PHON(9)) { PHL(); unsigned char* ws = WSP();
            pg8::Gemm g{(bf16*)(ws + WS_OM), (bf16*)(ws + WS_WMO) + (size_t)l * DM * MEMW, T, DM, MEMW}; pg8::StaticOrder S; S.init(T, DM, G, bid);
            pg8::EpiResid E{(bf16*)(ws + WS_XN), DM, (u64_t*)(ws + WS_ROWSQ) + (size_t)(l * 3 + 2) * T};
            pg8::gemm_phase<pg8::EpiResid, pg8::StaticOrder, true, true>(lds + RING_OFF, g, S, E, tid_);
        }
        SEAM(pb + 6);
        if (IN(pb + 7) && PHON(10)) for (int rep_ = 0; rep_ < REP_GEMM; ++rep_) { PHL(); unsigned char* ws = WSP();
            pg8::Gemm g{(bf16*)(ws + WS_XN), (bf16*)(ws + WS_WPQ) + (size_t)l * DM * DM, T, DM, DM}; pg8::StaticOrder S; S.init(T, DM, G, bid);
            pg8::EpiBf16Row E{(bf16*)(ws + WS_QP), DM, (const u64_t*)(ws + WS_ROWSQ) + (size_t)(l * 3 + 2) * T};
            pg8::gemm_phase<pg8::EpiBf16Row, pg8::StaticOrder, true, true>(lds + RING_OFF, g, S, E, tid_);
        }
        SEAM(pb + 7);
        if (IN(pb + 8) && PHON(11)) for (int rep_ = 0; rep_ < REP_SEL; ++rep_) { PHL(); unsigned char* ws = WSP();
            const bf16* pk = (const bf16*)(ws + WS_PKEYS) + (size_t)l * 8 * 2 * 128 * 128;
            for (int u = bid; u < (T / 256) * PEER_H; u += G) peer_select_unit((const bf16*)(ws + WS_QP), pk, (int*)(ws + WS_PIDX), (float*)(ws + WS_PGATE), u >> 3, u & 7, wave_, lane_);
        }
        SEAM(pb + 8);
        if (IN(pb + 9) && PHON(12)) { PHL(); unsigned char* ws = WSP();
            peer_gather6((bf16*)(ws + WS_XN), ws + WS_PU + (size_t)l * PEER_N * 1536, ws + WS_PV + (size_t)l * PEER_N * 1536, (const int*)(ws + WS_PIDX), (const float*)(ws + WS_PGATE), (l + 1 == DEPTH) ? OUTP() : (float*)nullptr,
                         (const u64_t*)(ws + WS_ROWSQ) + (size_t)(l * 3 + 2) * T, (l + 1 < DEPTH) ? (u64_t*)(ws + WS_ROWSQ) + (size_t)((l + 1) * 3 + 0) * T : (u64_t*)nullptr,
                         (LAS float*)(lds + RING_OFF + wave_ * 1024), gw_, NGW, lane_); }
        SEAM(pb + 9);
    }
#undef IN
#undef SEAM
}

#ifndef MK_MULTI_LAUNCH
#define MK_MULTI_LAUNCH 0
#endif
extern "C" void kernel_launch(void* const* d_in, const int* in_sizes, int n_in, void* d_out, int out_size, void* d_ws, size_t ws_size, hipStream_t stream) {
    static int grid = 0;
    if (grid == 0) {
        if (n_in != 23 || out_size != T * DM || ws_size < WS_END) { fprintf(stderr, "kernel_launch: unexpected shapes (n_in %d, out %d, ws %zu)\n", n_in, out_size, ws_size); grid = -1; return; }
        int dev = 0, cus = 0, per_cu = 0;
        if (hipGetDevice(&dev) != hipSuccess || hipDeviceGetAttribute(&cus, hipDeviceAttributeMultiprocessorCount, dev) != hipSuccess) { grid = -1; return; }
        if (hipFuncSetAttribute((const void*)mega, hipFuncAttributeMaxDynamicSharedMemorySize, LDS_BYTES) != hipSuccess) { fprintf(stderr, "kernel_launch: hipFuncSetAttribute failed\n"); grid = -1; return; }
        if (hipOccupancyMaxActiveBlocksPerMultiprocessor(&per_cu, (const void*)mega, NTHREADS, LDS_BYTES) != hipSuccess || per_cu < 1) { fprintf(stderr, "kernel_launch: occupancy query says %d\n", per_cu); }
        (void)hipGetLastError();
        grid = cus;
    }
    if (grid < 0) return;
    (void)hipMemsetAsync((char*)d_ws + WS_CTL, 0, CTL_ZERO_BYTES, stream);
    Args a{};
    for (int i = 0; i < 23; ++i) a.in[i] = (const float*)d_in[i];
    a.out = (float*)d_out; a.ws = (unsigned char*)d_ws;
#if MK_MULTI_LAUNCH
    for (int p = 0; p < N_PHASES; ++p) { a.ph_lo = p; a.ph_hi = p + 1; a.use_bar = 0; a.pad = 0; hipLaunchKernelGGL(mega, dim3(grid), dim3(NTHREADS), LDS_BYTES, stream, a); }
#else
    a.ph_lo = 0; a.ph_hi = N_PHASES; a.use_bar = 1; a.pad = 0;
    hipLaunchKernelGGL(mega, dim3(grid), dim3(NTHREADS), LDS_BYTES, stream, a);
#endif
    const hipError_t le = hipPeekAtLastError();
    if (le != hipSuccess) fprintf(stderr, "kernel_launch: launch failed: %s\n", hipGetErrorName(le));
}
```

```cpp
#include <hip/hip_runtime.h>
#include <cstdio>
#include <cstdint>
#include <cmath>
__device__ __forceinline__ float shx(float v, int k, int lane);
typedef unsigned long long u64_t;
__device__ __forceinline__ float rowsq_rs(const u64_t* rowsq, int row) { return 1.0f / sqrtf((float)rowsq[row] * (5.9604644775390625e-08f / 2048.0f) + 1e-6f); }
__device__ __forceinline__ u64_t rowsq_fx(float ss) { return (u64_t)(ss * 16777216.0f + 0.5f); }
namespace pg8 {
#define PG8_LAS __attribute__((address_space(3)))
typedef unsigned short bf16_t;
typedef short bf16x8 __attribute__((ext_vector_type(8)));
typedef float f32x4 __attribute__((ext_vector_type(4)));
typedef unsigned u32x4 __attribute__((ext_vector_type(4)));
constexpr int BM = 256, BK = 64, HALF = 128, HTB = HALF * BK * 2  , STAGE_BYTES = 8 * HTB, NXCD = 8, WGM = 8;

__host__ __device__ __forceinline__ int lds_byte(int r, int c) { const int st = (r >> 4) * 2 + (c >> 5), rr = r & 15, cc = c & 31, ob = rr * 64 + cc * 2; return st * 1024 + (ob ^ (((ob >> 9) & 1) << 5)); }
__host__ __device__ __forceinline__ void stage_rc(int b, int& R, int& C) { const int st = b / 1024, sb = b % 1024, swz = sb ^ (((sb >> 9) & 1) << 5); R = (st >> 1) * 16 + swz / 64; C = (st & 1) * 32 + (swz % 64) / 2; }
__host__ __device__ __forceinline__ int perm32(int rho) { const int n = rho >> 4, i = rho & 15; return 8 * (i >> 2) + 4 * n + (i & 3); }

struct Unit { int pm, pn; };
struct Gemm { const bf16_t* A; const bf16_t* Bt; int M, N, K; };

struct StaticOrder {
    int nM, nN, nwg, G, c;
    __host__ __device__ void init(int M, int N, int G_, int c_) { nM = M / BM; nN = N / BM; nwg = nM * nN; G = G_; c = c_; }
    __host__ __device__ bool next(int i, Unit& u) const {
        const long L = (long)i * G + c; if (L >= nwg) return false;
        int wgid = (int)L; { const int q = nwg / NXCD, r = nwg % NXCD, xcd = wgid % NXCD, off = wgid / NXCD; wgid = (xcd < r ? xcd * (q + 1) : r * (q + 1) + (xcd - r) * q) + off; }
        const int nig = WGM * nN, gid = wgid / nig, fm = gid * WGM, gsz = (nM - fm) < WGM ? (nM - fm) : WGM;
        u.pm = fm + ((wgid % nig) % gsz); u.pn = (wgid % nig) / gsz; return true;
    }
    __device__ __forceinline__ void a_ready(const Unit&) const {}
    __device__ __forceinline__ void done(const Unit&) const {}
};

__device__ __forceinline__ unsigned cvt_pk_bf16(float lo, float hi) { unsigned r; asm volatile("v_cvt_pk_bf16_f32 %0, %1, %2" : "=v"(r) : "v"(lo), "v"(hi)); return r; }
typedef float f32x2 __attribute__((ext_vector_type(2)));
__device__ __forceinline__ f32x2 gelu_pk(f32x2 v) {
    const f32x2 av = __builtin_elementwise_abs(v), d = av * 0.2316418882f + 1.0f;
    f32x2 t; t.x = __builtin_amdgcn_rcpf(d.x); t.y = __builtin_amdgcn_rcpf(d.y);
    f32x2 q = t * 0.5307027145f + (-0.7265760135f); q = q * t + 0.7107068705f; q = q * t + (-0.142248368f); q = q * t + 0.127414796f; q = q * t;
    const f32x2 s = (v * v) * (-0.72134752044f);
    f32x2 e; e.x = __builtin_amdgcn_exp2f(s.x); e.y = __builtin_amdgcn_exp2f(s.y);
    const f32x2 m = v * (q * e), r = v - m;
    f32x2 o; o.x = v.x < 0.f ? m.x : r.x; o.y = v.y < 0.f ? m.y : r.y; return o;
}

template <int ACT  > struct EpiBf16 {
    static constexpr bool PERM = true, AFTER_DRAIN = false; static_assert(ACT == 0 || ACT == 1, "EpiBf16: ACT is 0 (none) or 1 (gelu_pk)");
    bf16_t* O; int ldc; const float* bias; int split_cols; size_t split_stride; float scale0;
    __device__ __forceinline__ void operator()(const f32x4 (&acc)[2][2][4][2], const Unit& u, int wr, int wc, int fr, int fq) const {
        const int row0 = u.pm * BM + wr * 64 + fr; int colt = u.pn * BM; bf16_t* base = O;
        float sc = 1.f; if (split_cols) { const int t = colt / split_cols; base += (size_t)t * split_stride; colt -= t * split_cols; if (t == 0) sc = scale0; }
        const int col0 = colt + wc * 32 + 8 * fq, bcol0 = u.pn * BM + wc * 32 + 8 * fq;
        f32x4 bv[2][2];
#pragma unroll
        for (int bj = 0; bj < 2; ++bj)
#pragma unroll
            for (int n = 0; n < 2; ++n) bv[bj][n] = bias ? *(const f32x4*)(bias + bcol0 + bj * HALF + 4 * n) : (f32x4){0.f, 0.f, 0.f, 0.f};
#pragma unroll
        for (int ai = 0; ai < 2; ++ai)
#pragma unroll
            for (int m = 0; m < 4; ++m) { bf16_t* rowp = base + (size_t)(row0 + ai * HALF + m * 16) * ldc + col0;
#pragma unroll
                for (int bj = 0; bj < 2; ++bj) { f32x4 v0 = acc[ai][bj][m][0] + bv[bj][0], v1 = acc[ai][bj][m][1] + bv[bj][1];
                    if (ACT == 1) { f32x2 a = gelu_pk((f32x2){v0[0], v0[1]}), b = gelu_pk((f32x2){v0[2], v0[3]}), c = gelu_pk((f32x2){v1[0], v1[1]}), d = gelu_pk((f32x2){v1[2], v1[3]});
                        v0 = (f32x4){a.x, a.y, b.x, b.y}; v1 = (f32x4){c.x, c.y, d.x, d.y}; }
                    v0 = v0 * sc; v1 = v1 * sc; u32x4 w; w.x = cvt_pk_bf16(v0[0], v0[1]); w.y = cvt_pk_bf16(v0[2], v0[3]); w.z = cvt_pk_bf16(v1[0], v1[1]); w.w = cvt_pk_bf16(v1[2], v1[3]);
                    *(u32x4*)(rowp + bj * HALF) = w; } }
    }
};

typedef unsigned u32x2 __attribute__((ext_vector_type(2)));
struct EpiResid {
    static constexpr bool PERM = false, AFTER_DRAIN = false;
    bf16_t* s; int ldc; u64_t* rowsq;
    __device__ __forceinline__ void operator()(const f32x4 (&acc)[2][2][4][2], const Unit& u, int wr, int wc, int fr, int fq) const {
        const int col0 = u.pn * BM + wc * 32 + 4 * fq;
#pragma unroll
        for (int ai = 0; ai < 2; ++ai)
#pragma unroll
            for (int m = 0; m < 4; ++m) { const int row = u.pm * BM + ai * HALF + wr * 64 + m * 16 + fr; bf16_t* sp = s + (size_t)row * ldc + col0; float ss = 0.f;
                u32x2 in[2][2];
#pragma unroll
                for (int bj = 0; bj < 2; ++bj)
#pragma unroll
                    for (int n = 0; n < 2; ++n) in[bj][n] = *(const u32x2*)(sp + bj * HALF + n * 16);
#pragma unroll
                for (int bj = 0; bj < 2; ++bj)
#pragma unroll
                    for (int n = 0; n < 2; ++n) { const u32x2 w0 = in[bj][n];
                        const f32x4 bs = (f32x4){__builtin_bit_cast(float, w0.x << 16), __builtin_bit_cast(float, w0.x & 0xffff0000u), __builtin_bit_cast(float, w0.y << 16), __builtin_bit_cast(float, w0.y & 0xffff0000u)};
                        const f32x4 o = bs + acc[ai][bj][m][n]; ss += (o[0] * o[0] + o[1] * o[1]) + (o[2] * o[2] + o[3] * o[3]);
                        u32x2 w; w.x = cvt_pk_bf16(o[0], o[1]); w.y = cvt_pk_bf16(o[2], o[3]); *(u32x2*)(sp + bj * HALF + n * 16) = w; }
                ss += shx(ss, 16, fr + 16 * fq); ss += shx(ss, 32, fr + 16 * fq);
                if (fq == 0) atomicAdd(rowsq + row, rowsq_fx(ss)); }
    }
};
struct EpiBf16Row {
    static constexpr bool PERM = true, AFTER_DRAIN = false;
    bf16_t* O; int ldc; const u64_t* rowsq;
    __device__ __forceinline__ void operator()(const f32x4 (&acc)[2][2][4][2], const Unit& u, int wr, int wc, int fr, int fq) const {
        const int row0 = u.pm * BM + wr * 64 + fr, col0 = u.pn * BM + wc * 32 + 8 * fq;
#pragma unroll
        for (int ai = 0; ai < 2; ++ai)
#pragma unroll
            for (int m = 0; m < 4; ++m) { const int row = row0 + ai * HALF + m * 16; const float rs = rowsq_rs(rowsq, row); bf16_t* rowp = O + (size_t)row * ldc + col0;
#pragma unroll
                for (int bj = 0; bj < 2; ++bj) { const f32x4 v0 = acc[ai][bj][m][0] * rs, v1 = acc[ai][bj][m][1] * rs; u32x4 w; w.x = cvt_pk_bf16(v0[0], v0[1]); w.y = cvt_pk_bf16(v0[2], v0[3]); w.z = cvt_pk_bf16(v1[0], v1[1]); w.w = cvt_pk_bf16(v1[2], v1[3]);
                    *(u32x4*)(rowp + bj * HALF) = w; } }
    }
};
struct EpiQKV {
    static constexpr bool PERM = false, AFTER_DRAIN = false;
    bf16_t* O; const float* ga; const float* gb; const float* gc; const float* rope; const u64_t* rowsq;
    __device__ __forceinline__ void operator()(const f32x4 (&acc)[2][2][4][2], const Unit& u, int wr, int wc, int fr, int fq) const {
        const int hg = u.pn * 4 + wc;
        const float* g = nullptr; bool isq = false, dorope = false;
        if (hg < 12) { g = ga; isq = true; } else if (hg < 16) { g = ga + 64; } else if (hg < 20) { }
        else if (hg < 28) { g = gb; isq = true; } else if (hg < 36) { g = gb + 64; } else if (hg < 44) { }
        else if (hg < 56) { g = gc; isq = true; dorope = true; } else if (hg < 60) { g = gc + 64; dorope = true; }
        const float qs = isq ? 0.18033688011112042f : 1.0f;
#pragma unroll
        for (int ai = 0; ai < 2; ++ai)
#pragma unroll
            for (int m = 0; m < 4; ++m) {
                const int row = u.pm * BM + ai * HALF + wr * 64 + m * 16 + fr;
                f32x4 v[2][2];
                const float rsx = rowsq_rs(rowsq, row);
#pragma unroll
                for (int bj = 0; bj < 2; ++bj)
#pragma unroll
                    for (int n = 0; n < 2; ++n) v[bj][n] = acc[ai][bj][m][n] * rsx;
                if (g) {
                    float ss = 0.f;
#pragma unroll
                    for (int bj = 0; bj < 2; ++bj)
#pragma unroll
                        for (int n = 0; n < 2; ++n) { const f32x4 x = v[bj][n]; ss += (x[0] * x[0] + x[1] * x[1]) + (x[2] * x[2] + x[3] * x[3]); }
                    ss += shx(ss, 16, fr + 16 * fq); ss += shx(ss, 32, fr + 16 * fq);
                    const float r = qs / sqrtf(ss * (1.0f / 64.0f) + 1e-6f);
#pragma unroll
                    for (int bj = 0; bj < 2; ++bj)
#pragma unroll
                        for (int n = 0; n < 2; ++n) v[bj][n] = v[bj][n] * *(const f32x4*)(g + 32 * bj + 16 * n + 4 * fq) * r;
                }
                if (dorope) {
                    const int t = row & 2047, pr = t >> 6, pc = t & 63;
#pragma unroll
                    for (int bj = 0; bj < 2; ++bj) {
                        const int pos = bj ? pc : pr;
                        const float* rp = rope + (size_t)(pos * 16 + 4 * fq) * 2;
                        const f32x4 c01 = *(const f32x4*)rp, c23 = *(const f32x4*)(rp + 4);
                        const f32x4 cs = (f32x4){c01[0], c01[2], c23[0], c23[2]}, sn = (f32x4){c01[1], c01[3], c23[1], c23[3]};
                        const f32x4 x1 = v[bj][0], x2 = v[bj][1];
                        v[bj][0] = x1 * cs - x2 * sn; v[bj][1] = x1 * sn + x2 * cs;
                    }
                }
                bf16_t* rowp = O + (size_t)row * 4096 + hg * 64 + 4 * fq;
#pragma unroll
                for (int bj = 0; bj < 2; ++bj)
#pragma unroll
                    for (int n = 0; n < 2; ++n) { u32x2 w; w.x = cvt_pk_bf16(v[bj][n][0], v[bj][n][1]); w.y = cvt_pk_bf16(v[bj][n][2], v[bj][n][3]); *(u32x2*)(rowp + 32 * bj + 16 * n) = w; }
                asm volatile("" ::: "memory");
            }
    }
};
template <class Epi, class Sched, bool ALIGN_EPI = false, bool SP2 = false>
__device__ __forceinline__ void gemm_phase(PG8_LAS unsigned char* lds, const Gemm g, const Sched& S, const Epi& E, const int tid) {
    const int wid = __builtin_amdgcn_readfirstlane(tid >> 6), lane = tid & 63, wr = wid >> 2, wc = wid & 3, fr = lane & 15, fq = lane >> 4;
    const int K = g.K, nt = K / BK;
    unsigned voffA[2], voffB[2];
#pragma unroll
    for (int i = 0; i < 2; ++i) { int R, C; stage_rc(tid * 16 + i * 8192, R, C); const int Rb = Epi::PERM ? ((R & ~31) + perm32(R & 31)) : R;
        voffA[i] = (unsigned)(R * K + C) * 2u; voffB[i] = (unsigned)(Rb * K + C) * 2u; }
    const size_t kstep = (size_t)(BK * 2);
    const size_t hstep = (size_t)HALF * K * 2;
    const size_t tstep = 2 * hstep;
    const unsigned ldsw = (unsigned)wid * 1024u;
    const int aoff = lds_byte(wr * 64 + fr, fq * 8), boff = lds_byte(wc * 32 + fr, fq * 8);
#define PG8_SA(b, h) (((b) * 2 + (h)) * HTB)
#define PG8_SB(b, h) ((4 + (b) * 2 + (h)) * HTB)
#define PG8_STAGE(bufoff, gbase, voff) do { _Pragma("unroll") for (int _i = 0; _i < 2; ++_i) \
        __builtin_amdgcn_global_load_lds((const unsigned*)((const char*)(gbase) + (voff)[_i]), (PG8_LAS unsigned*)(lds + (bufoff) + ldsw + _i * 8192), 16, 0, 0); } while (0)
#define PG8_LDA(dst, b, h) do { _Pragma("unroll") for (int m = 0; m < 4; ++m) _Pragma("unroll") for (int k = 0; k < 2; ++k) dst[m][k] = *(const PG8_LAS bf16x8*)(lds + PG8_SA(b, h) + aoff + m * 2048 + k * 1024); } while (0)
#define PG8_LDB(dst, b, h) do { _Pragma("unroll") for (int n = 0; n < 2; ++n) _Pragma("unroll") for (int k = 0; k < 2; ++k) dst[n][k] = *(const PG8_LAS bf16x8*)(lds + PG8_SB(b, h) + boff + n * 2048 + k * 1024); } while (0)
#define PG8_MMA(ai, bj, At, Bt) do { __builtin_amdgcn_s_setprio(1); _Pragma("unroll") for (int m = 0; m < 4; ++m) _Pragma("unroll") for (int n = 0; n < 2; ++n) _Pragma("unroll") for (int k = 0; k < 2; ++k) \
        acc[ai][bj][m][n] = __builtin_amdgcn_mfma_f32_16x16x32_bf16(Bt[n][k], At[m][k], acc[ai][bj][m][n], 0, 0, 0); __builtin_amdgcn_s_setprio(0); } while (0)
#define PG8_WAIT_V(n) asm volatile("s_waitcnt vmcnt(" #n ")" ::: "memory")
#define PG8_WAIT_L(n) asm volatile("s_waitcnt lgkmcnt(" #n ")" ::: "memory")
#define PG8_BAR __builtin_amdgcn_s_barrier()
#define PG8_SCHED __builtin_amdgcn_sched_barrier(0)
    Unit cur, nxt; int ui = 0;
    if (!S.next(0, cur)) return;
    f32x4 acc[2][2][4][2];
#pragma unroll
    for (int a = 0; a < 2; ++a)
#pragma unroll
        for (int b = 0; b < 2; ++b)
#pragma unroll
            for (int m = 0; m < 4; ++m)
#pragma unroll
                for (int n = 0; n < 2; ++n) acc[a][b][m][n] = (f32x4){0.f, 0.f, 0.f, 0.f};
    bf16x8 At[4][2], B0[2][2], B1[2][2];
    const char* cA = (const char*)g.A + (size_t)cur.pm * tstep; const char* cB = (const char*)g.Bt + (size_t)cur.pn * tstep;
    S.a_ready(cur);
    if constexpr (SP2) {
        PG8_STAGE(PG8_SB(0, 0), cB, voffB); PG8_STAGE(PG8_SB(0, 1), cB + hstep, voffB); PG8_STAGE(PG8_SA(0, 0), cA, voffA); PG8_STAGE(PG8_SA(0, 1), cA + hstep, voffA);
        if (wr == 1) PG8_BAR;
        PG8_WAIT_V(2); PG8_BAR;
        PG8_STAGE(PG8_SB(1, 0), cB + kstep, voffB); PG8_STAGE(PG8_SA(1, 0), cA + kstep, voffA); PG8_STAGE(PG8_SB(1, 1), cB + hstep + kstep, voffB);
        PG8_WAIT_V(6); PG8_BAR;
    } else {
        PG8_STAGE(PG8_SB(0, 0), cB, voffB); PG8_STAGE(PG8_SA(0, 0), cA, voffA); PG8_STAGE(PG8_SB(0, 1), cB + hstep, voffB); PG8_STAGE(PG8_SA(0, 1), cA + hstep, voffA);
        if (wr == 1) PG8_BAR;
        PG8_WAIT_V(4); PG8_BAR;
        PG8_STAGE(PG8_SB(1, 0), cB + kstep, voffB); PG8_STAGE(PG8_SA(1, 0), cA + kstep, voffA); PG8_STAGE(PG8_SB(1, 1), cB + hstep + kstep, voffB);
        PG8_WAIT_V(6); PG8_BAR;
    }
    for (;;) {
        const bool has_next = S.next(ui + 1, nxt);
        const char* nA = has_next ? (const char*)g.A + (size_t)nxt.pm * tstep : cA; const char* nB = has_next ? (const char*)g.Bt + (size_t)nxt.pn * tstep : cB;
        for (int t = 0; t < nt; t += 2) {
            const bool last = (t == nt - 2);
            const char* a1 = cA + (size_t)(t + 1) * kstep;
            const char* a2 = last ? nA : cA + (size_t)(t + 2) * kstep; const char* b2 = last ? nB : cB + (size_t)(t + 2) * kstep;
            const char* a3 = a2 + kstep; const char* b3 = b2 + kstep;
            if (last && has_next) S.a_ready(nxt);
            if constexpr (SP2) {
            PG8_LDB(B0, 0, 0); PG8_LDB(B1, 0, 1); PG8_SCHED; PG8_LDA(At, 0, 0); PG8_STAGE(PG8_SA(1, 1), a1 + hstep, voffA);
            PG8_WAIT_V(8); PG8_WAIT_L(0); PG8_BAR; PG8_MMA(0, 0, At, B0); PG8_MMA(0, 1, At, B1); PG8_BAR; PG8_SCHED;
            PG8_LDA(At, 0, 1); PG8_STAGE(PG8_SB(0, 0), b2, voffB); PG8_STAGE(PG8_SB(0, 1), b2 + hstep, voffB); PG8_STAGE(PG8_SA(0, 0), a2, voffA);
            PG8_WAIT_V(8); PG8_WAIT_L(0); PG8_BAR; PG8_MMA(1, 0, At, B0); PG8_MMA(1, 1, At, B1); PG8_BAR; PG8_SCHED;
            PG8_LDB(B0, 1, 0); PG8_LDB(B1, 1, 1); PG8_SCHED; PG8_LDA(At, 1, 0); PG8_STAGE(PG8_SA(0, 1), a2 + hstep, voffA);
            PG8_WAIT_V(8); PG8_WAIT_L(0); PG8_BAR; PG8_MMA(0, 0, At, B0); PG8_MMA(0, 1, At, B1); PG8_BAR; PG8_SCHED;
            PG8_LDA(At, 1, 1); PG8_STAGE(PG8_SB(1, 0), b3, voffB); PG8_STAGE(PG8_SB(1, 1), b3 + hstep, voffB); PG8_STAGE(PG8_SA(1, 0), a3, voffA);
            PG8_WAIT_V(8); PG8_WAIT_L(0); PG8_BAR; PG8_MMA(1, 0, At, B0); PG8_MMA(1, 1, At, B1); PG8_BAR; PG8_SCHED;
            } else {
            PG8_LDB(B0, 0, 0); PG8_SCHED; PG8_LDA(At, 0, 0); PG8_STAGE(PG8_SA(1, 1), a1 + hstep, voffA);
            PG8_WAIT_L(8); PG8_BAR; PG8_WAIT_L(0); PG8_MMA(0, 0, At, B0); PG8_BAR; PG8_SCHED;
            PG8_LDB(B1, 0, 1); PG8_STAGE(PG8_SB(0, 0), b2, voffB);
            PG8_BAR; PG8_WAIT_L(0); PG8_MMA(0, 1, At, B1); PG8_BAR;
            PG8_LDA(At, 0, 1); PG8_STAGE(PG8_SA(0, 0), a2, voffA);
            PG8_BAR; PG8_WAIT_L(0); PG8_MMA(1, 0, At, B0); PG8_BAR; PG8_SCHED;
            PG8_STAGE(PG8_SB(0, 1), b2 + hstep, voffB);
            PG8_WAIT_V(6); PG8_BAR; PG8_MMA(1, 1, At, B1); PG8_BAR;
            PG8_LDB(B0, 1, 0); PG8_SCHED; PG8_LDA(At, 1, 0); PG8_STAGE(PG8_SA(0, 1), a2 + hstep, voffA);
            PG8_WAIT_L(8); PG8_BAR; PG8_WAIT_L(0); PG8_MMA(0, 0, At, B0); PG8_BAR; PG8_SCHED;
            PG8_LDB(B1, 1, 1); PG8_STAGE(PG8_SB(1, 0), b3, voffB);
            PG8_BAR; PG8_WAIT_L(0); PG8_MMA(0, 1, At, B1); PG8_BAR;
            PG8_LDA(At, 1, 1); PG8_STAGE(PG8_SA(1, 0), a3, voffA);
            PG8_BAR; PG8_WAIT_L(0); PG8_MMA(1, 0, At, B0); PG8_BAR; PG8_SCHED;
            PG8_STAGE(PG8_SB(1, 1), b3 + hstep, voffB);
            PG8_WAIT_V(6); PG8_BAR; PG8_MMA(1, 1, At, B1); PG8_BAR;
            }
        }
        if constexpr (ALIGN_EPI) { if (wr == 0) PG8_BAR; }
        if constexpr (!Epi::AFTER_DRAIN) { E(acc, cur, wr, wc, fr, fq); S.done(cur); }
        if (!has_next) break;
#pragma unroll
        for (int a = 0; a < 2; ++a)
#pragma unroll
            for (int b = 0; b < 2; ++b)
#pragma unroll
                for (int m = 0; m < 4; ++m)
#pragma unroll
                    for (int n = 0; n < 2; ++n) acc[a][b][m][n] = (f32x4){0.f, 0.f, 0.f, 0.f};
        cur = nxt; cA = nA; cB = nB; ++ui;
        if constexpr (ALIGN_EPI) { if (wr == 1) PG8_BAR; }
    }
    PG8_WAIT_V(0);
    if constexpr (!ALIGN_EPI) { if (wr == 0) PG8_BAR; }
    PG8_BAR;
    if constexpr (Epi::AFTER_DRAIN) { E.fused(acc, cur, wr, wc, fr, fq, lds, wid, lane); S.done(cur); }
#undef PG8_SA
#undef PG8_SB
#undef PG8_STAGE
#undef PG8_LDA
#undef PG8_LDB
#undef PG8_MMA
#undef PG8_WAIT_V
#undef PG8_WAIT_L
#undef PG8_BAR
#undef PG8_SCHED
}
}

constexpr int BATCH = 16, SEQ = 2048, DM = 2048, T = BATCH * SEQ, DEPTH = 2;
constexpr int NMEM = 256, DIN = 4096, MEMW = 512;
constexpr int PEER_H = 8, PEER_N = 16384;
constexpr int NWAVES = 8, NTHREADS = NWAVES * 64;
constexpr float EPS = 1e-6f;
constexpr int QA = 0, KA = 768, VA = 1024, QB = 1280, KB = 1792, VB = 2304, QC = 2816, KC = 3584, VC = 3840;
constexpr int OA = 0, OB = 768, OC = 1280;

constexpr size_t MiB = 1u << 20;
constexpr size_t WS_CTL = 0, CTL_ZERO_BYTES = 2 * MiB;
constexpr size_t WS_ROWSQ = 256 * 1024;
constexpr size_t WS_ROPE = 83 * MiB, WS_BIASA = 83 * MiB + 16384;
constexpr size_t WS_WIN = 2 * MiB, WS_WOUT = 34 * MiB, WS_WMQ = 50 * MiB, WS_WMKV = 54 * MiB, WS_WMO = 62 * MiB, WS_WPQ = 66 * MiB, WS_PKEYS = 82 * MiB;
constexpr size_t WS_MEMN = 84 * MiB, WS_KVM = 116 * MiB, WS_PU = 132 * MiB, WS_PV = 260 * MiB, WS_XN = 388 * MiB, WS_QKV = 516 * MiB, WS_ATT = 772 * MiB;
constexpr size_t WS_QM = 900 * MiB, WS_OM = 932 * MiB, WS_END = 964 * MiB;
constexpr size_t WS_QP = WS_QKV, WS_PIDX = WS_QKV + 128 * MiB, WS_PGATE = WS_QKV + 144 * MiB;
constexpr int CW_BAR = 4096;

constexpr int RING_OFF = 0, RING_BYTES = 131072;
constexpr int LDSCTL_OFF = RING_BYTES, MISC_OFF = LDSCTL_OFF + 320;
constexpr int LDS_BYTES = 147456;

#define GAS __attribute__((address_space(1)))
#define LAS __attribute__((address_space(3)))
typedef unsigned short bf16;
typedef unsigned v4u __attribute__((ext_vector_type(4)));
typedef unsigned v2u __attribute__((ext_vector_type(2)));
typedef float f32x4 __attribute__((ext_vector_type(4)));
typedef float f32x16 __attribute__((ext_vector_type(16)));
typedef short bf16x8 __attribute__((ext_vector_type(8)));
typedef GAS unsigned gu32;
#define LDS_WAIT() asm volatile("s_waitcnt lgkmcnt(0)" ::: "memory")
#define VM_WAIT() asm volatile("s_waitcnt vmcnt(0)" ::: "memory")
__device__ __forceinline__ unsigned f2bf(float f) { unsigned u = __builtin_bit_cast(unsigned, f); return (u + 0x7fffu + ((u >> 16) & 1u)) >> 16; }
__device__ __forceinline__ unsigned pk2(float lo, float hi) { return f2bf(lo) | (f2bf(hi) << 16); }
__device__ __forceinline__ float bflo(unsigned w) { return __builtin_bit_cast(float, w << 16); }
__device__ __forceinline__ float bfhi(unsigned w) { return __builtin_bit_cast(float, w & 0xffff0000u); }

__device__ __forceinline__ float shx(float v, int k, int lane) { return __builtin_bit_cast(float, __builtin_amdgcn_ds_bpermute((lane ^ k) << 2, __builtin_bit_cast(int, v))); }
#define XB_TMO      128
#define XB_XCNT(j)  (256  + 64 * (j))
#define XB_XSUB(j)  (1280 + 64 * (j))
#define XB_XGEN(j)  (2304 + 64 * (j))
#define XB_TOP      3328
#define XB_TOPGEN   3392
#define XCD_BAR_WORDS 3456
#define XB_SPIN_CAP (1u << 18)

__device__ __forceinline__ unsigned xb_ld(unsigned* p)              { return __hip_atomic_load(p, __ATOMIC_RELAXED, __HIP_MEMORY_SCOPE_AGENT); }
__device__ __forceinline__ unsigned xb_add(unsigned* p, unsigned v) { return __hip_atomic_fetch_add(p, v, __ATOMIC_RELAXED, __HIP_MEMORY_SCOPE_AGENT); }
__device__ __forceinline__ unsigned xb_xcc_id() { return (unsigned)__builtin_amdgcn_s_getreg((3 << 11) | 20) & 0xFu; }
#define XB_SPIN(cond, bar) do { unsigned _sp = 0; while (cond) { __builtin_amdgcn_s_sleep(1); \
    if ((++_sp & 255u) == 0u) { if (xb_ld(&(bar)[XB_TMO])) break; if (_sp > XB_SPIN_CAP) { atomicAdd(&(bar)[XB_TMO], 1u); break; } } } } while (0)

struct XcdBarrier {
    unsigned* bar; unsigned x;
    volatile LAS unsigned* st;
};

__device__ __forceinline__ XcdBarrier xcd_barrier_post(unsigned* bar, volatile LAS unsigned* st) {
    XcdBarrier b; b.bar = bar; b.x = xb_xcc_id(); b.st = st;
    if (threadIdx.x == 0) (void)xb_add(&bar[XB_XCNT(b.x)], 1u);
    return b;
}
__device__ __forceinline__ void xcd_barrier_complete(unsigned* bar, unsigned x, unsigned& nloc, unsigned& nx) {
    const unsigned G = gridDim.x * gridDim.y * gridDim.z;
    unsigned sum, cnt, mine, sp = 0u;
    for (;;) {
        sum = 0u; cnt = 0u; mine = 0u;
#pragma unroll
        for (unsigned j = 0; j < 16; ++j) { const unsigned c = xb_ld(&bar[XB_XCNT(j)]); sum += c; cnt += (c > 0u) ? 1u : 0u; mine = (j == x) ? c : mine; }
        if (sum == G) break;
        __builtin_amdgcn_s_sleep(1);
        if ((++sp & 255u) == 0u) { if (xb_ld(&bar[XB_TMO])) break; if (sp > XB_SPIN_CAP) { atomicAdd(&bar[XB_TMO], 1u); break; } }
    }
    nloc = mine > 0u ? mine : 1u; nx = cnt > 0u ? cnt : 1u;
}

__device__ __forceinline__ void xcd_barrier(const XcdBarrier& b) {
    asm volatile("s_waitcnt vmcnt(0)" ::: "memory");
    __syncthreads();
    if (threadIdx.x == 0) {
        unsigned* bar = b.bar;
        __builtin_amdgcn_s_waitcnt(0);
        unsigned nloc = b.st[0], nx = b.st[1];
        if (nloc == 0u) { xcd_barrier_complete(bar, b.x, nloc, nx); b.st[0] = nloc; b.st[1] = nx; }
        const unsigned old = xb_add(&bar[XB_XSUB(b.x)], 1u);
        const unsigned gen = old / nloc;
        if (old + 1u == (gen + 1u) * nloc) {
            __builtin_amdgcn_fence(__ATOMIC_RELEASE, "agent");
            asm volatile("s_waitcnt vmcnt(0)" ::: "memory");
            const unsigned og = xb_add(&bar[XB_TOP], 1u);
            const unsigned tg = og / nx;
            if (og + 1u == (tg + 1u) * nx) xb_add(&bar[XB_TOPGEN], 1u);
            else XB_SPIN(xb_ld(&bar[XB_TOPGEN]) == tg, bar);
            __builtin_amdgcn_fence(__ATOMIC_ACQUIRE, "agent");
            xb_add(&bar[XB_XGEN(b.x)], 1u);
            asm volatile("s_waitcnt vmcnt(0)" ::: "memory");
        } else {
            XB_SPIN(xb_ld(&bar[XB_XGEN(b.x)]) == gen, bar);
            __builtin_amdgcn_fence(__ATOMIC_ACQUIRE, "agent");
            asm volatile("s_waitcnt vmcnt(0)" ::: "memory");
        }
    }
    __syncthreads();
}

__device__ __forceinline__ float wave_sum(float v, int lane) {
#pragma unroll
    for (int o = 1; o < 64; o <<= 1) v += shx(v, o, lane);
    return v;
}
__device__ __forceinline__ void* ldptr(LAS unsigned char* lds, int i) {
    const unsigned long long v = ((const LAS unsigned long long*)(lds + LDSCTL_OFF + 1024))[i];
    const unsigned lo = __builtin_amdgcn_readfirstlane((unsigned)v), hi = __builtin_amdgcn_readfirstlane((unsigned)(v >> 32));
    return (void*)(((unsigned long long)hi << 32) | lo);
}
struct OffsetOrder {
    pg8::StaticOrder S;
    __device__ void init(int M, int N, int G, int c, int off) { S.init(M, N, G, (c + G - off % G) % G); }
    __device__ bool next(int i, pg8::Unit& u) const { return S.next(i, u); }
    __device__ __forceinline__ void a_ready(const pg8::Unit&) const {}
    __device__ __forceinline__ void done(const pg8::Unit&) const {}
};

template <bool PERMQKV>
__device__ __forceinline__ void transpose_item(const float* W, int K, int N, bf16* WT, LAS float* scr, int item, int lane, const float* gk = nullptr) {
    const int nblk = N / 32, kb = item / nblk, nb = item % nblk, k0 = 64 * kb, n0 = 32 * nb;
    int d0 = n0;
    if (PERMQKV) { const int within = n0 & 255; d0 = (n0 & ~255) + 128 * ((within >> 5) & 1) + 32 * (within >> 6); }
#pragma unroll 8
    for (int i = 0; i < 32; ++i) { const int kk = 2 * i + (lane >> 5); scr[kk * 33 + (lane & 31)] = W[(size_t)(k0 + kk) * N + n0 + (lane & 31)] * (gk ? gk[k0 + kk] : 1.f); }
    LDS_WAIT(); asm volatile("" ::: "memory");
    const int c = lane & 7;
#pragma unroll
    for (int j = 0; j < 4; ++j) { const int n = (lane >> 3) + 8 * j; const LAS float* s = scr + (8 * c) * 33 + n;
        v4u o; o.x = pk2(s[0 * 33], s[1 * 33]); o.y = pk2(s[2 * 33], s[3 * 33]); o.z = pk2(s[4 * 33], s[5 * 33]); o.w = pk2(s[6 * 33], s[7 * 33]);
        *(GAS v4u*)(WT + (size_t)(d0 + n) * K + k0 + 8 * c) = o; }
    LDS_WAIT(); asm volatile("" ::: "memory");
}
__device__ __forceinline__ void convert_bf16(const float* src, bf16* dst, size_t n, size_t gtid, size_t nthreads) {
    for (size_t i = gtid * 8; i < n; i += nthreads * 8) {
        const f32x4 a = *(const GAS f32x4*)(src + i), b = *(const GAS f32x4*)(src + i + 4);
        v4u o; o.x = pk2(a[0], a[1]); o.y = pk2(a[2], a[3]); o.z = pk2(b[0], b[1]); o.w = pk2(b[2], b[3]);
        *(GAS v4u*)(dst + i) = o;
    }
}
__device__ __forceinline__ int t5_bucket(int rel) {
    const int n = rel < 0 ? -rel : rel;
    const int b = n < 8 ? n : n < 12 ? 8 : n < 16 ? 9 : n < 23 ? 10 : n < 32 ? 11 : n < 46 ? 12 : n < 64 ? 13 : n < 91 ? 14 : 15;
    return b + (rel > 0 ? 16 : 0);
}
__constant__ float ROPE_INV[16] = {1.000000000e+00f, 5.623413324e-01f, 3.162277639e-01f, 1.778279394e-01f, 1.000000015e-01f, 5.623413250e-02f, 3.162277490e-02f, 1.778279431e-02f,
                                   9.999999776e-03f, 5.623413250e-03f, 3.162277630e-03f, 1.778279431e-03f, 1.000000047e-03f, 5.623413017e-04f, 3.162277571e-04f, 1.778279402e-04f};

__device__ __forceinline__ void rms_row_to_bf16(const float* xrow, const float* g0, bf16* o0, const float* g1, bf16* o1, int lane) {
    const GAS f32x4* xr = (const GAS f32x4*)xrow + lane;
    f32x4 v[8]; float s = 0.f;
#pragma unroll
    for (int j = 0; j < 8; ++j) { v[j] = xr[64 * j]; s += (v[j].x * v[j].x + v[j].y * v[j].y) + (v[j].z * v[j].z + v[j].w * v[j].w); }
    const float rstd = 1.f / sqrtf(wave_sum(s, lane) * (1.f / DM) + EPS);
    {   const GAS f32x4* gr = (const GAS f32x4*)g0 + lane; GAS v2u* o8 = (GAS v2u*)o0 + lane;
#pragma unroll
        for (int j = 0; j < 8; ++j) { const f32x4 gg = gr[64 * j]; v2u w; w.x = pk2(v[j].x * rstd * gg.x, v[j].y * rstd * gg.y); w.y = pk2(v[j].z * rstd * gg.z, v[j].w * rstd * gg.w); o8[64 * j] = w; } }
    if (g1) { const GAS f32x4* gr = (const GAS f32x4*)g1 + lane; GAS v2u* o8 = (GAS v2u*)o1 + lane;
#pragma unroll
        for (int j = 0; j < 8; ++j) { const f32x4 gg = gr[64 * j]; v2u w; w.x = pk2(v[j].x * rstd * gg.x, v[j].y * rstd * gg.y); w.y = pk2(v[j].z * rstd * gg.z, v[j].w * rstd * gg.w); o8[64 * j] = w; } }
}
__device__ __forceinline__ void prep_row(const float* xrow, bf16* orow, u64_t* sq, int lane) {
    const GAS f32x4* xr = (const GAS f32x4*)xrow + lane; GAS v2u* o8 = (GAS v2u*)orow + lane; float s = 0.f;
#pragma unroll
    for (int j = 0; j < 8; ++j) { const f32x4 v = xr[64 * j]; s += (v.x * v.x + v.y * v.y) + (v.z * v.z + v.w * v.w); v2u w; w.x = pk2(v.x, v.y); w.y = pk2(v.z, v.w); o8[64 * j] = w; }
    s = wave_sum(s, lane);
    if (lane == 0) *sq = rowsq_fx(s);
}
__device__ __forceinline__ void norm_rows(const float* X, const float* g, bf16* XN, int gw, int NGW, int lane) {
    for (int m = gw; m < T; m += NGW) rms_row_to_bf16(X + (size_t)m * DM, g, XN + (size_t)m * DM, nullptr, nullptr, lane);
}

template <int TYPE>
__device__ __forceinline__ void naive_attn_item(const bf16* QKV, bf16* ATT, int b, int grow, int head, int lane, const float* biasA, const float* sink, const float* rpb) {
    const int tpos = grow * 64 + lane; const size_t trow = (size_t)b * SEQ + tpos;
    int qcol, kcol, vcol, ocol;
    if (TYPE == 0) { qcol = QA + head * 64; kcol = KA + (head / 3) * 64; vcol = VA + (head / 3) * 64; ocol = OA + head * 64; }
    else if (TYPE == 1) { qcol = QB + head * 64; kcol = KB + head * 64; vcol = VB + head * 64; ocol = OB + head * 64; }
    else { qcol = QC + head * 64; kcol = KC + (head / 3) * 64; vcol = VC + (head / 3) * 64; ocol = OC + head * 64; }
    float q[64], o[64];
#pragma unroll
    for (int c = 0; c < 8; ++c) { const v4u w = *(const GAS v4u*)(QKV + trow * DIN + qcol + 8 * c);
        q[8 * c + 0] = bflo(w.x); q[8 * c + 1] = bfhi(w.x); q[8 * c + 2] = bflo(w.y); q[8 * c + 3] = bfhi(w.y); q[8 * c + 4] = bflo(w.z); q[8 * c + 5] = bfhi(w.z); q[8 * c + 6] = bflo(w.w); q[8 * c + 7] = bfhi(w.w); }
#pragma unroll
    for (int d = 0; d < 64; ++d) o[d] = 0.f;
    float m = -1e30f, l = 0.f;
    int j0, j1;
    if (TYPE == 0) { j0 = grow * 64 - 128; if (j0 < 0) j0 = 0; j1 = grow * 64 + 63 + 128; if (j1 > SEQ - 1) j1 = SEQ - 1; }
    else if (TYPE == 1) { int r0 = grow - 4; r0 = r0 < 0 ? 0 : (r0 > 24 ? 24 : r0); j0 = r0 * 64; j1 = j0 + 511; }
    else { j0 = 0; j1 = SEQ - 1; }
    int c0 = lane - 8; c0 = c0 < 0 ? 0 : (c0 > 48 ? 48 : c0);
#pragma unroll 1
    for (int j = j0; j <= j1; ++j) {
        const bf16* krow = QKV + ((size_t)b * SEQ + j) * DIN;
        float s = 0.f;
#pragma unroll
        for (int c = 0; c < 8; ++c) { const v4u w = *(const GAS v4u*)(krow + kcol + 8 * c);
            s += q[8 * c + 0] * bflo(w.x) + q[8 * c + 1] * bfhi(w.x) + q[8 * c + 2] * bflo(w.y) + q[8 * c + 3] * bfhi(w.y) + q[8 * c + 4] * bflo(w.z) + q[8 * c + 5] * bfhi(w.z) + q[8 * c + 6] * bflo(w.w) + q[8 * c + 7] * bfhi(w.w); }
        bool valid = true;
        if (TYPE == 0) { const int rel = j - tpos; valid = (rel >= -128 && rel <= 128); if (valid) s += biasA[head * 257 + rel + 128]; }
        if (TYPE == 1) { const int kr = j >> 6, kc = j & 63; valid = (kc >= c0 && kc < c0 + 16); if (valid) s += rpb[(head * 15 + (kr - grow + 7)) * 31 + (kc - lane + 15)]; }
        const float mn = valid ? fmaxf(m, s) : m;
        const float a = __expf(m - mn);
        const float p = valid ? __expf(s - mn) : 0.f;
        l = l * a + p; m = mn;
#pragma unroll
        for (int c = 0; c < 8; ++c) { const v4u w = *(const GAS v4u*)(krow + vcol + 8 * c);
            o[8 * c + 0] = o[8 * c + 0] * a + p * bflo(w.x); o[8 * c + 1] = o[8 * c + 1] * a + p * bfhi(w.x); o[8 * c + 2] = o[8 * c + 2] * a + p * bflo(w.y); o[8 * c + 3] = o[8 * c + 3] * a + p * bfhi(w.y);
            o[8 * c + 4] = o[8 * c + 4] * a + p * bflo(w.z); o[8 * c + 5] = o[8 * c + 5] * a + p * bfhi(w.z); o[8 * c + 6] = o[8 * c + 6] * a + p * bflo(w.w); o[8 * c + 7] = o[8 * c + 7] * a + p * bfhi(w.w); }
    }
    if (TYPE == 0) l += __expf(sink[head] - m);
    const float inv = 1.f / l;
#pragma unroll
    for (int c = 0; c < 8; ++c) { v4u w; w.x = pk2(o[8 * c + 0] * inv, o[8 * c + 1] * inv); w.y = pk2(o[8 * c + 2] * inv, o[8 * c + 3] * inv); w.z = pk2(o[8 * c + 4] * inv, o[8 * c + 5] * inv); w.w = pk2(o[8 * c + 6] * inv, o[8 * c + 7] * inv);
        *(GAS v4u*)(ATT + trow * DM + ocol + 8 * c) = w; }
}
__device__ __forceinline__ float rdl(float v, int l) { return __builtin_bit_cast(float, __builtin_amdgcn_readlane(__builtin_bit_cast(int, v), l)); }
__device__ __forceinline__ void naive_mem_item(const bf16* QM, const bf16* KVM, bf16* OM, const float* gq, size_t trow, int b, int head, int lane) {
    const unsigned qw = *(const GAS unsigned*)(QM + trow * MEMW + head * 128 + 2 * lane);
    float q0 = bflo(qw), q1 = bfhi(qw);
    const float ss = wave_sum(q0 * q0 + q1 * q1, lane);
    const float r = 0.08838834764831845f / sqrtf(ss * (1.f / 128.f) + EPS);
    q0 *= r * gq[2 * lane]; q1 *= r * gq[2 * lane + 1];
    const bf16* kbase = KVM + ((size_t)b * NMEM + lane) * 1024 + head * 128;
    float s[4] = {0.f, 0.f, 0.f, 0.f};
#pragma unroll 1
    for (int c = 0; c < 16; ++c) {
        float qa[8];
#pragma unroll
        for (int e = 0; e < 4; ++e) { qa[2 * e] = rdl(q0, 4 * c + e); qa[2 * e + 1] = rdl(q1, 4 * c + e); }
#pragma unroll
        for (int i = 0; i < 4; ++i) { const v4u w = *(const GAS v4u*)(kbase + (size_t)i * 64 * 1024 + 8 * c);
            s[i] += qa[0] * bflo(w.x) + qa[1] * bfhi(w.x) + qa[2] * bflo(w.y) + qa[3] * bfhi(w.y) + qa[4] * bflo(w.z) + qa[5] * bfhi(w.z) + qa[6] * bflo(w.w) + qa[7] * bfhi(w.w); }
    }
    float m = fmaxf(fmaxf(s[0], s[1]), fmaxf(s[2], s[3]));
#pragma unroll
    for (int o = 1; o < 64; o <<= 1) m = fmaxf(m, shx(m, o, lane));
    float p[4]; float l = 0.f;
#pragma unroll
    for (int i = 0; i < 4; ++i) { p[i] = __expf(s[i] - m); l += p[i]; }
    l = wave_sum(l, lane);
    const bf16* vbase = KVM + ((size_t)b * NMEM) * 1024 + 512 + head * 128 + 2 * lane;
    float o0 = 0.f, o1 = 0.f;
#pragma unroll
    for (int i = 0; i < 4; ++i) {
#pragma unroll 4
        for (int jj = 0; jj < 64; ++jj) { const float pj = rdl(p[i], jj); const unsigned w = *(const GAS unsigned*)(vbase + (size_t)(64 * i + jj) * 1024); o0 += pj * bflo(w); o1 += pj * bfhi(w); }
    }
    const float inv = 1.f / l;
    *(GAS unsigned*)(OM + trow * MEMW + head * 128 + 2 * lane) = pk2(o0 * inv, o1 * inv);
}
__device__ __forceinline__ void mixnorm_rows(bf16* ATT, const float* g, int gw, int NGW, int lane) {
    for (int m = gw; m < T; m += NGW) {
        GAS v4u* p = (GAS v4u*)(ATT + (size_t)m * DM + 32 * lane);
        v4u w[4]; float f[32]; float ss = 0.f;
#pragma unroll
        for (int c = 0; c < 4; ++c) { w[c] = p[c];
            f[8 * c + 0] = bflo(w[c].x); f[8 * c + 1] = bfhi(w[c].x); f[8 * c + 2] = bflo(w[c].y); f[8 * c + 3] = bfhi(w[c].y); f[8 * c + 4] = bflo(w[c].z); f[8 * c + 5] = bfhi(w[c].z); f[8 * c + 6] = bflo(w[c].w); f[8 * c + 7] = bfhi(w[c].w); }
#pragma unroll
        for (int i = 0; i < 32; ++i) ss += f[i] * f[i];
        const int grp = lane < 24 ? 0 : (lane < 40 ? 1 : 2);
        const float sa = wave_sum(grp == 0 ? ss : 0.f, lane), sb = wave_sum(grp == 1 ? ss : 0.f, lane), sc = wave_sum(grp == 2 ? ss : 0.f, lane);
        const float r = grp == 0 ? 1.f / sqrtf(sa * (1.f / 768.f) + EPS) : (grp == 1 ? 1.f / sqrtf(sb * (1.f / 512.f) + EPS) : 1.f / sqrtf(sc * (1.f / 768.f) + EPS));
        const float* gg = g + 32 * lane;
#pragma unroll
        for (int c = 0; c < 4; ++c) { const f32x4 g0 = *(const GAS f32x4*)(gg + 8 * c), g1 = *(const GAS f32x4*)(gg + 8 * c + 4);
            v4u o; o.x = pk2(f[8 * c + 0] * r * g0[0], f[8 * c + 1] * r * g0[1]); o.y = pk2(f[8 * c + 2] * r * g0[2], f[8 * c + 3] * r * g0[3]);
            o.z = pk2(f[8 * c + 4] * r * g1[0], f[8 * c + 5] * r * g1[1]); o.w = pk2(f[8 * c + 6] * r * g1[2], f[8 * c + 7] * r * g1[3]); p[c] = o; }
    }
}

#ifndef PEER_HD
#define PEER_HD __device__ __forceinline__
#define PEER_EXP(x) __expf(x)
#endif
template <int N> PEER_HD void bitonic_sort_desc(float* v) {
#pragma unroll
    for (int k = 2; k <= N; k <<= 1)
#pragma unroll
        for (int j = k >> 1; j > 0; j >>= 1)
#pragma unroll
            for (int i = 0; i < N; ++i) { const int l = i ^ j; if (l > i) { const bool desc = ((i & k) == 0); const float a = v[i], b = v[l]; const float hi = fmaxf(a, b), lo = fminf(a, b);
                v[i] = desc ? hi : lo; v[l] = desc ? lo : hi; } }
}
PEER_HD void merge_top16(float* a, const float* b) {
    float c[16];
#pragma unroll
    for (int i = 0; i < 16; ++i) c[i] = fmaxf(a[i], b[15 - i]);
#pragma unroll
    for (int j = 8; j > 0; j >>= 1)
#pragma unroll
        for (int i = 0; i < 16; ++i) { const int l = i ^ j; if (l > i) { const float x = c[i], y = c[l]; c[i] = fmaxf(x, y); c[l] = fminf(x, y); } }
#pragma unroll
    for (int i = 0; i < 16; ++i) a[i] = c[i];
}
PEER_HD void top16_of_64(float (&v)[64]) {
    bitonic_sort_desc<16>(&v[0]); bitonic_sort_desc<16>(&v[16]); bitonic_sort_desc<16>(&v[32]); bitonic_sort_desc<16>(&v[48]);
    merge_top16(&v[0], &v[16]); merge_top16(&v[32], &v[48]); merge_top16(&v[0], &v[32]);
}
PEER_HD float pack_idx(float s, unsigned idx, unsigned mask) { return __builtin_bit_cast(float, (__builtin_bit_cast(unsigned, s) & ~mask) | idx); }
PEER_HD unsigned low_bits(float s, unsigned mask) { return __builtin_bit_cast(unsigned, s) & mask; }
PEER_HD unsigned pick16(const float* a, unsigned i, unsigned mask) {
    unsigned r = 0;
#pragma unroll
    for (unsigned k = 0; k < 16; ++k) r = (i == k) ? low_bits(a[k], mask) : r;
    return r;
}
PEER_HD void peer_candidates(const float* a, const float* b, int* e, float* gate) {
    float c[64]; int n = 0;
#pragma unroll
    for (int i = 0; i < 16; ++i)
#pragma unroll
        for (int j = 0; j < 16; ++j) if ((i + 1) * (j + 1) <= 16) { c[n] = pack_idx(a[i] + b[j], (unsigned)(i * 16 + j), 0xffu); ++n; }
#pragma unroll
    for (int k = 50; k < 64; ++k) c[k] = -3.0e38f;
    top16_of_64(c);
    float mx = c[0], den = 0.f;
#pragma unroll
    for (int k = 0; k < 16; ++k) { const unsigned id = low_bits(c[k], 0xffu); const unsigned n0 = pick16(a, id >> 4, 0x7fu), n1 = pick16(b, id & 15u, 0x7fu);
        e[k] = (int)(n0 * 128u + n1); gate[k] = PEER_EXP(c[k] - mx); den += gate[k]; }
    const float inv = 1.f / den;
#pragma unroll
    for (int k = 0; k < 16; ++k) gate[k] *= inv;
}

__device__ __forceinline__ void peer_select_unit(const bf16* QP, const bf16* PK, int* PIDX, float* PGATE, int tb, int h, int wave, int lane) {
    const int hh = lane >> 5, tl = lane & 31; const size_t t = (size_t)tb * 256 + wave * 32 + tl;
    float ab[2][16];
#pragma unroll
    for (int p = 0; p < 2; ++p) {
        bf16x8 bq[8];
#pragma unroll
        for (int s = 0; s < 8; ++s) bq[s] = *(const GAS bf16x8*)(QP + t * DM + 256 * h + 128 * p + 16 * s + 8 * hh);
        float v[64];
#pragma unroll
        for (int nb = 0; nb < 4; ++nb) {
            f32x16 acc;
#pragma unroll
            for (int r = 0; r < 16; ++r) acc[r] = 0.f;
            const bf16* kp = PK + ((size_t)((h * 2 + p) * 128 + 32 * nb + tl)) * 128 + 8 * hh;
#pragma unroll
            for (int s = 0; s < 8; ++s) { const bf16x8 ak = *(const GAS bf16x8*)(kp + 16 * s); acc = __builtin_amdgcn_mfma_f32_32x32x16_bf16(ak, bq[s], acc, 0, 0, 0); }
#pragma unroll
            for (int r = 0; r < 16; ++r) v[16 * nb + r] = pack_idx(acc[r], (unsigned)(32 * nb + 8 * (r >> 2) + 4 * hh + (r & 3)), 0x7fu);
        }
        top16_of_64(v);
        float pv[16];
#pragma unroll
        for (int i = 0; i < 16; ++i) pv[i] = shx(v[i], 32, lane);
        merge_top16(&v[0], pv);
#pragma unroll
        for (int i = 0; i < 16; ++i) ab[p][i] = v[i];
    }
    int e[16]; float gate[16];
    peer_candidates(ab[0], ab[1], e, gate);
    if (hh == 0) { GAS v4u* o = (GAS v4u*)(PIDX + t * 128 + h * 16);
#pragma unroll
        for (int c = 0; c < 4; ++c) o[c] = (v4u){(unsigned)e[4 * c], (unsigned)e[4 * c + 1], (unsigned)e[4 * c + 2], (unsigned)e[4 * c + 3]}; }
    else { GAS f32x4* o = (GAS f32x4*)(PGATE + t * 128 + h * 16);
#pragma unroll
        for (int c = 0; c < 4; ++c) o[c] = (f32x4){gate[4 * c], gate[4 * c + 1], gate[4 * c + 2], gate[4 * c + 3]}; }
}

__device__ __forceinline__ float dot8(const v4u& x, const v4u& u) {
    return bflo(x.x) * bflo(u.x) + bfhi(x.x) * bfhi(u.x) + bflo(x.y) * bflo(u.y) + bfhi(x.y) * bfhi(u.y) + bflo(x.z) * bflo(u.z) + bfhi(x.z) * bfhi(u.z) + bflo(x.w) * bflo(u.w) + bfhi(x.w) * bfhi(u.w);
}
__device__ __forceinline__ void axpy8(float* y, float w, const v4u& v) {
    y[0] += w * bflo(v.x); y[1] += w * bfhi(v.x); y[2] += w * bflo(v.y); y[3] += w * bfhi(v.y); y[4] += w * bflo(v.z); y[5] += w * bfhi(v.z); y[6] += w * bflo(v.w); y[7] += w * bfhi(v.w);
}
__device__ __forceinline__ void peer_gather(const bf16* XN, const bf16* PU, const bf16* PV, const int* PIDX, const float* PGATE, float* X, int gw, int NGW, int lane) {
    for (int t = gw; t < T; t += NGW) {
        v4u xv[4];
#pragma unroll
        for (int j = 0; j < 4; ++j) xv[j] = *(const GAS v4u*)(XN + (size_t)t * DM + 8 * lane + 512 * j);
        float y[32];
#pragma unroll
        for (int i = 0; i < 32; ++i) y[i] = 0.f;
        for (int k = 0; k < 128; k += 2) {
            const int e0 = __builtin_amdgcn_readfirstlane(PIDX[(size_t)t * 128 + k]), e1 = __builtin_amdgcn_readfirstlane(PIDX[(size_t)t * 128 + k + 1]);
            const float g0 = PGATE[(size_t)t * 128 + k], g1 = PGATE[(size_t)t * 128 + k + 1];
            v4u u0[4], u1[4], v0[4], v1[4];
#pragma unroll
            for (int j = 0; j < 4; ++j) { u0[j] = *(const GAS v4u*)(PU + (size_t)e0 * DM + 8 * lane + 512 * j); u1[j] = *(const GAS v4u*)(PU + (size_t)e1 * DM + 8 * lane + 512 * j); }
#pragma unroll
            for (int j = 0; j < 4; ++j) { v0[j] = *(const GAS v4u*)(PV + (size_t)e0 * DM + 8 * lane + 512 * j); v1[j] = *(const GAS v4u*)(PV + (size_t)e1 * DM + 8 * lane + 512 * j); }
            float d0 = 0.f, d1 = 0.f;
#pragma unroll
            for (int j = 0; j < 4; ++j) { d0 += dot8(xv[j], u0[j]); d1 += dot8(xv[j], u1[j]); }
            d0 = wave_sum(d0, lane); d1 = wave_sum(d1, lane);
            const float w0 = g0 * 0.5f * d0 * (1.f + erff(d0 * 0.70710678118654752f)), w1 = g1 * 0.5f * d1 * (1.f + erff(d1 * 0.70710678118654752f));
#pragma unroll
            for (int j = 0; j < 4; ++j) { axpy8(&y[8 * j], w0, v0[j]); axpy8(&y[8 * j], w1, v1[j]); }
        }
#pragma unroll
        for (int j = 0; j < 4; ++j) { GAS f32x4* xp = (GAS f32x4*)(X + (size_t)t * DM + 8 * lane + 512 * j);
            f32x4 a = xp[0], b = xp[1]; a += (f32x4){y[8 * j], y[8 * j + 1], y[8 * j + 2], y[8 * j + 3]}; b += (f32x4){y[8 * j + 4], y[8 * j + 5], y[8 * j + 6], y[8 * j + 7]}; xp[0] = a; xp[1] = b; }
    }
}


typedef float f32x2 __attribute__((ext_vector_type(2)));
constexpr float PU_SCALE = 256.f, PV_SCALE = 16.f;
__device__ __forceinline__ void convert_fp8(const float* src, unsigned char* dst, size_t n, float scale, size_t gtid, size_t nthreads) {
    for (size_t i = gtid * 16; i < n; i += nthreads * 16) {
        v4u o;
#pragma unroll
        for (int c = 0; c < 4; ++c) { f32x4 a = *(const GAS f32x4*)(src + i + 4 * c) * scale;
#pragma unroll
            for (int e = 0; e < 4; ++e) a[e] = fminf(fmaxf(a[e], -448.f), 448.f);
            int p = 0; p = __builtin_amdgcn_cvt_pk_fp8_f32(a[0], a[1], p, false); p = __builtin_amdgcn_cvt_pk_fp8_f32(a[2], a[3], p, true); o[c] = (unsigned)p; }
        *(GAS v4u*)(dst + i) = o;
    }
}
__device__ __forceinline__ void dot16_fp8(f32x2& acc, const v4u& w, const f32x2* x) {
#pragma unroll
    for (int c = 0; c < 4; ++c) { acc += __builtin_amdgcn_cvt_pk_f32_fp8((int)w[c], false) * x[2 * c]; acc += __builtin_amdgcn_cvt_pk_f32_fp8((int)w[c], true) * x[2 * c + 1]; }
}
__device__ __forceinline__ void axpy16_fp8(f32x2* y, const f32x2 wv, const v4u& w) {
#pragma unroll
    for (int c = 0; c < 4; ++c) { y[2 * c] += __builtin_amdgcn_cvt_pk_f32_fp8((int)w[c], false) * wv; y[2 * c + 1] += __builtin_amdgcn_cvt_pk_f32_fp8((int)w[c], true) * wv; }
}
#define PG_R 4
#define PG_LOAD(buf, tab, idlo, idhi, g) do { _Pragma("unroll") for (int i_ = 0; i_ < PG_R; ++i_) { const int k_ = (g) * PG_R + i_; \
        const int e_ = __builtin_amdgcn_readlane(k_ < 64 ? idlo : idhi, k_ & 63); const unsigned char* rp_ = (tab) + (size_t)(unsigned)e_ * 2048u; \
        buf[i_][0] = *(const GAS v4u*)(rp_ + voff); buf[i_][1] = *(const GAS v4u*)(rp_ + voff + 1024); } } while (0)
#define PG_DOT(buf, g) do { float p_[4]; _Pragma("unroll") for (int i_ = 0; i_ < 4; ++i_) { f32x2 a_ = {0.f, 0.f}; dot16_fp8(a_, buf[i_][0], &x[0]); dot16_fp8(a_, buf[i_][1], &x[8]); p_[i_] = a_.x + a_.y; __builtin_amdgcn_sched_barrier(0); } \
        float r_[2]; _Pragma("unroll") for (int i_ = 0; i_ < 2; ++i_) { const float keep_ = b5 ? p_[i_ + 2] : p_[i_], send_ = b5 ? p_[i_] : p_[i_ + 2]; r_[i_] = keep_ + shx(send_, 32, lane); } \
        float s_; { const float keep_ = b4 ? r_[1] : r_[0], send_ = b4 ? r_[0] : r_[1]; s_ = keep_ + shx(send_, 16, lane); } \
        s_ += shx(s_, 8, lane); s_ += shx(s_, 4, lane); s_ += shx(s_, 2, lane); s_ += shx(s_, 1, lane); \
        if ((lane & 15) == 0) wl[(g) * 4 + (lane >> 4)] = s_; } while (0)
#define PG_AXPY(buf, g) do { _Pragma("unroll") for (int i_ = 0; i_ < PG_R; ++i_) { const float w_ = wl[(g) * PG_R + i_]; const f32x2 wv_ = {w_, w_}; axpy16_fp8(&y[0], wv_, buf[i_][0]); axpy16_fp8(&y[8], wv_, buf[i_][1]); __builtin_amdgcn_sched_barrier(0); } } while (0)
__device__ __forceinline__ void peer_gather8(const bf16* XN, const unsigned char* PU8, const unsigned char* PV8, const int* PIDX, const float* PGATE, float* X, LAS float* wl, int gw, int NGW, int lane) {
    const bool b5 = (lane >> 5) & 1, b4 = (lane >> 4) & 1; const unsigned voff = 16u * (unsigned)lane;
    for (int t = gw; t < T; t += NGW) {
        const unsigned l4 = 4u * (unsigned)lane; const char* pidx_t = (const char*)(PIDX + (size_t)t * 128); const char* pgate_t = (const char*)(PGATE + (size_t)t * 128);
        const int idlo = *(const GAS int*)(pidx_t + l4), idhi = *(const GAS int*)(pidx_t + l4 + 256);
        v4u A[PG_R][2], B[PG_R][2];
        PG_LOAD(A, PU8, idlo, idhi, 0);
        f32x2 x[16];
        {   const char* xr = (const char*)(XN + (size_t)t * DM); const unsigned l32 = 32u * (unsigned)lane;
            const v4u a0 = *(const GAS v4u*)(xr + l32), a1 = *(const GAS v4u*)(xr + l32 + 16), c0 = *(const GAS v4u*)(xr + l32 + 2048), c1 = *(const GAS v4u*)(xr + l32 + 2064);
#pragma unroll
            for (int c = 0; c < 4; ++c) { x[c] = (f32x2){bflo(a0[c]), bfhi(a0[c])} * (1.f / PU_SCALE); x[4 + c] = (f32x2){bflo(a1[c]), bfhi(a1[c])} * (1.f / PU_SCALE);
                                          x[8 + c] = (f32x2){bflo(c0[c]), bfhi(c0[c])} * (1.f / PU_SCALE); x[12 + c] = (f32x2){bflo(c1[c]), bfhi(c1[c])} * (1.f / PU_SCALE); } }
#pragma unroll 1
        for (int g = 0; g < 128 / PG_R; g += 2) {
            PG_LOAD(B, PU8, idlo, idhi, g + 1);
            PG_DOT(A, g);
            if (g + 2 < 128 / PG_R) PG_LOAD(A, PU8, idlo, idhi, g + 2); else PG_LOAD(A, PV8, idlo, idhi, 0);
            PG_DOT(B, g + 1);
        }
        LDS_WAIT();
        {
            const float g0 = *(const GAS float*)(pgate_t + l4), g1 = *(const GAS float*)(pgate_t + l4 + 256);
            const float d0 = wl[lane], d1 = wl[64 + lane];
            const float w0 = g0 * 0.5f * d0 * (1.f + erff(d0 * 0.70710678118654752f)) * (1.f / PV_SCALE), w1 = g1 * 0.5f * d1 * (1.f + erff(d1 * 0.70710678118654752f)) * (1.f / PV_SCALE);
            LDS_WAIT(); asm volatile("" ::: "memory");
            wl[lane] = w0; wl[64 + lane] = w1;
            LDS_WAIT(); asm volatile("" ::: "memory");
        }
        f32x2 y[16];
#pragma unroll
        for (int i = 0; i < 16; ++i) y[i] = (f32x2){0.f, 0.f};
#pragma unroll 1
        for (int g = 0; g < 128 / PG_R; g += 2) {
            PG_LOAD(B, PV8, idlo, idhi, g + 1);
            PG_AXPY(A, g);
            if (g + 2 < 128 / PG_R) PG_LOAD(A, PV8, idlo, idhi, g + 2);
            PG_AXPY(B, g + 1);
        }
        {   char* xo = (char*)(X + (size_t)t * DM); const unsigned l64 = 64u * (unsigned)lane;
#pragma unroll
            for (int h = 0; h < 2; ++h)
#pragma unroll
                for (int c = 0; c < 4; ++c) { GAS f32x4* p = (GAS f32x4*)(xo + l64 + 4096 * h + 16 * c); f32x4 v = *p; v += (f32x4){y[8 * h + 2 * c].x, y[8 * h + 2 * c].y, y[8 * h + 2 * c + 1].x, y[8 * h + 2 * c + 1].y}; *p = v; } }
        LDS_WAIT(); asm volatile("" ::: "memory");
    }
}


typedef unsigned v6u __attribute__((ext_vector_type(6)));
typedef float v32f __attribute__((ext_vector_type(32)));
typedef v4u __attribute__((aligned(8))) v4u_a8;
constexpr float PU_SCALE6 = 90.0f, PV_SCALE6 = 5.65f;
__device__ __forceinline__ unsigned enc_e2m3(float v) {
    const float a = fminf(fabsf(v), 7.5f);
    unsigned code;
    if (a < 1.0f) code = (unsigned)__builtin_rintf(a * 8.f);
    else { const unsigned b = __builtin_bit_cast(unsigned, a) - 0x3F800000u; code = ((b + 0x7FFFFu + ((b >> 20) & 1u)) >> 20) + 8u; }
    return code | (v < 0.f ? 32u : 0u);
}
__device__ __forceinline__ void convert_fp6_rows(const float* src, unsigned char* dst, int nrows, float scale, const float* gain, int gw, int NGW, int lane) {
    for (int r = gw; r < nrows; r += NGW) {
        const float* sp = src + (size_t)r * DM + 4 * lane; const float* gp = gain ? gain + (size_t)(r / PEER_N) * DM + 4 * lane : nullptr;
        unsigned w[6] = {0u, 0u, 0u, 0u, 0u, 0u};
#pragma unroll
        for (int j = 0; j < 8; ++j) { f32x4 a = *(const GAS f32x4*)(sp + 256 * j) * scale; if (gp) a = a * *(const GAS f32x4*)(gp + 256 * j);
#pragma unroll
            for (int e = 0; e < 4; ++e) { const unsigned code = enc_e2m3(a[e]); const int bp = 6 * (4 * j + e), wi = bp >> 5, sh = bp & 31;
                w[wi] |= code << sh; if (sh > 26) w[wi + 1] |= code >> (32 - sh); } }
        unsigned char* dp = dst + (size_t)r * 1536 + 24 * lane;
        *(GAS v4u_a8*)dp = (v4u){w[0], w[1], w[2], w[3]}; *(GAS v2u*)(dp + 16) = (v2u){w[4], w[5]};
    }
}
#ifndef PG6_R
#define PG6_R 8
#endif
#define PG6_LOAD(buf, tab, idlo, idhi, g) do { _Pragma("unroll") for (int i_ = 0; i_ < PG6_R; ++i_) { const int k_ = (g) * PG6_R + i_; \
        const int e_ = __builtin_amdgcn_readlane(k_ < 64 ? idlo : idhi, k_ & 63); const unsigned char* rp_ = (tab) + (size_t)(unsigned)e_ * 1536u; \
        const v4u a_ = *(const GAS v4u_a8*)(rp_ + voff); const v2u b_ = *(const GAS v2u*)(rp_ + voff + 16); buf[i_] = (v6u){a_.x, a_.y, a_.z, a_.w, b_.x, b_.y}; } } while (0)
#define PG6_DOT1(buf, i_, dst) do { const v32f f_ = __builtin_amdgcn_cvt_scalef32_pk32_f32_fp6(buf[i_], 1.0f); f32x2 a_ = {0.f, 0.f}; \
        _Pragma("unroll") for (int c_ = 0; c_ < 16; ++c_) a_ += (f32x2){f_[2 * c_], f_[2 * c_ + 1]} * x[c_]; dst = a_.x + a_.y; __builtin_amdgcn_sched_barrier(0); } while (0)
#if PG6_R == 8
#define PG6_DOT(buf, g) do { float p_[8]; _Pragma("unroll") for (int i_ = 0; i_ < 8; ++i_) PG6_DOT1(buf, i_, p_[i_]); \
        float q_[4]; _Pragma("unroll") for (int i_ = 0; i_ < 4; ++i_) { const float keep_ = b5 ? p_[i_ + 4] : p_[i_], send_ = b5 ? p_[i_] : p_[i_ + 4]; q_[i_] = keep_ + shx(send_, 32, lane); } \
        float r_[2]; _Pragma("unroll") for (int i_ = 0; i_ < 2; ++i_) { const float keep_ = b4 ? q_[i_ + 2] : q_[i_], send_ = b4 ? q_[i_] : q_[i_ + 2]; r_[i_] = keep_ + shx(send_, 16, lane); } \
        float s_; { const float keep_ = b3 ? r_[1] : r_[0], send_ = b3 ? r_[0] : r_[1]; s_ = keep_ + shx(send_, 8, lane); } \
        s_ += shx(s_, 4, lane); s_ += shx(s_, 2, lane); s_ += shx(s_, 1, lane); \
        if ((lane & 7) == 0) wl[(g) * 8 + (lane >> 3)] = s_; } while (0)
#else
#define PG6_DOT(buf, g) do { float p_[4]; _Pragma("unroll") for (int i_ = 0; i_ < 4; ++i_) PG6_DOT1(buf, i_, p_[i_]); \
        float r_[2]; _Pragma("unroll") for (int i_ = 0; i_ < 2; ++i_) { const float keep_ = b5 ? p_[i_ + 2] : p_[i_], send_ = b5 ? p_[i_] : p_[i_ + 2]; r_[i_] = keep_ + shx(send_, 32, lane); } \
        float s_; { const float keep_ = b4 ? r_[1] : r_[0], send_ = b4 ? r_[0] : r_[1]; s_ = keep_ + shx(send_, 16, lane); } \
        s_ += shx(s_, 8, lane); s_ += shx(s_, 4, lane); s_ += shx(s_, 2, lane); s_ += shx(s_, 1, lane); \
        if ((lane & 15) == 0) wl[(g) * 4 + (lane >> 4)] = s_; } while (0)
#endif
#define PG6_AXPY(buf, g) do { _Pragma("unroll") for (int i_ = 0; i_ < PG6_R; ++i_) { const float w_ = wl[(g) * PG6_R + i_]; const f32x2 wv_ = {w_, w_}; \
        const v32f f_ = __builtin_amdgcn_cvt_scalef32_pk32_f32_fp6(buf[i_], 1.0f); _Pragma("unroll") for (int c_ = 0; c_ < 16; ++c_) y[c_] += (f32x2){f_[2 * c_], f_[2 * c_ + 1]} * wv_; __builtin_amdgcn_sched_barrier(0); } } while (0)
__device__ __forceinline__ void peer_gather6(bf16* XN, const unsigned char* PU6, const unsigned char* PV6, const int* PIDX, const float* PGATE, float* X, const u64_t* rowsq_in, u64_t* rowsq_out, LAS float* wl, int gw, int NGW, int lane) {
    const bool b5 = (lane >> 5) & 1, b4 = (lane >> 4) & 1, b3 = (lane >> 3) & 1; (void)b3;
    const unsigned voff = 24u * (unsigned)lane, l4 = 4u * (unsigned)lane, l8 = 8u * (unsigned)lane, l16 = 16u * (unsigned)lane;
    constexpr int NG = 128 / PG6_R;
    for (int t = gw; t < T; t += NGW) {
        const char* pidx_t = (const char*)(PIDX + (size_t)t * 128); const char* pgate_t = (const char*)(PGATE + (size_t)t * 128);
        const int idlo = *(const GAS int*)(pidx_t + l4), idhi = *(const GAS int*)(pidx_t + l4 + 256);
        v6u A[PG6_R], B[PG6_R];
        PG6_LOAD(A, PU6, idlo, idhi, 0);
        f32x2 x[16];
        {   const char* xr = (const char*)(XN + (size_t)t * DM); const float xs = (1.f / PU_SCALE6) * rowsq_rs(rowsq_in, t);
#pragma unroll
            for (int j = 0; j < 8; ++j) { const v2u a = *(const GAS v2u*)(xr + l8 + 512 * j); x[2 * j] = (f32x2){bflo(a.x), bfhi(a.x)} * xs; x[2 * j + 1] = (f32x2){bflo(a.y), bfhi(a.y)} * xs; } }
#pragma unroll 1
        for (int g = 0; g < NG; g += 2) {
            PG6_LOAD(B, PU6, idlo, idhi, g + 1);
            PG6_DOT(A, g);
            if (g + 2 < NG) PG6_LOAD(A, PU6, idlo, idhi, g + 2); else PG6_LOAD(A, PV6, idlo, idhi, 0);
            PG6_DOT(B, g + 1);
        }
        LDS_WAIT();
        {   const float g0 = *(const GAS float*)(pgate_t + l4), g1 = *(const GAS float*)(pgate_t + l4 + 256);
            const float d0 = wl[lane], d1 = wl[64 + lane];
            const float w0 = g0 * 0.5f * d0 * (1.f + erff(d0 * 0.70710678118654752f)) * (1.f / PV_SCALE6), w1 = g1 * 0.5f * d1 * (1.f + erff(d1 * 0.70710678118654752f)) * (1.f / PV_SCALE6);
            LDS_WAIT(); asm volatile("" ::: "memory");
            wl[lane] = w0; wl[64 + lane] = w1;
            LDS_WAIT(); asm volatile("" ::: "memory");
        }
        f32x2 y[16];
#pragma unroll
        for (int i = 0; i < 16; ++i) y[i] = (f32x2){0.f, 0.f};
#pragma unroll 1
        for (int g = 0; g < NG; g += 2) {
            PG6_LOAD(B, PV6, idlo, idhi, g + 1);
            PG6_AXPY(A, g);
            if (g + 2 < NG) PG6_LOAD(A, PV6, idlo, idhi, g + 2);
            PG6_AXPY(B, g + 1);
        }
        {   char* xo = (char*)(X + (size_t)t * DM);
            char* xbo = (char*)(XN + (size_t)t * DM); float ss = 0.f;
#pragma unroll
            for (int j = 0; j < 8; ++j) { const v2u a = *(const GAS v2u*)(xbo + l8 + 512 * j); f32x4 v = (f32x4){bflo(a.x), bfhi(a.x), bflo(a.y), bfhi(a.y)}; v += (f32x4){y[2 * j].x, y[2 * j].y, y[2 * j + 1].x, y[2 * j + 1].y};
                if (X) *(GAS f32x4*)(xo + l16 + 1024 * j) = v;
                ss += (v[0] * v[0] + v[1] * v[1]) + (v[2] * v[2] + v[3] * v[3]); *(GAS v2u*)(xbo + l8 + 512 * j) = (v2u){pk2(v[0], v[1]), pk2(v[2], v[3])}; }
            if (rowsq_out) { ss = wave_sum(ss, lane); if (lane == 0) rowsq_out[t] = rowsq_fx(ss); } }
        LDS_WAIT(); asm volatile("" ::: "memory");
    }
}

typedef short s16x4 __attribute__((ext_vector_type(4)));
typedef __attribute__((address_space(3))) const char* lds_cptr;
__device__ __forceinline__ s16x4 vtr(lds_cptr p) { return __builtin_bit_cast(s16x4, __builtin_amdgcn_ds_read_tr16_b64_v4i16((__attribute__((address_space(3))) s16x4*)p)); }
__device__ __forceinline__ unsigned cvtpk(float lo, float hi) { unsigned r; asm("v_cvt_pk_bf16_f32 %0, %1, %2" : "=v"(r) : "v"(lo), "v"(hi)); return r; }
constexpr int AT_K0 = 0, AT_V0 = 16384, AT_TAB = 32768;
constexpr float LOG2E = 1.4426950408889634f;
template <int TYPE>
__device__ __forceinline__ void attn_unit(LAS unsigned char* lds, const bf16* QKV, bf16* ATT, int b, int head, int qb, const float* tabsrc, float Cl2, float sinkl2, int tid) {
    const int lane = tid & 63, w = __builtin_amdgcn_readfirstlane(tid >> 6), hh = lane >> 5, l31 = lane & 31;
    int qcol, kcol, vcol, ocol;
    if (TYPE == 0) { qcol = QA + head * 64; kcol = KA + (head / 3) * 64; vcol = VA + (head / 3) * 64; ocol = OA + head * 64; }
    else if (TYPE == 1) { qcol = QB + head * 64; kcol = KB + head * 64; vcol = VB + head * 64; ocol = OB + head * 64; }
    else { qcol = QC + head * 64; kcol = KC + (head / 3) * 64; vcol = VC + (head / 3) * 64; ocol = OC + head * 64; }
    const int q0 = 256 * qb + 32 * w, qpos = q0 + l31;
    int t_begin, t_end;
    if (TYPE == 0) { t_begin = 4 * qb - 2; if (t_begin < 0) t_begin = 0; t_end = 4 * qb + 6; if (t_end > 32) t_end = 32; }
    else if (TYPE == 1) { int a = 4 * qb - 4; a = a < 0 ? 0 : (a > 24 ? 24 : a); int e = 4 * qb - 1; e = e < 0 ? 0 : (e > 24 ? 24 : e); t_begin = a; t_end = e + 8; }
    else { t_begin = 0; t_end = 32; }
    LAS float* tab = (LAS float*)(lds + AT_TAB);
    if (TYPE == 0) { for (int i = tid; i < 1024; i += NTHREADS) { const int rel = i - 448; tab[i] = (rel >= -128 && rel <= 128) ? tabsrc[head * 257 + rel + 128] * LOG2E - Cl2 : -1e30f; } }
    if (TYPE == 1) { for (int i = tid; i < 15 * 31; i += NTHREADS) tab[i] = tabsrc[head * 465 + i] * LOG2E - Cl2; }
    bf16x8 qf[4];
    {   const bf16* qp = QKV + ((size_t)b * SEQ + qpos) * DIN + qcol + 8 * hh;
#pragma unroll
        for (int s = 0; s < 4; ++s) qf[s] = *(const GAS bf16x8*)(qp + 16 * s); }
    const int srow = tid >> 3, sch = tid & 7;
    const bf16* kg = QKV + ((size_t)b * SEQ + srow) * DIN + kcol + sch * 8;
    const bf16* vg = QKV + ((size_t)b * SEQ + srow) * DIN + vcol + sch * 8;
    const int kst = srow * 128 + ((sch ^ ((srow >> 1) & 7)) * 16);
    const int vst = srow * 128 + (((sch >> 2) ^ ((srow >> 1) & 1)) * 64) + (sch & 3) * 16;
    int kread[4], vread[2];
#pragma unroll
    for (int s = 0; s < 4; ++s) kread[s] = l31 * 128 + (((2 * s + hh) ^ ((lane >> 1) & 7)) * 16);
#pragma unroll
    for (int db = 0; db < 2; ++db) vread[db] = (4 * hh + ((lane >> 2) & 3)) * 128 + ((db ^ ((lane >> 3) & 1)) * 64) + 32 * ((lane >> 4) & 1) + 8 * (lane & 3);
    f32x16 O0, O1;
#pragma unroll
    for (int r = 0; r < 16; ++r) { O0[r] = 0.f; O1[r] = 0.f; }
    float lsum = 0.f;
    const int rw = 4 * qb + (w >> 1), cq = 32 * (w & 1) + l31;
    int r0w = rw - 4; r0w = r0w < 0 ? 0 : (r0w > 24 ? 24 : r0w);
    int c0 = cq - 8; c0 = c0 < 0 ? 0 : (c0 > 48 ? 48 : c0);
    {   const v4u kr = *(const GAS v4u*)(kg + (size_t)t_begin * 64 * DIN), vr = *(const GAS v4u*)(vg + (size_t)t_begin * 64 * DIN);
        *(LAS v4u*)(lds + AT_K0 + kst) = kr; *(LAS v4u*)(lds + AT_V0 + vst) = vr; }
    __syncthreads();
    for (int t = t_begin; t < t_end; ++t) {
        const int cur = (t - t_begin) & 1;
        v4u kr, vr;
        if (t + 1 < t_end) { kr = *(const GAS v4u*)(kg + (size_t)(t + 1) * 64 * DIN); vr = *(const GAS v4u*)(vg + (size_t)(t + 1) * 64 * DIN); }
        bool need = true;
        if (TYPE == 0) need = (64 * t <= q0 + 31 + 128) && (64 * t + 63 >= q0 - 128);
        if (TYPE == 1) need = (t >= r0w) && (t < r0w + 8);
        if (need) {
            const lds_cptr kb_ = (lds_cptr)(lds + AT_K0 + cur * 8192), vb_ = (lds_cptr)(lds + AT_V0 + cur * 8192);
            bf16x8 kf[8];
#pragma unroll
            for (int s = 0; s < 4; ++s) { kf[2 * s] = *(const LAS bf16x8*)(kb_ + kread[s]); kf[2 * s + 1] = *(const LAS bf16x8*)(kb_ + kread[s] + 4096); }
            f32x16 S0, S1;
            if (TYPE == 2) {
#pragma unroll
                for (int r = 0; r < 16; ++r) { S0[r] = -Cl2; S1[r] = -Cl2; }
            } else if (TYPE == 0) {
                const LAS float* tb = tab + (64 * t - qpos + 448 + 4 * hh);
#pragma unroll
                for (int r = 0; r < 16; ++r) { S0[r] = tb[8 * (r >> 2) + (r & 3)]; S1[r] = tb[32 + 8 * (r >> 2) + (r & 3)]; }
            } else {
                const LAS float* tb = tab + ((t - rw + 7) * 31 - cq + 15 + 4 * hh);
                const int kc0 = 4 * hh - c0;
#pragma unroll
                for (int r = 0; r < 16; ++r) { const int ka = 8 * (r >> 2) + (r & 3), kb2 = 32 + ka;
                    S0[r] = ((unsigned)(ka + kc0) < 16u) ? tb[ka] : -1e30f; S1[r] = ((unsigned)(kb2 + kc0) < 16u) ? tb[kb2] : -1e30f; }
            }
            __builtin_amdgcn_sched_barrier(0);
#pragma unroll
            for (int s = 0; s < 4; ++s) { S0 = __builtin_amdgcn_mfma_f32_32x32x16_bf16(kf[2 * s], qf[s], S0, 0, 0, 0); S1 = __builtin_amdgcn_mfma_f32_32x32x16_bf16(kf[2 * s + 1], qf[s], S1, 0, 0, 0); }
            s16x4 vf[4][2][2];
#pragma unroll
            for (int ks = 0; ks < 2; ++ks)
#pragma unroll
                for (int db = 0; db < 2; ++db) { vf[ks][db][0] = vtr(vb_ + vread[db] + (16 * ks) * 128); vf[ks][db][1] = vtr(vb_ + vread[db] + (16 * ks + 8) * 128); }
            __builtin_amdgcn_sched_barrier(0);
#pragma unroll
            for (int r = 0; r < 16; ++r) { S0[r] = __builtin_amdgcn_exp2f(S0[r]); S1[r] = __builtin_amdgcn_exp2f(S1[r]); }
#pragma unroll
            for (int r = 0; r < 16; ++r) lsum += S0[r] + S1[r];
            bf16x8 pb[4];
#pragma unroll
            for (int hf = 0; hf < 2; ++hf) {
                v4u a, c;
#pragma unroll
                for (int j = 0; j < 4; ++j) { a[j] = cvtpk(S0[8 * hf + 2 * j], S0[8 * hf + 2 * j + 1]); c[j] = cvtpk(S1[8 * hf + 2 * j], S1[8 * hf + 2 * j + 1]); }
                pb[hf] = __builtin_bit_cast(bf16x8, a); pb[2 + hf] = __builtin_bit_cast(bf16x8, c);
            }
#pragma unroll
            for (int ks = 2; ks < 4; ++ks)
#pragma unroll
                for (int db = 0; db < 2; ++db) { vf[ks][db][0] = vtr(vb_ + vread[db] + (16 * ks) * 128); vf[ks][db][1] = vtr(vb_ + vread[db] + (16 * ks + 8) * 128); }
            __builtin_amdgcn_sched_barrier(0);
#pragma unroll
            for (int ks = 0; ks < 4; ++ks) {
                const bf16x8 va = __builtin_shufflevector(vf[ks][0][0], vf[ks][0][1], 0, 1, 2, 3, 4, 5, 6, 7), vb2 = __builtin_shufflevector(vf[ks][1][0], vf[ks][1][1], 0, 1, 2, 3, 4, 5, 6, 7);
                O0 = __builtin_amdgcn_mfma_f32_32x32x16_bf16(va, pb[ks], O0, 0, 0, 0); O1 = __builtin_amdgcn_mfma_f32_32x32x16_bf16(vb2, pb[ks], O1, 0, 0, 0);
            }
        }
        __builtin_amdgcn_sched_barrier(0);
        if (t + 1 < t_end) { *(LAS v4u*)(lds + AT_K0 + (cur ^ 1) * 8192 + kst) = kr; *(LAS v4u*)(lds + AT_V0 + (cur ^ 1) * 8192 + vst) = vr; }
        __syncthreads();
    }
    lsum += shx(lsum, 32, lane);
    if (TYPE == 0) lsum += __builtin_amdgcn_exp2f(sinkl2 - Cl2);
    const float inv = 1.f / lsum;
    bf16* op = ATT + ((size_t)b * SEQ + qpos) * DM + ocol + 4 * hh;
#pragma unroll
    for (int g4 = 0; g4 < 4; ++g4) {
        v2u o0, o1; o0.x = cvtpk(O0[4 * g4] * inv, O0[4 * g4 + 1] * inv); o0.y = cvtpk(O0[4 * g4 + 2] * inv, O0[4 * g4 + 3] * inv);
        o1.x = cvtpk(O1[4 * g4] * inv, O1[4 * g4 + 1] * inv); o1.y = cvtpk(O1[4 * g4 + 2] * inv, O1[4 * g4 + 3] * inv);
        *(GAS v2u*)(op + 8 * g4) = o0; *(GAS v2u*)(op + 32 + 8 * g4) = o1;
    }
}


constexpr int MA_K0 = 0, MA_V0 = 32768;
__device__ __forceinline__ void mem_unit(LAS unsigned char* lds, const bf16* QM, const bf16* KVM, bf16* OM, const float* gq, int tb, int head, float Cl2, int tid) {
    const int lane = tid & 63, w = __builtin_amdgcn_readfirstlane(tid >> 6), hh = lane >> 5, l31 = lane & 31;
    const size_t trow = (size_t)tb * 256 + 32 * w + l31; const int b = tb >> 3;
    bf16x8 qf[8];
    {   const bf16* qp = QM + trow * MEMW + head * 128 + 8 * hh;
#pragma unroll
        for (int s = 0; s < 8; ++s) qf[s] = *(const GAS bf16x8*)(qp + 16 * s);
        float ss = 0.f;
#pragma unroll
        for (int s = 0; s < 8; ++s)
#pragma unroll
            for (int j = 0; j < 8; ++j) { const float f = __builtin_bit_cast(float, (unsigned)(unsigned short)qf[s][j] << 16); ss += f * f; }
        ss += shx(ss, 32, lane);
        const float r = 0.12751743074602468f / sqrtf(ss * (1.f / 128.f) + EPS);
#pragma unroll
        for (int s = 0; s < 8; ++s) { const f32x4 g0 = *(const GAS f32x4*)(gq + 16 * s + 8 * hh), g1 = *(const GAS f32x4*)(gq + 16 * s + 8 * hh + 4);
            v4u o;
#pragma unroll
            for (int j = 0; j < 4; ++j) { const float f0 = __builtin_bit_cast(float, (unsigned)(unsigned short)qf[s][2 * j] << 16), f1 = __builtin_bit_cast(float, (unsigned)(unsigned short)qf[s][2 * j + 1] << 16);
                const float ga = (2 * j < 4) ? g0[2 * j] : g1[2 * j - 4], gb2 = (2 * j + 1 < 4) ? g0[2 * j + 1] : g1[2 * j + 1 - 4];
                o[j] = cvtpk(f0 * r * ga, f1 * r * gb2); }
            qf[s] = __builtin_bit_cast(bf16x8, o); }
    }
    const int srow = tid >> 3, sch = tid & 7;
    const bf16* kg = KVM + ((size_t)b * NMEM + srow) * 1024 + head * 128 + sch * 8;
    const bf16* vg = kg + 512;
    const int kst0 = srow * 256 + ((sch ^ (srow & 15)) * 16), kst1 = srow * 256 + (((sch + 8) ^ (srow & 15)) * 16);
    const int vst0 = srow * 256 + ((((sch) >> 2) ^ (srow & 3)) * 64) + (sch & 3) * 16, vst1 = srow * 256 + ((((sch + 8) >> 2) ^ (srow & 3)) * 64) + (sch & 3) * 16;
    int kread[8], vread[4];
#pragma unroll
    for (int s = 0; s < 8; ++s) kread[s] = l31 * 256 + (((2 * s + hh) ^ (l31 & 15)) * 16);
#pragma unroll
    for (int db = 0; db < 4; ++db) vread[db] = (4 * hh + ((lane >> 2) & 3)) * 256 + ((db ^ ((lane >> 2) & 3)) * 64) + 32 * ((lane >> 4) & 1) + 8 * (lane & 3);
    f32x16 O[4];
#pragma unroll
    for (int db = 0; db < 4; ++db)
#pragma unroll
        for (int r = 0; r < 16; ++r) O[db][r] = 0.f;
    float lsum = 0.f;
    {   const v4u k0 = *(const GAS v4u*)kg, k1 = *(const GAS v4u*)(kg + 64), v0 = *(const GAS v4u*)vg, v1 = *(const GAS v4u*)(vg + 64);
        *(LAS v4u*)(lds + MA_K0 + kst0) = k0; *(LAS v4u*)(lds + MA_K0 + kst1) = k1; *(LAS v4u*)(lds + MA_V0 + vst0) = v0; *(LAS v4u*)(lds + MA_V0 + vst1) = v1; }
    __syncthreads();
#pragma unroll 1
    for (int t = 0; t < 4; ++t) {
        const int cur = t & 1;
        v4u k0, k1, v0, v1;
        if (t + 1 < 4) { const bf16* kn = kg + (size_t)(t + 1) * 64 * 1024; k0 = *(const GAS v4u*)kn; k1 = *(const GAS v4u*)(kn + 64); v0 = *(const GAS v4u*)(kn + 512); v1 = *(const GAS v4u*)(kn + 576); }
        const lds_cptr kb_ = (lds_cptr)(lds + MA_K0 + cur * 16384), vb_ = (lds_cptr)(lds + MA_V0 + cur * 16384);
        f32x16 S0, S1;
#pragma unroll
        for (int r = 0; r < 16; ++r) { S0[r] = -Cl2; S1[r] = -Cl2; }
#pragma unroll
        for (int s = 0; s < 8; ++s) { const bf16x8 a0 = *(const LAS bf16x8*)(kb_ + kread[s]), a1 = *(const LAS bf16x8*)(kb_ + kread[s] + 8192);
            S0 = __builtin_amdgcn_mfma_f32_32x32x16_bf16(a0, qf[s], S0, 0, 0, 0); S1 = __builtin_amdgcn_mfma_f32_32x32x16_bf16(a1, qf[s], S1, 0, 0, 0); }
#pragma unroll
        for (int r = 0; r < 16; ++r) { S0[r] = __builtin_amdgcn_exp2f(S0[r]); S1[r] = __builtin_amdgcn_exp2f(S1[r]); lsum += S0[r] + S1[r]; }
        bf16x8 pb[4];
#pragma unroll
        for (int hf = 0; hf < 2; ++hf) {
            v4u a, c;
#pragma unroll
            for (int j = 0; j < 4; ++j) { a[j] = cvtpk(S0[8 * hf + 2 * j], S0[8 * hf + 2 * j + 1]); c[j] = cvtpk(S1[8 * hf + 2 * j], S1[8 * hf + 2 * j + 1]); }
            pb[hf] = __builtin_bit_cast(bf16x8, a); pb[2 + hf] = __builtin_bit_cast(bf16x8, c);
        }
#pragma unroll
        for (int ks = 0; ks < 4; ++ks)
#pragma unroll
            for (int db = 0; db < 4; ++db) {
                const s16x4 a0 = vtr(vb_ + vread[db] + (16 * ks) * 256), a1 = vtr(vb_ + vread[db] + (16 * ks + 8) * 256);
                const bf16x8 va = __builtin_shufflevector(a0, a1, 0, 1, 2, 3, 4, 5, 6, 7);
                O[db] = __builtin_amdgcn_mfma_f32_32x32x16_bf16(va, pb[ks], O[db], 0, 0, 0);
            }
        if (t + 1 < 4) { LAS unsigned char* kn = lds + MA_K0 + (cur ^ 1) * 16384; LAS unsigned char* vn = lds + MA_V0 + (cur ^ 1) * 16384;
            *(LAS v4u*)(kn + kst0) = k0; *(LAS v4u*)(kn + kst1) = k1; *(LAS v4u*)(vn + vst0) = v0; *(LAS v4u*)(vn + vst1) = v1; }
        __syncthreads();
    }
    lsum += shx(lsum, 32, lane);
    const float inv = 1.f / lsum;
    bf16* op = OM + trow * MEMW + head * 128 + 4 * hh;
#pragma unroll
    for (int db = 0; db < 4; ++db)
#pragma unroll
        for (int g4 = 0; g4 < 4; ++g4) { v2u o; o.x = cvtpk(O[db][4 * g4] * inv, O[db][4 * g4 + 1] * inv); o.y = cvtpk(O[db][4 * g4 + 2] * inv, O[db][4 * g4 + 3] * inv); *(GAS v2u*)(op + 32 * db + 8 * g4) = o; }
}

__device__ __forceinline__ float wave_max(float v, int lane) {
#pragma unroll
    for (int o = 1; o < 64; o <<= 1) v = fmaxf(v, shx(v, o, lane));
    return v;
}
struct Args { const float* in[23]; float* out; unsigned char* ws; int ph_lo, ph_hi, use_bar, pad; };
#ifndef MK_OFF
#define MK_OFF 0u
#endif
#ifndef REP_ATT
#define REP_ATT 1
#endif
#ifndef REP_GEMM
#define REP_GEMM 1
#endif
#ifndef REP_NORM
#define REP_NORM 1
#endif
#ifndef REP_SEL
#define REP_SEL 1
#endif
#ifndef REP_MEM
#define REP_MEM 1
#endif
#define PHON(k) (!((MK_OFF >> (k)) & 1u))
constexpr int PH_PER_LAYER = 10, PH_BASE = 3, N_PHASES = PH_BASE + DEPTH * PH_PER_LAYER;
constexpr int PTAB_OFF = LDSCTL_OFF + 1024;

__global__ void __launch_bounds__(NTHREADS, 2) mega(Args a) {
    extern __shared__ __attribute__((aligned(16))) unsigned char lds_raw[];
    LAS unsigned char* lds = (LAS unsigned char*)lds_raw;
    {   const int tid0 = threadIdx.x;
        for (int u = tid0; u < (LDS_BYTES - LDSCTL_OFF) / 4; u += NTHREADS) ((LAS unsigned*)(lds + LDSCTL_OFF))[u] = 0u;
        __syncthreads();
        if (tid0 < 23) ((LAS unsigned long long*)(lds + PTAB_OFF))[tid0] = (unsigned long long)a.in[tid0];
        if (tid0 == 23) ((LAS unsigned long long*)(lds + PTAB_OFF))[23] = (unsigned long long)a.out;
        if (tid0 == 24) ((LAS unsigned long long*)(lds + PTAB_OFF))[24] = (unsigned long long)a.ws;
        __syncthreads();
    }
    volatile LAS unsigned* MISC = (volatile LAS unsigned*)(lds + MISC_OFF);
    const int G = gridDim.x, bid = blockIdx.x, NGW = G * NWAVES;
    const int use_bar = a.use_bar;
    XcdBarrier bar; bar.bar = (unsigned*)(a.ws + WS_CTL) + CW_BAR; bar.x = 0; bar.st = MISC + 8;
    if (use_bar) bar = xcd_barrier_post((unsigned*)(a.ws + WS_CTL) + CW_BAR, MISC + 8);
    const int lo = a.ph_lo, hi = a.ph_hi;
#define IN(k) (lo <= (k) && (k) < hi)
#define SEAM(k) do { if (use_bar && IN(k) && IN((k) + 1)) xcd_barrier(bar); } while (0)
#define PHL() int tid_ = threadIdx.x; asm volatile("" : "+v"(tid_)); const int lane_ = tid_ & 63, wave_ = __builtin_amdgcn_readfirstlane(tid_ >> 6), gw_ = bid * NWAVES + wave_; (void)lane_; (void)gw_; \
              int pz_ = 0; asm volatile("" : "+s"(pz_))
#define PTR(i) ((const float*)ldptr(lds, (i) + pz_))
#define WSP() ((unsigned char*)ldptr(lds, 24 + pz_))
#define OUTP() ((float*)ldptr(lds, 23 + pz_))

    if (IN(0) && PHON(0)) {
        PHL(); unsigned char* ws = WSP();
        LAS float* scr = (LAS float*)(lds + RING_OFF + wave_ * 16384);
        constexpr int I_IN = 32 * 128, I_OUT = 32 * 64, I_MQ = 32 * 16, I_MKV = 32 * 32, I_MO = 8 * 64, I_PQ = 32 * 64, I_L = I_IN + I_OUT + I_MQ + I_MKV + I_MO + I_PQ;
        for (int it = gw_; it < DEPTH * I_L; it += NGW) {
            const int l = it / I_L; int r = it % I_L;
            if (r < I_IN) { transpose_item<true>(PTR(4) + (size_t)l * DM * DIN, DM, DIN, (bf16*)(ws + WS_WIN) + (size_t)l * DIN * DM, scr, r, lane_, PTR(3) + (size_t)l * DM); continue; } r -= I_IN;
            if (r < I_OUT) { transpose_item<false>(PTR(11) + (size_t)l * DM * DM, DM, DM, (bf16*)(ws + WS_WOUT) + (size_t)l * DM * DM, scr, r, lane_); continue; } r -= I_OUT;
            if (r < I_MQ) { transpose_item<false>(PTR(14) + (size_t)l * DM * MEMW, DM, MEMW, (bf16*)(ws + WS_WMQ) + (size_t)l * MEMW * DM, scr, r, lane_, PTR(12) + (size_t)l * DM); continue; } r -= I_MQ;
            if (r < I_MKV) { transpose_item<false>(PTR(15) + (size_t)l * DM * 1024, DM, 1024, (bf16*)(ws + WS_WMKV) + (size_t)l * 1024 * DM, scr, r, lane_); continue; } r -= I_MKV;
            if (r < I_MO) { transpose_item<false>(PTR(17) + (size_t)l * MEMW * DM, MEMW, DM, (bf16*)(ws + WS_WMO) + (size_t)l * DM * MEMW, scr, r, lane_); continue; } r -= I_MO;
            transpose_item<false>(PTR(19) + (size_t)l * DM * DM, DM, DM, (bf16*)(ws + WS_WPQ) + (size_t)l * DM * DM, scr, r, lane_, PTR(18) + (size_t)l * DM);
        }
        const size_t gtid = (size_t)bid * NTHREADS + tid_, nth = (size_t)G * NTHREADS;
        convert_bf16(PTR(20), (bf16*)(ws + WS_PKEYS), (size_t)DEPTH * 8 * 2 * 128 * 128, gtid, nth);
        convert_fp6_rows(PTR(21), ws + WS_PU, DEPTH * PEER_N, PU_SCALE6, PTR(18), gw_, NGW, lane_);
        convert_fp6_rows(PTR(22), ws + WS_PV, DEPTH * PEER_N, PV_SCALE6, nullptr, gw_, NGW, lane_);
        {   const float* x0 = PTR(0); bf16* XN = (bf16*)(ws + WS_XN); u64_t* rsq = (u64_t*)(ws + WS_ROWSQ);
            for (int m = gw_; m < T; m += NGW) prep_row(x0 + (size_t)m * DM, XN + (size_t)m * DM, rsq + m, lane_); }
        {   const float* mem = PTR(1); const float* gkv = PTR(13); bf16* MEMN = (bf16*)(ws + WS_MEMN);
            for (int m = gw_; m < BATCH * NMEM; m += NGW)
                rms_row_to_bf16(mem + (size_t)m * DM, gkv, MEMN + (size_t)m * DM, gkv + DM, MEMN + (size_t)(BATCH * NMEM + m) * DM, lane_); }
        float* rope = (float*)(ws + WS_ROPE); float* biasA = (float*)(ws + WS_BIASA);
        if (gtid < 64 * 16) { const int pos = (int)gtid >> 4, i = (int)gtid & 15; const float ang = (float)pos * ROPE_INV[i]; rope[gtid * 2] = cosf(ang); rope[gtid * 2 + 1] = sinf(ang); }
        if (gtid < 12 * 257) { const int h = (int)gtid / 257, rel = (int)gtid % 257 - 128; biasA[gtid] = PTR(2)[t5_bucket(rel) * 12 + h]; }
    }
    SEAM(0);
    if (IN(1) && PHON(1)) {
#pragma unroll 1
        for (int l = 0; l < DEPTH; ++l) {
            PHL(); unsigned char* ws = WSP();
            pg8::Gemm g{(bf16*)(ws + WS_MEMN) + (size_t)l * BATCH * NMEM * DM, (bf16*)(ws + WS_WMKV) + (size_t)l * 1024 * DM, BATCH * NMEM, 1024, DM};
            OffsetOrder S; S.init(BATCH * NMEM, 1024, G, bid, 64 * l);
            pg8::EpiBf16<0> E{(bf16*)(ws + WS_KVM) + (size_t)l * BATCH * NMEM * 1024, 1024, nullptr, 0, 0, 1.f};
            pg8::gemm_phase<pg8::EpiBf16<0>, OffsetOrder, true, true>(lds + RING_OFF, g, S, E, tid_);
            __syncthreads();
        }
    }
    SEAM(1);
    if (IN(2) && PHON(2)) {
        PHL(); unsigned char* ws = WSP(); bf16* KVM = (bf16*)(ws + WS_KVM); const float* gm = PTR(16);
        for (int m = gw_; m < DEPTH * BATCH * NMEM; m += NGW) {
            const int l = m / (BATCH * NMEM);
            GAS v4u* p = (GAS v4u*)(KVM + (size_t)m * 1024 + 8 * lane_);
            const v4u w = *p;
            float f[8] = {bflo(w.x), bfhi(w.x), bflo(w.y), bfhi(w.y), bflo(w.z), bfhi(w.z), bflo(w.w), bfhi(w.w)};
            float ss = 0.f;
#pragma unroll
            for (int i = 0; i < 8; ++i) ss += f[i] * f[i];
            ss += shx(ss, 1, lane_); ss += shx(ss, 2, lane_); ss += shx(ss, 4, lane_); ss += shx(ss, 8, lane_);
            const float r = 1.f / sqrtf(ss * (1.f / 128.f) + EPS);
            const float* gk = gm + (size_t)l * 256 + 128 + 8 * (lane_ & 15);
            v4u o; o.x = pk2(f[0] * r * gk[0], f[1] * r * gk[1]); o.y = pk2(f[2] * r * gk[2], f[3] * r * gk[3]); o.z = pk2(f[4] * r * gk[4], f[5] * r * gk[5]); o.w = pk2(f[6] * r * gk[6], f[7] * r * gk[7]);
            *p = o;
        }
    }
    SEAM(2);

#pragma unroll 1
    for (int l = 0; l < DEPTH; ++l) {
        const int pb = PH_BASE + PH_PER_LAYER * l;
        if (IN(pb + 0) && PHON(3)) for (int rep_ = 0; rep_ < REP_GEMM; ++rep_) { PHL(); unsigned char* ws = WSP();
            pg8::Gemm g{(bf16*)(ws + WS_XN), (bf16*)(ws + WS_WIN) + (size_t)l * DIN * DM, T, DIN, DM}; pg8::StaticOrder S; S.init(T, DIN, G, bid);
            pg8::EpiQKV E{(bf16*)(ws + WS_QKV), PTR(5) + (size_t)l * 128, PTR(7) + (size_t)l * 128, PTR(9) + (size_t)l * 128, (const float*)(ws + WS_ROPE), (const u64_t*)(ws + WS_ROWSQ) + (size_t)(l * 3 + 0) * T};
            pg8::gemm_phase<pg8::EpiQKV, pg8::StaticOrder, true, true>(lds + RING_OFF, g, S, E, tid_);
        }
        SEAM(pb + 0);
        if (IN(pb + 1) && PHON(4)) for (int rep_ = 0; rep_ < REP_ATT; ++rep_) { PHL(); unsigned char* ws = WSP();
            const float* sink = PTR(6) + (size_t)l * 12; const float* rpb = PTR(8) + (size_t)l * 8 * 15 * 31; const float* biasA = (const float*)(ws + WS_BIASA);
            const bf16* QKV = (const bf16*)(ws + WS_QKV); bf16* ATT = (bf16*)(ws + WS_ATT);
            const float* ga = PTR(5) + (size_t)l * 128; const float* gb = PTR(7) + (size_t)l * 128; const float* gc = PTR(9) + (size_t)l * 128;
            const float CaL2 = 8.f * wave_max(fabsf(ga[lane_]), lane_) * wave_max(fabsf(ga[64 + lane_]), lane_) * LOG2E;
            const float CbL2 = 8.f * wave_max(fabsf(gb[lane_]), lane_) * wave_max(fabsf(gb[64 + lane_]), lane_) * LOG2E;
            const float CcL2 = 8.f * wave_max(fabsf(gc[lane_]), lane_) * wave_max(fabsf(gc[64 + lane_]), lane_) * LOG2E;
            const int vc = (G % 8 == 0) ? (bid % 8) * (G / 8) + bid / 8 : bid;
            for (int u = vc; u < BATCH * 12 * 8; u += G) attn_unit<2>(lds, QKV, ATT, u / 96, (u >> 3) % 12, u & 7, nullptr, CcL2, 0.f, tid_);
            for (int u = vc; u < BATCH * 8 * 8; u += G) attn_unit<1>(lds, QKV, ATT, u >> 6, (u >> 3) & 7, u & 7, rpb, CbL2, 0.f, tid_);
            for (int u = vc; u < BATCH * 12 * 8; u += G) { const int head = (u >> 3) % 12; attn_unit<0>(lds, QKV, ATT, u / 96, head, u & 7, biasA, CaL2, sink[head] * LOG2E, tid_); }
        }
        SEAM(pb + 1);
        if (IN(pb + 2) && PHON(5)) { PHL(); unsigned char* ws = WSP(); mixnorm_rows((bf16*)(ws + WS_ATT), PTR(10) + (size_t)l * DM, gw_, NGW, lane_); }
        SEAM(pb + 2);
        if (IN(pb + 3) && PHON(6)) { PHL(); unsigned char* ws = WSP();
            pg8::Gemm g{(bf16*)(ws + WS_ATT), (bf16*)(ws + WS_WOUT) + (size_t)l * DM * DM, T, DM, DM}; pg8::StaticOrder S; S.init(T, DM, G, bid);
            pg8::EpiResid E{(bf16*)(ws + WS_XN), DM, (u64_t*)(ws + WS_ROWSQ) + (size_t)(l * 3 + 1) * T};
            pg8::gemm_phase<pg8::EpiResid, pg8::StaticOrder, true, true>(lds + RING_OFF, g, S, E, tid_);
        }
        SEAM(pb + 3);
        if (IN(pb + 4) && PHON(7)) for (int rep_ = 0; rep_ < REP_GEMM; ++rep_) { PHL(); unsigned char* ws = WSP();
            pg8::Gemm g{(bf16*)(ws + WS_XN), (bf16*)(ws + WS_WMQ) + (size_t)l * MEMW * DM, T, MEMW, DM}; pg8::StaticOrder S; S.init(T, MEMW, G, bid);
            pg8::EpiBf16Row E{(bf16*)(ws + WS_QM), MEMW, (const u64_t*)(ws + WS_ROWSQ) + (size_t)(l * 3 + 1) * T};
            pg8::gemm_phase<pg8::EpiBf16Row, pg8::StaticOrder, true, true>(lds + RING_OFF, g, S, E, tid_);
        }
        SEAM(pb + 4);
        if (IN(pb + 5) && PHON(8)) for (int rep_ = 0; rep_ < REP_MEM; ++rep_) { PHL(); unsigned char* ws = WSP();
            const bf16* kvm = (const bf16*)(ws + WS_KVM) + (size_t)l * BATCH * NMEM * 1024; const float* gq = PTR(16) + (size_t)l * 256;
            const float CmL2 = 11.313708498984761f * wave_max(fmaxf(fabsf(gq[lane_]), fabsf(gq[64 + lane_])), lane_) * wave_max(fmaxf(fabsf(gq[128 + lane_]), fabsf(gq[192 + lane_])), lane_) * LOG2E;
            for (int u = bid; u < (T / 256) * 4; u += G) mem_unit(lds, (const bf16*)(ws + WS_QM), kvm, (bf16*)(ws + WS_OM), gq, u >> 2, u & 3, CmL2, tid_);
        }
        SEAM(pb + 5);
        if (IN(pb + 6) && PHON(9)) { PHL(); unsigned char* ws = WSP();
            pg8::Gemm g{(bf16*)(ws + WS_OM), (bf16*)(ws + WS_WMO) + (size_t)l * DM * MEMW, T, DM, MEMW}; pg8::StaticOrder S; S.init(T, DM, G, bid);
            pg8::EpiResid E{(bf16*)(ws + WS_XN), DM, (u64_t*)(ws + WS_ROWSQ) + (size_t)(l * 3 + 2) * T};
            pg8::gemm_phase<pg8::EpiResid, pg8::StaticOrder, true, true>(lds + RING_OFF, g, S, E, tid_);
        }
        SEAM(pb + 6);
        if (IN(pb + 7) && PHON(10)) for (int rep_ = 0; rep_ < REP_GEMM; ++rep_) { PHL(); unsigned char* ws = WSP();
            pg8::Gemm g{(bf16*)(ws + WS_XN), (bf16*)(ws + WS_WPQ) + (size_t)l * DM * DM, T, DM, DM}; pg8::StaticOrder S; S.init(T, DM, G, bid);
            pg8::EpiBf16Row E{(bf16*)(ws + WS_QP), DM, (const u64_t*)(ws + WS_ROWSQ) + (size_t)(l * 3 + 2) * T};
            pg8::gemm_phase<pg8::EpiBf16Row, pg8::StaticOrder, true, true>(lds + RING_OFF, g, S, E, tid_);
        }
        SEAM(pb + 7);
        if (IN(pb + 8) && PHON(11)) for (int rep_ = 0; rep_ < REP_SEL; ++rep_) { PHL(); unsigned char* ws = WSP();
            const bf16* pk = (const bf16*)(ws + WS_PKEYS) + (size_t)l * 8 * 2 * 128 * 128;
            for (int u = bid; u < (T / 256) * PEER_H; u += G) peer_select_unit((const bf16*)(ws + WS_QP), pk, (int*)(ws + WS_PIDX), (float*)(ws + WS_PGATE), u >> 3, u & 7, wave_, lane_);
        }
        SEAM(pb + 8);
        if (IN(pb + 9) && PHON(12)) { PHL(); unsigned char* ws = WSP();
            peer_gather6((bf16*)(ws + WS_XN), ws + WS_PU + (size_t)l * PEER_N * 1536, ws + WS_PV + (size_t)l * PEER_N * 1536, (const int*)(ws + WS_PIDX), (const float*)(ws + WS_PGATE), (l + 1 == DEPTH) ? OUTP() : (float*)nullptr,
                         (const u64_t*)(ws + WS_ROWSQ) + (size_t)(l * 3 + 2) * T, (l + 1 < DEPTH) ? (u64_t*)(ws + WS_ROWSQ) + (size_t)((l + 1) * 3 + 0) * T : (u64_t*)nullptr,
                         (LAS float*)(lds + RING_OFF + wave_ * 1024), gw_, NGW, lane_); }
        SEAM(pb + 9);
    }
#undef IN
#undef SEAM
}

#ifndef MK_MULTI_LAUNCH
#define MK_MULTI_LAUNCH 0
#endif
extern "C" void kernel_launch(void* const* d_in, const int* in_sizes, int n_in, void* d_out, int out_size, void* d_ws, size_t ws_size, hipStream_t stream) {
    static int grid = 0;
    if (grid == 0) {
        if (n_in != 23 || out_size != T * DM || ws_size < WS_END) { fprintf(stderr, "kernel_launch: unexpected shapes (n_in %d, out %d, ws %zu)\n", n_in, out_size, ws_size); grid = -1; return; }
        int dev = 0, cus = 0, per_cu = 0;
        if (hipGetDevice(&dev) != hipSuccess || hipDeviceGetAttribute(&cus, hipDeviceAttributeMultiprocessorCount, dev) != hipSuccess) { grid = -1; return; }
        if (hipFuncSetAttribute((const void*)mega, hipFuncAttributeMaxDynamicSharedMemorySize, LDS_BYTES) != hipSuccess) { fprintf(stderr, "kernel_launch: hipFuncSetAttribute failed\n"); grid = -1; return; }
        if (hipOccupancyMaxActiveBlocksPerMultiprocessor(&per_cu, (const void*)mega, NTHREADS, LDS_BYTES) != hipSuccess || per_cu < 1) { fprintf(stderr, "kernel_launch: occupancy query says %d\n", per_cu); }
        (void)hipGetLastError();
        grid = cus;
    }
    if (grid < 0) return;
    (void)hipMemsetAsync((char*)d_ws + WS_CTL, 0, CTL_ZERO_BYTES, stream);
    Args a{};
    for (int i = 0; i < 23; ++i) a.in[i] = (const float*)d_in[i];
    a.out = (float*)d_out; a.ws = (unsigned char*)d_ws;
#if MK_MULTI_LAUNCH
    for (int p = 0; p < N_PHASES; ++p) { a.ph_lo = p; a.ph_hi = p + 1; a.use_bar = 0; a.pad = 0; hipLaunchKernelGGL(mega, dim3(grid), dim3(NTHREADS), LDS_BYTES, stream, a); }
#else
    a.ph_lo = 0; a.ph_hi = N_PHASES; a.use_bar = 1; a.pad = 0;
    hipLaunchKernelGGL(mega, dim3(grid), dim3(NTHREADS), LDS_BYTES, stream, a);
#endif
    const hipError_t le = hipPeekAtLastError();
    if (le != hipSuccess) fprintf(stderr, "kernel_launch: launch failed: %s\n", hipGetErrorName(le));
}
```

```cpp
#include <hip/hip_runtime.h>
#include <cstdio>
#include <cstdint>
#include <cmath>
__device__ __forceinline__ float shx(float v, int k, int lane);
typedef unsigned long long u64_t;
__device__ __forceinline__ float rowsq_rs(const u64_t* rowsq, int row) { return 1.0f / sqrtf((float)rowsq[row] * (5.9604644775390625e-08f / 2048.0f) + 1e-6f); }
__device__ __forceinline__ u64_t rowsq_fx(float ss) { return (u64_t)(ss * 16777216.0f + 0.5f); }
namespace pg8 {
#define PG8_LAS __attribute__((address_space(3)))
typedef unsigned short bf16_t;
typedef short bf16x8 __attribute__((ext_vector_type(8)));
typedef float f32x4 __attribute__((ext_vector_type(4)));
typedef unsigned u32x4 __attribute__((ext_vector_type(4)));
constexpr int BM = 256, BK = 64, HALF = 128, HTB = HALF * BK * 2  , STAGE_BYTES = 8 * HTB, NXCD = 8, WGM = 8;

__host__ __device__ __forceinline__ int lds_byte(int r, int c) { const int st = (r >> 4) * 2 + (c >> 5), rr = r & 15, cc = c & 31, ob = rr * 64 + cc * 2; return st * 1024 + (ob ^ (((ob >> 9) & 1) << 5)); }
__host__ __device__ __forceinline__ void stage_rc(int b, int& R, int& C) { const int st = b / 1024, sb = b % 1024, swz = sb ^ (((sb >> 9) & 1) << 5); R = (st >> 1) * 16 + swz / 64; C = (st & 1) * 32 + (swz % 64) / 2; }
__host__ __device__ __forceinline__ int perm32(int rho) { const int n = rho >> 4, i = rho & 15; return 8 * (i >> 2) + 4 * n + (i & 3); }

struct Unit { int pm, pn; };
struct Gemm { const bf16_t* A; const bf16_t* Bt; int M, N, K; };

struct StaticOrder {
    int nM, nN, nwg, G, c;
    __host__ __device__ void init(int M, int N, int G_, int c_) { nM = M / BM; nN = N / BM; nwg = nM * nN; G = G_; c = c_; }
    __host__ __device__ bool next(int i, Unit& u) const {
        const long L = (long)i * G + c; if (L >= nwg) return false;
        int wgid = (int)L; { const int q = nwg / NXCD, r = nwg % NXCD, xcd = wgid % NXCD, off = wgid / NXCD; wgid = (xcd < r ? xcd * (q + 1) : r * (q + 1) + (xcd - r) * q) + off; }
        const int nig = WGM * nN, gid = wgid / nig, fm = gid * WGM, gsz = (nM - fm) < WGM ? (nM - fm) : WGM;
        u.pm = fm + ((wgid % nig) % gsz); u.pn = (wgid % nig) / gsz; return true;
    }
    __device__ __forceinline__ void a_ready(const Unit&) const {}
    __device__ __forceinline__ void done(const Unit&) const {}
};

__device__ __forceinline__ unsigned cvt_pk_bf16(float lo, float hi) { unsigned r; asm volatile("v_cvt_pk_bf16_f32 %0, %1, %2" : "=v"(r) : "v"(lo), "v"(hi)); return r; }
typedef float f32x2 __attribute__((ext_vector_type(2)));
__device__ __forceinline__ f32x2 gelu_pk(f32x2 v) {
    const f32x2 av = __builtin_elementwise_abs(v), d = av * 0.2316418882f + 1.0f;
    f32x2 t; t.x = __builtin_amdgcn_rcpf(d.x); t.y = __builtin_amdgcn_rcpf(d.y);
    f32x2 q = t * 0.5307027145f + (-0.7265760135f); q = q * t + 0.7107068705f; q = q * t + (-0.142248368f); q = q * t + 0.127414796f; q = q * t;
    const f32x2 s = (v * v) * (-0.72134752044f);
    f32x2 e; e.x = __builtin_amdgcn_exp2f(s.x); e.y = __builtin_amdgcn_exp2f(s.y);
    const f32x2 m = v * (q * e), r = v - m;
    f32x2 o; o.x = v.x < 0.f ? m.x : r.x; o.y = v.y < 0.f ? m.y : r.y; return o;
}

template <int ACT  > struct EpiBf16 {
    static constexpr bool PERM = true, AFTER_DRAIN = false; static_assert(ACT == 0 || ACT == 1, "EpiBf16: ACT is 0 (none) or 1 (gelu_pk)");
    bf16_t* O; int ldc; const float* bias; int split_cols; size_t split_stride; float scale0;
    __device__ __forceinline__ void operator()(const f32x4 (&acc)[2][2][4][2], const Unit& u, int wr, int wc, int fr, int fq) const {
        const int row0 = u.pm * BM + wr * 64 + fr; int colt = u.pn * BM; bf16_t* base = O;
        float sc = 1.f; if (split_cols) { const int t = colt / split_cols; base += (size_t)t * split_stride; colt -= t * split_cols; if (t == 0) sc = scale0; }
        const int col0 = colt + wc * 32 + 8 * fq, bcol0 = u.pn * BM + wc * 32 + 8 * fq;
        f32x4 bv[2][2];
#pragma unroll
        for (int bj = 0; bj < 2; ++bj)
#pragma unroll
            for (int n = 0; n < 2; ++n) bv[bj][n] = bias ? *(const f32x4*)(bias + bcol0 + bj * HALF + 4 * n) : (f32x4){0.f, 0.f, 0.f, 0.f};
#pragma unroll
        for (int ai = 0; ai < 2; ++ai)
#pragma unroll
            for (int m = 0; m < 4; ++m) { bf16_t* rowp = base + (size_t)(row0 + ai * HALF + m * 16) * ldc + col0;
#pragma unroll
                for (int bj = 0; bj < 2; ++bj) { f32x4 v0 = acc[ai][bj][m][0] + bv[bj][0], v1 = acc[ai][bj][m][1] + bv[bj][1];
                    if (ACT == 1) { f32x2 a = gelu_pk((f32x2){v0[0], v0[1]}), b = gelu_pk((f32x2){v0[2], v0[3]}), c = gelu_pk((f32x2){v1[0], v1[1]}), d = gelu_pk((f32x2){v1[2], v1[3]});
                        v0 = (f32x4){a.x, a.y, b.x, b.y}; v1 = (f32x4){c.x, c.y, d.x, d.y}; }
                    v0 = v0 * sc; v1 = v1 * sc; u32x4 w; w.x = cvt_pk_bf16(v0[0], v0[1]); w.y = cvt_pk_bf16(v0[2], v0[3]); w.z = cvt_pk_bf16(v1[0], v1[1]); w.w = cvt_pk_bf16(v1[2], v1[3]);
                    *(u32x4*)(rowp + bj * HALF) = w; } }
    }
};

typedef unsigned u32x2 __attribute__((ext_vector_type(2)));
struct EpiResid {
    static constexpr bool PERM = false, AFTER_DRAIN = false;
    bf16_t* s; int ldc; u64_t* rowsq;
    __device__ __forceinline__ void operator()(const f32x4 (&acc)[2][2][4][2], const Unit& u, int wr, int wc, int fr, int fq) const {
        const int col0 = u.pn * BM + wc * 32 + 4 * fq;
#pragma unroll
        for (int ai = 0; ai < 2; ++ai)
#pragma unroll
            for (int m = 0; m < 4; ++m) { const int row = u.pm * BM + ai * HALF + wr * 64 + m * 16 + fr; bf16_t* sp = s + (size_t)row * ldc + col0; float ss = 0.f;
                u32x2 in[2][2];
#pragma unroll
                for (int bj = 0; bj < 2; ++bj)
#pragma unroll
                    for (int n = 0; n < 2; ++n) in[bj][n] = *(const u32x2*)(sp + bj * HALF + n * 16);
#pragma unroll
                for (int bj = 0; bj < 2; ++bj)
#pragma unroll
                    for (int n = 0; n < 2; ++n) { const u32x2 w0 = in[bj][n];
                        const f32x4 bs = (f32x4){__builtin_bit_cast(float, w0.x << 16), __builtin_bit_cast(float, w0.x & 0xffff0000u), __builtin_bit_cast(float, w0.y << 16), __builtin_bit_cast(float, w0.y & 0xffff0000u)};
                        const f32x4 o = bs + acc[ai][bj][m][n]; ss += (o[0] * o[0] + o[1] * o[1]) + (o[2] * o[2] + o[3] * o[3]);
                        u32x2 w; w.x = cvt_pk_bf16(o[0], o[1]); w.y = cvt_pk_bf16(o[2], o[3]); *(u32x2*)(sp + bj * HALF + n * 16) = w; }
                ss += shx(ss, 16, fr + 16 * fq); ss += shx(ss, 32, fr + 16 * fq);
                if (fq == 0) atomicAdd(rowsq + row, rowsq_fx(ss)); }
    }
};
struct EpiBf16Row {
    static constexpr bool PERM = true, AFTER_DRAIN = false;
    bf16_t* O; int ldc; const u64_t* rowsq;
    __device__ __forceinline__ void operator()(const f32x4 (&acc)[2][2][4][2], const Unit& u, int wr, int wc, int fr, int fq) const {
        const int row0 = u.pm * BM + wr * 64 + fr, col0 = u.pn * BM + wc * 32 + 8 * fq;
#pragma unroll
        for (int ai = 0; ai < 2; ++ai)
#pragma unroll
            for (int m = 0; m < 4; ++m) { const int row = row0 + ai * HALF + m * 16; const float rs = rowsq_rs(rowsq, row); bf16_t* rowp = O + (size_t)row * ldc + col0;
#pragma unroll
                for (int bj = 0; bj < 2; ++bj) { const f32x4 v0 = acc[ai][bj][m][0] * rs, v1 = acc[ai][bj][m][1] * rs; u32x4 w; w.x = cvt_pk_bf16(v0[0], v0[1]); w.y = cvt_pk_bf16(v0[2], v0[3]); w.z = cvt_pk_bf16(v1[0], v1[1]); w.w = cvt_pk_bf16(v1[2], v1[3]);
                    *(u32x4*)(rowp + bj * HALF) = w; } }
    }
};
struct EpiQKV {
    static constexpr bool PERM = false, AFTER_DRAIN = false;
    bf16_t* O; const float* ga; const float* gb; const float* gc; const float* rope; const u64_t* rowsq;
    __device__ __forceinline__ void operator()(const f32x4 (&acc)[2][2][4][2], const Unit& u, int wr, int wc, int fr, int fq) const {
        const int hg = u.pn * 4 + wc;
        const float* g = nullptr; bool isq = false, dorope = false;
        if (hg < 12) { g = ga; isq = true; } else if (hg < 16) { g = ga + 64; } else if (hg < 20) { }
        else if (hg < 28) { g = gb; isq = true; } else if (hg < 36) { g = gb + 64; } else if (hg < 44) { }
        else if (hg < 56) { g = gc; isq = true; dorope = true; } else if (hg < 60) { g = gc + 64; dorope = true; }
        const float qs = isq ? 0.18033688011112042f : 1.0f;
#pragma unroll
        for (int ai = 0; ai < 2; ++ai)
#pragma unroll
            for (int m = 0; m < 4; ++m) {
                const int row = u.pm * BM + ai * HALF + wr * 64 + m * 16 + fr;
                f32x4 v[2][2];
                const float rsx = rowsq_rs(rowsq, row);
#pragma unroll
                for (int bj = 0; bj < 2; ++bj)
#pragma unroll
                    for (int n = 0; n < 2; ++n) v[bj][n] = acc[ai][bj][m][n] * rsx;
                if (g) {
                    float ss = 0.f;
#pragma unroll
                    for (int bj = 0; bj < 2; ++bj)
#pragma unroll
                        for (int n = 0; n < 2; ++n) { const f32x4 x = v[bj][n]; ss += (x[0] * x[0] + x[1] * x[1]) + (x[2] * x[2] + x[3] * x[3]); }
                    ss += shx(ss, 16, fr + 16 * fq); ss += shx(ss, 32, fr + 16 * fq);
                    const float r = qs / sqrtf(ss * (1.0f / 64.0f) + 1e-6f);
#pragma unroll
                    for (int bj = 0; bj < 2; ++bj)
#pragma unroll
                        for (int n = 0; n < 2; ++n) v[bj][n] = v[bj][n] * *(const f32x4*)(g + 32 * bj + 16 * n + 4 * fq) * r;
                }
                if (dorope) {
                    const int t = row & 2047, pr = t >> 6, pc = t & 63;
#pragma unroll
                    for (int bj = 0; bj < 2; ++bj) {
                        const int pos = bj ? pc : pr;
                        const float* rp = rope + (size_t)(pos * 16 + 4 * fq) * 2;
                        const f32x4 c01 = *(const f32x4*)rp, c23 = *(const f32x4*)(rp + 4);
                        const f32x4 cs = (f32x4){c01[0], c01[2], c23[0], c23[2]}, sn = (f32x4){c01[1], c01[3], c23[1], c23[3]};
                        const f32x4 x1 = v[bj][0], x2 = v[bj][1];
                        v[bj][0] = x1 * cs - x2 * sn; v[bj][1] = x1 * sn + x2 * cs;
                    }
                }
                bf16_t* rowp = O + (size_t)row * 4096 + hg * 64 + 4 * fq;
#pragma unroll
                for (int bj = 0; bj < 2; ++bj)
#pragma unroll
                    for (int n = 0; n < 2; ++n) { u32x2 w; w.x = cvt_pk_bf16(v[bj][n][0], v[bj][n][1]); w.y = cvt_pk_bf16(v[bj][n][2], v[bj][n][3]); *(u32x2*)(rowp + 32 * bj + 16 * n) = w; }
                asm volatile("" ::: "memory");
            }
    }
};
template <class Epi, class Sched, bool ALIGN_EPI = false, bool SP2 = false>
__device__ __forceinline__ void gemm_phase(PG8_LAS unsigned char* lds, const Gemm g, const Sched& S, const Epi& E, const int tid) {
    const int wid = __builtin_amdgcn_readfirstlane(tid >> 6), lane = tid & 63, wr = wid >> 2, wc = wid & 3, fr = lane & 15, fq = lane >> 4;
    const int K = g.K, nt = K / BK;
    unsigned voffA[2], voffB[2];
#pragma unroll
    for (int i = 0; i < 2; ++i) { int R, C; stage_rc(tid * 16 + i * 8192, R, C); const int Rb = Epi::PERM ? ((R & ~31) + perm32(R & 31)) : R;
        voffA[i] = (unsigned)(R * K + C) * 2u; voffB[i] = (unsigned)(Rb * K + C) * 2u; }
    const size_t kstep = (size_t)(BK * 2);
    const size_t hstep = (size_t)HALF * K * 2;
    const size_t tstep = 2 * hstep;
    const unsigned ldsw = (unsigned)wid * 1024u;
    const int aoff = lds_byte(wr * 64 + fr, fq * 8), boff = lds_byte(wc * 32 + fr, fq * 8);
#define PG8_SA(b, h) (((b) * 2 + (h)) * HTB)
#define PG8_SB(b, h) ((4 + (b) * 2 + (h)) * HTB)
#define PG8_STAGE(bufoff, gbase, voff) do { _Pragma("unroll") for (int _i = 0; _i < 2; ++_i) \
        __builtin_amdgcn_global_load_lds((const unsigned*)((const char*)(gbase) + (voff)[_i]), (PG8_LAS unsigned*)(lds + (bufoff) + ldsw + _i * 8192), 16, 0, 0); } while (0)
#define PG8_LDA(dst, b, h) do { _Pragma("unroll") for (int m = 0; m < 4; ++m) _Pragma("unroll") for (int k = 0; k < 2; ++k) dst[m][k] = *(const PG8_LAS bf16x8*)(lds + PG8_SA(b, h) + aoff + m * 2048 + k * 1024); } while (0)
#define PG8_LDB(dst, b, h) do { _Pragma("unroll") for (int n = 0; n < 2; ++n) _Pragma("unroll") for (int k = 0; k < 2; ++k) dst[n][k] = *(const PG8_LAS bf16x8*)(lds + PG8_SB(b, h) + boff + n * 2048 + k * 1024); } while (0)
#define PG8_MMA(ai, bj, At, Bt) do { __builtin_amdgcn_s_setprio(1); _Pragma("unroll") for (int m = 0; m < 4; ++m) _Pragma("unroll") for (int n = 0; n < 2; ++n) _Pragma("unroll") for (int k = 0; k < 2; ++k) \
        acc[ai][bj][m][n] = __builtin_amdgcn_mfma_f32_16x16x32_bf16(Bt[n][k], At[m][k], acc[ai][bj][m][n], 0, 0, 0); __builtin_amdgcn_s_setprio(0); } while (0)
#define PG8_WAIT_V(n) asm volatile("s_waitcnt vmcnt(" #n ")" ::: "memory")
#define PG8_WAIT_L(n) asm volatile("s_waitcnt lgkmcnt(" #n ")" ::: "memory")
#define PG8_BAR __builtin_amdgcn_s_barrier()
#define PG8_SCHED __builtin_amdgcn_sched_barrier(0)
    Unit cur, nxt; int ui = 0;
    if (!S.next(0, cur)) return;
    f32x4 acc[2][2][4][2];
#pragma unroll
    for (int a = 0; a < 2; ++a)
#pragma unroll
        for (int b = 0; b < 2; ++b)
#pragma unroll
            for (int m = 0; m < 4; ++m)
#pragma unroll
                for (int n = 0; n < 2; ++n) acc[a][b][m][n] = (f32x4){0.f, 0.f, 0.f, 0.f};
    bf16x8 At[4][2], B0[2][2], B1[2][2];
    const char* cA = (const char*)g.A + (size_t)cur.pm * tstep; const char* cB = (const char*)g.Bt + (size_t)cur.pn * tstep;
    S.a_ready(cur);
    if constexpr (SP2) {
        PG8_STAGE(PG8_SB(0, 0), cB, voffB); PG8_STAGE(PG8_SB(0, 1), cB + hstep, voffB); PG8_STAGE(PG8_SA(0, 0), cA, voffA); PG8_STAGE(PG8_SA(0, 1), cA + hstep, voffA);
        if (wr == 1) PG8_BAR;
        PG8_WAIT_V(2); PG8_BAR;
        PG8_STAGE(PG8_SB(1, 0), cB + kstep, voffB); PG8_STAGE(PG8_SA(1, 0), cA + kstep, voffA); PG8_STAGE(PG8_SB(1, 1), cB + hstep + kstep, voffB);
        PG8_WAIT_V(6); PG8_BAR;
    } else {
        PG8_STAGE(PG8_SB(0, 0), cB, voffB); PG8_STAGE(PG8_SA(0, 0), cA, voffA); PG8_STAGE(PG8_SB(0, 1), cB + hstep, voffB); PG8_STAGE(PG8_SA(0, 1), cA + hstep, voffA);
        if (wr == 1) PG8_BAR;
        PG8_WAIT_V(4); PG8_BAR;
        PG8_STAGE(PG8_SB(1, 0), cB + kstep, voffB); PG8_STAGE(PG8_SA(1, 0), cA + kstep, voffA); PG8_STAGE(PG8_SB(1, 1), cB + hstep + kstep, voffB);
        PG8_WAIT_V(6); PG8_BAR;
    }
    for (;;) {
        const bool has_next = S.next(ui + 1, nxt);
        const char* nA = has_next ? (const char*)g.A + (size_t)nxt.pm * tstep : cA; const char* nB = has_next ? (const char*)g.Bt + (size_t)nxt.pn * tstep : cB;
        for (int t = 0; t < nt; t += 2) {
            const bool last = (t == nt - 2);
            const char* a1 = cA + (size_t)(t + 1) * kstep;
            const char* a2 = last ? nA : cA + (size_t)(t + 2) * kstep; const char* b2 = last ? nB : cB + (size_t)(t + 2) * kstep;
            const char* a3 = a2 + kstep; const char* b3 = b2 + kstep;
            if (last && has_next) S.a_ready(nxt);
            if constexpr (SP2) {
            PG8_LDB(B0, 0, 0); PG8_LDB(B1, 0, 1); PG8_SCHED; PG8_LDA(At, 0, 0); PG8_STAGE(PG8_SA(1, 1), a1 + hstep, voffA);
            PG8_WAIT_V(8); PG8_WAIT_L(0); PG8_BAR; PG8_MMA(0, 0, At, B0); PG8_MMA(0, 1, At, B1); PG8_BAR; PG8_SCHED;
            PG8_LDA(At, 0, 1); PG8_STAGE(PG8_SB(0, 0), b2, voffB); PG8_STAGE(PG8_SB(0, 1), b2 + hstep, voffB); PG8_STAGE(PG8_SA(0, 0), a2, voffA);
            PG8_WAIT_V(8); PG8_WAIT_L(0); PG8_BAR; PG8_MMA(1, 0, At, B0); PG8_MMA(1, 1, At, B1); PG8_BAR; PG8_SCHED;
            PG8_LDB(B0, 1, 0); PG8_LDB(B1, 1, 1); PG8_SCHED; PG8_LDA(At, 1, 0); PG8_STAGE(PG8_SA(0, 1), a2 + hstep, voffA);
            PG8_WAIT_V(8); PG8_WAIT_L(0); PG8_BAR; PG8_MMA(0, 0, At, B0); PG8_MMA(0, 1, At, B1); PG8_BAR; PG8_SCHED;
            PG8_LDA(At, 1, 1); PG8_STAGE(PG8_SB(1, 0), b3, voffB); PG8_STAGE(PG8_SB(1, 1), b3 + hstep, voffB); PG8_STAGE(PG8_SA(1, 0), a3, voffA);
            PG8_WAIT_V(8); PG8_WAIT_L(0); PG8_BAR; PG8_MMA(1, 0, At, B0); PG8_MMA(1, 1, At, B1); PG8_BAR; PG8_SCHED;
            } else {
            PG8_LDB(B0, 0, 0); PG8_SCHED; PG8_LDA(At, 0, 0); PG8_STAGE(PG8_SA(1, 1), a1 + hstep, voffA);
            PG8_WAIT_L(8); PG8_BAR; PG8_WAIT_L(0); PG8_MMA(0, 0, At, B0); PG8_BAR; PG8_SCHED;
            PG8_LDB(B1, 0, 1); PG8_STAGE(PG8_SB(0, 0), b2, voffB);
            PG8_BAR; PG8_WAIT_L(0); PG8_MMA(0, 1, At, B1); PG8_BAR;
            PG8_LDA(At, 0, 1); PG8_STAGE(PG8_SA(0, 0), a2, voffA);
            PG8_BAR; PG8_WAIT_L(0); PG8_MMA(1, 0, At, B0); PG8_BAR; PG8_SCHED;
            PG8_STAGE(PG8_SB(0, 1), b2 + hstep, voffB);
            PG8_WAIT_V(6); PG8_BAR; PG8_MMA(1, 1, At, B1); PG8_BAR;
            PG8_LDB(B0, 1, 0); PG8_SCHED; PG8_LDA(At, 1, 0); PG8_STAGE(PG8_SA(0, 1), a2 + hstep, voffA);
            PG8_WAIT_L(8); PG8_BAR; PG8_WAIT_L(0); PG8_MMA(0, 0, At, B0); PG8_BAR; PG8_SCHED;
            PG8_LDB(B1, 1, 1); PG8_STAGE(PG8_SB(1, 0), b3, voffB);
            PG8_BAR; PG8_WAIT_L(0); PG8_MMA(0, 1, At, B1); PG8_BAR;
            PG8_LDA(At, 1, 1); PG8_STAGE(PG8_SA(1, 0), a3, voffA);
            PG8_BAR; PG8_WAIT_L(0); PG8_MMA(1, 0, At, B0); PG8_BAR; PG8_SCHED;
            PG8_STAGE(PG8_SB(1, 1), b3 + hstep, voffB);
            PG8_WAIT_V(6); PG8_BAR; PG8_MMA(1, 1, At, B1); PG8_BAR;
            }
        }
        if constexpr (ALIGN_EPI) { if (wr == 0) PG8_BAR; }
        if constexpr (!Epi::AFTER_DRAIN) { E(acc, cur, wr, wc, fr, fq); S.done(cur); }
        if (!has_next) break;
#pragma unroll
        for (int a = 0; a < 2; ++a)
#pragma unroll
            for (int b = 0; b < 2; ++b)
#pragma unroll
                for (int m = 0; m < 4; ++m)
#pragma unroll
                    for (int n = 0; n < 2; ++n) acc[a][b][m][n] = (f32x4){0.f, 0.f, 0.f, 0.f};
        cur = nxt; cA = nA; cB = nB; ++ui;
        if constexpr (ALIGN_EPI) { if (wr == 1) PG8_BAR; }
    }
    PG8_WAIT_V(0);
    if constexpr (!ALIGN_EPI) { if (wr == 0) PG8_BAR; }
    PG8_BAR;
    if constexpr (Epi::AFTER_DRAIN) { E.fused(acc, cur, wr, wc, fr, fq, lds, wid, lane); S.done(cur); }
#undef PG8_SA
#undef PG8_SB
#undef PG8_STAGE
#undef PG8_LDA
#undef PG8_LDB
#undef PG8_MMA
#undef PG8_WAIT_V
#undef PG8_WAIT_L
#undef PG8_BAR
#undef PG8_SCHED
}
}

constexpr int BATCH = 16, SEQ = 2048, DM = 2048, T = BATCH * SEQ, DEPTH = 2;
constexpr int NMEM = 256, DIN = 4096, MEMW = 512;
constexpr int PEER_H = 8, PEER_N = 16384;
constexpr int NWAVES = 8, NTHREADS = NWAVES * 64;
constexpr float EPS = 1e-6f;
constexpr int QA = 0, KA = 768, VA = 1024, QB = 1280, KB = 1792, VB = 2304, QC = 2816, KC = 3584, VC = 3840;
constexpr int OA = 0, OB = 768, OC = 1280;

constexpr size_t MiB = 1u << 20;
constexpr size_t WS_CTL = 0, CTL_ZERO_BYTES = 2 * MiB;
constexpr size_t WS_ROWSQ = 256 * 1024;
constexpr size_t WS_ROPE = 83 * MiB, WS_BIASA = 83 * MiB + 16384;
constexpr size_t WS_WIN = 2 * MiB, WS_WOUT = 34 * MiB, WS_WMQ = 50 * MiB, WS_WMKV = 54 * MiB, WS_WMO = 62 * MiB, WS_WPQ = 66 * MiB, WS_PKEYS = 82 * MiB;
constexpr size_t WS_MEMN = 84 * MiB, WS_KVM = 116 * MiB, WS_PU = 132 * MiB, WS_PV = 260 * MiB, WS_XN = 388 * MiB, WS_QKV = 516 * MiB, WS_ATT = 772 * MiB;
constexpr size_t WS_QM = 900 * MiB, WS_OM = 932 * MiB, WS_END = 964 * MiB;
constexpr size_t WS_QP = WS_QKV, WS_PIDX = WS_QKV + 128 * MiB, WS_PGATE = WS_QKV + 144 * MiB;
constexpr int CW_BAR = 4096;

constexpr int RING_OFF = 0, RING_BYTES = 131072;
constexpr int LDSCTL_OFF = RING_BYTES, MISC_OFF = LDSCTL_OFF + 320;
constexpr int LDS_BYTES = 147456;

#define GAS __attribute__((address_space(1)))
#define LAS __attribute__((address_space(3)))
typedef unsigned short bf16;
typedef unsigned v4u __attribute__((ext_vector_type(4)));
typedef unsigned v2u __attribute__((ext_vector_type(2)));
typedef float f32x4 __attribute__((ext_vector_type(4)));
typedef float f32x16 __attribute__((ext_vector_type(16)));
typedef short bf16x8 __attribute__((ext_vector_type(8)));
typedef GAS unsigned gu32;
#define LDS_WAIT() asm volatile("s_waitcnt lgkmcnt(0)" ::: "memory")
#define VM_WAIT() asm volatile("s_waitcnt vmcnt(0)" ::: "memory")
__device__ __forceinline__ unsigned f2bf(float f) { unsigned u = __builtin_bit_cast(unsigned, f); return (u + 0x7fffu + ((u >> 16) & 1u)) >> 16; }
__device__ __forceinline__ unsigned pk2(float lo, float hi) { return f2bf(lo) | (f2bf(hi) << 16); }
__device__ __forceinline__ float bflo(unsigned w) { return __builtin_bit_cast(float, w << 16); }
__device__ __forceinline__ float bfhi(unsigned w) { return __builtin_bit_cast(float, w & 0xffff0000u); }

__device__ __forceinline__ float shx(float v, int k, int lane) { return __builtin_bit_cast(float, __builtin_amdgcn_ds_bpermute((lane ^ k) << 2, __builtin_bit_cast(int, v))); }
#define XB_TMO      128
#define XB_XCNT(j)  (256  + 64 * (j))
#define XB_XSUB(j)  (1280 + 64 * (j))
#define XB_XGEN(j)  (2304 + 64 * (j))
#define XB_TOP      3328
#define XB_TOPGEN   3392
#define XCD_BAR_WORDS 3456
#define XB_SPIN_CAP (1u << 18)

__device__ __forceinline__ unsigned xb_ld(unsigned* p)              { return __hip_atomic_load(p, __ATOMIC_RELAXED, __HIP_MEMORY_SCOPE_AGENT); }
__device__ __forceinline__ unsigned xb_add(unsigned* p, unsigned v) { return __hip_atomic_fetch_add(p, v, __ATOMIC_RELAXED, __HIP_MEMORY_SCOPE_AGENT); }
__device__ __forceinline__ unsigned xb_xcc_id() { return (unsigned)__builtin_amdgcn_s_getreg((3 << 11) | 20) & 0xFu; }
#define XB_SPIN(cond, bar) do { unsigned _sp = 0; while (cond) { __builtin_amdgcn_s_sleep(1); \
    if ((++_sp & 255u) == 0u) { if (xb_ld(&(bar)[XB_TMO])) break; if (_sp > XB_SPIN_CAP) { atomicAdd(&(bar)[XB_TMO], 1u); break; } } } } while (0)

struct XcdBarrier {
    unsigned* bar; unsigned x;
    volatile LAS unsigned* st;
};

__device__ __forceinline__ XcdBarrier xcd_barrier_post(unsigned* bar, volatile LAS unsigned* st) {
    XcdBarrier b; b.bar = bar; b.x = xb_xcc_id(); b.st = st;
    if (threadIdx.x == 0) (void)xb_add(&bar[XB_XCNT(b.x)], 1u);
    return b;
}
__device__ __forceinline__ void xcd_barrier_complete(unsigned* bar, unsigned x, unsigned& nloc, unsigned& nx) {
    const unsigned G = gridDim.x * gridDim.y * gridDim.z;
    unsigned sum, cnt, mine, sp = 0u;
    for (;;) {
        sum = 0u; cnt = 0u; mine = 0u;
#pragma unroll
        for (unsigned j = 0; j < 16; ++j) { const unsigned c = xb_ld(&bar[XB_XCNT(j)]); sum += c; cnt += (c > 0u) ? 1u : 0u; mine = (j == x) ? c : mine; }
        if (sum == G) break;
        __builtin_amdgcn_s_sleep(1);
        if ((++sp & 255u) == 0u) { if (xb_ld(&bar[XB_TMO])) break; if (sp > XB_SPIN_CAP) { atomicAdd(&bar[XB_TMO], 1u); break; } }
    }
    nloc = mine > 0u ? mine : 1u; nx = cnt > 0u ? cnt : 1u;
}

__device__ __forceinline__ void xcd_barrier(const XcdBarrier& b) {
    asm volatile("s_waitcnt vmcnt(0)" ::: "memory");
    __syncthreads();
    if (threadIdx.x == 0) {
        unsigned* bar = b.bar;
        __builtin_amdgcn_s_waitcnt(0);
        unsigned nloc = b.st[0], nx = b.st[1];
        if (nloc == 0u) { xcd_barrier_complete(bar, b.x, nloc, nx); b.st[0] = nloc; b.st[1] = nx; }
        const unsigned old = xb_add(&bar[XB_XSUB(b.x)], 1u);
        const unsigned gen = old / nloc;
        if (old + 1u == (gen + 1u) * nloc) {
            __builtin_amdgcn_fence(__ATOMIC_RELEASE, "agent");
            asm volatile("s_waitcnt vmcnt(0)" ::: "memory");
            const unsigned og = xb_add(&bar[XB_TOP], 1u);
            const unsigned tg = og / nx;
            if (og + 1u == (tg + 1u) * nx) xb_add(&bar[XB_TOPGEN], 1u);
            else XB_SPIN(xb_ld(&bar[XB_TOPGEN]) == tg, bar);
            __builtin_amdgcn_fence(__ATOMIC_ACQUIRE, "agent");
            xb_add(&bar[XB_XGEN(b.x)], 1u);
            asm volatile("s_waitcnt vmcnt(0)" ::: "memory");
        } else {
            XB_SPIN(xb_ld(&bar[XB_XGEN(b.x)]) == gen, bar);
            __builtin_amdgcn_fence(__ATOMIC_ACQUIRE, "agent");
            asm volatile("s_waitcnt vmcnt(0)" ::: "memory");
        }
    }
    __syncthreads();
}

__device__ __forceinline__ float wave_sum(float v, int lane) {
#pragma unroll
    for (int o = 1; o < 64; o <<= 1) v += shx(v, o, lane);
    return v;
}
__device__ __forceinline__ void* ldptr(LAS unsigned char* lds, int i) {
    const unsigned long long v = ((const LAS unsigned long long*)(lds + LDSCTL_OFF + 1024))[i];
    const unsigned lo = __builtin_amdgcn_readfirstlane((unsigned)v), hi = __builtin_amdgcn_readfirstlane((unsigned)(v >> 32));
    return (void*)(((unsigned long long)hi << 32) | lo);
}
struct OffsetOrder {
    pg8::StaticOrder S;
    __device__ void init(int M, int N, int G, int c, int off) { S.init(M, N, G, (c + G - off % G) % G); }
    __device__ bool next(int i, pg8::Unit& u) const { return S.next(i, u); }
    __device__ __forceinline__ void a_ready(const pg8::Unit&) const {}
    __device__ __forceinline__ void done(const pg8::Unit&) const {}
};

template <bool PERMQKV>
__device__ __forceinline__ void transpose_item(const float* W, int K, int N, bf16* WT, LAS float* scr, int item, int lane, const float* gk = nullptr) {
    const int nblk = N / 32, kb = item / nblk, nb = item % nblk, k0 = 64 * kb, n0 = 32 * nb;
    int d0 = n0;
    if (PERMQKV) { const int within = n0 & 255; d0 = (n0 & ~255) + 128 * ((within >> 5) & 1) + 32 * (within >> 6); }
#pragma unroll 8
    for (int i = 0; i < 32; ++i) { const int kk = 2 * i + (lane >> 5); scr[kk * 33 + (lane & 31)] = W[(size_t)(k0 + kk) * N + n0 + (lane & 31)] * (gk ? gk[k0 + kk] : 1.f); }
    LDS_WAIT(); asm volatile("" ::: "memory");
    const int c = lane & 7;
#pragma unroll
    for (int j = 0; j < 4; ++j) { const int n = (lane >> 3) + 8 * j; const LAS float* s = scr + (8 * c) * 33 + n;
        v4u o; o.x = pk2(s[0 * 33], s[1 * 33]); o.y = pk2(s[2 * 33], s[3 * 33]); o.z = pk2(s[4 * 33], s[5 * 33]); o.w = pk2(s[6 * 33], s[7 * 33]);
        *(GAS v4u*)(WT + (size_t)(d0 + n) * K + k0 + 8 * c) = o; }
    LDS_WAIT(); asm volatile("" ::: "memory");
}
__device__ __forceinline__ void convert_bf16(const float* src, bf16* dst, size_t n, size_t gtid, size_t nthreads) {
    for (size_t i = gtid * 8; i < n; i += nthreads * 8) {
        const f32x4 a = *(const GAS f32x4*)(src + i), b = *(const GAS f32x4*)(src + i + 4);
        v4u o; o.x = pk2(a[0], a[1]); o.y = pk2(a[2], a[3]); o.z = pk2(b[0], b[1]); o.w = pk2(b[2], b[3]);
        *(GAS v4u*)(dst + i) = o;
    }
}
__device__ __forceinline__ int t5_bucket(int rel) {
    const int n = rel < 0 ? -rel : rel;
    const int b = n < 8 ? n : n < 12 ? 8 : n < 16 ? 9 : n < 23 ? 10 : n < 32 ? 11 : n < 46 ? 12 : n < 64 ? 13 : n < 91 ? 14 : 15;
    return b + (rel > 0 ? 16 : 0);
}
__constant__ float ROPE_INV[16] = {1.000000000e+00f, 5.623413324e-01f, 3.162277639e-01f, 1.778279394e-01f, 1.000000015e-01f, 5.623413250e-02f, 3.162277490e-02f, 1.778279431e-02f,
                                   9.999999776e-03f, 5.623413250e-03f, 3.162277630e-03f, 1.778279431e-03f, 1.000000047e-03f, 5.623413017e-04f, 3.162277571e-04f, 1.778279402e-04f};

__device__ __forceinline__ void rms_row_to_bf16(const float* xrow, const float* g0, bf16* o0, const float* g1, bf16* o1, int lane) {
    const GAS f32x4* xr = (const GAS f32x4*)xrow + lane;
    f32x4 v[8]; float s = 0.f;
#pragma unroll
    for (int j = 0; j < 8; ++j) { v[j] = xr[64 * j]; s += (v[j].x * v[j].x + v[j].y * v[j].y) + (v[j].z * v[j].z + v[j].w * v[j].w); }
    const float rstd = 1.f / sqrtf(wave_sum(s, lane) * (1.f / DM) + EPS);
    {   const GAS f32x4* gr = (const GAS f32x4*)g0 + lane; GAS v2u* o8 = (GAS v2u*)o0 + lane;
#pragma unroll
        for (int j = 0; j < 8; ++j) { const f32x4 gg = gr[64 * j]; v2u w; w.x = pk2(v[j].x * rstd * gg.x, v[j].y * rstd * gg.y); w.y = pk2(v[j].z * rstd * gg.z, v[j].w * rstd * gg.w); o8[64 * j] = w; } }
    if (g1) { const GAS f32x4* gr = (const GAS f32x4*)g1 + lane; GAS v2u* o8 = (GAS v2u*)o1 + lane;
#pragma unroll
        for (int j = 0; j < 8; ++j) { const f32x4 gg = gr[64 * j]; v2u w; w.x = pk2(v[j].x * rstd * gg.x, v[j].y * rstd * gg.y); w.y = pk2(v[j].z * rstd * gg.z, v[j].w * rstd * gg.w); o8[64 * j] = w; } }
}
__device__ __forceinline__ void prep_row(const float* xrow, bf16* orow, u64_t* sq, int lane) {
    const GAS f32x4* xr = (const GAS f32x4*)xrow + lane; GAS v2u* o8 = (GAS v2u*)orow + lane; float s = 0.f;
#pragma unroll
    for (int j = 0; j < 8; ++j) { const f32x4 v = xr[64 * j]; s += (v.x * v.x + v.y * v.y) + (v.z * v.z + v.w * v.w); v2u w; w.x = pk2(v.x, v.y); w.y = pk2(v.z, v.w); o8[64 * j] = w; }
    s = wave_sum(s, lane);
    if (lane == 0) *sq = rowsq_fx(s);
}
__device__ __forceinline__ void norm_rows(const float* X, const float* g, bf16* XN, int gw, int NGW, int lane) {
    for (int m = gw; m < T; m += NGW) rms_row_to_bf16(X + (size_t)m * DM, g, XN + (size_t)m * DM, nullptr, nullptr, lane);
}

template <int TYPE>
__device__ __forceinline__ void naive_attn_item(const bf16* QKV, bf16* ATT, int b, int grow, int head, int lane, const float* biasA, const float* sink, const float* rpb) {
    const int tpos = grow * 64 + lane; const size_t trow = (size_t)b * SEQ + tpos;
    int qcol, kcol, vcol, ocol;
    if (TYPE == 0) { qcol = QA + head * 64; kcol = KA + (head / 3) * 64; vcol = VA + (head / 3) * 64; ocol = OA + head * 64; }
    else if (TYPE == 1) { qcol = QB + head * 64; kcol = KB + head * 64; vcol = VB + head * 64; ocol = OB + head * 64; }
    else { qcol = QC + head * 64; kcol = KC + (head / 3) * 64; vcol = VC + (head / 3) * 64; ocol = OC + head * 64; }
    float q[64], o[64];
#pragma unroll
    for (int c = 0; c < 8; ++c) { const v4u w = *(const GAS v4u*)(QKV + trow * DIN + qcol + 8 * c);
        q[8 * c + 0] = bflo(w.x); q[8 * c + 1] = bfhi(w.x); q[8 * c + 2] = bflo(w.y); q[8 * c + 3] = bfhi(w.y); q[8 * c + 4] = bflo(w.z); q[8 * c + 5] = bfhi(w.z); q[8 * c + 6] = bflo(w.w); q[8 * c + 7] = bfhi(w.w); }
#pragma unroll
    for (int d = 0; d < 64; ++d) o[d] = 0.f;
    float m = -1e30f, l = 0.f;
    int j0, j1;
    if (TYPE == 0) { j0 = grow * 64 - 128; if (j0 < 0) j0 = 0; j1 = grow * 64 + 63 + 128; if (j1 > SEQ - 1) j1 = SEQ - 1; }
    else if (TYPE == 1) { int r0 = grow - 4; r0 = r0 < 0 ? 0 : (r0 > 24 ? 24 : r0); j0 = r0 * 64; j1 = j0 + 511; }
    else { j0 = 0; j1 = SEQ - 1; }
    int c0 = lane - 8; c0 = c0 < 0 ? 0 : (c0 > 48 ? 48 : c0);
#pragma unroll 1
    for (int j = j0; j <= j1; ++j) {
        const bf16* krow = QKV + ((size_t)b * SEQ + j) * DIN;
        float s = 0.f;
#pragma unroll
        for (int c = 0; c < 8; ++c) { const v4u w = *(const GAS v4u*)(krow + kcol + 8 * c);
            s += q[8 * c + 0] * bflo(w.x) + q[8 * c + 1] * bfhi(w.x) + q[8 * c + 2] * bflo(w.y) + q[8 * c + 3] * bfhi(w.y) + q[8 * c + 4] * bflo(w.z) + q[8 * c + 5] * bfhi(w.z) + q[8 * c + 6] * bflo(w.w) + q[8 * c + 7] * bfhi(w.w); }
        bool valid = true;
        if (TYPE == 0) { const int rel = j - tpos; valid = (rel >= -128 && rel <= 128); if (valid) s += biasA[head * 257 + rel + 128]; }
        if (TYPE == 1) { const int kr = j >> 6, kc = j & 63; valid = (kc >= c0 && kc < c0 + 16); if (valid) s += rpb[(head * 15 + (kr - grow + 7)) * 31 + (kc - lane + 15)]; }
        const float mn = valid ? fmaxf(m, s) : m;
        const float a = __expf(m - mn);
        const float p = valid ? __expf(s - mn) : 0.f;
        l = l * a + p; m = mn;
#pragma unroll
        for (int c = 0; c < 8; ++c) { const v4u w = *(const GAS v4u*)(krow + vcol + 8 * c);
            o[8 * c + 0] = o[8 * c + 0] * a + p * bflo(w.x); o[8 * c + 1] = o[8 * c + 1] * a + p * bfhi(w.x); o[8 * c + 2] = o[8 * c + 2] * a + p * bflo(w.y); o[8 * c + 3] = o[8 * c + 3] * a + p * bfhi(w.y);
            o[8 * c + 4] = o[8 * c + 4] * a + p * bflo(w.z); o[8 * c + 5] = o[8 * c + 5] * a + p * bfhi(w.z); o[8 * c + 6] = o[8 * c + 6] * a + p * bflo(w.w); o[8 * c + 7] = o[8 * c + 7] * a + p * bfhi(w.w); }
    }
    if (TYPE == 0) l += __expf(sink[head] - m);
    const float inv = 1.f / l;
#pragma unroll
    for (int c = 0; c < 8; ++c) { v4u w; w.x = pk2(o[8 * c + 0] * inv, o[8 * c + 1] * inv); w.y = pk2(o[8 * c + 2] * inv, o[8 * c + 3] * inv); w.z = pk2(o[8 * c + 4] * inv, o[8 * c + 5] * inv); w.w = pk2(o[8 * c + 6] * inv, o[8 * c + 7] * inv);
        *(GAS v4u*)(ATT + trow * DM + ocol + 8 * c) = w; }
}
__device__ __forceinline__ float rdl(float v, int l) { return __builtin_bit_cast(float, __builtin_amdgcn_readlane(__builtin_bit_cast(int, v), l)); }
__device__ __forceinline__ void naive_mem_item(const bf16* QM, const bf16* KVM, bf16* OM, const float* gq, size_t trow, int b, int head, int lane) {
    const unsigned qw = *(const GAS unsigned*)(QM + trow * MEMW + head * 128 + 2 * lane);
    float q0 = bflo(qw), q1 = bfhi(qw);
    const float ss = wave_sum(q0 * q0 + q1 * q1, lane);
    const float r = 0.08838834764831845f / sqrtf(ss * (1.f / 128.f) + EPS);
    q0 *= r * gq[2 * lane]; q1 *= r * gq[2 * lane + 1];
    const bf16* kbase = KVM + ((size_t)b * NMEM + lane) * 1024 + head * 128;
    float s[4] = {0.f, 0.f, 0.f, 0.f};
#pragma unroll 1
    for (int c = 0; c < 16; ++c) {
        float qa[8];
#pragma unroll
        for (int e = 0; e < 4; ++e) { qa[2 * e] = rdl(q0, 4 * c + e); qa[2 * e + 1] = rdl(q1, 4 * c + e); }
#pragma unroll
        for (int i = 0; i < 4; ++i) { const v4u w = *(const GAS v4u*)(kbase + (size_t)i * 64 * 1024 + 8 * c);
            s[i] += qa[0] * bflo(w.x) + qa[1] * bfhi(w.x) + qa[2] * bflo(w.y) + qa[3] * bfhi(w.y) + qa[4] * bflo(w.z) + qa[5] * bfhi(w.z) + qa[6] * bflo(w.w) + qa[7] * bfhi(w.w); }
    }
    float m = fmaxf(fmaxf(s[0], s[1]), fmaxf(s[2], s[3]));
#pragma unroll
    for (int o = 1; o < 64; o <<= 1) m = fmaxf(m, shx(m, o, lane));
    float p[4]; float l = 0.f;
#pragma unroll
    for (int i = 0; i < 4; ++i) { p[i] = __expf(s[i] - m); l += p[i]; }
    l = wave_sum(l, lane);
    const bf16* vbase = KVM + ((size_t)b * NMEM) * 1024 + 512 + head * 128 + 2 * lane;
    float o0 = 0.f, o1 = 0.f;
#pragma unroll
    for (int i = 0; i < 4; ++i) {
#pragma unroll 4
        for (int jj = 0; jj < 64; ++jj) { const float pj = rdl(p[i], jj); const unsigned w = *(const GAS unsigned*)(vbase + (size_t)(64 * i + jj) * 1024); o0 += pj * bflo(w); o1 += pj * bfhi(w); }
    }
    const float inv = 1.f / l;
    *(GAS unsigned*)(OM + trow * MEMW + head * 128 + 2 * lane) = pk2(o0 * inv, o1 * inv);
}
__device__ __forceinline__ void mixnorm_rows(bf16* ATT, const float* g, int gw, int NGW, int lane) {
    for (int m = gw; m < T; m += NGW) {
        GAS v4u* p = (GAS v4u*)(ATT + (size_t)m * DM + 32 * lane);
        v4u w[4]; float f[32]; float ss = 0.f;
#pragma unroll
        for (int c = 0; c < 4; ++c) { w[c] = p[c];
            f[8 * c + 0] = bflo(w[c].x); f[8 * c + 1] = bfhi(w[c].x); f[8 * c + 2] = bflo(w[c].y); f[8 * c + 3] = bfhi(w[c].y); f[8 * c + 4] = bflo(w[c].z); f[8 * c + 5] = bfhi(w[c].z); f[8 * c + 6] = bflo(w[c].w); f[8 * c + 7] = bfhi(w[c].w); }
#pragma unroll
        for (int i = 0; i < 32; ++i) ss += f[i] * f[i];
        const int grp = lane < 24 ? 0 : (lane < 40 ? 1 : 2);
        const float sa = wave_sum(grp == 0 ? ss : 0.f, lane), sb = wave_sum(grp == 1 ? ss : 0.f, lane), sc = wave_sum(grp == 2 ? ss : 0.f, lane);
        const float r = grp == 0 ? 1.f / sqrtf(sa * (1.f / 768.f) + EPS) : (grp == 1 ? 1.f / sqrtf(sb * (1.f / 512.f) + EPS) : 1.f / sqrtf(sc * (1.f / 768.f) + EPS));
        const float* gg = g + 32 * lane;
#pragma unroll
        for (int c = 0; c < 4; ++c) { const f32x4 g0 = *(const GAS f32x4*)(gg + 8 * c), g1 = *(const GAS f32x4*)(gg + 8 * c + 4);
            v4u o; o.x = pk2(f[8 * c + 0] * r * g0[0], f[8 * c + 1] * r * g0[1]); o.y = pk2(f[8 * c + 2] * r * g0[2], f[8 * c + 3] * r * g0[3]);
            o.z = pk2(f[8 * c + 4] * r * g1[0], f[8 * c + 5] * r * g1[1]); o.w = pk2(f[8 * c + 6] * r * g1[2], f[8 * c + 7] * r * g1[3]); p[c] = o; }
    }
}

#ifndef PEER_HD
#define PEER_HD __device__ __forceinline__
#define PEER_EXP(x) __expf(x)
#endif
template <int N> PEER_HD void bitonic_sort_desc(float* v) {
#pragma unroll
    for (int k = 2; k <= N; k <<= 1)
#pragma unroll
        for (int j = k >> 1; j > 0; j >>= 1)
#pragma unroll
            for (int i = 0; i < N; ++i) { const int l = i ^ j; if (l > i) { const bool desc = ((i & k) == 0); const float a = v[i], b = v[l]; const float hi = fmaxf(a, b), lo = fminf(a, b);
                v[i] = desc ? hi : lo; v[l] = desc ? lo : hi; } }
}
PEER_HD void merge_top16(float* a, const float* b) {
    float c[16];
#pragma unroll
    for (int i = 0; i < 16; ++i) c[i] = fmaxf(a[i], b[15 - i]);
#pragma unroll
    for (int j = 8; j > 0; j >>= 1)
#pragma unroll
        for (int i = 0; i < 16; ++i) { const int l = i ^ j; if (l > i) { const float x = c[i], y = c[l]; c[i] = fmaxf(x, y); c[l] = fminf(x, y); } }
#pragma unroll
    for (int i = 0; i < 16; ++i) a[i] = c[i];
}
PEER_HD void top16_of_64(float (&v)[64]) {
    bitonic_sort_desc<16>(&v[0]); bitonic_sort_desc<16>(&v[16]); bitonic_sort_desc<16>(&v[32]); bitonic_sort_desc<16>(&v[48]);
    merge_top16(&v[0], &v[16]); merge_top16(&v[32], &v[48]); merge_top16(&v[0], &v[32]);
}
PEER_HD float pack_idx(float s, unsigned idx, unsigned mask) { return __builtin_bit_cast(float, (__builtin_bit_cast(unsigned, s) & ~mask) | idx); }
PEER_HD unsigned low_bits(float s, unsigned mask) { return __builtin_bit_cast(unsigned, s) & mask; }
PEER_HD unsigned pick16(const float* a, unsigned i, unsigned mask) {
    unsigned r = 0;
#pragma unroll
    for (unsigned k = 0; k < 16; ++k) r = (i == k) ? low_bits(a[k], mask) : r;
    return r;
}
PEER_HD void peer_candidates(const float* a, const float* b, int* e, float* gate) {
    float c[64]; int n = 0;
#pragma unroll
    for (int i = 0; i < 16; ++i)
#pragma unroll
        for (int j = 0; j < 16; ++j) if ((i + 1) * (j + 1) <= 16) { c[n] = pack_idx(a[i] + b[j], (unsigned)(i * 16 + j), 0xffu); ++n; }
#pragma unroll
    for (int k = 50; k < 64; ++k) c[k] = -3.0e38f;
    top16_of_64(c);
    float mx = c[0], den = 0.f;
#pragma unroll
    for (int k = 0; k < 16; ++k) { const unsigned id = low_bits(c[k], 0xffu); const unsigned n0 = pick16(a, id >> 4, 0x7fu), n1 = pick16(b, id & 15u, 0x7fu);
        e[k] = (int)(n0 * 128u + n1); gate[k] = PEER_EXP(c[k] - mx); den += gate[k]; }
    const float inv = 1.f / den;
#pragma unroll
    for (int k = 0; k < 16; ++k) gate[k] *= inv;
}

__device__ __forceinline__ void peer_select_unit(const bf16* QP, const bf16* PK, int* PIDX, float* PGATE, int tb, int h, int wave, int lane) {
    const int hh = lane >> 5, tl = lane & 31; const size_t t = (size_t)tb * 256 + wave * 32 + tl;
    float ab[2][16];
#pragma unroll
    for (int p = 0; p < 2; ++p) {
        bf16x8 bq[8];
#pragma unroll
        for (int s = 0; s < 8; ++s) bq[s] = *(const GAS bf16x8*)(QP + t * DM + 256 * h + 128 * p + 16 * s + 8 * hh);
        float v[64];
#pragma unroll
        for (int nb = 0; nb < 4; ++nb) {
            f32x16 acc;
#pragma unroll
            for (int r = 0; r < 16; ++r) acc[r] = 0.f;
            const bf16* kp = PK + ((size_t)((h * 2 + p) * 128 + 32 * nb + tl)) * 128 + 8 * hh;
#pragma unroll
            for (int s = 0; s < 8; ++s) { const bf16x8 ak = *(const GAS bf16x8*)(kp + 16 * s); acc = __builtin_amdgcn_mfma_f32_32x32x16_bf16(ak, bq[s], acc, 0, 0, 0); }
#pragma unroll
            for (int r = 0; r < 16; ++r) v[16 * nb + r] = pack_idx(acc[r], (unsigned)(32 * nb + 8 * (r >> 2) + 4 * hh + (r & 3)), 0x7fu);
        }
        top16_of_64(v);
        float pv[16];
#pragma unroll
        for (int i = 0; i < 16; ++i) pv[i] = shx(v[i], 32, lane);
        merge_top16(&v[0], pv);
#pragma unroll
        for (int i = 0; i < 16; ++i) ab[p][i] = v[i];
    }
    int e[16]; float gate[16];
    peer_candidates(ab[0], ab[1], e, gate);
    if (hh == 0) { GAS v4u* o = (GAS v4u*)(PIDX + t * 128 + h * 16);
#pragma unroll
        for (int c = 0; c < 4; ++c) o[c] = (v4u){(unsigned)e[4 * c], (unsigned)e[4 * c + 1], (unsigned)e[4 * c + 2], (unsigned)e[4 * c + 3]}; }
    else { GAS f32x4* o = (GAS f32x4*)(PGATE + t * 128 + h * 16);
#pragma unroll
        for (int c = 0; c < 4; ++c) o[c] = (f32x4){gate[4 * c], gate[4 * c + 1], gate[4 * c + 2], gate[4 * c + 3]}; }
}

__device__ __forceinline__ float dot8(const v4u& x, const v4u& u) {
    return bflo(x.x) * bflo(u.x) + bfhi(x.x) * bfhi(u.x) + bflo(x.y) * bflo(u.y) + bfhi(x.y) * bfhi(u.y) + bflo(x.z) * bflo(u.z) + bfhi(x.z) * bfhi(u.z) + bflo(x.w) * bflo(u.w) + bfhi(x.w) * bfhi(u.w);
}
__device__ __forceinline__ void axpy8(float* y, float w, const v4u& v) {
    y[0] += w * bflo(v.x); y[1] += w * bfhi(v.x); y[2] += w * bflo(v.y); y[3] += w * bfhi(v.y); y[4] += w * bflo(v.z); y[5] += w * bfhi(v.z); y[6] += w * bflo(v.w); y[7] += w * bfhi(v.w);
}
__device__ __forceinline__ void peer_gather(const bf16* XN, const bf16* PU, const bf16* PV, const int* PIDX, const float* PGATE, float* X, int gw, int NGW, int lane) {
    for (int t = gw; t < T; t += NGW) {
        v4u xv[4];
#pragma unroll
        for (int j = 0; j < 4; ++j) xv[j] = *(const GAS v4u*)(XN + (size_t)t * DM + 8 * lane + 512 * j);
        float y[32];
#pragma unroll
        for (int i = 0; i < 32; ++i) y[i] = 0.f;
        for (int k = 0; k < 128; k += 2) {
            const int e0 = __builtin_amdgcn_readfirstlane(PIDX[(size_t)t * 128 + k]), e1 = __builtin_amdgcn_readfirstlane(PIDX[(size_t)t * 128 + k + 1]);
            const float g0 = PGATE[(size_t)t * 128 + k], g1 = PGATE[(size_t)t * 128 + k + 1];
            v4u u0[4], u1[4], v0[4], v1[4];
#pragma unroll
            for (int j = 0; j < 4; ++j) { u0[j] = *(const GAS v4u*)(PU + (size_t)e0 * DM + 8 * lane + 512 * j); u1[j] = *(const GAS v4u*)(PU + (size_t)e1 * DM + 8 * lane + 512 * j); }
#pragma unroll
            for (int j = 0; j < 4; ++j) { v0[j] = *(const GAS v4u*)(PV + (size_t)e0 * DM + 8 * lane + 512 * j); v1[j] = *(const GAS v4u*)(PV + (size_t)e1 * DM + 8 * lane + 512 * j); }
            float d0 = 0.f, d1 = 0.f;
#pragma unroll
            for (int j = 0; j < 4; ++j) { d0 += dot8(xv[j], u0[j]); d1 += dot8(xv[j], u1[j]); }
            d0 = wave_sum(d0, lane); d1 = wave_sum(d1, lane);
            const float w0 = g0 * 0.5f * d0 * (1.f + erff(d0 * 0.70710678118654752f)), w1 = g1 * 0.5f * d1 * (1.f + erff(d1 * 0.70710678118654752f));
#pragma unroll
            for (int j = 0; j < 4; ++j) { axpy8(&y[8 * j], w0, v0[j]); axpy8(&y[8 * j], w1, v1[j]); }
        }
#pragma unroll
        for (int j = 0; j < 4; ++j) { GAS f32x4* xp = (GAS f32x4*)(X + (size_t)t * DM + 8 * lane + 512 * j);
            f32x4 a = xp[0], b = xp[1]; a += (f32x4){y[8 * j], y[8 * j + 1], y[8 * j + 2], y[8 * j + 3]}; b += (f32x4){y[8 * j + 4], y[8 * j + 5], y[8 * j + 6], y[8 * j + 7]}; xp[0] = a; xp[1] = b; }
    }
}


typedef float f32x2 __attribute__((ext_vector_type(2)));
constexpr float PU_SCALE = 256.f, PV_SCALE = 16.f;
__device__ __forceinline__ void convert_fp8(const float* src, unsigned char* dst, size_t n, float scale, size_t gtid, size_t nthreads) {
    for (size_t i = gtid * 16; i < n; i += nthreads * 16) {
        v4u o;
#pragma unroll
        for (int c = 0; c < 4; ++c) { f32x4 a = *(const GAS f32x4*)(src + i + 4 * c) * scale;
#pragma unroll
            for (int e = 0; e < 4; ++e) a[e] = fminf(fmaxf(a[e], -448.f), 448.f);
            int p = 0; p = __builtin_amdgcn_cvt_pk_fp8_f32(a[0], a[1], p, false); p = __builtin_amdgcn_cvt_pk_fp8_f32(a[2], a[3], p, true); o[c] = (unsigned)p; }
        *(GAS v4u*)(dst + i) = o;
    }
}
__device__ __forceinline__ void dot16_fp8(f32x2& acc, const v4u& w, const f32x2* x) {
#pragma unroll
    for (int c = 0; c < 4; ++c) { acc += __builtin_amdgcn_cvt_pk_f32_fp8((int)w[c], false) * x[2 * c]; acc += __builtin_amdgcn_cvt_pk_f32_fp8((int)w[c], true) * x[2 * c + 1]; }
}
__device__ __forceinline__ void axpy16_fp8(f32x2* y, const f32x2 wv, const v4u& w) {
#pragma unroll
    for (int c = 0; c < 4; ++c) { y[2 * c] += __builtin_amdgcn_cvt_pk_f32_fp8((int)w[c], false) * wv; y[2 * c + 1] += __builtin_amdgcn_cvt_pk_f32_fp8((int)w[c], true) * wv; }
}
#define PG_R 4
#define PG_LOAD(buf, tab, idlo, idhi, g) do { _Pragma("unroll") for (int i_ = 0; i_ < PG_R; ++i_) { const int k_ = (g) * PG_R + i_; \
        const int e_ = __builtin_amdgcn_readlane(k_ < 64 ? idlo : idhi, k_ & 63); const unsigned char* rp_ = (tab) + (size_t)(unsigned)e_ * 2048u; \
        buf[i_][0] = *(const GAS v4u*)(rp_ + voff); buf[i_][1] = *(const GAS v4u*)(rp_ + voff + 1024); } } while (0)
#define PG_DOT(buf, g) do { float p_[4]; _Pragma("unroll") for (int i_ = 0; i_ < 4; ++i_) { f32x2 a_ = {0.f, 0.f}; dot16_fp8(a_, buf[i_][0], &x[0]); dot16_fp8(a_, buf[i_][1], &x[8]); p_[i_] = a_.x + a_.y; __builtin_amdgcn_sched_barrier(0); } \
        float r_[2]; _Pragma("unroll") for (int i_ = 0; i_ < 2; ++i_) { const float keep_ = b5 ? p_[i_ + 2] : p_[i_], send_ = b5 ? p_[i_] : p_[i_ + 2]; r_[i_] = keep_ + shx(send_, 32, lane); } \
        float s_; { const float keep_ = b4 ? r_[1] : r_[0], send_ = b4 ? r_[0] : r_[1]; s_ = keep_ + shx(send_, 16, lane); } \
        s_ += shx(s_, 8, lane); s_ += shx(s_, 4, lane); s_ += shx(s_, 2, lane); s_ += shx(s_, 1, lane); \
        if ((lane & 15) == 0) wl[(g) * 4 + (lane >> 4)] = s_; } while (0)
#define PG_AXPY(buf, g) do { _Pragma("unroll") for (int i_ = 0; i_ < PG_R; ++i_) { const float w_ = wl[(g) * PG_R + i_]; const f32x2 wv_ = {w_, w_}; axpy16_fp8(&y[0], wv_, buf[i_][0]); axpy16_fp8(&y[8], wv_, buf[i_][1]); __builtin_amdgcn_sched_barrier(0); } } while (0)
__device__ __forceinline__ void peer_gather8(const bf16* XN, const unsigned char* PU8, const unsigned char* PV8, const int* PIDX, const float* PGATE, float* X, LAS float* wl, int gw, int NGW, int lane) {
    const bool b5 = (lane >> 5) & 1, b4 = (lane >> 4) & 1; const unsigned voff = 16u * (unsigned)lane;
    for (int t = gw; t < T; t += NGW) {
        const unsigned l4 = 4u * (unsigned)lane; const char* pidx_t = (const char*)(PIDX + (size_t)t * 128); const char* pgate_t = (const char*)(PGATE + (size_t)t * 128);
        const int idlo = *(const GAS int*)(pidx_t + l4), idhi = *(const GAS int*)(pidx_t + l4 + 256);
        v4u A[PG_R][2], B[PG_R][2];
        PG_LOAD(A, PU8, idlo, idhi, 0);
        f32x2 x[16];
        {   const char* xr = (const char*)(XN + (size_t)t * DM); const unsigned l32 = 32u * (unsigned)lane;
            const v4u a0 = *(const GAS v4u*)(xr + l32), a1 = *(const GAS v4u*)(xr + l32 + 16), c0 = *(const GAS v4u*)(xr + l32 + 2048), c1 = *(const GAS v4u*)(xr + l32 + 2064);
#pragma unroll
            for (int c = 0; c < 4; ++c) { x[c] = (f32x2){bflo(a0[c]), bfhi(a0[c])} * (1.f / PU_SCALE); x[4 + c] = (f32x2){bflo(a1[c]), bfhi(a1[c])} * (1.f / PU_SCALE);
                                          x[8 + c] = (f32x2){bflo(c0[c]), bfhi(c0[c])} * (1.f / PU_SCALE); x[12 + c] = (f32x2){bflo(c1[c]), bfhi(c1[c])} * (1.f / PU_SCALE); } }
#pragma unroll 1
        for (int g = 0; g < 128 / PG_R; g += 2) {
            PG_LOAD(B, PU8, idlo, idhi, g + 1);
            PG_DOT(A, g);
            if (g + 2 < 128 / PG_R) PG_LOAD(A, PU8, idlo, idhi, g + 2); else PG_LOAD(A, PV8, idlo, idhi, 0);
            PG_DOT(B, g + 1);
        }
        LDS_WAIT();
        {
            const float g0 = *(const GAS float*)(pgate_t + l4), g1 = *(const GAS float*)(pgate_t + l4 + 256);
            const float d0 = wl[lane], d1 = wl[64 + lane];
            const float w0 = g0 * 0.5f * d0 * (1.f + erff(d0 * 0.70710678118654752f)) * (1.f / PV_SCALE), w1 = g1 * 0.5f * d1 * (1.f + erff(d1 * 0.70710678118654752f)) * (1.f / PV_SCALE);
            LDS_WAIT(); asm volatile("" ::: "memory");
            wl[lane] = w0; wl[64 + lane] = w1;
            LDS_WAIT(); asm volatile("" ::: "memory");
        }
        f32x2 y[16];
#pragma unroll
        for (int i = 0; i < 16; ++i) y[i] = (f32x2){0.f, 0.f};
#pragma unroll 1
        for (int g = 0; g < 128 / PG_R; g += 2) {
            PG_LOAD(B, PV8, idlo, idhi, g + 1);
            PG_AXPY(A, g);
            if (g + 2 < 128 / PG_R) PG_LOAD(A, PV8, idlo, idhi, g + 2);
            PG_AXPY(B, g + 1);
        }
        {   char* xo = (char*)(X + (size_t)t * DM); const unsigned l64 = 64u * (unsigned)lane;
#pragma unroll
            for (int h = 0; h < 2; ++h)
#pragma unroll
                for (int c = 0; c < 4; ++c) { GAS f32x4* p = (GAS f32x4*)(xo + l64 + 4096 * h + 16 * c); f32x4 v = *p; v += (f32x4){y[8 * h + 2 * c].x, y[8 * h + 2 * c].y, y[8 * h + 2 * c + 1].x, y[8 * h + 2 * c + 1].y}; *p = v; } }
        LDS_WAIT(); asm volatile("" ::: "memory");
    }
}


typedef unsigned v6u __attribute__((ext_vector_type(6)));
typedef float v32f __attribute__((ext_vector_type(32)));
typedef v4u __attribute__((aligned(8))) v4u_a8;
constexpr float PU_SCALE6 = 90.0f, PV_SCALE6 = 5.65f;
__device__ __forceinline__ unsigned enc_e2m3(float v) {
    const float a = fminf(fabsf(v), 7.5f);
    unsigned code;
    if (a < 1.0f) code = (unsigned)__builtin_rintf(a * 8.f);
    else { const unsigned b = __builtin_bit_cast(unsigned, a) - 0x3F800000u; code = ((b + 0x7FFFFu + ((b >> 20) & 1u)) >> 20) + 8u; }
    return code | (v < 0.f ? 32u : 0u);
}
__device__ __forceinline__ void convert_fp6_rows(const float* src, unsigned char* dst, int nrows, float scale, const float* gain, int gw, int NGW, int lane) {
    for (int r = gw; r < nrows; r += NGW) {
        const float* sp = src + (size_t)r * DM + 4 * lane; const float* gp = gain ? gain + (size_t)(r / PEER_N) * DM + 4 * lane : nullptr;
        unsigned w[6] = {0u, 0u, 0u, 0u, 0u, 0u};
#pragma unroll
        for (int j = 0; j < 8; ++j) { f32x4 a = *(const GAS f32x4*)(sp + 256 * j) * scale; if (gp) a = a * *(const GAS f32x4*)(gp + 256 * j);
#pragma unroll
            for (int e = 0; e < 4; ++e) { const unsigned code = enc_e2m3(a[e]); const int bp = 6 * (4 * j + e), wi = bp >> 5, sh = bp & 31;
                w[wi] |= code << sh; if (sh > 26) w[wi + 1] |= code >> (32 - sh); } }
        unsigned char* dp = dst + (size_t)r * 1536 + 24 * lane;
        *(GAS v4u_a8*)dp = (v4u){w[0], w[1], w[2], w[3]}; *(GAS v2u*)(dp + 16) = (v2u){w[4], w[5]};
    }
}
constexpr float PV_SCALE4 = 5.65f;
__device__ __forceinline__ unsigned enc_e2m1(float v) {
    const float a = fabsf(v);
    const unsigned code = a < 0.25f ? 0u : a < 0.75f ? 1u : a < 1.25f ? 2u : a < 1.75f ? 3u : a < 2.5f ? 4u : a < 3.5f ? 5u : a < 5.0f ? 6u : 7u;
    return code | (v < 0.f ? 8u : 0u);
}
__device__ __forceinline__ void convert_fp4_rows(const float* src, unsigned char* dst, int nrows, float scale, int gw, int NGW, int lane) {
    for (int r = gw; r < nrows; r += NGW) {
        const float* sp = src + (size_t)r * DM + 4 * lane;
        unsigned w[4] = {0u, 0u, 0u, 0u};
#pragma unroll
        for (int j = 0; j < 8; ++j) { const f32x4 a = *(const GAS f32x4*)(sp + 256 * j) * scale;
#pragma unroll
            for (int e = 0; e < 4; ++e) { const int i = 4 * j + e; w[i >> 3] |= enc_e2m1(a[e]) << (4 * (i & 7)); } }
        *(GAS v4u*)(dst + (size_t)r * 1024 + 16 * lane) = (v4u){w[0], w[1], w[2], w[3]};
    }
}
#define PG4_LOAD(buf, tab, idlo, idhi, g) do { _Pragma("unroll") for (int i_ = 0; i_ < PG6_R; ++i_) { const int k_ = (g) * PG6_R + i_; \
        const int e_ = __builtin_amdgcn_readlane(k_ < 64 ? idlo : idhi, k_ & 63); buf[i_] = *(const GAS v4u*)((tab) + (size_t)(unsigned)e_ * 1024u + voff4); } } while (0)
#define PG4_AXPY(buf, g) do { _Pragma("unroll") for (int i_ = 0; i_ < PG6_R; ++i_) { const float w_ = wl[(g) * PG6_R + i_]; const f32x2 wv_ = {w_, w_}; \
        _Pragma("unroll") for (int c_ = 0; c_ < 4; ++c_) { const unsigned u_ = buf[i_][c_]; \
            y[4 * c_ + 0] += __builtin_amdgcn_cvt_scalef32_pk_f32_fp4(u_, 1.0f, 0) * wv_; y[4 * c_ + 1] += __builtin_amdgcn_cvt_scalef32_pk_f32_fp4(u_, 1.0f, 1) * wv_; \
            y[4 * c_ + 2] += __builtin_amdgcn_cvt_scalef32_pk_f32_fp4(u_, 1.0f, 2) * wv_; y[4 * c_ + 3] += __builtin_amdgcn_cvt_scalef32_pk_f32_fp4(u_, 1.0f, 3) * wv_; } \
        __builtin_amdgcn_sched_barrier(0); } } while (0)
#ifndef PG6_R
#define PG6_R 8
#endif
#define PG6_LOAD(buf, tab, idlo, idhi, g) do { _Pragma("unroll") for (int i_ = 0; i_ < PG6_R; ++i_) { const int k_ = (g) * PG6_R + i_; \
        const int e_ = __builtin_amdgcn_readlane(k_ < 64 ? idlo : idhi, k_ & 63); const unsigned char* rp_ = (tab) + (size_t)(unsigned)e_ * 1536u; \
        const v4u a_ = *(const GAS v4u_a8*)(rp_ + voff); const v2u b_ = *(const GAS v2u*)(rp_ + voff + 16); buf[i_] = (v6u){a_.x, a_.y, a_.z, a_.w, b_.x, b_.y}; } } while (0)
#define PG6_DOT1(buf, i_, dst) do { const v32f f_ = __builtin_amdgcn_cvt_scalef32_pk32_f32_fp6(buf[i_], 1.0f); f32x2 a_ = {0.f, 0.f}; \
        _Pragma("unroll") for (int c_ = 0; c_ < 16; ++c_) a_ += (f32x2){f_[2 * c_], f_[2 * c_ + 1]} * x[c_]; dst = a_.x + a_.y; __builtin_amdgcn_sched_barrier(0); } while (0)
#if PG6_R == 8
#define PG6_DOT(buf, g) do { float p_[8]; _Pragma("unroll") for (int i_ = 0; i_ < 8; ++i_) PG6_DOT1(buf, i_, p_[i_]); \
        float q_[4]; _Pragma("unroll") for (int i_ = 0; i_ < 4; ++i_) { const float keep_ = b5 ? p_[i_ + 4] : p_[i_], send_ = b5 ? p_[i_] : p_[i_ + 4]; q_[i_] = keep_ + shx(send_, 32, lane); } \
        float r_[2]; _Pragma("unroll") for (int i_ = 0; i_ < 2; ++i_) { const float keep_ = b4 ? q_[i_ + 2] : q_[i_], send_ = b4 ? q_[i_] : q_[i_ + 2]; r_[i_] = keep_ + shx(send_, 16, lane); } \
        float s_; { const float keep_ = b3 ? r_[1] : r_[0], send_ = b3 ? r_[0] : r_[1]; s_ = keep_ + shx(send_, 8, lane); } \
        s_ += shx(s_, 4, lane); s_ += shx(s_, 2, lane); s_ += shx(s_, 1, lane); \
        if ((lane & 7) == 0) wl[(g) * 8 + (lane >> 3)] = s_; } while (0)
#else
#define PG6_DOT(buf, g) do { float p_[4]; _Pragma("unroll") for (int i_ = 0; i_ < 4; ++i_) PG6_DOT1(buf, i_, p_[i_]); \
        float r_[2]; _Pragma("unroll") for (int i_ = 0; i_ < 2; ++i_) { const float keep_ = b5 ? p_[i_ + 2] : p_[i_], send_ = b5 ? p_[i_] : p_[i_ + 2]; r_[i_] = keep_ + shx(send_, 32, lane); } \
        float s_; { const float keep_ = b4 ? r_[1] : r_[0], send_ = b4 ? r_[0] : r_[1]; s_ = keep_ + shx(send_, 16, lane); } \
        s_ += shx(s_, 8, lane); s_ += shx(s_, 4, lane); s_ += shx(s_, 2, lane); s_ += shx(s_, 1, lane); \
        if ((lane & 15) == 0) wl[(g) * 4 + (lane >> 4)] = s_; } while (0)
#endif
#define PG6_AXPY(buf, g) do { _Pragma("unroll") for (int i_ = 0; i_ < PG6_R; ++i_) { const float w_ = wl[(g) * PG6_R + i_]; const f32x2 wv_ = {w_, w_}; \
        const v32f f_ = __builtin_amdgcn_cvt_scalef32_pk32_f32_fp6(buf[i_], 1.0f); _Pragma("unroll") for (int c_ = 0; c_ < 16; ++c_) y[c_] += (f32x2){f_[2 * c_], f_[2 * c_ + 1]} * wv_; __builtin_amdgcn_sched_barrier(0); } } while (0)
__device__ __forceinline__ void peer_gather6(bf16* XN, const unsigned char* PU6, const unsigned char* PV6, const int* PIDX, const float* PGATE, float* X, const u64_t* rowsq_in, u64_t* rowsq_out, LAS float* wl, int gw, int NGW, int lane) {
    const bool b5 = (lane >> 5) & 1, b4 = (lane >> 4) & 1, b3 = (lane >> 3) & 1; (void)b3;
    const unsigned voff = 24u * (unsigned)lane, voff4 = 16u * (unsigned)lane, l4 = 4u * (unsigned)lane, l8 = 8u * (unsigned)lane, l16 = 16u * (unsigned)lane;
    constexpr int NG = 128 / PG6_R;
    for (int t_ = gw; t_ < T; t_ += NGW) {
        int t = t_; asm volatile("" : "+s"(t));
        const char* pidx_t = (const char*)(PIDX + (size_t)t * 128); const char* pgate_t = (const char*)(PGATE + (size_t)t * 128);
        const int idlo = *(const GAS int*)(pidx_t + l4), idhi = *(const GAS int*)(pidx_t + l4 + 256);
        v6u A[PG6_R], B[PG6_R]; v4u AV[PG6_R], BV[PG6_R];
        PG6_LOAD(A, PU6, idlo, idhi, 0);
        f32x2 x[16];
        {   const char* xr = (const char*)(XN + (size_t)t * DM); const float xs = (1.f / PU_SCALE6) * rowsq_rs(rowsq_in, t);
#pragma unroll
            for (int j = 0; j < 8; ++j) { const v2u a = *(const GAS v2u*)(xr + l8 + 512 * j); x[2 * j] = (f32x2){bflo(a.x), bfhi(a.x)} * xs; x[2 * j + 1] = (f32x2){bflo(a.y), bfhi(a.y)} * xs; } }
#pragma unroll 1
        for (int g = 0; g < NG - 2; g += 2) {
            PG6_LOAD(B, PU6, idlo, idhi, g + 1);
            PG6_DOT(A, g);
            PG6_LOAD(A, PU6, idlo, idhi, g + 2);
            PG6_DOT(B, g + 1);
        }
        PG6_LOAD(B, PU6, idlo, idhi, NG - 1);
        PG6_DOT(A, NG - 2);
        PG4_LOAD(AV, PV6, idlo, idhi, 0);
        PG6_DOT(B, NG - 1);
        LDS_WAIT();
        {   const float g0 = *(const GAS float*)(pgate_t + l4), g1 = *(const GAS float*)(pgate_t + l4 + 256);
            const float d0 = wl[lane], d1 = wl[64 + lane];
            const float w0 = g0 * 0.5f * d0 * (1.f + erff(d0 * 0.70710678118654752f)) * (1.f / PV_SCALE4), w1 = g1 * 0.5f * d1 * (1.f + erff(d1 * 0.70710678118654752f)) * (1.f / PV_SCALE4);
            LDS_WAIT(); asm volatile("" ::: "memory");
            wl[lane] = w0; wl[64 + lane] = w1;
            LDS_WAIT(); asm volatile("" ::: "memory");
        }
        f32x2 y[16];
#pragma unroll
        for (int i = 0; i < 16; ++i) y[i] = (f32x2){0.f, 0.f};
#pragma unroll 1
        for (int g = 0; g < NG; g += 2) {
            PG4_LOAD(BV, PV6, idlo, idhi, g + 1);
            PG4_AXPY(AV, g);
            if (g + 2 < NG) PG4_LOAD(AV, PV6, idlo, idhi, g + 2);
            PG4_AXPY(BV, g + 1);
        }
        {   char* xo = (char*)(X + (size_t)t * DM);
            char* xbo = (char*)(XN + (size_t)t * DM); float ss = 0.f;
#pragma unroll
            for (int j = 0; j < 8; ++j) { const v2u a = *(const GAS v2u*)(xbo + l8 + 512 * j); f32x4 v = (f32x4){bflo(a.x), bfhi(a.x), bflo(a.y), bfhi(a.y)}; v += (f32x4){y[2 * j].x, y[2 * j].y, y[2 * j + 1].x, y[2 * j + 1].y};
                if (X) *(GAS f32x4*)(xo + l16 + 1024 * j) = v;
                ss += (v[0] * v[0] + v[1] * v[1]) + (v[2] * v[2] + v[3] * v[3]); *(GAS v2u*)(xbo + l8 + 512 * j) = (v2u){pk2(v[0], v[1]), pk2(v[2], v[3])}; }
            if (rowsq_out) { ss = wave_sum(ss, lane); if (lane == 0) rowsq_out[t] = rowsq_fx(ss); } }
        LDS_WAIT(); asm volatile("" ::: "memory");
    }
}

typedef short s16x4 __attribute__((ext_vector_type(4)));
typedef __attribute__((address_space(3))) const char* lds_cptr;
__device__ __forceinline__ s16x4 vtr(lds_cptr p) { return __builtin_bit_cast(s16x4, __builtin_amdgcn_ds_read_tr16_b64_v4i16((__attribute__((address_space(3))) s16x4*)p)); }
__device__ __forceinline__ unsigned cvtpk(float lo, float hi) { unsigned r; asm("v_cvt_pk_bf16_f32 %0, %1, %2" : "=v"(r) : "v"(lo), "v"(hi)); return r; }
constexpr int AT_K0 = 0, AT_V0 = 16384, AT_TAB = 32768;
constexpr float LOG2E = 1.4426950408889634f;
template <int TYPE>
__device__ __forceinline__ void attn_unit(LAS unsigned char* lds, const bf16* QKV, bf16* ATT, int b, int head, int qb, const float* tabsrc, float Cl2, float sinkl2, int tid) {
    const int lane = tid & 63, w = __builtin_amdgcn_readfirstlane(tid >> 6), hh = lane >> 5, l31 = lane & 31;
    int qcol, kcol, vcol, ocol;
    if (TYPE == 0) { qcol = QA + head * 64; kcol = KA + (head / 3) * 64; vcol = VA + (head / 3) * 64; ocol = OA + head * 64; }
    else if (TYPE == 1) { qcol = QB + head * 64; kcol = KB + head * 64; vcol = VB + head * 64; ocol = OB + head * 64; }
    else { qcol = QC + head * 64; kcol = KC + (head / 3) * 64; vcol = VC + (head / 3) * 64; ocol = OC + head * 64; }
    const int q0 = 256 * qb + 32 * w, qpos = q0 + l31;
    int t_begin, t_end;
    if (TYPE == 0) { t_begin = 4 * qb - 2; if (t_begin < 0) t_begin = 0; t_end = 4 * qb + 6; if (t_end > 32) t_end = 32; }
    else if (TYPE == 1) { int a = 4 * qb - 4; a = a < 0 ? 0 : (a > 24 ? 24 : a); int e = 4 * qb - 1; e = e < 0 ? 0 : (e > 24 ? 24 : e); t_begin = a; t_end = e + 8; }
    else { t_begin = 0; t_end = 32; }
    LAS float* tab = (LAS float*)(lds + AT_TAB);
    if (TYPE == 0) { for (int i = tid; i < 1024; i += NTHREADS) { const int rel = i - 448; tab[i] = (rel >= -128 && rel <= 128) ? tabsrc[head * 257 + rel + 128] * LOG2E - Cl2 : -1e30f; } }
    if (TYPE == 1) { for (int i = tid; i < 15 * 31; i += NTHREADS) tab[i] = tabsrc[head * 465 + i] * LOG2E - Cl2; }
    bf16x8 qf[4];
    {   const bf16* qp = QKV + ((size_t)b * SEQ + qpos) * DIN + qcol + 8 * hh;
#pragma unroll
        for (int s = 0; s < 4; ++s) qf[s] = *(const GAS bf16x8*)(qp + 16 * s); }
    const int srow = tid >> 3, sch = tid & 7;
    const bf16* kg = QKV + ((size_t)b * SEQ + srow) * DIN + kcol + sch * 8;
    const bf16* vg = QKV + ((size_t)b * SEQ + srow) * DIN + vcol + sch * 8;
    const int kst = srow * 128 + ((sch ^ ((srow >> 1) & 7)) * 16);
    const int vst = srow * 128 + (((sch >> 2) ^ ((srow >> 1) & 1)) * 64) + (sch & 3) * 16;
    int kread[4], vread[2];
#pragma unroll
    for (int s = 0; s < 4; ++s) kread[s] = l31 * 128 + (((2 * s + hh) ^ ((lane >> 1) & 7)) * 16);
#pragma unroll
    for (int db = 0; db < 2; ++db) vread[db] = (4 * hh + ((lane >> 2) & 3)) * 128 + ((db ^ ((lane >> 3) & 1)) * 64) + 32 * ((lane >> 4) & 1) + 8 * (lane & 3);
    f32x16 O0, O1;
#pragma unroll
    for (int r = 0; r < 16; ++r) { O0[r] = 0.f; O1[r] = 0.f; }
    float lsum = 0.f;
    const int rw = 4 * qb + (w >> 1), cq = 32 * (w & 1) + l31;
    int r0w = rw - 4; r0w = r0w < 0 ? 0 : (r0w > 24 ? 24 : r0w);
    int c0 = cq - 8; c0 = c0 < 0 ? 0 : (c0 > 48 ? 48 : c0);
    {   const v4u kr = *(const GAS v4u*)(kg + (size_t)t_begin * 64 * DIN), vr = *(const GAS v4u*)(vg + (size_t)t_begin * 64 * DIN);
        *(LAS v4u*)(lds + AT_K0 + kst) = kr; *(LAS v4u*)(lds + AT_V0 + vst) = vr; }
    __syncthreads();
    for (int t = t_begin; t < t_end; ++t) {
        const int cur = (t - t_begin) & 1;
        v4u kr, vr;
        if (t + 1 < t_end) { kr = *(const GAS v4u*)(kg + (size_t)(t + 1) * 64 * DIN); vr = *(const GAS v4u*)(vg + (size_t)(t + 1) * 64 * DIN); }
        bool need = true;
        if (TYPE == 0) need = (64 * t <= q0 + 31 + 128) && (64 * t + 63 >= q0 - 128);
        if (TYPE == 1) need = (t >= r0w) && (t < r0w + 8);
        if (need) {
            const lds_cptr kb_ = (lds_cptr)(lds + AT_K0 + cur * 8192), vb_ = (lds_cptr)(lds + AT_V0 + cur * 8192);
            bf16x8 kf[8];
#pragma unroll
            for (int s = 0; s < 4; ++s) { kf[2 * s] = *(const LAS bf16x8*)(kb_ + kread[s]); kf[2 * s + 1] = *(const LAS bf16x8*)(kb_ + kread[s] + 4096); }
            f32x16 S0, S1;
            if (TYPE == 2) {
#pragma unroll
                for (int r = 0; r < 16; ++r) { S0[r] = -Cl2; S1[r] = -Cl2; }
            } else if (TYPE == 0) {
                const LAS float* tb = tab + (64 * t - qpos + 448 + 4 * hh);
#pragma unroll
                for (int r = 0; r < 16; ++r) { S0[r] = tb[8 * (r >> 2) + (r & 3)]; S1[r] = tb[32 + 8 * (r >> 2) + (r & 3)]; }
            } else {
                const LAS float* tb = tab + ((t - rw + 7) * 31 - cq + 15 + 4 * hh);
                const int kc0 = 4 * hh - c0;
#pragma unroll
                for (int r = 0; r < 16; ++r) { const int ka = 8 * (r >> 2) + (r & 3), kb2 = 32 + ka;
                    S0[r] = ((unsigned)(ka + kc0) < 16u) ? tb[ka] : -1e30f; S1[r] = ((unsigned)(kb2 + kc0) < 16u) ? tb[kb2] : -1e30f; }
            }
            __builtin_amdgcn_sched_barrier(0);
#pragma unroll
            for (int s = 0; s < 4; ++s) { S0 = __builtin_amdgcn_mfma_f32_32x32x16_bf16(kf[2 * s], qf[s], S0, 0, 0, 0); S1 = __builtin_amdgcn_mfma_f32_32x32x16_bf16(kf[2 * s + 1], qf[s], S1, 0, 0, 0); }
            s16x4 vf[4][2][2];
#pragma unroll
            for (int ks = 0; ks < 2; ++ks)
#pragma unroll
                for (int db = 0; db < 2; ++db) { vf[ks][db][0] = vtr(vb_ + vread[db] + (16 * ks) * 128); vf[ks][db][1] = vtr(vb_ + vread[db] + (16 * ks + 8) * 128); }
            __builtin_amdgcn_sched_barrier(0);
#pragma unroll
            for (int r = 0; r < 16; ++r) { S0[r] = __builtin_amdgcn_exp2f(S0[r]); S1[r] = __builtin_amdgcn_exp2f(S1[r]); }
#pragma unroll
            for (int r = 0; r < 16; ++r) lsum += S0[r] + S1[r];
            bf16x8 pb[4];
#pragma unroll
            for (int hf = 0; hf < 2; ++hf) {
                v4u a, c;
#pragma unroll
                for (int j = 0; j < 4; ++j) { a[j] = cvtpk(S0[8 * hf + 2 * j], S0[8 * hf + 2 * j + 1]); c[j] = cvtpk(S1[8 * hf + 2 * j], S1[8 * hf + 2 * j + 1]); }
                pb[hf] = __builtin_bit_cast(bf16x8, a); pb[2 + hf] = __builtin_bit_cast(bf16x8, c);
            }
#pragma unroll
            for (int ks = 2; ks < 4; ++ks)
#pragma unroll
                for (int db = 0; db < 2; ++db) { vf[ks][db][0] = vtr(vb_ + vread[db] + (16 * ks) * 128); vf[ks][db][1] = vtr(vb_ + vread[db] + (16 * ks + 8) * 128); }
            __builtin_amdgcn_sched_barrier(0);
#pragma unroll
            for (int ks = 0; ks < 4; ++ks) {
                const bf16x8 va = __builtin_shufflevector(vf[ks][0][0], vf[ks][0][1], 0, 1, 2, 3, 4, 5, 6, 7), vb2 = __builtin_shufflevector(vf[ks][1][0], vf[ks][1][1], 0, 1, 2, 3, 4, 5, 6, 7);
                O0 = __builtin_amdgcn_mfma_f32_32x32x16_bf16(va, pb[ks], O0, 0, 0, 0); O1 = __builtin_amdgcn_mfma_f32_32x32x16_bf16(vb2, pb[ks], O1, 0, 0, 0);
            }
        }
        __builtin_amdgcn_sched_barrier(0);
        if (t + 1 < t_end) { *(LAS v4u*)(lds + AT_K0 + (cur ^ 1) * 8192 + kst) = kr; *(LAS v4u*)(lds + AT_V0 + (cur ^ 1) * 8192 + vst) = vr; }
        __syncthreads();
    }
    lsum += shx(lsum, 32, lane);
    if (TYPE == 0) lsum += __builtin_amdgcn_exp2f(sinkl2 - Cl2);
    const float inv = 1.f / lsum;
    bf16* op = ATT + ((size_t)b * SEQ + qpos) * DM + ocol + 4 * hh;
#pragma unroll
    for (int g4 = 0; g4 < 4; ++g4) {
        v2u o0, o1; o0.x = cvtpk(O0[4 * g4] * inv, O0[4 * g4 + 1] * inv); o0.y = cvtpk(O0[4 * g4 + 2] * inv, O0[4 * g4 + 3] * inv);
        o1.x = cvtpk(O1[4 * g4] * inv, O1[4 * g4 + 1] * inv); o1.y = cvtpk(O1[4 * g4 + 2] * inv, O1[4 * g4 + 3] * inv);
        *(GAS v2u*)(op + 8 * g4) = o0; *(GAS v2u*)(op + 32 + 8 * g4) = o1;
    }
}


constexpr int MA_K0 = 0, MA_V0 = 32768;
__device__ __forceinline__ void mem_unit(LAS unsigned char* lds, const bf16* QM, const bf16* KVM, bf16* OM, const float* gq, int tb, int head, float Cl2, int tid) {
    const int lane = tid & 63, w = __builtin_amdgcn_readfirstlane(tid >> 6), hh = lane >> 5, l31 = lane & 31;
    const size_t trow = (size_t)tb * 256 + 32 * w + l31; const int b = tb >> 3;
    bf16x8 qf[8];
    {   const bf16* qp = QM + trow * MEMW + head * 128 + 8 * hh;
#pragma unroll
        for (int s = 0; s < 8; ++s) qf[s] = *(const GAS bf16x8*)(qp + 16 * s);
        float ss = 0.f;
#pragma unroll
        for (int s = 0; s < 8; ++s)
#pragma unroll
            for (int j = 0; j < 8; ++j) { const float f = __builtin_bit_cast(float, (unsigned)(unsigned short)qf[s][j] << 16); ss += f * f; }
        ss += shx(ss, 32, lane);
        const float r = 0.12751743074602468f / sqrtf(ss * (1.f / 128.f) + EPS);
#pragma unroll
        for (int s = 0; s < 8; ++s) { const f32x4 g0 = *(const GAS f32x4*)(gq + 16 * s + 8 * hh), g1 = *(const GAS f32x4*)(gq + 16 * s + 8 * hh + 4);
            v4u o;
#pragma unroll
            for (int j = 0; j < 4; ++j) { const float f0 = __builtin_bit_cast(float, (unsigned)(unsigned short)qf[s][2 * j] << 16), f1 = __builtin_bit_cast(float, (unsigned)(unsigned short)qf[s][2 * j + 1] << 16);
                const float ga = (2 * j < 4) ? g0[2 * j] : g1[2 * j - 4], gb2 = (2 * j + 1 < 4) ? g0[2 * j + 1] : g1[2 * j + 1 - 4];
                o[j] = cvtpk(f0 * r * ga, f1 * r * gb2); }
            qf[s] = __builtin_bit_cast(bf16x8, o); }
    }
    const int srow = tid >> 3, sch = tid & 7;
    const bf16* kg = KVM + ((size_t)b * NMEM + srow) * 1024 + head * 128 + sch * 8;
    const bf16* vg = kg + 512;
    const int kst0 = srow * 256 + ((sch ^ (srow & 15)) * 16), kst1 = srow * 256 + (((sch + 8) ^ (srow & 15)) * 16);
    const int vst0 = srow * 256 + ((((sch) >> 2) ^ (srow & 3)) * 64) + (sch & 3) * 16, vst1 = srow * 256 + ((((sch + 8) >> 2) ^ (srow & 3)) * 64) + (sch & 3) * 16;
    int kread[8], vread[4];
#pragma unroll
    for (int s = 0; s < 8; ++s) kread[s] = l31 * 256 + (((2 * s + hh) ^ (l31 & 15)) * 16);
#pragma unroll
    for (int db = 0; db < 4; ++db) vread[db] = (4 * hh + ((lane >> 2) & 3)) * 256 + ((db ^ ((lane >> 2) & 3)) * 64) + 32 * ((lane >> 4) & 1) + 8 * (lane & 3);
    f32x16 O[4];
#pragma unroll
    for (int db = 0; db < 4; ++db)
#pragma unroll
        for (int r = 0; r < 16; ++r) O[db][r] = 0.f;
    float lsum = 0.f;
    {   const v4u k0 = *(const GAS v4u*)kg, k1 = *(const GAS v4u*)(kg + 64), v0 = *(const GAS v4u*)vg, v1 = *(const GAS v4u*)(vg + 64);
        *(LAS v4u*)(lds + MA_K0 + kst0) = k0; *(LAS v4u*)(lds + MA_K0 + kst1) = k1; *(LAS v4u*)(lds + MA_V0 + vst0) = v0; *(LAS v4u*)(lds + MA_V0 + vst1) = v1; }
    __syncthreads();
#pragma unroll 1
    for (int t = 0; t < 4; ++t) {
        const int cur = t & 1;
        v4u k0, k1, v0, v1;
        if (t + 1 < 4) { const bf16* kn = kg + (size_t)(t + 1) * 64 * 1024; k0 = *(const GAS v4u*)kn; k1 = *(const GAS v4u*)(kn + 64); v0 = *(const GAS v4u*)(kn + 512); v1 = *(const GAS v4u*)(kn + 576); }
        const lds_cptr kb_ = (lds_cptr)(lds + MA_K0 + cur * 16384), vb_ = (lds_cptr)(lds + MA_V0 + cur * 16384);
        f32x16 S0, S1;
#pragma unroll
        for (int r = 0; r < 16; ++r) { S0[r] = -Cl2; S1[r] = -Cl2; }
#pragma unroll
        for (int s = 0; s < 8; ++s) { const bf16x8 a0 = *(const LAS bf16x8*)(kb_ + kread[s]), a1 = *(const LAS bf16x8*)(kb_ + kread[s] + 8192);
            S0 = __builtin_amdgcn_mfma_f32_32x32x16_bf16(a0, qf[s], S0, 0, 0, 0); S1 = __builtin_amdgcn_mfma_f32_32x32x16_bf16(a1, qf[s], S1, 0, 0, 0); }
#pragma unroll
        for (int r = 0; r < 16; ++r) { S0[r] = __builtin_amdgcn_exp2f(S0[r]); S1[r] = __builtin_amdgcn_exp2f(S1[r]); lsum += S0[r] + S1[r]; }
        bf16x8 pb[4];
#pragma unroll
        for (int hf = 0; hf < 2; ++hf) {
            v4u a, c;
#pragma unroll
            for (int j = 0; j < 4; ++j) { a[j] = cvtpk(S0[8 * hf + 2 * j], S0[8 * hf + 2 * j + 1]); c[j] = cvtpk(S1[8 * hf + 2 * j], S1[8 * hf + 2 * j + 1]); }
            pb[hf] = __builtin_bit_cast(bf16x8, a); pb[2 + hf] = __builtin_bit_cast(bf16x8, c);
        }
#pragma unroll
        for (int ks = 0; ks < 4; ++ks)
#pragma unroll
            for (int db = 0; db < 4; ++db) {
                const s16x4 a0 = vtr(vb_ + vread[db] + (16 * ks) * 256), a1 = vtr(vb_ + vread[db] + (16 * ks + 8) * 256);
                const bf16x8 va = __builtin_shufflevector(a0, a1, 0, 1, 2, 3, 4, 5, 6, 7);
                O[db] = __builtin_amdgcn_mfma_f32_32x32x16_bf16(va, pb[ks], O[db], 0, 0, 0);
            }
        if (t + 1 < 4) { LAS unsigned char* kn = lds + MA_K0 + (cur ^ 1) * 16384; LAS unsigned char* vn = lds + MA_V0 + (cur ^ 1) * 16384;
            *(LAS v4u*)(kn + kst0) = k0; *(LAS v4u*)(kn + kst1) = k1; *(LAS v4u*)(vn + vst0) = v0; *(LAS v4u*)(vn + vst1) = v1; }
        __syncthreads();
    }
    lsum += shx(lsum, 32, lane);
    const float inv = 1.f / lsum;
    bf16* op = OM + trow * MEMW + head * 128 + 4 * hh;
#pragma unroll
    for (int db = 0; db < 4; ++db)
#pragma unroll
        for (int g4 = 0; g4 < 4; ++g4) { v2u o; o.x = cvtpk(O[db][4 * g4] * inv, O[db][4 * g4 + 1] * inv); o.y = cvtpk(O[db][4 * g4 + 2] * inv, O[db][4 * g4 + 3] * inv); *(GAS v2u*)(op + 32 * db + 8 * g4) = o; }
}

__device__ __forceinline__ float wave_max(float v, int lane) {
#pragma unroll
    for (int o = 1; o < 64; o <<= 1) v = fmaxf(v, shx(v, o, lane));
    return v;
}
struct Args { const float* in[23]; float* out; unsigned char* ws; int ph_lo, ph_hi, use_bar, pad; };
#ifndef MK_OFF
#define MK_OFF 0u
#endif
#ifndef REP_ATT
#define REP_ATT 1
#endif
#ifndef REP_GEMM
#define REP_GEMM 1
#endif
#ifndef REP_NORM
#define REP_NORM 1
#endif
#ifndef REP_SEL
#define REP_SEL 1
#endif
#ifndef REP_MEM
#define REP_MEM 1
#endif
#define PHON(k) (!((MK_OFF >> (k)) & 1u))
constexpr int PH_PER_LAYER = 10, PH_BASE = 3, N_PHASES = PH_BASE + DEPTH * PH_PER_LAYER;
constexpr int PTAB_OFF = LDSCTL_OFF + 1024;

__global__ void __launch_bounds__(NTHREADS, 2) mega(Args a) {
    extern __shared__ __attribute__((aligned(16))) unsigned char lds_raw[];
    LAS unsigned char* lds = (LAS unsigned char*)lds_raw;
    {   const int tid0 = threadIdx.x;
        for (int u = tid0; u < (LDS_BYTES - LDSCTL_OFF) / 4; u += NTHREADS) ((LAS unsigned*)(lds + LDSCTL_OFF))[u] = 0u;
        __syncthreads();
        if (tid0 < 23) ((LAS unsigned long long*)(lds + PTAB_OFF))[tid0] = (unsigned long long)a.in[tid0];
        if (tid0 == 23) ((LAS unsigned long long*)(lds + PTAB_OFF))[23] = (unsigned long long)a.out;
        if (tid0 == 24) ((LAS unsigned long long*)(lds + PTAB_OFF))[24] = (unsigned long long)a.ws;
        __syncthreads();
    }
    volatile LAS unsigned* MISC = (volatile LAS unsigned*)(lds + MISC_OFF);
    const int G = gridDim.x, bid = blockIdx.x, NGW = G * NWAVES;
    const int use_bar = a.use_bar;
    XcdBarrier bar; bar.bar = (unsigned*)(a.ws + WS_CTL) + CW_BAR; bar.x = 0; bar.st = MISC + 8;
    if (use_bar) bar = xcd_barrier_post((unsigned*)(a.ws + WS_CTL) + CW_BAR, MISC + 8);
    const int lo = a.ph_lo, hi = a.ph_hi;
#define IN(k) (lo <= (k) && (k) < hi)
#define SEAM(k) do { if (use_bar && IN(k) && IN((k) + 1)) xcd_barrier(bar); } while (0)
#define PHL() int tid_ = threadIdx.x; asm volatile("" : "+v"(tid_)); const int lane_ = tid_ & 63, wave_ = __builtin_amdgcn_readfirstlane(tid_ >> 6), gw_ = bid * NWAVES + wave_; (void)lane_; (void)gw_; \
              int pz_ = 0; asm volatile("" : "+s"(pz_))
#define PTR(i) ((const float*)ldptr(lds, (i) + pz_))
#define WSP() ((unsigned char*)ldptr(lds, 24 + pz_))
#define OUTP() ((float*)ldptr(lds, 23 + pz_))

    if (IN(0) && PHON(0)) {
        PHL(); unsigned char* ws = WSP();
        LAS float* scr = (LAS float*)(lds + RING_OFF + wave_ * 16384);
        constexpr int I_IN = 32 * 128, I_OUT = 32 * 64, I_MQ = 32 * 16, I_MKV = 32 * 32, I_MO = 8 * 64, I_PQ = 32 * 64, I_L = I_IN + I_OUT + I_MQ + I_MKV + I_MO + I_PQ;
        for (int it = gw_; it < DEPTH * I_L; it += NGW) {
            const int l = it / I_L; int r = it % I_L;
            if (r < I_IN) { transpose_item<true>(PTR(4) + (size_t)l * DM * DIN, DM, DIN, (bf16*)(ws + WS_WIN) + (size_t)l * DIN * DM, scr, r, lane_, PTR(3) + (size_t)l * DM); continue; } r -= I_IN;
            if (r < I_OUT) { transpose_item<false>(PTR(11) + (size_t)l * DM * DM, DM, DM, (bf16*)(ws + WS_WOUT) + (size_t)l * DM * DM, scr, r, lane_); continue; } r -= I_OUT;
            if (r < I_MQ) { transpose_item<false>(PTR(14) + (size_t)l * DM * MEMW, DM, MEMW, (bf16*)(ws + WS_WMQ) + (size_t)l * MEMW * DM, scr, r, lane_, PTR(12) + (size_t)l * DM); continue; } r -= I_MQ;
            if (r < I_MKV) { transpose_item<false>(PTR(15) + (size_t)l * DM * 1024, DM, 1024, (bf16*)(ws + WS_WMKV) + (size_t)l * 1024 * DM, scr, r, lane_); continue; } r -= I_MKV;
            if (r < I_MO) { transpose_item<false>(PTR(17) + (size_t)l * MEMW * DM, MEMW, DM, (bf16*)(ws + WS_WMO) + (size_t)l * DM * MEMW, scr, r, lane_); continue; } r -= I_MO;
            transpose_item<false>(PTR(19) + (size_t)l * DM * DM, DM, DM, (bf16*)(ws + WS_WPQ) + (size_t)l * DM * DM, scr, r, lane_, PTR(18) + (size_t)l * DM);
        }
        const size_t gtid = (size_t)bid * NTHREADS + tid_, nth = (size_t)G * NTHREADS;
        convert_bf16(PTR(20), (bf16*)(ws + WS_PKEYS), (size_t)DEPTH * 8 * 2 * 128 * 128, gtid, nth);
        convert_fp6_rows(PTR(21), ws + WS_PU, DEPTH * PEER_N, PU_SCALE6, PTR(18), gw_, NGW, lane_);
        convert_fp4_rows(PTR(22), ws + WS_PV, DEPTH * PEER_N, PV_SCALE4, gw_, NGW, lane_);
        {   const float* x0 = PTR(0); bf16* XN = (bf16*)(ws + WS_XN); u64_t* rsq = (u64_t*)(ws + WS_ROWSQ);
            for (int m = gw_; m < T; m += NGW) prep_row(x0 + (size_t)m * DM, XN + (size_t)m * DM, rsq + m, lane_); }
        {   const float* mem = PTR(1); const float* gkv = PTR(13); bf16* MEMN = (bf16*)(ws + WS_MEMN);
            for (int m = gw_; m < BATCH * NMEM; m += NGW)
                rms_row_to_bf16(mem + (size_t)m * DM, gkv, MEMN + (size_t)m * DM, gkv + DM, MEMN + (size_t)(BATCH * NMEM + m) * DM, lane_); }
        float* rope = (float*)(ws + WS_ROPE); float* biasA = (float*)(ws + WS_BIASA);
        if (gtid < 64 * 16) { const int pos = (int)gtid >> 4, i = (int)gtid & 15; const float ang = (float)pos * ROPE_INV[i]; rope[gtid * 2] = cosf(ang); rope[gtid * 2 + 1] = sinf(ang); }
        if (gtid < 12 * 257) { const int h = (int)gtid / 257, rel = (int)gtid % 257 - 128; biasA[gtid] = PTR(2)[t5_bucket(rel) * 12 + h]; }
    }
    SEAM(0);
    if (IN(1) && PHON(1)) {
#pragma unroll 1
        for (int l = 0; l < DEPTH; ++l) {
            PHL(); unsigned char* ws = WSP();
            pg8::Gemm g{(bf16*)(ws + WS_MEMN) + (size_t)l * BATCH * NMEM * DM, (bf16*)(ws + WS_WMKV) + (size_t)l * 1024 * DM, BATCH * NMEM, 1024, DM};
            OffsetOrder S; S.init(BATCH * NMEM, 1024, G, bid, 64 * l);
            pg8::EpiBf16<0> E{(bf16*)(ws + WS_KVM) + (size_t)l * BATCH * NMEM * 1024, 1024, nullptr, 0, 0, 1.f};
            pg8::gemm_phase<pg8::EpiBf16<0>, OffsetOrder, true, true>(lds + RING_OFF, g, S, E, tid_);
            __syncthreads();
        }
    }
    SEAM(1);
    if (IN(2) && PHON(2)) {
        PHL(); unsigned char* ws = WSP(); bf16* KVM = (bf16*)(ws + WS_KVM); const float* gm = PTR(16);
        for (int m = gw_; m < DEPTH * BATCH * NMEM; m += NGW) {
            const int l = m / (BATCH * NMEM);
            GAS v4u* p = (GAS v4u*)(KVM + (size_t)m * 1024 + 8 * lane_);
            const v4u w = *p;
            float f[8] = {bflo(w.x), bfhi(w.x), bflo(w.y), bfhi(w.y), bflo(w.z), bfhi(w.z), bflo(w.w), bfhi(w.w)};
            float ss = 0.f;
#pragma unroll
            for (int i = 0; i < 8; ++i) ss += f[i] * f[i];
            ss += shx(ss, 1, lane_); ss += shx(ss, 2, lane_); ss += shx(ss, 4, lane_); ss += shx(ss, 8, lane_);
            const float r = 1.f / sqrtf(ss * (1.f / 128.f) + EPS);
            const float* gk = gm + (size_t)l * 256 + 128 + 8 * (lane_ & 15);
            v4u o; o.x = pk2(f[0] * r * gk[0], f[1] * r * gk[1]); o.y = pk2(f[2] * r * gk[2], f[3] * r * gk[3]); o.z = pk2(f[4] * r * gk[4], f[5] * r * gk[5]); o.w = pk2(f[6] * r * gk[6], f[7] * r * gk[7]);
            *p = o;
        }
    }
    SEAM(2);

#pragma unroll 1
    for (int l = 0; l < DEPTH; ++l) {
        const int pb = PH_BASE + PH_PER_LAYER * l;
        if (IN(pb + 0) && PHON(3)) for (int rep_ = 0; rep_ < REP_GEMM; ++rep_) { PHL(); unsigned char* ws = WSP();
            pg8::Gemm g{(bf16*)(ws + WS_XN), (bf16*)(ws + WS_WIN) + (size_t)l * DIN * DM, T, DIN, DM}; pg8::StaticOrder S; S.init(T, DIN, G, bid);
            pg8::EpiQKV E{(bf16*)(ws + WS_QKV), PTR(5) + (size_t)l * 128, PTR(7) + (size_t)l * 128, PTR(9) + (size_t)l * 128, (const float*)(ws + WS_ROPE), (const u64_t*)(ws + WS_ROWSQ) + (size_t)(l * 3 + 0) * T};
            pg8::gemm_phase<pg8::EpiQKV, pg8::StaticOrder, true, true>(lds + RING_OFF, g, S, E, tid_);
        }
        SEAM(pb + 0);
        if (IN(pb + 1) && PHON(4)) for (int rep_ = 0; rep_ < REP_ATT; ++rep_) { PHL(); unsigned char* ws = WSP();
            const float* sink = PTR(6) + (size_t)l * 12; const float* rpb = PTR(8) + (size_t)l * 8 * 15 * 31; const float* biasA = (const float*)(ws + WS_BIASA);
            const bf16* QKV = (const bf16*)(ws + WS_QKV); bf16* ATT = (bf16*)(ws + WS_ATT);
            const float* ga = PTR(5) + (size_t)l * 128; const float* gb = PTR(7) + (size_t)l * 128; const float* gc = PTR(9) + (size_t)l * 128;
            const float CaL2 = 8.f * wave_max(fabsf(ga[lane_]), lane_) * wave_max(fabsf(ga[64 + lane_]), lane_) * LOG2E;
            const float CbL2 = 8.f * wave_max(fabsf(gb[lane_]), lane_) * wave_max(fabsf(gb[64 + lane_]), lane_) * LOG2E;
            const float CcL2 = 8.f * wave_max(fabsf(gc[lane_]), lane_) * wave_max(fabsf(gc[64 + lane_]), lane_) * LOG2E;
            const int vc = (G % 8 == 0) ? (bid % 8) * (G / 8) + bid / 8 : bid;
            for (int u = vc; u < BATCH * 12 * 8; u += G) attn_unit<2>(lds, QKV, ATT, u / 96, (u >> 3) % 12, u & 7, nullptr, CcL2, 0.f, tid_);
            for (int u = vc; u < BATCH * 8 * 8; u += G) attn_unit<1>(lds, QKV, ATT, u >> 6, (u >> 3) & 7, u & 7, rpb, CbL2, 0.f, tid_);
            for (int u = vc; u < BATCH * 12 * 8; u += G) { const int head = (u >> 3) % 12; attn_unit<0>(lds, QKV, ATT, u / 96, head, u & 7, biasA, CaL2, sink[head] * LOG2E, tid_); }
        }
        SEAM(pb + 1);
        if (IN(pb + 2) && PHON(5)) { PHL(); unsigned char* ws = WSP(); mixnorm_rows((bf16*)(ws + WS_ATT), PTR(10) + (size_t)l * DM, gw_, NGW, lane_); }
        SEAM(pb + 2);
        if (IN(pb + 3) && PHON(6)) { PHL(); unsigned char* ws = WSP();
            pg8::Gemm g{(bf16*)(ws + WS_ATT), (bf16*)(ws + WS_WOUT) + (size_t)l * DM * DM, T, DM, DM}; pg8::StaticOrder S; S.init(T, DM, G, bid);
            pg8::EpiResid E{(bf16*)(ws + WS_XN), DM, (u64_t*)(ws + WS_ROWSQ) + (size_t)(l * 3 + 1) * T};
            pg8::gemm_phase<pg8::EpiResid, pg8::StaticOrder, true, true>(lds + RING_OFF, g, S, E, tid_);
        }
        SEAM(pb + 3);
        if (IN(pb + 4) && PHON(7)) for (int rep_ = 0; rep_ < REP_GEMM; ++rep_) { PHL(); unsigned char* ws = WSP();
            pg8::Gemm g{(bf16*)(ws + WS_XN), (bf16*)(ws + WS_WMQ) + (size_t)l * MEMW * DM, T, MEMW, DM}; pg8::StaticOrder S; S.init(T, MEMW, G, bid);
            pg8::EpiBf16Row E{(bf16*)(ws + WS_QM), MEMW, (const u64_t*)(ws + WS_ROWSQ) + (size_t)(l * 3 + 1) * T};
            pg8::gemm_phase<pg8::EpiBf16Row, pg8::StaticOrder, true, true>(lds + RING_OFF, g, S, E, tid_);
        }
        SEAM(pb + 4);
        if (IN(pb + 5) && PHON(8)) for (int rep_ = 0; rep_ < REP_MEM; ++rep_) { PHL(); unsigned char* ws = WSP();
            const bf16* kvm = (const bf16*)(ws + WS_KVM) + (size_t)l * BATCH * NMEM * 1024; const float* gq = PTR(16) + (size_t)l * 256;
            const float CmL2 = 11.313708498984761f * wave_max(fmaxf(fabsf(gq[lane_]), fabsf(gq[64 + lane_])), lane_) * wave_max(fmaxf(fabsf(gq[128 + lane_]), fabsf(gq[192 + lane_])), lane_) * LOG2E;
            for (int u = bid; u < (T / 256) * 4; u += G) mem_unit(lds, (const bf16*)(ws + WS_QM), kvm, (bf16*)(ws + WS_OM), gq, u >> 2, u & 3, CmL2, tid_);
        }
        SEAM(pb + 5);
        if (IN(pb + 6) && PHON(9)) { PHL(); unsigned char* ws = WSP();
            pg8::Gemm g{(bf16*)(ws + WS_OM), (bf16*)(ws + WS_WMO) + (size_t)l * DM * MEMW, T, DM, MEMW}; pg8::StaticOrder S; S.init(T, DM, G, bid);
            pg8::EpiResid E{(bf16*)(ws + WS_XN), DM, (u64_t*)(ws + WS_ROWSQ) + (size_t)(l * 3 + 2) * T};
            pg8::gemm_phase<pg8::EpiResid, pg8::StaticOrder, true, true>(lds + RING_OFF, g, S, E, tid_);
        }
        SEAM(pb + 6);
        if (IN(pb + 7) && PHON(10)) for (int rep_ = 0; rep_ < REP_GEMM; ++rep_) { PHL(); unsigned char* ws = WSP();
            pg8::Gemm g{(bf16*)(ws + WS_XN), (bf16*)(ws + WS_WPQ) + (size_t)l * DM * DM, T, DM, DM}; pg8::StaticOrder S; S.init(T, DM, G, bid);
            pg8::EpiBf16Row E{(bf16*)(ws + WS_QP), DM, (const u64_t*)(ws + WS_ROWSQ) + (size_t)(l * 3 + 2) * T};
            pg8::gemm_phase<pg8::EpiBf16Row, pg8::StaticOrder, true, true>(lds + RING_OFF, g, S, E, tid_);
        }
        SEAM(pb + 7);
        if (IN(pb + 8) && PHON(11)) for (int rep_ = 0; rep_ < REP_SEL; ++rep_) { PHL(); unsigned char* ws = WSP();
            const bf16* pk = (const bf16*)(ws + WS_PKEYS) + (size_t)l * 8 * 2 * 128 * 128;
            for (int u = bid; u < (T / 256) * PEER_H; u += G) peer_select_unit((const bf16*)(ws + WS_QP), pk, (int*)(ws + WS_PIDX), (float*)(ws + WS_PGATE), u >> 3, u & 7, wave_, lane_);
        }
        SEAM(pb + 8);
        if (IN(pb + 9) && PHON(12)) { PHL(); unsigned char* ws = WSP();
            peer_gather6((bf16*)(ws + WS_XN), ws + WS_PU + (size_t)l * PEER_N * 1536, ws + WS_PV + (size_t)l * PEER_N * 1024, (const int*)(ws + WS_PIDX), (const float*)(ws + WS_PGATE), (l + 1 == DEPTH) ? OUTP() : (float*)nullptr,
                         (const u64_t*)(ws + WS_ROWSQ) + (size_t)(l * 3 + 2) * T, (l + 1 < DEPTH) ? (u64_t*)(ws + WS_ROWSQ) + (size_t)((l + 1) * 3 + 0) * T : (u64_t*)nullptr,
                         (LAS float*)(lds + RING_OFF + wave_ * 1024), gw_, NGW, lane_); }
        SEAM(pb + 9);
    }
#undef IN
#undef SEAM
}

#ifndef MK_MULTI_LAUNCH
#define MK_MULTI_LAUNCH 0
#endif
extern "C" void kernel_launch(void* const* d_in, const int* in_sizes, int n_in, void* d_out, int out_size, void* d_ws, size_t ws_size, hipStream_t stream) {
    static int grid = 0;
    if (grid == 0) {
        if (n_in != 23 || out_size != T * DM || ws_size < WS_END) { fprintf(stderr, "kernel_launch: unexpected shapes (n_in %d, out %d, ws %zu)\n", n_in, out_size, ws_size); grid = -1; return; }
        int dev = 0, cus = 0, per_cu = 0;
        if (hipGetDevice(&dev) != hipSuccess || hipDeviceGetAttribute(&cus, hipDeviceAttributeMultiprocessorCount, dev) != hipSuccess) { grid = -1; return; }
        if (hipFuncSetAttribute((const void*)mega, hipFuncAttributeMaxDynamicSharedMemorySize, LDS_BYTES) != hipSuccess) { fprintf(stderr, "kernel_launch: hipFuncSetAttribute failed\n"); grid = -1; return; }
        if (hipOccupancyMaxActiveBlocksPerMultiprocessor(&per_cu, (const void*)mega, NTHREADS, LDS_BYTES) != hipSuccess || per_cu < 1) { fprintf(stderr, "kernel_launch: occupancy query says %d\n", per_cu); }
        (void)hipGetLastError();
        grid = cus;
    }
    if (grid < 0) return;
    (void)hipMemsetAsync((char*)d_ws + WS_CTL, 0, CTL_ZERO_BYTES, stream);
    Args a{};
    for (int i = 0; i < 23; ++i) a.in[i] = (const float*)d_in[i];
    a.out = (float*)d_out; a.ws = (unsigned char*)d_ws;
#if MK_MULTI_LAUNCH
    for (int p = 0; p < N_PHASES; ++p) { a.ph_lo = p; a.ph_hi = p + 1; a.use_bar = 0; a.pad = 0; hipLaunchKernelGGL(mega, dim3(grid), dim3(NTHREADS), LDS_BYTES, stream, a); }
#else
    a.ph_lo = 0; a.ph_hi = N_PHASES; a.use_bar = 1; a.pad = 0;
    hipLaunchKernelGGL(mega, dim3(grid), dim3(NTHREADS), LDS_BYTES, stream, a);
#endif
    const hipError_t le = hipPeekAtLastError();
    if (le != hipSuccess) fprintf(stderr, "kernel_launch: launch failed: %s\n", hipGetErrorName(le));
}
```

```cpp
#include <hip/hip_runtime.h>
#include <cstdio>
#include <cstdint>
#include <cmath>
__device__ __forceinline__ float shx(float v, int k, int lane);
typedef unsigned long long u64_t;
__device__ __forceinline__ float rowsq_rs(const u64_t* rowsq, int row) { return 1.0f / sqrtf((float)rowsq[row] * (5.9604644775390625e-08f / 2048.0f) + 1e-6f); }
__device__ __forceinline__ u64_t rowsq_fx(float ss) { return (u64_t)(ss * 16777216.0f + 0.5f); }
namespace pg8 {
#define PG8_LAS __attribute__((address_space(3)))
typedef unsigned short bf16_t;
typedef short bf16x8 __attribute__((ext_vector_type(8)));
typedef float f32x4 __attribute__((ext_vector_type(4)));
typedef unsigned u32x4 __attribute__((ext_vector_type(4)));
constexpr int BM = 256, BK = 64, HALF = 128, HTB = HALF * BK * 2  , STAGE_BYTES = 8 * HTB, NXCD = 8, WGM = 8;

__host__ __device__ __forceinline__ int lds_byte(int r, int c) { const int st = (r >> 4) * 2 + (c >> 5), rr = r & 15, cc = c & 31, ob = rr * 64 + cc * 2; return st * 1024 + (ob ^ (((ob >> 9) & 1) << 5)); }
__host__ __device__ __forceinline__ void stage_rc(int b, int& R, int& C) { const int st = b / 1024, sb = b % 1024, swz = sb ^ (((sb >> 9) & 1) << 5); R = (st >> 1) * 16 + swz / 64; C = (st & 1) * 32 + (swz % 64) / 2; }
__host__ __device__ __forceinline__ int perm32(int rho) { const int n = rho >> 4, i = rho & 15; return 8 * (i >> 2) + 4 * n + (i & 3); }

struct Unit { int pm, pn; };
struct Gemm { const bf16_t* A; const bf16_t* Bt; int M, N, K; };

struct StaticOrder {
    int nM, nN, nwg, G, c;
    __host__ __device__ void init(int M, int N, int G_, int c_) { nM = M / BM; nN = N / BM; nwg = nM * nN; G = G_; c = c_; }
    __host__ __device__ bool next(int i, Unit& u) const {
        const long L = (long)i * G + c; if (L >= nwg) return false;
        int wgid = (int)L; { const int q = nwg / NXCD, r = nwg % NXCD, xcd = wgid % NXCD, off = wgid / NXCD; wgid = (xcd < r ? xcd * (q + 1) : r * (q + 1) + (xcd - r) * q) + off; }
        const int nig = WGM * nN, gid = wgid / nig, fm = gid * WGM, gsz = (nM - fm) < WGM ? (nM - fm) : WGM;
        u.pm = fm + ((wgid % nig) % gsz); u.pn = (wgid % nig) / gsz; return true;
    }
    __device__ __forceinline__ void a_ready(const Unit&) const {}
    __device__ __forceinline__ void done(const Unit&) const {}
};

__device__ __forceinline__ unsigned cvt_pk_bf16(float lo, float hi) { unsigned r; asm volatile("v_cvt_pk_bf16_f32 %0, %1, %2" : "=v"(r) : "v"(lo), "v"(hi)); return r; }
typedef float f32x2 __attribute__((ext_vector_type(2)));
__device__ __forceinline__ f32x2 gelu_pk(f32x2 v) {
    const f32x2 av = __builtin_elementwise_abs(v), d = av * 0.2316418882f + 1.0f;
    f32x2 t; t.x = __builtin_amdgcn_rcpf(d.x); t.y = __builtin_amdgcn_rcpf(d.y);
    f32x2 q = t * 0.5307027145f + (-0.7265760135f); q = q * t + 0.7107068705f; q = q * t + (-0.142248368f); q = q * t + 0.127414796f; q = q * t;
    const f32x2 s = (v * v) * (-0.72134752044f);
    f32x2 e; e.x = __builtin_amdgcn_exp2f(s.x); e.y = __builtin_amdgcn_exp2f(s.y);
    const f32x2 m = v * (q * e), r = v - m;
    f32x2 o; o.x = v.x < 0.f ? m.x : r.x; o.y = v.y < 0.f ? m.y : r.y; return o;
}

template <int ACT  > struct EpiBf16 {
    static constexpr bool PERM = true, AFTER_DRAIN = false; static_assert(ACT == 0 || ACT == 1, "EpiBf16: ACT is 0 (none) or 1 (gelu_pk)");
    bf16_t* O; int ldc; const float* bias; int split_cols; size_t split_stride; float scale0;
    __device__ __forceinline__ void operator()(const f32x4 (&acc)[2][2][4][2], const Unit& u, int wr, int wc, int fr, int fq) const {
        const int row0 = u.pm * BM + wr * 64 + fr; int colt = u.pn * BM; bf16_t* base = O;
        float sc = 1.f; if (split_cols) { const int t = colt / split_cols; base += (size_t)t * split_stride; colt -= t * split_cols; if (t == 0) sc = scale0; }
        const int col0 = colt + wc * 32 + 8 * fq, bcol0 = u.pn * BM + wc * 32 + 8 * fq;
        f32x4 bv[2][2];
#pragma unroll
        for (int bj = 0; bj < 2; ++bj)
#pragma unroll
            for (int n = 0; n < 2; ++n) bv[bj][n] = bias ? *(const f32x4*)(bias + bcol0 + bj * HALF + 4 * n) : (f32x4){0.f, 0.f, 0.f, 0.f};
#pragma unroll
        for (int ai = 0; ai < 2; ++ai)
#pragma unroll
            for (int m = 0; m < 4; ++m) { bf16_t* rowp = base + (size_t)(row0 + ai * HALF + m * 16) * ldc + col0;
#pragma unroll
                for (int bj = 0; bj < 2; ++bj) { f32x4 v0 = acc[ai][bj][m][0] + bv[bj][0], v1 = acc[ai][bj][m][1] + bv[bj][1];
                    if (ACT == 1) { f32x2 a = gelu_pk((f32x2){v0[0], v0[1]}), b = gelu_pk((f32x2){v0[2], v0[3]}), c = gelu_pk((f32x2){v1[0], v1[1]}), d = gelu_pk((f32x2){v1[2], v1[3]});
                        v0 = (f32x4){a.x, a.y, b.x, b.y}; v1 = (f32x4){c.x, c.y, d.x, d.y}; }
                    v0 = v0 * sc; v1 = v1 * sc; u32x4 w; w.x = cvt_pk_bf16(v0[0], v0[1]); w.y = cvt_pk_bf16(v0[2], v0[3]); w.z = cvt_pk_bf16(v1[0], v1[1]); w.w = cvt_pk_bf16(v1[2], v1[3]);
                    *(u32x4*)(rowp + bj * HALF) = w; } }
    }
};

typedef unsigned u32x2 __attribute__((ext_vector_type(2)));
struct EpiResid {
    static constexpr bool PERM = false, AFTER_DRAIN = false;
    bf16_t* s; int ldc; u64_t* rowsq;
    __device__ __forceinline__ void operator()(const f32x4 (&acc)[2][2][4][2], const Unit& u, int wr, int wc, int fr, int fq) const {
        const int col0 = u.pn * BM + wc * 32 + 4 * fq;
#pragma unroll
        for (int ai = 0; ai < 2; ++ai)
#pragma unroll
            for (int m = 0; m < 4; ++m) { const int row = u.pm * BM + ai * HALF + wr * 64 + m * 16 + fr; bf16_t* sp = s + (size_t)row * ldc + col0; float ss = 0.f;
                u32x2 in[2][2];
#pragma unroll
                for (int bj = 0; bj < 2; ++bj)
#pragma unroll
                    for (int n = 0; n < 2; ++n) in[bj][n] = *(const u32x2*)(sp + bj * HALF + n * 16);
#pragma unroll
                for (int bj = 0; bj < 2; ++bj)
#pragma unroll
                    for (int n = 0; n < 2; ++n) { const u32x2 w0 = in[bj][n];
                        const f32x4 bs = (f32x4){__builtin_bit_cast(float, w0.x << 16), __builtin_bit_cast(float, w0.x & 0xffff0000u), __builtin_bit_cast(float, w0.y << 16), __builtin_bit_cast(float, w0.y & 0xffff0000u)};
                        const f32x4 o = bs + acc[ai][bj][m][n]; ss += (o[0] * o[0] + o[1] * o[1]) + (o[2] * o[2] + o[3] * o[3]);
                        u32x2 w; w.x = cvt_pk_bf16(o[0], o[1]); w.y = cvt_pk_bf16(o[2], o[3]); *(u32x2*)(sp + bj * HALF + n * 16) = w; }
                ss += shx(ss, 16, fr + 16 * fq); ss += shx(ss, 32, fr + 16 * fq);
                if (fq == 0) atomicAdd(rowsq + row, rowsq_fx(ss)); }
    }
};
struct EpiBf16Row {
    static constexpr bool PERM = true, AFTER_DRAIN = false;
    bf16_t* O; int ldc; const u64_t* rowsq;
    __device__ __forceinline__ void operator()(const f32x4 (&acc)[2][2][4][2], const Unit& u, int wr, int wc, int fr, int fq) const {
        const int row0 = u.pm * BM + wr * 64 + fr, col0 = u.pn * BM + wc * 32 + 8 * fq;
#pragma unroll
        for (int ai = 0; ai < 2; ++ai)
#pragma unroll
            for (int m = 0; m < 4; ++m) { const int row = row0 + ai * HALF + m * 16; const float rs = rowsq_rs(rowsq, row); bf16_t* rowp = O + (size_t)row * ldc + col0;
#pragma unroll
                for (int bj = 0; bj < 2; ++bj) { const f32x4 v0 = acc[ai][bj][m][0] * rs, v1 = acc[ai][bj][m][1] * rs; u32x4 w; w.x = cvt_pk_bf16(v0[0], v0[1]); w.y = cvt_pk_bf16(v0[2], v0[3]); w.z = cvt_pk_bf16(v1[0], v1[1]); w.w = cvt_pk_bf16(v1[2], v1[3]);
                    *(u32x4*)(rowp + bj * HALF) = w; } }
    }
};
struct EpiQKV {
    static constexpr bool PERM = false, AFTER_DRAIN = false;
    bf16_t* O; const float* ga; const float* gb; const float* gc; const float* rope; const u64_t* rowsq;
    __device__ __forceinline__ void operator()(const f32x4 (&acc)[2][2][4][2], const Unit& u, int wr, int wc, int fr, int fq) const {
        const int hg = u.pn * 4 + wc;
        const float* g = nullptr; bool isq = false, dorope = false;
        if (hg < 12) { g = ga; isq = true; } else if (hg < 16) { g = ga + 64; } else if (hg < 20) { }
        else if (hg < 28) { g = gb; isq = true; } else if (hg < 36) { g = gb + 64; } else if (hg < 44) { }
        else if (hg < 56) { g = gc; isq = true; dorope = true; } else if (hg < 60) { g = gc + 64; dorope = true; }
        const float qs = isq ? 0.18033688011112042f : 1.0f;
#pragma unroll
        for (int ai = 0; ai < 2; ++ai)
#pragma unroll
            for (int m = 0; m < 4; ++m) {
                const int row = u.pm * BM + ai * HALF + wr * 64 + m * 16 + fr;
                f32x4 v[2][2];
                const float rsx = rowsq_rs(rowsq, row);
#pragma unroll
                for (int bj = 0; bj < 2; ++bj)
#pragma unroll
                    for (int n = 0; n < 2; ++n) v[bj][n] = acc[ai][bj][m][n] * rsx;
                if (g) {
                    float ss = 0.f;
#pragma unroll
                    for (int bj = 0; bj < 2; ++bj)
#pragma unroll
                        for (int n = 0; n < 2; ++n) { const f32x4 x = v[bj][n]; ss += (x[0] * x[0] + x[1] * x[1]) + (x[2] * x[2] + x[3] * x[3]); }
                    ss += shx(ss, 16, fr + 16 * fq); ss += shx(ss, 32, fr + 16 * fq);
                    const float r = qs / sqrtf(ss * (1.0f / 64.0f) + 1e-6f);
#pragma unroll
                    for (int bj = 0; bj < 2; ++bj)
#pragma unroll
                        for (int n = 0; n < 2; ++n) v[bj][n] = v[bj][n] * *(const f32x4*)(g + 32 * bj + 16 * n + 4 * fq) * r;
                }
                if (dorope) {
                    const int t = row & 2047, pr = t >> 6, pc = t & 63;
#pragma unroll
                    for (int bj = 0; bj < 2; ++bj) {
                        const int pos = bj ? pc : pr;
                        const float* rp = rope + (size_t)(pos * 16 + 4 * fq) * 2;
                        const f32x4 c01 = *(const f32x4*)rp, c23 = *(const f32x4*)(rp + 4);
                        const f32x4 cs = (f32x4){c01[0], c01[2], c23[0], c23[2]}, sn = (f32x4){c01[1], c01[3], c23[1], c23[3]};
                        const f32x4 x1 = v[bj][0], x2 = v[bj][1];
                        v[bj][0] = x1 * cs - x2 * sn; v[bj][1] = x1 * sn + x2 * cs;
                    }
                }
                bf16_t* rowp = O + (size_t)row * 4096 + hg * 64 + 4 * fq;
#pragma unroll
                for (int bj = 0; bj < 2; ++bj)
#pragma unroll
                    for (int n = 0; n < 2; ++n) { u32x2 w; w.x = cvt_pk_bf16(v[bj][n][0], v[bj][n][1]); w.y = cvt_pk_bf16(v[bj][n][2], v[bj][n][3]); *(u32x2*)(rowp + 32 * bj + 16 * n) = w; }
                asm volatile("" ::: "memory");
            }
    }
};
template <class Epi, class Sched, bool ALIGN_EPI = false, bool SP2 = false>
__device__ __forceinline__ void gemm_phase(PG8_LAS unsigned char* lds, const Gemm g, const Sched& S, const Epi& E, const int tid) {
    const int wid = __builtin_amdgcn_readfirstlane(tid >> 6), lane = tid & 63, wr = wid >> 2, wc = wid & 3, fr = lane & 15, fq = lane >> 4;
    const int K = g.K, nt = K / BK;
    unsigned voffA[2], voffB[2];
#pragma unroll
    for (int i = 0; i < 2; ++i) { int R, C; stage_rc(tid * 16 + i * 8192, R, C); const int Rb = Epi::PERM ? ((R & ~31) + perm32(R & 31)) : R;
        voffA[i] = (unsigned)(R * K + C) * 2u; voffB[i] = (unsigned)(Rb * K + C) * 2u; }
    const size_t kstep = (size_t)(BK * 2);
    const size_t hstep = (size_t)HALF * K * 2;
    const size_t tstep = 2 * hstep;
    const unsigned ldsw = (unsigned)wid * 1024u;
    const int aoff = lds_byte(wr * 64 + fr, fq * 8), boff = lds_byte(wc * 32 + fr, fq * 8);
#define PG8_SA(b, h) (((b) * 2 + (h)) * HTB)
#define PG8_SB(b, h) ((4 + (b) * 2 + (h)) * HTB)
#define PG8_STAGE(bufoff, gbase, voff) do { _Pragma("unroll") for (int _i = 0; _i < 2; ++_i) \
        __builtin_amdgcn_global_load_lds((const unsigned*)((const char*)(gbase) + (voff)[_i]), (PG8_LAS unsigned*)(lds + (bufoff) + ldsw + _i * 8192), 16, 0, 0); } while (0)
#define PG8_LDA(dst, b, h) do { _Pragma("unroll") for (int m = 0; m < 4; ++m) _Pragma("unroll") for (int k = 0; k < 2; ++k) dst[m][k] = *(const PG8_LAS bf16x8*)(lds + PG8_SA(b, h) + aoff + m * 2048 + k * 1024); } while (0)
#define PG8_LDB(dst, b, h) do { _Pragma("unroll") for (int n = 0; n < 2; ++n) _Pragma("unroll") for (int k = 0; k < 2; ++k) dst[n][k] = *(const PG8_LAS bf16x8*)(lds + PG8_SB(b, h) + boff + n * 2048 + k * 1024); } while (0)
#define PG8_MMA(ai, bj, At, Bt) do { __builtin_amdgcn_s_setprio(1); _Pragma("unroll") for (int m = 0; m < 4; ++m) _Pragma("unroll") for (int n = 0; n < 2; ++n) _Pragma("unroll") for (int k = 0; k < 2; ++k) \
        acc[ai][bj][m][n] = __builtin_amdgcn_mfma_f32_16x16x32_bf16(Bt[n][k], At[m][k], acc[ai][bj][m][n], 0, 0, 0); __builtin_amdgcn_s_setprio(0); } while (0)
#define PG8_WAIT_V(n) asm volatile("s_waitcnt vmcnt(" #n ")" ::: "memory")
#define PG8_WAIT_L(n) asm volatile("s_waitcnt lgkmcnt(" #n ")" ::: "memory")
#define PG8_BAR __builtin_amdgcn_s_barrier()
#define PG8_SCHED __builtin_amdgcn_sched_barrier(0)
    Unit cur, nxt; int ui = 0;
    if (!S.next(0, cur)) return;
    f32x4 acc[2][2][4][2];
#pragma unroll
    for (int a = 0; a < 2; ++a)
#pragma unroll
        for (int b = 0; b < 2; ++b)
#pragma unroll
            for (int m = 0; m < 4; ++m)
#pragma unroll
                for (int n = 0; n < 2; ++n) acc[a][b][m][n] = (f32x4){0.f, 0.f, 0.f, 0.f};
    bf16x8 At[4][2], B0[2][2], B1[2][2];
    const char* cA = (const char*)g.A + (size_t)cur.pm * tstep; const char* cB = (const char*)g.Bt + (size_t)cur.pn * tstep;
    S.a_ready(cur);
    if constexpr (SP2) {
        PG8_STAGE(PG8_SB(0, 0), cB, voffB); PG8_STAGE(PG8_SB(0, 1), cB + hstep, voffB); PG8_STAGE(PG8_SA(0, 0), cA, voffA); PG8_STAGE(PG8_SA(0, 1), cA + hstep, voffA);
        if (wr == 1) PG8_BAR;
        PG8_WAIT_V(2); PG8_BAR;
        PG8_STAGE(PG8_SB(1, 0), cB + kstep, voffB); PG8_STAGE(PG8_SA(1, 0), cA + kstep, voffA); PG8_STAGE(PG8_SB(1, 1), cB + hstep + kstep, voffB);
        PG8_WAIT_V(6); PG8_BAR;
    } else {
        PG8_STAGE(PG8_SB(0, 0), cB, voffB); PG8_STAGE(PG8_SA(0, 0), cA, voffA); PG8_STAGE(PG8_SB(0, 1), cB + hstep, voffB); PG8_STAGE(PG8_SA(0, 1), cA + hstep, voffA);
        if (wr == 1) PG8_BAR;
        PG8_WAIT_V(4); PG8_BAR;
        PG8_STAGE(PG8_SB(1, 0), cB + kstep, voffB); PG8_STAGE(PG8_SA(1, 0), cA + kstep, voffA); PG8_STAGE(PG8_SB(1, 1), cB + hstep + kstep, voffB);
        PG8_WAIT_V(6); PG8_BAR;
    }
    for (;;) {
        const bool has_next = S.next(ui + 1, nxt);
        const char* nA = has_next ? (const char*)g.A + (size_t)nxt.pm * tstep : cA; const char* nB = has_next ? (const char*)g.Bt + (size_t)nxt.pn * tstep : cB;
        for (int t = 0; t < nt; t += 2) {
            const bool last = (t == nt - 2);
            const char* a1 = cA + (size_t)(t + 1) * kstep;
            const char* a2 = last ? nA : cA + (size_t)(t + 2) * kstep; const char* b2 = last ? nB : cB + (size_t)(t + 2) * kstep;
            const char* a3 = a2 + kstep; const char* b3 = b2 + kstep;
            if (last && has_next) S.a_ready(nxt);
            if constexpr (SP2) {
            PG8_LDB(B0, 0, 0); PG8_LDB(B1, 0, 1); PG8_SCHED; PG8_LDA(At, 0, 0); PG8_STAGE(PG8_SA(1, 1), a1 + hstep, voffA);
            PG8_WAIT_V(8); PG8_WAIT_L(0); PG8_BAR; PG8_MMA(0, 0, At, B0); PG8_MMA(0, 1, At, B1); PG8_BAR; PG8_SCHED;
            PG8_LDA(At, 0, 1); PG8_STAGE(PG8_SB(0, 0), b2, voffB); PG8_STAGE(PG8_SB(0, 1), b2 + hstep, voffB); PG8_STAGE(PG8_SA(0, 0), a2, voffA);
            PG8_WAIT_V(8); PG8_WAIT_L(0); PG8_BAR; PG8_MMA(1, 0, At, B0); PG8_MMA(1, 1, At, B1); PG8_BAR; PG8_SCHED;
            PG8_LDB(B0, 1, 0); PG8_LDB(B1, 1, 1); PG8_SCHED; PG8_LDA(At, 1, 0); PG8_STAGE(PG8_SA(0, 1), a2 + hstep, voffA);
            PG8_WAIT_V(8); PG8_WAIT_L(0); PG8_BAR; PG8_MMA(0, 0, At, B0); PG8_MMA(0, 1, At, B1); PG8_BAR; PG8_SCHED;
            PG8_LDA(At, 1, 1); PG8_STAGE(PG8_SB(1, 0), b3, voffB); PG8_STAGE(PG8_SB(1, 1), b3 + hstep, voffB); PG8_STAGE(PG8_SA(1, 0), a3, voffA);
            PG8_WAIT_V(8); PG8_WAIT_L(0); PG8_BAR; PG8_MMA(1, 0, At, B0); PG8_MMA(1, 1, At, B1); PG8_BAR; PG8_SCHED;
            } else {
            PG8_LDB(B0, 0, 0); PG8_SCHED; PG8_LDA(At, 0, 0); PG8_STAGE(PG8_SA(1, 1), a1 + hstep, voffA);
            PG8_WAIT_L(8); PG8_BAR; PG8_WAIT_L(0); PG8_MMA(0, 0, At, B0); PG8_BAR; PG8_SCHED;
            PG8_LDB(B1, 0, 1); PG8_STAGE(PG8_SB(0, 0), b2, voffB);
            PG8_BAR; PG8_WAIT_L(0); PG8_MMA(0, 1, At, B1); PG8_BAR;
            PG8_LDA(At, 0, 1); PG8_STAGE(PG8_SA(0, 0), a2, voffA);
            PG8_BAR; PG8_WAIT_L(0); PG8_MMA(1, 0, At, B0); PG8_BAR; PG8_SCHED;
            PG8_STAGE(PG8_SB(0, 1), b2 + hstep, voffB);
            PG8_WAIT_V(6); PG8_BAR; PG8_MMA(1, 1, At, B1); PG8_BAR;
            PG8_LDB(B0, 1, 0); PG8_SCHED; PG8_LDA(At, 1, 0); PG8_STAGE(PG8_SA(0, 1), a2 + hstep, voffA);
            PG8_WAIT_L(8); PG8_BAR; PG8_WAIT_L(0); PG8_MMA(0, 0, At, B0); PG8_BAR; PG8_SCHED;
            PG8_LDB(B1, 1, 1); PG8_STAGE(PG8_SB(1, 0), b3, voffB);
            PG8_BAR; PG8_WAIT_L(0); PG8_MMA(0, 1, At, B1); PG8_BAR;
            PG8_LDA(At, 1, 1); PG8_STAGE(PG8_SA(1, 0), a3, voffA);
            PG8_BAR; PG8_WAIT_L(0); PG8_MMA(1, 0, At, B0); PG8_BAR; PG8_SCHED;
            PG8_STAGE(PG8_SB(1, 1), b3 + hstep, voffB);
            PG8_WAIT_V(6); PG8_BAR; PG8_MMA(1, 1, At, B1); PG8_BAR;
            }
        }
        if constexpr (ALIGN_EPI) { if (wr == 0) PG8_BAR; }
        if constexpr (!Epi::AFTER_DRAIN) { E(acc, cur, wr, wc, fr, fq); S.done(cur); }
        if (!has_next) break;
#pragma unroll
        for (int a = 0; a < 2; ++a)
#pragma unroll
            for (int b = 0; b < 2; ++b)
#pragma unroll
                for (int m = 0; m < 4; ++m)
#pragma unroll
                    for (int n = 0; n < 2; ++n) acc[a][b][m][n] = (f32x4){0.f, 0.f, 0.f, 0.f};
        cur = nxt; cA = nA; cB = nB; ++ui;
        if constexpr (ALIGN_EPI) { if (wr == 1) PG8_BAR; }
    }
    PG8_WAIT_V(0);
    if constexpr (!ALIGN_EPI) { if (wr == 0) PG8_BAR; }
    PG8_BAR;
    if constexpr (Epi::AFTER_DRAIN) { E.fused(acc, cur, wr, wc, fr, fq, lds, wid, lane); S.done(cur); }
#undef PG8_SA
#undef PG8_SB
#undef PG8_STAGE
#undef PG8_LDA
#undef PG8_LDB
#undef PG8_MMA
#undef PG8_WAIT_V
#undef PG8_WAIT_L
#undef PG8_BAR
#undef PG8_SCHED
}
}

constexpr int BATCH = 16, SEQ = 2048, DM = 2048, T = BATCH * SEQ, DEPTH = 2;
constexpr int NMEM = 256, DIN = 4096, MEMW = 512;
constexpr int PEER_H = 8, PEER_N = 16384;
constexpr int NWAVES = 8, NTHREADS = NWAVES * 64;
constexpr float EPS = 1e-6f;
constexpr int QA = 0, KA = 768, VA = 1024, QB = 1280, KB = 1792, VB = 2304, QC = 2816, KC = 3584, VC = 3840;
constexpr int OA = 0, OB = 768, OC = 1280;

constexpr size_t MiB = 1u << 20;
constexpr size_t WS_CTL = 0, CTL_ZERO_BYTES = 2 * MiB;
constexpr size_t WS_ROWSQ = 256 * 1024;
constexpr size_t WS_ROPE = 83 * MiB, WS_BIASA = 83 * MiB + 16384;
constexpr size_t WS_WIN = 2 * MiB, WS_WOUT = 34 * MiB, WS_WMQ = 50 * MiB, WS_WMKV = 54 * MiB, WS_WMO = 62 * MiB, WS_WPQ = 66 * MiB, WS_PKEYS = 82 * MiB;
constexpr size_t WS_MEMN = 84 * MiB, WS_KVM = 116 * MiB, WS_PU = 132 * MiB, WS_PV = 260 * MiB, WS_XN = 388 * MiB, WS_QKV = 516 * MiB, WS_ATT = 772 * MiB;
constexpr size_t WS_QM = 900 * MiB, WS_OM = 932 * MiB, WS_END = 964 * MiB;
constexpr size_t WS_QP = WS_QKV, WS_PIDX = WS_QKV + 128 * MiB, WS_PGATE = WS_QKV + 144 * MiB;
constexpr int CW_BAR = 4096;

constexpr int RING_OFF = 0, RING_BYTES = 131072;
constexpr int LDSCTL_OFF = RING_BYTES, MISC_OFF = LDSCTL_OFF + 320;
constexpr int LDS_BYTES = 147456;

#define GAS __attribute__((address_space(1)))
#define LAS __attribute__((address_space(3)))
typedef unsigned short bf16;
typedef unsigned v4u __attribute__((ext_vector_type(4)));
typedef unsigned v2u __attribute__((ext_vector_type(2)));
typedef float f32x4 __attribute__((ext_vector_type(4)));
typedef float f32x16 __attribute__((ext_vector_type(16)));
typedef short bf16x8 __attribute__((ext_vector_type(8)));
typedef GAS unsigned gu32;
#define LDS_WAIT() asm volatile("s_waitcnt lgkmcnt(0)" ::: "memory")
#define VM_WAIT() asm volatile("s_waitcnt vmcnt(0)" ::: "memory")
__device__ __forceinline__ unsigned f2bf(float f) { unsigned u = __builtin_bit_cast(unsigned, f); return (u + 0x7fffu + ((u >> 16) & 1u)) >> 16; }
__device__ __forceinline__ unsigned pk2(float lo, float hi) { return f2bf(lo) | (f2bf(hi) << 16); }
__device__ __forceinline__ float bflo(unsigned w) { return __builtin_bit_cast(float, w << 16); }
__device__ __forceinline__ float bfhi(unsigned w) { return __builtin_bit_cast(float, w & 0xffff0000u); }

__device__ __forceinline__ float shx(float v, int k, int lane) { return __builtin_bit_cast(float, __builtin_amdgcn_ds_bpermute((lane ^ k) << 2, __builtin_bit_cast(int, v))); }
#define XB_TMO      128
#define XB_XCNT(j)  (256  + 64 * (j))
#define XB_XSUB(j)  (1280 + 64 * (j))
#define XB_XGEN(j)  (2304 + 64 * (j))
#define XB_TOP      3328
#define XB_TOPGEN   3392
#define XCD_BAR_WORDS 3456
#define XB_SPIN_CAP (1u << 18)

__device__ __forceinline__ unsigned xb_ld(unsigned* p)              { return __hip_atomic_load(p, __ATOMIC_RELAXED, __HIP_MEMORY_SCOPE_AGENT); }
__device__ __forceinline__ unsigned xb_add(unsigned* p, unsigned v) { return __hip_atomic_fetch_add(p, v, __ATOMIC_RELAXED, __HIP_MEMORY_SCOPE_AGENT); }
__device__ __forceinline__ unsigned xb_xcc_id() { return (unsigned)__builtin_amdgcn_s_getreg((3 << 11) | 20) & 0xFu; }
#define XB_SPIN(cond, bar) do { unsigned _sp = 0; while (cond) { __builtin_amdgcn_s_sleep(1); \
    if ((++_sp & 255u) == 0u) { if (xb_ld(&(bar)[XB_TMO])) break; if (_sp > XB_SPIN_CAP) { atomicAdd(&(bar)[XB_TMO], 1u); break; } } } } while (0)

struct XcdBarrier {
    unsigned* bar; unsigned x;
    volatile LAS unsigned* st;
};

__device__ __forceinline__ XcdBarrier xcd_barrier_post(unsigned* bar, volatile LAS unsigned* st) {
    XcdBarrier b; b.bar = bar; b.x = xb_xcc_id(); b.st = st;
    if (threadIdx.x == 0) (void)xb_add(&bar[XB_XCNT(b.x)], 1u);
    return b;
}
__device__ __forceinline__ void xcd_barrier_complete(unsigned* bar, unsigned x, unsigned& nloc, unsigned& nx) {
    const unsigned G = gridDim.x * gridDim.y * gridDim.z;
    unsigned sum, cnt, mine, sp = 0u;
    for (;;) {
        sum = 0u; cnt = 0u; mine = 0u;
#pragma unroll
        for (unsigned j = 0; j < 16; ++j) { const unsigned c = xb_ld(&bar[XB_XCNT(j)]); sum += c; cnt += (c > 0u) ? 1u : 0u; mine = (j == x) ? c : mine; }
        if (sum == G) break;
        __builtin_amdgcn_s_sleep(1);
        if ((++sp & 255u) == 0u) { if (xb_ld(&bar[XB_TMO])) break; if (sp > XB_SPIN_CAP) { atomicAdd(&bar[XB_TMO], 1u); break; } }
    }
    nloc = mine > 0u ? mine : 1u; nx = cnt > 0u ? cnt : 1u;
}

__device__ __forceinline__ void xcd_barrier(const XcdBarrier& b) {
    asm volatile("s_waitcnt vmcnt(0)" ::: "memory");
    __syncthreads();
    if (threadIdx.x == 0) {
        unsigned* bar = b.bar;
        __builtin_amdgcn_s_waitcnt(0);
        unsigned nloc = b.st[0], nx = b.st[1];
        if (nloc == 0u) { xcd_barrier_complete(bar, b.x, nloc, nx); b.st[0] = nloc; b.st[1] = nx; }
        const unsigned old = xb_add(&bar[XB_XSUB(b.x)], 1u);
        const unsigned gen = old / nloc;
        if (old + 1u == (gen + 1u) * nloc) {
            __builtin_amdgcn_fence(__ATOMIC_RELEASE, "agent");
            asm volatile("s_waitcnt vmcnt(0)" ::: "memory");
            const unsigned og = xb_add(&bar[XB_TOP], 1u);
            const unsigned tg = og / nx;
            if (og + 1u == (tg + 1u) * nx) xb_add(&bar[XB_TOPGEN], 1u);
            else XB_SPIN(xb_ld(&bar[XB_TOPGEN]) == tg, bar);
            __builtin_amdgcn_fence(__ATOMIC_ACQUIRE, "agent");
            xb_add(&bar[XB_XGEN(b.x)], 1u);
            asm volatile("s_waitcnt vmcnt(0)" ::: "memory");
        } else {
            XB_SPIN(xb_ld(&bar[XB_XGEN(b.x)]) == gen, bar);
            __builtin_amdgcn_fence(__ATOMIC_ACQUIRE, "agent");
            asm volatile("s_waitcnt vmcnt(0)" ::: "memory");
        }
    }
    __syncthreads();
}

__device__ __forceinline__ float wave_sum(float v, int lane) {
#pragma unroll
    for (int o = 1; o < 64; o <<= 1) v += shx(v, o, lane);
    return v;
}
__device__ __forceinline__ void* ldptr(LAS unsigned char* lds, int i) {
    const unsigned long long v = ((const LAS unsigned long long*)(lds + LDSCTL_OFF + 1024))[i];
    const unsigned lo = __builtin_amdgcn_readfirstlane((unsigned)v), hi = __builtin_amdgcn_readfirstlane((unsigned)(v >> 32));
    return (void*)(((unsigned long long)hi << 32) | lo);
}
struct OffsetOrder {
    pg8::StaticOrder S;
    __device__ void init(int M, int N, int G, int c, int off) { S.init(M, N, G, (c + G - off % G) % G); }
    __device__ bool next(int i, pg8::Unit& u) const { return S.next(i, u); }
    __device__ __forceinline__ void a_ready(const pg8::Unit&) const {}
    __device__ __forceinline__ void done(const pg8::Unit&) const {}
};

template <bool PERMQKV>
__device__ __forceinline__ void transpose_item(const float* W, int K, int N, bf16* WT, LAS float* scr, int item, int lane, const float* gk = nullptr) {
    const int nblk = N / 32, kb = item / nblk, nb = item % nblk, k0 = 64 * kb, n0 = 32 * nb;
    int d0 = n0;
    if (PERMQKV) { const int within = n0 & 255; d0 = (n0 & ~255) + 128 * ((within >> 5) & 1) + 32 * (within >> 6); }
#pragma unroll 8
    for (int i = 0; i < 32; ++i) { const int kk = 2 * i + (lane >> 5); scr[kk * 33 + (lane & 31)] = W[(size_t)(k0 + kk) * N + n0 + (lane & 31)] * (gk ? gk[k0 + kk] : 1.f); }
    LDS_WAIT(); asm volatile("" ::: "memory");
    const int c = lane & 7;
#pragma unroll
    for (int j = 0; j < 4; ++j) { const int n = (lane >> 3) + 8 * j; const LAS float* s = scr + (8 * c) * 33 + n;
        v4u o; o.x = pk2(s[0 * 33], s[1 * 33]); o.y = pk2(s[2 * 33], s[3 * 33]); o.z = pk2(s[4 * 33], s[5 * 33]); o.w = pk2(s[6 * 33], s[7 * 33]);
        *(GAS v4u*)(WT + (size_t)(d0 + n) * K + k0 + 8 * c) = o; }
    LDS_WAIT(); asm volatile("" ::: "memory");
}
__device__ __forceinline__ void convert_bf16(const float* src, bf16* dst, size_t n, size_t gtid, size_t nthreads) {
    for (size_t i = gtid * 8; i < n; i += nthreads * 8) {
        const f32x4 a = *(const GAS f32x4*)(src + i), b = *(const GAS f32x4*)(src + i + 4);
        v4u o; o.x = pk2(a[0], a[1]); o.y = pk2(a[2], a[3]); o.z = pk2(b[0], b[1]); o.w = pk2(b[2], b[3]);
        *(GAS v4u*)(dst + i) = o;
    }
}
__device__ __forceinline__ int t5_bucket(int rel) {
    const int n = rel < 0 ? -rel : rel;
    const int b = n < 8 ? n : n < 12 ? 8 : n < 16 ? 9 : n < 23 ? 10 : n < 32 ? 11 : n < 46 ? 12 : n < 64 ? 13 : n < 91 ? 14 : 15;
    return b + (rel > 0 ? 16 : 0);
}
__constant__ float ROPE_INV[16] = {1.000000000e+00f, 5.623413324e-01f, 3.162277639e-01f, 1.778279394e-01f, 1.000000015e-01f, 5.623413250e-02f, 3.162277490e-02f, 1.778279431e-02f,
                                   9.999999776e-03f, 5.623413250e-03f, 3.162277630e-03f, 1.778279431e-03f, 1.000000047e-03f, 5.623413017e-04f, 3.162277571e-04f, 1.778279402e-04f};

__device__ __forceinline__ void rms_row_to_bf16(const float* xrow, const float* g0, bf16* o0, const float* g1, bf16* o1, int lane) {
    const GAS f32x4* xr = (const GAS f32x4*)xrow + lane;
    f32x4 v[8]; float s = 0.f;
#pragma unroll
    for (int j = 0; j < 8; ++j) { v[j] = xr[64 * j]; s += (v[j].x * v[j].x + v[j].y * v[j].y) + (v[j].z * v[j].z + v[j].w * v[j].w); }
    const float rstd = 1.f / sqrtf(wave_sum(s, lane) * (1.f / DM) + EPS);
    {   const GAS f32x4* gr = (const GAS f32x4*)g0 + lane; GAS v2u* o8 = (GAS v2u*)o0 + lane;
#pragma unroll
        for (int j = 0; j < 8; ++j) { const f32x4 gg = gr[64 * j]; v2u w; w.x = pk2(v[j].x * rstd * gg.x, v[j].y * rstd * gg.y); w.y = pk2(v[j].z * rstd * gg.z, v[j].w * rstd * gg.w); o8[64 * j] = w; } }
    if (g1) { const GAS f32x4* gr = (const GAS f32x4*)g1 + lane; GAS v2u* o8 = (GAS v2u*)o1 + lane;
#pragma unroll
        for (int j = 0; j < 8; ++j) { const f32x4 gg = gr[64 * j]; v2u w; w.x = pk2(v[j].x * rstd * gg.x, v[j].y * rstd * gg.y); w.y = pk2(v[j].z * rstd * gg.z, v[j].w * rstd * gg.w); o8[64 * j] = w; } }
}
__device__ __forceinline__ void prep_row(const float* xrow, bf16* orow, u64_t* sq, int lane) {
    const GAS f32x4* xr = (const GAS f32x4*)xrow + lane; GAS v2u* o8 = (GAS v2u*)orow + lane; float s = 0.f;
#pragma unroll
    for (int j = 0; j < 8; ++j) { const f32x4 v = xr[64 * j]; s += (v.x * v.x + v.y * v.y) + (v.z * v.z + v.w * v.w); v2u w; w.x = pk2(v.x, v.y); w.y = pk2(v.z, v.w); o8[64 * j] = w; }
    s = wave_sum(s, lane);
    if (lane == 0) *sq = rowsq_fx(s);
}
__device__ __forceinline__ void norm_rows(const float* X, const float* g, bf16* XN, int gw, int NGW, int lane) {
    for (int m = gw; m < T; m += NGW) rms_row_to_bf16(X + (size_t)m * DM, g, XN + (size_t)m * DM, nullptr, nullptr, lane);
}

template <int TYPE>
__device__ __forceinline__ void naive_attn_item(const bf16* QKV, bf16* ATT, int b, int grow, int head, int lane, const float* biasA, const float* sink, const float* rpb) {
    const int tpos = grow * 64 + lane; const size_t trow = (size_t)b * SEQ + tpos;
    int qcol, kcol, vcol, ocol;
    if (TYPE == 0) { qcol = QA + head * 64; kcol = KA + (head / 3) * 64; vcol = VA + (head / 3) * 64; ocol = OA + head * 64; }
    else if (TYPE == 1) { qcol = QB + head * 64; kcol = KB + head * 64; vcol = VB + head * 64; ocol = OB + head * 64; }
    else { qcol = QC + head * 64; kcol = KC + (head / 3) * 64; vcol = VC + (head / 3) * 64; ocol = OC + head * 64; }
    float q[64], o[64];
#pragma unroll
    for (int c = 0; c < 8; ++c) { const v4u w = *(const GAS v4u*)(QKV + trow * DIN + qcol + 8 * c);
        q[8 * c + 0] = bflo(w.x); q[8 * c + 1] = bfhi(w.x); q[8 * c + 2] = bflo(w.y); q[8 * c + 3] = bfhi(w.y); q[8 * c + 4] = bflo(w.z); q[8 * c + 5] = bfhi(w.z); q[8 * c + 6] = bflo(w.w); q[8 * c + 7] = bfhi(w.w); }
#pragma unroll
    for (int d = 0; d < 64; ++d) o[d] = 0.f;
    float m = -1e30f, l = 0.f;
    int j0, j1;
    if (TYPE == 0) { j0 = grow * 64 - 128; if (j0 < 0) j0 = 0; j1 = grow * 64 + 63 + 128; if (j1 > SEQ - 1) j1 = SEQ - 1; }
    else if (TYPE == 1) { int r0 = grow - 4; r0 = r0 < 0 ? 0 : (r0 > 24 ? 24 : r0); j0 = r0 * 64; j1 = j0 + 511; }
    else { j0 = 0; j1 = SEQ - 1; }
    int c0 = lane - 8; c0 = c0 < 0 ? 0 : (c0 > 48 ? 48 : c0);
#pragma unroll 1
    for (int j = j0; j <= j1; ++j) {
        const bf16* krow = QKV + ((size_t)b * SEQ + j) * DIN;
        float s = 0.f;
#pragma unroll
        for (int c = 0; c < 8; ++c) { const v4u w = *(const GAS v4u*)(krow + kcol + 8 * c);
            s += q[8 * c + 0] * bflo(w.x) + q[8 * c + 1] * bfhi(w.x) + q[8 * c + 2] * bflo(w.y) + q[8 * c + 3] * bfhi(w.y) + q[8 * c + 4] * bflo(w.z) + q[8 * c + 5] * bfhi(w.z) + q[8 * c + 6] * bflo(w.w) + q[8 * c + 7] * bfhi(w.w); }
        bool valid = true;
        if (TYPE == 0) { const int rel = j - tpos; valid = (rel >= -128 && rel <= 128); if (valid) s += biasA[head * 257 + rel + 128]; }
        if (TYPE == 1) { const int kr = j >> 6, kc = j & 63; valid = (kc >= c0 && kc < c0 + 16); if (valid) s += rpb[(head * 15 + (kr - grow + 7)) * 31 + (kc - lane + 15)]; }
        const float mn = valid ? fmaxf(m, s) : m;
        const float a = __expf(m - mn);
        const float p = valid ? __expf(s - mn) : 0.f;
        l = l * a + p; m = mn;
#pragma unroll
        for (int c = 0; c < 8; ++c) { const v4u w = *(const GAS v4u*)(krow + vcol + 8 * c);
            o[8 * c + 0] = o[8 * c + 0] * a + p * bflo(w.x); o[8 * c + 1] = o[8 * c + 1] * a + p * bfhi(w.x); o[8 * c + 2] = o[8 * c + 2] * a + p * bflo(w.y); o[8 * c + 3] = o[8 * c + 3] * a + p * bfhi(w.y);
            o[8 * c + 4] = o[8 * c + 4] * a + p * bflo(w.z); o[8 * c + 5] = o[8 * c + 5] * a + p * bfhi(w.z); o[8 * c + 6] = o[8 * c + 6] * a + p * bflo(w.w); o[8 * c + 7] = o[8 * c + 7] * a + p * bfhi(w.w); }
    }
    if (TYPE == 0) l += __expf(sink[head] - m);
    const float inv = 1.f / l;
#pragma unroll
    for (int c = 0; c < 8; ++c) { v4u w; w.x = pk2(o[8 * c + 0] * inv, o[8 * c + 1] * inv); w.y = pk2(o[8 * c + 2] * inv, o[8 * c + 3] * inv); w.z = pk2(o[8 * c + 4] * inv, o[8 * c + 5] * inv); w.w = pk2(o[8 * c + 6] * inv, o[8 * c + 7] * inv);
        *(GAS v4u*)(ATT + trow * DM + ocol + 8 * c) = w; }
}
__device__ __forceinline__ float rdl(float v, int l) { return __builtin_bit_cast(float, __builtin_amdgcn_readlane(__builtin_bit_cast(int, v), l)); }
__device__ __forceinline__ void naive_mem_item(const bf16* QM, const bf16* KVM, bf16* OM, const float* gq, size_t trow, int b, int head, int lane) {
    const unsigned qw = *(const GAS unsigned*)(QM + trow * MEMW + head * 128 + 2 * lane);
    float q0 = bflo(qw), q1 = bfhi(qw);
    const float ss = wave_sum(q0 * q0 + q1 * q1, lane);
    const float r = 0.08838834764831845f / sqrtf(ss * (1.f / 128.f) + EPS);
    q0 *= r * gq[2 * lane]; q1 *= r * gq[2 * lane + 1];
    const bf16* kbase = KVM + ((size_t)b * NMEM + lane) * 1024 + head * 128;
    float s[4] = {0.f, 0.f, 0.f, 0.f};
#pragma unroll 1
    for (int c = 0; c < 16; ++c) {
        float qa[8];
#pragma unroll
        for (int e = 0; e < 4; ++e) { qa[2 * e] = rdl(q0, 4 * c + e); qa[2 * e + 1] = rdl(q1, 4 * c + e); }
#pragma unroll
        for (int i = 0; i < 4; ++i) { const v4u w = *(const GAS v4u*)(kbase + (size_t)i * 64 * 1024 + 8 * c);
            s[i] += qa[0] * bflo(w.x) + qa[1] * bfhi(w.x) + qa[2] * bflo(w.y) + qa[3] * bfhi(w.y) + qa[4] * bflo(w.z) + qa[5] * bfhi(w.z) + qa[6] * bflo(w.w) + qa[7] * bfhi(w.w); }
    }
    float m = fmaxf(fmaxf(s[0], s[1]), fmaxf(s[2], s[3]));
#pragma unroll
    for (int o = 1; o < 64; o <<= 1) m = fmaxf(m, shx(m, o, lane));
    float p[4]; float l = 0.f;
#pragma unroll
    for (int i = 0; i < 4; ++i) { p[i] = __expf(s[i] - m); l += p[i]; }
    l = wave_sum(l, lane);
    const bf16* vbase = KVM + ((size_t)b * NMEM) * 1024 + 512 + head * 128 + 2 * lane;
    float o0 = 0.f, o1 = 0.f;
#pragma unroll
    for (int i = 0; i < 4; ++i) {
#pragma unroll 4
        for (int jj = 0; jj < 64; ++jj) { const float pj = rdl(p[i], jj); const unsigned w = *(const GAS unsigned*)(vbase + (size_t)(64 * i + jj) * 1024); o0 += pj * bflo(w); o1 += pj * bfhi(w); }
    }
    const float inv = 1.f / l;
    *(GAS unsigned*)(OM + trow * MEMW + head * 128 + 2 * lane) = pk2(o0 * inv, o1 * inv);
}
__device__ __forceinline__ void mixnorm_rows(bf16* ATT, const float* g, int gw, int NGW, int lane) {
    for (int m = gw; m < T; m += NGW) {
        GAS v4u* p = (GAS v4u*)(ATT + (size_t)m * DM + 32 * lane);
        v4u w[4]; float f[32]; float ss = 0.f;
#pragma unroll
        for (int c = 0; c < 4; ++c) { w[c] = p[c];
            f[8 * c + 0] = bflo(w[c].x); f[8 * c + 1] = bfhi(w[c].x); f[8 * c + 2] = bflo(w[c].y); f[8 * c + 3] = bfhi(w[c].y); f[8 * c + 4] = bflo(w[c].z); f[8 * c + 5] = bfhi(w[c].z); f[8 * c + 6] = bflo(w[c].w); f[8 * c + 7] = bfhi(w[c].w); }
#pragma unroll
        for (int i = 0; i < 32; ++i) ss += f[i] * f[i];
        const int grp = lane < 24 ? 0 : (lane < 40 ? 1 : 2);
        const float sa = wave_sum(grp == 0 ? ss : 0.f, lane), sb = wave_sum(grp == 1 ? ss : 0.f, lane), sc = wave_sum(grp == 2 ? ss : 0.f, lane);
        const float r = grp == 0 ? 1.f / sqrtf(sa * (1.f / 768.f) + EPS) : (grp == 1 ? 1.f / sqrtf(sb * (1.f / 512.f) + EPS) : 1.f / sqrtf(sc * (1.f / 768.f) + EPS));
        const float* gg = g + 32 * lane;
#pragma unroll
        for (int c = 0; c < 4; ++c) { const f32x4 g0 = *(const GAS f32x4*)(gg + 8 * c), g1 = *(const GAS f32x4*)(gg + 8 * c + 4);
            v4u o; o.x = pk2(f[8 * c + 0] * r * g0[0], f[8 * c + 1] * r * g0[1]); o.y = pk2(f[8 * c + 2] * r * g0[2], f[8 * c + 3] * r * g0[3]);
            o.z = pk2(f[8 * c + 4] * r * g1[0], f[8 * c + 5] * r * g1[1]); o.w = pk2(f[8 * c + 6] * r * g1[2], f[8 * c + 7] * r * g1[3]); p[c] = o; }
    }
}

#ifndef PEER_HD
#define PEER_HD __device__ __forceinline__
#define PEER_EXP(x) __expf(x)
#endif
template <int N> PEER_HD void bitonic_sort_desc(float* v) {
#pragma unroll
    for (int k = 2; k <= N; k <<= 1)
#pragma unroll
        for (int j = k >> 1; j > 0; j >>= 1)
#pragma unroll
            for (int i = 0; i < N; ++i) { const int l = i ^ j; if (l > i) { const bool desc = ((i & k) == 0); const float a = v[i], b = v[l]; const float hi = fmaxf(a, b), lo = fminf(a, b);
                v[i] = desc ? hi : lo; v[l] = desc ? lo : hi; } }
}
PEER_HD void merge_top16(float* a, const float* b) {
    float c[16];
#pragma unroll
    for (int i = 0; i < 16; ++i) c[i] = fmaxf(a[i], b[15 - i]);
#pragma unroll
    for (int j = 8; j > 0; j >>= 1)
#pragma unroll
        for (int i = 0; i < 16; ++i) { const int l = i ^ j; if (l > i) { const float x = c[i], y = c[l]; c[i] = fmaxf(x, y); c[l] = fminf(x, y); } }
#pragma unroll
    for (int i = 0; i < 16; ++i) a[i] = c[i];
}
PEER_HD void top16_of_64(float (&v)[64]) {
    bitonic_sort_desc<16>(&v[0]); bitonic_sort_desc<16>(&v[16]); bitonic_sort_desc<16>(&v[32]); bitonic_sort_desc<16>(&v[48]);
    merge_top16(&v[0], &v[16]); merge_top16(&v[32], &v[48]); merge_top16(&v[0], &v[32]);
}
PEER_HD float pack_idx(float s, unsigned idx, unsigned mask) { return __builtin_bit_cast(float, (__builtin_bit_cast(unsigned, s) & ~mask) | idx); }
PEER_HD unsigned low_bits(float s, unsigned mask) { return __builtin_bit_cast(unsigned, s) & mask; }
PEER_HD unsigned pick16(const float* a, unsigned i, unsigned mask) {
    unsigned r = 0;
#pragma unroll
    for (unsigned k = 0; k < 16; ++k) r = (i == k) ? low_bits(a[k], mask) : r;
    return r;
}
PEER_HD void peer_candidates(const float* a, const float* b, int* e, float* gate) {
    float c[64]; int n = 0;
#pragma unroll
    for (int i = 0; i < 16; ++i)
#pragma unroll
        for (int j = 0; j < 16; ++j) if ((i + 1) * (j + 1) <= 16) { c[n] = pack_idx(a[i] + b[j], (unsigned)(i * 16 + j), 0xffu); ++n; }
#pragma unroll
    for (int k = 50; k < 64; ++k) c[k] = -3.0e38f;
    top16_of_64(c);
    float mx = c[0], den = 0.f;
#pragma unroll
    for (int k = 0; k < 16; ++k) { const unsigned id = low_bits(c[k], 0xffu); const unsigned n0 = pick16(a, id >> 4, 0x7fu), n1 = pick16(b, id & 15u, 0x7fu);
        e[k] = (int)(n0 * 128u + n1); gate[k] = PEER_EXP(c[k] - mx); den += gate[k]; }
    const float inv = 1.f / den;
#pragma unroll
    for (int k = 0; k < 16; ++k) gate[k] *= inv;
}

__device__ __forceinline__ void peer_select_unit(const bf16* QP, const bf16* PK, int* PIDX, float* PGATE, int tb, int h, int wave, int lane) {
    const int hh = lane >> 5, tl = lane & 31; const size_t t = (size_t)tb * 256 + wave * 32 + tl;
    float ab[2][16];
#pragma unroll
    for (int p = 0; p < 2; ++p) {
        bf16x8 bq[8];
#pragma unroll
        for (int s = 0; s < 8; ++s) bq[s] = *(const GAS bf16x8*)(QP + t * DM + 256 * h + 128 * p + 16 * s + 8 * hh);
        float v[64];
#pragma unroll
        for (int nb = 0; nb < 4; ++nb) {
            f32x16 acc;
#pragma unroll
            for (int r = 0; r < 16; ++r) acc[r] = 0.f;
            const bf16* kp = PK + ((size_t)((h * 2 + p) * 128 + 32 * nb + tl)) * 128 + 8 * hh;
#pragma unroll
            for (int s = 0; s < 8; ++s) { const bf16x8 ak = *(const GAS bf16x8*)(kp + 16 * s); acc = __builtin_amdgcn_mfma_f32_32x32x16_bf16(ak, bq[s], acc, 0, 0, 0); }
#pragma unroll
            for (int r = 0; r < 16; ++r) v[16 * nb + r] = pack_idx(acc[r], (unsigned)(32 * nb + 8 * (r >> 2) + 4 * hh + (r & 3)), 0x7fu);
        }
        top16_of_64(v);
        float pv[16];
#pragma unroll
        for (int i = 0; i < 16; ++i) pv[i] = shx(v[i], 32, lane);
        merge_top16(&v[0], pv);
#pragma unroll
        for (int i = 0; i < 16; ++i) ab[p][i] = v[i];
    }
    int e[16]; float gate[16];
    peer_candidates(ab[0], ab[1], e, gate);
    if (hh == 0) { GAS v4u* o = (GAS v4u*)(PIDX + t * 128 + h * 16);
#pragma unroll
        for (int c = 0; c < 4; ++c) o[c] = (v4u){(unsigned)e[4 * c], (unsigned)e[4 * c + 1], (unsigned)e[4 * c + 2], (unsigned)e[4 * c + 3]}; }
    else { GAS f32x4* o = (GAS f32x4*)(PGATE + t * 128 + h * 16);
#pragma unroll
        for (int c = 0; c < 4; ++c) o[c] = (f32x4){gate[4 * c], gate[4 * c + 1], gate[4 * c + 2], gate[4 * c + 3]}; }
}

typedef float f32x2 __attribute__((ext_vector_type(2)));
constexpr float PU_SCALE = 256.f, PV_SCALE = 16.f;
__device__ __forceinline__ void convert_fp8(const float* src, unsigned char* dst, size_t n, float scale, size_t gtid, size_t nthreads) {
    for (size_t i = gtid * 16; i < n; i += nthreads * 16) {
        v4u o;
#pragma unroll
        for (int c = 0; c < 4; ++c) { f32x4 a = *(const GAS f32x4*)(src + i + 4 * c) * scale;
#pragma unroll
            for (int e = 0; e < 4; ++e) a[e] = fminf(fmaxf(a[e], -448.f), 448.f);
            int p = 0; p = __builtin_amdgcn_cvt_pk_fp8_f32(a[0], a[1], p, false); p = __builtin_amdgcn_cvt_pk_fp8_f32(a[2], a[3], p, true); o[c] = (unsigned)p; }
        *(GAS v4u*)(dst + i) = o;
    }
}
__device__ __forceinline__ void dot16_fp8(f32x2& acc, const v4u& w, const f32x2* x) {
#pragma unroll
    for (int c = 0; c < 4; ++c) { acc += __builtin_amdgcn_cvt_pk_f32_fp8((int)w[c], false) * x[2 * c]; acc += __builtin_amdgcn_cvt_pk_f32_fp8((int)w[c], true) * x[2 * c + 1]; }
}
__device__ __forceinline__ void axpy16_fp8(f32x2* y, const f32x2 wv, const v4u& w) {
#pragma unroll
    for (int c = 0; c < 4; ++c) { y[2 * c] += __builtin_amdgcn_cvt_pk_f32_fp8((int)w[c], false) * wv; y[2 * c + 1] += __builtin_amdgcn_cvt_pk_f32_fp8((int)w[c], true) * wv; }
}
typedef unsigned v6u __attribute__((ext_vector_type(6)));
typedef float v32f __attribute__((ext_vector_type(32)));
typedef v4u __attribute__((aligned(8))) v4u_a8;
constexpr float PU_SCALE6 = 90.0f, PV_SCALE6 = 5.65f;
__device__ __forceinline__ unsigned enc_e2m3(float v) {
    const float a = fminf(fabsf(v), 7.5f);
    unsigned code;
    if (a < 1.0f) code = (unsigned)__builtin_rintf(a * 8.f);
    else { const unsigned b = __builtin_bit_cast(unsigned, a) - 0x3F800000u; code = ((b + 0x7FFFFu + ((b >> 20) & 1u)) >> 20) + 8u; }
    return code | (v < 0.f ? 32u : 0u);
}
__device__ __forceinline__ void convert_fp6_rows(const float* src, unsigned char* dst, int nrows, float scale, const float* gain, int gw, int NGW, int lane) {
    for (int r = gw; r < nrows; r += NGW) {
        const float* sp = src + (size_t)r * DM + 4 * lane; const float* gp = gain ? gain + (size_t)(r / PEER_N) * DM + 4 * lane : nullptr;
        unsigned w[6] = {0u, 0u, 0u, 0u, 0u, 0u};
#pragma unroll
        for (int j = 0; j < 8; ++j) { f32x4 a = *(const GAS f32x4*)(sp + 256 * j) * scale; if (gp) a = a * *(const GAS f32x4*)(gp + 256 * j);
#pragma unroll
            for (int e = 0; e < 4; ++e) { const unsigned code = enc_e2m3(a[e]); const int bp = 6 * (4 * j + e), wi = bp >> 5, sh = bp & 31;
                w[wi] |= code << sh; if (sh > 26) w[wi + 1] |= code >> (32 - sh); } }
        unsigned char* dp = dst + (size_t)r * 1536 + 24 * lane;
        *(GAS v4u_a8*)dp = (v4u){w[0], w[1], w[2], w[3]}; *(GAS v2u*)(dp + 16) = (v2u){w[4], w[5]};
    }
}
constexpr float PV_SCALE4 = 5.65f;
__device__ __forceinline__ unsigned enc_e2m1(float v) {
    const float a = fabsf(v);
    const unsigned code = a < 0.25f ? 0u : a < 0.75f ? 1u : a < 1.25f ? 2u : a < 1.75f ? 3u : a < 2.5f ? 4u : a < 3.5f ? 5u : a < 5.0f ? 6u : 7u;
    return code | (v < 0.f ? 8u : 0u);
}
__device__ __forceinline__ void convert_fp4_rows(const float* src, unsigned char* dst, int nrows, float scale, int gw, int NGW, int lane) {
    for (int r = gw; r < nrows; r += NGW) {
        const float* sp = src + (size_t)r * DM + 4 * lane;
        unsigned w[4] = {0u, 0u, 0u, 0u};
#pragma unroll
        for (int j = 0; j < 8; ++j) { const f32x4 a = *(const GAS f32x4*)(sp + 256 * j) * scale;
#pragma unroll
            for (int e = 0; e < 4; ++e) { const int i = 4 * j + e; w[i >> 3] |= enc_e2m1(a[e]) << (4 * (i & 7)); } }
        *(GAS v4u*)(dst + (size_t)r * 1024 + 16 * lane) = (v4u){w[0], w[1], w[2], w[3]};
    }
}
#define PG4_LOAD(buf, tab, idlo, idhi, g) do { _Pragma("unroll") for (int i_ = 0; i_ < PG6_R; ++i_) { const int k_ = (g) * PG6_R + i_; \
        const int e_ = __builtin_amdgcn_readlane(k_ < 64 ? idlo : idhi, k_ & 63); buf[i_] = *(const GAS v4u*)((tab) + (size_t)(unsigned)e_ * 1024u + voff4); } } while (0)
#define PG4_AXPY(buf, g) do { _Pragma("unroll") for (int i_ = 0; i_ < PG6_R; ++i_) { const float w_ = wl[(g) * PG6_R + i_]; const f32x2 wv_ = {w_, w_}; \
        _Pragma("unroll") for (int c_ = 0; c_ < 4; ++c_) { const unsigned u_ = buf[i_][c_]; \
            y[4 * c_ + 0] += __builtin_amdgcn_cvt_scalef32_pk_f32_fp4(u_, 1.0f, 0) * wv_; y[4 * c_ + 1] += __builtin_amdgcn_cvt_scalef32_pk_f32_fp4(u_, 1.0f, 1) * wv_; \
            y[4 * c_ + 2] += __builtin_amdgcn_cvt_scalef32_pk_f32_fp4(u_, 1.0f, 2) * wv_; y[4 * c_ + 3] += __builtin_amdgcn_cvt_scalef32_pk_f32_fp4(u_, 1.0f, 3) * wv_; } \
        __builtin_amdgcn_sched_barrier(0); } } while (0)
#ifndef PG6_R
#define PG6_R 8
#endif
#define PG6_LOAD(buf, tab, idlo, idhi, g) do { _Pragma("unroll") for (int i_ = 0; i_ < PG6_R; ++i_) { const int k_ = (g) * PG6_R + i_; \
        const int e_ = __builtin_amdgcn_readlane(k_ < 64 ? idlo : idhi, k_ & 63); const unsigned char* rp_ = (tab) + (size_t)(unsigned)e_ * 1536u; \
        const v4u a_ = *(const GAS v4u_a8*)(rp_ + voff); const v2u b_ = *(const GAS v2u*)(rp_ + voff + 16); buf[i_] = (v6u){a_.x, a_.y, a_.z, a_.w, b_.x, b_.y}; } } while (0)
#define PG6_DOT1(buf, i_, dst) do { const v32f f_ = __builtin_amdgcn_cvt_scalef32_pk32_f32_fp6(buf[i_], 1.0f); f32x2 a_ = {0.f, 0.f}; \
        _Pragma("unroll") for (int c_ = 0; c_ < 16; ++c_) a_ += (f32x2){f_[2 * c_], f_[2 * c_ + 1]} * x[c_]; dst = a_.x + a_.y; __builtin_amdgcn_sched_barrier(0); } while (0)
#if PG6_R == 8
#define PG6_DOT(buf, g) do { float p_[8]; _Pragma("unroll") for (int i_ = 0; i_ < 8; ++i_) PG6_DOT1(buf, i_, p_[i_]); \
        float q_[4]; _Pragma("unroll") for (int i_ = 0; i_ < 4; ++i_) { const float keep_ = b5 ? p_[i_ + 4] : p_[i_], send_ = b5 ? p_[i_] : p_[i_ + 4]; q_[i_] = keep_ + shx(send_, 32, lane); } \
        float r_[2]; _Pragma("unroll") for (int i_ = 0; i_ < 2; ++i_) { const float keep_ = b4 ? q_[i_ + 2] : q_[i_], send_ = b4 ? q_[i_] : q_[i_ + 2]; r_[i_] = keep_ + shx(send_, 16, lane); } \
        float s_; { const float keep_ = b3 ? r_[1] : r_[0], send_ = b3 ? r_[0] : r_[1]; s_ = keep_ + shx(send_, 8, lane); } \
        s_ += shx(s_, 4, lane); s_ += shx(s_, 2, lane); s_ += shx(s_, 1, lane); \
        if ((lane & 7) == 0) wl[(g) * 8 + (lane >> 3)] = s_; } while (0)
#else
#define PG6_DOT(buf, g) do { float p_[4]; _Pragma("unroll") for (int i_ = 0; i_ < 4; ++i_) PG6_DOT1(buf, i_, p_[i_]); \
        float r_[2]; _Pragma("unroll") for (int i_ = 0; i_ < 2; ++i_) { const float keep_ = b5 ? p_[i_ + 2] : p_[i_], send_ = b5 ? p_[i_] : p_[i_ + 2]; r_[i_] = keep_ + shx(send_, 32, lane); } \
        float s_; { const float keep_ = b4 ? r_[1] : r_[0], send_ = b4 ? r_[0] : r_[1]; s_ = keep_ + shx(send_, 16, lane); } \
        s_ += shx(s_, 8, lane); s_ += shx(s_, 4, lane); s_ += shx(s_, 2, lane); s_ += shx(s_, 1, lane); \
        if ((lane & 15) == 0) wl[(g) * 4 + (lane >> 4)] = s_; } while (0)
#endif
#define PG6_AXPY(buf, g) do { _Pragma("unroll") for (int i_ = 0; i_ < PG6_R; ++i_) { const float w_ = wl[(g) * PG6_R + i_]; const f32x2 wv_ = {w_, w_}; \
        const v32f f_ = __builtin_amdgcn_cvt_scalef32_pk32_f32_fp6(buf[i_], 1.0f); _Pragma("unroll") for (int c_ = 0; c_ < 16; ++c_) y[c_] += (f32x2){f_[2 * c_], f_[2 * c_ + 1]} * wv_; __builtin_amdgcn_sched_barrier(0); } } while (0)
__device__ __forceinline__ unsigned shxu(unsigned v, int k, int lane) { return (unsigned)__builtin_amdgcn_ds_bpermute((lane ^ k) << 2, (int)v); }
__device__ __forceinline__ void wave_sort128(unsigned& a, unsigned& b, int lane) {
#pragma unroll
    for (int k = 2; k <= 128; k <<= 1) {
#pragma unroll
        for (int j = k >> 1; j > 0; j >>= 1) {
            if (j == 64) { const unsigned lo = a < b ? a : b, hi = a < b ? b : a; a = lo; b = hi; }
            else {
                const unsigned pa = shxu(a, j, lane), pb = shxu(b, j, lane);
                const bool lower = (lane & j) == 0;
                const bool asc_a = (lane & k) == 0, asc_b = ((lane + 64) & k) == 0;
                const bool take_min_a = (lower == asc_a), take_min_b = (lower == asc_b);
                a = take_min_a ? (a < pa ? a : pa) : (a < pa ? pa : a);
                b = take_min_b ? (b < pb ? b : pb) : (b < pb ? pb : b);
            }
        }
    }
}
__device__ __forceinline__ void peer_gather6(bf16* XN, const unsigned char* PU6, const unsigned char* PV6, const int* PIDX, const float* PGATE, float* X, const u64_t* rowsq_in, u64_t* rowsq_out, LAS float* wl, int gw, int NGW, int lane) {
    const bool b5 = (lane >> 5) & 1, b4 = (lane >> 4) & 1, b3 = (lane >> 3) & 1; (void)b3;
    const unsigned voff = 24u * (unsigned)lane, voff4 = 16u * (unsigned)lane, l4 = 4u * (unsigned)lane, l8 = 8u * (unsigned)lane, l16 = 16u * (unsigned)lane;
    constexpr int NG = 128 / PG6_R;
    for (int t_ = gw; t_ < T; t_ += NGW) {
        int t = t_; asm volatile("" : "+s"(t));
        const char* pidx_t = (const char*)(PIDX + (size_t)t * 128); const char* pgate_t = (const char*)(PGATE + (size_t)t * 128);
        unsigned ka = ((unsigned)*(const GAS int*)(pidx_t + l4) << 7) | (unsigned)lane, kb = ((unsigned)*(const GAS int*)(pidx_t + l4 + 256) << 7) | (unsigned)(lane + 64);
        wave_sort128(ka, kb, lane);
        const int idlo = (int)(ka >> 7), idhi = (int)(kb >> 7);
        v6u A[PG6_R], B[PG6_R]; v4u AV[PG6_R], BV[PG6_R];
        PG6_LOAD(A, PU6, idlo, idhi, 0);
        f32x2 x[16];
        {   const char* xr = (const char*)(XN + (size_t)t * DM); const float xs = (1.f / PU_SCALE6) * rowsq_rs(rowsq_in, t);
#pragma unroll
            for (int j = 0; j < 8; ++j) { const v2u a = *(const GAS v2u*)(xr + l8 + 512 * j); x[2 * j] = (f32x2){bflo(a.x), bfhi(a.x)} * xs; x[2 * j + 1] = (f32x2){bflo(a.y), bfhi(a.y)} * xs; } }
#pragma unroll 1
        for (int g = 0; g < NG - 2; g += 2) {
            PG6_LOAD(B, PU6, idlo, idhi, g + 1);
            PG6_DOT(A, g);
            PG6_LOAD(A, PU6, idlo, idhi, g + 2);
            PG6_DOT(B, g + 1);
        }
        PG6_LOAD(B, PU6, idlo, idhi, NG - 1);
        PG6_DOT(A, NG - 2);
        PG4_LOAD(AV, PV6, idlo, idhi, 0);
        PG6_DOT(B, NG - 1);
        LDS_WAIT();
        {   const float g0 = *(const GAS float*)(pgate_t + 4u * (ka & 127u)), g1 = *(const GAS float*)(pgate_t + 4u * (kb & 127u));
            const float d0 = wl[lane], d1 = wl[64 + lane];
            const float w0 = g0 * 0.5f * d0 * (1.f + erff(d0 * 0.70710678118654752f)) * (1.f / PV_SCALE4), w1 = g1 * 0.5f * d1 * (1.f + erff(d1 * 0.70710678118654752f)) * (1.f / PV_SCALE4);
            LDS_WAIT(); asm volatile("" ::: "memory");
            wl[lane] = w0; wl[64 + lane] = w1;
            LDS_WAIT(); asm volatile("" ::: "memory");
        }
        f32x2 y[16];
#pragma unroll
        for (int i = 0; i < 16; ++i) y[i] = (f32x2){0.f, 0.f};
#pragma unroll 1
        for (int g = 0; g < NG; g += 2) {
            PG4_LOAD(BV, PV6, idlo, idhi, g + 1);
            PG4_AXPY(AV, g);
            if (g + 2 < NG) PG4_LOAD(AV, PV6, idlo, idhi, g + 2);
            PG4_AXPY(BV, g + 1);
        }
        {   char* xo = (char*)(X + (size_t)t * DM);
            char* xbo = (char*)(XN + (size_t)t * DM); float ss = 0.f;
#pragma unroll
            for (int j = 0; j < 8; ++j) { const v2u a = *(const GAS v2u*)(xbo + l8 + 512 * j); f32x4 v = (f32x4){bflo(a.x), bfhi(a.x), bflo(a.y), bfhi(a.y)}; v += (f32x4){y[2 * j].x, y[2 * j].y, y[2 * j + 1].x, y[2 * j + 1].y};
                if (X) *(GAS f32x4*)(xo + l16 + 1024 * j) = v;
                ss += (v[0] * v[0] + v[1] * v[1]) + (v[2] * v[2] + v[3] * v[3]); *(GAS v2u*)(xbo + l8 + 512 * j) = (v2u){pk2(v[0], v[1]), pk2(v[2], v[3])}; }
            if (rowsq_out) { ss = wave_sum(ss, lane); if (lane == 0) rowsq_out[t] = rowsq_fx(ss); } }
        LDS_WAIT(); asm volatile("" ::: "memory");
    }
}

typedef short s16x4 __attribute__((ext_vector_type(4)));
typedef __attribute__((address_space(3))) const char* lds_cptr;
__device__ __forceinline__ s16x4 vtr(lds_cptr p) { return __builtin_bit_cast(s16x4, __builtin_amdgcn_ds_read_tr16_b64_v4i16((__attribute__((address_space(3))) s16x4*)p)); }
__device__ __forceinline__ unsigned cvtpk(float lo, float hi) { unsigned r; asm("v_cvt_pk_bf16_f32 %0, %1, %2" : "=v"(r) : "v"(lo), "v"(hi)); return r; }
constexpr int AT_K0 = 0, AT_V0 = 16384, AT_TAB = 32768;
constexpr float LOG2E = 1.4426950408889634f;
template <int TYPE>
__device__ __forceinline__ void attn_unit(LAS unsigned char* lds, const bf16* QKV, bf16* ATT, int b, int head, int qb, const float* tabsrc, float Cl2, float sinkl2, int tid) {
    const int lane = tid & 63, w = __builtin_amdgcn_readfirstlane(tid >> 6), hh = lane >> 5, l31 = lane & 31;
    int qcol, kcol, vcol, ocol;
    if (TYPE == 0) { qcol = QA + head * 64; kcol = KA + (head / 3) * 64; vcol = VA + (head / 3) * 64; ocol = OA + head * 64; }
    else if (TYPE == 1) { qcol = QB + head * 64; kcol = KB + head * 64; vcol = VB + head * 64; ocol = OB + head * 64; }
    else { qcol = QC + head * 64; kcol = KC + (head / 3) * 64; vcol = VC + (head / 3) * 64; ocol = OC + head * 64; }
    const int q0 = 256 * qb + 32 * w, qpos = q0 + l31;
    int t_begin, t_end;
    if (TYPE == 0) { t_begin = 4 * qb - 2; if (t_begin < 0) t_begin = 0; t_end = 4 * qb + 6; if (t_end > 32) t_end = 32; }
    else if (TYPE == 1) { int a = 4 * qb - 4; a = a < 0 ? 0 : (a > 24 ? 24 : a); int e = 4 * qb - 1; e = e < 0 ? 0 : (e > 24 ? 24 : e); t_begin = a; t_end = e + 8; }
    else { t_begin = 0; t_end = 32; }
    LAS float* tab = (LAS float*)(lds + AT_TAB);
    if (TYPE == 0) { for (int i = tid; i < 1024; i += NTHREADS) { const int rel = i - 448; tab[i] = (rel >= -128 && rel <= 128) ? tabsrc[head * 257 + rel + 128] * LOG2E - Cl2 : -1e30f; } }
    if (TYPE == 1) { for (int i = tid; i < 15 * 31; i += NTHREADS) tab[i] = tabsrc[head * 465 + i] * LOG2E - Cl2; }
    bf16x8 qf[4];
    {   const bf16* qp = QKV + ((size_t)b * SEQ + qpos) * DIN + qcol + 8 * hh;
#pragma unroll
        for (int s = 0; s < 4; ++s) qf[s] = *(const GAS bf16x8*)(qp + 16 * s); }
    const int srow = tid >> 3, sch = tid & 7;
    const bf16* kg = QKV + ((size_t)b * SEQ + srow) * DIN + kcol + sch * 8;
    const bf16* vg = QKV + ((size_t)b * SEQ + srow) * DIN + vcol + sch * 8;
    const int kst = srow * 128 + ((sch ^ ((srow >> 1) & 7)) * 16);
    const int vst = srow * 128 + (((sch >> 2) ^ ((srow >> 1) & 1)) * 64) + (sch & 3) * 16;
    int kread[4], vread[2];
#pragma unroll
    for (int s = 0; s < 4; ++s) kread[s] = l31 * 128 + (((2 * s + hh) ^ ((lane >> 1) & 7)) * 16);
#pragma unroll
    for (int db = 0; db < 2; ++db) vread[db] = (4 * hh + ((lane >> 2) & 3)) * 128 + ((db ^ ((lane >> 3) & 1)) * 64) + 32 * ((lane >> 4) & 1) + 8 * (lane & 3);
    f32x16 O0, O1;
#pragma unroll
    for (int r = 0; r < 16; ++r) { O0[r] = 0.f; O1[r] = 0.f; }
    float lsum = 0.f;
    const int rw = 4 * qb + (w >> 1), cq = 32 * (w & 1) + l31;
    int r0w = rw - 4; r0w = r0w < 0 ? 0 : (r0w > 24 ? 24 : r0w);
    int c0 = cq - 8; c0 = c0 < 0 ? 0 : (c0 > 48 ? 48 : c0);
    {   const v4u kr = *(const GAS v4u*)(kg + (size_t)t_begin * 64 * DIN), vr = *(const GAS v4u*)(vg + (size_t)t_begin * 64 * DIN);
        *(LAS v4u*)(lds + AT_K0 + kst) = kr; *(LAS v4u*)(lds + AT_V0 + vst) = vr; }
    __syncthreads();
    for (int t = t_begin; t < t_end; ++t) {
        const int cur = (t - t_begin) & 1;
        v4u kr, vr;
        if (t + 1 < t_end) { kr = *(const GAS v4u*)(kg + (size_t)(t + 1) * 64 * DIN); vr = *(const GAS v4u*)(vg + (size_t)(t + 1) * 64 * DIN); }
        bool need = true;
        if (TYPE == 0) need = (64 * t <= q0 + 31 + 128) && (64 * t + 63 >= q0 - 128);
        if (TYPE == 1) need = (t >= r0w) && (t < r0w + 8);
        if (need) {
            const lds_cptr kb_ = (lds_cptr)(lds + AT_K0 + cur * 8192), vb_ = (lds_cptr)(lds + AT_V0 + cur * 8192);
            bf16x8 kf[8];
#pragma unroll
            for (int s = 0; s < 4; ++s) { kf[2 * s] = *(const LAS bf16x8*)(kb_ + kread[s]); kf[2 * s + 1] = *(const LAS bf16x8*)(kb_ + kread[s] + 4096); }
            f32x16 S0, S1;
            if (TYPE == 2) {
#pragma unroll
                for (int r = 0; r < 16; ++r) { S0[r] = -Cl2; S1[r] = -Cl2; }
            } else if (TYPE == 0) {
                const LAS float* tb = tab + (64 * t - qpos + 448 + 4 * hh);
#pragma unroll
                for (int r = 0; r < 16; ++r) { S0[r] = tb[8 * (r >> 2) + (r & 3)]; S1[r] = tb[32 + 8 * (r >> 2) + (r & 3)]; }
            } else {
                const LAS float* tb = tab + ((t - rw + 7) * 31 - cq + 15 + 4 * hh);
                const int kc0 = 4 * hh - c0;
#pragma unroll
                for (int r = 0; r < 16; ++r) { const int ka = 8 * (r >> 2) + (r & 3), kb2 = 32 + ka;
                    S0[r] = ((unsigned)(ka + kc0) < 16u) ? tb[ka] : -1e30f; S1[r] = ((unsigned)(kb2 + kc0) < 16u) ? tb[kb2] : -1e30f; }
            }
            __builtin_amdgcn_sched_barrier(0);
#pragma unroll
            for (int s = 0; s < 4; ++s) { S0 = __builtin_amdgcn_mfma_f32_32x32x16_bf16(kf[2 * s], qf[s], S0, 0, 0, 0); S1 = __builtin_amdgcn_mfma_f32_32x32x16_bf16(kf[2 * s + 1], qf[s], S1, 0, 0, 0); }
            s16x4 vf[4][2][2];
#pragma unroll
            for (int ks = 0; ks < 2; ++ks)
#pragma unroll
                for (int db = 0; db < 2; ++db) { vf[ks][db][0] = vtr(vb_ + vread[db] + (16 * ks) * 128); vf[ks][db][1] = vtr(vb_ + vread[db] + (16 * ks + 8) * 128); }
            __builtin_amdgcn_sched_barrier(0);
#pragma unroll
            for (int r = 0; r < 16; ++r) { S0[r] = __builtin_amdgcn_exp2f(S0[r]); S1[r] = __builtin_amdgcn_exp2f(S1[r]); }
#pragma unroll
            for (int r = 0; r < 16; ++r) lsum += S0[r] + S1[r];
            bf16x8 pb[4];
#pragma unroll
            for (int hf = 0; hf < 2; ++hf) {
                v4u a, c;
#pragma unroll
                for (int j = 0; j < 4; ++j) { a[j] = cvtpk(S0[8 * hf + 2 * j], S0[8 * hf + 2 * j + 1]); c[j] = cvtpk(S1[8 * hf + 2 * j], S1[8 * hf + 2 * j + 1]); }
                pb[hf] = __builtin_bit_cast(bf16x8, a); pb[2 + hf] = __builtin_bit_cast(bf16x8, c);
            }
#pragma unroll
            for (int ks = 2; ks < 4; ++ks)
#pragma unroll
                for (int db = 0; db < 2; ++db) { vf[ks][db][0] = vtr(vb_ + vread[db] + (16 * ks) * 128); vf[ks][db][1] = vtr(vb_ + vread[db] + (16 * ks + 8) * 128); }
            __builtin_amdgcn_sched_barrier(0);
#pragma unroll
            for (int ks = 0; ks < 4; ++ks) {
                const bf16x8 va = __builtin_shufflevector(vf[ks][0][0], vf[ks][0][1], 0, 1, 2, 3, 4, 5, 6, 7), vb2 = __builtin_shufflevector(vf[ks][1][0], vf[ks][1][1], 0, 1, 2, 3, 4, 5, 6, 7);
                O0 = __builtin_amdgcn_mfma_f32_32x32x16_bf16(va, pb[ks], O0, 0, 0, 0); O1 = __builtin_amdgcn_mfma_f32_32x32x16_bf16(vb2, pb[ks], O1, 0, 0, 0);
            }
        }
        __builtin_amdgcn_sched_barrier(0);
        if (t + 1 < t_end) { *(LAS v4u*)(lds + AT_K0 + (cur ^ 1) * 8192 + kst) = kr; *(LAS v4u*)(lds + AT_V0 + (cur ^ 1) * 8192 + vst) = vr; }
        __syncthreads();
    }
    lsum += shx(lsum, 32, lane);
    if (TYPE == 0) lsum += __builtin_amdgcn_exp2f(sinkl2 - Cl2);
    const float inv = 1.f / lsum;
    bf16* op = ATT + ((size_t)b * SEQ + qpos) * DM + ocol + 4 * hh;
#pragma unroll
    for (int g4 = 0; g4 < 4; ++g4) {
        v2u o0, o1; o0.x = cvtpk(O0[4 * g4] * inv, O0[4 * g4 + 1] * inv); o0.y = cvtpk(O0[4 * g4 + 2] * inv, O0[4 * g4 + 3] * inv);
        o1.x = cvtpk(O1[4 * g4] * inv, O1[4 * g4 + 1] * inv); o1.y = cvtpk(O1[4 * g4 + 2] * inv, O1[4 * g4 + 3] * inv);
        *(GAS v2u*)(op + 8 * g4) = o0; *(GAS v2u*)(op + 32 + 8 * g4) = o1;
    }
}


constexpr int MA_K0 = 0, MA_V0 = 32768;
__device__ __forceinline__ void mem_unit(LAS unsigned char* lds, const bf16* QM, const bf16* KVM, bf16* OM, const float* gq, int tb, int head, float Cl2, int tid) {
    const int lane = tid & 63, w = __builtin_amdgcn_readfirstlane(tid >> 6), hh = lane >> 5, l31 = lane & 31;
    const size_t trow = (size_t)tb * 256 + 32 * w + l31; const int b = tb >> 3;
    bf16x8 qf[8];
    {   const bf16* qp = QM + trow * MEMW + head * 128 + 8 * hh;
#pragma unroll
        for (int s = 0; s < 8; ++s) qf[s] = *(const GAS bf16x8*)(qp + 16 * s);
        float ss = 0.f;
#pragma unroll
        for (int s = 0; s < 8; ++s)
#pragma unroll
            for (int j = 0; j < 8; ++j) { const float f = __builtin_bit_cast(float, (unsigned)(unsigned short)qf[s][j] << 16); ss += f * f; }
        ss += shx(ss, 32, lane);
        const float r = 0.12751743074602468f / sqrtf(ss * (1.f / 128.f) + EPS);
#pragma unroll
        for (int s = 0; s < 8; ++s) { const f32x4 g0 = *(const GAS f32x4*)(gq + 16 * s + 8 * hh), g1 = *(const GAS f32x4*)(gq + 16 * s + 8 * hh + 4);
            v4u o;
#pragma unroll
            for (int j = 0; j < 4; ++j) { const float f0 = __builtin_bit_cast(float, (unsigned)(unsigned short)qf[s][2 * j] << 16), f1 = __builtin_bit_cast(float, (unsigned)(unsigned short)qf[s][2 * j + 1] << 16);
                const float ga = (2 * j < 4) ? g0[2 * j] : g1[2 * j - 4], gb2 = (2 * j + 1 < 4) ? g0[2 * j + 1] : g1[2 * j + 1 - 4];
                o[j] = cvtpk(f0 * r * ga, f1 * r * gb2); }
            qf[s] = __builtin_bit_cast(bf16x8, o); }
    }
    const int srow = tid >> 3, sch = tid & 7;
    const bf16* kg = KVM + ((size_t)b * NMEM + srow) * 1024 + head * 128 + sch * 8;
    const bf16* vg = kg + 512;
    const int kst0 = srow * 256 + ((sch ^ (srow & 15)) * 16), kst1 = srow * 256 + (((sch + 8) ^ (srow & 15)) * 16);
    const int vst0 = srow * 256 + ((((sch) >> 2) ^ (srow & 3)) * 64) + (sch & 3) * 16, vst1 = srow * 256 + ((((sch + 8) >> 2) ^ (srow & 3)) * 64) + (sch & 3) * 16;
    int kread[8], vread[4];
#pragma unroll
    for (int s = 0; s < 8; ++s) kread[s] = l31 * 256 + (((2 * s + hh) ^ (l31 & 15)) * 16);
#pragma unroll
    for (int db = 0; db < 4; ++db) vread[db] = (4 * hh + ((lane >> 2) & 3)) * 256 + ((db ^ ((lane >> 2) & 3)) * 64) + 32 * ((lane >> 4) & 1) + 8 * (lane & 3);
    f32x16 O[4];
#pragma unroll
    for (int db = 0; db < 4; ++db)
#pragma unroll
        for (int r = 0; r < 16; ++r) O[db][r] = 0.f;
    float lsum = 0.f;
    {   const v4u k0 = *(const GAS v4u*)kg, k1 = *(const GAS v4u*)(kg + 64), v0 = *(const GAS v4u*)vg, v1 = *(const GAS v4u*)(vg + 64);
        *(LAS v4u*)(lds + MA_K0 + kst0) = k0; *(LAS v4u*)(lds + MA_K0 + kst1) = k1; *(LAS v4u*)(lds + MA_V0 + vst0) = v0; *(LAS v4u*)(lds + MA_V0 + vst1) = v1; }
    __syncthreads();
#pragma unroll 1
    for (int t = 0; t < 4; ++t) {
        const int cur = t & 1;
        v4u k0, k1, v0, v1;
        if (t + 1 < 4) { const bf16* kn = kg + (size_t)(t + 1) * 64 * 1024; k0 = *(const GAS v4u*)kn; k1 = *(const GAS v4u*)(kn + 64); v0 = *(const GAS v4u*)(kn + 512); v1 = *(const GAS v4u*)(kn + 576); }
        const lds_cptr kb_ = (lds_cptr)(lds + MA_K0 + cur * 16384), vb_ = (lds_cptr)(lds + MA_V0 + cur * 16384);
        f32x16 S0, S1;
#pragma unroll
        for (int r = 0; r < 16; ++r) { S0[r] = -Cl2; S1[r] = -Cl2; }
#pragma unroll
        for (int s = 0; s < 8; ++s) { const bf16x8 a0 = *(const LAS bf16x8*)(kb_ + kread[s]), a1 = *(const LAS bf16x8*)(kb_ + kread[s] + 8192);
            S0 = __builtin_amdgcn_mfma_f32_32x32x16_bf16(a0, qf[s], S0, 0, 0, 0); S1 = __builtin_amdgcn_mfma_f32_32x32x16_bf16(a1, qf[s], S1, 0, 0, 0); }
#pragma unroll
        for (int r = 0; r < 16; ++r) { S0[r] = __builtin_amdgcn_exp2f(S0[r]); S1[r] = __builtin_amdgcn_exp2f(S1[r]); lsum += S0[r] + S1[r]; }
        bf16x8 pb[4];
#pragma unroll
        for (int hf = 0; hf < 2; ++hf) {
            v4u a, c;
#pragma unroll
            for (int j = 0; j < 4; ++j) { a[j] = cvtpk(S0[8 * hf + 2 * j], S0[8 * hf + 2 * j + 1]); c[j] = cvtpk(S1[8 * hf + 2 * j], S1[8 * hf + 2 * j + 1]); }
            pb[hf] = __builtin_bit_cast(bf16x8, a); pb[2 + hf] = __builtin_bit_cast(bf16x8, c);
        }
#pragma unroll
        for (int ks = 0; ks < 4; ++ks)
#pragma unroll
            for (int db = 0; db < 4; ++db) {
                const s16x4 a0 = vtr(vb_ + vread[db] + (16 * ks) * 256), a1 = vtr(vb_ + vread[db] + (16 * ks + 8) * 256);
                const bf16x8 va = __builtin_shufflevector(a0, a1, 0, 1, 2, 3, 4, 5, 6, 7);
                O[db] = __builtin_amdgcn_mfma_f32_32x32x16_bf16(va, pb[ks], O[db], 0, 0, 0);
            }
        if (t + 1 < 4) { LAS unsigned char* kn = lds + MA_K0 + (cur ^ 1) * 16384; LAS unsigned char* vn = lds + MA_V0 + (cur ^ 1) * 16384;
            *(LAS v4u*)(kn + kst0) = k0; *(LAS v4u*)(kn + kst1) = k1; *(LAS v4u*)(vn + vst0) = v0; *(LAS v4u*)(vn + vst1) = v1; }
        __syncthreads();
    }
    lsum += shx(lsum, 32, lane);
    const float inv = 1.f / lsum;
    bf16* op = OM + trow * MEMW + head * 128 + 4 * hh;
#pragma unroll
    for (int db = 0; db < 4; ++db)
#pragma unroll
        for (int g4 = 0; g4 < 4; ++g4) { v2u o; o.x = cvtpk(O[db][4 * g4] * inv, O[db][4 * g4 + 1] * inv); o.y = cvtpk(O[db][4 * g4 + 2] * inv, O[db][4 * g4 + 3] * inv); *(GAS v2u*)(op + 32 * db + 8 * g4) = o; }
}

__device__ __forceinline__ float wave_max(float v, int lane) {
#pragma unroll
    for (int o = 1; o < 64; o <<= 1) v = fmaxf(v, shx(v, o, lane));
    return v;
}
struct Args { const float* in[23]; float* out; unsigned char* ws; int ph_lo, ph_hi, use_bar, pad; };
#ifndef MK_OFF
#define MK_OFF 0u
#endif
#ifndef REP_ATT
#define REP_ATT 1
#endif
#ifndef REP_P0
#define REP_P0 1
#endif
#ifndef REP_GEMM
#define REP_GEMM 1
#endif
#ifndef REP_NORM
#define REP_NORM 1
#endif
#ifndef REP_SEL
#define REP_SEL 1
#endif
#ifndef REP_MEM
#define REP_MEM 1
#endif
#define PHON(k) (!((MK_OFF >> (k)) & 1u))
constexpr int PH_PER_LAYER = 10, PH_BASE = 3, N_PHASES = PH_BASE + DEPTH * PH_PER_LAYER;
constexpr int PTAB_OFF = LDSCTL_OFF + 1024;

__global__ void __launch_bounds__(NTHREADS, 2) mega(Args a) {
    extern __shared__ __attribute__((aligned(16))) unsigned char lds_raw[];
    LAS unsigned char* lds = (LAS unsigned char*)lds_raw;
    {   const int tid0 = threadIdx.x;
        for (int u = tid0; u < (LDS_BYTES - LDSCTL_OFF) / 4; u += NTHREADS) ((LAS unsigned*)(lds + LDSCTL_OFF))[u] = 0u;
        __syncthreads();
        if (tid0 < 23) ((LAS unsigned long long*)(lds + PTAB_OFF))[tid0] = (unsigned long long)a.in[tid0];
        if (tid0 == 23) ((LAS unsigned long long*)(lds + PTAB_OFF))[23] = (unsigned long long)a.out;
        if (tid0 == 24) ((LAS unsigned long long*)(lds + PTAB_OFF))[24] = (unsigned long long)a.ws;
        __syncthreads();
    }
    volatile LAS unsigned* MISC = (volatile LAS unsigned*)(lds + MISC_OFF);
    const int G = gridDim.x, bid = blockIdx.x, NGW = G * NWAVES;
    const int use_bar = a.use_bar;
    XcdBarrier bar; bar.bar = (unsigned*)(a.ws + WS_CTL) + CW_BAR; bar.x = 0; bar.st = MISC + 8;
    if (use_bar) bar = xcd_barrier_post((unsigned*)(a.ws + WS_CTL) + CW_BAR, MISC + 8);
    const int lo = a.ph_lo, hi = a.ph_hi;
#define IN(k) (lo <= (k) && (k) < hi)
#define SEAM(k) do { if (use_bar && IN(k) && IN((k) + 1)) xcd_barrier(bar); } while (0)
#define PHL() int tid_ = threadIdx.x; asm volatile("" : "+v"(tid_)); const int lane_ = tid_ & 63, wave_ = __builtin_amdgcn_readfirstlane(tid_ >> 6), gw_ = bid * NWAVES + wave_; (void)lane_; (void)gw_; \
              int pz_ = 0; asm volatile("" : "+s"(pz_))
#define PTR(i) ((const float*)ldptr(lds, (i) + pz_))
#define WSP() ((unsigned char*)ldptr(lds, 24 + pz_))
#define OUTP() ((float*)ldptr(lds, 23 + pz_))

    if (IN(0) && PHON(0)) for (int rep_ = 0; rep_ < REP_P0; ++rep_) {
        PHL(); unsigned char* ws = WSP();
        LAS float* scr = (LAS float*)(lds + RING_OFF + wave_ * 16384);
        constexpr int I_IN = 32 * 128, I_OUT = 32 * 64, I_MQ = 32 * 16, I_MKV = 32 * 32, I_MO = 8 * 64, I_PQ = 32 * 64, I_L = I_IN + I_OUT + I_MQ + I_MKV + I_MO + I_PQ;
        for (int it = gw_; it < DEPTH * I_L; it += NGW) {
            const int l = it / I_L; int r = it % I_L;
            if (r < I_IN) { transpose_item<true>(PTR(4) + (size_t)l * DM * DIN, DM, DIN, (bf16*)(ws + WS_WIN) + (size_t)l * DIN * DM, scr, r, lane_, PTR(3) + (size_t)l * DM); continue; } r -= I_IN;
            if (r < I_OUT) { transpose_item<false>(PTR(11) + (size_t)l * DM * DM, DM, DM, (bf16*)(ws + WS_WOUT) + (size_t)l * DM * DM, scr, r, lane_); continue; } r -= I_OUT;
            if (r < I_MQ) { transpose_item<false>(PTR(14) + (size_t)l * DM * MEMW, DM, MEMW, (bf16*)(ws + WS_WMQ) + (size_t)l * MEMW * DM, scr, r, lane_, PTR(12) + (size_t)l * DM); continue; } r -= I_MQ;
            if (r < I_MKV) { transpose_item<false>(PTR(15) + (size_t)l * DM * 1024, DM, 1024, (bf16*)(ws + WS_WMKV) + (size_t)l * 1024 * DM, scr, r, lane_); continue; } r -= I_MKV;
            if (r < I_MO) { transpose_item<false>(PTR(17) + (size_t)l * MEMW * DM, MEMW, DM, (bf16*)(ws + WS_WMO) + (size_t)l * DM * MEMW, scr, r, lane_); continue; } r -= I_MO;
            transpose_item<false>(PTR(19) + (size_t)l * DM * DM, DM, DM, (bf16*)(ws + WS_WPQ) + (size_t)l * DM * DM, scr, r, lane_, PTR(18) + (size_t)l * DM);
        }
        const size_t gtid = (size_t)bid * NTHREADS + tid_, nth = (size_t)G * NTHREADS;
        convert_bf16(PTR(20), (bf16*)(ws + WS_PKEYS), (size_t)DEPTH * 8 * 2 * 128 * 128, gtid, nth);
        convert_fp6_rows(PTR(21), ws + WS_PU, DEPTH * PEER_N, PU_SCALE6, PTR(18), gw_, NGW, lane_);
        convert_fp4_rows(PTR(22), ws + WS_PV, DEPTH * PEER_N, PV_SCALE4, gw_, NGW, lane_);
        {   const float* x0 = PTR(0); bf16* XN = (bf16*)(ws + WS_XN); u64_t* rsq = (u64_t*)(ws + WS_ROWSQ);
            for (int m = gw_; m < T; m += NGW) prep_row(x0 + (size_t)m * DM, XN + (size_t)m * DM, rsq + m, lane_); }
        {   const float* mem = PTR(1); const float* gkv = PTR(13); bf16* MEMN = (bf16*)(ws + WS_MEMN);
            for (int m = gw_; m < BATCH * NMEM; m += NGW)
                rms_row_to_bf16(mem + (size_t)m * DM, gkv, MEMN + (size_t)m * DM, gkv + DM, MEMN + (size_t)(BATCH * NMEM + m) * DM, lane_); }
        float* rope = (float*)(ws + WS_ROPE); float* biasA = (float*)(ws + WS_BIASA);
        if (gtid < 64 * 16) { const int pos = (int)gtid >> 4, i = (int)gtid & 15; const float ang = (float)pos * ROPE_INV[i]; rope[gtid * 2] = cosf(ang); rope[gtid * 2 + 1] = sinf(ang); }
        if (gtid < 12 * 257) { const int h = (int)gtid / 257, rel = (int)gtid % 257 - 128; biasA[gtid] = PTR(2)[t5_bucket(rel) * 12 + h]; }
    }
    SEAM(0);
    if (IN(1) && PHON(1)) {
#pragma unroll 1
        for (int l = 0; l < DEPTH; ++l) {
            PHL(); unsigned char* ws = WSP();
            pg8::Gemm g{(bf16*)(ws + WS_MEMN) + (size_t)l * BATCH * NMEM * DM, (bf16*)(ws + WS_WMKV) + (size_t)l * 1024 * DM, BATCH * NMEM, 1024, DM};
            OffsetOrder S; S.init(BATCH * NMEM, 1024, G, bid, 64 * l);
            pg8::EpiBf16<0> E{(bf16*)(ws + WS_KVM) + (size_t)l * BATCH * NMEM * 1024, 1024, nullptr, 0, 0, 1.f};
            pg8::gemm_phase<pg8::EpiBf16<0>, OffsetOrder, true, true>(lds + RING_OFF, g, S, E, tid_);
            __syncthreads();
        }
    }
    SEAM(1);
    if (IN(2) && PHON(2)) {
        PHL(); unsigned char* ws = WSP(); bf16* KVM = (bf16*)(ws + WS_KVM); const float* gm = PTR(16);
        for (int m = gw_; m < DEPTH * BATCH * NMEM; m += NGW) {
            const int l = m / (BATCH * NMEM);
            GAS v4u* p = (GAS v4u*)(KVM + (size_t)m * 1024 + 8 * lane_);
            const v4u w = *p;
            float f[8] = {bflo(w.x), bfhi(w.x), bflo(w.y), bfhi(w.y), bflo(w.z), bfhi(w.z), bflo(w.w), bfhi(w.w)};
            float ss = 0.f;
#pragma unroll
            for (int i = 0; i < 8; ++i) ss += f[i] * f[i];
            ss += shx(ss, 1, lane_); ss += shx(ss, 2, lane_); ss += shx(ss, 4, lane_); ss += shx(ss, 8, lane_);
            const float r = 1.f / sqrtf(ss * (1.f / 128.f) + EPS);
            const float* gk = gm + (size_t)l * 256 + 128 + 8 * (lane_ & 15);
            v4u o; o.x = pk2(f[0] * r * gk[0], f[1] * r * gk[1]); o.y = pk2(f[2] * r * gk[2], f[3] * r * gk[3]); o.z = pk2(f[4] * r * gk[4], f[5] * r * gk[5]); o.w = pk2(f[6] * r * gk[6], f[7] * r * gk[7]);
            *p = o;
        }
    }
    SEAM(2);

#pragma unroll 1
    for (int l = 0; l < DEPTH; ++l) {
        const int pb = PH_BASE + PH_PER_LAYER * l;
        if (IN(pb + 0) && PHON(3)) for (int rep_ = 0; rep_ < REP_GEMM; ++rep_) { PHL(); unsigned char* ws = WSP();
            pg8::Gemm g{(bf16*)(ws + WS_XN), (bf16*)(ws + WS_WIN) + (size_t)l * DIN * DM, T, DIN, DM}; pg8::StaticOrder S; S.init(T, DIN, G, bid);
            pg8::EpiQKV E{(bf16*)(ws + WS_QKV), PTR(5) + (size_t)l * 128, PTR(7) + (size_t)l * 128, PTR(9) + (size_t)l * 128, (const float*)(ws + WS_ROPE), (const u64_t*)(ws + WS_ROWSQ) + (size_t)(l * 3 + 0) * T};
            pg8::gemm_phase<pg8::EpiQKV, pg8::StaticOrder, true, true>(lds + RING_OFF, g, S, E, tid_);
        }
        SEAM(pb + 0);
        if (IN(pb + 1) && PHON(4)) for (int rep_ = 0; rep_ < REP_ATT; ++rep_) { PHL(); unsigned char* ws = WSP();
            const float* sink = PTR(6) + (size_t)l * 12; const float* rpb = PTR(8) + (size_t)l * 8 * 15 * 31; const float* biasA = (const float*)(ws + WS_BIASA);
            const bf16* QKV = (const bf16*)(ws + WS_QKV); bf16* ATT = (bf16*)(ws + WS_ATT);
            const float* ga = PTR(5) + (size_t)l * 128; const float* gb = PTR(7) + (size_t)l * 128; const float* gc = PTR(9) + (size_t)l * 128;
            const float CaL2 = 8.f * wave_max(fabsf(ga[lane_]), lane_) * wave_max(fabsf(ga[64 + lane_]), lane_) * LOG2E;
            const float CbL2 = 8.f * wave_max(fabsf(gb[lane_]), lane_) * wave_max(fabsf(gb[64 + lane_]), lane_) * LOG2E;
            const float CcL2 = 8.f * wave_max(fabsf(gc[lane_]), lane_) * wave_max(fabsf(gc[64 + lane_]), lane_) * LOG2E;
            const int vc = (G % 8 == 0) ? (bid % 8) * (G / 8) + bid / 8 : bid;
            for (int u = vc; u < BATCH * 12 * 8; u += G) attn_unit<2>(lds, QKV, ATT, u / 96, (u >> 3) % 12, u & 7, nullptr, CcL2, 0.f, tid_);
            for (int u = vc; u < BATCH * 8 * 8; u += G) attn_unit<1>(lds, QKV, ATT, u >> 6, (u >> 3) & 7, u & 7, rpb, CbL2, 0.f, tid_);
            for (int u = vc; u < BATCH * 12 * 8; u += G) { const int head = (u >> 3) % 12; attn_unit<0>(lds, QKV, ATT, u / 96, head, u & 7, biasA, CaL2, sink[head] * LOG2E, tid_); }
        }
        SEAM(pb + 1);
        if (IN(pb + 2) && PHON(5)) { PHL(); unsigned char* ws = WSP(); mixnorm_rows((bf16*)(ws + WS_ATT), PTR(10) + (size_t)l * DM, gw_, NGW, lane_); }
        SEAM(pb + 2);
        if (IN(pb + 3) && PHON(6)) { PHL(); unsigned char* ws = WSP();
            pg8::Gemm g{(bf16*)(ws + WS_ATT), (bf16*)(ws + WS_WOUT) + (size_t)l * DM * DM, T, DM, DM}; pg8::StaticOrder S; S.init(T, DM, G, bid);
            pg8::EpiResid E{(bf16*)(ws + WS_XN), DM, (u64_t*)(ws + WS_ROWSQ) + (size_t)(l * 3 + 1) * T};
            pg8::gemm_phase<pg8::EpiResid, pg8::StaticOrder, true, true>(lds + RING_OFF, g, S, E, tid_);
        }
        SEAM(pb + 3);
        if (IN(pb + 4) && PHON(7)) for (int rep_ = 0; rep_ < REP_GEMM; ++rep_) { PHL(); unsigned char* ws = WSP();
            pg8::Gemm g{(bf16*)(ws + WS_XN), (bf16*)(ws + WS_WMQ) + (size_t)l * MEMW * DM, T, MEMW, DM}; pg8::StaticOrder S; S.init(T, MEMW, G, bid);
            pg8::EpiBf16Row E{(bf16*)(ws + WS_QM), MEMW, (const u64_t*)(ws + WS_ROWSQ) + (size_t)(l * 3 + 1) * T};
            pg8::gemm_phase<pg8::EpiBf16Row, pg8::StaticOrder, true, true>(lds + RING_OFF, g, S, E, tid_);
        }
        SEAM(pb + 4);
        if (IN(pb + 5) && PHON(8)) for (int rep_ = 0; rep_ < REP_MEM; ++rep_) { PHL(); unsigned char* ws = WSP();
            const bf16* kvm = (const bf16*)(ws + WS_KVM) + (size_t)l * BATCH * NMEM * 1024; const float* gq = PTR(16) + (size_t)l * 256;
            const float CmL2 = 11.313708498984761f * wave_max(fmaxf(fabsf(gq[lane_]), fabsf(gq[64 + lane_])), lane_) * wave_max(fmaxf(fabsf(gq[128 + lane_]), fabsf(gq[192 + lane_])), lane_) * LOG2E;
            for (int u = bid; u < (T / 256) * 4; u += G) mem_unit(lds, (const bf16*)(ws + WS_QM), kvm, (bf16*)(ws + WS_OM), gq, u >> 2, u & 3, CmL2, tid_);
        }
        SEAM(pb + 5);
        if (IN(pb + 6) && PHON(9)) { PHL(); unsigned char* ws = WSP();
            pg8::Gemm g{(bf16*)(ws + WS_OM), (bf16*)(ws + WS_WMO) + (size_t)l * DM * MEMW, T, DM, MEMW}; pg8::StaticOrder S; S.init(T, DM, G, bid);
            pg8::EpiResid E{(bf16*)(ws + WS_XN), DM, (u64_t*)(ws + WS_ROWSQ) + (size_t)(l * 3 + 2) * T};
            pg8::gemm_phase<pg8::EpiResid, pg8::StaticOrder, true, true>(lds + RING_OFF, g, S, E, tid_);
        }
        SEAM(pb + 6);
        if (IN(pb + 7) && PHON(10)) for (int rep_ = 0; rep_ < REP_GEMM; ++rep_) { PHL(); unsigned char* ws = WSP();
            pg8::Gemm g{(bf16*)(ws + WS_XN), (bf16*)(ws + WS_WPQ) + (size_t)l * DM * DM, T, DM, DM}; pg8::StaticOrder S; S.init(T, DM, G, bid);
            pg8::EpiBf16Row E{(bf16*)(ws + WS_QP), DM, (const u64_t*)(ws + WS_ROWSQ) + (size_t)(l * 3 + 2) * T};
            pg8::gemm_phase<pg8::EpiBf16Row, pg8::StaticOrder, true, true>(lds + RING_OFF, g, S, E, tid_);
        }
        SEAM(pb + 7);
        if (IN(pb + 8) && PHON(11)) for (int rep_ = 0; rep_ < REP_SEL; ++rep_) { PHL(); unsigned char* ws = WSP();
            const bf16* pk = (const bf16*)(ws + WS_PKEYS) + (size_t)l * 8 * 2 * 128 * 128;
            for (int u = bid; u < (T / 256) * PEER_H; u += G) peer_select_unit((const bf16*)(ws + WS_QP), pk, (int*)(ws + WS_PIDX), (float*)(ws + WS_PGATE), u >> 3, u & 7, wave_, lane_);
        }
        SEAM(pb + 8);
        if (IN(pb + 9) && PHON(12)) { PHL(); unsigned char* ws = WSP();
            peer_gather6((bf16*)(ws + WS_XN), ws + WS_PU + (size_t)l * PEER_N * 1536, ws + WS_PV + (size_t)l * PEER_N * 1024, (const int*)(ws + WS_PIDX), (const float*)(ws + WS_PGATE), (l + 1 == DEPTH) ? OUTP() : (float*)nullptr,
                         (const u64_t*)(ws + WS_ROWSQ) + (size_t)(l * 3 + 2) * T, (l + 1 < DEPTH) ? (u64_t*)(ws + WS_ROWSQ) + (size_t)((l + 1) * 3 + 0) * T : (u64_t*)nullptr,
                         (LAS float*)(lds + RING_OFF + wave_ * 1024), gw_, NGW, lane_); }
        SEAM(pb + 9);
    }
#undef IN
#undef SEAM
}

#ifndef MK_MULTI_LAUNCH
#define MK_MULTI_LAUNCH 0
#endif
extern "C" void kernel_launch(void* const* d_in, const int* in_sizes, int n_in, void* d_out, int out_size, void* d_ws, size_t ws_size, hipStream_t stream) {
    static int grid = 0;
    if (grid == 0) {
        if (n_in != 23 || out_size != T * DM || ws_size < WS_END) { fprintf(stderr, "kernel_launch: unexpected shapes (n_in %d, out %d, ws %zu)\n", n_in, out_size, ws_size); grid = -1; return; }
        int dev = 0, cus = 0, per_cu = 0;
        if (hipGetDevice(&dev) != hipSuccess || hipDeviceGetAttribute(&cus, hipDeviceAttributeMultiprocessorCount, dev) != hipSuccess) { grid = -1; return; }
        if (hipFuncSetAttribute((const void*)mega, hipFuncAttributeMaxDynamicSharedMemorySize, LDS_BYTES) != hipSuccess) { fprintf(stderr, "kernel_launch: hipFuncSetAttribute failed\n"); grid = -1; return; }
        if (hipOccupancyMaxActiveBlocksPerMultiprocessor(&per_cu, (const void*)mega, NTHREADS, LDS_BYTES) != hipSuccess || per_cu < 1) { fprintf(stderr, "kernel_launch: occupancy query says %d\n", per_cu); }
        (void)hipGetLastError();
        grid = cus;
    }
    if (grid < 0) return;
    (void)hipMemsetAsync((char*)d_ws + WS_CTL, 0, CTL_ZERO_BYTES, stream);
    Args a{};
    for (int i = 0; i < 23; ++i) a.in[i] = (const float*)d_in[i];
    a.out = (float*)d_out; a.ws = (unsigned char*)d_ws;
#if MK_MULTI_LAUNCH
    for (int p = 0; p < N_PHASES; ++p) { a.ph_lo = p; a.ph_hi = p + 1; a.use_bar = 0; a.pad = 0; hipLaunchKernelGGL(mega, dim3(grid), dim3(NTHREADS), LDS_BYTES, stream, a); }
#else
    a.ph_lo = 0; a.ph_hi = N_PHASES; a.use_bar = 1; a.pad = 0;
    hipLaunchKernelGGL(mega, dim3(grid), dim3(NTHREADS), LDS_BYTES, stream, a);
#endif
    const hipError_t le = hipPeekAtLastError();
    if (le != hipSuccess) fprintf(stderr, "kernel_launch: launch failed: %s\n", hipGetErrorName(le));
}
```

```cpp
#include <hip/hip_runtime.h>
#include <cstdio>
#include <cstdint>
#include <cmath>
__device__ __forceinline__ float shx(float v, int k, int lane);
typedef unsigned long long u64_t;
__device__ __forceinline__ float rowsq_rs(const u64_t* rowsq, int row) { return 1.0f / sqrtf((float)rowsq[row] * (5.9604644775390625e-08f / 2048.0f) + 1e-6f); }
__device__ __forceinline__ u64_t rowsq_fx(float ss) { return (u64_t)(ss * 16777216.0f + 0.5f); }
namespace pg8 {
#define PG8_LAS __attribute__((address_space(3)))
typedef unsigned short bf16_t;
typedef short bf16x8 __attribute__((ext_vector_type(8)));
typedef float f32x4 __attribute__((ext_vector_type(4)));
typedef unsigned u32x4 __attribute__((ext_vector_type(4)));
constexpr int BM = 256, BK = 64, HALF = 128, HTB = HALF * BK * 2  , STAGE_BYTES = 8 * HTB, NXCD = 8, WGM = 8;

__host__ __device__ __forceinline__ int lds_byte(int r, int c) { const int st = (r >> 4) * 2 + (c >> 5), rr = r & 15, cc = c & 31, ob = rr * 64 + cc * 2; return st * 1024 + (ob ^ (((ob >> 9) & 1) << 5)); }
__host__ __device__ __forceinline__ void stage_rc(int b, int& R, int& C) { const int st = b / 1024, sb = b % 1024, swz = sb ^ (((sb >> 9) & 1) << 5); R = (st >> 1) * 16 + swz / 64; C = (st & 1) * 32 + (swz % 64) / 2; }
__host__ __device__ __forceinline__ int perm32(int rho) { const int n = rho >> 4, i = rho & 15; return 8 * (i >> 2) + 4 * n + (i & 3); }

struct Unit { int pm, pn; };
struct Gemm { const bf16_t* A; const bf16_t* Bt; int M, N, K; };

struct StaticOrder {
    int nM, nN, nwg, G, c;
    __host__ __device__ void init(int M, int N, int G_, int c_) { nM = M / BM; nN = N / BM; nwg = nM * nN; G = G_; c = c_; }
    __host__ __device__ bool next(int i, Unit& u) const {
        const long L = (long)i * G + c; if (L >= nwg) return false;
        int wgid = (int)L; { const int q = nwg / NXCD, r = nwg % NXCD, xcd = wgid % NXCD, off = wgid / NXCD; wgid = (xcd < r ? xcd * (q + 1) : r * (q + 1) + (xcd - r) * q) + off; }
        const int nig = WGM * nN, gid = wgid / nig, fm = gid * WGM, gsz = (nM - fm) < WGM ? (nM - fm) : WGM;
        u.pm = fm + ((wgid % nig) % gsz); u.pn = (wgid % nig) / gsz; return true;
    }
    __device__ __forceinline__ void a_ready(const Unit&) const {}
    __device__ __forceinline__ void done(const Unit&) const {}
};

__device__ __forceinline__ unsigned cvt_pk_bf16(float lo, float hi) { unsigned r; asm volatile("v_cvt_pk_bf16_f32 %0, %1, %2" : "=v"(r) : "v"(lo), "v"(hi)); return r; }
typedef float f32x2 __attribute__((ext_vector_type(2)));
__device__ __forceinline__ f32x2 gelu_pk(f32x2 v) {
    const f32x2 av = __builtin_elementwise_abs(v), d = av * 0.2316418882f + 1.0f;
    f32x2 t; t.x = __builtin_amdgcn_rcpf(d.x); t.y = __builtin_amdgcn_rcpf(d.y);
    f32x2 q = t * 0.5307027145f + (-0.7265760135f); q = q * t + 0.7107068705f; q = q * t + (-0.142248368f); q = q * t + 0.127414796f; q = q * t;
    const f32x2 s = (v * v) * (-0.72134752044f);
    f32x2 e; e.x = __builtin_amdgcn_exp2f(s.x); e.y = __builtin_amdgcn_exp2f(s.y);
    const f32x2 m = v * (q * e), r = v - m;
    f32x2 o; o.x = v.x < 0.f ? m.x : r.x; o.y = v.y < 0.f ? m.y : r.y; return o;
}

template <int ACT  > struct EpiBf16 {
    static constexpr bool PERM = true, AFTER_DRAIN = false; static_assert(ACT == 0 || ACT == 1, "EpiBf16: ACT is 0 (none) or 1 (gelu_pk)");
    bf16_t* O; int ldc; const float* bias; int split_cols; size_t split_stride; float scale0;
    __device__ __forceinline__ void operator()(const f32x4 (&acc)[2][2][4][2], const Unit& u, int wr, int wc, int fr, int fq) const {
        const int row0 = u.pm * BM + wr * 64 + fr; int colt = u.pn * BM; bf16_t* base = O;
        float sc = 1.f; if (split_cols) { const int t = colt / split_cols; base += (size_t)t * split_stride; colt -= t * split_cols; if (t == 0) sc = scale0; }
        const int col0 = colt + wc * 32 + 8 * fq, bcol0 = u.pn * BM + wc * 32 + 8 * fq;
        f32x4 bv[2][2];
#pragma unroll
        for (int bj = 0; bj < 2; ++bj)
#pragma unroll
            for (int n = 0; n < 2; ++n) bv[bj][n] = bias ? *(const f32x4*)(bias + bcol0 + bj * HALF + 4 * n) : (f32x4){0.f, 0.f, 0.f, 0.f};
#pragma unroll
        for (int ai = 0; ai < 2; ++ai)
#pragma unroll
            for (int m = 0; m < 4; ++m) { bf16_t* rowp = base + (size_t)(row0 + ai * HALF + m * 16) * ldc + col0;
#pragma unroll
                for (int bj = 0; bj < 2; ++bj) { f32x4 v0 = acc[ai][bj][m][0] + bv[bj][0], v1 = acc[ai][bj][m][1] + bv[bj][1];
                    if (ACT == 1) { f32x2 a = gelu_pk((f32x2){v0[0], v0[1]}), b = gelu_pk((f32x2){v0[2], v0[3]}), c = gelu_pk((f32x2){v1[0], v1[1]}), d = gelu_pk((f32x2){v1[2], v1[3]});
                        v0 = (f32x4){a.x, a.y, b.x, b.y}; v1 = (f32x4){c.x, c.y, d.x, d.y}; }
                    v0 = v0 * sc; v1 = v1 * sc; u32x4 w; w.x = cvt_pk_bf16(v0[0], v0[1]); w.y = cvt_pk_bf16(v0[2], v0[3]); w.z = cvt_pk_bf16(v1[0], v1[1]); w.w = cvt_pk_bf16(v1[2], v1[3]);
                    *(u32x4*)(rowp + bj * HALF) = w; } }
    }
};

typedef unsigned u32x2 __attribute__((ext_vector_type(2)));
struct EpiResid {
    static constexpr bool PERM = false, AFTER_DRAIN = false;
    bf16_t* s; int ldc; u64_t* rowsq;
    __device__ __forceinline__ void operator()(const f32x4 (&acc)[2][2][4][2], const Unit& u, int wr, int wc, int fr, int fq) const {
        const int col0 = u.pn * BM + wc * 32 + 4 * fq;
#pragma unroll
        for (int ai = 0; ai < 2; ++ai)
#pragma unroll
            for (int m = 0; m < 4; ++m) { const int row = u.pm * BM + ai * HALF + wr * 64 + m * 16 + fr; bf16_t* sp = s + (size_t)row * ldc + col0; float ss = 0.f;
                u32x2 in[2][2];
#pragma unroll
                for (int bj = 0; bj < 2; ++bj)
#pragma unroll
                    for (int n = 0; n < 2; ++n) in[bj][n] = *(const u32x2*)(sp + bj * HALF + n * 16);
#pragma unroll
                for (int bj = 0; bj < 2; ++bj)
#pragma unroll
                    for (int n = 0; n < 2; ++n) { const u32x2 w0 = in[bj][n];
                        const f32x4 bs = (f32x4){__builtin_bit_cast(float, w0.x << 16), __builtin_bit_cast(float, w0.x & 0xffff0000u), __builtin_bit_cast(float, w0.y << 16), __builtin_bit_cast(float, w0.y & 0xffff0000u)};
                        const f32x4 o = bs + acc[ai][bj][m][n]; ss += (o[0] * o[0] + o[1] * o[1]) + (o[2] * o[2] + o[3] * o[3]);
                        u32x2 w; w.x = cvt_pk_bf16(o[0], o[1]); w.y = cvt_pk_bf16(o[2], o[3]); *(u32x2*)(sp + bj * HALF + n * 16) = w; }
                ss += shx(ss, 16, fr + 16 * fq); ss += shx(ss, 32, fr + 16 * fq);
                if (fq == 0) atomicAdd(rowsq + row, rowsq_fx(ss)); }
    }
};
struct EpiBf16Row {
    static constexpr bool PERM = true, AFTER_DRAIN = false;
    bf16_t* O; int ldc; const u64_t* rowsq;
    __device__ __forceinline__ void operator()(const f32x4 (&acc)[2][2][4][2], const Unit& u, int wr, int wc, int fr, int fq) const {
        const int row0 = u.pm * BM + wr * 64 + fr, col0 = u.pn * BM + wc * 32 + 8 * fq;
#pragma unroll
        for (int ai = 0; ai < 2; ++ai)
#pragma unroll
            for (int m = 0; m < 4; ++m) { const int row = row0 + ai * HALF + m * 16; const float rs = rowsq_rs(rowsq, row); bf16_t* rowp = O + (size_t)row * ldc + col0;
#pragma unroll
                for (int bj = 0; bj < 2; ++bj) { const f32x4 v0 = acc[ai][bj][m][0] * rs, v1 = acc[ai][bj][m][1] * rs; u32x4 w; w.x = cvt_pk_bf16(v0[0], v0[1]); w.y = cvt_pk_bf16(v0[2], v0[3]); w.z = cvt_pk_bf16(v1[0], v1[1]); w.w = cvt_pk_bf16(v1[2], v1[3]);
                    *(u32x4*)(rowp + bj * HALF) = w; } }
    }
};
struct EpiQKV {
    static constexpr bool PERM = false, AFTER_DRAIN = false;
    bf16_t* O; const float* ga; const float* gb; const float* gc; const float* rope; const u64_t* rowsq;
    __device__ __forceinline__ void operator()(const f32x4 (&acc)[2][2][4][2], const Unit& u, int wr, int wc, int fr, int fq) const {
        const int hg = u.pn * 4 + wc;
        const float* g = nullptr; bool isq = false, dorope = false;
        if (hg < 12) { g = ga; isq = true; } else if (hg < 16) { g = ga + 64; } else if (hg < 20) { }
        else if (hg < 28) { g = gb; isq = true; } else if (hg < 36) { g = gb + 64; } else if (hg < 44) { }
        else if (hg < 56) { g = gc; isq = true; dorope = true; } else if (hg < 60) { g = gc + 64; dorope = true; }
        const float qs = isq ? 0.18033688011112042f : 1.0f;
#pragma unroll
        for (int ai = 0; ai < 2; ++ai)
#pragma unroll
            for (int m = 0; m < 4; ++m) {
                const int row = u.pm * BM + ai * HALF + wr * 64 + m * 16 + fr;
                f32x4 v[2][2];
                const float rsx = rowsq_rs(rowsq, row);
#pragma unroll
                for (int bj = 0; bj < 2; ++bj)
#pragma unroll
                    for (int n = 0; n < 2; ++n) v[bj][n] = acc[ai][bj][m][n] * rsx;
                if (g) {
                    float ss = 0.f;
#pragma unroll
                    for (int bj = 0; bj < 2; ++bj)
#pragma unroll
                        for (int n = 0; n < 2; ++n) { const f32x4 x = v[bj][n]; ss += (x[0] * x[0] + x[1] * x[1]) + (x[2] * x[2] + x[3] * x[3]); }
                    ss += shx(ss, 16, fr + 16 * fq); ss += shx(ss, 32, fr + 16 * fq);
                    const float r = qs / sqrtf(ss * (1.0f / 64.0f) + 1e-6f);
#pragma unroll
                    for (int bj = 0; bj < 2; ++bj)
#pragma unroll
                        for (int n = 0; n < 2; ++n) v[bj][n] = v[bj][n] * *(const f32x4*)(g + 32 * bj + 16 * n + 4 * fq) * r;
                }
                if (dorope) {
                    const int t = row & 2047, pr = t >> 6, pc = t & 63;
#pragma unroll
                    for (int bj = 0; bj < 2; ++bj) {
                        const int pos = bj ? pc : pr;
                        const float* rp = rope + (size_t)(pos * 16 + 4 * fq) * 2;
                        const f32x4 c01 = *(const f32x4*)rp, c23 = *(const f32x4*)(rp + 4);
                        const f32x4 cs = (f32x4){c01[0], c01[2], c23[0], c23[2]}, sn = (f32x4){c01[1], c01[3], c23[1], c23[3]};
                        const f32x4 x1 = v[bj][0], x2 = v[bj][1];
                        v[bj][0] = x1 * cs - x2 * sn; v[bj][1] = x1 * sn + x2 * cs;
                    }
                }
                bf16_t* rowp = O + (size_t)row * 4096 + hg * 64 + 4 * fq;
#pragma unroll
                for (int bj = 0; bj < 2; ++bj)
#pragma unroll
                    for (int n = 0; n < 2; ++n) { u32x2 w; w.x = cvt_pk_bf16(v[bj][n][0], v[bj][n][1]); w.y = cvt_pk_bf16(v[bj][n][2], v[bj][n][3]); *(u32x2*)(rowp + 32 * bj + 16 * n) = w; }
                asm volatile("" ::: "memory");
            }
    }
};
template <class Epi, class Sched, bool ALIGN_EPI = false, bool SP2 = false>
__device__ __forceinline__ void gemm_phase(PG8_LAS unsigned char* lds, const Gemm g, const Sched& S, const Epi& E, const int tid) {
    const int wid = __builtin_amdgcn_readfirstlane(tid >> 6), lane = tid & 63, wr = wid >> 2, wc = wid & 3, fr = lane & 15, fq = lane >> 4;
    const int K = g.K, nt = K / BK;
    unsigned voffA[2], voffB[2];
#pragma unroll
    for (int i = 0; i < 2; ++i) { int R, C; stage_rc(tid * 16 + i * 8192, R, C); const int Rb = Epi::PERM ? ((R & ~31) + perm32(R & 31)) : R;
        voffA[i] = (unsigned)(R * K + C) * 2u; voffB[i] = (unsigned)(Rb * K + C) * 2u; }
    const size_t kstep = (size_t)(BK * 2);
    const size_t hstep = (size_t)HALF * K * 2;
    const size_t tstep = 2 * hstep;
    const unsigned ldsw = (unsigned)wid * 1024u;
    const int aoff = lds_byte(wr * 64 + fr, fq * 8), boff = lds_byte(wc * 32 + fr, fq * 8);
#define PG8_SA(b, h) (((b) * 2 + (h)) * HTB)
#define PG8_SB(b, h) ((4 + (b) * 2 + (h)) * HTB)
#define PG8_STAGE(bufoff, gbase, voff) do { _Pragma("unroll") for (int _i = 0; _i < 2; ++_i) \
        __builtin_amdgcn_global_load_lds((const unsigned*)((const char*)(gbase) + (voff)[_i]), (PG8_LAS unsigned*)(lds + (bufoff) + ldsw + _i * 8192), 16, 0, 0); } while (0)
#define PG8_LDA(dst, b, h) do { _Pragma("unroll") for (int m = 0; m < 4; ++m) _Pragma("unroll") for (int k = 0; k < 2; ++k) dst[m][k] = *(const PG8_LAS bf16x8*)(lds + PG8_SA(b, h) + aoff + m * 2048 + k * 1024); } while (0)
#define PG8_LDB(dst, b, h) do { _Pragma("unroll") for (int n = 0; n < 2; ++n) _Pragma("unroll") for (int k = 0; k < 2; ++k) dst[n][k] = *(const PG8_LAS bf16x8*)(lds + PG8_SB(b, h) + boff + n * 2048 + k * 1024); } while (0)
#define PG8_MMA(ai, bj, At, Bt) do { __builtin_amdgcn_s_setprio(1); _Pragma("unroll") for (int m = 0; m < 4; ++m) _Pragma("unroll") for (int n = 0; n < 2; ++n) _Pragma("unroll") for (int k = 0; k < 2; ++k) \
        acc[ai][bj][m][n] = __builtin_amdgcn_mfma_f32_16x16x32_bf16(Bt[n][k], At[m][k], acc[ai][bj][m][n], 0, 0, 0); __builtin_amdgcn_s_setprio(0); } while (0)
#define PG8_WAIT_V(n) asm volatile("s_waitcnt vmcnt(" #n ")" ::: "memory")
#define PG8_WAIT_L(n) asm volatile("s_waitcnt lgkmcnt(" #n ")" ::: "memory")
#define PG8_BAR __builtin_amdgcn_s_barrier()
#define PG8_SCHED __builtin_amdgcn_sched_barrier(0)
    Unit cur, nxt; int ui = 0;
    if (!S.next(0, cur)) return;
    f32x4 acc[2][2][4][2];
#pragma unroll
    for (int a = 0; a < 2; ++a)
#pragma unroll
        for (int b = 0; b < 2; ++b)
#pragma unroll
            for (int m = 0; m < 4; ++m)
#pragma unroll
                for (int n = 0; n < 2; ++n) acc[a][b][m][n] = (f32x4){0.f, 0.f, 0.f, 0.f};
    bf16x8 At[4][2], B0[2][2], B1[2][2];
    const char* cA = (const char*)g.A + (size_t)cur.pm * tstep; const char* cB = (const char*)g.Bt + (size_t)cur.pn * tstep;
    S.a_ready(cur);
    if constexpr (SP2) {
        PG8_STAGE(PG8_SB(0, 0), cB, voffB); PG8_STAGE(PG8_SB(0, 1), cB + hstep, voffB); PG8_STAGE(PG8_SA(0, 0), cA, voffA); PG8_STAGE(PG8_SA(0, 1), cA + hstep, voffA);
        if (wr == 1) PG8_BAR;
        PG8_WAIT_V(2); PG8_BAR;
        PG8_STAGE(PG8_SB(1, 0), cB + kstep, voffB); PG8_STAGE(PG8_SA(1, 0), cA + kstep, voffA); PG8_STAGE(PG8_SB(1, 1), cB + hstep + kstep, voffB);
        PG8_WAIT_V(6); PG8_BAR;
    } else {
        PG8_STAGE(PG8_SB(0, 0), cB, voffB); PG8_STAGE(PG8_SA(0, 0), cA, voffA); PG8_STAGE(PG8_SB(0, 1), cB + hstep, voffB); PG8_STAGE(PG8_SA(0, 1), cA + hstep, voffA);
        if (wr == 1) PG8_BAR;
        PG8_WAIT_V(4); PG8_BAR;
        PG8_STAGE(PG8_SB(1, 0), cB + kstep, voffB); PG8_STAGE(PG8_SA(1, 0), cA + kstep, voffA); PG8_STAGE(PG8_SB(1, 1), cB + hstep + kstep, voffB);
        PG8_WAIT_V(6); PG8_BAR;
    }
    for (;;) {
        const bool has_next = S.next(ui + 1, nxt);
        const char* nA = has_next ? (const char*)g.A + (size_t)nxt.pm * tstep : cA; const char* nB = has_next ? (const char*)g.Bt + (size_t)nxt.pn * tstep : cB;
        for (int t = 0; t < nt; t += 2) {
            const bool last = (t == nt - 2);
            const char* a1 = cA + (size_t)(t + 1) * kstep;
            const char* a2 = last ? nA : cA + (size_t)(t + 2) * kstep; const char* b2 = last ? nB : cB + (size_t)(t + 2) * kstep;
            const char* a3 = a2 + kstep; const char* b3 = b2 + kstep;
            if (last && has_next) S.a_ready(nxt);
            if constexpr (SP2) {
            PG8_LDB(B0, 0, 0); PG8_LDB(B1, 0, 1); PG8_SCHED; PG8_LDA(At, 0, 0); PG8_STAGE(PG8_SA(1, 1), a1 + hstep, voffA);
            PG8_WAIT_V(8); PG8_WAIT_L(0); PG8_BAR; PG8_MMA(0, 0, At, B0); PG8_MMA(0, 1, At, B1); PG8_BAR; PG8_SCHED;
            PG8_LDA(At, 0, 1); PG8_STAGE(PG8_SB(0, 0), b2, voffB); PG8_STAGE(PG8_SB(0, 1), b2 + hstep, voffB); PG8_STAGE(PG8_SA(0, 0), a2, voffA);
            PG8_WAIT_V(8); PG8_WAIT_L(0); PG8_BAR; PG8_MMA(1, 0, At, B0); PG8_MMA(1, 1, At, B1); PG8_BAR; PG8_SCHED;
            PG8_LDB(B0, 1, 0); PG8_LDB(B1, 1, 1); PG8_SCHED; PG8_LDA(At, 1, 0); PG8_STAGE(PG8_SA(0, 1), a2 + hstep, voffA);
            PG8_WAIT_V(8); PG8_WAIT_L(0); PG8_BAR; PG8_MMA(0, 0, At, B0); PG8_MMA(0, 1, At, B1); PG8_BAR; PG8_SCHED;
            PG8_LDA(At, 1, 1); PG8_STAGE(PG8_SB(1, 0), b3, voffB); PG8_STAGE(PG8_SB(1, 1), b3 + hstep, voffB); PG8_STAGE(PG8_SA(1, 0), a3, voffA);
            PG8_WAIT_V(8); PG8_WAIT_L(0); PG8_BAR; PG8_MMA(1, 0, At, B0); PG8_MMA(1, 1, At, B1); PG8_BAR; PG8_SCHED;
            } else {
            PG8_LDB(B0, 0, 0); PG8_SCHED; PG8_LDA(At, 0, 0); PG8_STAGE(PG8_SA(1, 1), a1 + hstep, voffA);
            PG8_WAIT_L(8); PG8_BAR; PG8_WAIT_L(0); PG8_MMA(0, 0, At, B0); PG8_BAR; PG8_SCHED;
            PG8_LDB(B1, 0, 1); PG8_STAGE(PG8_SB(0, 0), b2, voffB);
            PG8_BAR; PG8_WAIT_L(0); PG8_MMA(0, 1, At, B1); PG8_BAR;
            PG8_LDA(At, 0, 1); PG8_STAGE(PG8_SA(0, 0), a2, voffA);
            PG8_BAR; PG8_WAIT_L(0); PG8_MMA(1, 0, At, B0); PG8_BAR; PG8_SCHED;
            PG8_STAGE(PG8_SB(0, 1), b2 + hstep, voffB);
            PG8_WAIT_V(6); PG8_BAR; PG8_MMA(1, 1, At, B1); PG8_BAR;
            PG8_LDB(B0, 1, 0); PG8_SCHED; PG8_LDA(At, 1, 0); PG8_STAGE(PG8_SA(0, 1), a2 + hstep, voffA);
            PG8_WAIT_L(8); PG8_BAR; PG8_WAIT_L(0); PG8_MMA(0, 0, At, B0); PG8_BAR; PG8_SCHED;
            PG8_LDB(B1, 1, 1); PG8_STAGE(PG8_SB(1, 0), b3, voffB);
            PG8_BAR; PG8_WAIT_L(0); PG8_MMA(0, 1, At, B1); PG8_BAR;
            PG8_LDA(At, 1, 1); PG8_STAGE(PG8_SA(1, 0), a3, voffA);
            PG8_BAR; PG8_WAIT_L(0); PG8_MMA(1, 0, At, B0); PG8_BAR; PG8_SCHED;
            PG8_STAGE(PG8_SB(1, 1), b3 + hstep, voffB);
            PG8_WAIT_V(6); PG8_BAR; PG8_MMA(1, 1, At, B1); PG8_BAR;
            }
        }
        if constexpr (ALIGN_EPI) { if (wr == 0) PG8_BAR; }
        if constexpr (!Epi::AFTER_DRAIN) { E(acc, cur, wr, wc, fr, fq); S.done(cur); }
        if (!has_next) break;
#pragma unroll
        for (int a = 0; a < 2; ++a)
#pragma unroll
            for (int b = 0; b < 2; ++b)
#pragma unroll
                for (int m = 0; m < 4; ++m)
#pragma unroll
                    for (int n = 0; n < 2; ++n) acc[a][b][m][n] = (f32x4){0.f, 0.f, 0.f, 0.f};
        cur = nxt; cA = nA; cB = nB; ++ui;
        if constexpr (ALIGN_EPI) { if (wr == 1) PG8_BAR; }
    }
    PG8_WAIT_V(0);
    if constexpr (!ALIGN_EPI) { if (wr == 0) PG8_BAR; }
    PG8_BAR;
    if constexpr (Epi::AFTER_DRAIN) { E.fused(acc, cur, wr, wc, fr, fq, lds, wid, lane); S.done(cur); }
#undef PG8_SA
#undef PG8_SB
#undef PG8_STAGE
#undef PG8_LDA
#undef PG8_LDB
#undef PG8_MMA
#undef PG8_WAIT_V
#undef PG8_WAIT_L
#undef PG8_BAR
#undef PG8_SCHED
}
}

constexpr int BATCH = 16, SEQ = 2048, DM = 2048, T = BATCH * SEQ, DEPTH = 2;
constexpr int NMEM = 256, DIN = 4096, MEMW = 512;
constexpr int PEER_H = 8, PEER_N = 16384;
constexpr int NWAVES = 8, NTHREADS = NWAVES * 64;
constexpr float EPS = 1e-6f;
constexpr int QA = 0, KA = 768, VA = 1024, QB = 1280, KB = 1792, VB = 2304, QC = 2816, KC = 3584, VC = 3840;
constexpr int OA = 0, OB = 768, OC = 1280;

constexpr size_t MiB = 1u << 20;
constexpr size_t WS_CTL = 0, CTL_ZERO_BYTES = 2 * MiB;
constexpr size_t WS_ROWSQ = 256 * 1024;
constexpr size_t WS_ROPE = 83 * MiB, WS_BIASA = 83 * MiB + 16384;
constexpr size_t WS_WIN = 2 * MiB, WS_WOUT = 34 * MiB, WS_WMQ = 50 * MiB, WS_WMKV = 54 * MiB, WS_WMO = 62 * MiB, WS_WPQ = 66 * MiB, WS_PKEYS = 82 * MiB;
constexpr size_t WS_MEMN = 84 * MiB, WS_KVM = 116 * MiB, WS_PU = 132 * MiB, WS_PV = 260 * MiB, WS_XN = 388 * MiB, WS_QKV = 516 * MiB, WS_ATT = 772 * MiB;
constexpr size_t WS_QM = 900 * MiB, WS_OM = 932 * MiB, WS_END = 964 * MiB;
constexpr size_t WS_QP = WS_QKV, WS_PIDX = WS_QKV + 128 * MiB, WS_PGATE = WS_QKV + 144 * MiB;
constexpr int CW_BAR = 4096;

constexpr int RING_OFF = 0, RING_BYTES = 131072;
constexpr int LDSCTL_OFF = RING_BYTES, MISC_OFF = LDSCTL_OFF + 320;
constexpr int LDS_BYTES = 147456;

#define GAS __attribute__((address_space(1)))
#define LAS __attribute__((address_space(3)))
typedef unsigned short bf16;
typedef unsigned v4u __attribute__((ext_vector_type(4)));
typedef unsigned v2u __attribute__((ext_vector_type(2)));
typedef float f32x4 __attribute__((ext_vector_type(4)));
typedef float f32x16 __attribute__((ext_vector_type(16)));
typedef short bf16x8 __attribute__((ext_vector_type(8)));
typedef GAS unsigned gu32;
#define LDS_WAIT() asm volatile("s_waitcnt lgkmcnt(0)" ::: "memory")
#define VM_WAIT() asm volatile("s_waitcnt vmcnt(0)" ::: "memory")
__device__ __forceinline__ unsigned f2bf(float f) { unsigned u = __builtin_bit_cast(unsigned, f); return (u + 0x7fffu + ((u >> 16) & 1u)) >> 16; }
__device__ __forceinline__ unsigned pk2(float lo, float hi) { return f2bf(lo) | (f2bf(hi) << 16); }
__device__ __forceinline__ float bflo(unsigned w) { return __builtin_bit_cast(float, w << 16); }
__device__ __forceinline__ float bfhi(unsigned w) { return __builtin_bit_cast(float, w & 0xffff0000u); }

__device__ __forceinline__ float shx(float v, int k, int lane) { return __builtin_bit_cast(float, __builtin_amdgcn_ds_bpermute((lane ^ k) << 2, __builtin_bit_cast(int, v))); }
#define XB_TMO      128
#define XB_XCNT(j)  (256  + 64 * (j))
#define XB_XSUB(j)  (1280 + 64 * (j))
#define XB_XGEN(j)  (2304 + 64 * (j))
#define XB_TOP      3328
#define XB_TOPGEN   3392
#define XCD_BAR_WORDS 3456
#define XB_SPIN_CAP (1u << 18)

__device__ __forceinline__ unsigned xb_ld(unsigned* p)              { return __hip_atomic_load(p, __ATOMIC_RELAXED, __HIP_MEMORY_SCOPE_AGENT); }
__device__ __forceinline__ unsigned xb_add(unsigned* p, unsigned v) { return __hip_atomic_fetch_add(p, v, __ATOMIC_RELAXED, __HIP_MEMORY_SCOPE_AGENT); }
__device__ __forceinline__ unsigned xb_xcc_id() { return (unsigned)__builtin_amdgcn_s_getreg((3 << 11) | 20) & 0xFu; }
#define XB_SPIN(cond, bar) do { unsigned _sp = 0; while (cond) { __builtin_amdgcn_s_sleep(1); \
    if ((++_sp & 255u) == 0u) { if (xb_ld(&(bar)[XB_TMO])) break; if (_sp > XB_SPIN_CAP) { atomicAdd(&(bar)[XB_TMO], 1u); break; } } } } while (0)

struct XcdBarrier {
    unsigned* bar; unsigned x;
    volatile LAS unsigned* st;
};

__device__ __forceinline__ XcdBarrier xcd_barrier_post(unsigned* bar, volatile LAS unsigned* st) {
    XcdBarrier b; b.bar = bar; b.x = xb_xcc_id(); b.st = st;
    if (threadIdx.x == 0) (void)xb_add(&bar[XB_XCNT(b.x)], 1u);
    return b;
}
__device__ __forceinline__ void xcd_barrier_complete(unsigned* bar, unsigned x, unsigned& nloc, unsigned& nx) {
    const unsigned G = gridDim.x * gridDim.y * gridDim.z;
    unsigned sum, cnt, mine, sp = 0u;
    for (;;) {
        sum = 0u; cnt = 0u; mine = 0u;
#pragma unroll
        for (unsigned j = 0; j < 16; ++j) { const unsigned c = xb_ld(&bar[XB_XCNT(j)]); sum += c; cnt += (c > 0u) ? 1u : 0u; mine = (j == x) ? c : mine; }
        if (sum == G) break;
        __builtin_amdgcn_s_sleep(1);
        if ((++sp & 255u) == 0u) { if (xb_ld(&bar[XB_TMO])) break; if (sp > XB_SPIN_CAP) { atomicAdd(&bar[XB_TMO], 1u); break; } }
    }
    nloc = mine > 0u ? mine : 1u; nx = cnt > 0u ? cnt : 1u;
}

__device__ __forceinline__ void xcd_barrier(const XcdBarrier& b) {
    asm volatile("s_waitcnt vmcnt(0)" ::: "memory");
    __syncthreads();
    if (threadIdx.x == 0) {
        unsigned* bar = b.bar;
        __builtin_amdgcn_s_waitcnt(0);
        unsigned nloc = b.st[0], nx = b.st[1];
        if (nloc == 0u) { xcd_barrier_complete(bar, b.x, nloc, nx); b.st[0] = nloc; b.st[1] = nx; }
        const unsigned old = xb_add(&bar[XB_XSUB(b.x)], 1u);
        const unsigned gen = old / nloc;
        if (old + 1u == (gen + 1u) * nloc) {
            __builtin_amdgcn_fence(__ATOMIC_RELEASE, "agent");
            asm volatile("s_waitcnt vmcnt(0)" ::: "memory");
            const unsigned og = xb_add(&bar[XB_TOP], 1u);
            const unsigned tg = og / nx;
            if (og + 1u == (tg + 1u) * nx) xb_add(&bar[XB_TOPGEN], 1u);
            else XB_SPIN(xb_ld(&bar[XB_TOPGEN]) == tg, bar);
            __builtin_amdgcn_fence(__ATOMIC_ACQUIRE, "agent");
            xb_add(&bar[XB_XGEN(b.x)], 1u);
            asm volatile("s_waitcnt vmcnt(0)" ::: "memory");
        } else {
            XB_SPIN(xb_ld(&bar[XB_XGEN(b.x)]) == gen, bar);
            __builtin_amdgcn_fence(__ATOMIC_ACQUIRE, "agent");
            asm volatile("s_waitcnt vmcnt(0)" ::: "memory");
        }
    }
    __syncthreads();
}

__device__ __forceinline__ float wave_sum(float v, int lane) {
#pragma unroll
    for (int o = 1; o < 64; o <<= 1) v += shx(v, o, lane);
    return v;
}
__device__ __forceinline__ void* ldptr(LAS unsigned char* lds, int i) {
    const unsigned long long v = ((const LAS unsigned long long*)(lds + LDSCTL_OFF + 1024))[i];
    const unsigned lo = __builtin_amdgcn_readfirstlane((unsigned)v), hi = __builtin_amdgcn_readfirstlane((unsigned)(v >> 32));
    return (void*)(((unsigned long long)hi << 32) | lo);
}
struct OffsetOrder {
    pg8::StaticOrder S;
    __device__ void init(int M, int N, int G, int c, int off) { S.init(M, N, G, (c + G - off % G) % G); }
    __device__ bool next(int i, pg8::Unit& u) const { return S.next(i, u); }
    __device__ __forceinline__ void a_ready(const pg8::Unit&) const {}
    __device__ __forceinline__ void done(const pg8::Unit&) const {}
};

template <bool PERMQKV>
__device__ __forceinline__ void transpose_item(const float* W, int K, int N, bf16* WT, LAS float* scr, int item, int lane, const float* gk = nullptr) {
    const int nblk = N / 32, kb = item / nblk, nb = item % nblk, k0 = 64 * kb, n0 = 32 * nb;
    int d0 = n0;
    if (PERMQKV) { const int within = n0 & 255; d0 = (n0 & ~255) + 128 * ((within >> 5) & 1) + 32 * (within >> 6); }
#pragma unroll 8
    for (int i = 0; i < 32; ++i) { const int kk = 2 * i + (lane >> 5); scr[kk * 33 + (lane & 31)] = W[(size_t)(k0 + kk) * N + n0 + (lane & 31)] * (gk ? gk[k0 + kk] : 1.f); }
    LDS_WAIT(); asm volatile("" ::: "memory");
    const int c = lane & 7;
#pragma unroll
    for (int j = 0; j < 4; ++j) { const int n = (lane >> 3) + 8 * j; const LAS float* s = scr + (8 * c) * 33 + n;
        v4u o; o.x = pk2(s[0 * 33], s[1 * 33]); o.y = pk2(s[2 * 33], s[3 * 33]); o.z = pk2(s[4 * 33], s[5 * 33]); o.w = pk2(s[6 * 33], s[7 * 33]);
        *(GAS v4u*)(WT + (size_t)(d0 + n) * K + k0 + 8 * c) = o; }
    LDS_WAIT(); asm volatile("" ::: "memory");
}
__device__ __forceinline__ void convert_bf16(const float* src, bf16* dst, size_t n, size_t gtid, size_t nthreads) {
    for (size_t i = gtid * 8; i < n; i += nthreads * 8) {
        const f32x4 a = *(const GAS f32x4*)(src + i), b = *(const GAS f32x4*)(src + i + 4);
        v4u o; o.x = pk2(a[0], a[1]); o.y = pk2(a[2], a[3]); o.z = pk2(b[0], b[1]); o.w = pk2(b[2], b[3]);
        *(GAS v4u*)(dst + i) = o;
    }
}
__device__ __forceinline__ int t5_bucket(int rel) {
    const int n = rel < 0 ? -rel : rel;
    const int b = n < 8 ? n : n < 12 ? 8 : n < 16 ? 9 : n < 23 ? 10 : n < 32 ? 11 : n < 46 ? 12 : n < 64 ? 13 : n < 91 ? 14 : 15;
    return b + (rel > 0 ? 16 : 0);
}
__constant__ float ROPE_INV[16] = {1.000000000e+00f, 5.623413324e-01f, 3.162277639e-01f, 1.778279394e-01f, 1.000000015e-01f, 5.623413250e-02f, 3.162277490e-02f, 1.778279431e-02f,
                                   9.999999776e-03f, 5.623413250e-03f, 3.162277630e-03f, 1.778279431e-03f, 1.000000047e-03f, 5.623413017e-04f, 3.162277571e-04f, 1.778279402e-04f};

__device__ __forceinline__ void rms_row_to_bf16(const float* xrow, const float* g0, bf16* o0, const float* g1, bf16* o1, int lane) {
    const GAS f32x4* xr = (const GAS f32x4*)xrow + lane;
    f32x4 v[8]; float s = 0.f;
#pragma unroll
    for (int j = 0; j < 8; ++j) { v[j] = xr[64 * j]; s += (v[j].x * v[j].x + v[j].y * v[j].y) + (v[j].z * v[j].z + v[j].w * v[j].w); }
    const float rstd = 1.f / sqrtf(wave_sum(s, lane) * (1.f / DM) + EPS);
    {   const GAS f32x4* gr = (const GAS f32x4*)g0 + lane; GAS v2u* o8 = (GAS v2u*)o0 + lane;
#pragma unroll
        for (int j = 0; j < 8; ++j) { const f32x4 gg = gr[64 * j]; v2u w; w.x = pk2(v[j].x * rstd * gg.x, v[j].y * rstd * gg.y); w.y = pk2(v[j].z * rstd * gg.z, v[j].w * rstd * gg.w); o8[64 * j] = w; } }
    if (g1) { const GAS f32x4* gr = (const GAS f32x4*)g1 + lane; GAS v2u* o8 = (GAS v2u*)o1 + lane;
#pragma unroll
        for (int j = 0; j < 8; ++j) { const f32x4 gg = gr[64 * j]; v2u w; w.x = pk2(v[j].x * rstd * gg.x, v[j].y * rstd * gg.y); w.y = pk2(v[j].z * rstd * gg.z, v[j].w * rstd * gg.w); o8[64 * j] = w; } }
}
__device__ __forceinline__ void prep_row(const float* xrow, bf16* orow, u64_t* sq, int lane) {
    const GAS f32x4* xr = (const GAS f32x4*)xrow + lane; GAS v2u* o8 = (GAS v2u*)orow + lane; float s = 0.f;
#pragma unroll
    for (int j = 0; j < 8; ++j) { const f32x4 v = xr[64 * j]; s += (v.x * v.x + v.y * v.y) + (v.z * v.z + v.w * v.w); v2u w; w.x = pk2(v.x, v.y); w.y = pk2(v.z, v.w); o8[64 * j] = w; }
    s = wave_sum(s, lane);
    if (lane == 0) *sq = rowsq_fx(s);
}
__device__ __forceinline__ void norm_rows(const float* X, const float* g, bf16* XN, int gw, int NGW, int lane) {
    for (int m = gw; m < T; m += NGW) rms_row_to_bf16(X + (size_t)m * DM, g, XN + (size_t)m * DM, nullptr, nullptr, lane);
}

template <int TYPE>
__device__ __forceinline__ void naive_attn_item(const bf16* QKV, bf16* ATT, int b, int grow, int head, int lane, const float* biasA, const float* sink, const float* rpb) {
    const int tpos = grow * 64 + lane; const size_t trow = (size_t)b * SEQ + tpos;
    int qcol, kcol, vcol, ocol;
    if (TYPE == 0) { qcol = QA + head * 64; kcol = KA + (head / 3) * 64; vcol = VA + (head / 3) * 64; ocol = OA + head * 64; }
    else if (TYPE == 1) { qcol = QB + head * 64; kcol = KB + head * 64; vcol = VB + head * 64; ocol = OB + head * 64; }
    else { qcol = QC + head * 64; kcol = KC + (head / 3) * 64; vcol = VC + (head / 3) * 64; ocol = OC + head * 64; }
    float q[64], o[64];
#pragma unroll
    for (int c = 0; c < 8; ++c) { const v4u w = *(const GAS v4u*)(QKV + trow * DIN + qcol + 8 * c);
        q[8 * c + 0] = bflo(w.x); q[8 * c + 1] = bfhi(w.x); q[8 * c + 2] = bflo(w.y); q[8 * c + 3] = bfhi(w.y); q[8 * c + 4] = bflo(w.z); q[8 * c + 5] = bfhi(w.z); q[8 * c + 6] = bflo(w.w); q[8 * c + 7] = bfhi(w.w); }
#pragma unroll
    for (int d = 0; d < 64; ++d) o[d] = 0.f;
    float m = -1e30f, l = 0.f;
    int j0, j1;
    if (TYPE == 0) { j0 = grow * 64 - 128; if (j0 < 0) j0 = 0; j1 = grow * 64 + 63 + 128; if (j1 > SEQ - 1) j1 = SEQ - 1; }
    else if (TYPE == 1) { int r0 = grow - 4; r0 = r0 < 0 ? 0 : (r0 > 24 ? 24 : r0); j0 = r0 * 64; j1 = j0 + 511; }
    else { j0 = 0; j1 = SEQ - 1; }
    int c0 = lane - 8; c0 = c0 < 0 ? 0 : (c0 > 48 ? 48 : c0);
#pragma unroll 1
    for (int j = j0; j <= j1; ++j) {
        const bf16* krow = QKV + ((size_t)b * SEQ + j) * DIN;
        float s = 0.f;
#pragma unroll
        for (int c = 0; c < 8; ++c) { const v4u w = *(const GAS v4u*)(krow + kcol + 8 * c);
            s += q[8 * c + 0] * bflo(w.x) + q[8 * c + 1] * bfhi(w.x) + q[8 * c + 2] * bflo(w.y) + q[8 * c + 3] * bfhi(w.y) + q[8 * c + 4] * bflo(w.z) + q[8 * c + 5] * bfhi(w.z) + q[8 * c + 6] * bflo(w.w) + q[8 * c + 7] * bfhi(w.w); }
        bool valid = true;
        if (TYPE == 0) { const int rel = j - tpos; valid = (rel >= -128 && rel <= 128); if (valid) s += biasA[head * 257 + rel + 128]; }
        if (TYPE == 1) { const int kr = j >> 6, kc = j & 63; valid = (kc >= c0 && kc < c0 + 16); if (valid) s += rpb[(head * 15 + (kr - grow + 7)) * 31 + (kc - lane + 15)]; }
        const float mn = valid ? fmaxf(m, s) : m;
        const float a = __expf(m - mn);
        const float p = valid ? __expf(s - mn) : 0.f;
        l = l * a + p; m = mn;
#pragma unroll
        for (int c = 0; c < 8; ++c) { const v4u w = *(const GAS v4u*)(krow + vcol + 8 * c);
            o[8 * c + 0] = o[8 * c + 0] * a + p * bflo(w.x); o[8 * c + 1] = o[8 * c + 1] * a + p * bfhi(w.x); o[8 * c + 2] = o[8 * c + 2] * a + p * bflo(w.y); o[8 * c + 3] = o[8 * c + 3] * a + p * bfhi(w.y);
            o[8 * c + 4] = o[8 * c + 4] * a + p * bflo(w.z); o[8 * c + 5] = o[8 * c + 5] * a + p * bfhi(w.z); o[8 * c + 6] = o[8 * c + 6] * a + p * bflo(w.w); o[8 * c + 7] = o[8 * c + 7] * a + p * bfhi(w.w); }
    }
    if (TYPE == 0) l += __expf(sink[head] - m);
    const float inv = 1.f / l;
#pragma unroll
    for (int c = 0; c < 8; ++c) { v4u w; w.x = pk2(o[8 * c + 0] * inv, o[8 * c + 1] * inv); w.y = pk2(o[8 * c + 2] * inv, o[8 * c + 3] * inv); w.z = pk2(o[8 * c + 4] * inv, o[8 * c + 5] * inv); w.w = pk2(o[8 * c + 6] * inv, o[8 * c + 7] * inv);
        *(GAS v4u*)(ATT + trow * DM + ocol + 8 * c) = w; }
}
__device__ __forceinline__ float rdl(float v, int l) { return __builtin_bit_cast(float, __builtin_amdgcn_readlane(__builtin_bit_cast(int, v), l)); }
__device__ __forceinline__ void naive_mem_item(const bf16* QM, const bf16* KVM, bf16* OM, const float* gq, size_t trow, int b, int head, int lane) {
    const unsigned qw = *(const GAS unsigned*)(QM + trow * MEMW + head * 128 + 2 * lane);
    float q0 = bflo(qw), q1 = bfhi(qw);
    const float ss = wave_sum(q0 * q0 + q1 * q1, lane);
    const float r = 0.08838834764831845f / sqrtf(ss * (1.f / 128.f) + EPS);
    q0 *= r * gq[2 * lane]; q1 *= r * gq[2 * lane + 1];
    const bf16* kbase = KVM + ((size_t)b * NMEM + lane) * 1024 + head * 128;
    float s[4] = {0.f, 0.f, 0.f, 0.f};
#pragma unroll 1
    for (int c = 0; c < 16; ++c) {
        float qa[8];
#pragma unroll
        for (int e = 0; e < 4; ++e) { qa[2 * e] = rdl(q0, 4 * c + e); qa[2 * e + 1] = rdl(q1, 4 * c + e); }
#pragma unroll
        for (int i = 0; i < 4; ++i) { const v4u w = *(const GAS v4u*)(kbase + (size_t)i * 64 * 1024 + 8 * c);
            s[i] += qa[0] * bflo(w.x) + qa[1] * bfhi(w.x) + qa[2] * bflo(w.y) + qa[3] * bfhi(w.y) + qa[4] * bflo(w.z) + qa[5] * bfhi(w.z) + qa[6] * bflo(w.w) + qa[7] * bfhi(w.w); }
    }
    float m = fmaxf(fmaxf(s[0], s[1]), fmaxf(s[2], s[3]));
#pragma unroll
    for (int o = 1; o < 64; o <<= 1) m = fmaxf(m, shx(m, o, lane));
    float p[4]; float l = 0.f;
#pragma unroll
    for (int i = 0; i < 4; ++i) { p[i] = __expf(s[i] - m); l += p[i]; }
    l = wave_sum(l, lane);
    const bf16* vbase = KVM + ((size_t)b * NMEM) * 1024 + 512 + head * 128 + 2 * lane;
    float o0 = 0.f, o1 = 0.f;
#pragma unroll
    for (int i = 0; i < 4; ++i) {
#pragma unroll 4
        for (int jj = 0; jj < 64; ++jj) { const float pj = rdl(p[i], jj); const unsigned w = *(const GAS unsigned*)(vbase + (size_t)(64 * i + jj) * 1024); o0 += pj * bflo(w); o1 += pj * bfhi(w); }
    }
    const float inv = 1.f / l;
    *(GAS unsigned*)(OM + trow * MEMW + head * 128 + 2 * lane) = pk2(o0 * inv, o1 * inv);
}
__device__ __forceinline__ void mixnorm_rows(bf16* ATT, const float* g, int gw, int NGW, int lane) {
    for (int m = gw; m < T; m += NGW) {
        GAS v4u* p = (GAS v4u*)(ATT + (size_t)m * DM + 32 * lane);
        v4u w[4]; float f[32]; float ss = 0.f;
#pragma unroll
        for (int c = 0; c < 4; ++c) { w[c] = p[c];
            f[8 * c + 0] = bflo(w[c].x); f[8 * c + 1] = bfhi(w[c].x); f[8 * c + 2] = bflo(w[c].y); f[8 * c + 3] = bfhi(w[c].y); f[8 * c + 4] = bflo(w[c].z); f[8 * c + 5] = bfhi(w[c].z); f[8 * c + 6] = bflo(w[c].w); f[8 * c + 7] = bfhi(w[c].w); }
#pragma unroll
        for (int i = 0; i < 32; ++i) ss += f[i] * f[i];
        const int grp = lane < 24 ? 0 : (lane < 40 ? 1 : 2);
        const float sa = wave_sum(grp == 0 ? ss : 0.f, lane), sb = wave_sum(grp == 1 ? ss : 0.f, lane), sc = wave_sum(grp == 2 ? ss : 0.f, lane);
        const float r = grp == 0 ? 1.f / sqrtf(sa * (1.f / 768.f) + EPS) : (grp == 1 ? 1.f / sqrtf(sb * (1.f / 512.f) + EPS) : 1.f / sqrtf(sc * (1.f / 768.f) + EPS));
        const float* gg = g + 32 * lane;
#pragma unroll
        for (int c = 0; c < 4; ++c) { const f32x4 g0 = *(const GAS f32x4*)(gg + 8 * c), g1 = *(const GAS f32x4*)(gg + 8 * c + 4);
            v4u o; o.x = pk2(f[8 * c + 0] * r * g0[0], f[8 * c + 1] * r * g0[1]); o.y = pk2(f[8 * c + 2] * r * g0[2], f[8 * c + 3] * r * g0[3]);
            o.z = pk2(f[8 * c + 4] * r * g1[0], f[8 * c + 5] * r * g1[1]); o.w = pk2(f[8 * c + 6] * r * g1[2], f[8 * c + 7] * r * g1[3]); p[c] = o; }
    }
}

#ifndef PEER_HD
#define PEER_HD __device__ __forceinline__
#define PEER_EXP(x) __expf(x)
#endif
template <int N> PEER_HD void bitonic_sort_desc(float* v) {
#pragma unroll
    for (int k = 2; k <= N; k <<= 1)
#pragma unroll
        for (int j = k >> 1; j > 0; j >>= 1)
#pragma unroll
            for (int i = 0; i < N; ++i) { const int l = i ^ j; if (l > i) { const bool desc = ((i & k) == 0); const float a = v[i], b = v[l]; const float hi = fmaxf(a, b), lo = fminf(a, b);
                v[i] = desc ? hi : lo; v[l] = desc ? lo : hi; } }
}
PEER_HD void merge_top16(float* a, const float* b) {
    float c[16];
#pragma unroll
    for (int i = 0; i < 16; ++i) c[i] = fmaxf(a[i], b[15 - i]);
#pragma unroll
    for (int j = 8; j > 0; j >>= 1)
#pragma unroll
        for (int i = 0; i < 16; ++i) { const int l = i ^ j; if (l > i) { const float x = c[i], y = c[l]; c[i] = fmaxf(x, y); c[l] = fminf(x, y); } }
#pragma unroll
    for (int i = 0; i < 16; ++i) a[i] = c[i];
}
PEER_HD void top16_of_64(float (&v)[64]) {
    bitonic_sort_desc<16>(&v[0]); bitonic_sort_desc<16>(&v[16]); bitonic_sort_desc<16>(&v[32]); bitonic_sort_desc<16>(&v[48]);
    merge_top16(&v[0], &v[16]); merge_top16(&v[32], &v[48]); merge_top16(&v[0], &v[32]);
}
PEER_HD float pack_idx(float s, unsigned idx, unsigned mask) { return __builtin_bit_cast(float, (__builtin_bit_cast(unsigned, s) & ~mask) | idx); }
PEER_HD unsigned low_bits(float s, unsigned mask) { return __builtin_bit_cast(unsigned, s) & mask; }
PEER_HD unsigned pick16(const float* a, unsigned i, unsigned mask) {
    unsigned r = 0;
#pragma unroll
    for (unsigned k = 0; k < 16; ++k) r = (i == k) ? low_bits(a[k], mask) : r;
    return r;
}
PEER_HD void peer_candidates(const float* a, const float* b, int* e, float* gate) {
    float c[64]; int n = 0;
#pragma unroll
    for (int i = 0; i < 16; ++i)
#pragma unroll
        for (int j = 0; j < 16; ++j) if ((i + 1) * (j + 1) <= 16) { c[n] = pack_idx(a[i] + b[j], (unsigned)(i * 16 + j), 0xffu); ++n; }
#pragma unroll
    for (int k = 50; k < 64; ++k) c[k] = -3.0e38f;
    top16_of_64(c);
    float mx = c[0], den = 0.f;
#pragma unroll
    for (int k = 0; k < 16; ++k) { const unsigned id = low_bits(c[k], 0xffu); const unsigned n0 = pick16(a, id >> 4, 0x7fu), n1 = pick16(b, id & 15u, 0x7fu);
        e[k] = (int)(n0 * 128u + n1); gate[k] = PEER_EXP(c[k] - mx); den += gate[k]; }
    const float inv = 1.f / den;
#pragma unroll
    for (int k = 0; k < 16; ++k) gate[k] *= inv;
}

__device__ __forceinline__ void peer_select_unit(const bf16* QP, const bf16* PK, int* PIDX, float* PGATE, int tb, int h, int wave, int lane) {
    const int hh = lane >> 5, tl = lane & 31; const size_t t = (size_t)tb * 256 + wave * 32 + tl;
    float ab[2][16];
#pragma unroll
    for (int p = 0; p < 2; ++p) {
        bf16x8 bq[8];
#pragma unroll
        for (int s = 0; s < 8; ++s) bq[s] = *(const GAS bf16x8*)(QP + t * DM + 256 * h + 128 * p + 16 * s + 8 * hh);
        float v[64];
#pragma unroll
        for (int nb = 0; nb < 4; ++nb) {
            f32x16 acc;
#pragma unroll
            for (int r = 0; r < 16; ++r) acc[r] = 0.f;
            const bf16* kp = PK + ((size_t)((h * 2 + p) * 128 + 32 * nb + tl)) * 128 + 8 * hh;
#pragma unroll
            for (int s = 0; s < 8; ++s) { const bf16x8 ak = *(const GAS bf16x8*)(kp + 16 * s); acc = __builtin_amdgcn_mfma_f32_32x32x16_bf16(ak, bq[s], acc, 0, 0, 0); }
#pragma unroll
            for (int r = 0; r < 16; ++r) v[16 * nb + r] = pack_idx(acc[r], (unsigned)(32 * nb + 8 * (r >> 2) + 4 * hh + (r & 3)), 0x7fu);
        }
        top16_of_64(v);
        float pv[16];
#pragma unroll
        for (int i = 0; i < 16; ++i) pv[i] = shx(v[i], 32, lane);
        merge_top16(&v[0], pv);
#pragma unroll
        for (int i = 0; i < 16; ++i) ab[p][i] = v[i];
    }
    int e[16]; float gate[16];
    peer_candidates(ab[0], ab[1], e, gate);
    if (hh == 0) { GAS v4u* o = (GAS v4u*)(PIDX + t * 128 + h * 16);
#pragma unroll
        for (int c = 0; c < 4; ++c) o[c] = (v4u){(unsigned)e[4 * c], (unsigned)e[4 * c + 1], (unsigned)e[4 * c + 2], (unsigned)e[4 * c + 3]}; }
    else { GAS f32x4* o = (GAS f32x4*)(PGATE + t * 128 + h * 16);
#pragma unroll
        for (int c = 0; c < 4; ++c) o[c] = (f32x4){gate[4 * c], gate[4 * c + 1], gate[4 * c + 2], gate[4 * c + 3]}; }
}

typedef float f32x2 __attribute__((ext_vector_type(2)));
constexpr float PU_SCALE = 256.f, PV_SCALE = 16.f;
__device__ __forceinline__ void convert_fp8(const float* src, unsigned char* dst, size_t n, float scale, size_t gtid, size_t nthreads) {
    for (size_t i = gtid * 16; i < n; i += nthreads * 16) {
        v4u o;
#pragma unroll
        for (int c = 0; c < 4; ++c) { f32x4 a = *(const GAS f32x4*)(src + i + 4 * c) * scale;
#pragma unroll
            for (int e = 0; e < 4; ++e) a[e] = fminf(fmaxf(a[e], -448.f), 448.f);
            int p = 0; p = __builtin_amdgcn_cvt_pk_fp8_f32(a[0], a[1], p, false); p = __builtin_amdgcn_cvt_pk_fp8_f32(a[2], a[3], p, true); o[c] = (unsigned)p; }
        *(GAS v4u*)(dst + i) = o;
    }
}
__device__ __forceinline__ void dot16_fp8(f32x2& acc, const v4u& w, const f32x2* x) {
#pragma unroll
    for (int c = 0; c < 4; ++c) { acc += __builtin_amdgcn_cvt_pk_f32_fp8((int)w[c], false) * x[2 * c]; acc += __builtin_amdgcn_cvt_pk_f32_fp8((int)w[c], true) * x[2 * c + 1]; }
}
__device__ __forceinline__ void axpy16_fp8(f32x2* y, const f32x2 wv, const v4u& w) {
#pragma unroll
    for (int c = 0; c < 4; ++c) { y[2 * c] += __builtin_amdgcn_cvt_pk_f32_fp8((int)w[c], false) * wv; y[2 * c + 1] += __builtin_amdgcn_cvt_pk_f32_fp8((int)w[c], true) * wv; }
}
typedef unsigned v6u __attribute__((ext_vector_type(6)));
typedef float v32f __attribute__((ext_vector_type(32)));
typedef v4u __attribute__((aligned(8))) v4u_a8;
constexpr float PU_SCALE6 = 90.0f, PV_SCALE6 = 5.65f;
__device__ __forceinline__ unsigned enc_e2m3(float v) {
    const float a = fminf(fabsf(v), 7.5f);
    unsigned code;
    if (a < 1.0f) code = (unsigned)__builtin_rintf(a * 8.f);
    else { const unsigned b = __builtin_bit_cast(unsigned, a) - 0x3F800000u; code = ((b + 0x7FFFFu + ((b >> 20) & 1u)) >> 20) + 8u; }
    return code | (v < 0.f ? 32u : 0u);
}
__device__ __forceinline__ void convert_fp6_rows(const float* src, unsigned char* dst, int nrows, float scale, const float* gain, int gw, int NGW, int lane) {
    for (int r = gw; r < nrows; r += NGW) {
        const float* sp = src + (size_t)r * DM + 4 * lane; const float* gp = gain ? gain + (size_t)(r / PEER_N) * DM + 4 * lane : nullptr;
        unsigned w[6] = {0u, 0u, 0u, 0u, 0u, 0u};
#pragma unroll
        for (int j = 0; j < 8; ++j) { f32x4 a = *(const GAS f32x4*)(sp + 256 * j) * scale; if (gp) a = a * *(const GAS f32x4*)(gp + 256 * j);
#pragma unroll
            for (int e = 0; e < 4; ++e) { const unsigned code = enc_e2m3(a[e]); const int bp = 6 * (4 * j + e), wi = bp >> 5, sh = bp & 31;
                w[wi] |= code << sh; if (sh > 26) w[wi + 1] |= code >> (32 - sh); } }
        unsigned char* dp = dst + (size_t)r * 1536 + 24 * lane;
        *(GAS v4u_a8*)dp = (v4u){w[0], w[1], w[2], w[3]}; *(GAS v2u*)(dp + 16) = (v2u){w[4], w[5]};
    }
}
constexpr float PV_SCALE4 = 5.65f, PU_SCALE4 = 90.0f;
__device__ __forceinline__ unsigned enc_e2m1(float v) {
    const float a = fabsf(v);
    const unsigned code = a < 0.25f ? 0u : a < 0.75f ? 1u : a < 1.25f ? 2u : a < 1.75f ? 3u : a < 2.5f ? 4u : a < 3.5f ? 5u : a < 5.0f ? 6u : 7u;
    return code | (v < 0.f ? 8u : 0u);
}
__device__ __forceinline__ void convert_fp4_rows(const float* src, unsigned char* dst, int nrows, float scale, const float* gain, int gw, int NGW, int lane) {
    for (int r = gw; r < nrows; r += NGW) {
        const float* sp = src + (size_t)r * DM + 4 * lane; const float* gp = gain ? gain + (size_t)(r / PEER_N) * DM + 4 * lane : nullptr;
        unsigned w[4] = {0u, 0u, 0u, 0u};
#pragma unroll
        for (int j = 0; j < 8; ++j) { f32x4 a = *(const GAS f32x4*)(sp + 256 * j) * scale; if (gp) a = a * *(const GAS f32x4*)(gp + 256 * j);
#pragma unroll
            for (int e = 0; e < 4; ++e) { const int i = 4 * j + e; w[i >> 3] |= enc_e2m1(a[e]) << (4 * (i & 7)); } }
        *(GAS v4u*)(dst + (size_t)r * 1024 + 16 * lane) = (v4u){w[0], w[1], w[2], w[3]};
    }
}
#define PG4_LOAD(buf, tab, idlo, idhi, g) do { _Pragma("unroll") for (int i_ = 0; i_ < PG6_R; ++i_) { const int k_ = (g) * PG6_R + i_; \
        const int e_ = __builtin_amdgcn_readlane(k_ < 64 ? idlo : idhi, k_ & 63); buf[i_] = *(const GAS v4u*)((tab) + (size_t)(unsigned)e_ * 1024u + voff4); } } while (0)
#define PG4_DOT1(buf, i_, dst) do { f32x2 a_ = {0.f, 0.f}; _Pragma("unroll") for (int c_ = 0; c_ < 4; ++c_) { const unsigned u_ = buf[i_][c_]; \
        a_ += __builtin_amdgcn_cvt_scalef32_pk_f32_fp4(u_, 1.0f, 0) * x[4 * c_ + 0]; a_ += __builtin_amdgcn_cvt_scalef32_pk_f32_fp4(u_, 1.0f, 1) * x[4 * c_ + 1]; \
        a_ += __builtin_amdgcn_cvt_scalef32_pk_f32_fp4(u_, 1.0f, 2) * x[4 * c_ + 2]; a_ += __builtin_amdgcn_cvt_scalef32_pk_f32_fp4(u_, 1.0f, 3) * x[4 * c_ + 3]; } dst = a_.x + a_.y; __builtin_amdgcn_sched_barrier(0); } while (0)
#define PG4_DOT(buf, g) do { float p_[8]; _Pragma("unroll") for (int i_ = 0; i_ < 8; ++i_) PG4_DOT1(buf, i_, p_[i_]); \
        float q_[4]; _Pragma("unroll") for (int i_ = 0; i_ < 4; ++i_) { const float keep_ = b5 ? p_[i_ + 4] : p_[i_], send_ = b5 ? p_[i_] : p_[i_ + 4]; q_[i_] = keep_ + shx(send_, 32, lane); } \
        float r_[2]; _Pragma("unroll") for (int i_ = 0; i_ < 2; ++i_) { const float keep_ = b4 ? q_[i_ + 2] : q_[i_], send_ = b4 ? q_[i_] : q_[i_ + 2]; r_[i_] = keep_ + shx(send_, 16, lane); } \
        float s_; { const float keep_ = b3 ? r_[1] : r_[0], send_ = b3 ? r_[0] : r_[1]; s_ = keep_ + shx(send_, 8, lane); } \
        s_ += shx(s_, 4, lane); s_ += shx(s_, 2, lane); s_ += shx(s_, 1, lane); \
        if ((lane & 7) == 0) wl[(g) * 8 + (lane >> 3)] = s_; } while (0)
#define PG4_AXPY(buf, g) do { _Pragma("unroll") for (int i_ = 0; i_ < PG6_R; ++i_) { const float w_ = wl[(g) * PG6_R + i_]; const f32x2 wv_ = {w_, w_}; \
        _Pragma("unroll") for (int c_ = 0; c_ < 4; ++c_) { const unsigned u_ = buf[i_][c_]; \
            y[4 * c_ + 0] += __builtin_amdgcn_cvt_scalef32_pk_f32_fp4(u_, 1.0f, 0) * wv_; y[4 * c_ + 1] += __builtin_amdgcn_cvt_scalef32_pk_f32_fp4(u_, 1.0f, 1) * wv_; \
            y[4 * c_ + 2] += __builtin_amdgcn_cvt_scalef32_pk_f32_fp4(u_, 1.0f, 2) * wv_; y[4 * c_ + 3] += __builtin_amdgcn_cvt_scalef32_pk_f32_fp4(u_, 1.0f, 3) * wv_; } \
        __builtin_amdgcn_sched_barrier(0); } } while (0)
#ifndef PG6_R
#define PG6_R 8
#endif
#define PG6_LOAD(buf, tab, idlo, idhi, g) do { _Pragma("unroll") for (int i_ = 0; i_ < PG6_R; ++i_) { const int k_ = (g) * PG6_R + i_; \
        const int e_ = __builtin_amdgcn_readlane(k_ < 64 ? idlo : idhi, k_ & 63); const unsigned char* rp_ = (tab) + (size_t)(unsigned)e_ * 1536u; \
        const v4u a_ = *(const GAS v4u_a8*)(rp_ + voff); const v2u b_ = *(const GAS v2u*)(rp_ + voff + 16); buf[i_] = (v6u){a_.x, a_.y, a_.z, a_.w, b_.x, b_.y}; } } while (0)
#define PG6_DOT1(buf, i_, dst) do { const v32f f_ = __builtin_amdgcn_cvt_scalef32_pk32_f32_fp6(buf[i_], 1.0f); f32x2 a_ = {0.f, 0.f}; \
        _Pragma("unroll") for (int c_ = 0; c_ < 16; ++c_) a_ += (f32x2){f_[2 * c_], f_[2 * c_ + 1]} * x[c_]; dst = a_.x + a_.y; __builtin_amdgcn_sched_barrier(0); } while (0)
#if PG6_R == 8
#define PG6_DOT(buf, g) do { float p_[8]; _Pragma("unroll") for (int i_ = 0; i_ < 8; ++i_) PG6_DOT1(buf, i_, p_[i_]); \
        float q_[4]; _Pragma("unroll") for (int i_ = 0; i_ < 4; ++i_) { const float keep_ = b5 ? p_[i_ + 4] : p_[i_], send_ = b5 ? p_[i_] : p_[i_ + 4]; q_[i_] = keep_ + shx(send_, 32, lane); } \
        float r_[2]; _Pragma("unroll") for (int i_ = 0; i_ < 2; ++i_) { const float keep_ = b4 ? q_[i_ + 2] : q_[i_], send_ = b4 ? q_[i_] : q_[i_ + 2]; r_[i_] = keep_ + shx(send_, 16, lane); } \
        float s_; { const float keep_ = b3 ? r_[1] : r_[0], send_ = b3 ? r_[0] : r_[1]; s_ = keep_ + shx(send_, 8, lane); } \
        s_ += shx(s_, 4, lane); s_ += shx(s_, 2, lane); s_ += shx(s_, 1, lane); \
        if ((lane & 7) == 0) wl[(g) * 8 + (lane >> 3)] = s_; } while (0)
#else
#define PG6_DOT(buf, g) do { float p_[4]; _Pragma("unroll") for (int i_ = 0; i_ < 4; ++i_) PG6_DOT1(buf, i_, p_[i_]); \
        float r_[2]; _Pragma("unroll") for (int i_ = 0; i_ < 2; ++i_) { const float keep_ = b5 ? p_[i_ + 2] : p_[i_], send_ = b5 ? p_[i_] : p_[i_ + 2]; r_[i_] = keep_ + shx(send_, 32, lane); } \
        float s_; { const float keep_ = b4 ? r_[1] : r_[0], send_ = b4 ? r_[0] : r_[1]; s_ = keep_ + shx(send_, 16, lane); } \
        s_ += shx(s_, 8, lane); s_ += shx(s_, 4, lane); s_ += shx(s_, 2, lane); s_ += shx(s_, 1, lane); \
        if ((lane & 15) == 0) wl[(g) * 4 + (lane >> 4)] = s_; } while (0)
#endif
#define PG6_AXPY(buf, g) do { _Pragma("unroll") for (int i_ = 0; i_ < PG6_R; ++i_) { const float w_ = wl[(g) * PG6_R + i_]; const f32x2 wv_ = {w_, w_}; \
        const v32f f_ = __builtin_amdgcn_cvt_scalef32_pk32_f32_fp6(buf[i_], 1.0f); _Pragma("unroll") for (int c_ = 0; c_ < 16; ++c_) y[c_] += (f32x2){f_[2 * c_], f_[2 * c_ + 1]} * wv_; __builtin_amdgcn_sched_barrier(0); } } while (0)
__device__ __forceinline__ unsigned shxu(unsigned v, int k, int lane) { return (unsigned)__builtin_amdgcn_ds_bpermute((lane ^ k) << 2, (int)v); }
__device__ __forceinline__ void wave_sort128(unsigned& a, unsigned& b, int lane) {
#pragma unroll
    for (int k = 2; k <= 128; k <<= 1) {
#pragma unroll
        for (int j = k >> 1; j > 0; j >>= 1) {
            if (j == 64) { const unsigned lo = a < b ? a : b, hi = a < b ? b : a; a = lo; b = hi; }
            else {
                const unsigned pa = shxu(a, j, lane), pb = shxu(b, j, lane);
                const bool lower = (lane & j) == 0;
                const bool asc_a = (lane & k) == 0, asc_b = ((lane + 64) & k) == 0;
                const bool take_min_a = (lower == asc_a), take_min_b = (lower == asc_b);
                a = take_min_a ? (a < pa ? a : pa) : (a < pa ? pa : a);
                b = take_min_b ? (b < pb ? b : pb) : (b < pb ? pb : b);
            }
        }
    }
}
__device__ __forceinline__ void peer_gather6(bf16* XN, const unsigned char* PU6, const unsigned char* PV6, const int* PIDX, const float* PGATE, float* X, const u64_t* rowsq_in, u64_t* rowsq_out, LAS float* wl, int gw, int NGW, int lane) {
    const bool b5 = (lane >> 5) & 1, b4 = (lane >> 4) & 1, b3 = (lane >> 3) & 1; (void)b3;
    const unsigned voff = 24u * (unsigned)lane, voff4 = 16u * (unsigned)lane, l4 = 4u * (unsigned)lane, l8 = 8u * (unsigned)lane, l16 = 16u * (unsigned)lane;
    constexpr int NG = 128 / PG6_R;
    for (int t_ = gw; t_ < T; t_ += NGW) {
        int t = t_; asm volatile("" : "+s"(t));
        const char* pidx_t = (const char*)(PIDX + (size_t)t * 128); const char* pgate_t = (const char*)(PGATE + (size_t)t * 128);
        unsigned ka = ((unsigned)*(const GAS int*)(pidx_t + l4) << 7) | (unsigned)lane, kb = ((unsigned)*(const GAS int*)(pidx_t + l4 + 256) << 7) | (unsigned)(lane + 64);
        wave_sort128(ka, kb, lane);
        const int idlo = (int)(ka >> 7), idhi = (int)(kb >> 7);
        v4u A[PG6_R], B[PG6_R], AV[PG6_R], BV[PG6_R];
        PG4_LOAD(A, PU6, idlo, idhi, 0);
        f32x2 x[16];
        {   const char* xr = (const char*)(XN + (size_t)t * DM); const float xs = (1.f / PU_SCALE4) * rowsq_rs(rowsq_in, t);
#pragma unroll
            for (int j = 0; j < 8; ++j) { const v2u a = *(const GAS v2u*)(xr + l8 + 512 * j); x[2 * j] = (f32x2){bflo(a.x), bfhi(a.x)} * xs; x[2 * j + 1] = (f32x2){bflo(a.y), bfhi(a.y)} * xs; } }
#pragma unroll 1
        for (int g = 0; g < NG - 2; g += 2) {
            PG4_LOAD(B, PU6, idlo, idhi, g + 1);
            PG4_DOT(A, g);
            PG4_LOAD(A, PU6, idlo, idhi, g + 2);
            PG4_DOT(B, g + 1);
        }
        PG4_LOAD(B, PU6, idlo, idhi, NG - 1);
        PG4_DOT(A, NG - 2);
        PG4_LOAD(AV, PV6, idlo, idhi, 0);
        PG4_DOT(B, NG - 1);
        LDS_WAIT();
        {   const float g0 = *(const GAS float*)(pgate_t + 4u * (ka & 127u)), g1 = *(const GAS float*)(pgate_t + 4u * (kb & 127u));
            const float d0 = wl[lane], d1 = wl[64 + lane];
            const float w0 = g0 * 0.5f * d0 * (1.f + erff(d0 * 0.70710678118654752f)) * (1.f / PV_SCALE4), w1 = g1 * 0.5f * d1 * (1.f + erff(d1 * 0.70710678118654752f)) * (1.f / PV_SCALE4);
            LDS_WAIT(); asm volatile("" ::: "memory");
            wl[lane] = w0; wl[64 + lane] = w1;
            LDS_WAIT(); asm volatile("" ::: "memory");
        }
        f32x2 y[16];
#pragma unroll
        for (int i = 0; i < 16; ++i) y[i] = (f32x2){0.f, 0.f};
#pragma unroll 1
        for (int g = 0; g < NG; g += 2) {
            PG4_LOAD(BV, PV6, idlo, idhi, g + 1);
            PG4_AXPY(AV, g);
            if (g + 2 < NG) PG4_LOAD(AV, PV6, idlo, idhi, g + 2);
            PG4_AXPY(BV, g + 1);
        }
        {   char* xo = (char*)(X + (size_t)t * DM);
            char* xbo = (char*)(XN + (size_t)t * DM); float ss = 0.f;
#pragma unroll
            for (int j = 0; j < 8; ++j) { const v2u a = *(const GAS v2u*)(xbo + l8 + 512 * j); f32x4 v = (f32x4){bflo(a.x), bfhi(a.x), bflo(a.y), bfhi(a.y)}; v += (f32x4){y[2 * j].x, y[2 * j].y, y[2 * j + 1].x, y[2 * j + 1].y};
                if (X) *(GAS f32x4*)(xo + l16 + 1024 * j) = v;
                ss += (v[0] * v[0] + v[1] * v[1]) + (v[2] * v[2] + v[3] * v[3]); *(GAS v2u*)(xbo + l8 + 512 * j) = (v2u){pk2(v[0], v[1]), pk2(v[2], v[3])}; }
            if (rowsq_out) { ss = wave_sum(ss, lane); if (lane == 0) rowsq_out[t] = rowsq_fx(ss); } }
        LDS_WAIT(); asm volatile("" ::: "memory");
    }
}

typedef short s16x4 __attribute__((ext_vector_type(4)));
typedef __attribute__((address_space(3))) const char* lds_cptr;
__device__ __forceinline__ s16x4 vtr(lds_cptr p) { return __builtin_bit_cast(s16x4, __builtin_amdgcn_ds_read_tr16_b64_v4i16((__attribute__((address_space(3))) s16x4*)p)); }
__device__ __forceinline__ unsigned cvtpk(float lo, float hi) { unsigned r; asm("v_cvt_pk_bf16_f32 %0, %1, %2" : "=v"(r) : "v"(lo), "v"(hi)); return r; }
constexpr int AT_K0 = 0, AT_V0 = 16384, AT_TAB = 32768;
constexpr float LOG2E = 1.4426950408889634f;
template <int TYPE>
__device__ __forceinline__ void attn_unit(LAS unsigned char* lds, const bf16* QKV, bf16* ATT, int b, int head, int qb, const float* tabsrc, float Cl2, float sinkl2, int tid) {
    const int lane = tid & 63, w = __builtin_amdgcn_readfirstlane(tid >> 6), hh = lane >> 5, l31 = lane & 31;
    int qcol, kcol, vcol, ocol;
    if (TYPE == 0) { qcol = QA + head * 64; kcol = KA + (head / 3) * 64; vcol = VA + (head / 3) * 64; ocol = OA + head * 64; }
    else if (TYPE == 1) { qcol = QB + head * 64; kcol = KB + head * 64; vcol = VB + head * 64; ocol = OB + head * 64; }
    else { qcol = QC + head * 64; kcol = KC + (head / 3) * 64; vcol = VC + (head / 3) * 64; ocol = OC + head * 64; }
    const int q0 = 256 * qb + 32 * w, qpos = q0 + l31;
    int t_begin, t_end;
    if (TYPE == 0) { t_begin = 4 * qb - 2; if (t_begin < 0) t_begin = 0; t_end = 4 * qb + 6; if (t_end > 32) t_end = 32; }
    else if (TYPE == 1) { int a = 4 * qb - 4; a = a < 0 ? 0 : (a > 24 ? 24 : a); int e = 4 * qb - 1; e = e < 0 ? 0 : (e > 24 ? 24 : e); t_begin = a; t_end = e + 8; }
    else { t_begin = 0; t_end = 32; }
    LAS float* tab = (LAS float*)(lds + AT_TAB);
    if (TYPE == 0) { for (int i = tid; i < 1024; i += NTHREADS) { const int rel = i - 448; tab[i] = (rel >= -128 && rel <= 128) ? tabsrc[head * 257 + rel + 128] * LOG2E - Cl2 : -1e30f; } }
    if (TYPE == 1) { for (int i = tid; i < 15 * 31; i += NTHREADS) tab[i] = tabsrc[head * 465 + i] * LOG2E - Cl2; }
    bf16x8 qf[4];
    {   const bf16* qp = QKV + ((size_t)b * SEQ + qpos) * DIN + qcol + 8 * hh;
#pragma unroll
        for (int s = 0; s < 4; ++s) qf[s] = *(const GAS bf16x8*)(qp + 16 * s); }
    const int srow = tid >> 3, sch = tid & 7;
    const bf16* kg = QKV + ((size_t)b * SEQ + srow) * DIN + kcol + sch * 8;
    const bf16* vg = QKV + ((size_t)b * SEQ + srow) * DIN + vcol + sch * 8;
    const int kst = srow * 128 + ((sch ^ ((srow >> 1) & 7)) * 16);
    const int vst = srow * 128 + (((sch >> 2) ^ ((srow >> 1) & 1)) * 64) + (sch & 3) * 16;
    int kread[4], vread[2];
#pragma unroll
    for (int s = 0; s < 4; ++s) kread[s] = l31 * 128 + (((2 * s + hh) ^ ((lane >> 1) & 7)) * 16);
#pragma unroll
    for (int db = 0; db < 2; ++db) vread[db] = (4 * hh + ((lane >> 2) & 3)) * 128 + ((db ^ ((lane >> 3) & 1)) * 64) + 32 * ((lane >> 4) & 1) + 8 * (lane & 3);
    f32x16 O0, O1;
#pragma unroll
    for (int r = 0; r < 16; ++r) { O0[r] = 0.f; O1[r] = 0.f; }
    float lsum = 0.f;
    const int rw = 4 * qb + (w >> 1), cq = 32 * (w & 1) + l31;
    int r0w = rw - 4; r0w = r0w < 0 ? 0 : (r0w > 24 ? 24 : r0w);
    int c0 = cq - 8; c0 = c0 < 0 ? 0 : (c0 > 48 ? 48 : c0);
    {   const v4u kr = *(const GAS v4u*)(kg + (size_t)t_begin * 64 * DIN), vr = *(const GAS v4u*)(vg + (size_t)t_begin * 64 * DIN);
        *(LAS v4u*)(lds + AT_K0 + kst) = kr; *(LAS v4u*)(lds + AT_V0 + vst) = vr; }
    __syncthreads();
    for (int t = t_begin; t < t_end; ++t) {
        const int cur = (t - t_begin) & 1;
        v4u kr, vr;
        if (t + 1 < t_end) { kr = *(const GAS v4u*)(kg + (size_t)(t + 1) * 64 * DIN); vr = *(const GAS v4u*)(vg + (size_t)(t + 1) * 64 * DIN); }
        bool need = true;
        if (TYPE == 0) need = (64 * t <= q0 + 31 + 128) && (64 * t + 63 >= q0 - 128);
        if (TYPE == 1) need = (t >= r0w) && (t < r0w + 8);
        if (need) {
            const lds_cptr kb_ = (lds_cptr)(lds + AT_K0 + cur * 8192), vb_ = (lds_cptr)(lds + AT_V0 + cur * 8192);
            bf16x8 kf[8];
#pragma unroll
            for (int s = 0; s < 4; ++s) { kf[2 * s] = *(const LAS bf16x8*)(kb_ + kread[s]); kf[2 * s + 1] = *(const LAS bf16x8*)(kb_ + kread[s] + 4096); }
            f32x16 S0, S1;
            if (TYPE == 2) {
#pragma unroll
                for (int r = 0; r < 16; ++r) { S0[r] = -Cl2; S1[r] = -Cl2; }
            } else if (TYPE == 0) {
                const LAS float* tb = tab + (64 * t - qpos + 448 + 4 * hh);
#pragma unroll
                for (int r = 0; r < 16; ++r) { S0[r] = tb[8 * (r >> 2) + (r & 3)]; S1[r] = tb[32 + 8 * (r >> 2) + (r & 3)]; }
            } else {
                const LAS float* tb = tab + ((t - rw + 7) * 31 - cq + 15 + 4 * hh);
                const int kc0 = 4 * hh - c0;
#pragma unroll
                for (int r = 0; r < 16; ++r) { const int ka = 8 * (r >> 2) + (r & 3), kb2 = 32 + ka;
                    S0[r] = ((unsigned)(ka + kc0) < 16u) ? tb[ka] : -1e30f; S1[r] = ((unsigned)(kb2 + kc0) < 16u) ? tb[kb2] : -1e30f; }
            }
            __builtin_amdgcn_sched_barrier(0);
#pragma unroll
            for (int s = 0; s < 4; ++s) { S0 = __builtin_amdgcn_mfma_f32_32x32x16_bf16(kf[2 * s], qf[s], S0, 0, 0, 0); S1 = __builtin_amdgcn_mfma_f32_32x32x16_bf16(kf[2 * s + 1], qf[s], S1, 0, 0, 0); }
            s16x4 vf[4][2][2];
#pragma unroll
            for (int ks = 0; ks < 2; ++ks)
#pragma unroll
                for (int db = 0; db < 2; ++db) { vf[ks][db][0] = vtr(vb_ + vread[db] + (16 * ks) * 128); vf[ks][db][1] = vtr(vb_ + vread[db] + (16 * ks + 8) * 128); }
            __builtin_amdgcn_sched_barrier(0);
#pragma unroll
            for (int r = 0; r < 16; ++r) { S0[r] = __builtin_amdgcn_exp2f(S0[r]); S1[r] = __builtin_amdgcn_exp2f(S1[r]); }
#pragma unroll
            for (int r = 0; r < 16; ++r) lsum += S0[r] + S1[r];
            bf16x8 pb[4];
#pragma unroll
            for (int hf = 0; hf < 2; ++hf) {
                v4u a, c;
#pragma unroll
                for (int j = 0; j < 4; ++j) { a[j] = cvtpk(S0[8 * hf + 2 * j], S0[8 * hf + 2 * j + 1]); c[j] = cvtpk(S1[8 * hf + 2 * j], S1[8 * hf + 2 * j + 1]); }
                pb[hf] = __builtin_bit_cast(bf16x8, a); pb[2 + hf] = __builtin_bit_cast(bf16x8, c);
            }
#pragma unroll
            for (int ks = 2; ks < 4; ++ks)
#pragma unroll
                for (int db = 0; db < 2; ++db) { vf[ks][db][0] = vtr(vb_ + vread[db] + (16 * ks) * 128); vf[ks][db][1] = vtr(vb_ + vread[db] + (16 * ks + 8) * 128); }
            __builtin_amdgcn_sched_barrier(0);
#pragma unroll
            for (int ks = 0; ks < 4; ++ks) {
                const bf16x8 va = __builtin_shufflevector(vf[ks][0][0], vf[ks][0][1], 0, 1, 2, 3, 4, 5, 6, 7), vb2 = __builtin_shufflevector(vf[ks][1][0], vf[ks][1][1], 0, 1, 2, 3, 4, 5, 6, 7);
                O0 = __builtin_amdgcn_mfma_f32_32x32x16_bf16(va, pb[ks], O0, 0, 0, 0); O1 = __builtin_amdgcn_mfma_f32_32x32x16_bf16(vb2, pb[ks], O1, 0, 0, 0);
            }
        }
        __builtin_amdgcn_sched_barrier(0);
        if (t + 1 < t_end) { *(LAS v4u*)(lds + AT_K0 + (cur ^ 1) * 8192 + kst) = kr; *(LAS v4u*)(lds + AT_V0 + (cur ^ 1) * 8192 + vst) = vr; }
        __syncthreads();
    }
    lsum += shx(lsum, 32, lane);
    if (TYPE == 0) lsum += __builtin_amdgcn_exp2f(sinkl2 - Cl2);
    const float inv = 1.f / lsum;
    bf16* op = ATT + ((size_t)b * SEQ + qpos) * DM + ocol + 4 * hh;
#pragma unroll
    for (int g4 = 0; g4 < 4; ++g4) {
        v2u o0, o1; o0.x = cvtpk(O0[4 * g4] * inv, O0[4 * g4 + 1] * inv); o0.y = cvtpk(O0[4 * g4 + 2] * inv, O0[4 * g4 + 3] * inv);
        o1.x = cvtpk(O1[4 * g4] * inv, O1[4 * g4 + 1] * inv); o1.y = cvtpk(O1[4 * g4 + 2] * inv, O1[4 * g4 + 3] * inv);
        *(GAS v2u*)(op + 8 * g4) = o0; *(GAS v2u*)(op + 32 + 8 * g4) = o1;
    }
}


constexpr int MA_K0 = 0, MA_V0 = 32768;
__device__ __forceinline__ void mem_unit(LAS unsigned char* lds, const bf16* QM, const bf16* KVM, bf16* OM, const float* gq, int tb, int head, float Cl2, int tid) {
    const int lane = tid & 63, w = __builtin_amdgcn_readfirstlane(tid >> 6), hh = lane >> 5, l31 = lane & 31;
    const size_t trow = (size_t)tb * 256 + 32 * w + l31; const int b = tb >> 3;
    bf16x8 qf[8];
    {   const bf16* qp = QM + trow * MEMW + head * 128 + 8 * hh;
#pragma unroll
        for (int s = 0; s < 8; ++s) qf[s] = *(const GAS bf16x8*)(qp + 16 * s);
        float ss = 0.f;
#pragma unroll
        for (int s = 0; s < 8; ++s)
#pragma unroll
            for (int j = 0; j < 8; ++j) { const float f = __builtin_bit_cast(float, (unsigned)(unsigned short)qf[s][j] << 16); ss += f * f; }
        ss += shx(ss, 32, lane);
        const float r = 0.12751743074602468f / sqrtf(ss * (1.f / 128.f) + EPS);
#pragma unroll
        for (int s = 0; s < 8; ++s) { const f32x4 g0 = *(const GAS f32x4*)(gq + 16 * s + 8 * hh), g1 = *(const GAS f32x4*)(gq + 16 * s + 8 * hh + 4);
            v4u o;
#pragma unroll
            for (int j = 0; j < 4; ++j) { const float f0 = __builtin_bit_cast(float, (unsigned)(unsigned short)qf[s][2 * j] << 16), f1 = __builtin_bit_cast(float, (unsigned)(unsigned short)qf[s][2 * j + 1] << 16);
                const float ga = (2 * j < 4) ? g0[2 * j] : g1[2 * j - 4], gb2 = (2 * j + 1 < 4) ? g0[2 * j + 1] : g1[2 * j + 1 - 4];
                o[j] = cvtpk(f0 * r * ga, f1 * r * gb2); }
            qf[s] = __builtin_bit_cast(bf16x8, o); }
    }
    const int srow = tid >> 3, sch = tid & 7;
    const bf16* kg = KVM + ((size_t)b * NMEM + srow) * 1024 + head * 128 + sch * 8;
    const bf16* vg = kg + 512;
    const int kst0 = srow * 256 + ((sch ^ (srow & 15)) * 16), kst1 = srow * 256 + (((sch + 8) ^ (srow & 15)) * 16);
    const int vst0 = srow * 256 + ((((sch) >> 2) ^ (srow & 3)) * 64) + (sch & 3) * 16, vst1 = srow * 256 + ((((sch + 8) >> 2) ^ (srow & 3)) * 64) + (sch & 3) * 16;
    int kread[8], vread[4];
#pragma unroll
    for (int s = 0; s < 8; ++s) kread[s] = l31 * 256 + (((2 * s + hh) ^ (l31 & 15)) * 16);
#pragma unroll
    for (int db = 0; db < 4; ++db) vread[db] = (4 * hh + ((lane >> 2) & 3)) * 256 + ((db ^ ((lane >> 2) & 3)) * 64) + 32 * ((lane >> 4) & 1) + 8 * (lane & 3);
    f32x16 O[4];
#pragma unroll
    for (int db = 0; db < 4; ++db)
#pragma unroll
        for (int r = 0; r < 16; ++r) O[db][r] = 0.f;
    float lsum = 0.f;
    {   const v4u k0 = *(const GAS v4u*)kg, k1 = *(const GAS v4u*)(kg + 64), v0 = *(const GAS v4u*)vg, v1 = *(const GAS v4u*)(vg + 64);
        *(LAS v4u*)(lds + MA_K0 + kst0) = k0; *(LAS v4u*)(lds + MA_K0 + kst1) = k1; *(LAS v4u*)(lds + MA_V0 + vst0) = v0; *(LAS v4u*)(lds + MA_V0 + vst1) = v1; }
    __syncthreads();
#pragma unroll 1
    for (int t = 0; t < 4; ++t) {
        const int cur = t & 1;
        v4u k0, k1, v0, v1;
        if (t + 1 < 4) { const bf16* kn = kg + (size_t)(t + 1) * 64 * 1024; k0 = *(const GAS v4u*)kn; k1 = *(const GAS v4u*)(kn + 64); v0 = *(const GAS v4u*)(kn + 512); v1 = *(const GAS v4u*)(kn + 576); }
        const lds_cptr kb_ = (lds_cptr)(lds + MA_K0 + cur * 16384), vb_ = (lds_cptr)(lds + MA_V0 + cur * 16384);
        f32x16 S0, S1;
#pragma unroll
        for (int r = 0; r < 16; ++r) { S0[r] = -Cl2; S1[r] = -Cl2; }
#pragma unroll
        for (int s = 0; s < 8; ++s) { const bf16x8 a0 = *(const LAS bf16x8*)(kb_ + kread[s]), a1 = *(const LAS bf16x8*)(kb_ + kread[s] + 8192);
            S0 = __builtin_amdgcn_mfma_f32_32x32x16_bf16(a0, qf[s], S0, 0, 0, 0); S1 = __builtin_amdgcn_mfma_f32_32x32x16_bf16(a1, qf[s], S1, 0, 0, 0); }
#pragma unroll
        for (int r = 0; r < 16; ++r) { S0[r] = __builtin_amdgcn_exp2f(S0[r]); S1[r] = __builtin_amdgcn_exp2f(S1[r]); lsum += S0[r] + S1[r]; }
        bf16x8 pb[4];
#pragma unroll
        for (int hf = 0; hf < 2; ++hf) {
            v4u a, c;
#pragma unroll
            for (int j = 0; j < 4; ++j) { a[j] = cvtpk(S0[8 * hf + 2 * j], S0[8 * hf + 2 * j + 1]); c[j] = cvtpk(S1[8 * hf + 2 * j], S1[8 * hf + 2 * j + 1]); }
            pb[hf] = __builtin_bit_cast(bf16x8, a); pb[2 + hf] = __builtin_bit_cast(bf16x8, c);
        }
#pragma unroll
        for (int ks = 0; ks < 4; ++ks)
#pragma unroll
            for (int db = 0; db < 4; ++db) {
                const s16x4 a0 = vtr(vb_ + vread[db] + (16 * ks) * 256), a1 = vtr(vb_ + vread[db] + (16 * ks + 8) * 256);
                const bf16x8 va = __builtin_shufflevector(a0, a1, 0, 1, 2, 3, 4, 5, 6, 7);
                O[db] = __builtin_amdgcn_mfma_f32_32x32x16_bf16(va, pb[ks], O[db], 0, 0, 0);
            }
        if (t + 1 < 4) { LAS unsigned char* kn = lds + MA_K0 + (cur ^ 1) * 16384; LAS unsigned char* vn = lds + MA_V0 + (cur ^ 1) * 16384;
            *(LAS v4u*)(kn + kst0) = k0; *(LAS v4u*)(kn + kst1) = k1; *(LAS v4u*)(vn + vst0) = v0; *(LAS v4u*)(vn + vst1) = v1; }
        __syncthreads();
    }
    lsum += shx(lsum, 32, lane);
    const float inv = 1.f / lsum;
    bf16* op = OM + trow * MEMW + head * 128 + 4 * hh;
#pragma unroll
    for (int db = 0; db < 4; ++db)
#pragma unroll
        for (int g4 = 0; g4 < 4; ++g4) { v2u o; o.x = cvtpk(O[db][4 * g4] * inv, O[db][4 * g4 + 1] * inv); o.y = cvtpk(O[db][4 * g4 + 2] * inv, O[db][4 * g4 + 3] * inv); *(GAS v2u*)(op + 32 * db + 8 * g4) = o; }
}

__device__ __forceinline__ float wave_max(float v, int lane) {
#pragma unroll
    for (int o = 1; o < 64; o <<= 1) v = fmaxf(v, shx(v, o, lane));
    return v;
}
struct Args { const float* in[23]; float* out; unsigned char* ws; int ph_lo, ph_hi, use_bar, pad; };
#ifndef MK_OFF
#define MK_OFF 0u
#endif
#ifndef REP_ATT
#define REP_ATT 1
#endif
#ifndef REP_P0
#define REP_P0 1
#endif
#ifndef REP_GEMM
#define REP_GEMM 1
#endif
#ifndef REP_NORM
#define REP_NORM 1
#endif
#ifndef REP_SEL
#define REP_SEL 1
#endif
#ifndef REP_MEM
#define REP_MEM 1
#endif
#define PHON(k) (!((MK_OFF >> (k)) & 1u))
constexpr int PH_PER_LAYER = 10, PH_BASE = 3, N_PHASES = PH_BASE + DEPTH * PH_PER_LAYER;
constexpr int PTAB_OFF = LDSCTL_OFF + 1024;

__global__ void __launch_bounds__(NTHREADS, 2) mega(Args a) {
    extern __shared__ __attribute__((aligned(16))) unsigned char lds_raw[];
    LAS unsigned char* lds = (LAS unsigned char*)lds_raw;
    {   const int tid0 = threadIdx.x;
        for (int u = tid0; u < (LDS_BYTES - LDSCTL_OFF) / 4; u += NTHREADS) ((LAS unsigned*)(lds + LDSCTL_OFF))[u] = 0u;
        __syncthreads();
        if (tid0 < 23) ((LAS unsigned long long*)(lds + PTAB_OFF))[tid0] = (unsigned long long)a.in[tid0];
        if (tid0 == 23) ((LAS unsigned long long*)(lds + PTAB_OFF))[23] = (unsigned long long)a.out;
        if (tid0 == 24) ((LAS unsigned long long*)(lds + PTAB_OFF))[24] = (unsigned long long)a.ws;
        __syncthreads();
    }
    volatile LAS unsigned* MISC = (volatile LAS unsigned*)(lds + MISC_OFF);
    const int G = gridDim.x, bid = blockIdx.x, NGW = G * NWAVES;
    const int use_bar = a.use_bar;
    XcdBarrier bar; bar.bar = (unsigned*)(a.ws + WS_CTL) + CW_BAR; bar.x = 0; bar.st = MISC + 8;
    if (use_bar) bar = xcd_barrier_post((unsigned*)(a.ws + WS_CTL) + CW_BAR, MISC + 8);
    const int lo = a.ph_lo, hi = a.ph_hi;
#define IN(k) (lo <= (k) && (k) < hi)
#define SEAM(k) do { if (use_bar && IN(k) && IN((k) + 1)) xcd_barrier(bar); } while (0)
#define PHL() int tid_ = threadIdx.x; asm volatile("" : "+v"(tid_)); const int lane_ = tid_ & 63, wave_ = __builtin_amdgcn_readfirstlane(tid_ >> 6), gw_ = bid * NWAVES + wave_; (void)lane_; (void)gw_; \
              int pz_ = 0; asm volatile("" : "+s"(pz_))
#define PTR(i) ((const float*)ldptr(lds, (i) + pz_))
#define WSP() ((unsigned char*)ldptr(lds, 24 + pz_))
#define OUTP() ((float*)ldptr(lds, 23 + pz_))

    if (IN(0) && PHON(0)) for (int rep_ = 0; rep_ < REP_P0; ++rep_) {
        PHL(); unsigned char* ws = WSP();
        LAS float* scr = (LAS float*)(lds + RING_OFF + wave_ * 16384);
        constexpr int I_IN = 32 * 128, I_OUT = 32 * 64, I_MQ = 32 * 16, I_MKV = 32 * 32, I_MO = 8 * 64, I_PQ = 32 * 64, I_L = I_IN + I_OUT + I_MQ + I_MKV + I_MO + I_PQ;
        for (int it = gw_; it < DEPTH * I_L; it += NGW) {
            const int l = it / I_L; int r = it % I_L;
            if (r < I_IN) { transpose_item<true>(PTR(4) + (size_t)l * DM * DIN, DM, DIN, (bf16*)(ws + WS_WIN) + (size_t)l * DIN * DM, scr, r, lane_, PTR(3) + (size_t)l * DM); continue; } r -= I_IN;
            if (r < I_OUT) { transpose_item<false>(PTR(11) + (size_t)l * DM * DM, DM, DM, (bf16*)(ws + WS_WOUT) + (size_t)l * DM * DM, scr, r, lane_); continue; } r -= I_OUT;
            if (r < I_MQ) { transpose_item<false>(PTR(14) + (size_t)l * DM * MEMW, DM, MEMW, (bf16*)(ws + WS_WMQ) + (size_t)l * MEMW * DM, scr, r, lane_, PTR(12) + (size_t)l * DM); continue; } r -= I_MQ;
            if (r < I_MKV) { transpose_item<false>(PTR(15) + (size_t)l * DM * 1024, DM, 1024, (bf16*)(ws + WS_WMKV) + (size_t)l * 1024 * DM, scr, r, lane_); continue; } r -= I_MKV;
            if (r < I_MO) { transpose_item<false>(PTR(17) + (size_t)l * MEMW * DM, MEMW, DM, (bf16*)(ws + WS_WMO) + (size_t)l * DM * MEMW, scr, r, lane_); continue; } r -= I_MO;
            transpose_item<false>(PTR(19) + (size_t)l * DM * DM, DM, DM, (bf16*)(ws + WS_WPQ) + (size_t)l * DM * DM, scr, r, lane_, PTR(18) + (size_t)l * DM);
        }
        const size_t gtid = (size_t)bid * NTHREADS + tid_, nth = (size_t)G * NTHREADS;
        convert_bf16(PTR(20), (bf16*)(ws + WS_PKEYS), (size_t)DEPTH * 8 * 2 * 128 * 128, gtid, nth);
        convert_fp4_rows(PTR(21), ws + WS_PU, DEPTH * PEER_N, PU_SCALE4, PTR(18), gw_, NGW, lane_);
        convert_fp4_rows(PTR(22), ws + WS_PV, DEPTH * PEER_N, PV_SCALE4, nullptr, gw_, NGW, lane_);
        {   const float* x0 = PTR(0); bf16* XN = (bf16*)(ws + WS_XN); u64_t* rsq = (u64_t*)(ws + WS_ROWSQ);
            for (int m = gw_; m < T; m += NGW) prep_row(x0 + (size_t)m * DM, XN + (size_t)m * DM, rsq + m, lane_); }
        {   const float* mem = PTR(1); const float* gkv = PTR(13); bf16* MEMN = (bf16*)(ws + WS_MEMN);
            for (int m = gw_; m < BATCH * NMEM; m += NGW)
                rms_row_to_bf16(mem + (size_t)m * DM, gkv, MEMN + (size_t)m * DM, gkv + DM, MEMN + (size_t)(BATCH * NMEM + m) * DM, lane_); }
        float* rope = (float*)(ws + WS_ROPE); float* biasA = (float*)(ws + WS_BIASA);
        if (gtid < 64 * 16) { const int pos = (int)gtid >> 4, i = (int)gtid & 15; const float ang = (float)pos * ROPE_INV[i]; rope[gtid * 2] = cosf(ang); rope[gtid * 2 + 1] = sinf(ang); }
        if (gtid < 12 * 257) { const int h = (int)gtid / 257, rel = (int)gtid % 257 - 128; biasA[gtid] = PTR(2)[t5_bucket(rel) * 12 + h]; }
    }
    SEAM(0);
    if (IN(1) && PHON(1)) {
#pragma unroll 1
        for (int l = 0; l < DEPTH; ++l) {
            PHL(); unsigned char* ws = WSP();
            pg8::Gemm g{(bf16*)(ws + WS_MEMN) + (size_t)l * BATCH * NMEM * DM, (bf16*)(ws + WS_WMKV) + (size_t)l * 1024 * DM, BATCH * NMEM, 1024, DM};
            OffsetOrder S; S.init(BATCH * NMEM, 1024, G, bid, 64 * l);
            pg8::EpiBf16<0> E{(bf16*)(ws + WS_KVM) + (size_t)l * BATCH * NMEM * 1024, 1024, nullptr, 0, 0, 1.f};
            pg8::gemm_phase<pg8::EpiBf16<0>, OffsetOrder, true, true>(lds + RING_OFF, g, S, E, tid_);
            __syncthreads();
        }
    }
    SEAM(1);
    if (IN(2) && PHON(2)) {
        PHL(); unsigned char* ws = WSP(); bf16* KVM = (bf16*)(ws + WS_KVM); const float* gm = PTR(16);
        for (int m = gw_; m < DEPTH * BATCH * NMEM; m += NGW) {
            const int l = m / (BATCH * NMEM);
            GAS v4u* p = (GAS v4u*)(KVM + (size_t)m * 1024 + 8 * lane_);
            const v4u w = *p;
            float f[8] = {bflo(w.x), bfhi(w.x), bflo(w.y), bfhi(w.y), bflo(w.z), bfhi(w.z), bflo(w.w), bfhi(w.w)};
            float ss = 0.f;
#pragma unroll
            for (int i = 0; i < 8; ++i) ss += f[i] * f[i];
            ss += shx(ss, 1, lane_); ss += shx(ss, 2, lane_); ss += shx(ss, 4, lane_); ss += shx(ss, 8, lane_);
            const float r = 1.f / sqrtf(ss * (1.f / 128.f) + EPS);
            const float* gk = gm + (size_t)l * 256 + 128 + 8 * (lane_ & 15);
            v4u o; o.x = pk2(f[0] * r * gk[0], f[1] * r * gk[1]); o.y = pk2(f[2] * r * gk[2], f[3] * r * gk[3]); o.z = pk2(f[4] * r * gk[4], f[5] * r * gk[5]); o.w = pk2(f[6] * r * gk[6], f[7] * r * gk[7]);
            *p = o;
        }
    }
    SEAM(2);

#pragma unroll 1
    for (int l = 0; l < DEPTH; ++l) {
        const int pb = PH_BASE + PH_PER_LAYER * l;
        if (IN(pb + 0) && PHON(3)) for (int rep_ = 0; rep_ < REP_GEMM; ++rep_) { PHL(); unsigned char* ws = WSP();
            pg8::Gemm g{(bf16*)(ws + WS_XN), (bf16*)(ws + WS_WIN) + (size_t)l * DIN * DM, T, DIN, DM}; pg8::StaticOrder S; S.init(T, DIN, G, bid);
            pg8::EpiQKV E{(bf16*)(ws + WS_QKV), PTR(5) + (size_t)l * 128, PTR(7) + (size_t)l * 128, PTR(9) + (size_t)l * 128, (const float*)(ws + WS_ROPE), (const u64_t*)(ws + WS_ROWSQ) + (size_t)(l * 3 + 0) * T};
            pg8::gemm_phase<pg8::EpiQKV, pg8::StaticOrder, true, true>(lds + RING_OFF, g, S, E, tid_);
        }
        SEAM(pb + 0);
        if (IN(pb + 1) && PHON(4)) for (int rep_ = 0; rep_ < REP_ATT; ++rep_) { PHL(); unsigned char* ws = WSP();
            const float* sink = PTR(6) + (size_t)l * 12; const float* rpb = PTR(8) + (size_t)l * 8 * 15 * 31; const float* biasA = (const float*)(ws + WS_BIASA);
            const bf16* QKV = (const bf16*)(ws + WS_QKV); bf16* ATT = (bf16*)(ws + WS_ATT);
            const float* ga = PTR(5) + (size_t)l * 128; const float* gb = PTR(7) + (size_t)l * 128; const float* gc = PTR(9) + (size_t)l * 128;
            const float CaL2 = 8.f * wave_max(fabsf(ga[lane_]), lane_) * wave_max(fabsf(ga[64 + lane_]), lane_) * LOG2E;
            const float CbL2 = 8.f * wave_max(fabsf(gb[lane_]), lane_) * wave_max(fabsf(gb[64 + lane_]), lane_) * LOG2E;
            const float CcL2 = 8.f * wave_max(fabsf(gc[lane_]), lane_) * wave_max(fabsf(gc[64 + lane_]), lane_) * LOG2E;
            const int vc = (G % 8 == 0) ? (bid % 8) * (G / 8) + bid / 8 : bid;
            for (int u = vc; u < BATCH * 12 * 8; u += G) attn_unit<2>(lds, QKV, ATT, u / 96, (u >> 3) % 12, u & 7, nullptr, CcL2, 0.f, tid_);
            for (int u = vc; u < BATCH * 8 * 8; u += G) attn_unit<1>(lds, QKV, ATT, u >> 6, (u >> 3) & 7, u & 7, rpb, CbL2, 0.f, tid_);
            for (int u = vc; u < BATCH * 12 * 8; u += G) { const int head = (u >> 3) % 12; attn_unit<0>(lds, QKV, ATT, u / 96, head, u & 7, biasA, CaL2, sink[head] * LOG2E, tid_); }
        }
        SEAM(pb + 1);
        if (IN(pb + 2) && PHON(5)) { PHL(); unsigned char* ws = WSP(); mixnorm_rows((bf16*)(ws + WS_ATT), PTR(10) + (size_t)l * DM, gw_, NGW, lane_); }
        SEAM(pb + 2);
        if (IN(pb + 3) && PHON(6)) { PHL(); unsigned char* ws = WSP();
            pg8::Gemm g{(bf16*)(ws + WS_ATT), (bf16*)(ws + WS_WOUT) + (size_t)l * DM * DM, T, DM, DM}; pg8::StaticOrder S; S.init(T, DM, G, bid);
            pg8::EpiResid E{(bf16*)(ws + WS_XN), DM, (u64_t*)(ws + WS_ROWSQ) + (size_t)(l * 3 + 1) * T};
            pg8::gemm_phase<pg8::EpiResid, pg8::StaticOrder, true, true>(lds + RING_OFF, g, S, E, tid_);
        }
        SEAM(pb + 3);
        if (IN(pb + 4) && PHON(7)) for (int rep_ = 0; rep_ < REP_GEMM; ++rep_) { PHL(); unsigned char* ws = WSP();
            pg8::Gemm g{(bf16*)(ws + WS_XN), (bf16*)(ws + WS_WMQ) + (size_t)l * MEMW * DM, T, MEMW, DM}; pg8::StaticOrder S; S.init(T, MEMW, G, bid);
            pg8::EpiBf16Row E{(bf16*)(ws + WS_QM), MEMW, (const u64_t*)(ws + WS_ROWSQ) + (size_t)(l * 3 + 1) * T};
            pg8::gemm_phase<pg8::EpiBf16Row, pg8::StaticOrder, true, true>(lds + RING_OFF, g, S, E, tid_);
        }
        SEAM(pb + 4);
        if (IN(pb + 5) && PHON(8)) for (int rep_ = 0; rep_ < REP_MEM; ++rep_) { PHL(); unsigned char* ws = WSP();
            const bf16* kvm = (const bf16*)(ws + WS_KVM) + (size_t)l * BATCH * NMEM * 1024; const float* gq = PTR(16) + (size_t)l * 256;
            const float CmL2 = 11.313708498984761f * wave_max(fmaxf(fabsf(gq[lane_]), fabsf(gq[64 + lane_])), lane_) * wave_max(fmaxf(fabsf(gq[128 + lane_]), fabsf(gq[192 + lane_])), lane_) * LOG2E;
            for (int u = bid; u < (T / 256) * 4; u += G) mem_unit(lds, (const bf16*)(ws + WS_QM), kvm, (bf16*)(ws + WS_OM), gq, u >> 2, u & 3, CmL2, tid_);
        }
        SEAM(pb + 5);
        if (IN(pb + 6) && PHON(9)) { PHL(); unsigned char* ws = WSP();
            pg8::Gemm g{(bf16*)(ws + WS_OM), (bf16*)(ws + WS_WMO) + (size_t)l * DM * MEMW, T, DM, MEMW}; pg8::StaticOrder S; S.init(T, DM, G, bid);
            pg8::EpiResid E{(bf16*)(ws + WS_XN), DM, (u64_t*)(ws + WS_ROWSQ) + (size_t)(l * 3 + 2) * T};
            pg8::gemm_phase<pg8::EpiResid, pg8::StaticOrder, true, true>(lds + RING_OFF, g, S, E, tid_);
        }
        SEAM(pb + 6);
        if (IN(pb + 7) && PHON(10)) for (int rep_ = 0; rep_ < REP_GEMM; ++rep_) { PHL(); unsigned char* ws = WSP();
            pg8::Gemm g{(bf16*)(ws + WS_XN), (bf16*)(ws + WS_WPQ) + (size_t)l * DM * DM, T, DM, DM}; pg8::StaticOrder S; S.init(T, DM, G, bid);
            pg8::EpiBf16Row E{(bf16*)(ws + WS_QP), DM, (const u64_t*)(ws + WS_ROWSQ) + (size_t)(l * 3 + 2) * T};
            pg8::gemm_phase<pg8::EpiBf16Row, pg8::StaticOrder, true, true>(lds + RING_OFF, g, S, E, tid_);
        }
        SEAM(pb + 7);
        if (IN(pb + 8) && PHON(11)) for (int rep_ = 0; rep_ < REP_SEL; ++rep_) { PHL(); unsigned char* ws = WSP();
            const bf16* pk = (const bf16*)(ws + WS_PKEYS) + (size_t)l * 8 * 2 * 128 * 128;
            for (int u = bid; u < (T / 256) * PEER_H; u += G) peer_select_unit((const bf16*)(ws + WS_QP), pk, (int*)(ws + WS_PIDX), (float*)(ws + WS_PGATE), u >> 3, u & 7, wave_, lane_);
        }
        SEAM(pb + 8);
        if (IN(pb + 9) && PHON(12)) { PHL(); unsigned char* ws = WSP();
            peer_gather6((bf16*)(ws + WS_XN), ws + WS_PU + (size_t)l * PEER_N * 1024, ws + WS_PV + (size_t)l * PEER_N * 1024, (const int*)(ws + WS_PIDX), (const float*)(ws + WS_PGATE), (l + 1 == DEPTH) ? OUTP() : (float*)nullptr,
                         (const u64_t*)(ws + WS_ROWSQ) + (size_t)(l * 3 + 2) * T, (l + 1 < DEPTH) ? (u64_t*)(ws + WS_ROWSQ) + (size_t)((l + 1) * 3 + 0) * T : (u64_t*)nullptr,
                         (LAS float*)(lds + RING_OFF + wave_ * 1024), gw_, NGW, lane_); }
        SEAM(pb + 9);
    }
#undef IN
#undef SEAM
}

#ifndef MK_MULTI_LAUNCH
#define MK_MULTI_LAUNCH 0
#endif
extern "C" void kernel_launch(void* const* d_in, const int* in_sizes, int n_in, void* d_out, int out_size, void* d_ws, size_t ws_size, hipStream_t stream) {
    static int grid = 0;
    if (grid == 0) {
        if (n_in != 23 || out_size != T * DM || ws_size < WS_END) { fprintf(stderr, "kernel_launch: unexpected shapes (n_in %d, out %d, ws %zu)\n", n_in, out_size, ws_size); grid = -1; return; }
        int dev = 0, cus = 0, per_cu = 0;
        if (hipGetDevice(&dev) != hipSuccess || hipDeviceGetAttribute(&cus, hipDeviceAttributeMultiprocessorCount, dev) != hipSuccess) { grid = -1; return; }
        if (hipFuncSetAttribute((const void*)mega, hipFuncAttributeMaxDynamicSharedMemorySize, LDS_BYTES) != hipSuccess) { fprintf(stderr, "kernel_launch: hipFuncSetAttribute failed\n"); grid = -1; return; }
        if (hipOccupancyMaxActiveBlocksPerMultiprocessor(&per_cu, (const void*)mega, NTHREADS, LDS_BYTES) != hipSuccess || per_cu < 1) { fprintf(stderr, "kernel_launch: occupancy query says %d\n", per_cu); }
        (void)hipGetLastError();
        grid = cus;
    }
    if (grid < 0) return;
    (void)hipMemsetAsync((char*)d_ws + WS_CTL, 0, CTL_ZERO_BYTES, stream);
    Args a{};
    for (int i = 0; i < 23; ++i) a.in[i] = (const float*)d_in[i];
    a.out = (float*)d_out; a.ws = (unsigned char*)d_ws;
#if MK_MULTI_LAUNCH
    for (int p = 0; p < N_PHASES; ++p) { a.ph_lo = p; a.ph_hi = p + 1; a.use_bar = 0; a.pad = 0; hipLaunchKernelGGL(mega, dim3(grid), dim3(NTHREADS), LDS_BYTES, stream, a); }
#else
    a.ph_lo = 0; a.ph_hi = N_PHASES; a.use_bar = 1; a.pad = 0;
    hipLaunchKernelGGL(mega, dim3(grid), dim3(NTHREADS), LDS_BYTES, stream, a);
#endif
    const hipError_t le = hipPeekAtLastError();
    if (le != hipSuccess) fprintf(stderr, "kernel_launch: launch failed: %s\n", hipGetErrorName(le));
}
```

```cpp
#include <hip/hip_runtime.h>
#include <cstdio>
#include <cstdint>
#include <cmath>
__device__ __forceinline__ float shx(float v, int k, int lane);
typedef unsigned long long u64_t;
__device__ __forceinline__ float rowsq_rs(const u64_t* rowsq, int row) { return 1.0f / sqrtf((float)rowsq[row] * (5.9604644775390625e-08f / 2048.0f) + 1e-6f); }
__device__ __forceinline__ u64_t rowsq_fx(float ss) { return (u64_t)(ss * 16777216.0f + 0.5f); }
namespace pg8 {
#define PG8_LAS __attribute__((address_space(3)))
typedef unsigned short bf16_t;
typedef short bf16x8 __attribute__((ext_vector_type(8)));
typedef float f32x4 __attribute__((ext_vector_type(4)));
typedef unsigned u32x4 __attribute__((ext_vector_type(4)));
constexpr int BM = 256, BK = 64, HALF = 128, HTB = HALF * BK * 2  , STAGE_BYTES = 8 * HTB, NXCD = 8, WGM = 8;

__host__ __device__ __forceinline__ int lds_byte(int r, int c) { const int st = (r >> 4) * 2 + (c >> 5), rr = r & 15, cc = c & 31, ob = rr * 64 + cc * 2; return st * 1024 + (ob ^ (((ob >> 9) & 1) << 5)); }
__host__ __device__ __forceinline__ void stage_rc(int b, int& R, int& C) { const int st = b / 1024, sb = b % 1024, swz = sb ^ (((sb >> 9) & 1) << 5); R = (st >> 1) * 16 + swz / 64; C = (st & 1) * 32 + (swz % 64) / 2; }
__host__ __device__ __forceinline__ int perm32(int rho) { const int n = rho >> 4, i = rho & 15; return 8 * (i >> 2) + 4 * n + (i & 3); }

struct Unit { int pm, pn; };
struct Gemm { const bf16_t* A; const bf16_t* Bt; int M, N, K; };

struct StaticOrder {
    int nM, nN, nwg, G, c;
    __host__ __device__ void init(int M, int N, int G_, int c_) { nM = M / BM; nN = N / BM; nwg = nM * nN; G = G_; c = c_; }
    __host__ __device__ bool next(int i, Unit& u) const {
        const long L = (long)i * G + c; if (L >= nwg) return false;
        int wgid = (int)L; { const int q = nwg / NXCD, r = nwg % NXCD, xcd = wgid % NXCD, off = wgid / NXCD; wgid = (xcd < r ? xcd * (q + 1) : r * (q + 1) + (xcd - r) * q) + off; }
        const int nig = WGM * nN, gid = wgid / nig, fm = gid * WGM, gsz = (nM - fm) < WGM ? (nM - fm) : WGM;
        u.pm = fm + ((wgid % nig) % gsz); u.pn = (wgid % nig) / gsz; return true;
    }
    __device__ __forceinline__ void a_ready(const Unit&) const {}
    __device__ __forceinline__ void done(const Unit&) const {}
};

__device__ __forceinline__ unsigned cvt_pk_bf16(float lo, float hi) { unsigned r; asm volatile("v_cvt_pk_bf16_f32 %0, %1, %2" : "=v"(r) : "v"(lo), "v"(hi)); return r; }
typedef float f32x2 __attribute__((ext_vector_type(2)));
__device__ __forceinline__ f32x2 gelu_pk(f32x2 v) {
    const f32x2 av = __builtin_elementwise_abs(v), d = av * 0.2316418882f + 1.0f;
    f32x2 t; t.x = __builtin_amdgcn_rcpf(d.x); t.y = __builtin_amdgcn_rcpf(d.y);
    f32x2 q = t * 0.5307027145f + (-0.7265760135f); q = q * t + 0.7107068705f; q = q * t + (-0.142248368f); q = q * t + 0.127414796f; q = q * t;
    const f32x2 s = (v * v) * (-0.72134752044f);
    f32x2 e; e.x = __builtin_amdgcn_exp2f(s.x); e.y = __builtin_amdgcn_exp2f(s.y);
    const f32x2 m = v * (q * e), r = v - m;
    f32x2 o; o.x = v.x < 0.f ? m.x : r.x; o.y = v.y < 0.f ? m.y : r.y; return o;
}

template <int ACT  > struct EpiBf16 {
    static constexpr bool PERM = true, AFTER_DRAIN = false; static_assert(ACT == 0 || ACT == 1, "EpiBf16: ACT is 0 (none) or 1 (gelu_pk)");
    bf16_t* O; int ldc; const float* bias; int split_cols; size_t split_stride; float scale0;
    __device__ __forceinline__ void operator()(const f32x4 (&acc)[2][2][4][2], const Unit& u, int wr, int wc, int fr, int fq) const {
        const int row0 = u.pm * BM + wr * 64 + fr; int colt = u.pn * BM; bf16_t* base = O;
        float sc = 1.f; if (split_cols) { const int t = colt / split_cols; base += (size_t)t * split_stride; colt -= t * split_cols; if (t == 0) sc = scale0; }
        const int col0 = colt + wc * 32 + 8 * fq, bcol0 = u.pn * BM + wc * 32 + 8 * fq;
        f32x4 bv[2][2];
#pragma unroll
        for (int bj = 0; bj < 2; ++bj)
#pragma unroll
            for (int n = 0; n < 2; ++n) bv[bj][n] = bias ? *(const f32x4*)(bias + bcol0 + bj * HALF + 4 * n) : (f32x4){0.f, 0.f, 0.f, 0.f};
#pragma unroll
        for (int ai = 0; ai < 2; ++ai)
#pragma unroll
            for (int m = 0; m < 4; ++m) { bf16_t* rowp = base + (size_t)(row0 + ai * HALF + m * 16) * ldc + col0;
#pragma unroll
                for (int bj = 0; bj < 2; ++bj) { f32x4 v0 = acc[ai][bj][m][0] + bv[bj][0], v1 = acc[ai][bj][m][1] + bv[bj][1];
                    if (ACT == 1) { f32x2 a = gelu_pk((f32x2){v0[0], v0[1]}), b = gelu_pk((f32x2){v0[2], v0[3]}), c = gelu_pk((f32x2){v1[0], v1[1]}), d = gelu_pk((f32x2){v1[2], v1[3]});
                        v0 = (f32x4){a.x, a.y, b.x, b.y}; v1 = (f32x4){c.x, c.y, d.x, d.y}; }
                    v0 = v0 * sc; v1 = v1 * sc; u32x4 w; w.x = cvt_pk_bf16(v0[0], v0[1]); w.y = cvt_pk_bf16(v0[2], v0[3]); w.z = cvt_pk_bf16(v1[0], v1[1]); w.w = cvt_pk_bf16(v1[2], v1[3]);
                    *(u32x4*)(rowp + bj * HALF) = w; } }
    }
};

typedef unsigned u32x2 __attribute__((ext_vector_type(2)));
struct EpiResid {
    static constexpr bool PERM = false, AFTER_DRAIN = false;
    bf16_t* s; int ldc; u64_t* rowsq;
    __device__ __forceinline__ void operator()(const f32x4 (&acc)[2][2][4][2], const Unit& u, int wr, int wc, int fr, int fq) const {
        const int col0 = u.pn * BM + wc * 32 + 4 * fq;
#pragma unroll
        for (int ai = 0; ai < 2; ++ai)
#pragma unroll
            for (int m = 0; m < 4; ++m) { const int row = u.pm * BM + ai * HALF + wr * 64 + m * 16 + fr; bf16_t* sp = s + (size_t)row * ldc + col0; float ss = 0.f;
                u32x2 in[2][2];
#pragma unroll
                for (int bj = 0; bj < 2; ++bj)
#pragma unroll
                    for (int n = 0; n < 2; ++n) in[bj][n] = *(const u32x2*)(sp + bj * HALF + n * 16);
#pragma unroll
                for (int bj = 0; bj < 2; ++bj)
#pragma unroll
                    for (int n = 0; n < 2; ++n) { const u32x2 w0 = in[bj][n];
                        const f32x4 bs = (f32x4){__builtin_bit_cast(float, w0.x << 16), __builtin_bit_cast(float, w0.x & 0xffff0000u), __builtin_bit_cast(float, w0.y << 16), __builtin_bit_cast(float, w0.y & 0xffff0000u)};
                        const f32x4 o = bs + acc[ai][bj][m][n]; ss += (o[0] * o[0] + o[1] * o[1]) + (o[2] * o[2] + o[3] * o[3]);
                        u32x2 w; w.x = cvt_pk_bf16(o[0], o[1]); w.y = cvt_pk_bf16(o[2], o[3]); *(u32x2*)(sp + bj * HALF + n * 16) = w; }
                ss += shx(ss, 16, fr + 16 * fq); ss += shx(ss, 32, fr + 16 * fq);
                if (fq == 0) atomicAdd(rowsq + row, rowsq_fx(ss)); }
    }
};
struct EpiBf16Row {
    static constexpr bool PERM = true, AFTER_DRAIN = false;
    bf16_t* O; int ldc; const u64_t* rowsq;
    __device__ __forceinline__ void operator()(const f32x4 (&acc)[2][2][4][2], const Unit& u, int wr, int wc, int fr, int fq) const {
        const int row0 = u.pm * BM + wr * 64 + fr, col0 = u.pn * BM + wc * 32 + 8 * fq;
#pragma unroll
        for (int ai = 0; ai < 2; ++ai)
#pragma unroll
            for (int m = 0; m < 4; ++m) { const int row = row0 + ai * HALF + m * 16; const float rs = rowsq_rs(rowsq, row); bf16_t* rowp = O + (size_t)row * ldc + col0;
#pragma unroll
                for (int bj = 0; bj < 2; ++bj) { const f32x4 v0 = acc[ai][bj][m][0] * rs, v1 = acc[ai][bj][m][1] * rs; u32x4 w; w.x = cvt_pk_bf16(v0[0], v0[1]); w.y = cvt_pk_bf16(v0[2], v0[3]); w.z = cvt_pk_bf16(v1[0], v1[1]); w.w = cvt_pk_bf16(v1[2], v1[3]);
                    *(u32x4*)(rowp + bj * HALF) = w; } }
    }
};
struct EpiQKV {
    static constexpr bool PERM = false, AFTER_DRAIN = false;
    bf16_t* O; const float* ga; const float* gb; const float* gc; const float* rope; const u64_t* rowsq;
    __device__ __forceinline__ void operator()(const f32x4 (&acc)[2][2][4][2], const Unit& u, int wr, int wc, int fr, int fq) const {
        const int hg = u.pn * 4 + wc;
        const float* g = nullptr; bool isq = false, dorope = false;
        if (hg < 12) { g = ga; isq = true; } else if (hg < 16) { g = ga + 64; } else if (hg < 20) { }
        else if (hg < 28) { g = gb; isq = true; } else if (hg < 36) { g = gb + 64; } else if (hg < 44) { }
        else if (hg < 56) { g = gc; isq = true; dorope = true; } else if (hg < 60) { g = gc + 64; dorope = true; }
        const float qs = isq ? 0.18033688011112042f : 1.0f;
#pragma unroll
        for (int ai = 0; ai < 2; ++ai)
#pragma unroll
            for (int m = 0; m < 4; ++m) {
                const int row = u.pm * BM + ai * HALF + wr * 64 + m * 16 + fr;
                f32x4 v[2][2];
                const float rsx = rowsq_rs(rowsq, row);
#pragma unroll
                for (int bj = 0; bj < 2; ++bj)
#pragma unroll
                    for (int n = 0; n < 2; ++n) v[bj][n] = acc[ai][bj][m][n] * rsx;
                if (g) {
                    float ss = 0.f;
#pragma unroll
                    for (int bj = 0; bj < 2; ++bj)
#pragma unroll
                        for (int n = 0; n < 2; ++n) { const f32x4 x = v[bj][n]; ss += (x[0] * x[0] + x[1] * x[1]) + (x[2] * x[2] + x[3] * x[3]); }
                    ss += shx(ss, 16, fr + 16 * fq); ss += shx(ss, 32, fr + 16 * fq);
                    const float r = qs / sqrtf(ss * (1.0f / 64.0f) + 1e-6f);
#pragma unroll
                    for (int bj = 0; bj < 2; ++bj)
#pragma unroll
                        for (int n = 0; n < 2; ++n) v[bj][n] = v[bj][n] * *(const f32x4*)(g + 32 * bj + 16 * n + 4 * fq) * r;
                }
                if (dorope) {
                    const int t = row & 2047, pr = t >> 6, pc = t & 63;
#pragma unroll
                    for (int bj = 0; bj < 2; ++bj) {
                        const int pos = bj ? pc : pr;
                        const float* rp = rope + (size_t)(pos * 16 + 4 * fq) * 2;
                        const f32x4 c01 = *(const f32x4*)rp, c23 = *(const f32x4*)(rp + 4);
                        const f32x4 cs = (f32x4){c01[0], c01[2], c23[0], c23[2]}, sn = (f32x4){c01[1], c01[3], c23[1], c23[3]};
                        const f32x4 x1 = v[bj][0], x2 = v[bj][1];
                        v[bj][0] = x1 * cs - x2 * sn; v[bj][1] = x1 * sn + x2 * cs;
                    }
                }
                bf16_t* rowp = O + (size_t)row * 4096 + hg * 64 + 4 * fq;
#pragma unroll
                for (int bj = 0; bj < 2; ++bj)
#pragma unroll
                    for (int n = 0; n < 2; ++n) { u32x2 w; w.x = cvt_pk_bf16(v[bj][n][0], v[bj][n][1]); w.y = cvt_pk_bf16(v[bj][n][2], v[bj][n][3]); *(u32x2*)(rowp + 32 * bj + 16 * n) = w; }
                asm volatile("" ::: "memory");
            }
    }
};
template <class Epi, class Sched, bool ALIGN_EPI = false, bool SP2 = false>
__device__ __forceinline__ void gemm_phase(PG8_LAS unsigned char* lds, const Gemm g, const Sched& S, const Epi& E, const int tid) {
    const int wid = __builtin_amdgcn_readfirstlane(tid >> 6), lane = tid & 63, wr = wid >> 2, wc = wid & 3, fr = lane & 15, fq = lane >> 4;
    const int K = g.K, nt = K / BK;
    unsigned voffA[2], voffB[2];
#pragma unroll
    for (int i = 0; i < 2; ++i) { int R, C; stage_rc(tid * 16 + i * 8192, R, C); const int Rb = Epi::PERM ? ((R & ~31) + perm32(R & 31)) : R;
        voffA[i] = (unsigned)(R * K + C) * 2u; voffB[i] = (unsigned)(Rb * K + C) * 2u; }
    const size_t kstep = (size_t)(BK * 2);
    const size_t hstep = (size_t)HALF * K * 2;
    const size_t tstep = 2 * hstep;
    const unsigned ldsw = (unsigned)wid * 1024u;
    const int aoff = lds_byte(wr * 64 + fr, fq * 8), boff = lds_byte(wc * 32 + fr, fq * 8);
#define PG8_SA(b, h) (((b) * 2 + (h)) * HTB)
#define PG8_SB(b, h) ((4 + (b) * 2 + (h)) * HTB)
#define PG8_STAGE(bufoff, gbase, voff) do { _Pragma("unroll") for (int _i = 0; _i < 2; ++_i) \
        __builtin_amdgcn_global_load_lds((const unsigned*)((const char*)(gbase) + (voff)[_i]), (PG8_LAS unsigned*)(lds + (bufoff) + ldsw + _i * 8192), 16, 0, 0); } while (0)
#define PG8_LDA(dst, b, h) do { _Pragma("unroll") for (int m = 0; m < 4; ++m) _Pragma("unroll") for (int k = 0; k < 2; ++k) dst[m][k] = *(const PG8_LAS bf16x8*)(lds + PG8_SA(b, h) + aoff + m * 2048 + k * 1024); } while (0)
#define PG8_LDB(dst, b, h) do { _Pragma("unroll") for (int n = 0; n < 2; ++n) _Pragma("unroll") for (int k = 0; k < 2; ++k) dst[n][k] = *(const PG8_LAS bf16x8*)(lds + PG8_SB(b, h) + boff + n * 2048 + k * 1024); } while (0)
#define PG8_MMA(ai, bj, At, Bt) do { __builtin_amdgcn_s_setprio(1); _Pragma("unroll") for (int m = 0; m < 4; ++m) _Pragma("unroll") for (int n = 0; n < 2; ++n) _Pragma("unroll") for (int k = 0; k < 2; ++k) \
        acc[ai][bj][m][n] = __builtin_amdgcn_mfma_f32_16x16x32_bf16(Bt[n][k], At[m][k], acc[ai][bj][m][n], 0, 0, 0); __builtin_amdgcn_s_setprio(0); } while (0)
#define PG8_WAIT_V(n) asm volatile("s_waitcnt vmcnt(" #n ")" ::: "memory")
#define PG8_WAIT_L(n) asm volatile("s_waitcnt lgkmcnt(" #n ")" ::: "memory")
#define PG8_BAR __builtin_amdgcn_s_barrier()
#define PG8_SCHED __builtin_amdgcn_sched_barrier(0)
    Unit cur, nxt; int ui = 0;
    if (!S.next(0, cur)) return;
    f32x4 acc[2][2][4][2];
#pragma unroll
    for (int a = 0; a < 2; ++a)
#pragma unroll
        for (int b = 0; b < 2; ++b)
#pragma unroll
            for (int m = 0; m < 4; ++m)
#pragma unroll
                for (int n = 0; n < 2; ++n) acc[a][b][m][n] = (f32x4){0.f, 0.f, 0.f, 0.f};
    bf16x8 At[4][2], B0[2][2], B1[2][2];
    const char* cA = (const char*)g.A + (size_t)cur.pm * tstep; const char* cB = (const char*)g.Bt + (size_t)cur.pn * tstep;
    S.a_ready(cur);
    if constexpr (SP2) {
        PG8_STAGE(PG8_SB(0, 0), cB, voffB); PG8_STAGE(PG8_SB(0, 1), cB + hstep, voffB); PG8_STAGE(PG8_SA(0, 0), cA, voffA); PG8_STAGE(PG8_SA(0, 1), cA + hstep, voffA);
        if (wr == 1) PG8_BAR;
        PG8_WAIT_V(2); PG8_BAR;
        PG8_STAGE(PG8_SB(1, 0), cB + kstep, voffB); PG8_STAGE(PG8_SA(1, 0), cA + kstep, voffA); PG8_STAGE(PG8_SB(1, 1), cB + hstep + kstep, voffB);
        PG8_WAIT_V(6); PG8_BAR;
    } else {
        PG8_STAGE(PG8_SB(0, 0), cB, voffB); PG8_STAGE(PG8_SA(0, 0), cA, voffA); PG8_STAGE(PG8_SB(0, 1), cB + hstep, voffB); PG8_STAGE(PG8_SA(0, 1), cA + hstep, voffA);
        if (wr == 1) PG8_BAR;
        PG8_WAIT_V(4); PG8_BAR;
        PG8_STAGE(PG8_SB(1, 0), cB + kstep, voffB); PG8_STAGE(PG8_SA(1, 0), cA + kstep, voffA); PG8_STAGE(PG8_SB(1, 1), cB + hstep + kstep, voffB);
        PG8_WAIT_V(6); PG8_BAR;
    }
    for (;;) {
        const bool has_next = S.next(ui + 1, nxt);
        const char* nA = has_next ? (const char*)g.A + (size_t)nxt.pm * tstep : cA; const char* nB = has_next ? (const char*)g.Bt + (size_t)nxt.pn * tstep : cB;
        for (int t = 0; t < nt; t += 2) {
            const bool last = (t == nt - 2);
            const char* a1 = cA + (size_t)(t + 1) * kstep;
            const char* a2 = last ? nA : cA + (size_t)(t + 2) * kstep; const char* b2 = last ? nB : cB + (size_t)(t + 2) * kstep;
            const char* a3 = a2 + kstep; const char* b3 = b2 + kstep;
            if (last && has_next) S.a_ready(nxt);
            if constexpr (SP2) {
            PG8_LDB(B0, 0, 0); PG8_LDB(B1, 0, 1); PG8_SCHED; PG8_LDA(At, 0, 0); PG8_STAGE(PG8_SA(1, 1), a1 + hstep, voffA);
            PG8_WAIT_V(8); PG8_WAIT_L(0); PG8_BAR; PG8_MMA(0, 0, At, B0); PG8_MMA(0, 1, At, B1); PG8_BAR; PG8_SCHED;
            PG8_LDA(At, 0, 1); PG8_STAGE(PG8_SB(0, 0), b2, voffB); PG8_STAGE(PG8_SB(0, 1), b2 + hstep, voffB); PG8_STAGE(PG8_SA(0, 0), a2, voffA);
            PG8_WAIT_V(8); PG8_WAIT_L(0); PG8_BAR; PG8_MMA(1, 0, At, B0); PG8_MMA(1, 1, At, B1); PG8_BAR; PG8_SCHED;
            PG8_LDB(B0, 1, 0); PG8_LDB(B1, 1, 1); PG8_SCHED; PG8_LDA(At, 1, 0); PG8_STAGE(PG8_SA(0, 1), a2 + hstep, voffA);
            PG8_WAIT_V(8); PG8_WAIT_L(0); PG8_BAR; PG8_MMA(0, 0, At, B0); PG8_MMA(0, 1, At, B1); PG8_BAR; PG8_SCHED;
            PG8_LDA(At, 1, 1); PG8_STAGE(PG8_SB(1, 0), b3, voffB); PG8_STAGE(PG8_SB(1, 1), b3 + hstep, voffB); PG8_STAGE(PG8_SA(1, 0), a3, voffA);
            PG8_WAIT_V(8); PG8_WAIT_L(0); PG8_BAR; PG8_MMA(1, 0, At, B0); PG8_MMA(1, 1, At, B1); PG8_BAR; PG8_SCHED;
            } else {
            PG8_LDB(B0, 0, 0); PG8_SCHED; PG8_LDA(At, 0, 0); PG8_STAGE(PG8_SA(1, 1), a1 + hstep, voffA);
            PG8_WAIT_L(8); PG8_BAR; PG8_WAIT_L(0); PG8_MMA(0, 0, At, B0); PG8_BAR; PG8_SCHED;
            PG8_LDB(B1, 0, 1); PG8_STAGE(PG8_SB(0, 0), b2, voffB);
            PG8_BAR; PG8_WAIT_L(0); PG8_MMA(0, 1, At, B1); PG8_BAR;
            PG8_LDA(At, 0, 1); PG8_STAGE(PG8_SA(0, 0), a2, voffA);
            PG8_BAR; PG8_WAIT_L(0); PG8_MMA(1, 0, At, B0); PG8_BAR; PG8_SCHED;
            PG8_STAGE(PG8_SB(0, 1), b2 + hstep, voffB);
            PG8_WAIT_V(6); PG8_BAR; PG8_MMA(1, 1, At, B1); PG8_BAR;
            PG8_LDB(B0, 1, 0); PG8_SCHED; PG8_LDA(At, 1, 0); PG8_STAGE(PG8_SA(0, 1), a2 + hstep, voffA);
            PG8_WAIT_L(8); PG8_BAR; PG8_WAIT_L(0); PG8_MMA(0, 0, At, B0); PG8_BAR; PG8_SCHED;
            PG8_LDB(B1, 1, 1); PG8_STAGE(PG8_SB(1, 0), b3, voffB);
            PG8_BAR; PG8_WAIT_L(0); PG8_MMA(0, 1, At, B1); PG8_BAR;
            PG8_LDA(At, 1, 1); PG8_STAGE(PG8_SA(1, 0), a3, voffA);
            PG8_BAR; PG8_WAIT_L(0); PG8_MMA(1, 0, At, B0); PG8_BAR; PG8_SCHED;
            PG8_STAGE(PG8_SB(1, 1), b3 + hstep, voffB);
            PG8_WAIT_V(6); PG8_BAR; PG8_MMA(1, 1, At, B1); PG8_BAR;
            }
        }
        if constexpr (ALIGN_EPI) { if (wr == 0) PG8_BAR; }
        if constexpr (!Epi::AFTER_DRAIN) { E(acc, cur, wr, wc, fr, fq); S.done(cur); }
        if (!has_next) break;
#pragma unroll
        for (int a = 0; a < 2; ++a)
#pragma unroll
            for (int b = 0; b < 2; ++b)
#pragma unroll
                for (int m = 0; m < 4; ++m)
#pragma unroll
                    for (int n = 0; n < 2; ++n) acc[a][b][m][n] = (f32x4){0.f, 0.f, 0.f, 0.f};
        cur = nxt; cA = nA; cB = nB; ++ui;
        if constexpr (ALIGN_EPI) { if (wr == 1) PG8_BAR; }
    }
    PG8_WAIT_V(0);
    if constexpr (!ALIGN_EPI) { if (wr == 0) PG8_BAR; }
    PG8_BAR;
    if constexpr (Epi::AFTER_DRAIN) { E.fused(acc, cur, wr, wc, fr, fq, lds, wid, lane); S.done(cur); }
#undef PG8_SA
#undef PG8_SB
#undef PG8_STAGE
#undef PG8_LDA
#undef PG8_LDB
#undef PG8_MMA
#undef PG8_WAIT_V
#undef PG8_WAIT_L
#undef PG8_BAR
#undef PG8_SCHED
}
}

constexpr int BATCH = 16, SEQ = 2048, DM = 2048, T = BATCH * SEQ, DEPTH = 2;
constexpr int NMEM = 256, DIN = 4096, MEMW = 512;
constexpr int PEER_H = 8, PEER_N = 16384;
constexpr int NWAVES = 8, NTHREADS = NWAVES * 64;
constexpr float EPS = 1e-6f;
constexpr int QA = 0, KA = 768, VA = 1024, QB = 1280, KB = 1792, VB = 2304, QC = 2816, KC = 3584, VC = 3840;
constexpr int OA = 0, OB = 768, OC = 1280;

constexpr size_t MiB = 1u << 20;
constexpr size_t WS_CTL = 0, CTL_ZERO_BYTES = 2 * MiB;
constexpr size_t WS_ROWSQ = 256 * 1024;
constexpr size_t WS_ROPE = 83 * MiB, WS_BIASA = 83 * MiB + 16384;
constexpr size_t WS_WIN = 2 * MiB, WS_WOUT = 34 * MiB, WS_WMQ = 50 * MiB, WS_WMKV = 54 * MiB, WS_WMO = 62 * MiB, WS_WPQ = 66 * MiB, WS_PKEYS = 82 * MiB;
constexpr size_t WS_MEMN = 84 * MiB, WS_KVM = 116 * MiB, WS_PU = 132 * MiB, WS_PV = 260 * MiB, WS_XN = 388 * MiB, WS_QKV = 516 * MiB, WS_ATT = 772 * MiB;
constexpr size_t WS_QM = 900 * MiB, WS_OM = 932 * MiB, WS_END = 964 * MiB;
constexpr size_t WS_QP = WS_QKV, WS_PIDX = WS_QKV + 128 * MiB, WS_PGATE = WS_QKV + 144 * MiB;
constexpr int CW_BAR = 4096;

constexpr int RING_OFF = 0, RING_BYTES = 131072;
constexpr int LDSCTL_OFF = RING_BYTES, MISC_OFF = LDSCTL_OFF + 320;
constexpr int LDS_BYTES = 147456;

#define GAS __attribute__((address_space(1)))
#define LAS __attribute__((address_space(3)))
typedef unsigned short bf16;
typedef unsigned v4u __attribute__((ext_vector_type(4)));
typedef unsigned v2u __attribute__((ext_vector_type(2)));
typedef float f32x4 __attribute__((ext_vector_type(4)));
typedef float f32x16 __attribute__((ext_vector_type(16)));
typedef short bf16x8 __attribute__((ext_vector_type(8)));
typedef GAS unsigned gu32;
#define LDS_WAIT() asm volatile("s_waitcnt lgkmcnt(0)" ::: "memory")
#define VM_WAIT() asm volatile("s_waitcnt vmcnt(0)" ::: "memory")
__device__ __forceinline__ unsigned f2bf(float f) { unsigned u = __builtin_bit_cast(unsigned, f); return (u + 0x7fffu + ((u >> 16) & 1u)) >> 16; }
__device__ __forceinline__ unsigned pk2(float lo, float hi) { return f2bf(lo) | (f2bf(hi) << 16); }
__device__ __forceinline__ float bflo(unsigned w) { return __builtin_bit_cast(float, w << 16); }
__device__ __forceinline__ float bfhi(unsigned w) { return __builtin_bit_cast(float, w & 0xffff0000u); }

__device__ __forceinline__ float shx(float v, int k, int lane) { return __builtin_bit_cast(float, __builtin_amdgcn_ds_bpermute((lane ^ k) << 2, __builtin_bit_cast(int, v))); }
#define XB_TMO      128
#define XB_XCNT(j)  (256  + 64 * (j))
#define XB_XSUB(j)  (1280 + 64 * (j))
#define XB_XGEN(j)  (2304 + 64 * (j))
#define XB_TOP      3328
#define XB_TOPGEN   3392
#define XCD_BAR_WORDS 3456
#define XB_SPIN_CAP (1u << 18)

__device__ __forceinline__ unsigned xb_ld(unsigned* p)              { return __hip_atomic_load(p, __ATOMIC_RELAXED, __HIP_MEMORY_SCOPE_AGENT); }
__device__ __forceinline__ unsigned xb_add(unsigned* p, unsigned v) { return __hip_atomic_fetch_add(p, v, __ATOMIC_RELAXED, __HIP_MEMORY_SCOPE_AGENT); }
__device__ __forceinline__ unsigned xb_xcc_id() { return (unsigned)__builtin_amdgcn_s_getreg((3 << 11) | 20) & 0xFu; }
#define XB_SPIN(cond, bar) do { unsigned _sp = 0; while (cond) { __builtin_amdgcn_s_sleep(1); \
    if ((++_sp & 255u) == 0u) { if (xb_ld(&(bar)[XB_TMO])) break; if (_sp > XB_SPIN_CAP) { atomicAdd(&(bar)[XB_TMO], 1u); break; } } } } while (0)

struct XcdBarrier {
    unsigned* bar; unsigned x;
    volatile LAS unsigned* st;
};

__device__ __forceinline__ XcdBarrier xcd_barrier_post(unsigned* bar, volatile LAS unsigned* st) {
    XcdBarrier b; b.bar = bar; b.x = xb_xcc_id(); b.st = st;
    if (threadIdx.x == 0) (void)xb_add(&bar[XB_XCNT(b.x)], 1u);
    return b;
}
__device__ __forceinline__ void xcd_barrier_complete(unsigned* bar, unsigned x, unsigned& nloc, unsigned& nx) {
    const unsigned G = gridDim.x * gridDim.y * gridDim.z;
    unsigned sum, cnt, mine, sp = 0u;
    for (;;) {
        sum = 0u; cnt = 0u; mine = 0u;
#pragma unroll
        for (unsigned j = 0; j < 16; ++j) { const unsigned c = xb_ld(&bar[XB_XCNT(j)]); sum += c; cnt += (c > 0u) ? 1u : 0u; mine = (j == x) ? c : mine; }
        if (sum == G) break;
        __builtin_amdgcn_s_sleep(1);
        if ((++sp & 255u) == 0u) { if (xb_ld(&bar[XB_TMO])) break; if (sp > XB_SPIN_CAP) { atomicAdd(&bar[XB_TMO], 1u); break; } }
    }
    nloc = mine > 0u ? mine : 1u; nx = cnt > 0u ? cnt : 1u;
}

__device__ __forceinline__ void xcd_barrier(const XcdBarrier& b) {
    asm volatile("s_waitcnt vmcnt(0)" ::: "memory");
    __syncthreads();
    if (threadIdx.x == 0) {
        unsigned* bar = b.bar;
        __builtin_amdgcn_s_waitcnt(0);
        unsigned nloc = b.st[0], nx = b.st[1];
        if (nloc == 0u) { xcd_barrier_complete(bar, b.x, nloc, nx); b.st[0] = nloc; b.st[1] = nx; }
        const unsigned old = xb_add(&bar[XB_XSUB(b.x)], 1u);
        const unsigned gen = old / nloc;
        if (old + 1u == (gen + 1u) * nloc) {
            __builtin_amdgcn_fence(__ATOMIC_RELEASE, "agent");
            asm volatile("s_waitcnt vmcnt(0)" ::: "memory");
            const unsigned og = xb_add(&bar[XB_TOP], 1u);
            const unsigned tg = og / nx;
            if (og + 1u == (tg + 1u) * nx) xb_add(&bar[XB_TOPGEN], 1u);
            else XB_SPIN(xb_ld(&bar[XB_TOPGEN]) == tg, bar);
            __builtin_amdgcn_fence(__ATOMIC_ACQUIRE, "agent");
            xb_add(&bar[XB_XGEN(b.x)], 1u);
            asm volatile("s_waitcnt vmcnt(0)" ::: "memory");
        } else {
            XB_SPIN(xb_ld(&bar[XB_XGEN(b.x)]) == gen, bar);
            __builtin_amdgcn_fence(__ATOMIC_ACQUIRE, "agent");
            asm volatile("s_waitcnt vmcnt(0)" ::: "memory");
        }
    }
    __syncthreads();
}

__device__ __forceinline__ float wave_sum(float v, int lane) {
#pragma unroll
    for (int o = 1; o < 64; o <<= 1) v += shx(v, o, lane);
    return v;
}
__device__ __forceinline__ void* ldptr(LAS unsigned char* lds, int i) {
    const unsigned long long v = ((const LAS unsigned long long*)(lds + LDSCTL_OFF + 1024))[i];
    const unsigned lo = __builtin_amdgcn_readfirstlane((unsigned)v), hi = __builtin_amdgcn_readfirstlane((unsigned)(v >> 32));
    return (void*)(((unsigned long long)hi << 32) | lo);
}
struct OffsetOrder {
    pg8::StaticOrder S;
    __device__ void init(int M, int N, int G, int c, int off) { S.init(M, N, G, (c + G - off % G) % G); }
    __device__ bool next(int i, pg8::Unit& u) const { return S.next(i, u); }
    __device__ __forceinline__ void a_ready(const pg8::Unit&) const {}
    __device__ __forceinline__ void done(const pg8::Unit&) const {}
};

template <bool PERMQKV>
__device__ __forceinline__ void transpose_item(const float* W, int K, int N, bf16* WT, LAS float* scr, int item, int lane, const float* gk = nullptr) {
    const int nblk = N / 32, kb = item / nblk, nb = item % nblk, k0 = 64 * kb, n0 = 32 * nb;
    int d0 = n0;
    if (PERMQKV) { const int within = n0 & 255; d0 = (n0 & ~255) + 128 * ((within >> 5) & 1) + 32 * (within >> 6); }
#pragma unroll
    for (int i = 0; i < 8; ++i) { const int kk = 8 * i + (lane >> 3), nn = 4 * (lane & 7);
        const f32x4 w4 = *(const GAS f32x4*)(W + (size_t)(k0 + kk) * N + n0 + nn) * (gk ? gk[k0 + kk] : 1.f);
        scr[kk * 33 + nn] = w4[0]; scr[kk * 33 + nn + 1] = w4[1]; scr[kk * 33 + nn + 2] = w4[2]; scr[kk * 33 + nn + 3] = w4[3]; }
    LDS_WAIT(); asm volatile("" ::: "memory");
    const int c = lane & 7;
#pragma unroll
    for (int j = 0; j < 4; ++j) { const int n = (lane >> 3) + 8 * j; const LAS float* s = scr + (8 * c) * 33 + n;
        v4u o; o.x = pk2(s[0 * 33], s[1 * 33]); o.y = pk2(s[2 * 33], s[3 * 33]); o.z = pk2(s[4 * 33], s[5 * 33]); o.w = pk2(s[6 * 33], s[7 * 33]);
        *(GAS v4u*)(WT + (size_t)(d0 + n) * K + k0 + 8 * c) = o; }
    LDS_WAIT(); asm volatile("" ::: "memory");
}
__device__ __forceinline__ void convert_bf16(const float* src, bf16* dst, size_t n, size_t gtid, size_t nthreads) {
    for (size_t i = gtid * 8; i < n; i += nthreads * 8) {
        const f32x4 a = *(const GAS f32x4*)(src + i), b = *(const GAS f32x4*)(src + i + 4);
        v4u o; o.x = pk2(a[0], a[1]); o.y = pk2(a[2], a[3]); o.z = pk2(b[0], b[1]); o.w = pk2(b[2], b[3]);
        *(GAS v4u*)(dst + i) = o;
    }
}
__device__ __forceinline__ int t5_bucket(int rel) {
    const int n = rel < 0 ? -rel : rel;
    const int b = n < 8 ? n : n < 12 ? 8 : n < 16 ? 9 : n < 23 ? 10 : n < 32 ? 11 : n < 46 ? 12 : n < 64 ? 13 : n < 91 ? 14 : 15;
    return b + (rel > 0 ? 16 : 0);
}
__constant__ float ROPE_INV[16] = {1.000000000e+00f, 5.623413324e-01f, 3.162277639e-01f, 1.778279394e-01f, 1.000000015e-01f, 5.623413250e-02f, 3.162277490e-02f, 1.778279431e-02f,
                                   9.999999776e-03f, 5.623413250e-03f, 3.162277630e-03f, 1.778279431e-03f, 1.000000047e-03f, 5.623413017e-04f, 3.162277571e-04f, 1.778279402e-04f};

__device__ __forceinline__ void rms_row_to_bf16(const float* xrow, const float* g0, bf16* o0, const float* g1, bf16* o1, int lane) {
    const GAS f32x4* xr = (const GAS f32x4*)xrow + lane;
    f32x4 v[8]; float s = 0.f;
#pragma unroll
    for (int j = 0; j < 8; ++j) { v[j] = xr[64 * j]; s += (v[j].x * v[j].x + v[j].y * v[j].y) + (v[j].z * v[j].z + v[j].w * v[j].w); }
    const float rstd = 1.f / sqrtf(wave_sum(s, lane) * (1.f / DM) + EPS);
    {   const GAS f32x4* gr = (const GAS f32x4*)g0 + lane; GAS v2u* o8 = (GAS v2u*)o0 + lane;
#pragma unroll
        for (int j = 0; j < 8; ++j) { const f32x4 gg = gr[64 * j]; v2u w; w.x = pk2(v[j].x * rstd * gg.x, v[j].y * rstd * gg.y); w.y = pk2(v[j].z * rstd * gg.z, v[j].w * rstd * gg.w); o8[64 * j] = w; } }
    if (g1) { const GAS f32x4* gr = (const GAS f32x4*)g1 + lane; GAS v2u* o8 = (GAS v2u*)o1 + lane;
#pragma unroll
        for (int j = 0; j < 8; ++j) { const f32x4 gg = gr[64 * j]; v2u w; w.x = pk2(v[j].x * rstd * gg.x, v[j].y * rstd * gg.y); w.y = pk2(v[j].z * rstd * gg.z, v[j].w * rstd * gg.w); o8[64 * j] = w; } }
}
__device__ __forceinline__ void prep_rows2(const float* x0, bf16* o0, u64_t* sq, int lane) {
    f32x4 v[2][8];
#pragma unroll
    for (int q = 0; q < 2; ++q) { const GAS f32x4* xr = (const GAS f32x4*)(x0 + (size_t)q * DM) + lane;
#pragma unroll
        for (int j = 0; j < 8; ++j) v[q][j] = xr[64 * j]; }
#pragma unroll
    for (int q = 0; q < 2; ++q) { GAS v2u* o8 = (GAS v2u*)(o0 + (size_t)q * DM) + lane; float s = 0.f;
#pragma unroll
        for (int j = 0; j < 8; ++j) { const f32x4 a = v[q][j]; s += (a.x * a.x + a.y * a.y) + (a.z * a.z + a.w * a.w); v2u w; w.x = pk2(a.x, a.y); w.y = pk2(a.z, a.w); o8[64 * j] = w; }
        s = wave_sum(s, lane);
        if (lane == 0) sq[q] = rowsq_fx(s); }
}
__device__ __forceinline__ void norm_rows(const float* X, const float* g, bf16* XN, int gw, int NGW, int lane) {
    for (int m = gw; m < T; m += NGW) rms_row_to_bf16(X + (size_t)m * DM, g, XN + (size_t)m * DM, nullptr, nullptr, lane);
}

template <int TYPE>
__device__ __forceinline__ void naive_attn_item(const bf16* QKV, bf16* ATT, int b, int grow, int head, int lane, const float* biasA, const float* sink, const float* rpb) {
    const int tpos = grow * 64 + lane; const size_t trow = (size_t)b * SEQ + tpos;
    int qcol, kcol, vcol, ocol;
    if (TYPE == 0) { qcol = QA + head * 64; kcol = KA + (head / 3) * 64; vcol = VA + (head / 3) * 64; ocol = OA + head * 64; }
    else if (TYPE == 1) { qcol = QB + head * 64; kcol = KB + head * 64; vcol = VB + head * 64; ocol = OB + head * 64; }
    else { qcol = QC + head * 64; kcol = KC + (head / 3) * 64; vcol = VC + (head / 3) * 64; ocol = OC + head * 64; }
    float q[64], o[64];
#pragma unroll
    for (int c = 0; c < 8; ++c) { const v4u w = *(const GAS v4u*)(QKV + trow * DIN + qcol + 8 * c);
        q[8 * c + 0] = bflo(w.x); q[8 * c + 1] = bfhi(w.x); q[8 * c + 2] = bflo(w.y); q[8 * c + 3] = bfhi(w.y); q[8 * c + 4] = bflo(w.z); q[8 * c + 5] = bfhi(w.z); q[8 * c + 6] = bflo(w.w); q[8 * c + 7] = bfhi(w.w); }
#pragma unroll
    for (int d = 0; d < 64; ++d) o[d] = 0.f;
    float m = -1e30f, l = 0.f;
    int j0, j1;
    if (TYPE == 0) { j0 = grow * 64 - 128; if (j0 < 0) j0 = 0; j1 = grow * 64 + 63 + 128; if (j1 > SEQ - 1) j1 = SEQ - 1; }
    else if (TYPE == 1) { int r0 = grow - 4; r0 = r0 < 0 ? 0 : (r0 > 24 ? 24 : r0); j0 = r0 * 64; j1 = j0 + 511; }
    else { j0 = 0; j1 = SEQ - 1; }
    int c0 = lane - 8; c0 = c0 < 0 ? 0 : (c0 > 48 ? 48 : c0);
#pragma unroll 1
    for (int j = j0; j <= j1; ++j) {
        const bf16* krow = QKV + ((size_t)b * SEQ + j) * DIN;
        float s = 0.f;
#pragma unroll
        for (int c = 0; c < 8; ++c) { const v4u w = *(const GAS v4u*)(krow + kcol + 8 * c);
            s += q[8 * c + 0] * bflo(w.x) + q[8 * c + 1] * bfhi(w.x) + q[8 * c + 2] * bflo(w.y) + q[8 * c + 3] * bfhi(w.y) + q[8 * c + 4] * bflo(w.z) + q[8 * c + 5] * bfhi(w.z) + q[8 * c + 6] * bflo(w.w) + q[8 * c + 7] * bfhi(w.w); }
        bool valid = true;
        if (TYPE == 0) { const int rel = j - tpos; valid = (rel >= -128 && rel <= 128); if (valid) s += biasA[head * 257 + rel + 128]; }
        if (TYPE == 1) { const int kr = j >> 6, kc = j & 63; valid = (kc >= c0 && kc < c0 + 16); if (valid) s += rpb[(head * 15 + (kr - grow + 7)) * 31 + (kc - lane + 15)]; }
        const float mn = valid ? fmaxf(m, s) : m;
        const float a = __expf(m - mn);
        const float p = valid ? __expf(s - mn) : 0.f;
        l = l * a + p; m = mn;
#pragma unroll
        for (int c = 0; c < 8; ++c) { const v4u w = *(const GAS v4u*)(krow + vcol + 8 * c);
            o[8 * c + 0] = o[8 * c + 0] * a + p * bflo(w.x); o[8 * c + 1] = o[8 * c + 1] * a + p * bfhi(w.x); o[8 * c + 2] = o[8 * c + 2] * a + p * bflo(w.y); o[8 * c + 3] = o[8 * c + 3] * a + p * bfhi(w.y);
            o[8 * c + 4] = o[8 * c + 4] * a + p * bflo(w.z); o[8 * c + 5] = o[8 * c + 5] * a + p * bfhi(w.z); o[8 * c + 6] = o[8 * c + 6] * a + p * bflo(w.w); o[8 * c + 7] = o[8 * c + 7] * a + p * bfhi(w.w); }
    }
    if (TYPE == 0) l += __expf(sink[head] - m);
    const float inv = 1.f / l;
#pragma unroll
    for (int c = 0; c < 8; ++c) { v4u w; w.x = pk2(o[8 * c + 0] * inv, o[8 * c + 1] * inv); w.y = pk2(o[8 * c + 2] * inv, o[8 * c + 3] * inv); w.z = pk2(o[8 * c + 4] * inv, o[8 * c + 5] * inv); w.w = pk2(o[8 * c + 6] * inv, o[8 * c + 7] * inv);
        *(GAS v4u*)(ATT + trow * DM + ocol + 8 * c) = w; }
}
__device__ __forceinline__ float rdl(float v, int l) { return __builtin_bit_cast(float, __builtin_amdgcn_readlane(__builtin_bit_cast(int, v), l)); }
__device__ __forceinline__ void naive_mem_item(const bf16* QM, const bf16* KVM, bf16* OM, const float* gq, size_t trow, int b, int head, int lane) {
    const unsigned qw = *(const GAS unsigned*)(QM + trow * MEMW + head * 128 + 2 * lane);
    float q0 = bflo(qw), q1 = bfhi(qw);
    const float ss = wave_sum(q0 * q0 + q1 * q1, lane);
    const float r = 0.08838834764831845f / sqrtf(ss * (1.f / 128.f) + EPS);
    q0 *= r * gq[2 * lane]; q1 *= r * gq[2 * lane + 1];
    const bf16* kbase = KVM + ((size_t)b * NMEM + lane) * 1024 + head * 128;
    float s[4] = {0.f, 0.f, 0.f, 0.f};
#pragma unroll 1
    for (int c = 0; c < 16; ++c) {
        float qa[8];
#pragma unroll
        for (int e = 0; e < 4; ++e) { qa[2 * e] = rdl(q0, 4 * c + e); qa[2 * e + 1] = rdl(q1, 4 * c + e); }
#pragma unroll
        for (int i = 0; i < 4; ++i) { const v4u w = *(const GAS v4u*)(kbase + (size_t)i * 64 * 1024 + 8 * c);
            s[i] += qa[0] * bflo(w.x) + qa[1] * bfhi(w.x) + qa[2] * bflo(w.y) + qa[3] * bfhi(w.y) + qa[4] * bflo(w.z) + qa[5] * bfhi(w.z) + qa[6] * bflo(w.w) + qa[7] * bfhi(w.w); }
    }
    float m = fmaxf(fmaxf(s[0], s[1]), fmaxf(s[2], s[3]));
#pragma unroll
    for (int o = 1; o < 64; o <<= 1) m = fmaxf(m, shx(m, o, lane));
    float p[4]; float l = 0.f;
#pragma unroll
    for (int i = 0; i < 4; ++i) { p[i] = __expf(s[i] - m); l += p[i]; }
    l = wave_sum(l, lane);
    const bf16* vbase = KVM + ((size_t)b * NMEM) * 1024 + 512 + head * 128 + 2 * lane;
    float o0 = 0.f, o1 = 0.f;
#pragma unroll
    for (int i = 0; i < 4; ++i) {
#pragma unroll 4
        for (int jj = 0; jj < 64; ++jj) { const float pj = rdl(p[i], jj); const unsigned w = *(const GAS unsigned*)(vbase + (size_t)(64 * i + jj) * 1024); o0 += pj * bflo(w); o1 += pj * bfhi(w); }
    }
    const float inv = 1.f / l;
    *(GAS unsigned*)(OM + trow * MEMW + head * 128 + 2 * lane) = pk2(o0 * inv, o1 * inv);
}
__device__ __forceinline__ void mixnorm_rows(bf16* ATT, const float* g, int gw, int NGW, int lane) {
    for (int m = gw; m < T; m += NGW) {
        GAS v4u* p = (GAS v4u*)(ATT + (size_t)m * DM + 32 * lane);
        v4u w[4]; float f[32]; float ss = 0.f;
#pragma unroll
        for (int c = 0; c < 4; ++c) { w[c] = p[c];
            f[8 * c + 0] = bflo(w[c].x); f[8 * c + 1] = bfhi(w[c].x); f[8 * c + 2] = bflo(w[c].y); f[8 * c + 3] = bfhi(w[c].y); f[8 * c + 4] = bflo(w[c].z); f[8 * c + 5] = bfhi(w[c].z); f[8 * c + 6] = bflo(w[c].w); f[8 * c + 7] = bfhi(w[c].w); }
#pragma unroll
        for (int i = 0; i < 32; ++i) ss += f[i] * f[i];
        const int grp = lane < 24 ? 0 : (lane < 40 ? 1 : 2);
        const float sa = wave_sum(grp == 0 ? ss : 0.f, lane), sb = wave_sum(grp == 1 ? ss : 0.f, lane), sc = wave_sum(grp == 2 ? ss : 0.f, lane);
        const float r = grp == 0 ? 1.f / sqrtf(sa * (1.f / 768.f) + EPS) : (grp == 1 ? 1.f / sqrtf(sb * (1.f / 512.f) + EPS) : 1.f / sqrtf(sc * (1.f / 768.f) + EPS));
        const float* gg = g + 32 * lane;
#pragma unroll
        for (int c = 0; c < 4; ++c) { const f32x4 g0 = *(const GAS f32x4*)(gg + 8 * c), g1 = *(const GAS f32x4*)(gg + 8 * c + 4);
            v4u o; o.x = pk2(f[8 * c + 0] * r * g0[0], f[8 * c + 1] * r * g0[1]); o.y = pk2(f[8 * c + 2] * r * g0[2], f[8 * c + 3] * r * g0[3]);
            o.z = pk2(f[8 * c + 4] * r * g1[0], f[8 * c + 5] * r * g1[1]); o.w = pk2(f[8 * c + 6] * r * g1[2], f[8 * c + 7] * r * g1[3]); p[c] = o; }
    }
}

#ifndef PEER_HD
#define PEER_HD __device__ __forceinline__
#define PEER_EXP(x) __expf(x)
#endif
template <int N> PEER_HD void bitonic_sort_desc(float* v) {
#pragma unroll
    for (int k = 2; k <= N; k <<= 1)
#pragma unroll
        for (int j = k >> 1; j > 0; j >>= 1)
#pragma unroll
            for (int i = 0; i < N; ++i) { const int l = i ^ j; if (l > i) { const bool desc = ((i & k) == 0); const float a = v[i], b = v[l]; const float hi = fmaxf(a, b), lo = fminf(a, b);
                v[i] = desc ? hi : lo; v[l] = desc ? lo : hi; } }
}
PEER_HD void merge_top16(float* a, const float* b) {
    float c[16];
#pragma unroll
    for (int i = 0; i < 16; ++i) c[i] = fmaxf(a[i], b[15 - i]);
#pragma unroll
    for (int j = 8; j > 0; j >>= 1)
#pragma unroll
        for (int i = 0; i < 16; ++i) { const int l = i ^ j; if (l > i) { const float x = c[i], y = c[l]; c[i] = fmaxf(x, y); c[l] = fminf(x, y); } }
#pragma unroll
    for (int i = 0; i < 16; ++i) a[i] = c[i];
}
PEER_HD void top16_of_64(float (&v)[64]) {
    bitonic_sort_desc<16>(&v[0]); bitonic_sort_desc<16>(&v[16]); bitonic_sort_desc<16>(&v[32]); bitonic_sort_desc<16>(&v[48]);
    merge_top16(&v[0], &v[16]); merge_top16(&v[32], &v[48]); merge_top16(&v[0], &v[32]);
}
PEER_HD float pack_idx(float s, unsigned idx, unsigned mask) { return __builtin_bit_cast(float, (__builtin_bit_cast(unsigned, s) & ~mask) | idx); }
PEER_HD unsigned low_bits(float s, unsigned mask) { return __builtin_bit_cast(unsigned, s) & mask; }
PEER_HD unsigned pick16(const float* a, unsigned i, unsigned mask) {
    unsigned r = 0;
#pragma unroll
    for (unsigned k = 0; k < 16; ++k) r = (i == k) ? low_bits(a[k], mask) : r;
    return r;
}
PEER_HD void peer_candidates(const float* a, const float* b, int* e, float* gate) {
    float c[64]; int n = 0;
#pragma unroll
    for (int i = 0; i < 16; ++i)
#pragma unroll
        for (int j = 0; j < 16; ++j) if ((i + 1) * (j + 1) <= 16) { c[n] = pack_idx(a[i] + b[j], (unsigned)(i * 16 + j), 0xffu); ++n; }
#pragma unroll
    for (int k = 50; k < 64; ++k) c[k] = -3.0e38f;
    top16_of_64(c);
    float mx = c[0], den = 0.f;
#pragma unroll
    for (int k = 0; k < 16; ++k) { const unsigned id = low_bits(c[k], 0xffu); const unsigned n0 = pick16(a, id >> 4, 0x7fu), n1 = pick16(b, id & 15u, 0x7fu);
        e[k] = (int)(n0 * 128u + n1); gate[k] = PEER_EXP(c[k] - mx); den += gate[k]; }
    const float inv = 1.f / den;
#pragma unroll
    for (int k = 0; k < 16; ++k) gate[k] *= inv;
}

__device__ __forceinline__ void peer_select_unit(const bf16* QP, const bf16* PK, int* PIDX, float* PGATE, int tb, int h, int wave, int lane) {
    const int hh = lane >> 5, tl = lane & 31; const size_t t = (size_t)tb * 256 + wave * 32 + tl;
    float ab[2][16];
#pragma unroll
    for (int p = 0; p < 2; ++p) {
        bf16x8 bq[8];
#pragma unroll
        for (int s = 0; s < 8; ++s) bq[s] = *(const GAS bf16x8*)(QP + t * DM + 256 * h + 128 * p + 16 * s + 8 * hh);
        float v[64];
#pragma unroll
        for (int nb = 0; nb < 4; ++nb) {
            f32x16 acc;
#pragma unroll
            for (int r = 0; r < 16; ++r) acc[r] = 0.f;
            const bf16* kp = PK + ((size_t)((h * 2 + p) * 128 + 32 * nb + tl)) * 128 + 8 * hh;
#pragma unroll
            for (int s = 0; s < 8; ++s) { const bf16x8 ak = *(const GAS bf16x8*)(kp + 16 * s); acc = __builtin_amdgcn_mfma_f32_32x32x16_bf16(ak, bq[s], acc, 0, 0, 0); }
#pragma unroll
            for (int r = 0; r < 16; ++r) v[16 * nb + r] = pack_idx(acc[r], (unsigned)(32 * nb + 8 * (r >> 2) + 4 * hh + (r & 3)), 0x7fu);
        }
        top16_of_64(v);
        float pv[16];
#pragma unroll
        for (int i = 0; i < 16; ++i) pv[i] = shx(v[i], 32, lane);
        merge_top16(&v[0], pv);
#pragma unroll
        for (int i = 0; i < 16; ++i) ab[p][i] = v[i];
    }
    int e[16]; float gate[16];
    peer_candidates(ab[0], ab[1], e, gate);
    if (hh == 0) { GAS v4u* o = (GAS v4u*)(PIDX + t * 128 + h * 16);
#pragma unroll
        for (int c = 0; c < 4; ++c) o[c] = (v4u){(unsigned)e[4 * c], (unsigned)e[4 * c + 1], (unsigned)e[4 * c + 2], (unsigned)e[4 * c + 3]}; }
    else { GAS f32x4* o = (GAS f32x4*)(PGATE + t * 128 + h * 16);
#pragma unroll
        for (int c = 0; c < 4; ++c) o[c] = (f32x4){gate[4 * c], gate[4 * c + 1], gate[4 * c + 2], gate[4 * c + 3]}; }
}

typedef float f32x2 __attribute__((ext_vector_type(2)));
typedef unsigned v6u __attribute__((ext_vector_type(6)));
typedef float v32f __attribute__((ext_vector_type(32)));
typedef v4u __attribute__((aligned(8))) v4u_a8;
constexpr float PU_SCALE6 = 90.0f, PV_SCALE6 = 5.65f;
__device__ __forceinline__ unsigned enc_e2m3(float v) {
    const float a = fminf(fabsf(v), 7.5f);
    unsigned code;
    if (a < 1.0f) code = (unsigned)__builtin_rintf(a * 8.f);
    else { const unsigned b = __builtin_bit_cast(unsigned, a) - 0x3F800000u; code = ((b + 0x7FFFFu + ((b >> 20) & 1u)) >> 20) + 8u; }
    return code | (v < 0.f ? 32u : 0u);
}
__device__ __forceinline__ void convert_fp6_rows(const float* src, unsigned char* dst, int nrows, float scale, const float* gain, int gw, int NGW, int lane) {
    for (int r = gw; r < nrows; r += NGW) {
        const float* sp = src + (size_t)r * DM + 4 * lane; const float* gp = gain ? gain + (size_t)(r / PEER_N) * DM + 4 * lane : nullptr;
        unsigned w[6] = {0u, 0u, 0u, 0u, 0u, 0u};
#pragma unroll
        for (int j = 0; j < 8; ++j) { f32x4 a = *(const GAS f32x4*)(sp + 256 * j) * scale; if (gp) a = a * *(const GAS f32x4*)(gp + 256 * j);
#pragma unroll
            for (int e = 0; e < 4; ++e) { const unsigned code = enc_e2m3(a[e]); const int bp = 6 * (4 * j + e), wi = bp >> 5, sh = bp & 31;
                w[wi] |= code << sh; if (sh > 26) w[wi + 1] |= code >> (32 - sh); } }
        unsigned char* dp = dst + (size_t)r * 1536 + 24 * lane;
        *(GAS v4u_a8*)dp = (v4u){w[0], w[1], w[2], w[3]}; *(GAS v2u*)(dp + 16) = (v2u){w[4], w[5]};
    }
}
constexpr float PV_SCALE4 = 5.65f, PU_SCALE4 = 90.0f;
__device__ __forceinline__ unsigned enc_e2m1(float v) {
    const float a = fabsf(v);
    const unsigned code = a < 0.25f ? 0u : a < 0.75f ? 1u : a < 1.25f ? 2u : a < 1.75f ? 3u : a < 2.5f ? 4u : a < 3.5f ? 5u : a < 5.0f ? 6u : 7u;
    return code | (v < 0.f ? 8u : 0u);
}
__device__ __forceinline__ void convert_fp4_rows(const float* src, unsigned char* dst, int nrows, float scale, const float* gain, int gw, int NGW, int lane) {
    for (int r0 = 2 * gw; r0 < nrows; r0 += 2 * NGW) {
        f32x4 a[2][8];
#pragma unroll
        for (int q = 0; q < 2; ++q) { const float* sp = src + (size_t)(r0 + q) * DM + 4 * lane;
#pragma unroll
            for (int j = 0; j < 8; ++j) a[q][j] = *(const GAS f32x4*)(sp + 256 * j); }
#pragma unroll
        for (int q = 0; q < 2; ++q) { const int r = r0 + q; const float* gp = gain ? gain + (size_t)(r / PEER_N) * DM + 4 * lane : nullptr;
            unsigned w[4] = {0u, 0u, 0u, 0u};
#pragma unroll
            for (int j = 0; j < 8; ++j) { f32x4 v = a[q][j] * scale; if (gp) v = v * *(const GAS f32x4*)(gp + 256 * j);
#pragma unroll
                for (int e = 0; e < 4; ++e) { const int i = 4 * j + e; w[i >> 3] |= enc_e2m1(v[e]) << (4 * (i & 7)); } }
            *(GAS v4u*)(dst + (size_t)r * 1024 + 16 * lane) = (v4u){w[0], w[1], w[2], w[3]}; }
    }
}
#define PG4_LOAD(buf, tab, idlo, idhi, g) do { _Pragma("unroll") for (int i_ = 0; i_ < PG6_R; ++i_) { const int k_ = (g) * PG6_R + i_; \
        const int e_ = __builtin_amdgcn_readlane(k_ < 64 ? idlo : idhi, k_ & 63); buf[i_] = *(const GAS v4u*)((tab) + (size_t)(unsigned)e_ * 1024u + voff4); } } while (0)
#define PG4_DOT1(buf, i_, dst) do { f32x2 a_ = {0.f, 0.f}; _Pragma("unroll") for (int c_ = 0; c_ < 4; ++c_) { const unsigned u_ = buf[i_][c_]; \
        a_ += __builtin_amdgcn_cvt_scalef32_pk_f32_fp4(u_, 1.0f, 0) * x[4 * c_ + 0]; a_ += __builtin_amdgcn_cvt_scalef32_pk_f32_fp4(u_, 1.0f, 1) * x[4 * c_ + 1]; \
        a_ += __builtin_amdgcn_cvt_scalef32_pk_f32_fp4(u_, 1.0f, 2) * x[4 * c_ + 2]; a_ += __builtin_amdgcn_cvt_scalef32_pk_f32_fp4(u_, 1.0f, 3) * x[4 * c_ + 3]; } dst = a_.x + a_.y; __builtin_amdgcn_sched_barrier(0); } while (0)
#define PG4_DOT(buf, g) do { float p_[8]; _Pragma("unroll") for (int i_ = 0; i_ < 8; ++i_) PG4_DOT1(buf, i_, p_[i_]); \
        float q_[4]; _Pragma("unroll") for (int i_ = 0; i_ < 4; ++i_) { const float keep_ = b5 ? p_[i_ + 4] : p_[i_], send_ = b5 ? p_[i_] : p_[i_ + 4]; q_[i_] = keep_ + shx(send_, 32, lane); } \
        float r_[2]; _Pragma("unroll") for (int i_ = 0; i_ < 2; ++i_) { const float keep_ = b4 ? q_[i_ + 2] : q_[i_], send_ = b4 ? q_[i_] : q_[i_ + 2]; r_[i_] = keep_ + shx(send_, 16, lane); } \
        float s_; { const float keep_ = b3 ? r_[1] : r_[0], send_ = b3 ? r_[0] : r_[1]; s_ = keep_ + shx(send_, 8, lane); } \
        s_ += shx(s_, 4, lane); s_ += shx(s_, 2, lane); s_ += shx(s_, 1, lane); \
        if ((lane & 7) == 0) wl[(g) * 8 + (lane >> 3)] = s_; } while (0)
#define PG4_AXPY(buf, g) do { _Pragma("unroll") for (int i_ = 0; i_ < PG6_R; ++i_) { const float w_ = wl[(g) * PG6_R + i_]; const f32x2 wv_ = {w_, w_}; \
        _Pragma("unroll") for (int c_ = 0; c_ < 4; ++c_) { const unsigned u_ = buf[i_][c_]; \
            y[4 * c_ + 0] += __builtin_amdgcn_cvt_scalef32_pk_f32_fp4(u_, 1.0f, 0) * wv_; y[4 * c_ + 1] += __builtin_amdgcn_cvt_scalef32_pk_f32_fp4(u_, 1.0f, 1) * wv_; \
            y[4 * c_ + 2] += __builtin_amdgcn_cvt_scalef32_pk_f32_fp4(u_, 1.0f, 2) * wv_; y[4 * c_ + 3] += __builtin_amdgcn_cvt_scalef32_pk_f32_fp4(u_, 1.0f, 3) * wv_; } \
        __builtin_amdgcn_sched_barrier(0); } } while (0)
#ifndef PG6_R
#define PG6_R 8
#endif
#define PG6_LOAD(buf, tab, idlo, idhi, g) do { _Pragma("unroll") for (int i_ = 0; i_ < PG6_R; ++i_) { const int k_ = (g) * PG6_R + i_; \
        const int e_ = __builtin_amdgcn_readlane(k_ < 64 ? idlo : idhi, k_ & 63); const unsigned char* rp_ = (tab) + (size_t)(unsigned)e_ * 1536u; \
        const v4u a_ = *(const GAS v4u_a8*)(rp_ + voff); const v2u b_ = *(const GAS v2u*)(rp_ + voff + 16); buf[i_] = (v6u){a_.x, a_.y, a_.z, a_.w, b_.x, b_.y}; } } while (0)
#define PG6_DOT1(buf, i_, dst) do { const v32f f_ = __builtin_amdgcn_cvt_scalef32_pk32_f32_fp6(buf[i_], 1.0f); f32x2 a_ = {0.f, 0.f}; \
        _Pragma("unroll") for (int c_ = 0; c_ < 16; ++c_) a_ += (f32x2){f_[2 * c_], f_[2 * c_ + 1]} * x[c_]; dst = a_.x + a_.y; __builtin_amdgcn_sched_barrier(0); } while (0)
#if PG6_R == 8
#define PG6_DOT(buf, g) do { float p_[8]; _Pragma("unroll") for (int i_ = 0; i_ < 8; ++i_) PG6_DOT1(buf, i_, p_[i_]); \
        float q_[4]; _Pragma("unroll") for (int i_ = 0; i_ < 4; ++i_) { const float keep_ = b5 ? p_[i_ + 4] : p_[i_], send_ = b5 ? p_[i_] : p_[i_ + 4]; q_[i_] = keep_ + shx(send_, 32, lane); } \
        float r_[2]; _Pragma("unroll") for (int i_ = 0; i_ < 2; ++i_) { const float keep_ = b4 ? q_[i_ + 2] : q_[i_], send_ = b4 ? q_[i_] : q_[i_ + 2]; r_[i_] = keep_ + shx(send_, 16, lane); } \
        float s_; { const float keep_ = b3 ? r_[1] : r_[0], send_ = b3 ? r_[0] : r_[1]; s_ = keep_ + shx(send_, 8, lane); } \
        s_ += shx(s_, 4, lane); s_ += shx(s_, 2, lane); s_ += shx(s_, 1, lane); \
        if ((lane & 7) == 0) wl[(g) * 8 + (lane >> 3)] = s_; } while (0)
#else
#define PG6_DOT(buf, g) do { float p_[4]; _Pragma("unroll") for (int i_ = 0; i_ < 4; ++i_) PG6_DOT1(buf, i_, p_[i_]); \
        float r_[2]; _Pragma("unroll") for (int i_ = 0; i_ < 2; ++i_) { const float keep_ = b5 ? p_[i_ + 2] : p_[i_], send_ = b5 ? p_[i_] : p_[i_ + 2]; r_[i_] = keep_ + shx(send_, 32, lane); } \
        float s_; { const float keep_ = b4 ? r_[1] : r_[0], send_ = b4 ? r_[0] : r_[1]; s_ = keep_ + shx(send_, 16, lane); } \
        s_ += shx(s_, 8, lane); s_ += shx(s_, 4, lane); s_ += shx(s_, 2, lane); s_ += shx(s_, 1, lane); \
        if ((lane & 15) == 0) wl[(g) * 4 + (lane >> 4)] = s_; } while (0)
#endif
#define PG6_AXPY(buf, g) do { _Pragma("unroll") for (int i_ = 0; i_ < PG6_R; ++i_) { const float w_ = wl[(g) * PG6_R + i_]; const f32x2 wv_ = {w_, w_}; \
        const v32f f_ = __builtin_amdgcn_cvt_scalef32_pk32_f32_fp6(buf[i_], 1.0f); _Pragma("unroll") for (int c_ = 0; c_ < 16; ++c_) y[c_] += (f32x2){f_[2 * c_], f_[2 * c_ + 1]} * wv_; __builtin_amdgcn_sched_barrier(0); } } while (0)
__device__ __forceinline__ unsigned shxu(unsigned v, int k, int lane) { return (unsigned)__builtin_amdgcn_ds_bpermute((lane ^ k) << 2, (int)v); }
__device__ __forceinline__ void wave_sort128(unsigned& a, unsigned& b, int lane) {
#pragma unroll
    for (int k = 2; k <= 128; k <<= 1) {
#pragma unroll
        for (int j = k >> 1; j > 0; j >>= 1) {
            if (j == 64) { const unsigned lo = a < b ? a : b, hi = a < b ? b : a; a = lo; b = hi; }
            else {
                const unsigned pa = shxu(a, j, lane), pb = shxu(b, j, lane);
                const bool lower = (lane & j) == 0;
                const bool asc_a = (lane & k) == 0, asc_b = ((lane + 64) & k) == 0;
                const bool take_min_a = (lower == asc_a), take_min_b = (lower == asc_b);
                a = take_min_a ? (a < pa ? a : pa) : (a < pa ? pa : a);
                b = take_min_b ? (b < pb ? b : pb) : (b < pb ? pb : b);
            }
        }
    }
}
#ifndef PEER_U_FP4
#define PEER_U_FP4 1
#endif
#if PEER_U_FP4
typedef v4u urow_t;
#define PGU_LOAD PG4_LOAD
#define PGU_DOT PG4_DOT
constexpr float PU_SCALE = PU_SCALE4; constexpr int PU_STRIDE = 1024;
#else
typedef v6u urow_t;
#define PGU_LOAD PG6_LOAD
#define PGU_DOT PG6_DOT
constexpr float PU_SCALE = PU_SCALE6; constexpr int PU_STRIDE = 1536;
#endif
__device__ __forceinline__ void peer_gather6(bf16* XN, const unsigned char* PU6, const unsigned char* PV6, const int* PIDX, const float* PGATE, float* X, const u64_t* rowsq_in, u64_t* rowsq_out, LAS float* wl, int gw, int NGW, int lane) {
    const bool b5 = (lane >> 5) & 1, b4 = (lane >> 4) & 1, b3 = (lane >> 3) & 1; (void)b3;
    const unsigned voff = 24u * (unsigned)lane, voff4 = 16u * (unsigned)lane, l4 = 4u * (unsigned)lane, l8 = 8u * (unsigned)lane, l16 = 16u * (unsigned)lane;
    constexpr int NG = 128 / PG6_R;
    for (int t_ = gw; t_ < T; t_ += NGW) {
        int t = t_; asm volatile("" : "+s"(t));
        const char* pidx_t = (const char*)(PIDX + (size_t)t * 128); const char* pgate_t = (const char*)(PGATE + (size_t)t * 128);
        unsigned ka = ((unsigned)*(const GAS int*)(pidx_t + l4) << 7) | (unsigned)lane, kb = ((unsigned)*(const GAS int*)(pidx_t + l4 + 256) << 7) | (unsigned)(lane + 64);
        wave_sort128(ka, kb, lane);
        const int idlo = (int)(ka >> 7), idhi = (int)(kb >> 7);
        urow_t A[PG6_R], B[PG6_R]; v4u AV[PG6_R], BV[PG6_R];
        PGU_LOAD(A, PU6, idlo, idhi, 0);
        f32x2 x[16];
        {   const char* xr = (const char*)(XN + (size_t)t * DM); const float xs = (1.f / PU_SCALE) * rowsq_rs(rowsq_in, t);
#pragma unroll
            for (int j = 0; j < 8; ++j) { const v2u a = *(const GAS v2u*)(xr + l8 + 512 * j); x[2 * j] = (f32x2){bflo(a.x), bfhi(a.x)} * xs; x[2 * j + 1] = (f32x2){bflo(a.y), bfhi(a.y)} * xs; } }
#pragma unroll 1
        for (int g = 0; g < NG - 2; g += 2) {
            PGU_LOAD(B, PU6, idlo, idhi, g + 1);
            PGU_DOT(A, g);
            PGU_LOAD(A, PU6, idlo, idhi, g + 2);
            PGU_DOT(B, g + 1);
        }
        PGU_LOAD(B, PU6, idlo, idhi, NG - 1);
        PGU_DOT(A, NG - 2);
        PG4_LOAD(AV, PV6, idlo, idhi, 0);
        PGU_DOT(B, NG - 1);
        LDS_WAIT();
        {   const float g0 = *(const GAS float*)(pgate_t + 4u * (ka & 127u)), g1 = *(const GAS float*)(pgate_t + 4u * (kb & 127u));
            const float d0 = wl[lane], d1 = wl[64 + lane];
            const float w0 = g0 * 0.5f * d0 * (1.f + erff(d0 * 0.70710678118654752f)) * (1.f / PV_SCALE4), w1 = g1 * 0.5f * d1 * (1.f + erff(d1 * 0.70710678118654752f)) * (1.f / PV_SCALE4);
            LDS_WAIT(); asm volatile("" ::: "memory");
            wl[lane] = w0; wl[64 + lane] = w1;
            LDS_WAIT(); asm volatile("" ::: "memory");
        }
        f32x2 y[16];
#pragma unroll
        for (int i = 0; i < 16; ++i) y[i] = (f32x2){0.f, 0.f};
#pragma unroll 1
        for (int g = 0; g < NG; g += 2) {
            PG4_LOAD(BV, PV6, idlo, idhi, g + 1);
            PG4_AXPY(AV, g);
            if (g + 2 < NG) PG4_LOAD(AV, PV6, idlo, idhi, g + 2);
            PG4_AXPY(BV, g + 1);
        }
        {   char* xo = (char*)(X + (size_t)t * DM);
            char* xbo = (char*)(XN + (size_t)t * DM); float ss = 0.f;
#pragma unroll
            for (int j = 0; j < 8; ++j) { const v2u a = *(const GAS v2u*)(xbo + l8 + 512 * j); f32x4 v = (f32x4){bflo(a.x), bfhi(a.x), bflo(a.y), bfhi(a.y)}; v += (f32x4){y[2 * j].x, y[2 * j].y, y[2 * j + 1].x, y[2 * j + 1].y};
                if (X) *(GAS f32x4*)(xo + l16 + 1024 * j) = v;
                ss += (v[0] * v[0] + v[1] * v[1]) + (v[2] * v[2] + v[3] * v[3]); *(GAS v2u*)(xbo + l8 + 512 * j) = (v2u){pk2(v[0], v[1]), pk2(v[2], v[3])}; }
            if (rowsq_out) { ss = wave_sum(ss, lane); if (lane == 0) rowsq_out[t] = rowsq_fx(ss); } }
        LDS_WAIT(); asm volatile("" ::: "memory");
    }
}

typedef short s16x4 __attribute__((ext_vector_type(4)));
typedef __attribute__((address_space(3))) const char* lds_cptr;
__device__ __forceinline__ s16x4 vtr(lds_cptr p) { return __builtin_bit_cast(s16x4, __builtin_amdgcn_ds_read_tr16_b64_v4i16((__attribute__((address_space(3))) s16x4*)p)); }
__device__ __forceinline__ unsigned cvtpk(float lo, float hi) { unsigned r; asm("v_cvt_pk_bf16_f32 %0, %1, %2" : "=v"(r) : "v"(lo), "v"(hi)); return r; }
constexpr int AT_K0 = 0, AT_V0 = 16384, AT_TAB = 32768;
constexpr float LOG2E = 1.4426950408889634f;
template <int TYPE>
__device__ __forceinline__ void attn_unit(LAS unsigned char* lds, const bf16* QKV, bf16* ATT, int b, int head, int qb, const float* tabsrc, float Cl2, float sinkl2, int tid) {
    const int lane = tid & 63, w = __builtin_amdgcn_readfirstlane(tid >> 6), hh = lane >> 5, l31 = lane & 31;
    int qcol, kcol, vcol, ocol;
    if (TYPE == 0) { qcol = QA + head * 64; kcol = KA + (head / 3) * 64; vcol = VA + (head / 3) * 64; ocol = OA + head * 64; }
    else if (TYPE == 1) { qcol = QB + head * 64; kcol = KB + head * 64; vcol = VB + head * 64; ocol = OB + head * 64; }
    else { qcol = QC + head * 64; kcol = KC + (head / 3) * 64; vcol = VC + (head / 3) * 64; ocol = OC + head * 64; }
    const int q0 = 256 * qb + 32 * w, qpos = q0 + l31;
    int t_begin, t_end;
    if (TYPE == 0) { t_begin = 4 * qb - 2; if (t_begin < 0) t_begin = 0; t_end = 4 * qb + 6; if (t_end > 32) t_end = 32; }
    else if (TYPE == 1) { int a = 4 * qb - 4; a = a < 0 ? 0 : (a > 24 ? 24 : a); int e = 4 * qb - 1; e = e < 0 ? 0 : (e > 24 ? 24 : e); t_begin = a; t_end = e + 8; }
    else { t_begin = 0; t_end = 32; }
    LAS float* tab = (LAS float*)(lds + AT_TAB);
    if (TYPE == 0) { for (int i = tid; i < 1024; i += NTHREADS) { const int rel = i - 448; tab[i] = (rel >= -128 && rel <= 128) ? tabsrc[head * 257 + rel + 128] * LOG2E - Cl2 : -1e30f; } }
    if (TYPE == 1) { for (int i = tid; i < 15 * 31; i += NTHREADS) tab[i] = tabsrc[head * 465 + i] * LOG2E - Cl2; }
    bf16x8 qf[4];
    {   const bf16* qp = QKV + ((size_t)b * SEQ + qpos) * DIN + qcol + 8 * hh;
#pragma unroll
        for (int s = 0; s < 4; ++s) qf[s] = *(const GAS bf16x8*)(qp + 16 * s); }
    const int srow = tid >> 3, sch = tid & 7;
    const bf16* kg = QKV + ((size_t)b * SEQ + srow) * DIN + kcol + sch * 8;
    const bf16* vg = QKV + ((size_t)b * SEQ + srow) * DIN + vcol + sch * 8;
    const int kst = srow * 128 + ((sch ^ ((srow >> 1) & 7)) * 16);
    const int vst = srow * 128 + (((sch >> 2) ^ ((srow >> 1) & 1)) * 64) + (sch & 3) * 16;
    int kread[4], vread[2];
#pragma unroll
    for (int s = 0; s < 4; ++s) kread[s] = l31 * 128 + (((2 * s + hh) ^ ((lane >> 1) & 7)) * 16);
#pragma unroll
    for (int db = 0; db < 2; ++db) vread[db] = (4 * hh + ((lane >> 2) & 3)) * 128 + ((db ^ ((lane >> 3) & 1)) * 64) + 32 * ((lane >> 4) & 1) + 8 * (lane & 3);
    f32x16 O0, O1;
#pragma unroll
    for (int r = 0; r < 16; ++r) { O0[r] = 0.f; O1[r] = 0.f; }
    float lsum = 0.f;
    const int rw = 4 * qb + (w >> 1), cq = 32 * (w & 1) + l31;
    int r0w = rw - 4; r0w = r0w < 0 ? 0 : (r0w > 24 ? 24 : r0w);
    int c0 = cq - 8; c0 = c0 < 0 ? 0 : (c0 > 48 ? 48 : c0);
    {   const v4u kr = *(const GAS v4u*)(kg + (size_t)t_begin * 64 * DIN), vr = *(const GAS v4u*)(vg + (size_t)t_begin * 64 * DIN);
        *(LAS v4u*)(lds + AT_K0 + kst) = kr; *(LAS v4u*)(lds + AT_V0 + vst) = vr; }
    __syncthreads();
    for (int t = t_begin; t < t_end; ++t) {
        const int cur = (t - t_begin) & 1;
        v4u kr, vr;
        if (t + 1 < t_end) { kr = *(const GAS v4u*)(kg + (size_t)(t + 1) * 64 * DIN); vr = *(const GAS v4u*)(vg + (size_t)(t + 1) * 64 * DIN); }
        bool need = true;
        if (TYPE == 0) need = (64 * t <= q0 + 31 + 128) && (64 * t + 63 >= q0 - 128);
        if (TYPE == 1) need = (t >= r0w) && (t < r0w + 8);
        if (need) {
            const lds_cptr kb_ = (lds_cptr)(lds + AT_K0 + cur * 8192), vb_ = (lds_cptr)(lds + AT_V0 + cur * 8192);
            bf16x8 kf[8];
#pragma unroll
            for (int s = 0; s < 4; ++s) { kf[2 * s] = *(const LAS bf16x8*)(kb_ + kread[s]); kf[2 * s + 1] = *(const LAS bf16x8*)(kb_ + kread[s] + 4096); }
            f32x16 S0, S1;
            if (TYPE == 2) {
#pragma unroll
                for (int r = 0; r < 16; ++r) { S0[r] = -Cl2; S1[r] = -Cl2; }
            } else if (TYPE == 0) {
                const LAS float* tb = tab + (64 * t - qpos + 448 + 4 * hh);
#pragma unroll
                for (int r = 0; r < 16; ++r) { S0[r] = tb[8 * (r >> 2) + (r & 3)]; S1[r] = tb[32 + 8 * (r >> 2) + (r & 3)]; }
            } else {
                const LAS float* tb = tab + ((t - rw + 7) * 31 - cq + 15 + 4 * hh);
                const int kc0 = 4 * hh - c0;
#pragma unroll
                for (int r = 0; r < 16; ++r) { const int ka = 8 * (r >> 2) + (r & 3), kb2 = 32 + ka;
                    S0[r] = ((unsigned)(ka + kc0) < 16u) ? tb[ka] : -1e30f; S1[r] = ((unsigned)(kb2 + kc0) < 16u) ? tb[kb2] : -1e30f; }
            }
            __builtin_amdgcn_sched_barrier(0);
#pragma unroll
            for (int s = 0; s < 4; ++s) { S0 = __builtin_amdgcn_mfma_f32_32x32x16_bf16(kf[2 * s], qf[s], S0, 0, 0, 0); S1 = __builtin_amdgcn_mfma_f32_32x32x16_bf16(kf[2 * s + 1], qf[s], S1, 0, 0, 0); }
            s16x4 vf[4][2][2];
#pragma unroll
            for (int ks = 0; ks < 2; ++ks)
#pragma unroll
                for (int db = 0; db < 2; ++db) { vf[ks][db][0] = vtr(vb_ + vread[db] + (16 * ks) * 128); vf[ks][db][1] = vtr(vb_ + vread[db] + (16 * ks + 8) * 128); }
            __builtin_amdgcn_sched_barrier(0);
#pragma unroll
            for (int r = 0; r < 16; ++r) { S0[r] = __builtin_amdgcn_exp2f(S0[r]); S1[r] = __builtin_amdgcn_exp2f(S1[r]); }
#pragma unroll
            for (int r = 0; r < 16; ++r) lsum += S0[r] + S1[r];
            bf16x8 pb[4];
#pragma unroll
            for (int hf = 0; hf < 2; ++hf) {
                v4u a, c;
#pragma unroll
                for (int j = 0; j < 4; ++j) { a[j] = cvtpk(S0[8 * hf + 2 * j], S0[8 * hf + 2 * j + 1]); c[j] = cvtpk(S1[8 * hf + 2 * j], S1[8 * hf + 2 * j + 1]); }
                pb[hf] = __builtin_bit_cast(bf16x8, a); pb[2 + hf] = __builtin_bit_cast(bf16x8, c);
            }
#pragma unroll
            for (int ks = 2; ks < 4; ++ks)
#pragma unroll
                for (int db = 0; db < 2; ++db) { vf[ks][db][0] = vtr(vb_ + vread[db] + (16 * ks) * 128); vf[ks][db][1] = vtr(vb_ + vread[db] + (16 * ks + 8) * 128); }
            __builtin_amdgcn_sched_barrier(0);
#pragma unroll
            for (int ks = 0; ks < 4; ++ks) {
                const bf16x8 va = __builtin_shufflevector(vf[ks][0][0], vf[ks][0][1], 0, 1, 2, 3, 4, 5, 6, 7), vb2 = __builtin_shufflevector(vf[ks][1][0], vf[ks][1][1], 0, 1, 2, 3, 4, 5, 6, 7);
                O0 = __builtin_amdgcn_mfma_f32_32x32x16_bf16(va, pb[ks], O0, 0, 0, 0); O1 = __builtin_amdgcn_mfma_f32_32x32x16_bf16(vb2, pb[ks], O1, 0, 0, 0);
            }
        }
        __builtin_amdgcn_sched_barrier(0);
        if (t + 1 < t_end) { *(LAS v4u*)(lds + AT_K0 + (cur ^ 1) * 8192 + kst) = kr; *(LAS v4u*)(lds + AT_V0 + (cur ^ 1) * 8192 + vst) = vr; }
        __syncthreads();
    }
    lsum += shx(lsum, 32, lane);
    if (TYPE == 0) lsum += __builtin_amdgcn_exp2f(sinkl2 - Cl2);
    const float inv = 1.f / lsum;
    bf16* op = ATT + ((size_t)b * SEQ + qpos) * DM + ocol + 4 * hh;
#pragma unroll
    for (int g4 = 0; g4 < 4; ++g4) {
        v2u o0, o1; o0.x = cvtpk(O0[4 * g4] * inv, O0[4 * g4 + 1] * inv); o0.y = cvtpk(O0[4 * g4 + 2] * inv, O0[4 * g4 + 3] * inv);
        o1.x = cvtpk(O1[4 * g4] * inv, O1[4 * g4 + 1] * inv); o1.y = cvtpk(O1[4 * g4 + 2] * inv, O1[4 * g4 + 3] * inv);
        *(GAS v2u*)(op + 8 * g4) = o0; *(GAS v2u*)(op + 32 + 8 * g4) = o1;
    }
}


constexpr int MA_K0 = 0, MA_V0 = 32768;
__device__ __forceinline__ void mem_unit(LAS unsigned char* lds, const bf16* QM, const bf16* KVM, bf16* OM, const float* gq, int tb, int head, float Cl2, int tid) {
    const int lane = tid & 63, w = __builtin_amdgcn_readfirstlane(tid >> 6), hh = lane >> 5, l31 = lane & 31;
    const size_t trow = (size_t)tb * 256 + 32 * w + l31; const int b = tb >> 3;
    bf16x8 qf[8];
    {   const bf16* qp = QM + trow * MEMW + head * 128 + 8 * hh;
#pragma unroll
        for (int s = 0; s < 8; ++s) qf[s] = *(const GAS bf16x8*)(qp + 16 * s);
        float ss = 0.f;
#pragma unroll
        for (int s = 0; s < 8; ++s)
#pragma unroll
            for (int j = 0; j < 8; ++j) { const float f = __builtin_bit_cast(float, (unsigned)(unsigned short)qf[s][j] << 16); ss += f * f; }
        ss += shx(ss, 32, lane);
        const float r = 0.12751743074602468f / sqrtf(ss * (1.f / 128.f) + EPS);
#pragma unroll
        for (int s = 0; s < 8; ++s) { const f32x4 g0 = *(const GAS f32x4*)(gq + 16 * s + 8 * hh), g1 = *(const GAS f32x4*)(gq + 16 * s + 8 * hh + 4);
            v4u o;
#pragma unroll
            for (int j = 0; j < 4; ++j) { const float f0 = __builtin_bit_cast(float, (unsigned)(unsigned short)qf[s][2 * j] << 16), f1 = __builtin_bit_cast(float, (unsigned)(unsigned short)qf[s][2 * j + 1] << 16);
                const float ga = (2 * j < 4) ? g0[2 * j] : g1[2 * j - 4], gb2 = (2 * j + 1 < 4) ? g0[2 * j + 1] : g1[2 * j + 1 - 4];
                o[j] = cvtpk(f0 * r * ga, f1 * r * gb2); }
            qf[s] = __builtin_bit_cast(bf16x8, o); }
    }
    const int srow = tid >> 3, sch = tid & 7;
    const bf16* kg = KVM + ((size_t)b * NMEM + srow) * 1024 + head * 128 + sch * 8;
    const bf16* vg = kg + 512;
    const int kst0 = srow * 256 + ((sch ^ (srow & 15)) * 16), kst1 = srow * 256 + (((sch + 8) ^ (srow & 15)) * 16);
    const int vst0 = srow * 256 + ((((sch) >> 2) ^ (srow & 3)) * 64) + (sch & 3) * 16, vst1 = srow * 256 + ((((sch + 8) >> 2) ^ (srow & 3)) * 64) + (sch & 3) * 16;
    int kread[8], vread[4];
#pragma unroll
    for (int s = 0; s < 8; ++s) kread[s] = l31 * 256 + (((2 * s + hh) ^ (l31 & 15)) * 16);
#pragma unroll
    for (int db = 0; db < 4; ++db) vread[db] = (4 * hh + ((lane >> 2) & 3)) * 256 + ((db ^ ((lane >> 2) & 3)) * 64) + 32 * ((lane >> 4) & 1) + 8 * (lane & 3);
    f32x16 O[4];
#pragma unroll
    for (int db = 0; db < 4; ++db)
#pragma unroll
        for (int r = 0; r < 16; ++r) O[db][r] = 0.f;
    float lsum = 0.f;
    {   const v4u k0 = *(const GAS v4u*)kg, k1 = *(const GAS v4u*)(kg + 64), v0 = *(const GAS v4u*)vg, v1 = *(const GAS v4u*)(vg + 64);
        *(LAS v4u*)(lds + MA_K0 + kst0) = k0; *(LAS v4u*)(lds + MA_K0 + kst1) = k1; *(LAS v4u*)(lds + MA_V0 + vst0) = v0; *(LAS v4u*)(lds + MA_V0 + vst1) = v1; }
    __syncthreads();
#pragma unroll 1
    for (int t = 0; t < 4; ++t) {
        const int cur = t & 1;
        v4u k0, k1, v0, v1;
        if (t + 1 < 4) { const bf16* kn = kg + (size_t)(t + 1) * 64 * 1024; k0 = *(const GAS v4u*)kn; k1 = *(const GAS v4u*)(kn + 64); v0 = *(const GAS v4u*)(kn + 512); v1 = *(const GAS v4u*)(kn + 576); }
        const lds_cptr kb_ = (lds_cptr)(lds + MA_K0 + cur * 16384), vb_ = (lds_cptr)(lds + MA_V0 + cur * 16384);
        f32x16 S0, S1;
#pragma unroll
        for (int r = 0; r < 16; ++r) { S0[r] = -Cl2; S1[r] = -Cl2; }
#pragma unroll
        for (int s = 0; s < 8; ++s) { const bf16x8 a0 = *(const LAS bf16x8*)(kb_ + kread[s]), a1 = *(const LAS bf16x8*)(kb_ + kread[s] + 8192);
            S0 = __builtin_amdgcn_mfma_f32_32x32x16_bf16(a0, qf[s], S0, 0, 0, 0); S1 = __builtin_amdgcn_mfma_f32_32x32x16_bf16(a1, qf[s], S1, 0, 0, 0); }
#pragma unroll
        for (int r = 0; r < 16; ++r) { S0[r] = __builtin_amdgcn_exp2f(S0[r]); S1[r] = __builtin_amdgcn_exp2f(S1[r]); lsum += S0[r] + S1[r]; }
        bf16x8 pb[4];
#pragma unroll
        for (int hf = 0; hf < 2; ++hf) {
            v4u a, c;
#pragma unroll
            for (int j = 0; j < 4; ++j) { a[j] = cvtpk(S0[8 * hf + 2 * j], S0[8 * hf + 2 * j + 1]); c[j] = cvtpk(S1[8 * hf + 2 * j], S1[8 * hf + 2 * j + 1]); }
            pb[hf] = __builtin_bit_cast(bf16x8, a); pb[2 + hf] = __builtin_bit_cast(bf16x8, c);
        }
#pragma unroll
        for (int ks = 0; ks < 4; ++ks)
#pragma unroll
            for (int db = 0; db < 4; ++db) {
                const s16x4 a0 = vtr(vb_ + vread[db] + (16 * ks) * 256), a1 = vtr(vb_ + vread[db] + (16 * ks + 8) * 256);
                const bf16x8 va = __builtin_shufflevector(a0, a1, 0, 1, 2, 3, 4, 5, 6, 7);
                O[db] = __builtin_amdgcn_mfma_f32_32x32x16_bf16(va, pb[ks], O[db], 0, 0, 0);
            }
        if (t + 1 < 4) { LAS unsigned char* kn = lds + MA_K0 + (cur ^ 1) * 16384; LAS unsigned char* vn = lds + MA_V0 + (cur ^ 1) * 16384;
            *(LAS v4u*)(kn + kst0) = k0; *(LAS v4u*)(kn + kst1) = k1; *(LAS v4u*)(vn + vst0) = v0; *(LAS v4u*)(vn + vst1) = v1; }
        __syncthreads();
    }
    lsum += shx(lsum, 32, lane);
    const float inv = 1.f / lsum;
    bf16* op = OM + trow * MEMW + head * 128 + 4 * hh;
#pragma unroll
    for (int db = 0; db < 4; ++db)
#pragma unroll
        for (int g4 = 0; g4 < 4; ++g4) { v2u o; o.x = cvtpk(O[db][4 * g4] * inv, O[db][4 * g4 + 1] * inv); o.y = cvtpk(O[db][4 * g4 + 2] * inv, O[db][4 * g4 + 3] * inv); *(GAS v2u*)(op + 32 * db + 8 * g4) = o; }
}

__device__ __forceinline__ float wave_max(float v, int lane) {
#pragma unroll
    for (int o = 1; o < 64; o <<= 1) v = fmaxf(v, shx(v, o, lane));
    return v;
}
struct Args { const float* in[23]; float* out; unsigned char* ws; int ph_lo, ph_hi, use_bar, pad; };
#ifndef MK_OFF
#define MK_OFF 0u
#endif
#ifndef REP_ATT
#define REP_ATT 1
#endif
#ifndef REP_P0
#define REP_P0 1
#endif
#ifndef REP_GEMM
#define REP_GEMM 1
#endif
#ifndef REP_NORM
#define REP_NORM 1
#endif
#ifndef REP_SEL
#define REP_SEL 1
#endif
#ifndef REP_MEM
#define REP_MEM 1
#endif
#define PHON(k) (!((MK_OFF >> (k)) & 1u))
constexpr int PH_PER_LAYER = 10, PH_BASE = 3, N_PHASES = PH_BASE + DEPTH * PH_PER_LAYER;
constexpr int PTAB_OFF = LDSCTL_OFF + 1024;

__global__ void __launch_bounds__(NTHREADS, 2) mega(Args a) {
    extern __shared__ __attribute__((aligned(16))) unsigned char lds_raw[];
    LAS unsigned char* lds = (LAS unsigned char*)lds_raw;
    {   const int tid0 = threadIdx.x;
        for (int u = tid0; u < (LDS_BYTES - LDSCTL_OFF) / 4; u += NTHREADS) ((LAS unsigned*)(lds + LDSCTL_OFF))[u] = 0u;
        __syncthreads();
        if (tid0 < 23) ((LAS unsigned long long*)(lds + PTAB_OFF))[tid0] = (unsigned long long)a.in[tid0];
        if (tid0 == 23) ((LAS unsigned long long*)(lds + PTAB_OFF))[23] = (unsigned long long)a.out;
        if (tid0 == 24) ((LAS unsigned long long*)(lds + PTAB_OFF))[24] = (unsigned long long)a.ws;
        __syncthreads();
    }
    volatile LAS unsigned* MISC = (volatile LAS unsigned*)(lds + MISC_OFF);
    const int G = gridDim.x, bid = blockIdx.x, NGW = G * NWAVES;
    const int use_bar = a.use_bar;
    XcdBarrier bar; bar.bar = (unsigned*)(a.ws + WS_CTL) + CW_BAR; bar.x = 0; bar.st = MISC + 8;
    if (use_bar) bar = xcd_barrier_post((unsigned*)(a.ws + WS_CTL) + CW_BAR, MISC + 8);
    const int lo = a.ph_lo, hi = a.ph_hi;
#define IN(k) (lo <= (k) && (k) < hi)
#define SEAM(k) do { if (use_bar && IN(k) && IN((k) + 1)) xcd_barrier(bar); } while (0)
#define PHL() int tid_ = threadIdx.x; asm volatile("" : "+v"(tid_)); const int lane_ = tid_ & 63, wave_ = __builtin_amdgcn_readfirstlane(tid_ >> 6), gw_ = bid * NWAVES + wave_; (void)lane_; (void)gw_; \
              int pz_ = 0; asm volatile("" : "+s"(pz_))
#define PTR(i) ((const float*)ldptr(lds, (i) + pz_))
#define WSP() ((unsigned char*)ldptr(lds, 24 + pz_))
#define OUTP() ((float*)ldptr(lds, 23 + pz_))

    if (IN(0) && PHON(0)) for (int rep_ = 0; rep_ < REP_P0; ++rep_) {
        PHL(); unsigned char* ws = WSP();
        LAS float* scr = (LAS float*)(lds + RING_OFF + wave_ * 16384);
        constexpr int I_IN = 32 * 128, I_OUT = 32 * 64, I_MQ = 32 * 16, I_MKV = 32 * 32, I_MO = 8 * 64, I_PQ = 32 * 64, I_L = I_IN + I_OUT + I_MQ + I_MKV + I_MO + I_PQ;
        for (int it = gw_; it < DEPTH * I_L; it += NGW) {
            const int l = it / I_L; int r = it % I_L;
            if (r < I_IN) { transpose_item<true>(PTR(4) + (size_t)l * DM * DIN, DM, DIN, (bf16*)(ws + WS_WIN) + (size_t)l * DIN * DM, scr, r, lane_, PTR(3) + (size_t)l * DM); continue; } r -= I_IN;
            if (r < I_OUT) { transpose_item<false>(PTR(11) + (size_t)l * DM * DM, DM, DM, (bf16*)(ws + WS_WOUT) + (size_t)l * DM * DM, scr, r, lane_); continue; } r -= I_OUT;
            if (r < I_MQ) { transpose_item<false>(PTR(14) + (size_t)l * DM * MEMW, DM, MEMW, (bf16*)(ws + WS_WMQ) + (size_t)l * MEMW * DM, scr, r, lane_, PTR(12) + (size_t)l * DM); continue; } r -= I_MQ;
            if (r < I_MKV) { transpose_item<false>(PTR(15) + (size_t)l * DM * 1024, DM, 1024, (bf16*)(ws + WS_WMKV) + (size_t)l * 1024 * DM, scr, r, lane_); continue; } r -= I_MKV;
            if (r < I_MO) { transpose_item<false>(PTR(17) + (size_t)l * MEMW * DM, MEMW, DM, (bf16*)(ws + WS_WMO) + (size_t)l * DM * MEMW, scr, r, lane_); continue; } r -= I_MO;
            transpose_item<false>(PTR(19) + (size_t)l * DM * DM, DM, DM, (bf16*)(ws + WS_WPQ) + (size_t)l * DM * DM, scr, r, lane_, PTR(18) + (size_t)l * DM);
        }
        const size_t gtid = (size_t)bid * NTHREADS + tid_, nth = (size_t)G * NTHREADS;
        convert_bf16(PTR(20), (bf16*)(ws + WS_PKEYS), (size_t)DEPTH * 8 * 2 * 128 * 128, gtid, nth);
        if (PEER_U_FP4) convert_fp4_rows(PTR(21), ws + WS_PU, DEPTH * PEER_N, PU_SCALE4, PTR(18), gw_, NGW, lane_);
        else convert_fp6_rows(PTR(21), ws + WS_PU, DEPTH * PEER_N, PU_SCALE6, PTR(18), gw_, NGW, lane_);
        convert_fp4_rows(PTR(22), ws + WS_PV, DEPTH * PEER_N, PV_SCALE4, nullptr, gw_, NGW, lane_);
        {   const float* x0 = PTR(0); bf16* XN = (bf16*)(ws + WS_XN); u64_t* rsq = (u64_t*)(ws + WS_ROWSQ);
            for (int m = 2 * gw_; m < T; m += 2 * NGW) prep_rows2(x0 + (size_t)m * DM, XN + (size_t)m * DM, rsq + m, lane_); }
        {   const float* mem = PTR(1); const float* gkv = PTR(13); bf16* MEMN = (bf16*)(ws + WS_MEMN);
            for (int m = gw_; m < BATCH * NMEM; m += NGW)
                rms_row_to_bf16(mem + (size_t)m * DM, gkv, MEMN + (size_t)m * DM, gkv + DM, MEMN + (size_t)(BATCH * NMEM + m) * DM, lane_); }
        float* rope = (float*)(ws + WS_ROPE); float* biasA = (float*)(ws + WS_BIASA);
        if (gtid < 64 * 16) { const int pos = (int)gtid >> 4, i = (int)gtid & 15; const float ang = (float)pos * ROPE_INV[i]; rope[gtid * 2] = cosf(ang); rope[gtid * 2 + 1] = sinf(ang); }
        if (gtid < 12 * 257) { const int h = (int)gtid / 257, rel = (int)gtid % 257 - 128; biasA[gtid] = PTR(2)[t5_bucket(rel) * 12 + h]; }
    }
    SEAM(0);
    if (IN(1) && PHON(1)) {
#pragma unroll 1
        for (int l = 0; l < DEPTH; ++l) {
            PHL(); unsigned char* ws = WSP();
            pg8::Gemm g{(bf16*)(ws + WS_MEMN) + (size_t)l * BATCH * NMEM * DM, (bf16*)(ws + WS_WMKV) + (size_t)l * 1024 * DM, BATCH * NMEM, 1024, DM};
            OffsetOrder S; S.init(BATCH * NMEM, 1024, G, bid, 64 * l);
            pg8::EpiBf16<0> E{(bf16*)(ws + WS_KVM) + (size_t)l * BATCH * NMEM * 1024, 1024, nullptr, 0, 0, 1.f};
            pg8::gemm_phase<pg8::EpiBf16<0>, OffsetOrder, true, true>(lds + RING_OFF, g, S, E, tid_);
            __syncthreads();
        }
    }
    SEAM(1);
    if (IN(2) && PHON(2)) {
        PHL(); unsigned char* ws = WSP(); bf16* KVM = (bf16*)(ws + WS_KVM); const float* gm = PTR(16);
        for (int m = gw_; m < DEPTH * BATCH * NMEM; m += NGW) {
            const int l = m / (BATCH * NMEM);
            GAS v4u* p = (GAS v4u*)(KVM + (size_t)m * 1024 + 8 * lane_);
            const v4u w = *p;
            float f[8] = {bflo(w.x), bfhi(w.x), bflo(w.y), bfhi(w.y), bflo(w.z), bfhi(w.z), bflo(w.w), bfhi(w.w)};
            float ss = 0.f;
#pragma unroll
            for (int i = 0; i < 8; ++i) ss += f[i] * f[i];
            ss += shx(ss, 1, lane_); ss += shx(ss, 2, lane_); ss += shx(ss, 4, lane_); ss += shx(ss, 8, lane_);
            const float r = 1.f / sqrtf(ss * (1.f / 128.f) + EPS);
            const float* gk = gm + (size_t)l * 256 + 128 + 8 * (lane_ & 15);
            v4u o; o.x = pk2(f[0] * r * gk[0], f[1] * r * gk[1]); o.y = pk2(f[2] * r * gk[2], f[3] * r * gk[3]); o.z = pk2(f[4] * r * gk[4], f[5] * r * gk[5]); o.w = pk2(f[6] * r * gk[6], f[7] * r * gk[7]);
            *p = o;
        }
    }
    SEAM(2);

#pragma unroll 1
    for (int l = 0; l < DEPTH; ++l) {
        const int pb = PH_BASE + PH_PER_LAYER * l;
        if (IN(pb + 0) && PHON(3)) for (int rep_ = 0; rep_ < REP_GEMM; ++rep_) { PHL(); unsigned char* ws = WSP();
            pg8::Gemm g{(bf16*)(ws + WS_XN), (bf16*)(ws + WS_WIN) + (size_t)l * DIN * DM, T, DIN, DM}; pg8::StaticOrder S; S.init(T, DIN, G, bid);
            pg8::EpiQKV E{(bf16*)(ws + WS_QKV), PTR(5) + (size_t)l * 128, PTR(7) + (size_t)l * 128, PTR(9) + (size_t)l * 128, (const float*)(ws + WS_ROPE), (const u64_t*)(ws + WS_ROWSQ) + (size_t)(l * 3 + 0) * T};
            pg8::gemm_phase<pg8::EpiQKV, pg8::StaticOrder, true, true>(lds + RING_OFF, g, S, E, tid_);
        }
        SEAM(pb + 0);
        if (IN(pb + 1) && PHON(4)) for (int rep_ = 0; rep_ < REP_ATT; ++rep_) { PHL(); unsigned char* ws = WSP();
            const float* sink = PTR(6) + (size_t)l * 12; const float* rpb = PTR(8) + (size_t)l * 8 * 15 * 31; const float* biasA = (const float*)(ws + WS_BIASA);
            const bf16* QKV = (const bf16*)(ws + WS_QKV); bf16* ATT = (bf16*)(ws + WS_ATT);
            const float* ga = PTR(5) + (size_t)l * 128; const float* gb = PTR(7) + (size_t)l * 128; const float* gc = PTR(9) + (size_t)l * 128;
            const float CaL2 = 8.f * wave_max(fabsf(ga[lane_]), lane_) * wave_max(fabsf(ga[64 + lane_]), lane_) * LOG2E;
            const float CbL2 = 8.f * wave_max(fabsf(gb[lane_]), lane_) * wave_max(fabsf(gb[64 + lane_]), lane_) * LOG2E;
            const float CcL2 = 8.f * wave_max(fabsf(gc[lane_]), lane_) * wave_max(fabsf(gc[64 + lane_]), lane_) * LOG2E;
            const int vc = (G % 8 == 0) ? (bid % 8) * (G / 8) + bid / 8 : bid;
            for (int u = vc; u < BATCH * 12 * 8; u += G) attn_unit<2>(lds, QKV, ATT, u / 96, (u >> 3) % 12, u & 7, nullptr, CcL2, 0.f, tid_);
            for (int u = vc; u < BATCH * 8 * 8; u += G) attn_unit<1>(lds, QKV, ATT, u >> 6, (u >> 3) & 7, u & 7, rpb, CbL2, 0.f, tid_);
            for (int u = vc; u < BATCH * 12 * 8; u += G) { const int head = (u >> 3) % 12; attn_unit<0>(lds, QKV, ATT, u / 96, head, u & 7, biasA, CaL2, sink[head] * LOG2E, tid_); }
        }
        SEAM(pb + 1);
        if (IN(pb + 2) && PHON(5)) { PHL(); unsigned char* ws = WSP(); mixnorm_rows((bf16*)(ws + WS_ATT), PTR(10) + (size_t)l * DM, gw_, NGW, lane_); }
        SEAM(pb + 2);
        if (IN(pb + 3) && PHON(6)) { PHL(); unsigned char* ws = WSP();
            pg8::Gemm g{(bf16*)(ws + WS_ATT), (bf16*)(ws + WS_WOUT) + (size_t)l * DM * DM, T, DM, DM}; pg8::StaticOrder S; S.init(T, DM, G, bid);
            pg8::EpiResid E{(bf16*)(ws + WS_XN), DM, (u64_t*)(ws + WS_ROWSQ) + (size_t)(l * 3 + 1) * T};
            pg8::gemm_phase<pg8::EpiResid, pg8::StaticOrder, true, true>(lds + RING_OFF, g, S, E, tid_);
        }
        SEAM(pb + 3);
        if (IN(pb + 4) && PHON(7)) for (int rep_ = 0; rep_ < REP_GEMM; ++rep_) { PHL(); unsigned char* ws = WSP();
            pg8::Gemm g{(bf16*)(ws + WS_XN), (bf16*)(ws + WS_WMQ) + (size_t)l * MEMW * DM, T, MEMW, DM}; pg8::StaticOrder S; S.init(T, MEMW, G, bid);
            pg8::EpiBf16Row E{(bf16*)(ws + WS_QM), MEMW, (const u64_t*)(ws + WS_ROWSQ) + (size_t)(l * 3 + 1) * T};
            pg8::gemm_phase<pg8::EpiBf16Row, pg8::StaticOrder, true, true>(lds + RING_OFF, g, S, E, tid_);
        }
        SEAM(pb + 4);
        if (IN(pb + 5) && PHON(8)) for (int rep_ = 0; rep_ < REP_MEM; ++rep_) { PHL(); unsigned char* ws = WSP();
            const bf16* kvm = (const bf16*)(ws + WS_KVM) + (size_t)l * BATCH * NMEM * 1024; const float* gq = PTR(16) + (size_t)l * 256;
            const float CmL2 = 11.313708498984761f * wave_max(fmaxf(fabsf(gq[lane_]), fabsf(gq[64 + lane_])), lane_) * wave_max(fmaxf(fabsf(gq[128 + lane_]), fabsf(gq[192 + lane_])), lane_) * LOG2E;
            for (int u = bid; u < (T / 256) * 4; u += G) mem_unit(lds, (const bf16*)(ws + WS_QM), kvm, (bf16*)(ws + WS_OM), gq, u >> 2, u & 3, CmL2, tid_);
        }
        SEAM(pb + 5);
        if (IN(pb + 6) && PHON(9)) { PHL(); unsigned char* ws = WSP();
            pg8::Gemm g{(bf16*)(ws + WS_OM), (bf16*)(ws + WS_WMO) + (size_t)l * DM * MEMW, T, DM, MEMW}; pg8::StaticOrder S; S.init(T, DM, G, bid);
            pg8::EpiResid E{(bf16*)(ws + WS_XN), DM, (u64_t*)(ws + WS_ROWSQ) + (size_t)(l * 3 + 2) * T};
            pg8::gemm_phase<pg8::EpiResid, pg8::StaticOrder, true, true>(lds + RING_OFF, g, S, E, tid_);
        }
        SEAM(pb + 6);
        if (IN(pb + 7) && PHON(10)) for (int rep_ = 0; rep_ < REP_GEMM; ++rep_) { PHL(); unsigned char* ws = WSP();
            pg8::Gemm g{(bf16*)(ws + WS_XN), (bf16*)(ws + WS_WPQ) + (size_t)l * DM * DM, T, DM, DM}; pg8::StaticOrder S; S.init(T, DM, G, bid);
            pg8::EpiBf16Row E{(bf16*)(ws + WS_QP), DM, (const u64_t*)(ws + WS_ROWSQ) + (size_t)(l * 3 + 2) * T};
            pg8::gemm_phase<pg8::EpiBf16Row, pg8::StaticOrder, true, true>(lds + RING_OFF, g, S, E, tid_);
        }
        SEAM(pb + 7);
        if (IN(pb + 8) && PHON(11)) for (int rep_ = 0; rep_ < REP_SEL; ++rep_) { PHL(); unsigned char* ws = WSP();
            const bf16* pk = (const bf16*)(ws + WS_PKEYS) + (size_t)l * 8 * 2 * 128 * 128;
            for (int u = bid; u < (T / 256) * PEER_H; u += G) peer_select_unit((const bf16*)(ws + WS_QP), pk, (int*)(ws + WS_PIDX), (float*)(ws + WS_PGATE), u >> 3, u & 7, wave_, lane_);
        }
        SEAM(pb + 8);
        if (IN(pb + 9) && PHON(12)) { PHL(); unsigned char* ws = WSP();
            peer_gather6((bf16*)(ws + WS_XN), ws + WS_PU + (size_t)l * PEER_N * PU_STRIDE, ws + WS_PV + (size_t)l * PEER_N * 1024, (const int*)(ws + WS_PIDX), (const float*)(ws + WS_PGATE), (l + 1 == DEPTH) ? OUTP() : (float*)nullptr,
                         (const u64_t*)(ws + WS_ROWSQ) + (size_t)(l * 3 + 2) * T, (l + 1 < DEPTH) ? (u64_t*)(ws + WS_ROWSQ) + (size_t)((l + 1) * 3 + 0) * T : (u64_t*)nullptr,
                         (LAS float*)(lds + RING_OFF + wave_ * 1024), gw_, NGW, lane_); }
        SEAM(pb + 9);
    }
#undef IN
#undef SEAM
}

#ifndef MK_MULTI_LAUNCH
#define MK_MULTI_LAUNCH 0
#endif
extern "C" void kernel_launch(void* const* d_in, const int* in_sizes, int n_in, void* d_out, int out_size, void* d_ws, size_t ws_size, hipStream_t stream) {
    static int grid = 0;
    if (grid == 0) {
        if (n_in != 23 || out_size != T * DM || ws_size < WS_END) { fprintf(stderr, "kernel_launch: unexpected shapes (n_in %d, out %d, ws %zu)\n", n_in, out_size, ws_size); grid = -1; return; }
        int dev = 0, cus = 0, per_cu = 0;
        if (hipGetDevice(&dev) != hipSuccess || hipDeviceGetAttribute(&cus, hipDeviceAttributeMultiprocessorCount, dev) != hipSuccess) { grid = -1; return; }
        if (hipFuncSetAttribute((const void*)mega, hipFuncAttributeMaxDynamicSharedMemorySize, LDS_BYTES) != hipSuccess) { fprintf(stderr, "kernel_launch: hipFuncSetAttribute failed\n"); grid = -1; return; }
        if (hipOccupancyMaxActiveBlocksPerMultiprocessor(&per_cu, (const void*)mega, NTHREADS, LDS_BYTES) != hipSuccess || per_cu < 1) { fprintf(stderr, "kernel_launch: occupancy query says %d\n", per_cu); }
        (void)hipGetLastError();
        grid = cus;
    }
    if (grid < 0) return;
    (void)hipMemsetAsync((char*)d_ws + WS_CTL, 0, CTL_ZERO_BYTES, stream);
    Args a{};
    for (int i = 0; i < 23; ++i) a.in[i] = (const float*)d_in[i];
    a.out = (float*)d_out; a.ws = (unsigned char*)d_ws;
#if MK_MULTI_LAUNCH
    for (int p = 0; p < N_PHASES; ++p) { a.ph_lo = p; a.ph_hi = p + 1; a.use_bar = 0; a.pad = 0; hipLaunchKernelGGL(mega, dim3(grid), dim3(NTHREADS), LDS_BYTES, stream, a); }
#else
    a.ph_lo = 0; a.ph_hi = N_PHASES; a.use_bar = 1; a.pad = 0;
    hipLaunchKernelGGL(mega, dim3(grid), dim3(NTHREADS), LDS_BYTES, stream, a);
#endif
    const hipError_t le = hipPeekAtLastError();
    if (le != hipSuccess) fprintf(stderr, "kernel_launch: launch failed: %s\n", hipGetErrorName(le));
}
```

```cpp
#include <hip/hip_runtime.h>
#include <cstdio>
#include <cstdint>
#include <cmath>
__device__ __forceinline__ float shx(float v, int k, int lane);
typedef unsigned long long u64_t;
__device__ __forceinline__ float rowsq_rs(const u64_t* rowsq, int row) { return 1.0f / sqrtf((float)rowsq[row] * (5.9604644775390625e-08f / 2048.0f) + 1e-6f); }
__device__ __forceinline__ u64_t rowsq_fx(float ss) { return (u64_t)(ss * 16777216.0f + 0.5f); }
namespace pg8 {
#define PG8_LAS __attribute__((address_space(3)))
typedef unsigned short bf16_t;
typedef short bf16x8 __attribute__((ext_vector_type(8)));
typedef float f32x4 __attribute__((ext_vector_type(4)));
typedef unsigned u32x4 __attribute__((ext_vector_type(4)));
constexpr int BM = 256, BK = 64, HALF = 128, HTB = HALF * BK * 2  , STAGE_BYTES = 8 * HTB, NXCD = 8, WGM = 8;

__host__ __device__ __forceinline__ int lds_byte(int r, int c) { const int st = (r >> 4) * 2 + (c >> 5), rr = r & 15, cc = c & 31, ob = rr * 64 + cc * 2; return st * 1024 + (ob ^ (((ob >> 9) & 1) << 5)); }
__host__ __device__ __forceinline__ void stage_rc(int b, int& R, int& C) { const int st = b / 1024, sb = b % 1024, swz = sb ^ (((sb >> 9) & 1) << 5); R = (st >> 1) * 16 + swz / 64; C = (st & 1) * 32 + (swz % 64) / 2; }
__host__ __device__ __forceinline__ int perm32(int rho) { const int n = rho >> 4, i = rho & 15; return 8 * (i >> 2) + 4 * n + (i & 3); }

struct Unit { int pm, pn; };
struct Gemm { const bf16_t* A; const bf16_t* Bt; int M, N, K; };

struct StaticOrder {
    int nM, nN, nwg, G, c;
    __host__ __device__ void init(int M, int N, int G_, int c_) { nM = M / BM; nN = N / BM; nwg = nM * nN; G = G_; c = c_; }
    __host__ __device__ bool next(int i, Unit& u) const {
        const long L = (long)i * G + c; if (L >= nwg) return false;
        int wgid = (int)L; { const int q = nwg / NXCD, r = nwg % NXCD, xcd = wgid % NXCD, off = wgid / NXCD; wgid = (xcd < r ? xcd * (q + 1) : r * (q + 1) + (xcd - r) * q) + off; }
        const int nig = WGM * nN, gid = wgid / nig, fm = gid * WGM, gsz = (nM - fm) < WGM ? (nM - fm) : WGM;
        u.pm = fm + ((wgid % nig) % gsz); u.pn = (wgid % nig) / gsz; return true;
    }
    __device__ __forceinline__ void a_ready(const Unit&) const {}
    __device__ __forceinline__ void done(const Unit&) const {}
};

__device__ __forceinline__ unsigned cvt_pk_bf16(float lo, float hi) { unsigned r; asm volatile("v_cvt_pk_bf16_f32 %0, %1, %2" : "=v"(r) : "v"(lo), "v"(hi)); return r; }
typedef float f32x2 __attribute__((ext_vector_type(2)));
__device__ __forceinline__ f32x2 gelu_pk(f32x2 v) {
    const f32x2 av = __builtin_elementwise_abs(v), d = av * 0.2316418882f + 1.0f;
    f32x2 t; t.x = __builtin_amdgcn_rcpf(d.x); t.y = __builtin_amdgcn_rcpf(d.y);
    f32x2 q = t * 0.5307027145f + (-0.7265760135f); q = q * t + 0.7107068705f; q = q * t + (-0.142248368f); q = q * t + 0.127414796f; q = q * t;
    const f32x2 s = (v * v) * (-0.72134752044f);
    f32x2 e; e.x = __builtin_amdgcn_exp2f(s.x); e.y = __builtin_amdgcn_exp2f(s.y);
    const f32x2 m = v * (q * e), r = v - m;
    f32x2 o; o.x = v.x < 0.f ? m.x : r.x; o.y = v.y < 0.f ? m.y : r.y; return o;
}

template <int ACT  > struct EpiBf16 {
    static constexpr bool PERM = true, AFTER_DRAIN = false; static_assert(ACT == 0 || ACT == 1, "EpiBf16: ACT is 0 (none) or 1 (gelu_pk)");
    bf16_t* O; int ldc; const float* bias; int split_cols; size_t split_stride; float scale0;
    __device__ __forceinline__ void operator()(const f32x4 (&acc)[2][2][4][2], const Unit& u, int wr, int wc, int fr, int fq) const {
        const int row0 = u.pm * BM + wr * 64 + fr; int colt = u.pn * BM; bf16_t* base = O;
        float sc = 1.f; if (split_cols) { const int t = colt / split_cols; base += (size_t)t * split_stride; colt -= t * split_cols; if (t == 0) sc = scale0; }
        const int col0 = colt + wc * 32 + 8 * fq, bcol0 = u.pn * BM + wc * 32 + 8 * fq;
        f32x4 bv[2][2];
#pragma unroll
        for (int bj = 0; bj < 2; ++bj)
#pragma unroll
            for (int n = 0; n < 2; ++n) bv[bj][n] = bias ? *(const f32x4*)(bias + bcol0 + bj * HALF + 4 * n) : (f32x4){0.f, 0.f, 0.f, 0.f};
#pragma unroll
        for (int ai = 0; ai < 2; ++ai)
#pragma unroll
            for (int m = 0; m < 4; ++m) { bf16_t* rowp = base + (size_t)(row0 + ai * HALF + m * 16) * ldc + col0;
#pragma unroll
                for (int bj = 0; bj < 2; ++bj) { f32x4 v0 = acc[ai][bj][m][0] + bv[bj][0], v1 = acc[ai][bj][m][1] + bv[bj][1];
                    if (ACT == 1) { f32x2 a = gelu_pk((f32x2){v0[0], v0[1]}), b = gelu_pk((f32x2){v0[2], v0[3]}), c = gelu_pk((f32x2){v1[0], v1[1]}), d = gelu_pk((f32x2){v1[2], v1[3]});
                        v0 = (f32x4){a.x, a.y, b.x, b.y}; v1 = (f32x4){c.x, c.y, d.x, d.y}; }
                    v0 = v0 * sc; v1 = v1 * sc; u32x4 w; w.x = cvt_pk_bf16(v0[0], v0[1]); w.y = cvt_pk_bf16(v0[2], v0[3]); w.z = cvt_pk_bf16(v1[0], v1[1]); w.w = cvt_pk_bf16(v1[2], v1[3]);
                    *(u32x4*)(rowp + bj * HALF) = w; } }
    }
};

typedef unsigned u32x2 __attribute__((ext_vector_type(2)));
struct EpiResid {
    static constexpr bool PERM = false, AFTER_DRAIN = false;
    bf16_t* s; int ldc; u64_t* rowsq;
    __device__ __forceinline__ void operator()(const f32x4 (&acc)[2][2][4][2], const Unit& u, int wr, int wc, int fr, int fq) const {
        const int col0 = u.pn * BM + wc * 32 + 4 * fq;
#pragma unroll
        for (int ai = 0; ai < 2; ++ai)
#pragma unroll
            for (int m = 0; m < 4; ++m) { const int row = u.pm * BM + ai * HALF + wr * 64 + m * 16 + fr; bf16_t* sp = s + (size_t)row * ldc + col0; float ss = 0.f;
                u32x2 in[2][2];
#pragma unroll
                for (int bj = 0; bj < 2; ++bj)
#pragma unroll
                    for (int n = 0; n < 2; ++n) in[bj][n] = *(const u32x2*)(sp + bj * HALF + n * 16);
#pragma unroll
                for (int bj = 0; bj < 2; ++bj)
#pragma unroll
                    for (int n = 0; n < 2; ++n) { const u32x2 w0 = in[bj][n];
                        const f32x4 bs = (f32x4){__builtin_bit_cast(float, w0.x << 16), __builtin_bit_cast(float, w0.x & 0xffff0000u), __builtin_bit_cast(float, w0.y << 16), __builtin_bit_cast(float, w0.y & 0xffff0000u)};
                        const f32x4 o = bs + acc[ai][bj][m][n]; ss += (o[0] * o[0] + o[1] * o[1]) + (o[2] * o[2] + o[3] * o[3]);
                        u32x2 w; w.x = cvt_pk_bf16(o[0], o[1]); w.y = cvt_pk_bf16(o[2], o[3]); *(u32x2*)(sp + bj * HALF + n * 16) = w; }
                ss += shx(ss, 16, fr + 16 * fq); ss += shx(ss, 32, fr + 16 * fq);
                if (fq == 0) atomicAdd(rowsq + row, rowsq_fx(ss)); }
    }
};
struct EpiBf16Row {
    static constexpr bool PERM = true, AFTER_DRAIN = false;
    bf16_t* O; int ldc; const u64_t* rowsq;
    __device__ __forceinline__ void operator()(const f32x4 (&acc)[2][2][4][2], const Unit& u, int wr, int wc, int fr, int fq) const {
        const int row0 = u.pm * BM + wr * 64 + fr, col0 = u.pn * BM + wc * 32 + 8 * fq;
#pragma unroll
        for (int ai = 0; ai < 2; ++ai)
#pragma unroll
            for (int m = 0; m < 4; ++m) { const int row = row0 + ai * HALF + m * 16; const float rs = rowsq_rs(rowsq, row); bf16_t* rowp = O + (size_t)row * ldc + col0;
#pragma unroll
                for (int bj = 0; bj < 2; ++bj) { const f32x4 v0 = acc[ai][bj][m][0] * rs, v1 = acc[ai][bj][m][1] * rs; u32x4 w; w.x = cvt_pk_bf16(v0[0], v0[1]); w.y = cvt_pk_bf16(v0[2], v0[3]); w.z = cvt_pk_bf16(v1[0], v1[1]); w.w = cvt_pk_bf16(v1[2], v1[3]);
                    *(u32x4*)(rowp + bj * HALF) = w; } }
    }
};
struct EpiQKV {
    static constexpr bool PERM = false, AFTER_DRAIN = false;
    bf16_t* O; const float* ga; const float* gb; const float* gc; const float* rope; const u64_t* rowsq;
    __device__ __forceinline__ void operator()(const f32x4 (&acc)[2][2][4][2], const Unit& u, int wr, int wc, int fr, int fq) const {
        const int hg = u.pn * 4 + wc;
        const float* g = nullptr; bool isq = false, dorope = false;
        if (hg < 12) { g = ga; isq = true; } else if (hg < 16) { g = ga + 64; } else if (hg < 20) { }
        else if (hg < 28) { g = gb; isq = true; } else if (hg < 36) { g = gb + 64; } else if (hg < 44) { }
        else if (hg < 56) { g = gc; isq = true; dorope = true; } else if (hg < 60) { g = gc + 64; dorope = true; }
        const float qs = isq ? 0.18033688011112042f : 1.0f;
#pragma unroll
        for (int ai = 0; ai < 2; ++ai)
#pragma unroll
            for (int m = 0; m < 4; ++m) {
                const int row = u.pm * BM + ai * HALF + wr * 64 + m * 16 + fr;
                f32x4 v[2][2];
                const float rsx = rowsq_rs(rowsq, row);
#pragma unroll
                for (int bj = 0; bj < 2; ++bj)
#pragma unroll
                    for (int n = 0; n < 2; ++n) v[bj][n] = acc[ai][bj][m][n] * rsx;
                if (g) {
                    float ss = 0.f;
#pragma unroll
                    for (int bj = 0; bj < 2; ++bj)
#pragma unroll
                        for (int n = 0; n < 2; ++n) { const f32x4 x = v[bj][n]; ss += (x[0] * x[0] + x[1] * x[1]) + (x[2] * x[2] + x[3] * x[3]); }
                    ss += shx(ss, 16, fr + 16 * fq); ss += shx(ss, 32, fr + 16 * fq);
                    const float r = qs / sqrtf(ss * (1.0f / 64.0f) + 1e-6f);
#pragma unroll
                    for (int bj = 0; bj < 2; ++bj)
#pragma unroll
                        for (int n = 0; n < 2; ++n) v[bj][n] = v[bj][n] * *(const f32x4*)(g + 32 * bj + 16 * n + 4 * fq) * r;
                }
                if (dorope) {
                    const int t = row & 2047, pr = t >> 6, pc = t & 63;
#pragma unroll
                    for (int bj = 0; bj < 2; ++bj) {
                        const int pos = bj ? pc : pr;
                        const float* rp = rope + (size_t)(pos * 16 + 4 * fq) * 2;
                        const f32x4 c01 = *(const f32x4*)rp, c23 = *(const f32x4*)(rp + 4);
                        const f32x4 cs = (f32x4){c01[0], c01[2], c23[0], c23[2]}, sn = (f32x4){c01[1], c01[3], c23[1], c23[3]};
                        const f32x4 x1 = v[bj][0], x2 = v[bj][1];
                        v[bj][0] = x1 * cs - x2 * sn; v[bj][1] = x1 * sn + x2 * cs;
                    }
                }
                bf16_t* rowp = O + (size_t)row * 4096 + hg * 64 + 4 * fq;
#pragma unroll
                for (int bj = 0; bj < 2; ++bj)
#pragma unroll
                    for (int n = 0; n < 2; ++n) { u32x2 w; w.x = cvt_pk_bf16(v[bj][n][0], v[bj][n][1]); w.y = cvt_pk_bf16(v[bj][n][2], v[bj][n][3]); *(u32x2*)(rowp + 32 * bj + 16 * n) = w; }
                asm volatile("" ::: "memory");
            }
    }
};
template <class Epi, class Sched, bool ALIGN_EPI = false, bool SP2 = false>
__device__ __forceinline__ void gemm_phase(PG8_LAS unsigned char* lds, const Gemm g, const Sched& S, const Epi& E, const int tid) {
    const int wid = __builtin_amdgcn_readfirstlane(tid >> 6), lane = tid & 63, wr = wid >> 2, wc = wid & 3, fr = lane & 15, fq = lane >> 4;
    const int K = g.K, nt = K / BK;
    unsigned voffA[2], voffB[2];
#pragma unroll
    for (int i = 0; i < 2; ++i) { int R, C; stage_rc(tid * 16 + i * 8192, R, C); const int Rb = Epi::PERM ? ((R & ~31) + perm32(R & 31)) : R;
        voffA[i] = (unsigned)(R * K + C) * 2u; voffB[i] = (unsigned)(Rb * K + C) * 2u; }
    const size_t kstep = (size_t)(BK * 2);
    const size_t hstep = (size_t)HALF * K * 2;
    const size_t tstep = 2 * hstep;
    const unsigned ldsw = (unsigned)wid * 1024u;
    const int aoff = lds_byte(wr * 64 + fr, fq * 8), boff = lds_byte(wc * 32 + fr, fq * 8);
#define PG8_SA(b, h) (((b) * 2 + (h)) * HTB)
#define PG8_SB(b, h) ((4 + (b) * 2 + (h)) * HTB)
#define PG8_STAGE(bufoff, gbase, voff) do { _Pragma("unroll") for (int _i = 0; _i < 2; ++_i) \
        __builtin_amdgcn_global_load_lds((const unsigned*)((const char*)(gbase) + (voff)[_i]), (PG8_LAS unsigned*)(lds + (bufoff) + ldsw + _i * 8192), 16, 0, 0); } while (0)
#define PG8_LDA(dst, b, h) do { _Pragma("unroll") for (int m = 0; m < 4; ++m) _Pragma("unroll") for (int k = 0; k < 2; ++k) dst[m][k] = *(const PG8_LAS bf16x8*)(lds + PG8_SA(b, h) + aoff + m * 2048 + k * 1024); } while (0)
#define PG8_LDB(dst, b, h) do { _Pragma("unroll") for (int n = 0; n < 2; ++n) _Pragma("unroll") for (int k = 0; k < 2; ++k) dst[n][k] = *(const PG8_LAS bf16x8*)(lds + PG8_SB(b, h) + boff + n * 2048 + k * 1024); } while (0)
#define PG8_MMA(ai, bj, At, Bt) do { __builtin_amdgcn_s_setprio(1); _Pragma("unroll") for (int m = 0; m < 4; ++m) _Pragma("unroll") for (int n = 0; n < 2; ++n) _Pragma("unroll") for (int k = 0; k < 2; ++k) \
        acc[ai][bj][m][n] = __builtin_amdgcn_mfma_f32_16x16x32_bf16(Bt[n][k], At[m][k], acc[ai][bj][m][n], 0, 0, 0); __builtin_amdgcn_s_setprio(0); } while (0)
#define PG8_WAIT_V(n) asm volatile("s_waitcnt vmcnt(" #n ")" ::: "memory")
#define PG8_WAIT_L(n) asm volatile("s_waitcnt lgkmcnt(" #n ")" ::: "memory")
#define PG8_BAR __builtin_amdgcn_s_barrier()
#define PG8_SCHED __builtin_amdgcn_sched_barrier(0)
    Unit cur, nxt; int ui = 0;
    if (!S.next(0, cur)) return;
    f32x4 acc[2][2][4][2];
#pragma unroll
    for (int a = 0; a < 2; ++a)
#pragma unroll
        for (int b = 0; b < 2; ++b)
#pragma unroll
            for (int m = 0; m < 4; ++m)
#pragma unroll
                for (int n = 0; n < 2; ++n) acc[a][b][m][n] = (f32x4){0.f, 0.f, 0.f, 0.f};
    bf16x8 At[4][2], B0[2][2], B1[2][2];
    const char* cA = (const char*)g.A + (size_t)cur.pm * tstep; const char* cB = (const char*)g.Bt + (size_t)cur.pn * tstep;
    S.a_ready(cur);
    if constexpr (SP2) {
        PG8_STAGE(PG8_SB(0, 0), cB, voffB); PG8_STAGE(PG8_SB(0, 1), cB + hstep, voffB); PG8_STAGE(PG8_SA(0, 0), cA, voffA); PG8_STAGE(PG8_SA(0, 1), cA + hstep, voffA);
        if (wr == 1) PG8_BAR;
        PG8_WAIT_V(2); PG8_BAR;
        PG8_STAGE(PG8_SB(1, 0), cB + kstep, voffB); PG8_STAGE(PG8_SA(1, 0), cA + kstep, voffA); PG8_STAGE(PG8_SB(1, 1), cB + hstep + kstep, voffB);
        PG8_WAIT_V(6); PG8_BAR;
    } else {
        PG8_STAGE(PG8_SB(0, 0), cB, voffB); PG8_STAGE(PG8_SA(0, 0), cA, voffA); PG8_STAGE(PG8_SB(0, 1), cB + hstep, voffB); PG8_STAGE(PG8_SA(0, 1), cA + hstep, voffA);
        if (wr == 1) PG8_BAR;
        PG8_WAIT_V(4); PG8_BAR;
        PG8_STAGE(PG8_SB(1, 0), cB + kstep, voffB); PG8_STAGE(PG8_SA(1, 0), cA + kstep, voffA); PG8_STAGE(PG8_SB(1, 1), cB + hstep + kstep, voffB);
        PG8_WAIT_V(6); PG8_BAR;
    }
    for (;;) {
        const bool has_next = S.next(ui + 1, nxt);
        const char* nA = has_next ? (const char*)g.A + (size_t)nxt.pm * tstep : cA; const char* nB = has_next ? (const char*)g.Bt + (size_t)nxt.pn * tstep : cB;
        for (int t = 0; t < nt; t += 2) {
            const bool last = (t == nt - 2);
            const char* a1 = cA + (size_t)(t + 1) * kstep;
            const char* a2 = last ? nA : cA + (size_t)(t + 2) * kstep; const char* b2 = last ? nB : cB + (size_t)(t + 2) * kstep;
            const char* a3 = a2 + kstep; const char* b3 = b2 + kstep;
            if (last && has_next) S.a_ready(nxt);
            if constexpr (SP2) {
            PG8_LDB(B0, 0, 0); PG8_LDB(B1, 0, 1); PG8_SCHED; PG8_LDA(At, 0, 0); PG8_STAGE(PG8_SA(1, 1), a1 + hstep, voffA);
            PG8_WAIT_V(8); PG8_WAIT_L(0); PG8_BAR; PG8_MMA(0, 0, At, B0); PG8_MMA(0, 1, At, B1); PG8_BAR; PG8_SCHED;
            PG8_LDA(At, 0, 1); PG8_STAGE(PG8_SB(0, 0), b2, voffB); PG8_STAGE(PG8_SB(0, 1), b2 + hstep, voffB); PG8_STAGE(PG8_SA(0, 0), a2, voffA);
            PG8_WAIT_V(8); PG8_WAIT_L(0); PG8_BAR; PG8_MMA(1, 0, At, B0); PG8_MMA(1, 1, At, B1); PG8_BAR; PG8_SCHED;
            PG8_LDB(B0, 1, 0); PG8_LDB(B1, 1, 1); PG8_SCHED; PG8_LDA(At, 1, 0); PG8_STAGE(PG8_SA(0, 1), a2 + hstep, voffA);
            PG8_WAIT_V(8); PG8_WAIT_L(0); PG8_BAR; PG8_MMA(0, 0, At, B0); PG8_MMA(0, 1, At, B1); PG8_BAR; PG8_SCHED;
            PG8_LDA(At, 1, 1); PG8_STAGE(PG8_SB(1, 0), b3, voffB); PG8_STAGE(PG8_SB(1, 1), b3 + hstep, voffB); PG8_STAGE(PG8_SA(1, 0), a3, voffA);
            PG8_WAIT_V(8); PG8_WAIT_L(0); PG8_BAR; PG8_MMA(1, 0, At, B0); PG8_MMA(1, 1, At, B1); PG8_BAR; PG8_SCHED;
            } else {
            PG8_LDB(B0, 0, 0); PG8_SCHED; PG8_LDA(At, 0, 0); PG8_STAGE(PG8_SA(1, 1), a1 + hstep, voffA);
            PG8_WAIT_L(8); PG8_BAR; PG8_WAIT_L(0); PG8_MMA(0, 0, At, B0); PG8_BAR; PG8_SCHED;
            PG8_LDB(B1, 0, 1); PG8_STAGE(PG8_SB(0, 0), b2, voffB);
            PG8_BAR; PG8_WAIT_L(0); PG8_MMA(0, 1, At, B1); PG8_BAR;
            PG8_LDA(At, 0, 1); PG8_STAGE(PG8_SA(0, 0), a2, voffA);
            PG8_BAR; PG8_WAIT_L(0); PG8_MMA(1, 0, At, B0); PG8_BAR; PG8_SCHED;
            PG8_STAGE(PG8_SB(0, 1), b2 + hstep, voffB);
            PG8_WAIT_V(6); PG8_BAR; PG8_MMA(1, 1, At, B1); PG8_BAR;
            PG8_LDB(B0, 1, 0); PG8_SCHED; PG8_LDA(At, 1, 0); PG8_STAGE(PG8_SA(0, 1), a2 + hstep, voffA);
            PG8_WAIT_L(8); PG8_BAR; PG8_WAIT_L(0); PG8_MMA(0, 0, At, B0); PG8_BAR; PG8_SCHED;
            PG8_LDB(B1, 1, 1); PG8_STAGE(PG8_SB(1, 0), b3, voffB);
            PG8_BAR; PG8_WAIT_L(0); PG8_MMA(0, 1, At, B1); PG8_BAR;
            PG8_LDA(At, 1, 1); PG8_STAGE(PG8_SA(1, 0), a3, voffA);
            PG8_BAR; PG8_WAIT_L(0); PG8_MMA(1, 0, At, B0); PG8_BAR; PG8_SCHED;
            PG8_STAGE(PG8_SB(1, 1), b3 + hstep, voffB);
            PG8_WAIT_V(6); PG8_BAR; PG8_MMA(1, 1, At, B1); PG8_BAR;
            }
        }
        if constexpr (ALIGN_EPI) { if (wr == 0) PG8_BAR; }
        if constexpr (!Epi::AFTER_DRAIN) { E(acc, cur, wr, wc, fr, fq); S.done(cur); }
        if (!has_next) break;
#pragma unroll
        for (int a = 0; a < 2; ++a)
#pragma unroll
            for (int b = 0; b < 2; ++b)
#pragma unroll
                for (int m = 0; m < 4; ++m)
#pragma unroll
                    for (int n = 0; n < 2; ++n) acc[a][b][m][n] = (f32x4){0.f, 0.f, 0.f, 0.f};
        cur = nxt; cA = nA; cB = nB; ++ui;
        if constexpr (ALIGN_EPI) { if (wr == 1) PG8_BAR; }
    }
    PG8_WAIT_V(0);
    if constexpr (!ALIGN_EPI) { if (wr == 0) PG8_BAR; }
    PG8_BAR;
    if constexpr (Epi::AFTER_DRAIN) { E.fused(acc, cur, wr, wc, fr, fq, lds, wid, lane); S.done(cur); }
#undef PG8_SA
#undef PG8_SB
#undef PG8_STAGE
#undef PG8_LDA
#undef PG8_LDB
#undef PG8_MMA
#undef PG8_WAIT_V
#undef PG8_WAIT_L
#undef PG8_BAR
#undef PG8_SCHED
}
}

constexpr int BATCH = 16, SEQ = 2048, DM = 2048, T = BATCH * SEQ, DEPTH = 2;
constexpr int NMEM = 256, DIN = 4096, MEMW = 512;
constexpr int PEER_H = 8, PEER_N = 16384;
constexpr int NWAVES = 8, NTHREADS = NWAVES * 64;
constexpr float EPS = 1e-6f;
constexpr int QA = 0, KA = 768, VA = 1024, QB = 1280, KB = 1792, VB = 2304, QC = 2816, KC = 3584, VC = 3840;
constexpr int OA = 0, OB = 768, OC = 1280;

constexpr size_t MiB = 1u << 20;
constexpr size_t WS_CTL = 0, CTL_ZERO_BYTES = 2 * MiB;
constexpr size_t WS_ROWSQ = 256 * 1024;
constexpr size_t WS_ROPE = 83 * MiB, WS_BIASA = 83 * MiB + 16384;
constexpr size_t WS_WIN = 2 * MiB, WS_WOUT = 34 * MiB, WS_WMQ = 50 * MiB, WS_WMKV = 54 * MiB, WS_WMO = 62 * MiB, WS_WPQ = 66 * MiB, WS_PKEYS = 82 * MiB;
constexpr size_t WS_MEMN = 84 * MiB, WS_KVM = 116 * MiB, WS_PU = 132 * MiB, WS_PV = 260 * MiB, WS_XN = 388 * MiB, WS_QKV = 516 * MiB, WS_ATT = 772 * MiB;
constexpr size_t WS_QM = 900 * MiB, WS_OM = 932 * MiB, WS_END = 964 * MiB;
constexpr size_t WS_QP = WS_QKV, WS_PIDX = WS_QKV + 128 * MiB, WS_PGATE = WS_QKV + 144 * MiB, WS_PARTI = WS_QKV + 160 * MiB;
constexpr size_t WS_XQH = 900 * MiB, WS_XQL = 932 * MiB;
constexpr int CW_BAR = 4096;

constexpr int RING_OFF = 0, RING_BYTES = 131072;
constexpr int LDSCTL_OFF = RING_BYTES, MISC_OFF = LDSCTL_OFF + 320;
constexpr int LDS_BYTES = 147456;

#define GAS __attribute__((address_space(1)))
#define LAS __attribute__((address_space(3)))
typedef unsigned short bf16;
typedef unsigned v4u __attribute__((ext_vector_type(4)));
typedef unsigned v2u __attribute__((ext_vector_type(2)));
typedef float f32x4 __attribute__((ext_vector_type(4)));
typedef float f32x16 __attribute__((ext_vector_type(16)));
typedef short bf16x8 __attribute__((ext_vector_type(8)));
typedef GAS unsigned gu32;
#define LDS_WAIT() asm volatile("s_waitcnt lgkmcnt(0)" ::: "memory")
#define VM_WAIT() asm volatile("s_waitcnt vmcnt(0)" ::: "memory")
__device__ __forceinline__ unsigned f2bf(float f) { unsigned u = __builtin_bit_cast(unsigned, f); return (u + 0x7fffu + ((u >> 16) & 1u)) >> 16; }
__device__ __forceinline__ unsigned pk2(float lo, float hi) { return f2bf(lo) | (f2bf(hi) << 16); }
__device__ __forceinline__ float bflo(unsigned w) { return __builtin_bit_cast(float, w << 16); }
__device__ __forceinline__ float bfhi(unsigned w) { return __builtin_bit_cast(float, w & 0xffff0000u); }

__device__ __forceinline__ float shx(float v, int k, int lane) { return __builtin_bit_cast(float, __builtin_amdgcn_ds_bpermute((lane ^ k) << 2, __builtin_bit_cast(int, v))); }
#define XB_TMO      128
#define XB_XCNT(j)  (256  + 64 * (j))
#define XB_XSUB(j)  (1280 + 64 * (j))
#define XB_XGEN(j)  (2304 + 64 * (j))
#define XB_TOP      3328
#define XB_TOPGEN   3392
#define XCD_BAR_WORDS 3456
#define XB_SPIN_CAP (1u << 18)

__device__ __forceinline__ unsigned xb_ld(unsigned* p)              { return __hip_atomic_load(p, __ATOMIC_RELAXED, __HIP_MEMORY_SCOPE_AGENT); }
__device__ __forceinline__ unsigned xb_add(unsigned* p, unsigned v) { return __hip_atomic_fetch_add(p, v, __ATOMIC_RELAXED, __HIP_MEMORY_SCOPE_AGENT); }
__device__ __forceinline__ unsigned xb_xcc_id() { return (unsigned)__builtin_amdgcn_s_getreg((3 << 11) | 20) & 0xFu; }
#define XB_SPIN(cond, bar) do { unsigned _sp = 0; while (cond) { __builtin_amdgcn_s_sleep(1); \
    if ((++_sp & 255u) == 0u) { if (xb_ld(&(bar)[XB_TMO])) break; if (_sp > XB_SPIN_CAP) { atomicAdd(&(bar)[XB_TMO], 1u); break; } } } } while (0)

struct XcdBarrier {
    unsigned* bar; unsigned x;
    volatile LAS unsigned* st;
};

__device__ __forceinline__ XcdBarrier xcd_barrier_post(unsigned* bar, volatile LAS unsigned* st) {
    XcdBarrier b; b.bar = bar; b.x = xb_xcc_id(); b.st = st;
    if (threadIdx.x == 0) (void)xb_add(&bar[XB_XCNT(b.x)], 1u);
    return b;
}
__device__ __forceinline__ void xcd_barrier_complete(unsigned* bar, unsigned x, unsigned& nloc, unsigned& nx) {
    const unsigned G = gridDim.x * gridDim.y * gridDim.z;
    unsigned sum, cnt, mine, sp = 0u;
    for (;;) {
        sum = 0u; cnt = 0u; mine = 0u;
#pragma unroll
        for (unsigned j = 0; j < 16; ++j) { const unsigned c = xb_ld(&bar[XB_XCNT(j)]); sum += c; cnt += (c > 0u) ? 1u : 0u; mine = (j == x) ? c : mine; }
        if (sum == G) break;
        __builtin_amdgcn_s_sleep(1);
        if ((++sp & 255u) == 0u) { if (xb_ld(&bar[XB_TMO])) break; if (sp > XB_SPIN_CAP) { atomicAdd(&bar[XB_TMO], 1u); break; } }
    }
    nloc = mine > 0u ? mine : 1u; nx = cnt > 0u ? cnt : 1u;
}

__device__ __forceinline__ void xcd_barrier(const XcdBarrier& b) {
    asm volatile("s_waitcnt vmcnt(0)" ::: "memory");
    __syncthreads();
    if (threadIdx.x == 0) {
        unsigned* bar = b.bar;
        __builtin_amdgcn_s_waitcnt(0);
        unsigned nloc = b.st[0], nx = b.st[1];
        if (nloc == 0u) { xcd_barrier_complete(bar, b.x, nloc, nx); b.st[0] = nloc; b.st[1] = nx; }
        const unsigned old = xb_add(&bar[XB_XSUB(b.x)], 1u);
        const unsigned gen = old / nloc;
        if (old + 1u == (gen + 1u) * nloc) {
            __builtin_amdgcn_fence(__ATOMIC_RELEASE, "agent");
            asm volatile("s_waitcnt vmcnt(0)" ::: "memory");
            const unsigned og = xb_add(&bar[XB_TOP], 1u);
            const unsigned tg = og / nx;
            if (og + 1u == (tg + 1u) * nx) xb_add(&bar[XB_TOPGEN], 1u);
            else XB_SPIN(xb_ld(&bar[XB_TOPGEN]) == tg, bar);
            __builtin_amdgcn_fence(__ATOMIC_ACQUIRE, "agent");
            xb_add(&bar[XB_XGEN(b.x)], 1u);
            asm volatile("s_waitcnt vmcnt(0)" ::: "memory");
        } else {
            XB_SPIN(xb_ld(&bar[XB_XGEN(b.x)]) == gen, bar);
            __builtin_amdgcn_fence(__ATOMIC_ACQUIRE, "agent");
            asm volatile("s_waitcnt vmcnt(0)" ::: "memory");
        }
    }
    __syncthreads();
}

__device__ __forceinline__ float wave_sum(float v, int lane) {
#pragma unroll
    for (int o = 1; o < 64; o <<= 1) v += shx(v, o, lane);
    return v;
}
__device__ __forceinline__ void* ldptr(LAS unsigned char* lds, int i) {
    const unsigned long long v = ((const LAS unsigned long long*)(lds + LDSCTL_OFF + 1024))[i];
    const unsigned lo = __builtin_amdgcn_readfirstlane((unsigned)v), hi = __builtin_amdgcn_readfirstlane((unsigned)(v >> 32));
    return (void*)(((unsigned long long)hi << 32) | lo);
}
struct OffsetOrder {
    pg8::StaticOrder S;
    __device__ void init(int M, int N, int G, int c, int off) { S.init(M, N, G, (c + G - off % G) % G); }
    __device__ bool next(int i, pg8::Unit& u) const { return S.next(i, u); }
    __device__ __forceinline__ void a_ready(const pg8::Unit&) const {}
    __device__ __forceinline__ void done(const pg8::Unit&) const {}
};

template <bool PERMQKV>
__device__ __forceinline__ void transpose_item(const float* W, int K, int N, bf16* WT, LAS float* scr, int item, int lane, const float* gk = nullptr) {
    const int nblk = N / 32, kb = item / nblk, nb = item % nblk, k0 = 64 * kb, n0 = 32 * nb;
    int d0 = n0;
    if (PERMQKV) { const int within = n0 & 255; d0 = (n0 & ~255) + 128 * ((within >> 5) & 1) + 32 * (within >> 6); }
#pragma unroll
    for (int i = 0; i < 8; ++i) { const int kk = 8 * i + (lane >> 3), nn = 4 * (lane & 7);
        const f32x4 w4 = *(const GAS f32x4*)(W + (size_t)(k0 + kk) * N + n0 + nn) * (gk ? gk[k0 + kk] : 1.f);
        scr[kk * 33 + nn] = w4[0]; scr[kk * 33 + nn + 1] = w4[1]; scr[kk * 33 + nn + 2] = w4[2]; scr[kk * 33 + nn + 3] = w4[3]; }
    LDS_WAIT(); asm volatile("" ::: "memory");
    const int c = lane & 7;
#pragma unroll
    for (int j = 0; j < 4; ++j) { const int n = (lane >> 3) + 8 * j; const LAS float* s = scr + (8 * c) * 33 + n;
        v4u o; o.x = pk2(s[0 * 33], s[1 * 33]); o.y = pk2(s[2 * 33], s[3 * 33]); o.z = pk2(s[4 * 33], s[5 * 33]); o.w = pk2(s[6 * 33], s[7 * 33]);
        *(GAS v4u*)(WT + (size_t)(d0 + n) * K + k0 + 8 * c) = o; }
    LDS_WAIT(); asm volatile("" ::: "memory");
}
__device__ __forceinline__ void convert_bf16(const float* src, bf16* dst, size_t n, size_t gtid, size_t nthreads) {
    for (size_t i = gtid * 8; i < n; i += nthreads * 8) {
        const f32x4 a = *(const GAS f32x4*)(src + i), b = *(const GAS f32x4*)(src + i + 4);
        v4u o; o.x = pk2(a[0], a[1]); o.y = pk2(a[2], a[3]); o.z = pk2(b[0], b[1]); o.w = pk2(b[2], b[3]);
        *(GAS v4u*)(dst + i) = o;
    }
}
__device__ __forceinline__ int t5_bucket(int rel) {
    const int n = rel < 0 ? -rel : rel;
    const int b = n < 8 ? n : n < 12 ? 8 : n < 16 ? 9 : n < 23 ? 10 : n < 32 ? 11 : n < 46 ? 12 : n < 64 ? 13 : n < 91 ? 14 : 15;
    return b + (rel > 0 ? 16 : 0);
}
__constant__ float ROPE_INV[16] = {1.000000000e+00f, 5.623413324e-01f, 3.162277639e-01f, 1.778279394e-01f, 1.000000015e-01f, 5.623413250e-02f, 3.162277490e-02f, 1.778279431e-02f,
                                   9.999999776e-03f, 5.623413250e-03f, 3.162277630e-03f, 1.778279431e-03f, 1.000000047e-03f, 5.623413017e-04f, 3.162277571e-04f, 1.778279402e-04f};

__device__ __forceinline__ void rms_row_to_bf16(const float* xrow, const float* g0, bf16* o0, const float* g1, bf16* o1, int lane) {
    const GAS f32x4* xr = (const GAS f32x4*)xrow + lane;
    f32x4 v[8]; float s = 0.f;
#pragma unroll
    for (int j = 0; j < 8; ++j) { v[j] = xr[64 * j]; s += (v[j].x * v[j].x + v[j].y * v[j].y) + (v[j].z * v[j].z + v[j].w * v[j].w); }
    const float rstd = 1.f / sqrtf(wave_sum(s, lane) * (1.f / DM) + EPS);
    {   const GAS f32x4* gr = (const GAS f32x4*)g0 + lane; GAS v2u* o8 = (GAS v2u*)o0 + lane;
#pragma unroll
        for (int j = 0; j < 8; ++j) { const f32x4 gg = gr[64 * j]; v2u w; w.x = pk2(v[j].x * rstd * gg.x, v[j].y * rstd * gg.y); w.y = pk2(v[j].z * rstd * gg.z, v[j].w * rstd * gg.w); o8[64 * j] = w; } }
    if (g1) { const GAS f32x4* gr = (const GAS f32x4*)g1 + lane; GAS v2u* o8 = (GAS v2u*)o1 + lane;
#pragma unroll
        for (int j = 0; j < 8; ++j) { const f32x4 gg = gr[64 * j]; v2u w; w.x = pk2(v[j].x * rstd * gg.x, v[j].y * rstd * gg.y); w.y = pk2(v[j].z * rstd * gg.z, v[j].w * rstd * gg.w); o8[64 * j] = w; } }
}
__device__ __forceinline__ void prep_rows2(const float* x0, bf16* o0, u64_t* sq, int lane) {
    f32x4 v[2][8];
#pragma unroll
    for (int q = 0; q < 2; ++q) { const GAS f32x4* xr = (const GAS f32x4*)(x0 + (size_t)q * DM) + lane;
#pragma unroll
        for (int j = 0; j < 8; ++j) v[q][j] = xr[64 * j]; }
#pragma unroll
    for (int q = 0; q < 2; ++q) { GAS v2u* o8 = (GAS v2u*)(o0 + (size_t)q * DM) + lane; float s = 0.f;
#pragma unroll
        for (int j = 0; j < 8; ++j) { const f32x4 a = v[q][j]; s += (a.x * a.x + a.y * a.y) + (a.z * a.z + a.w * a.w); v2u w; w.x = pk2(a.x, a.y); w.y = pk2(a.z, a.w); o8[64 * j] = w; }
        s = wave_sum(s, lane);
        if (lane == 0) sq[q] = rowsq_fx(s); }
}
__device__ __forceinline__ void norm_rows(const float* X, const float* g, bf16* XN, int gw, int NGW, int lane) {
    for (int m = gw; m < T; m += NGW) rms_row_to_bf16(X + (size_t)m * DM, g, XN + (size_t)m * DM, nullptr, nullptr, lane);
}

template <int TYPE>
__device__ __forceinline__ void naive_attn_item(const bf16* QKV, bf16* ATT, int b, int grow, int head, int lane, const float* biasA, const float* sink, const float* rpb) {
    const int tpos = grow * 64 + lane; const size_t trow = (size_t)b * SEQ + tpos;
    int qcol, kcol, vcol, ocol;
    if (TYPE == 0) { qcol = QA + head * 64; kcol = KA + (head / 3) * 64; vcol = VA + (head / 3) * 64; ocol = OA + head * 64; }
    else if (TYPE == 1) { qcol = QB + head * 64; kcol = KB + head * 64; vcol = VB + head * 64; ocol = OB + head * 64; }
    else { qcol = QC + head * 64; kcol = KC + (head / 3) * 64; vcol = VC + (head / 3) * 64; ocol = OC + head * 64; }
    float q[64], o[64];
#pragma unroll
    for (int c = 0; c < 8; ++c) { const v4u w = *(const GAS v4u*)(QKV + trow * DIN + qcol + 8 * c);
        q[8 * c + 0] = bflo(w.x); q[8 * c + 1] = bfhi(w.x); q[8 * c + 2] = bflo(w.y); q[8 * c + 3] = bfhi(w.y); q[8 * c + 4] = bflo(w.z); q[8 * c + 5] = bfhi(w.z); q[8 * c + 6] = bflo(w.w); q[8 * c + 7] = bfhi(w.w); }
#pragma unroll
    for (int d = 0; d < 64; ++d) o[d] = 0.f;
    float m = -1e30f, l = 0.f;
    int j0, j1;
    if (TYPE == 0) { j0 = grow * 64 - 128; if (j0 < 0) j0 = 0; j1 = grow * 64 + 63 + 128; if (j1 > SEQ - 1) j1 = SEQ - 1; }
    else if (TYPE == 1) { int r0 = grow - 4; r0 = r0 < 0 ? 0 : (r0 > 24 ? 24 : r0); j0 = r0 * 64; j1 = j0 + 511; }
    else { j0 = 0; j1 = SEQ - 1; }
    int c0 = lane - 8; c0 = c0 < 0 ? 0 : (c0 > 48 ? 48 : c0);
#pragma unroll 1
    for (int j = j0; j <= j1; ++j) {
        const bf16* krow = QKV + ((size_t)b * SEQ + j) * DIN;
        float s = 0.f;
#pragma unroll
        for (int c = 0; c < 8; ++c) { const v4u w = *(const GAS v4u*)(krow + kcol + 8 * c);
            s += q[8 * c + 0] * bflo(w.x) + q[8 * c + 1] * bfhi(w.x) + q[8 * c + 2] * bflo(w.y) + q[8 * c + 3] * bfhi(w.y) + q[8 * c + 4] * bflo(w.z) + q[8 * c + 5] * bfhi(w.z) + q[8 * c + 6] * bflo(w.w) + q[8 * c + 7] * bfhi(w.w); }
        bool valid = true;
        if (TYPE == 0) { const int rel = j - tpos; valid = (rel >= -128 && rel <= 128); if (valid) s += biasA[head * 257 + rel + 128]; }
        if (TYPE == 1) { const int kr = j >> 6, kc = j & 63; valid = (kc >= c0 && kc < c0 + 16); if (valid) s += rpb[(head * 15 + (kr - grow + 7)) * 31 + (kc - lane + 15)]; }
        const float mn = valid ? fmaxf(m, s) : m;
        const float a = __expf(m - mn);
        const float p = valid ? __expf(s - mn) : 0.f;
        l = l * a + p; m = mn;
#pragma unroll
        for (int c = 0; c < 8; ++c) { const v4u w = *(const GAS v4u*)(krow + vcol + 8 * c);
            o[8 * c + 0] = o[8 * c + 0] * a + p * bflo(w.x); o[8 * c + 1] = o[8 * c + 1] * a + p * bfhi(w.x); o[8 * c + 2] = o[8 * c + 2] * a + p * bflo(w.y); o[8 * c + 3] = o[8 * c + 3] * a + p * bfhi(w.y);
            o[8 * c + 4] = o[8 * c + 4] * a + p * bflo(w.z); o[8 * c + 5] = o[8 * c + 5] * a + p * bfhi(w.z); o[8 * c + 6] = o[8 * c + 6] * a + p * bflo(w.w); o[8 * c + 7] = o[8 * c + 7] * a + p * bfhi(w.w); }
    }
    if (TYPE == 0) l += __expf(sink[head] - m);
    const float inv = 1.f / l;
#pragma unroll
    for (int c = 0; c < 8; ++c) { v4u w; w.x = pk2(o[8 * c + 0] * inv, o[8 * c + 1] * inv); w.y = pk2(o[8 * c + 2] * inv, o[8 * c + 3] * inv); w.z = pk2(o[8 * c + 4] * inv, o[8 * c + 5] * inv); w.w = pk2(o[8 * c + 6] * inv, o[8 * c + 7] * inv);
        *(GAS v4u*)(ATT + trow * DM + ocol + 8 * c) = w; }
}
__device__ __forceinline__ float rdl(float v, int l) { return __builtin_bit_cast(float, __builtin_amdgcn_readlane(__builtin_bit_cast(int, v), l)); }
__device__ __forceinline__ void naive_mem_item(const bf16* QM, const bf16* KVM, bf16* OM, const float* gq, size_t trow, int b, int head, int lane) {
    const unsigned qw = *(const GAS unsigned*)(QM + trow * MEMW + head * 128 + 2 * lane);
    float q0 = bflo(qw), q1 = bfhi(qw);
    const float ss = wave_sum(q0 * q0 + q1 * q1, lane);
    const float r = 0.08838834764831845f / sqrtf(ss * (1.f / 128.f) + EPS);
    q0 *= r * gq[2 * lane]; q1 *= r * gq[2 * lane + 1];
    const bf16* kbase = KVM + ((size_t)b * NMEM + lane) * 1024 + head * 128;
    float s[4] = {0.f, 0.f, 0.f, 0.f};
#pragma unroll 1
    for (int c = 0; c < 16; ++c) {
        float qa[8];
#pragma unroll
        for (int e = 0; e < 4; ++e) { qa[2 * e] = rdl(q0, 4 * c + e); qa[2 * e + 1] = rdl(q1, 4 * c + e); }
#pragma unroll
        for (int i = 0; i < 4; ++i) { const v4u w = *(const GAS v4u*)(kbase + (size_t)i * 64 * 1024 + 8 * c);
            s[i] += qa[0] * bflo(w.x) + qa[1] * bfhi(w.x) + qa[2] * bflo(w.y) + qa[3] * bfhi(w.y) + qa[4] * bflo(w.z) + qa[5] * bfhi(w.z) + qa[6] * bflo(w.w) + qa[7] * bfhi(w.w); }
    }
    float m = fmaxf(fmaxf(s[0], s[1]), fmaxf(s[2], s[3]));
#pragma unroll
    for (int o = 1; o < 64; o <<= 1) m = fmaxf(m, shx(m, o, lane));
    float p[4]; float l = 0.f;
#pragma unroll
    for (int i = 0; i < 4; ++i) { p[i] = __expf(s[i] - m); l += p[i]; }
    l = wave_sum(l, lane);
    const bf16* vbase = KVM + ((size_t)b * NMEM) * 1024 + 512 + head * 128 + 2 * lane;
    float o0 = 0.f, o1 = 0.f;
#pragma unroll
    for (int i = 0; i < 4; ++i) {
#pragma unroll 4
        for (int jj = 0; jj < 64; ++jj) { const float pj = rdl(p[i], jj); const unsigned w = *(const GAS unsigned*)(vbase + (size_t)(64 * i + jj) * 1024); o0 += pj * bflo(w); o1 += pj * bfhi(w); }
    }
    const float inv = 1.f / l;
    *(GAS unsigned*)(OM + trow * MEMW + head * 128 + 2 * lane) = pk2(o0 * inv, o1 * inv);
}
__device__ __forceinline__ void mixnorm_rows(bf16* ATT, const float* g, int gw, int NGW, int lane) {
    for (int m = gw; m < T; m += NGW) {
        GAS v4u* p = (GAS v4u*)(ATT + (size_t)m * DM + 32 * lane);
        v4u w[4]; float f[32]; float ss = 0.f;
#pragma unroll
        for (int c = 0; c < 4; ++c) { w[c] = p[c];
            f[8 * c + 0] = bflo(w[c].x); f[8 * c + 1] = bfhi(w[c].x); f[8 * c + 2] = bflo(w[c].y); f[8 * c + 3] = bfhi(w[c].y); f[8 * c + 4] = bflo(w[c].z); f[8 * c + 5] = bfhi(w[c].z); f[8 * c + 6] = bflo(w[c].w); f[8 * c + 7] = bfhi(w[c].w); }
#pragma unroll
        for (int i = 0; i < 32; ++i) ss += f[i] * f[i];
        const int grp = lane < 24 ? 0 : (lane < 40 ? 1 : 2);
        const float sa = wave_sum(grp == 0 ? ss : 0.f, lane), sb = wave_sum(grp == 1 ? ss : 0.f, lane), sc = wave_sum(grp == 2 ? ss : 0.f, lane);
        const float r = grp == 0 ? 1.f / sqrtf(sa * (1.f / 768.f) + EPS) : (grp == 1 ? 1.f / sqrtf(sb * (1.f / 512.f) + EPS) : 1.f / sqrtf(sc * (1.f / 768.f) + EPS));
        const float* gg = g + 32 * lane;
#pragma unroll
        for (int c = 0; c < 4; ++c) { const f32x4 g0 = *(const GAS f32x4*)(gg + 8 * c), g1 = *(const GAS f32x4*)(gg + 8 * c + 4);
            v4u o; o.x = pk2(f[8 * c + 0] * r * g0[0], f[8 * c + 1] * r * g0[1]); o.y = pk2(f[8 * c + 2] * r * g0[2], f[8 * c + 3] * r * g0[3]);
            o.z = pk2(f[8 * c + 4] * r * g1[0], f[8 * c + 5] * r * g1[1]); o.w = pk2(f[8 * c + 6] * r * g1[2], f[8 * c + 7] * r * g1[3]); p[c] = o; }
    }
}

#ifndef PEER_HD
#define PEER_HD __device__ __forceinline__
#define PEER_EXP(x) __expf(x)
#endif
template <int N> PEER_HD void bitonic_sort_desc(float* v) {
#pragma unroll
    for (int k = 2; k <= N; k <<= 1)
#pragma unroll
        for (int j = k >> 1; j > 0; j >>= 1)
#pragma unroll
            for (int i = 0; i < N; ++i) { const int l = i ^ j; if (l > i) { const bool desc = ((i & k) == 0); const float a = v[i], b = v[l]; const float hi = fmaxf(a, b), lo = fminf(a, b);
                v[i] = desc ? hi : lo; v[l] = desc ? lo : hi; } }
}
PEER_HD void merge_top16(float* a, const float* b) {
    float c[16];
#pragma unroll
    for (int i = 0; i < 16; ++i) c[i] = fmaxf(a[i], b[15 - i]);
#pragma unroll
    for (int j = 8; j > 0; j >>= 1)
#pragma unroll
        for (int i = 0; i < 16; ++i) { const int l = i ^ j; if (l > i) { const float x = c[i], y = c[l]; c[i] = fmaxf(x, y); c[l] = fminf(x, y); } }
#pragma unroll
    for (int i = 0; i < 16; ++i) a[i] = c[i];
}
PEER_HD void top16_of_64(float (&v)[64]) {
    bitonic_sort_desc<16>(&v[0]); bitonic_sort_desc<16>(&v[16]); bitonic_sort_desc<16>(&v[32]); bitonic_sort_desc<16>(&v[48]);
    merge_top16(&v[0], &v[16]); merge_top16(&v[32], &v[48]); merge_top16(&v[0], &v[32]);
}
PEER_HD float pack_idx(float s, unsigned idx, unsigned mask) { return __builtin_bit_cast(float, (__builtin_bit_cast(unsigned, s) & ~mask) | idx); }
PEER_HD unsigned low_bits(float s, unsigned mask) { return __builtin_bit_cast(unsigned, s) & mask; }
PEER_HD unsigned pick16(const float* a, unsigned i, unsigned mask) {
    unsigned r = 0;
#pragma unroll
    for (unsigned k = 0; k < 16; ++k) r = (i == k) ? low_bits(a[k], mask) : r;
    return r;
}
PEER_HD void peer_candidates(const float* a, const float* b, int* e, float* gate) {
    float c[64]; int n = 0;
#pragma unroll
    for (int i = 0; i < 16; ++i)
#pragma unroll
        for (int j = 0; j < 16; ++j) if ((i + 1) * (j + 1) <= 16) { c[n] = pack_idx(a[i] + b[j], (unsigned)(i * 16 + j), 0xffu); ++n; }
#pragma unroll
    for (int k = 50; k < 64; ++k) c[k] = -3.0e38f;
    top16_of_64(c);
    float mx = c[0], den = 0.f;
#pragma unroll
    for (int k = 0; k < 16; ++k) { const unsigned id = low_bits(c[k], 0xffu); const unsigned n0 = pick16(a, id >> 4, 0x7fu), n1 = pick16(b, id & 15u, 0x7fu);
        e[k] = (int)(n0 * 128u + n1); gate[k] = PEER_EXP(c[k] - mx); den += gate[k]; }
    const float inv = 1.f / den;
#pragma unroll
    for (int k = 0; k < 16; ++k) gate[k] *= inv;
}

__device__ __forceinline__ void peer_select_unit(const bf16* QP, const bf16* PK, int* PIDX, float* PGATE, int tb, int h, int wave, int lane) {
    const int hh = lane >> 5, tl = lane & 31; const size_t t = (size_t)tb * 256 + wave * 32 + tl;
    float ab[2][16];
#pragma unroll
    for (int p = 0; p < 2; ++p) {
        bf16x8 bq[8];
#pragma unroll
        for (int s = 0; s < 8; ++s) bq[s] = *(const GAS bf16x8*)(QP + t * DM + 256 * h + 128 * p + 16 * s + 8 * hh);
        float v[64];
#pragma unroll
        for (int nb = 0; nb < 4; ++nb) {
            f32x16 acc;
#pragma unroll
            for (int r = 0; r < 16; ++r) acc[r] = 0.f;
            const bf16* kp = PK + ((size_t)((h * 2 + p) * 128 + 32 * nb + tl)) * 128 + 8 * hh;
            bf16x8 ak[8];
#pragma unroll
            for (int s = 0; s < 8; ++s) ak[s] = *(const GAS bf16x8*)(kp + 16 * s);
#pragma unroll
            for (int s = 0; s < 8; ++s) acc = __builtin_amdgcn_mfma_f32_32x32x16_bf16(ak[s], bq[s], acc, 0, 0, 0);
#pragma unroll
            for (int r = 0; r < 16; ++r) v[16 * nb + r] = pack_idx(acc[r], (unsigned)(32 * nb + 8 * (r >> 2) + 4 * hh + (r & 3)), 0x7fu);
        }
        top16_of_64(v);
        float pv[16];
#pragma unroll
        for (int i = 0; i < 16; ++i) pv[i] = shx(v[i], 32, lane);
        merge_top16(&v[0], pv);
#pragma unroll
        for (int i = 0; i < 16; ++i) ab[p][i] = v[i];
    }
    int e[16]; float gate[16];
    peer_candidates(ab[0], ab[1], e, gate);
    if (hh == 0) { GAS v4u* o = (GAS v4u*)(PIDX + t * 128 + h * 16);
#pragma unroll
        for (int c = 0; c < 4; ++c) o[c] = (v4u){(unsigned)e[4 * c], (unsigned)e[4 * c + 1], (unsigned)e[4 * c + 2], (unsigned)e[4 * c + 3]}; }
    else { GAS f32x4* o = (GAS f32x4*)(PGATE + t * 128 + h * 16);
#pragma unroll
        for (int c = 0; c < 4; ++c) o[c] = (f32x4){gate[4 * c], gate[4 * c + 1], gate[4 * c + 2], gate[4 * c + 3]}; }
}

typedef float f32x2 __attribute__((ext_vector_type(2)));
typedef unsigned v6u __attribute__((ext_vector_type(6)));
typedef float v32f __attribute__((ext_vector_type(32)));
typedef v4u __attribute__((aligned(8))) v4u_a8;
constexpr float PU_SCALE6 = 90.0f, PV_SCALE6 = 5.65f;
__device__ __forceinline__ unsigned enc_e2m3(float v) {
    const float a = fminf(fabsf(v), 7.5f);
    unsigned code;
    if (a < 1.0f) code = (unsigned)__builtin_rintf(a * 8.f);
    else { const unsigned b = __builtin_bit_cast(unsigned, a) - 0x3F800000u; code = ((b + 0x7FFFFu + ((b >> 20) & 1u)) >> 20) + 8u; }
    return code | (v < 0.f ? 32u : 0u);
}
__device__ __forceinline__ void convert_fp6_rows(const float* src, unsigned char* dst, int nrows, float scale, const float* gain, int gw, int NGW, int lane) {
    for (int r = gw; r < nrows; r += NGW) {
        const float* sp = src + (size_t)r * DM + 4 * lane; const float* gp = gain ? gain + (size_t)(r / PEER_N) * DM + 4 * lane : nullptr;
        unsigned w[6] = {0u, 0u, 0u, 0u, 0u, 0u};
#pragma unroll
        for (int j = 0; j < 8; ++j) { f32x4 a = *(const GAS f32x4*)(sp + 256 * j) * scale; if (gp) a = a * *(const GAS f32x4*)(gp + 256 * j);
#pragma unroll
            for (int e = 0; e < 4; ++e) { const unsigned code = enc_e2m3(a[e]); const int bp = 6 * (4 * j + e), wi = bp >> 5, sh = bp & 31;
                w[wi] |= code << sh; if (sh > 26) w[wi + 1] |= code >> (32 - sh); } }
        unsigned char* dp = dst + (size_t)r * 1536 + 24 * lane;
        *(GAS v4u_a8*)dp = (v4u){w[0], w[1], w[2], w[3]}; *(GAS v2u*)(dp + 16) = (v2u){w[4], w[5]};
    }
}
constexpr float PV_SCALE4 = 5.65f, PU_SCALE4 = 90.0f;
__device__ __forceinline__ unsigned enc_e2m1(float v) {
    const float a = fabsf(v);
    const unsigned code = a < 0.25f ? 0u : a < 0.75f ? 1u : a < 1.25f ? 2u : a < 1.75f ? 3u : a < 2.5f ? 4u : a < 3.5f ? 5u : a < 5.0f ? 6u : 7u;
    return code | (v < 0.f ? 8u : 0u);
}
__device__ __forceinline__ void convert_fp4_rows(const float* src, unsigned char* dst, int nrows, float scale, const float* gain, int gw, int NGW, int lane) {
    for (int r0 = 2 * gw; r0 < nrows; r0 += 2 * NGW) {
        f32x4 a[2][8];
#pragma unroll
        for (int q = 0; q < 2; ++q) { const float* sp = src + (size_t)(r0 + q) * DM + 4 * lane;
#pragma unroll
            for (int j = 0; j < 8; ++j) a[q][j] = *(const GAS f32x4*)(sp + 256 * j); }
#pragma unroll
        for (int q = 0; q < 2; ++q) { const int r = r0 + q; const float* gp = gain ? gain + (size_t)(r / PEER_N) * DM + 4 * lane : nullptr;
            unsigned w[4] = {0u, 0u, 0u, 0u};
#pragma unroll
            for (int j = 0; j < 8; ++j) { f32x4 v = a[q][j] * scale; if (gp) v = v * *(const GAS f32x4*)(gp + 256 * j);
#pragma unroll
                for (int e = 0; e < 4; ++e) { const int i = 4 * j + e; w[i >> 3] |= enc_e2m1(v[e]) << (4 * (i & 7)); } }
            *(GAS v4u*)(dst + (size_t)r * 1024 + 16 * lane) = (v4u){w[0], w[1], w[2], w[3]}; }
    }
}
#define PG4_LOAD(buf, tab, idlo, idhi, g) do { _Pragma("unroll") for (int i_ = 0; i_ < PG6_R; ++i_) { const int k_ = (g) * PG6_R + i_; \
        const int e_ = __builtin_amdgcn_readlane(k_ < 64 ? idlo : idhi, k_ & 63); buf[i_] = __builtin_amdgcn_raw_buffer_load_b128(tab, (int)voff4, e_ * 1024, 0); } } while (0)
#define PG4_DOT1(buf, i_, dst) do { f32x2 a_ = {0.f, 0.f}; _Pragma("unroll") for (int c_ = 0; c_ < 4; ++c_) { const unsigned u_ = buf[i_][c_]; \
        a_ += __builtin_amdgcn_cvt_scalef32_pk_f32_fp4(u_, 1.0f, 0) * x[4 * c_ + 0]; a_ += __builtin_amdgcn_cvt_scalef32_pk_f32_fp4(u_, 1.0f, 1) * x[4 * c_ + 1]; \
        a_ += __builtin_amdgcn_cvt_scalef32_pk_f32_fp4(u_, 1.0f, 2) * x[4 * c_ + 2]; a_ += __builtin_amdgcn_cvt_scalef32_pk_f32_fp4(u_, 1.0f, 3) * x[4 * c_ + 3]; } dst = a_.x + a_.y; __builtin_amdgcn_sched_barrier(0); } while (0)
#define PG4_DOT(buf, g) do { float p_[8]; _Pragma("unroll") for (int i_ = 0; i_ < 8; ++i_) PG4_DOT1(buf, i_, p_[i_]); \
        float q_[4]; _Pragma("unroll") for (int i_ = 0; i_ < 4; ++i_) { const float keep_ = b5 ? p_[i_ + 4] : p_[i_], send_ = b5 ? p_[i_] : p_[i_ + 4]; q_[i_] = keep_ + shx(send_, 32, lane); } \
        float r_[2]; _Pragma("unroll") for (int i_ = 0; i_ < 2; ++i_) { const float keep_ = b4 ? q_[i_ + 2] : q_[i_], send_ = b4 ? q_[i_] : q_[i_ + 2]; r_[i_] = keep_ + shx(send_, 16, lane); } \
        float s_; { const float keep_ = b3 ? r_[1] : r_[0], send_ = b3 ? r_[0] : r_[1]; s_ = keep_ + shx(send_, 8, lane); } \
        s_ += shx(s_, 4, lane); s_ += shx(s_, 2, lane); s_ += shx(s_, 1, lane); \
        if ((lane & 7) == 0) wl[(g) * 8 + (lane >> 3)] = s_; } while (0)
#define PG4_AXPY(buf, g) do { _Pragma("unroll") for (int i_ = 0; i_ < PG6_R; ++i_) { const float w_ = wl[(g) * PG6_R + i_]; const f32x2 wv_ = {w_, w_}; \
        _Pragma("unroll") for (int c_ = 0; c_ < 4; ++c_) { const unsigned u_ = buf[i_][c_]; \
            y[4 * c_ + 0] += __builtin_amdgcn_cvt_scalef32_pk_f32_fp4(u_, 1.0f, 0) * wv_; y[4 * c_ + 1] += __builtin_amdgcn_cvt_scalef32_pk_f32_fp4(u_, 1.0f, 1) * wv_; \
            y[4 * c_ + 2] += __builtin_amdgcn_cvt_scalef32_pk_f32_fp4(u_, 1.0f, 2) * wv_; y[4 * c_ + 3] += __builtin_amdgcn_cvt_scalef32_pk_f32_fp4(u_, 1.0f, 3) * wv_; } \
        __builtin_amdgcn_sched_barrier(0); } } while (0)
#ifndef PG6_R
#define PG6_R 8
#endif
#define PG6_LOAD(buf, tab, idlo, idhi, g) do { _Pragma("unroll") for (int i_ = 0; i_ < PG6_R; ++i_) { const int k_ = (g) * PG6_R + i_; \
        const int e_ = __builtin_amdgcn_readlane(k_ < 64 ? idlo : idhi, k_ & 63); const unsigned char* rp_ = (tab) + (size_t)(unsigned)e_ * 1536u; \
        const v4u a_ = *(const GAS v4u_a8*)(rp_ + voff); const v2u b_ = *(const GAS v2u*)(rp_ + voff + 16); buf[i_] = (v6u){a_.x, a_.y, a_.z, a_.w, b_.x, b_.y}; } } while (0)
#define PG6_DOT1(buf, i_, dst) do { const v32f f_ = __builtin_amdgcn_cvt_scalef32_pk32_f32_fp6(buf[i_], 1.0f); f32x2 a_ = {0.f, 0.f}; \
        _Pragma("unroll") for (int c_ = 0; c_ < 16; ++c_) a_ += (f32x2){f_[2 * c_], f_[2 * c_ + 1]} * x[c_]; dst = a_.x + a_.y; __builtin_amdgcn_sched_barrier(0); } while (0)
#if PG6_R == 8
#define PG6_DOT(buf, g) do { float p_[8]; _Pragma("unroll") for (int i_ = 0; i_ < 8; ++i_) PG6_DOT1(buf, i_, p_[i_]); \
        float q_[4]; _Pragma("unroll") for (int i_ = 0; i_ < 4; ++i_) { const float keep_ = b5 ? p_[i_ + 4] : p_[i_], send_ = b5 ? p_[i_] : p_[i_ + 4]; q_[i_] = keep_ + shx(send_, 32, lane); } \
        float r_[2]; _Pragma("unroll") for (int i_ = 0; i_ < 2; ++i_) { const float keep_ = b4 ? q_[i_ + 2] : q_[i_], send_ = b4 ? q_[i_] : q_[i_ + 2]; r_[i_] = keep_ + shx(send_, 16, lane); } \
        float s_; { const float keep_ = b3 ? r_[1] : r_[0], send_ = b3 ? r_[0] : r_[1]; s_ = keep_ + shx(send_, 8, lane); } \
        s_ += shx(s_, 4, lane); s_ += shx(s_, 2, lane); s_ += shx(s_, 1, lane); \
        if ((lane & 7) == 0) wl[(g) * 8 + (lane >> 3)] = s_; } while (0)
#else
#define PG6_DOT(buf, g) do { float p_[4]; _Pragma("unroll") for (int i_ = 0; i_ < 4; ++i_) PG6_DOT1(buf, i_, p_[i_]); \
        float r_[2]; _Pragma("unroll") for (int i_ = 0; i_ < 2; ++i_) { const float keep_ = b5 ? p_[i_ + 2] : p_[i_], send_ = b5 ? p_[i_] : p_[i_ + 2]; r_[i_] = keep_ + shx(send_, 32, lane); } \
        float s_; { const float keep_ = b4 ? r_[1] : r_[0], send_ = b4 ? r_[0] : r_[1]; s_ = keep_ + shx(send_, 16, lane); } \
        s_ += shx(s_, 8, lane); s_ += shx(s_, 4, lane); s_ += shx(s_, 2, lane); s_ += shx(s_, 1, lane); \
        if ((lane & 15) == 0) wl[(g) * 4 + (lane >> 4)] = s_; } while (0)
#endif
#define PG6_AXPY(buf, g) do { _Pragma("unroll") for (int i_ = 0; i_ < PG6_R; ++i_) { const float w_ = wl[(g) * PG6_R + i_]; const f32x2 wv_ = {w_, w_}; \
        const v32f f_ = __builtin_amdgcn_cvt_scalef32_pk32_f32_fp6(buf[i_], 1.0f); _Pragma("unroll") for (int c_ = 0; c_ < 16; ++c_) y[c_] += (f32x2){f_[2 * c_], f_[2 * c_ + 1]} * wv_; __builtin_amdgcn_sched_barrier(0); } } while (0)
__device__ __forceinline__ unsigned shxu(unsigned v, int k, int lane) { return (unsigned)__builtin_amdgcn_ds_bpermute((lane ^ k) << 2, (int)v); }
__device__ __forceinline__ void wave_sort128(unsigned& a, unsigned& b, int lane) {
#pragma unroll
    for (int k = 2; k <= 128; k <<= 1) {
#pragma unroll
        for (int j = k >> 1; j > 0; j >>= 1) {
            if (j == 64) { const unsigned lo = a < b ? a : b, hi = a < b ? b : a; a = lo; b = hi; }
            else {
                const unsigned pa = shxu(a, j, lane), pb = shxu(b, j, lane);
                const bool lower = (lane & j) == 0;
                const bool asc_a = (lane & k) == 0, asc_b = ((lane + 64) & k) == 0;
                const bool take_min_a = (lower == asc_a), take_min_b = (lower == asc_b);
                a = take_min_a ? (a < pa ? a : pa) : (a < pa ? pa : a);
                b = take_min_b ? (b < pb ? b : pb) : (b < pb ? pb : b);
            }
        }
    }
}
#ifndef PEER_U_FP4
#define PEER_U_FP4 1
#endif
#if PEER_U_FP4
typedef v4u urow_t;
#define PGU_LOAD PG4_LOAD
#define PGU_DOT PG4_DOT
constexpr float PU_SCALE = PU_SCALE4; constexpr int PU_STRIDE = 1024;
#else
typedef v6u urow_t;
#define PGU_LOAD PG6_LOAD
#define PGU_DOT PG6_DOT
constexpr float PU_SCALE = PU_SCALE6; constexpr int PU_STRIDE = 1536;
#endif
constexpr float PU_SCALEI = 135.0f, PX_SCALEI = 20.0f;
__device__ __forceinline__ void peer_v_pass(bf16* XN, const unsigned char* PV6, const int* PIDX, const float* PGATE, const int* PARTI, float* X, u64_t* rowsq_out, LAS float* wl, int gw, int NGW, int lane) {
    const unsigned voff4 = 16u * (unsigned)lane, l4 = 4u * (unsigned)lane, l8 = 8u * (unsigned)lane, l16 = 16u * (unsigned)lane;
    constexpr int NG = 128 / PG6_R;
    const __amdgpu_buffer_rsrc_t PVr = __builtin_amdgcn_make_buffer_rsrc((void*)PV6, 0, PEER_N * 1024, 0x00020000);
    for (int t_ = gw; t_ < T; t_ += NGW) {
        int t = t_; asm volatile("" : "+s"(t));
        const char* pidx_t = (const char*)(PIDX + (size_t)t * 128); const char* pgate_t = (const char*)(PGATE + (size_t)t * 128);
        const int idlo = *(const GAS int*)(pidx_t + l4), idhi = *(const GAS int*)(pidx_t + l4 + 256);
        v4u AV[PG6_R], BV[PG6_R];
        PG4_LOAD(AV, PVr, idlo, idhi, 0);
        {
            int s0 = 0, s1 = 0;
#pragma unroll
            for (int sp = 0; sp < 8; ++sp) { const char* pp = (const char*)(PARTI + ((size_t)sp * T + t) * 128); s0 += *(const GAS int*)(pp + l4); s1 += *(const GAS int*)(pp + l4 + 256); }
            const float d0 = (float)s0 * (1.f / (PX_SCALEI * PU_SCALEI)), d1 = (float)s1 * (1.f / (PX_SCALEI * PU_SCALEI));
            const float g0 = *(const GAS float*)(pgate_t + l4), g1 = *(const GAS float*)(pgate_t + l4 + 256);
            const float w0 = g0 * 0.5f * d0 * (1.f + erff(d0 * 0.70710678118654752f)) * (1.f / PV_SCALE4), w1 = g1 * 0.5f * d1 * (1.f + erff(d1 * 0.70710678118654752f)) * (1.f / PV_SCALE4);
            wl[lane] = w0; wl[64 + lane] = w1;
            LDS_WAIT(); asm volatile("" ::: "memory");
        }
        f32x2 y[16];
#pragma unroll
        for (int i = 0; i < 16; ++i) y[i] = (f32x2){0.f, 0.f};
#pragma unroll 1
        for (int g = 0; g < NG; g += 2) {
            PG4_LOAD(BV, PVr, idlo, idhi, g + 1);
            PG4_AXPY(AV, g);
            if (g + 2 < NG) PG4_LOAD(AV, PVr, idlo, idhi, g + 2);
            PG4_AXPY(BV, g + 1);
        }
        {   char* xo = (char*)(X + (size_t)t * DM);
            char* xbo = (char*)(XN + (size_t)t * DM); float ss = 0.f;
#pragma unroll
            for (int j = 0; j < 8; ++j) { const v2u a = *(const GAS v2u*)(xbo + l8 + 512 * j); f32x4 v = (f32x4){bflo(a.x), bfhi(a.x), bflo(a.y), bfhi(a.y)}; v += (f32x4){y[2 * j].x, y[2 * j].y, y[2 * j + 1].x, y[2 * j + 1].y};
                if (X) *(GAS f32x4*)(xo + l16 + 1024 * j) = v;
                ss += (v[0] * v[0] + v[1] * v[1]) + (v[2] * v[2] + v[3] * v[3]); *(GAS v2u*)(xbo + l8 + 512 * j) = (v2u){pk2(v[0], v[1]), pk2(v[2], v[3])}; }
            if (rowsq_out) { ss = wave_sum(ss, lane); if (lane == 0) rowsq_out[t] = rowsq_fx(ss); } }
        LDS_WAIT(); asm volatile("" ::: "memory");
    }
}


__device__ __forceinline__ unsigned enc_i4(float v) { int q = (int)__builtin_rintf(v); q = q < -7 ? -7 : (q > 7 ? 7 : q); return (unsigned)q & 15u; }
__device__ __forceinline__ void convert_int4_plain(const float* src, unsigned char* dst, int nrows, float scale, const float* gain, int gw, int NGW, int lane) {
    for (int r0 = 2 * gw; r0 < nrows; r0 += 2 * NGW) {
        f32x4 a[2][8];
#pragma unroll
        for (int q = 0; q < 2; ++q) { const float* sp = src + (size_t)(r0 + q) * DM + 4 * lane;
#pragma unroll
            for (int j = 0; j < 8; ++j) a[q][j] = *(const GAS f32x4*)(sp + 256 * j); }
#pragma unroll
        for (int q = 0; q < 2; ++q) { const int r = r0 + q; const float* gp = gain ? gain + (size_t)(r / PEER_N) * DM + 4 * lane : nullptr;
#pragma unroll
            for (int j = 0; j < 8; ++j) { f32x4 v = a[q][j] * scale; if (gp) v = v * *(const GAS f32x4*)(gp + 256 * j);
                const unsigned w = enc_i4(v[0]) | (enc_i4(v[1]) << 4) | (enc_i4(v[2]) << 8) | (enc_i4(v[3]) << 12);
                *(GAS unsigned short*)(dst + (size_t)r * 1024 + 128 * j + 2 * lane) = (unsigned short)w; } }
    }
}
__device__ __forceinline__ void peer_xquant_unit(const bf16* XN, const u64_t* rowsq, unsigned* XQH, unsigned* XQL, int tb, int sl, int tid) {
    for (int it = tid; it < 256 * 32; it += NTHREADS) {
        const int t = tb * 256 + (it >> 5), c8 = it & 31;
        const float xs = PX_SCALEI * rowsq_rs(rowsq, t);
        const v4u w = *(const GAS v4u*)(XN + (size_t)t * DM + 256 * sl + 8 * c8);
        const float f[8] = {bflo(w.x), bfhi(w.x), bflo(w.y), bfhi(w.y), bflo(w.z), bfhi(w.z), bflo(w.w), bfhi(w.w)};
        unsigned hi = 0u, lo = 0u;
#pragma unroll
        for (int j = 0; j < 8; ++j) { int q = (int)__builtin_rintf(f[j] * xs); q = q < -119 ? -119 : (q > 119 ? 119 : q);
            const int xl = ((q + 8) & 15) - 8, xh = (q - xl) >> 4;
            hi |= ((unsigned)xh & 15u) << (4 * j); lo |= ((unsigned)xl & 15u) << (4 * j); }
        XQH[(size_t)t * 256 + 32 * sl + c8] = hi; XQL[(size_t)t * 256 + 32 * sl + c8] = lo;
    }
}
#define PI_LOADROWS(buf, tab, ids, i0) do { _Pragma("unroll") for (int i_ = 0; i_ < 8; ++i_) buf[i_] = __builtin_amdgcn_raw_buffer_load_b128(tab, ids[(i0) + i_] * 1024 + (int)soff, 0, 0); } while (0)
#define PI_LOADIDS(ids, t) do { const char* ip_ = (const char*)PIDX + ((size_t)(t) * 128 + 16 * g) * 4; _Pragma("unroll") for (int c_ = 0; c_ < 4; ++c_) { const v4u q_ = *(const GAS v4u*)(ip_ + 16 * c_); \
        ids[4 * c_] = (int)q_.x; ids[4 * c_ + 1] = (int)q_.y; ids[4 * c_ + 2] = (int)q_.z; ids[4 * c_ + 3] = (int)q_.w; } } while (0)
#define PI_UGROUP(buf, i0) do { _Pragma("unroll") for (int i_ = 0; i_ < 8; ++i_) { int ah_ = 0, al_ = 0; \
        _Pragma("unroll") for (int c_ = 0; c_ < 4; ++c_) { ah_ = __builtin_amdgcn_sdot8((int)buf[i_][c_], (int)xh[c_], ah_, false); al_ = __builtin_amdgcn_sdot8((int)buf[i_][c_], (int)xl[c_], al_, false); } \
        int p_ = 16 * ah_ + al_; p_ += __builtin_amdgcn_ds_bpermute((lane ^ 1) << 2, p_); p_ += __builtin_amdgcn_ds_bpermute((lane ^ 2) << 2, p_); p_ += __builtin_amdgcn_ds_bpermute((lane ^ 4) << 2, p_); \
        if (m == (((i0) + i_) >> 1)) { if (((i0) + i_) & 1) keep1 = p_; else keep0 = p_; } } } while (0)
__device__ __forceinline__ void peer_u_phase_i4(const unsigned* XQH, const unsigned* XQL, const unsigned char* PU, const int* PIDX, int* PARTI, int bid, int G, int wave, int lane) {
    const int s = bid & 7, nr = (G - s + 7) >> 3, q = (bid >> 3) * NWAVES + wave, stride = nr * NWAVES, g = lane >> 3, m = lane & 7;
    const unsigned soff = 128u * (unsigned)s + 16u * (unsigned)m;
    if (q >= T) return;
    const __amdgpu_buffer_rsrc_t PUr = __builtin_amdgcn_make_buffer_rsrc((void*)PU, 0, PEER_N * 1024, 0x00020000);
    int idc[16], idn[16]; v4u xh, xl, xhn, xln, A[8], B[8];
    PI_LOADIDS(idc, q);
    xh = *(const GAS v4u*)((const char*)XQH + (size_t)q * 1024 + soff); xl = *(const GAS v4u*)((const char*)XQL + (size_t)q * 1024 + soff);
    PI_LOADROWS(A, PUr, idc, 0);
    for (int t = q; t < T; t += stride) {
        const int tn = (t + stride < T) ? t + stride : t;
        PI_LOADROWS(B, PUr, idc, 8);
        PI_LOADIDS(idn, tn);
        xhn = *(const GAS v4u*)((const char*)XQH + (size_t)tn * 1024 + soff); xln = *(const GAS v4u*)((const char*)XQL + (size_t)tn * 1024 + soff);
        int keep0 = 0, keep1 = 0;
        PI_UGROUP(A, 0);
        PI_LOADROWS(A, PUr, idn, 0);
        PI_UGROUP(B, 8);
        *(GAS v2u*)(PARTI + ((size_t)s * T + t) * 128 + 2 * lane) = (v2u){(unsigned)keep0, (unsigned)keep1};
#pragma unroll
        for (int i = 0; i < 16; ++i) idc[i] = idn[i];
        xh = xhn; xl = xln;
    }
}

typedef short s16x4 __attribute__((ext_vector_type(4)));
typedef __attribute__((address_space(3))) const char* lds_cptr;
__device__ __forceinline__ s16x4 vtr(lds_cptr p) { return __builtin_bit_cast(s16x4, __builtin_amdgcn_ds_read_tr16_b64_v4i16((__attribute__((address_space(3))) s16x4*)p)); }
__device__ __forceinline__ unsigned cvtpk(float lo, float hi) { unsigned r; asm("v_cvt_pk_bf16_f32 %0, %1, %2" : "=v"(r) : "v"(lo), "v"(hi)); return r; }
constexpr int AT_K0 = 0, AT_V0 = 16384, AT_TAB = 32768;
constexpr float LOG2E = 1.4426950408889634f;
template <int TYPE>
__device__ __forceinline__ void attn_unit(LAS unsigned char* lds, const bf16* QKV, bf16* ATT, int b, int head, int qb, const float* tabsrc, float Cl2, float sinkl2, int tid) {
    const int lane = tid & 63, w = __builtin_amdgcn_readfirstlane(tid >> 6), hh = lane >> 5, l31 = lane & 31;
    int qcol, kcol, vcol, ocol;
    if (TYPE == 0) { qcol = QA + head * 64; kcol = KA + (head / 3) * 64; vcol = VA + (head / 3) * 64; ocol = OA + head * 64; }
    else if (TYPE == 1) { qcol = QB + head * 64; kcol = KB + head * 64; vcol = VB + head * 64; ocol = OB + head * 64; }
    else { qcol = QC + head * 64; kcol = KC + (head / 3) * 64; vcol = VC + (head / 3) * 64; ocol = OC + head * 64; }
    const int q0 = 256 * qb + 32 * w, qpos = q0 + l31;
    int t_begin, t_end;
    if (TYPE == 0) { t_begin = 4 * qb - 2; if (t_begin < 0) t_begin = 0; t_end = 4 * qb + 6; if (t_end > 32) t_end = 32; }
    else if (TYPE == 1) { int a = 4 * qb - 4; a = a < 0 ? 0 : (a > 24 ? 24 : a); int e = 4 * qb - 1; e = e < 0 ? 0 : (e > 24 ? 24 : e); t_begin = a; t_end = e + 8; }
    else { t_begin = 0; t_end = 32; }
    LAS float* tab = (LAS float*)(lds + AT_TAB);
    if (TYPE == 0) { for (int i = tid; i < 1024; i += NTHREADS) { const int rel = i - 448; tab[i] = (rel >= -128 && rel <= 128) ? tabsrc[head * 257 + rel + 128] * LOG2E - Cl2 : -1e30f; } }
    if (TYPE == 1) { for (int i = tid; i < 15 * 31; i += NTHREADS) tab[i] = tabsrc[head * 465 + i] * LOG2E - Cl2; }
    bf16x8 qf[4];
    {   const bf16* qp = QKV + ((size_t)b * SEQ + qpos) * DIN + qcol + 8 * hh;
#pragma unroll
        for (int s = 0; s < 4; ++s) qf[s] = *(const GAS bf16x8*)(qp + 16 * s); }
    const int srow = tid >> 3, sch = tid & 7;
    const bf16* kg = QKV + ((size_t)b * SEQ + srow) * DIN + kcol + sch * 8;
    const bf16* vg = QKV + ((size_t)b * SEQ + srow) * DIN + vcol + sch * 8;
    const int kst = srow * 128 + ((sch ^ ((srow >> 1) & 7)) * 16);
    const int vst = srow * 128 + (((sch >> 2) ^ ((srow >> 1) & 1)) * 64) + (sch & 3) * 16;
    int kread[4], vread[2];
#pragma unroll
    for (int s = 0; s < 4; ++s) kread[s] = l31 * 128 + (((2 * s + hh) ^ ((lane >> 1) & 7)) * 16);
#pragma unroll
    for (int db = 0; db < 2; ++db) vread[db] = (4 * hh + ((lane >> 2) & 3)) * 128 + ((db ^ ((lane >> 3) & 1)) * 64) + 32 * ((lane >> 4) & 1) + 8 * (lane & 3);
    f32x16 O0, O1;
#pragma unroll
    for (int r = 0; r < 16; ++r) { O0[r] = 0.f; O1[r] = 0.f; }
    float lsum = 0.f;
    const int rw = 4 * qb + (w >> 1), cq = 32 * (w & 1) + l31;
    int r0w = rw - 4; r0w = r0w < 0 ? 0 : (r0w > 24 ? 24 : r0w);
    int c0 = cq - 8; c0 = c0 < 0 ? 0 : (c0 > 48 ? 48 : c0);
    {   const v4u kr = *(const GAS v4u*)(kg + (size_t)t_begin * 64 * DIN), vr = *(const GAS v4u*)(vg + (size_t)t_begin * 64 * DIN);
        *(LAS v4u*)(lds + AT_K0 + kst) = kr; *(LAS v4u*)(lds + AT_V0 + vst) = vr; }
    __syncthreads();
    for (int t = t_begin; t < t_end; ++t) {
        const int cur = (t - t_begin) & 1;
        v4u kr, vr;
        if (t + 1 < t_end) { kr = *(const GAS v4u*)(kg + (size_t)(t + 1) * 64 * DIN); vr = *(const GAS v4u*)(vg + (size_t)(t + 1) * 64 * DIN); }
        bool need = true;
        if (TYPE == 0) need = (64 * t <= q0 + 31 + 128) && (64 * t + 63 >= q0 - 128);
        if (TYPE == 1) need = (t >= r0w) && (t < r0w + 8);
        if (need) {
            const lds_cptr kb_ = (lds_cptr)(lds + AT_K0 + cur * 8192), vb_ = (lds_cptr)(lds + AT_V0 + cur * 8192);
            bf16x8 kf[8];
#pragma unroll
            for (int s = 0; s < 4; ++s) { kf[2 * s] = *(const LAS bf16x8*)(kb_ + kread[s]); kf[2 * s + 1] = *(const LAS bf16x8*)(kb_ + kread[s] + 4096); }
            f32x16 S0, S1;
            if (TYPE == 2) {
#pragma unroll
                for (int r = 0; r < 16; ++r) { S0[r] = -Cl2; S1[r] = -Cl2; }
            } else if (TYPE == 0) {
                const LAS float* tb = tab + (64 * t - qpos + 448 + 4 * hh);
#pragma unroll
                for (int r = 0; r < 16; ++r) { S0[r] = tb[8 * (r >> 2) + (r & 3)]; S1[r] = tb[32 + 8 * (r >> 2) + (r & 3)]; }
            } else {
                const LAS float* tb = tab + ((t - rw + 7) * 31 - cq + 15 + 4 * hh);
                const int kc0 = 4 * hh - c0;
#pragma unroll
                for (int r = 0; r < 16; ++r) { const int ka = 8 * (r >> 2) + (r & 3), kb2 = 32 + ka;
                    S0[r] = ((unsigned)(ka + kc0) < 16u) ? tb[ka] : -1e30f; S1[r] = ((unsigned)(kb2 + kc0) < 16u) ? tb[kb2] : -1e30f; }
            }
            __builtin_amdgcn_sched_barrier(0);
#pragma unroll
            for (int s = 0; s < 4; ++s) { S0 = __builtin_amdgcn_mfma_f32_32x32x16_bf16(kf[2 * s], qf[s], S0, 0, 0, 0); S1 = __builtin_amdgcn_mfma_f32_32x32x16_bf16(kf[2 * s + 1], qf[s], S1, 0, 0, 0); }
            s16x4 vf[4][2][2];
#pragma unroll
            for (int ks = 0; ks < 2; ++ks)
#pragma unroll
                for (int db = 0; db < 2; ++db) { vf[ks][db][0] = vtr(vb_ + vread[db] + (16 * ks) * 128); vf[ks][db][1] = vtr(vb_ + vread[db] + (16 * ks + 8) * 128); }
            __builtin_amdgcn_sched_barrier(0);
#pragma unroll
            for (int r = 0; r < 16; ++r) { S0[r] = __builtin_amdgcn_exp2f(S0[r]); S1[r] = __builtin_amdgcn_exp2f(S1[r]); }
#pragma unroll
            for (int r = 0; r < 16; ++r) lsum += S0[r] + S1[r];
            bf16x8 pb[4];
#pragma unroll
            for (int hf = 0; hf < 2; ++hf) {
                v4u a, c;
#pragma unroll
                for (int j = 0; j < 4; ++j) { a[j] = cvtpk(S0[8 * hf + 2 * j], S0[8 * hf + 2 * j + 1]); c[j] = cvtpk(S1[8 * hf + 2 * j], S1[8 * hf + 2 * j + 1]); }
                pb[hf] = __builtin_bit_cast(bf16x8, a); pb[2 + hf] = __builtin_bit_cast(bf16x8, c);
            }
#pragma unroll
            for (int ks = 2; ks < 4; ++ks)
#pragma unroll
                for (int db = 0; db < 2; ++db) { vf[ks][db][0] = vtr(vb_ + vread[db] + (16 * ks) * 128); vf[ks][db][1] = vtr(vb_ + vread[db] + (16 * ks + 8) * 128); }
            __builtin_amdgcn_sched_barrier(0);
#pragma unroll
            for (int ks = 0; ks < 4; ++ks) {
                const bf16x8 va = __builtin_shufflevector(vf[ks][0][0], vf[ks][0][1], 0, 1, 2, 3, 4, 5, 6, 7), vb2 = __builtin_shufflevector(vf[ks][1][0], vf[ks][1][1], 0, 1, 2, 3, 4, 5, 6, 7);
                O0 = __builtin_amdgcn_mfma_f32_32x32x16_bf16(va, pb[ks], O0, 0, 0, 0); O1 = __builtin_amdgcn_mfma_f32_32x32x16_bf16(vb2, pb[ks], O1, 0, 0, 0);
            }
        }
        __builtin_amdgcn_sched_barrier(0);
        if (t + 1 < t_end) { *(LAS v4u*)(lds + AT_K0 + (cur ^ 1) * 8192 + kst) = kr; *(LAS v4u*)(lds + AT_V0 + (cur ^ 1) * 8192 + vst) = vr; }
        __syncthreads();
    }
    lsum += shx(lsum, 32, lane);
    if (TYPE == 0) lsum += __builtin_amdgcn_exp2f(sinkl2 - Cl2);
    const float inv = 1.f / lsum;
    bf16* op = ATT + ((size_t)b * SEQ + qpos) * DM + ocol + 4 * hh;
#pragma unroll
    for (int g4 = 0; g4 < 4; ++g4) {
        v2u o0, o1; o0.x = cvtpk(O0[4 * g4] * inv, O0[4 * g4 + 1] * inv); o0.y = cvtpk(O0[4 * g4 + 2] * inv, O0[4 * g4 + 3] * inv);
        o1.x = cvtpk(O1[4 * g4] * inv, O1[4 * g4 + 1] * inv); o1.y = cvtpk(O1[4 * g4 + 2] * inv, O1[4 * g4 + 3] * inv);
        *(GAS v2u*)(op + 8 * g4) = o0; *(GAS v2u*)(op + 32 + 8 * g4) = o1;
    }
}


constexpr int MA_K0 = 0, MA_V0 = 32768;
__device__ __forceinline__ void mem_unit(LAS unsigned char* lds, const bf16* QM, const bf16* KVM, bf16* OM, const float* gq, int tb, int head, float Cl2, int tid) {
    const int lane = tid & 63, w = __builtin_amdgcn_readfirstlane(tid >> 6), hh = lane >> 5, l31 = lane & 31;
    const size_t trow = (size_t)tb * 256 + 32 * w + l31; const int b = tb >> 3;
    bf16x8 qf[8];
    {   const bf16* qp = QM + trow * MEMW + head * 128 + 8 * hh;
#pragma unroll
        for (int s = 0; s < 8; ++s) qf[s] = *(const GAS bf16x8*)(qp + 16 * s);
        float ss = 0.f;
#pragma unroll
        for (int s = 0; s < 8; ++s)
#pragma unroll
            for (int j = 0; j < 8; ++j) { const float f = __builtin_bit_cast(float, (unsigned)(unsigned short)qf[s][j] << 16); ss += f * f; }
        ss += shx(ss, 32, lane);
        const float r = 0.12751743074602468f / sqrtf(ss * (1.f / 128.f) + EPS);
#pragma unroll
        for (int s = 0; s < 8; ++s) { const f32x4 g0 = *(const GAS f32x4*)(gq + 16 * s + 8 * hh), g1 = *(const GAS f32x4*)(gq + 16 * s + 8 * hh + 4);
            v4u o;
#pragma unroll
            for (int j = 0; j < 4; ++j) { const float f0 = __builtin_bit_cast(float, (unsigned)(unsigned short)qf[s][2 * j] << 16), f1 = __builtin_bit_cast(float, (unsigned)(unsigned short)qf[s][2 * j + 1] << 16);
                const float ga = (2 * j < 4) ? g0[2 * j] : g1[2 * j - 4], gb2 = (2 * j + 1 < 4) ? g0[2 * j + 1] : g1[2 * j + 1 - 4];
                o[j] = cvtpk(f0 * r * ga, f1 * r * gb2); }
            qf[s] = __builtin_bit_cast(bf16x8, o); }
    }
    const int srow = tid >> 3, sch = tid & 7;
    const bf16* kg = KVM + ((size_t)b * NMEM + srow) * 1024 + head * 128 + sch * 8;
    const bf16* vg = kg + 512;
    const int kst0 = srow * 256 + ((sch ^ (srow & 15)) * 16), kst1 = srow * 256 + (((sch + 8) ^ (srow & 15)) * 16);
    const int vst0 = srow * 256 + ((((sch) >> 2) ^ (srow & 3)) * 64) + (sch & 3) * 16, vst1 = srow * 256 + ((((sch + 8) >> 2) ^ (srow & 3)) * 64) + (sch & 3) * 16;
    int kread[8], vread[4];
#pragma unroll
    for (int s = 0; s < 8; ++s) kread[s] = l31 * 256 + (((2 * s + hh) ^ (l31 & 15)) * 16);
#pragma unroll
    for (int db = 0; db < 4; ++db) vread[db] = (4 * hh + ((lane >> 2) & 3)) * 256 + ((db ^ ((lane >> 2) & 3)) * 64) + 32 * ((lane >> 4) & 1) + 8 * (lane & 3);
    f32x16 O[4];
#pragma unroll
    for (int db = 0; db < 4; ++db)
#pragma unroll
        for (int r = 0; r < 16; ++r) O[db][r] = 0.f;
    float lsum = 0.f;
    {   const v4u k0 = *(const GAS v4u*)kg, k1 = *(const GAS v4u*)(kg + 64), v0 = *(const GAS v4u*)vg, v1 = *(const GAS v4u*)(vg + 64);
        *(LAS v4u*)(lds + MA_K0 + kst0) = k0; *(LAS v4u*)(lds + MA_K0 + kst1) = k1; *(LAS v4u*)(lds + MA_V0 + vst0) = v0; *(LAS v4u*)(lds + MA_V0 + vst1) = v1; }
    __syncthreads();
#pragma unroll 1
    for (int t = 0; t < 4; ++t) {
        const int cur = t & 1;
        v4u k0, k1, v0, v1;
        if (t + 1 < 4) { const bf16* kn = kg + (size_t)(t + 1) * 64 * 1024; k0 = *(const GAS v4u*)kn; k1 = *(const GAS v4u*)(kn + 64); v0 = *(const GAS v4u*)(kn + 512); v1 = *(const GAS v4u*)(kn + 576); }
        const lds_cptr kb_ = (lds_cptr)(lds + MA_K0 + cur * 16384), vb_ = (lds_cptr)(lds + MA_V0 + cur * 16384);
        f32x16 S0, S1;
#pragma unroll
        for (int r = 0; r < 16; ++r) { S0[r] = -Cl2; S1[r] = -Cl2; }
#pragma unroll
        for (int s = 0; s < 8; ++s) { const bf16x8 a0 = *(const LAS bf16x8*)(kb_ + kread[s]), a1 = *(const LAS bf16x8*)(kb_ + kread[s] + 8192);
            S0 = __builtin_amdgcn_mfma_f32_32x32x16_bf16(a0, qf[s], S0, 0, 0, 0); S1 = __builtin_amdgcn_mfma_f32_32x32x16_bf16(a1, qf[s], S1, 0, 0, 0); }
#pragma unroll
        for (int r = 0; r < 16; ++r) { S0[r] = __builtin_amdgcn_exp2f(S0[r]); S1[r] = __builtin_amdgcn_exp2f(S1[r]); lsum += S0[r] + S1[r]; }
        bf16x8 pb[4];
#pragma unroll
        for (int hf = 0; hf < 2; ++hf) {
            v4u a, c;
#pragma unroll
            for (int j = 0; j < 4; ++j) { a[j] = cvtpk(S0[8 * hf + 2 * j], S0[8 * hf + 2 * j + 1]); c[j] = cvtpk(S1[8 * hf + 2 * j], S1[8 * hf + 2 * j + 1]); }
            pb[hf] = __builtin_bit_cast(bf16x8, a); pb[2 + hf] = __builtin_bit_cast(bf16x8, c);
        }
#pragma unroll
        for (int ks = 0; ks < 4; ++ks)
#pragma unroll
            for (int db = 0; db < 4; ++db) {
                const s16x4 a0 = vtr(vb_ + vread[db] + (16 * ks) * 256), a1 = vtr(vb_ + vread[db] + (16 * ks + 8) * 256);
                const bf16x8 va = __builtin_shufflevector(a0, a1, 0, 1, 2, 3, 4, 5, 6, 7);
                O[db] = __builtin_amdgcn_mfma_f32_32x32x16_bf16(va, pb[ks], O[db], 0, 0, 0);
            }
        if (t + 1 < 4) { LAS unsigned char* kn = lds + MA_K0 + (cur ^ 1) * 16384; LAS unsigned char* vn = lds + MA_V0 + (cur ^ 1) * 16384;
            *(LAS v4u*)(kn + kst0) = k0; *(LAS v4u*)(kn + kst1) = k1; *(LAS v4u*)(vn + vst0) = v0; *(LAS v4u*)(vn + vst1) = v1; }
        __syncthreads();
    }
    lsum += shx(lsum, 32, lane);
    const float inv = 1.f / lsum;
    bf16* op = OM + trow * MEMW + head * 128 + 4 * hh;
#pragma unroll
    for (int db = 0; db < 4; ++db)
#pragma unroll
        for (int g4 = 0; g4 < 4; ++g4) { v2u o; o.x = cvtpk(O[db][4 * g4] * inv, O[db][4 * g4 + 1] * inv); o.y = cvtpk(O[db][4 * g4 + 2] * inv, O[db][4 * g4 + 3] * inv); *(GAS v2u*)(op + 32 * db + 8 * g4) = o; }
}

__device__ __forceinline__ float wave_max(float v, int lane) {
#pragma unroll
    for (int o = 1; o < 64; o <<= 1) v = fmaxf(v, shx(v, o, lane));
    return v;
}
struct Args { const float* in[23]; float* out; unsigned char* ws; int ph_lo, ph_hi, use_bar, pad; };
#ifndef MK_OFF
#define MK_OFF 0u
#endif
#ifndef REP_ATT
#define REP_ATT 1
#endif
#ifndef REP_P0
#define REP_P0 1
#endif
#ifndef REP_GEMM
#define REP_GEMM 1
#endif
#ifndef REP_NORM
#define REP_NORM 1
#endif
#ifndef REP_SEL
#define REP_SEL 1
#endif
#ifndef REP_MEM
#define REP_MEM 1
#endif
#define PHON(k) (!((MK_OFF >> (k)) & 1u))
constexpr int PH_PER_LAYER = 11, PH_BASE = 3, N_PHASES = PH_BASE + DEPTH * PH_PER_LAYER;
constexpr int PTAB_OFF = LDSCTL_OFF + 1024;

__global__ void __launch_bounds__(NTHREADS, 2) mega(Args a) {
    extern __shared__ __attribute__((aligned(16))) unsigned char lds_raw[];
    LAS unsigned char* lds = (LAS unsigned char*)lds_raw;
    {   const int tid0 = threadIdx.x;
        for (int u = tid0; u < (LDS_BYTES - LDSCTL_OFF) / 4; u += NTHREADS) ((LAS unsigned*)(lds + LDSCTL_OFF))[u] = 0u;
        __syncthreads();
        if (tid0 < 23) ((LAS unsigned long long*)(lds + PTAB_OFF))[tid0] = (unsigned long long)a.in[tid0];
        if (tid0 == 23) ((LAS unsigned long long*)(lds + PTAB_OFF))[23] = (unsigned long long)a.out;
        if (tid0 == 24) ((LAS unsigned long long*)(lds + PTAB_OFF))[24] = (unsigned long long)a.ws;
        __syncthreads();
    }
    volatile LAS unsigned* MISC = (volatile LAS unsigned*)(lds + MISC_OFF);
    const int G = gridDim.x, bid = blockIdx.x, NGW = G * NWAVES;
    const int use_bar = a.use_bar;
    XcdBarrier bar; bar.bar = (unsigned*)(a.ws + WS_CTL) + CW_BAR; bar.x = 0; bar.st = MISC + 8;
    if (use_bar) bar = xcd_barrier_post((unsigned*)(a.ws + WS_CTL) + CW_BAR, MISC + 8);
    const int lo = a.ph_lo, hi = a.ph_hi;
#define IN(k) (lo <= (k) && (k) < hi)
#define SEAM(k) do { if (use_bar && IN(k) && IN((k) + 1)) xcd_barrier(bar); } while (0)
#define PHL() int tid_ = threadIdx.x; asm volatile("" : "+v"(tid_)); const int lane_ = tid_ & 63, wave_ = __builtin_amdgcn_readfirstlane(tid_ >> 6), gw_ = bid * NWAVES + wave_; (void)lane_; (void)gw_; \
              int pz_ = 0; asm volatile("" : "+s"(pz_))
#define PTR(i) ((const float*)ldptr(lds, (i) + pz_))
#define WSP() ((unsigned char*)ldptr(lds, 24 + pz_))
#define OUTP() ((float*)ldptr(lds, 23 + pz_))

    if (IN(0) && PHON(0)) for (int rep_ = 0; rep_ < REP_P0; ++rep_) {
        PHL(); unsigned char* ws = WSP();
        LAS float* scr = (LAS float*)(lds + RING_OFF + wave_ * 16384);
        constexpr int I_IN = 32 * 128, I_OUT = 32 * 64, I_MQ = 32 * 16, I_MKV = 32 * 32, I_MO = 8 * 64, I_PQ = 32 * 64, I_L = I_IN + I_OUT + I_MQ + I_MKV + I_MO + I_PQ;
        for (int it = gw_; it < DEPTH * I_L; it += NGW) {
            const int l = it / I_L; int r = it % I_L;
            if (r < I_IN) { transpose_item<true>(PTR(4) + (size_t)l * DM * DIN, DM, DIN, (bf16*)(ws + WS_WIN) + (size_t)l * DIN * DM, scr, r, lane_, PTR(3) + (size_t)l * DM); continue; } r -= I_IN;
            if (r < I_OUT) { transpose_item<false>(PTR(11) + (size_t)l * DM * DM, DM, DM, (bf16*)(ws + WS_WOUT) + (size_t)l * DM * DM, scr, r, lane_); continue; } r -= I_OUT;
            if (r < I_MQ) { transpose_item<false>(PTR(14) + (size_t)l * DM * MEMW, DM, MEMW, (bf16*)(ws + WS_WMQ) + (size_t)l * MEMW * DM, scr, r, lane_, PTR(12) + (size_t)l * DM); continue; } r -= I_MQ;
            if (r < I_MKV) { transpose_item<false>(PTR(15) + (size_t)l * DM * 1024, DM, 1024, (bf16*)(ws + WS_WMKV) + (size_t)l * 1024 * DM, scr, r, lane_); continue; } r -= I_MKV;
            if (r < I_MO) { transpose_item<false>(PTR(17) + (size_t)l * MEMW * DM, MEMW, DM, (bf16*)(ws + WS_WMO) + (size_t)l * DM * MEMW, scr, r, lane_); continue; } r -= I_MO;
            transpose_item<false>(PTR(19) + (size_t)l * DM * DM, DM, DM, (bf16*)(ws + WS_WPQ) + (size_t)l * DM * DM, scr, r, lane_, PTR(18) + (size_t)l * DM);
        }
        const size_t gtid = (size_t)bid * NTHREADS + tid_, nth = (size_t)G * NTHREADS;
        convert_bf16(PTR(20), (bf16*)(ws + WS_PKEYS), (size_t)DEPTH * 8 * 2 * 128 * 128, gtid, nth);
        convert_int4_plain(PTR(21), ws + WS_PU, DEPTH * PEER_N, PU_SCALEI, PTR(18), gw_, NGW, lane_);
        convert_fp4_rows(PTR(22), ws + WS_PV, DEPTH * PEER_N, PV_SCALE4, nullptr, gw_, NGW, lane_);
        {   const float* x0 = PTR(0); bf16* XN = (bf16*)(ws + WS_XN); u64_t* rsq = (u64_t*)(ws + WS_ROWSQ);
            for (int m = 2 * gw_; m < T; m += 2 * NGW) prep_rows2(x0 + (size_t)m * DM, XN + (size_t)m * DM, rsq + m, lane_); }
        {   const float* mem = PTR(1); const float* gkv = PTR(13); bf16* MEMN = (bf16*)(ws + WS_MEMN);
            for (int m = gw_; m < BATCH * NMEM; m += NGW)
                rms_row_to_bf16(mem + (size_t)m * DM, gkv, MEMN + (size_t)m * DM, gkv + DM, MEMN + (size_t)(BATCH * NMEM + m) * DM, lane_); }
        float* rope = (float*)(ws + WS_ROPE); float* biasA = (float*)(ws + WS_BIASA);
        if (gtid < 64 * 16) { const int pos = (int)gtid >> 4, i = (int)gtid & 15; const float ang = (float)pos * ROPE_INV[i]; rope[gtid * 2] = cosf(ang); rope[gtid * 2 + 1] = sinf(ang); }
        if (gtid < 12 * 257) { const int h = (int)gtid / 257, rel = (int)gtid % 257 - 128; biasA[gtid] = PTR(2)[t5_bucket(rel) * 12 + h]; }
    }
    SEAM(0);
    if (IN(1) && PHON(1)) {
#pragma unroll 1
        for (int l = 0; l < DEPTH; ++l) {
            PHL(); unsigned char* ws = WSP();
            pg8::Gemm g{(bf16*)(ws + WS_MEMN) + (size_t)l * BATCH * NMEM * DM, (bf16*)(ws + WS_WMKV) + (size_t)l * 1024 * DM, BATCH * NMEM, 1024, DM};
            OffsetOrder S; S.init(BATCH * NMEM, 1024, G, bid, 64 * l);
            pg8::EpiBf16<0> E{(bf16*)(ws + WS_KVM) + (size_t)l * BATCH * NMEM * 1024, 1024, nullptr, 0, 0, 1.f};
            pg8::gemm_phase<pg8::EpiBf16<0>, OffsetOrder, true, true>(lds + RING_OFF, g, S, E, tid_);
            __syncthreads();
        }
    }
    SEAM(1);
    if (IN(2) && PHON(2)) {
        PHL(); unsigned char* ws = WSP(); bf16* KVM = (bf16*)(ws + WS_KVM); const float* gm = PTR(16);
        for (int m = gw_; m < DEPTH * BATCH * NMEM; m += NGW) {
            const int l = m / (BATCH * NMEM);
            GAS v4u* p = (GAS v4u*)(KVM + (size_t)m * 1024 + 8 * lane_);
            const v4u w = *p;
            float f[8] = {bflo(w.x), bfhi(w.x), bflo(w.y), bfhi(w.y), bflo(w.z), bfhi(w.z), bflo(w.w), bfhi(w.w)};
            float ss = 0.f;
#pragma unroll
            for (int i = 0; i < 8; ++i) ss += f[i] * f[i];
            ss += shx(ss, 1, lane_); ss += shx(ss, 2, lane_); ss += shx(ss, 4, lane_); ss += shx(ss, 8, lane_);
            const float r = 1.f / sqrtf(ss * (1.f / 128.f) + EPS);
            const float* gk = gm + (size_t)l * 256 + 128 + 8 * (lane_ & 15);
            v4u o; o.x = pk2(f[0] * r * gk[0], f[1] * r * gk[1]); o.y = pk2(f[2] * r * gk[2], f[3] * r * gk[3]); o.z = pk2(f[4] * r * gk[4], f[5] * r * gk[5]); o.w = pk2(f[6] * r * gk[6], f[7] * r * gk[7]);
            *p = o;
        }
    }
    SEAM(2);

#pragma unroll 1
    for (int l = 0; l < DEPTH; ++l) {
        const int pb = PH_BASE + PH_PER_LAYER * l;
        if (IN(pb + 0) && PHON(3)) for (int rep_ = 0; rep_ < REP_GEMM; ++rep_) { PHL(); unsigned char* ws = WSP();
            pg8::Gemm g{(bf16*)(ws + WS_XN), (bf16*)(ws + WS_WIN) + (size_t)l * DIN * DM, T, DIN, DM}; pg8::StaticOrder S; S.init(T, DIN, G, bid);
            pg8::EpiQKV E{(bf16*)(ws + WS_QKV), PTR(5) + (size_t)l * 128, PTR(7) + (size_t)l * 128, PTR(9) + (size_t)l * 128, (const float*)(ws + WS_ROPE), (const u64_t*)(ws + WS_ROWSQ) + (size_t)(l * 3 + 0) * T};
            pg8::gemm_phase<pg8::EpiQKV, pg8::StaticOrder, true, true>(lds + RING_OFF, g, S, E, tid_);
        }
        SEAM(pb + 0);
        if (IN(pb + 1) && PHON(4)) for (int rep_ = 0; rep_ < REP_ATT; ++rep_) { PHL(); unsigned char* ws = WSP();
            const float* sink = PTR(6) + (size_t)l * 12; const float* rpb = PTR(8) + (size_t)l * 8 * 15 * 31; const float* biasA = (const float*)(ws + WS_BIASA);
            const bf16* QKV = (const bf16*)(ws + WS_QKV); bf16* ATT = (bf16*)(ws + WS_ATT);
            const float* ga = PTR(5) + (size_t)l * 128; const float* gb = PTR(7) + (size_t)l * 128; const float* gc = PTR(9) + (size_t)l * 128;
            const float CaL2 = 8.f * wave_max(fabsf(ga[lane_]), lane_) * wave_max(fabsf(ga[64 + lane_]), lane_) * LOG2E;
            const float CbL2 = 8.f * wave_max(fabsf(gb[lane_]), lane_) * wave_max(fabsf(gb[64 + lane_]), lane_) * LOG2E;
            const float CcL2 = 8.f * wave_max(fabsf(gc[lane_]), lane_) * wave_max(fabsf(gc[64 + lane_]), lane_) * LOG2E;
            const int vc = (G % 8 == 0) ? (bid % 8) * (G / 8) + bid / 8 : bid;
            for (int u = vc; u < BATCH * 12 * 8; u += G) attn_unit<2>(lds, QKV, ATT, u / 96, (u >> 3) % 12, u & 7, nullptr, CcL2, 0.f, tid_);
            for (int u = vc; u < BATCH * 8 * 8; u += G) attn_unit<1>(lds, QKV, ATT, u >> 6, (u >> 3) & 7, u & 7, rpb, CbL2, 0.f, tid_);
            for (int u = vc; u < BATCH * 12 * 8; u += G) { const int head = (u >> 3) % 12; attn_unit<0>(lds, QKV, ATT, u / 96, head, u & 7, biasA, CaL2, sink[head] * LOG2E, tid_); }
        }
        SEAM(pb + 1);
        if (IN(pb + 2) && PHON(5)) { PHL(); unsigned char* ws = WSP(); mixnorm_rows((bf16*)(ws + WS_ATT), PTR(10) + (size_t)l * DM, gw_, NGW, lane_); }
        SEAM(pb + 2);
        if (IN(pb + 3) && PHON(6)) { PHL(); unsigned char* ws = WSP();
            pg8::Gemm g{(bf16*)(ws + WS_ATT), (bf16*)(ws + WS_WOUT) + (size_t)l * DM * DM, T, DM, DM}; pg8::StaticOrder S; S.init(T, DM, G, bid);
            pg8::EpiResid E{(bf16*)(ws + WS_XN), DM, (u64_t*)(ws + WS_ROWSQ) + (size_t)(l * 3 + 1) * T};
            pg8::gemm_phase<pg8::EpiResid, pg8::StaticOrder, true, true>(lds + RING_OFF, g, S, E, tid_);
        }
        SEAM(pb + 3);
        if (IN(pb + 4) && PHON(7)) for (int rep_ = 0; rep_ < REP_GEMM; ++rep_) { PHL(); unsigned char* ws = WSP();
            pg8::Gemm g{(bf16*)(ws + WS_XN), (bf16*)(ws + WS_WMQ) + (size_t)l * MEMW * DM, T, MEMW, DM}; pg8::StaticOrder S; S.init(T, MEMW, G, bid);
            pg8::EpiBf16Row E{(bf16*)(ws + WS_QM), MEMW, (const u64_t*)(ws + WS_ROWSQ) + (size_t)(l * 3 + 1) * T};
            pg8::gemm_phase<pg8::EpiBf16Row, pg8::StaticOrder, true, true>(lds + RING_OFF, g, S, E, tid_);
        }
        SEAM(pb + 4);
        if (IN(pb + 5) && PHON(8)) for (int rep_ = 0; rep_ < REP_MEM; ++rep_) { PHL(); unsigned char* ws = WSP();
            const bf16* kvm = (const bf16*)(ws + WS_KVM) + (size_t)l * BATCH * NMEM * 1024; const float* gq = PTR(16) + (size_t)l * 256;
            const float CmL2 = 11.313708498984761f * wave_max(fmaxf(fabsf(gq[lane_]), fabsf(gq[64 + lane_])), lane_) * wave_max(fmaxf(fabsf(gq[128 + lane_]), fabsf(gq[192 + lane_])), lane_) * LOG2E;
            for (int u = bid; u < (T / 256) * 4; u += G) mem_unit(lds, (const bf16*)(ws + WS_QM), kvm, (bf16*)(ws + WS_OM), gq, u >> 2, u & 3, CmL2, tid_);
        }
        SEAM(pb + 5);
        if (IN(pb + 6) && PHON(9)) { PHL(); unsigned char* ws = WSP();
            pg8::Gemm g{(bf16*)(ws + WS_OM), (bf16*)(ws + WS_WMO) + (size_t)l * DM * MEMW, T, DM, MEMW}; pg8::StaticOrder S; S.init(T, DM, G, bid);
            pg8::EpiResid E{(bf16*)(ws + WS_XN), DM, (u64_t*)(ws + WS_ROWSQ) + (size_t)(l * 3 + 2) * T};
            pg8::gemm_phase<pg8::EpiResid, pg8::StaticOrder, true, true>(lds + RING_OFF, g, S, E, tid_);
        }
        SEAM(pb + 6);
        if (IN(pb + 7) && PHON(10)) for (int rep_ = 0; rep_ < REP_GEMM; ++rep_) { PHL(); unsigned char* ws = WSP();
            pg8::Gemm g{(bf16*)(ws + WS_XN), (bf16*)(ws + WS_WPQ) + (size_t)l * DM * DM, T, DM, DM}; pg8::StaticOrder S; S.init(T, DM, G, bid);
            pg8::EpiBf16Row E{(bf16*)(ws + WS_QP), DM, (const u64_t*)(ws + WS_ROWSQ) + (size_t)(l * 3 + 2) * T};
            pg8::gemm_phase<pg8::EpiBf16Row, pg8::StaticOrder, true, true>(lds + RING_OFF, g, S, E, tid_);
        }
        SEAM(pb + 7);
        if (IN(pb + 8) && PHON(11)) for (int rep_ = 0; rep_ < REP_SEL; ++rep_) { PHL(); unsigned char* ws = WSP();
            const bf16* pk = (const bf16*)(ws + WS_PKEYS) + (size_t)l * 8 * 2 * 128 * 128;
            for (int u = bid; u < (T / 256) * PEER_H; u += G) { peer_select_unit((const bf16*)(ws + WS_QP), pk, (int*)(ws + WS_PIDX), (float*)(ws + WS_PGATE), u >> 3, u & 7, wave_, lane_);
                peer_xquant_unit((const bf16*)(ws + WS_XN), (const u64_t*)(ws + WS_ROWSQ) + (size_t)(l * 3 + 2) * T, (unsigned*)(ws + WS_XQH), (unsigned*)(ws + WS_XQL), u >> 3, u & 7, tid_); }
        }
        SEAM(pb + 8);
        if (IN(pb + 9) && PHON(12)) { PHL(); unsigned char* ws = WSP();
            peer_u_phase_i4((const unsigned*)(ws + WS_XQH), (const unsigned*)(ws + WS_XQL), ws + WS_PU + (size_t)l * PEER_N * 1024, (const int*)(ws + WS_PIDX), (int*)(ws + WS_PARTI), bid, G, wave_, lane_); }
        SEAM(pb + 9);
        if (IN(pb + 10) && PHON(13)) { PHL(); unsigned char* ws = WSP();
            peer_v_pass((bf16*)(ws + WS_XN), ws + WS_PV + (size_t)l * PEER_N * 1024, (const int*)(ws + WS_PIDX), (const float*)(ws + WS_PGATE), (const int*)(ws + WS_PARTI), (l + 1 == DEPTH) ? OUTP() : (float*)nullptr,
                        (l + 1 < DEPTH) ? (u64_t*)(ws + WS_ROWSQ) + (size_t)((l + 1) * 3 + 0) * T : (u64_t*)nullptr, (LAS float*)(lds + RING_OFF + wave_ * 1024), gw_, NGW, lane_); }
        SEAM(pb + 10);
    }
#undef IN
#undef SEAM
}

#ifndef MK_MULTI_LAUNCH
#define MK_MULTI_LAUNCH 0
#endif
extern "C" void kernel_launch(void* const* d_in, const int* in_sizes, int n_in, void* d_out, int out_size, void* d_ws, size_t ws_size, hipStream_t stream) {
    static int grid = 0;
    if (grid == 0) {
        if (n_in != 23 || out_size != T * DM || ws_size < WS_END) { fprintf(stderr, "kernel_launch: unexpected shapes (n_in %d, out %d, ws %zu)\n", n_in, out_size, ws_size); grid = -1; return; }
        int dev = 0, cus = 0, per_cu = 0;
        if (hipGetDevice(&dev) != hipSuccess || hipDeviceGetAttribute(&cus, hipDeviceAttributeMultiprocessorCount, dev) != hipSuccess) { grid = -1; return; }
        if (hipFuncSetAttribute((const void*)mega, hipFuncAttributeMaxDynamicSharedMemorySize, LDS_BYTES) != hipSuccess) { fprintf(stderr, "kernel_launch: hipFuncSetAttribute failed\n"); grid = -1; return; }
        if (hipOccupancyMaxActiveBlocksPerMultiprocessor(&per_cu, (const void*)mega, NTHREADS, LDS_BYTES) != hipSuccess || per_cu < 1) { fprintf(stderr, "kernel_launch: occupancy query says %d\n", per_cu); }
        (void)hipGetLastError();
        grid = cus;
    }
    if (grid < 0) return;
    (void)hipMemsetAsync((char*)d_ws + WS_CTL, 0, CTL_ZERO_BYTES, stream);
    Args a{};
    for (int i = 0; i < 23; ++i) a.in[i] = (const float*)d_in[i];
    a.out = (float*)d_out; a.ws = (unsigned char*)d_ws;
#if MK_MULTI_LAUNCH
    for (int p = 0; p < N_PHASES; ++p) { a.ph_lo = p; a.ph_hi = p + 1; a.use_bar = 0; a.pad = 0; hipLaunchKernelGGL(mega, dim3(grid), dim3(NTHREADS), LDS_BYTES, stream, a); }
#else
    a.ph_lo = 0; a.ph_hi = N_PHASES; a.use_bar = 1; a.pad = 0;
    hipLaunchKernelGGL(mega, dim3(grid), dim3(NTHREADS), LDS_BYTES, stream, a);
#endif
    const hipError_t le = hipPeekAtLastError();
    if (le != hipSuccess) fprintf(stderr, "kernel_launch: launch failed: %s\n", hipGetErrorName(le));
}
```

```cpp
#include <hip/hip_runtime.h>
#include <cstdio>
#include <cstdint>
#include <cmath>
__device__ __forceinline__ float shx(float v, int k, int lane);
typedef unsigned long long u64_t;
__device__ __forceinline__ float rowsq_rs(const u64_t* rowsq, int row) { return 1.0f / sqrtf((float)rowsq[row] * (5.9604644775390625e-08f / 2048.0f) + 1e-6f); }
__device__ __forceinline__ u64_t rowsq_fx(float ss) { return (u64_t)(ss * 16777216.0f + 0.5f); }
namespace pg8 {
#define PG8_LAS __attribute__((address_space(3)))
typedef unsigned short bf16_t;
typedef short bf16x8 __attribute__((ext_vector_type(8)));
typedef float f32x4 __attribute__((ext_vector_type(4)));
typedef unsigned u32x4 __attribute__((ext_vector_type(4)));
constexpr int BM = 256, BK = 64, HALF = 128, HTB = HALF * BK * 2  , STAGE_BYTES = 8 * HTB, NXCD = 8, WGM = 8;

__host__ __device__ __forceinline__ int lds_byte(int r, int c) { const int st = (r >> 4) * 2 + (c >> 5), rr = r & 15, cc = c & 31, ob = rr * 64 + cc * 2; return st * 1024 + (ob ^ (((ob >> 9) & 1) << 5)); }
__host__ __device__ __forceinline__ void stage_rc(int b, int& R, int& C) { const int st = b / 1024, sb = b % 1024, swz = sb ^ (((sb >> 9) & 1) << 5); R = (st >> 1) * 16 + swz / 64; C = (st & 1) * 32 + (swz % 64) / 2; }
__host__ __device__ __forceinline__ int perm32(int rho) { const int n = rho >> 4, i = rho & 15; return 8 * (i >> 2) + 4 * n + (i & 3); }

struct Unit { int pm, pn; };
struct Gemm { const bf16_t* A; const bf16_t* Bt; int M, N, K; };

struct StaticOrder {
    int nM, nN, nwg, G, c;
    __host__ __device__ void init(int M, int N, int G_, int c_) { nM = M / BM; nN = N / BM; nwg = nM * nN; G = G_; c = c_; }
    __host__ __device__ bool next(int i, Unit& u) const {
        const long L = (long)i * G + c; if (L >= nwg) return false;
        int wgid = (int)L; { const int q = nwg / NXCD, r = nwg % NXCD, xcd = wgid % NXCD, off = wgid / NXCD; wgid = (xcd < r ? xcd * (q + 1) : r * (q + 1) + (xcd - r) * q) + off; }
        const int nig = WGM * nN, gid = wgid / nig, fm = gid * WGM, gsz = (nM - fm) < WGM ? (nM - fm) : WGM;
        u.pm = fm + ((wgid % nig) % gsz); u.pn = (wgid % nig) / gsz; return true;
    }
    __device__ __forceinline__ void a_ready(const Unit&) const {}
    __device__ __forceinline__ void done(const Unit&) const {}
};

__device__ __forceinline__ unsigned cvt_pk_bf16(float lo, float hi) { unsigned r; asm volatile("v_cvt_pk_bf16_f32 %0, %1, %2" : "=v"(r) : "v"(lo), "v"(hi)); return r; }
typedef float f32x2 __attribute__((ext_vector_type(2)));
__device__ __forceinline__ f32x2 gelu_pk(f32x2 v) {
    const f32x2 av = __builtin_elementwise_abs(v), d = av * 0.2316418882f + 1.0f;
    f32x2 t; t.x = __builtin_amdgcn_rcpf(d.x); t.y = __builtin_amdgcn_rcpf(d.y);
    f32x2 q = t * 0.5307027145f + (-0.7265760135f); q = q * t + 0.7107068705f; q = q * t + (-0.142248368f); q = q * t + 0.127414796f; q = q * t;
    const f32x2 s = (v * v) * (-0.72134752044f);
    f32x2 e; e.x = __builtin_amdgcn_exp2f(s.x); e.y = __builtin_amdgcn_exp2f(s.y);
    const f32x2 m = v * (q * e), r = v - m;
    f32x2 o; o.x = v.x < 0.f ? m.x : r.x; o.y = v.y < 0.f ? m.y : r.y; return o;
}

template <int ACT  > struct EpiBf16 {
    static constexpr bool PERM = true, AFTER_DRAIN = false; static_assert(ACT == 0 || ACT == 1, "EpiBf16: ACT is 0 (none) or 1 (gelu_pk)");
    bf16_t* O; int ldc; const float* bias; int split_cols; size_t split_stride; float scale0;
    __device__ __forceinline__ void operator()(const f32x4 (&acc)[2][2][4][2], const Unit& u, int wr, int wc, int fr, int fq) const {
        const int row0 = u.pm * BM + wr * 64 + fr; int colt = u.pn * BM; bf16_t* base = O;
        float sc = 1.f; if (split_cols) { const int t = colt / split_cols; base += (size_t)t * split_stride; colt -= t * split_cols; if (t == 0) sc = scale0; }
        const int col0 = colt + wc * 32 + 8 * fq, bcol0 = u.pn * BM + wc * 32 + 8 * fq;
        f32x4 bv[2][2];
#pragma unroll
        for (int bj = 0; bj < 2; ++bj)
#pragma unroll
            for (int n = 0; n < 2; ++n) bv[bj][n] = bias ? *(const f32x4*)(bias + bcol0 + bj * HALF + 4 * n) : (f32x4){0.f, 0.f, 0.f, 0.f};
#pragma unroll
        for (int ai = 0; ai < 2; ++ai)
#pragma unroll
            for (int m = 0; m < 4; ++m) { bf16_t* rowp = base + (size_t)(row0 + ai * HALF + m * 16) * ldc + col0;
#pragma unroll
                for (int bj = 0; bj < 2; ++bj) { f32x4 v0 = acc[ai][bj][m][0] + bv[bj][0], v1 = acc[ai][bj][m][1] + bv[bj][1];
                    if (ACT == 1) { f32x2 a = gelu_pk((f32x2){v0[0], v0[1]}), b = gelu_pk((f32x2){v0[2], v0[3]}), c = gelu_pk((f32x2){v1[0], v1[1]}), d = gelu_pk((f32x2){v1[2], v1[3]});
                        v0 = (f32x4){a.x, a.y, b.x, b.y}; v1 = (f32x4){c.x, c.y, d.x, d.y}; }
                    v0 = v0 * sc; v1 = v1 * sc; u32x4 w; w.x = cvt_pk_bf16(v0[0], v0[1]); w.y = cvt_pk_bf16(v0[2], v0[3]); w.z = cvt_pk_bf16(v1[0], v1[1]); w.w = cvt_pk_bf16(v1[2], v1[3]);
                    *(u32x4*)(rowp + bj * HALF) = w; } }
    }
};

typedef unsigned u32x2 __attribute__((ext_vector_type(2)));
struct EpiResid {
    static constexpr bool PERM = false, AFTER_DRAIN = false;
    bf16_t* s; int ldc; u64_t* rowsq;
    __device__ __forceinline__ void operator()(const f32x4 (&acc)[2][2][4][2], const Unit& u, int wr, int wc, int fr, int fq) const {
        const int col0 = u.pn * BM + wc * 32 + 4 * fq;
#pragma unroll
        for (int ai = 0; ai < 2; ++ai)
#pragma unroll
            for (int m = 0; m < 4; ++m) { const int row = u.pm * BM + ai * HALF + wr * 64 + m * 16 + fr; bf16_t* sp = s + (size_t)row * ldc + col0; float ss = 0.f;
                u32x2 in[2][2];
#pragma unroll
                for (int bj = 0; bj < 2; ++bj)
#pragma unroll
                    for (int n = 0; n < 2; ++n) in[bj][n] = *(const u32x2*)(sp + bj * HALF + n * 16);
#pragma unroll
                for (int bj = 0; bj < 2; ++bj)
#pragma unroll
                    for (int n = 0; n < 2; ++n) { const u32x2 w0 = in[bj][n];
                        const f32x4 bs = (f32x4){__builtin_bit_cast(float, w0.x << 16), __builtin_bit_cast(float, w0.x & 0xffff0000u), __builtin_bit_cast(float, w0.y << 16), __builtin_bit_cast(float, w0.y & 0xffff0000u)};
                        const f32x4 o = bs + acc[ai][bj][m][n]; ss += (o[0] * o[0] + o[1] * o[1]) + (o[2] * o[2] + o[3] * o[3]);
                        u32x2 w; w.x = cvt_pk_bf16(o[0], o[1]); w.y = cvt_pk_bf16(o[2], o[3]); *(u32x2*)(sp + bj * HALF + n * 16) = w; }
                ss += shx(ss, 16, fr + 16 * fq); ss += shx(ss, 32, fr + 16 * fq);
                if (fq == 0) atomicAdd(rowsq + row, rowsq_fx(ss)); }
    }
};
struct EpiBf16Row {
    static constexpr bool PERM = true, AFTER_DRAIN = false;
    bf16_t* O; int ldc; const u64_t* rowsq;
    __device__ __forceinline__ void operator()(const f32x4 (&acc)[2][2][4][2], const Unit& u, int wr, int wc, int fr, int fq) const {
        const int row0 = u.pm * BM + wr * 64 + fr, col0 = u.pn * BM + wc * 32 + 8 * fq;
#pragma unroll
        for (int ai = 0; ai < 2; ++ai)
#pragma unroll
            for (int m = 0; m < 4; ++m) { const int row = row0 + ai * HALF + m * 16; const float rs = rowsq_rs(rowsq, row); bf16_t* rowp = O + (size_t)row * ldc + col0;
#pragma unroll
                for (int bj = 0; bj < 2; ++bj) { const f32x4 v0 = acc[ai][bj][m][0] * rs, v1 = acc[ai][bj][m][1] * rs; u32x4 w; w.x = cvt_pk_bf16(v0[0], v0[1]); w.y = cvt_pk_bf16(v0[2], v0[3]); w.z = cvt_pk_bf16(v1[0], v1[1]); w.w = cvt_pk_bf16(v1[2], v1[3]);
                    *(u32x4*)(rowp + bj * HALF) = w; } }
    }
};
struct EpiQKV {
    static constexpr bool PERM = false, AFTER_DRAIN = false;
    bf16_t* O; const float* ga; const float* gb; const float* gc; const float* rope; const u64_t* rowsq;
    __device__ __forceinline__ void operator()(const f32x4 (&acc)[2][2][4][2], const Unit& u, int wr, int wc, int fr, int fq) const {
        const int hg = u.pn * 4 + wc;
        const float* g = nullptr; bool isq = false, dorope = false;
        if (hg < 12) { g = ga; isq = true; } else if (hg < 16) { g = ga + 64; } else if (hg < 20) { }
        else if (hg < 28) { g = gb; isq = true; } else if (hg < 36) { g = gb + 64; } else if (hg < 44) { }
        else if (hg < 56) { g = gc; isq = true; dorope = true; } else if (hg < 60) { g = gc + 64; dorope = true; }
        const float qs = isq ? 0.18033688011112042f : 1.0f;
#pragma unroll
        for (int ai = 0; ai < 2; ++ai)
#pragma unroll
            for (int m = 0; m < 4; ++m) {
                const int row = u.pm * BM + ai * HALF + wr * 64 + m * 16 + fr;
                f32x4 v[2][2];
                const float rsx = rowsq_rs(rowsq, row);
#pragma unroll
                for (int bj = 0; bj < 2; ++bj)
#pragma unroll
                    for (int n = 0; n < 2; ++n) v[bj][n] = acc[ai][bj][m][n] * rsx;
                if (g) {
                    float ss = 0.f;
#pragma unroll
                    for (int bj = 0; bj < 2; ++bj)
#pragma unroll
                        for (int n = 0; n < 2; ++n) { const f32x4 x = v[bj][n]; ss += (x[0] * x[0] + x[1] * x[1]) + (x[2] * x[2] + x[3] * x[3]); }
                    ss += shx(ss, 16, fr + 16 * fq); ss += shx(ss, 32, fr + 16 * fq);
                    const float r = qs / sqrtf(ss * (1.0f / 64.0f) + 1e-6f);
#pragma unroll
                    for (int bj = 0; bj < 2; ++bj)
#pragma unroll
                        for (int n = 0; n < 2; ++n) v[bj][n] = v[bj][n] * *(const f32x4*)(g + 32 * bj + 16 * n + 4 * fq) * r;
                }
                if (dorope) {
                    const int t = row & 2047, pr = t >> 6, pc = t & 63;
#pragma unroll
                    for (int bj = 0; bj < 2; ++bj) {
                        const int pos = bj ? pc : pr;
                        const float* rp = rope + (size_t)(pos * 16 + 4 * fq) * 2;
                        const f32x4 c01 = *(const f32x4*)rp, c23 = *(const f32x4*)(rp + 4);
                        const f32x4 cs = (f32x4){c01[0], c01[2], c23[0], c23[2]}, sn = (f32x4){c01[1], c01[3], c23[1], c23[3]};
                        const f32x4 x1 = v[bj][0], x2 = v[bj][1];
                        v[bj][0] = x1 * cs - x2 * sn; v[bj][1] = x1 * sn + x2 * cs;
                    }
                }
                bf16_t* rowp = O + (size_t)row * 4096 + hg * 64 + 4 * fq;
#pragma unroll
                for (int bj = 0; bj < 2; ++bj)
#pragma unroll
                    for (int n = 0; n < 2; ++n) { u32x2 w; w.x = cvt_pk_bf16(v[bj][n][0], v[bj][n][1]); w.y = cvt_pk_bf16(v[bj][n][2], v[bj][n][3]); *(u32x2*)(rowp + 32 * bj + 16 * n) = w; }
                asm volatile("" ::: "memory");
            }
    }
};
template <class Epi, class Sched, bool ALIGN_EPI = false, bool SP2 = false>
__device__ __forceinline__ void gemm_phase(PG8_LAS unsigned char* lds, const Gemm g, const Sched& S, const Epi& E, const int tid) {
    const int wid = __builtin_amdgcn_readfirstlane(tid >> 6), lane = tid & 63, wr = wid >> 2, wc = wid & 3, fr = lane & 15, fq = lane >> 4;
    const int K = g.K, nt = K / BK;
    unsigned voffA[2], voffB[2];
#pragma unroll
    for (int i = 0; i < 2; ++i) { int R, C; stage_rc(tid * 16 + i * 8192, R, C); const int Rb = Epi::PERM ? ((R & ~31) + perm32(R & 31)) : R;
        voffA[i] = (unsigned)(R * K + C) * 2u; voffB[i] = (unsigned)(Rb * K + C) * 2u; }
    const size_t kstep = (size_t)(BK * 2);
    const size_t hstep = (size_t)HALF * K * 2;
    const size_t tstep = 2 * hstep;
    const unsigned ldsw = (unsigned)wid * 1024u;
    const int aoff = lds_byte(wr * 64 + fr, fq * 8), boff = lds_byte(wc * 32 + fr, fq * 8);
#define PG8_SA(b, h) (((b) * 2 + (h)) * HTB)
#define PG8_SB(b, h) ((4 + (b) * 2 + (h)) * HTB)
#define PG8_STAGE(bufoff, gbase, voff) do { _Pragma("unroll") for (int _i = 0; _i < 2; ++_i) \
        __builtin_amdgcn_global_load_lds((const unsigned*)((const char*)(gbase) + (voff)[_i]), (PG8_LAS unsigned*)(lds + (bufoff) + ldsw + _i * 8192), 16, 0, 0); } while (0)
#define PG8_LDA(dst, b, h) do { _Pragma("unroll") for (int m = 0; m < 4; ++m) _Pragma("unroll") for (int k = 0; k < 2; ++k) dst[m][k] = *(const PG8_LAS bf16x8*)(lds + PG8_SA(b, h) + aoff + m * 2048 + k * 1024); } while (0)
#define PG8_LDB(dst, b, h) do { _Pragma("unroll") for (int n = 0; n < 2; ++n) _Pragma("unroll") for (int k = 0; k < 2; ++k) dst[n][k] = *(const PG8_LAS bf16x8*)(lds + PG8_SB(b, h) + boff + n * 2048 + k * 1024); } while (0)
#define PG8_MMA(ai, bj, At, Bt) do { __builtin_amdgcn_s_setprio(1); _Pragma("unroll") for (int m = 0; m < 4; ++m) _Pragma("unroll") for (int n = 0; n < 2; ++n) _Pragma("unroll") for (int k = 0; k < 2; ++k) \
        acc[ai][bj][m][n] = __builtin_amdgcn_mfma_f32_16x16x32_bf16(Bt[n][k], At[m][k], acc[ai][bj][m][n], 0, 0, 0); __builtin_amdgcn_s_setprio(0); } while (0)
#define PG8_WAIT_V(n) asm volatile("s_waitcnt vmcnt(" #n ")" ::: "memory")
#define PG8_WAIT_L(n) asm volatile("s_waitcnt lgkmcnt(" #n ")" ::: "memory")
#define PG8_BAR __builtin_amdgcn_s_barrier()
#define PG8_SCHED __builtin_amdgcn_sched_barrier(0)
    Unit cur, nxt; int ui = 0;
    if (!S.next(0, cur)) return;
    f32x4 acc[2][2][4][2];
#pragma unroll
    for (int a = 0; a < 2; ++a)
#pragma unroll
        for (int b = 0; b < 2; ++b)
#pragma unroll
            for (int m = 0; m < 4; ++m)
#pragma unroll
                for (int n = 0; n < 2; ++n) acc[a][b][m][n] = (f32x4){0.f, 0.f, 0.f, 0.f};
    bf16x8 At[4][2], B0[2][2], B1[2][2];
    const char* cA = (const char*)g.A + (size_t)cur.pm * tstep; const char* cB = (const char*)g.Bt + (size_t)cur.pn * tstep;
    S.a_ready(cur);
    if constexpr (SP2) {
        PG8_STAGE(PG8_SB(0, 0), cB, voffB); PG8_STAGE(PG8_SB(0, 1), cB + hstep, voffB); PG8_STAGE(PG8_SA(0, 0), cA, voffA); PG8_STAGE(PG8_SA(0, 1), cA + hstep, voffA);
        if (wr == 1) PG8_BAR;
        PG8_WAIT_V(2); PG8_BAR;
        PG8_STAGE(PG8_SB(1, 0), cB + kstep, voffB); PG8_STAGE(PG8_SA(1, 0), cA + kstep, voffA); PG8_STAGE(PG8_SB(1, 1), cB + hstep + kstep, voffB);
        PG8_WAIT_V(6); PG8_BAR;
    } else {
        PG8_STAGE(PG8_SB(0, 0), cB, voffB); PG8_STAGE(PG8_SA(0, 0), cA, voffA); PG8_STAGE(PG8_SB(0, 1), cB + hstep, voffB); PG8_STAGE(PG8_SA(0, 1), cA + hstep, voffA);
        if (wr == 1) PG8_BAR;
        PG8_WAIT_V(4); PG8_BAR;
        PG8_STAGE(PG8_SB(1, 0), cB + kstep, voffB); PG8_STAGE(PG8_SA(1, 0), cA + kstep, voffA); PG8_STAGE(PG8_SB(1, 1), cB + hstep + kstep, voffB);
        PG8_WAIT_V(6); PG8_BAR;
    }
    for (;;) {
        const bool has_next = S.next(ui + 1, nxt);
        const char* nA = has_next ? (const char*)g.A + (size_t)nxt.pm * tstep : cA; const char* nB = has_next ? (const char*)g.Bt + (size_t)nxt.pn * tstep : cB;
        for (int t = 0; t < nt; t += 2) {
            const bool last = (t == nt - 2);
            const char* a1 = cA + (size_t)(t + 1) * kstep;
            const char* a2 = last ? nA : cA + (size_t)(t + 2) * kstep; const char* b2 = last ? nB : cB + (size_t)(t + 2) * kstep;
            const char* a3 = a2 + kstep; const char* b3 = b2 + kstep;
            if (last && has_next) S.a_ready(nxt);
            if constexpr (SP2) {
            PG8_LDB(B0, 0, 0); PG8_LDB(B1, 0, 1); PG8_SCHED; PG8_LDA(At, 0, 0); PG8_STAGE(PG8_SA(1, 1), a1 + hstep, voffA);
            PG8_WAIT_V(8); PG8_WAIT_L(0); PG8_BAR; PG8_MMA(0, 0, At, B0); PG8_MMA(0, 1, At, B1); PG8_BAR; PG8_SCHED;
            PG8_LDA(At, 0, 1); PG8_STAGE(PG8_SB(0, 0), b2, voffB); PG8_STAGE(PG8_SB(0, 1), b2 + hstep, voffB); PG8_STAGE(PG8_SA(0, 0), a2, voffA);
            PG8_WAIT_V(8); PG8_WAIT_L(0); PG8_BAR; PG8_MMA(1, 0, At, B0); PG8_MMA(1, 1, At, B1); PG8_BAR; PG8_SCHED;
            PG8_LDB(B0, 1, 0); PG8_LDB(B1, 1, 1); PG8_SCHED; PG8_LDA(At, 1, 0); PG8_STAGE(PG8_SA(0, 1), a2 + hstep, voffA);
            PG8_WAIT_V(8); PG8_WAIT_L(0); PG8_BAR; PG8_MMA(0, 0, At, B0); PG8_MMA(0, 1, At, B1); PG8_BAR; PG8_SCHED;
            PG8_LDA(At, 1, 1); PG8_STAGE(PG8_SB(1, 0), b3, voffB); PG8_STAGE(PG8_SB(1, 1), b3 + hstep, voffB); PG8_STAGE(PG8_SA(1, 0), a3, voffA);
            PG8_WAIT_V(8); PG8_WAIT_L(0); PG8_BAR; PG8_MMA(1, 0, At, B0); PG8_MMA(1, 1, At, B1); PG8_BAR; PG8_SCHED;
            } else {
            PG8_LDB(B0, 0, 0); PG8_SCHED; PG8_LDA(At, 0, 0); PG8_STAGE(PG8_SA(1, 1), a1 + hstep, voffA);
            PG8_WAIT_L(8); PG8_BAR; PG8_WAIT_L(0); PG8_MMA(0, 0, At, B0); PG8_BAR; PG8_SCHED;
            PG8_LDB(B1, 0, 1); PG8_STAGE(PG8_SB(0, 0), b2, voffB);
            PG8_BAR; PG8_WAIT_L(0); PG8_MMA(0, 1, At, B1); PG8_BAR;
            PG8_LDA(At, 0, 1); PG8_STAGE(PG8_SA(0, 0), a2, voffA);
            PG8_BAR; PG8_WAIT_L(0); PG8_MMA(1, 0, At, B0); PG8_BAR; PG8_SCHED;
            PG8_STAGE(PG8_SB(0, 1), b2 + hstep, voffB);
            PG8_WAIT_V(6); PG8_BAR; PG8_MMA(1, 1, At, B1); PG8_BAR;
            PG8_LDB(B0, 1, 0); PG8_SCHED; PG8_LDA(At, 1, 0); PG8_STAGE(PG8_SA(0, 1), a2 + hstep, voffA);
            PG8_WAIT_L(8); PG8_BAR; PG8_WAIT_L(0); PG8_MMA(0, 0, At, B0); PG8_BAR; PG8_SCHED;
            PG8_LDB(B1, 1, 1); PG8_STAGE(PG8_SB(1, 0), b3, voffB);
            PG8_BAR; PG8_WAIT_L(0); PG8_MMA(0, 1, At, B1); PG8_BAR;
            PG8_LDA(At, 1, 1); PG8_STAGE(PG8_SA(1, 0), a3, voffA);
            PG8_BAR; PG8_WAIT_L(0); PG8_MMA(1, 0, At, B0); PG8_BAR; PG8_SCHED;
            PG8_STAGE(PG8_SB(1, 1), b3 + hstep, voffB);
            PG8_WAIT_V(6); PG8_BAR; PG8_MMA(1, 1, At, B1); PG8_BAR;
            }
        }
        if constexpr (ALIGN_EPI) { if (wr == 0) PG8_BAR; }
        if constexpr (!Epi::AFTER_DRAIN) { E(acc, cur, wr, wc, fr, fq); S.done(cur); }
        if (!has_next) break;
#pragma unroll
        for (int a = 0; a < 2; ++a)
#pragma unroll
            for (int b = 0; b < 2; ++b)
#pragma unroll
                for (int m = 0; m < 4; ++m)
#pragma unroll
                    for (int n = 0; n < 2; ++n) acc[a][b][m][n] = (f32x4){0.f, 0.f, 0.f, 0.f};
        cur = nxt; cA = nA; cB = nB; ++ui;
        if constexpr (ALIGN_EPI) { if (wr == 1) PG8_BAR; }
    }
    PG8_WAIT_V(0);
    if constexpr (!ALIGN_EPI) { if (wr == 0) PG8_BAR; }
    PG8_BAR;
    if constexpr (Epi::AFTER_DRAIN) { E.fused(acc, cur, wr, wc, fr, fq, lds, wid, lane); S.done(cur); }
#undef PG8_SA
#undef PG8_SB
#undef PG8_STAGE
#undef PG8_LDA
#undef PG8_LDB
#undef PG8_MMA
#undef PG8_WAIT_V
#undef PG8_WAIT_L
#undef PG8_BAR
#undef PG8_SCHED
}
}

constexpr int BATCH = 16, SEQ = 2048, DM = 2048, T = BATCH * SEQ, DEPTH = 2;
constexpr int NMEM = 256, DIN = 4096, MEMW = 512;
constexpr int PEER_H = 8, PEER_N = 16384;
constexpr int NWAVES = 8, NTHREADS = NWAVES * 64;
constexpr float EPS = 1e-6f;
constexpr int QA = 0, KA = 768, VA = 1024, QB = 1280, KB = 1792, VB = 2304, QC = 2816, KC = 3584, VC = 3840;
constexpr int OA = 0, OB = 768, OC = 1280;

constexpr size_t MiB = 1u << 20;
constexpr size_t WS_CTL = 0, CTL_ZERO_BYTES = 2 * MiB;
constexpr size_t WS_ROWSQ = 256 * 1024;
constexpr size_t WS_ROPE = 83 * MiB, WS_BIASA = 83 * MiB + 16384;
constexpr size_t WS_WIN = 2 * MiB, WS_WOUT = 34 * MiB, WS_WMQ = 50 * MiB, WS_WMKV = 54 * MiB, WS_WMO = 62 * MiB, WS_WPQ = 66 * MiB, WS_PKEYS = 82 * MiB;
constexpr size_t WS_MEMN = 84 * MiB, WS_KVM = 116 * MiB, WS_PU = 132 * MiB, WS_PV = 260 * MiB, WS_XN = 388 * MiB, WS_QKV = 516 * MiB, WS_ATT = 772 * MiB;
constexpr size_t WS_QM = 900 * MiB, WS_OM = 932 * MiB, WS_END = 964 * MiB;
constexpr size_t WS_QP = WS_QKV, WS_PIDX = WS_QKV + 128 * MiB, WS_PGATE = WS_QKV + 144 * MiB, WS_PARTI = WS_QKV + 160 * MiB;
constexpr size_t WS_XQH = 900 * MiB, WS_XQL = 932 * MiB;
constexpr int CW_BAR = 4096;

constexpr int RING_OFF = 0, RING_BYTES = 131072;
constexpr int LDSCTL_OFF = RING_BYTES, MISC_OFF = LDSCTL_OFF + 320;
constexpr int LDS_BYTES = 147456;

#define GAS __attribute__((address_space(1)))
#define LAS __attribute__((address_space(3)))
typedef unsigned short bf16;
typedef unsigned v4u __attribute__((ext_vector_type(4)));
typedef unsigned v2u __attribute__((ext_vector_type(2)));
typedef float f32x4 __attribute__((ext_vector_type(4)));
typedef float f32x16 __attribute__((ext_vector_type(16)));
typedef short bf16x8 __attribute__((ext_vector_type(8)));
typedef GAS unsigned gu32;
#define LDS_WAIT() asm volatile("s_waitcnt lgkmcnt(0)" ::: "memory")
#define VM_WAIT() asm volatile("s_waitcnt vmcnt(0)" ::: "memory")
__device__ __forceinline__ unsigned f2bf(float f) { unsigned u = __builtin_bit_cast(unsigned, f); return (u + 0x7fffu + ((u >> 16) & 1u)) >> 16; }
__device__ __forceinline__ unsigned pk2(float lo, float hi) { return f2bf(lo) | (f2bf(hi) << 16); }
__device__ __forceinline__ float bflo(unsigned w) { return __builtin_bit_cast(float, w << 16); }
__device__ __forceinline__ float bfhi(unsigned w) { return __builtin_bit_cast(float, w & 0xffff0000u); }

__device__ __forceinline__ float shx(float v, int k, int lane) { return __builtin_bit_cast(float, __builtin_amdgcn_ds_bpermute((lane ^ k) << 2, __builtin_bit_cast(int, v))); }
#define XB_TMO      128
#define XB_XCNT(j)  (256  + 64 * (j))
#define XB_XSUB(j)  (1280 + 64 * (j))
#define XB_XGEN(j)  (2304 + 64 * (j))
#define XB_TOP      3328
#define XB_TOPGEN   3392
#define XCD_BAR_WORDS 3456
#define XB_SPIN_CAP (1u << 18)

__device__ __forceinline__ unsigned xb_ld(unsigned* p)              { return __hip_atomic_load(p, __ATOMIC_RELAXED, __HIP_MEMORY_SCOPE_AGENT); }
__device__ __forceinline__ unsigned xb_add(unsigned* p, unsigned v) { return __hip_atomic_fetch_add(p, v, __ATOMIC_RELAXED, __HIP_MEMORY_SCOPE_AGENT); }
__device__ __forceinline__ unsigned xb_xcc_id() { return (unsigned)__builtin_amdgcn_s_getreg((3 << 11) | 20) & 0xFu; }
#define XB_SPIN(cond, bar) do { unsigned _sp = 0; while (cond) { __builtin_amdgcn_s_sleep(1); \
    if ((++_sp & 255u) == 0u) { if (xb_ld(&(bar)[XB_TMO])) break; if (_sp > XB_SPIN_CAP) { atomicAdd(&(bar)[XB_TMO], 1u); break; } } } } while (0)

struct XcdBarrier {
    unsigned* bar; unsigned x;
    volatile LAS unsigned* st;
};

__device__ __forceinline__ XcdBarrier xcd_barrier_post(unsigned* bar, volatile LAS unsigned* st) {
    XcdBarrier b; b.bar = bar; b.x = xb_xcc_id(); b.st = st;
    if (threadIdx.x == 0) (void)xb_add(&bar[XB_XCNT(b.x)], 1u);
    return b;
}
__device__ __forceinline__ void xcd_barrier_complete(unsigned* bar, unsigned x, unsigned& nloc, unsigned& nx) {
    const unsigned G = gridDim.x * gridDim.y * gridDim.z;
    unsigned sum, cnt, mine, sp = 0u;
    for (;;) {
        sum = 0u; cnt = 0u; mine = 0u;
#pragma unroll
        for (unsigned j = 0; j < 16; ++j) { const unsigned c = xb_ld(&bar[XB_XCNT(j)]); sum += c; cnt += (c > 0u) ? 1u : 0u; mine = (j == x) ? c : mine; }
        if (sum == G) break;
        __builtin_amdgcn_s_sleep(1);
        if ((++sp & 255u) == 0u) { if (xb_ld(&bar[XB_TMO])) break; if (sp > XB_SPIN_CAP) { atomicAdd(&bar[XB_TMO], 1u); break; } }
    }
    nloc = mine > 0u ? mine : 1u; nx = cnt > 0u ? cnt : 1u;
}

__device__ __forceinline__ void xcd_barrier(const XcdBarrier& b) {
    asm volatile("s_waitcnt vmcnt(0)" ::: "memory");
    __syncthreads();
    if (threadIdx.x == 0) {
        unsigned* bar = b.bar;
        __builtin_amdgcn_s_waitcnt(0);
        unsigned nloc = b.st[0], nx = b.st[1];
        if (nloc == 0u) { xcd_barrier_complete(bar, b.x, nloc, nx); b.st[0] = nloc; b.st[1] = nx; }
        const unsigned old = xb_add(&bar[XB_XSUB(b.x)], 1u);
        const unsigned gen = old / nloc;
        if (old + 1u == (gen + 1u) * nloc) {
            __builtin_amdgcn_fence(__ATOMIC_RELEASE, "agent");
            asm volatile("s_waitcnt vmcnt(0)" ::: "memory");
            const unsigned og = xb_add(&bar[XB_TOP], 1u);
            const unsigned tg = og / nx;
            if (og + 1u == (tg + 1u) * nx) xb_add(&bar[XB_TOPGEN], 1u);
            else XB_SPIN(xb_ld(&bar[XB_TOPGEN]) == tg, bar);
            __builtin_amdgcn_fence(__ATOMIC_ACQUIRE, "agent");
            xb_add(&bar[XB_XGEN(b.x)], 1u);
            asm volatile("s_waitcnt vmcnt(0)" ::: "memory");
        } else {
            XB_SPIN(xb_ld(&bar[XB_XGEN(b.x)]) == gen, bar);
            __builtin_amdgcn_fence(__ATOMIC_ACQUIRE, "agent");
            asm volatile("s_waitcnt vmcnt(0)" ::: "memory");
        }
    }
    __syncthreads();
}

__device__ __forceinline__ float wave_sum(float v, int lane) {
#pragma unroll
    for (int o = 1; o < 64; o <<= 1) v += shx(v, o, lane);
    return v;
}
__device__ __forceinline__ void* ldptr(LAS unsigned char* lds, int i) {
    const unsigned long long v = ((const LAS unsigned long long*)(lds + LDSCTL_OFF + 1024))[i];
    const unsigned lo = __builtin_amdgcn_readfirstlane((unsigned)v), hi = __builtin_amdgcn_readfirstlane((unsigned)(v >> 32));
    return (void*)(((unsigned long long)hi << 32) | lo);
}
struct OffsetOrder {
    pg8::StaticOrder S;
    __device__ void init(int M, int N, int G, int c, int off) { S.init(M, N, G, (c + G - off % G) % G); }
    __device__ bool next(int i, pg8::Unit& u) const { return S.next(i, u); }
    __device__ __forceinline__ void a_ready(const pg8::Unit&) const {}
    __device__ __forceinline__ void done(const pg8::Unit&) const {}
};

template <bool PERMQKV>
__device__ __forceinline__ void transpose_item(const float* W, int K, int N, bf16* WT, LAS float* scr, int item, int lane, const float* gk = nullptr) {
    const int nblk = N / 32, kb = item / nblk, nb = item % nblk, k0 = 64 * kb, n0 = 32 * nb;
    int d0 = n0;
    if (PERMQKV) { const int within = n0 & 255; d0 = (n0 & ~255) + 128 * ((within >> 5) & 1) + 32 * (within >> 6); }
#pragma unroll
    for (int i = 0; i < 8; ++i) { const int kk = 8 * i + (lane >> 3), nn = 4 * (lane & 7);
        const f32x4 w4 = *(const GAS f32x4*)(W + (size_t)(k0 + kk) * N + n0 + nn) * (gk ? gk[k0 + kk] : 1.f);
        scr[kk * 33 + nn] = w4[0]; scr[kk * 33 + nn + 1] = w4[1]; scr[kk * 33 + nn + 2] = w4[2]; scr[kk * 33 + nn + 3] = w4[3]; }
    LDS_WAIT(); asm volatile("" ::: "memory");
    const int c = lane & 7;
#pragma unroll
    for (int j = 0; j < 4; ++j) { const int n = (lane >> 3) + 8 * j; const LAS float* s = scr + (8 * c) * 33 + n;
        v4u o; o.x = pk2(s[0 * 33], s[1 * 33]); o.y = pk2(s[2 * 33], s[3 * 33]); o.z = pk2(s[4 * 33], s[5 * 33]); o.w = pk2(s[6 * 33], s[7 * 33]);
        *(GAS v4u*)(WT + (size_t)(d0 + n) * K + k0 + 8 * c) = o; }
    LDS_WAIT(); asm volatile("" ::: "memory");
}
__device__ __forceinline__ void convert_bf16(const float* src, bf16* dst, size_t n, size_t gtid, size_t nthreads) {
    for (size_t i = gtid * 8; i < n; i += nthreads * 8) {
        const f32x4 a = *(const GAS f32x4*)(src + i), b = *(const GAS f32x4*)(src + i + 4);
        v4u o; o.x = pk2(a[0], a[1]); o.y = pk2(a[2], a[3]); o.z = pk2(b[0], b[1]); o.w = pk2(b[2], b[3]);
        *(GAS v4u*)(dst + i) = o;
    }
}
__device__ __forceinline__ int t5_bucket(int rel) {
    const int n = rel < 0 ? -rel : rel;
    const int b = n < 8 ? n : n < 12 ? 8 : n < 16 ? 9 : n < 23 ? 10 : n < 32 ? 11 : n < 46 ? 12 : n < 64 ? 13 : n < 91 ? 14 : 15;
    return b + (rel > 0 ? 16 : 0);
}
__constant__ float ROPE_INV[16] = {1.000000000e+00f, 5.623413324e-01f, 3.162277639e-01f, 1.778279394e-01f, 1.000000015e-01f, 5.623413250e-02f, 3.162277490e-02f, 1.778279431e-02f,
                                   9.999999776e-03f, 5.623413250e-03f, 3.162277630e-03f, 1.778279431e-03f, 1.000000047e-03f, 5.623413017e-04f, 3.162277571e-04f, 1.778279402e-04f};

__device__ __forceinline__ void rms_row_to_bf16(const float* xrow, const float* g0, bf16* o0, const float* g1, bf16* o1, int lane) {
    const GAS f32x4* xr = (const GAS f32x4*)xrow + lane;
    f32x4 v[8]; float s = 0.f;
#pragma unroll
    for (int j = 0; j < 8; ++j) { v[j] = xr[64 * j]; s += (v[j].x * v[j].x + v[j].y * v[j].y) + (v[j].z * v[j].z + v[j].w * v[j].w); }
    const float rstd = 1.f / sqrtf(wave_sum(s, lane) * (1.f / DM) + EPS);
    {   const GAS f32x4* gr = (const GAS f32x4*)g0 + lane; GAS v2u* o8 = (GAS v2u*)o0 + lane;
#pragma unroll
        for (int j = 0; j < 8; ++j) { const f32x4 gg = gr[64 * j]; v2u w; w.x = pk2(v[j].x * rstd * gg.x, v[j].y * rstd * gg.y); w.y = pk2(v[j].z * rstd * gg.z, v[j].w * rstd * gg.w); o8[64 * j] = w; } }
    if (g1) { const GAS f32x4* gr = (const GAS f32x4*)g1 + lane; GAS v2u* o8 = (GAS v2u*)o1 + lane;
#pragma unroll
        for (int j = 0; j < 8; ++j) { const f32x4 gg = gr[64 * j]; v2u w; w.x = pk2(v[j].x * rstd * gg.x, v[j].y * rstd * gg.y); w.y = pk2(v[j].z * rstd * gg.z, v[j].w * rstd * gg.w); o8[64 * j] = w; } }
}
__device__ __forceinline__ void prep_rows2(const float* x0, bf16* o0, u64_t* sq, int lane) {
    f32x4 v[2][8];
#pragma unroll
    for (int q = 0; q < 2; ++q) { const GAS f32x4* xr = (const GAS f32x4*)(x0 + (size_t)q * DM) + lane;
#pragma unroll
        for (int j = 0; j < 8; ++j) v[q][j] = xr[64 * j]; }
#pragma unroll
    for (int q = 0; q < 2; ++q) { GAS v2u* o8 = (GAS v2u*)(o0 + (size_t)q * DM) + lane; float s = 0.f;
#pragma unroll
        for (int j = 0; j < 8; ++j) { const f32x4 a = v[q][j]; s += (a.x * a.x + a.y * a.y) + (a.z * a.z + a.w * a.w); v2u w; w.x = pk2(a.x, a.y); w.y = pk2(a.z, a.w); o8[64 * j] = w; }
        s = wave_sum(s, lane);
        if (lane == 0) sq[q] = rowsq_fx(s); }
}
__device__ __forceinline__ void norm_rows(const float* X, const float* g, bf16* XN, int gw, int NGW, int lane) {
    for (int m = gw; m < T; m += NGW) rms_row_to_bf16(X + (size_t)m * DM, g, XN + (size_t)m * DM, nullptr, nullptr, lane);
}

template <int TYPE>
__device__ __forceinline__ void naive_attn_item(const bf16* QKV, bf16* ATT, int b, int grow, int head, int lane, const float* biasA, const float* sink, const float* rpb) {
    const int tpos = grow * 64 + lane; const size_t trow = (size_t)b * SEQ + tpos;
    int qcol, kcol, vcol, ocol;
    if (TYPE == 0) { qcol = QA + head * 64; kcol = KA + (head / 3) * 64; vcol = VA + (head / 3) * 64; ocol = OA + head * 64; }
    else if (TYPE == 1) { qcol = QB + head * 64; kcol = KB + head * 64; vcol = VB + head * 64; ocol = OB + head * 64; }
    else { qcol = QC + head * 64; kcol = KC + (head / 3) * 64; vcol = VC + (head / 3) * 64; ocol = OC + head * 64; }
    float q[64], o[64];
#pragma unroll
    for (int c = 0; c < 8; ++c) { const v4u w = *(const GAS v4u*)(QKV + trow * DIN + qcol + 8 * c);
        q[8 * c + 0] = bflo(w.x); q[8 * c + 1] = bfhi(w.x); q[8 * c + 2] = bflo(w.y); q[8 * c + 3] = bfhi(w.y); q[8 * c + 4] = bflo(w.z); q[8 * c + 5] = bfhi(w.z); q[8 * c + 6] = bflo(w.w); q[8 * c + 7] = bfhi(w.w); }
#pragma unroll
    for (int d = 0; d < 64; ++d) o[d] = 0.f;
    float m = -1e30f, l = 0.f;
    int j0, j1;
    if (TYPE == 0) { j0 = grow * 64 - 128; if (j0 < 0) j0 = 0; j1 = grow * 64 + 63 + 128; if (j1 > SEQ - 1) j1 = SEQ - 1; }
    else if (TYPE == 1) { int r0 = grow - 4; r0 = r0 < 0 ? 0 : (r0 > 24 ? 24 : r0); j0 = r0 * 64; j1 = j0 + 511; }
    else { j0 = 0; j1 = SEQ - 1; }
    int c0 = lane - 8; c0 = c0 < 0 ? 0 : (c0 > 48 ? 48 : c0);
#pragma unroll 1
    for (int j = j0; j <= j1; ++j) {
        const bf16* krow = QKV + ((size_t)b * SEQ + j) * DIN;
        float s = 0.f;
#pragma unroll
        for (int c = 0; c < 8; ++c) { const v4u w = *(const GAS v4u*)(krow + kcol + 8 * c);
            s += q[8 * c + 0] * bflo(w.x) + q[8 * c + 1] * bfhi(w.x) + q[8 * c + 2] * bflo(w.y) + q[8 * c + 3] * bfhi(w.y) + q[8 * c + 4] * bflo(w.z) + q[8 * c + 5] * bfhi(w.z) + q[8 * c + 6] * bflo(w.w) + q[8 * c + 7] * bfhi(w.w); }
        bool valid = true;
        if (TYPE == 0) { const int rel = j - tpos; valid = (rel >= -128 && rel <= 128); if (valid) s += biasA[head * 257 + rel + 128]; }
        if (TYPE == 1) { const int kr = j >> 6, kc = j & 63; valid = (kc >= c0 && kc < c0 + 16); if (valid) s += rpb[(head * 15 + (kr - grow + 7)) * 31 + (kc - lane + 15)]; }
        const float mn = valid ? fmaxf(m, s) : m;
        const float a = __expf(m - mn);
        const float p = valid ? __expf(s - mn) : 0.f;
        l = l * a + p; m = mn;
#pragma unroll
        for (int c = 0; c < 8; ++c) { const v4u w = *(const GAS v4u*)(krow + vcol + 8 * c);
            o[8 * c + 0] = o[8 * c + 0] * a + p * bflo(w.x); o[8 * c + 1] = o[8 * c + 1] * a + p * bfhi(w.x); o[8 * c + 2] = o[8 * c + 2] * a + p * bflo(w.y); o[8 * c + 3] = o[8 * c + 3] * a + p * bfhi(w.y);
            o[8 * c + 4] = o[8 * c + 4] * a + p * bflo(w.z); o[8 * c + 5] = o[8 * c + 5] * a + p * bfhi(w.z); o[8 * c + 6] = o[8 * c + 6] * a + p * bflo(w.w); o[8 * c + 7] = o[8 * c + 7] * a + p * bfhi(w.w); }
    }
    if (TYPE == 0) l += __expf(sink[head] - m);
    const float inv = 1.f / l;
#pragma unroll
    for (int c = 0; c < 8; ++c) { v4u w; w.x = pk2(o[8 * c + 0] * inv, o[8 * c + 1] * inv); w.y = pk2(o[8 * c + 2] * inv, o[8 * c + 3] * inv); w.z = pk2(o[8 * c + 4] * inv, o[8 * c + 5] * inv); w.w = pk2(o[8 * c + 6] * inv, o[8 * c + 7] * inv);
        *(GAS v4u*)(ATT + trow * DM + ocol + 8 * c) = w; }
}
__device__ __forceinline__ float rdl(float v, int l) { return __builtin_bit_cast(float, __builtin_amdgcn_readlane(__builtin_bit_cast(int, v), l)); }
__device__ __forceinline__ void naive_mem_item(const bf16* QM, const bf16* KVM, bf16* OM, const float* gq, size_t trow, int b, int head, int lane) {
    const unsigned qw = *(const GAS unsigned*)(QM + trow * MEMW + head * 128 + 2 * lane);
    float q0 = bflo(qw), q1 = bfhi(qw);
    const float ss = wave_sum(q0 * q0 + q1 * q1, lane);
    const float r = 0.08838834764831845f / sqrtf(ss * (1.f / 128.f) + EPS);
    q0 *= r * gq[2 * lane]; q1 *= r * gq[2 * lane + 1];
    const bf16* kbase = KVM + ((size_t)b * NMEM + lane) * 1024 + head * 128;
    float s[4] = {0.f, 0.f, 0.f, 0.f};
#pragma unroll 1
    for (int c = 0; c < 16; ++c) {
        float qa[8];
#pragma unroll
        for (int e = 0; e < 4; ++e) { qa[2 * e] = rdl(q0, 4 * c + e); qa[2 * e + 1] = rdl(q1, 4 * c + e); }
#pragma unroll
        for (int i = 0; i < 4; ++i) { const v4u w = *(const GAS v4u*)(kbase + (size_t)i * 64 * 1024 + 8 * c);
            s[i] += qa[0] * bflo(w.x) + qa[1] * bfhi(w.x) + qa[2] * bflo(w.y) + qa[3] * bfhi(w.y) + qa[4] * bflo(w.z) + qa[5] * bfhi(w.z) + qa[6] * bflo(w.w) + qa[7] * bfhi(w.w); }
    }
    float m = fmaxf(fmaxf(s[0], s[1]), fmaxf(s[2], s[3]));
#pragma unroll
    for (int o = 1; o < 64; o <<= 1) m = fmaxf(m, shx(m, o, lane));
    float p[4]; float l = 0.f;
#pragma unroll
    for (int i = 0; i < 4; ++i) { p[i] = __expf(s[i] - m); l += p[i]; }
    l = wave_sum(l, lane);
    const bf16* vbase = KVM + ((size_t)b * NMEM) * 1024 + 512 + head * 128 + 2 * lane;
    float o0 = 0.f, o1 = 0.f;
#pragma unroll
    for (int i = 0; i < 4; ++i) {
#pragma unroll 4
        for (int jj = 0; jj < 64; ++jj) { const float pj = rdl(p[i], jj); const unsigned w = *(const GAS unsigned*)(vbase + (size_t)(64 * i + jj) * 1024); o0 += pj * bflo(w); o1 += pj * bfhi(w); }
    }
    const float inv = 1.f / l;
    *(GAS unsigned*)(OM + trow * MEMW + head * 128 + 2 * lane) = pk2(o0 * inv, o1 * inv);
}
__device__ __forceinline__ void mixnorm_rows(bf16* ATT, const float* g, int gw, int NGW, int lane) {
    for (int m = gw; m < T; m += NGW) {
        GAS v4u* p = (GAS v4u*)(ATT + (size_t)m * DM + 32 * lane);
        v4u w[4]; float f[32]; float ss = 0.f;
#pragma unroll
        for (int c = 0; c < 4; ++c) { w[c] = p[c];
            f[8 * c + 0] = bflo(w[c].x); f[8 * c + 1] = bfhi(w[c].x); f[8 * c + 2] = bflo(w[c].y); f[8 * c + 3] = bfhi(w[c].y); f[8 * c + 4] = bflo(w[c].z); f[8 * c + 5] = bfhi(w[c].z); f[8 * c + 6] = bflo(w[c].w); f[8 * c + 7] = bfhi(w[c].w); }
#pragma unroll
        for (int i = 0; i < 32; ++i) ss += f[i] * f[i];
        const int grp = lane < 24 ? 0 : (lane < 40 ? 1 : 2);
        const float sa = wave_sum(grp == 0 ? ss : 0.f, lane), sb = wave_sum(grp == 1 ? ss : 0.f, lane), sc = wave_sum(grp == 2 ? ss : 0.f, lane);
        const float r = grp == 0 ? 1.f / sqrtf(sa * (1.f / 768.f) + EPS) : (grp == 1 ? 1.f / sqrtf(sb * (1.f / 512.f) + EPS) : 1.f / sqrtf(sc * (1.f / 768.f) + EPS));
        const float* gg = g + 32 * lane;
#pragma unroll
        for (int c = 0; c < 4; ++c) { const f32x4 g0 = *(const GAS f32x4*)(gg + 8 * c), g1 = *(const GAS f32x4*)(gg + 8 * c + 4);
            v4u o; o.x = pk2(f[8 * c + 0] * r * g0[0], f[8 * c + 1] * r * g0[1]); o.y = pk2(f[8 * c + 2] * r * g0[2], f[8 * c + 3] * r * g0[3]);
            o.z = pk2(f[8 * c + 4] * r * g1[0], f[8 * c + 5] * r * g1[1]); o.w = pk2(f[8 * c + 6] * r * g1[2], f[8 * c + 7] * r * g1[3]); p[c] = o; }
    }
}

#ifndef PEER_HD
#define PEER_HD __device__ __forceinline__
#define PEER_EXP(x) __expf(x)
#endif
template <int N> PEER_HD void bitonic_sort_desc(float* v) {
#pragma unroll
    for (int k = 2; k <= N; k <<= 1)
#pragma unroll
        for (int j = k >> 1; j > 0; j >>= 1)
#pragma unroll
            for (int i = 0; i < N; ++i) { const int l = i ^ j; if (l > i) { const bool desc = ((i & k) == 0); const float a = v[i], b = v[l]; const float hi = fmaxf(a, b), lo = fminf(a, b);
                v[i] = desc ? hi : lo; v[l] = desc ? lo : hi; } }
}
PEER_HD void merge_top16(float* a, const float* b) {
    float c[16];
#pragma unroll
    for (int i = 0; i < 16; ++i) c[i] = fmaxf(a[i], b[15 - i]);
#pragma unroll
    for (int j = 8; j > 0; j >>= 1)
#pragma unroll
        for (int i = 0; i < 16; ++i) { const int l = i ^ j; if (l > i) { const float x = c[i], y = c[l]; c[i] = fmaxf(x, y); c[l] = fminf(x, y); } }
#pragma unroll
    for (int i = 0; i < 16; ++i) a[i] = c[i];
}
PEER_HD void top16_of_64(float (&v)[64]) {
    bitonic_sort_desc<16>(&v[0]); bitonic_sort_desc<16>(&v[16]); bitonic_sort_desc<16>(&v[32]); bitonic_sort_desc<16>(&v[48]);
    merge_top16(&v[0], &v[16]); merge_top16(&v[32], &v[48]); merge_top16(&v[0], &v[32]);
}
PEER_HD float pack_idx(float s, unsigned idx, unsigned mask) { return __builtin_bit_cast(float, (__builtin_bit_cast(unsigned, s) & ~mask) | idx); }
PEER_HD unsigned low_bits(float s, unsigned mask) { return __builtin_bit_cast(unsigned, s) & mask; }
PEER_HD unsigned pick16(const float* a, unsigned i, unsigned mask) {
    unsigned r = 0;
#pragma unroll
    for (unsigned k = 0; k < 16; ++k) r = (i == k) ? low_bits(a[k], mask) : r;
    return r;
}
PEER_HD void peer_candidates(const float* a, const float* b, int* e, float* gate) {
    float c[64]; int n = 0;
#pragma unroll
    for (int i = 0; i < 16; ++i)
#pragma unroll
        for (int j = 0; j < 16; ++j) if ((i + 1) * (j + 1) <= 16) { c[n] = pack_idx(a[i] + b[j], (unsigned)(i * 16 + j), 0xffu); ++n; }
#pragma unroll
    for (int k = 50; k < 64; ++k) c[k] = -3.0e38f;
    top16_of_64(c);
    float mx = c[0], den = 0.f;
#pragma unroll
    for (int k = 0; k < 16; ++k) { const unsigned id = low_bits(c[k], 0xffu); const unsigned n0 = pick16(a, id >> 4, 0x7fu), n1 = pick16(b, id & 15u, 0x7fu);
        e[k] = (int)(n0 * 128u + n1); gate[k] = PEER_EXP(c[k] - mx); den += gate[k]; }
    const float inv = 1.f / den;
#pragma unroll
    for (int k = 0; k < 16; ++k) gate[k] *= inv;
}

__device__ __forceinline__ void peer_select_unit(const bf16* QP, const bf16* PK, int* PIDX, float* PGATE, int tb, int h, int wave, int lane) {
    const int hh = lane >> 5, tl = lane & 31; const size_t t = (size_t)tb * 256 + wave * 32 + tl;
    float ab[2][16];
#pragma unroll
    for (int p = 0; p < 2; ++p) {
        bf16x8 bq[8];
#pragma unroll
        for (int s = 0; s < 8; ++s) bq[s] = *(const GAS bf16x8*)(QP + t * DM + 256 * h + 128 * p + 16 * s + 8 * hh);
        float v[64];
#pragma unroll
        for (int nb = 0; nb < 4; ++nb) {
            f32x16 acc;
#pragma unroll
            for (int r = 0; r < 16; ++r) acc[r] = 0.f;
            const bf16* kp = PK + ((size_t)((h * 2 + p) * 128 + 32 * nb + tl)) * 128 + 8 * hh;
            bf16x8 ak[8];
#pragma unroll
            for (int s = 0; s < 8; ++s) ak[s] = *(const GAS bf16x8*)(kp + 16 * s);
#pragma unroll
            for (int s = 0; s < 8; ++s) acc = __builtin_amdgcn_mfma_f32_32x32x16_bf16(ak[s], bq[s], acc, 0, 0, 0);
#pragma unroll
            for (int r = 0; r < 16; ++r) v[16 * nb + r] = pack_idx(acc[r], (unsigned)(32 * nb + 8 * (r >> 2) + 4 * hh + (r & 3)), 0x7fu);
        }
        top16_of_64(v);
        float pv[16];
#pragma unroll
        for (int i = 0; i < 16; ++i) pv[i] = shx(v[i], 32, lane);
        merge_top16(&v[0], pv);
#pragma unroll
        for (int i = 0; i < 16; ++i) ab[p][i] = v[i];
    }
    int e[16]; float gate[16];
    peer_candidates(ab[0], ab[1], e, gate);
    if (hh == 0) { GAS v4u* o = (GAS v4u*)(PIDX + t * 128 + h * 16);
#pragma unroll
        for (int c = 0; c < 4; ++c) o[c] = (v4u){(unsigned)e[4 * c], (unsigned)e[4 * c + 1], (unsigned)e[4 * c + 2], (unsigned)e[4 * c + 3]}; }
    else { GAS f32x4* o = (GAS f32x4*)(PGATE + t * 128 + h * 16);
#pragma unroll
        for (int c = 0; c < 4; ++c) o[c] = (f32x4){gate[4 * c], gate[4 * c + 1], gate[4 * c + 2], gate[4 * c + 3]}; }
}

typedef float f32x2 __attribute__((ext_vector_type(2)));
typedef unsigned v6u __attribute__((ext_vector_type(6)));
typedef float v32f __attribute__((ext_vector_type(32)));
typedef v4u __attribute__((aligned(8))) v4u_a8;
constexpr float PU_SCALE6 = 90.0f, PV_SCALE6 = 5.65f;
__device__ __forceinline__ unsigned enc_e2m3(float v) {
    const float a = fminf(fabsf(v), 7.5f);
    unsigned code;
    if (a < 1.0f) code = (unsigned)__builtin_rintf(a * 8.f);
    else { const unsigned b = __builtin_bit_cast(unsigned, a) - 0x3F800000u; code = ((b + 0x7FFFFu + ((b >> 20) & 1u)) >> 20) + 8u; }
    return code | (v < 0.f ? 32u : 0u);
}
__device__ __forceinline__ void convert_fp6_rows(const float* src, unsigned char* dst, int nrows, float scale, const float* gain, int gw, int NGW, int lane) {
    for (int r = gw; r < nrows; r += NGW) {
        const float* sp = src + (size_t)r * DM + 4 * lane; const float* gp = gain ? gain + (size_t)(r / PEER_N) * DM + 4 * lane : nullptr;
        unsigned w[6] = {0u, 0u, 0u, 0u, 0u, 0u};
#pragma unroll
        for (int j = 0; j < 8; ++j) { f32x4 a = *(const GAS f32x4*)(sp + 256 * j) * scale; if (gp) a = a * *(const GAS f32x4*)(gp + 256 * j);
#pragma unroll
            for (int e = 0; e < 4; ++e) { const unsigned code = enc_e2m3(a[e]); const int bp = 6 * (4 * j + e), wi = bp >> 5, sh = bp & 31;
                w[wi] |= code << sh; if (sh > 26) w[wi + 1] |= code >> (32 - sh); } }
        unsigned char* dp = dst + (size_t)r * 1536 + 24 * lane;
        *(GAS v4u_a8*)dp = (v4u){w[0], w[1], w[2], w[3]}; *(GAS v2u*)(dp + 16) = (v2u){w[4], w[5]};
    }
}
constexpr float PV_SCALE4 = 5.65f, PU_SCALE4 = 90.0f;
__device__ __forceinline__ unsigned enc_e2m1(float v) {
    const float a = fabsf(v);
    const unsigned code = a < 0.25f ? 0u : a < 0.75f ? 1u : a < 1.25f ? 2u : a < 1.75f ? 3u : a < 2.5f ? 4u : a < 3.5f ? 5u : a < 5.0f ? 6u : 7u;
    return code | (v < 0.f ? 8u : 0u);
}
__device__ __forceinline__ void convert_fp4_rows(const float* src, unsigned char* dst, int nrows, float scale, const float* gain, int gw, int NGW, int lane) {
    for (int r0 = 2 * gw; r0 < nrows; r0 += 2 * NGW) {
        f32x4 a[2][8];
#pragma unroll
        for (int q = 0; q < 2; ++q) { const float* sp = src + (size_t)(r0 + q) * DM + 4 * lane;
#pragma unroll
            for (int j = 0; j < 8; ++j) a[q][j] = *(const GAS f32x4*)(sp + 256 * j); }
#pragma unroll
        for (int q = 0; q < 2; ++q) { const int r = r0 + q; const float* gp = gain ? gain + (size_t)(r / PEER_N) * DM + 4 * lane : nullptr;
            unsigned w[4] = {0u, 0u, 0u, 0u};
#pragma unroll
            for (int j = 0; j < 8; ++j) { f32x4 v = a[q][j] * scale; if (gp) v = v * *(const GAS f32x4*)(gp + 256 * j);
#pragma unroll
                for (int e = 0; e < 4; ++e) { const int i = 4 * j + e; w[i >> 3] |= enc_e2m1(v[e]) << (4 * (i & 7)); } }
            *(GAS v4u*)(dst + (size_t)r * 1024 + 16 * lane) = (v4u){w[0], w[1], w[2], w[3]}; }
    }
}
#define PG4_LOAD(buf, tab, idlo, idhi, g) do { _Pragma("unroll") for (int i_ = 0; i_ < PG6_R; ++i_) { const int k_ = (g) * PG6_R + i_; \
        const int e_ = __builtin_amdgcn_readlane(k_ < 64 ? idlo : idhi, k_ & 63); buf[i_] = __builtin_amdgcn_raw_buffer_load_b128(tab, (int)voff4, e_ * 1024, 0); } } while (0)
#define PG4_DOT1(buf, i_, dst) do { f32x2 a_ = {0.f, 0.f}; _Pragma("unroll") for (int c_ = 0; c_ < 4; ++c_) { const unsigned u_ = buf[i_][c_]; \
        a_ += __builtin_amdgcn_cvt_scalef32_pk_f32_fp4(u_, 1.0f, 0) * x[4 * c_ + 0]; a_ += __builtin_amdgcn_cvt_scalef32_pk_f32_fp4(u_, 1.0f, 1) * x[4 * c_ + 1]; \
        a_ += __builtin_amdgcn_cvt_scalef32_pk_f32_fp4(u_, 1.0f, 2) * x[4 * c_ + 2]; a_ += __builtin_amdgcn_cvt_scalef32_pk_f32_fp4(u_, 1.0f, 3) * x[4 * c_ + 3]; } dst = a_.x + a_.y; __builtin_amdgcn_sched_barrier(0); } while (0)
#define PG4_DOT(buf, g) do { float p_[8]; _Pragma("unroll") for (int i_ = 0; i_ < 8; ++i_) PG4_DOT1(buf, i_, p_[i_]); \
        float q_[4]; _Pragma("unroll") for (int i_ = 0; i_ < 4; ++i_) { const float keep_ = b5 ? p_[i_ + 4] : p_[i_], send_ = b5 ? p_[i_] : p_[i_ + 4]; q_[i_] = keep_ + shx(send_, 32, lane); } \
        float r_[2]; _Pragma("unroll") for (int i_ = 0; i_ < 2; ++i_) { const float keep_ = b4 ? q_[i_ + 2] : q_[i_], send_ = b4 ? q_[i_] : q_[i_ + 2]; r_[i_] = keep_ + shx(send_, 16, lane); } \
        float s_; { const float keep_ = b3 ? r_[1] : r_[0], send_ = b3 ? r_[0] : r_[1]; s_ = keep_ + shx(send_, 8, lane); } \
        s_ += shx(s_, 4, lane); s_ += shx(s_, 2, lane); s_ += shx(s_, 1, lane); \
        if ((lane & 7) == 0) wl[(g) * 8 + (lane >> 3)] = s_; } while (0)
#define PG4_AXPY(buf, g) do { _Pragma("unroll") for (int i_ = 0; i_ < PG6_R; ++i_) { const float w_ = wl[(g) * PG6_R + i_]; const f32x2 wv_ = {w_, w_}; \
        _Pragma("unroll") for (int c_ = 0; c_ < 4; ++c_) { const unsigned u_ = buf[i_][c_]; \
            y[4 * c_ + 0] += __builtin_amdgcn_cvt_scalef32_pk_f32_fp4(u_, 1.0f, 0) * wv_; y[4 * c_ + 1] += __builtin_amdgcn_cvt_scalef32_pk_f32_fp4(u_, 1.0f, 1) * wv_; \
            y[4 * c_ + 2] += __builtin_amdgcn_cvt_scalef32_pk_f32_fp4(u_, 1.0f, 2) * wv_; y[4 * c_ + 3] += __builtin_amdgcn_cvt_scalef32_pk_f32_fp4(u_, 1.0f, 3) * wv_; } \
        __builtin_amdgcn_sched_barrier(0); } } while (0)
#ifndef PG6_R
#define PG6_R 8
#endif
#define PG6_LOAD(buf, tab, idlo, idhi, g) do { _Pragma("unroll") for (int i_ = 0; i_ < PG6_R; ++i_) { const int k_ = (g) * PG6_R + i_; \
        const int e_ = __builtin_amdgcn_readlane(k_ < 64 ? idlo : idhi, k_ & 63); const unsigned char* rp_ = (tab) + (size_t)(unsigned)e_ * 1536u; \
        const v4u a_ = *(const GAS v4u_a8*)(rp_ + voff); const v2u b_ = *(const GAS v2u*)(rp_ + voff + 16); buf[i_] = (v6u){a_.x, a_.y, a_.z, a_.w, b_.x, b_.y}; } } while (0)
#define PG6_DOT1(buf, i_, dst) do { const v32f f_ = __builtin_amdgcn_cvt_scalef32_pk32_f32_fp6(buf[i_], 1.0f); f32x2 a_ = {0.f, 0.f}; \
        _Pragma("unroll") for (int c_ = 0; c_ < 16; ++c_) a_ += (f32x2){f_[2 * c_], f_[2 * c_ + 1]} * x[c_]; dst = a_.x + a_.y; __builtin_amdgcn_sched_barrier(0); } while (0)
#if PG6_R == 8
#define PG6_DOT(buf, g) do { float p_[8]; _Pragma("unroll") for (int i_ = 0; i_ < 8; ++i_) PG6_DOT1(buf, i_, p_[i_]); \
        float q_[4]; _Pragma("unroll") for (int i_ = 0; i_ < 4; ++i_) { const float keep_ = b5 ? p_[i_ + 4] : p_[i_], send_ = b5 ? p_[i_] : p_[i_ + 4]; q_[i_] = keep_ + shx(send_, 32, lane); } \
        float r_[2]; _Pragma("unroll") for (int i_ = 0; i_ < 2; ++i_) { const float keep_ = b4 ? q_[i_ + 2] : q_[i_], send_ = b4 ? q_[i_] : q_[i_ + 2]; r_[i_] = keep_ + shx(send_, 16, lane); } \
        float s_; { const float keep_ = b3 ? r_[1] : r_[0], send_ = b3 ? r_[0] : r_[1]; s_ = keep_ + shx(send_, 8, lane); } \
        s_ += shx(s_, 4, lane); s_ += shx(s_, 2, lane); s_ += shx(s_, 1, lane); \
        if ((lane & 7) == 0) wl[(g) * 8 + (lane >> 3)] = s_; } while (0)
#else
#define PG6_DOT(buf, g) do { float p_[4]; _Pragma("unroll") for (int i_ = 0; i_ < 4; ++i_) PG6_DOT1(buf, i_, p_[i_]); \
        float r_[2]; _Pragma("unroll") for (int i_ = 0; i_ < 2; ++i_) { const float keep_ = b5 ? p_[i_ + 2] : p_[i_], send_ = b5 ? p_[i_] : p_[i_ + 2]; r_[i_] = keep_ + shx(send_, 32, lane); } \
        float s_; { const float keep_ = b4 ? r_[1] : r_[0], send_ = b4 ? r_[0] : r_[1]; s_ = keep_ + shx(send_, 16, lane); } \
        s_ += shx(s_, 8, lane); s_ += shx(s_, 4, lane); s_ += shx(s_, 2, lane); s_ += shx(s_, 1, lane); \
        if ((lane & 15) == 0) wl[(g) * 4 + (lane >> 4)] = s_; } while (0)
#endif
#define PG6_AXPY(buf, g) do { _Pragma("unroll") for (int i_ = 0; i_ < PG6_R; ++i_) { const float w_ = wl[(g) * PG6_R + i_]; const f32x2 wv_ = {w_, w_}; \
        const v32f f_ = __builtin_amdgcn_cvt_scalef32_pk32_f32_fp6(buf[i_], 1.0f); _Pragma("unroll") for (int c_ = 0; c_ < 16; ++c_) y[c_] += (f32x2){f_[2 * c_], f_[2 * c_ + 1]} * wv_; __builtin_amdgcn_sched_barrier(0); } } while (0)
__device__ __forceinline__ unsigned shxu(unsigned v, int k, int lane) { return (unsigned)__builtin_amdgcn_ds_bpermute((lane ^ k) << 2, (int)v); }
__device__ __forceinline__ void wave_sort128(unsigned& a, unsigned& b, int lane) {
#pragma unroll
    for (int k = 2; k <= 128; k <<= 1) {
#pragma unroll
        for (int j = k >> 1; j > 0; j >>= 1) {
            if (j == 64) { const unsigned lo = a < b ? a : b, hi = a < b ? b : a; a = lo; b = hi; }
            else {
                const unsigned pa = shxu(a, j, lane), pb = shxu(b, j, lane);
                const bool lower = (lane & j) == 0;
                const bool asc_a = (lane & k) == 0, asc_b = ((lane + 64) & k) == 0;
                const bool take_min_a = (lower == asc_a), take_min_b = (lower == asc_b);
                a = take_min_a ? (a < pa ? a : pa) : (a < pa ? pa : a);
                b = take_min_b ? (b < pb ? b : pb) : (b < pb ? pb : b);
            }
        }
    }
}
#ifndef PEER_U_FP4
#define PEER_U_FP4 1
#endif
#if PEER_U_FP4
typedef v4u urow_t;
#define PGU_LOAD PG4_LOAD
#define PGU_DOT PG4_DOT
constexpr float PU_SCALE = PU_SCALE4; constexpr int PU_STRIDE = 1024;
#else
typedef v6u urow_t;
#define PGU_LOAD PG6_LOAD
#define PGU_DOT PG6_DOT
constexpr float PU_SCALE = PU_SCALE6; constexpr int PU_STRIDE = 1536;
#endif
constexpr float PU_SCALEI = 135.0f, PX_SCALEI = 20.0f;
__device__ __forceinline__ void peer_v_pass(bf16* XN, const unsigned char* PV6, const int* PIDX, const float* PGATE, const int* PARTI, float* X, u64_t* rowsq_out, LAS float* wl, int gw, int NGW, int lane) {
    const unsigned voff4 = 16u * (unsigned)lane, l4 = 4u * (unsigned)lane, l8 = 8u * (unsigned)lane, l16 = 16u * (unsigned)lane;
    constexpr int NG = 128 / PG6_R;
    const __amdgpu_buffer_rsrc_t PVr = __builtin_amdgcn_make_buffer_rsrc((void*)PV6, 0, PEER_N * 1024, 0x00020000);
    for (int t_ = gw; t_ < T; t_ += NGW) {
        int t = t_; asm volatile("" : "+s"(t));
        const char* pidx_t = (const char*)(PIDX + (size_t)t * 128); const char* pgate_t = (const char*)(PGATE + (size_t)t * 128);
        const int idlo = *(const GAS int*)(pidx_t + l4), idhi = *(const GAS int*)(pidx_t + l4 + 256);
        v4u AV[PG6_R], BV[PG6_R];
        PG4_LOAD(AV, PVr, idlo, idhi, 0);
        {
            int s0 = 0, s1 = 0;
#pragma unroll
            for (int sp = 0; sp < 8; ++sp) { const char* pp = (const char*)(PARTI + ((size_t)sp * T + t) * 128); s0 += *(const GAS int*)(pp + l4); s1 += *(const GAS int*)(pp + l4 + 256); }
            const float d0 = (float)s0 * (1.f / (PX_SCALEI * PU_SCALEI)), d1 = (float)s1 * (1.f / (PX_SCALEI * PU_SCALEI));
            const float g0 = *(const GAS float*)(pgate_t + l4), g1 = *(const GAS float*)(pgate_t + l4 + 256);
            const float w0 = g0 * 0.5f * d0 * (1.f + erff(d0 * 0.70710678118654752f)) * (1.f / PV_SCALE4), w1 = g1 * 0.5f * d1 * (1.f + erff(d1 * 0.70710678118654752f)) * (1.f / PV_SCALE4);
            wl[lane] = w0; wl[64 + lane] = w1;
            LDS_WAIT(); asm volatile("" ::: "memory");
        }
        f32x2 y[16];
#pragma unroll
        for (int i = 0; i < 16; ++i) y[i] = (f32x2){0.f, 0.f};
#pragma unroll 1
        for (int g = 0; g < NG; g += 2) {
            PG4_LOAD(BV, PVr, idlo, idhi, g + 1);
            PG4_AXPY(AV, g);
            if (g + 2 < NG) PG4_LOAD(AV, PVr, idlo, idhi, g + 2);
            PG4_AXPY(BV, g + 1);
        }
        {   char* xo = (char*)(X + (size_t)t * DM);
            char* xbo = (char*)(XN + (size_t)t * DM); float ss = 0.f;
#pragma unroll
            for (int j = 0; j < 8; ++j) { const v2u a = *(const GAS v2u*)(xbo + l8 + 512 * j); f32x4 v = (f32x4){bflo(a.x), bfhi(a.x), bflo(a.y), bfhi(a.y)}; v += (f32x4){y[2 * j].x, y[2 * j].y, y[2 * j + 1].x, y[2 * j + 1].y};
                if (X) *(GAS f32x4*)(xo + l16 + 1024 * j) = v;
                ss += (v[0] * v[0] + v[1] * v[1]) + (v[2] * v[2] + v[3] * v[3]); *(GAS v2u*)(xbo + l8 + 512 * j) = (v2u){pk2(v[0], v[1]), pk2(v[2], v[3])}; }
            if (rowsq_out) { ss = wave_sum(ss, lane); if (lane == 0) rowsq_out[t] = rowsq_fx(ss); } }
        LDS_WAIT(); asm volatile("" ::: "memory");
    }
}


__device__ __forceinline__ unsigned enc_i4(float v) { int q = (int)__builtin_rintf(v); q = q < -7 ? -7 : (q > 7 ? 7 : q); return (unsigned)q & 15u; }
__device__ __forceinline__ void convert_int4_plain(const float* src, unsigned char* dst, int nrows, float scale, const float* gain, int gw, int NGW, int lane) {
    for (int r0 = 2 * gw; r0 < nrows; r0 += 2 * NGW) {
        f32x4 a[2][8];
#pragma unroll
        for (int q = 0; q < 2; ++q) { const float* sp = src + (size_t)(r0 + q) * DM + 4 * lane;
#pragma unroll
            for (int j = 0; j < 8; ++j) a[q][j] = *(const GAS f32x4*)(sp + 256 * j); }
#pragma unroll
        for (int q = 0; q < 2; ++q) { const int r = r0 + q; const float* gp = gain ? gain + (size_t)(r / PEER_N) * DM + 4 * lane : nullptr;
#pragma unroll
            for (int j = 0; j < 8; ++j) { f32x4 v = a[q][j] * scale; if (gp) v = v * *(const GAS f32x4*)(gp + 256 * j);
                const unsigned w = enc_i4(v[0]) | (enc_i4(v[1]) << 4) | (enc_i4(v[2]) << 8) | (enc_i4(v[3]) << 12);
                *(GAS unsigned short*)(dst + (size_t)r * 1024 + 128 * j + 2 * lane) = (unsigned short)w; } }
    }
}
__device__ __forceinline__ void peer_xquant_unit(const bf16* XN, const u64_t* rowsq, unsigned* XQH, unsigned* XQL, int tb, int sl, int tid) {
    for (int it = tid; it < 256 * 32; it += NTHREADS) {
        const int t = tb * 256 + (it >> 5), c8 = it & 31;
        const float xs = PX_SCALEI * rowsq_rs(rowsq, t);
        const v4u w = *(const GAS v4u*)(XN + (size_t)t * DM + 256 * sl + 8 * c8);
        const float f[8] = {bflo(w.x), bfhi(w.x), bflo(w.y), bfhi(w.y), bflo(w.z), bfhi(w.z), bflo(w.w), bfhi(w.w)};
        unsigned hi = 0u, lo = 0u;
#pragma unroll
        for (int j = 0; j < 8; ++j) { int q = (int)__builtin_rintf(f[j] * xs); q = q < -119 ? -119 : (q > 119 ? 119 : q);
            const int xl = ((q + 8) & 15) - 8, xh = (q - xl) >> 4;
            hi |= ((unsigned)xh & 15u) << (4 * j); lo |= ((unsigned)xl & 15u) << (4 * j); }
        XQH[(size_t)t * 256 + 32 * sl + c8] = hi; XQL[(size_t)t * 256 + 32 * sl + c8] = lo;
    }
}
#define PI_LOADROWS(buf, tab, ids, i0) do { _Pragma("unroll") for (int i_ = 0; i_ < 8; ++i_) buf[i_] = __builtin_amdgcn_raw_buffer_load_b128(tab, ids[(i0) + i_] * 1024 + (int)soff, 0, 0); } while (0)
#define PI_LOADIDS(ids, t) do { const char* ip_ = (const char*)PIDX + ((size_t)(t) * 128 + 16 * g) * 4; _Pragma("unroll") for (int c_ = 0; c_ < 4; ++c_) { const v4u q_ = *(const GAS v4u*)(ip_ + 16 * c_); \
        ids[4 * c_] = (int)q_.x; ids[4 * c_ + 1] = (int)q_.y; ids[4 * c_ + 2] = (int)q_.z; ids[4 * c_ + 3] = (int)q_.w; } } while (0)
#define PI_UGROUP(buf, i0) do { _Pragma("unroll") for (int i_ = 0; i_ < 8; ++i_) { int ah_ = 0, al_ = 0; \
        _Pragma("unroll") for (int c_ = 0; c_ < 4; ++c_) { ah_ = __builtin_amdgcn_sdot8((int)buf[i_][c_], (int)xh[c_], ah_, false); al_ = __builtin_amdgcn_sdot8((int)buf[i_][c_], (int)xl[c_], al_, false); } \
        int p_ = 16 * ah_ + al_; p_ += __builtin_amdgcn_ds_bpermute((lane ^ 1) << 2, p_); p_ += __builtin_amdgcn_ds_bpermute((lane ^ 2) << 2, p_); p_ += __builtin_amdgcn_ds_bpermute((lane ^ 4) << 2, p_); \
        if (m == (((i0) + i_) >> 1)) { if (((i0) + i_) & 1) keep1 = p_; else keep0 = p_; } } } while (0)
#define PI_LOADROWS16(buf, tab, ids) do { _Pragma("unroll") for (int i_ = 0; i_ < 16; ++i_) buf[i_] = __builtin_amdgcn_raw_buffer_load_b128(tab, ids[i_] * 1024 + (int)soff, 0, 0); } while (0)
#define PI_LOADX(xh_, xl_, t) do { xh_ = *(const GAS v4u*)((const char*)XQH + (size_t)(t) * 1024 + soff); xl_ = *(const GAS v4u*)((const char*)XQL + (size_t)(t) * 1024 + soff); } while (0)
#define PI_COMPUTE16(buf, xh_, xl_, t) do { int keep0 = 0, keep1 = 0; \
        _Pragma("unroll") for (int i_ = 0; i_ < 16; ++i_) { int ah_ = 0, al_ = 0; \
            _Pragma("unroll") for (int c_ = 0; c_ < 4; ++c_) { ah_ = __builtin_amdgcn_sdot8((int)buf[i_][c_], (int)xh_[c_], ah_, false); al_ = __builtin_amdgcn_sdot8((int)buf[i_][c_], (int)xl_[c_], al_, false); } \
            int p_ = 16 * ah_ + al_; p_ += __builtin_amdgcn_update_dpp(0, p_, 0xB1, 0xf, 0xf, true); p_ += __builtin_amdgcn_update_dpp(0, p_, 0x4E, 0xf, 0xf, true); p_ += __builtin_amdgcn_update_dpp(0, p_, 0x141, 0xf, 0xf, true);   \
            if (m == (i_ >> 1)) { if (i_ & 1) keep1 = p_; else keep0 = p_; } } \
        if ((t) < T) *(GAS v2u*)(PARTI + ((size_t)s * T + (t)) * 128 + 2 * lane) = (v2u){(unsigned)keep0, (unsigned)keep1}; } while (0)
__device__ __forceinline__ void peer_u_phase_i4(const unsigned* XQH, const unsigned* XQL, const unsigned char* PU, const int* PIDX, int* PARTI, int bid, int G, int wave, int lane) {
    const int s = bid & 7, nr = (G - s + 7) >> 3, q = (bid >> 3) * NWAVES + wave, stride = nr * NWAVES, g = lane >> 3, m = lane & 7;
    const unsigned soff = 128u * (unsigned)s + 16u * (unsigned)m;
    if (q >= T) return;
    const __amdgpu_buffer_rsrc_t PUr = __builtin_amdgcn_make_buffer_rsrc((void*)PU, 0, PEER_N * 1024, 0x00020000);
#define PI_CL(t) ((t) < T ? (t) : T - 1)
    int I1[16], I2[16]; v4u xh0, xl0, xh1, xl1, xh2, xl2, RA[16], RB[16];
    PI_LOADIDS(I1, q); PI_LOADX(xh0, xl0, q);
    PI_LOADROWS16(RA, PUr, I1);
    PI_LOADIDS(I1, PI_CL(q + stride)); PI_LOADX(xh1, xl1, PI_CL(q + stride));
    for (int t = q; t < T; t += 2 * stride) {
        PI_LOADROWS16(RB, PUr, I1);
        PI_LOADIDS(I2, PI_CL(t + 2 * stride)); PI_LOADX(xh2, xl2, PI_CL(t + 2 * stride));
        PI_COMPUTE16(RA, xh0, xl0, t);
        PI_LOADROWS16(RA, PUr, I2);
        PI_LOADIDS(I1, PI_CL(t + 3 * stride)); PI_LOADX(xh0, xl0, PI_CL(t + 3 * stride));
        PI_COMPUTE16(RB, xh1, xl1, t + stride);
        xh1 = xh0; xl1 = xl0; xh0 = xh2; xl0 = xl2;
    }
#undef PI_CL
}

typedef short s16x4 __attribute__((ext_vector_type(4)));
typedef __attribute__((address_space(3))) const char* lds_cptr;
__device__ __forceinline__ s16x4 vtr(lds_cptr p) { return __builtin_bit_cast(s16x4, __builtin_amdgcn_ds_read_tr16_b64_v4i16((__attribute__((address_space(3))) s16x4*)p)); }
__device__ __forceinline__ unsigned cvtpk(float lo, float hi) { unsigned r; asm("v_cvt_pk_bf16_f32 %0, %1, %2" : "=v"(r) : "v"(lo), "v"(hi)); return r; }
constexpr int AT_K0 = 0, AT_V0 = 16384, AT_TAB = 32768;
constexpr float LOG2E = 1.4426950408889634f;
template <int TYPE>
__device__ __forceinline__ void attn_unit(LAS unsigned char* lds, const bf16* QKV, bf16* ATT, int b, int head, int qb, const float* tabsrc, float Cl2, float sinkl2, int tid) {
    const int lane = tid & 63, w = __builtin_amdgcn_readfirstlane(tid >> 6), hh = lane >> 5, l31 = lane & 31;
    int qcol, kcol, vcol, ocol;
    if (TYPE == 0) { qcol = QA + head * 64; kcol = KA + (head / 3) * 64; vcol = VA + (head / 3) * 64; ocol = OA + head * 64; }
    else if (TYPE == 1) { qcol = QB + head * 64; kcol = KB + head * 64; vcol = VB + head * 64; ocol = OB + head * 64; }
    else { qcol = QC + head * 64; kcol = KC + (head / 3) * 64; vcol = VC + (head / 3) * 64; ocol = OC + head * 64; }
    const int q0 = 256 * qb + 32 * w, qpos = q0 + l31;
    int t_begin, t_end;
    if (TYPE == 0) { t_begin = 4 * qb - 2; if (t_begin < 0) t_begin = 0; t_end = 4 * qb + 6; if (t_end > 32) t_end = 32; }
    else if (TYPE == 1) { int a = 4 * qb - 4; a = a < 0 ? 0 : (a > 24 ? 24 : a); int e = 4 * qb - 1; e = e < 0 ? 0 : (e > 24 ? 24 : e); t_begin = a; t_end = e + 8; }
    else { t_begin = 0; t_end = 32; }
    LAS float* tab = (LAS float*)(lds + AT_TAB);
    if (TYPE == 0) { for (int i = tid; i < 1024; i += NTHREADS) { const int rel = i - 448; tab[i] = (rel >= -128 && rel <= 128) ? tabsrc[head * 257 + rel + 128] * LOG2E - Cl2 : -1e30f; } }
    if (TYPE == 1) { for (int i = tid; i < 15 * 31; i += NTHREADS) tab[i] = tabsrc[head * 465 + i] * LOG2E - Cl2; }
    bf16x8 qf[4];
    {   const bf16* qp = QKV + ((size_t)b * SEQ + qpos) * DIN + qcol + 8 * hh;
#pragma unroll
        for (int s = 0; s < 4; ++s) qf[s] = *(const GAS bf16x8*)(qp + 16 * s); }
    const int srow = tid >> 3, sch = tid & 7;
    const bf16* kg = QKV + ((size_t)b * SEQ + srow) * DIN + kcol + sch * 8;
    const bf16* vg = QKV + ((size_t)b * SEQ + srow) * DIN + vcol + sch * 8;
    const int kst = srow * 128 + ((sch ^ ((srow >> 1) & 7)) * 16);
    const int vst = srow * 128 + (((sch >> 2) ^ ((srow >> 1) & 1)) * 64) + (sch & 3) * 16;
    int kread[4], vread[2];
#pragma unroll
    for (int s = 0; s < 4; ++s) kread[s] = l31 * 128 + (((2 * s + hh) ^ ((lane >> 1) & 7)) * 16);
#pragma unroll
    for (int db = 0; db < 2; ++db) vread[db] = (4 * hh + ((lane >> 2) & 3)) * 128 + ((db ^ ((lane >> 3) & 1)) * 64) + 32 * ((lane >> 4) & 1) + 8 * (lane & 3);
    f32x16 O0, O1;
#pragma unroll
    for (int r = 0; r < 16; ++r) { O0[r] = 0.f; O1[r] = 0.f; }
    float lsum = 0.f;
    const int rw = 4 * qb + (w >> 1), cq = 32 * (w & 1) + l31;
    int r0w = rw - 4; r0w = r0w < 0 ? 0 : (r0w > 24 ? 24 : r0w);
    int c0 = cq - 8; c0 = c0 < 0 ? 0 : (c0 > 48 ? 48 : c0);
    {   const v4u kr = *(const GAS v4u*)(kg + (size_t)t_begin * 64 * DIN), vr = *(const GAS v4u*)(vg + (size_t)t_begin * 64 * DIN);
        *(LAS v4u*)(lds + AT_K0 + kst) = kr; *(LAS v4u*)(lds + AT_V0 + vst) = vr; }
    __syncthreads();
    for (int t = t_begin; t < t_end; ++t) {
        const int cur = (t - t_begin) & 1;
        v4u kr, vr;
        if (t + 1 < t_end) { kr = *(const GAS v4u*)(kg + (size_t)(t + 1) * 64 * DIN); vr = *(const GAS v4u*)(vg + (size_t)(t + 1) * 64 * DIN); }
        bool need = true;
        if (TYPE == 0) need = (64 * t <= q0 + 31 + 128) && (64 * t + 63 >= q0 - 128);
        if (TYPE == 1) need = (t >= r0w) && (t < r0w + 8);
        if (need) {
            const lds_cptr kb_ = (lds_cptr)(lds + AT_K0 + cur * 8192), vb_ = (lds_cptr)(lds + AT_V0 + cur * 8192);
            bf16x8 kf[8];
#pragma unroll
            for (int s = 0; s < 4; ++s) { kf[2 * s] = *(const LAS bf16x8*)(kb_ + kread[s]); kf[2 * s + 1] = *(const LAS bf16x8*)(kb_ + kread[s] + 4096); }
            f32x16 S0, S1;
            if (TYPE == 2) {
#pragma unroll
                for (int r = 0; r < 16; ++r) { S0[r] = -Cl2; S1[r] = -Cl2; }
            } else if (TYPE == 0) {
                const LAS float* tb = tab + (64 * t - qpos + 448 + 4 * hh);
#pragma unroll
                for (int r = 0; r < 16; ++r) { S0[r] = tb[8 * (r >> 2) + (r & 3)]; S1[r] = tb[32 + 8 * (r >> 2) + (r & 3)]; }
            } else {
                const LAS float* tb = tab + ((t - rw + 7) * 31 - cq + 15 + 4 * hh);
                const int kc0 = 4 * hh - c0;
#pragma unroll
                for (int r = 0; r < 16; ++r) { const int ka = 8 * (r >> 2) + (r & 3), kb2 = 32 + ka;
                    S0[r] = ((unsigned)(ka + kc0) < 16u) ? tb[ka] : -1e30f; S1[r] = ((unsigned)(kb2 + kc0) < 16u) ? tb[kb2] : -1e30f; }
            }
            __builtin_amdgcn_sched_barrier(0);
#pragma unroll
            for (int s = 0; s < 4; ++s) { S0 = __builtin_amdgcn_mfma_f32_32x32x16_bf16(kf[2 * s], qf[s], S0, 0, 0, 0); S1 = __builtin_amdgcn_mfma_f32_32x32x16_bf16(kf[2 * s + 1], qf[s], S1, 0, 0, 0); }
            s16x4 vf[4][2][2];
#pragma unroll
            for (int ks = 0; ks < 2; ++ks)
#pragma unroll
                for (int db = 0; db < 2; ++db) { vf[ks][db][0] = vtr(vb_ + vread[db] + (16 * ks) * 128); vf[ks][db][1] = vtr(vb_ + vread[db] + (16 * ks + 8) * 128); }
            __builtin_amdgcn_sched_barrier(0);
#pragma unroll
            for (int r = 0; r < 16; ++r) { S0[r] = __builtin_amdgcn_exp2f(S0[r]); S1[r] = __builtin_amdgcn_exp2f(S1[r]); }
#pragma unroll
            for (int r = 0; r < 16; ++r) lsum += S0[r] + S1[r];
            bf16x8 pb[4];
#pragma unroll
            for (int hf = 0; hf < 2; ++hf) {
                v4u a, c;
#pragma unroll
                for (int j = 0; j < 4; ++j) { a[j] = cvtpk(S0[8 * hf + 2 * j], S0[8 * hf + 2 * j + 1]); c[j] = cvtpk(S1[8 * hf + 2 * j], S1[8 * hf + 2 * j + 1]); }
                pb[hf] = __builtin_bit_cast(bf16x8, a); pb[2 + hf] = __builtin_bit_cast(bf16x8, c);
            }
#pragma unroll
            for (int ks = 2; ks < 4; ++ks)
#pragma unroll
                for (int db = 0; db < 2; ++db) { vf[ks][db][0] = vtr(vb_ + vread[db] + (16 * ks) * 128); vf[ks][db][1] = vtr(vb_ + vread[db] + (16 * ks + 8) * 128); }
            __builtin_amdgcn_sched_barrier(0);
#pragma unroll
            for (int ks = 0; ks < 4; ++ks) {
                const bf16x8 va = __builtin_shufflevector(vf[ks][0][0], vf[ks][0][1], 0, 1, 2, 3, 4, 5, 6, 7), vb2 = __builtin_shufflevector(vf[ks][1][0], vf[ks][1][1], 0, 1, 2, 3, 4, 5, 6, 7);
                O0 = __builtin_amdgcn_mfma_f32_32x32x16_bf16(va, pb[ks], O0, 0, 0, 0); O1 = __builtin_amdgcn_mfma_f32_32x32x16_bf16(vb2, pb[ks], O1, 0, 0, 0);
            }
        }
        __builtin_amdgcn_sched_barrier(0);
        if (t + 1 < t_end) { *(LAS v4u*)(lds + AT_K0 + (cur ^ 1) * 8192 + kst) = kr; *(LAS v4u*)(lds + AT_V0 + (cur ^ 1) * 8192 + vst) = vr; }
        __syncthreads();
    }
    lsum += shx(lsum, 32, lane);
    if (TYPE == 0) lsum += __builtin_amdgcn_exp2f(sinkl2 - Cl2);
    const float inv = 1.f / lsum;
    bf16* op = ATT + ((size_t)b * SEQ + qpos) * DM + ocol + 4 * hh;
#pragma unroll
    for (int g4 = 0; g4 < 4; ++g4) {
        v2u o0, o1; o0.x = cvtpk(O0[4 * g4] * inv, O0[4 * g4 + 1] * inv); o0.y = cvtpk(O0[4 * g4 + 2] * inv, O0[4 * g4 + 3] * inv);
        o1.x = cvtpk(O1[4 * g4] * inv, O1[4 * g4 + 1] * inv); o1.y = cvtpk(O1[4 * g4 + 2] * inv, O1[4 * g4 + 3] * inv);
        *(GAS v2u*)(op + 8 * g4) = o0; *(GAS v2u*)(op + 32 + 8 * g4) = o1;
    }
}


constexpr int MA_K0 = 0, MA_V0 = 32768;
__device__ __forceinline__ void mem_unit(LAS unsigned char* lds, const bf16* QM, const bf16* KVM, bf16* OM, const float* gq, int tb, int head, float Cl2, int tid) {
    const int lane = tid & 63, w = __builtin_amdgcn_readfirstlane(tid >> 6), hh = lane >> 5, l31 = lane & 31;
    const size_t trow = (size_t)tb * 256 + 32 * w + l31; const int b = tb >> 3;
    bf16x8 qf[8];
    {   const bf16* qp = QM + trow * MEMW + head * 128 + 8 * hh;
#pragma unroll
        for (int s = 0; s < 8; ++s) qf[s] = *(const GAS bf16x8*)(qp + 16 * s);
        float ss = 0.f;
#pragma unroll
        for (int s = 0; s < 8; ++s)
#pragma unroll
            for (int j = 0; j < 8; ++j) { const float f = __builtin_bit_cast(float, (unsigned)(unsigned short)qf[s][j] << 16); ss += f * f; }
        ss += shx(ss, 32, lane);
        const float r = 0.12751743074602468f / sqrtf(ss * (1.f / 128.f) + EPS);
#pragma unroll
        for (int s = 0; s < 8; ++s) { const f32x4 g0 = *(const GAS f32x4*)(gq + 16 * s + 8 * hh), g1 = *(const GAS f32x4*)(gq + 16 * s + 8 * hh + 4);
            v4u o;
#pragma unroll
            for (int j = 0; j < 4; ++j) { const float f0 = __builtin_bit_cast(float, (unsigned)(unsigned short)qf[s][2 * j] << 16), f1 = __builtin_bit_cast(float, (unsigned)(unsigned short)qf[s][2 * j + 1] << 16);
                const float ga = (2 * j < 4) ? g0[2 * j] : g1[2 * j - 4], gb2 = (2 * j + 1 < 4) ? g0[2 * j + 1] : g1[2 * j + 1 - 4];
                o[j] = cvtpk(f0 * r * ga, f1 * r * gb2); }
            qf[s] = __builtin_bit_cast(bf16x8, o); }
    }
    const int srow = tid >> 3, sch = tid & 7;
    const bf16* kg = KVM + ((size_t)b * NMEM + srow) * 1024 + head * 128 + sch * 8;
    const bf16* vg = kg + 512;
    const int kst0 = srow * 256 + ((sch ^ (srow & 15)) * 16), kst1 = srow * 256 + (((sch + 8) ^ (srow & 15)) * 16);
    const int vst0 = srow * 256 + ((((sch) >> 2) ^ (srow & 3)) * 64) + (sch & 3) * 16, vst1 = srow * 256 + ((((sch + 8) >> 2) ^ (srow & 3)) * 64) + (sch & 3) * 16;
    int kread[8], vread[4];
#pragma unroll
    for (int s = 0; s < 8; ++s) kread[s] = l31 * 256 + (((2 * s + hh) ^ (l31 & 15)) * 16);
#pragma unroll
    for (int db = 0; db < 4; ++db) vread[db] = (4 * hh + ((lane >> 2) & 3)) * 256 + ((db ^ ((lane >> 2) & 3)) * 64) + 32 * ((lane >> 4) & 1) + 8 * (lane & 3);
    f32x16 O[4];
#pragma unroll
    for (int db = 0; db < 4; ++db)
#pragma unroll
        for (int r = 0; r < 16; ++r) O[db][r] = 0.f;
    float lsum = 0.f;
    {   const v4u k0 = *(const GAS v4u*)kg, k1 = *(const GAS v4u*)(kg + 64), v0 = *(const GAS v4u*)vg, v1 = *(const GAS v4u*)(vg + 64);
        *(LAS v4u*)(lds + MA_K0 + kst0) = k0; *(LAS v4u*)(lds + MA_K0 + kst1) = k1; *(LAS v4u*)(lds + MA_V0 + vst0) = v0; *(LAS v4u*)(lds + MA_V0 + vst1) = v1; }
    __syncthreads();
#pragma unroll 1
    for (int t = 0; t < 4; ++t) {
        const int cur = t & 1;
        v4u k0, k1, v0, v1;
        if (t + 1 < 4) { const bf16* kn = kg + (size_t)(t + 1) * 64 * 1024; k0 = *(const GAS v4u*)kn; k1 = *(const GAS v4u*)(kn + 64); v0 = *(const GAS v4u*)(kn + 512); v1 = *(const GAS v4u*)(kn + 576); }
        const lds_cptr kb_ = (lds_cptr)(lds + MA_K0 + cur * 16384), vb_ = (lds_cptr)(lds + MA_V0 + cur * 16384);
        f32x16 S0, S1;
#pragma unroll
        for (int r = 0; r < 16; ++r) { S0[r] = -Cl2; S1[r] = -Cl2; }
#pragma unroll
        for (int s = 0; s < 8; ++s) { const bf16x8 a0 = *(const LAS bf16x8*)(kb_ + kread[s]), a1 = *(const LAS bf16x8*)(kb_ + kread[s] + 8192);
            S0 = __builtin_amdgcn_mfma_f32_32x32x16_bf16(a0, qf[s], S0, 0, 0, 0); S1 = __builtin_amdgcn_mfma_f32_32x32x16_bf16(a1, qf[s], S1, 0, 0, 0); }
#pragma unroll
        for (int r = 0; r < 16; ++r) { S0[r] = __builtin_amdgcn_exp2f(S0[r]); S1[r] = __builtin_amdgcn_exp2f(S1[r]); lsum += S0[r] + S1[r]; }
        bf16x8 pb[4];
#pragma unroll
        for (int hf = 0; hf < 2; ++hf) {
            v4u a, c;
#pragma unroll
            for (int j = 0; j < 4; ++j) { a[j] = cvtpk(S0[8 * hf + 2 * j], S0[8 * hf + 2 * j + 1]); c[j] = cvtpk(S1[8 * hf + 2 * j], S1[8 * hf + 2 * j + 1]); }
            pb[hf] = __builtin_bit_cast(bf16x8, a); pb[2 + hf] = __builtin_bit_cast(bf16x8, c);
        }
#pragma unroll
        for (int ks = 0; ks < 4; ++ks)
#pragma unroll
            for (int db = 0; db < 4; ++db) {
                const s16x4 a0 = vtr(vb_ + vread[db] + (16 * ks) * 256), a1 = vtr(vb_ + vread[db] + (16 * ks + 8) * 256);
                const bf16x8 va = __builtin_shufflevector(a0, a1, 0, 1, 2, 3, 4, 5, 6, 7);
                O[db] = __builtin_amdgcn_mfma_f32_32x32x16_bf16(va, pb[ks], O[db], 0, 0, 0);
            }
        if (t + 1 < 4) { LAS unsigned char* kn = lds + MA_K0 + (cur ^ 1) * 16384; LAS unsigned char* vn = lds + MA_V0 + (cur ^ 1) * 16384;
            *(LAS v4u*)(kn + kst0) = k0; *(LAS v4u*)(kn + kst1) = k1; *(LAS v4u*)(vn + vst0) = v0; *(LAS v4u*)(vn + vst1) = v1; }
        __syncthreads();
    }
    lsum += shx(lsum, 32, lane);
    const float inv = 1.f / lsum;
    bf16* op = OM + trow * MEMW + head * 128 + 4 * hh;
#pragma unroll
    for (int db = 0; db < 4; ++db)
#pragma unroll
        for (int g4 = 0; g4 < 4; ++g4) { v2u o; o.x = cvtpk(O[db][4 * g4] * inv, O[db][4 * g4 + 1] * inv); o.y = cvtpk(O[db][4 * g4 + 2] * inv, O[db][4 * g4 + 3] * inv); *(GAS v2u*)(op + 32 * db + 8 * g4) = o; }
}

__device__ __forceinline__ float wave_max(float v, int lane) {
#pragma unroll
    for (int o = 1; o < 64; o <<= 1) v = fmaxf(v, shx(v, o, lane));
    return v;
}
struct Args { const float* in[23]; float* out; unsigned char* ws; int ph_lo, ph_hi, use_bar, pad; };
#ifndef MK_OFF
#define MK_OFF 0u
#endif
#ifndef REP_ATT
#define REP_ATT 1
#endif
#ifndef REP_P0
#define REP_P0 1
#endif
#ifndef REP_GEMM
#define REP_GEMM 1
#endif
#ifndef REP_NORM
#define REP_NORM 1
#endif
#ifndef REP_SEL
#define REP_SEL 1
#endif
#ifndef REP_MEM
#define REP_MEM 1
#endif
#define PHON(k) (!((MK_OFF >> (k)) & 1u))
constexpr int PH_PER_LAYER = 11, PH_BASE = 3, N_PHASES = PH_BASE + DEPTH * PH_PER_LAYER;
constexpr int PTAB_OFF = LDSCTL_OFF + 1024;

__global__ void __launch_bounds__(NTHREADS, 2) mega(Args a) {
    extern __shared__ __attribute__((aligned(16))) unsigned char lds_raw[];
    LAS unsigned char* lds = (LAS unsigned char*)lds_raw;
    {   const int tid0 = threadIdx.x;
        for (int u = tid0; u < (LDS_BYTES - LDSCTL_OFF) / 4; u += NTHREADS) ((LAS unsigned*)(lds + LDSCTL_OFF))[u] = 0u;
        __syncthreads();
        if (tid0 < 23) ((LAS unsigned long long*)(lds + PTAB_OFF))[tid0] = (unsigned long long)a.in[tid0];
        if (tid0 == 23) ((LAS unsigned long long*)(lds + PTAB_OFF))[23] = (unsigned long long)a.out;
        if (tid0 == 24) ((LAS unsigned long long*)(lds + PTAB_OFF))[24] = (unsigned long long)a.ws;
        __syncthreads();
    }
    volatile LAS unsigned* MISC = (volatile LAS unsigned*)(lds + MISC_OFF);
    const int G = gridDim.x, bid = blockIdx.x, NGW = G * NWAVES;
    const int use_bar = a.use_bar;
    XcdBarrier bar; bar.bar = (unsigned*)(a.ws + WS_CTL) + CW_BAR; bar.x = 0; bar.st = MISC + 8;
    if (use_bar) bar = xcd_barrier_post((unsigned*)(a.ws + WS_CTL) + CW_BAR, MISC + 8);
    const int lo = a.ph_lo, hi = a.ph_hi;
#define IN(k) (lo <= (k) && (k) < hi)
#define SEAM(k) do { if (use_bar && IN(k) && IN((k) + 1)) xcd_barrier(bar); } while (0)
#define PHL() int tid_ = threadIdx.x; asm volatile("" : "+v"(tid_)); const int lane_ = tid_ & 63, wave_ = __builtin_amdgcn_readfirstlane(tid_ >> 6), gw_ = bid * NWAVES + wave_; (void)lane_; (void)gw_; \
              int pz_ = 0; asm volatile("" : "+s"(pz_))
#define PTR(i) ((const float*)ldptr(lds, (i) + pz_))
#define WSP() ((unsigned char*)ldptr(lds, 24 + pz_))
#define OUTP() ((float*)ldptr(lds, 23 + pz_))

    if (IN(0) && PHON(0)) for (int rep_ = 0; rep_ < REP_P0; ++rep_) {
        PHL(); unsigned char* ws = WSP();
        LAS float* scr = (LAS float*)(lds + RING_OFF + wave_ * 16384);
        constexpr int I_IN = 32 * 128, I_OUT = 32 * 64, I_MQ = 32 * 16, I_MKV = 32 * 32, I_MO = 8 * 64, I_PQ = 32 * 64, I_L = I_IN + I_OUT + I_MQ + I_MKV + I_MO + I_PQ;
        for (int it = gw_; it < DEPTH * I_L; it += NGW) {
            const int l = it / I_L; int r = it % I_L;
            if (r < I_IN) { transpose_item<true>(PTR(4) + (size_t)l * DM * DIN, DM, DIN, (bf16*)(ws + WS_WIN) + (size_t)l * DIN * DM, scr, r, lane_, PTR(3) + (size_t)l * DM); continue; } r -= I_IN;
            if (r < I_OUT) { transpose_item<false>(PTR(11) + (size_t)l * DM * DM, DM, DM, (bf16*)(ws + WS_WOUT) + (size_t)l * DM * DM, scr, r, lane_); continue; } r -= I_OUT;
            if (r < I_MQ) { transpose_item<false>(PTR(14) + (size_t)l * DM * MEMW, DM, MEMW, (bf16*)(ws + WS_WMQ) + (size_t)l * MEMW * DM, scr, r, lane_, PTR(12) + (size_t)l * DM); continue; } r -= I_MQ;
            if (r < I_MKV) { transpose_item<false>(PTR(15) + (size_t)l * DM * 1024, DM, 1024, (bf16*)(ws + WS_WMKV) + (size_t)l * 1024 * DM, scr, r, lane_); continue; } r -= I_MKV;
            if (r < I_MO) { transpose_item<false>(PTR(17) + (size_t)l * MEMW * DM, MEMW, DM, (bf16*)(ws + WS_WMO) + (size_t)l * DM * MEMW, scr, r, lane_); continue; } r -= I_MO;
            transpose_item<false>(PTR(19) + (size_t)l * DM * DM, DM, DM, (bf16*)(ws + WS_WPQ) + (size_t)l * DM * DM, scr, r, lane_, PTR(18) + (size_t)l * DM);
        }
        const size_t gtid = (size_t)bid * NTHREADS + tid_, nth = (size_t)G * NTHREADS;
        convert_bf16(PTR(20), (bf16*)(ws + WS_PKEYS), (size_t)DEPTH * 8 * 2 * 128 * 128, gtid, nth);
        convert_int4_plain(PTR(21), ws + WS_PU, DEPTH * PEER_N, PU_SCALEI, PTR(18), gw_, NGW, lane_);
        convert_fp4_rows(PTR(22), ws + WS_PV, DEPTH * PEER_N, PV_SCALE4, nullptr, gw_, NGW, lane_);
        {   const float* x0 = PTR(0); bf16* XN = (bf16*)(ws + WS_XN); u64_t* rsq = (u64_t*)(ws + WS_ROWSQ);
            for (int m = 2 * gw_; m < T; m += 2 * NGW) prep_rows2(x0 + (size_t)m * DM, XN + (size_t)m * DM, rsq + m, lane_); }
        {   const float* mem = PTR(1); const float* gkv = PTR(13); bf16* MEMN = (bf16*)(ws + WS_MEMN);
            for (int m = gw_; m < BATCH * NMEM; m += NGW)
                rms_row_to_bf16(mem + (size_t)m * DM, gkv, MEMN + (size_t)m * DM, gkv + DM, MEMN + (size_t)(BATCH * NMEM + m) * DM, lane_); }
        float* rope = (float*)(ws + WS_ROPE); float* biasA = (float*)(ws + WS_BIASA);
        if (gtid < 64 * 16) { const int pos = (int)gtid >> 4, i = (int)gtid & 15; const float ang = (float)pos * ROPE_INV[i]; rope[gtid * 2] = cosf(ang); rope[gtid * 2 + 1] = sinf(ang); }
        if (gtid < 12 * 257) { const int h = (int)gtid / 257, rel = (int)gtid % 257 - 128; biasA[gtid] = PTR(2)[t5_bucket(rel) * 12 + h]; }
    }
    SEAM(0);
    if (IN(1) && PHON(1)) {
#pragma unroll 1
        for (int l = 0; l < DEPTH; ++l) {
            PHL(); unsigned char* ws = WSP();
            pg8::Gemm g{(bf16*)(ws + WS_MEMN) + (size_t)l * BATCH * NMEM * DM, (bf16*)(ws + WS_WMKV) + (size_t)l * 1024 * DM, BATCH * NMEM, 1024, DM};
            OffsetOrder S; S.init(BATCH * NMEM, 1024, G, bid, 64 * l);
            pg8::EpiBf16<0> E{(bf16*)(ws + WS_KVM) + (size_t)l * BATCH * NMEM * 1024, 1024, nullptr, 0, 0, 1.f};
            pg8::gemm_phase<pg8::EpiBf16<0>, OffsetOrder, true, true>(lds + RING_OFF, g, S, E, tid_);
            __syncthreads();
        }
    }
    SEAM(1);
    if (IN(2) && PHON(2)) {
        PHL(); unsigned char* ws = WSP(); bf16* KVM = (bf16*)(ws + WS_KVM); const float* gm = PTR(16);
        for (int m = gw_; m < DEPTH * BATCH * NMEM; m += NGW) {
            const int l = m / (BATCH * NMEM);
            GAS v4u* p = (GAS v4u*)(KVM + (size_t)m * 1024 + 8 * lane_);
            const v4u w = *p;
            float f[8] = {bflo(w.x), bfhi(w.x), bflo(w.y), bfhi(w.y), bflo(w.z), bfhi(w.z), bflo(w.w), bfhi(w.w)};
            float ss = 0.f;
#pragma unroll
            for (int i = 0; i < 8; ++i) ss += f[i] * f[i];
            ss += shx(ss, 1, lane_); ss += shx(ss, 2, lane_); ss += shx(ss, 4, lane_); ss += shx(ss, 8, lane_);
            const float r = 1.f / sqrtf(ss * (1.f / 128.f) + EPS);
            const float* gk = gm + (size_t)l * 256 + 128 + 8 * (lane_ & 15);
            v4u o; o.x = pk2(f[0] * r * gk[0], f[1] * r * gk[1]); o.y = pk2(f[2] * r * gk[2], f[3] * r * gk[3]); o.z = pk2(f[4] * r * gk[4], f[5] * r * gk[5]); o.w = pk2(f[6] * r * gk[6], f[7] * r * gk[7]);
            *p = o;
        }
    }
    SEAM(2);

#pragma unroll 1
    for (int l = 0; l < DEPTH; ++l) {
        const int pb = PH_BASE + PH_PER_LAYER * l;
        if (IN(pb + 0) && PHON(3)) for (int rep_ = 0; rep_ < REP_GEMM; ++rep_) { PHL(); unsigned char* ws = WSP();
            pg8::Gemm g{(bf16*)(ws + WS_XN), (bf16*)(ws + WS_WIN) + (size_t)l * DIN * DM, T, DIN, DM}; pg8::StaticOrder S; S.init(T, DIN, G, bid);
            pg8::EpiQKV E{(bf16*)(ws + WS_QKV), PTR(5) + (size_t)l * 128, PTR(7) + (size_t)l * 128, PTR(9) + (size_t)l * 128, (const float*)(ws + WS_ROPE), (const u64_t*)(ws + WS_ROWSQ) + (size_t)(l * 3 + 0) * T};
            pg8::gemm_phase<pg8::EpiQKV, pg8::StaticOrder, true, true>(lds + RING_OFF, g, S, E, tid_);
        }
        SEAM(pb + 0);
        if (IN(pb + 1) && PHON(4)) for (int rep_ = 0; rep_ < REP_ATT; ++rep_) { PHL(); unsigned char* ws = WSP();
            const float* sink = PTR(6) + (size_t)l * 12; const float* rpb = PTR(8) + (size_t)l * 8 * 15 * 31; const float* biasA = (const float*)(ws + WS_BIASA);
            const bf16* QKV = (const bf16*)(ws + WS_QKV); bf16* ATT = (bf16*)(ws + WS_ATT);
            const float* ga = PTR(5) + (size_t)l * 128; const float* gb = PTR(7) + (size_t)l * 128; const float* gc = PTR(9) + (size_t)l * 128;
            const float CaL2 = 8.f * wave_max(fabsf(ga[lane_]), lane_) * wave_max(fabsf(ga[64 + lane_]), lane_) * LOG2E;
            const float CbL2 = 8.f * wave_max(fabsf(gb[lane_]), lane_) * wave_max(fabsf(gb[64 + lane_]), lane_) * LOG2E;
            const float CcL2 = 8.f * wave_max(fabsf(gc[lane_]), lane_) * wave_max(fabsf(gc[64 + lane_]), lane_) * LOG2E;
            const int vc = (G % 8 == 0) ? (bid % 8) * (G / 8) + bid / 8 : bid;
            for (int u = vc; u < BATCH * 12 * 8; u += G) attn_unit<2>(lds, QKV, ATT, u / 96, (u >> 3) % 12, u & 7, nullptr, CcL2, 0.f, tid_);
            for (int u = vc; u < BATCH * 8 * 8; u += G) attn_unit<1>(lds, QKV, ATT, u >> 6, (u >> 3) & 7, u & 7, rpb, CbL2, 0.f, tid_);
            for (int u = vc; u < BATCH * 12 * 8; u += G) { const int head = (u >> 3) % 12; attn_unit<0>(lds, QKV, ATT, u / 96, head, u & 7, biasA, CaL2, sink[head] * LOG2E, tid_); }
        }
        SEAM(pb + 1);
        if (IN(pb + 2) && PHON(5)) { PHL(); unsigned char* ws = WSP(); mixnorm_rows((bf16*)(ws + WS_ATT), PTR(10) + (size_t)l * DM, gw_, NGW, lane_); }
        SEAM(pb + 2);
        if (IN(pb + 3) && PHON(6)) { PHL(); unsigned char* ws = WSP();
            pg8::Gemm g{(bf16*)(ws + WS_ATT), (bf16*)(ws + WS_WOUT) + (size_t)l * DM * DM, T, DM, DM}; pg8::StaticOrder S; S.init(T, DM, G, bid);
            pg8::EpiResid E{(bf16*)(ws + WS_XN), DM, (u64_t*)(ws + WS_ROWSQ) + (size_t)(l * 3 + 1) * T};
            pg8::gemm_phase<pg8::EpiResid, pg8::StaticOrder, true, true>(lds + RING_OFF, g, S, E, tid_);
        }
        SEAM(pb + 3);
        if (IN(pb + 4) && PHON(7)) for (int rep_ = 0; rep_ < REP_GEMM; ++rep_) { PHL(); unsigned char* ws = WSP();
            pg8::Gemm g{(bf16*)(ws + WS_XN), (bf16*)(ws + WS_WMQ) + (size_t)l * MEMW * DM, T, MEMW, DM}; pg8::StaticOrder S; S.init(T, MEMW, G, bid);
            pg8::EpiBf16Row E{(bf16*)(ws + WS_QM), MEMW, (const u64_t*)(ws + WS_ROWSQ) + (size_t)(l * 3 + 1) * T};
            pg8::gemm_phase<pg8::EpiBf16Row, pg8::StaticOrder, true, true>(lds + RING_OFF, g, S, E, tid_);
        }
        SEAM(pb + 4);
        if (IN(pb + 5) && PHON(8)) for (int rep_ = 0; rep_ < REP_MEM; ++rep_) { PHL(); unsigned char* ws = WSP();
            const bf16* kvm = (const bf16*)(ws + WS_KVM) + (size_t)l * BATCH * NMEM * 1024; const float* gq = PTR(16) + (size_t)l * 256;
            const float CmL2 = 11.313708498984761f * wave_max(fmaxf(fabsf(gq[lane_]), fabsf(gq[64 + lane_])), lane_) * wave_max(fmaxf(fabsf(gq[128 + lane_]), fabsf(gq[192 + lane_])), lane_) * LOG2E;
            for (int u = bid; u < (T / 256) * 4; u += G) mem_unit(lds, (const bf16*)(ws + WS_QM), kvm, (bf16*)(ws + WS_OM), gq, u >> 2, u & 3, CmL2, tid_);
        }
        SEAM(pb + 5);
        if (IN(pb + 6) && PHON(9)) { PHL(); unsigned char* ws = WSP();
            pg8::Gemm g{(bf16*)(ws + WS_OM), (bf16*)(ws + WS_WMO) + (size_t)l * DM * MEMW, T, DM, MEMW}; pg8::StaticOrder S; S.init(T, DM, G, bid);
            pg8::EpiResid E{(bf16*)(ws + WS_XN), DM, (u64_t*)(ws + WS_ROWSQ) + (size_t)(l * 3 + 2) * T};
            pg8::gemm_phase<pg8::EpiResid, pg8::StaticOrder, true, true>(lds + RING_OFF, g, S, E, tid_);
        }
        SEAM(pb + 6);
        if (IN(pb + 7) && PHON(10)) for (int rep_ = 0; rep_ < REP_GEMM; ++rep_) { PHL(); unsigned char* ws = WSP();
            pg8::Gemm g{(bf16*)(ws + WS_XN), (bf16*)(ws + WS_WPQ) + (size_t)l * DM * DM, T, DM, DM}; pg8::StaticOrder S; S.init(T, DM, G, bid);
            pg8::EpiBf16Row E{(bf16*)(ws + WS_QP), DM, (const u64_t*)(ws + WS_ROWSQ) + (size_t)(l * 3 + 2) * T};
            pg8::gemm_phase<pg8::EpiBf16Row, pg8::StaticOrder, true, true>(lds + RING_OFF, g, S, E, tid_);
        }
        SEAM(pb + 7);
        if (IN(pb + 8) && PHON(11)) for (int rep_ = 0; rep_ < REP_SEL; ++rep_) { PHL(); unsigned char* ws = WSP();
            const bf16* pk = (const bf16*)(ws + WS_PKEYS) + (size_t)l * 8 * 2 * 128 * 128;
            for (int u = bid; u < (T / 256) * PEER_H; u += G) { peer_select_unit((const bf16*)(ws + WS_QP), pk, (int*)(ws + WS_PIDX), (float*)(ws + WS_PGATE), u >> 3, u & 7, wave_, lane_);
                peer_xquant_unit((const bf16*)(ws + WS_XN), (const u64_t*)(ws + WS_ROWSQ) + (size_t)(l * 3 + 2) * T, (unsigned*)(ws + WS_XQH), (unsigned*)(ws + WS_XQL), u >> 3, u & 7, tid_); }
        }
        SEAM(pb + 8);
        if (IN(pb + 9) && PHON(12)) { PHL(); unsigned char* ws = WSP();
            peer_u_phase_i4((const unsigned*)(ws + WS_XQH), (const unsigned*)(ws + WS_XQL), ws + WS_PU + (size_t)l * PEER_N * 1024, (const int*)(ws + WS_PIDX), (int*)(ws + WS_PARTI), bid, G, wave_, lane_); }
        SEAM(pb + 9);
        if (IN(pb + 10) && PHON(13)) { PHL(); unsigned char* ws = WSP();
            peer_v_pass((bf16*)(ws + WS_XN), ws + WS_PV + (size_t)l * PEER_N * 1024, (const int*)(ws + WS_PIDX), (const float*)(ws + WS_PGATE), (const int*)(ws + WS_PARTI), (l + 1 == DEPTH) ? OUTP() : (float*)nullptr,
                        (l + 1 < DEPTH) ? (u64_t*)(ws + WS_ROWSQ) + (size_t)((l + 1) * 3 + 0) * T : (u64_t*)nullptr, (LAS float*)(lds + RING_OFF + wave_ * 1024), gw_, NGW, lane_); }
        SEAM(pb + 10);
    }
#undef IN
#undef SEAM
}

#ifndef MK_MULTI_LAUNCH
#define MK_MULTI_LAUNCH 0
#endif
extern "C" void kernel_launch(void* const* d_in, const int* in_sizes, int n_in, void* d_out, int out_size, void* d_ws, size_t ws_size, hipStream_t stream) {
    static int grid = 0;
    if (grid == 0) {
        if (n_in != 23 || out_size != T * DM || ws_size < WS_END) { fprintf(stderr, "kernel_launch: unexpected shapes (n_in %d, out %d, ws %zu)\n", n_in, out_size, ws_size); grid = -1; return; }
        int dev = 0, cus = 0, per_cu = 0;
        if (hipGetDevice(&dev) != hipSuccess || hipDeviceGetAttribute(&cus, hipDeviceAttributeMultiprocessorCount, dev) != hipSuccess) { grid = -1; return; }
        if (hipFuncSetAttribute((const void*)mega, hipFuncAttributeMaxDynamicSharedMemorySize, LDS_BYTES) != hipSuccess) { fprintf(stderr, "kernel_launch: hipFuncSetAttribute failed\n"); grid = -1; return; }
        if (hipOccupancyMaxActiveBlocksPerMultiprocessor(&per_cu, (const void*)mega, NTHREADS, LDS_BYTES) != hipSuccess || per_cu < 1) { fprintf(stderr, "kernel_launch: occupancy query says %d\n", per_cu); }
        (void)hipGetLastError();
        grid = cus;
    }
    if (grid < 0) return;
    (void)hipMemsetAsync((char*)d_ws + WS_CTL, 0, CTL_ZERO_BYTES, stream);
    Args a{};
    for (int i = 0; i < 23; ++i) a.in[i] = (const float*)d_in[i];
    a.out = (float*)d_out; a.ws = (unsigned char*)d_ws;
#if MK_MULTI_LAUNCH
    for (int p = 0; p < N_PHASES; ++p) { a.ph_lo = p; a.ph_hi = p + 1; a.use_bar = 0; a.pad = 0; hipLaunchKernelGGL(mega, dim3(grid), dim3(NTHREADS), LDS_BYTES, stream, a); }
#else
    a.ph_lo = 0; a.ph_hi = N_PHASES; a.use_bar = 1; a.pad = 0;
    hipLaunchKernelGGL(mega, dim3(grid), dim3(NTHREADS), LDS_BYTES, stream, a);
#endif
    const hipError_t le = hipPeekAtLastError();
    if (le != hipSuccess) fprintf(stderr, "kernel_launch: launch failed: %s\n", hipGetErrorName(le));
}
```

```cpp
#include <hip/hip_runtime.h>
#include <cstdio>
#include <cstdint>
#include <cmath>
__device__ __forceinline__ float shx(float v, int k, int lane);
typedef unsigned long long u64_t;
__device__ __forceinline__ float rowsq_rs(const u64_t* rowsq, int row) { return 1.0f / sqrtf((float)*(const __attribute__((address_space(1))) u64_t*)(rowsq + row) * (5.9604644775390625e-08f / 2048.0f) + 1e-6f); }
__device__ __forceinline__ u64_t rowsq_fx(float ss) { return (u64_t)(ss * 16777216.0f + 0.5f); }
namespace pg8 {
#define PG8_LAS __attribute__((address_space(3)))
#define PG8_GAS __attribute__((address_space(1)))
typedef unsigned short bf16_t;
typedef short bf16x8 __attribute__((ext_vector_type(8)));
typedef float f32x4 __attribute__((ext_vector_type(4)));
typedef unsigned u32x4 __attribute__((ext_vector_type(4)));
constexpr int BM = 256, BK = 64, HALF = 128, HTB = HALF * BK * 2  , STAGE_BYTES = 8 * HTB, NXCD = 8, WGM = 8;

__host__ __device__ __forceinline__ int lds_byte(int r, int c) { const int st = (r >> 4) * 2 + (c >> 5), rr = r & 15, cc = c & 31, ob = rr * 64 + cc * 2; return st * 1024 + (ob ^ (((ob >> 9) & 1) << 5)); }
__host__ __device__ __forceinline__ void stage_rc(int b, int& R, int& C) { const int st = b / 1024, sb = b % 1024, swz = sb ^ (((sb >> 9) & 1) << 5); R = (st >> 1) * 16 + swz / 64; C = (st & 1) * 32 + (swz % 64) / 2; }
__host__ __device__ __forceinline__ int perm32(int rho) { const int n = rho >> 4, i = rho & 15; return 8 * (i >> 2) + 4 * n + (i & 3); }

struct Unit { int pm, pn; };
struct Gemm { const bf16_t* A; const bf16_t* Bt; int M, N, K; };

struct StaticOrder {
    int nM, nN, nwg, G, c;
    __host__ __device__ void init(int M, int N, int G_, int c_) { nM = M / BM; nN = N / BM; nwg = nM * nN; G = G_; c = c_; }
    __host__ __device__ bool next(int i, Unit& u) const {
        const long L = (long)i * G + c; if (L >= nwg) return false;
        int wgid = (int)L; { const int q = nwg / NXCD, r = nwg % NXCD, xcd = wgid % NXCD, off = wgid / NXCD; wgid = (xcd < r ? xcd * (q + 1) : r * (q + 1) + (xcd - r) * q) + off; }
        const int nig = WGM * nN, gid = wgid / nig, fm = gid * WGM, gsz = (nM - fm) < WGM ? (nM - fm) : WGM;
        u.pm = fm + ((wgid % nig) % gsz); u.pn = (wgid % nig) / gsz; return true;
    }
    __device__ __forceinline__ void a_ready(const Unit&) const {}
    __device__ __forceinline__ void done(const Unit&) const {}
};

__device__ __forceinline__ unsigned cvt_pk_bf16(float lo, float hi) { unsigned r; asm volatile("v_cvt_pk_bf16_f32 %0, %1, %2" : "=v"(r) : "v"(lo), "v"(hi)); return r; }
typedef float f32x2 __attribute__((ext_vector_type(2)));
__device__ __forceinline__ f32x2 gelu_pk(f32x2 v) {
    const f32x2 av = __builtin_elementwise_abs(v), d = av * 0.2316418882f + 1.0f;
    f32x2 t; t.x = __builtin_amdgcn_rcpf(d.x); t.y = __builtin_amdgcn_rcpf(d.y);
    f32x2 q = t * 0.5307027145f + (-0.7265760135f); q = q * t + 0.7107068705f; q = q * t + (-0.142248368f); q = q * t + 0.127414796f; q = q * t;
    const f32x2 s = (v * v) * (-0.72134752044f);
    f32x2 e; e.x = __builtin_amdgcn_exp2f(s.x); e.y = __builtin_amdgcn_exp2f(s.y);
    const f32x2 m = v * (q * e), r = v - m;
    f32x2 o; o.x = v.x < 0.f ? m.x : r.x; o.y = v.y < 0.f ? m.y : r.y; return o;
}

template <int ACT  > struct EpiBf16 {
    static constexpr bool PERM = true, AFTER_DRAIN = false; static_assert(ACT == 0 || ACT == 1, "EpiBf16: ACT is 0 (none) or 1 (gelu_pk)");
    bf16_t* O; int ldc; const float* bias; int split_cols; size_t split_stride; float scale0;
    __device__ __forceinline__ void operator()(const f32x4 (&acc)[2][2][4][2], const Unit& u, int wr, int wc, int fr, int fq) const {
        const int row0 = u.pm * BM + wr * 64 + fr; int colt = u.pn * BM; bf16_t* base = O;
        float sc = 1.f; if (split_cols) { const int t = colt / split_cols; base += (size_t)t * split_stride; colt -= t * split_cols; if (t == 0) sc = scale0; }
        const int col0 = colt + wc * 32 + 8 * fq, bcol0 = u.pn * BM + wc * 32 + 8 * fq;
        f32x4 bv[2][2];
#pragma unroll
        for (int bj = 0; bj < 2; ++bj)
#pragma unroll
            for (int n = 0; n < 2; ++n) bv[bj][n] = bias ? *(const PG8_GAS f32x4*)(bias + bcol0 + bj * HALF + 4 * n) : (f32x4){0.f, 0.f, 0.f, 0.f};
#pragma unroll
        for (int ai = 0; ai < 2; ++ai)
#pragma unroll
            for (int m = 0; m < 4; ++m) { bf16_t* rowp = base + (size_t)(row0 + ai * HALF + m * 16) * ldc + col0;
#pragma unroll
                for (int bj = 0; bj < 2; ++bj) { f32x4 v0 = acc[ai][bj][m][0] + bv[bj][0], v1 = acc[ai][bj][m][1] + bv[bj][1];
                    if (ACT == 1) { f32x2 a = gelu_pk((f32x2){v0[0], v0[1]}), b = gelu_pk((f32x2){v0[2], v0[3]}), c = gelu_pk((f32x2){v1[0], v1[1]}), d = gelu_pk((f32x2){v1[2], v1[3]});
                        v0 = (f32x4){a.x, a.y, b.x, b.y}; v1 = (f32x4){c.x, c.y, d.x, d.y}; }
                    v0 = v0 * sc; v1 = v1 * sc; u32x4 w; w.x = cvt_pk_bf16(v0[0], v0[1]); w.y = cvt_pk_bf16(v0[2], v0[3]); w.z = cvt_pk_bf16(v1[0], v1[1]); w.w = cvt_pk_bf16(v1[2], v1[3]);
                    *(PG8_GAS u32x4*)(rowp + bj * HALF) = w; } }
    }
};

typedef unsigned u32x2 __attribute__((ext_vector_type(2)));
struct EpiResid {
    static constexpr bool PERM = false, AFTER_DRAIN = false;
    bf16_t* s; int ldc; u64_t* rowsq;
    __device__ __forceinline__ void operator()(const f32x4 (&acc)[2][2][4][2], const Unit& u, int wr, int wc, int fr, int fq) const {
        const int col0 = u.pn * BM + wc * 32 + 4 * fq;
#pragma unroll
        for (int ai = 0; ai < 2; ++ai)
#pragma unroll
            for (int m = 0; m < 4; ++m) { const int row = u.pm * BM + ai * HALF + wr * 64 + m * 16 + fr; bf16_t* sp = s + (size_t)row * ldc + col0; float ss = 0.f;
                u32x2 in[2][2];
#pragma unroll
                for (int bj = 0; bj < 2; ++bj)
#pragma unroll
                    for (int n = 0; n < 2; ++n) in[bj][n] = *(const PG8_GAS u32x2*)(sp + bj * HALF + n * 16);
#pragma unroll
                for (int bj = 0; bj < 2; ++bj)
#pragma unroll
                    for (int n = 0; n < 2; ++n) { const u32x2 w0 = in[bj][n];
                        const f32x4 bs = (f32x4){__builtin_bit_cast(float, w0.x << 16), __builtin_bit_cast(float, w0.x & 0xffff0000u), __builtin_bit_cast(float, w0.y << 16), __builtin_bit_cast(float, w0.y & 0xffff0000u)};
                        const f32x4 o = bs + acc[ai][bj][m][n]; ss += (o[0] * o[0] + o[1] * o[1]) + (o[2] * o[2] + o[3] * o[3]);
                        u32x2 w; w.x = cvt_pk_bf16(o[0], o[1]); w.y = cvt_pk_bf16(o[2], o[3]); *(PG8_GAS u32x2*)(sp + bj * HALF + n * 16) = w; }
                ss += shx(ss, 16, fr + 16 * fq); ss += shx(ss, 32, fr + 16 * fq);
                if (fq == 0) (void)__hip_atomic_fetch_add((PG8_GAS u64_t*)(rowsq + row), rowsq_fx(ss), __ATOMIC_RELAXED, __HIP_MEMORY_SCOPE_AGENT); }
    }
};
struct EpiBf16Row {
    static constexpr bool PERM = true, AFTER_DRAIN = false;
    bf16_t* O; int ldc; const u64_t* rowsq;
    __device__ __forceinline__ void operator()(const f32x4 (&acc)[2][2][4][2], const Unit& u, int wr, int wc, int fr, int fq) const {
        const int row0 = u.pm * BM + wr * 64 + fr, col0 = u.pn * BM + wc * 32 + 8 * fq;
#pragma unroll
        for (int ai = 0; ai < 2; ++ai)
#pragma unroll
            for (int m = 0; m < 4; ++m) { const int row = row0 + ai * HALF + m * 16; const float rs = rowsq_rs(rowsq, row); bf16_t* rowp = O + (size_t)row * ldc + col0;
#pragma unroll
                for (int bj = 0; bj < 2; ++bj) { const f32x4 v0 = acc[ai][bj][m][0] * rs, v1 = acc[ai][bj][m][1] * rs; u32x4 w; w.x = cvt_pk_bf16(v0[0], v0[1]); w.y = cvt_pk_bf16(v0[2], v0[3]); w.z = cvt_pk_bf16(v1[0], v1[1]); w.w = cvt_pk_bf16(v1[2], v1[3]);
                    *(PG8_GAS u32x4*)(rowp + bj * HALF) = w; } }
    }
};
struct EpiQKV {
    static constexpr bool PERM = false, AFTER_DRAIN = false;
    bf16_t* O; const float* ga; const float* gb; const float* gc; const float* rope; const u64_t* rowsq;
    __device__ __forceinline__ void operator()(const f32x4 (&acc)[2][2][4][2], const Unit& u, int wr, int wc, int fr, int fq) const {
        const int hg = u.pn * 4 + wc;
        const float* g = nullptr; bool isq = false, dorope = false;
        if (hg < 12) { g = ga; isq = true; } else if (hg < 16) { g = ga + 64; } else if (hg < 20) { }
        else if (hg < 28) { g = gb; isq = true; } else if (hg < 36) { g = gb + 64; } else if (hg < 44) { }
        else if (hg < 56) { g = gc; isq = true; dorope = true; } else if (hg < 60) { g = gc + 64; dorope = true; }
        const float qs = isq ? 0.18033688011112042f : 1.0f;
#pragma unroll
        for (int ai = 0; ai < 2; ++ai)
#pragma unroll
            for (int m = 0; m < 4; ++m) {
                const int row = u.pm * BM + ai * HALF + wr * 64 + m * 16 + fr;
                f32x4 v[2][2];
                const float rsx = rowsq_rs(rowsq, row);
#pragma unroll
                for (int bj = 0; bj < 2; ++bj)
#pragma unroll
                    for (int n = 0; n < 2; ++n) v[bj][n] = acc[ai][bj][m][n] * rsx;
                if (g) {
                    float ss = 0.f;
#pragma unroll
                    for (int bj = 0; bj < 2; ++bj)
#pragma unroll
                        for (int n = 0; n < 2; ++n) { const f32x4 x = v[bj][n]; ss += (x[0] * x[0] + x[1] * x[1]) + (x[2] * x[2] + x[3] * x[3]); }
                    ss += shx(ss, 16, fr + 16 * fq); ss += shx(ss, 32, fr + 16 * fq);
                    const float r = qs / sqrtf(ss * (1.0f / 64.0f) + 1e-6f);
#pragma unroll
                    for (int bj = 0; bj < 2; ++bj)
#pragma unroll
                        for (int n = 0; n < 2; ++n) v[bj][n] = v[bj][n] * *(const PG8_GAS f32x4*)(g + 32 * bj + 16 * n + 4 * fq) * r;
                }
                if (dorope) {
                    const int t = row & 2047, pr = t >> 6, pc = t & 63;
#pragma unroll
                    for (int bj = 0; bj < 2; ++bj) {
                        const int pos = bj ? pc : pr;
                        const float* rp = rope + (size_t)(pos * 16 + 4 * fq) * 2;
                        const f32x4 c01 = *(const PG8_GAS f32x4*)rp, c23 = *(const PG8_GAS f32x4*)(rp + 4);
                        const f32x4 cs = (f32x4){c01[0], c01[2], c23[0], c23[2]}, sn = (f32x4){c01[1], c01[3], c23[1], c23[3]};
                        const f32x4 x1 = v[bj][0], x2 = v[bj][1];
                        v[bj][0] = x1 * cs - x2 * sn; v[bj][1] = x1 * sn + x2 * cs;
                    }
                }
                bf16_t* rowp = O + (size_t)row * 4096 + hg * 64 + 4 * fq;
#pragma unroll
                for (int bj = 0; bj < 2; ++bj)
#pragma unroll
                    for (int n = 0; n < 2; ++n) { u32x2 w; w.x = cvt_pk_bf16(v[bj][n][0], v[bj][n][1]); w.y = cvt_pk_bf16(v[bj][n][2], v[bj][n][3]); *(PG8_GAS u32x2*)(rowp + 32 * bj + 16 * n) = w; }
                asm volatile("" ::: "memory");
            }
    }
};
template <class Epi, class Sched, bool ALIGN_EPI = false, bool SP2 = false>
__device__ __forceinline__ void gemm_phase(PG8_LAS unsigned char* lds, const Gemm g, const Sched& S, const Epi& E, const int tid) {
    const int wid = __builtin_amdgcn_readfirstlane(tid >> 6), lane = tid & 63, wr = wid >> 2, wc = wid & 3, fr = lane & 15, fq = lane >> 4;
    const int K = g.K, nt = K / BK;
    unsigned voffA[2], voffB[2];
#pragma unroll
    for (int i = 0; i < 2; ++i) { int R, C; stage_rc(tid * 16 + i * 8192, R, C); const int Rb = Epi::PERM ? ((R & ~31) + perm32(R & 31)) : R;
        voffA[i] = (unsigned)(R * K + C) * 2u; voffB[i] = (unsigned)(Rb * K + C) * 2u; }
    const size_t kstep = (size_t)(BK * 2);
    const size_t hstep = (size_t)HALF * K * 2;
    const size_t tstep = 2 * hstep;
    const unsigned ldsw = (unsigned)wid * 1024u;
    const int aoff = lds_byte(wr * 64 + fr, fq * 8), boff = lds_byte(wc * 32 + fr, fq * 8);
#define PG8_SA(b, h) (((b) * 2 + (h)) * HTB)
#define PG8_SB(b, h) ((4 + (b) * 2 + (h)) * HTB)
#define PG8_STAGE(bufoff, gbase, voff) do { _Pragma("unroll") for (int _i = 0; _i < 2; ++_i) \
        __builtin_amdgcn_global_load_lds((const unsigned*)((const char*)(gbase) + (voff)[_i]), (PG8_LAS unsigned*)(lds + (bufoff) + ldsw + _i * 8192), 16, 0, 0); } while (0)
#define PG8_LDA(dst, b, h) do { _Pragma("unroll") for (int m = 0; m < 4; ++m) _Pragma("unroll") for (int k = 0; k < 2; ++k) dst[m][k] = *(const PG8_LAS bf16x8*)(lds + PG8_SA(b, h) + aoff + m * 2048 + k * 1024); } while (0)
#define PG8_LDB(dst, b, h) do { _Pragma("unroll") for (int n = 0; n < 2; ++n) _Pragma("unroll") for (int k = 0; k < 2; ++k) dst[n][k] = *(const PG8_LAS bf16x8*)(lds + PG8_SB(b, h) + boff + n * 2048 + k * 1024); } while (0)
#define PG8_MMA(ai, bj, At, Bt) do { __builtin_amdgcn_s_setprio(1); _Pragma("unroll") for (int m = 0; m < 4; ++m) _Pragma("unroll") for (int n = 0; n < 2; ++n) _Pragma("unroll") for (int k = 0; k < 2; ++k) \
        acc[ai][bj][m][n] = __builtin_amdgcn_mfma_f32_16x16x32_bf16(Bt[n][k], At[m][k], acc[ai][bj][m][n], 0, 0, 0); __builtin_amdgcn_s_setprio(0); } while (0)
#define PG8_WAIT_V(n) asm volatile("s_waitcnt vmcnt(" #n ")" ::: "memory")
#define PG8_WAIT_L(n) asm volatile("s_waitcnt lgkmcnt(" #n ")" ::: "memory")
#define PG8_BAR __builtin_amdgcn_s_barrier()
#define PG8_SCHED __builtin_amdgcn_sched_barrier(0)
    Unit cur, nxt; int ui = 0;
    if (!S.next(0, cur)) return;
    f32x4 acc[2][2][4][2];
#pragma unroll
    for (int a = 0; a < 2; ++a)
#pragma unroll
        for (int b = 0; b < 2; ++b)
#pragma unroll
            for (int m = 0; m < 4; ++m)
#pragma unroll
                for (int n = 0; n < 2; ++n) acc[a][b][m][n] = (f32x4){0.f, 0.f, 0.f, 0.f};
    bf16x8 At[4][2], B0[2][2], B1[2][2];
    const char* cA = (const char*)g.A + (size_t)cur.pm * tstep; const char* cB = (const char*)g.Bt + (size_t)cur.pn * tstep;
    S.a_ready(cur);
    if constexpr (SP2) {
        PG8_STAGE(PG8_SB(0, 0), cB, voffB); PG8_STAGE(PG8_SB(0, 1), cB + hstep, voffB); PG8_STAGE(PG8_SA(0, 0), cA, voffA); PG8_STAGE(PG8_SA(0, 1), cA + hstep, voffA);
        if (wr == 1) PG8_BAR;
        PG8_WAIT_V(2); PG8_BAR;
        PG8_STAGE(PG8_SB(1, 0), cB + kstep, voffB); PG8_STAGE(PG8_SA(1, 0), cA + kstep, voffA); PG8_STAGE(PG8_SB(1, 1), cB + hstep + kstep, voffB);
        PG8_WAIT_V(6); PG8_BAR;
    } else {
        PG8_STAGE(PG8_SB(0, 0), cB, voffB); PG8_STAGE(PG8_SA(0, 0), cA, voffA); PG8_STAGE(PG8_SB(0, 1), cB + hstep, voffB); PG8_STAGE(PG8_SA(0, 1), cA + hstep, voffA);
        if (wr == 1) PG8_BAR;
        PG8_WAIT_V(4); PG8_BAR;
        PG8_STAGE(PG8_SB(1, 0), cB + kstep, voffB); PG8_STAGE(PG8_SA(1, 0), cA + kstep, voffA); PG8_STAGE(PG8_SB(1, 1), cB + hstep + kstep, voffB);
        PG8_WAIT_V(6); PG8_BAR;
    }
    for (;;) {
        const bool has_next = S.next(ui + 1, nxt);
        const char* nA = has_next ? (const char*)g.A + (size_t)nxt.pm * tstep : cA; const char* nB = has_next ? (const char*)g.Bt + (size_t)nxt.pn * tstep : cB;
        for (int t = 0; t < nt; t += 2) {
            const bool last = (t == nt - 2);
            const char* a1 = cA + (size_t)(t + 1) * kstep;
            const char* a2 = last ? nA : cA + (size_t)(t + 2) * kstep; const char* b2 = last ? nB : cB + (size_t)(t + 2) * kstep;
            const char* a3 = a2 + kstep; const char* b3 = b2 + kstep;
            if (last && has_next) S.a_ready(nxt);
            if constexpr (SP2) {
            PG8_LDB(B0, 0, 0); PG8_LDB(B1, 0, 1); PG8_SCHED; PG8_LDA(At, 0, 0); PG8_STAGE(PG8_SA(1, 1), a1 + hstep, voffA);
            PG8_WAIT_V(8); PG8_WAIT_L(0); PG8_BAR; PG8_MMA(0, 0, At, B0); PG8_MMA(0, 1, At, B1); PG8_BAR; PG8_SCHED;
            PG8_LDA(At, 0, 1); PG8_STAGE(PG8_SB(0, 0), b2, voffB); PG8_STAGE(PG8_SB(0, 1), b2 + hstep, voffB); PG8_STAGE(PG8_SA(0, 0), a2, voffA);
            PG8_WAIT_V(8); PG8_WAIT_L(0); PG8_BAR; PG8_MMA(1, 0, At, B0); PG8_MMA(1, 1, At, B1); PG8_BAR; PG8_SCHED;
            PG8_LDB(B0, 1, 0); PG8_LDB(B1, 1, 1); PG8_SCHED; PG8_LDA(At, 1, 0); PG8_STAGE(PG8_SA(0, 1), a2 + hstep, voffA);
            PG8_WAIT_V(8); PG8_WAIT_L(0); PG8_BAR; PG8_MMA(0, 0, At, B0); PG8_MMA(0, 1, At, B1); PG8_BAR; PG8_SCHED;
            PG8_LDA(At, 1, 1); PG8_STAGE(PG8_SB(1, 0), b3, voffB); PG8_STAGE(PG8_SB(1, 1), b3 + hstep, voffB); PG8_STAGE(PG8_SA(1, 0), a3, voffA);
            PG8_WAIT_V(8); PG8_WAIT_L(0); PG8_BAR; PG8_MMA(1, 0, At, B0); PG8_MMA(1, 1, At, B1); PG8_BAR; PG8_SCHED;
            } else {
            PG8_LDB(B0, 0, 0); PG8_SCHED; PG8_LDA(At, 0, 0); PG8_STAGE(PG8_SA(1, 1), a1 + hstep, voffA);
            PG8_WAIT_L(8); PG8_BAR; PG8_WAIT_L(0); PG8_MMA(0, 0, At, B0); PG8_BAR; PG8_SCHED;
            PG8_LDB(B1, 0, 1); PG8_STAGE(PG8_SB(0, 0), b2, voffB);
            PG8_BAR; PG8_WAIT_L(0); PG8_MMA(0, 1, At, B1); PG8_BAR;
            PG8_LDA(At, 0, 1); PG8_STAGE(PG8_SA(0, 0), a2, voffA);
            PG8_BAR; PG8_WAIT_L(0); PG8_MMA(1, 0, At, B0); PG8_BAR; PG8_SCHED;
            PG8_STAGE(PG8_SB(0, 1), b2 + hstep, voffB);
            PG8_WAIT_V(6); PG8_BAR; PG8_MMA(1, 1, At, B1); PG8_BAR;
            PG8_LDB(B0, 1, 0); PG8_SCHED; PG8_LDA(At, 1, 0); PG8_STAGE(PG8_SA(0, 1), a2 + hstep, voffA);
            PG8_WAIT_L(8); PG8_BAR; PG8_WAIT_L(0); PG8_MMA(0, 0, At, B0); PG8_BAR; PG8_SCHED;
            PG8_LDB(B1, 1, 1); PG8_STAGE(PG8_SB(1, 0), b3, voffB);
            PG8_BAR; PG8_WAIT_L(0); PG8_MMA(0, 1, At, B1); PG8_BAR;
            PG8_LDA(At, 1, 1); PG8_STAGE(PG8_SA(1, 0), a3, voffA);
            PG8_BAR; PG8_WAIT_L(0); PG8_MMA(1, 0, At, B0); PG8_BAR; PG8_SCHED;
            PG8_STAGE(PG8_SB(1, 1), b3 + hstep, voffB);
            PG8_WAIT_V(6); PG8_BAR; PG8_MMA(1, 1, At, B1); PG8_BAR;
            }
        }
        if constexpr (ALIGN_EPI) { if (wr == 0) PG8_BAR; }
        if constexpr (!Epi::AFTER_DRAIN) { E(acc, cur, wr, wc, fr, fq); S.done(cur); }
        if (!has_next) break;
#pragma unroll
        for (int a = 0; a < 2; ++a)
#pragma unroll
            for (int b = 0; b < 2; ++b)
#pragma unroll
                for (int m = 0; m < 4; ++m)
#pragma unroll
                    for (int n = 0; n < 2; ++n) acc[a][b][m][n] = (f32x4){0.f, 0.f, 0.f, 0.f};
        cur = nxt; cA = nA; cB = nB; ++ui;
        if constexpr (ALIGN_EPI) { if (wr == 1) PG8_BAR; }
    }
    PG8_WAIT_V(0);
    if constexpr (!ALIGN_EPI) { if (wr == 0) PG8_BAR; }
    PG8_BAR;
    if constexpr (Epi::AFTER_DRAIN) { E.fused(acc, cur, wr, wc, fr, fq, lds, wid, lane); S.done(cur); }
#undef PG8_SA
#undef PG8_SB
#undef PG8_STAGE
#undef PG8_LDA
#undef PG8_LDB
#undef PG8_MMA
#undef PG8_WAIT_V
#undef PG8_WAIT_L
#undef PG8_BAR
#undef PG8_SCHED
}
}

constexpr int BATCH = 16, SEQ = 2048, DM = 2048, T = BATCH * SEQ, DEPTH = 2;
constexpr int NMEM = 256, DIN = 4096, MEMW = 512;
constexpr int PEER_H = 8, PEER_N = 16384;
constexpr int NWAVES = 8, NTHREADS = NWAVES * 64;
constexpr float EPS = 1e-6f;
constexpr int QA = 0, KA = 768, VA = 1024, QB = 1280, KB = 1792, VB = 2304, QC = 2816, KC = 3584, VC = 3840;
constexpr int OA = 0, OB = 768, OC = 1280;

constexpr size_t MiB = 1u << 20;
constexpr size_t WS_CTL = 0, CTL_ZERO_BYTES = 2 * MiB;
constexpr size_t WS_ROWSQ = 256 * 1024;
constexpr size_t WS_ROPE = 83 * MiB, WS_BIASA = 83 * MiB + 16384;
constexpr size_t WS_WIN = 2 * MiB, WS_WOUT = 34 * MiB, WS_WMQ = 50 * MiB, WS_WMKV = 54 * MiB, WS_WMO = 62 * MiB, WS_WPQ = 66 * MiB, WS_PKEYS = 82 * MiB;
constexpr size_t WS_MEMN = 84 * MiB, WS_KVM = 116 * MiB, WS_PU = 132 * MiB, WS_PV = 260 * MiB, WS_XN = 388 * MiB, WS_QKV = 516 * MiB, WS_ATT = 772 * MiB;
constexpr size_t WS_QM = 900 * MiB, WS_OM = 932 * MiB, WS_END = 964 * MiB;
constexpr size_t WS_QP = WS_QKV, WS_PIDX = WS_QKV + 128 * MiB, WS_PGATE = WS_QKV + 144 * MiB, WS_PARTI = WS_QKV + 160 * MiB;
constexpr size_t WS_XQH = 900 * MiB, WS_XQL = 932 * MiB;
constexpr int CW_BAR = 4096;

constexpr int RING_OFF = 0, RING_BYTES = 131072;
constexpr int LDSCTL_OFF = RING_BYTES, MISC_OFF = LDSCTL_OFF + 320;
constexpr int LDS_BYTES = 147456;

#define GAS __attribute__((address_space(1)))
#define LAS __attribute__((address_space(3)))
typedef unsigned short bf16;
typedef unsigned v4u __attribute__((ext_vector_type(4)));
typedef unsigned v2u __attribute__((ext_vector_type(2)));
typedef float f32x4 __attribute__((ext_vector_type(4)));
typedef float f32x16 __attribute__((ext_vector_type(16)));
typedef short bf16x8 __attribute__((ext_vector_type(8)));
typedef GAS unsigned gu32;
#define LDS_WAIT() asm volatile("s_waitcnt lgkmcnt(0)" ::: "memory")
#define VM_WAIT() asm volatile("s_waitcnt vmcnt(0)" ::: "memory")
__device__ __forceinline__ unsigned f2bf(float f) { unsigned u = __builtin_bit_cast(unsigned, f); return (u + 0x7fffu + ((u >> 16) & 1u)) >> 16; }
__device__ __forceinline__ unsigned pk2(float lo, float hi) { return f2bf(lo) | (f2bf(hi) << 16); }
__device__ __forceinline__ float bflo(unsigned w) { return __builtin_bit_cast(float, w << 16); }
__device__ __forceinline__ float bfhi(unsigned w) { return __builtin_bit_cast(float, w & 0xffff0000u); }

__device__ __forceinline__ float shx(float v, int k, int lane) { return __builtin_bit_cast(float, __builtin_amdgcn_ds_bpermute((lane ^ k) << 2, __builtin_bit_cast(int, v))); }
#define XB_TMO      128
#define XB_XCNT(j)  (256  + 64 * (j))
#define XB_XSUB(j)  (1280 + 64 * (j))
#define XB_XGEN(j)  (2304 + 64 * (j))
#define XB_TOP      3328
#define XB_TOPGEN   3392
#define XCD_BAR_WORDS 3456
#define XB_SPIN_CAP (1u << 18)

__device__ __forceinline__ unsigned xb_ld(unsigned* p)              { return __hip_atomic_load(p, __ATOMIC_RELAXED, __HIP_MEMORY_SCOPE_AGENT); }
__device__ __forceinline__ unsigned xb_add(unsigned* p, unsigned v) { return __hip_atomic_fetch_add(p, v, __ATOMIC_RELAXED, __HIP_MEMORY_SCOPE_AGENT); }
__device__ __forceinline__ unsigned xb_xcc_id() { return (unsigned)__builtin_amdgcn_s_getreg((3 << 11) | 20) & 0xFu; }
#define XB_SPIN(cond, bar) do { unsigned _sp = 0; while (cond) { __builtin_amdgcn_s_sleep(1); \
    if ((++_sp & 255u) == 0u) { if (xb_ld(&(bar)[XB_TMO])) break; if (_sp > XB_SPIN_CAP) { atomicAdd(&(bar)[XB_TMO], 1u); break; } } } } while (0)

struct XcdBarrier {
    unsigned* bar; unsigned x;
    volatile LAS unsigned* st;
};

__device__ __forceinline__ XcdBarrier xcd_barrier_post(unsigned* bar, volatile LAS unsigned* st) {
    XcdBarrier b; b.bar = bar; b.x = xb_xcc_id(); b.st = st;
    if (threadIdx.x == 0) (void)xb_add(&bar[XB_XCNT(b.x)], 1u);
    return b;
}
__device__ __forceinline__ void xcd_barrier_complete(unsigned* bar, unsigned x, unsigned& nloc, unsigned& nx) {
    const unsigned G = gridDim.x * gridDim.y * gridDim.z;
    unsigned sum, cnt, mine, sp = 0u;
    for (;;) {
        sum = 0u; cnt = 0u; mine = 0u;
#pragma unroll
        for (unsigned j = 0; j < 16; ++j) { const unsigned c = xb_ld(&bar[XB_XCNT(j)]); sum += c; cnt += (c > 0u) ? 1u : 0u; mine = (j == x) ? c : mine; }
        if (sum == G) break;
        __builtin_amdgcn_s_sleep(1);
        if ((++sp & 255u) == 0u) { if (xb_ld(&bar[XB_TMO])) break; if (sp > XB_SPIN_CAP) { atomicAdd(&bar[XB_TMO], 1u); break; } }
    }
    nloc = mine > 0u ? mine : 1u; nx = cnt > 0u ? cnt : 1u;
}

__device__ __forceinline__ void xcd_barrier(const XcdBarrier& b) {
    asm volatile("s_waitcnt vmcnt(0)" ::: "memory");
    __syncthreads();
    if (threadIdx.x == 0) {
        unsigned* bar = b.bar;
        __builtin_amdgcn_s_waitcnt(0);
        unsigned nloc = b.st[0], nx = b.st[1];
        if (nloc == 0u) { xcd_barrier_complete(bar, b.x, nloc, nx); b.st[0] = nloc; b.st[1] = nx; }
        const unsigned old = xb_add(&bar[XB_XSUB(b.x)], 1u);
        const unsigned gen = old / nloc;
        if (old + 1u == (gen + 1u) * nloc) {
            __builtin_amdgcn_fence(__ATOMIC_RELEASE, "agent");
            asm volatile("s_waitcnt vmcnt(0)" ::: "memory");
            const unsigned og = xb_add(&bar[XB_TOP], 1u);
            const unsigned tg = og / nx;
            if (og + 1u == (tg + 1u) * nx) xb_add(&bar[XB_TOPGEN], 1u);
            else XB_SPIN(xb_ld(&bar[XB_TOPGEN]) == tg, bar);
            __builtin_amdgcn_fence(__ATOMIC_ACQUIRE, "agent");
            xb_add(&bar[XB_XGEN(b.x)], 1u);
            asm volatile("s_waitcnt vmcnt(0)" ::: "memory");
        } else {
            XB_SPIN(xb_ld(&bar[XB_XGEN(b.x)]) == gen, bar);
            __builtin_amdgcn_fence(__ATOMIC_ACQUIRE, "agent");
            asm volatile("s_waitcnt vmcnt(0)" ::: "memory");
        }
    }
    __syncthreads();
}

__device__ __forceinline__ float wave_sum(float v, int lane) {
#pragma unroll
    for (int o = 1; o < 64; o <<= 1) v += shx(v, o, lane);
    return v;
}
__device__ __forceinline__ void* ldptr(LAS unsigned char* lds, int i) {
    const unsigned long long v = ((const LAS unsigned long long*)(lds + LDSCTL_OFF + 1024))[i];
    const unsigned lo = __builtin_amdgcn_readfirstlane((unsigned)v), hi = __builtin_amdgcn_readfirstlane((unsigned)(v >> 32));
    return (void*)(((unsigned long long)hi << 32) | lo);
}
struct OffsetOrder {
    pg8::StaticOrder S;
    __device__ void init(int M, int N, int G, int c, int off) { S.init(M, N, G, (c + G - off % G) % G); }
    __device__ bool next(int i, pg8::Unit& u) const { return S.next(i, u); }
    __device__ __forceinline__ void a_ready(const pg8::Unit&) const {}
    __device__ __forceinline__ void done(const pg8::Unit&) const {}
};

template <bool PERMQKV>
__device__ __forceinline__ void transpose_item(const float* W, int K, int N, bf16* WT, LAS float* scr, int item, int lane, const float* gk = nullptr) {
    const int nblk = N / 32, kb = item / nblk, nb = item % nblk, k0 = 64 * kb, n0 = 32 * nb;
    int d0 = n0;
    if (PERMQKV) { const int within = n0 & 255; d0 = (n0 & ~255) + 128 * ((within >> 5) & 1) + 32 * (within >> 6); }
#pragma unroll
    for (int i = 0; i < 8; ++i) { const int kk = 8 * i + (lane >> 3), nn = 4 * (lane & 7);
        const f32x4 w4 = *(const GAS f32x4*)(W + (size_t)(k0 + kk) * N + n0 + nn) * (gk ? gk[k0 + kk] : 1.f);
        scr[kk * 33 + nn] = w4[0]; scr[kk * 33 + nn + 1] = w4[1]; scr[kk * 33 + nn + 2] = w4[2]; scr[kk * 33 + nn + 3] = w4[3]; }
    LDS_WAIT(); asm volatile("" ::: "memory");
    const int c = lane & 7;
#pragma unroll
    for (int j = 0; j < 4; ++j) { const int n = (lane >> 3) + 8 * j; const LAS float* s = scr + (8 * c) * 33 + n;
        v4u o; o.x = pk2(s[0 * 33], s[1 * 33]); o.y = pk2(s[2 * 33], s[3 * 33]); o.z = pk2(s[4 * 33], s[5 * 33]); o.w = pk2(s[6 * 33], s[7 * 33]);
        *(GAS v4u*)(WT + (size_t)(d0 + n) * K + k0 + 8 * c) = o; }
    LDS_WAIT(); asm volatile("" ::: "memory");
}
__device__ __forceinline__ void convert_bf16(const float* src, bf16* dst, size_t n, size_t gtid, size_t nthreads) {
    for (size_t i = gtid * 8; i < n; i += nthreads * 8) {
        const f32x4 a = *(const GAS f32x4*)(src + i), b = *(const GAS f32x4*)(src + i + 4);
        v4u o; o.x = pk2(a[0], a[1]); o.y = pk2(a[2], a[3]); o.z = pk2(b[0], b[1]); o.w = pk2(b[2], b[3]);
        *(GAS v4u*)(dst + i) = o;
    }
}
__device__ __forceinline__ int t5_bucket(int rel) {
    const int n = rel < 0 ? -rel : rel;
    const int b = n < 8 ? n : n < 12 ? 8 : n < 16 ? 9 : n < 23 ? 10 : n < 32 ? 11 : n < 46 ? 12 : n < 64 ? 13 : n < 91 ? 14 : 15;
    return b + (rel > 0 ? 16 : 0);
}
__constant__ float ROPE_INV[16] = {1.000000000e+00f, 5.623413324e-01f, 3.162277639e-01f, 1.778279394e-01f, 1.000000015e-01f, 5.623413250e-02f, 3.162277490e-02f, 1.778279431e-02f,
                                   9.999999776e-03f, 5.623413250e-03f, 3.162277630e-03f, 1.778279431e-03f, 1.000000047e-03f, 5.623413017e-04f, 3.162277571e-04f, 1.778279402e-04f};

__device__ __forceinline__ void rms_row_to_bf16(const float* xrow, const float* g0, bf16* o0, const float* g1, bf16* o1, int lane) {
    const GAS f32x4* xr = (const GAS f32x4*)xrow + lane;
    f32x4 v[8]; float s = 0.f;
#pragma unroll
    for (int j = 0; j < 8; ++j) { v[j] = xr[64 * j]; s += (v[j].x * v[j].x + v[j].y * v[j].y) + (v[j].z * v[j].z + v[j].w * v[j].w); }
    const float rstd = 1.f / sqrtf(wave_sum(s, lane) * (1.f / DM) + EPS);
    {   const GAS f32x4* gr = (const GAS f32x4*)g0 + lane; GAS v2u* o8 = (GAS v2u*)o0 + lane;
#pragma unroll
        for (int j = 0; j < 8; ++j) { const f32x4 gg = gr[64 * j]; v2u w; w.x = pk2(v[j].x * rstd * gg.x, v[j].y * rstd * gg.y); w.y = pk2(v[j].z * rstd * gg.z, v[j].w * rstd * gg.w); o8[64 * j] = w; } }
    if (g1) { const GAS f32x4* gr = (const GAS f32x4*)g1 + lane; GAS v2u* o8 = (GAS v2u*)o1 + lane;
#pragma unroll
        for (int j = 0; j < 8; ++j) { const f32x4 gg = gr[64 * j]; v2u w; w.x = pk2(v[j].x * rstd * gg.x, v[j].y * rstd * gg.y); w.y = pk2(v[j].z * rstd * gg.z, v[j].w * rstd * gg.w); o8[64 * j] = w; } }
}
__device__ __forceinline__ void prep_rows2(const float* x0, bf16* o0, u64_t* sq, int lane) {
    f32x4 v[2][8];
#pragma unroll
    for (int q = 0; q < 2; ++q) { const GAS f32x4* xr = (const GAS f32x4*)(x0 + (size_t)q * DM) + lane;
#pragma unroll
        for (int j = 0; j < 8; ++j) v[q][j] = xr[64 * j]; }
#pragma unroll
    for (int q = 0; q < 2; ++q) { GAS v2u* o8 = (GAS v2u*)(o0 + (size_t)q * DM) + lane; float s = 0.f;
#pragma unroll
        for (int j = 0; j < 8; ++j) { const f32x4 a = v[q][j]; s += (a.x * a.x + a.y * a.y) + (a.z * a.z + a.w * a.w); v2u w; w.x = pk2(a.x, a.y); w.y = pk2(a.z, a.w); o8[64 * j] = w; }
        s = wave_sum(s, lane);
        if (lane == 0) sq[q] = rowsq_fx(s); }
}
__device__ __forceinline__ void norm_rows(const float* X, const float* g, bf16* XN, int gw, int NGW, int lane) {
    for (int m = gw; m < T; m += NGW) rms_row_to_bf16(X + (size_t)m * DM, g, XN + (size_t)m * DM, nullptr, nullptr, lane);
}

template <int TYPE>
__device__ __forceinline__ void naive_attn_item(const bf16* QKV, bf16* ATT, int b, int grow, int head, int lane, const float* biasA, const float* sink, const float* rpb) {
    const int tpos = grow * 64 + lane; const size_t trow = (size_t)b * SEQ + tpos;
    int qcol, kcol, vcol, ocol;
    if (TYPE == 0) { qcol = QA + head * 64; kcol = KA + (head / 3) * 64; vcol = VA + (head / 3) * 64; ocol = OA + head * 64; }
    else if (TYPE == 1) { qcol = QB + head * 64; kcol = KB + head * 64; vcol = VB + head * 64; ocol = OB + head * 64; }
    else { qcol = QC + head * 64; kcol = KC + (head / 3) * 64; vcol = VC + (head / 3) * 64; ocol = OC + head * 64; }
    float q[64], o[64];
#pragma unroll
    for (int c = 0; c < 8; ++c) { const v4u w = *(const GAS v4u*)(QKV + trow * DIN + qcol + 8 * c);
        q[8 * c + 0] = bflo(w.x); q[8 * c + 1] = bfhi(w.x); q[8 * c + 2] = bflo(w.y); q[8 * c + 3] = bfhi(w.y); q[8 * c + 4] = bflo(w.z); q[8 * c + 5] = bfhi(w.z); q[8 * c + 6] = bflo(w.w); q[8 * c + 7] = bfhi(w.w); }
#pragma unroll
    for (int d = 0; d < 64; ++d) o[d] = 0.f;
    float m = -1e30f, l = 0.f;
    int j0, j1;
    if (TYPE == 0) { j0 = grow * 64 - 128; if (j0 < 0) j0 = 0; j1 = grow * 64 + 63 + 128; if (j1 > SEQ - 1) j1 = SEQ - 1; }
    else if (TYPE == 1) { int r0 = grow - 4; r0 = r0 < 0 ? 0 : (r0 > 24 ? 24 : r0); j0 = r0 * 64; j1 = j0 + 511; }
    else { j0 = 0; j1 = SEQ - 1; }
    int c0 = lane - 8; c0 = c0 < 0 ? 0 : (c0 > 48 ? 48 : c0);
#pragma unroll 1
    for (int j = j0; j <= j1; ++j) {
        const bf16* krow = QKV + ((size_t)b * SEQ + j) * DIN;
        float s = 0.f;
#pragma unroll
        for (int c = 0; c < 8; ++c) { const v4u w = *(const GAS v4u*)(krow + kcol + 8 * c);
            s += q[8 * c + 0] * bflo(w.x) + q[8 * c + 1] * bfhi(w.x) + q[8 * c + 2] * bflo(w.y) + q[8 * c + 3] * bfhi(w.y) + q[8 * c + 4] * bflo(w.z) + q[8 * c + 5] * bfhi(w.z) + q[8 * c + 6] * bflo(w.w) + q[8 * c + 7] * bfhi(w.w); }
        bool valid = true;
        if (TYPE == 0) { const int rel = j - tpos; valid = (rel >= -128 && rel <= 128); if (valid) s += biasA[head * 257 + rel + 128]; }
        if (TYPE == 1) { const int kr = j >> 6, kc = j & 63; valid = (kc >= c0 && kc < c0 + 16); if (valid) s += rpb[(head * 15 + (kr - grow + 7)) * 31 + (kc - lane + 15)]; }
        const float mn = valid ? fmaxf(m, s) : m;
        const float a = __expf(m - mn);
        const float p = valid ? __expf(s - mn) : 0.f;
        l = l * a + p; m = mn;
#pragma unroll
        for (int c = 0; c < 8; ++c) { const v4u w = *(const GAS v4u*)(krow + vcol + 8 * c);
            o[8 * c + 0] = o[8 * c + 0] * a + p * bflo(w.x); o[8 * c + 1] = o[8 * c + 1] * a + p * bfhi(w.x); o[8 * c + 2] = o[8 * c + 2] * a + p * bflo(w.y); o[8 * c + 3] = o[8 * c + 3] * a + p * bfhi(w.y);
            o[8 * c + 4] = o[8 * c + 4] * a + p * bflo(w.z); o[8 * c + 5] = o[8 * c + 5] * a + p * bfhi(w.z); o[8 * c + 6] = o[8 * c + 6] * a + p * bflo(w.w); o[8 * c + 7] = o[8 * c + 7] * a + p * bfhi(w.w); }
    }
    if (TYPE == 0) l += __expf(sink[head] - m);
    const float inv = 1.f / l;
#pragma unroll
    for (int c = 0; c < 8; ++c) { v4u w; w.x = pk2(o[8 * c + 0] * inv, o[8 * c + 1] * inv); w.y = pk2(o[8 * c + 2] * inv, o[8 * c + 3] * inv); w.z = pk2(o[8 * c + 4] * inv, o[8 * c + 5] * inv); w.w = pk2(o[8 * c + 6] * inv, o[8 * c + 7] * inv);
        *(GAS v4u*)(ATT + trow * DM + ocol + 8 * c) = w; }
}
__device__ __forceinline__ float rdl(float v, int l) { return __builtin_bit_cast(float, __builtin_amdgcn_readlane(__builtin_bit_cast(int, v), l)); }
__device__ __forceinline__ void naive_mem_item(const bf16* QM, const bf16* KVM, bf16* OM, const float* gq, size_t trow, int b, int head, int lane) {
    const unsigned qw = *(const GAS unsigned*)(QM + trow * MEMW + head * 128 + 2 * lane);
    float q0 = bflo(qw), q1 = bfhi(qw);
    const float ss = wave_sum(q0 * q0 + q1 * q1, lane);
    const float r = 0.08838834764831845f / sqrtf(ss * (1.f / 128.f) + EPS);
    q0 *= r * gq[2 * lane]; q1 *= r * gq[2 * lane + 1];
    const bf16* kbase = KVM + ((size_t)b * NMEM + lane) * 1024 + head * 128;
    float s[4] = {0.f, 0.f, 0.f, 0.f};
#pragma unroll 1
    for (int c = 0; c < 16; ++c) {
        float qa[8];
#pragma unroll
        for (int e = 0; e < 4; ++e) { qa[2 * e] = rdl(q0, 4 * c + e); qa[2 * e + 1] = rdl(q1, 4 * c + e); }
#pragma unroll
        for (int i = 0; i < 4; ++i) { const v4u w = *(const GAS v4u*)(kbase + (size_t)i * 64 * 1024 + 8 * c);
            s[i] += qa[0] * bflo(w.x) + qa[1] * bfhi(w.x) + qa[2] * bflo(w.y) + qa[3] * bfhi(w.y) + qa[4] * bflo(w.z) + qa[5] * bfhi(w.z) + qa[6] * bflo(w.w) + qa[7] * bfhi(w.w); }
    }
    float m = fmaxf(fmaxf(s[0], s[1]), fmaxf(s[2], s[3]));
#pragma unroll
    for (int o = 1; o < 64; o <<= 1) m = fmaxf(m, shx(m, o, lane));
    float p[4]; float l = 0.f;
#pragma unroll
    for (int i = 0; i < 4; ++i) { p[i] = __expf(s[i] - m); l += p[i]; }
    l = wave_sum(l, lane);
    const bf16* vbase = KVM + ((size_t)b * NMEM) * 1024 + 512 + head * 128 + 2 * lane;
    float o0 = 0.f, o1 = 0.f;
#pragma unroll
    for (int i = 0; i < 4; ++i) {
#pragma unroll 4
        for (int jj = 0; jj < 64; ++jj) { const float pj = rdl(p[i], jj); const unsigned w = *(const GAS unsigned*)(vbase + (size_t)(64 * i + jj) * 1024); o0 += pj * bflo(w); o1 += pj * bfhi(w); }
    }
    const float inv = 1.f / l;
    *(GAS unsigned*)(OM + trow * MEMW + head * 128 + 2 * lane) = pk2(o0 * inv, o1 * inv);
}
__device__ __forceinline__ void mixnorm_rows(bf16* ATT, const float* g, int gw, int NGW, int lane) {
    for (int m = gw; m < T; m += NGW) {
        GAS v4u* p = (GAS v4u*)(ATT + (size_t)m * DM + 32 * lane);
        v4u w[4]; float f[32]; float ss = 0.f;
#pragma unroll
        for (int c = 0; c < 4; ++c) { w[c] = p[c];
            f[8 * c + 0] = bflo(w[c].x); f[8 * c + 1] = bfhi(w[c].x); f[8 * c + 2] = bflo(w[c].y); f[8 * c + 3] = bfhi(w[c].y); f[8 * c + 4] = bflo(w[c].z); f[8 * c + 5] = bfhi(w[c].z); f[8 * c + 6] = bflo(w[c].w); f[8 * c + 7] = bfhi(w[c].w); }
#pragma unroll
        for (int i = 0; i < 32; ++i) ss += f[i] * f[i];
        const int grp = lane < 24 ? 0 : (lane < 40 ? 1 : 2);
        const float sa = wave_sum(grp == 0 ? ss : 0.f, lane), sb = wave_sum(grp == 1 ? ss : 0.f, lane), sc = wave_sum(grp == 2 ? ss : 0.f, lane);
        const float r = grp == 0 ? 1.f / sqrtf(sa * (1.f / 768.f) + EPS) : (grp == 1 ? 1.f / sqrtf(sb * (1.f / 512.f) + EPS) : 1.f / sqrtf(sc * (1.f / 768.f) + EPS));
        const float* gg = g + 32 * lane;
#pragma unroll
        for (int c = 0; c < 4; ++c) { const f32x4 g0 = *(const GAS f32x4*)(gg + 8 * c), g1 = *(const GAS f32x4*)(gg + 8 * c + 4);
            v4u o; o.x = pk2(f[8 * c + 0] * r * g0[0], f[8 * c + 1] * r * g0[1]); o.y = pk2(f[8 * c + 2] * r * g0[2], f[8 * c + 3] * r * g0[3]);
            o.z = pk2(f[8 * c + 4] * r * g1[0], f[8 * c + 5] * r * g1[1]); o.w = pk2(f[8 * c + 6] * r * g1[2], f[8 * c + 7] * r * g1[3]); p[c] = o; }
    }
}

#ifndef PEER_HD
#define PEER_HD __device__ __forceinline__
#define PEER_EXP(x) __expf(x)
#endif
template <int N> PEER_HD void bitonic_sort_desc(float* v) {
#pragma unroll
    for (int k = 2; k <= N; k <<= 1)
#pragma unroll
        for (int j = k >> 1; j > 0; j >>= 1)
#pragma unroll
            for (int i = 0; i < N; ++i) { const int l = i ^ j; if (l > i) { const bool desc = ((i & k) == 0); const float a = v[i], b = v[l]; const float hi = fmaxf(a, b), lo = fminf(a, b);
                v[i] = desc ? hi : lo; v[l] = desc ? lo : hi; } }
}
PEER_HD void merge_top16(float* a, const float* b) {
    float c[16];
#pragma unroll
    for (int i = 0; i < 16; ++i) c[i] = fmaxf(a[i], b[15 - i]);
#pragma unroll
    for (int j = 8; j > 0; j >>= 1)
#pragma unroll
        for (int i = 0; i < 16; ++i) { const int l = i ^ j; if (l > i) { const float x = c[i], y = c[l]; c[i] = fmaxf(x, y); c[l] = fminf(x, y); } }
#pragma unroll
    for (int i = 0; i < 16; ++i) a[i] = c[i];
}
PEER_HD void top16_of_64(float (&v)[64]) {
    bitonic_sort_desc<16>(&v[0]); bitonic_sort_desc<16>(&v[16]); bitonic_sort_desc<16>(&v[32]); bitonic_sort_desc<16>(&v[48]);
    merge_top16(&v[0], &v[16]); merge_top16(&v[32], &v[48]); merge_top16(&v[0], &v[32]);
}
PEER_HD float pack_idx(float s, unsigned idx, unsigned mask) { return __builtin_bit_cast(float, (__builtin_bit_cast(unsigned, s) & ~mask) | idx); }
PEER_HD unsigned low_bits(float s, unsigned mask) { return __builtin_bit_cast(unsigned, s) & mask; }
PEER_HD unsigned pick16(const float* a, unsigned i, unsigned mask) {
    unsigned r = 0;
#pragma unroll
    for (unsigned k = 0; k < 16; ++k) r = (i == k) ? low_bits(a[k], mask) : r;
    return r;
}
PEER_HD void peer_candidates(const float* a, const float* b, int* e, float* gate) {
    float c[64]; int n = 0;
#pragma unroll
    for (int i = 0; i < 16; ++i)
#pragma unroll
        for (int j = 0; j < 16; ++j) if ((i + 1) * (j + 1) <= 16) { c[n] = pack_idx(a[i] + b[j], (unsigned)(i * 16 + j), 0xffu); ++n; }
#pragma unroll
    for (int k = 50; k < 64; ++k) c[k] = -3.0e38f;
    top16_of_64(c);
    float mx = c[0], den = 0.f;
#pragma unroll
    for (int k = 0; k < 16; ++k) { const unsigned id = low_bits(c[k], 0xffu); const unsigned n0 = pick16(a, id >> 4, 0x7fu), n1 = pick16(b, id & 15u, 0x7fu);
        e[k] = (int)(n0 * 128u + n1); gate[k] = PEER_EXP(c[k] - mx); den += gate[k]; }
    const float inv = 1.f / den;
#pragma unroll
    for (int k = 0; k < 16; ++k) gate[k] *= inv;
}

__device__ __forceinline__ void peer_select_unit(const bf16* QP, const bf16* PK, int* PIDX, float* PGATE, int tb, int h, int wave, int lane) {
    const int hh = lane >> 5, tl = lane & 31; const size_t t = (size_t)tb * 256 + wave * 32 + tl;
    float ab[2][16];
#pragma unroll
    for (int p = 0; p < 2; ++p) {
        bf16x8 bq[8];
#pragma unroll
        for (int s = 0; s < 8; ++s) bq[s] = *(const GAS bf16x8*)(QP + t * DM + 256 * h + 128 * p + 16 * s + 8 * hh);
        float v[64];
#pragma unroll
        for (int nb = 0; nb < 4; ++nb) {
            f32x16 acc;
#pragma unroll
            for (int r = 0; r < 16; ++r) acc[r] = 0.f;
            const bf16* kp = PK + ((size_t)((h * 2 + p) * 128 + 32 * nb + tl)) * 128 + 8 * hh;
            bf16x8 ak[8];
#pragma unroll
            for (int s = 0; s < 8; ++s) ak[s] = *(const GAS bf16x8*)(kp + 16 * s);
#pragma unroll
            for (int s = 0; s < 8; ++s) acc = __builtin_amdgcn_mfma_f32_32x32x16_bf16(ak[s], bq[s], acc, 0, 0, 0);
#pragma unroll
            for (int r = 0; r < 16; ++r) v[16 * nb + r] = pack_idx(acc[r], (unsigned)(32 * nb + 8 * (r >> 2) + 4 * hh + (r & 3)), 0x7fu);
        }
        top16_of_64(v);
        float pv[16];
#pragma unroll
        for (int i = 0; i < 16; ++i) pv[i] = shx(v[i], 32, lane);
        merge_top16(&v[0], pv);
#pragma unroll
        for (int i = 0; i < 16; ++i) ab[p][i] = v[i];
    }
    int e[16]; float gate[16];
    peer_candidates(ab[0], ab[1], e, gate);
    if (hh == 0) { GAS v4u* o = (GAS v4u*)(PIDX + t * 128 + h * 16);
#pragma unroll
        for (int c = 0; c < 4; ++c) o[c] = (v4u){(unsigned)e[4 * c], (unsigned)e[4 * c + 1], (unsigned)e[4 * c + 2], (unsigned)e[4 * c + 3]}; }
    else { GAS f32x4* o = (GAS f32x4*)(PGATE + t * 128 + h * 16);
#pragma unroll
        for (int c = 0; c < 4; ++c) o[c] = (f32x4){gate[4 * c], gate[4 * c + 1], gate[4 * c + 2], gate[4 * c + 3]}; }
}

typedef float f32x2 __attribute__((ext_vector_type(2)));
typedef unsigned v6u __attribute__((ext_vector_type(6)));
typedef float v32f __attribute__((ext_vector_type(32)));
typedef v4u __attribute__((aligned(8))) v4u_a8;
constexpr float PU_SCALE6 = 90.0f, PV_SCALE6 = 5.65f;
__device__ __forceinline__ unsigned enc_e2m3(float v) {
    const float a = fminf(fabsf(v), 7.5f);
    unsigned code;
    if (a < 1.0f) code = (unsigned)__builtin_rintf(a * 8.f);
    else { const unsigned b = __builtin_bit_cast(unsigned, a) - 0x3F800000u; code = ((b + 0x7FFFFu + ((b >> 20) & 1u)) >> 20) + 8u; }
    return code | (v < 0.f ? 32u : 0u);
}
__device__ __forceinline__ void convert_fp6_rows(const float* src, unsigned char* dst, int nrows, float scale, const float* gain, int gw, int NGW, int lane) {
    for (int r = gw; r < nrows; r += NGW) {
        const float* sp = src + (size_t)r * DM + 4 * lane; const float* gp = gain ? gain + (size_t)(r / PEER_N) * DM + 4 * lane : nullptr;
        unsigned w[6] = {0u, 0u, 0u, 0u, 0u, 0u};
#pragma unroll
        for (int j = 0; j < 8; ++j) { f32x4 a = *(const GAS f32x4*)(sp + 256 * j) * scale; if (gp) a = a * *(const GAS f32x4*)(gp + 256 * j);
#pragma unroll
            for (int e = 0; e < 4; ++e) { const unsigned code = enc_e2m3(a[e]); const int bp = 6 * (4 * j + e), wi = bp >> 5, sh = bp & 31;
                w[wi] |= code << sh; if (sh > 26) w[wi + 1] |= code >> (32 - sh); } }
        unsigned char* dp = dst + (size_t)r * 1536 + 24 * lane;
        *(GAS v4u_a8*)dp = (v4u){w[0], w[1], w[2], w[3]}; *(GAS v2u*)(dp + 16) = (v2u){w[4], w[5]};
    }
}
constexpr float PV_SCALE4 = 5.65f, PU_SCALE4 = 90.0f;
__device__ __forceinline__ unsigned enc_e2m1(float v) {
    const float a = fabsf(v);
    const unsigned code = a < 0.25f ? 0u : a < 0.75f ? 1u : a < 1.25f ? 2u : a < 1.75f ? 3u : a < 2.5f ? 4u : a < 3.5f ? 5u : a < 5.0f ? 6u : 7u;
    return code | (v < 0.f ? 8u : 0u);
}
__device__ __forceinline__ void convert_fp4_rows(const float* src, unsigned char* dst, int nrows, float scale, const float* gain, int gw, int NGW, int lane) {
    for (int r0 = 2 * gw; r0 < nrows; r0 += 2 * NGW) {
        f32x4 a[2][8];
#pragma unroll
        for (int q = 0; q < 2; ++q) { const float* sp = src + (size_t)(r0 + q) * DM + 4 * lane;
#pragma unroll
            for (int j = 0; j < 8; ++j) a[q][j] = *(const GAS f32x4*)(sp + 256 * j); }
#pragma unroll
        for (int q = 0; q < 2; ++q) { const int r = r0 + q; const float* gp = gain ? gain + (size_t)(r / PEER_N) * DM + 4 * lane : nullptr;
            unsigned w[4] = {0u, 0u, 0u, 0u};
#pragma unroll
            for (int j = 0; j < 8; ++j) { f32x4 v = a[q][j] * scale; if (gp) v = v * *(const GAS f32x4*)(gp + 256 * j);
#pragma unroll
                for (int e = 0; e < 4; ++e) { const int i = 4 * j + e; w[i >> 3] |= enc_e2m1(v[e]) << (4 * (i & 7)); } }
            *(GAS v4u*)(dst + (size_t)r * 1024 + 16 * lane) = (v4u){w[0], w[1], w[2], w[3]}; }
    }
}
#define PG4_LOAD(buf, tab, idlo, idhi, g) do { _Pragma("unroll") for (int i_ = 0; i_ < PG6_R; ++i_) { const int k_ = (g) * PG6_R + i_; \
        const int e_ = __builtin_amdgcn_readlane(k_ < 64 ? idlo : idhi, k_ & 63); buf[i_] = __builtin_amdgcn_raw_buffer_load_b128(tab, (int)voff4, e_ * 1024, 0); } } while (0)
#define PG4_DOT1(buf, i_, dst) do { f32x2 a_ = {0.f, 0.f}; _Pragma("unroll") for (int c_ = 0; c_ < 4; ++c_) { const unsigned u_ = buf[i_][c_]; \
        a_ += __builtin_amdgcn_cvt_scalef32_pk_f32_fp4(u_, 1.0f, 0) * x[4 * c_ + 0]; a_ += __builtin_amdgcn_cvt_scalef32_pk_f32_fp4(u_, 1.0f, 1) * x[4 * c_ + 1]; \
        a_ += __builtin_amdgcn_cvt_scalef32_pk_f32_fp4(u_, 1.0f, 2) * x[4 * c_ + 2]; a_ += __builtin_amdgcn_cvt_scalef32_pk_f32_fp4(u_, 1.0f, 3) * x[4 * c_ + 3]; } dst = a_.x + a_.y; __builtin_amdgcn_sched_barrier(0); } while (0)
#define PG4_DOT(buf, g) do { float p_[8]; _Pragma("unroll") for (int i_ = 0; i_ < 8; ++i_) PG4_DOT1(buf, i_, p_[i_]); \
        float q_[4]; _Pragma("unroll") for (int i_ = 0; i_ < 4; ++i_) { const float keep_ = b5 ? p_[i_ + 4] : p_[i_], send_ = b5 ? p_[i_] : p_[i_ + 4]; q_[i_] = keep_ + shx(send_, 32, lane); } \
        float r_[2]; _Pragma("unroll") for (int i_ = 0; i_ < 2; ++i_) { const float keep_ = b4 ? q_[i_ + 2] : q_[i_], send_ = b4 ? q_[i_] : q_[i_ + 2]; r_[i_] = keep_ + shx(send_, 16, lane); } \
        float s_; { const float keep_ = b3 ? r_[1] : r_[0], send_ = b3 ? r_[0] : r_[1]; s_ = keep_ + shx(send_, 8, lane); } \
        s_ += shx(s_, 4, lane); s_ += shx(s_, 2, lane); s_ += shx(s_, 1, lane); \
        if ((lane & 7) == 0) wl[(g) * 8 + (lane >> 3)] = s_; } while (0)
#define PG4_AXPY(buf, g) do { _Pragma("unroll") for (int i_ = 0; i_ < PG6_R; ++i_) { const float w_ = wl[(g) * PG6_R + i_]; const f32x2 wv_ = {w_, w_}; \
        _Pragma("unroll") for (int c_ = 0; c_ < 4; ++c_) { const unsigned u_ = buf[i_][c_]; \
            y[4 * c_ + 0] += __builtin_amdgcn_cvt_scalef32_pk_f32_fp4(u_, 1.0f, 0) * wv_; y[4 * c_ + 1] += __builtin_amdgcn_cvt_scalef32_pk_f32_fp4(u_, 1.0f, 1) * wv_; \
            y[4 * c_ + 2] += __builtin_amdgcn_cvt_scalef32_pk_f32_fp4(u_, 1.0f, 2) * wv_; y[4 * c_ + 3] += __builtin_amdgcn_cvt_scalef32_pk_f32_fp4(u_, 1.0f, 3) * wv_; } \
        __builtin_amdgcn_sched_barrier(0); } } while (0)
#ifndef PG6_R
#define PG6_R 8
#endif
#define PG6_LOAD(buf, tab, idlo, idhi, g) do { _Pragma("unroll") for (int i_ = 0; i_ < PG6_R; ++i_) { const int k_ = (g) * PG6_R + i_; \
        const int e_ = __builtin_amdgcn_readlane(k_ < 64 ? idlo : idhi, k_ & 63); const unsigned char* rp_ = (tab) + (size_t)(unsigned)e_ * 1536u; \
        const v4u a_ = *(const GAS v4u_a8*)(rp_ + voff); const v2u b_ = *(const GAS v2u*)(rp_ + voff + 16); buf[i_] = (v6u){a_.x, a_.y, a_.z, a_.w, b_.x, b_.y}; } } while (0)
#define PG6_DOT1(buf, i_, dst) do { const v32f f_ = __builtin_amdgcn_cvt_scalef32_pk32_f32_fp6(buf[i_], 1.0f); f32x2 a_ = {0.f, 0.f}; \
        _Pragma("unroll") for (int c_ = 0; c_ < 16; ++c_) a_ += (f32x2){f_[2 * c_], f_[2 * c_ + 1]} * x[c_]; dst = a_.x + a_.y; __builtin_amdgcn_sched_barrier(0); } while (0)
#if PG6_R == 8
#define PG6_DOT(buf, g) do { float p_[8]; _Pragma("unroll") for (int i_ = 0; i_ < 8; ++i_) PG6_DOT1(buf, i_, p_[i_]); \
        float q_[4]; _Pragma("unroll") for (int i_ = 0; i_ < 4; ++i_) { const float keep_ = b5 ? p_[i_ + 4] : p_[i_], send_ = b5 ? p_[i_] : p_[i_ + 4]; q_[i_] = keep_ + shx(send_, 32, lane); } \
        float r_[2]; _Pragma("unroll") for (int i_ = 0; i_ < 2; ++i_) { const float keep_ = b4 ? q_[i_ + 2] : q_[i_], send_ = b4 ? q_[i_] : q_[i_ + 2]; r_[i_] = keep_ + shx(send_, 16, lane); } \
        float s_; { const float keep_ = b3 ? r_[1] : r_[0], send_ = b3 ? r_[0] : r_[1]; s_ = keep_ + shx(send_, 8, lane); } \
        s_ += shx(s_, 4, lane); s_ += shx(s_, 2, lane); s_ += shx(s_, 1, lane); \
        if ((lane & 7) == 0) wl[(g) * 8 + (lane >> 3)] = s_; } while (0)
#else
#define PG6_DOT(buf, g) do { float p_[4]; _Pragma("unroll") for (int i_ = 0; i_ < 4; ++i_) PG6_DOT1(buf, i_, p_[i_]); \
        float r_[2]; _Pragma("unroll") for (int i_ = 0; i_ < 2; ++i_) { const float keep_ = b5 ? p_[i_ + 2] : p_[i_], send_ = b5 ? p_[i_] : p_[i_ + 2]; r_[i_] = keep_ + shx(send_, 32, lane); } \
        float s_; { const float keep_ = b4 ? r_[1] : r_[0], send_ = b4 ? r_[0] : r_[1]; s_ = keep_ + shx(send_, 16, lane); } \
        s_ += shx(s_, 8, lane); s_ += shx(s_, 4, lane); s_ += shx(s_, 2, lane); s_ += shx(s_, 1, lane); \
        if ((lane & 15) == 0) wl[(g) * 4 + (lane >> 4)] = s_; } while (0)
#endif
#define PG6_AXPY(buf, g) do { _Pragma("unroll") for (int i_ = 0; i_ < PG6_R; ++i_) { const float w_ = wl[(g) * PG6_R + i_]; const f32x2 wv_ = {w_, w_}; \
        const v32f f_ = __builtin_amdgcn_cvt_scalef32_pk32_f32_fp6(buf[i_], 1.0f); _Pragma("unroll") for (int c_ = 0; c_ < 16; ++c_) y[c_] += (f32x2){f_[2 * c_], f_[2 * c_ + 1]} * wv_; __builtin_amdgcn_sched_barrier(0); } } while (0)
__device__ __forceinline__ unsigned shxu(unsigned v, int k, int lane) { return (unsigned)__builtin_amdgcn_ds_bpermute((lane ^ k) << 2, (int)v); }
__device__ __forceinline__ void wave_sort128(unsigned& a, unsigned& b, int lane) {
#pragma unroll
    for (int k = 2; k <= 128; k <<= 1) {
#pragma unroll
        for (int j = k >> 1; j > 0; j >>= 1) {
            if (j == 64) { const unsigned lo = a < b ? a : b, hi = a < b ? b : a; a = lo; b = hi; }
            else {
                const unsigned pa = shxu(a, j, lane), pb = shxu(b, j, lane);
                const bool lower = (lane & j) == 0;
                const bool asc_a = (lane & k) == 0, asc_b = ((lane + 64) & k) == 0;
                const bool take_min_a = (lower == asc_a), take_min_b = (lower == asc_b);
                a = take_min_a ? (a < pa ? a : pa) : (a < pa ? pa : a);
                b = take_min_b ? (b < pb ? b : pb) : (b < pb ? pb : b);
            }
        }
    }
}
#ifndef PEER_U_FP4
#define PEER_U_FP4 1
#endif
#if PEER_U_FP4
typedef v4u urow_t;
#define PGU_LOAD PG4_LOAD
#define PGU_DOT PG4_DOT
constexpr float PU_SCALE = PU_SCALE4; constexpr int PU_STRIDE = 1024;
#else
typedef v6u urow_t;
#define PGU_LOAD PG6_LOAD
#define PGU_DOT PG6_DOT
constexpr float PU_SCALE = PU_SCALE6; constexpr int PU_STRIDE = 1536;
#endif
constexpr float PU_SCALEI = 135.0f, PX_SCALEI = 20.0f;
__device__ __forceinline__ void peer_v_pass(bf16* XN, const unsigned char* PV6, const int* PIDX, const float* PGATE, const int* PARTI, float* X, u64_t* rowsq_out, LAS float* wl, int gw, int NGW, int lane) {
    const unsigned voff4 = 16u * (unsigned)lane, l4 = 4u * (unsigned)lane, l8 = 8u * (unsigned)lane, l16 = 16u * (unsigned)lane;
    constexpr int NG = 128 / PG6_R;
    const __amdgpu_buffer_rsrc_t PVr = __builtin_amdgcn_make_buffer_rsrc((void*)PV6, 0, PEER_N * 1024, 0x00020000);
    for (int t_ = gw; t_ < T; t_ += NGW) {
        int t = t_; asm volatile("" : "+s"(t));
        const char* pidx_t = (const char*)(PIDX + (size_t)t * 128); const char* pgate_t = (const char*)(PGATE + (size_t)t * 128);
        const int idlo = *(const GAS int*)(pidx_t + l4), idhi = *(const GAS int*)(pidx_t + l4 + 256);
        v4u AV[PG6_R], BV[PG6_R];
        PG4_LOAD(AV, PVr, idlo, idhi, 0);
        {
            int s0 = 0, s1 = 0;
#pragma unroll
            for (int sp = 0; sp < 8; ++sp) { const char* pp = (const char*)(PARTI + ((size_t)sp * T + t) * 128); s0 += *(const GAS int*)(pp + l4); s1 += *(const GAS int*)(pp + l4 + 256); }
            const float d0 = (float)s0 * (1.f / (PX_SCALEI * PU_SCALEI)), d1 = (float)s1 * (1.f / (PX_SCALEI * PU_SCALEI));
            const float g0 = *(const GAS float*)(pgate_t + l4), g1 = *(const GAS float*)(pgate_t + l4 + 256);
            const float w0 = g0 * 0.5f * d0 * (1.f + erff(d0 * 0.70710678118654752f)) * (1.f / PV_SCALE4), w1 = g1 * 0.5f * d1 * (1.f + erff(d1 * 0.70710678118654752f)) * (1.f / PV_SCALE4);
            wl[lane] = w0; wl[64 + lane] = w1;
            LDS_WAIT(); asm volatile("" ::: "memory");
        }
        f32x2 y[16];
#pragma unroll
        for (int i = 0; i < 16; ++i) y[i] = (f32x2){0.f, 0.f};
#pragma unroll 1
        for (int g = 0; g < NG; g += 2) {
            PG4_LOAD(BV, PVr, idlo, idhi, g + 1);
            PG4_AXPY(AV, g);
            if (g + 2 < NG) PG4_LOAD(AV, PVr, idlo, idhi, g + 2);
            PG4_AXPY(BV, g + 1);
        }
        {   char* xo = (char*)(X + (size_t)t * DM);
            char* xbo = (char*)(XN + (size_t)t * DM); float ss = 0.f;
#pragma unroll
            for (int j = 0; j < 8; ++j) { const v2u a = *(const GAS v2u*)(xbo + l8 + 512 * j); f32x4 v = (f32x4){bflo(a.x), bfhi(a.x), bflo(a.y), bfhi(a.y)}; v += (f32x4){y[2 * j].x, y[2 * j].y, y[2 * j + 1].x, y[2 * j + 1].y};
                if (X) *(GAS f32x4*)(xo + l16 + 1024 * j) = v;
                ss += (v[0] * v[0] + v[1] * v[1]) + (v[2] * v[2] + v[3] * v[3]); *(GAS v2u*)(xbo + l8 + 512 * j) = (v2u){pk2(v[0], v[1]), pk2(v[2], v[3])}; }
            if (rowsq_out) { ss = wave_sum(ss, lane); if (lane == 0) rowsq_out[t] = rowsq_fx(ss); } }
        LDS_WAIT(); asm volatile("" ::: "memory");
    }
}


__device__ __forceinline__ unsigned enc_i4(float v) { int q = (int)__builtin_rintf(v); q = q < -7 ? -7 : (q > 7 ? 7 : q); return (unsigned)q & 15u; }
__device__ __forceinline__ void convert_int4_plain(const float* src, unsigned char* dst, int nrows, float scale, const float* gain, int gw, int NGW, int lane) {
    for (int r0 = 2 * gw; r0 < nrows; r0 += 2 * NGW) {
        f32x4 a[2][8];
#pragma unroll
        for (int q = 0; q < 2; ++q) { const float* sp = src + (size_t)(r0 + q) * DM + 4 * lane;
#pragma unroll
            for (int j = 0; j < 8; ++j) a[q][j] = *(const GAS f32x4*)(sp + 256 * j); }
#pragma unroll
        for (int q = 0; q < 2; ++q) { const int r = r0 + q; const float* gp = gain ? gain + (size_t)(r / PEER_N) * DM + 4 * lane : nullptr;
#pragma unroll
            for (int j = 0; j < 8; ++j) { f32x4 v = a[q][j] * scale; if (gp) v = v * *(const GAS f32x4*)(gp + 256 * j);
                const unsigned w = enc_i4(v[0]) | (enc_i4(v[1]) << 4) | (enc_i4(v[2]) << 8) | (enc_i4(v[3]) << 12);
                *(GAS unsigned short*)(dst + (size_t)r * 1024 + 128 * j + 2 * lane) = (unsigned short)w; } }
    }
}
__device__ __forceinline__ void peer_xquant_unit(const bf16* XN, const u64_t* rowsq, unsigned* XQH, unsigned* XQL, int tb, int sl, int tid) {
    for (int it = tid; it < 256 * 32; it += NTHREADS) {
        const int t = tb * 256 + (it >> 5), c8 = it & 31;
        const float xs = PX_SCALEI * rowsq_rs(rowsq, t);
        const v4u w = *(const GAS v4u*)(XN + (size_t)t * DM + 256 * sl + 8 * c8);
        const float f[8] = {bflo(w.x), bfhi(w.x), bflo(w.y), bfhi(w.y), bflo(w.z), bfhi(w.z), bflo(w.w), bfhi(w.w)};
        unsigned hi = 0u, lo = 0u;
#pragma unroll
        for (int j = 0; j < 8; ++j) { int q = (int)__builtin_rintf(f[j] * xs); q = q < -119 ? -119 : (q > 119 ? 119 : q);
            const int xl = ((q + 8) & 15) - 8, xh = (q - xl) >> 4;
            hi |= ((unsigned)xh & 15u) << (4 * j); lo |= ((unsigned)xl & 15u) << (4 * j); }
        XQH[(size_t)t * 256 + 32 * sl + c8] = hi; XQL[(size_t)t * 256 + 32 * sl + c8] = lo;
    }
}
#define PI_LOADROWS(buf, tab, ids, i0) do { _Pragma("unroll") for (int i_ = 0; i_ < 8; ++i_) buf[i_] = __builtin_amdgcn_raw_buffer_load_b128(tab, ids[(i0) + i_] * 1024 + (int)soff, 0, 0); } while (0)
#define PI_LOADIDS(ids, t) do { const char* ip_ = (const char*)PIDX + ((size_t)(t) * 128 + 16 * g) * 4; _Pragma("unroll") for (int c_ = 0; c_ < 4; ++c_) { const v4u q_ = *(const GAS v4u*)(ip_ + 16 * c_); \
        ids[4 * c_] = (int)q_.x; ids[4 * c_ + 1] = (int)q_.y; ids[4 * c_ + 2] = (int)q_.z; ids[4 * c_ + 3] = (int)q_.w; } } while (0)
#define PI_UGROUP(buf, i0) do { _Pragma("unroll") for (int i_ = 0; i_ < 8; ++i_) { int ah_ = 0, al_ = 0; \
        _Pragma("unroll") for (int c_ = 0; c_ < 4; ++c_) { ah_ = __builtin_amdgcn_sdot8((int)buf[i_][c_], (int)xh[c_], ah_, false); al_ = __builtin_amdgcn_sdot8((int)buf[i_][c_], (int)xl[c_], al_, false); } \
        int p_ = 16 * ah_ + al_; p_ += __builtin_amdgcn_ds_bpermute((lane ^ 1) << 2, p_); p_ += __builtin_amdgcn_ds_bpermute((lane ^ 2) << 2, p_); p_ += __builtin_amdgcn_ds_bpermute((lane ^ 4) << 2, p_); \
        if (m == (((i0) + i_) >> 1)) { if (((i0) + i_) & 1) keep1 = p_; else keep0 = p_; } } } while (0)
#define PI_LOADROWS16(buf, tab, ids) do { _Pragma("unroll") for (int i_ = 0; i_ < 16; ++i_) buf[i_] = __builtin_amdgcn_raw_buffer_load_b128(tab, ids[i_] * 1024 + (int)soff, 0, 0); } while (0)
#define PI_LOADX(xh_, xl_, t) do { xh_ = *(const GAS v4u*)((const char*)XQH + (size_t)(t) * 1024 + soff); xl_ = *(const GAS v4u*)((const char*)XQL + (size_t)(t) * 1024 + soff); } while (0)
#define PI_COMPUTE16(buf, xh_, xl_, t) do { int keep0 = 0, keep1 = 0; \
        _Pragma("unroll") for (int i_ = 0; i_ < 16; ++i_) { int ah_ = 0, al_ = 0; \
            _Pragma("unroll") for (int c_ = 0; c_ < 4; ++c_) { ah_ = __builtin_amdgcn_sdot8((int)buf[i_][c_], (int)xh_[c_], ah_, false); al_ = __builtin_amdgcn_sdot8((int)buf[i_][c_], (int)xl_[c_], al_, false); } \
            int p_ = 16 * ah_ + al_; p_ += __builtin_amdgcn_update_dpp(0, p_, 0xB1, 0xf, 0xf, true); p_ += __builtin_amdgcn_update_dpp(0, p_, 0x4E, 0xf, 0xf, true); p_ += __builtin_amdgcn_update_dpp(0, p_, 0x141, 0xf, 0xf, true);   \
            if (m == (i_ >> 1)) { if (i_ & 1) keep1 = p_; else keep0 = p_; } } \
        if ((t) < T) *(GAS v2u*)(PARTI + ((size_t)s * T + (t)) * 128 + 2 * lane) = (v2u){(unsigned)keep0, (unsigned)keep1}; } while (0)
__device__ __forceinline__ void peer_u_phase_i4(const unsigned* XQH, const unsigned* XQL, const unsigned char* PU, const int* PIDX, int* PARTI, int bid, int G, int wave, int lane) {
    const int s = bid & 7, nr = (G - s + 7) >> 3, q = (bid >> 3) * NWAVES + wave, stride = nr * NWAVES, g = lane >> 3, m = lane & 7;
    const unsigned soff = 128u * (unsigned)s + 16u * (unsigned)m;
    if (q >= T) return;
    const __amdgpu_buffer_rsrc_t PUr = __builtin_amdgcn_make_buffer_rsrc((void*)PU, 0, PEER_N * 1024, 0x00020000);
#define PI_CL(t) ((t) < T ? (t) : T - 1)
    int I1[16], I2[16]; v4u xh0, xl0, xh1, xl1, xh2, xl2, RA[16], RB[16];
    PI_LOADIDS(I1, q); PI_LOADX(xh0, xl0, q);
    PI_LOADROWS16(RA, PUr, I1);
    PI_LOADIDS(I1, PI_CL(q + stride)); PI_LOADX(xh1, xl1, PI_CL(q + stride));
    for (int t = q; t < T; t += 2 * stride) {
        PI_LOADROWS16(RB, PUr, I1);
        PI_LOADIDS(I2, PI_CL(t + 2 * stride)); PI_LOADX(xh2, xl2, PI_CL(t + 2 * stride));
        PI_COMPUTE16(RA, xh0, xl0, t);
        PI_LOADROWS16(RA, PUr, I2);
        PI_LOADIDS(I1, PI_CL(t + 3 * stride)); PI_LOADX(xh0, xl0, PI_CL(t + 3 * stride));
        PI_COMPUTE16(RB, xh1, xl1, t + stride);
        xh1 = xh0; xl1 = xl0; xh0 = xh2; xl0 = xl2;
    }
#undef PI_CL
}


constexpr float PV_SCALE4S = 5.65f;
__device__ __forceinline__ unsigned enc_e2m1s(float v) {
    const float a = fabsf(v);
    const unsigned code = a < 0.25f ? 0u : a < 0.75f ? 1u : a < 1.25f ? 2u : a < 1.75f ? 3u : a < 2.5f ? 4u : a < 3.5f ? 5u : a < 5.0f ? 6u : 7u;
    return code | (v < 0.f ? 8u : 0u);
}
__device__ __forceinline__ void convert_fp4_plain(const float* src, unsigned char* dst, int nrows, float scale, const float* gain, int gw, int NGW, int lane) {
    for (int r0 = 2 * gw; r0 < nrows; r0 += 2 * NGW) {
        f32x4 a[2][8];
#pragma unroll
        for (int q = 0; q < 2; ++q) { const float* sp = src + (size_t)(r0 + q) * DM + 4 * lane;
#pragma unroll
            for (int j = 0; j < 8; ++j) a[q][j] = *(const GAS f32x4*)(sp + 256 * j); }
#pragma unroll
        for (int q = 0; q < 2; ++q) { const int r = r0 + q; const float* gp = gain ? gain + (size_t)(r / PEER_N) * DM + 4 * lane : nullptr;
#pragma unroll
            for (int j = 0; j < 8; ++j) { f32x4 v = a[q][j] * scale; if (gp) v = v * *(const GAS f32x4*)(gp + 256 * j);
                const unsigned w = enc_e2m1s(v[0]) | (enc_e2m1s(v[1]) << 4) | (enc_e2m1s(v[2]) << 8) | (enc_e2m1s(v[3]) << 12);
                *(GAS unsigned short*)(dst + (size_t)r * 1024 + 128 * j + 2 * lane) = (unsigned short)w; } }
    }
}
#define PVS_LOADMETA(ids, pp, gg, t) do { PI_LOADIDS(ids, t); _Pragma("unroll") for (int sp_ = 0; sp_ < 8; ++sp_) pp[sp_] = *(const GAS v2u*)(PARTI + ((size_t)sp_ * T + (t)) * 128 + 2 * lane); \
        gg = *(const GAS f32x2*)(PGATE + (size_t)(t) * 128 + 2 * lane); } while (0)
#define PVS_COMPUTE16(buf, pp, gg, t) do { float w0, w1; { int s0_ = 0, s1_ = 0; _Pragma("unroll") for (int sp_ = 0; sp_ < 8; ++sp_) { s0_ += (int)pp[sp_].x; s1_ += (int)pp[sp_].y; } \
            const float d0_ = (float)s0_ * (1.f / (PX_SCALEI * PU_SCALEI)), d1_ = (float)s1_ * (1.f / (PX_SCALEI * PU_SCALEI)); \
            w0 = gg.x * 0.5f * d0_ * (1.f + erff(d0_ * 0.70710678118654752f)) * (1.f / PV_SCALE4S); w1 = gg.y * 0.5f * d1_ * (1.f + erff(d1_ * 0.70710678118654752f)) * (1.f / PV_SCALE4S); } \
        f32x2 y[16]; _Pragma("unroll") for (int i_ = 0; i_ < 16; ++i_) y[i_] = (f32x2){0.f, 0.f}; \
        _Pragma("unroll") for (int i_ = 0; i_ < 16; ++i_) { \
            const float w_ = __builtin_bit_cast(float, __builtin_amdgcn_ds_bpermute(((lane & 56) | (i_ >> 1)) << 2, __builtin_bit_cast(int, (i_ & 1) ? w1 : w0))); const f32x2 wv_ = {w_, w_}; \
            _Pragma("unroll") for (int c_ = 0; c_ < 4; ++c_) { const unsigned u_ = buf[i_][c_]; \
                y[4 * c_ + 0] += __builtin_amdgcn_cvt_scalef32_pk_f32_fp4(u_, 1.0f, 0) * wv_; y[4 * c_ + 1] += __builtin_amdgcn_cvt_scalef32_pk_f32_fp4(u_, 1.0f, 1) * wv_; \
                y[4 * c_ + 2] += __builtin_amdgcn_cvt_scalef32_pk_f32_fp4(u_, 1.0f, 2) * wv_; y[4 * c_ + 3] += __builtin_amdgcn_cvt_scalef32_pk_f32_fp4(u_, 1.0f, 3) * wv_; } } \
        {   LAS float* wp_ = yl + g * 288 + m * 36; \
            _Pragma("unroll") for (int c_ = 0; c_ < 8; ++c_) *(LAS f32x4*)(wp_ + 4 * c_) = (f32x4){y[2 * c_].x, y[2 * c_].y, y[2 * c_ + 1].x, y[2 * c_ + 1].y}; \
            LDS_WAIT(); asm volatile("" ::: "memory"); \
            f32x4 acc_ = {0.f, 0.f, 0.f, 0.f}; const LAS float* rp_ = yl + (lane >> 3) * 36 + 4 * (lane & 7); \
            _Pragma("unroll") for (int gg_ = 0; gg_ < 8; ++gg_) acc_ += *(const LAS f32x4*)(rp_ + gg_ * 288); \
            LDS_WAIT(); asm volatile("" ::: "memory"); \
            if ((t) < T) { bf16* xp_ = XN + (size_t)(t) * DM + 256 * s + 4 * lane; const v2u a_ = *(const GAS v2u*)xp_; \
                const f32x4 v_ = (f32x4){bflo(a_.x), bfhi(a_.x), bflo(a_.y), bfhi(a_.y)} + acc_; \
                *(GAS v2u*)xp_ = (v2u){pk2(v_[0], v_[1]), pk2(v_[2], v_[3])}; \
                if (Xout) *(GAS f32x4*)(Xout + (size_t)(t) * DM + 256 * s + 4 * lane) = v_; \
                if (rowsq_out) { const float ss_ = wave_sum((v_[0] * v_[0] + v_[1] * v_[1]) + (v_[2] * v_[2] + v_[3] * v_[3]), lane); if (lane == 0) atomicAdd(rowsq_out + (t), rowsq_fx(ss_)); } } } } while (0)
__device__ __forceinline__ void peer_v_phase_s(bf16* XN, const unsigned char* PV, const int* PIDX, const float* PGATE, const int* PARTI, float* Xout, u64_t* rowsq_out, LAS float* yl, int bid, int G, int wave, int lane) {
    const int s = bid & 7, nr = (G - s + 7) >> 3, q = (bid >> 3) * NWAVES + wave, stride = nr * NWAVES, g = lane >> 3, m = lane & 7;
    const unsigned soff = 128u * (unsigned)s + 16u * (unsigned)m;
    if (q >= T) return;
    const __amdgpu_buffer_rsrc_t PVr = __builtin_amdgcn_make_buffer_rsrc((void*)PV, 0, PEER_N * 1024, 0x00020000);
#define PVS_CL(t) ((t) < T ? (t) : T - 1)
    int I0[16], I1[16]; v2u P0[8], P1[8]; f32x2 G0, G1; v4u RA[16], RB[16];
#define PVS_LOADPG(pp, gg, t) do { _Pragma("unroll") for (int sp_ = 0; sp_ < 8; ++sp_) pp[sp_] = *(const GAS v2u*)(PARTI + ((size_t)sp_ * T + (t)) * 128 + 2 * lane); gg = *(const GAS f32x2*)(PGATE + (size_t)(t) * 128 + 2 * lane); } while (0)
    PI_LOADIDS(I0, q); PVS_LOADPG(P0, G0, q);
    PI_LOADROWS16(RA, PVr, I0);
    PI_LOADIDS(I1, PVS_CL(q + stride)); PVS_LOADPG(P1, G1, PVS_CL(q + stride));
    for (int t = q; t < T; t += 2 * stride) {
        PI_LOADROWS16(RB, PVr, I1);
        PI_LOADIDS(I0, PVS_CL(t + 2 * stride));
        PVS_COMPUTE16(RA, P0, G0, t);
        PVS_LOADPG(P0, G0, PVS_CL(t + 2 * stride));
        PI_LOADROWS16(RA, PVr, I0);
        PI_LOADIDS(I1, PVS_CL(t + 3 * stride));
        PVS_COMPUTE16(RB, P1, G1, t + stride);
        PVS_LOADPG(P1, G1, PVS_CL(t + 3 * stride));
    }
#undef PVS_LOADPG
#undef PVS_CL
}

typedef short s16x4 __attribute__((ext_vector_type(4)));
typedef __attribute__((address_space(3))) const char* lds_cptr;
__device__ __forceinline__ s16x4 vtr(lds_cptr p) { return __builtin_bit_cast(s16x4, __builtin_amdgcn_ds_read_tr16_b64_v4i16((__attribute__((address_space(3))) s16x4*)p)); }
__device__ __forceinline__ unsigned cvtpk(float lo, float hi) { unsigned r; asm("v_cvt_pk_bf16_f32 %0, %1, %2" : "=v"(r) : "v"(lo), "v"(hi)); return r; }
constexpr int AT_K0 = 0, AT_V0 = 16384, AT_TAB = 32768;
constexpr float LOG2E = 1.4426950408889634f;
template <int TYPE>
__device__ __forceinline__ void attn_unit(LAS unsigned char* lds, const bf16* QKV, bf16* ATT, int b, int head, int qb, const float* tabsrc, float Cl2, float sinkl2, int tid) {
    const int lane = tid & 63, w = __builtin_amdgcn_readfirstlane(tid >> 6), hh = lane >> 5, l31 = lane & 31;
    int qcol, kcol, vcol, ocol;
    if (TYPE == 0) { qcol = QA + head * 64; kcol = KA + (head / 3) * 64; vcol = VA + (head / 3) * 64; ocol = OA + head * 64; }
    else if (TYPE == 1) { qcol = QB + head * 64; kcol = KB + head * 64; vcol = VB + head * 64; ocol = OB + head * 64; }
    else { qcol = QC + head * 64; kcol = KC + (head / 3) * 64; vcol = VC + (head / 3) * 64; ocol = OC + head * 64; }
    const int q0 = 256 * qb + 32 * w, qpos = q0 + l31;
    int t_begin, t_end;
    if (TYPE == 0) { t_begin = 4 * qb - 2; if (t_begin < 0) t_begin = 0; t_end = 4 * qb + 6; if (t_end > 32) t_end = 32; }
    else if (TYPE == 1) { int a = 4 * qb - 4; a = a < 0 ? 0 : (a > 24 ? 24 : a); int e = 4 * qb - 1; e = e < 0 ? 0 : (e > 24 ? 24 : e); t_begin = a; t_end = e + 8; }
    else { t_begin = 0; t_end = 32; }
    LAS float* tab = (LAS float*)(lds + AT_TAB);
    if (TYPE == 0) { for (int i = tid; i < 1024; i += NTHREADS) { const int rel = i - 448; tab[i] = (rel >= -128 && rel <= 128) ? tabsrc[head * 257 + rel + 128] * LOG2E - Cl2 : -1e30f; } }
    if (TYPE == 1) { for (int i = tid; i < 15 * 31; i += NTHREADS) tab[i] = tabsrc[head * 465 + i] * LOG2E - Cl2; }
    bf16x8 qf[4];
    {   const bf16* qp = QKV + ((size_t)b * SEQ + qpos) * DIN + qcol + 8 * hh;
#pragma unroll
        for (int s = 0; s < 4; ++s) qf[s] = *(const GAS bf16x8*)(qp + 16 * s); }
    const int srow = tid >> 3, sch = tid & 7;
    const bf16* kg = QKV + ((size_t)b * SEQ + srow) * DIN + kcol + sch * 8;
    const bf16* vg = QKV + ((size_t)b * SEQ + srow) * DIN + vcol + sch * 8;
    const int kst = srow * 128 + ((sch ^ ((srow >> 1) & 7)) * 16);
    const int vst = srow * 128 + (((sch >> 2) ^ ((srow >> 1) & 1)) * 64) + (sch & 3) * 16;
    int kread[4], vread[2];
#pragma unroll
    for (int s = 0; s < 4; ++s) kread[s] = l31 * 128 + (((2 * s + hh) ^ ((lane >> 1) & 7)) * 16);
#pragma unroll
    for (int db = 0; db < 2; ++db) vread[db] = (4 * hh + ((lane >> 2) & 3)) * 128 + ((db ^ ((lane >> 3) & 1)) * 64) + 32 * ((lane >> 4) & 1) + 8 * (lane & 3);
    f32x16 O0, O1;
#pragma unroll
    for (int r = 0; r < 16; ++r) { O0[r] = 0.f; O1[r] = 0.f; }
    float lsum = 0.f;
    const int rw = 4 * qb + (w >> 1), cq = 32 * (w & 1) + l31;
    int r0w = rw - 4; r0w = r0w < 0 ? 0 : (r0w > 24 ? 24 : r0w);
    int c0 = cq - 8; c0 = c0 < 0 ? 0 : (c0 > 48 ? 48 : c0);
    {   const v4u kr = *(const GAS v4u*)(kg + (size_t)t_begin * 64 * DIN), vr = *(const GAS v4u*)(vg + (size_t)t_begin * 64 * DIN);
        *(LAS v4u*)(lds + AT_K0 + kst) = kr; *(LAS v4u*)(lds + AT_V0 + vst) = vr; }
    __syncthreads();
    for (int t = t_begin; t < t_end; ++t) {
        const int cur = (t - t_begin) & 1;
        v4u kr, vr;
        if (t + 1 < t_end) { kr = *(const GAS v4u*)(kg + (size_t)(t + 1) * 64 * DIN); vr = *(const GAS v4u*)(vg + (size_t)(t + 1) * 64 * DIN); }
        bool need = true;
        if (TYPE == 0) need = (64 * t <= q0 + 31 + 128) && (64 * t + 63 >= q0 - 128);
        if (TYPE == 1) need = (t >= r0w) && (t < r0w + 8);
        if (need) {
            const lds_cptr kb_ = (lds_cptr)(lds + AT_K0 + cur * 8192), vb_ = (lds_cptr)(lds + AT_V0 + cur * 8192);
            bf16x8 kf[8];
#pragma unroll
            for (int s = 0; s < 4; ++s) { kf[2 * s] = *(const LAS bf16x8*)(kb_ + kread[s]); kf[2 * s + 1] = *(const LAS bf16x8*)(kb_ + kread[s] + 4096); }
            f32x16 S0, S1;
            if (TYPE == 2) {
#pragma unroll
                for (int r = 0; r < 16; ++r) { S0[r] = -Cl2; S1[r] = -Cl2; }
            } else if (TYPE == 0) {
                const LAS float* tb = tab + (64 * t - qpos + 448 + 4 * hh);
#pragma unroll
                for (int r = 0; r < 16; ++r) { S0[r] = tb[8 * (r >> 2) + (r & 3)]; S1[r] = tb[32 + 8 * (r >> 2) + (r & 3)]; }
            } else {
                const LAS float* tb = tab + ((t - rw + 7) * 31 - cq + 15 + 4 * hh);
                const int kc0 = 4 * hh - c0;
#pragma unroll
                for (int r = 0; r < 16; ++r) { const int ka = 8 * (r >> 2) + (r & 3), kb2 = 32 + ka;
                    S0[r] = ((unsigned)(ka + kc0) < 16u) ? tb[ka] : -1e30f; S1[r] = ((unsigned)(kb2 + kc0) < 16u) ? tb[kb2] : -1e30f; }
            }
            __builtin_amdgcn_sched_barrier(0);
#pragma unroll
            for (int s = 0; s < 4; ++s) { S0 = __builtin_amdgcn_mfma_f32_32x32x16_bf16(kf[2 * s], qf[s], S0, 0, 0, 0); S1 = __builtin_amdgcn_mfma_f32_32x32x16_bf16(kf[2 * s + 1], qf[s], S1, 0, 0, 0); }
            s16x4 vf[4][2][2];
#pragma unroll
            for (int ks = 0; ks < 2; ++ks)
#pragma unroll
                for (int db = 0; db < 2; ++db) { vf[ks][db][0] = vtr(vb_ + vread[db] + (16 * ks) * 128); vf[ks][db][1] = vtr(vb_ + vread[db] + (16 * ks + 8) * 128); }
            __builtin_amdgcn_sched_barrier(0);
#pragma unroll
            for (int r = 0; r < 16; ++r) { S0[r] = __builtin_amdgcn_exp2f(S0[r]); S1[r] = __builtin_amdgcn_exp2f(S1[r]); }
#pragma unroll
            for (int r = 0; r < 16; ++r) lsum += S0[r] + S1[r];
            bf16x8 pb[4];
#pragma unroll
            for (int hf = 0; hf < 2; ++hf) {
                v4u a, c;
#pragma unroll
                for (int j = 0; j < 4; ++j) { a[j] = cvtpk(S0[8 * hf + 2 * j], S0[8 * hf + 2 * j + 1]); c[j] = cvtpk(S1[8 * hf + 2 * j], S1[8 * hf + 2 * j + 1]); }
                pb[hf] = __builtin_bit_cast(bf16x8, a); pb[2 + hf] = __builtin_bit_cast(bf16x8, c);
            }
#pragma unroll
            for (int ks = 2; ks < 4; ++ks)
#pragma unroll
                for (int db = 0; db < 2; ++db) { vf[ks][db][0] = vtr(vb_ + vread[db] + (16 * ks) * 128); vf[ks][db][1] = vtr(vb_ + vread[db] + (16 * ks + 8) * 128); }
            __builtin_amdgcn_sched_barrier(0);
#pragma unroll
            for (int ks = 0; ks < 4; ++ks) {
                const bf16x8 va = __builtin_shufflevector(vf[ks][0][0], vf[ks][0][1], 0, 1, 2, 3, 4, 5, 6, 7), vb2 = __builtin_shufflevector(vf[ks][1][0], vf[ks][1][1], 0, 1, 2, 3, 4, 5, 6, 7);
                O0 = __builtin_amdgcn_mfma_f32_32x32x16_bf16(va, pb[ks], O0, 0, 0, 0); O1 = __builtin_amdgcn_mfma_f32_32x32x16_bf16(vb2, pb[ks], O1, 0, 0, 0);
            }
        }
        __builtin_amdgcn_sched_barrier(0);
        if (t + 1 < t_end) { *(LAS v4u*)(lds + AT_K0 + (cur ^ 1) * 8192 + kst) = kr; *(LAS v4u*)(lds + AT_V0 + (cur ^ 1) * 8192 + vst) = vr; }
        __syncthreads();
    }
    lsum += shx(lsum, 32, lane);
    if (TYPE == 0) lsum += __builtin_amdgcn_exp2f(sinkl2 - Cl2);
    const float inv = 1.f / lsum;
    bf16* op = ATT + ((size_t)b * SEQ + qpos) * DM + ocol + 4 * hh;
#pragma unroll
    for (int g4 = 0; g4 < 4; ++g4) {
        v2u o0, o1; o0.x = cvtpk(O0[4 * g4] * inv, O0[4 * g4 + 1] * inv); o0.y = cvtpk(O0[4 * g4 + 2] * inv, O0[4 * g4 + 3] * inv);
        o1.x = cvtpk(O1[4 * g4] * inv, O1[4 * g4 + 1] * inv); o1.y = cvtpk(O1[4 * g4 + 2] * inv, O1[4 * g4 + 3] * inv);
        *(GAS v2u*)(op + 8 * g4) = o0; *(GAS v2u*)(op + 32 + 8 * g4) = o1;
    }
}


constexpr int MA_K0 = 0, MA_V0 = 32768;
__device__ __forceinline__ void mem_unit(LAS unsigned char* lds, const bf16* QM, const bf16* KVM, bf16* OM, const float* gq, int tb, int head, float Cl2, int tid) {
    const int lane = tid & 63, w = __builtin_amdgcn_readfirstlane(tid >> 6), hh = lane >> 5, l31 = lane & 31;
    const size_t trow = (size_t)tb * 256 + 32 * w + l31; const int b = tb >> 3;
    bf16x8 qf[8];
    {   const bf16* qp = QM + trow * MEMW + head * 128 + 8 * hh;
#pragma unroll
        for (int s = 0; s < 8; ++s) qf[s] = *(const GAS bf16x8*)(qp + 16 * s);
        float ss = 0.f;
#pragma unroll
        for (int s = 0; s < 8; ++s)
#pragma unroll
            for (int j = 0; j < 8; ++j) { const float f = __builtin_bit_cast(float, (unsigned)(unsigned short)qf[s][j] << 16); ss += f * f; }
        ss += shx(ss, 32, lane);
        const float r = 0.12751743074602468f / sqrtf(ss * (1.f / 128.f) + EPS);
#pragma unroll
        for (int s = 0; s < 8; ++s) { const f32x4 g0 = *(const GAS f32x4*)(gq + 16 * s + 8 * hh), g1 = *(const GAS f32x4*)(gq + 16 * s + 8 * hh + 4);
            v4u o;
#pragma unroll
            for (int j = 0; j < 4; ++j) { const float f0 = __builtin_bit_cast(float, (unsigned)(unsigned short)qf[s][2 * j] << 16), f1 = __builtin_bit_cast(float, (unsigned)(unsigned short)qf[s][2 * j + 1] << 16);
                const float ga = (2 * j < 4) ? g0[2 * j] : g1[2 * j - 4], gb2 = (2 * j + 1 < 4) ? g0[2 * j + 1] : g1[2 * j + 1 - 4];
                o[j] = cvtpk(f0 * r * ga, f1 * r * gb2); }
            qf[s] = __builtin_bit_cast(bf16x8, o); }
    }
    const int srow = tid >> 3, sch = tid & 7;
    const bf16* kg = KVM + ((size_t)b * NMEM + srow) * 1024 + head * 128 + sch * 8;
    const bf16* vg = kg + 512;
    const int kst0 = srow * 256 + ((sch ^ (srow & 15)) * 16), kst1 = srow * 256 + (((sch + 8) ^ (srow & 15)) * 16);
    const int vst0 = srow * 256 + ((((sch) >> 2) ^ (srow & 3)) * 64) + (sch & 3) * 16, vst1 = srow * 256 + ((((sch + 8) >> 2) ^ (srow & 3)) * 64) + (sch & 3) * 16;
    int kread[8], vread[4];
#pragma unroll
    for (int s = 0; s < 8; ++s) kread[s] = l31 * 256 + (((2 * s + hh) ^ (l31 & 15)) * 16);
#pragma unroll
    for (int db = 0; db < 4; ++db) vread[db] = (4 * hh + ((lane >> 2) & 3)) * 256 + ((db ^ ((lane >> 2) & 3)) * 64) + 32 * ((lane >> 4) & 1) + 8 * (lane & 3);
    f32x16 O[4];
#pragma unroll
    for (int db = 0; db < 4; ++db)
#pragma unroll
        for (int r = 0; r < 16; ++r) O[db][r] = 0.f;
    float lsum = 0.f;
    {   const v4u k0 = *(const GAS v4u*)kg, k1 = *(const GAS v4u*)(kg + 64), v0 = *(const GAS v4u*)vg, v1 = *(const GAS v4u*)(vg + 64);
        *(LAS v4u*)(lds + MA_K0 + kst0) = k0; *(LAS v4u*)(lds + MA_K0 + kst1) = k1; *(LAS v4u*)(lds + MA_V0 + vst0) = v0; *(LAS v4u*)(lds + MA_V0 + vst1) = v1; }
    __syncthreads();
#pragma unroll 1
    for (int t = 0; t < 4; ++t) {
        const int cur = t & 1;
        v4u k0, k1, v0, v1;
        if (t + 1 < 4) { const bf16* kn = kg + (size_t)(t + 1) * 64 * 1024; k0 = *(const GAS v4u*)kn; k1 = *(const GAS v4u*)(kn + 64); v0 = *(const GAS v4u*)(kn + 512); v1 = *(const GAS v4u*)(kn + 576); }
        const lds_cptr kb_ = (lds_cptr)(lds + MA_K0 + cur * 16384), vb_ = (lds_cptr)(lds + MA_V0 + cur * 16384);
        f32x16 S0, S1;
#pragma unroll
        for (int r = 0; r < 16; ++r) { S0[r] = -Cl2; S1[r] = -Cl2; }
#pragma unroll
        for (int s = 0; s < 8; ++s) { const bf16x8 a0 = *(const LAS bf16x8*)(kb_ + kread[s]), a1 = *(const LAS bf16x8*)(kb_ + kread[s] + 8192);
            S0 = __builtin_amdgcn_mfma_f32_32x32x16_bf16(a0, qf[s], S0, 0, 0, 0); S1 = __builtin_amdgcn_mfma_f32_32x32x16_bf16(a1, qf[s], S1, 0, 0, 0); }
#pragma unroll
        for (int r = 0; r < 16; ++r) { S0[r] = __builtin_amdgcn_exp2f(S0[r]); S1[r] = __builtin_amdgcn_exp2f(S1[r]); lsum += S0[r] + S1[r]; }
        bf16x8 pb[4];
#pragma unroll
        for (int hf = 0; hf < 2; ++hf) {
            v4u a, c;
#pragma unroll
            for (int j = 0; j < 4; ++j) { a[j] = cvtpk(S0[8 * hf + 2 * j], S0[8 * hf + 2 * j + 1]); c[j] = cvtpk(S1[8 * hf + 2 * j], S1[8 * hf + 2 * j + 1]); }
            pb[hf] = __builtin_bit_cast(bf16x8, a); pb[2 + hf] = __builtin_bit_cast(bf16x8, c);
        }
#pragma unroll
        for (int ks = 0; ks < 4; ++ks)
#pragma unroll
            for (int db = 0; db < 4; ++db) {
                const s16x4 a0 = vtr(vb_ + vread[db] + (16 * ks) * 256), a1 = vtr(vb_ + vread[db] + (16 * ks + 8) * 256);
                const bf16x8 va = __builtin_shufflevector(a0, a1, 0, 1, 2, 3, 4, 5, 6, 7);
                O[db] = __builtin_amdgcn_mfma_f32_32x32x16_bf16(va, pb[ks], O[db], 0, 0, 0);
            }
        if (t + 1 < 4) { LAS unsigned char* kn = lds + MA_K0 + (cur ^ 1) * 16384; LAS unsigned char* vn = lds + MA_V0 + (cur ^ 1) * 16384;
            *(LAS v4u*)(kn + kst0) = k0; *(LAS v4u*)(kn + kst1) = k1; *(LAS v4u*)(vn + vst0) = v0; *(LAS v4u*)(vn + vst1) = v1; }
        __syncthreads();
    }
    lsum += shx(lsum, 32, lane);
    const float inv = 1.f / lsum;
    bf16* op = OM + trow * MEMW + head * 128 + 4 * hh;
#pragma unroll
    for (int db = 0; db < 4; ++db)
#pragma unroll
        for (int g4 = 0; g4 < 4; ++g4) { v2u o; o.x = cvtpk(O[db][4 * g4] * inv, O[db][4 * g4 + 1] * inv); o.y = cvtpk(O[db][4 * g4 + 2] * inv, O[db][4 * g4 + 3] * inv); *(GAS v2u*)(op + 32 * db + 8 * g4) = o; }
}

__device__ __forceinline__ float wave_max(float v, int lane) {
#pragma unroll
    for (int o = 1; o < 64; o <<= 1) v = fmaxf(v, shx(v, o, lane));
    return v;
}
struct Args { const float* in[23]; float* out; unsigned char* ws; int ph_lo, ph_hi, use_bar, pad; };
#ifndef MK_OFF
#define MK_OFF 0u
#endif
#ifndef REP_ATT
#define REP_ATT 1
#endif
#ifndef REP_P0
#define REP_P0 1
#endif
#ifndef REP_U
#define REP_U 1
#endif
#ifndef REP_GEMM
#define REP_GEMM 1
#endif
#ifndef REP_NORM
#define REP_NORM 1
#endif
#ifndef REP_SEL
#define REP_SEL 1
#endif
#ifndef REP_MEM
#define REP_MEM 1
#endif
#define PHON(k) (!((MK_OFF >> (k)) & 1u))
constexpr int PH_PER_LAYER = 11, PH_BASE = 3, N_PHASES = PH_BASE + DEPTH * PH_PER_LAYER;
constexpr int PTAB_OFF = LDSCTL_OFF + 1024;

__global__ void __launch_bounds__(NTHREADS, 2) mega(Args a) {
    extern __shared__ __attribute__((aligned(16))) unsigned char lds_raw[];
    LAS unsigned char* lds = (LAS unsigned char*)lds_raw;
    {   const int tid0 = threadIdx.x;
        for (int u = tid0; u < (LDS_BYTES - LDSCTL_OFF) / 4; u += NTHREADS) ((LAS unsigned*)(lds + LDSCTL_OFF))[u] = 0u;
        __syncthreads();
        if (tid0 < 23) ((LAS unsigned long long*)(lds + PTAB_OFF))[tid0] = (unsigned long long)a.in[tid0];
        if (tid0 == 23) ((LAS unsigned long long*)(lds + PTAB_OFF))[23] = (unsigned long long)a.out;
        if (tid0 == 24) ((LAS unsigned long long*)(lds + PTAB_OFF))[24] = (unsigned long long)a.ws;
        __syncthreads();
    }
    volatile LAS unsigned* MISC = (volatile LAS unsigned*)(lds + MISC_OFF);
    const int G = gridDim.x, bid = blockIdx.x, NGW = G * NWAVES;
    const int use_bar = a.use_bar;
    XcdBarrier bar; bar.bar = (unsigned*)(a.ws + WS_CTL) + CW_BAR; bar.x = 0; bar.st = MISC + 8;
    if (use_bar) bar = xcd_barrier_post((unsigned*)(a.ws + WS_CTL) + CW_BAR, MISC + 8);
    const int lo = a.ph_lo, hi = a.ph_hi;
#define IN(k) (lo <= (k) && (k) < hi)
#define SEAM(k) do { if (use_bar && IN(k) && IN((k) + 1)) xcd_barrier(bar); } while (0)
#define PHL() int tid_ = threadIdx.x; asm volatile("" : "+v"(tid_)); const int lane_ = tid_ & 63, wave_ = __builtin_amdgcn_readfirstlane(tid_ >> 6), gw_ = bid * NWAVES + wave_; (void)lane_; (void)gw_; \
              int pz_ = 0; asm volatile("" : "+s"(pz_))
#define PTR(i) ((const float*)ldptr(lds, (i) + pz_))
#define WSP() ((unsigned char*)ldptr(lds, 24 + pz_))
#define OUTP() ((float*)ldptr(lds, 23 + pz_))

    if (IN(0) && PHON(0)) for (int rep_ = 0; rep_ < REP_P0; ++rep_) {
        PHL(); unsigned char* ws = WSP();
        LAS float* scr = (LAS float*)(lds + RING_OFF + wave_ * 16384);
        constexpr int I_IN = 32 * 128, I_OUT = 32 * 64, I_MQ = 32 * 16, I_MKV = 32 * 32, I_MO = 8 * 64, I_PQ = 32 * 64, I_L = I_IN + I_OUT + I_MQ + I_MKV + I_MO + I_PQ;
        for (int it = gw_; it < DEPTH * I_L; it += NGW) {
            const int l = it / I_L; int r = it % I_L;
            if (r < I_IN) { transpose_item<true>(PTR(4) + (size_t)l * DM * DIN, DM, DIN, (bf16*)(ws + WS_WIN) + (size_t)l * DIN * DM, scr, r, lane_, PTR(3) + (size_t)l * DM); continue; } r -= I_IN;
            if (r < I_OUT) { transpose_item<false>(PTR(11) + (size_t)l * DM * DM, DM, DM, (bf16*)(ws + WS_WOUT) + (size_t)l * DM * DM, scr, r, lane_); continue; } r -= I_OUT;
            if (r < I_MQ) { transpose_item<false>(PTR(14) + (size_t)l * DM * MEMW, DM, MEMW, (bf16*)(ws + WS_WMQ) + (size_t)l * MEMW * DM, scr, r, lane_, PTR(12) + (size_t)l * DM); continue; } r -= I_MQ;
            if (r < I_MKV) { transpose_item<false>(PTR(15) + (size_t)l * DM * 1024, DM, 1024, (bf16*)(ws + WS_WMKV) + (size_t)l * 1024 * DM, scr, r, lane_); continue; } r -= I_MKV;
            if (r < I_MO) { transpose_item<false>(PTR(17) + (size_t)l * MEMW * DM, MEMW, DM, (bf16*)(ws + WS_WMO) + (size_t)l * DM * MEMW, scr, r, lane_); continue; } r -= I_MO;
            transpose_item<false>(PTR(19) + (size_t)l * DM * DM, DM, DM, (bf16*)(ws + WS_WPQ) + (size_t)l * DM * DM, scr, r, lane_, PTR(18) + (size_t)l * DM);
        }
        const size_t gtid = (size_t)bid * NTHREADS + tid_, nth = (size_t)G * NTHREADS;
        convert_bf16(PTR(20), (bf16*)(ws + WS_PKEYS), (size_t)DEPTH * 8 * 2 * 128 * 128, gtid, nth);
        convert_int4_plain(PTR(21), ws + WS_PU, DEPTH * PEER_N, PU_SCALEI, PTR(18), gw_, NGW, lane_);
        convert_fp4_rows(PTR(22), ws + WS_PV, DEPTH * PEER_N, PV_SCALE4, nullptr, gw_, NGW, lane_);
        {   const float* x0 = PTR(0); bf16* XN = (bf16*)(ws + WS_XN); u64_t* rsq = (u64_t*)(ws + WS_ROWSQ);
            for (int m = 2 * gw_; m < T; m += 2 * NGW) prep_rows2(x0 + (size_t)m * DM, XN + (size_t)m * DM, rsq + m, lane_); }
        {   const float* mem = PTR(1); const float* gkv = PTR(13); bf16* MEMN = (bf16*)(ws + WS_MEMN);
            for (int m = gw_; m < BATCH * NMEM; m += NGW)
                rms_row_to_bf16(mem + (size_t)m * DM, gkv, MEMN + (size_t)m * DM, gkv + DM, MEMN + (size_t)(BATCH * NMEM + m) * DM, lane_); }
        float* rope = (float*)(ws + WS_ROPE); float* biasA = (float*)(ws + WS_BIASA);
        if (gtid < 64 * 16) { const int pos = (int)gtid >> 4, i = (int)gtid & 15; const float ang = (float)pos * ROPE_INV[i]; rope[gtid * 2] = cosf(ang); rope[gtid * 2 + 1] = sinf(ang); }
        if (gtid < 12 * 257) { const int h = (int)gtid / 257, rel = (int)gtid % 257 - 128; biasA[gtid] = PTR(2)[t5_bucket(rel) * 12 + h]; }
    }
    SEAM(0);
    if (IN(1) && PHON(1)) {
#pragma unroll 1
        for (int l = 0; l < DEPTH; ++l) {
            PHL(); unsigned char* ws = WSP();
            pg8::Gemm g{(bf16*)(ws + WS_MEMN) + (size_t)l * BATCH * NMEM * DM, (bf16*)(ws + WS_WMKV) + (size_t)l * 1024 * DM, BATCH * NMEM, 1024, DM};
            OffsetOrder S; S.init(BATCH * NMEM, 1024, G, bid, 64 * l);
            pg8::EpiBf16<0> E{(bf16*)(ws + WS_KVM) + (size_t)l * BATCH * NMEM * 1024, 1024, nullptr, 0, 0, 1.f};
            pg8::gemm_phase<pg8::EpiBf16<0>, OffsetOrder, true, true>(lds + RING_OFF, g, S, E, tid_);
            __syncthreads();
        }
    }
    SEAM(1);
    if (IN(2) && PHON(2)) {
        PHL(); unsigned char* ws = WSP(); bf16* KVM = (bf16*)(ws + WS_KVM); const float* gm = PTR(16);
#ifdef PROBE_INSTR
        {
            f32x2 a0 = {1.f + lane_, 2.f}, a1 = {3.f, 4.f}, a2 = {5.f, 6.f}, a3 = {7.f, 8.f}; unsigned u0 = tid_ * 2654435761u, u1 = u0 ^ 0x9e3779b9u; int i0 = (int)u0, i1 = (int)u1;
            v6u w6 = {u0, u1, u0 + 1, u1 + 1, u0 + 2, u1 + 2}; v32f f6; float e0 = 0.5f + lane_, e1 = 1.5f;
            for (int it = 0; it < 20000; ++it) {
#pragma unroll
                for (int k = 0; k < 8; ++k) {
#if PROBE_INSTR == 1
                    a0 = a0 * a1 + a2; a1 = a1 * a2 + a3; a2 = a2 * a3 + a0; a3 = a3 * a0 + a1;
#elif PROBE_INSTR == 2
                    a0 += __builtin_amdgcn_cvt_scalef32_pk_f32_fp4(u0, 1.0f, 0); a1 += __builtin_amdgcn_cvt_scalef32_pk_f32_fp4(u1, 1.0f, 1); a2 += __builtin_amdgcn_cvt_scalef32_pk_f32_fp4(u0, 1.0f, 2); a3 += __builtin_amdgcn_cvt_scalef32_pk_f32_fp4(u1, 1.0f, 3); u0 += 0x11111111u; u1 += 0x01010101u;
#elif PROBE_INSTR == 3
                    f6 = __builtin_amdgcn_cvt_scalef32_pk32_f32_fp6(w6, 1.0f); a0 += (f32x2){f6[0], f6[31]}; w6[0] += 0x11111111u; w6[5] += 0x01010101u;
#elif PROBE_INSTR == 4
                    e0 = __builtin_amdgcn_exp2f(e0); e1 = __builtin_amdgcn_exp2f(e1); e0 = e0 * 0.001f; e1 = e1 * 0.001f;
#else
                    i0 = __builtin_amdgcn_sdot8((int)u0, (int)u1, i0, false); i1 = __builtin_amdgcn_sdot8((int)u1, (int)u0, i1, false); u0 += 0x11111111u; u1 += 0x01010101u;
#endif
                }
            }
            const float chk = a0.x + a0.y + a1.x + a2.y + a3.x + e0 + e1 + (float)(i0 ^ i1);
            if (chk == 1.2345e-33f) *(float*)(ws + WS_BIASA + 15000) = chk;
        }
#endif
        for (int m = gw_; m < DEPTH * BATCH * NMEM; m += NGW) {
            const int l = m / (BATCH * NMEM);
            GAS v4u* p = (GAS v4u*)(KVM + (size_t)m * 1024 + 8 * lane_);
            const v4u w = *p;
            float f[8] = {bflo(w.x), bfhi(w.x), bflo(w.y), bfhi(w.y), bflo(w.z), bfhi(w.z), bflo(w.w), bfhi(w.w)};
            float ss = 0.f;
#pragma unroll
            for (int i = 0; i < 8; ++i) ss += f[i] * f[i];
            ss += shx(ss, 1, lane_); ss += shx(ss, 2, lane_); ss += shx(ss, 4, lane_); ss += shx(ss, 8, lane_);
            const float r = 1.f / sqrtf(ss * (1.f / 128.f) + EPS);
            const float* gk = gm + (size_t)l * 256 + 128 + 8 * (lane_ & 15);
            v4u o; o.x = pk2(f[0] * r * gk[0], f[1] * r * gk[1]); o.y = pk2(f[2] * r * gk[2], f[3] * r * gk[3]); o.z = pk2(f[4] * r * gk[4], f[5] * r * gk[5]); o.w = pk2(f[6] * r * gk[6], f[7] * r * gk[7]);
            *p = o;
        }
    }
    SEAM(2);

#pragma unroll 1
    for (int l = 0; l < DEPTH; ++l) {
        const int pb = PH_BASE + PH_PER_LAYER * l;
        if (IN(pb + 0) && PHON(3)) for (int rep_ = 0; rep_ < REP_GEMM; ++rep_) { PHL(); unsigned char* ws = WSP();
            pg8::Gemm g{(bf16*)(ws + WS_XN), (bf16*)(ws + WS_WIN) + (size_t)l * DIN * DM, T, DIN, DM}; pg8::StaticOrder S; S.init(T, DIN, G, bid);
            pg8::EpiQKV E{(bf16*)(ws + WS_QKV), PTR(5) + (size_t)l * 128, PTR(7) + (size_t)l * 128, PTR(9) + (size_t)l * 128, (const float*)(ws + WS_ROPE), (const u64_t*)(ws + WS_ROWSQ) + (size_t)(l * 3 + 0) * T};
            pg8::gemm_phase<pg8::EpiQKV, pg8::StaticOrder, true, true>(lds + RING_OFF, g, S, E, tid_);
        }
        SEAM(pb + 0);
        if (IN(pb + 1) && PHON(4)) for (int rep_ = 0; rep_ < REP_ATT; ++rep_) { PHL(); unsigned char* ws = WSP();
            const float* sink = PTR(6) + (size_t)l * 12; const float* rpb = PTR(8) + (size_t)l * 8 * 15 * 31; const float* biasA = (const float*)(ws + WS_BIASA);
            const bf16* QKV = (const bf16*)(ws + WS_QKV); bf16* ATT = (bf16*)(ws + WS_ATT);
            const float* ga = PTR(5) + (size_t)l * 128; const float* gb = PTR(7) + (size_t)l * 128; const float* gc = PTR(9) + (size_t)l * 128;
            const float CaL2 = 8.f * wave_max(fabsf(ga[lane_]), lane_) * wave_max(fabsf(ga[64 + lane_]), lane_) * LOG2E;
            const float CbL2 = 8.f * wave_max(fabsf(gb[lane_]), lane_) * wave_max(fabsf(gb[64 + lane_]), lane_) * LOG2E;
            const float CcL2 = 8.f * wave_max(fabsf(gc[lane_]), lane_) * wave_max(fabsf(gc[64 + lane_]), lane_) * LOG2E;
            const int vc = (G % 8 == 0) ? (bid % 8) * (G / 8) + bid / 8 : bid;
            for (int u = vc; u < BATCH * 12 * 8; u += G) attn_unit<2>(lds, QKV, ATT, u / 96, (u >> 3) % 12, u & 7, nullptr, CcL2, 0.f, tid_);
            for (int u = vc; u < BATCH * 8 * 8; u += G) attn_unit<1>(lds, QKV, ATT, u >> 6, (u >> 3) & 7, u & 7, rpb, CbL2, 0.f, tid_);
            for (int u = vc; u < BATCH * 12 * 8; u += G) { const int head = (u >> 3) % 12; attn_unit<0>(lds, QKV, ATT, u / 96, head, u & 7, biasA, CaL2, sink[head] * LOG2E, tid_); }
        }
        SEAM(pb + 1);
        if (IN(pb + 2) && PHON(5)) { PHL(); unsigned char* ws = WSP(); mixnorm_rows((bf16*)(ws + WS_ATT), PTR(10) + (size_t)l * DM, gw_, NGW, lane_); }
        SEAM(pb + 2);
        if (IN(pb + 3) && PHON(6)) { PHL(); unsigned char* ws = WSP();
            pg8::Gemm g{(bf16*)(ws + WS_ATT), (bf16*)(ws + WS_WOUT) + (size_t)l * DM * DM, T, DM, DM}; pg8::StaticOrder S; S.init(T, DM, G, bid);
            pg8::EpiResid E{(bf16*)(ws + WS_XN), DM, (u64_t*)(ws + WS_ROWSQ) + (size_t)(l * 3 + 1) * T};
            pg8::gemm_phase<pg8::EpiResid, pg8::StaticOrder, true, true>(lds + RING_OFF, g, S, E, tid_);
        }
        SEAM(pb + 3);
        if (IN(pb + 4) && PHON(7)) for (int rep_ = 0; rep_ < REP_GEMM; ++rep_) { PHL(); unsigned char* ws = WSP();
            pg8::Gemm g{(bf16*)(ws + WS_XN), (bf16*)(ws + WS_WMQ) + (size_t)l * MEMW * DM, T, MEMW, DM}; pg8::StaticOrder S; S.init(T, MEMW, G, bid);
            pg8::EpiBf16Row E{(bf16*)(ws + WS_QM), MEMW, (const u64_t*)(ws + WS_ROWSQ) + (size_t)(l * 3 + 1) * T};
            pg8::gemm_phase<pg8::EpiBf16Row, pg8::StaticOrder, true, true>(lds + RING_OFF, g, S, E, tid_);
        }
        SEAM(pb + 4);
        if (IN(pb + 5) && PHON(8)) for (int rep_ = 0; rep_ < REP_MEM; ++rep_) { PHL(); unsigned char* ws = WSP();
            const bf16* kvm = (const bf16*)(ws + WS_KVM) + (size_t)l * BATCH * NMEM * 1024; const float* gq = PTR(16) + (size_t)l * 256;
            const float CmL2 = 11.313708498984761f * wave_max(fmaxf(fabsf(gq[lane_]), fabsf(gq[64 + lane_])), lane_) * wave_max(fmaxf(fabsf(gq[128 + lane_]), fabsf(gq[192 + lane_])), lane_) * LOG2E;
            for (int u = bid; u < (T / 256) * 4; u += G) mem_unit(lds, (const bf16*)(ws + WS_QM), kvm, (bf16*)(ws + WS_OM), gq, u >> 2, u & 3, CmL2, tid_);
        }
        SEAM(pb + 5);
        if (IN(pb + 6) && PHON(9)) { PHL(); unsigned char* ws = WSP();
            pg8::Gemm g{(bf16*)(ws + WS_OM), (bf16*)(ws + WS_WMO) + (size_t)l * DM * MEMW, T, DM, MEMW}; pg8::StaticOrder S; S.init(T, DM, G, bid);
            pg8::EpiResid E{(bf16*)(ws + WS_XN), DM, (u64_t*)(ws + WS_ROWSQ) + (size_t)(l * 3 + 2) * T};
            pg8::gemm_phase<pg8::EpiResid, pg8::StaticOrder, true, true>(lds + RING_OFF, g, S, E, tid_);
        }
        SEAM(pb + 6);
        if (IN(pb + 7) && PHON(10)) for (int rep_ = 0; rep_ < REP_GEMM; ++rep_) { PHL(); unsigned char* ws = WSP();
            pg8::Gemm g{(bf16*)(ws + WS_XN), (bf16*)(ws + WS_WPQ) + (size_t)l * DM * DM, T, DM, DM}; pg8::StaticOrder S; S.init(T, DM, G, bid);
            pg8::EpiBf16Row E{(bf16*)(ws + WS_QP), DM, (const u64_t*)(ws + WS_ROWSQ) + (size_t)(l * 3 + 2) * T};
            pg8::gemm_phase<pg8::EpiBf16Row, pg8::StaticOrder, true, true>(lds + RING_OFF, g, S, E, tid_);
        }
        SEAM(pb + 7);
        if (IN(pb + 8) && PHON(11)) for (int rep_ = 0; rep_ < REP_SEL; ++rep_) { PHL(); unsigned char* ws = WSP();
            const bf16* pk = (const bf16*)(ws + WS_PKEYS) + (size_t)l * 8 * 2 * 128 * 128;
            for (int u = bid; u < (T / 256) * PEER_H; u += G) { peer_select_unit((const bf16*)(ws + WS_QP), pk, (int*)(ws + WS_PIDX), (float*)(ws + WS_PGATE), u >> 3, u & 7, wave_, lane_);
                peer_xquant_unit((const bf16*)(ws + WS_XN), (const u64_t*)(ws + WS_ROWSQ) + (size_t)(l * 3 + 2) * T, (unsigned*)(ws + WS_XQH), (unsigned*)(ws + WS_XQL), u >> 3, u & 7, tid_); }
        }
        SEAM(pb + 8);
        if (IN(pb + 9) && PHON(12)) for (int rep_ = 0; rep_ < REP_U; ++rep_) { PHL(); unsigned char* ws = WSP();
            peer_u_phase_i4((const unsigned*)(ws + WS_XQH), (const unsigned*)(ws + WS_XQL), ws + WS_PU + (size_t)l * PEER_N * 1024, (const int*)(ws + WS_PIDX), (int*)(ws + WS_PARTI), bid, G, wave_, lane_); }
        SEAM(pb + 9);
        if (IN(pb + 10) && PHON(13)) { PHL(); unsigned char* ws = WSP();
            peer_v_pass((bf16*)(ws + WS_XN), ws + WS_PV + (size_t)l * PEER_N * 1024, (const int*)(ws + WS_PIDX), (const float*)(ws + WS_PGATE), (const int*)(ws + WS_PARTI), (l + 1 == DEPTH) ? OUTP() : (float*)nullptr,
                        (l + 1 < DEPTH) ? (u64_t*)(ws + WS_ROWSQ) + (size_t)((l + 1) * 3 + 0) * T : (u64_t*)nullptr, (LAS float*)(lds + RING_OFF + wave_ * 1024), gw_, NGW, lane_); }
        SEAM(pb + 10);
    }
#undef IN
#undef SEAM
}

#ifndef MK_MULTI_LAUNCH
#define MK_MULTI_LAUNCH 0
#endif
extern "C" void kernel_launch(void* const* d_in, const int* in_sizes, int n_in, void* d_out, int out_size, void* d_ws, size_t ws_size, hipStream_t stream) {
    static int grid = 0;
    if (grid == 0) {
        if (n_in != 23 || out_size != T * DM || ws_size < WS_END) { fprintf(stderr, "kernel_launch: unexpected shapes (n_in %d, out %d, ws %zu)\n", n_in, out_size, ws_size); grid = -1; return; }
        int dev = 0, cus = 0, per_cu = 0;
        if (hipGetDevice(&dev) != hipSuccess || hipDeviceGetAttribute(&cus, hipDeviceAttributeMultiprocessorCount, dev) != hipSuccess) { grid = -1; return; }
        if (hipFuncSetAttribute((const void*)mega, hipFuncAttributeMaxDynamicSharedMemorySize, LDS_BYTES) != hipSuccess) { fprintf(stderr, "kernel_launch: hipFuncSetAttribute failed\n"); grid = -1; return; }
        if (hipOccupancyMaxActiveBlocksPerMultiprocessor(&per_cu, (const void*)mega, NTHREADS, LDS_BYTES) != hipSuccess || per_cu < 1) { fprintf(stderr, "kernel_launch: occupancy query says %d\n", per_cu); }
        (void)hipGetLastError();
        grid = cus;
    }
    if (grid < 0) return;
    (void)hipMemsetAsync((char*)d_ws + WS_CTL, 0, CTL_ZERO_BYTES, stream);
    Args a{};
    for (int i = 0; i < 23; ++i) a.in[i] = (const float*)d_in[i];
    a.out = (float*)d_out; a.ws = (unsigned char*)d_ws;
#if MK_MULTI_LAUNCH
    for (int p = 0; p < N_PHASES; ++p) { a.ph_lo = p; a.ph_hi = p + 1; a.use_bar = 0; a.pad = 0; hipLaunchKernelGGL(mega, dim3(grid), dim3(NTHREADS), LDS_BYTES, stream, a); }
#else
    a.ph_lo = 0; a.ph_hi = N_PHASES; a.use_bar = 1; a.pad = 0;
    hipLaunchKernelGGL(mega, dim3(grid), dim3(NTHREADS), LDS_BYTES, stream, a);
#endif
    const hipError_t le = hipPeekAtLastError();
    if (le != hipSuccess) fprintf(stderr, "kernel_launch: launch failed: %s\n", hipGetErrorName(le));
}
```

```cpp
#include <hip/hip_runtime.h>
#include <cstdio>
#include <cstdint>
#include <cmath>
__device__ __forceinline__ float shx(float v, int k, int lane);
typedef unsigned long long u64_t;
__device__ __forceinline__ float rowsq_rs(const u64_t* rowsq, int row) { return 1.0f / sqrtf((float)*(const __attribute__((address_space(1))) u64_t*)(rowsq + row) * (5.9604644775390625e-08f / 2048.0f) + 1e-6f); }
__device__ __forceinline__ u64_t rowsq_fx(float ss) { return (u64_t)(ss * 16777216.0f + 0.5f); }
namespace pg8 {
#define PG8_LAS __attribute__((address_space(3)))
#define PG8_GAS __attribute__((address_space(1)))
typedef unsigned short bf16_t;
typedef short bf16x8 __attribute__((ext_vector_type(8)));
typedef float f32x4 __attribute__((ext_vector_type(4)));
typedef unsigned u32x4 __attribute__((ext_vector_type(4)));
constexpr int BM = 256, BK = 64, HALF = 128, HTB = HALF * BK * 2  , STAGE_BYTES = 8 * HTB, NXCD = 8, WGM = 8;

__host__ __device__ __forceinline__ int lds_byte(int r, int c) { const int st = (r >> 4) * 2 + (c >> 5), rr = r & 15, cc = c & 31, ob = rr * 64 + cc * 2; return st * 1024 + (ob ^ (((ob >> 9) & 1) << 5)); }
__host__ __device__ __forceinline__ void stage_rc(int b, int& R, int& C) { const int st = b / 1024, sb = b % 1024, swz = sb ^ (((sb >> 9) & 1) << 5); R = (st >> 1) * 16 + swz / 64; C = (st & 1) * 32 + (swz % 64) / 2; }
__host__ __device__ __forceinline__ int perm32(int rho) { const int n = rho >> 4, i = rho & 15; return 8 * (i >> 2) + 4 * n + (i & 3); }

struct Unit { int pm, pn; };
struct Gemm { const bf16_t* A; const bf16_t* Bt; int M, N, K; };

struct StaticOrder {
    int nM, nN, nwg, G, c;
    __host__ __device__ __forceinline__ void init(int M, int N, int G_, int c_) { nM = M / BM; nN = N / BM; nwg = nM * nN; G = G_; c = c_; }
    __host__ __device__ __forceinline__ bool next(int i, Unit& u) const {
        const long L = (long)i * G + c; if (L >= nwg) return false;
        int wgid = (int)L; { const int q = nwg / NXCD, r = nwg % NXCD, xcd = wgid % NXCD, off = wgid / NXCD; wgid = (xcd < r ? xcd * (q + 1) : r * (q + 1) + (xcd - r) * q) + off; }
        const int nig = WGM * nN, gid = wgid / nig, fm = gid * WGM, gsz = (nM - fm) < WGM ? (nM - fm) : WGM;
        u.pm = fm + ((wgid % nig) % gsz); u.pn = (wgid % nig) / gsz; return true;
    }
    __device__ __forceinline__ void a_ready(const Unit&) const {}
    __device__ __forceinline__ void done(const Unit&) const {}
};

__device__ __forceinline__ unsigned cvt_pk_bf16(float lo, float hi) { unsigned r; asm volatile("v_cvt_pk_bf16_f32 %0, %1, %2" : "=v"(r) : "v"(lo), "v"(hi)); return r; }
typedef float f32x2 __attribute__((ext_vector_type(2)));
__device__ __forceinline__ f32x2 gelu_pk(f32x2 v) {
    const f32x2 av = __builtin_elementwise_abs(v), d = av * 0.2316418882f + 1.0f;
    f32x2 t; t.x = __builtin_amdgcn_rcpf(d.x); t.y = __builtin_amdgcn_rcpf(d.y);
    f32x2 q = t * 0.5307027145f + (-0.7265760135f); q = q * t + 0.7107068705f; q = q * t + (-0.142248368f); q = q * t + 0.127414796f; q = q * t;
    const f32x2 s = (v * v) * (-0.72134752044f);
    f32x2 e; e.x = __builtin_amdgcn_exp2f(s.x); e.y = __builtin_amdgcn_exp2f(s.y);
    const f32x2 m = v * (q * e), r = v - m;
    f32x2 o; o.x = v.x < 0.f ? m.x : r.x; o.y = v.y < 0.f ? m.y : r.y; return o;
}

template <int ACT  > struct EpiBf16 {
    static constexpr bool PERM = true, AFTER_DRAIN = false, KSCALE = false; static_assert(ACT == 0 || ACT == 1, "EpiBf16: ACT is 0 (none) or 1 (gelu_pk)");
    bf16_t* O; int ldc; const float* bias; int split_cols; size_t split_stride; float scale0;
    __device__ __forceinline__ void operator()(const f32x4 (&acc)[2][2][4][2], const Unit& u, int wr, int wc, int fr, int fq) const {
        const int row0 = u.pm * BM + wr * 64 + fr; int colt = u.pn * BM; bf16_t* base = O;
        float sc = 1.f; if (split_cols) { const int t = colt / split_cols; base += (size_t)t * split_stride; colt -= t * split_cols; if (t == 0) sc = scale0; }
        const int col0 = colt + wc * 32 + 8 * fq, bcol0 = u.pn * BM + wc * 32 + 8 * fq;
        f32x4 bv[2][2];
#pragma unroll
        for (int bj = 0; bj < 2; ++bj)
#pragma unroll
            for (int n = 0; n < 2; ++n) bv[bj][n] = bias ? *(const PG8_GAS f32x4*)(bias + bcol0 + bj * HALF + 4 * n) : (f32x4){0.f, 0.f, 0.f, 0.f};
#pragma unroll
        for (int ai = 0; ai < 2; ++ai)
#pragma unroll
            for (int m = 0; m < 4; ++m) { bf16_t* rowp = base + (size_t)(row0 + ai * HALF + m * 16) * ldc + col0;
#pragma unroll
                for (int bj = 0; bj < 2; ++bj) { f32x4 v0 = acc[ai][bj][m][0] + bv[bj][0], v1 = acc[ai][bj][m][1] + bv[bj][1];
                    if (ACT == 1) { f32x2 a = gelu_pk((f32x2){v0[0], v0[1]}), b = gelu_pk((f32x2){v0[2], v0[3]}), c = gelu_pk((f32x2){v1[0], v1[1]}), d = gelu_pk((f32x2){v1[2], v1[3]});
                        v0 = (f32x4){a.x, a.y, b.x, b.y}; v1 = (f32x4){c.x, c.y, d.x, d.y}; }
                    v0 = v0 * sc; v1 = v1 * sc; u32x4 w; w.x = cvt_pk_bf16(v0[0], v0[1]); w.y = cvt_pk_bf16(v0[2], v0[3]); w.z = cvt_pk_bf16(v1[0], v1[1]); w.w = cvt_pk_bf16(v1[2], v1[3]);
                    *(PG8_GAS u32x4*)(rowp + bj * HALF) = w; } }
    }
};

typedef unsigned u32x2 __attribute__((ext_vector_type(2)));
struct EpiResid {
    static constexpr bool PERM = false, AFTER_DRAIN = false, KSCALE = false;
    bf16_t* s; int ldc; u64_t* rowsq;
    __device__ __forceinline__ void operator()(const f32x4 (&acc)[2][2][4][2], const Unit& u, int wr, int wc, int fr, int fq) const {
        const int col0 = u.pn * BM + wc * 32 + 4 * fq;
#pragma unroll
        for (int ai = 0; ai < 2; ++ai)
#pragma unroll
            for (int m = 0; m < 4; ++m) { const int row = u.pm * BM + ai * HALF + wr * 64 + m * 16 + fr; bf16_t* sp = s + (size_t)row * ldc + col0; float ss = 0.f;
                u32x2 in[2][2];
#pragma unroll
                for (int bj = 0; bj < 2; ++bj)
#pragma unroll
                    for (int n = 0; n < 2; ++n) in[bj][n] = *(const PG8_GAS u32x2*)(sp + bj * HALF + n * 16);
#pragma unroll
                for (int bj = 0; bj < 2; ++bj)
#pragma unroll
                    for (int n = 0; n < 2; ++n) { const u32x2 w0 = in[bj][n];
                        const f32x4 bs = (f32x4){__builtin_bit_cast(float, w0.x << 16), __builtin_bit_cast(float, w0.x & 0xffff0000u), __builtin_bit_cast(float, w0.y << 16), __builtin_bit_cast(float, w0.y & 0xffff0000u)};
                        const f32x4 o = bs + acc[ai][bj][m][n]; ss += (o[0] * o[0] + o[1] * o[1]) + (o[2] * o[2] + o[3] * o[3]);
                        u32x2 w; w.x = cvt_pk_bf16(o[0], o[1]); w.y = cvt_pk_bf16(o[2], o[3]); *(PG8_GAS u32x2*)(sp + bj * HALF + n * 16) = w; }
                ss += shx(ss, 16, fr + 16 * fq); ss += shx(ss, 32, fr + 16 * fq);
                if (fq == 0) (void)__hip_atomic_fetch_add((PG8_GAS u64_t*)(rowsq + row), rowsq_fx(ss), __ATOMIC_RELAXED, __HIP_MEMORY_SCOPE_AGENT); }
    }
};
struct EpiResidMix {
    static constexpr bool PERM = false, AFTER_DRAIN = false, KSCALE = true; static constexpr int KS0 = 12, KS1 = 20;
    bf16_t* s; int ldc; u64_t* rowsq; const PG8_LAS float* ftab; const PG8_LAS int* pmtab;
    __device__ __forceinline__ int slot(int pm) const { return pmtab[0] == pm ? 0 : (pmtab[1] == pm ? 1 : (pmtab[2] == pm ? 2 : 3)); }
    __device__ __forceinline__ void kscale(f32x4 (&acc)[2][2][4][2], const Unit& u, int which, int wr, int fr) const {
        const PG8_LAS float* ft = ftab + which * 1024 + slot(u.pm) * 256;
#pragma unroll
        for (int ai = 0; ai < 2; ++ai)
#pragma unroll
            for (int m = 0; m < 4; ++m) { const float f = ft[ai * HALF + wr * 64 + m * 16 + fr];
#pragma unroll
                for (int bj = 0; bj < 2; ++bj)
#pragma unroll
                    for (int n = 0; n < 2; ++n) acc[ai][bj][m][n] = acc[ai][bj][m][n] * f; }
    }
    __device__ __forceinline__ void operator()(const f32x4 (&acc)[2][2][4][2], const Unit& u, int wr, int wc, int fr, int fq) const {
        const int col0 = u.pn * BM + wc * 32 + 4 * fq;
#pragma unroll
        for (int ai = 0; ai < 2; ++ai)
#pragma unroll
            for (int m = 0; m < 4; ++m) { const int row = u.pm * BM + ai * HALF + wr * 64 + m * 16 + fr; bf16_t* sp = s + (size_t)row * ldc + col0; float ss = 0.f; const float rc = ftab[2048 + slot(u.pm) * 256 + ai * HALF + wr * 64 + m * 16 + fr];
                u32x2 in[2][2];
#pragma unroll
                for (int bj = 0; bj < 2; ++bj)
#pragma unroll
                    for (int n = 0; n < 2; ++n) in[bj][n] = *(const PG8_GAS u32x2*)(sp + bj * HALF + n * 16);
#pragma unroll
                for (int bj = 0; bj < 2; ++bj)
#pragma unroll
                    for (int n = 0; n < 2; ++n) { const u32x2 w0 = in[bj][n];
                        const f32x4 bs = (f32x4){__builtin_bit_cast(float, w0.x << 16), __builtin_bit_cast(float, w0.x & 0xffff0000u), __builtin_bit_cast(float, w0.y << 16), __builtin_bit_cast(float, w0.y & 0xffff0000u)};
                        const f32x4 o = bs + acc[ai][bj][m][n] * rc; ss += (o[0] * o[0] + o[1] * o[1]) + (o[2] * o[2] + o[3] * o[3]);
                        u32x2 w; w.x = cvt_pk_bf16(o[0], o[1]); w.y = cvt_pk_bf16(o[2], o[3]); *(PG8_GAS u32x2*)(sp + bj * HALF + n * 16) = w; }
                ss += shx(ss, 16, fr + 16 * fq); ss += shx(ss, 32, fr + 16 * fq);
                if (fq == 0) (void)__hip_atomic_fetch_add((PG8_GAS u64_t*)(rowsq + row), rowsq_fx(ss), __ATOMIC_RELAXED, __HIP_MEMORY_SCOPE_AGENT); }
    }
};
struct EpiBf16Row {
    static constexpr bool PERM = true, AFTER_DRAIN = false, KSCALE = false;
    bf16_t* O; int ldc; const u64_t* rowsq;
    __device__ __forceinline__ void operator()(const f32x4 (&acc)[2][2][4][2], const Unit& u, int wr, int wc, int fr, int fq) const {
        const int row0 = u.pm * BM + wr * 64 + fr, col0 = u.pn * BM + wc * 32 + 8 * fq;
#pragma unroll
        for (int ai = 0; ai < 2; ++ai)
#pragma unroll
            for (int m = 0; m < 4; ++m) { const int row = row0 + ai * HALF + m * 16; const float rs = rowsq_rs(rowsq, row); bf16_t* rowp = O + (size_t)row * ldc + col0;
#pragma unroll
                for (int bj = 0; bj < 2; ++bj) { const f32x4 v0 = acc[ai][bj][m][0] * rs, v1 = acc[ai][bj][m][1] * rs; u32x4 w; w.x = cvt_pk_bf16(v0[0], v0[1]); w.y = cvt_pk_bf16(v0[2], v0[3]); w.z = cvt_pk_bf16(v1[0], v1[1]); w.w = cvt_pk_bf16(v1[2], v1[3]);
                    *(PG8_GAS u32x4*)(rowp + bj * HALF) = w; } }
    }
};
struct EpiQKV {
    static constexpr bool PERM = false, AFTER_DRAIN = false, KSCALE = false;
    bf16_t* O; const float* ga; const float* gb; const float* gc; const float* rope; const u64_t* rowsq;
    __device__ __forceinline__ void operator()(const f32x4 (&acc)[2][2][4][2], const Unit& u, int wr, int wc, int fr, int fq) const {
        const int hg = u.pn * 4 + wc;
        const float* g = nullptr; bool isq = false, dorope = false;
        if (hg < 12) { g = ga; isq = true; } else if (hg < 16) { g = ga + 64; } else if (hg < 20) { }
        else if (hg < 28) { g = gb; isq = true; } else if (hg < 36) { g = gb + 64; } else if (hg < 44) { }
        else if (hg < 56) { g = gc; isq = true; dorope = true; } else if (hg < 60) { g = gc + 64; dorope = true; }
        const float qs = isq ? 0.18033688011112042f : 1.0f;
#pragma unroll
        for (int ai = 0; ai < 2; ++ai)
#pragma unroll
            for (int m = 0; m < 4; ++m) {
                const int row = u.pm * BM + ai * HALF + wr * 64 + m * 16 + fr;
                f32x4 v[2][2];
                const float rsx = rowsq_rs(rowsq, row);
#pragma unroll
                for (int bj = 0; bj < 2; ++bj)
#pragma unroll
                    for (int n = 0; n < 2; ++n) v[bj][n] = acc[ai][bj][m][n] * rsx;
                if (g) {
                    float ss = 0.f;
#pragma unroll
                    for (int bj = 0; bj < 2; ++bj)
#pragma unroll
                        for (int n = 0; n < 2; ++n) { const f32x4 x = v[bj][n]; ss += (x[0] * x[0] + x[1] * x[1]) + (x[2] * x[2] + x[3] * x[3]); }
                    ss += shx(ss, 16, fr + 16 * fq); ss += shx(ss, 32, fr + 16 * fq);
                    const float r = qs / sqrtf(ss * (1.0f / 64.0f) + 1e-6f);
#pragma unroll
                    for (int bj = 0; bj < 2; ++bj)
#pragma unroll
                        for (int n = 0; n < 2; ++n) v[bj][n] = v[bj][n] * *(const PG8_GAS f32x4*)(g + 32 * bj + 16 * n + 4 * fq) * r;
                }
                if (dorope) {
                    const int t = row & 2047, pr = t >> 6, pc = t & 63;
#pragma unroll
                    for (int bj = 0; bj < 2; ++bj) {
                        const int pos = bj ? pc : pr;
                        const float* rp = rope + (size_t)(pos * 16 + 4 * fq) * 2;
                        const f32x4 c01 = *(const PG8_GAS f32x4*)rp, c23 = *(const PG8_GAS f32x4*)(rp + 4);
                        const f32x4 cs = (f32x4){c01[0], c01[2], c23[0], c23[2]}, sn = (f32x4){c01[1], c01[3], c23[1], c23[3]};
                        const f32x4 x1 = v[bj][0], x2 = v[bj][1];
                        v[bj][0] = x1 * cs - x2 * sn; v[bj][1] = x1 * sn + x2 * cs;
                    }
                }
                bf16_t* rowp = O + (size_t)row * 4096 + hg * 64 + 4 * fq;
#pragma unroll
                for (int bj = 0; bj < 2; ++bj)
#pragma unroll
                    for (int n = 0; n < 2; ++n) { u32x2 w; w.x = cvt_pk_bf16(v[bj][n][0], v[bj][n][1]); w.y = cvt_pk_bf16(v[bj][n][2], v[bj][n][3]); *(PG8_GAS u32x2*)(rowp + 32 * bj + 16 * n) = w; }
                asm volatile("" ::: "memory");
            }
    }
};
template <class Epi, class Sched, bool ALIGN_EPI = false, bool SP2 = false>
__device__ __forceinline__ void gemm_phase(PG8_LAS unsigned char* lds, const Gemm g, const Sched& S, const Epi& E, const int tid) {
    const int wid = __builtin_amdgcn_readfirstlane(tid >> 6), lane = tid & 63, wr = wid >> 2, wc = wid & 3, fr = lane & 15, fq = lane >> 4;
    const int K = g.K, nt = K / BK;
    unsigned voffA[2], voffB[2];
#pragma unroll
    for (int i = 0; i < 2; ++i) { int R, C; stage_rc(tid * 16 + i * 8192, R, C); const int Rb = Epi::PERM ? ((R & ~31) + perm32(R & 31)) : R;
        voffA[i] = (unsigned)(R * K + C) * 2u; voffB[i] = (unsigned)(Rb * K + C) * 2u; }
    const size_t kstep = (size_t)(BK * 2);
    const size_t hstep = (size_t)HALF * K * 2;
    const size_t tstep = 2 * hstep;
    const unsigned ldsw = (unsigned)wid * 1024u;
    const int aoff = lds_byte(wr * 64 + fr, fq * 8), boff = lds_byte(wc * 32 + fr, fq * 8);
#define PG8_SA(b, h) (((b) * 2 + (h)) * HTB)
#define PG8_SB(b, h) ((4 + (b) * 2 + (h)) * HTB)
#define PG8_STAGE(bufoff, gbase, voff) do { _Pragma("unroll") for (int _i = 0; _i < 2; ++_i) \
        __builtin_amdgcn_global_load_lds((const unsigned*)((const char*)(gbase) + (voff)[_i]), (PG8_LAS unsigned*)(lds + (bufoff) + ldsw + _i * 8192), 16, 0, 0); } while (0)
#define PG8_LDA(dst, b, h) do { _Pragma("unroll") for (int m = 0; m < 4; ++m) _Pragma("unroll") for (int k = 0; k < 2; ++k) dst[m][k] = *(const PG8_LAS bf16x8*)(lds + PG8_SA(b, h) + aoff + m * 2048 + k * 1024); } while (0)
#define PG8_LDB(dst, b, h) do { _Pragma("unroll") for (int n = 0; n < 2; ++n) _Pragma("unroll") for (int k = 0; k < 2; ++k) dst[n][k] = *(const PG8_LAS bf16x8*)(lds + PG8_SB(b, h) + boff + n * 2048 + k * 1024); } while (0)
#define PG8_MMA(ai, bj, At, Bt) do { __builtin_amdgcn_s_setprio(1); _Pragma("unroll") for (int m = 0; m < 4; ++m) _Pragma("unroll") for (int n = 0; n < 2; ++n) _Pragma("unroll") for (int k = 0; k < 2; ++k) \
        acc[ai][bj][m][n] = __builtin_amdgcn_mfma_f32_16x16x32_bf16(Bt[n][k], At[m][k], acc[ai][bj][m][n], 0, 0, 0); __builtin_amdgcn_s_setprio(0); } while (0)
#define PG8_WAIT_V(n) asm volatile("s_waitcnt vmcnt(" #n ")" ::: "memory")
#define PG8_WAIT_L(n) asm volatile("s_waitcnt lgkmcnt(" #n ")" ::: "memory")
#define PG8_BAR __builtin_amdgcn_s_barrier()
#define PG8_SCHED __builtin_amdgcn_sched_barrier(0)
    Unit cur, nxt; int ui = 0;
    if (!S.next(0, cur)) return;
    f32x4 acc[2][2][4][2];
#pragma unroll
    for (int a = 0; a < 2; ++a)
#pragma unroll
        for (int b = 0; b < 2; ++b)
#pragma unroll
            for (int m = 0; m < 4; ++m)
#pragma unroll
                for (int n = 0; n < 2; ++n) acc[a][b][m][n] = (f32x4){0.f, 0.f, 0.f, 0.f};
    bf16x8 At[4][2], B0[2][2], B1[2][2];
    const char* cA = (const char*)g.A + (size_t)cur.pm * tstep; const char* cB = (const char*)g.Bt + (size_t)cur.pn * tstep;
    S.a_ready(cur);
    if constexpr (SP2) {
        PG8_STAGE(PG8_SB(0, 0), cB, voffB); PG8_STAGE(PG8_SB(0, 1), cB + hstep, voffB); PG8_STAGE(PG8_SA(0, 0), cA, voffA); PG8_STAGE(PG8_SA(0, 1), cA + hstep, voffA);
        if (wr == 1) PG8_BAR;
        PG8_WAIT_V(2); PG8_BAR;
        PG8_STAGE(PG8_SB(1, 0), cB + kstep, voffB); PG8_STAGE(PG8_SA(1, 0), cA + kstep, voffA); PG8_STAGE(PG8_SB(1, 1), cB + hstep + kstep, voffB);
        PG8_WAIT_V(6); PG8_BAR;
    } else {
        PG8_STAGE(PG8_SB(0, 0), cB, voffB); PG8_STAGE(PG8_SA(0, 0), cA, voffA); PG8_STAGE(PG8_SB(0, 1), cB + hstep, voffB); PG8_STAGE(PG8_SA(0, 1), cA + hstep, voffA);
        if (wr == 1) PG8_BAR;
        PG8_WAIT_V(4); PG8_BAR;
        PG8_STAGE(PG8_SB(1, 0), cB + kstep, voffB); PG8_STAGE(PG8_SA(1, 0), cA + kstep, voffA); PG8_STAGE(PG8_SB(1, 1), cB + hstep + kstep, voffB);
        PG8_WAIT_V(6); PG8_BAR;
    }
    for (;;) {
        const bool has_next = S.next(ui + 1, nxt);
        const char* nA = has_next ? (const char*)g.A + (size_t)nxt.pm * tstep : cA; const char* nB = has_next ? (const char*)g.Bt + (size_t)nxt.pn * tstep : cB;
        for (int t = 0; t < nt; t += 2) {
            if constexpr (Epi::KSCALE) { if (t == Epi::KS0 || t == Epi::KS1) E.kscale(acc, cur, t == Epi::KS1 ? 1 : 0, wr, fr); }
            const bool last = (t == nt - 2);
            const char* a1 = cA + (size_t)(t + 1) * kstep;
            const char* a2 = last ? nA : cA + (size_t)(t + 2) * kstep; const char* b2 = last ? nB : cB + (size_t)(t + 2) * kstep;
            const char* a3 = a2 + kstep; const char* b3 = b2 + kstep;
            if (last && has_next) S.a_ready(nxt);
            if constexpr (SP2) {
            PG8_LDB(B0, 0, 0); PG8_LDB(B1, 0, 1); PG8_SCHED; PG8_LDA(At, 0, 0); PG8_STAGE(PG8_SA(1, 1), a1 + hstep, voffA);
            PG8_WAIT_V(8); PG8_WAIT_L(0); PG8_BAR; PG8_MMA(0, 0, At, B0); PG8_MMA(0, 1, At, B1); PG8_BAR; PG8_SCHED;
            PG8_LDA(At, 0, 1); PG8_STAGE(PG8_SB(0, 0), b2, voffB); PG8_STAGE(PG8_SB(0, 1), b2 + hstep, voffB); PG8_STAGE(PG8_SA(0, 0), a2, voffA);
            PG8_WAIT_V(8); PG8_WAIT_L(0); PG8_BAR; PG8_MMA(1, 0, At, B0); PG8_MMA(1, 1, At, B1); PG8_BAR; PG8_SCHED;
            PG8_LDB(B0, 1, 0); PG8_LDB(B1, 1, 1); PG8_SCHED; PG8_LDA(At, 1, 0); PG8_STAGE(PG8_SA(0, 1), a2 + hstep, voffA);
            PG8_WAIT_V(8); PG8_WAIT_L(0); PG8_BAR; PG8_MMA(0, 0, At, B0); PG8_MMA(0, 1, At, B1); PG8_BAR; PG8_SCHED;
            PG8_LDA(At, 1, 1); PG8_STAGE(PG8_SB(1, 0), b3, voffB); PG8_STAGE(PG8_SB(1, 1), b3 + hstep, voffB); PG8_STAGE(PG8_SA(1, 0), a3, voffA);
            PG8_WAIT_V(8); PG8_WAIT_L(0); PG8_BAR; PG8_MMA(1, 0, At, B0); PG8_MMA(1, 1, At, B1); PG8_BAR; PG8_SCHED;
            } else {
            PG8_LDB(B0, 0, 0); PG8_SCHED; PG8_LDA(At, 0, 0); PG8_STAGE(PG8_SA(1, 1), a1 + hstep, voffA);
            PG8_WAIT_L(8); PG8_BAR; PG8_WAIT_L(0); PG8_MMA(0, 0, At, B0); PG8_BAR; PG8_SCHED;
            PG8_LDB(B1, 0, 1); PG8_STAGE(PG8_SB(0, 0), b2, voffB);
            PG8_BAR; PG8_WAIT_L(0); PG8_MMA(0, 1, At, B1); PG8_BAR;
            PG8_LDA(At, 0, 1); PG8_STAGE(PG8_SA(0, 0), a2, voffA);
            PG8_BAR; PG8_WAIT_L(0); PG8_MMA(1, 0, At, B0); PG8_BAR; PG8_SCHED;
            PG8_STAGE(PG8_SB(0, 1), b2 + hstep, voffB);
            PG8_WAIT_V(6); PG8_BAR; PG8_MMA(1, 1, At, B1); PG8_BAR;
            PG8_LDB(B0, 1, 0); PG8_SCHED; PG8_LDA(At, 1, 0); PG8_STAGE(PG8_SA(0, 1), a2 + hstep, voffA);
            PG8_WAIT_L(8); PG8_BAR; PG8_WAIT_L(0); PG8_MMA(0, 0, At, B0); PG8_BAR; PG8_SCHED;
            PG8_LDB(B1, 1, 1); PG8_STAGE(PG8_SB(1, 0), b3, voffB);
            PG8_BAR; PG8_WAIT_L(0); PG8_MMA(0, 1, At, B1); PG8_BAR;
            PG8_LDA(At, 1, 1); PG8_STAGE(PG8_SA(1, 0), a3, voffA);
            PG8_BAR; PG8_WAIT_L(0); PG8_MMA(1, 0, At, B0); PG8_BAR; PG8_SCHED;
            PG8_STAGE(PG8_SB(1, 1), b3 + hstep, voffB);
            PG8_WAIT_V(6); PG8_BAR; PG8_MMA(1, 1, At, B1); PG8_BAR;
            }
        }
        if constexpr (ALIGN_EPI) { if (wr == 0) PG8_BAR; }
        if constexpr (!Epi::AFTER_DRAIN) { E(acc, cur, wr, wc, fr, fq); S.done(cur); }
        if (!has_next) break;
#pragma unroll
        for (int a = 0; a < 2; ++a)
#pragma unroll
            for (int b = 0; b < 2; ++b)
#pragma unroll
                for (int m = 0; m < 4; ++m)
#pragma unroll
                    for (int n = 0; n < 2; ++n) acc[a][b][m][n] = (f32x4){0.f, 0.f, 0.f, 0.f};
        cur = nxt; cA = nA; cB = nB; ++ui;
        if constexpr (ALIGN_EPI) { if (wr == 1) PG8_BAR; }
    }
    PG8_WAIT_V(0);
    if constexpr (!ALIGN_EPI) { if (wr == 0) PG8_BAR; }
    PG8_BAR;
    if constexpr (Epi::AFTER_DRAIN) { E.fused(acc, cur, wr, wc, fr, fq, lds, wid, lane); S.done(cur); }
#undef PG8_SA
#undef PG8_SB
#undef PG8_STAGE
#undef PG8_LDA
#undef PG8_LDB
#undef PG8_MMA
#undef PG8_WAIT_V
#undef PG8_WAIT_L
#undef PG8_BAR
#undef PG8_SCHED
}
}

constexpr int BATCH = 16, SEQ = 2048, DM = 2048, T = BATCH * SEQ, DEPTH = 2;
constexpr int NMEM = 256, DIN = 4096, MEMW = 512;
constexpr int PEER_H = 8, PEER_N = 16384;
constexpr int NWAVES = 8, NTHREADS = NWAVES * 64;
constexpr float EPS = 1e-6f;
constexpr int QA = 0, KA = 768, VA = 1024, QB = 1280, KB = 1792, VB = 2304, QC = 2816, KC = 3584, VC = 3840;
constexpr int OA = 0, OB = 768, OC = 1280;

constexpr size_t MiB = 1u << 20;
constexpr size_t WS_CTL = 0, CTL_ZERO_BYTES = 2 * MiB;
constexpr size_t WS_ROWSQ = 256 * 1024;
constexpr size_t WS_ROPE = 83 * MiB, WS_BIASA = 83 * MiB + 16384;
constexpr size_t WS_WIN = 2 * MiB, WS_WOUT = 34 * MiB, WS_WMQ = 50 * MiB, WS_WMKV = 54 * MiB, WS_WMO = 62 * MiB, WS_WPQ = 66 * MiB, WS_PKEYS = 82 * MiB;
constexpr size_t WS_MEMN = 84 * MiB, WS_KVM = 116 * MiB, WS_PU = 132 * MiB, WS_PV = 260 * MiB, WS_XN = 388 * MiB, WS_QKV = 516 * MiB, WS_ATT = 772 * MiB;
constexpr size_t WS_QM = 900 * MiB, WS_OM = 932 * MiB, WS_MIXSQ = 964 * MiB, MIXSQ_BYTES = 2 * MiB, WS_END = 966 * MiB;
constexpr size_t WS_QP = WS_QKV, WS_PIDX = WS_QKV + 128 * MiB, WS_PGATE = WS_QKV + 144 * MiB, WS_PARTI = WS_QKV + 160 * MiB;
constexpr size_t WS_XQH = 900 * MiB, WS_XQL = 932 * MiB;
constexpr int CW_BAR = 4096;

constexpr int RING_OFF = 0, RING_BYTES = 131072;
constexpr int LDSCTL_OFF = RING_BYTES, MISC_OFF = LDSCTL_OFF + 320;
constexpr int LDS_BYTES = 147456;

#define GAS __attribute__((address_space(1)))
#define LAS __attribute__((address_space(3)))
typedef unsigned short bf16;
typedef unsigned v4u __attribute__((ext_vector_type(4)));
typedef unsigned v2u __attribute__((ext_vector_type(2)));
typedef float f32x4 __attribute__((ext_vector_type(4)));
typedef float f32x16 __attribute__((ext_vector_type(16)));
typedef short bf16x8 __attribute__((ext_vector_type(8)));
typedef GAS unsigned gu32;
#define LDS_WAIT() asm volatile("s_waitcnt lgkmcnt(0)" ::: "memory")
#define VM_WAIT() asm volatile("s_waitcnt vmcnt(0)" ::: "memory")
__device__ __forceinline__ unsigned f2bf(float f) { unsigned u = __builtin_bit_cast(unsigned, f); return (u + 0x7fffu + ((u >> 16) & 1u)) >> 16; }
__device__ __forceinline__ unsigned pk2(float lo, float hi) { return f2bf(lo) | (f2bf(hi) << 16); }
__device__ __forceinline__ float bflo(unsigned w) { return __builtin_bit_cast(float, w << 16); }
__device__ __forceinline__ float bfhi(unsigned w) { return __builtin_bit_cast(float, w & 0xffff0000u); }

__device__ __forceinline__ float shx(float v, int k, int lane) { return __builtin_bit_cast(float, __builtin_amdgcn_ds_bpermute((lane ^ k) << 2, __builtin_bit_cast(int, v))); }
#define XB_TMO      128
#define XB_XCNT(j)  (256  + 64 * (j))
#define XB_XSUB(j)  (1280 + 64 * (j))
#define XB_XGEN(j)  (2304 + 64 * (j))
#define XB_TOP      3328
#define XB_TOPGEN   3392
#define XCD_BAR_WORDS 3456
#define XB_SPIN_CAP (1u << 18)

__device__ __forceinline__ unsigned xb_ld(unsigned* p)              { return __hip_atomic_load(p, __ATOMIC_RELAXED, __HIP_MEMORY_SCOPE_AGENT); }
__device__ __forceinline__ unsigned xb_add(unsigned* p, unsigned v) { return __hip_atomic_fetch_add(p, v, __ATOMIC_RELAXED, __HIP_MEMORY_SCOPE_AGENT); }
__device__ __forceinline__ unsigned xb_xcc_id() { return (unsigned)__builtin_amdgcn_s_getreg((3 << 11) | 20) & 0xFu; }
#define XB_SPIN(cond, bar) do { unsigned _sp = 0; while (cond) { __builtin_amdgcn_s_sleep(1); \
    if ((++_sp & 255u) == 0u) { if (xb_ld(&(bar)[XB_TMO])) break; if (_sp > XB_SPIN_CAP) { atomicAdd(&(bar)[XB_TMO], 1u); break; } } } } while (0)

struct XcdBarrier {
    unsigned* bar; unsigned x;
    volatile LAS unsigned* st;
};

__device__ __forceinline__ XcdBarrier xcd_barrier_post(unsigned* bar, volatile LAS unsigned* st) {
    XcdBarrier b; b.bar = bar; b.x = xb_xcc_id(); b.st = st;
    if (threadIdx.x == 0) (void)xb_add(&bar[XB_XCNT(b.x)], 1u);
    return b;
}
__device__ __forceinline__ void xcd_barrier_complete(unsigned* bar, unsigned x, unsigned& nloc, unsigned& nx) {
    const unsigned G = gridDim.x * gridDim.y * gridDim.z;
    unsigned sum, cnt, mine, sp = 0u;
    for (;;) {
        sum = 0u; cnt = 0u; mine = 0u;
#pragma unroll
        for (unsigned j = 0; j < 16; ++j) { const unsigned c = xb_ld(&bar[XB_XCNT(j)]); sum += c; cnt += (c > 0u) ? 1u : 0u; mine = (j == x) ? c : mine; }
        if (sum == G) break;
        __builtin_amdgcn_s_sleep(1);
        if ((++sp & 255u) == 0u) { if (xb_ld(&bar[XB_TMO])) break; if (sp > XB_SPIN_CAP) { atomicAdd(&bar[XB_TMO], 1u); break; } }
    }
    nloc = mine > 0u ? mine : 1u; nx = cnt > 0u ? cnt : 1u;
}

__device__ __forceinline__ void xcd_barrier(const XcdBarrier& b) {
    asm volatile("s_waitcnt vmcnt(0)" ::: "memory");
    __syncthreads();
    if (threadIdx.x == 0) {
        unsigned* bar = b.bar;
        __builtin_amdgcn_s_waitcnt(0);
        unsigned nloc = b.st[0], nx = b.st[1];
        if (nloc == 0u) { xcd_barrier_complete(bar, b.x, nloc, nx); b.st[0] = nloc; b.st[1] = nx; }
        const unsigned old = xb_add(&bar[XB_XSUB(b.x)], 1u);
        const unsigned gen = old / nloc;
        if (old + 1u == (gen + 1u) * nloc) {
            __builtin_amdgcn_fence(__ATOMIC_RELEASE, "agent");
            asm volatile("s_waitcnt vmcnt(0)" ::: "memory");
            const unsigned og = xb_add(&bar[XB_TOP], 1u);
            const unsigned tg = og / nx;
            if (og + 1u == (tg + 1u) * nx) xb_add(&bar[XB_TOPGEN], 1u);
            else XB_SPIN(xb_ld(&bar[XB_TOPGEN]) == tg, bar);
            __builtin_amdgcn_fence(__ATOMIC_ACQUIRE, "agent");
            xb_add(&bar[XB_XGEN(b.x)], 1u);
            asm volatile("s_waitcnt vmcnt(0)" ::: "memory");
        } else {
            XB_SPIN(xb_ld(&bar[XB_XGEN(b.x)]) == gen, bar);
            __builtin_amdgcn_fence(__ATOMIC_ACQUIRE, "agent");
            asm volatile("s_waitcnt vmcnt(0)" ::: "memory");
        }
    }
    __syncthreads();
}

__device__ __forceinline__ float wave_sum(float v, int lane) {
#pragma unroll
    for (int o = 1; o < 64; o <<= 1) v += shx(v, o, lane);
    return v;
}
__device__ __forceinline__ void* ldptr(LAS unsigned char* lds, int i) {
    const unsigned long long v = ((const LAS unsigned long long*)(lds + LDSCTL_OFF + 1024))[i];
    const unsigned lo = __builtin_amdgcn_readfirstlane((unsigned)v), hi = __builtin_amdgcn_readfirstlane((unsigned)(v >> 32));
    return (void*)(((unsigned long long)hi << 32) | lo);
}
struct OffsetOrder {
    pg8::StaticOrder S;
    __device__ void init(int M, int N, int G, int c, int off) { S.init(M, N, G, (c + G - off % G) % G); }
    __device__ bool next(int i, pg8::Unit& u) const { return S.next(i, u); }
    __device__ __forceinline__ void a_ready(const pg8::Unit&) const {}
    __device__ __forceinline__ void done(const pg8::Unit&) const {}
};

template <bool PERMQKV>
__device__ __forceinline__ void transpose_item(const float* W, int K, int N, bf16* WT, LAS float* scr, int item, int lane, const float* gk = nullptr) {
    const int nblk = N / 32, kb = item / nblk, nb = item % nblk, k0 = 64 * kb, n0 = 32 * nb;
    int d0 = n0;
    if (PERMQKV) { const int within = n0 & 255; d0 = (n0 & ~255) + 128 * ((within >> 5) & 1) + 32 * (within >> 6); }
#pragma unroll
    for (int i = 0; i < 8; ++i) { const int kk = 8 * i + (lane >> 3), nn = 4 * (lane & 7);
        const f32x4 w4 = *(const GAS f32x4*)(W + (size_t)(k0 + kk) * N + n0 + nn) * (gk ? gk[k0 + kk] : 1.f);
        scr[kk * 33 + nn] = w4[0]; scr[kk * 33 + nn + 1] = w4[1]; scr[kk * 33 + nn + 2] = w4[2]; scr[kk * 33 + nn + 3] = w4[3]; }
    LDS_WAIT(); asm volatile("" ::: "memory");
    const int c = lane & 7;
#pragma unroll
    for (int j = 0; j < 4; ++j) { const int n = (lane >> 3) + 8 * j; const LAS float* s = scr + (8 * c) * 33 + n;
        v4u o; o.x = pk2(s[0 * 33], s[1 * 33]); o.y = pk2(s[2 * 33], s[3 * 33]); o.z = pk2(s[4 * 33], s[5 * 33]); o.w = pk2(s[6 * 33], s[7 * 33]);
        *(GAS v4u*)(WT + (size_t)(d0 + n) * K + k0 + 8 * c) = o; }
    LDS_WAIT(); asm volatile("" ::: "memory");
}
__device__ __forceinline__ void convert_bf16(const float* src, bf16* dst, size_t n, size_t gtid, size_t nthreads) {
    for (size_t i = gtid * 8; i < n; i += nthreads * 8) {
        const f32x4 a = *(const GAS f32x4*)(src + i), b = *(const GAS f32x4*)(src + i + 4);
        v4u o; o.x = pk2(a[0], a[1]); o.y = pk2(a[2], a[3]); o.z = pk2(b[0], b[1]); o.w = pk2(b[2], b[3]);
        *(GAS v4u*)(dst + i) = o;
    }
}
__device__ __forceinline__ int t5_bucket(int rel) {
    const int n = rel < 0 ? -rel : rel;
    const int b = n < 8 ? n : n < 12 ? 8 : n < 16 ? 9 : n < 23 ? 10 : n < 32 ? 11 : n < 46 ? 12 : n < 64 ? 13 : n < 91 ? 14 : 15;
    return b + (rel > 0 ? 16 : 0);
}
__constant__ float ROPE_INV[16] = {1.000000000e+00f, 5.623413324e-01f, 3.162277639e-01f, 1.778279394e-01f, 1.000000015e-01f, 5.623413250e-02f, 3.162277490e-02f, 1.778279431e-02f,
                                   9.999999776e-03f, 5.623413250e-03f, 3.162277630e-03f, 1.778279431e-03f, 1.000000047e-03f, 5.623413017e-04f, 3.162277571e-04f, 1.778279402e-04f};

__device__ __forceinline__ void rms_row_to_bf16(const float* xrow, const float* g0, bf16* o0, const float* g1, bf16* o1, int lane) {
    const GAS f32x4* xr = (const GAS f32x4*)xrow + lane;
    f32x4 v[8]; float s = 0.f;
#pragma unroll
    for (int j = 0; j < 8; ++j) { v[j] = xr[64 * j]; s += (v[j].x * v[j].x + v[j].y * v[j].y) + (v[j].z * v[j].z + v[j].w * v[j].w); }
    const float rstd = 1.f / sqrtf(wave_sum(s, lane) * (1.f / DM) + EPS);
    {   const GAS f32x4* gr = (const GAS f32x4*)g0 + lane; GAS v2u* o8 = (GAS v2u*)o0 + lane;
#pragma unroll
        for (int j = 0; j < 8; ++j) { const f32x4 gg = gr[64 * j]; v2u w; w.x = pk2(v[j].x * rstd * gg.x, v[j].y * rstd * gg.y); w.y = pk2(v[j].z * rstd * gg.z, v[j].w * rstd * gg.w); o8[64 * j] = w; } }
    if (g1) { const GAS f32x4* gr = (const GAS f32x4*)g1 + lane; GAS v2u* o8 = (GAS v2u*)o1 + lane;
#pragma unroll
        for (int j = 0; j < 8; ++j) { const f32x4 gg = gr[64 * j]; v2u w; w.x = pk2(v[j].x * rstd * gg.x, v[j].y * rstd * gg.y); w.y = pk2(v[j].z * rstd * gg.z, v[j].w * rstd * gg.w); o8[64 * j] = w; } }
}
__device__ __forceinline__ void prep_rows2(const float* x0, bf16* o0, u64_t* sq, int lane) {
    f32x4 v[2][8];
#pragma unroll
    for (int q = 0; q < 2; ++q) { const GAS f32x4* xr = (const GAS f32x4*)(x0 + (size_t)q * DM) + lane;
#pragma unroll
        for (int j = 0; j < 8; ++j) v[q][j] = xr[64 * j]; }
#pragma unroll
    for (int q = 0; q < 2; ++q) { GAS v2u* o8 = (GAS v2u*)(o0 + (size_t)q * DM) + lane; float s = 0.f;
#pragma unroll
        for (int j = 0; j < 8; ++j) { const f32x4 a = v[q][j]; s += (a.x * a.x + a.y * a.y) + (a.z * a.z + a.w * a.w); v2u w; w.x = pk2(a.x, a.y); w.y = pk2(a.z, a.w); o8[64 * j] = w; }
        s = wave_sum(s, lane);
        if (lane == 0) sq[q] = rowsq_fx(s); }
}
__device__ __forceinline__ void norm_rows(const float* X, const float* g, bf16* XN, int gw, int NGW, int lane) {
    for (int m = gw; m < T; m += NGW) rms_row_to_bf16(X + (size_t)m * DM, g, XN + (size_t)m * DM, nullptr, nullptr, lane);
}

template <int TYPE>
__device__ __forceinline__ void naive_attn_item(const bf16* QKV, bf16* ATT, int b, int grow, int head, int lane, const float* biasA, const float* sink, const float* rpb) {
    const int tpos = grow * 64 + lane; const size_t trow = (size_t)b * SEQ + tpos;
    int qcol, kcol, vcol, ocol;
    if (TYPE == 0) { qcol = QA + head * 64; kcol = KA + (head / 3) * 64; vcol = VA + (head / 3) * 64; ocol = OA + head * 64; }
    else if (TYPE == 1) { qcol = QB + head * 64; kcol = KB + head * 64; vcol = VB + head * 64; ocol = OB + head * 64; }
    else { qcol = QC + head * 64; kcol = KC + (head / 3) * 64; vcol = VC + (head / 3) * 64; ocol = OC + head * 64; }
    float q[64], o[64];
#pragma unroll
    for (int c = 0; c < 8; ++c) { const v4u w = *(const GAS v4u*)(QKV + trow * DIN + qcol + 8 * c);
        q[8 * c + 0] = bflo(w.x); q[8 * c + 1] = bfhi(w.x); q[8 * c + 2] = bflo(w.y); q[8 * c + 3] = bfhi(w.y); q[8 * c + 4] = bflo(w.z); q[8 * c + 5] = bfhi(w.z); q[8 * c + 6] = bflo(w.w); q[8 * c + 7] = bfhi(w.w); }
#pragma unroll
    for (int d = 0; d < 64; ++d) o[d] = 0.f;
    float m = -1e30f, l = 0.f;
    int j0, j1;
    if (TYPE == 0) { j0 = grow * 64 - 128; if (j0 < 0) j0 = 0; j1 = grow * 64 + 63 + 128; if (j1 > SEQ - 1) j1 = SEQ - 1; }
    else if (TYPE == 1) { int r0 = grow - 4; r0 = r0 < 0 ? 0 : (r0 > 24 ? 24 : r0); j0 = r0 * 64; j1 = j0 + 511; }
    else { j0 = 0; j1 = SEQ - 1; }
    int c0 = lane - 8; c0 = c0 < 0 ? 0 : (c0 > 48 ? 48 : c0);
#pragma unroll 1
    for (int j = j0; j <= j1; ++j) {
        const bf16* krow = QKV + ((size_t)b * SEQ + j) * DIN;
        float s = 0.f;
#pragma unroll
        for (int c = 0; c < 8; ++c) { const v4u w = *(const GAS v4u*)(krow + kcol + 8 * c);
            s += q[8 * c + 0] * bflo(w.x) + q[8 * c + 1] * bfhi(w.x) + q[8 * c + 2] * bflo(w.y) + q[8 * c + 3] * bfhi(w.y) + q[8 * c + 4] * bflo(w.z) + q[8 * c + 5] * bfhi(w.z) + q[8 * c + 6] * bflo(w.w) + q[8 * c + 7] * bfhi(w.w); }
        bool valid = true;
        if (TYPE == 0) { const int rel = j - tpos; valid = (rel >= -128 && rel <= 128); if (valid) s += biasA[head * 257 + rel + 128]; }
        if (TYPE == 1) { const int kr = j >> 6, kc = j & 63; valid = (kc >= c0 && kc < c0 + 16); if (valid) s += rpb[(head * 15 + (kr - grow + 7)) * 31 + (kc - lane + 15)]; }
        const float mn = valid ? fmaxf(m, s) : m;
        const float a = __expf(m - mn);
        const float p = valid ? __expf(s - mn) : 0.f;
        l = l * a + p; m = mn;
#pragma unroll
        for (int c = 0; c < 8; ++c) { const v4u w = *(const GAS v4u*)(krow + vcol + 8 * c);
            o[8 * c + 0] = o[8 * c + 0] * a + p * bflo(w.x); o[8 * c + 1] = o[8 * c + 1] * a + p * bfhi(w.x); o[8 * c + 2] = o[8 * c + 2] * a + p * bflo(w.y); o[8 * c + 3] = o[8 * c + 3] * a + p * bfhi(w.y);
            o[8 * c + 4] = o[8 * c + 4] * a + p * bflo(w.z); o[8 * c + 5] = o[8 * c + 5] * a + p * bfhi(w.z); o[8 * c + 6] = o[8 * c + 6] * a + p * bflo(w.w); o[8 * c + 7] = o[8 * c + 7] * a + p * bfhi(w.w); }
    }
    if (TYPE == 0) l += __expf(sink[head] - m);
    const float inv = 1.f / l;
#pragma unroll
    for (int c = 0; c < 8; ++c) { v4u w; w.x = pk2(o[8 * c + 0] * inv, o[8 * c + 1] * inv); w.y = pk2(o[8 * c + 2] * inv, o[8 * c + 3] * inv); w.z = pk2(o[8 * c + 4] * inv, o[8 * c + 5] * inv); w.w = pk2(o[8 * c + 6] * inv, o[8 * c + 7] * inv);
        *(GAS v4u*)(ATT + trow * DM + ocol + 8 * c) = w; }
}
__device__ __forceinline__ float rdl(float v, int l) { return __builtin_bit_cast(float, __builtin_amdgcn_readlane(__builtin_bit_cast(int, v), l)); }
__device__ __forceinline__ void naive_mem_item(const bf16* QM, const bf16* KVM, bf16* OM, const float* gq, size_t trow, int b, int head, int lane) {
    const unsigned qw = *(const GAS unsigned*)(QM + trow * MEMW + head * 128 + 2 * lane);
    float q0 = bflo(qw), q1 = bfhi(qw);
    const float ss = wave_sum(q0 * q0 + q1 * q1, lane);
    const float r = 0.08838834764831845f / sqrtf(ss * (1.f / 128.f) + EPS);
    q0 *= r * gq[2 * lane]; q1 *= r * gq[2 * lane + 1];
    const bf16* kbase = KVM + ((size_t)b * NMEM + lane) * 1024 + head * 128;
    float s[4] = {0.f, 0.f, 0.f, 0.f};
#pragma unroll 1
    for (int c = 0; c < 16; ++c) {
        float qa[8];
#pragma unroll
        for (int e = 0; e < 4; ++e) { qa[2 * e] = rdl(q0, 4 * c + e); qa[2 * e + 1] = rdl(q1, 4 * c + e); }
#pragma unroll
        for (int i = 0; i < 4; ++i) { const v4u w = *(const GAS v4u*)(kbase + (size_t)i * 64 * 1024 + 8 * c);
            s[i] += qa[0] * bflo(w.x) + qa[1] * bfhi(w.x) + qa[2] * bflo(w.y) + qa[3] * bfhi(w.y) + qa[4] * bflo(w.z) + qa[5] * bfhi(w.z) + qa[6] * bflo(w.w) + qa[7] * bfhi(w.w); }
    }
    float m = fmaxf(fmaxf(s[0], s[1]), fmaxf(s[2], s[3]));
#pragma unroll
    for (int o = 1; o < 64; o <<= 1) m = fmaxf(m, shx(m, o, lane));
    float p[4]; float l = 0.f;
#pragma unroll
    for (int i = 0; i < 4; ++i) { p[i] = __expf(s[i] - m); l += p[i]; }
    l = wave_sum(l, lane);
    const bf16* vbase = KVM + ((size_t)b * NMEM) * 1024 + 512 + head * 128 + 2 * lane;
    float o0 = 0.f, o1 = 0.f;
#pragma unroll
    for (int i = 0; i < 4; ++i) {
#pragma unroll 4
        for (int jj = 0; jj < 64; ++jj) { const float pj = rdl(p[i], jj); const unsigned w = *(const GAS unsigned*)(vbase + (size_t)(64 * i + jj) * 1024); o0 += pj * bflo(w); o1 += pj * bfhi(w); }
    }
    const float inv = 1.f / l;
    *(GAS unsigned*)(OM + trow * MEMW + head * 128 + 2 * lane) = pk2(o0 * inv, o1 * inv);
}
__device__ __forceinline__ void mixnorm_rows(bf16* ATT, const float* g, int gw, int NGW, int lane) {
    for (int m = gw; m < T; m += NGW) {
        GAS v4u* p = (GAS v4u*)(ATT + (size_t)m * DM + 32 * lane);
        v4u w[4]; float f[32]; float ss = 0.f;
#pragma unroll
        for (int c = 0; c < 4; ++c) { w[c] = p[c];
            f[8 * c + 0] = bflo(w[c].x); f[8 * c + 1] = bfhi(w[c].x); f[8 * c + 2] = bflo(w[c].y); f[8 * c + 3] = bfhi(w[c].y); f[8 * c + 4] = bflo(w[c].z); f[8 * c + 5] = bfhi(w[c].z); f[8 * c + 6] = bflo(w[c].w); f[8 * c + 7] = bfhi(w[c].w); }
#pragma unroll
        for (int i = 0; i < 32; ++i) ss += f[i] * f[i];
        const int grp = lane < 24 ? 0 : (lane < 40 ? 1 : 2);
        const float sa = wave_sum(grp == 0 ? ss : 0.f, lane), sb = wave_sum(grp == 1 ? ss : 0.f, lane), sc = wave_sum(grp == 2 ? ss : 0.f, lane);
        const float r = grp == 0 ? 1.f / sqrtf(sa * (1.f / 768.f) + EPS) : (grp == 1 ? 1.f / sqrtf(sb * (1.f / 512.f) + EPS) : 1.f / sqrtf(sc * (1.f / 768.f) + EPS));
        const float* gg = g + 32 * lane;
#pragma unroll
        for (int c = 0; c < 4; ++c) { const f32x4 g0 = *(const GAS f32x4*)(gg + 8 * c), g1 = *(const GAS f32x4*)(gg + 8 * c + 4);
            v4u o; o.x = pk2(f[8 * c + 0] * r * g0[0], f[8 * c + 1] * r * g0[1]); o.y = pk2(f[8 * c + 2] * r * g0[2], f[8 * c + 3] * r * g0[3]);
            o.z = pk2(f[8 * c + 4] * r * g1[0], f[8 * c + 5] * r * g1[1]); o.w = pk2(f[8 * c + 6] * r * g1[2], f[8 * c + 7] * r * g1[3]); p[c] = o; }
    }
}

#ifndef PEER_HD
#define PEER_HD __device__ __forceinline__
#define PEER_EXP(x) __expf(x)
#endif
template <int N> PEER_HD void bitonic_sort_desc(float* v) {
#pragma unroll
    for (int k = 2; k <= N; k <<= 1)
#pragma unroll
        for (int j = k >> 1; j > 0; j >>= 1)
#pragma unroll
            for (int i = 0; i < N; ++i) { const int l = i ^ j; if (l > i) { const bool desc = ((i & k) == 0); const float a = v[i], b = v[l]; const float hi = fmaxf(a, b), lo = fminf(a, b);
                v[i] = desc ? hi : lo; v[l] = desc ? lo : hi; } }
}
PEER_HD void merge_top16(float* a, const float* b) {
    float c[16];
#pragma unroll
    for (int i = 0; i < 16; ++i) c[i] = fmaxf(a[i], b[15 - i]);
#pragma unroll
    for (int j = 8; j > 0; j >>= 1)
#pragma unroll
        for (int i = 0; i < 16; ++i) { const int l = i ^ j; if (l > i) { const float x = c[i], y = c[l]; c[i] = fmaxf(x, y); c[l] = fminf(x, y); } }
#pragma unroll
    for (int i = 0; i < 16; ++i) a[i] = c[i];
}
PEER_HD void top16_of_64(float (&v)[64]) {
    bitonic_sort_desc<16>(&v[0]); bitonic_sort_desc<16>(&v[16]); bitonic_sort_desc<16>(&v[32]); bitonic_sort_desc<16>(&v[48]);
    merge_top16(&v[0], &v[16]); merge_top16(&v[32], &v[48]); merge_top16(&v[0], &v[32]);
}
PEER_HD float pack_idx(float s, unsigned idx, unsigned mask) { return __builtin_bit_cast(float, (__builtin_bit_cast(unsigned, s) & ~mask) | idx); }
PEER_HD unsigned low_bits(float s, unsigned mask) { return __builtin_bit_cast(unsigned, s) & mask; }
PEER_HD unsigned pick16(const float* a, unsigned i, unsigned mask) {
    unsigned r = 0;
#pragma unroll
    for (unsigned k = 0; k < 16; ++k) r = (i == k) ? low_bits(a[k], mask) : r;
    return r;
}
PEER_HD void peer_candidates(const float* a, const float* b, int* e, float* gate) {
    float c[64]; int n = 0;
#pragma unroll
    for (int i = 0; i < 16; ++i)
#pragma unroll
        for (int j = 0; j < 16; ++j) if ((i + 1) * (j + 1) <= 16) { c[n] = pack_idx(a[i] + b[j], (unsigned)(i * 16 + j), 0xffu); ++n; }
#pragma unroll
    for (int k = 50; k < 64; ++k) c[k] = -3.0e38f;
    top16_of_64(c);
    float mx = c[0], den = 0.f;
#pragma unroll
    for (int k = 0; k < 16; ++k) { const unsigned id = low_bits(c[k], 0xffu); const unsigned n0 = pick16(a, id >> 4, 0x7fu), n1 = pick16(b, id & 15u, 0x7fu);
        e[k] = (int)(n0 * 128u + n1); gate[k] = PEER_EXP(c[k] - mx); den += gate[k]; }
    const float inv = 1.f / den;
#pragma unroll
    for (int k = 0; k < 16; ++k) gate[k] *= inv;
}

__device__ __forceinline__ void peer_select_unit(const bf16* QP, const bf16* PK, int* PIDX, float* PGATE, int tb, int h, int wave, int lane) {
    const int hh = lane >> 5, tl = lane & 31; const size_t t = (size_t)tb * 256 + wave * 32 + tl;
    float ab[2][16];
#pragma unroll
    for (int p = 0; p < 2; ++p) {
        bf16x8 bq[8];
#pragma unroll
        for (int s = 0; s < 8; ++s) bq[s] = *(const GAS bf16x8*)(QP + t * DM + 256 * h + 128 * p + 16 * s + 8 * hh);
        float v[64];
#pragma unroll
        for (int nb = 0; nb < 4; ++nb) {
            f32x16 acc;
#pragma unroll
            for (int r = 0; r < 16; ++r) acc[r] = 0.f;
            const bf16* kp = PK + ((size_t)((h * 2 + p) * 128 + 32 * nb + tl)) * 128 + 8 * hh;
            bf16x8 ak[8];
#pragma unroll
            for (int s = 0; s < 8; ++s) ak[s] = *(const GAS bf16x8*)(kp + 16 * s);
#pragma unroll
            for (int s = 0; s < 8; ++s) acc = __builtin_amdgcn_mfma_f32_32x32x16_bf16(ak[s], bq[s], acc, 0, 0, 0);
#pragma unroll
            for (int r = 0; r < 16; ++r) v[16 * nb + r] = pack_idx(acc[r], (unsigned)(32 * nb + 8 * (r >> 2) + 4 * hh + (r & 3)), 0x7fu);
        }
        top16_of_64(v);
        float pv[16];
#pragma unroll
        for (int i = 0; i < 16; ++i) pv[i] = shx(v[i], 32, lane);
        merge_top16(&v[0], pv);
#pragma unroll
        for (int i = 0; i < 16; ++i) ab[p][i] = v[i];
    }
    int e[16]; float gate[16];
    peer_candidates(ab[0], ab[1], e, gate);
    if (hh == 0) { GAS v4u* o = (GAS v4u*)(PIDX + t * 128 + h * 16);
#pragma unroll
        for (int c = 0; c < 4; ++c) o[c] = (v4u){(unsigned)e[4 * c], (unsigned)e[4 * c + 1], (unsigned)e[4 * c + 2], (unsigned)e[4 * c + 3]}; }
    else { GAS f32x4* o = (GAS f32x4*)(PGATE + t * 128 + h * 16);
#pragma unroll
        for (int c = 0; c < 4; ++c) o[c] = (f32x4){gate[4 * c], gate[4 * c + 1], gate[4 * c + 2], gate[4 * c + 3]}; }
}

typedef float f32x2 __attribute__((ext_vector_type(2)));
typedef unsigned v6u __attribute__((ext_vector_type(6)));
typedef float v32f __attribute__((ext_vector_type(32)));
typedef v4u __attribute__((aligned(8))) v4u_a8;
constexpr float PU_SCALE6 = 90.0f, PV_SCALE6 = 5.65f;
__device__ __forceinline__ unsigned enc_e2m3(float v) {
    const float a = fminf(fabsf(v), 7.5f);
    unsigned code;
    if (a < 1.0f) code = (unsigned)__builtin_rintf(a * 8.f);
    else { const unsigned b = __builtin_bit_cast(unsigned, a) - 0x3F800000u; code = ((b + 0x7FFFFu + ((b >> 20) & 1u)) >> 20) + 8u; }
    return code | (v < 0.f ? 32u : 0u);
}
__device__ __forceinline__ void convert_fp6_rows(const float* src, unsigned char* dst, int nrows, float scale, const float* gain, int gw, int NGW, int lane) {
    for (int r = gw; r < nrows; r += NGW) {
        const float* sp = src + (size_t)r * DM + 4 * lane; const float* gp = gain ? gain + (size_t)(r / PEER_N) * DM + 4 * lane : nullptr;
        unsigned w[6] = {0u, 0u, 0u, 0u, 0u, 0u};
#pragma unroll
        for (int j = 0; j < 8; ++j) { f32x4 a = *(const GAS f32x4*)(sp + 256 * j) * scale; if (gp) a = a * *(const GAS f32x4*)(gp + 256 * j);
#pragma unroll
            for (int e = 0; e < 4; ++e) { const unsigned code = enc_e2m3(a[e]); const int bp = 6 * (4 * j + e), wi = bp >> 5, sh = bp & 31;
                w[wi] |= code << sh; if (sh > 26) w[wi + 1] |= code >> (32 - sh); } }
        unsigned char* dp = dst + (size_t)r * 1536 + 24 * lane;
        *(GAS v4u_a8*)dp = (v4u){w[0], w[1], w[2], w[3]}; *(GAS v2u*)(dp + 16) = (v2u){w[4], w[5]};
    }
}
constexpr float PV_SCALE4 = 5.65f, PU_SCALE4 = 90.0f;
__device__ __forceinline__ unsigned enc_e2m1(float v) {
    const float a = fabsf(v);
    const unsigned code = a < 0.25f ? 0u : a < 0.75f ? 1u : a < 1.25f ? 2u : a < 1.75f ? 3u : a < 2.5f ? 4u : a < 3.5f ? 5u : a < 5.0f ? 6u : 7u;
    return code | (v < 0.f ? 8u : 0u);
}
__device__ __forceinline__ void convert_fp4_rows(const float* src, unsigned char* dst, int nrows, float scale, const float* gain, int gw, int NGW, int lane) {
    for (int r0 = 2 * gw; r0 < nrows; r0 += 2 * NGW) {
        f32x4 a[2][8];
#pragma unroll
        for (int q = 0; q < 2; ++q) { const float* sp = src + (size_t)(r0 + q) * DM + 4 * lane;
#pragma unroll
            for (int j = 0; j < 8; ++j) a[q][j] = *(const GAS f32x4*)(sp + 256 * j); }
#pragma unroll
        for (int q = 0; q < 2; ++q) { const int r = r0 + q; const float* gp = gain ? gain + (size_t)(r / PEER_N) * DM + 4 * lane : nullptr;
            unsigned w[4] = {0u, 0u, 0u, 0u};
#pragma unroll
            for (int j = 0; j < 8; ++j) { f32x4 v = a[q][j] * scale; if (gp) v = v * *(const GAS f32x4*)(gp + 256 * j);
#pragma unroll
                for (int e = 0; e < 4; ++e) { const int i = 4 * j + e; w[i >> 3] |= enc_e2m1(v[e]) << (4 * (i & 7)); } }
            *(GAS v4u*)(dst + (size_t)r * 1024 + 16 * lane) = (v4u){w[0], w[1], w[2], w[3]}; }
    }
}
#define PG4_LOAD(buf, tab, idlo, idhi, g) do { _Pragma("unroll") for (int i_ = 0; i_ < PG6_R; ++i_) { const int k_ = (g) * PG6_R + i_; \
        const int e_ = __builtin_amdgcn_readlane(k_ < 64 ? idlo : idhi, k_ & 63); buf[i_] = __builtin_amdgcn_raw_buffer_load_b128(tab, (int)voff4, e_ * 1024, 0); } } while (0)
#define PG4_DOT1(buf, i_, dst) do { f32x2 a_ = {0.f, 0.f}; _Pragma("unroll") for (int c_ = 0; c_ < 4; ++c_) { const unsigned u_ = buf[i_][c_]; \
        a_ += __builtin_amdgcn_cvt_scalef32_pk_f32_fp4(u_, 1.0f, 0) * x[4 * c_ + 0]; a_ += __builtin_amdgcn_cvt_scalef32_pk_f32_fp4(u_, 1.0f, 1) * x[4 * c_ + 1]; \
        a_ += __builtin_amdgcn_cvt_scalef32_pk_f32_fp4(u_, 1.0f, 2) * x[4 * c_ + 2]; a_ += __builtin_amdgcn_cvt_scalef32_pk_f32_fp4(u_, 1.0f, 3) * x[4 * c_ + 3]; } dst = a_.x + a_.y; __builtin_amdgcn_sched_barrier(0); } while (0)
#define PG4_DOT(buf, g) do { float p_[8]; _Pragma("unroll") for (int i_ = 0; i_ < 8; ++i_) PG4_DOT1(buf, i_, p_[i_]); \
        float q_[4]; _Pragma("unroll") for (int i_ = 0; i_ < 4; ++i_) { const float keep_ = b5 ? p_[i_ + 4] : p_[i_], send_ = b5 ? p_[i_] : p_[i_ + 4]; q_[i_] = keep_ + shx(send_, 32, lane); } \
        float r_[2]; _Pragma("unroll") for (int i_ = 0; i_ < 2; ++i_) { const float keep_ = b4 ? q_[i_ + 2] : q_[i_], send_ = b4 ? q_[i_] : q_[i_ + 2]; r_[i_] = keep_ + shx(send_, 16, lane); } \
        float s_; { const float keep_ = b3 ? r_[1] : r_[0], send_ = b3 ? r_[0] : r_[1]; s_ = keep_ + shx(send_, 8, lane); } \
        s_ += shx(s_, 4, lane); s_ += shx(s_, 2, lane); s_ += shx(s_, 1, lane); \
        if ((lane & 7) == 0) wl[(g) * 8 + (lane >> 3)] = s_; } while (0)
#define PG4_AXPY(buf, g) do { _Pragma("unroll") for (int i_ = 0; i_ < PG6_R; ++i_) { const float w_ = wl[(g) * PG6_R + i_]; const f32x2 wv_ = {w_, w_}; \
        _Pragma("unroll") for (int c_ = 0; c_ < 4; ++c_) { const unsigned u_ = buf[i_][c_]; \
            y[4 * c_ + 0] += __builtin_amdgcn_cvt_scalef32_pk_f32_fp4(u_, 1.0f, 0) * wv_; y[4 * c_ + 1] += __builtin_amdgcn_cvt_scalef32_pk_f32_fp4(u_, 1.0f, 1) * wv_; \
            y[4 * c_ + 2] += __builtin_amdgcn_cvt_scalef32_pk_f32_fp4(u_, 1.0f, 2) * wv_; y[4 * c_ + 3] += __builtin_amdgcn_cvt_scalef32_pk_f32_fp4(u_, 1.0f, 3) * wv_; } \
        __builtin_amdgcn_sched_barrier(0); } } while (0)
#ifndef PG6_R
#define PG6_R 8
#endif
#define PG6_LOAD(buf, tab, idlo, idhi, g) do { _Pragma("unroll") for (int i_ = 0; i_ < PG6_R; ++i_) { const int k_ = (g) * PG6_R + i_; \
        const int e_ = __builtin_amdgcn_readlane(k_ < 64 ? idlo : idhi, k_ & 63); const unsigned char* rp_ = (tab) + (size_t)(unsigned)e_ * 1536u; \
        const v4u a_ = *(const GAS v4u_a8*)(rp_ + voff); const v2u b_ = *(const GAS v2u*)(rp_ + voff + 16); buf[i_] = (v6u){a_.x, a_.y, a_.z, a_.w, b_.x, b_.y}; } } while (0)
#define PG6_DOT1(buf, i_, dst) do { const v32f f_ = __builtin_amdgcn_cvt_scalef32_pk32_f32_fp6(buf[i_], 1.0f); f32x2 a_ = {0.f, 0.f}; \
        _Pragma("unroll") for (int c_ = 0; c_ < 16; ++c_) a_ += (f32x2){f_[2 * c_], f_[2 * c_ + 1]} * x[c_]; dst = a_.x + a_.y; __builtin_amdgcn_sched_barrier(0); } while (0)
#if PG6_R == 8
#define PG6_DOT(buf, g) do { float p_[8]; _Pragma("unroll") for (int i_ = 0; i_ < 8; ++i_) PG6_DOT1(buf, i_, p_[i_]); \
        float q_[4]; _Pragma("unroll") for (int i_ = 0; i_ < 4; ++i_) { const float keep_ = b5 ? p_[i_ + 4] : p_[i_], send_ = b5 ? p_[i_] : p_[i_ + 4]; q_[i_] = keep_ + shx(send_, 32, lane); } \
        float r_[2]; _Pragma("unroll") for (int i_ = 0; i_ < 2; ++i_) { const float keep_ = b4 ? q_[i_ + 2] : q_[i_], send_ = b4 ? q_[i_] : q_[i_ + 2]; r_[i_] = keep_ + shx(send_, 16, lane); } \
        float s_; { const float keep_ = b3 ? r_[1] : r_[0], send_ = b3 ? r_[0] : r_[1]; s_ = keep_ + shx(send_, 8, lane); } \
        s_ += shx(s_, 4, lane); s_ += shx(s_, 2, lane); s_ += shx(s_, 1, lane); \
        if ((lane & 7) == 0) wl[(g) * 8 + (lane >> 3)] = s_; } while (0)
#else
#define PG6_DOT(buf, g) do { float p_[4]; _Pragma("unroll") for (int i_ = 0; i_ < 4; ++i_) PG6_DOT1(buf, i_, p_[i_]); \
        float r_[2]; _Pragma("unroll") for (int i_ = 0; i_ < 2; ++i_) { const float keep_ = b5 ? p_[i_ + 2] : p_[i_], send_ = b5 ? p_[i_] : p_[i_ + 2]; r_[i_] = keep_ + shx(send_, 32, lane); } \
        float s_; { const float keep_ = b4 ? r_[1] : r_[0], send_ = b4 ? r_[0] : r_[1]; s_ = keep_ + shx(send_, 16, lane); } \
        s_ += shx(s_, 8, lane); s_ += shx(s_, 4, lane); s_ += shx(s_, 2, lane); s_ += shx(s_, 1, lane); \
        if ((lane & 15) == 0) wl[(g) * 4 + (lane >> 4)] = s_; } while (0)
#endif
#define PG6_AXPY(buf, g) do { _Pragma("unroll") for (int i_ = 0; i_ < PG6_R; ++i_) { const float w_ = wl[(g) * PG6_R + i_]; const f32x2 wv_ = {w_, w_}; \
        const v32f f_ = __builtin_amdgcn_cvt_scalef32_pk32_f32_fp6(buf[i_], 1.0f); _Pragma("unroll") for (int c_ = 0; c_ < 16; ++c_) y[c_] += (f32x2){f_[2 * c_], f_[2 * c_ + 1]} * wv_; __builtin_amdgcn_sched_barrier(0); } } while (0)
__device__ __forceinline__ unsigned shxu(unsigned v, int k, int lane) { return (unsigned)__builtin_amdgcn_ds_bpermute((lane ^ k) << 2, (int)v); }
__device__ __forceinline__ void wave_sort128(unsigned& a, unsigned& b, int lane) {
#pragma unroll
    for (int k = 2; k <= 128; k <<= 1) {
#pragma unroll
        for (int j = k >> 1; j > 0; j >>= 1) {
            if (j == 64) { const unsigned lo = a < b ? a : b, hi = a < b ? b : a; a = lo; b = hi; }
            else {
                const unsigned pa = shxu(a, j, lane), pb = shxu(b, j, lane);
                const bool lower = (lane & j) == 0;
                const bool asc_a = (lane & k) == 0, asc_b = ((lane + 64) & k) == 0;
                const bool take_min_a = (lower == asc_a), take_min_b = (lower == asc_b);
                a = take_min_a ? (a < pa ? a : pa) : (a < pa ? pa : a);
                b = take_min_b ? (b < pb ? b : pb) : (b < pb ? pb : b);
            }
        }
    }
}
#ifndef PEER_U_FP4
#define PEER_U_FP4 1
#endif
#if PEER_U_FP4
typedef v4u urow_t;
#define PGU_LOAD PG4_LOAD
#define PGU_DOT PG4_DOT
constexpr float PU_SCALE = PU_SCALE4; constexpr int PU_STRIDE = 1024;
#else
typedef v6u urow_t;
#define PGU_LOAD PG6_LOAD
#define PGU_DOT PG6_DOT
constexpr float PU_SCALE = PU_SCALE6; constexpr int PU_STRIDE = 1536;
#endif
constexpr float PU_SCALEI = 135.0f, PX_SCALEI = 20.0f;
__device__ __forceinline__ void peer_v_pass(bf16* XN, const unsigned char* PV6, const int* PIDX, const float* PGATE, const int* PARTI, float* X, u64_t* rowsq_out, LAS float* wl, int gw, int NGW, int lane) {
    const unsigned voff4 = 16u * (unsigned)lane, l4 = 4u * (unsigned)lane, l8 = 8u * (unsigned)lane, l16 = 16u * (unsigned)lane;
    constexpr int NG = 128 / PG6_R;
    const __amdgpu_buffer_rsrc_t PVr = __builtin_amdgcn_make_buffer_rsrc((void*)PV6, 0, PEER_N * 1024, 0x00020000);
    for (int t_ = gw; t_ < T; t_ += NGW) {
        int t = t_; asm volatile("" : "+s"(t));
        const char* pidx_t = (const char*)(PIDX + (size_t)t * 128); const char* pgate_t = (const char*)(PGATE + (size_t)t * 128);
        const int idlo = *(const GAS int*)(pidx_t + l4), idhi = *(const GAS int*)(pidx_t + l4 + 256);
        v4u AV[PG6_R], BV[PG6_R];
        PG4_LOAD(AV, PVr, idlo, idhi, 0);
        {
            int s0 = 0, s1 = 0;
#pragma unroll
            for (int sp = 0; sp < 8; ++sp) { const char* pp = (const char*)(PARTI + ((size_t)sp * T + t) * 128); s0 += *(const GAS int*)(pp + l4); s1 += *(const GAS int*)(pp + l4 + 256); }
            const float d0 = (float)s0 * (1.f / (PX_SCALEI * PU_SCALEI)), d1 = (float)s1 * (1.f / (PX_SCALEI * PU_SCALEI));
            const float g0 = *(const GAS float*)(pgate_t + l4), g1 = *(const GAS float*)(pgate_t + l4 + 256);
            const float w0 = g0 * 0.5f * d0 * (1.f + erff(d0 * 0.70710678118654752f)) * (1.f / PV_SCALE4), w1 = g1 * 0.5f * d1 * (1.f + erff(d1 * 0.70710678118654752f)) * (1.f / PV_SCALE4);
            wl[lane] = w0; wl[64 + lane] = w1;
            LDS_WAIT(); asm volatile("" ::: "memory");
        }
        f32x2 y[16];
#pragma unroll
        for (int i = 0; i < 16; ++i) y[i] = (f32x2){0.f, 0.f};
#pragma unroll 1
        for (int g = 0; g < NG; g += 2) {
            PG4_LOAD(BV, PVr, idlo, idhi, g + 1);
            PG4_AXPY(AV, g);
            if (g + 2 < NG) PG4_LOAD(AV, PVr, idlo, idhi, g + 2);
            PG4_AXPY(BV, g + 1);
        }
        {   char* xo = (char*)(X + (size_t)t * DM);
            char* xbo = (char*)(XN + (size_t)t * DM); float ss = 0.f;
#pragma unroll
            for (int j = 0; j < 8; ++j) { const v2u a = *(const GAS v2u*)(xbo + l8 + 512 * j); f32x4 v = (f32x4){bflo(a.x), bfhi(a.x), bflo(a.y), bfhi(a.y)}; v += (f32x4){y[2 * j].x, y[2 * j].y, y[2 * j + 1].x, y[2 * j + 1].y};
                if (X) *(GAS f32x4*)(xo + l16 + 1024 * j) = v;
                ss += (v[0] * v[0] + v[1] * v[1]) + (v[2] * v[2] + v[3] * v[3]); *(GAS v2u*)(xbo + l8 + 512 * j) = (v2u){pk2(v[0], v[1]), pk2(v[2], v[3])}; }
            if (rowsq_out) { ss = wave_sum(ss, lane); if (lane == 0) rowsq_out[t] = rowsq_fx(ss); } }
        LDS_WAIT(); asm volatile("" ::: "memory");
    }
}


__device__ __forceinline__ unsigned enc_i4(float v) { int q = (int)__builtin_rintf(v); q = q < -7 ? -7 : (q > 7 ? 7 : q); return (unsigned)q & 15u; }
__device__ __forceinline__ void convert_int4_plain(const float* src, unsigned char* dst, int nrows, float scale, const float* gain, int gw, int NGW, int lane) {
    for (int r0 = 2 * gw; r0 < nrows; r0 += 2 * NGW) {
        f32x4 a[2][8];
#pragma unroll
        for (int q = 0; q < 2; ++q) { const float* sp = src + (size_t)(r0 + q) * DM + 4 * lane;
#pragma unroll
            for (int j = 0; j < 8; ++j) a[q][j] = *(const GAS f32x4*)(sp + 256 * j); }
#pragma unroll
        for (int q = 0; q < 2; ++q) { const int r = r0 + q; const float* gp = gain ? gain + (size_t)(r / PEER_N) * DM + 4 * lane : nullptr;
#pragma unroll
            for (int j = 0; j < 8; ++j) { f32x4 v = a[q][j] * scale; if (gp) v = v * *(const GAS f32x4*)(gp + 256 * j);
                const unsigned w = enc_i4(v[0]) | (enc_i4(v[1]) << 4) | (enc_i4(v[2]) << 8) | (enc_i4(v[3]) << 12);
                *(GAS unsigned short*)(dst + (size_t)r * 1024 + 128 * j + 2 * lane) = (unsigned short)w; } }
    }
}
__device__ __forceinline__ void peer_xquant_unit(const bf16* XN, const u64_t* rowsq, unsigned* XQH, unsigned* XQL, int tb, int sl, int tid) {
    for (int it = tid; it < 256 * 32; it += NTHREADS) {
        const int t = tb * 256 + (it >> 5), c8 = it & 31;
        const float xs = PX_SCALEI * rowsq_rs(rowsq, t);
        const v4u w = *(const GAS v4u*)(XN + (size_t)t * DM + 256 * sl + 8 * c8);
        const float f[8] = {bflo(w.x), bfhi(w.x), bflo(w.y), bfhi(w.y), bflo(w.z), bfhi(w.z), bflo(w.w), bfhi(w.w)};
        unsigned hi = 0u, lo = 0u;
#pragma unroll
        for (int j = 0; j < 8; ++j) { int q = (int)__builtin_rintf(f[j] * xs); q = q < -119 ? -119 : (q > 119 ? 119 : q);
            const int xl = ((q + 8) & 15) - 8, xh = (q - xl) >> 4;
            hi |= ((unsigned)xh & 15u) << (4 * j); lo |= ((unsigned)xl & 15u) << (4 * j); }
        XQH[(size_t)t * 256 + 32 * sl + c8] = hi; XQL[(size_t)t * 256 + 32 * sl + c8] = lo;
    }
}
#define PI_LOADROWS(buf, tab, ids, i0) do { _Pragma("unroll") for (int i_ = 0; i_ < 8; ++i_) buf[i_] = __builtin_amdgcn_raw_buffer_load_b128(tab, ids[(i0) + i_] * 1024 + (int)soff, 0, 0); } while (0)
#define PI_LOADIDS(ids, t) do { const char* ip_ = (const char*)PIDX + ((size_t)(t) * 128 + 16 * g) * 4; _Pragma("unroll") for (int c_ = 0; c_ < 4; ++c_) { const v4u q_ = *(const GAS v4u*)(ip_ + 16 * c_); \
        ids[4 * c_] = (int)q_.x; ids[4 * c_ + 1] = (int)q_.y; ids[4 * c_ + 2] = (int)q_.z; ids[4 * c_ + 3] = (int)q_.w; } } while (0)
#define PI_UGROUP(buf, i0) do { _Pragma("unroll") for (int i_ = 0; i_ < 8; ++i_) { int ah_ = 0, al_ = 0; \
        _Pragma("unroll") for (int c_ = 0; c_ < 4; ++c_) { ah_ = __builtin_amdgcn_sdot8((int)buf[i_][c_], (int)xh[c_], ah_, false); al_ = __builtin_amdgcn_sdot8((int)buf[i_][c_], (int)xl[c_], al_, false); } \
        int p_ = 16 * ah_ + al_; p_ += __builtin_amdgcn_ds_bpermute((lane ^ 1) << 2, p_); p_ += __builtin_amdgcn_ds_bpermute((lane ^ 2) << 2, p_); p_ += __builtin_amdgcn_ds_bpermute((lane ^ 4) << 2, p_); \
        if (m == (((i0) + i_) >> 1)) { if (((i0) + i_) & 1) keep1 = p_; else keep0 = p_; } } } while (0)
#define PI_LOADROWS16(buf, tab, ids) do { _Pragma("unroll") for (int i_ = 0; i_ < 16; ++i_) buf[i_] = __builtin_amdgcn_raw_buffer_load_b128(tab, ids[i_] * 1024 + (int)soff, 0, 0); } while (0)
#define PI_LOADX(xh_, xl_, t) do { xh_ = *(const GAS v4u*)((const char*)XQH + (size_t)(t) * 1024 + soff); xl_ = *(const GAS v4u*)((const char*)XQL + (size_t)(t) * 1024 + soff); } while (0)
#define PI_COMPUTE16(buf, xh_, xl_, t) do { int keep0 = 0, keep1 = 0; \
        _Pragma("unroll") for (int i_ = 0; i_ < 16; ++i_) { int ah_ = 0, al_ = 0; \
            _Pragma("unroll") for (int c_ = 0; c_ < 4; ++c_) { ah_ = __builtin_amdgcn_sdot8((int)buf[i_][c_], (int)xh_[c_], ah_, false); al_ = __builtin_amdgcn_sdot8((int)buf[i_][c_], (int)xl_[c_], al_, false); } \
            int p_ = 16 * ah_ + al_; p_ += __builtin_amdgcn_update_dpp(0, p_, 0xB1, 0xf, 0xf, true); p_ += __builtin_amdgcn_update_dpp(0, p_, 0x4E, 0xf, 0xf, true); p_ += __builtin_amdgcn_update_dpp(0, p_, 0x141, 0xf, 0xf, true);   \
            if (m == (i_ >> 1)) { if (i_ & 1) keep1 = p_; else keep0 = p_; } } \
        if ((t) < T) *(GAS v2u*)(PARTI + ((size_t)s * T + (t)) * 128 + 2 * lane) = (v2u){(unsigned)keep0, (unsigned)keep1}; } while (0)
__device__ __forceinline__ void peer_u_phase_i4(const unsigned* XQH, const unsigned* XQL, const unsigned char* PU, const int* PIDX, int* PARTI, int bid, int G, int wave, int lane) {
    const int s = bid & 7, nr = (G - s + 7) >> 3, q = (bid >> 3) * NWAVES + wave, stride = nr * NWAVES, g = lane >> 3, m = lane & 7;
    const unsigned soff = 128u * (unsigned)s + 16u * (unsigned)m;
    if (q >= T) return;
    const __amdgpu_buffer_rsrc_t PUr = __builtin_amdgcn_make_buffer_rsrc((void*)PU, 0, PEER_N * 1024, 0x00020000);
#define PI_CL(t) ((t) < T ? (t) : T - 1)
    int I1[16], I2[16]; v4u xh0, xl0, xh1, xl1, xh2, xl2, RA[16], RB[16];
    PI_LOADIDS(I1, q); PI_LOADX(xh0, xl0, q);
    PI_LOADROWS16(RA, PUr, I1);
    PI_LOADIDS(I1, PI_CL(q + stride)); PI_LOADX(xh1, xl1, PI_CL(q + stride));
    for (int t = q; t < T; t += 2 * stride) {
        PI_LOADROWS16(RB, PUr, I1);
        PI_LOADIDS(I2, PI_CL(t + 2 * stride)); PI_LOADX(xh2, xl2, PI_CL(t + 2 * stride));
        PI_COMPUTE16(RA, xh0, xl0, t);
        PI_LOADROWS16(RA, PUr, I2);
        PI_LOADIDS(I1, PI_CL(t + 3 * stride)); PI_LOADX(xh0, xl0, PI_CL(t + 3 * stride));
        PI_COMPUTE16(RB, xh1, xl1, t + stride);
        xh1 = xh0; xl1 = xl0; xh0 = xh2; xl0 = xl2;
    }
#undef PI_CL
}


constexpr float PV_SCALE4S = 5.65f;
__device__ __forceinline__ unsigned enc_e2m1s(float v) {
    const float a = fabsf(v);
    const unsigned code = a < 0.25f ? 0u : a < 0.75f ? 1u : a < 1.25f ? 2u : a < 1.75f ? 3u : a < 2.5f ? 4u : a < 3.5f ? 5u : a < 5.0f ? 6u : 7u;
    return code | (v < 0.f ? 8u : 0u);
}
__device__ __forceinline__ void convert_fp4_plain(const float* src, unsigned char* dst, int nrows, float scale, const float* gain, int gw, int NGW, int lane) {
    for (int r0 = 2 * gw; r0 < nrows; r0 += 2 * NGW) {
        f32x4 a[2][8];
#pragma unroll
        for (int q = 0; q < 2; ++q) { const float* sp = src + (size_t)(r0 + q) * DM + 4 * lane;
#pragma unroll
            for (int j = 0; j < 8; ++j) a[q][j] = *(const GAS f32x4*)(sp + 256 * j); }
#pragma unroll
        for (int q = 0; q < 2; ++q) { const int r = r0 + q; const float* gp = gain ? gain + (size_t)(r / PEER_N) * DM + 4 * lane : nullptr;
#pragma unroll
            for (int j = 0; j < 8; ++j) { f32x4 v = a[q][j] * scale; if (gp) v = v * *(const GAS f32x4*)(gp + 256 * j);
                const unsigned w = enc_e2m1s(v[0]) | (enc_e2m1s(v[1]) << 4) | (enc_e2m1s(v[2]) << 8) | (enc_e2m1s(v[3]) << 12);
                *(GAS unsigned short*)(dst + (size_t)r * 1024 + 128 * j + 2 * lane) = (unsigned short)w; } }
    }
}
#define PVS_LOADMETA(ids, pp, gg, t) do { PI_LOADIDS(ids, t); _Pragma("unroll") for (int sp_ = 0; sp_ < 8; ++sp_) pp[sp_] = *(const GAS v2u*)(PARTI + ((size_t)sp_ * T + (t)) * 128 + 2 * lane); \
        gg = *(const GAS f32x2*)(PGATE + (size_t)(t) * 128 + 2 * lane); } while (0)
#define PVS_COMPUTE16(buf, pp, gg, t) do { float w0, w1; { int s0_ = 0, s1_ = 0; _Pragma("unroll") for (int sp_ = 0; sp_ < 8; ++sp_) { s0_ += (int)pp[sp_].x; s1_ += (int)pp[sp_].y; } \
            const float d0_ = (float)s0_ * (1.f / (PX_SCALEI * PU_SCALEI)), d1_ = (float)s1_ * (1.f / (PX_SCALEI * PU_SCALEI)); \
            w0 = gg.x * 0.5f * d0_ * (1.f + erff(d0_ * 0.70710678118654752f)) * (1.f / PV_SCALE4S); w1 = gg.y * 0.5f * d1_ * (1.f + erff(d1_ * 0.70710678118654752f)) * (1.f / PV_SCALE4S); } \
        f32x2 y[16]; _Pragma("unroll") for (int i_ = 0; i_ < 16; ++i_) y[i_] = (f32x2){0.f, 0.f}; \
        _Pragma("unroll") for (int i_ = 0; i_ < 16; ++i_) { \
            const float w_ = __builtin_bit_cast(float, __builtin_amdgcn_ds_bpermute(((lane & 56) | (i_ >> 1)) << 2, __builtin_bit_cast(int, (i_ & 1) ? w1 : w0))); const f32x2 wv_ = {w_, w_}; \
            _Pragma("unroll") for (int c_ = 0; c_ < 4; ++c_) { const unsigned u_ = buf[i_][c_]; \
                y[4 * c_ + 0] += __builtin_amdgcn_cvt_scalef32_pk_f32_fp4(u_, 1.0f, 0) * wv_; y[4 * c_ + 1] += __builtin_amdgcn_cvt_scalef32_pk_f32_fp4(u_, 1.0f, 1) * wv_; \
                y[4 * c_ + 2] += __builtin_amdgcn_cvt_scalef32_pk_f32_fp4(u_, 1.0f, 2) * wv_; y[4 * c_ + 3] += __builtin_amdgcn_cvt_scalef32_pk_f32_fp4(u_, 1.0f, 3) * wv_; } } \
        {   LAS float* wp_ = yl + g * 288 + m * 36; \
            _Pragma("unroll") for (int c_ = 0; c_ < 8; ++c_) *(LAS f32x4*)(wp_ + 4 * c_) = (f32x4){y[2 * c_].x, y[2 * c_].y, y[2 * c_ + 1].x, y[2 * c_ + 1].y}; \
            LDS_WAIT(); asm volatile("" ::: "memory"); \
            f32x4 acc_ = {0.f, 0.f, 0.f, 0.f}; const LAS float* rp_ = yl + (lane >> 3) * 36 + 4 * (lane & 7); \
            _Pragma("unroll") for (int gg_ = 0; gg_ < 8; ++gg_) acc_ += *(const LAS f32x4*)(rp_ + gg_ * 288); \
            LDS_WAIT(); asm volatile("" ::: "memory"); \
            if ((t) < T) { bf16* xp_ = XN + (size_t)(t) * DM + 256 * s + 4 * lane; const v2u a_ = *(const GAS v2u*)xp_; \
                const f32x4 v_ = (f32x4){bflo(a_.x), bfhi(a_.x), bflo(a_.y), bfhi(a_.y)} + acc_; \
                *(GAS v2u*)xp_ = (v2u){pk2(v_[0], v_[1]), pk2(v_[2], v_[3])}; \
                if (Xout) *(GAS f32x4*)(Xout + (size_t)(t) * DM + 256 * s + 4 * lane) = v_; \
                if (rowsq_out) { const float ss_ = wave_sum((v_[0] * v_[0] + v_[1] * v_[1]) + (v_[2] * v_[2] + v_[3] * v_[3]), lane); if (lane == 0) atomicAdd(rowsq_out + (t), rowsq_fx(ss_)); } } } } while (0)
__device__ __forceinline__ void peer_v_phase_s(bf16* XN, const unsigned char* PV, const int* PIDX, const float* PGATE, const int* PARTI, float* Xout, u64_t* rowsq_out, LAS float* yl, int bid, int G, int wave, int lane) {
    const int s = bid & 7, nr = (G - s + 7) >> 3, q = (bid >> 3) * NWAVES + wave, stride = nr * NWAVES, g = lane >> 3, m = lane & 7;
    const unsigned soff = 128u * (unsigned)s + 16u * (unsigned)m;
    if (q >= T) return;
    const __amdgpu_buffer_rsrc_t PVr = __builtin_amdgcn_make_buffer_rsrc((void*)PV, 0, PEER_N * 1024, 0x00020000);
#define PVS_CL(t) ((t) < T ? (t) : T - 1)
    int I0[16], I1[16]; v2u P0[8], P1[8]; f32x2 G0, G1; v4u RA[16], RB[16];
#define PVS_LOADPG(pp, gg, t) do { _Pragma("unroll") for (int sp_ = 0; sp_ < 8; ++sp_) pp[sp_] = *(const GAS v2u*)(PARTI + ((size_t)sp_ * T + (t)) * 128 + 2 * lane); gg = *(const GAS f32x2*)(PGATE + (size_t)(t) * 128 + 2 * lane); } while (0)
    PI_LOADIDS(I0, q); PVS_LOADPG(P0, G0, q);
    PI_LOADROWS16(RA, PVr, I0);
    PI_LOADIDS(I1, PVS_CL(q + stride)); PVS_LOADPG(P1, G1, PVS_CL(q + stride));
    for (int t = q; t < T; t += 2 * stride) {
        PI_LOADROWS16(RB, PVr, I1);
        PI_LOADIDS(I0, PVS_CL(t + 2 * stride));
        PVS_COMPUTE16(RA, P0, G0, t);
        PVS_LOADPG(P0, G0, PVS_CL(t + 2 * stride));
        PI_LOADROWS16(RA, PVr, I0);
        PI_LOADIDS(I1, PVS_CL(t + 3 * stride));
        PVS_COMPUTE16(RB, P1, G1, t + stride);
        PVS_LOADPG(P1, G1, PVS_CL(t + 3 * stride));
    }
#undef PVS_LOADPG
#undef PVS_CL
}

typedef short s16x4 __attribute__((ext_vector_type(4)));
typedef __attribute__((address_space(3))) const char* lds_cptr;
__device__ __forceinline__ s16x4 vtr(lds_cptr p) { return __builtin_bit_cast(s16x4, __builtin_amdgcn_ds_read_tr16_b64_v4i16((__attribute__((address_space(3))) s16x4*)p)); }
__device__ __forceinline__ unsigned cvtpk(float lo, float hi) { unsigned r; asm("v_cvt_pk_bf16_f32 %0, %1, %2" : "=v"(r) : "v"(lo), "v"(hi)); return r; }
constexpr int AT_K0 = 0, AT_V0 = 16384, AT_TAB = 32768;
constexpr float LOG2E = 1.4426950408889634f;
template <int TYPE>
__device__ __forceinline__ void attn_unit(LAS unsigned char* lds, const bf16* QKV, bf16* ATT, u64_t* mixsq, int b, int head, int qb, const float* tabsrc, float Cl2, float sinkl2, int tid) {
    const int lane = tid & 63, w = __builtin_amdgcn_readfirstlane(tid >> 6), hh = lane >> 5, l31 = lane & 31;
    int qcol, kcol, vcol, ocol;
    if (TYPE == 0) { qcol = QA + head * 64; kcol = KA + (head / 3) * 64; vcol = VA + (head / 3) * 64; ocol = OA + head * 64; }
    else if (TYPE == 1) { qcol = QB + head * 64; kcol = KB + head * 64; vcol = VB + head * 64; ocol = OB + head * 64; }
    else { qcol = QC + head * 64; kcol = KC + (head / 3) * 64; vcol = VC + (head / 3) * 64; ocol = OC + head * 64; }
    const int q0 = 256 * qb + 32 * w, qpos = q0 + l31;
    int t_begin, t_end;
    if (TYPE == 0) { t_begin = 4 * qb - 2; if (t_begin < 0) t_begin = 0; t_end = 4 * qb + 6; if (t_end > 32) t_end = 32; }
    else if (TYPE == 1) { int a = 4 * qb - 4; a = a < 0 ? 0 : (a > 24 ? 24 : a); int e = 4 * qb - 1; e = e < 0 ? 0 : (e > 24 ? 24 : e); t_begin = a; t_end = e + 8; }
    else { t_begin = 0; t_end = 32; }
    LAS float* tab = (LAS float*)(lds + AT_TAB);
    if (TYPE == 0) { for (int i = tid; i < 1024; i += NTHREADS) { const int rel = i - 448; tab[i] = (rel >= -128 && rel <= 128) ? tabsrc[head * 257 + rel + 128] * LOG2E - Cl2 : -1e30f; } }
    if (TYPE == 1) { for (int i = tid; i < 15 * 31; i += NTHREADS) tab[i] = tabsrc[head * 465 + i] * LOG2E - Cl2; }
    bf16x8 qf[4];
    {   const bf16* qp = QKV + ((size_t)b * SEQ + qpos) * DIN + qcol + 8 * hh;
#pragma unroll
        for (int s = 0; s < 4; ++s) qf[s] = *(const GAS bf16x8*)(qp + 16 * s); }
    const int srow = tid >> 3, sch = tid & 7;
    const bf16* kg = QKV + ((size_t)b * SEQ + srow) * DIN + kcol + sch * 8;
    const bf16* vg = QKV + ((size_t)b * SEQ + srow) * DIN + vcol + sch * 8;
    const int kst = srow * 128 + ((sch ^ ((srow >> 1) & 7)) * 16);
    const int vst = srow * 128 + (((sch >> 2) ^ ((srow >> 1) & 1)) * 64) + (sch & 3) * 16;
    int kread[4], vread[2];
#pragma unroll
    for (int s = 0; s < 4; ++s) kread[s] = l31 * 128 + (((2 * s + hh) ^ ((lane >> 1) & 7)) * 16);
#pragma unroll
    for (int db = 0; db < 2; ++db) vread[db] = (4 * hh + ((lane >> 2) & 3)) * 128 + ((db ^ ((lane >> 3) & 1)) * 64) + 32 * ((lane >> 4) & 1) + 8 * (lane & 3);
    f32x16 O0, O1;
#pragma unroll
    for (int r = 0; r < 16; ++r) { O0[r] = 0.f; O1[r] = 0.f; }
    float lsum = 0.f;
    const int rw = 4 * qb + (w >> 1), cq = 32 * (w & 1) + l31;
    int r0w = rw - 4; r0w = r0w < 0 ? 0 : (r0w > 24 ? 24 : r0w);
    int c0 = cq - 8; c0 = c0 < 0 ? 0 : (c0 > 48 ? 48 : c0);
    {   const v4u kr = *(const GAS v4u*)(kg + (size_t)t_begin * 64 * DIN), vr = *(const GAS v4u*)(vg + (size_t)t_begin * 64 * DIN);
        *(LAS v4u*)(lds + AT_K0 + kst) = kr; *(LAS v4u*)(lds + AT_V0 + vst) = vr; }
    __syncthreads();
    for (int t = t_begin; t < t_end; ++t) {
        const int cur = (t - t_begin) & 1;
        v4u kr, vr;
        if (t + 1 < t_end) { kr = *(const GAS v4u*)(kg + (size_t)(t + 1) * 64 * DIN); vr = *(const GAS v4u*)(vg + (size_t)(t + 1) * 64 * DIN); }
        bool need = true;
        if (TYPE == 0) need = (64 * t <= q0 + 31 + 128) && (64 * t + 63 >= q0 - 128);
        if (TYPE == 1) need = (t >= r0w) && (t < r0w + 8);
        if (need) {
            const lds_cptr kb_ = (lds_cptr)(lds + AT_K0 + cur * 8192), vb_ = (lds_cptr)(lds + AT_V0 + cur * 8192);
            bf16x8 kf[8];
#pragma unroll
            for (int s = 0; s < 4; ++s) { kf[2 * s] = *(const LAS bf16x8*)(kb_ + kread[s]); kf[2 * s + 1] = *(const LAS bf16x8*)(kb_ + kread[s] + 4096); }
            f32x16 S0, S1;
            if (TYPE == 2) {
#pragma unroll
                for (int r = 0; r < 16; ++r) { S0[r] = -Cl2; S1[r] = -Cl2; }
            } else if (TYPE == 0) {
                const LAS float* tb = tab + (64 * t - qpos + 448 + 4 * hh);
#pragma unroll
                for (int r = 0; r < 16; ++r) { S0[r] = tb[8 * (r >> 2) + (r & 3)]; S1[r] = tb[32 + 8 * (r >> 2) + (r & 3)]; }
            } else {
                const LAS float* tb = tab + ((t - rw + 7) * 31 - cq + 15 + 4 * hh);
                const int kc0 = 4 * hh - c0;
#pragma unroll
                for (int r = 0; r < 16; ++r) { const int ka = 8 * (r >> 2) + (r & 3), kb2 = 32 + ka;
                    S0[r] = ((unsigned)(ka + kc0) < 16u) ? tb[ka] : -1e30f; S1[r] = ((unsigned)(kb2 + kc0) < 16u) ? tb[kb2] : -1e30f; }
            }
            __builtin_amdgcn_sched_barrier(0);
#pragma unroll
            for (int s = 0; s < 4; ++s) { S0 = __builtin_amdgcn_mfma_f32_32x32x16_bf16(kf[2 * s], qf[s], S0, 0, 0, 0); S1 = __builtin_amdgcn_mfma_f32_32x32x16_bf16(kf[2 * s + 1], qf[s], S1, 0, 0, 0); }
            s16x4 vf[4][2][2];
#pragma unroll
            for (int ks = 0; ks < 2; ++ks)
#pragma unroll
                for (int db = 0; db < 2; ++db) { vf[ks][db][0] = vtr(vb_ + vread[db] + (16 * ks) * 128); vf[ks][db][1] = vtr(vb_ + vread[db] + (16 * ks + 8) * 128); }
            __builtin_amdgcn_sched_barrier(0);
#pragma unroll
            for (int r = 0; r < 16; ++r) { S0[r] = __builtin_amdgcn_exp2f(S0[r]); S1[r] = __builtin_amdgcn_exp2f(S1[r]); }
#pragma unroll
            for (int r = 0; r < 16; ++r) lsum += S0[r] + S1[r];
            bf16x8 pb[4];
#pragma unroll
            for (int hf = 0; hf < 2; ++hf) {
                v4u a, c;
#pragma unroll
                for (int j = 0; j < 4; ++j) { a[j] = cvtpk(S0[8 * hf + 2 * j], S0[8 * hf + 2 * j + 1]); c[j] = cvtpk(S1[8 * hf + 2 * j], S1[8 * hf + 2 * j + 1]); }
                pb[hf] = __builtin_bit_cast(bf16x8, a); pb[2 + hf] = __builtin_bit_cast(bf16x8, c);
            }
#pragma unroll
            for (int ks = 2; ks < 4; ++ks)
#pragma unroll
                for (int db = 0; db < 2; ++db) { vf[ks][db][0] = vtr(vb_ + vread[db] + (16 * ks) * 128); vf[ks][db][1] = vtr(vb_ + vread[db] + (16 * ks + 8) * 128); }
            __builtin_amdgcn_sched_barrier(0);
#pragma unroll
            for (int ks = 0; ks < 4; ++ks) {
                const bf16x8 va = __builtin_shufflevector(vf[ks][0][0], vf[ks][0][1], 0, 1, 2, 3, 4, 5, 6, 7), vb2 = __builtin_shufflevector(vf[ks][1][0], vf[ks][1][1], 0, 1, 2, 3, 4, 5, 6, 7);
                O0 = __builtin_amdgcn_mfma_f32_32x32x16_bf16(va, pb[ks], O0, 0, 0, 0); O1 = __builtin_amdgcn_mfma_f32_32x32x16_bf16(vb2, pb[ks], O1, 0, 0, 0);
            }
        }
        __builtin_amdgcn_sched_barrier(0);
        if (t + 1 < t_end) { *(LAS v4u*)(lds + AT_K0 + (cur ^ 1) * 8192 + kst) = kr; *(LAS v4u*)(lds + AT_V0 + (cur ^ 1) * 8192 + vst) = vr; }
        __syncthreads();
    }
    lsum += shx(lsum, 32, lane);
    if (TYPE == 0) lsum += __builtin_amdgcn_exp2f(sinkl2 - Cl2);
    const float inv = 1.f / lsum;
    {   float ss = 0.f;
#pragma unroll
        for (int r = 0; r < 16; ++r) { const float a = O0[r] * inv, c = O1[r] * inv; ss += a * a + c * c; }
        ss += shx(ss, 32, lane);
        if (hh == 0) (void)__hip_atomic_fetch_add((GAS u64_t*)(mixsq + (size_t)b * SEQ + qpos), rowsq_fx(ss), __ATOMIC_RELAXED, __HIP_MEMORY_SCOPE_AGENT); }
    bf16* op = ATT + ((size_t)b * SEQ + qpos) * DM + ocol + 4 * hh;
#pragma unroll
    for (int g4 = 0; g4 < 4; ++g4) {
        v2u o0, o1; o0.x = cvtpk(O0[4 * g4] * inv, O0[4 * g4 + 1] * inv); o0.y = cvtpk(O0[4 * g4 + 2] * inv, O0[4 * g4 + 3] * inv);
        o1.x = cvtpk(O1[4 * g4] * inv, O1[4 * g4 + 1] * inv); o1.y = cvtpk(O1[4 * g4 + 2] * inv, O1[4 * g4 + 3] * inv);
        *(GAS v2u*)(op + 8 * g4) = o0; *(GAS v2u*)(op + 32 + 8 * g4) = o1;
    }
}


constexpr int MA_K0 = 0, MA_V0 = 32768;
__device__ __forceinline__ void mem_unit(LAS unsigned char* lds, const bf16* QM, const bf16* KVM, bf16* OM, const float* gq, int tb, int head, float Cl2, int tid) {
    const int lane = tid & 63, w = __builtin_amdgcn_readfirstlane(tid >> 6), hh = lane >> 5, l31 = lane & 31;
    const size_t trow = (size_t)tb * 256 + 32 * w + l31; const int b = tb >> 3;
    bf16x8 qf[8];
    {   const bf16* qp = QM + trow * MEMW + head * 128 + 8 * hh;
#pragma unroll
        for (int s = 0; s < 8; ++s) qf[s] = *(const GAS bf16x8*)(qp + 16 * s);
        float ss = 0.f;
#pragma unroll
        for (int s = 0; s < 8; ++s)
#pragma unroll
            for (int j = 0; j < 8; ++j) { const float f = __builtin_bit_cast(float, (unsigned)(unsigned short)qf[s][j] << 16); ss += f * f; }
        ss += shx(ss, 32, lane);
        const float r = 0.12751743074602468f / sqrtf(ss * (1.f / 128.f) + EPS);
#pragma unroll
        for (int s = 0; s < 8; ++s) { const f32x4 g0 = *(const GAS f32x4*)(gq + 16 * s + 8 * hh), g1 = *(const GAS f32x4*)(gq + 16 * s + 8 * hh + 4);
            v4u o;
#pragma unroll
            for (int j = 0; j < 4; ++j) { const float f0 = __builtin_bit_cast(float, (unsigned)(unsigned short)qf[s][2 * j] << 16), f1 = __builtin_bit_cast(float, (unsigned)(unsigned short)qf[s][2 * j + 1] << 16);
                const float ga = (2 * j < 4) ? g0[2 * j] : g1[2 * j - 4], gb2 = (2 * j + 1 < 4) ? g0[2 * j + 1] : g1[2 * j + 1 - 4];
                o[j] = cvtpk(f0 * r * ga, f1 * r * gb2); }
            qf[s] = __builtin_bit_cast(bf16x8, o); }
    }
    const int srow = tid >> 3, sch = tid & 7;
    const bf16* kg = KVM + ((size_t)b * NMEM + srow) * 1024 + head * 128 + sch * 8;
    const bf16* vg = kg + 512;
    const int kst0 = srow * 256 + ((sch ^ (srow & 15)) * 16), kst1 = srow * 256 + (((sch + 8) ^ (srow & 15)) * 16);
    const int vst0 = srow * 256 + ((((sch) >> 2) ^ (srow & 3)) * 64) + (sch & 3) * 16, vst1 = srow * 256 + ((((sch + 8) >> 2) ^ (srow & 3)) * 64) + (sch & 3) * 16;
    int kread[8], vread[4];
#pragma unroll
    for (int s = 0; s < 8; ++s) kread[s] = l31 * 256 + (((2 * s + hh) ^ (l31 & 15)) * 16);
#pragma unroll
    for (int db = 0; db < 4; ++db) vread[db] = (4 * hh + ((lane >> 2) & 3)) * 256 + ((db ^ ((lane >> 2) & 3)) * 64) + 32 * ((lane >> 4) & 1) + 8 * (lane & 3);
    f32x16 O[4];
#pragma unroll
    for (int db = 0; db < 4; ++db)
#pragma unroll
        for (int r = 0; r < 16; ++r) O[db][r] = 0.f;
    float lsum = 0.f;
    {   const v4u k0 = *(const GAS v4u*)kg, k1 = *(const GAS v4u*)(kg + 64), v0 = *(const GAS v4u*)vg, v1 = *(const GAS v4u*)(vg + 64);
        *(LAS v4u*)(lds + MA_K0 + kst0) = k0; *(LAS v4u*)(lds + MA_K0 + kst1) = k1; *(LAS v4u*)(lds + MA_V0 + vst0) = v0; *(LAS v4u*)(lds + MA_V0 + vst1) = v1; }
    __syncthreads();
#pragma unroll 1
    for (int t = 0; t < 4; ++t) {
        const int cur = t & 1;
        v4u k0, k1, v0, v1;
        if (t + 1 < 4) { const bf16* kn = kg + (size_t)(t + 1) * 64 * 1024; k0 = *(const GAS v4u*)kn; k1 = *(const GAS v4u*)(kn + 64); v0 = *(const GAS v4u*)(kn + 512); v1 = *(const GAS v4u*)(kn + 576); }
        const lds_cptr kb_ = (lds_cptr)(lds + MA_K0 + cur * 16384), vb_ = (lds_cptr)(lds + MA_V0 + cur * 16384);
        f32x16 S0, S1;
#pragma unroll
        for (int r = 0; r < 16; ++r) { S0[r] = -Cl2; S1[r] = -Cl2; }
#pragma unroll
        for (int s = 0; s < 8; ++s) { const bf16x8 a0 = *(const LAS bf16x8*)(kb_ + kread[s]), a1 = *(const LAS bf16x8*)(kb_ + kread[s] + 8192);
            S0 = __builtin_amdgcn_mfma_f32_32x32x16_bf16(a0, qf[s], S0, 0, 0, 0); S1 = __builtin_amdgcn_mfma_f32_32x32x16_bf16(a1, qf[s], S1, 0, 0, 0); }
#pragma unroll
        for (int r = 0; r < 16; ++r) { S0[r] = __builtin_amdgcn_exp2f(S0[r]); S1[r] = __builtin_amdgcn_exp2f(S1[r]); lsum += S0[r] + S1[r]; }
        bf16x8 pb[4];
#pragma unroll
        for (int hf = 0; hf < 2; ++hf) {
            v4u a, c;
#pragma unroll
            for (int j = 0; j < 4; ++j) { a[j] = cvtpk(S0[8 * hf + 2 * j], S0[8 * hf + 2 * j + 1]); c[j] = cvtpk(S1[8 * hf + 2 * j], S1[8 * hf + 2 * j + 1]); }
            pb[hf] = __builtin_bit_cast(bf16x8, a); pb[2 + hf] = __builtin_bit_cast(bf16x8, c);
        }
#pragma unroll
        for (int ks = 0; ks < 4; ++ks)
#pragma unroll
            for (int db = 0; db < 4; ++db) {
                const s16x4 a0 = vtr(vb_ + vread[db] + (16 * ks) * 256), a1 = vtr(vb_ + vread[db] + (16 * ks + 8) * 256);
                const bf16x8 va = __builtin_shufflevector(a0, a1, 0, 1, 2, 3, 4, 5, 6, 7);
                O[db] = __builtin_amdgcn_mfma_f32_32x32x16_bf16(va, pb[ks], O[db], 0, 0, 0);
            }
        if (t + 1 < 4) { LAS unsigned char* kn = lds + MA_K0 + (cur ^ 1) * 16384; LAS unsigned char* vn = lds + MA_V0 + (cur ^ 1) * 16384;
            *(LAS v4u*)(kn + kst0) = k0; *(LAS v4u*)(kn + kst1) = k1; *(LAS v4u*)(vn + vst0) = v0; *(LAS v4u*)(vn + vst1) = v1; }
        __syncthreads();
    }
    lsum += shx(lsum, 32, lane);
    const float inv = 1.f / lsum;
    bf16* op = OM + trow * MEMW + head * 128 + 4 * hh;
#pragma unroll
    for (int db = 0; db < 4; ++db)
#pragma unroll
        for (int g4 = 0; g4 < 4; ++g4) { v2u o; o.x = cvtpk(O[db][4 * g4] * inv, O[db][4 * g4 + 1] * inv); o.y = cvtpk(O[db][4 * g4 + 2] * inv, O[db][4 * g4 + 3] * inv); *(GAS v2u*)(op + 32 * db + 8 * g4) = o; }
}

__device__ __forceinline__ float wave_max(float v, int lane) {
#pragma unroll
    for (int o = 1; o < 64; o <<= 1) v = fmaxf(v, shx(v, o, lane));
    return v;
}
struct Args { const float* in[23]; float* out; unsigned char* ws; int ph_lo, ph_hi, use_bar, pad; };
#ifndef MK_OFF
#define MK_OFF 0u
#endif
#ifndef REP_ATT
#define REP_ATT 1
#endif
#ifndef REP_P0
#define REP_P0 1
#endif
#ifndef REP_U
#define REP_U 1
#endif
#ifndef REP_GEMM
#define REP_GEMM 1
#endif
#ifndef REP_NORM
#define REP_NORM 1
#endif
#ifndef REP_SEL
#define REP_SEL 1
#endif
#ifndef REP_MEM
#define REP_MEM 1
#endif
#define PHON(k) (!((MK_OFF >> (k)) & 1u))
constexpr int PH_PER_LAYER = 10, PH_BASE = 3, N_PHASES = PH_BASE + DEPTH * PH_PER_LAYER;
constexpr int PTAB_OFF = LDSCTL_OFF + 1024;

__global__ void __launch_bounds__(NTHREADS, 2) mega(Args a) {
    extern __shared__ __attribute__((aligned(16))) unsigned char lds_raw[];
    LAS unsigned char* lds = (LAS unsigned char*)lds_raw;
    {   const int tid0 = threadIdx.x;
        for (int u = tid0; u < (LDS_BYTES - LDSCTL_OFF) / 4; u += NTHREADS) ((LAS unsigned*)(lds + LDSCTL_OFF))[u] = 0u;
        __syncthreads();
        if (tid0 < 23) ((LAS unsigned long long*)(lds + PTAB_OFF))[tid0] = (unsigned long long)a.in[tid0];
        if (tid0 == 23) ((LAS unsigned long long*)(lds + PTAB_OFF))[23] = (unsigned long long)a.out;
        if (tid0 == 24) ((LAS unsigned long long*)(lds + PTAB_OFF))[24] = (unsigned long long)a.ws;
        __syncthreads();
    }
    volatile LAS unsigned* MISC = (volatile LAS unsigned*)(lds + MISC_OFF);
    const int G = gridDim.x, bid = blockIdx.x, NGW = G * NWAVES;
    const int use_bar = a.use_bar;
    XcdBarrier bar; bar.bar = (unsigned*)(a.ws + WS_CTL) + CW_BAR; bar.x = 0; bar.st = MISC + 8;
    if (use_bar) bar = xcd_barrier_post((unsigned*)(a.ws + WS_CTL) + CW_BAR, MISC + 8);
    const int lo = a.ph_lo, hi = a.ph_hi;
#define IN(k) (lo <= (k) && (k) < hi)
#define SEAM(k) do { if (use_bar && IN(k) && IN((k) + 1)) xcd_barrier(bar); } while (0)
#define PHL() int tid_ = threadIdx.x; asm volatile("" : "+v"(tid_)); const int lane_ = tid_ & 63, wave_ = __builtin_amdgcn_readfirstlane(tid_ >> 6), gw_ = bid * NWAVES + wave_; (void)lane_; (void)gw_; \
              int pz_ = 0; asm volatile("" : "+s"(pz_))
#define PTR(i) ((const float*)ldptr(lds, (i) + pz_))
#define WSP() ((unsigned char*)ldptr(lds, 24 + pz_))
#define OUTP() ((float*)ldptr(lds, 23 + pz_))

    if (IN(0) && PHON(0)) {
        PHL(); unsigned char* ws = WSP();
        LAS float* scr = (LAS float*)(lds + RING_OFF + wave_ * 16384);
        constexpr int I_IN = 32 * 128, I_OUT = 32 * 64, I_MQ = 32 * 16, I_MKV = 32 * 32, I_MO = 8 * 64, I_PQ = 32 * 64, I_L = I_IN + I_OUT + I_MQ + I_MKV + I_MO + I_PQ;
        for (int it = gw_; it < DEPTH * I_L; it += NGW) {
            const int l = it / I_L; int r = it % I_L;
            if (r < I_IN) { transpose_item<true>(PTR(4) + (size_t)l * DM * DIN, DM, DIN, (bf16*)(ws + WS_WIN) + (size_t)l * DIN * DM, scr, r, lane_, PTR(3) + (size_t)l * DM); continue; } r -= I_IN;
            if (r < I_OUT) { transpose_item<false>(PTR(11) + (size_t)l * DM * DM, DM, DM, (bf16*)(ws + WS_WOUT) + (size_t)l * DM * DM, scr, r, lane_, PTR(10) + (size_t)l * DM); continue; } r -= I_OUT;
            if (r < I_MQ) { transpose_item<false>(PTR(14) + (size_t)l * DM * MEMW, DM, MEMW, (bf16*)(ws + WS_WMQ) + (size_t)l * MEMW * DM, scr, r, lane_, PTR(12) + (size_t)l * DM); continue; } r -= I_MQ;
            if (r < I_MKV) { transpose_item<false>(PTR(15) + (size_t)l * DM * 1024, DM, 1024, (bf16*)(ws + WS_WMKV) + (size_t)l * 1024 * DM, scr, r, lane_); continue; } r -= I_MKV;
            if (r < I_MO) { transpose_item<false>(PTR(17) + (size_t)l * MEMW * DM, MEMW, DM, (bf16*)(ws + WS_WMO) + (size_t)l * DM * MEMW, scr, r, lane_); continue; } r -= I_MO;
            transpose_item<false>(PTR(19) + (size_t)l * DM * DM, DM, DM, (bf16*)(ws + WS_WPQ) + (size_t)l * DM * DM, scr, r, lane_, PTR(18) + (size_t)l * DM);
        }
        const size_t gtid = (size_t)bid * NTHREADS + tid_, nth = (size_t)G * NTHREADS;
        convert_bf16(PTR(20), (bf16*)(ws + WS_PKEYS), (size_t)DEPTH * 8 * 2 * 128 * 128, gtid, nth);
        convert_int4_plain(PTR(21), ws + WS_PU, DEPTH * PEER_N, PU_SCALEI, PTR(18), gw_, NGW, lane_);
        convert_fp4_rows(PTR(22), ws + WS_PV, DEPTH * PEER_N, PV_SCALE4, nullptr, gw_, NGW, lane_);
        {   const float* x0 = PTR(0); bf16* XN = (bf16*)(ws + WS_XN); u64_t* rsq = (u64_t*)(ws + WS_ROWSQ);
            for (int m = 2 * gw_; m < T; m += 2 * NGW) prep_rows2(x0 + (size_t)m * DM, XN + (size_t)m * DM, rsq + m, lane_); }
        {   const float* mem = PTR(1); const float* gkv = PTR(13); bf16* MEMN = (bf16*)(ws + WS_MEMN);
            for (int m = gw_; m < BATCH * NMEM; m += NGW)
                rms_row_to_bf16(mem + (size_t)m * DM, gkv, MEMN + (size_t)m * DM, gkv + DM, MEMN + (size_t)(BATCH * NMEM + m) * DM, lane_); }
        float* rope = (float*)(ws + WS_ROPE); float* biasA = (float*)(ws + WS_BIASA);
        if (gtid < 64 * 16) { const int pos = (int)gtid >> 4, i = (int)gtid & 15; const float ang = (float)pos * ROPE_INV[i]; rope[gtid * 2] = cosf(ang); rope[gtid * 2 + 1] = sinf(ang); }
        if (gtid < 12 * 257) { const int h = (int)gtid / 257, rel = (int)gtid % 257 - 128; biasA[gtid] = PTR(2)[t5_bucket(rel) * 12 + h]; }
    }
    SEAM(0);
    if (IN(1) && PHON(1)) {
#pragma unroll 1
        for (int l = 0; l < DEPTH; ++l) {
            PHL(); unsigned char* ws = WSP();
            pg8::Gemm g{(bf16*)(ws + WS_MEMN) + (size_t)l * BATCH * NMEM * DM, (bf16*)(ws + WS_WMKV) + (size_t)l * 1024 * DM, BATCH * NMEM, 1024, DM};
            OffsetOrder S; S.init(BATCH * NMEM, 1024, G, bid, 64 * l);
            pg8::EpiBf16<0> E{(bf16*)(ws + WS_KVM) + (size_t)l * BATCH * NMEM * 1024, 1024, nullptr, 0, 0, 1.f};
            pg8::gemm_phase<pg8::EpiBf16<0>, OffsetOrder, true, true>(lds + RING_OFF, g, S, E, tid_);
            __syncthreads();
        }
    }
    SEAM(1);
    if (IN(2) && PHON(2)) {
        PHL(); unsigned char* ws = WSP(); bf16* KVM = (bf16*)(ws + WS_KVM); const float* gm = PTR(16);
#ifdef PROBE_INSTR
        {
            f32x2 a0 = {1.f + lane_, 2.f}, a1 = {3.f, 4.f}, a2 = {5.f, 6.f}, a3 = {7.f, 8.f}; unsigned u0 = tid_ * 2654435761u, u1 = u0 ^ 0x9e3779b9u; int i0 = (int)u0, i1 = (int)u1;
            v6u w6 = {u0, u1, u0 + 1, u1 + 1, u0 + 2, u1 + 2}; v32f f6; float e0 = 0.5f + lane_, e1 = 1.5f;
            for (int it = 0; it < 20000; ++it) {
#pragma unroll
                for (int k = 0; k < 8; ++k) {
#if PROBE_INSTR == 1
                    a0 = a0 * a1 + a2; a1 = a1 * a2 + a3; a2 = a2 * a3 + a0; a3 = a3 * a0 + a1;
#elif PROBE_INSTR == 2
                    a0 += __builtin_amdgcn_cvt_scalef32_pk_f32_fp4(u0, 1.0f, 0); a1 += __builtin_amdgcn_cvt_scalef32_pk_f32_fp4(u1, 1.0f, 1); a2 += __builtin_amdgcn_cvt_scalef32_pk_f32_fp4(u0, 1.0f, 2); a3 += __builtin_amdgcn_cvt_scalef32_pk_f32_fp4(u1, 1.0f, 3); u0 += 0x11111111u; u1 += 0x01010101u;
#elif PROBE_INSTR == 3
                    f6 = __builtin_amdgcn_cvt_scalef32_pk32_f32_fp6(w6, 1.0f); a0 += (f32x2){f6[0], f6[31]}; w6[0] += 0x11111111u; w6[5] += 0x01010101u;
#elif PROBE_INSTR == 4
                    e0 = __builtin_amdgcn_exp2f(e0); e1 = __builtin_amdgcn_exp2f(e1); e0 = e0 * 0.001f; e1 = e1 * 0.001f;
#else
                    i0 = __builtin_amdgcn_sdot8((int)u0, (int)u1, i0, false); i1 = __builtin_amdgcn_sdot8((int)u1, (int)u0, i1, false); u0 += 0x11111111u; u1 += 0x01010101u;
#endif
                }
            }
            const float chk = a0.x + a0.y + a1.x + a2.y + a3.x + e0 + e1 + (float)(i0 ^ i1);
            if (chk == 1.2345e-33f) *(float*)(ws + WS_BIASA + 15000) = chk;
        }
#endif
        for (int m = gw_; m < DEPTH * BATCH * NMEM; m += NGW) {
            const int l = m / (BATCH * NMEM);
            GAS v4u* p = (GAS v4u*)(KVM + (size_t)m * 1024 + 8 * lane_);
            const v4u w = *p;
            float f[8] = {bflo(w.x), bfhi(w.x), bflo(w.y), bfhi(w.y), bflo(w.z), bfhi(w.z), bflo(w.w), bfhi(w.w)};
            float ss = 0.f;
#pragma unroll
            for (int i = 0; i < 8; ++i) ss += f[i] * f[i];
            ss += shx(ss, 1, lane_); ss += shx(ss, 2, lane_); ss += shx(ss, 4, lane_); ss += shx(ss, 8, lane_);
            const float r = 1.f / sqrtf(ss * (1.f / 128.f) + EPS);
            const float* gk = gm + (size_t)l * 256 + 128 + 8 * (lane_ & 15);
            v4u o; o.x = pk2(f[0] * r * gk[0], f[1] * r * gk[1]); o.y = pk2(f[2] * r * gk[2], f[3] * r * gk[3]); o.z = pk2(f[4] * r * gk[4], f[5] * r * gk[5]); o.w = pk2(f[6] * r * gk[6], f[7] * r * gk[7]);
            *p = o;
        }
    }
    SEAM(2);

#pragma unroll 1
    for (int l = 0; l < DEPTH; ++l) {
        const int pb = PH_BASE + PH_PER_LAYER * l;
        if (IN(pb + 0) && PHON(3)) { PHL(); unsigned char* ws = WSP();
            pg8::Gemm g{(bf16*)(ws + WS_XN), (bf16*)(ws + WS_WIN) + (size_t)l * DIN * DM, T, DIN, DM}; pg8::StaticOrder S; S.init(T, DIN, G, bid);
            pg8::EpiQKV E{(bf16*)(ws + WS_QKV), PTR(5) + (size_t)l * 128, PTR(7) + (size_t)l * 128, PTR(9) + (size_t)l * 128, (const float*)(ws + WS_ROPE), (const u64_t*)(ws + WS_ROWSQ) + (size_t)(l * 3 + 0) * T};
            pg8::gemm_phase<pg8::EpiQKV, pg8::StaticOrder, true, true>(lds + RING_OFF, g, S, E, tid_);
        }
        SEAM(pb + 0);
        if (IN(pb + 1) && PHON(4)) { PHL(); unsigned char* ws = WSP();
            const float* sink = PTR(6) + (size_t)l * 12; const float* rpb = PTR(8) + (size_t)l * 8 * 15 * 31; const float* biasA = (const float*)(ws + WS_BIASA);
            const bf16* QKV = (const bf16*)(ws + WS_QKV); bf16* ATT = (bf16*)(ws + WS_ATT);
            const float* ga = PTR(5) + (size_t)l * 128; const float* gb = PTR(7) + (size_t)l * 128; const float* gc = PTR(9) + (size_t)l * 128;
            const float CaL2 = 8.f * wave_max(fabsf(ga[lane_]), lane_) * wave_max(fabsf(ga[64 + lane_]), lane_) * LOG2E;
            const float CbL2 = 8.f * wave_max(fabsf(gb[lane_]), lane_) * wave_max(fabsf(gb[64 + lane_]), lane_) * LOG2E;
            const float CcL2 = 8.f * wave_max(fabsf(gc[lane_]), lane_) * wave_max(fabsf(gc[64 + lane_]), lane_) * LOG2E;
            const int vc = (G % 8 == 0) ? (bid % 8) * (G / 8) + bid / 8 : bid;
            u64_t* mixsq = (u64_t*)(ws + WS_MIXSQ) + (size_t)l * 3 * T;
            for (int u = vc; u < BATCH * 12 * 8; u += G) attn_unit<2>(lds, QKV, ATT, mixsq + 2 * (size_t)T, u / 96, (u >> 3) % 12, u & 7, nullptr, CcL2, 0.f, tid_);
            for (int u = vc; u < BATCH * 8 * 8; u += G) attn_unit<1>(lds, QKV, ATT, mixsq + (size_t)T, u >> 6, (u >> 3) & 7, u & 7, rpb, CbL2, 0.f, tid_);
            for (int u = vc; u < BATCH * 12 * 8; u += G) { const int head = (u >> 3) % 12; attn_unit<0>(lds, QKV, ATT, mixsq, u / 96, head, u & 7, biasA, CaL2, sink[head] * LOG2E, tid_); }
        }
        SEAM(pb + 1);
        if (IN(pb + 2) && PHON(5)) { PHL(); unsigned char* ws = WSP();
            pg8::Gemm g{(bf16*)(ws + WS_ATT), (bf16*)(ws + WS_WOUT) + (size_t)l * DM * DM, T, DM, DM}; pg8::StaticOrder S; S.init(T, DM, G, bid);
            LAS float* ftab = (LAS float*)(lds + LDSCTL_OFF + 2048); LAS int* pmtab = (LAS int*)(lds + LDSCTL_OFF + 1536);
            {   const u64_t* mixsq = (const u64_t*)(ws + WS_MIXSQ) + (size_t)l * 3 * T;
#pragma unroll
                for (int i = 0; i < 4; ++i) { pg8::Unit uu; uu.pm = -1; uu.pn = 0; const bool ok = S.next(i, uu); if (tid_ == 0) pmtab[i] = ok ? uu.pm : -1;
                    if (ok && tid_ < 256) { const size_t row = (size_t)uu.pm * 256 + tid_;
                        const float ra = 1.0f / sqrtf((float)*(const GAS u64_t*)(mixsq + row) * (5.9604644775390625e-08f / 768.0f) + EPS), rb = 1.0f / sqrtf((float)*(const GAS u64_t*)(mixsq + T + row) * (5.9604644775390625e-08f / 512.0f) + EPS),
                                    rc = 1.0f / sqrtf((float)*(const GAS u64_t*)(mixsq + 2 * (size_t)T + row) * (5.9604644775390625e-08f / 768.0f) + EPS);
                        ftab[i * 256 + tid_] = ra / rb; ftab[1024 + i * 256 + tid_] = rb / rc; ftab[2048 + i * 256 + tid_] = rc; } }
                __syncthreads(); }
            pg8::EpiResidMix E{(bf16*)(ws + WS_XN), DM, (u64_t*)(ws + WS_ROWSQ) + (size_t)(l * 3 + 1) * T, ftab, pmtab};
            pg8::gemm_phase<pg8::EpiResidMix, pg8::StaticOrder, true, true>(lds + RING_OFF, g, S, E, tid_);
        }
        SEAM(pb + 2);
        if (IN(pb + 3) && PHON(6)) { PHL(); unsigned char* ws = WSP();
            pg8::Gemm g{(bf16*)(ws + WS_XN), (bf16*)(ws + WS_WMQ) + (size_t)l * MEMW * DM, T, MEMW, DM}; pg8::StaticOrder S; S.init(T, MEMW, G, bid);
            pg8::EpiBf16Row E{(bf16*)(ws + WS_QM), MEMW, (const u64_t*)(ws + WS_ROWSQ) + (size_t)(l * 3 + 1) * T};
            pg8::gemm_phase<pg8::EpiBf16Row, pg8::StaticOrder, true, true>(lds + RING_OFF, g, S, E, tid_);
        }
        SEAM(pb + 3);
        if (IN(pb + 4) && PHON(7)) { PHL(); unsigned char* ws = WSP();
            const bf16* kvm = (const bf16*)(ws + WS_KVM) + (size_t)l * BATCH * NMEM * 1024; const float* gq = PTR(16) + (size_t)l * 256;
            const float CmL2 = 11.313708498984761f * wave_max(fmaxf(fabsf(gq[lane_]), fabsf(gq[64 + lane_])), lane_) * wave_max(fmaxf(fabsf(gq[128 + lane_]), fabsf(gq[192 + lane_])), lane_) * LOG2E;
            for (int u = bid; u < (T / 256) * 4; u += G) mem_unit(lds, (const bf16*)(ws + WS_QM), kvm, (bf16*)(ws + WS_OM), gq, u >> 2, u & 3, CmL2, tid_);
        }
        SEAM(pb + 4);
        if (IN(pb + 5) && PHON(8)) { PHL(); unsigned char* ws = WSP();
            pg8::Gemm g{(bf16*)(ws + WS_OM), (bf16*)(ws + WS_WMO) + (size_t)l * DM * MEMW, T, DM, MEMW}; pg8::StaticOrder S; S.init(T, DM, G, bid);
            pg8::EpiResid E{(bf16*)(ws + WS_XN), DM, (u64_t*)(ws + WS_ROWSQ) + (size_t)(l * 3 + 2) * T};
            pg8::gemm_phase<pg8::EpiResid, pg8::StaticOrder, true, true>(lds + RING_OFF, g, S, E, tid_);
        }
        SEAM(pb + 5);
        if (IN(pb + 6) && PHON(9)) { PHL(); unsigned char* ws = WSP();
            pg8::Gemm g{(bf16*)(ws + WS_XN), (bf16*)(ws + WS_WPQ) + (size_t)l * DM * DM, T, DM, DM}; pg8::StaticOrder S; S.init(T, DM, G, bid);
            pg8::EpiBf16Row E{(bf16*)(ws + WS_QP), DM, (const u64_t*)(ws + WS_ROWSQ) + (size_t)(l * 3 + 2) * T};
            pg8::gemm_phase<pg8::EpiBf16Row, pg8::StaticOrder, true, true>(lds + RING_OFF, g, S, E, tid_);
        }
        SEAM(pb + 6);
        if (IN(pb + 7) && PHON(10)) { PHL(); unsigned char* ws = WSP();
            const bf16* pk = (const bf16*)(ws + WS_PKEYS) + (size_t)l * 8 * 2 * 128 * 128;
            for (int u = bid; u < (T / 256) * PEER_H; u += G) { peer_select_unit((const bf16*)(ws + WS_QP), pk, (int*)(ws + WS_PIDX), (float*)(ws + WS_PGATE), u >> 3, u & 7, wave_, lane_);
                peer_xquant_unit((const bf16*)(ws + WS_XN), (const u64_t*)(ws + WS_ROWSQ) + (size_t)(l * 3 + 2) * T, (unsigned*)(ws + WS_XQH), (unsigned*)(ws + WS_XQL), u >> 3, u & 7, tid_); }
        }
        SEAM(pb + 7);
        if (IN(pb + 8) && PHON(11)) { PHL(); unsigned char* ws = WSP();
            peer_u_phase_i4((const unsigned*)(ws + WS_XQH), (const unsigned*)(ws + WS_XQL), ws + WS_PU + (size_t)l * PEER_N * 1024, (const int*)(ws + WS_PIDX), (int*)(ws + WS_PARTI), bid, G, wave_, lane_); }
        SEAM(pb + 8);
        if (IN(pb + 9) && PHON(12)) { PHL(); unsigned char* ws = WSP();
            peer_v_pass((bf16*)(ws + WS_XN), ws + WS_PV + (size_t)l * PEER_N * 1024, (const int*)(ws + WS_PIDX), (const float*)(ws + WS_PGATE), (const int*)(ws + WS_PARTI), (l + 1 == DEPTH) ? OUTP() : (float*)nullptr,
                        (l + 1 < DEPTH) ? (u64_t*)(ws + WS_ROWSQ) + (size_t)((l + 1) * 3 + 0) * T : (u64_t*)nullptr, (LAS float*)(lds + RING_OFF + wave_ * 1024), gw_, NGW, lane_); }
        SEAM(pb + 9);
    }
#undef IN
#undef SEAM
}

#ifndef MK_MULTI_LAUNCH
#define MK_MULTI_LAUNCH 0
#endif
extern "C" void kernel_launch(void* const* d_in, const int* in_sizes, int n_in, void* d_out, int out_size, void* d_ws, size_t ws_size, hipStream_t stream) {
    static int grid = 0;
    if (grid == 0) {
        if (n_in != 23 || out_size != T * DM || ws_size < WS_END) { fprintf(stderr, "kernel_launch: unexpected shapes (n_in %d, out %d, ws %zu)\n", n_in, out_size, ws_size); grid = -1; return; }
        int dev = 0, cus = 0, per_cu = 0;
        if (hipGetDevice(&dev) != hipSuccess || hipDeviceGetAttribute(&cus, hipDeviceAttributeMultiprocessorCount, dev) != hipSuccess) { grid = -1; return; }
        if (hipFuncSetAttribute((const void*)mega, hipFuncAttributeMaxDynamicSharedMemorySize, LDS_BYTES) != hipSuccess) { fprintf(stderr, "kernel_launch: hipFuncSetAttribute failed\n"); grid = -1; return; }
        if (hipOccupancyMaxActiveBlocksPerMultiprocessor(&per_cu, (const void*)mega, NTHREADS, LDS_BYTES) != hipSuccess || per_cu < 1) { fprintf(stderr, "kernel_launch: occupancy query says %d\n", per_cu); }
        (void)hipGetLastError();
        grid = cus;
    }
    if (grid < 0) return;
    (void)hipMemsetAsync((char*)d_ws + WS_CTL, 0, CTL_ZERO_BYTES, stream);
    (void)hipMemsetAsync((char*)d_ws + WS_MIXSQ, 0, MIXSQ_BYTES, stream);
    Args a{};
    for (int i = 0; i < 23; ++i) a.in[i] = (const float*)d_in[i];
    a.out = (float*)d_out; a.ws = (unsigned char*)d_ws;
#if MK_MULTI_LAUNCH
    for (int p = 0; p < N_PHASES; ++p) { a.ph_lo = p; a.ph_hi = p + 1; a.use_bar = 0; a.pad = 0; hipLaunchKernelGGL(mega, dim3(grid), dim3(NTHREADS), LDS_BYTES, stream, a); }
#else
    a.ph_lo = 0; a.ph_hi = N_PHASES; a.use_bar = 1; a.pad = 0;
    hipLaunchKernelGGL(mega, dim3(grid), dim3(NTHREADS), LDS_BYTES, stream, a);
#endif
    const hipError_t le = hipPeekAtLastError();
    if (le != hipSuccess) fprintf(stderr, "kernel_launch: launch failed: %s\n", hipGetErrorName(le));
}
```

```cpp
#include <hip/hip_runtime.h>
#include <cstdio>
#include <cstdint>
#include <cmath>
__device__ __forceinline__ float shx(float v, int k, int lane);
typedef unsigned long long u64_t;
__device__ __forceinline__ float rowsq_rs(const u64_t* rowsq, int row) { return 1.0f / sqrtf((float)*(const __attribute__((address_space(1))) u64_t*)(rowsq + row) * (5.9604644775390625e-08f / 2048.0f) + 1e-6f); }
__device__ __forceinline__ u64_t rowsq_fx(float ss) { return (u64_t)(ss * 16777216.0f + 0.5f); }
namespace pg8 {
#define PG8_LAS __attribute__((address_space(3)))
#define PG8_GAS __attribute__((address_space(1)))
typedef unsigned short bf16_t;
typedef short bf16x8 __attribute__((ext_vector_type(8)));
typedef float f32x4 __attribute__((ext_vector_type(4)));
typedef unsigned u32x4 __attribute__((ext_vector_type(4)));
constexpr int BM = 256, BK = 64, HALF = 128, HTB = HALF * BK * 2  , STAGE_BYTES = 8 * HTB, NXCD = 8, WGM = 8;

__host__ __device__ __forceinline__ int lds_byte(int r, int c) { const int st = (r >> 4) * 2 + (c >> 5), rr = r & 15, cc = c & 31, ob = rr * 64 + cc * 2; return st * 1024 + (ob ^ (((ob >> 9) & 1) << 5)); }
__host__ __device__ __forceinline__ void stage_rc(int b, int& R, int& C) { const int st = b / 1024, sb = b % 1024, swz = sb ^ (((sb >> 9) & 1) << 5); R = (st >> 1) * 16 + swz / 64; C = (st & 1) * 32 + (swz % 64) / 2; }
__host__ __device__ __forceinline__ int perm32(int rho) { const int n = rho >> 4, i = rho & 15; return 8 * (i >> 2) + 4 * n + (i & 3); }

struct Unit { int pm, pn; };
struct Gemm { const bf16_t* A; const bf16_t* Bt; int M, N, K; };

struct StaticOrder {
    int nM, nN, nwg, G, c;
    __host__ __device__ __forceinline__ void init(int M, int N, int G_, int c_) { nM = M / BM; nN = N / BM; nwg = nM * nN; G = G_; c = c_; }
    __host__ __device__ __forceinline__ bool next(int i, Unit& u) const {
        const long L = (long)i * G + c; if (L >= nwg) return false;
        int wgid = (int)L; { const int q = nwg / NXCD, r = nwg % NXCD, xcd = wgid % NXCD, off = wgid / NXCD; wgid = (xcd < r ? xcd * (q + 1) : r * (q + 1) + (xcd - r) * q) + off; }
        const int nig = WGM * nN, gid = wgid / nig, fm = gid * WGM, gsz = (nM - fm) < WGM ? (nM - fm) : WGM;
        u.pm = fm + ((wgid % nig) % gsz); u.pn = (wgid % nig) / gsz; return true;
    }
    __device__ __forceinline__ void a_ready(const Unit&) const {}
    __device__ __forceinline__ void done(const Unit&) const {}
};

__device__ __forceinline__ unsigned cvt_pk_bf16(float lo, float hi) { unsigned r; asm volatile("v_cvt_pk_bf16_f32 %0, %1, %2" : "=v"(r) : "v"(lo), "v"(hi)); return r; }
typedef float f32x2 __attribute__((ext_vector_type(2)));
__device__ __forceinline__ f32x2 gelu_pk(f32x2 v) {
    const f32x2 av = __builtin_elementwise_abs(v), d = av * 0.2316418882f + 1.0f;
    f32x2 t; t.x = __builtin_amdgcn_rcpf(d.x); t.y = __builtin_amdgcn_rcpf(d.y);
    f32x2 q = t * 0.5307027145f + (-0.7265760135f); q = q * t + 0.7107068705f; q = q * t + (-0.142248368f); q = q * t + 0.127414796f; q = q * t;
    const f32x2 s = (v * v) * (-0.72134752044f);
    f32x2 e; e.x = __builtin_amdgcn_exp2f(s.x); e.y = __builtin_amdgcn_exp2f(s.y);
    const f32x2 m = v * (q * e), r = v - m;
    f32x2 o; o.x = v.x < 0.f ? m.x : r.x; o.y = v.y < 0.f ? m.y : r.y; return o;
}

template <int ACT  > struct EpiBf16 {
    static constexpr bool PERM = true, AFTER_DRAIN = false, KSCALE = false; static_assert(ACT == 0 || ACT == 1, "EpiBf16: ACT is 0 (none) or 1 (gelu_pk)");
    bf16_t* O; int ldc; const float* bias; int split_cols; size_t split_stride; float scale0;
    __device__ __forceinline__ void operator()(const f32x4 (&acc)[2][2][4][2], const Unit& u, int wr, int wc, int fr, int fq) const {
        const int row0 = u.pm * BM + wr * 64 + fr; int colt = u.pn * BM; bf16_t* base = O;
        float sc = 1.f; if (split_cols) { const int t = colt / split_cols; base += (size_t)t * split_stride; colt -= t * split_cols; if (t == 0) sc = scale0; }
        const int col0 = colt + wc * 32 + 8 * fq, bcol0 = u.pn * BM + wc * 32 + 8 * fq;
        f32x4 bv[2][2];
#pragma unroll
        for (int bj = 0; bj < 2; ++bj)
#pragma unroll
            for (int n = 0; n < 2; ++n) bv[bj][n] = bias ? *(const PG8_GAS f32x4*)(bias + bcol0 + bj * HALF + 4 * n) : (f32x4){0.f, 0.f, 0.f, 0.f};
#pragma unroll
        for (int ai = 0; ai < 2; ++ai)
#pragma unroll
            for (int m = 0; m < 4; ++m) { bf16_t* rowp = base + (size_t)(row0 + ai * HALF + m * 16) * ldc + col0;
#pragma unroll
                for (int bj = 0; bj < 2; ++bj) { f32x4 v0 = acc[ai][bj][m][0] + bv[bj][0], v1 = acc[ai][bj][m][1] + bv[bj][1];
                    if (ACT == 1) { f32x2 a = gelu_pk((f32x2){v0[0], v0[1]}), b = gelu_pk((f32x2){v0[2], v0[3]}), c = gelu_pk((f32x2){v1[0], v1[1]}), d = gelu_pk((f32x2){v1[2], v1[3]});
                        v0 = (f32x4){a.x, a.y, b.x, b.y}; v1 = (f32x4){c.x, c.y, d.x, d.y}; }
                    v0 = v0 * sc; v1 = v1 * sc; u32x4 w; w.x = cvt_pk_bf16(v0[0], v0[1]); w.y = cvt_pk_bf16(v0[2], v0[3]); w.z = cvt_pk_bf16(v1[0], v1[1]); w.w = cvt_pk_bf16(v1[2], v1[3]);
                    *(PG8_GAS u32x4*)(rowp + bj * HALF) = w; } }
    }
};

typedef unsigned u32x2 __attribute__((ext_vector_type(2)));
struct EpiResid {
    static constexpr bool PERM = false, AFTER_DRAIN = false, KSCALE = false;
    bf16_t* s; int ldc; u64_t* rowsq;
    __device__ __forceinline__ void operator()(const f32x4 (&acc)[2][2][4][2], const Unit& u, int wr, int wc, int fr, int fq) const {
        const int col0 = u.pn * BM + wc * 32 + 4 * fq;
#pragma unroll
        for (int ai = 0; ai < 2; ++ai)
#pragma unroll
            for (int m = 0; m < 4; ++m) { const int row = u.pm * BM + ai * HALF + wr * 64 + m * 16 + fr; bf16_t* sp = s + (size_t)row * ldc + col0; float ss = 0.f;
                u32x2 in[2][2];
#pragma unroll
                for (int bj = 0; bj < 2; ++bj)
#pragma unroll
                    for (int n = 0; n < 2; ++n) in[bj][n] = *(const PG8_GAS u32x2*)(sp + bj * HALF + n * 16);
#pragma unroll
                for (int bj = 0; bj < 2; ++bj)
#pragma unroll
                    for (int n = 0; n < 2; ++n) { const u32x2 w0 = in[bj][n];
                        const f32x4 bs = (f32x4){__builtin_bit_cast(float, w0.x << 16), __builtin_bit_cast(float, w0.x & 0xffff0000u), __builtin_bit_cast(float, w0.y << 16), __builtin_bit_cast(float, w0.y & 0xffff0000u)};
                        const f32x4 o = bs + acc[ai][bj][m][n]; ss += (o[0] * o[0] + o[1] * o[1]) + (o[2] * o[2] + o[3] * o[3]);
                        u32x2 w; w.x = cvt_pk_bf16(o[0], o[1]); w.y = cvt_pk_bf16(o[2], o[3]); *(PG8_GAS u32x2*)(sp + bj * HALF + n * 16) = w; }
                ss += shx(ss, 16, fr + 16 * fq); ss += shx(ss, 32, fr + 16 * fq);
                if (fq == 0) (void)__hip_atomic_fetch_add((PG8_GAS u64_t*)(rowsq + row), rowsq_fx(ss), __ATOMIC_RELAXED, __HIP_MEMORY_SCOPE_AGENT); }
    }
};
struct EpiResidMix {
    static constexpr bool PERM = false, AFTER_DRAIN = false, KSCALE = true; static constexpr int KS0 = 12, KS1 = 20;
    bf16_t* s; int ldc; u64_t* rowsq; const PG8_LAS float* ftab; const PG8_LAS int* pmtab;
    __device__ __forceinline__ int slot(int pm) const { return pmtab[0] == pm ? 0 : (pmtab[1] == pm ? 1 : (pmtab[2] == pm ? 2 : 3)); }
    __device__ __forceinline__ void kscale(f32x4 (&acc)[2][2][4][2], const Unit& u, int which, int wr, int fr) const {
        const PG8_LAS float* ft = ftab + which * 1024 + slot(u.pm) * 256;
#pragma unroll
        for (int ai = 0; ai < 2; ++ai)
#pragma unroll
            for (int m = 0; m < 4; ++m) { const float f = ft[ai * HALF + wr * 64 + m * 16 + fr];
#pragma unroll
                for (int bj = 0; bj < 2; ++bj)
#pragma unroll
                    for (int n = 0; n < 2; ++n) acc[ai][bj][m][n] = acc[ai][bj][m][n] * f; }
    }
    __device__ __forceinline__ void operator()(const f32x4 (&acc)[2][2][4][2], const Unit& u, int wr, int wc, int fr, int fq) const {
        const int col0 = u.pn * BM + wc * 32 + 4 * fq;
#pragma unroll
        for (int ai = 0; ai < 2; ++ai)
#pragma unroll
            for (int m = 0; m < 4; ++m) { const int row = u.pm * BM + ai * HALF + wr * 64 + m * 16 + fr; bf16_t* sp = s + (size_t)row * ldc + col0; float ss = 0.f; const float rc = ftab[2048 + slot(u.pm) * 256 + ai * HALF + wr * 64 + m * 16 + fr];
                u32x2 in[2][2];
#pragma unroll
                for (int bj = 0; bj < 2; ++bj)
#pragma unroll
                    for (int n = 0; n < 2; ++n) in[bj][n] = *(const PG8_GAS u32x2*)(sp + bj * HALF + n * 16);
#pragma unroll
                for (int bj = 0; bj < 2; ++bj)
#pragma unroll
                    for (int n = 0; n < 2; ++n) { const u32x2 w0 = in[bj][n];
                        const f32x4 bs = (f32x4){__builtin_bit_cast(float, w0.x << 16), __builtin_bit_cast(float, w0.x & 0xffff0000u), __builtin_bit_cast(float, w0.y << 16), __builtin_bit_cast(float, w0.y & 0xffff0000u)};
                        const f32x4 o = bs + acc[ai][bj][m][n] * rc; ss += (o[0] * o[0] + o[1] * o[1]) + (o[2] * o[2] + o[3] * o[3]);
                        u32x2 w; w.x = cvt_pk_bf16(o[0], o[1]); w.y = cvt_pk_bf16(o[2], o[3]); *(PG8_GAS u32x2*)(sp + bj * HALF + n * 16) = w; }
                ss += shx(ss, 16, fr + 16 * fq); ss += shx(ss, 32, fr + 16 * fq);
                if (fq == 0) (void)__hip_atomic_fetch_add((PG8_GAS u64_t*)(rowsq + row), rowsq_fx(ss), __ATOMIC_RELAXED, __HIP_MEMORY_SCOPE_AGENT); }
    }
};
struct EpiBf16Row {
    static constexpr bool PERM = true, AFTER_DRAIN = false, KSCALE = false;
    bf16_t* O; int ldc; const u64_t* rowsq;
    __device__ __forceinline__ void operator()(const f32x4 (&acc)[2][2][4][2], const Unit& u, int wr, int wc, int fr, int fq) const {
        const int row0 = u.pm * BM + wr * 64 + fr, col0 = u.pn * BM + wc * 32 + 8 * fq;
#pragma unroll
        for (int ai = 0; ai < 2; ++ai)
#pragma unroll
            for (int m = 0; m < 4; ++m) { const int row = row0 + ai * HALF + m * 16; const float rs = rowsq_rs(rowsq, row); bf16_t* rowp = O + (size_t)row * ldc + col0;
#pragma unroll
                for (int bj = 0; bj < 2; ++bj) { const f32x4 v0 = acc[ai][bj][m][0] * rs, v1 = acc[ai][bj][m][1] * rs; u32x4 w; w.x = cvt_pk_bf16(v0[0], v0[1]); w.y = cvt_pk_bf16(v0[2], v0[3]); w.z = cvt_pk_bf16(v1[0], v1[1]); w.w = cvt_pk_bf16(v1[2], v1[3]);
                    *(PG8_GAS u32x4*)(rowp + bj * HALF) = w; } }
    }
};
struct EpiQKV {
    static constexpr bool PERM = false, AFTER_DRAIN = false, KSCALE = false;
    bf16_t* O; const float* ga; const float* gb; const float* gc; const float* rope; const u64_t* rowsq;
    __device__ __forceinline__ void operator()(const f32x4 (&acc)[2][2][4][2], const Unit& u, int wr, int wc, int fr, int fq) const {
        const int hg = u.pn * 4 + wc;
        const float* g = nullptr; bool isq = false, dorope = false;
        if (hg < 12) { g = ga; isq = true; } else if (hg < 16) { g = ga + 64; } else if (hg < 20) { }
        else if (hg < 28) { g = gb; isq = true; } else if (hg < 36) { g = gb + 64; } else if (hg < 44) { }
        else if (hg < 56) { g = gc; isq = true; dorope = true; } else if (hg < 60) { g = gc + 64; dorope = true; }
        const float qs = isq ? 0.18033688011112042f : 1.0f;
#pragma unroll
        for (int ai = 0; ai < 2; ++ai)
#pragma unroll
            for (int m = 0; m < 4; ++m) {
                const int row = u.pm * BM + ai * HALF + wr * 64 + m * 16 + fr;
                f32x4 v[2][2];
                const float rsx = rowsq_rs(rowsq, row);
#pragma unroll
                for (int bj = 0; bj < 2; ++bj)
#pragma unroll
                    for (int n = 0; n < 2; ++n) v[bj][n] = acc[ai][bj][m][n] * rsx;
                if (g) {
                    float ss = 0.f;
#pragma unroll
                    for (int bj = 0; bj < 2; ++bj)
#pragma unroll
                        for (int n = 0; n < 2; ++n) { const f32x4 x = v[bj][n]; ss += (x[0] * x[0] + x[1] * x[1]) + (x[2] * x[2] + x[3] * x[3]); }
                    ss += shx(ss, 16, fr + 16 * fq); ss += shx(ss, 32, fr + 16 * fq);
                    const float r = qs / sqrtf(ss * (1.0f / 64.0f) + 1e-6f);
#pragma unroll
                    for (int bj = 0; bj < 2; ++bj)
#pragma unroll
                        for (int n = 0; n < 2; ++n) v[bj][n] = v[bj][n] * *(const PG8_GAS f32x4*)(g + 32 * bj + 16 * n + 4 * fq) * r;
                }
                if (dorope) {
                    const int t = row & 2047, pr = t >> 6, pc = t & 63;
#pragma unroll
                    for (int bj = 0; bj < 2; ++bj) {
                        const int pos = bj ? pc : pr;
                        const float* rp = rope + (size_t)(pos * 16 + 4 * fq) * 2;
                        const f32x4 c01 = *(const PG8_GAS f32x4*)rp, c23 = *(const PG8_GAS f32x4*)(rp + 4);
                        const f32x4 cs = (f32x4){c01[0], c01[2], c23[0], c23[2]}, sn = (f32x4){c01[1], c01[3], c23[1], c23[3]};
                        const f32x4 x1 = v[bj][0], x2 = v[bj][1];
                        v[bj][0] = x1 * cs - x2 * sn; v[bj][1] = x1 * sn + x2 * cs;
                    }
                }
                bf16_t* rowp = O + (size_t)row * 4096 + hg * 64 + 4 * fq;
#pragma unroll
                for (int bj = 0; bj < 2; ++bj)
#pragma unroll
                    for (int n = 0; n < 2; ++n) { u32x2 w; w.x = cvt_pk_bf16(v[bj][n][0], v[bj][n][1]); w.y = cvt_pk_bf16(v[bj][n][2], v[bj][n][3]); *(PG8_GAS u32x2*)(rowp + 32 * bj + 16 * n) = w; }
                asm volatile("" ::: "memory");
            }
    }
};
template <class Epi, class Sched, bool ALIGN_EPI = false, bool SP2 = false>
__device__ __forceinline__ void gemm_phase(PG8_LAS unsigned char* lds, const Gemm g, const Sched& S, const Epi& E, const int tid) {
    const int wid = __builtin_amdgcn_readfirstlane(tid >> 6), lane = tid & 63, wr = wid >> 2, wc = wid & 3, fr = lane & 15, fq = lane >> 4;
    const int K = g.K, nt = K / BK;
    unsigned voffA[2], voffB[2];
#pragma unroll
    for (int i = 0; i < 2; ++i) { int R, C; stage_rc(tid * 16 + i * 8192, R, C); const int Rb = Epi::PERM ? ((R & ~31) + perm32(R & 31)) : R;
        voffA[i] = (unsigned)(R * K + C) * 2u; voffB[i] = (unsigned)(Rb * K + C) * 2u; }
    const size_t kstep = (size_t)(BK * 2);
    const size_t hstep = (size_t)HALF * K * 2;
    const size_t tstep = 2 * hstep;
    const unsigned ldsw = (unsigned)wid * 1024u;
    const int aoff = lds_byte(wr * 64 + fr, fq * 8), boff = lds_byte(wc * 32 + fr, fq * 8);
#define PG8_SA(b, h) (((b) * 2 + (h)) * HTB)
#define PG8_SB(b, h) ((4 + (b) * 2 + (h)) * HTB)
#define PG8_STAGE(bufoff, gbase, voff) do { _Pragma("unroll") for (int _i = 0; _i < 2; ++_i) \
        __builtin_amdgcn_global_load_lds((const unsigned*)((const char*)(gbase) + (voff)[_i]), (PG8_LAS unsigned*)(lds + (bufoff) + ldsw + _i * 8192), 16, 0, 0); } while (0)
#define PG8_LDA(dst, b, h) do { _Pragma("unroll") for (int m = 0; m < 4; ++m) _Pragma("unroll") for (int k = 0; k < 2; ++k) dst[m][k] = *(const PG8_LAS bf16x8*)(lds + PG8_SA(b, h) + aoff + m * 2048 + k * 1024); } while (0)
#define PG8_LDB(dst, b, h) do { _Pragma("unroll") for (int n = 0; n < 2; ++n) _Pragma("unroll") for (int k = 0; k < 2; ++k) dst[n][k] = *(const PG8_LAS bf16x8*)(lds + PG8_SB(b, h) + boff + n * 2048 + k * 1024); } while (0)
#define PG8_MMA(ai, bj, At, Bt) do { __builtin_amdgcn_s_setprio(1); _Pragma("unroll") for (int m = 0; m < 4; ++m) _Pragma("unroll") for (int n = 0; n < 2; ++n) _Pragma("unroll") for (int k = 0; k < 2; ++k) \
        acc[ai][bj][m][n] = __builtin_amdgcn_mfma_f32_16x16x32_bf16(Bt[n][k], At[m][k], acc[ai][bj][m][n], 0, 0, 0); __builtin_amdgcn_s_setprio(0); } while (0)
#define PG8_WAIT_V(n) asm volatile("s_waitcnt vmcnt(" #n ")" ::: "memory")
#define PG8_WAIT_L(n) asm volatile("s_waitcnt lgkmcnt(" #n ")" ::: "memory")
#define PG8_BAR __builtin_amdgcn_s_barrier()
#define PG8_SCHED __builtin_amdgcn_sched_barrier(0)
    Unit cur, nxt; int ui = 0;
    if (!S.next(0, cur)) return;
    f32x4 acc[2][2][4][2];
#pragma unroll
    for (int a = 0; a < 2; ++a)
#pragma unroll
        for (int b = 0; b < 2; ++b)
#pragma unroll
            for (int m = 0; m < 4; ++m)
#pragma unroll
                for (int n = 0; n < 2; ++n) acc[a][b][m][n] = (f32x4){0.f, 0.f, 0.f, 0.f};
    bf16x8 At[4][2], B0[2][2], B1[2][2];
    const char* cA = (const char*)g.A + (size_t)cur.pm * tstep; const char* cB = (const char*)g.Bt + (size_t)cur.pn * tstep;
    S.a_ready(cur);
    if constexpr (SP2) {
        PG8_STAGE(PG8_SB(0, 0), cB, voffB); PG8_STAGE(PG8_SB(0, 1), cB + hstep, voffB); PG8_STAGE(PG8_SA(0, 0), cA, voffA); PG8_STAGE(PG8_SA(0, 1), cA + hstep, voffA);
        if (wr == 1) PG8_BAR;
        PG8_WAIT_V(2); PG8_BAR;
        PG8_STAGE(PG8_SB(1, 0), cB + kstep, voffB); PG8_STAGE(PG8_SA(1, 0), cA + kstep, voffA); PG8_STAGE(PG8_SB(1, 1), cB + hstep + kstep, voffB);
        PG8_WAIT_V(6); PG8_BAR;
    } else {
        PG8_STAGE(PG8_SB(0, 0), cB, voffB); PG8_STAGE(PG8_SA(0, 0), cA, voffA); PG8_STAGE(PG8_SB(0, 1), cB + hstep, voffB); PG8_STAGE(PG8_SA(0, 1), cA + hstep, voffA);
        if (wr == 1) PG8_BAR;
        PG8_WAIT_V(4); PG8_BAR;
        PG8_STAGE(PG8_SB(1, 0), cB + kstep, voffB); PG8_STAGE(PG8_SA(1, 0), cA + kstep, voffA); PG8_STAGE(PG8_SB(1, 1), cB + hstep + kstep, voffB);
        PG8_WAIT_V(6); PG8_BAR;
    }
    for (;;) {
        const bool has_next = S.next(ui + 1, nxt);
        const char* nA = has_next ? (const char*)g.A + (size_t)nxt.pm * tstep : cA; const char* nB = has_next ? (const char*)g.Bt + (size_t)nxt.pn * tstep : cB;
        for (int t = 0; t < nt; t += 2) {
            if constexpr (Epi::KSCALE) { if (t == Epi::KS0 || t == Epi::KS1) E.kscale(acc, cur, t == Epi::KS1 ? 1 : 0, wr, fr); }
            const bool last = (t == nt - 2);
            const char* a1 = cA + (size_t)(t + 1) * kstep;
            const char* a2 = last ? nA : cA + (size_t)(t + 2) * kstep; const char* b2 = last ? nB : cB + (size_t)(t + 2) * kstep;
            const char* a3 = a2 + kstep; const char* b3 = b2 + kstep;
            if (last && has_next) S.a_ready(nxt);
            if constexpr (SP2) {
            PG8_LDB(B0, 0, 0); PG8_LDB(B1, 0, 1); PG8_SCHED; PG8_LDA(At, 0, 0); PG8_STAGE(PG8_SA(1, 1), a1 + hstep, voffA);
            PG8_WAIT_V(8); PG8_WAIT_L(0); PG8_BAR; PG8_MMA(0, 0, At, B0); PG8_MMA(0, 1, At, B1); PG8_BAR; PG8_SCHED;
            PG8_LDA(At, 0, 1); PG8_STAGE(PG8_SB(0, 0), b2, voffB); PG8_STAGE(PG8_SB(0, 1), b2 + hstep, voffB); PG8_STAGE(PG8_SA(0, 0), a2, voffA);
            PG8_WAIT_V(8); PG8_WAIT_L(0); PG8_BAR; PG8_MMA(1, 0, At, B0); PG8_MMA(1, 1, At, B1); PG8_BAR; PG8_SCHED;
            PG8_LDB(B0, 1, 0); PG8_LDB(B1, 1, 1); PG8_SCHED; PG8_LDA(At, 1, 0); PG8_STAGE(PG8_SA(0, 1), a2 + hstep, voffA);
            PG8_WAIT_V(8); PG8_WAIT_L(0); PG8_BAR; PG8_MMA(0, 0, At, B0); PG8_MMA(0, 1, At, B1); PG8_BAR; PG8_SCHED;
            PG8_LDA(At, 1, 1); PG8_STAGE(PG8_SB(1, 0), b3, voffB); PG8_STAGE(PG8_SB(1, 1), b3 + hstep, voffB); PG8_STAGE(PG8_SA(1, 0), a3, voffA);
            PG8_WAIT_V(8); PG8_WAIT_L(0); PG8_BAR; PG8_MMA(1, 0, At, B0); PG8_MMA(1, 1, At, B1); PG8_BAR; PG8_SCHED;
            } else {
            PG8_LDB(B0, 0, 0); PG8_SCHED; PG8_LDA(At, 0, 0); PG8_STAGE(PG8_SA(1, 1), a1 + hstep, voffA);
            PG8_WAIT_L(8); PG8_BAR; PG8_WAIT_L(0); PG8_MMA(0, 0, At, B0); PG8_BAR; PG8_SCHED;
            PG8_LDB(B1, 0, 1); PG8_STAGE(PG8_SB(0, 0), b2, voffB);
            PG8_BAR; PG8_WAIT_L(0); PG8_MMA(0, 1, At, B1); PG8_BAR;
            PG8_LDA(At, 0, 1); PG8_STAGE(PG8_SA(0, 0), a2, voffA);
            PG8_BAR; PG8_WAIT_L(0); PG8_MMA(1, 0, At, B0); PG8_BAR; PG8_SCHED;
            PG8_STAGE(PG8_SB(0, 1), b2 + hstep, voffB);
            PG8_WAIT_V(6); PG8_BAR; PG8_MMA(1, 1, At, B1); PG8_BAR;
            PG8_LDB(B0, 1, 0); PG8_SCHED; PG8_LDA(At, 1, 0); PG8_STAGE(PG8_SA(0, 1), a2 + hstep, voffA);
            PG8_WAIT_L(8); PG8_BAR; PG8_WAIT_L(0); PG8_MMA(0, 0, At, B0); PG8_BAR; PG8_SCHED;
            PG8_LDB(B1, 1, 1); PG8_STAGE(PG8_SB(1, 0), b3, voffB);
            PG8_BAR; PG8_WAIT_L(0); PG8_MMA(0, 1, At, B1); PG8_BAR;
            PG8_LDA(At, 1, 1); PG8_STAGE(PG8_SA(1, 0), a3, voffA);
            PG8_BAR; PG8_WAIT_L(0); PG8_MMA(1, 0, At, B0); PG8_BAR; PG8_SCHED;
            PG8_STAGE(PG8_SB(1, 1), b3 + hstep, voffB);
            PG8_WAIT_V(6); PG8_BAR; PG8_MMA(1, 1, At, B1); PG8_BAR;
            }
        }
        if constexpr (ALIGN_EPI) { if (wr == 0) PG8_BAR; }
        if constexpr (!Epi::AFTER_DRAIN) { E(acc, cur, wr, wc, fr, fq); S.done(cur); }
        if (!has_next) break;
#pragma unroll
        for (int a = 0; a < 2; ++a)
#pragma unroll
            for (int b = 0; b < 2; ++b)
#pragma unroll
                for (int m = 0; m < 4; ++m)
#pragma unroll
                    for (int n = 0; n < 2; ++n) acc[a][b][m][n] = (f32x4){0.f, 0.f, 0.f, 0.f};
        cur = nxt; cA = nA; cB = nB; ++ui;
        if constexpr (ALIGN_EPI) { if (wr == 1) PG8_BAR; }
    }
    PG8_WAIT_V(0);
    if constexpr (!ALIGN_EPI) { if (wr == 0) PG8_BAR; }
    PG8_BAR;
    if constexpr (Epi::AFTER_DRAIN) { E.fused(acc, cur, wr, wc, fr, fq, lds, wid, lane); S.done(cur); }
#undef PG8_SA
#undef PG8_SB
#undef PG8_STAGE
#undef PG8_LDA
#undef PG8_LDB
#undef PG8_MMA
#undef PG8_WAIT_V
#undef PG8_WAIT_L
#undef PG8_BAR
#undef PG8_SCHED
}
}

constexpr int BATCH = 16, SEQ = 2048, DM = 2048, T = BATCH * SEQ, DEPTH = 2;
constexpr int NMEM = 256, DIN = 4096, MEMW = 512;
constexpr int PEER_H = 8, PEER_N = 16384;
constexpr int NWAVES = 8, NTHREADS = NWAVES * 64;
constexpr float EPS = 1e-6f;
constexpr int QA = 0, KA = 768, VA = 1024, QB = 1280, KB = 1792, VB = 2304, QC = 2816, KC = 3584, VC = 3840;
constexpr int OA = 0, OB = 768, OC = 1280;

constexpr size_t MiB = 1u << 20;
constexpr size_t WS_CTL = 0, CTL_ZERO_BYTES = 2 * MiB;
constexpr size_t WS_ROWSQ = 256 * 1024;
constexpr size_t WS_ROPE = 83 * MiB, WS_BIASA = 83 * MiB + 16384;
constexpr size_t WS_WIN = 2 * MiB, WS_WOUT = 34 * MiB, WS_WMQ = 50 * MiB, WS_WMKV = 54 * MiB, WS_WMO = 62 * MiB, WS_WPQ = 66 * MiB, WS_PKEYS = 82 * MiB;
constexpr size_t WS_MEMN = 84 * MiB, WS_KVM = 116 * MiB, WS_PU = 132 * MiB, WS_PV = 260 * MiB, WS_XN = 388 * MiB, WS_QKV = 516 * MiB, WS_ATT = 772 * MiB;
constexpr size_t WS_QM = 900 * MiB, WS_OM = 932 * MiB, WS_MIXSQ = 964 * MiB, MIXSQ_BYTES = 2 * MiB, WS_END = 966 * MiB;
constexpr size_t WS_QP = WS_QKV, WS_PIDX = WS_QKV + 128 * MiB, WS_PGATE = WS_QKV + 144 * MiB, WS_PARTI = WS_QKV + 160 * MiB;
constexpr size_t WS_XQH = 900 * MiB, WS_XQL = 932 * MiB;
constexpr int CW_BAR = 4096;

constexpr int RING_OFF = 0, RING_BYTES = 131072;
constexpr int LDSCTL_OFF = RING_BYTES, MISC_OFF = LDSCTL_OFF + 320;
constexpr int LDS_BYTES = 147456;

#define GAS __attribute__((address_space(1)))
#define LAS __attribute__((address_space(3)))
typedef unsigned short bf16;
typedef unsigned v4u __attribute__((ext_vector_type(4)));
typedef unsigned v2u __attribute__((ext_vector_type(2)));
typedef float f32x4 __attribute__((ext_vector_type(4)));
typedef float f32x16 __attribute__((ext_vector_type(16)));
typedef short bf16x8 __attribute__((ext_vector_type(8)));
typedef GAS unsigned gu32;
#define LDS_WAIT() asm volatile("s_waitcnt lgkmcnt(0)" ::: "memory")
#define VM_WAIT() asm volatile("s_waitcnt vmcnt(0)" ::: "memory")
__device__ __forceinline__ unsigned f2bf(float f) { unsigned u = __builtin_bit_cast(unsigned, f); return (u + 0x7fffu + ((u >> 16) & 1u)) >> 16; }
__device__ __forceinline__ unsigned pk2(float lo, float hi) { return f2bf(lo) | (f2bf(hi) << 16); }
__device__ __forceinline__ float bflo(unsigned w) { return __builtin_bit_cast(float, w << 16); }
__device__ __forceinline__ float bfhi(unsigned w) { return __builtin_bit_cast(float, w & 0xffff0000u); }

__device__ __forceinline__ float shx(float v, int k, int lane) { return __builtin_bit_cast(float, __builtin_amdgcn_ds_bpermute((lane ^ k) << 2, __builtin_bit_cast(int, v))); }
#define XB_TMO      128
#define XB_XCNT(j)  (256  + 64 * (j))
#define XB_XSUB(j)  (1280 + 64 * (j))
#define XB_XGEN(j)  (2304 + 64 * (j))
#define XB_TOP      3328
#define XB_TOPGEN   3392
#define XCD_BAR_WORDS 3456
#define XB_SPIN_CAP (1u << 18)

__device__ __forceinline__ unsigned xb_ld(unsigned* p)              { return __hip_atomic_load(p, __ATOMIC_RELAXED, __HIP_MEMORY_SCOPE_AGENT); }
__device__ __forceinline__ unsigned xb_add(unsigned* p, unsigned v) { return __hip_atomic_fetch_add(p, v, __ATOMIC_RELAXED, __HIP_MEMORY_SCOPE_AGENT); }
__device__ __forceinline__ unsigned xb_xcc_id() { return (unsigned)__builtin_amdgcn_s_getreg((3 << 11) | 20) & 0xFu; }
#define XB_SPIN(cond, bar) do { unsigned _sp = 0; while (cond) { __builtin_amdgcn_s_sleep(1); \
    if ((++_sp & 255u) == 0u) { if (xb_ld(&(bar)[XB_TMO])) break; if (_sp > XB_SPIN_CAP) { atomicAdd(&(bar)[XB_TMO], 1u); break; } } } } while (0)

struct XcdBarrier {
    unsigned* bar; unsigned x;
    volatile LAS unsigned* st;
};

__device__ __forceinline__ XcdBarrier xcd_barrier_post(unsigned* bar, volatile LAS unsigned* st) {
    XcdBarrier b; b.bar = bar; b.x = xb_xcc_id(); b.st = st;
    if (threadIdx.x == 0) (void)xb_add(&bar[XB_XCNT(b.x)], 1u);
    return b;
}
__device__ __forceinline__ void xcd_barrier_complete(unsigned* bar, unsigned x, unsigned& nloc, unsigned& nx) {
    const unsigned G = gridDim.x * gridDim.y * gridDim.z;
    unsigned sum, cnt, mine, sp = 0u;
    for (;;) {
        sum = 0u; cnt = 0u; mine = 0u;
#pragma unroll
        for (unsigned j = 0; j < 16; ++j) { const unsigned c = xb_ld(&bar[XB_XCNT(j)]); sum += c; cnt += (c > 0u) ? 1u : 0u; mine = (j == x) ? c : mine; }
        if (sum == G) break;
        __builtin_amdgcn_s_sleep(1);
        if ((++sp & 255u) == 0u) { if (xb_ld(&bar[XB_TMO])) break; if (sp > XB_SPIN_CAP) { atomicAdd(&bar[XB_TMO], 1u); break; } }
    }
    nloc = mine > 0u ? mine : 1u; nx = cnt > 0u ? cnt : 1u;
}

__device__ __forceinline__ void xcd_barrier(const XcdBarrier& b) {
    asm volatile("s_waitcnt vmcnt(0)" ::: "memory");
    __syncthreads();
    if (threadIdx.x == 0) {
        unsigned* bar = b.bar;
        __builtin_amdgcn_s_waitcnt(0);
        unsigned nloc = b.st[0], nx = b.st[1];
        if (nloc == 0u) { xcd_barrier_complete(bar, b.x, nloc, nx); b.st[0] = nloc; b.st[1] = nx; }
        const unsigned old = xb_add(&bar[XB_XSUB(b.x)], 1u);
        const unsigned gen = old / nloc;
        if (old + 1u == (gen + 1u) * nloc) {
            __builtin_amdgcn_fence(__ATOMIC_RELEASE, "agent");
            asm volatile("s_waitcnt vmcnt(0)" ::: "memory");
            const unsigned og = xb_add(&bar[XB_TOP], 1u);
            const unsigned tg = og / nx;
            if (og + 1u == (tg + 1u) * nx) xb_add(&bar[XB_TOPGEN], 1u);
            else XB_SPIN(xb_ld(&bar[XB_TOPGEN]) == tg, bar);
            __builtin_amdgcn_fence(__ATOMIC_ACQUIRE, "agent");
            xb_add(&bar[XB_XGEN(b.x)], 1u);
            asm volatile("s_waitcnt vmcnt(0)" ::: "memory");
        } else {
            XB_SPIN(xb_ld(&bar[XB_XGEN(b.x)]) == gen, bar);
            __builtin_amdgcn_fence(__ATOMIC_ACQUIRE, "agent");
            asm volatile("s_waitcnt vmcnt(0)" ::: "memory");
        }
    }
    __syncthreads();
}

__device__ __forceinline__ float wave_sum(float v, int lane) {
#pragma unroll
    for (int o = 1; o < 64; o <<= 1) v += shx(v, o, lane);
    return v;
}
__device__ __forceinline__ void* ldptr(LAS unsigned char* lds, int i) {
    const unsigned long long v = ((const LAS unsigned long long*)(lds + LDSCTL_OFF + 1024))[i];
    const unsigned lo = __builtin_amdgcn_readfirstlane((unsigned)v), hi = __builtin_amdgcn_readfirstlane((unsigned)(v >> 32));
    return (void*)(((unsigned long long)hi << 32) | lo);
}
struct OffsetOrder {
    pg8::StaticOrder S;
    __device__ __forceinline__ void init(int M, int N, int G, int c, int off) { S.init(M, N, G, (c + G - off % G) % G); }
    __device__ __forceinline__ bool next(int i, pg8::Unit& u) const { return S.next(i, u); }
    __device__ __forceinline__ void a_ready(const pg8::Unit&) const {}
    __device__ __forceinline__ void done(const pg8::Unit&) const {}
};

template <bool PERMQKV>
__device__ __forceinline__ void transpose_item(const float* W, int K, int N, bf16* WT, LAS float* scr, int item, int lane, const float* gk = nullptr) {
    const int nblk = N / 32, kb = item / nblk, nb = item % nblk, k0 = 64 * kb, n0 = 32 * nb;
    int d0 = n0;
    if (PERMQKV) { const int within = n0 & 255; d0 = (n0 & ~255) + 128 * ((within >> 5) & 1) + 32 * (within >> 6); }
#pragma unroll
    for (int i = 0; i < 8; ++i) { const int kk = 8 * i + (lane >> 3), nn = 4 * (lane & 7);
        const f32x4 w4 = *(const GAS f32x4*)(W + (size_t)(k0 + kk) * N + n0 + nn) * (gk ? gk[k0 + kk] : 1.f);
        scr[kk * 33 + nn] = w4[0]; scr[kk * 33 + nn + 1] = w4[1]; scr[kk * 33 + nn + 2] = w4[2]; scr[kk * 33 + nn + 3] = w4[3]; }
    LDS_WAIT(); asm volatile("" ::: "memory");
    const int c = lane & 7;
#pragma unroll
    for (int j = 0; j < 4; ++j) { const int n = (lane >> 3) + 8 * j; const LAS float* s = scr + (8 * c) * 33 + n;
        v4u o; o.x = pk2(s[0 * 33], s[1 * 33]); o.y = pk2(s[2 * 33], s[3 * 33]); o.z = pk2(s[4 * 33], s[5 * 33]); o.w = pk2(s[6 * 33], s[7 * 33]);
        *(GAS v4u*)(WT + (size_t)(d0 + n) * K + k0 + 8 * c) = o; }
    LDS_WAIT(); asm volatile("" ::: "memory");
}
__device__ __forceinline__ void convert_bf16(const float* src, bf16* dst, size_t n, size_t gtid, size_t nthreads) {
    for (size_t i = gtid * 8; i < n; i += nthreads * 8) {
        const f32x4 a = *(const GAS f32x4*)(src + i), b = *(const GAS f32x4*)(src + i + 4);
        v4u o; o.x = pk2(a[0], a[1]); o.y = pk2(a[2], a[3]); o.z = pk2(b[0], b[1]); o.w = pk2(b[2], b[3]);
        *(GAS v4u*)(dst + i) = o;
    }
}
__device__ __forceinline__ int t5_bucket(int rel) {
    const int n = rel < 0 ? -rel : rel;
    const int b = n < 8 ? n : n < 12 ? 8 : n < 16 ? 9 : n < 23 ? 10 : n < 32 ? 11 : n < 46 ? 12 : n < 64 ? 13 : n < 91 ? 14 : 15;
    return b + (rel > 0 ? 16 : 0);
}
__constant__ float ROPE_INV[16] = {1.000000000e+00f, 5.623413324e-01f, 3.162277639e-01f, 1.778279394e-01f, 1.000000015e-01f, 5.623413250e-02f, 3.162277490e-02f, 1.778279431e-02f,
                                   9.999999776e-03f, 5.623413250e-03f, 3.162277630e-03f, 1.778279431e-03f, 1.000000047e-03f, 5.623413017e-04f, 3.162277571e-04f, 1.778279402e-04f};

__device__ __forceinline__ void rms_row_to_bf16(const float* xrow, const float* g0, bf16* o0, const float* g1, bf16* o1, int lane) {
    const GAS f32x4* xr = (const GAS f32x4*)xrow + lane;
    f32x4 v[8]; float s = 0.f;
#pragma unroll
    for (int j = 0; j < 8; ++j) { v[j] = xr[64 * j]; s += (v[j].x * v[j].x + v[j].y * v[j].y) + (v[j].z * v[j].z + v[j].w * v[j].w); }
    const float rstd = 1.f / sqrtf(wave_sum(s, lane) * (1.f / DM) + EPS);
    {   const GAS f32x4* gr = (const GAS f32x4*)g0 + lane; GAS v2u* o8 = (GAS v2u*)o0 + lane;
#pragma unroll
        for (int j = 0; j < 8; ++j) { const f32x4 gg = gr[64 * j]; v2u w; w.x = pk2(v[j].x * rstd * gg.x, v[j].y * rstd * gg.y); w.y = pk2(v[j].z * rstd * gg.z, v[j].w * rstd * gg.w); o8[64 * j] = w; } }
    if (g1) { const GAS f32x4* gr = (const GAS f32x4*)g1 + lane; GAS v2u* o8 = (GAS v2u*)o1 + lane;
#pragma unroll
        for (int j = 0; j < 8; ++j) { const f32x4 gg = gr[64 * j]; v2u w; w.x = pk2(v[j].x * rstd * gg.x, v[j].y * rstd * gg.y); w.y = pk2(v[j].z * rstd * gg.z, v[j].w * rstd * gg.w); o8[64 * j] = w; } }
}
__device__ __forceinline__ void prep_rows2(const float* x0, bf16* o0, u64_t* sq, int lane) {
    f32x4 v[2][8];
#pragma unroll
    for (int q = 0; q < 2; ++q) { const GAS f32x4* xr = (const GAS f32x4*)(x0 + (size_t)q * DM) + lane;
#pragma unroll
        for (int j = 0; j < 8; ++j) v[q][j] = xr[64 * j]; }
#pragma unroll
    for (int q = 0; q < 2; ++q) { GAS v2u* o8 = (GAS v2u*)(o0 + (size_t)q * DM) + lane; float s = 0.f;
#pragma unroll
        for (int j = 0; j < 8; ++j) { const f32x4 a = v[q][j]; s += (a.x * a.x + a.y * a.y) + (a.z * a.z + a.w * a.w); v2u w; w.x = pk2(a.x, a.y); w.y = pk2(a.z, a.w); o8[64 * j] = w; }
        s = wave_sum(s, lane);
        if (lane == 0) sq[q] = rowsq_fx(s); }
}
__device__ __forceinline__ void norm_rows(const float* X, const float* g, bf16* XN, int gw, int NGW, int lane) {
    for (int m = gw; m < T; m += NGW) rms_row_to_bf16(X + (size_t)m * DM, g, XN + (size_t)m * DM, nullptr, nullptr, lane);
}

template <int TYPE>
__device__ __forceinline__ void naive_attn_item(const bf16* QKV, bf16* ATT, int b, int grow, int head, int lane, const float* biasA, const float* sink, const float* rpb) {
    const int tpos = grow * 64 + lane; const size_t trow = (size_t)b * SEQ + tpos;
    int qcol, kcol, vcol, ocol;
    if (TYPE == 0) { qcol = QA + head * 64; kcol = KA + (head / 3) * 64; vcol = VA + (head / 3) * 64; ocol = OA + head * 64; }
    else if (TYPE == 1) { qcol = QB + head * 64; kcol = KB + head * 64; vcol = VB + head * 64; ocol = OB + head * 64; }
    else { qcol = QC + head * 64; kcol = KC + (head / 3) * 64; vcol = VC + (head / 3) * 64; ocol = OC + head * 64; }
    float q[64], o[64];
#pragma unroll
    for (int c = 0; c < 8; ++c) { const v4u w = *(const GAS v4u*)(QKV + trow * DIN + qcol + 8 * c);
        q[8 * c + 0] = bflo(w.x); q[8 * c + 1] = bfhi(w.x); q[8 * c + 2] = bflo(w.y); q[8 * c + 3] = bfhi(w.y); q[8 * c + 4] = bflo(w.z); q[8 * c + 5] = bfhi(w.z); q[8 * c + 6] = bflo(w.w); q[8 * c + 7] = bfhi(w.w); }
#pragma unroll
    for (int d = 0; d < 64; ++d) o[d] = 0.f;
    float m = -1e30f, l = 0.f;
    int j0, j1;
    if (TYPE == 0) { j0 = grow * 64 - 128; if (j0 < 0) j0 = 0; j1 = grow * 64 + 63 + 128; if (j1 > SEQ - 1) j1 = SEQ - 1; }
    else if (TYPE == 1) { int r0 = grow - 4; r0 = r0 < 0 ? 0 : (r0 > 24 ? 24 : r0); j0 = r0 * 64; j1 = j0 + 511; }
    else { j0 = 0; j1 = SEQ - 1; }
    int c0 = lane - 8; c0 = c0 < 0 ? 0 : (c0 > 48 ? 48 : c0);
#pragma unroll 1
    for (int j = j0; j <= j1; ++j) {
        const bf16* krow = QKV + ((size_t)b * SEQ + j) * DIN;
        float s = 0.f;
#pragma unroll
        for (int c = 0; c < 8; ++c) { const v4u w = *(const GAS v4u*)(krow + kcol + 8 * c);
            s += q[8 * c + 0] * bflo(w.x) + q[8 * c + 1] * bfhi(w.x) + q[8 * c + 2] * bflo(w.y) + q[8 * c + 3] * bfhi(w.y) + q[8 * c + 4] * bflo(w.z) + q[8 * c + 5] * bfhi(w.z) + q[8 * c + 6] * bflo(w.w) + q[8 * c + 7] * bfhi(w.w); }
        bool valid = true;
        if (TYPE == 0) { const int rel = j - tpos; valid = (rel >= -128 && rel <= 128); if (valid) s += biasA[head * 257 + rel + 128]; }
        if (TYPE == 1) { const int kr = j >> 6, kc = j & 63; valid = (kc >= c0 && kc < c0 + 16); if (valid) s += rpb[(head * 15 + (kr - grow + 7)) * 31 + (kc - lane + 15)]; }
        const float mn = valid ? fmaxf(m, s) : m;
        const float a = __expf(m - mn);
        const float p = valid ? __expf(s - mn) : 0.f;
        l = l * a + p; m = mn;
#pragma unroll
        for (int c = 0; c < 8; ++c) { const v4u w = *(const GAS v4u*)(krow + vcol + 8 * c);
            o[8 * c + 0] = o[8 * c + 0] * a + p * bflo(w.x); o[8 * c + 1] = o[8 * c + 1] * a + p * bfhi(w.x); o[8 * c + 2] = o[8 * c + 2] * a + p * bflo(w.y); o[8 * c + 3] = o[8 * c + 3] * a + p * bfhi(w.y);
            o[8 * c + 4] = o[8 * c + 4] * a + p * bflo(w.z); o[8 * c + 5] = o[8 * c + 5] * a + p * bfhi(w.z); o[8 * c + 6] = o[8 * c + 6] * a + p * bflo(w.w); o[8 * c + 7] = o[8 * c + 7] * a + p * bfhi(w.w); }
    }
    if (TYPE == 0) l += __expf(sink[head] - m);
    const float inv = 1.f / l;
#pragma unroll
    for (int c = 0; c < 8; ++c) { v4u w; w.x = pk2(o[8 * c + 0] * inv, o[8 * c + 1] * inv); w.y = pk2(o[8 * c + 2] * inv, o[8 * c + 3] * inv); w.z = pk2(o[8 * c + 4] * inv, o[8 * c + 5] * inv); w.w = pk2(o[8 * c + 6] * inv, o[8 * c + 7] * inv);
        *(GAS v4u*)(ATT + trow * DM + ocol + 8 * c) = w; }
}
__device__ __forceinline__ float rdl(float v, int l) { return __builtin_bit_cast(float, __builtin_amdgcn_readlane(__builtin_bit_cast(int, v), l)); }
__device__ __forceinline__ void naive_mem_item(const bf16* QM, const bf16* KVM, bf16* OM, const float* gq, size_t trow, int b, int head, int lane) {
    const unsigned qw = *(const GAS unsigned*)(QM + trow * MEMW + head * 128 + 2 * lane);
    float q0 = bflo(qw), q1 = bfhi(qw);
    const float ss = wave_sum(q0 * q0 + q1 * q1, lane);
    const float r = 0.08838834764831845f / sqrtf(ss * (1.f / 128.f) + EPS);
    q0 *= r * gq[2 * lane]; q1 *= r * gq[2 * lane + 1];
    const bf16* kbase = KVM + ((size_t)b * NMEM + lane) * 1024 + head * 128;
    float s[4] = {0.f, 0.f, 0.f, 0.f};
#pragma unroll 1
    for (int c = 0; c < 16; ++c) {
        float qa[8];
#pragma unroll
        for (int e = 0; e < 4; ++e) { qa[2 * e] = rdl(q0, 4 * c + e); qa[2 * e + 1] = rdl(q1, 4 * c + e); }
#pragma unroll
        for (int i = 0; i < 4; ++i) { const v4u w = *(const GAS v4u*)(kbase + (size_t)i * 64 * 1024 + 8 * c);
            s[i] += qa[0] * bflo(w.x) + qa[1] * bfhi(w.x) + qa[2] * bflo(w.y) + qa[3] * bfhi(w.y) + qa[4] * bflo(w.z) + qa[5] * bfhi(w.z) + qa[6] * bflo(w.w) + qa[7] * bfhi(w.w); }
    }
    float m = fmaxf(fmaxf(s[0], s[1]), fmaxf(s[2], s[3]));
#pragma unroll
    for (int o = 1; o < 64; o <<= 1) m = fmaxf(m, shx(m, o, lane));
    float p[4]; float l = 0.f;
#pragma unroll
    for (int i = 0; i < 4; ++i) { p[i] = __expf(s[i] - m); l += p[i]; }
    l = wave_sum(l, lane);
    const bf16* vbase = KVM + ((size_t)b * NMEM) * 1024 + 512 + head * 128 + 2 * lane;
    float o0 = 0.f, o1 = 0.f;
#pragma unroll
    for (int i = 0; i < 4; ++i) {
#pragma unroll 4
        for (int jj = 0; jj < 64; ++jj) { const float pj = rdl(p[i], jj); const unsigned w = *(const GAS unsigned*)(vbase + (size_t)(64 * i + jj) * 1024); o0 += pj * bflo(w); o1 += pj * bfhi(w); }
    }
    const float inv = 1.f / l;
    *(GAS unsigned*)(OM + trow * MEMW + head * 128 + 2 * lane) = pk2(o0 * inv, o1 * inv);
}
__device__ __forceinline__ void mixnorm_rows(bf16* ATT, const float* g, int gw, int NGW, int lane) {
    for (int m = gw; m < T; m += NGW) {
        GAS v4u* p = (GAS v4u*)(ATT + (size_t)m * DM + 32 * lane);
        v4u w[4]; float f[32]; float ss = 0.f;
#pragma unroll
        for (int c = 0; c < 4; ++c) { w[c] = p[c];
            f[8 * c + 0] = bflo(w[c].x); f[8 * c + 1] = bfhi(w[c].x); f[8 * c + 2] = bflo(w[c].y); f[8 * c + 3] = bfhi(w[c].y); f[8 * c + 4] = bflo(w[c].z); f[8 * c + 5] = bfhi(w[c].z); f[8 * c + 6] = bflo(w[c].w); f[8 * c + 7] = bfhi(w[c].w); }
#pragma unroll
        for (int i = 0; i < 32; ++i) ss += f[i] * f[i];
        const int grp = lane < 24 ? 0 : (lane < 40 ? 1 : 2);
        const float sa = wave_sum(grp == 0 ? ss : 0.f, lane), sb = wave_sum(grp == 1 ? ss : 0.f, lane), sc = wave_sum(grp == 2 ? ss : 0.f, lane);
        const float r = grp == 0 ? 1.f / sqrtf(sa * (1.f / 768.f) + EPS) : (grp == 1 ? 1.f / sqrtf(sb * (1.f / 512.f) + EPS) : 1.f / sqrtf(sc * (1.f / 768.f) + EPS));
        const float* gg = g + 32 * lane;
#pragma unroll
        for (int c = 0; c < 4; ++c) { const f32x4 g0 = *(const GAS f32x4*)(gg + 8 * c), g1 = *(const GAS f32x4*)(gg + 8 * c + 4);
            v4u o; o.x = pk2(f[8 * c + 0] * r * g0[0], f[8 * c + 1] * r * g0[1]); o.y = pk2(f[8 * c + 2] * r * g0[2], f[8 * c + 3] * r * g0[3]);
            o.z = pk2(f[8 * c + 4] * r * g1[0], f[8 * c + 5] * r * g1[1]); o.w = pk2(f[8 * c + 6] * r * g1[2], f[8 * c + 7] * r * g1[3]); p[c] = o; }
    }
}

#ifndef PEER_HD
#define PEER_HD __device__ __forceinline__
#define PEER_EXP(x) __expf(x)
#endif
template <int N> PEER_HD void bitonic_sort_desc(float* v) {
#pragma unroll
    for (int k = 2; k <= N; k <<= 1)
#pragma unroll
        for (int j = k >> 1; j > 0; j >>= 1)
#pragma unroll
            for (int i = 0; i < N; ++i) { const int l = i ^ j; if (l > i) { const bool desc = ((i & k) == 0); const float a = v[i], b = v[l]; const float hi = fmaxf(a, b), lo = fminf(a, b);
                v[i] = desc ? hi : lo; v[l] = desc ? lo : hi; } }
}
PEER_HD void merge_top16(float* a, const float* b) {
    float c[16];
#pragma unroll
    for (int i = 0; i < 16; ++i) c[i] = fmaxf(a[i], b[15 - i]);
#pragma unroll
    for (int j = 8; j > 0; j >>= 1)
#pragma unroll
        for (int i = 0; i < 16; ++i) { const int l = i ^ j; if (l > i) { const float x = c[i], y = c[l]; c[i] = fmaxf(x, y); c[l] = fminf(x, y); } }
#pragma unroll
    for (int i = 0; i < 16; ++i) a[i] = c[i];
}
PEER_HD void top16_of_64(float (&v)[64]) {
    bitonic_sort_desc<16>(&v[0]); bitonic_sort_desc<16>(&v[16]); bitonic_sort_desc<16>(&v[32]); bitonic_sort_desc<16>(&v[48]);
    merge_top16(&v[0], &v[16]); merge_top16(&v[32], &v[48]); merge_top16(&v[0], &v[32]);
}
PEER_HD float pack_idx(float s, unsigned idx, unsigned mask) { return __builtin_bit_cast(float, (__builtin_bit_cast(unsigned, s) & ~mask) | idx); }
PEER_HD unsigned low_bits(float s, unsigned mask) { return __builtin_bit_cast(unsigned, s) & mask; }
PEER_HD unsigned pick16(const float* a, unsigned i, unsigned mask) {
    unsigned r = 0;
#pragma unroll
    for (unsigned k = 0; k < 16; ++k) r = (i == k) ? low_bits(a[k], mask) : r;
    return r;
}
PEER_HD void peer_candidates(const float* a, const float* b, int* e, float* gate) {
    float c[64]; int n = 0;
#pragma unroll
    for (int i = 0; i < 16; ++i)
#pragma unroll
        for (int j = 0; j < 16; ++j) if ((i + 1) * (j + 1) <= 16) { c[n] = pack_idx(a[i] + b[j], (unsigned)(i * 16 + j), 0xffu); ++n; }
#pragma unroll
    for (int k = 50; k < 64; ++k) c[k] = -3.0e38f;
    top16_of_64(c);
    float mx = c[0], den = 0.f;
#pragma unroll
    for (int k = 0; k < 16; ++k) { const unsigned id = low_bits(c[k], 0xffu); const unsigned n0 = pick16(a, id >> 4, 0x7fu), n1 = pick16(b, id & 15u, 0x7fu);
        e[k] = (int)(n0 * 128u + n1); gate[k] = PEER_EXP(c[k] - mx); den += gate[k]; }
    const float inv = 1.f / den;
#pragma unroll
    for (int k = 0; k < 16; ++k) gate[k] *= inv;
}

__device__ __forceinline__ void peer_select_unit(const bf16* QP, const bf16* PK, int* PIDX, float* PGATE, int tb, int h, int wave, int lane) {
    const int hh = lane >> 5, tl = lane & 31; const size_t t = (size_t)tb * 256 + wave * 32 + tl;
    float ab[2][16];
#pragma unroll
    for (int p = 0; p < 2; ++p) {
        bf16x8 bq[8];
#pragma unroll
        for (int s = 0; s < 8; ++s) bq[s] = *(const GAS bf16x8*)(QP + t * DM + 256 * h + 128 * p + 16 * s + 8 * hh);
        float v[64];
#pragma unroll
        for (int nb = 0; nb < 4; ++nb) {
            f32x16 acc;
#pragma unroll
            for (int r = 0; r < 16; ++r) acc[r] = 0.f;
            const bf16* kp = PK + ((size_t)((h * 2 + p) * 128 + 32 * nb + tl)) * 128 + 8 * hh;
            bf16x8 ak[8];
#pragma unroll
            for (int s = 0; s < 8; ++s) ak[s] = *(const GAS bf16x8*)(kp + 16 * s);
#pragma unroll
            for (int s = 0; s < 8; ++s) acc = __builtin_amdgcn_mfma_f32_32x32x16_bf16(ak[s], bq[s], acc, 0, 0, 0);
#pragma unroll
            for (int r = 0; r < 16; ++r) v[16 * nb + r] = pack_idx(acc[r], (unsigned)(32 * nb + 8 * (r >> 2) + 4 * hh + (r & 3)), 0x7fu);
        }
        top16_of_64(v);
        float pv[16];
#pragma unroll
        for (int i = 0; i < 16; ++i) pv[i] = shx(v[i], 32, lane);
        merge_top16(&v[0], pv);
#pragma unroll
        for (int i = 0; i < 16; ++i) ab[p][i] = v[i];
    }
    int e[16]; float gate[16];
    peer_candidates(ab[0], ab[1], e, gate);
    if (hh == 0) { GAS v4u* o = (GAS v4u*)(PIDX + t * 128 + h * 16);
#pragma unroll
        for (int c = 0; c < 4; ++c) o[c] = (v4u){(unsigned)e[4 * c], (unsigned)e[4 * c + 1], (unsigned)e[4 * c + 2], (unsigned)e[4 * c + 3]}; }
    else { GAS f32x4* o = (GAS f32x4*)(PGATE + t * 128 + h * 16);
#pragma unroll
        for (int c = 0; c < 4; ++c) o[c] = (f32x4){gate[4 * c], gate[4 * c + 1], gate[4 * c + 2], gate[4 * c + 3]}; }
}

typedef float f32x2 __attribute__((ext_vector_type(2)));
typedef unsigned v6u __attribute__((ext_vector_type(6)));
typedef float v32f __attribute__((ext_vector_type(32)));
typedef v4u __attribute__((aligned(8))) v4u_a8;
constexpr float PU_SCALE6 = 90.0f, PV_SCALE6 = 5.65f;
__device__ __forceinline__ unsigned enc_e2m3(float v) {
    const float a = fminf(fabsf(v), 7.5f);
    unsigned code;
    if (a < 1.0f) code = (unsigned)__builtin_rintf(a * 8.f);
    else { const unsigned b = __builtin_bit_cast(unsigned, a) - 0x3F800000u; code = ((b + 0x7FFFFu + ((b >> 20) & 1u)) >> 20) + 8u; }
    return code | (v < 0.f ? 32u : 0u);
}
__device__ __forceinline__ void convert_fp6_rows(const float* src, unsigned char* dst, int nrows, float scale, const float* gain, int gw, int NGW, int lane) {
    for (int r = gw; r < nrows; r += NGW) {
        const float* sp = src + (size_t)r * DM + 4 * lane; const float* gp = gain ? gain + (size_t)(r / PEER_N) * DM + 4 * lane : nullptr;
        unsigned w[6] = {0u, 0u, 0u, 0u, 0u, 0u};
#pragma unroll
        for (int j = 0; j < 8; ++j) { f32x4 a = *(const GAS f32x4*)(sp + 256 * j) * scale; if (gp) a = a * *(const GAS f32x4*)(gp + 256 * j);
#pragma unroll
            for (int e = 0; e < 4; ++e) { const unsigned code = enc_e2m3(a[e]); const int bp = 6 * (4 * j + e), wi = bp >> 5, sh = bp & 31;
                w[wi] |= code << sh; if (sh > 26) w[wi + 1] |= code >> (32 - sh); } }
        unsigned char* dp = dst + (size_t)r * 1536 + 24 * lane;
        *(GAS v4u_a8*)dp = (v4u){w[0], w[1], w[2], w[3]}; *(GAS v2u*)(dp + 16) = (v2u){w[4], w[5]};
    }
}
constexpr float PV_SCALE4 = 5.65f, PU_SCALE4 = 90.0f;
__device__ __forceinline__ unsigned enc_e2m1(float v) {
    const float a = fabsf(v);
    const unsigned code = a < 0.25f ? 0u : a < 0.75f ? 1u : a < 1.25f ? 2u : a < 1.75f ? 3u : a < 2.5f ? 4u : a < 3.5f ? 5u : a < 5.0f ? 6u : 7u;
    return code | (v < 0.f ? 8u : 0u);
}
__device__ __forceinline__ void convert_fp4_rows(const float* src, unsigned char* dst, int nrows, float scale, const float* gain, int gw, int NGW, int lane) {
    for (int r0 = 2 * gw; r0 < nrows; r0 += 2 * NGW) {
        f32x4 a[2][8];
#pragma unroll
        for (int q = 0; q < 2; ++q) { const float* sp = src + (size_t)(r0 + q) * DM + 4 * lane;
#pragma unroll
            for (int j = 0; j < 8; ++j) a[q][j] = *(const GAS f32x4*)(sp + 256 * j); }
#pragma unroll
        for (int q = 0; q < 2; ++q) { const int r = r0 + q; const float* gp = gain ? gain + (size_t)(r / PEER_N) * DM + 4 * lane : nullptr;
            unsigned w[4] = {0u, 0u, 0u, 0u};
#pragma unroll
            for (int j = 0; j < 8; ++j) { f32x4 v = a[q][j] * scale; if (gp) v = v * *(const GAS f32x4*)(gp + 256 * j);
#pragma unroll
                for (int e = 0; e < 4; ++e) { const int i = 4 * j + e; w[i >> 3] |= enc_e2m1(v[e]) << (4 * (i & 7)); } }
            *(GAS v4u*)(dst + (size_t)r * 1024 + 16 * lane) = (v4u){w[0], w[1], w[2], w[3]}; }
    }
}
#define PG4_LOAD(buf, tab, idlo, idhi, g) do { _Pragma("unroll") for (int i_ = 0; i_ < PG6_R; ++i_) { const int k_ = (g) * PG6_R + i_; \
        const int e_ = __builtin_amdgcn_readlane(k_ < 64 ? idlo : idhi, k_ & 63); buf[i_] = __builtin_amdgcn_raw_buffer_load_b128(tab, (int)voff4, e_ * 1024, 0); } } while (0)
#define PG4_DOT1(buf, i_, dst) do { f32x2 a_ = {0.f, 0.f}; _Pragma("unroll") for (int c_ = 0; c_ < 4; ++c_) { const unsigned u_ = buf[i_][c_]; \
        a_ += __builtin_amdgcn_cvt_scalef32_pk_f32_fp4(u_, 1.0f, 0) * x[4 * c_ + 0]; a_ += __builtin_amdgcn_cvt_scalef32_pk_f32_fp4(u_, 1.0f, 1) * x[4 * c_ + 1]; \
        a_ += __builtin_amdgcn_cvt_scalef32_pk_f32_fp4(u_, 1.0f, 2) * x[4 * c_ + 2]; a_ += __builtin_amdgcn_cvt_scalef32_pk_f32_fp4(u_, 1.0f, 3) * x[4 * c_ + 3]; } dst = a_.x + a_.y; __builtin_amdgcn_sched_barrier(0); } while (0)
#define PG4_DOT(buf, g) do { float p_[8]; _Pragma("unroll") for (int i_ = 0; i_ < 8; ++i_) PG4_DOT1(buf, i_, p_[i_]); \
        float q_[4]; _Pragma("unroll") for (int i_ = 0; i_ < 4; ++i_) { const float keep_ = b5 ? p_[i_ + 4] : p_[i_], send_ = b5 ? p_[i_] : p_[i_ + 4]; q_[i_] = keep_ + shx(send_, 32, lane); } \
        float r_[2]; _Pragma("unroll") for (int i_ = 0; i_ < 2; ++i_) { const float keep_ = b4 ? q_[i_ + 2] : q_[i_], send_ = b4 ? q_[i_] : q_[i_ + 2]; r_[i_] = keep_ + shx(send_, 16, lane); } \
        float s_; { const float keep_ = b3 ? r_[1] : r_[0], send_ = b3 ? r_[0] : r_[1]; s_ = keep_ + shx(send_, 8, lane); } \
        s_ += shx(s_, 4, lane); s_ += shx(s_, 2, lane); s_ += shx(s_, 1, lane); \
        if ((lane & 7) == 0) wl[(g) * 8 + (lane >> 3)] = s_; } while (0)
#define PG4_AXPY(buf, g) do { _Pragma("unroll") for (int i_ = 0; i_ < PG6_R; ++i_) { const float w_ = wl[(g) * PG6_R + i_]; const f32x2 wv_ = {w_, w_}; \
        _Pragma("unroll") for (int c_ = 0; c_ < 4; ++c_) { const unsigned u_ = buf[i_][c_]; \
            y[4 * c_ + 0] += __builtin_amdgcn_cvt_scalef32_pk_f32_fp4(u_, 1.0f, 0) * wv_; y[4 * c_ + 1] += __builtin_amdgcn_cvt_scalef32_pk_f32_fp4(u_, 1.0f, 1) * wv_; \
            y[4 * c_ + 2] += __builtin_amdgcn_cvt_scalef32_pk_f32_fp4(u_, 1.0f, 2) * wv_; y[4 * c_ + 3] += __builtin_amdgcn_cvt_scalef32_pk_f32_fp4(u_, 1.0f, 3) * wv_; } \
        __builtin_amdgcn_sched_barrier(0); } } while (0)
#ifndef PG6_R
#define PG6_R 8
#endif
#define PG6_LOAD(buf, tab, idlo, idhi, g) do { _Pragma("unroll") for (int i_ = 0; i_ < PG6_R; ++i_) { const int k_ = (g) * PG6_R + i_; \
        const int e_ = __builtin_amdgcn_readlane(k_ < 64 ? idlo : idhi, k_ & 63); const unsigned char* rp_ = (tab) + (size_t)(unsigned)e_ * 1536u; \
        const v4u a_ = *(const GAS v4u_a8*)(rp_ + voff); const v2u b_ = *(const GAS v2u*)(rp_ + voff + 16); buf[i_] = (v6u){a_.x, a_.y, a_.z, a_.w, b_.x, b_.y}; } } while (0)
#define PG6_DOT1(buf, i_, dst) do { const v32f f_ = __builtin_amdgcn_cvt_scalef32_pk32_f32_fp6(buf[i_], 1.0f); f32x2 a_ = {0.f, 0.f}; \
        _Pragma("unroll") for (int c_ = 0; c_ < 16; ++c_) a_ += (f32x2){f_[2 * c_], f_[2 * c_ + 1]} * x[c_]; dst = a_.x + a_.y; __builtin_amdgcn_sched_barrier(0); } while (0)
#if PG6_R == 8
#define PG6_DOT(buf, g) do { float p_[8]; _Pragma("unroll") for (int i_ = 0; i_ < 8; ++i_) PG6_DOT1(buf, i_, p_[i_]); \
        float q_[4]; _Pragma("unroll") for (int i_ = 0; i_ < 4; ++i_) { const float keep_ = b5 ? p_[i_ + 4] : p_[i_], send_ = b5 ? p_[i_] : p_[i_ + 4]; q_[i_] = keep_ + shx(send_, 32, lane); } \
        float r_[2]; _Pragma("unroll") for (int i_ = 0; i_ < 2; ++i_) { const float keep_ = b4 ? q_[i_ + 2] : q_[i_], send_ = b4 ? q_[i_] : q_[i_ + 2]; r_[i_] = keep_ + shx(send_, 16, lane); } \
        float s_; { const float keep_ = b3 ? r_[1] : r_[0], send_ = b3 ? r_[0] : r_[1]; s_ = keep_ + shx(send_, 8, lane); } \
        s_ += shx(s_, 4, lane); s_ += shx(s_, 2, lane); s_ += shx(s_, 1, lane); \
        if ((lane & 7) == 0) wl[(g) * 8 + (lane >> 3)] = s_; } while (0)
#else
#define PG6_DOT(buf, g) do { float p_[4]; _Pragma("unroll") for (int i_ = 0; i_ < 4; ++i_) PG6_DOT1(buf, i_, p_[i_]); \
        float r_[2]; _Pragma("unroll") for (int i_ = 0; i_ < 2; ++i_) { const float keep_ = b5 ? p_[i_ + 2] : p_[i_], send_ = b5 ? p_[i_] : p_[i_ + 2]; r_[i_] = keep_ + shx(send_, 32, lane); } \
        float s_; { const float keep_ = b4 ? r_[1] : r_[0], send_ = b4 ? r_[0] : r_[1]; s_ = keep_ + shx(send_, 16, lane); } \
        s_ += shx(s_, 8, lane); s_ += shx(s_, 4, lane); s_ += shx(s_, 2, lane); s_ += shx(s_, 1, lane); \
        if ((lane & 15) == 0) wl[(g) * 4 + (lane >> 4)] = s_; } while (0)
#endif
#define PG6_AXPY(buf, g) do { _Pragma("unroll") for (int i_ = 0; i_ < PG6_R; ++i_) { const float w_ = wl[(g) * PG6_R + i_]; const f32x2 wv_ = {w_, w_}; \
        const v32f f_ = __builtin_amdgcn_cvt_scalef32_pk32_f32_fp6(buf[i_], 1.0f); _Pragma("unroll") for (int c_ = 0; c_ < 16; ++c_) y[c_] += (f32x2){f_[2 * c_], f_[2 * c_ + 1]} * wv_; __builtin_amdgcn_sched_barrier(0); } } while (0)
__device__ __forceinline__ unsigned shxu(unsigned v, int k, int lane) { return (unsigned)__builtin_amdgcn_ds_bpermute((lane ^ k) << 2, (int)v); }
__device__ __forceinline__ void wave_sort128(unsigned& a, unsigned& b, int lane) {
#pragma unroll
    for (int k = 2; k <= 128; k <<= 1) {
#pragma unroll
        for (int j = k >> 1; j > 0; j >>= 1) {
            if (j == 64) { const unsigned lo = a < b ? a : b, hi = a < b ? b : a; a = lo; b = hi; }
            else {
                const unsigned pa = shxu(a, j, lane), pb = shxu(b, j, lane);
                const bool lower = (lane & j) == 0;
                const bool asc_a = (lane & k) == 0, asc_b = ((lane + 64) & k) == 0;
                const bool take_min_a = (lower == asc_a), take_min_b = (lower == asc_b);
                a = take_min_a ? (a < pa ? a : pa) : (a < pa ? pa : a);
                b = take_min_b ? (b < pb ? b : pb) : (b < pb ? pb : b);
            }
        }
    }
}
#ifndef PEER_U_FP4
#define PEER_U_FP4 1
#endif
#if PEER_U_FP4
typedef v4u urow_t;
#define PGU_LOAD PG4_LOAD
#define PGU_DOT PG4_DOT
constexpr float PU_SCALE = PU_SCALE4; constexpr int PU_STRIDE = 1024;
#else
typedef v6u urow_t;
#define PGU_LOAD PG6_LOAD
#define PGU_DOT PG6_DOT
constexpr float PU_SCALE = PU_SCALE6; constexpr int PU_STRIDE = 1536;
#endif
constexpr float PU_SCALEI = 135.0f, PX_SCALEI = 20.0f;
__device__ __forceinline__ void peer_v_pass(bf16* XN, const unsigned char* PV6, const int* PIDX, const float* PGATE, const int* PARTI, float* X, u64_t* rowsq_out, LAS float* wl, int gw, int NGW, int lane) {
    const unsigned voff4 = 16u * (unsigned)lane, l4 = 4u * (unsigned)lane, l8 = 8u * (unsigned)lane, l16 = 16u * (unsigned)lane;
    constexpr int NG = 128 / PG6_R;
    const __amdgpu_buffer_rsrc_t PVr = __builtin_amdgcn_make_buffer_rsrc((void*)PV6, 0, PEER_N * 1024, 0x00020000);
    for (int t_ = gw; t_ < T; t_ += NGW) {
        int t = t_; asm volatile("" : "+s"(t));
        const char* pidx_t = (const char*)(PIDX + (size_t)t * 128); const char* pgate_t = (const char*)(PGATE + (size_t)t * 128);
        const int idlo = *(const GAS int*)(pidx_t + l4), idhi = *(const GAS int*)(pidx_t + l4 + 256);
        v4u AV[PG6_R], BV[PG6_R];
        PG4_LOAD(AV, PVr, idlo, idhi, 0);
        {
            int s0 = 0, s1 = 0;
#pragma unroll
            for (int sp = 0; sp < 8; ++sp) { const char* pp = (const char*)(PARTI + ((size_t)sp * T + t) * 128); s0 += *(const GAS int*)(pp + l4); s1 += *(const GAS int*)(pp + l4 + 256); }
            const float d0 = (float)s0 * (1.f / (PX_SCALEI * PU_SCALEI)), d1 = (float)s1 * (1.f / (PX_SCALEI * PU_SCALEI));
            const float g0 = *(const GAS float*)(pgate_t + l4), g1 = *(const GAS float*)(pgate_t + l4 + 256);
            const float w0 = g0 * 0.5f * d0 * (1.f + erff(d0 * 0.70710678118654752f)) * (1.f / PV_SCALE4), w1 = g1 * 0.5f * d1 * (1.f + erff(d1 * 0.70710678118654752f)) * (1.f / PV_SCALE4);
            wl[lane] = w0; wl[64 + lane] = w1;
            LDS_WAIT(); asm volatile("" ::: "memory");
        }
        f32x2 y[16];
#pragma unroll
        for (int i = 0; i < 16; ++i) y[i] = (f32x2){0.f, 0.f};
#pragma unroll 1
        for (int g = 0; g < NG; g += 2) {
            PG4_LOAD(BV, PVr, idlo, idhi, g + 1);
            PG4_AXPY(AV, g);
            if (g + 2 < NG) PG4_LOAD(AV, PVr, idlo, idhi, g + 2);
            PG4_AXPY(BV, g + 1);
        }
        {   char* xo = (char*)(X + (size_t)t * DM);
            char* xbo = (char*)(XN + (size_t)t * DM); float ss = 0.f;
#pragma unroll
            for (int j = 0; j < 8; ++j) { const v2u a = *(const GAS v2u*)(xbo + l8 + 512 * j); f32x4 v = (f32x4){bflo(a.x), bfhi(a.x), bflo(a.y), bfhi(a.y)}; v += (f32x4){y[2 * j].x, y[2 * j].y, y[2 * j + 1].x, y[2 * j + 1].y};
                if (X) *(GAS f32x4*)(xo + l16 + 1024 * j) = v;
                ss += (v[0] * v[0] + v[1] * v[1]) + (v[2] * v[2] + v[3] * v[3]); *(GAS v2u*)(xbo + l8 + 512 * j) = (v2u){pk2(v[0], v[1]), pk2(v[2], v[3])}; }
            if (rowsq_out) { ss = wave_sum(ss, lane); if (lane == 0) rowsq_out[t] = rowsq_fx(ss); } }
        LDS_WAIT(); asm volatile("" ::: "memory");
    }
}


__device__ __forceinline__ unsigned enc_i4(float v) { int q = (int)__builtin_rintf(v); q = q < -7 ? -7 : (q > 7 ? 7 : q); return (unsigned)q & 15u; }
__device__ __forceinline__ void convert_int4_plain(const float* src, unsigned char* dst, int nrows, float scale, const float* gain, int gw, int NGW, int lane) {
    for (int r0 = 2 * gw; r0 < nrows; r0 += 2 * NGW) {
        f32x4 a[2][8];
#pragma unroll
        for (int q = 0; q < 2; ++q) { const float* sp = src + (size_t)(r0 + q) * DM + 4 * lane;
#pragma unroll
            for (int j = 0; j < 8; ++j) a[q][j] = *(const GAS f32x4*)(sp + 256 * j); }
#pragma unroll
        for (int q = 0; q < 2; ++q) { const int r = r0 + q; const float* gp = gain ? gain + (size_t)(r / PEER_N) * DM + 4 * lane : nullptr;
#pragma unroll
            for (int j = 0; j < 8; ++j) { f32x4 v = a[q][j] * scale; if (gp) v = v * *(const GAS f32x4*)(gp + 256 * j);
                const unsigned w = enc_i4(v[0]) | (enc_i4(v[1]) << 4) | (enc_i4(v[2]) << 8) | (enc_i4(v[3]) << 12);
                *(GAS unsigned short*)(dst + (size_t)r * 1024 + 128 * j + 2 * lane) = (unsigned short)w; } }
    }
}
__device__ __forceinline__ void peer_xquant_unit(const bf16* XN, const u64_t* rowsq, unsigned* XQH, unsigned* XQL, int tb, int sl, int tid) {
    for (int it = tid; it < 256 * 32; it += NTHREADS) {
        const int t = tb * 256 + (it >> 5), c8 = it & 31;
        const float xs = PX_SCALEI * rowsq_rs(rowsq, t);
        const v4u w = *(const GAS v4u*)(XN + (size_t)t * DM + 256 * sl + 8 * c8);
        const float f[8] = {bflo(w.x), bfhi(w.x), bflo(w.y), bfhi(w.y), bflo(w.z), bfhi(w.z), bflo(w.w), bfhi(w.w)};
        unsigned hi = 0u, lo = 0u;
#pragma unroll
        for (int j = 0; j < 8; ++j) { int q = (int)__builtin_rintf(f[j] * xs); q = q < -119 ? -119 : (q > 119 ? 119 : q);
            const int xl = ((q + 8) & 15) - 8, xh = (q - xl) >> 4;
            hi |= ((unsigned)xh & 15u) << (4 * j); lo |= ((unsigned)xl & 15u) << (4 * j); }
        XQH[(size_t)t * 256 + 32 * sl + c8] = hi; XQL[(size_t)t * 256 + 32 * sl + c8] = lo;
    }
}
#define PI_LOADROWS(buf, tab, ids, i0) do { _Pragma("unroll") for (int i_ = 0; i_ < 8; ++i_) buf[i_] = __builtin_amdgcn_raw_buffer_load_b128(tab, ids[(i0) + i_] * 1024 + (int)soff, 0, 0); } while (0)
#define PI_LOADIDS(ids, t) do { const char* ip_ = (const char*)PIDX + ((size_t)(t) * 128 + 16 * g) * 4; _Pragma("unroll") for (int c_ = 0; c_ < 4; ++c_) { const v4u q_ = *(const GAS v4u*)(ip_ + 16 * c_); \
        ids[4 * c_] = (int)q_.x; ids[4 * c_ + 1] = (int)q_.y; ids[4 * c_ + 2] = (int)q_.z; ids[4 * c_ + 3] = (int)q_.w; } } while (0)
#define PI_UGROUP(buf, i0) do { _Pragma("unroll") for (int i_ = 0; i_ < 8; ++i_) { int ah_ = 0, al_ = 0; \
        _Pragma("unroll") for (int c_ = 0; c_ < 4; ++c_) { ah_ = __builtin_amdgcn_sdot8((int)buf[i_][c_], (int)xh[c_], ah_, false); al_ = __builtin_amdgcn_sdot8((int)buf[i_][c_], (int)xl[c_], al_, false); } \
        int p_ = 16 * ah_ + al_; p_ += __builtin_amdgcn_ds_bpermute((lane ^ 1) << 2, p_); p_ += __builtin_amdgcn_ds_bpermute((lane ^ 2) << 2, p_); p_ += __builtin_amdgcn_ds_bpermute((lane ^ 4) << 2, p_); \
        if (m == (((i0) + i_) >> 1)) { if (((i0) + i_) & 1) keep1 = p_; else keep0 = p_; } } } while (0)
#define PI_LOADROWS16(buf, tab, ids) do { _Pragma("unroll") for (int i_ = 0; i_ < 16; ++i_) buf[i_] = __builtin_amdgcn_raw_buffer_load_b128(tab, ids[i_] * 1024 + (int)soff, 0, 0); } while (0)
#define PI_LOADX(xh_, xl_, t) do { xh_ = *(const GAS v4u*)((const char*)XQH + (size_t)(t) * 1024 + soff); xl_ = *(const GAS v4u*)((const char*)XQL + (size_t)(t) * 1024 + soff); } while (0)
#define PI_COMPUTE16(buf, xh_, xl_, t) do { int keep0 = 0, keep1 = 0; \
        _Pragma("unroll") for (int i_ = 0; i_ < 16; ++i_) { int ah_ = 0, al_ = 0; \
            _Pragma("unroll") for (int c_ = 0; c_ < 4; ++c_) { ah_ = __builtin_amdgcn_sdot8((int)buf[i_][c_], (int)xh_[c_], ah_, false); al_ = __builtin_amdgcn_sdot8((int)buf[i_][c_], (int)xl_[c_], al_, false); } \
            int p_ = 16 * ah_ + al_; p_ += __builtin_amdgcn_update_dpp(0, p_, 0xB1, 0xf, 0xf, true); p_ += __builtin_amdgcn_update_dpp(0, p_, 0x4E, 0xf, 0xf, true); p_ += __builtin_amdgcn_update_dpp(0, p_, 0x141, 0xf, 0xf, true);   \
            if (m == (i_ >> 1)) { if (i_ & 1) keep1 = p_; else keep0 = p_; } } \
        if ((t) < T) *(GAS v2u*)(PARTI + ((size_t)s * T + (t)) * 128 + 2 * lane) = (v2u){(unsigned)keep0, (unsigned)keep1}; } while (0)
__device__ __forceinline__ void peer_u_phase_i4(const unsigned* XQH, const unsigned* XQL, const unsigned char* PU, const int* PIDX, int* PARTI, int bid, int G, int wave, int lane) {
    const int s = bid & 7, nr = (G - s + 7) >> 3, q = (bid >> 3) * NWAVES + wave, stride = nr * NWAVES, g = lane >> 3, m = lane & 7;
    const unsigned soff = 128u * (unsigned)s + 16u * (unsigned)m;
    if (q >= T) return;
    const __amdgpu_buffer_rsrc_t PUr = __builtin_amdgcn_make_buffer_rsrc((void*)PU, 0, PEER_N * 1024, 0x00020000);
#define PI_CL(t) ((t) < T ? (t) : T - 1)
    int I1[16], I2[16]; v4u xh0, xl0, xh1, xl1, xh2, xl2, RA[16], RB[16];
    PI_LOADIDS(I1, q); PI_LOADX(xh0, xl0, q);
    PI_LOADROWS16(RA, PUr, I1);
    PI_LOADIDS(I1, PI_CL(q + stride)); PI_LOADX(xh1, xl1, PI_CL(q + stride));
    for (int t = q; t < T; t += 2 * stride) {
        PI_LOADROWS16(RB, PUr, I1);
        PI_LOADIDS(I2, PI_CL(t + 2 * stride)); PI_LOADX(xh2, xl2, PI_CL(t + 2 * stride));
        PI_COMPUTE16(RA, xh0, xl0, t);
        PI_LOADROWS16(RA, PUr, I2);
        PI_LOADIDS(I1, PI_CL(t + 3 * stride)); PI_LOADX(xh0, xl0, PI_CL(t + 3 * stride));
        PI_COMPUTE16(RB, xh1, xl1, t + stride);
        xh1 = xh0; xl1 = xl0; xh0 = xh2; xl0 = xl2;
    }
#undef PI_CL
}


constexpr float PV_SCALE4S = 5.65f;
__device__ __forceinline__ unsigned enc_e2m1s(float v) {
    const float a = fabsf(v);
    const unsigned code = a < 0.25f ? 0u : a < 0.75f ? 1u : a < 1.25f ? 2u : a < 1.75f ? 3u : a < 2.5f ? 4u : a < 3.5f ? 5u : a < 5.0f ? 6u : 7u;
    return code | (v < 0.f ? 8u : 0u);
}
__device__ __forceinline__ void convert_fp4_plain(const float* src, unsigned char* dst, int nrows, float scale, const float* gain, int gw, int NGW, int lane) {
    for (int r0 = 2 * gw; r0 < nrows; r0 += 2 * NGW) {
        f32x4 a[2][8];
#pragma unroll
        for (int q = 0; q < 2; ++q) { const float* sp = src + (size_t)(r0 + q) * DM + 4 * lane;
#pragma unroll
            for (int j = 0; j < 8; ++j) a[q][j] = *(const GAS f32x4*)(sp + 256 * j); }
#pragma unroll
        for (int q = 0; q < 2; ++q) { const int r = r0 + q; const float* gp = gain ? gain + (size_t)(r / PEER_N) * DM + 4 * lane : nullptr;
#pragma unroll
            for (int j = 0; j < 8; ++j) { f32x4 v = a[q][j] * scale; if (gp) v = v * *(const GAS f32x4*)(gp + 256 * j);
                const unsigned w = enc_e2m1s(v[0]) | (enc_e2m1s(v[1]) << 4) | (enc_e2m1s(v[2]) << 8) | (enc_e2m1s(v[3]) << 12);
                *(GAS unsigned short*)(dst + (size_t)r * 1024 + 128 * j + 2 * lane) = (unsigned short)w; } }
    }
}
#define PVS_LOADMETA(ids, pp, gg, t) do { PI_LOADIDS(ids, t); _Pragma("unroll") for (int sp_ = 0; sp_ < 8; ++sp_) pp[sp_] = *(const GAS v2u*)(PARTI + ((size_t)sp_ * T + (t)) * 128 + 2 * lane); \
        gg = *(const GAS f32x2*)(PGATE + (size_t)(t) * 128 + 2 * lane); } while (0)
#define PVS_COMPUTE16(buf, pp, gg, t) do { float w0, w1; { int s0_ = 0, s1_ = 0; _Pragma("unroll") for (int sp_ = 0; sp_ < 8; ++sp_) { s0_ += (int)pp[sp_].x; s1_ += (int)pp[sp_].y; } \
            const float d0_ = (float)s0_ * (1.f / (PX_SCALEI * PU_SCALEI)), d1_ = (float)s1_ * (1.f / (PX_SCALEI * PU_SCALEI)); \
            w0 = gg.x * 0.5f * d0_ * (1.f + erff(d0_ * 0.70710678118654752f)) * (1.f / PV_SCALE4S); w1 = gg.y * 0.5f * d1_ * (1.f + erff(d1_ * 0.70710678118654752f)) * (1.f / PV_SCALE4S); } \
        f32x2 y[16]; _Pragma("unroll") for (int i_ = 0; i_ < 16; ++i_) y[i_] = (f32x2){0.f, 0.f}; \
        _Pragma("unroll") for (int i_ = 0; i_ < 16; ++i_) { \
            const float w_ = __builtin_bit_cast(float, __builtin_amdgcn_ds_bpermute(((lane & 56) | (i_ >> 1)) << 2, __builtin_bit_cast(int, (i_ & 1) ? w1 : w0))); const f32x2 wv_ = {w_, w_}; \
            _Pragma("unroll") for (int c_ = 0; c_ < 4; ++c_) { const unsigned u_ = buf[i_][c_]; \
                y[4 * c_ + 0] += __builtin_amdgcn_cvt_scalef32_pk_f32_fp4(u_, 1.0f, 0) * wv_; y[4 * c_ + 1] += __builtin_amdgcn_cvt_scalef32_pk_f32_fp4(u_, 1.0f, 1) * wv_; \
                y[4 * c_ + 2] += __builtin_amdgcn_cvt_scalef32_pk_f32_fp4(u_, 1.0f, 2) * wv_; y[4 * c_ + 3] += __builtin_amdgcn_cvt_scalef32_pk_f32_fp4(u_, 1.0f, 3) * wv_; } } \
        {   LAS float* wp_ = yl + g * 288 + m * 36; \
            _Pragma("unroll") for (int c_ = 0; c_ < 8; ++c_) *(LAS f32x4*)(wp_ + 4 * c_) = (f32x4){y[2 * c_].x, y[2 * c_].y, y[2 * c_ + 1].x, y[2 * c_ + 1].y}; \
            LDS_WAIT(); asm volatile("" ::: "memory"); \
            f32x4 acc_ = {0.f, 0.f, 0.f, 0.f}; const LAS float* rp_ = yl + (lane >> 3) * 36 + 4 * (lane & 7); \
            _Pragma("unroll") for (int gg_ = 0; gg_ < 8; ++gg_) acc_ += *(const LAS f32x4*)(rp_ + gg_ * 288); \
            LDS_WAIT(); asm volatile("" ::: "memory"); \
            if ((t) < T) { bf16* xp_ = XN + (size_t)(t) * DM + 256 * s + 4 * lane; const v2u a_ = *(const GAS v2u*)xp_; \
                const f32x4 v_ = (f32x4){bflo(a_.x), bfhi(a_.x), bflo(a_.y), bfhi(a_.y)} + acc_; \
                *(GAS v2u*)xp_ = (v2u){pk2(v_[0], v_[1]), pk2(v_[2], v_[3])}; \
                if (Xout) *(GAS f32x4*)(Xout + (size_t)(t) * DM + 256 * s + 4 * lane) = v_; \
                if (rowsq_out) { const float ss_ = wave_sum((v_[0] * v_[0] + v_[1] * v_[1]) + (v_[2] * v_[2] + v_[3] * v_[3]), lane); if (lane == 0) atomicAdd(rowsq_out + (t), rowsq_fx(ss_)); } } } } while (0)
__device__ __forceinline__ void peer_v_phase_s(bf16* XN, const unsigned char* PV, const int* PIDX, const float* PGATE, const int* PARTI, float* Xout, u64_t* rowsq_out, LAS float* yl, int bid, int G, int wave, int lane) {
    const int s = bid & 7, nr = (G - s + 7) >> 3, q = (bid >> 3) * NWAVES + wave, stride = nr * NWAVES, g = lane >> 3, m = lane & 7;
    const unsigned soff = 128u * (unsigned)s + 16u * (unsigned)m;
    if (q >= T) return;
    const __amdgpu_buffer_rsrc_t PVr = __builtin_amdgcn_make_buffer_rsrc((void*)PV, 0, PEER_N * 1024, 0x00020000);
#define PVS_CL(t) ((t) < T ? (t) : T - 1)
    int I0[16], I1[16]; v2u P0[8], P1[8]; f32x2 G0, G1; v4u RA[16], RB[16];
#define PVS_LOADPG(pp, gg, t) do { _Pragma("unroll") for (int sp_ = 0; sp_ < 8; ++sp_) pp[sp_] = *(const GAS v2u*)(PARTI + ((size_t)sp_ * T + (t)) * 128 + 2 * lane); gg = *(const GAS f32x2*)(PGATE + (size_t)(t) * 128 + 2 * lane); } while (0)
    PI_LOADIDS(I0, q); PVS_LOADPG(P0, G0, q);
    PI_LOADROWS16(RA, PVr, I0);
    PI_LOADIDS(I1, PVS_CL(q + stride)); PVS_LOADPG(P1, G1, PVS_CL(q + stride));
    for (int t = q; t < T; t += 2 * stride) {
        PI_LOADROWS16(RB, PVr, I1);
        PI_LOADIDS(I0, PVS_CL(t + 2 * stride));
        PVS_COMPUTE16(RA, P0, G0, t);
        PVS_LOADPG(P0, G0, PVS_CL(t + 2 * stride));
        PI_LOADROWS16(RA, PVr, I0);
        PI_LOADIDS(I1, PVS_CL(t + 3 * stride));
        PVS_COMPUTE16(RB, P1, G1, t + stride);
        PVS_LOADPG(P1, G1, PVS_CL(t + 3 * stride));
    }
#undef PVS_LOADPG
#undef PVS_CL
}

typedef short s16x4 __attribute__((ext_vector_type(4)));
typedef __attribute__((address_space(3))) const char* lds_cptr;
__device__ __forceinline__ s16x4 vtr(lds_cptr p) { return __builtin_bit_cast(s16x4, __builtin_amdgcn_ds_read_tr16_b64_v4i16((__attribute__((address_space(3))) s16x4*)p)); }
__device__ __forceinline__ unsigned cvtpk(float lo, float hi) { unsigned r; asm("v_cvt_pk_bf16_f32 %0, %1, %2" : "=v"(r) : "v"(lo), "v"(hi)); return r; }
constexpr int AT_K0 = 0, AT_V0 = 16384, AT_TAB = 32768;
constexpr float LOG2E = 1.4426950408889634f;
template <int TYPE>
__device__ __forceinline__ void attn_unit(LAS unsigned char* lds, const bf16* QKV, bf16* ATT, u64_t* mixsq, int b, int head, int qb, const float* tabsrc, float Cl2, float sinkl2, int tid) {
    const int lane = tid & 63, w = __builtin_amdgcn_readfirstlane(tid >> 6), hh = lane >> 5, l31 = lane & 31;
    int qcol, kcol, vcol, ocol;
    if (TYPE == 0) { qcol = QA + head * 64; kcol = KA + (head / 3) * 64; vcol = VA + (head / 3) * 64; ocol = OA + head * 64; }
    else if (TYPE == 1) { qcol = QB + head * 64; kcol = KB + head * 64; vcol = VB + head * 64; ocol = OB + head * 64; }
    else { qcol = QC + head * 64; kcol = KC + (head / 3) * 64; vcol = VC + (head / 3) * 64; ocol = OC + head * 64; }
    const int q0 = 256 * qb + 32 * w, qpos = q0 + l31;
    int t_begin, t_end;
    if (TYPE == 0) { t_begin = 4 * qb - 2; if (t_begin < 0) t_begin = 0; t_end = 4 * qb + 6; if (t_end > 32) t_end = 32; }
    else if (TYPE == 1) { int a = 4 * qb - 4; a = a < 0 ? 0 : (a > 24 ? 24 : a); int e = 4 * qb - 1; e = e < 0 ? 0 : (e > 24 ? 24 : e); t_begin = a; t_end = e + 8; }
    else { t_begin = 0; t_end = 32; }
    LAS float* tab = (LAS float*)(lds + AT_TAB);
    if (TYPE == 0) { for (int i = tid; i < 1024; i += NTHREADS) { const int rel = i - 448; tab[i] = (rel >= -128 && rel <= 128) ? tabsrc[head * 257 + rel + 128] * LOG2E - Cl2 : -1e30f; } }
    if (TYPE == 1) { for (int i = tid; i < 15 * 31; i += NTHREADS) tab[i] = tabsrc[head * 465 + i] * LOG2E - Cl2; }
    bf16x8 qf[4];
    {   const bf16* qp = QKV + ((size_t)b * SEQ + qpos) * DIN + qcol + 8 * hh;
#pragma unroll
        for (int s = 0; s < 4; ++s) qf[s] = *(const GAS bf16x8*)(qp + 16 * s); }
    const int srow = tid >> 3, sch = tid & 7;
    const bf16* kg = QKV + ((size_t)b * SEQ + srow) * DIN + kcol + sch * 8;
    const bf16* vg = QKV + ((size_t)b * SEQ + srow) * DIN + vcol + sch * 8;
    const int kst = srow * 128 + ((sch ^ ((srow >> 1) & 7)) * 16);
    const int vst = srow * 128 + (((sch >> 2) ^ ((srow >> 1) & 1)) * 64) + (sch & 3) * 16;
    int kread[4], vread[2];
#pragma unroll
    for (int s = 0; s < 4; ++s) kread[s] = l31 * 128 + (((2 * s + hh) ^ ((lane >> 1) & 7)) * 16);
#pragma unroll
    for (int db = 0; db < 2; ++db) vread[db] = (4 * hh + ((lane >> 2) & 3)) * 128 + ((db ^ ((lane >> 3) & 1)) * 64) + 32 * ((lane >> 4) & 1) + 8 * (lane & 3);
    f32x16 O0, O1;
#pragma unroll
    for (int r = 0; r < 16; ++r) { O0[r] = 0.f; O1[r] = 0.f; }
    float lsum = 0.f;
    const int rw = 4 * qb + (w >> 1), cq = 32 * (w & 1) + l31;
    int r0w = rw - 4; r0w = r0w < 0 ? 0 : (r0w > 24 ? 24 : r0w);
    int c0 = cq - 8; c0 = c0 < 0 ? 0 : (c0 > 48 ? 48 : c0);
    {   const v4u kr = *(const GAS v4u*)(kg + (size_t)t_begin * 64 * DIN), vr = *(const GAS v4u*)(vg + (size_t)t_begin * 64 * DIN);
        *(LAS v4u*)(lds + AT_K0 + kst) = kr; *(LAS v4u*)(lds + AT_V0 + vst) = vr; }
    __syncthreads();
    for (int t = t_begin; t < t_end; ++t) {
        const int cur = (t - t_begin) & 1;
        v4u kr, vr;
        if (t + 1 < t_end) { kr = *(const GAS v4u*)(kg + (size_t)(t + 1) * 64 * DIN); vr = *(const GAS v4u*)(vg + (size_t)(t + 1) * 64 * DIN); }
        bool need = true;
        if (TYPE == 0) need = (64 * t <= q0 + 31 + 128) && (64 * t + 63 >= q0 - 128);
        if (TYPE == 1) need = (t >= r0w) && (t < r0w + 8);
        if (need) {
            const lds_cptr kb_ = (lds_cptr)(lds + AT_K0 + cur * 8192), vb_ = (lds_cptr)(lds + AT_V0 + cur * 8192);
            bf16x8 kf[8];
#pragma unroll
            for (int s = 0; s < 4; ++s) { kf[2 * s] = *(const LAS bf16x8*)(kb_ + kread[s]); kf[2 * s + 1] = *(const LAS bf16x8*)(kb_ + kread[s] + 4096); }
            f32x16 S0, S1;
            if (TYPE == 2) {
#pragma unroll
                for (int r = 0; r < 16; ++r) { S0[r] = -Cl2; S1[r] = -Cl2; }
            } else if (TYPE == 0) {
                const LAS float* tb = tab + (64 * t - qpos + 448 + 4 * hh);
#pragma unroll
                for (int r = 0; r < 16; ++r) { S0[r] = tb[8 * (r >> 2) + (r & 3)]; S1[r] = tb[32 + 8 * (r >> 2) + (r & 3)]; }
            } else {
                const LAS float* tb = tab + ((t - rw + 7) * 31 - cq + 15 + 4 * hh);
                const int kc0 = 4 * hh - c0;
#pragma unroll
                for (int r = 0; r < 16; ++r) { const int ka = 8 * (r >> 2) + (r & 3), kb2 = 32 + ka;
                    S0[r] = ((unsigned)(ka + kc0) < 16u) ? tb[ka] : -1e30f; S1[r] = ((unsigned)(kb2 + kc0) < 16u) ? tb[kb2] : -1e30f; }
            }
            __builtin_amdgcn_sched_barrier(0);
#pragma unroll
            for (int s = 0; s < 4; ++s) { S0 = __builtin_amdgcn_mfma_f32_32x32x16_bf16(kf[2 * s], qf[s], S0, 0, 0, 0); S1 = __builtin_amdgcn_mfma_f32_32x32x16_bf16(kf[2 * s + 1], qf[s], S1, 0, 0, 0); }
            s16x4 vf[4][2][2];
#pragma unroll
            for (int ks = 0; ks < 2; ++ks)
#pragma unroll
                for (int db = 0; db < 2; ++db) { vf[ks][db][0] = vtr(vb_ + vread[db] + (16 * ks) * 128); vf[ks][db][1] = vtr(vb_ + vread[db] + (16 * ks + 8) * 128); }
            __builtin_amdgcn_sched_barrier(0);
#pragma unroll
            for (int r = 0; r < 16; ++r) { S0[r] = __builtin_amdgcn_exp2f(S0[r]); S1[r] = __builtin_amdgcn_exp2f(S1[r]); }
#pragma unroll
            for (int r = 0; r < 16; ++r) lsum += S0[r] + S1[r];
            bf16x8 pb[4];
#pragma unroll
            for (int hf = 0; hf < 2; ++hf) {
                v4u a, c;
#pragma unroll
                for (int j = 0; j < 4; ++j) { a[j] = cvtpk(S0[8 * hf + 2 * j], S0[8 * hf + 2 * j + 1]); c[j] = cvtpk(S1[8 * hf + 2 * j], S1[8 * hf + 2 * j + 1]); }
                pb[hf] = __builtin_bit_cast(bf16x8, a); pb[2 + hf] = __builtin_bit_cast(bf16x8, c);
            }
#pragma unroll
            for (int ks = 2; ks < 4; ++ks)
#pragma unroll
                for (int db = 0; db < 2; ++db) { vf[ks][db][0] = vtr(vb_ + vread[db] + (16 * ks) * 128); vf[ks][db][1] = vtr(vb_ + vread[db] + (16 * ks + 8) * 128); }
            __builtin_amdgcn_sched_barrier(0);
#pragma unroll
            for (int ks = 0; ks < 4; ++ks) {
                const bf16x8 va = __builtin_shufflevector(vf[ks][0][0], vf[ks][0][1], 0, 1, 2, 3, 4, 5, 6, 7), vb2 = __builtin_shufflevector(vf[ks][1][0], vf[ks][1][1], 0, 1, 2, 3, 4, 5, 6, 7);
                O0 = __builtin_amdgcn_mfma_f32_32x32x16_bf16(va, pb[ks], O0, 0, 0, 0); O1 = __builtin_amdgcn_mfma_f32_32x32x16_bf16(vb2, pb[ks], O1, 0, 0, 0);
            }
        }
        __builtin_amdgcn_sched_barrier(0);
        if (t + 1 < t_end) { *(LAS v4u*)(lds + AT_K0 + (cur ^ 1) * 8192 + kst) = kr; *(LAS v4u*)(lds + AT_V0 + (cur ^ 1) * 8192 + vst) = vr; }
        __syncthreads();
    }
    lsum += shx(lsum, 32, lane);
    if (TYPE == 0) lsum += __builtin_amdgcn_exp2f(sinkl2 - Cl2);
    const float inv = 1.f / lsum;
    {   float ss = 0.f;
#pragma unroll
        for (int r = 0; r < 16; ++r) { const float a = O0[r] * inv, c = O1[r] * inv; ss += a * a + c * c; }
        ss += shx(ss, 32, lane);
        if (hh == 0) (void)__hip_atomic_fetch_add((GAS u64_t*)(mixsq + (size_t)b * SEQ + qpos), rowsq_fx(ss), __ATOMIC_RELAXED, __HIP_MEMORY_SCOPE_AGENT); }
    bf16* op = ATT + ((size_t)b * SEQ + qpos) * DM + ocol + 4 * hh;
#pragma unroll
    for (int g4 = 0; g4 < 4; ++g4) {
        v2u o0, o1; o0.x = cvtpk(O0[4 * g4] * inv, O0[4 * g4 + 1] * inv); o0.y = cvtpk(O0[4 * g4 + 2] * inv, O0[4 * g4 + 3] * inv);
        o1.x = cvtpk(O1[4 * g4] * inv, O1[4 * g4 + 1] * inv); o1.y = cvtpk(O1[4 * g4 + 2] * inv, O1[4 * g4 + 3] * inv);
        *(GAS v2u*)(op + 8 * g4) = o0; *(GAS v2u*)(op + 32 + 8 * g4) = o1;
    }
}


constexpr int MA_K0 = 0, MA_V0 = 32768;
__device__ __forceinline__ void mem_unit(LAS unsigned char* lds, const bf16* QM, const bf16* KVM, bf16* OM, const float* gq, int tb, int head, float Cl2, int tid) {
    const int lane = tid & 63, w = __builtin_amdgcn_readfirstlane(tid >> 6), hh = lane >> 5, l31 = lane & 31;
    const size_t trow = (size_t)tb * 256 + 32 * w + l31; const int b = tb >> 3;
    bf16x8 qf[8];
    {   const bf16* qp = QM + trow * MEMW + head * 128 + 8 * hh;
#pragma unroll
        for (int s = 0; s < 8; ++s) qf[s] = *(const GAS bf16x8*)(qp + 16 * s);
        float ss = 0.f;
#pragma unroll
        for (int s = 0; s < 8; ++s)
#pragma unroll
            for (int j = 0; j < 8; ++j) { const float f = __builtin_bit_cast(float, (unsigned)(unsigned short)qf[s][j] << 16); ss += f * f; }
        ss += shx(ss, 32, lane);
        const float r = 0.12751743074602468f / sqrtf(ss * (1.f / 128.f) + EPS);
#pragma unroll
        for (int s = 0; s < 8; ++s) { const f32x4 g0 = *(const GAS f32x4*)(gq + 16 * s + 8 * hh), g1 = *(const GAS f32x4*)(gq + 16 * s + 8 * hh + 4);
            v4u o;
#pragma unroll
            for (int j = 0; j < 4; ++j) { const float f0 = __builtin_bit_cast(float, (unsigned)(unsigned short)qf[s][2 * j] << 16), f1 = __builtin_bit_cast(float, (unsigned)(unsigned short)qf[s][2 * j + 1] << 16);
                const float ga = (2 * j < 4) ? g0[2 * j] : g1[2 * j - 4], gb2 = (2 * j + 1 < 4) ? g0[2 * j + 1] : g1[2 * j + 1 - 4];
                o[j] = cvtpk(f0 * r * ga, f1 * r * gb2); }
            qf[s] = __builtin_bit_cast(bf16x8, o); }
    }
    const int srow = tid >> 3, sch = tid & 7;
    const bf16* kg = KVM + ((size_t)b * NMEM + srow) * 1024 + head * 128 + sch * 8;
    const bf16* vg = kg + 512;
    const int kst0 = srow * 256 + ((sch ^ (srow & 15)) * 16), kst1 = srow * 256 + (((sch + 8) ^ (srow & 15)) * 16);
    const int vst0 = srow * 256 + ((((sch) >> 2) ^ (srow & 3)) * 64) + (sch & 3) * 16, vst1 = srow * 256 + ((((sch + 8) >> 2) ^ (srow & 3)) * 64) + (sch & 3) * 16;
    int kread[8], vread[4];
#pragma unroll
    for (int s = 0; s < 8; ++s) kread[s] = l31 * 256 + (((2 * s + hh) ^ (l31 & 15)) * 16);
#pragma unroll
    for (int db = 0; db < 4; ++db) vread[db] = (4 * hh + ((lane >> 2) & 3)) * 256 + ((db ^ ((lane >> 2) & 3)) * 64) + 32 * ((lane >> 4) & 1) + 8 * (lane & 3);
    f32x16 O[4];
#pragma unroll
    for (int db = 0; db < 4; ++db)
#pragma unroll
        for (int r = 0; r < 16; ++r) O[db][r] = 0.f;
    float lsum = 0.f;
    {   const v4u k0 = *(const GAS v4u*)kg, k1 = *(const GAS v4u*)(kg + 64), v0 = *(const GAS v4u*)vg, v1 = *(const GAS v4u*)(vg + 64);
        *(LAS v4u*)(lds + MA_K0 + kst0) = k0; *(LAS v4u*)(lds + MA_K0 + kst1) = k1; *(LAS v4u*)(lds + MA_V0 + vst0) = v0; *(LAS v4u*)(lds + MA_V0 + vst1) = v1; }
    __syncthreads();
#pragma unroll 1
    for (int t = 0; t < 4; ++t) {
        const int cur = t & 1;
        v4u k0, k1, v0, v1;
        if (t + 1 < 4) { const bf16* kn = kg + (size_t)(t + 1) * 64 * 1024; k0 = *(const GAS v4u*)kn; k1 = *(const GAS v4u*)(kn + 64); v0 = *(const GAS v4u*)(kn + 512); v1 = *(const GAS v4u*)(kn + 576); }
        const lds_cptr kb_ = (lds_cptr)(lds + MA_K0 + cur * 16384), vb_ = (lds_cptr)(lds + MA_V0 + cur * 16384);
        f32x16 S0, S1;
#pragma unroll
        for (int r = 0; r < 16; ++r) { S0[r] = -Cl2; S1[r] = -Cl2; }
#pragma unroll
        for (int s = 0; s < 8; ++s) { const bf16x8 a0 = *(const LAS bf16x8*)(kb_ + kread[s]), a1 = *(const LAS bf16x8*)(kb_ + kread[s] + 8192);
            S0 = __builtin_amdgcn_mfma_f32_32x32x16_bf16(a0, qf[s], S0, 0, 0, 0); S1 = __builtin_amdgcn_mfma_f32_32x32x16_bf16(a1, qf[s], S1, 0, 0, 0); }
#pragma unroll
        for (int r = 0; r < 16; ++r) { S0[r] = __builtin_amdgcn_exp2f(S0[r]); S1[r] = __builtin_amdgcn_exp2f(S1[r]); lsum += S0[r] + S1[r]; }
        bf16x8 pb[4];
#pragma unroll
        for (int hf = 0; hf < 2; ++hf) {
            v4u a, c;
#pragma unroll
            for (int j = 0; j < 4; ++j) { a[j] = cvtpk(S0[8 * hf + 2 * j], S0[8 * hf + 2 * j + 1]); c[j] = cvtpk(S1[8 * hf + 2 * j], S1[8 * hf + 2 * j + 1]); }
            pb[hf] = __builtin_bit_cast(bf16x8, a); pb[2 + hf] = __builtin_bit_cast(bf16x8, c);
        }
#pragma unroll
        for (int ks = 0; ks < 4; ++ks)
#pragma unroll
            for (int db = 0; db < 4; ++db) {
                const s16x4 a0 = vtr(vb_ + vread[db] + (16 * ks) * 256), a1 = vtr(vb_ + vread[db] + (16 * ks + 8) * 256);
                const bf16x8 va = __builtin_shufflevector(a0, a1, 0, 1, 2, 3, 4, 5, 6, 7);
                O[db] = __builtin_amdgcn_mfma_f32_32x32x16_bf16(va, pb[ks], O[db], 0, 0, 0);
            }
        if (t + 1 < 4) { LAS unsigned char* kn = lds + MA_K0 + (cur ^ 1) * 16384; LAS unsigned char* vn = lds + MA_V0 + (cur ^ 1) * 16384;
            *(LAS v4u*)(kn + kst0) = k0; *(LAS v4u*)(kn + kst1) = k1; *(LAS v4u*)(vn + vst0) = v0; *(LAS v4u*)(vn + vst1) = v1; }
        __syncthreads();
    }
    lsum += shx(lsum, 32, lane);
    const float inv = 1.f / lsum;
    bf16* op = OM + trow * MEMW + head * 128 + 4 * hh;
#pragma unroll
    for (int db = 0; db < 4; ++db)
#pragma unroll
        for (int g4 = 0; g4 < 4; ++g4) { v2u o; o.x = cvtpk(O[db][4 * g4] * inv, O[db][4 * g4 + 1] * inv); o.y = cvtpk(O[db][4 * g4 + 2] * inv, O[db][4 * g4 + 3] * inv); *(GAS v2u*)(op + 32 * db + 8 * g4) = o; }
}

__device__ __forceinline__ float wave_max(float v, int lane) {
#pragma unroll
    for (int o = 1; o < 64; o <<= 1) v = fmaxf(v, shx(v, o, lane));
    return v;
}
struct Args { const float* in[23]; float* out; unsigned char* ws; int ph_lo, ph_hi, use_bar, pad; };
#ifndef MK_OFF
#define MK_OFF 0u
#endif
#ifndef REP_ATT
#define REP_ATT 1
#endif
#ifndef REP_P0
#define REP_P0 1
#endif
#ifndef REP_U
#define REP_U 1
#endif
#ifndef REP_GEMM
#define REP_GEMM 1
#endif
#ifndef REP_NORM
#define REP_NORM 1
#endif
#ifndef REP_SEL
#define REP_SEL 1
#endif
#ifndef REP_MEM
#define REP_MEM 1
#endif
#define PHON(k) (!((MK_OFF >> (k)) & 1u))
constexpr int PH_PER_LAYER = 8, PH_BASE = 2, N_PHASES = PH_BASE + DEPTH * PH_PER_LAYER;
constexpr int PTAB_OFF = LDSCTL_OFF + 1024;

__global__ void __launch_bounds__(NTHREADS, 2) mega(Args a) {
    extern __shared__ __attribute__((aligned(16))) unsigned char lds_raw[];
    LAS unsigned char* lds = (LAS unsigned char*)lds_raw;
    {   const int tid0 = threadIdx.x;
        for (int u = tid0; u < (LDS_BYTES - LDSCTL_OFF) / 4; u += NTHREADS) ((LAS unsigned*)(lds + LDSCTL_OFF))[u] = 0u;
        __syncthreads();
        if (tid0 < 23) ((LAS unsigned long long*)(lds + PTAB_OFF))[tid0] = (unsigned long long)a.in[tid0];
        if (tid0 == 23) ((LAS unsigned long long*)(lds + PTAB_OFF))[23] = (unsigned long long)a.out;
        if (tid0 == 24) ((LAS unsigned long long*)(lds + PTAB_OFF))[24] = (unsigned long long)a.ws;
        __syncthreads();
    }
    volatile LAS unsigned* MISC = (volatile LAS unsigned*)(lds + MISC_OFF);
    const int G = gridDim.x, bid = blockIdx.x, NGW = G * NWAVES;
    const int use_bar = a.use_bar;
    XcdBarrier bar; bar.bar = (unsigned*)(a.ws + WS_CTL) + CW_BAR; bar.x = 0; bar.st = MISC + 8;
    if (use_bar) bar = xcd_barrier_post((unsigned*)(a.ws + WS_CTL) + CW_BAR, MISC + 8);
    const int lo = a.ph_lo, hi = a.ph_hi;
#define IN(k) (lo <= (k) && (k) < hi)
#define SEAM(k) do { if (use_bar && IN(k) && IN((k) + 1)) xcd_barrier(bar); } while (0)
#define PHL() int tid_ = threadIdx.x; asm volatile("" : "+v"(tid_)); const int lane_ = tid_ & 63, wave_ = __builtin_amdgcn_readfirstlane(tid_ >> 6), gw_ = bid * NWAVES + wave_; (void)lane_; (void)gw_; \
              int pz_ = 0; asm volatile("" : "+s"(pz_))
#define PTR(i) ((const float*)ldptr(lds, (i) + pz_))
#define WSP() ((unsigned char*)ldptr(lds, 24 + pz_))
#define OUTP() ((float*)ldptr(lds, 23 + pz_))

    if (IN(0) && PHON(0)) {
        PHL(); unsigned char* ws = WSP();
        LAS float* scr = (LAS float*)(lds + RING_OFF + wave_ * 16384);
        constexpr int I_IN = 32 * 128, I_OUT = 32 * 64, I_MQ = 32 * 16, I_MKV = 32 * 32, I_MO = 8 * 64, I_PQ = 32 * 64, I_L = I_IN + I_OUT + I_MQ + I_MKV + I_MO + I_PQ;
        for (int it = gw_; it < DEPTH * I_L; it += NGW) {
            const int l = it / I_L; int r = it % I_L;
            if (r < I_IN) { transpose_item<true>(PTR(4) + (size_t)l * DM * DIN, DM, DIN, (bf16*)(ws + WS_WIN) + (size_t)l * DIN * DM, scr, r, lane_, PTR(3) + (size_t)l * DM); continue; } r -= I_IN;
            if (r < I_OUT) { transpose_item<false>(PTR(11) + (size_t)l * DM * DM, DM, DM, (bf16*)(ws + WS_WOUT) + (size_t)l * DM * DM, scr, r, lane_, PTR(10) + (size_t)l * DM); continue; } r -= I_OUT;
            if (r < I_MQ) { transpose_item<false>(PTR(14) + (size_t)l * DM * MEMW, DM, MEMW, (bf16*)(ws + WS_WMQ) + (size_t)l * MEMW * DM, scr, r, lane_, PTR(12) + (size_t)l * DM); continue; } r -= I_MQ;
            if (r < I_MKV) { transpose_item<false>(PTR(15) + (size_t)l * DM * 1024, DM, 1024, (bf16*)(ws + WS_WMKV) + (size_t)l * 1024 * DM, scr, r, lane_); continue; } r -= I_MKV;
            if (r < I_MO) { transpose_item<false>(PTR(17) + (size_t)l * MEMW * DM, MEMW, DM, (bf16*)(ws + WS_WMO) + (size_t)l * DM * MEMW, scr, r, lane_); continue; } r -= I_MO;
            transpose_item<false>(PTR(19) + (size_t)l * DM * DM, DM, DM, (bf16*)(ws + WS_WPQ) + (size_t)l * DM * DM, scr, r, lane_, PTR(18) + (size_t)l * DM);
        }
        const size_t gtid = (size_t)bid * NTHREADS + tid_, nth = (size_t)G * NTHREADS;
        convert_bf16(PTR(20), (bf16*)(ws + WS_PKEYS), (size_t)DEPTH * 8 * 2 * 128 * 128, gtid, nth);
        convert_int4_plain(PTR(21), ws + WS_PU, DEPTH * PEER_N, PU_SCALEI, PTR(18), gw_, NGW, lane_);
        convert_fp4_rows(PTR(22), ws + WS_PV, DEPTH * PEER_N, PV_SCALE4, nullptr, gw_, NGW, lane_);
        {   const float* x0 = PTR(0); bf16* XN = (bf16*)(ws + WS_XN); u64_t* rsq = (u64_t*)(ws + WS_ROWSQ);
            for (int m = 2 * gw_; m < T; m += 2 * NGW) prep_rows2(x0 + (size_t)m * DM, XN + (size_t)m * DM, rsq + m, lane_); }
        {   const float* mem = PTR(1); const float* gkv = PTR(13); bf16* MEMN = (bf16*)(ws + WS_MEMN);
            for (int m = gw_; m < BATCH * NMEM; m += NGW)
                rms_row_to_bf16(mem + (size_t)m * DM, gkv, MEMN + (size_t)m * DM, gkv + DM, MEMN + (size_t)(BATCH * NMEM + m) * DM, lane_); }
        float* rope = (float*)(ws + WS_ROPE); float* biasA = (float*)(ws + WS_BIASA);
        if (gtid < 64 * 16) { const int pos = (int)gtid >> 4, i = (int)gtid & 15; const float ang = (float)pos * ROPE_INV[i]; rope[gtid * 2] = cosf(ang); rope[gtid * 2 + 1] = sinf(ang); }
        if (gtid < 12 * 257) { const int h = (int)gtid / 257, rel = (int)gtid % 257 - 128; biasA[gtid] = PTR(2)[t5_bucket(rel) * 12 + h]; }
    }
    SEAM(0);
    if (IN(1) && PHON(1)) {
#pragma unroll 1
        for (int l = 0; l < DEPTH; ++l) {
            PHL(); unsigned char* ws = WSP();
            pg8::Gemm g{(bf16*)(ws + WS_MEMN) + (size_t)l * BATCH * NMEM * DM, (bf16*)(ws + WS_WMKV) + (size_t)l * 1024 * DM, BATCH * NMEM, 1024, DM};
            OffsetOrder S; S.init(BATCH * NMEM, 1024, G, bid, 64 * l);
            bf16* KVMl = (bf16*)(ws + WS_KVM) + (size_t)l * BATCH * NMEM * 1024;
            pg8::EpiBf16<0> E{KVMl, 1024, nullptr, 0, 0, 1.f};
            pg8::gemm_phase<pg8::EpiBf16<0>, OffsetOrder, true, true>(lds + RING_OFF, g, S, E, tid_);
            VM_WAIT(); __syncthreads();
            const float* gk = PTR(16) + (size_t)l * 256 + 128;
#pragma unroll 1
            for (int i = 0; i < 4; ++i) { pg8::Unit uu; uu.pm = 0; uu.pn = 0; if (!S.next(i, uu)) break;
                if (uu.pn < 2) {
                    for (int r2 = wave_; r2 < 128; r2 += NWAVES) { const int row = uu.pm * 256 + 2 * r2 + (lane_ >> 5), cl = lane_ & 31;
                        GAS v4u* p = (GAS v4u*)(KVMl + (size_t)row * 1024 + 256 * uu.pn + 8 * cl);
                        const v4u w = *p;
                        float f[8] = {bflo(w.x), bfhi(w.x), bflo(w.y), bfhi(w.y), bflo(w.z), bfhi(w.z), bflo(w.w), bfhi(w.w)};
                        float ss = 0.f;
#pragma unroll
                        for (int e = 0; e < 8; ++e) ss += f[e] * f[e];
                        ss += shx(ss, 1, lane_); ss += shx(ss, 2, lane_); ss += shx(ss, 4, lane_); ss += shx(ss, 8, lane_);
                        const float r = 1.f / sqrtf(ss * (1.f / 128.f) + EPS);
                        const float* gg = gk + 8 * (cl & 15);
                        v4u o; o.x = pk2(f[0] * r * gg[0], f[1] * r * gg[1]); o.y = pk2(f[2] * r * gg[2], f[3] * r * gg[3]); o.z = pk2(f[4] * r * gg[4], f[5] * r * gg[5]); o.w = pk2(f[6] * r * gg[6], f[7] * r * gg[7]);
                        *p = o; } } }
            __syncthreads();
        }
    }
    SEAM(1);

#pragma unroll 1
    for (int l = 0; l < DEPTH; ++l) {
        const int pb = PH_BASE + PH_PER_LAYER * l;
        if (IN(pb + 0) && PHON(3)) { PHL(); unsigned char* ws = WSP();
            pg8::Gemm g{(bf16*)(ws + WS_XN), (bf16*)(ws + WS_WIN) + (size_t)l * DIN * DM, T, DIN, DM}; pg8::StaticOrder S; S.init(T, DIN, G, bid);
            pg8::EpiQKV E{(bf16*)(ws + WS_QKV), PTR(5) + (size_t)l * 128, PTR(7) + (size_t)l * 128, PTR(9) + (size_t)l * 128, (const float*)(ws + WS_ROPE), (const u64_t*)(ws + WS_ROWSQ) + (size_t)(l * 3 + 0) * T};
            pg8::gemm_phase<pg8::EpiQKV, pg8::StaticOrder, true, true>(lds + RING_OFF, g, S, E, tid_);
        }
        SEAM(pb + 0);
        if (IN(pb + 1) && PHON(4)) { PHL(); unsigned char* ws = WSP();
            const float* sink = PTR(6) + (size_t)l * 12; const float* rpb = PTR(8) + (size_t)l * 8 * 15 * 31; const float* biasA = (const float*)(ws + WS_BIASA);
            const bf16* QKV = (const bf16*)(ws + WS_QKV); bf16* ATT = (bf16*)(ws + WS_ATT);
            const float* ga = PTR(5) + (size_t)l * 128; const float* gb = PTR(7) + (size_t)l * 128; const float* gc = PTR(9) + (size_t)l * 128;
            const float CaL2 = 8.f * wave_max(fabsf(ga[lane_]), lane_) * wave_max(fabsf(ga[64 + lane_]), lane_) * LOG2E;
            const float CbL2 = 8.f * wave_max(fabsf(gb[lane_]), lane_) * wave_max(fabsf(gb[64 + lane_]), lane_) * LOG2E;
            const float CcL2 = 8.f * wave_max(fabsf(gc[lane_]), lane_) * wave_max(fabsf(gc[64 + lane_]), lane_) * LOG2E;
            const int vc = (G % 8 == 0) ? (bid % 8) * (G / 8) + bid / 8 : bid;
            u64_t* mixsq = (u64_t*)(ws + WS_MIXSQ) + (size_t)l * 3 * T;
            for (int u = vc; u < BATCH * 12 * 8; u += G) attn_unit<2>(lds, QKV, ATT, mixsq + 2 * (size_t)T, u / 96, (u >> 3) % 12, u & 7, nullptr, CcL2, 0.f, tid_);
            for (int u = vc; u < BATCH * 8 * 8; u += G) attn_unit<1>(lds, QKV, ATT, mixsq + (size_t)T, u >> 6, (u >> 3) & 7, u & 7, rpb, CbL2, 0.f, tid_);
            for (int u = vc; u < BATCH * 12 * 8; u += G) { const int head = (u >> 3) % 12; attn_unit<0>(lds, QKV, ATT, mixsq, u / 96, head, u & 7, biasA, CaL2, sink[head] * LOG2E, tid_); }
        }
        SEAM(pb + 1);
        if (IN(pb + 2) && PHON(5)) { PHL(); unsigned char* ws = WSP();
            pg8::Gemm g{(bf16*)(ws + WS_ATT), (bf16*)(ws + WS_WOUT) + (size_t)l * DM * DM, T, DM, DM}; pg8::StaticOrder S; S.init(T, DM, G, bid);
            LAS float* ftab = (LAS float*)(lds + LDSCTL_OFF + 2048); LAS int* pmtab = (LAS int*)(lds + LDSCTL_OFF + 1536);
            {   const u64_t* mixsq = (const u64_t*)(ws + WS_MIXSQ) + (size_t)l * 3 * T;
#pragma unroll
                for (int i = 0; i < 4; ++i) { pg8::Unit uu; uu.pm = -1; uu.pn = 0; const bool ok = S.next(i, uu); if (tid_ == 0) pmtab[i] = ok ? uu.pm : -1;
                    if (ok && tid_ < 256) { const size_t row = (size_t)uu.pm * 256 + tid_;
                        const float ra = 1.0f / sqrtf((float)*(const GAS u64_t*)(mixsq + row) * (5.9604644775390625e-08f / 768.0f) + EPS), rb = 1.0f / sqrtf((float)*(const GAS u64_t*)(mixsq + T + row) * (5.9604644775390625e-08f / 512.0f) + EPS),
                                    rc = 1.0f / sqrtf((float)*(const GAS u64_t*)(mixsq + 2 * (size_t)T + row) * (5.9604644775390625e-08f / 768.0f) + EPS);
                        ftab[i * 256 + tid_] = ra / rb; ftab[1024 + i * 256 + tid_] = rb / rc; ftab[2048 + i * 256 + tid_] = rc; } }
                __syncthreads(); }
            pg8::EpiResidMix E{(bf16*)(ws + WS_XN), DM, (u64_t*)(ws + WS_ROWSQ) + (size_t)(l * 3 + 1) * T, ftab, pmtab};
            pg8::gemm_phase<pg8::EpiResidMix, pg8::StaticOrder, true, true>(lds + RING_OFF, g, S, E, tid_);
        }
        SEAM(pb + 2);
        if (IN(pb + 3) && PHON(6)) { PHL(); unsigned char* ws = WSP();
            pg8::Gemm g{(bf16*)(ws + WS_XN), (bf16*)(ws + WS_WMQ) + (size_t)l * MEMW * DM, T, MEMW, DM}; pg8::StaticOrder S; S.init(T, MEMW, G, bid);
            pg8::EpiBf16Row E{(bf16*)(ws + WS_QM), MEMW, (const u64_t*)(ws + WS_ROWSQ) + (size_t)(l * 3 + 1) * T};
            pg8::gemm_phase<pg8::EpiBf16Row, pg8::StaticOrder, true, true>(lds + RING_OFF, g, S, E, tid_);
            VM_WAIT(); __syncthreads();
            const bf16* kvm = (const bf16*)(ws + WS_KVM) + (size_t)l * BATCH * NMEM * 1024; const float* gq = PTR(16) + (size_t)l * 256;
            const float CmL2 = 11.313708498984761f * wave_max(fmaxf(fabsf(gq[lane_]), fabsf(gq[64 + lane_])), lane_) * wave_max(fmaxf(fabsf(gq[128 + lane_]), fabsf(gq[192 + lane_])), lane_) * LOG2E;
#pragma unroll 1
            for (int i = 0; i < 4; ++i) { pg8::Unit uu; uu.pm = 0; uu.pn = 0; if (!S.next(i, uu)) break;
                mem_unit(lds, (const bf16*)(ws + WS_QM), kvm, (bf16*)(ws + WS_OM), gq, uu.pm, 2 * uu.pn, CmL2, tid_);
                mem_unit(lds, (const bf16*)(ws + WS_QM), kvm, (bf16*)(ws + WS_OM), gq, uu.pm, 2 * uu.pn + 1, CmL2, tid_); }
        }
        SEAM(pb + 3);
        if (IN(pb + 4) && PHON(7)) { PHL(); unsigned char* ws = WSP();
            pg8::Gemm g{(bf16*)(ws + WS_OM), (bf16*)(ws + WS_WMO) + (size_t)l * DM * MEMW, T, DM, MEMW}; pg8::StaticOrder S; S.init(T, DM, G, bid);
            pg8::EpiResid E{(bf16*)(ws + WS_XN), DM, (u64_t*)(ws + WS_ROWSQ) + (size_t)(l * 3 + 2) * T};
            pg8::gemm_phase<pg8::EpiResid, pg8::StaticOrder, true, true>(lds + RING_OFF, g, S, E, tid_);
        }
        SEAM(pb + 4);
        if (IN(pb + 5) && PHON(8)) { PHL(); unsigned char* ws = WSP();
            pg8::Gemm g{(bf16*)(ws + WS_XN), (bf16*)(ws + WS_WPQ) + (size_t)l * DM * DM, T, DM, DM}; pg8::StaticOrder S; S.init(T, DM, G, bid);
            pg8::EpiBf16Row E{(bf16*)(ws + WS_QP), DM, (const u64_t*)(ws + WS_ROWSQ) + (size_t)(l * 3 + 2) * T};
            pg8::gemm_phase<pg8::EpiBf16Row, pg8::StaticOrder, true, true>(lds + RING_OFF, g, S, E, tid_);
            VM_WAIT(); __syncthreads();
            const bf16* pk = (const bf16*)(ws + WS_PKEYS) + (size_t)l * 8 * 2 * 128 * 128;
#pragma unroll 1
            for (int i = 0; i < 8; ++i) { pg8::Unit uu; uu.pm = 0; uu.pn = 0; if (!S.next(i, uu)) break;
                peer_select_unit((const bf16*)(ws + WS_QP), pk, (int*)(ws + WS_PIDX), (float*)(ws + WS_PGATE), uu.pm, uu.pn, wave_, lane_);
                peer_xquant_unit((const bf16*)(ws + WS_XN), (const u64_t*)(ws + WS_ROWSQ) + (size_t)(l * 3 + 2) * T, (unsigned*)(ws + WS_XQH), (unsigned*)(ws + WS_XQL), uu.pm, uu.pn, tid_); }
        }
        SEAM(pb + 5);
        if (IN(pb + 6) && PHON(9)) { PHL(); unsigned char* ws = WSP();
            peer_u_phase_i4((const unsigned*)(ws + WS_XQH), (const unsigned*)(ws + WS_XQL), ws + WS_PU + (size_t)l * PEER_N * 1024, (const int*)(ws + WS_PIDX), (int*)(ws + WS_PARTI), bid, G, wave_, lane_); }
        SEAM(pb + 6);
        if (IN(pb + 7) && PHON(10)) { PHL(); unsigned char* ws = WSP();
            peer_v_pass((bf16*)(ws + WS_XN), ws + WS_PV + (size_t)l * PEER_N * 1024, (const int*)(ws + WS_PIDX), (const float*)(ws + WS_PGATE), (const int*)(ws + WS_PARTI), (l + 1 == DEPTH) ? OUTP() : (float*)nullptr,
                        (l + 1 < DEPTH) ? (u64_t*)(ws + WS_ROWSQ) + (size_t)((l + 1) * 3 + 0) * T : (u64_t*)nullptr, (LAS float*)(lds + RING_OFF + wave_ * 1024), gw_, NGW, lane_); }
        SEAM(pb + 7);
    }
#undef IN
#undef SEAM
}

#ifndef MK_MULTI_LAUNCH
#define MK_MULTI_LAUNCH 0
#endif
extern "C" void kernel_launch(void* const* d_in, const int* in_sizes, int n_in, void* d_out, int out_size, void* d_ws, size_t ws_size, hipStream_t stream) {
    static int grid = 0;
    if (grid == 0) {
        if (n_in != 23 || out_size != T * DM || ws_size < WS_END) { fprintf(stderr, "kernel_launch: unexpected shapes (n_in %d, out %d, ws %zu)\n", n_in, out_size, ws_size); grid = -1; return; }
        int dev = 0, cus = 0, per_cu = 0;
        if (hipGetDevice(&dev) != hipSuccess || hipDeviceGetAttribute(&cus, hipDeviceAttributeMultiprocessorCount, dev) != hipSuccess) { grid = -1; return; }
        if (hipFuncSetAttribute((const void*)mega, hipFuncAttributeMaxDynamicSharedMemorySize, LDS_BYTES) != hipSuccess) { fprintf(stderr, "kernel_launch: hipFuncSetAttribute failed\n"); grid = -1; return; }
        if (hipOccupancyMaxActiveBlocksPerMultiprocessor(&per_cu, (const void*)mega, NTHREADS, LDS_BYTES) != hipSuccess || per_cu < 1) { fprintf(stderr, "kernel_launch: occupancy query says %d\n", per_cu); }
        (void)hipGetLastError();
        grid = cus;
    }
    if (grid < 0) return;
    (void)hipMemsetAsync((char*)d_ws + WS_CTL, 0, CTL_ZERO_BYTES, stream);
    (void)hipMemsetAsync((char*)d_ws + WS_MIXSQ, 0, MIXSQ_BYTES, stream);
    Args a{};
    for (int i = 0; i < 23; ++i) a.in[i] = (const float*)d_in[i];
    a.out = (float*)d_out; a.ws = (unsigned char*)d_ws;
#if MK_MULTI_LAUNCH
    for (int p = 0; p < N_PHASES; ++p) { a.ph_lo = p; a.ph_hi = p + 1; a.use_bar = 0; a.pad = 0; hipLaunchKernelGGL(mega, dim3(grid), dim3(NTHREADS), LDS_BYTES, stream, a); }
#else
    a.ph_lo = 0; a.ph_hi = N_PHASES; a.use_bar = 1; a.pad = 0;
    hipLaunchKernelGGL(mega, dim3(grid), dim3(NTHREADS), LDS_BYTES, stream, a);
#endif
    const hipError_t le = hipPeekAtLastError();
    if (le != hipSuccess) fprintf(stderr, "kernel_launch: launch failed: %s\n", hipGetErrorName(le));
}
```

```cpp
#include <hip/hip_runtime.h>
#include <cstdio>
#include <cstdint>
#include <cmath>
__device__ __forceinline__ float shx(float v, int k, int lane);
typedef unsigned long long u64_t;
__device__ __forceinline__ float rowsq_rs(const u64_t* rowsq, int row) { return 1.0f / sqrtf((float)*(const __attribute__((address_space(1))) u64_t*)(rowsq + row) * (5.9604644775390625e-08f / 2048.0f) + 1e-6f); }
__device__ __forceinline__ u64_t rowsq_fx(float ss) { return (u64_t)(ss * 16777216.0f + 0.5f); }
namespace pg8 {
#define PG8_LAS __attribute__((address_space(3)))
#define PG8_GAS __attribute__((address_space(1)))
typedef unsigned short bf16_t;
typedef short bf16x8 __attribute__((ext_vector_type(8)));
typedef float f32x4 __attribute__((ext_vector_type(4)));
typedef unsigned u32x4 __attribute__((ext_vector_type(4)));
constexpr int BM = 256, BK = 64, HALF = 128, HTB = HALF * BK * 2  , STAGE_BYTES = 8 * HTB, NXCD = 8, WGM = 8;

__host__ __device__ __forceinline__ int lds_byte(int r, int c) { const int st = (r >> 4) * 2 + (c >> 5), rr = r & 15, cc = c & 31, ob = rr * 64 + cc * 2; return st * 1024 + (ob ^ (((ob >> 9) & 1) << 5)); }
__host__ __device__ __forceinline__ void stage_rc(int b, int& R, int& C) { const int st = b / 1024, sb = b % 1024, swz = sb ^ (((sb >> 9) & 1) << 5); R = (st >> 1) * 16 + swz / 64; C = (st & 1) * 32 + (swz % 64) / 2; }
__host__ __device__ __forceinline__ int perm32(int rho) { const int n = rho >> 4, i = rho & 15; return 8 * (i >> 2) + 4 * n + (i & 3); }

struct Unit { int pm, pn; };
struct Gemm { const bf16_t* A; const bf16_t* Bt; int M, N, K; };

struct StaticOrder {
    int nM, nN, nwg, G, c;
    __host__ __device__ __forceinline__ void init(int M, int N, int G_, int c_) { nM = M / BM; nN = N / BM; nwg = nM * nN; G = G_; c = c_; }
    __host__ __device__ __forceinline__ bool next(int i, Unit& u) const {
        const long L = (long)i * G + c; if (L >= nwg) return false;
        int wgid = (int)L; { const int q = nwg / NXCD, r = nwg % NXCD, xcd = wgid % NXCD, off = wgid / NXCD; wgid = (xcd < r ? xcd * (q + 1) : r * (q + 1) + (xcd - r) * q) + off; }
        const int nig = WGM * nN, gid = wgid / nig, fm = gid * WGM, gsz = (nM - fm) < WGM ? (nM - fm) : WGM;
        u.pm = fm + ((wgid % nig) % gsz); u.pn = (wgid % nig) / gsz; return true;
    }
    __device__ __forceinline__ void a_ready(const Unit&) const {}
    __device__ __forceinline__ void done(const Unit&) const {}
};

__device__ __forceinline__ unsigned cvt_pk_bf16(float lo, float hi) { unsigned r; asm volatile("v_cvt_pk_bf16_f32 %0, %1, %2" : "=v"(r) : "v"(lo), "v"(hi)); return r; }
typedef float f32x2 __attribute__((ext_vector_type(2)));
__device__ __forceinline__ f32x2 gelu_pk(f32x2 v) {
    const f32x2 av = __builtin_elementwise_abs(v), d = av * 0.2316418882f + 1.0f;
    f32x2 t; t.x = __builtin_amdgcn_rcpf(d.x); t.y = __builtin_amdgcn_rcpf(d.y);
    f32x2 q = t * 0.5307027145f + (-0.7265760135f); q = q * t + 0.7107068705f; q = q * t + (-0.142248368f); q = q * t + 0.127414796f; q = q * t;
    const f32x2 s = (v * v) * (-0.72134752044f);
    f32x2 e; e.x = __builtin_amdgcn_exp2f(s.x); e.y = __builtin_amdgcn_exp2f(s.y);
    const f32x2 m = v * (q * e), r = v - m;
    f32x2 o; o.x = v.x < 0.f ? m.x : r.x; o.y = v.y < 0.f ? m.y : r.y; return o;
}

template <int ACT  > struct EpiBf16 {
    static constexpr bool PERM = true, AFTER_DRAIN = false, KSCALE = false; static_assert(ACT == 0 || ACT == 1, "EpiBf16: ACT is 0 (none) or 1 (gelu_pk)");
    bf16_t* O; int ldc; const float* bias; int split_cols; size_t split_stride; float scale0;
    __device__ __forceinline__ void operator()(const f32x4 (&acc)[2][2][4][2], const Unit& u, int wr, int wc, int fr, int fq) const {
        const int row0 = u.pm * BM + wr * 64 + fr; int colt = u.pn * BM; bf16_t* base = O;
        float sc = 1.f; if (split_cols) { const int t = colt / split_cols; base += (size_t)t * split_stride; colt -= t * split_cols; if (t == 0) sc = scale0; }
        const int col0 = colt + wc * 32 + 8 * fq, bcol0 = u.pn * BM + wc * 32 + 8 * fq;
        f32x4 bv[2][2];
#pragma unroll
        for (int bj = 0; bj < 2; ++bj)
#pragma unroll
            for (int n = 0; n < 2; ++n) bv[bj][n] = bias ? *(const PG8_GAS f32x4*)(bias + bcol0 + bj * HALF + 4 * n) : (f32x4){0.f, 0.f, 0.f, 0.f};
#pragma unroll
        for (int ai = 0; ai < 2; ++ai)
#pragma unroll
            for (int m = 0; m < 4; ++m) { bf16_t* rowp = base + (size_t)(row0 + ai * HALF + m * 16) * ldc + col0;
#pragma unroll
                for (int bj = 0; bj < 2; ++bj) { f32x4 v0 = acc[ai][bj][m][0] + bv[bj][0], v1 = acc[ai][bj][m][1] + bv[bj][1];
                    if (ACT == 1) { f32x2 a = gelu_pk((f32x2){v0[0], v0[1]}), b = gelu_pk((f32x2){v0[2], v0[3]}), c = gelu_pk((f32x2){v1[0], v1[1]}), d = gelu_pk((f32x2){v1[2], v1[3]});
                        v0 = (f32x4){a.x, a.y, b.x, b.y}; v1 = (f32x4){c.x, c.y, d.x, d.y}; }
                    v0 = v0 * sc; v1 = v1 * sc; u32x4 w; w.x = cvt_pk_bf16(v0[0], v0[1]); w.y = cvt_pk_bf16(v0[2], v0[3]); w.z = cvt_pk_bf16(v1[0], v1[1]); w.w = cvt_pk_bf16(v1[2], v1[3]);
                    *(PG8_GAS u32x4*)(rowp + bj * HALF) = w; } }
    }
};

typedef unsigned u32x2 __attribute__((ext_vector_type(2)));
struct EpiResid {
    static constexpr bool PERM = false, AFTER_DRAIN = false, KSCALE = false;
    bf16_t* s; int ldc; u64_t* rowsq;
    __device__ __forceinline__ void operator()(const f32x4 (&acc)[2][2][4][2], const Unit& u, int wr, int wc, int fr, int fq) const {
        const int col0 = u.pn * BM + wc * 32 + 4 * fq;
#pragma unroll
        for (int ai = 0; ai < 2; ++ai)
#pragma unroll
            for (int m = 0; m < 4; ++m) { const int row = u.pm * BM + ai * HALF + wr * 64 + m * 16 + fr; bf16_t* sp = s + (size_t)row * ldc + col0; float ss = 0.f;
                u32x2 in[2][2];
#pragma unroll
                for (int bj = 0; bj < 2; ++bj)
#pragma unroll
                    for (int n = 0; n < 2; ++n) in[bj][n] = *(const PG8_GAS u32x2*)(sp + bj * HALF + n * 16);
#pragma unroll
                for (int bj = 0; bj < 2; ++bj)
#pragma unroll
                    for (int n = 0; n < 2; ++n) { const u32x2 w0 = in[bj][n];
                        const f32x4 bs = (f32x4){__builtin_bit_cast(float, w0.x << 16), __builtin_bit_cast(float, w0.x & 0xffff0000u), __builtin_bit_cast(float, w0.y << 16), __builtin_bit_cast(float, w0.y & 0xffff0000u)};
                        const f32x4 o = bs + acc[ai][bj][m][n]; ss += (o[0] * o[0] + o[1] * o[1]) + (o[2] * o[2] + o[3] * o[3]);
                        u32x2 w; w.x = cvt_pk_bf16(o[0], o[1]); w.y = cvt_pk_bf16(o[2], o[3]); *(PG8_GAS u32x2*)(sp + bj * HALF + n * 16) = w; }
                ss += shx(ss, 16, fr + 16 * fq); ss += shx(ss, 32, fr + 16 * fq);
                if (fq == 0) (void)__hip_atomic_fetch_add((PG8_GAS u64_t*)(rowsq + row), rowsq_fx(ss), __ATOMIC_RELAXED, __HIP_MEMORY_SCOPE_AGENT); }
    }
};
struct EpiResidMix {
    static constexpr bool PERM = false, AFTER_DRAIN = false, KSCALE = true; static constexpr int KS0 = 12, KS1 = 20;
    bf16_t* s; int ldc; u64_t* rowsq; const PG8_LAS float* ftab; const PG8_LAS int* pmtab;
    __device__ __forceinline__ int slot(int pm) const { return pmtab[0] == pm ? 0 : (pmtab[1] == pm ? 1 : (pmtab[2] == pm ? 2 : 3)); }
    __device__ __forceinline__ void kscale(f32x4 (&acc)[2][2][4][2], const Unit& u, int which, int wr, int fr) const {
        const PG8_LAS float* ft = ftab + which * 1024 + slot(u.pm) * 256;
#pragma unroll
        for (int ai = 0; ai < 2; ++ai)
#pragma unroll
            for (int m = 0; m < 4; ++m) { const float f = ft[ai * HALF + wr * 64 + m * 16 + fr];
#pragma unroll
                for (int bj = 0; bj < 2; ++bj)
#pragma unroll
                    for (int n = 0; n < 2; ++n) acc[ai][bj][m][n] = acc[ai][bj][m][n] * f; }
    }
    __device__ __forceinline__ void operator()(const f32x4 (&acc)[2][2][4][2], const Unit& u, int wr, int wc, int fr, int fq) const {
        const int col0 = u.pn * BM + wc * 32 + 4 * fq;
#pragma unroll
        for (int ai = 0; ai < 2; ++ai)
#pragma unroll
            for (int m = 0; m < 4; ++m) { const int row = u.pm * BM + ai * HALF + wr * 64 + m * 16 + fr; bf16_t* sp = s + (size_t)row * ldc + col0; float ss = 0.f; const float rc = ftab[2048 + slot(u.pm) * 256 + ai * HALF + wr * 64 + m * 16 + fr];
                u32x2 in[2][2];
#pragma unroll
                for (int bj = 0; bj < 2; ++bj)
#pragma unroll
                    for (int n = 0; n < 2; ++n) in[bj][n] = *(const PG8_GAS u32x2*)(sp + bj * HALF + n * 16);
#pragma unroll
                for (int bj = 0; bj < 2; ++bj)
#pragma unroll
                    for (int n = 0; n < 2; ++n) { const u32x2 w0 = in[bj][n];
                        const f32x4 bs = (f32x4){__builtin_bit_cast(float, w0.x << 16), __builtin_bit_cast(float, w0.x & 0xffff0000u), __builtin_bit_cast(float, w0.y << 16), __builtin_bit_cast(float, w0.y & 0xffff0000u)};
                        const f32x4 o = bs + acc[ai][bj][m][n] * rc; ss += (o[0] * o[0] + o[1] * o[1]) + (o[2] * o[2] + o[3] * o[3]);
                        u32x2 w; w.x = cvt_pk_bf16(o[0], o[1]); w.y = cvt_pk_bf16(o[2], o[3]); *(PG8_GAS u32x2*)(sp + bj * HALF + n * 16) = w; }
                ss += shx(ss, 16, fr + 16 * fq); ss += shx(ss, 32, fr + 16 * fq);
                if (fq == 0) (void)__hip_atomic_fetch_add((PG8_GAS u64_t*)(rowsq + row), rowsq_fx(ss), __ATOMIC_RELAXED, __HIP_MEMORY_SCOPE_AGENT); }
    }
};
struct EpiBf16Row {
    static constexpr bool PERM = true, AFTER_DRAIN = false, KSCALE = false;
    bf16_t* O; int ldc; const u64_t* rowsq;
    __device__ __forceinline__ void operator()(const f32x4 (&acc)[2][2][4][2], const Unit& u, int wr, int wc, int fr, int fq) const {
        const int row0 = u.pm * BM + wr * 64 + fr, col0 = u.pn * BM + wc * 32 + 8 * fq;
#pragma unroll
        for (int ai = 0; ai < 2; ++ai)
#pragma unroll
            for (int m = 0; m < 4; ++m) { const int row = row0 + ai * HALF + m * 16; const float rs = rowsq_rs(rowsq, row); bf16_t* rowp = O + (size_t)row * ldc + col0;
#pragma unroll
                for (int bj = 0; bj < 2; ++bj) { const f32x4 v0 = acc[ai][bj][m][0] * rs, v1 = acc[ai][bj][m][1] * rs; u32x4 w; w.x = cvt_pk_bf16(v0[0], v0[1]); w.y = cvt_pk_bf16(v0[2], v0[3]); w.z = cvt_pk_bf16(v1[0], v1[1]); w.w = cvt_pk_bf16(v1[2], v1[3]);
                    *(PG8_GAS u32x4*)(rowp + bj * HALF) = w; } }
    }
};
struct EpiQKV {
    static constexpr bool PERM = false, AFTER_DRAIN = false, KSCALE = false;
    bf16_t* O; const float* ga; const float* gb; const float* gc; const float* rope; const u64_t* rowsq;
    __device__ __forceinline__ void operator()(const f32x4 (&acc)[2][2][4][2], const Unit& u, int wr, int wc, int fr, int fq) const {
        const int hg = u.pn * 4 + wc;
        const float* g = nullptr; bool isq = false, dorope = false;
        if (hg < 12) { g = ga; isq = true; } else if (hg < 16) { g = ga + 64; } else if (hg < 20) { }
        else if (hg < 28) { g = gb; isq = true; } else if (hg < 36) { g = gb + 64; } else if (hg < 44) { }
        else if (hg < 56) { g = gc; isq = true; dorope = true; } else if (hg < 60) { g = gc + 64; dorope = true; }
        const float qs = isq ? 0.18033688011112042f : 1.0f;
#pragma unroll
        for (int ai = 0; ai < 2; ++ai)
#pragma unroll
            for (int m = 0; m < 4; ++m) {
                const int row = u.pm * BM + ai * HALF + wr * 64 + m * 16 + fr;
                f32x4 v[2][2];
                const float rsx = rowsq_rs(rowsq, row);
#pragma unroll
                for (int bj = 0; bj < 2; ++bj)
#pragma unroll
                    for (int n = 0; n < 2; ++n) v[bj][n] = acc[ai][bj][m][n] * rsx;
                if (g) {
                    float ss = 0.f;
#pragma unroll
                    for (int bj = 0; bj < 2; ++bj)
#pragma unroll
                        for (int n = 0; n < 2; ++n) { const f32x4 x = v[bj][n]; ss += (x[0] * x[0] + x[1] * x[1]) + (x[2] * x[2] + x[3] * x[3]); }
                    ss += shx(ss, 16, fr + 16 * fq); ss += shx(ss, 32, fr + 16 * fq);
                    const float r = qs / sqrtf(ss * (1.0f / 64.0f) + 1e-6f);
#pragma unroll
                    for (int bj = 0; bj < 2; ++bj)
#pragma unroll
                        for (int n = 0; n < 2; ++n) v[bj][n] = v[bj][n] * *(const PG8_GAS f32x4*)(g + 32 * bj + 16 * n + 4 * fq) * r;
                }
                if (dorope) {
                    const int t = row & 2047, pr = t >> 6, pc = t & 63;
#pragma unroll
                    for (int bj = 0; bj < 2; ++bj) {
                        const int pos = bj ? pc : pr;
                        const float* rp = rope + (size_t)(pos * 16 + 4 * fq) * 2;
                        const f32x4 c01 = *(const PG8_GAS f32x4*)rp, c23 = *(const PG8_GAS f32x4*)(rp + 4);
                        const f32x4 cs = (f32x4){c01[0], c01[2], c23[0], c23[2]}, sn = (f32x4){c01[1], c01[3], c23[1], c23[3]};
                        const f32x4 x1 = v[bj][0], x2 = v[bj][1];
                        v[bj][0] = x1 * cs - x2 * sn; v[bj][1] = x1 * sn + x2 * cs;
                    }
                }
                bf16_t* rowp = O + (size_t)row * 4096 + hg * 64 + 4 * fq;
#pragma unroll
                for (int bj = 0; bj < 2; ++bj)
#pragma unroll
                    for (int n = 0; n < 2; ++n) { u32x2 w; w.x = cvt_pk_bf16(v[bj][n][0], v[bj][n][1]); w.y = cvt_pk_bf16(v[bj][n][2], v[bj][n][3]); *(PG8_GAS u32x2*)(rowp + 32 * bj + 16 * n) = w; }
                asm volatile("" ::: "memory");
            }
    }
};
template <class Epi, class Sched, bool ALIGN_EPI = false, bool SP2 = false>
__device__ __forceinline__ void gemm_phase(PG8_LAS unsigned char* lds, const Gemm g, const Sched& S, const Epi& E, const int tid) {
    const int wid = __builtin_amdgcn_readfirstlane(tid >> 6), lane = tid & 63, wr = wid >> 2, wc = wid & 3, fr = lane & 15, fq = lane >> 4;
    const int K = g.K, nt = K / BK;
    unsigned voffA[2], voffB[2];
#pragma unroll
    for (int i = 0; i < 2; ++i) { int R, C; stage_rc(tid * 16 + i * 8192, R, C); const int Rb = Epi::PERM ? ((R & ~31) + perm32(R & 31)) : R;
        voffA[i] = (unsigned)(R * K + C) * 2u; voffB[i] = (unsigned)(Rb * K + C) * 2u; }
    const size_t kstep = (size_t)(BK * 2);
    const size_t hstep = (size_t)HALF * K * 2;
    const size_t tstep = 2 * hstep;
    const unsigned ldsw = (unsigned)wid * 1024u;
    const int aoff = lds_byte(wr * 64 + fr, fq * 8), boff = lds_byte(wc * 32 + fr, fq * 8);
#define PG8_SA(b, h) (((b) * 2 + (h)) * HTB)
#define PG8_SB(b, h) ((4 + (b) * 2 + (h)) * HTB)
#define PG8_STAGE(bufoff, gbase, voff) do { _Pragma("unroll") for (int _i = 0; _i < 2; ++_i) \
        __builtin_amdgcn_global_load_lds((const unsigned*)((const char*)(gbase) + (voff)[_i]), (PG8_LAS unsigned*)(lds + (bufoff) + ldsw + _i * 8192), 16, 0, 0); } while (0)
#define PG8_LDA(dst, b, h) do { _Pragma("unroll") for (int m = 0; m < 4; ++m) _Pragma("unroll") for (int k = 0; k < 2; ++k) dst[m][k] = *(const PG8_LAS bf16x8*)(lds + PG8_SA(b, h) + aoff + m * 2048 + k * 1024); } while (0)
#define PG8_LDB(dst, b, h) do { _Pragma("unroll") for (int n = 0; n < 2; ++n) _Pragma("unroll") for (int k = 0; k < 2; ++k) dst[n][k] = *(const PG8_LAS bf16x8*)(lds + PG8_SB(b, h) + boff + n * 2048 + k * 1024); } while (0)
#define PG8_MMA(ai, bj, At, Bt) do { __builtin_amdgcn_s_setprio(1); _Pragma("unroll") for (int m = 0; m < 4; ++m) _Pragma("unroll") for (int n = 0; n < 2; ++n) _Pragma("unroll") for (int k = 0; k < 2; ++k) \
        acc[ai][bj][m][n] = __builtin_amdgcn_mfma_f32_16x16x32_bf16(Bt[n][k], At[m][k], acc[ai][bj][m][n], 0, 0, 0); __builtin_amdgcn_s_setprio(0); } while (0)
#define PG8_WAIT_V(n) asm volatile("s_waitcnt vmcnt(" #n ")" ::: "memory")
#define PG8_WAIT_L(n) asm volatile("s_waitcnt lgkmcnt(" #n ")" ::: "memory")
#define PG8_BAR __builtin_amdgcn_s_barrier()
#define PG8_SCHED __builtin_amdgcn_sched_barrier(0)
    Unit cur, nxt; int ui = 0;
    if (!S.next(0, cur)) return;
    f32x4 acc[2][2][4][2];
#pragma unroll
    for (int a = 0; a < 2; ++a)
#pragma unroll
        for (int b = 0; b < 2; ++b)
#pragma unroll
            for (int m = 0; m < 4; ++m)
#pragma unroll
                for (int n = 0; n < 2; ++n) acc[a][b][m][n] = (f32x4){0.f, 0.f, 0.f, 0.f};
    bf16x8 At[4][2], B0[2][2], B1[2][2];
    const char* cA = (const char*)g.A + (size_t)cur.pm * tstep; const char* cB = (const char*)g.Bt + (size_t)cur.pn * tstep;
    S.a_ready(cur);
    if constexpr (SP2) {
        PG8_STAGE(PG8_SB(0, 0), cB, voffB); PG8_STAGE(PG8_SB(0, 1), cB + hstep, voffB); PG8_STAGE(PG8_SA(0, 0), cA, voffA); PG8_STAGE(PG8_SA(0, 1), cA + hstep, voffA);
        if (wr == 1) PG8_BAR;
        PG8_WAIT_V(2); PG8_BAR;
        PG8_STAGE(PG8_SB(1, 0), cB + kstep, voffB); PG8_STAGE(PG8_SA(1, 0), cA + kstep, voffA); PG8_STAGE(PG8_SB(1, 1), cB + hstep + kstep, voffB);
        PG8_WAIT_V(6); PG8_BAR;
    } else {
        PG8_STAGE(PG8_SB(0, 0), cB, voffB); PG8_STAGE(PG8_SA(0, 0), cA, voffA); PG8_STAGE(PG8_SB(0, 1), cB + hstep, voffB); PG8_STAGE(PG8_SA(0, 1), cA + hstep, voffA);
        if (wr == 1) PG8_BAR;
        PG8_WAIT_V(4); PG8_BAR;
        PG8_STAGE(PG8_SB(1, 0), cB + kstep, voffB); PG8_STAGE(PG8_SA(1, 0), cA + kstep, voffA); PG8_STAGE(PG8_SB(1, 1), cB + hstep + kstep, voffB);
        PG8_WAIT_V(6); PG8_BAR;
    }
    for (;;) {
        const bool has_next = S.next(ui + 1, nxt);
        const char* nA = has_next ? (const char*)g.A + (size_t)nxt.pm * tstep : cA; const char* nB = has_next ? (const char*)g.Bt + (size_t)nxt.pn * tstep : cB;
        for (int t = 0; t < nt; t += 2) {
            if constexpr (Epi::KSCALE) { if (t == Epi::KS0 || t == Epi::KS1) E.kscale(acc, cur, t == Epi::KS1 ? 1 : 0, wr, fr); }
            const bool last = (t == nt - 2);
            const char* a1 = cA + (size_t)(t + 1) * kstep;
            const char* a2 = last ? nA : cA + (size_t)(t + 2) * kstep; const char* b2 = last ? nB : cB + (size_t)(t + 2) * kstep;
            const char* a3 = a2 + kstep; const char* b3 = b2 + kstep;
            if (last && has_next) S.a_ready(nxt);
            if constexpr (SP2) {
            PG8_LDB(B0, 0, 0); PG8_LDB(B1, 0, 1); PG8_SCHED; PG8_LDA(At, 0, 0); PG8_STAGE(PG8_SA(1, 1), a1 + hstep, voffA);
            PG8_WAIT_V(8); PG8_WAIT_L(0); PG8_BAR; PG8_MMA(0, 0, At, B0); PG8_MMA(0, 1, At, B1); PG8_BAR; PG8_SCHED;
            PG8_LDA(At, 0, 1); PG8_STAGE(PG8_SB(0, 0), b2, voffB); PG8_STAGE(PG8_SB(0, 1), b2 + hstep, voffB); PG8_STAGE(PG8_SA(0, 0), a2, voffA);
            PG8_WAIT_V(8); PG8_WAIT_L(0); PG8_BAR; PG8_MMA(1, 0, At, B0); PG8_MMA(1, 1, At, B1); PG8_BAR; PG8_SCHED;
            PG8_LDB(B0, 1, 0); PG8_LDB(B1, 1, 1); PG8_SCHED; PG8_LDA(At, 1, 0); PG8_STAGE(PG8_SA(0, 1), a2 + hstep, voffA);
            PG8_WAIT_V(8); PG8_WAIT_L(0); PG8_BAR; PG8_MMA(0, 0, At, B0); PG8_MMA(0, 1, At, B1); PG8_BAR; PG8_SCHED;
            PG8_LDA(At, 1, 1); PG8_STAGE(PG8_SB(1, 0), b3, voffB); PG8_STAGE(PG8_SB(1, 1), b3 + hstep, voffB); PG8_STAGE(PG8_SA(1, 0), a3, voffA);
            PG8_WAIT_V(8); PG8_WAIT_L(0); PG8_BAR; PG8_MMA(1, 0, At, B0); PG8_MMA(1, 1, At, B1); PG8_BAR; PG8_SCHED;
            } else {
            PG8_LDB(B0, 0, 0); PG8_SCHED; PG8_LDA(At, 0, 0); PG8_STAGE(PG8_SA(1, 1), a1 + hstep, voffA);
            PG8_WAIT_L(8); PG8_BAR; PG8_WAIT_L(0); PG8_MMA(0, 0, At, B0); PG8_BAR; PG8_SCHED;
            PG8_LDB(B1, 0, 1); PG8_STAGE(PG8_SB(0, 0), b2, voffB);
            PG8_BAR; PG8_WAIT_L(0); PG8_MMA(0, 1, At, B1); PG8_BAR;
            PG8_LDA(At, 0, 1); PG8_STAGE(PG8_SA(0, 0), a2, voffA);
            PG8_BAR; PG8_WAIT_L(0); PG8_MMA(1, 0, At, B0); PG8_BAR; PG8_SCHED;
            PG8_STAGE(PG8_SB(0, 1), b2 + hstep, voffB);
            PG8_WAIT_V(6); PG8_BAR; PG8_MMA(1, 1, At, B1); PG8_BAR;
            PG8_LDB(B0, 1, 0); PG8_SCHED; PG8_LDA(At, 1, 0); PG8_STAGE(PG8_SA(0, 1), a2 + hstep, voffA);
            PG8_WAIT_L(8); PG8_BAR; PG8_WAIT_L(0); PG8_MMA(0, 0, At, B0); PG8_BAR; PG8_SCHED;
            PG8_LDB(B1, 1, 1); PG8_STAGE(PG8_SB(1, 0), b3, voffB);
            PG8_BAR; PG8_WAIT_L(0); PG8_MMA(0, 1, At, B1); PG8_BAR;
            PG8_LDA(At, 1, 1); PG8_STAGE(PG8_SA(1, 0), a3, voffA);
            PG8_BAR; PG8_WAIT_L(0); PG8_MMA(1, 0, At, B0); PG8_BAR; PG8_SCHED;
            PG8_STAGE(PG8_SB(1, 1), b3 + hstep, voffB);
            PG8_WAIT_V(6); PG8_BAR; PG8_MMA(1, 1, At, B1); PG8_BAR;
            }
        }
        if constexpr (ALIGN_EPI) { if (wr == 0) PG8_BAR; }
        if constexpr (!Epi::AFTER_DRAIN) { E(acc, cur, wr, wc, fr, fq); S.done(cur); }
        if (!has_next) break;
#pragma unroll
        for (int a = 0; a < 2; ++a)
#pragma unroll
            for (int b = 0; b < 2; ++b)
#pragma unroll
                for (int m = 0; m < 4; ++m)
#pragma unroll
                    for (int n = 0; n < 2; ++n) acc[a][b][m][n] = (f32x4){0.f, 0.f, 0.f, 0.f};
        cur = nxt; cA = nA; cB = nB; ++ui;
        if constexpr (ALIGN_EPI) { if (wr == 1) PG8_BAR; }
    }
    PG8_WAIT_V(0);
    if constexpr (!ALIGN_EPI) { if (wr == 0) PG8_BAR; }
    PG8_BAR;
    if constexpr (Epi::AFTER_DRAIN) { E.fused(acc, cur, wr, wc, fr, fq, lds, wid, lane); S.done(cur); }
#undef PG8_SA
#undef PG8_SB
#undef PG8_STAGE
#undef PG8_LDA
#undef PG8_LDB
#undef PG8_MMA
#undef PG8_WAIT_V
#undef PG8_WAIT_L
#undef PG8_BAR
#undef PG8_SCHED
}
}

constexpr int BATCH = 16, SEQ = 2048, DM = 2048, T = BATCH * SEQ, DEPTH = 2;
constexpr int NMEM = 256, DIN = 4096, MEMW = 512;
constexpr int PEER_H = 8, PEER_N = 16384;
constexpr int NWAVES = 8, NTHREADS = NWAVES * 64;
constexpr float EPS = 1e-6f;
constexpr int QA = 0, KA = 768, VA = 1024, QB = 1280, KB = 1792, VB = 2304, QC = 2816, KC = 3584, VC = 3840;
constexpr int OA = 0, OB = 768, OC = 1280;

constexpr size_t MiB = 1u << 20;
constexpr size_t WS_CTL = 0, CTL_ZERO_BYTES = 2 * MiB;
constexpr size_t WS_ROWSQ = 256 * 1024;
constexpr size_t WS_ROPE = 83 * MiB, WS_BIASA = 83 * MiB + 16384;
constexpr size_t WS_WIN = 2 * MiB, WS_WOUT = 34 * MiB, WS_WMQ = 50 * MiB, WS_WMKV = 54 * MiB, WS_WMO = 62 * MiB, WS_WPQ = 66 * MiB, WS_PKEYS = 82 * MiB;
constexpr size_t WS_MEMN = 84 * MiB, WS_KVM = 116 * MiB, WS_PU = 132 * MiB, WS_PV = 260 * MiB, WS_XN = 388 * MiB, WS_QKV = 516 * MiB, WS_ATT = 772 * MiB;
constexpr size_t WS_QM = 900 * MiB, WS_OM = 932 * MiB, WS_MIXSQ = 964 * MiB, MIXSQ_BYTES = 2 * MiB, WS_END = 966 * MiB;
constexpr size_t WS_QP = WS_QKV, WS_PIDX = WS_QKV + 128 * MiB, WS_PGATE = WS_QKV + 144 * MiB, WS_PARTI = WS_QKV + 160 * MiB;
constexpr size_t WS_XQH = 900 * MiB, WS_XQL = 932 * MiB;
constexpr int CW_BAR = 4096;

constexpr int RING_OFF = 0, RING_BYTES = 131072;
constexpr int LDSCTL_OFF = RING_BYTES, MISC_OFF = LDSCTL_OFF + 320;
constexpr int LDS_BYTES = 147456;

#define GAS __attribute__((address_space(1)))
#define LAS __attribute__((address_space(3)))
typedef unsigned short bf16;
typedef unsigned v4u __attribute__((ext_vector_type(4)));
typedef unsigned v2u __attribute__((ext_vector_type(2)));
typedef float f32x4 __attribute__((ext_vector_type(4)));
typedef float f32x16 __attribute__((ext_vector_type(16)));
typedef short bf16x8 __attribute__((ext_vector_type(8)));
typedef GAS unsigned gu32;
#define LDS_WAIT() asm volatile("s_waitcnt lgkmcnt(0)" ::: "memory")
#define VM_WAIT() asm volatile("s_waitcnt vmcnt(0)" ::: "memory")
__device__ __forceinline__ unsigned f2bf(float f) { unsigned u = __builtin_bit_cast(unsigned, f); return (u + 0x7fffu + ((u >> 16) & 1u)) >> 16; }
__device__ __forceinline__ unsigned pk2(float lo, float hi) { return f2bf(lo) | (f2bf(hi) << 16); }
__device__ __forceinline__ float bflo(unsigned w) { return __builtin_bit_cast(float, w << 16); }
__device__ __forceinline__ float bfhi(unsigned w) { return __builtin_bit_cast(float, w & 0xffff0000u); }

__device__ __forceinline__ float shx(float v, int k, int lane) { return __builtin_bit_cast(float, __builtin_amdgcn_ds_bpermute((lane ^ k) << 2, __builtin_bit_cast(int, v))); }
#define XB_TMO      128
#define XB_XCNT(j)  (256  + 64 * (j))
#define XB_XSUB(j)  (1280 + 64 * (j))
#define XB_XGEN(j)  (2304 + 64 * (j))
#define XB_TOP      3328
#define XB_TOPGEN   3392
#define XCD_BAR_WORDS 3456
#define XB_SPIN_CAP (1u << 18)

__device__ __forceinline__ unsigned xb_ld(unsigned* p)              { return __hip_atomic_load(p, __ATOMIC_RELAXED, __HIP_MEMORY_SCOPE_AGENT); }
__device__ __forceinline__ unsigned xb_add(unsigned* p, unsigned v) { return __hip_atomic_fetch_add(p, v, __ATOMIC_RELAXED, __HIP_MEMORY_SCOPE_AGENT); }
__device__ __forceinline__ unsigned xb_xcc_id() { return (unsigned)__builtin_amdgcn_s_getreg((3 << 11) | 20) & 0xFu; }
#define XB_SPIN(cond, bar) do { unsigned _sp = 0; while (cond) { __builtin_amdgcn_s_sleep(1); \
    if ((++_sp & 255u) == 0u) { if (xb_ld(&(bar)[XB_TMO])) break; if (_sp > XB_SPIN_CAP) { atomicAdd(&(bar)[XB_TMO], 1u); break; } } } } while (0)

struct XcdBarrier {
    unsigned* bar; unsigned x;
    volatile LAS unsigned* st;
};

__device__ __forceinline__ XcdBarrier xcd_barrier_post(unsigned* bar, volatile LAS unsigned* st) {
    XcdBarrier b; b.bar = bar; b.x = xb_xcc_id(); b.st = st;
    if (threadIdx.x == 0) (void)xb_add(&bar[XB_XCNT(b.x)], 1u);
    return b;
}
__device__ __forceinline__ void xcd_barrier_complete(unsigned* bar, unsigned x, unsigned& nloc, unsigned& nx) {
    const unsigned G = gridDim.x * gridDim.y * gridDim.z;
    unsigned sum, cnt, mine, sp = 0u;
    for (;;) {
        sum = 0u; cnt = 0u; mine = 0u;
#pragma unroll
        for (unsigned j = 0; j < 16; ++j) { const unsigned c = xb_ld(&bar[XB_XCNT(j)]); sum += c; cnt += (c > 0u) ? 1u : 0u; mine = (j == x) ? c : mine; }
        if (sum == G) break;
        __builtin_amdgcn_s_sleep(1);
        if ((++sp & 255u) == 0u) { if (xb_ld(&bar[XB_TMO])) break; if (sp > XB_SPIN_CAP) { atomicAdd(&bar[XB_TMO], 1u); break; } }
    }
    nloc = mine > 0u ? mine : 1u; nx = cnt > 0u ? cnt : 1u;
}

__device__ __forceinline__ void xcd_barrier(const XcdBarrier& b) {
    asm volatile("s_waitcnt vmcnt(0)" ::: "memory");
    __syncthreads();
    if (threadIdx.x == 0) {
        unsigned* bar = b.bar;
        __builtin_amdgcn_s_waitcnt(0);
        unsigned nloc = b.st[0], nx = b.st[1];
        if (nloc == 0u) { xcd_barrier_complete(bar, b.x, nloc, nx); b.st[0] = nloc; b.st[1] = nx; }
        const unsigned old = xb_add(&bar[XB_XSUB(b.x)], 1u);
        const unsigned gen = old / nloc;
        if (old + 1u == (gen + 1u) * nloc) {
            __builtin_amdgcn_fence(__ATOMIC_RELEASE, "agent");
            asm volatile("s_waitcnt vmcnt(0)" ::: "memory");
            const unsigned og = xb_add(&bar[XB_TOP], 1u);
            const unsigned tg = og / nx;
            if (og + 1u == (tg + 1u) * nx) xb_add(&bar[XB_TOPGEN], 1u);
            else XB_SPIN(xb_ld(&bar[XB_TOPGEN]) == tg, bar);
            __builtin_amdgcn_fence(__ATOMIC_ACQUIRE, "agent");
            xb_add(&bar[XB_XGEN(b.x)], 1u);
            asm volatile("s_waitcnt vmcnt(0)" ::: "memory");
        } else {
            XB_SPIN(xb_ld(&bar[XB_XGEN(b.x)]) == gen, bar);
            __builtin_amdgcn_fence(__ATOMIC_ACQUIRE, "agent");
            asm volatile("s_waitcnt vmcnt(0)" ::: "memory");
        }
    }
    __syncthreads();
}

__device__ __forceinline__ float wave_sum(float v, int lane) {
#pragma unroll
    for (int o = 1; o < 64; o <<= 1) v += shx(v, o, lane);
    return v;
}
__device__ __forceinline__ void* ldptr(LAS unsigned char* lds, int i) {
    const unsigned long long v = ((const LAS unsigned long long*)(lds + LDSCTL_OFF + 1024))[i];
    const unsigned lo = __builtin_amdgcn_readfirstlane((unsigned)v), hi = __builtin_amdgcn_readfirstlane((unsigned)(v >> 32));
    return (void*)(((unsigned long long)hi << 32) | lo);
}
struct OffsetOrder {
    pg8::StaticOrder S;
    __device__ __forceinline__ void init(int M, int N, int G, int c, int off) { S.init(M, N, G, (c + G - off % G) % G); }
    __device__ __forceinline__ bool next(int i, pg8::Unit& u) const { return S.next(i, u); }
    __device__ __forceinline__ void a_ready(const pg8::Unit&) const {}
    __device__ __forceinline__ void done(const pg8::Unit&) const {}
};

template <bool PERMQKV>
__device__ __forceinline__ void transpose_item(const float* W, int K, int N, bf16* WT, LAS float* scr, int item, int lane, const float* gk = nullptr) {
    const int nblk = N / 32, kb = item / nblk, nb = item % nblk, k0 = 64 * kb, n0 = 32 * nb;
    int d0 = n0;
    if (PERMQKV) { const int within = n0 & 255; d0 = (n0 & ~255) + 128 * ((within >> 5) & 1) + 32 * (within >> 6); }
#pragma unroll
    for (int i = 0; i < 8; ++i) { const int kk = 8 * i + (lane >> 3), nn = 4 * (lane & 7);
        const f32x4 w4 = *(const GAS f32x4*)(W + (size_t)(k0 + kk) * N + n0 + nn) * (gk ? gk[k0 + kk] : 1.f);
        scr[kk * 33 + nn] = w4[0]; scr[kk * 33 + nn + 1] = w4[1]; scr[kk * 33 + nn + 2] = w4[2]; scr[kk * 33 + nn + 3] = w4[3]; }
    LDS_WAIT(); asm volatile("" ::: "memory");
    const int c = lane & 7;
#pragma unroll
    for (int j = 0; j < 4; ++j) { const int n = (lane >> 3) + 8 * j; const LAS float* s = scr + (8 * c) * 33 + n;
        v4u o; o.x = pk2(s[0 * 33], s[1 * 33]); o.y = pk2(s[2 * 33], s[3 * 33]); o.z = pk2(s[4 * 33], s[5 * 33]); o.w = pk2(s[6 * 33], s[7 * 33]);
        *(GAS v4u*)(WT + (size_t)(d0 + n) * K + k0 + 8 * c) = o; }
    LDS_WAIT(); asm volatile("" ::: "memory");
}
__device__ __forceinline__ void convert_bf16(const float* src, bf16* dst, size_t n, size_t gtid, size_t nthreads) {
    for (size_t i = gtid * 8; i < n; i += nthreads * 8) {
        const f32x4 a = *(const GAS f32x4*)(src + i), b = *(const GAS f32x4*)(src + i + 4);
        v4u o; o.x = pk2(a[0], a[1]); o.y = pk2(a[2], a[3]); o.z = pk2(b[0], b[1]); o.w = pk2(b[2], b[3]);
        *(GAS v4u*)(dst + i) = o;
    }
}
__device__ __forceinline__ int t5_bucket(int rel) {
    const int n = rel < 0 ? -rel : rel;
    const int b = n < 8 ? n : n < 12 ? 8 : n < 16 ? 9 : n < 23 ? 10 : n < 32 ? 11 : n < 46 ? 12 : n < 64 ? 13 : n < 91 ? 14 : 15;
    return b + (rel > 0 ? 16 : 0);
}
__constant__ float ROPE_INV[16] = {1.000000000e+00f, 5.623413324e-01f, 3.162277639e-01f, 1.778279394e-01f, 1.000000015e-01f, 5.623413250e-02f, 3.162277490e-02f, 1.778279431e-02f,
                                   9.999999776e-03f, 5.623413250e-03f, 3.162277630e-03f, 1.778279431e-03f, 1.000000047e-03f, 5.623413017e-04f, 3.162277571e-04f, 1.778279402e-04f};

__device__ __forceinline__ void rms_row_to_bf16(const float* xrow, const float* g0, bf16* o0, const float* g1, bf16* o1, int lane) {
    const GAS f32x4* xr = (const GAS f32x4*)xrow + lane;
    f32x4 v[8]; float s = 0.f;
#pragma unroll
    for (int j = 0; j < 8; ++j) { v[j] = xr[64 * j]; s += (v[j].x * v[j].x + v[j].y * v[j].y) + (v[j].z * v[j].z + v[j].w * v[j].w); }
    const float rstd = 1.f / sqrtf(wave_sum(s, lane) * (1.f / DM) + EPS);
    {   const GAS f32x4* gr = (const GAS f32x4*)g0 + lane; GAS v2u* o8 = (GAS v2u*)o0 + lane;
#pragma unroll
        for (int j = 0; j < 8; ++j) { const f32x4 gg = gr[64 * j]; v2u w; w.x = pk2(v[j].x * rstd * gg.x, v[j].y * rstd * gg.y); w.y = pk2(v[j].z * rstd * gg.z, v[j].w * rstd * gg.w); o8[64 * j] = w; } }
    if (g1) { const GAS f32x4* gr = (const GAS f32x4*)g1 + lane; GAS v2u* o8 = (GAS v2u*)o1 + lane;
#pragma unroll
        for (int j = 0; j < 8; ++j) { const f32x4 gg = gr[64 * j]; v2u w; w.x = pk2(v[j].x * rstd * gg.x, v[j].y * rstd * gg.y); w.y = pk2(v[j].z * rstd * gg.z, v[j].w * rstd * gg.w); o8[64 * j] = w; } }
}
__device__ __forceinline__ void prep_rows2(const float* x0, bf16* o0, u64_t* sq, int lane) {
    f32x4 v[2][8];
#pragma unroll
    for (int q = 0; q < 2; ++q) { const GAS f32x4* xr = (const GAS f32x4*)(x0 + (size_t)q * DM) + lane;
#pragma unroll
        for (int j = 0; j < 8; ++j) v[q][j] = xr[64 * j]; }
#pragma unroll
    for (int q = 0; q < 2; ++q) { GAS v2u* o8 = (GAS v2u*)(o0 + (size_t)q * DM) + lane; float s = 0.f;
#pragma unroll
        for (int j = 0; j < 8; ++j) { const f32x4 a = v[q][j]; s += (a.x * a.x + a.y * a.y) + (a.z * a.z + a.w * a.w); v2u w; w.x = pk2(a.x, a.y); w.y = pk2(a.z, a.w); o8[64 * j] = w; }
        s = wave_sum(s, lane);
        if (lane == 0) sq[q] = rowsq_fx(s); }
}
__device__ __forceinline__ void norm_rows(const float* X, const float* g, bf16* XN, int gw, int NGW, int lane) {
    for (int m = gw; m < T; m += NGW) rms_row_to_bf16(X + (size_t)m * DM, g, XN + (size_t)m * DM, nullptr, nullptr, lane);
}

template <int TYPE>
__device__ __forceinline__ void naive_attn_item(const bf16* QKV, bf16* ATT, int b, int grow, int head, int lane, const float* biasA, const float* sink, const float* rpb) {
    const int tpos = grow * 64 + lane; const size_t trow = (size_t)b * SEQ + tpos;
    int qcol, kcol, vcol, ocol;
    if (TYPE == 0) { qcol = QA + head * 64; kcol = KA + (head / 3) * 64; vcol = VA + (head / 3) * 64; ocol = OA + head * 64; }
    else if (TYPE == 1) { qcol = QB + head * 64; kcol = KB + head * 64; vcol = VB + head * 64; ocol = OB + head * 64; }
    else { qcol = QC + head * 64; kcol = KC + (head / 3) * 64; vcol = VC + (head / 3) * 64; ocol = OC + head * 64; }
    float q[64], o[64];
#pragma unroll
    for (int c = 0; c < 8; ++c) { const v4u w = *(const GAS v4u*)(QKV + trow * DIN + qcol + 8 * c);
        q[8 * c + 0] = bflo(w.x); q[8 * c + 1] = bfhi(w.x); q[8 * c + 2] = bflo(w.y); q[8 * c + 3] = bfhi(w.y); q[8 * c + 4] = bflo(w.z); q[8 * c + 5] = bfhi(w.z); q[8 * c + 6] = bflo(w.w); q[8 * c + 7] = bfhi(w.w); }
#pragma unroll
    for (int d = 0; d < 64; ++d) o[d] = 0.f;
    float m = -1e30f, l = 0.f;
    int j0, j1;
    if (TYPE == 0) { j0 = grow * 64 - 128; if (j0 < 0) j0 = 0; j1 = grow * 64 + 63 + 128; if (j1 > SEQ - 1) j1 = SEQ - 1; }
    else if (TYPE == 1) { int r0 = grow - 4; r0 = r0 < 0 ? 0 : (r0 > 24 ? 24 : r0); j0 = r0 * 64; j1 = j0 + 511; }
    else { j0 = 0; j1 = SEQ - 1; }
    int c0 = lane - 8; c0 = c0 < 0 ? 0 : (c0 > 48 ? 48 : c0);
#pragma unroll 1
    for (int j = j0; j <= j1; ++j) {
        const bf16* krow = QKV + ((size_t)b * SEQ + j) * DIN;
        float s = 0.f;
#pragma unroll
        for (int c = 0; c < 8; ++c) { const v4u w = *(const GAS v4u*)(krow + kcol + 8 * c);
            s += q[8 * c + 0] * bflo(w.x) + q[8 * c + 1] * bfhi(w.x) + q[8 * c + 2] * bflo(w.y) + q[8 * c + 3] * bfhi(w.y) + q[8 * c + 4] * bflo(w.z) + q[8 * c + 5] * bfhi(w.z) + q[8 * c + 6] * bflo(w.w) + q[8 * c + 7] * bfhi(w.w); }
        bool valid = true;
        if (TYPE == 0) { const int rel = j - tpos; valid = (rel >= -128 && rel <= 128); if (valid) s += biasA[head * 257 + rel + 128]; }
        if (TYPE == 1) { const int kr = j >> 6, kc = j & 63; valid = (kc >= c0 && kc < c0 + 16); if (valid) s += rpb[(head * 15 + (kr - grow + 7)) * 31 + (kc - lane + 15)]; }
        const float mn = valid ? fmaxf(m, s) : m;
        const float a = __expf(m - mn);
        const float p = valid ? __expf(s - mn) : 0.f;
        l = l * a + p; m = mn;
#pragma unroll
        for (int c = 0; c < 8; ++c) { const v4u w = *(const GAS v4u*)(krow + vcol + 8 * c);
            o[8 * c + 0] = o[8 * c + 0] * a + p * bflo(w.x); o[8 * c + 1] = o[8 * c + 1] * a + p * bfhi(w.x); o[8 * c + 2] = o[8 * c + 2] * a + p * bflo(w.y); o[8 * c + 3] = o[8 * c + 3] * a + p * bfhi(w.y);
            o[8 * c + 4] = o[8 * c + 4] * a + p * bflo(w.z); o[8 * c + 5] = o[8 * c + 5] * a + p * bfhi(w.z); o[8 * c + 6] = o[8 * c + 6] * a + p * bflo(w.w); o[8 * c + 7] = o[8 * c + 7] * a + p * bfhi(w.w); }
    }
    if (TYPE == 0) l += __expf(sink[head] - m);
    const float inv = 1.f / l;
#pragma unroll
    for (int c = 0; c < 8; ++c) { v4u w; w.x = pk2(o[8 * c + 0] * inv, o[8 * c + 1] * inv); w.y = pk2(o[8 * c + 2] * inv, o[8 * c + 3] * inv); w.z = pk2(o[8 * c + 4] * inv, o[8 * c + 5] * inv); w.w = pk2(o[8 * c + 6] * inv, o[8 * c + 7] * inv);
        *(GAS v4u*)(ATT + trow * DM + ocol + 8 * c) = w; }
}
__device__ __forceinline__ float rdl(float v, int l) { return __builtin_bit_cast(float, __builtin_amdgcn_readlane(__builtin_bit_cast(int, v), l)); }
__device__ __forceinline__ void naive_mem_item(const bf16* QM, const bf16* KVM, bf16* OM, const float* gq, size_t trow, int b, int head, int lane) {
    const unsigned qw = *(const GAS unsigned*)(QM + trow * MEMW + head * 128 + 2 * lane);
    float q0 = bflo(qw), q1 = bfhi(qw);
    const float ss = wave_sum(q0 * q0 + q1 * q1, lane);
    const float r = 0.08838834764831845f / sqrtf(ss * (1.f / 128.f) + EPS);
    q0 *= r * gq[2 * lane]; q1 *= r * gq[2 * lane + 1];
    const bf16* kbase = KVM + ((size_t)b * NMEM + lane) * 1024 + head * 128;
    float s[4] = {0.f, 0.f, 0.f, 0.f};
#pragma unroll 1
    for (int c = 0; c < 16; ++c) {
        float qa[8];
#pragma unroll
        for (int e = 0; e < 4; ++e) { qa[2 * e] = rdl(q0, 4 * c + e); qa[2 * e + 1] = rdl(q1, 4 * c + e); }
#pragma unroll
        for (int i = 0; i < 4; ++i) { const v4u w = *(const GAS v4u*)(kbase + (size_t)i * 64 * 1024 + 8 * c);
            s[i] += qa[0] * bflo(w.x) + qa[1] * bfhi(w.x) + qa[2] * bflo(w.y) + qa[3] * bfhi(w.y) + qa[4] * bflo(w.z) + qa[5] * bfhi(w.z) + qa[6] * bflo(w.w) + qa[7] * bfhi(w.w); }
    }
    float m = fmaxf(fmaxf(s[0], s[1]), fmaxf(s[2], s[3]));
#pragma unroll
    for (int o = 1; o < 64; o <<= 1) m = fmaxf(m, shx(m, o, lane));
    float p[4]; float l = 0.f;
#pragma unroll
    for (int i = 0; i < 4; ++i) { p[i] = __expf(s[i] - m); l += p[i]; }
    l = wave_sum(l, lane);
    const bf16* vbase = KVM + ((size_t)b * NMEM) * 1024 + 512 + head * 128 + 2 * lane;
    float o0 = 0.f, o1 = 0.f;
#pragma unroll
    for (int i = 0; i < 4; ++i) {
#pragma unroll 4
        for (int jj = 0; jj < 64; ++jj) { const float pj = rdl(p[i], jj); const unsigned w = *(const GAS unsigned*)(vbase + (size_t)(64 * i + jj) * 1024); o0 += pj * bflo(w); o1 += pj * bfhi(w); }
    }
    const float inv = 1.f / l;
    *(GAS unsigned*)(OM + trow * MEMW + head * 128 + 2 * lane) = pk2(o0 * inv, o1 * inv);
}
__device__ __forceinline__ void mixnorm_rows(bf16* ATT, const float* g, int gw, int NGW, int lane) {
    for (int m = gw; m < T; m += NGW) {
        GAS v4u* p = (GAS v4u*)(ATT + (size_t)m * DM + 32 * lane);
        v4u w[4]; float f[32]; float ss = 0.f;
#pragma unroll
        for (int c = 0; c < 4; ++c) { w[c] = p[c];
            f[8 * c + 0] = bflo(w[c].x); f[8 * c + 1] = bfhi(w[c].x); f[8 * c + 2] = bflo(w[c].y); f[8 * c + 3] = bfhi(w[c].y); f[8 * c + 4] = bflo(w[c].z); f[8 * c + 5] = bfhi(w[c].z); f[8 * c + 6] = bflo(w[c].w); f[8 * c + 7] = bfhi(w[c].w); }
#pragma unroll
        for (int i = 0; i < 32; ++i) ss += f[i] * f[i];
        const int grp = lane < 24 ? 0 : (lane < 40 ? 1 : 2);
        const float sa = wave_sum(grp == 0 ? ss : 0.f, lane), sb = wave_sum(grp == 1 ? ss : 0.f, lane), sc = wave_sum(grp == 2 ? ss : 0.f, lane);
        const float r = grp == 0 ? 1.f / sqrtf(sa * (1.f / 768.f) + EPS) : (grp == 1 ? 1.f / sqrtf(sb * (1.f / 512.f) + EPS) : 1.f / sqrtf(sc * (1.f / 768.f) + EPS));
        const float* gg = g + 32 * lane;
#pragma unroll
        for (int c = 0; c < 4; ++c) { const f32x4 g0 = *(const GAS f32x4*)(gg + 8 * c), g1 = *(const GAS f32x4*)(gg + 8 * c + 4);
            v4u o; o.x = pk2(f[8 * c + 0] * r * g0[0], f[8 * c + 1] * r * g0[1]); o.y = pk2(f[8 * c + 2] * r * g0[2], f[8 * c + 3] * r * g0[3]);
            o.z = pk2(f[8 * c + 4] * r * g1[0], f[8 * c + 5] * r * g1[1]); o.w = pk2(f[8 * c + 6] * r * g1[2], f[8 * c + 7] * r * g1[3]); p[c] = o; }
    }
}

#ifndef PEER_HD
#define PEER_HD __device__ __forceinline__
#define PEER_EXP(x) __expf(x)
#endif
template <int N> PEER_HD void bitonic_sort_desc(float* v) {
#pragma unroll
    for (int k = 2; k <= N; k <<= 1)
#pragma unroll
        for (int j = k >> 1; j > 0; j >>= 1)
#pragma unroll
            for (int i = 0; i < N; ++i) { const int l = i ^ j; if (l > i) { const bool desc = ((i & k) == 0); const float a = v[i], b = v[l]; const float hi = fmaxf(a, b), lo = fminf(a, b);
                v[i] = desc ? hi : lo; v[l] = desc ? lo : hi; } }
}
PEER_HD void merge_top16(float* a, const float* b) {
    float c[16];
#pragma unroll
    for (int i = 0; i < 16; ++i) c[i] = fmaxf(a[i], b[15 - i]);
#pragma unroll
    for (int j = 8; j > 0; j >>= 1)
#pragma unroll
        for (int i = 0; i < 16; ++i) { const int l = i ^ j; if (l > i) { const float x = c[i], y = c[l]; c[i] = fmaxf(x, y); c[l] = fminf(x, y); } }
#pragma unroll
    for (int i = 0; i < 16; ++i) a[i] = c[i];
}
PEER_HD void top16_of_64(float (&v)[64]) {
    bitonic_sort_desc<16>(&v[0]); bitonic_sort_desc<16>(&v[16]); bitonic_sort_desc<16>(&v[32]); bitonic_sort_desc<16>(&v[48]);
    merge_top16(&v[0], &v[16]); merge_top16(&v[32], &v[48]); merge_top16(&v[0], &v[32]);
}
PEER_HD float pack_idx(float s, unsigned idx, unsigned mask) { return __builtin_bit_cast(float, (__builtin_bit_cast(unsigned, s) & ~mask) | idx); }
PEER_HD unsigned low_bits(float s, unsigned mask) { return __builtin_bit_cast(unsigned, s) & mask; }
PEER_HD unsigned pick16(const float* a, unsigned i, unsigned mask) {
    unsigned r = 0;
#pragma unroll
    for (unsigned k = 0; k < 16; ++k) r = (i == k) ? low_bits(a[k], mask) : r;
    return r;
}
PEER_HD void peer_candidates(const float* a, const float* b, int* e, float* gate) {
    float c[64]; int n = 0;
#pragma unroll
    for (int i = 0; i < 16; ++i)
#pragma unroll
        for (int j = 0; j < 16; ++j) if ((i + 1) * (j + 1) <= 16) { c[n] = pack_idx(a[i] + b[j], (unsigned)(i * 16 + j), 0xffu); ++n; }
#pragma unroll
    for (int k = 50; k < 64; ++k) c[k] = -3.0e38f;
    top16_of_64(c);
    float mx = c[0], den = 0.f;
#pragma unroll
    for (int k = 0; k < 16; ++k) { const unsigned id = low_bits(c[k], 0xffu); const unsigned n0 = pick16(a, id >> 4, 0x7fu), n1 = pick16(b, id & 15u, 0x7fu);
        e[k] = (int)(n0 * 128u + n1); gate[k] = PEER_EXP(c[k] - mx); den += gate[k]; }
    const float inv = 1.f / den;
#pragma unroll
    for (int k = 0; k < 16; ++k) gate[k] *= inv;
}

__device__ __forceinline__ void peer_select_unit(const bf16* QP, const bf16* PK, int* PIDX, float* PGATE, int tb, int h, int wave, int lane) {
    const int hh = lane >> 5, tl = lane & 31; const size_t t = (size_t)tb * 256 + wave * 32 + tl;
    float ab[2][16];
#pragma unroll
    for (int p = 0; p < 2; ++p) {
        bf16x8 bq[8];
#pragma unroll
        for (int s = 0; s < 8; ++s) bq[s] = *(const GAS bf16x8*)(QP + t * DM + 256 * h + 128 * p + 16 * s + 8 * hh);
        float v[64];
#pragma unroll
        for (int nb = 0; nb < 4; ++nb) {
            f32x16 acc;
#pragma unroll
            for (int r = 0; r < 16; ++r) acc[r] = 0.f;
            const bf16* kp = PK + ((size_t)((h * 2 + p) * 128 + 32 * nb + tl)) * 128 + 8 * hh;
            bf16x8 ak[8];
#pragma unroll
            for (int s = 0; s < 8; ++s) ak[s] = *(const GAS bf16x8*)(kp + 16 * s);
#pragma unroll
            for (int s = 0; s < 8; ++s) acc = __builtin_amdgcn_mfma_f32_32x32x16_bf16(ak[s], bq[s], acc, 0, 0, 0);
#pragma unroll
            for (int r = 0; r < 16; ++r) v[16 * nb + r] = pack_idx(acc[r], (unsigned)(32 * nb + 8 * (r >> 2) + 4 * hh + (r & 3)), 0x7fu);
        }
        top16_of_64(v);
        float pv[16];
#pragma unroll
        for (int i = 0; i < 16; ++i) pv[i] = shx(v[i], 32, lane);
        merge_top16(&v[0], pv);
#pragma unroll
        for (int i = 0; i < 16; ++i) ab[p][i] = v[i];
    }
    int e[16]; float gate[16];
    peer_candidates(ab[0], ab[1], e, gate);
    if (hh == 0) { GAS v4u* o = (GAS v4u*)(PIDX + t * 128 + h * 16);
#pragma unroll
        for (int c = 0; c < 4; ++c) o[c] = (v4u){(unsigned)e[4 * c], (unsigned)e[4 * c + 1], (unsigned)e[4 * c + 2], (unsigned)e[4 * c + 3]}; }
    else { GAS f32x4* o = (GAS f32x4*)(PGATE + t * 128 + h * 16);
#pragma unroll
        for (int c = 0; c < 4; ++c) o[c] = (f32x4){gate[4 * c], gate[4 * c + 1], gate[4 * c + 2], gate[4 * c + 3]}; }
}

typedef float f32x2 __attribute__((ext_vector_type(2)));
typedef unsigned v6u __attribute__((ext_vector_type(6)));
typedef float v32f __attribute__((ext_vector_type(32)));
typedef v4u __attribute__((aligned(8))) v4u_a8;
constexpr float PU_SCALE6 = 90.0f, PV_SCALE6 = 5.65f;
__device__ __forceinline__ unsigned enc_e2m3(float v) {
    const float a = fminf(fabsf(v), 7.5f);
    unsigned code;
    if (a < 1.0f) code = (unsigned)__builtin_rintf(a * 8.f);
    else { const unsigned b = __builtin_bit_cast(unsigned, a) - 0x3F800000u; code = ((b + 0x7FFFFu + ((b >> 20) & 1u)) >> 20) + 8u; }
    return code | (v < 0.f ? 32u : 0u);
}
__device__ __forceinline__ void convert_fp6_rows(const float* src, unsigned char* dst, int nrows, float scale, const float* gain, int gw, int NGW, int lane) {
    for (int r = gw; r < nrows; r += NGW) {
        const float* sp = src + (size_t)r * DM + 4 * lane; const float* gp = gain ? gain + (size_t)(r / PEER_N) * DM + 4 * lane : nullptr;
        unsigned w[6] = {0u, 0u, 0u, 0u, 0u, 0u};
#pragma unroll
        for (int j = 0; j < 8; ++j) { f32x4 a = *(const GAS f32x4*)(sp + 256 * j) * scale; if (gp) a = a * *(const GAS f32x4*)(gp + 256 * j);
#pragma unroll
            for (int e = 0; e < 4; ++e) { const unsigned code = enc_e2m3(a[e]); const int bp = 6 * (4 * j + e), wi = bp >> 5, sh = bp & 31;
                w[wi] |= code << sh; if (sh > 26) w[wi + 1] |= code >> (32 - sh); } }
        unsigned char* dp = dst + (size_t)r * 1536 + 24 * lane;
        *(GAS v4u_a8*)dp = (v4u){w[0], w[1], w[2], w[3]}; *(GAS v2u*)(dp + 16) = (v2u){w[4], w[5]};
    }
}
constexpr float PV_SCALE4 = 5.65f, PU_SCALE4 = 90.0f;
__device__ __forceinline__ unsigned enc_e2m1(float v) {
    const float a = fabsf(v);
    const unsigned code = a < 0.25f ? 0u : a < 0.75f ? 1u : a < 1.25f ? 2u : a < 1.75f ? 3u : a < 2.5f ? 4u : a < 3.5f ? 5u : a < 5.0f ? 6u : 7u;
    return code | (v < 0.f ? 8u : 0u);
}
__device__ __forceinline__ void convert_fp4_rows(const float* src, unsigned char* dst, int nrows, float scale, const float* gain, int gw, int NGW, int lane) {
    for (int r0 = 2 * gw; r0 < nrows; r0 += 2 * NGW) {
        f32x4 a[2][8];
#pragma unroll
        for (int q = 0; q < 2; ++q) { const float* sp = src + (size_t)(r0 + q) * DM + 4 * lane;
#pragma unroll
            for (int j = 0; j < 8; ++j) a[q][j] = *(const GAS f32x4*)(sp + 256 * j); }
#pragma unroll
        for (int q = 0; q < 2; ++q) { const int r = r0 + q; const float* gp = gain ? gain + (size_t)(r / PEER_N) * DM + 4 * lane : nullptr;
            unsigned w[4] = {0u, 0u, 0u, 0u};
#pragma unroll
            for (int j = 0; j < 8; ++j) { f32x4 v = a[q][j] * scale; if (gp) v = v * *(const GAS f32x4*)(gp + 256 * j);
#pragma unroll
                for (int e = 0; e < 4; ++e) { const int i = 4 * j + e; w[i >> 3] |= enc_e2m1(v[e]) << (4 * (i & 7)); } }
            *(GAS v4u*)(dst + (size_t)r * 1024 + 16 * lane) = (v4u){w[0], w[1], w[2], w[3]}; }
    }
}
#define PG4_LOAD(buf, tab, idlo, idhi, g) do { _Pragma("unroll") for (int i_ = 0; i_ < PG6_R; ++i_) { const int k_ = (g) * PG6_R + i_; \
        const int e_ = __builtin_amdgcn_readlane(k_ < 64 ? idlo : idhi, k_ & 63); buf[i_] = __builtin_amdgcn_raw_buffer_load_b128(tab, (int)voff4, e_ * 1024, 0); } } while (0)
#define PG4_DOT1(buf, i_, dst) do { f32x2 a_ = {0.f, 0.f}; _Pragma("unroll") for (int c_ = 0; c_ < 4; ++c_) { const unsigned u_ = buf[i_][c_]; \
        a_ += __builtin_amdgcn_cvt_scalef32_pk_f32_fp4(u_, 1.0f, 0) * x[4 * c_ + 0]; a_ += __builtin_amdgcn_cvt_scalef32_pk_f32_fp4(u_, 1.0f, 1) * x[4 * c_ + 1]; \
        a_ += __builtin_amdgcn_cvt_scalef32_pk_f32_fp4(u_, 1.0f, 2) * x[4 * c_ + 2]; a_ += __builtin_amdgcn_cvt_scalef32_pk_f32_fp4(u_, 1.0f, 3) * x[4 * c_ + 3]; } dst = a_.x + a_.y; __builtin_amdgcn_sched_barrier(0); } while (0)
#define PG4_DOT(buf, g) do { float p_[8]; _Pragma("unroll") for (int i_ = 0; i_ < 8; ++i_) PG4_DOT1(buf, i_, p_[i_]); \
        float q_[4]; _Pragma("unroll") for (int i_ = 0; i_ < 4; ++i_) { const float keep_ = b5 ? p_[i_ + 4] : p_[i_], send_ = b5 ? p_[i_] : p_[i_ + 4]; q_[i_] = keep_ + shx(send_, 32, lane); } \
        float r_[2]; _Pragma("unroll") for (int i_ = 0; i_ < 2; ++i_) { const float keep_ = b4 ? q_[i_ + 2] : q_[i_], send_ = b4 ? q_[i_] : q_[i_ + 2]; r_[i_] = keep_ + shx(send_, 16, lane); } \
        float s_; { const float keep_ = b3 ? r_[1] : r_[0], send_ = b3 ? r_[0] : r_[1]; s_ = keep_ + shx(send_, 8, lane); } \
        s_ += shx(s_, 4, lane); s_ += shx(s_, 2, lane); s_ += shx(s_, 1, lane); \
        if ((lane & 7) == 0) wl[(g) * 8 + (lane >> 3)] = s_; } while (0)
#define PG4_AXPY(buf, g) do { _Pragma("unroll") for (int i_ = 0; i_ < PG6_R; ++i_) { const float w_ = wl[(g) * PG6_R + i_]; const f32x2 wv_ = {w_, w_}; \
        _Pragma("unroll") for (int c_ = 0; c_ < 4; ++c_) { const unsigned u_ = buf[i_][c_]; \
            y[4 * c_ + 0] += __builtin_amdgcn_cvt_scalef32_pk_f32_fp4(u_, 1.0f, 0) * wv_; y[4 * c_ + 1] += __builtin_amdgcn_cvt_scalef32_pk_f32_fp4(u_, 1.0f, 1) * wv_; \
            y[4 * c_ + 2] += __builtin_amdgcn_cvt_scalef32_pk_f32_fp4(u_, 1.0f, 2) * wv_; y[4 * c_ + 3] += __builtin_amdgcn_cvt_scalef32_pk_f32_fp4(u_, 1.0f, 3) * wv_; } \
        __builtin_amdgcn_sched_barrier(0); } } while (0)
#ifndef PG6_R
#define PG6_R 8
#endif
#define PG6_LOAD(buf, tab, idlo, idhi, g) do { _Pragma("unroll") for (int i_ = 0; i_ < PG6_R; ++i_) { const int k_ = (g) * PG6_R + i_; \
        const int e_ = __builtin_amdgcn_readlane(k_ < 64 ? idlo : idhi, k_ & 63); const unsigned char* rp_ = (tab) + (size_t)(unsigned)e_ * 1536u; \
        const v4u a_ = *(const GAS v4u_a8*)(rp_ + voff); const v2u b_ = *(const GAS v2u*)(rp_ + voff + 16); buf[i_] = (v6u){a_.x, a_.y, a_.z, a_.w, b_.x, b_.y}; } } while (0)
#define PG6_DOT1(buf, i_, dst) do { const v32f f_ = __builtin_amdgcn_cvt_scalef32_pk32_f32_fp6(buf[i_], 1.0f); f32x2 a_ = {0.f, 0.f}; \
        _Pragma("unroll") for (int c_ = 0; c_ < 16; ++c_) a_ += (f32x2){f_[2 * c_], f_[2 * c_ + 1]} * x[c_]; dst = a_.x + a_.y; __builtin_amdgcn_sched_barrier(0); } while (0)
#if PG6_R == 8
#define PG6_DOT(buf, g) do { float p_[8]; _Pragma("unroll") for (int i_ = 0; i_ < 8; ++i_) PG6_DOT1(buf, i_, p_[i_]); \
        float q_[4]; _Pragma("unroll") for (int i_ = 0; i_ < 4; ++i_) { const float keep_ = b5 ? p_[i_ + 4] : p_[i_], send_ = b5 ? p_[i_] : p_[i_ + 4]; q_[i_] = keep_ + shx(send_, 32, lane); } \
        float r_[2]; _Pragma("unroll") for (int i_ = 0; i_ < 2; ++i_) { const float keep_ = b4 ? q_[i_ + 2] : q_[i_], send_ = b4 ? q_[i_] : q_[i_ + 2]; r_[i_] = keep_ + shx(send_, 16, lane); } \
        float s_; { const float keep_ = b3 ? r_[1] : r_[0], send_ = b3 ? r_[0] : r_[1]; s_ = keep_ + shx(send_, 8, lane); } \
        s_ += shx(s_, 4, lane); s_ += shx(s_, 2, lane); s_ += shx(s_, 1, lane); \
        if ((lane & 7) == 0) wl[(g) * 8 + (lane >> 3)] = s_; } while (0)
#else
#define PG6_DOT(buf, g) do { float p_[4]; _Pragma("unroll") for (int i_ = 0; i_ < 4; ++i_) PG6_DOT1(buf, i_, p_[i_]); \
        float r_[2]; _Pragma("unroll") for (int i_ = 0; i_ < 2; ++i_) { const float keep_ = b5 ? p_[i_ + 2] : p_[i_], send_ = b5 ? p_[i_] : p_[i_ + 2]; r_[i_] = keep_ + shx(send_, 32, lane); } \
        float s_; { const float keep_ = b4 ? r_[1] : r_[0], send_ = b4 ? r_[0] : r_[1]; s_ = keep_ + shx(send_, 16, lane); } \
        s_ += shx(s_, 8, lane); s_ += shx(s_, 4, lane); s_ += shx(s_, 2, lane); s_ += shx(s_, 1, lane); \
        if ((lane & 15) == 0) wl[(g) * 4 + (lane >> 4)] = s_; } while (0)
#endif
#define PG6_AXPY(buf, g) do { _Pragma("unroll") for (int i_ = 0; i_ < PG6_R; ++i_) { const float w_ = wl[(g) * PG6_R + i_]; const f32x2 wv_ = {w_, w_}; \
        const v32f f_ = __builtin_amdgcn_cvt_scalef32_pk32_f32_fp6(buf[i_], 1.0f); _Pragma("unroll") for (int c_ = 0; c_ < 16; ++c_) y[c_] += (f32x2){f_[2 * c_], f_[2 * c_ + 1]} * wv_; __builtin_amdgcn_sched_barrier(0); } } while (0)
__device__ __forceinline__ unsigned shxu(unsigned v, int k, int lane) { return (unsigned)__builtin_amdgcn_ds_bpermute((lane ^ k) << 2, (int)v); }
__device__ __forceinline__ void wave_sort128(unsigned& a, unsigned& b, int lane) {
#pragma unroll
    for (int k = 2; k <= 128; k <<= 1) {
#pragma unroll
        for (int j = k >> 1; j > 0; j >>= 1) {
            if (j == 64) { const unsigned lo = a < b ? a : b, hi = a < b ? b : a; a = lo; b = hi; }
            else {
                const unsigned pa = shxu(a, j, lane), pb = shxu(b, j, lane);
                const bool lower = (lane & j) == 0;
                const bool asc_a = (lane & k) == 0, asc_b = ((lane + 64) & k) == 0;
                const bool take_min_a = (lower == asc_a), take_min_b = (lower == asc_b);
                a = take_min_a ? (a < pa ? a : pa) : (a < pa ? pa : a);
                b = take_min_b ? (b < pb ? b : pb) : (b < pb ? pb : b);
            }
        }
    }
}
#ifndef PEER_U_FP4
#define PEER_U_FP4 1
#endif
#if PEER_U_FP4
typedef v4u urow_t;
#define PGU_LOAD PG4_LOAD
#define PGU_DOT PG4_DOT
constexpr float PU_SCALE = PU_SCALE4; constexpr int PU_STRIDE = 1024;
#else
typedef v6u urow_t;
#define PGU_LOAD PG6_LOAD
#define PGU_DOT PG6_DOT
constexpr float PU_SCALE = PU_SCALE6; constexpr int PU_STRIDE = 1536;
#endif
constexpr float PU_SCALEI = 135.0f, PX_SCALEI = 20.0f;
__device__ __forceinline__ void peer_v_pass(bf16* XN, const unsigned char* PV6, const int* PIDX, const float* PGATE, const int* PARTI, float* X, u64_t* rowsq_out, LAS float* wl, int gw, int NGW, int lane) {
    const unsigned voff4 = 16u * (unsigned)lane, l4 = 4u * (unsigned)lane, l8 = 8u * (unsigned)lane, l16 = 16u * (unsigned)lane;
    constexpr int NG = 128 / PG6_R;
    const __amdgpu_buffer_rsrc_t PVr = __builtin_amdgcn_make_buffer_rsrc((void*)PV6, 0, PEER_N * 1024, 0x00020000);
    for (int t_ = gw; t_ < T; t_ += NGW) {
        int t = t_; asm volatile("" : "+s"(t));
        const char* pidx_t = (const char*)(PIDX + (size_t)t * 128); const char* pgate_t = (const char*)(PGATE + (size_t)t * 128);
        const int idlo = *(const GAS int*)(pidx_t + l4), idhi = *(const GAS int*)(pidx_t + l4 + 256);
        v4u AV[PG6_R], BV[PG6_R];
        PG4_LOAD(AV, PVr, idlo, idhi, 0);
        {
            int s0 = 0, s1 = 0;
#pragma unroll
            for (int sp = 0; sp < 8; ++sp) { const char* pp = (const char*)(PARTI + ((size_t)sp * T + t) * 128); s0 += *(const GAS int*)(pp + l4); s1 += *(const GAS int*)(pp + l4 + 256); }
            const float d0 = (float)s0 * (1.f / (PX_SCALEI * PU_SCALEI)), d1 = (float)s1 * (1.f / (PX_SCALEI * PU_SCALEI));
            const float g0 = *(const GAS float*)(pgate_t + l4), g1 = *(const GAS float*)(pgate_t + l4 + 256);
            const float w0 = g0 * 0.5f * d0 * (1.f + erff(d0 * 0.70710678118654752f)) * (1.f / PV_SCALE4), w1 = g1 * 0.5f * d1 * (1.f + erff(d1 * 0.70710678118654752f)) * (1.f / PV_SCALE4);
            wl[lane] = w0; wl[64 + lane] = w1;
            LDS_WAIT(); asm volatile("" ::: "memory");
        }
        f32x2 y[16];
#pragma unroll
        for (int i = 0; i < 16; ++i) y[i] = (f32x2){0.f, 0.f};
#pragma unroll 1
        for (int g = 0; g < NG; g += 2) {
            PG4_LOAD(BV, PVr, idlo, idhi, g + 1);
            PG4_AXPY(AV, g);
            if (g + 2 < NG) PG4_LOAD(AV, PVr, idlo, idhi, g + 2);
            PG4_AXPY(BV, g + 1);
        }
        {   char* xo = (char*)(X + (size_t)t * DM);
            char* xbo = (char*)(XN + (size_t)t * DM); float ss = 0.f;
#pragma unroll
            for (int j = 0; j < 8; ++j) { const v2u a = *(const GAS v2u*)(xbo + l8 + 512 * j); f32x4 v = (f32x4){bflo(a.x), bfhi(a.x), bflo(a.y), bfhi(a.y)}; v += (f32x4){y[2 * j].x, y[2 * j].y, y[2 * j + 1].x, y[2 * j + 1].y};
                if (X) *(GAS f32x4*)(xo + l16 + 1024 * j) = v;
                ss += (v[0] * v[0] + v[1] * v[1]) + (v[2] * v[2] + v[3] * v[3]); *(GAS v2u*)(xbo + l8 + 512 * j) = (v2u){pk2(v[0], v[1]), pk2(v[2], v[3])}; }
            if (rowsq_out) { ss = wave_sum(ss, lane); if (lane == 0) rowsq_out[t] = rowsq_fx(ss); } }
        LDS_WAIT(); asm volatile("" ::: "memory");
    }
}


__device__ __forceinline__ unsigned enc_i4(float v) { int q = (int)__builtin_rintf(v); q = q < -7 ? -7 : (q > 7 ? 7 : q); return (unsigned)q & 15u; }
__device__ __forceinline__ void convert_int4_plain(const float* src, unsigned char* dst, int nrows, float scale, const float* gain, int gw, int NGW, int lane) {
    for (int r0 = 2 * gw; r0 < nrows; r0 += 2 * NGW) {
        f32x4 a[2][8];
#pragma unroll
        for (int q = 0; q < 2; ++q) { const float* sp = src + (size_t)(r0 + q) * DM + 4 * lane;
#pragma unroll
            for (int j = 0; j < 8; ++j) a[q][j] = *(const GAS f32x4*)(sp + 256 * j); }
#pragma unroll
        for (int q = 0; q < 2; ++q) { const int r = r0 + q; const float* gp = gain ? gain + (size_t)(r / PEER_N) * DM + 4 * lane : nullptr;
#pragma unroll
            for (int j = 0; j < 8; ++j) { f32x4 v = a[q][j] * scale; if (gp) v = v * *(const GAS f32x4*)(gp + 256 * j);
                const unsigned w = enc_i4(v[0]) | (enc_i4(v[1]) << 4) | (enc_i4(v[2]) << 8) | (enc_i4(v[3]) << 12);
                *(GAS unsigned short*)(dst + (size_t)r * 1024 + 128 * j + 2 * lane) = (unsigned short)w; } }
    }
}
__device__ __forceinline__ void peer_xquant_unit(const bf16* XN, const u64_t* rowsq, unsigned* XQH, unsigned* XQL, int tb, int sl, int tid) {
    for (int it = tid; it < 256 * 32; it += NTHREADS) {
        const int t = tb * 256 + (it >> 5), c8 = it & 31;
        const float xs = PX_SCALEI * rowsq_rs(rowsq, t);
        const v4u w = *(const GAS v4u*)(XN + (size_t)t * DM + 256 * sl + 8 * c8);
        const float f[8] = {bflo(w.x), bfhi(w.x), bflo(w.y), bfhi(w.y), bflo(w.z), bfhi(w.z), bflo(w.w), bfhi(w.w)};
        unsigned hi = 0u, lo = 0u;
#pragma unroll
        for (int j = 0; j < 8; ++j) { int q = (int)__builtin_rintf(f[j] * xs); q = q < -119 ? -119 : (q > 119 ? 119 : q);
            const int xl = ((q + 8) & 15) - 8, xh = (q - xl) >> 4;
            hi |= ((unsigned)xh & 15u) << (4 * j); lo |= ((unsigned)xl & 15u) << (4 * j); }
        XQH[(size_t)t * 256 + 32 * sl + c8] = hi; XQL[(size_t)t * 256 + 32 * sl + c8] = lo;
    }
}
#define PI_LOADROWS(buf, tab, ids, i0) do { _Pragma("unroll") for (int i_ = 0; i_ < 8; ++i_) buf[i_] = __builtin_amdgcn_raw_buffer_load_b128(tab, ids[(i0) + i_] * 1024 + (int)soff, 0, 0); } while (0)
#define PI_LOADIDS(ids, t) do { const char* ip_ = (const char*)PIDX + ((size_t)(t) * 128 + 16 * g) * 4; _Pragma("unroll") for (int c_ = 0; c_ < 4; ++c_) { const v4u q_ = *(const GAS v4u*)(ip_ + 16 * c_); \
        ids[4 * c_] = (int)q_.x; ids[4 * c_ + 1] = (int)q_.y; ids[4 * c_ + 2] = (int)q_.z; ids[4 * c_ + 3] = (int)q_.w; } } while (0)
#define PI_UGROUP(buf, i0) do { _Pragma("unroll") for (int i_ = 0; i_ < 8; ++i_) { int ah_ = 0, al_ = 0; \
        _Pragma("unroll") for (int c_ = 0; c_ < 4; ++c_) { ah_ = __builtin_amdgcn_sdot8((int)buf[i_][c_], (int)xh[c_], ah_, false); al_ = __builtin_amdgcn_sdot8((int)buf[i_][c_], (int)xl[c_], al_, false); } \
        int p_ = 16 * ah_ + al_; p_ += __builtin_amdgcn_ds_bpermute((lane ^ 1) << 2, p_); p_ += __builtin_amdgcn_ds_bpermute((lane ^ 2) << 2, p_); p_ += __builtin_amdgcn_ds_bpermute((lane ^ 4) << 2, p_); \
        if (m == (((i0) + i_) >> 1)) { if (((i0) + i_) & 1) keep1 = p_; else keep0 = p_; } } } while (0)
#define PI_LOADROWS16(buf, tab, ids) do { _Pragma("unroll") for (int i_ = 0; i_ < 16; ++i_) buf[i_] = __builtin_amdgcn_raw_buffer_load_b128(tab, ids[i_] * 1024 + (int)soff, 0, 0); } while (0)
#define PI_LOADX(xh_, xl_, t) do { xh_ = *(const GAS v4u*)((const char*)XQH + (size_t)(t) * 1024 + soff); xl_ = *(const GAS v4u*)((const char*)XQL + (size_t)(t) * 1024 + soff); } while (0)
#define PI_COMPUTE16(buf, xh_, xl_, t) do { int keep0 = 0, keep1 = 0; \
        _Pragma("unroll") for (int i_ = 0; i_ < 16; ++i_) { int ah_ = 0, al_ = 0; \
            _Pragma("unroll") for (int c_ = 0; c_ < 4; ++c_) { ah_ = __builtin_amdgcn_sdot8((int)buf[i_][c_], (int)xh_[c_], ah_, false); al_ = __builtin_amdgcn_sdot8((int)buf[i_][c_], (int)xl_[c_], al_, false); } \
            int p_ = 16 * ah_ + al_; p_ += __builtin_amdgcn_update_dpp(0, p_, 0xB1, 0xf, 0xf, true); p_ += __builtin_amdgcn_update_dpp(0, p_, 0x4E, 0xf, 0xf, true); p_ += __builtin_amdgcn_update_dpp(0, p_, 0x141, 0xf, 0xf, true);   \
            if (m == (i_ >> 1)) { if (i_ & 1) keep1 = p_; else keep0 = p_; } } \
        if ((t) < T) *(GAS v2u*)(PARTI + ((size_t)s * T + (t)) * 128 + 2 * lane) = (v2u){(unsigned)keep0, (unsigned)keep1}; } while (0)
__device__ __forceinline__ void peer_u_phase_i4(const unsigned* XQH, const unsigned* XQL, const unsigned char* PU, const int* PIDX, int* PARTI, int bid, int G, int wave, int lane) {
    const int s = bid & 7, nr = (G - s + 7) >> 3, q = (bid >> 3) * NWAVES + wave, stride = nr * NWAVES, g = lane >> 3, m = lane & 7;
    const unsigned soff = 128u * (unsigned)s + 16u * (unsigned)m;
    if (q >= T) return;
    const __amdgpu_buffer_rsrc_t PUr = __builtin_amdgcn_make_buffer_rsrc((void*)PU, 0, PEER_N * 1024, 0x00020000);
#define PI_CL(t) ((t) < T ? (t) : T - 1)
    int I1[16], I2[16]; v4u xh0, xl0, xh1, xl1, xh2, xl2, RA[16], RB[16];
    PI_LOADIDS(I1, q); PI_LOADX(xh0, xl0, q);
    PI_LOADROWS16(RA, PUr, I1);
    PI_LOADIDS(I1, PI_CL(q + stride)); PI_LOADX(xh1, xl1, PI_CL(q + stride));
    for (int t = q; t < T; t += 2 * stride) {
        PI_LOADROWS16(RB, PUr, I1);
        PI_LOADIDS(I2, PI_CL(t + 2 * stride)); PI_LOADX(xh2, xl2, PI_CL(t + 2 * stride));
        PI_COMPUTE16(RA, xh0, xl0, t);
        PI_LOADROWS16(RA, PUr, I2);
        PI_LOADIDS(I1, PI_CL(t + 3 * stride)); PI_LOADX(xh0, xl0, PI_CL(t + 3 * stride));
        PI_COMPUTE16(RB, xh1, xl1, t + stride);
        xh1 = xh0; xl1 = xl0; xh0 = xh2; xl0 = xl2;
    }
#undef PI_CL
}


constexpr float PV_SCALE4S = 5.65f;
__device__ __forceinline__ unsigned enc_e2m1s(float v) {
    const float a = fabsf(v);
    const unsigned code = a < 0.25f ? 0u : a < 0.75f ? 1u : a < 1.25f ? 2u : a < 1.75f ? 3u : a < 2.5f ? 4u : a < 3.5f ? 5u : a < 5.0f ? 6u : 7u;
    return code | (v < 0.f ? 8u : 0u);
}
__device__ __forceinline__ void convert_fp4_plain(const float* src, unsigned char* dst, int nrows, float scale, const float* gain, int gw, int NGW, int lane) {
    for (int r0 = 2 * gw; r0 < nrows; r0 += 2 * NGW) {
        f32x4 a[2][8];
#pragma unroll
        for (int q = 0; q < 2; ++q) { const float* sp = src + (size_t)(r0 + q) * DM + 4 * lane;
#pragma unroll
            for (int j = 0; j < 8; ++j) a[q][j] = *(const GAS f32x4*)(sp + 256 * j); }
#pragma unroll
        for (int q = 0; q < 2; ++q) { const int r = r0 + q; const float* gp = gain ? gain + (size_t)(r / PEER_N) * DM + 4 * lane : nullptr;
#pragma unroll
            for (int j = 0; j < 8; ++j) { f32x4 v = a[q][j] * scale; if (gp) v = v * *(const GAS f32x4*)(gp + 256 * j);
                const unsigned w = enc_e2m1s(v[0]) | (enc_e2m1s(v[1]) << 4) | (enc_e2m1s(v[2]) << 8) | (enc_e2m1s(v[3]) << 12);
                *(GAS unsigned short*)(dst + (size_t)r * 1024 + 128 * j + 2 * lane) = (unsigned short)w; } }
    }
}
#define PVS_LOADMETA(ids, pp, gg, t) do { PI_LOADIDS(ids, t); _Pragma("unroll") for (int sp_ = 0; sp_ < 8; ++sp_) pp[sp_] = *(const GAS v2u*)(PARTI + ((size_t)sp_ * T + (t)) * 128 + 2 * lane); \
        gg = *(const GAS f32x2*)(PGATE + (size_t)(t) * 128 + 2 * lane); } while (0)
#define PVS_COMPUTE16(buf, pp, gg, t) do { float w0, w1; { int s0_ = 0, s1_ = 0; _Pragma("unroll") for (int sp_ = 0; sp_ < 8; ++sp_) { s0_ += (int)pp[sp_].x; s1_ += (int)pp[sp_].y; } \
            const float d0_ = (float)s0_ * (1.f / (PX_SCALEI * PU_SCALEI)), d1_ = (float)s1_ * (1.f / (PX_SCALEI * PU_SCALEI)); \
            w0 = gg.x * 0.5f * d0_ * (1.f + erff(d0_ * 0.70710678118654752f)) * (1.f / PV_SCALE4S); w1 = gg.y * 0.5f * d1_ * (1.f + erff(d1_ * 0.70710678118654752f)) * (1.f / PV_SCALE4S); } \
        f32x2 y[16]; _Pragma("unroll") for (int i_ = 0; i_ < 16; ++i_) y[i_] = (f32x2){0.f, 0.f}; \
        _Pragma("unroll") for (int i_ = 0; i_ < 16; ++i_) { \
            const float w_ = __builtin_bit_cast(float, __builtin_amdgcn_ds_bpermute(((lane & 56) | (i_ >> 1)) << 2, __builtin_bit_cast(int, (i_ & 1) ? w1 : w0))); const f32x2 wv_ = {w_, w_}; \
            _Pragma("unroll") for (int c_ = 0; c_ < 4; ++c_) { const unsigned u_ = buf[i_][c_]; \
                y[4 * c_ + 0] += __builtin_amdgcn_cvt_scalef32_pk_f32_fp4(u_, 1.0f, 0) * wv_; y[4 * c_ + 1] += __builtin_amdgcn_cvt_scalef32_pk_f32_fp4(u_, 1.0f, 1) * wv_; \
                y[4 * c_ + 2] += __builtin_amdgcn_cvt_scalef32_pk_f32_fp4(u_, 1.0f, 2) * wv_; y[4 * c_ + 3] += __builtin_amdgcn_cvt_scalef32_pk_f32_fp4(u_, 1.0f, 3) * wv_; } } \
        {   LAS float* wp_ = yl + g * 288 + m * 36; \
            _Pragma("unroll") for (int c_ = 0; c_ < 8; ++c_) *(LAS f32x4*)(wp_ + 4 * c_) = (f32x4){y[2 * c_].x, y[2 * c_].y, y[2 * c_ + 1].x, y[2 * c_ + 1].y}; \
            LDS_WAIT(); asm volatile("" ::: "memory"); \
            f32x4 acc_ = {0.f, 0.f, 0.f, 0.f}; const LAS float* rp_ = yl + (lane >> 3) * 36 + 4 * (lane & 7); \
            _Pragma("unroll") for (int gg_ = 0; gg_ < 8; ++gg_) acc_ += *(const LAS f32x4*)(rp_ + gg_ * 288); \
            LDS_WAIT(); asm volatile("" ::: "memory"); \
            if ((t) < T) { bf16* xp_ = XN + (size_t)(t) * DM + 256 * s + 4 * lane; const v2u a_ = *(const GAS v2u*)xp_; \
                const f32x4 v_ = (f32x4){bflo(a_.x), bfhi(a_.x), bflo(a_.y), bfhi(a_.y)} + acc_; \
                *(GAS v2u*)xp_ = (v2u){pk2(v_[0], v_[1]), pk2(v_[2], v_[3])}; \
                if (Xout) *(GAS f32x4*)(Xout + (size_t)(t) * DM + 256 * s + 4 * lane) = v_; \
                if (rowsq_out) { const float ss_ = wave_sum((v_[0] * v_[0] + v_[1] * v_[1]) + (v_[2] * v_[2] + v_[3] * v_[3]), lane); if (lane == 0) atomicAdd(rowsq_out + (t), rowsq_fx(ss_)); } } } } while (0)
__device__ __forceinline__ void peer_v_phase_s(bf16* XN, const unsigned char* PV, const int* PIDX, const float* PGATE, const int* PARTI, float* Xout, u64_t* rowsq_out, LAS float* yl, int bid, int G, int wave, int lane) {
    const int s = bid & 7, nr = (G - s + 7) >> 3, q = (bid >> 3) * NWAVES + wave, stride = nr * NWAVES, g = lane >> 3, m = lane & 7;
    const unsigned soff = 128u * (unsigned)s + 16u * (unsigned)m;
    if (q >= T) return;
    const __amdgpu_buffer_rsrc_t PVr = __builtin_amdgcn_make_buffer_rsrc((void*)PV, 0, PEER_N * 1024, 0x00020000);
#define PVS_CL(t) ((t) < T ? (t) : T - 1)
    int I0[16], I1[16]; v2u P0[8], P1[8]; f32x2 G0, G1; v4u RA[16], RB[16];
#define PVS_LOADPG(pp, gg, t) do { _Pragma("unroll") for (int sp_ = 0; sp_ < 8; ++sp_) pp[sp_] = *(const GAS v2u*)(PARTI + ((size_t)sp_ * T + (t)) * 128 + 2 * lane); gg = *(const GAS f32x2*)(PGATE + (size_t)(t) * 128 + 2 * lane); } while (0)
    PI_LOADIDS(I0, q); PVS_LOADPG(P0, G0, q);
    PI_LOADROWS16(RA, PVr, I0);
    PI_LOADIDS(I1, PVS_CL(q + stride)); PVS_LOADPG(P1, G1, PVS_CL(q + stride));
    for (int t = q; t < T; t += 2 * stride) {
        PI_LOADROWS16(RB, PVr, I1);
        PI_LOADIDS(I0, PVS_CL(t + 2 * stride));
        PVS_COMPUTE16(RA, P0, G0, t);
        PVS_LOADPG(P0, G0, PVS_CL(t + 2 * stride));
        PI_LOADROWS16(RA, PVr, I0);
        PI_LOADIDS(I1, PVS_CL(t + 3 * stride));
        PVS_COMPUTE16(RB, P1, G1, t + stride);
        PVS_LOADPG(P1, G1, PVS_CL(t + 3 * stride));
    }
#undef PVS_LOADPG
#undef PVS_CL
}

typedef short s16x4 __attribute__((ext_vector_type(4)));
typedef __attribute__((address_space(3))) const char* lds_cptr;
__device__ __forceinline__ s16x4 vtr(lds_cptr p) { return __builtin_bit_cast(s16x4, __builtin_amdgcn_ds_read_tr16_b64_v4i16((__attribute__((address_space(3))) s16x4*)p)); }
__device__ __forceinline__ unsigned cvtpk(float lo, float hi) { unsigned r; asm("v_cvt_pk_bf16_f32 %0, %1, %2" : "=v"(r) : "v"(lo), "v"(hi)); return r; }
constexpr int AT_K0 = 0, AT_V0 = 16384, AT_TAB = 32768;
constexpr float LOG2E = 1.4426950408889634f;
template <int TYPE>
__device__ __forceinline__ void attn_unit(LAS unsigned char* lds, const bf16* QKV, bf16* ATT, u64_t* mixsq, int b, int head, int qb, const float* tabsrc, float Cl2, float sinkl2, int tid) {
    const int lane = tid & 63, w = __builtin_amdgcn_readfirstlane(tid >> 6), hh = lane >> 5, l31 = lane & 31;
    int qcol, kcol, vcol, ocol;
    if (TYPE == 0) { qcol = QA + head * 64; kcol = KA + (head / 3) * 64; vcol = VA + (head / 3) * 64; ocol = OA + head * 64; }
    else if (TYPE == 1) { qcol = QB + head * 64; kcol = KB + head * 64; vcol = VB + head * 64; ocol = OB + head * 64; }
    else { qcol = QC + head * 64; kcol = KC + (head / 3) * 64; vcol = VC + (head / 3) * 64; ocol = OC + head * 64; }
    const int q0 = 256 * qb + 32 * w, qpos = q0 + l31;
    int t_begin, t_end;
    if (TYPE == 0) { t_begin = 4 * qb - 2; if (t_begin < 0) t_begin = 0; t_end = 4 * qb + 6; if (t_end > 32) t_end = 32; }
    else if (TYPE == 1) { int a = 4 * qb - 4; a = a < 0 ? 0 : (a > 24 ? 24 : a); int e = 4 * qb - 1; e = e < 0 ? 0 : (e > 24 ? 24 : e); t_begin = a; t_end = e + 8; }
    else { t_begin = 0; t_end = 32; }
    LAS float* tab = (LAS float*)(lds + AT_TAB);
    if (TYPE == 0) { for (int i = tid; i < 1024; i += NTHREADS) { const int rel = i - 448; tab[i] = (rel >= -128 && rel <= 128) ? tabsrc[head * 257 + rel + 128] * LOG2E - Cl2 : -1e30f; } }
    if (TYPE == 1) { for (int i = tid; i < 15 * 31; i += NTHREADS) tab[i] = tabsrc[head * 465 + i] * LOG2E - Cl2; }
    bf16x8 qf[4];
    {   const bf16* qp = QKV + ((size_t)b * SEQ + qpos) * DIN + qcol + 8 * hh;
#pragma unroll
        for (int s = 0; s < 4; ++s) qf[s] = *(const GAS bf16x8*)(qp + 16 * s); }
    const int srow = tid >> 3, sch = tid & 7;
    const bf16* kg = QKV + ((size_t)b * SEQ + srow) * DIN + kcol + sch * 8;
    const bf16* vg = QKV + ((size_t)b * SEQ + srow) * DIN + vcol + sch * 8;
    const int kst = srow * 128 + ((sch ^ ((srow >> 1) & 7)) * 16);
    const int vst = srow * 128 + (((sch >> 2) ^ ((srow >> 1) & 1)) * 64) + (sch & 3) * 16;
    int kread[4], vread[2];
#pragma unroll
    for (int s = 0; s < 4; ++s) kread[s] = l31 * 128 + (((2 * s + hh) ^ ((lane >> 1) & 7)) * 16);
#pragma unroll
    for (int db = 0; db < 2; ++db) vread[db] = (4 * hh + ((lane >> 2) & 3)) * 128 + ((db ^ ((lane >> 3) & 1)) * 64) + 32 * ((lane >> 4) & 1) + 8 * (lane & 3);
    f32x16 O0, O1;
#pragma unroll
    for (int r = 0; r < 16; ++r) { O0[r] = 0.f; O1[r] = 0.f; }
    float lsum = 0.f;
    const int rw = 4 * qb + (w >> 1), cq = 32 * (w & 1) + l31;
    int r0w = rw - 4; r0w = r0w < 0 ? 0 : (r0w > 24 ? 24 : r0w);
    int c0 = cq - 8; c0 = c0 < 0 ? 0 : (c0 > 48 ? 48 : c0);
    {   const v4u kr = *(const GAS v4u*)(kg + (size_t)t_begin * 64 * DIN), vr = *(const GAS v4u*)(vg + (size_t)t_begin * 64 * DIN);
        *(LAS v4u*)(lds + AT_K0 + kst) = kr; *(LAS v4u*)(lds + AT_V0 + vst) = vr; }
    __syncthreads();
    for (int t = t_begin; t < t_end; ++t) {
        const int cur = (t - t_begin) & 1;
        v4u kr, vr;
        if (t + 1 < t_end) { kr = *(const GAS v4u*)(kg + (size_t)(t + 1) * 64 * DIN); vr = *(const GAS v4u*)(vg + (size_t)(t + 1) * 64 * DIN); }
        bool need = true;
        if (TYPE == 0) need = (64 * t <= q0 + 31 + 128) && (64 * t + 63 >= q0 - 128);
        if (TYPE == 1) need = (t >= r0w) && (t < r0w + 8);
        if (need) {
            const lds_cptr kb_ = (lds_cptr)(lds + AT_K0 + cur * 8192), vb_ = (lds_cptr)(lds + AT_V0 + cur * 8192);
            bf16x8 kf[8];
#pragma unroll
            for (int s = 0; s < 4; ++s) { kf[2 * s] = *(const LAS bf16x8*)(kb_ + kread[s]); kf[2 * s + 1] = *(const LAS bf16x8*)(kb_ + kread[s] + 4096); }
            f32x16 S0, S1;
            if (TYPE == 2) {
#pragma unroll
                for (int r = 0; r < 16; ++r) { S0[r] = -Cl2; S1[r] = -Cl2; }
            } else if (TYPE == 0) {
                const LAS float* tb = tab + (64 * t - qpos + 448 + 4 * hh);
#pragma unroll
                for (int r = 0; r < 16; ++r) { S0[r] = tb[8 * (r >> 2) + (r & 3)]; S1[r] = tb[32 + 8 * (r >> 2) + (r & 3)]; }
            } else {
                const LAS float* tb = tab + ((t - rw + 7) * 31 - cq + 15 + 4 * hh);
                const int kc0 = 4 * hh - c0;
#pragma unroll
                for (int r = 0; r < 16; ++r) { const int ka = 8 * (r >> 2) + (r & 3), kb2 = 32 + ka;
                    S0[r] = ((unsigned)(ka + kc0) < 16u) ? tb[ka] : -1e30f; S1[r] = ((unsigned)(kb2 + kc0) < 16u) ? tb[kb2] : -1e30f; }
            }
            __builtin_amdgcn_sched_barrier(0);
#pragma unroll
            for (int s = 0; s < 4; ++s) { S0 = __builtin_amdgcn_mfma_f32_32x32x16_bf16(kf[2 * s], qf[s], S0, 0, 0, 0); S1 = __builtin_amdgcn_mfma_f32_32x32x16_bf16(kf[2 * s + 1], qf[s], S1, 0, 0, 0); }
            s16x4 vf[4][2][2];
#pragma unroll
            for (int ks = 0; ks < 2; ++ks)
#pragma unroll
                for (int db = 0; db < 2; ++db) { vf[ks][db][0] = vtr(vb_ + vread[db] + (16 * ks) * 128); vf[ks][db][1] = vtr(vb_ + vread[db] + (16 * ks + 8) * 128); }
            __builtin_amdgcn_sched_barrier(0);
#pragma unroll
            for (int r = 0; r < 16; ++r) { S0[r] = __builtin_amdgcn_exp2f(S0[r]); S1[r] = __builtin_amdgcn_exp2f(S1[r]); }
#pragma unroll
            for (int r = 0; r < 16; ++r) lsum += S0[r] + S1[r];
            bf16x8 pb[4];
#pragma unroll
            for (int hf = 0; hf < 2; ++hf) {
                v4u a, c;
#pragma unroll
                for (int j = 0; j < 4; ++j) { a[j] = cvtpk(S0[8 * hf + 2 * j], S0[8 * hf + 2 * j + 1]); c[j] = cvtpk(S1[8 * hf + 2 * j], S1[8 * hf + 2 * j + 1]); }
                pb[hf] = __builtin_bit_cast(bf16x8, a); pb[2 + hf] = __builtin_bit_cast(bf16x8, c);
            }
#pragma unroll
            for (int ks = 2; ks < 4; ++ks)
#pragma unroll
                for (int db = 0; db < 2; ++db) { vf[ks][db][0] = vtr(vb_ + vread[db] + (16 * ks) * 128); vf[ks][db][1] = vtr(vb_ + vread[db] + (16 * ks + 8) * 128); }
            __builtin_amdgcn_sched_barrier(0);
#pragma unroll
            for (int ks = 0; ks < 4; ++ks) {
                const bf16x8 va = __builtin_shufflevector(vf[ks][0][0], vf[ks][0][1], 0, 1, 2, 3, 4, 5, 6, 7), vb2 = __builtin_shufflevector(vf[ks][1][0], vf[ks][1][1], 0, 1, 2, 3, 4, 5, 6, 7);
                O0 = __builtin_amdgcn_mfma_f32_32x32x16_bf16(va, pb[ks], O0, 0, 0, 0); O1 = __builtin_amdgcn_mfma_f32_32x32x16_bf16(vb2, pb[ks], O1, 0, 0, 0);
            }
        }
        __builtin_amdgcn_sched_barrier(0);
        if (t + 1 < t_end) { *(LAS v4u*)(lds + AT_K0 + (cur ^ 1) * 8192 + kst) = kr; *(LAS v4u*)(lds + AT_V0 + (cur ^ 1) * 8192 + vst) = vr; }
        __syncthreads();
    }
    lsum += shx(lsum, 32, lane);
    if (TYPE == 0) lsum += __builtin_amdgcn_exp2f(sinkl2 - Cl2);
    const float inv = 1.f / lsum;
    {   float ss = 0.f;
#pragma unroll
        for (int r = 0; r < 16; ++r) { const float a = O0[r] * inv, c = O1[r] * inv; ss += a * a + c * c; }
        ss += shx(ss, 32, lane);
        if (hh == 0) (void)__hip_atomic_fetch_add((GAS u64_t*)(mixsq + (size_t)b * SEQ + qpos), rowsq_fx(ss), __ATOMIC_RELAXED, __HIP_MEMORY_SCOPE_AGENT); }
    bf16* op = ATT + ((size_t)b * SEQ + qpos) * DM + ocol + 4 * hh;
#pragma unroll
    for (int g4 = 0; g4 < 4; ++g4) {
        v2u o0, o1; o0.x = cvtpk(O0[4 * g4] * inv, O0[4 * g4 + 1] * inv); o0.y = cvtpk(O0[4 * g4 + 2] * inv, O0[4 * g4 + 3] * inv);
        o1.x = cvtpk(O1[4 * g4] * inv, O1[4 * g4 + 1] * inv); o1.y = cvtpk(O1[4 * g4 + 2] * inv, O1[4 * g4 + 3] * inv);
        *(GAS v2u*)(op + 8 * g4) = o0; *(GAS v2u*)(op + 32 + 8 * g4) = o1;
    }
}


constexpr int MA_K0 = 0, MA_V0 = 32768;
__device__ __forceinline__ void mem_unit(LAS unsigned char* lds, const bf16* QM, const bf16* KVM, bf16* OM, const float* gq, int tb, int head, float Cl2, int tid) {
    const int lane = tid & 63, w = __builtin_amdgcn_readfirstlane(tid >> 6), hh = lane >> 5, l31 = lane & 31;
    const size_t trow = (size_t)tb * 256 + 32 * w + l31; const int b = tb >> 3;
    bf16x8 qf[8];
    {   const bf16* qp = QM + trow * MEMW + head * 128 + 8 * hh;
#pragma unroll
        for (int s = 0; s < 8; ++s) qf[s] = *(const GAS bf16x8*)(qp + 16 * s);
        float ss = 0.f;
#pragma unroll
        for (int s = 0; s < 8; ++s)
#pragma unroll
            for (int j = 0; j < 8; ++j) { const float f = __builtin_bit_cast(float, (unsigned)(unsigned short)qf[s][j] << 16); ss += f * f; }
        ss += shx(ss, 32, lane);
        const float r = 0.12751743074602468f / sqrtf(ss * (1.f / 128.f) + EPS);
#pragma unroll
        for (int s = 0; s < 8; ++s) { const f32x4 g0 = *(const GAS f32x4*)(gq + 16 * s + 8 * hh), g1 = *(const GAS f32x4*)(gq + 16 * s + 8 * hh + 4);
            v4u o;
#pragma unroll
            for (int j = 0; j < 4; ++j) { const float f0 = __builtin_bit_cast(float, (unsigned)(unsigned short)qf[s][2 * j] << 16), f1 = __builtin_bit_cast(float, (unsigned)(unsigned short)qf[s][2 * j + 1] << 16);
                const float ga = (2 * j < 4) ? g0[2 * j] : g1[2 * j - 4], gb2 = (2 * j + 1 < 4) ? g0[2 * j + 1] : g1[2 * j + 1 - 4];
                o[j] = cvtpk(f0 * r * ga, f1 * r * gb2); }
            qf[s] = __builtin_bit_cast(bf16x8, o); }
    }
    const int srow = tid >> 3, sch = tid & 7;
    const bf16* kg = KVM + ((size_t)b * NMEM + srow) * 1024 + head * 128 + sch * 8;
    const bf16* vg = kg + 512;
    const int kst0 = srow * 256 + ((sch ^ (srow & 15)) * 16), kst1 = srow * 256 + (((sch + 8) ^ (srow & 15)) * 16);
    const int vst0 = srow * 256 + ((((sch) >> 2) ^ (srow & 3)) * 64) + (sch & 3) * 16, vst1 = srow * 256 + ((((sch + 8) >> 2) ^ (srow & 3)) * 64) + (sch & 3) * 16;
    int kread[8], vread[4];
#pragma unroll
    for (int s = 0; s < 8; ++s) kread[s] = l31 * 256 + (((2 * s + hh) ^ (l31 & 15)) * 16);
#pragma unroll
    for (int db = 0; db < 4; ++db) vread[db] = (4 * hh + ((lane >> 2) & 3)) * 256 + ((db ^ ((lane >> 2) & 3)) * 64) + 32 * ((lane >> 4) & 1) + 8 * (lane & 3);
    f32x16 O[4];
#pragma unroll
    for (int db = 0; db < 4; ++db)
#pragma unroll
        for (int r = 0; r < 16; ++r) O[db][r] = 0.f;
    float lsum = 0.f;
    {   const v4u k0 = *(const GAS v4u*)kg, k1 = *(const GAS v4u*)(kg + 64), v0 = *(const GAS v4u*)vg, v1 = *(const GAS v4u*)(vg + 64);
        *(LAS v4u*)(lds + MA_K0 + kst0) = k0; *(LAS v4u*)(lds + MA_K0 + kst1) = k1; *(LAS v4u*)(lds + MA_V0 + vst0) = v0; *(LAS v4u*)(lds + MA_V0 + vst1) = v1; }
    __syncthreads();
#pragma unroll 1
    for (int t = 0; t < 4; ++t) {
        const int cur = t & 1;
        v4u k0, k1, v0, v1;
        if (t + 1 < 4) { const bf16* kn = kg + (size_t)(t + 1) * 64 * 1024; k0 = *(const GAS v4u*)kn; k1 = *(const GAS v4u*)(kn + 64); v0 = *(const GAS v4u*)(kn + 512); v1 = *(const GAS v4u*)(kn + 576); }
        const lds_cptr kb_ = (lds_cptr)(lds + MA_K0 + cur * 16384), vb_ = (lds_cptr)(lds + MA_V0 + cur * 16384);
        f32x16 S0, S1;
#pragma unroll
        for (int r = 0; r < 16; ++r) { S0[r] = -Cl2; S1[r] = -Cl2; }
#pragma unroll
        for (int s = 0; s < 8; ++s) { const bf16x8 a0 = *(const LAS bf16x8*)(kb_ + kread[s]), a1 = *(const LAS bf16x8*)(kb_ + kread[s] + 8192);
            S0 = __builtin_amdgcn_mfma_f32_32x32x16_bf16(a0, qf[s], S0, 0, 0, 0); S1 = __builtin_amdgcn_mfma_f32_32x32x16_bf16(a1, qf[s], S1, 0, 0, 0); }
#pragma unroll
        for (int r = 0; r < 16; ++r) { S0[r] = __builtin_amdgcn_exp2f(S0[r]); S1[r] = __builtin_amdgcn_exp2f(S1[r]); lsum += S0[r] + S1[r]; }
        bf16x8 pb[4];
#pragma unroll
        for (int hf = 0; hf < 2; ++hf) {
            v4u a, c;
#pragma unroll
            for (int j = 0; j < 4; ++j) { a[j] = cvtpk(S0[8 * hf + 2 * j], S0[8 * hf + 2 * j + 1]); c[j] = cvtpk(S1[8 * hf + 2 * j], S1[8 * hf + 2 * j + 1]); }
            pb[hf] = __builtin_bit_cast(bf16x8, a); pb[2 + hf] = __builtin_bit_cast(bf16x8, c);
        }
#pragma unroll
        for (int ks = 0; ks < 4; ++ks)
#pragma unroll
            for (int db = 0; db < 4; ++db) {
                const s16x4 a0 = vtr(vb_ + vread[db] + (16 * ks) * 256), a1 = vtr(vb_ + vread[db] + (16 * ks + 8) * 256);
                const bf16x8 va = __builtin_shufflevector(a0, a1, 0, 1, 2, 3, 4, 5, 6, 7);
                O[db] = __builtin_amdgcn_mfma_f32_32x32x16_bf16(va, pb[ks], O[db], 0, 0, 0);
            }
        if (t + 1 < 4) { LAS unsigned char* kn = lds + MA_K0 + (cur ^ 1) * 16384; LAS unsigned char* vn = lds + MA_V0 + (cur ^ 1) * 16384;
            *(LAS v4u*)(kn + kst0) = k0; *(LAS v4u*)(kn + kst1) = k1; *(LAS v4u*)(vn + vst0) = v0; *(LAS v4u*)(vn + vst1) = v1; }
        __syncthreads();
    }
    lsum += shx(lsum, 32, lane);
    const float inv = 1.f / lsum;
    bf16* op = OM + trow * MEMW + head * 128 + 4 * hh;
#pragma unroll
    for (int db = 0; db < 4; ++db)
#pragma unroll
        for (int g4 = 0; g4 < 4; ++g4) { v2u o; o.x = cvtpk(O[db][4 * g4] * inv, O[db][4 * g4 + 1] * inv); o.y = cvtpk(O[db][4 * g4 + 2] * inv, O[db][4 * g4 + 3] * inv); *(GAS v2u*)(op + 32 * db + 8 * g4) = o; }
}

__device__ __forceinline__ float wave_max(float v, int lane) {
#pragma unroll
    for (int o = 1; o < 64; o <<= 1) v = fmaxf(v, shx(v, o, lane));
    return v;
}
struct Args { const float* in[23]; float* out; unsigned char* ws; int ph_lo, ph_hi, use_bar, pad; };
#ifndef MK_OFF
#define MK_OFF 0u
#endif
#ifndef REP_ATT
#define REP_ATT 1
#endif
#ifndef REP_P0
#define REP_P0 1
#endif
#ifndef REP_U
#define REP_U 1
#endif
#ifndef REP_GEMM
#define REP_GEMM 1
#endif
#ifndef REP_NORM
#define REP_NORM 1
#endif
#ifndef REP_SEL
#define REP_SEL 1
#endif
#ifndef REP_MEM
#define REP_MEM 1
#endif
#define PHON(k) (!((MK_OFF >> (k)) & 1u))
constexpr int PH_PER_LAYER = 8, PH_BASE = 2, N_PHASES = PH_BASE + DEPTH * PH_PER_LAYER;
constexpr int PTAB_OFF = LDSCTL_OFF + 1024;

__global__ void __launch_bounds__(NTHREADS, 2) mega(Args a) {
    extern __shared__ __attribute__((aligned(16))) unsigned char lds_raw[];
    LAS unsigned char* lds = (LAS unsigned char*)lds_raw;
    {   const int tid0 = threadIdx.x;
        for (int u = tid0; u < (LDS_BYTES - LDSCTL_OFF) / 4; u += NTHREADS) ((LAS unsigned*)(lds + LDSCTL_OFF))[u] = 0u;
        __syncthreads();
        if (tid0 < 23) ((LAS unsigned long long*)(lds + PTAB_OFF))[tid0] = (unsigned long long)a.in[tid0];
        if (tid0 == 23) ((LAS unsigned long long*)(lds + PTAB_OFF))[23] = (unsigned long long)a.out;
        if (tid0 == 24) ((LAS unsigned long long*)(lds + PTAB_OFF))[24] = (unsigned long long)a.ws;
        __syncthreads();
    }
    volatile LAS unsigned* MISC = (volatile LAS unsigned*)(lds + MISC_OFF);
    const int G = gridDim.x, bid = blockIdx.x, NGW = G * NWAVES;
    const int use_bar = a.use_bar;
    XcdBarrier bar; bar.bar = (unsigned*)(a.ws + WS_CTL) + CW_BAR; bar.x = 0; bar.st = MISC + 8;
    if (use_bar) bar = xcd_barrier_post((unsigned*)(a.ws + WS_CTL) + CW_BAR, MISC + 8);
    const int lo = a.ph_lo, hi = a.ph_hi;
#define IN(k) (lo <= (k) && (k) < hi)
#define SEAM(k) do { if (use_bar && IN(k) && IN((k) + 1)) xcd_barrier(bar); } while (0)
#define PHL() int tid_ = threadIdx.x; asm volatile("" : "+v"(tid_)); const int lane_ = tid_ & 63, wave_ = __builtin_amdgcn_readfirstlane(tid_ >> 6), gw_ = bid * NWAVES + wave_; (void)lane_; (void)gw_; \
              int pz_ = 0; asm volatile("" : "+s"(pz_))
#define PTR(i) ((const float*)ldptr(lds, (i) + pz_))
#define WSP() ((unsigned char*)ldptr(lds, 24 + pz_))
#define OUTP() ((float*)ldptr(lds, 23 + pz_))

    if (IN(0) && PHON(0)) {
        PHL(); unsigned char* ws = WSP();
        LAS float* scr = (LAS float*)(lds + RING_OFF + wave_ * 16384);
        constexpr int I_IN = 32 * 128, I_OUT = 32 * 64, I_MQ = 32 * 16, I_MKV = 32 * 32, I_MO = 8 * 64, I_PQ = 32 * 64, I_L = I_IN + I_OUT + I_MQ + I_MKV + I_MO + I_PQ;
        for (int it = gw_; it < DEPTH * I_L; it += NGW) {
            const int l = it / I_L; int r = it % I_L;
            if (r < I_IN) { transpose_item<true>(PTR(4) + (size_t)l * DM * DIN, DM, DIN, (bf16*)(ws + WS_WIN) + (size_t)l * DIN * DM, scr, r, lane_, PTR(3) + (size_t)l * DM); continue; } r -= I_IN;
            if (r < I_OUT) { transpose_item<false>(PTR(11) + (size_t)l * DM * DM, DM, DM, (bf16*)(ws + WS_WOUT) + (size_t)l * DM * DM, scr, r, lane_, PTR(10) + (size_t)l * DM); continue; } r -= I_OUT;
            if (r < I_MQ) { transpose_item<false>(PTR(14) + (size_t)l * DM * MEMW, DM, MEMW, (bf16*)(ws + WS_WMQ) + (size_t)l * MEMW * DM, scr, r, lane_, PTR(12) + (size_t)l * DM); continue; } r -= I_MQ;
            if (r < I_MKV) { transpose_item<false>(PTR(15) + (size_t)l * DM * 1024, DM, 1024, (bf16*)(ws + WS_WMKV) + (size_t)l * 1024 * DM, scr, r, lane_); continue; } r -= I_MKV;
            if (r < I_MO) { transpose_item<false>(PTR(17) + (size_t)l * MEMW * DM, MEMW, DM, (bf16*)(ws + WS_WMO) + (size_t)l * DM * MEMW, scr, r, lane_); continue; } r -= I_MO;
            transpose_item<false>(PTR(19) + (size_t)l * DM * DM, DM, DM, (bf16*)(ws + WS_WPQ) + (size_t)l * DM * DM, scr, r, lane_, PTR(18) + (size_t)l * DM);
        }
        const size_t gtid = (size_t)bid * NTHREADS + tid_, nth = (size_t)G * NTHREADS;
        convert_bf16(PTR(20), (bf16*)(ws + WS_PKEYS), (size_t)DEPTH * 8 * 2 * 128 * 128, gtid, nth);
        convert_int4_plain(PTR(21), ws + WS_PU, DEPTH * PEER_N, PU_SCALEI, PTR(18), gw_, NGW, lane_);
        convert_fp4_rows(PTR(22), ws + WS_PV, PEER_N, PV_SCALE4, nullptr, gw_, NGW, lane_);
        {   const float* x0 = PTR(0); bf16* XN = (bf16*)(ws + WS_XN); u64_t* rsq = (u64_t*)(ws + WS_ROWSQ);
            for (int m = 2 * gw_; m < T; m += 2 * NGW) prep_rows2(x0 + (size_t)m * DM, XN + (size_t)m * DM, rsq + m, lane_); }
        {   const float* mem = PTR(1); const float* gkv = PTR(13); bf16* MEMN = (bf16*)(ws + WS_MEMN);
            for (int m = gw_; m < BATCH * NMEM; m += NGW)
                rms_row_to_bf16(mem + (size_t)m * DM, gkv, MEMN + (size_t)m * DM, gkv + DM, MEMN + (size_t)(BATCH * NMEM + m) * DM, lane_); }
        float* rope = (float*)(ws + WS_ROPE); float* biasA = (float*)(ws + WS_BIASA);
        if (gtid < 64 * 16) { const int pos = (int)gtid >> 4, i = (int)gtid & 15; const float ang = (float)pos * ROPE_INV[i]; rope[gtid * 2] = cosf(ang); rope[gtid * 2 + 1] = sinf(ang); }
        if (gtid < 12 * 257) { const int h = (int)gtid / 257, rel = (int)gtid % 257 - 128; biasA[gtid] = PTR(2)[t5_bucket(rel) * 12 + h]; }
    }
    SEAM(0);
    if (IN(1) && PHON(1)) {
#pragma unroll 1
        for (int l = 0; l < DEPTH; ++l) {
            PHL(); unsigned char* ws = WSP();
            pg8::Gemm g{(bf16*)(ws + WS_MEMN) + (size_t)l * BATCH * NMEM * DM, (bf16*)(ws + WS_WMKV) + (size_t)l * 1024 * DM, BATCH * NMEM, 1024, DM};
            OffsetOrder S; S.init(BATCH * NMEM, 1024, G, bid, 64 * l);
            bf16* KVMl = (bf16*)(ws + WS_KVM) + (size_t)l * BATCH * NMEM * 1024;
            pg8::EpiBf16<0> E{KVMl, 1024, nullptr, 0, 0, 1.f};
            pg8::gemm_phase<pg8::EpiBf16<0>, OffsetOrder, true, true>(lds + RING_OFF, g, S, E, tid_);
            VM_WAIT(); __syncthreads();
            const float* gk = PTR(16) + (size_t)l * 256 + 128;
#pragma unroll 1
            for (int i = 0; i < 4; ++i) { pg8::Unit uu; uu.pm = 0; uu.pn = 0; if (!S.next(i, uu)) break;
                if (uu.pn < 2) {
                    for (int r2 = wave_; r2 < 128; r2 += NWAVES) { const int row = uu.pm * 256 + 2 * r2 + (lane_ >> 5), cl = lane_ & 31;
                        GAS v4u* p = (GAS v4u*)(KVMl + (size_t)row * 1024 + 256 * uu.pn + 8 * cl);
                        const v4u w = *p;
                        float f[8] = {bflo(w.x), bfhi(w.x), bflo(w.y), bfhi(w.y), bflo(w.z), bfhi(w.z), bflo(w.w), bfhi(w.w)};
                        float ss = 0.f;
#pragma unroll
                        for (int e = 0; e < 8; ++e) ss += f[e] * f[e];
                        ss += shx(ss, 1, lane_); ss += shx(ss, 2, lane_); ss += shx(ss, 4, lane_); ss += shx(ss, 8, lane_);
                        const float r = 1.f / sqrtf(ss * (1.f / 128.f) + EPS);
                        const float* gg = gk + 8 * (cl & 15);
                        v4u o; o.x = pk2(f[0] * r * gg[0], f[1] * r * gg[1]); o.y = pk2(f[2] * r * gg[2], f[3] * r * gg[3]); o.z = pk2(f[4] * r * gg[4], f[5] * r * gg[5]); o.w = pk2(f[6] * r * gg[6], f[7] * r * gg[7]);
                        *p = o; } } }
            __syncthreads();
        }
        if (G >= 256 && bid >= 128) { PHL(); unsigned char* ws = WSP();
            convert_fp4_rows(PTR(22) + (size_t)PEER_N * DM, ws + WS_PV + (size_t)PEER_N * 1024, PEER_N, PV_SCALE4, nullptr, (bid - 128) * NWAVES + wave_, (G - 128) * NWAVES, lane_); }
        else if (G < 256) { PHL(); unsigned char* ws = WSP(); convert_fp4_rows(PTR(22) + (size_t)PEER_N * DM, ws + WS_PV + (size_t)PEER_N * 1024, PEER_N, PV_SCALE4, nullptr, gw_, NGW, lane_); }
    }
    SEAM(1);

#pragma unroll 1
    for (int l = 0; l < DEPTH; ++l) {
        const int pb = PH_BASE + PH_PER_LAYER * l;
        if (IN(pb + 0) && PHON(3)) { PHL(); unsigned char* ws = WSP();
            pg8::Gemm g{(bf16*)(ws + WS_XN), (bf16*)(ws + WS_WIN) + (size_t)l * DIN * DM, T, DIN, DM}; pg8::StaticOrder S; S.init(T, DIN, G, bid);
            pg8::EpiQKV E{(bf16*)(ws + WS_QKV), PTR(5) + (size_t)l * 128, PTR(7) + (size_t)l * 128, PTR(9) + (size_t)l * 128, (const float*)(ws + WS_ROPE), (const u64_t*)(ws + WS_ROWSQ) + (size_t)(l * 3 + 0) * T};
            pg8::gemm_phase<pg8::EpiQKV, pg8::StaticOrder, true, true>(lds + RING_OFF, g, S, E, tid_);
        }
        SEAM(pb + 0);
        if (IN(pb + 1) && PHON(4)) { PHL(); unsigned char* ws = WSP();
            const float* sink = PTR(6) + (size_t)l * 12; const float* rpb = PTR(8) + (size_t)l * 8 * 15 * 31; const float* biasA = (const float*)(ws + WS_BIASA);
            const bf16* QKV = (const bf16*)(ws + WS_QKV); bf16* ATT = (bf16*)(ws + WS_ATT);
            const float* ga = PTR(5) + (size_t)l * 128; const float* gb = PTR(7) + (size_t)l * 128; const float* gc = PTR(9) + (size_t)l * 128;
            const float CaL2 = 8.f * wave_max(fabsf(ga[lane_]), lane_) * wave_max(fabsf(ga[64 + lane_]), lane_) * LOG2E;
            const float CbL2 = 8.f * wave_max(fabsf(gb[lane_]), lane_) * wave_max(fabsf(gb[64 + lane_]), lane_) * LOG2E;
            const float CcL2 = 8.f * wave_max(fabsf(gc[lane_]), lane_) * wave_max(fabsf(gc[64 + lane_]), lane_) * LOG2E;
            const int vc = (G % 8 == 0) ? (bid % 8) * (G / 8) + bid / 8 : bid;
            u64_t* mixsq = (u64_t*)(ws + WS_MIXSQ) + (size_t)l * 3 * T;
            for (int u = vc; u < BATCH * 12 * 8; u += G) attn_unit<2>(lds, QKV, ATT, mixsq + 2 * (size_t)T, u / 96, (u >> 3) % 12, u & 7, nullptr, CcL2, 0.f, tid_);
            for (int u = vc; u < BATCH * 8 * 8; u += G) attn_unit<1>(lds, QKV, ATT, mixsq + (size_t)T, u >> 6, (u >> 3) & 7, u & 7, rpb, CbL2, 0.f, tid_);
            for (int u = vc; u < BATCH * 12 * 8; u += G) { const int head = (u >> 3) % 12; attn_unit<0>(lds, QKV, ATT, mixsq, u / 96, head, u & 7, biasA, CaL2, sink[head] * LOG2E, tid_); }
        }
        SEAM(pb + 1);
        if (IN(pb + 2) && PHON(5)) { PHL(); unsigned char* ws = WSP();
            pg8::Gemm g{(bf16*)(ws + WS_ATT), (bf16*)(ws + WS_WOUT) + (size_t)l * DM * DM, T, DM, DM}; pg8::StaticOrder S; S.init(T, DM, G, bid);
            LAS float* ftab = (LAS float*)(lds + LDSCTL_OFF + 2048); LAS int* pmtab = (LAS int*)(lds + LDSCTL_OFF + 1536);
            {   const u64_t* mixsq = (const u64_t*)(ws + WS_MIXSQ) + (size_t)l * 3 * T;
#pragma unroll
                for (int i = 0; i < 4; ++i) { pg8::Unit uu; uu.pm = -1; uu.pn = 0; const bool ok = S.next(i, uu); if (tid_ == 0) pmtab[i] = ok ? uu.pm : -1;
                    if (ok && tid_ < 256) { const size_t row = (size_t)uu.pm * 256 + tid_;
                        const float ra = 1.0f / sqrtf((float)*(const GAS u64_t*)(mixsq + row) * (5.9604644775390625e-08f / 768.0f) + EPS), rb = 1.0f / sqrtf((float)*(const GAS u64_t*)(mixsq + T + row) * (5.9604644775390625e-08f / 512.0f) + EPS),
                                    rc = 1.0f / sqrtf((float)*(const GAS u64_t*)(mixsq + 2 * (size_t)T + row) * (5.9604644775390625e-08f / 768.0f) + EPS);
                        ftab[i * 256 + tid_] = ra / rb; ftab[1024 + i * 256 + tid_] = rb / rc; ftab[2048 + i * 256 + tid_] = rc; } }
                __syncthreads(); }
            pg8::EpiResidMix E{(bf16*)(ws + WS_XN), DM, (u64_t*)(ws + WS_ROWSQ) + (size_t)(l * 3 + 1) * T, ftab, pmtab};
            pg8::gemm_phase<pg8::EpiResidMix, pg8::StaticOrder, true, true>(lds + RING_OFF, g, S, E, tid_);
        }
        SEAM(pb + 2);
        if (IN(pb + 3) && PHON(6)) { PHL(); unsigned char* ws = WSP();
            pg8::Gemm g{(bf16*)(ws + WS_XN), (bf16*)(ws + WS_WMQ) + (size_t)l * MEMW * DM, T, MEMW, DM}; pg8::StaticOrder S; S.init(T, MEMW, G, bid);
            pg8::EpiBf16Row E{(bf16*)(ws + WS_QM), MEMW, (const u64_t*)(ws + WS_ROWSQ) + (size_t)(l * 3 + 1) * T};
            pg8::gemm_phase<pg8::EpiBf16Row, pg8::StaticOrder, true, true>(lds + RING_OFF, g, S, E, tid_);
            VM_WAIT(); __syncthreads();
            const bf16* kvm = (const bf16*)(ws + WS_KVM) + (size_t)l * BATCH * NMEM * 1024; const float* gq = PTR(16) + (size_t)l * 256;
            const float CmL2 = 11.313708498984761f * wave_max(fmaxf(fabsf(gq[lane_]), fabsf(gq[64 + lane_])), lane_) * wave_max(fmaxf(fabsf(gq[128 + lane_]), fabsf(gq[192 + lane_])), lane_) * LOG2E;
#pragma unroll 1
            for (int i = 0; i < 4; ++i) { pg8::Unit uu; uu.pm = 0; uu.pn = 0; if (!S.next(i, uu)) break;
                mem_unit(lds, (const bf16*)(ws + WS_QM), kvm, (bf16*)(ws + WS_OM), gq, uu.pm, 2 * uu.pn, CmL2, tid_);
                mem_unit(lds, (const bf16*)(ws + WS_QM), kvm, (bf16*)(ws + WS_OM), gq, uu.pm, 2 * uu.pn + 1, CmL2, tid_); }
        }
        SEAM(pb + 3);
        if (IN(pb + 4) && PHON(7)) { PHL(); unsigned char* ws = WSP();
            pg8::Gemm g{(bf16*)(ws + WS_OM), (bf16*)(ws + WS_WMO) + (size_t)l * DM * MEMW, T, DM, MEMW}; pg8::StaticOrder S; S.init(T, DM, G, bid);
            pg8::EpiResid E{(bf16*)(ws + WS_XN), DM, (u64_t*)(ws + WS_ROWSQ) + (size_t)(l * 3 + 2) * T};
            pg8::gemm_phase<pg8::EpiResid, pg8::StaticOrder, true, true>(lds + RING_OFF, g, S, E, tid_);
        }
        SEAM(pb + 4);
        if (IN(pb + 5) && PHON(8)) { PHL(); unsigned char* ws = WSP();
            pg8::Gemm g{(bf16*)(ws + WS_XN), (bf16*)(ws + WS_WPQ) + (size_t)l * DM * DM, T, DM, DM}; pg8::StaticOrder S; S.init(T, DM, G, bid);
            pg8::EpiBf16Row E{(bf16*)(ws + WS_QP), DM, (const u64_t*)(ws + WS_ROWSQ) + (size_t)(l * 3 + 2) * T};
            pg8::gemm_phase<pg8::EpiBf16Row, pg8::StaticOrder, true, true>(lds + RING_OFF, g, S, E, tid_);
            VM_WAIT(); __syncthreads();
            const bf16* pk = (const bf16*)(ws + WS_PKEYS) + (size_t)l * 8 * 2 * 128 * 128;
#pragma unroll 1
            for (int i = 0; i < 8; ++i) { pg8::Unit uu; uu.pm = 0; uu.pn = 0; if (!S.next(i, uu)) break;
                peer_select_unit((const bf16*)(ws + WS_QP), pk, (int*)(ws + WS_PIDX), (float*)(ws + WS_PGATE), uu.pm, uu.pn, wave_, lane_);
                peer_xquant_unit((const bf16*)(ws + WS_XN), (const u64_t*)(ws + WS_ROWSQ) + (size_t)(l * 3 + 2) * T, (unsigned*)(ws + WS_XQH), (unsigned*)(ws + WS_XQL), uu.pm, uu.pn, tid_); }
        }
        SEAM(pb + 5);
        if (IN(pb + 6) && PHON(9)) { PHL(); unsigned char* ws = WSP();
            peer_u_phase_i4((const unsigned*)(ws + WS_XQH), (const unsigned*)(ws + WS_XQL), ws + WS_PU + (size_t)l * PEER_N * 1024, (const int*)(ws + WS_PIDX), (int*)(ws + WS_PARTI), bid, G, wave_, lane_); }
        SEAM(pb + 6);
        if (IN(pb + 7) && PHON(10)) { PHL(); unsigned char* ws = WSP();
            peer_v_pass((bf16*)(ws + WS_XN), ws + WS_PV + (size_t)l * PEER_N * 1024, (const int*)(ws + WS_PIDX), (const float*)(ws + WS_PGATE), (const int*)(ws + WS_PARTI), (l + 1 == DEPTH) ? OUTP() : (float*)nullptr,
                        (l + 1 < DEPTH) ? (u64_t*)(ws + WS_ROWSQ) + (size_t)((l + 1) * 3 + 0) * T : (u64_t*)nullptr, (LAS float*)(lds + RING_OFF + wave_ * 1024), gw_, NGW, lane_); }
        SEAM(pb + 7);
    }
#undef IN
#undef SEAM
}

#ifndef MK_MULTI_LAUNCH
#define MK_MULTI_LAUNCH 0
#endif
extern "C" void kernel_launch(void* const* d_in, const int* in_sizes, int n_in, void* d_out, int out_size, void* d_ws, size_t ws_size, hipStream_t stream) {
    static int grid = 0;
    if (grid == 0) {
        if (n_in != 23 || out_size != T * DM || ws_size < WS_END) { fprintf(stderr, "kernel_launch: unexpected shapes (n_in %d, out %d, ws %zu)\n", n_in, out_size, ws_size); grid = -1; return; }
        int dev = 0, cus = 0, per_cu = 0;
        if (hipGetDevice(&dev) != hipSuccess || hipDeviceGetAttribute(&cus, hipDeviceAttributeMultiprocessorCount, dev) != hipSuccess) { grid = -1; return; }
        if (hipFuncSetAttribute((const void*)mega, hipFuncAttributeMaxDynamicSharedMemorySize, LDS_BYTES) != hipSuccess) { fprintf(stderr, "kernel_launch: hipFuncSetAttribute failed\n"); grid = -1; return; }
        if (hipOccupancyMaxActiveBlocksPerMultiprocessor(&per_cu, (const void*)mega, NTHREADS, LDS_BYTES) != hipSuccess || per_cu < 1) { fprintf(stderr, "kernel_launch: occupancy query says %d\n", per_cu); }
        (void)hipGetLastError();
        grid = cus;
    }
    if (grid < 0) return;
    (void)hipMemsetAsync((char*)d_ws + WS_CTL, 0, CTL_ZERO_BYTES, stream);
    (void)hipMemsetAsync((char*)d_ws + WS_MIXSQ, 0, MIXSQ_BYTES, stream);
    Args a{};
    for (int i = 0; i < 23; ++i) a.in[i] = (const float*)d_in[i];
    a.out = (float*)d_out; a.ws = (unsigned char*)d_ws;
#if MK_MULTI_LAUNCH
    for (int p = 0; p < N_PHASES; ++p) { a.ph_lo = p; a.ph_hi = p + 1; a.use_bar = 0; a.pad = 0; hipLaunchKernelGGL(mega, dim3(grid), dim3(NTHREADS), LDS_BYTES, stream, a); }
#else
    a.ph_lo = 0; a.ph_hi = N_PHASES; a.use_bar = 1; a.pad = 0;
    hipLaunchKernelGGL(mega, dim3(grid), dim3(NTHREADS), LDS_BYTES, stream, a);
#endif
    const hipError_t le = hipPeekAtLastError();
    if (le != hipSuccess) fprintf(stderr, "kernel_launch: launch failed: %s\n", hipGetErrorName(le));
}
```

```cpp
#include <hip/hip_runtime.h>
#include <cstdio>
#include <cstdint>
#include <cmath>
__device__ __forceinline__ float shx(float v, int k, int lane);
typedef unsigned long long u64_t;
__device__ __forceinline__ float rowsq_rs(const u64_t* rowsq, int row) { return 1.0f / sqrtf((float)*(const __attribute__((address_space(1))) u64_t*)(rowsq + row) * (5.9604644775390625e-08f / 2048.0f) + 1e-6f); }
__device__ __forceinline__ u64_t rowsq_fx(float ss) { return (u64_t)(ss * 16777216.0f + 0.5f); }
namespace pg8 {
#define PG8_LAS __attribute__((address_space(3)))
#define PG8_GAS __attribute__((address_space(1)))
typedef unsigned short bf16_t;
typedef short bf16x8 __attribute__((ext_vector_type(8)));
typedef float f32x4 __attribute__((ext_vector_type(4)));
typedef unsigned u32x4 __attribute__((ext_vector_type(4)));
constexpr int BM = 256, BK = 64, HALF = 128, HTB = HALF * BK * 2  , STAGE_BYTES = 8 * HTB, NXCD = 8, WGM = 8;

__host__ __device__ __forceinline__ int lds_byte(int r, int c) { const int st = (r >> 4) * 2 + (c >> 5), rr = r & 15, cc = c & 31, ob = rr * 64 + cc * 2; return st * 1024 + (ob ^ (((ob >> 9) & 1) << 5)); }
__host__ __device__ __forceinline__ void stage_rc(int b, int& R, int& C) { const int st = b / 1024, sb = b % 1024, swz = sb ^ (((sb >> 9) & 1) << 5); R = (st >> 1) * 16 + swz / 64; C = (st & 1) * 32 + (swz % 64) / 2; }
__host__ __device__ __forceinline__ int perm32(int rho) { const int n = rho >> 4, i = rho & 15; return 8 * (i >> 2) + 4 * n + (i & 3); }

struct Unit { int pm, pn; };
struct Gemm { const bf16_t* A; const bf16_t* Bt; int M, N, K; };

struct StaticOrder {
    int nM, nN, nwg, G, c;
    __host__ __device__ __forceinline__ void init(int M, int N, int G_, int c_) { nM = M / BM; nN = N / BM; nwg = nM * nN; G = G_; c = c_; }
    __host__ __device__ __forceinline__ bool next(int i, Unit& u) const {
        const long L = (long)i * G + c; if (L >= nwg) return false;
        int wgid = (int)L; { const int q = nwg / NXCD, r = nwg % NXCD, xcd = wgid % NXCD, off = wgid / NXCD; wgid = (xcd < r ? xcd * (q + 1) : r * (q + 1) + (xcd - r) * q) + off; }
        const int nig = WGM * nN, gid = wgid / nig, fm = gid * WGM, gsz = (nM - fm) < WGM ? (nM - fm) : WGM;
        u.pm = fm + ((wgid % nig) % gsz); u.pn = (wgid % nig) / gsz; return true;
    }
    __device__ __forceinline__ void a_ready(const Unit&) const {}
    __device__ __forceinline__ void done(const Unit&) const {}
};

__device__ __forceinline__ unsigned cvt_pk_bf16(float lo, float hi) { unsigned r; asm volatile("v_cvt_pk_bf16_f32 %0, %1, %2" : "=v"(r) : "v"(lo), "v"(hi)); return r; }
typedef float f32x2 __attribute__((ext_vector_type(2)));
__device__ __forceinline__ f32x2 gelu_pk(f32x2 v) {
    const f32x2 av = __builtin_elementwise_abs(v), d = av * 0.2316418882f + 1.0f;
    f32x2 t; t.x = __builtin_amdgcn_rcpf(d.x); t.y = __builtin_amdgcn_rcpf(d.y);
    f32x2 q = t * 0.5307027145f + (-0.7265760135f); q = q * t + 0.7107068705f; q = q * t + (-0.142248368f); q = q * t + 0.127414796f; q = q * t;
    const f32x2 s = (v * v) * (-0.72134752044f);
    f32x2 e; e.x = __builtin_amdgcn_exp2f(s.x); e.y = __builtin_amdgcn_exp2f(s.y);
    const f32x2 m = v * (q * e), r = v - m;
    f32x2 o; o.x = v.x < 0.f ? m.x : r.x; o.y = v.y < 0.f ? m.y : r.y; return o;
}

template <int ACT  > struct EpiBf16 {
    static constexpr bool PERM = true, AFTER_DRAIN = false, KSCALE = false, I8 = false; static_assert(ACT == 0 || ACT == 1, "EpiBf16: ACT is 0 (none) or 1 (gelu_pk)");
    bf16_t* O; int ldc; const float* bias; int split_cols; size_t split_stride; float scale0;
    __device__ __forceinline__ void operator()(const f32x4 (&acc)[2][2][4][2], const Unit& u, int wr, int wc, int fr, int fq) const {
        const int row0 = u.pm * BM + wr * 64 + fr; int colt = u.pn * BM; bf16_t* base = O;
        float sc = 1.f; if (split_cols) { const int t = colt / split_cols; base += (size_t)t * split_stride; colt -= t * split_cols; if (t == 0) sc = scale0; }
        const int col0 = colt + wc * 32 + 8 * fq, bcol0 = u.pn * BM + wc * 32 + 8 * fq;
        f32x4 bv[2][2];
#pragma unroll
        for (int bj = 0; bj < 2; ++bj)
#pragma unroll
            for (int n = 0; n < 2; ++n) bv[bj][n] = bias ? *(const PG8_GAS f32x4*)(bias + bcol0 + bj * HALF + 4 * n) : (f32x4){0.f, 0.f, 0.f, 0.f};
#pragma unroll
        for (int ai = 0; ai < 2; ++ai)
#pragma unroll
            for (int m = 0; m < 4; ++m) { bf16_t* rowp = base + (size_t)(row0 + ai * HALF + m * 16) * ldc + col0;
#pragma unroll
                for (int bj = 0; bj < 2; ++bj) { f32x4 v0 = acc[ai][bj][m][0] + bv[bj][0], v1 = acc[ai][bj][m][1] + bv[bj][1];
                    if (ACT == 1) { f32x2 a = gelu_pk((f32x2){v0[0], v0[1]}), b = gelu_pk((f32x2){v0[2], v0[3]}), c = gelu_pk((f32x2){v1[0], v1[1]}), d = gelu_pk((f32x2){v1[2], v1[3]});
                        v0 = (f32x4){a.x, a.y, b.x, b.y}; v1 = (f32x4){c.x, c.y, d.x, d.y}; }
                    v0 = v0 * sc; v1 = v1 * sc; u32x4 w; w.x = cvt_pk_bf16(v0[0], v0[1]); w.y = cvt_pk_bf16(v0[2], v0[3]); w.z = cvt_pk_bf16(v1[0], v1[1]); w.w = cvt_pk_bf16(v1[2], v1[3]);
                    *(PG8_GAS u32x4*)(rowp + bj * HALF) = w; } }
    }
};

typedef unsigned u32x2 __attribute__((ext_vector_type(2)));
typedef int i32x4 __attribute__((ext_vector_type(4)));
struct EpiResid {
    static constexpr bool PERM = false, AFTER_DRAIN = false, KSCALE = false, I8 = false;
    bf16_t* s; int ldc; u64_t* rowsq;
    __device__ __forceinline__ void operator()(const f32x4 (&acc)[2][2][4][2], const Unit& u, int wr, int wc, int fr, int fq) const {
        const int col0 = u.pn * BM + wc * 32 + 4 * fq;
#pragma unroll
        for (int ai = 0; ai < 2; ++ai)
#pragma unroll
            for (int m = 0; m < 4; ++m) { const int row = u.pm * BM + ai * HALF + wr * 64 + m * 16 + fr; bf16_t* sp = s + (size_t)row * ldc + col0; float ss = 0.f;
                u32x2 in[2][2];
#pragma unroll
                for (int bj = 0; bj < 2; ++bj)
#pragma unroll
                    for (int n = 0; n < 2; ++n) in[bj][n] = *(const PG8_GAS u32x2*)(sp + bj * HALF + n * 16);
#pragma unroll
                for (int bj = 0; bj < 2; ++bj)
#pragma unroll
                    for (int n = 0; n < 2; ++n) { const u32x2 w0 = in[bj][n];
                        const f32x4 bs = (f32x4){__builtin_bit_cast(float, w0.x << 16), __builtin_bit_cast(float, w0.x & 0xffff0000u), __builtin_bit_cast(float, w0.y << 16), __builtin_bit_cast(float, w0.y & 0xffff0000u)};
                        const f32x4 o = bs + acc[ai][bj][m][n]; ss += (o[0] * o[0] + o[1] * o[1]) + (o[2] * o[2] + o[3] * o[3]);
                        u32x2 w; w.x = cvt_pk_bf16(o[0], o[1]); w.y = cvt_pk_bf16(o[2], o[3]); *(PG8_GAS u32x2*)(sp + bj * HALF + n * 16) = w; }
                ss += shx(ss, 16, fr + 16 * fq); ss += shx(ss, 32, fr + 16 * fq);
                if (fq == 0) (void)__hip_atomic_fetch_add((PG8_GAS u64_t*)(rowsq + row), rowsq_fx(ss), __ATOMIC_RELAXED, __HIP_MEMORY_SCOPE_AGENT); }
    }
};
struct EpiResidMix {
    static constexpr bool PERM = false, AFTER_DRAIN = false, KSCALE = true, I8 = false; static constexpr int KS0 = 12, KS1 = 20;
    bf16_t* s; int ldc; u64_t* rowsq; const PG8_LAS float* ftab; const PG8_LAS int* pmtab;
    __device__ __forceinline__ int slot(int pm) const { return pmtab[0] == pm ? 0 : (pmtab[1] == pm ? 1 : (pmtab[2] == pm ? 2 : 3)); }
    __device__ __forceinline__ void kscale(f32x4 (&acc)[2][2][4][2], const Unit& u, int which, int wr, int fr) const {
        const PG8_LAS float* ft = ftab + which * 1024 + slot(u.pm) * 256;
#pragma unroll
        for (int ai = 0; ai < 2; ++ai)
#pragma unroll
            for (int m = 0; m < 4; ++m) { const float f = ft[ai * HALF + wr * 64 + m * 16 + fr];
#pragma unroll
                for (int bj = 0; bj < 2; ++bj)
#pragma unroll
                    for (int n = 0; n < 2; ++n) acc[ai][bj][m][n] = acc[ai][bj][m][n] * f; }
    }
    __device__ __forceinline__ void operator()(const f32x4 (&acc)[2][2][4][2], const Unit& u, int wr, int wc, int fr, int fq) const {
        const int col0 = u.pn * BM + wc * 32 + 4 * fq;
#pragma unroll
        for (int ai = 0; ai < 2; ++ai)
#pragma unroll
            for (int m = 0; m < 4; ++m) { const int row = u.pm * BM + ai * HALF + wr * 64 + m * 16 + fr; bf16_t* sp = s + (size_t)row * ldc + col0; float ss = 0.f; const float rc = ftab[2048 + slot(u.pm) * 256 + ai * HALF + wr * 64 + m * 16 + fr];
                u32x2 in[2][2];
#pragma unroll
                for (int bj = 0; bj < 2; ++bj)
#pragma unroll
                    for (int n = 0; n < 2; ++n) in[bj][n] = *(const PG8_GAS u32x2*)(sp + bj * HALF + n * 16);
#pragma unroll
                for (int bj = 0; bj < 2; ++bj)
#pragma unroll
                    for (int n = 0; n < 2; ++n) { const u32x2 w0 = in[bj][n];
                        const f32x4 bs = (f32x4){__builtin_bit_cast(float, w0.x << 16), __builtin_bit_cast(float, w0.x & 0xffff0000u), __builtin_bit_cast(float, w0.y << 16), __builtin_bit_cast(float, w0.y & 0xffff0000u)};
                        const f32x4 o = bs + acc[ai][bj][m][n] * rc; ss += (o[0] * o[0] + o[1] * o[1]) + (o[2] * o[2] + o[3] * o[3]);
                        u32x2 w; w.x = cvt_pk_bf16(o[0], o[1]); w.y = cvt_pk_bf16(o[2], o[3]); *(PG8_GAS u32x2*)(sp + bj * HALF + n * 16) = w; }
                ss += shx(ss, 16, fr + 16 * fq); ss += shx(ss, 32, fr + 16 * fq);
                if (fq == 0) (void)__hip_atomic_fetch_add((PG8_GAS u64_t*)(rowsq + row), rowsq_fx(ss), __ATOMIC_RELAXED, __HIP_MEMORY_SCOPE_AGENT); }
    }
};
struct EpiBf16Row {
    static constexpr bool PERM = true, AFTER_DRAIN = false, KSCALE = false, I8 = false;
    bf16_t* O; int ldc; const u64_t* rowsq;
    __device__ __forceinline__ void operator()(const f32x4 (&acc)[2][2][4][2], const Unit& u, int wr, int wc, int fr, int fq) const {
        const int row0 = u.pm * BM + wr * 64 + fr, col0 = u.pn * BM + wc * 32 + 8 * fq;
#pragma unroll
        for (int ai = 0; ai < 2; ++ai)
#pragma unroll
            for (int m = 0; m < 4; ++m) { const int row = row0 + ai * HALF + m * 16; const float rs = rowsq_rs(rowsq, row); bf16_t* rowp = O + (size_t)row * ldc + col0;
#pragma unroll
                for (int bj = 0; bj < 2; ++bj) { const f32x4 v0 = acc[ai][bj][m][0] * rs, v1 = acc[ai][bj][m][1] * rs; u32x4 w; w.x = cvt_pk_bf16(v0[0], v0[1]); w.y = cvt_pk_bf16(v0[2], v0[3]); w.z = cvt_pk_bf16(v1[0], v1[1]); w.w = cvt_pk_bf16(v1[2], v1[3]);
                    *(PG8_GAS u32x4*)(rowp + bj * HALF) = w; } }
    }
};
struct EpiQKV {
    static constexpr bool PERM = false, AFTER_DRAIN = false, KSCALE = false, I8 = true;
    bf16_t* O; const float* ga; const float* gb; const float* gc; const float* rope; const u64_t* rowsq; const float* xsc; const float* wsc;
    __device__ __forceinline__ void operator()(const f32x4 (&acc)[2][2][4][2], const Unit& u, int wr, int wc, int fr, int fq) const {
        const int hg = u.pn * 4 + wc;
        const float* g = nullptr; bool isq = false, dorope = false;
        if (hg < 12) { g = ga; isq = true; } else if (hg < 16) { g = ga + 64; } else if (hg < 20) { }
        else if (hg < 28) { g = gb; isq = true; } else if (hg < 36) { g = gb + 64; } else if (hg < 44) { }
        else if (hg < 56) { g = gc; isq = true; dorope = true; } else if (hg < 60) { g = gc + 64; dorope = true; }
        const float qs = isq ? 0.18033688011112042f : 1.0f;
#pragma unroll
        for (int ai = 0; ai < 2; ++ai)
#pragma unroll
            for (int m = 0; m < 4; ++m) {
                const int row = u.pm * BM + ai * HALF + wr * 64 + m * 16 + fr;
                f32x4 v[2][2];
                const float rsx = rowsq_rs(rowsq, row) * *(const PG8_GAS float*)(xsc + row);
#pragma unroll
                for (int bj = 0; bj < 2; ++bj)
#pragma unroll
                    for (int n = 0; n < 2; ++n) { const i32x4 ia = __builtin_bit_cast(i32x4, acc[ai][bj][m][n]);
                        v[bj][n] = (f32x4){(float)ia[0], (float)ia[1], (float)ia[2], (float)ia[3]} * *(const PG8_GAS f32x4*)(wsc + hg * 64 + 32 * bj + 16 * n + 4 * fq) * rsx; }
                if (g) {
                    float ss = 0.f;
#pragma unroll
                    for (int bj = 0; bj < 2; ++bj)
#pragma unroll
                        for (int n = 0; n < 2; ++n) { const f32x4 x = v[bj][n]; ss += (x[0] * x[0] + x[1] * x[1]) + (x[2] * x[2] + x[3] * x[3]); }
                    ss += shx(ss, 16, fr + 16 * fq); ss += shx(ss, 32, fr + 16 * fq);
                    const float r = qs / sqrtf(ss * (1.0f / 64.0f) + 1e-6f);
#pragma unroll
                    for (int bj = 0; bj < 2; ++bj)
#pragma unroll
                        for (int n = 0; n < 2; ++n) v[bj][n] = v[bj][n] * *(const PG8_GAS f32x4*)(g + 32 * bj + 16 * n + 4 * fq) * r;
                }
                if (dorope) {
                    const int t = row & 2047, pr = t >> 6, pc = t & 63;
#pragma unroll
                    for (int bj = 0; bj < 2; ++bj) {
                        const int pos = bj ? pc : pr;
                        const float* rp = rope + (size_t)(pos * 16 + 4 * fq) * 2;
                        const f32x4 c01 = *(const PG8_GAS f32x4*)rp, c23 = *(const PG8_GAS f32x4*)(rp + 4);
                        const f32x4 cs = (f32x4){c01[0], c01[2], c23[0], c23[2]}, sn = (f32x4){c01[1], c01[3], c23[1], c23[3]};
                        const f32x4 x1 = v[bj][0], x2 = v[bj][1];
                        v[bj][0] = x1 * cs - x2 * sn; v[bj][1] = x1 * sn + x2 * cs;
                    }
                }
                bf16_t* rowp = O + (size_t)row * 4096 + hg * 64 + 4 * fq;
#pragma unroll
                for (int bj = 0; bj < 2; ++bj)
#pragma unroll
                    for (int n = 0; n < 2; ++n) { u32x2 w; w.x = cvt_pk_bf16(v[bj][n][0], v[bj][n][1]); w.y = cvt_pk_bf16(v[bj][n][2], v[bj][n][3]); *(PG8_GAS u32x2*)(rowp + 32 * bj + 16 * n) = w; }
                asm volatile("" ::: "memory");
            }
    }
};
template <bool I8> __device__ __forceinline__ f32x4 mma16(const bf16x8 b, const bf16x8 a, const f32x4 c) {
    if constexpr (I8) return __builtin_bit_cast(f32x4, __builtin_amdgcn_mfma_i32_16x16x64_i8(__builtin_bit_cast(i32x4, b), __builtin_bit_cast(i32x4, a), __builtin_bit_cast(i32x4, c), 0, 0, 0));
    else return __builtin_amdgcn_mfma_f32_16x16x32_bf16(b, a, c, 0, 0, 0);
}
template <class Epi, class Sched, bool ALIGN_EPI = false, bool SP2 = false>
__device__ __forceinline__ void gemm_phase(PG8_LAS unsigned char* lds, const Gemm g, const Sched& S, const Epi& E, const int tid) {
    const int wid = __builtin_amdgcn_readfirstlane(tid >> 6), lane = tid & 63, wr = wid >> 2, wc = wid & 3, fr = lane & 15, fq = lane >> 4;
    const int K = g.K, nt = K / BK;
    unsigned voffA[2], voffB[2];
#pragma unroll
    for (int i = 0; i < 2; ++i) { int R, C; stage_rc(tid * 16 + i * 8192, R, C); const int Rb = Epi::PERM ? ((R & ~31) + perm32(R & 31)) : R;
        voffA[i] = (unsigned)(R * K + C) * 2u; voffB[i] = (unsigned)(Rb * K + C) * 2u; }
    const size_t kstep = (size_t)(BK * 2);
    const size_t hstep = (size_t)HALF * K * 2;
    const size_t tstep = 2 * hstep;
    const unsigned ldsw = (unsigned)wid * 1024u;
    const int aoff = lds_byte(wr * 64 + fr, fq * 8), boff = lds_byte(wc * 32 + fr, fq * 8);
#define PG8_SA(b, h) (((b) * 2 + (h)) * HTB)
#define PG8_SB(b, h) ((4 + (b) * 2 + (h)) * HTB)
#define PG8_STAGE(bufoff, gbase, voff) do { _Pragma("unroll") for (int _i = 0; _i < 2; ++_i) \
        __builtin_amdgcn_global_load_lds((const unsigned*)((const char*)(gbase) + (voff)[_i]), (PG8_LAS unsigned*)(lds + (bufoff) + ldsw + _i * 8192), 16, 0, 0); } while (0)
#define PG8_LDA(dst, b, h) do { _Pragma("unroll") for (int m = 0; m < 4; ++m) _Pragma("unroll") for (int k = 0; k < 2; ++k) dst[m][k] = *(const PG8_LAS bf16x8*)(lds + PG8_SA(b, h) + aoff + m * 2048 + k * 1024); } while (0)
#define PG8_LDB(dst, b, h) do { _Pragma("unroll") for (int n = 0; n < 2; ++n) _Pragma("unroll") for (int k = 0; k < 2; ++k) dst[n][k] = *(const PG8_LAS bf16x8*)(lds + PG8_SB(b, h) + boff + n * 2048 + k * 1024); } while (0)
#define PG8_MMA(ai, bj, At, Bt) do { __builtin_amdgcn_s_setprio(1); _Pragma("unroll") for (int m = 0; m < 4; ++m) _Pragma("unroll") for (int n = 0; n < 2; ++n) _Pragma("unroll") for (int k = 0; k < 2; ++k) \
        acc[ai][bj][m][n] = mma16<Epi::I8>(Bt[n][k], At[m][k], acc[ai][bj][m][n]); __builtin_amdgcn_s_setprio(0); } while (0)
#define PG8_WAIT_V(n) asm volatile("s_waitcnt vmcnt(" #n ")" ::: "memory")
#define PG8_WAIT_L(n) asm volatile("s_waitcnt lgkmcnt(" #n ")" ::: "memory")
#define PG8_BAR __builtin_amdgcn_s_barrier()
#define PG8_SCHED __builtin_amdgcn_sched_barrier(0)
    Unit cur, nxt; int ui = 0;
    if (!S.next(0, cur)) return;
    f32x4 acc[2][2][4][2];
#pragma unroll
    for (int a = 0; a < 2; ++a)
#pragma unroll
        for (int b = 0; b < 2; ++b)
#pragma unroll
            for (int m = 0; m < 4; ++m)
#pragma unroll
                for (int n = 0; n < 2; ++n) acc[a][b][m][n] = (f32x4){0.f, 0.f, 0.f, 0.f};
    bf16x8 At[4][2], B0[2][2], B1[2][2];
    const char* cA = (const char*)g.A + (size_t)cur.pm * tstep; const char* cB = (const char*)g.Bt + (size_t)cur.pn * tstep;
    S.a_ready(cur);
    if constexpr (SP2) {
        PG8_STAGE(PG8_SB(0, 0), cB, voffB); PG8_STAGE(PG8_SB(0, 1), cB + hstep, voffB); PG8_STAGE(PG8_SA(0, 0), cA, voffA); PG8_STAGE(PG8_SA(0, 1), cA + hstep, voffA);
        if (wr == 1) PG8_BAR;
        PG8_WAIT_V(2); PG8_BAR;
        PG8_STAGE(PG8_SB(1, 0), cB + kstep, voffB); PG8_STAGE(PG8_SA(1, 0), cA + kstep, voffA); PG8_STAGE(PG8_SB(1, 1), cB + hstep + kstep, voffB);
        PG8_WAIT_V(6); PG8_BAR;
    } else {
        PG8_STAGE(PG8_SB(0, 0), cB, voffB); PG8_STAGE(PG8_SA(0, 0), cA, voffA); PG8_STAGE(PG8_SB(0, 1), cB + hstep, voffB); PG8_STAGE(PG8_SA(0, 1), cA + hstep, voffA);
        if (wr == 1) PG8_BAR;
        PG8_WAIT_V(4); PG8_BAR;
        PG8_STAGE(PG8_SB(1, 0), cB + kstep, voffB); PG8_STAGE(PG8_SA(1, 0), cA + kstep, voffA); PG8_STAGE(PG8_SB(1, 1), cB + hstep + kstep, voffB);
        PG8_WAIT_V(6); PG8_BAR;
    }
    for (;;) {
        const bool has_next = S.next(ui + 1, nxt);
        const char* nA = has_next ? (const char*)g.A + (size_t)nxt.pm * tstep : cA; const char* nB = has_next ? (const char*)g.Bt + (size_t)nxt.pn * tstep : cB;
        for (int t = 0; t < nt; t += 2) {
            if constexpr (Epi::KSCALE) { if (t == Epi::KS0 || t == Epi::KS1) E.kscale(acc, cur, t == Epi::KS1 ? 1 : 0, wr, fr); }
            const bool last = (t == nt - 2);
            const char* a1 = cA + (size_t)(t + 1) * kstep;
            const char* a2 = last ? nA : cA + (size_t)(t + 2) * kstep; const char* b2 = last ? nB : cB + (size_t)(t + 2) * kstep;
            const char* a3 = a2 + kstep; const char* b3 = b2 + kstep;
            if (last && has_next) S.a_ready(nxt);
            if constexpr (SP2) {
            PG8_LDB(B0, 0, 0); PG8_LDB(B1, 0, 1); PG8_SCHED; PG8_LDA(At, 0, 0); PG8_STAGE(PG8_SA(1, 1), a1 + hstep, voffA);
            PG8_WAIT_V(8); PG8_WAIT_L(0); PG8_BAR; PG8_MMA(0, 0, At, B0); PG8_MMA(0, 1, At, B1); PG8_BAR; PG8_SCHED;
            PG8_LDA(At, 0, 1); PG8_STAGE(PG8_SB(0, 0), b2, voffB); PG8_STAGE(PG8_SB(0, 1), b2 + hstep, voffB); PG8_STAGE(PG8_SA(0, 0), a2, voffA);
            PG8_WAIT_V(8); PG8_WAIT_L(0); PG8_BAR; PG8_MMA(1, 0, At, B0); PG8_MMA(1, 1, At, B1); PG8_BAR; PG8_SCHED;
            PG8_LDB(B0, 1, 0); PG8_LDB(B1, 1, 1); PG8_SCHED; PG8_LDA(At, 1, 0); PG8_STAGE(PG8_SA(0, 1), a2 + hstep, voffA);
            PG8_WAIT_V(8); PG8_WAIT_L(0); PG8_BAR; PG8_MMA(0, 0, At, B0); PG8_MMA(0, 1, At, B1); PG8_BAR; PG8_SCHED;
            PG8_LDA(At, 1, 1); PG8_STAGE(PG8_SB(1, 0), b3, voffB); PG8_STAGE(PG8_SB(1, 1), b3 + hstep, voffB); PG8_STAGE(PG8_SA(1, 0), a3, voffA);
            PG8_WAIT_V(8); PG8_WAIT_L(0); PG8_BAR; PG8_MMA(1, 0, At, B0); PG8_MMA(1, 1, At, B1); PG8_BAR; PG8_SCHED;
            } else {
            PG8_LDB(B0, 0, 0); PG8_SCHED; PG8_LDA(At, 0, 0); PG8_STAGE(PG8_SA(1, 1), a1 + hstep, voffA);
            PG8_WAIT_L(8); PG8_BAR; PG8_WAIT_L(0); PG8_MMA(0, 0, At, B0); PG8_BAR; PG8_SCHED;
            PG8_LDB(B1, 0, 1); PG8_STAGE(PG8_SB(0, 0), b2, voffB);
            PG8_BAR; PG8_WAIT_L(0); PG8_MMA(0, 1, At, B1); PG8_BAR;
            PG8_LDA(At, 0, 1); PG8_STAGE(PG8_SA(0, 0), a2, voffA);
            PG8_BAR; PG8_WAIT_L(0); PG8_MMA(1, 0, At, B0); PG8_BAR; PG8_SCHED;
            PG8_STAGE(PG8_SB(0, 1), b2 + hstep, voffB);
            PG8_WAIT_V(6); PG8_BAR; PG8_MMA(1, 1, At, B1); PG8_BAR;
            PG8_LDB(B0, 1, 0); PG8_SCHED; PG8_LDA(At, 1, 0); PG8_STAGE(PG8_SA(0, 1), a2 + hstep, voffA);
            PG8_WAIT_L(8); PG8_BAR; PG8_WAIT_L(0); PG8_MMA(0, 0, At, B0); PG8_BAR; PG8_SCHED;
            PG8_LDB(B1, 1, 1); PG8_STAGE(PG8_SB(1, 0), b3, voffB);
            PG8_BAR; PG8_WAIT_L(0); PG8_MMA(0, 1, At, B1); PG8_BAR;
            PG8_LDA(At, 1, 1); PG8_STAGE(PG8_SA(1, 0), a3, voffA);
            PG8_BAR; PG8_WAIT_L(0); PG8_MMA(1, 0, At, B0); PG8_BAR; PG8_SCHED;
            PG8_STAGE(PG8_SB(1, 1), b3 + hstep, voffB);
            PG8_WAIT_V(6); PG8_BAR; PG8_MMA(1, 1, At, B1); PG8_BAR;
            }
        }
        if constexpr (ALIGN_EPI) { if (wr == 0) PG8_BAR; }
        if constexpr (!Epi::AFTER_DRAIN) { E(acc, cur, wr, wc, fr, fq); S.done(cur); }
        if (!has_next) break;
#pragma unroll
        for (int a = 0; a < 2; ++a)
#pragma unroll
            for (int b = 0; b < 2; ++b)
#pragma unroll
                for (int m = 0; m < 4; ++m)
#pragma unroll
                    for (int n = 0; n < 2; ++n) acc[a][b][m][n] = (f32x4){0.f, 0.f, 0.f, 0.f};
        cur = nxt; cA = nA; cB = nB; ++ui;
        if constexpr (ALIGN_EPI) { if (wr == 1) PG8_BAR; }
    }
    PG8_WAIT_V(0);
    if constexpr (!ALIGN_EPI) { if (wr == 0) PG8_BAR; }
    PG8_BAR;
    if constexpr (Epi::AFTER_DRAIN) { E.fused(acc, cur, wr, wc, fr, fq, lds, wid, lane); S.done(cur); }
#undef PG8_SA
#undef PG8_SB
#undef PG8_STAGE
#undef PG8_LDA
#undef PG8_LDB
#undef PG8_MMA
#undef PG8_WAIT_V
#undef PG8_WAIT_L
#undef PG8_BAR
#undef PG8_SCHED
}
}

constexpr int BATCH = 16, SEQ = 2048, DM = 2048, T = BATCH * SEQ, DEPTH = 2;
constexpr int NMEM = 256, DIN = 4096, MEMW = 512;
constexpr int PEER_H = 8, PEER_N = 16384;
constexpr int NWAVES = 8, NTHREADS = NWAVES * 64;
constexpr float EPS = 1e-6f;
constexpr int QA = 0, KA = 768, VA = 1024, QB = 1280, KB = 1792, VB = 2304, QC = 2816, KC = 3584, VC = 3840;
constexpr int OA = 0, OB = 768, OC = 1280;

constexpr size_t MiB = 1u << 20;
constexpr size_t WS_CTL = 0, CTL_ZERO_BYTES = 2 * MiB;
constexpr size_t WS_ROWSQ = 256 * 1024;
constexpr size_t WS_ROPE = 83 * MiB, WS_BIASA = 83 * MiB + 16384;
constexpr size_t WS_WIN = 2 * MiB, WS_WOUT = 34 * MiB, WS_WMQ = 50 * MiB, WS_WMKV = 54 * MiB, WS_WMO = 62 * MiB, WS_WPQ = 66 * MiB, WS_PKEYS = 82 * MiB;
constexpr size_t WS_MEMN = 84 * MiB, WS_KVM = 116 * MiB, WS_PU = 132 * MiB, WS_PV = 260 * MiB, WS_XN = 388 * MiB, WS_QKV = 516 * MiB, WS_ATT = 772 * MiB;
constexpr size_t WS_QM = 900 * MiB, WS_OM = 932 * MiB, WS_MIXSQ = 964 * MiB, MIXSQ_BYTES = 2 * MiB, WS_WIN8 = 966 * MiB, WS_WSC = 982 * MiB, WS_XSC = 982 * MiB + 65536, WS_END = 984 * MiB;
constexpr size_t WS_QP = WS_QKV, WS_PIDX = WS_QKV + 128 * MiB, WS_PGATE = WS_QKV + 144 * MiB, WS_PARTI = WS_QKV + 160 * MiB;
constexpr size_t WS_XQH = 900 * MiB, WS_XQL = 932 * MiB;
constexpr size_t WS_XN8 = 836 * MiB;
constexpr int CW_BAR = 4096;

constexpr int RING_OFF = 0, RING_BYTES = 131072;
constexpr int LDSCTL_OFF = RING_BYTES, MISC_OFF = LDSCTL_OFF + 320;
constexpr int LDS_BYTES = 147456;

#define GAS __attribute__((address_space(1)))
#define LAS __attribute__((address_space(3)))
typedef unsigned short bf16;
typedef unsigned v4u __attribute__((ext_vector_type(4)));
typedef unsigned v2u __attribute__((ext_vector_type(2)));
typedef float f32x4 __attribute__((ext_vector_type(4)));
typedef float f32x16 __attribute__((ext_vector_type(16)));
typedef short bf16x8 __attribute__((ext_vector_type(8)));
typedef GAS unsigned gu32;
#define LDS_WAIT() asm volatile("s_waitcnt lgkmcnt(0)" ::: "memory")
#define VM_WAIT() asm volatile("s_waitcnt vmcnt(0)" ::: "memory")
__device__ __forceinline__ unsigned f2bf(float f) { unsigned u = __builtin_bit_cast(unsigned, f); return (u + 0x7fffu + ((u >> 16) & 1u)) >> 16; }
__device__ __forceinline__ unsigned pk2(float lo, float hi) { return f2bf(lo) | (f2bf(hi) << 16); }
__device__ __forceinline__ float bflo(unsigned w) { return __builtin_bit_cast(float, w << 16); }
__device__ __forceinline__ float bfhi(unsigned w) { return __builtin_bit_cast(float, w & 0xffff0000u); }

__device__ __forceinline__ float shx(float v, int k, int lane) { return __builtin_bit_cast(float, __builtin_amdgcn_ds_bpermute((lane ^ k) << 2, __builtin_bit_cast(int, v))); }
#define XB_TMO      128
#define XB_XCNT(j)  (256  + 64 * (j))
#define XB_XSUB(j)  (1280 + 64 * (j))
#define XB_XGEN(j)  (2304 + 64 * (j))
#define XB_TOP      3328
#define XB_TOPGEN   3392
#define XCD_BAR_WORDS 3456
#define XB_SPIN_CAP (1u << 18)

__device__ __forceinline__ unsigned xb_ld(unsigned* p)              { return __hip_atomic_load(p, __ATOMIC_RELAXED, __HIP_MEMORY_SCOPE_AGENT); }
__device__ __forceinline__ unsigned xb_add(unsigned* p, unsigned v) { return __hip_atomic_fetch_add(p, v, __ATOMIC_RELAXED, __HIP_MEMORY_SCOPE_AGENT); }
__device__ __forceinline__ unsigned xb_xcc_id() { return (unsigned)__builtin_amdgcn_s_getreg((3 << 11) | 20) & 0xFu; }
#define XB_SPIN(cond, bar) do { unsigned _sp = 0; while (cond) { __builtin_amdgcn_s_sleep(1); \
    if ((++_sp & 255u) == 0u) { if (xb_ld(&(bar)[XB_TMO])) break; if (_sp > XB_SPIN_CAP) { atomicAdd(&(bar)[XB_TMO], 1u); break; } } } } while (0)

struct XcdBarrier {
    unsigned* bar; unsigned x;
    volatile LAS unsigned* st;
};

__device__ __forceinline__ XcdBarrier xcd_barrier_post(unsigned* bar, volatile LAS unsigned* st) {
    XcdBarrier b; b.bar = bar; b.x = xb_xcc_id(); b.st = st;
    if (threadIdx.x == 0) (void)xb_add(&bar[XB_XCNT(b.x)], 1u);
    return b;
}
__device__ __forceinline__ void xcd_barrier_complete(unsigned* bar, unsigned x, unsigned& nloc, unsigned& nx) {
    const unsigned G = gridDim.x * gridDim.y * gridDim.z;
    unsigned sum, cnt, mine, sp = 0u;
    for (;;) {
        sum = 0u; cnt = 0u; mine = 0u;
#pragma unroll
        for (unsigned j = 0; j < 16; ++j) { const unsigned c = xb_ld(&bar[XB_XCNT(j)]); sum += c; cnt += (c > 0u) ? 1u : 0u; mine = (j == x) ? c : mine; }
        if (sum == G) break;
        __builtin_amdgcn_s_sleep(1);
        if ((++sp & 255u) == 0u) { if (xb_ld(&bar[XB_TMO])) break; if (sp > XB_SPIN_CAP) { atomicAdd(&bar[XB_TMO], 1u); break; } }
    }
    nloc = mine > 0u ? mine : 1u; nx = cnt > 0u ? cnt : 1u;
}

__device__ __forceinline__ void xcd_barrier(const XcdBarrier& b) {
    asm volatile("s_waitcnt vmcnt(0)" ::: "memory");
    __syncthreads();
    if (threadIdx.x == 0) {
        unsigned* bar = b.bar;
        __builtin_amdgcn_s_waitcnt(0);
        unsigned nloc = b.st[0], nx = b.st[1];
        if (nloc == 0u) { xcd_barrier_complete(bar, b.x, nloc, nx); b.st[0] = nloc; b.st[1] = nx; }
        const unsigned old = xb_add(&bar[XB_XSUB(b.x)], 1u);
        const unsigned gen = old / nloc;
        if (old + 1u == (gen + 1u) * nloc) {
            __builtin_amdgcn_fence(__ATOMIC_RELEASE, "agent");
            asm volatile("s_waitcnt vmcnt(0)" ::: "memory");
            const unsigned og = xb_add(&bar[XB_TOP], 1u);
            const unsigned tg = og / nx;
            if (og + 1u == (tg + 1u) * nx) xb_add(&bar[XB_TOPGEN], 1u);
            else XB_SPIN(xb_ld(&bar[XB_TOPGEN]) == tg, bar);
            __builtin_amdgcn_fence(__ATOMIC_ACQUIRE, "agent");
            xb_add(&bar[XB_XGEN(b.x)], 1u);
            asm volatile("s_waitcnt vmcnt(0)" ::: "memory");
        } else {
            XB_SPIN(xb_ld(&bar[XB_XGEN(b.x)]) == gen, bar);
            __builtin_amdgcn_fence(__ATOMIC_ACQUIRE, "agent");
            asm volatile("s_waitcnt vmcnt(0)" ::: "memory");
        }
    }
    __syncthreads();
}

__device__ __forceinline__ float wave_sum(float v, int lane) {
#pragma unroll
    for (int o = 1; o < 64; o <<= 1) v += shx(v, o, lane);
    return v;
}
__device__ __forceinline__ void* ldptr(LAS unsigned char* lds, int i) {
    const unsigned long long v = ((const LAS unsigned long long*)(lds + LDSCTL_OFF + 1024))[i];
    const unsigned lo = __builtin_amdgcn_readfirstlane((unsigned)v), hi = __builtin_amdgcn_readfirstlane((unsigned)(v >> 32));
    return (void*)(((unsigned long long)hi << 32) | lo);
}
struct OffsetOrder {
    pg8::StaticOrder S;
    __device__ __forceinline__ void init(int M, int N, int G, int c, int off) { S.init(M, N, G, (c + G - off % G) % G); }
    __device__ __forceinline__ bool next(int i, pg8::Unit& u) const { return S.next(i, u); }
    __device__ __forceinline__ void a_ready(const pg8::Unit&) const {}
    __device__ __forceinline__ void done(const pg8::Unit&) const {}
};

template <bool PERMQKV>
__device__ __forceinline__ void transpose_item(const float* W, int K, int N, bf16* WT, LAS float* scr, int item, int lane, const float* gk = nullptr) {
    const int nblk = N / 32, kb = item / nblk, nb = item % nblk, k0 = 64 * kb, n0 = 32 * nb;
    int d0 = n0;
    if (PERMQKV) { const int within = n0 & 255; d0 = (n0 & ~255) + 128 * ((within >> 5) & 1) + 32 * (within >> 6); }
#pragma unroll
    for (int i = 0; i < 8; ++i) { const int kk = 8 * i + (lane >> 3), nn = 4 * (lane & 7);
        const f32x4 w4 = *(const GAS f32x4*)(W + (size_t)(k0 + kk) * N + n0 + nn) * (gk ? gk[k0 + kk] : 1.f);
        scr[kk * 33 + nn] = w4[0]; scr[kk * 33 + nn + 1] = w4[1]; scr[kk * 33 + nn + 2] = w4[2]; scr[kk * 33 + nn + 3] = w4[3]; }
    LDS_WAIT(); asm volatile("" ::: "memory");
    const int c = lane & 7;
#pragma unroll
    for (int j = 0; j < 4; ++j) { const int n = (lane >> 3) + 8 * j; const LAS float* s = scr + (8 * c) * 33 + n;
        v4u o; o.x = pk2(s[0 * 33], s[1 * 33]); o.y = pk2(s[2 * 33], s[3 * 33]); o.z = pk2(s[4 * 33], s[5 * 33]); o.w = pk2(s[6 * 33], s[7 * 33]);
        *(GAS v4u*)(WT + (size_t)(d0 + n) * K + k0 + 8 * c) = o; }
    LDS_WAIT(); asm volatile("" ::: "memory");
}
__device__ __forceinline__ void convert_bf16(const float* src, bf16* dst, size_t n, size_t gtid, size_t nthreads) {
    for (size_t i = gtid * 8; i < n; i += nthreads * 8) {
        const f32x4 a = *(const GAS f32x4*)(src + i), b = *(const GAS f32x4*)(src + i + 4);
        v4u o; o.x = pk2(a[0], a[1]); o.y = pk2(a[2], a[3]); o.z = pk2(b[0], b[1]); o.w = pk2(b[2], b[3]);
        *(GAS v4u*)(dst + i) = o;
    }
}
__device__ __forceinline__ int t5_bucket(int rel) {
    const int n = rel < 0 ? -rel : rel;
    const int b = n < 8 ? n : n < 12 ? 8 : n < 16 ? 9 : n < 23 ? 10 : n < 32 ? 11 : n < 46 ? 12 : n < 64 ? 13 : n < 91 ? 14 : 15;
    return b + (rel > 0 ? 16 : 0);
}
__constant__ float ROPE_INV[16] = {1.000000000e+00f, 5.623413324e-01f, 3.162277639e-01f, 1.778279394e-01f, 1.000000015e-01f, 5.623413250e-02f, 3.162277490e-02f, 1.778279431e-02f,
                                   9.999999776e-03f, 5.623413250e-03f, 3.162277630e-03f, 1.778279431e-03f, 1.000000047e-03f, 5.623413017e-04f, 3.162277571e-04f, 1.778279402e-04f};

__device__ __forceinline__ void rms_row_to_bf16(const float* xrow, const float* g0, bf16* o0, const float* g1, bf16* o1, int lane) {
    const GAS f32x4* xr = (const GAS f32x4*)xrow + lane;
    f32x4 v[8]; float s = 0.f;
#pragma unroll
    for (int j = 0; j < 8; ++j) { v[j] = xr[64 * j]; s += (v[j].x * v[j].x + v[j].y * v[j].y) + (v[j].z * v[j].z + v[j].w * v[j].w); }
    const float rstd = 1.f / sqrtf(wave_sum(s, lane) * (1.f / DM) + EPS);
    {   const GAS f32x4* gr = (const GAS f32x4*)g0 + lane; GAS v2u* o8 = (GAS v2u*)o0 + lane;
#pragma unroll
        for (int j = 0; j < 8; ++j) { const f32x4 gg = gr[64 * j]; v2u w; w.x = pk2(v[j].x * rstd * gg.x, v[j].y * rstd * gg.y); w.y = pk2(v[j].z * rstd * gg.z, v[j].w * rstd * gg.w); o8[64 * j] = w; } }
    if (g1) { const GAS f32x4* gr = (const GAS f32x4*)g1 + lane; GAS v2u* o8 = (GAS v2u*)o1 + lane;
#pragma unroll
        for (int j = 0; j < 8; ++j) { const f32x4 gg = gr[64 * j]; v2u w; w.x = pk2(v[j].x * rstd * gg.x, v[j].y * rstd * gg.y); w.y = pk2(v[j].z * rstd * gg.z, v[j].w * rstd * gg.w); o8[64 * j] = w; } }
}
__device__ __forceinline__ float wave_max(float v, int lane) {
#pragma unroll
    for (int o = 1; o < 64; o <<= 1) v = fmaxf(v, shx(v, o, lane));
    return v;
}
__device__ __forceinline__ unsigned q8x4(const f32x4 v, const float inv) {
    unsigned w = 0;
    w = __builtin_amdgcn_cvt_pk_u8_f32(__builtin_rintf(__builtin_fmaf(v[0], inv, 128.f)), 0, w); w = __builtin_amdgcn_cvt_pk_u8_f32(__builtin_rintf(__builtin_fmaf(v[1], inv, 128.f)), 1, w);
    w = __builtin_amdgcn_cvt_pk_u8_f32(__builtin_rintf(__builtin_fmaf(v[2], inv, 128.f)), 2, w); w = __builtin_amdgcn_cvt_pk_u8_f32(__builtin_rintf(__builtin_fmaf(v[3], inv, 128.f)), 3, w);
    return w ^ 0x80808080u;
}
__device__ __forceinline__ float amax4(const f32x4 v) { return fmaxf(fmaxf(fabsf(v[0]), fabsf(v[1])), fmaxf(fabsf(v[2]), fabsf(v[3]))); }
__device__ __forceinline__ void quant_wrow(const bf16* src, unsigned char* dst, float* step, int lane) {
    v4u w[4]; float am = 0.f;
#pragma unroll
    for (int j = 0; j < 4; ++j) w[j] = *(const GAS v4u*)(src + 8 * lane + 512 * j);
    f32x4 lo[4], hi[4];
#pragma unroll
    for (int j = 0; j < 4; ++j) { lo[j] = (f32x4){bflo(w[j].x), bfhi(w[j].x), bflo(w[j].y), bfhi(w[j].y)}; hi[j] = (f32x4){bflo(w[j].z), bfhi(w[j].z), bflo(w[j].w), bfhi(w[j].w)}; am = fmaxf(am, fmaxf(amax4(lo[j]), amax4(hi[j]))); }
    am = fmaxf(wave_max(am, lane), 1e-30f);
    const float inv = 127.f / am;
#pragma unroll
    for (int j = 0; j < 4; ++j) *(GAS v2u*)(dst + 8 * lane + 512 * j) = (v2u){q8x4(lo[j], inv), q8x4(hi[j], inv)};
    if (lane == 0) *step = am * (1.f / 127.f);
}
__device__ __forceinline__ void prep_rows2(const float* x0, bf16* o0, u64_t* sq, unsigned char* q0, float* qstep, int lane) {
    f32x4 v[2][8];
#pragma unroll
    for (int q = 0; q < 2; ++q) { const GAS f32x4* xr = (const GAS f32x4*)(x0 + (size_t)q * DM) + lane;
#pragma unroll
        for (int j = 0; j < 8; ++j) v[q][j] = xr[64 * j]; }
#pragma unroll
    for (int q = 0; q < 2; ++q) { GAS v2u* o8 = (GAS v2u*)(o0 + (size_t)q * DM) + lane; float s = 0.f;
#pragma unroll
        for (int j = 0; j < 8; ++j) { const f32x4 a = v[q][j]; s += (a.x * a.x + a.y * a.y) + (a.z * a.z + a.w * a.w); v2u w; w.x = pk2(a.x, a.y); w.y = pk2(a.z, a.w); o8[64 * j] = w; }
        s = wave_sum(s, lane);
        float am = 0.f;
#pragma unroll
        for (int j = 0; j < 8; ++j) am = fmaxf(am, amax4(v[q][j]));
        am = fmaxf(wave_max(am, lane), 1e-30f);
        const float inv = 127.f / am;
#pragma unroll
        for (int j = 0; j < 8; ++j) *(GAS unsigned*)(q0 + (size_t)q * DM + 4 * lane + 256 * j) = q8x4(v[q][j], inv);
        if (lane == 0) { sq[q] = rowsq_fx(s); qstep[q] = am * (1.f / 127.f); } }
}
__device__ __forceinline__ void norm_rows(const float* X, const float* g, bf16* XN, int gw, int NGW, int lane) {
    for (int m = gw; m < T; m += NGW) rms_row_to_bf16(X + (size_t)m * DM, g, XN + (size_t)m * DM, nullptr, nullptr, lane);
}

template <int TYPE>
__device__ __forceinline__ void naive_attn_item(const bf16* QKV, bf16* ATT, int b, int grow, int head, int lane, const float* biasA, const float* sink, const float* rpb) {
    const int tpos = grow * 64 + lane; const size_t trow = (size_t)b * SEQ + tpos;
    int qcol, kcol, vcol, ocol;
    if (TYPE == 0) { qcol = QA + head * 64; kcol = KA + (head / 3) * 64; vcol = VA + (head / 3) * 64; ocol = OA + head * 64; }
    else if (TYPE == 1) { qcol = QB + head * 64; kcol = KB + head * 64; vcol = VB + head * 64; ocol = OB + head * 64; }
    else { qcol = QC + head * 64; kcol = KC + (head / 3) * 64; vcol = VC + (head / 3) * 64; ocol = OC + head * 64; }
    float q[64], o[64];
#pragma unroll
    for (int c = 0; c < 8; ++c) { const v4u w = *(const GAS v4u*)(QKV + trow * DIN + qcol + 8 * c);
        q[8 * c + 0] = bflo(w.x); q[8 * c + 1] = bfhi(w.x); q[8 * c + 2] = bflo(w.y); q[8 * c + 3] = bfhi(w.y); q[8 * c + 4] = bflo(w.z); q[8 * c + 5] = bfhi(w.z); q[8 * c + 6] = bflo(w.w); q[8 * c + 7] = bfhi(w.w); }
#pragma unroll
    for (int d = 0; d < 64; ++d) o[d] = 0.f;
    float m = -1e30f, l = 0.f;
    int j0, j1;
    if (TYPE == 0) { j0 = grow * 64 - 128; if (j0 < 0) j0 = 0; j1 = grow * 64 + 63 + 128; if (j1 > SEQ - 1) j1 = SEQ - 1; }
    else if (TYPE == 1) { int r0 = grow - 4; r0 = r0 < 0 ? 0 : (r0 > 24 ? 24 : r0); j0 = r0 * 64; j1 = j0 + 511; }
    else { j0 = 0; j1 = SEQ - 1; }
    int c0 = lane - 8; c0 = c0 < 0 ? 0 : (c0 > 48 ? 48 : c0);
#pragma unroll 1
    for (int j = j0; j <= j1; ++j) {
        const bf16* krow = QKV + ((size_t)b * SEQ + j) * DIN;
        float s = 0.f;
#pragma unroll
        for (int c = 0; c < 8; ++c) { const v4u w = *(const GAS v4u*)(krow + kcol + 8 * c);
            s += q[8 * c + 0] * bflo(w.x) + q[8 * c + 1] * bfhi(w.x) + q[8 * c + 2] * bflo(w.y) + q[8 * c + 3] * bfhi(w.y) + q[8 * c + 4] * bflo(w.z) + q[8 * c + 5] * bfhi(w.z) + q[8 * c + 6] * bflo(w.w) + q[8 * c + 7] * bfhi(w.w); }
        bool valid = true;
        if (TYPE == 0) { const int rel = j - tpos; valid = (rel >= -128 && rel <= 128); if (valid) s += biasA[head * 257 + rel + 128]; }
        if (TYPE == 1) { const int kr = j >> 6, kc = j & 63; valid = (kc >= c0 && kc < c0 + 16); if (valid) s += rpb[(head * 15 + (kr - grow + 7)) * 31 + (kc - lane + 15)]; }
        const float mn = valid ? fmaxf(m, s) : m;
        const float a = __expf(m - mn);
        const float p = valid ? __expf(s - mn) : 0.f;
        l = l * a + p; m = mn;
#pragma unroll
        for (int c = 0; c < 8; ++c) { const v4u w = *(const GAS v4u*)(krow + vcol + 8 * c);
            o[8 * c + 0] = o[8 * c + 0] * a + p * bflo(w.x); o[8 * c + 1] = o[8 * c + 1] * a + p * bfhi(w.x); o[8 * c + 2] = o[8 * c + 2] * a + p * bflo(w.y); o[8 * c + 3] = o[8 * c + 3] * a + p * bfhi(w.y);
            o[8 * c + 4] = o[8 * c + 4] * a + p * bflo(w.z); o[8 * c + 5] = o[8 * c + 5] * a + p * bfhi(w.z); o[8 * c + 6] = o[8 * c + 6] * a + p * bflo(w.w); o[8 * c + 7] = o[8 * c + 7] * a + p * bfhi(w.w); }
    }
    if (TYPE == 0) l += __expf(sink[head] - m);
    const float inv = 1.f / l;
#pragma unroll
    for (int c = 0; c < 8; ++c) { v4u w; w.x = pk2(o[8 * c + 0] * inv, o[8 * c + 1] * inv); w.y = pk2(o[8 * c + 2] * inv, o[8 * c + 3] * inv); w.z = pk2(o[8 * c + 4] * inv, o[8 * c + 5] * inv); w.w = pk2(o[8 * c + 6] * inv, o[8 * c + 7] * inv);
        *(GAS v4u*)(ATT + trow * DM + ocol + 8 * c) = w; }
}
__device__ __forceinline__ float rdl(float v, int l) { return __builtin_bit_cast(float, __builtin_amdgcn_readlane(__builtin_bit_cast(int, v), l)); }
__device__ __forceinline__ void naive_mem_item(const bf16* QM, const bf16* KVM, bf16* OM, const float* gq, size_t trow, int b, int head, int lane) {
    const unsigned qw = *(const GAS unsigned*)(QM + trow * MEMW + head * 128 + 2 * lane);
    float q0 = bflo(qw), q1 = bfhi(qw);
    const float ss = wave_sum(q0 * q0 + q1 * q1, lane);
    const float r = 0.08838834764831845f / sqrtf(ss * (1.f / 128.f) + EPS);
    q0 *= r * gq[2 * lane]; q1 *= r * gq[2 * lane + 1];
    const bf16* kbase = KVM + ((size_t)b * NMEM + lane) * 1024 + head * 128;
    float s[4] = {0.f, 0.f, 0.f, 0.f};
#pragma unroll 1
    for (int c = 0; c < 16; ++c) {
        float qa[8];
#pragma unroll
        for (int e = 0; e < 4; ++e) { qa[2 * e] = rdl(q0, 4 * c + e); qa[2 * e + 1] = rdl(q1, 4 * c + e); }
#pragma unroll
        for (int i = 0; i < 4; ++i) { const v4u w = *(const GAS v4u*)(kbase + (size_t)i * 64 * 1024 + 8 * c);
            s[i] += qa[0] * bflo(w.x) + qa[1] * bfhi(w.x) + qa[2] * bflo(w.y) + qa[3] * bfhi(w.y) + qa[4] * bflo(w.z) + qa[5] * bfhi(w.z) + qa[6] * bflo(w.w) + qa[7] * bfhi(w.w); }
    }
    float m = fmaxf(fmaxf(s[0], s[1]), fmaxf(s[2], s[3]));
#pragma unroll
    for (int o = 1; o < 64; o <<= 1) m = fmaxf(m, shx(m, o, lane));
    float p[4]; float l = 0.f;
#pragma unroll
    for (int i = 0; i < 4; ++i) { p[i] = __expf(s[i] - m); l += p[i]; }
    l = wave_sum(l, lane);
    const bf16* vbase = KVM + ((size_t)b * NMEM) * 1024 + 512 + head * 128 + 2 * lane;
    float o0 = 0.f, o1 = 0.f;
#pragma unroll
    for (int i = 0; i < 4; ++i) {
#pragma unroll 4
        for (int jj = 0; jj < 64; ++jj) { const float pj = rdl(p[i], jj); const unsigned w = *(const GAS unsigned*)(vbase + (size_t)(64 * i + jj) * 1024); o0 += pj * bflo(w); o1 += pj * bfhi(w); }
    }
    const float inv = 1.f / l;
    *(GAS unsigned*)(OM + trow * MEMW + head * 128 + 2 * lane) = pk2(o0 * inv, o1 * inv);
}
__device__ __forceinline__ void mixnorm_rows(bf16* ATT, const float* g, int gw, int NGW, int lane) {
    for (int m = gw; m < T; m += NGW) {
        GAS v4u* p = (GAS v4u*)(ATT + (size_t)m * DM + 32 * lane);
        v4u w[4]; float f[32]; float ss = 0.f;
#pragma unroll
        for (int c = 0; c < 4; ++c) { w[c] = p[c];
            f[8 * c + 0] = bflo(w[c].x); f[8 * c + 1] = bfhi(w[c].x); f[8 * c + 2] = bflo(w[c].y); f[8 * c + 3] = bfhi(w[c].y); f[8 * c + 4] = bflo(w[c].z); f[8 * c + 5] = bfhi(w[c].z); f[8 * c + 6] = bflo(w[c].w); f[8 * c + 7] = bfhi(w[c].w); }
#pragma unroll
        for (int i = 0; i < 32; ++i) ss += f[i] * f[i];
        const int grp = lane < 24 ? 0 : (lane < 40 ? 1 : 2);
        const float sa = wave_sum(grp == 0 ? ss : 0.f, lane), sb = wave_sum(grp == 1 ? ss : 0.f, lane), sc = wave_sum(grp == 2 ? ss : 0.f, lane);
        const float r = grp == 0 ? 1.f / sqrtf(sa * (1.f / 768.f) + EPS) : (grp == 1 ? 1.f / sqrtf(sb * (1.f / 512.f) + EPS) : 1.f / sqrtf(sc * (1.f / 768.f) + EPS));
        const float* gg = g + 32 * lane;
#pragma unroll
        for (int c = 0; c < 4; ++c) { const f32x4 g0 = *(const GAS f32x4*)(gg + 8 * c), g1 = *(const GAS f32x4*)(gg + 8 * c + 4);
            v4u o; o.x = pk2(f[8 * c + 0] * r * g0[0], f[8 * c + 1] * r * g0[1]); o.y = pk2(f[8 * c + 2] * r * g0[2], f[8 * c + 3] * r * g0[3]);
            o.z = pk2(f[8 * c + 4] * r * g1[0], f[8 * c + 5] * r * g1[1]); o.w = pk2(f[8 * c + 6] * r * g1[2], f[8 * c + 7] * r * g1[3]); p[c] = o; }
    }
}

#ifndef PEER_HD
#define PEER_HD __device__ __forceinline__
#define PEER_EXP(x) __expf(x)
#endif
template <int N> PEER_HD void bitonic_sort_desc(float* v) {
#pragma unroll
    for (int k = 2; k <= N; k <<= 1)
#pragma unroll
        for (int j = k >> 1; j > 0; j >>= 1)
#pragma unroll
            for (int i = 0; i < N; ++i) { const int l = i ^ j; if (l > i) { const bool desc = ((i & k) == 0); const float a = v[i], b = v[l]; const float hi = fmaxf(a, b), lo = fminf(a, b);
                v[i] = desc ? hi : lo; v[l] = desc ? lo : hi; } }
}
PEER_HD void merge_top16(float* a, const float* b) {
    float c[16];
#pragma unroll
    for (int i = 0; i < 16; ++i) c[i] = fmaxf(a[i], b[15 - i]);
#pragma unroll
    for (int j = 8; j > 0; j >>= 1)
#pragma unroll
        for (int i = 0; i < 16; ++i) { const int l = i ^ j; if (l > i) { const float x = c[i], y = c[l]; c[i] = fmaxf(x, y); c[l] = fminf(x, y); } }
#pragma unroll
    for (int i = 0; i < 16; ++i) a[i] = c[i];
}
PEER_HD void top16_of_64(float (&v)[64]) {
    bitonic_sort_desc<16>(&v[0]); bitonic_sort_desc<16>(&v[16]); bitonic_sort_desc<16>(&v[32]); bitonic_sort_desc<16>(&v[48]);
    merge_top16(&v[0], &v[16]); merge_top16(&v[32], &v[48]); merge_top16(&v[0], &v[32]);
}
PEER_HD float pack_idx(float s, unsigned idx, unsigned mask) { return __builtin_bit_cast(float, (__builtin_bit_cast(unsigned, s) & ~mask) | idx); }
PEER_HD unsigned low_bits(float s, unsigned mask) { return __builtin_bit_cast(unsigned, s) & mask; }
PEER_HD unsigned pick16(const float* a, unsigned i, unsigned mask) {
    unsigned r = 0;
#pragma unroll
    for (unsigned k = 0; k < 16; ++k) r = (i == k) ? low_bits(a[k], mask) : r;
    return r;
}
PEER_HD void peer_candidates(const float* a, const float* b, int* e, float* gate) {
    float c[64]; int n = 0;
#pragma unroll
    for (int i = 0; i < 16; ++i)
#pragma unroll
        for (int j = 0; j < 16; ++j) if ((i + 1) * (j + 1) <= 16) { c[n] = pack_idx(a[i] + b[j], (unsigned)(i * 16 + j), 0xffu); ++n; }
#pragma unroll
    for (int k = 50; k < 64; ++k) c[k] = -3.0e38f;
    top16_of_64(c);
    float mx = c[0], den = 0.f;
#pragma unroll
    for (int k = 0; k < 16; ++k) { const unsigned id = low_bits(c[k], 0xffu); const unsigned n0 = pick16(a, id >> 4, 0x7fu), n1 = pick16(b, id & 15u, 0x7fu);
        e[k] = (int)(n0 * 128u + n1); gate[k] = PEER_EXP(c[k] - mx); den += gate[k]; }
    const float inv = 1.f / den;
#pragma unroll
    for (int k = 0; k < 16; ++k) gate[k] *= inv;
}

__device__ __forceinline__ void peer_select_unit(const bf16* QP, const bf16* PK, int* PIDX, float* PGATE, int tb, int h, int wave, int lane) {
    const int hh = lane >> 5, tl = lane & 31; const size_t t = (size_t)tb * 256 + wave * 32 + tl;
    float ab[2][16];
#pragma unroll
    for (int p = 0; p < 2; ++p) {
        bf16x8 bq[8];
#pragma unroll
        for (int s = 0; s < 8; ++s) bq[s] = *(const GAS bf16x8*)(QP + t * DM + 256 * h + 128 * p + 16 * s + 8 * hh);
        float v[64];
#pragma unroll
        for (int nb = 0; nb < 4; ++nb) {
            f32x16 acc;
#pragma unroll
            for (int r = 0; r < 16; ++r) acc[r] = 0.f;
            const bf16* kp = PK + ((size_t)((h * 2 + p) * 128 + 32 * nb + tl)) * 128 + 8 * hh;
            bf16x8 ak[8];
#pragma unroll
            for (int s = 0; s < 8; ++s) ak[s] = *(const GAS bf16x8*)(kp + 16 * s);
#pragma unroll
            for (int s = 0; s < 8; ++s) acc = __builtin_amdgcn_mfma_f32_32x32x16_bf16(ak[s], bq[s], acc, 0, 0, 0);
#pragma unroll
            for (int r = 0; r < 16; ++r) v[16 * nb + r] = pack_idx(acc[r], (unsigned)(32 * nb + 8 * (r >> 2) + 4 * hh + (r & 3)), 0x7fu);
        }
        top16_of_64(v);
        float pv[16];
#pragma unroll
        for (int i = 0; i < 16; ++i) pv[i] = shx(v[i], 32, lane);
        merge_top16(&v[0], pv);
#pragma unroll
        for (int i = 0; i < 16; ++i) ab[p][i] = v[i];
    }
    int e[16]; float gate[16];
    peer_candidates(ab[0], ab[1], e, gate);
    if (hh == 0) { GAS v4u* o = (GAS v4u*)(PIDX + t * 128 + h * 16);
#pragma unroll
        for (int c = 0; c < 4; ++c) o[c] = (v4u){(unsigned)e[4 * c], (unsigned)e[4 * c + 1], (unsigned)e[4 * c + 2], (unsigned)e[4 * c + 3]}; }
    else { GAS f32x4* o = (GAS f32x4*)(PGATE + t * 128 + h * 16);
#pragma unroll
        for (int c = 0; c < 4; ++c) o[c] = (f32x4){gate[4 * c], gate[4 * c + 1], gate[4 * c + 2], gate[4 * c + 3]}; }
}

typedef float f32x2 __attribute__((ext_vector_type(2)));
typedef unsigned v6u __attribute__((ext_vector_type(6)));
typedef float v32f __attribute__((ext_vector_type(32)));
typedef v4u __attribute__((aligned(8))) v4u_a8;
constexpr float PU_SCALE6 = 90.0f, PV_SCALE6 = 5.65f;
__device__ __forceinline__ unsigned enc_e2m3(float v) {
    const float a = fminf(fabsf(v), 7.5f);
    unsigned code;
    if (a < 1.0f) code = (unsigned)__builtin_rintf(a * 8.f);
    else { const unsigned b = __builtin_bit_cast(unsigned, a) - 0x3F800000u; code = ((b + 0x7FFFFu + ((b >> 20) & 1u)) >> 20) + 8u; }
    return code | (v < 0.f ? 32u : 0u);
}
__device__ __forceinline__ void convert_fp6_rows(const float* src, unsigned char* dst, int nrows, float scale, const float* gain, int gw, int NGW, int lane) {
    for (int r = gw; r < nrows; r += NGW) {
        const float* sp = src + (size_t)r * DM + 4 * lane; const float* gp = gain ? gain + (size_t)(r / PEER_N) * DM + 4 * lane : nullptr;
        unsigned w[6] = {0u, 0u, 0u, 0u, 0u, 0u};
#pragma unroll
        for (int j = 0; j < 8; ++j) { f32x4 a = *(const GAS f32x4*)(sp + 256 * j) * scale; if (gp) a = a * *(const GAS f32x4*)(gp + 256 * j);
#pragma unroll
            for (int e = 0; e < 4; ++e) { const unsigned code = enc_e2m3(a[e]); const int bp = 6 * (4 * j + e), wi = bp >> 5, sh = bp & 31;
                w[wi] |= code << sh; if (sh > 26) w[wi + 1] |= code >> (32 - sh); } }
        unsigned char* dp = dst + (size_t)r * 1536 + 24 * lane;
        *(GAS v4u_a8*)dp = (v4u){w[0], w[1], w[2], w[3]}; *(GAS v2u*)(dp + 16) = (v2u){w[4], w[5]};
    }
}
constexpr float PV_SCALE4 = 5.65f, PU_SCALE4 = 90.0f;
__device__ __forceinline__ unsigned enc_e2m1(float v) {
    const float a = fabsf(v);
    const unsigned code = a < 0.25f ? 0u : a < 0.75f ? 1u : a < 1.25f ? 2u : a < 1.75f ? 3u : a < 2.5f ? 4u : a < 3.5f ? 5u : a < 5.0f ? 6u : 7u;
    return code | (v < 0.f ? 8u : 0u);
}
__device__ __forceinline__ void convert_fp4_rows(const float* src, unsigned char* dst, int nrows, float scale, const float* gain, int gw, int NGW, int lane) {
    for (int r0 = 2 * gw; r0 < nrows; r0 += 2 * NGW) {
        f32x4 a[2][8];
#pragma unroll
        for (int q = 0; q < 2; ++q) { const float* sp = src + (size_t)(r0 + q) * DM + 4 * lane;
#pragma unroll
            for (int j = 0; j < 8; ++j) a[q][j] = *(const GAS f32x4*)(sp + 256 * j); }
#pragma unroll
        for (int q = 0; q < 2; ++q) { const int r = r0 + q; const float* gp = gain ? gain + (size_t)(r / PEER_N) * DM + 4 * lane : nullptr;
            unsigned w[4] = {0u, 0u, 0u, 0u};
#pragma unroll
            for (int j = 0; j < 8; ++j) { f32x4 v = a[q][j] * scale; if (gp) v = v * *(const GAS f32x4*)(gp + 256 * j);
#pragma unroll
                for (int e = 0; e < 4; ++e) { const int i = 4 * j + e; w[i >> 3] |= enc_e2m1(v[e]) << (4 * (i & 7)); } }
            *(GAS v4u*)(dst + (size_t)r * 1024 + 16 * lane) = (v4u){w[0], w[1], w[2], w[3]}; }
    }
}
#define PG4_LOAD(buf, tab, idlo, idhi, g) do { _Pragma("unroll") for (int i_ = 0; i_ < PG6_R; ++i_) { const int k_ = (g) * PG6_R + i_; \
        const int e_ = __builtin_amdgcn_readlane(k_ < 64 ? idlo : idhi, k_ & 63); buf[i_] = __builtin_amdgcn_raw_buffer_load_b128(tab, (int)voff4, e_ * 1024, 0); } } while (0)
#define PG4_DOT1(buf, i_, dst) do { f32x2 a_ = {0.f, 0.f}; _Pragma("unroll") for (int c_ = 0; c_ < 4; ++c_) { const unsigned u_ = buf[i_][c_]; \
        a_ += __builtin_amdgcn_cvt_scalef32_pk_f32_fp4(u_, 1.0f, 0) * x[4 * c_ + 0]; a_ += __builtin_amdgcn_cvt_scalef32_pk_f32_fp4(u_, 1.0f, 1) * x[4 * c_ + 1]; \
        a_ += __builtin_amdgcn_cvt_scalef32_pk_f32_fp4(u_, 1.0f, 2) * x[4 * c_ + 2]; a_ += __builtin_amdgcn_cvt_scalef32_pk_f32_fp4(u_, 1.0f, 3) * x[4 * c_ + 3]; } dst = a_.x + a_.y; __builtin_amdgcn_sched_barrier(0); } while (0)
#define PG4_DOT(buf, g) do { float p_[8]; _Pragma("unroll") for (int i_ = 0; i_ < 8; ++i_) PG4_DOT1(buf, i_, p_[i_]); \
        float q_[4]; _Pragma("unroll") for (int i_ = 0; i_ < 4; ++i_) { const float keep_ = b5 ? p_[i_ + 4] : p_[i_], send_ = b5 ? p_[i_] : p_[i_ + 4]; q_[i_] = keep_ + shx(send_, 32, lane); } \
        float r_[2]; _Pragma("unroll") for (int i_ = 0; i_ < 2; ++i_) { const float keep_ = b4 ? q_[i_ + 2] : q_[i_], send_ = b4 ? q_[i_] : q_[i_ + 2]; r_[i_] = keep_ + shx(send_, 16, lane); } \
        float s_; { const float keep_ = b3 ? r_[1] : r_[0], send_ = b3 ? r_[0] : r_[1]; s_ = keep_ + shx(send_, 8, lane); } \
        s_ += shx(s_, 4, lane); s_ += shx(s_, 2, lane); s_ += shx(s_, 1, lane); \
        if ((lane & 7) == 0) wl[(g) * 8 + (lane >> 3)] = s_; } while (0)
#define PG4_AXPY(buf, g) do { _Pragma("unroll") for (int i_ = 0; i_ < PG6_R; ++i_) { const float w_ = wl[(g) * PG6_R + i_]; const f32x2 wv_ = {w_, w_}; \
        _Pragma("unroll") for (int c_ = 0; c_ < 4; ++c_) { const unsigned u_ = buf[i_][c_]; \
            y[4 * c_ + 0] += __builtin_amdgcn_cvt_scalef32_pk_f32_fp4(u_, 1.0f, 0) * wv_; y[4 * c_ + 1] += __builtin_amdgcn_cvt_scalef32_pk_f32_fp4(u_, 1.0f, 1) * wv_; \
            y[4 * c_ + 2] += __builtin_amdgcn_cvt_scalef32_pk_f32_fp4(u_, 1.0f, 2) * wv_; y[4 * c_ + 3] += __builtin_amdgcn_cvt_scalef32_pk_f32_fp4(u_, 1.0f, 3) * wv_; } \
        __builtin_amdgcn_sched_barrier(0); } } while (0)
#ifndef PG6_R
#define PG6_R 8
#endif
#define PG6_LOAD(buf, tab, idlo, idhi, g) do { _Pragma("unroll") for (int i_ = 0; i_ < PG6_R; ++i_) { const int k_ = (g) * PG6_R + i_; \
        const int e_ = __builtin_amdgcn_readlane(k_ < 64 ? idlo : idhi, k_ & 63); const unsigned char* rp_ = (tab) + (size_t)(unsigned)e_ * 1536u; \
        const v4u a_ = *(const GAS v4u_a8*)(rp_ + voff); const v2u b_ = *(const GAS v2u*)(rp_ + voff + 16); buf[i_] = (v6u){a_.x, a_.y, a_.z, a_.w, b_.x, b_.y}; } } while (0)
#define PG6_DOT1(buf, i_, dst) do { const v32f f_ = __builtin_amdgcn_cvt_scalef32_pk32_f32_fp6(buf[i_], 1.0f); f32x2 a_ = {0.f, 0.f}; \
        _Pragma("unroll") for (int c_ = 0; c_ < 16; ++c_) a_ += (f32x2){f_[2 * c_], f_[2 * c_ + 1]} * x[c_]; dst = a_.x + a_.y; __builtin_amdgcn_sched_barrier(0); } while (0)
#if PG6_R == 8
#define PG6_DOT(buf, g) do { float p_[8]; _Pragma("unroll") for (int i_ = 0; i_ < 8; ++i_) PG6_DOT1(buf, i_, p_[i_]); \
        float q_[4]; _Pragma("unroll") for (int i_ = 0; i_ < 4; ++i_) { const float keep_ = b5 ? p_[i_ + 4] : p_[i_], send_ = b5 ? p_[i_] : p_[i_ + 4]; q_[i_] = keep_ + shx(send_, 32, lane); } \
        float r_[2]; _Pragma("unroll") for (int i_ = 0; i_ < 2; ++i_) { const float keep_ = b4 ? q_[i_ + 2] : q_[i_], send_ = b4 ? q_[i_] : q_[i_ + 2]; r_[i_] = keep_ + shx(send_, 16, lane); } \
        float s_; { const float keep_ = b3 ? r_[1] : r_[0], send_ = b3 ? r_[0] : r_[1]; s_ = keep_ + shx(send_, 8, lane); } \
        s_ += shx(s_, 4, lane); s_ += shx(s_, 2, lane); s_ += shx(s_, 1, lane); \
        if ((lane & 7) == 0) wl[(g) * 8 + (lane >> 3)] = s_; } while (0)
#else
#define PG6_DOT(buf, g) do { float p_[4]; _Pragma("unroll") for (int i_ = 0; i_ < 4; ++i_) PG6_DOT1(buf, i_, p_[i_]); \
        float r_[2]; _Pragma("unroll") for (int i_ = 0; i_ < 2; ++i_) { const float keep_ = b5 ? p_[i_ + 2] : p_[i_], send_ = b5 ? p_[i_] : p_[i_ + 2]; r_[i_] = keep_ + shx(send_, 32, lane); } \
        float s_; { const float keep_ = b4 ? r_[1] : r_[0], send_ = b4 ? r_[0] : r_[1]; s_ = keep_ + shx(send_, 16, lane); } \
        s_ += shx(s_, 8, lane); s_ += shx(s_, 4, lane); s_ += shx(s_, 2, lane); s_ += shx(s_, 1, lane); \
        if ((lane & 15) == 0) wl[(g) * 4 + (lane >> 4)] = s_; } while (0)
#endif
#define PG6_AXPY(buf, g) do { _Pragma("unroll") for (int i_ = 0; i_ < PG6_R; ++i_) { const float w_ = wl[(g) * PG6_R + i_]; const f32x2 wv_ = {w_, w_}; \
        const v32f f_ = __builtin_amdgcn_cvt_scalef32_pk32_f32_fp6(buf[i_], 1.0f); _Pragma("unroll") for (int c_ = 0; c_ < 16; ++c_) y[c_] += (f32x2){f_[2 * c_], f_[2 * c_ + 1]} * wv_; __builtin_amdgcn_sched_barrier(0); } } while (0)
__device__ __forceinline__ unsigned shxu(unsigned v, int k, int lane) { return (unsigned)__builtin_amdgcn_ds_bpermute((lane ^ k) << 2, (int)v); }
__device__ __forceinline__ void wave_sort128(unsigned& a, unsigned& b, int lane) {
#pragma unroll
    for (int k = 2; k <= 128; k <<= 1) {
#pragma unroll
        for (int j = k >> 1; j > 0; j >>= 1) {
            if (j == 64) { const unsigned lo = a < b ? a : b, hi = a < b ? b : a; a = lo; b = hi; }
            else {
                const unsigned pa = shxu(a, j, lane), pb = shxu(b, j, lane);
                const bool lower = (lane & j) == 0;
                const bool asc_a = (lane & k) == 0, asc_b = ((lane + 64) & k) == 0;
                const bool take_min_a = (lower == asc_a), take_min_b = (lower == asc_b);
                a = take_min_a ? (a < pa ? a : pa) : (a < pa ? pa : a);
                b = take_min_b ? (b < pb ? b : pb) : (b < pb ? pb : b);
            }
        }
    }
}
#ifndef PEER_U_FP4
#define PEER_U_FP4 1
#endif
#if PEER_U_FP4
typedef v4u urow_t;
#define PGU_LOAD PG4_LOAD
#define PGU_DOT PG4_DOT
constexpr float PU_SCALE = PU_SCALE4; constexpr int PU_STRIDE = 1024;
#else
typedef v6u urow_t;
#define PGU_LOAD PG6_LOAD
#define PGU_DOT PG6_DOT
constexpr float PU_SCALE = PU_SCALE6; constexpr int PU_STRIDE = 1536;
#endif
constexpr float PU_SCALEI = 135.0f, PX_SCALEI = 20.0f;
__device__ __forceinline__ void peer_v_pass(bf16* XN, const unsigned char* PV6, const int* PIDX, const float* PGATE, const int* PARTI, float* X, u64_t* rowsq_out, unsigned char* XN8, float* xsc, LAS float* wl, int gw, int NGW, int lane) {
    const unsigned voff4 = 16u * (unsigned)lane, l4 = 4u * (unsigned)lane, l8 = 8u * (unsigned)lane, l16 = 16u * (unsigned)lane;
    constexpr int NG = 128 / PG6_R;
    const __amdgpu_buffer_rsrc_t PVr = __builtin_amdgcn_make_buffer_rsrc((void*)PV6, 0, PEER_N * 1024, 0x00020000);
    for (int t_ = gw; t_ < T; t_ += NGW) {
        int t = t_; asm volatile("" : "+s"(t));
        const char* pidx_t = (const char*)(PIDX + (size_t)t * 128); const char* pgate_t = (const char*)(PGATE + (size_t)t * 128);
        const int idlo = *(const GAS int*)(pidx_t + l4), idhi = *(const GAS int*)(pidx_t + l4 + 256);
        v4u AV[PG6_R], BV[PG6_R];
        PG4_LOAD(AV, PVr, idlo, idhi, 0);
        {
            int s0 = 0, s1 = 0;
#pragma unroll
            for (int sp = 0; sp < 8; ++sp) { const char* pp = (const char*)(PARTI + ((size_t)sp * T + t) * 128); s0 += *(const GAS int*)(pp + l4); s1 += *(const GAS int*)(pp + l4 + 256); }
            const float d0 = (float)s0 * (1.f / (PX_SCALEI * PU_SCALEI)), d1 = (float)s1 * (1.f / (PX_SCALEI * PU_SCALEI));
            const float g0 = *(const GAS float*)(pgate_t + l4), g1 = *(const GAS float*)(pgate_t + l4 + 256);
            const float w0 = g0 * 0.5f * d0 * (1.f + erff(d0 * 0.70710678118654752f)) * (1.f / PV_SCALE4), w1 = g1 * 0.5f * d1 * (1.f + erff(d1 * 0.70710678118654752f)) * (1.f / PV_SCALE4);
            wl[lane] = w0; wl[64 + lane] = w1;
            LDS_WAIT(); asm volatile("" ::: "memory");
        }
        f32x2 y[16];
#pragma unroll
        for (int i = 0; i < 16; ++i) y[i] = (f32x2){0.f, 0.f};
#pragma unroll 1
        for (int g = 0; g < NG; g += 2) {
            PG4_LOAD(BV, PVr, idlo, idhi, g + 1);
            PG4_AXPY(AV, g);
            if (g + 2 < NG) PG4_LOAD(AV, PVr, idlo, idhi, g + 2);
            PG4_AXPY(BV, g + 1);
        }
        {   char* xo = (char*)(X + (size_t)t * DM);
            char* xbo = (char*)(XN + (size_t)t * DM); float ss = 0.f;
#pragma unroll
            for (int j = 0; j < 8; ++j) { const v2u a = *(const GAS v2u*)(xbo + l8 + 512 * j); f32x4 v = (f32x4){bflo(a.x), bfhi(a.x), bflo(a.y), bfhi(a.y)}; v += (f32x4){y[2 * j].x, y[2 * j].y, y[2 * j + 1].x, y[2 * j + 1].y};
                if (X) *(GAS f32x4*)(xo + l16 + 1024 * j) = v;
                y[2 * j] = (f32x2){v[0], v[1]}; y[2 * j + 1] = (f32x2){v[2], v[3]};
                ss += (v[0] * v[0] + v[1] * v[1]) + (v[2] * v[2] + v[3] * v[3]); *(GAS v2u*)(xbo + l8 + 512 * j) = (v2u){pk2(v[0], v[1]), pk2(v[2], v[3])}; }
            if (rowsq_out) { ss = wave_sum(ss, lane); if (lane == 0) rowsq_out[t] = rowsq_fx(ss); }
            if (XN8) {
                float am = 0.f;
#pragma unroll
                for (int j = 0; j < 16; ++j) am = fmaxf(am, fmaxf(fabsf(y[j].x), fabsf(y[j].y)));
                am = fmaxf(wave_max(am, lane), 1e-30f);
                const float inv = 127.f / am; char* qo = (char*)(XN8 + (size_t)t * DM);
#pragma unroll
                for (int j = 0; j < 8; ++j) *(GAS unsigned*)(qo + l4 + 256 * j) = q8x4((f32x4){y[2 * j].x, y[2 * j].y, y[2 * j + 1].x, y[2 * j + 1].y}, inv);
                if (lane == 0) xsc[t] = am * (1.f / 127.f); } }
        LDS_WAIT(); asm volatile("" ::: "memory");
    }
}


__device__ __forceinline__ unsigned enc_i4(float v) { int q = (int)__builtin_rintf(v); q = q < -7 ? -7 : (q > 7 ? 7 : q); return (unsigned)q & 15u; }
__device__ __forceinline__ void convert_int4_plain(const float* src, unsigned char* dst, int nrows, float scale, const float* gain, int gw, int NGW, int lane) {
    for (int r0 = 2 * gw; r0 < nrows; r0 += 2 * NGW) {
        f32x4 a[2][8];
#pragma unroll
        for (int q = 0; q < 2; ++q) { const float* sp = src + (size_t)(r0 + q) * DM + 4 * lane;
#pragma unroll
            for (int j = 0; j < 8; ++j) a[q][j] = *(const GAS f32x4*)(sp + 256 * j); }
#pragma unroll
        for (int q = 0; q < 2; ++q) { const int r = r0 + q; const float* gp = gain ? gain + (size_t)(r / PEER_N) * DM + 4 * lane : nullptr;
#pragma unroll
            for (int j = 0; j < 8; ++j) { f32x4 v = a[q][j] * scale; if (gp) v = v * *(const GAS f32x4*)(gp + 256 * j);
                const unsigned w = enc_i4(v[0]) | (enc_i4(v[1]) << 4) | (enc_i4(v[2]) << 8) | (enc_i4(v[3]) << 12);
                *(GAS unsigned short*)(dst + (size_t)r * 1024 + 128 * j + 2 * lane) = (unsigned short)w; } }
    }
}
__device__ __forceinline__ void peer_xquant_unit(const bf16* XN, const u64_t* rowsq, unsigned* XQH, unsigned* XQL, int tb, int sl, int tid) {
    for (int it = tid; it < 256 * 32; it += NTHREADS) {
        const int t = tb * 256 + (it >> 5), c8 = it & 31;
        const float xs = PX_SCALEI * rowsq_rs(rowsq, t);
        const v4u w = *(const GAS v4u*)(XN + (size_t)t * DM + 256 * sl + 8 * c8);
        const float f[8] = {bflo(w.x), bfhi(w.x), bflo(w.y), bfhi(w.y), bflo(w.z), bfhi(w.z), bflo(w.w), bfhi(w.w)};
        unsigned hi = 0u, lo = 0u;
#pragma unroll
        for (int j = 0; j < 8; ++j) { int q = (int)__builtin_rintf(f[j] * xs); q = q < -119 ? -119 : (q > 119 ? 119 : q);
            const int xl = ((q + 8) & 15) - 8, xh = (q - xl) >> 4;
            hi |= ((unsigned)xh & 15u) << (4 * j); lo |= ((unsigned)xl & 15u) << (4 * j); }
        XQH[(size_t)t * 256 + 32 * sl + c8] = hi; XQL[(size_t)t * 256 + 32 * sl + c8] = lo;
    }
}
#define PI_LOADROWS(buf, tab, ids, i0) do { _Pragma("unroll") for (int i_ = 0; i_ < 8; ++i_) buf[i_] = __builtin_amdgcn_raw_buffer_load_b128(tab, ids[(i0) + i_] * 1024 + (int)soff, 0, 0); } while (0)
#define PI_LOADIDS(ids, t) do { const char* ip_ = (const char*)PIDX + ((size_t)(t) * 128 + 16 * g) * 4; _Pragma("unroll") for (int c_ = 0; c_ < 4; ++c_) { const v4u q_ = *(const GAS v4u*)(ip_ + 16 * c_); \
        ids[4 * c_] = (int)q_.x; ids[4 * c_ + 1] = (int)q_.y; ids[4 * c_ + 2] = (int)q_.z; ids[4 * c_ + 3] = (int)q_.w; } } while (0)
#define PI_UGROUP(buf, i0) do { _Pragma("unroll") for (int i_ = 0; i_ < 8; ++i_) { int ah_ = 0, al_ = 0; \
        _Pragma("unroll") for (int c_ = 0; c_ < 4; ++c_) { ah_ = __builtin_amdgcn_sdot8((int)buf[i_][c_], (int)xh[c_], ah_, false); al_ = __builtin_amdgcn_sdot8((int)buf[i_][c_], (int)xl[c_], al_, false); } \
        int p_ = 16 * ah_ + al_; p_ += __builtin_amdgcn_ds_bpermute((lane ^ 1) << 2, p_); p_ += __builtin_amdgcn_ds_bpermute((lane ^ 2) << 2, p_); p_ += __builtin_amdgcn_ds_bpermute((lane ^ 4) << 2, p_); \
        if (m == (((i0) + i_) >> 1)) { if (((i0) + i_) & 1) keep1 = p_; else keep0 = p_; } } } while (0)
#define PI_LOADROWS16(buf, tab, ids) do { _Pragma("unroll") for (int i_ = 0; i_ < 16; ++i_) buf[i_] = __builtin_amdgcn_raw_buffer_load_b128(tab, ids[i_] * 1024 + (int)soff, 0, 0); } while (0)
#define PI_LOADX(xh_, xl_, t) do { xh_ = *(const GAS v4u*)((const char*)XQH + (size_t)(t) * 1024 + soff); xl_ = *(const GAS v4u*)((const char*)XQL + (size_t)(t) * 1024 + soff); } while (0)
#define PI_COMPUTE16(buf, xh_, xl_, t) do { int keep0 = 0, keep1 = 0; \
        _Pragma("unroll") for (int i_ = 0; i_ < 16; ++i_) { int ah_ = 0, al_ = 0; \
            _Pragma("unroll") for (int c_ = 0; c_ < 4; ++c_) { ah_ = __builtin_amdgcn_sdot8((int)buf[i_][c_], (int)xh_[c_], ah_, false); al_ = __builtin_amdgcn_sdot8((int)buf[i_][c_], (int)xl_[c_], al_, false); } \
            int p_ = 16 * ah_ + al_; p_ += __builtin_amdgcn_update_dpp(0, p_, 0xB1, 0xf, 0xf, true); p_ += __builtin_amdgcn_update_dpp(0, p_, 0x4E, 0xf, 0xf, true); p_ += __builtin_amdgcn_update_dpp(0, p_, 0x141, 0xf, 0xf, true);   \
            if (m == (i_ >> 1)) { if (i_ & 1) keep1 = p_; else keep0 = p_; } } \
        if ((t) < T) *(GAS v2u*)(PARTI + ((size_t)s * T + (t)) * 128 + 2 * lane) = (v2u){(unsigned)keep0, (unsigned)keep1}; } while (0)
__device__ __forceinline__ void peer_u_phase_i4(const unsigned* XQH, const unsigned* XQL, const unsigned char* PU, const int* PIDX, int* PARTI, int bid, int G, int wave, int lane) {
    const int s = bid & 7, nr = (G - s + 7) >> 3, q = (bid >> 3) * NWAVES + wave, stride = nr * NWAVES, g = lane >> 3, m = lane & 7;
    const unsigned soff = 128u * (unsigned)s + 16u * (unsigned)m;
    if (q >= T) return;
    const __amdgpu_buffer_rsrc_t PUr = __builtin_amdgcn_make_buffer_rsrc((void*)PU, 0, PEER_N * 1024, 0x00020000);
#define PI_CL(t) ((t) < T ? (t) : T - 1)
    int I1[16], I2[16]; v4u xh0, xl0, xh1, xl1, xh2, xl2, RA[16], RB[16];
    PI_LOADIDS(I1, q); PI_LOADX(xh0, xl0, q);
    PI_LOADROWS16(RA, PUr, I1);
    PI_LOADIDS(I1, PI_CL(q + stride)); PI_LOADX(xh1, xl1, PI_CL(q + stride));
    for (int t = q; t < T; t += 2 * stride) {
        PI_LOADROWS16(RB, PUr, I1);
        PI_LOADIDS(I2, PI_CL(t + 2 * stride)); PI_LOADX(xh2, xl2, PI_CL(t + 2 * stride));
        PI_COMPUTE16(RA, xh0, xl0, t);
        PI_LOADROWS16(RA, PUr, I2);
        PI_LOADIDS(I1, PI_CL(t + 3 * stride)); PI_LOADX(xh0, xl0, PI_CL(t + 3 * stride));
        PI_COMPUTE16(RB, xh1, xl1, t + stride);
        xh1 = xh0; xl1 = xl0; xh0 = xh2; xl0 = xl2;
    }
#undef PI_CL
}


constexpr float PV_SCALE4S = 5.65f;
__device__ __forceinline__ unsigned enc_e2m1s(float v) {
    const float a = fabsf(v);
    const unsigned code = a < 0.25f ? 0u : a < 0.75f ? 1u : a < 1.25f ? 2u : a < 1.75f ? 3u : a < 2.5f ? 4u : a < 3.5f ? 5u : a < 5.0f ? 6u : 7u;
    return code | (v < 0.f ? 8u : 0u);
}
__device__ __forceinline__ void convert_fp4_plain(const float* src, unsigned char* dst, int nrows, float scale, const float* gain, int gw, int NGW, int lane) {
    for (int r0 = 2 * gw; r0 < nrows; r0 += 2 * NGW) {
        f32x4 a[2][8];
#pragma unroll
        for (int q = 0; q < 2; ++q) { const float* sp = src + (size_t)(r0 + q) * DM + 4 * lane;
#pragma unroll
            for (int j = 0; j < 8; ++j) a[q][j] = *(const GAS f32x4*)(sp + 256 * j); }
#pragma unroll
        for (int q = 0; q < 2; ++q) { const int r = r0 + q; const float* gp = gain ? gain + (size_t)(r / PEER_N) * DM + 4 * lane : nullptr;
#pragma unroll
            for (int j = 0; j < 8; ++j) { f32x4 v = a[q][j] * scale; if (gp) v = v * *(const GAS f32x4*)(gp + 256 * j);
                const unsigned w = enc_e2m1s(v[0]) | (enc_e2m1s(v[1]) << 4) | (enc_e2m1s(v[2]) << 8) | (enc_e2m1s(v[3]) << 12);
                *(GAS unsigned short*)(dst + (size_t)r * 1024 + 128 * j + 2 * lane) = (unsigned short)w; } }
    }
}
#define PVS_LOADMETA(ids, pp, gg, t) do { PI_LOADIDS(ids, t); _Pragma("unroll") for (int sp_ = 0; sp_ < 8; ++sp_) pp[sp_] = *(const GAS v2u*)(PARTI + ((size_t)sp_ * T + (t)) * 128 + 2 * lane); \
        gg = *(const GAS f32x2*)(PGATE + (size_t)(t) * 128 + 2 * lane); } while (0)
#define PVS_COMPUTE16(buf, pp, gg, t) do { float w0, w1; { int s0_ = 0, s1_ = 0; _Pragma("unroll") for (int sp_ = 0; sp_ < 8; ++sp_) { s0_ += (int)pp[sp_].x; s1_ += (int)pp[sp_].y; } \
            const float d0_ = (float)s0_ * (1.f / (PX_SCALEI * PU_SCALEI)), d1_ = (float)s1_ * (1.f / (PX_SCALEI * PU_SCALEI)); \
            w0 = gg.x * 0.5f * d0_ * (1.f + erff(d0_ * 0.70710678118654752f)) * (1.f / PV_SCALE4S); w1 = gg.y * 0.5f * d1_ * (1.f + erff(d1_ * 0.70710678118654752f)) * (1.f / PV_SCALE4S); } \
        f32x2 y[16]; _Pragma("unroll") for (int i_ = 0; i_ < 16; ++i_) y[i_] = (f32x2){0.f, 0.f}; \
        _Pragma("unroll") for (int i_ = 0; i_ < 16; ++i_) { \
            const float w_ = __builtin_bit_cast(float, __builtin_amdgcn_ds_bpermute(((lane & 56) | (i_ >> 1)) << 2, __builtin_bit_cast(int, (i_ & 1) ? w1 : w0))); const f32x2 wv_ = {w_, w_}; \
            _Pragma("unroll") for (int c_ = 0; c_ < 4; ++c_) { const unsigned u_ = buf[i_][c_]; \
                y[4 * c_ + 0] += __builtin_amdgcn_cvt_scalef32_pk_f32_fp4(u_, 1.0f, 0) * wv_; y[4 * c_ + 1] += __builtin_amdgcn_cvt_scalef32_pk_f32_fp4(u_, 1.0f, 1) * wv_; \
                y[4 * c_ + 2] += __builtin_amdgcn_cvt_scalef32_pk_f32_fp4(u_, 1.0f, 2) * wv_; y[4 * c_ + 3] += __builtin_amdgcn_cvt_scalef32_pk_f32_fp4(u_, 1.0f, 3) * wv_; } } \
        {   LAS float* wp_ = yl + g * 288 + m * 36; \
            _Pragma("unroll") for (int c_ = 0; c_ < 8; ++c_) *(LAS f32x4*)(wp_ + 4 * c_) = (f32x4){y[2 * c_].x, y[2 * c_].y, y[2 * c_ + 1].x, y[2 * c_ + 1].y}; \
            LDS_WAIT(); asm volatile("" ::: "memory"); \
            f32x4 acc_ = {0.f, 0.f, 0.f, 0.f}; const LAS float* rp_ = yl + (lane >> 3) * 36 + 4 * (lane & 7); \
            _Pragma("unroll") for (int gg_ = 0; gg_ < 8; ++gg_) acc_ += *(const LAS f32x4*)(rp_ + gg_ * 288); \
            LDS_WAIT(); asm volatile("" ::: "memory"); \
            if ((t) < T) { bf16* xp_ = XN + (size_t)(t) * DM + 256 * s + 4 * lane; const v2u a_ = *(const GAS v2u*)xp_; \
                const f32x4 v_ = (f32x4){bflo(a_.x), bfhi(a_.x), bflo(a_.y), bfhi(a_.y)} + acc_; \
                *(GAS v2u*)xp_ = (v2u){pk2(v_[0], v_[1]), pk2(v_[2], v_[3])}; \
                if (Xout) *(GAS f32x4*)(Xout + (size_t)(t) * DM + 256 * s + 4 * lane) = v_; \
                if (rowsq_out) { const float ss_ = wave_sum((v_[0] * v_[0] + v_[1] * v_[1]) + (v_[2] * v_[2] + v_[3] * v_[3]), lane); if (lane == 0) atomicAdd(rowsq_out + (t), rowsq_fx(ss_)); } } } } while (0)
__device__ __forceinline__ void peer_v_phase_s(bf16* XN, const unsigned char* PV, const int* PIDX, const float* PGATE, const int* PARTI, float* Xout, u64_t* rowsq_out, LAS float* yl, int bid, int G, int wave, int lane) {
    const int s = bid & 7, nr = (G - s + 7) >> 3, q = (bid >> 3) * NWAVES + wave, stride = nr * NWAVES, g = lane >> 3, m = lane & 7;
    const unsigned soff = 128u * (unsigned)s + 16u * (unsigned)m;
    if (q >= T) return;
    const __amdgpu_buffer_rsrc_t PVr = __builtin_amdgcn_make_buffer_rsrc((void*)PV, 0, PEER_N * 1024, 0x00020000);
#define PVS_CL(t) ((t) < T ? (t) : T - 1)
    int I0[16], I1[16]; v2u P0[8], P1[8]; f32x2 G0, G1; v4u RA[16], RB[16];
#define PVS_LOADPG(pp, gg, t) do { _Pragma("unroll") for (int sp_ = 0; sp_ < 8; ++sp_) pp[sp_] = *(const GAS v2u*)(PARTI + ((size_t)sp_ * T + (t)) * 128 + 2 * lane); gg = *(const GAS f32x2*)(PGATE + (size_t)(t) * 128 + 2 * lane); } while (0)
    PI_LOADIDS(I0, q); PVS_LOADPG(P0, G0, q);
    PI_LOADROWS16(RA, PVr, I0);
    PI_LOADIDS(I1, PVS_CL(q + stride)); PVS_LOADPG(P1, G1, PVS_CL(q + stride));
    for (int t = q; t < T; t += 2 * stride) {
        PI_LOADROWS16(RB, PVr, I1);
        PI_LOADIDS(I0, PVS_CL(t + 2 * stride));
        PVS_COMPUTE16(RA, P0, G0, t);
        PVS_LOADPG(P0, G0, PVS_CL(t + 2 * stride));
        PI_LOADROWS16(RA, PVr, I0);
        PI_LOADIDS(I1, PVS_CL(t + 3 * stride));
        PVS_COMPUTE16(RB, P1, G1, t + stride);
        PVS_LOADPG(P1, G1, PVS_CL(t + 3 * stride));
    }
#undef PVS_LOADPG
#undef PVS_CL
}

typedef short s16x4 __attribute__((ext_vector_type(4)));
typedef __attribute__((address_space(3))) const char* lds_cptr;
__device__ __forceinline__ s16x4 vtr(lds_cptr p) { return __builtin_bit_cast(s16x4, __builtin_amdgcn_ds_read_tr16_b64_v4i16((__attribute__((address_space(3))) s16x4*)p)); }
__device__ __forceinline__ unsigned cvtpk(float lo, float hi) { unsigned r; asm("v_cvt_pk_bf16_f32 %0, %1, %2" : "=v"(r) : "v"(lo), "v"(hi)); return r; }
constexpr int AT_K0 = 0, AT_V0 = 16384, AT_TAB = 32768;
constexpr float LOG2E = 1.4426950408889634f;
template <int TYPE>
__device__ __forceinline__ void attn_unit(LAS unsigned char* lds, const bf16* QKV, bf16* ATT, u64_t* mixsq, int b, int head, int qb, const float* tabsrc, float Cl2, float sinkl2, int tid) {
    const int lane = tid & 63, w = __builtin_amdgcn_readfirstlane(tid >> 6), hh = lane >> 5, l31 = lane & 31;
    int qcol, kcol, vcol, ocol;
    if (TYPE == 0) { qcol = QA + head * 64; kcol = KA + (head / 3) * 64; vcol = VA + (head / 3) * 64; ocol = OA + head * 64; }
    else if (TYPE == 1) { qcol = QB + head * 64; kcol = KB + head * 64; vcol = VB + head * 64; ocol = OB + head * 64; }
    else { qcol = QC + head * 64; kcol = KC + (head / 3) * 64; vcol = VC + (head / 3) * 64; ocol = OC + head * 64; }
    const int q0 = 256 * qb + 32 * w, qpos = q0 + l31;
    int t_begin, t_end;
    if (TYPE == 0) { t_begin = 4 * qb - 2; if (t_begin < 0) t_begin = 0; t_end = 4 * qb + 6; if (t_end > 32) t_end = 32; }
    else if (TYPE == 1) { int a = 4 * qb - 4; a = a < 0 ? 0 : (a > 24 ? 24 : a); int e = 4 * qb - 1; e = e < 0 ? 0 : (e > 24 ? 24 : e); t_begin = a; t_end = e + 8; }
    else { t_begin = 0; t_end = 32; }
    LAS float* tab = (LAS float*)(lds + AT_TAB);
    if (TYPE == 0) { for (int i = tid; i < 1024; i += NTHREADS) { const int rel = i - 448; tab[i] = (rel >= -128 && rel <= 128) ? tabsrc[head * 257 + rel + 128] * LOG2E - Cl2 : -1e30f; } }
    if (TYPE == 1) { for (int i = tid; i < 15 * 31; i += NTHREADS) tab[i] = tabsrc[head * 465 + i] * LOG2E - Cl2; }
    bf16x8 qf[4];
    {   const bf16* qp = QKV + ((size_t)b * SEQ + qpos) * DIN + qcol + 8 * hh;
#pragma unroll
        for (int s = 0; s < 4; ++s) qf[s] = *(const GAS bf16x8*)(qp + 16 * s); }
    const int srow = tid >> 3, sch = tid & 7;
    const bf16* kg = QKV + ((size_t)b * SEQ + srow) * DIN + kcol + sch * 8;
    const bf16* vg = QKV + ((size_t)b * SEQ + srow) * DIN + vcol + sch * 8;
    const int kst = srow * 128 + ((sch ^ ((srow >> 1) & 7)) * 16);
    const int vst = srow * 128 + (((sch >> 2) ^ ((srow >> 1) & 1)) * 64) + (sch & 3) * 16;
    int kread[4], vread[2];
#pragma unroll
    for (int s = 0; s < 4; ++s) kread[s] = l31 * 128 + (((2 * s + hh) ^ ((lane >> 1) & 7)) * 16);
#pragma unroll
    for (int db = 0; db < 2; ++db) vread[db] = (4 * hh + ((lane >> 2) & 3)) * 128 + ((db ^ ((lane >> 3) & 1)) * 64) + 32 * ((lane >> 4) & 1) + 8 * (lane & 3);
    f32x16 O0, O1;
#pragma unroll
    for (int r = 0; r < 16; ++r) { O0[r] = 0.f; O1[r] = 0.f; }
    float lsum = 0.f;
    const int rw = 4 * qb + (w >> 1), cq = 32 * (w & 1) + l31;
    int r0w = rw - 4; r0w = r0w < 0 ? 0 : (r0w > 24 ? 24 : r0w);
    int c0 = cq - 8; c0 = c0 < 0 ? 0 : (c0 > 48 ? 48 : c0);
    {   const v4u kr = *(const GAS v4u*)(kg + (size_t)t_begin * 64 * DIN), vr = *(const GAS v4u*)(vg + (size_t)t_begin * 64 * DIN);
        *(LAS v4u*)(lds + AT_K0 + kst) = kr; *(LAS v4u*)(lds + AT_V0 + vst) = vr; }
    __syncthreads();
    for (int t = t_begin; t < t_end; ++t) {
        const int cur = (t - t_begin) & 1;
        v4u kr, vr;
        if (t + 1 < t_end) { kr = *(const GAS v4u*)(kg + (size_t)(t + 1) * 64 * DIN); vr = *(const GAS v4u*)(vg + (size_t)(t + 1) * 64 * DIN); }
        bool need = true;
        if (TYPE == 0) need = (64 * t <= q0 + 31 + 128) && (64 * t + 63 >= q0 - 128);
        if (TYPE == 1) need = (t >= r0w) && (t < r0w + 8);
        if (need) {
            const lds_cptr kb_ = (lds_cptr)(lds + AT_K0 + cur * 8192), vb_ = (lds_cptr)(lds + AT_V0 + cur * 8192);
            bf16x8 kf[8];
#pragma unroll
            for (int s = 0; s < 4; ++s) { kf[2 * s] = *(const LAS bf16x8*)(kb_ + kread[s]); kf[2 * s + 1] = *(const LAS bf16x8*)(kb_ + kread[s] + 4096); }
            f32x16 S0, S1;
            if (TYPE == 2) {
#pragma unroll
                for (int r = 0; r < 16; ++r) { S0[r] = -Cl2; S1[r] = -Cl2; }
            } else if (TYPE == 0) {
                const LAS float* tb = tab + (64 * t - qpos + 448 + 4 * hh);
#pragma unroll
                for (int r = 0; r < 16; ++r) { S0[r] = tb[8 * (r >> 2) + (r & 3)]; S1[r] = tb[32 + 8 * (r >> 2) + (r & 3)]; }
            } else {
                const LAS float* tb = tab + ((t - rw + 7) * 31 - cq + 15 + 4 * hh);
                const int kc0 = 4 * hh - c0;
#pragma unroll
                for (int r = 0; r < 16; ++r) { const int ka = 8 * (r >> 2) + (r & 3), kb2 = 32 + ka;
                    S0[r] = ((unsigned)(ka + kc0) < 16u) ? tb[ka] : -1e30f; S1[r] = ((unsigned)(kb2 + kc0) < 16u) ? tb[kb2] : -1e30f; }
            }
            __builtin_amdgcn_sched_barrier(0);
#pragma unroll
            for (int s = 0; s < 4; ++s) { S0 = __builtin_amdgcn_mfma_f32_32x32x16_bf16(kf[2 * s], qf[s], S0, 0, 0, 0); S1 = __builtin_amdgcn_mfma_f32_32x32x16_bf16(kf[2 * s + 1], qf[s], S1, 0, 0, 0); }
            s16x4 vf[4][2][2];
#pragma unroll
            for (int ks = 0; ks < 2; ++ks)
#pragma unroll
                for (int db = 0; db < 2; ++db) { vf[ks][db][0] = vtr(vb_ + vread[db] + (16 * ks) * 128); vf[ks][db][1] = vtr(vb_ + vread[db] + (16 * ks + 8) * 128); }
            __builtin_amdgcn_sched_barrier(0);
#pragma unroll
            for (int r = 0; r < 16; ++r) { S0[r] = __builtin_amdgcn_exp2f(S0[r]); S1[r] = __builtin_amdgcn_exp2f(S1[r]); }
#pragma unroll
            for (int r = 0; r < 16; ++r) lsum += S0[r] + S1[r];
            bf16x8 pb[4];
#pragma unroll
            for (int hf = 0; hf < 2; ++hf) {
                v4u a, c;
#pragma unroll
                for (int j = 0; j < 4; ++j) { a[j] = cvtpk(S0[8 * hf + 2 * j], S0[8 * hf + 2 * j + 1]); c[j] = cvtpk(S1[8 * hf + 2 * j], S1[8 * hf + 2 * j + 1]); }
                pb[hf] = __builtin_bit_cast(bf16x8, a); pb[2 + hf] = __builtin_bit_cast(bf16x8, c);
            }
#pragma unroll
            for (int ks = 2; ks < 4; ++ks)
#pragma unroll
                for (int db = 0; db < 2; ++db) { vf[ks][db][0] = vtr(vb_ + vread[db] + (16 * ks) * 128); vf[ks][db][1] = vtr(vb_ + vread[db] + (16 * ks + 8) * 128); }
            __builtin_amdgcn_sched_barrier(0);
#pragma unroll
            for (int ks = 0; ks < 4; ++ks) {
                const bf16x8 va = __builtin_shufflevector(vf[ks][0][0], vf[ks][0][1], 0, 1, 2, 3, 4, 5, 6, 7), vb2 = __builtin_shufflevector(vf[ks][1][0], vf[ks][1][1], 0, 1, 2, 3, 4, 5, 6, 7);
                O0 = __builtin_amdgcn_mfma_f32_32x32x16_bf16(va, pb[ks], O0, 0, 0, 0); O1 = __builtin_amdgcn_mfma_f32_32x32x16_bf16(vb2, pb[ks], O1, 0, 0, 0);
            }
        }
        __builtin_amdgcn_sched_barrier(0);
        if (t + 1 < t_end) { *(LAS v4u*)(lds + AT_K0 + (cur ^ 1) * 8192 + kst) = kr; *(LAS v4u*)(lds + AT_V0 + (cur ^ 1) * 8192 + vst) = vr; }
        __syncthreads();
    }
    lsum += shx(lsum, 32, lane);
    if (TYPE == 0) lsum += __builtin_amdgcn_exp2f(sinkl2 - Cl2);
    const float inv = 1.f / lsum;
    {   float ss = 0.f;
#pragma unroll
        for (int r = 0; r < 16; ++r) { const float a = O0[r] * inv, c = O1[r] * inv; ss += a * a + c * c; }
        ss += shx(ss, 32, lane);
        if (hh == 0) (void)__hip_atomic_fetch_add((GAS u64_t*)(mixsq + (size_t)b * SEQ + qpos), rowsq_fx(ss), __ATOMIC_RELAXED, __HIP_MEMORY_SCOPE_AGENT); }
    bf16* op = ATT + ((size_t)b * SEQ + qpos) * DM + ocol + 4 * hh;
#pragma unroll
    for (int g4 = 0; g4 < 4; ++g4) {
        v2u o0, o1; o0.x = cvtpk(O0[4 * g4] * inv, O0[4 * g4 + 1] * inv); o0.y = cvtpk(O0[4 * g4 + 2] * inv, O0[4 * g4 + 3] * inv);
        o1.x = cvtpk(O1[4 * g4] * inv, O1[4 * g4 + 1] * inv); o1.y = cvtpk(O1[4 * g4 + 2] * inv, O1[4 * g4 + 3] * inv);
        *(GAS v2u*)(op + 8 * g4) = o0; *(GAS v2u*)(op + 32 + 8 * g4) = o1;
    }
}


constexpr int MA_K0 = 0, MA_V0 = 32768;
__device__ __forceinline__ void mem_unit(LAS unsigned char* lds, const bf16* QM, const bf16* KVM, bf16* OM, const float* gq, int tb, int head, float Cl2, int tid) {
    const int lane = tid & 63, w = __builtin_amdgcn_readfirstlane(tid >> 6), hh = lane >> 5, l31 = lane & 31;
    const size_t trow = (size_t)tb * 256 + 32 * w + l31; const int b = tb >> 3;
    bf16x8 qf[8];
    {   const bf16* qp = QM + trow * MEMW + head * 128 + 8 * hh;
#pragma unroll
        for (int s = 0; s < 8; ++s) qf[s] = *(const GAS bf16x8*)(qp + 16 * s);
        float ss = 0.f;
#pragma unroll
        for (int s = 0; s < 8; ++s)
#pragma unroll
            for (int j = 0; j < 8; ++j) { const float f = __builtin_bit_cast(float, (unsigned)(unsigned short)qf[s][j] << 16); ss += f * f; }
        ss += shx(ss, 32, lane);
        const float r = 0.12751743074602468f / sqrtf(ss * (1.f / 128.f) + EPS);
#pragma unroll
        for (int s = 0; s < 8; ++s) { const f32x4 g0 = *(const GAS f32x4*)(gq + 16 * s + 8 * hh), g1 = *(const GAS f32x4*)(gq + 16 * s + 8 * hh + 4);
            v4u o;
#pragma unroll
            for (int j = 0; j < 4; ++j) { const float f0 = __builtin_bit_cast(float, (unsigned)(unsigned short)qf[s][2 * j] << 16), f1 = __builtin_bit_cast(float, (unsigned)(unsigned short)qf[s][2 * j + 1] << 16);
                const float ga = (2 * j < 4) ? g0[2 * j] : g1[2 * j - 4], gb2 = (2 * j + 1 < 4) ? g0[2 * j + 1] : g1[2 * j + 1 - 4];
                o[j] = cvtpk(f0 * r * ga, f1 * r * gb2); }
            qf[s] = __builtin_bit_cast(bf16x8, o); }
    }
    const int srow = tid >> 3, sch = tid & 7;
    const bf16* kg = KVM + ((size_t)b * NMEM + srow) * 1024 + head * 128 + sch * 8;
    const bf16* vg = kg + 512;
    const int kst0 = srow * 256 + ((sch ^ (srow & 15)) * 16), kst1 = srow * 256 + (((sch + 8) ^ (srow & 15)) * 16);
    const int vst0 = srow * 256 + ((((sch) >> 2) ^ (srow & 3)) * 64) + (sch & 3) * 16, vst1 = srow * 256 + ((((sch + 8) >> 2) ^ (srow & 3)) * 64) + (sch & 3) * 16;
    int kread[8], vread[4];
#pragma unroll
    for (int s = 0; s < 8; ++s) kread[s] = l31 * 256 + (((2 * s + hh) ^ (l31 & 15)) * 16);
#pragma unroll
    for (int db = 0; db < 4; ++db) vread[db] = (4 * hh + ((lane >> 2) & 3)) * 256 + ((db ^ ((lane >> 2) & 3)) * 64) + 32 * ((lane >> 4) & 1) + 8 * (lane & 3);
    f32x16 O[4];
#pragma unroll
    for (int db = 0; db < 4; ++db)
#pragma unroll
        for (int r = 0; r < 16; ++r) O[db][r] = 0.f;
    float lsum = 0.f;
    {   const v4u k0 = *(const GAS v4u*)kg, k1 = *(const GAS v4u*)(kg + 64), v0 = *(const GAS v4u*)vg, v1 = *(const GAS v4u*)(vg + 64);
        *(LAS v4u*)(lds + MA_K0 + kst0) = k0; *(LAS v4u*)(lds + MA_K0 + kst1) = k1; *(LAS v4u*)(lds + MA_V0 + vst0) = v0; *(LAS v4u*)(lds + MA_V0 + vst1) = v1; }
    __syncthreads();
#pragma unroll 1
    for (int t = 0; t < 4; ++t) {
        const int cur = t & 1;
        v4u k0, k1, v0, v1;
        if (t + 1 < 4) { const bf16* kn = kg + (size_t)(t + 1) * 64 * 1024; k0 = *(const GAS v4u*)kn; k1 = *(const GAS v4u*)(kn + 64); v0 = *(const GAS v4u*)(kn + 512); v1 = *(const GAS v4u*)(kn + 576); }
        const lds_cptr kb_ = (lds_cptr)(lds + MA_K0 + cur * 16384), vb_ = (lds_cptr)(lds + MA_V0 + cur * 16384);
        f32x16 S0, S1;
#pragma unroll
        for (int r = 0; r < 16; ++r) { S0[r] = -Cl2; S1[r] = -Cl2; }
#pragma unroll
        for (int s = 0; s < 8; ++s) { const bf16x8 a0 = *(const LAS bf16x8*)(kb_ + kread[s]), a1 = *(const LAS bf16x8*)(kb_ + kread[s] + 8192);
            S0 = __builtin_amdgcn_mfma_f32_32x32x16_bf16(a0, qf[s], S0, 0, 0, 0); S1 = __builtin_amdgcn_mfma_f32_32x32x16_bf16(a1, qf[s], S1, 0, 0, 0); }
#pragma unroll
        for (int r = 0; r < 16; ++r) { S0[r] = __builtin_amdgcn_exp2f(S0[r]); S1[r] = __builtin_amdgcn_exp2f(S1[r]); lsum += S0[r] + S1[r]; }
        bf16x8 pb[4];
#pragma unroll
        for (int hf = 0; hf < 2; ++hf) {
            v4u a, c;
#pragma unroll
            for (int j = 0; j < 4; ++j) { a[j] = cvtpk(S0[8 * hf + 2 * j], S0[8 * hf + 2 * j + 1]); c[j] = cvtpk(S1[8 * hf + 2 * j], S1[8 * hf + 2 * j + 1]); }
            pb[hf] = __builtin_bit_cast(bf16x8, a); pb[2 + hf] = __builtin_bit_cast(bf16x8, c);
        }
#pragma unroll
        for (int ks = 0; ks < 4; ++ks)
#pragma unroll
            for (int db = 0; db < 4; ++db) {
                const s16x4 a0 = vtr(vb_ + vread[db] + (16 * ks) * 256), a1 = vtr(vb_ + vread[db] + (16 * ks + 8) * 256);
                const bf16x8 va = __builtin_shufflevector(a0, a1, 0, 1, 2, 3, 4, 5, 6, 7);
                O[db] = __builtin_amdgcn_mfma_f32_32x32x16_bf16(va, pb[ks], O[db], 0, 0, 0);
            }
        if (t + 1 < 4) { LAS unsigned char* kn = lds + MA_K0 + (cur ^ 1) * 16384; LAS unsigned char* vn = lds + MA_V0 + (cur ^ 1) * 16384;
            *(LAS v4u*)(kn + kst0) = k0; *(LAS v4u*)(kn + kst1) = k1; *(LAS v4u*)(vn + vst0) = v0; *(LAS v4u*)(vn + vst1) = v1; }
        __syncthreads();
    }
    lsum += shx(lsum, 32, lane);
    const float inv = 1.f / lsum;
    bf16* op = OM + trow * MEMW + head * 128 + 4 * hh;
#pragma unroll
    for (int db = 0; db < 4; ++db)
#pragma unroll
        for (int g4 = 0; g4 < 4; ++g4) { v2u o; o.x = cvtpk(O[db][4 * g4] * inv, O[db][4 * g4 + 1] * inv); o.y = cvtpk(O[db][4 * g4 + 2] * inv, O[db][4 * g4 + 3] * inv); *(GAS v2u*)(op + 32 * db + 8 * g4) = o; }
}

struct Args { const float* in[23]; float* out; unsigned char* ws; int ph_lo, ph_hi, use_bar, pad; };
#ifndef MK_OFF
#define MK_OFF 0u
#endif
#ifndef REP_ATT
#define REP_ATT 1
#endif
#ifndef REP_P0
#define REP_P0 1
#endif
#ifndef REP_U
#define REP_U 1
#endif
#ifndef REP_GEMM
#define REP_GEMM 1
#endif
#ifndef REP_NORM
#define REP_NORM 1
#endif
#ifndef REP_SEL
#define REP_SEL 1
#endif
#ifndef REP_MEM
#define REP_MEM 1
#endif
#define PHON(k) (!((MK_OFF >> (k)) & 1u))
constexpr int PH_PER_LAYER = 8, PH_BASE = 2, N_PHASES = PH_BASE + DEPTH * PH_PER_LAYER;
constexpr int PTAB_OFF = LDSCTL_OFF + 1024;

__global__ void __launch_bounds__(NTHREADS, 2) mega(Args a) {
    extern __shared__ __attribute__((aligned(16))) unsigned char lds_raw[];
    LAS unsigned char* lds = (LAS unsigned char*)lds_raw;
    {   const int tid0 = threadIdx.x;
        for (int u = tid0; u < (LDS_BYTES - LDSCTL_OFF) / 4; u += NTHREADS) ((LAS unsigned*)(lds + LDSCTL_OFF))[u] = 0u;
        __syncthreads();
        if (tid0 < 23) ((LAS unsigned long long*)(lds + PTAB_OFF))[tid0] = (unsigned long long)a.in[tid0];
        if (tid0 == 23) ((LAS unsigned long long*)(lds + PTAB_OFF))[23] = (unsigned long long)a.out;
        if (tid0 == 24) ((LAS unsigned long long*)(lds + PTAB_OFF))[24] = (unsigned long long)a.ws;
        __syncthreads();
    }
    volatile LAS unsigned* MISC = (volatile LAS unsigned*)(lds + MISC_OFF);
    const int G = gridDim.x, bid = blockIdx.x, NGW = G * NWAVES;
    const int use_bar = a.use_bar;
    XcdBarrier bar; bar.bar = (unsigned*)(a.ws + WS_CTL) + CW_BAR; bar.x = 0; bar.st = MISC + 8;
    if (use_bar) bar = xcd_barrier_post((unsigned*)(a.ws + WS_CTL) + CW_BAR, MISC + 8);
    const int lo = a.ph_lo, hi = a.ph_hi;
#define IN(k) (lo <= (k) && (k) < hi)
#define SEAM(k) do { if (use_bar && IN(k) && IN((k) + 1)) xcd_barrier(bar); } while (0)
#define PHL() int tid_ = threadIdx.x; asm volatile("" : "+v"(tid_)); const int lane_ = tid_ & 63, wave_ = __builtin_amdgcn_readfirstlane(tid_ >> 6), gw_ = bid * NWAVES + wave_; (void)lane_; (void)gw_; \
              int pz_ = 0; asm volatile("" : "+s"(pz_))
#define PTR(i) ((const float*)ldptr(lds, (i) + pz_))
#define WSP() ((unsigned char*)ldptr(lds, 24 + pz_))
#define OUTP() ((float*)ldptr(lds, 23 + pz_))

    if (IN(0) && PHON(0)) {
        PHL(); unsigned char* ws = WSP();
        LAS float* scr = (LAS float*)(lds + RING_OFF + wave_ * 16384);
        constexpr int I_IN = 32 * 128, I_OUT = 32 * 64, I_MQ = 32 * 16, I_MKV = 32 * 32, I_MO = 8 * 64, I_PQ = 32 * 64, I_L = I_IN + I_OUT + I_MQ + I_MKV + I_MO + I_PQ;
        for (int it = gw_; it < DEPTH * I_L; it += NGW) {
            const int l = it / I_L; int r = it % I_L;
            if (r < I_IN) { transpose_item<true>(PTR(4) + (size_t)l * DM * DIN, DM, DIN, (bf16*)(ws + WS_WIN) + (size_t)l * DIN * DM, scr, r, lane_, PTR(3) + (size_t)l * DM); continue; } r -= I_IN;
            if (r < I_OUT) { transpose_item<false>(PTR(11) + (size_t)l * DM * DM, DM, DM, (bf16*)(ws + WS_WOUT) + (size_t)l * DM * DM, scr, r, lane_, PTR(10) + (size_t)l * DM); continue; } r -= I_OUT;
            if (r < I_MQ) { transpose_item<false>(PTR(14) + (size_t)l * DM * MEMW, DM, MEMW, (bf16*)(ws + WS_WMQ) + (size_t)l * MEMW * DM, scr, r, lane_, PTR(12) + (size_t)l * DM); continue; } r -= I_MQ;
            if (r < I_MKV) { transpose_item<false>(PTR(15) + (size_t)l * DM * 1024, DM, 1024, (bf16*)(ws + WS_WMKV) + (size_t)l * 1024 * DM, scr, r, lane_); continue; } r -= I_MKV;
            if (r < I_MO) { transpose_item<false>(PTR(17) + (size_t)l * MEMW * DM, MEMW, DM, (bf16*)(ws + WS_WMO) + (size_t)l * DM * MEMW, scr, r, lane_); continue; } r -= I_MO;
            transpose_item<false>(PTR(19) + (size_t)l * DM * DM, DM, DM, (bf16*)(ws + WS_WPQ) + (size_t)l * DM * DM, scr, r, lane_, PTR(18) + (size_t)l * DM);
        }
        const size_t gtid = (size_t)bid * NTHREADS + tid_, nth = (size_t)G * NTHREADS;
        convert_bf16(PTR(20), (bf16*)(ws + WS_PKEYS), (size_t)DEPTH * 8 * 2 * 128 * 128, gtid, nth);
        convert_int4_plain(PTR(21), ws + WS_PU, DEPTH * PEER_N, PU_SCALEI, PTR(18), gw_, NGW, lane_);
        convert_fp4_rows(PTR(22), ws + WS_PV, PEER_N, PV_SCALE4, nullptr, gw_, NGW, lane_);
        {   const float* x0 = PTR(0); bf16* XN = (bf16*)(ws + WS_XN); u64_t* rsq = (u64_t*)(ws + WS_ROWSQ);
            for (int m = 2 * gw_; m < T; m += 2 * NGW) prep_rows2(x0 + (size_t)m * DM, XN + (size_t)m * DM, rsq + m, ws + WS_XN8 + (size_t)m * DM, (float*)(ws + WS_XSC) + m, lane_); }
        {   const float* mem = PTR(1); const float* gkv = PTR(13); bf16* MEMN = (bf16*)(ws + WS_MEMN);
            for (int m = gw_; m < BATCH * NMEM; m += NGW)
                rms_row_to_bf16(mem + (size_t)m * DM, gkv, MEMN + (size_t)m * DM, gkv + DM, MEMN + (size_t)(BATCH * NMEM + m) * DM, lane_); }
        float* rope = (float*)(ws + WS_ROPE); float* biasA = (float*)(ws + WS_BIASA);
        if (gtid < 64 * 16) { const int pos = (int)gtid >> 4, i = (int)gtid & 15; const float ang = (float)pos * ROPE_INV[i]; rope[gtid * 2] = cosf(ang); rope[gtid * 2 + 1] = sinf(ang); }
        if (gtid < 12 * 257) { const int h = (int)gtid / 257, rel = (int)gtid % 257 - 128; biasA[gtid] = PTR(2)[t5_bucket(rel) * 12 + h]; }
    }
    SEAM(0);
    if (IN(1) && PHON(1)) {
        {   PHL(); unsigned char* ws = WSP();
            for (int r = gw_; r < DEPTH * DIN; r += NGW) { const int rr = r & (DIN - 1), src = (rr & ~255) + 64 * ((rr >> 5) & 3) + 32 * ((rr >> 7) & 1) + (rr & 31);
                quant_wrow((const bf16*)(ws + WS_WIN) + (size_t)r * DM, ws + WS_WIN8 + (size_t)r * DM, (float*)(ws + WS_WSC) + (r & ~(DIN - 1)) + src, lane_); } }
#pragma unroll 1
        for (int l = 0; l < DEPTH; ++l) {
            PHL(); unsigned char* ws = WSP();
            pg8::Gemm g{(bf16*)(ws + WS_MEMN) + (size_t)l * BATCH * NMEM * DM, (bf16*)(ws + WS_WMKV) + (size_t)l * 1024 * DM, BATCH * NMEM, 1024, DM};
            OffsetOrder S; S.init(BATCH * NMEM, 1024, G, bid, 64 * l);
            bf16* KVMl = (bf16*)(ws + WS_KVM) + (size_t)l * BATCH * NMEM * 1024;
            pg8::EpiBf16<0> E{KVMl, 1024, nullptr, 0, 0, 1.f};
            pg8::gemm_phase<pg8::EpiBf16<0>, OffsetOrder, true, true>(lds + RING_OFF, g, S, E, tid_);
            VM_WAIT(); __syncthreads();
            const float* gk = PTR(16) + (size_t)l * 256 + 128;
#pragma unroll 1
            for (int i = 0; i < 4; ++i) { pg8::Unit uu; uu.pm = 0; uu.pn = 0; if (!S.next(i, uu)) break;
                if (uu.pn < 2) {
                    for (int r2 = wave_; r2 < 128; r2 += NWAVES) { const int row = uu.pm * 256 + 2 * r2 + (lane_ >> 5), cl = lane_ & 31;
                        GAS v4u* p = (GAS v4u*)(KVMl + (size_t)row * 1024 + 256 * uu.pn + 8 * cl);
                        const v4u w = *p;
                        float f[8] = {bflo(w.x), bfhi(w.x), bflo(w.y), bfhi(w.y), bflo(w.z), bfhi(w.z), bflo(w.w), bfhi(w.w)};
                        float ss = 0.f;
#pragma unroll
                        for (int e = 0; e < 8; ++e) ss += f[e] * f[e];
                        ss += shx(ss, 1, lane_); ss += shx(ss, 2, lane_); ss += shx(ss, 4, lane_); ss += shx(ss, 8, lane_);
                        const float r = 1.f / sqrtf(ss * (1.f / 128.f) + EPS);
                        const float* gg = gk + 8 * (cl & 15);
                        v4u o; o.x = pk2(f[0] * r * gg[0], f[1] * r * gg[1]); o.y = pk2(f[2] * r * gg[2], f[3] * r * gg[3]); o.z = pk2(f[4] * r * gg[4], f[5] * r * gg[5]); o.w = pk2(f[6] * r * gg[6], f[7] * r * gg[7]);
                        *p = o; } } }
            __syncthreads();
        }
        if (G >= 256 && bid >= 128) { PHL(); unsigned char* ws = WSP();
            convert_fp4_rows(PTR(22) + (size_t)PEER_N * DM, ws + WS_PV + (size_t)PEER_N * 1024, PEER_N, PV_SCALE4, nullptr, (bid - 128) * NWAVES + wave_, (G - 128) * NWAVES, lane_); }
        else if (G < 256) { PHL(); unsigned char* ws = WSP(); convert_fp4_rows(PTR(22) + (size_t)PEER_N * DM, ws + WS_PV + (size_t)PEER_N * 1024, PEER_N, PV_SCALE4, nullptr, gw_, NGW, lane_); }
    }
    SEAM(1);

#pragma unroll 1
    for (int l = 0; l < DEPTH; ++l) {
        const int pb = PH_BASE + PH_PER_LAYER * l;
        if (IN(pb + 0) && PHON(3)) { PHL(); unsigned char* ws = WSP();
            pg8::Gemm g{(bf16*)(ws + WS_XN8), (bf16*)(ws + WS_WIN8 + (size_t)l * DIN * DM), T, DIN, DM / 2}; pg8::StaticOrder S; S.init(T, DIN, G, bid);
            pg8::EpiQKV E{(bf16*)(ws + WS_QKV), PTR(5) + (size_t)l * 128, PTR(7) + (size_t)l * 128, PTR(9) + (size_t)l * 128, (const float*)(ws + WS_ROPE), (const u64_t*)(ws + WS_ROWSQ) + (size_t)(l * 3 + 0) * T, (const float*)(ws + WS_XSC), (const float*)(ws + WS_WSC) + (size_t)l * DIN};
            pg8::gemm_phase<pg8::EpiQKV, pg8::StaticOrder, true, true>(lds + RING_OFF, g, S, E, tid_);
        }
        SEAM(pb + 0);
        if (IN(pb + 1) && PHON(4)) { PHL(); unsigned char* ws = WSP();
            const float* sink = PTR(6) + (size_t)l * 12; const float* rpb = PTR(8) + (size_t)l * 8 * 15 * 31; const float* biasA = (const float*)(ws + WS_BIASA);
            const bf16* QKV = (const bf16*)(ws + WS_QKV); bf16* ATT = (bf16*)(ws + WS_ATT);
            const float* ga = PTR(5) + (size_t)l * 128; const float* gb = PTR(7) + (size_t)l * 128; const float* gc = PTR(9) + (size_t)l * 128;
            const float CaL2 = 8.f * wave_max(fabsf(ga[lane_]), lane_) * wave_max(fabsf(ga[64 + lane_]), lane_) * LOG2E;
            const float CbL2 = 8.f * wave_max(fabsf(gb[lane_]), lane_) * wave_max(fabsf(gb[64 + lane_]), lane_) * LOG2E;
            const float CcL2 = 8.f * wave_max(fabsf(gc[lane_]), lane_) * wave_max(fabsf(gc[64 + lane_]), lane_) * LOG2E;
            const int vc = (G % 8 == 0) ? (bid % 8) * (G / 8) + bid / 8 : bid;
            u64_t* mixsq = (u64_t*)(ws + WS_MIXSQ) + (size_t)l * 3 * T;
            for (int u = vc; u < BATCH * 12 * 8; u += G) attn_unit<2>(lds, QKV, ATT, mixsq + 2 * (size_t)T, u / 96, (u >> 3) % 12, u & 7, nullptr, CcL2, 0.f, tid_);
            for (int u = vc; u < BATCH * 8 * 8; u += G) attn_unit<1>(lds, QKV, ATT, mixsq + (size_t)T, u >> 6, (u >> 3) & 7, u & 7, rpb, CbL2, 0.f, tid_);
            for (int u = vc; u < BATCH * 12 * 8; u += G) { const int head = (u >> 3) % 12; attn_unit<0>(lds, QKV, ATT, mixsq, u / 96, head, u & 7, biasA, CaL2, sink[head] * LOG2E, tid_); }
        }
        SEAM(pb + 1);
        if (IN(pb + 2) && PHON(5)) { PHL(); unsigned char* ws = WSP();
            pg8::Gemm g{(bf16*)(ws + WS_ATT), (bf16*)(ws + WS_WOUT) + (size_t)l * DM * DM, T, DM, DM}; pg8::StaticOrder S; S.init(T, DM, G, bid);
            LAS float* ftab = (LAS float*)(lds + LDSCTL_OFF + 2048); LAS int* pmtab = (LAS int*)(lds + LDSCTL_OFF + 1536);
            {   const u64_t* mixsq = (const u64_t*)(ws + WS_MIXSQ) + (size_t)l * 3 * T;
#pragma unroll
                for (int i = 0; i < 4; ++i) { pg8::Unit uu; uu.pm = -1; uu.pn = 0; const bool ok = S.next(i, uu); if (tid_ == 0) pmtab[i] = ok ? uu.pm : -1;
                    if (ok && tid_ < 256) { const size_t row = (size_t)uu.pm * 256 + tid_;
                        const float ra = 1.0f / sqrtf((float)*(const GAS u64_t*)(mixsq + row) * (5.9604644775390625e-08f / 768.0f) + EPS), rb = 1.0f / sqrtf((float)*(const GAS u64_t*)(mixsq + T + row) * (5.9604644775390625e-08f / 512.0f) + EPS),
                                    rc = 1.0f / sqrtf((float)*(const GAS u64_t*)(mixsq + 2 * (size_t)T + row) * (5.9604644775390625e-08f / 768.0f) + EPS);
                        ftab[i * 256 + tid_] = ra / rb; ftab[1024 + i * 256 + tid_] = rb / rc; ftab[2048 + i * 256 + tid_] = rc; } }
                __syncthreads(); }
            pg8::EpiResidMix E{(bf16*)(ws + WS_XN), DM, (u64_t*)(ws + WS_ROWSQ) + (size_t)(l * 3 + 1) * T, ftab, pmtab};
            pg8::gemm_phase<pg8::EpiResidMix, pg8::StaticOrder, true, true>(lds + RING_OFF, g, S, E, tid_);
        }
        SEAM(pb + 2);
        if (IN(pb + 3) && PHON(6)) { PHL(); unsigned char* ws = WSP();
            pg8::Gemm g{(bf16*)(ws + WS_XN), (bf16*)(ws + WS_WMQ) + (size_t)l * MEMW * DM, T, MEMW, DM}; pg8::StaticOrder S; S.init(T, MEMW, G, bid);
            pg8::EpiBf16Row E{(bf16*)(ws + WS_QM), MEMW, (const u64_t*)(ws + WS_ROWSQ) + (size_t)(l * 3 + 1) * T};
            pg8::gemm_phase<pg8::EpiBf16Row, pg8::StaticOrder, true, true>(lds + RING_OFF, g, S, E, tid_);
            VM_WAIT(); __syncthreads();
            const bf16* kvm = (const bf16*)(ws + WS_KVM) + (size_t)l * BATCH * NMEM * 1024; const float* gq = PTR(16) + (size_t)l * 256;
            const float CmL2 = 11.313708498984761f * wave_max(fmaxf(fabsf(gq[lane_]), fabsf(gq[64 + lane_])), lane_) * wave_max(fmaxf(fabsf(gq[128 + lane_]), fabsf(gq[192 + lane_])), lane_) * LOG2E;
#pragma unroll 1
            for (int i = 0; i < 4; ++i) { pg8::Unit uu; uu.pm = 0; uu.pn = 0; if (!S.next(i, uu)) break;
                mem_unit(lds, (const bf16*)(ws + WS_QM), kvm, (bf16*)(ws + WS_OM), gq, uu.pm, 2 * uu.pn, CmL2, tid_);
                mem_unit(lds, (const bf16*)(ws + WS_QM), kvm, (bf16*)(ws + WS_OM), gq, uu.pm, 2 * uu.pn + 1, CmL2, tid_); }
        }
        SEAM(pb + 3);
        if (IN(pb + 4) && PHON(7)) { PHL(); unsigned char* ws = WSP();
            pg8::Gemm g{(bf16*)(ws + WS_OM), (bf16*)(ws + WS_WMO) + (size_t)l * DM * MEMW, T, DM, MEMW}; pg8::StaticOrder S; S.init(T, DM, G, bid);
            pg8::EpiResid E{(bf16*)(ws + WS_XN), DM, (u64_t*)(ws + WS_ROWSQ) + (size_t)(l * 3 + 2) * T};
            pg8::gemm_phase<pg8::EpiResid, pg8::StaticOrder, true, true>(lds + RING_OFF, g, S, E, tid_);
        }
        SEAM(pb + 4);
        if (IN(pb + 5) && PHON(8)) { PHL(); unsigned char* ws = WSP();
            pg8::Gemm g{(bf16*)(ws + WS_XN), (bf16*)(ws + WS_WPQ) + (size_t)l * DM * DM, T, DM, DM}; pg8::StaticOrder S; S.init(T, DM, G, bid);
            pg8::EpiBf16Row E{(bf16*)(ws + WS_QP), DM, (const u64_t*)(ws + WS_ROWSQ) + (size_t)(l * 3 + 2) * T};
            pg8::gemm_phase<pg8::EpiBf16Row, pg8::StaticOrder, true, true>(lds + RING_OFF, g, S, E, tid_);
            VM_WAIT(); __syncthreads();
            const bf16* pk = (const bf16*)(ws + WS_PKEYS) + (size_t)l * 8 * 2 * 128 * 128;
#pragma unroll 1
            for (int i = 0; i < 8; ++i) { pg8::Unit uu; uu.pm = 0; uu.pn = 0; if (!S.next(i, uu)) break;
                peer_select_unit((const bf16*)(ws + WS_QP), pk, (int*)(ws + WS_PIDX), (float*)(ws + WS_PGATE), uu.pm, uu.pn, wave_, lane_);
                peer_xquant_unit((const bf16*)(ws + WS_XN), (const u64_t*)(ws + WS_ROWSQ) + (size_t)(l * 3 + 2) * T, (unsigned*)(ws + WS_XQH), (unsigned*)(ws + WS_XQL), uu.pm, uu.pn, tid_); }
        }
        SEAM(pb + 5);
        if (IN(pb + 6) && PHON(9)) { PHL(); unsigned char* ws = WSP();
            peer_u_phase_i4((const unsigned*)(ws + WS_XQH), (const unsigned*)(ws + WS_XQL), ws + WS_PU + (size_t)l * PEER_N * 1024, (const int*)(ws + WS_PIDX), (int*)(ws + WS_PARTI), bid, G, wave_, lane_); }
        SEAM(pb + 6);
        if (IN(pb + 7) && PHON(10)) { PHL(); unsigned char* ws = WSP();
            peer_v_pass((bf16*)(ws + WS_XN), ws + WS_PV + (size_t)l * PEER_N * 1024, (const int*)(ws + WS_PIDX), (const float*)(ws + WS_PGATE), (const int*)(ws + WS_PARTI), (l + 1 == DEPTH) ? OUTP() : (float*)nullptr,
                        (l + 1 < DEPTH) ? (u64_t*)(ws + WS_ROWSQ) + (size_t)((l + 1) * 3 + 0) * T : (u64_t*)nullptr, (l + 1 < DEPTH) ? ws + WS_XN8 : (unsigned char*)nullptr, (float*)(ws + WS_XSC), (LAS float*)(lds + RING_OFF + wave_ * 1024), gw_, NGW, lane_); }
        SEAM(pb + 7);
    }
#undef IN
#undef SEAM
}

#ifndef MK_MULTI_LAUNCH
#define MK_MULTI_LAUNCH 0
#endif
extern "C" void kernel_launch(void* const* d_in, const int* in_sizes, int n_in, void* d_out, int out_size, void* d_ws, size_t ws_size, hipStream_t stream) {
    static int grid = 0;
    if (grid == 0) {
        if (n_in != 23 || out_size != T * DM || ws_size < WS_END) { fprintf(stderr, "kernel_launch: unexpected shapes (n_in %d, out %d, ws %zu)\n", n_in, out_size, ws_size); grid = -1; return; }
        int dev = 0, cus = 0, per_cu = 0;
        if (hipGetDevice(&dev) != hipSuccess || hipDeviceGetAttribute(&cus, hipDeviceAttributeMultiprocessorCount, dev) != hipSuccess) { grid = -1; return; }
        if (hipFuncSetAttribute((const void*)mega, hipFuncAttributeMaxDynamicSharedMemorySize, LDS_BYTES) != hipSuccess) { fprintf(stderr, "kernel_launch: hipFuncSetAttribute failed\n"); grid = -1; return; }
        if (hipOccupancyMaxActiveBlocksPerMultiprocessor(&per_cu, (const void*)mega, NTHREADS, LDS_BYTES) != hipSuccess || per_cu < 1) { fprintf(stderr, "kernel_launch: occupancy query says %d\n", per_cu); }
        (void)hipGetLastError();
        grid = cus;
    }
    if (grid < 0) return;
    (void)hipMemsetAsync((char*)d_ws + WS_CTL, 0, CTL_ZERO_BYTES, stream);
    (void)hipMemsetAsync((char*)d_ws + WS_MIXSQ, 0, MIXSQ_BYTES, stream);
    Args a{};
    for (int i = 0; i < 23; ++i) a.in[i] = (const float*)d_in[i];
    a.out = (float*)d_out; a.ws = (unsigned char*)d_ws;
#if MK_MULTI_LAUNCH
    for (int p = 0; p < N_PHASES; ++p) { a.ph_lo = p; a.ph_hi = p + 1; a.use_bar = 0; a.pad = 0; hipLaunchKernelGGL(mega, dim3(grid), dim3(NTHREADS), LDS_BYTES, stream, a); }
#else
    a.ph_lo = 0; a.ph_hi = N_PHASES; a.use_bar = 1; a.pad = 0;
    hipLaunchKernelGGL(mega, dim3(grid), dim3(NTHREADS), LDS_BYTES, stream, a);
#endif
    const hipError_t le = hipPeekAtLastError();
    if (le != hipSuccess) fprintf(stderr, "kernel_launch: launch failed: %s\n", hipGetErrorName(le));
}
```

```cpp
#include <hip/hip_runtime.h>
#include <cstdio>
#include <cstdint>
#include <cmath>
__device__ __forceinline__ float shx(float v, int k, int lane);
typedef unsigned long long u64_t;
__device__ __forceinline__ float rowsq_rs(const u64_t* rowsq, int row) { return 1.0f / sqrtf((float)*(const __attribute__((address_space(1))) u64_t*)(rowsq + row) * (5.9604644775390625e-08f / 2048.0f) + 1e-6f); }
__device__ __forceinline__ u64_t rowsq_fx(float ss) { return (u64_t)(ss * 16777216.0f + 0.5f); }
namespace pg8 {
#define PG8_LAS __attribute__((address_space(3)))
#define PG8_GAS __attribute__((address_space(1)))
typedef unsigned short bf16_t;
typedef short bf16x8 __attribute__((ext_vector_type(8)));
typedef float f32x4 __attribute__((ext_vector_type(4)));
typedef unsigned u32x4 __attribute__((ext_vector_type(4)));
constexpr int BM = 256, BK = 64, HALF = 128, HTB = HALF * BK * 2  , STAGE_BYTES = 8 * HTB, NXCD = 8, WGM = 8;

__host__ __device__ __forceinline__ int lds_byte(int r, int c) { const int st = (r >> 4) * 2 + (c >> 5), rr = r & 15, cc = c & 31, ob = rr * 64 + cc * 2; return st * 1024 + (ob ^ (((ob >> 9) & 1) << 5)); }
__host__ __device__ __forceinline__ void stage_rc(int b, int& R, int& C) { const int st = b / 1024, sb = b % 1024, swz = sb ^ (((sb >> 9) & 1) << 5); R = (st >> 1) * 16 + swz / 64; C = (st & 1) * 32 + (swz % 64) / 2; }
__host__ __device__ __forceinline__ int perm32(int rho) { const int n = rho >> 4, i = rho & 15; return 8 * (i >> 2) + 4 * n + (i & 3); }

struct Unit { int pm, pn; };
struct Gemm { const bf16_t* A; const bf16_t* Bt; int M, N, K; };

struct StaticOrder {
    int nM, nN, nwg, G, c;
    __host__ __device__ __forceinline__ void init(int M, int N, int G_, int c_) { nM = M / BM; nN = N / BM; nwg = nM * nN; G = G_; c = c_; }
    __host__ __device__ __forceinline__ bool next(int i, Unit& u) const {
        const long L = (long)i * G + c; if (L >= nwg) return false;
        int wgid = (int)L; { const int q = nwg / NXCD, r = nwg % NXCD, xcd = wgid % NXCD, off = wgid / NXCD; wgid = (xcd < r ? xcd * (q + 1) : r * (q + 1) + (xcd - r) * q) + off; }
        const int nig = WGM * nN, gid = wgid / nig, fm = gid * WGM, gsz = (nM - fm) < WGM ? (nM - fm) : WGM;
        u.pm = fm + ((wgid % nig) % gsz); u.pn = (wgid % nig) / gsz; return true;
    }
    __device__ __forceinline__ void a_ready(const Unit&) const {}
    __device__ __forceinline__ void done(const Unit&) const {}
};

__device__ __forceinline__ unsigned cvt_pk_bf16(float lo, float hi) { unsigned r; asm volatile("v_cvt_pk_bf16_f32 %0, %1, %2" : "=v"(r) : "v"(lo), "v"(hi)); return r; }
typedef float f32x2 __attribute__((ext_vector_type(2)));
__device__ __forceinline__ f32x2 gelu_pk(f32x2 v) {
    const f32x2 av = __builtin_elementwise_abs(v), d = av * 0.2316418882f + 1.0f;
    f32x2 t; t.x = __builtin_amdgcn_rcpf(d.x); t.y = __builtin_amdgcn_rcpf(d.y);
    f32x2 q = t * 0.5307027145f + (-0.7265760135f); q = q * t + 0.7107068705f; q = q * t + (-0.142248368f); q = q * t + 0.127414796f; q = q * t;
    const f32x2 s = (v * v) * (-0.72134752044f);
    f32x2 e; e.x = __builtin_amdgcn_exp2f(s.x); e.y = __builtin_amdgcn_exp2f(s.y);
    const f32x2 m = v * (q * e), r = v - m;
    f32x2 o; o.x = v.x < 0.f ? m.x : r.x; o.y = v.y < 0.f ? m.y : r.y; return o;
}

template <int ACT  > struct EpiBf16 {
    static constexpr bool PERM = true, AFTER_DRAIN = false, KSCALE = false, I8 = false; static_assert(ACT == 0 || ACT == 1, "EpiBf16: ACT is 0 (none) or 1 (gelu_pk)");
    bf16_t* O; int ldc; const float* bias; int split_cols; size_t split_stride; float scale0;
    __device__ __forceinline__ void operator()(const f32x4 (&acc)[2][2][4][2], const Unit& u, int wr, int wc, int fr, int fq) const {
        const int row0 = u.pm * BM + wr * 64 + fr; int colt = u.pn * BM; bf16_t* base = O;
        float sc = 1.f; if (split_cols) { const int t = colt / split_cols; base += (size_t)t * split_stride; colt -= t * split_cols; if (t == 0) sc = scale0; }
        const int col0 = colt + wc * 32 + 8 * fq, bcol0 = u.pn * BM + wc * 32 + 8 * fq;
        f32x4 bv[2][2];
#pragma unroll
        for (int bj = 0; bj < 2; ++bj)
#pragma unroll
            for (int n = 0; n < 2; ++n) bv[bj][n] = bias ? *(const PG8_GAS f32x4*)(bias + bcol0 + bj * HALF + 4 * n) : (f32x4){0.f, 0.f, 0.f, 0.f};
#pragma unroll
        for (int ai = 0; ai < 2; ++ai)
#pragma unroll
            for (int m = 0; m < 4; ++m) { bf16_t* rowp = base + (size_t)(row0 + ai * HALF + m * 16) * ldc + col0;
#pragma unroll
                for (int bj = 0; bj < 2; ++bj) { f32x4 v0 = acc[ai][bj][m][0] + bv[bj][0], v1 = acc[ai][bj][m][1] + bv[bj][1];
                    if (ACT == 1) { f32x2 a = gelu_pk((f32x2){v0[0], v0[1]}), b = gelu_pk((f32x2){v0[2], v0[3]}), c = gelu_pk((f32x2){v1[0], v1[1]}), d = gelu_pk((f32x2){v1[2], v1[3]});
                        v0 = (f32x4){a.x, a.y, b.x, b.y}; v1 = (f32x4){c.x, c.y, d.x, d.y}; }
                    v0 = v0 * sc; v1 = v1 * sc; u32x4 w; w.x = cvt_pk_bf16(v0[0], v0[1]); w.y = cvt_pk_bf16(v0[2], v0[3]); w.z = cvt_pk_bf16(v1[0], v1[1]); w.w = cvt_pk_bf16(v1[2], v1[3]);
                    *(PG8_GAS u32x4*)(rowp + bj * HALF) = w; } }
    }
};

typedef unsigned u32x2 __attribute__((ext_vector_type(2)));
typedef int i32x4 __attribute__((ext_vector_type(4)));
struct EpiResid {
    static constexpr bool PERM = false, AFTER_DRAIN = false, KSCALE = false, I8 = false;
    bf16_t* s; int ldc; u64_t* rowsq;
    __device__ __forceinline__ void operator()(const f32x4 (&acc)[2][2][4][2], const Unit& u, int wr, int wc, int fr, int fq) const {
        const int col0 = u.pn * BM + wc * 32 + 4 * fq;
#pragma unroll
        for (int ai = 0; ai < 2; ++ai)
#pragma unroll
            for (int m = 0; m < 4; ++m) { const int row = u.pm * BM + ai * HALF + wr * 64 + m * 16 + fr; bf16_t* sp = s + (size_t)row * ldc + col0; float ss = 0.f;
                u32x2 in[2][2];
#pragma unroll
                for (int bj = 0; bj < 2; ++bj)
#pragma unroll
                    for (int n = 0; n < 2; ++n) in[bj][n] = *(const PG8_GAS u32x2*)(sp + bj * HALF + n * 16);
#pragma unroll
                for (int bj = 0; bj < 2; ++bj)
#pragma unroll
                    for (int n = 0; n < 2; ++n) { const u32x2 w0 = in[bj][n];
                        const f32x4 bs = (f32x4){__builtin_bit_cast(float, w0.x << 16), __builtin_bit_cast(float, w0.x & 0xffff0000u), __builtin_bit_cast(float, w0.y << 16), __builtin_bit_cast(float, w0.y & 0xffff0000u)};
                        const f32x4 o = bs + acc[ai][bj][m][n]; ss += (o[0] * o[0] + o[1] * o[1]) + (o[2] * o[2] + o[3] * o[3]);
                        u32x2 w; w.x = cvt_pk_bf16(o[0], o[1]); w.y = cvt_pk_bf16(o[2], o[3]); *(PG8_GAS u32x2*)(sp + bj * HALF + n * 16) = w; }
                ss += shx(ss, 16, fr + 16 * fq); ss += shx(ss, 32, fr + 16 * fq);
                if (fq == 0) (void)__hip_atomic_fetch_add((PG8_GAS u64_t*)(rowsq + row), rowsq_fx(ss), __ATOMIC_RELAXED, __HIP_MEMORY_SCOPE_AGENT); }
    }
};
struct EpiResid8 {
    static constexpr bool PERM = false, AFTER_DRAIN = false, KSCALE = false, I8 = true;
    bf16_t* s; int ldc; u64_t* rowsq; const float* xsc; const float* wsc;
    __device__ __forceinline__ void operator()(const f32x4 (&acc)[2][2][4][2], const Unit& u, int wr, int wc, int fr, int fq) const {
        const int col0 = u.pn * BM + wc * 32 + 4 * fq;
#pragma unroll
        for (int ai = 0; ai < 2; ++ai)
#pragma unroll
            for (int m = 0; m < 4; ++m) { const int row = u.pm * BM + ai * HALF + wr * 64 + m * 16 + fr; bf16_t* sp = s + (size_t)row * ldc + col0; float ss = 0.f; const float xs = *(const PG8_GAS float*)(xsc + row);
                u32x2 in[2][2];
#pragma unroll
                for (int bj = 0; bj < 2; ++bj)
#pragma unroll
                    for (int n = 0; n < 2; ++n) in[bj][n] = *(const PG8_GAS u32x2*)(sp + bj * HALF + n * 16);
#pragma unroll
                for (int bj = 0; bj < 2; ++bj)
#pragma unroll
                    for (int n = 0; n < 2; ++n) { const u32x2 w0 = in[bj][n]; const i32x4 ia = __builtin_bit_cast(i32x4, acc[ai][bj][m][n]);
                        const f32x4 bs = (f32x4){__builtin_bit_cast(float, w0.x << 16), __builtin_bit_cast(float, w0.x & 0xffff0000u), __builtin_bit_cast(float, w0.y << 16), __builtin_bit_cast(float, w0.y & 0xffff0000u)};
                        const f32x4 o = bs + (f32x4){(float)ia[0], (float)ia[1], (float)ia[2], (float)ia[3]} * *(const PG8_GAS f32x4*)(wsc + col0 + bj * HALF + n * 16) * xs; ss += (o[0] * o[0] + o[1] * o[1]) + (o[2] * o[2] + o[3] * o[3]);
                        u32x2 w; w.x = cvt_pk_bf16(o[0], o[1]); w.y = cvt_pk_bf16(o[2], o[3]); *(PG8_GAS u32x2*)(sp + bj * HALF + n * 16) = w; }
                ss += shx(ss, 16, fr + 16 * fq); ss += shx(ss, 32, fr + 16 * fq);
                if (fq == 0) (void)__hip_atomic_fetch_add((PG8_GAS u64_t*)(rowsq + row), rowsq_fx(ss), __ATOMIC_RELAXED, __HIP_MEMORY_SCOPE_AGENT); }
    }
};
struct EpiResidMix {
    static constexpr bool PERM = false, AFTER_DRAIN = false, KSCALE = true, I8 = false; static constexpr int KS0 = 12, KS1 = 20;
    bf16_t* s; int ldc; u64_t* rowsq; const PG8_LAS float* ftab; const PG8_LAS int* pmtab;
    __device__ __forceinline__ int slot(int pm) const { return pmtab[0] == pm ? 0 : (pmtab[1] == pm ? 1 : (pmtab[2] == pm ? 2 : 3)); }
    __device__ __forceinline__ void kscale(f32x4 (&acc)[2][2][4][2], const Unit& u, int which, int wr, int fr) const {
        const PG8_LAS float* ft = ftab + which * 1024 + slot(u.pm) * 256;
#pragma unroll
        for (int ai = 0; ai < 2; ++ai)
#pragma unroll
            for (int m = 0; m < 4; ++m) { const float f = ft[ai * HALF + wr * 64 + m * 16 + fr];
#pragma unroll
                for (int bj = 0; bj < 2; ++bj)
#pragma unroll
                    for (int n = 0; n < 2; ++n) acc[ai][bj][m][n] = acc[ai][bj][m][n] * f; }
    }
    __device__ __forceinline__ void operator()(const f32x4 (&acc)[2][2][4][2], const Unit& u, int wr, int wc, int fr, int fq) const {
        const int col0 = u.pn * BM + wc * 32 + 4 * fq;
#pragma unroll
        for (int ai = 0; ai < 2; ++ai)
#pragma unroll
            for (int m = 0; m < 4; ++m) { const int row = u.pm * BM + ai * HALF + wr * 64 + m * 16 + fr; bf16_t* sp = s + (size_t)row * ldc + col0; float ss = 0.f; const float rc = ftab[2048 + slot(u.pm) * 256 + ai * HALF + wr * 64 + m * 16 + fr];
                u32x2 in[2][2];
#pragma unroll
                for (int bj = 0; bj < 2; ++bj)
#pragma unroll
                    for (int n = 0; n < 2; ++n) in[bj][n] = *(const PG8_GAS u32x2*)(sp + bj * HALF + n * 16);
#pragma unroll
                for (int bj = 0; bj < 2; ++bj)
#pragma unroll
                    for (int n = 0; n < 2; ++n) { const u32x2 w0 = in[bj][n];
                        const f32x4 bs = (f32x4){__builtin_bit_cast(float, w0.x << 16), __builtin_bit_cast(float, w0.x & 0xffff0000u), __builtin_bit_cast(float, w0.y << 16), __builtin_bit_cast(float, w0.y & 0xffff0000u)};
                        const f32x4 o = bs + acc[ai][bj][m][n] * rc; ss += (o[0] * o[0] + o[1] * o[1]) + (o[2] * o[2] + o[3] * o[3]);
                        u32x2 w; w.x = cvt_pk_bf16(o[0], o[1]); w.y = cvt_pk_bf16(o[2], o[3]); *(PG8_GAS u32x2*)(sp + bj * HALF + n * 16) = w; }
                ss += shx(ss, 16, fr + 16 * fq); ss += shx(ss, 32, fr + 16 * fq);
                if (fq == 0) (void)__hip_atomic_fetch_add((PG8_GAS u64_t*)(rowsq + row), rowsq_fx(ss), __ATOMIC_RELAXED, __HIP_MEMORY_SCOPE_AGENT); }
    }
};
struct EpiBf16Row {
    static constexpr bool PERM = true, AFTER_DRAIN = false, KSCALE = false, I8 = false;
    bf16_t* O; int ldc; const u64_t* rowsq;
    __device__ __forceinline__ void operator()(const f32x4 (&acc)[2][2][4][2], const Unit& u, int wr, int wc, int fr, int fq) const {
        const int row0 = u.pm * BM + wr * 64 + fr, col0 = u.pn * BM + wc * 32 + 8 * fq;
#pragma unroll
        for (int ai = 0; ai < 2; ++ai)
#pragma unroll
            for (int m = 0; m < 4; ++m) { const int row = row0 + ai * HALF + m * 16; const float rs = rowsq_rs(rowsq, row); bf16_t* rowp = O + (size_t)row * ldc + col0;
#pragma unroll
                for (int bj = 0; bj < 2; ++bj) { const f32x4 v0 = acc[ai][bj][m][0] * rs, v1 = acc[ai][bj][m][1] * rs; u32x4 w; w.x = cvt_pk_bf16(v0[0], v0[1]); w.y = cvt_pk_bf16(v0[2], v0[3]); w.z = cvt_pk_bf16(v1[0], v1[1]); w.w = cvt_pk_bf16(v1[2], v1[3]);
                    *(PG8_GAS u32x4*)(rowp + bj * HALF) = w; } }
    }
};
struct EpiQKV {
    static constexpr bool PERM = false, AFTER_DRAIN = false, KSCALE = false, I8 = true;
    bf16_t* O; const float* ga; const float* gb; const float* gc; const float* rope; const u64_t* rowsq; const float* xsc; const float* wsc;
    __device__ __forceinline__ void operator()(const f32x4 (&acc)[2][2][4][2], const Unit& u, int wr, int wc, int fr, int fq) const {
        const int hg = u.pn * 4 + wc;
        const float* g = nullptr; bool isq = false, dorope = false;
        if (hg < 12) { g = ga; isq = true; } else if (hg < 16) { g = ga + 64; } else if (hg < 20) { }
        else if (hg < 28) { g = gb; isq = true; } else if (hg < 36) { g = gb + 64; } else if (hg < 44) { }
        else if (hg < 56) { g = gc; isq = true; dorope = true; } else if (hg < 60) { g = gc + 64; dorope = true; }
        const float qs = isq ? 0.18033688011112042f : 1.0f;
#pragma unroll
        for (int ai = 0; ai < 2; ++ai)
#pragma unroll
            for (int m = 0; m < 4; ++m) {
                const int row = u.pm * BM + ai * HALF + wr * 64 + m * 16 + fr;
                f32x4 v[2][2];
                const float rsx = rowsq_rs(rowsq, row) * *(const PG8_GAS float*)(xsc + row);
#pragma unroll
                for (int bj = 0; bj < 2; ++bj)
#pragma unroll
                    for (int n = 0; n < 2; ++n) { const i32x4 ia = __builtin_bit_cast(i32x4, acc[ai][bj][m][n]);
                        v[bj][n] = (f32x4){(float)ia[0], (float)ia[1], (float)ia[2], (float)ia[3]} * *(const PG8_GAS f32x4*)(wsc + hg * 64 + 32 * bj + 16 * n + 4 * fq) * rsx; }
                if (g) {
                    float ss = 0.f;
#pragma unroll
                    for (int bj = 0; bj < 2; ++bj)
#pragma unroll
                        for (int n = 0; n < 2; ++n) { const f32x4 x = v[bj][n]; ss += (x[0] * x[0] + x[1] * x[1]) + (x[2] * x[2] + x[3] * x[3]); }
                    ss += shx(ss, 16, fr + 16 * fq); ss += shx(ss, 32, fr + 16 * fq);
                    const float r = qs / sqrtf(ss * (1.0f / 64.0f) + 1e-6f);
#pragma unroll
                    for (int bj = 0; bj < 2; ++bj)
#pragma unroll
                        for (int n = 0; n < 2; ++n) v[bj][n] = v[bj][n] * *(const PG8_GAS f32x4*)(g + 32 * bj + 16 * n + 4 * fq) * r;
                }
                if (dorope) {
                    const int t = row & 2047, pr = t >> 6, pc = t & 63;
#pragma unroll
                    for (int bj = 0; bj < 2; ++bj) {
                        const int pos = bj ? pc : pr;
                        const float* rp = rope + (size_t)(pos * 16 + 4 * fq) * 2;
                        const f32x4 c01 = *(const PG8_GAS f32x4*)rp, c23 = *(const PG8_GAS f32x4*)(rp + 4);
                        const f32x4 cs = (f32x4){c01[0], c01[2], c23[0], c23[2]}, sn = (f32x4){c01[1], c01[3], c23[1], c23[3]};
                        const f32x4 x1 = v[bj][0], x2 = v[bj][1];
                        v[bj][0] = x1 * cs - x2 * sn; v[bj][1] = x1 * sn + x2 * cs;
                    }
                }
                bf16_t* rowp = O + (size_t)row * 4096 + hg * 64 + 4 * fq;
#pragma unroll
                for (int bj = 0; bj < 2; ++bj)
#pragma unroll
                    for (int n = 0; n < 2; ++n) { u32x2 w; w.x = cvt_pk_bf16(v[bj][n][0], v[bj][n][1]); w.y = cvt_pk_bf16(v[bj][n][2], v[bj][n][3]); *(PG8_GAS u32x2*)(rowp + 32 * bj + 16 * n) = w; }
                asm volatile("" ::: "memory");
            }
    }
};
template <bool I8> __device__ __forceinline__ f32x4 mma16(const bf16x8 b, const bf16x8 a, const f32x4 c) {
    if constexpr (I8) return __builtin_bit_cast(f32x4, __builtin_amdgcn_mfma_i32_16x16x64_i8(__builtin_bit_cast(i32x4, b), __builtin_bit_cast(i32x4, a), __builtin_bit_cast(i32x4, c), 0, 0, 0));
    else return __builtin_amdgcn_mfma_f32_16x16x32_bf16(b, a, c, 0, 0, 0);
}
template <class Epi, class Sched, bool ALIGN_EPI = false, bool SP2 = false>
__device__ __forceinline__ void gemm_phase(PG8_LAS unsigned char* lds, const Gemm g, const Sched& S, const Epi& E, const int tid) {
    const int wid = __builtin_amdgcn_readfirstlane(tid >> 6), lane = tid & 63, wr = wid >> 2, wc = wid & 3, fr = lane & 15, fq = lane >> 4;
    const int K = g.K, nt = K / BK;
    unsigned voffA[2], voffB[2];
#pragma unroll
    for (int i = 0; i < 2; ++i) { int R, C; stage_rc(tid * 16 + i * 8192, R, C); const int Rb = Epi::PERM ? ((R & ~31) + perm32(R & 31)) : R;
        voffA[i] = (unsigned)(R * K + C) * 2u; voffB[i] = (unsigned)(Rb * K + C) * 2u; }
    const size_t kstep = (size_t)(BK * 2);
    const size_t hstep = (size_t)HALF * K * 2;
    const size_t tstep = 2 * hstep;
    const unsigned ldsw = (unsigned)wid * 1024u;
    const int aoff = lds_byte(wr * 64 + fr, fq * 8), boff = lds_byte(wc * 32 + fr, fq * 8);
#define PG8_SA(b, h) (((b) * 2 + (h)) * HTB)
#define PG8_SB(b, h) ((4 + (b) * 2 + (h)) * HTB)
#define PG8_STAGE(bufoff, gbase, voff) do { _Pragma("unroll") for (int _i = 0; _i < 2; ++_i) \
        __builtin_amdgcn_global_load_lds((const unsigned*)((const char*)(gbase) + (voff)[_i]), (PG8_LAS unsigned*)(lds + (bufoff) + ldsw + _i * 8192), 16, 0, 0); } while (0)
#define PG8_LDA(dst, b, h) do { _Pragma("unroll") for (int m = 0; m < 4; ++m) _Pragma("unroll") for (int k = 0; k < 2; ++k) dst[m][k] = *(const PG8_LAS bf16x8*)(lds + PG8_SA(b, h) + aoff + m * 2048 + k * 1024); } while (0)
#define PG8_LDB(dst, b, h) do { _Pragma("unroll") for (int n = 0; n < 2; ++n) _Pragma("unroll") for (int k = 0; k < 2; ++k) dst[n][k] = *(const PG8_LAS bf16x8*)(lds + PG8_SB(b, h) + boff + n * 2048 + k * 1024); } while (0)
#define PG8_MMA(ai, bj, At, Bt) do { __builtin_amdgcn_s_setprio(1); _Pragma("unroll") for (int m = 0; m < 4; ++m) _Pragma("unroll") for (int n = 0; n < 2; ++n) _Pragma("unroll") for (int k = 0; k < 2; ++k) \
        acc[ai][bj][m][n] = mma16<Epi::I8>(Bt[n][k], At[m][k], acc[ai][bj][m][n]); __builtin_amdgcn_s_setprio(0); } while (0)
#define PG8_WAIT_V(n) asm volatile("s_waitcnt vmcnt(" #n ")" ::: "memory")
#define PG8_WAIT_L(n) asm volatile("s_waitcnt lgkmcnt(" #n ")" ::: "memory")
#define PG8_BAR __builtin_amdgcn_s_barrier()
#define PG8_SCHED __builtin_amdgcn_sched_barrier(0)
    Unit cur, nxt; int ui = 0;
    if (!S.next(0, cur)) return;
    f32x4 acc[2][2][4][2];
#pragma unroll
    for (int a = 0; a < 2; ++a)
#pragma unroll
        for (int b = 0; b < 2; ++b)
#pragma unroll
            for (int m = 0; m < 4; ++m)
#pragma unroll
                for (int n = 0; n < 2; ++n) acc[a][b][m][n] = (f32x4){0.f, 0.f, 0.f, 0.f};
    bf16x8 At[4][2], B0[2][2], B1[2][2];
    const char* cA = (const char*)g.A + (size_t)cur.pm * tstep; const char* cB = (const char*)g.Bt + (size_t)cur.pn * tstep;
    S.a_ready(cur);
    if constexpr (SP2) {
        PG8_STAGE(PG8_SB(0, 0), cB, voffB); PG8_STAGE(PG8_SB(0, 1), cB + hstep, voffB); PG8_STAGE(PG8_SA(0, 0), cA, voffA); PG8_STAGE(PG8_SA(0, 1), cA + hstep, voffA);
        if (wr == 1) PG8_BAR;
        PG8_WAIT_V(2); PG8_BAR;
        PG8_STAGE(PG8_SB(1, 0), cB + kstep, voffB); PG8_STAGE(PG8_SA(1, 0), cA + kstep, voffA); PG8_STAGE(PG8_SB(1, 1), cB + hstep + kstep, voffB);
        PG8_WAIT_V(6); PG8_BAR;
    } else {
        PG8_STAGE(PG8_SB(0, 0), cB, voffB); PG8_STAGE(PG8_SA(0, 0), cA, voffA); PG8_STAGE(PG8_SB(0, 1), cB + hstep, voffB); PG8_STAGE(PG8_SA(0, 1), cA + hstep, voffA);
        if (wr == 1) PG8_BAR;
        PG8_WAIT_V(4); PG8_BAR;
        PG8_STAGE(PG8_SB(1, 0), cB + kstep, voffB); PG8_STAGE(PG8_SA(1, 0), cA + kstep, voffA); PG8_STAGE(PG8_SB(1, 1), cB + hstep + kstep, voffB);
        PG8_WAIT_V(6); PG8_BAR;
    }
    for (;;) {
        const bool has_next = S.next(ui + 1, nxt);
        const char* nA = has_next ? (const char*)g.A + (size_t)nxt.pm * tstep : cA; const char* nB = has_next ? (const char*)g.Bt + (size_t)nxt.pn * tstep : cB;
        for (int t = 0; t < nt; t += 2) {
            if constexpr (Epi::KSCALE) { if (t == Epi::KS0 || t == Epi::KS1) E.kscale(acc, cur, t == Epi::KS1 ? 1 : 0, wr, fr); }
            const bool last = (t == nt - 2);
            const char* a1 = cA + (size_t)(t + 1) * kstep;
            const char* a2 = last ? nA : cA + (size_t)(t + 2) * kstep; const char* b2 = last ? nB : cB + (size_t)(t + 2) * kstep;
            const char* a3 = a2 + kstep; const char* b3 = b2 + kstep;
            if (last && has_next) S.a_ready(nxt);
            if constexpr (SP2) {
            PG8_LDB(B0, 0, 0); PG8_LDB(B1, 0, 1); PG8_SCHED; PG8_LDA(At, 0, 0); PG8_STAGE(PG8_SA(1, 1), a1 + hstep, voffA);
            PG8_WAIT_V(8); PG8_WAIT_L(0); PG8_BAR; PG8_MMA(0, 0, At, B0); PG8_MMA(0, 1, At, B1); PG8_BAR; PG8_SCHED;
            PG8_LDA(At, 0, 1); PG8_STAGE(PG8_SB(0, 0), b2, voffB); PG8_STAGE(PG8_SB(0, 1), b2 + hstep, voffB); PG8_STAGE(PG8_SA(0, 0), a2, voffA);
            PG8_WAIT_V(8); PG8_WAIT_L(0); PG8_BAR; PG8_MMA(1, 0, At, B0); PG8_MMA(1, 1, At, B1); PG8_BAR; PG8_SCHED;
            PG8_LDB(B0, 1, 0); PG8_LDB(B1, 1, 1); PG8_SCHED; PG8_LDA(At, 1, 0); PG8_STAGE(PG8_SA(0, 1), a2 + hstep, voffA);
            PG8_WAIT_V(8); PG8_WAIT_L(0); PG8_BAR; PG8_MMA(0, 0, At, B0); PG8_MMA(0, 1, At, B1); PG8_BAR; PG8_SCHED;
            PG8_LDA(At, 1, 1); PG8_STAGE(PG8_SB(1, 0), b3, voffB); PG8_STAGE(PG8_SB(1, 1), b3 + hstep, voffB); PG8_STAGE(PG8_SA(1, 0), a3, voffA);
            PG8_WAIT_V(8); PG8_WAIT_L(0); PG8_BAR; PG8_MMA(1, 0, At, B0); PG8_MMA(1, 1, At, B1); PG8_BAR; PG8_SCHED;
            } else {
            PG8_LDB(B0, 0, 0); PG8_SCHED; PG8_LDA(At, 0, 0); PG8_STAGE(PG8_SA(1, 1), a1 + hstep, voffA);
            PG8_WAIT_L(8); PG8_BAR; PG8_WAIT_L(0); PG8_MMA(0, 0, At, B0); PG8_BAR; PG8_SCHED;
            PG8_LDB(B1, 0, 1); PG8_STAGE(PG8_SB(0, 0), b2, voffB);
            PG8_BAR; PG8_WAIT_L(0); PG8_MMA(0, 1, At, B1); PG8_BAR;
            PG8_LDA(At, 0, 1); PG8_STAGE(PG8_SA(0, 0), a2, voffA);
            PG8_BAR; PG8_WAIT_L(0); PG8_MMA(1, 0, At, B0); PG8_BAR; PG8_SCHED;
            PG8_STAGE(PG8_SB(0, 1), b2 + hstep, voffB);
            PG8_WAIT_V(6); PG8_BAR; PG8_MMA(1, 1, At, B1); PG8_BAR;
            PG8_LDB(B0, 1, 0); PG8_SCHED; PG8_LDA(At, 1, 0); PG8_STAGE(PG8_SA(0, 1), a2 + hstep, voffA);
            PG8_WAIT_L(8); PG8_BAR; PG8_WAIT_L(0); PG8_MMA(0, 0, At, B0); PG8_BAR; PG8_SCHED;
            PG8_LDB(B1, 1, 1); PG8_STAGE(PG8_SB(1, 0), b3, voffB);
            PG8_BAR; PG8_WAIT_L(0); PG8_MMA(0, 1, At, B1); PG8_BAR;
            PG8_LDA(At, 1, 1); PG8_STAGE(PG8_SA(1, 0), a3, voffA);
            PG8_BAR; PG8_WAIT_L(0); PG8_MMA(1, 0, At, B0); PG8_BAR; PG8_SCHED;
            PG8_STAGE(PG8_SB(1, 1), b3 + hstep, voffB);
            PG8_WAIT_V(6); PG8_BAR; PG8_MMA(1, 1, At, B1); PG8_BAR;
            }
        }
        if constexpr (ALIGN_EPI) { if (wr == 0) PG8_BAR; }
        if constexpr (!Epi::AFTER_DRAIN) { E(acc, cur, wr, wc, fr, fq); S.done(cur); }
        if (!has_next) break;
#pragma unroll
        for (int a = 0; a < 2; ++a)
#pragma unroll
            for (int b = 0; b < 2; ++b)
#pragma unroll
                for (int m = 0; m < 4; ++m)
#pragma unroll
                    for (int n = 0; n < 2; ++n) acc[a][b][m][n] = (f32x4){0.f, 0.f, 0.f, 0.f};
        cur = nxt; cA = nA; cB = nB; ++ui;
        if constexpr (ALIGN_EPI) { if (wr == 1) PG8_BAR; }
    }
    PG8_WAIT_V(0);
    if constexpr (!ALIGN_EPI) { if (wr == 0) PG8_BAR; }
    PG8_BAR;
    if constexpr (Epi::AFTER_DRAIN) { E.fused(acc, cur, wr, wc, fr, fq, lds, wid, lane); S.done(cur); }
#undef PG8_SA
#undef PG8_SB
#undef PG8_STAGE
#undef PG8_LDA
#undef PG8_LDB
#undef PG8_MMA
#undef PG8_WAIT_V
#undef PG8_WAIT_L
#undef PG8_BAR
#undef PG8_SCHED
}
}

constexpr int BATCH = 16, SEQ = 2048, DM = 2048, T = BATCH * SEQ, DEPTH = 2;
constexpr int NMEM = 256, DIN = 4096, MEMW = 512;
constexpr int PEER_H = 8, PEER_N = 16384;
constexpr int NWAVES = 8, NTHREADS = NWAVES * 64;
constexpr float EPS = 1e-6f;
constexpr int QA = 0, KA = 768, VA = 1024, QB = 1280, KB = 1792, VB = 2304, QC = 2816, KC = 3584, VC = 3840;
constexpr int OA = 0, OB = 768, OC = 1280;

constexpr size_t MiB = 1u << 20;
constexpr size_t WS_CTL = 0, CTL_ZERO_BYTES = 2 * MiB;
constexpr size_t WS_ROWSQ = 256 * 1024;
constexpr size_t WS_ROPE = 83 * MiB, WS_BIASA = 83 * MiB + 16384;
constexpr size_t WS_WIN = 2 * MiB, WS_WOUT = 34 * MiB, WS_WMQ = 50 * MiB, WS_WMKV = 54 * MiB, WS_WMO = 62 * MiB, WS_WPQ = 66 * MiB, WS_PKEYS = 82 * MiB;
constexpr size_t WS_MEMN = 84 * MiB, WS_KVM = 116 * MiB, WS_PU = 132 * MiB, WS_PV = 260 * MiB, WS_XN = 388 * MiB, WS_QKV = 516 * MiB, WS_ATT = 772 * MiB;
constexpr size_t WS_QM = 900 * MiB, WS_OM = 932 * MiB, WS_MIXSQ = 964 * MiB, MIXSQ_BYTES = 2 * MiB, WS_WIN8 = 966 * MiB, WS_WSC = 982 * MiB, WS_XSC = 982 * MiB + 65536, WS_XSC2 = 982 * MiB + 196608, WS_WSCO = 982 * MiB + 327680, WS_WSCP = 982 * MiB + 344064, WS_WSCM = 982 * MiB + 352256,
                 WS_WOUT8 = 984 * MiB, WS_WPQ8 = 992 * MiB, WS_WMQ8 = 996 * MiB, WS_END = 998 * MiB;
constexpr size_t WS_QP = WS_QKV, WS_PIDX = WS_QKV + 128 * MiB, WS_PGATE = WS_QKV + 144 * MiB, WS_PARTI = WS_QKV + 160 * MiB;
constexpr size_t WS_XQH = 900 * MiB, WS_XQL = 932 * MiB;
constexpr size_t WS_ATT8 = 900 * MiB;
constexpr size_t WS_XN8 = 836 * MiB;
constexpr int CW_BAR = 4096;

constexpr int RING_OFF = 0, RING_BYTES = 131072;
constexpr int LDSCTL_OFF = RING_BYTES, MISC_OFF = LDSCTL_OFF + 320;
constexpr int LDS_BYTES = 147456;

#define GAS __attribute__((address_space(1)))
#define LAS __attribute__((address_space(3)))
typedef unsigned short bf16;
typedef unsigned v4u __attribute__((ext_vector_type(4)));
typedef unsigned v2u __attribute__((ext_vector_type(2)));
typedef float f32x4 __attribute__((ext_vector_type(4)));
typedef float f32x16 __attribute__((ext_vector_type(16)));
typedef short bf16x8 __attribute__((ext_vector_type(8)));
typedef GAS unsigned gu32;
#define LDS_WAIT() asm volatile("s_waitcnt lgkmcnt(0)" ::: "memory")
#define VM_WAIT() asm volatile("s_waitcnt vmcnt(0)" ::: "memory")
__device__ __forceinline__ unsigned f2bf(float f) { unsigned u = __builtin_bit_cast(unsigned, f); return (u + 0x7fffu + ((u >> 16) & 1u)) >> 16; }
__device__ __forceinline__ unsigned pk2(float lo, float hi) { return f2bf(lo) | (f2bf(hi) << 16); }
__device__ __forceinline__ float bflo(unsigned w) { return __builtin_bit_cast(float, w << 16); }
__device__ __forceinline__ float bfhi(unsigned w) { return __builtin_bit_cast(float, w & 0xffff0000u); }

__device__ __forceinline__ float shx(float v, int k, int lane) { return __builtin_bit_cast(float, __builtin_amdgcn_ds_bpermute((lane ^ k) << 2, __builtin_bit_cast(int, v))); }
#define XB_TMO      128
#define XB_XCNT(j)  (256  + 64 * (j))
#define XB_XSUB(j)  (1280 + 64 * (j))
#define XB_XGEN(j)  (2304 + 64 * (j))
#define XB_TOP      3328
#define XB_TOPGEN   3392
#define XCD_BAR_WORDS 3456
#define XB_SPIN_CAP (1u << 18)

__device__ __forceinline__ unsigned xb_ld(unsigned* p)              { return __hip_atomic_load(p, __ATOMIC_RELAXED, __HIP_MEMORY_SCOPE_AGENT); }
__device__ __forceinline__ unsigned xb_add(unsigned* p, unsigned v) { return __hip_atomic_fetch_add(p, v, __ATOMIC_RELAXED, __HIP_MEMORY_SCOPE_AGENT); }
__device__ __forceinline__ unsigned xb_xcc_id() { return (unsigned)__builtin_amdgcn_s_getreg((3 << 11) | 20) & 0xFu; }
#define XB_SPIN(cond, bar) do { unsigned _sp = 0; while (cond) { __builtin_amdgcn_s_sleep(1); \
    if ((++_sp & 255u) == 0u) { if (xb_ld(&(bar)[XB_TMO])) break; if (_sp > XB_SPIN_CAP) { atomicAdd(&(bar)[XB_TMO], 1u); break; } } } } while (0)

struct XcdBarrier {
    unsigned* bar; unsigned x;
    volatile LAS unsigned* st;
};

__device__ __forceinline__ XcdBarrier xcd_barrier_post(unsigned* bar, volatile LAS unsigned* st) {
    XcdBarrier b; b.bar = bar; b.x = xb_xcc_id(); b.st = st;
    if (threadIdx.x == 0) (void)xb_add(&bar[XB_XCNT(b.x)], 1u);
    return b;
}
__device__ __forceinline__ void xcd_barrier_complete(unsigned* bar, unsigned x, unsigned& nloc, unsigned& nx) {
    const unsigned G = gridDim.x * gridDim.y * gridDim.z;
    unsigned sum, cnt, mine, sp = 0u;
    for (;;) {
        sum = 0u; cnt = 0u; mine = 0u;
#pragma unroll
        for (unsigned j = 0; j < 16; ++j) { const unsigned c = xb_ld(&bar[XB_XCNT(j)]); sum += c; cnt += (c > 0u) ? 1u : 0u; mine = (j == x) ? c : mine; }
        if (sum == G) break;
        __builtin_amdgcn_s_sleep(1);
        if ((++sp & 255u) == 0u) { if (xb_ld(&bar[XB_TMO])) break; if (sp > XB_SPIN_CAP) { atomicAdd(&bar[XB_TMO], 1u); break; } }
    }
    nloc = mine > 0u ? mine : 1u; nx = cnt > 0u ? cnt : 1u;
}

__device__ __forceinline__ void xcd_barrier(const XcdBarrier& b) {
    asm volatile("s_waitcnt vmcnt(0)" ::: "memory");
    __syncthreads();
    if (threadIdx.x == 0) {
        unsigned* bar = b.bar;
        __builtin_amdgcn_s_waitcnt(0);
        unsigned nloc = b.st[0], nx = b.st[1];
        if (nloc == 0u) { xcd_barrier_complete(bar, b.x, nloc, nx); b.st[0] = nloc; b.st[1] = nx; }
        const unsigned old = xb_add(&bar[XB_XSUB(b.x)], 1u);
        const unsigned gen = old / nloc;
        if (old + 1u == (gen + 1u) * nloc) {
            __builtin_amdgcn_fence(__ATOMIC_RELEASE, "agent");
            asm volatile("s_waitcnt vmcnt(0)" ::: "memory");
            const unsigned og = xb_add(&bar[XB_TOP], 1u);
            const unsigned tg = og / nx;
            if (og + 1u == (tg + 1u) * nx) xb_add(&bar[XB_TOPGEN], 1u);
            else XB_SPIN(xb_ld(&bar[XB_TOPGEN]) == tg, bar);
            __builtin_amdgcn_fence(__ATOMIC_ACQUIRE, "agent");
            xb_add(&bar[XB_XGEN(b.x)], 1u);
            asm volatile("s_waitcnt vmcnt(0)" ::: "memory");
        } else {
            XB_SPIN(xb_ld(&bar[XB_XGEN(b.x)]) == gen, bar);
            __builtin_amdgcn_fence(__ATOMIC_ACQUIRE, "agent");
            asm volatile("s_waitcnt vmcnt(0)" ::: "memory");
        }
    }
    __syncthreads();
}

__device__ __forceinline__ float wave_sum(float v, int lane) {
#pragma unroll
    for (int o = 1; o < 64; o <<= 1) v += shx(v, o, lane);
    return v;
}
__device__ __forceinline__ void* ldptr(LAS unsigned char* lds, int i) {
    const unsigned long long v = ((const LAS unsigned long long*)(lds + LDSCTL_OFF + 1024))[i];
    const unsigned lo = __builtin_amdgcn_readfirstlane((unsigned)v), hi = __builtin_amdgcn_readfirstlane((unsigned)(v >> 32));
    return (void*)(((unsigned long long)hi << 32) | lo);
}
struct OffsetOrder {
    pg8::StaticOrder S;
    __device__ __forceinline__ void init(int M, int N, int G, int c, int off) { S.init(M, N, G, (c + G - off % G) % G); }
    __device__ __forceinline__ bool next(int i, pg8::Unit& u) const { return S.next(i, u); }
    __device__ __forceinline__ void a_ready(const pg8::Unit&) const {}
    __device__ __forceinline__ void done(const pg8::Unit&) const {}
};

template <bool PERMQKV>
__device__ __forceinline__ void transpose_item(const float* W, int K, int N, bf16* WT, LAS float* scr, int item, int lane, const float* gk = nullptr) {
    const int nblk = N / 32, kb = item / nblk, nb = item % nblk, k0 = 64 * kb, n0 = 32 * nb;
    int d0 = n0;
    if (PERMQKV) { const int within = n0 & 255; d0 = (n0 & ~255) + 128 * ((within >> 5) & 1) + 32 * (within >> 6); }
#pragma unroll
    for (int i = 0; i < 8; ++i) { const int kk = 8 * i + (lane >> 3), nn = 4 * (lane & 7);
        const f32x4 w4 = *(const GAS f32x4*)(W + (size_t)(k0 + kk) * N + n0 + nn) * (gk ? gk[k0 + kk] : 1.f);
        scr[kk * 33 + nn] = w4[0]; scr[kk * 33 + nn + 1] = w4[1]; scr[kk * 33 + nn + 2] = w4[2]; scr[kk * 33 + nn + 3] = w4[3]; }
    LDS_WAIT(); asm volatile("" ::: "memory");
    const int c = lane & 7;
#pragma unroll
    for (int j = 0; j < 4; ++j) { const int n = (lane >> 3) + 8 * j; const LAS float* s = scr + (8 * c) * 33 + n;
        v4u o; o.x = pk2(s[0 * 33], s[1 * 33]); o.y = pk2(s[2 * 33], s[3 * 33]); o.z = pk2(s[4 * 33], s[5 * 33]); o.w = pk2(s[6 * 33], s[7 * 33]);
        *(GAS v4u*)(WT + (size_t)(d0 + n) * K + k0 + 8 * c) = o; }
    LDS_WAIT(); asm volatile("" ::: "memory");
}
__device__ __forceinline__ void convert_bf16(const float* src, bf16* dst, size_t n, size_t gtid, size_t nthreads) {
    for (size_t i = gtid * 8; i < n; i += nthreads * 8) {
        const f32x4 a = *(const GAS f32x4*)(src + i), b = *(const GAS f32x4*)(src + i + 4);
        v4u o; o.x = pk2(a[0], a[1]); o.y = pk2(a[2], a[3]); o.z = pk2(b[0], b[1]); o.w = pk2(b[2], b[3]);
        *(GAS v4u*)(dst + i) = o;
    }
}
__device__ __forceinline__ int t5_bucket(int rel) {
    const int n = rel < 0 ? -rel : rel;
    const int b = n < 8 ? n : n < 12 ? 8 : n < 16 ? 9 : n < 23 ? 10 : n < 32 ? 11 : n < 46 ? 12 : n < 64 ? 13 : n < 91 ? 14 : 15;
    return b + (rel > 0 ? 16 : 0);
}
__constant__ float ROPE_INV[16] = {1.000000000e+00f, 5.623413324e-01f, 3.162277639e-01f, 1.778279394e-01f, 1.000000015e-01f, 5.623413250e-02f, 3.162277490e-02f, 1.778279431e-02f,
                                   9.999999776e-03f, 5.623413250e-03f, 3.162277630e-03f, 1.778279431e-03f, 1.000000047e-03f, 5.623413017e-04f, 3.162277571e-04f, 1.778279402e-04f};

__device__ __forceinline__ void rms_row_to_bf16(const float* xrow, const float* g0, bf16* o0, const float* g1, bf16* o1, int lane) {
    const GAS f32x4* xr = (const GAS f32x4*)xrow + lane;
    f32x4 v[8]; float s = 0.f;
#pragma unroll
    for (int j = 0; j < 8; ++j) { v[j] = xr[64 * j]; s += (v[j].x * v[j].x + v[j].y * v[j].y) + (v[j].z * v[j].z + v[j].w * v[j].w); }
    const float rstd = 1.f / sqrtf(wave_sum(s, lane) * (1.f / DM) + EPS);
    {   const GAS f32x4* gr = (const GAS f32x4*)g0 + lane; GAS v2u* o8 = (GAS v2u*)o0 + lane;
#pragma unroll
        for (int j = 0; j < 8; ++j) { const f32x4 gg = gr[64 * j]; v2u w; w.x = pk2(v[j].x * rstd * gg.x, v[j].y * rstd * gg.y); w.y = pk2(v[j].z * rstd * gg.z, v[j].w * rstd * gg.w); o8[64 * j] = w; } }
    if (g1) { const GAS f32x4* gr = (const GAS f32x4*)g1 + lane; GAS v2u* o8 = (GAS v2u*)o1 + lane;
#pragma unroll
        for (int j = 0; j < 8; ++j) { const f32x4 gg = gr[64 * j]; v2u w; w.x = pk2(v[j].x * rstd * gg.x, v[j].y * rstd * gg.y); w.y = pk2(v[j].z * rstd * gg.z, v[j].w * rstd * gg.w); o8[64 * j] = w; } }
}
__device__ __forceinline__ float wave_max(float v, int lane) {
#pragma unroll
    for (int o = 1; o < 64; o <<= 1) v = fmaxf(v, shx(v, o, lane));
    return v;
}
__device__ __forceinline__ unsigned q8x4(const f32x4 v, const float inv) {
    unsigned w = 0;
    w = __builtin_amdgcn_cvt_pk_u8_f32(__builtin_rintf(__builtin_fmaf(v[0], inv, 128.f)), 0, w); w = __builtin_amdgcn_cvt_pk_u8_f32(__builtin_rintf(__builtin_fmaf(v[1], inv, 128.f)), 1, w);
    w = __builtin_amdgcn_cvt_pk_u8_f32(__builtin_rintf(__builtin_fmaf(v[2], inv, 128.f)), 2, w); w = __builtin_amdgcn_cvt_pk_u8_f32(__builtin_rintf(__builtin_fmaf(v[3], inv, 128.f)), 3, w);
    return w ^ 0x80808080u;
}
__device__ __forceinline__ float amax4(const f32x4 v) { return fmaxf(fmaxf(fabsf(v[0]), fabsf(v[1])), fmaxf(fabsf(v[2]), fabsf(v[3]))); }
__device__ __forceinline__ void quant_wrow(const bf16* src, unsigned char* dst, float* step, int lane) {
    v4u w[4]; float am = 0.f;
#pragma unroll
    for (int j = 0; j < 4; ++j) w[j] = *(const GAS v4u*)(src + 8 * lane + 512 * j);
    f32x4 lo[4], hi[4];
#pragma unroll
    for (int j = 0; j < 4; ++j) { lo[j] = (f32x4){bflo(w[j].x), bfhi(w[j].x), bflo(w[j].y), bfhi(w[j].y)}; hi[j] = (f32x4){bflo(w[j].z), bfhi(w[j].z), bflo(w[j].w), bfhi(w[j].w)}; am = fmaxf(am, fmaxf(amax4(lo[j]), amax4(hi[j]))); }
    am = fmaxf(wave_max(am, lane), 1e-30f);
    const float inv = 127.f / am;
#pragma unroll
    for (int j = 0; j < 4; ++j) *(GAS v2u*)(dst + 8 * lane + 512 * j) = (v2u){q8x4(lo[j], inv), q8x4(hi[j], inv)};
    if (lane == 0) *step = am * (1.f / 127.f);
}
template <int R>
__device__ __forceinline__ void att_quant_rows(const bf16* ATT, const u64_t* mixsq, unsigned char* Q, float* step, int row0, int lane) {
    v4u w[R][4];
#pragma unroll
    for (int q = 0; q < R; ++q)
#pragma unroll
        for (int j = 0; j < 4; ++j) w[q][j] = *(const GAS v4u*)(ATT + (size_t)(row0 + q) * DM + 8 * lane + 512 * j);
#pragma unroll
    for (int q = 0; q < R; ++q) { const int row = row0 + q;
        const float ra = 1.0f / sqrtf((float)*(const GAS u64_t*)(mixsq + row) * (5.9604644775390625e-08f / 768.0f) + EPS), rb = 1.0f / sqrtf((float)*(const GAS u64_t*)(mixsq + T + row) * (5.9604644775390625e-08f / 512.0f) + EPS),
                    rc = 1.0f / sqrtf((float)*(const GAS u64_t*)(mixsq + 2 * (size_t)T + row) * (5.9604644775390625e-08f / 768.0f) + EPS);
        const float rj[4] = {ra, lane < 32 ? ra : rb, lane < 32 ? rb : rc, rc};
        f32x4 lo[4], hi[4]; float am = 0.f;
#pragma unroll
        for (int j = 0; j < 4; ++j) { lo[j] = (f32x4){bflo(w[q][j].x), bfhi(w[q][j].x), bflo(w[q][j].y), bfhi(w[q][j].y)} * rj[j]; hi[j] = (f32x4){bflo(w[q][j].z), bfhi(w[q][j].z), bflo(w[q][j].w), bfhi(w[q][j].w)} * rj[j]; am = fmaxf(am, fmaxf(amax4(lo[j]), amax4(hi[j]))); }
        am = fmaxf(wave_max(am, lane), 1e-30f);
        const float inv = 127.f / am;
#pragma unroll
        for (int j = 0; j < 4; ++j) *(GAS v2u*)(Q + (size_t)row * DM + 8 * lane + 512 * j) = (v2u){q8x4(lo[j], inv), q8x4(hi[j], inv)};
        if (lane == 0) step[row] = am * (1.f / 127.f); }
}
__device__ __forceinline__ void prep_rows2(const float* x0, bf16* o0, u64_t* sq, unsigned char* q0, float* qstep, int lane) {
    f32x4 v[2][8];
#pragma unroll
    for (int q = 0; q < 2; ++q) { const GAS f32x4* xr = (const GAS f32x4*)(x0 + (size_t)q * DM) + lane;
#pragma unroll
        for (int j = 0; j < 8; ++j) v[q][j] = xr[64 * j]; }
#pragma unroll
    for (int q = 0; q < 2; ++q) { GAS v2u* o8 = (GAS v2u*)(o0 + (size_t)q * DM) + lane; float s = 0.f;
#pragma unroll
        for (int j = 0; j < 8; ++j) { const f32x4 a = v[q][j]; s += (a.x * a.x + a.y * a.y) + (a.z * a.z + a.w * a.w); v2u w; w.x = pk2(a.x, a.y); w.y = pk2(a.z, a.w); o8[64 * j] = w; }
        s = wave_sum(s, lane);
        float am = 0.f;
#pragma unroll
        for (int j = 0; j < 8; ++j) am = fmaxf(am, amax4(v[q][j]));
        am = fmaxf(wave_max(am, lane), 1e-30f);
        const float inv = 127.f / am;
#pragma unroll
        for (int j = 0; j < 8; ++j) *(GAS unsigned*)(q0 + (size_t)q * DM + 4 * lane + 256 * j) = q8x4(v[q][j], inv);
        if (lane == 0) { sq[q] = rowsq_fx(s); qstep[q] = am * (1.f / 127.f); } }
}
__device__ __forceinline__ void norm_rows(const float* X, const float* g, bf16* XN, int gw, int NGW, int lane) {
    for (int m = gw; m < T; m += NGW) rms_row_to_bf16(X + (size_t)m * DM, g, XN + (size_t)m * DM, nullptr, nullptr, lane);
}

template <int TYPE>
__device__ __forceinline__ void naive_attn_item(const bf16* QKV, bf16* ATT, int b, int grow, int head, int lane, const float* biasA, const float* sink, const float* rpb) {
    const int tpos = grow * 64 + lane; const size_t trow = (size_t)b * SEQ + tpos;
    int qcol, kcol, vcol, ocol;
    if (TYPE == 0) { qcol = QA + head * 64; kcol = KA + (head / 3) * 64; vcol = VA + (head / 3) * 64; ocol = OA + head * 64; }
    else if (TYPE == 1) { qcol = QB + head * 64; kcol = KB + head * 64; vcol = VB + head * 64; ocol = OB + head * 64; }
    else { qcol = QC + head * 64; kcol = KC + (head / 3) * 64; vcol = VC + (head / 3) * 64; ocol = OC + head * 64; }
    float q[64], o[64];
#pragma unroll
    for (int c = 0; c < 8; ++c) { const v4u w = *(const GAS v4u*)(QKV + trow * DIN + qcol + 8 * c);
        q[8 * c + 0] = bflo(w.x); q[8 * c + 1] = bfhi(w.x); q[8 * c + 2] = bflo(w.y); q[8 * c + 3] = bfhi(w.y); q[8 * c + 4] = bflo(w.z); q[8 * c + 5] = bfhi(w.z); q[8 * c + 6] = bflo(w.w); q[8 * c + 7] = bfhi(w.w); }
#pragma unroll
    for (int d = 0; d < 64; ++d) o[d] = 0.f;
    float m = -1e30f, l = 0.f;
    int j0, j1;
    if (TYPE == 0) { j0 = grow * 64 - 128; if (j0 < 0) j0 = 0; j1 = grow * 64 + 63 + 128; if (j1 > SEQ - 1) j1 = SEQ - 1; }
    else if (TYPE == 1) { int r0 = grow - 4; r0 = r0 < 0 ? 0 : (r0 > 24 ? 24 : r0); j0 = r0 * 64; j1 = j0 + 511; }
    else { j0 = 0; j1 = SEQ - 1; }
    int c0 = lane - 8; c0 = c0 < 0 ? 0 : (c0 > 48 ? 48 : c0);
#pragma unroll 1
    for (int j = j0; j <= j1; ++j) {
        const bf16* krow = QKV + ((size_t)b * SEQ + j) * DIN;
        float s = 0.f;
#pragma unroll
        for (int c = 0; c < 8; ++c) { const v4u w = *(const GAS v4u*)(krow + kcol + 8 * c);
            s += q[8 * c + 0] * bflo(w.x) + q[8 * c + 1] * bfhi(w.x) + q[8 * c + 2] * bflo(w.y) + q[8 * c + 3] * bfhi(w.y) + q[8 * c + 4] * bflo(w.z) + q[8 * c + 5] * bfhi(w.z) + q[8 * c + 6] * bflo(w.w) + q[8 * c + 7] * bfhi(w.w); }
        bool valid = true;
        if (TYPE == 0) { const int rel = j - tpos; valid = (rel >= -128 && rel <= 128); if (valid) s += biasA[head * 257 + rel + 128]; }
        if (TYPE == 1) { const int kr = j >> 6, kc = j & 63; valid = (kc >= c0 && kc < c0 + 16); if (valid) s += rpb[(head * 15 + (kr - grow + 7)) * 31 + (kc - lane + 15)]; }
        const float mn = valid ? fmaxf(m, s) : m;
        const float a = __expf(m - mn);
        const float p = valid ? __expf(s - mn) : 0.f;
        l = l * a + p; m = mn;
#pragma unroll
        for (int c = 0; c < 8; ++c) { const v4u w = *(const GAS v4u*)(krow + vcol + 8 * c);
            o[8 * c + 0] = o[8 * c + 0] * a + p * bflo(w.x); o[8 * c + 1] = o[8 * c + 1] * a + p * bfhi(w.x); o[8 * c + 2] = o[8 * c + 2] * a + p * bflo(w.y); o[8 * c + 3] = o[8 * c + 3] * a + p * bfhi(w.y);
            o[8 * c + 4] = o[8 * c + 4] * a + p * bflo(w.z); o[8 * c + 5] = o[8 * c + 5] * a + p * bfhi(w.z); o[8 * c + 6] = o[8 * c + 6] * a + p * bflo(w.w); o[8 * c + 7] = o[8 * c + 7] * a + p * bfhi(w.w); }
    }
    if (TYPE == 0) l += __expf(sink[head] - m);
    const float inv = 1.f / l;
#pragma unroll
    for (int c = 0; c < 8; ++c) { v4u w; w.x = pk2(o[8 * c + 0] * inv, o[8 * c + 1] * inv); w.y = pk2(o[8 * c + 2] * inv, o[8 * c + 3] * inv); w.z = pk2(o[8 * c + 4] * inv, o[8 * c + 5] * inv); w.w = pk2(o[8 * c + 6] * inv, o[8 * c + 7] * inv);
        *(GAS v4u*)(ATT + trow * DM + ocol + 8 * c) = w; }
}
__device__ __forceinline__ float rdl(float v, int l) { return __builtin_bit_cast(float, __builtin_amdgcn_readlane(__builtin_bit_cast(int, v), l)); }
__device__ __forceinline__ void naive_mem_item(const bf16* QM, const bf16* KVM, bf16* OM, const float* gq, size_t trow, int b, int head, int lane) {
    const unsigned qw = *(const GAS unsigned*)(QM + trow * MEMW + head * 128 + 2 * lane);
    float q0 = bflo(qw), q1 = bfhi(qw);
    const float ss = wave_sum(q0 * q0 + q1 * q1, lane);
    const float r = 0.08838834764831845f / sqrtf(ss * (1.f / 128.f) + EPS);
    q0 *= r * gq[2 * lane]; q1 *= r * gq[2 * lane + 1];
    const bf16* kbase = KVM + ((size_t)b * NMEM + lane) * 1024 + head * 128;
    float s[4] = {0.f, 0.f, 0.f, 0.f};
#pragma unroll 1
    for (int c = 0; c < 16; ++c) {
        float qa[8];
#pragma unroll
        for (int e = 0; e < 4; ++e) { qa[2 * e] = rdl(q0, 4 * c + e); qa[2 * e + 1] = rdl(q1, 4 * c + e); }
#pragma unroll
        for (int i = 0; i < 4; ++i) { const v4u w = *(const GAS v4u*)(kbase + (size_t)i * 64 * 1024 + 8 * c);
            s[i] += qa[0] * bflo(w.x) + qa[1] * bfhi(w.x) + qa[2] * bflo(w.y) + qa[3] * bfhi(w.y) + qa[4] * bflo(w.z) + qa[5] * bfhi(w.z) + qa[6] * bflo(w.w) + qa[7] * bfhi(w.w); }
    }
    float m = fmaxf(fmaxf(s[0], s[1]), fmaxf(s[2], s[3]));
#pragma unroll
    for (int o = 1; o < 64; o <<= 1) m = fmaxf(m, shx(m, o, lane));
    float p[4]; float l = 0.f;
#pragma unroll
    for (int i = 0; i < 4; ++i) { p[i] = __expf(s[i] - m); l += p[i]; }
    l = wave_sum(l, lane);
    const bf16* vbase = KVM + ((size_t)b * NMEM) * 1024 + 512 + head * 128 + 2 * lane;
    float o0 = 0.f, o1 = 0.f;
#pragma unroll
    for (int i = 0; i < 4; ++i) {
#pragma unroll 4
        for (int jj = 0; jj < 64; ++jj) { const float pj = rdl(p[i], jj); const unsigned w = *(const GAS unsigned*)(vbase + (size_t)(64 * i + jj) * 1024); o0 += pj * bflo(w); o1 += pj * bfhi(w); }
    }
    const float inv = 1.f / l;
    *(GAS unsigned*)(OM + trow * MEMW + head * 128 + 2 * lane) = pk2(o0 * inv, o1 * inv);
}
__device__ __forceinline__ void mixnorm_rows(bf16* ATT, const float* g, int gw, int NGW, int lane) {
    for (int m = gw; m < T; m += NGW) {
        GAS v4u* p = (GAS v4u*)(ATT + (size_t)m * DM + 32 * lane);
        v4u w[4]; float f[32]; float ss = 0.f;
#pragma unroll
        for (int c = 0; c < 4; ++c) { w[c] = p[c];
            f[8 * c + 0] = bflo(w[c].x); f[8 * c + 1] = bfhi(w[c].x); f[8 * c + 2] = bflo(w[c].y); f[8 * c + 3] = bfhi(w[c].y); f[8 * c + 4] = bflo(w[c].z); f[8 * c + 5] = bfhi(w[c].z); f[8 * c + 6] = bflo(w[c].w); f[8 * c + 7] = bfhi(w[c].w); }
#pragma unroll
        for (int i = 0; i < 32; ++i) ss += f[i] * f[i];
        const int grp = lane < 24 ? 0 : (lane < 40 ? 1 : 2);
        const float sa = wave_sum(grp == 0 ? ss : 0.f, lane), sb = wave_sum(grp == 1 ? ss : 0.f, lane), sc = wave_sum(grp == 2 ? ss : 0.f, lane);
        const float r = grp == 0 ? 1.f / sqrtf(sa * (1.f / 768.f) + EPS) : (grp == 1 ? 1.f / sqrtf(sb * (1.f / 512.f) + EPS) : 1.f / sqrtf(sc * (1.f / 768.f) + EPS));
        const float* gg = g + 32 * lane;
#pragma unroll
        for (int c = 0; c < 4; ++c) { const f32x4 g0 = *(const GAS f32x4*)(gg + 8 * c), g1 = *(const GAS f32x4*)(gg + 8 * c + 4);
            v4u o; o.x = pk2(f[8 * c + 0] * r * g0[0], f[8 * c + 1] * r * g0[1]); o.y = pk2(f[8 * c + 2] * r * g0[2], f[8 * c + 3] * r * g0[3]);
            o.z = pk2(f[8 * c + 4] * r * g1[0], f[8 * c + 5] * r * g1[1]); o.w = pk2(f[8 * c + 6] * r * g1[2], f[8 * c + 7] * r * g1[3]); p[c] = o; }
    }
}

#ifndef PEER_HD
#define PEER_HD __device__ __forceinline__
#define PEER_EXP(x) __expf(x)
#endif
template <int N> PEER_HD void bitonic_sort_desc(float* v) {
#pragma unroll
    for (int k = 2; k <= N; k <<= 1)
#pragma unroll
        for (int j = k >> 1; j > 0; j >>= 1)
#pragma unroll
            for (int i = 0; i < N; ++i) { const int l = i ^ j; if (l > i) { const bool desc = ((i & k) == 0); const float a = v[i], b = v[l]; const float hi = fmaxf(a, b), lo = fminf(a, b);
                v[i] = desc ? hi : lo; v[l] = desc ? lo : hi; } }
}
PEER_HD void merge_top16(float* a, const float* b) {
    float c[16];
#pragma unroll
    for (int i = 0; i < 16; ++i) c[i] = fmaxf(a[i], b[15 - i]);
#pragma unroll
    for (int j = 8; j > 0; j >>= 1)
#pragma unroll
        for (int i = 0; i < 16; ++i) { const int l = i ^ j; if (l > i) { const float x = c[i], y = c[l]; c[i] = fmaxf(x, y); c[l] = fminf(x, y); } }
#pragma unroll
    for (int i = 0; i < 16; ++i) a[i] = c[i];
}
PEER_HD void top16_of_64(float (&v)[64]) {
    bitonic_sort_desc<16>(&v[0]); bitonic_sort_desc<16>(&v[16]); bitonic_sort_desc<16>(&v[32]); bitonic_sort_desc<16>(&v[48]);
    merge_top16(&v[0], &v[16]); merge_top16(&v[32], &v[48]); merge_top16(&v[0], &v[32]);
}
PEER_HD float pack_idx(float s, unsigned idx, unsigned mask) { return __builtin_bit_cast(float, (__builtin_bit_cast(unsigned, s) & ~mask) | idx); }
PEER_HD unsigned low_bits(float s, unsigned mask) { return __builtin_bit_cast(unsigned, s) & mask; }
PEER_HD unsigned pick16(const float* a, unsigned i, unsigned mask) {
    unsigned r = 0;
#pragma unroll
    for (unsigned k = 0; k < 16; ++k) r = (i == k) ? low_bits(a[k], mask) : r;
    return r;
}
PEER_HD void peer_candidates(const float* a, const float* b, int* e, float* gate) {
    float c[64]; int n = 0;
#pragma unroll
    for (int i = 0; i < 16; ++i)
#pragma unroll
        for (int j = 0; j < 16; ++j) if ((i + 1) * (j + 1) <= 16) { c[n] = pack_idx(a[i] + b[j], (unsigned)(i * 16 + j), 0xffu); ++n; }
#pragma unroll
    for (int k = 50; k < 64; ++k) c[k] = -3.0e38f;
    top16_of_64(c);
    float mx = c[0], den = 0.f;
#pragma unroll
    for (int k = 0; k < 16; ++k) { const unsigned id = low_bits(c[k], 0xffu); const unsigned n0 = pick16(a, id >> 4, 0x7fu), n1 = pick16(b, id & 15u, 0x7fu);
        e[k] = (int)(n0 * 128u + n1); gate[k] = PEER_EXP(c[k] - mx); den += gate[k]; }
    const float inv = 1.f / den;
#pragma unroll
    for (int k = 0; k < 16; ++k) gate[k] *= inv;
}

__device__ __forceinline__ void peer_select_unit(const bf16* QP, const bf16* PK, int* PIDX, float* PGATE, int tb, int h, int wave, int lane) {
    const int hh = lane >> 5, tl = lane & 31; const size_t t = (size_t)tb * 256 + wave * 32 + tl;
    float ab[2][16];
#pragma unroll
    for (int p = 0; p < 2; ++p) {
        bf16x8 bq[8];
#pragma unroll
        for (int s = 0; s < 8; ++s) bq[s] = *(const GAS bf16x8*)(QP + t * DM + 256 * h + 128 * p + 16 * s + 8 * hh);
        float v[64];
#pragma unroll
        for (int nb = 0; nb < 4; ++nb) {
            f32x16 acc;
#pragma unroll
            for (int r = 0; r < 16; ++r) acc[r] = 0.f;
            const bf16* kp = PK + ((size_t)((h * 2 + p) * 128 + 32 * nb + tl)) * 128 + 8 * hh;
            bf16x8 ak[8];
#pragma unroll
            for (int s = 0; s < 8; ++s) ak[s] = *(const GAS bf16x8*)(kp + 16 * s);
#pragma unroll
            for (int s = 0; s < 8; ++s) acc = __builtin_amdgcn_mfma_f32_32x32x16_bf16(ak[s], bq[s], acc, 0, 0, 0);
#pragma unroll
            for (int r = 0; r < 16; ++r) v[16 * nb + r] = pack_idx(acc[r], (unsigned)(32 * nb + 8 * (r >> 2) + 4 * hh + (r & 3)), 0x7fu);
        }
        top16_of_64(v);
        float pv[16];
#pragma unroll
        for (int i = 0; i < 16; ++i) pv[i] = shx(v[i], 32, lane);
        merge_top16(&v[0], pv);
#pragma unroll
        for (int i = 0; i < 16; ++i) ab[p][i] = v[i];
    }
    int e[16]; float gate[16];
    peer_candidates(ab[0], ab[1], e, gate);
    if (hh == 0) { GAS v4u* o = (GAS v4u*)(PIDX + t * 128 + h * 16);
#pragma unroll
        for (int c = 0; c < 4; ++c) o[c] = (v4u){(unsigned)e[4 * c], (unsigned)e[4 * c + 1], (unsigned)e[4 * c + 2], (unsigned)e[4 * c + 3]}; }
    else { GAS f32x4* o = (GAS f32x4*)(PGATE + t * 128 + h * 16);
#pragma unroll
        for (int c = 0; c < 4; ++c) o[c] = (f32x4){gate[4 * c], gate[4 * c + 1], gate[4 * c + 2], gate[4 * c + 3]}; }
}

typedef float f32x2 __attribute__((ext_vector_type(2)));
typedef unsigned v6u __attribute__((ext_vector_type(6)));
typedef float v32f __attribute__((ext_vector_type(32)));
typedef v4u __attribute__((aligned(8))) v4u_a8;
constexpr float PU_SCALE6 = 90.0f, PV_SCALE6 = 5.65f;
__device__ __forceinline__ unsigned enc_e2m3(float v) {
    const float a = fminf(fabsf(v), 7.5f);
    unsigned code;
    if (a < 1.0f) code = (unsigned)__builtin_rintf(a * 8.f);
    else { const unsigned b = __builtin_bit_cast(unsigned, a) - 0x3F800000u; code = ((b + 0x7FFFFu + ((b >> 20) & 1u)) >> 20) + 8u; }
    return code | (v < 0.f ? 32u : 0u);
}
__device__ __forceinline__ void convert_fp6_rows(const float* src, unsigned char* dst, int nrows, float scale, const float* gain, int gw, int NGW, int lane) {
    for (int r = gw; r < nrows; r += NGW) {
        const float* sp = src + (size_t)r * DM + 4 * lane; const float* gp = gain ? gain + (size_t)(r / PEER_N) * DM + 4 * lane : nullptr;
        unsigned w[6] = {0u, 0u, 0u, 0u, 0u, 0u};
#pragma unroll
        for (int j = 0; j < 8; ++j) { f32x4 a = *(const GAS f32x4*)(sp + 256 * j) * scale; if (gp) a = a * *(const GAS f32x4*)(gp + 256 * j);
#pragma unroll
            for (int e = 0; e < 4; ++e) { const unsigned code = enc_e2m3(a[e]); const int bp = 6 * (4 * j + e), wi = bp >> 5, sh = bp & 31;
                w[wi] |= code << sh; if (sh > 26) w[wi + 1] |= code >> (32 - sh); } }
        unsigned char* dp = dst + (size_t)r * 1536 + 24 * lane;
        *(GAS v4u_a8*)dp = (v4u){w[0], w[1], w[2], w[3]}; *(GAS v2u*)(dp + 16) = (v2u){w[4], w[5]};
    }
}
constexpr float PV_SCALE4 = 5.65f, PU_SCALE4 = 90.0f;
__device__ __forceinline__ unsigned enc_e2m1(float v) {
    const float a = fabsf(v);
    const unsigned code = a < 0.25f ? 0u : a < 0.75f ? 1u : a < 1.25f ? 2u : a < 1.75f ? 3u : a < 2.5f ? 4u : a < 3.5f ? 5u : a < 5.0f ? 6u : 7u;
    return code | (v < 0.f ? 8u : 0u);
}
__device__ __forceinline__ void convert_fp4_rows(const float* src, unsigned char* dst, int nrows, float scale, const float* gain, int gw, int NGW, int lane) {
    for (int r0 = 2 * gw; r0 < nrows; r0 += 2 * NGW) {
        f32x4 a[2][8];
#pragma unroll
        for (int q = 0; q < 2; ++q) { const float* sp = src + (size_t)(r0 + q) * DM + 4 * lane;
#pragma unroll
            for (int j = 0; j < 8; ++j) a[q][j] = *(const GAS f32x4*)(sp + 256 * j); }
#pragma unroll
        for (int q = 0; q < 2; ++q) { const int r = r0 + q; const float* gp = gain ? gain + (size_t)(r / PEER_N) * DM + 4 * lane : nullptr;
            unsigned w[4] = {0u, 0u, 0u, 0u};
#pragma unroll
            for (int j = 0; j < 8; ++j) { f32x4 v = a[q][j] * scale; if (gp) v = v * *(const GAS f32x4*)(gp + 256 * j);
#pragma unroll
                for (int e = 0; e < 4; ++e) { const int i = 4 * j + e; w[i >> 3] |= enc_e2m1(v[e]) << (4 * (i & 7)); } }
            *(GAS v4u*)(dst + (size_t)r * 1024 + 16 * lane) = (v4u){w[0], w[1], w[2], w[3]}; }
    }
}
#define PG4_LOAD(buf, tab, idlo, idhi, g) do { _Pragma("unroll") for (int i_ = 0; i_ < PG6_R; ++i_) { const int k_ = (g) * PG6_R + i_; \
        const int e_ = __builtin_amdgcn_readlane(k_ < 64 ? idlo : idhi, k_ & 63); buf[i_] = __builtin_amdgcn_raw_buffer_load_b128(tab, (int)voff4, e_ * 1024, 0); } } while (0)
#define PG4_DOT1(buf, i_, dst) do { f32x2 a_ = {0.f, 0.f}; _Pragma("unroll") for (int c_ = 0; c_ < 4; ++c_) { const unsigned u_ = buf[i_][c_]; \
        a_ += __builtin_amdgcn_cvt_scalef32_pk_f32_fp4(u_, 1.0f, 0) * x[4 * c_ + 0]; a_ += __builtin_amdgcn_cvt_scalef32_pk_f32_fp4(u_, 1.0f, 1) * x[4 * c_ + 1]; \
        a_ += __builtin_amdgcn_cvt_scalef32_pk_f32_fp4(u_, 1.0f, 2) * x[4 * c_ + 2]; a_ += __builtin_amdgcn_cvt_scalef32_pk_f32_fp4(u_, 1.0f, 3) * x[4 * c_ + 3]; } dst = a_.x + a_.y; __builtin_amdgcn_sched_barrier(0); } while (0)
#define PG4_DOT(buf, g) do { float p_[8]; _Pragma("unroll") for (int i_ = 0; i_ < 8; ++i_) PG4_DOT1(buf, i_, p_[i_]); \
        float q_[4]; _Pragma("unroll") for (int i_ = 0; i_ < 4; ++i_) { const float keep_ = b5 ? p_[i_ + 4] : p_[i_], send_ = b5 ? p_[i_] : p_[i_ + 4]; q_[i_] = keep_ + shx(send_, 32, lane); } \
        float r_[2]; _Pragma("unroll") for (int i_ = 0; i_ < 2; ++i_) { const float keep_ = b4 ? q_[i_ + 2] : q_[i_], send_ = b4 ? q_[i_] : q_[i_ + 2]; r_[i_] = keep_ + shx(send_, 16, lane); } \
        float s_; { const float keep_ = b3 ? r_[1] : r_[0], send_ = b3 ? r_[0] : r_[1]; s_ = keep_ + shx(send_, 8, lane); } \
        s_ += shx(s_, 4, lane); s_ += shx(s_, 2, lane); s_ += shx(s_, 1, lane); \
        if ((lane & 7) == 0) wl[(g) * 8 + (lane >> 3)] = s_; } while (0)
#define PG4_AXPY(buf, g) do { _Pragma("unroll") for (int i_ = 0; i_ < PG6_R; ++i_) { const float w_ = wl[(g) * PG6_R + i_]; const f32x2 wv_ = {w_, w_}; \
        _Pragma("unroll") for (int c_ = 0; c_ < 4; ++c_) { const unsigned u_ = buf[i_][c_]; \
            y[4 * c_ + 0] += __builtin_amdgcn_cvt_scalef32_pk_f32_fp4(u_, 1.0f, 0) * wv_; y[4 * c_ + 1] += __builtin_amdgcn_cvt_scalef32_pk_f32_fp4(u_, 1.0f, 1) * wv_; \
            y[4 * c_ + 2] += __builtin_amdgcn_cvt_scalef32_pk_f32_fp4(u_, 1.0f, 2) * wv_; y[4 * c_ + 3] += __builtin_amdgcn_cvt_scalef32_pk_f32_fp4(u_, 1.0f, 3) * wv_; } \
        __builtin_amdgcn_sched_barrier(0); } } while (0)
#ifndef PG6_R
#define PG6_R 8
#endif
#define PG6_LOAD(buf, tab, idlo, idhi, g) do { _Pragma("unroll") for (int i_ = 0; i_ < PG6_R; ++i_) { const int k_ = (g) * PG6_R + i_; \
        const int e_ = __builtin_amdgcn_readlane(k_ < 64 ? idlo : idhi, k_ & 63); const unsigned char* rp_ = (tab) + (size_t)(unsigned)e_ * 1536u; \
        const v4u a_ = *(const GAS v4u_a8*)(rp_ + voff); const v2u b_ = *(const GAS v2u*)(rp_ + voff + 16); buf[i_] = (v6u){a_.x, a_.y, a_.z, a_.w, b_.x, b_.y}; } } while (0)
#define PG6_DOT1(buf, i_, dst) do { const v32f f_ = __builtin_amdgcn_cvt_scalef32_pk32_f32_fp6(buf[i_], 1.0f); f32x2 a_ = {0.f, 0.f}; \
        _Pragma("unroll") for (int c_ = 0; c_ < 16; ++c_) a_ += (f32x2){f_[2 * c_], f_[2 * c_ + 1]} * x[c_]; dst = a_.x + a_.y; __builtin_amdgcn_sched_barrier(0); } while (0)
#if PG6_R == 8
#define PG6_DOT(buf, g) do { float p_[8]; _Pragma("unroll") for (int i_ = 0; i_ < 8; ++i_) PG6_DOT1(buf, i_, p_[i_]); \
        float q_[4]; _Pragma("unroll") for (int i_ = 0; i_ < 4; ++i_) { const float keep_ = b5 ? p_[i_ + 4] : p_[i_], send_ = b5 ? p_[i_] : p_[i_ + 4]; q_[i_] = keep_ + shx(send_, 32, lane); } \
        float r_[2]; _Pragma("unroll") for (int i_ = 0; i_ < 2; ++i_) { const float keep_ = b4 ? q_[i_ + 2] : q_[i_], send_ = b4 ? q_[i_] : q_[i_ + 2]; r_[i_] = keep_ + shx(send_, 16, lane); } \
        float s_; { const float keep_ = b3 ? r_[1] : r_[0], send_ = b3 ? r_[0] : r_[1]; s_ = keep_ + shx(send_, 8, lane); } \
        s_ += shx(s_, 4, lane); s_ += shx(s_, 2, lane); s_ += shx(s_, 1, lane); \
        if ((lane & 7) == 0) wl[(g) * 8 + (lane >> 3)] = s_; } while (0)
#else
#define PG6_DOT(buf, g) do { float p_[4]; _Pragma("unroll") for (int i_ = 0; i_ < 4; ++i_) PG6_DOT1(buf, i_, p_[i_]); \
        float r_[2]; _Pragma("unroll") for (int i_ = 0; i_ < 2; ++i_) { const float keep_ = b5 ? p_[i_ + 2] : p_[i_], send_ = b5 ? p_[i_] : p_[i_ + 2]; r_[i_] = keep_ + shx(send_, 32, lane); } \
        float s_; { const float keep_ = b4 ? r_[1] : r_[0], send_ = b4 ? r_[0] : r_[1]; s_ = keep_ + shx(send_, 16, lane); } \
        s_ += shx(s_, 8, lane); s_ += shx(s_, 4, lane); s_ += shx(s_, 2, lane); s_ += shx(s_, 1, lane); \
        if ((lane & 15) == 0) wl[(g) * 4 + (lane >> 4)] = s_; } while (0)
#endif
#define PG6_AXPY(buf, g) do { _Pragma("unroll") for (int i_ = 0; i_ < PG6_R; ++i_) { const float w_ = wl[(g) * PG6_R + i_]; const f32x2 wv_ = {w_, w_}; \
        const v32f f_ = __builtin_amdgcn_cvt_scalef32_pk32_f32_fp6(buf[i_], 1.0f); _Pragma("unroll") for (int c_ = 0; c_ < 16; ++c_) y[c_] += (f32x2){f_[2 * c_], f_[2 * c_ + 1]} * wv_; __builtin_amdgcn_sched_barrier(0); } } while (0)
__device__ __forceinline__ unsigned shxu(unsigned v, int k, int lane) { return (unsigned)__builtin_amdgcn_ds_bpermute((lane ^ k) << 2, (int)v); }
__device__ __forceinline__ void wave_sort128(unsigned& a, unsigned& b, int lane) {
#pragma unroll
    for (int k = 2; k <= 128; k <<= 1) {
#pragma unroll
        for (int j = k >> 1; j > 0; j >>= 1) {
            if (j == 64) { const unsigned lo = a < b ? a : b, hi = a < b ? b : a; a = lo; b = hi; }
            else {
                const unsigned pa = shxu(a, j, lane), pb = shxu(b, j, lane);
                const bool lower = (lane & j) == 0;
                const bool asc_a = (lane & k) == 0, asc_b = ((lane + 64) & k) == 0;
                const bool take_min_a = (lower == asc_a), take_min_b = (lower == asc_b);
                a = take_min_a ? (a < pa ? a : pa) : (a < pa ? pa : a);
                b = take_min_b ? (b < pb ? b : pb) : (b < pb ? pb : b);
            }
        }
    }
}
#ifndef PEER_U_FP4
#define PEER_U_FP4 1
#endif
#if PEER_U_FP4
typedef v4u urow_t;
#define PGU_LOAD PG4_LOAD
#define PGU_DOT PG4_DOT
constexpr float PU_SCALE = PU_SCALE4; constexpr int PU_STRIDE = 1024;
#else
typedef v6u urow_t;
#define PGU_LOAD PG6_LOAD
#define PGU_DOT PG6_DOT
constexpr float PU_SCALE = PU_SCALE6; constexpr int PU_STRIDE = 1536;
#endif
constexpr float PU_SCALEI = 135.0f, PX_SCALEI = 20.0f;
__device__ __forceinline__ void peer_v_pass(bf16* XN, const unsigned char* PV6, const int* PIDX, const float* PGATE, const int* PARTI, float* X, u64_t* rowsq_out, unsigned char* XN8, float* xsc, LAS float* wl, int gw, int NGW, int lane) {
    const unsigned voff4 = 16u * (unsigned)lane, l4 = 4u * (unsigned)lane, l8 = 8u * (unsigned)lane, l16 = 16u * (unsigned)lane;
    constexpr int NG = 128 / PG6_R;
    const __amdgpu_buffer_rsrc_t PVr = __builtin_amdgcn_make_buffer_rsrc((void*)PV6, 0, PEER_N * 1024, 0x00020000);
    for (int t_ = gw; t_ < T; t_ += NGW) {
        int t = t_; asm volatile("" : "+s"(t));
        const char* pidx_t = (const char*)(PIDX + (size_t)t * 128); const char* pgate_t = (const char*)(PGATE + (size_t)t * 128);
        const int idlo = *(const GAS int*)(pidx_t + l4), idhi = *(const GAS int*)(pidx_t + l4 + 256);
        v4u AV[PG6_R], BV[PG6_R];
        PG4_LOAD(AV, PVr, idlo, idhi, 0);
        {
            int s0 = 0, s1 = 0;
#pragma unroll
            for (int sp = 0; sp < 8; ++sp) { const char* pp = (const char*)(PARTI + ((size_t)sp * T + t) * 128); s0 += *(const GAS int*)(pp + l4); s1 += *(const GAS int*)(pp + l4 + 256); }
            const float d0 = (float)s0 * (1.f / (PX_SCALEI * PU_SCALEI)), d1 = (float)s1 * (1.f / (PX_SCALEI * PU_SCALEI));
            const float g0 = *(const GAS float*)(pgate_t + l4), g1 = *(const GAS float*)(pgate_t + l4 + 256);
            const float w0 = g0 * 0.5f * d0 * (1.f + erff(d0 * 0.70710678118654752f)) * (1.f / PV_SCALE4), w1 = g1 * 0.5f * d1 * (1.f + erff(d1 * 0.70710678118654752f)) * (1.f / PV_SCALE4);
            wl[lane] = w0; wl[64 + lane] = w1;
            LDS_WAIT(); asm volatile("" ::: "memory");
        }
        f32x2 y[16];
#pragma unroll
        for (int i = 0; i < 16; ++i) y[i] = (f32x2){0.f, 0.f};
#pragma unroll 1
        for (int g = 0; g < NG; g += 2) {
            PG4_LOAD(BV, PVr, idlo, idhi, g + 1);
            PG4_AXPY(AV, g);
            if (g + 2 < NG) PG4_LOAD(AV, PVr, idlo, idhi, g + 2);
            PG4_AXPY(BV, g + 1);
        }
        {   char* xo = (char*)(X + (size_t)t * DM);
            char* xbo = (char*)(XN + (size_t)t * DM); float ss = 0.f;
#pragma unroll
            for (int j = 0; j < 8; ++j) { const v2u a = *(const GAS v2u*)(xbo + l8 + 512 * j); f32x4 v = (f32x4){bflo(a.x), bfhi(a.x), bflo(a.y), bfhi(a.y)}; v += (f32x4){y[2 * j].x, y[2 * j].y, y[2 * j + 1].x, y[2 * j + 1].y};
                if (X) *(GAS f32x4*)(xo + l16 + 1024 * j) = v;
                y[2 * j] = (f32x2){v[0], v[1]}; y[2 * j + 1] = (f32x2){v[2], v[3]};
                ss += (v[0] * v[0] + v[1] * v[1]) + (v[2] * v[2] + v[3] * v[3]); *(GAS v2u*)(xbo + l8 + 512 * j) = (v2u){pk2(v[0], v[1]), pk2(v[2], v[3])}; }
            if (rowsq_out) { ss = wave_sum(ss, lane); if (lane == 0) rowsq_out[t] = rowsq_fx(ss); }
            if (XN8) {
                float am = 0.f;
#pragma unroll
                for (int j = 0; j < 16; ++j) am = fmaxf(am, fmaxf(fabsf(y[j].x), fabsf(y[j].y)));
                am = fmaxf(wave_max(am, lane), 1e-30f);
                const float inv = 127.f / am; char* qo = (char*)(XN8 + (size_t)t * DM);
#pragma unroll
                for (int j = 0; j < 8; ++j) *(GAS unsigned*)(qo + l4 + 256 * j) = q8x4((f32x4){y[2 * j].x, y[2 * j].y, y[2 * j + 1].x, y[2 * j + 1].y}, inv);
                if (lane == 0) xsc[t] = am * (1.f / 127.f); } }
        LDS_WAIT(); asm volatile("" ::: "memory");
    }
}


__device__ __forceinline__ unsigned enc_i4(float v) { int q = (int)__builtin_rintf(v); q = q < -7 ? -7 : (q > 7 ? 7 : q); return (unsigned)q & 15u; }
__device__ __forceinline__ void convert_int4_plain(const float* src, unsigned char* dst, int nrows, float scale, const float* gain, int gw, int NGW, int lane) {
    for (int r0 = 2 * gw; r0 < nrows; r0 += 2 * NGW) {
        f32x4 a[2][8];
#pragma unroll
        for (int q = 0; q < 2; ++q) { const float* sp = src + (size_t)(r0 + q) * DM + 4 * lane;
#pragma unroll
            for (int j = 0; j < 8; ++j) a[q][j] = *(const GAS f32x4*)(sp + 256 * j); }
#pragma unroll
        for (int q = 0; q < 2; ++q) { const int r = r0 + q; const float* gp = gain ? gain + (size_t)(r / PEER_N) * DM + 4 * lane : nullptr;
#pragma unroll
            for (int j = 0; j < 8; ++j) { f32x4 v = a[q][j] * scale; if (gp) v = v * *(const GAS f32x4*)(gp + 256 * j);
                const unsigned w = enc_i4(v[0]) | (enc_i4(v[1]) << 4) | (enc_i4(v[2]) << 8) | (enc_i4(v[3]) << 12);
                *(GAS unsigned short*)(dst + (size_t)r * 1024 + 128 * j + 2 * lane) = (unsigned short)w; } }
    }
}
__device__ __forceinline__ void peer_xquant_unit(const bf16* XN, const u64_t* rowsq, unsigned* XQH, unsigned* XQL, int tb, int sl, int tid) {
    for (int it = tid; it < 256 * 32; it += NTHREADS) {
        const int t = tb * 256 + (it >> 5), c8 = it & 31;
        const float xs = PX_SCALEI * rowsq_rs(rowsq, t);
        const v4u w = *(const GAS v4u*)(XN + (size_t)t * DM + 256 * sl + 8 * c8);
        const float f[8] = {bflo(w.x), bfhi(w.x), bflo(w.y), bfhi(w.y), bflo(w.z), bfhi(w.z), bflo(w.w), bfhi(w.w)};
        unsigned hi = 0u, lo = 0u;
#pragma unroll
        for (int j = 0; j < 8; ++j) { int q = (int)__builtin_rintf(f[j] * xs); q = q < -119 ? -119 : (q > 119 ? 119 : q);
            const int xl = ((q + 8) & 15) - 8, xh = (q - xl) >> 4;
            hi |= ((unsigned)xh & 15u) << (4 * j); lo |= ((unsigned)xl & 15u) << (4 * j); }
        XQH[(size_t)t * 256 + 32 * sl + c8] = hi; XQL[(size_t)t * 256 + 32 * sl + c8] = lo;
    }
}
#define PI_LOADROWS(buf, tab, ids, i0) do { _Pragma("unroll") for (int i_ = 0; i_ < 8; ++i_) buf[i_] = __builtin_amdgcn_raw_buffer_load_b128(tab, ids[(i0) + i_] * 1024 + (int)soff, 0, 0); } while (0)
#define PI_LOADIDS(ids, t) do { const char* ip_ = (const char*)PIDX + ((size_t)(t) * 128 + 16 * g) * 4; _Pragma("unroll") for (int c_ = 0; c_ < 4; ++c_) { const v4u q_ = *(const GAS v4u*)(ip_ + 16 * c_); \
        ids[4 * c_] = (int)q_.x; ids[4 * c_ + 1] = (int)q_.y; ids[4 * c_ + 2] = (int)q_.z; ids[4 * c_ + 3] = (int)q_.w; } } while (0)
#define PI_UGROUP(buf, i0) do { _Pragma("unroll") for (int i_ = 0; i_ < 8; ++i_) { int ah_ = 0, al_ = 0; \
        _Pragma("unroll") for (int c_ = 0; c_ < 4; ++c_) { ah_ = __builtin_amdgcn_sdot8((int)buf[i_][c_], (int)xh[c_], ah_, false); al_ = __builtin_amdgcn_sdot8((int)buf[i_][c_], (int)xl[c_], al_, false); } \
        int p_ = 16 * ah_ + al_; p_ += __builtin_amdgcn_ds_bpermute((lane ^ 1) << 2, p_); p_ += __builtin_amdgcn_ds_bpermute((lane ^ 2) << 2, p_); p_ += __builtin_amdgcn_ds_bpermute((lane ^ 4) << 2, p_); \
        if (m == (((i0) + i_) >> 1)) { if (((i0) + i_) & 1) keep1 = p_; else keep0 = p_; } } } while (0)
#define PI_LOADROWS16(buf, tab, ids) do { _Pragma("unroll") for (int i_ = 0; i_ < 16; ++i_) buf[i_] = __builtin_amdgcn_raw_buffer_load_b128(tab, ids[i_] * 1024 + (int)soff, 0, 0); } while (0)
#define PI_LOADX(xh_, xl_, t) do { xh_ = *(const GAS v4u*)((const char*)XQH + (size_t)(t) * 1024 + soff); xl_ = *(const GAS v4u*)((const char*)XQL + (size_t)(t) * 1024 + soff); } while (0)
#define PI_COMPUTE16(buf, xh_, xl_, t) do { int keep0 = 0, keep1 = 0; \
        _Pragma("unroll") for (int i_ = 0; i_ < 16; ++i_) { int ah_ = 0, al_ = 0; \
            _Pragma("unroll") for (int c_ = 0; c_ < 4; ++c_) { ah_ = __builtin_amdgcn_sdot8((int)buf[i_][c_], (int)xh_[c_], ah_, false); al_ = __builtin_amdgcn_sdot8((int)buf[i_][c_], (int)xl_[c_], al_, false); } \
            int p_ = 16 * ah_ + al_; p_ += __builtin_amdgcn_update_dpp(0, p_, 0xB1, 0xf, 0xf, true); p_ += __builtin_amdgcn_update_dpp(0, p_, 0x4E, 0xf, 0xf, true); p_ += __builtin_amdgcn_update_dpp(0, p_, 0x141, 0xf, 0xf, true);   \
            if (m == (i_ >> 1)) { if (i_ & 1) keep1 = p_; else keep0 = p_; } } \
        if ((t) < T) *(GAS v2u*)(PARTI + ((size_t)s * T + (t)) * 128 + 2 * lane) = (v2u){(unsigned)keep0, (unsigned)keep1}; } while (0)
__device__ __forceinline__ void peer_u_phase_i4(const unsigned* XQH, const unsigned* XQL, const unsigned char* PU, const int* PIDX, int* PARTI, int bid, int G, int wave, int lane) {
    const int s = bid & 7, nr = (G - s + 7) >> 3, q = (bid >> 3) * NWAVES + wave, stride = nr * NWAVES, g = lane >> 3, m = lane & 7;
    const unsigned soff = 128u * (unsigned)s + 16u * (unsigned)m;
    if (q >= T) return;
    const __amdgpu_buffer_rsrc_t PUr = __builtin_amdgcn_make_buffer_rsrc((void*)PU, 0, PEER_N * 1024, 0x00020000);
#define PI_CL(t) ((t) < T ? (t) : T - 1)
    int I1[16], I2[16]; v4u xh0, xl0, xh1, xl1, xh2, xl2, RA[16], RB[16];
    PI_LOADIDS(I1, q); PI_LOADX(xh0, xl0, q);
    PI_LOADROWS16(RA, PUr, I1);
    PI_LOADIDS(I1, PI_CL(q + stride)); PI_LOADX(xh1, xl1, PI_CL(q + stride));
    for (int t = q; t < T; t += 2 * stride) {
        PI_LOADROWS16(RB, PUr, I1);
        PI_LOADIDS(I2, PI_CL(t + 2 * stride)); PI_LOADX(xh2, xl2, PI_CL(t + 2 * stride));
        PI_COMPUTE16(RA, xh0, xl0, t);
        PI_LOADROWS16(RA, PUr, I2);
        PI_LOADIDS(I1, PI_CL(t + 3 * stride)); PI_LOADX(xh0, xl0, PI_CL(t + 3 * stride));
        PI_COMPUTE16(RB, xh1, xl1, t + stride);
        xh1 = xh0; xl1 = xl0; xh0 = xh2; xl0 = xl2;
    }
#undef PI_CL
}


constexpr float PV_SCALE4S = 5.65f;
__device__ __forceinline__ unsigned enc_e2m1s(float v) {
    const float a = fabsf(v);
    const unsigned code = a < 0.25f ? 0u : a < 0.75f ? 1u : a < 1.25f ? 2u : a < 1.75f ? 3u : a < 2.5f ? 4u : a < 3.5f ? 5u : a < 5.0f ? 6u : 7u;
    return code | (v < 0.f ? 8u : 0u);
}
__device__ __forceinline__ void convert_fp4_plain(const float* src, unsigned char* dst, int nrows, float scale, const float* gain, int gw, int NGW, int lane) {
    for (int r0 = 2 * gw; r0 < nrows; r0 += 2 * NGW) {
        f32x4 a[2][8];
#pragma unroll
        for (int q = 0; q < 2; ++q) { const float* sp = src + (size_t)(r0 + q) * DM + 4 * lane;
#pragma unroll
            for (int j = 0; j < 8; ++j) a[q][j] = *(const GAS f32x4*)(sp + 256 * j); }
#pragma unroll
        for (int q = 0; q < 2; ++q) { const int r = r0 + q; const float* gp = gain ? gain + (size_t)(r / PEER_N) * DM + 4 * lane : nullptr;
#pragma unroll
            for (int j = 0; j < 8; ++j) { f32x4 v = a[q][j] * scale; if (gp) v = v * *(const GAS f32x4*)(gp + 256 * j);
                const unsigned w = enc_e2m1s(v[0]) | (enc_e2m1s(v[1]) << 4) | (enc_e2m1s(v[2]) << 8) | (enc_e2m1s(v[3]) << 12);
                *(GAS unsigned short*)(dst + (size_t)r * 1024 + 128 * j + 2 * lane) = (unsigned short)w; } }
    }
}
#define PVS_LOADMETA(ids, pp, gg, t) do { PI_LOADIDS(ids, t); _Pragma("unroll") for (int sp_ = 0; sp_ < 8; ++sp_) pp[sp_] = *(const GAS v2u*)(PARTI + ((size_t)sp_ * T + (t)) * 128 + 2 * lane); \
        gg = *(const GAS f32x2*)(PGATE + (size_t)(t) * 128 + 2 * lane); } while (0)
#define PVS_COMPUTE16(buf, pp, gg, t) do { float w0, w1; { int s0_ = 0, s1_ = 0; _Pragma("unroll") for (int sp_ = 0; sp_ < 8; ++sp_) { s0_ += (int)pp[sp_].x; s1_ += (int)pp[sp_].y; } \
            const float d0_ = (float)s0_ * (1.f / (PX_SCALEI * PU_SCALEI)), d1_ = (float)s1_ * (1.f / (PX_SCALEI * PU_SCALEI)); \
            w0 = gg.x * 0.5f * d0_ * (1.f + erff(d0_ * 0.70710678118654752f)) * (1.f / PV_SCALE4S); w1 = gg.y * 0.5f * d1_ * (1.f + erff(d1_ * 0.70710678118654752f)) * (1.f / PV_SCALE4S); } \
        f32x2 y[16]; _Pragma("unroll") for (int i_ = 0; i_ < 16; ++i_) y[i_] = (f32x2){0.f, 0.f}; \
        _Pragma("unroll") for (int i_ = 0; i_ < 16; ++i_) { \
            const float w_ = __builtin_bit_cast(float, __builtin_amdgcn_ds_bpermute(((lane & 56) | (i_ >> 1)) << 2, __builtin_bit_cast(int, (i_ & 1) ? w1 : w0))); const f32x2 wv_ = {w_, w_}; \
            _Pragma("unroll") for (int c_ = 0; c_ < 4; ++c_) { const unsigned u_ = buf[i_][c_]; \
                y[4 * c_ + 0] += __builtin_amdgcn_cvt_scalef32_pk_f32_fp4(u_, 1.0f, 0) * wv_; y[4 * c_ + 1] += __builtin_amdgcn_cvt_scalef32_pk_f32_fp4(u_, 1.0f, 1) * wv_; \
                y[4 * c_ + 2] += __builtin_amdgcn_cvt_scalef32_pk_f32_fp4(u_, 1.0f, 2) * wv_; y[4 * c_ + 3] += __builtin_amdgcn_cvt_scalef32_pk_f32_fp4(u_, 1.0f, 3) * wv_; } } \
        {   LAS float* wp_ = yl + g * 288 + m * 36; \
            _Pragma("unroll") for (int c_ = 0; c_ < 8; ++c_) *(LAS f32x4*)(wp_ + 4 * c_) = (f32x4){y[2 * c_].x, y[2 * c_].y, y[2 * c_ + 1].x, y[2 * c_ + 1].y}; \
            LDS_WAIT(); asm volatile("" ::: "memory"); \
            f32x4 acc_ = {0.f, 0.f, 0.f, 0.f}; const LAS float* rp_ = yl + (lane >> 3) * 36 + 4 * (lane & 7); \
            _Pragma("unroll") for (int gg_ = 0; gg_ < 8; ++gg_) acc_ += *(const LAS f32x4*)(rp_ + gg_ * 288); \
            LDS_WAIT(); asm volatile("" ::: "memory"); \
            if ((t) < T) { bf16* xp_ = XN + (size_t)(t) * DM + 256 * s + 4 * lane; const v2u a_ = *(const GAS v2u*)xp_; \
                const f32x4 v_ = (f32x4){bflo(a_.x), bfhi(a_.x), bflo(a_.y), bfhi(a_.y)} + acc_; \
                *(GAS v2u*)xp_ = (v2u){pk2(v_[0], v_[1]), pk2(v_[2], v_[3])}; \
                if (Xout) *(GAS f32x4*)(Xout + (size_t)(t) * DM + 256 * s + 4 * lane) = v_; \
                if (rowsq_out) { const float ss_ = wave_sum((v_[0] * v_[0] + v_[1] * v_[1]) + (v_[2] * v_[2] + v_[3] * v_[3]), lane); if (lane == 0) atomicAdd(rowsq_out + (t), rowsq_fx(ss_)); } } } } while (0)
__device__ __forceinline__ void peer_v_phase_s(bf16* XN, const unsigned char* PV, const int* PIDX, const float* PGATE, const int* PARTI, float* Xout, u64_t* rowsq_out, LAS float* yl, int bid, int G, int wave, int lane) {
    const int s = bid & 7, nr = (G - s + 7) >> 3, q = (bid >> 3) * NWAVES + wave, stride = nr * NWAVES, g = lane >> 3, m = lane & 7;
    const unsigned soff = 128u * (unsigned)s + 16u * (unsigned)m;
    if (q >= T) return;
    const __amdgpu_buffer_rsrc_t PVr = __builtin_amdgcn_make_buffer_rsrc((void*)PV, 0, PEER_N * 1024, 0x00020000);
#define PVS_CL(t) ((t) < T ? (t) : T - 1)
    int I0[16], I1[16]; v2u P0[8], P1[8]; f32x2 G0, G1; v4u RA[16], RB[16];
#define PVS_LOADPG(pp, gg, t) do { _Pragma("unroll") for (int sp_ = 0; sp_ < 8; ++sp_) pp[sp_] = *(const GAS v2u*)(PARTI + ((size_t)sp_ * T + (t)) * 128 + 2 * lane); gg = *(const GAS f32x2*)(PGATE + (size_t)(t) * 128 + 2 * lane); } while (0)
    PI_LOADIDS(I0, q); PVS_LOADPG(P0, G0, q);
    PI_LOADROWS16(RA, PVr, I0);
    PI_LOADIDS(I1, PVS_CL(q + stride)); PVS_LOADPG(P1, G1, PVS_CL(q + stride));
    for (int t = q; t < T; t += 2 * stride) {
        PI_LOADROWS16(RB, PVr, I1);
        PI_LOADIDS(I0, PVS_CL(t + 2 * stride));
        PVS_COMPUTE16(RA, P0, G0, t);
        PVS_LOADPG(P0, G0, PVS_CL(t + 2 * stride));
        PI_LOADROWS16(RA, PVr, I0);
        PI_LOADIDS(I1, PVS_CL(t + 3 * stride));
        PVS_COMPUTE16(RB, P1, G1, t + stride);
        PVS_LOADPG(P1, G1, PVS_CL(t + 3 * stride));
    }
#undef PVS_LOADPG
#undef PVS_CL
}

typedef short s16x4 __attribute__((ext_vector_type(4)));
typedef __attribute__((address_space(3))) const char* lds_cptr;
__device__ __forceinline__ s16x4 vtr(lds_cptr p) { return __builtin_bit_cast(s16x4, __builtin_amdgcn_ds_read_tr16_b64_v4i16((__attribute__((address_space(3))) s16x4*)p)); }
__device__ __forceinline__ unsigned cvtpk(float lo, float hi) { unsigned r; asm("v_cvt_pk_bf16_f32 %0, %1, %2" : "=v"(r) : "v"(lo), "v"(hi)); return r; }
constexpr int AT_K0 = 0, AT_V0 = 16384, AT_TAB = 32768;
constexpr float LOG2E = 1.4426950408889634f;
template <int TYPE>
__device__ __forceinline__ void attn_unit(LAS unsigned char* lds, const bf16* QKV, bf16* ATT, u64_t* mixsq, int b, int head, int qb, const float* tabsrc, float Cl2, float sinkl2, int tid) {
    const int lane = tid & 63, w = __builtin_amdgcn_readfirstlane(tid >> 6), hh = lane >> 5, l31 = lane & 31;
    int qcol, kcol, vcol, ocol;
    if (TYPE == 0) { qcol = QA + head * 64; kcol = KA + (head / 3) * 64; vcol = VA + (head / 3) * 64; ocol = OA + head * 64; }
    else if (TYPE == 1) { qcol = QB + head * 64; kcol = KB + head * 64; vcol = VB + head * 64; ocol = OB + head * 64; }
    else { qcol = QC + head * 64; kcol = KC + (head / 3) * 64; vcol = VC + (head / 3) * 64; ocol = OC + head * 64; }
    const int q0 = 256 * qb + 32 * w, qpos = q0 + l31;
    int t_begin, t_end;
    if (TYPE == 0) { t_begin = 4 * qb - 2; if (t_begin < 0) t_begin = 0; t_end = 4 * qb + 6; if (t_end > 32) t_end = 32; }
    else if (TYPE == 1) { int a = 4 * qb - 4; a = a < 0 ? 0 : (a > 24 ? 24 : a); int e = 4 * qb - 1; e = e < 0 ? 0 : (e > 24 ? 24 : e); t_begin = a; t_end = e + 8; }
    else { t_begin = 0; t_end = 32; }
    LAS float* tab = (LAS float*)(lds + AT_TAB);
    if (TYPE == 0) { for (int i = tid; i < 1024; i += NTHREADS) { const int rel = i - 448; tab[i] = (rel >= -128 && rel <= 128) ? tabsrc[head * 257 + rel + 128] * LOG2E - Cl2 : -1e30f; } }
    if (TYPE == 1) { for (int i = tid; i < 15 * 31; i += NTHREADS) tab[i] = tabsrc[head * 465 + i] * LOG2E - Cl2; }
    bf16x8 qf[4];
    {   const bf16* qp = QKV + ((size_t)b * SEQ + qpos) * DIN + qcol + 8 * hh;
#pragma unroll
        for (int s = 0; s < 4; ++s) qf[s] = *(const GAS bf16x8*)(qp + 16 * s); }
    const int srow = tid >> 3, sch = tid & 7;
    const bf16* kg = QKV + ((size_t)b * SEQ + srow) * DIN + kcol + sch * 8;
    const bf16* vg = QKV + ((size_t)b * SEQ + srow) * DIN + vcol + sch * 8;
    const int kst = srow * 128 + ((sch ^ ((srow >> 1) & 7)) * 16);
    const int vst = srow * 128 + (((sch >> 2) ^ ((srow >> 1) & 1)) * 64) + (sch & 3) * 16;
    int kread[4], vread[2];
#pragma unroll
    for (int s = 0; s < 4; ++s) kread[s] = l31 * 128 + (((2 * s + hh) ^ ((lane >> 1) & 7)) * 16);
#pragma unroll
    for (int db = 0; db < 2; ++db) vread[db] = (4 * hh + ((lane >> 2) & 3)) * 128 + ((db ^ ((lane >> 3) & 1)) * 64) + 32 * ((lane >> 4) & 1) + 8 * (lane & 3);
    f32x16 O0, O1;
#pragma unroll
    for (int r = 0; r < 16; ++r) { O0[r] = 0.f; O1[r] = 0.f; }
    float lsum = 0.f;
    const int rw = 4 * qb + (w >> 1), cq = 32 * (w & 1) + l31;
    int r0w = rw - 4; r0w = r0w < 0 ? 0 : (r0w > 24 ? 24 : r0w);
    int c0 = cq - 8; c0 = c0 < 0 ? 0 : (c0 > 48 ? 48 : c0);
    {   const v4u kr = *(const GAS v4u*)(kg + (size_t)t_begin * 64 * DIN), vr = *(const GAS v4u*)(vg + (size_t)t_begin * 64 * DIN);
        *(LAS v4u*)(lds + AT_K0 + kst) = kr; *(LAS v4u*)(lds + AT_V0 + vst) = vr; }
    __syncthreads();
    for (int t = t_begin; t < t_end; ++t) {
        const int cur = (t - t_begin) & 1;
        v4u kr, vr;
        if (t + 1 < t_end) { kr = *(const GAS v4u*)(kg + (size_t)(t + 1) * 64 * DIN); vr = *(const GAS v4u*)(vg + (size_t)(t + 1) * 64 * DIN); }
        bool need = true;
        if (TYPE == 0) need = (64 * t <= q0 + 31 + 128) && (64 * t + 63 >= q0 - 128);
        if (TYPE == 1) need = (t >= r0w) && (t < r0w + 8);
        if (need) {
            const lds_cptr kb_ = (lds_cptr)(lds + AT_K0 + cur * 8192), vb_ = (lds_cptr)(lds + AT_V0 + cur * 8192);
            bf16x8 kf[8];
#pragma unroll
            for (int s = 0; s < 4; ++s) { kf[2 * s] = *(const LAS bf16x8*)(kb_ + kread[s]); kf[2 * s + 1] = *(const LAS bf16x8*)(kb_ + kread[s] + 4096); }
            f32x16 S0, S1;
            if (TYPE == 2) {
#pragma unroll
                for (int r = 0; r < 16; ++r) { S0[r] = -Cl2; S1[r] = -Cl2; }
            } else if (TYPE == 0) {
                const LAS float* tb = tab + (64 * t - qpos + 448 + 4 * hh);
#pragma unroll
                for (int r = 0; r < 16; ++r) { S0[r] = tb[8 * (r >> 2) + (r & 3)]; S1[r] = tb[32 + 8 * (r >> 2) + (r & 3)]; }
            } else {
                const LAS float* tb = tab + ((t - rw + 7) * 31 - cq + 15 + 4 * hh);
                const int kc0 = 4 * hh - c0;
#pragma unroll
                for (int r = 0; r < 16; ++r) { const int ka = 8 * (r >> 2) + (r & 3), kb2 = 32 + ka;
                    S0[r] = ((unsigned)(ka + kc0) < 16u) ? tb[ka] : -1e30f; S1[r] = ((unsigned)(kb2 + kc0) < 16u) ? tb[kb2] : -1e30f; }
            }
            __builtin_amdgcn_sched_barrier(0);
#pragma unroll
            for (int s = 0; s < 4; ++s) { S0 = __builtin_amdgcn_mfma_f32_32x32x16_bf16(kf[2 * s], qf[s], S0, 0, 0, 0); S1 = __builtin_amdgcn_mfma_f32_32x32x16_bf16(kf[2 * s + 1], qf[s], S1, 0, 0, 0); }
            s16x4 vf[4][2][2];
#pragma unroll
            for (int ks = 0; ks < 2; ++ks)
#pragma unroll
                for (int db = 0; db < 2; ++db) { vf[ks][db][0] = vtr(vb_ + vread[db] + (16 * ks) * 128); vf[ks][db][1] = vtr(vb_ + vread[db] + (16 * ks + 8) * 128); }
            __builtin_amdgcn_sched_barrier(0);
#pragma unroll
            for (int r = 0; r < 16; ++r) { S0[r] = __builtin_amdgcn_exp2f(S0[r]); S1[r] = __builtin_amdgcn_exp2f(S1[r]); }
#pragma unroll
            for (int r = 0; r < 16; ++r) lsum += S0[r] + S1[r];
            bf16x8 pb[4];
#pragma unroll
            for (int hf = 0; hf < 2; ++hf) {
                v4u a, c;
#pragma unroll
                for (int j = 0; j < 4; ++j) { a[j] = cvtpk(S0[8 * hf + 2 * j], S0[8 * hf + 2 * j + 1]); c[j] = cvtpk(S1[8 * hf + 2 * j], S1[8 * hf + 2 * j + 1]); }
                pb[hf] = __builtin_bit_cast(bf16x8, a); pb[2 + hf] = __builtin_bit_cast(bf16x8, c);
            }
#pragma unroll
            for (int ks = 2; ks < 4; ++ks)
#pragma unroll
                for (int db = 0; db < 2; ++db) { vf[ks][db][0] = vtr(vb_ + vread[db] + (16 * ks) * 128); vf[ks][db][1] = vtr(vb_ + vread[db] + (16 * ks + 8) * 128); }
            __builtin_amdgcn_sched_barrier(0);
#pragma unroll
            for (int ks = 0; ks < 4; ++ks) {
                const bf16x8 va = __builtin_shufflevector(vf[ks][0][0], vf[ks][0][1], 0, 1, 2, 3, 4, 5, 6, 7), vb2 = __builtin_shufflevector(vf[ks][1][0], vf[ks][1][1], 0, 1, 2, 3, 4, 5, 6, 7);
                O0 = __builtin_amdgcn_mfma_f32_32x32x16_bf16(va, pb[ks], O0, 0, 0, 0); O1 = __builtin_amdgcn_mfma_f32_32x32x16_bf16(vb2, pb[ks], O1, 0, 0, 0);
            }
        }
        __builtin_amdgcn_sched_barrier(0);
        if (t + 1 < t_end) { *(LAS v4u*)(lds + AT_K0 + (cur ^ 1) * 8192 + kst) = kr; *(LAS v4u*)(lds + AT_V0 + (cur ^ 1) * 8192 + vst) = vr; }
        __syncthreads();
    }
    lsum += shx(lsum, 32, lane);
    if (TYPE == 0) lsum += __builtin_amdgcn_exp2f(sinkl2 - Cl2);
    const float inv = 1.f / lsum;
    {   float ss = 0.f;
#pragma unroll
        for (int r = 0; r < 16; ++r) { const float a = O0[r] * inv, c = O1[r] * inv; ss += a * a + c * c; }
        ss += shx(ss, 32, lane);
        if (hh == 0) (void)__hip_atomic_fetch_add((GAS u64_t*)(mixsq + (size_t)b * SEQ + qpos), rowsq_fx(ss), __ATOMIC_RELAXED, __HIP_MEMORY_SCOPE_AGENT); }
    bf16* op = ATT + ((size_t)b * SEQ + qpos) * DM + ocol + 4 * hh;
#pragma unroll
    for (int g4 = 0; g4 < 4; ++g4) {
        v2u o0, o1; o0.x = cvtpk(O0[4 * g4] * inv, O0[4 * g4 + 1] * inv); o0.y = cvtpk(O0[4 * g4 + 2] * inv, O0[4 * g4 + 3] * inv);
        o1.x = cvtpk(O1[4 * g4] * inv, O1[4 * g4 + 1] * inv); o1.y = cvtpk(O1[4 * g4 + 2] * inv, O1[4 * g4 + 3] * inv);
        *(GAS v2u*)(op + 8 * g4) = o0; *(GAS v2u*)(op + 32 + 8 * g4) = o1;
    }
}


constexpr int MA_K0 = 0, MA_V0 = 32768;
__device__ __forceinline__ void mem_unit(LAS unsigned char* lds, const bf16* QM, const bf16* KVM, bf16* OM, const float* gq, int tb, int head, float Cl2, int tid) {
    const int lane = tid & 63, w = __builtin_amdgcn_readfirstlane(tid >> 6), hh = lane >> 5, l31 = lane & 31;
    const size_t trow = (size_t)tb * 256 + 32 * w + l31; const int b = tb >> 3;
    bf16x8 qf[8];
    {   const bf16* qp = QM + trow * MEMW + head * 128 + 8 * hh;
#pragma unroll
        for (int s = 0; s < 8; ++s) qf[s] = *(const GAS bf16x8*)(qp + 16 * s);
        float ss = 0.f;
#pragma unroll
        for (int s = 0; s < 8; ++s)
#pragma unroll
            for (int j = 0; j < 8; ++j) { const float f = __builtin_bit_cast(float, (unsigned)(unsigned short)qf[s][j] << 16); ss += f * f; }
        ss += shx(ss, 32, lane);
        const float r = 0.12751743074602468f / sqrtf(ss * (1.f / 128.f) + EPS);
#pragma unroll
        for (int s = 0; s < 8; ++s) { const f32x4 g0 = *(const GAS f32x4*)(gq + 16 * s + 8 * hh), g1 = *(const GAS f32x4*)(gq + 16 * s + 8 * hh + 4);
            v4u o;
#pragma unroll
            for (int j = 0; j < 4; ++j) { const float f0 = __builtin_bit_cast(float, (unsigned)(unsigned short)qf[s][2 * j] << 16), f1 = __builtin_bit_cast(float, (unsigned)(unsigned short)qf[s][2 * j + 1] << 16);
                const float ga = (2 * j < 4) ? g0[2 * j] : g1[2 * j - 4], gb2 = (2 * j + 1 < 4) ? g0[2 * j + 1] : g1[2 * j + 1 - 4];
                o[j] = cvtpk(f0 * r * ga, f1 * r * gb2); }
            qf[s] = __builtin_bit_cast(bf16x8, o); }
    }
    const int srow = tid >> 3, sch = tid & 7;
    const bf16* kg = KVM + ((size_t)b * NMEM + srow) * 1024 + head * 128 + sch * 8;
    const bf16* vg = kg + 512;
    const int kst0 = srow * 256 + ((sch ^ (srow & 15)) * 16), kst1 = srow * 256 + (((sch + 8) ^ (srow & 15)) * 16);
    const int vst0 = srow * 256 + ((((sch) >> 2) ^ (srow & 3)) * 64) + (sch & 3) * 16, vst1 = srow * 256 + ((((sch + 8) >> 2) ^ (srow & 3)) * 64) + (sch & 3) * 16;
    int kread[8], vread[4];
#pragma unroll
    for (int s = 0; s < 8; ++s) kread[s] = l31 * 256 + (((2 * s + hh) ^ (l31 & 15)) * 16);
#pragma unroll
    for (int db = 0; db < 4; ++db) vread[db] = (4 * hh + ((lane >> 2) & 3)) * 256 + ((db ^ ((lane >> 2) & 3)) * 64) + 32 * ((lane >> 4) & 1) + 8 * (lane & 3);
    f32x16 O[4];
#pragma unroll
    for (int db = 0; db < 4; ++db)
#pragma unroll
        for (int r = 0; r < 16; ++r) O[db][r] = 0.f;
    float lsum = 0.f;
    {   const v4u k0 = *(const GAS v4u*)kg, k1 = *(const GAS v4u*)(kg + 64), v0 = *(const GAS v4u*)vg, v1 = *(const GAS v4u*)(vg + 64);
        *(LAS v4u*)(lds + MA_K0 + kst0) = k0; *(LAS v4u*)(lds + MA_K0 + kst1) = k1; *(LAS v4u*)(lds + MA_V0 + vst0) = v0; *(LAS v4u*)(lds + MA_V0 + vst1) = v1; }
    __syncthreads();
#pragma unroll 1
    for (int t = 0; t < 4; ++t) {
        const int cur = t & 1;
        v4u k0, k1, v0, v1;
        if (t + 1 < 4) { const bf16* kn = kg + (size_t)(t + 1) * 64 * 1024; k0 = *(const GAS v4u*)kn; k1 = *(const GAS v4u*)(kn + 64); v0 = *(const GAS v4u*)(kn + 512); v1 = *(const GAS v4u*)(kn + 576); }
        const lds_cptr kb_ = (lds_cptr)(lds + MA_K0 + cur * 16384), vb_ = (lds_cptr)(lds + MA_V0 + cur * 16384);
        f32x16 S0, S1;
#pragma unroll
        for (int r = 0; r < 16; ++r) { S0[r] = -Cl2; S1[r] = -Cl2; }
#pragma unroll
        for (int s = 0; s < 8; ++s) { const bf16x8 a0 = *(const LAS bf16x8*)(kb_ + kread[s]), a1 = *(const LAS bf16x8*)(kb_ + kread[s] + 8192);
            S0 = __builtin_amdgcn_mfma_f32_32x32x16_bf16(a0, qf[s], S0, 0, 0, 0); S1 = __builtin_amdgcn_mfma_f32_32x32x16_bf16(a1, qf[s], S1, 0, 0, 0); }
#pragma unroll
        for (int r = 0; r < 16; ++r) { S0[r] = __builtin_amdgcn_exp2f(S0[r]); S1[r] = __builtin_amdgcn_exp2f(S1[r]); lsum += S0[r] + S1[r]; }
        bf16x8 pb[4];
#pragma unroll
        for (int hf = 0; hf < 2; ++hf) {
            v4u a, c;
#pragma unroll
            for (int j = 0; j < 4; ++j) { a[j] = cvtpk(S0[8 * hf + 2 * j], S0[8 * hf + 2 * j + 1]); c[j] = cvtpk(S1[8 * hf + 2 * j], S1[8 * hf + 2 * j + 1]); }
            pb[hf] = __builtin_bit_cast(bf16x8, a); pb[2 + hf] = __builtin_bit_cast(bf16x8, c);
        }
#pragma unroll
        for (int ks = 0; ks < 4; ++ks)
#pragma unroll
            for (int db = 0; db < 4; ++db) {
                const s16x4 a0 = vtr(vb_ + vread[db] + (16 * ks) * 256), a1 = vtr(vb_ + vread[db] + (16 * ks + 8) * 256);
                const bf16x8 va = __builtin_shufflevector(a0, a1, 0, 1, 2, 3, 4, 5, 6, 7);
                O[db] = __builtin_amdgcn_mfma_f32_32x32x16_bf16(va, pb[ks], O[db], 0, 0, 0);
            }
        if (t + 1 < 4) { LAS unsigned char* kn = lds + MA_K0 + (cur ^ 1) * 16384; LAS unsigned char* vn = lds + MA_V0 + (cur ^ 1) * 16384;
            *(LAS v4u*)(kn + kst0) = k0; *(LAS v4u*)(kn + kst1) = k1; *(LAS v4u*)(vn + vst0) = v0; *(LAS v4u*)(vn + vst1) = v1; }
        __syncthreads();
    }
    lsum += shx(lsum, 32, lane);
    const float inv = 1.f / lsum;
    bf16* op = OM + trow * MEMW + head * 128 + 4 * hh;
#pragma unroll
    for (int db = 0; db < 4; ++db)
#pragma unroll
        for (int g4 = 0; g4 < 4; ++g4) { v2u o; o.x = cvtpk(O[db][4 * g4] * inv, O[db][4 * g4 + 1] * inv); o.y = cvtpk(O[db][4 * g4 + 2] * inv, O[db][4 * g4 + 3] * inv); *(GAS v2u*)(op + 32 * db + 8 * g4) = o; }
}

struct Args { const float* in[23]; float* out; unsigned char* ws; int ph_lo, ph_hi, use_bar, pad; };
#ifndef MK_OFF
#define MK_OFF 0u
#endif
#ifndef REP_ATT
#define REP_ATT 1
#endif
#ifndef REP_P0
#define REP_P0 1
#endif
#ifndef REP_U
#define REP_U 1
#endif
#ifndef REP_GEMM
#define REP_GEMM 1
#endif
#ifndef REP_NORM
#define REP_NORM 1
#endif
#ifndef REP_SEL
#define REP_SEL 1
#endif
#ifndef REP_MEM
#define REP_MEM 1
#endif
#define PHON(k) (!((MK_OFF >> (k)) & 1u))
constexpr int PH_PER_LAYER = 9, PH_BASE = 2, N_PHASES = PH_BASE + DEPTH * PH_PER_LAYER;
constexpr int PTAB_OFF = LDSCTL_OFF + 1024;

__global__ void __launch_bounds__(NTHREADS, 2) mega(Args a) {
    extern __shared__ __attribute__((aligned(16))) unsigned char lds_raw[];
    LAS unsigned char* lds = (LAS unsigned char*)lds_raw;
    {   const int tid0 = threadIdx.x;
        for (int u = tid0; u < (LDS_BYTES - LDSCTL_OFF) / 4; u += NTHREADS) ((LAS unsigned*)(lds + LDSCTL_OFF))[u] = 0u;
        __syncthreads();
        if (tid0 < 23) ((LAS unsigned long long*)(lds + PTAB_OFF))[tid0] = (unsigned long long)a.in[tid0];
        if (tid0 == 23) ((LAS unsigned long long*)(lds + PTAB_OFF))[23] = (unsigned long long)a.out;
        if (tid0 == 24) ((LAS unsigned long long*)(lds + PTAB_OFF))[24] = (unsigned long long)a.ws;
        __syncthreads();
    }
    volatile LAS unsigned* MISC = (volatile LAS unsigned*)(lds + MISC_OFF);
    const int G = gridDim.x, bid = blockIdx.x, NGW = G * NWAVES;
    const int use_bar = a.use_bar;
    XcdBarrier bar; bar.bar = (unsigned*)(a.ws + WS_CTL) + CW_BAR; bar.x = 0; bar.st = MISC + 8;
    if (use_bar) bar = xcd_barrier_post((unsigned*)(a.ws + WS_CTL) + CW_BAR, MISC + 8);
    const int lo = a.ph_lo, hi = a.ph_hi;
#define IN(k) (lo <= (k) && (k) < hi)
#define SEAM(k) do { if (use_bar && IN(k) && IN((k) + 1)) xcd_barrier(bar); } while (0)
#define PHL() int tid_ = threadIdx.x; asm volatile("" : "+v"(tid_)); const int lane_ = tid_ & 63, wave_ = __builtin_amdgcn_readfirstlane(tid_ >> 6), gw_ = bid * NWAVES + wave_; (void)lane_; (void)gw_; \
              int pz_ = 0; asm volatile("" : "+s"(pz_))
#define PTR(i) ((const float*)ldptr(lds, (i) + pz_))
#define WSP() ((unsigned char*)ldptr(lds, 24 + pz_))
#define OUTP() ((float*)ldptr(lds, 23 + pz_))

    if (IN(0) && PHON(0)) {
        PHL(); unsigned char* ws = WSP();
        LAS float* scr = (LAS float*)(lds + RING_OFF + wave_ * 16384);
        constexpr int I_IN = 32 * 128, I_OUT = 32 * 64, I_MQ = 32 * 16, I_MKV = 32 * 32, I_MO = 8 * 64, I_PQ = 32 * 64, I_L = I_IN + I_OUT + I_MQ + I_MKV + I_MO + I_PQ;
        for (int it = gw_; it < DEPTH * I_L; it += NGW) {
            const int l = it / I_L; int r = it % I_L;
            if (r < I_IN) { transpose_item<true>(PTR(4) + (size_t)l * DM * DIN, DM, DIN, (bf16*)(ws + WS_WIN) + (size_t)l * DIN * DM, scr, r, lane_, PTR(3) + (size_t)l * DM); continue; } r -= I_IN;
            if (r < I_OUT) { transpose_item<false>(PTR(11) + (size_t)l * DM * DM, DM, DM, (bf16*)(ws + WS_WOUT) + (size_t)l * DM * DM, scr, r, lane_, PTR(10) + (size_t)l * DM); continue; } r -= I_OUT;
            if (r < I_MQ) { transpose_item<false>(PTR(14) + (size_t)l * DM * MEMW, DM, MEMW, (bf16*)(ws + WS_WMQ) + (size_t)l * MEMW * DM, scr, r, lane_, PTR(12) + (size_t)l * DM); continue; } r -= I_MQ;
            if (r < I_MKV) { transpose_item<false>(PTR(15) + (size_t)l * DM * 1024, DM, 1024, (bf16*)(ws + WS_WMKV) + (size_t)l * 1024 * DM, scr, r, lane_); continue; } r -= I_MKV;
            if (r < I_MO) { transpose_item<false>(PTR(17) + (size_t)l * MEMW * DM, MEMW, DM, (bf16*)(ws + WS_WMO) + (size_t)l * DM * MEMW, scr, r, lane_); continue; } r -= I_MO;
            transpose_item<false>(PTR(19) + (size_t)l * DM * DM, DM, DM, (bf16*)(ws + WS_WPQ) + (size_t)l * DM * DM, scr, r, lane_, PTR(18) + (size_t)l * DM);
        }
        const size_t gtid = (size_t)bid * NTHREADS + tid_, nth = (size_t)G * NTHREADS;
        convert_bf16(PTR(20), (bf16*)(ws + WS_PKEYS), (size_t)DEPTH * 8 * 2 * 128 * 128, gtid, nth);
        convert_int4_plain(PTR(21), ws + WS_PU, DEPTH * PEER_N, PU_SCALEI, PTR(18), gw_, NGW, lane_);
        convert_fp4_rows(PTR(22), ws + WS_PV, PEER_N, PV_SCALE4, nullptr, gw_, NGW, lane_);
        {   const float* x0 = PTR(0); bf16* XN = (bf16*)(ws + WS_XN); u64_t* rsq = (u64_t*)(ws + WS_ROWSQ);
            for (int m = 2 * gw_; m < T; m += 2 * NGW) prep_rows2(x0 + (size_t)m * DM, XN + (size_t)m * DM, rsq + m, ws + WS_XN8 + (size_t)m * DM, (float*)(ws + WS_XSC) + m, lane_); }
        {   const float* mem = PTR(1); const float* gkv = PTR(13); bf16* MEMN = (bf16*)(ws + WS_MEMN);
            for (int m = gw_; m < BATCH * NMEM; m += NGW)
                rms_row_to_bf16(mem + (size_t)m * DM, gkv, MEMN + (size_t)m * DM, gkv + DM, MEMN + (size_t)(BATCH * NMEM + m) * DM, lane_); }
        float* rope = (float*)(ws + WS_ROPE); float* biasA = (float*)(ws + WS_BIASA);
        if (gtid < 64 * 16) { const int pos = (int)gtid >> 4, i = (int)gtid & 15; const float ang = (float)pos * ROPE_INV[i]; rope[gtid * 2] = cosf(ang); rope[gtid * 2 + 1] = sinf(ang); }
        if (gtid < 12 * 257) { const int h = (int)gtid / 257, rel = (int)gtid % 257 - 128; biasA[gtid] = PTR(2)[t5_bucket(rel) * 12 + h]; }
    }
    SEAM(0);
    if (IN(1) && PHON(1)) {
        {   PHL(); unsigned char* ws = WSP();
            for (int r = gw_; r < DEPTH * DIN; r += NGW) { const int rr = r & (DIN - 1), src = (rr & ~255) + 64 * ((rr >> 5) & 3) + 32 * ((rr >> 7) & 1) + (rr & 31);
                quant_wrow((const bf16*)(ws + WS_WIN) + (size_t)r * DM, ws + WS_WIN8 + (size_t)r * DM, (float*)(ws + WS_WSC) + (r & ~(DIN - 1)) + src, lane_); }
            for (int r = gw_; r < DEPTH * DM; r += NGW) quant_wrow((const bf16*)(ws + WS_WOUT) + (size_t)r * DM, ws + WS_WOUT8 + (size_t)r * DM, (float*)(ws + WS_WSCO) + r, lane_); }
#pragma unroll 1
        for (int l = 0; l < DEPTH; ++l) {
            PHL(); unsigned char* ws = WSP();
            pg8::Gemm g{(bf16*)(ws + WS_MEMN) + (size_t)l * BATCH * NMEM * DM, (bf16*)(ws + WS_WMKV) + (size_t)l * 1024 * DM, BATCH * NMEM, 1024, DM};
            OffsetOrder S; S.init(BATCH * NMEM, 1024, G, bid, 64 * l);
            bf16* KVMl = (bf16*)(ws + WS_KVM) + (size_t)l * BATCH * NMEM * 1024;
            pg8::EpiBf16<0> E{KVMl, 1024, nullptr, 0, 0, 1.f};
            pg8::gemm_phase<pg8::EpiBf16<0>, OffsetOrder, true, true>(lds + RING_OFF, g, S, E, tid_);
            VM_WAIT(); __syncthreads();
            const float* gk = PTR(16) + (size_t)l * 256 + 128;
#pragma unroll 1
            for (int i = 0; i < 4; ++i) { pg8::Unit uu; uu.pm = 0; uu.pn = 0; if (!S.next(i, uu)) break;
                if (uu.pn < 2) {
                    for (int r2 = wave_; r2 < 128; r2 += NWAVES) { const int row = uu.pm * 256 + 2 * r2 + (lane_ >> 5), cl = lane_ & 31;
                        GAS v4u* p = (GAS v4u*)(KVMl + (size_t)row * 1024 + 256 * uu.pn + 8 * cl);
                        const v4u w = *p;
                        float f[8] = {bflo(w.x), bfhi(w.x), bflo(w.y), bfhi(w.y), bflo(w.z), bfhi(w.z), bflo(w.w), bfhi(w.w)};
                        float ss = 0.f;
#pragma unroll
                        for (int e = 0; e < 8; ++e) ss += f[e] * f[e];
                        ss += shx(ss, 1, lane_); ss += shx(ss, 2, lane_); ss += shx(ss, 4, lane_); ss += shx(ss, 8, lane_);
                        const float r = 1.f / sqrtf(ss * (1.f / 128.f) + EPS);
                        const float* gg = gk + 8 * (cl & 15);
                        v4u o; o.x = pk2(f[0] * r * gg[0], f[1] * r * gg[1]); o.y = pk2(f[2] * r * gg[2], f[3] * r * gg[3]); o.z = pk2(f[4] * r * gg[4], f[5] * r * gg[5]); o.w = pk2(f[6] * r * gg[6], f[7] * r * gg[7]);
                        *p = o; } } }
            __syncthreads();
        }
        if (G >= 256 && bid >= 128) { PHL(); unsigned char* ws = WSP();
            convert_fp4_rows(PTR(22) + (size_t)PEER_N * DM, ws + WS_PV + (size_t)PEER_N * 1024, PEER_N, PV_SCALE4, nullptr, (bid - 128) * NWAVES + wave_, (G - 128) * NWAVES, lane_); }
        else if (G < 256) { PHL(); unsigned char* ws = WSP(); convert_fp4_rows(PTR(22) + (size_t)PEER_N * DM, ws + WS_PV + (size_t)PEER_N * 1024, PEER_N, PV_SCALE4, nullptr, gw_, NGW, lane_); }
    }
    SEAM(1);

#pragma unroll 1
    for (int l = 0; l < DEPTH; ++l) {
        const int pb = PH_BASE + PH_PER_LAYER * l;
        if (IN(pb + 0) && PHON(3)) { PHL(); unsigned char* ws = WSP();
            pg8::Gemm g{(bf16*)(ws + WS_XN8), (bf16*)(ws + WS_WIN8 + (size_t)l * DIN * DM), T, DIN, DM / 2}; pg8::StaticOrder S; S.init(T, DIN, G, bid);
            pg8::EpiQKV E{(bf16*)(ws + WS_QKV), PTR(5) + (size_t)l * 128, PTR(7) + (size_t)l * 128, PTR(9) + (size_t)l * 128, (const float*)(ws + WS_ROPE), (const u64_t*)(ws + WS_ROWSQ) + (size_t)(l * 3 + 0) * T, (const float*)(ws + WS_XSC), (const float*)(ws + WS_WSC) + (size_t)l * DIN};
            pg8::gemm_phase<pg8::EpiQKV, pg8::StaticOrder, true, true>(lds + RING_OFF, g, S, E, tid_);
        }
        SEAM(pb + 0);
        if (IN(pb + 1) && PHON(4)) { PHL(); unsigned char* ws = WSP();
            const float* sink = PTR(6) + (size_t)l * 12; const float* rpb = PTR(8) + (size_t)l * 8 * 15 * 31; const float* biasA = (const float*)(ws + WS_BIASA);
            const bf16* QKV = (const bf16*)(ws + WS_QKV); bf16* ATT = (bf16*)(ws + WS_ATT);
            const float* ga = PTR(5) + (size_t)l * 128; const float* gb = PTR(7) + (size_t)l * 128; const float* gc = PTR(9) + (size_t)l * 128;
            const float CaL2 = 8.f * wave_max(fabsf(ga[lane_]), lane_) * wave_max(fabsf(ga[64 + lane_]), lane_) * LOG2E;
            const float CbL2 = 8.f * wave_max(fabsf(gb[lane_]), lane_) * wave_max(fabsf(gb[64 + lane_]), lane_) * LOG2E;
            const float CcL2 = 8.f * wave_max(fabsf(gc[lane_]), lane_) * wave_max(fabsf(gc[64 + lane_]), lane_) * LOG2E;
            const int vc = (G % 8 == 0) ? (bid % 8) * (G / 8) + bid / 8 : bid;
            u64_t* mixsq = (u64_t*)(ws + WS_MIXSQ) + (size_t)l * 3 * T;
            for (int u = vc; u < BATCH * 12 * 8; u += G) attn_unit<2>(lds, QKV, ATT, mixsq + 2 * (size_t)T, u / 96, (u >> 3) % 12, u & 7, nullptr, CcL2, 0.f, tid_);
            for (int u = vc; u < BATCH * 8 * 8; u += G) attn_unit<1>(lds, QKV, ATT, mixsq + (size_t)T, u >> 6, (u >> 3) & 7, u & 7, rpb, CbL2, 0.f, tid_);
            for (int u = vc; u < BATCH * 12 * 8; u += G) { const int head = (u >> 3) % 12; attn_unit<0>(lds, QKV, ATT, mixsq, u / 96, head, u & 7, biasA, CaL2, sink[head] * LOG2E, tid_); }
        }
        SEAM(pb + 1);
        if (IN(pb + 2) && PHON(5)) { PHL(); unsigned char* ws = WSP();
            const u64_t* mixsq = (const u64_t*)(ws + WS_MIXSQ) + (size_t)l * 3 * T;
            for (int r = 4 * gw_; r < T; r += 4 * NGW) att_quant_rows<4>((const bf16*)(ws + WS_ATT), mixsq, ws + WS_ATT8, (float*)(ws + WS_XSC2), r, lane_);
        }
        SEAM(pb + 2);
        if (IN(pb + 3) && PHON(5)) { PHL(); unsigned char* ws = WSP();
            pg8::Gemm g{(bf16*)(ws + WS_ATT8), (bf16*)(ws + WS_WOUT8 + (size_t)l * DM * DM), T, DM, DM / 2}; pg8::StaticOrder S; S.init(T, DM, G, bid);
            pg8::EpiResid8 E{(bf16*)(ws + WS_XN), DM, (u64_t*)(ws + WS_ROWSQ) + (size_t)(l * 3 + 1) * T, (const float*)(ws + WS_XSC2), (const float*)(ws + WS_WSCO) + (size_t)l * DM};
            pg8::gemm_phase<pg8::EpiResid8, pg8::StaticOrder, true, true>(lds + RING_OFF, g, S, E, tid_);
        }
        SEAM(pb + 3);
        if (IN(pb + 4) && PHON(6)) { PHL(); unsigned char* ws = WSP();
            pg8::Gemm g{(bf16*)(ws + WS_XN), (bf16*)(ws + WS_WMQ) + (size_t)l * MEMW * DM, T, MEMW, DM}; pg8::StaticOrder S; S.init(T, MEMW, G, bid);
            pg8::EpiBf16Row E{(bf16*)(ws + WS_QM), MEMW, (const u64_t*)(ws + WS_ROWSQ) + (size_t)(l * 3 + 1) * T};
            pg8::gemm_phase<pg8::EpiBf16Row, pg8::StaticOrder, true, true>(lds + RING_OFF, g, S, E, tid_);
            VM_WAIT(); __syncthreads();
            const bf16* kvm = (const bf16*)(ws + WS_KVM) + (size_t)l * BATCH * NMEM * 1024; const float* gq = PTR(16) + (size_t)l * 256;
            const float CmL2 = 11.313708498984761f * wave_max(fmaxf(fabsf(gq[lane_]), fabsf(gq[64 + lane_])), lane_) * wave_max(fmaxf(fabsf(gq[128 + lane_]), fabsf(gq[192 + lane_])), lane_) * LOG2E;
#pragma unroll 1
            for (int i = 0; i < 4; ++i) { pg8::Unit uu; uu.pm = 0; uu.pn = 0; if (!S.next(i, uu)) break;
                mem_unit(lds, (const bf16*)(ws + WS_QM), kvm, (bf16*)(ws + WS_OM), gq, uu.pm, 2 * uu.pn, CmL2, tid_);
                mem_unit(lds, (const bf16*)(ws + WS_QM), kvm, (bf16*)(ws + WS_OM), gq, uu.pm, 2 * uu.pn + 1, CmL2, tid_); }
        }
        SEAM(pb + 4);
        if (IN(pb + 5) && PHON(7)) { PHL(); unsigned char* ws = WSP();
            pg8::Gemm g{(bf16*)(ws + WS_OM), (bf16*)(ws + WS_WMO) + (size_t)l * DM * MEMW, T, DM, MEMW}; pg8::StaticOrder S; S.init(T, DM, G, bid);
            pg8::EpiResid E{(bf16*)(ws + WS_XN), DM, (u64_t*)(ws + WS_ROWSQ) + (size_t)(l * 3 + 2) * T};
            pg8::gemm_phase<pg8::EpiResid, pg8::StaticOrder, true, true>(lds + RING_OFF, g, S, E, tid_);
        }
        SEAM(pb + 5);
        if (IN(pb + 6) && PHON(8)) { PHL(); unsigned char* ws = WSP();
            pg8::Gemm g{(bf16*)(ws + WS_XN), (bf16*)(ws + WS_WPQ) + (size_t)l * DM * DM, T, DM, DM}; pg8::StaticOrder S; S.init(T, DM, G, bid);
            pg8::EpiBf16Row E{(bf16*)(ws + WS_QP), DM, (const u64_t*)(ws + WS_ROWSQ) + (size_t)(l * 3 + 2) * T};
            pg8::gemm_phase<pg8::EpiBf16Row, pg8::StaticOrder, true, true>(lds + RING_OFF, g, S, E, tid_);
            VM_WAIT(); __syncthreads();
            const bf16* pk = (const bf16*)(ws + WS_PKEYS) + (size_t)l * 8 * 2 * 128 * 128;
#pragma unroll 1
            for (int i = 0; i < 8; ++i) { pg8::Unit uu; uu.pm = 0; uu.pn = 0; if (!S.next(i, uu)) break;
                peer_select_unit((const bf16*)(ws + WS_QP), pk, (int*)(ws + WS_PIDX), (float*)(ws + WS_PGATE), uu.pm, uu.pn, wave_, lane_);
                peer_xquant_unit((const bf16*)(ws + WS_XN), (const u64_t*)(ws + WS_ROWSQ) + (size_t)(l * 3 + 2) * T, (unsigned*)(ws + WS_XQH), (unsigned*)(ws + WS_XQL), uu.pm, uu.pn, tid_); }
        }
        SEAM(pb + 6);
        if (IN(pb + 7) && PHON(9)) { PHL(); unsigned char* ws = WSP();
            peer_u_phase_i4((const unsigned*)(ws + WS_XQH), (const unsigned*)(ws + WS_XQL), ws + WS_PU + (size_t)l * PEER_N * 1024, (const int*)(ws + WS_PIDX), (int*)(ws + WS_PARTI), bid, G, wave_, lane_); }
        SEAM(pb + 7);
        if (IN(pb + 8) && PHON(10)) { PHL(); unsigned char* ws = WSP();
            peer_v_pass((bf16*)(ws + WS_XN), ws + WS_PV + (size_t)l * PEER_N * 1024, (const int*)(ws + WS_PIDX), (const float*)(ws + WS_PGATE), (const int*)(ws + WS_PARTI), (l + 1 == DEPTH) ? OUTP() : (float*)nullptr,
                        (l + 1 < DEPTH) ? (u64_t*)(ws + WS_ROWSQ) + (size_t)((l + 1) * 3 + 0) * T : (u64_t*)nullptr, (l + 1 < DEPTH) ? ws + WS_XN8 : (unsigned char*)nullptr, (float*)(ws + WS_XSC), (LAS float*)(lds + RING_OFF + wave_ * 1024), gw_, NGW, lane_); }
        SEAM(pb + 8);
    }
#undef IN
#undef SEAM
}

#ifndef MK_MULTI_LAUNCH
#define MK_MULTI_LAUNCH 0
#endif
extern "C" void kernel_launch(void* const* d_in, const int* in_sizes, int n_in, void* d_out, int out_size, void* d_ws, size_t ws_size, hipStream_t stream) {
    static int grid = 0;
    if (grid == 0) {
        if (n_in != 23 || out_size != T * DM || ws_size < WS_END) { fprintf(stderr, "kernel_launch: unexpected shapes (n_in %d, out %d, ws %zu)\n", n_in, out_size, ws_size); grid = -1; return; }
        int dev = 0, cus = 0, per_cu = 0;
        if (hipGetDevice(&dev) != hipSuccess || hipDeviceGetAttribute(&cus, hipDeviceAttributeMultiprocessorCount, dev) != hipSuccess) { grid = -1; return; }
        if (hipFuncSetAttribute((const void*)mega, hipFuncAttributeMaxDynamicSharedMemorySize, LDS_BYTES) != hipSuccess) { fprintf(stderr, "kernel_launch: hipFuncSetAttribute failed\n"); grid = -1; return; }
        if (hipOccupancyMaxActiveBlocksPerMultiprocessor(&per_cu, (const void*)mega, NTHREADS, LDS_BYTES) != hipSuccess || per_cu < 1) { fprintf(stderr, "kernel_launch: occupancy query says %d\n", per_cu); }
        (void)hipGetLastError();
        grid = cus;
    }
    if (grid < 0) return;
    (void)hipMemsetAsync((char*)d_ws + WS_CTL, 0, CTL_ZERO_BYTES, stream);
    (void)hipMemsetAsync((char*)d_ws + WS_MIXSQ, 0, MIXSQ_BYTES, stream);
    Args a{};
    for (int i = 0; i < 23; ++i) a.in[i] = (const float*)d_in[i];
    a.out = (float*)d_out; a.ws = (unsigned char*)d_ws;
#if MK_MULTI_LAUNCH
    for (int p = 0; p < N_PHASES; ++p) { a.ph_lo = p; a.ph_hi = p + 1; a.use_bar = 0; a.pad = 0; hipLaunchKernelGGL(mega, dim3(grid), dim3(NTHREADS), LDS_BYTES, stream, a); }
#else
    a.ph_lo = 0; a.ph_hi = N_PHASES; a.use_bar = 1; a.pad = 0;
    hipLaunchKernelGGL(mega, dim3(grid), dim3(NTHREADS), LDS_BYTES, stream, a);
#endif
    const hipError_t le = hipPeekAtLastError();
    if (le != hipSuccess) fprintf(stderr, "kernel_launch: launch failed: %s\n", hipGetErrorName(le));
}
```

```cpp
#include <hip/hip_runtime.h>
#include <cstdio>
#include <cstdint>
#include <cmath>
__device__ __forceinline__ float shx(float v, int k, int lane);
typedef unsigned long long u64_t;
__device__ __forceinline__ float rowsq_rs(const u64_t* rowsq, int row) { return 1.0f / sqrtf((float)*(const __attribute__((address_space(1))) u64_t*)(rowsq + row) * (5.9604644775390625e-08f / 2048.0f) + 1e-6f); }
__device__ __forceinline__ u64_t rowsq_fx(float ss) { return (u64_t)(ss * 16777216.0f + 0.5f); }
__device__ __forceinline__ unsigned q8x4c(float a, float b, float c, float d, float inv) {
    unsigned w = 0;
    w = __builtin_amdgcn_cvt_pk_u8_f32(__builtin_rintf(__builtin_amdgcn_fmed3f(__builtin_fmaf(a, inv, 128.f), 1.f, 255.f)), 0, w); w = __builtin_amdgcn_cvt_pk_u8_f32(__builtin_rintf(__builtin_amdgcn_fmed3f(__builtin_fmaf(b, inv, 128.f), 1.f, 255.f)), 1, w);
    w = __builtin_amdgcn_cvt_pk_u8_f32(__builtin_rintf(__builtin_amdgcn_fmed3f(__builtin_fmaf(c, inv, 128.f), 1.f, 255.f)), 2, w); w = __builtin_amdgcn_cvt_pk_u8_f32(__builtin_rintf(__builtin_amdgcn_fmed3f(__builtin_fmaf(d, inv, 128.f), 1.f, 255.f)), 3, w);
    return w ^ 0x80808080u;
}
namespace pg8 {
#define PG8_LAS __attribute__((address_space(3)))
#define PG8_GAS __attribute__((address_space(1)))
typedef unsigned short bf16_t;
typedef short bf16x8 __attribute__((ext_vector_type(8)));
typedef float f32x4 __attribute__((ext_vector_type(4)));
typedef unsigned u32x4 __attribute__((ext_vector_type(4)));
constexpr int BM = 256, BK = 64, HALF = 128, HTB = HALF * BK * 2  , STAGE_BYTES = 8 * HTB, NXCD = 8, WGM = 8;

__host__ __device__ __forceinline__ int lds_byte(int r, int c) { const int st = (r >> 4) * 2 + (c >> 5), rr = r & 15, cc = c & 31, ob = rr * 64 + cc * 2; return st * 1024 + (ob ^ (((ob >> 9) & 1) << 5)); }
__host__ __device__ __forceinline__ void stage_rc(int b, int& R, int& C) { const int st = b / 1024, sb = b % 1024, swz = sb ^ (((sb >> 9) & 1) << 5); R = (st >> 1) * 16 + swz / 64; C = (st & 1) * 32 + (swz % 64) / 2; }
__host__ __device__ __forceinline__ int perm32(int rho) { const int n = rho >> 4, i = rho & 15; return 8 * (i >> 2) + 4 * n + (i & 3); }

struct Unit { int pm, pn; };
struct Gemm { const bf16_t* A; const bf16_t* Bt; int M, N, K; };

struct StaticOrder {
    int nM, nN, nwg, G, c;
    __host__ __device__ __forceinline__ void init(int M, int N, int G_, int c_) { nM = M / BM; nN = N / BM; nwg = nM * nN; G = G_; c = c_; }
    __host__ __device__ __forceinline__ bool next(int i, Unit& u) const {
        const long L = (long)i * G + c; if (L >= nwg) return false;
        int wgid = (int)L; { const int q = nwg / NXCD, r = nwg % NXCD, xcd = wgid % NXCD, off = wgid / NXCD; wgid = (xcd < r ? xcd * (q + 1) : r * (q + 1) + (xcd - r) * q) + off; }
        const int nig = WGM * nN, gid = wgid / nig, fm = gid * WGM, gsz = (nM - fm) < WGM ? (nM - fm) : WGM;
        u.pm = fm + ((wgid % nig) % gsz); u.pn = (wgid % nig) / gsz; return true;
    }
    __device__ __forceinline__ void a_ready(const Unit&) const {}
    __device__ __forceinline__ void done(const Unit&) const {}
};

__device__ __forceinline__ unsigned cvt_pk_bf16(float lo, float hi) { unsigned r; asm volatile("v_cvt_pk_bf16_f32 %0, %1, %2" : "=v"(r) : "v"(lo), "v"(hi)); return r; }
typedef float f32x2 __attribute__((ext_vector_type(2)));
__device__ __forceinline__ f32x2 gelu_pk(f32x2 v) {
    const f32x2 av = __builtin_elementwise_abs(v), d = av * 0.2316418882f + 1.0f;
    f32x2 t; t.x = __builtin_amdgcn_rcpf(d.x); t.y = __builtin_amdgcn_rcpf(d.y);
    f32x2 q = t * 0.5307027145f + (-0.7265760135f); q = q * t + 0.7107068705f; q = q * t + (-0.142248368f); q = q * t + 0.127414796f; q = q * t;
    const f32x2 s = (v * v) * (-0.72134752044f);
    f32x2 e; e.x = __builtin_amdgcn_exp2f(s.x); e.y = __builtin_amdgcn_exp2f(s.y);
    const f32x2 m = v * (q * e), r = v - m;
    f32x2 o; o.x = v.x < 0.f ? m.x : r.x; o.y = v.y < 0.f ? m.y : r.y; return o;
}

template <int ACT  > struct EpiBf16 {
    static constexpr bool PERM = true, AFTER_DRAIN = false, KSCALE = false, I8 = false; static_assert(ACT == 0 || ACT == 1, "EpiBf16: ACT is 0 (none) or 1 (gelu_pk)");
    bf16_t* O; int ldc; const float* bias; int split_cols; size_t split_stride; float scale0;
    __device__ __forceinline__ void operator()(const f32x4 (&acc)[2][2][4][2], const Unit& u, int wr, int wc, int fr, int fq) const {
        const int row0 = u.pm * BM + wr * 64 + fr; int colt = u.pn * BM; bf16_t* base = O;
        float sc = 1.f; if (split_cols) { const int t = colt / split_cols; base += (size_t)t * split_stride; colt -= t * split_cols; if (t == 0) sc = scale0; }
        const int col0 = colt + wc * 32 + 8 * fq, bcol0 = u.pn * BM + wc * 32 + 8 * fq;
        f32x4 bv[2][2];
#pragma unroll
        for (int bj = 0; bj < 2; ++bj)
#pragma unroll
            for (int n = 0; n < 2; ++n) bv[bj][n] = bias ? *(const PG8_GAS f32x4*)(bias + bcol0 + bj * HALF + 4 * n) : (f32x4){0.f, 0.f, 0.f, 0.f};
#pragma unroll
        for (int ai = 0; ai < 2; ++ai)
#pragma unroll
            for (int m = 0; m < 4; ++m) { bf16_t* rowp = base + (size_t)(row0 + ai * HALF + m * 16) * ldc + col0;
#pragma unroll
                for (int bj = 0; bj < 2; ++bj) { f32x4 v0 = acc[ai][bj][m][0] + bv[bj][0], v1 = acc[ai][bj][m][1] + bv[bj][1];
                    if (ACT == 1) { f32x2 a = gelu_pk((f32x2){v0[0], v0[1]}), b = gelu_pk((f32x2){v0[2], v0[3]}), c = gelu_pk((f32x2){v1[0], v1[1]}), d = gelu_pk((f32x2){v1[2], v1[3]});
                        v0 = (f32x4){a.x, a.y, b.x, b.y}; v1 = (f32x4){c.x, c.y, d.x, d.y}; }
                    v0 = v0 * sc; v1 = v1 * sc; u32x4 w; w.x = cvt_pk_bf16(v0[0], v0[1]); w.y = cvt_pk_bf16(v0[2], v0[3]); w.z = cvt_pk_bf16(v1[0], v1[1]); w.w = cvt_pk_bf16(v1[2], v1[3]);
                    *(PG8_GAS u32x4*)(rowp + bj * HALF) = w; } }
    }
};

typedef unsigned u32x2 __attribute__((ext_vector_type(2)));
typedef int i32x4 __attribute__((ext_vector_type(4)));
struct EpiResid {
    static constexpr bool PERM = false, AFTER_DRAIN = false, KSCALE = false, I8 = false;
    bf16_t* s; int ldc; u64_t* rowsq;
    __device__ __forceinline__ void operator()(const f32x4 (&acc)[2][2][4][2], const Unit& u, int wr, int wc, int fr, int fq) const {
        const int col0 = u.pn * BM + wc * 32 + 4 * fq;
#pragma unroll
        for (int ai = 0; ai < 2; ++ai)
#pragma unroll
            for (int m = 0; m < 4; ++m) { const int row = u.pm * BM + ai * HALF + wr * 64 + m * 16 + fr; bf16_t* sp = s + (size_t)row * ldc + col0; float ss = 0.f;
                u32x2 in[2][2];
#pragma unroll
                for (int bj = 0; bj < 2; ++bj)
#pragma unroll
                    for (int n = 0; n < 2; ++n) in[bj][n] = *(const PG8_GAS u32x2*)(sp + bj * HALF + n * 16);
#pragma unroll
                for (int bj = 0; bj < 2; ++bj)
#pragma unroll
                    for (int n = 0; n < 2; ++n) { const u32x2 w0 = in[bj][n];
                        const f32x4 bs = (f32x4){__builtin_bit_cast(float, w0.x << 16), __builtin_bit_cast(float, w0.x & 0xffff0000u), __builtin_bit_cast(float, w0.y << 16), __builtin_bit_cast(float, w0.y & 0xffff0000u)};
                        const f32x4 o = bs + acc[ai][bj][m][n]; ss += (o[0] * o[0] + o[1] * o[1]) + (o[2] * o[2] + o[3] * o[3]);
                        u32x2 w; w.x = cvt_pk_bf16(o[0], o[1]); w.y = cvt_pk_bf16(o[2], o[3]); *(PG8_GAS u32x2*)(sp + bj * HALF + n * 16) = w; }
                ss += shx(ss, 16, fr + 16 * fq); ss += shx(ss, 32, fr + 16 * fq);
                if (fq == 0) (void)__hip_atomic_fetch_add((PG8_GAS u64_t*)(rowsq + row), rowsq_fx(ss), __ATOMIC_RELAXED, __HIP_MEMORY_SCOPE_AGENT); }
    }
};
struct EpiResid8 {
    static constexpr bool PERM = false, AFTER_DRAIN = false, KSCALE = false, I8 = true;
    bf16_t* s; int ldc; u64_t* rowsq; const float* xsc; const float* wsc;
    __device__ __forceinline__ void operator()(const f32x4 (&acc)[2][2][4][2], const Unit& u, int wr, int wc, int fr, int fq) const {
        const int col0 = u.pn * BM + wc * 32 + 4 * fq;
#pragma unroll
        for (int ai = 0; ai < 2; ++ai)
#pragma unroll
            for (int m = 0; m < 4; ++m) { const int row = u.pm * BM + ai * HALF + wr * 64 + m * 16 + fr; bf16_t* sp = s + (size_t)row * ldc + col0; float ss = 0.f; const float xs = *(const PG8_GAS float*)(xsc + row);
                u32x2 in[2][2];
#pragma unroll
                for (int bj = 0; bj < 2; ++bj)
#pragma unroll
                    for (int n = 0; n < 2; ++n) in[bj][n] = *(const PG8_GAS u32x2*)(sp + bj * HALF + n * 16);
#pragma unroll
                for (int bj = 0; bj < 2; ++bj)
#pragma unroll
                    for (int n = 0; n < 2; ++n) { const u32x2 w0 = in[bj][n]; const i32x4 ia = __builtin_bit_cast(i32x4, acc[ai][bj][m][n]);
                        const f32x4 bs = (f32x4){__builtin_bit_cast(float, w0.x << 16), __builtin_bit_cast(float, w0.x & 0xffff0000u), __builtin_bit_cast(float, w0.y << 16), __builtin_bit_cast(float, w0.y & 0xffff0000u)};
                        const f32x4 o = bs + (f32x4){(float)ia[0], (float)ia[1], (float)ia[2], (float)ia[3]} * *(const PG8_GAS f32x4*)(wsc + col0 + bj * HALF + n * 16) * xs; ss += (o[0] * o[0] + o[1] * o[1]) + (o[2] * o[2] + o[3] * o[3]);
                        u32x2 w; w.x = cvt_pk_bf16(o[0], o[1]); w.y = cvt_pk_bf16(o[2], o[3]); *(PG8_GAS u32x2*)(sp + bj * HALF + n * 16) = w; }
                ss += shx(ss, 16, fr + 16 * fq); ss += shx(ss, 32, fr + 16 * fq);
                if (fq == 0) (void)__hip_atomic_fetch_add((PG8_GAS u64_t*)(rowsq + row), rowsq_fx(ss), __ATOMIC_RELAXED, __HIP_MEMORY_SCOPE_AGENT); }
    }
};
template <bool I8IN, int QOUT>
struct EpiResidT {
    static constexpr bool PERM = true, AFTER_DRAIN = false, KSCALE = false, I8 = I8IN;
    bf16_t* s; int ldc; u64_t* rowsq; const float* xsc; const float* wsc; unsigned char* q8; const u64_t* rowsq_prev;
    __device__ __forceinline__ void operator()(const f32x4 (&acc)[2][2][4][2], const Unit& u, int wr, int wc, int fr, int fq) const {
        const int col0 = u.pn * BM + wc * 32 + 8 * fq;
#pragma unroll
        for (int ai = 0; ai < 2; ++ai)
#pragma unroll
            for (int m = 0; m < 4; ++m) { const int row = u.pm * BM + ai * HALF + wr * 64 + m * 16 + fr; bf16_t* sp = s + (size_t)row * ldc + col0; float ss = 0.f;
                float xs = 1.f, qinv = 0.f;
                if constexpr (I8IN) xs = *(const PG8_GAS float*)(xsc + row);
                if constexpr (QOUT > 0) qinv = (127.0f / QOUT) * rowsq_rs(rowsq_prev, row);
                u32x4 in[2];
#pragma unroll
                for (int bj = 0; bj < 2; ++bj) in[bj] = *(const PG8_GAS u32x4*)(sp + bj * HALF);
#pragma unroll
                for (int bj = 0; bj < 2; ++bj) { const u32x4 w0 = in[bj]; f32x4 a0 = acc[ai][bj][m][0], a1 = acc[ai][bj][m][1];
                    if constexpr (I8IN) { const i32x4 i0 = __builtin_bit_cast(i32x4, a0), i1 = __builtin_bit_cast(i32x4, a1);
                        a0 = (f32x4){(float)i0[0], (float)i0[1], (float)i0[2], (float)i0[3]} * *(const PG8_GAS f32x4*)(wsc + col0 + bj * HALF) * xs;
                        a1 = (f32x4){(float)i1[0], (float)i1[1], (float)i1[2], (float)i1[3]} * *(const PG8_GAS f32x4*)(wsc + col0 + bj * HALF + 4) * xs; }
                    const f32x4 o0 = (f32x4){__builtin_bit_cast(float, w0.x << 16), __builtin_bit_cast(float, w0.x & 0xffff0000u), __builtin_bit_cast(float, w0.y << 16), __builtin_bit_cast(float, w0.y & 0xffff0000u)} + a0;
                    const f32x4 o1 = (f32x4){__builtin_bit_cast(float, w0.z << 16), __builtin_bit_cast(float, w0.z & 0xffff0000u), __builtin_bit_cast(float, w0.w << 16), __builtin_bit_cast(float, w0.w & 0xffff0000u)} + a1;
                    ss += ((o0[0] * o0[0] + o0[1] * o0[1]) + (o0[2] * o0[2] + o0[3] * o0[3])) + ((o1[0] * o1[0] + o1[1] * o1[1]) + (o1[2] * o1[2] + o1[3] * o1[3]));
                    u32x4 w; w.x = cvt_pk_bf16(o0[0], o0[1]); w.y = cvt_pk_bf16(o0[2], o0[3]); w.z = cvt_pk_bf16(o1[0], o1[1]); w.w = cvt_pk_bf16(o1[2], o1[3]); *(PG8_GAS u32x4*)(sp + bj * HALF) = w;
                    if constexpr (QOUT > 0) { u32x2 q; q.x = q8x4c(o0[0], o0[1], o0[2], o0[3], qinv); q.y = q8x4c(o1[0], o1[1], o1[2], o1[3], qinv); *(PG8_GAS u32x2*)(q8 + (size_t)row * ldc + col0 + bj * HALF) = q; } }
                ss += shx(ss, 16, fr + 16 * fq); ss += shx(ss, 32, fr + 16 * fq);
                if (fq == 0) (void)__hip_atomic_fetch_add((PG8_GAS u64_t*)(rowsq + row), rowsq_fx(ss), __ATOMIC_RELAXED, __HIP_MEMORY_SCOPE_AGENT); }
    }
};
template <int QIN>
struct EpiBf16Row8 {
    static constexpr bool PERM = true, AFTER_DRAIN = false, KSCALE = false, I8 = true;
    bf16_t* O; int ldc; const u64_t* rowsq; const u64_t* rowsq_prev; const float* wsc;
    __device__ __forceinline__ void operator()(const f32x4 (&acc)[2][2][4][2], const Unit& u, int wr, int wc, int fr, int fq) const {
        const int row0 = u.pm * BM + wr * 64 + fr, col0 = u.pn * BM + wc * 32 + 8 * fq;
#pragma unroll
        for (int ai = 0; ai < 2; ++ai)
#pragma unroll
            for (int m = 0; m < 4; ++m) { const int row = row0 + ai * HALF + m * 16; const float rs = rowsq_rs(rowsq, row) * (QIN / 127.0f) / rowsq_rs(rowsq_prev, row); bf16_t* rowp = O + (size_t)row * ldc + col0;
#pragma unroll
                for (int bj = 0; bj < 2; ++bj) { const i32x4 i0 = __builtin_bit_cast(i32x4, acc[ai][bj][m][0]), i1 = __builtin_bit_cast(i32x4, acc[ai][bj][m][1]);
                    const f32x4 v0 = (f32x4){(float)i0[0], (float)i0[1], (float)i0[2], (float)i0[3]} * *(const PG8_GAS f32x4*)(wsc + col0 + bj * HALF) * rs, v1 = (f32x4){(float)i1[0], (float)i1[1], (float)i1[2], (float)i1[3]} * *(const PG8_GAS f32x4*)(wsc + col0 + bj * HALF + 4) * rs;
                    u32x4 w; w.x = cvt_pk_bf16(v0[0], v0[1]); w.y = cvt_pk_bf16(v0[2], v0[3]); w.z = cvt_pk_bf16(v1[0], v1[1]); w.w = cvt_pk_bf16(v1[2], v1[3]);
                    *(PG8_GAS u32x4*)(rowp + bj * HALF) = w; } }
    }
};
struct EpiResidMix {
    static constexpr bool PERM = false, AFTER_DRAIN = false, KSCALE = true, I8 = false; static constexpr int KS0 = 12, KS1 = 20;
    bf16_t* s; int ldc; u64_t* rowsq; const PG8_LAS float* ftab; const PG8_LAS int* pmtab;
    __device__ __forceinline__ int slot(int pm) const { return pmtab[0] == pm ? 0 : (pmtab[1] == pm ? 1 : (pmtab[2] == pm ? 2 : 3)); }
    __device__ __forceinline__ void kscale(f32x4 (&acc)[2][2][4][2], const Unit& u, int which, int wr, int fr) const {
        const PG8_LAS float* ft = ftab + which * 1024 + slot(u.pm) * 256;
#pragma unroll
        for (int ai = 0; ai < 2; ++ai)
#pragma unroll
            for (int m = 0; m < 4; ++m) { const float f = ft[ai * HALF + wr * 64 + m * 16 + fr];
#pragma unroll
                for (int bj = 0; bj < 2; ++bj)
#pragma unroll
                    for (int n = 0; n < 2; ++n) acc[ai][bj][m][n] = acc[ai][bj][m][n] * f; }
    }
    __device__ __forceinline__ void operator()(const f32x4 (&acc)[2][2][4][2], const Unit& u, int wr, int wc, int fr, int fq) const {
        const int col0 = u.pn * BM + wc * 32 + 4 * fq;
#pragma unroll
        for (int ai = 0; ai < 2; ++ai)
#pragma unroll
            for (int m = 0; m < 4; ++m) { const int row = u.pm * BM + ai * HALF + wr * 64 + m * 16 + fr; bf16_t* sp = s + (size_t)row * ldc + col0; float ss = 0.f; const float rc = ftab[2048 + slot(u.pm) * 256 + ai * HALF + wr * 64 + m * 16 + fr];
                u32x2 in[2][2];
#pragma unroll
                for (int bj = 0; bj < 2; ++bj)
#pragma unroll
                    for (int n = 0; n < 2; ++n) in[bj][n] = *(const PG8_GAS u32x2*)(sp + bj * HALF + n * 16);
#pragma unroll
                for (int bj = 0; bj < 2; ++bj)
#pragma unroll
                    for (int n = 0; n < 2; ++n) { const u32x2 w0 = in[bj][n];
                        const f32x4 bs = (f32x4){__builtin_bit_cast(float, w0.x << 16), __builtin_bit_cast(float, w0.x & 0xffff0000u), __builtin_bit_cast(float, w0.y << 16), __builtin_bit_cast(float, w0.y & 0xffff0000u)};
                        const f32x4 o = bs + acc[ai][bj][m][n] * rc; ss += (o[0] * o[0] + o[1] * o[1]) + (o[2] * o[2] + o[3] * o[3]);
                        u32x2 w; w.x = cvt_pk_bf16(o[0], o[1]); w.y = cvt_pk_bf16(o[2], o[3]); *(PG8_GAS u32x2*)(sp + bj * HALF + n * 16) = w; }
                ss += shx(ss, 16, fr + 16 * fq); ss += shx(ss, 32, fr + 16 * fq);
                if (fq == 0) (void)__hip_atomic_fetch_add((PG8_GAS u64_t*)(rowsq + row), rowsq_fx(ss), __ATOMIC_RELAXED, __HIP_MEMORY_SCOPE_AGENT); }
    }
};
struct EpiBf16Row {
    static constexpr bool PERM = true, AFTER_DRAIN = false, KSCALE = false, I8 = false;
    bf16_t* O; int ldc; const u64_t* rowsq;
    __device__ __forceinline__ void operator()(const f32x4 (&acc)[2][2][4][2], const Unit& u, int wr, int wc, int fr, int fq) const {
        const int row0 = u.pm * BM + wr * 64 + fr, col0 = u.pn * BM + wc * 32 + 8 * fq;
#pragma unroll
        for (int ai = 0; ai < 2; ++ai)
#pragma unroll
            for (int m = 0; m < 4; ++m) { const int row = row0 + ai * HALF + m * 16; const float rs = rowsq_rs(rowsq, row); bf16_t* rowp = O + (size_t)row * ldc + col0;
#pragma unroll
                for (int bj = 0; bj < 2; ++bj) { const f32x4 v0 = acc[ai][bj][m][0] * rs, v1 = acc[ai][bj][m][1] * rs; u32x4 w; w.x = cvt_pk_bf16(v0[0], v0[1]); w.y = cvt_pk_bf16(v0[2], v0[3]); w.z = cvt_pk_bf16(v1[0], v1[1]); w.w = cvt_pk_bf16(v1[2], v1[3]);
                    *(PG8_GAS u32x4*)(rowp + bj * HALF) = w; } }
    }
};
struct EpiQKV {
    static constexpr bool PERM = false, AFTER_DRAIN = false, KSCALE = false, I8 = true;
    bf16_t* O; const float* ga; const float* gb; const float* gc; const float* rope; const u64_t* rowsq; const float* xsc; const float* wsc;
    __device__ __forceinline__ void operator()(const f32x4 (&acc)[2][2][4][2], const Unit& u, int wr, int wc, int fr, int fq) const {
        const int hg = u.pn * 4 + wc;
        const float* g = nullptr; bool isq = false, dorope = false;
        if (hg < 12) { g = ga; isq = true; } else if (hg < 16) { g = ga + 64; } else if (hg < 20) { }
        else if (hg < 28) { g = gb; isq = true; } else if (hg < 36) { g = gb + 64; } else if (hg < 44) { }
        else if (hg < 56) { g = gc; isq = true; dorope = true; } else if (hg < 60) { g = gc + 64; dorope = true; }
        const float qs = isq ? 0.18033688011112042f : 1.0f;
#pragma unroll
        for (int ai = 0; ai < 2; ++ai)
#pragma unroll
            for (int m = 0; m < 4; ++m) {
                const int row = u.pm * BM + ai * HALF + wr * 64 + m * 16 + fr;
                f32x4 v[2][2];
                const float rsx = rowsq_rs(rowsq, row) * *(const PG8_GAS float*)(xsc + row);
#pragma unroll
                for (int bj = 0; bj < 2; ++bj)
#pragma unroll
                    for (int n = 0; n < 2; ++n) { const i32x4 ia = __builtin_bit_cast(i32x4, acc[ai][bj][m][n]);
                        v[bj][n] = (f32x4){(float)ia[0], (float)ia[1], (float)ia[2], (float)ia[3]} * *(const PG8_GAS f32x4*)(wsc + hg * 64 + 32 * bj + 16 * n + 4 * fq) * rsx; }
                if (g) {
                    float ss = 0.f;
#pragma unroll
                    for (int bj = 0; bj < 2; ++bj)
#pragma unroll
                        for (int n = 0; n < 2; ++n) { const f32x4 x = v[bj][n]; ss += (x[0] * x[0] + x[1] * x[1]) + (x[2] * x[2] + x[3] * x[3]); }
                    ss += shx(ss, 16, fr + 16 * fq); ss += shx(ss, 32, fr + 16 * fq);
                    const float r = qs / sqrtf(ss * (1.0f / 64.0f) + 1e-6f);
#pragma unroll
                    for (int bj = 0; bj < 2; ++bj)
#pragma unroll
                        for (int n = 0; n < 2; ++n) v[bj][n] = v[bj][n] * *(const PG8_GAS f32x4*)(g + 32 * bj + 16 * n + 4 * fq) * r;
                }
                if (dorope) {
                    const int t = row & 2047, pr = t >> 6, pc = t & 63;
#pragma unroll
                    for (int bj = 0; bj < 2; ++bj) {
                        const int pos = bj ? pc : pr;
                        const float* rp = rope + (size_t)(pos * 16 + 4 * fq) * 2;
                        const f32x4 c01 = *(const PG8_GAS f32x4*)rp, c23 = *(const PG8_GAS f32x4*)(rp + 4);
                        const f32x4 cs = (f32x4){c01[0], c01[2], c23[0], c23[2]}, sn = (f32x4){c01[1], c01[3], c23[1], c23[3]};
                        const f32x4 x1 = v[bj][0], x2 = v[bj][1];
                        v[bj][0] = x1 * cs - x2 * sn; v[bj][1] = x1 * sn + x2 * cs;
                    }
                }
                bf16_t* rowp = O + (size_t)row * 4096 + hg * 64 + 4 * fq;
#pragma unroll
                for (int bj = 0; bj < 2; ++bj)
#pragma unroll
                    for (int n = 0; n < 2; ++n) { u32x2 w; w.x = cvt_pk_bf16(v[bj][n][0], v[bj][n][1]); w.y = cvt_pk_bf16(v[bj][n][2], v[bj][n][3]); *(PG8_GAS u32x2*)(rowp + 32 * bj + 16 * n) = w; }
                asm volatile("" ::: "memory");
            }
    }
};
template <bool I8> __device__ __forceinline__ f32x4 mma16(const bf16x8 b, const bf16x8 a, const f32x4 c) {
    if constexpr (I8) return __builtin_bit_cast(f32x4, __builtin_amdgcn_mfma_i32_16x16x64_i8(__builtin_bit_cast(i32x4, b), __builtin_bit_cast(i32x4, a), __builtin_bit_cast(i32x4, c), 0, 0, 0));
    else return __builtin_amdgcn_mfma_f32_16x16x32_bf16(b, a, c, 0, 0, 0);
}
template <class Epi, class Sched, bool ALIGN_EPI = false, bool SP2 = false>
__device__ __forceinline__ void gemm_phase(PG8_LAS unsigned char* lds, const Gemm g, const Sched& S, const Epi& E, const int tid) {
    const int wid = __builtin_amdgcn_readfirstlane(tid >> 6), lane = tid & 63, wr = wid >> 2, wc = wid & 3, fr = lane & 15, fq = lane >> 4;
    const int K = g.K, nt = K / BK;
    unsigned voffA[2], voffB[2];
#pragma unroll
    for (int i = 0; i < 2; ++i) { int R, C; stage_rc(tid * 16 + i * 8192, R, C); const int Rb = Epi::PERM ? ((R & ~31) + perm32(R & 31)) : R;
        voffA[i] = (unsigned)(R * K + C) * 2u; voffB[i] = (unsigned)(Rb * K + C) * 2u; }
    const size_t kstep = (size_t)(BK * 2);
    const size_t hstep = (size_t)HALF * K * 2;
    const size_t tstep = 2 * hstep;
    const unsigned ldsw = (unsigned)wid * 1024u;
    const int aoff = lds_byte(wr * 64 + fr, fq * 8), boff = lds_byte(wc * 32 + fr, fq * 8);
#define PG8_SA(b, h) (((b) * 2 + (h)) * HTB)
#define PG8_SB(b, h) ((4 + (b) * 2 + (h)) * HTB)
#define PG8_STAGE(bufoff, gbase, voff) do { _Pragma("unroll") for (int _i = 0; _i < 2; ++_i) \
        __builtin_amdgcn_global_load_lds((const unsigned*)((const char*)(gbase) + (voff)[_i]), (PG8_LAS unsigned*)(lds + (bufoff) + ldsw + _i * 8192), 16, 0, 0); } while (0)
#define PG8_LDA(dst, b, h) do { _Pragma("unroll") for (int m = 0; m < 4; ++m) _Pragma("unroll") for (int k = 0; k < 2; ++k) dst[m][k] = *(const PG8_LAS bf16x8*)(lds + PG8_SA(b, h) + aoff + m * 2048 + k * 1024); } while (0)
#define PG8_LDB(dst, b, h) do { _Pragma("unroll") for (int n = 0; n < 2; ++n) _Pragma("unroll") for (int k = 0; k < 2; ++k) dst[n][k] = *(const PG8_LAS bf16x8*)(lds + PG8_SB(b, h) + boff + n * 2048 + k * 1024); } while (0)
#define PG8_MMA(ai, bj, At, Bt) do { __builtin_amdgcn_s_setprio(1); _Pragma("unroll") for (int m = 0; m < 4; ++m) _Pragma("unroll") for (int n = 0; n < 2; ++n) _Pragma("unroll") for (int k = 0; k < 2; ++k) \
        acc[ai][bj][m][n] = mma16<Epi::I8>(Bt[n][k], At[m][k], acc[ai][bj][m][n]); __builtin_amdgcn_s_setprio(0); } while (0)
#define PG8_WAIT_V(n) asm volatile("s_waitcnt vmcnt(" #n ")" ::: "memory")
#define PG8_WAIT_L(n) asm volatile("s_waitcnt lgkmcnt(" #n ")" ::: "memory")
#define PG8_BAR __builtin_amdgcn_s_barrier()
#define PG8_SCHED __builtin_amdgcn_sched_barrier(0)
    Unit cur, nxt; int ui = 0;
    if (!S.next(0, cur)) return;
    f32x4 acc[2][2][4][2];
#pragma unroll
    for (int a = 0; a < 2; ++a)
#pragma unroll
        for (int b = 0; b < 2; ++b)
#pragma unroll
            for (int m = 0; m < 4; ++m)
#pragma unroll
                for (int n = 0; n < 2; ++n) acc[a][b][m][n] = (f32x4){0.f, 0.f, 0.f, 0.f};
    bf16x8 At[4][2], B0[2][2], B1[2][2];
    const char* cA = (const char*)g.A + (size_t)cur.pm * tstep; const char* cB = (const char*)g.Bt + (size_t)cur.pn * tstep;
    S.a_ready(cur);
    if constexpr (SP2) {
        PG8_STAGE(PG8_SB(0, 0), cB, voffB); PG8_STAGE(PG8_SB(0, 1), cB + hstep, voffB); PG8_STAGE(PG8_SA(0, 0), cA, voffA); PG8_STAGE(PG8_SA(0, 1), cA + hstep, voffA);
        if (wr == 1) PG8_BAR;
        PG8_WAIT_V(2); PG8_BAR;
        PG8_STAGE(PG8_SB(1, 0), cB + kstep, voffB); PG8_STAGE(PG8_SA(1, 0), cA + kstep, voffA); PG8_STAGE(PG8_SB(1, 1), cB + hstep + kstep, voffB);
        PG8_WAIT_V(6); PG8_BAR;
    } else {
        PG8_STAGE(PG8_SB(0, 0), cB, voffB); PG8_STAGE(PG8_SA(0, 0), cA, voffA); PG8_STAGE(PG8_SB(0, 1), cB + hstep, voffB); PG8_STAGE(PG8_SA(0, 1), cA + hstep, voffA);
        if (wr == 1) PG8_BAR;
        PG8_WAIT_V(4); PG8_BAR;
        PG8_STAGE(PG8_SB(1, 0), cB + kstep, voffB); PG8_STAGE(PG8_SA(1, 0), cA + kstep, voffA); PG8_STAGE(PG8_SB(1, 1), cB + hstep + kstep, voffB);
        PG8_WAIT_V(6); PG8_BAR;
    }
    for (;;) {
        const bool has_next = S.next(ui + 1, nxt);
        const char* nA = has_next ? (const char*)g.A + (size_t)nxt.pm * tstep : cA; const char* nB = has_next ? (const char*)g.Bt + (size_t)nxt.pn * tstep : cB;
        for (int t = 0; t < nt; t += 2) {
            if constexpr (Epi::KSCALE) { if (t == Epi::KS0 || t == Epi::KS1) E.kscale(acc, cur, t == Epi::KS1 ? 1 : 0, wr, fr); }
            const bool last = (t == nt - 2);
            const char* a1 = cA + (size_t)(t + 1) * kstep;
            const char* a2 = last ? nA : cA + (size_t)(t + 2) * kstep; const char* b2 = last ? nB : cB + (size_t)(t + 2) * kstep;
            const char* a3 = a2 + kstep; const char* b3 = b2 + kstep;
            if (last && has_next) S.a_ready(nxt);
            if constexpr (SP2) {
            PG8_LDB(B0, 0, 0); PG8_LDB(B1, 0, 1); PG8_SCHED; PG8_LDA(At, 0, 0); PG8_STAGE(PG8_SA(1, 1), a1 + hstep, voffA);
            PG8_WAIT_V(8); PG8_WAIT_L(0); PG8_BAR; PG8_MMA(0, 0, At, B0); PG8_MMA(0, 1, At, B1); PG8_BAR; PG8_SCHED;
            PG8_LDA(At, 0, 1); PG8_STAGE(PG8_SB(0, 0), b2, voffB); PG8_STAGE(PG8_SB(0, 1), b2 + hstep, voffB); PG8_STAGE(PG8_SA(0, 0), a2, voffA);
            PG8_WAIT_V(8); PG8_WAIT_L(0); PG8_BAR; PG8_MMA(1, 0, At, B0); PG8_MMA(1, 1, At, B1); PG8_BAR; PG8_SCHED;
            PG8_LDB(B0, 1, 0); PG8_LDB(B1, 1, 1); PG8_SCHED; PG8_LDA(At, 1, 0); PG8_STAGE(PG8_SA(0, 1), a2 + hstep, voffA);
            PG8_WAIT_V(8); PG8_WAIT_L(0); PG8_BAR; PG8_MMA(0, 0, At, B0); PG8_MMA(0, 1, At, B1); PG8_BAR; PG8_SCHED;
            PG8_LDA(At, 1, 1); PG8_STAGE(PG8_SB(1, 0), b3, voffB); PG8_STAGE(PG8_SB(1, 1), b3 + hstep, voffB); PG8_STAGE(PG8_SA(1, 0), a3, voffA);
            PG8_WAIT_V(8); PG8_WAIT_L(0); PG8_BAR; PG8_MMA(1, 0, At, B0); PG8_MMA(1, 1, At, B1); PG8_BAR; PG8_SCHED;
            } else {
            PG8_LDB(B0, 0, 0); PG8_SCHED; PG8_LDA(At, 0, 0); PG8_STAGE(PG8_SA(1, 1), a1 + hstep, voffA);
            PG8_WAIT_L(8); PG8_BAR; PG8_WAIT_L(0); PG8_MMA(0, 0, At, B0); PG8_BAR; PG8_SCHED;
            PG8_LDB(B1, 0, 1); PG8_STAGE(PG8_SB(0, 0), b2, voffB);
            PG8_BAR; PG8_WAIT_L(0); PG8_MMA(0, 1, At, B1); PG8_BAR;
            PG8_LDA(At, 0, 1); PG8_STAGE(PG8_SA(0, 0), a2, voffA);
            PG8_BAR; PG8_WAIT_L(0); PG8_MMA(1, 0, At, B0); PG8_BAR; PG8_SCHED;
            PG8_STAGE(PG8_SB(0, 1), b2 + hstep, voffB);
            PG8_WAIT_V(6); PG8_BAR; PG8_MMA(1, 1, At, B1); PG8_BAR;
            PG8_LDB(B0, 1, 0); PG8_SCHED; PG8_LDA(At, 1, 0); PG8_STAGE(PG8_SA(0, 1), a2 + hstep, voffA);
            PG8_WAIT_L(8); PG8_BAR; PG8_WAIT_L(0); PG8_MMA(0, 0, At, B0); PG8_BAR; PG8_SCHED;
            PG8_LDB(B1, 1, 1); PG8_STAGE(PG8_SB(1, 0), b3, voffB);
            PG8_BAR; PG8_WAIT_L(0); PG8_MMA(0, 1, At, B1); PG8_BAR;
            PG8_LDA(At, 1, 1); PG8_STAGE(PG8_SA(1, 0), a3, voffA);
            PG8_BAR; PG8_WAIT_L(0); PG8_MMA(1, 0, At, B0); PG8_BAR; PG8_SCHED;
            PG8_STAGE(PG8_SB(1, 1), b3 + hstep, voffB);
            PG8_WAIT_V(6); PG8_BAR; PG8_MMA(1, 1, At, B1); PG8_BAR;
            }
        }
        if constexpr (ALIGN_EPI) { if (wr == 0) PG8_BAR; }
        if constexpr (!Epi::AFTER_DRAIN) { E(acc, cur, wr, wc, fr, fq); S.done(cur); }
        if (!has_next) break;
#pragma unroll
        for (int a = 0; a < 2; ++a)
#pragma unroll
            for (int b = 0; b < 2; ++b)
#pragma unroll
                for (int m = 0; m < 4; ++m)
#pragma unroll
                    for (int n = 0; n < 2; ++n) acc[a][b][m][n] = (f32x4){0.f, 0.f, 0.f, 0.f};
        cur = nxt; cA = nA; cB = nB; ++ui;
        if constexpr (ALIGN_EPI) { if (wr == 1) PG8_BAR; }
    }
    PG8_WAIT_V(0);
    if constexpr (!ALIGN_EPI) { if (wr == 0) PG8_BAR; }
    PG8_BAR;
    if constexpr (Epi::AFTER_DRAIN) { E.fused(acc, cur, wr, wc, fr, fq, lds, wid, lane); S.done(cur); }
#undef PG8_SA
#undef PG8_SB
#undef PG8_STAGE
#undef PG8_LDA
#undef PG8_LDB
#undef PG8_MMA
#undef PG8_WAIT_V
#undef PG8_WAIT_L
#undef PG8_BAR
#undef PG8_SCHED
}
}

constexpr int BATCH = 16, SEQ = 2048, DM = 2048, T = BATCH * SEQ, DEPTH = 2;
constexpr int NMEM = 256, DIN = 4096, MEMW = 512;
constexpr int PEER_H = 8, PEER_N = 16384;
constexpr int NWAVES = 8, NTHREADS = NWAVES * 64;
constexpr float EPS = 1e-6f;
constexpr int QA = 0, KA = 768, VA = 1024, QB = 1280, KB = 1792, VB = 2304, QC = 2816, KC = 3584, VC = 3840;
constexpr int OA = 0, OB = 768, OC = 1280;

constexpr size_t MiB = 1u << 20;
constexpr size_t WS_CTL = 0, CTL_ZERO_BYTES = 2 * MiB;
constexpr size_t WS_ROWSQ = 256 * 1024;
constexpr size_t WS_ROPE = 83 * MiB, WS_BIASA = 83 * MiB + 16384;
constexpr size_t WS_WIN = 2 * MiB, WS_WOUT = 34 * MiB, WS_WMQ = 50 * MiB, WS_WMKV = 54 * MiB, WS_WMO = 62 * MiB, WS_WPQ = 66 * MiB, WS_PKEYS = 82 * MiB;
constexpr size_t WS_MEMN = 84 * MiB, WS_KVM = 116 * MiB, WS_PU = 132 * MiB, WS_PV = 260 * MiB, WS_XN = 388 * MiB, WS_QKV = 516 * MiB, WS_ATT = 772 * MiB;
constexpr size_t WS_QM = 900 * MiB, WS_OM = 932 * MiB, WS_MIXSQ = 964 * MiB, MIXSQ_BYTES = 2 * MiB, WS_WIN8 = 966 * MiB, WS_WSC = 982 * MiB, WS_XSC = 982 * MiB + 65536, WS_XSC2 = 982 * MiB + 196608, WS_WSCO = 982 * MiB + 327680, WS_WSCP = 982 * MiB + 344064, WS_WSCM = 982 * MiB + 360448,
                 WS_WOUT8 = 984 * MiB, WS_WPQ8 = 992 * MiB, WS_WMQ8 = 1000 * MiB, WS_END = 1002 * MiB;
constexpr size_t WS_QP = WS_QKV, WS_PIDX = WS_QKV + 128 * MiB, WS_PGATE = WS_QKV + 144 * MiB, WS_PARTI = WS_QKV + 160 * MiB;
constexpr size_t WS_XQH = 900 * MiB, WS_XQL = 932 * MiB;
constexpr size_t WS_ATT8 = 900 * MiB;
constexpr size_t WS_X8 = 772 * MiB;
constexpr size_t WS_XN8 = 836 * MiB;
constexpr int CW_BAR = 4096;

constexpr int RING_OFF = 0, RING_BYTES = 131072;
constexpr int LDSCTL_OFF = RING_BYTES, MISC_OFF = LDSCTL_OFF + 320;
constexpr int LDS_BYTES = 147456;

#define GAS __attribute__((address_space(1)))
#define LAS __attribute__((address_space(3)))
typedef unsigned short bf16;
typedef unsigned v4u __attribute__((ext_vector_type(4)));
typedef unsigned v2u __attribute__((ext_vector_type(2)));
typedef float f32x4 __attribute__((ext_vector_type(4)));
typedef float f32x16 __attribute__((ext_vector_type(16)));
typedef short bf16x8 __attribute__((ext_vector_type(8)));
typedef GAS unsigned gu32;
#define LDS_WAIT() asm volatile("s_waitcnt lgkmcnt(0)" ::: "memory")
#define VM_WAIT() asm volatile("s_waitcnt vmcnt(0)" ::: "memory")
__device__ __forceinline__ unsigned f2bf(float f) { unsigned u = __builtin_bit_cast(unsigned, f); return (u + 0x7fffu + ((u >> 16) & 1u)) >> 16; }
__device__ __forceinline__ unsigned pk2(float lo, float hi) { return f2bf(lo) | (f2bf(hi) << 16); }
__device__ __forceinline__ float bflo(unsigned w) { return __builtin_bit_cast(float, w << 16); }
__device__ __forceinline__ float bfhi(unsigned w) { return __builtin_bit_cast(float, w & 0xffff0000u); }

__device__ __forceinline__ float shx(float v, int k, int lane) { return __builtin_bit_cast(float, __builtin_amdgcn_ds_bpermute((lane ^ k) << 2, __builtin_bit_cast(int, v))); }
#define XB_TMO      128
#define XB_XCNT(j)  (256  + 64 * (j))
#define XB_XSUB(j)  (1280 + 64 * (j))
#define XB_XGEN(j)  (2304 + 64 * (j))
#define XB_TOP      3328
#define XB_TOPGEN   3392
#define XCD_BAR_WORDS 3456
#define XB_SPIN_CAP (1u << 18)

__device__ __forceinline__ unsigned xb_ld(unsigned* p)              { return __hip_atomic_load(p, __ATOMIC_RELAXED, __HIP_MEMORY_SCOPE_AGENT); }
__device__ __forceinline__ unsigned xb_add(unsigned* p, unsigned v) { return __hip_atomic_fetch_add(p, v, __ATOMIC_RELAXED, __HIP_MEMORY_SCOPE_AGENT); }
__device__ __forceinline__ unsigned xb_xcc_id() { return (unsigned)__builtin_amdgcn_s_getreg((3 << 11) | 20) & 0xFu; }
#define XB_SPIN(cond, bar) do { unsigned _sp = 0; while (cond) { __builtin_amdgcn_s_sleep(1); \
    if ((++_sp & 255u) == 0u) { if (xb_ld(&(bar)[XB_TMO])) break; if (_sp > XB_SPIN_CAP) { atomicAdd(&(bar)[XB_TMO], 1u); break; } } } } while (0)

struct XcdBarrier {
    unsigned* bar; unsigned x;
    volatile LAS unsigned* st;
};

__device__ __forceinline__ XcdBarrier xcd_barrier_post(unsigned* bar, volatile LAS unsigned* st) {
    XcdBarrier b; b.bar = bar; b.x = xb_xcc_id(); b.st = st;
    if (threadIdx.x == 0) (void)xb_add(&bar[XB_XCNT(b.x)], 1u);
    return b;
}
__device__ __forceinline__ void xcd_barrier_complete(unsigned* bar, unsigned x, unsigned& nloc, unsigned& nx) {
    const unsigned G = gridDim.x * gridDim.y * gridDim.z;
    unsigned sum, cnt, mine, sp = 0u;
    for (;;) {
        sum = 0u; cnt = 0u; mine = 0u;
#pragma unroll
        for (unsigned j = 0; j < 16; ++j) { const unsigned c = xb_ld(&bar[XB_XCNT(j)]); sum += c; cnt += (c > 0u) ? 1u : 0u; mine = (j == x) ? c : mine; }
        if (sum == G) break;
        __builtin_amdgcn_s_sleep(1);
        if ((++sp & 255u) == 0u) { if (xb_ld(&bar[XB_TMO])) break; if (sp > XB_SPIN_CAP) { atomicAdd(&bar[XB_TMO], 1u); break; } }
    }
    nloc = mine > 0u ? mine : 1u; nx = cnt > 0u ? cnt : 1u;
}

__device__ __forceinline__ void xcd_barrier(const XcdBarrier& b) {
    asm volatile("s_waitcnt vmcnt(0)" ::: "memory");
    __syncthreads();
    if (threadIdx.x == 0) {
        unsigned* bar = b.bar;
        __builtin_amdgcn_s_waitcnt(0);
        unsigned nloc = b.st[0], nx = b.st[1];
        if (nloc == 0u) { xcd_barrier_complete(bar, b.x, nloc, nx); b.st[0] = nloc; b.st[1] = nx; }
        const unsigned old = xb_add(&bar[XB_XSUB(b.x)], 1u);
        const unsigned gen = old / nloc;
        if (old + 1u == (gen + 1u) * nloc) {
            __builtin_amdgcn_fence(__ATOMIC_RELEASE, "agent");
            asm volatile("s_waitcnt vmcnt(0)" ::: "memory");
            const unsigned og = xb_add(&bar[XB_TOP], 1u);
            const unsigned tg = og / nx;
            if (og + 1u == (tg + 1u) * nx) xb_add(&bar[XB_TOPGEN], 1u);
            else XB_SPIN(xb_ld(&bar[XB_TOPGEN]) == tg, bar);
            __builtin_amdgcn_fence(__ATOMIC_ACQUIRE, "agent");
            xb_add(&bar[XB_XGEN(b.x)], 1u);
            asm volatile("s_waitcnt vmcnt(0)" ::: "memory");
        } else {
            XB_SPIN(xb_ld(&bar[XB_XGEN(b.x)]) == gen, bar);
            __builtin_amdgcn_fence(__ATOMIC_ACQUIRE, "agent");
            asm volatile("s_waitcnt vmcnt(0)" ::: "memory");
        }
    }
    __syncthreads();
}

__device__ __forceinline__ float wave_sum(float v, int lane) {
#pragma unroll
    for (int o = 1; o < 64; o <<= 1) v += shx(v, o, lane);
    return v;
}
__device__ __forceinline__ void* ldptr(LAS unsigned char* lds, int i) {
    const unsigned long long v = ((const LAS unsigned long long*)(lds + LDSCTL_OFF + 1024))[i];
    const unsigned lo = __builtin_amdgcn_readfirstlane((unsigned)v), hi = __builtin_amdgcn_readfirstlane((unsigned)(v >> 32));
    return (void*)(((unsigned long long)hi << 32) | lo);
}
struct OffsetOrder {
    pg8::StaticOrder S;
    __device__ __forceinline__ void init(int M, int N, int G, int c, int off) { S.init(M, N, G, (c + G - off % G) % G); }
    __device__ __forceinline__ bool next(int i, pg8::Unit& u) const { return S.next(i, u); }
    __device__ __forceinline__ void a_ready(const pg8::Unit&) const {}
    __device__ __forceinline__ void done(const pg8::Unit&) const {}
};

template <bool PERMQKV>
__device__ __forceinline__ void transpose_item(const float* W, int K, int N, bf16* WT, LAS float* scr, int item, int lane, const float* gk = nullptr) {
    const int nblk = N / 32, kb = item / nblk, nb = item % nblk, k0 = 64 * kb, n0 = 32 * nb;
    int d0 = n0;
    if (PERMQKV) { const int within = n0 & 255; d0 = (n0 & ~255) + 128 * ((within >> 5) & 1) + 32 * (within >> 6); }
#pragma unroll
    for (int i = 0; i < 8; ++i) { const int kk = 8 * i + (lane >> 3), nn = 4 * (lane & 7);
        const f32x4 w4 = *(const GAS f32x4*)(W + (size_t)(k0 + kk) * N + n0 + nn) * (gk ? gk[k0 + kk] : 1.f);
        scr[kk * 33 + nn] = w4[0]; scr[kk * 33 + nn + 1] = w4[1]; scr[kk * 33 + nn + 2] = w4[2]; scr[kk * 33 + nn + 3] = w4[3]; }
    LDS_WAIT(); asm volatile("" ::: "memory");
    const int c = lane & 7;
#pragma unroll
    for (int j = 0; j < 4; ++j) { const int n = (lane >> 3) + 8 * j; const LAS float* s = scr + (8 * c) * 33 + n;
        v4u o; o.x = pk2(s[0 * 33], s[1 * 33]); o.y = pk2(s[2 * 33], s[3 * 33]); o.z = pk2(s[4 * 33], s[5 * 33]); o.w = pk2(s[6 * 33], s[7 * 33]);
        *(GAS v4u*)(WT + (size_t)(d0 + n) * K + k0 + 8 * c) = o; }
    LDS_WAIT(); asm volatile("" ::: "memory");
}
__device__ __forceinline__ void convert_bf16(const float* src, bf16* dst, size_t n, size_t gtid, size_t nthreads) {
    for (size_t i = gtid * 8; i < n; i += nthreads * 8) {
        const f32x4 a = *(const GAS f32x4*)(src + i), b = *(const GAS f32x4*)(src + i + 4);
        v4u o; o.x = pk2(a[0], a[1]); o.y = pk2(a[2], a[3]); o.z = pk2(b[0], b[1]); o.w = pk2(b[2], b[3]);
        *(GAS v4u*)(dst + i) = o;
    }
}
__device__ __forceinline__ int t5_bucket(int rel) {
    const int n = rel < 0 ? -rel : rel;
    const int b = n < 8 ? n : n < 12 ? 8 : n < 16 ? 9 : n < 23 ? 10 : n < 32 ? 11 : n < 46 ? 12 : n < 64 ? 13 : n < 91 ? 14 : 15;
    return b + (rel > 0 ? 16 : 0);
}
__constant__ float ROPE_INV[16] = {1.000000000e+00f, 5.623413324e-01f, 3.162277639e-01f, 1.778279394e-01f, 1.000000015e-01f, 5.623413250e-02f, 3.162277490e-02f, 1.778279431e-02f,
                                   9.999999776e-03f, 5.623413250e-03f, 3.162277630e-03f, 1.778279431e-03f, 1.000000047e-03f, 5.623413017e-04f, 3.162277571e-04f, 1.778279402e-04f};

__device__ __forceinline__ void rms_row_to_bf16(const float* xrow, const float* g0, bf16* o0, const float* g1, bf16* o1, int lane) {
    const GAS f32x4* xr = (const GAS f32x4*)xrow + lane;
    f32x4 v[8]; float s = 0.f;
#pragma unroll
    for (int j = 0; j < 8; ++j) { v[j] = xr[64 * j]; s += (v[j].x * v[j].x + v[j].y * v[j].y) + (v[j].z * v[j].z + v[j].w * v[j].w); }
    const float rstd = 1.f / sqrtf(wave_sum(s, lane) * (1.f / DM) + EPS);
    {   const GAS f32x4* gr = (const GAS f32x4*)g0 + lane; GAS v2u* o8 = (GAS v2u*)o0 + lane;
#pragma unroll
        for (int j = 0; j < 8; ++j) { const f32x4 gg = gr[64 * j]; v2u w; w.x = pk2(v[j].x * rstd * gg.x, v[j].y * rstd * gg.y); w.y = pk2(v[j].z * rstd * gg.z, v[j].w * rstd * gg.w); o8[64 * j] = w; } }
    if (g1) { const GAS f32x4* gr = (const GAS f32x4*)g1 + lane; GAS v2u* o8 = (GAS v2u*)o1 + lane;
#pragma unroll
        for (int j = 0; j < 8; ++j) { const f32x4 gg = gr[64 * j]; v2u w; w.x = pk2(v[j].x * rstd * gg.x, v[j].y * rstd * gg.y); w.y = pk2(v[j].z * rstd * gg.z, v[j].w * rstd * gg.w); o8[64 * j] = w; } }
}
__device__ __forceinline__ float wave_max(float v, int lane) {
#pragma unroll
    for (int o = 1; o < 64; o <<= 1) v = fmaxf(v, shx(v, o, lane));
    return v;
}
__device__ __forceinline__ unsigned q8x4(const f32x4 v, const float inv) {
    unsigned w = 0;
    w = __builtin_amdgcn_cvt_pk_u8_f32(__builtin_rintf(__builtin_fmaf(v[0], inv, 128.f)), 0, w); w = __builtin_amdgcn_cvt_pk_u8_f32(__builtin_rintf(__builtin_fmaf(v[1], inv, 128.f)), 1, w);
    w = __builtin_amdgcn_cvt_pk_u8_f32(__builtin_rintf(__builtin_fmaf(v[2], inv, 128.f)), 2, w); w = __builtin_amdgcn_cvt_pk_u8_f32(__builtin_rintf(__builtin_fmaf(v[3], inv, 128.f)), 3, w);
    return w ^ 0x80808080u;
}
__device__ __forceinline__ float amax4(const f32x4 v) { return fmaxf(fmaxf(fabsf(v[0]), fabsf(v[1])), fmaxf(fabsf(v[2]), fabsf(v[3]))); }
__device__ __forceinline__ void quant_wrow(const bf16* src, unsigned char* dst, float* step, int lane) {
    v4u w[4]; float am = 0.f;
#pragma unroll
    for (int j = 0; j < 4; ++j) w[j] = *(const GAS v4u*)(src + 8 * lane + 512 * j);
    f32x4 lo[4], hi[4];
#pragma unroll
    for (int j = 0; j < 4; ++j) { lo[j] = (f32x4){bflo(w[j].x), bfhi(w[j].x), bflo(w[j].y), bfhi(w[j].y)}; hi[j] = (f32x4){bflo(w[j].z), bfhi(w[j].z), bflo(w[j].w), bfhi(w[j].w)}; am = fmaxf(am, fmaxf(amax4(lo[j]), amax4(hi[j]))); }
    am = fmaxf(wave_max(am, lane), 1e-30f);
    const float inv = 127.f / am;
#pragma unroll
    for (int j = 0; j < 4; ++j) *(GAS v2u*)(dst + 8 * lane + 512 * j) = (v2u){q8x4(lo[j], inv), q8x4(hi[j], inv)};
    if (lane == 0) *step = am * (1.f / 127.f);
}
template <int R>
__device__ __forceinline__ void att_quant_rows(const bf16* ATT, const u64_t* mixsq, unsigned char* Q, float* step, int row0, int lane) {
    v4u w[R][4];
#pragma unroll
    for (int q = 0; q < R; ++q)
#pragma unroll
        for (int j = 0; j < 4; ++j) w[q][j] = *(const GAS v4u*)(ATT + (size_t)(row0 + q) * DM + 8 * lane + 512 * j);
#pragma unroll
    for (int q = 0; q < R; ++q) { const int row = row0 + q;
        const float ra = 1.0f / sqrtf((float)*(const GAS u64_t*)(mixsq + row) * (5.9604644775390625e-08f / 768.0f) + EPS), rb = 1.0f / sqrtf((float)*(const GAS u64_t*)(mixsq + T + row) * (5.9604644775390625e-08f / 512.0f) + EPS),
                    rc = 1.0f / sqrtf((float)*(const GAS u64_t*)(mixsq + 2 * (size_t)T + row) * (5.9604644775390625e-08f / 768.0f) + EPS);
        const float rj[4] = {ra, lane < 32 ? ra : rb, lane < 32 ? rb : rc, rc};
        f32x4 lo[4], hi[4]; float am = 0.f;
#pragma unroll
        for (int j = 0; j < 4; ++j) { lo[j] = (f32x4){bflo(w[q][j].x), bfhi(w[q][j].x), bflo(w[q][j].y), bfhi(w[q][j].y)} * rj[j]; hi[j] = (f32x4){bflo(w[q][j].z), bfhi(w[q][j].z), bflo(w[q][j].w), bfhi(w[q][j].w)} * rj[j]; am = fmaxf(am, fmaxf(amax4(lo[j]), amax4(hi[j]))); }
        am = fmaxf(wave_max(am, lane), 1e-30f);
        const float inv = 127.f / am;
#pragma unroll
        for (int j = 0; j < 4; ++j) *(GAS v2u*)(Q + (size_t)row * DM + 8 * lane + 512 * j) = (v2u){q8x4(lo[j], inv), q8x4(hi[j], inv)};
        if (lane == 0) step[row] = am * (1.f / 127.f); }
}
__device__ __forceinline__ void prep_rows2(const float* x0, bf16* o0, u64_t* sq, unsigned char* q0, float* qstep, int lane) {
    f32x4 v[2][8];
#pragma unroll
    for (int q = 0; q < 2; ++q) { const GAS f32x4* xr = (const GAS f32x4*)(x0 + (size_t)q * DM) + lane;
#pragma unroll
        for (int j = 0; j < 8; ++j) v[q][j] = xr[64 * j]; }
#pragma unroll
    for (int q = 0; q < 2; ++q) { GAS v2u* o8 = (GAS v2u*)(o0 + (size_t)q * DM) + lane; float s = 0.f;
#pragma unroll
        for (int j = 0; j < 8; ++j) { const f32x4 a = v[q][j]; s += (a.x * a.x + a.y * a.y) + (a.z * a.z + a.w * a.w); v2u w; w.x = pk2(a.x, a.y); w.y = pk2(a.z, a.w); o8[64 * j] = w; }
        s = wave_sum(s, lane);
        float am = 0.f;
#pragma unroll
        for (int j = 0; j < 8; ++j) am = fmaxf(am, amax4(v[q][j]));
        am = fmaxf(wave_max(am, lane), 1e-30f);
        const float inv = 127.f / am;
#pragma unroll
        for (int j = 0; j < 8; ++j) *(GAS unsigned*)(q0 + (size_t)q * DM + 4 * lane + 256 * j) = q8x4(v[q][j], inv);
        if (lane == 0) { sq[q] = rowsq_fx(s); qstep[q] = am * (1.f / 127.f); } }
}
__device__ __forceinline__ void norm_rows(const float* X, const float* g, bf16* XN, int gw, int NGW, int lane) {
    for (int m = gw; m < T; m += NGW) rms_row_to_bf16(X + (size_t)m * DM, g, XN + (size_t)m * DM, nullptr, nullptr, lane);
}

template <int TYPE>
__device__ __forceinline__ void naive_attn_item(const bf16* QKV, bf16* ATT, int b, int grow, int head, int lane, const float* biasA, const float* sink, const float* rpb) {
    const int tpos = grow * 64 + lane; const size_t trow = (size_t)b * SEQ + tpos;
    int qcol, kcol, vcol, ocol;
    if (TYPE == 0) { qcol = QA + head * 64; kcol = KA + (head / 3) * 64; vcol = VA + (head / 3) * 64; ocol = OA + head * 64; }
    else if (TYPE == 1) { qcol = QB + head * 64; kcol = KB + head * 64; vcol = VB + head * 64; ocol = OB + head * 64; }
    else { qcol = QC + head * 64; kcol = KC + (head / 3) * 64; vcol = VC + (head / 3) * 64; ocol = OC + head * 64; }
    float q[64], o[64];
#pragma unroll
    for (int c = 0; c < 8; ++c) { const v4u w = *(const GAS v4u*)(QKV + trow * DIN + qcol + 8 * c);
        q[8 * c + 0] = bflo(w.x); q[8 * c + 1] = bfhi(w.x); q[8 * c + 2] = bflo(w.y); q[8 * c + 3] = bfhi(w.y); q[8 * c + 4] = bflo(w.z); q[8 * c + 5] = bfhi(w.z); q[8 * c + 6] = bflo(w.w); q[8 * c + 7] = bfhi(w.w); }
#pragma unroll
    for (int d = 0; d < 64; ++d) o[d] = 0.f;
    float m = -1e30f, l = 0.f;
    int j0, j1;
    if (TYPE == 0) { j0 = grow * 64 - 128; if (j0 < 0) j0 = 0; j1 = grow * 64 + 63 + 128; if (j1 > SEQ - 1) j1 = SEQ - 1; }
    else if (TYPE == 1) { int r0 = grow - 4; r0 = r0 < 0 ? 0 : (r0 > 24 ? 24 : r0); j0 = r0 * 64; j1 = j0 + 511; }
    else { j0 = 0; j1 = SEQ - 1; }
    int c0 = lane - 8; c0 = c0 < 0 ? 0 : (c0 > 48 ? 48 : c0);
#pragma unroll 1
    for (int j = j0; j <= j1; ++j) {
        const bf16* krow = QKV + ((size_t)b * SEQ + j) * DIN;
        float s = 0.f;
#pragma unroll
        for (int c = 0; c < 8; ++c) { const v4u w = *(const GAS v4u*)(krow + kcol + 8 * c);
            s += q[8 * c + 0] * bflo(w.x) + q[8 * c + 1] * bfhi(w.x) + q[8 * c + 2] * bflo(w.y) + q[8 * c + 3] * bfhi(w.y) + q[8 * c + 4] * bflo(w.z) + q[8 * c + 5] * bfhi(w.z) + q[8 * c + 6] * bflo(w.w) + q[8 * c + 7] * bfhi(w.w); }
        bool valid = true;
        if (TYPE == 0) { const int rel = j - tpos; valid = (rel >= -128 && rel <= 128); if (valid) s += biasA[head * 257 + rel + 128]; }
        if (TYPE == 1) { const int kr = j >> 6, kc = j & 63; valid = (kc >= c0 && kc < c0 + 16); if (valid) s += rpb[(head * 15 + (kr - grow + 7)) * 31 + (kc - lane + 15)]; }
        const float mn = valid ? fmaxf(m, s) : m;
        const float a = __expf(m - mn);
        const float p = valid ? __expf(s - mn) : 0.f;
        l = l * a + p; m = mn;
#pragma unroll
        for (int c = 0; c < 8; ++c) { const v4u w = *(const GAS v4u*)(krow + vcol + 8 * c);
            o[8 * c + 0] = o[8 * c + 0] * a + p * bflo(w.x); o[8 * c + 1] = o[8 * c + 1] * a + p * bfhi(w.x); o[8 * c + 2] = o[8 * c + 2] * a + p * bflo(w.y); o[8 * c + 3] = o[8 * c + 3] * a + p * bfhi(w.y);
            o[8 * c + 4] = o[8 * c + 4] * a + p * bflo(w.z); o[8 * c + 5] = o[8 * c + 5] * a + p * bfhi(w.z); o[8 * c + 6] = o[8 * c + 6] * a + p * bflo(w.w); o[8 * c + 7] = o[8 * c + 7] * a + p * bfhi(w.w); }
    }
    if (TYPE == 0) l += __expf(sink[head] - m);
    const float inv = 1.f / l;
#pragma unroll
    for (int c = 0; c < 8; ++c) { v4u w; w.x = pk2(o[8 * c + 0] * inv, o[8 * c + 1] * inv); w.y = pk2(o[8 * c + 2] * inv, o[8 * c + 3] * inv); w.z = pk2(o[8 * c + 4] * inv, o[8 * c + 5] * inv); w.w = pk2(o[8 * c + 6] * inv, o[8 * c + 7] * inv);
        *(GAS v4u*)(ATT + trow * DM + ocol + 8 * c) = w; }
}
__device__ __forceinline__ float rdl(float v, int l) { return __builtin_bit_cast(float, __builtin_amdgcn_readlane(__builtin_bit_cast(int, v), l)); }
__device__ __forceinline__ void naive_mem_item(const bf16* QM, const bf16* KVM, bf16* OM, const float* gq, size_t trow, int b, int head, int lane) {
    const unsigned qw = *(const GAS unsigned*)(QM + trow * MEMW + head * 128 + 2 * lane);
    float q0 = bflo(qw), q1 = bfhi(qw);
    const float ss = wave_sum(q0 * q0 + q1 * q1, lane);
    const float r = 0.08838834764831845f / sqrtf(ss * (1.f / 128.f) + EPS);
    q0 *= r * gq[2 * lane]; q1 *= r * gq[2 * lane + 1];
    const bf16* kbase = KVM + ((size_t)b * NMEM + lane) * 1024 + head * 128;
    float s[4] = {0.f, 0.f, 0.f, 0.f};
#pragma unroll 1
    for (int c = 0; c < 16; ++c) {
        float qa[8];
#pragma unroll
        for (int e = 0; e < 4; ++e) { qa[2 * e] = rdl(q0, 4 * c + e); qa[2 * e + 1] = rdl(q1, 4 * c + e); }
#pragma unroll
        for (int i = 0; i < 4; ++i) { const v4u w = *(const GAS v4u*)(kbase + (size_t)i * 64 * 1024 + 8 * c);
            s[i] += qa[0] * bflo(w.x) + qa[1] * bfhi(w.x) + qa[2] * bflo(w.y) + qa[3] * bfhi(w.y) + qa[4] * bflo(w.z) + qa[5] * bfhi(w.z) + qa[6] * bflo(w.w) + qa[7] * bfhi(w.w); }
    }
    float m = fmaxf(fmaxf(s[0], s[1]), fmaxf(s[2], s[3]));
#pragma unroll
    for (int o = 1; o < 64; o <<= 1) m = fmaxf(m, shx(m, o, lane));
    float p[4]; float l = 0.f;
#pragma unroll
    for (int i = 0; i < 4; ++i) { p[i] = __expf(s[i] - m); l += p[i]; }
    l = wave_sum(l, lane);
    const bf16* vbase = KVM + ((size_t)b * NMEM) * 1024 + 512 + head * 128 + 2 * lane;
    float o0 = 0.f, o1 = 0.f;
#pragma unroll
    for (int i = 0; i < 4; ++i) {
#pragma unroll 4
        for (int jj = 0; jj < 64; ++jj) { const float pj = rdl(p[i], jj); const unsigned w = *(const GAS unsigned*)(vbase + (size_t)(64 * i + jj) * 1024); o0 += pj * bflo(w); o1 += pj * bfhi(w); }
    }
    const float inv = 1.f / l;
    *(GAS unsigned*)(OM + trow * MEMW + head * 128 + 2 * lane) = pk2(o0 * inv, o1 * inv);
}
__device__ __forceinline__ void mixnorm_rows(bf16* ATT, const float* g, int gw, int NGW, int lane) {
    for (int m = gw; m < T; m += NGW) {
        GAS v4u* p = (GAS v4u*)(ATT + (size_t)m * DM + 32 * lane);
        v4u w[4]; float f[32]; float ss = 0.f;
#pragma unroll
        for (int c = 0; c < 4; ++c) { w[c] = p[c];
            f[8 * c + 0] = bflo(w[c].x); f[8 * c + 1] = bfhi(w[c].x); f[8 * c + 2] = bflo(w[c].y); f[8 * c + 3] = bfhi(w[c].y); f[8 * c + 4] = bflo(w[c].z); f[8 * c + 5] = bfhi(w[c].z); f[8 * c + 6] = bflo(w[c].w); f[8 * c + 7] = bfhi(w[c].w); }
#pragma unroll
        for (int i = 0; i < 32; ++i) ss += f[i] * f[i];
        const int grp = lane < 24 ? 0 : (lane < 40 ? 1 : 2);
        const float sa = wave_sum(grp == 0 ? ss : 0.f, lane), sb = wave_sum(grp == 1 ? ss : 0.f, lane), sc = wave_sum(grp == 2 ? ss : 0.f, lane);
        const float r = grp == 0 ? 1.f / sqrtf(sa * (1.f / 768.f) + EPS) : (grp == 1 ? 1.f / sqrtf(sb * (1.f / 512.f) + EPS) : 1.f / sqrtf(sc * (1.f / 768.f) + EPS));
        const float* gg = g + 32 * lane;
#pragma unroll
        for (int c = 0; c < 4; ++c) { const f32x4 g0 = *(const GAS f32x4*)(gg + 8 * c), g1 = *(const GAS f32x4*)(gg + 8 * c + 4);
            v4u o; o.x = pk2(f[8 * c + 0] * r * g0[0], f[8 * c + 1] * r * g0[1]); o.y = pk2(f[8 * c + 2] * r * g0[2], f[8 * c + 3] * r * g0[3]);
            o.z = pk2(f[8 * c + 4] * r * g1[0], f[8 * c + 5] * r * g1[1]); o.w = pk2(f[8 * c + 6] * r * g1[2], f[8 * c + 7] * r * g1[3]); p[c] = o; }
    }
}

#ifndef PEER_HD
#define PEER_HD __device__ __forceinline__
#define PEER_EXP(x) __expf(x)
#endif
template <int N> PEER_HD void bitonic_sort_desc(float* v) {
#pragma unroll
    for (int k = 2; k <= N; k <<= 1)
#pragma unroll
        for (int j = k >> 1; j > 0; j >>= 1)
#pragma unroll
            for (int i = 0; i < N; ++i) { const int l = i ^ j; if (l > i) { const bool desc = ((i & k) == 0); const float a = v[i], b = v[l]; const float hi = fmaxf(a, b), lo = fminf(a, b);
                v[i] = desc ? hi : lo; v[l] = desc ? lo : hi; } }
}
PEER_HD void merge_top16(float* a, const float* b) {
    float c[16];
#pragma unroll
    for (int i = 0; i < 16; ++i) c[i] = fmaxf(a[i], b[15 - i]);
#pragma unroll
    for (int j = 8; j > 0; j >>= 1)
#pragma unroll
        for (int i = 0; i < 16; ++i) { const int l = i ^ j; if (l > i) { const float x = c[i], y = c[l]; c[i] = fmaxf(x, y); c[l] = fminf(x, y); } }
#pragma unroll
    for (int i = 0; i < 16; ++i) a[i] = c[i];
}
PEER_HD void top16_of_64(float (&v)[64]) {
    bitonic_sort_desc<16>(&v[0]); bitonic_sort_desc<16>(&v[16]); bitonic_sort_desc<16>(&v[32]); bitonic_sort_desc<16>(&v[48]);
    merge_top16(&v[0], &v[16]); merge_top16(&v[32], &v[48]); merge_top16(&v[0], &v[32]);
}
PEER_HD float pack_idx(float s, unsigned idx, unsigned mask) { return __builtin_bit_cast(float, (__builtin_bit_cast(unsigned, s) & ~mask) | idx); }
PEER_HD unsigned low_bits(float s, unsigned mask) { return __builtin_bit_cast(unsigned, s) & mask; }
PEER_HD unsigned pick16(const float* a, unsigned i, unsigned mask) {
    unsigned r = 0;
#pragma unroll
    for (unsigned k = 0; k < 16; ++k) r = (i == k) ? low_bits(a[k], mask) : r;
    return r;
}
PEER_HD void peer_candidates(const float* a, const float* b, int* e, float* gate) {
    float c[64]; int n = 0;
#pragma unroll
    for (int i = 0; i < 16; ++i)
#pragma unroll
        for (int j = 0; j < 16; ++j) if ((i + 1) * (j + 1) <= 16) { c[n] = pack_idx(a[i] + b[j], (unsigned)(i * 16 + j), 0xffu); ++n; }
#pragma unroll
    for (int k = 50; k < 64; ++k) c[k] = -3.0e38f;
    top16_of_64(c);
    float mx = c[0], den = 0.f;
#pragma unroll
    for (int k = 0; k < 16; ++k) { const unsigned id = low_bits(c[k], 0xffu); const unsigned n0 = pick16(a, id >> 4, 0x7fu), n1 = pick16(b, id & 15u, 0x7fu);
        e[k] = (int)(n0 * 128u + n1); gate[k] = PEER_EXP(c[k] - mx); den += gate[k]; }
    const float inv = 1.f / den;
#pragma unroll
    for (int k = 0; k < 16; ++k) gate[k] *= inv;
}

__device__ __forceinline__ void peer_select_unit(const bf16* QP, const bf16* PK, int* PIDX, float* PGATE, int tb, int h, int wave, int lane) {
    const int hh = lane >> 5, tl = lane & 31; const size_t t = (size_t)tb * 256 + wave * 32 + tl;
    float ab[2][16];
#pragma unroll
    for (int p = 0; p < 2; ++p) {
        bf16x8 bq[8];
#pragma unroll
        for (int s = 0; s < 8; ++s) bq[s] = *(const GAS bf16x8*)(QP + t * DM + 256 * h + 128 * p + 16 * s + 8 * hh);
        float v[64];
#pragma unroll
        for (int nb = 0; nb < 4; ++nb) {
            f32x16 acc;
#pragma unroll
            for (int r = 0; r < 16; ++r) acc[r] = 0.f;
            const bf16* kp = PK + ((size_t)((h * 2 + p) * 128 + 32 * nb + tl)) * 128 + 8 * hh;
            bf16x8 ak[8];
#pragma unroll
            for (int s = 0; s < 8; ++s) ak[s] = *(const GAS bf16x8*)(kp + 16 * s);
#pragma unroll
            for (int s = 0; s < 8; ++s) acc = __builtin_amdgcn_mfma_f32_32x32x16_bf16(ak[s], bq[s], acc, 0, 0, 0);
#pragma unroll
            for (int r = 0; r < 16; ++r) v[16 * nb + r] = pack_idx(acc[r], (unsigned)(32 * nb + 8 * (r >> 2) + 4 * hh + (r & 3)), 0x7fu);
        }
        top16_of_64(v);
        float pv[16];
#pragma unroll
        for (int i = 0; i < 16; ++i) pv[i] = shx(v[i], 32, lane);
        merge_top16(&v[0], pv);
#pragma unroll
        for (int i = 0; i < 16; ++i) ab[p][i] = v[i];
    }
    int e[16]; float gate[16];
    peer_candidates(ab[0], ab[1], e, gate);
    if (hh == 0) { GAS v4u* o = (GAS v4u*)(PIDX + t * 128 + h * 16);
#pragma unroll
        for (int c = 0; c < 4; ++c) o[c] = (v4u){(unsigned)e[4 * c], (unsigned)e[4 * c + 1], (unsigned)e[4 * c + 2], (unsigned)e[4 * c + 3]}; }
    else { GAS f32x4* o = (GAS f32x4*)(PGATE + t * 128 + h * 16);
#pragma unroll
        for (int c = 0; c < 4; ++c) o[c] = (f32x4){gate[4 * c], gate[4 * c + 1], gate[4 * c + 2], gate[4 * c + 3]}; }
}

typedef float f32x2 __attribute__((ext_vector_type(2)));
typedef unsigned v6u __attribute__((ext_vector_type(6)));
typedef float v32f __attribute__((ext_vector_type(32)));
typedef v4u __attribute__((aligned(8))) v4u_a8;
constexpr float PU_SCALE6 = 90.0f, PV_SCALE6 = 5.65f;
__device__ __forceinline__ unsigned enc_e2m3(float v) {
    const float a = fminf(fabsf(v), 7.5f);
    unsigned code;
    if (a < 1.0f) code = (unsigned)__builtin_rintf(a * 8.f);
    else { const unsigned b = __builtin_bit_cast(unsigned, a) - 0x3F800000u; code = ((b + 0x7FFFFu + ((b >> 20) & 1u)) >> 20) + 8u; }
    return code | (v < 0.f ? 32u : 0u);
}
__device__ __forceinline__ void convert_fp6_rows(const float* src, unsigned char* dst, int nrows, float scale, const float* gain, int gw, int NGW, int lane) {
    for (int r = gw; r < nrows; r += NGW) {
        const float* sp = src + (size_t)r * DM + 4 * lane; const float* gp = gain ? gain + (size_t)(r / PEER_N) * DM + 4 * lane : nullptr;
        unsigned w[6] = {0u, 0u, 0u, 0u, 0u, 0u};
#pragma unroll
        for (int j = 0; j < 8; ++j) { f32x4 a = *(const GAS f32x4*)(sp + 256 * j) * scale; if (gp) a = a * *(const GAS f32x4*)(gp + 256 * j);
#pragma unroll
            for (int e = 0; e < 4; ++e) { const unsigned code = enc_e2m3(a[e]); const int bp = 6 * (4 * j + e), wi = bp >> 5, sh = bp & 31;
                w[wi] |= code << sh; if (sh > 26) w[wi + 1] |= code >> (32 - sh); } }
        unsigned char* dp = dst + (size_t)r * 1536 + 24 * lane;
        *(GAS v4u_a8*)dp = (v4u){w[0], w[1], w[2], w[3]}; *(GAS v2u*)(dp + 16) = (v2u){w[4], w[5]};
    }
}
constexpr float PV_SCALE4 = 5.65f, PU_SCALE4 = 90.0f;
__device__ __forceinline__ unsigned enc_e2m1(float v) {
    const float a = fabsf(v);
    const unsigned code = a < 0.25f ? 0u : a < 0.75f ? 1u : a < 1.25f ? 2u : a < 1.75f ? 3u : a < 2.5f ? 4u : a < 3.5f ? 5u : a < 5.0f ? 6u : 7u;
    return code | (v < 0.f ? 8u : 0u);
}
__device__ __forceinline__ void convert_fp4_rows(const float* src, unsigned char* dst, int nrows, float scale, const float* gain, int gw, int NGW, int lane) {
    for (int r0 = 2 * gw; r0 < nrows; r0 += 2 * NGW) {
        f32x4 a[2][8];
#pragma unroll
        for (int q = 0; q < 2; ++q) { const float* sp = src + (size_t)(r0 + q) * DM + 4 * lane;
#pragma unroll
            for (int j = 0; j < 8; ++j) a[q][j] = *(const GAS f32x4*)(sp + 256 * j); }
#pragma unroll
        for (int q = 0; q < 2; ++q) { const int r = r0 + q; const float* gp = gain ? gain + (size_t)(r / PEER_N) * DM + 4 * lane : nullptr;
            unsigned w[4] = {0u, 0u, 0u, 0u};
#pragma unroll
            for (int j = 0; j < 8; ++j) { f32x4 v = a[q][j] * scale; if (gp) v = v * *(const GAS f32x4*)(gp + 256 * j);
#pragma unroll
                for (int e = 0; e < 4; ++e) { const int i = 4 * j + e; w[i >> 3] |= enc_e2m1(v[e]) << (4 * (i & 7)); } }
            *(GAS v4u*)(dst + (size_t)r * 1024 + 16 * lane) = (v4u){w[0], w[1], w[2], w[3]}; }
    }
}
#define PG4_LOAD(buf, tab, idlo, idhi, g) do { _Pragma("unroll") for (int i_ = 0; i_ < PG6_R; ++i_) { const int k_ = (g) * PG6_R + i_; \
        const int e_ = __builtin_amdgcn_readlane(k_ < 64 ? idlo : idhi, k_ & 63); buf[i_] = __builtin_amdgcn_raw_buffer_load_b128(tab, (int)voff4, e_ * 1024, 0); } } while (0)
#define PG4_DOT1(buf, i_, dst) do { f32x2 a_ = {0.f, 0.f}; _Pragma("unroll") for (int c_ = 0; c_ < 4; ++c_) { const unsigned u_ = buf[i_][c_]; \
        a_ += __builtin_amdgcn_cvt_scalef32_pk_f32_fp4(u_, 1.0f, 0) * x[4 * c_ + 0]; a_ += __builtin_amdgcn_cvt_scalef32_pk_f32_fp4(u_, 1.0f, 1) * x[4 * c_ + 1]; \
        a_ += __builtin_amdgcn_cvt_scalef32_pk_f32_fp4(u_, 1.0f, 2) * x[4 * c_ + 2]; a_ += __builtin_amdgcn_cvt_scalef32_pk_f32_fp4(u_, 1.0f, 3) * x[4 * c_ + 3]; } dst = a_.x + a_.y; __builtin_amdgcn_sched_barrier(0); } while (0)
#define PG4_DOT(buf, g) do { float p_[8]; _Pragma("unroll") for (int i_ = 0; i_ < 8; ++i_) PG4_DOT1(buf, i_, p_[i_]); \
        float q_[4]; _Pragma("unroll") for (int i_ = 0; i_ < 4; ++i_) { const float keep_ = b5 ? p_[i_ + 4] : p_[i_], send_ = b5 ? p_[i_] : p_[i_ + 4]; q_[i_] = keep_ + shx(send_, 32, lane); } \
        float r_[2]; _Pragma("unroll") for (int i_ = 0; i_ < 2; ++i_) { const float keep_ = b4 ? q_[i_ + 2] : q_[i_], send_ = b4 ? q_[i_] : q_[i_ + 2]; r_[i_] = keep_ + shx(send_, 16, lane); } \
        float s_; { const float keep_ = b3 ? r_[1] : r_[0], send_ = b3 ? r_[0] : r_[1]; s_ = keep_ + shx(send_, 8, lane); } \
        s_ += shx(s_, 4, lane); s_ += shx(s_, 2, lane); s_ += shx(s_, 1, lane); \
        if ((lane & 7) == 0) wl[(g) * 8 + (lane >> 3)] = s_; } while (0)
#define PG4_AXPY(buf, g) do { _Pragma("unroll") for (int i_ = 0; i_ < PG6_R; ++i_) { const float w_ = wl[(g) * PG6_R + i_]; const f32x2 wv_ = {w_, w_}; \
        _Pragma("unroll") for (int c_ = 0; c_ < 4; ++c_) { const unsigned u_ = buf[i_][c_]; \
            y[4 * c_ + 0] += __builtin_amdgcn_cvt_scalef32_pk_f32_fp4(u_, 1.0f, 0) * wv_; y[4 * c_ + 1] += __builtin_amdgcn_cvt_scalef32_pk_f32_fp4(u_, 1.0f, 1) * wv_; \
            y[4 * c_ + 2] += __builtin_amdgcn_cvt_scalef32_pk_f32_fp4(u_, 1.0f, 2) * wv_; y[4 * c_ + 3] += __builtin_amdgcn_cvt_scalef32_pk_f32_fp4(u_, 1.0f, 3) * wv_; } \
        __builtin_amdgcn_sched_barrier(0); } } while (0)
#ifndef PG6_R
#define PG6_R 8
#endif
#define PG6_LOAD(buf, tab, idlo, idhi, g) do { _Pragma("unroll") for (int i_ = 0; i_ < PG6_R; ++i_) { const int k_ = (g) * PG6_R + i_; \
        const int e_ = __builtin_amdgcn_readlane(k_ < 64 ? idlo : idhi, k_ & 63); const unsigned char* rp_ = (tab) + (size_t)(unsigned)e_ * 1536u; \
        const v4u a_ = *(const GAS v4u_a8*)(rp_ + voff); const v2u b_ = *(const GAS v2u*)(rp_ + voff + 16); buf[i_] = (v6u){a_.x, a_.y, a_.z, a_.w, b_.x, b_.y}; } } while (0)
#define PG6_DOT1(buf, i_, dst) do { const v32f f_ = __builtin_amdgcn_cvt_scalef32_pk32_f32_fp6(buf[i_], 1.0f); f32x2 a_ = {0.f, 0.f}; \
        _Pragma("unroll") for (int c_ = 0; c_ < 16; ++c_) a_ += (f32x2){f_[2 * c_], f_[2 * c_ + 1]} * x[c_]; dst = a_.x + a_.y; __builtin_amdgcn_sched_barrier(0); } while (0)
#if PG6_R == 8
#define PG6_DOT(buf, g) do { float p_[8]; _Pragma("unroll") for (int i_ = 0; i_ < 8; ++i_) PG6_DOT1(buf, i_, p_[i_]); \
        float q_[4]; _Pragma("unroll") for (int i_ = 0; i_ < 4; ++i_) { const float keep_ = b5 ? p_[i_ + 4] : p_[i_], send_ = b5 ? p_[i_] : p_[i_ + 4]; q_[i_] = keep_ + shx(send_, 32, lane); } \
        float r_[2]; _Pragma("unroll") for (int i_ = 0; i_ < 2; ++i_) { const float keep_ = b4 ? q_[i_ + 2] : q_[i_], send_ = b4 ? q_[i_] : q_[i_ + 2]; r_[i_] = keep_ + shx(send_, 16, lane); } \
        float s_; { const float keep_ = b3 ? r_[1] : r_[0], send_ = b3 ? r_[0] : r_[1]; s_ = keep_ + shx(send_, 8, lane); } \
        s_ += shx(s_, 4, lane); s_ += shx(s_, 2, lane); s_ += shx(s_, 1, lane); \
        if ((lane & 7) == 0) wl[(g) * 8 + (lane >> 3)] = s_; } while (0)
#else
#define PG6_DOT(buf, g) do { float p_[4]; _Pragma("unroll") for (int i_ = 0; i_ < 4; ++i_) PG6_DOT1(buf, i_, p_[i_]); \
        float r_[2]; _Pragma("unroll") for (int i_ = 0; i_ < 2; ++i_) { const float keep_ = b5 ? p_[i_ + 2] : p_[i_], send_ = b5 ? p_[i_] : p_[i_ + 2]; r_[i_] = keep_ + shx(send_, 32, lane); } \
        float s_; { const float keep_ = b4 ? r_[1] : r_[0], send_ = b4 ? r_[0] : r_[1]; s_ = keep_ + shx(send_, 16, lane); } \
        s_ += shx(s_, 8, lane); s_ += shx(s_, 4, lane); s_ += shx(s_, 2, lane); s_ += shx(s_, 1, lane); \
        if ((lane & 15) == 0) wl[(g) * 4 + (lane >> 4)] = s_; } while (0)
#endif
#define PG6_AXPY(buf, g) do { _Pragma("unroll") for (int i_ = 0; i_ < PG6_R; ++i_) { const float w_ = wl[(g) * PG6_R + i_]; const f32x2 wv_ = {w_, w_}; \
        const v32f f_ = __builtin_amdgcn_cvt_scalef32_pk32_f32_fp6(buf[i_], 1.0f); _Pragma("unroll") for (int c_ = 0; c_ < 16; ++c_) y[c_] += (f32x2){f_[2 * c_], f_[2 * c_ + 1]} * wv_; __builtin_amdgcn_sched_barrier(0); } } while (0)
__device__ __forceinline__ unsigned shxu(unsigned v, int k, int lane) { return (unsigned)__builtin_amdgcn_ds_bpermute((lane ^ k) << 2, (int)v); }
__device__ __forceinline__ void wave_sort128(unsigned& a, unsigned& b, int lane) {
#pragma unroll
    for (int k = 2; k <= 128; k <<= 1) {
#pragma unroll
        for (int j = k >> 1; j > 0; j >>= 1) {
            if (j == 64) { const unsigned lo = a < b ? a : b, hi = a < b ? b : a; a = lo; b = hi; }
            else {
                const unsigned pa = shxu(a, j, lane), pb = shxu(b, j, lane);
                const bool lower = (lane & j) == 0;
                const bool asc_a = (lane & k) == 0, asc_b = ((lane + 64) & k) == 0;
                const bool take_min_a = (lower == asc_a), take_min_b = (lower == asc_b);
                a = take_min_a ? (a < pa ? a : pa) : (a < pa ? pa : a);
                b = take_min_b ? (b < pb ? b : pb) : (b < pb ? pb : b);
            }
        }
    }
}
#ifndef PEER_U_FP4
#define PEER_U_FP4 1
#endif
#if PEER_U_FP4
typedef v4u urow_t;
#define PGU_LOAD PG4_LOAD
#define PGU_DOT PG4_DOT
constexpr float PU_SCALE = PU_SCALE4; constexpr int PU_STRIDE = 1024;
#else
typedef v6u urow_t;
#define PGU_LOAD PG6_LOAD
#define PGU_DOT PG6_DOT
constexpr float PU_SCALE = PU_SCALE6; constexpr int PU_STRIDE = 1536;
#endif
constexpr float PU_SCALEI = 135.0f, PX_SCALEI = 20.0f;
__device__ __forceinline__ void peer_v_pass(bf16* XN, const unsigned char* PV6, const int* PIDX, const float* PGATE, const int* PARTI, float* X, u64_t* rowsq_out, unsigned char* XN8, float* xsc, LAS float* wl, int gw, int NGW, int lane) {
    const unsigned voff4 = 16u * (unsigned)lane, l4 = 4u * (unsigned)lane, l8 = 8u * (unsigned)lane, l16 = 16u * (unsigned)lane;
    constexpr int NG = 128 / PG6_R;
    const __amdgpu_buffer_rsrc_t PVr = __builtin_amdgcn_make_buffer_rsrc((void*)PV6, 0, PEER_N * 1024, 0x00020000);
    for (int t_ = gw; t_ < T; t_ += NGW) {
        int t = t_; asm volatile("" : "+s"(t));
        const char* pidx_t = (const char*)(PIDX + (size_t)t * 128); const char* pgate_t = (const char*)(PGATE + (size_t)t * 128);
        const int idlo = *(const GAS int*)(pidx_t + l4), idhi = *(const GAS int*)(pidx_t + l4 + 256);
        v4u AV[PG6_R], BV[PG6_R];
        PG4_LOAD(AV, PVr, idlo, idhi, 0);
        {
            int s0 = 0, s1 = 0;
#pragma unroll
            for (int sp = 0; sp < 8; ++sp) { const char* pp = (const char*)(PARTI + ((size_t)sp * T + t) * 128); s0 += *(const GAS int*)(pp + l4); s1 += *(const GAS int*)(pp + l4 + 256); }
            const float d0 = (float)s0 * (1.f / (PX_SCALEI * PU_SCALEI)), d1 = (float)s1 * (1.f / (PX_SCALEI * PU_SCALEI));
            const float g0 = *(const GAS float*)(pgate_t + l4), g1 = *(const GAS float*)(pgate_t + l4 + 256);
            const float w0 = g0 * 0.5f * d0 * (1.f + erff(d0 * 0.70710678118654752f)) * (1.f / PV_SCALE4), w1 = g1 * 0.5f * d1 * (1.f + erff(d1 * 0.70710678118654752f)) * (1.f / PV_SCALE4);
            wl[lane] = w0; wl[64 + lane] = w1;
            LDS_WAIT(); asm volatile("" ::: "memory");
        }
        f32x2 y[16];
#pragma unroll
        for (int i = 0; i < 16; ++i) y[i] = (f32x2){0.f, 0.f};
#pragma unroll 1
        for (int g = 0; g < NG; g += 2) {
            PG4_LOAD(BV, PVr, idlo, idhi, g + 1);
            PG4_AXPY(AV, g);
            if (g + 2 < NG) PG4_LOAD(AV, PVr, idlo, idhi, g + 2);
            PG4_AXPY(BV, g + 1);
        }
        {   char* xo = (char*)(X + (size_t)t * DM);
            char* xbo = (char*)(XN + (size_t)t * DM); float ss = 0.f;
#pragma unroll
            for (int j = 0; j < 8; ++j) { const v2u a = *(const GAS v2u*)(xbo + l8 + 512 * j); f32x4 v = (f32x4){bflo(a.x), bfhi(a.x), bflo(a.y), bfhi(a.y)}; v += (f32x4){y[2 * j].x, y[2 * j].y, y[2 * j + 1].x, y[2 * j + 1].y};
                if (X) *(GAS f32x4*)(xo + l16 + 1024 * j) = v;
                y[2 * j] = (f32x2){v[0], v[1]}; y[2 * j + 1] = (f32x2){v[2], v[3]};
                ss += (v[0] * v[0] + v[1] * v[1]) + (v[2] * v[2] + v[3] * v[3]); *(GAS v2u*)(xbo + l8 + 512 * j) = (v2u){pk2(v[0], v[1]), pk2(v[2], v[3])}; }
            if (rowsq_out) { ss = wave_sum(ss, lane); if (lane == 0) rowsq_out[t] = rowsq_fx(ss); }
            if (XN8) {
                float am = 0.f;
#pragma unroll
                for (int j = 0; j < 16; ++j) am = fmaxf(am, fmaxf(fabsf(y[j].x), fabsf(y[j].y)));
                am = fmaxf(wave_max(am, lane), 1e-30f);
                const float inv = 127.f / am; char* qo = (char*)(XN8 + (size_t)t * DM);
#pragma unroll
                for (int j = 0; j < 8; ++j) *(GAS unsigned*)(qo + l4 + 256 * j) = q8x4((f32x4){y[2 * j].x, y[2 * j].y, y[2 * j + 1].x, y[2 * j + 1].y}, inv);
                if (lane == 0) xsc[t] = am * (1.f / 127.f); } }
        LDS_WAIT(); asm volatile("" ::: "memory");
    }
}


__device__ __forceinline__ unsigned enc_i4(float v) { int q = (int)__builtin_rintf(v); q = q < -7 ? -7 : (q > 7 ? 7 : q); return (unsigned)q & 15u; }
__device__ __forceinline__ void convert_int4_plain(const float* src, unsigned char* dst, int nrows, float scale, const float* gain, int gw, int NGW, int lane) {
    for (int r0 = 2 * gw; r0 < nrows; r0 += 2 * NGW) {
        f32x4 a[2][8];
#pragma unroll
        for (int q = 0; q < 2; ++q) { const float* sp = src + (size_t)(r0 + q) * DM + 4 * lane;
#pragma unroll
            for (int j = 0; j < 8; ++j) a[q][j] = *(const GAS f32x4*)(sp + 256 * j); }
#pragma unroll
        for (int q = 0; q < 2; ++q) { const int r = r0 + q; const float* gp = gain ? gain + (size_t)(r / PEER_N) * DM + 4 * lane : nullptr;
#pragma unroll
            for (int j = 0; j < 8; ++j) { f32x4 v = a[q][j] * scale; if (gp) v = v * *(const GAS f32x4*)(gp + 256 * j);
                const unsigned w = enc_i4(v[0]) | (enc_i4(v[1]) << 4) | (enc_i4(v[2]) << 8) | (enc_i4(v[3]) << 12);
                *(GAS unsigned short*)(dst + (size_t)r * 1024 + 128 * j + 2 * lane) = (unsigned short)w; } }
    }
}
__device__ __forceinline__ void peer_xquant_unit(const bf16* XN, const u64_t* rowsq, unsigned* XQH, unsigned* XQL, int tb, int sl, int tid) {
    for (int it = tid; it < 256 * 32; it += NTHREADS) {
        const int t = tb * 256 + (it >> 5), c8 = it & 31;
        const float xs = PX_SCALEI * rowsq_rs(rowsq, t);
        const v4u w = *(const GAS v4u*)(XN + (size_t)t * DM + 256 * sl + 8 * c8);
        const float f[8] = {bflo(w.x), bfhi(w.x), bflo(w.y), bfhi(w.y), bflo(w.z), bfhi(w.z), bflo(w.w), bfhi(w.w)};
        unsigned hi = 0u, lo = 0u;
#pragma unroll
        for (int j = 0; j < 8; ++j) { int q = (int)__builtin_rintf(f[j] * xs); q = q < -119 ? -119 : (q > 119 ? 119 : q);
            const int xl = ((q + 8) & 15) - 8, xh = (q - xl) >> 4;
            hi |= ((unsigned)xh & 15u) << (4 * j); lo |= ((unsigned)xl & 15u) << (4 * j); }
        XQH[(size_t)t * 256 + 32 * sl + c8] = hi; XQL[(size_t)t * 256 + 32 * sl + c8] = lo;
    }
}
#define PI_LOADROWS(buf, tab, ids, i0) do { _Pragma("unroll") for (int i_ = 0; i_ < 8; ++i_) buf[i_] = __builtin_amdgcn_raw_buffer_load_b128(tab, ids[(i0) + i_] * 1024 + (int)soff, 0, 0); } while (0)
#define PI_LOADIDS(ids, t) do { const char* ip_ = (const char*)PIDX + ((size_t)(t) * 128 + 16 * g) * 4; _Pragma("unroll") for (int c_ = 0; c_ < 4; ++c_) { const v4u q_ = *(const GAS v4u*)(ip_ + 16 * c_); \
        ids[4 * c_] = (int)q_.x; ids[4 * c_ + 1] = (int)q_.y; ids[4 * c_ + 2] = (int)q_.z; ids[4 * c_ + 3] = (int)q_.w; } } while (0)
#define PI_UGROUP(buf, i0) do { _Pragma("unroll") for (int i_ = 0; i_ < 8; ++i_) { int ah_ = 0, al_ = 0; \
        _Pragma("unroll") for (int c_ = 0; c_ < 4; ++c_) { ah_ = __builtin_amdgcn_sdot8((int)buf[i_][c_], (int)xh[c_], ah_, false); al_ = __builtin_amdgcn_sdot8((int)buf[i_][c_], (int)xl[c_], al_, false); } \
        int p_ = 16 * ah_ + al_; p_ += __builtin_amdgcn_ds_bpermute((lane ^ 1) << 2, p_); p_ += __builtin_amdgcn_ds_bpermute((lane ^ 2) << 2, p_); p_ += __builtin_amdgcn_ds_bpermute((lane ^ 4) << 2, p_); \
        if (m == (((i0) + i_) >> 1)) { if (((i0) + i_) & 1) keep1 = p_; else keep0 = p_; } } } while (0)
#define PI_LOADROWS16(buf, tab, ids) do { _Pragma("unroll") for (int i_ = 0; i_ < 16; ++i_) buf[i_] = __builtin_amdgcn_raw_buffer_load_b128(tab, ids[i_] * 1024 + (int)soff, 0, 0); } while (0)
#define PI_LOADX(xh_, xl_, t) do { xh_ = *(const GAS v4u*)((const char*)XQH + (size_t)(t) * 1024 + soff); xl_ = *(const GAS v4u*)((const char*)XQL + (size_t)(t) * 1024 + soff); } while (0)
#define PI_COMPUTE16(buf, xh_, xl_, t) do { int keep0 = 0, keep1 = 0; \
        _Pragma("unroll") for (int i_ = 0; i_ < 16; ++i_) { int ah_ = 0, al_ = 0; \
            _Pragma("unroll") for (int c_ = 0; c_ < 4; ++c_) { ah_ = __builtin_amdgcn_sdot8((int)buf[i_][c_], (int)xh_[c_], ah_, false); al_ = __builtin_amdgcn_sdot8((int)buf[i_][c_], (int)xl_[c_], al_, false); } \
            int p_ = 16 * ah_ + al_; p_ += __builtin_amdgcn_update_dpp(0, p_, 0xB1, 0xf, 0xf, true); p_ += __builtin_amdgcn_update_dpp(0, p_, 0x4E, 0xf, 0xf, true); p_ += __builtin_amdgcn_update_dpp(0, p_, 0x141, 0xf, 0xf, true);   \
            if (m == (i_ >> 1)) { if (i_ & 1) keep1 = p_; else keep0 = p_; } } \
        if ((t) < T) *(GAS v2u*)(PARTI + ((size_t)s * T + (t)) * 128 + 2 * lane) = (v2u){(unsigned)keep0, (unsigned)keep1}; } while (0)
__device__ __forceinline__ void peer_u_phase_i4(const unsigned* XQH, const unsigned* XQL, const unsigned char* PU, const int* PIDX, int* PARTI, int bid, int G, int wave, int lane) {
    const int s = bid & 7, nr = (G - s + 7) >> 3, q = (bid >> 3) * NWAVES + wave, stride = nr * NWAVES, g = lane >> 3, m = lane & 7;
    const unsigned soff = 128u * (unsigned)s + 16u * (unsigned)m;
    if (q >= T) return;
    const __amdgpu_buffer_rsrc_t PUr = __builtin_amdgcn_make_buffer_rsrc((void*)PU, 0, PEER_N * 1024, 0x00020000);
#define PI_CL(t) ((t) < T ? (t) : T - 1)
    int I1[16], I2[16]; v4u xh0, xl0, xh1, xl1, xh2, xl2, RA[16], RB[16];
    PI_LOADIDS(I1, q); PI_LOADX(xh0, xl0, q);
    PI_LOADROWS16(RA, PUr, I1);
    PI_LOADIDS(I1, PI_CL(q + stride)); PI_LOADX(xh1, xl1, PI_CL(q + stride));
    for (int t = q; t < T; t += 2 * stride) {
        PI_LOADROWS16(RB, PUr, I1);
        PI_LOADIDS(I2, PI_CL(t + 2 * stride)); PI_LOADX(xh2, xl2, PI_CL(t + 2 * stride));
        PI_COMPUTE16(RA, xh0, xl0, t);
        PI_LOADROWS16(RA, PUr, I2);
        PI_LOADIDS(I1, PI_CL(t + 3 * stride)); PI_LOADX(xh0, xl0, PI_CL(t + 3 * stride));
        PI_COMPUTE16(RB, xh1, xl1, t + stride);
        xh1 = xh0; xl1 = xl0; xh0 = xh2; xl0 = xl2;
    }
#undef PI_CL
}


constexpr float PV_SCALE4S = 5.65f;
__device__ __forceinline__ unsigned enc_e2m1s(float v) {
    const float a = fabsf(v);
    const unsigned code = a < 0.25f ? 0u : a < 0.75f ? 1u : a < 1.25f ? 2u : a < 1.75f ? 3u : a < 2.5f ? 4u : a < 3.5f ? 5u : a < 5.0f ? 6u : 7u;
    return code | (v < 0.f ? 8u : 0u);
}
__device__ __forceinline__ void convert_fp4_plain(const float* src, unsigned char* dst, int nrows, float scale, const float* gain, int gw, int NGW, int lane) {
    for (int r0 = 2 * gw; r0 < nrows; r0 += 2 * NGW) {
        f32x4 a[2][8];
#pragma unroll
        for (int q = 0; q < 2; ++q) { const float* sp = src + (size_t)(r0 + q) * DM + 4 * lane;
#pragma unroll
            for (int j = 0; j < 8; ++j) a[q][j] = *(const GAS f32x4*)(sp + 256 * j); }
#pragma unroll
        for (int q = 0; q < 2; ++q) { const int r = r0 + q; const float* gp = gain ? gain + (size_t)(r / PEER_N) * DM + 4 * lane : nullptr;
#pragma unroll
            for (int j = 0; j < 8; ++j) { f32x4 v = a[q][j] * scale; if (gp) v = v * *(const GAS f32x4*)(gp + 256 * j);
                const unsigned w = enc_e2m1s(v[0]) | (enc_e2m1s(v[1]) << 4) | (enc_e2m1s(v[2]) << 8) | (enc_e2m1s(v[3]) << 12);
                *(GAS unsigned short*)(dst + (size_t)r * 1024 + 128 * j + 2 * lane) = (unsigned short)w; } }
    }
}
#define PVS_LOADMETA(ids, pp, gg, t) do { PI_LOADIDS(ids, t); _Pragma("unroll") for (int sp_ = 0; sp_ < 8; ++sp_) pp[sp_] = *(const GAS v2u*)(PARTI + ((size_t)sp_ * T + (t)) * 128 + 2 * lane); \
        gg = *(const GAS f32x2*)(PGATE + (size_t)(t) * 128 + 2 * lane); } while (0)
#define PVS_COMPUTE16(buf, pp, gg, t) do { float w0, w1; { int s0_ = 0, s1_ = 0; _Pragma("unroll") for (int sp_ = 0; sp_ < 8; ++sp_) { s0_ += (int)pp[sp_].x; s1_ += (int)pp[sp_].y; } \
            const float d0_ = (float)s0_ * (1.f / (PX_SCALEI * PU_SCALEI)), d1_ = (float)s1_ * (1.f / (PX_SCALEI * PU_SCALEI)); \
            w0 = gg.x * 0.5f * d0_ * (1.f + erff(d0_ * 0.70710678118654752f)) * (1.f / PV_SCALE4S); w1 = gg.y * 0.5f * d1_ * (1.f + erff(d1_ * 0.70710678118654752f)) * (1.f / PV_SCALE4S); } \
        f32x2 y[16]; _Pragma("unroll") for (int i_ = 0; i_ < 16; ++i_) y[i_] = (f32x2){0.f, 0.f}; \
        _Pragma("unroll") for (int i_ = 0; i_ < 16; ++i_) { \
            const float w_ = __builtin_bit_cast(float, __builtin_amdgcn_ds_bpermute(((lane & 56) | (i_ >> 1)) << 2, __builtin_bit_cast(int, (i_ & 1) ? w1 : w0))); const f32x2 wv_ = {w_, w_}; \
            _Pragma("unroll") for (int c_ = 0; c_ < 4; ++c_) { const unsigned u_ = buf[i_][c_]; \
                y[4 * c_ + 0] += __builtin_amdgcn_cvt_scalef32_pk_f32_fp4(u_, 1.0f, 0) * wv_; y[4 * c_ + 1] += __builtin_amdgcn_cvt_scalef32_pk_f32_fp4(u_, 1.0f, 1) * wv_; \
                y[4 * c_ + 2] += __builtin_amdgcn_cvt_scalef32_pk_f32_fp4(u_, 1.0f, 2) * wv_; y[4 * c_ + 3] += __builtin_amdgcn_cvt_scalef32_pk_f32_fp4(u_, 1.0f, 3) * wv_; } } \
        {   LAS float* wp_ = yl + g * 288 + m * 36; \
            _Pragma("unroll") for (int c_ = 0; c_ < 8; ++c_) *(LAS f32x4*)(wp_ + 4 * c_) = (f32x4){y[2 * c_].x, y[2 * c_].y, y[2 * c_ + 1].x, y[2 * c_ + 1].y}; \
            LDS_WAIT(); asm volatile("" ::: "memory"); \
            f32x4 acc_ = {0.f, 0.f, 0.f, 0.f}; const LAS float* rp_ = yl + (lane >> 3) * 36 + 4 * (lane & 7); \
            _Pragma("unroll") for (int gg_ = 0; gg_ < 8; ++gg_) acc_ += *(const LAS f32x4*)(rp_ + gg_ * 288); \
            LDS_WAIT(); asm volatile("" ::: "memory"); \
            if ((t) < T) { bf16* xp_ = XN + (size_t)(t) * DM + 256 * s + 4 * lane; const v2u a_ = *(const GAS v2u*)xp_; \
                const f32x4 v_ = (f32x4){bflo(a_.x), bfhi(a_.x), bflo(a_.y), bfhi(a_.y)} + acc_; \
                *(GAS v2u*)xp_ = (v2u){pk2(v_[0], v_[1]), pk2(v_[2], v_[3])}; \
                if (Xout) *(GAS f32x4*)(Xout + (size_t)(t) * DM + 256 * s + 4 * lane) = v_; \
                if (rowsq_out) { const float ss_ = wave_sum((v_[0] * v_[0] + v_[1] * v_[1]) + (v_[2] * v_[2] + v_[3] * v_[3]), lane); if (lane == 0) atomicAdd(rowsq_out + (t), rowsq_fx(ss_)); } } } } while (0)
__device__ __forceinline__ void peer_v_phase_s(bf16* XN, const unsigned char* PV, const int* PIDX, const float* PGATE, const int* PARTI, float* Xout, u64_t* rowsq_out, LAS float* yl, int bid, int G, int wave, int lane) {
    const int s = bid & 7, nr = (G - s + 7) >> 3, q = (bid >> 3) * NWAVES + wave, stride = nr * NWAVES, g = lane >> 3, m = lane & 7;
    const unsigned soff = 128u * (unsigned)s + 16u * (unsigned)m;
    if (q >= T) return;
    const __amdgpu_buffer_rsrc_t PVr = __builtin_amdgcn_make_buffer_rsrc((void*)PV, 0, PEER_N * 1024, 0x00020000);
#define PVS_CL(t) ((t) < T ? (t) : T - 1)
    int I0[16], I1[16]; v2u P0[8], P1[8]; f32x2 G0, G1; v4u RA[16], RB[16];
#define PVS_LOADPG(pp, gg, t) do { _Pragma("unroll") for (int sp_ = 0; sp_ < 8; ++sp_) pp[sp_] = *(const GAS v2u*)(PARTI + ((size_t)sp_ * T + (t)) * 128 + 2 * lane); gg = *(const GAS f32x2*)(PGATE + (size_t)(t) * 128 + 2 * lane); } while (0)
    PI_LOADIDS(I0, q); PVS_LOADPG(P0, G0, q);
    PI_LOADROWS16(RA, PVr, I0);
    PI_LOADIDS(I1, PVS_CL(q + stride)); PVS_LOADPG(P1, G1, PVS_CL(q + stride));
    for (int t = q; t < T; t += 2 * stride) {
        PI_LOADROWS16(RB, PVr, I1);
        PI_LOADIDS(I0, PVS_CL(t + 2 * stride));
        PVS_COMPUTE16(RA, P0, G0, t);
        PVS_LOADPG(P0, G0, PVS_CL(t + 2 * stride));
        PI_LOADROWS16(RA, PVr, I0);
        PI_LOADIDS(I1, PVS_CL(t + 3 * stride));
        PVS_COMPUTE16(RB, P1, G1, t + stride);
        PVS_LOADPG(P1, G1, PVS_CL(t + 3 * stride));
    }
#undef PVS_LOADPG
#undef PVS_CL
}

typedef short s16x4 __attribute__((ext_vector_type(4)));
typedef __attribute__((address_space(3))) const char* lds_cptr;
__device__ __forceinline__ s16x4 vtr(lds_cptr p) { return __builtin_bit_cast(s16x4, __builtin_amdgcn_ds_read_tr16_b64_v4i16((__attribute__((address_space(3))) s16x4*)p)); }
__device__ __forceinline__ unsigned cvtpk(float lo, float hi) { unsigned r; asm("v_cvt_pk_bf16_f32 %0, %1, %2" : "=v"(r) : "v"(lo), "v"(hi)); return r; }
constexpr int AT_K0 = 0, AT_V0 = 16384, AT_TAB = 32768;
constexpr float LOG2E = 1.4426950408889634f;
template <int TYPE>
__device__ __forceinline__ void attn_unit(LAS unsigned char* lds, const bf16* QKV, bf16* ATT, u64_t* mixsq, int b, int head, int qb, const float* tabsrc, float Cl2, float sinkl2, int tid) {
    const int lane = tid & 63, w = __builtin_amdgcn_readfirstlane(tid >> 6), hh = lane >> 5, l31 = lane & 31;
    int qcol, kcol, vcol, ocol;
    if (TYPE == 0) { qcol = QA + head * 64; kcol = KA + (head / 3) * 64; vcol = VA + (head / 3) * 64; ocol = OA + head * 64; }
    else if (TYPE == 1) { qcol = QB + head * 64; kcol = KB + head * 64; vcol = VB + head * 64; ocol = OB + head * 64; }
    else { qcol = QC + head * 64; kcol = KC + (head / 3) * 64; vcol = VC + (head / 3) * 64; ocol = OC + head * 64; }
    const int q0 = 256 * qb + 32 * w, qpos = q0 + l31;
    int t_begin, t_end;
    if (TYPE == 0) { t_begin = 4 * qb - 2; if (t_begin < 0) t_begin = 0; t_end = 4 * qb + 6; if (t_end > 32) t_end = 32; }
    else if (TYPE == 1) { int a = 4 * qb - 4; a = a < 0 ? 0 : (a > 24 ? 24 : a); int e = 4 * qb - 1; e = e < 0 ? 0 : (e > 24 ? 24 : e); t_begin = a; t_end = e + 8; }
    else { t_begin = 0; t_end = 32; }
    LAS float* tab = (LAS float*)(lds + AT_TAB);
    if (TYPE == 0) { for (int i = tid; i < 1024; i += NTHREADS) { const int rel = i - 448; tab[i] = (rel >= -128 && rel <= 128) ? tabsrc[head * 257 + rel + 128] * LOG2E - Cl2 : -1e30f; } }
    if (TYPE == 1) { for (int i = tid; i < 15 * 31; i += NTHREADS) tab[i] = tabsrc[head * 465 + i] * LOG2E - Cl2; }
    bf16x8 qf[4];
    {   const bf16* qp = QKV + ((size_t)b * SEQ + qpos) * DIN + qcol + 8 * hh;
#pragma unroll
        for (int s = 0; s < 4; ++s) qf[s] = *(const GAS bf16x8*)(qp + 16 * s); }
    const int srow = tid >> 3, sch = tid & 7;
    const bf16* kg = QKV + ((size_t)b * SEQ + srow) * DIN + kcol + sch * 8;
    const bf16* vg = QKV + ((size_t)b * SEQ + srow) * DIN + vcol + sch * 8;
    const int kst = srow * 128 + ((sch ^ ((srow >> 1) & 7)) * 16);
    const int vst = srow * 128 + (((sch >> 2) ^ ((srow >> 1) & 1)) * 64) + (sch & 3) * 16;
    int kread[4], vread[2];
#pragma unroll
    for (int s = 0; s < 4; ++s) kread[s] = l31 * 128 + (((2 * s + hh) ^ ((lane >> 1) & 7)) * 16);
#pragma unroll
    for (int db = 0; db < 2; ++db) vread[db] = (4 * hh + ((lane >> 2) & 3)) * 128 + ((db ^ ((lane >> 3) & 1)) * 64) + 32 * ((lane >> 4) & 1) + 8 * (lane & 3);
    f32x16 O0, O1;
#pragma unroll
    for (int r = 0; r < 16; ++r) { O0[r] = 0.f; O1[r] = 0.f; }
    float lsum = 0.f;
    const int rw = 4 * qb + (w >> 1), cq = 32 * (w & 1) + l31;
    int r0w = rw - 4; r0w = r0w < 0 ? 0 : (r0w > 24 ? 24 : r0w);
    int c0 = cq - 8; c0 = c0 < 0 ? 0 : (c0 > 48 ? 48 : c0);
    {   const v4u kr = *(const GAS v4u*)(kg + (size_t)t_begin * 64 * DIN), vr = *(const GAS v4u*)(vg + (size_t)t_begin * 64 * DIN);
        *(LAS v4u*)(lds + AT_K0 + kst) = kr; *(LAS v4u*)(lds + AT_V0 + vst) = vr; }
    __syncthreads();
    for (int t = t_begin; t < t_end; ++t) {
        const int cur = (t - t_begin) & 1;
        v4u kr, vr;
        if (t + 1 < t_end) { kr = *(const GAS v4u*)(kg + (size_t)(t + 1) * 64 * DIN); vr = *(const GAS v4u*)(vg + (size_t)(t + 1) * 64 * DIN); }
        bool need = true;
        if (TYPE == 0) need = (64 * t <= q0 + 31 + 128) && (64 * t + 63 >= q0 - 128);
        if (TYPE == 1) need = (t >= r0w) && (t < r0w + 8);
        if (need) {
            const lds_cptr kb_ = (lds_cptr)(lds + AT_K0 + cur * 8192), vb_ = (lds_cptr)(lds + AT_V0 + cur * 8192);
            bf16x8 kf[8];
#pragma unroll
            for (int s = 0; s < 4; ++s) { kf[2 * s] = *(const LAS bf16x8*)(kb_ + kread[s]); kf[2 * s + 1] = *(const LAS bf16x8*)(kb_ + kread[s] + 4096); }
            f32x16 S0, S1;
            if (TYPE == 2) {
#pragma unroll
                for (int r = 0; r < 16; ++r) { S0[r] = -Cl2; S1[r] = -Cl2; }
            } else if (TYPE == 0) {
                const LAS float* tb = tab + (64 * t - qpos + 448 + 4 * hh);
#pragma unroll
                for (int r = 0; r < 16; ++r) { S0[r] = tb[8 * (r >> 2) + (r & 3)]; S1[r] = tb[32 + 8 * (r >> 2) + (r & 3)]; }
            } else {
                const LAS float* tb = tab + ((t - rw + 7) * 31 - cq + 15 + 4 * hh);
                const int kc0 = 4 * hh - c0;
#pragma unroll
                for (int r = 0; r < 16; ++r) { const int ka = 8 * (r >> 2) + (r & 3), kb2 = 32 + ka;
                    S0[r] = ((unsigned)(ka + kc0) < 16u) ? tb[ka] : -1e30f; S1[r] = ((unsigned)(kb2 + kc0) < 16u) ? tb[kb2] : -1e30f; }
            }
            __builtin_amdgcn_sched_barrier(0);
#pragma unroll
            for (int s = 0; s < 4; ++s) { S0 = __builtin_amdgcn_mfma_f32_32x32x16_bf16(kf[2 * s], qf[s], S0, 0, 0, 0); S1 = __builtin_amdgcn_mfma_f32_32x32x16_bf16(kf[2 * s + 1], qf[s], S1, 0, 0, 0); }
            s16x4 vf[4][2][2];
#pragma unroll
            for (int ks = 0; ks < 2; ++ks)
#pragma unroll
                for (int db = 0; db < 2; ++db) { vf[ks][db][0] = vtr(vb_ + vread[db] + (16 * ks) * 128); vf[ks][db][1] = vtr(vb_ + vread[db] + (16 * ks + 8) * 128); }
            __builtin_amdgcn_sched_barrier(0);
#pragma unroll
            for (int r = 0; r < 16; ++r) { S0[r] = __builtin_amdgcn_exp2f(S0[r]); S1[r] = __builtin_amdgcn_exp2f(S1[r]); }
#pragma unroll
            for (int r = 0; r < 16; ++r) lsum += S0[r] + S1[r];
            bf16x8 pb[4];
#pragma unroll
            for (int hf = 0; hf < 2; ++hf) {
                v4u a, c;
#pragma unroll
                for (int j = 0; j < 4; ++j) { a[j] = cvtpk(S0[8 * hf + 2 * j], S0[8 * hf + 2 * j + 1]); c[j] = cvtpk(S1[8 * hf + 2 * j], S1[8 * hf + 2 * j + 1]); }
                pb[hf] = __builtin_bit_cast(bf16x8, a); pb[2 + hf] = __builtin_bit_cast(bf16x8, c);
            }
#pragma unroll
            for (int ks = 2; ks < 4; ++ks)
#pragma unroll
                for (int db = 0; db < 2; ++db) { vf[ks][db][0] = vtr(vb_ + vread[db] + (16 * ks) * 128); vf[ks][db][1] = vtr(vb_ + vread[db] + (16 * ks + 8) * 128); }
            __builtin_amdgcn_sched_barrier(0);
#pragma unroll
            for (int ks = 0; ks < 4; ++ks) {
                const bf16x8 va = __builtin_shufflevector(vf[ks][0][0], vf[ks][0][1], 0, 1, 2, 3, 4, 5, 6, 7), vb2 = __builtin_shufflevector(vf[ks][1][0], vf[ks][1][1], 0, 1, 2, 3, 4, 5, 6, 7);
                O0 = __builtin_amdgcn_mfma_f32_32x32x16_bf16(va, pb[ks], O0, 0, 0, 0); O1 = __builtin_amdgcn_mfma_f32_32x32x16_bf16(vb2, pb[ks], O1, 0, 0, 0);
            }
        }
        __builtin_amdgcn_sched_barrier(0);
        if (t + 1 < t_end) { *(LAS v4u*)(lds + AT_K0 + (cur ^ 1) * 8192 + kst) = kr; *(LAS v4u*)(lds + AT_V0 + (cur ^ 1) * 8192 + vst) = vr; }
        __syncthreads();
    }
    lsum += shx(lsum, 32, lane);
    if (TYPE == 0) lsum += __builtin_amdgcn_exp2f(sinkl2 - Cl2);
    const float inv = 1.f / lsum;
    {   float ss = 0.f;
#pragma unroll
        for (int r = 0; r < 16; ++r) { const float a = O0[r] * inv, c = O1[r] * inv; ss += a * a + c * c; }
        ss += shx(ss, 32, lane);
        if (hh == 0) (void)__hip_atomic_fetch_add((GAS u64_t*)(mixsq + (size_t)b * SEQ + qpos), rowsq_fx(ss), __ATOMIC_RELAXED, __HIP_MEMORY_SCOPE_AGENT); }
    bf16* op = ATT + ((size_t)b * SEQ + qpos) * DM + ocol + 4 * hh;
#pragma unroll
    for (int g4 = 0; g4 < 4; ++g4) {
        v2u o0, o1; o0.x = cvtpk(O0[4 * g4] * inv, O0[4 * g4 + 1] * inv); o0.y = cvtpk(O0[4 * g4 + 2] * inv, O0[4 * g4 + 3] * inv);
        o1.x = cvtpk(O1[4 * g4] * inv, O1[4 * g4 + 1] * inv); o1.y = cvtpk(O1[4 * g4 + 2] * inv, O1[4 * g4 + 3] * inv);
        *(GAS v2u*)(op + 8 * g4) = o0; *(GAS v2u*)(op + 32 + 8 * g4) = o1;
    }
}


constexpr int MA_K0 = 0, MA_V0 = 32768;
__device__ __forceinline__ void mem_unit(LAS unsigned char* lds, const bf16* QM, const bf16* KVM, bf16* OM, const float* gq, int tb, int head, float Cl2, int tid) {
    const int lane = tid & 63, w = __builtin_amdgcn_readfirstlane(tid >> 6), hh = lane >> 5, l31 = lane & 31;
    const size_t trow = (size_t)tb * 256 + 32 * w + l31; const int b = tb >> 3;
    bf16x8 qf[8];
    {   const bf16* qp = QM + trow * MEMW + head * 128 + 8 * hh;
#pragma unroll
        for (int s = 0; s < 8; ++s) qf[s] = *(const GAS bf16x8*)(qp + 16 * s);
        float ss = 0.f;
#pragma unroll
        for (int s = 0; s < 8; ++s)
#pragma unroll
            for (int j = 0; j < 8; ++j) { const float f = __builtin_bit_cast(float, (unsigned)(unsigned short)qf[s][j] << 16); ss += f * f; }
        ss += shx(ss, 32, lane);
        const float r = 0.12751743074602468f / sqrtf(ss * (1.f / 128.f) + EPS);
#pragma unroll
        for (int s = 0; s < 8; ++s) { const f32x4 g0 = *(const GAS f32x4*)(gq + 16 * s + 8 * hh), g1 = *(const GAS f32x4*)(gq + 16 * s + 8 * hh + 4);
            v4u o;
#pragma unroll
            for (int j = 0; j < 4; ++j) { const float f0 = __builtin_bit_cast(float, (unsigned)(unsigned short)qf[s][2 * j] << 16), f1 = __builtin_bit_cast(float, (unsigned)(unsigned short)qf[s][2 * j + 1] << 16);
                const float ga = (2 * j < 4) ? g0[2 * j] : g1[2 * j - 4], gb2 = (2 * j + 1 < 4) ? g0[2 * j + 1] : g1[2 * j + 1 - 4];
                o[j] = cvtpk(f0 * r * ga, f1 * r * gb2); }
            qf[s] = __builtin_bit_cast(bf16x8, o); }
    }
    const int srow = tid >> 3, sch = tid & 7;
    const bf16* kg = KVM + ((size_t)b * NMEM + srow) * 1024 + head * 128 + sch * 8;
    const bf16* vg = kg + 512;
    const int kst0 = srow * 256 + ((sch ^ (srow & 15)) * 16), kst1 = srow * 256 + (((sch + 8) ^ (srow & 15)) * 16);
    const int vst0 = srow * 256 + ((((sch) >> 2) ^ (srow & 3)) * 64) + (sch & 3) * 16, vst1 = srow * 256 + ((((sch + 8) >> 2) ^ (srow & 3)) * 64) + (sch & 3) * 16;
    int kread[8], vread[4];
#pragma unroll
    for (int s = 0; s < 8; ++s) kread[s] = l31 * 256 + (((2 * s + hh) ^ (l31 & 15)) * 16);
#pragma unroll
    for (int db = 0; db < 4; ++db) vread[db] = (4 * hh + ((lane >> 2) & 3)) * 256 + ((db ^ ((lane >> 2) & 3)) * 64) + 32 * ((lane >> 4) & 1) + 8 * (lane & 3);
    f32x16 O[4];
#pragma unroll
    for (int db = 0; db < 4; ++db)
#pragma unroll
        for (int r = 0; r < 16; ++r) O[db][r] = 0.f;
    float lsum = 0.f;
    {   const v4u k0 = *(const GAS v4u*)kg, k1 = *(const GAS v4u*)(kg + 64), v0 = *(const GAS v4u*)vg, v1 = *(const GAS v4u*)(vg + 64);
        *(LAS v4u*)(lds + MA_K0 + kst0) = k0; *(LAS v4u*)(lds + MA_K0 + kst1) = k1; *(LAS v4u*)(lds + MA_V0 + vst0) = v0; *(LAS v4u*)(lds + MA_V0 + vst1) = v1; }
    __syncthreads();
#pragma unroll 1
    for (int t = 0; t < 4; ++t) {
        const int cur = t & 1;
        v4u k0, k1, v0, v1;
        if (t + 1 < 4) { const bf16* kn = kg + (size_t)(t + 1) * 64 * 1024; k0 = *(const GAS v4u*)kn; k1 = *(const GAS v4u*)(kn + 64); v0 = *(const GAS v4u*)(kn + 512); v1 = *(const GAS v4u*)(kn + 576); }
        const lds_cptr kb_ = (lds_cptr)(lds + MA_K0 + cur * 16384), vb_ = (lds_cptr)(lds + MA_V0 + cur * 16384);
        f32x16 S0, S1;
#pragma unroll
        for (int r = 0; r < 16; ++r) { S0[r] = -Cl2; S1[r] = -Cl2; }
#pragma unroll
        for (int s = 0; s < 8; ++s) { const bf16x8 a0 = *(const LAS bf16x8*)(kb_ + kread[s]), a1 = *(const LAS bf16x8*)(kb_ + kread[s] + 8192);
            S0 = __builtin_amdgcn_mfma_f32_32x32x16_bf16(a0, qf[s], S0, 0, 0, 0); S1 = __builtin_amdgcn_mfma_f32_32x32x16_bf16(a1, qf[s], S1, 0, 0, 0); }
#pragma unroll
        for (int r = 0; r < 16; ++r) { S0[r] = __builtin_amdgcn_exp2f(S0[r]); S1[r] = __builtin_amdgcn_exp2f(S1[r]); lsum += S0[r] + S1[r]; }
        bf16x8 pb[4];
#pragma unroll
        for (int hf = 0; hf < 2; ++hf) {
            v4u a, c;
#pragma unroll
            for (int j = 0; j < 4; ++j) { a[j] = cvtpk(S0[8 * hf + 2 * j], S0[8 * hf + 2 * j + 1]); c[j] = cvtpk(S1[8 * hf + 2 * j], S1[8 * hf + 2 * j + 1]); }
            pb[hf] = __builtin_bit_cast(bf16x8, a); pb[2 + hf] = __builtin_bit_cast(bf16x8, c);
        }
#pragma unroll
        for (int ks = 0; ks < 4; ++ks)
#pragma unroll
            for (int db = 0; db < 4; ++db) {
                const s16x4 a0 = vtr(vb_ + vread[db] + (16 * ks) * 256), a1 = vtr(vb_ + vread[db] + (16 * ks + 8) * 256);
                const bf16x8 va = __builtin_shufflevector(a0, a1, 0, 1, 2, 3, 4, 5, 6, 7);
                O[db] = __builtin_amdgcn_mfma_f32_32x32x16_bf16(va, pb[ks], O[db], 0, 0, 0);
            }
        if (t + 1 < 4) { LAS unsigned char* kn = lds + MA_K0 + (cur ^ 1) * 16384; LAS unsigned char* vn = lds + MA_V0 + (cur ^ 1) * 16384;
            *(LAS v4u*)(kn + kst0) = k0; *(LAS v4u*)(kn + kst1) = k1; *(LAS v4u*)(vn + vst0) = v0; *(LAS v4u*)(vn + vst1) = v1; }
        __syncthreads();
    }
    lsum += shx(lsum, 32, lane);
    const float inv = 1.f / lsum;
    bf16* op = OM + trow * MEMW + head * 128 + 4 * hh;
#pragma unroll
    for (int db = 0; db < 4; ++db)
#pragma unroll
        for (int g4 = 0; g4 < 4; ++g4) { v2u o; o.x = cvtpk(O[db][4 * g4] * inv, O[db][4 * g4 + 1] * inv); o.y = cvtpk(O[db][4 * g4 + 2] * inv, O[db][4 * g4 + 3] * inv); *(GAS v2u*)(op + 32 * db + 8 * g4) = o; }
}

struct Args { const float* in[23]; float* out; unsigned char* ws; int ph_lo, ph_hi, use_bar, pad; };
#ifndef MK_OFF
#define MK_OFF 0u
#endif
#ifndef REP_ATT
#define REP_ATT 1
#endif
#ifndef REP_P0
#define REP_P0 1
#endif
#ifndef REP_U
#define REP_U 1
#endif
#ifndef REP_GEMM
#define REP_GEMM 1
#endif
#ifndef REP_NORM
#define REP_NORM 1
#endif
#ifndef REP_SEL
#define REP_SEL 1
#endif
#ifndef REP_MEM
#define REP_MEM 1
#endif
#define PHON(k) (!((MK_OFF >> (k)) & 1u))
constexpr int PH_PER_LAYER = 9, PH_BASE = 2, N_PHASES = PH_BASE + DEPTH * PH_PER_LAYER;
constexpr int PTAB_OFF = LDSCTL_OFF + 1024;

__global__ void __launch_bounds__(NTHREADS, 2) mega(Args a) {
    extern __shared__ __attribute__((aligned(16))) unsigned char lds_raw[];
    LAS unsigned char* lds = (LAS unsigned char*)lds_raw;
    {   const int tid0 = threadIdx.x;
        for (int u = tid0; u < (LDS_BYTES - LDSCTL_OFF) / 4; u += NTHREADS) ((LAS unsigned*)(lds + LDSCTL_OFF))[u] = 0u;
        __syncthreads();
        if (tid0 < 23) ((LAS unsigned long long*)(lds + PTAB_OFF))[tid0] = (unsigned long long)a.in[tid0];
        if (tid0 == 23) ((LAS unsigned long long*)(lds + PTAB_OFF))[23] = (unsigned long long)a.out;
        if (tid0 == 24) ((LAS unsigned long long*)(lds + PTAB_OFF))[24] = (unsigned long long)a.ws;
        __syncthreads();
    }
    volatile LAS unsigned* MISC = (volatile LAS unsigned*)(lds + MISC_OFF);
    const int G = gridDim.x, bid = blockIdx.x, NGW = G * NWAVES;
    const int use_bar = a.use_bar;
    XcdBarrier bar; bar.bar = (unsigned*)(a.ws + WS_CTL) + CW_BAR; bar.x = 0; bar.st = MISC + 8;
    if (use_bar) bar = xcd_barrier_post((unsigned*)(a.ws + WS_CTL) + CW_BAR, MISC + 8);
    const int lo = a.ph_lo, hi = a.ph_hi;
#define IN(k) (lo <= (k) && (k) < hi)
#define SEAM(k) do { if (use_bar && IN(k) && IN((k) + 1)) xcd_barrier(bar); } while (0)
#define PHL() int tid_ = threadIdx.x; asm volatile("" : "+v"(tid_)); const int lane_ = tid_ & 63, wave_ = __builtin_amdgcn_readfirstlane(tid_ >> 6), gw_ = bid * NWAVES + wave_; (void)lane_; (void)gw_; \
              int pz_ = 0; asm volatile("" : "+s"(pz_))
#define PTR(i) ((const float*)ldptr(lds, (i) + pz_))
#define WSP() ((unsigned char*)ldptr(lds, 24 + pz_))
#define OUTP() ((float*)ldptr(lds, 23 + pz_))

    if (IN(0) && PHON(0)) {
        PHL(); unsigned char* ws = WSP();
        LAS float* scr = (LAS float*)(lds + RING_OFF + wave_ * 16384);
        constexpr int I_IN = 32 * 128, I_OUT = 32 * 64, I_MQ = 32 * 16, I_MKV = 32 * 32, I_MO = 8 * 64, I_PQ = 32 * 64, I_L = I_IN + I_OUT + I_MQ + I_MKV + I_MO + I_PQ;
        for (int it = gw_; it < DEPTH * I_L; it += NGW) {
            const int l = it / I_L; int r = it % I_L;
            if (r < I_IN) { transpose_item<true>(PTR(4) + (size_t)l * DM * DIN, DM, DIN, (bf16*)(ws + WS_WIN) + (size_t)l * DIN * DM, scr, r, lane_, PTR(3) + (size_t)l * DM); continue; } r -= I_IN;
            if (r < I_OUT) { transpose_item<false>(PTR(11) + (size_t)l * DM * DM, DM, DM, (bf16*)(ws + WS_WOUT) + (size_t)l * DM * DM, scr, r, lane_, PTR(10) + (size_t)l * DM); continue; } r -= I_OUT;
            if (r < I_MQ) { transpose_item<false>(PTR(14) + (size_t)l * DM * MEMW, DM, MEMW, (bf16*)(ws + WS_WMQ) + (size_t)l * MEMW * DM, scr, r, lane_, PTR(12) + (size_t)l * DM); continue; } r -= I_MQ;
            if (r < I_MKV) { transpose_item<false>(PTR(15) + (size_t)l * DM * 1024, DM, 1024, (bf16*)(ws + WS_WMKV) + (size_t)l * 1024 * DM, scr, r, lane_); continue; } r -= I_MKV;
            if (r < I_MO) { transpose_item<false>(PTR(17) + (size_t)l * MEMW * DM, MEMW, DM, (bf16*)(ws + WS_WMO) + (size_t)l * DM * MEMW, scr, r, lane_); continue; } r -= I_MO;
            transpose_item<false>(PTR(19) + (size_t)l * DM * DM, DM, DM, (bf16*)(ws + WS_WPQ) + (size_t)l * DM * DM, scr, r, lane_, PTR(18) + (size_t)l * DM);
        }
        const size_t gtid = (size_t)bid * NTHREADS + tid_, nth = (size_t)G * NTHREADS;
        convert_bf16(PTR(20), (bf16*)(ws + WS_PKEYS), (size_t)DEPTH * 8 * 2 * 128 * 128, gtid, nth);
        convert_int4_plain(PTR(21), ws + WS_PU, DEPTH * PEER_N, PU_SCALEI, PTR(18), gw_, NGW, lane_);
        convert_fp4_rows(PTR(22), ws + WS_PV, PEER_N, PV_SCALE4, nullptr, gw_, NGW, lane_);
        {   const float* x0 = PTR(0); bf16* XN = (bf16*)(ws + WS_XN); u64_t* rsq = (u64_t*)(ws + WS_ROWSQ);
            for (int m = 2 * gw_; m < T; m += 2 * NGW) prep_rows2(x0 + (size_t)m * DM, XN + (size_t)m * DM, rsq + m, ws + WS_XN8 + (size_t)m * DM, (float*)(ws + WS_XSC) + m, lane_); }
        {   const float* mem = PTR(1); const float* gkv = PTR(13); bf16* MEMN = (bf16*)(ws + WS_MEMN);
            for (int m = gw_; m < BATCH * NMEM; m += NGW)
                rms_row_to_bf16(mem + (size_t)m * DM, gkv, MEMN + (size_t)m * DM, gkv + DM, MEMN + (size_t)(BATCH * NMEM + m) * DM, lane_); }
        float* rope = (float*)(ws + WS_ROPE); float* biasA = (float*)(ws + WS_BIASA);
        if (gtid < 64 * 16) { const int pos = (int)gtid >> 4, i = (int)gtid & 15; const float ang = (float)pos * ROPE_INV[i]; rope[gtid * 2] = cosf(ang); rope[gtid * 2 + 1] = sinf(ang); }
        if (gtid < 12 * 257) { const int h = (int)gtid / 257, rel = (int)gtid % 257 - 128; biasA[gtid] = PTR(2)[t5_bucket(rel) * 12 + h]; }
    }
    SEAM(0);
    if (IN(1) && PHON(1)) {
        {   PHL(); unsigned char* ws = WSP();
            for (int r = gw_; r < DEPTH * DIN; r += NGW) { const int rr = r & (DIN - 1), src = (rr & ~255) + 64 * ((rr >> 5) & 3) + 32 * ((rr >> 7) & 1) + (rr & 31);
                quant_wrow((const bf16*)(ws + WS_WIN) + (size_t)r * DM, ws + WS_WIN8 + (size_t)r * DM, (float*)(ws + WS_WSC) + (r & ~(DIN - 1)) + src, lane_); }
            for (int r = gw_; r < DEPTH * DM; r += NGW) quant_wrow((const bf16*)(ws + WS_WOUT) + (size_t)r * DM, ws + WS_WOUT8 + (size_t)r * DM, (float*)(ws + WS_WSCO) + r, lane_);
            for (int r = gw_; r < DEPTH * DM; r += NGW) quant_wrow((const bf16*)(ws + WS_WPQ) + (size_t)r * DM, ws + WS_WPQ8 + (size_t)r * DM, (float*)(ws + WS_WSCP) + r, lane_);
            for (int r = gw_; r < DEPTH * MEMW; r += NGW) quant_wrow((const bf16*)(ws + WS_WMQ) + (size_t)r * DM, ws + WS_WMQ8 + (size_t)r * DM, (float*)(ws + WS_WSCM) + r, lane_); }
#pragma unroll 1
        for (int l = 0; l < DEPTH; ++l) {
            PHL(); unsigned char* ws = WSP();
            pg8::Gemm g{(bf16*)(ws + WS_MEMN) + (size_t)l * BATCH * NMEM * DM, (bf16*)(ws + WS_WMKV) + (size_t)l * 1024 * DM, BATCH * NMEM, 1024, DM};
            OffsetOrder S; S.init(BATCH * NMEM, 1024, G, bid, 64 * l);
            bf16* KVMl = (bf16*)(ws + WS_KVM) + (size_t)l * BATCH * NMEM * 1024;
            pg8::EpiBf16<0> E{KVMl, 1024, nullptr, 0, 0, 1.f};
            pg8::gemm_phase<pg8::EpiBf16<0>, OffsetOrder, true, true>(lds + RING_OFF, g, S, E, tid_);
            VM_WAIT(); __syncthreads();
            const float* gk = PTR(16) + (size_t)l * 256 + 128;
#pragma unroll 1
            for (int i = 0; i < 4; ++i) { pg8::Unit uu; uu.pm = 0; uu.pn = 0; if (!S.next(i, uu)) break;
                if (uu.pn < 2) {
                    for (int r2 = wave_; r2 < 128; r2 += NWAVES) { const int row = uu.pm * 256 + 2 * r2 + (lane_ >> 5), cl = lane_ & 31;
                        GAS v4u* p = (GAS v4u*)(KVMl + (size_t)row * 1024 + 256 * uu.pn + 8 * cl);
                        const v4u w = *p;
                        float f[8] = {bflo(w.x), bfhi(w.x), bflo(w.y), bfhi(w.y), bflo(w.z), bfhi(w.z), bflo(w.w), bfhi(w.w)};
                        float ss = 0.f;
#pragma unroll
                        for (int e = 0; e < 8; ++e) ss += f[e] * f[e];
                        ss += shx(ss, 1, lane_); ss += shx(ss, 2, lane_); ss += shx(ss, 4, lane_); ss += shx(ss, 8, lane_);
                        const float r = 1.f / sqrtf(ss * (1.f / 128.f) + EPS);
                        const float* gg = gk + 8 * (cl & 15);
                        v4u o; o.x = pk2(f[0] * r * gg[0], f[1] * r * gg[1]); o.y = pk2(f[2] * r * gg[2], f[3] * r * gg[3]); o.z = pk2(f[4] * r * gg[4], f[5] * r * gg[5]); o.w = pk2(f[6] * r * gg[6], f[7] * r * gg[7]);
                        *p = o; } } }
            __syncthreads();
        }
        if (G >= 256 && bid >= 128) { PHL(); unsigned char* ws = WSP();
            convert_fp4_rows(PTR(22) + (size_t)PEER_N * DM, ws + WS_PV + (size_t)PEER_N * 1024, PEER_N, PV_SCALE4, nullptr, (bid - 128) * NWAVES + wave_, (G - 128) * NWAVES, lane_); }
        else if (G < 256) { PHL(); unsigned char* ws = WSP(); convert_fp4_rows(PTR(22) + (size_t)PEER_N * DM, ws + WS_PV + (size_t)PEER_N * 1024, PEER_N, PV_SCALE4, nullptr, gw_, NGW, lane_); }
    }
    SEAM(1);

#pragma unroll 1
    for (int l = 0; l < DEPTH; ++l) {
        const int pb = PH_BASE + PH_PER_LAYER * l;
        if (IN(pb + 0) && PHON(3)) { PHL(); unsigned char* ws = WSP();
            pg8::Gemm g{(bf16*)(ws + WS_XN8), (bf16*)(ws + WS_WIN8 + (size_t)l * DIN * DM), T, DIN, DM / 2}; pg8::StaticOrder S; S.init(T, DIN, G, bid);
            pg8::EpiQKV E{(bf16*)(ws + WS_QKV), PTR(5) + (size_t)l * 128, PTR(7) + (size_t)l * 128, PTR(9) + (size_t)l * 128, (const float*)(ws + WS_ROPE), (const u64_t*)(ws + WS_ROWSQ) + (size_t)(l * 3 + 0) * T, (const float*)(ws + WS_XSC), (const float*)(ws + WS_WSC) + (size_t)l * DIN};
            pg8::gemm_phase<pg8::EpiQKV, pg8::StaticOrder, true, true>(lds + RING_OFF, g, S, E, tid_);
        }
        SEAM(pb + 0);
        if (IN(pb + 1) && PHON(4)) { PHL(); unsigned char* ws = WSP();
            const float* sink = PTR(6) + (size_t)l * 12; const float* rpb = PTR(8) + (size_t)l * 8 * 15 * 31; const float* biasA = (const float*)(ws + WS_BIASA);
            const bf16* QKV = (const bf16*)(ws + WS_QKV); bf16* ATT = (bf16*)(ws + WS_ATT);
            const float* ga = PTR(5) + (size_t)l * 128; const float* gb = PTR(7) + (size_t)l * 128; const float* gc = PTR(9) + (size_t)l * 128;
            const float CaL2 = 8.f * wave_max(fabsf(ga[lane_]), lane_) * wave_max(fabsf(ga[64 + lane_]), lane_) * LOG2E;
            const float CbL2 = 8.f * wave_max(fabsf(gb[lane_]), lane_) * wave_max(fabsf(gb[64 + lane_]), lane_) * LOG2E;
            const float CcL2 = 8.f * wave_max(fabsf(gc[lane_]), lane_) * wave_max(fabsf(gc[64 + lane_]), lane_) * LOG2E;
            const int vc = (G % 8 == 0) ? (bid % 8) * (G / 8) + bid / 8 : bid;
            u64_t* mixsq = (u64_t*)(ws + WS_MIXSQ) + (size_t)l * 3 * T;
            for (int u = vc; u < BATCH * 12 * 8; u += G) attn_unit<2>(lds, QKV, ATT, mixsq + 2 * (size_t)T, u / 96, (u >> 3) % 12, u & 7, nullptr, CcL2, 0.f, tid_);
            for (int u = vc; u < BATCH * 8 * 8; u += G) attn_unit<1>(lds, QKV, ATT, mixsq + (size_t)T, u >> 6, (u >> 3) & 7, u & 7, rpb, CbL2, 0.f, tid_);
            for (int u = vc; u < BATCH * 12 * 8; u += G) { const int head = (u >> 3) % 12; attn_unit<0>(lds, QKV, ATT, mixsq, u / 96, head, u & 7, biasA, CaL2, sink[head] * LOG2E, tid_); }
        }
        SEAM(pb + 1);
        if (IN(pb + 2) && PHON(5)) { PHL(); unsigned char* ws = WSP();
            const u64_t* mixsq = (const u64_t*)(ws + WS_MIXSQ) + (size_t)l * 3 * T;
            for (int r = 4 * gw_; r < T; r += 4 * NGW) att_quant_rows<4>((const bf16*)(ws + WS_ATT), mixsq, ws + WS_ATT8, (float*)(ws + WS_XSC2), r, lane_);
        }
        SEAM(pb + 2);
        if (IN(pb + 3) && PHON(5)) { PHL(); unsigned char* ws = WSP();
            pg8::Gemm g{(bf16*)(ws + WS_ATT8), (bf16*)(ws + WS_WOUT8 + (size_t)l * DM * DM), T, DM, DM / 2}; pg8::StaticOrder S; S.init(T, DM, G, bid);
            typedef pg8::EpiResidT<true, 10> EpiX1;
            EpiX1 E{(bf16*)(ws + WS_XN), DM, (u64_t*)(ws + WS_ROWSQ) + (size_t)(l * 3 + 1) * T, (const float*)(ws + WS_XSC2), (const float*)(ws + WS_WSCO) + (size_t)l * DM, ws + WS_X8, (const u64_t*)(ws + WS_ROWSQ) + (size_t)(l * 3 + 0) * T};
            pg8::gemm_phase<EpiX1, pg8::StaticOrder, true, true>(lds + RING_OFF, g, S, E, tid_);
        }
        SEAM(pb + 3);
        if (IN(pb + 4) && PHON(6)) { PHL(); unsigned char* ws = WSP();
            pg8::Gemm g{(bf16*)(ws + WS_X8), (bf16*)(ws + WS_WMQ8 + (size_t)l * MEMW * DM), T, MEMW, DM / 2}; pg8::StaticOrder S; S.init(T, MEMW, G, bid);
            pg8::EpiBf16Row8<10> E{(bf16*)(ws + WS_QM), MEMW, (const u64_t*)(ws + WS_ROWSQ) + (size_t)(l * 3 + 1) * T, (const u64_t*)(ws + WS_ROWSQ) + (size_t)(l * 3 + 0) * T, (const float*)(ws + WS_WSCM) + (size_t)l * MEMW};
            pg8::gemm_phase<pg8::EpiBf16Row8<10>, pg8::StaticOrder, true, true>(lds + RING_OFF, g, S, E, tid_);
            VM_WAIT(); __syncthreads();
            const bf16* kvm = (const bf16*)(ws + WS_KVM) + (size_t)l * BATCH * NMEM * 1024; const float* gq = PTR(16) + (size_t)l * 256;
            const float CmL2 = 11.313708498984761f * wave_max(fmaxf(fabsf(gq[lane_]), fabsf(gq[64 + lane_])), lane_) * wave_max(fmaxf(fabsf(gq[128 + lane_]), fabsf(gq[192 + lane_])), lane_) * LOG2E;
#pragma unroll 1
            for (int i = 0; i < 4; ++i) { pg8::Unit uu; uu.pm = 0; uu.pn = 0; if (!S.next(i, uu)) break;
                mem_unit(lds, (const bf16*)(ws + WS_QM), kvm, (bf16*)(ws + WS_OM), gq, uu.pm, 2 * uu.pn, CmL2, tid_);
                mem_unit(lds, (const bf16*)(ws + WS_QM), kvm, (bf16*)(ws + WS_OM), gq, uu.pm, 2 * uu.pn + 1, CmL2, tid_); }
        }
        SEAM(pb + 4);
        if (IN(pb + 5) && PHON(7)) { PHL(); unsigned char* ws = WSP();
            pg8::Gemm g{(bf16*)(ws + WS_OM), (bf16*)(ws + WS_WMO) + (size_t)l * DM * MEMW, T, DM, MEMW}; pg8::StaticOrder S; S.init(T, DM, G, bid);
            typedef pg8::EpiResidT<false, 8> EpiX2;
            EpiX2 E{(bf16*)(ws + WS_XN), DM, (u64_t*)(ws + WS_ROWSQ) + (size_t)(l * 3 + 2) * T, nullptr, nullptr, ws + WS_X8, (const u64_t*)(ws + WS_ROWSQ) + (size_t)(l * 3 + 1) * T};
            pg8::gemm_phase<EpiX2, pg8::StaticOrder, true, true>(lds + RING_OFF, g, S, E, tid_);
        }
        SEAM(pb + 5);
        if (IN(pb + 6) && PHON(8)) { PHL(); unsigned char* ws = WSP();
            pg8::Gemm g{(bf16*)(ws + WS_X8), (bf16*)(ws + WS_WPQ8 + (size_t)l * DM * DM), T, DM, DM / 2}; pg8::StaticOrder S; S.init(T, DM, G, bid);
            pg8::EpiBf16Row8<8> E{(bf16*)(ws + WS_QP), DM, (const u64_t*)(ws + WS_ROWSQ) + (size_t)(l * 3 + 2) * T, (const u64_t*)(ws + WS_ROWSQ) + (size_t)(l * 3 + 1) * T, (const float*)(ws + WS_WSCP) + (size_t)l * DM};
            pg8::gemm_phase<pg8::EpiBf16Row8<8>, pg8::StaticOrder, true, true>(lds + RING_OFF, g, S, E, tid_);
            VM_WAIT(); __syncthreads();
            const bf16* pk = (const bf16*)(ws + WS_PKEYS) + (size_t)l * 8 * 2 * 128 * 128;
#pragma unroll 1
            for (int i = 0; i < 8; ++i) { pg8::Unit uu; uu.pm = 0; uu.pn = 0; if (!S.next(i, uu)) break;
                peer_select_unit((const bf16*)(ws + WS_QP), pk, (int*)(ws + WS_PIDX), (float*)(ws + WS_PGATE), uu.pm, uu.pn, wave_, lane_);
                peer_xquant_unit((const bf16*)(ws + WS_XN), (const u64_t*)(ws + WS_ROWSQ) + (size_t)(l * 3 + 2) * T, (unsigned*)(ws + WS_XQH), (unsigned*)(ws + WS_XQL), uu.pm, uu.pn, tid_); }
        }
        SEAM(pb + 6);
        if (IN(pb + 7) && PHON(9)) { PHL(); unsigned char* ws = WSP();
            peer_u_phase_i4((const unsigned*)(ws + WS_XQH), (const unsigned*)(ws + WS_XQL), ws + WS_PU + (size_t)l * PEER_N * 1024, (const int*)(ws + WS_PIDX), (int*)(ws + WS_PARTI), bid, G, wave_, lane_); }
        SEAM(pb + 7);
        if (IN(pb + 8) && PHON(10)) { PHL(); unsigned char* ws = WSP();
            peer_v_pass((bf16*)(ws + WS_XN), ws + WS_PV + (size_t)l * PEER_N * 1024, (const int*)(ws + WS_PIDX), (const float*)(ws + WS_PGATE), (const int*)(ws + WS_PARTI), (l + 1 == DEPTH) ? OUTP() : (float*)nullptr,
                        (l + 1 < DEPTH) ? (u64_t*)(ws + WS_ROWSQ) + (size_t)((l + 1) * 3 + 0) * T : (u64_t*)nullptr, (l + 1 < DEPTH) ? ws + WS_XN8 : (unsigned char*)nullptr, (float*)(ws + WS_XSC), (LAS float*)(lds + RING_OFF + wave_ * 1024), gw_, NGW, lane_); }
        SEAM(pb + 8);
    }
#undef IN
#undef SEAM
}

#ifndef MK_MULTI_LAUNCH
#define MK_MULTI_LAUNCH 0
#endif
extern "C" void kernel_launch(void* const* d_in, const int* in_sizes, int n_in, void* d_out, int out_size, void* d_ws, size_t ws_size, hipStream_t stream) {
    static int grid = 0;
    if (grid == 0) {
        if (n_in != 23 || out_size != T * DM || ws_size < WS_END) { fprintf(stderr, "kernel_launch: unexpected shapes (n_in %d, out %d, ws %zu)\n", n_in, out_size, ws_size); grid = -1; return; }
        int dev = 0, cus = 0, per_cu = 0;
        if (hipGetDevice(&dev) != hipSuccess || hipDeviceGetAttribute(&cus, hipDeviceAttributeMultiprocessorCount, dev) != hipSuccess) { grid = -1; return; }
        if (hipFuncSetAttribute((const void*)mega, hipFuncAttributeMaxDynamicSharedMemorySize, LDS_BYTES) != hipSuccess) { fprintf(stderr, "kernel_launch: hipFuncSetAttribute failed\n"); grid = -1; return; }
        if (hipOccupancyMaxActiveBlocksPerMultiprocessor(&per_cu, (const void*)mega, NTHREADS, LDS_BYTES) != hipSuccess || per_cu < 1) { fprintf(stderr, "kernel_launch: occupancy query says %d\n", per_cu); }
        (void)hipGetLastError();
        grid = cus;
    }
    if (grid < 0) return;
    (void)hipMemsetAsync((char*)d_ws + WS_CTL, 0, CTL_ZERO_BYTES, stream);
    (void)hipMemsetAsync((char*)d_ws + WS_MIXSQ, 0, MIXSQ_BYTES, stream);
    Args a{};
    for (int i = 0; i < 23; ++i) a.in[i] = (const float*)d_in[i];
    a.out = (float*)d_out; a.ws = (unsigned char*)d_ws;
#if MK_MULTI_LAUNCH
    for (int p = 0; p < N_PHASES; ++p) { a.ph_lo = p; a.ph_hi = p + 1; a.use_bar = 0; a.pad = 0; hipLaunchKernelGGL(mega, dim3(grid), dim3(NTHREADS), LDS_BYTES, stream, a); }
#else
    a.ph_lo = 0; a.ph_hi = N_PHASES; a.use_bar = 1; a.pad = 0;
    hipLaunchKernelGGL(mega, dim3(grid), dim3(NTHREADS), LDS_BYTES, stream, a);
#endif
    const hipError_t le = hipPeekAtLastError();
    if (le != hipSuccess) fprintf(stderr, "kernel_launch: launch failed: %s\n", hipGetErrorName(le));
}
```

```cpp
#include <hip/hip_runtime.h>
#include <cstdio>
#include <cstdint>
#include <cmath>
__device__ __forceinline__ float shx(float v, int k, int lane);
typedef unsigned long long u64_t;
__device__ __forceinline__ float rowsq_rs(const u64_t* rowsq, int row) { return 1.0f / sqrtf((float)*(const __attribute__((address_space(1))) u64_t*)(rowsq + row) * (5.9604644775390625e-08f / 2048.0f) + 1e-6f); }
__device__ __forceinline__ u64_t rowsq_fx(float ss) { return (u64_t)(ss * 16777216.0f + 0.5f); }
__device__ __forceinline__ unsigned q8x4c(float a, float b, float c, float d, float inv) {
    unsigned w = 0;
    w = __builtin_amdgcn_cvt_pk_u8_f32(__builtin_rintf(__builtin_amdgcn_fmed3f(__builtin_fmaf(a, inv, 128.f), 1.f, 255.f)), 0, w); w = __builtin_amdgcn_cvt_pk_u8_f32(__builtin_rintf(__builtin_amdgcn_fmed3f(__builtin_fmaf(b, inv, 128.f), 1.f, 255.f)), 1, w);
    w = __builtin_amdgcn_cvt_pk_u8_f32(__builtin_rintf(__builtin_amdgcn_fmed3f(__builtin_fmaf(c, inv, 128.f), 1.f, 255.f)), 2, w); w = __builtin_amdgcn_cvt_pk_u8_f32(__builtin_rintf(__builtin_amdgcn_fmed3f(__builtin_fmaf(d, inv, 128.f), 1.f, 255.f)), 3, w);
    return w ^ 0x80808080u;
}
namespace pg8 {
#define PG8_LAS __attribute__((address_space(3)))
#define PG8_GAS __attribute__((address_space(1)))
typedef unsigned short bf16_t;
typedef short bf16x8 __attribute__((ext_vector_type(8)));
typedef float f32x4 __attribute__((ext_vector_type(4)));
typedef unsigned u32x4 __attribute__((ext_vector_type(4)));
constexpr int BM = 256, BK = 64, HALF = 128, HTB = HALF * BK * 2  , STAGE_BYTES = 8 * HTB, NXCD = 8, WGM = 8;

__host__ __device__ __forceinline__ int lds_byte(int r, int c) { const int st = (r >> 4) * 2 + (c >> 5), rr = r & 15, cc = c & 31, ob = rr * 64 + cc * 2; return st * 1024 + (ob ^ (((ob >> 9) & 1) << 5)); }
__host__ __device__ __forceinline__ void stage_rc(int b, int& R, int& C) { const int st = b / 1024, sb = b % 1024, swz = sb ^ (((sb >> 9) & 1) << 5); R = (st >> 1) * 16 + swz / 64; C = (st & 1) * 32 + (swz % 64) / 2; }
__host__ __device__ __forceinline__ int perm32(int rho) { const int n = rho >> 4, i = rho & 15; return 8 * (i >> 2) + 4 * n + (i & 3); }

struct Unit { int pm, pn; };
struct Gemm { const bf16_t* A; const bf16_t* Bt; int M, N, K; };

struct StaticOrder {
    int nM, nN, nwg, G, c;
    __host__ __device__ __forceinline__ void init(int M, int N, int G_, int c_) { nM = M / BM; nN = N / BM; nwg = nM * nN; G = G_; c = c_; }
    __host__ __device__ __forceinline__ bool next(int i, Unit& u) const {
        const long L = (long)i * G + c; if (L >= nwg) return false;
        int wgid = (int)L; { const int q = nwg / NXCD, r = nwg % NXCD, xcd = wgid % NXCD, off = wgid / NXCD; wgid = (xcd < r ? xcd * (q + 1) : r * (q + 1) + (xcd - r) * q) + off; }
        const int nig = WGM * nN, gid = wgid / nig, fm = gid * WGM, gsz = (nM - fm) < WGM ? (nM - fm) : WGM;
        u.pm = fm + ((wgid % nig) % gsz); u.pn = (wgid % nig) / gsz; return true;
    }
    __device__ __forceinline__ void a_ready(const Unit&) const {}
    __device__ __forceinline__ void done(const Unit&) const {}
};

__device__ __forceinline__ unsigned cvt_pk_bf16(float lo, float hi) { unsigned r; asm volatile("v_cvt_pk_bf16_f32 %0, %1, %2" : "=v"(r) : "v"(lo), "v"(hi)); return r; }
typedef float f32x2 __attribute__((ext_vector_type(2)));
__device__ __forceinline__ f32x2 gelu_pk(f32x2 v) {
    const f32x2 av = __builtin_elementwise_abs(v), d = av * 0.2316418882f + 1.0f;
    f32x2 t; t.x = __builtin_amdgcn_rcpf(d.x); t.y = __builtin_amdgcn_rcpf(d.y);
    f32x2 q = t * 0.5307027145f + (-0.7265760135f); q = q * t + 0.7107068705f; q = q * t + (-0.142248368f); q = q * t + 0.127414796f; q = q * t;
    const f32x2 s = (v * v) * (-0.72134752044f);
    f32x2 e; e.x = __builtin_amdgcn_exp2f(s.x); e.y = __builtin_amdgcn_exp2f(s.y);
    const f32x2 m = v * (q * e), r = v - m;
    f32x2 o; o.x = v.x < 0.f ? m.x : r.x; o.y = v.y < 0.f ? m.y : r.y; return o;
}

template <int ACT  > struct EpiBf16 {
    static constexpr bool PERM = true, AFTER_DRAIN = false, KSCALE = false, I8 = false; static_assert(ACT == 0 || ACT == 1, "EpiBf16: ACT is 0 (none) or 1 (gelu_pk)");
    bf16_t* O; int ldc; const float* bias; int split_cols; size_t split_stride; float scale0;
    __device__ __forceinline__ void operator()(const f32x4 (&acc)[2][2][4][2], const Unit& u, int wr, int wc, int fr, int fq) const {
        const int row0 = u.pm * BM + wr * 64 + fr; int colt = u.pn * BM; bf16_t* base = O;
        float sc = 1.f; if (split_cols) { const int t = colt / split_cols; base += (size_t)t * split_stride; colt -= t * split_cols; if (t == 0) sc = scale0; }
        const int col0 = colt + wc * 32 + 8 * fq, bcol0 = u.pn * BM + wc * 32 + 8 * fq;
        f32x4 bv[2][2];
#pragma unroll
        for (int bj = 0; bj < 2; ++bj)
#pragma unroll
            for (int n = 0; n < 2; ++n) bv[bj][n] = bias ? *(const PG8_GAS f32x4*)(bias + bcol0 + bj * HALF + 4 * n) : (f32x4){0.f, 0.f, 0.f, 0.f};
#pragma unroll
        for (int ai = 0; ai < 2; ++ai)
#pragma unroll
            for (int m = 0; m < 4; ++m) { bf16_t* rowp = base + (size_t)(row0 + ai * HALF + m * 16) * ldc + col0;
#pragma unroll
                for (int bj = 0; bj < 2; ++bj) { f32x4 v0 = acc[ai][bj][m][0] + bv[bj][0], v1 = acc[ai][bj][m][1] + bv[bj][1];
                    if (ACT == 1) { f32x2 a = gelu_pk((f32x2){v0[0], v0[1]}), b = gelu_pk((f32x2){v0[2], v0[3]}), c = gelu_pk((f32x2){v1[0], v1[1]}), d = gelu_pk((f32x2){v1[2], v1[3]});
                        v0 = (f32x4){a.x, a.y, b.x, b.y}; v1 = (f32x4){c.x, c.y, d.x, d.y}; }
                    v0 = v0 * sc; v1 = v1 * sc; u32x4 w; w.x = cvt_pk_bf16(v0[0], v0[1]); w.y = cvt_pk_bf16(v0[2], v0[3]); w.z = cvt_pk_bf16(v1[0], v1[1]); w.w = cvt_pk_bf16(v1[2], v1[3]);
                    *(PG8_GAS u32x4*)(rowp + bj * HALF) = w; } }
    }
};

typedef unsigned u32x2 __attribute__((ext_vector_type(2)));
typedef int i32x4 __attribute__((ext_vector_type(4)));
struct EpiResid {
    static constexpr bool PERM = false, AFTER_DRAIN = false, KSCALE = false, I8 = false;
    bf16_t* s; int ldc; u64_t* rowsq;
    __device__ __forceinline__ void operator()(const f32x4 (&acc)[2][2][4][2], const Unit& u, int wr, int wc, int fr, int fq) const {
        const int col0 = u.pn * BM + wc * 32 + 4 * fq;
#pragma unroll
        for (int ai = 0; ai < 2; ++ai)
#pragma unroll
            for (int m = 0; m < 4; ++m) { const int row = u.pm * BM + ai * HALF + wr * 64 + m * 16 + fr; bf16_t* sp = s + (size_t)row * ldc + col0; float ss = 0.f;
                u32x2 in[2][2];
#pragma unroll
                for (int bj = 0; bj < 2; ++bj)
#pragma unroll
                    for (int n = 0; n < 2; ++n) in[bj][n] = *(const PG8_GAS u32x2*)(sp + bj * HALF + n * 16);
#pragma unroll
                for (int bj = 0; bj < 2; ++bj)
#pragma unroll
                    for (int n = 0; n < 2; ++n) { const u32x2 w0 = in[bj][n];
                        const f32x4 bs = (f32x4){__builtin_bit_cast(float, w0.x << 16), __builtin_bit_cast(float, w0.x & 0xffff0000u), __builtin_bit_cast(float, w0.y << 16), __builtin_bit_cast(float, w0.y & 0xffff0000u)};
                        const f32x4 o = bs + acc[ai][bj][m][n]; ss += (o[0] * o[0] + o[1] * o[1]) + (o[2] * o[2] + o[3] * o[3]);
                        u32x2 w; w.x = cvt_pk_bf16(o[0], o[1]); w.y = cvt_pk_bf16(o[2], o[3]); *(PG8_GAS u32x2*)(sp + bj * HALF + n * 16) = w; }
                ss += shx(ss, 16, fr + 16 * fq); ss += shx(ss, 32, fr + 16 * fq);
                if (fq == 0) (void)__hip_atomic_fetch_add((PG8_GAS u64_t*)(rowsq + row), rowsq_fx(ss), __ATOMIC_RELAXED, __HIP_MEMORY_SCOPE_AGENT); }
    }
};
struct EpiResid8 {
    static constexpr bool PERM = false, AFTER_DRAIN = false, KSCALE = false, I8 = true;
    bf16_t* s; int ldc; u64_t* rowsq; const float* xsc; const float* wsc;
    __device__ __forceinline__ void operator()(const f32x4 (&acc)[2][2][4][2], const Unit& u, int wr, int wc, int fr, int fq) const {
        const int col0 = u.pn * BM + wc * 32 + 4 * fq;
#pragma unroll
        for (int ai = 0; ai < 2; ++ai)
#pragma unroll
            for (int m = 0; m < 4; ++m) { const int row = u.pm * BM + ai * HALF + wr * 64 + m * 16 + fr; bf16_t* sp = s + (size_t)row * ldc + col0; float ss = 0.f; const float xs = *(const PG8_GAS float*)(xsc + row);
                u32x2 in[2][2];
#pragma unroll
                for (int bj = 0; bj < 2; ++bj)
#pragma unroll
                    for (int n = 0; n < 2; ++n) in[bj][n] = *(const PG8_GAS u32x2*)(sp + bj * HALF + n * 16);
#pragma unroll
                for (int bj = 0; bj < 2; ++bj)
#pragma unroll
                    for (int n = 0; n < 2; ++n) { const u32x2 w0 = in[bj][n]; const i32x4 ia = __builtin_bit_cast(i32x4, acc[ai][bj][m][n]);
                        const f32x4 bs = (f32x4){__builtin_bit_cast(float, w0.x << 16), __builtin_bit_cast(float, w0.x & 0xffff0000u), __builtin_bit_cast(float, w0.y << 16), __builtin_bit_cast(float, w0.y & 0xffff0000u)};
                        const f32x4 o = bs + (f32x4){(float)ia[0], (float)ia[1], (float)ia[2], (float)ia[3]} * *(const PG8_GAS f32x4*)(wsc + col0 + bj * HALF + n * 16) * xs; ss += (o[0] * o[0] + o[1] * o[1]) + (o[2] * o[2] + o[3] * o[3]);
                        u32x2 w; w.x = cvt_pk_bf16(o[0], o[1]); w.y = cvt_pk_bf16(o[2], o[3]); *(PG8_GAS u32x2*)(sp + bj * HALF + n * 16) = w; }
                ss += shx(ss, 16, fr + 16 * fq); ss += shx(ss, 32, fr + 16 * fq);
                if (fq == 0) (void)__hip_atomic_fetch_add((PG8_GAS u64_t*)(rowsq + row), rowsq_fx(ss), __ATOMIC_RELAXED, __HIP_MEMORY_SCOPE_AGENT); }
    }
};
template <bool I8IN, int QOUT>
struct EpiResidT {
    static constexpr bool PERM = true, AFTER_DRAIN = false, KSCALE = false, I8 = I8IN;
    bf16_t* s; int ldc; u64_t* rowsq; const float* xsc; const float* wsc; unsigned char* q8; const u64_t* rowsq_prev;
    __device__ __forceinline__ void operator()(const f32x4 (&acc)[2][2][4][2], const Unit& u, int wr, int wc, int fr, int fq) const {
        const int col0 = u.pn * BM + wc * 32 + 8 * fq, rowb = u.pm * BM + wr * 64 + fr;
        f32x4 wv[2][2];
        if constexpr (I8IN) {
#pragma unroll
            for (int bj = 0; bj < 2; ++bj) { wv[bj][0] = *(const PG8_GAS f32x4*)(wsc + col0 + bj * HALF); wv[bj][1] = *(const PG8_GAS f32x4*)(wsc + col0 + bj * HALF + 4); } }
#pragma unroll
        for (int ai = 0; ai < 2; ++ai) {
            u32x4 in[4][2]; float xs[4], qv[4];
#pragma unroll
            for (int m = 0; m < 4; ++m) { const int row = rowb + ai * HALF + m * 16; const bf16_t* sp = s + (size_t)row * ldc + col0;
#pragma unroll
                for (int bj = 0; bj < 2; ++bj) in[m][bj] = *(const PG8_GAS u32x4*)(sp + bj * HALF);
                if constexpr (I8IN) xs[m] = *(const PG8_GAS float*)(xsc + row); else xs[m] = 1.f;
                if constexpr (QOUT > 0) qv[m] = (127.0f / QOUT) * rowsq_rs(rowsq_prev, row); else qv[m] = 0.f; }
            __builtin_amdgcn_sched_barrier(0);
#pragma unroll
            for (int m = 0; m < 4; ++m) { const int row = rowb + ai * HALF + m * 16; bf16_t* sp = s + (size_t)row * ldc + col0; float ss = 0.f;
#pragma unroll
                for (int bj = 0; bj < 2; ++bj) { const u32x4 w0 = in[m][bj]; f32x4 a0 = acc[ai][bj][m][0], a1 = acc[ai][bj][m][1];
                    if constexpr (I8IN) { const i32x4 i0 = __builtin_bit_cast(i32x4, a0), i1 = __builtin_bit_cast(i32x4, a1);
                        a0 = (f32x4){(float)i0[0], (float)i0[1], (float)i0[2], (float)i0[3]} * wv[bj][0] * xs[m];
                        a1 = (f32x4){(float)i1[0], (float)i1[1], (float)i1[2], (float)i1[3]} * wv[bj][1] * xs[m]; }
                    const f32x4 o0 = (f32x4){__builtin_bit_cast(float, w0.x << 16), __builtin_bit_cast(float, w0.x & 0xffff0000u), __builtin_bit_cast(float, w0.y << 16), __builtin_bit_cast(float, w0.y & 0xffff0000u)} + a0;
                    const f32x4 o1 = (f32x4){__builtin_bit_cast(float, w0.z << 16), __builtin_bit_cast(float, w0.z & 0xffff0000u), __builtin_bit_cast(float, w0.w << 16), __builtin_bit_cast(float, w0.w & 0xffff0000u)} + a1;
                    ss += ((o0[0] * o0[0] + o0[1] * o0[1]) + (o0[2] * o0[2] + o0[3] * o0[3])) + ((o1[0] * o1[0] + o1[1] * o1[1]) + (o1[2] * o1[2] + o1[3] * o1[3]));
                    u32x4 w; w.x = cvt_pk_bf16(o0[0], o0[1]); w.y = cvt_pk_bf16(o0[2], o0[3]); w.z = cvt_pk_bf16(o1[0], o1[1]); w.w = cvt_pk_bf16(o1[2], o1[3]); *(PG8_GAS u32x4*)(sp + bj * HALF) = w;
                    if constexpr (QOUT > 0) { u32x2 q; q.x = q8x4c(o0[0], o0[1], o0[2], o0[3], qv[m]); q.y = q8x4c(o1[0], o1[1], o1[2], o1[3], qv[m]); *(PG8_GAS u32x2*)(q8 + (size_t)row * ldc + col0 + bj * HALF) = q; } }
                ss += shx(ss, 16, fr + 16 * fq); ss += shx(ss, 32, fr + 16 * fq);
                if (fq == 0) (void)__hip_atomic_fetch_add((PG8_GAS u64_t*)(rowsq + row), rowsq_fx(ss), __ATOMIC_RELAXED, __HIP_MEMORY_SCOPE_AGENT); }
            __builtin_amdgcn_sched_barrier(0);
        }
    }
};
template <int QIN>
struct EpiBf16Row8 {
    static constexpr bool PERM = true, AFTER_DRAIN = false, KSCALE = false, I8 = true;
    bf16_t* O; int ldc; const u64_t* rowsq; const u64_t* rowsq_prev; const float* wsc;
    __device__ __forceinline__ void operator()(const f32x4 (&acc)[2][2][4][2], const Unit& u, int wr, int wc, int fr, int fq) const {
        const int row0 = u.pm * BM + wr * 64 + fr, col0 = u.pn * BM + wc * 32 + 8 * fq;
        float rs[2][4]; f32x4 wv[2][2];
#pragma unroll
        for (int ai = 0; ai < 2; ++ai)
#pragma unroll
            for (int m = 0; m < 4; ++m) { const int row = row0 + ai * HALF + m * 16; rs[ai][m] = rowsq_rs(rowsq, row) * (QIN / 127.0f) / rowsq_rs(rowsq_prev, row); }
#pragma unroll
        for (int bj = 0; bj < 2; ++bj) { wv[bj][0] = *(const PG8_GAS f32x4*)(wsc + col0 + bj * HALF); wv[bj][1] = *(const PG8_GAS f32x4*)(wsc + col0 + bj * HALF + 4); }
        __builtin_amdgcn_sched_barrier(0);
#pragma unroll
        for (int ai = 0; ai < 2; ++ai)
#pragma unroll
            for (int m = 0; m < 4; ++m) { const int row = row0 + ai * HALF + m * 16; bf16_t* rowp = O + (size_t)row * ldc + col0;
#pragma unroll
                for (int bj = 0; bj < 2; ++bj) { const i32x4 i0 = __builtin_bit_cast(i32x4, acc[ai][bj][m][0]), i1 = __builtin_bit_cast(i32x4, acc[ai][bj][m][1]);
                    const f32x4 v0 = (f32x4){(float)i0[0], (float)i0[1], (float)i0[2], (float)i0[3]} * wv[bj][0] * rs[ai][m], v1 = (f32x4){(float)i1[0], (float)i1[1], (float)i1[2], (float)i1[3]} * wv[bj][1] * rs[ai][m];
                    u32x4 w; w.x = cvt_pk_bf16(v0[0], v0[1]); w.y = cvt_pk_bf16(v0[2], v0[3]); w.z = cvt_pk_bf16(v1[0], v1[1]); w.w = cvt_pk_bf16(v1[2], v1[3]);
                    *(PG8_GAS u32x4*)(rowp + bj * HALF) = w; } }
    }
};
struct EpiResidMix {
    static constexpr bool PERM = false, AFTER_DRAIN = false, KSCALE = true, I8 = false; static constexpr int KS0 = 12, KS1 = 20;
    bf16_t* s; int ldc; u64_t* rowsq; const PG8_LAS float* ftab; const PG8_LAS int* pmtab;
    __device__ __forceinline__ int slot(int pm) const { return pmtab[0] == pm ? 0 : (pmtab[1] == pm ? 1 : (pmtab[2] == pm ? 2 : 3)); }
    __device__ __forceinline__ void kscale(f32x4 (&acc)[2][2][4][2], const Unit& u, int which, int wr, int fr) const {
        const PG8_LAS float* ft = ftab + which * 1024 + slot(u.pm) * 256;
#pragma unroll
        for (int ai = 0; ai < 2; ++ai)
#pragma unroll
            for (int m = 0; m < 4; ++m) { const float f = ft[ai * HALF + wr * 64 + m * 16 + fr];
#pragma unroll
                for (int bj = 0; bj < 2; ++bj)
#pragma unroll
                    for (int n = 0; n < 2; ++n) acc[ai][bj][m][n] = acc[ai][bj][m][n] * f; }
    }
    __device__ __forceinline__ void operator()(const f32x4 (&acc)[2][2][4][2], const Unit& u, int wr, int wc, int fr, int fq) const {
        const int col0 = u.pn * BM + wc * 32 + 4 * fq;
#pragma unroll
        for (int ai = 0; ai < 2; ++ai)
#pragma unroll
            for (int m = 0; m < 4; ++m) { const int row = u.pm * BM + ai * HALF + wr * 64 + m * 16 + fr; bf16_t* sp = s + (size_t)row * ldc + col0; float ss = 0.f; const float rc = ftab[2048 + slot(u.pm) * 256 + ai * HALF + wr * 64 + m * 16 + fr];
                u32x2 in[2][2];
#pragma unroll
                for (int bj = 0; bj < 2; ++bj)
#pragma unroll
                    for (int n = 0; n < 2; ++n) in[bj][n] = *(const PG8_GAS u32x2*)(sp + bj * HALF + n * 16);
#pragma unroll
                for (int bj = 0; bj < 2; ++bj)
#pragma unroll
                    for (int n = 0; n < 2; ++n) { const u32x2 w0 = in[bj][n];
                        const f32x4 bs = (f32x4){__builtin_bit_cast(float, w0.x << 16), __builtin_bit_cast(float, w0.x & 0xffff0000u), __builtin_bit_cast(float, w0.y << 16), __builtin_bit_cast(float, w0.y & 0xffff0000u)};
                        const f32x4 o = bs + acc[ai][bj][m][n] * rc; ss += (o[0] * o[0] + o[1] * o[1]) + (o[2] * o[2] + o[3] * o[3]);
                        u32x2 w; w.x = cvt_pk_bf16(o[0], o[1]); w.y = cvt_pk_bf16(o[2], o[3]); *(PG8_GAS u32x2*)(sp + bj * HALF + n * 16) = w; }
                ss += shx(ss, 16, fr + 16 * fq); ss += shx(ss, 32, fr + 16 * fq);
                if (fq == 0) (void)__hip_atomic_fetch_add((PG8_GAS u64_t*)(rowsq + row), rowsq_fx(ss), __ATOMIC_RELAXED, __HIP_MEMORY_SCOPE_AGENT); }
    }
};
struct EpiBf16Row {
    static constexpr bool PERM = true, AFTER_DRAIN = false, KSCALE = false, I8 = false;
    bf16_t* O; int ldc; const u64_t* rowsq;
    __device__ __forceinline__ void operator()(const f32x4 (&acc)[2][2][4][2], const Unit& u, int wr, int wc, int fr, int fq) const {
        const int row0 = u.pm * BM + wr * 64 + fr, col0 = u.pn * BM + wc * 32 + 8 * fq;
#pragma unroll
        for (int ai = 0; ai < 2; ++ai)
#pragma unroll
            for (int m = 0; m < 4; ++m) { const int row = row0 + ai * HALF + m * 16; const float rs = rowsq_rs(rowsq, row); bf16_t* rowp = O + (size_t)row * ldc + col0;
#pragma unroll
                for (int bj = 0; bj < 2; ++bj) { const f32x4 v0 = acc[ai][bj][m][0] * rs, v1 = acc[ai][bj][m][1] * rs; u32x4 w; w.x = cvt_pk_bf16(v0[0], v0[1]); w.y = cvt_pk_bf16(v0[2], v0[3]); w.z = cvt_pk_bf16(v1[0], v1[1]); w.w = cvt_pk_bf16(v1[2], v1[3]);
                    *(PG8_GAS u32x4*)(rowp + bj * HALF) = w; } }
    }
};
struct EpiQKV {
    static constexpr bool PERM = false, AFTER_DRAIN = false, KSCALE = false, I8 = true;
    bf16_t* O; const float* ga; const float* gb; const float* gc; const PG8_LAS float* rope; const u64_t* rowsq; const float* xsc; const float* wsc;
    __device__ __forceinline__ void operator()(const f32x4 (&acc)[2][2][4][2], const Unit& u, int wr, int wc, int fr, int fq) const {
        const int hg = u.pn * 4 + wc;
        const float* g = nullptr; bool isq = false, dorope = false;
        if (hg < 12) { g = ga; isq = true; } else if (hg < 16) { g = ga + 64; } else if (hg < 20) { }
        else if (hg < 28) { g = gb; isq = true; } else if (hg < 36) { g = gb + 64; } else if (hg < 44) { }
        else if (hg < 56) { g = gc; isq = true; dorope = true; } else if (hg < 60) { g = gc + 64; dorope = true; }
        const float qs = isq ? 0.18033688011112042f : 1.0f;
        float rsxa[2][4]; f32x4 wv[2][2], gv[2][2];
#pragma unroll
        for (int ai = 0; ai < 2; ++ai)
#pragma unroll
            for (int m = 0; m < 4; ++m) { const int row = u.pm * BM + ai * HALF + wr * 64 + m * 16 + fr; rsxa[ai][m] = *(const PG8_GAS float*)(xsc + row); }
#pragma unroll
        for (int bj = 0; bj < 2; ++bj)
#pragma unroll
            for (int n = 0; n < 2; ++n) { wv[bj][n] = *(const PG8_GAS f32x4*)(wsc + hg * 64 + 32 * bj + 16 * n + 4 * fq); gv[bj][n] = g ? *(const PG8_GAS f32x4*)(g + 32 * bj + 16 * n + 4 * fq) : (f32x4){1.f, 1.f, 1.f, 1.f}; }
        __builtin_amdgcn_sched_barrier(0);
#pragma unroll
        for (int ai = 0; ai < 2; ++ai)
#pragma unroll
            for (int m = 0; m < 4; ++m) {
                const int row = u.pm * BM + ai * HALF + wr * 64 + m * 16 + fr;
                f32x4 v[2][2];
                const float rsx = rsxa[ai][m];
#pragma unroll
                for (int bj = 0; bj < 2; ++bj)
#pragma unroll
                    for (int n = 0; n < 2; ++n) { const i32x4 ia = __builtin_bit_cast(i32x4, acc[ai][bj][m][n]);
                        v[bj][n] = (f32x4){(float)ia[0], (float)ia[1], (float)ia[2], (float)ia[3]} * wv[bj][n] * rsx; }
                if (g) {
                    float ss = 0.f;
#pragma unroll
                    for (int bj = 0; bj < 2; ++bj)
#pragma unroll
                        for (int n = 0; n < 2; ++n) { const f32x4 x = v[bj][n]; ss += (x[0] * x[0] + x[1] * x[1]) + (x[2] * x[2] + x[3] * x[3]); }
                    ss += shx(ss, 16, fr + 16 * fq); ss += shx(ss, 32, fr + 16 * fq);
                    const float r = qs / sqrtf(ss * (1.0f / 64.0f) + 1e-6f);
#pragma unroll
                    for (int bj = 0; bj < 2; ++bj)
#pragma unroll
                        for (int n = 0; n < 2; ++n) v[bj][n] = v[bj][n] * gv[bj][n] * r;
                }
                if (dorope) {
                    const int t = row & 2047, pr = t >> 6, pc = t & 63;
#pragma unroll
                    for (int bj = 0; bj < 2; ++bj) {
                        const int pos = bj ? pc : pr;
                        const PG8_LAS float* rp = rope + (pos * 16 + 4 * fq) * 2;
                        const f32x4 c01 = *(const PG8_LAS f32x4*)rp, c23 = *(const PG8_LAS f32x4*)(rp + 4);
                        const f32x4 cs = (f32x4){c01[0], c01[2], c23[0], c23[2]}, sn = (f32x4){c01[1], c01[3], c23[1], c23[3]};
                        const f32x4 x1 = v[bj][0], x2 = v[bj][1];
                        v[bj][0] = x1 * cs - x2 * sn; v[bj][1] = x1 * sn + x2 * cs;
                    }
                }
                bf16_t* rowp = O + (size_t)row * 4096 + hg * 64 + 4 * fq;
#pragma unroll
                for (int bj = 0; bj < 2; ++bj)
#pragma unroll
                    for (int n = 0; n < 2; ++n) { u32x2 w; w.x = cvt_pk_bf16(v[bj][n][0], v[bj][n][1]); w.y = cvt_pk_bf16(v[bj][n][2], v[bj][n][3]); *(PG8_GAS u32x2*)(rowp + 32 * bj + 16 * n) = w; }
                asm volatile("" ::: "memory");
            }
    }
};
template <bool I8> __device__ __forceinline__ f32x4 mma16(const bf16x8 b, const bf16x8 a, const f32x4 c) {
    if constexpr (I8) return __builtin_bit_cast(f32x4, __builtin_amdgcn_mfma_i32_16x16x64_i8(__builtin_bit_cast(i32x4, b), __builtin_bit_cast(i32x4, a), __builtin_bit_cast(i32x4, c), 0, 0, 0));
    else return __builtin_amdgcn_mfma_f32_16x16x32_bf16(b, a, c, 0, 0, 0);
}
template <class Epi, class Sched, bool ALIGN_EPI = false, bool SP2 = false>
__device__ __forceinline__ void gemm_phase(PG8_LAS unsigned char* lds, const Gemm g, const Sched& S, const Epi& E, const int tid) {
    const int wid = __builtin_amdgcn_readfirstlane(tid >> 6), lane = tid & 63, wr = wid >> 2, wc = wid & 3, fr = lane & 15, fq = lane >> 4;
    const int K = g.K, nt = K / BK;
    unsigned voffA[2], voffB[2];
#pragma unroll
    for (int i = 0; i < 2; ++i) { int R, C; stage_rc(tid * 16 + i * 8192, R, C); const int Rb = Epi::PERM ? ((R & ~31) + perm32(R & 31)) : R;
        voffA[i] = (unsigned)(R * K + C) * 2u; voffB[i] = (unsigned)(Rb * K + C) * 2u; }
    const size_t kstep = (size_t)(BK * 2);
    const size_t hstep = (size_t)HALF * K * 2;
    const size_t tstep = 2 * hstep;
    const unsigned ldsw = (unsigned)wid * 1024u;
    const int aoff = lds_byte(wr * 64 + fr, fq * 8), boff = lds_byte(wc * 32 + fr, fq * 8);
#define PG8_SA(b, h) (((b) * 2 + (h)) * HTB)
#define PG8_SB(b, h) ((4 + (b) * 2 + (h)) * HTB)
#define PG8_STAGE(bufoff, gbase, voff) do { _Pragma("unroll") for (int _i = 0; _i < 2; ++_i) \
        __builtin_amdgcn_global_load_lds((const unsigned*)((const char*)(gbase) + (voff)[_i]), (PG8_LAS unsigned*)(lds + (bufoff) + ldsw + _i * 8192), 16, 0, 0); } while (0)
#define PG8_LDA(dst, b, h) do { _Pragma("unroll") for (int m = 0; m < 4; ++m) _Pragma("unroll") for (int k = 0; k < 2; ++k) dst[m][k] = *(const PG8_LAS bf16x8*)(lds + PG8_SA(b, h) + aoff + m * 2048 + k * 1024); } while (0)
#define PG8_LDB(dst, b, h) do { _Pragma("unroll") for (int n = 0; n < 2; ++n) _Pragma("unroll") for (int k = 0; k < 2; ++k) dst[n][k] = *(const PG8_LAS bf16x8*)(lds + PG8_SB(b, h) + boff + n * 2048 + k * 1024); } while (0)
#define PG8_MMA(ai, bj, At, Bt) do { __builtin_amdgcn_s_setprio(1); _Pragma("unroll") for (int m = 0; m < 4; ++m) _Pragma("unroll") for (int n = 0; n < 2; ++n) _Pragma("unroll") for (int k = 0; k < 2; ++k) \
        acc[ai][bj][m][n] = mma16<Epi::I8>(Bt[n][k], At[m][k], acc[ai][bj][m][n]); __builtin_amdgcn_s_setprio(0); } while (0)
#define PG8_WAIT_V(n) asm volatile("s_waitcnt vmcnt(" #n ")" ::: "memory")
#define PG8_WAIT_L(n) asm volatile("s_waitcnt lgkmcnt(" #n ")" ::: "memory")
#define PG8_BAR __builtin_amdgcn_s_barrier()
#define PG8_SCHED __builtin_amdgcn_sched_barrier(0)
    Unit cur, nxt; int ui = 0;
    if (!S.next(0, cur)) return;
    f32x4 acc[2][2][4][2];
#pragma unroll
    for (int a = 0; a < 2; ++a)
#pragma unroll
        for (int b = 0; b < 2; ++b)
#pragma unroll
            for (int m = 0; m < 4; ++m)
#pragma unroll
                for (int n = 0; n < 2; ++n) acc[a][b][m][n] = (f32x4){0.f, 0.f, 0.f, 0.f};
    bf16x8 At[4][2], B0[2][2], B1[2][2];
    const char* cA = (const char*)g.A + (size_t)cur.pm * tstep; const char* cB = (const char*)g.Bt + (size_t)cur.pn * tstep;
    S.a_ready(cur);
    if constexpr (SP2) {
        PG8_STAGE(PG8_SB(0, 0), cB, voffB); PG8_STAGE(PG8_SB(0, 1), cB + hstep, voffB); PG8_STAGE(PG8_SA(0, 0), cA, voffA); PG8_STAGE(PG8_SA(0, 1), cA + hstep, voffA);
        if (wr == 1) PG8_BAR;
        PG8_WAIT_V(2); PG8_BAR;
        PG8_STAGE(PG8_SB(1, 0), cB + kstep, voffB); PG8_STAGE(PG8_SA(1, 0), cA + kstep, voffA); PG8_STAGE(PG8_SB(1, 1), cB + hstep + kstep, voffB);
        PG8_WAIT_V(6); PG8_BAR;
    } else {
        PG8_STAGE(PG8_SB(0, 0), cB, voffB); PG8_STAGE(PG8_SA(0, 0), cA, voffA); PG8_STAGE(PG8_SB(0, 1), cB + hstep, voffB); PG8_STAGE(PG8_SA(0, 1), cA + hstep, voffA);
        if (wr == 1) PG8_BAR;
        PG8_WAIT_V(4); PG8_BAR;
        PG8_STAGE(PG8_SB(1, 0), cB + kstep, voffB); PG8_STAGE(PG8_SA(1, 0), cA + kstep, voffA); PG8_STAGE(PG8_SB(1, 1), cB + hstep + kstep, voffB);
        PG8_WAIT_V(6); PG8_BAR;
    }
    for (;;) {
        const bool has_next = S.next(ui + 1, nxt);
        const char* nA = has_next ? (const char*)g.A + (size_t)nxt.pm * tstep : cA; const char* nB = has_next ? (const char*)g.Bt + (size_t)nxt.pn * tstep : cB;
        for (int t = 0; t < nt; t += 2) {
            if constexpr (Epi::KSCALE) { if (t == Epi::KS0 || t == Epi::KS1) E.kscale(acc, cur, t == Epi::KS1 ? 1 : 0, wr, fr); }
            const bool last = (t == nt - 2);
            const char* a1 = cA + (size_t)(t + 1) * kstep;
            const char* a2 = last ? nA : cA + (size_t)(t + 2) * kstep; const char* b2 = last ? nB : cB + (size_t)(t + 2) * kstep;
            const char* a3 = a2 + kstep; const char* b3 = b2 + kstep;
            if (last && has_next) S.a_ready(nxt);
            if constexpr (SP2) {
            PG8_LDB(B0, 0, 0); PG8_LDB(B1, 0, 1); PG8_SCHED; PG8_LDA(At, 0, 0); PG8_STAGE(PG8_SA(1, 1), a1 + hstep, voffA);
            PG8_WAIT_V(8); PG8_WAIT_L(0); PG8_BAR; PG8_MMA(0, 0, At, B0); PG8_MMA(0, 1, At, B1); PG8_BAR; PG8_SCHED;
            PG8_LDA(At, 0, 1); PG8_STAGE(PG8_SB(0, 0), b2, voffB); PG8_STAGE(PG8_SB(0, 1), b2 + hstep, voffB); PG8_STAGE(PG8_SA(0, 0), a2, voffA);
            PG8_WAIT_V(8); PG8_WAIT_L(0); PG8_BAR; PG8_MMA(1, 0, At, B0); PG8_MMA(1, 1, At, B1); PG8_BAR; PG8_SCHED;
            PG8_LDB(B0, 1, 0); PG8_LDB(B1, 1, 1); PG8_SCHED; PG8_LDA(At, 1, 0); PG8_STAGE(PG8_SA(0, 1), a2 + hstep, voffA);
            PG8_WAIT_V(8); PG8_WAIT_L(0); PG8_BAR; PG8_MMA(0, 0, At, B0); PG8_MMA(0, 1, At, B1); PG8_BAR; PG8_SCHED;
            PG8_LDA(At, 1, 1); PG8_STAGE(PG8_SB(1, 0), b3, voffB); PG8_STAGE(PG8_SB(1, 1), b3 + hstep, voffB); PG8_STAGE(PG8_SA(1, 0), a3, voffA);
            PG8_WAIT_V(8); PG8_WAIT_L(0); PG8_BAR; PG8_MMA(1, 0, At, B0); PG8_MMA(1, 1, At, B1); PG8_BAR; PG8_SCHED;
            } else {
            PG8_LDB(B0, 0, 0); PG8_SCHED; PG8_LDA(At, 0, 0); PG8_STAGE(PG8_SA(1, 1), a1 + hstep, voffA);
            PG8_WAIT_L(8); PG8_BAR; PG8_WAIT_L(0); PG8_MMA(0, 0, At, B0); PG8_BAR; PG8_SCHED;
            PG8_LDB(B1, 0, 1); PG8_STAGE(PG8_SB(0, 0), b2, voffB);
            PG8_BAR; PG8_WAIT_L(0); PG8_MMA(0, 1, At, B1); PG8_BAR;
            PG8_LDA(At, 0, 1); PG8_STAGE(PG8_SA(0, 0), a2, voffA);
            PG8_BAR; PG8_WAIT_L(0); PG8_MMA(1, 0, At, B0); PG8_BAR; PG8_SCHED;
            PG8_STAGE(PG8_SB(0, 1), b2 + hstep, voffB);
            PG8_WAIT_V(6); PG8_BAR; PG8_MMA(1, 1, At, B1); PG8_BAR;
            PG8_LDB(B0, 1, 0); PG8_SCHED; PG8_LDA(At, 1, 0); PG8_STAGE(PG8_SA(0, 1), a2 + hstep, voffA);
            PG8_WAIT_L(8); PG8_BAR; PG8_WAIT_L(0); PG8_MMA(0, 0, At, B0); PG8_BAR; PG8_SCHED;
            PG8_LDB(B1, 1, 1); PG8_STAGE(PG8_SB(1, 0), b3, voffB);
            PG8_BAR; PG8_WAIT_L(0); PG8_MMA(0, 1, At, B1); PG8_BAR;
            PG8_LDA(At, 1, 1); PG8_STAGE(PG8_SA(1, 0), a3, voffA);
            PG8_BAR; PG8_WAIT_L(0); PG8_MMA(1, 0, At, B0); PG8_BAR; PG8_SCHED;
            PG8_STAGE(PG8_SB(1, 1), b3 + hstep, voffB);
            PG8_WAIT_V(6); PG8_BAR; PG8_MMA(1, 1, At, B1); PG8_BAR;
            }
        }
        if constexpr (ALIGN_EPI) { if (wr == 0) PG8_BAR; }
        if constexpr (!Epi::AFTER_DRAIN) { E(acc, cur, wr, wc, fr, fq); S.done(cur); }
        if (!has_next) break;
#pragma unroll
        for (int a = 0; a < 2; ++a)
#pragma unroll
            for (int b = 0; b < 2; ++b)
#pragma unroll
                for (int m = 0; m < 4; ++m)
#pragma unroll
                    for (int n = 0; n < 2; ++n) acc[a][b][m][n] = (f32x4){0.f, 0.f, 0.f, 0.f};
        cur = nxt; cA = nA; cB = nB; ++ui;
        if constexpr (ALIGN_EPI) { if (wr == 1) PG8_BAR; }
    }
    PG8_WAIT_V(0);
    if constexpr (!ALIGN_EPI) { if (wr == 0) PG8_BAR; }
    PG8_BAR;
    if constexpr (Epi::AFTER_DRAIN) { E.fused(acc, cur, wr, wc, fr, fq, lds, wid, lane); S.done(cur); }
#undef PG8_SA
#undef PG8_SB
#undef PG8_STAGE
#undef PG8_LDA
#undef PG8_LDB
#undef PG8_MMA
#undef PG8_WAIT_V
#undef PG8_WAIT_L
#undef PG8_BAR
#undef PG8_SCHED
}
}

constexpr int BATCH = 16, SEQ = 2048, DM = 2048, T = BATCH * SEQ, DEPTH = 2;
constexpr int NMEM = 256, DIN = 4096, MEMW = 512;
constexpr int PEER_H = 8, PEER_N = 16384;
constexpr int NWAVES = 8, NTHREADS = NWAVES * 64;
constexpr float EPS = 1e-6f;
constexpr int QA = 0, KA = 768, VA = 1024, QB = 1280, KB = 1792, VB = 2304, QC = 2816, KC = 3584, VC = 3840;
constexpr int OA = 0, OB = 768, OC = 1280;

constexpr size_t MiB = 1u << 20;
constexpr size_t WS_CTL = 0, CTL_ZERO_BYTES = 2 * MiB;
constexpr size_t WS_ROWSQ = 256 * 1024;
constexpr size_t WS_ROPE = 83 * MiB, WS_BIASA = 83 * MiB + 16384;
constexpr size_t WS_WIN = 2 * MiB, WS_WOUT = 34 * MiB, WS_WMQ = 50 * MiB, WS_WMKV = 54 * MiB, WS_WMO = 62 * MiB, WS_WPQ = 66 * MiB, WS_PKEYS = 82 * MiB;
constexpr size_t WS_MEMN = 84 * MiB, WS_KVM = 116 * MiB, WS_PU = 132 * MiB, WS_PV = 260 * MiB, WS_XN = 388 * MiB, WS_QKV = 516 * MiB, WS_ATT = 772 * MiB;
constexpr size_t WS_QM = 900 * MiB, WS_OM = 932 * MiB, WS_MIXSQ = 964 * MiB, MIXSQ_BYTES = 2 * MiB, WS_WIN8 = 966 * MiB, WS_WSC = 982 * MiB, WS_XSC = 982 * MiB + 65536, WS_XSC2 = 982 * MiB + 196608, WS_WSCO = 982 * MiB + 327680, WS_WSCP = 982 * MiB + 344064, WS_WSCM = 982 * MiB + 360448,
                 WS_WOUT8 = 984 * MiB, WS_WPQ8 = 992 * MiB, WS_WMQ8 = 1000 * MiB, WS_END = 1002 * MiB;
constexpr size_t WS_QP = WS_QKV, WS_PIDX = WS_QKV + 128 * MiB, WS_PGATE = WS_QKV + 144 * MiB, WS_PARTI = WS_QKV + 160 * MiB;
constexpr size_t WS_XQH = 900 * MiB, WS_XQL = 932 * MiB;
constexpr size_t WS_ATT8 = 900 * MiB;
constexpr size_t WS_X8 = 772 * MiB;
constexpr size_t WS_XN8 = 836 * MiB;
constexpr int CW_BAR = 4096;

constexpr int RING_OFF = 0, RING_BYTES = 131072;
constexpr int LDSCTL_OFF = RING_BYTES, MISC_OFF = LDSCTL_OFF + 320;
constexpr int LDS_BYTES = 147456;

#define GAS __attribute__((address_space(1)))
#define LAS __attribute__((address_space(3)))
typedef unsigned short bf16;
typedef unsigned v4u __attribute__((ext_vector_type(4)));
typedef unsigned v2u __attribute__((ext_vector_type(2)));
typedef float f32x4 __attribute__((ext_vector_type(4)));
typedef float f32x16 __attribute__((ext_vector_type(16)));
typedef short bf16x8 __attribute__((ext_vector_type(8)));
typedef GAS unsigned gu32;
#define LDS_WAIT() asm volatile("s_waitcnt lgkmcnt(0)" ::: "memory")
#define VM_WAIT() asm volatile("s_waitcnt vmcnt(0)" ::: "memory")
__device__ __forceinline__ unsigned f2bf(float f) { unsigned u = __builtin_bit_cast(unsigned, f); return (u + 0x7fffu + ((u >> 16) & 1u)) >> 16; }
__device__ __forceinline__ unsigned pk2(float lo, float hi) { return f2bf(lo) | (f2bf(hi) << 16); }
__device__ __forceinline__ float bflo(unsigned w) { return __builtin_bit_cast(float, w << 16); }
__device__ __forceinline__ float bfhi(unsigned w) { return __builtin_bit_cast(float, w & 0xffff0000u); }

__device__ __forceinline__ float shx(float v, int k, int lane) { return __builtin_bit_cast(float, __builtin_amdgcn_ds_bpermute((lane ^ k) << 2, __builtin_bit_cast(int, v))); }
#define XB_TMO      128
#define XB_XCNT(j)  (256  + 64 * (j))
#define XB_XSUB(j)  (1280 + 64 * (j))
#define XB_XGEN(j)  (2304 + 64 * (j))
#define XB_TOP      3328
#define XB_TOPGEN   3392
#define XCD_BAR_WORDS 3456
#define XB_SPIN_CAP (1u << 18)

__device__ __forceinline__ unsigned xb_ld(unsigned* p)              { return __hip_atomic_load(p, __ATOMIC_RELAXED, __HIP_MEMORY_SCOPE_AGENT); }
__device__ __forceinline__ unsigned xb_add(unsigned* p, unsigned v) { return __hip_atomic_fetch_add(p, v, __ATOMIC_RELAXED, __HIP_MEMORY_SCOPE_AGENT); }
__device__ __forceinline__ unsigned xb_xcc_id() { return (unsigned)__builtin_amdgcn_s_getreg((3 << 11) | 20) & 0xFu; }
#define XB_SPIN(cond, bar) do { unsigned _sp = 0; while (cond) { __builtin_amdgcn_s_sleep(1); \
    if ((++_sp & 255u) == 0u) { if (xb_ld(&(bar)[XB_TMO])) break; if (_sp > XB_SPIN_CAP) { atomicAdd(&(bar)[XB_TMO], 1u); break; } } } } while (0)

struct XcdBarrier {
    unsigned* bar; unsigned x;
    volatile LAS unsigned* st;
};

__device__ __forceinline__ XcdBarrier xcd_barrier_post(unsigned* bar, volatile LAS unsigned* st) {
    XcdBarrier b; b.bar = bar; b.x = xb_xcc_id(); b.st = st;
    if (threadIdx.x == 0) (void)xb_add(&bar[XB_XCNT(b.x)], 1u);
    return b;
}
__device__ __forceinline__ void xcd_barrier_complete(unsigned* bar, unsigned x, unsigned& nloc, unsigned& nx) {
    const unsigned G = gridDim.x * gridDim.y * gridDim.z;
    unsigned sum, cnt, mine, sp = 0u;
    for (;;) {
        sum = 0u; cnt = 0u; mine = 0u;
#pragma unroll
        for (unsigned j = 0; j < 16; ++j) { const unsigned c = xb_ld(&bar[XB_XCNT(j)]); sum += c; cnt += (c > 0u) ? 1u : 0u; mine = (j == x) ? c : mine; }
        if (sum == G) break;
        __builtin_amdgcn_s_sleep(1);
        if ((++sp & 255u) == 0u) { if (xb_ld(&bar[XB_TMO])) break; if (sp > XB_SPIN_CAP) { atomicAdd(&bar[XB_TMO], 1u); break; } }
    }
    nloc = mine > 0u ? mine : 1u; nx = cnt > 0u ? cnt : 1u;
}

__device__ __forceinline__ void xcd_barrier(const XcdBarrier& b) {
    asm volatile("s_waitcnt vmcnt(0)" ::: "memory");
    __syncthreads();
    if (threadIdx.x == 0) {
        unsigned* bar = b.bar;
        __builtin_amdgcn_s_waitcnt(0);
        unsigned nloc = b.st[0], nx = b.st[1];
        if (nloc == 0u) { xcd_barrier_complete(bar, b.x, nloc, nx); b.st[0] = nloc; b.st[1] = nx; }
        const unsigned old = xb_add(&bar[XB_XSUB(b.x)], 1u);
        const unsigned gen = old / nloc;
        if (old + 1u == (gen + 1u) * nloc) {
            __builtin_amdgcn_fence(__ATOMIC_RELEASE, "agent");
            asm volatile("s_waitcnt vmcnt(0)" ::: "memory");
            const unsigned og = xb_add(&bar[XB_TOP], 1u);
            const unsigned tg = og / nx;
            if (og + 1u == (tg + 1u) * nx) xb_add(&bar[XB_TOPGEN], 1u);
            else XB_SPIN(xb_ld(&bar[XB_TOPGEN]) == tg, bar);
            __builtin_amdgcn_fence(__ATOMIC_ACQUIRE, "agent");
            xb_add(&bar[XB_XGEN(b.x)], 1u);
            asm volatile("s_waitcnt vmcnt(0)" ::: "memory");
        } else {
            XB_SPIN(xb_ld(&bar[XB_XGEN(b.x)]) == gen, bar);
            __builtin_amdgcn_fence(__ATOMIC_ACQUIRE, "agent");
            asm volatile("s_waitcnt vmcnt(0)" ::: "memory");
        }
    }
    __syncthreads();
}

__device__ __forceinline__ float wave_sum(float v, int lane) {
#pragma unroll
    for (int o = 1; o < 64; o <<= 1) v += shx(v, o, lane);
    return v;
}
__device__ __forceinline__ void* ldptr(LAS unsigned char* lds, int i) {
    const unsigned long long v = ((const LAS unsigned long long*)(lds + LDSCTL_OFF + 1024))[i];
    const unsigned lo = __builtin_amdgcn_readfirstlane((unsigned)v), hi = __builtin_amdgcn_readfirstlane((unsigned)(v >> 32));
    return (void*)(((unsigned long long)hi << 32) | lo);
}
struct OffsetOrder {
    pg8::StaticOrder S;
    __device__ __forceinline__ void init(int M, int N, int G, int c, int off) { S.init(M, N, G, (c + G - off % G) % G); }
    __device__ __forceinline__ bool next(int i, pg8::Unit& u) const { return S.next(i, u); }
    __device__ __forceinline__ void a_ready(const pg8::Unit&) const {}
    __device__ __forceinline__ void done(const pg8::Unit&) const {}
};

template <bool PERMQKV>
__device__ __forceinline__ void transpose_item(const float* W, int K, int N, bf16* WT, LAS float* scr, int item, int lane, const float* gk = nullptr) {
    const int nblk = N / 32, kb = item / nblk, nb = item % nblk, k0 = 64 * kb, n0 = 32 * nb;
    int d0 = n0;
    if (PERMQKV) { const int within = n0 & 255; d0 = (n0 & ~255) + 128 * ((within >> 5) & 1) + 32 * (within >> 6); }
#pragma unroll
    for (int i = 0; i < 8; ++i) { const int kk = 8 * i + (lane >> 3), nn = 4 * (lane & 7);
        const f32x4 w4 = *(const GAS f32x4*)(W + (size_t)(k0 + kk) * N + n0 + nn) * (gk ? gk[k0 + kk] : 1.f);
        scr[kk * 33 + nn] = w4[0]; scr[kk * 33 + nn + 1] = w4[1]; scr[kk * 33 + nn + 2] = w4[2]; scr[kk * 33 + nn + 3] = w4[3]; }
    LDS_WAIT(); asm volatile("" ::: "memory");
    const int c = lane & 7;
#pragma unroll
    for (int j = 0; j < 4; ++j) { const int n = (lane >> 3) + 8 * j; const LAS float* s = scr + (8 * c) * 33 + n;
        v4u o; o.x = pk2(s[0 * 33], s[1 * 33]); o.y = pk2(s[2 * 33], s[3 * 33]); o.z = pk2(s[4 * 33], s[5 * 33]); o.w = pk2(s[6 * 33], s[7 * 33]);
        *(GAS v4u*)(WT + (size_t)(d0 + n) * K + k0 + 8 * c) = o; }
    LDS_WAIT(); asm volatile("" ::: "memory");
}
__device__ __forceinline__ void convert_bf16(const float* src, bf16* dst, size_t n, size_t gtid, size_t nthreads) {
    for (size_t i = gtid * 8; i < n; i += nthreads * 8) {
        const f32x4 a = *(const GAS f32x4*)(src + i), b = *(const GAS f32x4*)(src + i + 4);
        v4u o; o.x = pk2(a[0], a[1]); o.y = pk2(a[2], a[3]); o.z = pk2(b[0], b[1]); o.w = pk2(b[2], b[3]);
        *(GAS v4u*)(dst + i) = o;
    }
}
__device__ __forceinline__ int t5_bucket(int rel) {
    const int n = rel < 0 ? -rel : rel;
    const int b = n < 8 ? n : n < 12 ? 8 : n < 16 ? 9 : n < 23 ? 10 : n < 32 ? 11 : n < 46 ? 12 : n < 64 ? 13 : n < 91 ? 14 : 15;
    return b + (rel > 0 ? 16 : 0);
}
__constant__ float ROPE_INV[16] = {1.000000000e+00f, 5.623413324e-01f, 3.162277639e-01f, 1.778279394e-01f, 1.000000015e-01f, 5.623413250e-02f, 3.162277490e-02f, 1.778279431e-02f,
                                   9.999999776e-03f, 5.623413250e-03f, 3.162277630e-03f, 1.778279431e-03f, 1.000000047e-03f, 5.623413017e-04f, 3.162277571e-04f, 1.778279402e-04f};

__device__ __forceinline__ void rms_row_to_bf16(const float* xrow, const float* g0, bf16* o0, const float* g1, bf16* o1, int lane) {
    const GAS f32x4* xr = (const GAS f32x4*)xrow + lane;
    f32x4 v[8]; float s = 0.f;
#pragma unroll
    for (int j = 0; j < 8; ++j) { v[j] = xr[64 * j]; s += (v[j].x * v[j].x + v[j].y * v[j].y) + (v[j].z * v[j].z + v[j].w * v[j].w); }
    const float rstd = 1.f / sqrtf(wave_sum(s, lane) * (1.f / DM) + EPS);
    {   const GAS f32x4* gr = (const GAS f32x4*)g0 + lane; GAS v2u* o8 = (GAS v2u*)o0 + lane;
#pragma unroll
        for (int j = 0; j < 8; ++j) { const f32x4 gg = gr[64 * j]; v2u w; w.x = pk2(v[j].x * rstd * gg.x, v[j].y * rstd * gg.y); w.y = pk2(v[j].z * rstd * gg.z, v[j].w * rstd * gg.w); o8[64 * j] = w; } }
    if (g1) { const GAS f32x4* gr = (const GAS f32x4*)g1 + lane; GAS v2u* o8 = (GAS v2u*)o1 + lane;
#pragma unroll
        for (int j = 0; j < 8; ++j) { const f32x4 gg = gr[64 * j]; v2u w; w.x = pk2(v[j].x * rstd * gg.x, v[j].y * rstd * gg.y); w.y = pk2(v[j].z * rstd * gg.z, v[j].w * rstd * gg.w); o8[64 * j] = w; } }
}
__device__ __forceinline__ float wave_max(float v, int lane) {
#pragma unroll
    for (int o = 1; o < 64; o <<= 1) v = fmaxf(v, shx(v, o, lane));
    return v;
}
__device__ __forceinline__ unsigned q8x4(const f32x4 v, const float inv) {
    unsigned w = 0;
    w = __builtin_amdgcn_cvt_pk_u8_f32(__builtin_rintf(__builtin_fmaf(v[0], inv, 128.f)), 0, w); w = __builtin_amdgcn_cvt_pk_u8_f32(__builtin_rintf(__builtin_fmaf(v[1], inv, 128.f)), 1, w);
    w = __builtin_amdgcn_cvt_pk_u8_f32(__builtin_rintf(__builtin_fmaf(v[2], inv, 128.f)), 2, w); w = __builtin_amdgcn_cvt_pk_u8_f32(__builtin_rintf(__builtin_fmaf(v[3], inv, 128.f)), 3, w);
    return w ^ 0x80808080u;
}
__device__ __forceinline__ float amax4(const f32x4 v) { return fmaxf(fmaxf(fabsf(v[0]), fabsf(v[1])), fmaxf(fabsf(v[2]), fabsf(v[3]))); }
__device__ __forceinline__ void quant_wrow(const bf16* src, unsigned char* dst, float* step, int lane) {
    v4u w[4]; float am = 0.f;
#pragma unroll
    for (int j = 0; j < 4; ++j) w[j] = *(const GAS v4u*)(src + 8 * lane + 512 * j);
    f32x4 lo[4], hi[4];
#pragma unroll
    for (int j = 0; j < 4; ++j) { lo[j] = (f32x4){bflo(w[j].x), bfhi(w[j].x), bflo(w[j].y), bfhi(w[j].y)}; hi[j] = (f32x4){bflo(w[j].z), bfhi(w[j].z), bflo(w[j].w), bfhi(w[j].w)}; am = fmaxf(am, fmaxf(amax4(lo[j]), amax4(hi[j]))); }
    am = fmaxf(wave_max(am, lane), 1e-30f);
    const float inv = 127.f / am;
#pragma unroll
    for (int j = 0; j < 4; ++j) *(GAS v2u*)(dst + 8 * lane + 512 * j) = (v2u){q8x4(lo[j], inv), q8x4(hi[j], inv)};
    if (lane == 0) *step = am * (1.f / 127.f);
}
template <int R>
__device__ __forceinline__ void att_quant_rows(const bf16* ATT, const u64_t* mixsq, unsigned char* Q, float* step, int row0, int lane) {
    v4u w[R][4];
#pragma unroll
    for (int q = 0; q < R; ++q)
#pragma unroll
        for (int j = 0; j < 4; ++j) w[q][j] = *(const GAS v4u*)(ATT + (size_t)(row0 + q) * DM + 8 * lane + 512 * j);
#pragma unroll
    for (int q = 0; q < R; ++q) { const int row = row0 + q;
        const float ra = 1.0f / sqrtf((float)*(const GAS u64_t*)(mixsq + row) * (5.9604644775390625e-08f / 768.0f) + EPS), rb = 1.0f / sqrtf((float)*(const GAS u64_t*)(mixsq + T + row) * (5.9604644775390625e-08f / 512.0f) + EPS),
                    rc = 1.0f / sqrtf((float)*(const GAS u64_t*)(mixsq + 2 * (size_t)T + row) * (5.9604644775390625e-08f / 768.0f) + EPS);
        const float rj[4] = {ra, lane < 32 ? ra : rb, lane < 32 ? rb : rc, rc};
        f32x4 lo[4], hi[4]; float am = 0.f;
#pragma unroll
        for (int j = 0; j < 4; ++j) { lo[j] = (f32x4){bflo(w[q][j].x), bfhi(w[q][j].x), bflo(w[q][j].y), bfhi(w[q][j].y)} * rj[j]; hi[j] = (f32x4){bflo(w[q][j].z), bfhi(w[q][j].z), bflo(w[q][j].w), bfhi(w[q][j].w)} * rj[j]; am = fmaxf(am, fmaxf(amax4(lo[j]), amax4(hi[j]))); }
        am = fmaxf(wave_max(am, lane), 1e-30f);
        const float inv = 127.f / am;
#pragma unroll
        for (int j = 0; j < 4; ++j) *(GAS v2u*)(Q + (size_t)row * DM + 8 * lane + 512 * j) = (v2u){q8x4(lo[j], inv), q8x4(hi[j], inv)};
        if (lane == 0) step[row] = am * (1.f / 127.f); }
}
__device__ __forceinline__ void prep_rows2(const float* x0, bf16* o0, u64_t* sq, unsigned char* q0, float* qstep, int lane) {
    f32x4 v[2][8];
#pragma unroll
    for (int q = 0; q < 2; ++q) { const GAS f32x4* xr = (const GAS f32x4*)(x0 + (size_t)q * DM) + lane;
#pragma unroll
        for (int j = 0; j < 8; ++j) v[q][j] = xr[64 * j]; }
#pragma unroll
    for (int q = 0; q < 2; ++q) { GAS v2u* o8 = (GAS v2u*)(o0 + (size_t)q * DM) + lane; float s = 0.f;
#pragma unroll
        for (int j = 0; j < 8; ++j) { const f32x4 a = v[q][j]; s += (a.x * a.x + a.y * a.y) + (a.z * a.z + a.w * a.w); v2u w; w.x = pk2(a.x, a.y); w.y = pk2(a.z, a.w); o8[64 * j] = w; }
        s = wave_sum(s, lane);
        float am = 0.f;
#pragma unroll
        for (int j = 0; j < 8; ++j) am = fmaxf(am, amax4(v[q][j]));
        am = fmaxf(wave_max(am, lane), 1e-30f);
        const float inv = 127.f / am;
#pragma unroll
        for (int j = 0; j < 8; ++j) *(GAS unsigned*)(q0 + (size_t)q * DM + 4 * lane + 256 * j) = q8x4(v[q][j], inv);
        if (lane == 0) { sq[q] = rowsq_fx(s); qstep[q] = am * (1.f / 127.f) / sqrtf(s * (1.f / DM) + 1e-6f); } }
}
__device__ __forceinline__ void norm_rows(const float* X, const float* g, bf16* XN, int gw, int NGW, int lane) {
    for (int m = gw; m < T; m += NGW) rms_row_to_bf16(X + (size_t)m * DM, g, XN + (size_t)m * DM, nullptr, nullptr, lane);
}

template <int TYPE>
__device__ __forceinline__ void naive_attn_item(const bf16* QKV, bf16* ATT, int b, int grow, int head, int lane, const float* biasA, const float* sink, const float* rpb) {
    const int tpos = grow * 64 + lane; const size_t trow = (size_t)b * SEQ + tpos;
    int qcol, kcol, vcol, ocol;
    if (TYPE == 0) { qcol = QA + head * 64; kcol = KA + (head / 3) * 64; vcol = VA + (head / 3) * 64; ocol = OA + head * 64; }
    else if (TYPE == 1) { qcol = QB + head * 64; kcol = KB + head * 64; vcol = VB + head * 64; ocol = OB + head * 64; }
    else { qcol = QC + head * 64; kcol = KC + (head / 3) * 64; vcol = VC + (head / 3) * 64; ocol = OC + head * 64; }
    float q[64], o[64];
#pragma unroll
    for (int c = 0; c < 8; ++c) { const v4u w = *(const GAS v4u*)(QKV + trow * DIN + qcol + 8 * c);
        q[8 * c + 0] = bflo(w.x); q[8 * c + 1] = bfhi(w.x); q[8 * c + 2] = bflo(w.y); q[8 * c + 3] = bfhi(w.y); q[8 * c + 4] = bflo(w.z); q[8 * c + 5] = bfhi(w.z); q[8 * c + 6] = bflo(w.w); q[8 * c + 7] = bfhi(w.w); }
#pragma unroll
    for (int d = 0; d < 64; ++d) o[d] = 0.f;
    float m = -1e30f, l = 0.f;
    int j0, j1;
    if (TYPE == 0) { j0 = grow * 64 - 128; if (j0 < 0) j0 = 0; j1 = grow * 64 + 63 + 128; if (j1 > SEQ - 1) j1 = SEQ - 1; }
    else if (TYPE == 1) { int r0 = grow - 4; r0 = r0 < 0 ? 0 : (r0 > 24 ? 24 : r0); j0 = r0 * 64; j1 = j0 + 511; }
    else { j0 = 0; j1 = SEQ - 1; }
    int c0 = lane - 8; c0 = c0 < 0 ? 0 : (c0 > 48 ? 48 : c0);
#pragma unroll 1
    for (int j = j0; j <= j1; ++j) {
        const bf16* krow = QKV + ((size_t)b * SEQ + j) * DIN;
        float s = 0.f;
#pragma unroll
        for (int c = 0; c < 8; ++c) { const v4u w = *(const GAS v4u*)(krow + kcol + 8 * c);
            s += q[8 * c + 0] * bflo(w.x) + q[8 * c + 1] * bfhi(w.x) + q[8 * c + 2] * bflo(w.y) + q[8 * c + 3] * bfhi(w.y) + q[8 * c + 4] * bflo(w.z) + q[8 * c + 5] * bfhi(w.z) + q[8 * c + 6] * bflo(w.w) + q[8 * c + 7] * bfhi(w.w); }
        bool valid = true;
        if (TYPE == 0) { const int rel = j - tpos; valid = (rel >= -128 && rel <= 128); if (valid) s += biasA[head * 257 + rel + 128]; }
        if (TYPE == 1) { const int kr = j >> 6, kc = j & 63; valid = (kc >= c0 && kc < c0 + 16); if (valid) s += rpb[(head * 15 + (kr - grow + 7)) * 31 + (kc - lane + 15)]; }
        const float mn = valid ? fmaxf(m, s) : m;
        const float a = __expf(m - mn);
        const float p = valid ? __expf(s - mn) : 0.f;
        l = l * a + p; m = mn;
#pragma unroll
        for (int c = 0; c < 8; ++c) { const v4u w = *(const GAS v4u*)(krow + vcol + 8 * c);
            o[8 * c + 0] = o[8 * c + 0] * a + p * bflo(w.x); o[8 * c + 1] = o[8 * c + 1] * a + p * bfhi(w.x); o[8 * c + 2] = o[8 * c + 2] * a + p * bflo(w.y); o[8 * c + 3] = o[8 * c + 3] * a + p * bfhi(w.y);
            o[8 * c + 4] = o[8 * c + 4] * a + p * bflo(w.z); o[8 * c + 5] = o[8 * c + 5] * a + p * bfhi(w.z); o[8 * c + 6] = o[8 * c + 6] * a + p * bflo(w.w); o[8 * c + 7] = o[8 * c + 7] * a + p * bfhi(w.w); }
    }
    if (TYPE == 0) l += __expf(sink[head] - m);
    const float inv = 1.f / l;
#pragma unroll
    for (int c = 0; c < 8; ++c) { v4u w; w.x = pk2(o[8 * c + 0] * inv, o[8 * c + 1] * inv); w.y = pk2(o[8 * c + 2] * inv, o[8 * c + 3] * inv); w.z = pk2(o[8 * c + 4] * inv, o[8 * c + 5] * inv); w.w = pk2(o[8 * c + 6] * inv, o[8 * c + 7] * inv);
        *(GAS v4u*)(ATT + trow * DM + ocol + 8 * c) = w; }
}
__device__ __forceinline__ float rdl(float v, int l) { return __builtin_bit_cast(float, __builtin_amdgcn_readlane(__builtin_bit_cast(int, v), l)); }
__device__ __forceinline__ void naive_mem_item(const bf16* QM, const bf16* KVM, bf16* OM, const float* gq, size_t trow, int b, int head, int lane) {
    const unsigned qw = *(const GAS unsigned*)(QM + trow * MEMW + head * 128 + 2 * lane);
    float q0 = bflo(qw), q1 = bfhi(qw);
    const float ss = wave_sum(q0 * q0 + q1 * q1, lane);
    const float r = 0.08838834764831845f / sqrtf(ss * (1.f / 128.f) + EPS);
    q0 *= r * gq[2 * lane]; q1 *= r * gq[2 * lane + 1];
    const bf16* kbase = KVM + ((size_t)b * NMEM + lane) * 1024 + head * 128;
    float s[4] = {0.f, 0.f, 0.f, 0.f};
#pragma unroll 1
    for (int c = 0; c < 16; ++c) {
        float qa[8];
#pragma unroll
        for (int e = 0; e < 4; ++e) { qa[2 * e] = rdl(q0, 4 * c + e); qa[2 * e + 1] = rdl(q1, 4 * c + e); }
#pragma unroll
        for (int i = 0; i < 4; ++i) { const v4u w = *(const GAS v4u*)(kbase + (size_t)i * 64 * 1024 + 8 * c);
            s[i] += qa[0] * bflo(w.x) + qa[1] * bfhi(w.x) + qa[2] * bflo(w.y) + qa[3] * bfhi(w.y) + qa[4] * bflo(w.z) + qa[5] * bfhi(w.z) + qa[6] * bflo(w.w) + qa[7] * bfhi(w.w); }
    }
    float m = fmaxf(fmaxf(s[0], s[1]), fmaxf(s[2], s[3]));
#pragma unroll
    for (int o = 1; o < 64; o <<= 1) m = fmaxf(m, shx(m, o, lane));
    float p[4]; float l = 0.f;
#pragma unroll
    for (int i = 0; i < 4; ++i) { p[i] = __expf(s[i] - m); l += p[i]; }
    l = wave_sum(l, lane);
    const bf16* vbase = KVM + ((size_t)b * NMEM) * 1024 + 512 + head * 128 + 2 * lane;
    float o0 = 0.f, o1 = 0.f;
#pragma unroll
    for (int i = 0; i < 4; ++i) {
#pragma unroll 4
        for (int jj = 0; jj < 64; ++jj) { const float pj = rdl(p[i], jj); const unsigned w = *(const GAS unsigned*)(vbase + (size_t)(64 * i + jj) * 1024); o0 += pj * bflo(w); o1 += pj * bfhi(w); }
    }
    const float inv = 1.f / l;
    *(GAS unsigned*)(OM + trow * MEMW + head * 128 + 2 * lane) = pk2(o0 * inv, o1 * inv);
}
__device__ __forceinline__ void mixnorm_rows(bf16* ATT, const float* g, int gw, int NGW, int lane) {
    for (int m = gw; m < T; m += NGW) {
        GAS v4u* p = (GAS v4u*)(ATT + (size_t)m * DM + 32 * lane);
        v4u w[4]; float f[32]; float ss = 0.f;
#pragma unroll
        for (int c = 0; c < 4; ++c) { w[c] = p[c];
            f[8 * c + 0] = bflo(w[c].x); f[8 * c + 1] = bfhi(w[c].x); f[8 * c + 2] = bflo(w[c].y); f[8 * c + 3] = bfhi(w[c].y); f[8 * c + 4] = bflo(w[c].z); f[8 * c + 5] = bfhi(w[c].z); f[8 * c + 6] = bflo(w[c].w); f[8 * c + 7] = bfhi(w[c].w); }
#pragma unroll
        for (int i = 0; i < 32; ++i) ss += f[i] * f[i];
        const int grp = lane < 24 ? 0 : (lane < 40 ? 1 : 2);
        const float sa = wave_sum(grp == 0 ? ss : 0.f, lane), sb = wave_sum(grp == 1 ? ss : 0.f, lane), sc = wave_sum(grp == 2 ? ss : 0.f, lane);
        const float r = grp == 0 ? 1.f / sqrtf(sa * (1.f / 768.f) + EPS) : (grp == 1 ? 1.f / sqrtf(sb * (1.f / 512.f) + EPS) : 1.f / sqrtf(sc * (1.f / 768.f) + EPS));
        const float* gg = g + 32 * lane;
#pragma unroll
        for (int c = 0; c < 4; ++c) { const f32x4 g0 = *(const GAS f32x4*)(gg + 8 * c), g1 = *(const GAS f32x4*)(gg + 8 * c + 4);
            v4u o; o.x = pk2(f[8 * c + 0] * r * g0[0], f[8 * c + 1] * r * g0[1]); o.y = pk2(f[8 * c + 2] * r * g0[2], f[8 * c + 3] * r * g0[3]);
            o.z = pk2(f[8 * c + 4] * r * g1[0], f[8 * c + 5] * r * g1[1]); o.w = pk2(f[8 * c + 6] * r * g1[2], f[8 * c + 7] * r * g1[3]); p[c] = o; }
    }
}

#ifndef PEER_HD
#define PEER_HD __device__ __forceinline__
#define PEER_EXP(x) __expf(x)
#endif
template <int N> PEER_HD void bitonic_sort_desc(float* v) {
#pragma unroll
    for (int k = 2; k <= N; k <<= 1)
#pragma unroll
        for (int j = k >> 1; j > 0; j >>= 1)
#pragma unroll
            for (int i = 0; i < N; ++i) { const int l = i ^ j; if (l > i) { const bool desc = ((i & k) == 0); const float a = v[i], b = v[l]; const float hi = fmaxf(a, b), lo = fminf(a, b);
                v[i] = desc ? hi : lo; v[l] = desc ? lo : hi; } }
}
PEER_HD void merge_top16(float* a, const float* b) {
    float c[16];
#pragma unroll
    for (int i = 0; i < 16; ++i) c[i] = fmaxf(a[i], b[15 - i]);
#pragma unroll
    for (int j = 8; j > 0; j >>= 1)
#pragma unroll
        for (int i = 0; i < 16; ++i) { const int l = i ^ j; if (l > i) { const float x = c[i], y = c[l]; c[i] = fmaxf(x, y); c[l] = fminf(x, y); } }
#pragma unroll
    for (int i = 0; i < 16; ++i) a[i] = c[i];
}
PEER_HD void top16_of_64(float (&v)[64]) {
    bitonic_sort_desc<16>(&v[0]); bitonic_sort_desc<16>(&v[16]); bitonic_sort_desc<16>(&v[32]); bitonic_sort_desc<16>(&v[48]);
    merge_top16(&v[0], &v[16]); merge_top16(&v[32], &v[48]); merge_top16(&v[0], &v[32]);
}
PEER_HD float pack_idx(float s, unsigned idx, unsigned mask) { return __builtin_bit_cast(float, (__builtin_bit_cast(unsigned, s) & ~mask) | idx); }
PEER_HD unsigned low_bits(float s, unsigned mask) { return __builtin_bit_cast(unsigned, s) & mask; }
PEER_HD unsigned pick16(const float* a, unsigned i, unsigned mask) {
    unsigned r = 0;
#pragma unroll
    for (unsigned k = 0; k < 16; ++k) r = (i == k) ? low_bits(a[k], mask) : r;
    return r;
}
PEER_HD void peer_candidates(const float* a, const float* b, int* e, float* gate) {
    float c[64]; int n = 0;
#pragma unroll
    for (int i = 0; i < 16; ++i)
#pragma unroll
        for (int j = 0; j < 16; ++j) if ((i + 1) * (j + 1) <= 16) { c[n] = pack_idx(a[i] + b[j], (unsigned)(i * 16 + j), 0xffu); ++n; }
#pragma unroll
    for (int k = 50; k < 64; ++k) c[k] = -3.0e38f;
    top16_of_64(c);
    float mx = c[0], den = 0.f;
#pragma unroll
    for (int k = 0; k < 16; ++k) { const unsigned id = low_bits(c[k], 0xffu); const unsigned n0 = pick16(a, id >> 4, 0x7fu), n1 = pick16(b, id & 15u, 0x7fu);
        e[k] = (int)(n0 * 128u + n1); gate[k] = PEER_EXP(c[k] - mx); den += gate[k]; }
    const float inv = 1.f / den;
#pragma unroll
    for (int k = 0; k < 16; ++k) gate[k] *= inv;
}

__device__ __forceinline__ void peer_select_unit(const bf16* QP, const bf16* PK, int* PIDX, float* PGATE, int tb, int h, int wave, int lane) {
    const int hh = lane >> 5, tl = lane & 31; const size_t t = (size_t)tb * 256 + wave * 32 + tl;
    float ab[2][16];
#pragma unroll
    for (int p = 0; p < 2; ++p) {
        bf16x8 bq[8];
#pragma unroll
        for (int s = 0; s < 8; ++s) bq[s] = *(const GAS bf16x8*)(QP + t * DM + 256 * h + 128 * p + 16 * s + 8 * hh);
        float v[64];
#pragma unroll
        for (int nb = 0; nb < 4; ++nb) {
            f32x16 acc;
#pragma unroll
            for (int r = 0; r < 16; ++r) acc[r] = 0.f;
            const bf16* kp = PK + ((size_t)((h * 2 + p) * 128 + 32 * nb + tl)) * 128 + 8 * hh;
            bf16x8 ak[8];
#pragma unroll
            for (int s = 0; s < 8; ++s) ak[s] = *(const GAS bf16x8*)(kp + 16 * s);
#pragma unroll
            for (int s = 0; s < 8; ++s) acc = __builtin_amdgcn_mfma_f32_32x32x16_bf16(ak[s], bq[s], acc, 0, 0, 0);
#pragma unroll
            for (int r = 0; r < 16; ++r) v[16 * nb + r] = pack_idx(acc[r], (unsigned)(32 * nb + 8 * (r >> 2) + 4 * hh + (r & 3)), 0x7fu);
        }
        top16_of_64(v);
        float pv[16];
#pragma unroll
        for (int i = 0; i < 16; ++i) pv[i] = shx(v[i], 32, lane);
        merge_top16(&v[0], pv);
#pragma unroll
        for (int i = 0; i < 16; ++i) ab[p][i] = v[i];
    }
    int e[16]; float gate[16];
    peer_candidates(ab[0], ab[1], e, gate);
    if (hh == 0) { GAS v4u* o = (GAS v4u*)(PIDX + t * 128 + h * 16);
#pragma unroll
        for (int c = 0; c < 4; ++c) o[c] = (v4u){(unsigned)e[4 * c], (unsigned)e[4 * c + 1], (unsigned)e[4 * c + 2], (unsigned)e[4 * c + 3]}; }
    else { GAS f32x4* o = (GAS f32x4*)(PGATE + t * 128 + h * 16);
#pragma unroll
        for (int c = 0; c < 4; ++c) o[c] = (f32x4){gate[4 * c], gate[4 * c + 1], gate[4 * c + 2], gate[4 * c + 3]}; }
}

typedef float f32x2 __attribute__((ext_vector_type(2)));
typedef unsigned v6u __attribute__((ext_vector_type(6)));
typedef float v32f __attribute__((ext_vector_type(32)));
typedef v4u __attribute__((aligned(8))) v4u_a8;
constexpr float PU_SCALE6 = 90.0f, PV_SCALE6 = 5.65f;
__device__ __forceinline__ unsigned enc_e2m3(float v) {
    const float a = fminf(fabsf(v), 7.5f);
    unsigned code;
    if (a < 1.0f) code = (unsigned)__builtin_rintf(a * 8.f);
    else { const unsigned b = __builtin_bit_cast(unsigned, a) - 0x3F800000u; code = ((b + 0x7FFFFu + ((b >> 20) & 1u)) >> 20) + 8u; }
    return code | (v < 0.f ? 32u : 0u);
}
__device__ __forceinline__ void convert_fp6_rows(const float* src, unsigned char* dst, int nrows, float scale, const float* gain, int gw, int NGW, int lane) {
    for (int r = gw; r < nrows; r += NGW) {
        const float* sp = src + (size_t)r * DM + 4 * lane; const float* gp = gain ? gain + (size_t)(r / PEER_N) * DM + 4 * lane : nullptr;
        unsigned w[6] = {0u, 0u, 0u, 0u, 0u, 0u};
#pragma unroll
        for (int j = 0; j < 8; ++j) { f32x4 a = *(const GAS f32x4*)(sp + 256 * j) * scale; if (gp) a = a * *(const GAS f32x4*)(gp + 256 * j);
#pragma unroll
            for (int e = 0; e < 4; ++e) { const unsigned code = enc_e2m3(a[e]); const int bp = 6 * (4 * j + e), wi = bp >> 5, sh = bp & 31;
                w[wi] |= code << sh; if (sh > 26) w[wi + 1] |= code >> (32 - sh); } }
        unsigned char* dp = dst + (size_t)r * 1536 + 24 * lane;
        *(GAS v4u_a8*)dp = (v4u){w[0], w[1], w[2], w[3]}; *(GAS v2u*)(dp + 16) = (v2u){w[4], w[5]};
    }
}
constexpr float PV_SCALE4 = 5.65f, PU_SCALE4 = 90.0f;
__device__ __forceinline__ unsigned enc_e2m1(float v) {
    const float a = fabsf(v);
    const unsigned code = a < 0.25f ? 0u : a < 0.75f ? 1u : a < 1.25f ? 2u : a < 1.75f ? 3u : a < 2.5f ? 4u : a < 3.5f ? 5u : a < 5.0f ? 6u : 7u;
    return code | (v < 0.f ? 8u : 0u);
}
__device__ __forceinline__ void convert_fp4_rows(const float* src, unsigned char* dst, int nrows, float scale, const float* gain, int gw, int NGW, int lane) {
    for (int r0 = 2 * gw; r0 < nrows; r0 += 2 * NGW) {
        f32x4 a[2][8];
#pragma unroll
        for (int q = 0; q < 2; ++q) { const float* sp = src + (size_t)(r0 + q) * DM + 4 * lane;
#pragma unroll
            for (int j = 0; j < 8; ++j) a[q][j] = *(const GAS f32x4*)(sp + 256 * j); }
#pragma unroll
        for (int q = 0; q < 2; ++q) { const int r = r0 + q; const float* gp = gain ? gain + (size_t)(r / PEER_N) * DM + 4 * lane : nullptr;
            unsigned w[4] = {0u, 0u, 0u, 0u};
#pragma unroll
            for (int j = 0; j < 8; ++j) { f32x4 v = a[q][j] * scale; if (gp) v = v * *(const GAS f32x4*)(gp + 256 * j);
#pragma unroll
                for (int e = 0; e < 4; ++e) { const int i = 4 * j + e; w[i >> 3] |= enc_e2m1(v[e]) << (4 * (i & 7)); } }
            *(GAS v4u*)(dst + (size_t)r * 1024 + 16 * lane) = (v4u){w[0], w[1], w[2], w[3]}; }
    }
}
#define PG4_LOAD(buf, tab, idlo, idhi, g) do { _Pragma("unroll") for (int i_ = 0; i_ < PG6_R; ++i_) { const int k_ = (g) * PG6_R + i_; \
        const int e_ = __builtin_amdgcn_readlane(k_ < 64 ? idlo : idhi, k_ & 63); buf[i_] = __builtin_amdgcn_raw_buffer_load_b128(tab, (int)voff4, e_ * 1024, 0); } } while (0)
#define PG4_DOT1(buf, i_, dst) do { f32x2 a_ = {0.f, 0.f}; _Pragma("unroll") for (int c_ = 0; c_ < 4; ++c_) { const unsigned u_ = buf[i_][c_]; \
        a_ += __builtin_amdgcn_cvt_scalef32_pk_f32_fp4(u_, 1.0f, 0) * x[4 * c_ + 0]; a_ += __builtin_amdgcn_cvt_scalef32_pk_f32_fp4(u_, 1.0f, 1) * x[4 * c_ + 1]; \
        a_ += __builtin_amdgcn_cvt_scalef32_pk_f32_fp4(u_, 1.0f, 2) * x[4 * c_ + 2]; a_ += __builtin_amdgcn_cvt_scalef32_pk_f32_fp4(u_, 1.0f, 3) * x[4 * c_ + 3]; } dst = a_.x + a_.y; __builtin_amdgcn_sched_barrier(0); } while (0)
#define PG4_DOT(buf, g) do { float p_[8]; _Pragma("unroll") for (int i_ = 0; i_ < 8; ++i_) PG4_DOT1(buf, i_, p_[i_]); \
        float q_[4]; _Pragma("unroll") for (int i_ = 0; i_ < 4; ++i_) { const float keep_ = b5 ? p_[i_ + 4] : p_[i_], send_ = b5 ? p_[i_] : p_[i_ + 4]; q_[i_] = keep_ + shx(send_, 32, lane); } \
        float r_[2]; _Pragma("unroll") for (int i_ = 0; i_ < 2; ++i_) { const float keep_ = b4 ? q_[i_ + 2] : q_[i_], send_ = b4 ? q_[i_] : q_[i_ + 2]; r_[i_] = keep_ + shx(send_, 16, lane); } \
        float s_; { const float keep_ = b3 ? r_[1] : r_[0], send_ = b3 ? r_[0] : r_[1]; s_ = keep_ + shx(send_, 8, lane); } \
        s_ += shx(s_, 4, lane); s_ += shx(s_, 2, lane); s_ += shx(s_, 1, lane); \
        if ((lane & 7) == 0) wl[(g) * 8 + (lane >> 3)] = s_; } while (0)
#define PG4_AXPY(buf, g) do { _Pragma("unroll") for (int i_ = 0; i_ < PG6_R; ++i_) { const float w_ = wl[(g) * PG6_R + i_]; const f32x2 wv_ = {w_, w_}; \
        _Pragma("unroll") for (int c_ = 0; c_ < 4; ++c_) { const unsigned u_ = buf[i_][c_]; \
            y[4 * c_ + 0] += __builtin_amdgcn_cvt_scalef32_pk_f32_fp4(u_, 1.0f, 0) * wv_; y[4 * c_ + 1] += __builtin_amdgcn_cvt_scalef32_pk_f32_fp4(u_, 1.0f, 1) * wv_; \
            y[4 * c_ + 2] += __builtin_amdgcn_cvt_scalef32_pk_f32_fp4(u_, 1.0f, 2) * wv_; y[4 * c_ + 3] += __builtin_amdgcn_cvt_scalef32_pk_f32_fp4(u_, 1.0f, 3) * wv_; } \
        __builtin_amdgcn_sched_barrier(0); } } while (0)
#ifndef PG6_R
#define PG6_R 8
#endif
#define PG6_LOAD(buf, tab, idlo, idhi, g) do { _Pragma("unroll") for (int i_ = 0; i_ < PG6_R; ++i_) { const int k_ = (g) * PG6_R + i_; \
        const int e_ = __builtin_amdgcn_readlane(k_ < 64 ? idlo : idhi, k_ & 63); const unsigned char* rp_ = (tab) + (size_t)(unsigned)e_ * 1536u; \
        const v4u a_ = *(const GAS v4u_a8*)(rp_ + voff); const v2u b_ = *(const GAS v2u*)(rp_ + voff + 16); buf[i_] = (v6u){a_.x, a_.y, a_.z, a_.w, b_.x, b_.y}; } } while (0)
#define PG6_DOT1(buf, i_, dst) do { const v32f f_ = __builtin_amdgcn_cvt_scalef32_pk32_f32_fp6(buf[i_], 1.0f); f32x2 a_ = {0.f, 0.f}; \
        _Pragma("unroll") for (int c_ = 0; c_ < 16; ++c_) a_ += (f32x2){f_[2 * c_], f_[2 * c_ + 1]} * x[c_]; dst = a_.x + a_.y; __builtin_amdgcn_sched_barrier(0); } while (0)
#if PG6_R == 8
#define PG6_DOT(buf, g) do { float p_[8]; _Pragma("unroll") for (int i_ = 0; i_ < 8; ++i_) PG6_DOT1(buf, i_, p_[i_]); \
        float q_[4]; _Pragma("unroll") for (int i_ = 0; i_ < 4; ++i_) { const float keep_ = b5 ? p_[i_ + 4] : p_[i_], send_ = b5 ? p_[i_] : p_[i_ + 4]; q_[i_] = keep_ + shx(send_, 32, lane); } \
        float r_[2]; _Pragma("unroll") for (int i_ = 0; i_ < 2; ++i_) { const float keep_ = b4 ? q_[i_ + 2] : q_[i_], send_ = b4 ? q_[i_] : q_[i_ + 2]; r_[i_] = keep_ + shx(send_, 16, lane); } \
        float s_; { const float keep_ = b3 ? r_[1] : r_[0], send_ = b3 ? r_[0] : r_[1]; s_ = keep_ + shx(send_, 8, lane); } \
        s_ += shx(s_, 4, lane); s_ += shx(s_, 2, lane); s_ += shx(s_, 1, lane); \
        if ((lane & 7) == 0) wl[(g) * 8 + (lane >> 3)] = s_; } while (0)
#else
#define PG6_DOT(buf, g) do { float p_[4]; _Pragma("unroll") for (int i_ = 0; i_ < 4; ++i_) PG6_DOT1(buf, i_, p_[i_]); \
        float r_[2]; _Pragma("unroll") for (int i_ = 0; i_ < 2; ++i_) { const float keep_ = b5 ? p_[i_ + 2] : p_[i_], send_ = b5 ? p_[i_] : p_[i_ + 2]; r_[i_] = keep_ + shx(send_, 32, lane); } \
        float s_; { const float keep_ = b4 ? r_[1] : r_[0], send_ = b4 ? r_[0] : r_[1]; s_ = keep_ + shx(send_, 16, lane); } \
        s_ += shx(s_, 8, lane); s_ += shx(s_, 4, lane); s_ += shx(s_, 2, lane); s_ += shx(s_, 1, lane); \
        if ((lane & 15) == 0) wl[(g) * 4 + (lane >> 4)] = s_; } while (0)
#endif
#define PG6_AXPY(buf, g) do { _Pragma("unroll") for (int i_ = 0; i_ < PG6_R; ++i_) { const float w_ = wl[(g) * PG6_R + i_]; const f32x2 wv_ = {w_, w_}; \
        const v32f f_ = __builtin_amdgcn_cvt_scalef32_pk32_f32_fp6(buf[i_], 1.0f); _Pragma("unroll") for (int c_ = 0; c_ < 16; ++c_) y[c_] += (f32x2){f_[2 * c_], f_[2 * c_ + 1]} * wv_; __builtin_amdgcn_sched_barrier(0); } } while (0)
__device__ __forceinline__ unsigned shxu(unsigned v, int k, int lane) { return (unsigned)__builtin_amdgcn_ds_bpermute((lane ^ k) << 2, (int)v); }
__device__ __forceinline__ void wave_sort128(unsigned& a, unsigned& b, int lane) {
#pragma unroll
    for (int k = 2; k <= 128; k <<= 1) {
#pragma unroll
        for (int j = k >> 1; j > 0; j >>= 1) {
            if (j == 64) { const unsigned lo = a < b ? a : b, hi = a < b ? b : a; a = lo; b = hi; }
            else {
                const unsigned pa = shxu(a, j, lane), pb = shxu(b, j, lane);
                const bool lower = (lane & j) == 0;
                const bool asc_a = (lane & k) == 0, asc_b = ((lane + 64) & k) == 0;
                const bool take_min_a = (lower == asc_a), take_min_b = (lower == asc_b);
                a = take_min_a ? (a < pa ? a : pa) : (a < pa ? pa : a);
                b = take_min_b ? (b < pb ? b : pb) : (b < pb ? pb : b);
            }
        }
    }
}
#ifndef PEER_U_FP4
#define PEER_U_FP4 1
#endif
#if PEER_U_FP4
typedef v4u urow_t;
#define PGU_LOAD PG4_LOAD
#define PGU_DOT PG4_DOT
constexpr float PU_SCALE = PU_SCALE4; constexpr int PU_STRIDE = 1024;
#else
typedef v6u urow_t;
#define PGU_LOAD PG6_LOAD
#define PGU_DOT PG6_DOT
constexpr float PU_SCALE = PU_SCALE6; constexpr int PU_STRIDE = 1536;
#endif
constexpr float PU_SCALEI = 135.0f, PX_SCALEI = 20.0f;
__device__ __forceinline__ void peer_v_pass(bf16* XN, const unsigned char* PV6, const int* PIDX, const float* PGATE, const int* PARTI, float* X, u64_t* rowsq_out, unsigned char* XN8, float* xsc, LAS float* wl, int gw, int NGW, int lane) {
    const unsigned voff4 = 16u * (unsigned)lane, l4 = 4u * (unsigned)lane, l8 = 8u * (unsigned)lane, l16 = 16u * (unsigned)lane;
    constexpr int NG = 128 / PG6_R;
    const __amdgpu_buffer_rsrc_t PVr = __builtin_amdgcn_make_buffer_rsrc((void*)PV6, 0, PEER_N * 1024, 0x00020000);
    for (int t_ = gw; t_ < T; t_ += NGW) {
        int t = t_; asm volatile("" : "+s"(t));
        const char* pidx_t = (const char*)(PIDX + (size_t)t * 128); const char* pgate_t = (const char*)(PGATE + (size_t)t * 128);
        const int idlo = *(const GAS int*)(pidx_t + l4), idhi = *(const GAS int*)(pidx_t + l4 + 256);
        v4u AV[PG6_R], BV[PG6_R];
        PG4_LOAD(AV, PVr, idlo, idhi, 0);
        {
            int s0 = 0, s1 = 0;
#pragma unroll
            for (int sp = 0; sp < 8; ++sp) { const char* pp = (const char*)(PARTI + ((size_t)sp * T + t) * 128); s0 += *(const GAS int*)(pp + l4); s1 += *(const GAS int*)(pp + l4 + 256); }
            const float d0 = (float)s0 * (1.f / (PX_SCALEI * PU_SCALEI)), d1 = (float)s1 * (1.f / (PX_SCALEI * PU_SCALEI));
            const float g0 = *(const GAS float*)(pgate_t + l4), g1 = *(const GAS float*)(pgate_t + l4 + 256);
            const float w0 = g0 * 0.5f * d0 * (1.f + erff(d0 * 0.70710678118654752f)) * (1.f / PV_SCALE4), w1 = g1 * 0.5f * d1 * (1.f + erff(d1 * 0.70710678118654752f)) * (1.f / PV_SCALE4);
            wl[lane] = w0; wl[64 + lane] = w1;
            LDS_WAIT(); asm volatile("" ::: "memory");
        }
        f32x2 y[16];
#pragma unroll
        for (int i = 0; i < 16; ++i) y[i] = (f32x2){0.f, 0.f};
#pragma unroll 1
        for (int g = 0; g < NG; g += 2) {
            PG4_LOAD(BV, PVr, idlo, idhi, g + 1);
            PG4_AXPY(AV, g);
            if (g + 2 < NG) PG4_LOAD(AV, PVr, idlo, idhi, g + 2);
            PG4_AXPY(BV, g + 1);
        }
        {   char* xo = (char*)(X + (size_t)t * DM);
            char* xbo = (char*)(XN + (size_t)t * DM); float ss = 0.f;
#pragma unroll
            for (int j = 0; j < 8; ++j) { const v2u a = *(const GAS v2u*)(xbo + l8 + 512 * j); f32x4 v = (f32x4){bflo(a.x), bfhi(a.x), bflo(a.y), bfhi(a.y)}; v += (f32x4){y[2 * j].x, y[2 * j].y, y[2 * j + 1].x, y[2 * j + 1].y};
                if (X) *(GAS f32x4*)(xo + l16 + 1024 * j) = v;
                y[2 * j] = (f32x2){v[0], v[1]}; y[2 * j + 1] = (f32x2){v[2], v[3]};
                ss += (v[0] * v[0] + v[1] * v[1]) + (v[2] * v[2] + v[3] * v[3]); *(GAS v2u*)(xbo + l8 + 512 * j) = (v2u){pk2(v[0], v[1]), pk2(v[2], v[3])}; }
            if (rowsq_out) { ss = wave_sum(ss, lane); if (lane == 0) rowsq_out[t] = rowsq_fx(ss); }
            if (XN8) {
                float am = 0.f;
#pragma unroll
                for (int j = 0; j < 16; ++j) am = fmaxf(am, fmaxf(fabsf(y[j].x), fabsf(y[j].y)));
                am = fmaxf(wave_max(am, lane), 1e-30f);
                const float inv = 127.f / am; char* qo = (char*)(XN8 + (size_t)t * DM);
#pragma unroll
                for (int j = 0; j < 8; ++j) *(GAS unsigned*)(qo + l4 + 256 * j) = q8x4((f32x4){y[2 * j].x, y[2 * j].y, y[2 * j + 1].x, y[2 * j + 1].y}, inv);
                if (lane == 0) xsc[t] = am * (1.f / 127.f) / sqrtf(ss * (1.f / DM) + 1e-6f); } }
        LDS_WAIT(); asm volatile("" ::: "memory");
    }
}


__device__ __forceinline__ unsigned enc_i4(float v) { int q = (int)__builtin_rintf(v); q = q < -7 ? -7 : (q > 7 ? 7 : q); return (unsigned)q & 15u; }
__device__ __forceinline__ void convert_int4_plain(const float* src, unsigned char* dst, int nrows, float scale, const float* gain, int gw, int NGW, int lane) {
    for (int r0 = 2 * gw; r0 < nrows; r0 += 2 * NGW) {
        f32x4 a[2][8];
#pragma unroll
        for (int q = 0; q < 2; ++q) { const float* sp = src + (size_t)(r0 + q) * DM + 4 * lane;
#pragma unroll
            for (int j = 0; j < 8; ++j) a[q][j] = *(const GAS f32x4*)(sp + 256 * j); }
#pragma unroll
        for (int q = 0; q < 2; ++q) { const int r = r0 + q; const float* gp = gain ? gain + (size_t)(r / PEER_N) * DM + 4 * lane : nullptr;
#pragma unroll
            for (int j = 0; j < 8; ++j) { f32x4 v = a[q][j] * scale; if (gp) v = v * *(const GAS f32x4*)(gp + 256 * j);
                const unsigned w = enc_i4(v[0]) | (enc_i4(v[1]) << 4) | (enc_i4(v[2]) << 8) | (enc_i4(v[3]) << 12);
                *(GAS unsigned short*)(dst + (size_t)r * 1024 + 128 * j + 2 * lane) = (unsigned short)w; } }
    }
}
__device__ __forceinline__ void peer_xquant_unit(const bf16* XN, const u64_t* rowsq, unsigned* XQH, unsigned* XQL, int tb, int sl, int tid) {
    for (int it = tid; it < 256 * 32; it += NTHREADS) {
        const int t = tb * 256 + (it >> 5), c8 = it & 31;
        const float xs = PX_SCALEI * rowsq_rs(rowsq, t);
        const v4u w = *(const GAS v4u*)(XN + (size_t)t * DM + 256 * sl + 8 * c8);
        const float f[8] = {bflo(w.x), bfhi(w.x), bflo(w.y), bfhi(w.y), bflo(w.z), bfhi(w.z), bflo(w.w), bfhi(w.w)};
        unsigned hi = 0u, lo = 0u;
#pragma unroll
        for (int j = 0; j < 8; ++j) { int q = (int)__builtin_rintf(f[j] * xs); q = q < -119 ? -119 : (q > 119 ? 119 : q);
            const int xl = ((q + 8) & 15) - 8, xh = (q - xl) >> 4;
            hi |= ((unsigned)xh & 15u) << (4 * j); lo |= ((unsigned)xl & 15u) << (4 * j); }
        XQH[(size_t)t * 256 + 32 * sl + c8] = hi; XQL[(size_t)t * 256 + 32 * sl + c8] = lo;
    }
}
#define PI_LOADROWS(buf, tab, ids, i0) do { _Pragma("unroll") for (int i_ = 0; i_ < 8; ++i_) buf[i_] = __builtin_amdgcn_raw_buffer_load_b128(tab, ids[(i0) + i_] * 1024 + (int)soff, 0, 0); } while (0)
#define PI_LOADIDS(ids, t) do { const char* ip_ = (const char*)PIDX + ((size_t)(t) * 128 + 16 * g) * 4; _Pragma("unroll") for (int c_ = 0; c_ < 4; ++c_) { const v4u q_ = *(const GAS v4u*)(ip_ + 16 * c_); \
        ids[4 * c_] = (int)q_.x; ids[4 * c_ + 1] = (int)q_.y; ids[4 * c_ + 2] = (int)q_.z; ids[4 * c_ + 3] = (int)q_.w; } } while (0)
#define PI_UGROUP(buf, i0) do { _Pragma("unroll") for (int i_ = 0; i_ < 8; ++i_) { int ah_ = 0, al_ = 0; \
        _Pragma("unroll") for (int c_ = 0; c_ < 4; ++c_) { ah_ = __builtin_amdgcn_sdot8((int)buf[i_][c_], (int)xh[c_], ah_, false); al_ = __builtin_amdgcn_sdot8((int)buf[i_][c_], (int)xl[c_], al_, false); } \
        int p_ = 16 * ah_ + al_; p_ += __builtin_amdgcn_ds_bpermute((lane ^ 1) << 2, p_); p_ += __builtin_amdgcn_ds_bpermute((lane ^ 2) << 2, p_); p_ += __builtin_amdgcn_ds_bpermute((lane ^ 4) << 2, p_); \
        if (m == (((i0) + i_) >> 1)) { if (((i0) + i_) & 1) keep1 = p_; else keep0 = p_; } } } while (0)
#define PI_LOADROWS16(buf, tab, ids) do { _Pragma("unroll") for (int i_ = 0; i_ < 16; ++i_) buf[i_] = __builtin_amdgcn_raw_buffer_load_b128(tab, ids[i_] * 1024 + (int)soff, 0, 0); } while (0)
#define PI_LOADX(xh_, xl_, t) do { xh_ = *(const GAS v4u*)((const char*)XQH + (size_t)(t) * 1024 + soff); xl_ = *(const GAS v4u*)((const char*)XQL + (size_t)(t) * 1024 + soff); } while (0)
#define PI_COMPUTE16(buf, xh_, xl_, t) do { int keep0 = 0, keep1 = 0; \
        _Pragma("unroll") for (int i_ = 0; i_ < 16; ++i_) { int ah_ = 0, al_ = 0; \
            _Pragma("unroll") for (int c_ = 0; c_ < 4; ++c_) { ah_ = __builtin_amdgcn_sdot8((int)buf[i_][c_], (int)xh_[c_], ah_, false); al_ = __builtin_amdgcn_sdot8((int)buf[i_][c_], (int)xl_[c_], al_, false); } \
            int p_ = 16 * ah_ + al_; p_ += __builtin_amdgcn_update_dpp(0, p_, 0xB1, 0xf, 0xf, true); p_ += __builtin_amdgcn_update_dpp(0, p_, 0x4E, 0xf, 0xf, true); p_ += __builtin_amdgcn_update_dpp(0, p_, 0x141, 0xf, 0xf, true);   \
            if (m == (i_ >> 1)) { if (i_ & 1) keep1 = p_; else keep0 = p_; } } \
        if ((t) < T) *(GAS v2u*)(PARTI + ((size_t)s * T + (t)) * 128 + 2 * lane) = (v2u){(unsigned)keep0, (unsigned)keep1}; } while (0)
__device__ __forceinline__ void peer_u_phase_i4(const unsigned* XQH, const unsigned* XQL, const unsigned char* PU, const int* PIDX, int* PARTI, int bid, int G, int wave, int lane) {
    const int s = bid & 7, nr = (G - s + 7) >> 3, q = (bid >> 3) * NWAVES + wave, stride = nr * NWAVES, g = lane >> 3, m = lane & 7;
    const unsigned soff = 128u * (unsigned)s + 16u * (unsigned)m;
    if (q >= T) return;
    const __amdgpu_buffer_rsrc_t PUr = __builtin_amdgcn_make_buffer_rsrc((void*)PU, 0, PEER_N * 1024, 0x00020000);
#define PI_CL(t) ((t) < T ? (t) : T - 1)
    int I1[16], I2[16]; v4u xh0, xl0, xh1, xl1, xh2, xl2, RA[16], RB[16];
    PI_LOADIDS(I1, q); PI_LOADX(xh0, xl0, q);
    PI_LOADROWS16(RA, PUr, I1);
    PI_LOADIDS(I1, PI_CL(q + stride)); PI_LOADX(xh1, xl1, PI_CL(q + stride));
    for (int t = q; t < T; t += 2 * stride) {
        PI_LOADROWS16(RB, PUr, I1);
        PI_LOADIDS(I2, PI_CL(t + 2 * stride)); PI_LOADX(xh2, xl2, PI_CL(t + 2 * stride));
        PI_COMPUTE16(RA, xh0, xl0, t);
        PI_LOADROWS16(RA, PUr, I2);
        PI_LOADIDS(I1, PI_CL(t + 3 * stride)); PI_LOADX(xh0, xl0, PI_CL(t + 3 * stride));
        PI_COMPUTE16(RB, xh1, xl1, t + stride);
        xh1 = xh0; xl1 = xl0; xh0 = xh2; xl0 = xl2;
    }
#undef PI_CL
}


constexpr float PV_SCALE4S = 5.65f;
__device__ __forceinline__ unsigned enc_e2m1s(float v) {
    const float a = fabsf(v);
    const unsigned code = a < 0.25f ? 0u : a < 0.75f ? 1u : a < 1.25f ? 2u : a < 1.75f ? 3u : a < 2.5f ? 4u : a < 3.5f ? 5u : a < 5.0f ? 6u : 7u;
    return code | (v < 0.f ? 8u : 0u);
}
__device__ __forceinline__ void convert_fp4_plain(const float* src, unsigned char* dst, int nrows, float scale, const float* gain, int gw, int NGW, int lane) {
    for (int r0 = 2 * gw; r0 < nrows; r0 += 2 * NGW) {
        f32x4 a[2][8];
#pragma unroll
        for (int q = 0; q < 2; ++q) { const float* sp = src + (size_t)(r0 + q) * DM + 4 * lane;
#pragma unroll
            for (int j = 0; j < 8; ++j) a[q][j] = *(const GAS f32x4*)(sp + 256 * j); }
#pragma unroll
        for (int q = 0; q < 2; ++q) { const int r = r0 + q; const float* gp = gain ? gain + (size_t)(r / PEER_N) * DM + 4 * lane : nullptr;
#pragma unroll
            for (int j = 0; j < 8; ++j) { f32x4 v = a[q][j] * scale; if (gp) v = v * *(const GAS f32x4*)(gp + 256 * j);
                const unsigned w = enc_e2m1s(v[0]) | (enc_e2m1s(v[1]) << 4) | (enc_e2m1s(v[2]) << 8) | (enc_e2m1s(v[3]) << 12);
                *(GAS unsigned short*)(dst + (size_t)r * 1024 + 128 * j + 2 * lane) = (unsigned short)w; } }
    }
}
#define PVS_LOADMETA(ids, pp, gg, t) do { PI_LOADIDS(ids, t); _Pragma("unroll") for (int sp_ = 0; sp_ < 8; ++sp_) pp[sp_] = *(const GAS v2u*)(PARTI + ((size_t)sp_ * T + (t)) * 128 + 2 * lane); \
        gg = *(const GAS f32x2*)(PGATE + (size_t)(t) * 128 + 2 * lane); } while (0)
#define PVS_COMPUTE16(buf, pp, gg, t) do { float w0, w1; { int s0_ = 0, s1_ = 0; _Pragma("unroll") for (int sp_ = 0; sp_ < 8; ++sp_) { s0_ += (int)pp[sp_].x; s1_ += (int)pp[sp_].y; } \
            const float d0_ = (float)s0_ * (1.f / (PX_SCALEI * PU_SCALEI)), d1_ = (float)s1_ * (1.f / (PX_SCALEI * PU_SCALEI)); \
            w0 = gg.x * 0.5f * d0_ * (1.f + erff(d0_ * 0.70710678118654752f)) * (1.f / PV_SCALE4S); w1 = gg.y * 0.5f * d1_ * (1.f + erff(d1_ * 0.70710678118654752f)) * (1.f / PV_SCALE4S); } \
        f32x2 y[16]; _Pragma("unroll") for (int i_ = 0; i_ < 16; ++i_) y[i_] = (f32x2){0.f, 0.f}; \
        _Pragma("unroll") for (int i_ = 0; i_ < 16; ++i_) { \
            const float w_ = __builtin_bit_cast(float, __builtin_amdgcn_ds_bpermute(((lane & 56) | (i_ >> 1)) << 2, __builtin_bit_cast(int, (i_ & 1) ? w1 : w0))); const f32x2 wv_ = {w_, w_}; \
            _Pragma("unroll") for (int c_ = 0; c_ < 4; ++c_) { const unsigned u_ = buf[i_][c_]; \
                y[4 * c_ + 0] += __builtin_amdgcn_cvt_scalef32_pk_f32_fp4(u_, 1.0f, 0) * wv_; y[4 * c_ + 1] += __builtin_amdgcn_cvt_scalef32_pk_f32_fp4(u_, 1.0f, 1) * wv_; \
                y[4 * c_ + 2] += __builtin_amdgcn_cvt_scalef32_pk_f32_fp4(u_, 1.0f, 2) * wv_; y[4 * c_ + 3] += __builtin_amdgcn_cvt_scalef32_pk_f32_fp4(u_, 1.0f, 3) * wv_; } } \
        {   LAS float* wp_ = yl + g * 288 + m * 36; \
            _Pragma("unroll") for (int c_ = 0; c_ < 8; ++c_) *(LAS f32x4*)(wp_ + 4 * c_) = (f32x4){y[2 * c_].x, y[2 * c_].y, y[2 * c_ + 1].x, y[2 * c_ + 1].y}; \
            LDS_WAIT(); asm volatile("" ::: "memory"); \
            f32x4 acc_ = {0.f, 0.f, 0.f, 0.f}; const LAS float* rp_ = yl + (lane >> 3) * 36 + 4 * (lane & 7); \
            _Pragma("unroll") for (int gg_ = 0; gg_ < 8; ++gg_) acc_ += *(const LAS f32x4*)(rp_ + gg_ * 288); \
            LDS_WAIT(); asm volatile("" ::: "memory"); \
            if ((t) < T) { bf16* xp_ = XN + (size_t)(t) * DM + 256 * s + 4 * lane; const v2u a_ = *(const GAS v2u*)xp_; \
                const f32x4 v_ = (f32x4){bflo(a_.x), bfhi(a_.x), bflo(a_.y), bfhi(a_.y)} + acc_; \
                *(GAS v2u*)xp_ = (v2u){pk2(v_[0], v_[1]), pk2(v_[2], v_[3])}; \
                if (Xout) *(GAS f32x4*)(Xout + (size_t)(t) * DM + 256 * s + 4 * lane) = v_; \
                if (rowsq_out) { const float ss_ = wave_sum((v_[0] * v_[0] + v_[1] * v_[1]) + (v_[2] * v_[2] + v_[3] * v_[3]), lane); if (lane == 0) atomicAdd(rowsq_out + (t), rowsq_fx(ss_)); } } } } while (0)
__device__ __forceinline__ void peer_v_phase_s(bf16* XN, const unsigned char* PV, const int* PIDX, const float* PGATE, const int* PARTI, float* Xout, u64_t* rowsq_out, LAS float* yl, int bid, int G, int wave, int lane) {
    const int s = bid & 7, nr = (G - s + 7) >> 3, q = (bid >> 3) * NWAVES + wave, stride = nr * NWAVES, g = lane >> 3, m = lane & 7;
    const unsigned soff = 128u * (unsigned)s + 16u * (unsigned)m;
    if (q >= T) return;
    const __amdgpu_buffer_rsrc_t PVr = __builtin_amdgcn_make_buffer_rsrc((void*)PV, 0, PEER_N * 1024, 0x00020000);
#define PVS_CL(t) ((t) < T ? (t) : T - 1)
    int I0[16], I1[16]; v2u P0[8], P1[8]; f32x2 G0, G1; v4u RA[16], RB[16];
#define PVS_LOADPG(pp, gg, t) do { _Pragma("unroll") for (int sp_ = 0; sp_ < 8; ++sp_) pp[sp_] = *(const GAS v2u*)(PARTI + ((size_t)sp_ * T + (t)) * 128 + 2 * lane); gg = *(const GAS f32x2*)(PGATE + (size_t)(t) * 128 + 2 * lane); } while (0)
    PI_LOADIDS(I0, q); PVS_LOADPG(P0, G0, q);
    PI_LOADROWS16(RA, PVr, I0);
    PI_LOADIDS(I1, PVS_CL(q + stride)); PVS_LOADPG(P1, G1, PVS_CL(q + stride));
    for (int t = q; t < T; t += 2 * stride) {
        PI_LOADROWS16(RB, PVr, I1);
        PI_LOADIDS(I0, PVS_CL(t + 2 * stride));
        PVS_COMPUTE16(RA, P0, G0, t);
        PVS_LOADPG(P0, G0, PVS_CL(t + 2 * stride));
        PI_LOADROWS16(RA, PVr, I0);
        PI_LOADIDS(I1, PVS_CL(t + 3 * stride));
        PVS_COMPUTE16(RB, P1, G1, t + stride);
        PVS_LOADPG(P1, G1, PVS_CL(t + 3 * stride));
    }
#undef PVS_LOADPG
#undef PVS_CL
}

typedef short s16x4 __attribute__((ext_vector_type(4)));
typedef __attribute__((address_space(3))) const char* lds_cptr;
__device__ __forceinline__ s16x4 vtr(lds_cptr p) { return __builtin_bit_cast(s16x4, __builtin_amdgcn_ds_read_tr16_b64_v4i16((__attribute__((address_space(3))) s16x4*)p)); }
__device__ __forceinline__ unsigned cvtpk(float lo, float hi) { unsigned r; asm("v_cvt_pk_bf16_f32 %0, %1, %2" : "=v"(r) : "v"(lo), "v"(hi)); return r; }
constexpr int AT_K0 = 0, AT_V0 = 16384, AT_TAB = 32768;
constexpr float LOG2E = 1.4426950408889634f;
template <int TYPE>
__device__ __forceinline__ void attn_unit(LAS unsigned char* lds, const bf16* QKV, bf16* ATT, u64_t* mixsq, int b, int head, int qb, const float* tabsrc, float Cl2, float sinkl2, int tid) {
    const int lane = tid & 63, w = __builtin_amdgcn_readfirstlane(tid >> 6), hh = lane >> 5, l31 = lane & 31;
    int qcol, kcol, vcol, ocol;
    if (TYPE == 0) { qcol = QA + head * 64; kcol = KA + (head / 3) * 64; vcol = VA + (head / 3) * 64; ocol = OA + head * 64; }
    else if (TYPE == 1) { qcol = QB + head * 64; kcol = KB + head * 64; vcol = VB + head * 64; ocol = OB + head * 64; }
    else { qcol = QC + head * 64; kcol = KC + (head / 3) * 64; vcol = VC + (head / 3) * 64; ocol = OC + head * 64; }
    const int q0 = 256 * qb + 32 * w, qpos = q0 + l31;
    int t_begin, t_end;
    if (TYPE == 0) { t_begin = 4 * qb - 2; if (t_begin < 0) t_begin = 0; t_end = 4 * qb + 6; if (t_end > 32) t_end = 32; }
    else if (TYPE == 1) { int a = 4 * qb - 4; a = a < 0 ? 0 : (a > 24 ? 24 : a); int e = 4 * qb - 1; e = e < 0 ? 0 : (e > 24 ? 24 : e); t_begin = a; t_end = e + 8; }
    else { t_begin = 0; t_end = 32; }
    LAS float* tab = (LAS float*)(lds + AT_TAB);
    if (TYPE == 0) { for (int i = tid; i < 1024; i += NTHREADS) { const int rel = i - 448; tab[i] = (rel >= -128 && rel <= 128) ? tabsrc[head * 257 + rel + 128] * LOG2E - Cl2 : -1e30f; } }
    if (TYPE == 1) { for (int i = tid; i < 15 * 31; i += NTHREADS) tab[i] = tabsrc[head * 465 + i] * LOG2E - Cl2; }
    bf16x8 qf[4];
    {   const bf16* qp = QKV + ((size_t)b * SEQ + qpos) * DIN + qcol + 8 * hh;
#pragma unroll
        for (int s = 0; s < 4; ++s) qf[s] = *(const GAS bf16x8*)(qp + 16 * s); }
    const int srow = tid >> 3, sch = tid & 7;
    const bf16* kg = QKV + ((size_t)b * SEQ + srow) * DIN + kcol + sch * 8;
    const bf16* vg = QKV + ((size_t)b * SEQ + srow) * DIN + vcol + sch * 8;
    const int kst = srow * 128 + ((sch ^ ((srow >> 1) & 7)) * 16);
    const int vst = srow * 128 + (((sch >> 2) ^ ((srow >> 1) & 1)) * 64) + (sch & 3) * 16;
    int kread[4], vread[2];
#pragma unroll
    for (int s = 0; s < 4; ++s) kread[s] = l31 * 128 + (((2 * s + hh) ^ ((lane >> 1) & 7)) * 16);
#pragma unroll
    for (int db = 0; db < 2; ++db) vread[db] = (4 * hh + ((lane >> 2) & 3)) * 128 + ((db ^ ((lane >> 3) & 1)) * 64) + 32 * ((lane >> 4) & 1) + 8 * (lane & 3);
    f32x16 O0, O1;
#pragma unroll
    for (int r = 0; r < 16; ++r) { O0[r] = 0.f; O1[r] = 0.f; }
    float lsum = 0.f;
    const int rw = 4 * qb + (w >> 1), cq = 32 * (w & 1) + l31;
    int r0w = rw - 4; r0w = r0w < 0 ? 0 : (r0w > 24 ? 24 : r0w);
    int c0 = cq - 8; c0 = c0 < 0 ? 0 : (c0 > 48 ? 48 : c0);
    {   const v4u kr = *(const GAS v4u*)(kg + (size_t)t_begin * 64 * DIN), vr = *(const GAS v4u*)(vg + (size_t)t_begin * 64 * DIN);
        *(LAS v4u*)(lds + AT_K0 + kst) = kr; *(LAS v4u*)(lds + AT_V0 + vst) = vr; }
    __syncthreads();
    for (int t = t_begin; t < t_end; ++t) {
        const int cur = (t - t_begin) & 1;
        v4u kr, vr;
        if (t + 1 < t_end) { kr = *(const GAS v4u*)(kg + (size_t)(t + 1) * 64 * DIN); vr = *(const GAS v4u*)(vg + (size_t)(t + 1) * 64 * DIN); }
        bool need = true;
        if (TYPE == 0) need = (64 * t <= q0 + 31 + 128) && (64 * t + 63 >= q0 - 128);
        if (TYPE == 1) need = (t >= r0w) && (t < r0w + 8);
        if (need) {
            const lds_cptr kb_ = (lds_cptr)(lds + AT_K0 + cur * 8192), vb_ = (lds_cptr)(lds + AT_V0 + cur * 8192);
            bf16x8 kf[8];
#pragma unroll
            for (int s = 0; s < 4; ++s) { kf[2 * s] = *(const LAS bf16x8*)(kb_ + kread[s]); kf[2 * s + 1] = *(const LAS bf16x8*)(kb_ + kread[s] + 4096); }
            f32x16 S0, S1;
            if (TYPE == 2) {
#pragma unroll
                for (int r = 0; r < 16; ++r) { S0[r] = -Cl2; S1[r] = -Cl2; }
            } else if (TYPE == 0) {
                const LAS float* tb = tab + (64 * t - qpos + 448 + 4 * hh);
#pragma unroll
                for (int r = 0; r < 16; ++r) { S0[r] = tb[8 * (r >> 2) + (r & 3)]; S1[r] = tb[32 + 8 * (r >> 2) + (r & 3)]; }
            } else {
                const LAS float* tb = tab + ((t - rw + 7) * 31 - cq + 15 + 4 * hh);
                const int kc0 = 4 * hh - c0;
#pragma unroll
                for (int r = 0; r < 16; ++r) { const int ka = 8 * (r >> 2) + (r & 3), kb2 = 32 + ka;
                    S0[r] = ((unsigned)(ka + kc0) < 16u) ? tb[ka] : -1e30f; S1[r] = ((unsigned)(kb2 + kc0) < 16u) ? tb[kb2] : -1e30f; }
            }
            __builtin_amdgcn_sched_barrier(0);
#pragma unroll
            for (int s = 0; s < 4; ++s) { S0 = __builtin_amdgcn_mfma_f32_32x32x16_bf16(kf[2 * s], qf[s], S0, 0, 0, 0); S1 = __builtin_amdgcn_mfma_f32_32x32x16_bf16(kf[2 * s + 1], qf[s], S1, 0, 0, 0); }
            s16x4 vf[4][2][2];
#pragma unroll
            for (int ks = 0; ks < 2; ++ks)
#pragma unroll
                for (int db = 0; db < 2; ++db) { vf[ks][db][0] = vtr(vb_ + vread[db] + (16 * ks) * 128); vf[ks][db][1] = vtr(vb_ + vread[db] + (16 * ks + 8) * 128); }
            __builtin_amdgcn_sched_barrier(0);
#pragma unroll
            for (int r = 0; r < 16; ++r) { S0[r] = __builtin_amdgcn_exp2f(S0[r]); S1[r] = __builtin_amdgcn_exp2f(S1[r]); }
#pragma unroll
            for (int r = 0; r < 16; ++r) lsum += S0[r] + S1[r];
            bf16x8 pb[4];
#pragma unroll
            for (int hf = 0; hf < 2; ++hf) {
                v4u a, c;
#pragma unroll
                for (int j = 0; j < 4; ++j) { a[j] = cvtpk(S0[8 * hf + 2 * j], S0[8 * hf + 2 * j + 1]); c[j] = cvtpk(S1[8 * hf + 2 * j], S1[8 * hf + 2 * j + 1]); }
                pb[hf] = __builtin_bit_cast(bf16x8, a); pb[2 + hf] = __builtin_bit_cast(bf16x8, c);
            }
#pragma unroll
            for (int ks = 2; ks < 4; ++ks)
#pragma unroll
                for (int db = 0; db < 2; ++db) { vf[ks][db][0] = vtr(vb_ + vread[db] + (16 * ks) * 128); vf[ks][db][1] = vtr(vb_ + vread[db] + (16 * ks + 8) * 128); }
            __builtin_amdgcn_sched_barrier(0);
#pragma unroll
            for (int ks = 0; ks < 4; ++ks) {
                const bf16x8 va = __builtin_shufflevector(vf[ks][0][0], vf[ks][0][1], 0, 1, 2, 3, 4, 5, 6, 7), vb2 = __builtin_shufflevector(vf[ks][1][0], vf[ks][1][1], 0, 1, 2, 3, 4, 5, 6, 7);
                O0 = __builtin_amdgcn_mfma_f32_32x32x16_bf16(va, pb[ks], O0, 0, 0, 0); O1 = __builtin_amdgcn_mfma_f32_32x32x16_bf16(vb2, pb[ks], O1, 0, 0, 0);
            }
        }
        __builtin_amdgcn_sched_barrier(0);
        if (t + 1 < t_end) { *(LAS v4u*)(lds + AT_K0 + (cur ^ 1) * 8192 + kst) = kr; *(LAS v4u*)(lds + AT_V0 + (cur ^ 1) * 8192 + vst) = vr; }
        __syncthreads();
    }
    lsum += shx(lsum, 32, lane);
    if (TYPE == 0) lsum += __builtin_amdgcn_exp2f(sinkl2 - Cl2);
    const float inv = 1.f / lsum;
    {   float ss = 0.f;
#pragma unroll
        for (int r = 0; r < 16; ++r) { const float a = O0[r] * inv, c = O1[r] * inv; ss += a * a + c * c; }
        ss += shx(ss, 32, lane);
        if (hh == 0) (void)__hip_atomic_fetch_add((GAS u64_t*)(mixsq + (size_t)b * SEQ + qpos), rowsq_fx(ss), __ATOMIC_RELAXED, __HIP_MEMORY_SCOPE_AGENT); }
    bf16* op = ATT + ((size_t)b * SEQ + qpos) * DM + ocol + 4 * hh;
#pragma unroll
    for (int g4 = 0; g4 < 4; ++g4) {
        v2u o0, o1; o0.x = cvtpk(O0[4 * g4] * inv, O0[4 * g4 + 1] * inv); o0.y = cvtpk(O0[4 * g4 + 2] * inv, O0[4 * g4 + 3] * inv);
        o1.x = cvtpk(O1[4 * g4] * inv, O1[4 * g4 + 1] * inv); o1.y = cvtpk(O1[4 * g4 + 2] * inv, O1[4 * g4 + 3] * inv);
        *(GAS v2u*)(op + 8 * g4) = o0; *(GAS v2u*)(op + 32 + 8 * g4) = o1;
    }
}


constexpr int MA_K0 = 0, MA_V0 = 32768;
__device__ __forceinline__ void mem_unit(LAS unsigned char* lds, const bf16* QM, const bf16* KVM, bf16* OM, const float* gq, int tb, int head, float Cl2, int tid) {
    const int lane = tid & 63, w = __builtin_amdgcn_readfirstlane(tid >> 6), hh = lane >> 5, l31 = lane & 31;
    const size_t trow = (size_t)tb * 256 + 32 * w + l31; const int b = tb >> 3;
    bf16x8 qf[8];
    {   const bf16* qp = QM + trow * MEMW + head * 128 + 8 * hh;
#pragma unroll
        for (int s = 0; s < 8; ++s) qf[s] = *(const GAS bf16x8*)(qp + 16 * s);
        float ss = 0.f;
#pragma unroll
        for (int s = 0; s < 8; ++s)
#pragma unroll
            for (int j = 0; j < 8; ++j) { const float f = __builtin_bit_cast(float, (unsigned)(unsigned short)qf[s][j] << 16); ss += f * f; }
        ss += shx(ss, 32, lane);
        const float r = 0.12751743074602468f / sqrtf(ss * (1.f / 128.f) + EPS);
#pragma unroll
        for (int s = 0; s < 8; ++s) { const f32x4 g0 = *(const GAS f32x4*)(gq + 16 * s + 8 * hh), g1 = *(const GAS f32x4*)(gq + 16 * s + 8 * hh + 4);
            v4u o;
#pragma unroll
            for (int j = 0; j < 4; ++j) { const float f0 = __builtin_bit_cast(float, (unsigned)(unsigned short)qf[s][2 * j] << 16), f1 = __builtin_bit_cast(float, (unsigned)(unsigned short)qf[s][2 * j + 1] << 16);
                const float ga = (2 * j < 4) ? g0[2 * j] : g1[2 * j - 4], gb2 = (2 * j + 1 < 4) ? g0[2 * j + 1] : g1[2 * j + 1 - 4];
                o[j] = cvtpk(f0 * r * ga, f1 * r * gb2); }
            qf[s] = __builtin_bit_cast(bf16x8, o); }
    }
    const int srow = tid >> 3, sch = tid & 7;
    const bf16* kg = KVM + ((size_t)b * NMEM + srow) * 1024 + head * 128 + sch * 8;
    const bf16* vg = kg + 512;
    const int kst0 = srow * 256 + ((sch ^ (srow & 15)) * 16), kst1 = srow * 256 + (((sch + 8) ^ (srow & 15)) * 16);
    const int vst0 = srow * 256 + ((((sch) >> 2) ^ (srow & 3)) * 64) + (sch & 3) * 16, vst1 = srow * 256 + ((((sch + 8) >> 2) ^ (srow & 3)) * 64) + (sch & 3) * 16;
    int kread[8], vread[4];
#pragma unroll
    for (int s = 0; s < 8; ++s) kread[s] = l31 * 256 + (((2 * s + hh) ^ (l31 & 15)) * 16);
#pragma unroll
    for (int db = 0; db < 4; ++db) vread[db] = (4 * hh + ((lane >> 2) & 3)) * 256 + ((db ^ ((lane >> 2) & 3)) * 64) + 32 * ((lane >> 4) & 1) + 8 * (lane & 3);
    f32x16 O[4];
#pragma unroll
    for (int db = 0; db < 4; ++db)
#pragma unroll
        for (int r = 0; r < 16; ++r) O[db][r] = 0.f;
    float lsum = 0.f;
    {   const v4u k0 = *(const GAS v4u*)kg, k1 = *(const GAS v4u*)(kg + 64), v0 = *(const GAS v4u*)vg, v1 = *(const GAS v4u*)(vg + 64);
        *(LAS v4u*)(lds + MA_K0 + kst0) = k0; *(LAS v4u*)(lds + MA_K0 + kst1) = k1; *(LAS v4u*)(lds + MA_V0 + vst0) = v0; *(LAS v4u*)(lds + MA_V0 + vst1) = v1; }
    __syncthreads();
#pragma unroll 1
    for (int t = 0; t < 4; ++t) {
        const int cur = t & 1;
        v4u k0, k1, v0, v1;
        if (t + 1 < 4) { const bf16* kn = kg + (size_t)(t + 1) * 64 * 1024; k0 = *(const GAS v4u*)kn; k1 = *(const GAS v4u*)(kn + 64); v0 = *(const GAS v4u*)(kn + 512); v1 = *(const GAS v4u*)(kn + 576); }
        const lds_cptr kb_ = (lds_cptr)(lds + MA_K0 + cur * 16384), vb_ = (lds_cptr)(lds + MA_V0 + cur * 16384);
        f32x16 S0, S1;
#pragma unroll
        for (int r = 0; r < 16; ++r) { S0[r] = -Cl2; S1[r] = -Cl2; }
#pragma unroll
        for (int s = 0; s < 8; ++s) { const bf16x8 a0 = *(const LAS bf16x8*)(kb_ + kread[s]), a1 = *(const LAS bf16x8*)(kb_ + kread[s] + 8192);
            S0 = __builtin_amdgcn_mfma_f32_32x32x16_bf16(a0, qf[s], S0, 0, 0, 0); S1 = __builtin_amdgcn_mfma_f32_32x32x16_bf16(a1, qf[s], S1, 0, 0, 0); }
#pragma unroll
        for (int r = 0; r < 16; ++r) { S0[r] = __builtin_amdgcn_exp2f(S0[r]); S1[r] = __builtin_amdgcn_exp2f(S1[r]); lsum += S0[r] + S1[r]; }
        bf16x8 pb[4];
#pragma unroll
        for (int hf = 0; hf < 2; ++hf) {
            v4u a, c;
#pragma unroll
            for (int j = 0; j < 4; ++j) { a[j] = cvtpk(S0[8 * hf + 2 * j], S0[8 * hf + 2 * j + 1]); c[j] = cvtpk(S1[8 * hf + 2 * j], S1[8 * hf + 2 * j + 1]); }
            pb[hf] = __builtin_bit_cast(bf16x8, a); pb[2 + hf] = __builtin_bit_cast(bf16x8, c);
        }
#pragma unroll
        for (int ks = 0; ks < 4; ++ks)
#pragma unroll
            for (int db = 0; db < 4; ++db) {
                const s16x4 a0 = vtr(vb_ + vread[db] + (16 * ks) * 256), a1 = vtr(vb_ + vread[db] + (16 * ks + 8) * 256);
                const bf16x8 va = __builtin_shufflevector(a0, a1, 0, 1, 2, 3, 4, 5, 6, 7);
                O[db] = __builtin_amdgcn_mfma_f32_32x32x16_bf16(va, pb[ks], O[db], 0, 0, 0);
            }
        if (t + 1 < 4) { LAS unsigned char* kn = lds + MA_K0 + (cur ^ 1) * 16384; LAS unsigned char* vn = lds + MA_V0 + (cur ^ 1) * 16384;
            *(LAS v4u*)(kn + kst0) = k0; *(LAS v4u*)(kn + kst1) = k1; *(LAS v4u*)(vn + vst0) = v0; *(LAS v4u*)(vn + vst1) = v1; }
        __syncthreads();
    }
    lsum += shx(lsum, 32, lane);
    const float inv = 1.f / lsum;
    bf16* op = OM + trow * MEMW + head * 128 + 4 * hh;
#pragma unroll
    for (int db = 0; db < 4; ++db)
#pragma unroll
        for (int g4 = 0; g4 < 4; ++g4) { v2u o; o.x = cvtpk(O[db][4 * g4] * inv, O[db][4 * g4 + 1] * inv); o.y = cvtpk(O[db][4 * g4 + 2] * inv, O[db][4 * g4 + 3] * inv); *(GAS v2u*)(op + 32 * db + 8 * g4) = o; }
}

struct Args { const float* in[23]; float* out; unsigned char* ws; int ph_lo, ph_hi, use_bar, pad; };
#ifndef MK_OFF
#define MK_OFF 0u
#endif
#ifndef REP_ATT
#define REP_ATT 1
#endif
#ifndef REP_P0
#define REP_P0 1
#endif
#ifndef REP_U
#define REP_U 1
#endif
#ifndef REP_GEMM
#define REP_GEMM 1
#endif
#ifndef REP_NORM
#define REP_NORM 1
#endif
#ifndef REP_SEL
#define REP_SEL 1
#endif
#ifndef REP_MEM
#define REP_MEM 1
#endif
#define PHON(k) (!((MK_OFF >> (k)) & 1u))
constexpr int PH_PER_LAYER = 9, PH_BASE = 2, N_PHASES = PH_BASE + DEPTH * PH_PER_LAYER;
constexpr int PTAB_OFF = LDSCTL_OFF + 1024;

__global__ void __launch_bounds__(NTHREADS, 2) mega(Args a) {
    extern __shared__ __attribute__((aligned(16))) unsigned char lds_raw[];
    LAS unsigned char* lds = (LAS unsigned char*)lds_raw;
    {   const int tid0 = threadIdx.x;
        for (int u = tid0; u < (LDS_BYTES - LDSCTL_OFF) / 4; u += NTHREADS) ((LAS unsigned*)(lds + LDSCTL_OFF))[u] = 0u;
        __syncthreads();
        if (tid0 < 23) ((LAS unsigned long long*)(lds + PTAB_OFF))[tid0] = (unsigned long long)a.in[tid0];
        if (tid0 == 23) ((LAS unsigned long long*)(lds + PTAB_OFF))[23] = (unsigned long long)a.out;
        if (tid0 == 24) ((LAS unsigned long long*)(lds + PTAB_OFF))[24] = (unsigned long long)a.ws;
        __syncthreads();
    }
    volatile LAS unsigned* MISC = (volatile LAS unsigned*)(lds + MISC_OFF);
    const int G = gridDim.x, bid = blockIdx.x, NGW = G * NWAVES;
    const int use_bar = a.use_bar;
    XcdBarrier bar; bar.bar = (unsigned*)(a.ws + WS_CTL) + CW_BAR; bar.x = 0; bar.st = MISC + 8;
    if (use_bar) bar = xcd_barrier_post((unsigned*)(a.ws + WS_CTL) + CW_BAR, MISC + 8);
    const int lo = a.ph_lo, hi = a.ph_hi;
#define IN(k) (lo <= (k) && (k) < hi)
#define SEAM(k) do { if (use_bar && IN(k) && IN((k) + 1)) xcd_barrier(bar); } while (0)
#define PHL() int tid_ = threadIdx.x; asm volatile("" : "+v"(tid_)); const int lane_ = tid_ & 63, wave_ = __builtin_amdgcn_readfirstlane(tid_ >> 6), gw_ = bid * NWAVES + wave_; (void)lane_; (void)gw_; \
              int pz_ = 0; asm volatile("" : "+s"(pz_))
#define PTR(i) ((const float*)ldptr(lds, (i) + pz_))
#define WSP() ((unsigned char*)ldptr(lds, 24 + pz_))
#define OUTP() ((float*)ldptr(lds, 23 + pz_))

    if (IN(0) && PHON(0)) {
        PHL(); unsigned char* ws = WSP();
        LAS float* scr = (LAS float*)(lds + RING_OFF + wave_ * 16384);
        constexpr int I_IN = 32 * 128, I_OUT = 32 * 64, I_MQ = 32 * 16, I_MKV = 32 * 32, I_MO = 8 * 64, I_PQ = 32 * 64, I_L = I_IN + I_OUT + I_MQ + I_MKV + I_MO + I_PQ;
        for (int it = gw_; it < DEPTH * I_L; it += NGW) {
            const int l = it / I_L; int r = it % I_L;
            if (r < I_IN) { transpose_item<true>(PTR(4) + (size_t)l * DM * DIN, DM, DIN, (bf16*)(ws + WS_WIN) + (size_t)l * DIN * DM, scr, r, lane_, PTR(3) + (size_t)l * DM); continue; } r -= I_IN;
            if (r < I_OUT) { transpose_item<false>(PTR(11) + (size_t)l * DM * DM, DM, DM, (bf16*)(ws + WS_WOUT) + (size_t)l * DM * DM, scr, r, lane_, PTR(10) + (size_t)l * DM); continue; } r -= I_OUT;
            if (r < I_MQ) { transpose_item<false>(PTR(14) + (size_t)l * DM * MEMW, DM, MEMW, (bf16*)(ws + WS_WMQ) + (size_t)l * MEMW * DM, scr, r, lane_, PTR(12) + (size_t)l * DM); continue; } r -= I_MQ;
            if (r < I_MKV) { transpose_item<false>(PTR(15) + (size_t)l * DM * 1024, DM, 1024, (bf16*)(ws + WS_WMKV) + (size_t)l * 1024 * DM, scr, r, lane_); continue; } r -= I_MKV;
            if (r < I_MO) { transpose_item<false>(PTR(17) + (size_t)l * MEMW * DM, MEMW, DM, (bf16*)(ws + WS_WMO) + (size_t)l * DM * MEMW, scr, r, lane_); continue; } r -= I_MO;
            transpose_item<false>(PTR(19) + (size_t)l * DM * DM, DM, DM, (bf16*)(ws + WS_WPQ) + (size_t)l * DM * DM, scr, r, lane_, PTR(18) + (size_t)l * DM);
        }
        const size_t gtid = (size_t)bid * NTHREADS + tid_, nth = (size_t)G * NTHREADS;
        convert_bf16(PTR(20), (bf16*)(ws + WS_PKEYS), (size_t)DEPTH * 8 * 2 * 128 * 128, gtid, nth);
        convert_int4_plain(PTR(21), ws + WS_PU, DEPTH * PEER_N, PU_SCALEI, PTR(18), gw_, NGW, lane_);
        convert_fp4_rows(PTR(22), ws + WS_PV, PEER_N, PV_SCALE4, nullptr, gw_, NGW, lane_);
        {   const float* x0 = PTR(0); bf16* XN = (bf16*)(ws + WS_XN); u64_t* rsq = (u64_t*)(ws + WS_ROWSQ);
            for (int m = 2 * gw_; m < T; m += 2 * NGW) prep_rows2(x0 + (size_t)m * DM, XN + (size_t)m * DM, rsq + m, ws + WS_XN8 + (size_t)m * DM, (float*)(ws + WS_XSC) + m, lane_); }
        {   const float* mem = PTR(1); const float* gkv = PTR(13); bf16* MEMN = (bf16*)(ws + WS_MEMN);
            for (int m = gw_; m < BATCH * NMEM; m += NGW)
                rms_row_to_bf16(mem + (size_t)m * DM, gkv, MEMN + (size_t)m * DM, gkv + DM, MEMN + (size_t)(BATCH * NMEM + m) * DM, lane_); }
        float* rope = (float*)(ws + WS_ROPE); float* biasA = (float*)(ws + WS_BIASA);
        if (gtid < 64 * 16) { const int pos = (int)gtid >> 4, i = (int)gtid & 15; const float ang = (float)pos * ROPE_INV[i]; rope[gtid * 2] = cosf(ang); rope[gtid * 2 + 1] = sinf(ang); }
        if (gtid < 12 * 257) { const int h = (int)gtid / 257, rel = (int)gtid % 257 - 128; biasA[gtid] = PTR(2)[t5_bucket(rel) * 12 + h]; }
    }
    SEAM(0);
    if (IN(1) && PHON(1)) {
        {   PHL(); unsigned char* ws = WSP();
            for (int r = gw_; r < DEPTH * DIN; r += NGW) { const int rr = r & (DIN - 1), src = (rr & ~255) + 64 * ((rr >> 5) & 3) + 32 * ((rr >> 7) & 1) + (rr & 31);
                quant_wrow((const bf16*)(ws + WS_WIN) + (size_t)r * DM, ws + WS_WIN8 + (size_t)r * DM, (float*)(ws + WS_WSC) + (r & ~(DIN - 1)) + src, lane_); }
            for (int r = gw_; r < DEPTH * DM; r += NGW) quant_wrow((const bf16*)(ws + WS_WOUT) + (size_t)r * DM, ws + WS_WOUT8 + (size_t)r * DM, (float*)(ws + WS_WSCO) + r, lane_);
            for (int r = gw_; r < DEPTH * DM; r += NGW) quant_wrow((const bf16*)(ws + WS_WPQ) + (size_t)r * DM, ws + WS_WPQ8 + (size_t)r * DM, (float*)(ws + WS_WSCP) + r, lane_);
            for (int r = gw_; r < DEPTH * MEMW; r += NGW) quant_wrow((const bf16*)(ws + WS_WMQ) + (size_t)r * DM, ws + WS_WMQ8 + (size_t)r * DM, (float*)(ws + WS_WSCM) + r, lane_); }
#pragma unroll 1
        for (int l = 0; l < DEPTH; ++l) {
            PHL(); unsigned char* ws = WSP();
            pg8::Gemm g{(bf16*)(ws + WS_MEMN) + (size_t)l * BATCH * NMEM * DM, (bf16*)(ws + WS_WMKV) + (size_t)l * 1024 * DM, BATCH * NMEM, 1024, DM};
            OffsetOrder S; S.init(BATCH * NMEM, 1024, G, bid, 64 * l);
            bf16* KVMl = (bf16*)(ws + WS_KVM) + (size_t)l * BATCH * NMEM * 1024;
            pg8::EpiBf16<0> E{KVMl, 1024, nullptr, 0, 0, 1.f};
            pg8::gemm_phase<pg8::EpiBf16<0>, OffsetOrder, true, true>(lds + RING_OFF, g, S, E, tid_);
            VM_WAIT(); __syncthreads();
            const float* gk = PTR(16) + (size_t)l * 256 + 128;
#pragma unroll 1
            for (int i = 0; i < 4; ++i) { pg8::Unit uu; uu.pm = 0; uu.pn = 0; if (!S.next(i, uu)) break;
                if (uu.pn < 2) {
                    for (int r2 = wave_; r2 < 128; r2 += NWAVES) { const int row = uu.pm * 256 + 2 * r2 + (lane_ >> 5), cl = lane_ & 31;
                        GAS v4u* p = (GAS v4u*)(KVMl + (size_t)row * 1024 + 256 * uu.pn + 8 * cl);
                        const v4u w = *p;
                        float f[8] = {bflo(w.x), bfhi(w.x), bflo(w.y), bfhi(w.y), bflo(w.z), bfhi(w.z), bflo(w.w), bfhi(w.w)};
                        float ss = 0.f;
#pragma unroll
                        for (int e = 0; e < 8; ++e) ss += f[e] * f[e];
                        ss += shx(ss, 1, lane_); ss += shx(ss, 2, lane_); ss += shx(ss, 4, lane_); ss += shx(ss, 8, lane_);
                        const float r = 1.f / sqrtf(ss * (1.f / 128.f) + EPS);
                        const float* gg = gk + 8 * (cl & 15);
                        v4u o; o.x = pk2(f[0] * r * gg[0], f[1] * r * gg[1]); o.y = pk2(f[2] * r * gg[2], f[3] * r * gg[3]); o.z = pk2(f[4] * r * gg[4], f[5] * r * gg[5]); o.w = pk2(f[6] * r * gg[6], f[7] * r * gg[7]);
                        *p = o; } } }
            __syncthreads();
        }
        if (G >= 256 && bid >= 128) { PHL(); unsigned char* ws = WSP();
            convert_fp4_rows(PTR(22) + (size_t)PEER_N * DM, ws + WS_PV + (size_t)PEER_N * 1024, PEER_N, PV_SCALE4, nullptr, (bid - 128) * NWAVES + wave_, (G - 128) * NWAVES, lane_); }
        else if (G < 256) { PHL(); unsigned char* ws = WSP(); convert_fp4_rows(PTR(22) + (size_t)PEER_N * DM, ws + WS_PV + (size_t)PEER_N * 1024, PEER_N, PV_SCALE4, nullptr, gw_, NGW, lane_); }
    }
    SEAM(1);

#pragma unroll 1
    for (int l = 0; l < DEPTH; ++l) {
        const int pb = PH_BASE + PH_PER_LAYER * l;
        if (IN(pb + 0) && PHON(3)) { PHL(); unsigned char* ws = WSP();
            pg8::Gemm g{(bf16*)(ws + WS_XN8), (bf16*)(ws + WS_WIN8 + (size_t)l * DIN * DM), T, DIN, DM / 2}; pg8::StaticOrder S; S.init(T, DIN, G, bid);
            LAS float* ropel = (LAS float*)(lds + LDSCTL_OFF + 2048);
            for (int i = tid_; i < 64 * 16 * 2; i += NTHREADS) ropel[i] = ((const float*)(ws + WS_ROPE))[i];
            __syncthreads();
            pg8::EpiQKV E{(bf16*)(ws + WS_QKV), PTR(5) + (size_t)l * 128, PTR(7) + (size_t)l * 128, PTR(9) + (size_t)l * 128, ropel, (const u64_t*)(ws + WS_ROWSQ) + (size_t)(l * 3 + 0) * T, (const float*)(ws + WS_XSC), (const float*)(ws + WS_WSC) + (size_t)l * DIN};
            pg8::gemm_phase<pg8::EpiQKV, pg8::StaticOrder, true, true>(lds + RING_OFF, g, S, E, tid_);
        }
        SEAM(pb + 0);
        if (IN(pb + 1) && PHON(4)) { PHL(); unsigned char* ws = WSP();
            const float* sink = PTR(6) + (size_t)l * 12; const float* rpb = PTR(8) + (size_t)l * 8 * 15 * 31; const float* biasA = (const float*)(ws + WS_BIASA);
            const bf16* QKV = (const bf16*)(ws + WS_QKV); bf16* ATT = (bf16*)(ws + WS_ATT);
            const float* ga = PTR(5) + (size_t)l * 128; const float* gb = PTR(7) + (size_t)l * 128; const float* gc = PTR(9) + (size_t)l * 128;
            const float CaL2 = 8.f * wave_max(fabsf(ga[lane_]), lane_) * wave_max(fabsf(ga[64 + lane_]), lane_) * LOG2E;
            const float CbL2 = 8.f * wave_max(fabsf(gb[lane_]), lane_) * wave_max(fabsf(gb[64 + lane_]), lane_) * LOG2E;
            const float CcL2 = 8.f * wave_max(fabsf(gc[lane_]), lane_) * wave_max(fabsf(gc[64 + lane_]), lane_) * LOG2E;
            const int vc = (G % 8 == 0) ? (bid % 8) * (G / 8) + bid / 8 : bid;
            u64_t* mixsq = (u64_t*)(ws + WS_MIXSQ) + (size_t)l * 3 * T;
            for (int u = vc; u < BATCH * 12 * 8; u += G) attn_unit<2>(lds, QKV, ATT, mixsq + 2 * (size_t)T, u / 96, (u >> 3) % 12, u & 7, nullptr, CcL2, 0.f, tid_);
            for (int u = vc; u < BATCH * 8 * 8; u += G) attn_unit<1>(lds, QKV, ATT, mixsq + (size_t)T, u >> 6, (u >> 3) & 7, u & 7, rpb, CbL2, 0.f, tid_);
            for (int u = vc; u < BATCH * 12 * 8; u += G) { const int head = (u >> 3) % 12; attn_unit<0>(lds, QKV, ATT, mixsq, u / 96, head, u & 7, biasA, CaL2, sink[head] * LOG2E, tid_); }
        }
        SEAM(pb + 1);
        if (IN(pb + 2) && PHON(5)) { PHL(); unsigned char* ws = WSP();
            const u64_t* mixsq = (const u64_t*)(ws + WS_MIXSQ) + (size_t)l * 3 * T;
            for (int r = 4 * gw_; r < T; r += 4 * NGW) att_quant_rows<4>((const bf16*)(ws + WS_ATT), mixsq, ws + WS_ATT8, (float*)(ws + WS_XSC2), r, lane_);
        }
        SEAM(pb + 2);
        if (IN(pb + 3) && PHON(5)) { PHL(); unsigned char* ws = WSP();
            pg8::Gemm g{(bf16*)(ws + WS_ATT8), (bf16*)(ws + WS_WOUT8 + (size_t)l * DM * DM), T, DM, DM / 2}; pg8::StaticOrder S; S.init(T, DM, G, bid);
            typedef pg8::EpiResidT<true, 10> EpiX1;
            EpiX1 E{(bf16*)(ws + WS_XN), DM, (u64_t*)(ws + WS_ROWSQ) + (size_t)(l * 3 + 1) * T, (const float*)(ws + WS_XSC2), (const float*)(ws + WS_WSCO) + (size_t)l * DM, ws + WS_X8, (const u64_t*)(ws + WS_ROWSQ) + (size_t)(l * 3 + 0) * T};
            pg8::gemm_phase<EpiX1, pg8::StaticOrder, true, true>(lds + RING_OFF, g, S, E, tid_);
        }
        SEAM(pb + 3);
        if (IN(pb + 4) && PHON(6)) { PHL(); unsigned char* ws = WSP();
            pg8::Gemm g{(bf16*)(ws + WS_X8), (bf16*)(ws + WS_WMQ8 + (size_t)l * MEMW * DM), T, MEMW, DM / 2}; pg8::StaticOrder S; S.init(T, MEMW, G, bid);
            pg8::EpiBf16Row8<10> E{(bf16*)(ws + WS_QM), MEMW, (const u64_t*)(ws + WS_ROWSQ) + (size_t)(l * 3 + 1) * T, (const u64_t*)(ws + WS_ROWSQ) + (size_t)(l * 3 + 0) * T, (const float*)(ws + WS_WSCM) + (size_t)l * MEMW};
            pg8::gemm_phase<pg8::EpiBf16Row8<10>, pg8::StaticOrder, true, true>(lds + RING_OFF, g, S, E, tid_);
            VM_WAIT(); __syncthreads();
            const bf16* kvm = (const bf16*)(ws + WS_KVM) + (size_t)l * BATCH * NMEM * 1024; const float* gq = PTR(16) + (size_t)l * 256;
            const float CmL2 = 11.313708498984761f * wave_max(fmaxf(fabsf(gq[lane_]), fabsf(gq[64 + lane_])), lane_) * wave_max(fmaxf(fabsf(gq[128 + lane_]), fabsf(gq[192 + lane_])), lane_) * LOG2E;
#pragma unroll 1
            for (int i = 0; i < 4; ++i) { pg8::Unit uu; uu.pm = 0; uu.pn = 0; if (!S.next(i, uu)) break;
                mem_unit(lds, (const bf16*)(ws + WS_QM), kvm, (bf16*)(ws + WS_OM), gq, uu.pm, 2 * uu.pn, CmL2, tid_);
                mem_unit(lds, (const bf16*)(ws + WS_QM), kvm, (bf16*)(ws + WS_OM), gq, uu.pm, 2 * uu.pn + 1, CmL2, tid_); }
        }
        SEAM(pb + 4);
        if (IN(pb + 5) && PHON(7)) { PHL(); unsigned char* ws = WSP();
            pg8::Gemm g{(bf16*)(ws + WS_OM), (bf16*)(ws + WS_WMO) + (size_t)l * DM * MEMW, T, DM, MEMW}; pg8::StaticOrder S; S.init(T, DM, G, bid);
            typedef pg8::EpiResidT<false, 8> EpiX2;
            EpiX2 E{(bf16*)(ws + WS_XN), DM, (u64_t*)(ws + WS_ROWSQ) + (size_t)(l * 3 + 2) * T, nullptr, nullptr, ws + WS_X8, (const u64_t*)(ws + WS_ROWSQ) + (size_t)(l * 3 + 1) * T};
            pg8::gemm_phase<EpiX2, pg8::StaticOrder, true, true>(lds + RING_OFF, g, S, E, tid_);
        }
        SEAM(pb + 5);
        if (IN(pb + 6) && PHON(8)) { PHL(); unsigned char* ws = WSP();
            pg8::Gemm g{(bf16*)(ws + WS_X8), (bf16*)(ws + WS_WPQ8 + (size_t)l * DM * DM), T, DM, DM / 2}; pg8::StaticOrder S; S.init(T, DM, G, bid);
            pg8::EpiBf16Row8<8> E{(bf16*)(ws + WS_QP), DM, (const u64_t*)(ws + WS_ROWSQ) + (size_t)(l * 3 + 2) * T, (const u64_t*)(ws + WS_ROWSQ) + (size_t)(l * 3 + 1) * T, (const float*)(ws + WS_WSCP) + (size_t)l * DM};
            pg8::gemm_phase<pg8::EpiBf16Row8<8>, pg8::StaticOrder, true, true>(lds + RING_OFF, g, S, E, tid_);
            VM_WAIT(); __syncthreads();
            const bf16* pk = (const bf16*)(ws + WS_PKEYS) + (size_t)l * 8 * 2 * 128 * 128;
#pragma unroll 1
            for (int i = 0; i < 8; ++i) { pg8::Unit uu; uu.pm = 0; uu.pn = 0; if (!S.next(i, uu)) break;
                peer_select_unit((const bf16*)(ws + WS_QP), pk, (int*)(ws + WS_PIDX), (float*)(ws + WS_PGATE), uu.pm, uu.pn, wave_, lane_);
                peer_xquant_unit((const bf16*)(ws + WS_XN), (const u64_t*)(ws + WS_ROWSQ) + (size_t)(l * 3 + 2) * T, (unsigned*)(ws + WS_XQH), (unsigned*)(ws + WS_XQL), uu.pm, uu.pn, tid_); }
        }
        SEAM(pb + 6);
        if (IN(pb + 7) && PHON(9)) { PHL(); unsigned char* ws = WSP();
            peer_u_phase_i4((const unsigned*)(ws + WS_XQH), (const unsigned*)(ws + WS_XQL), ws + WS_PU + (size_t)l * PEER_N * 1024, (const int*)(ws + WS_PIDX), (int*)(ws + WS_PARTI), bid, G, wave_, lane_); }
        SEAM(pb + 7);
        if (IN(pb + 8) && PHON(10)) { PHL(); unsigned char* ws = WSP();
            peer_v_pass((bf16*)(ws + WS_XN), ws + WS_PV + (size_t)l * PEER_N * 1024, (const int*)(ws + WS_PIDX), (const float*)(ws + WS_PGATE), (const int*)(ws + WS_PARTI), (l + 1 == DEPTH) ? OUTP() : (float*)nullptr,
                        (l + 1 < DEPTH) ? (u64_t*)(ws + WS_ROWSQ) + (size_t)((l + 1) * 3 + 0) * T : (u64_t*)nullptr, (l + 1 < DEPTH) ? ws + WS_XN8 : (unsigned char*)nullptr, (float*)(ws + WS_XSC), (LAS float*)(lds + RING_OFF + wave_ * 1024), gw_, NGW, lane_); }
        SEAM(pb + 8);
    }
#undef IN
#undef SEAM
}

#ifndef MK_MULTI_LAUNCH
#define MK_MULTI_LAUNCH 0
#endif
extern "C" void kernel_launch(void* const* d_in, const int* in_sizes, int n_in, void* d_out, int out_size, void* d_ws, size_t ws_size, hipStream_t stream) {
    static int grid = 0;
    if (grid == 0) {
        if (n_in != 23 || out_size != T * DM || ws_size < WS_END) { fprintf(stderr, "kernel_launch: unexpected shapes (n_in %d, out %d, ws %zu)\n", n_in, out_size, ws_size); grid = -1; return; }
        int dev = 0, cus = 0, per_cu = 0;
        if (hipGetDevice(&dev) != hipSuccess || hipDeviceGetAttribute(&cus, hipDeviceAttributeMultiprocessorCount, dev) != hipSuccess) { grid = -1; return; }
        if (hipFuncSetAttribute((const void*)mega, hipFuncAttributeMaxDynamicSharedMemorySize, LDS_BYTES) != hipSuccess) { fprintf(stderr, "kernel_launch: hipFuncSetAttribute failed\n"); grid = -1; return; }
        if (hipOccupancyMaxActiveBlocksPerMultiprocessor(&per_cu, (const void*)mega, NTHREADS, LDS_BYTES) != hipSuccess || per_cu < 1) { fprintf(stderr, "kernel_launch: occupancy query says %d\n", per_cu); }
        (void)hipGetLastError();
        grid = cus;
    }
    if (grid < 0) return;
    (void)hipMemsetAsync((char*)d_ws + WS_CTL, 0, CTL_ZERO_BYTES, stream);
    (void)hipMemsetAsync((char*)d_ws + WS_MIXSQ, 0, MIXSQ_BYTES, stream);
    Args a{};
    for (int i = 0; i < 23; ++i) a.in[i] = (const float*)d_in[i];
    a.out = (float*)d_out; a.ws = (unsigned char*)d_ws;
#if MK_MULTI_LAUNCH
    for (int p = 0; p < N_PHASES; ++p) { a.ph_lo = p; a.ph_hi = p + 1; a.use_bar = 0; a.pad = 0; hipLaunchKernelGGL(mega, dim3(grid), dim3(NTHREADS), LDS_BYTES, stream, a); }
#else
    a.ph_lo = 0; a.ph_hi = N_PHASES; a.use_bar = 1; a.pad = 0;
    hipLaunchKernelGGL(mega, dim3(grid), dim3(NTHREADS), LDS_BYTES, stream, a);
#endif
    const hipError_t le = hipPeekAtLastError();
    if (le != hipSuccess) fprintf(stderr, "kernel_launch: launch failed: %s\n", hipGetErrorName(le));
}
```

```cpp
#include <hip/hip_runtime.h>
#include <cstdio>
#include <cstdint>
#include <cmath>
__device__ __forceinline__ float shx(float v, int k, int lane);
typedef unsigned long long u64_t;
__device__ __forceinline__ float rowsq_rs(const u64_t* rowsq, int row) { return 1.0f / sqrtf((float)*(const __attribute__((address_space(1))) u64_t*)(rowsq + row) * (5.9604644775390625e-08f / 2048.0f) + 1e-6f); }
__device__ __forceinline__ u64_t rowsq_fx(float ss) { return (u64_t)(ss * 16777216.0f + 0.5f); }
__device__ __forceinline__ unsigned q8x4c(float a, float b, float c, float d, float inv) {
    unsigned w = 0;
    w = __builtin_amdgcn_cvt_pk_u8_f32(__builtin_rintf(__builtin_amdgcn_fmed3f(__builtin_fmaf(a, inv, 128.f), 1.f, 255.f)), 0, w); w = __builtin_amdgcn_cvt_pk_u8_f32(__builtin_rintf(__builtin_amdgcn_fmed3f(__builtin_fmaf(b, inv, 128.f), 1.f, 255.f)), 1, w);
    w = __builtin_amdgcn_cvt_pk_u8_f32(__builtin_rintf(__builtin_amdgcn_fmed3f(__builtin_fmaf(c, inv, 128.f), 1.f, 255.f)), 2, w); w = __builtin_amdgcn_cvt_pk_u8_f32(__builtin_rintf(__builtin_amdgcn_fmed3f(__builtin_fmaf(d, inv, 128.f), 1.f, 255.f)), 3, w);
    return w ^ 0x80808080u;
}
namespace pg8 {
#define PG8_LAS __attribute__((address_space(3)))
#define PG8_GAS __attribute__((address_space(1)))
typedef unsigned short bf16_t;
typedef short bf16x8 __attribute__((ext_vector_type(8)));
typedef float f32x4 __attribute__((ext_vector_type(4)));
typedef unsigned u32x4 __attribute__((ext_vector_type(4)));
constexpr int BM = 256, BK = 64, HALF = 128, HTB = HALF * BK * 2  , STAGE_BYTES = 8 * HTB, NXCD = 8, WGM = 8;

__host__ __device__ __forceinline__ int lds_byte(int r, int c) { const int st = (r >> 4) * 2 + (c >> 5), rr = r & 15, cc = c & 31, ob = rr * 64 + cc * 2; return st * 1024 + (ob ^ (((ob >> 9) & 1) << 5)); }
__host__ __device__ __forceinline__ void stage_rc(int b, int& R, int& C) { const int st = b / 1024, sb = b % 1024, swz = sb ^ (((sb >> 9) & 1) << 5); R = (st >> 1) * 16 + swz / 64; C = (st & 1) * 32 + (swz % 64) / 2; }
__host__ __device__ __forceinline__ int perm32(int rho) { const int n = rho >> 4, i = rho & 15; return 8 * (i >> 2) + 4 * n + (i & 3); }

struct Unit { int pm, pn; };
struct Gemm { const bf16_t* A; const bf16_t* Bt; int M, N, K; };

struct StaticOrder {
    int nM, nN, nwg, G, c;
    __host__ __device__ __forceinline__ void init(int M, int N, int G_, int c_) { nM = M / BM; nN = N / BM; nwg = nM * nN; G = G_; c = c_; }
    __host__ __device__ __forceinline__ bool next(int i, Unit& u) const {
        const long L = (long)i * G + c; if (L >= nwg) return false;
        int wgid = (int)L; { const int q = nwg / NXCD, r = nwg % NXCD, xcd = wgid % NXCD, off = wgid / NXCD; wgid = (xcd < r ? xcd * (q + 1) : r * (q + 1) + (xcd - r) * q) + off; }
        const int nig = WGM * nN, gid = wgid / nig, fm = gid * WGM, gsz = (nM - fm) < WGM ? (nM - fm) : WGM;
        u.pm = fm + ((wgid % nig) % gsz); u.pn = (wgid % nig) / gsz; return true;
    }
    __device__ __forceinline__ void a_ready(const Unit&) const {}
    __device__ __forceinline__ void done(const Unit&) const {}
};

__device__ __forceinline__ unsigned cvt_pk_bf16(float lo, float hi) { unsigned r; asm volatile("v_cvt_pk_bf16_f32 %0, %1, %2" : "=v"(r) : "v"(lo), "v"(hi)); return r; }
typedef float f32x2 __attribute__((ext_vector_type(2)));
__device__ __forceinline__ f32x2 gelu_pk(f32x2 v) {
    const f32x2 av = __builtin_elementwise_abs(v), d = av * 0.2316418882f + 1.0f;
    f32x2 t; t.x = __builtin_amdgcn_rcpf(d.x); t.y = __builtin_amdgcn_rcpf(d.y);
    f32x2 q = t * 0.5307027145f + (-0.7265760135f); q = q * t + 0.7107068705f; q = q * t + (-0.142248368f); q = q * t + 0.127414796f; q = q * t;
    const f32x2 s = (v * v) * (-0.72134752044f);
    f32x2 e; e.x = __builtin_amdgcn_exp2f(s.x); e.y = __builtin_amdgcn_exp2f(s.y);
    const f32x2 m = v * (q * e), r = v - m;
    f32x2 o; o.x = v.x < 0.f ? m.x : r.x; o.y = v.y < 0.f ? m.y : r.y; return o;
}

template <int ACT  > struct EpiBf16 {
    static constexpr bool PERM = true, AFTER_DRAIN = false, KSCALE = false, I8 = false; static_assert(ACT == 0 || ACT == 1, "EpiBf16: ACT is 0 (none) or 1 (gelu_pk)");
    bf16_t* O; int ldc; const float* bias; int split_cols; size_t split_stride; float scale0;
    __device__ __forceinline__ void operator()(const f32x4 (&acc)[2][2][4][2], const Unit& u, int wr, int wc, int fr, int fq) const {
        const int row0 = u.pm * BM + wr * 64 + fr; int colt = u.pn * BM; bf16_t* base = O;
        float sc = 1.f; if (split_cols) { const int t = colt / split_cols; base += (size_t)t * split_stride; colt -= t * split_cols; if (t == 0) sc = scale0; }
        const int col0 = colt + wc * 32 + 8 * fq, bcol0 = u.pn * BM + wc * 32 + 8 * fq;
        f32x4 bv[2][2];
#pragma unroll
        for (int bj = 0; bj < 2; ++bj)
#pragma unroll
            for (int n = 0; n < 2; ++n) bv[bj][n] = bias ? *(const PG8_GAS f32x4*)(bias + bcol0 + bj * HALF + 4 * n) : (f32x4){0.f, 0.f, 0.f, 0.f};
#pragma unroll
        for (int ai = 0; ai < 2; ++ai)
#pragma unroll
            for (int m = 0; m < 4; ++m) { bf16_t* rowp = base + (size_t)(row0 + ai * HALF + m * 16) * ldc + col0;
#pragma unroll
                for (int bj = 0; bj < 2; ++bj) { f32x4 v0 = acc[ai][bj][m][0] + bv[bj][0], v1 = acc[ai][bj][m][1] + bv[bj][1];
                    if (ACT == 1) { f32x2 a = gelu_pk((f32x2){v0[0], v0[1]}), b = gelu_pk((f32x2){v0[2], v0[3]}), c = gelu_pk((f32x2){v1[0], v1[1]}), d = gelu_pk((f32x2){v1[2], v1[3]});
                        v0 = (f32x4){a.x, a.y, b.x, b.y}; v1 = (f32x4){c.x, c.y, d.x, d.y}; }
                    v0 = v0 * sc; v1 = v1 * sc; u32x4 w; w.x = cvt_pk_bf16(v0[0], v0[1]); w.y = cvt_pk_bf16(v0[2], v0[3]); w.z = cvt_pk_bf16(v1[0], v1[1]); w.w = cvt_pk_bf16(v1[2], v1[3]);
                    *(PG8_GAS u32x4*)(rowp + bj * HALF) = w; } }
    }
};

typedef unsigned u32x2 __attribute__((ext_vector_type(2)));
typedef int i32x4 __attribute__((ext_vector_type(4)));
struct EpiResid {
    static constexpr bool PERM = false, AFTER_DRAIN = false, KSCALE = false, I8 = false;
    bf16_t* s; int ldc; u64_t* rowsq;
    __device__ __forceinline__ void operator()(const f32x4 (&acc)[2][2][4][2], const Unit& u, int wr, int wc, int fr, int fq) const {
        const int col0 = u.pn * BM + wc * 32 + 4 * fq;
#pragma unroll
        for (int ai = 0; ai < 2; ++ai)
#pragma unroll
            for (int m = 0; m < 4; ++m) { const int row = u.pm * BM + ai * HALF + wr * 64 + m * 16 + fr; bf16_t* sp = s + (size_t)row * ldc + col0; float ss = 0.f;
                u32x2 in[2][2];
#pragma unroll
                for (int bj = 0; bj < 2; ++bj)
#pragma unroll
                    for (int n = 0; n < 2; ++n) in[bj][n] = *(const PG8_GAS u32x2*)(sp + bj * HALF + n * 16);
#pragma unroll
                for (int bj = 0; bj < 2; ++bj)
#pragma unroll
                    for (int n = 0; n < 2; ++n) { const u32x2 w0 = in[bj][n];
                        const f32x4 bs = (f32x4){__builtin_bit_cast(float, w0.x << 16), __builtin_bit_cast(float, w0.x & 0xffff0000u), __builtin_bit_cast(float, w0.y << 16), __builtin_bit_cast(float, w0.y & 0xffff0000u)};
                        const f32x4 o = bs + acc[ai][bj][m][n]; ss += (o[0] * o[0] + o[1] * o[1]) + (o[2] * o[2] + o[3] * o[3]);
                        u32x2 w; w.x = cvt_pk_bf16(o[0], o[1]); w.y = cvt_pk_bf16(o[2], o[3]); *(PG8_GAS u32x2*)(sp + bj * HALF + n * 16) = w; }
                ss += shx(ss, 16, fr + 16 * fq); ss += shx(ss, 32, fr + 16 * fq);
                if (fq == 0) (void)__hip_atomic_fetch_add((PG8_GAS u64_t*)(rowsq + row), rowsq_fx(ss), __ATOMIC_RELAXED, __HIP_MEMORY_SCOPE_AGENT); }
    }
};
struct EpiResid8 {
    static constexpr bool PERM = false, AFTER_DRAIN = false, KSCALE = false, I8 = true;
    bf16_t* s; int ldc; u64_t* rowsq; const float* xsc; const float* wsc;
    __device__ __forceinline__ void operator()(const f32x4 (&acc)[2][2][4][2], const Unit& u, int wr, int wc, int fr, int fq) const {
        const int col0 = u.pn * BM + wc * 32 + 4 * fq;
#pragma unroll
        for (int ai = 0; ai < 2; ++ai)
#pragma unroll
            for (int m = 0; m < 4; ++m) { const int row = u.pm * BM + ai * HALF + wr * 64 + m * 16 + fr; bf16_t* sp = s + (size_t)row * ldc + col0; float ss = 0.f; const float xs = *(const PG8_GAS float*)(xsc + row);
                u32x2 in[2][2];
#pragma unroll
                for (int bj = 0; bj < 2; ++bj)
#pragma unroll
                    for (int n = 0; n < 2; ++n) in[bj][n] = *(const PG8_GAS u32x2*)(sp + bj * HALF + n * 16);
#pragma unroll
                for (int bj = 0; bj < 2; ++bj)
#pragma unroll
                    for (int n = 0; n < 2; ++n) { const u32x2 w0 = in[bj][n]; const i32x4 ia = __builtin_bit_cast(i32x4, acc[ai][bj][m][n]);
                        const f32x4 bs = (f32x4){__builtin_bit_cast(float, w0.x << 16), __builtin_bit_cast(float, w0.x & 0xffff0000u), __builtin_bit_cast(float, w0.y << 16), __builtin_bit_cast(float, w0.y & 0xffff0000u)};
                        const f32x4 o = bs + (f32x4){(float)ia[0], (float)ia[1], (float)ia[2], (float)ia[3]} * *(const PG8_GAS f32x4*)(wsc + col0 + bj * HALF + n * 16) * xs; ss += (o[0] * o[0] + o[1] * o[1]) + (o[2] * o[2] + o[3] * o[3]);
                        u32x2 w; w.x = cvt_pk_bf16(o[0], o[1]); w.y = cvt_pk_bf16(o[2], o[3]); *(PG8_GAS u32x2*)(sp + bj * HALF + n * 16) = w; }
                ss += shx(ss, 16, fr + 16 * fq); ss += shx(ss, 32, fr + 16 * fq);
                if (fq == 0) (void)__hip_atomic_fetch_add((PG8_GAS u64_t*)(rowsq + row), rowsq_fx(ss), __ATOMIC_RELAXED, __HIP_MEMORY_SCOPE_AGENT); }
    }
};
template <bool I8IN, int QOUT>
struct EpiResidT {
    static constexpr bool PERM = true, AFTER_DRAIN = false, KSCALE = false, I8 = I8IN;
    bf16_t* s; int ldc; u64_t* rowsq; const float* xsc; const float* wsc; unsigned char* q8; const u64_t* rowsq_prev;
    __device__ __forceinline__ void operator()(const f32x4 (&acc)[2][2][4][2], const Unit& u, int wr, int wc, int fr, int fq) const {
        const int col0 = u.pn * BM + wc * 32 + 8 * fq, rowb = u.pm * BM + wr * 64 + fr;
        f32x4 wv[2][2];
        if constexpr (I8IN) {
#pragma unroll
            for (int bj = 0; bj < 2; ++bj) { wv[bj][0] = *(const PG8_GAS f32x4*)(wsc + col0 + bj * HALF); wv[bj][1] = *(const PG8_GAS f32x4*)(wsc + col0 + bj * HALF + 4); } }
#pragma unroll
        for (int ai = 0; ai < 2; ++ai) {
            u32x4 in[4][2]; float xs[4], qv[4];
#pragma unroll
            for (int m = 0; m < 4; ++m) { const int row = rowb + ai * HALF + m * 16; const bf16_t* sp = s + (size_t)row * ldc + col0;
#pragma unroll
                for (int bj = 0; bj < 2; ++bj) in[m][bj] = *(const PG8_GAS u32x4*)(sp + bj * HALF);
                if constexpr (I8IN) xs[m] = *(const PG8_GAS float*)(xsc + row); else xs[m] = 1.f;
                if constexpr (QOUT > 0) qv[m] = (127.0f / QOUT) * rowsq_rs(rowsq_prev, row); else qv[m] = 0.f; }
            __builtin_amdgcn_sched_barrier(0);
#pragma unroll
            for (int m = 0; m < 4; ++m) { const int row = rowb + ai * HALF + m * 16; bf16_t* sp = s + (size_t)row * ldc + col0; float ss = 0.f;
#pragma unroll
                for (int bj = 0; bj < 2; ++bj) { const u32x4 w0 = in[m][bj]; f32x4 a0 = acc[ai][bj][m][0], a1 = acc[ai][bj][m][1];
                    if constexpr (I8IN) { const i32x4 i0 = __builtin_bit_cast(i32x4, a0), i1 = __builtin_bit_cast(i32x4, a1);
                        a0 = (f32x4){(float)i0[0], (float)i0[1], (float)i0[2], (float)i0[3]} * wv[bj][0] * xs[m];
                        a1 = (f32x4){(float)i1[0], (float)i1[1], (float)i1[2], (float)i1[3]} * wv[bj][1] * xs[m]; }
                    const f32x4 o0 = (f32x4){__builtin_bit_cast(float, w0.x << 16), __builtin_bit_cast(float, w0.x & 0xffff0000u), __builtin_bit_cast(float, w0.y << 16), __builtin_bit_cast(float, w0.y & 0xffff0000u)} + a0;
                    const f32x4 o1 = (f32x4){__builtin_bit_cast(float, w0.z << 16), __builtin_bit_cast(float, w0.z & 0xffff0000u), __builtin_bit_cast(float, w0.w << 16), __builtin_bit_cast(float, w0.w & 0xffff0000u)} + a1;
                    ss += ((o0[0] * o0[0] + o0[1] * o0[1]) + (o0[2] * o0[2] + o0[3] * o0[3])) + ((o1[0] * o1[0] + o1[1] * o1[1]) + (o1[2] * o1[2] + o1[3] * o1[3]));
                    u32x4 w; w.x = cvt_pk_bf16(o0[0], o0[1]); w.y = cvt_pk_bf16(o0[2], o0[3]); w.z = cvt_pk_bf16(o1[0], o1[1]); w.w = cvt_pk_bf16(o1[2], o1[3]); *(PG8_GAS u32x4*)(sp + bj * HALF) = w;
                    if constexpr (QOUT > 0) { u32x2 q; q.x = q8x4c(o0[0], o0[1], o0[2], o0[3], qv[m]); q.y = q8x4c(o1[0], o1[1], o1[2], o1[3], qv[m]); *(PG8_GAS u32x2*)(q8 + (size_t)row * ldc + col0 + bj * HALF) = q; } }
                ss += shx(ss, 16, fr + 16 * fq); ss += shx(ss, 32, fr + 16 * fq);
                if (fq == 0) (void)__hip_atomic_fetch_add((PG8_GAS u64_t*)(rowsq + row), rowsq_fx(ss), __ATOMIC_RELAXED, __HIP_MEMORY_SCOPE_AGENT); }
            __builtin_amdgcn_sched_barrier(0);
        }
    }
};
template <int QIN>
struct EpiBf16Row8 {
    static constexpr bool PERM = true, AFTER_DRAIN = false, KSCALE = false, I8 = true;
    bf16_t* O; int ldc; const u64_t* rowsq; const u64_t* rowsq_prev; const float* wsc;
    __device__ __forceinline__ void operator()(const f32x4 (&acc)[2][2][4][2], const Unit& u, int wr, int wc, int fr, int fq) const {
        const int row0 = u.pm * BM + wr * 64 + fr, col0 = u.pn * BM + wc * 32 + 8 * fq;
        float rs[2][4]; f32x4 wv[2][2];
#pragma unroll
        for (int ai = 0; ai < 2; ++ai)
#pragma unroll
            for (int m = 0; m < 4; ++m) { const int row = row0 + ai * HALF + m * 16; rs[ai][m] = rowsq_rs(rowsq, row) * (QIN / 127.0f) / rowsq_rs(rowsq_prev, row); }
#pragma unroll
        for (int bj = 0; bj < 2; ++bj) { wv[bj][0] = *(const PG8_GAS f32x4*)(wsc + col0 + bj * HALF); wv[bj][1] = *(const PG8_GAS f32x4*)(wsc + col0 + bj * HALF + 4); }
        __builtin_amdgcn_sched_barrier(0);
#pragma unroll
        for (int ai = 0; ai < 2; ++ai)
#pragma unroll
            for (int m = 0; m < 4; ++m) { const int row = row0 + ai * HALF + m * 16; bf16_t* rowp = O + (size_t)row * ldc + col0;
#pragma unroll
                for (int bj = 0; bj < 2; ++bj) { const i32x4 i0 = __builtin_bit_cast(i32x4, acc[ai][bj][m][0]), i1 = __builtin_bit_cast(i32x4, acc[ai][bj][m][1]);
                    const f32x4 v0 = (f32x4){(float)i0[0], (float)i0[1], (float)i0[2], (float)i0[3]} * wv[bj][0] * rs[ai][m], v1 = (f32x4){(float)i1[0], (float)i1[1], (float)i1[2], (float)i1[3]} * wv[bj][1] * rs[ai][m];
                    u32x4 w; w.x = cvt_pk_bf16(v0[0], v0[1]); w.y = cvt_pk_bf16(v0[2], v0[3]); w.z = cvt_pk_bf16(v1[0], v1[1]); w.w = cvt_pk_bf16(v1[2], v1[3]);
                    *(PG8_GAS u32x4*)(rowp + bj * HALF) = w; } }
    }
};
struct EpiResidMix {
    static constexpr bool PERM = false, AFTER_DRAIN = false, KSCALE = true, I8 = false; static constexpr int KS0 = 12, KS1 = 20;
    bf16_t* s; int ldc; u64_t* rowsq; const PG8_LAS float* ftab; const PG8_LAS int* pmtab;
    __device__ __forceinline__ int slot(int pm) const { return pmtab[0] == pm ? 0 : (pmtab[1] == pm ? 1 : (pmtab[2] == pm ? 2 : 3)); }
    __device__ __forceinline__ void kscale(f32x4 (&acc)[2][2][4][2], const Unit& u, int which, int wr, int fr) const {
        const PG8_LAS float* ft = ftab + which * 1024 + slot(u.pm) * 256;
#pragma unroll
        for (int ai = 0; ai < 2; ++ai)
#pragma unroll
            for (int m = 0; m < 4; ++m) { const float f = ft[ai * HALF + wr * 64 + m * 16 + fr];
#pragma unroll
                for (int bj = 0; bj < 2; ++bj)
#pragma unroll
                    for (int n = 0; n < 2; ++n) acc[ai][bj][m][n] = acc[ai][bj][m][n] * f; }
    }
    __device__ __forceinline__ void operator()(const f32x4 (&acc)[2][2][4][2], const Unit& u, int wr, int wc, int fr, int fq) const {
        const int col0 = u.pn * BM + wc * 32 + 4 * fq;
#pragma unroll
        for (int ai = 0; ai < 2; ++ai)
#pragma unroll
            for (int m = 0; m < 4; ++m) { const int row = u.pm * BM + ai * HALF + wr * 64 + m * 16 + fr; bf16_t* sp = s + (size_t)row * ldc + col0; float ss = 0.f; const float rc = ftab[2048 + slot(u.pm) * 256 + ai * HALF + wr * 64 + m * 16 + fr];
                u32x2 in[2][2];
#pragma unroll
                for (int bj = 0; bj < 2; ++bj)
#pragma unroll
                    for (int n = 0; n < 2; ++n) in[bj][n] = *(const PG8_GAS u32x2*)(sp + bj * HALF + n * 16);
#pragma unroll
                for (int bj = 0; bj < 2; ++bj)
#pragma unroll
                    for (int n = 0; n < 2; ++n) { const u32x2 w0 = in[bj][n];
                        const f32x4 bs = (f32x4){__builtin_bit_cast(float, w0.x << 16), __builtin_bit_cast(float, w0.x & 0xffff0000u), __builtin_bit_cast(float, w0.y << 16), __builtin_bit_cast(float, w0.y & 0xffff0000u)};
                        const f32x4 o = bs + acc[ai][bj][m][n] * rc; ss += (o[0] * o[0] + o[1] * o[1]) + (o[2] * o[2] + o[3] * o[3]);
                        u32x2 w; w.x = cvt_pk_bf16(o[0], o[1]); w.y = cvt_pk_bf16(o[2], o[3]); *(PG8_GAS u32x2*)(sp + bj * HALF + n * 16) = w; }
                ss += shx(ss, 16, fr + 16 * fq); ss += shx(ss, 32, fr + 16 * fq);
                if (fq == 0) (void)__hip_atomic_fetch_add((PG8_GAS u64_t*)(rowsq + row), rowsq_fx(ss), __ATOMIC_RELAXED, __HIP_MEMORY_SCOPE_AGENT); }
    }
};
struct EpiBf16Row {
    static constexpr bool PERM = true, AFTER_DRAIN = false, KSCALE = false, I8 = false;
    bf16_t* O; int ldc; const u64_t* rowsq;
    __device__ __forceinline__ void operator()(const f32x4 (&acc)[2][2][4][2], const Unit& u, int wr, int wc, int fr, int fq) const {
        const int row0 = u.pm * BM + wr * 64 + fr, col0 = u.pn * BM + wc * 32 + 8 * fq;
#pragma unroll
        for (int ai = 0; ai < 2; ++ai)
#pragma unroll
            for (int m = 0; m < 4; ++m) { const int row = row0 + ai * HALF + m * 16; const float rs = rowsq_rs(rowsq, row); bf16_t* rowp = O + (size_t)row * ldc + col0;
#pragma unroll
                for (int bj = 0; bj < 2; ++bj) { const f32x4 v0 = acc[ai][bj][m][0] * rs, v1 = acc[ai][bj][m][1] * rs; u32x4 w; w.x = cvt_pk_bf16(v0[0], v0[1]); w.y = cvt_pk_bf16(v0[2], v0[3]); w.z = cvt_pk_bf16(v1[0], v1[1]); w.w = cvt_pk_bf16(v1[2], v1[3]);
                    *(PG8_GAS u32x4*)(rowp + bj * HALF) = w; } }
    }
};
struct EpiQKV {
    static constexpr bool PERM = false, AFTER_DRAIN = false, KSCALE = false, I8 = true;
    bf16_t* O; const float* ga; const float* gb; const float* gc; const PG8_LAS float* rope; const u64_t* rowsq; const float* xsc; const float* wsc;
    __device__ __forceinline__ void operator()(const f32x4 (&acc)[2][2][4][2], const Unit& u, int wr, int wc, int fr, int fq) const {
        const int hg = u.pn * 4 + wc;
        const float* g = nullptr; bool isq = false, dorope = false;
        if (hg < 12) { g = ga; isq = true; } else if (hg < 16) { g = ga + 64; } else if (hg < 20) { }
        else if (hg < 28) { g = gb; isq = true; } else if (hg < 36) { g = gb + 64; } else if (hg < 44) { }
        else if (hg < 56) { g = gc; isq = true; dorope = true; } else if (hg < 60) { g = gc + 64; dorope = true; }
        const float qs = isq ? 0.18033688011112042f : 1.0f;
        float rsxa[2][4]; f32x4 wv[2][2], gv[2][2];
#pragma unroll
        for (int ai = 0; ai < 2; ++ai)
#pragma unroll
            for (int m = 0; m < 4; ++m) { const int row = u.pm * BM + ai * HALF + wr * 64 + m * 16 + fr; rsxa[ai][m] = *(const PG8_GAS float*)(xsc + row); }
#pragma unroll
        for (int bj = 0; bj < 2; ++bj)
#pragma unroll
            for (int n = 0; n < 2; ++n) { wv[bj][n] = *(const PG8_GAS f32x4*)(wsc + hg * 64 + 32 * bj + 16 * n + 4 * fq); gv[bj][n] = g ? *(const PG8_GAS f32x4*)(g + 32 * bj + 16 * n + 4 * fq) : (f32x4){1.f, 1.f, 1.f, 1.f}; }
        __builtin_amdgcn_sched_barrier(0);
#pragma unroll
        for (int ai = 0; ai < 2; ++ai)
#pragma unroll
            for (int m = 0; m < 4; ++m) {
                const int row = u.pm * BM + ai * HALF + wr * 64 + m * 16 + fr;
                f32x4 v[2][2];
                const float rsx = rsxa[ai][m];
#pragma unroll
                for (int bj = 0; bj < 2; ++bj)
#pragma unroll
                    for (int n = 0; n < 2; ++n) { const i32x4 ia = __builtin_bit_cast(i32x4, acc[ai][bj][m][n]);
                        v[bj][n] = (f32x4){(float)ia[0], (float)ia[1], (float)ia[2], (float)ia[3]} * wv[bj][n] * rsx; }
                if (g) {
                    float ss = 0.f;
#pragma unroll
                    for (int bj = 0; bj < 2; ++bj)
#pragma unroll
                        for (int n = 0; n < 2; ++n) { const f32x4 x = v[bj][n]; ss += (x[0] * x[0] + x[1] * x[1]) + (x[2] * x[2] + x[3] * x[3]); }
                    ss += shx(ss, 16, fr + 16 * fq); ss += shx(ss, 32, fr + 16 * fq);
                    const float r = qs / sqrtf(ss * (1.0f / 64.0f) + 1e-6f);
#pragma unroll
                    for (int bj = 0; bj < 2; ++bj)
#pragma unroll
                        for (int n = 0; n < 2; ++n) v[bj][n] = v[bj][n] * gv[bj][n] * r;
                }
                if (dorope) {
                    const int t = row & 2047, pr = t >> 6, pc = t & 63;
#pragma unroll
                    for (int bj = 0; bj < 2; ++bj) {
                        const int pos = bj ? pc : pr;
                        const PG8_LAS float* rp = rope + (pos * 16 + 4 * fq) * 2;
                        const f32x4 c01 = *(const PG8_LAS f32x4*)rp, c23 = *(const PG8_LAS f32x4*)(rp + 4);
                        const f32x4 cs = (f32x4){c01[0], c01[2], c23[0], c23[2]}, sn = (f32x4){c01[1], c01[3], c23[1], c23[3]};
                        const f32x4 x1 = v[bj][0], x2 = v[bj][1];
                        v[bj][0] = x1 * cs - x2 * sn; v[bj][1] = x1 * sn + x2 * cs;
                    }
                }
                bf16_t* rowp = O + (size_t)row * 4096 + hg * 64 + 4 * fq;
#pragma unroll
                for (int bj = 0; bj < 2; ++bj)
#pragma unroll
                    for (int n = 0; n < 2; ++n) { u32x2 w; w.x = cvt_pk_bf16(v[bj][n][0], v[bj][n][1]); w.y = cvt_pk_bf16(v[bj][n][2], v[bj][n][3]); *(PG8_GAS u32x2*)(rowp + 32 * bj + 16 * n) = w; }
                asm volatile("" ::: "memory");
            }
    }
};
template <bool I8> __device__ __forceinline__ f32x4 mma16(const bf16x8 b, const bf16x8 a, const f32x4 c) {
    if constexpr (I8) return __builtin_bit_cast(f32x4, __builtin_amdgcn_mfma_i32_16x16x64_i8(__builtin_bit_cast(i32x4, b), __builtin_bit_cast(i32x4, a), __builtin_bit_cast(i32x4, c), 0, 0, 0));
    else return __builtin_amdgcn_mfma_f32_16x16x32_bf16(b, a, c, 0, 0, 0);
}
template <class Epi, class Sched, bool ALIGN_EPI = false, bool SP2 = false>
__device__ __forceinline__ void gemm_phase(PG8_LAS unsigned char* lds, const Gemm g, const Sched& S, const Epi& E, const int tid) {
    const int wid = __builtin_amdgcn_readfirstlane(tid >> 6), lane = tid & 63, wr = wid >> 2, wc = wid & 3, fr = lane & 15, fq = lane >> 4;
    const int K = g.K, nt = K / BK;
    unsigned voffA[2], voffB[2];
#pragma unroll
    for (int i = 0; i < 2; ++i) { int R, C; stage_rc(tid * 16 + i * 8192, R, C); const int Rb = Epi::PERM ? ((R & ~31) + perm32(R & 31)) : R;
        voffA[i] = (unsigned)(R * K + C) * 2u; voffB[i] = (unsigned)(Rb * K + C) * 2u; }
    const size_t kstep = (size_t)(BK * 2);
    const size_t hstep = (size_t)HALF * K * 2;
    const size_t tstep = 2 * hstep;
    const unsigned ldsw = (unsigned)wid * 1024u;
    const int aoff = lds_byte(wr * 64 + fr, fq * 8), boff = lds_byte(wc * 32 + fr, fq * 8);
#define PG8_SA(b, h) (((b) * 2 + (h)) * HTB)
#define PG8_SB(b, h) ((4 + (b) * 2 + (h)) * HTB)
#define PG8_STAGE(bufoff, gbase, voff) do { _Pragma("unroll") for (int _i = 0; _i < 2; ++_i) \
        __builtin_amdgcn_global_load_lds((const unsigned*)((const char*)(gbase) + (voff)[_i]), (PG8_LAS unsigned*)(lds + (bufoff) + ldsw + _i * 8192), 16, 0, 0); } while (0)
#define PG8_LDA(dst, b, h) do { _Pragma("unroll") for (int m = 0; m < 4; ++m) _Pragma("unroll") for (int k = 0; k < 2; ++k) dst[m][k] = *(const PG8_LAS bf16x8*)(lds + PG8_SA(b, h) + aoff + m * 2048 + k * 1024); } while (0)
#define PG8_LDB(dst, b, h) do { _Pragma("unroll") for (int n = 0; n < 2; ++n) _Pragma("unroll") for (int k = 0; k < 2; ++k) dst[n][k] = *(const PG8_LAS bf16x8*)(lds + PG8_SB(b, h) + boff + n * 2048 + k * 1024); } while (0)
#define PG8_MMA(ai, bj, At, Bt) do { __builtin_amdgcn_s_setprio(1); _Pragma("unroll") for (int m = 0; m < 4; ++m) _Pragma("unroll") for (int n = 0; n < 2; ++n) _Pragma("unroll") for (int k = 0; k < 2; ++k) \
        acc[ai][bj][m][n] = mma16<Epi::I8>(Bt[n][k], At[m][k], acc[ai][bj][m][n]); __builtin_amdgcn_s_setprio(0); } while (0)
#define PG8_WAIT_V(n) asm volatile("s_waitcnt vmcnt(" #n ")" ::: "memory")
#define PG8_WAIT_L(n) asm volatile("s_waitcnt lgkmcnt(" #n ")" ::: "memory")
#define PG8_BAR __builtin_amdgcn_s_barrier()
#define PG8_SCHED __builtin_amdgcn_sched_barrier(0)
    Unit cur, nxt; int ui = 0;
    if (!S.next(0, cur)) return;
    f32x4 acc[2][2][4][2];
#pragma unroll
    for (int a = 0; a < 2; ++a)
#pragma unroll
        for (int b = 0; b < 2; ++b)
#pragma unroll
            for (int m = 0; m < 4; ++m)
#pragma unroll
                for (int n = 0; n < 2; ++n) acc[a][b][m][n] = (f32x4){0.f, 0.f, 0.f, 0.f};
    bf16x8 At[4][2], B0[2][2], B1[2][2];
    const char* cA = (const char*)g.A + (size_t)cur.pm * tstep; const char* cB = (const char*)g.Bt + (size_t)cur.pn * tstep;
    S.a_ready(cur);
    if constexpr (SP2) {
        PG8_STAGE(PG8_SB(0, 0), cB, voffB); PG8_STAGE(PG8_SB(0, 1), cB + hstep, voffB); PG8_STAGE(PG8_SA(0, 0), cA, voffA); PG8_STAGE(PG8_SA(0, 1), cA + hstep, voffA);
        if (wr == 1) PG8_BAR;
        PG8_WAIT_V(2); PG8_BAR;
        PG8_STAGE(PG8_SB(1, 0), cB + kstep, voffB); PG8_STAGE(PG8_SA(1, 0), cA + kstep, voffA); PG8_STAGE(PG8_SB(1, 1), cB + hstep + kstep, voffB);
        PG8_WAIT_V(6); PG8_BAR;
    } else {
        PG8_STAGE(PG8_SB(0, 0), cB, voffB); PG8_STAGE(PG8_SA(0, 0), cA, voffA); PG8_STAGE(PG8_SB(0, 1), cB + hstep, voffB); PG8_STAGE(PG8_SA(0, 1), cA + hstep, voffA);
        if (wr == 1) PG8_BAR;
        PG8_WAIT_V(4); PG8_BAR;
        PG8_STAGE(PG8_SB(1, 0), cB + kstep, voffB); PG8_STAGE(PG8_SA(1, 0), cA + kstep, voffA); PG8_STAGE(PG8_SB(1, 1), cB + hstep + kstep, voffB);
        PG8_WAIT_V(6); PG8_BAR;
    }
    for (;;) {
        const bool has_next = S.next(ui + 1, nxt);
        const char* nA = has_next ? (const char*)g.A + (size_t)nxt.pm * tstep : cA; const char* nB = has_next ? (const char*)g.Bt + (size_t)nxt.pn * tstep : cB;
        for (int t = 0; t < nt; t += 2) {
            if constexpr (Epi::KSCALE) { if (t == Epi::KS0 || t == Epi::KS1) E.kscale(acc, cur, t == Epi::KS1 ? 1 : 0, wr, fr); }
            const bool last = (t == nt - 2);
            const char* a1 = cA + (size_t)(t + 1) * kstep;
            const char* a2 = last ? nA : cA + (size_t)(t + 2) * kstep; const char* b2 = last ? nB : cB + (size_t)(t + 2) * kstep;
            const char* a3 = a2 + kstep; const char* b3 = b2 + kstep;
            if (last && has_next) S.a_ready(nxt);
            if constexpr (SP2) {
            PG8_LDB(B0, 0, 0); PG8_LDB(B1, 0, 1); PG8_SCHED; PG8_LDA(At, 0, 0); PG8_STAGE(PG8_SA(1, 1), a1 + hstep, voffA);
            PG8_WAIT_V(8); PG8_WAIT_L(0); PG8_BAR; PG8_MMA(0, 0, At, B0); PG8_MMA(0, 1, At, B1); PG8_BAR; PG8_SCHED;
            PG8_LDA(At, 0, 1); PG8_STAGE(PG8_SB(0, 0), b2, voffB); PG8_STAGE(PG8_SB(0, 1), b2 + hstep, voffB); PG8_STAGE(PG8_SA(0, 0), a2, voffA);
            PG8_WAIT_V(8); PG8_WAIT_L(0); PG8_BAR; PG8_MMA(1, 0, At, B0); PG8_MMA(1, 1, At, B1); PG8_BAR; PG8_SCHED;
            PG8_LDB(B0, 1, 0); PG8_LDB(B1, 1, 1); PG8_SCHED; PG8_LDA(At, 1, 0); PG8_STAGE(PG8_SA(0, 1), a2 + hstep, voffA);
            PG8_WAIT_V(8); PG8_WAIT_L(0); PG8_BAR; PG8_MMA(0, 0, At, B0); PG8_MMA(0, 1, At, B1); PG8_BAR; PG8_SCHED;
            PG8_LDA(At, 1, 1); PG8_STAGE(PG8_SB(1, 0), b3, voffB); PG8_STAGE(PG8_SB(1, 1), b3 + hstep, voffB); PG8_STAGE(PG8_SA(1, 0), a3, voffA);
            PG8_WAIT_V(8); PG8_WAIT_L(0); PG8_BAR; PG8_MMA(1, 0, At, B0); PG8_MMA(1, 1, At, B1); PG8_BAR; PG8_SCHED;
            } else {
            PG8_LDB(B0, 0, 0); PG8_SCHED; PG8_LDA(At, 0, 0); PG8_STAGE(PG8_SA(1, 1), a1 + hstep, voffA);
            PG8_WAIT_L(8); PG8_BAR; PG8_WAIT_L(0); PG8_MMA(0, 0, At, B0); PG8_BAR; PG8_SCHED;
            PG8_LDB(B1, 0, 1); PG8_STAGE(PG8_SB(0, 0), b2, voffB);
            PG8_BAR; PG8_WAIT_L(0); PG8_MMA(0, 1, At, B1); PG8_BAR;
            PG8_LDA(At, 0, 1); PG8_STAGE(PG8_SA(0, 0), a2, voffA);
            PG8_BAR; PG8_WAIT_L(0); PG8_MMA(1, 0, At, B0); PG8_BAR; PG8_SCHED;
            PG8_STAGE(PG8_SB(0, 1), b2 + hstep, voffB);
            PG8_WAIT_V(6); PG8_BAR; PG8_MMA(1, 1, At, B1); PG8_BAR;
            PG8_LDB(B0, 1, 0); PG8_SCHED; PG8_LDA(At, 1, 0); PG8_STAGE(PG8_SA(0, 1), a2 + hstep, voffA);
            PG8_WAIT_L(8); PG8_BAR; PG8_WAIT_L(0); PG8_MMA(0, 0, At, B0); PG8_BAR; PG8_SCHED;
            PG8_LDB(B1, 1, 1); PG8_STAGE(PG8_SB(1, 0), b3, voffB);
            PG8_BAR; PG8_WAIT_L(0); PG8_MMA(0, 1, At, B1); PG8_BAR;
            PG8_LDA(At, 1, 1); PG8_STAGE(PG8_SA(1, 0), a3, voffA);
            PG8_BAR; PG8_WAIT_L(0); PG8_MMA(1, 0, At, B0); PG8_BAR; PG8_SCHED;
            PG8_STAGE(PG8_SB(1, 1), b3 + hstep, voffB);
            PG8_WAIT_V(6); PG8_BAR; PG8_MMA(1, 1, At, B1); PG8_BAR;
            }
        }
        if constexpr (ALIGN_EPI) { if (wr == 0) PG8_BAR; }
        if constexpr (!Epi::AFTER_DRAIN) { E(acc, cur, wr, wc, fr, fq); S.done(cur); }
        if (!has_next) break;
#pragma unroll
        for (int a = 0; a < 2; ++a)
#pragma unroll
            for (int b = 0; b < 2; ++b)
#pragma unroll
                for (int m = 0; m < 4; ++m)
#pragma unroll
                    for (int n = 0; n < 2; ++n) acc[a][b][m][n] = (f32x4){0.f, 0.f, 0.f, 0.f};
        cur = nxt; cA = nA; cB = nB; ++ui;
        if constexpr (ALIGN_EPI) { if (wr == 1) PG8_BAR; }
    }
    PG8_WAIT_V(0);
    if constexpr (!ALIGN_EPI) { if (wr == 0) PG8_BAR; }
    PG8_BAR;
    if constexpr (Epi::AFTER_DRAIN) { E.fused(acc, cur, wr, wc, fr, fq, lds, wid, lane); S.done(cur); }
#undef PG8_SA
#undef PG8_SB
#undef PG8_STAGE
#undef PG8_LDA
#undef PG8_LDB
#undef PG8_MMA
#undef PG8_WAIT_V
#undef PG8_WAIT_L
#undef PG8_BAR
#undef PG8_SCHED
}
}

constexpr int BATCH = 16, SEQ = 2048, DM = 2048, T = BATCH * SEQ, DEPTH = 2;
constexpr int NMEM = 256, DIN = 4096, MEMW = 512;
constexpr int PEER_H = 8, PEER_N = 16384;
constexpr int NWAVES = 8, NTHREADS = NWAVES * 64;
constexpr float EPS = 1e-6f;
constexpr int QA = 0, KA = 768, VA = 1024, QB = 1280, KB = 1792, VB = 2304, QC = 2816, KC = 3584, VC = 3840;
constexpr int OA = 0, OB = 768, OC = 1280;

constexpr size_t MiB = 1u << 20;
constexpr size_t WS_CTL = 0, CTL_ZERO_BYTES = 2 * MiB;
constexpr size_t WS_ROWSQ = 256 * 1024;
constexpr size_t WS_ROPE = 83 * MiB, WS_BIASA = 83 * MiB + 16384;
constexpr size_t WS_WIN = 2 * MiB, WS_WOUT = 34 * MiB, WS_WMQ = 50 * MiB, WS_WMKV = 54 * MiB, WS_WMO = 62 * MiB, WS_WPQ = 66 * MiB, WS_PKEYS = 82 * MiB;
constexpr size_t WS_MEMN = 84 * MiB, WS_KVM = 116 * MiB, WS_PU = 132 * MiB, WS_PV = 260 * MiB, WS_XN = 388 * MiB, WS_QKV = 516 * MiB, WS_ATT = 772 * MiB;
constexpr size_t WS_QM = 900 * MiB, WS_OM = 932 * MiB, WS_MIXSQ = 964 * MiB, MIXSQ_BYTES = 2 * MiB, WS_WIN8 = 966 * MiB, WS_WSC = 982 * MiB, WS_XSC = 982 * MiB + 65536, WS_XSC2 = 982 * MiB + 196608, WS_WSCO = 982 * MiB + 327680, WS_WSCP = 982 * MiB + 344064, WS_WSCM = 982 * MiB + 360448,
                 WS_WOUT8 = 984 * MiB, WS_WPQ8 = 992 * MiB, WS_WMQ8 = 1000 * MiB, WS_END = 1002 * MiB;
constexpr size_t WS_QP = WS_QKV, WS_PIDX = WS_QKV + 128 * MiB, WS_PGATE = WS_QKV + 144 * MiB, WS_PARTI = WS_QKV + 160 * MiB;
constexpr size_t WS_XQH = 900 * MiB, WS_XQL = 932 * MiB;
constexpr size_t WS_ATT8 = 900 * MiB;
constexpr size_t WS_X8 = 772 * MiB;
constexpr size_t WS_XN8 = 836 * MiB;
constexpr int CW_BAR = 4096;

constexpr int RING_OFF = 0, RING_BYTES = 131072;
constexpr int LDSCTL_OFF = RING_BYTES, MISC_OFF = LDSCTL_OFF + 320;
constexpr int LDS_BYTES = 147456;

#define GAS __attribute__((address_space(1)))
#define LAS __attribute__((address_space(3)))
typedef unsigned short bf16;
typedef unsigned v4u __attribute__((ext_vector_type(4)));
typedef unsigned v2u __attribute__((ext_vector_type(2)));
typedef float f32x4 __attribute__((ext_vector_type(4)));
typedef float f32x16 __attribute__((ext_vector_type(16)));
typedef short bf16x8 __attribute__((ext_vector_type(8)));
typedef GAS unsigned gu32;
#define LDS_WAIT() asm volatile("s_waitcnt lgkmcnt(0)" ::: "memory")
#define VM_WAIT() asm volatile("s_waitcnt vmcnt(0)" ::: "memory")
__device__ __forceinline__ unsigned f2bf(float f) { unsigned u = __builtin_bit_cast(unsigned, f); return (u + 0x7fffu + ((u >> 16) & 1u)) >> 16; }
__device__ __forceinline__ unsigned pk2(float lo, float hi) { return f2bf(lo) | (f2bf(hi) << 16); }
__device__ __forceinline__ float bflo(unsigned w) { return __builtin_bit_cast(float, w << 16); }
__device__ __forceinline__ float bfhi(unsigned w) { return __builtin_bit_cast(float, w & 0xffff0000u); }

__device__ __forceinline__ float shx(float v, int k, int lane) { return __builtin_bit_cast(float, __builtin_amdgcn_ds_bpermute((lane ^ k) << 2, __builtin_bit_cast(int, v))); }
#define XB_TMO      128
#define XB_XCNT(j)  (256  + 64 * (j))
#define XB_XSUB(j)  (1280 + 64 * (j))
#define XB_XGEN(j)  (2304 + 64 * (j))
#define XB_TOP      3328
#define XB_TOPGEN   3392
#define XCD_BAR_WORDS 3456
#define XB_SPIN_CAP (1u << 18)

__device__ __forceinline__ unsigned xb_ld(unsigned* p)              { return __hip_atomic_load(p, __ATOMIC_RELAXED, __HIP_MEMORY_SCOPE_AGENT); }
__device__ __forceinline__ unsigned xb_add(unsigned* p, unsigned v) { return __hip_atomic_fetch_add(p, v, __ATOMIC_RELAXED, __HIP_MEMORY_SCOPE_AGENT); }
__device__ __forceinline__ unsigned xb_xcc_id() { return (unsigned)__builtin_amdgcn_s_getreg((3 << 11) | 20) & 0xFu; }
#define XB_SPIN(cond, bar) do { unsigned _sp = 0; while (cond) { __builtin_amdgcn_s_sleep(1); \
    if ((++_sp & 255u) == 0u) { if (xb_ld(&(bar)[XB_TMO])) break; if (_sp > XB_SPIN_CAP) { atomicAdd(&(bar)[XB_TMO], 1u); break; } } } } while (0)

struct XcdBarrier {
    unsigned* bar; unsigned x;
    volatile LAS unsigned* st;
};

__device__ __forceinline__ XcdBarrier xcd_barrier_post(unsigned* bar, volatile LAS unsigned* st) {
    XcdBarrier b; b.bar = bar; b.x = xb_xcc_id(); b.st = st;
    if (threadIdx.x == 0) (void)xb_add(&bar[XB_XCNT(b.x)], 1u);
    return b;
}
__device__ __forceinline__ void xcd_barrier_complete(unsigned* bar, unsigned x, unsigned& nloc, unsigned& nx) {
    const unsigned G = gridDim.x * gridDim.y * gridDim.z;
    unsigned sum, cnt, mine, sp = 0u;
    for (;;) {
        sum = 0u; cnt = 0u; mine = 0u;
#pragma unroll
        for (unsigned j = 0; j < 16; ++j) { const unsigned c = xb_ld(&bar[XB_XCNT(j)]); sum += c; cnt += (c > 0u) ? 1u : 0u; mine = (j == x) ? c : mine; }
        if (sum == G) break;
        __builtin_amdgcn_s_sleep(1);
        if ((++sp & 255u) == 0u) { if (xb_ld(&bar[XB_TMO])) break; if (sp > XB_SPIN_CAP) { atomicAdd(&bar[XB_TMO], 1u); break; } }
    }
    nloc = mine > 0u ? mine : 1u; nx = cnt > 0u ? cnt : 1u;
}

__device__ __forceinline__ void xcd_barrier(const XcdBarrier& b) {
    asm volatile("s_waitcnt vmcnt(0)" ::: "memory");
    __syncthreads();
    if (threadIdx.x == 0) {
        unsigned* bar = b.bar;
        __builtin_amdgcn_s_waitcnt(0);
        unsigned nloc = b.st[0], nx = b.st[1];
        if (nloc == 0u) { xcd_barrier_complete(bar, b.x, nloc, nx); b.st[0] = nloc; b.st[1] = nx; }
        const unsigned old = xb_add(&bar[XB_XSUB(b.x)], 1u);
        const unsigned gen = old / nloc;
        if (old + 1u == (gen + 1u) * nloc) {
            __builtin_amdgcn_fence(__ATOMIC_RELEASE, "agent");
            asm volatile("s_waitcnt vmcnt(0)" ::: "memory");
            const unsigned og = xb_add(&bar[XB_TOP], 1u);
            const unsigned tg = og / nx;
            if (og + 1u == (tg + 1u) * nx) xb_add(&bar[XB_TOPGEN], 1u);
            else XB_SPIN(xb_ld(&bar[XB_TOPGEN]) == tg, bar);
            __builtin_amdgcn_fence(__ATOMIC_ACQUIRE, "agent");
            xb_add(&bar[XB_XGEN(b.x)], 1u);
            asm volatile("s_waitcnt vmcnt(0)" ::: "memory");
        } else {
            XB_SPIN(xb_ld(&bar[XB_XGEN(b.x)]) == gen, bar);
            __builtin_amdgcn_fence(__ATOMIC_ACQUIRE, "agent");
            asm volatile("s_waitcnt vmcnt(0)" ::: "memory");
        }
    }
    __syncthreads();
}

__device__ __forceinline__ float wave_sum(float v, int lane) {
#pragma unroll
    for (int o = 1; o < 64; o <<= 1) v += shx(v, o, lane);
    return v;
}
__device__ __forceinline__ void* ldptr(LAS unsigned char* lds, int i) {
    const unsigned long long v = ((const LAS unsigned long long*)(lds + LDSCTL_OFF + 1024))[i];
    const unsigned lo = __builtin_amdgcn_readfirstlane((unsigned)v), hi = __builtin_amdgcn_readfirstlane((unsigned)(v >> 32));
    return (void*)(((unsigned long long)hi << 32) | lo);
}
struct OffsetOrder {
    pg8::StaticOrder S;
    __device__ __forceinline__ void init(int M, int N, int G, int c, int off) { S.init(M, N, G, (c + G - off % G) % G); }
    __device__ __forceinline__ bool next(int i, pg8::Unit& u) const { return S.next(i, u); }
    __device__ __forceinline__ void a_ready(const pg8::Unit&) const {}
    __device__ __forceinline__ void done(const pg8::Unit&) const {}
};

template <bool PERMQKV>
__device__ __forceinline__ void transpose_item(const float* W, int K, int N, bf16* WT, LAS float* scr, int item, int lane, const float* gk = nullptr) {
    const int nblk = N / 32, kb = item / nblk, nb = item % nblk, k0 = 64 * kb, n0 = 32 * nb;
    int d0 = n0;
    if (PERMQKV) { const int within = n0 & 255; d0 = (n0 & ~255) + 128 * ((within >> 5) & 1) + 32 * (within >> 6); }
#pragma unroll
    for (int i = 0; i < 8; ++i) { const int kk = 8 * i + (lane >> 3), nn = 4 * (lane & 7);
        const f32x4 w4 = *(const GAS f32x4*)(W + (size_t)(k0 + kk) * N + n0 + nn) * (gk ? gk[k0 + kk] : 1.f);
        scr[kk * 33 + nn] = w4[0]; scr[kk * 33 + nn + 1] = w4[1]; scr[kk * 33 + nn + 2] = w4[2]; scr[kk * 33 + nn + 3] = w4[3]; }
    LDS_WAIT(); asm volatile("" ::: "memory");
    const int c = lane & 7;
#pragma unroll
    for (int j = 0; j < 4; ++j) { const int n = (lane >> 3) + 8 * j; const LAS float* s = scr + (8 * c) * 33 + n;
        v4u o; o.x = pk2(s[0 * 33], s[1 * 33]); o.y = pk2(s[2 * 33], s[3 * 33]); o.z = pk2(s[4 * 33], s[5 * 33]); o.w = pk2(s[6 * 33], s[7 * 33]);
        *(GAS v4u*)(WT + (size_t)(d0 + n) * K + k0 + 8 * c) = o; }
    LDS_WAIT(); asm volatile("" ::: "memory");
}
__device__ __forceinline__ void convert_bf16(const float* src, bf16* dst, size_t n, size_t gtid, size_t nthreads) {
    for (size_t i = gtid * 8; i < n; i += nthreads * 8) {
        const f32x4 a = *(const GAS f32x4*)(src + i), b = *(const GAS f32x4*)(src + i + 4);
        v4u o; o.x = pk2(a[0], a[1]); o.y = pk2(a[2], a[3]); o.z = pk2(b[0], b[1]); o.w = pk2(b[2], b[3]);
        *(GAS v4u*)(dst + i) = o;
    }
}
__device__ __forceinline__ int t5_bucket(int rel) {
    const int n = rel < 0 ? -rel : rel;
    const int b = n < 8 ? n : n < 12 ? 8 : n < 16 ? 9 : n < 23 ? 10 : n < 32 ? 11 : n < 46 ? 12 : n < 64 ? 13 : n < 91 ? 14 : 15;
    return b + (rel > 0 ? 16 : 0);
}
__constant__ float ROPE_INV[16] = {1.000000000e+00f, 5.623413324e-01f, 3.162277639e-01f, 1.778279394e-01f, 1.000000015e-01f, 5.623413250e-02f, 3.162277490e-02f, 1.778279431e-02f,
                                   9.999999776e-03f, 5.623413250e-03f, 3.162277630e-03f, 1.778279431e-03f, 1.000000047e-03f, 5.623413017e-04f, 3.162277571e-04f, 1.778279402e-04f};

__device__ __forceinline__ void rms_row_to_bf16(const float* xrow, const float* g0, bf16* o0, const float* g1, bf16* o1, int lane) {
    const GAS f32x4* xr = (const GAS f32x4*)xrow + lane;
    f32x4 v[8]; float s = 0.f;
#pragma unroll
    for (int j = 0; j < 8; ++j) { v[j] = xr[64 * j]; s += (v[j].x * v[j].x + v[j].y * v[j].y) + (v[j].z * v[j].z + v[j].w * v[j].w); }
    const float rstd = 1.f / sqrtf(wave_sum(s, lane) * (1.f / DM) + EPS);
    {   const GAS f32x4* gr = (const GAS f32x4*)g0 + lane; GAS v2u* o8 = (GAS v2u*)o0 + lane;
#pragma unroll
        for (int j = 0; j < 8; ++j) { const f32x4 gg = gr[64 * j]; v2u w; w.x = pk2(v[j].x * rstd * gg.x, v[j].y * rstd * gg.y); w.y = pk2(v[j].z * rstd * gg.z, v[j].w * rstd * gg.w); o8[64 * j] = w; } }
    if (g1) { const GAS f32x4* gr = (const GAS f32x4*)g1 + lane; GAS v2u* o8 = (GAS v2u*)o1 + lane;
#pragma unroll
        for (int j = 0; j < 8; ++j) { const f32x4 gg = gr[64 * j]; v2u w; w.x = pk2(v[j].x * rstd * gg.x, v[j].y * rstd * gg.y); w.y = pk2(v[j].z * rstd * gg.z, v[j].w * rstd * gg.w); o8[64 * j] = w; } }
}
__device__ __forceinline__ float wave_max(float v, int lane) {
#pragma unroll
    for (int o = 1; o < 64; o <<= 1) v = fmaxf(v, shx(v, o, lane));
    return v;
}
__device__ __forceinline__ unsigned q8x4(const f32x4 v, const float inv) {
    unsigned w = 0;
    w = __builtin_amdgcn_cvt_pk_u8_f32(__builtin_rintf(__builtin_fmaf(v[0], inv, 128.f)), 0, w); w = __builtin_amdgcn_cvt_pk_u8_f32(__builtin_rintf(__builtin_fmaf(v[1], inv, 128.f)), 1, w);
    w = __builtin_amdgcn_cvt_pk_u8_f32(__builtin_rintf(__builtin_fmaf(v[2], inv, 128.f)), 2, w); w = __builtin_amdgcn_cvt_pk_u8_f32(__builtin_rintf(__builtin_fmaf(v[3], inv, 128.f)), 3, w);
    return w ^ 0x80808080u;
}
__device__ __forceinline__ float amax4(const f32x4 v) { return fmaxf(fmaxf(fabsf(v[0]), fabsf(v[1])), fmaxf(fabsf(v[2]), fabsf(v[3]))); }
__device__ __forceinline__ void quant_wrow(const bf16* src, unsigned char* dst, float* step, int lane) {
    v4u w[4]; float am = 0.f;
#pragma unroll
    for (int j = 0; j < 4; ++j) w[j] = *(const GAS v4u*)(src + 8 * lane + 512 * j);
    f32x4 lo[4], hi[4];
#pragma unroll
    for (int j = 0; j < 4; ++j) { lo[j] = (f32x4){bflo(w[j].x), bfhi(w[j].x), bflo(w[j].y), bfhi(w[j].y)}; hi[j] = (f32x4){bflo(w[j].z), bfhi(w[j].z), bflo(w[j].w), bfhi(w[j].w)}; am = fmaxf(am, fmaxf(amax4(lo[j]), amax4(hi[j]))); }
    am = fmaxf(wave_max(am, lane), 1e-30f);
    const float inv = 127.f / am;
#pragma unroll
    for (int j = 0; j < 4; ++j) *(GAS v2u*)(dst + 8 * lane + 512 * j) = (v2u){q8x4(lo[j], inv), q8x4(hi[j], inv)};
    if (lane == 0) *step = am * (1.f / 127.f);
}
template <int R>
__device__ __forceinline__ void att_quant_rows(const bf16* ATT, const u64_t* mixsq, unsigned char* Q, float* step, int row0, int lane) {
    v4u w[R][4];
#pragma unroll
    for (int q = 0; q < R; ++q)
#pragma unroll
        for (int j = 0; j < 4; ++j) w[q][j] = *(const GAS v4u*)(ATT + (size_t)(row0 + q) * DM + 8 * lane + 512 * j);
#pragma unroll
    for (int q = 0; q < R; ++q) { const int row = row0 + q;
        const float ra = 1.0f / sqrtf((float)*(const GAS u64_t*)(mixsq + row) * (5.9604644775390625e-08f / 768.0f) + EPS), rb = 1.0f / sqrtf((float)*(const GAS u64_t*)(mixsq + T + row) * (5.9604644775390625e-08f / 512.0f) + EPS),
                    rc = 1.0f / sqrtf((float)*(const GAS u64_t*)(mixsq + 2 * (size_t)T + row) * (5.9604644775390625e-08f / 768.0f) + EPS);
        const float rj[4] = {ra, lane < 32 ? ra : rb, lane < 32 ? rb : rc, rc};
        f32x4 lo[4], hi[4]; float am = 0.f;
#pragma unroll
        for (int j = 0; j < 4; ++j) { lo[j] = (f32x4){bflo(w[q][j].x), bfhi(w[q][j].x), bflo(w[q][j].y), bfhi(w[q][j].y)} * rj[j]; hi[j] = (f32x4){bflo(w[q][j].z), bfhi(w[q][j].z), bflo(w[q][j].w), bfhi(w[q][j].w)} * rj[j]; am = fmaxf(am, fmaxf(amax4(lo[j]), amax4(hi[j]))); }
        am = fmaxf(wave_max(am, lane), 1e-30f);
        const float inv = 127.f / am;
#pragma unroll
        for (int j = 0; j < 4; ++j) *(GAS v2u*)(Q + (size_t)row * DM + 8 * lane + 512 * j) = (v2u){q8x4(lo[j], inv), q8x4(hi[j], inv)};
        if (lane == 0) step[row] = am * (1.f / 127.f); }
}
__device__ __forceinline__ void prep_rows2(const float* x0, bf16* o0, u64_t* sq, unsigned char* q0, float* qstep, int lane) {
    f32x4 v[2][8];
#pragma unroll
    for (int q = 0; q < 2; ++q) { const GAS f32x4* xr = (const GAS f32x4*)(x0 + (size_t)q * DM) + lane;
#pragma unroll
        for (int j = 0; j < 8; ++j) v[q][j] = xr[64 * j]; }
#pragma unroll
    for (int q = 0; q < 2; ++q) { GAS v2u* o8 = (GAS v2u*)(o0 + (size_t)q * DM) + lane; float s = 0.f;
#pragma unroll
        for (int j = 0; j < 8; ++j) { const f32x4 a = v[q][j]; s += (a.x * a.x + a.y * a.y) + (a.z * a.z + a.w * a.w); v2u w; w.x = pk2(a.x, a.y); w.y = pk2(a.z, a.w); o8[64 * j] = w; }
        s = wave_sum(s, lane);
        float am = 0.f;
#pragma unroll
        for (int j = 0; j < 8; ++j) am = fmaxf(am, amax4(v[q][j]));
        am = fmaxf(wave_max(am, lane), 1e-30f);
        const float inv = 127.f / am;
#pragma unroll
        for (int j = 0; j < 8; ++j) *(GAS unsigned*)(q0 + (size_t)q * DM + 4 * lane + 256 * j) = q8x4(v[q][j], inv);
        if (lane == 0) { sq[q] = rowsq_fx(s); qstep[q] = am * (1.f / 127.f) / sqrtf(s * (1.f / DM) + 1e-6f); } }
}
__device__ __forceinline__ void norm_rows(const float* X, const float* g, bf16* XN, int gw, int NGW, int lane) {
    for (int m = gw; m < T; m += NGW) rms_row_to_bf16(X + (size_t)m * DM, g, XN + (size_t)m * DM, nullptr, nullptr, lane);
}

template <int TYPE>
__device__ __forceinline__ void naive_attn_item(const bf16* QKV, bf16* ATT, int b, int grow, int head, int lane, const float* biasA, const float* sink, const float* rpb) {
    const int tpos = grow * 64 + lane; const size_t trow = (size_t)b * SEQ + tpos;
    int qcol, kcol, vcol, ocol;
    if (TYPE == 0) { qcol = QA + head * 64; kcol = KA + (head / 3) * 64; vcol = VA + (head / 3) * 64; ocol = OA + head * 64; }
    else if (TYPE == 1) { qcol = QB + head * 64; kcol = KB + head * 64; vcol = VB + head * 64; ocol = OB + head * 64; }
    else { qcol = QC + head * 64; kcol = KC + (head / 3) * 64; vcol = VC + (head / 3) * 64; ocol = OC + head * 64; }
    float q[64], o[64];
#pragma unroll
    for (int c = 0; c < 8; ++c) { const v4u w = *(const GAS v4u*)(QKV + trow * DIN + qcol + 8 * c);
        q[8 * c + 0] = bflo(w.x); q[8 * c + 1] = bfhi(w.x); q[8 * c + 2] = bflo(w.y); q[8 * c + 3] = bfhi(w.y); q[8 * c + 4] = bflo(w.z); q[8 * c + 5] = bfhi(w.z); q[8 * c + 6] = bflo(w.w); q[8 * c + 7] = bfhi(w.w); }
#pragma unroll
    for (int d = 0; d < 64; ++d) o[d] = 0.f;
    float m = -1e30f, l = 0.f;
    int j0, j1;
    if (TYPE == 0) { j0 = grow * 64 - 128; if (j0 < 0) j0 = 0; j1 = grow * 64 + 63 + 128; if (j1 > SEQ - 1) j1 = SEQ - 1; }
    else if (TYPE == 1) { int r0 = grow - 4; r0 = r0 < 0 ? 0 : (r0 > 24 ? 24 : r0); j0 = r0 * 64; j1 = j0 + 511; }
    else { j0 = 0; j1 = SEQ - 1; }
    int c0 = lane - 8; c0 = c0 < 0 ? 0 : (c0 > 48 ? 48 : c0);
#pragma unroll 1
    for (int j = j0; j <= j1; ++j) {
        const bf16* krow = QKV + ((size_t)b * SEQ + j) * DIN;
        float s = 0.f;
#pragma unroll
        for (int c = 0; c < 8; ++c) { const v4u w = *(const GAS v4u*)(krow + kcol + 8 * c);
            s += q[8 * c + 0] * bflo(w.x) + q[8 * c + 1] * bfhi(w.x) + q[8 * c + 2] * bflo(w.y) + q[8 * c + 3] * bfhi(w.y) + q[8 * c + 4] * bflo(w.z) + q[8 * c + 5] * bfhi(w.z) + q[8 * c + 6] * bflo(w.w) + q[8 * c + 7] * bfhi(w.w); }
        bool valid = true;
        if (TYPE == 0) { const int rel = j - tpos; valid = (rel >= -128 && rel <= 128); if (valid) s += biasA[head * 257 + rel + 128]; }
        if (TYPE == 1) { const int kr = j >> 6, kc = j & 63; valid = (kc >= c0 && kc < c0 + 16); if (valid) s += rpb[(head * 15 + (kr - grow + 7)) * 31 + (kc - lane + 15)]; }
        const float mn = valid ? fmaxf(m, s) : m;
        const float a = __expf(m - mn);
        const float p = valid ? __expf(s - mn) : 0.f;
        l = l * a + p; m = mn;
#pragma unroll
        for (int c = 0; c < 8; ++c) { const v4u w = *(const GAS v4u*)(krow + vcol + 8 * c);
            o[8 * c + 0] = o[8 * c + 0] * a + p * bflo(w.x); o[8 * c + 1] = o[8 * c + 1] * a + p * bfhi(w.x); o[8 * c + 2] = o[8 * c + 2] * a + p * bflo(w.y); o[8 * c + 3] = o[8 * c + 3] * a + p * bfhi(w.y);
            o[8 * c + 4] = o[8 * c + 4] * a + p * bflo(w.z); o[8 * c + 5] = o[8 * c + 5] * a + p * bfhi(w.z); o[8 * c + 6] = o[8 * c + 6] * a + p * bflo(w.w); o[8 * c + 7] = o[8 * c + 7] * a + p * bfhi(w.w); }
    }
    if (TYPE == 0) l += __expf(sink[head] - m);
    const float inv = 1.f / l;
#pragma unroll
    for (int c = 0; c < 8; ++c) { v4u w; w.x = pk2(o[8 * c + 0] * inv, o[8 * c + 1] * inv); w.y = pk2(o[8 * c + 2] * inv, o[8 * c + 3] * inv); w.z = pk2(o[8 * c + 4] * inv, o[8 * c + 5] * inv); w.w = pk2(o[8 * c + 6] * inv, o[8 * c + 7] * inv);
        *(GAS v4u*)(ATT + trow * DM + ocol + 8 * c) = w; }
}
__device__ __forceinline__ float rdl(float v, int l) { return __builtin_bit_cast(float, __builtin_amdgcn_readlane(__builtin_bit_cast(int, v), l)); }
__device__ __forceinline__ void naive_mem_item(const bf16* QM, const bf16* KVM, bf16* OM, const float* gq, size_t trow, int b, int head, int lane) {
    const unsigned qw = *(const GAS unsigned*)(QM + trow * MEMW + head * 128 + 2 * lane);
    float q0 = bflo(qw), q1 = bfhi(qw);
    const float ss = wave_sum(q0 * q0 + q1 * q1, lane);
    const float r = 0.08838834764831845f / sqrtf(ss * (1.f / 128.f) + EPS);
    q0 *= r * gq[2 * lane]; q1 *= r * gq[2 * lane + 1];
    const bf16* kbase = KVM + ((size_t)b * NMEM + lane) * 1024 + head * 128;
    float s[4] = {0.f, 0.f, 0.f, 0.f};
#pragma unroll 1
    for (int c = 0; c < 16; ++c) {
        float qa[8];
#pragma unroll
        for (int e = 0; e < 4; ++e) { qa[2 * e] = rdl(q0, 4 * c + e); qa[2 * e + 1] = rdl(q1, 4 * c + e); }
#pragma unroll
        for (int i = 0; i < 4; ++i) { const v4u w = *(const GAS v4u*)(kbase + (size_t)i * 64 * 1024 + 8 * c);
            s[i] += qa[0] * bflo(w.x) + qa[1] * bfhi(w.x) + qa[2] * bflo(w.y) + qa[3] * bfhi(w.y) + qa[4] * bflo(w.z) + qa[5] * bfhi(w.z) + qa[6] * bflo(w.w) + qa[7] * bfhi(w.w); }
    }
    float m = fmaxf(fmaxf(s[0], s[1]), fmaxf(s[2], s[3]));
#pragma unroll
    for (int o = 1; o < 64; o <<= 1) m = fmaxf(m, shx(m, o, lane));
    float p[4]; float l = 0.f;
#pragma unroll
    for (int i = 0; i < 4; ++i) { p[i] = __expf(s[i] - m); l += p[i]; }
    l = wave_sum(l, lane);
    const bf16* vbase = KVM + ((size_t)b * NMEM) * 1024 + 512 + head * 128 + 2 * lane;
    float o0 = 0.f, o1 = 0.f;
#pragma unroll
    for (int i = 0; i < 4; ++i) {
#pragma unroll 4
        for (int jj = 0; jj < 64; ++jj) { const float pj = rdl(p[i], jj); const unsigned w = *(const GAS unsigned*)(vbase + (size_t)(64 * i + jj) * 1024); o0 += pj * bflo(w); o1 += pj * bfhi(w); }
    }
    const float inv = 1.f / l;
    *(GAS unsigned*)(OM + trow * MEMW + head * 128 + 2 * lane) = pk2(o0 * inv, o1 * inv);
}
__device__ __forceinline__ void mixnorm_rows(bf16* ATT, const float* g, int gw, int NGW, int lane) {
    for (int m = gw; m < T; m += NGW) {
        GAS v4u* p = (GAS v4u*)(ATT + (size_t)m * DM + 32 * lane);
        v4u w[4]; float f[32]; float ss = 0.f;
#pragma unroll
        for (int c = 0; c < 4; ++c) { w[c] = p[c];
            f[8 * c + 0] = bflo(w[c].x); f[8 * c + 1] = bfhi(w[c].x); f[8 * c + 2] = bflo(w[c].y); f[8 * c + 3] = bfhi(w[c].y); f[8 * c + 4] = bflo(w[c].z); f[8 * c + 5] = bfhi(w[c].z); f[8 * c + 6] = bflo(w[c].w); f[8 * c + 7] = bfhi(w[c].w); }
#pragma unroll
        for (int i = 0; i < 32; ++i) ss += f[i] * f[i];
        const int grp = lane < 24 ? 0 : (lane < 40 ? 1 : 2);
        const float sa = wave_sum(grp == 0 ? ss : 0.f, lane), sb = wave_sum(grp == 1 ? ss : 0.f, lane), sc = wave_sum(grp == 2 ? ss : 0.f, lane);
        const float r = grp == 0 ? 1.f / sqrtf(sa * (1.f / 768.f) + EPS) : (grp == 1 ? 1.f / sqrtf(sb * (1.f / 512.f) + EPS) : 1.f / sqrtf(sc * (1.f / 768.f) + EPS));
        const float* gg = g + 32 * lane;
#pragma unroll
        for (int c = 0; c < 4; ++c) { const f32x4 g0 = *(const GAS f32x4*)(gg + 8 * c), g1 = *(const GAS f32x4*)(gg + 8 * c + 4);
            v4u o; o.x = pk2(f[8 * c + 0] * r * g0[0], f[8 * c + 1] * r * g0[1]); o.y = pk2(f[8 * c + 2] * r * g0[2], f[8 * c + 3] * r * g0[3]);
            o.z = pk2(f[8 * c + 4] * r * g1[0], f[8 * c + 5] * r * g1[1]); o.w = pk2(f[8 * c + 6] * r * g1[2], f[8 * c + 7] * r * g1[3]); p[c] = o; }
    }
}

#ifndef PEER_HD
#define PEER_HD __device__ __forceinline__
#define PEER_EXP(x) __expf(x)
#endif
template <int N> PEER_HD void bitonic_sort_desc(float* v) {
#pragma unroll
    for (int k = 2; k <= N; k <<= 1)
#pragma unroll
        for (int j = k >> 1; j > 0; j >>= 1)
#pragma unroll
            for (int i = 0; i < N; ++i) { const int l = i ^ j; if (l > i) { const bool desc = ((i & k) == 0); const float a = v[i], b = v[l]; const float hi = fmaxf(a, b), lo = fminf(a, b);
                v[i] = desc ? hi : lo; v[l] = desc ? lo : hi; } }
}
PEER_HD void merge_top16(float* a, const float* b) {
    float c[16];
#pragma unroll
    for (int i = 0; i < 16; ++i) c[i] = fmaxf(a[i], b[15 - i]);
#pragma unroll
    for (int j = 8; j > 0; j >>= 1)
#pragma unroll
        for (int i = 0; i < 16; ++i) { const int l = i ^ j; if (l > i) { const float x = c[i], y = c[l]; c[i] = fmaxf(x, y); c[l] = fminf(x, y); } }
#pragma unroll
    for (int i = 0; i < 16; ++i) a[i] = c[i];
}
PEER_HD void top16_of_64(float (&v)[64]) {
    bitonic_sort_desc<16>(&v[0]); bitonic_sort_desc<16>(&v[16]); bitonic_sort_desc<16>(&v[32]); bitonic_sort_desc<16>(&v[48]);
    merge_top16(&v[0], &v[16]); merge_top16(&v[32], &v[48]); merge_top16(&v[0], &v[32]);
}
PEER_HD float pack_idx(float s, unsigned idx, unsigned mask) { return __builtin_bit_cast(float, (__builtin_bit_cast(unsigned, s) & ~mask) | idx); }
PEER_HD unsigned low_bits(float s, unsigned mask) { return __builtin_bit_cast(unsigned, s) & mask; }
PEER_HD unsigned pick16(const float* a, unsigned i, unsigned mask) {
    unsigned r = 0;
#pragma unroll
    for (unsigned k = 0; k < 16; ++k) r = (i == k) ? low_bits(a[k], mask) : r;
    return r;
}
PEER_HD void peer_candidates(const float* a, const float* b, int* e, float* gate) {
    float c[64]; int n = 0;
#pragma unroll
    for (int i = 0; i < 16; ++i)
#pragma unroll
        for (int j = 0; j < 16; ++j) if ((i + 1) * (j + 1) <= 16) { c[n] = pack_idx(a[i] + b[j], (unsigned)(i * 16 + j), 0xffu); ++n; }
#pragma unroll
    for (int k = 50; k < 64; ++k) c[k] = -3.0e38f;
    top16_of_64(c);
    float mx = c[0], den = 0.f;
#pragma unroll
    for (int k = 0; k < 16; ++k) { const unsigned id = low_bits(c[k], 0xffu); const unsigned n0 = pick16(a, id >> 4, 0x7fu), n1 = pick16(b, id & 15u, 0x7fu);
        e[k] = (int)(n0 * 128u + n1); gate[k] = PEER_EXP(c[k] - mx); den += gate[k]; }
    const float inv = 1.f / den;
#pragma unroll
    for (int k = 0; k < 16; ++k) gate[k] *= inv;
}

__device__ __forceinline__ void peer_select_unit(const bf16* QP, const bf16* PK, int* PIDX, float* PGATE, int tb, int h, int wave, int lane) {
    const int hh = lane >> 5, tl = lane & 31; const size_t t = (size_t)tb * 256 + wave * 32 + tl;
    float ab[2][16];
#pragma unroll
    for (int p = 0; p < 2; ++p) {
        bf16x8 bq[8];
#pragma unroll
        for (int s = 0; s < 8; ++s) bq[s] = *(const GAS bf16x8*)(QP + t * DM + 256 * h + 128 * p + 16 * s + 8 * hh);
        float v[64];
#pragma unroll
        for (int nb = 0; nb < 4; ++nb) {
            f32x16 acc;
#pragma unroll
            for (int r = 0; r < 16; ++r) acc[r] = 0.f;
            const bf16* kp = PK + ((size_t)((h * 2 + p) * 128 + 32 * nb + tl)) * 128 + 8 * hh;
            bf16x8 ak[8];
#pragma unroll
            for (int s = 0; s < 8; ++s) ak[s] = *(const GAS bf16x8*)(kp + 16 * s);
#pragma unroll
            for (int s = 0; s < 8; ++s) acc = __builtin_amdgcn_mfma_f32_32x32x16_bf16(ak[s], bq[s], acc, 0, 0, 0);
#pragma unroll
            for (int r = 0; r < 16; ++r) v[16 * nb + r] = pack_idx(acc[r], (unsigned)(32 * nb + 8 * (r >> 2) + 4 * hh + (r & 3)), 0x7fu);
        }
        top16_of_64(v);
        float pv[16];
#pragma unroll
        for (int i = 0; i < 16; ++i) pv[i] = shx(v[i], 32, lane);
        merge_top16(&v[0], pv);
#pragma unroll
        for (int i = 0; i < 16; ++i) ab[p][i] = v[i];
    }
    int e[16]; float gate[16];
    peer_candidates(ab[0], ab[1], e, gate);
    if (hh == 0) { GAS v4u* o = (GAS v4u*)(PIDX + t * 128 + h * 16);
#pragma unroll
        for (int c = 0; c < 4; ++c) o[c] = (v4u){(unsigned)e[4 * c], (unsigned)e[4 * c + 1], (unsigned)e[4 * c + 2], (unsigned)e[4 * c + 3]}; }
    else { GAS f32x4* o = (GAS f32x4*)(PGATE + t * 128 + h * 16);
#pragma unroll
        for (int c = 0; c < 4; ++c) o[c] = (f32x4){gate[4 * c], gate[4 * c + 1], gate[4 * c + 2], gate[4 * c + 3]}; }
}

typedef float f32x2 __attribute__((ext_vector_type(2)));
typedef unsigned v6u __attribute__((ext_vector_type(6)));
typedef float v32f __attribute__((ext_vector_type(32)));
typedef v4u __attribute__((aligned(8))) v4u_a8;
constexpr float PU_SCALE6 = 90.0f, PV_SCALE6 = 5.65f;
__device__ __forceinline__ unsigned enc_e2m3(float v) {
    const float a = fminf(fabsf(v), 7.5f);
    unsigned code;
    if (a < 1.0f) code = (unsigned)__builtin_rintf(a * 8.f);
    else { const unsigned b = __builtin_bit_cast(unsigned, a) - 0x3F800000u; code = ((b + 0x7FFFFu + ((b >> 20) & 1u)) >> 20) + 8u; }
    return code | (v < 0.f ? 32u : 0u);
}
__device__ __forceinline__ void convert_fp6_rows(const float* src, unsigned char* dst, int nrows, float scale, const float* gain, int gw, int NGW, int lane) {
    for (int r = gw; r < nrows; r += NGW) {
        const float* sp = src + (size_t)r * DM + 4 * lane; const float* gp = gain ? gain + (size_t)(r / PEER_N) * DM + 4 * lane : nullptr;
        unsigned w[6] = {0u, 0u, 0u, 0u, 0u, 0u};
#pragma unroll
        for (int j = 0; j < 8; ++j) { f32x4 a = *(const GAS f32x4*)(sp + 256 * j) * scale; if (gp) a = a * *(const GAS f32x4*)(gp + 256 * j);
#pragma unroll
            for (int e = 0; e < 4; ++e) { const unsigned code = enc_e2m3(a[e]); const int bp = 6 * (4 * j + e), wi = bp >> 5, sh = bp & 31;
                w[wi] |= code << sh; if (sh > 26) w[wi + 1] |= code >> (32 - sh); } }
        unsigned char* dp = dst + (size_t)r * 1536 + 24 * lane;
        *(GAS v4u_a8*)dp = (v4u){w[0], w[1], w[2], w[3]}; *(GAS v2u*)(dp + 16) = (v2u){w[4], w[5]};
    }
}
constexpr float PV_SCALE4 = 5.65f, PU_SCALE4 = 90.0f;
__device__ __forceinline__ unsigned enc_e2m1(float v) {
    const float a = fabsf(v);
    const unsigned code = a < 0.25f ? 0u : a < 0.75f ? 1u : a < 1.25f ? 2u : a < 1.75f ? 3u : a < 2.5f ? 4u : a < 3.5f ? 5u : a < 5.0f ? 6u : 7u;
    return code | (v < 0.f ? 8u : 0u);
}
__device__ __forceinline__ void convert_fp4_rows(const float* src, unsigned char* dst, int nrows, float scale, const float* gain, int gw, int NGW, int lane) {
    for (int r0 = 2 * gw; r0 < nrows; r0 += 2 * NGW) {
        f32x4 a[2][8];
#pragma unroll
        for (int q = 0; q < 2; ++q) { const float* sp = src + (size_t)(r0 + q) * DM + 4 * lane;
#pragma unroll
            for (int j = 0; j < 8; ++j) a[q][j] = *(const GAS f32x4*)(sp + 256 * j); }
#pragma unroll
        for (int q = 0; q < 2; ++q) { const int r = r0 + q; const float* gp = gain ? gain + (size_t)(r / PEER_N) * DM + 4 * lane : nullptr;
            unsigned w[4] = {0u, 0u, 0u, 0u};
#pragma unroll
            for (int j = 0; j < 8; ++j) { f32x4 v = a[q][j] * scale; if (gp) v = v * *(const GAS f32x4*)(gp + 256 * j);
#pragma unroll
                for (int e = 0; e < 4; ++e) { const int i = 4 * j + e; w[i >> 3] |= enc_e2m1(v[e]) << (4 * (i & 7)); } }
            *(GAS v4u*)(dst + (size_t)r * 1024 + 16 * lane) = (v4u){w[0], w[1], w[2], w[3]}; }
    }
}
#define PG4_LOAD(buf, tab, idlo, idhi, g) do { _Pragma("unroll") for (int i_ = 0; i_ < PG6_R; ++i_) { const int k_ = (g) * PG6_R + i_; \
        const int e_ = __builtin_amdgcn_readlane(k_ < 64 ? idlo : idhi, k_ & 63); buf[i_] = __builtin_amdgcn_raw_buffer_load_b128(tab, (int)voff4, e_ * 1024, 0); } } while (0)
#define PG4_DOT1(buf, i_, dst) do { f32x2 a_ = {0.f, 0.f}; _Pragma("unroll") for (int c_ = 0; c_ < 4; ++c_) { const unsigned u_ = buf[i_][c_]; \
        a_ += __builtin_amdgcn_cvt_scalef32_pk_f32_fp4(u_, 1.0f, 0) * x[4 * c_ + 0]; a_ += __builtin_amdgcn_cvt_scalef32_pk_f32_fp4(u_, 1.0f, 1) * x[4 * c_ + 1]; \
        a_ += __builtin_amdgcn_cvt_scalef32_pk_f32_fp4(u_, 1.0f, 2) * x[4 * c_ + 2]; a_ += __builtin_amdgcn_cvt_scalef32_pk_f32_fp4(u_, 1.0f, 3) * x[4 * c_ + 3]; } dst = a_.x + a_.y; __builtin_amdgcn_sched_barrier(0); } while (0)
#define PG4_DOT(buf, g) do { float p_[8]; _Pragma("unroll") for (int i_ = 0; i_ < 8; ++i_) PG4_DOT1(buf, i_, p_[i_]); \
        float q_[4]; _Pragma("unroll") for (int i_ = 0; i_ < 4; ++i_) { const float keep_ = b5 ? p_[i_ + 4] : p_[i_], send_ = b5 ? p_[i_] : p_[i_ + 4]; q_[i_] = keep_ + shx(send_, 32, lane); } \
        float r_[2]; _Pragma("unroll") for (int i_ = 0; i_ < 2; ++i_) { const float keep_ = b4 ? q_[i_ + 2] : q_[i_], send_ = b4 ? q_[i_] : q_[i_ + 2]; r_[i_] = keep_ + shx(send_, 16, lane); } \
        float s_; { const float keep_ = b3 ? r_[1] : r_[0], send_ = b3 ? r_[0] : r_[1]; s_ = keep_ + shx(send_, 8, lane); } \
        s_ += shx(s_, 4, lane); s_ += shx(s_, 2, lane); s_ += shx(s_, 1, lane); \
        if ((lane & 7) == 0) wl[(g) * 8 + (lane >> 3)] = s_; } while (0)
#define PG4_AXPY(buf, g) do { _Pragma("unroll") for (int i_ = 0; i_ < PG6_R; ++i_) { const float w_ = wl[(g) * PG6_R + i_]; const f32x2 wv_ = {w_, w_}; \
        _Pragma("unroll") for (int c_ = 0; c_ < 4; ++c_) { const unsigned u_ = buf[i_][c_]; \
            y[4 * c_ + 0] += __builtin_amdgcn_cvt_scalef32_pk_f32_fp4(u_, 1.0f, 0) * wv_; y[4 * c_ + 1] += __builtin_amdgcn_cvt_scalef32_pk_f32_fp4(u_, 1.0f, 1) * wv_; \
            y[4 * c_ + 2] += __builtin_amdgcn_cvt_scalef32_pk_f32_fp4(u_, 1.0f, 2) * wv_; y[4 * c_ + 3] += __builtin_amdgcn_cvt_scalef32_pk_f32_fp4(u_, 1.0f, 3) * wv_; } \
        __builtin_amdgcn_sched_barrier(0); } } while (0)
#ifndef PG6_R
#define PG6_R 8
#endif
#define PG6_LOAD(buf, tab, idlo, idhi, g) do { _Pragma("unroll") for (int i_ = 0; i_ < PG6_R; ++i_) { const int k_ = (g) * PG6_R + i_; \
        const int e_ = __builtin_amdgcn_readlane(k_ < 64 ? idlo : idhi, k_ & 63); const unsigned char* rp_ = (tab) + (size_t)(unsigned)e_ * 1536u; \
        const v4u a_ = *(const GAS v4u_a8*)(rp_ + voff); const v2u b_ = *(const GAS v2u*)(rp_ + voff + 16); buf[i_] = (v6u){a_.x, a_.y, a_.z, a_.w, b_.x, b_.y}; } } while (0)
#define PG6_DOT1(buf, i_, dst) do { const v32f f_ = __builtin_amdgcn_cvt_scalef32_pk32_f32_fp6(buf[i_], 1.0f); f32x2 a_ = {0.f, 0.f}; \
        _Pragma("unroll") for (int c_ = 0; c_ < 16; ++c_) a_ += (f32x2){f_[2 * c_], f_[2 * c_ + 1]} * x[c_]; dst = a_.x + a_.y; __builtin_amdgcn_sched_barrier(0); } while (0)
#if PG6_R == 8
#define PG6_DOT(buf, g) do { float p_[8]; _Pragma("unroll") for (int i_ = 0; i_ < 8; ++i_) PG6_DOT1(buf, i_, p_[i_]); \
        float q_[4]; _Pragma("unroll") for (int i_ = 0; i_ < 4; ++i_) { const float keep_ = b5 ? p_[i_ + 4] : p_[i_], send_ = b5 ? p_[i_] : p_[i_ + 4]; q_[i_] = keep_ + shx(send_, 32, lane); } \
        float r_[2]; _Pragma("unroll") for (int i_ = 0; i_ < 2; ++i_) { const float keep_ = b4 ? q_[i_ + 2] : q_[i_], send_ = b4 ? q_[i_] : q_[i_ + 2]; r_[i_] = keep_ + shx(send_, 16, lane); } \
        float s_; { const float keep_ = b3 ? r_[1] : r_[0], send_ = b3 ? r_[0] : r_[1]; s_ = keep_ + shx(send_, 8, lane); } \
        s_ += shx(s_, 4, lane); s_ += shx(s_, 2, lane); s_ += shx(s_, 1, lane); \
        if ((lane & 7) == 0) wl[(g) * 8 + (lane >> 3)] = s_; } while (0)
#else
#define PG6_DOT(buf, g) do { float p_[4]; _Pragma("unroll") for (int i_ = 0; i_ < 4; ++i_) PG6_DOT1(buf, i_, p_[i_]); \
        float r_[2]; _Pragma("unroll") for (int i_ = 0; i_ < 2; ++i_) { const float keep_ = b5 ? p_[i_ + 2] : p_[i_], send_ = b5 ? p_[i_] : p_[i_ + 2]; r_[i_] = keep_ + shx(send_, 32, lane); } \
        float s_; { const float keep_ = b4 ? r_[1] : r_[0], send_ = b4 ? r_[0] : r_[1]; s_ = keep_ + shx(send_, 16, lane); } \
        s_ += shx(s_, 8, lane); s_ += shx(s_, 4, lane); s_ += shx(s_, 2, lane); s_ += shx(s_, 1, lane); \
        if ((lane & 15) == 0) wl[(g) * 4 + (lane >> 4)] = s_; } while (0)
#endif
#define PG6_AXPY(buf, g) do { _Pragma("unroll") for (int i_ = 0; i_ < PG6_R; ++i_) { const float w_ = wl[(g) * PG6_R + i_]; const f32x2 wv_ = {w_, w_}; \
        const v32f f_ = __builtin_amdgcn_cvt_scalef32_pk32_f32_fp6(buf[i_], 1.0f); _Pragma("unroll") for (int c_ = 0; c_ < 16; ++c_) y[c_] += (f32x2){f_[2 * c_], f_[2 * c_ + 1]} * wv_; __builtin_amdgcn_sched_barrier(0); } } while (0)
__device__ __forceinline__ unsigned shxu(unsigned v, int k, int lane) { return (unsigned)__builtin_amdgcn_ds_bpermute((lane ^ k) << 2, (int)v); }
__device__ __forceinline__ void wave_sort128(unsigned& a, unsigned& b, int lane) {
#pragma unroll
    for (int k = 2; k <= 128; k <<= 1) {
#pragma unroll
        for (int j = k >> 1; j > 0; j >>= 1) {
            if (j == 64) { const unsigned lo = a < b ? a : b, hi = a < b ? b : a; a = lo; b = hi; }
            else {
                const unsigned pa = shxu(a, j, lane), pb = shxu(b, j, lane);
                const bool lower = (lane & j) == 0;
                const bool asc_a = (lane & k) == 0, asc_b = ((lane + 64) & k) == 0;
                const bool take_min_a = (lower == asc_a), take_min_b = (lower == asc_b);
                a = take_min_a ? (a < pa ? a : pa) : (a < pa ? pa : a);
                b = take_min_b ? (b < pb ? b : pb) : (b < pb ? pb : b);
            }
        }
    }
}
#ifndef PEER_U_FP4
#define PEER_U_FP4 1
#endif
#if PEER_U_FP4
typedef v4u urow_t;
#define PGU_LOAD PG4_LOAD
#define PGU_DOT PG4_DOT
constexpr float PU_SCALE = PU_SCALE4; constexpr int PU_STRIDE = 1024;
#else
typedef v6u urow_t;
#define PGU_LOAD PG6_LOAD
#define PGU_DOT PG6_DOT
constexpr float PU_SCALE = PU_SCALE6; constexpr int PU_STRIDE = 1536;
#endif
constexpr float PU_SCALEI = 135.0f, PX_SCALEI = 20.0f;
__device__ __forceinline__ void peer_v_pass(bf16* XN, const unsigned char* PV6, const int* PIDX, const float* PGATE, const int* PARTI, float* X, u64_t* rowsq_out, unsigned char* XN8, float* xsc, LAS float* wl, int gw, int NGW, int lane) {
    const unsigned voff4 = 16u * (unsigned)lane, l4 = 4u * (unsigned)lane, l8 = 8u * (unsigned)lane, l16 = 16u * (unsigned)lane;
    constexpr int NG = 128 / PG6_R;
    const __amdgpu_buffer_rsrc_t PVr = __builtin_amdgcn_make_buffer_rsrc((void*)PV6, 0, PEER_N * 1024, 0x00020000);
    for (int t_ = gw; t_ < T; t_ += NGW) {
        int t = t_; asm volatile("" : "+s"(t));
        const char* pidx_t = (const char*)(PIDX + (size_t)t * 128); const char* pgate_t = (const char*)(PGATE + (size_t)t * 128);
        const int idlo = *(const GAS int*)(pidx_t + l4), idhi = *(const GAS int*)(pidx_t + l4 + 256);
        v4u AV[PG6_R], BV[PG6_R];
        PG4_LOAD(AV, PVr, idlo, idhi, 0);
        {
            int s0 = 0, s1 = 0;
#pragma unroll
            for (int sp = 0; sp < 8; ++sp) { const char* pp = (const char*)(PARTI + ((size_t)sp * T + t) * 128); s0 += *(const GAS int*)(pp + l4); s1 += *(const GAS int*)(pp + l4 + 256); }
            const float d0 = (float)s0 * (1.f / (PX_SCALEI * PU_SCALEI)), d1 = (float)s1 * (1.f / (PX_SCALEI * PU_SCALEI));
            const float g0 = *(const GAS float*)(pgate_t + l4), g1 = *(const GAS float*)(pgate_t + l4 + 256);
            const float w0 = g0 * 0.5f * d0 * (1.f + erff(d0 * 0.70710678118654752f)) * (1.f / PV_SCALE4), w1 = g1 * 0.5f * d1 * (1.f + erff(d1 * 0.70710678118654752f)) * (1.f / PV_SCALE4);
            wl[lane] = w0; wl[64 + lane] = w1;
            LDS_WAIT(); asm volatile("" ::: "memory");
        }
        f32x2 y[16];
#pragma unroll
        for (int i = 0; i < 16; ++i) y[i] = (f32x2){0.f, 0.f};
#pragma unroll 1
        for (int g = 0; g < NG; g += 2) {
            PG4_LOAD(BV, PVr, idlo, idhi, g + 1);
            PG4_AXPY(AV, g);
            if (g + 2 < NG) PG4_LOAD(AV, PVr, idlo, idhi, g + 2);
            PG4_AXPY(BV, g + 1);
        }
        {   char* xo = (char*)(X + (size_t)t * DM);
            char* xbo = (char*)(XN + (size_t)t * DM); float ss = 0.f;
#pragma unroll
            for (int j = 0; j < 8; ++j) { const v2u a = *(const GAS v2u*)(xbo + l8 + 512 * j); f32x4 v = (f32x4){bflo(a.x), bfhi(a.x), bflo(a.y), bfhi(a.y)}; v += (f32x4){y[2 * j].x, y[2 * j].y, y[2 * j + 1].x, y[2 * j + 1].y};
                if (X) *(GAS f32x4*)(xo + l16 + 1024 * j) = v;
                y[2 * j] = (f32x2){v[0], v[1]}; y[2 * j + 1] = (f32x2){v[2], v[3]};
                ss += (v[0] * v[0] + v[1] * v[1]) + (v[2] * v[2] + v[3] * v[3]); *(GAS v2u*)(xbo + l8 + 512 * j) = (v2u){pk2(v[0], v[1]), pk2(v[2], v[3])}; }
            if (rowsq_out) { ss = wave_sum(ss, lane); if (lane == 0) rowsq_out[t] = rowsq_fx(ss); }
            if (XN8) {
                float am = 0.f;
#pragma unroll
                for (int j = 0; j < 16; ++j) am = fmaxf(am, fmaxf(fabsf(y[j].x), fabsf(y[j].y)));
                am = fmaxf(wave_max(am, lane), 1e-30f);
                const float inv = 127.f / am; char* qo = (char*)(XN8 + (size_t)t * DM);
#pragma unroll
                for (int j = 0; j < 8; ++j) *(GAS unsigned*)(qo + l4 + 256 * j) = q8x4((f32x4){y[2 * j].x, y[2 * j].y, y[2 * j + 1].x, y[2 * j + 1].y}, inv);
                if (lane == 0) xsc[t] = am * (1.f / 127.f) / sqrtf(ss * (1.f / DM) + 1e-6f); } }
        LDS_WAIT(); asm volatile("" ::: "memory");
    }
}


__device__ __forceinline__ unsigned enc_i4(float v) { int q = (int)__builtin_rintf(v); q = q < -7 ? -7 : (q > 7 ? 7 : q); return (unsigned)q & 15u; }
__device__ __forceinline__ void convert_int4_plain(const float* src, unsigned char* dst, int nrows, float scale, const float* gain, int gw, int NGW, int lane) {
    for (int r0 = 2 * gw; r0 < nrows; r0 += 2 * NGW) {
        f32x4 a[2][8];
#pragma unroll
        for (int q = 0; q < 2; ++q) { const float* sp = src + (size_t)(r0 + q) * DM + 4 * lane;
#pragma unroll
            for (int j = 0; j < 8; ++j) a[q][j] = *(const GAS f32x4*)(sp + 256 * j); }
#pragma unroll
        for (int q = 0; q < 2; ++q) { const int r = r0 + q; const float* gp = gain ? gain + (size_t)(r / PEER_N) * DM + 4 * lane : nullptr;
#pragma unroll
            for (int j = 0; j < 8; ++j) { f32x4 v = a[q][j] * scale; if (gp) v = v * *(const GAS f32x4*)(gp + 256 * j);
                const unsigned w = enc_i4(v[0]) | (enc_i4(v[1]) << 4) | (enc_i4(v[2]) << 8) | (enc_i4(v[3]) << 12);
                *(GAS unsigned short*)(dst + (size_t)r * 1024 + 128 * j + 2 * lane) = (unsigned short)w; } }
    }
}
__device__ __forceinline__ void peer_xquant_unit(const bf16* XN, const u64_t* rowsq, unsigned* XQH, unsigned* XQL, int tb, int sl, int tid) {
    for (int it = tid; it < 256 * 32; it += NTHREADS) {
        const int t = tb * 256 + (it >> 5), c8 = it & 31;
        const float xs = PX_SCALEI * rowsq_rs(rowsq, t);
        const v4u w = *(const GAS v4u*)(XN + (size_t)t * DM + 256 * sl + 8 * c8);
        const float f[8] = {bflo(w.x), bfhi(w.x), bflo(w.y), bfhi(w.y), bflo(w.z), bfhi(w.z), bflo(w.w), bfhi(w.w)};
        unsigned hi = 0u, lo = 0u;
#pragma unroll
        for (int j = 0; j < 8; ++j) { int q = (int)__builtin_rintf(f[j] * xs); q = q < -119 ? -119 : (q > 119 ? 119 : q);
            const int xl = ((q + 8) & 15) - 8, xh = (q - xl) >> 4;
            hi |= ((unsigned)xh & 15u) << (4 * j); lo |= ((unsigned)xl & 15u) << (4 * j); }
        XQH[(size_t)t * 256 + 32 * sl + c8] = hi; XQL[(size_t)t * 256 + 32 * sl + c8] = lo;
    }
}
#define PI_LOADROWS(buf, tab, ids, i0) do { _Pragma("unroll") for (int i_ = 0; i_ < 8; ++i_) buf[i_] = __builtin_amdgcn_raw_buffer_load_b128(tab, ids[(i0) + i_] * 1024 + (int)soff, 0, 0); } while (0)
#define PI_LOADIDS(ids, t) do { const char* ip_ = (const char*)PIDX + ((size_t)(t) * 128 + 16 * g) * 4; _Pragma("unroll") for (int c_ = 0; c_ < 4; ++c_) { const v4u q_ = *(const GAS v4u*)(ip_ + 16 * c_); \
        ids[4 * c_] = (int)q_.x; ids[4 * c_ + 1] = (int)q_.y; ids[4 * c_ + 2] = (int)q_.z; ids[4 * c_ + 3] = (int)q_.w; } } while (0)
#define PI_UGROUP(buf, i0) do { _Pragma("unroll") for (int i_ = 0; i_ < 8; ++i_) { int ah_ = 0, al_ = 0; \
        _Pragma("unroll") for (int c_ = 0; c_ < 4; ++c_) { ah_ = __builtin_amdgcn_sdot8((int)buf[i_][c_], (int)xh[c_], ah_, false); al_ = __builtin_amdgcn_sdot8((int)buf[i_][c_], (int)xl[c_], al_, false); } \
        int p_ = 16 * ah_ + al_; p_ += __builtin_amdgcn_ds_bpermute((lane ^ 1) << 2, p_); p_ += __builtin_amdgcn_ds_bpermute((lane ^ 2) << 2, p_); p_ += __builtin_amdgcn_ds_bpermute((lane ^ 4) << 2, p_); \
        if (m == (((i0) + i_) >> 1)) { if (((i0) + i_) & 1) keep1 = p_; else keep0 = p_; } } } while (0)
#define PI_LOADROWS16(buf, tab, ids) do { _Pragma("unroll") for (int i_ = 0; i_ < 16; ++i_) buf[i_] = __builtin_amdgcn_raw_buffer_load_b128(tab, ids[i_] * 1024 + (int)soff, 0, 0); } while (0)
#define PI_LOADX(xh_, xl_, t) do { xh_ = *(const GAS v4u*)((const char*)XQH + (size_t)(t) * 1024 + soff); xl_ = *(const GAS v4u*)((const char*)XQL + (size_t)(t) * 1024 + soff); } while (0)
#define PI_COMPUTE16(buf, xh_, xl_, t) do { int keep0 = 0, keep1 = 0; \
        _Pragma("unroll") for (int i_ = 0; i_ < 16; ++i_) { int ah_ = 0, al_ = 0; \
            _Pragma("unroll") for (int c_ = 0; c_ < 4; ++c_) { ah_ = __builtin_amdgcn_sdot8((int)buf[i_][c_], (int)xh_[c_], ah_, false); al_ = __builtin_amdgcn_sdot8((int)buf[i_][c_], (int)xl_[c_], al_, false); } \
            int p_ = 16 * ah_ + al_; p_ += __builtin_amdgcn_update_dpp(0, p_, 0xB1, 0xf, 0xf, true); p_ += __builtin_amdgcn_update_dpp(0, p_, 0x4E, 0xf, 0xf, true); p_ += __builtin_amdgcn_update_dpp(0, p_, 0x141, 0xf, 0xf, true);   \
            if (m == (i_ >> 1)) { if (i_ & 1) keep1 = p_; else keep0 = p_; } } \
        if ((t) < T) *(GAS v2u*)(PARTI + ((size_t)s * T + (t)) * 128 + 2 * lane) = (v2u){(unsigned)keep0, (unsigned)keep1}; } while (0)
__device__ __forceinline__ void peer_u_phase_i4(const unsigned* XQH, const unsigned* XQL, const unsigned char* PU, const int* PIDX, int* PARTI, int bid, int G, int wave, int lane) {
    const int s = bid & 7, nr = (G - s + 7) >> 3, q = (bid >> 3) * NWAVES + wave, stride = nr * NWAVES, g = lane >> 3, m = lane & 7;
    const unsigned soff = 128u * (unsigned)s + 16u * (unsigned)m;
    if (q >= T) return;
    const __amdgpu_buffer_rsrc_t PUr = __builtin_amdgcn_make_buffer_rsrc((void*)PU, 0, PEER_N * 1024, 0x00020000);
#define PI_CL(t) ((t) < T ? (t) : T - 1)
    int I1[16], I2[16]; v4u xh0, xl0, xh1, xl1, xh2, xl2, RA[16], RB[16];
    PI_LOADIDS(I1, q); PI_LOADX(xh0, xl0, q);
    PI_LOADROWS16(RA, PUr, I1);
    PI_LOADIDS(I1, PI_CL(q + stride)); PI_LOADX(xh1, xl1, PI_CL(q + stride));
    for (int t = q; t < T; t += 2 * stride) {
        PI_LOADROWS16(RB, PUr, I1);
        PI_LOADIDS(I2, PI_CL(t + 2 * stride)); PI_LOADX(xh2, xl2, PI_CL(t + 2 * stride));
        PI_COMPUTE16(RA, xh0, xl0, t);
        PI_LOADROWS16(RA, PUr, I2);
        PI_LOADIDS(I1, PI_CL(t + 3 * stride)); PI_LOADX(xh0, xl0, PI_CL(t + 3 * stride));
        PI_COMPUTE16(RB, xh1, xl1, t + stride);
        xh1 = xh0; xl1 = xl0; xh0 = xh2; xl0 = xl2;
    }
#undef PI_CL
}


constexpr float PV_SCALE4S = 5.65f;
__device__ __forceinline__ unsigned enc_e2m1s(float v) {
    const float a = fabsf(v);
    const unsigned code = a < 0.25f ? 0u : a < 0.75f ? 1u : a < 1.25f ? 2u : a < 1.75f ? 3u : a < 2.5f ? 4u : a < 3.5f ? 5u : a < 5.0f ? 6u : 7u;
    return code | (v < 0.f ? 8u : 0u);
}
__device__ __forceinline__ void convert_fp4_plain(const float* src, unsigned char* dst, int nrows, float scale, const float* gain, int gw, int NGW, int lane) {
    for (int r0 = 2 * gw; r0 < nrows; r0 += 2 * NGW) {
        f32x4 a[2][8];
#pragma unroll
        for (int q = 0; q < 2; ++q) { const float* sp = src + (size_t)(r0 + q) * DM + 4 * lane;
#pragma unroll
            for (int j = 0; j < 8; ++j) a[q][j] = *(const GAS f32x4*)(sp + 256 * j); }
#pragma unroll
        for (int q = 0; q < 2; ++q) { const int r = r0 + q; const float* gp = gain ? gain + (size_t)(r / PEER_N) * DM + 4 * lane : nullptr;
#pragma unroll
            for (int j = 0; j < 8; ++j) { f32x4 v = a[q][j] * scale; if (gp) v = v * *(const GAS f32x4*)(gp + 256 * j);
                const unsigned w = enc_e2m1s(v[0]) | (enc_e2m1s(v[1]) << 4) | (enc_e2m1s(v[2]) << 8) | (enc_e2m1s(v[3]) << 12);
                *(GAS unsigned short*)(dst + (size_t)r * 1024 + 128 * j + 2 * lane) = (unsigned short)w; } }
    }
}
#define PVS_LOADMETA(ids, pp, gg, t) do { PI_LOADIDS(ids, t); _Pragma("unroll") for (int sp_ = 0; sp_ < 8; ++sp_) pp[sp_] = *(const GAS v2u*)(PARTI + ((size_t)sp_ * T + (t)) * 128 + 2 * lane); \
        gg = *(const GAS f32x2*)(PGATE + (size_t)(t) * 128 + 2 * lane); } while (0)
#define PVS_COMPUTE16(buf, pp, gg, t) do { float w0, w1; { int s0_ = 0, s1_ = 0; _Pragma("unroll") for (int sp_ = 0; sp_ < 8; ++sp_) { s0_ += (int)pp[sp_].x; s1_ += (int)pp[sp_].y; } \
            const float d0_ = (float)s0_ * (1.f / (PX_SCALEI * PU_SCALEI)), d1_ = (float)s1_ * (1.f / (PX_SCALEI * PU_SCALEI)); \
            w0 = gg.x * 0.5f * d0_ * (1.f + erff(d0_ * 0.70710678118654752f)) * (1.f / PV_SCALE4S); w1 = gg.y * 0.5f * d1_ * (1.f + erff(d1_ * 0.70710678118654752f)) * (1.f / PV_SCALE4S); } \
        f32x2 y[16]; _Pragma("unroll") for (int i_ = 0; i_ < 16; ++i_) y[i_] = (f32x2){0.f, 0.f}; \
        _Pragma("unroll") for (int i_ = 0; i_ < 16; ++i_) { \
            const float w_ = __builtin_bit_cast(float, __builtin_amdgcn_ds_bpermute(((lane & 56) | (i_ >> 1)) << 2, __builtin_bit_cast(int, (i_ & 1) ? w1 : w0))); const f32x2 wv_ = {w_, w_}; \
            _Pragma("unroll") for (int c_ = 0; c_ < 4; ++c_) { const unsigned u_ = buf[i_][c_]; \
                y[4 * c_ + 0] += __builtin_amdgcn_cvt_scalef32_pk_f32_fp4(u_, 1.0f, 0) * wv_; y[4 * c_ + 1] += __builtin_amdgcn_cvt_scalef32_pk_f32_fp4(u_, 1.0f, 1) * wv_; \
                y[4 * c_ + 2] += __builtin_amdgcn_cvt_scalef32_pk_f32_fp4(u_, 1.0f, 2) * wv_; y[4 * c_ + 3] += __builtin_amdgcn_cvt_scalef32_pk_f32_fp4(u_, 1.0f, 3) * wv_; } } \
        {   LAS float* wp_ = yl + g * 288 + m * 36; \
            _Pragma("unroll") for (int c_ = 0; c_ < 8; ++c_) *(LAS f32x4*)(wp_ + 4 * c_) = (f32x4){y[2 * c_].x, y[2 * c_].y, y[2 * c_ + 1].x, y[2 * c_ + 1].y}; \
            LDS_WAIT(); asm volatile("" ::: "memory"); \
            f32x4 acc_ = {0.f, 0.f, 0.f, 0.f}; const LAS float* rp_ = yl + (lane >> 3) * 36 + 4 * (lane & 7); \
            _Pragma("unroll") for (int gg_ = 0; gg_ < 8; ++gg_) acc_ += *(const LAS f32x4*)(rp_ + gg_ * 288); \
            LDS_WAIT(); asm volatile("" ::: "memory"); \
            if ((t) < T) { bf16* xp_ = XN + (size_t)(t) * DM + 256 * s + 4 * lane; const v2u a_ = *(const GAS v2u*)xp_; \
                const f32x4 v_ = (f32x4){bflo(a_.x), bfhi(a_.x), bflo(a_.y), bfhi(a_.y)} + acc_; \
                *(GAS v2u*)xp_ = (v2u){pk2(v_[0], v_[1]), pk2(v_[2], v_[3])}; \
                if (Xout) *(GAS f32x4*)(Xout + (size_t)(t) * DM + 256 * s + 4 * lane) = v_; \
                if (rowsq_out) { const float ss_ = wave_sum((v_[0] * v_[0] + v_[1] * v_[1]) + (v_[2] * v_[2] + v_[3] * v_[3]), lane); if (lane == 0) atomicAdd(rowsq_out + (t), rowsq_fx(ss_)); } } } } while (0)
__device__ __forceinline__ void peer_v_phase_s(bf16* XN, const unsigned char* PV, const int* PIDX, const float* PGATE, const int* PARTI, float* Xout, u64_t* rowsq_out, LAS float* yl, int bid, int G, int wave, int lane) {
    const int s = bid & 7, nr = (G - s + 7) >> 3, q = (bid >> 3) * NWAVES + wave, stride = nr * NWAVES, g = lane >> 3, m = lane & 7;
    const unsigned soff = 128u * (unsigned)s + 16u * (unsigned)m;
    if (q >= T) return;
    const __amdgpu_buffer_rsrc_t PVr = __builtin_amdgcn_make_buffer_rsrc((void*)PV, 0, PEER_N * 1024, 0x00020000);
#define PVS_CL(t) ((t) < T ? (t) : T - 1)
    int I0[16], I1[16]; v2u P0[8], P1[8]; f32x2 G0, G1; v4u RA[16], RB[16];
#define PVS_LOADPG(pp, gg, t) do { _Pragma("unroll") for (int sp_ = 0; sp_ < 8; ++sp_) pp[sp_] = *(const GAS v2u*)(PARTI + ((size_t)sp_ * T + (t)) * 128 + 2 * lane); gg = *(const GAS f32x2*)(PGATE + (size_t)(t) * 128 + 2 * lane); } while (0)
    PI_LOADIDS(I0, q); PVS_LOADPG(P0, G0, q);
    PI_LOADROWS16(RA, PVr, I0);
    PI_LOADIDS(I1, PVS_CL(q + stride)); PVS_LOADPG(P1, G1, PVS_CL(q + stride));
    for (int t = q; t < T; t += 2 * stride) {
        PI_LOADROWS16(RB, PVr, I1);
        PI_LOADIDS(I0, PVS_CL(t + 2 * stride));
        PVS_COMPUTE16(RA, P0, G0, t);
        PVS_LOADPG(P0, G0, PVS_CL(t + 2 * stride));
        PI_LOADROWS16(RA, PVr, I0);
        PI_LOADIDS(I1, PVS_CL(t + 3 * stride));
        PVS_COMPUTE16(RB, P1, G1, t + stride);
        PVS_LOADPG(P1, G1, PVS_CL(t + 3 * stride));
    }
#undef PVS_LOADPG
#undef PVS_CL
}

typedef short s16x4 __attribute__((ext_vector_type(4)));
typedef __attribute__((address_space(3))) const char* lds_cptr;
__device__ __forceinline__ s16x4 vtr(lds_cptr p) { return __builtin_bit_cast(s16x4, __builtin_amdgcn_ds_read_tr16_b64_v4i16((__attribute__((address_space(3))) s16x4*)p)); }
__device__ __forceinline__ unsigned cvtpk(float lo, float hi) { unsigned r; asm("v_cvt_pk_bf16_f32 %0, %1, %2" : "=v"(r) : "v"(lo), "v"(hi)); return r; }
constexpr int AT_K0 = 0, AT_V0 = 16384, AT_TAB = 32768;
constexpr float LOG2E = 1.4426950408889634f;
template <int TYPE>
__device__ __forceinline__ void attn_unit(LAS unsigned char* lds, const bf16* QKV, bf16* ATT, u64_t* mixsq, int b, int head, int qb, const float* tabsrc, float Cl2, float sinkl2, int tid) {
    const int lane = tid & 63, w = __builtin_amdgcn_readfirstlane(tid >> 6), hh = lane >> 5, l31 = lane & 31;
    int qcol, kcol, vcol, ocol;
    if (TYPE == 0) { qcol = QA + head * 64; kcol = KA + (head / 3) * 64; vcol = VA + (head / 3) * 64; ocol = OA + head * 64; }
    else if (TYPE == 1) { qcol = QB + head * 64; kcol = KB + head * 64; vcol = VB + head * 64; ocol = OB + head * 64; }
    else { qcol = QC + head * 64; kcol = KC + (head / 3) * 64; vcol = VC + (head / 3) * 64; ocol = OC + head * 64; }
    const int q0 = 256 * qb + 32 * w, qpos = q0 + l31;
    int t_begin, t_end;
    if (TYPE == 0) { t_begin = 4 * qb - 2; if (t_begin < 0) t_begin = 0; t_end = 4 * qb + 6; if (t_end > 32) t_end = 32; }
    else if (TYPE == 1) { int a = 4 * qb - 4; a = a < 0 ? 0 : (a > 24 ? 24 : a); int e = 4 * qb - 1; e = e < 0 ? 0 : (e > 24 ? 24 : e); t_begin = a; t_end = e + 8; }
    else { t_begin = 0; t_end = 32; }
    LAS float* tab = (LAS float*)(lds + AT_TAB);
    if (TYPE == 0) { for (int i = tid; i < 1024; i += NTHREADS) { const int rel = i - 448; tab[i] = (rel >= -128 && rel <= 128) ? tabsrc[head * 257 + rel + 128] * LOG2E - Cl2 : -1e30f; } }
    if (TYPE == 1) { for (int i = tid; i < 15 * 31; i += NTHREADS) tab[i] = tabsrc[head * 465 + i] * LOG2E - Cl2; }
    bf16x8 qf[4];
    {   const bf16* qp = QKV + ((size_t)b * SEQ + qpos) * DIN + qcol + 8 * hh;
#pragma unroll
        for (int s = 0; s < 4; ++s) qf[s] = *(const GAS bf16x8*)(qp + 16 * s); }
    const int srow = tid >> 3, sch = tid & 7;
    const bf16* kg = QKV + ((size_t)b * SEQ + srow) * DIN + kcol + sch * 8;
    const bf16* vg = QKV + ((size_t)b * SEQ + srow) * DIN + vcol + sch * 8;
    const int kst = srow * 128 + ((sch ^ ((srow >> 1) & 7)) * 16);
    const int vst = srow * 128 + (((sch >> 2) ^ ((srow >> 1) & 1)) * 64) + (sch & 3) * 16;
    int kread[4], vread[2];
#pragma unroll
    for (int s = 0; s < 4; ++s) kread[s] = l31 * 128 + (((2 * s + hh) ^ ((lane >> 1) & 7)) * 16);
#pragma unroll
    for (int db = 0; db < 2; ++db) vread[db] = (4 * hh + ((lane >> 2) & 3)) * 128 + ((db ^ ((lane >> 3) & 1)) * 64) + 32 * ((lane >> 4) & 1) + 8 * (lane & 3);
    f32x16 O0, O1;
#pragma unroll
    for (int r = 0; r < 16; ++r) { O0[r] = 0.f; O1[r] = 0.f; }
    float lsum = 0.f;
    const int rw = 4 * qb + (w >> 1), cq = 32 * (w & 1) + l31;
    int r0w = rw - 4; r0w = r0w < 0 ? 0 : (r0w > 24 ? 24 : r0w);
    int c0 = cq - 8; c0 = c0 < 0 ? 0 : (c0 > 48 ? 48 : c0);
    {   const v4u kr = *(const GAS v4u*)(kg + (size_t)t_begin * 64 * DIN), vr = *(const GAS v4u*)(vg + (size_t)t_begin * 64 * DIN);
        *(LAS v4u*)(lds + AT_K0 + kst) = kr; *(LAS v4u*)(lds + AT_V0 + vst) = vr; }
    __syncthreads();
    for (int t = t_begin; t < t_end; ++t) {
        const int cur = (t - t_begin) & 1;
        v4u kr, vr;
        if (t + 1 < t_end) { kr = *(const GAS v4u*)(kg + (size_t)(t + 1) * 64 * DIN); vr = *(const GAS v4u*)(vg + (size_t)(t + 1) * 64 * DIN); }
        bool need = true;
        if (TYPE == 0) need = (64 * t <= q0 + 31 + 128) && (64 * t + 63 >= q0 - 128);
        if (TYPE == 1) need = (t >= r0w) && (t < r0w + 8);
        if (need) {
            const lds_cptr kb_ = (lds_cptr)(lds + AT_K0 + cur * 8192), vb_ = (lds_cptr)(lds + AT_V0 + cur * 8192);
            bf16x8 kf[8];
#pragma unroll
            for (int s = 0; s < 4; ++s) { kf[2 * s] = *(const LAS bf16x8*)(kb_ + kread[s]); kf[2 * s + 1] = *(const LAS bf16x8*)(kb_ + kread[s] + 4096); }
            f32x16 S0, S1;
            if (TYPE == 2) {
#pragma unroll
                for (int r = 0; r < 16; ++r) { S0[r] = -Cl2; S1[r] = -Cl2; }
            } else if (TYPE == 0) {
                const LAS float* tb = tab + (64 * t - qpos + 448 + 4 * hh);
#pragma unroll
                for (int r = 0; r < 16; ++r) { S0[r] = tb[8 * (r >> 2) + (r & 3)]; S1[r] = tb[32 + 8 * (r >> 2) + (r & 3)]; }
            } else {
                const LAS float* tb = tab + ((t - rw + 7) * 31 - cq + 15 + 4 * hh);
                const int kc0 = 4 * hh - c0;
#pragma unroll
                for (int r = 0; r < 16; ++r) { const int ka = 8 * (r >> 2) + (r & 3), kb2 = 32 + ka;
                    S0[r] = ((unsigned)(ka + kc0) < 16u) ? tb[ka] : -1e30f; S1[r] = ((unsigned)(kb2 + kc0) < 16u) ? tb[kb2] : -1e30f; }
            }
            __builtin_amdgcn_sched_barrier(0);
#define AT_SB __builtin_amdgcn_sched_barrier(0)
#define AT_SOFT(SX, base, dst) do { _Pragma("unroll") for (int r = (base); r < (base) + 8; ++r) SX[r] = __builtin_amdgcn_exp2f(SX[r]); \
            lsum += ((SX[(base)] + SX[(base) + 1]) + (SX[(base) + 2] + SX[(base) + 3])) + ((SX[(base) + 4] + SX[(base) + 5]) + (SX[(base) + 6] + SX[(base) + 7])); \
            v4u a_; _Pragma("unroll") for (int j = 0; j < 4; ++j) a_[j] = cvtpk(SX[(base) + 2 * j], SX[(base) + 2 * j + 1]); dst = __builtin_bit_cast(bf16x8, a_); } while (0)
#pragma unroll
            for (int s = 0; s < 4; ++s) S0 = __builtin_amdgcn_mfma_f32_32x32x16_bf16(kf[2 * s], qf[s], S0, 0, 0, 0);
            s16x4 vf[4][2][2];
#pragma unroll
            for (int ks = 0; ks < 2; ++ks)
#pragma unroll
                for (int db = 0; db < 2; ++db) { vf[ks][db][0] = vtr(vb_ + vread[db] + (16 * ks) * 128); vf[ks][db][1] = vtr(vb_ + vread[db] + (16 * ks + 8) * 128); }
            S1 = __builtin_amdgcn_mfma_f32_32x32x16_bf16(kf[1], qf[0], S1, 0, 0, 0); S1 = __builtin_amdgcn_mfma_f32_32x32x16_bf16(kf[3], qf[1], S1, 0, 0, 0);
            AT_SB;
            bf16x8 pb[4];
            AT_SOFT(S0, 0, pb[0]);
            AT_SB;
            S1 = __builtin_amdgcn_mfma_f32_32x32x16_bf16(kf[5], qf[2], S1, 0, 0, 0);
            AT_SB;
            AT_SOFT(S0, 8, pb[1]);
            AT_SB;
            S1 = __builtin_amdgcn_mfma_f32_32x32x16_bf16(kf[7], qf[3], S1, 0, 0, 0);
            asm volatile("s_waitcnt lgkmcnt(7)" ::: "memory");
#pragma unroll
            for (int ks = 2; ks < 4; ++ks)
#pragma unroll
                for (int db = 0; db < 2; ++db) { vf[ks][db][0] = vtr(vb_ + vread[db] + (16 * ks) * 128); vf[ks][db][1] = vtr(vb_ + vread[db] + (16 * ks + 8) * 128); }
            AT_SB;
#define AT_PV(ks) do { const bf16x8 va = __builtin_shufflevector(vf[ks][0][0], vf[ks][0][1], 0, 1, 2, 3, 4, 5, 6, 7), vb2 = __builtin_shufflevector(vf[ks][1][0], vf[ks][1][1], 0, 1, 2, 3, 4, 5, 6, 7); \
            O0 = __builtin_amdgcn_mfma_f32_32x32x16_bf16(va, pb[ks], O0, 0, 0, 0); O1 = __builtin_amdgcn_mfma_f32_32x32x16_bf16(vb2, pb[ks], O1, 0, 0, 0); } while (0)
            AT_PV(0);
            AT_SB;
            AT_SOFT(S1, 0, pb[2]);
            AT_SB;
            AT_PV(1);
            AT_SB;
            AT_SOFT(S1, 8, pb[3]);
            AT_SB;
            AT_PV(2); AT_PV(3);
#undef AT_PV
#undef AT_SOFT
#undef AT_SB
        }
        __builtin_amdgcn_sched_barrier(0);
        if (t + 1 < t_end) { *(LAS v4u*)(lds + AT_K0 + (cur ^ 1) * 8192 + kst) = kr; *(LAS v4u*)(lds + AT_V0 + (cur ^ 1) * 8192 + vst) = vr; }
        __syncthreads();
    }
    lsum += shx(lsum, 32, lane);
    if (TYPE == 0) lsum += __builtin_amdgcn_exp2f(sinkl2 - Cl2);
    const float inv = 1.f / lsum;
    {   float ss = 0.f;
#pragma unroll
        for (int r = 0; r < 16; ++r) { const float a = O0[r] * inv, c = O1[r] * inv; ss += a * a + c * c; }
        ss += shx(ss, 32, lane);
        if (hh == 0) (void)__hip_atomic_fetch_add((GAS u64_t*)(mixsq + (size_t)b * SEQ + qpos), rowsq_fx(ss), __ATOMIC_RELAXED, __HIP_MEMORY_SCOPE_AGENT); }
    bf16* op = ATT + ((size_t)b * SEQ + qpos) * DM + ocol + 4 * hh;
#pragma unroll
    for (int g4 = 0; g4 < 4; ++g4) {
        v2u o0, o1; o0.x = cvtpk(O0[4 * g4] * inv, O0[4 * g4 + 1] * inv); o0.y = cvtpk(O0[4 * g4 + 2] * inv, O0[4 * g4 + 3] * inv);
        o1.x = cvtpk(O1[4 * g4] * inv, O1[4 * g4 + 1] * inv); o1.y = cvtpk(O1[4 * g4 + 2] * inv, O1[4 * g4 + 3] * inv);
        *(GAS v2u*)(op + 8 * g4) = o0; *(GAS v2u*)(op + 32 + 8 * g4) = o1;
    }
}


constexpr int MA_K0 = 0, MA_V0 = 32768;
__device__ __forceinline__ void mem_unit(LAS unsigned char* lds, const bf16* QM, const bf16* KVM, bf16* OM, const float* gq, int tb, int head, float Cl2, int tid) {
    const int lane = tid & 63, w = __builtin_amdgcn_readfirstlane(tid >> 6), hh = lane >> 5, l31 = lane & 31;
    const size_t trow = (size_t)tb * 256 + 32 * w + l31; const int b = tb >> 3;
    bf16x8 qf[8];
    {   const bf16* qp = QM + trow * MEMW + head * 128 + 8 * hh;
#pragma unroll
        for (int s = 0; s < 8; ++s) qf[s] = *(const GAS bf16x8*)(qp + 16 * s);
        float ss = 0.f;
#pragma unroll
        for (int s = 0; s < 8; ++s)
#pragma unroll
            for (int j = 0; j < 8; ++j) { const float f = __builtin_bit_cast(float, (unsigned)(unsigned short)qf[s][j] << 16); ss += f * f; }
        ss += shx(ss, 32, lane);
        const float r = 0.12751743074602468f / sqrtf(ss * (1.f / 128.f) + EPS);
#pragma unroll
        for (int s = 0; s < 8; ++s) { const f32x4 g0 = *(const GAS f32x4*)(gq + 16 * s + 8 * hh), g1 = *(const GAS f32x4*)(gq + 16 * s + 8 * hh + 4);
            v4u o;
#pragma unroll
            for (int j = 0; j < 4; ++j) { const float f0 = __builtin_bit_cast(float, (unsigned)(unsigned short)qf[s][2 * j] << 16), f1 = __builtin_bit_cast(float, (unsigned)(unsigned short)qf[s][2 * j + 1] << 16);
                const float ga = (2 * j < 4) ? g0[2 * j] : g1[2 * j - 4], gb2 = (2 * j + 1 < 4) ? g0[2 * j + 1] : g1[2 * j + 1 - 4];
                o[j] = cvtpk(f0 * r * ga, f1 * r * gb2); }
            qf[s] = __builtin_bit_cast(bf16x8, o); }
    }
    const int srow = tid >> 3, sch = tid & 7;
    const bf16* kg = KVM + ((size_t)b * NMEM + srow) * 1024 + head * 128 + sch * 8;
    const bf16* vg = kg + 512;
    const int kst0 = srow * 256 + ((sch ^ (srow & 15)) * 16), kst1 = srow * 256 + (((sch + 8) ^ (srow & 15)) * 16);
    const int vst0 = srow * 256 + ((((sch) >> 2) ^ (srow & 3)) * 64) + (sch & 3) * 16, vst1 = srow * 256 + ((((sch + 8) >> 2) ^ (srow & 3)) * 64) + (sch & 3) * 16;
    int kread[8], vread[4];
#pragma unroll
    for (int s = 0; s < 8; ++s) kread[s] = l31 * 256 + (((2 * s + hh) ^ (l31 & 15)) * 16);
#pragma unroll
    for (int db = 0; db < 4; ++db) vread[db] = (4 * hh + ((lane >> 2) & 3)) * 256 + ((db ^ ((lane >> 2) & 3)) * 64) + 32 * ((lane >> 4) & 1) + 8 * (lane & 3);
    f32x16 O[4];
#pragma unroll
    for (int db = 0; db < 4; ++db)
#pragma unroll
        for (int r = 0; r < 16; ++r) O[db][r] = 0.f;
    float lsum = 0.f;
    {   const v4u k0 = *(const GAS v4u*)kg, k1 = *(const GAS v4u*)(kg + 64), v0 = *(const GAS v4u*)vg, v1 = *(const GAS v4u*)(vg + 64);
        *(LAS v4u*)(lds + MA_K0 + kst0) = k0; *(LAS v4u*)(lds + MA_K0 + kst1) = k1; *(LAS v4u*)(lds + MA_V0 + vst0) = v0; *(LAS v4u*)(lds + MA_V0 + vst1) = v1; }
    __syncthreads();
#pragma unroll 1
    for (int t = 0; t < 4; ++t) {
        const int cur = t & 1;
        v4u k0, k1, v0, v1;
        if (t + 1 < 4) { const bf16* kn = kg + (size_t)(t + 1) * 64 * 1024; k0 = *(const GAS v4u*)kn; k1 = *(const GAS v4u*)(kn + 64); v0 = *(const GAS v4u*)(kn + 512); v1 = *(const GAS v4u*)(kn + 576); }
        const lds_cptr kb_ = (lds_cptr)(lds + MA_K0 + cur * 16384), vb_ = (lds_cptr)(lds + MA_V0 + cur * 16384);
        f32x16 S0, S1;
#pragma unroll
        for (int r = 0; r < 16; ++r) { S0[r] = -Cl2; S1[r] = -Cl2; }
#pragma unroll
        for (int s = 0; s < 8; ++s) { const bf16x8 a0 = *(const LAS bf16x8*)(kb_ + kread[s]), a1 = *(const LAS bf16x8*)(kb_ + kread[s] + 8192);
            S0 = __builtin_amdgcn_mfma_f32_32x32x16_bf16(a0, qf[s], S0, 0, 0, 0); S1 = __builtin_amdgcn_mfma_f32_32x32x16_bf16(a1, qf[s], S1, 0, 0, 0); }
#pragma unroll
        for (int r = 0; r < 16; ++r) { S0[r] = __builtin_amdgcn_exp2f(S0[r]); S1[r] = __builtin_amdgcn_exp2f(S1[r]); lsum += S0[r] + S1[r]; }
        bf16x8 pb[4];
#pragma unroll
        for (int hf = 0; hf < 2; ++hf) {
            v4u a, c;
#pragma unroll
            for (int j = 0; j < 4; ++j) { a[j] = cvtpk(S0[8 * hf + 2 * j], S0[8 * hf + 2 * j + 1]); c[j] = cvtpk(S1[8 * hf + 2 * j], S1[8 * hf + 2 * j + 1]); }
            pb[hf] = __builtin_bit_cast(bf16x8, a); pb[2 + hf] = __builtin_bit_cast(bf16x8, c);
        }
#pragma unroll
        for (int ks = 0; ks < 4; ++ks)
#pragma unroll
            for (int db = 0; db < 4; ++db) {
                const s16x4 a0 = vtr(vb_ + vread[db] + (16 * ks) * 256), a1 = vtr(vb_ + vread[db] + (16 * ks + 8) * 256);
                const bf16x8 va = __builtin_shufflevector(a0, a1, 0, 1, 2, 3, 4, 5, 6, 7);
                O[db] = __builtin_amdgcn_mfma_f32_32x32x16_bf16(va, pb[ks], O[db], 0, 0, 0);
            }
        if (t + 1 < 4) { LAS unsigned char* kn = lds + MA_K0 + (cur ^ 1) * 16384; LAS unsigned char* vn = lds + MA_V0 + (cur ^ 1) * 16384;
            *(LAS v4u*)(kn + kst0) = k0; *(LAS v4u*)(kn + kst1) = k1; *(LAS v4u*)(vn + vst0) = v0; *(LAS v4u*)(vn + vst1) = v1; }
        __syncthreads();
    }
    lsum += shx(lsum, 32, lane);
    const float inv = 1.f / lsum;
    bf16* op = OM + trow * MEMW + head * 128 + 4 * hh;
#pragma unroll
    for (int db = 0; db < 4; ++db)
#pragma unroll
        for (int g4 = 0; g4 < 4; ++g4) { v2u o; o.x = cvtpk(O[db][4 * g4] * inv, O[db][4 * g4 + 1] * inv); o.y = cvtpk(O[db][4 * g4 + 2] * inv, O[db][4 * g4 + 3] * inv); *(GAS v2u*)(op + 32 * db + 8 * g4) = o; }
}

struct Args { const float* in[23]; float* out; unsigned char* ws; int ph_lo, ph_hi, use_bar, pad; };
#ifndef MK_OFF
#define MK_OFF 0u
#endif
#ifndef REP_ATT
#define REP_ATT 1
#endif
#ifndef REP_P0
#define REP_P0 1
#endif
#ifndef REP_U
#define REP_U 1
#endif
#ifndef REP_GEMM
#define REP_GEMM 1
#endif
#ifndef REP_NORM
#define REP_NORM 1
#endif
#ifndef REP_SEL
#define REP_SEL 1
#endif
#ifndef REP_MEM
#define REP_MEM 1
#endif
#define PHON(k) (!((MK_OFF >> (k)) & 1u))
constexpr int PH_PER_LAYER = 9, PH_BASE = 2, N_PHASES = PH_BASE + DEPTH * PH_PER_LAYER;
constexpr int PTAB_OFF = LDSCTL_OFF + 1024;

__global__ void __launch_bounds__(NTHREADS, 2) mega(Args a) {
    extern __shared__ __attribute__((aligned(16))) unsigned char lds_raw[];
    LAS unsigned char* lds = (LAS unsigned char*)lds_raw;
    const int wave0_ = __builtin_amdgcn_readfirstlane((int)threadIdx.x >> 6);
    {   const int tid0 = threadIdx.x;
        for (int u = tid0; u < (LDS_BYTES - LDSCTL_OFF) / 4; u += NTHREADS) ((LAS unsigned*)(lds + LDSCTL_OFF))[u] = 0u;
        __syncthreads();
        if (tid0 < 23) ((LAS unsigned long long*)(lds + PTAB_OFF))[tid0] = (unsigned long long)a.in[tid0];
        if (tid0 == 23) ((LAS unsigned long long*)(lds + PTAB_OFF))[23] = (unsigned long long)a.out;
        if (tid0 == 24) ((LAS unsigned long long*)(lds + PTAB_OFF))[24] = (unsigned long long)a.ws;
        __syncthreads();
    }
    volatile LAS unsigned* MISC = (volatile LAS unsigned*)(lds + MISC_OFF);
    const int G = gridDim.x, bid = blockIdx.x, NGW = G * NWAVES;
    const int use_bar = a.use_bar;
    XcdBarrier bar; bar.bar = (unsigned*)(a.ws + WS_CTL) + CW_BAR; bar.x = 0; bar.st = MISC + 8;
    if (use_bar) bar = xcd_barrier_post((unsigned*)(a.ws + WS_CTL) + CW_BAR, MISC + 8);
    const int lo = a.ph_lo, hi = a.ph_hi;
#define IN(k) (lo <= (k) && (k) < hi)
#define SEAM(k) do { if (use_bar && IN(k) && IN((k) + 1)) xcd_barrier(bar); } while (0)
#define PHL() int tid_ = wave0_ * 64 + (int)__builtin_amdgcn_mbcnt_hi(~0u, __builtin_amdgcn_mbcnt_lo(~0u, 0u)); asm volatile("" : "+v"(tid_)); const int lane_ = tid_ & 63, wave_ = __builtin_amdgcn_readfirstlane(tid_ >> 6), gw_ = bid * NWAVES + wave_; (void)lane_; (void)gw_; \
              int pz_ = 0; asm volatile("" : "+s"(pz_))
#define PTR(i) ((const float*)ldptr(lds, (i) + pz_))
#define WSP() ((unsigned char*)ldptr(lds, 24 + pz_))
#define OUTP() ((float*)ldptr(lds, 23 + pz_))

    if (IN(0) && PHON(0)) {
        PHL(); unsigned char* ws = WSP();
        LAS float* scr = (LAS float*)(lds + RING_OFF + wave_ * 16384);
        constexpr int I_IN = 32 * 128, I_OUT = 32 * 64, I_MQ = 32 * 16, I_MKV = 32 * 32, I_MO = 8 * 64, I_PQ = 32 * 64, I_L = I_IN + I_OUT + I_MQ + I_MKV + I_MO + I_PQ;
        for (int it = gw_; it < DEPTH * I_L; it += NGW) {
            const int l = it / I_L; int r = it % I_L;
            if (r < I_IN) { transpose_item<true>(PTR(4) + (size_t)l * DM * DIN, DM, DIN, (bf16*)(ws + WS_WIN) + (size_t)l * DIN * DM, scr, r, lane_, PTR(3) + (size_t)l * DM); continue; } r -= I_IN;
            if (r < I_OUT) { transpose_item<false>(PTR(11) + (size_t)l * DM * DM, DM, DM, (bf16*)(ws + WS_WOUT) + (size_t)l * DM * DM, scr, r, lane_, PTR(10) + (size_t)l * DM); continue; } r -= I_OUT;
            if (r < I_MQ) { transpose_item<false>(PTR(14) + (size_t)l * DM * MEMW, DM, MEMW, (bf16*)(ws + WS_WMQ) + (size_t)l * MEMW * DM, scr, r, lane_, PTR(12) + (size_t)l * DM); continue; } r -= I_MQ;
            if (r < I_MKV) { transpose_item<false>(PTR(15) + (size_t)l * DM * 1024, DM, 1024, (bf16*)(ws + WS_WMKV) + (size_t)l * 1024 * DM, scr, r, lane_); continue; } r -= I_MKV;
            if (r < I_MO) { transpose_item<false>(PTR(17) + (size_t)l * MEMW * DM, MEMW, DM, (bf16*)(ws + WS_WMO) + (size_t)l * DM * MEMW, scr, r, lane_); continue; } r -= I_MO;
            transpose_item<false>(PTR(19) + (size_t)l * DM * DM, DM, DM, (bf16*)(ws + WS_WPQ) + (size_t)l * DM * DM, scr, r, lane_, PTR(18) + (size_t)l * DM);
        }
        const size_t gtid = (size_t)bid * NTHREADS + tid_, nth = (size_t)G * NTHREADS;
        convert_bf16(PTR(20), (bf16*)(ws + WS_PKEYS), (size_t)DEPTH * 8 * 2 * 128 * 128, gtid, nth);
        convert_int4_plain(PTR(21), ws + WS_PU, DEPTH * PEER_N, PU_SCALEI, PTR(18), gw_, NGW, lane_);
        convert_fp4_rows(PTR(22), ws + WS_PV, PEER_N, PV_SCALE4, nullptr, gw_, NGW, lane_);
        {   const float* x0 = PTR(0); bf16* XN = (bf16*)(ws + WS_XN); u64_t* rsq = (u64_t*)(ws + WS_ROWSQ);
            for (int m = 2 * gw_; m < T; m += 2 * NGW) prep_rows2(x0 + (size_t)m * DM, XN + (size_t)m * DM, rsq + m, ws + WS_XN8 + (size_t)m * DM, (float*)(ws + WS_XSC) + m, lane_); }
        {   const float* mem = PTR(1); const float* gkv = PTR(13); bf16* MEMN = (bf16*)(ws + WS_MEMN);
            for (int m = gw_; m < BATCH * NMEM; m += NGW)
                rms_row_to_bf16(mem + (size_t)m * DM, gkv, MEMN + (size_t)m * DM, gkv + DM, MEMN + (size_t)(BATCH * NMEM + m) * DM, lane_); }
        float* rope = (float*)(ws + WS_ROPE); float* biasA = (float*)(ws + WS_BIASA);
        if (gtid < 64 * 16) { const int pos = (int)gtid >> 4, i = (int)gtid & 15; const float ang = (float)pos * ROPE_INV[i]; rope[gtid * 2] = cosf(ang); rope[gtid * 2 + 1] = sinf(ang); }
        if (gtid < 12 * 257) { const int h = (int)gtid / 257, rel = (int)gtid % 257 - 128; biasA[gtid] = PTR(2)[t5_bucket(rel) * 12 + h]; }
    }
    SEAM(0);
    if (IN(1) && PHON(1)) {
        {   PHL(); unsigned char* ws = WSP();
            for (int r = gw_; r < DEPTH * DIN; r += NGW) { const int rr = r & (DIN - 1), src = (rr & ~255) + 64 * ((rr >> 5) & 3) + 32 * ((rr >> 7) & 1) + (rr & 31);
                quant_wrow((const bf16*)(ws + WS_WIN) + (size_t)r * DM, ws + WS_WIN8 + (size_t)r * DM, (float*)(ws + WS_WSC) + (r & ~(DIN - 1)) + src, lane_); }
            for (int r = gw_; r < DEPTH * DM; r += NGW) quant_wrow((const bf16*)(ws + WS_WOUT) + (size_t)r * DM, ws + WS_WOUT8 + (size_t)r * DM, (float*)(ws + WS_WSCO) + r, lane_);
            for (int r = gw_; r < DEPTH * DM; r += NGW) quant_wrow((const bf16*)(ws + WS_WPQ) + (size_t)r * DM, ws + WS_WPQ8 + (size_t)r * DM, (float*)(ws + WS_WSCP) + r, lane_);
            for (int r = gw_; r < DEPTH * MEMW; r += NGW) quant_wrow((const bf16*)(ws + WS_WMQ) + (size_t)r * DM, ws + WS_WMQ8 + (size_t)r * DM, (float*)(ws + WS_WSCM) + r, lane_); }
#pragma unroll 1
        for (int l = 0; l < DEPTH; ++l) {
            PHL(); unsigned char* ws = WSP();
            pg8::Gemm g{(bf16*)(ws + WS_MEMN) + (size_t)l * BATCH * NMEM * DM, (bf16*)(ws + WS_WMKV) + (size_t)l * 1024 * DM, BATCH * NMEM, 1024, DM};
            OffsetOrder S; S.init(BATCH * NMEM, 1024, G, bid, 64 * l);
            bf16* KVMl = (bf16*)(ws + WS_KVM) + (size_t)l * BATCH * NMEM * 1024;
            pg8::EpiBf16<0> E{KVMl, 1024, nullptr, 0, 0, 1.f};
            pg8::gemm_phase<pg8::EpiBf16<0>, OffsetOrder, true, true>(lds + RING_OFF, g, S, E, tid_);
            VM_WAIT(); __syncthreads();
            const float* gk = PTR(16) + (size_t)l * 256 + 128;
#pragma unroll 1
            for (int i = 0; i < 4; ++i) { pg8::Unit uu; uu.pm = 0; uu.pn = 0; if (!S.next(i, uu)) break;
                if (uu.pn < 2) {
                    for (int r2 = wave_; r2 < 128; r2 += NWAVES) { const int row = uu.pm * 256 + 2 * r2 + (lane_ >> 5), cl = lane_ & 31;
                        GAS v4u* p = (GAS v4u*)(KVMl + (size_t)row * 1024 + 256 * uu.pn + 8 * cl);
                        const v4u w = *p;
                        float f[8] = {bflo(w.x), bfhi(w.x), bflo(w.y), bfhi(w.y), bflo(w.z), bfhi(w.z), bflo(w.w), bfhi(w.w)};
                        float ss = 0.f;
#pragma unroll
                        for (int e = 0; e < 8; ++e) ss += f[e] * f[e];
                        ss += shx(ss, 1, lane_); ss += shx(ss, 2, lane_); ss += shx(ss, 4, lane_); ss += shx(ss, 8, lane_);
                        const float r = 1.f / sqrtf(ss * (1.f / 128.f) + EPS);
                        const float* gg = gk + 8 * (cl & 15);
                        v4u o; o.x = pk2(f[0] * r * gg[0], f[1] * r * gg[1]); o.y = pk2(f[2] * r * gg[2], f[3] * r * gg[3]); o.z = pk2(f[4] * r * gg[4], f[5] * r * gg[5]); o.w = pk2(f[6] * r * gg[6], f[7] * r * gg[7]);
                        *p = o; } } }
            __syncthreads();
        }
        if (G >= 256 && bid >= 128) { PHL(); unsigned char* ws = WSP();
            convert_fp4_rows(PTR(22) + (size_t)PEER_N * DM, ws + WS_PV + (size_t)PEER_N * 1024, PEER_N, PV_SCALE4, nullptr, (bid - 128) * NWAVES + wave_, (G - 128) * NWAVES, lane_); }
        else if (G < 256) { PHL(); unsigned char* ws = WSP(); convert_fp4_rows(PTR(22) + (size_t)PEER_N * DM, ws + WS_PV + (size_t)PEER_N * 1024, PEER_N, PV_SCALE4, nullptr, gw_, NGW, lane_); }
    }
    SEAM(1);

#pragma unroll 1
    for (int l = 0; l < DEPTH; ++l) {
        const int pb = PH_BASE + PH_PER_LAYER * l;
        if (IN(pb + 0) && PHON(3)) { PHL(); unsigned char* ws = WSP();
            pg8::Gemm g{(bf16*)(ws + WS_XN8), (bf16*)(ws + WS_WIN8 + (size_t)l * DIN * DM), T, DIN, DM / 2}; pg8::StaticOrder S; S.init(T, DIN, G, bid);
            LAS float* ropel = (LAS float*)(lds + LDSCTL_OFF + 2048);
            for (int i = tid_; i < 64 * 16 * 2; i += NTHREADS) ropel[i] = ((const float*)(ws + WS_ROPE))[i];
            __syncthreads();
            pg8::EpiQKV E{(bf16*)(ws + WS_QKV), PTR(5) + (size_t)l * 128, PTR(7) + (size_t)l * 128, PTR(9) + (size_t)l * 128, ropel, (const u64_t*)(ws + WS_ROWSQ) + (size_t)(l * 3 + 0) * T, (const float*)(ws + WS_XSC), (const float*)(ws + WS_WSC) + (size_t)l * DIN};
            pg8::gemm_phase<pg8::EpiQKV, pg8::StaticOrder, true, true>(lds + RING_OFF, g, S, E, tid_);
        }
        SEAM(pb + 0);
        if (IN(pb + 1) && PHON(4)) { PHL(); unsigned char* ws = WSP();
            const float* sink = PTR(6) + (size_t)l * 12; const float* rpb = PTR(8) + (size_t)l * 8 * 15 * 31; const float* biasA = (const float*)(ws + WS_BIASA);
            const bf16* QKV = (const bf16*)(ws + WS_QKV); bf16* ATT = (bf16*)(ws + WS_ATT);
            const float* ga = PTR(5) + (size_t)l * 128; const float* gb = PTR(7) + (size_t)l * 128; const float* gc = PTR(9) + (size_t)l * 128;
            const float CaL2 = 8.f * wave_max(fabsf(ga[lane_]), lane_) * wave_max(fabsf(ga[64 + lane_]), lane_) * LOG2E;
            const float CbL2 = 8.f * wave_max(fabsf(gb[lane_]), lane_) * wave_max(fabsf(gb[64 + lane_]), lane_) * LOG2E;
            const float CcL2 = 8.f * wave_max(fabsf(gc[lane_]), lane_) * wave_max(fabsf(gc[64 + lane_]), lane_) * LOG2E;
            const int vc = (G % 8 == 0) ? (bid % 8) * (G / 8) + bid / 8 : bid;
            u64_t* mixsq = (u64_t*)(ws + WS_MIXSQ) + (size_t)l * 3 * T;
            for (int u = vc; u < BATCH * 12 * 8; u += G) attn_unit<2>(lds, QKV, ATT, mixsq + 2 * (size_t)T, u / 96, (u >> 3) % 12, u & 7, nullptr, CcL2, 0.f, tid_);
            for (int u = vc; u < BATCH * 8 * 8; u += G) attn_unit<1>(lds, QKV, ATT, mixsq + (size_t)T, u >> 6, (u >> 3) & 7, u & 7, rpb, CbL2, 0.f, tid_);
            for (int u = vc; u < BATCH * 12 * 8; u += G) { const int head = (u >> 3) % 12; attn_unit<0>(lds, QKV, ATT, mixsq, u / 96, head, u & 7, biasA, CaL2, sink[head] * LOG2E, tid_); }
        }
        SEAM(pb + 1);
        if (IN(pb + 2) && PHON(5)) { PHL(); unsigned char* ws = WSP();
            const u64_t* mixsq = (const u64_t*)(ws + WS_MIXSQ) + (size_t)l * 3 * T;
            for (int r = 4 * gw_; r < T; r += 4 * NGW) att_quant_rows<4>((const bf16*)(ws + WS_ATT), mixsq, ws + WS_ATT8, (float*)(ws + WS_XSC2), r, lane_);
        }
        SEAM(pb + 2);
        if (IN(pb + 3) && PHON(5)) { PHL(); unsigned char* ws = WSP();
            pg8::Gemm g{(bf16*)(ws + WS_ATT8), (bf16*)(ws + WS_WOUT8 + (size_t)l * DM * DM), T, DM, DM / 2}; pg8::StaticOrder S; S.init(T, DM, G, bid);
            typedef pg8::EpiResidT<true, 10> EpiX1;
            EpiX1 E{(bf16*)(ws + WS_XN), DM, (u64_t*)(ws + WS_ROWSQ) + (size_t)(l * 3 + 1) * T, (const float*)(ws + WS_XSC2), (const float*)(ws + WS_WSCO) + (size_t)l * DM, ws + WS_X8, (const u64_t*)(ws + WS_ROWSQ) + (size_t)(l * 3 + 0) * T};
            pg8::gemm_phase<EpiX1, pg8::StaticOrder, true, true>(lds + RING_OFF, g, S, E, tid_);
        }
        SEAM(pb + 3);
        if (IN(pb + 4) && PHON(6)) { PHL(); unsigned char* ws = WSP();
            pg8::Gemm g{(bf16*)(ws + WS_X8), (bf16*)(ws + WS_WMQ8 + (size_t)l * MEMW * DM), T, MEMW, DM / 2}; pg8::StaticOrder S; S.init(T, MEMW, G, bid);
            pg8::EpiBf16Row8<10> E{(bf16*)(ws + WS_QM), MEMW, (const u64_t*)(ws + WS_ROWSQ) + (size_t)(l * 3 + 1) * T, (const u64_t*)(ws + WS_ROWSQ) + (size_t)(l * 3 + 0) * T, (const float*)(ws + WS_WSCM) + (size_t)l * MEMW};
            pg8::gemm_phase<pg8::EpiBf16Row8<10>, pg8::StaticOrder, true, true>(lds + RING_OFF, g, S, E, tid_);
            VM_WAIT(); __syncthreads();
            const bf16* kvm = (const bf16*)(ws + WS_KVM) + (size_t)l * BATCH * NMEM * 1024; const float* gq = PTR(16) + (size_t)l * 256;
            const float CmL2 = 11.313708498984761f * wave_max(fmaxf(fabsf(gq[lane_]), fabsf(gq[64 + lane_])), lane_) * wave_max(fmaxf(fabsf(gq[128 + lane_]), fabsf(gq[192 + lane_])), lane_) * LOG2E;
#pragma unroll 1
            for (int i = 0; i < 4; ++i) { pg8::Unit uu; uu.pm = 0; uu.pn = 0; if (!S.next(i, uu)) break;
                mem_unit(lds, (const bf16*)(ws + WS_QM), kvm, (bf16*)(ws + WS_OM), gq, uu.pm, 2 * uu.pn, CmL2, tid_);
                mem_unit(lds, (const bf16*)(ws + WS_QM), kvm, (bf16*)(ws + WS_OM), gq, uu.pm, 2 * uu.pn + 1, CmL2, tid_); }
        }
        SEAM(pb + 4);
        if (IN(pb + 5) && PHON(7)) { PHL(); unsigned char* ws = WSP();
            pg8::Gemm g{(bf16*)(ws + WS_OM), (bf16*)(ws + WS_WMO) + (size_t)l * DM * MEMW, T, DM, MEMW}; pg8::StaticOrder S; S.init(T, DM, G, bid);
            typedef pg8::EpiResidT<false, 8> EpiX2;
            EpiX2 E{(bf16*)(ws + WS_XN), DM, (u64_t*)(ws + WS_ROWSQ) + (size_t)(l * 3 + 2) * T, nullptr, nullptr, ws + WS_X8, (const u64_t*)(ws + WS_ROWSQ) + (size_t)(l * 3 + 1) * T};
            pg8::gemm_phase<EpiX2, pg8::StaticOrder, true, true>(lds + RING_OFF, g, S, E, tid_);
        }
        SEAM(pb + 5);
        if (IN(pb + 6) && PHON(8)) { PHL(); unsigned char* ws = WSP();
            pg8::Gemm g{(bf16*)(ws + WS_X8), (bf16*)(ws + WS_WPQ8 + (size_t)l * DM * DM), T, DM, DM / 2}; pg8::StaticOrder S; S.init(T, DM, G, bid);
            pg8::EpiBf16Row8<8> E{(bf16*)(ws + WS_QP), DM, (const u64_t*)(ws + WS_ROWSQ) + (size_t)(l * 3 + 2) * T, (const u64_t*)(ws + WS_ROWSQ) + (size_t)(l * 3 + 1) * T, (const float*)(ws + WS_WSCP) + (size_t)l * DM};
            pg8::gemm_phase<pg8::EpiBf16Row8<8>, pg8::StaticOrder, true, true>(lds + RING_OFF, g, S, E, tid_);
            VM_WAIT(); __syncthreads();
            const bf16* pk = (const bf16*)(ws + WS_PKEYS) + (size_t)l * 8 * 2 * 128 * 128;
#pragma unroll 1
            for (int i = 0; i < 8; ++i) { pg8::Unit uu; uu.pm = 0; uu.pn = 0; if (!S.next(i, uu)) break;
                peer_select_unit((const bf16*)(ws + WS_QP), pk, (int*)(ws + WS_PIDX), (float*)(ws + WS_PGATE), uu.pm, uu.pn, wave_, lane_);
                peer_xquant_unit((const bf16*)(ws + WS_XN), (const u64_t*)(ws + WS_ROWSQ) + (size_t)(l * 3 + 2) * T, (unsigned*)(ws + WS_XQH), (unsigned*)(ws + WS_XQL), uu.pm, uu.pn, tid_); }
        }
        SEAM(pb + 6);
        if (IN(pb + 7) && PHON(9)) { PHL(); unsigned char* ws = WSP();
            peer_u_phase_i4((const unsigned*)(ws + WS_XQH), (const unsigned*)(ws + WS_XQL), ws + WS_PU + (size_t)l * PEER_N * 1024, (const int*)(ws + WS_PIDX), (int*)(ws + WS_PARTI), bid, G, wave_, lane_); }
        SEAM(pb + 7);
        if (IN(pb + 8) && PHON(10)) { PHL(); unsigned char* ws = WSP();
            peer_v_pass((bf16*)(ws + WS_XN), ws + WS_PV + (size_t)l * PEER_N * 1024, (const int*)(ws + WS_PIDX), (const float*)(ws + WS_PGATE), (const int*)(ws + WS_PARTI), (l + 1 == DEPTH) ? OUTP() : (float*)nullptr,
                        (l + 1 < DEPTH) ? (u64_t*)(ws + WS_ROWSQ) + (size_t)((l + 1) * 3 + 0) * T : (u64_t*)nullptr, (l + 1 < DEPTH) ? ws + WS_XN8 : (unsigned char*)nullptr, (float*)(ws + WS_XSC), (LAS float*)(lds + RING_OFF + wave_ * 1024), gw_, NGW, lane_); }
        SEAM(pb + 8);
    }
#undef IN
#undef SEAM
}

#ifndef MK_MULTI_LAUNCH
#define MK_MULTI_LAUNCH 0
#endif
extern "C" void kernel_launch(void* const* d_in, const int* in_sizes, int n_in, void* d_out, int out_size, void* d_ws, size_t ws_size, hipStream_t stream) {
    static int grid = 0;
    if (grid == 0) {
        if (n_in != 23 || out_size != T * DM || ws_size < WS_END) { fprintf(stderr, "kernel_launch: unexpected shapes (n_in %d, out %d, ws %zu)\n", n_in, out_size, ws_size); grid = -1; return; }
        int dev = 0, cus = 0, per_cu = 0;
        if (hipGetDevice(&dev) != hipSuccess || hipDeviceGetAttribute(&cus, hipDeviceAttributeMultiprocessorCount, dev) != hipSuccess) { grid = -1; return; }
        if (hipFuncSetAttribute((const void*)mega, hipFuncAttributeMaxDynamicSharedMemorySize, LDS_BYTES) != hipSuccess) { fprintf(stderr, "kernel_launch: hipFuncSetAttribute failed\n"); grid = -1; return; }
        if (hipOccupancyMaxActiveBlocksPerMultiprocessor(&per_cu, (const void*)mega, NTHREADS, LDS_BYTES) != hipSuccess || per_cu < 1) { fprintf(stderr, "kernel_launch: occupancy query says %d\n", per_cu); }
        (void)hipGetLastError();
        grid = cus;
    }
    if (grid < 0) return;
    (void)hipMemsetAsync((char*)d_ws + WS_CTL, 0, CTL_ZERO_BYTES, stream);
    (void)hipMemsetAsync((char*)d_ws + WS_MIXSQ, 0, MIXSQ_BYTES, stream);
    Args a{};
    for (int i = 0; i < 23; ++i) a.in[i] = (const float*)d_in[i];
    a.out = (float*)d_out; a.ws = (unsigned char*)d_ws;
#if MK_MULTI_LAUNCH
    for (int p = 0; p < N_PHASES; ++p) { a.ph_lo = p; a.ph_hi = p + 1; a.use_bar = 0; a.pad = 0; hipLaunchKernelGGL(mega, dim3(grid), dim3(NTHREADS), LDS_BYTES, stream, a); }
#else
    a.ph_lo = 0; a.ph_hi = N_PHASES; a.use_bar = 1; a.pad = 0;
    hipLaunchKernelGGL(mega, dim3(grid), dim3(NTHREADS), LDS_BYTES, stream, a);
#endif
    const hipError_t le = hipPeekAtLastError();
    if (le != hipSuccess) fprintf(stderr, "kernel_launch: launch failed: %s\n", hipGetErrorName(le));
}
```

```cpp
#include <hip/hip_runtime.h>
#include <cstdio>
#include <cstdint>
#include <cmath>
__device__ __forceinline__ float shx(float v, int k, int lane);
typedef unsigned long long u64_t;
__device__ __forceinline__ float rowsq_rs(const u64_t* rowsq, int row) { return 1.0f / sqrtf((float)*(const __attribute__((address_space(1))) u64_t*)(rowsq + row) * (5.9604644775390625e-08f / 2048.0f) + 1e-6f); }
__device__ __forceinline__ u64_t rowsq_fx(float ss) { return (u64_t)(ss * 16777216.0f + 0.5f); }
template <int HI = 255>
__device__ __forceinline__ unsigned q8x4c(float a, float b, float c, float d, float inv) {
    unsigned w = 0;
    w = __builtin_amdgcn_cvt_pk_u8_f32(__builtin_rintf(__builtin_amdgcn_fmed3f(__builtin_fmaf(a, inv, 128.f), 1.f, (float)HI)), 0, w); w = __builtin_amdgcn_cvt_pk_u8_f32(__builtin_rintf(__builtin_amdgcn_fmed3f(__builtin_fmaf(b, inv, 128.f), 1.f, (float)HI)), 1, w);
    w = __builtin_amdgcn_cvt_pk_u8_f32(__builtin_rintf(__builtin_amdgcn_fmed3f(__builtin_fmaf(c, inv, 128.f), 1.f, (float)HI)), 2, w); w = __builtin_amdgcn_cvt_pk_u8_f32(__builtin_rintf(__builtin_amdgcn_fmed3f(__builtin_fmaf(d, inv, 128.f), 1.f, (float)HI)), 3, w);
    return w ^ 0x80808080u;
}
__device__ __forceinline__ unsigned dig_lo4(unsigned d) { return d & 0x0f0f0f0fu; }
__device__ __forceinline__ unsigned dig_hi4(unsigned d) { const unsigned t = ((d & 0x7f7f7f7fu) + 0x08080808u) ^ (d & 0x80808080u); return (t >> 4) & 0x0f0f0f0fu; }
__device__ __forceinline__ unsigned nib_pack8(unsigned a, unsigned b) { a = (a | (a >> 4)) & 0x00ff00ffu; a = (a | (a >> 8)) & 0xffffu; b = (b | (b >> 4)) & 0x00ff00ffu; b = (b | (b >> 8)) & 0xffffu; return a | (b << 16); }
namespace pg8 {
#define PG8_LAS __attribute__((address_space(3)))
#define PG8_GAS __attribute__((address_space(1)))
typedef unsigned short bf16_t;
typedef short bf16x8 __attribute__((ext_vector_type(8)));
typedef float f32x4 __attribute__((ext_vector_type(4)));
typedef unsigned u32x4 __attribute__((ext_vector_type(4)));
constexpr int BM = 256, BK = 64, HALF = 128, HTB = HALF * BK * 2  , STAGE_BYTES = 8 * HTB, NXCD = 8, WGM = 8;

__host__ __device__ __forceinline__ int lds_byte(int r, int c) { const int st = (r >> 4) * 2 + (c >> 5), rr = r & 15, cc = c & 31, ob = rr * 64 + cc * 2; return st * 1024 + (ob ^ (((ob >> 9) & 1) << 5)); }
__host__ __device__ __forceinline__ void stage_rc(int b, int& R, int& C) { const int st = b / 1024, sb = b % 1024, swz = sb ^ (((sb >> 9) & 1) << 5); R = (st >> 1) * 16 + swz / 64; C = (st & 1) * 32 + (swz % 64) / 2; }
__host__ __device__ __forceinline__ int perm32(int rho) { const int n = rho >> 4, i = rho & 15; return 8 * (i >> 2) + 4 * n + (i & 3); }

struct Unit { int pm, pn; };
struct Gemm { const bf16_t* A; const bf16_t* Bt; int M, N, K; };

struct StaticOrder {
    int nM, nN, nwg, G, c;
    __host__ __device__ __forceinline__ void init(int M, int N, int G_, int c_) { nM = M / BM; nN = N / BM; nwg = nM * nN; G = G_; c = c_; }
    __host__ __device__ __forceinline__ bool next(int i, Unit& u) const {
        const long L = (long)i * G + c; if (L >= nwg) return false;
        int wgid = (int)L; { const int q = nwg / NXCD, r = nwg % NXCD, xcd = wgid % NXCD, off = wgid / NXCD; wgid = (xcd < r ? xcd * (q + 1) : r * (q + 1) + (xcd - r) * q) + off; }
        const int nig = WGM * nN, gid = wgid / nig, fm = gid * WGM, gsz = (nM - fm) < WGM ? (nM - fm) : WGM;
        u.pm = fm + ((wgid % nig) % gsz); u.pn = (wgid % nig) / gsz; return true;
    }
    __device__ __forceinline__ void a_ready(const Unit&) const {}
    __device__ __forceinline__ void done(const Unit&) const {}
};

__device__ __forceinline__ unsigned cvt_pk_bf16(float lo, float hi) { unsigned r; asm volatile("v_cvt_pk_bf16_f32 %0, %1, %2" : "=v"(r) : "v"(lo), "v"(hi)); return r; }
typedef float f32x2 __attribute__((ext_vector_type(2)));
__device__ __forceinline__ f32x2 gelu_pk(f32x2 v) {
    const f32x2 av = __builtin_elementwise_abs(v), d = av * 0.2316418882f + 1.0f;
    f32x2 t; t.x = __builtin_amdgcn_rcpf(d.x); t.y = __builtin_amdgcn_rcpf(d.y);
    f32x2 q = t * 0.5307027145f + (-0.7265760135f); q = q * t + 0.7107068705f; q = q * t + (-0.142248368f); q = q * t + 0.127414796f; q = q * t;
    const f32x2 s = (v * v) * (-0.72134752044f);
    f32x2 e; e.x = __builtin_amdgcn_exp2f(s.x); e.y = __builtin_amdgcn_exp2f(s.y);
    const f32x2 m = v * (q * e), r = v - m;
    f32x2 o; o.x = v.x < 0.f ? m.x : r.x; o.y = v.y < 0.f ? m.y : r.y; return o;
}

template <int ACT  > struct EpiBf16 {
    static constexpr bool PERM = true, AFTER_DRAIN = false, KSCALE = false, I8 = false; static_assert(ACT == 0 || ACT == 1, "EpiBf16: ACT is 0 (none) or 1 (gelu_pk)");
    bf16_t* O; int ldc; const float* bias; int split_cols; size_t split_stride; float scale0;
    __device__ __forceinline__ void operator()(const f32x4 (&acc)[2][2][4][2], const Unit& u, int wr, int wc, int fr, int fq) const {
        const int row0 = u.pm * BM + wr * 64 + fr; int colt = u.pn * BM; bf16_t* base = O;
        float sc = 1.f; if (split_cols) { const int t = colt / split_cols; base += (size_t)t * split_stride; colt -= t * split_cols; if (t == 0) sc = scale0; }
        const int col0 = colt + wc * 32 + 8 * fq, bcol0 = u.pn * BM + wc * 32 + 8 * fq;
        f32x4 bv[2][2];
#pragma unroll
        for (int bj = 0; bj < 2; ++bj)
#pragma unroll
            for (int n = 0; n < 2; ++n) bv[bj][n] = bias ? *(const PG8_GAS f32x4*)(bias + bcol0 + bj * HALF + 4 * n) : (f32x4){0.f, 0.f, 0.f, 0.f};
#pragma unroll
        for (int ai = 0; ai < 2; ++ai)
#pragma unroll
            for (int m = 0; m < 4; ++m) { bf16_t* rowp = base + (size_t)(row0 + ai * HALF + m * 16) * ldc + col0;
#pragma unroll
                for (int bj = 0; bj < 2; ++bj) { f32x4 v0 = acc[ai][bj][m][0] + bv[bj][0], v1 = acc[ai][bj][m][1] + bv[bj][1];
                    if (ACT == 1) { f32x2 a = gelu_pk((f32x2){v0[0], v0[1]}), b = gelu_pk((f32x2){v0[2], v0[3]}), c = gelu_pk((f32x2){v1[0], v1[1]}), d = gelu_pk((f32x2){v1[2], v1[3]});
                        v0 = (f32x4){a.x, a.y, b.x, b.y}; v1 = (f32x4){c.x, c.y, d.x, d.y}; }
                    v0 = v0 * sc; v1 = v1 * sc; u32x4 w; w.x = cvt_pk_bf16(v0[0], v0[1]); w.y = cvt_pk_bf16(v0[2], v0[3]); w.z = cvt_pk_bf16(v1[0], v1[1]); w.w = cvt_pk_bf16(v1[2], v1[3]);
                    *(PG8_GAS u32x4*)(rowp + bj * HALF) = w; } }
    }
};

typedef unsigned u32x2 __attribute__((ext_vector_type(2)));
typedef int i32x4 __attribute__((ext_vector_type(4)));
struct EpiResid {
    static constexpr bool PERM = false, AFTER_DRAIN = false, KSCALE = false, I8 = false;
    bf16_t* s; int ldc; u64_t* rowsq;
    __device__ __forceinline__ void operator()(const f32x4 (&acc)[2][2][4][2], const Unit& u, int wr, int wc, int fr, int fq) const {
        const int col0 = u.pn * BM + wc * 32 + 4 * fq;
#pragma unroll
        for (int ai = 0; ai < 2; ++ai)
#pragma unroll
            for (int m = 0; m < 4; ++m) { const int row = u.pm * BM + ai * HALF + wr * 64 + m * 16 + fr; bf16_t* sp = s + (size_t)row * ldc + col0; float ss = 0.f;
                u32x2 in[2][2];
#pragma unroll
                for (int bj = 0; bj < 2; ++bj)
#pragma unroll
                    for (int n = 0; n < 2; ++n) in[bj][n] = *(const PG8_GAS u32x2*)(sp + bj * HALF + n * 16);
#pragma unroll
                for (int bj = 0; bj < 2; ++bj)
#pragma unroll
                    for (int n = 0; n < 2; ++n) { const u32x2 w0 = in[bj][n];
                        const f32x4 bs = (f32x4){__builtin_bit_cast(float, w0.x << 16), __builtin_bit_cast(float, w0.x & 0xffff0000u), __builtin_bit_cast(float, w0.y << 16), __builtin_bit_cast(float, w0.y & 0xffff0000u)};
                        const f32x4 o = bs + acc[ai][bj][m][n]; ss += (o[0] * o[0] + o[1] * o[1]) + (o[2] * o[2] + o[3] * o[3]);
                        u32x2 w; w.x = cvt_pk_bf16(o[0], o[1]); w.y = cvt_pk_bf16(o[2], o[3]); *(PG8_GAS u32x2*)(sp + bj * HALF + n * 16) = w; }
                ss += shx(ss, 16, fr + 16 * fq); ss += shx(ss, 32, fr + 16 * fq);
                if (fq == 0) (void)__hip_atomic_fetch_add((PG8_GAS u64_t*)(rowsq + row), rowsq_fx(ss), __ATOMIC_RELAXED, __HIP_MEMORY_SCOPE_AGENT); }
    }
};
struct EpiResid8 {
    static constexpr bool PERM = false, AFTER_DRAIN = false, KSCALE = false, I8 = true;
    bf16_t* s; int ldc; u64_t* rowsq; const float* xsc; const float* wsc;
    __device__ __forceinline__ void operator()(const f32x4 (&acc)[2][2][4][2], const Unit& u, int wr, int wc, int fr, int fq) const {
        const int col0 = u.pn * BM + wc * 32 + 4 * fq;
#pragma unroll
        for (int ai = 0; ai < 2; ++ai)
#pragma unroll
            for (int m = 0; m < 4; ++m) { const int row = u.pm * BM + ai * HALF + wr * 64 + m * 16 + fr; bf16_t* sp = s + (size_t)row * ldc + col0; float ss = 0.f; const float xs = *(const PG8_GAS float*)(xsc + row);
                u32x2 in[2][2];
#pragma unroll
                for (int bj = 0; bj < 2; ++bj)
#pragma unroll
                    for (int n = 0; n < 2; ++n) in[bj][n] = *(const PG8_GAS u32x2*)(sp + bj * HALF + n * 16);
#pragma unroll
                for (int bj = 0; bj < 2; ++bj)
#pragma unroll
                    for (int n = 0; n < 2; ++n) { const u32x2 w0 = in[bj][n]; const i32x4 ia = __builtin_bit_cast(i32x4, acc[ai][bj][m][n]);
                        const f32x4 bs = (f32x4){__builtin_bit_cast(float, w0.x << 16), __builtin_bit_cast(float, w0.x & 0xffff0000u), __builtin_bit_cast(float, w0.y << 16), __builtin_bit_cast(float, w0.y & 0xffff0000u)};
                        const f32x4 o = bs + (f32x4){(float)ia[0], (float)ia[1], (float)ia[2], (float)ia[3]} * *(const PG8_GAS f32x4*)(wsc + col0 + bj * HALF + n * 16) * xs; ss += (o[0] * o[0] + o[1] * o[1]) + (o[2] * o[2] + o[3] * o[3]);
                        u32x2 w; w.x = cvt_pk_bf16(o[0], o[1]); w.y = cvt_pk_bf16(o[2], o[3]); *(PG8_GAS u32x2*)(sp + bj * HALF + n * 16) = w; }
                ss += shx(ss, 16, fr + 16 * fq); ss += shx(ss, 32, fr + 16 * fq);
                if (fq == 0) (void)__hip_atomic_fetch_add((PG8_GAS u64_t*)(rowsq + row), rowsq_fx(ss), __ATOMIC_RELAXED, __HIP_MEMORY_SCOPE_AGENT); }
    }
};
template <bool I8IN, int QOUT, bool DIG = false>
struct EpiResidT {
    static constexpr bool PERM = true, AFTER_DRAIN = false, KSCALE = false, I8 = I8IN;
    bf16_t* s; int ldc; u64_t* rowsq; const float* xsc; const float* wsc; unsigned char* q8; const u64_t* rowsq_prev; unsigned char* dgh; unsigned char* dgl;
    __device__ __forceinline__ void operator()(const f32x4 (&acc)[2][2][4][2], const Unit& u, int wr, int wc, int fr, int fq) const {
        const int col0 = u.pn * BM + wc * 32 + 8 * fq, rowb = u.pm * BM + wr * 64 + fr;
        f32x4 wv[2][2];
        if constexpr (I8IN) {
#pragma unroll
            for (int bj = 0; bj < 2; ++bj) { wv[bj][0] = *(const PG8_GAS f32x4*)(wsc + col0 + bj * HALF); wv[bj][1] = *(const PG8_GAS f32x4*)(wsc + col0 + bj * HALF + 4); } }
#pragma unroll
        for (int ai = 0; ai < 2; ++ai) {
            u32x4 in[4][2]; float xs[4], qv[4];
#pragma unroll
            for (int m = 0; m < 4; ++m) { const int row = rowb + ai * HALF + m * 16; const bf16_t* sp = s + (size_t)row * ldc + col0;
#pragma unroll
                for (int bj = 0; bj < 2; ++bj) in[m][bj] = *(const PG8_GAS u32x4*)(sp + bj * HALF);
                if constexpr (I8IN) xs[m] = *(const PG8_GAS float*)(xsc + row); else xs[m] = 1.f;
                if constexpr (QOUT > 0) qv[m] = (127.0f / QOUT) * rowsq_rs(rowsq_prev, row); else qv[m] = 0.f; }
            __builtin_amdgcn_sched_barrier(0);
#pragma unroll
            for (int m = 0; m < 4; ++m) { const int row = rowb + ai * HALF + m * 16; bf16_t* sp = s + (size_t)row * ldc + col0; float ss = 0.f;
#pragma unroll
                for (int bj = 0; bj < 2; ++bj) { const u32x4 w0 = in[m][bj]; f32x4 a0 = acc[ai][bj][m][0], a1 = acc[ai][bj][m][1];
                    if constexpr (I8IN) { const i32x4 i0 = __builtin_bit_cast(i32x4, a0), i1 = __builtin_bit_cast(i32x4, a1);
                        a0 = (f32x4){(float)i0[0], (float)i0[1], (float)i0[2], (float)i0[3]} * wv[bj][0] * xs[m];
                        a1 = (f32x4){(float)i1[0], (float)i1[1], (float)i1[2], (float)i1[3]} * wv[bj][1] * xs[m]; }
                    const f32x4 o0 = (f32x4){__builtin_bit_cast(float, w0.x << 16), __builtin_bit_cast(float, w0.x & 0xffff0000u), __builtin_bit_cast(float, w0.y << 16), __builtin_bit_cast(float, w0.y & 0xffff0000u)} + a0;
                    const f32x4 o1 = (f32x4){__builtin_bit_cast(float, w0.z << 16), __builtin_bit_cast(float, w0.z & 0xffff0000u), __builtin_bit_cast(float, w0.w << 16), __builtin_bit_cast(float, w0.w & 0xffff0000u)} + a1;
                    ss += ((o0[0] * o0[0] + o0[1] * o0[1]) + (o0[2] * o0[2] + o0[3] * o0[3])) + ((o1[0] * o1[0] + o1[1] * o1[1]) + (o1[2] * o1[2] + o1[3] * o1[3]));
                    u32x4 w; w.x = cvt_pk_bf16(o0[0], o0[1]); w.y = cvt_pk_bf16(o0[2], o0[3]); w.z = cvt_pk_bf16(o1[0], o1[1]); w.w = cvt_pk_bf16(o1[2], o1[3]); *(PG8_GAS u32x4*)(sp + bj * HALF) = w;
                    if constexpr (QOUT > 0) { u32x2 q; q.x = q8x4c<DIG ? 247 : 255>(o0[0], o0[1], o0[2], o0[3], qv[m]); q.y = q8x4c<DIG ? 247 : 255>(o1[0], o1[1], o1[2], o1[3], qv[m]); *(PG8_GAS u32x2*)(q8 + (size_t)row * ldc + col0 + bj * HALF) = q;
                        if constexpr (DIG) { const size_t db = (size_t)row * 1024 + ((col0 + bj * HALF) >> 1);
                            *(PG8_GAS unsigned*)(dgl + db) = nib_pack8(dig_lo4(q.x), dig_lo4(q.y)); *(PG8_GAS unsigned*)(dgh + db) = nib_pack8(dig_hi4(q.x), dig_hi4(q.y)); } } }
                ss += shx(ss, 16, fr + 16 * fq); ss += shx(ss, 32, fr + 16 * fq);
                if (fq == 0) (void)__hip_atomic_fetch_add((PG8_GAS u64_t*)(rowsq + row), rowsq_fx(ss), __ATOMIC_RELAXED, __HIP_MEMORY_SCOPE_AGENT); }
            __builtin_amdgcn_sched_barrier(0);
        }
    }
};
template <int QIN>
struct EpiBf16Row8 {
    static constexpr bool PERM = true, AFTER_DRAIN = false, KSCALE = false, I8 = true;
    bf16_t* O; int ldc; const u64_t* rowsq; const u64_t* rowsq_prev; const float* wsc;
    __device__ __forceinline__ void operator()(const f32x4 (&acc)[2][2][4][2], const Unit& u, int wr, int wc, int fr, int fq) const {
        const int row0 = u.pm * BM + wr * 64 + fr, col0 = u.pn * BM + wc * 32 + 8 * fq;
        float rs[2][4]; f32x4 wv[2][2];
#pragma unroll
        for (int ai = 0; ai < 2; ++ai)
#pragma unroll
            for (int m = 0; m < 4; ++m) { const int row = row0 + ai * HALF + m * 16; rs[ai][m] = rowsq_rs(rowsq, row) * (QIN / 127.0f) / rowsq_rs(rowsq_prev, row); }
#pragma unroll
        for (int bj = 0; bj < 2; ++bj) { wv[bj][0] = *(const PG8_GAS f32x4*)(wsc + col0 + bj * HALF); wv[bj][1] = *(const PG8_GAS f32x4*)(wsc + col0 + bj * HALF + 4); }
        __builtin_amdgcn_sched_barrier(0);
#pragma unroll
        for (int ai = 0; ai < 2; ++ai)
#pragma unroll
            for (int m = 0; m < 4; ++m) { const int row = row0 + ai * HALF + m * 16; bf16_t* rowp = O + (size_t)row * ldc + col0;
#pragma unroll
                for (int bj = 0; bj < 2; ++bj) { const i32x4 i0 = __builtin_bit_cast(i32x4, acc[ai][bj][m][0]), i1 = __builtin_bit_cast(i32x4, acc[ai][bj][m][1]);
                    const f32x4 v0 = (f32x4){(float)i0[0], (float)i0[1], (float)i0[2], (float)i0[3]} * wv[bj][0] * rs[ai][m], v1 = (f32x4){(float)i1[0], (float)i1[1], (float)i1[2], (float)i1[3]} * wv[bj][1] * rs[ai][m];
                    u32x4 w; w.x = cvt_pk_bf16(v0[0], v0[1]); w.y = cvt_pk_bf16(v0[2], v0[3]); w.z = cvt_pk_bf16(v1[0], v1[1]); w.w = cvt_pk_bf16(v1[2], v1[3]);
                    *(PG8_GAS u32x4*)(rowp + bj * HALF) = w; } }
    }
};
struct EpiResidMix {
    static constexpr bool PERM = false, AFTER_DRAIN = false, KSCALE = true, I8 = false; static constexpr int KS0 = 12, KS1 = 20;
    bf16_t* s; int ldc; u64_t* rowsq; const PG8_LAS float* ftab; const PG8_LAS int* pmtab;
    __device__ __forceinline__ int slot(int pm) const { return pmtab[0] == pm ? 0 : (pmtab[1] == pm ? 1 : (pmtab[2] == pm ? 2 : 3)); }
    __device__ __forceinline__ void kscale(f32x4 (&acc)[2][2][4][2], const Unit& u, int which, int wr, int fr) const {
        const PG8_LAS float* ft = ftab + which * 1024 + slot(u.pm) * 256;
#pragma unroll
        for (int ai = 0; ai < 2; ++ai)
#pragma unroll
            for (int m = 0; m < 4; ++m) { const float f = ft[ai * HALF + wr * 64 + m * 16 + fr];
#pragma unroll
                for (int bj = 0; bj < 2; ++bj)
#pragma unroll
                    for (int n = 0; n < 2; ++n) acc[ai][bj][m][n] = acc[ai][bj][m][n] * f; }
    }
    __device__ __forceinline__ void operator()(const f32x4 (&acc)[2][2][4][2], const Unit& u, int wr, int wc, int fr, int fq) const {
        const int col0 = u.pn * BM + wc * 32 + 4 * fq;
#pragma unroll
        for (int ai = 0; ai < 2; ++ai)
#pragma unroll
            for (int m = 0; m < 4; ++m) { const int row = u.pm * BM + ai * HALF + wr * 64 + m * 16 + fr; bf16_t* sp = s + (size_t)row * ldc + col0; float ss = 0.f; const float rc = ftab[2048 + slot(u.pm) * 256 + ai * HALF + wr * 64 + m * 16 + fr];
                u32x2 in[2][2];
#pragma unroll
                for (int bj = 0; bj < 2; ++bj)
#pragma unroll
                    for (int n = 0; n < 2; ++n) in[bj][n] = *(const PG8_GAS u32x2*)(sp + bj * HALF + n * 16);
#pragma unroll
                for (int bj = 0; bj < 2; ++bj)
#pragma unroll
                    for (int n = 0; n < 2; ++n) { const u32x2 w0 = in[bj][n];
                        const f32x4 bs = (f32x4){__builtin_bit_cast(float, w0.x << 16), __builtin_bit_cast(float, w0.x & 0xffff0000u), __builtin_bit_cast(float, w0.y << 16), __builtin_bit_cast(float, w0.y & 0xffff0000u)};
                        const f32x4 o = bs + acc[ai][bj][m][n] * rc; ss += (o[0] * o[0] + o[1] * o[1]) + (o[2] * o[2] + o[3] * o[3]);
                        u32x2 w; w.x = cvt_pk_bf16(o[0], o[1]); w.y = cvt_pk_bf16(o[2], o[3]); *(PG8_GAS u32x2*)(sp + bj * HALF + n * 16) = w; }
                ss += shx(ss, 16, fr + 16 * fq); ss += shx(ss, 32, fr + 16 * fq);
                if (fq == 0) (void)__hip_atomic_fetch_add((PG8_GAS u64_t*)(rowsq + row), rowsq_fx(ss), __ATOMIC_RELAXED, __HIP_MEMORY_SCOPE_AGENT); }
    }
};
struct EpiBf16Row {
    static constexpr bool PERM = true, AFTER_DRAIN = false, KSCALE = false, I8 = false;
    bf16_t* O; int ldc; const u64_t* rowsq;
    __device__ __forceinline__ void operator()(const f32x4 (&acc)[2][2][4][2], const Unit& u, int wr, int wc, int fr, int fq) const {
        const int row0 = u.pm * BM + wr * 64 + fr, col0 = u.pn * BM + wc * 32 + 8 * fq;
#pragma unroll
        for (int ai = 0; ai < 2; ++ai)
#pragma unroll
            for (int m = 0; m < 4; ++m) { const int row = row0 + ai * HALF + m * 16; const float rs = rowsq_rs(rowsq, row); bf16_t* rowp = O + (size_t)row * ldc + col0;
#pragma unroll
                for (int bj = 0; bj < 2; ++bj) { const f32x4 v0 = acc[ai][bj][m][0] * rs, v1 = acc[ai][bj][m][1] * rs; u32x4 w; w.x = cvt_pk_bf16(v0[0], v0[1]); w.y = cvt_pk_bf16(v0[2], v0[3]); w.z = cvt_pk_bf16(v1[0], v1[1]); w.w = cvt_pk_bf16(v1[2], v1[3]);
                    *(PG8_GAS u32x4*)(rowp + bj * HALF) = w; } }
    }
};
struct EpiQKV {
    static constexpr bool PERM = false, AFTER_DRAIN = false, KSCALE = false, I8 = true;
    bf16_t* O; const float* ga; const float* gb; const float* gc; const PG8_LAS float* rope; const u64_t* rowsq; const float* xsc; const float* wsc;
    __device__ __forceinline__ void operator()(const f32x4 (&acc)[2][2][4][2], const Unit& u, int wr, int wc, int fr, int fq) const {
        const int hg = u.pn * 4 + wc;
        const float* g = nullptr; bool isq = false, dorope = false;
        if (hg < 12) { g = ga; isq = true; } else if (hg < 16) { g = ga + 64; } else if (hg < 20) { }
        else if (hg < 28) { g = gb; isq = true; } else if (hg < 36) { g = gb + 64; } else if (hg < 44) { }
        else if (hg < 56) { g = gc; isq = true; dorope = true; } else if (hg < 60) { g = gc + 64; dorope = true; }
        const float qs = isq ? 0.18033688011112042f : 1.0f;
        float rsxa[2][4]; f32x4 wv[2][2], gv[2][2];
#pragma unroll
        for (int ai = 0; ai < 2; ++ai)
#pragma unroll
            for (int m = 0; m < 4; ++m) { const int row = u.pm * BM + ai * HALF + wr * 64 + m * 16 + fr; rsxa[ai][m] = *(const PG8_GAS float*)(xsc + row); }
#pragma unroll
        for (int bj = 0; bj < 2; ++bj)
#pragma unroll
            for (int n = 0; n < 2; ++n) { wv[bj][n] = *(const PG8_GAS f32x4*)(wsc + hg * 64 + 32 * bj + 16 * n + 4 * fq); gv[bj][n] = g ? *(const PG8_GAS f32x4*)(g + 32 * bj + 16 * n + 4 * fq) : (f32x4){1.f, 1.f, 1.f, 1.f}; }
        __builtin_amdgcn_sched_barrier(0);
#pragma unroll
        for (int ai = 0; ai < 2; ++ai)
#pragma unroll
            for (int m = 0; m < 4; ++m) {
                const int row = u.pm * BM + ai * HALF + wr * 64 + m * 16 + fr;
                f32x4 v[2][2];
                const float rsx = rsxa[ai][m];
#pragma unroll
                for (int bj = 0; bj < 2; ++bj)
#pragma unroll
                    for (int n = 0; n < 2; ++n) { const i32x4 ia = __builtin_bit_cast(i32x4, acc[ai][bj][m][n]);
                        v[bj][n] = (f32x4){(float)ia[0], (float)ia[1], (float)ia[2], (float)ia[3]} * wv[bj][n] * rsx; }
                if (g) {
                    float ss = 0.f;
#pragma unroll
                    for (int bj = 0; bj < 2; ++bj)
#pragma unroll
                        for (int n = 0; n < 2; ++n) { const f32x4 x = v[bj][n]; ss += (x[0] * x[0] + x[1] * x[1]) + (x[2] * x[2] + x[3] * x[3]); }
                    ss += shx(ss, 16, fr + 16 * fq); ss += shx(ss, 32, fr + 16 * fq);
                    const float r = qs / sqrtf(ss * (1.0f / 64.0f) + 1e-6f);
#pragma unroll
                    for (int bj = 0; bj < 2; ++bj)
#pragma unroll
                        for (int n = 0; n < 2; ++n) v[bj][n] = v[bj][n] * gv[bj][n] * r;
                }
                if (dorope) {
                    const int t = row & 2047, pr = t >> 6, pc = t & 63;
#pragma unroll
                    for (int bj = 0; bj < 2; ++bj) {
                        const int pos = bj ? pc : pr;
                        const PG8_LAS float* rp = rope + (pos * 16 + 4 * fq) * 2;
                        const f32x4 c01 = *(const PG8_LAS f32x4*)rp, c23 = *(const PG8_LAS f32x4*)(rp + 4);
                        const f32x4 cs = (f32x4){c01[0], c01[2], c23[0], c23[2]}, sn = (f32x4){c01[1], c01[3], c23[1], c23[3]};
                        const f32x4 x1 = v[bj][0], x2 = v[bj][1];
                        v[bj][0] = x1 * cs - x2 * sn; v[bj][1] = x1 * sn + x2 * cs;
                    }
                }
                bf16_t* rowp = O + (size_t)row * 4096 + hg * 64 + 4 * fq;
#pragma unroll
                for (int bj = 0; bj < 2; ++bj)
#pragma unroll
                    for (int n = 0; n < 2; ++n) { u32x2 w; w.x = cvt_pk_bf16(v[bj][n][0], v[bj][n][1]); w.y = cvt_pk_bf16(v[bj][n][2], v[bj][n][3]); *(PG8_GAS u32x2*)(rowp + 32 * bj + 16 * n) = w; }
                asm volatile("" ::: "memory");
            }
    }
};
template <bool I8> __device__ __forceinline__ f32x4 mma16(const bf16x8 b, const bf16x8 a, const f32x4 c) {
    if constexpr (I8) return __builtin_bit_cast(f32x4, __builtin_amdgcn_mfma_i32_16x16x64_i8(__builtin_bit_cast(i32x4, b), __builtin_bit_cast(i32x4, a), __builtin_bit_cast(i32x4, c), 0, 0, 0));
    else return __builtin_amdgcn_mfma_f32_16x16x32_bf16(b, a, c, 0, 0, 0);
}
template <class Epi, class Sched, bool ALIGN_EPI = false, bool SP2 = false>
__device__ __forceinline__ void gemm_phase(PG8_LAS unsigned char* lds, const Gemm g, const Sched& S, const Epi& E, const int tid) {
    const int wid = __builtin_amdgcn_readfirstlane(tid >> 6), lane = tid & 63, wr = wid >> 2, wc = wid & 3, fr = lane & 15, fq = lane >> 4;
    const int K = g.K, nt = K / BK;
    unsigned voffA[2], voffB[2];
#pragma unroll
    for (int i = 0; i < 2; ++i) { int R, C; stage_rc(tid * 16 + i * 8192, R, C); const int Rb = Epi::PERM ? ((R & ~31) + perm32(R & 31)) : R;
        voffA[i] = (unsigned)(R * K + C) * 2u; voffB[i] = (unsigned)(Rb * K + C) * 2u; }
    const size_t kstep = (size_t)(BK * 2);
    const size_t hstep = (size_t)HALF * K * 2;
    const size_t tstep = 2 * hstep;
    const unsigned ldsw = (unsigned)wid * 1024u;
    const int aoff = lds_byte(wr * 64 + fr, fq * 8), boff = lds_byte(wc * 32 + fr, fq * 8);
#define PG8_SA(b, h) (((b) * 2 + (h)) * HTB)
#define PG8_SB(b, h) ((4 + (b) * 2 + (h)) * HTB)
#define PG8_STAGE(bufoff, gbase, voff) do { _Pragma("unroll") for (int _i = 0; _i < 2; ++_i) \
        __builtin_amdgcn_global_load_lds((const unsigned*)((const char*)(gbase) + (voff)[_i]), (PG8_LAS unsigned*)(lds + (bufoff) + ldsw + _i * 8192), 16, 0, 0); } while (0)
#define PG8_LDA(dst, b, h) do { _Pragma("unroll") for (int m = 0; m < 4; ++m) _Pragma("unroll") for (int k = 0; k < 2; ++k) dst[m][k] = *(const PG8_LAS bf16x8*)(lds + PG8_SA(b, h) + aoff + m * 2048 + k * 1024); } while (0)
#define PG8_LDB(dst, b, h) do { _Pragma("unroll") for (int n = 0; n < 2; ++n) _Pragma("unroll") for (int k = 0; k < 2; ++k) dst[n][k] = *(const PG8_LAS bf16x8*)(lds + PG8_SB(b, h) + boff + n * 2048 + k * 1024); } while (0)
#define PG8_MMA(ai, bj, At, Bt) do { __builtin_amdgcn_s_setprio(1); _Pragma("unroll") for (int m = 0; m < 4; ++m) _Pragma("unroll") for (int n = 0; n < 2; ++n) _Pragma("unroll") for (int k = 0; k < 2; ++k) \
        acc[ai][bj][m][n] = mma16<Epi::I8>(Bt[n][k], At[m][k], acc[ai][bj][m][n]); __builtin_amdgcn_s_setprio(0); } while (0)
#define PG8_WAIT_V(n) asm volatile("s_waitcnt vmcnt(" #n ")" ::: "memory")
#define PG8_WAIT_L(n) asm volatile("s_waitcnt lgkmcnt(" #n ")" ::: "memory")
#define PG8_BAR __builtin_amdgcn_s_barrier()
#define PG8_SCHED __builtin_amdgcn_sched_barrier(0)
    Unit cur, nxt; int ui = 0;
    if (!S.next(0, cur)) return;
    f32x4 acc[2][2][4][2];
#pragma unroll
    for (int a = 0; a < 2; ++a)
#pragma unroll
        for (int b = 0; b < 2; ++b)
#pragma unroll
            for (int m = 0; m < 4; ++m)
#pragma unroll
                for (int n = 0; n < 2; ++n) acc[a][b][m][n] = (f32x4){0.f, 0.f, 0.f, 0.f};
    bf16x8 At[4][2], B0[2][2], B1[2][2];
    const char* cA = (const char*)g.A + (size_t)cur.pm * tstep; const char* cB = (const char*)g.Bt + (size_t)cur.pn * tstep;
    S.a_ready(cur);
    if constexpr (SP2) {
        PG8_STAGE(PG8_SB(0, 0), cB, voffB); PG8_STAGE(PG8_SB(0, 1), cB + hstep, voffB); PG8_STAGE(PG8_SA(0, 0), cA, voffA); PG8_STAGE(PG8_SA(0, 1), cA + hstep, voffA);
        if (wr == 1) PG8_BAR;
        PG8_WAIT_V(2); PG8_BAR;
        PG8_STAGE(PG8_SB(1, 0), cB + kstep, voffB); PG8_STAGE(PG8_SA(1, 0), cA + kstep, voffA); PG8_STAGE(PG8_SB(1, 1), cB + hstep + kstep, voffB);
        PG8_WAIT_V(6); PG8_BAR;
    } else {
        PG8_STAGE(PG8_SB(0, 0), cB, voffB); PG8_STAGE(PG8_SA(0, 0), cA, voffA); PG8_STAGE(PG8_SB(0, 1), cB + hstep, voffB); PG8_STAGE(PG8_SA(0, 1), cA + hstep, voffA);
        if (wr == 1) PG8_BAR;
        PG8_WAIT_V(4); PG8_BAR;
        PG8_STAGE(PG8_SB(1, 0), cB + kstep, voffB); PG8_STAGE(PG8_SA(1, 0), cA + kstep, voffA); PG8_STAGE(PG8_SB(1, 1), cB + hstep + kstep, voffB);
        PG8_WAIT_V(6); PG8_BAR;
    }
    for (;;) {
        const bool has_next = S.next(ui + 1, nxt);
        const char* nA = has_next ? (const char*)g.A + (size_t)nxt.pm * tstep : cA; const char* nB = has_next ? (const char*)g.Bt + (size_t)nxt.pn * tstep : cB;
        for (int t = 0; t < nt; t += 2) {
            if constexpr (Epi::KSCALE) { if (t == Epi::KS0 || t == Epi::KS1) E.kscale(acc, cur, t == Epi::KS1 ? 1 : 0, wr, fr); }
            const bool last = (t == nt - 2);
            const char* a1 = cA + (size_t)(t + 1) * kstep;
            const char* a2 = last ? nA : cA + (size_t)(t + 2) * kstep; const char* b2 = last ? nB : cB + (size_t)(t + 2) * kstep;
            const char* a3 = a2 + kstep; const char* b3 = b2 + kstep;
            if (last && has_next) S.a_ready(nxt);
            if constexpr (SP2) {
            PG8_LDB(B0, 0, 0); PG8_LDB(B1, 0, 1); PG8_SCHED; PG8_LDA(At, 0, 0); PG8_STAGE(PG8_SA(1, 1), a1 + hstep, voffA);
            PG8_WAIT_V(8); PG8_WAIT_L(0); PG8_BAR; PG8_MMA(0, 0, At, B0); PG8_MMA(0, 1, At, B1); PG8_BAR; PG8_SCHED;
            PG8_LDA(At, 0, 1); PG8_STAGE(PG8_SB(0, 0), b2, voffB); PG8_STAGE(PG8_SB(0, 1), b2 + hstep, voffB); PG8_STAGE(PG8_SA(0, 0), a2, voffA);
            PG8_WAIT_V(8); PG8_WAIT_L(0); PG8_BAR; PG8_MMA(1, 0, At, B0); PG8_MMA(1, 1, At, B1); PG8_BAR; PG8_SCHED;
            PG8_LDB(B0, 1, 0); PG8_LDB(B1, 1, 1); PG8_SCHED; PG8_LDA(At, 1, 0); PG8_STAGE(PG8_SA(0, 1), a2 + hstep, voffA);
            PG8_WAIT_V(8); PG8_WAIT_L(0); PG8_BAR; PG8_MMA(0, 0, At, B0); PG8_MMA(0, 1, At, B1); PG8_BAR; PG8_SCHED;
            PG8_LDA(At, 1, 1); PG8_STAGE(PG8_SB(1, 0), b3, voffB); PG8_STAGE(PG8_SB(1, 1), b3 + hstep, voffB); PG8_STAGE(PG8_SA(1, 0), a3, voffA);
            PG8_WAIT_V(8); PG8_WAIT_L(0); PG8_BAR; PG8_MMA(1, 0, At, B0); PG8_MMA(1, 1, At, B1); PG8_BAR; PG8_SCHED;
            } else {
            PG8_LDB(B0, 0, 0); PG8_SCHED; PG8_LDA(At, 0, 0); PG8_STAGE(PG8_SA(1, 1), a1 + hstep, voffA);
            PG8_WAIT_L(8); PG8_BAR; PG8_WAIT_L(0); PG8_MMA(0, 0, At, B0); PG8_BAR; PG8_SCHED;
            PG8_LDB(B1, 0, 1); PG8_STAGE(PG8_SB(0, 0), b2, voffB);
            PG8_BAR; PG8_WAIT_L(0); PG8_MMA(0, 1, At, B1); PG8_BAR;
            PG8_LDA(At, 0, 1); PG8_STAGE(PG8_SA(0, 0), a2, voffA);
            PG8_BAR; PG8_WAIT_L(0); PG8_MMA(1, 0, At, B0); PG8_BAR; PG8_SCHED;
            PG8_STAGE(PG8_SB(0, 1), b2 + hstep, voffB);
            PG8_WAIT_V(6); PG8_BAR; PG8_MMA(1, 1, At, B1); PG8_BAR;
            PG8_LDB(B0, 1, 0); PG8_SCHED; PG8_LDA(At, 1, 0); PG8_STAGE(PG8_SA(0, 1), a2 + hstep, voffA);
            PG8_WAIT_L(8); PG8_BAR; PG8_WAIT_L(0); PG8_MMA(0, 0, At, B0); PG8_BAR; PG8_SCHED;
            PG8_LDB(B1, 1, 1); PG8_STAGE(PG8_SB(1, 0), b3, voffB);
            PG8_BAR; PG8_WAIT_L(0); PG8_MMA(0, 1, At, B1); PG8_BAR;
            PG8_LDA(At, 1, 1); PG8_STAGE(PG8_SA(1, 0), a3, voffA);
            PG8_BAR; PG8_WAIT_L(0); PG8_MMA(1, 0, At, B0); PG8_BAR; PG8_SCHED;
            PG8_STAGE(PG8_SB(1, 1), b3 + hstep, voffB);
            PG8_WAIT_V(6); PG8_BAR; PG8_MMA(1, 1, At, B1); PG8_BAR;
            }
        }
        if constexpr (ALIGN_EPI) { if (wr == 0) PG8_BAR; }
        if constexpr (!Epi::AFTER_DRAIN) { E(acc, cur, wr, wc, fr, fq); S.done(cur); }
        if (!has_next) break;
#pragma unroll
        for (int a = 0; a < 2; ++a)
#pragma unroll
            for (int b = 0; b < 2; ++b)
#pragma unroll
                for (int m = 0; m < 4; ++m)
#pragma unroll
                    for (int n = 0; n < 2; ++n) acc[a][b][m][n] = (f32x4){0.f, 0.f, 0.f, 0.f};
        cur = nxt; cA = nA; cB = nB; ++ui;
        if constexpr (ALIGN_EPI) { if (wr == 1) PG8_BAR; }
    }
    PG8_WAIT_V(0);
    if constexpr (!ALIGN_EPI) { if (wr == 0) PG8_BAR; }
    PG8_BAR;
    if constexpr (Epi::AFTER_DRAIN) { E.fused(acc, cur, wr, wc, fr, fq, lds, wid, lane); S.done(cur); }
#undef PG8_SA
#undef PG8_SB
#undef PG8_STAGE
#undef PG8_LDA
#undef PG8_LDB
#undef PG8_MMA
#undef PG8_WAIT_V
#undef PG8_WAIT_L
#undef PG8_BAR
#undef PG8_SCHED
}
}

constexpr int BATCH = 16, SEQ = 2048, DM = 2048, T = BATCH * SEQ, DEPTH = 2;
constexpr int NMEM = 256, DIN = 4096, MEMW = 512;
constexpr int PEER_H = 8, PEER_N = 16384;
constexpr int NWAVES = 8, NTHREADS = NWAVES * 64;
constexpr float EPS = 1e-6f;
constexpr int QA = 0, KA = 768, VA = 1024, QB = 1280, KB = 1792, VB = 2304, QC = 2816, KC = 3584, VC = 3840;
constexpr int OA = 0, OB = 768, OC = 1280;

constexpr size_t MiB = 1u << 20;
constexpr size_t WS_CTL = 0, CTL_ZERO_BYTES = 2 * MiB;
constexpr size_t WS_ROWSQ = 256 * 1024;
constexpr size_t WS_ROPE = 83 * MiB, WS_BIASA = 83 * MiB + 16384;
constexpr size_t WS_WIN = 2 * MiB, WS_WOUT = 34 * MiB, WS_WMQ = 50 * MiB, WS_WMKV = 54 * MiB, WS_WMO = 62 * MiB, WS_WPQ = 66 * MiB, WS_PKEYS = 82 * MiB;
constexpr size_t WS_MEMN = 84 * MiB, WS_KVM = 116 * MiB, WS_PU = 132 * MiB, WS_PV = 260 * MiB, WS_XN = 388 * MiB, WS_QKV = 516 * MiB, WS_ATT = 772 * MiB;
constexpr size_t WS_QM = 900 * MiB, WS_OM = 932 * MiB, WS_MIXSQ = 964 * MiB, MIXSQ_BYTES = 2 * MiB, WS_WIN8 = 966 * MiB, WS_WSC = 982 * MiB, WS_XSC = 982 * MiB + 65536, WS_XSC2 = 982 * MiB + 196608, WS_WSCO = 982 * MiB + 327680, WS_WSCP = 982 * MiB + 344064, WS_WSCM = 982 * MiB + 360448,
                 WS_WOUT8 = 984 * MiB, WS_WPQ8 = 992 * MiB, WS_WMQ8 = 1000 * MiB, WS_END = 1002 * MiB;
constexpr size_t WS_QP = WS_QKV, WS_PIDX = WS_QKV + 128 * MiB, WS_PGATE = WS_QKV + 144 * MiB, WS_PARTI = WS_QKV + 160 * MiB;
constexpr size_t WS_XQH = 836 * MiB, WS_XQL = 868 * MiB;
constexpr size_t WS_XQH_OLD = 900 * MiB, WS_XQL_OLD = 932 * MiB;
constexpr size_t WS_ATT8 = 900 * MiB;
constexpr size_t WS_X8 = 772 * MiB;
constexpr size_t WS_XN8 = 836 * MiB;
constexpr int CW_BAR = 4096;

constexpr int RING_OFF = 0, RING_BYTES = 131072;
constexpr int LDSCTL_OFF = RING_BYTES, MISC_OFF = LDSCTL_OFF + 320;
constexpr int LDS_BYTES = 147456;

#define GAS __attribute__((address_space(1)))
#define LAS __attribute__((address_space(3)))
typedef unsigned short bf16;
typedef unsigned v4u __attribute__((ext_vector_type(4)));
typedef unsigned v2u __attribute__((ext_vector_type(2)));
typedef float f32x4 __attribute__((ext_vector_type(4)));
typedef float f32x16 __attribute__((ext_vector_type(16)));
typedef short bf16x8 __attribute__((ext_vector_type(8)));
typedef GAS unsigned gu32;
#define LDS_WAIT() asm volatile("s_waitcnt lgkmcnt(0)" ::: "memory")
#define VM_WAIT() asm volatile("s_waitcnt vmcnt(0)" ::: "memory")
__device__ __forceinline__ unsigned f2bf(float f) { unsigned u = __builtin_bit_cast(unsigned, f); return (u + 0x7fffu + ((u >> 16) & 1u)) >> 16; }
__device__ __forceinline__ unsigned pk2(float lo, float hi) { return f2bf(lo) | (f2bf(hi) << 16); }
__device__ __forceinline__ float bflo(unsigned w) { return __builtin_bit_cast(float, w << 16); }
__device__ __forceinline__ float bfhi(unsigned w) { return __builtin_bit_cast(float, w & 0xffff0000u); }

__device__ __forceinline__ float shx(float v, int k, int lane) { return __builtin_bit_cast(float, __builtin_amdgcn_ds_bpermute((lane ^ k) << 2, __builtin_bit_cast(int, v))); }
#define XB_TMO      128
#define XB_XCNT(j)  (256  + 64 * (j))
#define XB_XSUB(j)  (1280 + 64 * (j))
#define XB_XGEN(j)  (2304 + 64 * (j))
#define XB_TOP      3328
#define XB_TOPGEN   3392
#define XCD_BAR_WORDS 3456
#define XB_SPIN_CAP (1u << 18)

__device__ __forceinline__ unsigned xb_ld(unsigned* p)              { return __hip_atomic_load(p, __ATOMIC_RELAXED, __HIP_MEMORY_SCOPE_AGENT); }
__device__ __forceinline__ unsigned xb_add(unsigned* p, unsigned v) { return __hip_atomic_fetch_add(p, v, __ATOMIC_RELAXED, __HIP_MEMORY_SCOPE_AGENT); }
__device__ __forceinline__ unsigned xb_xcc_id() { return (unsigned)__builtin_amdgcn_s_getreg((3 << 11) | 20) & 0xFu; }
#define XB_SPIN(cond, bar) do { unsigned _sp = 0; while (cond) { __builtin_amdgcn_s_sleep(1); \
    if ((++_sp & 255u) == 0u) { if (xb_ld(&(bar)[XB_TMO])) break; if (_sp > XB_SPIN_CAP) { atomicAdd(&(bar)[XB_TMO], 1u); break; } } } } while (0)

struct XcdBarrier {
    unsigned* bar; unsigned x;
    volatile LAS unsigned* st;
};

__device__ __forceinline__ XcdBarrier xcd_barrier_post(unsigned* bar, volatile LAS unsigned* st) {
    XcdBarrier b; b.bar = bar; b.x = xb_xcc_id(); b.st = st;
    if (threadIdx.x == 0) (void)xb_add(&bar[XB_XCNT(b.x)], 1u);
    return b;
}
__device__ __forceinline__ void xcd_barrier_complete(unsigned* bar, unsigned x, unsigned& nloc, unsigned& nx) {
    const unsigned G = gridDim.x * gridDim.y * gridDim.z;
    unsigned sum, cnt, mine, sp = 0u;
    for (;;) {
        sum = 0u; cnt = 0u; mine = 0u;
#pragma unroll
        for (unsigned j = 0; j < 16; ++j) { const unsigned c = xb_ld(&bar[XB_XCNT(j)]); sum += c; cnt += (c > 0u) ? 1u : 0u; mine = (j == x) ? c : mine; }
        if (sum == G) break;
        __builtin_amdgcn_s_sleep(1);
        if ((++sp & 255u) == 0u) { if (xb_ld(&bar[XB_TMO])) break; if (sp > XB_SPIN_CAP) { atomicAdd(&bar[XB_TMO], 1u); break; } }
    }
    nloc = mine > 0u ? mine : 1u; nx = cnt > 0u ? cnt : 1u;
}

__device__ __forceinline__ void xcd_barrier(const XcdBarrier& b) {
    asm volatile("s_waitcnt vmcnt(0)" ::: "memory");
    __syncthreads();
    if (threadIdx.x == 0) {
        unsigned* bar = b.bar;
        __builtin_amdgcn_s_waitcnt(0);
        unsigned nloc = b.st[0], nx = b.st[1];
        if (nloc == 0u) { xcd_barrier_complete(bar, b.x, nloc, nx); b.st[0] = nloc; b.st[1] = nx; }
        const unsigned old = xb_add(&bar[XB_XSUB(b.x)], 1u);
        const unsigned gen = old / nloc;
        if (old + 1u == (gen + 1u) * nloc) {
            __builtin_amdgcn_fence(__ATOMIC_RELEASE, "agent");
            asm volatile("s_waitcnt vmcnt(0)" ::: "memory");
            const unsigned og = xb_add(&bar[XB_TOP], 1u);
            const unsigned tg = og / nx;
            if (og + 1u == (tg + 1u) * nx) xb_add(&bar[XB_TOPGEN], 1u);
            else XB_SPIN(xb_ld(&bar[XB_TOPGEN]) == tg, bar);
            __builtin_amdgcn_fence(__ATOMIC_ACQUIRE, "agent");
            xb_add(&bar[XB_XGEN(b.x)], 1u);
            asm volatile("s_waitcnt vmcnt(0)" ::: "memory");
        } else {
            XB_SPIN(xb_ld(&bar[XB_XGEN(b.x)]) == gen, bar);
            __builtin_amdgcn_fence(__ATOMIC_ACQUIRE, "agent");
            asm volatile("s_waitcnt vmcnt(0)" ::: "memory");
        }
    }
    __syncthreads();
}

__device__ __forceinline__ float wave_sum(float v, int lane) {
#pragma unroll
    for (int o = 1; o < 64; o <<= 1) v += shx(v, o, lane);
    return v;
}
__device__ __forceinline__ void* ldptr(LAS unsigned char* lds, int i) {
    const unsigned long long v = ((const LAS unsigned long long*)(lds + LDSCTL_OFF + 1024))[i];
    const unsigned lo = __builtin_amdgcn_readfirstlane((unsigned)v), hi = __builtin_amdgcn_readfirstlane((unsigned)(v >> 32));
    return (void*)(((unsigned long long)hi << 32) | lo);
}
struct OffsetOrder {
    pg8::StaticOrder S;
    __device__ __forceinline__ void init(int M, int N, int G, int c, int off) { S.init(M, N, G, (c + G - off % G) % G); }
    __device__ __forceinline__ bool next(int i, pg8::Unit& u) const { return S.next(i, u); }
    __device__ __forceinline__ void a_ready(const pg8::Unit&) const {}
    __device__ __forceinline__ void done(const pg8::Unit&) const {}
};

template <bool PERMQKV>
__device__ __forceinline__ void transpose_item(const float* W, int K, int N, bf16* WT, LAS float* scr, int item, int lane, const float* gk = nullptr) {
    const int nblk = N / 32, kb = item / nblk, nb = item % nblk, k0 = 64 * kb, n0 = 32 * nb;
    int d0 = n0;
    if (PERMQKV) { const int within = n0 & 255; d0 = (n0 & ~255) + 128 * ((within >> 5) & 1) + 32 * (within >> 6); }
#pragma unroll
    for (int i = 0; i < 8; ++i) { const int kk = 8 * i + (lane >> 3), nn = 4 * (lane & 7);
        const f32x4 w4 = *(const GAS f32x4*)(W + (size_t)(k0 + kk) * N + n0 + nn) * (gk ? gk[k0 + kk] : 1.f);
        scr[kk * 33 + nn] = w4[0]; scr[kk * 33 + nn + 1] = w4[1]; scr[kk * 33 + nn + 2] = w4[2]; scr[kk * 33 + nn + 3] = w4[3]; }
    LDS_WAIT(); asm volatile("" ::: "memory");
    const int c = lane & 7;
#pragma unroll
    for (int j = 0; j < 4; ++j) { const int n = (lane >> 3) + 8 * j; const LAS float* s = scr + (8 * c) * 33 + n;
        v4u o; o.x = pk2(s[0 * 33], s[1 * 33]); o.y = pk2(s[2 * 33], s[3 * 33]); o.z = pk2(s[4 * 33], s[5 * 33]); o.w = pk2(s[6 * 33], s[7 * 33]);
        *(GAS v4u*)(WT + (size_t)(d0 + n) * K + k0 + 8 * c) = o; }
    LDS_WAIT(); asm volatile("" ::: "memory");
}
__device__ __forceinline__ void convert_bf16(const float* src, bf16* dst, size_t n, size_t gtid, size_t nthreads) {
    for (size_t i = gtid * 8; i < n; i += nthreads * 8) {
        const f32x4 a = *(const GAS f32x4*)(src + i), b = *(const GAS f32x4*)(src + i + 4);
        v4u o; o.x = pk2(a[0], a[1]); o.y = pk2(a[2], a[3]); o.z = pk2(b[0], b[1]); o.w = pk2(b[2], b[3]);
        *(GAS v4u*)(dst + i) = o;
    }
}
__device__ __forceinline__ int t5_bucket(int rel) {
    const int n = rel < 0 ? -rel : rel;
    const int b = n < 8 ? n : n < 12 ? 8 : n < 16 ? 9 : n < 23 ? 10 : n < 32 ? 11 : n < 46 ? 12 : n < 64 ? 13 : n < 91 ? 14 : 15;
    return b + (rel > 0 ? 16 : 0);
}
__constant__ float ROPE_INV[16] = {1.000000000e+00f, 5.623413324e-01f, 3.162277639e-01f, 1.778279394e-01f, 1.000000015e-01f, 5.623413250e-02f, 3.162277490e-02f, 1.778279431e-02f,
                                   9.999999776e-03f, 5.623413250e-03f, 3.162277630e-03f, 1.778279431e-03f, 1.000000047e-03f, 5.623413017e-04f, 3.162277571e-04f, 1.778279402e-04f};

__device__ __forceinline__ void rms_row_to_bf16(const float* xrow, const float* g0, bf16* o0, const float* g1, bf16* o1, int lane) {
    const GAS f32x4* xr = (const GAS f32x4*)xrow + lane;
    f32x4 v[8]; float s = 0.f;
#pragma unroll
    for (int j = 0; j < 8; ++j) { v[j] = xr[64 * j]; s += (v[j].x * v[j].x + v[j].y * v[j].y) + (v[j].z * v[j].z + v[j].w * v[j].w); }
    const float rstd = 1.f / sqrtf(wave_sum(s, lane) * (1.f / DM) + EPS);
    {   const GAS f32x4* gr = (const GAS f32x4*)g0 + lane; GAS v2u* o8 = (GAS v2u*)o0 + lane;
#pragma unroll
        for (int j = 0; j < 8; ++j) { const f32x4 gg = gr[64 * j]; v2u w; w.x = pk2(v[j].x * rstd * gg.x, v[j].y * rstd * gg.y); w.y = pk2(v[j].z * rstd * gg.z, v[j].w * rstd * gg.w); o8[64 * j] = w; } }
    if (g1) { const GAS f32x4* gr = (const GAS f32x4*)g1 + lane; GAS v2u* o8 = (GAS v2u*)o1 + lane;
#pragma unroll
        for (int j = 0; j < 8; ++j) { const f32x4 gg = gr[64 * j]; v2u w; w.x = pk2(v[j].x * rstd * gg.x, v[j].y * rstd * gg.y); w.y = pk2(v[j].z * rstd * gg.z, v[j].w * rstd * gg.w); o8[64 * j] = w; } }
}
__device__ __forceinline__ float wave_max(float v, int lane) {
#pragma unroll
    for (int o = 1; o < 64; o <<= 1) v = fmaxf(v, shx(v, o, lane));
    return v;
}
__device__ __forceinline__ unsigned q8x4(const f32x4 v, const float inv) {
    unsigned w = 0;
    w = __builtin_amdgcn_cvt_pk_u8_f32(__builtin_rintf(__builtin_fmaf(v[0], inv, 128.f)), 0, w); w = __builtin_amdgcn_cvt_pk_u8_f32(__builtin_rintf(__builtin_fmaf(v[1], inv, 128.f)), 1, w);
    w = __builtin_amdgcn_cvt_pk_u8_f32(__builtin_rintf(__builtin_fmaf(v[2], inv, 128.f)), 2, w); w = __builtin_amdgcn_cvt_pk_u8_f32(__builtin_rintf(__builtin_fmaf(v[3], inv, 128.f)), 3, w);
    return w ^ 0x80808080u;
}
__device__ __forceinline__ float amax4(const f32x4 v) { return fmaxf(fmaxf(fabsf(v[0]), fabsf(v[1])), fmaxf(fabsf(v[2]), fabsf(v[3]))); }
__device__ __forceinline__ void quant_wrow(const bf16* src, unsigned char* dst, float* step, int lane) {
    v4u w[4]; float am = 0.f;
#pragma unroll
    for (int j = 0; j < 4; ++j) w[j] = *(const GAS v4u*)(src + 8 * lane + 512 * j);
    f32x4 lo[4], hi[4];
#pragma unroll
    for (int j = 0; j < 4; ++j) { lo[j] = (f32x4){bflo(w[j].x), bfhi(w[j].x), bflo(w[j].y), bfhi(w[j].y)}; hi[j] = (f32x4){bflo(w[j].z), bfhi(w[j].z), bflo(w[j].w), bfhi(w[j].w)}; am = fmaxf(am, fmaxf(amax4(lo[j]), amax4(hi[j]))); }
    am = fmaxf(wave_max(am, lane), 1e-30f);
    const float inv = 127.f / am;
#pragma unroll
    for (int j = 0; j < 4; ++j) *(GAS v2u*)(dst + 8 * lane + 512 * j) = (v2u){q8x4(lo[j], inv), q8x4(hi[j], inv)};
    if (lane == 0) *step = am * (1.f / 127.f);
}
template <int R>
__device__ __forceinline__ void att_quant_rows(const bf16* ATT, const u64_t* mixsq, unsigned char* Q, float* step, int row0, int lane) {
    v4u w[R][4];
#pragma unroll
    for (int q = 0; q < R; ++q)
#pragma unroll
        for (int j = 0; j < 4; ++j) w[q][j] = *(const GAS v4u*)(ATT + (size_t)(row0 + q) * DM + 8 * lane + 512 * j);
#pragma unroll
    for (int q = 0; q < R; ++q) { const int row = row0 + q;
        const float ra = 1.0f / sqrtf((float)*(const GAS u64_t*)(mixsq + row) * (5.9604644775390625e-08f / 768.0f) + EPS), rb = 1.0f / sqrtf((float)*(const GAS u64_t*)(mixsq + T + row) * (5.9604644775390625e-08f / 512.0f) + EPS),
                    rc = 1.0f / sqrtf((float)*(const GAS u64_t*)(mixsq + 2 * (size_t)T + row) * (5.9604644775390625e-08f / 768.0f) + EPS);
        const float rj[4] = {ra, lane < 32 ? ra : rb, lane < 32 ? rb : rc, rc};
        f32x4 lo[4], hi[4]; float am = 0.f;
#pragma unroll
        for (int j = 0; j < 4; ++j) { lo[j] = (f32x4){bflo(w[q][j].x), bfhi(w[q][j].x), bflo(w[q][j].y), bfhi(w[q][j].y)} * rj[j]; hi[j] = (f32x4){bflo(w[q][j].z), bfhi(w[q][j].z), bflo(w[q][j].w), bfhi(w[q][j].w)} * rj[j]; am = fmaxf(am, fmaxf(amax4(lo[j]), amax4(hi[j]))); }
        am = fmaxf(wave_max(am, lane), 1e-30f);
        const float inv = 127.f / am;
#pragma unroll
        for (int j = 0; j < 4; ++j) *(GAS v2u*)(Q + (size_t)row * DM + 8 * lane + 512 * j) = (v2u){q8x4(lo[j], inv), q8x4(hi[j], inv)};
        if (lane == 0) step[row] = am * (1.f / 127.f); }
}
__device__ __forceinline__ void prep_rows2(const float* x0, bf16* o0, u64_t* sq, unsigned char* q0, float* qstep, int lane) {
    f32x4 v[2][8];
#pragma unroll
    for (int q = 0; q < 2; ++q) { const GAS f32x4* xr = (const GAS f32x4*)(x0 + (size_t)q * DM) + lane;
#pragma unroll
        for (int j = 0; j < 8; ++j) v[q][j] = xr[64 * j]; }
#pragma unroll
    for (int q = 0; q < 2; ++q) { GAS v2u* o8 = (GAS v2u*)(o0 + (size_t)q * DM) + lane; float s = 0.f;
#pragma unroll
        for (int j = 0; j < 8; ++j) { const f32x4 a = v[q][j]; s += (a.x * a.x + a.y * a.y) + (a.z * a.z + a.w * a.w); v2u w; w.x = pk2(a.x, a.y); w.y = pk2(a.z, a.w); o8[64 * j] = w; }
        s = wave_sum(s, lane);
        float am = 0.f;
#pragma unroll
        for (int j = 0; j < 8; ++j) am = fmaxf(am, amax4(v[q][j]));
        am = fmaxf(wave_max(am, lane), 1e-30f);
        const float inv = 127.f / am;
#pragma unroll
        for (int j = 0; j < 8; ++j) *(GAS unsigned*)(q0 + (size_t)q * DM + 4 * lane + 256 * j) = q8x4(v[q][j], inv);
        if (lane == 0) { sq[q] = rowsq_fx(s); qstep[q] = am * (1.f / 127.f) / sqrtf(s * (1.f / DM) + 1e-6f); } }
}
__device__ __forceinline__ void norm_rows(const float* X, const float* g, bf16* XN, int gw, int NGW, int lane) {
    for (int m = gw; m < T; m += NGW) rms_row_to_bf16(X + (size_t)m * DM, g, XN + (size_t)m * DM, nullptr, nullptr, lane);
}

template <int TYPE>
__device__ __forceinline__ void naive_attn_item(const bf16* QKV, bf16* ATT, int b, int grow, int head, int lane, const float* biasA, const float* sink, const float* rpb) {
    const int tpos = grow * 64 + lane; const size_t trow = (size_t)b * SEQ + tpos;
    int qcol, kcol, vcol, ocol;
    if (TYPE == 0) { qcol = QA + head * 64; kcol = KA + (head / 3) * 64; vcol = VA + (head / 3) * 64; ocol = OA + head * 64; }
    else if (TYPE == 1) { qcol = QB + head * 64; kcol = KB + head * 64; vcol = VB + head * 64; ocol = OB + head * 64; }
    else { qcol = QC + head * 64; kcol = KC + (head / 3) * 64; vcol = VC + (head / 3) * 64; ocol = OC + head * 64; }
    float q[64], o[64];
#pragma unroll
    for (int c = 0; c < 8; ++c) { const v4u w = *(const GAS v4u*)(QKV + trow * DIN + qcol + 8 * c);
        q[8 * c + 0] = bflo(w.x); q[8 * c + 1] = bfhi(w.x); q[8 * c + 2] = bflo(w.y); q[8 * c + 3] = bfhi(w.y); q[8 * c + 4] = bflo(w.z); q[8 * c + 5] = bfhi(w.z); q[8 * c + 6] = bflo(w.w); q[8 * c + 7] = bfhi(w.w); }
#pragma unroll
    for (int d = 0; d < 64; ++d) o[d] = 0.f;
    float m = -1e30f, l = 0.f;
    int j0, j1;
    if (TYPE == 0) { j0 = grow * 64 - 128; if (j0 < 0) j0 = 0; j1 = grow * 64 + 63 + 128; if (j1 > SEQ - 1) j1 = SEQ - 1; }
    else if (TYPE == 1) { int r0 = grow - 4; r0 = r0 < 0 ? 0 : (r0 > 24 ? 24 : r0); j0 = r0 * 64; j1 = j0 + 511; }
    else { j0 = 0; j1 = SEQ - 1; }
    int c0 = lane - 8; c0 = c0 < 0 ? 0 : (c0 > 48 ? 48 : c0);
#pragma unroll 1
    for (int j = j0; j <= j1; ++j) {
        const bf16* krow = QKV + ((size_t)b * SEQ + j) * DIN;
        float s = 0.f;
#pragma unroll
        for (int c = 0; c < 8; ++c) { const v4u w = *(const GAS v4u*)(krow + kcol + 8 * c);
            s += q[8 * c + 0] * bflo(w.x) + q[8 * c + 1] * bfhi(w.x) + q[8 * c + 2] * bflo(w.y) + q[8 * c + 3] * bfhi(w.y) + q[8 * c + 4] * bflo(w.z) + q[8 * c + 5] * bfhi(w.z) + q[8 * c + 6] * bflo(w.w) + q[8 * c + 7] * bfhi(w.w); }
        bool valid = true;
        if (TYPE == 0) { const int rel = j - tpos; valid = (rel >= -128 && rel <= 128); if (valid) s += biasA[head * 257 + rel + 128]; }
        if (TYPE == 1) { const int kr = j >> 6, kc = j & 63; valid = (kc >= c0 && kc < c0 + 16); if (valid) s += rpb[(head * 15 + (kr - grow + 7)) * 31 + (kc - lane + 15)]; }
        const float mn = valid ? fmaxf(m, s) : m;
        const float a = __expf(m - mn);
        const float p = valid ? __expf(s - mn) : 0.f;
        l = l * a + p; m = mn;
#pragma unroll
        for (int c = 0; c < 8; ++c) { const v4u w = *(const GAS v4u*)(krow + vcol + 8 * c);
            o[8 * c + 0] = o[8 * c + 0] * a + p * bflo(w.x); o[8 * c + 1] = o[8 * c + 1] * a + p * bfhi(w.x); o[8 * c + 2] = o[8 * c + 2] * a + p * bflo(w.y); o[8 * c + 3] = o[8 * c + 3] * a + p * bfhi(w.y);
            o[8 * c + 4] = o[8 * c + 4] * a + p * bflo(w.z); o[8 * c + 5] = o[8 * c + 5] * a + p * bfhi(w.z); o[8 * c + 6] = o[8 * c + 6] * a + p * bflo(w.w); o[8 * c + 7] = o[8 * c + 7] * a + p * bfhi(w.w); }
    }
    if (TYPE == 0) l += __expf(sink[head] - m);
    const float inv = 1.f / l;
#pragma unroll
    for (int c = 0; c < 8; ++c) { v4u w; w.x = pk2(o[8 * c + 0] * inv, o[8 * c + 1] * inv); w.y = pk2(o[8 * c + 2] * inv, o[8 * c + 3] * inv); w.z = pk2(o[8 * c + 4] * inv, o[8 * c + 5] * inv); w.w = pk2(o[8 * c + 6] * inv, o[8 * c + 7] * inv);
        *(GAS v4u*)(ATT + trow * DM + ocol + 8 * c) = w; }
}
__device__ __forceinline__ float rdl(float v, int l) { return __builtin_bit_cast(float, __builtin_amdgcn_readlane(__builtin_bit_cast(int, v), l)); }
__device__ __forceinline__ void naive_mem_item(const bf16* QM, const bf16* KVM, bf16* OM, const float* gq, size_t trow, int b, int head, int lane) {
    const unsigned qw = *(const GAS unsigned*)(QM + trow * MEMW + head * 128 + 2 * lane);
    float q0 = bflo(qw), q1 = bfhi(qw);
    const float ss = wave_sum(q0 * q0 + q1 * q1, lane);
    const float r = 0.08838834764831845f / sqrtf(ss * (1.f / 128.f) + EPS);
    q0 *= r * gq[2 * lane]; q1 *= r * gq[2 * lane + 1];
    const bf16* kbase = KVM + ((size_t)b * NMEM + lane) * 1024 + head * 128;
    float s[4] = {0.f, 0.f, 0.f, 0.f};
#pragma unroll 1
    for (int c = 0; c < 16; ++c) {
        float qa[8];
#pragma unroll
        for (int e = 0; e < 4; ++e) { qa[2 * e] = rdl(q0, 4 * c + e); qa[2 * e + 1] = rdl(q1, 4 * c + e); }
#pragma unroll
        for (int i = 0; i < 4; ++i) { const v4u w = *(const GAS v4u*)(kbase + (size_t)i * 64 * 1024 + 8 * c);
            s[i] += qa[0] * bflo(w.x) + qa[1] * bfhi(w.x) + qa[2] * bflo(w.y) + qa[3] * bfhi(w.y) + qa[4] * bflo(w.z) + qa[5] * bfhi(w.z) + qa[6] * bflo(w.w) + qa[7] * bfhi(w.w); }
    }
    float m = fmaxf(fmaxf(s[0], s[1]), fmaxf(s[2], s[3]));
#pragma unroll
    for (int o = 1; o < 64; o <<= 1) m = fmaxf(m, shx(m, o, lane));
    float p[4]; float l = 0.f;
#pragma unroll
    for (int i = 0; i < 4; ++i) { p[i] = __expf(s[i] - m); l += p[i]; }
    l = wave_sum(l, lane);
    const bf16* vbase = KVM + ((size_t)b * NMEM) * 1024 + 512 + head * 128 + 2 * lane;
    float o0 = 0.f, o1 = 0.f;
#pragma unroll
    for (int i = 0; i < 4; ++i) {
#pragma unroll 4
        for (int jj = 0; jj < 64; ++jj) { const float pj = rdl(p[i], jj); const unsigned w = *(const GAS unsigned*)(vbase + (size_t)(64 * i + jj) * 1024); o0 += pj * bflo(w); o1 += pj * bfhi(w); }
    }
    const float inv = 1.f / l;
    *(GAS unsigned*)(OM + trow * MEMW + head * 128 + 2 * lane) = pk2(o0 * inv, o1 * inv);
}
__device__ __forceinline__ void mixnorm_rows(bf16* ATT, const float* g, int gw, int NGW, int lane) {
    for (int m = gw; m < T; m += NGW) {
        GAS v4u* p = (GAS v4u*)(ATT + (size_t)m * DM + 32 * lane);
        v4u w[4]; float f[32]; float ss = 0.f;
#pragma unroll
        for (int c = 0; c < 4; ++c) { w[c] = p[c];
            f[8 * c + 0] = bflo(w[c].x); f[8 * c + 1] = bfhi(w[c].x); f[8 * c + 2] = bflo(w[c].y); f[8 * c + 3] = bfhi(w[c].y); f[8 * c + 4] = bflo(w[c].z); f[8 * c + 5] = bfhi(w[c].z); f[8 * c + 6] = bflo(w[c].w); f[8 * c + 7] = bfhi(w[c].w); }
#pragma unroll
        for (int i = 0; i < 32; ++i) ss += f[i] * f[i];
        const int grp = lane < 24 ? 0 : (lane < 40 ? 1 : 2);
        const float sa = wave_sum(grp == 0 ? ss : 0.f, lane), sb = wave_sum(grp == 1 ? ss : 0.f, lane), sc = wave_sum(grp == 2 ? ss : 0.f, lane);
        const float r = grp == 0 ? 1.f / sqrtf(sa * (1.f / 768.f) + EPS) : (grp == 1 ? 1.f / sqrtf(sb * (1.f / 512.f) + EPS) : 1.f / sqrtf(sc * (1.f / 768.f) + EPS));
        const float* gg = g + 32 * lane;
#pragma unroll
        for (int c = 0; c < 4; ++c) { const f32x4 g0 = *(const GAS f32x4*)(gg + 8 * c), g1 = *(const GAS f32x4*)(gg + 8 * c + 4);
            v4u o; o.x = pk2(f[8 * c + 0] * r * g0[0], f[8 * c + 1] * r * g0[1]); o.y = pk2(f[8 * c + 2] * r * g0[2], f[8 * c + 3] * r * g0[3]);
            o.z = pk2(f[8 * c + 4] * r * g1[0], f[8 * c + 5] * r * g1[1]); o.w = pk2(f[8 * c + 6] * r * g1[2], f[8 * c + 7] * r * g1[3]); p[c] = o; }
    }
}

#ifndef PEER_HD
#define PEER_HD __device__ __forceinline__
#define PEER_EXP(x) __expf(x)
#endif
template <int N> PEER_HD void bitonic_sort_desc(float* v) {
#pragma unroll
    for (int k = 2; k <= N; k <<= 1)
#pragma unroll
        for (int j = k >> 1; j > 0; j >>= 1)
#pragma unroll
            for (int i = 0; i < N; ++i) { const int l = i ^ j; if (l > i) { const bool desc = ((i & k) == 0); const float a = v[i], b = v[l]; const float hi = fmaxf(a, b), lo = fminf(a, b);
                v[i] = desc ? hi : lo; v[l] = desc ? lo : hi; } }
}
PEER_HD void merge_top16(float* a, const float* b) {
    float c[16];
#pragma unroll
    for (int i = 0; i < 16; ++i) c[i] = fmaxf(a[i], b[15 - i]);
#pragma unroll
    for (int j = 8; j > 0; j >>= 1)
#pragma unroll
        for (int i = 0; i < 16; ++i) { const int l = i ^ j; if (l > i) { const float x = c[i], y = c[l]; c[i] = fmaxf(x, y); c[l] = fminf(x, y); } }
#pragma unroll
    for (int i = 0; i < 16; ++i) a[i] = c[i];
}
PEER_HD void top16_of_64(float (&v)[64]) {
    bitonic_sort_desc<16>(&v[0]); bitonic_sort_desc<16>(&v[16]); bitonic_sort_desc<16>(&v[32]); bitonic_sort_desc<16>(&v[48]);
    merge_top16(&v[0], &v[16]); merge_top16(&v[32], &v[48]); merge_top16(&v[0], &v[32]);
}
PEER_HD float pack_idx(float s, unsigned idx, unsigned mask) { return __builtin_bit_cast(float, (__builtin_bit_cast(unsigned, s) & ~mask) | idx); }
PEER_HD unsigned low_bits(float s, unsigned mask) { return __builtin_bit_cast(unsigned, s) & mask; }
PEER_HD unsigned pick16(const float* a, unsigned i, unsigned mask) {
    unsigned r = 0;
#pragma unroll
    for (unsigned k = 0; k < 16; ++k) r = (i == k) ? low_bits(a[k], mask) : r;
    return r;
}
PEER_HD void peer_candidates(const float* a, const float* b, int* e, float* gate) {
    float c[64]; int n = 0;
#pragma unroll
    for (int i = 0; i < 16; ++i)
#pragma unroll
        for (int j = 0; j < 16; ++j) if ((i + 1) * (j + 1) <= 16) { c[n] = pack_idx(a[i] + b[j], (unsigned)(i * 16 + j), 0xffu); ++n; }
#pragma unroll
    for (int k = 50; k < 64; ++k) c[k] = -3.0e38f;
    top16_of_64(c);
    float mx = c[0], den = 0.f;
#pragma unroll
    for (int k = 0; k < 16; ++k) { const unsigned id = low_bits(c[k], 0xffu); const unsigned n0 = pick16(a, id >> 4, 0x7fu), n1 = pick16(b, id & 15u, 0x7fu);
        e[k] = (int)(n0 * 128u + n1); gate[k] = PEER_EXP(c[k] - mx); den += gate[k]; }
    const float inv = 1.f / den;
#pragma unroll
    for (int k = 0; k < 16; ++k) gate[k] *= inv;
}

__device__ __forceinline__ void peer_select_unit(const bf16* QP, const bf16* PK, int* PIDX, float* PGATE, int tb, int h, int wave, int lane) {
    const int hh = lane >> 5, tl = lane & 31; const size_t t = (size_t)tb * 256 + wave * 32 + tl;
    float ab[2][16];
#pragma unroll
    for (int p = 0; p < 2; ++p) {
        bf16x8 bq[8];
#pragma unroll
        for (int s = 0; s < 8; ++s) bq[s] = *(const GAS bf16x8*)(QP + t * DM + 256 * h + 128 * p + 16 * s + 8 * hh);
        float v[64];
#pragma unroll
        for (int nb = 0; nb < 4; ++nb) {
            f32x16 acc;
#pragma unroll
            for (int r = 0; r < 16; ++r) acc[r] = 0.f;
            const bf16* kp = PK + ((size_t)((h * 2 + p) * 128 + 32 * nb + tl)) * 128 + 8 * hh;
            bf16x8 ak[8];
#pragma unroll
            for (int s = 0; s < 8; ++s) ak[s] = *(const GAS bf16x8*)(kp + 16 * s);
#pragma unroll
            for (int s = 0; s < 8; ++s) acc = __builtin_amdgcn_mfma_f32_32x32x16_bf16(ak[s], bq[s], acc, 0, 0, 0);
#pragma unroll
            for (int r = 0; r < 16; ++r) v[16 * nb + r] = pack_idx(acc[r], (unsigned)(32 * nb + 8 * (r >> 2) + 4 * hh + (r & 3)), 0x7fu);
        }
        top16_of_64(v);
        float pv[16];
#pragma unroll
        for (int i = 0; i < 16; ++i) pv[i] = shx(v[i], 32, lane);
        merge_top16(&v[0], pv);
#pragma unroll
        for (int i = 0; i < 16; ++i) ab[p][i] = v[i];
    }
    int e[16]; float gate[16];
    peer_candidates(ab[0], ab[1], e, gate);
    if (hh == 0) { GAS v4u* o = (GAS v4u*)(PIDX + t * 128 + h * 16);
#pragma unroll
        for (int c = 0; c < 4; ++c) o[c] = (v4u){(unsigned)e[4 * c], (unsigned)e[4 * c + 1], (unsigned)e[4 * c + 2], (unsigned)e[4 * c + 3]}; }
    else { GAS f32x4* o = (GAS f32x4*)(PGATE + t * 128 + h * 16);
#pragma unroll
        for (int c = 0; c < 4; ++c) o[c] = (f32x4){gate[4 * c], gate[4 * c + 1], gate[4 * c + 2], gate[4 * c + 3]}; }
}

typedef float f32x2 __attribute__((ext_vector_type(2)));
typedef unsigned v6u __attribute__((ext_vector_type(6)));
typedef float v32f __attribute__((ext_vector_type(32)));
typedef v4u __attribute__((aligned(8))) v4u_a8;
constexpr float PU_SCALE6 = 90.0f, PV_SCALE6 = 5.65f;
__device__ __forceinline__ unsigned enc_e2m3(float v) {
    const float a = fminf(fabsf(v), 7.5f);
    unsigned code;
    if (a < 1.0f) code = (unsigned)__builtin_rintf(a * 8.f);
    else { const unsigned b = __builtin_bit_cast(unsigned, a) - 0x3F800000u; code = ((b + 0x7FFFFu + ((b >> 20) & 1u)) >> 20) + 8u; }
    return code | (v < 0.f ? 32u : 0u);
}
__device__ __forceinline__ void convert_fp6_rows(const float* src, unsigned char* dst, int nrows, float scale, const float* gain, int gw, int NGW, int lane) {
    for (int r = gw; r < nrows; r += NGW) {
        const float* sp = src + (size_t)r * DM + 4 * lane; const float* gp = gain ? gain + (size_t)(r / PEER_N) * DM + 4 * lane : nullptr;
        unsigned w[6] = {0u, 0u, 0u, 0u, 0u, 0u};
#pragma unroll
        for (int j = 0; j < 8; ++j) { f32x4 a = *(const GAS f32x4*)(sp + 256 * j) * scale; if (gp) a = a * *(const GAS f32x4*)(gp + 256 * j);
#pragma unroll
            for (int e = 0; e < 4; ++e) { const unsigned code = enc_e2m3(a[e]); const int bp = 6 * (4 * j + e), wi = bp >> 5, sh = bp & 31;
                w[wi] |= code << sh; if (sh > 26) w[wi + 1] |= code >> (32 - sh); } }
        unsigned char* dp = dst + (size_t)r * 1536 + 24 * lane;
        *(GAS v4u_a8*)dp = (v4u){w[0], w[1], w[2], w[3]}; *(GAS v2u*)(dp + 16) = (v2u){w[4], w[5]};
    }
}
constexpr float PV_SCALE4 = 5.65f, PU_SCALE4 = 90.0f;
__device__ __forceinline__ unsigned enc_e2m1(float v) {
    const float a = fabsf(v);
    const unsigned code = a < 0.25f ? 0u : a < 0.75f ? 1u : a < 1.25f ? 2u : a < 1.75f ? 3u : a < 2.5f ? 4u : a < 3.5f ? 5u : a < 5.0f ? 6u : 7u;
    return code | (v < 0.f ? 8u : 0u);
}
__device__ __forceinline__ void convert_fp4_rows(const float* src, unsigned char* dst, int nrows, float scale, const float* gain, int gw, int NGW, int lane) {
    for (int r0 = 2 * gw; r0 < nrows; r0 += 2 * NGW) {
        f32x4 a[2][8];
#pragma unroll
        for (int q = 0; q < 2; ++q) { const float* sp = src + (size_t)(r0 + q) * DM + 4 * lane;
#pragma unroll
            for (int j = 0; j < 8; ++j) a[q][j] = *(const GAS f32x4*)(sp + 256 * j); }
#pragma unroll
        for (int q = 0; q < 2; ++q) { const int r = r0 + q; const float* gp = gain ? gain + (size_t)(r / PEER_N) * DM + 4 * lane : nullptr;
            unsigned w[4] = {0u, 0u, 0u, 0u};
#pragma unroll
            for (int j = 0; j < 8; ++j) { f32x4 v = a[q][j] * scale; if (gp) v = v * *(const GAS f32x4*)(gp + 256 * j);
#pragma unroll
                for (int e = 0; e < 4; ++e) { const int i = 4 * j + e; w[i >> 3] |= enc_e2m1(v[e]) << (4 * (i & 7)); } }
            *(GAS v4u*)(dst + (size_t)r * 1024 + 16 * lane) = (v4u){w[0], w[1], w[2], w[3]}; }
    }
}
#define PG4_LOAD(buf, tab, idlo, idhi, g) do { _Pragma("unroll") for (int i_ = 0; i_ < PG6_R; ++i_) { const int k_ = (g) * PG6_R + i_; \
        const int e_ = __builtin_amdgcn_readlane(k_ < 64 ? idlo : idhi, k_ & 63); buf[i_] = __builtin_amdgcn_raw_buffer_load_b128(tab, (int)voff4, e_ * 1024, 0); } } while (0)
#define PG4_DOT1(buf, i_, dst) do { f32x2 a_ = {0.f, 0.f}; _Pragma("unroll") for (int c_ = 0; c_ < 4; ++c_) { const unsigned u_ = buf[i_][c_]; \
        a_ += __builtin_amdgcn_cvt_scalef32_pk_f32_fp4(u_, 1.0f, 0) * x[4 * c_ + 0]; a_ += __builtin_amdgcn_cvt_scalef32_pk_f32_fp4(u_, 1.0f, 1) * x[4 * c_ + 1]; \
        a_ += __builtin_amdgcn_cvt_scalef32_pk_f32_fp4(u_, 1.0f, 2) * x[4 * c_ + 2]; a_ += __builtin_amdgcn_cvt_scalef32_pk_f32_fp4(u_, 1.0f, 3) * x[4 * c_ + 3]; } dst = a_.x + a_.y; __builtin_amdgcn_sched_barrier(0); } while (0)
#define PG4_DOT(buf, g) do { float p_[8]; _Pragma("unroll") for (int i_ = 0; i_ < 8; ++i_) PG4_DOT1(buf, i_, p_[i_]); \
        float q_[4]; _Pragma("unroll") for (int i_ = 0; i_ < 4; ++i_) { const float keep_ = b5 ? p_[i_ + 4] : p_[i_], send_ = b5 ? p_[i_] : p_[i_ + 4]; q_[i_] = keep_ + shx(send_, 32, lane); } \
        float r_[2]; _Pragma("unroll") for (int i_ = 0; i_ < 2; ++i_) { const float keep_ = b4 ? q_[i_ + 2] : q_[i_], send_ = b4 ? q_[i_] : q_[i_ + 2]; r_[i_] = keep_ + shx(send_, 16, lane); } \
        float s_; { const float keep_ = b3 ? r_[1] : r_[0], send_ = b3 ? r_[0] : r_[1]; s_ = keep_ + shx(send_, 8, lane); } \
        s_ += shx(s_, 4, lane); s_ += shx(s_, 2, lane); s_ += shx(s_, 1, lane); \
        if ((lane & 7) == 0) wl[(g) * 8 + (lane >> 3)] = s_; } while (0)
#define PG4_AXPY(buf, g) do { _Pragma("unroll") for (int i_ = 0; i_ < PG6_R; ++i_) { const float w_ = wl[(g) * PG6_R + i_]; const f32x2 wv_ = {w_, w_}; \
        _Pragma("unroll") for (int c_ = 0; c_ < 4; ++c_) { const unsigned u_ = buf[i_][c_]; \
            y[4 * c_ + 0] += __builtin_amdgcn_cvt_scalef32_pk_f32_fp4(u_, 1.0f, 0) * wv_; y[4 * c_ + 1] += __builtin_amdgcn_cvt_scalef32_pk_f32_fp4(u_, 1.0f, 1) * wv_; \
            y[4 * c_ + 2] += __builtin_amdgcn_cvt_scalef32_pk_f32_fp4(u_, 1.0f, 2) * wv_; y[4 * c_ + 3] += __builtin_amdgcn_cvt_scalef32_pk_f32_fp4(u_, 1.0f, 3) * wv_; } \
        __builtin_amdgcn_sched_barrier(0); } } while (0)
#ifndef PG6_R
#define PG6_R 8
#endif
#define PG6_LOAD(buf, tab, idlo, idhi, g) do { _Pragma("unroll") for (int i_ = 0; i_ < PG6_R; ++i_) { const int k_ = (g) * PG6_R + i_; \
        const int e_ = __builtin_amdgcn_readlane(k_ < 64 ? idlo : idhi, k_ & 63); const unsigned char* rp_ = (tab) + (size_t)(unsigned)e_ * 1536u; \
        const v4u a_ = *(const GAS v4u_a8*)(rp_ + voff); const v2u b_ = *(const GAS v2u*)(rp_ + voff + 16); buf[i_] = (v6u){a_.x, a_.y, a_.z, a_.w, b_.x, b_.y}; } } while (0)
#define PG6_DOT1(buf, i_, dst) do { const v32f f_ = __builtin_amdgcn_cvt_scalef32_pk32_f32_fp6(buf[i_], 1.0f); f32x2 a_ = {0.f, 0.f}; \
        _Pragma("unroll") for (int c_ = 0; c_ < 16; ++c_) a_ += (f32x2){f_[2 * c_], f_[2 * c_ + 1]} * x[c_]; dst = a_.x + a_.y; __builtin_amdgcn_sched_barrier(0); } while (0)
#if PG6_R == 8
#define PG6_DOT(buf, g) do { float p_[8]; _Pragma("unroll") for (int i_ = 0; i_ < 8; ++i_) PG6_DOT1(buf, i_, p_[i_]); \
        float q_[4]; _Pragma("unroll") for (int i_ = 0; i_ < 4; ++i_) { const float keep_ = b5 ? p_[i_ + 4] : p_[i_], send_ = b5 ? p_[i_] : p_[i_ + 4]; q_[i_] = keep_ + shx(send_, 32, lane); } \
        float r_[2]; _Pragma("unroll") for (int i_ = 0; i_ < 2; ++i_) { const float keep_ = b4 ? q_[i_ + 2] : q_[i_], send_ = b4 ? q_[i_] : q_[i_ + 2]; r_[i_] = keep_ + shx(send_, 16, lane); } \
        float s_; { const float keep_ = b3 ? r_[1] : r_[0], send_ = b3 ? r_[0] : r_[1]; s_ = keep_ + shx(send_, 8, lane); } \
        s_ += shx(s_, 4, lane); s_ += shx(s_, 2, lane); s_ += shx(s_, 1, lane); \
        if ((lane & 7) == 0) wl[(g) * 8 + (lane >> 3)] = s_; } while (0)
#else
#define PG6_DOT(buf, g) do { float p_[4]; _Pragma("unroll") for (int i_ = 0; i_ < 4; ++i_) PG6_DOT1(buf, i_, p_[i_]); \
        float r_[2]; _Pragma("unroll") for (int i_ = 0; i_ < 2; ++i_) { const float keep_ = b5 ? p_[i_ + 2] : p_[i_], send_ = b5 ? p_[i_] : p_[i_ + 2]; r_[i_] = keep_ + shx(send_, 32, lane); } \
        float s_; { const float keep_ = b4 ? r_[1] : r_[0], send_ = b4 ? r_[0] : r_[1]; s_ = keep_ + shx(send_, 16, lane); } \
        s_ += shx(s_, 8, lane); s_ += shx(s_, 4, lane); s_ += shx(s_, 2, lane); s_ += shx(s_, 1, lane); \
        if ((lane & 15) == 0) wl[(g) * 4 + (lane >> 4)] = s_; } while (0)
#endif
#define PG6_AXPY(buf, g) do { _Pragma("unroll") for (int i_ = 0; i_ < PG6_R; ++i_) { const float w_ = wl[(g) * PG6_R + i_]; const f32x2 wv_ = {w_, w_}; \
        const v32f f_ = __builtin_amdgcn_cvt_scalef32_pk32_f32_fp6(buf[i_], 1.0f); _Pragma("unroll") for (int c_ = 0; c_ < 16; ++c_) y[c_] += (f32x2){f_[2 * c_], f_[2 * c_ + 1]} * wv_; __builtin_amdgcn_sched_barrier(0); } } while (0)
__device__ __forceinline__ unsigned shxu(unsigned v, int k, int lane) { return (unsigned)__builtin_amdgcn_ds_bpermute((lane ^ k) << 2, (int)v); }
__device__ __forceinline__ void wave_sort128(unsigned& a, unsigned& b, int lane) {
#pragma unroll
    for (int k = 2; k <= 128; k <<= 1) {
#pragma unroll
        for (int j = k >> 1; j > 0; j >>= 1) {
            if (j == 64) { const unsigned lo = a < b ? a : b, hi = a < b ? b : a; a = lo; b = hi; }
            else {
                const unsigned pa = shxu(a, j, lane), pb = shxu(b, j, lane);
                const bool lower = (lane & j) == 0;
                const bool asc_a = (lane & k) == 0, asc_b = ((lane + 64) & k) == 0;
                const bool take_min_a = (lower == asc_a), take_min_b = (lower == asc_b);
                a = take_min_a ? (a < pa ? a : pa) : (a < pa ? pa : a);
                b = take_min_b ? (b < pb ? b : pb) : (b < pb ? pb : b);
            }
        }
    }
}
#ifndef PEER_U_FP4
#define PEER_U_FP4 1
#endif
#if PEER_U_FP4
typedef v4u urow_t;
#define PGU_LOAD PG4_LOAD
#define PGU_DOT PG4_DOT
constexpr float PU_SCALE = PU_SCALE4; constexpr int PU_STRIDE = 1024;
#else
typedef v6u urow_t;
#define PGU_LOAD PG6_LOAD
#define PGU_DOT PG6_DOT
constexpr float PU_SCALE = PU_SCALE6; constexpr int PU_STRIDE = 1536;
#endif
constexpr float PU_SCALEI = 135.0f, PX_SCALEI = 20.0f;
__device__ __forceinline__ void peer_v_pass(bf16* XN, const unsigned char* PV6, const int* PIDX, const float* PGATE, const int* PARTI, float* X, u64_t* rowsq_out, unsigned char* XN8, float* xsc, const u64_t* rowsq1, const u64_t* rowsq2, LAS float* wl, int gw, int NGW, int lane) {
    const unsigned voff4 = 16u * (unsigned)lane, l4 = 4u * (unsigned)lane, l8 = 8u * (unsigned)lane, l16 = 16u * (unsigned)lane;
    constexpr int NG = 128 / PG6_R;
    const __amdgpu_buffer_rsrc_t PVr = __builtin_amdgcn_make_buffer_rsrc((void*)PV6, 0, PEER_N * 1024, 0x00020000);
    for (int t_ = gw; t_ < T; t_ += NGW) {
        int t = t_; asm volatile("" : "+s"(t));
        const char* pidx_t = (const char*)(PIDX + (size_t)t * 128); const char* pgate_t = (const char*)(PGATE + (size_t)t * 128);
        const int idlo = *(const GAS int*)(pidx_t + l4), idhi = *(const GAS int*)(pidx_t + l4 + 256);
        v4u AV[PG6_R], BV[PG6_R];
        PG4_LOAD(AV, PVr, idlo, idhi, 0);
        {
            int s0 = 0, s1 = 0;
#pragma unroll
            for (int sp = 0; sp < 8; ++sp) { const char* pp = (const char*)(PARTI + ((size_t)sp * T + t) * 128); s0 += *(const GAS int*)(pp + l4); s1 += *(const GAS int*)(pp + l4 + 256); }
            const float sct = (8.0f / 127.0f / PU_SCALEI) * rowsq_rs(rowsq2, t) / rowsq_rs(rowsq1, t);
            const float d0 = (float)s0 * sct, d1 = (float)s1 * sct;
            const float g0 = *(const GAS float*)(pgate_t + l4), g1 = *(const GAS float*)(pgate_t + l4 + 256);
            const float w0 = g0 * 0.5f * d0 * (1.f + erff(d0 * 0.70710678118654752f)) * (1.f / PV_SCALE4), w1 = g1 * 0.5f * d1 * (1.f + erff(d1 * 0.70710678118654752f)) * (1.f / PV_SCALE4);
            wl[lane] = w0; wl[64 + lane] = w1;
            LDS_WAIT(); asm volatile("" ::: "memory");
        }
        f32x2 y[16];
#pragma unroll
        for (int i = 0; i < 16; ++i) y[i] = (f32x2){0.f, 0.f};
#pragma unroll 1
        for (int g = 0; g < NG; g += 2) {
            PG4_LOAD(BV, PVr, idlo, idhi, g + 1);
            PG4_AXPY(AV, g);
            if (g + 2 < NG) PG4_LOAD(AV, PVr, idlo, idhi, g + 2);
            PG4_AXPY(BV, g + 1);
        }
        {   char* xo = (char*)(X + (size_t)t * DM);
            char* xbo = (char*)(XN + (size_t)t * DM); float ss = 0.f;
#pragma unroll
            for (int j = 0; j < 8; ++j) { const v2u a = *(const GAS v2u*)(xbo + l8 + 512 * j); f32x4 v = (f32x4){bflo(a.x), bfhi(a.x), bflo(a.y), bfhi(a.y)}; v += (f32x4){y[2 * j].x, y[2 * j].y, y[2 * j + 1].x, y[2 * j + 1].y};
                if (X) *(GAS f32x4*)(xo + l16 + 1024 * j) = v;
                y[2 * j] = (f32x2){v[0], v[1]}; y[2 * j + 1] = (f32x2){v[2], v[3]};
                ss += (v[0] * v[0] + v[1] * v[1]) + (v[2] * v[2] + v[3] * v[3]); *(GAS v2u*)(xbo + l8 + 512 * j) = (v2u){pk2(v[0], v[1]), pk2(v[2], v[3])}; }
            if (rowsq_out) { ss = wave_sum(ss, lane); if (lane == 0) rowsq_out[t] = rowsq_fx(ss); }
            if (XN8) {
                float am = 0.f;
#pragma unroll
                for (int j = 0; j < 16; ++j) am = fmaxf(am, fmaxf(fabsf(y[j].x), fabsf(y[j].y)));
                am = fmaxf(wave_max(am, lane), 1e-30f);
                const float inv = 127.f / am; char* qo = (char*)(XN8 + (size_t)t * DM);
#pragma unroll
                for (int j = 0; j < 8; ++j) *(GAS unsigned*)(qo + l4 + 256 * j) = q8x4((f32x4){y[2 * j].x, y[2 * j].y, y[2 * j + 1].x, y[2 * j + 1].y}, inv);
                if (lane == 0) xsc[t] = am * (1.f / 127.f) / sqrtf(ss * (1.f / DM) + 1e-6f); } }
        LDS_WAIT(); asm volatile("" ::: "memory");
    }
}


__device__ __forceinline__ unsigned enc_i4(float v) { int q = (int)__builtin_rintf(v); q = q < -7 ? -7 : (q > 7 ? 7 : q); return (unsigned)q & 15u; }
__device__ __forceinline__ void convert_int4_plain(const float* src, unsigned char* dst, int nrows, float scale, const float* gain, int gw, int NGW, int lane) {
    for (int r0 = 2 * gw; r0 < nrows; r0 += 2 * NGW) {
        f32x4 a[2][8];
#pragma unroll
        for (int q = 0; q < 2; ++q) { const float* sp = src + (size_t)(r0 + q) * DM + 4 * lane;
#pragma unroll
            for (int j = 0; j < 8; ++j) a[q][j] = *(const GAS f32x4*)(sp + 256 * j); }
#pragma unroll
        for (int q = 0; q < 2; ++q) { const int r = r0 + q; const float* gp = gain ? gain + (size_t)(r / PEER_N) * DM + 4 * lane : nullptr;
#pragma unroll
            for (int j = 0; j < 8; ++j) { f32x4 v = a[q][j] * scale; if (gp) v = v * *(const GAS f32x4*)(gp + 256 * j);
                const unsigned w = enc_i4(v[0]) | (enc_i4(v[1]) << 4) | (enc_i4(v[2]) << 8) | (enc_i4(v[3]) << 12);
                *(GAS unsigned short*)(dst + (size_t)r * 1024 + 128 * j + 2 * lane) = (unsigned short)w; } }
    }
}
__device__ __forceinline__ void peer_xquant_unit(const bf16* XN, const u64_t* rowsq, unsigned* XQH, unsigned* XQL, int tb, int sl, int tid) {
    for (int it = tid; it < 256 * 32; it += NTHREADS) {
        const int t = tb * 256 + (it >> 5), c8 = it & 31;
        const float xs = PX_SCALEI * rowsq_rs(rowsq, t);
        const v4u w = *(const GAS v4u*)(XN + (size_t)t * DM + 256 * sl + 8 * c8);
        const float f[8] = {bflo(w.x), bfhi(w.x), bflo(w.y), bfhi(w.y), bflo(w.z), bfhi(w.z), bflo(w.w), bfhi(w.w)};
        unsigned hi = 0u, lo = 0u;
#pragma unroll
        for (int j = 0; j < 8; ++j) { int q = (int)__builtin_rintf(f[j] * xs); q = q < -119 ? -119 : (q > 119 ? 119 : q);
            const int xl = ((q + 8) & 15) - 8, xh = (q - xl) >> 4;
            hi |= ((unsigned)xh & 15u) << (4 * j); lo |= ((unsigned)xl & 15u) << (4 * j); }
        XQH[(size_t)t * 256 + 32 * sl + c8] = hi; XQL[(size_t)t * 256 + 32 * sl + c8] = lo;
    }
}
#define PI_LOADROWS(buf, tab, ids, i0) do { _Pragma("unroll") for (int i_ = 0; i_ < 8; ++i_) buf[i_] = __builtin_amdgcn_raw_buffer_load_b128(tab, ids[(i0) + i_] * 1024 + (int)soff, 0, 0); } while (0)
#define PI_LOADIDS(ids, t) do { const char* ip_ = (const char*)PIDX + ((size_t)(t) * 128 + 16 * g) * 4; _Pragma("unroll") for (int c_ = 0; c_ < 4; ++c_) { const v4u q_ = *(const GAS v4u*)(ip_ + 16 * c_); \
        ids[4 * c_] = (int)q_.x; ids[4 * c_ + 1] = (int)q_.y; ids[4 * c_ + 2] = (int)q_.z; ids[4 * c_ + 3] = (int)q_.w; } } while (0)
#define PI_UGROUP(buf, i0) do { _Pragma("unroll") for (int i_ = 0; i_ < 8; ++i_) { int ah_ = 0, al_ = 0; \
        _Pragma("unroll") for (int c_ = 0; c_ < 4; ++c_) { ah_ = __builtin_amdgcn_sdot8((int)buf[i_][c_], (int)xh[c_], ah_, false); al_ = __builtin_amdgcn_sdot8((int)buf[i_][c_], (int)xl[c_], al_, false); } \
        int p_ = 16 * ah_ + al_; p_ += __builtin_amdgcn_ds_bpermute((lane ^ 1) << 2, p_); p_ += __builtin_amdgcn_ds_bpermute((lane ^ 2) << 2, p_); p_ += __builtin_amdgcn_ds_bpermute((lane ^ 4) << 2, p_); \
        if (m == (((i0) + i_) >> 1)) { if (((i0) + i_) & 1) keep1 = p_; else keep0 = p_; } } } while (0)
#define PI_LOADROWS16(buf, tab, ids) do { _Pragma("unroll") for (int i_ = 0; i_ < 16; ++i_) buf[i_] = __builtin_amdgcn_raw_buffer_load_b128(tab, ids[i_] * 1024 + (int)soff, 0, 0); } while (0)
#define PI_LOADX(xh_, xl_, t) do { xh_ = *(const GAS v4u*)((const char*)XQH + (size_t)(t) * 1024 + soff); xl_ = *(const GAS v4u*)((const char*)XQL + (size_t)(t) * 1024 + soff); } while (0)
#define PI_COMPUTE16(buf, xh_, xl_, t) do { int keep0 = 0, keep1 = 0; \
        _Pragma("unroll") for (int i_ = 0; i_ < 16; ++i_) { int ah_ = 0, al_ = 0; \
            _Pragma("unroll") for (int c_ = 0; c_ < 4; ++c_) { ah_ = __builtin_amdgcn_sdot8((int)buf[i_][c_], (int)xh_[c_], ah_, false); al_ = __builtin_amdgcn_sdot8((int)buf[i_][c_], (int)xl_[c_], al_, false); } \
            int p_ = 16 * ah_ + al_; p_ += __builtin_amdgcn_update_dpp(0, p_, 0xB1, 0xf, 0xf, true); p_ += __builtin_amdgcn_update_dpp(0, p_, 0x4E, 0xf, 0xf, true); p_ += __builtin_amdgcn_update_dpp(0, p_, 0x141, 0xf, 0xf, true);   \
            if (m == (i_ >> 1)) { if (i_ & 1) keep1 = p_; else keep0 = p_; } } \
        if ((t) < T) *(GAS v2u*)(PARTI + ((size_t)s * T + (t)) * 128 + 2 * lane) = (v2u){(unsigned)keep0, (unsigned)keep1}; } while (0)
__device__ __forceinline__ void peer_u_phase_i4(const unsigned* XQH, const unsigned* XQL, const unsigned char* PU, const int* PIDX, int* PARTI, int bid, int G, int wave, int lane) {
    const int s = bid & 7, nr = (G - s + 7) >> 3, q = (bid >> 3) * NWAVES + wave, stride = nr * NWAVES, g = lane >> 3, m = lane & 7;
    const unsigned soff = 128u * (unsigned)s + 16u * (unsigned)m;
    if (q >= T) return;
    const __amdgpu_buffer_rsrc_t PUr = __builtin_amdgcn_make_buffer_rsrc((void*)PU, 0, PEER_N * 1024, 0x00020000);
#define PI_CL(t) ((t) < T ? (t) : T - 1)
    int I1[16], I2[16]; v4u xh0, xl0, xh1, xl1, xh2, xl2, RA[16], RB[16];
    PI_LOADIDS(I1, q); PI_LOADX(xh0, xl0, q);
    PI_LOADROWS16(RA, PUr, I1);
    PI_LOADIDS(I1, PI_CL(q + stride)); PI_LOADX(xh1, xl1, PI_CL(q + stride));
    for (int t = q; t < T; t += 2 * stride) {
        PI_LOADROWS16(RB, PUr, I1);
        PI_LOADIDS(I2, PI_CL(t + 2 * stride)); PI_LOADX(xh2, xl2, PI_CL(t + 2 * stride));
        PI_COMPUTE16(RA, xh0, xl0, t);
        PI_LOADROWS16(RA, PUr, I2);
        PI_LOADIDS(I1, PI_CL(t + 3 * stride)); PI_LOADX(xh0, xl0, PI_CL(t + 3 * stride));
        PI_COMPUTE16(RB, xh1, xl1, t + stride);
        xh1 = xh0; xl1 = xl0; xh0 = xh2; xl0 = xl2;
    }
#undef PI_CL
}


constexpr float PV_SCALE4S = 5.65f;
__device__ __forceinline__ unsigned enc_e2m1s(float v) {
    const float a = fabsf(v);
    const unsigned code = a < 0.25f ? 0u : a < 0.75f ? 1u : a < 1.25f ? 2u : a < 1.75f ? 3u : a < 2.5f ? 4u : a < 3.5f ? 5u : a < 5.0f ? 6u : 7u;
    return code | (v < 0.f ? 8u : 0u);
}
__device__ __forceinline__ void convert_fp4_plain(const float* src, unsigned char* dst, int nrows, float scale, const float* gain, int gw, int NGW, int lane) {
    for (int r0 = 2 * gw; r0 < nrows; r0 += 2 * NGW) {
        f32x4 a[2][8];
#pragma unroll
        for (int q = 0; q < 2; ++q) { const float* sp = src + (size_t)(r0 + q) * DM + 4 * lane;
#pragma unroll
            for (int j = 0; j < 8; ++j) a[q][j] = *(const GAS f32x4*)(sp + 256 * j); }
#pragma unroll
        for (int q = 0; q < 2; ++q) { const int r = r0 + q; const float* gp = gain ? gain + (size_t)(r / PEER_N) * DM + 4 * lane : nullptr;
#pragma unroll
            for (int j = 0; j < 8; ++j) { f32x4 v = a[q][j] * scale; if (gp) v = v * *(const GAS f32x4*)(gp + 256 * j);
                const unsigned w = enc_e2m1s(v[0]) | (enc_e2m1s(v[1]) << 4) | (enc_e2m1s(v[2]) << 8) | (enc_e2m1s(v[3]) << 12);
                *(GAS unsigned short*)(dst + (size_t)r * 1024 + 128 * j + 2 * lane) = (unsigned short)w; } }
    }
}
#define PVS_LOADMETA(ids, pp, gg, t) do { PI_LOADIDS(ids, t); _Pragma("unroll") for (int sp_ = 0; sp_ < 8; ++sp_) pp[sp_] = *(const GAS v2u*)(PARTI + ((size_t)sp_ * T + (t)) * 128 + 2 * lane); \
        gg = *(const GAS f32x2*)(PGATE + (size_t)(t) * 128 + 2 * lane); } while (0)
#define PVS_COMPUTE16(buf, pp, gg, t) do { float w0, w1; { int s0_ = 0, s1_ = 0; _Pragma("unroll") for (int sp_ = 0; sp_ < 8; ++sp_) { s0_ += (int)pp[sp_].x; s1_ += (int)pp[sp_].y; } \
            const float d0_ = (float)s0_ * (1.f / (PX_SCALEI * PU_SCALEI)), d1_ = (float)s1_ * (1.f / (PX_SCALEI * PU_SCALEI)); \
            w0 = gg.x * 0.5f * d0_ * (1.f + erff(d0_ * 0.70710678118654752f)) * (1.f / PV_SCALE4S); w1 = gg.y * 0.5f * d1_ * (1.f + erff(d1_ * 0.70710678118654752f)) * (1.f / PV_SCALE4S); } \
        f32x2 y[16]; _Pragma("unroll") for (int i_ = 0; i_ < 16; ++i_) y[i_] = (f32x2){0.f, 0.f}; \
        _Pragma("unroll") for (int i_ = 0; i_ < 16; ++i_) { \
            const float w_ = __builtin_bit_cast(float, __builtin_amdgcn_ds_bpermute(((lane & 56) | (i_ >> 1)) << 2, __builtin_bit_cast(int, (i_ & 1) ? w1 : w0))); const f32x2 wv_ = {w_, w_}; \
            _Pragma("unroll") for (int c_ = 0; c_ < 4; ++c_) { const unsigned u_ = buf[i_][c_]; \
                y[4 * c_ + 0] += __builtin_amdgcn_cvt_scalef32_pk_f32_fp4(u_, 1.0f, 0) * wv_; y[4 * c_ + 1] += __builtin_amdgcn_cvt_scalef32_pk_f32_fp4(u_, 1.0f, 1) * wv_; \
                y[4 * c_ + 2] += __builtin_amdgcn_cvt_scalef32_pk_f32_fp4(u_, 1.0f, 2) * wv_; y[4 * c_ + 3] += __builtin_amdgcn_cvt_scalef32_pk_f32_fp4(u_, 1.0f, 3) * wv_; } } \
        {   LAS float* wp_ = yl + g * 288 + m * 36; \
            _Pragma("unroll") for (int c_ = 0; c_ < 8; ++c_) *(LAS f32x4*)(wp_ + 4 * c_) = (f32x4){y[2 * c_].x, y[2 * c_].y, y[2 * c_ + 1].x, y[2 * c_ + 1].y}; \
            LDS_WAIT(); asm volatile("" ::: "memory"); \
            f32x4 acc_ = {0.f, 0.f, 0.f, 0.f}; const LAS float* rp_ = yl + (lane >> 3) * 36 + 4 * (lane & 7); \
            _Pragma("unroll") for (int gg_ = 0; gg_ < 8; ++gg_) acc_ += *(const LAS f32x4*)(rp_ + gg_ * 288); \
            LDS_WAIT(); asm volatile("" ::: "memory"); \
            if ((t) < T) { bf16* xp_ = XN + (size_t)(t) * DM + 256 * s + 4 * lane; const v2u a_ = *(const GAS v2u*)xp_; \
                const f32x4 v_ = (f32x4){bflo(a_.x), bfhi(a_.x), bflo(a_.y), bfhi(a_.y)} + acc_; \
                *(GAS v2u*)xp_ = (v2u){pk2(v_[0], v_[1]), pk2(v_[2], v_[3])}; \
                if (Xout) *(GAS f32x4*)(Xout + (size_t)(t) * DM + 256 * s + 4 * lane) = v_; \
                if (rowsq_out) { const float ss_ = wave_sum((v_[0] * v_[0] + v_[1] * v_[1]) + (v_[2] * v_[2] + v_[3] * v_[3]), lane); if (lane == 0) atomicAdd(rowsq_out + (t), rowsq_fx(ss_)); } } } } while (0)
__device__ __forceinline__ void peer_v_phase_s(bf16* XN, const unsigned char* PV, const int* PIDX, const float* PGATE, const int* PARTI, float* Xout, u64_t* rowsq_out, LAS float* yl, int bid, int G, int wave, int lane) {
    const int s = bid & 7, nr = (G - s + 7) >> 3, q = (bid >> 3) * NWAVES + wave, stride = nr * NWAVES, g = lane >> 3, m = lane & 7;
    const unsigned soff = 128u * (unsigned)s + 16u * (unsigned)m;
    if (q >= T) return;
    const __amdgpu_buffer_rsrc_t PVr = __builtin_amdgcn_make_buffer_rsrc((void*)PV, 0, PEER_N * 1024, 0x00020000);
#define PVS_CL(t) ((t) < T ? (t) : T - 1)
    int I0[16], I1[16]; v2u P0[8], P1[8]; f32x2 G0, G1; v4u RA[16], RB[16];
#define PVS_LOADPG(pp, gg, t) do { _Pragma("unroll") for (int sp_ = 0; sp_ < 8; ++sp_) pp[sp_] = *(const GAS v2u*)(PARTI + ((size_t)sp_ * T + (t)) * 128 + 2 * lane); gg = *(const GAS f32x2*)(PGATE + (size_t)(t) * 128 + 2 * lane); } while (0)
    PI_LOADIDS(I0, q); PVS_LOADPG(P0, G0, q);
    PI_LOADROWS16(RA, PVr, I0);
    PI_LOADIDS(I1, PVS_CL(q + stride)); PVS_LOADPG(P1, G1, PVS_CL(q + stride));
    for (int t = q; t < T; t += 2 * stride) {
        PI_LOADROWS16(RB, PVr, I1);
        PI_LOADIDS(I0, PVS_CL(t + 2 * stride));
        PVS_COMPUTE16(RA, P0, G0, t);
        PVS_LOADPG(P0, G0, PVS_CL(t + 2 * stride));
        PI_LOADROWS16(RA, PVr, I0);
        PI_LOADIDS(I1, PVS_CL(t + 3 * stride));
        PVS_COMPUTE16(RB, P1, G1, t + stride);
        PVS_LOADPG(P1, G1, PVS_CL(t + 3 * stride));
    }
#undef PVS_LOADPG
#undef PVS_CL
}

typedef short s16x4 __attribute__((ext_vector_type(4)));
typedef __attribute__((address_space(3))) const char* lds_cptr;
__device__ __forceinline__ s16x4 vtr(lds_cptr p) { return __builtin_bit_cast(s16x4, __builtin_amdgcn_ds_read_tr16_b64_v4i16((__attribute__((address_space(3))) s16x4*)p)); }
__device__ __forceinline__ unsigned cvtpk(float lo, float hi) { unsigned r; asm("v_cvt_pk_bf16_f32 %0, %1, %2" : "=v"(r) : "v"(lo), "v"(hi)); return r; }
constexpr int AT_K0 = 0, AT_V0 = 16384, AT_TAB = 32768;
constexpr float LOG2E = 1.4426950408889634f;
template <int TYPE>
__device__ __forceinline__ void attn_unit(LAS unsigned char* lds, const bf16* QKV, bf16* ATT, u64_t* mixsq, int b, int head, int qb, const float* tabsrc, float Cl2, float sinkl2, int tid) {
    const int lane = tid & 63, w = __builtin_amdgcn_readfirstlane(tid >> 6), hh = lane >> 5, l31 = lane & 31;
    int qcol, kcol, vcol, ocol;
    if (TYPE == 0) { qcol = QA + head * 64; kcol = KA + (head / 3) * 64; vcol = VA + (head / 3) * 64; ocol = OA + head * 64; }
    else if (TYPE == 1) { qcol = QB + head * 64; kcol = KB + head * 64; vcol = VB + head * 64; ocol = OB + head * 64; }
    else { qcol = QC + head * 64; kcol = KC + (head / 3) * 64; vcol = VC + (head / 3) * 64; ocol = OC + head * 64; }
    const int q0 = 256 * qb + 32 * w, qpos = q0 + l31;
    int t_begin, t_end;
    if (TYPE == 0) { t_begin = 4 * qb - 2; if (t_begin < 0) t_begin = 0; t_end = 4 * qb + 6; if (t_end > 32) t_end = 32; }
    else if (TYPE == 1) { int a = 4 * qb - 4; a = a < 0 ? 0 : (a > 24 ? 24 : a); int e = 4 * qb - 1; e = e < 0 ? 0 : (e > 24 ? 24 : e); t_begin = a; t_end = e + 8; }
    else { t_begin = 0; t_end = 32; }
    LAS float* tab = (LAS float*)(lds + AT_TAB);
    if (TYPE == 0) { for (int i = tid; i < 1024; i += NTHREADS) { const int rel = i - 448; tab[i] = (rel >= -128 && rel <= 128) ? tabsrc[head * 257 + rel + 128] * LOG2E - Cl2 : -1e30f; } }
    if (TYPE == 1) { for (int i = tid; i < 15 * 31; i += NTHREADS) tab[i] = tabsrc[head * 465 + i] * LOG2E - Cl2; }
    bf16x8 qf[4];
    {   const bf16* qp = QKV + ((size_t)b * SEQ + qpos) * DIN + qcol + 8 * hh;
#pragma unroll
        for (int s = 0; s < 4; ++s) qf[s] = *(const GAS bf16x8*)(qp + 16 * s); }
    const int srow = tid >> 3, sch = tid & 7;
    const bf16* kg = QKV + ((size_t)b * SEQ + srow) * DIN + kcol + sch * 8;
    const bf16* vg = QKV + ((size_t)b * SEQ + srow) * DIN + vcol + sch * 8;
    const int kst = srow * 128 + ((sch ^ ((srow >> 1) & 7)) * 16);
    const int vst = srow * 128 + (((sch >> 2) ^ ((srow >> 1) & 1)) * 64) + (sch & 3) * 16;
    int kread[4], vread[2];
#pragma unroll
    for (int s = 0; s < 4; ++s) kread[s] = l31 * 128 + (((2 * s + hh) ^ ((lane >> 1) & 7)) * 16);
#pragma unroll
    for (int db = 0; db < 2; ++db) vread[db] = (4 * hh + ((lane >> 2) & 3)) * 128 + ((db ^ ((lane >> 3) & 1)) * 64) + 32 * ((lane >> 4) & 1) + 8 * (lane & 3);
    f32x16 O0, O1;
#pragma unroll
    for (int r = 0; r < 16; ++r) { O0[r] = 0.f; O1[r] = 0.f; }
    float lsum = 0.f;
    const int rw = 4 * qb + (w >> 1), cq = 32 * (w & 1) + l31;
    int r0w = rw - 4; r0w = r0w < 0 ? 0 : (r0w > 24 ? 24 : r0w);
    int c0 = cq - 8; c0 = c0 < 0 ? 0 : (c0 > 48 ? 48 : c0);
    {   const v4u kr = *(const GAS v4u*)(kg + (size_t)t_begin * 64 * DIN), vr = *(const GAS v4u*)(vg + (size_t)t_begin * 64 * DIN);
        *(LAS v4u*)(lds + AT_K0 + kst) = kr; *(LAS v4u*)(lds + AT_V0 + vst) = vr; }
    __syncthreads();
    for (int t = t_begin; t < t_end; ++t) {
        const int cur = (t - t_begin) & 1;
        v4u kr, vr;
        if (t + 1 < t_end) { kr = *(const GAS v4u*)(kg + (size_t)(t + 1) * 64 * DIN); vr = *(const GAS v4u*)(vg + (size_t)(t + 1) * 64 * DIN); }
        bool need = true;
        if (TYPE == 0) need = (64 * t <= q0 + 31 + 128) && (64 * t + 63 >= q0 - 128);
        if (TYPE == 1) need = (t >= r0w) && (t < r0w + 8);
        if (need) {
            const lds_cptr kb_ = (lds_cptr)(lds + AT_K0 + cur * 8192), vb_ = (lds_cptr)(lds + AT_V0 + cur * 8192);
            bf16x8 kf[8];
#pragma unroll
            for (int s = 0; s < 4; ++s) { kf[2 * s] = *(const LAS bf16x8*)(kb_ + kread[s]); kf[2 * s + 1] = *(const LAS bf16x8*)(kb_ + kread[s] + 4096); }
            f32x16 S0, S1;
            if (TYPE == 2) {
#pragma unroll
                for (int r = 0; r < 16; ++r) { S0[r] = -Cl2; S1[r] = -Cl2; }
            } else if (TYPE == 0) {
                const LAS float* tb = tab + (64 * t - qpos + 448 + 4 * hh);
#pragma unroll
                for (int r = 0; r < 16; ++r) { S0[r] = tb[8 * (r >> 2) + (r & 3)]; S1[r] = tb[32 + 8 * (r >> 2) + (r & 3)]; }
            } else {
                const LAS float* tb = tab + ((t - rw + 7) * 31 - cq + 15 + 4 * hh);
                const int kc0 = 4 * hh - c0;
#pragma unroll
                for (int r = 0; r < 16; ++r) { const int ka = 8 * (r >> 2) + (r & 3), kb2 = 32 + ka;
                    S0[r] = ((unsigned)(ka + kc0) < 16u) ? tb[ka] : -1e30f; S1[r] = ((unsigned)(kb2 + kc0) < 16u) ? tb[kb2] : -1e30f; }
            }
            __builtin_amdgcn_sched_barrier(0);
#define AT_SB __builtin_amdgcn_sched_barrier(0)
#define AT_SOFT(SX, base, dst) do { _Pragma("unroll") for (int r = (base); r < (base) + 8; ++r) SX[r] = __builtin_amdgcn_exp2f(SX[r]); \
            lsum += ((SX[(base)] + SX[(base) + 1]) + (SX[(base) + 2] + SX[(base) + 3])) + ((SX[(base) + 4] + SX[(base) + 5]) + (SX[(base) + 6] + SX[(base) + 7])); \
            v4u a_; _Pragma("unroll") for (int j = 0; j < 4; ++j) a_[j] = cvtpk(SX[(base) + 2 * j], SX[(base) + 2 * j + 1]); dst = __builtin_bit_cast(bf16x8, a_); } while (0)
#pragma unroll
            for (int s = 0; s < 4; ++s) S0 = __builtin_amdgcn_mfma_f32_32x32x16_bf16(kf[2 * s], qf[s], S0, 0, 0, 0);
            s16x4 vf[4][2][2];
#pragma unroll
            for (int ks = 0; ks < 2; ++ks)
#pragma unroll
                for (int db = 0; db < 2; ++db) { vf[ks][db][0] = vtr(vb_ + vread[db] + (16 * ks) * 128); vf[ks][db][1] = vtr(vb_ + vread[db] + (16 * ks + 8) * 128); }
            S1 = __builtin_amdgcn_mfma_f32_32x32x16_bf16(kf[1], qf[0], S1, 0, 0, 0); S1 = __builtin_amdgcn_mfma_f32_32x32x16_bf16(kf[3], qf[1], S1, 0, 0, 0);
            AT_SB;
            bf16x8 pb[4];
            AT_SOFT(S0, 0, pb[0]);
            AT_SB;
            S1 = __builtin_amdgcn_mfma_f32_32x32x16_bf16(kf[5], qf[2], S1, 0, 0, 0);
            AT_SB;
            AT_SOFT(S0, 8, pb[1]);
            AT_SB;
            S1 = __builtin_amdgcn_mfma_f32_32x32x16_bf16(kf[7], qf[3], S1, 0, 0, 0);
            asm volatile("s_waitcnt lgkmcnt(7)" ::: "memory");
#pragma unroll
            for (int ks = 2; ks < 4; ++ks)
#pragma unroll
                for (int db = 0; db < 2; ++db) { vf[ks][db][0] = vtr(vb_ + vread[db] + (16 * ks) * 128); vf[ks][db][1] = vtr(vb_ + vread[db] + (16 * ks + 8) * 128); }
            AT_SB;
#define AT_PV(ks) do { const bf16x8 va = __builtin_shufflevector(vf[ks][0][0], vf[ks][0][1], 0, 1, 2, 3, 4, 5, 6, 7), vb2 = __builtin_shufflevector(vf[ks][1][0], vf[ks][1][1], 0, 1, 2, 3, 4, 5, 6, 7); \
            O0 = __builtin_amdgcn_mfma_f32_32x32x16_bf16(va, pb[ks], O0, 0, 0, 0); O1 = __builtin_amdgcn_mfma_f32_32x32x16_bf16(vb2, pb[ks], O1, 0, 0, 0); } while (0)
            AT_PV(0);
            AT_SB;
            AT_SOFT(S1, 0, pb[2]);
            AT_SB;
            AT_PV(1);
            AT_SB;
            AT_SOFT(S1, 8, pb[3]);
            AT_SB;
            AT_PV(2); AT_PV(3);
#undef AT_PV
#undef AT_SOFT
#undef AT_SB
        }
        __builtin_amdgcn_sched_barrier(0);
        if (t + 1 < t_end) { *(LAS v4u*)(lds + AT_K0 + (cur ^ 1) * 8192 + kst) = kr; *(LAS v4u*)(lds + AT_V0 + (cur ^ 1) * 8192 + vst) = vr; }
        __syncthreads();
    }
    lsum += shx(lsum, 32, lane);
    if (TYPE == 0) lsum += __builtin_amdgcn_exp2f(sinkl2 - Cl2);
    const float inv = 1.f / lsum;
    {   float ss = 0.f;
#pragma unroll
        for (int r = 0; r < 16; ++r) { const float a = O0[r] * inv, c = O1[r] * inv; ss += a * a + c * c; }
        ss += shx(ss, 32, lane);
        if (hh == 0) (void)__hip_atomic_fetch_add((GAS u64_t*)(mixsq + (size_t)b * SEQ + qpos), rowsq_fx(ss), __ATOMIC_RELAXED, __HIP_MEMORY_SCOPE_AGENT); }
    bf16* op = ATT + ((size_t)b * SEQ + qpos) * DM + ocol + 4 * hh;
#pragma unroll
    for (int g4 = 0; g4 < 4; ++g4) {
        v2u o0, o1; o0.x = cvtpk(O0[4 * g4] * inv, O0[4 * g4 + 1] * inv); o0.y = cvtpk(O0[4 * g4 + 2] * inv, O0[4 * g4 + 3] * inv);
        o1.x = cvtpk(O1[4 * g4] * inv, O1[4 * g4 + 1] * inv); o1.y = cvtpk(O1[4 * g4 + 2] * inv, O1[4 * g4 + 3] * inv);
        *(GAS v2u*)(op + 8 * g4) = o0; *(GAS v2u*)(op + 32 + 8 * g4) = o1;
    }
}


constexpr int MA_K0 = 0, MA_V0 = 32768;
__device__ __forceinline__ void mem_unit(LAS unsigned char* lds, const bf16* QM, const bf16* KVM, bf16* OM, const float* gq, int tb, int head, float Cl2, int tid) {
    const int lane = tid & 63, w = __builtin_amdgcn_readfirstlane(tid >> 6), hh = lane >> 5, l31 = lane & 31;
    const size_t trow = (size_t)tb * 256 + 32 * w + l31; const int b = tb >> 3;
    bf16x8 qf[8];
    {   const bf16* qp = QM + trow * MEMW + head * 128 + 8 * hh;
#pragma unroll
        for (int s = 0; s < 8; ++s) qf[s] = *(const GAS bf16x8*)(qp + 16 * s);
        float ss = 0.f;
#pragma unroll
        for (int s = 0; s < 8; ++s)
#pragma unroll
            for (int j = 0; j < 8; ++j) { const float f = __builtin_bit_cast(float, (unsigned)(unsigned short)qf[s][j] << 16); ss += f * f; }
        ss += shx(ss, 32, lane);
        const float r = 0.12751743074602468f / sqrtf(ss * (1.f / 128.f) + EPS);
#pragma unroll
        for (int s = 0; s < 8; ++s) { const f32x4 g0 = *(const GAS f32x4*)(gq + 16 * s + 8 * hh), g1 = *(const GAS f32x4*)(gq + 16 * s + 8 * hh + 4);
            v4u o;
#pragma unroll
            for (int j = 0; j < 4; ++j) { const float f0 = __builtin_bit_cast(float, (unsigned)(unsigned short)qf[s][2 * j] << 16), f1 = __builtin_bit_cast(float, (unsigned)(unsigned short)qf[s][2 * j + 1] << 16);
                const float ga = (2 * j < 4) ? g0[2 * j] : g1[2 * j - 4], gb2 = (2 * j + 1 < 4) ? g0[2 * j + 1] : g1[2 * j + 1 - 4];
                o[j] = cvtpk(f0 * r * ga, f1 * r * gb2); }
            qf[s] = __builtin_bit_cast(bf16x8, o); }
    }
    const int srow = tid >> 3, sch = tid & 7;
    const bf16* kg = KVM + ((size_t)b * NMEM + srow) * 1024 + head * 128 + sch * 8;
    const bf16* vg = kg + 512;
    const int kst0 = srow * 256 + ((sch ^ (srow & 15)) * 16), kst1 = srow * 256 + (((sch + 8) ^ (srow & 15)) * 16);
    const int vst0 = srow * 256 + ((((sch) >> 2) ^ (srow & 3)) * 64) + (sch & 3) * 16, vst1 = srow * 256 + ((((sch + 8) >> 2) ^ (srow & 3)) * 64) + (sch & 3) * 16;
    int kread[8], vread[4];
#pragma unroll
    for (int s = 0; s < 8; ++s) kread[s] = l31 * 256 + (((2 * s + hh) ^ (l31 & 15)) * 16);
#pragma unroll
    for (int db = 0; db < 4; ++db) vread[db] = (4 * hh + ((lane >> 2) & 3)) * 256 + ((db ^ ((lane >> 2) & 3)) * 64) + 32 * ((lane >> 4) & 1) + 8 * (lane & 3);
    f32x16 O[4];
#pragma unroll
    for (int db = 0; db < 4; ++db)
#pragma unroll
        for (int r = 0; r < 16; ++r) O[db][r] = 0.f;
    float lsum = 0.f;
    {   const v4u k0 = *(const GAS v4u*)kg, k1 = *(const GAS v4u*)(kg + 64), v0 = *(const GAS v4u*)vg, v1 = *(const GAS v4u*)(vg + 64);
        *(LAS v4u*)(lds + MA_K0 + kst0) = k0; *(LAS v4u*)(lds + MA_K0 + kst1) = k1; *(LAS v4u*)(lds + MA_V0 + vst0) = v0; *(LAS v4u*)(lds + MA_V0 + vst1) = v1; }
    __syncthreads();
#pragma unroll 1
    for (int t = 0; t < 4; ++t) {
        const int cur = t & 1;
        v4u k0, k1, v0, v1;
        if (t + 1 < 4) { const bf16* kn = kg + (size_t)(t + 1) * 64 * 1024; k0 = *(const GAS v4u*)kn; k1 = *(const GAS v4u*)(kn + 64); v0 = *(const GAS v4u*)(kn + 512); v1 = *(const GAS v4u*)(kn + 576); }
        const lds_cptr kb_ = (lds_cptr)(lds + MA_K0 + cur * 16384), vb_ = (lds_cptr)(lds + MA_V0 + cur * 16384);
        f32x16 S0, S1;
#pragma unroll
        for (int r = 0; r < 16; ++r) { S0[r] = -Cl2; S1[r] = -Cl2; }
#pragma unroll
        for (int s = 0; s < 8; ++s) { const bf16x8 a0 = *(const LAS bf16x8*)(kb_ + kread[s]), a1 = *(const LAS bf16x8*)(kb_ + kread[s] + 8192);
            S0 = __builtin_amdgcn_mfma_f32_32x32x16_bf16(a0, qf[s], S0, 0, 0, 0); S1 = __builtin_amdgcn_mfma_f32_32x32x16_bf16(a1, qf[s], S1, 0, 0, 0); }
#pragma unroll
        for (int r = 0; r < 16; ++r) { S0[r] = __builtin_amdgcn_exp2f(S0[r]); S1[r] = __builtin_amdgcn_exp2f(S1[r]); lsum += S0[r] + S1[r]; }
        bf16x8 pb[4];
#pragma unroll
        for (int hf = 0; hf < 2; ++hf) {
            v4u a, c;
#pragma unroll
            for (int j = 0; j < 4; ++j) { a[j] = cvtpk(S0[8 * hf + 2 * j], S0[8 * hf + 2 * j + 1]); c[j] = cvtpk(S1[8 * hf + 2 * j], S1[8 * hf + 2 * j + 1]); }
            pb[hf] = __builtin_bit_cast(bf16x8, a); pb[2 + hf] = __builtin_bit_cast(bf16x8, c);
        }
#pragma unroll
        for (int ks = 0; ks < 4; ++ks)
#pragma unroll
            for (int db = 0; db < 4; ++db) {
                const s16x4 a0 = vtr(vb_ + vread[db] + (16 * ks) * 256), a1 = vtr(vb_ + vread[db] + (16 * ks + 8) * 256);
                const bf16x8 va = __builtin_shufflevector(a0, a1, 0, 1, 2, 3, 4, 5, 6, 7);
                O[db] = __builtin_amdgcn_mfma_f32_32x32x16_bf16(va, pb[ks], O[db], 0, 0, 0);
            }
        if (t + 1 < 4) { LAS unsigned char* kn = lds + MA_K0 + (cur ^ 1) * 16384; LAS unsigned char* vn = lds + MA_V0 + (cur ^ 1) * 16384;
            *(LAS v4u*)(kn + kst0) = k0; *(LAS v4u*)(kn + kst1) = k1; *(LAS v4u*)(vn + vst0) = v0; *(LAS v4u*)(vn + vst1) = v1; }
        __syncthreads();
    }
    lsum += shx(lsum, 32, lane);
    const float inv = 1.f / lsum;
    bf16* op = OM + trow * MEMW + head * 128 + 4 * hh;
#pragma unroll
    for (int db = 0; db < 4; ++db)
#pragma unroll
        for (int g4 = 0; g4 < 4; ++g4) { v2u o; o.x = cvtpk(O[db][4 * g4] * inv, O[db][4 * g4 + 1] * inv); o.y = cvtpk(O[db][4 * g4 + 2] * inv, O[db][4 * g4 + 3] * inv); *(GAS v2u*)(op + 32 * db + 8 * g4) = o; }
}

struct Args { const float* in[23]; float* out; unsigned char* ws; int ph_lo, ph_hi, use_bar, pad; };
#ifndef MK_OFF
#define MK_OFF 0u
#endif
#ifndef REP_ATT
#define REP_ATT 1
#endif
#ifndef REP_P0
#define REP_P0 1
#endif
#ifndef REP_U
#define REP_U 1
#endif
#ifndef REP_GEMM
#define REP_GEMM 1
#endif
#ifndef REP_NORM
#define REP_NORM 1
#endif
#ifndef REP_SEL
#define REP_SEL 1
#endif
#ifndef REP_MEM
#define REP_MEM 1
#endif
#define PHON(k) (!((MK_OFF >> (k)) & 1u))
#ifndef MK_REP
#define MK_REP 0
#endif
constexpr int PH_PER_LAYER = 9, PH_BASE = 2, N_PHASES = PH_BASE + DEPTH * PH_PER_LAYER;
constexpr int PTAB_OFF = LDSCTL_OFF + 1024;

__global__ void __launch_bounds__(NTHREADS, 2) mega(Args a) {
    extern __shared__ __attribute__((aligned(16))) unsigned char lds_raw[];
    LAS unsigned char* lds = (LAS unsigned char*)lds_raw;
    const int wave0_ = __builtin_amdgcn_readfirstlane((int)threadIdx.x >> 6);
    {   const int tid0 = threadIdx.x;
        for (int u = tid0; u < (LDS_BYTES - LDSCTL_OFF) / 4; u += NTHREADS) ((LAS unsigned*)(lds + LDSCTL_OFF))[u] = 0u;
        __syncthreads();
        if (tid0 < 23) ((LAS unsigned long long*)(lds + PTAB_OFF))[tid0] = (unsigned long long)a.in[tid0];
        if (tid0 == 23) ((LAS unsigned long long*)(lds + PTAB_OFF))[23] = (unsigned long long)a.out;
        if (tid0 == 24) ((LAS unsigned long long*)(lds + PTAB_OFF))[24] = (unsigned long long)a.ws;
        __syncthreads();
    }
    volatile LAS unsigned* MISC = (volatile LAS unsigned*)(lds + MISC_OFF);
    const int G = gridDim.x, bid = blockIdx.x, NGW = G * NWAVES;
    const int use_bar = a.use_bar;
    XcdBarrier bar; bar.bar = (unsigned*)(a.ws + WS_CTL) + CW_BAR; bar.x = 0; bar.st = MISC + 8;
    if (use_bar) bar = xcd_barrier_post((unsigned*)(a.ws + WS_CTL) + CW_BAR, MISC + 8);
    const int lo = a.ph_lo, hi = a.ph_hi;
#define IN(k) (lo <= (k) && (k) < hi)
#define SEAM(k) do { if (use_bar && IN(k) && IN((k) + 1)) xcd_barrier(bar); } while (0)
#define PHL() int tid_ = wave0_ * 64 + (int)__builtin_amdgcn_mbcnt_hi(~0u, __builtin_amdgcn_mbcnt_lo(~0u, 0u)); asm volatile("" : "+v"(tid_)); const int lane_ = tid_ & 63, wave_ = __builtin_amdgcn_readfirstlane(tid_ >> 6), gw_ = bid * NWAVES + wave_; (void)lane_; (void)gw_; \
              int pz_ = 0; asm volatile("" : "+s"(pz_))
#define PTR(i) ((const float*)ldptr(lds, (i) + pz_))
#define WSP() ((unsigned char*)ldptr(lds, 24 + pz_))
#define OUTP() ((float*)ldptr(lds, 23 + pz_))

    if (IN(0) && PHON(0)) {
        PHL(); unsigned char* ws = WSP();
        LAS float* scr = (LAS float*)(lds + RING_OFF + wave_ * 16384);
        constexpr int I_IN = 32 * 128, I_OUT = 32 * 64, I_MQ = 32 * 16, I_MKV = 32 * 32, I_MO = 8 * 64, I_PQ = 32 * 64, I_L = I_IN + I_OUT + I_MQ + I_MKV + I_MO + I_PQ;
        for (int it = gw_; it < DEPTH * I_L; it += NGW) {
            const int l = it / I_L; int r = it % I_L;
            if (r < I_IN) { transpose_item<true>(PTR(4) + (size_t)l * DM * DIN, DM, DIN, (bf16*)(ws + WS_WIN) + (size_t)l * DIN * DM, scr, r, lane_, PTR(3) + (size_t)l * DM); continue; } r -= I_IN;
            if (r < I_OUT) { transpose_item<false>(PTR(11) + (size_t)l * DM * DM, DM, DM, (bf16*)(ws + WS_WOUT) + (size_t)l * DM * DM, scr, r, lane_, PTR(10) + (size_t)l * DM); continue; } r -= I_OUT;
            if (r < I_MQ) { transpose_item<false>(PTR(14) + (size_t)l * DM * MEMW, DM, MEMW, (bf16*)(ws + WS_WMQ) + (size_t)l * MEMW * DM, scr, r, lane_, PTR(12) + (size_t)l * DM); continue; } r -= I_MQ;
            if (r < I_MKV) { transpose_item<false>(PTR(15) + (size_t)l * DM * 1024, DM, 1024, (bf16*)(ws + WS_WMKV) + (size_t)l * 1024 * DM, scr, r, lane_); continue; } r -= I_MKV;
            if (r < I_MO) { transpose_item<false>(PTR(17) + (size_t)l * MEMW * DM, MEMW, DM, (bf16*)(ws + WS_WMO) + (size_t)l * DM * MEMW, scr, r, lane_); continue; } r -= I_MO;
            transpose_item<false>(PTR(19) + (size_t)l * DM * DM, DM, DM, (bf16*)(ws + WS_WPQ) + (size_t)l * DM * DM, scr, r, lane_, PTR(18) + (size_t)l * DM);
        }
        const size_t gtid = (size_t)bid * NTHREADS + tid_, nth = (size_t)G * NTHREADS;
        convert_bf16(PTR(20), (bf16*)(ws + WS_PKEYS), (size_t)DEPTH * 8 * 2 * 128 * 128, gtid, nth);
        convert_int4_plain(PTR(21), ws + WS_PU, DEPTH * PEER_N, PU_SCALEI, PTR(18), gw_, NGW, lane_);
        convert_fp4_rows(PTR(22), ws + WS_PV, PEER_N, PV_SCALE4, nullptr, gw_, NGW, lane_);
        {   const float* x0 = PTR(0); bf16* XN = (bf16*)(ws + WS_XN); u64_t* rsq = (u64_t*)(ws + WS_ROWSQ);
            for (int m = 2 * gw_; m < T; m += 2 * NGW) prep_rows2(x0 + (size_t)m * DM, XN + (size_t)m * DM, rsq + m, ws + WS_XN8 + (size_t)m * DM, (float*)(ws + WS_XSC) + m, lane_); }
        {   const float* mem = PTR(1); const float* gkv = PTR(13); bf16* MEMN = (bf16*)(ws + WS_MEMN);
            for (int m = gw_; m < BATCH * NMEM; m += NGW)
                rms_row_to_bf16(mem + (size_t)m * DM, gkv, MEMN + (size_t)m * DM, gkv + DM, MEMN + (size_t)(BATCH * NMEM + m) * DM, lane_); }
        float* rope = (float*)(ws + WS_ROPE); float* biasA = (float*)(ws + WS_BIASA);
        if (gtid < 64 * 16) { const int pos = (int)gtid >> 4, i = (int)gtid & 15; const float ang = (float)pos * ROPE_INV[i]; rope[gtid * 2] = cosf(ang); rope[gtid * 2 + 1] = sinf(ang); }
        if (gtid < 12 * 257) { const int h = (int)gtid / 257, rel = (int)gtid % 257 - 128; biasA[gtid] = PTR(2)[t5_bucket(rel) * 12 + h]; }
    }
    SEAM(0);
    if (IN(1) && PHON(1)) {
        {   PHL(); unsigned char* ws = WSP();
            for (int r = gw_; r < DEPTH * DIN; r += NGW) { const int rr = r & (DIN - 1), src = (rr & ~255) + 64 * ((rr >> 5) & 3) + 32 * ((rr >> 7) & 1) + (rr & 31);
                quant_wrow((const bf16*)(ws + WS_WIN) + (size_t)r * DM, ws + WS_WIN8 + (size_t)r * DM, (float*)(ws + WS_WSC) + (r & ~(DIN - 1)) + src, lane_); }
            for (int r = gw_; r < DEPTH * DM; r += NGW) quant_wrow((const bf16*)(ws + WS_WOUT) + (size_t)r * DM, ws + WS_WOUT8 + (size_t)r * DM, (float*)(ws + WS_WSCO) + r, lane_);
            for (int r = gw_; r < DEPTH * DM; r += NGW) quant_wrow((const bf16*)(ws + WS_WPQ) + (size_t)r * DM, ws + WS_WPQ8 + (size_t)r * DM, (float*)(ws + WS_WSCP) + r, lane_);
            for (int r = gw_; r < DEPTH * MEMW; r += NGW) quant_wrow((const bf16*)(ws + WS_WMQ) + (size_t)r * DM, ws + WS_WMQ8 + (size_t)r * DM, (float*)(ws + WS_WSCM) + r, lane_); }
#pragma unroll 1
        for (int l = 0; l < DEPTH; ++l) {
            PHL(); unsigned char* ws = WSP();
            pg8::Gemm g{(bf16*)(ws + WS_MEMN) + (size_t)l * BATCH * NMEM * DM, (bf16*)(ws + WS_WMKV) + (size_t)l * 1024 * DM, BATCH * NMEM, 1024, DM};
            OffsetOrder S; S.init(BATCH * NMEM, 1024, G, bid, 64 * l);
            bf16* KVMl = (bf16*)(ws + WS_KVM) + (size_t)l * BATCH * NMEM * 1024;
            pg8::EpiBf16<0> E{KVMl, 1024, nullptr, 0, 0, 1.f};
            pg8::gemm_phase<pg8::EpiBf16<0>, OffsetOrder, true, true>(lds + RING_OFF, g, S, E, tid_);
            VM_WAIT(); __syncthreads();
            const float* gk = PTR(16) + (size_t)l * 256 + 128;
#pragma unroll 1
            for (int i = 0; i < 4; ++i) { pg8::Unit uu; uu.pm = 0; uu.pn = 0; if (!S.next(i, uu)) break;
                if (uu.pn < 2) {
                    for (int r2 = wave_; r2 < 128; r2 += NWAVES) { const int row = uu.pm * 256 + 2 * r2 + (lane_ >> 5), cl = lane_ & 31;
                        GAS v4u* p = (GAS v4u*)(KVMl + (size_t)row * 1024 + 256 * uu.pn + 8 * cl);
                        const v4u w = *p;
                        float f[8] = {bflo(w.x), bfhi(w.x), bflo(w.y), bfhi(w.y), bflo(w.z), bfhi(w.z), bflo(w.w), bfhi(w.w)};
                        float ss = 0.f;
#pragma unroll
                        for (int e = 0; e < 8; ++e) ss += f[e] * f[e];
                        ss += shx(ss, 1, lane_); ss += shx(ss, 2, lane_); ss += shx(ss, 4, lane_); ss += shx(ss, 8, lane_);
                        const float r = 1.f / sqrtf(ss * (1.f / 128.f) + EPS);
                        const float* gg = gk + 8 * (cl & 15);
                        v4u o; o.x = pk2(f[0] * r * gg[0], f[1] * r * gg[1]); o.y = pk2(f[2] * r * gg[2], f[3] * r * gg[3]); o.z = pk2(f[4] * r * gg[4], f[5] * r * gg[5]); o.w = pk2(f[6] * r * gg[6], f[7] * r * gg[7]);
                        *p = o; } } }
            __syncthreads();
        }
        if (G >= 256 && bid >= 128) { PHL(); unsigned char* ws = WSP();
            convert_fp4_rows(PTR(22) + (size_t)PEER_N * DM, ws + WS_PV + (size_t)PEER_N * 1024, PEER_N, PV_SCALE4, nullptr, (bid - 128) * NWAVES + wave_, (G - 128) * NWAVES, lane_); }
        else if (G < 256) { PHL(); unsigned char* ws = WSP(); convert_fp4_rows(PTR(22) + (size_t)PEER_N * DM, ws + WS_PV + (size_t)PEER_N * 1024, PEER_N, PV_SCALE4, nullptr, gw_, NGW, lane_); }
    }
    SEAM(1);

#pragma unroll 1
    for (int l = 0; l < DEPTH; ++l) {
        const int pb = PH_BASE + PH_PER_LAYER * l;
        if (IN(pb + 0) && PHON(3)) { PHL(); unsigned char* ws = WSP();
            pg8::Gemm g{(bf16*)(ws + WS_XN8), (bf16*)(ws + WS_WIN8 + (size_t)l * DIN * DM), T, DIN, DM / 2}; pg8::StaticOrder S; S.init(T, DIN, G, bid);
            LAS float* ropel = (LAS float*)(lds + LDSCTL_OFF + 2048);
            for (int i = tid_; i < 64 * 16 * 2; i += NTHREADS) ropel[i] = ((const float*)(ws + WS_ROPE))[i];
            __syncthreads();
            pg8::EpiQKV E{(bf16*)(ws + WS_QKV), PTR(5) + (size_t)l * 128, PTR(7) + (size_t)l * 128, PTR(9) + (size_t)l * 128, ropel, (const u64_t*)(ws + WS_ROWSQ) + (size_t)(l * 3 + 0) * T, (const float*)(ws + WS_XSC), (const float*)(ws + WS_WSC) + (size_t)l * DIN};
            pg8::gemm_phase<pg8::EpiQKV, pg8::StaticOrder, true, true>(lds + RING_OFF, g, S, E, tid_);
        }
        SEAM(pb + 0);
        if (IN(pb + 1) && PHON(4)) { PHL(); unsigned char* ws = WSP();
            const float* sink = PTR(6) + (size_t)l * 12; const float* rpb = PTR(8) + (size_t)l * 8 * 15 * 31; const float* biasA = (const float*)(ws + WS_BIASA);
            const bf16* QKV = (const bf16*)(ws + WS_QKV); bf16* ATT = (bf16*)(ws + WS_ATT);
            const float* ga = PTR(5) + (size_t)l * 128; const float* gb = PTR(7) + (size_t)l * 128; const float* gc = PTR(9) + (size_t)l * 128;
            const float CaL2 = 8.f * wave_max(fabsf(ga[lane_]), lane_) * wave_max(fabsf(ga[64 + lane_]), lane_) * LOG2E;
            const float CbL2 = 8.f * wave_max(fabsf(gb[lane_]), lane_) * wave_max(fabsf(gb[64 + lane_]), lane_) * LOG2E;
            const float CcL2 = 8.f * wave_max(fabsf(gc[lane_]), lane_) * wave_max(fabsf(gc[64 + lane_]), lane_) * LOG2E;
            const int vc = (G % 8 == 0) ? (bid % 8) * (G / 8) + bid / 8 : bid;
            u64_t* mixsq = (u64_t*)(ws + WS_MIXSQ) + (size_t)l * 3 * T;
            for (int u = vc; u < BATCH * 12 * 8; u += G) attn_unit<2>(lds, QKV, ATT, mixsq + 2 * (size_t)T, u / 96, (u >> 3) % 12, u & 7, nullptr, CcL2, 0.f, tid_);
            for (int u = vc; u < BATCH * 8 * 8; u += G) attn_unit<1>(lds, QKV, ATT, mixsq + (size_t)T, u >> 6, (u >> 3) & 7, u & 7, rpb, CbL2, 0.f, tid_);
            for (int u = vc; u < BATCH * 12 * 8; u += G) { const int head = (u >> 3) % 12; attn_unit<0>(lds, QKV, ATT, mixsq, u / 96, head, u & 7, biasA, CaL2, sink[head] * LOG2E, tid_); }
        }
        SEAM(pb + 1);
        if (IN(pb + 2) && PHON(5)) { PHL(); unsigned char* ws = WSP();
            const u64_t* mixsq = (const u64_t*)(ws + WS_MIXSQ) + (size_t)l * 3 * T;
            for (int r = 4 * gw_; r < T; r += 4 * NGW) att_quant_rows<4>((const bf16*)(ws + WS_ATT), mixsq, ws + WS_ATT8, (float*)(ws + WS_XSC2), r, lane_);
        }
        SEAM(pb + 2);
        if (IN(pb + 3) && PHON(5)) { PHL(); unsigned char* ws = WSP();
            pg8::Gemm g{(bf16*)(ws + WS_ATT8), (bf16*)(ws + WS_WOUT8 + (size_t)l * DM * DM), T, DM, DM / 2}; pg8::StaticOrder S; S.init(T, DM, G, bid);
            typedef pg8::EpiResidT<true, 10> EpiX1;
            EpiX1 E{(bf16*)(ws + WS_XN), DM, (u64_t*)(ws + WS_ROWSQ) + (size_t)(l * 3 + 1) * T, (const float*)(ws + WS_XSC2), (const float*)(ws + WS_WSCO) + (size_t)l * DM, ws + WS_X8, (const u64_t*)(ws + WS_ROWSQ) + (size_t)(l * 3 + 0) * T, nullptr, nullptr};
            pg8::gemm_phase<EpiX1, pg8::StaticOrder, true, true>(lds + RING_OFF, g, S, E, tid_);
        }
        SEAM(pb + 3);
        if (IN(pb + 4) && PHON(6)) { PHL(); unsigned char* ws = WSP();
            pg8::Gemm g{(bf16*)(ws + WS_X8), (bf16*)(ws + WS_WMQ8 + (size_t)l * MEMW * DM), T, MEMW, DM / 2}; pg8::StaticOrder S; S.init(T, MEMW, G, bid);
            pg8::EpiBf16Row8<10> E{(bf16*)(ws + WS_QM), MEMW, (const u64_t*)(ws + WS_ROWSQ) + (size_t)(l * 3 + 1) * T, (const u64_t*)(ws + WS_ROWSQ) + (size_t)(l * 3 + 0) * T, (const float*)(ws + WS_WSCM) + (size_t)l * MEMW};
            pg8::gemm_phase<pg8::EpiBf16Row8<10>, pg8::StaticOrder, true, true>(lds + RING_OFF, g, S, E, tid_);
            VM_WAIT(); __syncthreads();
            const bf16* kvm = (const bf16*)(ws + WS_KVM) + (size_t)l * BATCH * NMEM * 1024; const float* gq = PTR(16) + (size_t)l * 256;
            const float CmL2 = 11.313708498984761f * wave_max(fmaxf(fabsf(gq[lane_]), fabsf(gq[64 + lane_])), lane_) * wave_max(fmaxf(fabsf(gq[128 + lane_]), fabsf(gq[192 + lane_])), lane_) * LOG2E;
#pragma unroll 1
            for (int i = 0; i < 4; ++i) { pg8::Unit uu; uu.pm = 0; uu.pn = 0; if (!S.next(i, uu)) break;
                mem_unit(lds, (const bf16*)(ws + WS_QM), kvm, (bf16*)(ws + WS_OM), gq, uu.pm, 2 * uu.pn, CmL2, tid_);
                mem_unit(lds, (const bf16*)(ws + WS_QM), kvm, (bf16*)(ws + WS_OM), gq, uu.pm, 2 * uu.pn + 1, CmL2, tid_);
#if MK_REP == 1
                mem_unit(lds, (const bf16*)(ws + WS_QM), kvm, (bf16*)(ws + WS_OM), gq, uu.pm, 2 * uu.pn, CmL2, tid_); mem_unit(lds, (const bf16*)(ws + WS_QM), kvm, (bf16*)(ws + WS_OM), gq, uu.pm, 2 * uu.pn + 1, CmL2, tid_);
#endif
            }
        }
        SEAM(pb + 4);
        if (IN(pb + 5) && PHON(7)) { PHL(); unsigned char* ws = WSP();
            pg8::Gemm g{(bf16*)(ws + WS_OM), (bf16*)(ws + WS_WMO) + (size_t)l * DM * MEMW, T, DM, MEMW}; pg8::StaticOrder S; S.init(T, DM, G, bid);
            typedef pg8::EpiResidT<false, 8, true> EpiX2;
            EpiX2 E{(bf16*)(ws + WS_XN), DM, (u64_t*)(ws + WS_ROWSQ) + (size_t)(l * 3 + 2) * T, nullptr, nullptr, ws + WS_X8, (const u64_t*)(ws + WS_ROWSQ) + (size_t)(l * 3 + 1) * T, ws + WS_XQH, ws + WS_XQL};
            pg8::gemm_phase<EpiX2, pg8::StaticOrder, true, true>(lds + RING_OFF, g, S, E, tid_);
        }
        SEAM(pb + 5);
        if (IN(pb + 6) && PHON(8)) { PHL(); unsigned char* ws = WSP();
            pg8::Gemm g{(bf16*)(ws + WS_X8), (bf16*)(ws + WS_WPQ8 + (size_t)l * DM * DM), T, DM, DM / 2}; pg8::StaticOrder S; S.init(T, DM, G, bid);
            pg8::EpiBf16Row8<8> E{(bf16*)(ws + WS_QP), DM, (const u64_t*)(ws + WS_ROWSQ) + (size_t)(l * 3 + 2) * T, (const u64_t*)(ws + WS_ROWSQ) + (size_t)(l * 3 + 1) * T, (const float*)(ws + WS_WSCP) + (size_t)l * DM};
            pg8::gemm_phase<pg8::EpiBf16Row8<8>, pg8::StaticOrder, true, true>(lds + RING_OFF, g, S, E, tid_);
            VM_WAIT(); __syncthreads();
            const bf16* pk = (const bf16*)(ws + WS_PKEYS) + (size_t)l * 8 * 2 * 128 * 128;
#pragma unroll 1
            for (int i = 0; i < 8; ++i) { pg8::Unit uu; uu.pm = 0; uu.pn = 0; if (!S.next(i, uu)) break;
                peer_select_unit((const bf16*)(ws + WS_QP), pk, (int*)(ws + WS_PIDX), (float*)(ws + WS_PGATE), uu.pm, uu.pn, wave_, lane_);
#if MK_REP == 2
                peer_select_unit((const bf16*)(ws + WS_QP), pk, (int*)(ws + WS_PIDX), (float*)(ws + WS_PGATE), uu.pm, uu.pn, wave_, lane_);
#endif
#if MK_REP == 3
#endif
            }
        }
        SEAM(pb + 6);
        if (IN(pb + 7) && PHON(9)) { PHL(); unsigned char* ws = WSP();
            peer_u_phase_i4((const unsigned*)(ws + WS_XQH), (const unsigned*)(ws + WS_XQL), ws + WS_PU + (size_t)l * PEER_N * 1024, (const int*)(ws + WS_PIDX), (int*)(ws + WS_PARTI), bid, G, wave_, lane_); }
        SEAM(pb + 7);
        if (IN(pb + 8) && PHON(10)) { PHL(); unsigned char* ws = WSP();
            peer_v_pass((bf16*)(ws + WS_XN), ws + WS_PV + (size_t)l * PEER_N * 1024, (const int*)(ws + WS_PIDX), (const float*)(ws + WS_PGATE), (const int*)(ws + WS_PARTI), (l + 1 == DEPTH) ? OUTP() : (float*)nullptr,
                        (l + 1 < DEPTH) ? (u64_t*)(ws + WS_ROWSQ) + (size_t)((l + 1) * 3 + 0) * T : (u64_t*)nullptr, (l + 1 < DEPTH) ? ws + WS_XN8 : (unsigned char*)nullptr, (float*)(ws + WS_XSC), (const u64_t*)(ws + WS_ROWSQ) + (size_t)(l * 3 + 1) * T, (const u64_t*)(ws + WS_ROWSQ) + (size_t)(l * 3 + 2) * T, (LAS float*)(lds + RING_OFF + wave_ * 1024), gw_, NGW, lane_); }
        SEAM(pb + 8);
    }
#undef IN
#undef SEAM
}

#ifndef MK_MULTI_LAUNCH
#define MK_MULTI_LAUNCH 0
#endif
extern "C" void kernel_launch(void* const* d_in, const int* in_sizes, int n_in, void* d_out, int out_size, void* d_ws, size_t ws_size, hipStream_t stream) {
    static int grid = 0;
    if (grid == 0) {
        if (n_in != 23 || out_size != T * DM || ws_size < WS_END) { fprintf(stderr, "kernel_launch: unexpected shapes (n_in %d, out %d, ws %zu)\n", n_in, out_size, ws_size); grid = -1; return; }
        int dev = 0, cus = 0, per_cu = 0;
        if (hipGetDevice(&dev) != hipSuccess || hipDeviceGetAttribute(&cus, hipDeviceAttributeMultiprocessorCount, dev) != hipSuccess) { grid = -1; return; }
        if (hipFuncSetAttribute((const void*)mega, hipFuncAttributeMaxDynamicSharedMemorySize, LDS_BYTES) != hipSuccess) { fprintf(stderr, "kernel_launch: hipFuncSetAttribute failed\n"); grid = -1; return; }
        if (hipOccupancyMaxActiveBlocksPerMultiprocessor(&per_cu, (const void*)mega, NTHREADS, LDS_BYTES) != hipSuccess || per_cu < 1) { fprintf(stderr, "kernel_launch: occupancy query says %d\n", per_cu); }
        (void)hipGetLastError();
        grid = cus;
    }
    if (grid < 0) return;
    (void)hipMemsetAsync((char*)d_ws + WS_CTL, 0, CTL_ZERO_BYTES, stream);
    (void)hipMemsetAsync((char*)d_ws + WS_MIXSQ, 0, MIXSQ_BYTES, stream);
    Args a{};
    for (int i = 0; i < 23; ++i) a.in[i] = (const float*)d_in[i];
    a.out = (float*)d_out; a.ws = (unsigned char*)d_ws;
#if MK_MULTI_LAUNCH
    for (int p = 0; p < N_PHASES; ++p) { a.ph_lo = p; a.ph_hi = p + 1; a.use_bar = 0; a.pad = 0; hipLaunchKernelGGL(mega, dim3(grid), dim3(NTHREADS), LDS_BYTES, stream, a); }
#else
    a.ph_lo = 0; a.ph_hi = N_PHASES; a.use_bar = 1; a.pad = 0;
    hipLaunchKernelGGL(mega, dim3(grid), dim3(NTHREADS), LDS_BYTES, stream, a);
#endif
    const hipError_t le = hipPeekAtLastError();
    if (le != hipSuccess) fprintf(stderr, "kernel_launch: launch failed: %s\n", hipGetErrorName(le));
}
```

```cpp
#include <hip/hip_runtime.h>
#include <cstdio>
#include <cstdint>
#include <cmath>
__device__ __forceinline__ float shx(float v, int k, int lane);
typedef unsigned long long u64_t;
__device__ __forceinline__ float rowsq_rs(const u64_t* rowsq, int row) { return 1.0f / sqrtf((float)*(const __attribute__((address_space(1))) u64_t*)(rowsq + row) * (5.9604644775390625e-08f / 2048.0f) + 1e-6f); }
__device__ __forceinline__ u64_t rowsq_fx(float ss) { return (u64_t)(ss * 16777216.0f + 0.5f); }
template <int HI = 255>
__device__ __forceinline__ unsigned q8x4c(float a, float b, float c, float d, float inv) {
    unsigned w = 0;
    w = __builtin_amdgcn_cvt_pk_u8_f32(__builtin_rintf(__builtin_amdgcn_fmed3f(__builtin_fmaf(a, inv, 128.f), 1.f, (float)HI)), 0, w); w = __builtin_amdgcn_cvt_pk_u8_f32(__builtin_rintf(__builtin_amdgcn_fmed3f(__builtin_fmaf(b, inv, 128.f), 1.f, (float)HI)), 1, w);
    w = __builtin_amdgcn_cvt_pk_u8_f32(__builtin_rintf(__builtin_amdgcn_fmed3f(__builtin_fmaf(c, inv, 128.f), 1.f, (float)HI)), 2, w); w = __builtin_amdgcn_cvt_pk_u8_f32(__builtin_rintf(__builtin_amdgcn_fmed3f(__builtin_fmaf(d, inv, 128.f), 1.f, (float)HI)), 3, w);
    return w ^ 0x80808080u;
}
__device__ __forceinline__ unsigned dig_lo4(unsigned d) { return d & 0x0f0f0f0fu; }
__device__ __forceinline__ unsigned dig_hi4(unsigned d) { const unsigned t = ((d & 0x7f7f7f7fu) + 0x08080808u) ^ (d & 0x80808080u); return (t >> 4) & 0x0f0f0f0fu; }
__device__ __forceinline__ unsigned nib_pack8(unsigned a, unsigned b) { a = (a | (a >> 4)) & 0x00ff00ffu; a = (a | (a >> 8)) & 0xffffu; b = (b | (b >> 4)) & 0x00ff00ffu; b = (b | (b >> 8)) & 0xffffu; return a | (b << 16); }
namespace pg8 {
#define PG8_LAS __attribute__((address_space(3)))
#define PG8_GAS __attribute__((address_space(1)))
typedef unsigned short bf16_t;
typedef short bf16x8 __attribute__((ext_vector_type(8)));
typedef float f32x4 __attribute__((ext_vector_type(4)));
typedef unsigned u32x4 __attribute__((ext_vector_type(4)));
constexpr int BM = 256, BK = 64, HALF = 128, HTB = HALF * BK * 2  , STAGE_BYTES = 8 * HTB, NXCD = 8, WGM = 8;

__host__ __device__ __forceinline__ int lds_byte(int r, int c) { const int st = (r >> 4) * 2 + (c >> 5), rr = r & 15, cc = c & 31, ob = rr * 64 + cc * 2; return st * 1024 + (ob ^ (((ob >> 9) & 1) << 5)); }
__host__ __device__ __forceinline__ void stage_rc(int b, int& R, int& C) { const int st = b / 1024, sb = b % 1024, swz = sb ^ (((sb >> 9) & 1) << 5); R = (st >> 1) * 16 + swz / 64; C = (st & 1) * 32 + (swz % 64) / 2; }
__host__ __device__ __forceinline__ int perm32(int rho) { const int n = rho >> 4, i = rho & 15; return 8 * (i >> 2) + 4 * n + (i & 3); }

struct Unit { int pm, pn; };
struct Gemm { const bf16_t* A; const bf16_t* Bt; int M, N, K; };

struct StaticOrder {
    int nM, nN, nwg, G, c;
    __host__ __device__ __forceinline__ void init(int M, int N, int G_, int c_) { nM = M / BM; nN = N / BM; nwg = nM * nN; G = G_; c = c_; }
    __host__ __device__ __forceinline__ bool next(int i, Unit& u) const {
        const long L = (long)i * G + c; if (L >= nwg) return false;
        int wgid = (int)L; { const int q = nwg / NXCD, r = nwg % NXCD, xcd = wgid % NXCD, off = wgid / NXCD; wgid = (xcd < r ? xcd * (q + 1) : r * (q + 1) + (xcd - r) * q) + off; }
        const int nig = WGM * nN, gid = wgid / nig, fm = gid * WGM, gsz = (nM - fm) < WGM ? (nM - fm) : WGM;
        u.pm = fm + ((wgid % nig) % gsz); u.pn = (wgid % nig) / gsz; return true;
    }
    __device__ __forceinline__ void a_ready(const Unit&) const {}
    __device__ __forceinline__ void done(const Unit&) const {}
};

__device__ __forceinline__ unsigned cvt_pk_bf16(float lo, float hi) { unsigned r; asm volatile("v_cvt_pk_bf16_f32 %0, %1, %2" : "=v"(r) : "v"(lo), "v"(hi)); return r; }
typedef float f32x2 __attribute__((ext_vector_type(2)));
__device__ __forceinline__ f32x2 gelu_pk(f32x2 v) {
    const f32x2 av = __builtin_elementwise_abs(v), d = av * 0.2316418882f + 1.0f;
    f32x2 t; t.x = __builtin_amdgcn_rcpf(d.x); t.y = __builtin_amdgcn_rcpf(d.y);
    f32x2 q = t * 0.5307027145f + (-0.7265760135f); q = q * t + 0.7107068705f; q = q * t + (-0.142248368f); q = q * t + 0.127414796f; q = q * t;
    const f32x2 s = (v * v) * (-0.72134752044f);
    f32x2 e; e.x = __builtin_amdgcn_exp2f(s.x); e.y = __builtin_amdgcn_exp2f(s.y);
    const f32x2 m = v * (q * e), r = v - m;
    f32x2 o; o.x = v.x < 0.f ? m.x : r.x; o.y = v.y < 0.f ? m.y : r.y; return o;
}

template <int ACT  > struct EpiBf16 {
    static constexpr bool PERM = true, AFTER_DRAIN = false, KSCALE = false, I8 = false; static_assert(ACT == 0 || ACT == 1, "EpiBf16: ACT is 0 (none) or 1 (gelu_pk)");
    bf16_t* O; int ldc; const float* bias; int split_cols; size_t split_stride; float scale0;
    __device__ __forceinline__ void operator()(const f32x4 (&acc)[2][2][4][2], const Unit& u, int wr, int wc, int fr, int fq) const {
        const int row0 = u.pm * BM + wr * 64 + fr; int colt = u.pn * BM; bf16_t* base = O;
        float sc = 1.f; if (split_cols) { const int t = colt / split_cols; base += (size_t)t * split_stride; colt -= t * split_cols; if (t == 0) sc = scale0; }
        const int col0 = colt + wc * 32 + 8 * fq, bcol0 = u.pn * BM + wc * 32 + 8 * fq;
        f32x4 bv[2][2];
#pragma unroll
        for (int bj = 0; bj < 2; ++bj)
#pragma unroll
            for (int n = 0; n < 2; ++n) bv[bj][n] = bias ? *(const PG8_GAS f32x4*)(bias + bcol0 + bj * HALF + 4 * n) : (f32x4){0.f, 0.f, 0.f, 0.f};
#pragma unroll
        for (int ai = 0; ai < 2; ++ai)
#pragma unroll
            for (int m = 0; m < 4; ++m) { bf16_t* rowp = base + (size_t)(row0 + ai * HALF + m * 16) * ldc + col0;
#pragma unroll
                for (int bj = 0; bj < 2; ++bj) { f32x4 v0 = acc[ai][bj][m][0] + bv[bj][0], v1 = acc[ai][bj][m][1] + bv[bj][1];
                    if (ACT == 1) { f32x2 a = gelu_pk((f32x2){v0[0], v0[1]}), b = gelu_pk((f32x2){v0[2], v0[3]}), c = gelu_pk((f32x2){v1[0], v1[1]}), d = gelu_pk((f32x2){v1[2], v1[3]});
                        v0 = (f32x4){a.x, a.y, b.x, b.y}; v1 = (f32x4){c.x, c.y, d.x, d.y}; }
                    v0 = v0 * sc; v1 = v1 * sc; u32x4 w; w.x = cvt_pk_bf16(v0[0], v0[1]); w.y = cvt_pk_bf16(v0[2], v0[3]); w.z = cvt_pk_bf16(v1[0], v1[1]); w.w = cvt_pk_bf16(v1[2], v1[3]);
                    *(PG8_GAS u32x4*)(rowp + bj * HALF) = w; } }
    }
};

typedef unsigned u32x2 __attribute__((ext_vector_type(2)));
typedef int i32x4 __attribute__((ext_vector_type(4)));
struct EpiResid {
    static constexpr bool PERM = false, AFTER_DRAIN = false, KSCALE = false, I8 = false;
    bf16_t* s; int ldc; u64_t* rowsq;
    __device__ __forceinline__ void operator()(const f32x4 (&acc)[2][2][4][2], const Unit& u, int wr, int wc, int fr, int fq) const {
        const int col0 = u.pn * BM + wc * 32 + 4 * fq;
#pragma unroll
        for (int ai = 0; ai < 2; ++ai)
#pragma unroll
            for (int m = 0; m < 4; ++m) { const int row = u.pm * BM + ai * HALF + wr * 64 + m * 16 + fr; bf16_t* sp = s + (size_t)row * ldc + col0; float ss = 0.f;
                u32x2 in[2][2];
#pragma unroll
                for (int bj = 0; bj < 2; ++bj)
#pragma unroll
                    for (int n = 0; n < 2; ++n) in[bj][n] = *(const PG8_GAS u32x2*)(sp + bj * HALF + n * 16);
#pragma unroll
                for (int bj = 0; bj < 2; ++bj)
#pragma unroll
                    for (int n = 0; n < 2; ++n) { const u32x2 w0 = in[bj][n];
                        const f32x4 bs = (f32x4){__builtin_bit_cast(float, w0.x << 16), __builtin_bit_cast(float, w0.x & 0xffff0000u), __builtin_bit_cast(float, w0.y << 16), __builtin_bit_cast(float, w0.y & 0xffff0000u)};
                        const f32x4 o = bs + acc[ai][bj][m][n]; ss += (o[0] * o[0] + o[1] * o[1]) + (o[2] * o[2] + o[3] * o[3]);
                        u32x2 w; w.x = cvt_pk_bf16(o[0], o[1]); w.y = cvt_pk_bf16(o[2], o[3]); *(PG8_GAS u32x2*)(sp + bj * HALF + n * 16) = w; }
                ss += shx(ss, 16, fr + 16 * fq); ss += shx(ss, 32, fr + 16 * fq);
                if (fq == 0) (void)__hip_atomic_fetch_add((PG8_GAS u64_t*)(rowsq + row), rowsq_fx(ss), __ATOMIC_RELAXED, __HIP_MEMORY_SCOPE_AGENT); }
    }
};
struct EpiResid8 {
    static constexpr bool PERM = false, AFTER_DRAIN = false, KSCALE = false, I8 = true;
    bf16_t* s; int ldc; u64_t* rowsq; const float* xsc; const float* wsc;
    __device__ __forceinline__ void operator()(const f32x4 (&acc)[2][2][4][2], const Unit& u, int wr, int wc, int fr, int fq) const {
        const int col0 = u.pn * BM + wc * 32 + 4 * fq;
#pragma unroll
        for (int ai = 0; ai < 2; ++ai)
#pragma unroll
            for (int m = 0; m < 4; ++m) { const int row = u.pm * BM + ai * HALF + wr * 64 + m * 16 + fr; bf16_t* sp = s + (size_t)row * ldc + col0; float ss = 0.f; const float xs = *(const PG8_GAS float*)(xsc + row);
                u32x2 in[2][2];
#pragma unroll
                for (int bj = 0; bj < 2; ++bj)
#pragma unroll
                    for (int n = 0; n < 2; ++n) in[bj][n] = *(const PG8_GAS u32x2*)(sp + bj * HALF + n * 16);
#pragma unroll
                for (int bj = 0; bj < 2; ++bj)
#pragma unroll
                    for (int n = 0; n < 2; ++n) { const u32x2 w0 = in[bj][n]; const i32x4 ia = __builtin_bit_cast(i32x4, acc[ai][bj][m][n]);
                        const f32x4 bs = (f32x4){__builtin_bit_cast(float, w0.x << 16), __builtin_bit_cast(float, w0.x & 0xffff0000u), __builtin_bit_cast(float, w0.y << 16), __builtin_bit_cast(float, w0.y & 0xffff0000u)};
                        const f32x4 o = bs + (f32x4){(float)ia[0], (float)ia[1], (float)ia[2], (float)ia[3]} * *(const PG8_GAS f32x4*)(wsc + col0 + bj * HALF + n * 16) * xs; ss += (o[0] * o[0] + o[1] * o[1]) + (o[2] * o[2] + o[3] * o[3]);
                        u32x2 w; w.x = cvt_pk_bf16(o[0], o[1]); w.y = cvt_pk_bf16(o[2], o[3]); *(PG8_GAS u32x2*)(sp + bj * HALF + n * 16) = w; }
                ss += shx(ss, 16, fr + 16 * fq); ss += shx(ss, 32, fr + 16 * fq);
                if (fq == 0) (void)__hip_atomic_fetch_add((PG8_GAS u64_t*)(rowsq + row), rowsq_fx(ss), __ATOMIC_RELAXED, __HIP_MEMORY_SCOPE_AGENT); }
    }
};
template <bool I8IN, int QOUT, bool DIG = false>
struct EpiResidT {
    static constexpr bool PERM = true, AFTER_DRAIN = false, KSCALE = false, I8 = I8IN;
    bf16_t* s; int ldc; u64_t* rowsq; const float* xsc; const float* wsc; unsigned char* q8; const u64_t* rowsq_prev; unsigned char* dgh; unsigned char* dgl;
    __device__ __forceinline__ void operator()(const f32x4 (&acc)[2][2][4][2], const Unit& u, int wr, int wc, int fr, int fq) const {
        const int col0 = u.pn * BM + wc * 32 + 8 * fq, rowb = u.pm * BM + wr * 64 + fr;
        f32x4 wv[2][2];
        if constexpr (I8IN) {
#pragma unroll
            for (int bj = 0; bj < 2; ++bj) { wv[bj][0] = *(const PG8_GAS f32x4*)(wsc + col0 + bj * HALF); wv[bj][1] = *(const PG8_GAS f32x4*)(wsc + col0 + bj * HALF + 4); } }
#pragma unroll
        for (int ai = 0; ai < 2; ++ai) {
            u32x4 in[4][2]; float xs[4], qv[4];
#pragma unroll
            for (int m = 0; m < 4; ++m) { const int row = rowb + ai * HALF + m * 16; const bf16_t* sp = s + (size_t)row * ldc + col0;
#pragma unroll
                for (int bj = 0; bj < 2; ++bj) in[m][bj] = *(const PG8_GAS u32x4*)(sp + bj * HALF);
                if constexpr (I8IN) xs[m] = *(const PG8_GAS float*)(xsc + row); else xs[m] = 1.f;
                if constexpr (QOUT > 0) qv[m] = (127.0f / QOUT) * rowsq_rs(rowsq_prev, row); else qv[m] = 0.f; }
            __builtin_amdgcn_sched_barrier(0);
#pragma unroll
            for (int m = 0; m < 4; ++m) { const int row = rowb + ai * HALF + m * 16; bf16_t* sp = s + (size_t)row * ldc + col0; float ss = 0.f;
#pragma unroll
                for (int bj = 0; bj < 2; ++bj) { const u32x4 w0 = in[m][bj]; f32x4 a0 = acc[ai][bj][m][0], a1 = acc[ai][bj][m][1];
                    if constexpr (I8IN) { const i32x4 i0 = __builtin_bit_cast(i32x4, a0), i1 = __builtin_bit_cast(i32x4, a1);
                        a0 = (f32x4){(float)i0[0], (float)i0[1], (float)i0[2], (float)i0[3]} * wv[bj][0] * xs[m];
                        a1 = (f32x4){(float)i1[0], (float)i1[1], (float)i1[2], (float)i1[3]} * wv[bj][1] * xs[m]; }
                    const f32x4 o0 = (f32x4){__builtin_bit_cast(float, w0.x << 16), __builtin_bit_cast(float, w0.x & 0xffff0000u), __builtin_bit_cast(float, w0.y << 16), __builtin_bit_cast(float, w0.y & 0xffff0000u)} + a0;
                    const f32x4 o1 = (f32x4){__builtin_bit_cast(float, w0.z << 16), __builtin_bit_cast(float, w0.z & 0xffff0000u), __builtin_bit_cast(float, w0.w << 16), __builtin_bit_cast(float, w0.w & 0xffff0000u)} + a1;
                    ss += ((o0[0] * o0[0] + o0[1] * o0[1]) + (o0[2] * o0[2] + o0[3] * o0[3])) + ((o1[0] * o1[0] + o1[1] * o1[1]) + (o1[2] * o1[2] + o1[3] * o1[3]));
                    u32x4 w; w.x = cvt_pk_bf16(o0[0], o0[1]); w.y = cvt_pk_bf16(o0[2], o0[3]); w.z = cvt_pk_bf16(o1[0], o1[1]); w.w = cvt_pk_bf16(o1[2], o1[3]); *(PG8_GAS u32x4*)(sp + bj * HALF) = w;
                    if constexpr (QOUT > 0) { u32x2 q; q.x = q8x4c<DIG ? 247 : 255>(o0[0], o0[1], o0[2], o0[3], qv[m]); q.y = q8x4c<DIG ? 247 : 255>(o1[0], o1[1], o1[2], o1[3], qv[m]); *(PG8_GAS u32x2*)(q8 + (size_t)row * ldc + col0 + bj * HALF) = q;
                        if constexpr (DIG) { const size_t db = (size_t)row * 1024 + ((col0 + bj * HALF) >> 1);
                            *(PG8_GAS unsigned*)(dgl + db) = nib_pack8(dig_lo4(q.x), dig_lo4(q.y)); *(PG8_GAS unsigned*)(dgh + db) = nib_pack8(dig_hi4(q.x), dig_hi4(q.y)); } } }
                ss += shx(ss, 16, fr + 16 * fq); ss += shx(ss, 32, fr + 16 * fq);
                if (fq == 0) (void)__hip_atomic_fetch_add((PG8_GAS u64_t*)(rowsq + row), rowsq_fx(ss), __ATOMIC_RELAXED, __HIP_MEMORY_SCOPE_AGENT); }
            __builtin_amdgcn_sched_barrier(0);
        }
    }
};
template <int QIN>
struct EpiBf16Row8 {
    static constexpr bool PERM = true, AFTER_DRAIN = false, KSCALE = false, I8 = true;
    bf16_t* O; int ldc; const u64_t* rowsq; const u64_t* rowsq_prev; const float* wsc;
    __device__ __forceinline__ void operator()(const f32x4 (&acc)[2][2][4][2], const Unit& u, int wr, int wc, int fr, int fq) const {
        const int row0 = u.pm * BM + wr * 64 + fr, col0 = u.pn * BM + wc * 32 + 8 * fq;
        float rs[2][4]; f32x4 wv[2][2];
#pragma unroll
        for (int ai = 0; ai < 2; ++ai)
#pragma unroll
            for (int m = 0; m < 4; ++m) { const int row = row0 + ai * HALF + m * 16; rs[ai][m] = rowsq_rs(rowsq, row) * (QIN / 127.0f) / rowsq_rs(rowsq_prev, row); }
#pragma unroll
        for (int bj = 0; bj < 2; ++bj) { wv[bj][0] = *(const PG8_GAS f32x4*)(wsc + col0 + bj * HALF); wv[bj][1] = *(const PG8_GAS f32x4*)(wsc + col0 + bj * HALF + 4); }
        __builtin_amdgcn_sched_barrier(0);
#pragma unroll
        for (int ai = 0; ai < 2; ++ai)
#pragma unroll
            for (int m = 0; m < 4; ++m) { const int row = row0 + ai * HALF + m * 16; bf16_t* rowp = O + (size_t)row * ldc + col0;
#pragma unroll
                for (int bj = 0; bj < 2; ++bj) { const i32x4 i0 = __builtin_bit_cast(i32x4, acc[ai][bj][m][0]), i1 = __builtin_bit_cast(i32x4, acc[ai][bj][m][1]);
                    const f32x4 v0 = (f32x4){(float)i0[0], (float)i0[1], (float)i0[2], (float)i0[3]} * wv[bj][0] * rs[ai][m], v1 = (f32x4){(float)i1[0], (float)i1[1], (float)i1[2], (float)i1[3]} * wv[bj][1] * rs[ai][m];
                    u32x4 w; w.x = cvt_pk_bf16(v0[0], v0[1]); w.y = cvt_pk_bf16(v0[2], v0[3]); w.z = cvt_pk_bf16(v1[0], v1[1]); w.w = cvt_pk_bf16(v1[2], v1[3]);
                    *(PG8_GAS u32x4*)(rowp + bj * HALF) = w; } }
    }
};
struct EpiResidMix {
    static constexpr bool PERM = false, AFTER_DRAIN = false, KSCALE = true, I8 = false; static constexpr int KS0 = 12, KS1 = 20;
    bf16_t* s; int ldc; u64_t* rowsq; const PG8_LAS float* ftab; const PG8_LAS int* pmtab;
    __device__ __forceinline__ int slot(int pm) const { return pmtab[0] == pm ? 0 : (pmtab[1] == pm ? 1 : (pmtab[2] == pm ? 2 : 3)); }
    __device__ __forceinline__ void kscale(f32x4 (&acc)[2][2][4][2], const Unit& u, int which, int wr, int fr) const {
        const PG8_LAS float* ft = ftab + which * 1024 + slot(u.pm) * 256;
#pragma unroll
        for (int ai = 0; ai < 2; ++ai)
#pragma unroll
            for (int m = 0; m < 4; ++m) { const float f = ft[ai * HALF + wr * 64 + m * 16 + fr];
#pragma unroll
                for (int bj = 0; bj < 2; ++bj)
#pragma unroll
                    for (int n = 0; n < 2; ++n) acc[ai][bj][m][n] = acc[ai][bj][m][n] * f; }
    }
    __device__ __forceinline__ void operator()(const f32x4 (&acc)[2][2][4][2], const Unit& u, int wr, int wc, int fr, int fq) const {
        const int col0 = u.pn * BM + wc * 32 + 4 * fq;
#pragma unroll
        for (int ai = 0; ai < 2; ++ai)
#pragma unroll
            for (int m = 0; m < 4; ++m) { const int row = u.pm * BM + ai * HALF + wr * 64 + m * 16 + fr; bf16_t* sp = s + (size_t)row * ldc + col0; float ss = 0.f; const float rc = ftab[2048 + slot(u.pm) * 256 + ai * HALF + wr * 64 + m * 16 + fr];
                u32x2 in[2][2];
#pragma unroll
                for (int bj = 0; bj < 2; ++bj)
#pragma unroll
                    for (int n = 0; n < 2; ++n) in[bj][n] = *(const PG8_GAS u32x2*)(sp + bj * HALF + n * 16);
#pragma unroll
                for (int bj = 0; bj < 2; ++bj)
#pragma unroll
                    for (int n = 0; n < 2; ++n) { const u32x2 w0 = in[bj][n];
                        const f32x4 bs = (f32x4){__builtin_bit_cast(float, w0.x << 16), __builtin_bit_cast(float, w0.x & 0xffff0000u), __builtin_bit_cast(float, w0.y << 16), __builtin_bit_cast(float, w0.y & 0xffff0000u)};
                        const f32x4 o = bs + acc[ai][bj][m][n] * rc; ss += (o[0] * o[0] + o[1] * o[1]) + (o[2] * o[2] + o[3] * o[3]);
                        u32x2 w; w.x = cvt_pk_bf16(o[0], o[1]); w.y = cvt_pk_bf16(o[2], o[3]); *(PG8_GAS u32x2*)(sp + bj * HALF + n * 16) = w; }
                ss += shx(ss, 16, fr + 16 * fq); ss += shx(ss, 32, fr + 16 * fq);
                if (fq == 0) (void)__hip_atomic_fetch_add((PG8_GAS u64_t*)(rowsq + row), rowsq_fx(ss), __ATOMIC_RELAXED, __HIP_MEMORY_SCOPE_AGENT); }
    }
};
struct EpiBf16Row {
    static constexpr bool PERM = true, AFTER_DRAIN = false, KSCALE = false, I8 = false;
    bf16_t* O; int ldc; const u64_t* rowsq;
    __device__ __forceinline__ void operator()(const f32x4 (&acc)[2][2][4][2], const Unit& u, int wr, int wc, int fr, int fq) const {
        const int row0 = u.pm * BM + wr * 64 + fr, col0 = u.pn * BM + wc * 32 + 8 * fq;
#pragma unroll
        for (int ai = 0; ai < 2; ++ai)
#pragma unroll
            for (int m = 0; m < 4; ++m) { const int row = row0 + ai * HALF + m * 16; const float rs = rowsq_rs(rowsq, row); bf16_t* rowp = O + (size_t)row * ldc + col0;
#pragma unroll
                for (int bj = 0; bj < 2; ++bj) { const f32x4 v0 = acc[ai][bj][m][0] * rs, v1 = acc[ai][bj][m][1] * rs; u32x4 w; w.x = cvt_pk_bf16(v0[0], v0[1]); w.y = cvt_pk_bf16(v0[2], v0[3]); w.z = cvt_pk_bf16(v1[0], v1[1]); w.w = cvt_pk_bf16(v1[2], v1[3]);
                    *(PG8_GAS u32x4*)(rowp + bj * HALF) = w; } }
    }
};
struct EpiQKV {
    static constexpr bool PERM = false, AFTER_DRAIN = false, KSCALE = false, I8 = true;
    bf16_t* O; const float* ga; const float* gb; const float* gc; const PG8_LAS float* rope; const u64_t* rowsq; const float* xsc; const float* wsc;
    __device__ __forceinline__ void operator()(const f32x4 (&acc)[2][2][4][2], const Unit& u, int wr, int wc, int fr, int fq) const {
        const int hg = u.pn * 4 + wc;
        const float* g = nullptr; bool isq = false, dorope = false;
        if (hg < 12) { g = ga; isq = true; } else if (hg < 16) { g = ga + 64; } else if (hg < 20) { }
        else if (hg < 28) { g = gb; isq = true; } else if (hg < 36) { g = gb + 64; } else if (hg < 44) { }
        else if (hg < 56) { g = gc; isq = true; dorope = true; } else if (hg < 60) { g = gc + 64; dorope = true; }
        const float qs = isq ? 0.18033688011112042f : 1.0f;
        float rsxa[2][4]; f32x4 wv[2][2], gv[2][2];
#pragma unroll
        for (int ai = 0; ai < 2; ++ai)
#pragma unroll
            for (int m = 0; m < 4; ++m) { const int row = u.pm * BM + ai * HALF + wr * 64 + m * 16 + fr; rsxa[ai][m] = *(const PG8_GAS float*)(xsc + row); }
#pragma unroll
        for (int bj = 0; bj < 2; ++bj)
#pragma unroll
            for (int n = 0; n < 2; ++n) { wv[bj][n] = *(const PG8_GAS f32x4*)(wsc + hg * 64 + 32 * bj + 16 * n + 4 * fq); gv[bj][n] = g ? *(const PG8_GAS f32x4*)(g + 32 * bj + 16 * n + 4 * fq) : (f32x4){1.f, 1.f, 1.f, 1.f}; }
        __builtin_amdgcn_sched_barrier(0);
#pragma unroll
        for (int ai = 0; ai < 2; ++ai)
#pragma unroll
            for (int m = 0; m < 4; ++m) {
                const int row = u.pm * BM + ai * HALF + wr * 64 + m * 16 + fr;
                f32x4 v[2][2];
                const float rsx = rsxa[ai][m];
#pragma unroll
                for (int bj = 0; bj < 2; ++bj)
#pragma unroll
                    for (int n = 0; n < 2; ++n) { const i32x4 ia = __builtin_bit_cast(i32x4, acc[ai][bj][m][n]);
                        v[bj][n] = (f32x4){(float)ia[0], (float)ia[1], (float)ia[2], (float)ia[3]} * wv[bj][n] * rsx; }
                if (g) {
                    float ss = 0.f;
#pragma unroll
                    for (int bj = 0; bj < 2; ++bj)
#pragma unroll
                        for (int n = 0; n < 2; ++n) { const f32x4 x = v[bj][n]; ss += (x[0] * x[0] + x[1] * x[1]) + (x[2] * x[2] + x[3] * x[3]); }
                    ss += shx(ss, 16, fr + 16 * fq); ss += shx(ss, 32, fr + 16 * fq);
                    const float r = qs / sqrtf(ss * (1.0f / 64.0f) + 1e-6f);
#pragma unroll
                    for (int bj = 0; bj < 2; ++bj)
#pragma unroll
                        for (int n = 0; n < 2; ++n) v[bj][n] = v[bj][n] * gv[bj][n] * r;
                }
                if (dorope) {
                    const int t = row & 2047, pr = t >> 6, pc = t & 63;
#pragma unroll
                    for (int bj = 0; bj < 2; ++bj) {
                        const int pos = bj ? pc : pr;
                        const PG8_LAS float* rp = rope + (pos * 16 + 4 * fq) * 2;
                        const f32x4 c01 = *(const PG8_LAS f32x4*)rp, c23 = *(const PG8_LAS f32x4*)(rp + 4);
                        const f32x4 cs = (f32x4){c01[0], c01[2], c23[0], c23[2]}, sn = (f32x4){c01[1], c01[3], c23[1], c23[3]};
                        const f32x4 x1 = v[bj][0], x2 = v[bj][1];
                        v[bj][0] = x1 * cs - x2 * sn; v[bj][1] = x1 * sn + x2 * cs;
                    }
                }
                bf16_t* rowp = O + (size_t)row * 4096 + hg * 64 + 4 * fq;
#pragma unroll
                for (int bj = 0; bj < 2; ++bj)
#pragma unroll
                    for (int n = 0; n < 2; ++n) { u32x2 w; w.x = cvt_pk_bf16(v[bj][n][0], v[bj][n][1]); w.y = cvt_pk_bf16(v[bj][n][2], v[bj][n][3]); *(PG8_GAS u32x2*)(rowp + 32 * bj + 16 * n) = w; }
                asm volatile("" ::: "memory");
            }
    }
};
template <bool I8> __device__ __forceinline__ f32x4 mma16(const bf16x8 b, const bf16x8 a, const f32x4 c) {
    if constexpr (I8) return __builtin_bit_cast(f32x4, __builtin_amdgcn_mfma_i32_16x16x64_i8(__builtin_bit_cast(i32x4, b), __builtin_bit_cast(i32x4, a), __builtin_bit_cast(i32x4, c), 0, 0, 0));
    else return __builtin_amdgcn_mfma_f32_16x16x32_bf16(b, a, c, 0, 0, 0);
}
template <class Epi, class Sched, bool ALIGN_EPI = false, bool SP2 = false>
__device__ __forceinline__ void gemm_phase(PG8_LAS unsigned char* lds, const Gemm g, const Sched& S, const Epi& E, const int tid) {
    const int wid = __builtin_amdgcn_readfirstlane(tid >> 6), lane = tid & 63, wr = wid >> 2, wc = wid & 3, fr = lane & 15, fq = lane >> 4;
    const int K = g.K, nt = K / BK;
    unsigned voffA[2], voffB[2];
#pragma unroll
    for (int i = 0; i < 2; ++i) { int R, C; stage_rc(tid * 16 + i * 8192, R, C); const int Rb = Epi::PERM ? ((R & ~31) + perm32(R & 31)) : R;
        voffA[i] = (unsigned)(R * K + C) * 2u; voffB[i] = (unsigned)(Rb * K + C) * 2u; }
    const size_t kstep = (size_t)(BK * 2);
    const size_t hstep = (size_t)HALF * K * 2;
    const size_t tstep = 2 * hstep;
    const unsigned ldsw = (unsigned)wid * 1024u;
    const int aoff = lds_byte(wr * 64 + fr, fq * 8), boff = lds_byte(wc * 32 + fr, fq * 8);
#define PG8_SA(b, h) (((b) * 2 + (h)) * HTB)
#define PG8_SB(b, h) ((4 + (b) * 2 + (h)) * HTB)
#define PG8_STAGE(bufoff, gbase, voff) do { _Pragma("unroll") for (int _i = 0; _i < 2; ++_i) \
        __builtin_amdgcn_global_load_lds((const unsigned*)((const char*)(gbase) + (voff)[_i]), (PG8_LAS unsigned*)(lds + (bufoff) + ldsw + _i * 8192), 16, 0, 0); } while (0)
#define PG8_LDA(dst, b, h) do { _Pragma("unroll") for (int m = 0; m < 4; ++m) _Pragma("unroll") for (int k = 0; k < 2; ++k) dst[m][k] = *(const PG8_LAS bf16x8*)(lds + PG8_SA(b, h) + aoff + m * 2048 + k * 1024); } while (0)
#define PG8_LDB(dst, b, h) do { _Pragma("unroll") for (int n = 0; n < 2; ++n) _Pragma("unroll") for (int k = 0; k < 2; ++k) dst[n][k] = *(const PG8_LAS bf16x8*)(lds + PG8_SB(b, h) + boff + n * 2048 + k * 1024); } while (0)
#define PG8_MMA(ai, bj, At, Bt) do { __builtin_amdgcn_s_setprio(1); _Pragma("unroll") for (int m = 0; m < 4; ++m) _Pragma("unroll") for (int n = 0; n < 2; ++n) _Pragma("unroll") for (int k = 0; k < 2; ++k) \
        acc[ai][bj][m][n] = mma16<Epi::I8>(Bt[n][k], At[m][k], acc[ai][bj][m][n]); __builtin_amdgcn_s_setprio(0); } while (0)
#define PG8_WAIT_V(n) asm volatile("s_waitcnt vmcnt(" #n ")" ::: "memory")
#define PG8_WAIT_L(n) asm volatile("s_waitcnt lgkmcnt(" #n ")" ::: "memory")
#define PG8_BAR __builtin_amdgcn_s_barrier()
#define PG8_SCHED __builtin_amdgcn_sched_barrier(0)
    Unit cur, nxt; int ui = 0;
    if (!S.next(0, cur)) return;
    f32x4 acc[2][2][4][2];
#pragma unroll
    for (int a = 0; a < 2; ++a)
#pragma unroll
        for (int b = 0; b < 2; ++b)
#pragma unroll
            for (int m = 0; m < 4; ++m)
#pragma unroll
                for (int n = 0; n < 2; ++n) acc[a][b][m][n] = (f32x4){0.f, 0.f, 0.f, 0.f};
    bf16x8 At[4][2], B0[2][2], B1[2][2];
    const char* cA = (const char*)g.A + (size_t)cur.pm * tstep; const char* cB = (const char*)g.Bt + (size_t)cur.pn * tstep;
    S.a_ready(cur);
    if constexpr (SP2) {
        PG8_STAGE(PG8_SB(0, 0), cB, voffB); PG8_STAGE(PG8_SB(0, 1), cB + hstep, voffB); PG8_STAGE(PG8_SA(0, 0), cA, voffA); PG8_STAGE(PG8_SA(0, 1), cA + hstep, voffA);
        if (wr == 1) PG8_BAR;
        PG8_WAIT_V(2); PG8_BAR;
        PG8_STAGE(PG8_SB(1, 0), cB + kstep, voffB); PG8_STAGE(PG8_SA(1, 0), cA + kstep, voffA); PG8_STAGE(PG8_SB(1, 1), cB + hstep + kstep, voffB);
        PG8_WAIT_V(6); PG8_BAR;
    } else {
        PG8_STAGE(PG8_SB(0, 0), cB, voffB); PG8_STAGE(PG8_SA(0, 0), cA, voffA); PG8_STAGE(PG8_SB(0, 1), cB + hstep, voffB); PG8_STAGE(PG8_SA(0, 1), cA + hstep, voffA);
        if (wr == 1) PG8_BAR;
        PG8_WAIT_V(4); PG8_BAR;
        PG8_STAGE(PG8_SB(1, 0), cB + kstep, voffB); PG8_STAGE(PG8_SA(1, 0), cA + kstep, voffA); PG8_STAGE(PG8_SB(1, 1), cB + hstep + kstep, voffB);
        PG8_WAIT_V(6); PG8_BAR;
    }
    for (;;) {
        const bool has_next = S.next(ui + 1, nxt);
        const char* nA = has_next ? (const char*)g.A + (size_t)nxt.pm * tstep : cA; const char* nB = has_next ? (const char*)g.Bt + (size_t)nxt.pn * tstep : cB;
        for (int t = 0; t < nt; t += 2) {
            if constexpr (Epi::KSCALE) { if (t == Epi::KS0 || t == Epi::KS1) E.kscale(acc, cur, t == Epi::KS1 ? 1 : 0, wr, fr); }
            const bool last = (t == nt - 2);
            const char* a1 = cA + (size_t)(t + 1) * kstep;
            const char* a2 = last ? nA : cA + (size_t)(t + 2) * kstep; const char* b2 = last ? nB : cB + (size_t)(t + 2) * kstep;
            const char* a3 = a2 + kstep; const char* b3 = b2 + kstep;
            if (last && has_next) S.a_ready(nxt);
            if constexpr (SP2) {
            PG8_LDB(B0, 0, 0); PG8_LDB(B1, 0, 1); PG8_SCHED; PG8_LDA(At, 0, 0); PG8_STAGE(PG8_SA(1, 1), a1 + hstep, voffA);
            PG8_WAIT_V(8); PG8_WAIT_L(0); PG8_BAR; PG8_MMA(0, 0, At, B0); PG8_MMA(0, 1, At, B1); PG8_BAR; PG8_SCHED;
            PG8_LDA(At, 0, 1); PG8_STAGE(PG8_SB(0, 0), b2, voffB); PG8_STAGE(PG8_SB(0, 1), b2 + hstep, voffB); PG8_STAGE(PG8_SA(0, 0), a2, voffA);
            PG8_WAIT_V(8); PG8_WAIT_L(0); PG8_BAR; PG8_MMA(1, 0, At, B0); PG8_MMA(1, 1, At, B1); PG8_BAR; PG8_SCHED;
            PG8_LDB(B0, 1, 0); PG8_LDB(B1, 1, 1); PG8_SCHED; PG8_LDA(At, 1, 0); PG8_STAGE(PG8_SA(0, 1), a2 + hstep, voffA);
            PG8_WAIT_V(8); PG8_WAIT_L(0); PG8_BAR; PG8_MMA(0, 0, At, B0); PG8_MMA(0, 1, At, B1); PG8_BAR; PG8_SCHED;
            PG8_LDA(At, 1, 1); PG8_STAGE(PG8_SB(1, 0), b3, voffB); PG8_STAGE(PG8_SB(1, 1), b3 + hstep, voffB); PG8_STAGE(PG8_SA(1, 0), a3, voffA);
            PG8_WAIT_V(8); PG8_WAIT_L(0); PG8_BAR; PG8_MMA(1, 0, At, B0); PG8_MMA(1, 1, At, B1); PG8_BAR; PG8_SCHED;
            } else {
            PG8_LDB(B0, 0, 0); PG8_SCHED; PG8_LDA(At, 0, 0); PG8_STAGE(PG8_SA(1, 1), a1 + hstep, voffA);
            PG8_WAIT_L(8); PG8_BAR; PG8_WAIT_L(0); PG8_MMA(0, 0, At, B0); PG8_BAR; PG8_SCHED;
            PG8_LDB(B1, 0, 1); PG8_STAGE(PG8_SB(0, 0), b2, voffB);
            PG8_BAR; PG8_WAIT_L(0); PG8_MMA(0, 1, At, B1); PG8_BAR;
            PG8_LDA(At, 0, 1); PG8_STAGE(PG8_SA(0, 0), a2, voffA);
            PG8_BAR; PG8_WAIT_L(0); PG8_MMA(1, 0, At, B0); PG8_BAR; PG8_SCHED;
            PG8_STAGE(PG8_SB(0, 1), b2 + hstep, voffB);
            PG8_WAIT_V(6); PG8_BAR; PG8_MMA(1, 1, At, B1); PG8_BAR;
            PG8_LDB(B0, 1, 0); PG8_SCHED; PG8_LDA(At, 1, 0); PG8_STAGE(PG8_SA(0, 1), a2 + hstep, voffA);
            PG8_WAIT_L(8); PG8_BAR; PG8_WAIT_L(0); PG8_MMA(0, 0, At, B0); PG8_BAR; PG8_SCHED;
            PG8_LDB(B1, 1, 1); PG8_STAGE(PG8_SB(1, 0), b3, voffB);
            PG8_BAR; PG8_WAIT_L(0); PG8_MMA(0, 1, At, B1); PG8_BAR;
            PG8_LDA(At, 1, 1); PG8_STAGE(PG8_SA(1, 0), a3, voffA);
            PG8_BAR; PG8_WAIT_L(0); PG8_MMA(1, 0, At, B0); PG8_BAR; PG8_SCHED;
            PG8_STAGE(PG8_SB(1, 1), b3 + hstep, voffB);
            PG8_WAIT_V(6); PG8_BAR; PG8_MMA(1, 1, At, B1); PG8_BAR;
            }
        }
        if constexpr (ALIGN_EPI) { if (wr == 0) PG8_BAR; }
        if constexpr (!Epi::AFTER_DRAIN) { E(acc, cur, wr, wc, fr, fq); S.done(cur); }
        if (!has_next) break;
#pragma unroll
        for (int a = 0; a < 2; ++a)
#pragma unroll
            for (int b = 0; b < 2; ++b)
#pragma unroll
                for (int m = 0; m < 4; ++m)
#pragma unroll
                    for (int n = 0; n < 2; ++n) acc[a][b][m][n] = (f32x4){0.f, 0.f, 0.f, 0.f};
        cur = nxt; cA = nA; cB = nB; ++ui;
        if constexpr (ALIGN_EPI) { if (wr == 1) PG8_BAR; }
    }
    PG8_WAIT_V(0);
    if constexpr (!ALIGN_EPI) { if (wr == 0) PG8_BAR; }
    PG8_BAR;
    if constexpr (Epi::AFTER_DRAIN) { E.fused(acc, cur, wr, wc, fr, fq, lds, wid, lane); S.done(cur); }
#undef PG8_SA
#undef PG8_SB
#undef PG8_STAGE
#undef PG8_LDA
#undef PG8_LDB
#undef PG8_MMA
#undef PG8_WAIT_V
#undef PG8_WAIT_L
#undef PG8_BAR
#undef PG8_SCHED
}
}

constexpr int BATCH = 16, SEQ = 2048, DM = 2048, T = BATCH * SEQ, DEPTH = 2;
constexpr int NMEM = 256, DIN = 4096, MEMW = 512;
constexpr int PEER_H = 8, PEER_N = 16384;
constexpr int NWAVES = 8, NTHREADS = NWAVES * 64;
constexpr float EPS = 1e-6f;
constexpr int QA = 0, KA = 768, VA = 1024, QB = 1280, KB = 1792, VB = 2304, QC = 2816, KC = 3584, VC = 3840;
constexpr int OA = 0, OB = 768, OC = 1280;

constexpr size_t MiB = 1u << 20;
constexpr size_t WS_CTL = 0, CTL_ZERO_BYTES = 2 * MiB;
constexpr size_t WS_ROWSQ = 256 * 1024;
constexpr size_t WS_ROPE = 83 * MiB, WS_BIASA = 83 * MiB + 16384;
constexpr size_t WS_WIN = 2 * MiB, WS_WOUT = 34 * MiB, WS_WMQ = 50 * MiB, WS_WMKV = 54 * MiB, WS_WMO = 62 * MiB, WS_WPQ = 66 * MiB, WS_PKEYS = 82 * MiB;
constexpr size_t WS_MEMN = 84 * MiB, WS_KVM = 116 * MiB, WS_PU = 132 * MiB, WS_PV = 260 * MiB, WS_XN = 388 * MiB, WS_QKV = 516 * MiB, WS_ATT = 772 * MiB;
constexpr size_t WS_QM = 900 * MiB, WS_OM = 932 * MiB, WS_MIXSQ = 964 * MiB, MIXSQ_BYTES = 2 * MiB, WS_WIN8 = 966 * MiB, WS_WSC = 982 * MiB, WS_XSC = 982 * MiB + 65536, WS_XSC2 = 982 * MiB + 196608, WS_WSCO = 982 * MiB + 327680, WS_WSCP = 982 * MiB + 344064, WS_WSCM = 982 * MiB + 360448,
                 WS_WOUT8 = 984 * MiB, WS_WPQ8 = 992 * MiB, WS_WMQ8 = 1000 * MiB, WS_END = 1002 * MiB;
constexpr size_t WS_QP = WS_QKV, WS_PIDX = WS_QKV + 128 * MiB, WS_PGATE = WS_QKV + 144 * MiB, WS_PARTI = WS_QKV + 160 * MiB;
constexpr size_t WS_XQH = 836 * MiB, WS_XQL = 868 * MiB;
constexpr size_t WS_XQH_OLD = 900 * MiB, WS_XQL_OLD = 932 * MiB;
constexpr size_t WS_ATT8 = 900 * MiB;
constexpr size_t WS_X8 = 772 * MiB;
constexpr size_t WS_XN8 = 836 * MiB;
constexpr int CW_BAR = 4096;

constexpr int RING_OFF = 0, RING_BYTES = 131072;
constexpr int LDSCTL_OFF = RING_BYTES, MISC_OFF = LDSCTL_OFF + 320;
constexpr int LDS_BYTES = 147456;

#define GAS __attribute__((address_space(1)))
#define LAS __attribute__((address_space(3)))
typedef unsigned short bf16;
typedef unsigned v4u __attribute__((ext_vector_type(4)));
typedef unsigned v2u __attribute__((ext_vector_type(2)));
typedef float f32x4 __attribute__((ext_vector_type(4)));
typedef float f32x16 __attribute__((ext_vector_type(16)));
typedef short bf16x8 __attribute__((ext_vector_type(8)));
typedef GAS unsigned gu32;
#define LDS_WAIT() asm volatile("s_waitcnt lgkmcnt(0)" ::: "memory")
#define VM_WAIT() asm volatile("s_waitcnt vmcnt(0)" ::: "memory")
__device__ __forceinline__ unsigned f2bf(float f) { unsigned u = __builtin_bit_cast(unsigned, f); return (u + 0x7fffu + ((u >> 16) & 1u)) >> 16; }
__device__ __forceinline__ unsigned pk2(float lo, float hi) { return f2bf(lo) | (f2bf(hi) << 16); }
__device__ __forceinline__ float bflo(unsigned w) { return __builtin_bit_cast(float, w << 16); }
__device__ __forceinline__ float bfhi(unsigned w) { return __builtin_bit_cast(float, w & 0xffff0000u); }

__device__ __forceinline__ float shx(float v, int k, int lane) { return __builtin_bit_cast(float, __builtin_amdgcn_ds_bpermute((lane ^ k) << 2, __builtin_bit_cast(int, v))); }
#define XB_TMO      128
#define XB_XCNT(j)  (256  + 64 * (j))
#define XB_XSUB(j)  (1280 + 64 * (j))
#define XB_XGEN(j)  (2304 + 64 * (j))
#define XB_TOP      3328
#define XB_TOPGEN   3392
#define XCD_BAR_WORDS 3456
#define XB_SPIN_CAP (1u << 18)

__device__ __forceinline__ unsigned xb_ld(unsigned* p)              { return __hip_atomic_load(p, __ATOMIC_RELAXED, __HIP_MEMORY_SCOPE_AGENT); }
__device__ __forceinline__ unsigned xb_add(unsigned* p, unsigned v) { return __hip_atomic_fetch_add(p, v, __ATOMIC_RELAXED, __HIP_MEMORY_SCOPE_AGENT); }
__device__ __forceinline__ unsigned xb_xcc_id() { return (unsigned)__builtin_amdgcn_s_getreg((3 << 11) | 20) & 0xFu; }
#define XB_SPIN(cond, bar) do { unsigned _sp = 0; while (cond) { __builtin_amdgcn_s_sleep(1); \
    if ((++_sp & 255u) == 0u) { if (xb_ld(&(bar)[XB_TMO])) break; if (_sp > XB_SPIN_CAP) { atomicAdd(&(bar)[XB_TMO], 1u); break; } } } } while (0)

struct XcdBarrier {
    unsigned* bar; unsigned x;
    volatile LAS unsigned* st;
};

__device__ __forceinline__ XcdBarrier xcd_barrier_post(unsigned* bar, volatile LAS unsigned* st) {
    XcdBarrier b; b.bar = bar; b.x = xb_xcc_id(); b.st = st;
    if (threadIdx.x == 0) (void)xb_add(&bar[XB_XCNT(b.x)], 1u);
    return b;
}
__device__ __forceinline__ void xcd_barrier_complete(unsigned* bar, unsigned x, unsigned& nloc, unsigned& nx) {
    const unsigned G = gridDim.x * gridDim.y * gridDim.z;
    unsigned sum, cnt, mine, sp = 0u;
    for (;;) {
        sum = 0u; cnt = 0u; mine = 0u;
#pragma unroll
        for (unsigned j = 0; j < 16; ++j) { const unsigned c = xb_ld(&bar[XB_XCNT(j)]); sum += c; cnt += (c > 0u) ? 1u : 0u; mine = (j == x) ? c : mine; }
        if (sum == G) break;
        __builtin_amdgcn_s_sleep(1);
        if ((++sp & 255u) == 0u) { if (xb_ld(&bar[XB_TMO])) break; if (sp > XB_SPIN_CAP) { atomicAdd(&bar[XB_TMO], 1u); break; } }
    }
    nloc = mine > 0u ? mine : 1u; nx = cnt > 0u ? cnt : 1u;
}

__device__ __forceinline__ void xcd_barrier(const XcdBarrier& b) {
    asm volatile("s_waitcnt vmcnt(0)" ::: "memory");
    __syncthreads();
    if (threadIdx.x == 0) {
        unsigned* bar = b.bar;
        __builtin_amdgcn_s_waitcnt(0);
        unsigned nloc = b.st[0], nx = b.st[1];
        if (nloc == 0u) { xcd_barrier_complete(bar, b.x, nloc, nx); b.st[0] = nloc; b.st[1] = nx; }
        const unsigned old = xb_add(&bar[XB_XSUB(b.x)], 1u);
        const unsigned gen = old / nloc;
        if (old + 1u == (gen + 1u) * nloc) {
            __builtin_amdgcn_fence(__ATOMIC_RELEASE, "agent");
            asm volatile("s_waitcnt vmcnt(0)" ::: "memory");
            const unsigned og = xb_add(&bar[XB_TOP], 1u);
            const unsigned tg = og / nx;
            if (og + 1u == (tg + 1u) * nx) xb_add(&bar[XB_TOPGEN], 1u);
            else XB_SPIN(xb_ld(&bar[XB_TOPGEN]) == tg, bar);
            __builtin_amdgcn_fence(__ATOMIC_ACQUIRE, "agent");
            xb_add(&bar[XB_XGEN(b.x)], 1u);
            asm volatile("s_waitcnt vmcnt(0)" ::: "memory");
        } else {
            XB_SPIN(xb_ld(&bar[XB_XGEN(b.x)]) == gen, bar);
            __builtin_amdgcn_fence(__ATOMIC_ACQUIRE, "agent");
            asm volatile("s_waitcnt vmcnt(0)" ::: "memory");
        }
    }
    __syncthreads();
}

__device__ __forceinline__ float wave_sum(float v, int lane) {
#pragma unroll
    for (int o = 1; o < 64; o <<= 1) v += shx(v, o, lane);
    return v;
}
__device__ __forceinline__ void* ldptr(LAS unsigned char* lds, int i) {
    const unsigned long long v = ((const LAS unsigned long long*)(lds + LDSCTL_OFF + 1024))[i];
    const unsigned lo = __builtin_amdgcn_readfirstlane((unsigned)v), hi = __builtin_amdgcn_readfirstlane((unsigned)(v >> 32));
    return (void*)(((unsigned long long)hi << 32) | lo);
}
struct OffsetOrder {
    pg8::StaticOrder S;
    __device__ __forceinline__ void init(int M, int N, int G, int c, int off) { S.init(M, N, G, (c + G - off % G) % G); }
    __device__ __forceinline__ bool next(int i, pg8::Unit& u) const { return S.next(i, u); }
    __device__ __forceinline__ void a_ready(const pg8::Unit&) const {}
    __device__ __forceinline__ void done(const pg8::Unit&) const {}
};

template <bool PERMQKV>
__device__ __forceinline__ void transpose_item(const float* W, int K, int N, bf16* WT, LAS float* scr, int item, int lane, const float* gk = nullptr) {
    const int nblk = N / 32, kb = item / nblk, nb = item % nblk, k0 = 64 * kb, n0 = 32 * nb;
    int d0 = n0;
    if (PERMQKV) { const int within = n0 & 255; d0 = (n0 & ~255) + 128 * ((within >> 5) & 1) + 32 * (within >> 6); }
#pragma unroll
    for (int i = 0; i < 8; ++i) { const int kk = 8 * i + (lane >> 3), nn = 4 * (lane & 7);
        const f32x4 w4 = *(const GAS f32x4*)(W + (size_t)(k0 + kk) * N + n0 + nn) * (gk ? gk[k0 + kk] : 1.f);
        scr[kk * 33 + nn] = w4[0]; scr[kk * 33 + nn + 1] = w4[1]; scr[kk * 33 + nn + 2] = w4[2]; scr[kk * 33 + nn + 3] = w4[3]; }
    LDS_WAIT(); asm volatile("" ::: "memory");
    const int c = lane & 7;
#pragma unroll
    for (int j = 0; j < 4; ++j) { const int n = (lane >> 3) + 8 * j; const LAS float* s = scr + (8 * c) * 33 + n;
        v4u o; o.x = pk2(s[0 * 33], s[1 * 33]); o.y = pk2(s[2 * 33], s[3 * 33]); o.z = pk2(s[4 * 33], s[5 * 33]); o.w = pk2(s[6 * 33], s[7 * 33]);
        *(GAS v4u*)(WT + (size_t)(d0 + n) * K + k0 + 8 * c) = o; }
    LDS_WAIT(); asm volatile("" ::: "memory");
}
__device__ __forceinline__ void convert_bf16(const float* src, bf16* dst, size_t n, size_t gtid, size_t nthreads) {
    for (size_t i = gtid * 8; i < n; i += nthreads * 8) {
        const f32x4 a = *(const GAS f32x4*)(src + i), b = *(const GAS f32x4*)(src + i + 4);
        v4u o; o.x = pk2(a[0], a[1]); o.y = pk2(a[2], a[3]); o.z = pk2(b[0], b[1]); o.w = pk2(b[2], b[3]);
        *(GAS v4u*)(dst + i) = o;
    }
}
__device__ __forceinline__ int t5_bucket(int rel) {
    const int n = rel < 0 ? -rel : rel;
    const int b = n < 8 ? n : n < 12 ? 8 : n < 16 ? 9 : n < 23 ? 10 : n < 32 ? 11 : n < 46 ? 12 : n < 64 ? 13 : n < 91 ? 14 : 15;
    return b + (rel > 0 ? 16 : 0);
}
__constant__ float ROPE_INV[16] = {1.000000000e+00f, 5.623413324e-01f, 3.162277639e-01f, 1.778279394e-01f, 1.000000015e-01f, 5.623413250e-02f, 3.162277490e-02f, 1.778279431e-02f,
                                   9.999999776e-03f, 5.623413250e-03f, 3.162277630e-03f, 1.778279431e-03f, 1.000000047e-03f, 5.623413017e-04f, 3.162277571e-04f, 1.778279402e-04f};

__device__ __forceinline__ void rms_row_to_bf16(const float* xrow, const float* g0, bf16* o0, const float* g1, bf16* o1, int lane) {
    const GAS f32x4* xr = (const GAS f32x4*)xrow + lane;
    f32x4 v[8]; float s = 0.f;
#pragma unroll
    for (int j = 0; j < 8; ++j) { v[j] = xr[64 * j]; s += (v[j].x * v[j].x + v[j].y * v[j].y) + (v[j].z * v[j].z + v[j].w * v[j].w); }
    const float rstd = 1.f / sqrtf(wave_sum(s, lane) * (1.f / DM) + EPS);
    {   const GAS f32x4* gr = (const GAS f32x4*)g0 + lane; GAS v2u* o8 = (GAS v2u*)o0 + lane;
#pragma unroll
        for (int j = 0; j < 8; ++j) { const f32x4 gg = gr[64 * j]; v2u w; w.x = pk2(v[j].x * rstd * gg.x, v[j].y * rstd * gg.y); w.y = pk2(v[j].z * rstd * gg.z, v[j].w * rstd * gg.w); o8[64 * j] = w; } }
    if (g1) { const GAS f32x4* gr = (const GAS f32x4*)g1 + lane; GAS v2u* o8 = (GAS v2u*)o1 + lane;
#pragma unroll
        for (int j = 0; j < 8; ++j) { const f32x4 gg = gr[64 * j]; v2u w; w.x = pk2(v[j].x * rstd * gg.x, v[j].y * rstd * gg.y); w.y = pk2(v[j].z * rstd * gg.z, v[j].w * rstd * gg.w); o8[64 * j] = w; } }
}
__device__ __forceinline__ float wave_max(float v, int lane) {
#pragma unroll
    for (int o = 1; o < 64; o <<= 1) v = fmaxf(v, shx(v, o, lane));
    return v;
}
__device__ __forceinline__ unsigned q8x4(const f32x4 v, const float inv) {
    unsigned w = 0;
    w = __builtin_amdgcn_cvt_pk_u8_f32(__builtin_rintf(__builtin_fmaf(v[0], inv, 128.f)), 0, w); w = __builtin_amdgcn_cvt_pk_u8_f32(__builtin_rintf(__builtin_fmaf(v[1], inv, 128.f)), 1, w);
    w = __builtin_amdgcn_cvt_pk_u8_f32(__builtin_rintf(__builtin_fmaf(v[2], inv, 128.f)), 2, w); w = __builtin_amdgcn_cvt_pk_u8_f32(__builtin_rintf(__builtin_fmaf(v[3], inv, 128.f)), 3, w);
    return w ^ 0x80808080u;
}
__device__ __forceinline__ float amax4(const f32x4 v) { return fmaxf(fmaxf(fabsf(v[0]), fabsf(v[1])), fmaxf(fabsf(v[2]), fabsf(v[3]))); }
__device__ __forceinline__ void quant_wrow(const bf16* src, unsigned char* dst, float* step, int lane) {
    v4u w[4]; float am = 0.f;
#pragma unroll
    for (int j = 0; j < 4; ++j) w[j] = *(const GAS v4u*)(src + 8 * lane + 512 * j);
    f32x4 lo[4], hi[4];
#pragma unroll
    for (int j = 0; j < 4; ++j) { lo[j] = (f32x4){bflo(w[j].x), bfhi(w[j].x), bflo(w[j].y), bfhi(w[j].y)}; hi[j] = (f32x4){bflo(w[j].z), bfhi(w[j].z), bflo(w[j].w), bfhi(w[j].w)}; am = fmaxf(am, fmaxf(amax4(lo[j]), amax4(hi[j]))); }
    am = fmaxf(wave_max(am, lane), 1e-30f);
    const float inv = 127.f / am;
#pragma unroll
    for (int j = 0; j < 4; ++j) *(GAS v2u*)(dst + 8 * lane + 512 * j) = (v2u){q8x4(lo[j], inv), q8x4(hi[j], inv)};
    if (lane == 0) *step = am * (1.f / 127.f);
}
template <int R>
__device__ __forceinline__ void att_quant_rows(const bf16* ATT, const u64_t* mixsq, unsigned char* Q, float* step, int row0, int lane) {
    v4u w[R][4];
#pragma unroll
    for (int q = 0; q < R; ++q)
#pragma unroll
        for (int j = 0; j < 4; ++j) w[q][j] = *(const GAS v4u*)(ATT + (size_t)(row0 + q) * DM + 8 * lane + 512 * j);
#pragma unroll
    for (int q = 0; q < R; ++q) { const int row = row0 + q;
        const float ra = 1.0f / sqrtf((float)*(const GAS u64_t*)(mixsq + row) * (5.9604644775390625e-08f / 768.0f) + EPS), rb = 1.0f / sqrtf((float)*(const GAS u64_t*)(mixsq + T + row) * (5.9604644775390625e-08f / 512.0f) + EPS),
                    rc = 1.0f / sqrtf((float)*(const GAS u64_t*)(mixsq + 2 * (size_t)T + row) * (5.9604644775390625e-08f / 768.0f) + EPS);
        const float rj[4] = {ra, lane < 32 ? ra : rb, lane < 32 ? rb : rc, rc};
        f32x4 lo[4], hi[4]; float am = 0.f;
#pragma unroll
        for (int j = 0; j < 4; ++j) { lo[j] = (f32x4){bflo(w[q][j].x), bfhi(w[q][j].x), bflo(w[q][j].y), bfhi(w[q][j].y)} * rj[j]; hi[j] = (f32x4){bflo(w[q][j].z), bfhi(w[q][j].z), bflo(w[q][j].w), bfhi(w[q][j].w)} * rj[j]; am = fmaxf(am, fmaxf(amax4(lo[j]), amax4(hi[j]))); }
        am = fmaxf(wave_max(am, lane), 1e-30f);
        const float inv = 127.f / am;
#pragma unroll
        for (int j = 0; j < 4; ++j) *(GAS v2u*)(Q + (size_t)row * DM + 8 * lane + 512 * j) = (v2u){q8x4(lo[j], inv), q8x4(hi[j], inv)};
        if (lane == 0) step[row] = am * (1.f / 127.f); }
}
__device__ __forceinline__ void prep_rows2(const float* x0, bf16* o0, u64_t* sq, unsigned char* q0, float* qstep, int lane) {
    f32x4 v[2][8];
#pragma unroll
    for (int q = 0; q < 2; ++q) { const GAS f32x4* xr = (const GAS f32x4*)(x0 + (size_t)q * DM) + lane;
#pragma unroll
        for (int j = 0; j < 8; ++j) v[q][j] = xr[64 * j]; }
#pragma unroll
    for (int q = 0; q < 2; ++q) { GAS v2u* o8 = (GAS v2u*)(o0 + (size_t)q * DM) + lane; float s = 0.f;
#pragma unroll
        for (int j = 0; j < 8; ++j) { const f32x4 a = v[q][j]; s += (a.x * a.x + a.y * a.y) + (a.z * a.z + a.w * a.w); v2u w; w.x = pk2(a.x, a.y); w.y = pk2(a.z, a.w); o8[64 * j] = w; }
        s = wave_sum(s, lane);
        float am = 0.f;
#pragma unroll
        for (int j = 0; j < 8; ++j) am = fmaxf(am, amax4(v[q][j]));
        am = fmaxf(wave_max(am, lane), 1e-30f);
        const float inv = 127.f / am;
#pragma unroll
        for (int j = 0; j < 8; ++j) *(GAS unsigned*)(q0 + (size_t)q * DM + 4 * lane + 256 * j) = q8x4(v[q][j], inv);
        if (lane == 0) { sq[q] = rowsq_fx(s); qstep[q] = am * (1.f / 127.f) / sqrtf(s * (1.f / DM) + 1e-6f); } }
}
__device__ __forceinline__ void norm_rows(const float* X, const float* g, bf16* XN, int gw, int NGW, int lane) {
    for (int m = gw; m < T; m += NGW) rms_row_to_bf16(X + (size_t)m * DM, g, XN + (size_t)m * DM, nullptr, nullptr, lane);
}

template <int TYPE>
__device__ __forceinline__ void naive_attn_item(const bf16* QKV, bf16* ATT, int b, int grow, int head, int lane, const float* biasA, const float* sink, const float* rpb) {
    const int tpos = grow * 64 + lane; const size_t trow = (size_t)b * SEQ + tpos;
    int qcol, kcol, vcol, ocol;
    if (TYPE == 0) { qcol = QA + head * 64; kcol = KA + (head / 3) * 64; vcol = VA + (head / 3) * 64; ocol = OA + head * 64; }
    else if (TYPE == 1) { qcol = QB + head * 64; kcol = KB + head * 64; vcol = VB + head * 64; ocol = OB + head * 64; }
    else { qcol = QC + head * 64; kcol = KC + (head / 3) * 64; vcol = VC + (head / 3) * 64; ocol = OC + head * 64; }
    float q[64], o[64];
#pragma unroll
    for (int c = 0; c < 8; ++c) { const v4u w = *(const GAS v4u*)(QKV + trow * DIN + qcol + 8 * c);
        q[8 * c + 0] = bflo(w.x); q[8 * c + 1] = bfhi(w.x); q[8 * c + 2] = bflo(w.y); q[8 * c + 3] = bfhi(w.y); q[8 * c + 4] = bflo(w.z); q[8 * c + 5] = bfhi(w.z); q[8 * c + 6] = bflo(w.w); q[8 * c + 7] = bfhi(w.w); }
#pragma unroll
    for (int d = 0; d < 64; ++d) o[d] = 0.f;
    float m = -1e30f, l = 0.f;
    int j0, j1;
    if (TYPE == 0) { j0 = grow * 64 - 128; if (j0 < 0) j0 = 0; j1 = grow * 64 + 63 + 128; if (j1 > SEQ - 1) j1 = SEQ - 1; }
    else if (TYPE == 1) { int r0 = grow - 4; r0 = r0 < 0 ? 0 : (r0 > 24 ? 24 : r0); j0 = r0 * 64; j1 = j0 + 511; }
    else { j0 = 0; j1 = SEQ - 1; }
    int c0 = lane - 8; c0 = c0 < 0 ? 0 : (c0 > 48 ? 48 : c0);
#pragma unroll 1
    for (int j = j0; j <= j1; ++j) {
        const bf16* krow = QKV + ((size_t)b * SEQ + j) * DIN;
        float s = 0.f;
#pragma unroll
        for (int c = 0; c < 8; ++c) { const v4u w = *(const GAS v4u*)(krow + kcol + 8 * c);
            s += q[8 * c + 0] * bflo(w.x) + q[8 * c + 1] * bfhi(w.x) + q[8 * c + 2] * bflo(w.y) + q[8 * c + 3] * bfhi(w.y) + q[8 * c + 4] * bflo(w.z) + q[8 * c + 5] * bfhi(w.z) + q[8 * c + 6] * bflo(w.w) + q[8 * c + 7] * bfhi(w.w); }
        bool valid = true;
        if (TYPE == 0) { const int rel = j - tpos; valid = (rel >= -128 && rel <= 128); if (valid) s += biasA[head * 257 + rel + 128]; }
        if (TYPE == 1) { const int kr = j >> 6, kc = j & 63; valid = (kc >= c0 && kc < c0 + 16); if (valid) s += rpb[(head * 15 + (kr - grow + 7)) * 31 + (kc - lane + 15)]; }
        const float mn = valid ? fmaxf(m, s) : m;
        const float a = __expf(m - mn);
        const float p = valid ? __expf(s - mn) : 0.f;
        l = l * a + p; m = mn;
#pragma unroll
        for (int c = 0; c < 8; ++c) { const v4u w = *(const GAS v4u*)(krow + vcol + 8 * c);
            o[8 * c + 0] = o[8 * c + 0] * a + p * bflo(w.x); o[8 * c + 1] = o[8 * c + 1] * a + p * bfhi(w.x); o[8 * c + 2] = o[8 * c + 2] * a + p * bflo(w.y); o[8 * c + 3] = o[8 * c + 3] * a + p * bfhi(w.y);
            o[8 * c + 4] = o[8 * c + 4] * a + p * bflo(w.z); o[8 * c + 5] = o[8 * c + 5] * a + p * bfhi(w.z); o[8 * c + 6] = o[8 * c + 6] * a + p * bflo(w.w); o[8 * c + 7] = o[8 * c + 7] * a + p * bfhi(w.w); }
    }
    if (TYPE == 0) l += __expf(sink[head] - m);
    const float inv = 1.f / l;
#pragma unroll
    for (int c = 0; c < 8; ++c) { v4u w; w.x = pk2(o[8 * c + 0] * inv, o[8 * c + 1] * inv); w.y = pk2(o[8 * c + 2] * inv, o[8 * c + 3] * inv); w.z = pk2(o[8 * c + 4] * inv, o[8 * c + 5] * inv); w.w = pk2(o[8 * c + 6] * inv, o[8 * c + 7] * inv);
        *(GAS v4u*)(ATT + trow * DM + ocol + 8 * c) = w; }
}
__device__ __forceinline__ float rdl(float v, int l) { return __builtin_bit_cast(float, __builtin_amdgcn_readlane(__builtin_bit_cast(int, v), l)); }
__device__ __forceinline__ void naive_mem_item(const bf16* QM, const bf16* KVM, bf16* OM, const float* gq, size_t trow, int b, int head, int lane) {
    const unsigned qw = *(const GAS unsigned*)(QM + trow * MEMW + head * 128 + 2 * lane);
    float q0 = bflo(qw), q1 = bfhi(qw);
    const float ss = wave_sum(q0 * q0 + q1 * q1, lane);
    const float r = 0.08838834764831845f / sqrtf(ss * (1.f / 128.f) + EPS);
    q0 *= r * gq[2 * lane]; q1 *= r * gq[2 * lane + 1];
    const bf16* kbase = KVM + ((size_t)b * NMEM + lane) * 1024 + head * 128;
    float s[4] = {0.f, 0.f, 0.f, 0.f};
#pragma unroll 1
    for (int c = 0; c < 16; ++c) {
        float qa[8];
#pragma unroll
        for (int e = 0; e < 4; ++e) { qa[2 * e] = rdl(q0, 4 * c + e); qa[2 * e + 1] = rdl(q1, 4 * c + e); }
#pragma unroll
        for (int i = 0; i < 4; ++i) { const v4u w = *(const GAS v4u*)(kbase + (size_t)i * 64 * 1024 + 8 * c);
            s[i] += qa[0] * bflo(w.x) + qa[1] * bfhi(w.x) + qa[2] * bflo(w.y) + qa[3] * bfhi(w.y) + qa[4] * bflo(w.z) + qa[5] * bfhi(w.z) + qa[6] * bflo(w.w) + qa[7] * bfhi(w.w); }
    }
    float m = fmaxf(fmaxf(s[0], s[1]), fmaxf(s[2], s[3]));
#pragma unroll
    for (int o = 1; o < 64; o <<= 1) m = fmaxf(m, shx(m, o, lane));
    float p[4]; float l = 0.f;
#pragma unroll
    for (int i = 0; i < 4; ++i) { p[i] = __expf(s[i] - m); l += p[i]; }
    l = wave_sum(l, lane);
    const bf16* vbase = KVM + ((size_t)b * NMEM) * 1024 + 512 + head * 128 + 2 * lane;
    float o0 = 0.f, o1 = 0.f;
#pragma unroll
    for (int i = 0; i < 4; ++i) {
#pragma unroll 4
        for (int jj = 0; jj < 64; ++jj) { const float pj = rdl(p[i], jj); const unsigned w = *(const GAS unsigned*)(vbase + (size_t)(64 * i + jj) * 1024); o0 += pj * bflo(w); o1 += pj * bfhi(w); }
    }
    const float inv = 1.f / l;
    *(GAS unsigned*)(OM + trow * MEMW + head * 128 + 2 * lane) = pk2(o0 * inv, o1 * inv);
}
__device__ __forceinline__ void mixnorm_rows(bf16* ATT, const float* g, int gw, int NGW, int lane) {
    for (int m = gw; m < T; m += NGW) {
        GAS v4u* p = (GAS v4u*)(ATT + (size_t)m * DM + 32 * lane);
        v4u w[4]; float f[32]; float ss = 0.f;
#pragma unroll
        for (int c = 0; c < 4; ++c) { w[c] = p[c];
            f[8 * c + 0] = bflo(w[c].x); f[8 * c + 1] = bfhi(w[c].x); f[8 * c + 2] = bflo(w[c].y); f[8 * c + 3] = bfhi(w[c].y); f[8 * c + 4] = bflo(w[c].z); f[8 * c + 5] = bfhi(w[c].z); f[8 * c + 6] = bflo(w[c].w); f[8 * c + 7] = bfhi(w[c].w); }
#pragma unroll
        for (int i = 0; i < 32; ++i) ss += f[i] * f[i];
        const int grp = lane < 24 ? 0 : (lane < 40 ? 1 : 2);
        const float sa = wave_sum(grp == 0 ? ss : 0.f, lane), sb = wave_sum(grp == 1 ? ss : 0.f, lane), sc = wave_sum(grp == 2 ? ss : 0.f, lane);
        const float r = grp == 0 ? 1.f / sqrtf(sa * (1.f / 768.f) + EPS) : (grp == 1 ? 1.f / sqrtf(sb * (1.f / 512.f) + EPS) : 1.f / sqrtf(sc * (1.f / 768.f) + EPS));
        const float* gg = g + 32 * lane;
#pragma unroll
        for (int c = 0; c < 4; ++c) { const f32x4 g0 = *(const GAS f32x4*)(gg + 8 * c), g1 = *(const GAS f32x4*)(gg + 8 * c + 4);
            v4u o; o.x = pk2(f[8 * c + 0] * r * g0[0], f[8 * c + 1] * r * g0[1]); o.y = pk2(f[8 * c + 2] * r * g0[2], f[8 * c + 3] * r * g0[3]);
            o.z = pk2(f[8 * c + 4] * r * g1[0], f[8 * c + 5] * r * g1[1]); o.w = pk2(f[8 * c + 6] * r * g1[2], f[8 * c + 7] * r * g1[3]); p[c] = o; }
    }
}

#ifndef PEER_HD
#define PEER_HD __device__ __forceinline__
#define PEER_EXP(x) __expf(x)
#endif
template <int N> PEER_HD void bitonic_sort_desc(float* v) {
#pragma unroll
    for (int k = 2; k <= N; k <<= 1)
#pragma unroll
        for (int j = k >> 1; j > 0; j >>= 1)
#pragma unroll
            for (int i = 0; i < N; ++i) { const int l = i ^ j; if (l > i) { const bool desc = ((i & k) == 0); const float a = v[i], b = v[l]; const float hi = fmaxf(a, b), lo = fminf(a, b);
                v[i] = desc ? hi : lo; v[l] = desc ? lo : hi; } }
}
PEER_HD void merge_top16(float* a, const float* b) {
    float c[16];
#pragma unroll
    for (int i = 0; i < 16; ++i) c[i] = fmaxf(a[i], b[15 - i]);
#pragma unroll
    for (int j = 8; j > 0; j >>= 1)
#pragma unroll
        for (int i = 0; i < 16; ++i) { const int l = i ^ j; if (l > i) { const float x = c[i], y = c[l]; c[i] = fmaxf(x, y); c[l] = fminf(x, y); } }
#pragma unroll
    for (int i = 0; i < 16; ++i) a[i] = c[i];
}
PEER_HD void top16_of_64(float (&v)[64]) {
    bitonic_sort_desc<16>(&v[0]); bitonic_sort_desc<16>(&v[16]); bitonic_sort_desc<16>(&v[32]); bitonic_sort_desc<16>(&v[48]);
    merge_top16(&v[0], &v[16]); merge_top16(&v[32], &v[48]); merge_top16(&v[0], &v[32]);
}
PEER_HD float pack_idx(float s, unsigned idx, unsigned mask) { return __builtin_bit_cast(float, (__builtin_bit_cast(unsigned, s) & ~mask) | idx); }
PEER_HD unsigned low_bits(float s, unsigned mask) { return __builtin_bit_cast(unsigned, s) & mask; }
PEER_HD unsigned pick16(const float* a, unsigned i, unsigned mask) {
    unsigned r = 0;
#pragma unroll
    for (unsigned k = 0; k < 16; ++k) r = (i == k) ? low_bits(a[k], mask) : r;
    return r;
}
PEER_HD void peer_candidates(const float* a, const float* b, int* e, float* gate) {
    float c[64]; int n = 0;
#pragma unroll
    for (int i = 0; i < 16; ++i)
#pragma unroll
        for (int j = 0; j < 16; ++j) if ((i + 1) * (j + 1) <= 16) { c[n] = pack_idx(a[i] + b[j], (unsigned)(i * 16 + j), 0xffu); ++n; }
#pragma unroll
    for (int k = 50; k < 64; ++k) c[k] = -3.0e38f;
    top16_of_64(c);
    float mx = c[0], den = 0.f;
#pragma unroll
    for (int k = 0; k < 16; ++k) { const unsigned id = low_bits(c[k], 0xffu); const unsigned n0 = pick16(a, id >> 4, 0x7fu), n1 = pick16(b, id & 15u, 0x7fu);
        e[k] = (int)(n0 * 128u + n1); gate[k] = PEER_EXP(c[k] - mx); den += gate[k]; }
    const float inv = 1.f / den;
#pragma unroll
    for (int k = 0; k < 16; ++k) gate[k] *= inv;
}

__device__ __forceinline__ void peer_select_unit(const bf16* QP, const bf16* PK, int* PIDX, float* PGATE, int tb, int h, int wave, int lane, LAS unsigned char* lds) {
    const int hh = lane >> 5, tl = lane & 31; const size_t t = (size_t)tb * 256 + wave * 32 + tl;
    __syncthreads();
    {   const int tid = wave * 64 + lane; const bf16* src = PK + (size_t)h * 256 * 128;
#pragma unroll 1
        for (int i0 = 0; i0 < 8; i0 += 4) { v4u st[4];
#pragma unroll
            for (int i = 0; i < 4; ++i) st[i] = *(const GAS v4u*)(src + (size_t)(tid + 512 * (i0 + i)) * 8);
#pragma unroll
            for (int i = 0; i < 4; ++i) { const int c = tid + 512 * (i0 + i), row = c >> 4, ch = c & 15; *(LAS v4u*)(lds + row * 256 + ((ch ^ (row & 15)) * 16)) = st[i]; } } }
    __syncthreads();
    float ab[2][16];
#pragma unroll
    for (int p = 0; p < 2; ++p) {
        bf16x8 bq[8];
#pragma unroll
        for (int s = 0; s < 8; ++s) bq[s] = *(const GAS bf16x8*)(QP + t * DM + 256 * h + 128 * p + 16 * s + 8 * hh);
        float v[64];
#pragma unroll
        for (int nb = 0; nb < 4; ++nb) {
            f32x16 acc;
#pragma unroll
            for (int r = 0; r < 16; ++r) acc[r] = 0.f;
            const int krow = p * 128 + 32 * nb + tl;
            bf16x8 ak[8];
#pragma unroll
            for (int s = 0; s < 8; ++s) ak[s] = *(const LAS bf16x8*)(lds + krow * 256 + (((2 * s + hh) ^ (krow & 15)) * 16));
#pragma unroll
            for (int s = 0; s < 8; ++s) acc = __builtin_amdgcn_mfma_f32_32x32x16_bf16(ak[s], bq[s], acc, 0, 0, 0);
#pragma unroll
            for (int r = 0; r < 16; ++r) v[16 * nb + r] = pack_idx(acc[r], (unsigned)(32 * nb + 8 * (r >> 2) + 4 * hh + (r & 3)), 0x7fu);
        }
        top16_of_64(v);
        float pv[16];
#pragma unroll
        for (int i = 0; i < 16; ++i) pv[i] = shx(v[i], 32, lane);
        merge_top16(&v[0], pv);
#pragma unroll
        for (int i = 0; i < 16; ++i) ab[p][i] = v[i];
    }
    int e[16]; float gate[16];
    peer_candidates(ab[0], ab[1], e, gate);
    if (hh == 0) { GAS v4u* o = (GAS v4u*)(PIDX + t * 128 + h * 16);
#pragma unroll
        for (int c = 0; c < 4; ++c) o[c] = (v4u){(unsigned)e[4 * c], (unsigned)e[4 * c + 1], (unsigned)e[4 * c + 2], (unsigned)e[4 * c + 3]}; }
    else { GAS f32x4* o = (GAS f32x4*)(PGATE + t * 128 + h * 16);
#pragma unroll
        for (int c = 0; c < 4; ++c) o[c] = (f32x4){gate[4 * c], gate[4 * c + 1], gate[4 * c + 2], gate[4 * c + 3]}; }
}

typedef float f32x2 __attribute__((ext_vector_type(2)));
typedef unsigned v6u __attribute__((ext_vector_type(6)));
typedef float v32f __attribute__((ext_vector_type(32)));
typedef v4u __attribute__((aligned(8))) v4u_a8;
constexpr float PU_SCALE6 = 90.0f, PV_SCALE6 = 5.65f;
__device__ __forceinline__ unsigned enc_e2m3(float v) {
    const float a = fminf(fabsf(v), 7.5f);
    unsigned code;
    if (a < 1.0f) code = (unsigned)__builtin_rintf(a * 8.f);
    else { const unsigned b = __builtin_bit_cast(unsigned, a) - 0x3F800000u; code = ((b + 0x7FFFFu + ((b >> 20) & 1u)) >> 20) + 8u; }
    return code | (v < 0.f ? 32u : 0u);
}
__device__ __forceinline__ void convert_fp6_rows(const float* src, unsigned char* dst, int nrows, float scale, const float* gain, int gw, int NGW, int lane) {
    for (int r = gw; r < nrows; r += NGW) {
        const float* sp = src + (size_t)r * DM + 4 * lane; const float* gp = gain ? gain + (size_t)(r / PEER_N) * DM + 4 * lane : nullptr;
        unsigned w[6] = {0u, 0u, 0u, 0u, 0u, 0u};
#pragma unroll
        for (int j = 0; j < 8; ++j) { f32x4 a = *(const GAS f32x4*)(sp + 256 * j) * scale; if (gp) a = a * *(const GAS f32x4*)(gp + 256 * j);
#pragma unroll
            for (int e = 0; e < 4; ++e) { const unsigned code = enc_e2m3(a[e]); const int bp = 6 * (4 * j + e), wi = bp >> 5, sh = bp & 31;
                w[wi] |= code << sh; if (sh > 26) w[wi + 1] |= code >> (32 - sh); } }
        unsigned char* dp = dst + (size_t)r * 1536 + 24 * lane;
        *(GAS v4u_a8*)dp = (v4u){w[0], w[1], w[2], w[3]}; *(GAS v2u*)(dp + 16) = (v2u){w[4], w[5]};
    }
}
constexpr float PV_SCALE4 = 5.65f, PU_SCALE4 = 90.0f;
__device__ __forceinline__ unsigned enc_e2m1(float v) {
    const float a = fabsf(v);
    const unsigned code = a < 0.25f ? 0u : a < 0.75f ? 1u : a < 1.25f ? 2u : a < 1.75f ? 3u : a < 2.5f ? 4u : a < 3.5f ? 5u : a < 5.0f ? 6u : 7u;
    return code | (v < 0.f ? 8u : 0u);
}
__device__ __forceinline__ void convert_fp4_rows(const float* src, unsigned char* dst, int nrows, float scale, const float* gain, int gw, int NGW, int lane) {
    for (int r0 = 2 * gw; r0 < nrows; r0 += 2 * NGW) {
        f32x4 a[2][8];
#pragma unroll
        for (int q = 0; q < 2; ++q) { const float* sp = src + (size_t)(r0 + q) * DM + 4 * lane;
#pragma unroll
            for (int j = 0; j < 8; ++j) a[q][j] = *(const GAS f32x4*)(sp + 256 * j); }
#pragma unroll
        for (int q = 0; q < 2; ++q) { const int r = r0 + q; const float* gp = gain ? gain + (size_t)(r / PEER_N) * DM + 4 * lane : nullptr;
            unsigned w[4] = {0u, 0u, 0u, 0u};
#pragma unroll
            for (int j = 0; j < 8; ++j) { f32x4 v = a[q][j] * scale; if (gp) v = v * *(const GAS f32x4*)(gp + 256 * j);
#pragma unroll
                for (int e = 0; e < 4; ++e) { const int i = 4 * j + e; w[i >> 3] |= enc_e2m1(v[e]) << (4 * (i & 7)); } }
            *(GAS v4u*)(dst + (size_t)r * 1024 + 16 * lane) = (v4u){w[0], w[1], w[2], w[3]}; }
    }
}
#define PG4_LOAD(buf, tab, idlo, idhi, g) do { _Pragma("unroll") for (int i_ = 0; i_ < PG6_R; ++i_) { const int k_ = (g) * PG6_R + i_; \
        const int e_ = __builtin_amdgcn_readlane(k_ < 64 ? idlo : idhi, k_ & 63); buf[i_] = __builtin_amdgcn_raw_buffer_load_b128(tab, (int)voff4, e_ * 1024, 0); } } while (0)
#define PG4_DOT1(buf, i_, dst) do { f32x2 a_ = {0.f, 0.f}; _Pragma("unroll") for (int c_ = 0; c_ < 4; ++c_) { const unsigned u_ = buf[i_][c_]; \
        a_ += __builtin_amdgcn_cvt_scalef32_pk_f32_fp4(u_, 1.0f, 0) * x[4 * c_ + 0]; a_ += __builtin_amdgcn_cvt_scalef32_pk_f32_fp4(u_, 1.0f, 1) * x[4 * c_ + 1]; \
        a_ += __builtin_amdgcn_cvt_scalef32_pk_f32_fp4(u_, 1.0f, 2) * x[4 * c_ + 2]; a_ += __builtin_amdgcn_cvt_scalef32_pk_f32_fp4(u_, 1.0f, 3) * x[4 * c_ + 3]; } dst = a_.x + a_.y; __builtin_amdgcn_sched_barrier(0); } while (0)
#define PG4_DOT(buf, g) do { float p_[8]; _Pragma("unroll") for (int i_ = 0; i_ < 8; ++i_) PG4_DOT1(buf, i_, p_[i_]); \
        float q_[4]; _Pragma("unroll") for (int i_ = 0; i_ < 4; ++i_) { const float keep_ = b5 ? p_[i_ + 4] : p_[i_], send_ = b5 ? p_[i_] : p_[i_ + 4]; q_[i_] = keep_ + shx(send_, 32, lane); } \
        float r_[2]; _Pragma("unroll") for (int i_ = 0; i_ < 2; ++i_) { const float keep_ = b4 ? q_[i_ + 2] : q_[i_], send_ = b4 ? q_[i_] : q_[i_ + 2]; r_[i_] = keep_ + shx(send_, 16, lane); } \
        float s_; { const float keep_ = b3 ? r_[1] : r_[0], send_ = b3 ? r_[0] : r_[1]; s_ = keep_ + shx(send_, 8, lane); } \
        s_ += shx(s_, 4, lane); s_ += shx(s_, 2, lane); s_ += shx(s_, 1, lane); \
        if ((lane & 7) == 0) wl[(g) * 8 + (lane >> 3)] = s_; } while (0)
#define PG4_AXPY(buf, g) do { _Pragma("unroll") for (int i_ = 0; i_ < PG6_R; ++i_) { const float w_ = wl[(g) * PG6_R + i_]; const f32x2 wv_ = {w_, w_}; \
        _Pragma("unroll") for (int c_ = 0; c_ < 4; ++c_) { const unsigned u_ = buf[i_][c_]; \
            y[4 * c_ + 0] += __builtin_amdgcn_cvt_scalef32_pk_f32_fp4(u_, 1.0f, 0) * wv_; y[4 * c_ + 1] += __builtin_amdgcn_cvt_scalef32_pk_f32_fp4(u_, 1.0f, 1) * wv_; \
            y[4 * c_ + 2] += __builtin_amdgcn_cvt_scalef32_pk_f32_fp4(u_, 1.0f, 2) * wv_; y[4 * c_ + 3] += __builtin_amdgcn_cvt_scalef32_pk_f32_fp4(u_, 1.0f, 3) * wv_; } \
        __builtin_amdgcn_sched_barrier(0); } } while (0)
#ifndef PG6_R
#define PG6_R 8
#endif
#define PG6_LOAD(buf, tab, idlo, idhi, g) do { _Pragma("unroll") for (int i_ = 0; i_ < PG6_R; ++i_) { const int k_ = (g) * PG6_R + i_; \
        const int e_ = __builtin_amdgcn_readlane(k_ < 64 ? idlo : idhi, k_ & 63); const unsigned char* rp_ = (tab) + (size_t)(unsigned)e_ * 1536u; \
        const v4u a_ = *(const GAS v4u_a8*)(rp_ + voff); const v2u b_ = *(const GAS v2u*)(rp_ + voff + 16); buf[i_] = (v6u){a_.x, a_.y, a_.z, a_.w, b_.x, b_.y}; } } while (0)
#define PG6_DOT1(buf, i_, dst) do { const v32f f_ = __builtin_amdgcn_cvt_scalef32_pk32_f32_fp6(buf[i_], 1.0f); f32x2 a_ = {0.f, 0.f}; \
        _Pragma("unroll") for (int c_ = 0; c_ < 16; ++c_) a_ += (f32x2){f_[2 * c_], f_[2 * c_ + 1]} * x[c_]; dst = a_.x + a_.y; __builtin_amdgcn_sched_barrier(0); } while (0)
#if PG6_R == 8
#define PG6_DOT(buf, g) do { float p_[8]; _Pragma("unroll") for (int i_ = 0; i_ < 8; ++i_) PG6_DOT1(buf, i_, p_[i_]); \
        float q_[4]; _Pragma("unroll") for (int i_ = 0; i_ < 4; ++i_) { const float keep_ = b5 ? p_[i_ + 4] : p_[i_], send_ = b5 ? p_[i_] : p_[i_ + 4]; q_[i_] = keep_ + shx(send_, 32, lane); } \
        float r_[2]; _Pragma("unroll") for (int i_ = 0; i_ < 2; ++i_) { const float keep_ = b4 ? q_[i_ + 2] : q_[i_], send_ = b4 ? q_[i_] : q_[i_ + 2]; r_[i_] = keep_ + shx(send_, 16, lane); } \
        float s_; { const float keep_ = b3 ? r_[1] : r_[0], send_ = b3 ? r_[0] : r_[1]; s_ = keep_ + shx(send_, 8, lane); } \
        s_ += shx(s_, 4, lane); s_ += shx(s_, 2, lane); s_ += shx(s_, 1, lane); \
        if ((lane & 7) == 0) wl[(g) * 8 + (lane >> 3)] = s_; } while (0)
#else
#define PG6_DOT(buf, g) do { float p_[4]; _Pragma("unroll") for (int i_ = 0; i_ < 4; ++i_) PG6_DOT1(buf, i_, p_[i_]); \
        float r_[2]; _Pragma("unroll") for (int i_ = 0; i_ < 2; ++i_) { const float keep_ = b5 ? p_[i_ + 2] : p_[i_], send_ = b5 ? p_[i_] : p_[i_ + 2]; r_[i_] = keep_ + shx(send_, 32, lane); } \
        float s_; { const float keep_ = b4 ? r_[1] : r_[0], send_ = b4 ? r_[0] : r_[1]; s_ = keep_ + shx(send_, 16, lane); } \
        s_ += shx(s_, 8, lane); s_ += shx(s_, 4, lane); s_ += shx(s_, 2, lane); s_ += shx(s_, 1, lane); \
        if ((lane & 15) == 0) wl[(g) * 4 + (lane >> 4)] = s_; } while (0)
#endif
#define PG6_AXPY(buf, g) do { _Pragma("unroll") for (int i_ = 0; i_ < PG6_R; ++i_) { const float w_ = wl[(g) * PG6_R + i_]; const f32x2 wv_ = {w_, w_}; \
        const v32f f_ = __builtin_amdgcn_cvt_scalef32_pk32_f32_fp6(buf[i_], 1.0f); _Pragma("unroll") for (int c_ = 0; c_ < 16; ++c_) y[c_] += (f32x2){f_[2 * c_], f_[2 * c_ + 1]} * wv_; __builtin_amdgcn_sched_barrier(0); } } while (0)
__device__ __forceinline__ unsigned shxu(unsigned v, int k, int lane) { return (unsigned)__builtin_amdgcn_ds_bpermute((lane ^ k) << 2, (int)v); }
__device__ __forceinline__ void wave_sort128(unsigned& a, unsigned& b, int lane) {
#pragma unroll
    for (int k = 2; k <= 128; k <<= 1) {
#pragma unroll
        for (int j = k >> 1; j > 0; j >>= 1) {
            if (j == 64) { const unsigned lo = a < b ? a : b, hi = a < b ? b : a; a = lo; b = hi; }
            else {
                const unsigned pa = shxu(a, j, lane), pb = shxu(b, j, lane);
                const bool lower = (lane & j) == 0;
                const bool asc_a = (lane & k) == 0, asc_b = ((lane + 64) & k) == 0;
                const bool take_min_a = (lower == asc_a), take_min_b = (lower == asc_b);
                a = take_min_a ? (a < pa ? a : pa) : (a < pa ? pa : a);
                b = take_min_b ? (b < pb ? b : pb) : (b < pb ? pb : b);
            }
        }
    }
}
#ifndef PEER_U_FP4
#define PEER_U_FP4 1
#endif
#if PEER_U_FP4
typedef v4u urow_t;
#define PGU_LOAD PG4_LOAD
#define PGU_DOT PG4_DOT
constexpr float PU_SCALE = PU_SCALE4; constexpr int PU_STRIDE = 1024;
#else
typedef v6u urow_t;
#define PGU_LOAD PG6_LOAD
#define PGU_DOT PG6_DOT
constexpr float PU_SCALE = PU_SCALE6; constexpr int PU_STRIDE = 1536;
#endif
constexpr float PU_SCALEI = 135.0f, PX_SCALEI = 20.0f;
__device__ __forceinline__ void peer_v_pass(bf16* XN, const unsigned char* PV6, const int* PIDX, const float* PGATE, const int* PARTI, float* X, u64_t* rowsq_out, unsigned char* XN8, float* xsc, const u64_t* rowsq1, const u64_t* rowsq2, LAS float* wl, int gw, int NGW, int lane) {
    const unsigned voff4 = 16u * (unsigned)lane, l4 = 4u * (unsigned)lane, l8 = 8u * (unsigned)lane, l16 = 16u * (unsigned)lane;
    constexpr int NG = 128 / PG6_R;
    const __amdgpu_buffer_rsrc_t PVr = __builtin_amdgcn_make_buffer_rsrc((void*)PV6, 0, PEER_N * 1024, 0x00020000);
    for (int t_ = gw; t_ < T; t_ += NGW) {
        int t = t_; asm volatile("" : "+s"(t));
        const char* pidx_t = (const char*)(PIDX + (size_t)t * 128); const char* pgate_t = (const char*)(PGATE + (size_t)t * 128);
        const int idlo = *(const GAS int*)(pidx_t + l4), idhi = *(const GAS int*)(pidx_t + l4 + 256);
        v4u AV[PG6_R], BV[PG6_R];
        PG4_LOAD(AV, PVr, idlo, idhi, 0);
        {
            int s0 = 0, s1 = 0;
#pragma unroll
            for (int sp = 0; sp < 8; ++sp) { const char* pp = (const char*)(PARTI + ((size_t)sp * T + t) * 128); s0 += *(const GAS int*)(pp + l4); s1 += *(const GAS int*)(pp + l4 + 256); }
            const float sct = (8.0f / 127.0f / PU_SCALEI) * rowsq_rs(rowsq2, t) / rowsq_rs(rowsq1, t);
            const float d0 = (float)s0 * sct, d1 = (float)s1 * sct;
            const float g0 = *(const GAS float*)(pgate_t + l4), g1 = *(const GAS float*)(pgate_t + l4 + 256);
            const float w0 = g0 * 0.5f * d0 * (1.f + erff(d0 * 0.70710678118654752f)) * (1.f / PV_SCALE4), w1 = g1 * 0.5f * d1 * (1.f + erff(d1 * 0.70710678118654752f)) * (1.f / PV_SCALE4);
            wl[lane] = w0; wl[64 + lane] = w1;
            LDS_WAIT(); asm volatile("" ::: "memory");
        }
        f32x2 y[16];
#pragma unroll
        for (int i = 0; i < 16; ++i) y[i] = (f32x2){0.f, 0.f};
#pragma unroll 1
        for (int g = 0; g < NG; g += 2) {
            PG4_LOAD(BV, PVr, idlo, idhi, g + 1);
            PG4_AXPY(AV, g);
            if (g + 2 < NG) PG4_LOAD(AV, PVr, idlo, idhi, g + 2);
            PG4_AXPY(BV, g + 1);
        }
        {   char* xo = (char*)(X + (size_t)t * DM);
            char* xbo = (char*)(XN + (size_t)t * DM); float ss = 0.f;
#pragma unroll
            for (int j = 0; j < 8; ++j) { const v2u a = *(const GAS v2u*)(xbo + l8 + 512 * j); f32x4 v = (f32x4){bflo(a.x), bfhi(a.x), bflo(a.y), bfhi(a.y)}; v += (f32x4){y[2 * j].x, y[2 * j].y, y[2 * j + 1].x, y[2 * j + 1].y};
                if (X) *(GAS f32x4*)(xo + l16 + 1024 * j) = v;
                y[2 * j] = (f32x2){v[0], v[1]}; y[2 * j + 1] = (f32x2){v[2], v[3]};
                ss += (v[0] * v[0] + v[1] * v[1]) + (v[2] * v[2] + v[3] * v[3]); *(GAS v2u*)(xbo + l8 + 512 * j) = (v2u){pk2(v[0], v[1]), pk2(v[2], v[3])}; }
            if (rowsq_out) { ss = wave_sum(ss, lane); if (lane == 0) rowsq_out[t] = rowsq_fx(ss); }
            if (XN8) {
                float am = 0.f;
#pragma unroll
                for (int j = 0; j < 16; ++j) am = fmaxf(am, fmaxf(fabsf(y[j].x), fabsf(y[j].y)));
                am = fmaxf(wave_max(am, lane), 1e-30f);
                const float inv = 127.f / am; char* qo = (char*)(XN8 + (size_t)t * DM);
#pragma unroll
                for (int j = 0; j < 8; ++j) *(GAS unsigned*)(qo + l4 + 256 * j) = q8x4((f32x4){y[2 * j].x, y[2 * j].y, y[2 * j + 1].x, y[2 * j + 1].y}, inv);
                if (lane == 0) xsc[t] = am * (1.f / 127.f) / sqrtf(ss * (1.f / DM) + 1e-6f); } }
        LDS_WAIT(); asm volatile("" ::: "memory");
    }
}


__device__ __forceinline__ unsigned enc_i4(float v) { int q = (int)__builtin_rintf(v); q = q < -7 ? -7 : (q > 7 ? 7 : q); return (unsigned)q & 15u; }
__device__ __forceinline__ void convert_int4_plain(const float* src, unsigned char* dst, int nrows, float scale, const float* gain, int gw, int NGW, int lane) {
    for (int r0 = 2 * gw; r0 < nrows; r0 += 2 * NGW) {
        f32x4 a[2][8];
#pragma unroll
        for (int q = 0; q < 2; ++q) { const float* sp = src + (size_t)(r0 + q) * DM + 4 * lane;
#pragma unroll
            for (int j = 0; j < 8; ++j) a[q][j] = *(const GAS f32x4*)(sp + 256 * j); }
#pragma unroll
        for (int q = 0; q < 2; ++q) { const int r = r0 + q; const float* gp = gain ? gain + (size_t)(r / PEER_N) * DM + 4 * lane : nullptr;
#pragma unroll
            for (int j = 0; j < 8; ++j) { f32x4 v = a[q][j] * scale; if (gp) v = v * *(const GAS f32x4*)(gp + 256 * j);
                const unsigned w = enc_i4(v[0]) | (enc_i4(v[1]) << 4) | (enc_i4(v[2]) << 8) | (enc_i4(v[3]) << 12);
                *(GAS unsigned short*)(dst + (size_t)r * 1024 + 128 * j + 2 * lane) = (unsigned short)w; } }
    }
}
__device__ __forceinline__ void peer_xquant_unit(const bf16* XN, const u64_t* rowsq, unsigned* XQH, unsigned* XQL, int tb, int sl, int tid) {
    for (int it = tid; it < 256 * 32; it += NTHREADS) {
        const int t = tb * 256 + (it >> 5), c8 = it & 31;
        const float xs = PX_SCALEI * rowsq_rs(rowsq, t);
        const v4u w = *(const GAS v4u*)(XN + (size_t)t * DM + 256 * sl + 8 * c8);
        const float f[8] = {bflo(w.x), bfhi(w.x), bflo(w.y), bfhi(w.y), bflo(w.z), bfhi(w.z), bflo(w.w), bfhi(w.w)};
        unsigned hi = 0u, lo = 0u;
#pragma unroll
        for (int j = 0; j < 8; ++j) { int q = (int)__builtin_rintf(f[j] * xs); q = q < -119 ? -119 : (q > 119 ? 119 : q);
            const int xl = ((q + 8) & 15) - 8, xh = (q - xl) >> 4;
            hi |= ((unsigned)xh & 15u) << (4 * j); lo |= ((unsigned)xl & 15u) << (4 * j); }
        XQH[(size_t)t * 256 + 32 * sl + c8] = hi; XQL[(size_t)t * 256 + 32 * sl + c8] = lo;
    }
}
#define PI_LOADROWS(buf, tab, ids, i0) do { _Pragma("unroll") for (int i_ = 0; i_ < 8; ++i_) buf[i_] = __builtin_amdgcn_raw_buffer_load_b128(tab, ids[(i0) + i_] * 1024 + (int)soff, 0, 0); } while (0)
#define PI_LOADIDS(ids, t) do { const char* ip_ = (const char*)PIDX + ((size_t)(t) * 128 + 16 * g) * 4; _Pragma("unroll") for (int c_ = 0; c_ < 4; ++c_) { const v4u q_ = *(const GAS v4u*)(ip_ + 16 * c_); \
        ids[4 * c_] = (int)q_.x; ids[4 * c_ + 1] = (int)q_.y; ids[4 * c_ + 2] = (int)q_.z; ids[4 * c_ + 3] = (int)q_.w; } } while (0)
#define PI_UGROUP(buf, i0) do { _Pragma("unroll") for (int i_ = 0; i_ < 8; ++i_) { int ah_ = 0, al_ = 0; \
        _Pragma("unroll") for (int c_ = 0; c_ < 4; ++c_) { ah_ = __builtin_amdgcn_sdot8((int)buf[i_][c_], (int)xh[c_], ah_, false); al_ = __builtin_amdgcn_sdot8((int)buf[i_][c_], (int)xl[c_], al_, false); } \
        int p_ = 16 * ah_ + al_; p_ += __builtin_amdgcn_ds_bpermute((lane ^ 1) << 2, p_); p_ += __builtin_amdgcn_ds_bpermute((lane ^ 2) << 2, p_); p_ += __builtin_amdgcn_ds_bpermute((lane ^ 4) << 2, p_); \
        if (m == (((i0) + i_) >> 1)) { if (((i0) + i_) & 1) keep1 = p_; else keep0 = p_; } } } while (0)
#define PI_LOADROWS16(buf, tab, ids) do { _Pragma("unroll") for (int i_ = 0; i_ < 16; ++i_) buf[i_] = __builtin_amdgcn_raw_buffer_load_b128(tab, ids[i_] * 1024 + (int)soff, 0, 0); } while (0)
#define PI_LOADX(xh_, xl_, t) do { xh_ = *(const GAS v4u*)((const char*)XQH + (size_t)(t) * 1024 + soff); xl_ = *(const GAS v4u*)((const char*)XQL + (size_t)(t) * 1024 + soff); } while (0)
#define PI_COMPUTE16(buf, xh_, xl_, t) do { int keep0 = 0, keep1 = 0; \
        _Pragma("unroll") for (int i_ = 0; i_ < 16; ++i_) { int ah_ = 0, al_ = 0; \
            _Pragma("unroll") for (int c_ = 0; c_ < 4; ++c_) { ah_ = __builtin_amdgcn_sdot8((int)buf[i_][c_], (int)xh_[c_], ah_, false); al_ = __builtin_amdgcn_sdot8((int)buf[i_][c_], (int)xl_[c_], al_, false); } \
            int p_ = 16 * ah_ + al_; p_ += __builtin_amdgcn_update_dpp(0, p_, 0xB1, 0xf, 0xf, true); p_ += __builtin_amdgcn_update_dpp(0, p_, 0x4E, 0xf, 0xf, true); p_ += __builtin_amdgcn_update_dpp(0, p_, 0x141, 0xf, 0xf, true);   \
            if (m == (i_ >> 1)) { if (i_ & 1) keep1 = p_; else keep0 = p_; } } \
        if ((t) < T) *(GAS v2u*)(PARTI + ((size_t)s * T + (t)) * 128 + 2 * lane) = (v2u){(unsigned)keep0, (unsigned)keep1}; } while (0)
__device__ __forceinline__ void peer_u_phase_i4(const unsigned* XQH, const unsigned* XQL, const unsigned char* PU, const int* PIDX, int* PARTI, int bid, int G, int wave, int lane) {
    const int s = bid & 7, nr = (G - s + 7) >> 3, q = (bid >> 3) * NWAVES + wave, stride = nr * NWAVES, g = lane >> 3, m = lane & 7;
    const unsigned soff = 128u * (unsigned)s + 16u * (unsigned)m;
    if (q >= T) return;
    const __amdgpu_buffer_rsrc_t PUr = __builtin_amdgcn_make_buffer_rsrc((void*)PU, 0, PEER_N * 1024, 0x00020000);
#define PI_CL(t) ((t) < T ? (t) : T - 1)
    int I1[16], I2[16]; v4u xh0, xl0, xh1, xl1, xh2, xl2, RA[16], RB[16];
    PI_LOADIDS(I1, q); PI_LOADX(xh0, xl0, q);
    PI_LOADROWS16(RA, PUr, I1);
    PI_LOADIDS(I1, PI_CL(q + stride)); PI_LOADX(xh1, xl1, PI_CL(q + stride));
    for (int t = q; t < T; t += 2 * stride) {
        PI_LOADROWS16(RB, PUr, I1);
        PI_LOADIDS(I2, PI_CL(t + 2 * stride)); PI_LOADX(xh2, xl2, PI_CL(t + 2 * stride));
        PI_COMPUTE16(RA, xh0, xl0, t);
        PI_LOADROWS16(RA, PUr, I2);
        PI_LOADIDS(I1, PI_CL(t + 3 * stride)); PI_LOADX(xh0, xl0, PI_CL(t + 3 * stride));
        PI_COMPUTE16(RB, xh1, xl1, t + stride);
        xh1 = xh0; xl1 = xl0; xh0 = xh2; xl0 = xl2;
    }
#undef PI_CL
}


constexpr float PV_SCALE4S = 5.65f;
__device__ __forceinline__ unsigned enc_e2m1s(float v) {
    const float a = fabsf(v);
    const unsigned code = a < 0.25f ? 0u : a < 0.75f ? 1u : a < 1.25f ? 2u : a < 1.75f ? 3u : a < 2.5f ? 4u : a < 3.5f ? 5u : a < 5.0f ? 6u : 7u;
    return code | (v < 0.f ? 8u : 0u);
}
__device__ __forceinline__ void convert_fp4_plain(const float* src, unsigned char* dst, int nrows, float scale, const float* gain, int gw, int NGW, int lane) {
    for (int r0 = 2 * gw; r0 < nrows; r0 += 2 * NGW) {
        f32x4 a[2][8];
#pragma unroll
        for (int q = 0; q < 2; ++q) { const float* sp = src + (size_t)(r0 + q) * DM + 4 * lane;
#pragma unroll
            for (int j = 0; j < 8; ++j) a[q][j] = *(const GAS f32x4*)(sp + 256 * j); }
#pragma unroll
        for (int q = 0; q < 2; ++q) { const int r = r0 + q; const float* gp = gain ? gain + (size_t)(r / PEER_N) * DM + 4 * lane : nullptr;
#pragma unroll
            for (int j = 0; j < 8; ++j) { f32x4 v = a[q][j] * scale; if (gp) v = v * *(const GAS f32x4*)(gp + 256 * j);
                const unsigned w = enc_e2m1s(v[0]) | (enc_e2m1s(v[1]) << 4) | (enc_e2m1s(v[2]) << 8) | (enc_e2m1s(v[3]) << 12);
                *(GAS unsigned short*)(dst + (size_t)r * 1024 + 128 * j + 2 * lane) = (unsigned short)w; } }
    }
}
#define PVS_LOADMETA(ids, pp, gg, t) do { PI_LOADIDS(ids, t); _Pragma("unroll") for (int sp_ = 0; sp_ < 8; ++sp_) pp[sp_] = *(const GAS v2u*)(PARTI + ((size_t)sp_ * T + (t)) * 128 + 2 * lane); \
        gg = *(const GAS f32x2*)(PGATE + (size_t)(t) * 128 + 2 * lane); } while (0)
#define PVS_COMPUTE16(buf, pp, gg, t) do { float w0, w1; { int s0_ = 0, s1_ = 0; _Pragma("unroll") for (int sp_ = 0; sp_ < 8; ++sp_) { s0_ += (int)pp[sp_].x; s1_ += (int)pp[sp_].y; } \
            const float d0_ = (float)s0_ * (1.f / (PX_SCALEI * PU_SCALEI)), d1_ = (float)s1_ * (1.f / (PX_SCALEI * PU_SCALEI)); \
            w0 = gg.x * 0.5f * d0_ * (1.f + erff(d0_ * 0.70710678118654752f)) * (1.f / PV_SCALE4S); w1 = gg.y * 0.5f * d1_ * (1.f + erff(d1_ * 0.70710678118654752f)) * (1.f / PV_SCALE4S); } \
        f32x2 y[16]; _Pragma("unroll") for (int i_ = 0; i_ < 16; ++i_) y[i_] = (f32x2){0.f, 0.f}; \
        _Pragma("unroll") for (int i_ = 0; i_ < 16; ++i_) { \
            const float w_ = __builtin_bit_cast(float, __builtin_amdgcn_ds_bpermute(((lane & 56) | (i_ >> 1)) << 2, __builtin_bit_cast(int, (i_ & 1) ? w1 : w0))); const f32x2 wv_ = {w_, w_}; \
            _Pragma("unroll") for (int c_ = 0; c_ < 4; ++c_) { const unsigned u_ = buf[i_][c_]; \
                y[4 * c_ + 0] += __builtin_amdgcn_cvt_scalef32_pk_f32_fp4(u_, 1.0f, 0) * wv_; y[4 * c_ + 1] += __builtin_amdgcn_cvt_scalef32_pk_f32_fp4(u_, 1.0f, 1) * wv_; \
                y[4 * c_ + 2] += __builtin_amdgcn_cvt_scalef32_pk_f32_fp4(u_, 1.0f, 2) * wv_; y[4 * c_ + 3] += __builtin_amdgcn_cvt_scalef32_pk_f32_fp4(u_, 1.0f, 3) * wv_; } } \
        {   LAS float* wp_ = yl + g * 288 + m * 36; \
            _Pragma("unroll") for (int c_ = 0; c_ < 8; ++c_) *(LAS f32x4*)(wp_ + 4 * c_) = (f32x4){y[2 * c_].x, y[2 * c_].y, y[2 * c_ + 1].x, y[2 * c_ + 1].y}; \
            LDS_WAIT(); asm volatile("" ::: "memory"); \
            f32x4 acc_ = {0.f, 0.f, 0.f, 0.f}; const LAS float* rp_ = yl + (lane >> 3) * 36 + 4 * (lane & 7); \
            _Pragma("unroll") for (int gg_ = 0; gg_ < 8; ++gg_) acc_ += *(const LAS f32x4*)(rp_ + gg_ * 288); \
            LDS_WAIT(); asm volatile("" ::: "memory"); \
            if ((t) < T) { bf16* xp_ = XN + (size_t)(t) * DM + 256 * s + 4 * lane; const v2u a_ = *(const GAS v2u*)xp_; \
                const f32x4 v_ = (f32x4){bflo(a_.x), bfhi(a_.x), bflo(a_.y), bfhi(a_.y)} + acc_; \
                *(GAS v2u*)xp_ = (v2u){pk2(v_[0], v_[1]), pk2(v_[2], v_[3])}; \
                if (Xout) *(GAS f32x4*)(Xout + (size_t)(t) * DM + 256 * s + 4 * lane) = v_; \
                if (rowsq_out) { const float ss_ = wave_sum((v_[0] * v_[0] + v_[1] * v_[1]) + (v_[2] * v_[2] + v_[3] * v_[3]), lane); if (lane == 0) atomicAdd(rowsq_out + (t), rowsq_fx(ss_)); } } } } while (0)
__device__ __forceinline__ void peer_v_phase_s(bf16* XN, const unsigned char* PV, const int* PIDX, const float* PGATE, const int* PARTI, float* Xout, u64_t* rowsq_out, LAS float* yl, int bid, int G, int wave, int lane) {
    const int s = bid & 7, nr = (G - s + 7) >> 3, q = (bid >> 3) * NWAVES + wave, stride = nr * NWAVES, g = lane >> 3, m = lane & 7;
    const unsigned soff = 128u * (unsigned)s + 16u * (unsigned)m;
    if (q >= T) return;
    const __amdgpu_buffer_rsrc_t PVr = __builtin_amdgcn_make_buffer_rsrc((void*)PV, 0, PEER_N * 1024, 0x00020000);
#define PVS_CL(t) ((t) < T ? (t) : T - 1)
    int I0[16], I1[16]; v2u P0[8], P1[8]; f32x2 G0, G1; v4u RA[16], RB[16];
#define PVS_LOADPG(pp, gg, t) do { _Pragma("unroll") for (int sp_ = 0; sp_ < 8; ++sp_) pp[sp_] = *(const GAS v2u*)(PARTI + ((size_t)sp_ * T + (t)) * 128 + 2 * lane); gg = *(const GAS f32x2*)(PGATE + (size_t)(t) * 128 + 2 * lane); } while (0)
    PI_LOADIDS(I0, q); PVS_LOADPG(P0, G0, q);
    PI_LOADROWS16(RA, PVr, I0);
    PI_LOADIDS(I1, PVS_CL(q + stride)); PVS_LOADPG(P1, G1, PVS_CL(q + stride));
    for (int t = q; t < T; t += 2 * stride) {
        PI_LOADROWS16(RB, PVr, I1);
        PI_LOADIDS(I0, PVS_CL(t + 2 * stride));
        PVS_COMPUTE16(RA, P0, G0, t);
        PVS_LOADPG(P0, G0, PVS_CL(t + 2 * stride));
        PI_LOADROWS16(RA, PVr, I0);
        PI_LOADIDS(I1, PVS_CL(t + 3 * stride));
        PVS_COMPUTE16(RB, P1, G1, t + stride);
        PVS_LOADPG(P1, G1, PVS_CL(t + 3 * stride));
    }
#undef PVS_LOADPG
#undef PVS_CL
}

typedef short s16x4 __attribute__((ext_vector_type(4)));
typedef __attribute__((address_space(3))) const char* lds_cptr;
__device__ __forceinline__ s16x4 vtr(lds_cptr p) { return __builtin_bit_cast(s16x4, __builtin_amdgcn_ds_read_tr16_b64_v4i16((__attribute__((address_space(3))) s16x4*)p)); }
__device__ __forceinline__ unsigned cvtpk(float lo, float hi) { unsigned r; asm("v_cvt_pk_bf16_f32 %0, %1, %2" : "=v"(r) : "v"(lo), "v"(hi)); return r; }
constexpr int AT_K0 = 0, AT_V0 = 16384, AT_TAB = 32768;
constexpr float LOG2E = 1.4426950408889634f;
template <int TYPE>
__device__ __forceinline__ void attn_unit(LAS unsigned char* lds, const bf16* QKV, bf16* ATT, u64_t* mixsq, int b, int head, int qb, const float* tabsrc, float Cl2, float sinkl2, int tid) {
    const int lane = tid & 63, w = __builtin_amdgcn_readfirstlane(tid >> 6), hh = lane >> 5, l31 = lane & 31;
    int qcol, kcol, vcol, ocol;
    if (TYPE == 0) { qcol = QA + head * 64; kcol = KA + (head / 3) * 64; vcol = VA + (head / 3) * 64; ocol = OA + head * 64; }
    else if (TYPE == 1) { qcol = QB + head * 64; kcol = KB + head * 64; vcol = VB + head * 64; ocol = OB + head * 64; }
    else { qcol = QC + head * 64; kcol = KC + (head / 3) * 64; vcol = VC + (head / 3) * 64; ocol = OC + head * 64; }
    const int q0 = 256 * qb + 32 * w, qpos = q0 + l31;
    int t_begin, t_end;
    if (TYPE == 0) { t_begin = 4 * qb - 2; if (t_begin < 0) t_begin = 0; t_end = 4 * qb + 6; if (t_end > 32) t_end = 32; }
    else if (TYPE == 1) { int a = 4 * qb - 4; a = a < 0 ? 0 : (a > 24 ? 24 : a); int e = 4 * qb - 1; e = e < 0 ? 0 : (e > 24 ? 24 : e); t_begin = a; t_end = e + 8; }
    else { t_begin = 0; t_end = 32; }
    LAS float* tab = (LAS float*)(lds + AT_TAB);
    if (TYPE == 0) { for (int i = tid; i < 1024; i += NTHREADS) { const int rel = i - 448; tab[i] = (rel >= -128 && rel <= 128) ? tabsrc[head * 257 + rel + 128] * LOG2E - Cl2 : -1e30f; } }
    if (TYPE == 1) { for (int i = tid; i < 15 * 31; i += NTHREADS) tab[i] = tabsrc[head * 465 + i] * LOG2E - Cl2; }
    bf16x8 qf[4];
    {   const bf16* qp = QKV + ((size_t)b * SEQ + qpos) * DIN + qcol + 8 * hh;
#pragma unroll
        for (int s = 0; s < 4; ++s) qf[s] = *(const GAS bf16x8*)(qp + 16 * s); }
    const int srow = tid >> 3, sch = tid & 7;
    const bf16* kg = QKV + ((size_t)b * SEQ + srow) * DIN + kcol + sch * 8;
    const bf16* vg = QKV + ((size_t)b * SEQ + srow) * DIN + vcol + sch * 8;
    const int kst = srow * 128 + ((sch ^ ((srow >> 1) & 7)) * 16);
    const int vst = srow * 128 + (((sch >> 2) ^ ((srow >> 1) & 1)) * 64) + (sch & 3) * 16;
    int kread[4], vread[2];
#pragma unroll
    for (int s = 0; s < 4; ++s) kread[s] = l31 * 128 + (((2 * s + hh) ^ ((lane >> 1) & 7)) * 16);
#pragma unroll
    for (int db = 0; db < 2; ++db) vread[db] = (4 * hh + ((lane >> 2) & 3)) * 128 + ((db ^ ((lane >> 3) & 1)) * 64) + 32 * ((lane >> 4) & 1) + 8 * (lane & 3);
    f32x16 O0, O1;
#pragma unroll
    for (int r = 0; r < 16; ++r) { O0[r] = 0.f; O1[r] = 0.f; }
    float lsum = 0.f;
    const int rw = 4 * qb + (w >> 1), cq = 32 * (w & 1) + l31;
    int r0w = rw - 4; r0w = r0w < 0 ? 0 : (r0w > 24 ? 24 : r0w);
    int c0 = cq - 8; c0 = c0 < 0 ? 0 : (c0 > 48 ? 48 : c0);
    {   const v4u kr = *(const GAS v4u*)(kg + (size_t)t_begin * 64 * DIN), vr = *(const GAS v4u*)(vg + (size_t)t_begin * 64 * DIN);
        *(LAS v4u*)(lds + AT_K0 + kst) = kr; *(LAS v4u*)(lds + AT_V0 + vst) = vr; }
    __syncthreads();
    for (int t = t_begin; t < t_end; ++t) {
        const int cur = (t - t_begin) & 1;
        v4u kr, vr;
        if (t + 1 < t_end) { kr = *(const GAS v4u*)(kg + (size_t)(t + 1) * 64 * DIN); vr = *(const GAS v4u*)(vg + (size_t)(t + 1) * 64 * DIN); }
        bool need = true;
        if (TYPE == 0) need = (64 * t <= q0 + 31 + 128) && (64 * t + 63 >= q0 - 128);
        if (TYPE == 1) need = (t >= r0w) && (t < r0w + 8);
        if (need) {
            const lds_cptr kb_ = (lds_cptr)(lds + AT_K0 + cur * 8192), vb_ = (lds_cptr)(lds + AT_V0 + cur * 8192);
            bf16x8 kf[8];
#pragma unroll
            for (int s = 0; s < 4; ++s) { kf[2 * s] = *(const LAS bf16x8*)(kb_ + kread[s]); kf[2 * s + 1] = *(const LAS bf16x8*)(kb_ + kread[s] + 4096); }
            f32x16 S0, S1;
            if (TYPE == 2) {
#pragma unroll
                for (int r = 0; r < 16; ++r) { S0[r] = -Cl2; S1[r] = -Cl2; }
            } else if (TYPE == 0) {
                const LAS float* tb = tab + (64 * t - qpos + 448 + 4 * hh);
#pragma unroll
                for (int r = 0; r < 16; ++r) { S0[r] = tb[8 * (r >> 2) + (r & 3)]; S1[r] = tb[32 + 8 * (r >> 2) + (r & 3)]; }
            } else {
                const LAS float* tb = tab + ((t - rw + 7) * 31 - cq + 15 + 4 * hh);
                const int kc0 = 4 * hh - c0;
#pragma unroll
                for (int r = 0; r < 16; ++r) { const int ka = 8 * (r >> 2) + (r & 3), kb2 = 32 + ka;
                    S0[r] = ((unsigned)(ka + kc0) < 16u) ? tb[ka] : -1e30f; S1[r] = ((unsigned)(kb2 + kc0) < 16u) ? tb[kb2] : -1e30f; }
            }
            __builtin_amdgcn_sched_barrier(0);
#define AT_SB __builtin_amdgcn_sched_barrier(0)
#define AT_SOFT(SX, base, dst) do { _Pragma("unroll") for (int r = (base); r < (base) + 8; ++r) SX[r] = __builtin_amdgcn_exp2f(SX[r]); \
            lsum += ((SX[(base)] + SX[(base) + 1]) + (SX[(base) + 2] + SX[(base) + 3])) + ((SX[(base) + 4] + SX[(base) + 5]) + (SX[(base) + 6] + SX[(base) + 7])); \
            v4u a_; _Pragma("unroll") for (int j = 0; j < 4; ++j) a_[j] = cvtpk(SX[(base) + 2 * j], SX[(base) + 2 * j + 1]); dst = __builtin_bit_cast(bf16x8, a_); } while (0)
#pragma unroll
            for (int s = 0; s < 4; ++s) S0 = __builtin_amdgcn_mfma_f32_32x32x16_bf16(kf[2 * s], qf[s], S0, 0, 0, 0);
            s16x4 vf[4][2][2];
#pragma unroll
            for (int ks = 0; ks < 2; ++ks)
#pragma unroll
                for (int db = 0; db < 2; ++db) { vf[ks][db][0] = vtr(vb_ + vread[db] + (16 * ks) * 128); vf[ks][db][1] = vtr(vb_ + vread[db] + (16 * ks + 8) * 128); }
            S1 = __builtin_amdgcn_mfma_f32_32x32x16_bf16(kf[1], qf[0], S1, 0, 0, 0); S1 = __builtin_amdgcn_mfma_f32_32x32x16_bf16(kf[3], qf[1], S1, 0, 0, 0);
            AT_SB;
            bf16x8 pb[4];
            AT_SOFT(S0, 0, pb[0]);
            AT_SB;
            S1 = __builtin_amdgcn_mfma_f32_32x32x16_bf16(kf[5], qf[2], S1, 0, 0, 0);
            AT_SB;
            AT_SOFT(S0, 8, pb[1]);
            AT_SB;
            S1 = __builtin_amdgcn_mfma_f32_32x32x16_bf16(kf[7], qf[3], S1, 0, 0, 0);
            asm volatile("s_waitcnt lgkmcnt(7)" ::: "memory");
#pragma unroll
            for (int ks = 2; ks < 4; ++ks)
#pragma unroll
                for (int db = 0; db < 2; ++db) { vf[ks][db][0] = vtr(vb_ + vread[db] + (16 * ks) * 128); vf[ks][db][1] = vtr(vb_ + vread[db] + (16 * ks + 8) * 128); }
            AT_SB;
#define AT_PV(ks) do { const bf16x8 va = __builtin_shufflevector(vf[ks][0][0], vf[ks][0][1], 0, 1, 2, 3, 4, 5, 6, 7), vb2 = __builtin_shufflevector(vf[ks][1][0], vf[ks][1][1], 0, 1, 2, 3, 4, 5, 6, 7); \
            O0 = __builtin_amdgcn_mfma_f32_32x32x16_bf16(va, pb[ks], O0, 0, 0, 0); O1 = __builtin_amdgcn_mfma_f32_32x32x16_bf16(vb2, pb[ks], O1, 0, 0, 0); } while (0)
            AT_PV(0);
            AT_SB;
            AT_SOFT(S1, 0, pb[2]);
            AT_SB;
            AT_PV(1);
            AT_SB;
            AT_SOFT(S1, 8, pb[3]);
            AT_SB;
            AT_PV(2); AT_PV(3);
#undef AT_PV
#undef AT_SOFT
#undef AT_SB
        }
        __builtin_amdgcn_sched_barrier(0);
        if (t + 1 < t_end) { *(LAS v4u*)(lds + AT_K0 + (cur ^ 1) * 8192 + kst) = kr; *(LAS v4u*)(lds + AT_V0 + (cur ^ 1) * 8192 + vst) = vr; }
        __syncthreads();
    }
    lsum += shx(lsum, 32, lane);
    if (TYPE == 0) lsum += __builtin_amdgcn_exp2f(sinkl2 - Cl2);
    const float inv = 1.f / lsum;
    {   float ss = 0.f;
#pragma unroll
        for (int r = 0; r < 16; ++r) { const float a = O0[r] * inv, c = O1[r] * inv; ss += a * a + c * c; }
        ss += shx(ss, 32, lane);
        if (hh == 0) (void)__hip_atomic_fetch_add((GAS u64_t*)(mixsq + (size_t)b * SEQ + qpos), rowsq_fx(ss), __ATOMIC_RELAXED, __HIP_MEMORY_SCOPE_AGENT); }
    bf16* op = ATT + ((size_t)b * SEQ + qpos) * DM + ocol + 4 * hh;
#pragma unroll
    for (int g4 = 0; g4 < 4; ++g4) {
        v2u o0, o1; o0.x = cvtpk(O0[4 * g4] * inv, O0[4 * g4 + 1] * inv); o0.y = cvtpk(O0[4 * g4 + 2] * inv, O0[4 * g4 + 3] * inv);
        o1.x = cvtpk(O1[4 * g4] * inv, O1[4 * g4 + 1] * inv); o1.y = cvtpk(O1[4 * g4 + 2] * inv, O1[4 * g4 + 3] * inv);
        *(GAS v2u*)(op + 8 * g4) = o0; *(GAS v2u*)(op + 32 + 8 * g4) = o1;
    }
}


constexpr int MA_K0 = 0, MA_V0 = 32768;
__device__ __forceinline__ void mem_unit(LAS unsigned char* lds, const bf16* QM, const bf16* KVM, bf16* OM, const float* gq, int tb, int head, float Cl2, int tid) {
    const int lane = tid & 63, w = __builtin_amdgcn_readfirstlane(tid >> 6), hh = lane >> 5, l31 = lane & 31;
    const size_t trow = (size_t)tb * 256 + 32 * w + l31; const int b = tb >> 3;
    bf16x8 qf[8];
    {   const bf16* qp = QM + trow * MEMW + head * 128 + 8 * hh;
#pragma unroll
        for (int s = 0; s < 8; ++s) qf[s] = *(const GAS bf16x8*)(qp + 16 * s);
        float ss = 0.f;
#pragma unroll
        for (int s = 0; s < 8; ++s)
#pragma unroll
            for (int j = 0; j < 8; ++j) { const float f = __builtin_bit_cast(float, (unsigned)(unsigned short)qf[s][j] << 16); ss += f * f; }
        ss += shx(ss, 32, lane);
        const float r = 0.12751743074602468f / sqrtf(ss * (1.f / 128.f) + EPS);
#pragma unroll
        for (int s = 0; s < 8; ++s) { const f32x4 g0 = *(const GAS f32x4*)(gq + 16 * s + 8 * hh), g1 = *(const GAS f32x4*)(gq + 16 * s + 8 * hh + 4);
            v4u o;
#pragma unroll
            for (int j = 0; j < 4; ++j) { const float f0 = __builtin_bit_cast(float, (unsigned)(unsigned short)qf[s][2 * j] << 16), f1 = __builtin_bit_cast(float, (unsigned)(unsigned short)qf[s][2 * j + 1] << 16);
                const float ga = (2 * j < 4) ? g0[2 * j] : g1[2 * j - 4], gb2 = (2 * j + 1 < 4) ? g0[2 * j + 1] : g1[2 * j + 1 - 4];
                o[j] = cvtpk(f0 * r * ga, f1 * r * gb2); }
            qf[s] = __builtin_bit_cast(bf16x8, o); }
    }
    const int srow = tid >> 3, sch = tid & 7;
    const bf16* kg = KVM + ((size_t)b * NMEM + srow) * 1024 + head * 128 + sch * 8;
    const bf16* vg = kg + 512;
    const int kst0 = srow * 256 + ((sch ^ (srow & 15)) * 16), kst1 = srow * 256 + (((sch + 8) ^ (srow & 15)) * 16);
    const int vst0 = srow * 256 + ((((sch) >> 2) ^ (srow & 3)) * 64) + (sch & 3) * 16, vst1 = srow * 256 + ((((sch + 8) >> 2) ^ (srow & 3)) * 64) + (sch & 3) * 16;
    int kread[8], vread[4];
#pragma unroll
    for (int s = 0; s < 8; ++s) kread[s] = l31 * 256 + (((2 * s + hh) ^ (l31 & 15)) * 16);
#pragma unroll
    for (int db = 0; db < 4; ++db) vread[db] = (4 * hh + ((lane >> 2) & 3)) * 256 + ((db ^ ((lane >> 2) & 3)) * 64) + 32 * ((lane >> 4) & 1) + 8 * (lane & 3);
    f32x16 O[4];
#pragma unroll
    for (int db = 0; db < 4; ++db)
#pragma unroll
        for (int r = 0; r < 16; ++r) O[db][r] = 0.f;
    float lsum = 0.f;
    {   const v4u k0 = *(const GAS v4u*)kg, k1 = *(const GAS v4u*)(kg + 64), v0 = *(const GAS v4u*)vg, v1 = *(const GAS v4u*)(vg + 64);
        *(LAS v4u*)(lds + MA_K0 + kst0) = k0; *(LAS v4u*)(lds + MA_K0 + kst1) = k1; *(LAS v4u*)(lds + MA_V0 + vst0) = v0; *(LAS v4u*)(lds + MA_V0 + vst1) = v1; }
    __syncthreads();
#pragma unroll 1
    for (int t = 0; t < 4; ++t) {
        const int cur = t & 1;
        v4u k0, k1, v0, v1;
        if (t + 1 < 4) { const bf16* kn = kg + (size_t)(t + 1) * 64 * 1024; k0 = *(const GAS v4u*)kn; k1 = *(const GAS v4u*)(kn + 64); v0 = *(const GAS v4u*)(kn + 512); v1 = *(const GAS v4u*)(kn + 576); }
        const lds_cptr kb_ = (lds_cptr)(lds + MA_K0 + cur * 16384), vb_ = (lds_cptr)(lds + MA_V0 + cur * 16384);
        f32x16 S0, S1;
#pragma unroll
        for (int r = 0; r < 16; ++r) { S0[r] = -Cl2; S1[r] = -Cl2; }
#pragma unroll
        for (int s = 0; s < 8; ++s) { const bf16x8 a0 = *(const LAS bf16x8*)(kb_ + kread[s]), a1 = *(const LAS bf16x8*)(kb_ + kread[s] + 8192);
            S0 = __builtin_amdgcn_mfma_f32_32x32x16_bf16(a0, qf[s], S0, 0, 0, 0); S1 = __builtin_amdgcn_mfma_f32_32x32x16_bf16(a1, qf[s], S1, 0, 0, 0); }
#pragma unroll
        for (int r = 0; r < 16; ++r) { S0[r] = __builtin_amdgcn_exp2f(S0[r]); S1[r] = __builtin_amdgcn_exp2f(S1[r]); lsum += S0[r] + S1[r]; }
        bf16x8 pb[4];
#pragma unroll
        for (int hf = 0; hf < 2; ++hf) {
            v4u a, c;
#pragma unroll
            for (int j = 0; j < 4; ++j) { a[j] = cvtpk(S0[8 * hf + 2 * j], S0[8 * hf + 2 * j + 1]); c[j] = cvtpk(S1[8 * hf + 2 * j], S1[8 * hf + 2 * j + 1]); }
            pb[hf] = __builtin_bit_cast(bf16x8, a); pb[2 + hf] = __builtin_bit_cast(bf16x8, c);
        }
#pragma unroll
        for (int ks = 0; ks < 4; ++ks)
#pragma unroll
            for (int db = 0; db < 4; ++db) {
                const s16x4 a0 = vtr(vb_ + vread[db] + (16 * ks) * 256), a1 = vtr(vb_ + vread[db] + (16 * ks + 8) * 256);
                const bf16x8 va = __builtin_shufflevector(a0, a1, 0, 1, 2, 3, 4, 5, 6, 7);
                O[db] = __builtin_amdgcn_mfma_f32_32x32x16_bf16(va, pb[ks], O[db], 0, 0, 0);
            }
        if (t + 1 < 4) { LAS unsigned char* kn = lds + MA_K0 + (cur ^ 1) * 16384; LAS unsigned char* vn = lds + MA_V0 + (cur ^ 1) * 16384;
            *(LAS v4u*)(kn + kst0) = k0; *(LAS v4u*)(kn + kst1) = k1; *(LAS v4u*)(vn + vst0) = v0; *(LAS v4u*)(vn + vst1) = v1; }
        __syncthreads();
    }
    lsum += shx(lsum, 32, lane);
    const float inv = 1.f / lsum;
    bf16* op = OM + trow * MEMW + head * 128 + 4 * hh;
#pragma unroll
    for (int db = 0; db < 4; ++db)
#pragma unroll
        for (int g4 = 0; g4 < 4; ++g4) { v2u o; o.x = cvtpk(O[db][4 * g4] * inv, O[db][4 * g4 + 1] * inv); o.y = cvtpk(O[db][4 * g4 + 2] * inv, O[db][4 * g4 + 3] * inv); *(GAS v2u*)(op + 32 * db + 8 * g4) = o; }
}

struct Args { const float* in[23]; float* out; unsigned char* ws; int ph_lo, ph_hi, use_bar, pad; };
#ifndef MK_OFF
#define MK_OFF 0u
#endif
#ifndef REP_ATT
#define REP_ATT 1
#endif
#ifndef REP_P0
#define REP_P0 1
#endif
#ifndef REP_U
#define REP_U 1
#endif
#ifndef REP_GEMM
#define REP_GEMM 1
#endif
#ifndef REP_NORM
#define REP_NORM 1
#endif
#ifndef REP_SEL
#define REP_SEL 1
#endif
#ifndef REP_MEM
#define REP_MEM 1
#endif
#define PHON(k) (!((MK_OFF >> (k)) & 1u))
#ifndef MK_REP
#define MK_REP 0
#endif
constexpr int PH_PER_LAYER = 9, PH_BASE = 2, N_PHASES = PH_BASE + DEPTH * PH_PER_LAYER;
constexpr int PTAB_OFF = LDSCTL_OFF + 1024;

__global__ void __launch_bounds__(NTHREADS, 2) mega(Args a) {
    extern __shared__ __attribute__((aligned(16))) unsigned char lds_raw[];
    LAS unsigned char* lds = (LAS unsigned char*)lds_raw;
    const int wave0_ = __builtin_amdgcn_readfirstlane((int)threadIdx.x >> 6);
    {   const int tid0 = threadIdx.x;
        for (int u = tid0; u < (LDS_BYTES - LDSCTL_OFF) / 4; u += NTHREADS) ((LAS unsigned*)(lds + LDSCTL_OFF))[u] = 0u;
        __syncthreads();
        if (tid0 < 23) ((LAS unsigned long long*)(lds + PTAB_OFF))[tid0] = (unsigned long long)a.in[tid0];
        if (tid0 == 23) ((LAS unsigned long long*)(lds + PTAB_OFF))[23] = (unsigned long long)a.out;
        if (tid0 == 24) ((LAS unsigned long long*)(lds + PTAB_OFF))[24] = (unsigned long long)a.ws;
        __syncthreads();
    }
    volatile LAS unsigned* MISC = (volatile LAS unsigned*)(lds + MISC_OFF);
    const int G = gridDim.x, bid = blockIdx.x, NGW = G * NWAVES;
    const int use_bar = a.use_bar;
    XcdBarrier bar; bar.bar = (unsigned*)(a.ws + WS_CTL) + CW_BAR; bar.x = 0; bar.st = MISC + 8;
    if (use_bar) bar = xcd_barrier_post((unsigned*)(a.ws + WS_CTL) + CW_BAR, MISC + 8);
    const int lo = a.ph_lo, hi = a.ph_hi;
#define IN(k) (lo <= (k) && (k) < hi)
#define SEAM(k) do { if (use_bar && IN(k) && IN((k) + 1)) xcd_barrier(bar); } while (0)
#define PHL() int tid_ = wave0_ * 64 + (int)__builtin_amdgcn_mbcnt_hi(~0u, __builtin_amdgcn_mbcnt_lo(~0u, 0u)); asm volatile("" : "+v"(tid_)); const int lane_ = tid_ & 63, wave_ = __builtin_amdgcn_readfirstlane(tid_ >> 6), gw_ = bid * NWAVES + wave_; (void)lane_; (void)gw_; \
              int pz_ = 0; asm volatile("" : "+s"(pz_))
#define PTR(i) ((const float*)ldptr(lds, (i) + pz_))
#define WSP() ((unsigned char*)ldptr(lds, 24 + pz_))
#define OUTP() ((float*)ldptr(lds, 23 + pz_))

    if (IN(0) && PHON(0)) {
        PHL(); unsigned char* ws = WSP();
        LAS float* scr = (LAS float*)(lds + RING_OFF + wave_ * 16384);
        constexpr int I_IN = 32 * 128, I_OUT = 32 * 64, I_MQ = 32 * 16, I_MKV = 32 * 32, I_MO = 8 * 64, I_PQ = 32 * 64, I_L = I_IN + I_OUT + I_MQ + I_MKV + I_MO + I_PQ;
        for (int it = gw_; it < DEPTH * I_L; it += NGW) {
            const int l = it / I_L; int r = it % I_L;
            if (r < I_IN) { transpose_item<true>(PTR(4) + (size_t)l * DM * DIN, DM, DIN, (bf16*)(ws + WS_WIN) + (size_t)l * DIN * DM, scr, r, lane_, PTR(3) + (size_t)l * DM); continue; } r -= I_IN;
            if (r < I_OUT) { transpose_item<false>(PTR(11) + (size_t)l * DM * DM, DM, DM, (bf16*)(ws + WS_WOUT) + (size_t)l * DM * DM, scr, r, lane_, PTR(10) + (size_t)l * DM); continue; } r -= I_OUT;
            if (r < I_MQ) { transpose_item<false>(PTR(14) + (size_t)l * DM * MEMW, DM, MEMW, (bf16*)(ws + WS_WMQ) + (size_t)l * MEMW * DM, scr, r, lane_, PTR(12) + (size_t)l * DM); continue; } r -= I_MQ;
            if (r < I_MKV) { transpose_item<false>(PTR(15) + (size_t)l * DM * 1024, DM, 1024, (bf16*)(ws + WS_WMKV) + (size_t)l * 1024 * DM, scr, r, lane_); continue; } r -= I_MKV;
            if (r < I_MO) { transpose_item<false>(PTR(17) + (size_t)l * MEMW * DM, MEMW, DM, (bf16*)(ws + WS_WMO) + (size_t)l * DM * MEMW, scr, r, lane_); continue; } r -= I_MO;
            transpose_item<false>(PTR(19) + (size_t)l * DM * DM, DM, DM, (bf16*)(ws + WS_WPQ) + (size_t)l * DM * DM, scr, r, lane_, PTR(18) + (size_t)l * DM);
        }
        const size_t gtid = (size_t)bid * NTHREADS + tid_, nth = (size_t)G * NTHREADS;
        convert_bf16(PTR(20), (bf16*)(ws + WS_PKEYS), (size_t)DEPTH * 8 * 2 * 128 * 128, gtid, nth);
        convert_int4_plain(PTR(21), ws + WS_PU, DEPTH * PEER_N, PU_SCALEI, PTR(18), gw_, NGW, lane_);
        convert_fp4_rows(PTR(22), ws + WS_PV, PEER_N, PV_SCALE4, nullptr, gw_, NGW, lane_);
        {   const float* x0 = PTR(0); bf16* XN = (bf16*)(ws + WS_XN); u64_t* rsq = (u64_t*)(ws + WS_ROWSQ);
            for (int m = 2 * gw_; m < T; m += 2 * NGW) prep_rows2(x0 + (size_t)m * DM, XN + (size_t)m * DM, rsq + m, ws + WS_XN8 + (size_t)m * DM, (float*)(ws + WS_XSC) + m, lane_); }
        {   const float* mem = PTR(1); const float* gkv = PTR(13); bf16* MEMN = (bf16*)(ws + WS_MEMN);
            for (int m = gw_; m < BATCH * NMEM; m += NGW)
                rms_row_to_bf16(mem + (size_t)m * DM, gkv, MEMN + (size_t)m * DM, gkv + DM, MEMN + (size_t)(BATCH * NMEM + m) * DM, lane_); }
        float* rope = (float*)(ws + WS_ROPE); float* biasA = (float*)(ws + WS_BIASA);
        if (gtid < 64 * 16) { const int pos = (int)gtid >> 4, i = (int)gtid & 15; const float ang = (float)pos * ROPE_INV[i]; rope[gtid * 2] = cosf(ang); rope[gtid * 2 + 1] = sinf(ang); }
        if (gtid < 12 * 257) { const int h = (int)gtid / 257, rel = (int)gtid % 257 - 128; biasA[gtid] = PTR(2)[t5_bucket(rel) * 12 + h]; }
    }
    SEAM(0);
    if (IN(1) && PHON(1)) {
        {   PHL(); unsigned char* ws = WSP();
            for (int r = gw_; r < DEPTH * DIN; r += NGW) { const int rr = r & (DIN - 1), src = (rr & ~255) + 64 * ((rr >> 5) & 3) + 32 * ((rr >> 7) & 1) + (rr & 31);
                quant_wrow((const bf16*)(ws + WS_WIN) + (size_t)r * DM, ws + WS_WIN8 + (size_t)r * DM, (float*)(ws + WS_WSC) + (r & ~(DIN - 1)) + src, lane_); }
            for (int r = gw_; r < DEPTH * DM; r += NGW) quant_wrow((const bf16*)(ws + WS_WOUT) + (size_t)r * DM, ws + WS_WOUT8 + (size_t)r * DM, (float*)(ws + WS_WSCO) + r, lane_);
            for (int r = gw_; r < DEPTH * DM; r += NGW) quant_wrow((const bf16*)(ws + WS_WPQ) + (size_t)r * DM, ws + WS_WPQ8 + (size_t)r * DM, (float*)(ws + WS_WSCP) + r, lane_);
            for (int r = gw_; r < DEPTH * MEMW; r += NGW) quant_wrow((const bf16*)(ws + WS_WMQ) + (size_t)r * DM, ws + WS_WMQ8 + (size_t)r * DM, (float*)(ws + WS_WSCM) + r, lane_); }
#pragma unroll 1
        for (int l = 0; l < DEPTH; ++l) {
            PHL(); unsigned char* ws = WSP();
            pg8::Gemm g{(bf16*)(ws + WS_MEMN) + (size_t)l * BATCH * NMEM * DM, (bf16*)(ws + WS_WMKV) + (size_t)l * 1024 * DM, BATCH * NMEM, 1024, DM};
            OffsetOrder S; S.init(BATCH * NMEM, 1024, G, bid, 64 * l);
            bf16* KVMl = (bf16*)(ws + WS_KVM) + (size_t)l * BATCH * NMEM * 1024;
            pg8::EpiBf16<0> E{KVMl, 1024, nullptr, 0, 0, 1.f};
            pg8::gemm_phase<pg8::EpiBf16<0>, OffsetOrder, true, true>(lds + RING_OFF, g, S, E, tid_);
            VM_WAIT(); __syncthreads();
            const float* gk = PTR(16) + (size_t)l * 256 + 128;
#pragma unroll 1
            for (int i = 0; i < 4; ++i) { pg8::Unit uu; uu.pm = 0; uu.pn = 0; if (!S.next(i, uu)) break;
                if (uu.pn < 2) {
                    for (int r2 = wave_; r2 < 128; r2 += NWAVES) { const int row = uu.pm * 256 + 2 * r2 + (lane_ >> 5), cl = lane_ & 31;
                        GAS v4u* p = (GAS v4u*)(KVMl + (size_t)row * 1024 + 256 * uu.pn + 8 * cl);
                        const v4u w = *p;
                        float f[8] = {bflo(w.x), bfhi(w.x), bflo(w.y), bfhi(w.y), bflo(w.z), bfhi(w.z), bflo(w.w), bfhi(w.w)};
                        float ss = 0.f;
#pragma unroll
                        for (int e = 0; e < 8; ++e) ss += f[e] * f[e];
                        ss += shx(ss, 1, lane_); ss += shx(ss, 2, lane_); ss += shx(ss, 4, lane_); ss += shx(ss, 8, lane_);
                        const float r = 1.f / sqrtf(ss * (1.f / 128.f) + EPS);
                        const float* gg = gk + 8 * (cl & 15);
                        v4u o; o.x = pk2(f[0] * r * gg[0], f[1] * r * gg[1]); o.y = pk2(f[2] * r * gg[2], f[3] * r * gg[3]); o.z = pk2(f[4] * r * gg[4], f[5] * r * gg[5]); o.w = pk2(f[6] * r * gg[6], f[7] * r * gg[7]);
                        *p = o; } } }
            __syncthreads();
        }
        if (G >= 256 && bid >= 128) { PHL(); unsigned char* ws = WSP();
            convert_fp4_rows(PTR(22) + (size_t)PEER_N * DM, ws + WS_PV + (size_t)PEER_N * 1024, PEER_N, PV_SCALE4, nullptr, (bid - 128) * NWAVES + wave_, (G - 128) * NWAVES, lane_); }
        else if (G < 256) { PHL(); unsigned char* ws = WSP(); convert_fp4_rows(PTR(22) + (size_t)PEER_N * DM, ws + WS_PV + (size_t)PEER_N * 1024, PEER_N, PV_SCALE4, nullptr, gw_, NGW, lane_); }
    }
    SEAM(1);

#pragma unroll 1
    for (int l = 0; l < DEPTH; ++l) {
        const int pb = PH_BASE + PH_PER_LAYER * l;
        if (IN(pb + 0) && PHON(3)) { PHL(); unsigned char* ws = WSP();
            pg8::Gemm g{(bf16*)(ws + WS_XN8), (bf16*)(ws + WS_WIN8 + (size_t)l * DIN * DM), T, DIN, DM / 2}; pg8::StaticOrder S; S.init(T, DIN, G, bid);
            LAS float* ropel = (LAS float*)(lds + LDSCTL_OFF + 2048);
            for (int i = tid_; i < 64 * 16 * 2; i += NTHREADS) ropel[i] = ((const float*)(ws + WS_ROPE))[i];
            __syncthreads();
            pg8::EpiQKV E{(bf16*)(ws + WS_QKV), PTR(5) + (size_t)l * 128, PTR(7) + (size_t)l * 128, PTR(9) + (size_t)l * 128, ropel, (const u64_t*)(ws + WS_ROWSQ) + (size_t)(l * 3 + 0) * T, (const float*)(ws + WS_XSC), (const float*)(ws + WS_WSC) + (size_t)l * DIN};
            pg8::gemm_phase<pg8::EpiQKV, pg8::StaticOrder, true, true>(lds + RING_OFF, g, S, E, tid_);
        }
        SEAM(pb + 0);
        if (IN(pb + 1) && PHON(4)) { PHL(); unsigned char* ws = WSP();
            const float* sink = PTR(6) + (size_t)l * 12; const float* rpb = PTR(8) + (size_t)l * 8 * 15 * 31; const float* biasA = (const float*)(ws + WS_BIASA);
            const bf16* QKV = (const bf16*)(ws + WS_QKV); bf16* ATT = (bf16*)(ws + WS_ATT);
            const float* ga = PTR(5) + (size_t)l * 128; const float* gb = PTR(7) + (size_t)l * 128; const float* gc = PTR(9) + (size_t)l * 128;
            const float CaL2 = 8.f * wave_max(fabsf(ga[lane_]), lane_) * wave_max(fabsf(ga[64 + lane_]), lane_) * LOG2E;
            const float CbL2 = 8.f * wave_max(fabsf(gb[lane_]), lane_) * wave_max(fabsf(gb[64 + lane_]), lane_) * LOG2E;
            const float CcL2 = 8.f * wave_max(fabsf(gc[lane_]), lane_) * wave_max(fabsf(gc[64 + lane_]), lane_) * LOG2E;
            const int vc = (G % 8 == 0) ? (bid % 8) * (G / 8) + bid / 8 : bid;
            u64_t* mixsq = (u64_t*)(ws + WS_MIXSQ) + (size_t)l * 3 * T;
            for (int u = vc; u < BATCH * 12 * 8; u += G) attn_unit<2>(lds, QKV, ATT, mixsq + 2 * (size_t)T, u / 96, (u >> 3) % 12, u & 7, nullptr, CcL2, 0.f, tid_);
            for (int u = vc; u < BATCH * 8 * 8; u += G) attn_unit<1>(lds, QKV, ATT, mixsq + (size_t)T, u >> 6, (u >> 3) & 7, u & 7, rpb, CbL2, 0.f, tid_);
            for (int u = vc; u < BATCH * 12 * 8; u += G) { const int head = (u >> 3) % 12; attn_unit<0>(lds, QKV, ATT, mixsq, u / 96, head, u & 7, biasA, CaL2, sink[head] * LOG2E, tid_); }
        }
        SEAM(pb + 1);
        if (IN(pb + 2) && PHON(5)) { PHL(); unsigned char* ws = WSP();
            const u64_t* mixsq = (const u64_t*)(ws + WS_MIXSQ) + (size_t)l * 3 * T;
            for (int r = 4 * gw_; r < T; r += 4 * NGW) att_quant_rows<4>((const bf16*)(ws + WS_ATT), mixsq, ws + WS_ATT8, (float*)(ws + WS_XSC2), r, lane_);
        }
        SEAM(pb + 2);
        if (IN(pb + 3) && PHON(5)) { PHL(); unsigned char* ws = WSP();
            pg8::Gemm g{(bf16*)(ws + WS_ATT8), (bf16*)(ws + WS_WOUT8 + (size_t)l * DM * DM), T, DM, DM / 2}; pg8::StaticOrder S; S.init(T, DM, G, bid);
            typedef pg8::EpiResidT<true, 10> EpiX1;
            EpiX1 E{(bf16*)(ws + WS_XN), DM, (u64_t*)(ws + WS_ROWSQ) + (size_t)(l * 3 + 1) * T, (const float*)(ws + WS_XSC2), (const float*)(ws + WS_WSCO) + (size_t)l * DM, ws + WS_X8, (const u64_t*)(ws + WS_ROWSQ) + (size_t)(l * 3 + 0) * T, nullptr, nullptr};
            pg8::gemm_phase<EpiX1, pg8::StaticOrder, true, true>(lds + RING_OFF, g, S, E, tid_);
        }
        SEAM(pb + 3);
        if (IN(pb + 4) && PHON(6)) { PHL(); unsigned char* ws = WSP();
            pg8::Gemm g{(bf16*)(ws + WS_X8), (bf16*)(ws + WS_WMQ8 + (size_t)l * MEMW * DM), T, MEMW, DM / 2}; pg8::StaticOrder S; S.init(T, MEMW, G, bid);
            pg8::EpiBf16Row8<10> E{(bf16*)(ws + WS_QM), MEMW, (const u64_t*)(ws + WS_ROWSQ) + (size_t)(l * 3 + 1) * T, (const u64_t*)(ws + WS_ROWSQ) + (size_t)(l * 3 + 0) * T, (const float*)(ws + WS_WSCM) + (size_t)l * MEMW};
            pg8::gemm_phase<pg8::EpiBf16Row8<10>, pg8::StaticOrder, true, true>(lds + RING_OFF, g, S, E, tid_);
            VM_WAIT(); __syncthreads();
            const bf16* kvm = (const bf16*)(ws + WS_KVM) + (size_t)l * BATCH * NMEM * 1024; const float* gq = PTR(16) + (size_t)l * 256;
            const float CmL2 = 11.313708498984761f * wave_max(fmaxf(fabsf(gq[lane_]), fabsf(gq[64 + lane_])), lane_) * wave_max(fmaxf(fabsf(gq[128 + lane_]), fabsf(gq[192 + lane_])), lane_) * LOG2E;
#pragma unroll 1
            for (int i = 0; i < 4; ++i) { pg8::Unit uu; uu.pm = 0; uu.pn = 0; if (!S.next(i, uu)) break;
                mem_unit(lds, (const bf16*)(ws + WS_QM), kvm, (bf16*)(ws + WS_OM), gq, uu.pm, 2 * uu.pn, CmL2, tid_);
                mem_unit(lds, (const bf16*)(ws + WS_QM), kvm, (bf16*)(ws + WS_OM), gq, uu.pm, 2 * uu.pn + 1, CmL2, tid_);
#if MK_REP == 1
                mem_unit(lds, (const bf16*)(ws + WS_QM), kvm, (bf16*)(ws + WS_OM), gq, uu.pm, 2 * uu.pn, CmL2, tid_); mem_unit(lds, (const bf16*)(ws + WS_QM), kvm, (bf16*)(ws + WS_OM), gq, uu.pm, 2 * uu.pn + 1, CmL2, tid_);
#endif
            }
        }
        SEAM(pb + 4);
        if (IN(pb + 5) && PHON(7)) { PHL(); unsigned char* ws = WSP();
            pg8::Gemm g{(bf16*)(ws + WS_OM), (bf16*)(ws + WS_WMO) + (size_t)l * DM * MEMW, T, DM, MEMW}; pg8::StaticOrder S; S.init(T, DM, G, bid);
            typedef pg8::EpiResidT<false, 8, true> EpiX2;
            EpiX2 E{(bf16*)(ws + WS_XN), DM, (u64_t*)(ws + WS_ROWSQ) + (size_t)(l * 3 + 2) * T, nullptr, nullptr, ws + WS_X8, (const u64_t*)(ws + WS_ROWSQ) + (size_t)(l * 3 + 1) * T, ws + WS_XQH, ws + WS_XQL};
            pg8::gemm_phase<EpiX2, pg8::StaticOrder, true, true>(lds + RING_OFF, g, S, E, tid_);
        }
        SEAM(pb + 5);
        if (IN(pb + 6) && PHON(8)) { PHL(); unsigned char* ws = WSP();
            pg8::Gemm g{(bf16*)(ws + WS_X8), (bf16*)(ws + WS_WPQ8 + (size_t)l * DM * DM), T, DM, DM / 2}; pg8::StaticOrder S; S.init(T, DM, G, bid);
            pg8::EpiBf16Row8<8> E{(bf16*)(ws + WS_QP), DM, (const u64_t*)(ws + WS_ROWSQ) + (size_t)(l * 3 + 2) * T, (const u64_t*)(ws + WS_ROWSQ) + (size_t)(l * 3 + 1) * T, (const float*)(ws + WS_WSCP) + (size_t)l * DM};
            pg8::gemm_phase<pg8::EpiBf16Row8<8>, pg8::StaticOrder, true, true>(lds + RING_OFF, g, S, E, tid_);
            VM_WAIT(); __syncthreads();
            const bf16* pk = (const bf16*)(ws + WS_PKEYS) + (size_t)l * 8 * 2 * 128 * 128;
#pragma unroll 1
            for (int i = 0; i < 8; ++i) { pg8::Unit uu; uu.pm = 0; uu.pn = 0; if (!S.next(i, uu)) break;
                peer_select_unit((const bf16*)(ws + WS_QP), pk, (int*)(ws + WS_PIDX), (float*)(ws + WS_PGATE), uu.pm, uu.pn, wave_, lane_, lds + RING_OFF);
#if MK_REP == 2
                peer_select_unit((const bf16*)(ws + WS_QP), pk, (int*)(ws + WS_PIDX), (float*)(ws + WS_PGATE), uu.pm, uu.pn, wave_, lane_, lds + RING_OFF);
#endif
#if MK_REP == 3
#endif
            }
        }
        SEAM(pb + 6);
        if (IN(pb + 7) && PHON(9)) { PHL(); unsigned char* ws = WSP();
            peer_u_phase_i4((const unsigned*)(ws + WS_XQH), (const unsigned*)(ws + WS_XQL), ws + WS_PU + (size_t)l * PEER_N * 1024, (const int*)(ws + WS_PIDX), (int*)(ws + WS_PARTI), bid, G, wave_, lane_); }
        SEAM(pb + 7);
        if (IN(pb + 8) && PHON(10)) { PHL(); unsigned char* ws = WSP();
            peer_v_pass((bf16*)(ws + WS_XN), ws + WS_PV + (size_t)l * PEER_N * 1024, (const int*)(ws + WS_PIDX), (const float*)(ws + WS_PGATE), (const int*)(ws + WS_PARTI), (l + 1 == DEPTH) ? OUTP() : (float*)nullptr,
                        (l + 1 < DEPTH) ? (u64_t*)(ws + WS_ROWSQ) + (size_t)((l + 1) * 3 + 0) * T : (u64_t*)nullptr, (l + 1 < DEPTH) ? ws + WS_XN8 : (unsigned char*)nullptr, (float*)(ws + WS_XSC), (const u64_t*)(ws + WS_ROWSQ) + (size_t)(l * 3 + 1) * T, (const u64_t*)(ws + WS_ROWSQ) + (size_t)(l * 3 + 2) * T, (LAS float*)(lds + RING_OFF + wave_ * 1024), gw_, NGW, lane_); }
        SEAM(pb + 8);
    }
#undef IN
#undef SEAM
}

#ifndef MK_MULTI_LAUNCH
#define MK_MULTI_LAUNCH 0
#endif
extern "C" void kernel_launch(void* const* d_in, const int* in_sizes, int n_in, void* d_out, int out_size, void* d_ws, size_t ws_size, hipStream_t stream) {
    static int grid = 0;
    if (grid == 0) {
        if (n_in != 23 || out_size != T * DM || ws_size < WS_END) { fprintf(stderr, "kernel_launch: unexpected shapes (n_in %d, out %d, ws %zu)\n", n_in, out_size, ws_size); grid = -1; return; }
        int dev = 0, cus = 0, per_cu = 0;
        if (hipGetDevice(&dev) != hipSuccess || hipDeviceGetAttribute(&cus, hipDeviceAttributeMultiprocessorCount, dev) != hipSuccess) { grid = -1; return; }
        if (hipFuncSetAttribute((const void*)mega, hipFuncAttributeMaxDynamicSharedMemorySize, LDS_BYTES) != hipSuccess) { fprintf(stderr, "kernel_launch: hipFuncSetAttribute failed\n"); grid = -1; return; }
        if (hipOccupancyMaxActiveBlocksPerMultiprocessor(&per_cu, (const void*)mega, NTHREADS, LDS_BYTES) != hipSuccess || per_cu < 1) { fprintf(stderr, "kernel_launch: occupancy query says %d\n", per_cu); }
        (void)hipGetLastError();
        grid = cus;
    }
    if (grid < 0) return;
    (void)hipMemsetAsync((char*)d_ws + WS_CTL, 0, CTL_ZERO_BYTES, stream);
    (void)hipMemsetAsync((char*)d_ws + WS_MIXSQ, 0, MIXSQ_BYTES, stream);
    Args a{};
    for (int i = 0; i < 23; ++i) a.in[i] = (const float*)d_in[i];
    a.out = (float*)d_out; a.ws = (unsigned char*)d_ws;
#if MK_MULTI_LAUNCH
    for (int p = 0; p < N_PHASES; ++p) { a.ph_lo = p; a.ph_hi = p + 1; a.use_bar = 0; a.pad = 0; hipLaunchKernelGGL(mega, dim3(grid), dim3(NTHREADS), LDS_BYTES, stream, a); }
#else
    a.ph_lo = 0; a.ph_hi = N_PHASES; a.use_bar = 1; a.pad = 0;
    hipLaunchKernelGGL(mega, dim3(grid), dim3(NTHREADS), LDS_BYTES, stream, a);
#endif
    const hipError_t le = hipPeekAtLastError();
    if (le != hipSuccess) fprintf(stderr, "kernel_launch: launch failed: %s\n", hipGetErrorName(le));
}
```

```cpp
#include <hip/hip_runtime.h>
#include <cstdio>
#include <cstdint>
#include <cmath>
__device__ __forceinline__ float shx(float v, int k, int lane);
typedef unsigned long long u64_t;
__device__ __forceinline__ float rowsq_rs(const u64_t* rowsq, int row) { return 1.0f / sqrtf((float)*(const __attribute__((address_space(1))) u64_t*)(rowsq + row) * (5.9604644775390625e-08f / 2048.0f) + 1e-6f); }
__device__ __forceinline__ u64_t rowsq_fx(float ss) { return (u64_t)(ss * 16777216.0f + 0.5f); }
template <int HI = 255>
__device__ __forceinline__ unsigned q8x4c(float a, float b, float c, float d, float inv) {
    unsigned w = 0;
    w = __builtin_amdgcn_cvt_pk_u8_f32(__builtin_rintf(__builtin_amdgcn_fmed3f(__builtin_fmaf(a, inv, 128.f), 1.f, (float)HI)), 0, w); w = __builtin_amdgcn_cvt_pk_u8_f32(__builtin_rintf(__builtin_amdgcn_fmed3f(__builtin_fmaf(b, inv, 128.f), 1.f, (float)HI)), 1, w);
    w = __builtin_amdgcn_cvt_pk_u8_f32(__builtin_rintf(__builtin_amdgcn_fmed3f(__builtin_fmaf(c, inv, 128.f), 1.f, (float)HI)), 2, w); w = __builtin_amdgcn_cvt_pk_u8_f32(__builtin_rintf(__builtin_amdgcn_fmed3f(__builtin_fmaf(d, inv, 128.f), 1.f, (float)HI)), 3, w);
    return w ^ 0x80808080u;
}
__device__ __forceinline__ unsigned dig_lo4(unsigned d) { return d & 0x0f0f0f0fu; }
__device__ __forceinline__ unsigned dig_hi4(unsigned d) { const unsigned t = ((d & 0x7f7f7f7fu) + 0x08080808u) ^ (d & 0x80808080u); return (t >> 4) & 0x0f0f0f0fu; }
__device__ __forceinline__ unsigned nib_pack8(unsigned a, unsigned b) { a = (a | (a >> 4)) & 0x00ff00ffu; a = (a | (a >> 8)) & 0xffffu; b = (b | (b >> 4)) & 0x00ff00ffu; b = (b | (b >> 8)) & 0xffffu; return a | (b << 16); }
namespace pg8 {
#define PG8_LAS __attribute__((address_space(3)))
#define PG8_GAS __attribute__((address_space(1)))
typedef unsigned short bf16_t;
typedef short bf16x8 __attribute__((ext_vector_type(8)));
typedef float f32x4 __attribute__((ext_vector_type(4)));
typedef unsigned u32x4 __attribute__((ext_vector_type(4)));
constexpr int BM = 256, BK = 64, HALF = 128, HTB = HALF * BK * 2  , STAGE_BYTES = 8 * HTB, NXCD = 8, WGM = 8;

__host__ __device__ __forceinline__ int lds_byte(int r, int c) { const int st = (r >> 4) * 2 + (c >> 5), rr = r & 15, cc = c & 31, ob = rr * 64 + cc * 2; return st * 1024 + (ob ^ (((ob >> 9) & 1) << 5)); }
__host__ __device__ __forceinline__ void stage_rc(int b, int& R, int& C) { const int st = b / 1024, sb = b % 1024, swz = sb ^ (((sb >> 9) & 1) << 5); R = (st >> 1) * 16 + swz / 64; C = (st & 1) * 32 + (swz % 64) / 2; }
__host__ __device__ __forceinline__ int perm32(int rho) { const int n = rho >> 4, i = rho & 15; return 8 * (i >> 2) + 4 * n + (i & 3); }

struct Unit { int pm, pn; };
struct Gemm { const bf16_t* A; const bf16_t* Bt; int M, N, K; };

struct StaticOrder {
    int nM, nN, nwg, G, c;
    __host__ __device__ __forceinline__ void init(int M, int N, int G_, int c_) { nM = M / BM; nN = N / BM; nwg = nM * nN; G = G_; c = c_; }
    __host__ __device__ __forceinline__ bool next(int i, Unit& u) const {
        const long L = (long)i * G + c; if (L >= nwg) return false;
        int wgid = (int)L; { const int q = nwg / NXCD, r = nwg % NXCD, xcd = wgid % NXCD, off = wgid / NXCD; wgid = (xcd < r ? xcd * (q + 1) : r * (q + 1) + (xcd - r) * q) + off; }
        const int nig = WGM * nN, gid = wgid / nig, fm = gid * WGM, gsz = (nM - fm) < WGM ? (nM - fm) : WGM;
        u.pm = fm + ((wgid % nig) % gsz); u.pn = (wgid % nig) / gsz; return true;
    }
    __device__ __forceinline__ void a_ready(const Unit&) const {}
    __device__ __forceinline__ void done(const Unit&) const {}
};

__device__ __forceinline__ unsigned cvt_pk_bf16(float lo, float hi) { unsigned r; asm volatile("v_cvt_pk_bf16_f32 %0, %1, %2" : "=v"(r) : "v"(lo), "v"(hi)); return r; }
typedef float f32x2 __attribute__((ext_vector_type(2)));
__device__ __forceinline__ f32x2 gelu_pk(f32x2 v) {
    const f32x2 av = __builtin_elementwise_abs(v), d = av * 0.2316418882f + 1.0f;
    f32x2 t; t.x = __builtin_amdgcn_rcpf(d.x); t.y = __builtin_amdgcn_rcpf(d.y);
    f32x2 q = t * 0.5307027145f + (-0.7265760135f); q = q * t + 0.7107068705f; q = q * t + (-0.142248368f); q = q * t + 0.127414796f; q = q * t;
    const f32x2 s = (v * v) * (-0.72134752044f);
    f32x2 e; e.x = __builtin_amdgcn_exp2f(s.x); e.y = __builtin_amdgcn_exp2f(s.y);
    const f32x2 m = v * (q * e), r = v - m;
    f32x2 o; o.x = v.x < 0.f ? m.x : r.x; o.y = v.y < 0.f ? m.y : r.y; return o;
}

template <int ACT  > struct EpiBf16 {
    static constexpr bool PERM = true, AFTER_DRAIN = false, KSCALE = false, I8 = false; static_assert(ACT == 0 || ACT == 1, "EpiBf16: ACT is 0 (none) or 1 (gelu_pk)");
    bf16_t* O; int ldc; const float* bias; int split_cols; size_t split_stride; float scale0;
    __device__ __forceinline__ void operator()(const f32x4 (&acc)[2][2][4][2], const Unit& u, int wr, int wc, int fr, int fq) const {
        const int row0 = u.pm * BM + wr * 64 + fr; int colt = u.pn * BM; bf16_t* base = O;
        float sc = 1.f; if (split_cols) { const int t = colt / split_cols; base += (size_t)t * split_stride; colt -= t * split_cols; if (t == 0) sc = scale0; }
        const int col0 = colt + wc * 32 + 8 * fq, bcol0 = u.pn * BM + wc * 32 + 8 * fq;
        f32x4 bv[2][2];
#pragma unroll
        for (int bj = 0; bj < 2; ++bj)
#pragma unroll
            for (int n = 0; n < 2; ++n) bv[bj][n] = bias ? *(const PG8_GAS f32x4*)(bias + bcol0 + bj * HALF + 4 * n) : (f32x4){0.f, 0.f, 0.f, 0.f};
#pragma unroll
        for (int ai = 0; ai < 2; ++ai)
#pragma unroll
            for (int m = 0; m < 4; ++m) { bf16_t* rowp = base + (size_t)(row0 + ai * HALF + m * 16) * ldc + col0;
#pragma unroll
                for (int bj = 0; bj < 2; ++bj) { f32x4 v0 = acc[ai][bj][m][0] + bv[bj][0], v1 = acc[ai][bj][m][1] + bv[bj][1];
                    if (ACT == 1) { f32x2 a = gelu_pk((f32x2){v0[0], v0[1]}), b = gelu_pk((f32x2){v0[2], v0[3]}), c = gelu_pk((f32x2){v1[0], v1[1]}), d = gelu_pk((f32x2){v1[2], v1[3]});
                        v0 = (f32x4){a.x, a.y, b.x, b.y}; v1 = (f32x4){c.x, c.y, d.x, d.y}; }
                    v0 = v0 * sc; v1 = v1 * sc; u32x4 w; w.x = cvt_pk_bf16(v0[0], v0[1]); w.y = cvt_pk_bf16(v0[2], v0[3]); w.z = cvt_pk_bf16(v1[0], v1[1]); w.w = cvt_pk_bf16(v1[2], v1[3]);
                    *(PG8_GAS u32x4*)(rowp + bj * HALF) = w; } }
    }
};

typedef unsigned u32x2 __attribute__((ext_vector_type(2)));
typedef int i32x4 __attribute__((ext_vector_type(4)));
struct EpiResid {
    static constexpr bool PERM = false, AFTER_DRAIN = false, KSCALE = false, I8 = false;
    bf16_t* s; int ldc; u64_t* rowsq;
    __device__ __forceinline__ void operator()(const f32x4 (&acc)[2][2][4][2], const Unit& u, int wr, int wc, int fr, int fq) const {
        const int col0 = u.pn * BM + wc * 32 + 4 * fq;
#pragma unroll
        for (int ai = 0; ai < 2; ++ai)
#pragma unroll
            for (int m = 0; m < 4; ++m) { const int row = u.pm * BM + ai * HALF + wr * 64 + m * 16 + fr; bf16_t* sp = s + (size_t)row * ldc + col0; float ss = 0.f;
                u32x2 in[2][2];
#pragma unroll
                for (int bj = 0; bj < 2; ++bj)
#pragma unroll
                    for (int n = 0; n < 2; ++n) in[bj][n] = *(const PG8_GAS u32x2*)(sp + bj * HALF + n * 16);
#pragma unroll
                for (int bj = 0; bj < 2; ++bj)
#pragma unroll
                    for (int n = 0; n < 2; ++n) { const u32x2 w0 = in[bj][n];
                        const f32x4 bs = (f32x4){__builtin_bit_cast(float, w0.x << 16), __builtin_bit_cast(float, w0.x & 0xffff0000u), __builtin_bit_cast(float, w0.y << 16), __builtin_bit_cast(float, w0.y & 0xffff0000u)};
                        const f32x4 o = bs + acc[ai][bj][m][n]; ss += (o[0] * o[0] + o[1] * o[1]) + (o[2] * o[2] + o[3] * o[3]);
                        u32x2 w; w.x = cvt_pk_bf16(o[0], o[1]); w.y = cvt_pk_bf16(o[2], o[3]); *(PG8_GAS u32x2*)(sp + bj * HALF + n * 16) = w; }
                ss += shx(ss, 16, fr + 16 * fq); ss += shx(ss, 32, fr + 16 * fq);
                if (fq == 0) (void)__hip_atomic_fetch_add((PG8_GAS u64_t*)(rowsq + row), rowsq_fx(ss), __ATOMIC_RELAXED, __HIP_MEMORY_SCOPE_AGENT); }
    }
};
struct EpiResid8 {
    static constexpr bool PERM = false, AFTER_DRAIN = false, KSCALE = false, I8 = true;
    bf16_t* s; int ldc; u64_t* rowsq; const float* xsc; const float* wsc;
    __device__ __forceinline__ void operator()(const f32x4 (&acc)[2][2][4][2], const Unit& u, int wr, int wc, int fr, int fq) const {
        const int col0 = u.pn * BM + wc * 32 + 4 * fq;
#pragma unroll
        for (int ai = 0; ai < 2; ++ai)
#pragma unroll
            for (int m = 0; m < 4; ++m) { const int row = u.pm * BM + ai * HALF + wr * 64 + m * 16 + fr; bf16_t* sp = s + (size_t)row * ldc + col0; float ss = 0.f; const float xs = *(const PG8_GAS float*)(xsc + row);
                u32x2 in[2][2];
#pragma unroll
                for (int bj = 0; bj < 2; ++bj)
#pragma unroll
                    for (int n = 0; n < 2; ++n) in[bj][n] = *(const PG8_GAS u32x2*)(sp + bj * HALF + n * 16);
#pragma unroll
                for (int bj = 0; bj < 2; ++bj)
#pragma unroll
                    for (int n = 0; n < 2; ++n) { const u32x2 w0 = in[bj][n]; const i32x4 ia = __builtin_bit_cast(i32x4, acc[ai][bj][m][n]);
                        const f32x4 bs = (f32x4){__builtin_bit_cast(float, w0.x << 16), __builtin_bit_cast(float, w0.x & 0xffff0000u), __builtin_bit_cast(float, w0.y << 16), __builtin_bit_cast(float, w0.y & 0xffff0000u)};
                        const f32x4 o = bs + (f32x4){(float)ia[0], (float)ia[1], (float)ia[2], (float)ia[3]} * *(const PG8_GAS f32x4*)(wsc + col0 + bj * HALF + n * 16) * xs; ss += (o[0] * o[0] + o[1] * o[1]) + (o[2] * o[2] + o[3] * o[3]);
                        u32x2 w; w.x = cvt_pk_bf16(o[0], o[1]); w.y = cvt_pk_bf16(o[2], o[3]); *(PG8_GAS u32x2*)(sp + bj * HALF + n * 16) = w; }
                ss += shx(ss, 16, fr + 16 * fq); ss += shx(ss, 32, fr + 16 * fq);
                if (fq == 0) (void)__hip_atomic_fetch_add((PG8_GAS u64_t*)(rowsq + row), rowsq_fx(ss), __ATOMIC_RELAXED, __HIP_MEMORY_SCOPE_AGENT); }
    }
};
template <bool I8IN, int QOUT, bool DIG = false>
struct EpiResidT {
    static constexpr bool PERM = true, AFTER_DRAIN = false, KSCALE = false, I8 = I8IN;
    bf16_t* s; int ldc; u64_t* rowsq; const float* xsc; const float* wsc; unsigned char* q8; const u64_t* rowsq_prev; unsigned char* dgh; unsigned char* dgl;
    __device__ __forceinline__ void operator()(const f32x4 (&acc)[2][2][4][2], const Unit& u, int wr, int wc, int fr, int fq) const {
        const int col0 = u.pn * BM + wc * 32 + 8 * fq, rowb = u.pm * BM + wr * 64 + fr;
        f32x4 wv[2][2];
        if constexpr (I8IN) {
#pragma unroll
            for (int bj = 0; bj < 2; ++bj) { wv[bj][0] = *(const PG8_GAS f32x4*)(wsc + col0 + bj * HALF); wv[bj][1] = *(const PG8_GAS f32x4*)(wsc + col0 + bj * HALF + 4); } }
#pragma unroll
        for (int ai = 0; ai < 2; ++ai) {
            u32x4 in[4][2]; float xs[4], qv[4];
#pragma unroll
            for (int m = 0; m < 4; ++m) { const int row = rowb + ai * HALF + m * 16; const bf16_t* sp = s + (size_t)row * ldc + col0;
#pragma unroll
                for (int bj = 0; bj < 2; ++bj) in[m][bj] = *(const PG8_GAS u32x4*)(sp + bj * HALF);
                if constexpr (I8IN) xs[m] = *(const PG8_GAS float*)(xsc + row); else xs[m] = 1.f;
                if constexpr (QOUT > 0) qv[m] = (127.0f / QOUT) * rowsq_rs(rowsq_prev, row); else qv[m] = 0.f; }
            __builtin_amdgcn_sched_barrier(0);
#pragma unroll
            for (int m = 0; m < 4; ++m) { const int row = rowb + ai * HALF + m * 16; bf16_t* sp = s + (size_t)row * ldc + col0; float ss = 0.f;
#pragma unroll
                for (int bj = 0; bj < 2; ++bj) { const u32x4 w0 = in[m][bj]; f32x4 a0 = acc[ai][bj][m][0], a1 = acc[ai][bj][m][1];
                    if constexpr (I8IN) { const i32x4 i0 = __builtin_bit_cast(i32x4, a0), i1 = __builtin_bit_cast(i32x4, a1);
                        a0 = (f32x4){(float)i0[0], (float)i0[1], (float)i0[2], (float)i0[3]} * wv[bj][0] * xs[m];
                        a1 = (f32x4){(float)i1[0], (float)i1[1], (float)i1[2], (float)i1[3]} * wv[bj][1] * xs[m]; }
                    const f32x4 o0 = (f32x4){__builtin_bit_cast(float, w0.x << 16), __builtin_bit_cast(float, w0.x & 0xffff0000u), __builtin_bit_cast(float, w0.y << 16), __builtin_bit_cast(float, w0.y & 0xffff0000u)} + a0;
                    const f32x4 o1 = (f32x4){__builtin_bit_cast(float, w0.z << 16), __builtin_bit_cast(float, w0.z & 0xffff0000u), __builtin_bit_cast(float, w0.w << 16), __builtin_bit_cast(float, w0.w & 0xffff0000u)} + a1;
                    ss += ((o0[0] * o0[0] + o0[1] * o0[1]) + (o0[2] * o0[2] + o0[3] * o0[3])) + ((o1[0] * o1[0] + o1[1] * o1[1]) + (o1[2] * o1[2] + o1[3] * o1[3]));
                    u32x4 w; w.x = cvt_pk_bf16(o0[0], o0[1]); w.y = cvt_pk_bf16(o0[2], o0[3]); w.z = cvt_pk_bf16(o1[0], o1[1]); w.w = cvt_pk_bf16(o1[2], o1[3]); *(PG8_GAS u32x4*)(sp + bj * HALF) = w;
                    if constexpr (QOUT > 0) { u32x2 q; q.x = q8x4c<DIG ? 247 : 255>(o0[0], o0[1], o0[2], o0[3], qv[m]); q.y = q8x4c<DIG ? 247 : 255>(o1[0], o1[1], o1[2], o1[3], qv[m]); *(PG8_GAS u32x2*)(q8 + (size_t)row * ldc + col0 + bj * HALF) = q;
                        if constexpr (DIG) { const size_t db = (size_t)row * 1024 + ((col0 + bj * HALF) >> 1);
                            *(PG8_GAS unsigned*)(dgl + db) = nib_pack8(dig_lo4(q.x), dig_lo4(q.y)); *(PG8_GAS unsigned*)(dgh + db) = nib_pack8(dig_hi4(q.x), dig_hi4(q.y)); } } }
                ss += shx(ss, 16, fr + 16 * fq); ss += shx(ss, 32, fr + 16 * fq);
                if (fq == 0) (void)__hip_atomic_fetch_add((PG8_GAS u64_t*)(rowsq + row), rowsq_fx(ss), __ATOMIC_RELAXED, __HIP_MEMORY_SCOPE_AGENT); }
            __builtin_amdgcn_sched_barrier(0);
        }
    }
};
template <int QIN>
struct EpiBf16Row8 {
    static constexpr bool PERM = true, AFTER_DRAIN = false, KSCALE = false, I8 = true;
    bf16_t* O; int ldc; const u64_t* rowsq; const u64_t* rowsq_prev; const float* wsc;
    __device__ __forceinline__ void operator()(const f32x4 (&acc)[2][2][4][2], const Unit& u, int wr, int wc, int fr, int fq) const {
        const int row0 = u.pm * BM + wr * 64 + fr, col0 = u.pn * BM + wc * 32 + 8 * fq;
        float rs[2][4]; f32x4 wv[2][2];
#pragma unroll
        for (int ai = 0; ai < 2; ++ai)
#pragma unroll
            for (int m = 0; m < 4; ++m) { const int row = row0 + ai * HALF + m * 16; rs[ai][m] = rowsq_rs(rowsq, row) * (QIN / 127.0f) / rowsq_rs(rowsq_prev, row); }
#pragma unroll
        for (int bj = 0; bj < 2; ++bj) { wv[bj][0] = *(const PG8_GAS f32x4*)(wsc + col0 + bj * HALF); wv[bj][1] = *(const PG8_GAS f32x4*)(wsc + col0 + bj * HALF + 4); }
        __builtin_amdgcn_sched_barrier(0);
#pragma unroll
        for (int ai = 0; ai < 2; ++ai)
#pragma unroll
            for (int m = 0; m < 4; ++m) { const int row = row0 + ai * HALF + m * 16; bf16_t* rowp = O + (size_t)row * ldc + col0;
#pragma unroll
                for (int bj = 0; bj < 2; ++bj) { const i32x4 i0 = __builtin_bit_cast(i32x4, acc[ai][bj][m][0]), i1 = __builtin_bit_cast(i32x4, acc[ai][bj][m][1]);
                    const f32x4 v0 = (f32x4){(float)i0[0], (float)i0[1], (float)i0[2], (float)i0[3]} * wv[bj][0] * rs[ai][m], v1 = (f32x4){(float)i1[0], (float)i1[1], (float)i1[2], (float)i1[3]} * wv[bj][1] * rs[ai][m];
                    u32x4 w; w.x = cvt_pk_bf16(v0[0], v0[1]); w.y = cvt_pk_bf16(v0[2], v0[3]); w.z = cvt_pk_bf16(v1[0], v1[1]); w.w = cvt_pk_bf16(v1[2], v1[3]);
                    *(PG8_GAS u32x4*)(rowp + bj * HALF) = w; } }
    }
};
struct EpiResidMix {
    static constexpr bool PERM = false, AFTER_DRAIN = false, KSCALE = true, I8 = false; static constexpr int KS0 = 12, KS1 = 20;
    bf16_t* s; int ldc; u64_t* rowsq; const PG8_LAS float* ftab; const PG8_LAS int* pmtab;
    __device__ __forceinline__ int slot(int pm) const { return pmtab[0] == pm ? 0 : (pmtab[1] == pm ? 1 : (pmtab[2] == pm ? 2 : 3)); }
    __device__ __forceinline__ void kscale(f32x4 (&acc)[2][2][4][2], const Unit& u, int which, int wr, int fr) const {
        const PG8_LAS float* ft = ftab + which * 1024 + slot(u.pm) * 256;
#pragma unroll
        for (int ai = 0; ai < 2; ++ai)
#pragma unroll
            for (int m = 0; m < 4; ++m) { const float f = ft[ai * HALF + wr * 64 + m * 16 + fr];
#pragma unroll
                for (int bj = 0; bj < 2; ++bj)
#pragma unroll
                    for (int n = 0; n < 2; ++n) acc[ai][bj][m][n] = acc[ai][bj][m][n] * f; }
    }
    __device__ __forceinline__ void operator()(const f32x4 (&acc)[2][2][4][2], const Unit& u, int wr, int wc, int fr, int fq) const {
        const int col0 = u.pn * BM + wc * 32 + 4 * fq;
#pragma unroll
        for (int ai = 0; ai < 2; ++ai)
#pragma unroll
            for (int m = 0; m < 4; ++m) { const int row = u.pm * BM + ai * HALF + wr * 64 + m * 16 + fr; bf16_t* sp = s + (size_t)row * ldc + col0; float ss = 0.f; const float rc = ftab[2048 + slot(u.pm) * 256 + ai * HALF + wr * 64 + m * 16 + fr];
                u32x2 in[2][2];
#pragma unroll
                for (int bj = 0; bj < 2; ++bj)
#pragma unroll
                    for (int n = 0; n < 2; ++n) in[bj][n] = *(const PG8_GAS u32x2*)(sp + bj * HALF + n * 16);
#pragma unroll
                for (int bj = 0; bj < 2; ++bj)
#pragma unroll
                    for (int n = 0; n < 2; ++n) { const u32x2 w0 = in[bj][n];
                        const f32x4 bs = (f32x4){__builtin_bit_cast(float, w0.x << 16), __builtin_bit_cast(float, w0.x & 0xffff0000u), __builtin_bit_cast(float, w0.y << 16), __builtin_bit_cast(float, w0.y & 0xffff0000u)};
                        const f32x4 o = bs + acc[ai][bj][m][n] * rc; ss += (o[0] * o[0] + o[1] * o[1]) + (o[2] * o[2] + o[3] * o[3]);
                        u32x2 w; w.x = cvt_pk_bf16(o[0], o[1]); w.y = cvt_pk_bf16(o[2], o[3]); *(PG8_GAS u32x2*)(sp + bj * HALF + n * 16) = w; }
                ss += shx(ss, 16, fr + 16 * fq); ss += shx(ss, 32, fr + 16 * fq);
                if (fq == 0) (void)__hip_atomic_fetch_add((PG8_GAS u64_t*)(rowsq + row), rowsq_fx(ss), __ATOMIC_RELAXED, __HIP_MEMORY_SCOPE_AGENT); }
    }
};
struct EpiBf16Row {
    static constexpr bool PERM = true, AFTER_DRAIN = false, KSCALE = false, I8 = false;
    bf16_t* O; int ldc; const u64_t* rowsq;
    __device__ __forceinline__ void operator()(const f32x4 (&acc)[2][2][4][2], const Unit& u, int wr, int wc, int fr, int fq) const {
        const int row0 = u.pm * BM + wr * 64 + fr, col0 = u.pn * BM + wc * 32 + 8 * fq;
#pragma unroll
        for (int ai = 0; ai < 2; ++ai)
#pragma unroll
            for (int m = 0; m < 4; ++m) { const int row = row0 + ai * HALF + m * 16; const float rs = rowsq_rs(rowsq, row); bf16_t* rowp = O + (size_t)row * ldc + col0;
#pragma unroll
                for (int bj = 0; bj < 2; ++bj) { const f32x4 v0 = acc[ai][bj][m][0] * rs, v1 = acc[ai][bj][m][1] * rs; u32x4 w; w.x = cvt_pk_bf16(v0[0], v0[1]); w.y = cvt_pk_bf16(v0[2], v0[3]); w.z = cvt_pk_bf16(v1[0], v1[1]); w.w = cvt_pk_bf16(v1[2], v1[3]);
                    *(PG8_GAS u32x4*)(rowp + bj * HALF) = w; } }
    }
};
struct EpiQKV {
    static constexpr bool PERM = false, AFTER_DRAIN = false, KSCALE = false, I8 = true;
    bf16_t* O; const float* ga; const float* gb; const float* gc; const PG8_LAS float* rope; const u64_t* rowsq; const float* xsc; const float* wsc;
    __device__ __forceinline__ void operator()(const f32x4 (&acc)[2][2][4][2], const Unit& u, int wr, int wc, int fr, int fq) const {
        const int hg = u.pn * 4 + wc;
        const float* g = nullptr; bool isq = false, dorope = false;
        if (hg < 12) { g = ga; isq = true; } else if (hg < 16) { g = ga + 64; } else if (hg < 20) { }
        else if (hg < 28) { g = gb; isq = true; } else if (hg < 36) { g = gb + 64; } else if (hg < 44) { }
        else if (hg < 56) { g = gc; isq = true; dorope = true; } else if (hg < 60) { g = gc + 64; dorope = true; }
        const float qs = isq ? 0.18033688011112042f : 1.0f;
        float rsxa[2][4]; f32x4 wv[2][2], gv[2][2];
#pragma unroll
        for (int ai = 0; ai < 2; ++ai)
#pragma unroll
            for (int m = 0; m < 4; ++m) { const int row = u.pm * BM + ai * HALF + wr * 64 + m * 16 + fr; rsxa[ai][m] = *(const PG8_GAS float*)(xsc + row); }
#pragma unroll
        for (int bj = 0; bj < 2; ++bj)
#pragma unroll
            for (int n = 0; n < 2; ++n) { wv[bj][n] = *(const PG8_GAS f32x4*)(wsc + hg * 64 + 32 * bj + 16 * n + 4 * fq); gv[bj][n] = g ? *(const PG8_GAS f32x4*)(g + 32 * bj + 16 * n + 4 * fq) : (f32x4){1.f, 1.f, 1.f, 1.f}; }
        __builtin_amdgcn_sched_barrier(0);
#pragma unroll
        for (int ai = 0; ai < 2; ++ai)
#pragma unroll
            for (int m = 0; m < 4; ++m) {
                const int row = u.pm * BM + ai * HALF + wr * 64 + m * 16 + fr;
                f32x4 v[2][2];
                const float rsx = rsxa[ai][m];
#pragma unroll
                for (int bj = 0; bj < 2; ++bj)
#pragma unroll
                    for (int n = 0; n < 2; ++n) { const i32x4 ia = __builtin_bit_cast(i32x4, acc[ai][bj][m][n]);
                        v[bj][n] = (f32x4){(float)ia[0], (float)ia[1], (float)ia[2], (float)ia[3]} * wv[bj][n] * rsx; }
                if (g) {
                    float ss = 0.f;
#pragma unroll
                    for (int bj = 0; bj < 2; ++bj)
#pragma unroll
                        for (int n = 0; n < 2; ++n) { const f32x4 x = v[bj][n]; ss += (x[0] * x[0] + x[1] * x[1]) + (x[2] * x[2] + x[3] * x[3]); }
                    ss += shx(ss, 16, fr + 16 * fq); ss += shx(ss, 32, fr + 16 * fq);
                    const float r = qs / sqrtf(ss * (1.0f / 64.0f) + 1e-6f);
#pragma unroll
                    for (int bj = 0; bj < 2; ++bj)
#pragma unroll
                        for (int n = 0; n < 2; ++n) v[bj][n] = v[bj][n] * gv[bj][n] * r;
                }
                if (dorope) {
                    const int t = row & 2047, pr = t >> 6, pc = t & 63;
#pragma unroll
                    for (int bj = 0; bj < 2; ++bj) {
                        const int pos = bj ? pc : pr;
                        const PG8_LAS float* rp = rope + (pos * 16 + 4 * fq) * 2;
                        const f32x4 c01 = *(const PG8_LAS f32x4*)rp, c23 = *(const PG8_LAS f32x4*)(rp + 4);
                        const f32x4 cs = (f32x4){c01[0], c01[2], c23[0], c23[2]}, sn = (f32x4){c01[1], c01[3], c23[1], c23[3]};
                        const f32x4 x1 = v[bj][0], x2 = v[bj][1];
                        v[bj][0] = x1 * cs - x2 * sn; v[bj][1] = x1 * sn + x2 * cs;
                    }
                }
                bf16_t* rowp = O + (size_t)row * 4096 + hg * 64 + 4 * fq;
#pragma unroll
                for (int bj = 0; bj < 2; ++bj)
#pragma unroll
                    for (int n = 0; n < 2; ++n) { u32x2 w; w.x = cvt_pk_bf16(v[bj][n][0], v[bj][n][1]); w.y = cvt_pk_bf16(v[bj][n][2], v[bj][n][3]); *(PG8_GAS u32x2*)(rowp + 32 * bj + 16 * n) = w; }
                asm volatile("" ::: "memory");
            }
    }
};
template <bool I8> __device__ __forceinline__ f32x4 mma16(const bf16x8 b, const bf16x8 a, const f32x4 c) {
    if constexpr (I8) return __builtin_bit_cast(f32x4, __builtin_amdgcn_mfma_i32_16x16x64_i8(__builtin_bit_cast(i32x4, b), __builtin_bit_cast(i32x4, a), __builtin_bit_cast(i32x4, c), 0, 0, 0));
    else return __builtin_amdgcn_mfma_f32_16x16x32_bf16(b, a, c, 0, 0, 0);
}
template <class Epi, class Sched, bool ALIGN_EPI = false, bool SP2 = false>
__device__ __forceinline__ void gemm_phase(PG8_LAS unsigned char* lds, const Gemm g, const Sched& S, const Epi& E, const int tid) {
    const int wid = __builtin_amdgcn_readfirstlane(tid >> 6), lane = tid & 63, wr = wid >> 2, wc = wid & 3, fr = lane & 15, fq = lane >> 4;
    const int K = g.K, nt = K / BK;
    unsigned voffA[2], voffB[2];
#pragma unroll
    for (int i = 0; i < 2; ++i) { int R, C; stage_rc(tid * 16 + i * 8192, R, C); const int Rb = Epi::PERM ? ((R & ~31) + perm32(R & 31)) : R;
        voffA[i] = (unsigned)(R * K + C) * 2u; voffB[i] = (unsigned)(Rb * K + C) * 2u; }
    const size_t kstep = (size_t)(BK * 2);
    const size_t hstep = (size_t)HALF * K * 2;
    const size_t tstep = 2 * hstep;
    const unsigned ldsw = (unsigned)wid * 1024u;
    const int aoff = lds_byte(wr * 64 + fr, fq * 8), boff = lds_byte(wc * 32 + fr, fq * 8);
#define PG8_SA(b, h) (((b) * 2 + (h)) * HTB)
#define PG8_SB(b, h) ((4 + (b) * 2 + (h)) * HTB)
#define PG8_STAGE(bufoff, gbase, voff) do { _Pragma("unroll") for (int _i = 0; _i < 2; ++_i) \
        __builtin_amdgcn_global_load_lds((const unsigned*)((const char*)(gbase) + (voff)[_i]), (PG8_LAS unsigned*)(lds + (bufoff) + ldsw + _i * 8192), 16, 0, 0); } while (0)
#define PG8_LDA(dst, b, h) do { _Pragma("unroll") for (int m = 0; m < 4; ++m) _Pragma("unroll") for (int k = 0; k < 2; ++k) dst[m][k] = *(const PG8_LAS bf16x8*)(lds + PG8_SA(b, h) + aoff + m * 2048 + k * 1024); } while (0)
#define PG8_LDB(dst, b, h) do { _Pragma("unroll") for (int n = 0; n < 2; ++n) _Pragma("unroll") for (int k = 0; k < 2; ++k) dst[n][k] = *(const PG8_LAS bf16x8*)(lds + PG8_SB(b, h) + boff + n * 2048 + k * 1024); } while (0)
#define PG8_MMA(ai, bj, At, Bt) do { __builtin_amdgcn_s_setprio(1); _Pragma("unroll") for (int m = 0; m < 4; ++m) _Pragma("unroll") for (int n = 0; n < 2; ++n) _Pragma("unroll") for (int k = 0; k < 2; ++k) \
        acc[ai][bj][m][n] = mma16<Epi::I8>(Bt[n][k], At[m][k], acc[ai][bj][m][n]); __builtin_amdgcn_s_setprio(0); } while (0)
#define PG8_WAIT_V(n) asm volatile("s_waitcnt vmcnt(" #n ")" ::: "memory")
#define PG8_WAIT_L(n) asm volatile("s_waitcnt lgkmcnt(" #n ")" ::: "memory")
#define PG8_BAR __builtin_amdgcn_s_barrier()
#define PG8_SCHED __builtin_amdgcn_sched_barrier(0)
    Unit cur, nxt; int ui = 0;
    if (!S.next(0, cur)) return;
    f32x4 acc[2][2][4][2];
#pragma unroll
    for (int a = 0; a < 2; ++a)
#pragma unroll
        for (int b = 0; b < 2; ++b)
#pragma unroll
            for (int m = 0; m < 4; ++m)
#pragma unroll
                for (int n = 0; n < 2; ++n) acc[a][b][m][n] = (f32x4){0.f, 0.f, 0.f, 0.f};
    bf16x8 At[4][2], B0[2][2], B1[2][2];
    const char* cA = (const char*)g.A + (size_t)cur.pm * tstep; const char* cB = (const char*)g.Bt + (size_t)cur.pn * tstep;
    S.a_ready(cur);
    if constexpr (SP2) {
        PG8_STAGE(PG8_SB(0, 0), cB, voffB); PG8_STAGE(PG8_SB(0, 1), cB + hstep, voffB); PG8_STAGE(PG8_SA(0, 0), cA, voffA); PG8_STAGE(PG8_SA(0, 1), cA + hstep, voffA);
        if (wr == 1) PG8_BAR;
        PG8_WAIT_V(2); PG8_BAR;
        PG8_STAGE(PG8_SB(1, 0), cB + kstep, voffB); PG8_STAGE(PG8_SA(1, 0), cA + kstep, voffA); PG8_STAGE(PG8_SB(1, 1), cB + hstep + kstep, voffB);
        PG8_WAIT_V(6); PG8_BAR;
    } else {
        PG8_STAGE(PG8_SB(0, 0), cB, voffB); PG8_STAGE(PG8_SA(0, 0), cA, voffA); PG8_STAGE(PG8_SB(0, 1), cB + hstep, voffB); PG8_STAGE(PG8_SA(0, 1), cA + hstep, voffA);
        if (wr == 1) PG8_BAR;
        PG8_WAIT_V(4); PG8_BAR;
        PG8_STAGE(PG8_SB(1, 0), cB + kstep, voffB); PG8_STAGE(PG8_SA(1, 0), cA + kstep, voffA); PG8_STAGE(PG8_SB(1, 1), cB + hstep + kstep, voffB);
        PG8_WAIT_V(6); PG8_BAR;
    }
    for (;;) {
        const bool has_next = S.next(ui + 1, nxt);
        const char* nA = has_next ? (const char*)g.A + (size_t)nxt.pm * tstep : cA; const char* nB = has_next ? (const char*)g.Bt + (size_t)nxt.pn * tstep : cB;
        for (int t = 0; t < nt; t += 2) {
            if constexpr (Epi::KSCALE) { if (t == Epi::KS0 || t == Epi::KS1) E.kscale(acc, cur, t == Epi::KS1 ? 1 : 0, wr, fr); }
            const bool last = (t == nt - 2);
            const char* a1 = cA + (size_t)(t + 1) * kstep;
            const char* a2 = last ? nA : cA + (size_t)(t + 2) * kstep; const char* b2 = last ? nB : cB + (size_t)(t + 2) * kstep;
            const char* a3 = a2 + kstep; const char* b3 = b2 + kstep;
            if (last && has_next) S.a_ready(nxt);
            if constexpr (SP2) {
            PG8_LDB(B0, 0, 0); PG8_LDB(B1, 0, 1); PG8_SCHED; PG8_LDA(At, 0, 0); PG8_STAGE(PG8_SA(1, 1), a1 + hstep, voffA);
            PG8_WAIT_V(8); PG8_WAIT_L(0); PG8_BAR; PG8_MMA(0, 0, At, B0); PG8_MMA(0, 1, At, B1); PG8_BAR; PG8_SCHED;
            PG8_LDA(At, 0, 1); PG8_STAGE(PG8_SB(0, 0), b2, voffB); PG8_STAGE(PG8_SB(0, 1), b2 + hstep, voffB); PG8_STAGE(PG8_SA(0, 0), a2, voffA);
            PG8_WAIT_V(8); PG8_WAIT_L(0); PG8_BAR; PG8_MMA(1, 0, At, B0); PG8_MMA(1, 1, At, B1); PG8_BAR; PG8_SCHED;
            PG8_LDB(B0, 1, 0); PG8_LDB(B1, 1, 1); PG8_SCHED; PG8_LDA(At, 1, 0); PG8_STAGE(PG8_SA(0, 1), a2 + hstep, voffA);
            PG8_WAIT_V(8); PG8_WAIT_L(0); PG8_BAR; PG8_MMA(0, 0, At, B0); PG8_MMA(0, 1, At, B1); PG8_BAR; PG8_SCHED;
            PG8_LDA(At, 1, 1); PG8_STAGE(PG8_SB(1, 0), b3, voffB); PG8_STAGE(PG8_SB(1, 1), b3 + hstep, voffB); PG8_STAGE(PG8_SA(1, 0), a3, voffA);
            PG8_WAIT_V(8); PG8_WAIT_L(0); PG8_BAR; PG8_MMA(1, 0, At, B0); PG8_MMA(1, 1, At, B1); PG8_BAR; PG8_SCHED;
            } else {
            PG8_LDB(B0, 0, 0); PG8_SCHED; PG8_LDA(At, 0, 0); PG8_STAGE(PG8_SA(1, 1), a1 + hstep, voffA);
            PG8_WAIT_L(8); PG8_BAR; PG8_WAIT_L(0); PG8_MMA(0, 0, At, B0); PG8_BAR; PG8_SCHED;
            PG8_LDB(B1, 0, 1); PG8_STAGE(PG8_SB(0, 0), b2, voffB);
            PG8_BAR; PG8_WAIT_L(0); PG8_MMA(0, 1, At, B1); PG8_BAR;
            PG8_LDA(At, 0, 1); PG8_STAGE(PG8_SA(0, 0), a2, voffA);
            PG8_BAR; PG8_WAIT_L(0); PG8_MMA(1, 0, At, B0); PG8_BAR; PG8_SCHED;
            PG8_STAGE(PG8_SB(0, 1), b2 + hstep, voffB);
            PG8_WAIT_V(6); PG8_BAR; PG8_MMA(1, 1, At, B1); PG8_BAR;
            PG8_LDB(B0, 1, 0); PG8_SCHED; PG8_LDA(At, 1, 0); PG8_STAGE(PG8_SA(0, 1), a2 + hstep, voffA);
            PG8_WAIT_L(8); PG8_BAR; PG8_WAIT_L(0); PG8_MMA(0, 0, At, B0); PG8_BAR; PG8_SCHED;
            PG8_LDB(B1, 1, 1); PG8_STAGE(PG8_SB(1, 0), b3, voffB);
            PG8_BAR; PG8_WAIT_L(0); PG8_MMA(0, 1, At, B1); PG8_BAR;
            PG8_LDA(At, 1, 1); PG8_STAGE(PG8_SA(1, 0), a3, voffA);
            PG8_BAR; PG8_WAIT_L(0); PG8_MMA(1, 0, At, B0); PG8_BAR; PG8_SCHED;
            PG8_STAGE(PG8_SB(1, 1), b3 + hstep, voffB);
            PG8_WAIT_V(6); PG8_BAR; PG8_MMA(1, 1, At, B1); PG8_BAR;
            }
        }
        if constexpr (ALIGN_EPI) { if (wr == 0) PG8_BAR; }
        if constexpr (!Epi::AFTER_DRAIN) { E(acc, cur, wr, wc, fr, fq); S.done(cur); }
        if (!has_next) break;
#pragma unroll
        for (int a = 0; a < 2; ++a)
#pragma unroll
            for (int b = 0; b < 2; ++b)
#pragma unroll
                for (int m = 0; m < 4; ++m)
#pragma unroll
                    for (int n = 0; n < 2; ++n) acc[a][b][m][n] = (f32x4){0.f, 0.f, 0.f, 0.f};
        cur = nxt; cA = nA; cB = nB; ++ui;
        if constexpr (ALIGN_EPI) { if (wr == 1) PG8_BAR; }
    }
    PG8_WAIT_V(0);
    if constexpr (!ALIGN_EPI) { if (wr == 0) PG8_BAR; }
    PG8_BAR;
    if constexpr (Epi::AFTER_DRAIN) { E.fused(acc, cur, wr, wc, fr, fq, lds, wid, lane); S.done(cur); }
#undef PG8_SA
#undef PG8_SB
#undef PG8_STAGE
#undef PG8_LDA
#undef PG8_LDB
#undef PG8_MMA
#undef PG8_WAIT_V
#undef PG8_WAIT_L
#undef PG8_BAR
#undef PG8_SCHED
}
}

constexpr int BATCH = 16, SEQ = 2048, DM = 2048, T = BATCH * SEQ, DEPTH = 2;
constexpr int NMEM = 256, DIN = 4096, MEMW = 512;
constexpr int PEER_H = 8, PEER_N = 16384;
constexpr int NWAVES = 8, NTHREADS = NWAVES * 64;
constexpr float EPS = 1e-6f;
constexpr int QA = 0, KA = 768, VA = 1024, QB = 1280, KB = 1792, VB = 2304, QC = 2816, KC = 3584, VC = 3840;
constexpr int OA = 0, OB = 768, OC = 1280;

constexpr size_t MiB = 1u << 20;
constexpr size_t WS_CTL = 0, CTL_ZERO_BYTES = 2 * MiB;
constexpr size_t WS_ROWSQ = 256 * 1024;
constexpr size_t WS_ROPE = 83 * MiB, WS_BIASA = 83 * MiB + 16384;
constexpr size_t WS_WIN = 2 * MiB, WS_WOUT = 34 * MiB, WS_WMQ = 50 * MiB, WS_WMKV = 54 * MiB, WS_WMO = 62 * MiB, WS_WPQ = 66 * MiB, WS_PKEYS = 82 * MiB;
constexpr size_t WS_MEMN = 84 * MiB, WS_KVM = 116 * MiB, WS_PU = 132 * MiB, WS_PV = 260 * MiB, WS_XN = 388 * MiB, WS_QKV = 516 * MiB, WS_ATT = 772 * MiB;
constexpr size_t WS_QM = 900 * MiB, WS_OM = 932 * MiB, WS_MIXSQ = 964 * MiB, MIXSQ_BYTES = 2 * MiB, WS_WIN8 = 966 * MiB, WS_WSC = 982 * MiB, WS_XSC = 982 * MiB + 65536, WS_XSC2 = 982 * MiB + 196608, WS_WSCO = 982 * MiB + 327680, WS_WSCP = 982 * MiB + 344064, WS_WSCM = 982 * MiB + 360448,
                 WS_WOUT8 = 984 * MiB, WS_WPQ8 = 992 * MiB, WS_WMQ8 = 1000 * MiB, WS_END = 1002 * MiB;
constexpr size_t WS_QP = WS_QKV, WS_PIDX = WS_QKV + 128 * MiB, WS_PGATE = WS_QKV + 144 * MiB, WS_PARTI = WS_QKV + 160 * MiB;
constexpr size_t WS_XQH = 836 * MiB, WS_XQL = 868 * MiB;
constexpr size_t WS_XQH_OLD = 900 * MiB, WS_XQL_OLD = 932 * MiB;
constexpr size_t WS_ATT8 = 900 * MiB;
constexpr size_t WS_X8 = 772 * MiB;
constexpr size_t WS_XN8 = 836 * MiB;
constexpr int CW_BAR = 4096;

constexpr int RING_OFF = 0, RING_BYTES = 131072;
constexpr int LDSCTL_OFF = RING_BYTES, MISC_OFF = LDSCTL_OFF + 320;
constexpr int LDS_BYTES = 147456;

#define GAS __attribute__((address_space(1)))
#define LAS __attribute__((address_space(3)))
typedef unsigned short bf16;
typedef unsigned v4u __attribute__((ext_vector_type(4)));
typedef unsigned v2u __attribute__((ext_vector_type(2)));
typedef float f32x4 __attribute__((ext_vector_type(4)));
typedef float f32x16 __attribute__((ext_vector_type(16)));
typedef short bf16x8 __attribute__((ext_vector_type(8)));
typedef GAS unsigned gu32;
#define LDS_WAIT() asm volatile("s_waitcnt lgkmcnt(0)" ::: "memory")
#define VM_WAIT() asm volatile("s_waitcnt vmcnt(0)" ::: "memory")
__device__ __forceinline__ unsigned f2bf(float f) { unsigned u = __builtin_bit_cast(unsigned, f); return (u + 0x7fffu + ((u >> 16) & 1u)) >> 16; }
__device__ __forceinline__ unsigned pk2(float lo, float hi) { return f2bf(lo) | (f2bf(hi) << 16); }
__device__ __forceinline__ float bflo(unsigned w) { return __builtin_bit_cast(float, w << 16); }
__device__ __forceinline__ float bfhi(unsigned w) { return __builtin_bit_cast(float, w & 0xffff0000u); }

__device__ __forceinline__ float shx(float v, int k, int lane) { return __builtin_bit_cast(float, __builtin_amdgcn_ds_bpermute((lane ^ k) << 2, __builtin_bit_cast(int, v))); }
#define XB_TMO      128
#define XB_XCNT(j)  (256  + 64 * (j))
#define XB_XSUB(j)  (1280 + 64 * (j))
#define XB_XGEN(j)  (2304 + 64 * (j))
#define XB_TOP      3328
#define XB_TOPGEN   3392
#define XCD_BAR_WORDS 3456
#define XB_SPIN_CAP (1u << 18)

__device__ __forceinline__ unsigned xb_ld(unsigned* p)              { return __hip_atomic_load(p, __ATOMIC_RELAXED, __HIP_MEMORY_SCOPE_AGENT); }
__device__ __forceinline__ unsigned xb_add(unsigned* p, unsigned v) { return __hip_atomic_fetch_add(p, v, __ATOMIC_RELAXED, __HIP_MEMORY_SCOPE_AGENT); }
__device__ __forceinline__ unsigned xb_xcc_id() { return (unsigned)__builtin_amdgcn_s_getreg((3 << 11) | 20) & 0xFu; }
#define XB_SPIN(cond, bar) do { unsigned _sp = 0; while (cond) { __builtin_amdgcn_s_sleep(1); \
    if ((++_sp & 255u) == 0u) { if (xb_ld(&(bar)[XB_TMO])) break; if (_sp > XB_SPIN_CAP) { atomicAdd(&(bar)[XB_TMO], 1u); break; } } } } while (0)

struct XcdBarrier {
    unsigned* bar; unsigned x;
    volatile LAS unsigned* st;
};

__device__ __forceinline__ XcdBarrier xcd_barrier_post(unsigned* bar, volatile LAS unsigned* st) {
    XcdBarrier b; b.bar = bar; b.x = xb_xcc_id(); b.st = st;
    if (threadIdx.x == 0) (void)xb_add(&bar[XB_XCNT(b.x)], 1u);
    return b;
}
__device__ __forceinline__ void xcd_barrier_complete(unsigned* bar, unsigned x, unsigned& nloc, unsigned& nx) {
    const unsigned G = gridDim.x * gridDim.y * gridDim.z;
    unsigned sum, cnt, mine, sp = 0u;
    for (;;) {
        sum = 0u; cnt = 0u; mine = 0u;
#pragma unroll
        for (unsigned j = 0; j < 16; ++j) { const unsigned c = xb_ld(&bar[XB_XCNT(j)]); sum += c; cnt += (c > 0u) ? 1u : 0u; mine = (j == x) ? c : mine; }
        if (sum == G) break;
        __builtin_amdgcn_s_sleep(1);
        if ((++sp & 255u) == 0u) { if (xb_ld(&bar[XB_TMO])) break; if (sp > XB_SPIN_CAP) { atomicAdd(&bar[XB_TMO], 1u); break; } }
    }
    nloc = mine > 0u ? mine : 1u; nx = cnt > 0u ? cnt : 1u;
}

__device__ __forceinline__ void xcd_barrier(const XcdBarrier& b) {
    asm volatile("s_waitcnt vmcnt(0)" ::: "memory");
    __syncthreads();
    if (threadIdx.x == 0) {
        unsigned* bar = b.bar;
        __builtin_amdgcn_s_waitcnt(0);
        unsigned nloc = b.st[0], nx = b.st[1];
        if (nloc == 0u) { xcd_barrier_complete(bar, b.x, nloc, nx); b.st[0] = nloc; b.st[1] = nx; }
        const unsigned old = xb_add(&bar[XB_XSUB(b.x)], 1u);
        const unsigned gen = old / nloc;
        if (old + 1u == (gen + 1u) * nloc) {
            __builtin_amdgcn_fence(__ATOMIC_RELEASE, "agent");
            asm volatile("s_waitcnt vmcnt(0)" ::: "memory");
            const unsigned og = xb_add(&bar[XB_TOP], 1u);
            const unsigned tg = og / nx;
            if (og + 1u == (tg + 1u) * nx) xb_add(&bar[XB_TOPGEN], 1u);
            else XB_SPIN(xb_ld(&bar[XB_TOPGEN]) == tg, bar);
            __builtin_amdgcn_fence(__ATOMIC_ACQUIRE, "agent");
            xb_add(&bar[XB_XGEN(b.x)], 1u);
            asm volatile("s_waitcnt vmcnt(0)" ::: "memory");
        } else {
            XB_SPIN(xb_ld(&bar[XB_XGEN(b.x)]) == gen, bar);
            __builtin_amdgcn_fence(__ATOMIC_ACQUIRE, "agent");
            asm volatile("s_waitcnt vmcnt(0)" ::: "memory");
        }
    }
    __syncthreads();
}

__device__ __forceinline__ float wave_sum(float v, int lane) {
#pragma unroll
    for (int o = 1; o < 64; o <<= 1) v += shx(v, o, lane);
    return v;
}
__device__ __forceinline__ void* ldptr(LAS unsigned char* lds, int i) {
    const unsigned long long v = ((const LAS unsigned long long*)(lds + LDSCTL_OFF + 1024))[i];
    const unsigned lo = __builtin_amdgcn_readfirstlane((unsigned)v), hi = __builtin_amdgcn_readfirstlane((unsigned)(v >> 32));
    return (void*)(((unsigned long long)hi << 32) | lo);
}
struct OffsetOrder {
    pg8::StaticOrder S;
    __device__ __forceinline__ void init(int M, int N, int G, int c, int off) { S.init(M, N, G, (c + G - off % G) % G); }
    __device__ __forceinline__ bool next(int i, pg8::Unit& u) const { return S.next(i, u); }
    __device__ __forceinline__ void a_ready(const pg8::Unit&) const {}
    __device__ __forceinline__ void done(const pg8::Unit&) const {}
};

template <bool PERMQKV>
__device__ __forceinline__ void transpose_item(const float* W, int K, int N, bf16* WT, LAS float* scr, int item, int lane, const float* gk = nullptr) {
    const int nblk = N / 32, kb = item / nblk, nb = item % nblk, k0 = 64 * kb, n0 = 32 * nb;
    int d0 = n0;
    if (PERMQKV) { const int within = n0 & 255; d0 = (n0 & ~255) + 128 * ((within >> 5) & 1) + 32 * (within >> 6); }
#pragma unroll
    for (int i = 0; i < 8; ++i) { const int kk = 8 * i + (lane >> 3), nn = 4 * (lane & 7);
        const f32x4 w4 = *(const GAS f32x4*)(W + (size_t)(k0 + kk) * N + n0 + nn) * (gk ? gk[k0 + kk] : 1.f);
        scr[kk * 33 + nn] = w4[0]; scr[kk * 33 + nn + 1] = w4[1]; scr[kk * 33 + nn + 2] = w4[2]; scr[kk * 33 + nn + 3] = w4[3]; }
    LDS_WAIT(); asm volatile("" ::: "memory");
    const int c = lane & 7;
#pragma unroll
    for (int j = 0; j < 4; ++j) { const int n = (lane >> 3) + 8 * j; const LAS float* s = scr + (8 * c) * 33 + n;
        v4u o; o.x = pk2(s[0 * 33], s[1 * 33]); o.y = pk2(s[2 * 33], s[3 * 33]); o.z = pk2(s[4 * 33], s[5 * 33]); o.w = pk2(s[6 * 33], s[7 * 33]);
        *(GAS v4u*)(WT + (size_t)(d0 + n) * K + k0 + 8 * c) = o; }
    LDS_WAIT(); asm volatile("" ::: "memory");
}
__device__ __forceinline__ void convert_bf16(const float* src, bf16* dst, size_t n, size_t gtid, size_t nthreads) {
    for (size_t i = gtid * 8; i < n; i += nthreads * 8) {
        const f32x4 a = *(const GAS f32x4*)(src + i), b = *(const GAS f32x4*)(src + i + 4);
        v4u o; o.x = pk2(a[0], a[1]); o.y = pk2(a[2], a[3]); o.z = pk2(b[0], b[1]); o.w = pk2(b[2], b[3]);
        *(GAS v4u*)(dst + i) = o;
    }
}
__device__ __forceinline__ int t5_bucket(int rel) {
    const int n = rel < 0 ? -rel : rel;
    const int b = n < 8 ? n : n < 12 ? 8 : n < 16 ? 9 : n < 23 ? 10 : n < 32 ? 11 : n < 46 ? 12 : n < 64 ? 13 : n < 91 ? 14 : 15;
    return b + (rel > 0 ? 16 : 0);
}
__constant__ float ROPE_INV[16] = {1.000000000e+00f, 5.623413324e-01f, 3.162277639e-01f, 1.778279394e-01f, 1.000000015e-01f, 5.623413250e-02f, 3.162277490e-02f, 1.778279431e-02f,
                                   9.999999776e-03f, 5.623413250e-03f, 3.162277630e-03f, 1.778279431e-03f, 1.000000047e-03f, 5.623413017e-04f, 3.162277571e-04f, 1.778279402e-04f};

__device__ __forceinline__ void rms_row_to_bf16(const float* xrow, const float* g0, bf16* o0, const float* g1, bf16* o1, int lane) {
    const GAS f32x4* xr = (const GAS f32x4*)xrow + lane;
    f32x4 v[8]; float s = 0.f;
#pragma unroll
    for (int j = 0; j < 8; ++j) { v[j] = xr[64 * j]; s += (v[j].x * v[j].x + v[j].y * v[j].y) + (v[j].z * v[j].z + v[j].w * v[j].w); }
    const float rstd = 1.f / sqrtf(wave_sum(s, lane) * (1.f / DM) + EPS);
    {   const GAS f32x4* gr = (const GAS f32x4*)g0 + lane; GAS v2u* o8 = (GAS v2u*)o0 + lane;
#pragma unroll
        for (int j = 0; j < 8; ++j) { const f32x4 gg = gr[64 * j]; v2u w; w.x = pk2(v[j].x * rstd * gg.x, v[j].y * rstd * gg.y); w.y = pk2(v[j].z * rstd * gg.z, v[j].w * rstd * gg.w); o8[64 * j] = w; } }
    if (g1) { const GAS f32x4* gr = (const GAS f32x4*)g1 + lane; GAS v2u* o8 = (GAS v2u*)o1 + lane;
#pragma unroll
        for (int j = 0; j < 8; ++j) { const f32x4 gg = gr[64 * j]; v2u w; w.x = pk2(v[j].x * rstd * gg.x, v[j].y * rstd * gg.y); w.y = pk2(v[j].z * rstd * gg.z, v[j].w * rstd * gg.w); o8[64 * j] = w; } }
}
__device__ __forceinline__ float wave_max(float v, int lane) {
#pragma unroll
    for (int o = 1; o < 64; o <<= 1) v = fmaxf(v, shx(v, o, lane));
    return v;
}
__device__ __forceinline__ unsigned q8x4(const f32x4 v, const float inv) {
    unsigned w = 0;
    w = __builtin_amdgcn_cvt_pk_u8_f32(__builtin_rintf(__builtin_fmaf(v[0], inv, 128.f)), 0, w); w = __builtin_amdgcn_cvt_pk_u8_f32(__builtin_rintf(__builtin_fmaf(v[1], inv, 128.f)), 1, w);
    w = __builtin_amdgcn_cvt_pk_u8_f32(__builtin_rintf(__builtin_fmaf(v[2], inv, 128.f)), 2, w); w = __builtin_amdgcn_cvt_pk_u8_f32(__builtin_rintf(__builtin_fmaf(v[3], inv, 128.f)), 3, w);
    return w ^ 0x80808080u;
}
__device__ __forceinline__ float amax4(const f32x4 v) { return fmaxf(fmaxf(fabsf(v[0]), fabsf(v[1])), fmaxf(fabsf(v[2]), fabsf(v[3]))); }
__device__ __forceinline__ void quant_wrow(const bf16* src, unsigned char* dst, float* step, int lane) {
    v4u w[4]; float am = 0.f;
#pragma unroll
    for (int j = 0; j < 4; ++j) w[j] = *(const GAS v4u*)(src + 8 * lane + 512 * j);
    f32x4 lo[4], hi[4];
#pragma unroll
    for (int j = 0; j < 4; ++j) { lo[j] = (f32x4){bflo(w[j].x), bfhi(w[j].x), bflo(w[j].y), bfhi(w[j].y)}; hi[j] = (f32x4){bflo(w[j].z), bfhi(w[j].z), bflo(w[j].w), bfhi(w[j].w)}; am = fmaxf(am, fmaxf(amax4(lo[j]), amax4(hi[j]))); }
    am = fmaxf(wave_max(am, lane), 1e-30f);
    const float inv = 127.f / am;
#pragma unroll
    for (int j = 0; j < 4; ++j) *(GAS v2u*)(dst + 8 * lane + 512 * j) = (v2u){q8x4(lo[j], inv), q8x4(hi[j], inv)};
    if (lane == 0) *step = am * (1.f / 127.f);
}
template <int R>
__device__ __forceinline__ void att_quant_rows(const bf16* ATT, const u64_t* mixsq, unsigned char* Q, float* step, int row0, int lane) {
    v4u w[R][4];
#pragma unroll
    for (int q = 0; q < R; ++q)
#pragma unroll
        for (int j = 0; j < 4; ++j) w[q][j] = *(const GAS v4u*)(ATT + (size_t)(row0 + q) * DM + 8 * lane + 512 * j);
#pragma unroll
    for (int q = 0; q < R; ++q) { const int row = row0 + q;
        const float ra = 1.0f / sqrtf((float)*(const GAS u64_t*)(mixsq + row) * (5.9604644775390625e-08f / 768.0f) + EPS), rb = 1.0f / sqrtf((float)*(const GAS u64_t*)(mixsq + T + row) * (5.9604644775390625e-08f / 512.0f) + EPS),
                    rc = 1.0f / sqrtf((float)*(const GAS u64_t*)(mixsq + 2 * (size_t)T + row) * (5.9604644775390625e-08f / 768.0f) + EPS);
        const float rj[4] = {ra, lane < 32 ? ra : rb, lane < 32 ? rb : rc, rc};
        f32x4 lo[4], hi[4]; float am = 0.f;
#pragma unroll
        for (int j = 0; j < 4; ++j) { lo[j] = (f32x4){bflo(w[q][j].x), bfhi(w[q][j].x), bflo(w[q][j].y), bfhi(w[q][j].y)} * rj[j]; hi[j] = (f32x4){bflo(w[q][j].z), bfhi(w[q][j].z), bflo(w[q][j].w), bfhi(w[q][j].w)} * rj[j]; am = fmaxf(am, fmaxf(amax4(lo[j]), amax4(hi[j]))); }
        am = fmaxf(wave_max(am, lane), 1e-30f);
        const float inv = 127.f / am;
#pragma unroll
        for (int j = 0; j < 4; ++j) *(GAS v2u*)(Q + (size_t)row * DM + 8 * lane + 512 * j) = (v2u){q8x4(lo[j], inv), q8x4(hi[j], inv)};
        if (lane == 0) step[row] = am * (1.f / 127.f); }
}
__device__ __forceinline__ void prep_rows2(const float* x0, bf16* o0, u64_t* sq, unsigned char* q0, float* qstep, int lane) {
    f32x4 v[2][8];
#pragma unroll
    for (int q = 0; q < 2; ++q) { const GAS f32x4* xr = (const GAS f32x4*)(x0 + (size_t)q * DM) + lane;
#pragma unroll
        for (int j = 0; j < 8; ++j) v[q][j] = xr[64 * j]; }
#pragma unroll
    for (int q = 0; q < 2; ++q) { GAS v2u* o8 = (GAS v2u*)(o0 + (size_t)q * DM) + lane; float s = 0.f;
#pragma unroll
        for (int j = 0; j < 8; ++j) { const f32x4 a = v[q][j]; s += (a.x * a.x + a.y * a.y) + (a.z * a.z + a.w * a.w); v2u w; w.x = pk2(a.x, a.y); w.y = pk2(a.z, a.w); o8[64 * j] = w; }
        s = wave_sum(s, lane);
        float am = 0.f;
#pragma unroll
        for (int j = 0; j < 8; ++j) am = fmaxf(am, amax4(v[q][j]));
        am = fmaxf(wave_max(am, lane), 1e-30f);
        const float inv = 127.f / am;
#pragma unroll
        for (int j = 0; j < 8; ++j) *(GAS unsigned*)(q0 + (size_t)q * DM + 4 * lane + 256 * j) = q8x4(v[q][j], inv);
        if (lane == 0) { sq[q] = rowsq_fx(s); qstep[q] = am * (1.f / 127.f) / sqrtf(s * (1.f / DM) + 1e-6f); } }
}
__device__ __forceinline__ void norm_rows(const float* X, const float* g, bf16* XN, int gw, int NGW, int lane) {
    for (int m = gw; m < T; m += NGW) rms_row_to_bf16(X + (size_t)m * DM, g, XN + (size_t)m * DM, nullptr, nullptr, lane);
}

template <int TYPE>
__device__ __forceinline__ void naive_attn_item(const bf16* QKV, bf16* ATT, int b, int grow, int head, int lane, const float* biasA, const float* sink, const float* rpb) {
    const int tpos = grow * 64 + lane; const size_t trow = (size_t)b * SEQ + tpos;
    int qcol, kcol, vcol, ocol;
    if (TYPE == 0) { qcol = QA + head * 64; kcol = KA + (head / 3) * 64; vcol = VA + (head / 3) * 64; ocol = OA + head * 64; }
    else if (TYPE == 1) { qcol = QB + head * 64; kcol = KB + head * 64; vcol = VB + head * 64; ocol = OB + head * 64; }
    else { qcol = QC + head * 64; kcol = KC + (head / 3) * 64; vcol = VC + (head / 3) * 64; ocol = OC + head * 64; }
    float q[64], o[64];
#pragma unroll
    for (int c = 0; c < 8; ++c) { const v4u w = *(const GAS v4u*)(QKV + trow * DIN + qcol + 8 * c);
        q[8 * c + 0] = bflo(w.x); q[8 * c + 1] = bfhi(w.x); q[8 * c + 2] = bflo(w.y); q[8 * c + 3] = bfhi(w.y); q[8 * c + 4] = bflo(w.z); q[8 * c + 5] = bfhi(w.z); q[8 * c + 6] = bflo(w.w); q[8 * c + 7] = bfhi(w.w); }
#pragma unroll
    for (int d = 0; d < 64; ++d) o[d] = 0.f;
    float m = -1e30f, l = 0.f;
    int j0, j1;
    if (TYPE == 0) { j0 = grow * 64 - 128; if (j0 < 0) j0 = 0; j1 = grow * 64 + 63 + 128; if (j1 > SEQ - 1) j1 = SEQ - 1; }
    else if (TYPE == 1) { int r0 = grow - 4; r0 = r0 < 0 ? 0 : (r0 > 24 ? 24 : r0); j0 = r0 * 64; j1 = j0 + 511; }
    else { j0 = 0; j1 = SEQ - 1; }
    int c0 = lane - 8; c0 = c0 < 0 ? 0 : (c0 > 48 ? 48 : c0);
#pragma unroll 1
    for (int j = j0; j <= j1; ++j) {
        const bf16* krow = QKV + ((size_t)b * SEQ + j) * DIN;
        float s = 0.f;
#pragma unroll
        for (int c = 0; c < 8; ++c) { const v4u w = *(const GAS v4u*)(krow + kcol + 8 * c);
            s += q[8 * c + 0] * bflo(w.x) + q[8 * c + 1] * bfhi(w.x) + q[8 * c + 2] * bflo(w.y) + q[8 * c + 3] * bfhi(w.y) + q[8 * c + 4] * bflo(w.z) + q[8 * c + 5] * bfhi(w.z) + q[8 * c + 6] * bflo(w.w) + q[8 * c + 7] * bfhi(w.w); }
        bool valid = true;
        if (TYPE == 0) { const int rel = j - tpos; valid = (rel >= -128 && rel <= 128); if (valid) s += biasA[head * 257 + rel + 128]; }
        if (TYPE == 1) { const int kr = j >> 6, kc = j & 63; valid = (kc >= c0 && kc < c0 + 16); if (valid) s += rpb[(head * 15 + (kr - grow + 7)) * 31 + (kc - lane + 15)]; }
        const float mn = valid ? fmaxf(m, s) : m;
        const float a = __expf(m - mn);
        const float p = valid ? __expf(s - mn) : 0.f;
        l = l * a + p; m = mn;
#pragma unroll
        for (int c = 0; c < 8; ++c) { const v4u w = *(const GAS v4u*)(krow + vcol + 8 * c);
            o[8 * c + 0] = o[8 * c + 0] * a + p * bflo(w.x); o[8 * c + 1] = o[8 * c + 1] * a + p * bfhi(w.x); o[8 * c + 2] = o[8 * c + 2] * a + p * bflo(w.y); o[8 * c + 3] = o[8 * c + 3] * a + p * bfhi(w.y);
            o[8 * c + 4] = o[8 * c + 4] * a + p * bflo(w.z); o[8 * c + 5] = o[8 * c + 5] * a + p * bfhi(w.z); o[8 * c + 6] = o[8 * c + 6] * a + p * bflo(w.w); o[8 * c + 7] = o[8 * c + 7] * a + p * bfhi(w.w); }
    }
    if (TYPE == 0) l += __expf(sink[head] - m);
    const float inv = 1.f / l;
#pragma unroll
    for (int c = 0; c < 8; ++c) { v4u w; w.x = pk2(o[8 * c + 0] * inv, o[8 * c + 1] * inv); w.y = pk2(o[8 * c + 2] * inv, o[8 * c + 3] * inv); w.z = pk2(o[8 * c + 4] * inv, o[8 * c + 5] * inv); w.w = pk2(o[8 * c + 6] * inv, o[8 * c + 7] * inv);
        *(GAS v4u*)(ATT + trow * DM + ocol + 8 * c) = w; }
}
__device__ __forceinline__ float rdl(float v, int l) { return __builtin_bit_cast(float, __builtin_amdgcn_readlane(__builtin_bit_cast(int, v), l)); }
__device__ __forceinline__ void naive_mem_item(const bf16* QM, const bf16* KVM, bf16* OM, const float* gq, size_t trow, int b, int head, int lane) {
    const unsigned qw = *(const GAS unsigned*)(QM + trow * MEMW + head * 128 + 2 * lane);
    float q0 = bflo(qw), q1 = bfhi(qw);
    const float ss = wave_sum(q0 * q0 + q1 * q1, lane);
    const float r = 0.08838834764831845f / sqrtf(ss * (1.f / 128.f) + EPS);
    q0 *= r * gq[2 * lane]; q1 *= r * gq[2 * lane + 1];
    const bf16* kbase = KVM + ((size_t)b * NMEM + lane) * 1024 + head * 128;
    float s[4] = {0.f, 0.f, 0.f, 0.f};
#pragma unroll 1
    for (int c = 0; c < 16; ++c) {
        float qa[8];
#pragma unroll
        for (int e = 0; e < 4; ++e) { qa[2 * e] = rdl(q0, 4 * c + e); qa[2 * e + 1] = rdl(q1, 4 * c + e); }
#pragma unroll
        for (int i = 0; i < 4; ++i) { const v4u w = *(const GAS v4u*)(kbase + (size_t)i * 64 * 1024 + 8 * c);
            s[i] += qa[0] * bflo(w.x) + qa[1] * bfhi(w.x) + qa[2] * bflo(w.y) + qa[3] * bfhi(w.y) + qa[4] * bflo(w.z) + qa[5] * bfhi(w.z) + qa[6] * bflo(w.w) + qa[7] * bfhi(w.w); }
    }
    float m = fmaxf(fmaxf(s[0], s[1]), fmaxf(s[2], s[3]));
#pragma unroll
    for (int o = 1; o < 64; o <<= 1) m = fmaxf(m, shx(m, o, lane));
    float p[4]; float l = 0.f;
#pragma unroll
    for (int i = 0; i < 4; ++i) { p[i] = __expf(s[i] - m); l += p[i]; }
    l = wave_sum(l, lane);
    const bf16* vbase = KVM + ((size_t)b * NMEM) * 1024 + 512 + head * 128 + 2 * lane;
    float o0 = 0.f, o1 = 0.f;
#pragma unroll
    for (int i = 0; i < 4; ++i) {
#pragma unroll 4
        for (int jj = 0; jj < 64; ++jj) { const float pj = rdl(p[i], jj); const unsigned w = *(const GAS unsigned*)(vbase + (size_t)(64 * i + jj) * 1024); o0 += pj * bflo(w); o1 += pj * bfhi(w); }
    }
    const float inv = 1.f / l;
    *(GAS unsigned*)(OM + trow * MEMW + head * 128 + 2 * lane) = pk2(o0 * inv, o1 * inv);
}
__device__ __forceinline__ void mixnorm_rows(bf16* ATT, const float* g, int gw, int NGW, int lane) {
    for (int m = gw; m < T; m += NGW) {
        GAS v4u* p = (GAS v4u*)(ATT + (size_t)m * DM + 32 * lane);
        v4u w[4]; float f[32]; float ss = 0.f;
#pragma unroll
        for (int c = 0; c < 4; ++c) { w[c] = p[c];
            f[8 * c + 0] = bflo(w[c].x); f[8 * c + 1] = bfhi(w[c].x); f[8 * c + 2] = bflo(w[c].y); f[8 * c + 3] = bfhi(w[c].y); f[8 * c + 4] = bflo(w[c].z); f[8 * c + 5] = bfhi(w[c].z); f[8 * c + 6] = bflo(w[c].w); f[8 * c + 7] = bfhi(w[c].w); }
#pragma unroll
        for (int i = 0; i < 32; ++i) ss += f[i] * f[i];
        const int grp = lane < 24 ? 0 : (lane < 40 ? 1 : 2);
        const float sa = wave_sum(grp == 0 ? ss : 0.f, lane), sb = wave_sum(grp == 1 ? ss : 0.f, lane), sc = wave_sum(grp == 2 ? ss : 0.f, lane);
        const float r = grp == 0 ? 1.f / sqrtf(sa * (1.f / 768.f) + EPS) : (grp == 1 ? 1.f / sqrtf(sb * (1.f / 512.f) + EPS) : 1.f / sqrtf(sc * (1.f / 768.f) + EPS));
        const float* gg = g + 32 * lane;
#pragma unroll
        for (int c = 0; c < 4; ++c) { const f32x4 g0 = *(const GAS f32x4*)(gg + 8 * c), g1 = *(const GAS f32x4*)(gg + 8 * c + 4);
            v4u o; o.x = pk2(f[8 * c + 0] * r * g0[0], f[8 * c + 1] * r * g0[1]); o.y = pk2(f[8 * c + 2] * r * g0[2], f[8 * c + 3] * r * g0[3]);
            o.z = pk2(f[8 * c + 4] * r * g1[0], f[8 * c + 5] * r * g1[1]); o.w = pk2(f[8 * c + 6] * r * g1[2], f[8 * c + 7] * r * g1[3]); p[c] = o; }
    }
}

#ifndef PEER_HD
#define PEER_HD __device__ __forceinline__
#define PEER_EXP(x) __expf(x)
#endif
template <int N> PEER_HD void bitonic_sort_desc(float* v) {
#pragma unroll
    for (int k = 2; k <= N; k <<= 1)
#pragma unroll
        for (int j = k >> 1; j > 0; j >>= 1)
#pragma unroll
            for (int i = 0; i < N; ++i) { const int l = i ^ j; if (l > i) { const bool desc = ((i & k) == 0); const float a = v[i], b = v[l]; const float hi = fmaxf(a, b), lo = fminf(a, b);
                v[i] = desc ? hi : lo; v[l] = desc ? lo : hi; } }
}
PEER_HD void merge_top16(float* a, const float* b) {
    float c[16];
#pragma unroll
    for (int i = 0; i < 16; ++i) c[i] = fmaxf(a[i], b[15 - i]);
#pragma unroll
    for (int j = 8; j > 0; j >>= 1)
#pragma unroll
        for (int i = 0; i < 16; ++i) { const int l = i ^ j; if (l > i) { const float x = c[i], y = c[l]; c[i] = fmaxf(x, y); c[l] = fminf(x, y); } }
#pragma unroll
    for (int i = 0; i < 16; ++i) a[i] = c[i];
}
PEER_HD void top16_of_64(float (&v)[64]) {
    bitonic_sort_desc<16>(&v[0]); bitonic_sort_desc<16>(&v[16]); bitonic_sort_desc<16>(&v[32]); bitonic_sort_desc<16>(&v[48]);
    merge_top16(&v[0], &v[16]); merge_top16(&v[32], &v[48]); merge_top16(&v[0], &v[32]);
}
PEER_HD float pack_idx(float s, unsigned idx, unsigned mask) { return __builtin_bit_cast(float, (__builtin_bit_cast(unsigned, s) & ~mask) | idx); }
PEER_HD unsigned low_bits(float s, unsigned mask) { return __builtin_bit_cast(unsigned, s) & mask; }
PEER_HD unsigned pick16(const float* a, unsigned i, unsigned mask) {
    unsigned r = 0;
#pragma unroll
    for (unsigned k = 0; k < 16; ++k) r = (i == k) ? low_bits(a[k], mask) : r;
    return r;
}
PEER_HD void peer_candidates(const float* a, const float* b, int* e, float* gate) {
    float c[64]; int n = 0;
#pragma unroll
    for (int i = 0; i < 16; ++i)
#pragma unroll
        for (int j = 0; j < 16; ++j) if ((i + 1) * (j + 1) <= 16) { c[n] = pack_idx(a[i] + b[j], (unsigned)(i * 16 + j), 0xffu); ++n; }
#pragma unroll
    for (int k = 50; k < 64; ++k) c[k] = -3.0e38f;
    top16_of_64(c);
    float mx = c[0], den = 0.f;
#pragma unroll
    for (int k = 0; k < 16; ++k) { const unsigned id = low_bits(c[k], 0xffu); const unsigned n0 = pick16(a, id >> 4, 0x7fu), n1 = pick16(b, id & 15u, 0x7fu);
        e[k] = (int)(n0 * 128u + n1); gate[k] = PEER_EXP(c[k] - mx); den += gate[k]; }
    const float inv = 1.f / den;
#pragma unroll
    for (int k = 0; k < 16; ++k) gate[k] *= inv;
}

__device__ __forceinline__ void peer_select_unit(const bf16* QP, const bf16* PK, int* PIDX, float* PGATE, int tb, int h, int wave, int lane, LAS unsigned char* lds) {
    const int hh = lane >> 5, tl = lane & 31; const size_t t = (size_t)tb * 256 + wave * 32 + tl;
    __syncthreads();
    {   const int tid = wave * 64 + lane; const bf16* src = PK + (size_t)h * 256 * 128;
#pragma unroll 1
        for (int i0 = 0; i0 < 8; i0 += 4) { v4u st[4];
#pragma unroll
            for (int i = 0; i < 4; ++i) st[i] = *(const GAS v4u*)(src + (size_t)(tid + 512 * (i0 + i)) * 8);
#pragma unroll
            for (int i = 0; i < 4; ++i) { const int c = tid + 512 * (i0 + i), row = c >> 4, ch = c & 15; *(LAS v4u*)(lds + row * 256 + ((ch ^ (row & 15)) * 16)) = st[i]; } } }
    __syncthreads();
    float ab[2][16];
#pragma unroll
    for (int p = 0; p < 2; ++p) {
        bf16x8 bq[8];
#pragma unroll
        for (int s = 0; s < 8; ++s) bq[s] = *(const GAS bf16x8*)(QP + t * DM + 256 * h + 128 * p + 16 * s + 8 * hh);
        float v[64];
#pragma unroll
        for (int nb = 0; nb < 4; ++nb) {
            f32x16 acc;
#pragma unroll
            for (int r = 0; r < 16; ++r) acc[r] = 0.f;
            const int krow = p * 128 + 32 * nb + tl;
            bf16x8 ak[8];
#pragma unroll
            for (int s = 0; s < 8; ++s) ak[s] = *(const LAS bf16x8*)(lds + krow * 256 + (((2 * s + hh) ^ (krow & 15)) * 16));
#pragma unroll
            for (int s = 0; s < 8; ++s) acc = __builtin_amdgcn_mfma_f32_32x32x16_bf16(ak[s], bq[s], acc, 0, 0, 0);
#pragma unroll
            for (int r = 0; r < 16; ++r) v[16 * nb + r] = pack_idx(acc[r], (unsigned)(32 * nb + 8 * (r >> 2) + 4 * hh + (r & 3)), 0x7fu);
        }
        top16_of_64(v);
        float pv[16];
#pragma unroll
        for (int i = 0; i < 16; ++i) pv[i] = shx(v[i], 32, lane);
        merge_top16(&v[0], pv);
#pragma unroll
        for (int i = 0; i < 16; ++i) ab[p][i] = v[i];
    }
    int e[16]; float gate[16];
    peer_candidates(ab[0], ab[1], e, gate);
    if (hh == 0) { GAS v4u* o = (GAS v4u*)(PIDX + t * 128 + h * 16);
#pragma unroll
        for (int c = 0; c < 4; ++c) o[c] = (v4u){(unsigned)e[4 * c], (unsigned)e[4 * c + 1], (unsigned)e[4 * c + 2], (unsigned)e[4 * c + 3]}; }
    else { GAS f32x4* o = (GAS f32x4*)(PGATE + t * 128 + h * 16);
#pragma unroll
        for (int c = 0; c < 4; ++c) o[c] = (f32x4){gate[4 * c], gate[4 * c + 1], gate[4 * c + 2], gate[4 * c + 3]}; }
}

typedef float f32x2 __attribute__((ext_vector_type(2)));
typedef unsigned v6u __attribute__((ext_vector_type(6)));
typedef float v32f __attribute__((ext_vector_type(32)));
typedef v4u __attribute__((aligned(8))) v4u_a8;
constexpr float PU_SCALE6 = 90.0f, PV_SCALE6 = 5.65f;
__device__ __forceinline__ unsigned enc_e2m3(float v) {
    const float a = fminf(fabsf(v), 7.5f);
    unsigned code;
    if (a < 1.0f) code = (unsigned)__builtin_rintf(a * 8.f);
    else { const unsigned b = __builtin_bit_cast(unsigned, a) - 0x3F800000u; code = ((b + 0x7FFFFu + ((b >> 20) & 1u)) >> 20) + 8u; }
    return code | (v < 0.f ? 32u : 0u);
}
__device__ __forceinline__ void convert_fp6_rows(const float* src, unsigned char* dst, int nrows, float scale, const float* gain, int gw, int NGW, int lane) {
    for (int r = gw; r < nrows; r += NGW) {
        const float* sp = src + (size_t)r * DM + 4 * lane; const float* gp = gain ? gain + (size_t)(r / PEER_N) * DM + 4 * lane : nullptr;
        unsigned w[6] = {0u, 0u, 0u, 0u, 0u, 0u};
#pragma unroll
        for (int j = 0; j < 8; ++j) { f32x4 a = *(const GAS f32x4*)(sp + 256 * j) * scale; if (gp) a = a * *(const GAS f32x4*)(gp + 256 * j);
#pragma unroll
            for (int e = 0; e < 4; ++e) { const unsigned code = enc_e2m3(a[e]); const int bp = 6 * (4 * j + e), wi = bp >> 5, sh = bp & 31;
                w[wi] |= code << sh; if (sh > 26) w[wi + 1] |= code >> (32 - sh); } }
        unsigned char* dp = dst + (size_t)r * 1536 + 24 * lane;
        *(GAS v4u_a8*)dp = (v4u){w[0], w[1], w[2], w[3]}; *(GAS v2u*)(dp + 16) = (v2u){w[4], w[5]};
    }
}
constexpr float PV_SCALE4 = 5.65f, PU_SCALE4 = 90.0f;
__device__ __forceinline__ unsigned enc_e2m1(float v) {
    const float a = fabsf(v);
    const unsigned code = a < 0.25f ? 0u : a < 0.75f ? 1u : a < 1.25f ? 2u : a < 1.75f ? 3u : a < 2.5f ? 4u : a < 3.5f ? 5u : a < 5.0f ? 6u : 7u;
    return code | (v < 0.f ? 8u : 0u);
}
__device__ __forceinline__ void convert_fp4_rows(const float* src, unsigned char* dst, int nrows, float scale, const float* gain, int gw, int NGW, int lane) {
    for (int r0 = 2 * gw; r0 < nrows; r0 += 2 * NGW) {
        f32x4 a[2][8];
#pragma unroll
        for (int q = 0; q < 2; ++q) { const float* sp = src + (size_t)(r0 + q) * DM + 4 * lane;
#pragma unroll
            for (int j = 0; j < 8; ++j) a[q][j] = *(const GAS f32x4*)(sp + 256 * j); }
#pragma unroll
        for (int q = 0; q < 2; ++q) { const int r = r0 + q; const float* gp = gain ? gain + (size_t)(r / PEER_N) * DM + 4 * lane : nullptr;
            unsigned w[4] = {0u, 0u, 0u, 0u};
#pragma unroll
            for (int j = 0; j < 8; ++j) { f32x4 v = a[q][j] * scale; if (gp) v = v * *(const GAS f32x4*)(gp + 256 * j);
#pragma unroll
                for (int e = 0; e < 4; ++e) { const int i = 4 * j + e; w[i >> 3] |= enc_e2m1(v[e]) << (4 * (i & 7)); } }
            *(GAS v4u*)(dst + (size_t)r * 1024 + 16 * lane) = (v4u){w[0], w[1], w[2], w[3]}; }
    }
}
#define PG4_LOAD(buf, tab, idlo, idhi, g) do { _Pragma("unroll") for (int i_ = 0; i_ < PG6_R; ++i_) { const int k_ = (g) * PG6_R + i_; \
        const int e_ = __builtin_amdgcn_readlane(k_ < 64 ? idlo : idhi, k_ & 63); buf[i_] = __builtin_amdgcn_raw_buffer_load_b128(tab, (int)voff4, e_ * 1024, 0); } } while (0)
#define PG4_DOT1(buf, i_, dst) do { f32x2 a_ = {0.f, 0.f}; _Pragma("unroll") for (int c_ = 0; c_ < 4; ++c_) { const unsigned u_ = buf[i_][c_]; \
        a_ += __builtin_amdgcn_cvt_scalef32_pk_f32_fp4(u_, 1.0f, 0) * x[4 * c_ + 0]; a_ += __builtin_amdgcn_cvt_scalef32_pk_f32_fp4(u_, 1.0f, 1) * x[4 * c_ + 1]; \
        a_ += __builtin_amdgcn_cvt_scalef32_pk_f32_fp4(u_, 1.0f, 2) * x[4 * c_ + 2]; a_ += __builtin_amdgcn_cvt_scalef32_pk_f32_fp4(u_, 1.0f, 3) * x[4 * c_ + 3]; } dst = a_.x + a_.y; __builtin_amdgcn_sched_barrier(0); } while (0)
#define PG4_DOT(buf, g) do { float p_[8]; _Pragma("unroll") for (int i_ = 0; i_ < 8; ++i_) PG4_DOT1(buf, i_, p_[i_]); \
        float q_[4]; _Pragma("unroll") for (int i_ = 0; i_ < 4; ++i_) { const float keep_ = b5 ? p_[i_ + 4] : p_[i_], send_ = b5 ? p_[i_] : p_[i_ + 4]; q_[i_] = keep_ + shx(send_, 32, lane); } \
        float r_[2]; _Pragma("unroll") for (int i_ = 0; i_ < 2; ++i_) { const float keep_ = b4 ? q_[i_ + 2] : q_[i_], send_ = b4 ? q_[i_] : q_[i_ + 2]; r_[i_] = keep_ + shx(send_, 16, lane); } \
        float s_; { const float keep_ = b3 ? r_[1] : r_[0], send_ = b3 ? r_[0] : r_[1]; s_ = keep_ + shx(send_, 8, lane); } \
        s_ += shx(s_, 4, lane); s_ += shx(s_, 2, lane); s_ += shx(s_, 1, lane); \
        if ((lane & 7) == 0) wl[(g) * 8 + (lane >> 3)] = s_; } while (0)
#define PG4_AXPY(buf, g) do { _Pragma("unroll") for (int i_ = 0; i_ < PG6_R; ++i_) { const float w_ = wl[(g) * PG6_R + i_]; const f32x2 wv_ = {w_, w_}; \
        _Pragma("unroll") for (int c_ = 0; c_ < 4; ++c_) { const unsigned u_ = buf[i_][c_]; \
            y[4 * c_ + 0] += __builtin_amdgcn_cvt_scalef32_pk_f32_fp4(u_, 1.0f, 0) * wv_; y[4 * c_ + 1] += __builtin_amdgcn_cvt_scalef32_pk_f32_fp4(u_, 1.0f, 1) * wv_; \
            y[4 * c_ + 2] += __builtin_amdgcn_cvt_scalef32_pk_f32_fp4(u_, 1.0f, 2) * wv_; y[4 * c_ + 3] += __builtin_amdgcn_cvt_scalef32_pk_f32_fp4(u_, 1.0f, 3) * wv_; } \
        __builtin_amdgcn_sched_barrier(0); } } while (0)
#ifndef PG6_R
#define PG6_R 8
#endif
#define PG6_LOAD(buf, tab, idlo, idhi, g) do { _Pragma("unroll") for (int i_ = 0; i_ < PG6_R; ++i_) { const int k_ = (g) * PG6_R + i_; \
        const int e_ = __builtin_amdgcn_readlane(k_ < 64 ? idlo : idhi, k_ & 63); const unsigned char* rp_ = (tab) + (size_t)(unsigned)e_ * 1536u; \
        const v4u a_ = *(const GAS v4u_a8*)(rp_ + voff); const v2u b_ = *(const GAS v2u*)(rp_ + voff + 16); buf[i_] = (v6u){a_.x, a_.y, a_.z, a_.w, b_.x, b_.y}; } } while (0)
#define PG6_DOT1(buf, i_, dst) do { const v32f f_ = __builtin_amdgcn_cvt_scalef32_pk32_f32_fp6(buf[i_], 1.0f); f32x2 a_ = {0.f, 0.f}; \
        _Pragma("unroll") for (int c_ = 0; c_ < 16; ++c_) a_ += (f32x2){f_[2 * c_], f_[2 * c_ + 1]} * x[c_]; dst = a_.x + a_.y; __builtin_amdgcn_sched_barrier(0); } while (0)
#if PG6_R == 8
#define PG6_DOT(buf, g) do { float p_[8]; _Pragma("unroll") for (int i_ = 0; i_ < 8; ++i_) PG6_DOT1(buf, i_, p_[i_]); \
        float q_[4]; _Pragma("unroll") for (int i_ = 0; i_ < 4; ++i_) { const float keep_ = b5 ? p_[i_ + 4] : p_[i_], send_ = b5 ? p_[i_] : p_[i_ + 4]; q_[i_] = keep_ + shx(send_, 32, lane); } \
        float r_[2]; _Pragma("unroll") for (int i_ = 0; i_ < 2; ++i_) { const float keep_ = b4 ? q_[i_ + 2] : q_[i_], send_ = b4 ? q_[i_] : q_[i_ + 2]; r_[i_] = keep_ + shx(send_, 16, lane); } \
        float s_; { const float keep_ = b3 ? r_[1] : r_[0], send_ = b3 ? r_[0] : r_[1]; s_ = keep_ + shx(send_, 8, lane); } \
        s_ += shx(s_, 4, lane); s_ += shx(s_, 2, lane); s_ += shx(s_, 1, lane); \
        if ((lane & 7) == 0) wl[(g) * 8 + (lane >> 3)] = s_; } while (0)
#else
#define PG6_DOT(buf, g) do { float p_[4]; _Pragma("unroll") for (int i_ = 0; i_ < 4; ++i_) PG6_DOT1(buf, i_, p_[i_]); \
        float r_[2]; _Pragma("unroll") for (int i_ = 0; i_ < 2; ++i_) { const float keep_ = b5 ? p_[i_ + 2] : p_[i_], send_ = b5 ? p_[i_] : p_[i_ + 2]; r_[i_] = keep_ + shx(send_, 32, lane); } \
        float s_; { const float keep_ = b4 ? r_[1] : r_[0], send_ = b4 ? r_[0] : r_[1]; s_ = keep_ + shx(send_, 16, lane); } \
        s_ += shx(s_, 8, lane); s_ += shx(s_, 4, lane); s_ += shx(s_, 2, lane); s_ += shx(s_, 1, lane); \
        if ((lane & 15) == 0) wl[(g) * 4 + (lane >> 4)] = s_; } while (0)
#endif
#define PG6_AXPY(buf, g) do { _Pragma("unroll") for (int i_ = 0; i_ < PG6_R; ++i_) { const float w_ = wl[(g) * PG6_R + i_]; const f32x2 wv_ = {w_, w_}; \
        const v32f f_ = __builtin_amdgcn_cvt_scalef32_pk32_f32_fp6(buf[i_], 1.0f); _Pragma("unroll") for (int c_ = 0; c_ < 16; ++c_) y[c_] += (f32x2){f_[2 * c_], f_[2 * c_ + 1]} * wv_; __builtin_amdgcn_sched_barrier(0); } } while (0)
__device__ __forceinline__ unsigned shxu(unsigned v, int k, int lane) { return (unsigned)__builtin_amdgcn_ds_bpermute((lane ^ k) << 2, (int)v); }
__device__ __forceinline__ void wave_sort128(unsigned& a, unsigned& b, int lane) {
#pragma unroll
    for (int k = 2; k <= 128; k <<= 1) {
#pragma unroll
        for (int j = k >> 1; j > 0; j >>= 1) {
            if (j == 64) { const unsigned lo = a < b ? a : b, hi = a < b ? b : a; a = lo; b = hi; }
            else {
                const unsigned pa = shxu(a, j, lane), pb = shxu(b, j, lane);
                const bool lower = (lane & j) == 0;
                const bool asc_a = (lane & k) == 0, asc_b = ((lane + 64) & k) == 0;
                const bool take_min_a = (lower == asc_a), take_min_b = (lower == asc_b);
                a = take_min_a ? (a < pa ? a : pa) : (a < pa ? pa : a);
                b = take_min_b ? (b < pb ? b : pb) : (b < pb ? pb : b);
            }
        }
    }
}
#ifndef PEER_U_FP4
#define PEER_U_FP4 1
#endif
#if PEER_U_FP4
typedef v4u urow_t;
#define PGU_LOAD PG4_LOAD
#define PGU_DOT PG4_DOT
constexpr float PU_SCALE = PU_SCALE4; constexpr int PU_STRIDE = 1024;
#else
typedef v6u urow_t;
#define PGU_LOAD PG6_LOAD
#define PGU_DOT PG6_DOT
constexpr float PU_SCALE = PU_SCALE6; constexpr int PU_STRIDE = 1536;
#endif
constexpr float PU_SCALEI = 135.0f, PX_SCALEI = 20.0f;
__device__ __forceinline__ void peer_v_pass(bf16* XN, const unsigned char* PV6, const int* PIDX, const float* PGATE, const int* PARTI, float* X, u64_t* rowsq_out, unsigned char* XN8, float* xsc, const u64_t* rowsq1, const u64_t* rowsq2, LAS float* wl, int gw, int NGW, int lane) {
    const unsigned voff4 = 16u * (unsigned)lane, l4 = 4u * (unsigned)lane, l8 = 8u * (unsigned)lane, l16 = 16u * (unsigned)lane;
    constexpr int NG = 128 / PG6_R;
    const __amdgpu_buffer_rsrc_t PVr = __builtin_amdgcn_make_buffer_rsrc((void*)PV6, 0, PEER_N * 1024, 0x00020000);
    for (int t_ = gw; t_ < T; t_ += NGW) {
        int t = t_; asm volatile("" : "+s"(t));
        const char* pidx_t = (const char*)(PIDX + (size_t)t * 128); const char* pgate_t = (const char*)(PGATE + (size_t)t * 128);
        const int idlo = *(const GAS int*)(pidx_t + l4), idhi = *(const GAS int*)(pidx_t + l4 + 256);
        v4u AV[PG6_R], BV[PG6_R];
        PG4_LOAD(AV, PVr, idlo, idhi, 0);
        {
            int s0 = 0, s1 = 0;
#pragma unroll
            for (int sp = 0; sp < 8; ++sp) { const char* pp = (const char*)(PARTI + ((size_t)sp * T + t) * 128); s0 += *(const GAS int*)(pp + l4); s1 += *(const GAS int*)(pp + l4 + 256); }
            const float sct = (8.0f / 127.0f / PU_SCALEI) * rowsq_rs(rowsq2, t) / rowsq_rs(rowsq1, t);
            const float d0 = (float)s0 * sct, d1 = (float)s1 * sct;
            const float g0 = *(const GAS float*)(pgate_t + l4), g1 = *(const GAS float*)(pgate_t + l4 + 256);
            const float w0 = g0 * 0.5f * d0 * (1.f + erff(d0 * 0.70710678118654752f)) * (1.f / PV_SCALE4), w1 = g1 * 0.5f * d1 * (1.f + erff(d1 * 0.70710678118654752f)) * (1.f / PV_SCALE4);
            wl[lane] = w0; wl[64 + lane] = w1;
            LDS_WAIT(); asm volatile("" ::: "memory");
        }
        f32x2 y[16];
#pragma unroll
        for (int i = 0; i < 16; ++i) y[i] = (f32x2){0.f, 0.f};
#pragma unroll 1
        for (int g = 0; g < NG; g += 2) {
            PG4_LOAD(BV, PVr, idlo, idhi, g + 1);
            PG4_AXPY(AV, g);
            if (g + 2 < NG) PG4_LOAD(AV, PVr, idlo, idhi, g + 2);
            PG4_AXPY(BV, g + 1);
        }
        {   char* xo = (char*)(X + (size_t)t * DM);
            char* xbo = (char*)(XN + (size_t)t * DM); float ss = 0.f;
#pragma unroll
            for (int j = 0; j < 8; ++j) { const v2u a = *(const GAS v2u*)(xbo + l8 + 512 * j); f32x4 v = (f32x4){bflo(a.x), bfhi(a.x), bflo(a.y), bfhi(a.y)}; v += (f32x4){y[2 * j].x, y[2 * j].y, y[2 * j + 1].x, y[2 * j + 1].y};
                if (X) *(GAS f32x4*)(xo + l16 + 1024 * j) = v;
                y[2 * j] = (f32x2){v[0], v[1]}; y[2 * j + 1] = (f32x2){v[2], v[3]};
                ss += (v[0] * v[0] + v[1] * v[1]) + (v[2] * v[2] + v[3] * v[3]); *(GAS v2u*)(xbo + l8 + 512 * j) = (v2u){pk2(v[0], v[1]), pk2(v[2], v[3])}; }
            if (rowsq_out) { ss = wave_sum(ss, lane); if (lane == 0) rowsq_out[t] = rowsq_fx(ss); }
            if (XN8) {
                float am = 0.f;
#pragma unroll
                for (int j = 0; j < 16; ++j) am = fmaxf(am, fmaxf(fabsf(y[j].x), fabsf(y[j].y)));
                am = fmaxf(wave_max(am, lane), 1e-30f);
                const float inv = 127.f / am; char* qo = (char*)(XN8 + (size_t)t * DM);
#pragma unroll
                for (int j = 0; j < 8; ++j) *(GAS unsigned*)(qo + l4 + 256 * j) = q8x4((f32x4){y[2 * j].x, y[2 * j].y, y[2 * j + 1].x, y[2 * j + 1].y}, inv);
                if (lane == 0) xsc[t] = am * (1.f / 127.f) / sqrtf(ss * (1.f / DM) + 1e-6f); } }
        LDS_WAIT(); asm volatile("" ::: "memory");
    }
}


__device__ __forceinline__ unsigned enc_i4(float v) { int q = (int)__builtin_rintf(v); q = q < -7 ? -7 : (q > 7 ? 7 : q); return (unsigned)q & 15u; }
__device__ __forceinline__ void convert_int4_plain(const float* src, unsigned char* dst, int nrows, float scale, const float* gain, int gw, int NGW, int lane) {
    for (int r0 = 2 * gw; r0 < nrows; r0 += 2 * NGW) {
        f32x4 a[2][8];
#pragma unroll
        for (int q = 0; q < 2; ++q) { const float* sp = src + (size_t)(r0 + q) * DM + 4 * lane;
#pragma unroll
            for (int j = 0; j < 8; ++j) a[q][j] = *(const GAS f32x4*)(sp + 256 * j); }
#pragma unroll
        for (int q = 0; q < 2; ++q) { const int r = r0 + q; const float* gp = gain ? gain + (size_t)(r / PEER_N) * DM + 4 * lane : nullptr;
#pragma unroll
            for (int j = 0; j < 8; ++j) { f32x4 v = a[q][j] * scale; if (gp) v = v * *(const GAS f32x4*)(gp + 256 * j);
                const unsigned w = enc_i4(v[0]) | (enc_i4(v[1]) << 4) | (enc_i4(v[2]) << 8) | (enc_i4(v[3]) << 12);
                *(GAS unsigned short*)(dst + (size_t)r * 1024 + 128 * j + 2 * lane) = (unsigned short)w; } }
    }
}
__device__ __forceinline__ void peer_xquant_unit(const bf16* XN, const u64_t* rowsq, unsigned* XQH, unsigned* XQL, int tb, int sl, int tid) {
    for (int it = tid; it < 256 * 32; it += NTHREADS) {
        const int t = tb * 256 + (it >> 5), c8 = it & 31;
        const float xs = PX_SCALEI * rowsq_rs(rowsq, t);
        const v4u w = *(const GAS v4u*)(XN + (size_t)t * DM + 256 * sl + 8 * c8);
        const float f[8] = {bflo(w.x), bfhi(w.x), bflo(w.y), bfhi(w.y), bflo(w.z), bfhi(w.z), bflo(w.w), bfhi(w.w)};
        unsigned hi = 0u, lo = 0u;
#pragma unroll
        for (int j = 0; j < 8; ++j) { int q = (int)__builtin_rintf(f[j] * xs); q = q < -119 ? -119 : (q > 119 ? 119 : q);
            const int xl = ((q + 8) & 15) - 8, xh = (q - xl) >> 4;
            hi |= ((unsigned)xh & 15u) << (4 * j); lo |= ((unsigned)xl & 15u) << (4 * j); }
        XQH[(size_t)t * 256 + 32 * sl + c8] = hi; XQL[(size_t)t * 256 + 32 * sl + c8] = lo;
    }
}
#define PI_LOADROWS(buf, tab, ids, i0) do { _Pragma("unroll") for (int i_ = 0; i_ < 8; ++i_) buf[i_] = __builtin_amdgcn_raw_buffer_load_b128(tab, ids[(i0) + i_] * 1024 + (int)soff, 0, 0); } while (0)
#define PI_LOADIDS(ids, t) do { const char* ip_ = (const char*)PIDX + ((size_t)(t) * 128 + 16 * g) * 4; _Pragma("unroll") for (int c_ = 0; c_ < 4; ++c_) { const v4u q_ = *(const GAS v4u*)(ip_ + 16 * c_); \
        ids[4 * c_] = (int)q_.x; ids[4 * c_ + 1] = (int)q_.y; ids[4 * c_ + 2] = (int)q_.z; ids[4 * c_ + 3] = (int)q_.w; } } while (0)
#define PI_UGROUP(buf, i0) do { _Pragma("unroll") for (int i_ = 0; i_ < 8; ++i_) { int ah_ = 0, al_ = 0; \
        _Pragma("unroll") for (int c_ = 0; c_ < 4; ++c_) { ah_ = __builtin_amdgcn_sdot8((int)buf[i_][c_], (int)xh[c_], ah_, false); al_ = __builtin_amdgcn_sdot8((int)buf[i_][c_], (int)xl[c_], al_, false); } \
        int p_ = 16 * ah_ + al_; p_ += __builtin_amdgcn_ds_bpermute((lane ^ 1) << 2, p_); p_ += __builtin_amdgcn_ds_bpermute((lane ^ 2) << 2, p_); p_ += __builtin_amdgcn_ds_bpermute((lane ^ 4) << 2, p_); \
        if (m == (((i0) + i_) >> 1)) { if (((i0) + i_) & 1) keep1 = p_; else keep0 = p_; } } } while (0)
#define PI_LOADROWS16(buf, tab, ids) do { _Pragma("unroll") for (int i_ = 0; i_ < 16; ++i_) buf[i_] = __builtin_amdgcn_raw_buffer_load_b128(tab, ids[i_] * 1024 + (int)soff, 0, 0); } while (0)
#define PI_LOADX(xh_, xl_, t) do { xh_ = *(const GAS v4u*)((const char*)XQH + (size_t)(t) * 1024 + soff); xl_ = *(const GAS v4u*)((const char*)XQL + (size_t)(t) * 1024 + soff); } while (0)
#define PI_COMPUTE16(buf, xh_, xl_, t) do { int keep0 = 0, keep1 = 0; \
        _Pragma("unroll") for (int i_ = 0; i_ < 16; ++i_) { int ah_ = 0, al_ = 0; \
            _Pragma("unroll") for (int c_ = 0; c_ < 4; ++c_) { ah_ = __builtin_amdgcn_sdot8((int)buf[i_][c_], (int)xh_[c_], ah_, false); al_ = __builtin_amdgcn_sdot8((int)buf[i_][c_], (int)xl_[c_], al_, false); } \
            int p_ = 16 * ah_ + al_; p_ += __builtin_amdgcn_update_dpp(0, p_, 0xB1, 0xf, 0xf, true); p_ += __builtin_amdgcn_update_dpp(0, p_, 0x4E, 0xf, 0xf, true); p_ += __builtin_amdgcn_update_dpp(0, p_, 0x141, 0xf, 0xf, true);   \
            if (m == (i_ >> 1)) { if (i_ & 1) keep1 = p_; else keep0 = p_; } } \
        if ((t) < T) *(GAS v2u*)(PARTI + ((size_t)s * T + (t)) * 128 + 2 * lane) = (v2u){(unsigned)keep0, (unsigned)keep1}; } while (0)
__device__ __forceinline__ void peer_u_phase_i4(const unsigned* XQH, const unsigned* XQL, const unsigned char* PU, const int* PIDX, int* PARTI, int bid, int G, int wave, int lane) {
    const int s = bid & 7, nr = (G - s + 7) >> 3, q = (bid >> 3) * NWAVES + wave, stride = nr * NWAVES, g = lane >> 3, m = lane & 7;
    const unsigned soff = 128u * (unsigned)s + 16u * (unsigned)m;
    if (q >= T) return;
    const __amdgpu_buffer_rsrc_t PUr = __builtin_amdgcn_make_buffer_rsrc((void*)PU, 0, PEER_N * 1024, 0x00020000);
#define PI_CL(t) ((t) < T ? (t) : T - 1)
    int I1[16], I2[16]; v4u xh0, xl0, xh1, xl1, xh2, xl2, RA[16], RB[16];
    PI_LOADIDS(I1, q); PI_LOADX(xh0, xl0, q);
    PI_LOADROWS16(RA, PUr, I1);
    PI_LOADIDS(I1, PI_CL(q + stride)); PI_LOADX(xh1, xl1, PI_CL(q + stride));
    for (int t = q; t < T; t += 2 * stride) {
        PI_LOADROWS16(RB, PUr, I1);
        PI_LOADIDS(I2, PI_CL(t + 2 * stride)); PI_LOADX(xh2, xl2, PI_CL(t + 2 * stride));
        PI_COMPUTE16(RA, xh0, xl0, t);
        PI_LOADROWS16(RA, PUr, I2);
        PI_LOADIDS(I1, PI_CL(t + 3 * stride)); PI_LOADX(xh0, xl0, PI_CL(t + 3 * stride));
        PI_COMPUTE16(RB, xh1, xl1, t + stride);
        xh1 = xh0; xl1 = xl0; xh0 = xh2; xl0 = xl2;
    }
#undef PI_CL
}


constexpr float PV_SCALE4S = 5.65f;
__device__ __forceinline__ unsigned enc_e2m1s(float v) {
    const float a = fabsf(v);
    const unsigned code = a < 0.25f ? 0u : a < 0.75f ? 1u : a < 1.25f ? 2u : a < 1.75f ? 3u : a < 2.5f ? 4u : a < 3.5f ? 5u : a < 5.0f ? 6u : 7u;
    return code | (v < 0.f ? 8u : 0u);
}
__device__ __forceinline__ void convert_fp4_plain(const float* src, unsigned char* dst, int nrows, float scale, const float* gain, int gw, int NGW, int lane) {
    for (int r0 = 2 * gw; r0 < nrows; r0 += 2 * NGW) {
        f32x4 a[2][8];
#pragma unroll
        for (int q = 0; q < 2; ++q) { const float* sp = src + (size_t)(r0 + q) * DM + 4 * lane;
#pragma unroll
            for (int j = 0; j < 8; ++j) a[q][j] = *(const GAS f32x4*)(sp + 256 * j); }
#pragma unroll
        for (int q = 0; q < 2; ++q) { const int r = r0 + q; const float* gp = gain ? gain + (size_t)(r / PEER_N) * DM + 4 * lane : nullptr;
#pragma unroll
            for (int j = 0; j < 8; ++j) { f32x4 v = a[q][j] * scale; if (gp) v = v * *(const GAS f32x4*)(gp + 256 * j);
                const unsigned w = enc_e2m1s(v[0]) | (enc_e2m1s(v[1]) << 4) | (enc_e2m1s(v[2]) << 8) | (enc_e2m1s(v[3]) << 12);
                *(GAS unsigned short*)(dst + (size_t)r * 1024 + 128 * j + 2 * lane) = (unsigned short)w; } }
    }
}
#define PVS_LOADMETA(ids, pp, gg, t) do { PI_LOADIDS(ids, t); _Pragma("unroll") for (int sp_ = 0; sp_ < 8; ++sp_) pp[sp_] = *(const GAS v2u*)(PARTI + ((size_t)sp_ * T + (t)) * 128 + 2 * lane); \
        gg = *(const GAS f32x2*)(PGATE + (size_t)(t) * 128 + 2 * lane); } while (0)
#define PVS_COMPUTE16(buf, pp, gg, t) do { float w0, w1; { int s0_ = 0, s1_ = 0; _Pragma("unroll") for (int sp_ = 0; sp_ < 8; ++sp_) { s0_ += (int)pp[sp_].x; s1_ += (int)pp[sp_].y; } \
            const float d0_ = (float)s0_ * (1.f / (PX_SCALEI * PU_SCALEI)), d1_ = (float)s1_ * (1.f / (PX_SCALEI * PU_SCALEI)); \
            w0 = gg.x * 0.5f * d0_ * (1.f + erff(d0_ * 0.70710678118654752f)) * (1.f / PV_SCALE4S); w1 = gg.y * 0.5f * d1_ * (1.f + erff(d1_ * 0.70710678118654752f)) * (1.f / PV_SCALE4S); } \
        f32x2 y[16]; _Pragma("unroll") for (int i_ = 0; i_ < 16; ++i_) y[i_] = (f32x2){0.f, 0.f}; \
        _Pragma("unroll") for (int i_ = 0; i_ < 16; ++i_) { \
            const float w_ = __builtin_bit_cast(float, __builtin_amdgcn_ds_bpermute(((lane & 56) | (i_ >> 1)) << 2, __builtin_bit_cast(int, (i_ & 1) ? w1 : w0))); const f32x2 wv_ = {w_, w_}; \
            _Pragma("unroll") for (int c_ = 0; c_ < 4; ++c_) { const unsigned u_ = buf[i_][c_]; \
                y[4 * c_ + 0] += __builtin_amdgcn_cvt_scalef32_pk_f32_fp4(u_, 1.0f, 0) * wv_; y[4 * c_ + 1] += __builtin_amdgcn_cvt_scalef32_pk_f32_fp4(u_, 1.0f, 1) * wv_; \
                y[4 * c_ + 2] += __builtin_amdgcn_cvt_scalef32_pk_f32_fp4(u_, 1.0f, 2) * wv_; y[4 * c_ + 3] += __builtin_amdgcn_cvt_scalef32_pk_f32_fp4(u_, 1.0f, 3) * wv_; } } \
        {   LAS float* wp_ = yl + g * 288 + m * 36; \
            _Pragma("unroll") for (int c_ = 0; c_ < 8; ++c_) *(LAS f32x4*)(wp_ + 4 * c_) = (f32x4){y[2 * c_].x, y[2 * c_].y, y[2 * c_ + 1].x, y[2 * c_ + 1].y}; \
            LDS_WAIT(); asm volatile("" ::: "memory"); \
            f32x4 acc_ = {0.f, 0.f, 0.f, 0.f}; const LAS float* rp_ = yl + (lane >> 3) * 36 + 4 * (lane & 7); \
            _Pragma("unroll") for (int gg_ = 0; gg_ < 8; ++gg_) acc_ += *(const LAS f32x4*)(rp_ + gg_ * 288); \
            LDS_WAIT(); asm volatile("" ::: "memory"); \
            if ((t) < T) { bf16* xp_ = XN + (size_t)(t) * DM + 256 * s + 4 * lane; const v2u a_ = *(const GAS v2u*)xp_; \
                const f32x4 v_ = (f32x4){bflo(a_.x), bfhi(a_.x), bflo(a_.y), bfhi(a_.y)} + acc_; \
                *(GAS v2u*)xp_ = (v2u){pk2(v_[0], v_[1]), pk2(v_[2], v_[3])}; \
                if (Xout) *(GAS f32x4*)(Xout + (size_t)(t) * DM + 256 * s + 4 * lane) = v_; \
                if (rowsq_out) { const float ss_ = wave_sum((v_[0] * v_[0] + v_[1] * v_[1]) + (v_[2] * v_[2] + v_[3] * v_[3]), lane); if (lane == 0) atomicAdd(rowsq_out + (t), rowsq_fx(ss_)); } } } } while (0)
__device__ __forceinline__ void peer_v_phase_s(bf16* XN, const unsigned char* PV, const int* PIDX, const float* PGATE, const int* PARTI, float* Xout, u64_t* rowsq_out, LAS float* yl, int bid, int G, int wave, int lane) {
    const int s = bid & 7, nr = (G - s + 7) >> 3, q = (bid >> 3) * NWAVES + wave, stride = nr * NWAVES, g = lane >> 3, m = lane & 7;
    const unsigned soff = 128u * (unsigned)s + 16u * (unsigned)m;
    if (q >= T) return;
    const __amdgpu_buffer_rsrc_t PVr = __builtin_amdgcn_make_buffer_rsrc((void*)PV, 0, PEER_N * 1024, 0x00020000);
#define PVS_CL(t) ((t) < T ? (t) : T - 1)
    int I0[16], I1[16]; v2u P0[8], P1[8]; f32x2 G0, G1; v4u RA[16], RB[16];
#define PVS_LOADPG(pp, gg, t) do { _Pragma("unroll") for (int sp_ = 0; sp_ < 8; ++sp_) pp[sp_] = *(const GAS v2u*)(PARTI + ((size_t)sp_ * T + (t)) * 128 + 2 * lane); gg = *(const GAS f32x2*)(PGATE + (size_t)(t) * 128 + 2 * lane); } while (0)
    PI_LOADIDS(I0, q); PVS_LOADPG(P0, G0, q);
    PI_LOADROWS16(RA, PVr, I0);
    PI_LOADIDS(I1, PVS_CL(q + stride)); PVS_LOADPG(P1, G1, PVS_CL(q + stride));
    for (int t = q; t < T; t += 2 * stride) {
        PI_LOADROWS16(RB, PVr, I1);
        PI_LOADIDS(I0, PVS_CL(t + 2 * stride));
        PVS_COMPUTE16(RA, P0, G0, t);
        PVS_LOADPG(P0, G0, PVS_CL(t + 2 * stride));
        PI_LOADROWS16(RA, PVr, I0);
        PI_LOADIDS(I1, PVS_CL(t + 3 * stride));
        PVS_COMPUTE16(RB, P1, G1, t + stride);
        PVS_LOADPG(P1, G1, PVS_CL(t + 3 * stride));
    }
#undef PVS_LOADPG
#undef PVS_CL
}

typedef short s16x4 __attribute__((ext_vector_type(4)));
typedef __attribute__((address_space(3))) const char* lds_cptr;
__device__ __forceinline__ s16x4 vtr(lds_cptr p) { return __builtin_bit_cast(s16x4, __builtin_amdgcn_ds_read_tr16_b64_v4i16((__attribute__((address_space(3))) s16x4*)p)); }
__device__ __forceinline__ unsigned cvtpk(float lo, float hi) { unsigned r; asm("v_cvt_pk_bf16_f32 %0, %1, %2" : "=v"(r) : "v"(lo), "v"(hi)); return r; }
constexpr int AT_K0 = 0, AT_V0 = 16384, AT_TAB = 32768;
constexpr float LOG2E = 1.4426950408889634f;
template <int TYPE>
__device__ __forceinline__ void attn_unit(LAS unsigned char* lds, const bf16* QKV, bf16* ATT, u64_t* mixsq, int b, int head, int qb, const float* tabsrc, float Cl2, float sinkl2, int tid) {
    const int lane = tid & 63, w = __builtin_amdgcn_readfirstlane(tid >> 6), hh = lane >> 5, l31 = lane & 31;
    int qcol, kcol, vcol, ocol;
    if (TYPE == 0) { qcol = QA + head * 64; kcol = KA + (head / 3) * 64; vcol = VA + (head / 3) * 64; ocol = OA + head * 64; }
    else if (TYPE == 1) { qcol = QB + head * 64; kcol = KB + head * 64; vcol = VB + head * 64; ocol = OB + head * 64; }
    else { qcol = QC + head * 64; kcol = KC + (head / 3) * 64; vcol = VC + (head / 3) * 64; ocol = OC + head * 64; }
    const int q0 = 256 * qb + 32 * w, qpos = q0 + l31;
    int t_begin, t_end;
    if (TYPE == 0) { t_begin = 4 * qb - 2; if (t_begin < 0) t_begin = 0; t_end = 4 * qb + 6; if (t_end > 32) t_end = 32; }
    else if (TYPE == 1) { int a = 4 * qb - 4; a = a < 0 ? 0 : (a > 24 ? 24 : a); int e = 4 * qb - 1; e = e < 0 ? 0 : (e > 24 ? 24 : e); t_begin = a; t_end = e + 8; }
    else { t_begin = 0; t_end = 32; }
    LAS float* tab = (LAS float*)(lds + AT_TAB);
    if (TYPE == 0) { for (int i = tid; i < 1024; i += NTHREADS) { const int rel = i - 448; tab[i] = (rel >= -128 && rel <= 128) ? tabsrc[head * 257 + rel + 128] * LOG2E - Cl2 : -1e30f; } }
    if (TYPE == 1) { for (int i = tid; i < 15 * 31; i += NTHREADS) tab[i] = tabsrc[head * 465 + i] * LOG2E - Cl2; }
    bf16x8 qf[4];
    {   const bf16* qp = QKV + ((size_t)b * SEQ + qpos) * DIN + qcol + 8 * hh;
#pragma unroll
        for (int s = 0; s < 4; ++s) qf[s] = *(const GAS bf16x8*)(qp + 16 * s); }
    const int srow = tid >> 3, sch = tid & 7;
    const bf16* kg = QKV + ((size_t)b * SEQ + srow) * DIN + kcol + sch * 8;
    const bf16* vg = QKV + ((size_t)b * SEQ + srow) * DIN + vcol + sch * 8;
    const int kst = srow * 128 + ((sch ^ ((srow >> 1) & 7)) * 16);
    const int vst = srow * 128 + (((sch >> 2) ^ ((srow >> 1) & 1)) * 64) + (sch & 3) * 16;
    int kread[4], vread[2];
#pragma unroll
    for (int s = 0; s < 4; ++s) kread[s] = l31 * 128 + (((2 * s + hh) ^ ((lane >> 1) & 7)) * 16);
#pragma unroll
    for (int db = 0; db < 2; ++db) vread[db] = (4 * hh + ((lane >> 2) & 3)) * 128 + ((db ^ ((lane >> 3) & 1)) * 64) + 32 * ((lane >> 4) & 1) + 8 * (lane & 3);
    f32x16 O0, O1;
#pragma unroll
    for (int r = 0; r < 16; ++r) { O0[r] = 0.f; O1[r] = 0.f; }
    float lsum = 0.f;
    const int rw = 4 * qb + (w >> 1), cq = 32 * (w & 1) + l31;
    int r0w = rw - 4; r0w = r0w < 0 ? 0 : (r0w > 24 ? 24 : r0w);
    int c0 = cq - 8; c0 = c0 < 0 ? 0 : (c0 > 48 ? 48 : c0);
    {   const v4u kr = *(const GAS v4u*)(kg + (size_t)t_begin * 64 * DIN), vr = *(const GAS v4u*)(vg + (size_t)t_begin * 64 * DIN);
        *(LAS v4u*)(lds + AT_K0 + kst) = kr; *(LAS v4u*)(lds + AT_V0 + vst) = vr; }
    __syncthreads();
    for (int t = t_begin; t < t_end; ++t) {
        const int cur = (t - t_begin) & 1;
        v4u kr, vr;
        if (t + 1 < t_end) { kr = *(const GAS v4u*)(kg + (size_t)(t + 1) * 64 * DIN); vr = *(const GAS v4u*)(vg + (size_t)(t + 1) * 64 * DIN); }
        bool need = true;
        if (TYPE == 0) need = (64 * t <= q0 + 31 + 128) && (64 * t + 63 >= q0 - 128);
        if (TYPE == 1) need = (t >= r0w) && (t < r0w + 8);
        if (need) {
            const lds_cptr kb_ = (lds_cptr)(lds + AT_K0 + cur * 8192), vb_ = (lds_cptr)(lds + AT_V0 + cur * 8192);
            bf16x8 kf[8];
#pragma unroll
            for (int s = 0; s < 4; ++s) { kf[2 * s] = *(const LAS bf16x8*)(kb_ + kread[s]); kf[2 * s + 1] = *(const LAS bf16x8*)(kb_ + kread[s] + 4096); }
            f32x16 S0, S1;
            if (TYPE == 2) {
#pragma unroll
                for (int r = 0; r < 16; ++r) { S0[r] = -Cl2; S1[r] = -Cl2; }
            } else if (TYPE == 0) {
                const LAS float* tb = tab + (64 * t - qpos + 448 + 4 * hh);
#pragma unroll
                for (int r = 0; r < 16; ++r) { S0[r] = tb[8 * (r >> 2) + (r & 3)]; S1[r] = tb[32 + 8 * (r >> 2) + (r & 3)]; }
            } else {
                const LAS float* tb = tab + ((t - rw + 7) * 31 - cq + 15 + 4 * hh);
                const int kc0 = 4 * hh - c0;
#pragma unroll
                for (int r = 0; r < 16; ++r) { const int ka = 8 * (r >> 2) + (r & 3), kb2 = 32 + ka;
                    S0[r] = ((unsigned)(ka + kc0) < 16u) ? tb[ka] : -1e30f; S1[r] = ((unsigned)(kb2 + kc0) < 16u) ? tb[kb2] : -1e30f; }
            }
            __builtin_amdgcn_sched_barrier(0);
#define AT_SB __builtin_amdgcn_sched_barrier(0)
#define AT_SOFT(SX, base, dst) do { _Pragma("unroll") for (int r = (base); r < (base) + 8; ++r) SX[r] = __builtin_amdgcn_exp2f(SX[r]); \
            lsum += ((SX[(base)] + SX[(base) + 1]) + (SX[(base) + 2] + SX[(base) + 3])) + ((SX[(base) + 4] + SX[(base) + 5]) + (SX[(base) + 6] + SX[(base) + 7])); \
            v4u a_; _Pragma("unroll") for (int j = 0; j < 4; ++j) a_[j] = cvtpk(SX[(base) + 2 * j], SX[(base) + 2 * j + 1]); dst = __builtin_bit_cast(bf16x8, a_); } while (0)
#pragma unroll
            for (int s = 0; s < 4; ++s) S0 = __builtin_amdgcn_mfma_f32_32x32x16_bf16(kf[2 * s], qf[s], S0, 0, 0, 0);
            s16x4 vf[4][2][2];
#pragma unroll
            for (int ks = 0; ks < 2; ++ks)
#pragma unroll
                for (int db = 0; db < 2; ++db) { vf[ks][db][0] = vtr(vb_ + vread[db] + (16 * ks) * 128); vf[ks][db][1] = vtr(vb_ + vread[db] + (16 * ks + 8) * 128); }
            S1 = __builtin_amdgcn_mfma_f32_32x32x16_bf16(kf[1], qf[0], S1, 0, 0, 0); S1 = __builtin_amdgcn_mfma_f32_32x32x16_bf16(kf[3], qf[1], S1, 0, 0, 0);
            AT_SB;
            bf16x8 pb[4];
            AT_SOFT(S0, 0, pb[0]);
            AT_SB;
            S1 = __builtin_amdgcn_mfma_f32_32x32x16_bf16(kf[5], qf[2], S1, 0, 0, 0);
            AT_SB;
            AT_SOFT(S0, 8, pb[1]);
            AT_SB;
            S1 = __builtin_amdgcn_mfma_f32_32x32x16_bf16(kf[7], qf[3], S1, 0, 0, 0);
            asm volatile("s_waitcnt lgkmcnt(7)" ::: "memory");
#pragma unroll
            for (int ks = 2; ks < 4; ++ks)
#pragma unroll
                for (int db = 0; db < 2; ++db) { vf[ks][db][0] = vtr(vb_ + vread[db] + (16 * ks) * 128); vf[ks][db][1] = vtr(vb_ + vread[db] + (16 * ks + 8) * 128); }
            AT_SB;
#define AT_PV(ks) do { const bf16x8 va = __builtin_shufflevector(vf[ks][0][0], vf[ks][0][1], 0, 1, 2, 3, 4, 5, 6, 7), vb2 = __builtin_shufflevector(vf[ks][1][0], vf[ks][1][1], 0, 1, 2, 3, 4, 5, 6, 7); \
            O0 = __builtin_amdgcn_mfma_f32_32x32x16_bf16(va, pb[ks], O0, 0, 0, 0); O1 = __builtin_amdgcn_mfma_f32_32x32x16_bf16(vb2, pb[ks], O1, 0, 0, 0); } while (0)
            AT_PV(0);
            AT_SB;
            AT_SOFT(S1, 0, pb[2]);
            AT_SB;
            AT_PV(1);
            AT_SB;
            AT_SOFT(S1, 8, pb[3]);
            AT_SB;
            AT_PV(2); AT_PV(3);
#undef AT_PV
#undef AT_SOFT
#undef AT_SB
        }
        __builtin_amdgcn_sched_barrier(0);
        if (t + 1 < t_end) { *(LAS v4u*)(lds + AT_K0 + (cur ^ 1) * 8192 + kst) = kr; *(LAS v4u*)(lds + AT_V0 + (cur ^ 1) * 8192 + vst) = vr; }
        __syncthreads();
    }
    lsum += shx(lsum, 32, lane);
    if (TYPE == 0) lsum += __builtin_amdgcn_exp2f(sinkl2 - Cl2);
    const float inv = 1.f / lsum;
    {   float ss = 0.f;
#pragma unroll
        for (int r = 0; r < 16; ++r) { const float a = O0[r] * inv, c = O1[r] * inv; ss += a * a + c * c; }
        ss += shx(ss, 32, lane);
        if (hh == 0) (void)__hip_atomic_fetch_add((GAS u64_t*)(mixsq + (size_t)b * SEQ + qpos), rowsq_fx(ss), __ATOMIC_RELAXED, __HIP_MEMORY_SCOPE_AGENT); }
    bf16* op = ATT + ((size_t)b * SEQ + qpos) * DM + ocol + 4 * hh;
#pragma unroll
    for (int g4 = 0; g4 < 4; ++g4) {
        v2u o0, o1; o0.x = cvtpk(O0[4 * g4] * inv, O0[4 * g4 + 1] * inv); o0.y = cvtpk(O0[4 * g4 + 2] * inv, O0[4 * g4 + 3] * inv);
        o1.x = cvtpk(O1[4 * g4] * inv, O1[4 * g4 + 1] * inv); o1.y = cvtpk(O1[4 * g4 + 2] * inv, O1[4 * g4 + 3] * inv);
        *(GAS v2u*)(op + 8 * g4) = o0; *(GAS v2u*)(op + 32 + 8 * g4) = o1;
    }
}


constexpr int MA_K0 = 0, MA_V0 = 32768;
template <int MODE = 0>
__device__ __forceinline__ void mem_unit(LAS unsigned char* lds, const bf16* QM, const bf16* KVM, bf16* OM, const float* gq, int tb, int head, float Cl2, int tid) {
    const int lane = tid & 63, w = __builtin_amdgcn_readfirstlane(tid >> 6), hh = lane >> 5, l31 = lane & 31;
    const size_t trow = (size_t)tb * 256 + 32 * w + l31; const int b = tb >> 3;
    __syncthreads();
    bf16x8 qf[8];
    {   const bf16* qp = QM + trow * MEMW + head * 128 + 8 * hh;
#pragma unroll
        for (int s = 0; s < 8; ++s) qf[s] = *(const GAS bf16x8*)(qp + 16 * s);
        float ss = 0.f;
#pragma unroll
        for (int s = 0; s < 8; ++s)
#pragma unroll
            for (int j = 0; j < 8; ++j) { const float f = __builtin_bit_cast(float, (unsigned)(unsigned short)qf[s][j] << 16); ss += f * f; }
        ss += shx(ss, 32, lane);
        const float r = 0.12751743074602468f / sqrtf(ss * (1.f / 128.f) + EPS);
#pragma unroll
        for (int s = 0; s < 8; ++s) { const f32x4 g0 = *(const GAS f32x4*)(gq + 16 * s + 8 * hh), g1 = *(const GAS f32x4*)(gq + 16 * s + 8 * hh + 4);
            v4u o;
#pragma unroll
            for (int j = 0; j < 4; ++j) { const float f0 = __builtin_bit_cast(float, (unsigned)(unsigned short)qf[s][2 * j] << 16), f1 = __builtin_bit_cast(float, (unsigned)(unsigned short)qf[s][2 * j + 1] << 16);
                const float ga = (2 * j < 4) ? g0[2 * j] : g1[2 * j - 4], gb2 = (2 * j + 1 < 4) ? g0[2 * j + 1] : g1[2 * j + 1 - 4];
                o[j] = cvtpk(f0 * r * ga, f1 * r * gb2); }
            qf[s] = __builtin_bit_cast(bf16x8, o); }
    }
    int kread[8], vread[4];
#pragma unroll
    for (int s = 0; s < 8; ++s) kread[s] = l31 * 256 + (((2 * s + hh) ^ (l31 & 15)) * 16);
#pragma unroll
    for (int db = 0; db < 4; ++db) vread[db] = 65536 + (4 * hh + ((lane >> 2) & 3)) * 256 + ((db ^ ((lane >> 2) & 3)) * 64) + 32 * ((lane >> 4) & 1) + 8 * (lane & 3);
    f32x16 O[4];
#pragma unroll
    for (int db = 0; db < 4; ++db)
#pragma unroll
        for (int r = 0; r < 16; ++r) O[db][r] = 0.f;
    float lsum = 0.f;
    if (MODE != 1) {   const bf16* src = KVM + (size_t)b * NMEM * 1024 + head * 128;
#pragma unroll 1
        for (int half = 0; half < 2; ++half) {
            v4u st[8];
#pragma unroll
            for (int i = 0; i < 8; ++i) { const int c = tid + 512 * i, row = c >> 4, ch = c & 15; st[i] = *(const GAS v4u*)(src + (size_t)row * 1024 + 512 * half + ch * 8); }
#pragma unroll
            for (int i = 0; i < 8; ++i) { const int c = tid + 512 * i, row = c >> 4, ch = c & 15;
                const int off = half == 0 ? row * 256 + ((ch ^ (row & 15)) * 16) : 65536 + row * 256 + (((ch >> 2) ^ (row & 3)) * 64) + (ch & 3) * 16;
                *(LAS v4u*)(lds + off) = st[i]; }
        }
    }
    __syncthreads();
#define MA_SB __builtin_amdgcn_sched_barrier(0)
#define MA_LW(n) asm volatile("s_waitcnt lgkmcnt(" #n ")" ::: "memory")
#pragma unroll 1
    for (int t = 0; t < (MODE ? 0 : 4); ++t) {
        const lds_cptr kb_ = (lds_cptr)(lds + t * 16384), vb_ = (lds_cptr)(lds + t * 16384);
        f32x16 S0, S1;
#pragma unroll
        for (int r = 0; r < 16; ++r) { S0[r] = -Cl2; S1[r] = -Cl2; }
        bf16x8 a0[8], a1[4];
#pragma unroll
        for (int s = 0; s < 8; ++s) a0[s] = *(const LAS bf16x8*)(kb_ + kread[s]);
        MA_SB;
#pragma unroll
        for (int s = 0; s < 4; ++s) S0 = __builtin_amdgcn_mfma_f32_32x32x16_bf16(a0[s], qf[s], S0, 0, 0, 0);
        MA_SB;
#pragma unroll
        for (int s = 0; s < 4; ++s) a1[s] = *(const LAS bf16x8*)(kb_ + kread[s] + 8192);
        MA_SB;
#pragma unroll
        for (int s = 4; s < 8; ++s) S0 = __builtin_amdgcn_mfma_f32_32x32x16_bf16(a0[s], qf[s], S0, 0, 0, 0);
        MA_SB;
#pragma unroll
        for (int s = 0; s < 4; ++s) a0[s] = *(const LAS bf16x8*)(kb_ + kread[4 + s] + 8192);
        MA_SB;
#pragma unroll
        for (int s = 0; s < 4; ++s) S1 = __builtin_amdgcn_mfma_f32_32x32x16_bf16(a1[s], qf[s], S1, 0, 0, 0);
#pragma unroll
        for (int s = 0; s < 4; ++s) S1 = __builtin_amdgcn_mfma_f32_32x32x16_bf16(a0[s], qf[4 + s], S1, 0, 0, 0);
        MA_SB;
        s16x4 vf[2][4][2];
#define MA_VRD(ks) do { _Pragma("unroll") for (int db = 0; db < 4; ++db) { vf[(ks) & 1][db][0] = vtr(vb_ + vread[db] + (16 * (ks)) * 256); vf[(ks) & 1][db][1] = vtr(vb_ + vread[db] + (16 * (ks) + 8) * 256); } } while (0)
#define MA_PV(ks) do { _Pragma("unroll") for (int db = 0; db < 4; ++db) { const bf16x8 va = __builtin_shufflevector(vf[(ks) & 1][db][0], vf[(ks) & 1][db][1], 0, 1, 2, 3, 4, 5, 6, 7); \
            O[db] = __builtin_amdgcn_mfma_f32_32x32x16_bf16(va, pb[ks], O[db], 0, 0, 0); } } while (0)
        MA_VRD(0);
        MA_SB;
#pragma unroll
        for (int r = 0; r < 16; ++r) { S0[r] = __builtin_amdgcn_exp2f(S0[r]); S1[r] = __builtin_amdgcn_exp2f(S1[r]); lsum += S0[r] + S1[r]; }
        bf16x8 pb[4];
#pragma unroll
        for (int hf = 0; hf < 2; ++hf) {
            v4u a, c;
#pragma unroll
            for (int j = 0; j < 4; ++j) { a[j] = cvtpk(S0[8 * hf + 2 * j], S0[8 * hf + 2 * j + 1]); c[j] = cvtpk(S1[8 * hf + 2 * j], S1[8 * hf + 2 * j + 1]); }
            pb[hf] = __builtin_bit_cast(bf16x8, a); pb[2 + hf] = __builtin_bit_cast(bf16x8, c);
        }
        MA_SB;
        MA_LW(7); MA_VRD(1); MA_SB; MA_PV(0); MA_SB;
        MA_LW(7); MA_VRD(2); MA_SB; MA_PV(1); MA_SB;
        MA_LW(7); MA_VRD(3); MA_SB; MA_PV(2); MA_SB;
        MA_PV(3);
        MA_SB;
    }
#undef MA_VRD
#undef MA_PV
#undef MA_SB
#undef MA_LW
    lsum += shx(lsum, 32, lane);
    const float inv = MODE ? 1.f : 1.f / lsum;
    bf16* op = OM + trow * MEMW + head * 128 + 4 * hh;
#pragma unroll
    for (int db = 0; db < 4; ++db)
#pragma unroll
        for (int g4 = 0; g4 < 4; ++g4) { v2u o; o.x = cvtpk(O[db][4 * g4] * inv, O[db][4 * g4 + 1] * inv); o.y = cvtpk(O[db][4 * g4 + 2] * inv, O[db][4 * g4 + 3] * inv); *(GAS v2u*)(op + 32 * db + 8 * g4) = o; }
}

struct Args { const float* in[23]; float* out; unsigned char* ws; int ph_lo, ph_hi, use_bar, pad; };
#ifndef MK_OFF
#define MK_OFF 0u
#endif
#ifndef REP_ATT
#define REP_ATT 1
#endif
#ifndef REP_P0
#define REP_P0 1
#endif
#ifndef REP_U
#define REP_U 1
#endif
#ifndef REP_GEMM
#define REP_GEMM 1
#endif
#ifndef REP_NORM
#define REP_NORM 1
#endif
#ifndef REP_SEL
#define REP_SEL 1
#endif
#ifndef REP_MEM
#define REP_MEM 1
#endif
#define PHON(k) (!((MK_OFF >> (k)) & 1u))
#ifndef MK_REP
#define MK_REP 0
#endif
constexpr int PH_PER_LAYER = 9, PH_BASE = 2, N_PHASES = PH_BASE + DEPTH * PH_PER_LAYER;
constexpr int PTAB_OFF = LDSCTL_OFF + 1024;

__global__ void __launch_bounds__(NTHREADS, 2) mega(Args a) {
    extern __shared__ __attribute__((aligned(16))) unsigned char lds_raw[];
    LAS unsigned char* lds = (LAS unsigned char*)lds_raw;
    const int wave0_ = __builtin_amdgcn_readfirstlane((int)threadIdx.x >> 6);
    {   const int tid0 = threadIdx.x;
        for (int u = tid0; u < (LDS_BYTES - LDSCTL_OFF) / 4; u += NTHREADS) ((LAS unsigned*)(lds + LDSCTL_OFF))[u] = 0u;
        __syncthreads();
        if (tid0 < 23) ((LAS unsigned long long*)(lds + PTAB_OFF))[tid0] = (unsigned long long)a.in[tid0];
        if (tid0 == 23) ((LAS unsigned long long*)(lds + PTAB_OFF))[23] = (unsigned long long)a.out;
        if (tid0 == 24) ((LAS unsigned long long*)(lds + PTAB_OFF))[24] = (unsigned long long)a.ws;
        __syncthreads();
    }
    volatile LAS unsigned* MISC = (volatile LAS unsigned*)(lds + MISC_OFF);
    const int G = gridDim.x, bid = blockIdx.x, NGW = G * NWAVES;
    const int use_bar = a.use_bar;
    XcdBarrier bar; bar.bar = (unsigned*)(a.ws + WS_CTL) + CW_BAR; bar.x = 0; bar.st = MISC + 8;
    if (use_bar) bar = xcd_barrier_post((unsigned*)(a.ws + WS_CTL) + CW_BAR, MISC + 8);
    const int lo = a.ph_lo, hi = a.ph_hi;
#define IN(k) (lo <= (k) && (k) < hi)
#define SEAM(k) do { if (use_bar && IN(k) && IN((k) + 1)) xcd_barrier(bar); } while (0)
#define PHL() int tid_ = wave0_ * 64 + (int)__builtin_amdgcn_mbcnt_hi(~0u, __builtin_amdgcn_mbcnt_lo(~0u, 0u)); asm volatile("" : "+v"(tid_)); const int lane_ = tid_ & 63, wave_ = __builtin_amdgcn_readfirstlane(tid_ >> 6), gw_ = bid * NWAVES + wave_; (void)lane_; (void)gw_; \
              int pz_ = 0; asm volatile("" : "+s"(pz_))
#define PTR(i) ((const float*)ldptr(lds, (i) + pz_))
#define WSP() ((unsigned char*)ldptr(lds, 24 + pz_))
#define OUTP() ((float*)ldptr(lds, 23 + pz_))

    if (IN(0) && PHON(0)) {
        PHL(); unsigned char* ws = WSP();
        LAS float* scr = (LAS float*)(lds + RING_OFF + wave_ * 16384);
        constexpr int I_IN = 32 * 128, I_OUT = 32 * 64, I_MQ = 32 * 16, I_MKV = 32 * 32, I_MO = 8 * 64, I_PQ = 32 * 64, I_L = I_IN + I_OUT + I_MQ + I_MKV + I_MO + I_PQ;
        for (int it = gw_; it < DEPTH * I_L; it += NGW) {
            const int l = it / I_L; int r = it % I_L;
            if (r < I_IN) { transpose_item<true>(PTR(4) + (size_t)l * DM * DIN, DM, DIN, (bf16*)(ws + WS_WIN) + (size_t)l * DIN * DM, scr, r, lane_, PTR(3) + (size_t)l * DM); continue; } r -= I_IN;
            if (r < I_OUT) { transpose_item<false>(PTR(11) + (size_t)l * DM * DM, DM, DM, (bf16*)(ws + WS_WOUT) + (size_t)l * DM * DM, scr, r, lane_, PTR(10) + (size_t)l * DM); continue; } r -= I_OUT;
            if (r < I_MQ) { transpose_item<false>(PTR(14) + (size_t)l * DM * MEMW, DM, MEMW, (bf16*)(ws + WS_WMQ) + (size_t)l * MEMW * DM, scr, r, lane_, PTR(12) + (size_t)l * DM); continue; } r -= I_MQ;
            if (r < I_MKV) { transpose_item<false>(PTR(15) + (size_t)l * DM * 1024, DM, 1024, (bf16*)(ws + WS_WMKV) + (size_t)l * 1024 * DM, scr, r, lane_); continue; } r -= I_MKV;
            if (r < I_MO) { transpose_item<false>(PTR(17) + (size_t)l * MEMW * DM, MEMW, DM, (bf16*)(ws + WS_WMO) + (size_t)l * DM * MEMW, scr, r, lane_); continue; } r -= I_MO;
            transpose_item<false>(PTR(19) + (size_t)l * DM * DM, DM, DM, (bf16*)(ws + WS_WPQ) + (size_t)l * DM * DM, scr, r, lane_, PTR(18) + (size_t)l * DM);
        }
        const size_t gtid = (size_t)bid * NTHREADS + tid_, nth = (size_t)G * NTHREADS;
        convert_bf16(PTR(20), (bf16*)(ws + WS_PKEYS), (size_t)DEPTH * 8 * 2 * 128 * 128, gtid, nth);
        convert_int4_plain(PTR(21), ws + WS_PU, DEPTH * PEER_N, PU_SCALEI, PTR(18), gw_, NGW, lane_);
        convert_fp4_rows(PTR(22), ws + WS_PV, PEER_N, PV_SCALE4, nullptr, gw_, NGW, lane_);
        {   const float* x0 = PTR(0); bf16* XN = (bf16*)(ws + WS_XN); u64_t* rsq = (u64_t*)(ws + WS_ROWSQ);
            for (int m = 2 * gw_; m < T; m += 2 * NGW) prep_rows2(x0 + (size_t)m * DM, XN + (size_t)m * DM, rsq + m, ws + WS_XN8 + (size_t)m * DM, (float*)(ws + WS_XSC) + m, lane_); }
        {   const float* mem = PTR(1); const float* gkv = PTR(13); bf16* MEMN = (bf16*)(ws + WS_MEMN);
            for (int m = gw_; m < BATCH * NMEM; m += NGW)
                rms_row_to_bf16(mem + (size_t)m * DM, gkv, MEMN + (size_t)m * DM, gkv + DM, MEMN + (size_t)(BATCH * NMEM + m) * DM, lane_); }
        float* rope = (float*)(ws + WS_ROPE); float* biasA = (float*)(ws + WS_BIASA);
        if (gtid < 64 * 16) { const int pos = (int)gtid >> 4, i = (int)gtid & 15; const float ang = (float)pos * ROPE_INV[i]; rope[gtid * 2] = cosf(ang); rope[gtid * 2 + 1] = sinf(ang); }
        if (gtid < 12 * 257) { const int h = (int)gtid / 257, rel = (int)gtid % 257 - 128; biasA[gtid] = PTR(2)[t5_bucket(rel) * 12 + h]; }
    }
    SEAM(0);
    if (IN(1) && PHON(1)) {
        {   PHL(); unsigned char* ws = WSP();
            for (int r = gw_; r < DEPTH * DIN; r += NGW) { const int rr = r & (DIN - 1), src = (rr & ~255) + 64 * ((rr >> 5) & 3) + 32 * ((rr >> 7) & 1) + (rr & 31);
                quant_wrow((const bf16*)(ws + WS_WIN) + (size_t)r * DM, ws + WS_WIN8 + (size_t)r * DM, (float*)(ws + WS_WSC) + (r & ~(DIN - 1)) + src, lane_); }
            for (int r = gw_; r < DEPTH * DM; r += NGW) quant_wrow((const bf16*)(ws + WS_WOUT) + (size_t)r * DM, ws + WS_WOUT8 + (size_t)r * DM, (float*)(ws + WS_WSCO) + r, lane_);
            for (int r = gw_; r < DEPTH * DM; r += NGW) quant_wrow((const bf16*)(ws + WS_WPQ) + (size_t)r * DM, ws + WS_WPQ8 + (size_t)r * DM, (float*)(ws + WS_WSCP) + r, lane_);
            for (int r = gw_; r < DEPTH * MEMW; r += NGW) quant_wrow((const bf16*)(ws + WS_WMQ) + (size_t)r * DM, ws + WS_WMQ8 + (size_t)r * DM, (float*)(ws + WS_WSCM) + r, lane_); }
#pragma unroll 1
        for (int l = 0; l < DEPTH; ++l) {
            PHL(); unsigned char* ws = WSP();
            pg8::Gemm g{(bf16*)(ws + WS_MEMN) + (size_t)l * BATCH * NMEM * DM, (bf16*)(ws + WS_WMKV) + (size_t)l * 1024 * DM, BATCH * NMEM, 1024, DM};
            OffsetOrder S; S.init(BATCH * NMEM, 1024, G, bid, 64 * l);
            bf16* KVMl = (bf16*)(ws + WS_KVM) + (size_t)l * BATCH * NMEM * 1024;
            pg8::EpiBf16<0> E{KVMl, 1024, nullptr, 0, 0, 1.f};
            pg8::gemm_phase<pg8::EpiBf16<0>, OffsetOrder, true, true>(lds + RING_OFF, g, S, E, tid_);
            VM_WAIT(); __syncthreads();
            const float* gk = PTR(16) + (size_t)l * 256 + 128;
#pragma unroll 1
            for (int i = 0; i < 4; ++i) { pg8::Unit uu; uu.pm = 0; uu.pn = 0; if (!S.next(i, uu)) break;
                if (uu.pn < 2) {
                    for (int r2 = wave_; r2 < 128; r2 += NWAVES) { const int row = uu.pm * 256 + 2 * r2 + (lane_ >> 5), cl = lane_ & 31;
                        GAS v4u* p = (GAS v4u*)(KVMl + (size_t)row * 1024 + 256 * uu.pn + 8 * cl);
                        const v4u w = *p;
                        float f[8] = {bflo(w.x), bfhi(w.x), bflo(w.y), bfhi(w.y), bflo(w.z), bfhi(w.z), bflo(w.w), bfhi(w.w)};
                        float ss = 0.f;
#pragma unroll
                        for (int e = 0; e < 8; ++e) ss += f[e] * f[e];
                        ss += shx(ss, 1, lane_); ss += shx(ss, 2, lane_); ss += shx(ss, 4, lane_); ss += shx(ss, 8, lane_);
                        const float r = 1.f / sqrtf(ss * (1.f / 128.f) + EPS);
                        const float* gg = gk + 8 * (cl & 15);
                        v4u o; o.x = pk2(f[0] * r * gg[0], f[1] * r * gg[1]); o.y = pk2(f[2] * r * gg[2], f[3] * r * gg[3]); o.z = pk2(f[4] * r * gg[4], f[5] * r * gg[5]); o.w = pk2(f[6] * r * gg[6], f[7] * r * gg[7]);
                        *p = o; } } }
            __syncthreads();
        }
        if (G >= 256 && bid >= 128) { PHL(); unsigned char* ws = WSP();
            convert_fp4_rows(PTR(22) + (size_t)PEER_N * DM, ws + WS_PV + (size_t)PEER_N * 1024, PEER_N, PV_SCALE4, nullptr, (bid - 128) * NWAVES + wave_, (G - 128) * NWAVES, lane_); }
        else if (G < 256) { PHL(); unsigned char* ws = WSP(); convert_fp4_rows(PTR(22) + (size_t)PEER_N * DM, ws + WS_PV + (size_t)PEER_N * 1024, PEER_N, PV_SCALE4, nullptr, gw_, NGW, lane_); }
    }
    SEAM(1);

#pragma unroll 1
    for (int l = 0; l < DEPTH; ++l) {
        const int pb = PH_BASE + PH_PER_LAYER * l;
        if (IN(pb + 0) && PHON(3)) { PHL(); unsigned char* ws = WSP();
            pg8::Gemm g{(bf16*)(ws + WS_XN8), (bf16*)(ws + WS_WIN8 + (size_t)l * DIN * DM), T, DIN, DM / 2}; pg8::StaticOrder S; S.init(T, DIN, G, bid);
            LAS float* ropel = (LAS float*)(lds + LDSCTL_OFF + 2048);
            for (int i = tid_; i < 64 * 16 * 2; i += NTHREADS) ropel[i] = ((const float*)(ws + WS_ROPE))[i];
            __syncthreads();
            pg8::EpiQKV E{(bf16*)(ws + WS_QKV), PTR(5) + (size_t)l * 128, PTR(7) + (size_t)l * 128, PTR(9) + (size_t)l * 128, ropel, (const u64_t*)(ws + WS_ROWSQ) + (size_t)(l * 3 + 0) * T, (const float*)(ws + WS_XSC), (const float*)(ws + WS_WSC) + (size_t)l * DIN};
            pg8::gemm_phase<pg8::EpiQKV, pg8::StaticOrder, true, true>(lds + RING_OFF, g, S, E, tid_);
        }
        SEAM(pb + 0);
        if (IN(pb + 1) && PHON(4)) { PHL(); unsigned char* ws = WSP();
            const float* sink = PTR(6) + (size_t)l * 12; const float* rpb = PTR(8) + (size_t)l * 8 * 15 * 31; const float* biasA = (const float*)(ws + WS_BIASA);
            const bf16* QKV = (const bf16*)(ws + WS_QKV); bf16* ATT = (bf16*)(ws + WS_ATT);
            const float* ga = PTR(5) + (size_t)l * 128; const float* gb = PTR(7) + (size_t)l * 128; const float* gc = PTR(9) + (size_t)l * 128;
            const float CaL2 = 8.f * wave_max(fabsf(ga[lane_]), lane_) * wave_max(fabsf(ga[64 + lane_]), lane_) * LOG2E;
            const float CbL2 = 8.f * wave_max(fabsf(gb[lane_]), lane_) * wave_max(fabsf(gb[64 + lane_]), lane_) * LOG2E;
            const float CcL2 = 8.f * wave_max(fabsf(gc[lane_]), lane_) * wave_max(fabsf(gc[64 + lane_]), lane_) * LOG2E;
            const int vc = (G % 8 == 0) ? (bid % 8) * (G / 8) + bid / 8 : bid;
            u64_t* mixsq = (u64_t*)(ws + WS_MIXSQ) + (size_t)l * 3 * T;
            for (int u = vc; u < BATCH * 12 * 8; u += G) attn_unit<2>(lds, QKV, ATT, mixsq + 2 * (size_t)T, u / 96, (u >> 3) % 12, u & 7, nullptr, CcL2, 0.f, tid_);
            for (int u = vc; u < BATCH * 8 * 8; u += G) attn_unit<1>(lds, QKV, ATT, mixsq + (size_t)T, u >> 6, (u >> 3) & 7, u & 7, rpb, CbL2, 0.f, tid_);
            for (int u = vc; u < BATCH * 12 * 8; u += G) { const int head = (u >> 3) % 12; attn_unit<0>(lds, QKV, ATT, mixsq, u / 96, head, u & 7, biasA, CaL2, sink[head] * LOG2E, tid_); }
        }
        SEAM(pb + 1);
        if (IN(pb + 2) && PHON(5)) { PHL(); unsigned char* ws = WSP();
            const u64_t* mixsq = (const u64_t*)(ws + WS_MIXSQ) + (size_t)l * 3 * T;
            for (int r = 4 * gw_; r < T; r += 4 * NGW) att_quant_rows<4>((const bf16*)(ws + WS_ATT), mixsq, ws + WS_ATT8, (float*)(ws + WS_XSC2), r, lane_);
        }
        SEAM(pb + 2);
        if (IN(pb + 3) && PHON(5)) { PHL(); unsigned char* ws = WSP();
            pg8::Gemm g{(bf16*)(ws + WS_ATT8), (bf16*)(ws + WS_WOUT8 + (size_t)l * DM * DM), T, DM, DM / 2}; pg8::StaticOrder S; S.init(T, DM, G, bid);
            typedef pg8::EpiResidT<true, 10> EpiX1;
            EpiX1 E{(bf16*)(ws + WS_XN), DM, (u64_t*)(ws + WS_ROWSQ) + (size_t)(l * 3 + 1) * T, (const float*)(ws + WS_XSC2), (const float*)(ws + WS_WSCO) + (size_t)l * DM, ws + WS_X8, (const u64_t*)(ws + WS_ROWSQ) + (size_t)(l * 3 + 0) * T, nullptr, nullptr};
            pg8::gemm_phase<EpiX1, pg8::StaticOrder, true, true>(lds + RING_OFF, g, S, E, tid_);
        }
        SEAM(pb + 3);
        if (IN(pb + 4) && PHON(6)) { PHL(); unsigned char* ws = WSP();
            pg8::Gemm g{(bf16*)(ws + WS_X8), (bf16*)(ws + WS_WMQ8 + (size_t)l * MEMW * DM), T, MEMW, DM / 2}; pg8::StaticOrder S; S.init(T, MEMW, G, bid);
            pg8::EpiBf16Row8<10> E{(bf16*)(ws + WS_QM), MEMW, (const u64_t*)(ws + WS_ROWSQ) + (size_t)(l * 3 + 1) * T, (const u64_t*)(ws + WS_ROWSQ) + (size_t)(l * 3 + 0) * T, (const float*)(ws + WS_WSCM) + (size_t)l * MEMW};
            pg8::gemm_phase<pg8::EpiBf16Row8<10>, pg8::StaticOrder, true, true>(lds + RING_OFF, g, S, E, tid_);
            VM_WAIT(); __syncthreads();
            const bf16* kvm = (const bf16*)(ws + WS_KVM) + (size_t)l * BATCH * NMEM * 1024; const float* gq = PTR(16) + (size_t)l * 256;
            const float CmL2 = 11.313708498984761f * wave_max(fmaxf(fabsf(gq[lane_]), fabsf(gq[64 + lane_])), lane_) * wave_max(fmaxf(fabsf(gq[128 + lane_]), fabsf(gq[192 + lane_])), lane_) * LOG2E;
#pragma unroll 1
            for (int i = 0; i < 4; ++i) { pg8::Unit uu; uu.pm = 0; uu.pn = 0; if (!S.next(i, uu)) break;
                int nrep_ = (MK_REP == 1) ? 4 : 2; asm volatile("" : "+s"(nrep_));
#pragma unroll 1
                for (int hr = 0; hr < nrep_; ++hr) mem_unit(lds, (const bf16*)(ws + WS_QM), kvm, (bf16*)(ws + WS_OM), gq, uu.pm, 2 * uu.pn + (hr & 1), CmL2, tid_);
#if MK_REP == 4 || MK_REP == 5
                mem_unit<MK_REP - 3>(lds, (const bf16*)(ws + WS_QM), kvm, (bf16*)(ws + WS_QKV), gq, uu.pm, 2 * uu.pn, CmL2, tid_); mem_unit<MK_REP - 3>(lds, (const bf16*)(ws + WS_QM), kvm, (bf16*)(ws + WS_QKV), gq, uu.pm, 2 * uu.pn + 1, CmL2, tid_);
#endif
            }
        }
        SEAM(pb + 4);
        if (IN(pb + 5) && PHON(7)) { PHL(); unsigned char* ws = WSP();
            pg8::Gemm g{(bf16*)(ws + WS_OM), (bf16*)(ws + WS_WMO) + (size_t)l * DM * MEMW, T, DM, MEMW}; pg8::StaticOrder S; S.init(T, DM, G, bid);
            typedef pg8::EpiResidT<false, 8, true> EpiX2;
            EpiX2 E{(bf16*)(ws + WS_XN), DM, (u64_t*)(ws + WS_ROWSQ) + (size_t)(l * 3 + 2) * T, nullptr, nullptr, ws + WS_X8, (const u64_t*)(ws + WS_ROWSQ) + (size_t)(l * 3 + 1) * T, ws + WS_XQH, ws + WS_XQL};
            pg8::gemm_phase<EpiX2, pg8::StaticOrder, true, true>(lds + RING_OFF, g, S, E, tid_);
        }
        SEAM(pb + 5);
        if (IN(pb + 6) && PHON(8)) { PHL(); unsigned char* ws = WSP();
            pg8::Gemm g{(bf16*)(ws + WS_X8), (bf16*)(ws + WS_WPQ8 + (size_t)l * DM * DM), T, DM, DM / 2}; pg8::StaticOrder S; S.init(T, DM, G, bid);
            pg8::EpiBf16Row8<8> E{(bf16*)(ws + WS_QP), DM, (const u64_t*)(ws + WS_ROWSQ) + (size_t)(l * 3 + 2) * T, (const u64_t*)(ws + WS_ROWSQ) + (size_t)(l * 3 + 1) * T, (const float*)(ws + WS_WSCP) + (size_t)l * DM};
            pg8::gemm_phase<pg8::EpiBf16Row8<8>, pg8::StaticOrder, true, true>(lds + RING_OFF, g, S, E, tid_);
            VM_WAIT(); __syncthreads();
            const bf16* pk = (const bf16*)(ws + WS_PKEYS) + (size_t)l * 8 * 2 * 128 * 128;
#pragma unroll 1
            for (int i = 0; i < 8; ++i) { pg8::Unit uu; uu.pm = 0; uu.pn = 0; if (!S.next(i, uu)) break;
                peer_select_unit((const bf16*)(ws + WS_QP), pk, (int*)(ws + WS_PIDX), (float*)(ws + WS_PGATE), uu.pm, uu.pn, wave_, lane_, lds + RING_OFF);
#if MK_REP == 2
                peer_select_unit((const bf16*)(ws + WS_QP), pk, (int*)(ws + WS_PIDX), (float*)(ws + WS_PGATE), uu.pm, uu.pn, wave_, lane_, lds + RING_OFF);
#endif
#if MK_REP == 3
#endif
            }
        }
        SEAM(pb + 6);
        if (IN(pb + 7) && PHON(9)) { PHL(); unsigned char* ws = WSP();
            peer_u_phase_i4((const unsigned*)(ws + WS_XQH), (const unsigned*)(ws + WS_XQL), ws + WS_PU + (size_t)l * PEER_N * 1024, (const int*)(ws + WS_PIDX), (int*)(ws + WS_PARTI), bid, G, wave_, lane_); }
        SEAM(pb + 7);
        if (IN(pb + 8) && PHON(10)) { PHL(); unsigned char* ws = WSP();
            peer_v_pass((bf16*)(ws + WS_XN), ws + WS_PV + (size_t)l * PEER_N * 1024, (const int*)(ws + WS_PIDX), (const float*)(ws + WS_PGATE), (const int*)(ws + WS_PARTI), (l + 1 == DEPTH) ? OUTP() : (float*)nullptr,
                        (l + 1 < DEPTH) ? (u64_t*)(ws + WS_ROWSQ) + (size_t)((l + 1) * 3 + 0) * T : (u64_t*)nullptr, (l + 1 < DEPTH) ? ws + WS_XN8 : (unsigned char*)nullptr, (float*)(ws + WS_XSC), (const u64_t*)(ws + WS_ROWSQ) + (size_t)(l * 3 + 1) * T, (const u64_t*)(ws + WS_ROWSQ) + (size_t)(l * 3 + 2) * T, (LAS float*)(lds + RING_OFF + wave_ * 1024), gw_, NGW, lane_); }
        SEAM(pb + 8);
    }
#undef IN
#undef SEAM
}

#ifndef MK_MULTI_LAUNCH
#define MK_MULTI_LAUNCH 0
#endif
extern "C" void kernel_launch(void* const* d_in, const int* in_sizes, int n_in, void* d_out, int out_size, void* d_ws, size_t ws_size, hipStream_t stream) {
    static int grid = 0;
    if (grid == 0) {
        if (n_in != 23 || out_size != T * DM || ws_size < WS_END) { fprintf(stderr, "kernel_launch: unexpected shapes (n_in %d, out %d, ws %zu)\n", n_in, out_size, ws_size); grid = -1; return; }
        int dev = 0, cus = 0, per_cu = 0;
        if (hipGetDevice(&dev) != hipSuccess || hipDeviceGetAttribute(&cus, hipDeviceAttributeMultiprocessorCount, dev) != hipSuccess) { grid = -1; return; }
        if (hipFuncSetAttribute((const void*)mega, hipFuncAttributeMaxDynamicSharedMemorySize, LDS_BYTES) != hipSuccess) { fprintf(stderr, "kernel_launch: hipFuncSetAttribute failed\n"); grid = -1; return; }
        if (hipOccupancyMaxActiveBlocksPerMultiprocessor(&per_cu, (const void*)mega, NTHREADS, LDS_BYTES) != hipSuccess || per_cu < 1) { fprintf(stderr, "kernel_launch: occupancy query says %d\n", per_cu); }
        (void)hipGetLastError();
        grid = cus;
    }
    if (grid < 0) return;
    (void)hipMemsetAsync((char*)d_ws + WS_CTL, 0, CTL_ZERO_BYTES, stream);
    (void)hipMemsetAsync((char*)d_ws + WS_MIXSQ, 0, MIXSQ_BYTES, stream);
    Args a{};
    for (int i = 0; i < 23; ++i) a.in[i] = (const float*)d_in[i];
    a.out = (float*)d_out; a.ws = (unsigned char*)d_ws;
#if MK_MULTI_LAUNCH
    for (int p = 0; p < N_PHASES; ++p) { a.ph_lo = p; a.ph_hi = p + 1; a.use_bar = 0; a.pad = 0; hipLaunchKernelGGL(mega, dim3(grid), dim3(NTHREADS), LDS_BYTES, stream, a); }
#else
    a.ph_lo = 0; a.ph_hi = N_PHASES; a.use_bar = 1; a.pad = 0;
    hipLaunchKernelGGL(mega, dim3(grid), dim3(NTHREADS), LDS_BYTES, stream, a);
#endif
    const hipError_t le = hipPeekAtLastError();
    if (le != hipSuccess) fprintf(stderr, "kernel_launch: launch failed: %s\n", hipGetErrorName(le));
}
```

```cpp
#include <hip/hip_runtime.h>
#include <cstdio>
#include <cstdint>
#include <cmath>
__device__ __forceinline__ float shx(float v, int k, int lane);
typedef unsigned long long u64_t;
__device__ __forceinline__ float rowsq_rs(const u64_t* rowsq, int row) { return 1.0f / sqrtf((float)*(const __attribute__((address_space(1))) u64_t*)(rowsq + row) * (5.9604644775390625e-08f / 2048.0f) + 1e-6f); }
__device__ __forceinline__ u64_t rowsq_fx(float ss) { return (u64_t)(ss * 16777216.0f + 0.5f); }
template <int HI = 255>
__device__ __forceinline__ unsigned q8x4c(float a, float b, float c, float d, float inv) {
    unsigned w = 0;
    w = __builtin_amdgcn_cvt_pk_u8_f32(__builtin_rintf(__builtin_amdgcn_fmed3f(__builtin_fmaf(a, inv, 128.f), 1.f, (float)HI)), 0, w); w = __builtin_amdgcn_cvt_pk_u8_f32(__builtin_rintf(__builtin_amdgcn_fmed3f(__builtin_fmaf(b, inv, 128.f), 1.f, (float)HI)), 1, w);
    w = __builtin_amdgcn_cvt_pk_u8_f32(__builtin_rintf(__builtin_amdgcn_fmed3f(__builtin_fmaf(c, inv, 128.f), 1.f, (float)HI)), 2, w); w = __builtin_amdgcn_cvt_pk_u8_f32(__builtin_rintf(__builtin_amdgcn_fmed3f(__builtin_fmaf(d, inv, 128.f), 1.f, (float)HI)), 3, w);
    return w ^ 0x80808080u;
}
__device__ __forceinline__ unsigned dig_lo4(unsigned d) { return d & 0x0f0f0f0fu; }
__device__ __forceinline__ unsigned dig_hi4(unsigned d) { const unsigned t = ((d & 0x7f7f7f7fu) + 0x08080808u) ^ (d & 0x80808080u); return (t >> 4) & 0x0f0f0f0fu; }
__device__ __forceinline__ unsigned nib_pack8(unsigned a, unsigned b) { a = (a | (a >> 4)) & 0x00ff00ffu; a = (a | (a >> 8)) & 0xffffu; b = (b | (b >> 4)) & 0x00ff00ffu; b = (b | (b >> 8)) & 0xffffu; return a | (b << 16); }
namespace pg8 {
#define PG8_LAS __attribute__((address_space(3)))
#define PG8_GAS __attribute__((address_space(1)))
typedef unsigned short bf16_t;
typedef short bf16x8 __attribute__((ext_vector_type(8)));
typedef float f32x4 __attribute__((ext_vector_type(4)));
typedef unsigned u32x4 __attribute__((ext_vector_type(4)));
constexpr int BM = 256, BK = 64, HALF = 128, HTB = HALF * BK * 2  , STAGE_BYTES = 8 * HTB, NXCD = 8, WGM = 8;

__host__ __device__ __forceinline__ int lds_byte(int r, int c) { const int st = (r >> 4) * 2 + (c >> 5), rr = r & 15, cc = c & 31, ob = rr * 64 + cc * 2; return st * 1024 + (ob ^ (((ob >> 9) & 1) << 5)); }
__host__ __device__ __forceinline__ void stage_rc(int b, int& R, int& C) { const int st = b / 1024, sb = b % 1024, swz = sb ^ (((sb >> 9) & 1) << 5); R = (st >> 1) * 16 + swz / 64; C = (st & 1) * 32 + (swz % 64) / 2; }
__host__ __device__ __forceinline__ int perm32(int rho) { const int n = rho >> 4, i = rho & 15; return 8 * (i >> 2) + 4 * n + (i & 3); }

struct Unit { int pm, pn; };
struct Gemm { const bf16_t* A; const bf16_t* Bt; int M, N, K; };

struct StaticOrder {
    int nM, nN, nwg, G, c;
    __host__ __device__ __forceinline__ void init(int M, int N, int G_, int c_) { nM = M / BM; nN = N / BM; nwg = nM * nN; G = G_; c = c_; }
    __host__ __device__ __forceinline__ bool next(int i, Unit& u) const {
        const long L = (long)i * G + c; if (L >= nwg) return false;
        int wgid = (int)L; { const int q = nwg / NXCD, r = nwg % NXCD, xcd = wgid % NXCD, off = wgid / NXCD; wgid = (xcd < r ? xcd * (q + 1) : r * (q + 1) + (xcd - r) * q) + off; }
        const int nig = WGM * nN, gid = wgid / nig, fm = gid * WGM, gsz = (nM - fm) < WGM ? (nM - fm) : WGM;
        u.pm = fm + ((wgid % nig) % gsz); u.pn = (wgid % nig) / gsz; return true;
    }
    __device__ __forceinline__ void a_ready(const Unit&) const {}
    __device__ __forceinline__ void done(const Unit&) const {}
};

__device__ __forceinline__ unsigned cvt_pk_bf16(float lo, float hi) { unsigned r; asm volatile("v_cvt_pk_bf16_f32 %0, %1, %2" : "=v"(r) : "v"(lo), "v"(hi)); return r; }
typedef float f32x2 __attribute__((ext_vector_type(2)));
__device__ __forceinline__ f32x2 gelu_pk(f32x2 v) {
    const f32x2 av = __builtin_elementwise_abs(v), d = av * 0.2316418882f + 1.0f;
    f32x2 t; t.x = __builtin_amdgcn_rcpf(d.x); t.y = __builtin_amdgcn_rcpf(d.y);
    f32x2 q = t * 0.5307027145f + (-0.7265760135f); q = q * t + 0.7107068705f; q = q * t + (-0.142248368f); q = q * t + 0.127414796f; q = q * t;
    const f32x2 s = (v * v) * (-0.72134752044f);
    f32x2 e; e.x = __builtin_amdgcn_exp2f(s.x); e.y = __builtin_amdgcn_exp2f(s.y);
    const f32x2 m = v * (q * e), r = v - m;
    f32x2 o; o.x = v.x < 0.f ? m.x : r.x; o.y = v.y < 0.f ? m.y : r.y; return o;
}

template <int ACT  > struct EpiBf16 {
    static constexpr bool PERM = true, AFTER_DRAIN = false, KSCALE = false, I8 = false; static_assert(ACT == 0 || ACT == 1, "EpiBf16: ACT is 0 (none) or 1 (gelu_pk)");
    bf16_t* O; int ldc; const float* bias; int split_cols; size_t split_stride; float scale0;
    __device__ __forceinline__ void operator()(const f32x4 (&acc)[2][2][4][2], const Unit& u, int wr, int wc, int fr, int fq) const {
        const int row0 = u.pm * BM + wr * 64 + fr; int colt = u.pn * BM; bf16_t* base = O;
        float sc = 1.f; if (split_cols) { const int t = colt / split_cols; base += (size_t)t * split_stride; colt -= t * split_cols; if (t == 0) sc = scale0; }
        const int col0 = colt + wc * 32 + 8 * fq, bcol0 = u.pn * BM + wc * 32 + 8 * fq;
        f32x4 bv[2][2];
#pragma unroll
        for (int bj = 0; bj < 2; ++bj)
#pragma unroll
            for (int n = 0; n < 2; ++n) bv[bj][n] = bias ? *(const PG8_GAS f32x4*)(bias + bcol0 + bj * HALF + 4 * n) : (f32x4){0.f, 0.f, 0.f, 0.f};
#pragma unroll
        for (int ai = 0; ai < 2; ++ai)
#pragma unroll
            for (int m = 0; m < 4; ++m) { bf16_t* rowp = base + (size_t)(row0 + ai * HALF + m * 16) * ldc + col0;
#pragma unroll
                for (int bj = 0; bj < 2; ++bj) { f32x4 v0 = acc[ai][bj][m][0] + bv[bj][0], v1 = acc[ai][bj][m][1] + bv[bj][1];
                    if (ACT == 1) { f32x2 a = gelu_pk((f32x2){v0[0], v0[1]}), b = gelu_pk((f32x2){v0[2], v0[3]}), c = gelu_pk((f32x2){v1[0], v1[1]}), d = gelu_pk((f32x2){v1[2], v1[3]});
                        v0 = (f32x4){a.x, a.y, b.x, b.y}; v1 = (f32x4){c.x, c.y, d.x, d.y}; }
                    v0 = v0 * sc; v1 = v1 * sc; u32x4 w; w.x = cvt_pk_bf16(v0[0], v0[1]); w.y = cvt_pk_bf16(v0[2], v0[3]); w.z = cvt_pk_bf16(v1[0], v1[1]); w.w = cvt_pk_bf16(v1[2], v1[3]);
                    *(PG8_GAS u32x4*)(rowp + bj * HALF) = w; } }
    }
};

typedef unsigned u32x2 __attribute__((ext_vector_type(2)));
typedef int i32x4 __attribute__((ext_vector_type(4)));
struct EpiResid {
    static constexpr bool PERM = false, AFTER_DRAIN = false, KSCALE = false, I8 = false;
    bf16_t* s; int ldc; u64_t* rowsq;
    __device__ __forceinline__ void operator()(const f32x4 (&acc)[2][2][4][2], const Unit& u, int wr, int wc, int fr, int fq) const {
        const int col0 = u.pn * BM + wc * 32 + 4 * fq;
#pragma unroll
        for (int ai = 0; ai < 2; ++ai)
#pragma unroll
            for (int m = 0; m < 4; ++m) { const int row = u.pm * BM + ai * HALF + wr * 64 + m * 16 + fr; bf16_t* sp = s + (size_t)row * ldc + col0; float ss = 0.f;
                u32x2 in[2][2];
#pragma unroll
                for (int bj = 0; bj < 2; ++bj)
#pragma unroll
                    for (int n = 0; n < 2; ++n) in[bj][n] = *(const PG8_GAS u32x2*)(sp + bj * HALF + n * 16);
#pragma unroll
                for (int bj = 0; bj < 2; ++bj)
#pragma unroll
                    for (int n = 0; n < 2; ++n) { const u32x2 w0 = in[bj][n];
                        const f32x4 bs = (f32x4){__builtin_bit_cast(float, w0.x << 16), __builtin_bit_cast(float, w0.x & 0xffff0000u), __builtin_bit_cast(float, w0.y << 16), __builtin_bit_cast(float, w0.y & 0xffff0000u)};
                        const f32x4 o = bs + acc[ai][bj][m][n]; ss += (o[0] * o[0] + o[1] * o[1]) + (o[2] * o[2] + o[3] * o[3]);
                        u32x2 w; w.x = cvt_pk_bf16(o[0], o[1]); w.y = cvt_pk_bf16(o[2], o[3]); *(PG8_GAS u32x2*)(sp + bj * HALF + n * 16) = w; }
                ss += shx(ss, 16, fr + 16 * fq); ss += shx(ss, 32, fr + 16 * fq);
                if (fq == 0) (void)__hip_atomic_fetch_add((PG8_GAS u64_t*)(rowsq + row), rowsq_fx(ss), __ATOMIC_RELAXED, __HIP_MEMORY_SCOPE_AGENT); }
    }
};
struct EpiResid8 {
    static constexpr bool PERM = false, AFTER_DRAIN = false, KSCALE = false, I8 = true;
    bf16_t* s; int ldc; u64_t* rowsq; const float* xsc; const float* wsc;
    __device__ __forceinline__ void operator()(const f32x4 (&acc)[2][2][4][2], const Unit& u, int wr, int wc, int fr, int fq) const {
        const int col0 = u.pn * BM + wc * 32 + 4 * fq;
#pragma unroll
        for (int ai = 0; ai < 2; ++ai)
#pragma unroll
            for (int m = 0; m < 4; ++m) { const int row = u.pm * BM + ai * HALF + wr * 64 + m * 16 + fr; bf16_t* sp = s + (size_t)row * ldc + col0; float ss = 0.f; const float xs = *(const PG8_GAS float*)(xsc + row);
                u32x2 in[2][2];
#pragma unroll
                for (int bj = 0; bj < 2; ++bj)
#pragma unroll
                    for (int n = 0; n < 2; ++n) in[bj][n] = *(const PG8_GAS u32x2*)(sp + bj * HALF + n * 16);
#pragma unroll
                for (int bj = 0; bj < 2; ++bj)
#pragma unroll
                    for (int n = 0; n < 2; ++n) { const u32x2 w0 = in[bj][n]; const i32x4 ia = __builtin_bit_cast(i32x4, acc[ai][bj][m][n]);
                        const f32x4 bs = (f32x4){__builtin_bit_cast(float, w0.x << 16), __builtin_bit_cast(float, w0.x & 0xffff0000u), __builtin_bit_cast(float, w0.y << 16), __builtin_bit_cast(float, w0.y & 0xffff0000u)};
                        const f32x4 o = bs + (f32x4){(float)ia[0], (float)ia[1], (float)ia[2], (float)ia[3]} * *(const PG8_GAS f32x4*)(wsc + col0 + bj * HALF + n * 16) * xs; ss += (o[0] * o[0] + o[1] * o[1]) + (o[2] * o[2] + o[3] * o[3]);
                        u32x2 w; w.x = cvt_pk_bf16(o[0], o[1]); w.y = cvt_pk_bf16(o[2], o[3]); *(PG8_GAS u32x2*)(sp + bj * HALF + n * 16) = w; }
                ss += shx(ss, 16, fr + 16 * fq); ss += shx(ss, 32, fr + 16 * fq);
                if (fq == 0) (void)__hip_atomic_fetch_add((PG8_GAS u64_t*)(rowsq + row), rowsq_fx(ss), __ATOMIC_RELAXED, __HIP_MEMORY_SCOPE_AGENT); }
    }
};
template <bool I8IN, int QOUT, bool DIG = false>
struct EpiResidT {
    static constexpr bool PERM = true, AFTER_DRAIN = false, KSCALE = false, I8 = I8IN;
    bf16_t* s; int ldc; u64_t* rowsq; const float* xsc; const float* wsc; unsigned char* q8; const u64_t* rowsq_prev; unsigned char* dgh; unsigned char* dgl;
    __device__ __forceinline__ void operator()(const f32x4 (&acc)[2][2][4][2], const Unit& u, int wr, int wc, int fr, int fq) const {
        const int col0 = u.pn * BM + wc * 32 + 8 * fq, rowb = u.pm * BM + wr * 64 + fr;
        f32x4 wv[2][2];
        if constexpr (I8IN) {
#pragma unroll
            for (int bj = 0; bj < 2; ++bj) { wv[bj][0] = *(const PG8_GAS f32x4*)(wsc + col0 + bj * HALF); wv[bj][1] = *(const PG8_GAS f32x4*)(wsc + col0 + bj * HALF + 4); } }
#pragma unroll
        for (int ai = 0; ai < 2; ++ai) {
            u32x4 in[4][2]; float xs[4], qv[4];
#pragma unroll
            for (int m = 0; m < 4; ++m) { const int row = rowb + ai * HALF + m * 16; const bf16_t* sp = s + (size_t)row * ldc + col0;
#pragma unroll
                for (int bj = 0; bj < 2; ++bj) in[m][bj] = *(const PG8_GAS u32x4*)(sp + bj * HALF);
                if constexpr (I8IN) xs[m] = *(const PG8_GAS float*)(xsc + row); else xs[m] = 1.f;
                if constexpr (QOUT > 0) qv[m] = (127.0f / QOUT) * rowsq_rs(rowsq_prev, row); else qv[m] = 0.f; }
            __builtin_amdgcn_sched_barrier(0);
#pragma unroll
            for (int m = 0; m < 4; ++m) { const int row = rowb + ai * HALF + m * 16; bf16_t* sp = s + (size_t)row * ldc + col0; float ss = 0.f;
#pragma unroll
                for (int bj = 0; bj < 2; ++bj) { const u32x4 w0 = in[m][bj]; f32x4 a0 = acc[ai][bj][m][0], a1 = acc[ai][bj][m][1];
                    if constexpr (I8IN) { const i32x4 i0 = __builtin_bit_cast(i32x4, a0), i1 = __builtin_bit_cast(i32x4, a1);
                        a0 = (f32x4){(float)i0[0], (float)i0[1], (float)i0[2], (float)i0[3]} * wv[bj][0] * xs[m];
                        a1 = (f32x4){(float)i1[0], (float)i1[1], (float)i1[2], (float)i1[3]} * wv[bj][1] * xs[m]; }
                    const f32x4 o0 = (f32x4){__builtin_bit_cast(float, w0.x << 16), __builtin_bit_cast(float, w0.x & 0xffff0000u), __builtin_bit_cast(float, w0.y << 16), __builtin_bit_cast(float, w0.y & 0xffff0000u)} + a0;
                    const f32x4 o1 = (f32x4){__builtin_bit_cast(float, w0.z << 16), __builtin_bit_cast(float, w0.z & 0xffff0000u), __builtin_bit_cast(float, w0.w << 16), __builtin_bit_cast(float, w0.w & 0xffff0000u)} + a1;
                    ss += ((o0[0] * o0[0] + o0[1] * o0[1]) + (o0[2] * o0[2] + o0[3] * o0[3])) + ((o1[0] * o1[0] + o1[1] * o1[1]) + (o1[2] * o1[2] + o1[3] * o1[3]));
                    u32x4 w; w.x = cvt_pk_bf16(o0[0], o0[1]); w.y = cvt_pk_bf16(o0[2], o0[3]); w.z = cvt_pk_bf16(o1[0], o1[1]); w.w = cvt_pk_bf16(o1[2], o1[3]); *(PG8_GAS u32x4*)(sp + bj * HALF) = w;
                    if constexpr (QOUT > 0) { u32x2 q; q.x = q8x4c<DIG ? 247 : 255>(o0[0], o0[1], o0[2], o0[3], qv[m]); q.y = q8x4c<DIG ? 247 : 255>(o1[0], o1[1], o1[2], o1[3], qv[m]); *(PG8_GAS u32x2*)(q8 + (size_t)row * ldc + col0 + bj * HALF) = q;
                        if constexpr (DIG) { const size_t db = (size_t)row * 1024 + ((col0 + bj * HALF) >> 1);
                            *(PG8_GAS unsigned*)(dgl + db) = nib_pack8(dig_lo4(q.x), dig_lo4(q.y)); *(PG8_GAS unsigned*)(dgh + db) = nib_pack8(dig_hi4(q.x), dig_hi4(q.y)); } } }
                ss += shx(ss, 16, fr + 16 * fq); ss += shx(ss, 32, fr + 16 * fq);
                if (fq == 0) (void)__hip_atomic_fetch_add((PG8_GAS u64_t*)(rowsq + row), rowsq_fx(ss), __ATOMIC_RELAXED, __HIP_MEMORY_SCOPE_AGENT); }
            __builtin_amdgcn_sched_barrier(0);
        }
    }
};
template <int QIN>
struct EpiBf16Row8 {
    static constexpr bool PERM = true, AFTER_DRAIN = false, KSCALE = false, I8 = true;
    bf16_t* O; int ldc; const u64_t* rowsq; const u64_t* rowsq_prev; const float* wsc;
    __device__ __forceinline__ void operator()(const f32x4 (&acc)[2][2][4][2], const Unit& u, int wr, int wc, int fr, int fq) const {
        const int row0 = u.pm * BM + wr * 64 + fr, col0 = u.pn * BM + wc * 32 + 8 * fq;
        float rs[2][4]; f32x4 wv[2][2];
#pragma unroll
        for (int ai = 0; ai < 2; ++ai)
#pragma unroll
            for (int m = 0; m < 4; ++m) { const int row = row0 + ai * HALF + m * 16; rs[ai][m] = rowsq_rs(rowsq, row) * (QIN / 127.0f) / rowsq_rs(rowsq_prev, row); }
#pragma unroll
        for (int bj = 0; bj < 2; ++bj) { wv[bj][0] = *(const PG8_GAS f32x4*)(wsc + col0 + bj * HALF); wv[bj][1] = *(const PG8_GAS f32x4*)(wsc + col0 + bj * HALF + 4); }
        __builtin_amdgcn_sched_barrier(0);
#pragma unroll
        for (int ai = 0; ai < 2; ++ai)
#pragma unroll
            for (int m = 0; m < 4; ++m) { const int row = row0 + ai * HALF + m * 16; bf16_t* rowp = O + (size_t)row * ldc + col0;
#pragma unroll
                for (int bj = 0; bj < 2; ++bj) { const i32x4 i0 = __builtin_bit_cast(i32x4, acc[ai][bj][m][0]), i1 = __builtin_bit_cast(i32x4, acc[ai][bj][m][1]);
                    const f32x4 v0 = (f32x4){(float)i0[0], (float)i0[1], (float)i0[2], (float)i0[3]} * wv[bj][0] * rs[ai][m], v1 = (f32x4){(float)i1[0], (float)i1[1], (float)i1[2], (float)i1[3]} * wv[bj][1] * rs[ai][m];
                    u32x4 w; w.x = cvt_pk_bf16(v0[0], v0[1]); w.y = cvt_pk_bf16(v0[2], v0[3]); w.z = cvt_pk_bf16(v1[0], v1[1]); w.w = cvt_pk_bf16(v1[2], v1[3]);
                    *(PG8_GAS u32x4*)(rowp + bj * HALF) = w; } }
    }
};
struct EpiResidMix {
    static constexpr bool PERM = false, AFTER_DRAIN = false, KSCALE = true, I8 = false; static constexpr int KS0 = 12, KS1 = 20;
    bf16_t* s; int ldc; u64_t* rowsq; const PG8_LAS float* ftab; const PG8_LAS int* pmtab;
    __device__ __forceinline__ int slot(int pm) const { return pmtab[0] == pm ? 0 : (pmtab[1] == pm ? 1 : (pmtab[2] == pm ? 2 : 3)); }
    __device__ __forceinline__ void kscale(f32x4 (&acc)[2][2][4][2], const Unit& u, int which, int wr, int fr) const {
        const PG8_LAS float* ft = ftab + which * 1024 + slot(u.pm) * 256;
#pragma unroll
        for (int ai = 0; ai < 2; ++ai)
#pragma unroll
            for (int m = 0; m < 4; ++m) { const float f = ft[ai * HALF + wr * 64 + m * 16 + fr];
#pragma unroll
                for (int bj = 0; bj < 2; ++bj)
#pragma unroll
                    for (int n = 0; n < 2; ++n) acc[ai][bj][m][n] = acc[ai][bj][m][n] * f; }
    }
    __device__ __forceinline__ void operator()(const f32x4 (&acc)[2][2][4][2], const Unit& u, int wr, int wc, int fr, int fq) const {
        const int col0 = u.pn * BM + wc * 32 + 4 * fq;
#pragma unroll
        for (int ai = 0; ai < 2; ++ai)
#pragma unroll
            for (int m = 0; m < 4; ++m) { const int row = u.pm * BM + ai * HALF + wr * 64 + m * 16 + fr; bf16_t* sp = s + (size_t)row * ldc + col0; float ss = 0.f; const float rc = ftab[2048 + slot(u.pm) * 256 + ai * HALF + wr * 64 + m * 16 + fr];
                u32x2 in[2][2];
#pragma unroll
                for (int bj = 0; bj < 2; ++bj)
#pragma unroll
                    for (int n = 0; n < 2; ++n) in[bj][n] = *(const PG8_GAS u32x2*)(sp + bj * HALF + n * 16);
#pragma unroll
                for (int bj = 0; bj < 2; ++bj)
#pragma unroll
                    for (int n = 0; n < 2; ++n) { const u32x2 w0 = in[bj][n];
                        const f32x4 bs = (f32x4){__builtin_bit_cast(float, w0.x << 16), __builtin_bit_cast(float, w0.x & 0xffff0000u), __builtin_bit_cast(float, w0.y << 16), __builtin_bit_cast(float, w0.y & 0xffff0000u)};
                        const f32x4 o = bs + acc[ai][bj][m][n] * rc; ss += (o[0] * o[0] + o[1] * o[1]) + (o[2] * o[2] + o[3] * o[3]);
                        u32x2 w; w.x = cvt_pk_bf16(o[0], o[1]); w.y = cvt_pk_bf16(o[2], o[3]); *(PG8_GAS u32x2*)(sp + bj * HALF + n * 16) = w; }
                ss += shx(ss, 16, fr + 16 * fq); ss += shx(ss, 32, fr + 16 * fq);
                if (fq == 0) (void)__hip_atomic_fetch_add((PG8_GAS u64_t*)(rowsq + row), rowsq_fx(ss), __ATOMIC_RELAXED, __HIP_MEMORY_SCOPE_AGENT); }
    }
};
struct EpiBf16Row {
    static constexpr bool PERM = true, AFTER_DRAIN = false, KSCALE = false, I8 = false;
    bf16_t* O; int ldc; const u64_t* rowsq;
    __device__ __forceinline__ void operator()(const f32x4 (&acc)[2][2][4][2], const Unit& u, int wr, int wc, int fr, int fq) const {
        const int row0 = u.pm * BM + wr * 64 + fr, col0 = u.pn * BM + wc * 32 + 8 * fq;
#pragma unroll
        for (int ai = 0; ai < 2; ++ai)
#pragma unroll
            for (int m = 0; m < 4; ++m) { const int row = row0 + ai * HALF + m * 16; const float rs = rowsq_rs(rowsq, row); bf16_t* rowp = O + (size_t)row * ldc + col0;
#pragma unroll
                for (int bj = 0; bj < 2; ++bj) { const f32x4 v0 = acc[ai][bj][m][0] * rs, v1 = acc[ai][bj][m][1] * rs; u32x4 w; w.x = cvt_pk_bf16(v0[0], v0[1]); w.y = cvt_pk_bf16(v0[2], v0[3]); w.z = cvt_pk_bf16(v1[0], v1[1]); w.w = cvt_pk_bf16(v1[2], v1[3]);
                    *(PG8_GAS u32x4*)(rowp + bj * HALF) = w; } }
    }
};
struct EpiQKV {
    static constexpr bool PERM = false, AFTER_DRAIN = false, KSCALE = false, I8 = true;
    bf16_t* O; const float* ga; const float* gb; const float* gc; const PG8_LAS float* rope; const u64_t* rowsq; const float* xsc; const float* wsc;
    __device__ __forceinline__ void operator()(const f32x4 (&acc)[2][2][4][2], const Unit& u, int wr, int wc, int fr, int fq) const {
        const int hg = u.pn * 4 + wc;
        const float* g = nullptr; bool isq = false, dorope = false;
        if (hg < 12) { g = ga; isq = true; } else if (hg < 16) { g = ga + 64; } else if (hg < 20) { }
        else if (hg < 28) { g = gb; isq = true; } else if (hg < 36) { g = gb + 64; } else if (hg < 44) { }
        else if (hg < 56) { g = gc; isq = true; dorope = true; } else if (hg < 60) { g = gc + 64; dorope = true; }
        const float qs = isq ? 0.18033688011112042f : 1.0f;
        float rsxa[2][4]; f32x4 wv[2][2], gv[2][2];
#pragma unroll
        for (int ai = 0; ai < 2; ++ai)
#pragma unroll
            for (int m = 0; m < 4; ++m) { const int row = u.pm * BM + ai * HALF + wr * 64 + m * 16 + fr; rsxa[ai][m] = *(const PG8_GAS float*)(xsc + row); }
#pragma unroll
        for (int bj = 0; bj < 2; ++bj)
#pragma unroll
            for (int n = 0; n < 2; ++n) { wv[bj][n] = *(const PG8_GAS f32x4*)(wsc + hg * 64 + 32 * bj + 16 * n + 4 * fq); gv[bj][n] = g ? *(const PG8_GAS f32x4*)(g + 32 * bj + 16 * n + 4 * fq) : (f32x4){1.f, 1.f, 1.f, 1.f}; }
        __builtin_amdgcn_sched_barrier(0);
#pragma unroll
        for (int ai = 0; ai < 2; ++ai)
#pragma unroll
            for (int m = 0; m < 4; ++m) {
                const int row = u.pm * BM + ai * HALF + wr * 64 + m * 16 + fr;
                f32x4 v[2][2];
                const float rsx = rsxa[ai][m];
#pragma unroll
                for (int bj = 0; bj < 2; ++bj)
#pragma unroll
                    for (int n = 0; n < 2; ++n) { const i32x4 ia = __builtin_bit_cast(i32x4, acc[ai][bj][m][n]);
                        v[bj][n] = (f32x4){(float)ia[0], (float)ia[1], (float)ia[2], (float)ia[3]} * wv[bj][n] * rsx; }
                if (g) {
                    float ss = 0.f;
#pragma unroll
                    for (int bj = 0; bj < 2; ++bj)
#pragma unroll
                        for (int n = 0; n < 2; ++n) { const f32x4 x = v[bj][n]; ss += (x[0] * x[0] + x[1] * x[1]) + (x[2] * x[2] + x[3] * x[3]); }
                    ss += shx(ss, 16, fr + 16 * fq); ss += shx(ss, 32, fr + 16 * fq);
                    const float r = qs / sqrtf(ss * (1.0f / 64.0f) + 1e-6f);
#pragma unroll
                    for (int bj = 0; bj < 2; ++bj)
#pragma unroll
                        for (int n = 0; n < 2; ++n) v[bj][n] = v[bj][n] * gv[bj][n] * r;
                }
                if (dorope) {
                    const int t = row & 2047, pr = t >> 6, pc = t & 63;
#pragma unroll
                    for (int bj = 0; bj < 2; ++bj) {
                        const int pos = bj ? pc : pr;
                        const PG8_LAS float* rp = rope + (pos * 16 + 4 * fq) * 2;
                        const f32x4 c01 = *(const PG8_LAS f32x4*)rp, c23 = *(const PG8_LAS f32x4*)(rp + 4);
                        const f32x4 cs = (f32x4){c01[0], c01[2], c23[0], c23[2]}, sn = (f32x4){c01[1], c01[3], c23[1], c23[3]};
                        const f32x4 x1 = v[bj][0], x2 = v[bj][1];
                        v[bj][0] = x1 * cs - x2 * sn; v[bj][1] = x1 * sn + x2 * cs;
                    }
                }
                bf16_t* rowp = O + (size_t)row * 4096 + hg * 64 + 4 * fq;
#pragma unroll
                for (int bj = 0; bj < 2; ++bj)
#pragma unroll
                    for (int n = 0; n < 2; ++n) { u32x2 w; w.x = cvt_pk_bf16(v[bj][n][0], v[bj][n][1]); w.y = cvt_pk_bf16(v[bj][n][2], v[bj][n][3]); *(PG8_GAS u32x2*)(rowp + 32 * bj + 16 * n) = w; }
                asm volatile("" ::: "memory");
            }
    }
};
template <bool I8> __device__ __forceinline__ f32x4 mma16(const bf16x8 b, const bf16x8 a, const f32x4 c) {
    if constexpr (I8) return __builtin_bit_cast(f32x4, __builtin_amdgcn_mfma_i32_16x16x64_i8(__builtin_bit_cast(i32x4, b), __builtin_bit_cast(i32x4, a), __builtin_bit_cast(i32x4, c), 0, 0, 0));
    else return __builtin_amdgcn_mfma_f32_16x16x32_bf16(b, a, c, 0, 0, 0);
}
template <class Epi, class Sched, bool ALIGN_EPI = false, bool SP2 = false>
__device__ __forceinline__ void gemm_phase(PG8_LAS unsigned char* lds, const Gemm g, const Sched& S, const Epi& E, const int tid) {
    const int wid = __builtin_amdgcn_readfirstlane(tid >> 6), lane = tid & 63, wr = wid >> 2, wc = wid & 3, fr = lane & 15, fq = lane >> 4;
    const int K = g.K, nt = K / BK;
    unsigned voffA[2], voffB[2];
#pragma unroll
    for (int i = 0; i < 2; ++i) { int R, C; stage_rc(tid * 16 + i * 8192, R, C); const int Rb = Epi::PERM ? ((R & ~31) + perm32(R & 31)) : R;
        voffA[i] = (unsigned)(R * K + C) * 2u; voffB[i] = (unsigned)(Rb * K + C) * 2u; }
    const size_t kstep = (size_t)(BK * 2);
    const size_t hstep = (size_t)HALF * K * 2;
    const size_t tstep = 2 * hstep;
    const unsigned ldsw = (unsigned)wid * 1024u;
    const int aoff = lds_byte(wr * 64 + fr, fq * 8), boff = lds_byte(wc * 32 + fr, fq * 8);
#define PG8_SA(b, h) (((b) * 2 + (h)) * HTB)
#define PG8_SB(b, h) ((4 + (b) * 2 + (h)) * HTB)
#define PG8_STAGE(bufoff, gbase, voff) do { _Pragma("unroll") for (int _i = 0; _i < 2; ++_i) \
        __builtin_amdgcn_global_load_lds((const unsigned*)((const char*)(gbase) + (voff)[_i]), (PG8_LAS unsigned*)(lds + (bufoff) + ldsw + _i * 8192), 16, 0, 0); } while (0)
#define PG8_LDA(dst, b, h) do { _Pragma("unroll") for (int m = 0; m < 4; ++m) _Pragma("unroll") for (int k = 0; k < 2; ++k) dst[m][k] = *(const PG8_LAS bf16x8*)(lds + PG8_SA(b, h) + aoff + m * 2048 + k * 1024); } while (0)
#define PG8_LDB(dst, b, h) do { _Pragma("unroll") for (int n = 0; n < 2; ++n) _Pragma("unroll") for (int k = 0; k < 2; ++k) dst[n][k] = *(const PG8_LAS bf16x8*)(lds + PG8_SB(b, h) + boff + n * 2048 + k * 1024); } while (0)
#define PG8_MMA(ai, bj, At, Bt) do { __builtin_amdgcn_s_setprio(1); _Pragma("unroll") for (int m = 0; m < 4; ++m) _Pragma("unroll") for (int n = 0; n < 2; ++n) _Pragma("unroll") for (int k = 0; k < 2; ++k) \
        acc[ai][bj][m][n] = mma16<Epi::I8>(Bt[n][k], At[m][k], acc[ai][bj][m][n]); __builtin_amdgcn_s_setprio(0); } while (0)
#define PG8_WAIT_V(n) asm volatile("s_waitcnt vmcnt(" #n ")" ::: "memory")
#define PG8_WAIT_L(n) asm volatile("s_waitcnt lgkmcnt(" #n ")" ::: "memory")
#define PG8_BAR __builtin_amdgcn_s_barrier()
#define PG8_SCHED __builtin_amdgcn_sched_barrier(0)
    Unit cur, nxt; int ui = 0;
    if (!S.next(0, cur)) return;
    f32x4 acc[2][2][4][2];
#pragma unroll
    for (int a = 0; a < 2; ++a)
#pragma unroll
        for (int b = 0; b < 2; ++b)
#pragma unroll
            for (int m = 0; m < 4; ++m)
#pragma unroll
                for (int n = 0; n < 2; ++n) acc[a][b][m][n] = (f32x4){0.f, 0.f, 0.f, 0.f};
    bf16x8 At[4][2], B0[2][2], B1[2][2];
    const char* cA = (const char*)g.A + (size_t)cur.pm * tstep; const char* cB = (const char*)g.Bt + (size_t)cur.pn * tstep;
    S.a_ready(cur);
    if constexpr (SP2) {
        PG8_STAGE(PG8_SB(0, 0), cB, voffB); PG8_STAGE(PG8_SB(0, 1), cB + hstep, voffB); PG8_STAGE(PG8_SA(0, 0), cA, voffA); PG8_STAGE(PG8_SA(0, 1), cA + hstep, voffA);
        if (wr == 1) PG8_BAR;
        PG8_WAIT_V(2); PG8_BAR;
        PG8_STAGE(PG8_SB(1, 0), cB + kstep, voffB); PG8_STAGE(PG8_SA(1, 0), cA + kstep, voffA); PG8_STAGE(PG8_SB(1, 1), cB + hstep + kstep, voffB);
        PG8_WAIT_V(6); PG8_BAR;
    } else {
        PG8_STAGE(PG8_SB(0, 0), cB, voffB); PG8_STAGE(PG8_SA(0, 0), cA, voffA); PG8_STAGE(PG8_SB(0, 1), cB + hstep, voffB); PG8_STAGE(PG8_SA(0, 1), cA + hstep, voffA);
        if (wr == 1) PG8_BAR;
        PG8_WAIT_V(4); PG8_BAR;
        PG8_STAGE(PG8_SB(1, 0), cB + kstep, voffB); PG8_STAGE(PG8_SA(1, 0), cA + kstep, voffA); PG8_STAGE(PG8_SB(1, 1), cB + hstep + kstep, voffB);
        PG8_WAIT_V(6); PG8_BAR;
    }
    for (;;) {
        const bool has_next = S.next(ui + 1, nxt);
        const char* nA = has_next ? (const char*)g.A + (size_t)nxt.pm * tstep : cA; const char* nB = has_next ? (const char*)g.Bt + (size_t)nxt.pn * tstep : cB;
        for (int t = 0; t < nt; t += 2) {
            if constexpr (Epi::KSCALE) { if (t == Epi::KS0 || t == Epi::KS1) E.kscale(acc, cur, t == Epi::KS1 ? 1 : 0, wr, fr); }
            const bool last = (t == nt - 2);
            const char* a1 = cA + (size_t)(t + 1) * kstep;
            const char* a2 = last ? nA : cA + (size_t)(t + 2) * kstep; const char* b2 = last ? nB : cB + (size_t)(t + 2) * kstep;
            const char* a3 = a2 + kstep; const char* b3 = b2 + kstep;
            if (last && has_next) S.a_ready(nxt);
            if constexpr (SP2) {
            PG8_LDB(B0, 0, 0); PG8_LDB(B1, 0, 1); PG8_SCHED; PG8_LDA(At, 0, 0); PG8_STAGE(PG8_SA(1, 1), a1 + hstep, voffA);
            PG8_WAIT_V(8); PG8_WAIT_L(0); PG8_BAR; PG8_MMA(0, 0, At, B0); PG8_MMA(0, 1, At, B1); PG8_BAR; PG8_SCHED;
            PG8_LDA(At, 0, 1); PG8_STAGE(PG8_SB(0, 0), b2, voffB); PG8_STAGE(PG8_SB(0, 1), b2 + hstep, voffB); PG8_STAGE(PG8_SA(0, 0), a2, voffA);
            PG8_WAIT_V(8); PG8_WAIT_L(0); PG8_BAR; PG8_MMA(1, 0, At, B0); PG8_MMA(1, 1, At, B1); PG8_BAR; PG8_SCHED;
            PG8_LDB(B0, 1, 0); PG8_LDB(B1, 1, 1); PG8_SCHED; PG8_LDA(At, 1, 0); PG8_STAGE(PG8_SA(0, 1), a2 + hstep, voffA);
            PG8_WAIT_V(8); PG8_WAIT_L(0); PG8_BAR; PG8_MMA(0, 0, At, B0); PG8_MMA(0, 1, At, B1); PG8_BAR; PG8_SCHED;
            PG8_LDA(At, 1, 1); PG8_STAGE(PG8_SB(1, 0), b3, voffB); PG8_STAGE(PG8_SB(1, 1), b3 + hstep, voffB); PG8_STAGE(PG8_SA(1, 0), a3, voffA);
            PG8_WAIT_V(8); PG8_WAIT_L(0); PG8_BAR; PG8_MMA(1, 0, At, B0); PG8_MMA(1, 1, At, B1); PG8_BAR; PG8_SCHED;
            } else {
            PG8_LDB(B0, 0, 0); PG8_SCHED; PG8_LDA(At, 0, 0); PG8_STAGE(PG8_SA(1, 1), a1 + hstep, voffA);
            PG8_WAIT_L(8); PG8_BAR; PG8_WAIT_L(0); PG8_MMA(0, 0, At, B0); PG8_BAR; PG8_SCHED;
            PG8_LDB(B1, 0, 1); PG8_STAGE(PG8_SB(0, 0), b2, voffB);
            PG8_BAR; PG8_WAIT_L(0); PG8_MMA(0, 1, At, B1); PG8_BAR;
            PG8_LDA(At, 0, 1); PG8_STAGE(PG8_SA(0, 0), a2, voffA);
            PG8_BAR; PG8_WAIT_L(0); PG8_MMA(1, 0, At, B0); PG8_BAR; PG8_SCHED;
            PG8_STAGE(PG8_SB(0, 1), b2 + hstep, voffB);
            PG8_WAIT_V(6); PG8_BAR; PG8_MMA(1, 1, At, B1); PG8_BAR;
            PG8_LDB(B0, 1, 0); PG8_SCHED; PG8_LDA(At, 1, 0); PG8_STAGE(PG8_SA(0, 1), a2 + hstep, voffA);
            PG8_WAIT_L(8); PG8_BAR; PG8_WAIT_L(0); PG8_MMA(0, 0, At, B0); PG8_BAR; PG8_SCHED;
            PG8_LDB(B1, 1, 1); PG8_STAGE(PG8_SB(1, 0), b3, voffB);
            PG8_BAR; PG8_WAIT_L(0); PG8_MMA(0, 1, At, B1); PG8_BAR;
            PG8_LDA(At, 1, 1); PG8_STAGE(PG8_SA(1, 0), a3, voffA);
            PG8_BAR; PG8_WAIT_L(0); PG8_MMA(1, 0, At, B0); PG8_BAR; PG8_SCHED;
            PG8_STAGE(PG8_SB(1, 1), b3 + hstep, voffB);
            PG8_WAIT_V(6); PG8_BAR; PG8_MMA(1, 1, At, B1); PG8_BAR;
            }
        }
        if constexpr (ALIGN_EPI) { if (wr == 0) PG8_BAR; }
        if constexpr (!Epi::AFTER_DRAIN) { E(acc, cur, wr, wc, fr, fq); S.done(cur); }
        if (!has_next) break;
#pragma unroll
        for (int a = 0; a < 2; ++a)
#pragma unroll
            for (int b = 0; b < 2; ++b)
#pragma unroll
                for (int m = 0; m < 4; ++m)
#pragma unroll
                    for (int n = 0; n < 2; ++n) acc[a][b][m][n] = (f32x4){0.f, 0.f, 0.f, 0.f};
        cur = nxt; cA = nA; cB = nB; ++ui;
        if constexpr (ALIGN_EPI) { if (wr == 1) PG8_BAR; }
    }
    PG8_WAIT_V(0);
    if constexpr (!ALIGN_EPI) { if (wr == 0) PG8_BAR; }
    PG8_BAR;
    if constexpr (Epi::AFTER_DRAIN) { E.fused(acc, cur, wr, wc, fr, fq, lds, wid, lane); S.done(cur); }
#undef PG8_SA
#undef PG8_SB
#undef PG8_STAGE
#undef PG8_LDA
#undef PG8_LDB
#undef PG8_MMA
#undef PG8_WAIT_V
#undef PG8_WAIT_L
#undef PG8_BAR
#undef PG8_SCHED
}
}

constexpr int BATCH = 16, SEQ = 2048, DM = 2048, T = BATCH * SEQ, DEPTH = 2;
constexpr int NMEM = 256, DIN = 4096, MEMW = 512;
constexpr int PEER_H = 8, PEER_N = 16384;
constexpr int NWAVES = 8, NTHREADS = NWAVES * 64;
constexpr float EPS = 1e-6f;
constexpr int QA = 0, KA = 768, VA = 1024, QB = 1280, KB = 1792, VB = 2304, QC = 2816, KC = 3584, VC = 3840;
constexpr int OA = 0, OB = 768, OC = 1280;

constexpr size_t MiB = 1u << 20;
constexpr size_t WS_CTL = 0, CTL_ZERO_BYTES = 2 * MiB;
constexpr size_t WS_ROWSQ = 256 * 1024;
constexpr size_t WS_ROPE = 83 * MiB, WS_BIASA = 83 * MiB + 16384;
constexpr size_t WS_WIN = 2 * MiB, WS_WOUT = 34 * MiB, WS_WMQ = 50 * MiB, WS_WMKV = 54 * MiB, WS_WMO = 62 * MiB, WS_WPQ = 66 * MiB, WS_PKEYS = 82 * MiB;
constexpr size_t WS_MEMN = 84 * MiB, WS_KVM = 116 * MiB, WS_PU = 132 * MiB, WS_PV = 260 * MiB, WS_XN = 388 * MiB, WS_QKV = 516 * MiB, WS_ATT = 772 * MiB;
constexpr size_t WS_QM = 900 * MiB, WS_OM = 932 * MiB, WS_MIXSQ = 964 * MiB, MIXSQ_BYTES = 2 * MiB, WS_WIN8 = 966 * MiB, WS_WSC = 982 * MiB, WS_XSC = 982 * MiB + 65536, WS_XSC2 = 982 * MiB + 196608, WS_WSCO = 982 * MiB + 327680, WS_WSCP = 982 * MiB + 344064, WS_WSCM = 982 * MiB + 360448,
                 WS_WOUT8 = 984 * MiB, WS_WPQ8 = 992 * MiB, WS_WMQ8 = 1000 * MiB, WS_END = 1002 * MiB;
constexpr size_t WS_QP = WS_QKV, WS_PIDX = WS_QKV + 128 * MiB, WS_PGATE = WS_QKV + 144 * MiB, WS_PARTI = WS_QKV + 160 * MiB;
constexpr size_t WS_XQH = 836 * MiB, WS_XQL = 868 * MiB;
constexpr size_t WS_XQH_OLD = 900 * MiB, WS_XQL_OLD = 932 * MiB;
constexpr size_t WS_ATT8 = 900 * MiB;
constexpr size_t WS_X8 = 772 * MiB;
constexpr size_t WS_XN8 = 836 * MiB;
constexpr int CW_BAR = 4096;

constexpr int RING_OFF = 0, RING_BYTES = 131072;
constexpr int LDSCTL_OFF = RING_BYTES, MISC_OFF = LDSCTL_OFF + 320;
constexpr int LDS_BYTES = 147456;

#define GAS __attribute__((address_space(1)))
#define LAS __attribute__((address_space(3)))
typedef unsigned short bf16;
typedef unsigned v4u __attribute__((ext_vector_type(4)));
typedef unsigned v2u __attribute__((ext_vector_type(2)));
typedef float f32x4 __attribute__((ext_vector_type(4)));
typedef float f32x16 __attribute__((ext_vector_type(16)));
typedef short bf16x8 __attribute__((ext_vector_type(8)));
typedef GAS unsigned gu32;
#define LDS_WAIT() asm volatile("s_waitcnt lgkmcnt(0)" ::: "memory")
#define VM_WAIT() asm volatile("s_waitcnt vmcnt(0)" ::: "memory")
__device__ __forceinline__ unsigned f2bf(float f) { unsigned u = __builtin_bit_cast(unsigned, f); return (u + 0x7fffu + ((u >> 16) & 1u)) >> 16; }
__device__ __forceinline__ unsigned pk2(float lo, float hi) { return f2bf(lo) | (f2bf(hi) << 16); }
__device__ __forceinline__ float bflo(unsigned w) { return __builtin_bit_cast(float, w << 16); }
__device__ __forceinline__ float bfhi(unsigned w) { return __builtin_bit_cast(float, w & 0xffff0000u); }

__device__ __forceinline__ float shx(float v, int k, int lane) { return __builtin_bit_cast(float, __builtin_amdgcn_ds_bpermute((lane ^ k) << 2, __builtin_bit_cast(int, v))); }
#define XB_TMO      128
#define XB_XCNT(j)  (256  + 64 * (j))
#define XB_XSUB(j)  (1280 + 64 * (j))
#define XB_XGEN(j)  (2304 + 64 * (j))
#define XB_TOP      3328
#define XB_TOPGEN   3392
#define XCD_BAR_WORDS 3456
#define XB_SPIN_CAP (1u << 18)

__device__ __forceinline__ unsigned xb_ld(unsigned* p)              { return __hip_atomic_load(p, __ATOMIC_RELAXED, __HIP_MEMORY_SCOPE_AGENT); }
__device__ __forceinline__ unsigned xb_add(unsigned* p, unsigned v) { return __hip_atomic_fetch_add(p, v, __ATOMIC_RELAXED, __HIP_MEMORY_SCOPE_AGENT); }
__device__ __forceinline__ unsigned xb_xcc_id() { return (unsigned)__builtin_amdgcn_s_getreg((3 << 11) | 20) & 0xFu; }
#define XB_SPIN(cond, bar) do { unsigned _sp = 0; while (cond) { __builtin_amdgcn_s_sleep(1); \
    if ((++_sp & 255u) == 0u) { if (xb_ld(&(bar)[XB_TMO])) break; if (_sp > XB_SPIN_CAP) { atomicAdd(&(bar)[XB_TMO], 1u); break; } } } } while (0)

struct XcdBarrier {
    unsigned* bar; unsigned x;
    volatile LAS unsigned* st;
};

__device__ __forceinline__ XcdBarrier xcd_barrier_post(unsigned* bar, volatile LAS unsigned* st) {
    XcdBarrier b; b.bar = bar; b.x = xb_xcc_id(); b.st = st;
    if (threadIdx.x == 0) (void)xb_add(&bar[XB_XCNT(b.x)], 1u);
    return b;
}
__device__ __forceinline__ void xcd_barrier_complete(unsigned* bar, unsigned x, unsigned& nloc, unsigned& nx) {
    const unsigned G = gridDim.x * gridDim.y * gridDim.z;
    unsigned sum, cnt, mine, sp = 0u;
    for (;;) {
        sum = 0u; cnt = 0u; mine = 0u;
#pragma unroll
        for (unsigned j = 0; j < 16; ++j) { const unsigned c = xb_ld(&bar[XB_XCNT(j)]); sum += c; cnt += (c > 0u) ? 1u : 0u; mine = (j == x) ? c : mine; }
        if (sum == G) break;
        __builtin_amdgcn_s_sleep(1);
        if ((++sp & 255u) == 0u) { if (xb_ld(&bar[XB_TMO])) break; if (sp > XB_SPIN_CAP) { atomicAdd(&bar[XB_TMO], 1u); break; } }
    }
    nloc = mine > 0u ? mine : 1u; nx = cnt > 0u ? cnt : 1u;
}

__device__ __forceinline__ void xcd_barrier(const XcdBarrier& b) {
    asm volatile("s_waitcnt vmcnt(0)" ::: "memory");
    __syncthreads();
    if (threadIdx.x == 0) {
        unsigned* bar = b.bar;
        __builtin_amdgcn_s_waitcnt(0);
        unsigned nloc = b.st[0], nx = b.st[1];
        if (nloc == 0u) { xcd_barrier_complete(bar, b.x, nloc, nx); b.st[0] = nloc; b.st[1] = nx; }
        const unsigned old = xb_add(&bar[XB_XSUB(b.x)], 1u);
        const unsigned gen = old / nloc;
        if (old + 1u == (gen + 1u) * nloc) {
            __builtin_amdgcn_fence(__ATOMIC_RELEASE, "agent");
            asm volatile("s_waitcnt vmcnt(0)" ::: "memory");
            const unsigned og = xb_add(&bar[XB_TOP], 1u);
            const unsigned tg = og / nx;
            if (og + 1u == (tg + 1u) * nx) xb_add(&bar[XB_TOPGEN], 1u);
            else XB_SPIN(xb_ld(&bar[XB_TOPGEN]) == tg, bar);
            __builtin_amdgcn_fence(__ATOMIC_ACQUIRE, "agent");
            xb_add(&bar[XB_XGEN(b.x)], 1u);
            asm volatile("s_waitcnt vmcnt(0)" ::: "memory");
        } else {
            XB_SPIN(xb_ld(&bar[XB_XGEN(b.x)]) == gen, bar);
            __builtin_amdgcn_fence(__ATOMIC_ACQUIRE, "agent");
            asm volatile("s_waitcnt vmcnt(0)" ::: "memory");
        }
    }
    __syncthreads();
}

__device__ __forceinline__ float wave_sum(float v, int lane) {
#pragma unroll
    for (int o = 1; o < 64; o <<= 1) v += shx(v, o, lane);
    return v;
}
__device__ __forceinline__ void* ldptr(LAS unsigned char* lds, int i) {
    const unsigned long long v = ((const LAS unsigned long long*)(lds + LDSCTL_OFF + 1024))[i];
    const unsigned lo = __builtin_amdgcn_readfirstlane((unsigned)v), hi = __builtin_amdgcn_readfirstlane((unsigned)(v >> 32));
    return (void*)(((unsigned long long)hi << 32) | lo);
}
struct OffsetOrder {
    pg8::StaticOrder S;
    __device__ __forceinline__ void init(int M, int N, int G, int c, int off) { S.init(M, N, G, (c + G - off % G) % G); }
    __device__ __forceinline__ bool next(int i, pg8::Unit& u) const { return S.next(i, u); }
    __device__ __forceinline__ void a_ready(const pg8::Unit&) const {}
    __device__ __forceinline__ void done(const pg8::Unit&) const {}
};

template <bool PERMQKV>
__device__ __forceinline__ void transpose_item(const float* W, int K, int N, bf16* WT, LAS float* scr, int item, int lane, const float* gk = nullptr) {
    const int nblk = N / 32, kb = item / nblk, nb = item % nblk, k0 = 64 * kb, n0 = 32 * nb;
    int d0 = n0;
    if (PERMQKV) { const int within = n0 & 255; d0 = (n0 & ~255) + 128 * ((within >> 5) & 1) + 32 * (within >> 6); }
#pragma unroll
    for (int i = 0; i < 8; ++i) { const int kk = 8 * i + (lane >> 3), nn = 4 * (lane & 7);
        const f32x4 w4 = *(const GAS f32x4*)(W + (size_t)(k0 + kk) * N + n0 + nn) * (gk ? gk[k0 + kk] : 1.f);
        scr[kk * 33 + nn] = w4[0]; scr[kk * 33 + nn + 1] = w4[1]; scr[kk * 33 + nn + 2] = w4[2]; scr[kk * 33 + nn + 3] = w4[3]; }
    LDS_WAIT(); asm volatile("" ::: "memory");
    const int c = lane & 7;
#pragma unroll
    for (int j = 0; j < 4; ++j) { const int n = (lane >> 3) + 8 * j; const LAS float* s = scr + (8 * c) * 33 + n;
        v4u o; o.x = pk2(s[0 * 33], s[1 * 33]); o.y = pk2(s[2 * 33], s[3 * 33]); o.z = pk2(s[4 * 33], s[5 * 33]); o.w = pk2(s[6 * 33], s[7 * 33]);
        *(GAS v4u*)(WT + (size_t)(d0 + n) * K + k0 + 8 * c) = o; }
    LDS_WAIT(); asm volatile("" ::: "memory");
}
__device__ __forceinline__ void convert_bf16(const float* src, bf16* dst, size_t n, size_t gtid, size_t nthreads) {
    for (size_t i = gtid * 8; i < n; i += nthreads * 8) {
        const f32x4 a = *(const GAS f32x4*)(src + i), b = *(const GAS f32x4*)(src + i + 4);
        v4u o; o.x = pk2(a[0], a[1]); o.y = pk2(a[2], a[3]); o.z = pk2(b[0], b[1]); o.w = pk2(b[2], b[3]);
        *(GAS v4u*)(dst + i) = o;
    }
}
__device__ __forceinline__ int t5_bucket(int rel) {
    const int n = rel < 0 ? -rel : rel;
    const int b = n < 8 ? n : n < 12 ? 8 : n < 16 ? 9 : n < 23 ? 10 : n < 32 ? 11 : n < 46 ? 12 : n < 64 ? 13 : n < 91 ? 14 : 15;
    return b + (rel > 0 ? 16 : 0);
}
__constant__ float ROPE_INV[16] = {1.000000000e+00f, 5.623413324e-01f, 3.162277639e-01f, 1.778279394e-01f, 1.000000015e-01f, 5.623413250e-02f, 3.162277490e-02f, 1.778279431e-02f,
                                   9.999999776e-03f, 5.623413250e-03f, 3.162277630e-03f, 1.778279431e-03f, 1.000000047e-03f, 5.623413017e-04f, 3.162277571e-04f, 1.778279402e-04f};

__device__ __forceinline__ void rms_row_to_bf16(const float* xrow, const float* g0, bf16* o0, const float* g1, bf16* o1, int lane) {
    const GAS f32x4* xr = (const GAS f32x4*)xrow + lane;
    f32x4 v[8]; float s = 0.f;
#pragma unroll
    for (int j = 0; j < 8; ++j) { v[j] = xr[64 * j]; s += (v[j].x * v[j].x + v[j].y * v[j].y) + (v[j].z * v[j].z + v[j].w * v[j].w); }
    const float rstd = 1.f / sqrtf(wave_sum(s, lane) * (1.f / DM) + EPS);
    {   const GAS f32x4* gr = (const GAS f32x4*)g0 + lane; GAS v2u* o8 = (GAS v2u*)o0 + lane;
#pragma unroll
        for (int j = 0; j < 8; ++j) { const f32x4 gg = gr[64 * j]; v2u w; w.x = pk2(v[j].x * rstd * gg.x, v[j].y * rstd * gg.y); w.y = pk2(v[j].z * rstd * gg.z, v[j].w * rstd * gg.w); o8[64 * j] = w; } }
    if (g1) { const GAS f32x4* gr = (const GAS f32x4*)g1 + lane; GAS v2u* o8 = (GAS v2u*)o1 + lane;
#pragma unroll
        for (int j = 0; j < 8; ++j) { const f32x4 gg = gr[64 * j]; v2u w; w.x = pk2(v[j].x * rstd * gg.x, v[j].y * rstd * gg.y); w.y = pk2(v[j].z * rstd * gg.z, v[j].w * rstd * gg.w); o8[64 * j] = w; } }
}
__device__ __forceinline__ float wave_max(float v, int lane) {
#pragma unroll
    for (int o = 1; o < 64; o <<= 1) v = fmaxf(v, shx(v, o, lane));
    return v;
}
__device__ __forceinline__ unsigned q8x4(const f32x4 v, const float inv) {
    unsigned w = 0;
    w = __builtin_amdgcn_cvt_pk_u8_f32(__builtin_rintf(__builtin_fmaf(v[0], inv, 128.f)), 0, w); w = __builtin_amdgcn_cvt_pk_u8_f32(__builtin_rintf(__builtin_fmaf(v[1], inv, 128.f)), 1, w);
    w = __builtin_amdgcn_cvt_pk_u8_f32(__builtin_rintf(__builtin_fmaf(v[2], inv, 128.f)), 2, w); w = __builtin_amdgcn_cvt_pk_u8_f32(__builtin_rintf(__builtin_fmaf(v[3], inv, 128.f)), 3, w);
    return w ^ 0x80808080u;
}
__device__ __forceinline__ float amax4(const f32x4 v) { return fmaxf(fmaxf(fabsf(v[0]), fabsf(v[1])), fmaxf(fabsf(v[2]), fabsf(v[3]))); }
__device__ __forceinline__ void quant_wrow(const bf16* src, unsigned char* dst, float* step, int lane) {
    v4u w[4]; float am = 0.f;
#pragma unroll
    for (int j = 0; j < 4; ++j) w[j] = *(const GAS v4u*)(src + 8 * lane + 512 * j);
    f32x4 lo[4], hi[4];
#pragma unroll
    for (int j = 0; j < 4; ++j) { lo[j] = (f32x4){bflo(w[j].x), bfhi(w[j].x), bflo(w[j].y), bfhi(w[j].y)}; hi[j] = (f32x4){bflo(w[j].z), bfhi(w[j].z), bflo(w[j].w), bfhi(w[j].w)}; am = fmaxf(am, fmaxf(amax4(lo[j]), amax4(hi[j]))); }
    am = fmaxf(wave_max(am, lane), 1e-30f);
    const float inv = 127.f / am;
#pragma unroll
    for (int j = 0; j < 4; ++j) *(GAS v2u*)(dst + 8 * lane + 512 * j) = (v2u){q8x4(lo[j], inv), q8x4(hi[j], inv)};
    if (lane == 0) *step = am * (1.f / 127.f);
}
template <int R>
__device__ __forceinline__ void att_quant_rows(const bf16* ATT, const u64_t* mixsq, unsigned char* Q, float* step, int row0, int lane) {
    v4u w[R][4];
#pragma unroll
    for (int q = 0; q < R; ++q)
#pragma unroll
        for (int j = 0; j < 4; ++j) w[q][j] = *(const GAS v4u*)(ATT + (size_t)(row0 + q) * DM + 8 * lane + 512 * j);
#pragma unroll
    for (int q = 0; q < R; ++q) { const int row = row0 + q;
        const float ra = 1.0f / sqrtf((float)*(const GAS u64_t*)(mixsq + row) * (5.9604644775390625e-08f / 768.0f) + EPS), rb = 1.0f / sqrtf((float)*(const GAS u64_t*)(mixsq + T + row) * (5.9604644775390625e-08f / 512.0f) + EPS),
                    rc = 1.0f / sqrtf((float)*(const GAS u64_t*)(mixsq + 2 * (size_t)T + row) * (5.9604644775390625e-08f / 768.0f) + EPS);
        const float rj[4] = {ra, lane < 32 ? ra : rb, lane < 32 ? rb : rc, rc};
        f32x4 lo[4], hi[4]; float am = 0.f;
#pragma unroll
        for (int j = 0; j < 4; ++j) { lo[j] = (f32x4){bflo(w[q][j].x), bfhi(w[q][j].x), bflo(w[q][j].y), bfhi(w[q][j].y)} * rj[j]; hi[j] = (f32x4){bflo(w[q][j].z), bfhi(w[q][j].z), bflo(w[q][j].w), bfhi(w[q][j].w)} * rj[j]; am = fmaxf(am, fmaxf(amax4(lo[j]), amax4(hi[j]))); }
        am = fmaxf(wave_max(am, lane), 1e-30f);
        const float inv = 127.f / am;
#pragma unroll
        for (int j = 0; j < 4; ++j) *(GAS v2u*)(Q + (size_t)row * DM + 8 * lane + 512 * j) = (v2u){q8x4(lo[j], inv), q8x4(hi[j], inv)};
        if (lane == 0) step[row] = am * (1.f / 127.f); }
}
__device__ __forceinline__ void prep_rows2(const float* x0, bf16* o0, u64_t* sq, unsigned char* q0, float* qstep, int lane) {
    f32x4 v[2][8];
#pragma unroll
    for (int q = 0; q < 2; ++q) { const GAS f32x4* xr = (const GAS f32x4*)(x0 + (size_t)q * DM) + lane;
#pragma unroll
        for (int j = 0; j < 8; ++j) v[q][j] = xr[64 * j]; }
#pragma unroll
    for (int q = 0; q < 2; ++q) { GAS v2u* o8 = (GAS v2u*)(o0 + (size_t)q * DM) + lane; float s = 0.f;
#pragma unroll
        for (int j = 0; j < 8; ++j) { const f32x4 a = v[q][j]; s += (a.x * a.x + a.y * a.y) + (a.z * a.z + a.w * a.w); v2u w; w.x = pk2(a.x, a.y); w.y = pk2(a.z, a.w); o8[64 * j] = w; }
        s = wave_sum(s, lane);
        float am = 0.f;
#pragma unroll
        for (int j = 0; j < 8; ++j) am = fmaxf(am, amax4(v[q][j]));
        am = fmaxf(wave_max(am, lane), 1e-30f);
        const float inv = 127.f / am;
#pragma unroll
        for (int j = 0; j < 8; ++j) *(GAS unsigned*)(q0 + (size_t)q * DM + 4 * lane + 256 * j) = q8x4(v[q][j], inv);
        if (lane == 0) { sq[q] = rowsq_fx(s); qstep[q] = am * (1.f / 127.f) / sqrtf(s * (1.f / DM) + 1e-6f); } }
}
__device__ __forceinline__ void norm_rows(const float* X, const float* g, bf16* XN, int gw, int NGW, int lane) {
    for (int m = gw; m < T; m += NGW) rms_row_to_bf16(X + (size_t)m * DM, g, XN + (size_t)m * DM, nullptr, nullptr, lane);
}

template <int TYPE>
__device__ __forceinline__ void naive_attn_item(const bf16* QKV, bf16* ATT, int b, int grow, int head, int lane, const float* biasA, const float* sink, const float* rpb) {
    const int tpos = grow * 64 + lane; const size_t trow = (size_t)b * SEQ + tpos;
    int qcol, kcol, vcol, ocol;
    if (TYPE == 0) { qcol = QA + head * 64; kcol = KA + (head / 3) * 64; vcol = VA + (head / 3) * 64; ocol = OA + head * 64; }
    else if (TYPE == 1) { qcol = QB + head * 64; kcol = KB + head * 64; vcol = VB + head * 64; ocol = OB + head * 64; }
    else { qcol = QC + head * 64; kcol = KC + (head / 3) * 64; vcol = VC + (head / 3) * 64; ocol = OC + head * 64; }
    float q[64], o[64];
#pragma unroll
    for (int c = 0; c < 8; ++c) { const v4u w = *(const GAS v4u*)(QKV + trow * DIN + qcol + 8 * c);
        q[8 * c + 0] = bflo(w.x); q[8 * c + 1] = bfhi(w.x); q[8 * c + 2] = bflo(w.y); q[8 * c + 3] = bfhi(w.y); q[8 * c + 4] = bflo(w.z); q[8 * c + 5] = bfhi(w.z); q[8 * c + 6] = bflo(w.w); q[8 * c + 7] = bfhi(w.w); }
#pragma unroll
    for (int d = 0; d < 64; ++d) o[d] = 0.f;
    float m = -1e30f, l = 0.f;
    int j0, j1;
    if (TYPE == 0) { j0 = grow * 64 - 128; if (j0 < 0) j0 = 0; j1 = grow * 64 + 63 + 128; if (j1 > SEQ - 1) j1 = SEQ - 1; }
    else if (TYPE == 1) { int r0 = grow - 4; r0 = r0 < 0 ? 0 : (r0 > 24 ? 24 : r0); j0 = r0 * 64; j1 = j0 + 511; }
    else { j0 = 0; j1 = SEQ - 1; }
    int c0 = lane - 8; c0 = c0 < 0 ? 0 : (c0 > 48 ? 48 : c0);
#pragma unroll 1
    for (int j = j0; j <= j1; ++j) {
        const bf16* krow = QKV + ((size_t)b * SEQ + j) * DIN;
        float s = 0.f;
#pragma unroll
        for (int c = 0; c < 8; ++c) { const v4u w = *(const GAS v4u*)(krow + kcol + 8 * c);
            s += q[8 * c + 0] * bflo(w.x) + q[8 * c + 1] * bfhi(w.x) + q[8 * c + 2] * bflo(w.y) + q[8 * c + 3] * bfhi(w.y) + q[8 * c + 4] * bflo(w.z) + q[8 * c + 5] * bfhi(w.z) + q[8 * c + 6] * bflo(w.w) + q[8 * c + 7] * bfhi(w.w); }
        bool valid = true;
        if (TYPE == 0) { const int rel = j - tpos; valid = (rel >= -128 && rel <= 128); if (valid) s += biasA[head * 257 + rel + 128]; }
        if (TYPE == 1) { const int kr = j >> 6, kc = j & 63; valid = (kc >= c0 && kc < c0 + 16); if (valid) s += rpb[(head * 15 + (kr - grow + 7)) * 31 + (kc - lane + 15)]; }
        const float mn = valid ? fmaxf(m, s) : m;
        const float a = __expf(m - mn);
        const float p = valid ? __expf(s - mn) : 0.f;
        l = l * a + p; m = mn;
#pragma unroll
        for (int c = 0; c < 8; ++c) { const v4u w = *(const GAS v4u*)(krow + vcol + 8 * c);
            o[8 * c + 0] = o[8 * c + 0] * a + p * bflo(w.x); o[8 * c + 1] = o[8 * c + 1] * a + p * bfhi(w.x); o[8 * c + 2] = o[8 * c + 2] * a + p * bflo(w.y); o[8 * c + 3] = o[8 * c + 3] * a + p * bfhi(w.y);
            o[8 * c + 4] = o[8 * c + 4] * a + p * bflo(w.z); o[8 * c + 5] = o[8 * c + 5] * a + p * bfhi(w.z); o[8 * c + 6] = o[8 * c + 6] * a + p * bflo(w.w); o[8 * c + 7] = o[8 * c + 7] * a + p * bfhi(w.w); }
    }
    if (TYPE == 0) l += __expf(sink[head] - m);
    const float inv = 1.f / l;
#pragma unroll
    for (int c = 0; c < 8; ++c) { v4u w; w.x = pk2(o[8 * c + 0] * inv, o[8 * c + 1] * inv); w.y = pk2(o[8 * c + 2] * inv, o[8 * c + 3] * inv); w.z = pk2(o[8 * c + 4] * inv, o[8 * c + 5] * inv); w.w = pk2(o[8 * c + 6] * inv, o[8 * c + 7] * inv);
        *(GAS v4u*)(ATT + trow * DM + ocol + 8 * c) = w; }
}
__device__ __forceinline__ float rdl(float v, int l) { return __builtin_bit_cast(float, __builtin_amdgcn_readlane(__builtin_bit_cast(int, v), l)); }
__device__ __forceinline__ void naive_mem_item(const bf16* QM, const bf16* KVM, bf16* OM, const float* gq, size_t trow, int b, int head, int lane) {
    const unsigned qw = *(const GAS unsigned*)(QM + trow * MEMW + head * 128 + 2 * lane);
    float q0 = bflo(qw), q1 = bfhi(qw);
    const float ss = wave_sum(q0 * q0 + q1 * q1, lane);
    const float r = 0.08838834764831845f / sqrtf(ss * (1.f / 128.f) + EPS);
    q0 *= r * gq[2 * lane]; q1 *= r * gq[2 * lane + 1];
    const bf16* kbase = KVM + ((size_t)b * NMEM + lane) * 1024 + head * 128;
    float s[4] = {0.f, 0.f, 0.f, 0.f};
#pragma unroll 1
    for (int c = 0; c < 16; ++c) {
        float qa[8];
#pragma unroll
        for (int e = 0; e < 4; ++e) { qa[2 * e] = rdl(q0, 4 * c + e); qa[2 * e + 1] = rdl(q1, 4 * c + e); }
#pragma unroll
        for (int i = 0; i < 4; ++i) { const v4u w = *(const GAS v4u*)(kbase + (size_t)i * 64 * 1024 + 8 * c);
            s[i] += qa[0] * bflo(w.x) + qa[1] * bfhi(w.x) + qa[2] * bflo(w.y) + qa[3] * bfhi(w.y) + qa[4] * bflo(w.z) + qa[5] * bfhi(w.z) + qa[6] * bflo(w.w) + qa[7] * bfhi(w.w); }
    }
    float m = fmaxf(fmaxf(s[0], s[1]), fmaxf(s[2], s[3]));
#pragma unroll
    for (int o = 1; o < 64; o <<= 1) m = fmaxf(m, shx(m, o, lane));
    float p[4]; float l = 0.f;
#pragma unroll
    for (int i = 0; i < 4; ++i) { p[i] = __expf(s[i] - m); l += p[i]; }
    l = wave_sum(l, lane);
    const bf16* vbase = KVM + ((size_t)b * NMEM) * 1024 + 512 + head * 128 + 2 * lane;
    float o0 = 0.f, o1 = 0.f;
#pragma unroll
    for (int i = 0; i < 4; ++i) {
#pragma unroll 4
        for (int jj = 0; jj < 64; ++jj) { const float pj = rdl(p[i], jj); const unsigned w = *(const GAS unsigned*)(vbase + (size_t)(64 * i + jj) * 1024); o0 += pj * bflo(w); o1 += pj * bfhi(w); }
    }
    const float inv = 1.f / l;
    *(GAS unsigned*)(OM + trow * MEMW + head * 128 + 2 * lane) = pk2(o0 * inv, o1 * inv);
}
__device__ __forceinline__ void mixnorm_rows(bf16* ATT, const float* g, int gw, int NGW, int lane) {
    for (int m = gw; m < T; m += NGW) {
        GAS v4u* p = (GAS v4u*)(ATT + (size_t)m * DM + 32 * lane);
        v4u w[4]; float f[32]; float ss = 0.f;
#pragma unroll
        for (int c = 0; c < 4; ++c) { w[c] = p[c];
            f[8 * c + 0] = bflo(w[c].x); f[8 * c + 1] = bfhi(w[c].x); f[8 * c + 2] = bflo(w[c].y); f[8 * c + 3] = bfhi(w[c].y); f[8 * c + 4] = bflo(w[c].z); f[8 * c + 5] = bfhi(w[c].z); f[8 * c + 6] = bflo(w[c].w); f[8 * c + 7] = bfhi(w[c].w); }
#pragma unroll
        for (int i = 0; i < 32; ++i) ss += f[i] * f[i];
        const int grp = lane < 24 ? 0 : (lane < 40 ? 1 : 2);
        const float sa = wave_sum(grp == 0 ? ss : 0.f, lane), sb = wave_sum(grp == 1 ? ss : 0.f, lane), sc = wave_sum(grp == 2 ? ss : 0.f, lane);
        const float r = grp == 0 ? 1.f / sqrtf(sa * (1.f / 768.f) + EPS) : (grp == 1 ? 1.f / sqrtf(sb * (1.f / 512.f) + EPS) : 1.f / sqrtf(sc * (1.f / 768.f) + EPS));
        const float* gg = g + 32 * lane;
#pragma unroll
        for (int c = 0; c < 4; ++c) { const f32x4 g0 = *(const GAS f32x4*)(gg + 8 * c), g1 = *(const GAS f32x4*)(gg + 8 * c + 4);
            v4u o; o.x = pk2(f[8 * c + 0] * r * g0[0], f[8 * c + 1] * r * g0[1]); o.y = pk2(f[8 * c + 2] * r * g0[2], f[8 * c + 3] * r * g0[3]);
            o.z = pk2(f[8 * c + 4] * r * g1[0], f[8 * c + 5] * r * g1[1]); o.w = pk2(f[8 * c + 6] * r * g1[2], f[8 * c + 7] * r * g1[3]); p[c] = o; }
    }
}

#ifndef PEER_HD
#define PEER_HD __device__ __forceinline__
#define PEER_EXP(x) __expf(x)
#endif
template <int N> PEER_HD void bitonic_sort_desc(float* v) {
#pragma unroll
    for (int k = 2; k <= N; k <<= 1)
#pragma unroll
        for (int j = k >> 1; j > 0; j >>= 1)
#pragma unroll
            for (int i = 0; i < N; ++i) { const int l = i ^ j; if (l > i) { const bool desc = ((i & k) == 0); const float a = v[i], b = v[l]; const float hi = fmaxf(a, b), lo = fminf(a, b);
                v[i] = desc ? hi : lo; v[l] = desc ? lo : hi; } }
}
#define PEER_CE(i, j) do { const float x_ = v[i], y_ = v[j]; v[i] = fmaxf(x_, y_); v[j] = fminf(x_, y_); } while (0)
PEER_HD void sort16_desc(float* v) {
    PEER_CE(0,13); PEER_CE(1,12); PEER_CE(2,15); PEER_CE(3,14); PEER_CE(4,8); PEER_CE(5,6); PEER_CE(7,11); PEER_CE(9,10);
    PEER_CE(0,5); PEER_CE(1,7); PEER_CE(2,9); PEER_CE(3,4); PEER_CE(6,13); PEER_CE(8,14); PEER_CE(10,15); PEER_CE(11,12);
    PEER_CE(0,1); PEER_CE(2,3); PEER_CE(4,5); PEER_CE(6,8); PEER_CE(7,9); PEER_CE(10,11); PEER_CE(12,13); PEER_CE(14,15);
    PEER_CE(0,2); PEER_CE(1,3); PEER_CE(4,10); PEER_CE(5,11); PEER_CE(6,7); PEER_CE(8,9); PEER_CE(12,14); PEER_CE(13,15);
    PEER_CE(1,2); PEER_CE(3,12); PEER_CE(4,6); PEER_CE(5,7); PEER_CE(8,10); PEER_CE(9,11); PEER_CE(13,14);
    PEER_CE(1,4); PEER_CE(2,6); PEER_CE(5,8); PEER_CE(7,10); PEER_CE(9,13); PEER_CE(11,14);
    PEER_CE(2,4); PEER_CE(3,6); PEER_CE(9,12); PEER_CE(11,13);
    PEER_CE(3,5); PEER_CE(6,8); PEER_CE(7,9); PEER_CE(10,12);
    PEER_CE(3,4); PEER_CE(5,6); PEER_CE(7,8); PEER_CE(9,10); PEER_CE(11,12);
    PEER_CE(6,7); PEER_CE(8,9);
}
PEER_HD void sort6_desc(float* v) {
    PEER_CE(0,5); PEER_CE(1,3); PEER_CE(2,4); PEER_CE(1,2); PEER_CE(3,4); PEER_CE(0,3); PEER_CE(2,5); PEER_CE(0,1); PEER_CE(2,3); PEER_CE(4,5); PEER_CE(1,2); PEER_CE(3,4);
}
PEER_HD void merge_top16(float* a, const float* b) {
    float c[16];
#pragma unroll
    for (int i = 0; i < 16; ++i) c[i] = fmaxf(a[i], b[15 - i]);
#pragma unroll
    for (int j = 8; j > 0; j >>= 1)
#pragma unroll
        for (int i = 0; i < 16; ++i) { const int l = i ^ j; if (l > i) { const float x = c[i], y = c[l]; c[i] = fmaxf(x, y); c[l] = fminf(x, y); } }
#pragma unroll
    for (int i = 0; i < 16; ++i) a[i] = c[i];
}
PEER_HD void top16_of_64(float (&v)[64]) {
    sort16_desc(&v[0]); sort16_desc(&v[16]); sort16_desc(&v[32]); sort16_desc(&v[48]);
    merge_top16(&v[0], &v[16]); merge_top16(&v[32], &v[48]); merge_top16(&v[0], &v[32]);
}
PEER_HD float pack_idx(float s, unsigned idx, unsigned mask) { return __builtin_bit_cast(float, (__builtin_bit_cast(unsigned, s) & ~mask) | idx); }
PEER_HD unsigned low_bits(float s, unsigned mask) { return __builtin_bit_cast(unsigned, s) & mask; }
PEER_HD unsigned pick16(const float* a, unsigned i, unsigned mask) {
    unsigned r = 0;
#pragma unroll
    for (unsigned k = 0; k < 16; ++k) r = (i == k) ? low_bits(a[k], mask) : r;
    return r;
}
PEER_HD void peer_candidates(const float* a, const float* b, int* e, float* gate) {
    const float NEG = -3.0e38f;
#define PEER_S(i, j) pack_idx(a[i] + b[j], (unsigned)((i) * 16 + (j)), 0xffu)
    float r0[16], r1[16], c0[16], c1[16], z[16];
#pragma unroll
    for (int j = 0; j < 16; ++j) { r0[j] = PEER_S(0, j); r1[j] = j < 8 ? PEER_S(1, j) : NEG; c0[j] = j < 14 ? PEER_S(j + 2 < 16 ? j + 2 : 15, 0) : NEG; c1[j] = j < 6 ? PEER_S(j + 2 < 16 ? j + 2 : 15, 1) : NEG; z[j] = NEG; }
    z[0] = PEER_S(2, 2); z[1] = PEER_S(2, 3); z[2] = PEER_S(2, 4); z[3] = PEER_S(3, 2); z[4] = PEER_S(3, 3); z[5] = PEER_S(4, 2);
#undef PEER_S
    sort6_desc(z);
    merge_top16(c1, z); merge_top16(c0, c1); merge_top16(r0, r1);
    float c[16];
#pragma unroll
    for (int i = 0; i < 16; ++i) c[i] = fmaxf(r0[i], c0[15 - i]);
    float mx = c[0], den = 0.f;
#pragma unroll
    for (int k = 0; k < 16; ++k) { const unsigned id = low_bits(c[k], 0xffu); const unsigned n0 = pick16(a, id >> 4, 0x7fu), n1 = pick16(b, id & 15u, 0x7fu);
        e[k] = (int)(n0 * 128u + n1); gate[k] = PEER_EXP(c[k] - mx); den += gate[k]; }
    const float inv = 1.f / den;
#pragma unroll
    for (int k = 0; k < 16; ++k) gate[k] *= inv;
}

__device__ __forceinline__ void peer_select_unit(const bf16* QP, const bf16* PK, int* PIDX, float* PGATE, int tb, int h, int wave, int lane, LAS unsigned char* lds) {
    const int hh = lane >> 5, tl = lane & 31; const size_t t = (size_t)tb * 256 + wave * 32 + tl;
    __syncthreads();
    {   const int tid = wave * 64 + lane; const bf16* src = PK + (size_t)h * 256 * 128;
#pragma unroll 1
        for (int i0 = 0; i0 < 8; i0 += 4) { v4u st[4];
#pragma unroll
            for (int i = 0; i < 4; ++i) st[i] = *(const GAS v4u*)(src + (size_t)(tid + 512 * (i0 + i)) * 8);
#pragma unroll
            for (int i = 0; i < 4; ++i) { const int c = tid + 512 * (i0 + i), row = c >> 4, ch = c & 15; *(LAS v4u*)(lds + row * 256 + ((ch ^ (row & 15)) * 16)) = st[i]; } } }
    __syncthreads();
    float ab[2][16];
#pragma unroll
    for (int p = 0; p < 2; ++p) {
        bf16x8 bq[8];
#pragma unroll
        for (int s = 0; s < 8; ++s) bq[s] = *(const GAS bf16x8*)(QP + t * DM + 256 * h + 128 * p + 16 * s + 8 * hh);
        float v[64];
#pragma unroll
        for (int nb = 0; nb < 4; ++nb) {
            f32x16 acc;
#pragma unroll
            for (int r = 0; r < 16; ++r) acc[r] = 0.f;
            const int krow = p * 128 + 32 * nb + tl;
            bf16x8 ak[8];
#pragma unroll
            for (int s = 0; s < 8; ++s) ak[s] = *(const LAS bf16x8*)(lds + krow * 256 + (((2 * s + hh) ^ (krow & 15)) * 16));
#pragma unroll
            for (int s = 0; s < 8; ++s) acc = __builtin_amdgcn_mfma_f32_32x32x16_bf16(ak[s], bq[s], acc, 0, 0, 0);
#pragma unroll
            for (int r = 0; r < 16; ++r) v[16 * nb + r] = pack_idx(acc[r], (unsigned)(32 * nb + 8 * (r >> 2) + 4 * hh + (r & 3)), 0x7fu);
        }
        top16_of_64(v);
        float pv[16];
#pragma unroll
        for (int i = 0; i < 16; ++i) pv[i] = shx(v[i], 32, lane);
        merge_top16(&v[0], pv);
#pragma unroll
        for (int i = 0; i < 16; ++i) ab[p][i] = v[i];
    }
    int e[16]; float gate[16];
    peer_candidates(ab[0], ab[1], e, gate);
    if (hh == 0) { GAS v4u* o = (GAS v4u*)(PIDX + t * 128 + h * 16);
#pragma unroll
        for (int c = 0; c < 4; ++c) o[c] = (v4u){(unsigned)e[4 * c], (unsigned)e[4 * c + 1], (unsigned)e[4 * c + 2], (unsigned)e[4 * c + 3]}; }
    else { GAS f32x4* o = (GAS f32x4*)(PGATE + t * 128 + h * 16);
#pragma unroll
        for (int c = 0; c < 4; ++c) o[c] = (f32x4){gate[4 * c], gate[4 * c + 1], gate[4 * c + 2], gate[4 * c + 3]}; }
}

typedef float f32x2 __attribute__((ext_vector_type(2)));
typedef unsigned v6u __attribute__((ext_vector_type(6)));
typedef float v32f __attribute__((ext_vector_type(32)));
typedef v4u __attribute__((aligned(8))) v4u_a8;
constexpr float PU_SCALE6 = 90.0f, PV_SCALE6 = 5.65f;
__device__ __forceinline__ unsigned enc_e2m3(float v) {
    const float a = fminf(fabsf(v), 7.5f);
    unsigned code;
    if (a < 1.0f) code = (unsigned)__builtin_rintf(a * 8.f);
    else { const unsigned b = __builtin_bit_cast(unsigned, a) - 0x3F800000u; code = ((b + 0x7FFFFu + ((b >> 20) & 1u)) >> 20) + 8u; }
    return code | (v < 0.f ? 32u : 0u);
}
__device__ __forceinline__ void convert_fp6_rows(const float* src, unsigned char* dst, int nrows, float scale, const float* gain, int gw, int NGW, int lane) {
    for (int r = gw; r < nrows; r += NGW) {
        const float* sp = src + (size_t)r * DM + 4 * lane; const float* gp = gain ? gain + (size_t)(r / PEER_N) * DM + 4 * lane : nullptr;
        unsigned w[6] = {0u, 0u, 0u, 0u, 0u, 0u};
#pragma unroll
        for (int j = 0; j < 8; ++j) { f32x4 a = *(const GAS f32x4*)(sp + 256 * j) * scale; if (gp) a = a * *(const GAS f32x4*)(gp + 256 * j);
#pragma unroll
            for (int e = 0; e < 4; ++e) { const unsigned code = enc_e2m3(a[e]); const int bp = 6 * (4 * j + e), wi = bp >> 5, sh = bp & 31;
                w[wi] |= code << sh; if (sh > 26) w[wi + 1] |= code >> (32 - sh); } }
        unsigned char* dp = dst + (size_t)r * 1536 + 24 * lane;
        *(GAS v4u_a8*)dp = (v4u){w[0], w[1], w[2], w[3]}; *(GAS v2u*)(dp + 16) = (v2u){w[4], w[5]};
    }
}
constexpr float PV_SCALE4 = 5.65f, PU_SCALE4 = 90.0f;
__device__ __forceinline__ unsigned enc_e2m1(float v) {
    const float a = fabsf(v);
    const unsigned code = a < 0.25f ? 0u : a < 0.75f ? 1u : a < 1.25f ? 2u : a < 1.75f ? 3u : a < 2.5f ? 4u : a < 3.5f ? 5u : a < 5.0f ? 6u : 7u;
    return code | (v < 0.f ? 8u : 0u);
}
__device__ __forceinline__ void convert_fp4_rows(const float* src, unsigned char* dst, int nrows, float scale, const float* gain, int gw, int NGW, int lane) {
    for (int r0 = 2 * gw; r0 < nrows; r0 += 2 * NGW) {
        f32x4 a[2][8];
#pragma unroll
        for (int q = 0; q < 2; ++q) { const float* sp = src + (size_t)(r0 + q) * DM + 4 * lane;
#pragma unroll
            for (int j = 0; j < 8; ++j) a[q][j] = *(const GAS f32x4*)(sp + 256 * j); }
#pragma unroll
        for (int q = 0; q < 2; ++q) { const int r = r0 + q; const float* gp = gain ? gain + (size_t)(r / PEER_N) * DM + 4 * lane : nullptr;
            unsigned w[4] = {0u, 0u, 0u, 0u};
#pragma unroll
            for (int j = 0; j < 8; ++j) { f32x4 v = a[q][j] * scale; if (gp) v = v * *(const GAS f32x4*)(gp + 256 * j);
#pragma unroll
                for (int e = 0; e < 4; ++e) { const int i = 4 * j + e; w[i >> 3] |= enc_e2m1(v[e]) << (4 * (i & 7)); } }
            *(GAS v4u*)(dst + (size_t)r * 1024 + 16 * lane) = (v4u){w[0], w[1], w[2], w[3]}; }
    }
}
#define PG4_LOAD(buf, tab, idlo, idhi, g) do { _Pragma("unroll") for (int i_ = 0; i_ < PG6_R; ++i_) { const int k_ = (g) * PG6_R + i_; \
        const int e_ = __builtin_amdgcn_readlane(k_ < 64 ? idlo : idhi, k_ & 63); buf[i_] = __builtin_amdgcn_raw_buffer_load_b128(tab, (int)voff4, e_ * 1024, 0); } } while (0)
#define PG4_DOT1(buf, i_, dst) do { f32x2 a_ = {0.f, 0.f}; _Pragma("unroll") for (int c_ = 0; c_ < 4; ++c_) { const unsigned u_ = buf[i_][c_]; \
        a_ += __builtin_amdgcn_cvt_scalef32_pk_f32_fp4(u_, 1.0f, 0) * x[4 * c_ + 0]; a_ += __builtin_amdgcn_cvt_scalef32_pk_f32_fp4(u_, 1.0f, 1) * x[4 * c_ + 1]; \
        a_ += __builtin_amdgcn_cvt_scalef32_pk_f32_fp4(u_, 1.0f, 2) * x[4 * c_ + 2]; a_ += __builtin_amdgcn_cvt_scalef32_pk_f32_fp4(u_, 1.0f, 3) * x[4 * c_ + 3]; } dst = a_.x + a_.y; __builtin_amdgcn_sched_barrier(0); } while (0)
#define PG4_DOT(buf, g) do { float p_[8]; _Pragma("unroll") for (int i_ = 0; i_ < 8; ++i_) PG4_DOT1(buf, i_, p_[i_]); \
        float q_[4]; _Pragma("unroll") for (int i_ = 0; i_ < 4; ++i_) { const float keep_ = b5 ? p_[i_ + 4] : p_[i_], send_ = b5 ? p_[i_] : p_[i_ + 4]; q_[i_] = keep_ + shx(send_, 32, lane); } \
        float r_[2]; _Pragma("unroll") for (int i_ = 0; i_ < 2; ++i_) { const float keep_ = b4 ? q_[i_ + 2] : q_[i_], send_ = b4 ? q_[i_] : q_[i_ + 2]; r_[i_] = keep_ + shx(send_, 16, lane); } \
        float s_; { const float keep_ = b3 ? r_[1] : r_[0], send_ = b3 ? r_[0] : r_[1]; s_ = keep_ + shx(send_, 8, lane); } \
        s_ += shx(s_, 4, lane); s_ += shx(s_, 2, lane); s_ += shx(s_, 1, lane); \
        if ((lane & 7) == 0) wl[(g) * 8 + (lane >> 3)] = s_; } while (0)
#define PG4_AXPY(buf, g) do { _Pragma("unroll") for (int i_ = 0; i_ < PG6_R; ++i_) { const float w_ = wl[(g) * PG6_R + i_]; const f32x2 wv_ = {w_, w_}; \
        _Pragma("unroll") for (int c_ = 0; c_ < 4; ++c_) { const unsigned u_ = buf[i_][c_]; \
            y[4 * c_ + 0] += __builtin_amdgcn_cvt_scalef32_pk_f32_fp4(u_, 1.0f, 0) * wv_; y[4 * c_ + 1] += __builtin_amdgcn_cvt_scalef32_pk_f32_fp4(u_, 1.0f, 1) * wv_; \
            y[4 * c_ + 2] += __builtin_amdgcn_cvt_scalef32_pk_f32_fp4(u_, 1.0f, 2) * wv_; y[4 * c_ + 3] += __builtin_amdgcn_cvt_scalef32_pk_f32_fp4(u_, 1.0f, 3) * wv_; } \
        __builtin_amdgcn_sched_barrier(0); } } while (0)
#ifndef PG6_R
#define PG6_R 8
#endif
#define PG6_LOAD(buf, tab, idlo, idhi, g) do { _Pragma("unroll") for (int i_ = 0; i_ < PG6_R; ++i_) { const int k_ = (g) * PG6_R + i_; \
        const int e_ = __builtin_amdgcn_readlane(k_ < 64 ? idlo : idhi, k_ & 63); const unsigned char* rp_ = (tab) + (size_t)(unsigned)e_ * 1536u; \
        const v4u a_ = *(const GAS v4u_a8*)(rp_ + voff); const v2u b_ = *(const GAS v2u*)(rp_ + voff + 16); buf[i_] = (v6u){a_.x, a_.y, a_.z, a_.w, b_.x, b_.y}; } } while (0)
#define PG6_DOT1(buf, i_, dst) do { const v32f f_ = __builtin_amdgcn_cvt_scalef32_pk32_f32_fp6(buf[i_], 1.0f); f32x2 a_ = {0.f, 0.f}; \
        _Pragma("unroll") for (int c_ = 0; c_ < 16; ++c_) a_ += (f32x2){f_[2 * c_], f_[2 * c_ + 1]} * x[c_]; dst = a_.x + a_.y; __builtin_amdgcn_sched_barrier(0); } while (0)
#if PG6_R == 8
#define PG6_DOT(buf, g) do { float p_[8]; _Pragma("unroll") for (int i_ = 0; i_ < 8; ++i_) PG6_DOT1(buf, i_, p_[i_]); \
        float q_[4]; _Pragma("unroll") for (int i_ = 0; i_ < 4; ++i_) { const float keep_ = b5 ? p_[i_ + 4] : p_[i_], send_ = b5 ? p_[i_] : p_[i_ + 4]; q_[i_] = keep_ + shx(send_, 32, lane); } \
        float r_[2]; _Pragma("unroll") for (int i_ = 0; i_ < 2; ++i_) { const float keep_ = b4 ? q_[i_ + 2] : q_[i_], send_ = b4 ? q_[i_] : q_[i_ + 2]; r_[i_] = keep_ + shx(send_, 16, lane); } \
        float s_; { const float keep_ = b3 ? r_[1] : r_[0], send_ = b3 ? r_[0] : r_[1]; s_ = keep_ + shx(send_, 8, lane); } \
        s_ += shx(s_, 4, lane); s_ += shx(s_, 2, lane); s_ += shx(s_, 1, lane); \
        if ((lane & 7) == 0) wl[(g) * 8 + (lane >> 3)] = s_; } while (0)
#else
#define PG6_DOT(buf, g) do { float p_[4]; _Pragma("unroll") for (int i_ = 0; i_ < 4; ++i_) PG6_DOT1(buf, i_, p_[i_]); \
        float r_[2]; _Pragma("unroll") for (int i_ = 0; i_ < 2; ++i_) { const float keep_ = b5 ? p_[i_ + 2] : p_[i_], send_ = b5 ? p_[i_] : p_[i_ + 2]; r_[i_] = keep_ + shx(send_, 32, lane); } \
        float s_; { const float keep_ = b4 ? r_[1] : r_[0], send_ = b4 ? r_[0] : r_[1]; s_ = keep_ + shx(send_, 16, lane); } \
        s_ += shx(s_, 8, lane); s_ += shx(s_, 4, lane); s_ += shx(s_, 2, lane); s_ += shx(s_, 1, lane); \
        if ((lane & 15) == 0) wl[(g) * 4 + (lane >> 4)] = s_; } while (0)
#endif
#define PG6_AXPY(buf, g) do { _Pragma("unroll") for (int i_ = 0; i_ < PG6_R; ++i_) { const float w_ = wl[(g) * PG6_R + i_]; const f32x2 wv_ = {w_, w_}; \
        const v32f f_ = __builtin_amdgcn_cvt_scalef32_pk32_f32_fp6(buf[i_], 1.0f); _Pragma("unroll") for (int c_ = 0; c_ < 16; ++c_) y[c_] += (f32x2){f_[2 * c_], f_[2 * c_ + 1]} * wv_; __builtin_amdgcn_sched_barrier(0); } } while (0)
__device__ __forceinline__ unsigned shxu(unsigned v, int k, int lane) { return (unsigned)__builtin_amdgcn_ds_bpermute((lane ^ k) << 2, (int)v); }
__device__ __forceinline__ void wave_sort128(unsigned& a, unsigned& b, int lane) {
#pragma unroll
    for (int k = 2; k <= 128; k <<= 1) {
#pragma unroll
        for (int j = k >> 1; j > 0; j >>= 1) {
            if (j == 64) { const unsigned lo = a < b ? a : b, hi = a < b ? b : a; a = lo; b = hi; }
            else {
                const unsigned pa = shxu(a, j, lane), pb = shxu(b, j, lane);
                const bool lower = (lane & j) == 0;
                const bool asc_a = (lane & k) == 0, asc_b = ((lane + 64) & k) == 0;
                const bool take_min_a = (lower == asc_a), take_min_b = (lower == asc_b);
                a = take_min_a ? (a < pa ? a : pa) : (a < pa ? pa : a);
                b = take_min_b ? (b < pb ? b : pb) : (b < pb ? pb : b);
            }
        }
    }
}
#ifndef PEER_U_FP4
#define PEER_U_FP4 1
#endif
#if PEER_U_FP4
typedef v4u urow_t;
#define PGU_LOAD PG4_LOAD
#define PGU_DOT PG4_DOT
constexpr float PU_SCALE = PU_SCALE4; constexpr int PU_STRIDE = 1024;
#else
typedef v6u urow_t;
#define PGU_LOAD PG6_LOAD
#define PGU_DOT PG6_DOT
constexpr float PU_SCALE = PU_SCALE6; constexpr int PU_STRIDE = 1536;
#endif
constexpr float PU_SCALEI = 135.0f, PX_SCALEI = 20.0f;
__device__ __forceinline__ void peer_v_pass(bf16* XN, const unsigned char* PV6, const int* PIDX, const float* PGATE, const int* PARTI, float* X, u64_t* rowsq_out, unsigned char* XN8, float* xsc, const u64_t* rowsq1, const u64_t* rowsq2, LAS float* wl, int gw, int NGW, int lane) {
    const unsigned voff4 = 16u * (unsigned)lane, l4 = 4u * (unsigned)lane, l8 = 8u * (unsigned)lane, l16 = 16u * (unsigned)lane;
    constexpr int NG = 128 / PG6_R;
    const __amdgpu_buffer_rsrc_t PVr = __builtin_amdgcn_make_buffer_rsrc((void*)PV6, 0, PEER_N * 1024, 0x00020000);
    for (int t_ = gw; t_ < T; t_ += NGW) {
        int t = t_; asm volatile("" : "+s"(t));
        const char* pidx_t = (const char*)(PIDX + (size_t)t * 128); const char* pgate_t = (const char*)(PGATE + (size_t)t * 128);
        const int idlo = *(const GAS int*)(pidx_t + l4), idhi = *(const GAS int*)(pidx_t + l4 + 256);
        v4u AV[PG6_R], BV[PG6_R];
        PG4_LOAD(AV, PVr, idlo, idhi, 0);
        {
            int s0 = 0, s1 = 0;
#pragma unroll
            for (int sp = 0; sp < 8; ++sp) { const char* pp = (const char*)(PARTI + ((size_t)sp * T + t) * 128); s0 += *(const GAS int*)(pp + l4); s1 += *(const GAS int*)(pp + l4 + 256); }
            const float sct = (8.0f / 127.0f / PU_SCALEI) * rowsq_rs(rowsq2, t) / rowsq_rs(rowsq1, t);
            const float d0 = (float)s0 * sct, d1 = (float)s1 * sct;
            const float g0 = *(const GAS float*)(pgate_t + l4), g1 = *(const GAS float*)(pgate_t + l4 + 256);
            const float w0 = g0 * 0.5f * d0 * (1.f + erff(d0 * 0.70710678118654752f)) * (1.f / PV_SCALE4), w1 = g1 * 0.5f * d1 * (1.f + erff(d1 * 0.70710678118654752f)) * (1.f / PV_SCALE4);
            wl[lane] = w0; wl[64 + lane] = w1;
            LDS_WAIT(); asm volatile("" ::: "memory");
        }
        f32x2 y[16];
#pragma unroll
        for (int i = 0; i < 16; ++i) y[i] = (f32x2){0.f, 0.f};
#pragma unroll 1
        for (int g = 0; g < NG; g += 2) {
            PG4_LOAD(BV, PVr, idlo, idhi, g + 1);
            PG4_AXPY(AV, g);
            if (g + 2 < NG) PG4_LOAD(AV, PVr, idlo, idhi, g + 2);
            PG4_AXPY(BV, g + 1);
        }
        {   char* xo = (char*)(X + (size_t)t * DM);
            char* xbo = (char*)(XN + (size_t)t * DM); float ss = 0.f;
#pragma unroll
            for (int j = 0; j < 8; ++j) { const v2u a = *(const GAS v2u*)(xbo + l8 + 512 * j); f32x4 v = (f32x4){bflo(a.x), bfhi(a.x), bflo(a.y), bfhi(a.y)}; v += (f32x4){y[2 * j].x, y[2 * j].y, y[2 * j + 1].x, y[2 * j + 1].y};
                if (X) *(GAS f32x4*)(xo + l16 + 1024 * j) = v;
                y[2 * j] = (f32x2){v[0], v[1]}; y[2 * j + 1] = (f32x2){v[2], v[3]};
                ss += (v[0] * v[0] + v[1] * v[1]) + (v[2] * v[2] + v[3] * v[3]); *(GAS v2u*)(xbo + l8 + 512 * j) = (v2u){pk2(v[0], v[1]), pk2(v[2], v[3])}; }
            if (rowsq_out) { ss = wave_sum(ss, lane); if (lane == 0) rowsq_out[t] = rowsq_fx(ss); }
            if (XN8) {
                float am = 0.f;
#pragma unroll
                for (int j = 0; j < 16; ++j) am = fmaxf(am, fmaxf(fabsf(y[j].x), fabsf(y[j].y)));
                am = fmaxf(wave_max(am, lane), 1e-30f);
                const float inv = 127.f / am; char* qo = (char*)(XN8 + (size_t)t * DM);
#pragma unroll
                for (int j = 0; j < 8; ++j) *(GAS unsigned*)(qo + l4 + 256 * j) = q8x4((f32x4){y[2 * j].x, y[2 * j].y, y[2 * j + 1].x, y[2 * j + 1].y}, inv);
                if (lane == 0) xsc[t] = am * (1.f / 127.f) / sqrtf(ss * (1.f / DM) + 1e-6f); } }
        LDS_WAIT(); asm volatile("" ::: "memory");
    }
}


__device__ __forceinline__ unsigned enc_i4(float v) { int q = (int)__builtin_rintf(v); q = q < -7 ? -7 : (q > 7 ? 7 : q); return (unsigned)q & 15u; }
__device__ __forceinline__ void convert_int4_plain(const float* src, unsigned char* dst, int nrows, float scale, const float* gain, int gw, int NGW, int lane) {
    for (int r0 = 2 * gw; r0 < nrows; r0 += 2 * NGW) {
        f32x4 a[2][8];
#pragma unroll
        for (int q = 0; q < 2; ++q) { const float* sp = src + (size_t)(r0 + q) * DM + 4 * lane;
#pragma unroll
            for (int j = 0; j < 8; ++j) a[q][j] = *(const GAS f32x4*)(sp + 256 * j); }
#pragma unroll
        for (int q = 0; q < 2; ++q) { const int r = r0 + q; const float* gp = gain ? gain + (size_t)(r / PEER_N) * DM + 4 * lane : nullptr;
#pragma unroll
            for (int j = 0; j < 8; ++j) { f32x4 v = a[q][j] * scale; if (gp) v = v * *(const GAS f32x4*)(gp + 256 * j);
                const unsigned w = enc_i4(v[0]) | (enc_i4(v[1]) << 4) | (enc_i4(v[2]) << 8) | (enc_i4(v[3]) << 12);
                *(GAS unsigned short*)(dst + (size_t)r * 1024 + 128 * j + 2 * lane) = (unsigned short)w; } }
    }
}
__device__ __forceinline__ void peer_xquant_unit(const bf16* XN, const u64_t* rowsq, unsigned* XQH, unsigned* XQL, int tb, int sl, int tid) {
    for (int it = tid; it < 256 * 32; it += NTHREADS) {
        const int t = tb * 256 + (it >> 5), c8 = it & 31;
        const float xs = PX_SCALEI * rowsq_rs(rowsq, t);
        const v4u w = *(const GAS v4u*)(XN + (size_t)t * DM + 256 * sl + 8 * c8);
        const float f[8] = {bflo(w.x), bfhi(w.x), bflo(w.y), bfhi(w.y), bflo(w.z), bfhi(w.z), bflo(w.w), bfhi(w.w)};
        unsigned hi = 0u, lo = 0u;
#pragma unroll
        for (int j = 0; j < 8; ++j) { int q = (int)__builtin_rintf(f[j] * xs); q = q < -119 ? -119 : (q > 119 ? 119 : q);
            const int xl = ((q + 8) & 15) - 8, xh = (q - xl) >> 4;
            hi |= ((unsigned)xh & 15u) << (4 * j); lo |= ((unsigned)xl & 15u) << (4 * j); }
        XQH[(size_t)t * 256 + 32 * sl + c8] = hi; XQL[(size_t)t * 256 + 32 * sl + c8] = lo;
    }
}
#define PI_LOADROWS(buf, tab, ids, i0) do { _Pragma("unroll") for (int i_ = 0; i_ < 8; ++i_) buf[i_] = __builtin_amdgcn_raw_buffer_load_b128(tab, ids[(i0) + i_] * 1024 + (int)soff, 0, 0); } while (0)
#define PI_LOADIDS(ids, t) do { const char* ip_ = (const char*)PIDX + ((size_t)(t) * 128 + 16 * g) * 4; _Pragma("unroll") for (int c_ = 0; c_ < 4; ++c_) { const v4u q_ = *(const GAS v4u*)(ip_ + 16 * c_); \
        ids[4 * c_] = (int)q_.x; ids[4 * c_ + 1] = (int)q_.y; ids[4 * c_ + 2] = (int)q_.z; ids[4 * c_ + 3] = (int)q_.w; } } while (0)
#define PI_UGROUP(buf, i0) do { _Pragma("unroll") for (int i_ = 0; i_ < 8; ++i_) { int ah_ = 0, al_ = 0; \
        _Pragma("unroll") for (int c_ = 0; c_ < 4; ++c_) { ah_ = __builtin_amdgcn_sdot8((int)buf[i_][c_], (int)xh[c_], ah_, false); al_ = __builtin_amdgcn_sdot8((int)buf[i_][c_], (int)xl[c_], al_, false); } \
        int p_ = 16 * ah_ + al_; p_ += __builtin_amdgcn_ds_bpermute((lane ^ 1) << 2, p_); p_ += __builtin_amdgcn_ds_bpermute((lane ^ 2) << 2, p_); p_ += __builtin_amdgcn_ds_bpermute((lane ^ 4) << 2, p_); \
        if (m == (((i0) + i_) >> 1)) { if (((i0) + i_) & 1) keep1 = p_; else keep0 = p_; } } } while (0)
#define PI_LOADROWS16(buf, tab, ids) do { _Pragma("unroll") for (int i_ = 0; i_ < 16; ++i_) buf[i_] = __builtin_amdgcn_raw_buffer_load_b128(tab, ids[i_] * 1024 + (int)soff, 0, 0); } while (0)
#define PI_LOADX(xh_, xl_, t) do { xh_ = *(const GAS v4u*)((const char*)XQH + (size_t)(t) * 1024 + soff); xl_ = *(const GAS v4u*)((const char*)XQL + (size_t)(t) * 1024 + soff); } while (0)
#define PI_COMPUTE16(buf, xh_, xl_, t) do { int keep0 = 0, keep1 = 0; \
        _Pragma("unroll") for (int i_ = 0; i_ < 16; ++i_) { int ah_ = 0, al_ = 0; \
            _Pragma("unroll") for (int c_ = 0; c_ < 4; ++c_) { ah_ = __builtin_amdgcn_sdot8((int)buf[i_][c_], (int)xh_[c_], ah_, false); al_ = __builtin_amdgcn_sdot8((int)buf[i_][c_], (int)xl_[c_], al_, false); } \
            int p_ = 16 * ah_ + al_; p_ += __builtin_amdgcn_update_dpp(0, p_, 0xB1, 0xf, 0xf, true); p_ += __builtin_amdgcn_update_dpp(0, p_, 0x4E, 0xf, 0xf, true); p_ += __builtin_amdgcn_update_dpp(0, p_, 0x141, 0xf, 0xf, true);   \
            if (m == (i_ >> 1)) { if (i_ & 1) keep1 = p_; else keep0 = p_; } } \
        if ((t) < T) *(GAS v2u*)(PARTI + ((size_t)s * T + (t)) * 128 + 2 * lane) = (v2u){(unsigned)keep0, (unsigned)keep1}; } while (0)
__device__ __forceinline__ void peer_u_phase_i4(const unsigned* XQH, const unsigned* XQL, const unsigned char* PU, const int* PIDX, int* PARTI, int bid, int G, int wave, int lane) {
    const int s = bid & 7, nr = (G - s + 7) >> 3, q = (bid >> 3) * NWAVES + wave, stride = nr * NWAVES, g = lane >> 3, m = lane & 7;
    const unsigned soff = 128u * (unsigned)s + 16u * (unsigned)m;
    if (q >= T) return;
    const __amdgpu_buffer_rsrc_t PUr = __builtin_amdgcn_make_buffer_rsrc((void*)PU, 0, PEER_N * 1024, 0x00020000);
#define PI_CL(t) ((t) < T ? (t) : T - 1)
    int I1[16], I2[16]; v4u xh0, xl0, xh1, xl1, xh2, xl2, RA[16], RB[16];
    PI_LOADIDS(I1, q); PI_LOADX(xh0, xl0, q);
    PI_LOADROWS16(RA, PUr, I1);
    PI_LOADIDS(I1, PI_CL(q + stride)); PI_LOADX(xh1, xl1, PI_CL(q + stride));
    for (int t = q; t < T; t += 2 * stride) {
        PI_LOADROWS16(RB, PUr, I1);
        PI_LOADIDS(I2, PI_CL(t + 2 * stride)); PI_LOADX(xh2, xl2, PI_CL(t + 2 * stride));
        PI_COMPUTE16(RA, xh0, xl0, t);
        PI_LOADROWS16(RA, PUr, I2);
        PI_LOADIDS(I1, PI_CL(t + 3 * stride)); PI_LOADX(xh0, xl0, PI_CL(t + 3 * stride));
        PI_COMPUTE16(RB, xh1, xl1, t + stride);
        xh1 = xh0; xl1 = xl0; xh0 = xh2; xl0 = xl2;
    }
#undef PI_CL
}


constexpr float PV_SCALE4S = 5.65f;
__device__ __forceinline__ unsigned enc_e2m1s(float v) {
    const float a = fabsf(v);
    const unsigned code = a < 0.25f ? 0u : a < 0.75f ? 1u : a < 1.25f ? 2u : a < 1.75f ? 3u : a < 2.5f ? 4u : a < 3.5f ? 5u : a < 5.0f ? 6u : 7u;
    return code | (v < 0.f ? 8u : 0u);
}
__device__ __forceinline__ void convert_fp4_plain(const float* src, unsigned char* dst, int nrows, float scale, const float* gain, int gw, int NGW, int lane) {
    for (int r0 = 2 * gw; r0 < nrows; r0 += 2 * NGW) {
        f32x4 a[2][8];
#pragma unroll
        for (int q = 0; q < 2; ++q) { const float* sp = src + (size_t)(r0 + q) * DM + 4 * lane;
#pragma unroll
            for (int j = 0; j < 8; ++j) a[q][j] = *(const GAS f32x4*)(sp + 256 * j); }
#pragma unroll
        for (int q = 0; q < 2; ++q) { const int r = r0 + q; const float* gp = gain ? gain + (size_t)(r / PEER_N) * DM + 4 * lane : nullptr;
#pragma unroll
            for (int j = 0; j < 8; ++j) { f32x4 v = a[q][j] * scale; if (gp) v = v * *(const GAS f32x4*)(gp + 256 * j);
                const unsigned w = enc_e2m1s(v[0]) | (enc_e2m1s(v[1]) << 4) | (enc_e2m1s(v[2]) << 8) | (enc_e2m1s(v[3]) << 12);
                *(GAS unsigned short*)(dst + (size_t)r * 1024 + 128 * j + 2 * lane) = (unsigned short)w; } }
    }
}
#define PVS_LOADMETA(ids, pp, gg, t) do { PI_LOADIDS(ids, t); _Pragma("unroll") for (int sp_ = 0; sp_ < 8; ++sp_) pp[sp_] = *(const GAS v2u*)(PARTI + ((size_t)sp_ * T + (t)) * 128 + 2 * lane); \
        gg = *(const GAS f32x2*)(PGATE + (size_t)(t) * 128 + 2 * lane); } while (0)
#define PVS_COMPUTE16(buf, pp, gg, t) do { float w0, w1; { int s0_ = 0, s1_ = 0; _Pragma("unroll") for (int sp_ = 0; sp_ < 8; ++sp_) { s0_ += (int)pp[sp_].x; s1_ += (int)pp[sp_].y; } \
            const float d0_ = (float)s0_ * (1.f / (PX_SCALEI * PU_SCALEI)), d1_ = (float)s1_ * (1.f / (PX_SCALEI * PU_SCALEI)); \
            w0 = gg.x * 0.5f * d0_ * (1.f + erff(d0_ * 0.70710678118654752f)) * (1.f / PV_SCALE4S); w1 = gg.y * 0.5f * d1_ * (1.f + erff(d1_ * 0.70710678118654752f)) * (1.f / PV_SCALE4S); } \
        f32x2 y[16]; _Pragma("unroll") for (int i_ = 0; i_ < 16; ++i_) y[i_] = (f32x2){0.f, 0.f}; \
        _Pragma("unroll") for (int i_ = 0; i_ < 16; ++i_) { \
            const float w_ = __builtin_bit_cast(float, __builtin_amdgcn_ds_bpermute(((lane & 56) | (i_ >> 1)) << 2, __builtin_bit_cast(int, (i_ & 1) ? w1 : w0))); const f32x2 wv_ = {w_, w_}; \
            _Pragma("unroll") for (int c_ = 0; c_ < 4; ++c_) { const unsigned u_ = buf[i_][c_]; \
                y[4 * c_ + 0] += __builtin_amdgcn_cvt_scalef32_pk_f32_fp4(u_, 1.0f, 0) * wv_; y[4 * c_ + 1] += __builtin_amdgcn_cvt_scalef32_pk_f32_fp4(u_, 1.0f, 1) * wv_; \
                y[4 * c_ + 2] += __builtin_amdgcn_cvt_scalef32_pk_f32_fp4(u_, 1.0f, 2) * wv_; y[4 * c_ + 3] += __builtin_amdgcn_cvt_scalef32_pk_f32_fp4(u_, 1.0f, 3) * wv_; } } \
        {   LAS float* wp_ = yl + g * 288 + m * 36; \
            _Pragma("unroll") for (int c_ = 0; c_ < 8; ++c_) *(LAS f32x4*)(wp_ + 4 * c_) = (f32x4){y[2 * c_].x, y[2 * c_].y, y[2 * c_ + 1].x, y[2 * c_ + 1].y}; \
            LDS_WAIT(); asm volatile("" ::: "memory"); \
            f32x4 acc_ = {0.f, 0.f, 0.f, 0.f}; const LAS float* rp_ = yl + (lane >> 3) * 36 + 4 * (lane & 7); \
            _Pragma("unroll") for (int gg_ = 0; gg_ < 8; ++gg_) acc_ += *(const LAS f32x4*)(rp_ + gg_ * 288); \
            LDS_WAIT(); asm volatile("" ::: "memory"); \
            if ((t) < T) { bf16* xp_ = XN + (size_t)(t) * DM + 256 * s + 4 * lane; const v2u a_ = *(const GAS v2u*)xp_; \
                const f32x4 v_ = (f32x4){bflo(a_.x), bfhi(a_.x), bflo(a_.y), bfhi(a_.y)} + acc_; \
                *(GAS v2u*)xp_ = (v2u){pk2(v_[0], v_[1]), pk2(v_[2], v_[3])}; \
                if (Xout) *(GAS f32x4*)(Xout + (size_t)(t) * DM + 256 * s + 4 * lane) = v_; \
                if (rowsq_out) { const float ss_ = wave_sum((v_[0] * v_[0] + v_[1] * v_[1]) + (v_[2] * v_[2] + v_[3] * v_[3]), lane); if (lane == 0) atomicAdd(rowsq_out + (t), rowsq_fx(ss_)); } } } } while (0)
__device__ __forceinline__ void peer_v_phase_s(bf16* XN, const unsigned char* PV, const int* PIDX, const float* PGATE, const int* PARTI, float* Xout, u64_t* rowsq_out, LAS float* yl, int bid, int G, int wave, int lane) {
    const int s = bid & 7, nr = (G - s + 7) >> 3, q = (bid >> 3) * NWAVES + wave, stride = nr * NWAVES, g = lane >> 3, m = lane & 7;
    const unsigned soff = 128u * (unsigned)s + 16u * (unsigned)m;
    if (q >= T) return;
    const __amdgpu_buffer_rsrc_t PVr = __builtin_amdgcn_make_buffer_rsrc((void*)PV, 0, PEER_N * 1024, 0x00020000);
#define PVS_CL(t) ((t) < T ? (t) : T - 1)
    int I0[16], I1[16]; v2u P0[8], P1[8]; f32x2 G0, G1; v4u RA[16], RB[16];
#define PVS_LOADPG(pp, gg, t) do { _Pragma("unroll") for (int sp_ = 0; sp_ < 8; ++sp_) pp[sp_] = *(const GAS v2u*)(PARTI + ((size_t)sp_ * T + (t)) * 128 + 2 * lane); gg = *(const GAS f32x2*)(PGATE + (size_t)(t) * 128 + 2 * lane); } while (0)
    PI_LOADIDS(I0, q); PVS_LOADPG(P0, G0, q);
    PI_LOADROWS16(RA, PVr, I0);
    PI_LOADIDS(I1, PVS_CL(q + stride)); PVS_LOADPG(P1, G1, PVS_CL(q + stride));
    for (int t = q; t < T; t += 2 * stride) {
        PI_LOADROWS16(RB, PVr, I1);
        PI_LOADIDS(I0, PVS_CL(t + 2 * stride));
        PVS_COMPUTE16(RA, P0, G0, t);
        PVS_LOADPG(P0, G0, PVS_CL(t + 2 * stride));
        PI_LOADROWS16(RA, PVr, I0);
        PI_LOADIDS(I1, PVS_CL(t + 3 * stride));
        PVS_COMPUTE16(RB, P1, G1, t + stride);
        PVS_LOADPG(P1, G1, PVS_CL(t + 3 * stride));
    }
#undef PVS_LOADPG
#undef PVS_CL
}

typedef short s16x4 __attribute__((ext_vector_type(4)));
typedef __attribute__((address_space(3))) const char* lds_cptr;
__device__ __forceinline__ s16x4 vtr(lds_cptr p) { return __builtin_bit_cast(s16x4, __builtin_amdgcn_ds_read_tr16_b64_v4i16((__attribute__((address_space(3))) s16x4*)p)); }
__device__ __forceinline__ unsigned cvtpk(float lo, float hi) { unsigned r; asm("v_cvt_pk_bf16_f32 %0, %1, %2" : "=v"(r) : "v"(lo), "v"(hi)); return r; }
constexpr int AT_K0 = 0, AT_V0 = 16384, AT_TAB = 32768;
constexpr float LOG2E = 1.4426950408889634f;
template <int TYPE>
__device__ __forceinline__ void attn_unit(LAS unsigned char* lds, const bf16* QKV, bf16* ATT, u64_t* mixsq, int b, int head, int qb, const float* tabsrc, float Cl2, float sinkl2, int tid) {
    const int lane = tid & 63, w = __builtin_amdgcn_readfirstlane(tid >> 6), hh = lane >> 5, l31 = lane & 31;
    int qcol, kcol, vcol, ocol;
    if (TYPE == 0) { qcol = QA + head * 64; kcol = KA + (head / 3) * 64; vcol = VA + (head / 3) * 64; ocol = OA + head * 64; }
    else if (TYPE == 1) { qcol = QB + head * 64; kcol = KB + head * 64; vcol = VB + head * 64; ocol = OB + head * 64; }
    else { qcol = QC + head * 64; kcol = KC + (head / 3) * 64; vcol = VC + (head / 3) * 64; ocol = OC + head * 64; }
    const int q0 = 256 * qb + 32 * w, qpos = q0 + l31;
    int t_begin, t_end;
    if (TYPE == 0) { t_begin = 4 * qb - 2; if (t_begin < 0) t_begin = 0; t_end = 4 * qb + 6; if (t_end > 32) t_end = 32; }
    else if (TYPE == 1) { int a = 4 * qb - 4; a = a < 0 ? 0 : (a > 24 ? 24 : a); int e = 4 * qb - 1; e = e < 0 ? 0 : (e > 24 ? 24 : e); t_begin = a; t_end = e + 8; }
    else { t_begin = 0; t_end = 32; }
    LAS float* tab = (LAS float*)(lds + AT_TAB);
    if (TYPE == 0) { for (int i = tid; i < 1024; i += NTHREADS) { const int rel = i - 448; tab[i] = (rel >= -128 && rel <= 128) ? tabsrc[head * 257 + rel + 128] * LOG2E - Cl2 : -1e30f; } }
    if (TYPE == 1) { for (int i = tid; i < 15 * 31; i += NTHREADS) tab[i] = tabsrc[head * 465 + i] * LOG2E - Cl2; }
    bf16x8 qf[4];
    {   const bf16* qp = QKV + ((size_t)b * SEQ + qpos) * DIN + qcol + 8 * hh;
#pragma unroll
        for (int s = 0; s < 4; ++s) qf[s] = *(const GAS bf16x8*)(qp + 16 * s); }
    const int srow = tid >> 3, sch = tid & 7;
    const bf16* kg = QKV + ((size_t)b * SEQ + srow) * DIN + kcol + sch * 8;
    const bf16* vg = QKV + ((size_t)b * SEQ + srow) * DIN + vcol + sch * 8;
    const int kst = srow * 128 + ((sch ^ ((srow >> 1) & 7)) * 16);
    const int vst = srow * 128 + (((sch >> 2) ^ ((srow >> 1) & 1)) * 64) + (sch & 3) * 16;
    int kread[4], vread[2];
#pragma unroll
    for (int s = 0; s < 4; ++s) kread[s] = l31 * 128 + (((2 * s + hh) ^ ((lane >> 1) & 7)) * 16);
#pragma unroll
    for (int db = 0; db < 2; ++db) vread[db] = (4 * hh + ((lane >> 2) & 3)) * 128 + ((db ^ ((lane >> 3) & 1)) * 64) + 32 * ((lane >> 4) & 1) + 8 * (lane & 3);
    f32x16 O0, O1;
#pragma unroll
    for (int r = 0; r < 16; ++r) { O0[r] = 0.f; O1[r] = 0.f; }
    float lsum = 0.f;
    const int rw = 4 * qb + (w >> 1), cq = 32 * (w & 1) + l31;
    int r0w = rw - 4; r0w = r0w < 0 ? 0 : (r0w > 24 ? 24 : r0w);
    int c0 = cq - 8; c0 = c0 < 0 ? 0 : (c0 > 48 ? 48 : c0);
    {   const v4u kr = *(const GAS v4u*)(kg + (size_t)t_begin * 64 * DIN), vr = *(const GAS v4u*)(vg + (size_t)t_begin * 64 * DIN);
        *(LAS v4u*)(lds + AT_K0 + kst) = kr; *(LAS v4u*)(lds + AT_V0 + vst) = vr; }
    __syncthreads();
    for (int t = t_begin; t < t_end; ++t) {
        const int cur = (t - t_begin) & 1;
        v4u kr, vr;
        if (t + 1 < t_end) { kr = *(const GAS v4u*)(kg + (size_t)(t + 1) * 64 * DIN); vr = *(const GAS v4u*)(vg + (size_t)(t + 1) * 64 * DIN); }
        bool need = true;
        if (TYPE == 0) need = (64 * t <= q0 + 31 + 128) && (64 * t + 63 >= q0 - 128);
        if (TYPE == 1) need = (t >= r0w) && (t < r0w + 8);
        if (need) {
            const lds_cptr kb_ = (lds_cptr)(lds + AT_K0 + cur * 8192), vb_ = (lds_cptr)(lds + AT_V0 + cur * 8192);
            bf16x8 kf[8];
#pragma unroll
            for (int s = 0; s < 4; ++s) { kf[2 * s] = *(const LAS bf16x8*)(kb_ + kread[s]); kf[2 * s + 1] = *(const LAS bf16x8*)(kb_ + kread[s] + 4096); }
            f32x16 S0, S1;
            if (TYPE == 2) {
#pragma unroll
                for (int r = 0; r < 16; ++r) { S0[r] = -Cl2; S1[r] = -Cl2; }
            } else if (TYPE == 0) {
                const LAS float* tb = tab + (64 * t - qpos + 448 + 4 * hh);
#pragma unroll
                for (int r = 0; r < 16; ++r) { S0[r] = tb[8 * (r >> 2) + (r & 3)]; S1[r] = tb[32 + 8 * (r >> 2) + (r & 3)]; }
            } else {
                const LAS float* tb = tab + ((t - rw + 7) * 31 - cq + 15 + 4 * hh);
                const int kc0 = 4 * hh - c0;
#pragma unroll
                for (int r = 0; r < 16; ++r) { const int ka = 8 * (r >> 2) + (r & 3), kb2 = 32 + ka;
                    S0[r] = ((unsigned)(ka + kc0) < 16u) ? tb[ka] : -1e30f; S1[r] = ((unsigned)(kb2 + kc0) < 16u) ? tb[kb2] : -1e30f; }
            }
            __builtin_amdgcn_sched_barrier(0);
#define AT_SB __builtin_amdgcn_sched_barrier(0)
#define AT_SOFT(SX, base, dst) do { _Pragma("unroll") for (int r = (base); r < (base) + 8; ++r) SX[r] = __builtin_amdgcn_exp2f(SX[r]); \
            lsum += ((SX[(base)] + SX[(base) + 1]) + (SX[(base) + 2] + SX[(base) + 3])) + ((SX[(base) + 4] + SX[(base) + 5]) + (SX[(base) + 6] + SX[(base) + 7])); \
            v4u a_; _Pragma("unroll") for (int j = 0; j < 4; ++j) a_[j] = cvtpk(SX[(base) + 2 * j], SX[(base) + 2 * j + 1]); dst = __builtin_bit_cast(bf16x8, a_); } while (0)
#pragma unroll
            for (int s = 0; s < 4; ++s) S0 = __builtin_amdgcn_mfma_f32_32x32x16_bf16(kf[2 * s], qf[s], S0, 0, 0, 0);
            s16x4 vf[4][2][2];
#pragma unroll
            for (int ks = 0; ks < 2; ++ks)
#pragma unroll
                for (int db = 0; db < 2; ++db) { vf[ks][db][0] = vtr(vb_ + vread[db] + (16 * ks) * 128); vf[ks][db][1] = vtr(vb_ + vread[db] + (16 * ks + 8) * 128); }
            S1 = __builtin_amdgcn_mfma_f32_32x32x16_bf16(kf[1], qf[0], S1, 0, 0, 0); S1 = __builtin_amdgcn_mfma_f32_32x32x16_bf16(kf[3], qf[1], S1, 0, 0, 0);
            AT_SB;
            bf16x8 pb[4];
            AT_SOFT(S0, 0, pb[0]);
            AT_SB;
            S1 = __builtin_amdgcn_mfma_f32_32x32x16_bf16(kf[5], qf[2], S1, 0, 0, 0);
            AT_SB;
            AT_SOFT(S0, 8, pb[1]);
            AT_SB;
            S1 = __builtin_amdgcn_mfma_f32_32x32x16_bf16(kf[7], qf[3], S1, 0, 0, 0);
            asm volatile("s_waitcnt lgkmcnt(7)" ::: "memory");
#pragma unroll
            for (int ks = 2; ks < 4; ++ks)
#pragma unroll
                for (int db = 0; db < 2; ++db) { vf[ks][db][0] = vtr(vb_ + vread[db] + (16 * ks) * 128); vf[ks][db][1] = vtr(vb_ + vread[db] + (16 * ks + 8) * 128); }
            AT_SB;
#define AT_PV(ks) do { const bf16x8 va = __builtin_shufflevector(vf[ks][0][0], vf[ks][0][1], 0, 1, 2, 3, 4, 5, 6, 7), vb2 = __builtin_shufflevector(vf[ks][1][0], vf[ks][1][1], 0, 1, 2, 3, 4, 5, 6, 7); \
            O0 = __builtin_amdgcn_mfma_f32_32x32x16_bf16(va, pb[ks], O0, 0, 0, 0); O1 = __builtin_amdgcn_mfma_f32_32x32x16_bf16(vb2, pb[ks], O1, 0, 0, 0); } while (0)
            AT_PV(0);
            AT_SB;
            AT_SOFT(S1, 0, pb[2]);
            AT_SB;
            AT_PV(1);
            AT_SB;
            AT_SOFT(S1, 8, pb[3]);
            AT_SB;
            AT_PV(2); AT_PV(3);
#undef AT_PV
#undef AT_SOFT
#undef AT_SB
        }
        __builtin_amdgcn_sched_barrier(0);
        if (t + 1 < t_end) { *(LAS v4u*)(lds + AT_K0 + (cur ^ 1) * 8192 + kst) = kr; *(LAS v4u*)(lds + AT_V0 + (cur ^ 1) * 8192 + vst) = vr; }
        __syncthreads();
    }
    lsum += shx(lsum, 32, lane);
    if (TYPE == 0) lsum += __builtin_amdgcn_exp2f(sinkl2 - Cl2);
    const float inv = 1.f / lsum;
    {   float ss = 0.f;
#pragma unroll
        for (int r = 0; r < 16; ++r) { const float a = O0[r] * inv, c = O1[r] * inv; ss += a * a + c * c; }
        ss += shx(ss, 32, lane);
        if (hh == 0) (void)__hip_atomic_fetch_add((GAS u64_t*)(mixsq + (size_t)b * SEQ + qpos), rowsq_fx(ss), __ATOMIC_RELAXED, __HIP_MEMORY_SCOPE_AGENT); }
    bf16* op = ATT + ((size_t)b * SEQ + qpos) * DM + ocol + 4 * hh;
#pragma unroll
    for (int g4 = 0; g4 < 4; ++g4) {
        v2u o0, o1; o0.x = cvtpk(O0[4 * g4] * inv, O0[4 * g4 + 1] * inv); o0.y = cvtpk(O0[4 * g4 + 2] * inv, O0[4 * g4 + 3] * inv);
        o1.x = cvtpk(O1[4 * g4] * inv, O1[4 * g4 + 1] * inv); o1.y = cvtpk(O1[4 * g4 + 2] * inv, O1[4 * g4 + 3] * inv);
        *(GAS v2u*)(op + 8 * g4) = o0; *(GAS v2u*)(op + 32 + 8 * g4) = o1;
    }
}


constexpr int MA_K0 = 0, MA_V0 = 32768;
template <int MODE = 0>
__device__ __forceinline__ void mem_unit(LAS unsigned char* lds, const bf16* QM, const bf16* KVM, bf16* OM, const float* gq, int tb, int head, float Cl2, int tid) {
    const int lane = tid & 63, w = __builtin_amdgcn_readfirstlane(tid >> 6), hh = lane >> 5, l31 = lane & 31;
    const size_t trow = (size_t)tb * 256 + 32 * w + l31; const int b = tb >> 3;
    __syncthreads();
    bf16x8 qf[8];
    {   const bf16* qp = QM + trow * MEMW + head * 128 + 8 * hh;
#pragma unroll
        for (int s = 0; s < 8; ++s) qf[s] = *(const GAS bf16x8*)(qp + 16 * s);
        float ss = 0.f;
#pragma unroll
        for (int s = 0; s < 8; ++s)
#pragma unroll
            for (int j = 0; j < 8; ++j) { const float f = __builtin_bit_cast(float, (unsigned)(unsigned short)qf[s][j] << 16); ss += f * f; }
        ss += shx(ss, 32, lane);
        const float r = 0.12751743074602468f / sqrtf(ss * (1.f / 128.f) + EPS);
#pragma unroll
        for (int s = 0; s < 8; ++s) { const f32x4 g0 = *(const GAS f32x4*)(gq + 16 * s + 8 * hh), g1 = *(const GAS f32x4*)(gq + 16 * s + 8 * hh + 4);
            v4u o;
#pragma unroll
            for (int j = 0; j < 4; ++j) { const float f0 = __builtin_bit_cast(float, (unsigned)(unsigned short)qf[s][2 * j] << 16), f1 = __builtin_bit_cast(float, (unsigned)(unsigned short)qf[s][2 * j + 1] << 16);
                const float ga = (2 * j < 4) ? g0[2 * j] : g1[2 * j - 4], gb2 = (2 * j + 1 < 4) ? g0[2 * j + 1] : g1[2 * j + 1 - 4];
                o[j] = cvtpk(f0 * r * ga, f1 * r * gb2); }
            qf[s] = __builtin_bit_cast(bf16x8, o); }
    }
    int kread[8], vread[4];
#pragma unroll
    for (int s = 0; s < 8; ++s) kread[s] = l31 * 256 + (((2 * s + hh) ^ (l31 & 15)) * 16);
#pragma unroll
    for (int db = 0; db < 4; ++db) vread[db] = 65536 + (4 * hh + ((lane >> 2) & 3)) * 256 + ((db ^ ((lane >> 2) & 3)) * 64) + 32 * ((lane >> 4) & 1) + 8 * (lane & 3);
    f32x16 O[4];
#pragma unroll
    for (int db = 0; db < 4; ++db)
#pragma unroll
        for (int r = 0; r < 16; ++r) O[db][r] = 0.f;
    float lsum = 0.f;
    if (MODE != 1) {   const bf16* src = KVM + (size_t)b * NMEM * 1024 + head * 128;
#pragma unroll 1
        for (int half = 0; half < 2; ++half) {
            v4u st[8];
#pragma unroll
            for (int i = 0; i < 8; ++i) { const int c = tid + 512 * i, row = c >> 4, ch = c & 15; st[i] = *(const GAS v4u*)(src + (size_t)row * 1024 + 512 * half + ch * 8); }
#pragma unroll
            for (int i = 0; i < 8; ++i) { const int c = tid + 512 * i, row = c >> 4, ch = c & 15;
                const int off = half == 0 ? row * 256 + ((ch ^ (row & 15)) * 16) : 65536 + row * 256 + (((ch >> 2) ^ (row & 3)) * 64) + (ch & 3) * 16;
                *(LAS v4u*)(lds + off) = st[i]; }
        }
    }
    __syncthreads();
#define MA_SB __builtin_amdgcn_sched_barrier(0)
#define MA_LW(n) asm volatile("s_waitcnt lgkmcnt(" #n ")" ::: "memory")
#pragma unroll 1
    for (int t = 0; t < (MODE ? 0 : 4); ++t) {
        const lds_cptr kb_ = (lds_cptr)(lds + t * 16384), vb_ = (lds_cptr)(lds + t * 16384);
        f32x16 S0, S1;
#pragma unroll
        for (int r = 0; r < 16; ++r) { S0[r] = -Cl2; S1[r] = -Cl2; }
        bf16x8 a0[8], a1[4];
#pragma unroll
        for (int s = 0; s < 8; ++s) a0[s] = *(const LAS bf16x8*)(kb_ + kread[s]);
        MA_SB;
#pragma unroll
        for (int s = 0; s < 4; ++s) S0 = __builtin_amdgcn_mfma_f32_32x32x16_bf16(a0[s], qf[s], S0, 0, 0, 0);
        MA_SB;
#pragma unroll
        for (int s = 0; s < 4; ++s) a1[s] = *(const LAS bf16x8*)(kb_ + kread[s] + 8192);
        MA_SB;
#pragma unroll
        for (int s = 4; s < 8; ++s) S0 = __builtin_amdgcn_mfma_f32_32x32x16_bf16(a0[s], qf[s], S0, 0, 0, 0);
        MA_SB;
#pragma unroll
        for (int s = 0; s < 4; ++s) a0[s] = *(const LAS bf16x8*)(kb_ + kread[4 + s] + 8192);
        MA_SB;
#pragma unroll
        for (int s = 0; s < 4; ++s) S1 = __builtin_amdgcn_mfma_f32_32x32x16_bf16(a1[s], qf[s], S1, 0, 0, 0);
#pragma unroll
        for (int s = 0; s < 4; ++s) S1 = __builtin_amdgcn_mfma_f32_32x32x16_bf16(a0[s], qf[4 + s], S1, 0, 0, 0);
        MA_SB;
        s16x4 vf[2][4][2];
#define MA_VRD(ks) do { _Pragma("unroll") for (int db = 0; db < 4; ++db) { vf[(ks) & 1][db][0] = vtr(vb_ + vread[db] + (16 * (ks)) * 256); vf[(ks) & 1][db][1] = vtr(vb_ + vread[db] + (16 * (ks) + 8) * 256); } } while (0)
#define MA_PV(ks) do { _Pragma("unroll") for (int db = 0; db < 4; ++db) { const bf16x8 va = __builtin_shufflevector(vf[(ks) & 1][db][0], vf[(ks) & 1][db][1], 0, 1, 2, 3, 4, 5, 6, 7); \
            O[db] = __builtin_amdgcn_mfma_f32_32x32x16_bf16(va, pb[ks], O[db], 0, 0, 0); } } while (0)
        MA_VRD(0);
        MA_SB;
#pragma unroll
        for (int r = 0; r < 16; ++r) { S0[r] = __builtin_amdgcn_exp2f(S0[r]); S1[r] = __builtin_amdgcn_exp2f(S1[r]); lsum += S0[r] + S1[r]; }
        bf16x8 pb[4];
#pragma unroll
        for (int hf = 0; hf < 2; ++hf) {
            v4u a, c;
#pragma unroll
            for (int j = 0; j < 4; ++j) { a[j] = cvtpk(S0[8 * hf + 2 * j], S0[8 * hf + 2 * j + 1]); c[j] = cvtpk(S1[8 * hf + 2 * j], S1[8 * hf + 2 * j + 1]); }
            pb[hf] = __builtin_bit_cast(bf16x8, a); pb[2 + hf] = __builtin_bit_cast(bf16x8, c);
        }
        MA_SB;
        MA_LW(7); MA_VRD(1); MA_SB; MA_PV(0); MA_SB;
        MA_LW(7); MA_VRD(2); MA_SB; MA_PV(1); MA_SB;
        MA_LW(7); MA_VRD(3); MA_SB; MA_PV(2); MA_SB;
        MA_PV(3);
        MA_SB;
    }
#undef MA_VRD
#undef MA_PV
#undef MA_SB
#undef MA_LW
    lsum += shx(lsum, 32, lane);
    const float inv = MODE ? 1.f : 1.f / lsum;
    bf16* op = OM + trow * MEMW + head * 128 + 4 * hh;
#pragma unroll
    for (int db = 0; db < 4; ++db)
#pragma unroll
        for (int g4 = 0; g4 < 4; ++g4) { v2u o; o.x = cvtpk(O[db][4 * g4] * inv, O[db][4 * g4 + 1] * inv); o.y = cvtpk(O[db][4 * g4 + 2] * inv, O[db][4 * g4 + 3] * inv); *(GAS v2u*)(op + 32 * db + 8 * g4) = o; }
}

struct Args { const float* in[23]; float* out; unsigned char* ws; int ph_lo, ph_hi, use_bar, pad; };
#ifndef MK_OFF
#define MK_OFF 0u
#endif
#ifndef REP_ATT
#define REP_ATT 1
#endif
#ifndef REP_P0
#define REP_P0 1
#endif
#ifndef REP_U
#define REP_U 1
#endif
#ifndef REP_GEMM
#define REP_GEMM 1
#endif
#ifndef REP_NORM
#define REP_NORM 1
#endif
#ifndef REP_SEL
#define REP_SEL 1
#endif
#ifndef REP_MEM
#define REP_MEM 1
#endif
#define PHON(k) (!((MK_OFF >> (k)) & 1u))
#ifndef MK_REP
#define MK_REP 0
#endif
constexpr int PH_PER_LAYER = 9, PH_BASE = 2, N_PHASES = PH_BASE + DEPTH * PH_PER_LAYER;
constexpr int PTAB_OFF = LDSCTL_OFF + 1024;

__global__ void __launch_bounds__(NTHREADS, 2) mega(Args a) {
    extern __shared__ __attribute__((aligned(16))) unsigned char lds_raw[];
    LAS unsigned char* lds = (LAS unsigned char*)lds_raw;
    const int wave0_ = __builtin_amdgcn_readfirstlane((int)threadIdx.x >> 6);
    {   const int tid0 = threadIdx.x;
        for (int u = tid0; u < (LDS_BYTES - LDSCTL_OFF) / 4; u += NTHREADS) ((LAS unsigned*)(lds + LDSCTL_OFF))[u] = 0u;
        __syncthreads();
        if (tid0 < 23) ((LAS unsigned long long*)(lds + PTAB_OFF))[tid0] = (unsigned long long)a.in[tid0];
        if (tid0 == 23) ((LAS unsigned long long*)(lds + PTAB_OFF))[23] = (unsigned long long)a.out;
        if (tid0 == 24) ((LAS unsigned long long*)(lds + PTAB_OFF))[24] = (unsigned long long)a.ws;
        __syncthreads();
    }
    volatile LAS unsigned* MISC = (volatile LAS unsigned*)(lds + MISC_OFF);
    const int G = gridDim.x, bid = blockIdx.x, NGW = G * NWAVES;
    const int use_bar = a.use_bar;
    XcdBarrier bar; bar.bar = (unsigned*)(a.ws + WS_CTL) + CW_BAR; bar.x = 0; bar.st = MISC + 8;
    if (use_bar) bar = xcd_barrier_post((unsigned*)(a.ws + WS_CTL) + CW_BAR, MISC + 8);
    const int lo = a.ph_lo, hi = a.ph_hi;
#define IN(k) (lo <= (k) && (k) < hi)
#define SEAM(k) do { if (use_bar && IN(k) && IN((k) + 1)) xcd_barrier(bar); } while (0)
#define PHL() int tid_ = wave0_ * 64 + (int)__builtin_amdgcn_mbcnt_hi(~0u, __builtin_amdgcn_mbcnt_lo(~0u, 0u)); asm volatile("" : "+v"(tid_)); const int lane_ = tid_ & 63, wave_ = __builtin_amdgcn_readfirstlane(tid_ >> 6), gw_ = bid * NWAVES + wave_; (void)lane_; (void)gw_; \
              int pz_ = 0; asm volatile("" : "+s"(pz_))
#define PTR(i) ((const float*)ldptr(lds, (i) + pz_))
#define WSP() ((unsigned char*)ldptr(lds, 24 + pz_))
#define OUTP() ((float*)ldptr(lds, 23 + pz_))

    if (IN(0) && PHON(0)) {
        PHL(); unsigned char* ws = WSP();
        LAS float* scr = (LAS float*)(lds + RING_OFF + wave_ * 16384);
        constexpr int I_IN = 32 * 128, I_OUT = 32 * 64, I_MQ = 32 * 16, I_MKV = 32 * 32, I_MO = 8 * 64, I_PQ = 32 * 64, I_L = I_IN + I_OUT + I_MQ + I_MKV + I_MO + I_PQ;
        for (int it = gw_; it < DEPTH * I_L; it += NGW) {
            const int l = it / I_L; int r = it % I_L;
            if (r < I_IN) { transpose_item<true>(PTR(4) + (size_t)l * DM * DIN, DM, DIN, (bf16*)(ws + WS_WIN) + (size_t)l * DIN * DM, scr, r, lane_, PTR(3) + (size_t)l * DM); continue; } r -= I_IN;
            if (r < I_OUT) { transpose_item<false>(PTR(11) + (size_t)l * DM * DM, DM, DM, (bf16*)(ws + WS_WOUT) + (size_t)l * DM * DM, scr, r, lane_, PTR(10) + (size_t)l * DM); continue; } r -= I_OUT;
            if (r < I_MQ) { transpose_item<false>(PTR(14) + (size_t)l * DM * MEMW, DM, MEMW, (bf16*)(ws + WS_WMQ) + (size_t)l * MEMW * DM, scr, r, lane_, PTR(12) + (size_t)l * DM); continue; } r -= I_MQ;
            if (r < I_MKV) { transpose_item<false>(PTR(15) + (size_t)l * DM * 1024, DM, 1024, (bf16*)(ws + WS_WMKV) + (size_t)l * 1024 * DM, scr, r, lane_); continue; } r -= I_MKV;
            if (r < I_MO) { transpose_item<false>(PTR(17) + (size_t)l * MEMW * DM, MEMW, DM, (bf16*)(ws + WS_WMO) + (size_t)l * DM * MEMW, scr, r, lane_); continue; } r -= I_MO;
            transpose_item<false>(PTR(19) + (size_t)l * DM * DM, DM, DM, (bf16*)(ws + WS_WPQ) + (size_t)l * DM * DM, scr, r, lane_, PTR(18) + (size_t)l * DM);
        }
        const size_t gtid = (size_t)bid * NTHREADS + tid_, nth = (size_t)G * NTHREADS;
        convert_bf16(PTR(20), (bf16*)(ws + WS_PKEYS), (size_t)DEPTH * 8 * 2 * 128 * 128, gtid, nth);
        convert_int4_plain(PTR(21), ws + WS_PU, DEPTH * PEER_N, PU_SCALEI, PTR(18), gw_, NGW, lane_);
        convert_fp4_rows(PTR(22), ws + WS_PV, PEER_N, PV_SCALE4, nullptr, gw_, NGW, lane_);
        {   const float* x0 = PTR(0); bf16* XN = (bf16*)(ws + WS_XN); u64_t* rsq = (u64_t*)(ws + WS_ROWSQ);
            for (int m = 2 * gw_; m < T; m += 2 * NGW) prep_rows2(x0 + (size_t)m * DM, XN + (size_t)m * DM, rsq + m, ws + WS_XN8 + (size_t)m * DM, (float*)(ws + WS_XSC) + m, lane_); }
        {   const float* mem = PTR(1); const float* gkv = PTR(13); bf16* MEMN = (bf16*)(ws + WS_MEMN);
            for (int m = gw_; m < BATCH * NMEM; m += NGW)
                rms_row_to_bf16(mem + (size_t)m * DM, gkv, MEMN + (size_t)m * DM, gkv + DM, MEMN + (size_t)(BATCH * NMEM + m) * DM, lane_); }
        float* rope = (float*)(ws + WS_ROPE); float* biasA = (float*)(ws + WS_BIASA);
        if (gtid < 64 * 16) { const int pos = (int)gtid >> 4, i = (int)gtid & 15; const float ang = (float)pos * ROPE_INV[i]; rope[gtid * 2] = cosf(ang); rope[gtid * 2 + 1] = sinf(ang); }
        if (gtid < 12 * 257) { const int h = (int)gtid / 257, rel = (int)gtid % 257 - 128; biasA[gtid] = PTR(2)[t5_bucket(rel) * 12 + h]; }
    }
    SEAM(0);
    if (IN(1) && PHON(1)) {
        {   PHL(); unsigned char* ws = WSP();
            for (int r = gw_; r < DEPTH * DIN; r += NGW) { const int rr = r & (DIN - 1), src = (rr & ~255) + 64 * ((rr >> 5) & 3) + 32 * ((rr >> 7) & 1) + (rr & 31);
                quant_wrow((const bf16*)(ws + WS_WIN) + (size_t)r * DM, ws + WS_WIN8 + (size_t)r * DM, (float*)(ws + WS_WSC) + (r & ~(DIN - 1)) + src, lane_); }
            for (int r = gw_; r < DEPTH * DM; r += NGW) quant_wrow((const bf16*)(ws + WS_WOUT) + (size_t)r * DM, ws + WS_WOUT8 + (size_t)r * DM, (float*)(ws + WS_WSCO) + r, lane_);
            for (int r = gw_; r < DEPTH * DM; r += NGW) quant_wrow((const bf16*)(ws + WS_WPQ) + (size_t)r * DM, ws + WS_WPQ8 + (size_t)r * DM, (float*)(ws + WS_WSCP) + r, lane_);
            for (int r = gw_; r < DEPTH * MEMW; r += NGW) quant_wrow((const bf16*)(ws + WS_WMQ) + (size_t)r * DM, ws + WS_WMQ8 + (size_t)r * DM, (float*)(ws + WS_WSCM) + r, lane_); }
#pragma unroll 1
        for (int l = 0; l < DEPTH; ++l) {
            PHL(); unsigned char* ws = WSP();
            pg8::Gemm g{(bf16*)(ws + WS_MEMN) + (size_t)l * BATCH * NMEM * DM, (bf16*)(ws + WS_WMKV) + (size_t)l * 1024 * DM, BATCH * NMEM, 1024, DM};
            OffsetOrder S; S.init(BATCH * NMEM, 1024, G, bid, 64 * l);
            bf16* KVMl = (bf16*)(ws + WS_KVM) + (size_t)l * BATCH * NMEM * 1024;
            pg8::EpiBf16<0> E{KVMl, 1024, nullptr, 0, 0, 1.f};
            pg8::gemm_phase<pg8::EpiBf16<0>, OffsetOrder, true, true>(lds + RING_OFF, g, S, E, tid_);
            VM_WAIT(); __syncthreads();
            const float* gk = PTR(16) + (size_t)l * 256 + 128;
#pragma unroll 1
            for (int i = 0; i < 4; ++i) { pg8::Unit uu; uu.pm = 0; uu.pn = 0; if (!S.next(i, uu)) break;
                if (uu.pn < 2) {
                    for (int r2 = wave_; r2 < 128; r2 += NWAVES) { const int row = uu.pm * 256 + 2 * r2 + (lane_ >> 5), cl = lane_ & 31;
                        GAS v4u* p = (GAS v4u*)(KVMl + (size_t)row * 1024 + 256 * uu.pn + 8 * cl);
                        const v4u w = *p;
                        float f[8] = {bflo(w.x), bfhi(w.x), bflo(w.y), bfhi(w.y), bflo(w.z), bfhi(w.z), bflo(w.w), bfhi(w.w)};
                        float ss = 0.f;
#pragma unroll
                        for (int e = 0; e < 8; ++e) ss += f[e] * f[e];
                        ss += shx(ss, 1, lane_); ss += shx(ss, 2, lane_); ss += shx(ss, 4, lane_); ss += shx(ss, 8, lane_);
                        const float r = 1.f / sqrtf(ss * (1.f / 128.f) + EPS);
                        const float* gg = gk + 8 * (cl & 15);
                        v4u o; o.x = pk2(f[0] * r * gg[0], f[1] * r * gg[1]); o.y = pk2(f[2] * r * gg[2], f[3] * r * gg[3]); o.z = pk2(f[4] * r * gg[4], f[5] * r * gg[5]); o.w = pk2(f[6] * r * gg[6], f[7] * r * gg[7]);
                        *p = o; } } }
            __syncthreads();
        }
        if (G >= 256 && bid >= 128) { PHL(); unsigned char* ws = WSP();
            convert_fp4_rows(PTR(22) + (size_t)PEER_N * DM, ws + WS_PV + (size_t)PEER_N * 1024, PEER_N, PV_SCALE4, nullptr, (bid - 128) * NWAVES + wave_, (G - 128) * NWAVES, lane_); }
        else if (G < 256) { PHL(); unsigned char* ws = WSP(); convert_fp4_rows(PTR(22) + (size_t)PEER_N * DM, ws + WS_PV + (size_t)PEER_N * 1024, PEER_N, PV_SCALE4, nullptr, gw_, NGW, lane_); }
    }
    SEAM(1);

#pragma unroll 1
    for (int l = 0; l < DEPTH; ++l) {
        const int pb = PH_BASE + PH_PER_LAYER * l;
        if (IN(pb + 0) && PHON(3)) { PHL(); unsigned char* ws = WSP();
            pg8::Gemm g{(bf16*)(ws + WS_XN8), (bf16*)(ws + WS_WIN8 + (size_t)l * DIN * DM), T, DIN, DM / 2}; pg8::StaticOrder S; S.init(T, DIN, G, bid);
            LAS float* ropel = (LAS float*)(lds + LDSCTL_OFF + 2048);
            for (int i = tid_; i < 64 * 16 * 2; i += NTHREADS) ropel[i] = ((const float*)(ws + WS_ROPE))[i];
            __syncthreads();
            pg8::EpiQKV E{(bf16*)(ws + WS_QKV), PTR(5) + (size_t)l * 128, PTR(7) + (size_t)l * 128, PTR(9) + (size_t)l * 128, ropel, (const u64_t*)(ws + WS_ROWSQ) + (size_t)(l * 3 + 0) * T, (const float*)(ws + WS_XSC), (const float*)(ws + WS_WSC) + (size_t)l * DIN};
            pg8::gemm_phase<pg8::EpiQKV, pg8::StaticOrder, true, true>(lds + RING_OFF, g, S, E, tid_);
        }
        SEAM(pb + 0);
        if (IN(pb + 1) && PHON(4)) { PHL(); unsigned char* ws = WSP();
            const float* sink = PTR(6) + (size_t)l * 12; const float* rpb = PTR(8) + (size_t)l * 8 * 15 * 31; const float* biasA = (const float*)(ws + WS_BIASA);
            const bf16* QKV = (const bf16*)(ws + WS_QKV); bf16* ATT = (bf16*)(ws + WS_ATT);
            const float* ga = PTR(5) + (size_t)l * 128; const float* gb = PTR(7) + (size_t)l * 128; const float* gc = PTR(9) + (size_t)l * 128;
            const float CaL2 = 8.f * wave_max(fabsf(ga[lane_]), lane_) * wave_max(fabsf(ga[64 + lane_]), lane_) * LOG2E;
            const float CbL2 = 8.f * wave_max(fabsf(gb[lane_]), lane_) * wave_max(fabsf(gb[64 + lane_]), lane_) * LOG2E;
            const float CcL2 = 8.f * wave_max(fabsf(gc[lane_]), lane_) * wave_max(fabsf(gc[64 + lane_]), lane_) * LOG2E;
            const int vc = (G % 8 == 0) ? (bid % 8) * (G / 8) + bid / 8 : bid;
            u64_t* mixsq = (u64_t*)(ws + WS_MIXSQ) + (size_t)l * 3 * T;
            for (int u = vc; u < BATCH * 12 * 8; u += G) attn_unit<2>(lds, QKV, ATT, mixsq + 2 * (size_t)T, u / 96, (u >> 3) % 12, u & 7, nullptr, CcL2, 0.f, tid_);
            for (int u = vc; u < BATCH * 8 * 8; u += G) attn_unit<1>(lds, QKV, ATT, mixsq + (size_t)T, u >> 6, (u >> 3) & 7, u & 7, rpb, CbL2, 0.f, tid_);
            for (int u = vc; u < BATCH * 12 * 8; u += G) { const int head = (u >> 3) % 12; attn_unit<0>(lds, QKV, ATT, mixsq, u / 96, head, u & 7, biasA, CaL2, sink[head] * LOG2E, tid_); }
        }
        SEAM(pb + 1);
        if (IN(pb + 2) && PHON(5)) { PHL(); unsigned char* ws = WSP();
            const u64_t* mixsq = (const u64_t*)(ws + WS_MIXSQ) + (size_t)l * 3 * T;
            for (int r = 4 * gw_; r < T; r += 4 * NGW) att_quant_rows<4>((const bf16*)(ws + WS_ATT), mixsq, ws + WS_ATT8, (float*)(ws + WS_XSC2), r, lane_);
        }
        SEAM(pb + 2);
        if (IN(pb + 3) && PHON(5)) { PHL(); unsigned char* ws = WSP();
            pg8::Gemm g{(bf16*)(ws + WS_ATT8), (bf16*)(ws + WS_WOUT8 + (size_t)l * DM * DM), T, DM, DM / 2}; pg8::StaticOrder S; S.init(T, DM, G, bid);
            typedef pg8::EpiResidT<true, 10> EpiX1;
            EpiX1 E{(bf16*)(ws + WS_XN), DM, (u64_t*)(ws + WS_ROWSQ) + (size_t)(l * 3 + 1) * T, (const float*)(ws + WS_XSC2), (const float*)(ws + WS_WSCO) + (size_t)l * DM, ws + WS_X8, (const u64_t*)(ws + WS_ROWSQ) + (size_t)(l * 3 + 0) * T, nullptr, nullptr};
            pg8::gemm_phase<EpiX1, pg8::StaticOrder, true, true>(lds + RING_OFF, g, S, E, tid_);
        }
        SEAM(pb + 3);
        if (IN(pb + 4) && PHON(6)) { PHL(); unsigned char* ws = WSP();
            pg8::Gemm g{(bf16*)(ws + WS_X8), (bf16*)(ws + WS_WMQ8 + (size_t)l * MEMW * DM), T, MEMW, DM / 2}; pg8::StaticOrder S; S.init(T, MEMW, G, bid);
            pg8::EpiBf16Row8<10> E{(bf16*)(ws + WS_QM), MEMW, (const u64_t*)(ws + WS_ROWSQ) + (size_t)(l * 3 + 1) * T, (const u64_t*)(ws + WS_ROWSQ) + (size_t)(l * 3 + 0) * T, (const float*)(ws + WS_WSCM) + (size_t)l * MEMW};
            pg8::gemm_phase<pg8::EpiBf16Row8<10>, pg8::StaticOrder, true, true>(lds + RING_OFF, g, S, E, tid_);
            VM_WAIT(); __syncthreads();
            const bf16* kvm = (const bf16*)(ws + WS_KVM) + (size_t)l * BATCH * NMEM * 1024; const float* gq = PTR(16) + (size_t)l * 256;
            const float CmL2 = 11.313708498984761f * wave_max(fmaxf(fabsf(gq[lane_]), fabsf(gq[64 + lane_])), lane_) * wave_max(fmaxf(fabsf(gq[128 + lane_]), fabsf(gq[192 + lane_])), lane_) * LOG2E;
#pragma unroll 1
            for (int i = 0; i < 4; ++i) { pg8::Unit uu; uu.pm = 0; uu.pn = 0; if (!S.next(i, uu)) break;
                int nrep_ = (MK_REP == 1) ? 4 : 2; asm volatile("" : "+s"(nrep_));
#pragma unroll 1
                for (int hr = 0; hr < nrep_; ++hr) mem_unit(lds, (const bf16*)(ws + WS_QM), kvm, (bf16*)(ws + WS_OM), gq, uu.pm, 2 * uu.pn + (hr & 1), CmL2, tid_);
#if MK_REP == 4 || MK_REP == 5
                mem_unit<MK_REP - 3>(lds, (const bf16*)(ws + WS_QM), kvm, (bf16*)(ws + WS_QKV), gq, uu.pm, 2 * uu.pn, CmL2, tid_); mem_unit<MK_REP - 3>(lds, (const bf16*)(ws + WS_QM), kvm, (bf16*)(ws + WS_QKV), gq, uu.pm, 2 * uu.pn + 1, CmL2, tid_);
#endif
            }
        }
        SEAM(pb + 4);
        if (IN(pb + 5) && PHON(7)) { PHL(); unsigned char* ws = WSP();
            pg8::Gemm g{(bf16*)(ws + WS_OM), (bf16*)(ws + WS_WMO) + (size_t)l * DM * MEMW, T, DM, MEMW}; pg8::StaticOrder S; S.init(T, DM, G, bid);
            typedef pg8::EpiResidT<false, 8, true> EpiX2;
            EpiX2 E{(bf16*)(ws + WS_XN), DM, (u64_t*)(ws + WS_ROWSQ) + (size_t)(l * 3 + 2) * T, nullptr, nullptr, ws + WS_X8, (const u64_t*)(ws + WS_ROWSQ) + (size_t)(l * 3 + 1) * T, ws + WS_XQH, ws + WS_XQL};
            pg8::gemm_phase<EpiX2, pg8::StaticOrder, true, true>(lds + RING_OFF, g, S, E, tid_);
        }
        SEAM(pb + 5);
        if (IN(pb + 6) && PHON(8)) { PHL(); unsigned char* ws = WSP();
            pg8::Gemm g{(bf16*)(ws + WS_X8), (bf16*)(ws + WS_WPQ8 + (size_t)l * DM * DM), T, DM, DM / 2}; pg8::StaticOrder S; S.init(T, DM, G, bid);
            pg8::EpiBf16Row8<8> E{(bf16*)(ws + WS_QP), DM, (const u64_t*)(ws + WS_ROWSQ) + (size_t)(l * 3 + 2) * T, (const u64_t*)(ws + WS_ROWSQ) + (size_t)(l * 3 + 1) * T, (const float*)(ws + WS_WSCP) + (size_t)l * DM};
            pg8::gemm_phase<pg8::EpiBf16Row8<8>, pg8::StaticOrder, true, true>(lds + RING_OFF, g, S, E, tid_);
            VM_WAIT(); __syncthreads();
            const bf16* pk = (const bf16*)(ws + WS_PKEYS) + (size_t)l * 8 * 2 * 128 * 128;
#pragma unroll 1
            for (int i = 0; i < 8; ++i) { pg8::Unit uu; uu.pm = 0; uu.pn = 0; if (!S.next(i, uu)) break;
                peer_select_unit((const bf16*)(ws + WS_QP), pk, (int*)(ws + WS_PIDX), (float*)(ws + WS_PGATE), uu.pm, uu.pn, wave_, lane_, lds + RING_OFF);
#if MK_REP == 2
                peer_select_unit((const bf16*)(ws + WS_QP), pk, (int*)(ws + WS_PIDX), (float*)(ws + WS_PGATE), uu.pm, uu.pn, wave_, lane_, lds + RING_OFF);
#endif
#if MK_REP == 3
#endif
            }
        }
        SEAM(pb + 6);
        if (IN(pb + 7) && PHON(9)) { PHL(); unsigned char* ws = WSP();
            peer_u_phase_i4((const unsigned*)(ws + WS_XQH), (const unsigned*)(ws + WS_XQL), ws + WS_PU + (size_t)l * PEER_N * 1024, (const int*)(ws + WS_PIDX), (int*)(ws + WS_PARTI), bid, G, wave_, lane_); }
        SEAM(pb + 7);
        if (IN(pb + 8) && PHON(10)) { PHL(); unsigned char* ws = WSP();
            peer_v_pass((bf16*)(ws + WS_XN), ws + WS_PV + (size_t)l * PEER_N * 1024, (const int*)(ws + WS_PIDX), (const float*)(ws + WS_PGATE), (const int*)(ws + WS_PARTI), (l + 1 == DEPTH) ? OUTP() : (float*)nullptr,
                        (l + 1 < DEPTH) ? (u64_t*)(ws + WS_ROWSQ) + (size_t)((l + 1) * 3 + 0) * T : (u64_t*)nullptr, (l + 1 < DEPTH) ? ws + WS_XN8 : (unsigned char*)nullptr, (float*)(ws + WS_XSC), (const u64_t*)(ws + WS_ROWSQ) + (size_t)(l * 3 + 1) * T, (const u64_t*)(ws + WS_ROWSQ) + (size_t)(l * 3 + 2) * T, (LAS float*)(lds + RING_OFF + wave_ * 1024), gw_, NGW, lane_); }
        SEAM(pb + 8);
    }
#undef IN
#undef SEAM
}

#ifndef MK_MULTI_LAUNCH
#define MK_MULTI_LAUNCH 0
#endif
extern "C" void kernel_launch(void* const* d_in, const int* in_sizes, int n_in, void* d_out, int out_size, void* d_ws, size_t ws_size, hipStream_t stream) {
    static int grid = 0;
    if (grid == 0) {
        if (n_in != 23 || out_size != T * DM || ws_size < WS_END) { fprintf(stderr, "kernel_launch: unexpected shapes (n_in %d, out %d, ws %zu)\n", n_in, out_size, ws_size); grid = -1; return; }
        int dev = 0, cus = 0, per_cu = 0;
        if (hipGetDevice(&dev) != hipSuccess || hipDeviceGetAttribute(&cus, hipDeviceAttributeMultiprocessorCount, dev) != hipSuccess) { grid = -1; return; }
        if (hipFuncSetAttribute((const void*)mega, hipFuncAttributeMaxDynamicSharedMemorySize, LDS_BYTES) != hipSuccess) { fprintf(stderr, "kernel_launch: hipFuncSetAttribute failed\n"); grid = -1; return; }
        if (hipOccupancyMaxActiveBlocksPerMultiprocessor(&per_cu, (const void*)mega, NTHREADS, LDS_BYTES) != hipSuccess || per_cu < 1) { fprintf(stderr, "kernel_launch: occupancy query says %d\n", per_cu); }
        (void)hipGetLastError();
        grid = cus;
    }
    if (grid < 0) return;
    (void)hipMemsetAsync((char*)d_ws + WS_CTL, 0, CTL_ZERO_BYTES, stream);
    (void)hipMemsetAsync((char*)d_ws + WS_MIXSQ, 0, MIXSQ_BYTES, stream);
    Args a{};
    for (int i = 0; i < 23; ++i) a.in[i] = (const float*)d_in[i];
    a.out = (float*)d_out; a.ws = (unsigned char*)d_ws;
#if MK_MULTI_LAUNCH
    for (int p = 0; p < N_PHASES; ++p) { a.ph_lo = p; a.ph_hi = p + 1; a.use_bar = 0; a.pad = 0; hipLaunchKernelGGL(mega, dim3(grid), dim3(NTHREADS), LDS_BYTES, stream, a); }
#else
    a.ph_lo = 0; a.ph_hi = N_PHASES; a.use_bar = 1; a.pad = 0;
    hipLaunchKernelGGL(mega, dim3(grid), dim3(NTHREADS), LDS_BYTES, stream, a);
#endif
    const hipError_t le = hipPeekAtLastError();
    if (le != hipSuccess) fprintf(stderr, "kernel_launch: launch failed: %s\n", hipGetErrorName(le));
}
```

```cpp
#include <hip/hip_runtime.h>
#include <cstdio>
#include <cstdint>
#include <cmath>
__device__ __forceinline__ float shx(float v, int k, int lane);
typedef unsigned long long u64_t;
__device__ __forceinline__ float rowsq_rs(const u64_t* rowsq, int row) { return 1.0f / sqrtf((float)*(const __attribute__((address_space(1))) u64_t*)(rowsq + row) * (5.9604644775390625e-08f / 2048.0f) + 1e-6f); }
__device__ __forceinline__ u64_t rowsq_fx(float ss) { return (u64_t)(ss * 16777216.0f + 0.5f); }
template <int HI = 255>
__device__ __forceinline__ unsigned q8x4c(float a, float b, float c, float d, float inv) {
    unsigned w = 0;
    w = __builtin_amdgcn_cvt_pk_u8_f32(__builtin_rintf(__builtin_amdgcn_fmed3f(__builtin_fmaf(a, inv, 128.f), 1.f, (float)HI)), 0, w); w = __builtin_amdgcn_cvt_pk_u8_f32(__builtin_rintf(__builtin_amdgcn_fmed3f(__builtin_fmaf(b, inv, 128.f), 1.f, (float)HI)), 1, w);
    w = __builtin_amdgcn_cvt_pk_u8_f32(__builtin_rintf(__builtin_amdgcn_fmed3f(__builtin_fmaf(c, inv, 128.f), 1.f, (float)HI)), 2, w); w = __builtin_amdgcn_cvt_pk_u8_f32(__builtin_rintf(__builtin_amdgcn_fmed3f(__builtin_fmaf(d, inv, 128.f), 1.f, (float)HI)), 3, w);
    return w ^ 0x80808080u;
}
__device__ __forceinline__ unsigned dig_lo4(unsigned d) { return d & 0x0f0f0f0fu; }
__device__ __forceinline__ unsigned dig_hi4(unsigned d) { const unsigned t = ((d & 0x7f7f7f7fu) + 0x08080808u) ^ (d & 0x80808080u); return (t >> 4) & 0x0f0f0f0fu; }
__device__ __forceinline__ unsigned nib_pack8(unsigned a, unsigned b) { a = (a | (a >> 4)) & 0x00ff00ffu; a = (a | (a >> 8)) & 0xffffu; b = (b | (b >> 4)) & 0x00ff00ffu; b = (b | (b >> 8)) & 0xffffu; return a | (b << 16); }
namespace pg8 {
#define PG8_LAS __attribute__((address_space(3)))
#define PG8_GAS __attribute__((address_space(1)))
typedef unsigned short bf16_t;
typedef short bf16x8 __attribute__((ext_vector_type(8)));
typedef float f32x4 __attribute__((ext_vector_type(4)));
typedef unsigned u32x4 __attribute__((ext_vector_type(4)));
constexpr int BM = 256, BK = 64, HALF = 128, HTB = HALF * BK * 2  , STAGE_BYTES = 8 * HTB, NXCD = 8, WGM = 8;

__host__ __device__ __forceinline__ int lds_byte(int r, int c) { const int st = (r >> 4) * 2 + (c >> 5), rr = r & 15, cc = c & 31, ob = rr * 64 + cc * 2; return st * 1024 + (ob ^ (((ob >> 9) & 1) << 5)); }
__host__ __device__ __forceinline__ void stage_rc(int b, int& R, int& C) { const int st = b / 1024, sb = b % 1024, swz = sb ^ (((sb >> 9) & 1) << 5); R = (st >> 1) * 16 + swz / 64; C = (st & 1) * 32 + (swz % 64) / 2; }
__host__ __device__ __forceinline__ int perm32(int rho) { const int n = rho >> 4, i = rho & 15; return 8 * (i >> 2) + 4 * n + (i & 3); }

struct Unit { int pm, pn; };
struct Gemm { const bf16_t* A; const bf16_t* Bt; int M, N, K; };

struct StaticOrder {
    int nM, nN, nwg, G, c;
    __host__ __device__ __forceinline__ void init(int M, int N, int G_, int c_) { nM = M / BM; nN = N / BM; nwg = nM * nN; G = G_; c = c_; }
    __host__ __device__ __forceinline__ bool next(int i, Unit& u) const {
        const long L = (long)i * G + c; if (L >= nwg) return false;
        int wgid = (int)L; { const int q = nwg / NXCD, r = nwg % NXCD, xcd = wgid % NXCD, off = wgid / NXCD; wgid = (xcd < r ? xcd * (q + 1) : r * (q + 1) + (xcd - r) * q) + off; }
        const int nig = WGM * nN, gid = wgid / nig, fm = gid * WGM, gsz = (nM - fm) < WGM ? (nM - fm) : WGM;
        u.pm = fm + ((wgid % nig) % gsz); u.pn = (wgid % nig) / gsz; return true;
    }
    __device__ __forceinline__ void a_ready(const Unit&) const {}
    __device__ __forceinline__ void done(const Unit&) const {}
};

__device__ __forceinline__ unsigned cvt_pk_bf16(float lo, float hi) { unsigned r; asm volatile("v_cvt_pk_bf16_f32 %0, %1, %2" : "=v"(r) : "v"(lo), "v"(hi)); return r; }
typedef float f32x2 __attribute__((ext_vector_type(2)));
__device__ __forceinline__ f32x2 gelu_pk(f32x2 v) {
    const f32x2 av = __builtin_elementwise_abs(v), d = av * 0.2316418882f + 1.0f;
    f32x2 t; t.x = __builtin_amdgcn_rcpf(d.x); t.y = __builtin_amdgcn_rcpf(d.y);
    f32x2 q = t * 0.5307027145f + (-0.7265760135f); q = q * t + 0.7107068705f; q = q * t + (-0.142248368f); q = q * t + 0.127414796f; q = q * t;
    const f32x2 s = (v * v) * (-0.72134752044f);
    f32x2 e; e.x = __builtin_amdgcn_exp2f(s.x); e.y = __builtin_amdgcn_exp2f(s.y);
    const f32x2 m = v * (q * e), r = v - m;
    f32x2 o; o.x = v.x < 0.f ? m.x : r.x; o.y = v.y < 0.f ? m.y : r.y; return o;
}

template <int ACT  > struct EpiBf16 {
    static constexpr bool PERM = true, AFTER_DRAIN = false, KSCALE = false, I8 = false; static_assert(ACT == 0 || ACT == 1, "EpiBf16: ACT is 0 (none) or 1 (gelu_pk)");
    bf16_t* O; int ldc; const float* bias; int split_cols; size_t split_stride; float scale0;
    __device__ __forceinline__ void operator()(const f32x4 (&acc)[2][2][4][2], const Unit& u, int wr, int wc, int fr, int fq) const {
        const int row0 = u.pm * BM + wr * 64 + fr; int colt = u.pn * BM; bf16_t* base = O;
        float sc = 1.f; if (split_cols) { const int t = colt / split_cols; base += (size_t)t * split_stride; colt -= t * split_cols; if (t == 0) sc = scale0; }
        const int col0 = colt + wc * 32 + 8 * fq, bcol0 = u.pn * BM + wc * 32 + 8 * fq;
        f32x4 bv[2][2];
#pragma unroll
        for (int bj = 0; bj < 2; ++bj)
#pragma unroll
            for (int n = 0; n < 2; ++n) bv[bj][n] = bias ? *(const PG8_GAS f32x4*)(bias + bcol0 + bj * HALF + 4 * n) : (f32x4){0.f, 0.f, 0.f, 0.f};
#pragma unroll
        for (int ai = 0; ai < 2; ++ai)
#pragma unroll
            for (int m = 0; m < 4; ++m) { bf16_t* rowp = base + (size_t)(row0 + ai * HALF + m * 16) * ldc + col0;
#pragma unroll
                for (int bj = 0; bj < 2; ++bj) { f32x4 v0 = acc[ai][bj][m][0] + bv[bj][0], v1 = acc[ai][bj][m][1] + bv[bj][1];
                    if (ACT == 1) { f32x2 a = gelu_pk((f32x2){v0[0], v0[1]}), b = gelu_pk((f32x2){v0[2], v0[3]}), c = gelu_pk((f32x2){v1[0], v1[1]}), d = gelu_pk((f32x2){v1[2], v1[3]});
                        v0 = (f32x4){a.x, a.y, b.x, b.y}; v1 = (f32x4){c.x, c.y, d.x, d.y}; }
                    v0 = v0 * sc; v1 = v1 * sc; u32x4 w; w.x = cvt_pk_bf16(v0[0], v0[1]); w.y = cvt_pk_bf16(v0[2], v0[3]); w.z = cvt_pk_bf16(v1[0], v1[1]); w.w = cvt_pk_bf16(v1[2], v1[3]);
                    *(PG8_GAS u32x4*)(rowp + bj * HALF) = w; } }
    }
};

typedef unsigned u32x2 __attribute__((ext_vector_type(2)));
typedef int i32x4 __attribute__((ext_vector_type(4)));
struct EpiResid {
    static constexpr bool PERM = false, AFTER_DRAIN = false, KSCALE = false, I8 = false;
    bf16_t* s; int ldc; u64_t* rowsq;
    __device__ __forceinline__ void operator()(const f32x4 (&acc)[2][2][4][2], const Unit& u, int wr, int wc, int fr, int fq) const {
        const int col0 = u.pn * BM + wc * 32 + 4 * fq;
#pragma unroll
        for (int ai = 0; ai < 2; ++ai)
#pragma unroll
            for (int m = 0; m < 4; ++m) { const int row = u.pm * BM + ai * HALF + wr * 64 + m * 16 + fr; bf16_t* sp = s + (size_t)row * ldc + col0; float ss = 0.f;
                u32x2 in[2][2];
#pragma unroll
                for (int bj = 0; bj < 2; ++bj)
#pragma unroll
                    for (int n = 0; n < 2; ++n) in[bj][n] = *(const PG8_GAS u32x2*)(sp + bj * HALF + n * 16);
#pragma unroll
                for (int bj = 0; bj < 2; ++bj)
#pragma unroll
                    for (int n = 0; n < 2; ++n) { const u32x2 w0 = in[bj][n];
                        const f32x4 bs = (f32x4){__builtin_bit_cast(float, w0.x << 16), __builtin_bit_cast(float, w0.x & 0xffff0000u), __builtin_bit_cast(float, w0.y << 16), __builtin_bit_cast(float, w0.y & 0xffff0000u)};
                        const f32x4 o = bs + acc[ai][bj][m][n]; ss += (o[0] * o[0] + o[1] * o[1]) + (o[2] * o[2] + o[3] * o[3]);
                        u32x2 w; w.x = cvt_pk_bf16(o[0], o[1]); w.y = cvt_pk_bf16(o[2], o[3]); *(PG8_GAS u32x2*)(sp + bj * HALF + n * 16) = w; }
                ss += shx(ss, 16, fr + 16 * fq); ss += shx(ss, 32, fr + 16 * fq);
                if (fq == 0) (void)__hip_atomic_fetch_add((PG8_GAS u64_t*)(rowsq + row), rowsq_fx(ss), __ATOMIC_RELAXED, __HIP_MEMORY_SCOPE_AGENT); }
    }
};
struct EpiResid8 {
    static constexpr bool PERM = false, AFTER_DRAIN = false, KSCALE = false, I8 = true;
    bf16_t* s; int ldc; u64_t* rowsq; const float* xsc; const float* wsc;
    __device__ __forceinline__ void operator()(const f32x4 (&acc)[2][2][4][2], const Unit& u, int wr, int wc, int fr, int fq) const {
        const int col0 = u.pn * BM + wc * 32 + 4 * fq;
#pragma unroll
        for (int ai = 0; ai < 2; ++ai)
#pragma unroll
            for (int m = 0; m < 4; ++m) { const int row = u.pm * BM + ai * HALF + wr * 64 + m * 16 + fr; bf16_t* sp = s + (size_t)row * ldc + col0; float ss = 0.f; const float xs = *(const PG8_GAS float*)(xsc + row);
                u32x2 in[2][2];
#pragma unroll
                for (int bj = 0; bj < 2; ++bj)
#pragma unroll
                    for (int n = 0; n < 2; ++n) in[bj][n] = *(const PG8_GAS u32x2*)(sp + bj * HALF + n * 16);
#pragma unroll
                for (int bj = 0; bj < 2; ++bj)
#pragma unroll
                    for (int n = 0; n < 2; ++n) { const u32x2 w0 = in[bj][n]; const i32x4 ia = __builtin_bit_cast(i32x4, acc[ai][bj][m][n]);
                        const f32x4 bs = (f32x4){__builtin_bit_cast(float, w0.x << 16), __builtin_bit_cast(float, w0.x & 0xffff0000u), __builtin_bit_cast(float, w0.y << 16), __builtin_bit_cast(float, w0.y & 0xffff0000u)};
                        const f32x4 o = bs + (f32x4){(float)ia[0], (float)ia[1], (float)ia[2], (float)ia[3]} * *(const PG8_GAS f32x4*)(wsc + col0 + bj * HALF + n * 16) * xs; ss += (o[0] * o[0] + o[1] * o[1]) + (o[2] * o[2] + o[3] * o[3]);
                        u32x2 w; w.x = cvt_pk_bf16(o[0], o[1]); w.y = cvt_pk_bf16(o[2], o[3]); *(PG8_GAS u32x2*)(sp + bj * HALF + n * 16) = w; }
                ss += shx(ss, 16, fr + 16 * fq); ss += shx(ss, 32, fr + 16 * fq);
                if (fq == 0) (void)__hip_atomic_fetch_add((PG8_GAS u64_t*)(rowsq + row), rowsq_fx(ss), __ATOMIC_RELAXED, __HIP_MEMORY_SCOPE_AGENT); }
    }
};
template <bool I8IN, int QOUT, bool DIG = false>
struct EpiResidT {
    static constexpr bool PERM = true, AFTER_DRAIN = false, KSCALE = false, I8 = I8IN;
    bf16_t* s; int ldc; u64_t* rowsq; const float* xsc; const float* wsc; unsigned char* q8; const u64_t* rowsq_prev; unsigned char* dgh; unsigned char* dgl;
    __device__ __forceinline__ void operator()(const f32x4 (&acc)[2][2][4][2], const Unit& u, int wr, int wc, int fr, int fq) const {
        const int col0 = u.pn * BM + wc * 32 + 8 * fq, rowb = u.pm * BM + wr * 64 + fr;
        f32x4 wv[2][2];
        if constexpr (I8IN) {
#pragma unroll
            for (int bj = 0; bj < 2; ++bj) { wv[bj][0] = *(const PG8_GAS f32x4*)(wsc + col0 + bj * HALF); wv[bj][1] = *(const PG8_GAS f32x4*)(wsc + col0 + bj * HALF + 4); } }
#pragma unroll
        for (int ai = 0; ai < 2; ++ai) {
            u32x4 in[4][2]; float xs[4], qv[4];
#pragma unroll
            for (int m = 0; m < 4; ++m) { const int row = rowb + ai * HALF + m * 16; const bf16_t* sp = s + (size_t)row * ldc + col0;
#pragma unroll
                for (int bj = 0; bj < 2; ++bj) in[m][bj] = *(const PG8_GAS u32x4*)(sp + bj * HALF);
                if constexpr (I8IN) xs[m] = *(const PG8_GAS float*)(xsc + row); else xs[m] = 1.f;
                if constexpr (QOUT > 0) qv[m] = (127.0f / QOUT) * rowsq_rs(rowsq_prev, row); else qv[m] = 0.f; }
            __builtin_amdgcn_sched_barrier(0);
#pragma unroll
            for (int m = 0; m < 4; ++m) { const int row = rowb + ai * HALF + m * 16; bf16_t* sp = s + (size_t)row * ldc + col0; float ss = 0.f;
#pragma unroll
                for (int bj = 0; bj < 2; ++bj) { const u32x4 w0 = in[m][bj]; f32x4 a0 = acc[ai][bj][m][0], a1 = acc[ai][bj][m][1];
                    if constexpr (I8IN) { const i32x4 i0 = __builtin_bit_cast(i32x4, a0), i1 = __builtin_bit_cast(i32x4, a1);
                        a0 = (f32x4){(float)i0[0], (float)i0[1], (float)i0[2], (float)i0[3]} * wv[bj][0] * xs[m];
                        a1 = (f32x4){(float)i1[0], (float)i1[1], (float)i1[2], (float)i1[3]} * wv[bj][1] * xs[m]; }
                    const f32x4 o0 = (f32x4){__builtin_bit_cast(float, w0.x << 16), __builtin_bit_cast(float, w0.x & 0xffff0000u), __builtin_bit_cast(float, w0.y << 16), __builtin_bit_cast(float, w0.y & 0xffff0000u)} + a0;
                    const f32x4 o1 = (f32x4){__builtin_bit_cast(float, w0.z << 16), __builtin_bit_cast(float, w0.z & 0xffff0000u), __builtin_bit_cast(float, w0.w << 16), __builtin_bit_cast(float, w0.w & 0xffff0000u)} + a1;
                    ss += ((o0[0] * o0[0] + o0[1] * o0[1]) + (o0[2] * o0[2] + o0[3] * o0[3])) + ((o1[0] * o1[0] + o1[1] * o1[1]) + (o1[2] * o1[2] + o1[3] * o1[3]));
                    u32x4 w; w.x = cvt_pk_bf16(o0[0], o0[1]); w.y = cvt_pk_bf16(o0[2], o0[3]); w.z = cvt_pk_bf16(o1[0], o1[1]); w.w = cvt_pk_bf16(o1[2], o1[3]); *(PG8_GAS u32x4*)(sp + bj * HALF) = w;
                    if constexpr (QOUT > 0) { u32x2 q; q.x = q8x4c<DIG ? 247 : 255>(o0[0], o0[1], o0[2], o0[3], qv[m]); q.y = q8x4c<DIG ? 247 : 255>(o1[0], o1[1], o1[2], o1[3], qv[m]); *(PG8_GAS u32x2*)(q8 + (size_t)row * ldc + col0 + bj * HALF) = q;
                        if constexpr (DIG) { const size_t db = (size_t)row * 1024 + ((col0 + bj * HALF) >> 1);
                            *(PG8_GAS unsigned*)(dgl + db) = nib_pack8(dig_lo4(q.x), dig_lo4(q.y)); *(PG8_GAS unsigned*)(dgh + db) = nib_pack8(dig_hi4(q.x), dig_hi4(q.y)); } } }
                ss += shx(ss, 16, fr + 16 * fq); ss += shx(ss, 32, fr + 16 * fq);
                if (fq == 0) (void)__hip_atomic_fetch_add((PG8_GAS u64_t*)(rowsq + row), rowsq_fx(ss), __ATOMIC_RELAXED, __HIP_MEMORY_SCOPE_AGENT); }
            __builtin_amdgcn_sched_barrier(0);
        }
    }
};
template <int QIN>
struct EpiBf16Row8 {
    static constexpr bool PERM = true, AFTER_DRAIN = false, KSCALE = false, I8 = true;
    bf16_t* O; int ldc; const u64_t* rowsq; const u64_t* rowsq_prev; const float* wsc;
    __device__ __forceinline__ void operator()(const f32x4 (&acc)[2][2][4][2], const Unit& u, int wr, int wc, int fr, int fq) const {
        const int row0 = u.pm * BM + wr * 64 + fr, col0 = u.pn * BM + wc * 32 + 8 * fq;
        float rs[2][4]; f32x4 wv[2][2];
#pragma unroll
        for (int ai = 0; ai < 2; ++ai)
#pragma unroll
            for (int m = 0; m < 4; ++m) { const int row = row0 + ai * HALF + m * 16; rs[ai][m] = rowsq_rs(rowsq, row) * (QIN / 127.0f) / rowsq_rs(rowsq_prev, row); }
#pragma unroll
        for (int bj = 0; bj < 2; ++bj) { wv[bj][0] = *(const PG8_GAS f32x4*)(wsc + col0 + bj * HALF); wv[bj][1] = *(const PG8_GAS f32x4*)(wsc + col0 + bj * HALF + 4); }
        __builtin_amdgcn_sched_barrier(0);
#pragma unroll
        for (int ai = 0; ai < 2; ++ai)
#pragma unroll
            for (int m = 0; m < 4; ++m) { const int row = row0 + ai * HALF + m * 16; bf16_t* rowp = O + (size_t)row * ldc + col0;
#pragma unroll
                for (int bj = 0; bj < 2; ++bj) { const i32x4 i0 = __builtin_bit_cast(i32x4, acc[ai][bj][m][0]), i1 = __builtin_bit_cast(i32x4, acc[ai][bj][m][1]);
                    const f32x4 v0 = (f32x4){(float)i0[0], (float)i0[1], (float)i0[2], (float)i0[3]} * wv[bj][0] * rs[ai][m], v1 = (f32x4){(float)i1[0], (float)i1[1], (float)i1[2], (float)i1[3]} * wv[bj][1] * rs[ai][m];
                    u32x4 w; w.x = cvt_pk_bf16(v0[0], v0[1]); w.y = cvt_pk_bf16(v0[2], v0[3]); w.z = cvt_pk_bf16(v1[0], v1[1]); w.w = cvt_pk_bf16(v1[2], v1[3]);
                    *(PG8_GAS u32x4*)(rowp + bj * HALF) = w; } }
    }
};
struct EpiResidMix {
    static constexpr bool PERM = false, AFTER_DRAIN = false, KSCALE = true, I8 = false; static constexpr int KS0 = 12, KS1 = 20;
    bf16_t* s; int ldc; u64_t* rowsq; const PG8_LAS float* ftab; const PG8_LAS int* pmtab;
    __device__ __forceinline__ int slot(int pm) const { return pmtab[0] == pm ? 0 : (pmtab[1] == pm ? 1 : (pmtab[2] == pm ? 2 : 3)); }
    __device__ __forceinline__ void kscale(f32x4 (&acc)[2][2][4][2], const Unit& u, int which, int wr, int fr) const {
        const PG8_LAS float* ft = ftab + which * 1024 + slot(u.pm) * 256;
#pragma unroll
        for (int ai = 0; ai < 2; ++ai)
#pragma unroll
            for (int m = 0; m < 4; ++m) { const float f = ft[ai * HALF + wr * 64 + m * 16 + fr];
#pragma unroll
                for (int bj = 0; bj < 2; ++bj)
#pragma unroll
                    for (int n = 0; n < 2; ++n) acc[ai][bj][m][n] = acc[ai][bj][m][n] * f; }
    }
    __device__ __forceinline__ void operator()(const f32x4 (&acc)[2][2][4][2], const Unit& u, int wr, int wc, int fr, int fq) const {
        const int col0 = u.pn * BM + wc * 32 + 4 * fq;
#pragma unroll
        for (int ai = 0; ai < 2; ++ai)
#pragma unroll
            for (int m = 0; m < 4; ++m) { const int row = u.pm * BM + ai * HALF + wr * 64 + m * 16 + fr; bf16_t* sp = s + (size_t)row * ldc + col0; float ss = 0.f; const float rc = ftab[2048 + slot(u.pm) * 256 + ai * HALF + wr * 64 + m * 16 + fr];
                u32x2 in[2][2];
#pragma unroll
                for (int bj = 0; bj < 2; ++bj)
#pragma unroll
                    for (int n = 0; n < 2; ++n) in[bj][n] = *(const PG8_GAS u32x2*)(sp + bj * HALF + n * 16);
#pragma unroll
                for (int bj = 0; bj < 2; ++bj)
#pragma unroll
                    for (int n = 0; n < 2; ++n) { const u32x2 w0 = in[bj][n];
                        const f32x4 bs = (f32x4){__builtin_bit_cast(float, w0.x << 16), __builtin_bit_cast(float, w0.x & 0xffff0000u), __builtin_bit_cast(float, w0.y << 16), __builtin_bit_cast(float, w0.y & 0xffff0000u)};
                        const f32x4 o = bs + acc[ai][bj][m][n] * rc; ss += (o[0] * o[0] + o[1] * o[1]) + (o[2] * o[2] + o[3] * o[3]);
                        u32x2 w; w.x = cvt_pk_bf16(o[0], o[1]); w.y = cvt_pk_bf16(o[2], o[3]); *(PG8_GAS u32x2*)(sp + bj * HALF + n * 16) = w; }
                ss += shx(ss, 16, fr + 16 * fq); ss += shx(ss, 32, fr + 16 * fq);
                if (fq == 0) (void)__hip_atomic_fetch_add((PG8_GAS u64_t*)(rowsq + row), rowsq_fx(ss), __ATOMIC_RELAXED, __HIP_MEMORY_SCOPE_AGENT); }
    }
};
struct EpiBf16Row {
    static constexpr bool PERM = true, AFTER_DRAIN = false, KSCALE = false, I8 = false;
    bf16_t* O; int ldc; const u64_t* rowsq;
    __device__ __forceinline__ void operator()(const f32x4 (&acc)[2][2][4][2], const Unit& u, int wr, int wc, int fr, int fq) const {
        const int row0 = u.pm * BM + wr * 64 + fr, col0 = u.pn * BM + wc * 32 + 8 * fq;
#pragma unroll
        for (int ai = 0; ai < 2; ++ai)
#pragma unroll
            for (int m = 0; m < 4; ++m) { const int row = row0 + ai * HALF + m * 16; const float rs = rowsq_rs(rowsq, row); bf16_t* rowp = O + (size_t)row * ldc + col0;
#pragma unroll
                for (int bj = 0; bj < 2; ++bj) { const f32x4 v0 = acc[ai][bj][m][0] * rs, v1 = acc[ai][bj][m][1] * rs; u32x4 w; w.x = cvt_pk_bf16(v0[0], v0[1]); w.y = cvt_pk_bf16(v0[2], v0[3]); w.z = cvt_pk_bf16(v1[0], v1[1]); w.w = cvt_pk_bf16(v1[2], v1[3]);
                    *(PG8_GAS u32x4*)(rowp + bj * HALF) = w; } }
    }
};
struct EpiQKV {
    static constexpr bool PERM = false, AFTER_DRAIN = false, KSCALE = false, I8 = true;
    bf16_t* O; const float* ga; const float* gb; const float* gc; const PG8_LAS float* rope; const u64_t* rowsq; const float* xsc; const float* wsc;
    __device__ __forceinline__ void operator()(const f32x4 (&acc)[2][2][4][2], const Unit& u, int wr, int wc, int fr, int fq) const {
        const int hg = u.pn * 4 + wc;
        const float* g = nullptr; bool isq = false, dorope = false;
        if (hg < 12) { g = ga; isq = true; } else if (hg < 16) { g = ga + 64; } else if (hg < 20) { }
        else if (hg < 28) { g = gb; isq = true; } else if (hg < 36) { g = gb + 64; } else if (hg < 44) { }
        else if (hg < 56) { g = gc; isq = true; dorope = true; } else if (hg < 60) { g = gc + 64; dorope = true; }
        const float qs = isq ? 0.18033688011112042f : 1.0f;
        float rsxa[2][4]; f32x4 wv[2][2], gv[2][2];
#pragma unroll
        for (int ai = 0; ai < 2; ++ai)
#pragma unroll
            for (int m = 0; m < 4; ++m) { const int row = u.pm * BM + ai * HALF + wr * 64 + m * 16 + fr; rsxa[ai][m] = *(const PG8_GAS float*)(xsc + row); }
#pragma unroll
        for (int bj = 0; bj < 2; ++bj)
#pragma unroll
            for (int n = 0; n < 2; ++n) { wv[bj][n] = *(const PG8_GAS f32x4*)(wsc + hg * 64 + 32 * bj + 16 * n + 4 * fq); gv[bj][n] = g ? *(const PG8_GAS f32x4*)(g + 32 * bj + 16 * n + 4 * fq) : (f32x4){1.f, 1.f, 1.f, 1.f}; }
        __builtin_amdgcn_sched_barrier(0);
#pragma unroll
        for (int ai = 0; ai < 2; ++ai)
#pragma unroll
            for (int m = 0; m < 4; ++m) {
                const int row = u.pm * BM + ai * HALF + wr * 64 + m * 16 + fr;
                f32x4 v[2][2];
                const float rsx = rsxa[ai][m];
#pragma unroll
                for (int bj = 0; bj < 2; ++bj)
#pragma unroll
                    for (int n = 0; n < 2; ++n) { const i32x4 ia = __builtin_bit_cast(i32x4, acc[ai][bj][m][n]);
                        v[bj][n] = (f32x4){(float)ia[0], (float)ia[1], (float)ia[2], (float)ia[3]} * wv[bj][n] * rsx; }
                if (g) {
                    float ss = 0.f;
#pragma unroll
                    for (int bj = 0; bj < 2; ++bj)
#pragma unroll
                        for (int n = 0; n < 2; ++n) { const f32x4 x = v[bj][n]; ss += (x[0] * x[0] + x[1] * x[1]) + (x[2] * x[2] + x[3] * x[3]); }
                    ss += shx(ss, 16, fr + 16 * fq); ss += shx(ss, 32, fr + 16 * fq);
                    const float r = qs / sqrtf(ss * (1.0f / 64.0f) + 1e-6f);
#pragma unroll
                    for (int bj = 0; bj < 2; ++bj)
#pragma unroll
                        for (int n = 0; n < 2; ++n) v[bj][n] = v[bj][n] * gv[bj][n] * r;
                }
                if (dorope) {
                    const int t = row & 2047, pr = t >> 6, pc = t & 63;
#pragma unroll
                    for (int bj = 0; bj < 2; ++bj) {
                        const int pos = bj ? pc : pr;
                        const PG8_LAS float* rp = rope + (pos * 16 + 4 * fq) * 2;
                        const f32x4 c01 = *(const PG8_LAS f32x4*)rp, c23 = *(const PG8_LAS f32x4*)(rp + 4);
                        const f32x4 cs = (f32x4){c01[0], c01[2], c23[0], c23[2]}, sn = (f32x4){c01[1], c01[3], c23[1], c23[3]};
                        const f32x4 x1 = v[bj][0], x2 = v[bj][1];
                        v[bj][0] = x1 * cs - x2 * sn; v[bj][1] = x1 * sn + x2 * cs;
                    }
                }
                bf16_t* rowp = O + (size_t)row * 4096 + hg * 64 + 4 * fq;
#pragma unroll
                for (int bj = 0; bj < 2; ++bj)
#pragma unroll
                    for (int n = 0; n < 2; ++n) { u32x2 w; w.x = cvt_pk_bf16(v[bj][n][0], v[bj][n][1]); w.y = cvt_pk_bf16(v[bj][n][2], v[bj][n][3]); *(PG8_GAS u32x2*)(rowp + 32 * bj + 16 * n) = w; }
                asm volatile("" ::: "memory");
            }
    }
};
template <bool I8> __device__ __forceinline__ f32x4 mma16(const bf16x8 b, const bf16x8 a, const f32x4 c) {
    if constexpr (I8) return __builtin_bit_cast(f32x4, __builtin_amdgcn_mfma_i32_16x16x64_i8(__builtin_bit_cast(i32x4, b), __builtin_bit_cast(i32x4, a), __builtin_bit_cast(i32x4, c), 0, 0, 0));
    else return __builtin_amdgcn_mfma_f32_16x16x32_bf16(b, a, c, 0, 0, 0);
}
template <class Epi, class Sched, bool ALIGN_EPI = false, bool SP2 = false>
__device__ __forceinline__ void gemm_phase(PG8_LAS unsigned char* lds, const Gemm g, const Sched& S, const Epi& E, const int tid) {
    const int wid = __builtin_amdgcn_readfirstlane(tid >> 6), lane = tid & 63, wr = wid >> 2, wc = wid & 3, fr = lane & 15, fq = lane >> 4;
    const int K = g.K, nt = K / BK;
    unsigned voffA[2], voffB[2];
#pragma unroll
    for (int i = 0; i < 2; ++i) { int R, C; stage_rc(tid * 16 + i * 8192, R, C); const int Rb = Epi::PERM ? ((R & ~31) + perm32(R & 31)) : R;
        voffA[i] = (unsigned)(R * K + C) * 2u; voffB[i] = (unsigned)(Rb * K + C) * 2u; }
    const size_t kstep = (size_t)(BK * 2);
    const size_t hstep = (size_t)HALF * K * 2;
    const size_t tstep = 2 * hstep;
    const unsigned ldsw = (unsigned)wid * 1024u;
    const int aoff = lds_byte(wr * 64 + fr, fq * 8), boff = lds_byte(wc * 32 + fr, fq * 8);
#define PG8_SA(b, h) (((b) * 2 + (h)) * HTB)
#define PG8_SB(b, h) ((4 + (b) * 2 + (h)) * HTB)
#define PG8_STAGE(bufoff, gbase, voff) do { _Pragma("unroll") for (int _i = 0; _i < 2; ++_i) \
        __builtin_amdgcn_global_load_lds((const unsigned*)((const char*)(gbase) + (voff)[_i]), (PG8_LAS unsigned*)(lds + (bufoff) + ldsw + _i * 8192), 16, 0, 0); } while (0)
#define PG8_LDA(dst, b, h) do { _Pragma("unroll") for (int m = 0; m < 4; ++m) _Pragma("unroll") for (int k = 0; k < 2; ++k) dst[m][k] = *(const PG8_LAS bf16x8*)(lds + PG8_SA(b, h) + aoff + m * 2048 + k * 1024); } while (0)
#define PG8_LDB(dst, b, h) do { _Pragma("unroll") for (int n = 0; n < 2; ++n) _Pragma("unroll") for (int k = 0; k < 2; ++k) dst[n][k] = *(const PG8_LAS bf16x8*)(lds + PG8_SB(b, h) + boff + n * 2048 + k * 1024); } while (0)
#define PG8_MMA(ai, bj, At, Bt) do { __builtin_amdgcn_s_setprio(1); _Pragma("unroll") for (int m = 0; m < 4; ++m) _Pragma("unroll") for (int n = 0; n < 2; ++n) _Pragma("unroll") for (int k = 0; k < 2; ++k) \
        acc[ai][bj][m][n] = mma16<Epi::I8>(Bt[n][k], At[m][k], acc[ai][bj][m][n]); __builtin_amdgcn_s_setprio(0); } while (0)
#define PG8_WAIT_V(n) asm volatile("s_waitcnt vmcnt(" #n ")" ::: "memory")
#define PG8_WAIT_L(n) asm volatile("s_waitcnt lgkmcnt(" #n ")" ::: "memory")
#define PG8_BAR __builtin_amdgcn_s_barrier()
#define PG8_SCHED __builtin_amdgcn_sched_barrier(0)
    Unit cur, nxt; int ui = 0;
    if (!S.next(0, cur)) return;
    f32x4 acc[2][2][4][2];
#pragma unroll
    for (int a = 0; a < 2; ++a)
#pragma unroll
        for (int b = 0; b < 2; ++b)
#pragma unroll
            for (int m = 0; m < 4; ++m)
#pragma unroll
                for (int n = 0; n < 2; ++n) acc[a][b][m][n] = (f32x4){0.f, 0.f, 0.f, 0.f};
    bf16x8 At[4][2], B0[2][2], B1[2][2];
    const char* cA = (const char*)g.A + (size_t)cur.pm * tstep; const char* cB = (const char*)g.Bt + (size_t)cur.pn * tstep;
    S.a_ready(cur);
    if constexpr (SP2) {
        PG8_STAGE(PG8_SB(0, 0), cB, voffB); PG8_STAGE(PG8_SB(0, 1), cB + hstep, voffB); PG8_STAGE(PG8_SA(0, 0), cA, voffA); PG8_STAGE(PG8_SA(0, 1), cA + hstep, voffA);
        if (wr == 1) PG8_BAR;
        PG8_WAIT_V(2); PG8_BAR;
        PG8_STAGE(PG8_SB(1, 0), cB + kstep, voffB); PG8_STAGE(PG8_SA(1, 0), cA + kstep, voffA); PG8_STAGE(PG8_SB(1, 1), cB + hstep + kstep, voffB);
        PG8_WAIT_V(6); PG8_BAR;
    } else {
        PG8_STAGE(PG8_SB(0, 0), cB, voffB); PG8_STAGE(PG8_SA(0, 0), cA, voffA); PG8_STAGE(PG8_SB(0, 1), cB + hstep, voffB); PG8_STAGE(PG8_SA(0, 1), cA + hstep, voffA);
        if (wr == 1) PG8_BAR;
        PG8_WAIT_V(4); PG8_BAR;
        PG8_STAGE(PG8_SB(1, 0), cB + kstep, voffB); PG8_STAGE(PG8_SA(1, 0), cA + kstep, voffA); PG8_STAGE(PG8_SB(1, 1), cB + hstep + kstep, voffB);
        PG8_WAIT_V(6); PG8_BAR;
    }
    for (;;) {
        const bool has_next = S.next(ui + 1, nxt);
        const char* nA = has_next ? (const char*)g.A + (size_t)nxt.pm * tstep : cA; const char* nB = has_next ? (const char*)g.Bt + (size_t)nxt.pn * tstep : cB;
        for (int t = 0; t < nt; t += 2) {
            if constexpr (Epi::KSCALE) { if (t == Epi::KS0 || t == Epi::KS1) E.kscale(acc, cur, t == Epi::KS1 ? 1 : 0, wr, fr); }
            const bool last = (t == nt - 2);
            const char* a1 = cA + (size_t)(t + 1) * kstep;
            const char* a2 = last ? nA : cA + (size_t)(t + 2) * kstep; const char* b2 = last ? nB : cB + (size_t)(t + 2) * kstep;
            const char* a3 = a2 + kstep; const char* b3 = b2 + kstep;
            if (last && has_next) S.a_ready(nxt);
            if constexpr (SP2) {
            PG8_LDB(B0, 0, 0); PG8_LDB(B1, 0, 1); PG8_SCHED; PG8_LDA(At, 0, 0); PG8_STAGE(PG8_SA(1, 1), a1 + hstep, voffA);
            PG8_WAIT_V(8); PG8_WAIT_L(0); PG8_BAR; PG8_MMA(0, 0, At, B0); PG8_MMA(0, 1, At, B1); PG8_BAR; PG8_SCHED;
            PG8_LDA(At, 0, 1); PG8_STAGE(PG8_SB(0, 0), b2, voffB); PG8_STAGE(PG8_SB(0, 1), b2 + hstep, voffB); PG8_STAGE(PG8_SA(0, 0), a2, voffA);
            PG8_WAIT_V(8); PG8_WAIT_L(0); PG8_BAR; PG8_MMA(1, 0, At, B0); PG8_MMA(1, 1, At, B1); PG8_BAR; PG8_SCHED;
            PG8_LDB(B0, 1, 0); PG8_LDB(B1, 1, 1); PG8_SCHED; PG8_LDA(At, 1, 0); PG8_STAGE(PG8_SA(0, 1), a2 + hstep, voffA);
            PG8_WAIT_V(8); PG8_WAIT_L(0); PG8_BAR; PG8_MMA(0, 0, At, B0); PG8_MMA(0, 1, At, B1); PG8_BAR; PG8_SCHED;
            PG8_LDA(At, 1, 1); PG8_STAGE(PG8_SB(1, 0), b3, voffB); PG8_STAGE(PG8_SB(1, 1), b3 + hstep, voffB); PG8_STAGE(PG8_SA(1, 0), a3, voffA);
            PG8_WAIT_V(8); PG8_WAIT_L(0); PG8_BAR; PG8_MMA(1, 0, At, B0); PG8_MMA(1, 1, At, B1); PG8_BAR; PG8_SCHED;
            } else {
            PG8_LDB(B0, 0, 0); PG8_SCHED; PG8_LDA(At, 0, 0); PG8_STAGE(PG8_SA(1, 1), a1 + hstep, voffA);
            PG8_WAIT_L(8); PG8_BAR; PG8_WAIT_L(0); PG8_MMA(0, 0, At, B0); PG8_BAR; PG8_SCHED;
            PG8_LDB(B1, 0, 1); PG8_STAGE(PG8_SB(0, 0), b2, voffB);
            PG8_BAR; PG8_WAIT_L(0); PG8_MMA(0, 1, At, B1); PG8_BAR;
            PG8_LDA(At, 0, 1); PG8_STAGE(PG8_SA(0, 0), a2, voffA);
            PG8_BAR; PG8_WAIT_L(0); PG8_MMA(1, 0, At, B0); PG8_BAR; PG8_SCHED;
            PG8_STAGE(PG8_SB(0, 1), b2 + hstep, voffB);
            PG8_WAIT_V(6); PG8_BAR; PG8_MMA(1, 1, At, B1); PG8_BAR;
            PG8_LDB(B0, 1, 0); PG8_SCHED; PG8_LDA(At, 1, 0); PG8_STAGE(PG8_SA(0, 1), a2 + hstep, voffA);
            PG8_WAIT_L(8); PG8_BAR; PG8_WAIT_L(0); PG8_MMA(0, 0, At, B0); PG8_BAR; PG8_SCHED;
            PG8_LDB(B1, 1, 1); PG8_STAGE(PG8_SB(1, 0), b3, voffB);
            PG8_BAR; PG8_WAIT_L(0); PG8_MMA(0, 1, At, B1); PG8_BAR;
            PG8_LDA(At, 1, 1); PG8_STAGE(PG8_SA(1, 0), a3, voffA);
            PG8_BAR; PG8_WAIT_L(0); PG8_MMA(1, 0, At, B0); PG8_BAR; PG8_SCHED;
            PG8_STAGE(PG8_SB(1, 1), b3 + hstep, voffB);
            PG8_WAIT_V(6); PG8_BAR; PG8_MMA(1, 1, At, B1); PG8_BAR;
            }
        }
        if constexpr (ALIGN_EPI) { if (wr == 0) PG8_BAR; }
        if constexpr (!Epi::AFTER_DRAIN) { E(acc, cur, wr, wc, fr, fq); S.done(cur); }
        if (!has_next) break;
#pragma unroll
        for (int a = 0; a < 2; ++a)
#pragma unroll
            for (int b = 0; b < 2; ++b)
#pragma unroll
                for (int m = 0; m < 4; ++m)
#pragma unroll
                    for (int n = 0; n < 2; ++n) acc[a][b][m][n] = (f32x4){0.f, 0.f, 0.f, 0.f};
        cur = nxt; cA = nA; cB = nB; ++ui;
        if constexpr (ALIGN_EPI) { if (wr == 1) PG8_BAR; }
    }
    PG8_WAIT_V(0);
    if constexpr (!ALIGN_EPI) { if (wr == 0) PG8_BAR; }
    PG8_BAR;
    if constexpr (Epi::AFTER_DRAIN) { E.fused(acc, cur, wr, wc, fr, fq, lds, wid, lane); S.done(cur); }
#undef PG8_SA
#undef PG8_SB
#undef PG8_STAGE
#undef PG8_LDA
#undef PG8_LDB
#undef PG8_MMA
#undef PG8_WAIT_V
#undef PG8_WAIT_L
#undef PG8_BAR
#undef PG8_SCHED
}
}

constexpr int BATCH = 16, SEQ = 2048, DM = 2048, T = BATCH * SEQ, DEPTH = 2;
constexpr int NMEM = 256, DIN = 4096, MEMW = 512;
constexpr int PEER_H = 8, PEER_N = 16384;
constexpr int NWAVES = 8, NTHREADS = NWAVES * 64;
constexpr float EPS = 1e-6f;
constexpr int QA = 0, KA = 768, VA = 1024, QB = 1280, KB = 1792, VB = 2304, QC = 2816, KC = 3584, VC = 3840;
constexpr int OA = 0, OB = 768, OC = 1280;

constexpr size_t MiB = 1u << 20;
constexpr size_t WS_CTL = 0, CTL_ZERO_BYTES = 2 * MiB;
constexpr size_t WS_ROWSQ = 256 * 1024;
constexpr size_t WS_ROPE = 83 * MiB, WS_BIASA = 83 * MiB + 16384;
constexpr size_t WS_WIN = 2 * MiB, WS_WOUT = 34 * MiB, WS_WMQ = 50 * MiB, WS_WMKV = 54 * MiB, WS_WMO = 62 * MiB, WS_WPQ = 66 * MiB, WS_PKEYS = 82 * MiB;
constexpr size_t WS_MEMN = 84 * MiB, WS_KVM = 116 * MiB, WS_PU = 132 * MiB, WS_PV = 260 * MiB, WS_XN = 388 * MiB, WS_QKV = 516 * MiB, WS_ATT = 772 * MiB;
constexpr size_t WS_QM = 900 * MiB, WS_OM = 932 * MiB, WS_MIXSQ = 964 * MiB, MIXSQ_BYTES = 2 * MiB, WS_WIN8 = 966 * MiB, WS_WSC = 982 * MiB, WS_XSC = 982 * MiB + 65536, WS_XSC2 = 982 * MiB + 196608, WS_WSCO = 982 * MiB + 327680, WS_WSCP = 982 * MiB + 344064, WS_WSCM = 982 * MiB + 360448,
                 WS_WOUT8 = 984 * MiB, WS_WPQ8 = 992 * MiB, WS_WMQ8 = 1000 * MiB, WS_END = 1002 * MiB;
constexpr size_t WS_QP = WS_QKV, WS_PIDX = WS_QKV + 128 * MiB, WS_PGATE = WS_QKV + 144 * MiB, WS_PARTI = WS_QKV + 160 * MiB;
constexpr size_t WS_XQH = 836 * MiB, WS_XQL = 868 * MiB;
constexpr size_t WS_XQH_OLD = 900 * MiB, WS_XQL_OLD = 932 * MiB;
constexpr size_t WS_ATT8 = 900 * MiB;
constexpr size_t WS_X8 = 772 * MiB;
constexpr size_t WS_XN8 = 836 * MiB;
constexpr int CW_BAR = 4096;

constexpr int RING_OFF = 0, RING_BYTES = 131072;
constexpr int LDSCTL_OFF = RING_BYTES, MISC_OFF = LDSCTL_OFF + 320;
constexpr int LDS_BYTES = 147456;

#define GAS __attribute__((address_space(1)))
#define LAS __attribute__((address_space(3)))
typedef unsigned short bf16;
typedef unsigned v4u __attribute__((ext_vector_type(4)));
typedef unsigned v2u __attribute__((ext_vector_type(2)));
typedef float f32x4 __attribute__((ext_vector_type(4)));
typedef float f32x16 __attribute__((ext_vector_type(16)));
typedef short bf16x8 __attribute__((ext_vector_type(8)));
typedef GAS unsigned gu32;
#define LDS_WAIT() asm volatile("s_waitcnt lgkmcnt(0)" ::: "memory")
#define VM_WAIT() asm volatile("s_waitcnt vmcnt(0)" ::: "memory")
__device__ __forceinline__ unsigned f2bf(float f) { unsigned u = __builtin_bit_cast(unsigned, f); return (u + 0x7fffu + ((u >> 16) & 1u)) >> 16; }
__device__ __forceinline__ unsigned pk2(float lo, float hi) { return f2bf(lo) | (f2bf(hi) << 16); }
__device__ __forceinline__ float bflo(unsigned w) { return __builtin_bit_cast(float, w << 16); }
__device__ __forceinline__ float bfhi(unsigned w) { return __builtin_bit_cast(float, w & 0xffff0000u); }

__device__ __forceinline__ float shx(float v, int k, int lane) { return __builtin_bit_cast(float, __builtin_amdgcn_ds_bpermute((lane ^ k) << 2, __builtin_bit_cast(int, v))); }
#define XB_TMO      128
#define XB_XCNT(j)  (256  + 64 * (j))
#define XB_XSUB(j)  (1280 + 64 * (j))
#define XB_XGEN(j)  (2304 + 64 * (j))
#define XB_TOP      3328
#define XB_TOPGEN   3392
#define XCD_BAR_WORDS 3456
#define XB_SPIN_CAP (1u << 18)

__device__ __forceinline__ unsigned xb_ld(unsigned* p)              { return __hip_atomic_load(p, __ATOMIC_RELAXED, __HIP_MEMORY_SCOPE_AGENT); }
__device__ __forceinline__ unsigned xb_add(unsigned* p, unsigned v) { return __hip_atomic_fetch_add(p, v, __ATOMIC_RELAXED, __HIP_MEMORY_SCOPE_AGENT); }
__device__ __forceinline__ unsigned xb_xcc_id() { return (unsigned)__builtin_amdgcn_s_getreg((3 << 11) | 20) & 0xFu; }
#define XB_SPIN(cond, bar) do { unsigned _sp = 0; while (cond) { __builtin_amdgcn_s_sleep(1); \
    if ((++_sp & 255u) == 0u) { if (xb_ld(&(bar)[XB_TMO])) break; if (_sp > XB_SPIN_CAP) { atomicAdd(&(bar)[XB_TMO], 1u); break; } } } } while (0)

struct XcdBarrier {
    unsigned* bar; unsigned x;
    volatile LAS unsigned* st;
};

__device__ __forceinline__ XcdBarrier xcd_barrier_post(unsigned* bar, volatile LAS unsigned* st) {
    XcdBarrier b; b.bar = bar; b.x = xb_xcc_id(); b.st = st;
    if (threadIdx.x == 0) (void)xb_add(&bar[XB_XCNT(b.x)], 1u);
    return b;
}
__device__ __forceinline__ void xcd_barrier_complete(unsigned* bar, unsigned x, unsigned& nloc, unsigned& nx) {
    const unsigned G = gridDim.x * gridDim.y * gridDim.z;
    unsigned sum, cnt, mine, sp = 0u;
    for (;;) {
        sum = 0u; cnt = 0u; mine = 0u;
#pragma unroll
        for (unsigned j = 0; j < 16; ++j) { const unsigned c = xb_ld(&bar[XB_XCNT(j)]); sum += c; cnt += (c > 0u) ? 1u : 0u; mine = (j == x) ? c : mine; }
        if (sum == G) break;
        __builtin_amdgcn_s_sleep(1);
        if ((++sp & 255u) == 0u) { if (xb_ld(&bar[XB_TMO])) break; if (sp > XB_SPIN_CAP) { atomicAdd(&bar[XB_TMO], 1u); break; } }
    }
    nloc = mine > 0u ? mine : 1u; nx = cnt > 0u ? cnt : 1u;
}

__device__ __forceinline__ void xcd_barrier(const XcdBarrier& b) {
    asm volatile("s_waitcnt vmcnt(0)" ::: "memory");
    __syncthreads();
    if (threadIdx.x == 0) {
        unsigned* bar = b.bar;
        __builtin_amdgcn_s_waitcnt(0);
        unsigned nloc = b.st[0], nx = b.st[1];
        if (nloc == 0u) { xcd_barrier_complete(bar, b.x, nloc, nx); b.st[0] = nloc; b.st[1] = nx; }
        const unsigned old = xb_add(&bar[XB_XSUB(b.x)], 1u);
        const unsigned gen = old / nloc;
        if (old + 1u == (gen + 1u) * nloc) {
            __builtin_amdgcn_fence(__ATOMIC_RELEASE, "agent");
            asm volatile("s_waitcnt vmcnt(0)" ::: "memory");
            const unsigned og = xb_add(&bar[XB_TOP], 1u);
            const unsigned tg = og / nx;
            if (og + 1u == (tg + 1u) * nx) xb_add(&bar[XB_TOPGEN], 1u);
            else XB_SPIN(xb_ld(&bar[XB_TOPGEN]) == tg, bar);
            __builtin_amdgcn_fence(__ATOMIC_ACQUIRE, "agent");
            xb_add(&bar[XB_XGEN(b.x)], 1u);
            asm volatile("s_waitcnt vmcnt(0)" ::: "memory");
        } else {
            XB_SPIN(xb_ld(&bar[XB_XGEN(b.x)]) == gen, bar);
            __builtin_amdgcn_fence(__ATOMIC_ACQUIRE, "agent");
            asm volatile("s_waitcnt vmcnt(0)" ::: "memory");
        }
    }
    __syncthreads();
}

__device__ __forceinline__ float wave_sum(float v, int lane) {
#pragma unroll
    for (int o = 1; o < 64; o <<= 1) v += shx(v, o, lane);
    return v;
}
__device__ __forceinline__ void* ldptr(LAS unsigned char* lds, int i) {
    const unsigned long long v = ((const LAS unsigned long long*)(lds + LDSCTL_OFF + 1024))[i];
    const unsigned lo = __builtin_amdgcn_readfirstlane((unsigned)v), hi = __builtin_amdgcn_readfirstlane((unsigned)(v >> 32));
    return (void*)(((unsigned long long)hi << 32) | lo);
}
struct OffsetOrder {
    pg8::StaticOrder S;
    __device__ __forceinline__ void init(int M, int N, int G, int c, int off) { S.init(M, N, G, (c + G - off % G) % G); }
    __device__ __forceinline__ bool next(int i, pg8::Unit& u) const { return S.next(i, u); }
    __device__ __forceinline__ void a_ready(const pg8::Unit&) const {}
    __device__ __forceinline__ void done(const pg8::Unit&) const {}
};

template <bool PERMQKV>
__device__ __forceinline__ void transpose_item(const float* W, int K, int N, bf16* WT, LAS float* scr, int item, int lane, const float* gk = nullptr) {
    const int nblk = N / 32, kb = item / nblk, nb = item % nblk, k0 = 64 * kb, n0 = 32 * nb;
    int d0 = n0;
    if (PERMQKV) { const int within = n0 & 255; d0 = (n0 & ~255) + 128 * ((within >> 5) & 1) + 32 * (within >> 6); }
#pragma unroll
    for (int i = 0; i < 8; ++i) { const int kk = 8 * i + (lane >> 3), nn = 4 * (lane & 7);
        const f32x4 w4 = *(const GAS f32x4*)(W + (size_t)(k0 + kk) * N + n0 + nn) * (gk ? gk[k0 + kk] : 1.f);
        scr[kk * 33 + nn] = w4[0]; scr[kk * 33 + nn + 1] = w4[1]; scr[kk * 33 + nn + 2] = w4[2]; scr[kk * 33 + nn + 3] = w4[3]; }
    LDS_WAIT(); asm volatile("" ::: "memory");
    const int c = lane & 7;
#pragma unroll
    for (int j = 0; j < 4; ++j) { const int n = (lane >> 3) + 8 * j; const LAS float* s = scr + (8 * c) * 33 + n;
        v4u o; o.x = pk2(s[0 * 33], s[1 * 33]); o.y = pk2(s[2 * 33], s[3 * 33]); o.z = pk2(s[4 * 33], s[5 * 33]); o.w = pk2(s[6 * 33], s[7 * 33]);
        *(GAS v4u*)(WT + (size_t)(d0 + n) * K + k0 + 8 * c) = o; }
    LDS_WAIT(); asm volatile("" ::: "memory");
}
__device__ __forceinline__ void convert_bf16(const float* src, bf16* dst, size_t n, size_t gtid, size_t nthreads) {
    for (size_t i = gtid * 8; i < n; i += nthreads * 8) {
        const f32x4 a = *(const GAS f32x4*)(src + i), b = *(const GAS f32x4*)(src + i + 4);
        v4u o; o.x = pk2(a[0], a[1]); o.y = pk2(a[2], a[3]); o.z = pk2(b[0], b[1]); o.w = pk2(b[2], b[3]);
        *(GAS v4u*)(dst + i) = o;
    }
}
__device__ __forceinline__ int t5_bucket(int rel) {
    const int n = rel < 0 ? -rel : rel;
    const int b = n < 8 ? n : n < 12 ? 8 : n < 16 ? 9 : n < 23 ? 10 : n < 32 ? 11 : n < 46 ? 12 : n < 64 ? 13 : n < 91 ? 14 : 15;
    return b + (rel > 0 ? 16 : 0);
}
__constant__ float ROPE_INV[16] = {1.000000000e+00f, 5.623413324e-01f, 3.162277639e-01f, 1.778279394e-01f, 1.000000015e-01f, 5.623413250e-02f, 3.162277490e-02f, 1.778279431e-02f,
                                   9.999999776e-03f, 5.623413250e-03f, 3.162277630e-03f, 1.778279431e-03f, 1.000000047e-03f, 5.623413017e-04f, 3.162277571e-04f, 1.778279402e-04f};

__device__ __forceinline__ void rms_row_to_bf16(const float* xrow, const float* g0, bf16* o0, const float* g1, bf16* o1, int lane) {
    const GAS f32x4* xr = (const GAS f32x4*)xrow + lane;
    f32x4 v[8]; float s = 0.f;
#pragma unroll
    for (int j = 0; j < 8; ++j) { v[j] = xr[64 * j]; s += (v[j].x * v[j].x + v[j].y * v[j].y) + (v[j].z * v[j].z + v[j].w * v[j].w); }
    const float rstd = 1.f / sqrtf(wave_sum(s, lane) * (1.f / DM) + EPS);
    {   const GAS f32x4* gr = (const GAS f32x4*)g0 + lane; GAS v2u* o8 = (GAS v2u*)o0 + lane;
#pragma unroll
        for (int j = 0; j < 8; ++j) { const f32x4 gg = gr[64 * j]; v2u w; w.x = pk2(v[j].x * rstd * gg.x, v[j].y * rstd * gg.y); w.y = pk2(v[j].z * rstd * gg.z, v[j].w * rstd * gg.w); o8[64 * j] = w; } }
    if (g1) { const GAS f32x4* gr = (const GAS f32x4*)g1 + lane; GAS v2u* o8 = (GAS v2u*)o1 + lane;
#pragma unroll
        for (int j = 0; j < 8; ++j) { const f32x4 gg = gr[64 * j]; v2u w; w.x = pk2(v[j].x * rstd * gg.x, v[j].y * rstd * gg.y); w.y = pk2(v[j].z * rstd * gg.z, v[j].w * rstd * gg.w); o8[64 * j] = w; } }
}
__device__ __forceinline__ float wave_max(float v, int lane) {
#pragma unroll
    for (int o = 1; o < 64; o <<= 1) v = fmaxf(v, shx(v, o, lane));
    return v;
}
__device__ __forceinline__ unsigned q8x4(const f32x4 v, const float inv) {
    unsigned w = 0;
    w = __builtin_amdgcn_cvt_pk_u8_f32(__builtin_rintf(__builtin_fmaf(v[0], inv, 128.f)), 0, w); w = __builtin_amdgcn_cvt_pk_u8_f32(__builtin_rintf(__builtin_fmaf(v[1], inv, 128.f)), 1, w);
    w = __builtin_amdgcn_cvt_pk_u8_f32(__builtin_rintf(__builtin_fmaf(v[2], inv, 128.f)), 2, w); w = __builtin_amdgcn_cvt_pk_u8_f32(__builtin_rintf(__builtin_fmaf(v[3], inv, 128.f)), 3, w);
    return w ^ 0x80808080u;
}
__device__ __forceinline__ float amax4(const f32x4 v) { return fmaxf(fmaxf(fabsf(v[0]), fabsf(v[1])), fmaxf(fabsf(v[2]), fabsf(v[3]))); }
__device__ __forceinline__ void quant_wrow(const bf16* src, unsigned char* dst, float* step, int lane) {
    v4u w[4]; float am = 0.f;
#pragma unroll
    for (int j = 0; j < 4; ++j) w[j] = *(const GAS v4u*)(src + 8 * lane + 512 * j);
    f32x4 lo[4], hi[4];
#pragma unroll
    for (int j = 0; j < 4; ++j) { lo[j] = (f32x4){bflo(w[j].x), bfhi(w[j].x), bflo(w[j].y), bfhi(w[j].y)}; hi[j] = (f32x4){bflo(w[j].z), bfhi(w[j].z), bflo(w[j].w), bfhi(w[j].w)}; am = fmaxf(am, fmaxf(amax4(lo[j]), amax4(hi[j]))); }
    am = fmaxf(wave_max(am, lane), 1e-30f);
    const float inv = 127.f / am;
#pragma unroll
    for (int j = 0; j < 4; ++j) *(GAS v2u*)(dst + 8 * lane + 512 * j) = (v2u){q8x4(lo[j], inv), q8x4(hi[j], inv)};
    if (lane == 0) *step = am * (1.f / 127.f);
}
template <int R>
__device__ __forceinline__ void att_quant_rows(const bf16* ATT, const u64_t* mixsq, unsigned char* Q, float* step, int row0, int lane) {
    v4u w[R][4];
#pragma unroll
    for (int q = 0; q < R; ++q)
#pragma unroll
        for (int j = 0; j < 4; ++j) w[q][j] = *(const GAS v4u*)(ATT + (size_t)(row0 + q) * DM + 8 * lane + 512 * j);
#pragma unroll
    for (int q = 0; q < R; ++q) { const int row = row0 + q;
        const float ra = 1.0f / sqrtf((float)*(const GAS u64_t*)(mixsq + row) * (5.9604644775390625e-08f / 768.0f) + EPS), rb = 1.0f / sqrtf((float)*(const GAS u64_t*)(mixsq + T + row) * (5.9604644775390625e-08f / 512.0f) + EPS),
                    rc = 1.0f / sqrtf((float)*(const GAS u64_t*)(mixsq + 2 * (size_t)T + row) * (5.9604644775390625e-08f / 768.0f) + EPS);
        const float rj[4] = {ra, lane < 32 ? ra : rb, lane < 32 ? rb : rc, rc};
        f32x4 lo[4], hi[4]; float am = 0.f;
#pragma unroll
        for (int j = 0; j < 4; ++j) { lo[j] = (f32x4){bflo(w[q][j].x), bfhi(w[q][j].x), bflo(w[q][j].y), bfhi(w[q][j].y)} * rj[j]; hi[j] = (f32x4){bflo(w[q][j].z), bfhi(w[q][j].z), bflo(w[q][j].w), bfhi(w[q][j].w)} * rj[j]; am = fmaxf(am, fmaxf(amax4(lo[j]), amax4(hi[j]))); }
        am = fmaxf(wave_max(am, lane), 1e-30f);
        const float inv = 127.f / am;
#pragma unroll
        for (int j = 0; j < 4; ++j) *(GAS v2u*)(Q + (size_t)row * DM + 8 * lane + 512 * j) = (v2u){q8x4(lo[j], inv), q8x4(hi[j], inv)};
        if (lane == 0) step[row] = am * (1.f / 127.f); }
}
__device__ __forceinline__ void prep_rows2(const float* x0, bf16* o0, u64_t* sq, unsigned char* q0, float* qstep, int lane) {
    f32x4 v[2][8];
#pragma unroll
    for (int q = 0; q < 2; ++q) { const GAS f32x4* xr = (const GAS f32x4*)(x0 + (size_t)q * DM) + lane;
#pragma unroll
        for (int j = 0; j < 8; ++j) v[q][j] = xr[64 * j]; }
#pragma unroll
    for (int q = 0; q < 2; ++q) { GAS v2u* o8 = (GAS v2u*)(o0 + (size_t)q * DM) + lane; float s = 0.f;
#pragma unroll
        for (int j = 0; j < 8; ++j) { const f32x4 a = v[q][j]; s += (a.x * a.x + a.y * a.y) + (a.z * a.z + a.w * a.w); v2u w; w.x = pk2(a.x, a.y); w.y = pk2(a.z, a.w); o8[64 * j] = w; }
        s = wave_sum(s, lane);
        float am = 0.f;
#pragma unroll
        for (int j = 0; j < 8; ++j) am = fmaxf(am, amax4(v[q][j]));
        am = fmaxf(wave_max(am, lane), 1e-30f);
        const float inv = 127.f / am;
#pragma unroll
        for (int j = 0; j < 8; ++j) *(GAS unsigned*)(q0 + (size_t)q * DM + 4 * lane + 256 * j) = q8x4(v[q][j], inv);
        if (lane == 0) { sq[q] = rowsq_fx(s); qstep[q] = am * (1.f / 127.f) / sqrtf(s * (1.f / DM) + 1e-6f); } }
}
__device__ __forceinline__ void norm_rows(const float* X, const float* g, bf16* XN, int gw, int NGW, int lane) {
    for (int m = gw; m < T; m += NGW) rms_row_to_bf16(X + (size_t)m * DM, g, XN + (size_t)m * DM, nullptr, nullptr, lane);
}

template <int TYPE>
__device__ __forceinline__ void naive_attn_item(const bf16* QKV, bf16* ATT, int b, int grow, int head, int lane, const float* biasA, const float* sink, const float* rpb) {
    const int tpos = grow * 64 + lane; const size_t trow = (size_t)b * SEQ + tpos;
    int qcol, kcol, vcol, ocol;
    if (TYPE == 0) { qcol = QA + head * 64; kcol = KA + (head / 3) * 64; vcol = VA + (head / 3) * 64; ocol = OA + head * 64; }
    else if (TYPE == 1) { qcol = QB + head * 64; kcol = KB + head * 64; vcol = VB + head * 64; ocol = OB + head * 64; }
    else { qcol = QC + head * 64; kcol = KC + (head / 3) * 64; vcol = VC + (head / 3) * 64; ocol = OC + head * 64; }
    float q[64], o[64];
#pragma unroll
    for (int c = 0; c < 8; ++c) { const v4u w = *(const GAS v4u*)(QKV + trow * DIN + qcol + 8 * c);
        q[8 * c + 0] = bflo(w.x); q[8 * c + 1] = bfhi(w.x); q[8 * c + 2] = bflo(w.y); q[8 * c + 3] = bfhi(w.y); q[8 * c + 4] = bflo(w.z); q[8 * c + 5] = bfhi(w.z); q[8 * c + 6] = bflo(w.w); q[8 * c + 7] = bfhi(w.w); }
#pragma unroll
    for (int d = 0; d < 64; ++d) o[d] = 0.f;
    float m = -1e30f, l = 0.f;
    int j0, j1;
    if (TYPE == 0) { j0 = grow * 64 - 128; if (j0 < 0) j0 = 0; j1 = grow * 64 + 63 + 128; if (j1 > SEQ - 1) j1 = SEQ - 1; }
    else if (TYPE == 1) { int r0 = grow - 4; r0 = r0 < 0 ? 0 : (r0 > 24 ? 24 : r0); j0 = r0 * 64; j1 = j0 + 511; }
    else { j0 = 0; j1 = SEQ - 1; }
    int c0 = lane - 8; c0 = c0 < 0 ? 0 : (c0 > 48 ? 48 : c0);
#pragma unroll 1
    for (int j = j0; j <= j1; ++j) {
        const bf16* krow = QKV + ((size_t)b * SEQ + j) * DIN;
        float s = 0.f;
#pragma unroll
        for (int c = 0; c < 8; ++c) { const v4u w = *(const GAS v4u*)(krow + kcol + 8 * c);
            s += q[8 * c + 0] * bflo(w.x) + q[8 * c + 1] * bfhi(w.x) + q[8 * c + 2] * bflo(w.y) + q[8 * c + 3] * bfhi(w.y) + q[8 * c + 4] * bflo(w.z) + q[8 * c + 5] * bfhi(w.z) + q[8 * c + 6] * bflo(w.w) + q[8 * c + 7] * bfhi(w.w); }
        bool valid = true;
        if (TYPE == 0) { const int rel = j - tpos; valid = (rel >= -128 && rel <= 128); if (valid) s += biasA[head * 257 + rel + 128]; }
        if (TYPE == 1) { const int kr = j >> 6, kc = j & 63; valid = (kc >= c0 && kc < c0 + 16); if (valid) s += rpb[(head * 15 + (kr - grow + 7)) * 31 + (kc - lane + 15)]; }
        const float mn = valid ? fmaxf(m, s) : m;
        const float a = __expf(m - mn);
        const float p = valid ? __expf(s - mn) : 0.f;
        l = l * a + p; m = mn;
#pragma unroll
        for (int c = 0; c < 8; ++c) { const v4u w = *(const GAS v4u*)(krow + vcol + 8 * c);
            o[8 * c + 0] = o[8 * c + 0] * a + p * bflo(w.x); o[8 * c + 1] = o[8 * c + 1] * a + p * bfhi(w.x); o[8 * c + 2] = o[8 * c + 2] * a + p * bflo(w.y); o[8 * c + 3] = o[8 * c + 3] * a + p * bfhi(w.y);
            o[8 * c + 4] = o[8 * c + 4] * a + p * bflo(w.z); o[8 * c + 5] = o[8 * c + 5] * a + p * bfhi(w.z); o[8 * c + 6] = o[8 * c + 6] * a + p * bflo(w.w); o[8 * c + 7] = o[8 * c + 7] * a + p * bfhi(w.w); }
    }
    if (TYPE == 0) l += __expf(sink[head] - m);
    const float inv = 1.f / l;
#pragma unroll
    for (int c = 0; c < 8; ++c) { v4u w; w.x = pk2(o[8 * c + 0] * inv, o[8 * c + 1] * inv); w.y = pk2(o[8 * c + 2] * inv, o[8 * c + 3] * inv); w.z = pk2(o[8 * c + 4] * inv, o[8 * c + 5] * inv); w.w = pk2(o[8 * c + 6] * inv, o[8 * c + 7] * inv);
        *(GAS v4u*)(ATT + trow * DM + ocol + 8 * c) = w; }
}
__device__ __forceinline__ float rdl(float v, int l) { return __builtin_bit_cast(float, __builtin_amdgcn_readlane(__builtin_bit_cast(int, v), l)); }
__device__ __forceinline__ void naive_mem_item(const bf16* QM, const bf16* KVM, bf16* OM, const float* gq, size_t trow, int b, int head, int lane) {
    const unsigned qw = *(const GAS unsigned*)(QM + trow * MEMW + head * 128 + 2 * lane);
    float q0 = bflo(qw), q1 = bfhi(qw);
    const float ss = wave_sum(q0 * q0 + q1 * q1, lane);
    const float r = 0.08838834764831845f / sqrtf(ss * (1.f / 128.f) + EPS);
    q0 *= r * gq[2 * lane]; q1 *= r * gq[2 * lane + 1];
    const bf16* kbase = KVM + ((size_t)b * NMEM + lane) * 1024 + head * 128;
    float s[4] = {0.f, 0.f, 0.f, 0.f};
#pragma unroll 1
    for (int c = 0; c < 16; ++c) {
        float qa[8];
#pragma unroll
        for (int e = 0; e < 4; ++e) { qa[2 * e] = rdl(q0, 4 * c + e); qa[2 * e + 1] = rdl(q1, 4 * c + e); }
#pragma unroll
        for (int i = 0; i < 4; ++i) { const v4u w = *(const GAS v4u*)(kbase + (size_t)i * 64 * 1024 + 8 * c);
            s[i] += qa[0] * bflo(w.x) + qa[1] * bfhi(w.x) + qa[2] * bflo(w.y) + qa[3] * bfhi(w.y) + qa[4] * bflo(w.z) + qa[5] * bfhi(w.z) + qa[6] * bflo(w.w) + qa[7] * bfhi(w.w); }
    }
    float m = fmaxf(fmaxf(s[0], s[1]), fmaxf(s[2], s[3]));
#pragma unroll
    for (int o = 1; o < 64; o <<= 1) m = fmaxf(m, shx(m, o, lane));
    float p[4]; float l = 0.f;
#pragma unroll
    for (int i = 0; i < 4; ++i) { p[i] = __expf(s[i] - m); l += p[i]; }
    l = wave_sum(l, lane);
    const bf16* vbase = KVM + ((size_t)b * NMEM) * 1024 + 512 + head * 128 + 2 * lane;
    float o0 = 0.f, o1 = 0.f;
#pragma unroll
    for (int i = 0; i < 4; ++i) {
#pragma unroll 4
        for (int jj = 0; jj < 64; ++jj) { const float pj = rdl(p[i], jj); const unsigned w = *(const GAS unsigned*)(vbase + (size_t)(64 * i + jj) * 1024); o0 += pj * bflo(w); o1 += pj * bfhi(w); }
    }
    const float inv = 1.f / l;
    *(GAS unsigned*)(OM + trow * MEMW + head * 128 + 2 * lane) = pk2(o0 * inv, o1 * inv);
}
__device__ __forceinline__ void mixnorm_rows(bf16* ATT, const float* g, int gw, int NGW, int lane) {
    for (int m = gw; m < T; m += NGW) {
        GAS v4u* p = (GAS v4u*)(ATT + (size_t)m * DM + 32 * lane);
        v4u w[4]; float f[32]; float ss = 0.f;
#pragma unroll
        for (int c = 0; c < 4; ++c) { w[c] = p[c];
            f[8 * c + 0] = bflo(w[c].x); f[8 * c + 1] = bfhi(w[c].x); f[8 * c + 2] = bflo(w[c].y); f[8 * c + 3] = bfhi(w[c].y); f[8 * c + 4] = bflo(w[c].z); f[8 * c + 5] = bfhi(w[c].z); f[8 * c + 6] = bflo(w[c].w); f[8 * c + 7] = bfhi(w[c].w); }
#pragma unroll
        for (int i = 0; i < 32; ++i) ss += f[i] * f[i];
        const int grp = lane < 24 ? 0 : (lane < 40 ? 1 : 2);
        const float sa = wave_sum(grp == 0 ? ss : 0.f, lane), sb = wave_sum(grp == 1 ? ss : 0.f, lane), sc = wave_sum(grp == 2 ? ss : 0.f, lane);
        const float r = grp == 0 ? 1.f / sqrtf(sa * (1.f / 768.f) + EPS) : (grp == 1 ? 1.f / sqrtf(sb * (1.f / 512.f) + EPS) : 1.f / sqrtf(sc * (1.f / 768.f) + EPS));
        const float* gg = g + 32 * lane;
#pragma unroll
        for (int c = 0; c < 4; ++c) { const f32x4 g0 = *(const GAS f32x4*)(gg + 8 * c), g1 = *(const GAS f32x4*)(gg + 8 * c + 4);
            v4u o; o.x = pk2(f[8 * c + 0] * r * g0[0], f[8 * c + 1] * r * g0[1]); o.y = pk2(f[8 * c + 2] * r * g0[2], f[8 * c + 3] * r * g0[3]);
            o.z = pk2(f[8 * c + 4] * r * g1[0], f[8 * c + 5] * r * g1[1]); o.w = pk2(f[8 * c + 6] * r * g1[2], f[8 * c + 7] * r * g1[3]); p[c] = o; }
    }
}

#ifndef PEER_HD
#define PEER_HD __device__ __forceinline__
#define PEER_EXP(x) __expf(x)
#endif
template <int N> PEER_HD void bitonic_sort_desc(float* v) {
#pragma unroll
    for (int k = 2; k <= N; k <<= 1)
#pragma unroll
        for (int j = k >> 1; j > 0; j >>= 1)
#pragma unroll
            for (int i = 0; i < N; ++i) { const int l = i ^ j; if (l > i) { const bool desc = ((i & k) == 0); const float a = v[i], b = v[l]; const float hi = fmaxf(a, b), lo = fminf(a, b);
                v[i] = desc ? hi : lo; v[l] = desc ? lo : hi; } }
}
#define PEER_CE(i, j) do { const float x_ = v[i], y_ = v[j]; v[i] = fmaxf(x_, y_); v[j] = fminf(x_, y_); } while (0)
PEER_HD void sort16_desc(float* v) {
    PEER_CE(0,13); PEER_CE(1,12); PEER_CE(2,15); PEER_CE(3,14); PEER_CE(4,8); PEER_CE(5,6); PEER_CE(7,11); PEER_CE(9,10);
    PEER_CE(0,5); PEER_CE(1,7); PEER_CE(2,9); PEER_CE(3,4); PEER_CE(6,13); PEER_CE(8,14); PEER_CE(10,15); PEER_CE(11,12);
    PEER_CE(0,1); PEER_CE(2,3); PEER_CE(4,5); PEER_CE(6,8); PEER_CE(7,9); PEER_CE(10,11); PEER_CE(12,13); PEER_CE(14,15);
    PEER_CE(0,2); PEER_CE(1,3); PEER_CE(4,10); PEER_CE(5,11); PEER_CE(6,7); PEER_CE(8,9); PEER_CE(12,14); PEER_CE(13,15);
    PEER_CE(1,2); PEER_CE(3,12); PEER_CE(4,6); PEER_CE(5,7); PEER_CE(8,10); PEER_CE(9,11); PEER_CE(13,14);
    PEER_CE(1,4); PEER_CE(2,6); PEER_CE(5,8); PEER_CE(7,10); PEER_CE(9,13); PEER_CE(11,14);
    PEER_CE(2,4); PEER_CE(3,6); PEER_CE(9,12); PEER_CE(11,13);
    PEER_CE(3,5); PEER_CE(6,8); PEER_CE(7,9); PEER_CE(10,12);
    PEER_CE(3,4); PEER_CE(5,6); PEER_CE(7,8); PEER_CE(9,10); PEER_CE(11,12);
    PEER_CE(6,7); PEER_CE(8,9);
}
PEER_HD void sort6_desc(float* v) {
    PEER_CE(0,5); PEER_CE(1,3); PEER_CE(2,4); PEER_CE(1,2); PEER_CE(3,4); PEER_CE(0,3); PEER_CE(2,5); PEER_CE(0,1); PEER_CE(2,3); PEER_CE(4,5); PEER_CE(1,2); PEER_CE(3,4);
}
PEER_HD void merge_top16(float* a, const float* b) {
    float c[16];
#pragma unroll
    for (int i = 0; i < 16; ++i) c[i] = fmaxf(a[i], b[15 - i]);
#pragma unroll
    for (int j = 8; j > 0; j >>= 1)
#pragma unroll
        for (int i = 0; i < 16; ++i) { const int l = i ^ j; if (l > i) { const float x = c[i], y = c[l]; c[i] = fmaxf(x, y); c[l] = fminf(x, y); } }
#pragma unroll
    for (int i = 0; i < 16; ++i) a[i] = c[i];
}
PEER_HD void top16_of_64(float (&v)[64]) {
    sort16_desc(&v[0]); sort16_desc(&v[16]); sort16_desc(&v[32]); sort16_desc(&v[48]);
    merge_top16(&v[0], &v[16]); merge_top16(&v[32], &v[48]); merge_top16(&v[0], &v[32]);
}
PEER_HD float pack_idx(float s, unsigned idx, unsigned mask) { return __builtin_bit_cast(float, (__builtin_bit_cast(unsigned, s) & ~mask) | idx); }
PEER_HD unsigned low_bits(float s, unsigned mask) { return __builtin_bit_cast(unsigned, s) & mask; }
PEER_HD unsigned pick16(const float* a, unsigned i, unsigned mask) {
    unsigned r = 0;
#pragma unroll
    for (unsigned k = 0; k < 16; ++k) r = (i == k) ? low_bits(a[k], mask) : r;
    return r;
}
PEER_HD void peer_candidates(const float* a, const float* b, int* e, float* gate) {
    const float NEG = -3.0e38f;
#define PEER_S(i, j) pack_idx(a[i] + b[j], (unsigned)((i) * 16 + (j)), 0xffu)
    float r0[16], r1[16], c0[16], c1[16], z[16];
#pragma unroll
    for (int j = 0; j < 16; ++j) { r0[j] = PEER_S(0, j); r1[j] = j < 8 ? PEER_S(1, j) : NEG; c0[j] = j < 14 ? PEER_S(j + 2 < 16 ? j + 2 : 15, 0) : NEG; c1[j] = j < 6 ? PEER_S(j + 2 < 16 ? j + 2 : 15, 1) : NEG; z[j] = NEG; }
    z[0] = PEER_S(2, 2); z[1] = PEER_S(2, 3); z[2] = PEER_S(2, 4); z[3] = PEER_S(3, 2); z[4] = PEER_S(3, 3); z[5] = PEER_S(4, 2);
#undef PEER_S
    sort6_desc(z);
    merge_top16(c1, z); merge_top16(c0, c1); merge_top16(r0, r1);
    float c[16];
#pragma unroll
    for (int i = 0; i < 16; ++i) c[i] = fmaxf(r0[i], c0[15 - i]);
    float mx = c[0], den = 0.f;
#pragma unroll
    for (int k = 0; k < 16; ++k) { const unsigned id = low_bits(c[k], 0xffu); const unsigned n0 = pick16(a, id >> 4, 0x7fu), n1 = pick16(b, id & 15u, 0x7fu);
        e[k] = (int)(n0 * 128u + n1); gate[k] = PEER_EXP(c[k] - mx); den += gate[k]; }
    const float inv = 1.f / den;
#pragma unroll
    for (int k = 0; k < 16; ++k) gate[k] *= inv;
}

__device__ __forceinline__ void peer_select_unit(const bf16* QP, const bf16* PK, int* PIDX, float* PGATE, int tb, int h, int wave, int lane, LAS unsigned char* lds) {
    const int hh = lane >> 5, tl = lane & 31; const size_t t = (size_t)tb * 256 + wave * 32 + tl;
    __syncthreads();
    {   const int tid = wave * 64 + lane; const bf16* src = PK + (size_t)h * 256 * 128;
#pragma unroll 1
        for (int i0 = 0; i0 < 8; i0 += 4) { v4u st[4];
#pragma unroll
            for (int i = 0; i < 4; ++i) st[i] = *(const GAS v4u*)(src + (size_t)(tid + 512 * (i0 + i)) * 8);
#pragma unroll
            for (int i = 0; i < 4; ++i) { const int c = tid + 512 * (i0 + i), row = c >> 4, ch = c & 15; *(LAS v4u*)(lds + row * 256 + ((ch ^ (row & 15)) * 16)) = st[i]; } } }
    __syncthreads();
    float ab[2][16];
#pragma unroll
    for (int p = 0; p < 2; ++p) {
        bf16x8 bq[8];
#pragma unroll
        for (int s = 0; s < 8; ++s) bq[s] = *(const GAS bf16x8*)(QP + t * DM + 256 * h + 128 * p + 16 * s + 8 * hh);
        float v[64];
#pragma unroll
        for (int nb = 0; nb < 4; ++nb) {
            f32x16 acc;
#pragma unroll
            for (int r = 0; r < 16; ++r) acc[r] = 0.f;
            const int krow = p * 128 + 32 * nb + tl;
            bf16x8 ak[8];
#pragma unroll
            for (int s = 0; s < 8; ++s) ak[s] = *(const LAS bf16x8*)(lds + krow * 256 + (((2 * s + hh) ^ (krow & 15)) * 16));
#pragma unroll
            for (int s = 0; s < 8; ++s) acc = __builtin_amdgcn_mfma_f32_32x32x16_bf16(ak[s], bq[s], acc, 0, 0, 0);
#pragma unroll
            for (int r = 0; r < 16; ++r) v[16 * nb + r] = pack_idx(acc[r], (unsigned)(32 * nb + 8 * (r >> 2) + 4 * hh + (r & 3)), 0x7fu);
        }
        top16_of_64(v);
        float pv[16];
#pragma unroll
        for (int i = 0; i < 16; ++i) pv[i] = shx(v[i], 32, lane);
        merge_top16(&v[0], pv);
#pragma unroll
        for (int i = 0; i < 16; ++i) ab[p][i] = v[i];
    }
    int e[16]; float gate[16];
    peer_candidates(ab[0], ab[1], e, gate);
    if (hh == 0) { GAS v4u* o = (GAS v4u*)(PIDX + t * 128 + h * 16);
#pragma unroll
        for (int c = 0; c < 4; ++c) o[c] = (v4u){(unsigned)e[4 * c], (unsigned)e[4 * c + 1], (unsigned)e[4 * c + 2], (unsigned)e[4 * c + 3]}; }
    else { GAS f32x4* o = (GAS f32x4*)(PGATE + t * 128 + h * 16);
#pragma unroll
        for (int c = 0; c < 4; ++c) o[c] = (f32x4){gate[4 * c], gate[4 * c + 1], gate[4 * c + 2], gate[4 * c + 3]}; }
}

typedef float f32x2 __attribute__((ext_vector_type(2)));
typedef unsigned v6u __attribute__((ext_vector_type(6)));
typedef float v32f __attribute__((ext_vector_type(32)));
typedef v4u __attribute__((aligned(8))) v4u_a8;
constexpr float PU_SCALE6 = 90.0f, PV_SCALE6 = 5.65f;
__device__ __forceinline__ unsigned enc_e2m3(float v) {
    const float a = fminf(fabsf(v), 7.5f);
    unsigned code;
    if (a < 1.0f) code = (unsigned)__builtin_rintf(a * 8.f);
    else { const unsigned b = __builtin_bit_cast(unsigned, a) - 0x3F800000u; code = ((b + 0x7FFFFu + ((b >> 20) & 1u)) >> 20) + 8u; }
    return code | (v < 0.f ? 32u : 0u);
}
__device__ __forceinline__ void convert_fp6_rows(const float* src, unsigned char* dst, int nrows, float scale, const float* gain, int gw, int NGW, int lane) {
    for (int r = gw; r < nrows; r += NGW) {
        const float* sp = src + (size_t)r * DM + 4 * lane; const float* gp = gain ? gain + (size_t)(r / PEER_N) * DM + 4 * lane : nullptr;
        unsigned w[6] = {0u, 0u, 0u, 0u, 0u, 0u};
#pragma unroll
        for (int j = 0; j < 8; ++j) { f32x4 a = *(const GAS f32x4*)(sp + 256 * j) * scale; if (gp) a = a * *(const GAS f32x4*)(gp + 256 * j);
#pragma unroll
            for (int e = 0; e < 4; ++e) { const unsigned code = enc_e2m3(a[e]); const int bp = 6 * (4 * j + e), wi = bp >> 5, sh = bp & 31;
                w[wi] |= code << sh; if (sh > 26) w[wi + 1] |= code >> (32 - sh); } }
        unsigned char* dp = dst + (size_t)r * 1536 + 24 * lane;
        *(GAS v4u_a8*)dp = (v4u){w[0], w[1], w[2], w[3]}; *(GAS v2u*)(dp + 16) = (v2u){w[4], w[5]};
    }
}
constexpr float PV_SCALE4 = 5.65f, PU_SCALE4 = 90.0f;
__device__ __forceinline__ unsigned enc_e2m1(float v) {
    const float a = fabsf(v);
    const unsigned code = a < 0.25f ? 0u : a < 0.75f ? 1u : a < 1.25f ? 2u : a < 1.75f ? 3u : a < 2.5f ? 4u : a < 3.5f ? 5u : a < 5.0f ? 6u : 7u;
    return code | (v < 0.f ? 8u : 0u);
}
__device__ __forceinline__ void convert_fp4_rows(const float* src, unsigned char* dst, int nrows, float scale, const float* gain, int gw, int NGW, int lane) {
    for (int r0 = 2 * gw; r0 < nrows; r0 += 2 * NGW) {
        f32x4 a[2][8];
#pragma unroll
        for (int q = 0; q < 2; ++q) { const float* sp = src + (size_t)(r0 + q) * DM + 4 * lane;
#pragma unroll
            for (int j = 0; j < 8; ++j) a[q][j] = *(const GAS f32x4*)(sp + 256 * j); }
#pragma unroll
        for (int q = 0; q < 2; ++q) { const int r = r0 + q; const float* gp = gain ? gain + (size_t)(r / PEER_N) * DM + 4 * lane : nullptr;
            unsigned w[4] = {0u, 0u, 0u, 0u};
#pragma unroll
            for (int j = 0; j < 8; ++j) { f32x4 v = a[q][j] * scale; if (gp) v = v * *(const GAS f32x4*)(gp + 256 * j);
#pragma unroll
                for (int e = 0; e < 4; ++e) { const int i = 4 * j + e; w[i >> 3] |= enc_e2m1(v[e]) << (4 * (i & 7)); } }
            *(GAS v4u*)(dst + (size_t)r * 1024 + 16 * lane) = (v4u){w[0], w[1], w[2], w[3]}; }
    }
}
#define PG4_LOAD(buf, tab, idlo, idhi, g) do { _Pragma("unroll") for (int i_ = 0; i_ < PG6_R; ++i_) { const int k_ = (g) * PG6_R + i_; \
        const int e_ = __builtin_amdgcn_readlane(k_ < 64 ? idlo : idhi, k_ & 63); buf[i_] = __builtin_amdgcn_raw_buffer_load_b128(tab, (int)voff4, e_ * 1024, 0); } } while (0)
#define PG4_DOT1(buf, i_, dst) do { f32x2 a_ = {0.f, 0.f}; _Pragma("unroll") for (int c_ = 0; c_ < 4; ++c_) { const unsigned u_ = buf[i_][c_]; \
        a_ += __builtin_amdgcn_cvt_scalef32_pk_f32_fp4(u_, 1.0f, 0) * x[4 * c_ + 0]; a_ += __builtin_amdgcn_cvt_scalef32_pk_f32_fp4(u_, 1.0f, 1) * x[4 * c_ + 1]; \
        a_ += __builtin_amdgcn_cvt_scalef32_pk_f32_fp4(u_, 1.0f, 2) * x[4 * c_ + 2]; a_ += __builtin_amdgcn_cvt_scalef32_pk_f32_fp4(u_, 1.0f, 3) * x[4 * c_ + 3]; } dst = a_.x + a_.y; __builtin_amdgcn_sched_barrier(0); } while (0)
#define PG4_DOT(buf, g) do { float p_[8]; _Pragma("unroll") for (int i_ = 0; i_ < 8; ++i_) PG4_DOT1(buf, i_, p_[i_]); \
        float q_[4]; _Pragma("unroll") for (int i_ = 0; i_ < 4; ++i_) { const float keep_ = b5 ? p_[i_ + 4] : p_[i_], send_ = b5 ? p_[i_] : p_[i_ + 4]; q_[i_] = keep_ + shx(send_, 32, lane); } \
        float r_[2]; _Pragma("unroll") for (int i_ = 0; i_ < 2; ++i_) { const float keep_ = b4 ? q_[i_ + 2] : q_[i_], send_ = b4 ? q_[i_] : q_[i_ + 2]; r_[i_] = keep_ + shx(send_, 16, lane); } \
        float s_; { const float keep_ = b3 ? r_[1] : r_[0], send_ = b3 ? r_[0] : r_[1]; s_ = keep_ + shx(send_, 8, lane); } \
        s_ += shx(s_, 4, lane); s_ += shx(s_, 2, lane); s_ += shx(s_, 1, lane); \
        if ((lane & 7) == 0) wl[(g) * 8 + (lane >> 3)] = s_; } while (0)
#define PG4_AXPY(buf, g) do { _Pragma("unroll") for (int i_ = 0; i_ < PG6_R; ++i_) { const float w_ = wl[(g) * PG6_R + i_]; const f32x2 wv_ = {w_, w_}; \
        _Pragma("unroll") for (int c_ = 0; c_ < 4; ++c_) { const unsigned u_ = buf[i_][c_]; \
            y[4 * c_ + 0] += __builtin_amdgcn_cvt_scalef32_pk_f32_fp4(u_, 1.0f, 0) * wv_; y[4 * c_ + 1] += __builtin_amdgcn_cvt_scalef32_pk_f32_fp4(u_, 1.0f, 1) * wv_; \
            y[4 * c_ + 2] += __builtin_amdgcn_cvt_scalef32_pk_f32_fp4(u_, 1.0f, 2) * wv_; y[4 * c_ + 3] += __builtin_amdgcn_cvt_scalef32_pk_f32_fp4(u_, 1.0f, 3) * wv_; } \
        __builtin_amdgcn_sched_barrier(0); } } while (0)
#ifndef PG6_R
#define PG6_R 8
#endif
#define PG6_LOAD(buf, tab, idlo, idhi, g) do { _Pragma("unroll") for (int i_ = 0; i_ < PG6_R; ++i_) { const int k_ = (g) * PG6_R + i_; \
        const int e_ = __builtin_amdgcn_readlane(k_ < 64 ? idlo : idhi, k_ & 63); const unsigned char* rp_ = (tab) + (size_t)(unsigned)e_ * 1536u; \
        const v4u a_ = *(const GAS v4u_a8*)(rp_ + voff); const v2u b_ = *(const GAS v2u*)(rp_ + voff + 16); buf[i_] = (v6u){a_.x, a_.y, a_.z, a_.w, b_.x, b_.y}; } } while (0)
#define PG6_DOT1(buf, i_, dst) do { const v32f f_ = __builtin_amdgcn_cvt_scalef32_pk32_f32_fp6(buf[i_], 1.0f); f32x2 a_ = {0.f, 0.f}; \
        _Pragma("unroll") for (int c_ = 0; c_ < 16; ++c_) a_ += (f32x2){f_[2 * c_], f_[2 * c_ + 1]} * x[c_]; dst = a_.x + a_.y; __builtin_amdgcn_sched_barrier(0); } while (0)
#if PG6_R == 8
#define PG6_DOT(buf, g) do { float p_[8]; _Pragma("unroll") for (int i_ = 0; i_ < 8; ++i_) PG6_DOT1(buf, i_, p_[i_]); \
        float q_[4]; _Pragma("unroll") for (int i_ = 0; i_ < 4; ++i_) { const float keep_ = b5 ? p_[i_ + 4] : p_[i_], send_ = b5 ? p_[i_] : p_[i_ + 4]; q_[i_] = keep_ + shx(send_, 32, lane); } \
        float r_[2]; _Pragma("unroll") for (int i_ = 0; i_ < 2; ++i_) { const float keep_ = b4 ? q_[i_ + 2] : q_[i_], send_ = b4 ? q_[i_] : q_[i_ + 2]; r_[i_] = keep_ + shx(send_, 16, lane); } \
        float s_; { const float keep_ = b3 ? r_[1] : r_[0], send_ = b3 ? r_[0] : r_[1]; s_ = keep_ + shx(send_, 8, lane); } \
        s_ += shx(s_, 4, lane); s_ += shx(s_, 2, lane); s_ += shx(s_, 1, lane); \
        if ((lane & 7) == 0) wl[(g) * 8 + (lane >> 3)] = s_; } while (0)
#else
#define PG6_DOT(buf, g) do { float p_[4]; _Pragma("unroll") for (int i_ = 0; i_ < 4; ++i_) PG6_DOT1(buf, i_, p_[i_]); \
        float r_[2]; _Pragma("unroll") for (int i_ = 0; i_ < 2; ++i_) { const float keep_ = b5 ? p_[i_ + 2] : p_[i_], send_ = b5 ? p_[i_] : p_[i_ + 2]; r_[i_] = keep_ + shx(send_, 32, lane); } \
        float s_; { const float keep_ = b4 ? r_[1] : r_[0], send_ = b4 ? r_[0] : r_[1]; s_ = keep_ + shx(send_, 16, lane); } \
        s_ += shx(s_, 8, lane); s_ += shx(s_, 4, lane); s_ += shx(s_, 2, lane); s_ += shx(s_, 1, lane); \
        if ((lane & 15) == 0) wl[(g) * 4 + (lane >> 4)] = s_; } while (0)
#endif
#define PG6_AXPY(buf, g) do { _Pragma("unroll") for (int i_ = 0; i_ < PG6_R; ++i_) { const float w_ = wl[(g) * PG6_R + i_]; const f32x2 wv_ = {w_, w_}; \
        const v32f f_ = __builtin_amdgcn_cvt_scalef32_pk32_f32_fp6(buf[i_], 1.0f); _Pragma("unroll") for (int c_ = 0; c_ < 16; ++c_) y[c_] += (f32x2){f_[2 * c_], f_[2 * c_ + 1]} * wv_; __builtin_amdgcn_sched_barrier(0); } } while (0)
__device__ __forceinline__ unsigned shxu(unsigned v, int k, int lane) { return (unsigned)__builtin_amdgcn_ds_bpermute((lane ^ k) << 2, (int)v); }
__device__ __forceinline__ void wave_sort128(unsigned& a, unsigned& b, int lane) {
#pragma unroll
    for (int k = 2; k <= 128; k <<= 1) {
#pragma unroll
        for (int j = k >> 1; j > 0; j >>= 1) {
            if (j == 64) { const unsigned lo = a < b ? a : b, hi = a < b ? b : a; a = lo; b = hi; }
            else {
                const unsigned pa = shxu(a, j, lane), pb = shxu(b, j, lane);
                const bool lower = (lane & j) == 0;
                const bool asc_a = (lane & k) == 0, asc_b = ((lane + 64) & k) == 0;
                const bool take_min_a = (lower == asc_a), take_min_b = (lower == asc_b);
                a = take_min_a ? (a < pa ? a : pa) : (a < pa ? pa : a);
                b = take_min_b ? (b < pb ? b : pb) : (b < pb ? pb : b);
            }
        }
    }
}
#ifndef PEER_U_FP4
#define PEER_U_FP4 1
#endif
#if PEER_U_FP4
typedef v4u urow_t;
#define PGU_LOAD PG4_LOAD
#define PGU_DOT PG4_DOT
constexpr float PU_SCALE = PU_SCALE4; constexpr int PU_STRIDE = 1024;
#else
typedef v6u urow_t;
#define PGU_LOAD PG6_LOAD
#define PGU_DOT PG6_DOT
constexpr float PU_SCALE = PU_SCALE6; constexpr int PU_STRIDE = 1536;
#endif
constexpr float PU_SCALEI = 135.0f, PX_SCALEI = 20.0f;
__device__ __forceinline__ void peer_v_pass(bf16* XN, const unsigned char* PV6, const int* PIDX, const float* PGATE, const int* PARTI, float* X, u64_t* rowsq_out, unsigned char* XN8, float* xsc, const u64_t* rowsq1, const u64_t* rowsq2, LAS float* wl, int gw, int NGW, int lane) {
    const unsigned voff4 = 16u * (unsigned)lane, l4 = 4u * (unsigned)lane, l8 = 8u * (unsigned)lane, l16 = 16u * (unsigned)lane;
    constexpr int NG = 128 / PG6_R;
    const __amdgpu_buffer_rsrc_t PVr = __builtin_amdgcn_make_buffer_rsrc((void*)PV6, 0, PEER_N * 1024, 0x00020000);
    for (int t_ = gw; t_ < T; t_ += NGW) {
        int t = t_; asm volatile("" : "+s"(t));
        const char* pidx_t = (const char*)(PIDX + (size_t)t * 128); const char* pgate_t = (const char*)(PGATE + (size_t)t * 128);
        const int idlo = *(const GAS int*)(pidx_t + l4), idhi = *(const GAS int*)(pidx_t + l4 + 256);
        v4u AV[PG6_R], BV[PG6_R];
        PG4_LOAD(AV, PVr, idlo, idhi, 0);
        {
            int s0 = 0, s1 = 0;
#pragma unroll
            for (int sp = 0; sp < 8; ++sp) { const char* pp = (const char*)(PARTI + ((size_t)sp * T + t) * 128); s0 += *(const GAS int*)(pp + l4); s1 += *(const GAS int*)(pp + l4 + 256); }
            const float sct = (8.0f / 127.0f / PU_SCALEI) * rowsq_rs(rowsq2, t) / rowsq_rs(rowsq1, t);
            const float d0 = (float)s0 * sct, d1 = (float)s1 * sct;
            const float g0 = *(const GAS float*)(pgate_t + l4), g1 = *(const GAS float*)(pgate_t + l4 + 256);
            const float w0 = g0 * 0.5f * d0 * (1.f + erff(d0 * 0.70710678118654752f)) * (1.f / PV_SCALE4), w1 = g1 * 0.5f * d1 * (1.f + erff(d1 * 0.70710678118654752f)) * (1.f / PV_SCALE4);
            wl[lane] = w0; wl[64 + lane] = w1;
            LDS_WAIT(); asm volatile("" ::: "memory");
        }
        f32x2 y[16];
#pragma unroll
        for (int i = 0; i < 16; ++i) y[i] = (f32x2){0.f, 0.f};
#pragma unroll 1
        for (int g = 0; g < NG; g += 2) {
            PG4_LOAD(BV, PVr, idlo, idhi, g + 1);
            PG4_AXPY(AV, g);
            if (g + 2 < NG) PG4_LOAD(AV, PVr, idlo, idhi, g + 2);
            PG4_AXPY(BV, g + 1);
        }
        {   char* xo = (char*)(X + (size_t)t * DM);
            char* xbo = (char*)(XN + (size_t)t * DM); float ss = 0.f;
#pragma unroll
            for (int j = 0; j < 8; ++j) { const v2u a = *(const GAS v2u*)(xbo + l8 + 512 * j); f32x4 v = (f32x4){bflo(a.x), bfhi(a.x), bflo(a.y), bfhi(a.y)}; v += (f32x4){y[2 * j].x, y[2 * j].y, y[2 * j + 1].x, y[2 * j + 1].y};
                if (X) *(GAS f32x4*)(xo + l16 + 1024 * j) = v;
                y[2 * j] = (f32x2){v[0], v[1]}; y[2 * j + 1] = (f32x2){v[2], v[3]};
                ss += (v[0] * v[0] + v[1] * v[1]) + (v[2] * v[2] + v[3] * v[3]); *(GAS v2u*)(xbo + l8 + 512 * j) = (v2u){pk2(v[0], v[1]), pk2(v[2], v[3])}; }
            if (rowsq_out) { ss = wave_sum(ss, lane); if (lane == 0) rowsq_out[t] = rowsq_fx(ss); }
            if (XN8) {
                float am = 0.f;
#pragma unroll
                for (int j = 0; j < 16; ++j) am = fmaxf(am, fmaxf(fabsf(y[j].x), fabsf(y[j].y)));
                am = fmaxf(wave_max(am, lane), 1e-30f);
                const float inv = 127.f / am; char* qo = (char*)(XN8 + (size_t)t * DM);
#pragma unroll
                for (int j = 0; j < 8; ++j) *(GAS unsigned*)(qo + l4 + 256 * j) = q8x4((f32x4){y[2 * j].x, y[2 * j].y, y[2 * j + 1].x, y[2 * j + 1].y}, inv);
                if (lane == 0) xsc[t] = am * (1.f / 127.f) / sqrtf(ss * (1.f / DM) + 1e-6f); } }
        LDS_WAIT(); asm volatile("" ::: "memory");
    }
}


__device__ __forceinline__ unsigned enc_i4(float v) { int q = (int)__builtin_rintf(v); q = q < -7 ? -7 : (q > 7 ? 7 : q); return (unsigned)q & 15u; }
__device__ __forceinline__ void convert_int4_plain(const float* src, unsigned char* dst, int nrows, float scale, const float* gain, int gw, int NGW, int lane) {
    for (int r0 = 2 * gw; r0 < nrows; r0 += 2 * NGW) {
        f32x4 a[2][8];
#pragma unroll
        for (int q = 0; q < 2; ++q) { const float* sp = src + (size_t)(r0 + q) * DM + 4 * lane;
#pragma unroll
            for (int j = 0; j < 8; ++j) a[q][j] = *(const GAS f32x4*)(sp + 256 * j); }
#pragma unroll
        for (int q = 0; q < 2; ++q) { const int r = r0 + q; const float* gp = gain ? gain + (size_t)(r / PEER_N) * DM + 4 * lane : nullptr;
#pragma unroll
            for (int j = 0; j < 8; ++j) { f32x4 v = a[q][j] * scale; if (gp) v = v * *(const GAS f32x4*)(gp + 256 * j);
                const unsigned w = enc_i4(v[0]) | (enc_i4(v[1]) << 4) | (enc_i4(v[2]) << 8) | (enc_i4(v[3]) << 12);
                *(GAS unsigned short*)(dst + (size_t)r * 1024 + 128 * j + 2 * lane) = (unsigned short)w; } }
    }
}
__device__ __forceinline__ void peer_xquant_unit(const bf16* XN, const u64_t* rowsq, unsigned* XQH, unsigned* XQL, int tb, int sl, int tid) {
    for (int it = tid; it < 256 * 32; it += NTHREADS) {
        const int t = tb * 256 + (it >> 5), c8 = it & 31;
        const float xs = PX_SCALEI * rowsq_rs(rowsq, t);
        const v4u w = *(const GAS v4u*)(XN + (size_t)t * DM + 256 * sl + 8 * c8);
        const float f[8] = {bflo(w.x), bfhi(w.x), bflo(w.y), bfhi(w.y), bflo(w.z), bfhi(w.z), bflo(w.w), bfhi(w.w)};
        unsigned hi = 0u, lo = 0u;
#pragma unroll
        for (int j = 0; j < 8; ++j) { int q = (int)__builtin_rintf(f[j] * xs); q = q < -119 ? -119 : (q > 119 ? 119 : q);
            const int xl = ((q + 8) & 15) - 8, xh = (q - xl) >> 4;
            hi |= ((unsigned)xh & 15u) << (4 * j); lo |= ((unsigned)xl & 15u) << (4 * j); }
        XQH[(size_t)t * 256 + 32 * sl + c8] = hi; XQL[(size_t)t * 256 + 32 * sl + c8] = lo;
    }
}
#define PI_LOADROWS(buf, tab, ids, i0) do { _Pragma("unroll") for (int i_ = 0; i_ < 8; ++i_) buf[i_] = __builtin_amdgcn_raw_buffer_load_b128(tab, ids[(i0) + i_] * 1024 + (int)soff, 0, 0); } while (0)
#define PI_LOADIDS(ids, t) do { const char* ip_ = (const char*)PIDX + ((size_t)(t) * 128 + 16 * g) * 4; _Pragma("unroll") for (int c_ = 0; c_ < 4; ++c_) { const v4u q_ = *(const GAS v4u*)(ip_ + 16 * c_); \
        ids[4 * c_] = (int)q_.x; ids[4 * c_ + 1] = (int)q_.y; ids[4 * c_ + 2] = (int)q_.z; ids[4 * c_ + 3] = (int)q_.w; } } while (0)
#define PI_UGROUP(buf, i0) do { _Pragma("unroll") for (int i_ = 0; i_ < 8; ++i_) { int ah_ = 0, al_ = 0; \
        _Pragma("unroll") for (int c_ = 0; c_ < 4; ++c_) { ah_ = __builtin_amdgcn_sdot8((int)buf[i_][c_], (int)xh[c_], ah_, false); al_ = __builtin_amdgcn_sdot8((int)buf[i_][c_], (int)xl[c_], al_, false); } \
        int p_ = 16 * ah_ + al_; p_ += __builtin_amdgcn_ds_bpermute((lane ^ 1) << 2, p_); p_ += __builtin_amdgcn_ds_bpermute((lane ^ 2) << 2, p_); p_ += __builtin_amdgcn_ds_bpermute((lane ^ 4) << 2, p_); \
        if (m == (((i0) + i_) >> 1)) { if (((i0) + i_) & 1) keep1 = p_; else keep0 = p_; } } } while (0)
#define PI_LOADROWS16(buf, tab, ids) do { _Pragma("unroll") for (int i_ = 0; i_ < 16; ++i_) buf[i_] = __builtin_amdgcn_raw_buffer_load_b128(tab, ids[i_] * 1024 + (int)soff, 0, 0); } while (0)
#define PI_LOADX(xh_, xl_, t) do { xh_ = *(const GAS v4u*)((const char*)XQH + (size_t)(t) * 1024 + soff); xl_ = *(const GAS v4u*)((const char*)XQL + (size_t)(t) * 1024 + soff); } while (0)
#define PI_COMPUTE16(buf, xh_, xl_, t) do { int keep0 = 0, keep1 = 0; \
        _Pragma("unroll") for (int i_ = 0; i_ < 16; ++i_) { int ah_ = 0, al_ = 0; \
            _Pragma("unroll") for (int c_ = 0; c_ < 4; ++c_) { ah_ = __builtin_amdgcn_sdot8((int)buf[i_][c_], (int)xh_[c_], ah_, false); al_ = __builtin_amdgcn_sdot8((int)buf[i_][c_], (int)xl_[c_], al_, false); } \
            int p_ = 16 * ah_ + al_; p_ += __builtin_amdgcn_update_dpp(0, p_, 0xB1, 0xf, 0xf, true); p_ += __builtin_amdgcn_update_dpp(0, p_, 0x4E, 0xf, 0xf, true); p_ += __builtin_amdgcn_update_dpp(0, p_, 0x141, 0xf, 0xf, true);   \
            if (m == (i_ >> 1)) { if (i_ & 1) keep1 = p_; else keep0 = p_; } } \
        if ((t) < T) *(GAS v2u*)(PARTI + ((size_t)s * T + (t)) * 128 + 2 * lane) = (v2u){(unsigned)keep0, (unsigned)keep1}; } while (0)
__device__ __forceinline__ void peer_u_phase_i4(const unsigned* XQH, const unsigned* XQL, const unsigned char* PU, const int* PIDX, int* PARTI, int bid, int G, int wave, int lane) {
    const int s = bid & 7, nr = (G - s + 7) >> 3, q = (bid >> 3) * NWAVES + wave, stride = nr * NWAVES, g = lane >> 3, m = lane & 7;
    const unsigned soff = 128u * (unsigned)s + 16u * (unsigned)m;
    if (q >= T) return;
    const __amdgpu_buffer_rsrc_t PUr = __builtin_amdgcn_make_buffer_rsrc((void*)PU, 0, PEER_N * 1024, 0x00020000);
#define PI_CL(t) ((t) < T ? (t) : T - 1)
    int I1[16], I2[16]; v4u xh0, xl0, xh1, xl1, xh2, xl2, RA[16], RB[16];
    PI_LOADIDS(I1, q); PI_LOADX(xh0, xl0, q);
    PI_LOADROWS16(RA, PUr, I1);
    PI_LOADIDS(I1, PI_CL(q + stride)); PI_LOADX(xh1, xl1, PI_CL(q + stride));
    for (int t = q; t < T; t += 2 * stride) {
        PI_LOADROWS16(RB, PUr, I1);
        PI_LOADIDS(I2, PI_CL(t + 2 * stride)); PI_LOADX(xh2, xl2, PI_CL(t + 2 * stride));
        PI_COMPUTE16(RA, xh0, xl0, t);
        PI_LOADROWS16(RA, PUr, I2);
        PI_LOADIDS(I1, PI_CL(t + 3 * stride)); PI_LOADX(xh0, xl0, PI_CL(t + 3 * stride));
        PI_COMPUTE16(RB, xh1, xl1, t + stride);
        xh1 = xh0; xl1 = xl0; xh0 = xh2; xl0 = xl2;
    }
#undef PI_CL
}


constexpr float PV_SCALE4S = 5.65f;
__device__ __forceinline__ unsigned enc_e2m1s(float v) {
    const float a = fabsf(v);
    const unsigned code = a < 0.25f ? 0u : a < 0.75f ? 1u : a < 1.25f ? 2u : a < 1.75f ? 3u : a < 2.5f ? 4u : a < 3.5f ? 5u : a < 5.0f ? 6u : 7u;
    return code | (v < 0.f ? 8u : 0u);
}
__device__ __forceinline__ void convert_fp4_plain(const float* src, unsigned char* dst, int nrows, float scale, const float* gain, int gw, int NGW, int lane) {
    for (int r0 = 2 * gw; r0 < nrows; r0 += 2 * NGW) {
        f32x4 a[2][8];
#pragma unroll
        for (int q = 0; q < 2; ++q) { const float* sp = src + (size_t)(r0 + q) * DM + 4 * lane;
#pragma unroll
            for (int j = 0; j < 8; ++j) a[q][j] = *(const GAS f32x4*)(sp + 256 * j); }
#pragma unroll
        for (int q = 0; q < 2; ++q) { const int r = r0 + q; const float* gp = gain ? gain + (size_t)(r / PEER_N) * DM + 4 * lane : nullptr;
#pragma unroll
            for (int j = 0; j < 8; ++j) { f32x4 v = a[q][j] * scale; if (gp) v = v * *(const GAS f32x4*)(gp + 256 * j);
                const unsigned w = enc_e2m1s(v[0]) | (enc_e2m1s(v[1]) << 4) | (enc_e2m1s(v[2]) << 8) | (enc_e2m1s(v[3]) << 12);
                *(GAS unsigned short*)(dst + (size_t)r * 1024 + 128 * j + 2 * lane) = (unsigned short)w; } }
    }
}
#define PVS_LOADMETA(ids, pp, gg, t) do { PI_LOADIDS(ids, t); _Pragma("unroll") for (int sp_ = 0; sp_ < 8; ++sp_) pp[sp_] = *(const GAS v2u*)(PARTI + ((size_t)sp_ * T + (t)) * 128 + 2 * lane); \
        gg = *(const GAS f32x2*)(PGATE + (size_t)(t) * 128 + 2 * lane); } while (0)
#define PVS_COMPUTE16(buf, pp, gg, t) do { float w0, w1; { int s0_ = 0, s1_ = 0; _Pragma("unroll") for (int sp_ = 0; sp_ < 8; ++sp_) { s0_ += (int)pp[sp_].x; s1_ += (int)pp[sp_].y; } \
            const float d0_ = (float)s0_ * (1.f / (PX_SCALEI * PU_SCALEI)), d1_ = (float)s1_ * (1.f / (PX_SCALEI * PU_SCALEI)); \
            w0 = gg.x * 0.5f * d0_ * (1.f + erff(d0_ * 0.70710678118654752f)) * (1.f / PV_SCALE4S); w1 = gg.y * 0.5f * d1_ * (1.f + erff(d1_ * 0.70710678118654752f)) * (1.f / PV_SCALE4S); } \
        f32x2 y[16]; _Pragma("unroll") for (int i_ = 0; i_ < 16; ++i_) y[i_] = (f32x2){0.f, 0.f}; \
        _Pragma("unroll") for (int i_ = 0; i_ < 16; ++i_) { \
            const float w_ = __builtin_bit_cast(float, __builtin_amdgcn_ds_bpermute(((lane & 56) | (i_ >> 1)) << 2, __builtin_bit_cast(int, (i_ & 1) ? w1 : w0))); const f32x2 wv_ = {w_, w_}; \
            _Pragma("unroll") for (int c_ = 0; c_ < 4; ++c_) { const unsigned u_ = buf[i_][c_]; \
                y[4 * c_ + 0] += __builtin_amdgcn_cvt_scalef32_pk_f32_fp4(u_, 1.0f, 0) * wv_; y[4 * c_ + 1] += __builtin_amdgcn_cvt_scalef32_pk_f32_fp4(u_, 1.0f, 1) * wv_; \
                y[4 * c_ + 2] += __builtin_amdgcn_cvt_scalef32_pk_f32_fp4(u_, 1.0f, 2) * wv_; y[4 * c_ + 3] += __builtin_amdgcn_cvt_scalef32_pk_f32_fp4(u_, 1.0f, 3) * wv_; } } \
        {   LAS float* wp_ = yl + g * 288 + m * 36; \
            _Pragma("unroll") for (int c_ = 0; c_ < 8; ++c_) *(LAS f32x4*)(wp_ + 4 * c_) = (f32x4){y[2 * c_].x, y[2 * c_].y, y[2 * c_ + 1].x, y[2 * c_ + 1].y}; \
            LDS_WAIT(); asm volatile("" ::: "memory"); \
            f32x4 acc_ = {0.f, 0.f, 0.f, 0.f}; const LAS float* rp_ = yl + (lane >> 3) * 36 + 4 * (lane & 7); \
            _Pragma("unroll") for (int gg_ = 0; gg_ < 8; ++gg_) acc_ += *(const LAS f32x4*)(rp_ + gg_ * 288); \
            LDS_WAIT(); asm volatile("" ::: "memory"); \
            if ((t) < T) { bf16* xp_ = XN + (size_t)(t) * DM + 256 * s + 4 * lane; const v2u a_ = *(const GAS v2u*)xp_; \
                const f32x4 v_ = (f32x4){bflo(a_.x), bfhi(a_.x), bflo(a_.y), bfhi(a_.y)} + acc_; \
                *(GAS v2u*)xp_ = (v2u){pk2(v_[0], v_[1]), pk2(v_[2], v_[3])}; \
                if (Xout) *(GAS f32x4*)(Xout + (size_t)(t) * DM + 256 * s + 4 * lane) = v_; \
                if (rowsq_out) { const float ss_ = wave_sum((v_[0] * v_[0] + v_[1] * v_[1]) + (v_[2] * v_[2] + v_[3] * v_[3]), lane); if (lane == 0) atomicAdd(rowsq_out + (t), rowsq_fx(ss_)); } } } } while (0)
__device__ __forceinline__ void peer_v_phase_s(bf16* XN, const unsigned char* PV, const int* PIDX, const float* PGATE, const int* PARTI, float* Xout, u64_t* rowsq_out, LAS float* yl, int bid, int G, int wave, int lane) {
    const int s = bid & 7, nr = (G - s + 7) >> 3, q = (bid >> 3) * NWAVES + wave, stride = nr * NWAVES, g = lane >> 3, m = lane & 7;
    const unsigned soff = 128u * (unsigned)s + 16u * (unsigned)m;
    if (q >= T) return;
    const __amdgpu_buffer_rsrc_t PVr = __builtin_amdgcn_make_buffer_rsrc((void*)PV, 0, PEER_N * 1024, 0x00020000);
#define PVS_CL(t) ((t) < T ? (t) : T - 1)
    int I0[16], I1[16]; v2u P0[8], P1[8]; f32x2 G0, G1; v4u RA[16], RB[16];
#define PVS_LOADPG(pp, gg, t) do { _Pragma("unroll") for (int sp_ = 0; sp_ < 8; ++sp_) pp[sp_] = *(const GAS v2u*)(PARTI + ((size_t)sp_ * T + (t)) * 128 + 2 * lane); gg = *(const GAS f32x2*)(PGATE + (size_t)(t) * 128 + 2 * lane); } while (0)
    PI_LOADIDS(I0, q); PVS_LOADPG(P0, G0, q);
    PI_LOADROWS16(RA, PVr, I0);
    PI_LOADIDS(I1, PVS_CL(q + stride)); PVS_LOADPG(P1, G1, PVS_CL(q + stride));
    for (int t = q; t < T; t += 2 * stride) {
        PI_LOADROWS16(RB, PVr, I1);
        PI_LOADIDS(I0, PVS_CL(t + 2 * stride));
        PVS_COMPUTE16(RA, P0, G0, t);
        PVS_LOADPG(P0, G0, PVS_CL(t + 2 * stride));
        PI_LOADROWS16(RA, PVr, I0);
        PI_LOADIDS(I1, PVS_CL(t + 3 * stride));
        PVS_COMPUTE16(RB, P1, G1, t + stride);
        PVS_LOADPG(P1, G1, PVS_CL(t + 3 * stride));
    }
#undef PVS_LOADPG
#undef PVS_CL
}

typedef short s16x4 __attribute__((ext_vector_type(4)));
typedef __attribute__((address_space(3))) const char* lds_cptr;
__device__ __forceinline__ s16x4 vtr(lds_cptr p) { return __builtin_bit_cast(s16x4, __builtin_amdgcn_ds_read_tr16_b64_v4i16((__attribute__((address_space(3))) s16x4*)p)); }
__device__ __forceinline__ unsigned cvtpk(float lo, float hi) { unsigned r; asm("v_cvt_pk_bf16_f32 %0, %1, %2" : "=v"(r) : "v"(lo), "v"(hi)); return r; }
constexpr int AS_STAGE = 65536, AS_V = 32768, AT_TAB = LDSCTL_OFF + 2048;
constexpr float LOG2E = 1.4426950408889634f;
__device__ __forceinline__ void at_dma16(const char* sbase, unsigned voff, unsigned ldsaddr) {
    asm volatile("s_mov_b32 m0, %2\n\ts_nop 0\n\tglobal_load_lds_dwordx4 %0, %1" :: "v"(voff), "s"(sbase), "s"(ldsaddr) : "memory");
}
template <int TYPE>
__device__ __forceinline__ void attn_unit(LAS unsigned char* lds, const bf16* QKV, bf16* ATT, u64_t* mixsq, int b, int head, int qb, const float* tabsrc, float Cl2, float sinkl2, int tid) {
    const int lane = tid & 63, w = __builtin_amdgcn_readfirstlane(tid >> 6), hh = lane >> 5, l31 = lane & 31;
    int qcol, kcol, vcol, ocol;
    if (TYPE == 0) { qcol = QA + head * 64; kcol = KA + (head / 3) * 64; vcol = VA + (head / 3) * 64; ocol = OA + head * 64; }
    else if (TYPE == 1) { qcol = QB + head * 64; kcol = KB + head * 64; vcol = VB + head * 64; ocol = OB + head * 64; }
    else { qcol = QC + head * 64; kcol = KC + (head / 3) * 64; vcol = VC + (head / 3) * 64; ocol = OC + head * 64; }
    const int q0 = 256 * qb + 32 * w, qpos = q0 + l31;
    int t_begin, t_end;
    if (TYPE == 0) { t_begin = 4 * qb - 2; if (t_begin < 0) t_begin = 0; t_end = 4 * qb + 6; if (t_end > 32) t_end = 32; }
    else if (TYPE == 1) { int a = 4 * qb - 4; a = a < 0 ? 0 : (a > 24 ? 24 : a); int e = 4 * qb - 1; e = e < 0 ? 0 : (e > 24 ? 24 : e); t_begin = a; t_end = e + 8; }
    else { t_begin = 0; t_end = 32; }
    LAS float* tab = (LAS float*)(lds + AT_TAB);
    if (TYPE == 0) { for (int i = tid; i < 1024; i += NTHREADS) { const int rel = i - 448; tab[i] = (rel >= -128 && rel <= 128) ? tabsrc[head * 257 + rel + 128] * LOG2E - Cl2 : -1e30f; } }
    if (TYPE == 1) { for (int i = tid; i < 15 * 31; i += NTHREADS) tab[i] = tabsrc[head * 465 + i] * LOG2E - Cl2; }
    bf16x8 qf[4];
    {   const bf16* qp = QKV + ((size_t)b * SEQ + qpos) * DIN + qcol + 8 * hh;
#pragma unroll
        for (int s = 0; s < 4; ++s) qf[s] = *(const GAS bf16x8*)(qp + 16 * s); }
    const int drow = 8 * w + (lane >> 3), dsl = lane & 7;
    const unsigned koff = (unsigned)((drow * DIN + kcol + ((dsl ^ ((drow >> 1) & 7)) * 8)) * 2);
    const unsigned voff = (unsigned)((drow * DIN + vcol + (((((dsl >> 2) ^ ((drow >> 1) & 1)) << 2) | (dsl & 3)) * 8)) * 2);
    const char* gbp = (const char*)(QKV + (size_t)b * SEQ * DIN);
    const unsigned ldsb = (unsigned)(size_t)lds + (unsigned)w * 1024u;
#define AT_STAGE(sbuf, t0_) do { _Pragma("unroll") for (int i_ = 0; i_ < 4; ++i_) { const int tl_ = (t0_) + i_; if (tl_ < t_end) { \
        at_dma16(gbp + (size_t)tl_ * (64 * DIN * 2), koff, ldsb + (sbuf) * AS_STAGE + i_ * 8192); at_dma16(gbp + (size_t)tl_ * (64 * DIN * 2), voff, ldsb + (sbuf) * AS_STAGE + AS_V + i_ * 8192); } } } while (0)
    int kread[4], vread[2];
#pragma unroll
    for (int s = 0; s < 4; ++s) kread[s] = l31 * 128 + (((2 * s + hh) ^ ((lane >> 1) & 7)) * 16);
#pragma unroll
    for (int db = 0; db < 2; ++db) vread[db] = (4 * hh + ((lane >> 2) & 3)) * 128 + ((db ^ ((lane >> 3) & 1)) * 64) + 32 * ((lane >> 4) & 1) + 8 * (lane & 3);
    f32x16 O0, O1;
#pragma unroll
    for (int r = 0; r < 16; ++r) { O0[r] = 0.f; O1[r] = 0.f; }
    float lsum = 0.f;
    const int rw = 4 * qb + (w >> 1), cq = 32 * (w & 1) + l31;
    int r0w = rw - 4; r0w = r0w < 0 ? 0 : (r0w > 24 ? 24 : r0w);
    int c0 = cq - 8; c0 = c0 < 0 ? 0 : (c0 > 48 ? 48 : c0);
    const int nst = (t_end - t_begin + 3) >> 2;
#pragma unroll
    for (int s = 0; s < 4; ++s) asm volatile("" : "+v"(qf[s]));
    AT_STAGE(0, t_begin);
    VM_WAIT(); __syncthreads();
#pragma unroll 1
    for (int st = 0; st < nst; ++st) {
        const int t0 = t_begin + 4 * st;
        if (st + 1 < nst) AT_STAGE((st + 1) & 1, t0 + 4);
#pragma unroll 1
      for (int ti = 0; ti < 4; ++ti) {
        const int t = t0 + ti; if (t >= t_end) break;
        bool need = true;
        if (TYPE == 0) need = (64 * t <= q0 + 31 + 128) && (64 * t + 63 >= q0 - 128);
        if (TYPE == 1) need = (t >= r0w) && (t < r0w + 8);
        if (need) {
            const lds_cptr kb_ = (lds_cptr)(lds + (st & 1) * AS_STAGE + ti * 8192), vb_ = (lds_cptr)(lds + (st & 1) * AS_STAGE + AS_V + ti * 8192);
            bf16x8 kf[8];
#pragma unroll
            for (int s = 0; s < 4; ++s) { kf[2 * s] = *(const LAS bf16x8*)(kb_ + kread[s]); kf[2 * s + 1] = *(const LAS bf16x8*)(kb_ + kread[s] + 4096); }
            f32x16 S0, S1;
            if (TYPE == 2) {
#pragma unroll
                for (int r = 0; r < 16; ++r) { S0[r] = -Cl2; S1[r] = -Cl2; }
            } else if (TYPE == 0) {
                const LAS float* tb = tab + (64 * t - qpos + 448 + 4 * hh);
#pragma unroll
                for (int r = 0; r < 16; ++r) { S0[r] = tb[8 * (r >> 2) + (r & 3)]; S1[r] = tb[32 + 8 * (r >> 2) + (r & 3)]; }
            } else {
                const LAS float* tb = tab + ((t - rw + 7) * 31 - cq + 15 + 4 * hh);
                const int kc0 = 4 * hh - c0;
#pragma unroll
                for (int r = 0; r < 16; ++r) { const int ka = 8 * (r >> 2) + (r & 3), kb2 = 32 + ka;
                    S0[r] = ((unsigned)(ka + kc0) < 16u) ? tb[ka] : -1e30f; S1[r] = ((unsigned)(kb2 + kc0) < 16u) ? tb[kb2] : -1e30f; }
            }
            __builtin_amdgcn_sched_barrier(0);
#define AT_SB __builtin_amdgcn_sched_barrier(0)
#define AT_SOFT(SX, base, dst) do { _Pragma("unroll") for (int r = (base); r < (base) + 8; ++r) SX[r] = __builtin_amdgcn_exp2f(SX[r]); \
            lsum += ((SX[(base)] + SX[(base) + 1]) + (SX[(base) + 2] + SX[(base) + 3])) + ((SX[(base) + 4] + SX[(base) + 5]) + (SX[(base) + 6] + SX[(base) + 7])); \
            v4u a_; _Pragma("unroll") for (int j = 0; j < 4; ++j) a_[j] = cvtpk(SX[(base) + 2 * j], SX[(base) + 2 * j + 1]); dst = __builtin_bit_cast(bf16x8, a_); } while (0)
#pragma unroll
            for (int s = 0; s < 4; ++s) S0 = __builtin_amdgcn_mfma_f32_32x32x16_bf16(kf[2 * s], qf[s], S0, 0, 0, 0);
            s16x4 vf[4][2][2];
#pragma unroll
            for (int ks = 0; ks < 2; ++ks)
#pragma unroll
                for (int db = 0; db < 2; ++db) { vf[ks][db][0] = vtr(vb_ + vread[db] + (16 * ks) * 128); vf[ks][db][1] = vtr(vb_ + vread[db] + (16 * ks + 8) * 128); }
            S1 = __builtin_amdgcn_mfma_f32_32x32x16_bf16(kf[1], qf[0], S1, 0, 0, 0); S1 = __builtin_amdgcn_mfma_f32_32x32x16_bf16(kf[3], qf[1], S1, 0, 0, 0);
            AT_SB;
            bf16x8 pb[4];
            AT_SOFT(S0, 0, pb[0]);
            AT_SB;
            S1 = __builtin_amdgcn_mfma_f32_32x32x16_bf16(kf[5], qf[2], S1, 0, 0, 0);
            AT_SB;
            AT_SOFT(S0, 8, pb[1]);
            AT_SB;
            S1 = __builtin_amdgcn_mfma_f32_32x32x16_bf16(kf[7], qf[3], S1, 0, 0, 0);
            asm volatile("s_waitcnt lgkmcnt(7)" ::: "memory");
#pragma unroll
            for (int ks = 2; ks < 4; ++ks)
#pragma unroll
                for (int db = 0; db < 2; ++db) { vf[ks][db][0] = vtr(vb_ + vread[db] + (16 * ks) * 128); vf[ks][db][1] = vtr(vb_ + vread[db] + (16 * ks + 8) * 128); }
            AT_SB;
#define AT_PV(ks) do { const bf16x8 va = __builtin_shufflevector(vf[ks][0][0], vf[ks][0][1], 0, 1, 2, 3, 4, 5, 6, 7), vb2 = __builtin_shufflevector(vf[ks][1][0], vf[ks][1][1], 0, 1, 2, 3, 4, 5, 6, 7); \
            O0 = __builtin_amdgcn_mfma_f32_32x32x16_bf16(va, pb[ks], O0, 0, 0, 0); O1 = __builtin_amdgcn_mfma_f32_32x32x16_bf16(vb2, pb[ks], O1, 0, 0, 0); } while (0)
            AT_PV(0);
            AT_SB;
            AT_SOFT(S1, 0, pb[2]);
            AT_SB;
            AT_PV(1);
            AT_SB;
            AT_SOFT(S1, 8, pb[3]);
            AT_SB;
            AT_PV(2); AT_PV(3);
#undef AT_PV
#undef AT_SOFT
#undef AT_SB
        }
      }
        VM_WAIT(); __syncthreads();
    }
    lsum += shx(lsum, 32, lane);
    if (TYPE == 0) lsum += __builtin_amdgcn_exp2f(sinkl2 - Cl2);
    const float inv = 1.f / lsum;
    {   float ss = 0.f;
#pragma unroll
        for (int r = 0; r < 16; ++r) { const float a = O0[r] * inv, c = O1[r] * inv; ss += a * a + c * c; }
        ss += shx(ss, 32, lane);
        if (hh == 0) (void)__hip_atomic_fetch_add((GAS u64_t*)(mixsq + (size_t)b * SEQ + qpos), rowsq_fx(ss), __ATOMIC_RELAXED, __HIP_MEMORY_SCOPE_AGENT); }
    bf16* op = ATT + ((size_t)b * SEQ + qpos) * DM + ocol + 4 * hh;
#pragma unroll
    for (int g4 = 0; g4 < 4; ++g4) {
        v2u o0, o1; o0.x = cvtpk(O0[4 * g4] * inv, O0[4 * g4 + 1] * inv); o0.y = cvtpk(O0[4 * g4 + 2] * inv, O0[4 * g4 + 3] * inv);
        o1.x = cvtpk(O1[4 * g4] * inv, O1[4 * g4 + 1] * inv); o1.y = cvtpk(O1[4 * g4 + 2] * inv, O1[4 * g4 + 3] * inv);
        *(GAS v2u*)(op + 8 * g4) = o0; *(GAS v2u*)(op + 32 + 8 * g4) = o1;
    }
}


constexpr int MA_K0 = 0, MA_V0 = 32768;
template <int MODE = 0>
__device__ __forceinline__ void mem_unit(LAS unsigned char* lds, const bf16* QM, const bf16* KVM, bf16* OM, const float* gq, int tb, int head, float Cl2, int tid) {
    const int lane = tid & 63, w = __builtin_amdgcn_readfirstlane(tid >> 6), hh = lane >> 5, l31 = lane & 31;
    const size_t trow = (size_t)tb * 256 + 32 * w + l31; const int b = tb >> 3;
    __syncthreads();
    bf16x8 qf[8];
    {   const bf16* qp = QM + trow * MEMW + head * 128 + 8 * hh;
#pragma unroll
        for (int s = 0; s < 8; ++s) qf[s] = *(const GAS bf16x8*)(qp + 16 * s);
        float ss = 0.f;
#pragma unroll
        for (int s = 0; s < 8; ++s)
#pragma unroll
            for (int j = 0; j < 8; ++j) { const float f = __builtin_bit_cast(float, (unsigned)(unsigned short)qf[s][j] << 16); ss += f * f; }
        ss += shx(ss, 32, lane);
        const float r = 0.12751743074602468f / sqrtf(ss * (1.f / 128.f) + EPS);
#pragma unroll
        for (int s = 0; s < 8; ++s) { const f32x4 g0 = *(const GAS f32x4*)(gq + 16 * s + 8 * hh), g1 = *(const GAS f32x4*)(gq + 16 * s + 8 * hh + 4);
            v4u o;
#pragma unroll
            for (int j = 0; j < 4; ++j) { const float f0 = __builtin_bit_cast(float, (unsigned)(unsigned short)qf[s][2 * j] << 16), f1 = __builtin_bit_cast(float, (unsigned)(unsigned short)qf[s][2 * j + 1] << 16);
                const float ga = (2 * j < 4) ? g0[2 * j] : g1[2 * j - 4], gb2 = (2 * j + 1 < 4) ? g0[2 * j + 1] : g1[2 * j + 1 - 4];
                o[j] = cvtpk(f0 * r * ga, f1 * r * gb2); }
            qf[s] = __builtin_bit_cast(bf16x8, o); }
    }
    int kread[8], vread[4];
#pragma unroll
    for (int s = 0; s < 8; ++s) kread[s] = l31 * 256 + (((2 * s + hh) ^ (l31 & 15)) * 16);
#pragma unroll
    for (int db = 0; db < 4; ++db) vread[db] = 65536 + (4 * hh + ((lane >> 2) & 3)) * 256 + ((db ^ ((lane >> 2) & 3)) * 64) + 32 * ((lane >> 4) & 1) + 8 * (lane & 3);
    f32x16 O[4];
#pragma unroll
    for (int db = 0; db < 4; ++db)
#pragma unroll
        for (int r = 0; r < 16; ++r) O[db][r] = 0.f;
    float lsum = 0.f;
    if (MODE != 1) {   const bf16* src = KVM + (size_t)b * NMEM * 1024 + head * 128;
#pragma unroll 1
        for (int half = 0; half < 2; ++half) {
            v4u st[8];
#pragma unroll
            for (int i = 0; i < 8; ++i) { const int c = tid + 512 * i, row = c >> 4, ch = c & 15; st[i] = *(const GAS v4u*)(src + (size_t)row * 1024 + 512 * half + ch * 8); }
#pragma unroll
            for (int i = 0; i < 8; ++i) { const int c = tid + 512 * i, row = c >> 4, ch = c & 15;
                const int off = half == 0 ? row * 256 + ((ch ^ (row & 15)) * 16) : 65536 + row * 256 + (((ch >> 2) ^ (row & 3)) * 64) + (ch & 3) * 16;
                *(LAS v4u*)(lds + off) = st[i]; }
        }
    }
    __syncthreads();
#define MA_SB __builtin_amdgcn_sched_barrier(0)
#define MA_LW(n) asm volatile("s_waitcnt lgkmcnt(" #n ")" ::: "memory")
#pragma unroll 1
    for (int t = 0; t < (MODE ? 0 : 4); ++t) {
        const lds_cptr kb_ = (lds_cptr)(lds + t * 16384), vb_ = (lds_cptr)(lds + t * 16384);
        f32x16 S0, S1;
#pragma unroll
        for (int r = 0; r < 16; ++r) { S0[r] = -Cl2; S1[r] = -Cl2; }
        bf16x8 a0[8], a1[4];
#pragma unroll
        for (int s = 0; s < 8; ++s) a0[s] = *(const LAS bf16x8*)(kb_ + kread[s]);
        MA_SB;
#pragma unroll
        for (int s = 0; s < 4; ++s) S0 = __builtin_amdgcn_mfma_f32_32x32x16_bf16(a0[s], qf[s], S0, 0, 0, 0);
        MA_SB;
#pragma unroll
        for (int s = 0; s < 4; ++s) a1[s] = *(const LAS bf16x8*)(kb_ + kread[s] + 8192);
        MA_SB;
#pragma unroll
        for (int s = 4; s < 8; ++s) S0 = __builtin_amdgcn_mfma_f32_32x32x16_bf16(a0[s], qf[s], S0, 0, 0, 0);
        MA_SB;
#pragma unroll
        for (int s = 0; s < 4; ++s) a0[s] = *(const LAS bf16x8*)(kb_ + kread[4 + s] + 8192);
        MA_SB;
#pragma unroll
        for (int s = 0; s < 4; ++s) S1 = __builtin_amdgcn_mfma_f32_32x32x16_bf16(a1[s], qf[s], S1, 0, 0, 0);
#pragma unroll
        for (int s = 0; s < 4; ++s) S1 = __builtin_amdgcn_mfma_f32_32x32x16_bf16(a0[s], qf[4 + s], S1, 0, 0, 0);
        MA_SB;
        s16x4 vf[2][4][2];
#define MA_VRD(ks) do { _Pragma("unroll") for (int db = 0; db < 4; ++db) { vf[(ks) & 1][db][0] = vtr(vb_ + vread[db] + (16 * (ks)) * 256); vf[(ks) & 1][db][1] = vtr(vb_ + vread[db] + (16 * (ks) + 8) * 256); } } while (0)
#define MA_PV(ks) do { _Pragma("unroll") for (int db = 0; db < 4; ++db) { const bf16x8 va = __builtin_shufflevector(vf[(ks) & 1][db][0], vf[(ks) & 1][db][1], 0, 1, 2, 3, 4, 5, 6, 7); \
            O[db] = __builtin_amdgcn_mfma_f32_32x32x16_bf16(va, pb[ks], O[db], 0, 0, 0); } } while (0)
        MA_VRD(0);
        MA_SB;
#pragma unroll
        for (int r = 0; r < 16; ++r) { S0[r] = __builtin_amdgcn_exp2f(S0[r]); S1[r] = __builtin_amdgcn_exp2f(S1[r]); lsum += S0[r] + S1[r]; }
        bf16x8 pb[4];
#pragma unroll
        for (int hf = 0; hf < 2; ++hf) {
            v4u a, c;
#pragma unroll
            for (int j = 0; j < 4; ++j) { a[j] = cvtpk(S0[8 * hf + 2 * j], S0[8 * hf + 2 * j + 1]); c[j] = cvtpk(S1[8 * hf + 2 * j], S1[8 * hf + 2 * j + 1]); }
            pb[hf] = __builtin_bit_cast(bf16x8, a); pb[2 + hf] = __builtin_bit_cast(bf16x8, c);
        }
        MA_SB;
        MA_LW(7); MA_VRD(1); MA_SB; MA_PV(0); MA_SB;
        MA_LW(7); MA_VRD(2); MA_SB; MA_PV(1); MA_SB;
        MA_LW(7); MA_VRD(3); MA_SB; MA_PV(2); MA_SB;
        MA_PV(3);
        MA_SB;
    }
#undef MA_VRD
#undef MA_PV
#undef MA_SB
#undef MA_LW
    lsum += shx(lsum, 32, lane);
    const float inv = MODE ? 1.f : 1.f / lsum;
    bf16* op = OM + trow * MEMW + head * 128 + 4 * hh;
#pragma unroll
    for (int db = 0; db < 4; ++db)
#pragma unroll
        for (int g4 = 0; g4 < 4; ++g4) { v2u o; o.x = cvtpk(O[db][4 * g4] * inv, O[db][4 * g4 + 1] * inv); o.y = cvtpk(O[db][4 * g4 + 2] * inv, O[db][4 * g4 + 3] * inv); *(GAS v2u*)(op + 32 * db + 8 * g4) = o; }
}

struct Args { const float* in[23]; float* out; unsigned char* ws; int ph_lo, ph_hi, use_bar, pad; };
#ifndef MK_OFF
#define MK_OFF 0u
#endif
#ifndef REP_ATT
#define REP_ATT 1
#endif
#ifndef REP_P0
#define REP_P0 1
#endif
#ifndef REP_U
#define REP_U 1
#endif
#ifndef REP_GEMM
#define REP_GEMM 1
#endif
#ifndef REP_NORM
#define REP_NORM 1
#endif
#ifndef REP_SEL
#define REP_SEL 1
#endif
#ifndef REP_MEM
#define REP_MEM 1
#endif
#define PHON(k) (!((MK_OFF >> (k)) & 1u))
#ifndef MK_REP
#define MK_REP 0
#endif
constexpr int PH_PER_LAYER = 9, PH_BASE = 2, N_PHASES = PH_BASE + DEPTH * PH_PER_LAYER;
constexpr int PTAB_OFF = LDSCTL_OFF + 1024;

__global__ void __launch_bounds__(NTHREADS, 2) mega(Args a) {
    extern __shared__ __attribute__((aligned(16))) unsigned char lds_raw[];
    LAS unsigned char* lds = (LAS unsigned char*)lds_raw;
    const int wave0_ = __builtin_amdgcn_readfirstlane((int)threadIdx.x >> 6);
    {   const int tid0 = threadIdx.x;
        for (int u = tid0; u < (LDS_BYTES - LDSCTL_OFF) / 4; u += NTHREADS) ((LAS unsigned*)(lds + LDSCTL_OFF))[u] = 0u;
        __syncthreads();
        if (tid0 < 23) ((LAS unsigned long long*)(lds + PTAB_OFF))[tid0] = (unsigned long long)a.in[tid0];
        if (tid0 == 23) ((LAS unsigned long long*)(lds + PTAB_OFF))[23] = (unsigned long long)a.out;
        if (tid0 == 24) ((LAS unsigned long long*)(lds + PTAB_OFF))[24] = (unsigned long long)a.ws;
        __syncthreads();
    }
    volatile LAS unsigned* MISC = (volatile LAS unsigned*)(lds + MISC_OFF);
    const int G = gridDim.x, bid = blockIdx.x, NGW = G * NWAVES;
    const int use_bar = a.use_bar;
    XcdBarrier bar; bar.bar = (unsigned*)(a.ws + WS_CTL) + CW_BAR; bar.x = 0; bar.st = MISC + 8;
    if (use_bar) bar = xcd_barrier_post((unsigned*)(a.ws + WS_CTL) + CW_BAR, MISC + 8);
    const int lo = a.ph_lo, hi = a.ph_hi;
#define IN(k) (lo <= (k) && (k) < hi)
#define SEAM(k) do { if (use_bar && IN(k) && IN((k) + 1)) xcd_barrier(bar); } while (0)
#define PHL() int tid_ = wave0_ * 64 + (int)__builtin_amdgcn_mbcnt_hi(~0u, __builtin_amdgcn_mbcnt_lo(~0u, 0u)); asm volatile("" : "+v"(tid_)); const int lane_ = tid_ & 63, wave_ = __builtin_amdgcn_readfirstlane(tid_ >> 6), gw_ = bid * NWAVES + wave_; (void)lane_; (void)gw_; \
              int pz_ = 0; asm volatile("" : "+s"(pz_))
#define PTR(i) ((const float*)ldptr(lds, (i) + pz_))
#define WSP() ((unsigned char*)ldptr(lds, 24 + pz_))
#define OUTP() ((float*)ldptr(lds, 23 + pz_))

    if (IN(0) && PHON(0)) {
        PHL(); unsigned char* ws = WSP();
        LAS float* scr = (LAS float*)(lds + RING_OFF + wave_ * 16384);
        constexpr int I_IN = 32 * 128, I_OUT = 32 * 64, I_MQ = 32 * 16, I_MKV = 32 * 32, I_MO = 8 * 64, I_PQ = 32 * 64, I_L = I_IN + I_OUT + I_MQ + I_MKV + I_MO + I_PQ;
        for (int it = gw_; it < DEPTH * I_L; it += NGW) {
            const int l = it / I_L; int r = it % I_L;
            if (r < I_IN) { transpose_item<true>(PTR(4) + (size_t)l * DM * DIN, DM, DIN, (bf16*)(ws + WS_WIN) + (size_t)l * DIN * DM, scr, r, lane_, PTR(3) + (size_t)l * DM); continue; } r -= I_IN;
            if (r < I_OUT) { transpose_item<false>(PTR(11) + (size_t)l * DM * DM, DM, DM, (bf16*)(ws + WS_WOUT) + (size_t)l * DM * DM, scr, r, lane_, PTR(10) + (size_t)l * DM); continue; } r -= I_OUT;
            if (r < I_MQ) { transpose_item<false>(PTR(14) + (size_t)l * DM * MEMW, DM, MEMW, (bf16*)(ws + WS_WMQ) + (size_t)l * MEMW * DM, scr, r, lane_, PTR(12) + (size_t)l * DM); continue; } r -= I_MQ;
            if (r < I_MKV) { transpose_item<false>(PTR(15) + (size_t)l * DM * 1024, DM, 1024, (bf16*)(ws + WS_WMKV) + (size_t)l * 1024 * DM, scr, r, lane_); continue; } r -= I_MKV;
            if (r < I_MO) { transpose_item<false>(PTR(17) + (size_t)l * MEMW * DM, MEMW, DM, (bf16*)(ws + WS_WMO) + (size_t)l * DM * MEMW, scr, r, lane_); continue; } r -= I_MO;
            transpose_item<false>(PTR(19) + (size_t)l * DM * DM, DM, DM, (bf16*)(ws + WS_WPQ) + (size_t)l * DM * DM, scr, r, lane_, PTR(18) + (size_t)l * DM);
        }
        const size_t gtid = (size_t)bid * NTHREADS + tid_, nth = (size_t)G * NTHREADS;
        convert_bf16(PTR(20), (bf16*)(ws + WS_PKEYS), (size_t)DEPTH * 8 * 2 * 128 * 128, gtid, nth);
        convert_int4_plain(PTR(21), ws + WS_PU, DEPTH * PEER_N, PU_SCALEI, PTR(18), gw_, NGW, lane_);
        convert_fp4_rows(PTR(22), ws + WS_PV, PEER_N, PV_SCALE4, nullptr, gw_, NGW, lane_);
        {   const float* x0 = PTR(0); bf16* XN = (bf16*)(ws + WS_XN); u64_t* rsq = (u64_t*)(ws + WS_ROWSQ);
            for (int m = 2 * gw_; m < T; m += 2 * NGW) prep_rows2(x0 + (size_t)m * DM, XN + (size_t)m * DM, rsq + m, ws + WS_XN8 + (size_t)m * DM, (float*)(ws + WS_XSC) + m, lane_); }
        {   const float* mem = PTR(1); const float* gkv = PTR(13); bf16* MEMN = (bf16*)(ws + WS_MEMN);
            for (int m = gw_; m < BATCH * NMEM; m += NGW)
                rms_row_to_bf16(mem + (size_t)m * DM, gkv, MEMN + (size_t)m * DM, gkv + DM, MEMN + (size_t)(BATCH * NMEM + m) * DM, lane_); }
        float* rope = (float*)(ws + WS_ROPE); float* biasA = (float*)(ws + WS_BIASA);
        if (gtid < 64 * 16) { const int pos = (int)gtid >> 4, i = (int)gtid & 15; const float ang = (float)pos * ROPE_INV[i]; rope[gtid * 2] = cosf(ang); rope[gtid * 2 + 1] = sinf(ang); }
        if (gtid < 12 * 257) { const int h = (int)gtid / 257, rel = (int)gtid % 257 - 128; biasA[gtid] = PTR(2)[t5_bucket(rel) * 12 + h]; }
    }
    SEAM(0);
    if (IN(1) && PHON(1)) {
        {   PHL(); unsigned char* ws = WSP();
            for (int r = gw_; r < DEPTH * DIN; r += NGW) { const int rr = r & (DIN - 1), src = (rr & ~255) + 64 * ((rr >> 5) & 3) + 32 * ((rr >> 7) & 1) + (rr & 31);
                quant_wrow((const bf16*)(ws + WS_WIN) + (size_t)r * DM, ws + WS_WIN8 + (size_t)r * DM, (float*)(ws + WS_WSC) + (r & ~(DIN - 1)) + src, lane_); }
            for (int r = gw_; r < DEPTH * DM; r += NGW) quant_wrow((const bf16*)(ws + WS_WOUT) + (size_t)r * DM, ws + WS_WOUT8 + (size_t)r * DM, (float*)(ws + WS_WSCO) + r, lane_);
            for (int r = gw_; r < DEPTH * DM; r += NGW) quant_wrow((const bf16*)(ws + WS_WPQ) + (size_t)r * DM, ws + WS_WPQ8 + (size_t)r * DM, (float*)(ws + WS_WSCP) + r, lane_);
            for (int r = gw_; r < DEPTH * MEMW; r += NGW) quant_wrow((const bf16*)(ws + WS_WMQ) + (size_t)r * DM, ws + WS_WMQ8 + (size_t)r * DM, (float*)(ws + WS_WSCM) + r, lane_); }
#pragma unroll 1
        for (int l = 0; l < DEPTH; ++l) {
            PHL(); unsigned char* ws = WSP();
            pg8::Gemm g{(bf16*)(ws + WS_MEMN) + (size_t)l * BATCH * NMEM * DM, (bf16*)(ws + WS_WMKV) + (size_t)l * 1024 * DM, BATCH * NMEM, 1024, DM};
            OffsetOrder S; S.init(BATCH * NMEM, 1024, G, bid, 64 * l);
            bf16* KVMl = (bf16*)(ws + WS_KVM) + (size_t)l * BATCH * NMEM * 1024;
            pg8::EpiBf16<0> E{KVMl, 1024, nullptr, 0, 0, 1.f};
            pg8::gemm_phase<pg8::EpiBf16<0>, OffsetOrder, true, true>(lds + RING_OFF, g, S, E, tid_);
            VM_WAIT(); __syncthreads();
            const float* gk = PTR(16) + (size_t)l * 256 + 128;
#pragma unroll 1
            for (int i = 0; i < 4; ++i) { pg8::Unit uu; uu.pm = 0; uu.pn = 0; if (!S.next(i, uu)) break;
                if (uu.pn < 2) {
                    for (int r2 = wave_; r2 < 128; r2 += NWAVES) { const int row = uu.pm * 256 + 2 * r2 + (lane_ >> 5), cl = lane_ & 31;
                        GAS v4u* p = (GAS v4u*)(KVMl + (size_t)row * 1024 + 256 * uu.pn + 8 * cl);
                        const v4u w = *p;
                        float f[8] = {bflo(w.x), bfhi(w.x), bflo(w.y), bfhi(w.y), bflo(w.z), bfhi(w.z), bflo(w.w), bfhi(w.w)};
                        float ss = 0.f;
#pragma unroll
                        for (int e = 0; e < 8; ++e) ss += f[e] * f[e];
                        ss += shx(ss, 1, lane_); ss += shx(ss, 2, lane_); ss += shx(ss, 4, lane_); ss += shx(ss, 8, lane_);
                        const float r = 1.f / sqrtf(ss * (1.f / 128.f) + EPS);
                        const float* gg = gk + 8 * (cl & 15);
                        v4u o; o.x = pk2(f[0] * r * gg[0], f[1] * r * gg[1]); o.y = pk2(f[2] * r * gg[2], f[3] * r * gg[3]); o.z = pk2(f[4] * r * gg[4], f[5] * r * gg[5]); o.w = pk2(f[6] * r * gg[6], f[7] * r * gg[7]);
                        *p = o; } } }
            __syncthreads();
        }
        if (G >= 256 && bid >= 128) { PHL(); unsigned char* ws = WSP();
            convert_fp4_rows(PTR(22) + (size_t)PEER_N * DM, ws + WS_PV + (size_t)PEER_N * 1024, PEER_N, PV_SCALE4, nullptr, (bid - 128) * NWAVES + wave_, (G - 128) * NWAVES, lane_); }
        else if (G < 256) { PHL(); unsigned char* ws = WSP(); convert_fp4_rows(PTR(22) + (size_t)PEER_N * DM, ws + WS_PV + (size_t)PEER_N * 1024, PEER_N, PV_SCALE4, nullptr, gw_, NGW, lane_); }
    }
    SEAM(1);

#pragma unroll 1
    for (int l = 0; l < DEPTH; ++l) {
        const int pb = PH_BASE + PH_PER_LAYER * l;
        if (IN(pb + 0) && PHON(3)) { PHL(); unsigned char* ws = WSP();
            pg8::Gemm g{(bf16*)(ws + WS_XN8), (bf16*)(ws + WS_WIN8 + (size_t)l * DIN * DM), T, DIN, DM / 2}; pg8::StaticOrder S; S.init(T, DIN, G, bid);
            LAS float* ropel = (LAS float*)(lds + LDSCTL_OFF + 2048);
            for (int i = tid_; i < 64 * 16 * 2; i += NTHREADS) ropel[i] = ((const float*)(ws + WS_ROPE))[i];
            __syncthreads();
            pg8::EpiQKV E{(bf16*)(ws + WS_QKV), PTR(5) + (size_t)l * 128, PTR(7) + (size_t)l * 128, PTR(9) + (size_t)l * 128, ropel, (const u64_t*)(ws + WS_ROWSQ) + (size_t)(l * 3 + 0) * T, (const float*)(ws + WS_XSC), (const float*)(ws + WS_WSC) + (size_t)l * DIN};
            pg8::gemm_phase<pg8::EpiQKV, pg8::StaticOrder, true, true>(lds + RING_OFF, g, S, E, tid_);
        }
        SEAM(pb + 0);
        if (IN(pb + 1) && PHON(4)) { PHL(); unsigned char* ws = WSP();
            const float* sink = PTR(6) + (size_t)l * 12; const float* rpb = PTR(8) + (size_t)l * 8 * 15 * 31; const float* biasA = (const float*)(ws + WS_BIASA);
            const bf16* QKV = (const bf16*)(ws + WS_QKV); bf16* ATT = (bf16*)(ws + WS_ATT);
            const float* ga = PTR(5) + (size_t)l * 128; const float* gb = PTR(7) + (size_t)l * 128; const float* gc = PTR(9) + (size_t)l * 128;
            const float CaL2 = 8.f * wave_max(fabsf(ga[lane_]), lane_) * wave_max(fabsf(ga[64 + lane_]), lane_) * LOG2E;
            const float CbL2 = 8.f * wave_max(fabsf(gb[lane_]), lane_) * wave_max(fabsf(gb[64 + lane_]), lane_) * LOG2E;
            const float CcL2 = 8.f * wave_max(fabsf(gc[lane_]), lane_) * wave_max(fabsf(gc[64 + lane_]), lane_) * LOG2E;
            const int vc = (G % 8 == 0) ? (bid % 8) * (G / 8) + bid / 8 : bid;
            u64_t* mixsq = (u64_t*)(ws + WS_MIXSQ) + (size_t)l * 3 * T;
            for (int u = vc; u < BATCH * 12 * 8; u += G) attn_unit<2>(lds, QKV, ATT, mixsq + 2 * (size_t)T, u / 96, (u >> 3) % 12, u & 7, nullptr, CcL2, 0.f, tid_);
            for (int u = vc; u < BATCH * 8 * 8; u += G) attn_unit<1>(lds, QKV, ATT, mixsq + (size_t)T, u >> 6, (u >> 3) & 7, u & 7, rpb, CbL2, 0.f, tid_);
            for (int u = vc; u < BATCH * 12 * 8; u += G) { const int head = (u >> 3) % 12; attn_unit<0>(lds, QKV, ATT, mixsq, u / 96, head, u & 7, biasA, CaL2, sink[head] * LOG2E, tid_); }
        }
        SEAM(pb + 1);
        if (IN(pb + 2) && PHON(5)) { PHL(); unsigned char* ws = WSP();
            const u64_t* mixsq = (const u64_t*)(ws + WS_MIXSQ) + (size_t)l * 3 * T;
            for (int r = 4 * gw_; r < T; r += 4 * NGW) att_quant_rows<4>((const bf16*)(ws + WS_ATT), mixsq, ws + WS_ATT8, (float*)(ws + WS_XSC2), r, lane_);
        }
        SEAM(pb + 2);
        if (IN(pb + 3) && PHON(5)) { PHL(); unsigned char* ws = WSP();
            pg8::Gemm g{(bf16*)(ws + WS_ATT8), (bf16*)(ws + WS_WOUT8 + (size_t)l * DM * DM), T, DM, DM / 2}; pg8::StaticOrder S; S.init(T, DM, G, bid);
            typedef pg8::EpiResidT<true, 10> EpiX1;
            EpiX1 E{(bf16*)(ws + WS_XN), DM, (u64_t*)(ws + WS_ROWSQ) + (size_t)(l * 3 + 1) * T, (const float*)(ws + WS_XSC2), (const float*)(ws + WS_WSCO) + (size_t)l * DM, ws + WS_X8, (const u64_t*)(ws + WS_ROWSQ) + (size_t)(l * 3 + 0) * T, nullptr, nullptr};
            pg8::gemm_phase<EpiX1, pg8::StaticOrder, true, true>(lds + RING_OFF, g, S, E, tid_);
        }
        SEAM(pb + 3);
        if (IN(pb + 4) && PHON(6)) { PHL(); unsigned char* ws = WSP();
            pg8::Gemm g{(bf16*)(ws + WS_X8), (bf16*)(ws + WS_WMQ8 + (size_t)l * MEMW * DM), T, MEMW, DM / 2}; pg8::StaticOrder S; S.init(T, MEMW, G, bid);
            pg8::EpiBf16Row8<10> E{(bf16*)(ws + WS_QM), MEMW, (const u64_t*)(ws + WS_ROWSQ) + (size_t)(l * 3 + 1) * T, (const u64_t*)(ws + WS_ROWSQ) + (size_t)(l * 3 + 0) * T, (const float*)(ws + WS_WSCM) + (size_t)l * MEMW};
            pg8::gemm_phase<pg8::EpiBf16Row8<10>, pg8::StaticOrder, true, true>(lds + RING_OFF, g, S, E, tid_);
            VM_WAIT(); __syncthreads();
            const bf16* kvm = (const bf16*)(ws + WS_KVM) + (size_t)l * BATCH * NMEM * 1024; const float* gq = PTR(16) + (size_t)l * 256;
            const float CmL2 = 11.313708498984761f * wave_max(fmaxf(fabsf(gq[lane_]), fabsf(gq[64 + lane_])), lane_) * wave_max(fmaxf(fabsf(gq[128 + lane_]), fabsf(gq[192 + lane_])), lane_) * LOG2E;
#pragma unroll 1
            for (int i = 0; i < 4; ++i) { pg8::Unit uu; uu.pm = 0; uu.pn = 0; if (!S.next(i, uu)) break;
                int nrep_ = (MK_REP == 1) ? 4 : 2; asm volatile("" : "+s"(nrep_));
#pragma unroll 1
                for (int hr = 0; hr < nrep_; ++hr) mem_unit(lds, (const bf16*)(ws + WS_QM), kvm, (bf16*)(ws + WS_OM), gq, uu.pm, 2 * uu.pn + (hr & 1), CmL2, tid_);
#if MK_REP == 4 || MK_REP == 5
                mem_unit<MK_REP - 3>(lds, (const bf16*)(ws + WS_QM), kvm, (bf16*)(ws + WS_QKV), gq, uu.pm, 2 * uu.pn, CmL2, tid_); mem_unit<MK_REP - 3>(lds, (const bf16*)(ws + WS_QM), kvm, (bf16*)(ws + WS_QKV), gq, uu.pm, 2 * uu.pn + 1, CmL2, tid_);
#endif
            }
        }
        SEAM(pb + 4);
        if (IN(pb + 5) && PHON(7)) { PHL(); unsigned char* ws = WSP();
            pg8::Gemm g{(bf16*)(ws + WS_OM), (bf16*)(ws + WS_WMO) + (size_t)l * DM * MEMW, T, DM, MEMW}; pg8::StaticOrder S; S.init(T, DM, G, bid);
            typedef pg8::EpiResidT<false, 8, true> EpiX2;
            EpiX2 E{(bf16*)(ws + WS_XN), DM, (u64_t*)(ws + WS_ROWSQ) + (size_t)(l * 3 + 2) * T, nullptr, nullptr, ws + WS_X8, (const u64_t*)(ws + WS_ROWSQ) + (size_t)(l * 3 + 1) * T, ws + WS_XQH, ws + WS_XQL};
            pg8::gemm_phase<EpiX2, pg8::StaticOrder, true, true>(lds + RING_OFF, g, S, E, tid_);
        }
        SEAM(pb + 5);
        if (IN(pb + 6) && PHON(8)) { PHL(); unsigned char* ws = WSP();
            pg8::Gemm g{(bf16*)(ws + WS_X8), (bf16*)(ws + WS_WPQ8 + (size_t)l * DM * DM), T, DM, DM / 2}; pg8::StaticOrder S; S.init(T, DM, G, bid);
            pg8::EpiBf16Row8<8> E{(bf16*)(ws + WS_QP), DM, (const u64_t*)(ws + WS_ROWSQ) + (size_t)(l * 3 + 2) * T, (const u64_t*)(ws + WS_ROWSQ) + (size_t)(l * 3 + 1) * T, (const float*)(ws + WS_WSCP) + (size_t)l * DM};
            pg8::gemm_phase<pg8::EpiBf16Row8<8>, pg8::StaticOrder, true, true>(lds + RING_OFF, g, S, E, tid_);
            VM_WAIT(); __syncthreads();
            const bf16* pk = (const bf16*)(ws + WS_PKEYS) + (size_t)l * 8 * 2 * 128 * 128;
#pragma unroll 1
            for (int i = 0; i < 8; ++i) { pg8::Unit uu; uu.pm = 0; uu.pn = 0; if (!S.next(i, uu)) break;
                peer_select_unit((const bf16*)(ws + WS_QP), pk, (int*)(ws + WS_PIDX), (float*)(ws + WS_PGATE), uu.pm, uu.pn, wave_, lane_, lds + RING_OFF);
#if MK_REP == 2
                peer_select_unit((const bf16*)(ws + WS_QP), pk, (int*)(ws + WS_PIDX), (float*)(ws + WS_PGATE), uu.pm, uu.pn, wave_, lane_, lds + RING_OFF);
#endif
#if MK_REP == 3
#endif
            }
        }
        SEAM(pb + 6);
        if (IN(pb + 7) && PHON(9)) { PHL(); unsigned char* ws = WSP();
            peer_u_phase_i4((const unsigned*)(ws + WS_XQH), (const unsigned*)(ws + WS_XQL), ws + WS_PU + (size_t)l * PEER_N * 1024, (const int*)(ws + WS_PIDX), (int*)(ws + WS_PARTI), bid, G, wave_, lane_); }
        SEAM(pb + 7);
        if (IN(pb + 8) && PHON(10)) { PHL(); unsigned char* ws = WSP();
            peer_v_pass((bf16*)(ws + WS_XN), ws + WS_PV + (size_t)l * PEER_N * 1024, (const int*)(ws + WS_PIDX), (const float*)(ws + WS_PGATE), (const int*)(ws + WS_PARTI), (l + 1 == DEPTH) ? OUTP() : (float*)nullptr,
                        (l + 1 < DEPTH) ? (u64_t*)(ws + WS_ROWSQ) + (size_t)((l + 1) * 3 + 0) * T : (u64_t*)nullptr, (l + 1 < DEPTH) ? ws + WS_XN8 : (unsigned char*)nullptr, (float*)(ws + WS_XSC), (const u64_t*)(ws + WS_ROWSQ) + (size_t)(l * 3 + 1) * T, (const u64_t*)(ws + WS_ROWSQ) + (size_t)(l * 3 + 2) * T, (LAS float*)(lds + RING_OFF + wave_ * 1024), gw_, NGW, lane_); }
        SEAM(pb + 8);
    }
#undef IN
#undef SEAM
}

#ifndef MK_MULTI_LAUNCH
#define MK_MULTI_LAUNCH 0
#endif
extern "C" void kernel_launch(void* const* d_in, const int* in_sizes, int n_in, void* d_out, int out_size, void* d_ws, size_t ws_size, hipStream_t stream) {
    static int grid = 0;
    if (grid == 0) {
        if (n_in != 23 || out_size != T * DM || ws_size < WS_END) { fprintf(stderr, "kernel_launch: unexpected shapes (n_in %d, out %d, ws %zu)\n", n_in, out_size, ws_size); grid = -1; return; }
        int dev = 0, cus = 0, per_cu = 0;
        if (hipGetDevice(&dev) != hipSuccess || hipDeviceGetAttribute(&cus, hipDeviceAttributeMultiprocessorCount, dev) != hipSuccess) { grid = -1; return; }
        if (hipFuncSetAttribute((const void*)mega, hipFuncAttributeMaxDynamicSharedMemorySize, LDS_BYTES) != hipSuccess) { fprintf(stderr, "kernel_launch: hipFuncSetAttribute failed\n"); grid = -1; return; }
        if (hipOccupancyMaxActiveBlocksPerMultiprocessor(&per_cu, (const void*)mega, NTHREADS, LDS_BYTES) != hipSuccess || per_cu < 1) { fprintf(stderr, "kernel_launch: occupancy query says %d\n", per_cu); }
        (void)hipGetLastError();
        grid = cus;
    }
    if (grid < 0) return;
    (void)hipMemsetAsync((char*)d_ws + WS_CTL, 0, CTL_ZERO_BYTES, stream);
    (void)hipMemsetAsync((char*)d_ws + WS_MIXSQ, 0, MIXSQ_BYTES, stream);
    Args a{};
    for (int i = 0; i < 23; ++i) a.in[i] = (const float*)d_in[i];
    a.out = (float*)d_out; a.ws = (unsigned char*)d_ws;
#if MK_MULTI_LAUNCH
    for (int p = 0; p < N_PHASES; ++p) { a.ph_lo = p; a.ph_hi = p + 1; a.use_bar = 0; a.pad = 0; hipLaunchKernelGGL(mega, dim3(grid), dim3(NTHREADS), LDS_BYTES, stream, a); }
#else
    a.ph_lo = 0; a.ph_hi = N_PHASES; a.use_bar = 1; a.pad = 0;
    hipLaunchKernelGGL(mega, dim3(grid), dim3(NTHREADS), LDS_BYTES, stream, a);
#endif
    const hipError_t le = hipPeekAtLastError();
    if (le != hipSuccess) fprintf(stderr, "kernel_launch: launch failed: %s\n", hipGetErrorName(le));
}
```

```cpp
#include <hip/hip_runtime.h>
#include <cstdio>
#include <cstdint>
#include <cmath>
__device__ __forceinline__ float shx(float v, int k, int lane);
typedef unsigned long long u64_t;
__device__ __forceinline__ float rowsq_rs(const u64_t* rowsq, int row) { return 1.0f / sqrtf((float)*(const __attribute__((address_space(1))) u64_t*)(rowsq + row) * (5.9604644775390625e-08f / 2048.0f) + 1e-6f); }
__device__ __forceinline__ u64_t rowsq_fx(float ss) { return (u64_t)(ss * 16777216.0f + 0.5f); }
template <int HI = 255>
__device__ __forceinline__ unsigned q8x4c(float a, float b, float c, float d, float inv) {
    unsigned w = 0;
    w = __builtin_amdgcn_cvt_pk_u8_f32(__builtin_rintf(__builtin_amdgcn_fmed3f(__builtin_fmaf(a, inv, 128.f), 1.f, (float)HI)), 0, w); w = __builtin_amdgcn_cvt_pk_u8_f32(__builtin_rintf(__builtin_amdgcn_fmed3f(__builtin_fmaf(b, inv, 128.f), 1.f, (float)HI)), 1, w);
    w = __builtin_amdgcn_cvt_pk_u8_f32(__builtin_rintf(__builtin_amdgcn_fmed3f(__builtin_fmaf(c, inv, 128.f), 1.f, (float)HI)), 2, w); w = __builtin_amdgcn_cvt_pk_u8_f32(__builtin_rintf(__builtin_amdgcn_fmed3f(__builtin_fmaf(d, inv, 128.f), 1.f, (float)HI)), 3, w);
    return w ^ 0x80808080u;
}
__device__ __forceinline__ unsigned dig_lo4(unsigned d) { return d & 0x0f0f0f0fu; }
__device__ __forceinline__ unsigned dig_hi4(unsigned d) { const unsigned t = ((d & 0x7f7f7f7fu) + 0x08080808u) ^ (d & 0x80808080u); return (t >> 4) & 0x0f0f0f0fu; }
__device__ __forceinline__ unsigned nib_pack8(unsigned a, unsigned b) { a = (a | (a >> 4)) & 0x00ff00ffu; a = (a | (a >> 8)) & 0xffffu; b = (b | (b >> 4)) & 0x00ff00ffu; b = (b | (b >> 8)) & 0xffffu; return a | (b << 16); }
namespace pg8 {
#define PG8_LAS __attribute__((address_space(3)))
#define PG8_GAS __attribute__((address_space(1)))
typedef unsigned short bf16_t;
typedef short bf16x8 __attribute__((ext_vector_type(8)));
typedef float f32x4 __attribute__((ext_vector_type(4)));
typedef unsigned u32x4 __attribute__((ext_vector_type(4)));
constexpr int BM = 256, BK = 64, HALF = 128, HTB = HALF * BK * 2  , STAGE_BYTES = 8 * HTB, NXCD = 8, WGM = 8;

__host__ __device__ __forceinline__ int lds_byte(int r, int c) { const int st = (r >> 4) * 2 + (c >> 5), rr = r & 15, cc = c & 31, ob = rr * 64 + cc * 2; return st * 1024 + (ob ^ (((ob >> 9) & 1) << 5)); }
__host__ __device__ __forceinline__ void stage_rc(int b, int& R, int& C) { const int st = b / 1024, sb = b % 1024, swz = sb ^ (((sb >> 9) & 1) << 5); R = (st >> 1) * 16 + swz / 64; C = (st & 1) * 32 + (swz % 64) / 2; }
__host__ __device__ __forceinline__ int perm32(int rho) { const int n = rho >> 4, i = rho & 15; return 8 * (i >> 2) + 4 * n + (i & 3); }

struct Unit { int pm, pn; };
struct Gemm { const bf16_t* A; const bf16_t* Bt; int M, N, K; };

struct StaticOrder {
    int nM, nN, nwg, G, c;
    __host__ __device__ __forceinline__ void init(int M, int N, int G_, int c_) { nM = M / BM; nN = N / BM; nwg = nM * nN; G = G_; c = c_; }
    __host__ __device__ __forceinline__ bool next(int i, Unit& u) const {
        const long L = (long)i * G + c; if (L >= nwg) return false;
        int wgid = (int)L; { const int q = nwg / NXCD, r = nwg % NXCD, xcd = wgid % NXCD, off = wgid / NXCD; wgid = (xcd < r ? xcd * (q + 1) : r * (q + 1) + (xcd - r) * q) + off; }
        const int nig = WGM * nN, gid = wgid / nig, fm = gid * WGM, gsz = (nM - fm) < WGM ? (nM - fm) : WGM;
        u.pm = fm + ((wgid % nig) % gsz); u.pn = (wgid % nig) / gsz; return true;
    }
    __device__ __forceinline__ void a_ready(const Unit&) const {}
    __device__ __forceinline__ void done(const Unit&) const {}
};

__device__ __forceinline__ unsigned cvt_pk_bf16(float lo, float hi) { unsigned r; asm volatile("v_cvt_pk_bf16_f32 %0, %1, %2" : "=v"(r) : "v"(lo), "v"(hi)); return r; }
typedef float f32x2 __attribute__((ext_vector_type(2)));
__device__ __forceinline__ f32x2 gelu_pk(f32x2 v) {
    const f32x2 av = __builtin_elementwise_abs(v), d = av * 0.2316418882f + 1.0f;
    f32x2 t; t.x = __builtin_amdgcn_rcpf(d.x); t.y = __builtin_amdgcn_rcpf(d.y);
    f32x2 q = t * 0.5307027145f + (-0.7265760135f); q = q * t + 0.7107068705f; q = q * t + (-0.142248368f); q = q * t + 0.127414796f; q = q * t;
    const f32x2 s = (v * v) * (-0.72134752044f);
    f32x2 e; e.x = __builtin_amdgcn_exp2f(s.x); e.y = __builtin_amdgcn_exp2f(s.y);
    const f32x2 m = v * (q * e), r = v - m;
    f32x2 o; o.x = v.x < 0.f ? m.x : r.x; o.y = v.y < 0.f ? m.y : r.y; return o;
}

template <int ACT  > struct EpiBf16 {
    static constexpr bool PERM = true, AFTER_DRAIN = false, KSCALE = false, I8 = false; static_assert(ACT == 0 || ACT == 1, "EpiBf16: ACT is 0 (none) or 1 (gelu_pk)");
    bf16_t* O; int ldc; const float* bias; int split_cols; size_t split_stride; float scale0;
    __device__ __forceinline__ void operator()(const f32x4 (&acc)[2][2][4][2], const Unit& u, int wr, int wc, int fr, int fq) const {
        const int row0 = u.pm * BM + wr * 64 + fr; int colt = u.pn * BM; bf16_t* base = O;
        float sc = 1.f; if (split_cols) { const int t = colt / split_cols; base += (size_t)t * split_stride; colt -= t * split_cols; if (t == 0) sc = scale0; }
        const int col0 = colt + wc * 32 + 8 * fq, bcol0 = u.pn * BM + wc * 32 + 8 * fq;
        f32x4 bv[2][2];
#pragma unroll
        for (int bj = 0; bj < 2; ++bj)
#pragma unroll
            for (int n = 0; n < 2; ++n) bv[bj][n] = bias ? *(const PG8_GAS f32x4*)(bias + bcol0 + bj * HALF + 4 * n) : (f32x4){0.f, 0.f, 0.f, 0.f};
#pragma unroll
        for (int ai = 0; ai < 2; ++ai)
#pragma unroll
            for (int m = 0; m < 4; ++m) { bf16_t* rowp = base + (size_t)(row0 + ai * HALF + m * 16) * ldc + col0;
#pragma unroll
                for (int bj = 0; bj < 2; ++bj) { f32x4 v0 = acc[ai][bj][m][0] + bv[bj][0], v1 = acc[ai][bj][m][1] + bv[bj][1];
                    if (ACT == 1) { f32x2 a = gelu_pk((f32x2){v0[0], v0[1]}), b = gelu_pk((f32x2){v0[2], v0[3]}), c = gelu_pk((f32x2){v1[0], v1[1]}), d = gelu_pk((f32x2){v1[2], v1[3]});
                        v0 = (f32x4){a.x, a.y, b.x, b.y}; v1 = (f32x4){c.x, c.y, d.x, d.y}; }
                    v0 = v0 * sc; v1 = v1 * sc; u32x4 w; w.x = cvt_pk_bf16(v0[0], v0[1]); w.y = cvt_pk_bf16(v0[2], v0[3]); w.z = cvt_pk_bf16(v1[0], v1[1]); w.w = cvt_pk_bf16(v1[2], v1[3]);
                    *(PG8_GAS u32x4*)(rowp + bj * HALF) = w; } }
    }
};

typedef unsigned u32x2 __attribute__((ext_vector_type(2)));
typedef int i32x4 __attribute__((ext_vector_type(4)));
struct EpiResid {
    static constexpr bool PERM = false, AFTER_DRAIN = false, KSCALE = false, I8 = false;
    bf16_t* s; int ldc; u64_t* rowsq;
    __device__ __forceinline__ void operator()(const f32x4 (&acc)[2][2][4][2], const Unit& u, int wr, int wc, int fr, int fq) const {
        const int col0 = u.pn * BM + wc * 32 + 4 * fq;
#pragma unroll
        for (int ai = 0; ai < 2; ++ai)
#pragma unroll
            for (int m = 0; m < 4; ++m) { const int row = u.pm * BM + ai * HALF + wr * 64 + m * 16 + fr; bf16_t* sp = s + (size_t)row * ldc + col0; float ss = 0.f;
                u32x2 in[2][2];
#pragma unroll
                for (int bj = 0; bj < 2; ++bj)
#pragma unroll
                    for (int n = 0; n < 2; ++n) in[bj][n] = *(const PG8_GAS u32x2*)(sp + bj * HALF + n * 16);
#pragma unroll
                for (int bj = 0; bj < 2; ++bj)
#pragma unroll
                    for (int n = 0; n < 2; ++n) { const u32x2 w0 = in[bj][n];
                        const f32x4 bs = (f32x4){__builtin_bit_cast(float, w0.x << 16), __builtin_bit_cast(float, w0.x & 0xffff0000u), __builtin_bit_cast(float, w0.y << 16), __builtin_bit_cast(float, w0.y & 0xffff0000u)};
                        const f32x4 o = bs + acc[ai][bj][m][n]; ss += (o[0] * o[0] + o[1] * o[1]) + (o[2] * o[2] + o[3] * o[3]);
                        u32x2 w; w.x = cvt_pk_bf16(o[0], o[1]); w.y = cvt_pk_bf16(o[2], o[3]); *(PG8_GAS u32x2*)(sp + bj * HALF + n * 16) = w; }
                ss += shx(ss, 16, fr + 16 * fq); ss += shx(ss, 32, fr + 16 * fq);
                if (fq == 0) (void)__hip_atomic_fetch_add((PG8_GAS u64_t*)(rowsq + row), rowsq_fx(ss), __ATOMIC_RELAXED, __HIP_MEMORY_SCOPE_AGENT); }
    }
};
struct EpiResid8 {
    static constexpr bool PERM = false, AFTER_DRAIN = false, KSCALE = false, I8 = true;
    bf16_t* s; int ldc; u64_t* rowsq; const float* xsc; const float* wsc;
    __device__ __forceinline__ void operator()(const f32x4 (&acc)[2][2][4][2], const Unit& u, int wr, int wc, int fr, int fq) const {
        const int col0 = u.pn * BM + wc * 32 + 4 * fq;
#pragma unroll
        for (int ai = 0; ai < 2; ++ai)
#pragma unroll
            for (int m = 0; m < 4; ++m) { const int row = u.pm * BM + ai * HALF + wr * 64 + m * 16 + fr; bf16_t* sp = s + (size_t)row * ldc + col0; float ss = 0.f; const float xs = *(const PG8_GAS float*)(xsc + row);
                u32x2 in[2][2];
#pragma unroll
                for (int bj = 0; bj < 2; ++bj)
#pragma unroll
                    for (int n = 0; n < 2; ++n) in[bj][n] = *(const PG8_GAS u32x2*)(sp + bj * HALF + n * 16);
#pragma unroll
                for (int bj = 0; bj < 2; ++bj)
#pragma unroll
                    for (int n = 0; n < 2; ++n) { const u32x2 w0 = in[bj][n]; const i32x4 ia = __builtin_bit_cast(i32x4, acc[ai][bj][m][n]);
                        const f32x4 bs = (f32x4){__builtin_bit_cast(float, w0.x << 16), __builtin_bit_cast(float, w0.x & 0xffff0000u), __builtin_bit_cast(float, w0.y << 16), __builtin_bit_cast(float, w0.y & 0xffff0000u)};
                        const f32x4 o = bs + (f32x4){(float)ia[0], (float)ia[1], (float)ia[2], (float)ia[3]} * *(const PG8_GAS f32x4*)(wsc + col0 + bj * HALF + n * 16) * xs; ss += (o[0] * o[0] + o[1] * o[1]) + (o[2] * o[2] + o[3] * o[3]);
                        u32x2 w; w.x = cvt_pk_bf16(o[0], o[1]); w.y = cvt_pk_bf16(o[2], o[3]); *(PG8_GAS u32x2*)(sp + bj * HALF + n * 16) = w; }
                ss += shx(ss, 16, fr + 16 * fq); ss += shx(ss, 32, fr + 16 * fq);
                if (fq == 0) (void)__hip_atomic_fetch_add((PG8_GAS u64_t*)(rowsq + row), rowsq_fx(ss), __ATOMIC_RELAXED, __HIP_MEMORY_SCOPE_AGENT); }
    }
};
template <bool I8IN, int QOUT, bool DIG = false>
struct EpiResidT {
    static constexpr bool PERM = true, AFTER_DRAIN = false, KSCALE = false, I8 = I8IN;
    bf16_t* s; int ldc; u64_t* rowsq; const float* xsc; const float* wsc; unsigned char* q8; const u64_t* rowsq_prev; unsigned char* dgh; unsigned char* dgl;
    __device__ __forceinline__ void operator()(const f32x4 (&acc)[2][2][4][2], const Unit& u, int wr, int wc, int fr, int fq) const {
        const int col0 = u.pn * BM + wc * 32 + 8 * fq, rowb = u.pm * BM + wr * 64 + fr;
        f32x4 wv[2][2];
        if constexpr (I8IN) {
#pragma unroll
            for (int bj = 0; bj < 2; ++bj) { wv[bj][0] = *(const PG8_GAS f32x4*)(wsc + col0 + bj * HALF); wv[bj][1] = *(const PG8_GAS f32x4*)(wsc + col0 + bj * HALF + 4); } }
#pragma unroll
        for (int ai = 0; ai < 2; ++ai) {
            u32x4 in[4][2]; float xs[4], qv[4];
#pragma unroll
            for (int m = 0; m < 4; ++m) { const int row = rowb + ai * HALF + m * 16; const bf16_t* sp = s + (size_t)row * ldc + col0;
#pragma unroll
                for (int bj = 0; bj < 2; ++bj) in[m][bj] = *(const PG8_GAS u32x4*)(sp + bj * HALF);
                if constexpr (I8IN) xs[m] = *(const PG8_GAS float*)(xsc + row); else xs[m] = 1.f;
                if constexpr (QOUT > 0) qv[m] = (127.0f / QOUT) * rowsq_rs(rowsq_prev, row); else qv[m] = 0.f; }
            __builtin_amdgcn_sched_barrier(0);
#pragma unroll
            for (int m = 0; m < 4; ++m) { const int row = rowb + ai * HALF + m * 16; bf16_t* sp = s + (size_t)row * ldc + col0; float ss = 0.f;
#pragma unroll
                for (int bj = 0; bj < 2; ++bj) { const u32x4 w0 = in[m][bj]; f32x4 a0 = acc[ai][bj][m][0], a1 = acc[ai][bj][m][1];
                    if constexpr (I8IN) { const i32x4 i0 = __builtin_bit_cast(i32x4, a0), i1 = __builtin_bit_cast(i32x4, a1);
                        a0 = (f32x4){(float)i0[0], (float)i0[1], (float)i0[2], (float)i0[3]} * wv[bj][0] * xs[m];
                        a1 = (f32x4){(float)i1[0], (float)i1[1], (float)i1[2], (float)i1[3]} * wv[bj][1] * xs[m]; }
                    const f32x4 o0 = (f32x4){__builtin_bit_cast(float, w0.x << 16), __builtin_bit_cast(float, w0.x & 0xffff0000u), __builtin_bit_cast(float, w0.y << 16), __builtin_bit_cast(float, w0.y & 0xffff0000u)} + a0;
                    const f32x4 o1 = (f32x4){__builtin_bit_cast(float, w0.z << 16), __builtin_bit_cast(float, w0.z & 0xffff0000u), __builtin_bit_cast(float, w0.w << 16), __builtin_bit_cast(float, w0.w & 0xffff0000u)} + a1;
                    ss += ((o0[0] * o0[0] + o0[1] * o0[1]) + (o0[2] * o0[2] + o0[3] * o0[3])) + ((o1[0] * o1[0] + o1[1] * o1[1]) + (o1[2] * o1[2] + o1[3] * o1[3]));
                    u32x4 w; w.x = cvt_pk_bf16(o0[0], o0[1]); w.y = cvt_pk_bf16(o0[2], o0[3]); w.z = cvt_pk_bf16(o1[0], o1[1]); w.w = cvt_pk_bf16(o1[2], o1[3]); *(PG8_GAS u32x4*)(sp + bj * HALF) = w;
                    if constexpr (QOUT > 0) { u32x2 q; q.x = q8x4c<DIG ? 247 : 255>(o0[0], o0[1], o0[2], o0[3], qv[m]); q.y = q8x4c<DIG ? 247 : 255>(o1[0], o1[1], o1[2], o1[3], qv[m]); *(PG8_GAS u32x2*)(q8 + (size_t)row * ldc + col0 + bj * HALF) = q;
                        if constexpr (DIG) { const size_t db = (size_t)row * 1024 + ((col0 + bj * HALF) >> 1);
                            *(PG8_GAS unsigned*)(dgl + db) = nib_pack8(dig_lo4(q.x), dig_lo4(q.y)); *(PG8_GAS unsigned*)(dgh + db) = nib_pack8(dig_hi4(q.x), dig_hi4(q.y)); } } }
                ss += shx(ss, 16, fr + 16 * fq); ss += shx(ss, 32, fr + 16 * fq);
                if (fq == 0) (void)__hip_atomic_fetch_add((PG8_GAS u64_t*)(rowsq + row), rowsq_fx(ss), __ATOMIC_RELAXED, __HIP_MEMORY_SCOPE_AGENT); }
            __builtin_amdgcn_sched_barrier(0);
        }
    }
};
template <int QIN>
struct EpiBf16Row8 {
    static constexpr bool PERM = true, AFTER_DRAIN = false, KSCALE = false, I8 = true;
    bf16_t* O; int ldc; const u64_t* rowsq; const u64_t* rowsq_prev; const float* wsc;
    __device__ __forceinline__ void operator()(const f32x4 (&acc)[2][2][4][2], const Unit& u, int wr, int wc, int fr, int fq) const {
        const int row0 = u.pm * BM + wr * 64 + fr, col0 = u.pn * BM + wc * 32 + 8 * fq;
        float rs[2][4]; f32x4 wv[2][2];
#pragma unroll
        for (int ai = 0; ai < 2; ++ai)
#pragma unroll
            for (int m = 0; m < 4; ++m) { const int row = row0 + ai * HALF + m * 16; rs[ai][m] = rowsq_rs(rowsq, row) * (QIN / 127.0f) / rowsq_rs(rowsq_prev, row); }
#pragma unroll
        for (int bj = 0; bj < 2; ++bj) { wv[bj][0] = *(const PG8_GAS f32x4*)(wsc + col0 + bj * HALF); wv[bj][1] = *(const PG8_GAS f32x4*)(wsc + col0 + bj * HALF + 4); }
        __builtin_amdgcn_sched_barrier(0);
#pragma unroll
        for (int ai = 0; ai < 2; ++ai)
#pragma unroll
            for (int m = 0; m < 4; ++m) { const int row = row0 + ai * HALF + m * 16; bf16_t* rowp = O + (size_t)row * ldc + col0;
#pragma unroll
                for (int bj = 0; bj < 2; ++bj) { const i32x4 i0 = __builtin_bit_cast(i32x4, acc[ai][bj][m][0]), i1 = __builtin_bit_cast(i32x4, acc[ai][bj][m][1]);
                    const f32x4 v0 = (f32x4){(float)i0[0], (float)i0[1], (float)i0[2], (float)i0[3]} * wv[bj][0] * rs[ai][m], v1 = (f32x4){(float)i1[0], (float)i1[1], (float)i1[2], (float)i1[3]} * wv[bj][1] * rs[ai][m];
                    u32x4 w; w.x = cvt_pk_bf16(v0[0], v0[1]); w.y = cvt_pk_bf16(v0[2], v0[3]); w.z = cvt_pk_bf16(v1[0], v1[1]); w.w = cvt_pk_bf16(v1[2], v1[3]);
                    *(PG8_GAS u32x4*)(rowp + bj * HALF) = w; } }
    }
};
struct EpiResidMix {
    static constexpr bool PERM = false, AFTER_DRAIN = false, KSCALE = true, I8 = false; static constexpr int KS0 = 12, KS1 = 20;
    bf16_t* s; int ldc; u64_t* rowsq; const PG8_LAS float* ftab; const PG8_LAS int* pmtab;
    __device__ __forceinline__ int slot(int pm) const { return pmtab[0] == pm ? 0 : (pmtab[1] == pm ? 1 : (pmtab[2] == pm ? 2 : 3)); }
    __device__ __forceinline__ void kscale(f32x4 (&acc)[2][2][4][2], const Unit& u, int which, int wr, int fr) const {
        const PG8_LAS float* ft = ftab + which * 1024 + slot(u.pm) * 256;
#pragma unroll
        for (int ai = 0; ai < 2; ++ai)
#pragma unroll
            for (int m = 0; m < 4; ++m) { const float f = ft[ai * HALF + wr * 64 + m * 16 + fr];
#pragma unroll
                for (int bj = 0; bj < 2; ++bj)
#pragma unroll
                    for (int n = 0; n < 2; ++n) acc[ai][bj][m][n] = acc[ai][bj][m][n] * f; }
    }
    __device__ __forceinline__ void operator()(const f32x4 (&acc)[2][2][4][2], const Unit& u, int wr, int wc, int fr, int fq) const {
        const int col0 = u.pn * BM + wc * 32 + 4 * fq;
#pragma unroll
        for (int ai = 0; ai < 2; ++ai)
#pragma unroll
            for (int m = 0; m < 4; ++m) { const int row = u.pm * BM + ai * HALF + wr * 64 + m * 16 + fr; bf16_t* sp = s + (size_t)row * ldc + col0; float ss = 0.f; const float rc = ftab[2048 + slot(u.pm) * 256 + ai * HALF + wr * 64 + m * 16 + fr];
                u32x2 in[2][2];
#pragma unroll
                for (int bj = 0; bj < 2; ++bj)
#pragma unroll
                    for (int n = 0; n < 2; ++n) in[bj][n] = *(const PG8_GAS u32x2*)(sp + bj * HALF + n * 16);
#pragma unroll
                for (int bj = 0; bj < 2; ++bj)
#pragma unroll
                    for (int n = 0; n < 2; ++n) { const u32x2 w0 = in[bj][n];
                        const f32x4 bs = (f32x4){__builtin_bit_cast(float, w0.x << 16), __builtin_bit_cast(float, w0.x & 0xffff0000u), __builtin_bit_cast(float, w0.y << 16), __builtin_bit_cast(float, w0.y & 0xffff0000u)};
                        const f32x4 o = bs + acc[ai][bj][m][n] * rc; ss += (o[0] * o[0] + o[1] * o[1]) + (o[2] * o[2] + o[3] * o[3]);
                        u32x2 w; w.x = cvt_pk_bf16(o[0], o[1]); w.y = cvt_pk_bf16(o[2], o[3]); *(PG8_GAS u32x2*)(sp + bj * HALF + n * 16) = w; }
                ss += shx(ss, 16, fr + 16 * fq); ss += shx(ss, 32, fr + 16 * fq);
                if (fq == 0) (void)__hip_atomic_fetch_add((PG8_GAS u64_t*)(rowsq + row), rowsq_fx(ss), __ATOMIC_RELAXED, __HIP_MEMORY_SCOPE_AGENT); }
    }
};
struct EpiBf16Row {
    static constexpr bool PERM = true, AFTER_DRAIN = false, KSCALE = false, I8 = false;
    bf16_t* O; int ldc; const u64_t* rowsq;
    __device__ __forceinline__ void operator()(const f32x4 (&acc)[2][2][4][2], const Unit& u, int wr, int wc, int fr, int fq) const {
        const int row0 = u.pm * BM + wr * 64 + fr, col0 = u.pn * BM + wc * 32 + 8 * fq;
#pragma unroll
        for (int ai = 0; ai < 2; ++ai)
#pragma unroll
            for (int m = 0; m < 4; ++m) { const int row = row0 + ai * HALF + m * 16; const float rs = rowsq_rs(rowsq, row); bf16_t* rowp = O + (size_t)row * ldc + col0;
#pragma unroll
                for (int bj = 0; bj < 2; ++bj) { const f32x4 v0 = acc[ai][bj][m][0] * rs, v1 = acc[ai][bj][m][1] * rs; u32x4 w; w.x = cvt_pk_bf16(v0[0], v0[1]); w.y = cvt_pk_bf16(v0[2], v0[3]); w.z = cvt_pk_bf16(v1[0], v1[1]); w.w = cvt_pk_bf16(v1[2], v1[3]);
                    *(PG8_GAS u32x4*)(rowp + bj * HALF) = w; } }
    }
};
struct EpiQKV {
    static constexpr bool PERM = false, AFTER_DRAIN = false, KSCALE = false, I8 = true;
    bf16_t* O; const float* ga; const float* gb; const float* gc; const PG8_LAS float* rope; const u64_t* rowsq; const float* xsc; const float* wsc;
    __device__ __forceinline__ void operator()(const f32x4 (&acc)[2][2][4][2], const Unit& u, int wr, int wc, int fr, int fq) const {
        const int hg = u.pn * 4 + wc;
        const float* g = nullptr; bool isq = false, dorope = false;
        if (hg < 12) { g = ga; isq = true; } else if (hg < 16) { g = ga + 64; } else if (hg < 20) { }
        else if (hg < 28) { g = gb; isq = true; } else if (hg < 36) { g = gb + 64; } else if (hg < 44) { }
        else if (hg < 56) { g = gc; isq = true; dorope = true; } else if (hg < 60) { g = gc + 64; dorope = true; }
        const float qs = isq ? 0.18033688011112042f : 1.0f;
        float rsxa[2][4]; f32x4 wv[2][2], gv[2][2];
#pragma unroll
        for (int ai = 0; ai < 2; ++ai)
#pragma unroll
            for (int m = 0; m < 4; ++m) { const int row = u.pm * BM + ai * HALF + wr * 64 + m * 16 + fr; rsxa[ai][m] = *(const PG8_GAS float*)(xsc + row); }
#pragma unroll
        for (int bj = 0; bj < 2; ++bj)
#pragma unroll
            for (int n = 0; n < 2; ++n) { wv[bj][n] = *(const PG8_GAS f32x4*)(wsc + hg * 64 + 32 * bj + 16 * n + 4 * fq); gv[bj][n] = g ? *(const PG8_GAS f32x4*)(g + 32 * bj + 16 * n + 4 * fq) : (f32x4){1.f, 1.f, 1.f, 1.f}; }
        __builtin_amdgcn_sched_barrier(0);
#pragma unroll
        for (int ai = 0; ai < 2; ++ai)
#pragma unroll
            for (int m = 0; m < 4; ++m) {
                const int row = u.pm * BM + ai * HALF + wr * 64 + m * 16 + fr;
                f32x4 v[2][2];
                const float rsx = rsxa[ai][m];
#pragma unroll
                for (int bj = 0; bj < 2; ++bj)
#pragma unroll
                    for (int n = 0; n < 2; ++n) { const i32x4 ia = __builtin_bit_cast(i32x4, acc[ai][bj][m][n]);
                        v[bj][n] = (f32x4){(float)ia[0], (float)ia[1], (float)ia[2], (float)ia[3]} * wv[bj][n] * rsx; }
                if (g) {
                    float ss = 0.f;
#pragma unroll
                    for (int bj = 0; bj < 2; ++bj)
#pragma unroll
                        for (int n = 0; n < 2; ++n) { const f32x4 x = v[bj][n]; ss += (x[0] * x[0] + x[1] * x[1]) + (x[2] * x[2] + x[3] * x[3]); }
                    ss += shx(ss, 16, fr + 16 * fq); ss += shx(ss, 32, fr + 16 * fq);
                    const float r = qs / sqrtf(ss * (1.0f / 64.0f) + 1e-6f);
#pragma unroll
                    for (int bj = 0; bj < 2; ++bj)
#pragma unroll
                        for (int n = 0; n < 2; ++n) v[bj][n] = v[bj][n] * gv[bj][n] * r;
                }
                if (dorope) {
                    const int t = row & 2047, pr = t >> 6, pc = t & 63;
#pragma unroll
                    for (int bj = 0; bj < 2; ++bj) {
                        const int pos = bj ? pc : pr;
                        const PG8_LAS float* rp = rope + (pos * 16 + 4 * fq) * 2;
                        const f32x4 c01 = *(const PG8_LAS f32x4*)rp, c23 = *(const PG8_LAS f32x4*)(rp + 4);
                        const f32x4 cs = (f32x4){c01[0], c01[2], c23[0], c23[2]}, sn = (f32x4){c01[1], c01[3], c23[1], c23[3]};
                        const f32x4 x1 = v[bj][0], x2 = v[bj][1];
                        v[bj][0] = x1 * cs - x2 * sn; v[bj][1] = x1 * sn + x2 * cs;
                    }
                }
                bf16_t* rowp = O + (size_t)row * 4096 + hg * 64 + 4 * fq;
#pragma unroll
                for (int bj = 0; bj < 2; ++bj)
#pragma unroll
                    for (int n = 0; n < 2; ++n) { u32x2 w; w.x = cvt_pk_bf16(v[bj][n][0], v[bj][n][1]); w.y = cvt_pk_bf16(v[bj][n][2], v[bj][n][3]); *(PG8_GAS u32x2*)(rowp + 32 * bj + 16 * n) = w; }
                asm volatile("" ::: "memory");
            }
    }
};
template <bool I8> __device__ __forceinline__ f32x4 mma16(const bf16x8 b, const bf16x8 a, const f32x4 c) {
    if constexpr (I8) return __builtin_bit_cast(f32x4, __builtin_amdgcn_mfma_i32_16x16x64_i8(__builtin_bit_cast(i32x4, b), __builtin_bit_cast(i32x4, a), __builtin_bit_cast(i32x4, c), 0, 0, 0));
    else return __builtin_amdgcn_mfma_f32_16x16x32_bf16(b, a, c, 0, 0, 0);
}
template <class Epi, class Sched, bool ALIGN_EPI = false, bool SP2 = false>
__device__ __forceinline__ void gemm_phase(PG8_LAS unsigned char* lds, const Gemm g, const Sched& S, const Epi& E, const int tid) {
    const int wid = __builtin_amdgcn_readfirstlane(tid >> 6), lane = tid & 63, wr = wid >> 2, wc = wid & 3, fr = lane & 15, fq = lane >> 4;
    const int K = g.K, nt = K / BK;
    unsigned voffA[2], voffB[2];
#pragma unroll
    for (int i = 0; i < 2; ++i) { int R, C; stage_rc(tid * 16 + i * 8192, R, C); const int Rb = Epi::PERM ? ((R & ~31) + perm32(R & 31)) : R;
        voffA[i] = (unsigned)(R * K + C) * 2u; voffB[i] = (unsigned)(Rb * K + C) * 2u; }
    const size_t kstep = (size_t)(BK * 2);
    const size_t hstep = (size_t)HALF * K * 2;
    const size_t tstep = 2 * hstep;
    const unsigned ldsw = (unsigned)wid * 1024u;
    const int aoff = lds_byte(wr * 64 + fr, fq * 8), boff = lds_byte(wc * 32 + fr, fq * 8);
#define PG8_SA(b, h) (((b) * 2 + (h)) * HTB)
#define PG8_SB(b, h) ((4 + (b) * 2 + (h)) * HTB)
#define PG8_STAGE(bufoff, gbase, voff) do { _Pragma("unroll") for (int _i = 0; _i < 2; ++_i) \
        __builtin_amdgcn_global_load_lds((const unsigned*)((const char*)(gbase) + (voff)[_i]), (PG8_LAS unsigned*)(lds + (bufoff) + ldsw + _i * 8192), 16, 0, 0); } while (0)
#define PG8_LDA(dst, b, h) do { _Pragma("unroll") for (int m = 0; m < 4; ++m) _Pragma("unroll") for (int k = 0; k < 2; ++k) dst[m][k] = *(const PG8_LAS bf16x8*)(lds + PG8_SA(b, h) + aoff + m * 2048 + k * 1024); } while (0)
#define PG8_LDB(dst, b, h) do { _Pragma("unroll") for (int n = 0; n < 2; ++n) _Pragma("unroll") for (int k = 0; k < 2; ++k) dst[n][k] = *(const PG8_LAS bf16x8*)(lds + PG8_SB(b, h) + boff + n * 2048 + k * 1024); } while (0)
#define PG8_MMA(ai, bj, At, Bt) do { __builtin_amdgcn_s_setprio(1); _Pragma("unroll") for (int m = 0; m < 4; ++m) _Pragma("unroll") for (int n = 0; n < 2; ++n) _Pragma("unroll") for (int k = 0; k < 2; ++k) \
        acc[ai][bj][m][n] = mma16<Epi::I8>(Bt[n][k], At[m][k], acc[ai][bj][m][n]); __builtin_amdgcn_s_setprio(0); } while (0)
#define PG8_WAIT_V(n) asm volatile("s_waitcnt vmcnt(" #n ")" ::: "memory")
#define PG8_WAIT_L(n) asm volatile("s_waitcnt lgkmcnt(" #n ")" ::: "memory")
#define PG8_BAR __builtin_amdgcn_s_barrier()
#define PG8_SCHED __builtin_amdgcn_sched_barrier(0)
    Unit cur, nxt; int ui = 0;
    if (!S.next(0, cur)) return;
    f32x4 acc[2][2][4][2];
#pragma unroll
    for (int a = 0; a < 2; ++a)
#pragma unroll
        for (int b = 0; b < 2; ++b)
#pragma unroll
            for (int m = 0; m < 4; ++m)
#pragma unroll
                for (int n = 0; n < 2; ++n) acc[a][b][m][n] = (f32x4){0.f, 0.f, 0.f, 0.f};
    bf16x8 At[4][2], B0[2][2], B1[2][2];
    const char* cA = (const char*)g.A + (size_t)cur.pm * tstep; const char* cB = (const char*)g.Bt + (size_t)cur.pn * tstep;
    S.a_ready(cur);
    if constexpr (SP2) {
        PG8_STAGE(PG8_SB(0, 0), cB, voffB); PG8_STAGE(PG8_SB(0, 1), cB + hstep, voffB); PG8_STAGE(PG8_SA(0, 0), cA, voffA); PG8_STAGE(PG8_SA(0, 1), cA + hstep, voffA);
        if (wr == 1) PG8_BAR;
        PG8_WAIT_V(2); PG8_BAR;
        PG8_STAGE(PG8_SB(1, 0), cB + kstep, voffB); PG8_STAGE(PG8_SA(1, 0), cA + kstep, voffA); PG8_STAGE(PG8_SB(1, 1), cB + hstep + kstep, voffB);
        PG8_WAIT_V(6); PG8_BAR;
    } else {
        PG8_STAGE(PG8_SB(0, 0), cB, voffB); PG8_STAGE(PG8_SA(0, 0), cA, voffA); PG8_STAGE(PG8_SB(0, 1), cB + hstep, voffB); PG8_STAGE(PG8_SA(0, 1), cA + hstep, voffA);
        if (wr == 1) PG8_BAR;
        PG8_WAIT_V(4); PG8_BAR;
        PG8_STAGE(PG8_SB(1, 0), cB + kstep, voffB); PG8_STAGE(PG8_SA(1, 0), cA + kstep, voffA); PG8_STAGE(PG8_SB(1, 1), cB + hstep + kstep, voffB);
        PG8_WAIT_V(6); PG8_BAR;
    }
    for (;;) {
        const bool has_next = S.next(ui + 1, nxt);
        const char* nA = has_next ? (const char*)g.A + (size_t)nxt.pm * tstep : cA; const char* nB = has_next ? (const char*)g.Bt + (size_t)nxt.pn * tstep : cB;
        for (int t = 0; t < nt; t += 2) {
            if constexpr (Epi::KSCALE) { if (t == Epi::KS0 || t == Epi::KS1) E.kscale(acc, cur, t == Epi::KS1 ? 1 : 0, wr, fr); }
            const bool last = (t == nt - 2);
            const char* a1 = cA + (size_t)(t + 1) * kstep;
            const char* a2 = last ? nA : cA + (size_t)(t + 2) * kstep; const char* b2 = last ? nB : cB + (size_t)(t + 2) * kstep;
            const char* a3 = a2 + kstep; const char* b3 = b2 + kstep;
            if (last && has_next) S.a_ready(nxt);
            if constexpr (SP2) {
            PG8_LDB(B0, 0, 0); PG8_LDB(B1, 0, 1); PG8_SCHED; PG8_LDA(At, 0, 0); PG8_STAGE(PG8_SA(1, 1), a1 + hstep, voffA);
            PG8_WAIT_V(8); PG8_WAIT_L(0); PG8_BAR; PG8_MMA(0, 0, At, B0); PG8_MMA(0, 1, At, B1); PG8_BAR; PG8_SCHED;
            PG8_LDA(At, 0, 1); PG8_STAGE(PG8_SB(0, 0), b2, voffB); PG8_STAGE(PG8_SB(0, 1), b2 + hstep, voffB); PG8_STAGE(PG8_SA(0, 0), a2, voffA);
            PG8_WAIT_V(8); PG8_WAIT_L(0); PG8_BAR; PG8_MMA(1, 0, At, B0); PG8_MMA(1, 1, At, B1); PG8_BAR; PG8_SCHED;
            PG8_LDB(B0, 1, 0); PG8_LDB(B1, 1, 1); PG8_SCHED; PG8_LDA(At, 1, 0); PG8_STAGE(PG8_SA(0, 1), a2 + hstep, voffA);
            PG8_WAIT_V(8); PG8_WAIT_L(0); PG8_BAR; PG8_MMA(0, 0, At, B0); PG8_MMA(0, 1, At, B1); PG8_BAR; PG8_SCHED;
            PG8_LDA(At, 1, 1); PG8_STAGE(PG8_SB(1, 0), b3, voffB); PG8_STAGE(PG8_SB(1, 1), b3 + hstep, voffB); PG8_STAGE(PG8_SA(1, 0), a3, voffA);
            PG8_WAIT_V(8); PG8_WAIT_L(0); PG8_BAR; PG8_MMA(1, 0, At, B0); PG8_MMA(1, 1, At, B1); PG8_BAR; PG8_SCHED;
            } else {
            PG8_LDB(B0, 0, 0); PG8_SCHED; PG8_LDA(At, 0, 0); PG8_STAGE(PG8_SA(1, 1), a1 + hstep, voffA);
            PG8_WAIT_L(8); PG8_BAR; PG8_WAIT_L(0); PG8_MMA(0, 0, At, B0); PG8_BAR; PG8_SCHED;
            PG8_LDB(B1, 0, 1); PG8_STAGE(PG8_SB(0, 0), b2, voffB);
            PG8_BAR; PG8_WAIT_L(0); PG8_MMA(0, 1, At, B1); PG8_BAR;
            PG8_LDA(At, 0, 1); PG8_STAGE(PG8_SA(0, 0), a2, voffA);
            PG8_BAR; PG8_WAIT_L(0); PG8_MMA(1, 0, At, B0); PG8_BAR; PG8_SCHED;
            PG8_STAGE(PG8_SB(0, 1), b2 + hstep, voffB);
            PG8_WAIT_V(6); PG8_BAR; PG8_MMA(1, 1, At, B1); PG8_BAR;
            PG8_LDB(B0, 1, 0); PG8_SCHED; PG8_LDA(At, 1, 0); PG8_STAGE(PG8_SA(0, 1), a2 + hstep, voffA);
            PG8_WAIT_L(8); PG8_BAR; PG8_WAIT_L(0); PG8_MMA(0, 0, At, B0); PG8_BAR; PG8_SCHED;
            PG8_LDB(B1, 1, 1); PG8_STAGE(PG8_SB(1, 0), b3, voffB);
            PG8_BAR; PG8_WAIT_L(0); PG8_MMA(0, 1, At, B1); PG8_BAR;
            PG8_LDA(At, 1, 1); PG8_STAGE(PG8_SA(1, 0), a3, voffA);
            PG8_BAR; PG8_WAIT_L(0); PG8_MMA(1, 0, At, B0); PG8_BAR; PG8_SCHED;
            PG8_STAGE(PG8_SB(1, 1), b3 + hstep, voffB);
            PG8_WAIT_V(6); PG8_BAR; PG8_MMA(1, 1, At, B1); PG8_BAR;
            }
        }
        if constexpr (ALIGN_EPI) { if (wr == 0) PG8_BAR; }
        if constexpr (!Epi::AFTER_DRAIN) { E(acc, cur, wr, wc, fr, fq); S.done(cur); }
        if (!has_next) break;
#pragma unroll
        for (int a = 0; a < 2; ++a)
#pragma unroll
            for (int b = 0; b < 2; ++b)
#pragma unroll
                for (int m = 0; m < 4; ++m)
#pragma unroll
                    for (int n = 0; n < 2; ++n) acc[a][b][m][n] = (f32x4){0.f, 0.f, 0.f, 0.f};
        cur = nxt; cA = nA; cB = nB; ++ui;
        if constexpr (ALIGN_EPI) { if (wr == 1) PG8_BAR; }
    }
    PG8_WAIT_V(0);
    if constexpr (!ALIGN_EPI) { if (wr == 0) PG8_BAR; }
    PG8_BAR;
    if constexpr (Epi::AFTER_DRAIN) { E.fused(acc, cur, wr, wc, fr, fq, lds, wid, lane); S.done(cur); }
#undef PG8_SA
#undef PG8_SB
#undef PG8_STAGE
#undef PG8_LDA
#undef PG8_LDB
#undef PG8_MMA
#undef PG8_WAIT_V
#undef PG8_WAIT_L
#undef PG8_BAR
#undef PG8_SCHED
}
}

constexpr int BATCH = 16, SEQ = 2048, DM = 2048, T = BATCH * SEQ, DEPTH = 2;
constexpr int NMEM = 256, DIN = 4096, MEMW = 512;
constexpr int PEER_H = 8, PEER_N = 16384;
constexpr int NWAVES = 8, NTHREADS = NWAVES * 64;
constexpr float EPS = 1e-6f;
constexpr int QA = 0, KA = 768, VA = 1024, QB = 1280, KB = 1792, VB = 2304, QC = 2816, KC = 3584, VC = 3840;
constexpr int OA = 0, OB = 768, OC = 1280;

constexpr size_t MiB = 1u << 20;
constexpr size_t WS_CTL = 0, CTL_ZERO_BYTES = 2 * MiB;
constexpr size_t WS_ROWSQ = 256 * 1024;
constexpr size_t WS_ROPE = 83 * MiB, WS_BIASA = 83 * MiB + 16384;
constexpr size_t WS_WIN = 2 * MiB, WS_WOUT = 34 * MiB, WS_WMQ = 50 * MiB, WS_WMKV = 54 * MiB, WS_WMO = 62 * MiB, WS_WPQ = 66 * MiB, WS_PKEYS = 82 * MiB;
constexpr size_t WS_MEMN = 84 * MiB, WS_KVM = 116 * MiB, WS_PU = 132 * MiB, WS_PV = 260 * MiB, WS_XN = 388 * MiB, WS_QKV = 516 * MiB, WS_ATT = 772 * MiB;
constexpr size_t WS_QM = 900 * MiB, WS_OM = 932 * MiB, WS_MIXSQ = 964 * MiB, MIXSQ_BYTES = 2 * MiB, WS_WIN8 = 966 * MiB, WS_WSC = 982 * MiB, WS_XSC = 982 * MiB + 65536, WS_XSC2 = 982 * MiB + 196608, WS_WSCO = 982 * MiB + 327680, WS_WSCP = 982 * MiB + 344064, WS_WSCM = 982 * MiB + 360448,
                 WS_WOUT8 = 984 * MiB, WS_WPQ8 = 992 * MiB, WS_WMQ8 = 1000 * MiB, WS_END = 1002 * MiB;
constexpr size_t WS_QP = WS_QKV, WS_PIDX = WS_QKV + 128 * MiB, WS_PGATE = WS_QKV + 144 * MiB, WS_PARTI = WS_QKV + 160 * MiB;
constexpr size_t WS_XQH = 836 * MiB, WS_XQL = 868 * MiB;
constexpr size_t WS_XQH_OLD = 900 * MiB, WS_XQL_OLD = 932 * MiB;
constexpr size_t WS_ATT8 = 900 * MiB;
constexpr size_t WS_X8 = 772 * MiB;
constexpr size_t WS_XN8 = 836 * MiB;
constexpr int CW_BAR = 4096;

constexpr int RING_OFF = 0, RING_BYTES = 131072;
constexpr int LDSCTL_OFF = RING_BYTES, MISC_OFF = LDSCTL_OFF + 320;
constexpr int LDS_BYTES = 147456;

#define GAS __attribute__((address_space(1)))
#define LAS __attribute__((address_space(3)))
typedef unsigned short bf16;
typedef unsigned v4u __attribute__((ext_vector_type(4)));
typedef unsigned v2u __attribute__((ext_vector_type(2)));
typedef float f32x4 __attribute__((ext_vector_type(4)));
typedef float f32x16 __attribute__((ext_vector_type(16)));
typedef short bf16x8 __attribute__((ext_vector_type(8)));
typedef GAS unsigned gu32;
#define LDS_WAIT() asm volatile("s_waitcnt lgkmcnt(0)" ::: "memory")
#define VM_WAIT() asm volatile("s_waitcnt vmcnt(0)" ::: "memory")
__device__ __forceinline__ unsigned f2bf(float f) { unsigned u = __builtin_bit_cast(unsigned, f); return (u + 0x7fffu + ((u >> 16) & 1u)) >> 16; }
__device__ __forceinline__ unsigned pk2(float lo, float hi) { return f2bf(lo) | (f2bf(hi) << 16); }
__device__ __forceinline__ float bflo(unsigned w) { return __builtin_bit_cast(float, w << 16); }
__device__ __forceinline__ float bfhi(unsigned w) { return __builtin_bit_cast(float, w & 0xffff0000u); }

__device__ __forceinline__ float shx(float v, int k, int lane) { return __builtin_bit_cast(float, __builtin_amdgcn_ds_bpermute((lane ^ k) << 2, __builtin_bit_cast(int, v))); }
#define XB_TMO      128
#define XB_XCNT(j)  (256  + 64 * (j))
#define XB_XSUB(j)  (1280 + 64 * (j))
#define XB_XGEN(j)  (2304 + 64 * (j))
#define XB_TOP      3328
#define XB_TOPGEN   3392
#define XCD_BAR_WORDS 3456
#define XB_SPIN_CAP (1u << 18)

__device__ __forceinline__ unsigned xb_ld(unsigned* p)              { return __hip_atomic_load(p, __ATOMIC_RELAXED, __HIP_MEMORY_SCOPE_AGENT); }
__device__ __forceinline__ unsigned xb_add(unsigned* p, unsigned v) { return __hip_atomic_fetch_add(p, v, __ATOMIC_RELAXED, __HIP_MEMORY_SCOPE_AGENT); }
__device__ __forceinline__ unsigned xb_xcc_id() { return (unsigned)__builtin_amdgcn_s_getreg((3 << 11) | 20) & 0xFu; }
#define XB_SPIN(cond, bar) do { unsigned _sp = 0; while (cond) { __builtin_amdgcn_s_sleep(1); \
    if ((++_sp & 255u) == 0u) { if (xb_ld(&(bar)[XB_TMO])) break; if (_sp > XB_SPIN_CAP) { atomicAdd(&(bar)[XB_TMO], 1u); break; } } } } while (0)

struct XcdBarrier {
    unsigned* bar; unsigned x;
    volatile LAS unsigned* st;
};

__device__ __forceinline__ XcdBarrier xcd_barrier_post(unsigned* bar, volatile LAS unsigned* st) {
    XcdBarrier b; b.bar = bar; b.x = xb_xcc_id(); b.st = st;
    if (threadIdx.x == 0) (void)xb_add(&bar[XB_XCNT(b.x)], 1u);
    return b;
}
__device__ __forceinline__ void xcd_barrier_complete(unsigned* bar, unsigned x, unsigned& nloc, unsigned& nx) {
    const unsigned G = gridDim.x * gridDim.y * gridDim.z;
    unsigned sum, cnt, mine, sp = 0u;
    for (;;) {
        sum = 0u; cnt = 0u; mine = 0u;
#pragma unroll
        for (unsigned j = 0; j < 16; ++j) { const unsigned c = xb_ld(&bar[XB_XCNT(j)]); sum += c; cnt += (c > 0u) ? 1u : 0u; mine = (j == x) ? c : mine; }
        if (sum == G) break;
        __builtin_amdgcn_s_sleep(1);
        if ((++sp & 255u) == 0u) { if (xb_ld(&bar[XB_TMO])) break; if (sp > XB_SPIN_CAP) { atomicAdd(&bar[XB_TMO], 1u); break; } }
    }
    nloc = mine > 0u ? mine : 1u; nx = cnt > 0u ? cnt : 1u;
}

__device__ __forceinline__ void xcd_barrier(const XcdBarrier& b) {
    asm volatile("s_waitcnt vmcnt(0)" ::: "memory");
    __syncthreads();
    if (threadIdx.x == 0) {
        unsigned* bar = b.bar;
        __builtin_amdgcn_s_waitcnt(0);
        unsigned nloc = b.st[0], nx = b.st[1];
        if (nloc == 0u) { xcd_barrier_complete(bar, b.x, nloc, nx); b.st[0] = nloc; b.st[1] = nx; }
        const unsigned old = xb_add(&bar[XB_XSUB(b.x)], 1u);
        const unsigned gen = old / nloc;
        if (old + 1u == (gen + 1u) * nloc) {
            __builtin_amdgcn_fence(__ATOMIC_RELEASE, "agent");
            asm volatile("s_waitcnt vmcnt(0)" ::: "memory");
            const unsigned og = xb_add(&bar[XB_TOP], 1u);
            const unsigned tg = og / nx;
            if (og + 1u == (tg + 1u) * nx) xb_add(&bar[XB_TOPGEN], 1u);
            else XB_SPIN(xb_ld(&bar[XB_TOPGEN]) == tg, bar);
            __builtin_amdgcn_fence(__ATOMIC_ACQUIRE, "agent");
            xb_add(&bar[XB_XGEN(b.x)], 1u);
            asm volatile("s_waitcnt vmcnt(0)" ::: "memory");
        } else {
            XB_SPIN(xb_ld(&bar[XB_XGEN(b.x)]) == gen, bar);
            __builtin_amdgcn_fence(__ATOMIC_ACQUIRE, "agent");
            asm volatile("s_waitcnt vmcnt(0)" ::: "memory");
        }
    }
    __syncthreads();
}

__device__ __forceinline__ float wave_sum(float v, int lane) {
#pragma unroll
    for (int o = 1; o < 64; o <<= 1) v += shx(v, o, lane);
    return v;
}
__device__ __forceinline__ void* ldptr(LAS unsigned char* lds, int i) {
    const unsigned long long v = ((const LAS unsigned long long*)(lds + LDSCTL_OFF + 1024))[i];
    const unsigned lo = __builtin_amdgcn_readfirstlane((unsigned)v), hi = __builtin_amdgcn_readfirstlane((unsigned)(v >> 32));
    return (void*)(((unsigned long long)hi << 32) | lo);
}
struct OffsetOrder {
    pg8::StaticOrder S;
    __device__ __forceinline__ void init(int M, int N, int G, int c, int off) { S.init(M, N, G, (c + G - off % G) % G); }
    __device__ __forceinline__ bool next(int i, pg8::Unit& u) const { return S.next(i, u); }
    __device__ __forceinline__ void a_ready(const pg8::Unit&) const {}
    __device__ __forceinline__ void done(const pg8::Unit&) const {}
};

template <bool PERMQKV>
__device__ __forceinline__ void transpose_item(const float* W, int K, int N, bf16* WT, LAS float* scr, int item, int lane, const float* gk = nullptr) {
    const int nblk = N / 32, kb = item / nblk, nb = item % nblk, k0 = 64 * kb, n0 = 32 * nb;
    int d0 = n0;
    if (PERMQKV) { const int within = n0 & 255; d0 = (n0 & ~255) + 128 * ((within >> 5) & 1) + 32 * (within >> 6); }
#pragma unroll
    for (int i = 0; i < 8; ++i) { const int kk = 8 * i + (lane >> 3), nn = 4 * (lane & 7);
        const f32x4 w4 = *(const GAS f32x4*)(W + (size_t)(k0 + kk) * N + n0 + nn) * (gk ? gk[k0 + kk] : 1.f);
        scr[kk * 33 + nn] = w4[0]; scr[kk * 33 + nn + 1] = w4[1]; scr[kk * 33 + nn + 2] = w4[2]; scr[kk * 33 + nn + 3] = w4[3]; }
    LDS_WAIT(); asm volatile("" ::: "memory");
    const int c = lane & 7;
#pragma unroll
    for (int j = 0; j < 4; ++j) { const int n = (lane >> 3) + 8 * j; const LAS float* s = scr + (8 * c) * 33 + n;
        v4u o; o.x = pk2(s[0 * 33], s[1 * 33]); o.y = pk2(s[2 * 33], s[3 * 33]); o.z = pk2(s[4 * 33], s[5 * 33]); o.w = pk2(s[6 * 33], s[7 * 33]);
        *(GAS v4u*)(WT + (size_t)(d0 + n) * K + k0 + 8 * c) = o; }
    LDS_WAIT(); asm volatile("" ::: "memory");
}
__device__ __forceinline__ void convert_bf16(const float* src, bf16* dst, size_t n, size_t gtid, size_t nthreads) {
    for (size_t i = gtid * 8; i < n; i += nthreads * 8) {
        const f32x4 a = *(const GAS f32x4*)(src + i), b = *(const GAS f32x4*)(src + i + 4);
        v4u o; o.x = pk2(a[0], a[1]); o.y = pk2(a[2], a[3]); o.z = pk2(b[0], b[1]); o.w = pk2(b[2], b[3]);
        *(GAS v4u*)(dst + i) = o;
    }
}
__device__ __forceinline__ int t5_bucket(int rel) {
    const int n = rel < 0 ? -rel : rel;
    const int b = n < 8 ? n : n < 12 ? 8 : n < 16 ? 9 : n < 23 ? 10 : n < 32 ? 11 : n < 46 ? 12 : n < 64 ? 13 : n < 91 ? 14 : 15;
    return b + (rel > 0 ? 16 : 0);
}
__constant__ float ROPE_INV[16] = {1.000000000e+00f, 5.623413324e-01f, 3.162277639e-01f, 1.778279394e-01f, 1.000000015e-01f, 5.623413250e-02f, 3.162277490e-02f, 1.778279431e-02f,
                                   9.999999776e-03f, 5.623413250e-03f, 3.162277630e-03f, 1.778279431e-03f, 1.000000047e-03f, 5.623413017e-04f, 3.162277571e-04f, 1.778279402e-04f};

__device__ __forceinline__ void rms_row_to_bf16(const float* xrow, const float* g0, bf16* o0, const float* g1, bf16* o1, int lane) {
    const GAS f32x4* xr = (const GAS f32x4*)xrow + lane;
    f32x4 v[8]; float s = 0.f;
#pragma unroll
    for (int j = 0; j < 8; ++j) { v[j] = xr[64 * j]; s += (v[j].x * v[j].x + v[j].y * v[j].y) + (v[j].z * v[j].z + v[j].w * v[j].w); }
    const float rstd = 1.f / sqrtf(wave_sum(s, lane) * (1.f / DM) + EPS);
    {   const GAS f32x4* gr = (const GAS f32x4*)g0 + lane; GAS v2u* o8 = (GAS v2u*)o0 + lane;
#pragma unroll
        for (int j = 0; j < 8; ++j) { const f32x4 gg = gr[64 * j]; v2u w; w.x = pk2(v[j].x * rstd * gg.x, v[j].y * rstd * gg.y); w.y = pk2(v[j].z * rstd * gg.z, v[j].w * rstd * gg.w); o8[64 * j] = w; } }
    if (g1) { const GAS f32x4* gr = (const GAS f32x4*)g1 + lane; GAS v2u* o8 = (GAS v2u*)o1 + lane;
#pragma unroll
        for (int j = 0; j < 8; ++j) { const f32x4 gg = gr[64 * j]; v2u w; w.x = pk2(v[j].x * rstd * gg.x, v[j].y * rstd * gg.y); w.y = pk2(v[j].z * rstd * gg.z, v[j].w * rstd * gg.w); o8[64 * j] = w; } }
}
__device__ __forceinline__ float wave_max(float v, int lane) {
#pragma unroll
    for (int o = 1; o < 64; o <<= 1) v = fmaxf(v, shx(v, o, lane));
    return v;
}
__device__ __forceinline__ unsigned q8x4(const f32x4 v, const float inv) {
    unsigned w = 0;
    w = __builtin_amdgcn_cvt_pk_u8_f32(__builtin_rintf(__builtin_fmaf(v[0], inv, 128.f)), 0, w); w = __builtin_amdgcn_cvt_pk_u8_f32(__builtin_rintf(__builtin_fmaf(v[1], inv, 128.f)), 1, w);
    w = __builtin_amdgcn_cvt_pk_u8_f32(__builtin_rintf(__builtin_fmaf(v[2], inv, 128.f)), 2, w); w = __builtin_amdgcn_cvt_pk_u8_f32(__builtin_rintf(__builtin_fmaf(v[3], inv, 128.f)), 3, w);
    return w ^ 0x80808080u;
}
__device__ __forceinline__ float amax4(const f32x4 v) { return fmaxf(fmaxf(fabsf(v[0]), fabsf(v[1])), fmaxf(fabsf(v[2]), fabsf(v[3]))); }
__device__ __forceinline__ void quant_wrow(const bf16* src, unsigned char* dst, float* step, int lane) {
    v4u w[4]; float am = 0.f;
#pragma unroll
    for (int j = 0; j < 4; ++j) w[j] = *(const GAS v4u*)(src + 8 * lane + 512 * j);
    f32x4 lo[4], hi[4];
#pragma unroll
    for (int j = 0; j < 4; ++j) { lo[j] = (f32x4){bflo(w[j].x), bfhi(w[j].x), bflo(w[j].y), bfhi(w[j].y)}; hi[j] = (f32x4){bflo(w[j].z), bfhi(w[j].z), bflo(w[j].w), bfhi(w[j].w)}; am = fmaxf(am, fmaxf(amax4(lo[j]), amax4(hi[j]))); }
    am = fmaxf(wave_max(am, lane), 1e-30f);
    const float inv = 127.f / am;
#pragma unroll
    for (int j = 0; j < 4; ++j) *(GAS v2u*)(dst + 8 * lane + 512 * j) = (v2u){q8x4(lo[j], inv), q8x4(hi[j], inv)};
    if (lane == 0) *step = am * (1.f / 127.f);
}
template <int R>
__device__ __forceinline__ void att_quant_rows(const bf16* ATT, const u64_t* mixsq, unsigned char* Q, float* step, int row0, int lane) {
    v4u w[R][4];
#pragma unroll
    for (int q = 0; q < R; ++q)
#pragma unroll
        for (int j = 0; j < 4; ++j) w[q][j] = *(const GAS v4u*)(ATT + (size_t)(row0 + q) * DM + 8 * lane + 512 * j);
#pragma unroll
    for (int q = 0; q < R; ++q) { const int row = row0 + q;
        const float ra = 1.0f / sqrtf((float)*(const GAS u64_t*)(mixsq + row) * (5.9604644775390625e-08f / 768.0f) + EPS), rb = 1.0f / sqrtf((float)*(const GAS u64_t*)(mixsq + T + row) * (5.9604644775390625e-08f / 512.0f) + EPS),
                    rc = 1.0f / sqrtf((float)*(const GAS u64_t*)(mixsq + 2 * (size_t)T + row) * (5.9604644775390625e-08f / 768.0f) + EPS);
        const float rj[4] = {ra, lane < 32 ? ra : rb, lane < 32 ? rb : rc, rc};
        f32x4 lo[4], hi[4]; float am = 0.f;
#pragma unroll
        for (int j = 0; j < 4; ++j) { lo[j] = (f32x4){bflo(w[q][j].x), bfhi(w[q][j].x), bflo(w[q][j].y), bfhi(w[q][j].y)} * rj[j]; hi[j] = (f32x4){bflo(w[q][j].z), bfhi(w[q][j].z), bflo(w[q][j].w), bfhi(w[q][j].w)} * rj[j]; am = fmaxf(am, fmaxf(amax4(lo[j]), amax4(hi[j]))); }
        am = fmaxf(wave_max(am, lane), 1e-30f);
        const float inv = 127.f / am;
#pragma unroll
        for (int j = 0; j < 4; ++j) *(GAS v2u*)(Q + (size_t)row * DM + 8 * lane + 512 * j) = (v2u){q8x4(lo[j], inv), q8x4(hi[j], inv)};
        if (lane == 0) step[row] = am * (1.f / 127.f); }
}
__device__ __forceinline__ void prep_rows2(const float* x0, bf16* o0, u64_t* sq, unsigned char* q0, float* qstep, int lane) {
    f32x4 v[2][8];
#pragma unroll
    for (int q = 0; q < 2; ++q) { const GAS f32x4* xr = (const GAS f32x4*)(x0 + (size_t)q * DM) + lane;
#pragma unroll
        for (int j = 0; j < 8; ++j) v[q][j] = xr[64 * j]; }
#pragma unroll
    for (int q = 0; q < 2; ++q) { GAS v2u* o8 = (GAS v2u*)(o0 + (size_t)q * DM) + lane; float s = 0.f;
#pragma unroll
        for (int j = 0; j < 8; ++j) { const f32x4 a = v[q][j]; s += (a.x * a.x + a.y * a.y) + (a.z * a.z + a.w * a.w); v2u w; w.x = pk2(a.x, a.y); w.y = pk2(a.z, a.w); o8[64 * j] = w; }
        s = wave_sum(s, lane);
        float am = 0.f;
#pragma unroll
        for (int j = 0; j < 8; ++j) am = fmaxf(am, amax4(v[q][j]));
        am = fmaxf(wave_max(am, lane), 1e-30f);
        const float inv = 127.f / am;
#pragma unroll
        for (int j = 0; j < 8; ++j) *(GAS unsigned*)(q0 + (size_t)q * DM + 4 * lane + 256 * j) = q8x4(v[q][j], inv);
        if (lane == 0) { sq[q] = rowsq_fx(s); qstep[q] = am * (1.f / 127.f) / sqrtf(s * (1.f / DM) + 1e-6f); } }
}
__device__ __forceinline__ void norm_rows(const float* X, const float* g, bf16* XN, int gw, int NGW, int lane) {
    for (int m = gw; m < T; m += NGW) rms_row_to_bf16(X + (size_t)m * DM, g, XN + (size_t)m * DM, nullptr, nullptr, lane);
}

template <int TYPE>
__device__ __forceinline__ void naive_attn_item(const bf16* QKV, bf16* ATT, int b, int grow, int head, int lane, const float* biasA, const float* sink, const float* rpb) {
    const int tpos = grow * 64 + lane; const size_t trow = (size_t)b * SEQ + tpos;
    int qcol, kcol, vcol, ocol;
    if (TYPE == 0) { qcol = QA + head * 64; kcol = KA + (head / 3) * 64; vcol = VA + (head / 3) * 64; ocol = OA + head * 64; }
    else if (TYPE == 1) { qcol = QB + head * 64; kcol = KB + head * 64; vcol = VB + head * 64; ocol = OB + head * 64; }
    else { qcol = QC + head * 64; kcol = KC + (head / 3) * 64; vcol = VC + (head / 3) * 64; ocol = OC + head * 64; }
    float q[64], o[64];
#pragma unroll
    for (int c = 0; c < 8; ++c) { const v4u w = *(const GAS v4u*)(QKV + trow * DIN + qcol + 8 * c);
        q[8 * c + 0] = bflo(w.x); q[8 * c + 1] = bfhi(w.x); q[8 * c + 2] = bflo(w.y); q[8 * c + 3] = bfhi(w.y); q[8 * c + 4] = bflo(w.z); q[8 * c + 5] = bfhi(w.z); q[8 * c + 6] = bflo(w.w); q[8 * c + 7] = bfhi(w.w); }
#pragma unroll
    for (int d = 0; d < 64; ++d) o[d] = 0.f;
    float m = -1e30f, l = 0.f;
    int j0, j1;
    if (TYPE == 0) { j0 = grow * 64 - 128; if (j0 < 0) j0 = 0; j1 = grow * 64 + 63 + 128; if (j1 > SEQ - 1) j1 = SEQ - 1; }
    else if (TYPE == 1) { int r0 = grow - 4; r0 = r0 < 0 ? 0 : (r0 > 24 ? 24 : r0); j0 = r0 * 64; j1 = j0 + 511; }
    else { j0 = 0; j1 = SEQ - 1; }
    int c0 = lane - 8; c0 = c0 < 0 ? 0 : (c0 > 48 ? 48 : c0);
#pragma unroll 1
    for (int j = j0; j <= j1; ++j) {
        const bf16* krow = QKV + ((size_t)b * SEQ + j) * DIN;
        float s = 0.f;
#pragma unroll
        for (int c = 0; c < 8; ++c) { const v4u w = *(const GAS v4u*)(krow + kcol + 8 * c);
            s += q[8 * c + 0] * bflo(w.x) + q[8 * c + 1] * bfhi(w.x) + q[8 * c + 2] * bflo(w.y) + q[8 * c + 3] * bfhi(w.y) + q[8 * c + 4] * bflo(w.z) + q[8 * c + 5] * bfhi(w.z) + q[8 * c + 6] * bflo(w.w) + q[8 * c + 7] * bfhi(w.w); }
        bool valid = true;
        if (TYPE == 0) { const int rel = j - tpos; valid = (rel >= -128 && rel <= 128); if (valid) s += biasA[head * 257 + rel + 128]; }
        if (TYPE == 1) { const int kr = j >> 6, kc = j & 63; valid = (kc >= c0 && kc < c0 + 16); if (valid) s += rpb[(head * 15 + (kr - grow + 7)) * 31 + (kc - lane + 15)]; }
        const float mn = valid ? fmaxf(m, s) : m;
        const float a = __expf(m - mn);
        const float p = valid ? __expf(s - mn) : 0.f;
        l = l * a + p; m = mn;
#pragma unroll
        for (int c = 0; c < 8; ++c) { const v4u w = *(const GAS v4u*)(krow + vcol + 8 * c);
            o[8 * c + 0] = o[8 * c + 0] * a + p * bflo(w.x); o[8 * c + 1] = o[8 * c + 1] * a + p * bfhi(w.x); o[8 * c + 2] = o[8 * c + 2] * a + p * bflo(w.y); o[8 * c + 3] = o[8 * c + 3] * a + p * bfhi(w.y);
            o[8 * c + 4] = o[8 * c + 4] * a + p * bflo(w.z); o[8 * c + 5] = o[8 * c + 5] * a + p * bfhi(w.z); o[8 * c + 6] = o[8 * c + 6] * a + p * bflo(w.w); o[8 * c + 7] = o[8 * c + 7] * a + p * bfhi(w.w); }
    }
    if (TYPE == 0) l += __expf(sink[head] - m);
    const float inv = 1.f / l;
#pragma unroll
    for (int c = 0; c < 8; ++c) { v4u w; w.x = pk2(o[8 * c + 0] * inv, o[8 * c + 1] * inv); w.y = pk2(o[8 * c + 2] * inv, o[8 * c + 3] * inv); w.z = pk2(o[8 * c + 4] * inv, o[8 * c + 5] * inv); w.w = pk2(o[8 * c + 6] * inv, o[8 * c + 7] * inv);
        *(GAS v4u*)(ATT + trow * DM + ocol + 8 * c) = w; }
}
__device__ __forceinline__ float rdl(float v, int l) { return __builtin_bit_cast(float, __builtin_amdgcn_readlane(__builtin_bit_cast(int, v), l)); }
__device__ __forceinline__ void naive_mem_item(const bf16* QM, const bf16* KVM, bf16* OM, const float* gq, size_t trow, int b, int head, int lane) {
    const unsigned qw = *(const GAS unsigned*)(QM + trow * MEMW + head * 128 + 2 * lane);
    float q0 = bflo(qw), q1 = bfhi(qw);
    const float ss = wave_sum(q0 * q0 + q1 * q1, lane);
    const float r = 0.08838834764831845f / sqrtf(ss * (1.f / 128.f) + EPS);
    q0 *= r * gq[2 * lane]; q1 *= r * gq[2 * lane + 1];
    const bf16* kbase = KVM + ((size_t)b * NMEM + lane) * 1024 + head * 128;
    float s[4] = {0.f, 0.f, 0.f, 0.f};
#pragma unroll 1
    for (int c = 0; c < 16; ++c) {
        float qa[8];
#pragma unroll
        for (int e = 0; e < 4; ++e) { qa[2 * e] = rdl(q0, 4 * c + e); qa[2 * e + 1] = rdl(q1, 4 * c + e); }
#pragma unroll
        for (int i = 0; i < 4; ++i) { const v4u w = *(const GAS v4u*)(kbase + (size_t)i * 64 * 1024 + 8 * c);
            s[i] += qa[0] * bflo(w.x) + qa[1] * bfhi(w.x) + qa[2] * bflo(w.y) + qa[3] * bfhi(w.y) + qa[4] * bflo(w.z) + qa[5] * bfhi(w.z) + qa[6] * bflo(w.w) + qa[7] * bfhi(w.w); }
    }
    float m = fmaxf(fmaxf(s[0], s[1]), fmaxf(s[2], s[3]));
#pragma unroll
    for (int o = 1; o < 64; o <<= 1) m = fmaxf(m, shx(m, o, lane));
    float p[4]; float l = 0.f;
#pragma unroll
    for (int i = 0; i < 4; ++i) { p[i] = __expf(s[i] - m); l += p[i]; }
    l = wave_sum(l, lane);
    const bf16* vbase = KVM + ((size_t)b * NMEM) * 1024 + 512 + head * 128 + 2 * lane;
    float o0 = 0.f, o1 = 0.f;
#pragma unroll
    for (int i = 0; i < 4; ++i) {
#pragma unroll 4
        for (int jj = 0; jj < 64; ++jj) { const float pj = rdl(p[i], jj); const unsigned w = *(const GAS unsigned*)(vbase + (size_t)(64 * i + jj) * 1024); o0 += pj * bflo(w); o1 += pj * bfhi(w); }
    }
    const float inv = 1.f / l;
    *(GAS unsigned*)(OM + trow * MEMW + head * 128 + 2 * lane) = pk2(o0 * inv, o1 * inv);
}
__device__ __forceinline__ void mixnorm_rows(bf16* ATT, const float* g, int gw, int NGW, int lane) {
    for (int m = gw; m < T; m += NGW) {
        GAS v4u* p = (GAS v4u*)(ATT + (size_t)m * DM + 32 * lane);
        v4u w[4]; float f[32]; float ss = 0.f;
#pragma unroll
        for (int c = 0; c < 4; ++c) { w[c] = p[c];
            f[8 * c + 0] = bflo(w[c].x); f[8 * c + 1] = bfhi(w[c].x); f[8 * c + 2] = bflo(w[c].y); f[8 * c + 3] = bfhi(w[c].y); f[8 * c + 4] = bflo(w[c].z); f[8 * c + 5] = bfhi(w[c].z); f[8 * c + 6] = bflo(w[c].w); f[8 * c + 7] = bfhi(w[c].w); }
#pragma unroll
        for (int i = 0; i < 32; ++i) ss += f[i] * f[i];
        const int grp = lane < 24 ? 0 : (lane < 40 ? 1 : 2);
        const float sa = wave_sum(grp == 0 ? ss : 0.f, lane), sb = wave_sum(grp == 1 ? ss : 0.f, lane), sc = wave_sum(grp == 2 ? ss : 0.f, lane);
        const float r = grp == 0 ? 1.f / sqrtf(sa * (1.f / 768.f) + EPS) : (grp == 1 ? 1.f / sqrtf(sb * (1.f / 512.f) + EPS) : 1.f / sqrtf(sc * (1.f / 768.f) + EPS));
        const float* gg = g + 32 * lane;
#pragma unroll
        for (int c = 0; c < 4; ++c) { const f32x4 g0 = *(const GAS f32x4*)(gg + 8 * c), g1 = *(const GAS f32x4*)(gg + 8 * c + 4);
            v4u o; o.x = pk2(f[8 * c + 0] * r * g0[0], f[8 * c + 1] * r * g0[1]); o.y = pk2(f[8 * c + 2] * r * g0[2], f[8 * c + 3] * r * g0[3]);
            o.z = pk2(f[8 * c + 4] * r * g1[0], f[8 * c + 5] * r * g1[1]); o.w = pk2(f[8 * c + 6] * r * g1[2], f[8 * c + 7] * r * g1[3]); p[c] = o; }
    }
}

#ifndef PEER_HD
#define PEER_HD __device__ __forceinline__
#define PEER_EXP(x) __expf(x)
#endif
template <int N> PEER_HD void bitonic_sort_desc(float* v) {
#pragma unroll
    for (int k = 2; k <= N; k <<= 1)
#pragma unroll
        for (int j = k >> 1; j > 0; j >>= 1)
#pragma unroll
            for (int i = 0; i < N; ++i) { const int l = i ^ j; if (l > i) { const bool desc = ((i & k) == 0); const float a = v[i], b = v[l]; const float hi = fmaxf(a, b), lo = fminf(a, b);
                v[i] = desc ? hi : lo; v[l] = desc ? lo : hi; } }
}
#define PEER_CE(i, j) do { const float x_ = v[i], y_ = v[j]; v[i] = fmaxf(x_, y_); v[j] = fminf(x_, y_); } while (0)
PEER_HD void sort16_desc(float* v) {
    PEER_CE(0,13); PEER_CE(1,12); PEER_CE(2,15); PEER_CE(3,14); PEER_CE(4,8); PEER_CE(5,6); PEER_CE(7,11); PEER_CE(9,10);
    PEER_CE(0,5); PEER_CE(1,7); PEER_CE(2,9); PEER_CE(3,4); PEER_CE(6,13); PEER_CE(8,14); PEER_CE(10,15); PEER_CE(11,12);
    PEER_CE(0,1); PEER_CE(2,3); PEER_CE(4,5); PEER_CE(6,8); PEER_CE(7,9); PEER_CE(10,11); PEER_CE(12,13); PEER_CE(14,15);
    PEER_CE(0,2); PEER_CE(1,3); PEER_CE(4,10); PEER_CE(5,11); PEER_CE(6,7); PEER_CE(8,9); PEER_CE(12,14); PEER_CE(13,15);
    PEER_CE(1,2); PEER_CE(3,12); PEER_CE(4,6); PEER_CE(5,7); PEER_CE(8,10); PEER_CE(9,11); PEER_CE(13,14);
    PEER_CE(1,4); PEER_CE(2,6); PEER_CE(5,8); PEER_CE(7,10); PEER_CE(9,13); PEER_CE(11,14);
    PEER_CE(2,4); PEER_CE(3,6); PEER_CE(9,12); PEER_CE(11,13);
    PEER_CE(3,5); PEER_CE(6,8); PEER_CE(7,9); PEER_CE(10,12);
    PEER_CE(3,4); PEER_CE(5,6); PEER_CE(7,8); PEER_CE(9,10); PEER_CE(11,12);
    PEER_CE(6,7); PEER_CE(8,9);
}
PEER_HD void sort6_desc(float* v) {
    PEER_CE(0,5); PEER_CE(1,3); PEER_CE(2,4); PEER_CE(1,2); PEER_CE(3,4); PEER_CE(0,3); PEER_CE(2,5); PEER_CE(0,1); PEER_CE(2,3); PEER_CE(4,5); PEER_CE(1,2); PEER_CE(3,4);
}
PEER_HD void merge_top16(float* a, const float* b) {
    float c[16];
#pragma unroll
    for (int i = 0; i < 16; ++i) c[i] = fmaxf(a[i], b[15 - i]);
#pragma unroll
    for (int j = 8; j > 0; j >>= 1)
#pragma unroll
        for (int i = 0; i < 16; ++i) { const int l = i ^ j; if (l > i) { const float x = c[i], y = c[l]; c[i] = fmaxf(x, y); c[l] = fminf(x, y); } }
#pragma unroll
    for (int i = 0; i < 16; ++i) a[i] = c[i];
}
PEER_HD void top16_of_64(float (&v)[64]) {
    sort16_desc(&v[0]); sort16_desc(&v[16]); sort16_desc(&v[32]); sort16_desc(&v[48]);
    merge_top16(&v[0], &v[16]); merge_top16(&v[32], &v[48]); merge_top16(&v[0], &v[32]);
}
PEER_HD float pack_idx(float s, unsigned idx, unsigned mask) { return __builtin_bit_cast(float, (__builtin_bit_cast(unsigned, s) & ~mask) | idx); }
PEER_HD unsigned low_bits(float s, unsigned mask) { return __builtin_bit_cast(unsigned, s) & mask; }
PEER_HD unsigned pick16(const float* a, unsigned i, unsigned mask) {
    unsigned r = 0;
#pragma unroll
    for (unsigned k = 0; k < 16; ++k) r = (i == k) ? low_bits(a[k], mask) : r;
    return r;
}
PEER_HD void peer_candidates(const float* a, const float* b, int* e, float* gate) {
    const float NEG = -3.0e38f;
#define PEER_S(i, j) pack_idx(a[i] + b[j], (unsigned)((i) * 16 + (j)), 0xffu)
    float r0[16], r1[16], c0[16], c1[16], z[16];
#pragma unroll
    for (int j = 0; j < 16; ++j) { r0[j] = PEER_S(0, j); r1[j] = j < 8 ? PEER_S(1, j) : NEG; c0[j] = j < 14 ? PEER_S(j + 2 < 16 ? j + 2 : 15, 0) : NEG; c1[j] = j < 6 ? PEER_S(j + 2 < 16 ? j + 2 : 15, 1) : NEG; z[j] = NEG; }
    z[0] = PEER_S(2, 2); z[1] = PEER_S(2, 3); z[2] = PEER_S(2, 4); z[3] = PEER_S(3, 2); z[4] = PEER_S(3, 3); z[5] = PEER_S(4, 2);
#undef PEER_S
    sort6_desc(z);
    merge_top16(c1, z); merge_top16(c0, c1); merge_top16(r0, r1);
    float c[16];
#pragma unroll
    for (int i = 0; i < 16; ++i) c[i] = fmaxf(r0[i], c0[15 - i]);
    float mx = c[0], den = 0.f;
#pragma unroll
    for (int k = 0; k < 16; ++k) { const unsigned id = low_bits(c[k], 0xffu); const unsigned n0 = pick16(a, id >> 4, 0x7fu), n1 = pick16(b, id & 15u, 0x7fu);
        e[k] = (int)(n0 * 128u + n1); gate[k] = PEER_EXP(c[k] - mx); den += gate[k]; }
    const float inv = 1.f / den;
#pragma unroll
    for (int k = 0; k < 16; ++k) gate[k] *= inv;
}

__device__ __forceinline__ void peer_select_unit(const bf16* QP, const bf16* PK, int* PIDX, float* PGATE, int tb, int h, int wave, int lane, LAS unsigned char* lds) {
    const int hh = lane >> 5, tl = lane & 31; const size_t t = (size_t)tb * 256 + wave * 32 + tl;
    __syncthreads();
    {   const int tid = wave * 64 + lane; const bf16* src = PK + (size_t)h * 256 * 128;
#pragma unroll 1
        for (int i0 = 0; i0 < 8; i0 += 4) { v4u st[4];
#pragma unroll
            for (int i = 0; i < 4; ++i) st[i] = *(const GAS v4u*)(src + (size_t)(tid + 512 * (i0 + i)) * 8);
#pragma unroll
            for (int i = 0; i < 4; ++i) { const int c = tid + 512 * (i0 + i), row = c >> 4, ch = c & 15; *(LAS v4u*)(lds + row * 256 + ((ch ^ (row & 15)) * 16)) = st[i]; } } }
    __syncthreads();
    float ab[2][16];
#pragma unroll
    for (int p = 0; p < 2; ++p) {
        bf16x8 bq[8];
#pragma unroll
        for (int s = 0; s < 8; ++s) bq[s] = *(const GAS bf16x8*)(QP + t * DM + 256 * h + 128 * p + 16 * s + 8 * hh);
        float v[64];
#pragma unroll
        for (int nb = 0; nb < 4; ++nb) {
            f32x16 acc;
#pragma unroll
            for (int r = 0; r < 16; ++r) acc[r] = 0.f;
            const int krow = p * 128 + 32 * nb + tl;
            bf16x8 ak[8];
#pragma unroll
            for (int s = 0; s < 8; ++s) ak[s] = *(const LAS bf16x8*)(lds + krow * 256 + (((2 * s + hh) ^ (krow & 15)) * 16));
#pragma unroll
            for (int s = 0; s < 8; ++s) acc = __builtin_amdgcn_mfma_f32_32x32x16_bf16(ak[s], bq[s], acc, 0, 0, 0);
#pragma unroll
            for (int r = 0; r < 16; ++r) v[16 * nb + r] = pack_idx(acc[r], (unsigned)(32 * nb + 8 * (r >> 2) + 4 * hh + (r & 3)), 0x7fu);
        }
        top16_of_64(v);
        float pv[16];
#pragma unroll
        for (int i = 0; i < 16; ++i) pv[i] = shx(v[i], 32, lane);
        merge_top16(&v[0], pv);
#pragma unroll
        for (int i = 0; i < 16; ++i) ab[p][i] = v[i];
    }
    int e[16]; float gate[16];
    peer_candidates(ab[0], ab[1], e, gate);
    if (hh == 0) { GAS v4u* o = (GAS v4u*)(PIDX + t * 128 + h * 16);
#pragma unroll
        for (int c = 0; c < 4; ++c) o[c] = (v4u){(unsigned)e[4 * c], (unsigned)e[4 * c + 1], (unsigned)e[4 * c + 2], (unsigned)e[4 * c + 3]}; }
    else { GAS f32x4* o = (GAS f32x4*)(PGATE + t * 128 + h * 16);
#pragma unroll
        for (int c = 0; c < 4; ++c) o[c] = (f32x4){gate[4 * c], gate[4 * c + 1], gate[4 * c + 2], gate[4 * c + 3]}; }
}

typedef float f32x2 __attribute__((ext_vector_type(2)));
typedef unsigned v6u __attribute__((ext_vector_type(6)));
typedef float v32f __attribute__((ext_vector_type(32)));
typedef v4u __attribute__((aligned(8))) v4u_a8;
constexpr float PU_SCALE6 = 90.0f, PV_SCALE6 = 5.65f;
__device__ __forceinline__ unsigned enc_e2m3(float v) {
    const float a = fminf(fabsf(v), 7.5f);
    unsigned code;
    if (a < 1.0f) code = (unsigned)__builtin_rintf(a * 8.f);
    else { const unsigned b = __builtin_bit_cast(unsigned, a) - 0x3F800000u; code = ((b + 0x7FFFFu + ((b >> 20) & 1u)) >> 20) + 8u; }
    return code | (v < 0.f ? 32u : 0u);
}
__device__ __forceinline__ void convert_fp6_rows(const float* src, unsigned char* dst, int nrows, float scale, const float* gain, int gw, int NGW, int lane) {
    for (int r = gw; r < nrows; r += NGW) {
        const float* sp = src + (size_t)r * DM + 4 * lane; const float* gp = gain ? gain + (size_t)(r / PEER_N) * DM + 4 * lane : nullptr;
        unsigned w[6] = {0u, 0u, 0u, 0u, 0u, 0u};
#pragma unroll
        for (int j = 0; j < 8; ++j) { f32x4 a = *(const GAS f32x4*)(sp + 256 * j) * scale; if (gp) a = a * *(const GAS f32x4*)(gp + 256 * j);
#pragma unroll
            for (int e = 0; e < 4; ++e) { const unsigned code = enc_e2m3(a[e]); const int bp = 6 * (4 * j + e), wi = bp >> 5, sh = bp & 31;
                w[wi] |= code << sh; if (sh > 26) w[wi + 1] |= code >> (32 - sh); } }
        unsigned char* dp = dst + (size_t)r * 1536 + 24 * lane;
        *(GAS v4u_a8*)dp = (v4u){w[0], w[1], w[2], w[3]}; *(GAS v2u*)(dp + 16) = (v2u){w[4], w[5]};
    }
}
constexpr float PV_SCALE4 = 5.65f, PU_SCALE4 = 90.0f;
__device__ __forceinline__ unsigned enc_e2m1(float v) {
    const float a = fabsf(v);
    const unsigned code = a < 0.25f ? 0u : a < 0.75f ? 1u : a < 1.25f ? 2u : a < 1.75f ? 3u : a < 2.5f ? 4u : a < 3.5f ? 5u : a < 5.0f ? 6u : 7u;
    return code | (v < 0.f ? 8u : 0u);
}
__device__ __forceinline__ void convert_fp4_rows(const float* src, unsigned char* dst, int nrows, float scale, const float* gain, int gw, int NGW, int lane) {
    for (int r0 = 2 * gw; r0 < nrows; r0 += 2 * NGW) {
        f32x4 a[2][8];
#pragma unroll
        for (int q = 0; q < 2; ++q) { const float* sp = src + (size_t)(r0 + q) * DM + 4 * lane;
#pragma unroll
            for (int j = 0; j < 8; ++j) a[q][j] = *(const GAS f32x4*)(sp + 256 * j); }
#pragma unroll
        for (int q = 0; q < 2; ++q) { const int r = r0 + q; const float* gp = gain ? gain + (size_t)(r / PEER_N) * DM + 4 * lane : nullptr;
            unsigned w[4] = {0u, 0u, 0u, 0u};
#pragma unroll
            for (int j = 0; j < 8; ++j) { f32x4 v = a[q][j] * scale; if (gp) v = v * *(const GAS f32x4*)(gp + 256 * j);
#pragma unroll
                for (int e = 0; e < 4; ++e) { const int i = 4 * j + e; w[i >> 3] |= enc_e2m1(v[e]) << (4 * (i & 7)); } }
            *(GAS v4u*)(dst + (size_t)r * 1024 + 16 * lane) = (v4u){w[0], w[1], w[2], w[3]}; }
    }
}
#define PG4_LOAD(buf, tab, idlo, idhi, g) do { _Pragma("unroll") for (int i_ = 0; i_ < PG6_R; ++i_) { const int k_ = (g) * PG6_R + i_; \
        const int e_ = __builtin_amdgcn_readlane(k_ < 64 ? idlo : idhi, k_ & 63); buf[i_] = __builtin_amdgcn_raw_buffer_load_b128(tab, (int)voff4, e_ * 1024, 0); } } while (0)
#define PG4_DOT1(buf, i_, dst) do { f32x2 a_ = {0.f, 0.f}; _Pragma("unroll") for (int c_ = 0; c_ < 4; ++c_) { const unsigned u_ = buf[i_][c_]; \
        a_ += __builtin_amdgcn_cvt_scalef32_pk_f32_fp4(u_, 1.0f, 0) * x[4 * c_ + 0]; a_ += __builtin_amdgcn_cvt_scalef32_pk_f32_fp4(u_, 1.0f, 1) * x[4 * c_ + 1]; \
        a_ += __builtin_amdgcn_cvt_scalef32_pk_f32_fp4(u_, 1.0f, 2) * x[4 * c_ + 2]; a_ += __builtin_amdgcn_cvt_scalef32_pk_f32_fp4(u_, 1.0f, 3) * x[4 * c_ + 3]; } dst = a_.x + a_.y; __builtin_amdgcn_sched_barrier(0); } while (0)
#define PG4_DOT(buf, g) do { float p_[8]; _Pragma("unroll") for (int i_ = 0; i_ < 8; ++i_) PG4_DOT1(buf, i_, p_[i_]); \
        float q_[4]; _Pragma("unroll") for (int i_ = 0; i_ < 4; ++i_) { const float keep_ = b5 ? p_[i_ + 4] : p_[i_], send_ = b5 ? p_[i_] : p_[i_ + 4]; q_[i_] = keep_ + shx(send_, 32, lane); } \
        float r_[2]; _Pragma("unroll") for (int i_ = 0; i_ < 2; ++i_) { const float keep_ = b4 ? q_[i_ + 2] : q_[i_], send_ = b4 ? q_[i_] : q_[i_ + 2]; r_[i_] = keep_ + shx(send_, 16, lane); } \
        float s_; { const float keep_ = b3 ? r_[1] : r_[0], send_ = b3 ? r_[0] : r_[1]; s_ = keep_ + shx(send_, 8, lane); } \
        s_ += shx(s_, 4, lane); s_ += shx(s_, 2, lane); s_ += shx(s_, 1, lane); \
        if ((lane & 7) == 0) wl[(g) * 8 + (lane >> 3)] = s_; } while (0)
#define PG4_AXPY(buf, g) do { _Pragma("unroll") for (int i_ = 0; i_ < PG6_R; ++i_) { const float w_ = wl[(g) * PG6_R + i_]; const f32x2 wv_ = {w_, w_}; \
        _Pragma("unroll") for (int c_ = 0; c_ < 4; ++c_) { const unsigned u_ = buf[i_][c_]; \
            y[4 * c_ + 0] += __builtin_amdgcn_cvt_scalef32_pk_f32_fp4(u_, 1.0f, 0) * wv_; y[4 * c_ + 1] += __builtin_amdgcn_cvt_scalef32_pk_f32_fp4(u_, 1.0f, 1) * wv_; \
            y[4 * c_ + 2] += __builtin_amdgcn_cvt_scalef32_pk_f32_fp4(u_, 1.0f, 2) * wv_; y[4 * c_ + 3] += __builtin_amdgcn_cvt_scalef32_pk_f32_fp4(u_, 1.0f, 3) * wv_; } \
        __builtin_amdgcn_sched_barrier(0); } } while (0)
#ifndef PG6_R
#define PG6_R 8
#endif
#define PG6_LOAD(buf, tab, idlo, idhi, g) do { _Pragma("unroll") for (int i_ = 0; i_ < PG6_R; ++i_) { const int k_ = (g) * PG6_R + i_; \
        const int e_ = __builtin_amdgcn_readlane(k_ < 64 ? idlo : idhi, k_ & 63); const unsigned char* rp_ = (tab) + (size_t)(unsigned)e_ * 1536u; \
        const v4u a_ = *(const GAS v4u_a8*)(rp_ + voff); const v2u b_ = *(const GAS v2u*)(rp_ + voff + 16); buf[i_] = (v6u){a_.x, a_.y, a_.z, a_.w, b_.x, b_.y}; } } while (0)
#define PG6_DOT1(buf, i_, dst) do { const v32f f_ = __builtin_amdgcn_cvt_scalef32_pk32_f32_fp6(buf[i_], 1.0f); f32x2 a_ = {0.f, 0.f}; \
        _Pragma("unroll") for (int c_ = 0; c_ < 16; ++c_) a_ += (f32x2){f_[2 * c_], f_[2 * c_ + 1]} * x[c_]; dst = a_.x + a_.y; __builtin_amdgcn_sched_barrier(0); } while (0)
#if PG6_R == 8
#define PG6_DOT(buf, g) do { float p_[8]; _Pragma("unroll") for (int i_ = 0; i_ < 8; ++i_) PG6_DOT1(buf, i_, p_[i_]); \
        float q_[4]; _Pragma("unroll") for (int i_ = 0; i_ < 4; ++i_) { const float keep_ = b5 ? p_[i_ + 4] : p_[i_], send_ = b5 ? p_[i_] : p_[i_ + 4]; q_[i_] = keep_ + shx(send_, 32, lane); } \
        float r_[2]; _Pragma("unroll") for (int i_ = 0; i_ < 2; ++i_) { const float keep_ = b4 ? q_[i_ + 2] : q_[i_], send_ = b4 ? q_[i_] : q_[i_ + 2]; r_[i_] = keep_ + shx(send_, 16, lane); } \
        float s_; { const float keep_ = b3 ? r_[1] : r_[0], send_ = b3 ? r_[0] : r_[1]; s_ = keep_ + shx(send_, 8, lane); } \
        s_ += shx(s_, 4, lane); s_ += shx(s_, 2, lane); s_ += shx(s_, 1, lane); \
        if ((lane & 7) == 0) wl[(g) * 8 + (lane >> 3)] = s_; } while (0)
#else
#define PG6_DOT(buf, g) do { float p_[4]; _Pragma("unroll") for (int i_ = 0; i_ < 4; ++i_) PG6_DOT1(buf, i_, p_[i_]); \
        float r_[2]; _Pragma("unroll") for (int i_ = 0; i_ < 2; ++i_) { const float keep_ = b5 ? p_[i_ + 2] : p_[i_], send_ = b5 ? p_[i_] : p_[i_ + 2]; r_[i_] = keep_ + shx(send_, 32, lane); } \
        float s_; { const float keep_ = b4 ? r_[1] : r_[0], send_ = b4 ? r_[0] : r_[1]; s_ = keep_ + shx(send_, 16, lane); } \
        s_ += shx(s_, 8, lane); s_ += shx(s_, 4, lane); s_ += shx(s_, 2, lane); s_ += shx(s_, 1, lane); \
        if ((lane & 15) == 0) wl[(g) * 4 + (lane >> 4)] = s_; } while (0)
#endif
#define PG6_AXPY(buf, g) do { _Pragma("unroll") for (int i_ = 0; i_ < PG6_R; ++i_) { const float w_ = wl[(g) * PG6_R + i_]; const f32x2 wv_ = {w_, w_}; \
        const v32f f_ = __builtin_amdgcn_cvt_scalef32_pk32_f32_fp6(buf[i_], 1.0f); _Pragma("unroll") for (int c_ = 0; c_ < 16; ++c_) y[c_] += (f32x2){f_[2 * c_], f_[2 * c_ + 1]} * wv_; __builtin_amdgcn_sched_barrier(0); } } while (0)
__device__ __forceinline__ unsigned shxu(unsigned v, int k, int lane) { return (unsigned)__builtin_amdgcn_ds_bpermute((lane ^ k) << 2, (int)v); }
__device__ __forceinline__ void wave_sort128(unsigned& a, unsigned& b, int lane) {
#pragma unroll
    for (int k = 2; k <= 128; k <<= 1) {
#pragma unroll
        for (int j = k >> 1; j > 0; j >>= 1) {
            if (j == 64) { const unsigned lo = a < b ? a : b, hi = a < b ? b : a; a = lo; b = hi; }
            else {
                const unsigned pa = shxu(a, j, lane), pb = shxu(b, j, lane);
                const bool lower = (lane & j) == 0;
                const bool asc_a = (lane & k) == 0, asc_b = ((lane + 64) & k) == 0;
                const bool take_min_a = (lower == asc_a), take_min_b = (lower == asc_b);
                a = take_min_a ? (a < pa ? a : pa) : (a < pa ? pa : a);
                b = take_min_b ? (b < pb ? b : pb) : (b < pb ? pb : b);
            }
        }
    }
}
#ifndef PEER_U_FP4
#define PEER_U_FP4 1
#endif
#if PEER_U_FP4
typedef v4u urow_t;
#define PGU_LOAD PG4_LOAD
#define PGU_DOT PG4_DOT
constexpr float PU_SCALE = PU_SCALE4; constexpr int PU_STRIDE = 1024;
#else
typedef v6u urow_t;
#define PGU_LOAD PG6_LOAD
#define PGU_DOT PG6_DOT
constexpr float PU_SCALE = PU_SCALE6; constexpr int PU_STRIDE = 1536;
#endif
constexpr float PU_SCALEI = 135.0f, PX_SCALEI = 20.0f;
__device__ __forceinline__ void peer_v_pass(bf16* XN, const unsigned char* PV6, const int* PIDX, const float* PGATE, const int* PARTI, float* X, u64_t* rowsq_out, unsigned char* XN8, float* xsc, const u64_t* rowsq1, const u64_t* rowsq2, LAS float* wl, int gw, int NGW, int lane) {
    const unsigned voff4 = 16u * (unsigned)lane, l4 = 4u * (unsigned)lane, l8 = 8u * (unsigned)lane, l16 = 16u * (unsigned)lane;
    constexpr int NG = 128 / PG6_R;
    const __amdgpu_buffer_rsrc_t PVr = __builtin_amdgcn_make_buffer_rsrc((void*)PV6, 0, PEER_N * 1024, 0x00020000);
    for (int t_ = gw; t_ < T; t_ += NGW) {
        int t = t_; asm volatile("" : "+s"(t));
        const char* pidx_t = (const char*)(PIDX + (size_t)t * 128); const char* pgate_t = (const char*)(PGATE + (size_t)t * 128);
        const int idlo = *(const GAS int*)(pidx_t + l4), idhi = *(const GAS int*)(pidx_t + l4 + 256);
        v4u AV[PG6_R], BV[PG6_R];
        PG4_LOAD(AV, PVr, idlo, idhi, 0);
        {
            int s0 = 0, s1 = 0;
#pragma unroll
            for (int sp = 0; sp < 8; ++sp) { const char* pp = (const char*)(PARTI + ((size_t)sp * T + t) * 128); s0 += *(const GAS int*)(pp + l4); s1 += *(const GAS int*)(pp + l4 + 256); }
            const float sct = (8.0f / 127.0f / PU_SCALEI) * rowsq_rs(rowsq2, t) / rowsq_rs(rowsq1, t);
            const float d0 = (float)s0 * sct, d1 = (float)s1 * sct;
            const float g0 = *(const GAS float*)(pgate_t + l4), g1 = *(const GAS float*)(pgate_t + l4 + 256);
            const float w0 = g0 * 0.5f * d0 * (1.f + erff(d0 * 0.70710678118654752f)) * (1.f / PV_SCALE4), w1 = g1 * 0.5f * d1 * (1.f + erff(d1 * 0.70710678118654752f)) * (1.f / PV_SCALE4);
            wl[lane] = w0; wl[64 + lane] = w1;
            LDS_WAIT(); asm volatile("" ::: "memory");
        }
        f32x2 y[16];
#pragma unroll
        for (int i = 0; i < 16; ++i) y[i] = (f32x2){0.f, 0.f};
#pragma unroll 1
        for (int g = 0; g < NG; g += 2) {
            PG4_LOAD(BV, PVr, idlo, idhi, g + 1);
            PG4_AXPY(AV, g);
            if (g + 2 < NG) PG4_LOAD(AV, PVr, idlo, idhi, g + 2);
            PG4_AXPY(BV, g + 1);
        }
        {   char* xo = (char*)(X + (size_t)t * DM);
            char* xbo = (char*)(XN + (size_t)t * DM); float ss = 0.f;
#pragma unroll
            for (int j = 0; j < 8; ++j) { const v2u a = *(const GAS v2u*)(xbo + l8 + 512 * j); f32x4 v = (f32x4){bflo(a.x), bfhi(a.x), bflo(a.y), bfhi(a.y)}; v += (f32x4){y[2 * j].x, y[2 * j].y, y[2 * j + 1].x, y[2 * j + 1].y};
                if (X) *(GAS f32x4*)(xo + l16 + 1024 * j) = v;
                y[2 * j] = (f32x2){v[0], v[1]}; y[2 * j + 1] = (f32x2){v[2], v[3]};
                ss += (v[0] * v[0] + v[1] * v[1]) + (v[2] * v[2] + v[3] * v[3]); *(GAS v2u*)(xbo + l8 + 512 * j) = (v2u){pk2(v[0], v[1]), pk2(v[2], v[3])}; }
            if (rowsq_out) { ss = wave_sum(ss, lane); if (lane == 0) rowsq_out[t] = rowsq_fx(ss); }
            if (XN8) {
                float am = 0.f;
#pragma unroll
                for (int j = 0; j < 16; ++j) am = fmaxf(am, fmaxf(fabsf(y[j].x), fabsf(y[j].y)));
                am = fmaxf(wave_max(am, lane), 1e-30f);
                const float inv = 127.f / am; char* qo = (char*)(XN8 + (size_t)t * DM);
#pragma unroll
                for (int j = 0; j < 8; ++j) *(GAS unsigned*)(qo + l4 + 256 * j) = q8x4((f32x4){y[2 * j].x, y[2 * j].y, y[2 * j + 1].x, y[2 * j + 1].y}, inv);
                if (lane == 0) xsc[t] = am * (1.f / 127.f) / sqrtf(ss * (1.f / DM) + 1e-6f); } }
        LDS_WAIT(); asm volatile("" ::: "memory");
    }
}


__device__ __forceinline__ unsigned enc_i4(float v) { int q = (int)__builtin_rintf(v); q = q < -7 ? -7 : (q > 7 ? 7 : q); return (unsigned)q & 15u; }
__device__ __forceinline__ void convert_int4_plain(const float* src, unsigned char* dst, int nrows, float scale, const float* gain, int gw, int NGW, int lane) {
    for (int r0 = 2 * gw; r0 < nrows; r0 += 2 * NGW) {
        f32x4 a[2][8];
#pragma unroll
        for (int q = 0; q < 2; ++q) { const float* sp = src + (size_t)(r0 + q) * DM + 4 * lane;
#pragma unroll
            for (int j = 0; j < 8; ++j) a[q][j] = *(const GAS f32x4*)(sp + 256 * j); }
#pragma unroll
        for (int q = 0; q < 2; ++q) { const int r = r0 + q; const float* gp = gain ? gain + (size_t)(r / PEER_N) * DM + 4 * lane : nullptr;
#pragma unroll
            for (int j = 0; j < 8; ++j) { f32x4 v = a[q][j] * scale; if (gp) v = v * *(const GAS f32x4*)(gp + 256 * j);
                const unsigned w = enc_i4(v[0]) | (enc_i4(v[1]) << 4) | (enc_i4(v[2]) << 8) | (enc_i4(v[3]) << 12);
                *(GAS unsigned short*)(dst + (size_t)r * 1024 + 128 * j + 2 * lane) = (unsigned short)w; } }
    }
}
__device__ __forceinline__ void peer_xquant_unit(const bf16* XN, const u64_t* rowsq, unsigned* XQH, unsigned* XQL, int tb, int sl, int tid) {
    for (int it = tid; it < 256 * 32; it += NTHREADS) {
        const int t = tb * 256 + (it >> 5), c8 = it & 31;
        const float xs = PX_SCALEI * rowsq_rs(rowsq, t);
        const v4u w = *(const GAS v4u*)(XN + (size_t)t * DM + 256 * sl + 8 * c8);
        const float f[8] = {bflo(w.x), bfhi(w.x), bflo(w.y), bfhi(w.y), bflo(w.z), bfhi(w.z), bflo(w.w), bfhi(w.w)};
        unsigned hi = 0u, lo = 0u;
#pragma unroll
        for (int j = 0; j < 8; ++j) { int q = (int)__builtin_rintf(f[j] * xs); q = q < -119 ? -119 : (q > 119 ? 119 : q);
            const int xl = ((q + 8) & 15) - 8, xh = (q - xl) >> 4;
            hi |= ((unsigned)xh & 15u) << (4 * j); lo |= ((unsigned)xl & 15u) << (4 * j); }
        XQH[(size_t)t * 256 + 32 * sl + c8] = hi; XQL[(size_t)t * 256 + 32 * sl + c8] = lo;
    }
}
#define PI_LOADROWS(buf, tab, ids, i0) do { _Pragma("unroll") for (int i_ = 0; i_ < 8; ++i_) buf[i_] = __builtin_amdgcn_raw_buffer_load_b128(tab, ids[(i0) + i_] * 1024 + (int)soff, 0, 0); } while (0)
#define PI_LOADIDS(ids, t) do { const char* ip_ = (const char*)PIDX + ((size_t)(t) * 128 + 16 * g) * 4; _Pragma("unroll") for (int c_ = 0; c_ < 4; ++c_) { const v4u q_ = *(const GAS v4u*)(ip_ + 16 * c_); \
        ids[4 * c_] = (int)q_.x; ids[4 * c_ + 1] = (int)q_.y; ids[4 * c_ + 2] = (int)q_.z; ids[4 * c_ + 3] = (int)q_.w; } } while (0)
#define PI_UGROUP(buf, i0) do { _Pragma("unroll") for (int i_ = 0; i_ < 8; ++i_) { int ah_ = 0, al_ = 0; \
        _Pragma("unroll") for (int c_ = 0; c_ < 4; ++c_) { ah_ = __builtin_amdgcn_sdot8((int)buf[i_][c_], (int)xh[c_], ah_, false); al_ = __builtin_amdgcn_sdot8((int)buf[i_][c_], (int)xl[c_], al_, false); } \
        int p_ = 16 * ah_ + al_; p_ += __builtin_amdgcn_ds_bpermute((lane ^ 1) << 2, p_); p_ += __builtin_amdgcn_ds_bpermute((lane ^ 2) << 2, p_); p_ += __builtin_amdgcn_ds_bpermute((lane ^ 4) << 2, p_); \
        if (m == (((i0) + i_) >> 1)) { if (((i0) + i_) & 1) keep1 = p_; else keep0 = p_; } } } while (0)
#define PI_LOADROWS16(buf, tab, ids) do { _Pragma("unroll") for (int i_ = 0; i_ < 16; ++i_) buf[i_] = __builtin_amdgcn_raw_buffer_load_b128(tab, ids[i_] * 1024 + (int)soff, 0, 0); } while (0)
#define PI_LOADX(xh_, xl_, t) do { xh_ = *(const GAS v4u*)((const char*)XQH + (size_t)(t) * 1024 + soff); xl_ = *(const GAS v4u*)((const char*)XQL + (size_t)(t) * 1024 + soff); } while (0)
#define PI_COMPUTE16(buf, xh_, xl_, t) do { int keep0 = 0, keep1 = 0; \
        _Pragma("unroll") for (int i_ = 0; i_ < 16; ++i_) { int ah_ = 0, al_ = 0; \
            _Pragma("unroll") for (int c_ = 0; c_ < 4; ++c_) { ah_ = __builtin_amdgcn_sdot8((int)buf[i_][c_], (int)xh_[c_], ah_, false); al_ = __builtin_amdgcn_sdot8((int)buf[i_][c_], (int)xl_[c_], al_, false); } \
            int p_ = 16 * ah_ + al_; p_ += __builtin_amdgcn_update_dpp(0, p_, 0xB1, 0xf, 0xf, true); p_ += __builtin_amdgcn_update_dpp(0, p_, 0x4E, 0xf, 0xf, true); p_ += __builtin_amdgcn_update_dpp(0, p_, 0x141, 0xf, 0xf, true);   \
            if (m == (i_ >> 1)) { if (i_ & 1) keep1 = p_; else keep0 = p_; } } \
        if ((t) < T) *(GAS v2u*)(PARTI + ((size_t)s * T + (t)) * 128 + 2 * lane) = (v2u){(unsigned)keep0, (unsigned)keep1}; } while (0)
__device__ __forceinline__ void peer_u_phase_i4(const unsigned* XQH, const unsigned* XQL, const unsigned char* PU, const int* PIDX, int* PARTI, int bid, int G, int wave, int lane) {
    const int s = bid & 7, nr = (G - s + 7) >> 3, q = (bid >> 3) * NWAVES + wave, stride = nr * NWAVES, g = lane >> 3, m = lane & 7;
    const unsigned soff = 128u * (unsigned)s + 16u * (unsigned)m;
    if (q >= T) return;
    const __amdgpu_buffer_rsrc_t PUr = __builtin_amdgcn_make_buffer_rsrc((void*)PU, 0, PEER_N * 1024, 0x00020000);
#define PI_CL(t) ((t) < T ? (t) : T - 1)
    int I1[16], I2[16]; v4u xh0, xl0, xh1, xl1, xh2, xl2, RA[16], RB[16];
    PI_LOADIDS(I1, q); PI_LOADX(xh0, xl0, q);
    PI_LOADROWS16(RA, PUr, I1);
    PI_LOADIDS(I1, PI_CL(q + stride)); PI_LOADX(xh1, xl1, PI_CL(q + stride));
    for (int t = q; t < T; t += 2 * stride) {
        PI_LOADROWS16(RB, PUr, I1);
        PI_LOADIDS(I2, PI_CL(t + 2 * stride)); PI_LOADX(xh2, xl2, PI_CL(t + 2 * stride));
        PI_COMPUTE16(RA, xh0, xl0, t);
        PI_LOADROWS16(RA, PUr, I2);
        PI_LOADIDS(I1, PI_CL(t + 3 * stride)); PI_LOADX(xh0, xl0, PI_CL(t + 3 * stride));
        PI_COMPUTE16(RB, xh1, xl1, t + stride);
        xh1 = xh0; xl1 = xl0; xh0 = xh2; xl0 = xl2;
    }
#undef PI_CL
}


constexpr float PV_SCALE4S = 5.65f;
__device__ __forceinline__ unsigned enc_e2m1s(float v) {
    const float a = fabsf(v);
    const unsigned code = a < 0.25f ? 0u : a < 0.75f ? 1u : a < 1.25f ? 2u : a < 1.75f ? 3u : a < 2.5f ? 4u : a < 3.5f ? 5u : a < 5.0f ? 6u : 7u;
    return code | (v < 0.f ? 8u : 0u);
}
__device__ __forceinline__ void convert_fp4_plain(const float* src, unsigned char* dst, int nrows, float scale, const float* gain, int gw, int NGW, int lane) {
    for (int r0 = 2 * gw; r0 < nrows; r0 += 2 * NGW) {
        f32x4 a[2][8];
#pragma unroll
        for (int q = 0; q < 2; ++q) { const float* sp = src + (size_t)(r0 + q) * DM + 4 * lane;
#pragma unroll
            for (int j = 0; j < 8; ++j) a[q][j] = *(const GAS f32x4*)(sp + 256 * j); }
#pragma unroll
        for (int q = 0; q < 2; ++q) { const int r = r0 + q; const float* gp = gain ? gain + (size_t)(r / PEER_N) * DM + 4 * lane : nullptr;
#pragma unroll
            for (int j = 0; j < 8; ++j) { f32x4 v = a[q][j] * scale; if (gp) v = v * *(const GAS f32x4*)(gp + 256 * j);
                const unsigned w = enc_e2m1s(v[0]) | (enc_e2m1s(v[1]) << 4) | (enc_e2m1s(v[2]) << 8) | (enc_e2m1s(v[3]) << 12);
                *(GAS unsigned short*)(dst + (size_t)r * 1024 + 128 * j + 2 * lane) = (unsigned short)w; } }
    }
}
#define PVS_LOADMETA(ids, pp, gg, t) do { PI_LOADIDS(ids, t); _Pragma("unroll") for (int sp_ = 0; sp_ < 8; ++sp_) pp[sp_] = *(const GAS v2u*)(PARTI + ((size_t)sp_ * T + (t)) * 128 + 2 * lane); \
        gg = *(const GAS f32x2*)(PGATE + (size_t)(t) * 128 + 2 * lane); } while (0)
#define PVS_COMPUTE16(buf, pp, gg, t) do { float w0, w1; { int s0_ = 0, s1_ = 0; _Pragma("unroll") for (int sp_ = 0; sp_ < 8; ++sp_) { s0_ += (int)pp[sp_].x; s1_ += (int)pp[sp_].y; } \
            const float d0_ = (float)s0_ * (1.f / (PX_SCALEI * PU_SCALEI)), d1_ = (float)s1_ * (1.f / (PX_SCALEI * PU_SCALEI)); \
            w0 = gg.x * 0.5f * d0_ * (1.f + erff(d0_ * 0.70710678118654752f)) * (1.f / PV_SCALE4S); w1 = gg.y * 0.5f * d1_ * (1.f + erff(d1_ * 0.70710678118654752f)) * (1.f / PV_SCALE4S); } \
        f32x2 y[16]; _Pragma("unroll") for (int i_ = 0; i_ < 16; ++i_) y[i_] = (f32x2){0.f, 0.f}; \
        _Pragma("unroll") for (int i_ = 0; i_ < 16; ++i_) { \
            const float w_ = __builtin_bit_cast(float, __builtin_amdgcn_ds_bpermute(((lane & 56) | (i_ >> 1)) << 2, __builtin_bit_cast(int, (i_ & 1) ? w1 : w0))); const f32x2 wv_ = {w_, w_}; \
            _Pragma("unroll") for (int c_ = 0; c_ < 4; ++c_) { const unsigned u_ = buf[i_][c_]; \
                y[4 * c_ + 0] += __builtin_amdgcn_cvt_scalef32_pk_f32_fp4(u_, 1.0f, 0) * wv_; y[4 * c_ + 1] += __builtin_amdgcn_cvt_scalef32_pk_f32_fp4(u_, 1.0f, 1) * wv_; \
                y[4 * c_ + 2] += __builtin_amdgcn_cvt_scalef32_pk_f32_fp4(u_, 1.0f, 2) * wv_; y[4 * c_ + 3] += __builtin_amdgcn_cvt_scalef32_pk_f32_fp4(u_, 1.0f, 3) * wv_; } } \
        {   LAS float* wp_ = yl + g * 288 + m * 36; \
            _Pragma("unroll") for (int c_ = 0; c_ < 8; ++c_) *(LAS f32x4*)(wp_ + 4 * c_) = (f32x4){y[2 * c_].x, y[2 * c_].y, y[2 * c_ + 1].x, y[2 * c_ + 1].y}; \
            LDS_WAIT(); asm volatile("" ::: "memory"); \
            f32x4 acc_ = {0.f, 0.f, 0.f, 0.f}; const LAS float* rp_ = yl + (lane >> 3) * 36 + 4 * (lane & 7); \
            _Pragma("unroll") for (int gg_ = 0; gg_ < 8; ++gg_) acc_ += *(const LAS f32x4*)(rp_ + gg_ * 288); \
            LDS_WAIT(); asm volatile("" ::: "memory"); \
            if ((t) < T) { bf16* xp_ = XN + (size_t)(t) * DM + 256 * s + 4 * lane; const v2u a_ = *(const GAS v2u*)xp_; \
                const f32x4 v_ = (f32x4){bflo(a_.x), bfhi(a_.x), bflo(a_.y), bfhi(a_.y)} + acc_; \
                *(GAS v2u*)xp_ = (v2u){pk2(v_[0], v_[1]), pk2(v_[2], v_[3])}; \
                if (Xout) *(GAS f32x4*)(Xout + (size_t)(t) * DM + 256 * s + 4 * lane) = v_; \
                if (rowsq_out) { const float ss_ = wave_sum((v_[0] * v_[0] + v_[1] * v_[1]) + (v_[2] * v_[2] + v_[3] * v_[3]), lane); if (lane == 0) atomicAdd(rowsq_out + (t), rowsq_fx(ss_)); } } } } while (0)
__device__ __forceinline__ void peer_v_phase_s(bf16* XN, const unsigned char* PV, const int* PIDX, const float* PGATE, const int* PARTI, float* Xout, u64_t* rowsq_out, LAS float* yl, int bid, int G, int wave, int lane) {
    const int s = bid & 7, nr = (G - s + 7) >> 3, q = (bid >> 3) * NWAVES + wave, stride = nr * NWAVES, g = lane >> 3, m = lane & 7;
    const unsigned soff = 128u * (unsigned)s + 16u * (unsigned)m;
    if (q >= T) return;
    const __amdgpu_buffer_rsrc_t PVr = __builtin_amdgcn_make_buffer_rsrc((void*)PV, 0, PEER_N * 1024, 0x00020000);
#define PVS_CL(t) ((t) < T ? (t) : T - 1)
    int I0[16], I1[16]; v2u P0[8], P1[8]; f32x2 G0, G1; v4u RA[16], RB[16];
#define PVS_LOADPG(pp, gg, t) do { _Pragma("unroll") for (int sp_ = 0; sp_ < 8; ++sp_) pp[sp_] = *(const GAS v2u*)(PARTI + ((size_t)sp_ * T + (t)) * 128 + 2 * lane); gg = *(const GAS f32x2*)(PGATE + (size_t)(t) * 128 + 2 * lane); } while (0)
    PI_LOADIDS(I0, q); PVS_LOADPG(P0, G0, q);
    PI_LOADROWS16(RA, PVr, I0);
    PI_LOADIDS(I1, PVS_CL(q + stride)); PVS_LOADPG(P1, G1, PVS_CL(q + stride));
    for (int t = q; t < T; t += 2 * stride) {
        PI_LOADROWS16(RB, PVr, I1);
        PI_LOADIDS(I0, PVS_CL(t + 2 * stride));
        PVS_COMPUTE16(RA, P0, G0, t);
        PVS_LOADPG(P0, G0, PVS_CL(t + 2 * stride));
        PI_LOADROWS16(RA, PVr, I0);
        PI_LOADIDS(I1, PVS_CL(t + 3 * stride));
        PVS_COMPUTE16(RB, P1, G1, t + stride);
        PVS_LOADPG(P1, G1, PVS_CL(t + 3 * stride));
    }
#undef PVS_LOADPG
#undef PVS_CL
}

typedef short s16x4 __attribute__((ext_vector_type(4)));
typedef __attribute__((address_space(3))) const char* lds_cptr;
__device__ __forceinline__ s16x4 vtr(lds_cptr p) { return __builtin_bit_cast(s16x4, __builtin_amdgcn_ds_read_tr16_b64_v4i16((__attribute__((address_space(3))) s16x4*)p)); }
__device__ __forceinline__ unsigned cvtpk(float lo, float hi) { unsigned r; asm("v_cvt_pk_bf16_f32 %0, %1, %2" : "=v"(r) : "v"(lo), "v"(hi)); return r; }
constexpr int AS_STAGE = 65536, AS_V = 32768, AT_TAB = LDSCTL_OFF + 2048;
constexpr float LOG2E = 1.4426950408889634f;
__device__ __forceinline__ void at_dma16(const char* sbase, unsigned voff, unsigned ldsaddr) {
    asm volatile("s_mov_b32 m0, %2\n\ts_nop 0\n\tglobal_load_lds_dwordx4 %0, %1" :: "v"(voff), "s"(sbase), "s"(ldsaddr) : "memory");
}
template <int TYPE>
__device__ __forceinline__ void attn_unit(LAS unsigned char* lds, const bf16* QKV, bf16* ATT, u64_t* mixsq, int b, int head, int qb, const float* tabsrc, float Cl2, float sinkl2, int tid) {
    const int lane = tid & 63, w = __builtin_amdgcn_readfirstlane(tid >> 6), hh = lane >> 5, l31 = lane & 31;
    int qcol, kcol, vcol, ocol;
    if (TYPE == 0) { qcol = QA + head * 64; kcol = KA + (head / 3) * 64; vcol = VA + (head / 3) * 64; ocol = OA + head * 64; }
    else if (TYPE == 1) { qcol = QB + head * 64; kcol = KB + head * 64; vcol = VB + head * 64; ocol = OB + head * 64; }
    else { qcol = QC + head * 64; kcol = KC + (head / 3) * 64; vcol = VC + (head / 3) * 64; ocol = OC + head * 64; }
    const int q0 = 256 * qb + 32 * w, qpos = q0 + l31;
    int t_begin, t_end;
    if (TYPE == 0) { t_begin = 4 * qb - 2; if (t_begin < 0) t_begin = 0; t_end = 4 * qb + 6; if (t_end > 32) t_end = 32; }
    else if (TYPE == 1) { int a = 4 * qb - 4; a = a < 0 ? 0 : (a > 24 ? 24 : a); int e = 4 * qb - 1; e = e < 0 ? 0 : (e > 24 ? 24 : e); t_begin = a; t_end = e + 8; }
    else { t_begin = 0; t_end = 32; }
    LAS float* tab = (LAS float*)(lds + AT_TAB);
    if (TYPE == 0) { for (int i = tid; i < 1024; i += NTHREADS) { const int rel = i - 448; tab[i] = (rel >= -128 && rel <= 128) ? tabsrc[head * 257 + rel + 128] * LOG2E - Cl2 : -1e30f; } }
    if (TYPE == 1) { for (int i = tid; i < 15 * 31; i += NTHREADS) tab[i] = tabsrc[head * 465 + i] * LOG2E - Cl2; }
    bf16x8 qf[4];
    {   const bf16* qp = QKV + ((size_t)b * SEQ + qpos) * DIN + qcol + 8 * hh;
#pragma unroll
        for (int s = 0; s < 4; ++s) qf[s] = *(const GAS bf16x8*)(qp + 16 * s); }
    const int drow = 8 * w + (lane >> 3), dsl = lane & 7;
    const unsigned koff = (unsigned)((drow * DIN + kcol + ((dsl ^ ((drow >> 1) & 7)) * 8)) * 2);
    const unsigned voff = (unsigned)((drow * DIN + vcol + (((((dsl >> 2) ^ ((drow >> 1) & 1)) << 2) | (dsl & 3)) * 8)) * 2);
    const char* gbp = (const char*)(QKV + (size_t)b * SEQ * DIN);
    const unsigned ldsb = (unsigned)(size_t)lds + (unsigned)w * 1024u;
#define AT_STAGE(sbuf, t0_) do { _Pragma("unroll") for (int i_ = 0; i_ < 4; ++i_) { const int tl_ = (t0_) + i_; if (tl_ < t_end) { \
        at_dma16(gbp + (size_t)tl_ * (64 * DIN * 2), koff, ldsb + (sbuf) * AS_STAGE + i_ * 8192); at_dma16(gbp + (size_t)tl_ * (64 * DIN * 2), voff, ldsb + (sbuf) * AS_STAGE + AS_V + i_ * 8192); } } } while (0)
    int kread[4], vread[2];
#pragma unroll
    for (int s = 0; s < 4; ++s) kread[s] = l31 * 128 + (((2 * s + hh) ^ ((lane >> 1) & 7)) * 16);
#pragma unroll
    for (int db = 0; db < 2; ++db) vread[db] = (4 * hh + ((lane >> 2) & 3)) * 128 + ((db ^ ((lane >> 3) & 1)) * 64) + 32 * ((lane >> 4) & 1) + 8 * (lane & 3);
    f32x16 O0, O1;
#pragma unroll
    for (int r = 0; r < 16; ++r) { O0[r] = 0.f; O1[r] = 0.f; }
    float lsum = 0.f;
    const int rw = 4 * qb + (w >> 1), cq = 32 * (w & 1) + l31;
    int r0w = rw - 4; r0w = r0w < 0 ? 0 : (r0w > 24 ? 24 : r0w);
    int c0 = cq - 8; c0 = c0 < 0 ? 0 : (c0 > 48 ? 48 : c0);
    const int nst = (t_end - t_begin + 3) >> 2;
#pragma unroll
    for (int s = 0; s < 4; ++s) asm volatile("" : "+v"(qf[s]));
    AT_STAGE(0, t_begin);
    VM_WAIT(); __syncthreads();
    bf16x8 kf[8];
#pragma unroll 1
    for (int st = 0; st < nst; ++st) {
        const int t0 = t_begin + 4 * st;
        if (st + 1 < nst) AT_STAGE((st + 1) & 1, t0 + 4);
        bool havek = false;
#pragma unroll 1
      for (int ti = 0; ti < 4; ++ti) {
        const int t = t0 + ti; if (t >= t_end) break;
        bool need = true;
        if (TYPE == 0) need = (64 * t <= q0 + 31 + 128) && (64 * t + 63 >= q0 - 128);
        if (TYPE == 1) need = (t >= r0w) && (t < r0w + 8);
        if (need) {
            const lds_cptr kb_ = (lds_cptr)(lds + (st & 1) * AS_STAGE + ti * 8192), vb_ = (lds_cptr)(lds + (st & 1) * AS_STAGE + AS_V + ti * 8192);
            if (!havek) {
#pragma unroll
                for (int s = 0; s < 4; ++s) { kf[2 * s] = *(const LAS bf16x8*)(kb_ + kread[s]); kf[2 * s + 1] = *(const LAS bf16x8*)(kb_ + kread[s] + 4096); } }
            f32x16 S0, S1;
            if (TYPE == 2) {
#pragma unroll
                for (int r = 0; r < 16; ++r) { S0[r] = -Cl2; S1[r] = -Cl2; }
            } else if (TYPE == 0) {
                const LAS float* tb = tab + (64 * t - qpos + 448 + 4 * hh);
#pragma unroll
                for (int r = 0; r < 16; ++r) { S0[r] = tb[8 * (r >> 2) + (r & 3)]; S1[r] = tb[32 + 8 * (r >> 2) + (r & 3)]; }
            } else {
                const LAS float* tb = tab + ((t - rw + 7) * 31 - cq + 15 + 4 * hh);
                const int kc0 = 4 * hh - c0;
#pragma unroll
                for (int r = 0; r < 16; ++r) { const int ka = 8 * (r >> 2) + (r & 3), kb2 = 32 + ka;
                    S0[r] = ((unsigned)(ka + kc0) < 16u) ? tb[ka] : -1e30f; S1[r] = ((unsigned)(kb2 + kc0) < 16u) ? tb[kb2] : -1e30f; }
            }
            __builtin_amdgcn_sched_barrier(0);
#define AT_SB __builtin_amdgcn_sched_barrier(0)
#define AT_SOFT(SX, base, dst) do { _Pragma("unroll") for (int r = (base); r < (base) + 8; ++r) SX[r] = __builtin_amdgcn_exp2f(SX[r]); \
            lsum += ((SX[(base)] + SX[(base) + 1]) + (SX[(base) + 2] + SX[(base) + 3])) + ((SX[(base) + 4] + SX[(base) + 5]) + (SX[(base) + 6] + SX[(base) + 7])); \
            v4u a_; _Pragma("unroll") for (int j = 0; j < 4; ++j) a_[j] = cvtpk(SX[(base) + 2 * j], SX[(base) + 2 * j + 1]); dst = __builtin_bit_cast(bf16x8, a_); } while (0)
#pragma unroll
            for (int s = 0; s < 4; ++s) S0 = __builtin_amdgcn_mfma_f32_32x32x16_bf16(kf[2 * s], qf[s], S0, 0, 0, 0);
            s16x4 vf[4][2][2];
#pragma unroll
            for (int ks = 0; ks < 2; ++ks)
#pragma unroll
                for (int db = 0; db < 2; ++db) { vf[ks][db][0] = vtr(vb_ + vread[db] + (16 * ks) * 128); vf[ks][db][1] = vtr(vb_ + vread[db] + (16 * ks + 8) * 128); }
            S1 = __builtin_amdgcn_mfma_f32_32x32x16_bf16(kf[1], qf[0], S1, 0, 0, 0); S1 = __builtin_amdgcn_mfma_f32_32x32x16_bf16(kf[3], qf[1], S1, 0, 0, 0);
            AT_SB;
            bf16x8 pb[4];
            AT_SOFT(S0, 0, pb[0]);
            AT_SB;
            S1 = __builtin_amdgcn_mfma_f32_32x32x16_bf16(kf[5], qf[2], S1, 0, 0, 0);
            AT_SB;
            AT_SOFT(S0, 8, pb[1]);
            AT_SB;
            S1 = __builtin_amdgcn_mfma_f32_32x32x16_bf16(kf[7], qf[3], S1, 0, 0, 0);
            asm volatile("s_waitcnt lgkmcnt(7)" ::: "memory");
#pragma unroll
            for (int ks = 2; ks < 4; ++ks)
#pragma unroll
                for (int db = 0; db < 2; ++db) { vf[ks][db][0] = vtr(vb_ + vread[db] + (16 * ks) * 128); vf[ks][db][1] = vtr(vb_ + vread[db] + (16 * ks + 8) * 128); }
            AT_SB;
#define AT_PV(ks) do { const bf16x8 va = __builtin_shufflevector(vf[ks][0][0], vf[ks][0][1], 0, 1, 2, 3, 4, 5, 6, 7), vb2 = __builtin_shufflevector(vf[ks][1][0], vf[ks][1][1], 0, 1, 2, 3, 4, 5, 6, 7); \
            O0 = __builtin_amdgcn_mfma_f32_32x32x16_bf16(va, pb[ks], O0, 0, 0, 0); O1 = __builtin_amdgcn_mfma_f32_32x32x16_bf16(vb2, pb[ks], O1, 0, 0, 0); } while (0)
            AT_PV(0);
            AT_SB;
            AT_SOFT(S1, 0, pb[2]);
            AT_SB;
            AT_PV(1);
            AT_SB;
            AT_SOFT(S1, 8, pb[3]);
            AT_SB;
            havek = (ti < 3) && (t + 1 < t_end);
            if (havek) { asm volatile("s_waitcnt lgkmcnt(7)" ::: "memory");
#pragma unroll
                for (int s = 0; s < 4; ++s) { kf[2 * s] = *(const LAS bf16x8*)(kb_ + 8192 + kread[s]); kf[2 * s + 1] = *(const LAS bf16x8*)(kb_ + 8192 + kread[s] + 4096); } }
            AT_SB;
            AT_PV(2); AT_PV(3);
#undef AT_PV
#undef AT_SOFT
#undef AT_SB
        } else havek = false;
      }
        VM_WAIT(); __syncthreads();
    }
    lsum += shx(lsum, 32, lane);
    if (TYPE == 0) lsum += __builtin_amdgcn_exp2f(sinkl2 - Cl2);
    const float inv = 1.f / lsum;
    {   float ss = 0.f;
#pragma unroll
        for (int r = 0; r < 16; ++r) { const float a = O0[r] * inv, c = O1[r] * inv; ss += a * a + c * c; }
        ss += shx(ss, 32, lane);
        if (hh == 0) (void)__hip_atomic_fetch_add((GAS u64_t*)(mixsq + (size_t)b * SEQ + qpos), rowsq_fx(ss), __ATOMIC_RELAXED, __HIP_MEMORY_SCOPE_AGENT); }
    bf16* op = ATT + ((size_t)b * SEQ + qpos) * DM + ocol + 4 * hh;
#pragma unroll
    for (int g4 = 0; g4 < 4; ++g4) {
        v2u o0, o1; o0.x = cvtpk(O0[4 * g4] * inv, O0[4 * g4 + 1] * inv); o0.y = cvtpk(O0[4 * g4 + 2] * inv, O0[4 * g4 + 3] * inv);
        o1.x = cvtpk(O1[4 * g4] * inv, O1[4 * g4 + 1] * inv); o1.y = cvtpk(O1[4 * g4 + 2] * inv, O1[4 * g4 + 3] * inv);
        *(GAS v2u*)(op + 8 * g4) = o0; *(GAS v2u*)(op + 32 + 8 * g4) = o1;
    }
}


constexpr int MA_K0 = 0, MA_V0 = 32768;
template <int MODE = 0>
__device__ __forceinline__ void mem_unit(LAS unsigned char* lds, const bf16* QM, const bf16* KVM, bf16* OM, const float* gq, int tb, int head, float Cl2, int tid) {
    const int lane = tid & 63, w = __builtin_amdgcn_readfirstlane(tid >> 6), hh = lane >> 5, l31 = lane & 31;
    const size_t trow = (size_t)tb * 256 + 32 * w + l31; const int b = tb >> 3;
    __syncthreads();
    bf16x8 qf[8];
    {   const bf16* qp = QM + trow * MEMW + head * 128 + 8 * hh;
#pragma unroll
        for (int s = 0; s < 8; ++s) qf[s] = *(const GAS bf16x8*)(qp + 16 * s);
        float ss = 0.f;
#pragma unroll
        for (int s = 0; s < 8; ++s)
#pragma unroll
            for (int j = 0; j < 8; ++j) { const float f = __builtin_bit_cast(float, (unsigned)(unsigned short)qf[s][j] << 16); ss += f * f; }
        ss += shx(ss, 32, lane);
        const float r = 0.12751743074602468f / sqrtf(ss * (1.f / 128.f) + EPS);
#pragma unroll
        for (int s = 0; s < 8; ++s) { const f32x4 g0 = *(const GAS f32x4*)(gq + 16 * s + 8 * hh), g1 = *(const GAS f32x4*)(gq + 16 * s + 8 * hh + 4);
            v4u o;
#pragma unroll
            for (int j = 0; j < 4; ++j) { const float f0 = __builtin_bit_cast(float, (unsigned)(unsigned short)qf[s][2 * j] << 16), f1 = __builtin_bit_cast(float, (unsigned)(unsigned short)qf[s][2 * j + 1] << 16);
                const float ga = (2 * j < 4) ? g0[2 * j] : g1[2 * j - 4], gb2 = (2 * j + 1 < 4) ? g0[2 * j + 1] : g1[2 * j + 1 - 4];
                o[j] = cvtpk(f0 * r * ga, f1 * r * gb2); }
            qf[s] = __builtin_bit_cast(bf16x8, o); }
    }
    int kread[8], vread[4];
#pragma unroll
    for (int s = 0; s < 8; ++s) kread[s] = l31 * 256 + (((2 * s + hh) ^ (l31 & 15)) * 16);
#pragma unroll
    for (int db = 0; db < 4; ++db) vread[db] = 65536 + (4 * hh + ((lane >> 2) & 3)) * 256 + ((db ^ ((lane >> 2) & 3)) * 64) + 32 * ((lane >> 4) & 1) + 8 * (lane & 3);
    f32x16 O[4];
#pragma unroll
    for (int db = 0; db < 4; ++db)
#pragma unroll
        for (int r = 0; r < 16; ++r) O[db][r] = 0.f;
    float lsum = 0.f;
    if (MODE != 1) {   const bf16* src = KVM + (size_t)b * NMEM * 1024 + head * 128;
#pragma unroll 1
        for (int half = 0; half < 2; ++half) {
            v4u st[8];
#pragma unroll
            for (int i = 0; i < 8; ++i) { const int c = tid + 512 * i, row = c >> 4, ch = c & 15; st[i] = *(const GAS v4u*)(src + (size_t)row * 1024 + 512 * half + ch * 8); }
#pragma unroll
            for (int i = 0; i < 8; ++i) { const int c = tid + 512 * i, row = c >> 4, ch = c & 15;
                const int off = half == 0 ? row * 256 + ((ch ^ (row & 15)) * 16) : 65536 + row * 256 + (((ch >> 2) ^ (row & 3)) * 64) + (ch & 3) * 16;
                *(LAS v4u*)(lds + off) = st[i]; }
        }
    }
    __syncthreads();
#define MA_SB __builtin_amdgcn_sched_barrier(0)
#define MA_LW(n) asm volatile("s_waitcnt lgkmcnt(" #n ")" ::: "memory")
#pragma unroll 1
    for (int t = 0; t < (MODE ? 0 : 4); ++t) {
        const lds_cptr kb_ = (lds_cptr)(lds + t * 16384), vb_ = (lds_cptr)(lds + t * 16384);
        f32x16 S0, S1;
#pragma unroll
        for (int r = 0; r < 16; ++r) { S0[r] = -Cl2; S1[r] = -Cl2; }
        bf16x8 a0[8], a1[4];
#pragma unroll
        for (int s = 0; s < 8; ++s) a0[s] = *(const LAS bf16x8*)(kb_ + kread[s]);
        MA_SB;
#pragma unroll
        for (int s = 0; s < 4; ++s) S0 = __builtin_amdgcn_mfma_f32_32x32x16_bf16(a0[s], qf[s], S0, 0, 0, 0);
        MA_SB;
#pragma unroll
        for (int s = 0; s < 4; ++s) a1[s] = *(const LAS bf16x8*)(kb_ + kread[s] + 8192);
        MA_SB;
#pragma unroll
        for (int s = 4; s < 8; ++s) S0 = __builtin_amdgcn_mfma_f32_32x32x16_bf16(a0[s], qf[s], S0, 0, 0, 0);
        MA_SB;
#pragma unroll
        for (int s = 0; s < 4; ++s) a0[s] = *(const LAS bf16x8*)(kb_ + kread[4 + s] + 8192);
        MA_SB;
#pragma unroll
        for (int s = 0; s < 4; ++s) S1 = __builtin_amdgcn_mfma_f32_32x32x16_bf16(a1[s], qf[s], S1, 0, 0, 0);
#pragma unroll
        for (int s = 0; s < 4; ++s) S1 = __builtin_amdgcn_mfma_f32_32x32x16_bf16(a0[s], qf[4 + s], S1, 0, 0, 0);
        MA_SB;
        s16x4 vf[2][4][2];
#define MA_VRD(ks) do { _Pragma("unroll") for (int db = 0; db < 4; ++db) { vf[(ks) & 1][db][0] = vtr(vb_ + vread[db] + (16 * (ks)) * 256); vf[(ks) & 1][db][1] = vtr(vb_ + vread[db] + (16 * (ks) + 8) * 256); } } while (0)
#define MA_PV(ks) do { _Pragma("unroll") for (int db = 0; db < 4; ++db) { const bf16x8 va = __builtin_shufflevector(vf[(ks) & 1][db][0], vf[(ks) & 1][db][1], 0, 1, 2, 3, 4, 5, 6, 7); \
            O[db] = __builtin_amdgcn_mfma_f32_32x32x16_bf16(va, pb[ks], O[db], 0, 0, 0); } } while (0)
        MA_VRD(0);
        MA_SB;
#pragma unroll
        for (int r = 0; r < 16; ++r) { S0[r] = __builtin_amdgcn_exp2f(S0[r]); S1[r] = __builtin_amdgcn_exp2f(S1[r]); lsum += S0[r] + S1[r]; }
        bf16x8 pb[4];
#pragma unroll
        for (int hf = 0; hf < 2; ++hf) {
            v4u a, c;
#pragma unroll
            for (int j = 0; j < 4; ++j) { a[j] = cvtpk(S0[8 * hf + 2 * j], S0[8 * hf + 2 * j + 1]); c[j] = cvtpk(S1[8 * hf + 2 * j], S1[8 * hf + 2 * j + 1]); }
            pb[hf] = __builtin_bit_cast(bf16x8, a); pb[2 + hf] = __builtin_bit_cast(bf16x8, c);
        }
        MA_SB;
        MA_LW(7); MA_VRD(1); MA_SB; MA_PV(0); MA_SB;
        MA_LW(7); MA_VRD(2); MA_SB; MA_PV(1); MA_SB;
        MA_LW(7); MA_VRD(3); MA_SB; MA_PV(2); MA_SB;
        MA_PV(3);
        MA_SB;
    }
#undef MA_VRD
#undef MA_PV
#undef MA_SB
#undef MA_LW
    lsum += shx(lsum, 32, lane);
    const float inv = MODE ? 1.f : 1.f / lsum;
    bf16* op = OM + trow * MEMW + head * 128 + 4 * hh;
#pragma unroll
    for (int db = 0; db < 4; ++db)
#pragma unroll
        for (int g4 = 0; g4 < 4; ++g4) { v2u o; o.x = cvtpk(O[db][4 * g4] * inv, O[db][4 * g4 + 1] * inv); o.y = cvtpk(O[db][4 * g4 + 2] * inv, O[db][4 * g4 + 3] * inv); *(GAS v2u*)(op + 32 * db + 8 * g4) = o; }
}

struct Args { const float* in[23]; float* out; unsigned char* ws; int ph_lo, ph_hi, use_bar, pad; };
#ifndef MK_OFF
#define MK_OFF 0u
#endif
#ifndef REP_ATT
#define REP_ATT 1
#endif
#ifndef REP_P0
#define REP_P0 1
#endif
#ifndef REP_U
#define REP_U 1
#endif
#ifndef REP_GEMM
#define REP_GEMM 1
#endif
#ifndef REP_NORM
#define REP_NORM 1
#endif
#ifndef REP_SEL
#define REP_SEL 1
#endif
#ifndef REP_MEM
#define REP_MEM 1
#endif
#define PHON(k) (!((MK_OFF >> (k)) & 1u))
#ifndef MK_REP
#define MK_REP 0
#endif
constexpr int PH_PER_LAYER = 9, PH_BASE = 2, N_PHASES = PH_BASE + DEPTH * PH_PER_LAYER;
constexpr int PTAB_OFF = LDSCTL_OFF + 1024;

__global__ void __launch_bounds__(NTHREADS, 2) mega(Args a) {
    extern __shared__ __attribute__((aligned(16))) unsigned char lds_raw[];
    LAS unsigned char* lds = (LAS unsigned char*)lds_raw;
    const int wave0_ = __builtin_amdgcn_readfirstlane((int)threadIdx.x >> 6);
    {   const int tid0 = threadIdx.x;
        for (int u = tid0; u < (LDS_BYTES - LDSCTL_OFF) / 4; u += NTHREADS) ((LAS unsigned*)(lds + LDSCTL_OFF))[u] = 0u;
        __syncthreads();
        if (tid0 < 23) ((LAS unsigned long long*)(lds + PTAB_OFF))[tid0] = (unsigned long long)a.in[tid0];
        if (tid0 == 23) ((LAS unsigned long long*)(lds + PTAB_OFF))[23] = (unsigned long long)a.out;
        if (tid0 == 24) ((LAS unsigned long long*)(lds + PTAB_OFF))[24] = (unsigned long long)a.ws;
        __syncthreads();
    }
    volatile LAS unsigned* MISC = (volatile LAS unsigned*)(lds + MISC_OFF);
    const int G = gridDim.x, bid = blockIdx.x, NGW = G * NWAVES;
    const int use_bar = a.use_bar;
    XcdBarrier bar; bar.bar = (unsigned*)(a.ws + WS_CTL) + CW_BAR; bar.x = 0; bar.st = MISC + 8;
    if (use_bar) bar = xcd_barrier_post((unsigned*)(a.ws + WS_CTL) + CW_BAR, MISC + 8);
    const int lo = a.ph_lo, hi = a.ph_hi;
#define IN(k) (lo <= (k) && (k) < hi)
#define SEAM(k) do { if (use_bar && IN(k) && IN((k) + 1)) xcd_barrier(bar); } while (0)
#define PHL() int tid_ = wave0_ * 64 + (int)__builtin_amdgcn_mbcnt_hi(~0u, __builtin_amdgcn_mbcnt_lo(~0u, 0u)); asm volatile("" : "+v"(tid_)); const int lane_ = tid_ & 63, wave_ = __builtin_amdgcn_readfirstlane(tid_ >> 6), gw_ = bid * NWAVES + wave_; (void)lane_; (void)gw_; \
              int pz_ = 0; asm volatile("" : "+s"(pz_))
#define PTR(i) ((const float*)ldptr(lds, (i) + pz_))
#define WSP() ((unsigned char*)ldptr(lds, 24 + pz_))
#define OUTP() ((float*)ldptr(lds, 23 + pz_))

    if (IN(0) && PHON(0)) {
        PHL(); unsigned char* ws = WSP();
        LAS float* scr = (LAS float*)(lds + RING_OFF + wave_ * 16384);
        constexpr int I_IN = 32 * 128, I_OUT = 32 * 64, I_MQ = 32 * 16, I_MKV = 32 * 32, I_MO = 8 * 64, I_PQ = 32 * 64, I_L = I_IN + I_OUT + I_MQ + I_MKV + I_MO + I_PQ;
        for (int it = gw_; it < DEPTH * I_L; it += NGW) {
            const int l = it / I_L; int r = it % I_L;
            if (r < I_IN) { transpose_item<true>(PTR(4) + (size_t)l * DM * DIN, DM, DIN, (bf16*)(ws + WS_WIN) + (size_t)l * DIN * DM, scr, r, lane_, PTR(3) + (size_t)l * DM); continue; } r -= I_IN;
            if (r < I_OUT) { transpose_item<false>(PTR(11) + (size_t)l * DM * DM, DM, DM, (bf16*)(ws + WS_WOUT) + (size_t)l * DM * DM, scr, r, lane_, PTR(10) + (size_t)l * DM); continue; } r -= I_OUT;
            if (r < I_MQ) { transpose_item<false>(PTR(14) + (size_t)l * DM * MEMW, DM, MEMW, (bf16*)(ws + WS_WMQ) + (size_t)l * MEMW * DM, scr, r, lane_, PTR(12) + (size_t)l * DM); continue; } r -= I_MQ;
            if (r < I_MKV) { transpose_item<false>(PTR(15) + (size_t)l * DM * 1024, DM, 1024, (bf16*)(ws + WS_WMKV) + (size_t)l * 1024 * DM, scr, r, lane_); continue; } r -= I_MKV;
            if (r < I_MO) { transpose_item<false>(PTR(17) + (size_t)l * MEMW * DM, MEMW, DM, (bf16*)(ws + WS_WMO) + (size_t)l * DM * MEMW, scr, r, lane_); continue; } r -= I_MO;
            transpose_item<false>(PTR(19) + (size_t)l * DM * DM, DM, DM, (bf16*)(ws + WS_WPQ) + (size_t)l * DM * DM, scr, r, lane_, PTR(18) + (size_t)l * DM);
        }
        const size_t gtid = (size_t)bid * NTHREADS + tid_, nth = (size_t)G * NTHREADS;
        convert_bf16(PTR(20), (bf16*)(ws + WS_PKEYS), (size_t)DEPTH * 8 * 2 * 128 * 128, gtid, nth);
        convert_int4_plain(PTR(21), ws + WS_PU, DEPTH * PEER_N, PU_SCALEI, PTR(18), gw_, NGW, lane_);
        convert_fp4_rows(PTR(22), ws + WS_PV, PEER_N, PV_SCALE4, nullptr, gw_, NGW, lane_);
        {   const float* x0 = PTR(0); bf16* XN = (bf16*)(ws + WS_XN); u64_t* rsq = (u64_t*)(ws + WS_ROWSQ);
            for (int m = 2 * gw_; m < T; m += 2 * NGW) prep_rows2(x0 + (size_t)m * DM, XN + (size_t)m * DM, rsq + m, ws + WS_XN8 + (size_t)m * DM, (float*)(ws + WS_XSC) + m, lane_); }
        {   const float* mem = PTR(1); const float* gkv = PTR(13); bf16* MEMN = (bf16*)(ws + WS_MEMN);
            for (int m = gw_; m < BATCH * NMEM; m += NGW)
                rms_row_to_bf16(mem + (size_t)m * DM, gkv, MEMN + (size_t)m * DM, gkv + DM, MEMN + (size_t)(BATCH * NMEM + m) * DM, lane_); }
        float* rope = (float*)(ws + WS_ROPE); float* biasA = (float*)(ws + WS_BIASA);
        if (gtid < 64 * 16) { const int pos = (int)gtid >> 4, i = (int)gtid & 15; const float ang = (float)pos * ROPE_INV[i]; rope[gtid * 2] = cosf(ang); rope[gtid * 2 + 1] = sinf(ang); }
        if (gtid < 12 * 257) { const int h = (int)gtid / 257, rel = (int)gtid % 257 - 128; biasA[gtid] = PTR(2)[t5_bucket(rel) * 12 + h]; }
    }
    SEAM(0);
    if (IN(1) && PHON(1)) {
        {   PHL(); unsigned char* ws = WSP();
            for (int r = gw_; r < DEPTH * DIN; r += NGW) { const int rr = r & (DIN - 1), src = (rr & ~255) + 64 * ((rr >> 5) & 3) + 32 * ((rr >> 7) & 1) + (rr & 31);
                quant_wrow((const bf16*)(ws + WS_WIN) + (size_t)r * DM, ws + WS_WIN8 + (size_t)r * DM, (float*)(ws + WS_WSC) + (r & ~(DIN - 1)) + src, lane_); }
            for (int r = gw_; r < DEPTH * DM; r += NGW) quant_wrow((const bf16*)(ws + WS_WOUT) + (size_t)r * DM, ws + WS_WOUT8 + (size_t)r * DM, (float*)(ws + WS_WSCO) + r, lane_);
            for (int r = gw_; r < DEPTH * DM; r += NGW) quant_wrow((const bf16*)(ws + WS_WPQ) + (size_t)r * DM, ws + WS_WPQ8 + (size_t)r * DM, (float*)(ws + WS_WSCP) + r, lane_);
            for (int r = gw_; r < DEPTH * MEMW; r += NGW) quant_wrow((const bf16*)(ws + WS_WMQ) + (size_t)r * DM, ws + WS_WMQ8 + (size_t)r * DM, (float*)(ws + WS_WSCM) + r, lane_); }
#pragma unroll 1
        for (int l = 0; l < DEPTH; ++l) {
            PHL(); unsigned char* ws = WSP();
            pg8::Gemm g{(bf16*)(ws + WS_MEMN) + (size_t)l * BATCH * NMEM * DM, (bf16*)(ws + WS_WMKV) + (size_t)l * 1024 * DM, BATCH * NMEM, 1024, DM};
            OffsetOrder S; S.init(BATCH * NMEM, 1024, G, bid, 64 * l);
            bf16* KVMl = (bf16*)(ws + WS_KVM) + (size_t)l * BATCH * NMEM * 1024;
            pg8::EpiBf16<0> E{KVMl, 1024, nullptr, 0, 0, 1.f};
            pg8::gemm_phase<pg8::EpiBf16<0>, OffsetOrder, true, true>(lds + RING_OFF, g, S, E, tid_);
            VM_WAIT(); __syncthreads();
            const float* gk = PTR(16) + (size_t)l * 256 + 128;
#pragma unroll 1
            for (int i = 0; i < 4; ++i) { pg8::Unit uu; uu.pm = 0; uu.pn = 0; if (!S.next(i, uu)) break;
                if (uu.pn < 2) {
                    for (int r2 = wave_; r2 < 128; r2 += NWAVES) { const int row = uu.pm * 256 + 2 * r2 + (lane_ >> 5), cl = lane_ & 31;
                        GAS v4u* p = (GAS v4u*)(KVMl + (size_t)row * 1024 + 256 * uu.pn + 8 * cl);
                        const v4u w = *p;
                        float f[8] = {bflo(w.x), bfhi(w.x), bflo(w.y), bfhi(w.y), bflo(w.z), bfhi(w.z), bflo(w.w), bfhi(w.w)};
                        float ss = 0.f;
#pragma unroll
                        for (int e = 0; e < 8; ++e) ss += f[e] * f[e];
                        ss += shx(ss, 1, lane_); ss += shx(ss, 2, lane_); ss += shx(ss, 4, lane_); ss += shx(ss, 8, lane_);
                        const float r = 1.f / sqrtf(ss * (1.f / 128.f) + EPS);
                        const float* gg = gk + 8 * (cl & 15);
                        v4u o; o.x = pk2(f[0] * r * gg[0], f[1] * r * gg[1]); o.y = pk2(f[2] * r * gg[2], f[3] * r * gg[3]); o.z = pk2(f[4] * r * gg[4], f[5] * r * gg[5]); o.w = pk2(f[6] * r * gg[6], f[7] * r * gg[7]);
                        *p = o; } } }
            __syncthreads();
        }
        if (G >= 256 && bid >= 128) { PHL(); unsigned char* ws = WSP();
            convert_fp4_rows(PTR(22) + (size_t)PEER_N * DM, ws + WS_PV + (size_t)PEER_N * 1024, PEER_N, PV_SCALE4, nullptr, (bid - 128) * NWAVES + wave_, (G - 128) * NWAVES, lane_); }
        else if (G < 256) { PHL(); unsigned char* ws = WSP(); convert_fp4_rows(PTR(22) + (size_t)PEER_N * DM, ws + WS_PV + (size_t)PEER_N * 1024, PEER_N, PV_SCALE4, nullptr, gw_, NGW, lane_); }
    }
    SEAM(1);

#pragma unroll 1
    for (int l = 0; l < DEPTH; ++l) {
        const int pb = PH_BASE + PH_PER_LAYER * l;
        if (IN(pb + 0) && PHON(3)) { PHL(); unsigned char* ws = WSP();
            pg8::Gemm g{(bf16*)(ws + WS_XN8), (bf16*)(ws + WS_WIN8 + (size_t)l * DIN * DM), T, DIN, DM / 2}; pg8::StaticOrder S; S.init(T, DIN, G, bid);
            LAS float* ropel = (LAS float*)(lds + LDSCTL_OFF + 2048);
            for (int i = tid_; i < 64 * 16 * 2; i += NTHREADS) ropel[i] = ((const float*)(ws + WS_ROPE))[i];
            __syncthreads();
            pg8::EpiQKV E{(bf16*)(ws + WS_QKV), PTR(5) + (size_t)l * 128, PTR(7) + (size_t)l * 128, PTR(9) + (size_t)l * 128, ropel, (const u64_t*)(ws + WS_ROWSQ) + (size_t)(l * 3 + 0) * T, (const float*)(ws + WS_XSC), (const float*)(ws + WS_WSC) + (size_t)l * DIN};
            pg8::gemm_phase<pg8::EpiQKV, pg8::StaticOrder, true, true>(lds + RING_OFF, g, S, E, tid_);
        }
        SEAM(pb + 0);
        if (IN(pb + 1) && PHON(4)) { PHL(); unsigned char* ws = WSP();
            const float* sink = PTR(6) + (size_t)l * 12; const float* rpb = PTR(8) + (size_t)l * 8 * 15 * 31; const float* biasA = (const float*)(ws + WS_BIASA);
            const bf16* QKV = (const bf16*)(ws + WS_QKV); bf16* ATT = (bf16*)(ws + WS_ATT);
            const float* ga = PTR(5) + (size_t)l * 128; const float* gb = PTR(7) + (size_t)l * 128; const float* gc = PTR(9) + (size_t)l * 128;
            const float CaL2 = 8.f * wave_max(fabsf(ga[lane_]), lane_) * wave_max(fabsf(ga[64 + lane_]), lane_) * LOG2E;
            const float CbL2 = 8.f * wave_max(fabsf(gb[lane_]), lane_) * wave_max(fabsf(gb[64 + lane_]), lane_) * LOG2E;
            const float CcL2 = 8.f * wave_max(fabsf(gc[lane_]), lane_) * wave_max(fabsf(gc[64 + lane_]), lane_) * LOG2E;
            const int vc = (G % 8 == 0) ? (bid % 8) * (G / 8) + bid / 8 : bid;
            u64_t* mixsq = (u64_t*)(ws + WS_MIXSQ) + (size_t)l * 3 * T;
            for (int u = vc; u < BATCH * 12 * 8; u += G) attn_unit<2>(lds, QKV, ATT, mixsq + 2 * (size_t)T, u / 96, (u >> 3) % 12, u & 7, nullptr, CcL2, 0.f, tid_);
            for (int u = vc; u < BATCH * 8 * 8; u += G) attn_unit<1>(lds, QKV, ATT, mixsq + (size_t)T, u >> 6, (u >> 3) & 7, u & 7, rpb, CbL2, 0.f, tid_);
            for (int u = vc; u < BATCH * 12 * 8; u += G) { const int head = (u >> 3) % 12; attn_unit<0>(lds, QKV, ATT, mixsq, u / 96, head, u & 7, biasA, CaL2, sink[head] * LOG2E, tid_); }
        }
        SEAM(pb + 1);
        if (IN(pb + 2) && PHON(5)) { PHL(); unsigned char* ws = WSP();
            const u64_t* mixsq = (const u64_t*)(ws + WS_MIXSQ) + (size_t)l * 3 * T;
            for (int r = 4 * gw_; r < T; r += 4 * NGW) att_quant_rows<4>((const bf16*)(ws + WS_ATT), mixsq, ws + WS_ATT8, (float*)(ws + WS_XSC2), r, lane_);
        }
        SEAM(pb + 2);
        if (IN(pb + 3) && PHON(5)) { PHL(); unsigned char* ws = WSP();
            pg8::Gemm g{(bf16*)(ws + WS_ATT8), (bf16*)(ws + WS_WOUT8 + (size_t)l * DM * DM), T, DM, DM / 2}; pg8::StaticOrder S; S.init(T, DM, G, bid);
            typedef pg8::EpiResidT<true, 10> EpiX1;
            EpiX1 E{(bf16*)(ws + WS_XN), DM, (u64_t*)(ws + WS_ROWSQ) + (size_t)(l * 3 + 1) * T, (const float*)(ws + WS_XSC2), (const float*)(ws + WS_WSCO) + (size_t)l * DM, ws + WS_X8, (const u64_t*)(ws + WS_ROWSQ) + (size_t)(l * 3 + 0) * T, nullptr, nullptr};
            pg8::gemm_phase<EpiX1, pg8::StaticOrder, true, true>(lds + RING_OFF, g, S, E, tid_);
        }
        SEAM(pb + 3);
        if (IN(pb + 4) && PHON(6)) { PHL(); unsigned char* ws = WSP();
            pg8::Gemm g{(bf16*)(ws + WS_X8), (bf16*)(ws + WS_WMQ8 + (size_t)l * MEMW * DM), T, MEMW, DM / 2}; pg8::StaticOrder S; S.init(T, MEMW, G, bid);
            pg8::EpiBf16Row8<10> E{(bf16*)(ws + WS_QM), MEMW, (const u64_t*)(ws + WS_ROWSQ) + (size_t)(l * 3 + 1) * T, (const u64_t*)(ws + WS_ROWSQ) + (size_t)(l * 3 + 0) * T, (const float*)(ws + WS_WSCM) + (size_t)l * MEMW};
            pg8::gemm_phase<pg8::EpiBf16Row8<10>, pg8::StaticOrder, true, true>(lds + RING_OFF, g, S, E, tid_);
            VM_WAIT(); __syncthreads();
            const bf16* kvm = (const bf16*)(ws + WS_KVM) + (size_t)l * BATCH * NMEM * 1024; const float* gq = PTR(16) + (size_t)l * 256;
            const float CmL2 = 11.313708498984761f * wave_max(fmaxf(fabsf(gq[lane_]), fabsf(gq[64 + lane_])), lane_) * wave_max(fmaxf(fabsf(gq[128 + lane_]), fabsf(gq[192 + lane_])), lane_) * LOG2E;
#pragma unroll 1
            for (int i = 0; i < 4; ++i) { pg8::Unit uu; uu.pm = 0; uu.pn = 0; if (!S.next(i, uu)) break;
                int nrep_ = (MK_REP == 1) ? 4 : 2; asm volatile("" : "+s"(nrep_));
#pragma unroll 1
                for (int hr = 0; hr < nrep_; ++hr) mem_unit(lds, (const bf16*)(ws + WS_QM), kvm, (bf16*)(ws + WS_OM), gq, uu.pm, 2 * uu.pn + (hr & 1), CmL2, tid_);
#if MK_REP == 4 || MK_REP == 5
                mem_unit<MK_REP - 3>(lds, (const bf16*)(ws + WS_QM), kvm, (bf16*)(ws + WS_QKV), gq, uu.pm, 2 * uu.pn, CmL2, tid_); mem_unit<MK_REP - 3>(lds, (const bf16*)(ws + WS_QM), kvm, (bf16*)(ws + WS_QKV), gq, uu.pm, 2 * uu.pn + 1, CmL2, tid_);
#endif
            }
        }
        SEAM(pb + 4);
        if (IN(pb + 5) && PHON(7)) { PHL(); unsigned char* ws = WSP();
            pg8::Gemm g{(bf16*)(ws + WS_OM), (bf16*)(ws + WS_WMO) + (size_t)l * DM * MEMW, T, DM, MEMW}; pg8::StaticOrder S; S.init(T, DM, G, bid);
            typedef pg8::EpiResidT<false, 8, true> EpiX2;
            EpiX2 E{(bf16*)(ws + WS_XN), DM, (u64_t*)(ws + WS_ROWSQ) + (size_t)(l * 3 + 2) * T, nullptr, nullptr, ws + WS_X8, (const u64_t*)(ws + WS_ROWSQ) + (size_t)(l * 3 + 1) * T, ws + WS_XQH, ws + WS_XQL};
            pg8::gemm_phase<EpiX2, pg8::StaticOrder, true, true>(lds + RING_OFF, g, S, E, tid_);
        }
        SEAM(pb + 5);
        if (IN(pb + 6) && PHON(8)) { PHL(); unsigned char* ws = WSP();
            pg8::Gemm g{(bf16*)(ws + WS_X8), (bf16*)(ws + WS_WPQ8 + (size_t)l * DM * DM), T, DM, DM / 2}; pg8::StaticOrder S; S.init(T, DM, G, bid);
            pg8::EpiBf16Row8<8> E{(bf16*)(ws + WS_QP), DM, (const u64_t*)(ws + WS_ROWSQ) + (size_t)(l * 3 + 2) * T, (const u64_t*)(ws + WS_ROWSQ) + (size_t)(l * 3 + 1) * T, (const float*)(ws + WS_WSCP) + (size_t)l * DM};
            pg8::gemm_phase<pg8::EpiBf16Row8<8>, pg8::StaticOrder, true, true>(lds + RING_OFF, g, S, E, tid_);
            VM_WAIT(); __syncthreads();
            const bf16* pk = (const bf16*)(ws + WS_PKEYS) + (size_t)l * 8 * 2 * 128 * 128;
#pragma unroll 1
            for (int i = 0; i < 8; ++i) { pg8::Unit uu; uu.pm = 0; uu.pn = 0; if (!S.next(i, uu)) break;
                peer_select_unit((const bf16*)(ws + WS_QP), pk, (int*)(ws + WS_PIDX), (float*)(ws + WS_PGATE), uu.pm, uu.pn, wave_, lane_, lds + RING_OFF);
#if MK_REP == 2
                peer_select_unit((const bf16*)(ws + WS_QP), pk, (int*)(ws + WS_PIDX), (float*)(ws + WS_PGATE), uu.pm, uu.pn, wave_, lane_, lds + RING_OFF);
#endif
#if MK_REP == 3
#endif
            }
        }
        SEAM(pb + 6);
        if (IN(pb + 7) && PHON(9)) { PHL(); unsigned char* ws = WSP();
            peer_u_phase_i4((const unsigned*)(ws + WS_XQH), (const unsigned*)(ws + WS_XQL), ws + WS_PU + (size_t)l * PEER_N * 1024, (const int*)(ws + WS_PIDX), (int*)(ws + WS_PARTI), bid, G, wave_, lane_); }
        SEAM(pb + 7);
        if (IN(pb + 8) && PHON(10)) { PHL(); unsigned char* ws = WSP();
            peer_v_pass((bf16*)(ws + WS_XN), ws + WS_PV + (size_t)l * PEER_N * 1024, (const int*)(ws + WS_PIDX), (const float*)(ws + WS_PGATE), (const int*)(ws + WS_PARTI), (l + 1 == DEPTH) ? OUTP() : (float*)nullptr,
                        (l + 1 < DEPTH) ? (u64_t*)(ws + WS_ROWSQ) + (size_t)((l + 1) * 3 + 0) * T : (u64_t*)nullptr, (l + 1 < DEPTH) ? ws + WS_XN8 : (unsigned char*)nullptr, (float*)(ws + WS_XSC), (const u64_t*)(ws + WS_ROWSQ) + (size_t)(l * 3 + 1) * T, (const u64_t*)(ws + WS_ROWSQ) + (size_t)(l * 3 + 2) * T, (LAS float*)(lds + RING_OFF + wave_ * 1024), gw_, NGW, lane_); }
        SEAM(pb + 8);
    }
#undef IN
#undef SEAM
}

#ifndef MK_MULTI_LAUNCH
#define MK_MULTI_LAUNCH 0
#endif
extern "C" void kernel_launch(void* const* d_in, const int* in_sizes, int n_in, void* d_out, int out_size, void* d_ws, size_t ws_size, hipStream_t stream) {
    static int grid = 0;
    if (grid == 0) {
        if (n_in != 23 || out_size != T * DM || ws_size < WS_END) { fprintf(stderr, "kernel_launch: unexpected shapes (n_in %d, out %d, ws %zu)\n", n_in, out_size, ws_size); grid = -1; return; }
        int dev = 0, cus = 0, per_cu = 0;
        if (hipGetDevice(&dev) != hipSuccess || hipDeviceGetAttribute(&cus, hipDeviceAttributeMultiprocessorCount, dev) != hipSuccess) { grid = -1; return; }
        if (hipFuncSetAttribute((const void*)mega, hipFuncAttributeMaxDynamicSharedMemorySize, LDS_BYTES) != hipSuccess) { fprintf(stderr, "kernel_launch: hipFuncSetAttribute failed\n"); grid = -1; return; }
        if (hipOccupancyMaxActiveBlocksPerMultiprocessor(&per_cu, (const void*)mega, NTHREADS, LDS_BYTES) != hipSuccess || per_cu < 1) { fprintf(stderr, "kernel_launch: occupancy query says %d\n", per_cu); }
        (void)hipGetLastError();
        grid = cus;
    }
    if (grid < 0) return;
    (void)hipMemsetAsync((char*)d_ws + WS_CTL, 0, CTL_ZERO_BYTES, stream);
    (void)hipMemsetAsync((char*)d_ws + WS_MIXSQ, 0, MIXSQ_BYTES, stream);
    Args a{};
    for (int i = 0; i < 23; ++i) a.in[i] = (const float*)d_in[i];
    a.out = (float*)d_out; a.ws = (unsigned char*)d_ws;
#if MK_MULTI_LAUNCH
    for (int p = 0; p < N_PHASES; ++p) { a.ph_lo = p; a.ph_hi = p + 1; a.use_bar = 0; a.pad = 0; hipLaunchKernelGGL(mega, dim3(grid), dim3(NTHREADS), LDS_BYTES, stream, a); }
#else
    a.ph_lo = 0; a.ph_hi = N_PHASES; a.use_bar = 1; a.pad = 0;
    hipLaunchKernelGGL(mega, dim3(grid), dim3(NTHREADS), LDS_BYTES, stream, a);
#endif
    const hipError_t le = hipPeekAtLastError();
    if (le != hipSuccess) fprintf(stderr, "kernel_launch: launch failed: %s\n", hipGetErrorName(le));
}
```

```cpp
#include <hip/hip_runtime.h>
#include <cstdio>
#include <cstdint>
#include <cmath>
__device__ __forceinline__ float shx(float v, int k, int lane);
typedef unsigned long long u64_t;
__device__ __forceinline__ float rowsq_rs(const u64_t* rowsq, int row) { return 1.0f / sqrtf((float)*(const __attribute__((address_space(1))) u64_t*)(rowsq + row) * (5.9604644775390625e-08f / 2048.0f) + 1e-6f); }
__device__ __forceinline__ u64_t rowsq_fx(float ss) { return (u64_t)(ss * 16777216.0f + 0.5f); }
template <int HI = 255>
__device__ __forceinline__ unsigned q8x4c(float a, float b, float c, float d, float inv) {
    unsigned w = 0;
    w = __builtin_amdgcn_cvt_pk_u8_f32(__builtin_rintf(__builtin_amdgcn_fmed3f(__builtin_fmaf(a, inv, 128.f), 1.f, (float)HI)), 0, w); w = __builtin_amdgcn_cvt_pk_u8_f32(__builtin_rintf(__builtin_amdgcn_fmed3f(__builtin_fmaf(b, inv, 128.f), 1.f, (float)HI)), 1, w);
    w = __builtin_amdgcn_cvt_pk_u8_f32(__builtin_rintf(__builtin_amdgcn_fmed3f(__builtin_fmaf(c, inv, 128.f), 1.f, (float)HI)), 2, w); w = __builtin_amdgcn_cvt_pk_u8_f32(__builtin_rintf(__builtin_amdgcn_fmed3f(__builtin_fmaf(d, inv, 128.f), 1.f, (float)HI)), 3, w);
    return w ^ 0x80808080u;
}
__device__ __forceinline__ unsigned dig_lo4(unsigned d) { return d & 0x0f0f0f0fu; }
__device__ __forceinline__ unsigned dig_hi4(unsigned d) { const unsigned t = ((d & 0x7f7f7f7fu) + 0x08080808u) ^ (d & 0x80808080u); return (t >> 4) & 0x0f0f0f0fu; }
__device__ __forceinline__ unsigned nib_pack8(unsigned a, unsigned b) { a = (a | (a >> 4)) & 0x00ff00ffu; a = (a | (a >> 8)) & 0xffffu; b = (b | (b >> 4)) & 0x00ff00ffu; b = (b | (b >> 8)) & 0xffffu; return a | (b << 16); }
namespace pg8 {
#define PG8_LAS __attribute__((address_space(3)))
#define PG8_GAS __attribute__((address_space(1)))
typedef unsigned short bf16_t;
typedef short bf16x8 __attribute__((ext_vector_type(8)));
typedef float f32x4 __attribute__((ext_vector_type(4)));
typedef unsigned u32x4 __attribute__((ext_vector_type(4)));
constexpr int BM = 256, BK = 64, HALF = 128, HTB = HALF * BK * 2  , STAGE_BYTES = 8 * HTB, NXCD = 8, WGM = 8;

__host__ __device__ __forceinline__ int lds_byte(int r, int c) { const int st = (r >> 4) * 2 + (c >> 5), rr = r & 15, cc = c & 31, ob = rr * 64 + cc * 2; return st * 1024 + (ob ^ (((ob >> 9) & 1) << 5)); }
__host__ __device__ __forceinline__ void stage_rc(int b, int& R, int& C) { const int st = b / 1024, sb = b % 1024, swz = sb ^ (((sb >> 9) & 1) << 5); R = (st >> 1) * 16 + swz / 64; C = (st & 1) * 32 + (swz % 64) / 2; }
__host__ __device__ __forceinline__ int perm32(int rho) { const int n = rho >> 4, i = rho & 15; return 8 * (i >> 2) + 4 * n + (i & 3); }

struct Unit { int pm, pn; };
struct Gemm { const bf16_t* A; const bf16_t* Bt; int M, N, K; };

struct StaticOrder {
    int nM, nN, nwg, G, c;
    __host__ __device__ __forceinline__ void init(int M, int N, int G_, int c_) { nM = M / BM; nN = N / BM; nwg = nM * nN; G = G_; c = c_; }
    __host__ __device__ __forceinline__ bool next(int i, Unit& u) const {
        const long L = (long)i * G + c; if (L >= nwg) return false;
        int wgid = (int)L; { const int q = nwg / NXCD, r = nwg % NXCD, xcd = wgid % NXCD, off = wgid / NXCD; wgid = (xcd < r ? xcd * (q + 1) : r * (q + 1) + (xcd - r) * q) + off; }
        const int nig = WGM * nN, gid = wgid / nig, fm = gid * WGM, gsz = (nM - fm) < WGM ? (nM - fm) : WGM;
        u.pm = fm + ((wgid % nig) % gsz); u.pn = (wgid % nig) / gsz; return true;
    }
    __device__ __forceinline__ void a_ready(const Unit&) const {}
    __device__ __forceinline__ void done(const Unit&) const {}
};

__device__ __forceinline__ unsigned cvt_pk_bf16(float lo, float hi) { unsigned r; asm volatile("v_cvt_pk_bf16_f32 %0, %1, %2" : "=v"(r) : "v"(lo), "v"(hi)); return r; }
typedef float f32x2 __attribute__((ext_vector_type(2)));
__device__ __forceinline__ f32x2 gelu_pk(f32x2 v) {
    const f32x2 av = __builtin_elementwise_abs(v), d = av * 0.2316418882f + 1.0f;
    f32x2 t; t.x = __builtin_amdgcn_rcpf(d.x); t.y = __builtin_amdgcn_rcpf(d.y);
    f32x2 q = t * 0.5307027145f + (-0.7265760135f); q = q * t + 0.7107068705f; q = q * t + (-0.142248368f); q = q * t + 0.127414796f; q = q * t;
    const f32x2 s = (v * v) * (-0.72134752044f);
    f32x2 e; e.x = __builtin_amdgcn_exp2f(s.x); e.y = __builtin_amdgcn_exp2f(s.y);
    const f32x2 m = v * (q * e), r = v - m;
    f32x2 o; o.x = v.x < 0.f ? m.x : r.x; o.y = v.y < 0.f ? m.y : r.y; return o;
}

template <int ACT  > struct EpiBf16 {
    static constexpr bool PERM = true, AFTER_DRAIN = false, KSCALE = false, I8 = false; static_assert(ACT == 0 || ACT == 1, "EpiBf16: ACT is 0 (none) or 1 (gelu_pk)");
    bf16_t* O; int ldc; const float* bias; int split_cols; size_t split_stride; float scale0;
    __device__ __forceinline__ void operator()(const f32x4 (&acc)[2][2][4][2], const Unit& u, int wr, int wc, int fr, int fq) const {
        const int row0 = u.pm * BM + wr * 64 + fr; int colt = u.pn * BM; bf16_t* base = O;
        float sc = 1.f; if (split_cols) { const int t = colt / split_cols; base += (size_t)t * split_stride; colt -= t * split_cols; if (t == 0) sc = scale0; }
        const int col0 = colt + wc * 32 + 8 * fq, bcol0 = u.pn * BM + wc * 32 + 8 * fq;
        f32x4 bv[2][2];
#pragma unroll
        for (int bj = 0; bj < 2; ++bj)
#pragma unroll
            for (int n = 0; n < 2; ++n) bv[bj][n] = bias ? *(const PG8_GAS f32x4*)(bias + bcol0 + bj * HALF + 4 * n) : (f32x4){0.f, 0.f, 0.f, 0.f};
#pragma unroll
        for (int ai = 0; ai < 2; ++ai)
#pragma unroll
            for (int m = 0; m < 4; ++m) { bf16_t* rowp = base + (size_t)(row0 + ai * HALF + m * 16) * ldc + col0;
#pragma unroll
                for (int bj = 0; bj < 2; ++bj) { f32x4 v0 = acc[ai][bj][m][0] + bv[bj][0], v1 = acc[ai][bj][m][1] + bv[bj][1];
                    if (ACT == 1) { f32x2 a = gelu_pk((f32x2){v0[0], v0[1]}), b = gelu_pk((f32x2){v0[2], v0[3]}), c = gelu_pk((f32x2){v1[0], v1[1]}), d = gelu_pk((f32x2){v1[2], v1[3]});
                        v0 = (f32x4){a.x, a.y, b.x, b.y}; v1 = (f32x4){c.x, c.y, d.x, d.y}; }
                    v0 = v0 * sc; v1 = v1 * sc; u32x4 w; w.x = cvt_pk_bf16(v0[0], v0[1]); w.y = cvt_pk_bf16(v0[2], v0[3]); w.z = cvt_pk_bf16(v1[0], v1[1]); w.w = cvt_pk_bf16(v1[2], v1[3]);
                    *(PG8_GAS u32x4*)(rowp + bj * HALF) = w; } }
    }
};

typedef unsigned u32x2 __attribute__((ext_vector_type(2)));
typedef int i32x4 __attribute__((ext_vector_type(4)));
struct EpiResid {
    static constexpr bool PERM = false, AFTER_DRAIN = false, KSCALE = false, I8 = false;
    bf16_t* s; int ldc; u64_t* rowsq;
    __device__ __forceinline__ void operator()(const f32x4 (&acc)[2][2][4][2], const Unit& u, int wr, int wc, int fr, int fq) const {
        const int col0 = u.pn * BM + wc * 32 + 4 * fq;
#pragma unroll
        for (int ai = 0; ai < 2; ++ai)
#pragma unroll
            for (int m = 0; m < 4; ++m) { const int row = u.pm * BM + ai * HALF + wr * 64 + m * 16 + fr; bf16_t* sp = s + (size_t)row * ldc + col0; float ss = 0.f;
                u32x2 in[2][2];
#pragma unroll
                for (int bj = 0; bj < 2; ++bj)
#pragma unroll
                    for (int n = 0; n < 2; ++n) in[bj][n] = *(const PG8_GAS u32x2*)(sp + bj * HALF + n * 16);
#pragma unroll
                for (int bj = 0; bj < 2; ++bj)
#pragma unroll
                    for (int n = 0; n < 2; ++n) { const u32x2 w0 = in[bj][n];
                        const f32x4 bs = (f32x4){__builtin_bit_cast(float, w0.x << 16), __builtin_bit_cast(float, w0.x & 0xffff0000u), __builtin_bit_cast(float, w0.y << 16), __builtin_bit_cast(float, w0.y & 0xffff0000u)};
                        const f32x4 o = bs + acc[ai][bj][m][n]; ss += (o[0] * o[0] + o[1] * o[1]) + (o[2] * o[2] + o[3] * o[3]);
                        u32x2 w; w.x = cvt_pk_bf16(o[0], o[1]); w.y = cvt_pk_bf16(o[2], o[3]); *(PG8_GAS u32x2*)(sp + bj * HALF + n * 16) = w; }
                ss += shx(ss, 16, fr + 16 * fq); ss += shx(ss, 32, fr + 16 * fq);
                if (fq == 0) (void)__hip_atomic_fetch_add((PG8_GAS u64_t*)(rowsq + row), rowsq_fx(ss), __ATOMIC_RELAXED, __HIP_MEMORY_SCOPE_AGENT); }
    }
};
struct EpiResid8 {
    static constexpr bool PERM = false, AFTER_DRAIN = false, KSCALE = false, I8 = true;
    bf16_t* s; int ldc; u64_t* rowsq; const float* xsc; const float* wsc;
    __device__ __forceinline__ void operator()(const f32x4 (&acc)[2][2][4][2], const Unit& u, int wr, int wc, int fr, int fq) const {
        const int col0 = u.pn * BM + wc * 32 + 4 * fq;
#pragma unroll
        for (int ai = 0; ai < 2; ++ai)
#pragma unroll
            for (int m = 0; m < 4; ++m) { const int row = u.pm * BM + ai * HALF + wr * 64 + m * 16 + fr; bf16_t* sp = s + (size_t)row * ldc + col0; float ss = 0.f; const float xs = *(const PG8_GAS float*)(xsc + row);
                u32x2 in[2][2];
#pragma unroll
                for (int bj = 0; bj < 2; ++bj)
#pragma unroll
                    for (int n = 0; n < 2; ++n) in[bj][n] = *(const PG8_GAS u32x2*)(sp + bj * HALF + n * 16);
#pragma unroll
                for (int bj = 0; bj < 2; ++bj)
#pragma unroll
                    for (int n = 0; n < 2; ++n) { const u32x2 w0 = in[bj][n]; const i32x4 ia = __builtin_bit_cast(i32x4, acc[ai][bj][m][n]);
                        const f32x4 bs = (f32x4){__builtin_bit_cast(float, w0.x << 16), __builtin_bit_cast(float, w0.x & 0xffff0000u), __builtin_bit_cast(float, w0.y << 16), __builtin_bit_cast(float, w0.y & 0xffff0000u)};
                        const f32x4 o = bs + (f32x4){(float)ia[0], (float)ia[1], (float)ia[2], (float)ia[3]} * *(const PG8_GAS f32x4*)(wsc + col0 + bj * HALF + n * 16) * xs; ss += (o[0] * o[0] + o[1] * o[1]) + (o[2] * o[2] + o[3] * o[3]);
                        u32x2 w; w.x = cvt_pk_bf16(o[0], o[1]); w.y = cvt_pk_bf16(o[2], o[3]); *(PG8_GAS u32x2*)(sp + bj * HALF + n * 16) = w; }
                ss += shx(ss, 16, fr + 16 * fq); ss += shx(ss, 32, fr + 16 * fq);
                if (fq == 0) (void)__hip_atomic_fetch_add((PG8_GAS u64_t*)(rowsq + row), rowsq_fx(ss), __ATOMIC_RELAXED, __HIP_MEMORY_SCOPE_AGENT); }
    }
};
template <bool I8IN, int QOUT, bool DIG = false>
struct EpiResidT {
    static constexpr bool PERM = true, AFTER_DRAIN = false, KSCALE = false, I8 = I8IN;
    bf16_t* s; int ldc; u64_t* rowsq; const float* xsc; const float* wsc; unsigned char* q8; const u64_t* rowsq_prev; unsigned char* dgh; unsigned char* dgl; PG8_LAS float* part;
    __device__ __forceinline__ void operator()(const f32x4 (&acc)[2][2][4][2], const Unit& u, int wr, int wc, int fr, int fq) const {
        const int col0 = u.pn * BM + wc * 32 + 8 * fq, colw = u.pn * BM + wc * 32, rowb = u.pm * BM + wr * 64 + fr;
        f32x4 wv[2][2];
        if constexpr (I8IN) {
#pragma unroll
            for (int bj = 0; bj < 2; ++bj) { wv[bj][0] = *(const PG8_GAS f32x4*)(wsc + col0 + bj * HALF); wv[bj][1] = *(const PG8_GAS f32x4*)(wsc + col0 + bj * HALF + 4); } }
#pragma unroll
        for (int ai = 0; ai < 2; ++ai) {
            u32x4 in[4][2]; float xs[4], qv[4];
#pragma unroll
            for (int m = 0; m < 4; ++m) { const int row = rowb + ai * HALF + m * 16; const bf16_t* sp = s + (size_t)row * ldc + col0;
#pragma unroll
                for (int bj = 0; bj < 2; ++bj) in[m][bj] = *(const PG8_GAS u32x4*)(sp + bj * HALF);
                if constexpr (I8IN) xs[m] = *(const PG8_GAS float*)(xsc + row); else xs[m] = 1.f;
                if constexpr (QOUT > 0) qv[m] = (127.0f / QOUT) * rowsq_rs(rowsq_prev, row); else qv[m] = 0.f; }
            __builtin_amdgcn_sched_barrier(0);
#pragma unroll
            for (int m = 0; m < 4; ++m) { const int row = rowb + ai * HALF + m * 16; bf16_t* sp = s + (size_t)row * ldc + col0; float ss = 0.f; u32x2 qq[2] = {{0u, 0u}, {0u, 0u}};
#pragma unroll
                for (int bj = 0; bj < 2; ++bj) { const u32x4 w0 = in[m][bj]; f32x4 a0 = acc[ai][bj][m][0], a1 = acc[ai][bj][m][1];
                    if constexpr (I8IN) { const i32x4 i0 = __builtin_bit_cast(i32x4, a0), i1 = __builtin_bit_cast(i32x4, a1);
                        a0 = (f32x4){(float)i0[0], (float)i0[1], (float)i0[2], (float)i0[3]} * wv[bj][0] * xs[m];
                        a1 = (f32x4){(float)i1[0], (float)i1[1], (float)i1[2], (float)i1[3]} * wv[bj][1] * xs[m]; }
                    const f32x4 o0 = (f32x4){__builtin_bit_cast(float, w0.x << 16), __builtin_bit_cast(float, w0.x & 0xffff0000u), __builtin_bit_cast(float, w0.y << 16), __builtin_bit_cast(float, w0.y & 0xffff0000u)} + a0;
                    const f32x4 o1 = (f32x4){__builtin_bit_cast(float, w0.z << 16), __builtin_bit_cast(float, w0.z & 0xffff0000u), __builtin_bit_cast(float, w0.w << 16), __builtin_bit_cast(float, w0.w & 0xffff0000u)} + a1;
                    ss += ((o0[0] * o0[0] + o0[1] * o0[1]) + (o0[2] * o0[2] + o0[3] * o0[3])) + ((o1[0] * o1[0] + o1[1] * o1[1]) + (o1[2] * o1[2] + o1[3] * o1[3]));
                    u32x4 w; w.x = cvt_pk_bf16(o0[0], o0[1]); w.y = cvt_pk_bf16(o0[2], o0[3]); w.z = cvt_pk_bf16(o1[0], o1[1]); w.w = cvt_pk_bf16(o1[2], o1[3]); *(PG8_GAS u32x4*)(sp + bj * HALF) = w;
                    if constexpr (QOUT > 0) { qq[bj].x = q8x4c<DIG ? 247 : 255>(o0[0], o0[1], o0[2], o0[3], qv[m]); qq[bj].y = q8x4c<DIG ? 247 : 255>(o1[0], o1[1], o1[2], o1[3], qv[m]); } }
                if constexpr (QOUT > 0) {
                    const auto sx = __builtin_amdgcn_permlane16_swap(qq[0].x, qq[1].x, false, false), sy = __builtin_amdgcn_permlane16_swap(qq[0].y, qq[1].y, false, false);
                    *(PG8_GAS u32x4*)(q8 + (size_t)row * ldc + colw + ((fq & 1) ? HALF + 8 * (fq - 1) : 8 * fq)) = (u32x4){sx[0], sy[0], sx[1], sy[1]};
                    if constexpr (DIG) {
                        unsigned r0 = nib_pack8(dig_lo4(qq[0].x), dig_lo4(qq[0].y)), r1 = nib_pack8(dig_hi4(qq[0].x), dig_hi4(qq[0].y)), r2 = nib_pack8(dig_lo4(qq[1].x), dig_lo4(qq[1].y)), r3 = nib_pack8(dig_hi4(qq[1].x), dig_hi4(qq[1].y));
                        const auto t01 = __builtin_amdgcn_permlane16_swap(r0, r1, false, false), t23 = __builtin_amdgcn_permlane16_swap(r2, r3, false, false);
                        const auto u02 = __builtin_amdgcn_permlane32_swap(t01[0], t23[0], false, false), u13 = __builtin_amdgcn_permlane32_swap(t01[1], t23[1], false, false);
                        unsigned char* pl = (fq & 1) ? dgh : dgl;
                        *(PG8_GAS u32x4*)(pl + (size_t)row * 1024 + (colw >> 1) + (fq >> 1) * (HALF / 2)) = (u32x4){u02[0], u13[0], u02[1], u13[1]}; } }
                ss += shx(ss, 16, fr + 16 * fq); ss += shx(ss, 32, fr + 16 * fq);
                if (fq == 0) part[(row - u.pm * BM) * 4 + wc] = ss; }
            __builtin_amdgcn_sched_barrier(0);
        }
        asm volatile("s_waitcnt lgkmcnt(0)" ::: "memory"); __builtin_amdgcn_s_barrier();
        {   const int tid = ((wr * 4 + wc) * 4 + fq) * 16 + fr;
            if (tid < BM) { const f32x4 p4 = *(const PG8_LAS f32x4*)(part + 4 * tid);
                (void)__hip_atomic_fetch_add((PG8_GAS u64_t*)(rowsq + u.pm * BM + tid), rowsq_fx((p4[0] + p4[1]) + (p4[2] + p4[3])), __ATOMIC_RELAXED, __HIP_MEMORY_SCOPE_AGENT); } }
    }
};
template <int QIN>
struct EpiBf16Row8 {
    static constexpr bool PERM = true, AFTER_DRAIN = false, KSCALE = false, I8 = true;
    bf16_t* O; int ldc; const u64_t* rowsq; const u64_t* rowsq_prev; const float* wsc;
    __device__ __forceinline__ void operator()(const f32x4 (&acc)[2][2][4][2], const Unit& u, int wr, int wc, int fr, int fq) const {
        const int row0 = u.pm * BM + wr * 64 + fr, col0 = u.pn * BM + wc * 32 + 8 * fq;
        float rs[2][4]; f32x4 wv[2][2];
        {   u64_t qa[2][4], qb[2][4];
#pragma unroll
            for (int ai = 0; ai < 2; ++ai)
#pragma unroll
                for (int m = 0; m < 4; ++m) { const int row = row0 + ai * HALF + m * 16; qa[ai][m] = *(const PG8_GAS u64_t*)(rowsq + row); qb[ai][m] = *(const PG8_GAS u64_t*)(rowsq_prev + row); }
            __builtin_amdgcn_sched_barrier(0);
#pragma unroll
            for (int ai = 0; ai < 2; ++ai)
#pragma unroll
                for (int m = 0; m < 4; ++m) rs[ai][m] = (QIN / 127.0f) * sqrtf((float)qb[ai][m] * (5.9604644775390625e-08f / 2048.0f) + 1e-6f) / sqrtf((float)qa[ai][m] * (5.9604644775390625e-08f / 2048.0f) + 1e-6f); }
#pragma unroll
        for (int bj = 0; bj < 2; ++bj) { wv[bj][0] = *(const PG8_GAS f32x4*)(wsc + col0 + bj * HALF); wv[bj][1] = *(const PG8_GAS f32x4*)(wsc + col0 + bj * HALF + 4); }
        __builtin_amdgcn_sched_barrier(0);
#pragma unroll
        for (int ai = 0; ai < 2; ++ai)
#pragma unroll
            for (int m = 0; m < 4; ++m) { const int row = row0 + ai * HALF + m * 16; bf16_t* rowp = O + (size_t)row * ldc + col0;
#pragma unroll
                for (int bj = 0; bj < 2; ++bj) { const i32x4 i0 = __builtin_bit_cast(i32x4, acc[ai][bj][m][0]), i1 = __builtin_bit_cast(i32x4, acc[ai][bj][m][1]);
                    const f32x4 v0 = (f32x4){(float)i0[0], (float)i0[1], (float)i0[2], (float)i0[3]} * wv[bj][0] * rs[ai][m], v1 = (f32x4){(float)i1[0], (float)i1[1], (float)i1[2], (float)i1[3]} * wv[bj][1] * rs[ai][m];
                    u32x4 w; w.x = cvt_pk_bf16(v0[0], v0[1]); w.y = cvt_pk_bf16(v0[2], v0[3]); w.z = cvt_pk_bf16(v1[0], v1[1]); w.w = cvt_pk_bf16(v1[2], v1[3]);
                    *(PG8_GAS u32x4*)(rowp + bj * HALF) = w; } }
    }
};
struct EpiBf16Q8 {
    static constexpr bool PERM = true, AFTER_DRAIN = false, KSCALE = false, I8 = true;
    bf16_t* O; int ldc; const float* xs; const float* wsc;
    __device__ __forceinline__ void operator()(const f32x4 (&acc)[2][2][4][2], const Unit& u, int wr, int wc, int fr, int fq) const {
        const int row0 = u.pm * BM + wr * 64 + fr, col0 = u.pn * BM + wc * 32 + 8 * fq;
        float rs[2][4]; f32x4 wv[2][2];
#pragma unroll
        for (int ai = 0; ai < 2; ++ai)
#pragma unroll
            for (int m = 0; m < 4; ++m) rs[ai][m] = *(const PG8_GAS float*)(xs + row0 + ai * HALF + m * 16);
#pragma unroll
        for (int bj = 0; bj < 2; ++bj) { wv[bj][0] = *(const PG8_GAS f32x4*)(wsc + col0 + bj * HALF); wv[bj][1] = *(const PG8_GAS f32x4*)(wsc + col0 + bj * HALF + 4); }
        __builtin_amdgcn_sched_barrier(0);
#pragma unroll
        for (int ai = 0; ai < 2; ++ai)
#pragma unroll
            for (int m = 0; m < 4; ++m) { const int row = row0 + ai * HALF + m * 16; bf16_t* rowp = O + (size_t)row * ldc + col0;
#pragma unroll
                for (int bj = 0; bj < 2; ++bj) { const i32x4 i0 = __builtin_bit_cast(i32x4, acc[ai][bj][m][0]), i1 = __builtin_bit_cast(i32x4, acc[ai][bj][m][1]);
                    const f32x4 v0 = (f32x4){(float)i0[0], (float)i0[1], (float)i0[2], (float)i0[3]} * wv[bj][0] * rs[ai][m], v1 = (f32x4){(float)i1[0], (float)i1[1], (float)i1[2], (float)i1[3]} * wv[bj][1] * rs[ai][m];
                    u32x4 w; w.x = cvt_pk_bf16(v0[0], v0[1]); w.y = cvt_pk_bf16(v0[2], v0[3]); w.z = cvt_pk_bf16(v1[0], v1[1]); w.w = cvt_pk_bf16(v1[2], v1[3]);
                    *(PG8_GAS u32x4*)(rowp + bj * HALF) = w; } }
    }
};
struct EpiResidMix {
    static constexpr bool PERM = false, AFTER_DRAIN = false, KSCALE = true, I8 = false; static constexpr int KS0 = 12, KS1 = 20;
    bf16_t* s; int ldc; u64_t* rowsq; const PG8_LAS float* ftab; const PG8_LAS int* pmtab;
    __device__ __forceinline__ int slot(int pm) const { return pmtab[0] == pm ? 0 : (pmtab[1] == pm ? 1 : (pmtab[2] == pm ? 2 : 3)); }
    __device__ __forceinline__ void kscale(f32x4 (&acc)[2][2][4][2], const Unit& u, int which, int wr, int fr) const {
        const PG8_LAS float* ft = ftab + which * 1024 + slot(u.pm) * 256;
#pragma unroll
        for (int ai = 0; ai < 2; ++ai)
#pragma unroll
            for (int m = 0; m < 4; ++m) { const float f = ft[ai * HALF + wr * 64 + m * 16 + fr];
#pragma unroll
                for (int bj = 0; bj < 2; ++bj)
#pragma unroll
                    for (int n = 0; n < 2; ++n) acc[ai][bj][m][n] = acc[ai][bj][m][n] * f; }
    }
    __device__ __forceinline__ void operator()(const f32x4 (&acc)[2][2][4][2], const Unit& u, int wr, int wc, int fr, int fq) const {
        const int col0 = u.pn * BM + wc * 32 + 4 * fq;
#pragma unroll
        for (int ai = 0; ai < 2; ++ai)
#pragma unroll
            for (int m = 0; m < 4; ++m) { const int row = u.pm * BM + ai * HALF + wr * 64 + m * 16 + fr; bf16_t* sp = s + (size_t)row * ldc + col0; float ss = 0.f; const float rc = ftab[2048 + slot(u.pm) * 256 + ai * HALF + wr * 64 + m * 16 + fr];
                u32x2 in[2][2];
#pragma unroll
                for (int bj = 0; bj < 2; ++bj)
#pragma unroll
                    for (int n = 0; n < 2; ++n) in[bj][n] = *(const PG8_GAS u32x2*)(sp + bj * HALF + n * 16);
#pragma unroll
                for (int bj = 0; bj < 2; ++bj)
#pragma unroll
                    for (int n = 0; n < 2; ++n) { const u32x2 w0 = in[bj][n];
                        const f32x4 bs = (f32x4){__builtin_bit_cast(float, w0.x << 16), __builtin_bit_cast(float, w0.x & 0xffff0000u), __builtin_bit_cast(float, w0.y << 16), __builtin_bit_cast(float, w0.y & 0xffff0000u)};
                        const f32x4 o = bs + acc[ai][bj][m][n] * rc; ss += (o[0] * o[0] + o[1] * o[1]) + (o[2] * o[2] + o[3] * o[3]);
                        u32x2 w; w.x = cvt_pk_bf16(o[0], o[1]); w.y = cvt_pk_bf16(o[2], o[3]); *(PG8_GAS u32x2*)(sp + bj * HALF + n * 16) = w; }
                ss += shx(ss, 16, fr + 16 * fq); ss += shx(ss, 32, fr + 16 * fq);
                if (fq == 0) (void)__hip_atomic_fetch_add((PG8_GAS u64_t*)(rowsq + row), rowsq_fx(ss), __ATOMIC_RELAXED, __HIP_MEMORY_SCOPE_AGENT); }
    }
};
struct EpiBf16Row {
    static constexpr bool PERM = true, AFTER_DRAIN = false, KSCALE = false, I8 = false;
    bf16_t* O; int ldc; const u64_t* rowsq;
    __device__ __forceinline__ void operator()(const f32x4 (&acc)[2][2][4][2], const Unit& u, int wr, int wc, int fr, int fq) const {
        const int row0 = u.pm * BM + wr * 64 + fr, col0 = u.pn * BM + wc * 32 + 8 * fq;
#pragma unroll
        for (int ai = 0; ai < 2; ++ai)
#pragma unroll
            for (int m = 0; m < 4; ++m) { const int row = row0 + ai * HALF + m * 16; const float rs = rowsq_rs(rowsq, row); bf16_t* rowp = O + (size_t)row * ldc + col0;
#pragma unroll
                for (int bj = 0; bj < 2; ++bj) { const f32x4 v0 = acc[ai][bj][m][0] * rs, v1 = acc[ai][bj][m][1] * rs; u32x4 w; w.x = cvt_pk_bf16(v0[0], v0[1]); w.y = cvt_pk_bf16(v0[2], v0[3]); w.z = cvt_pk_bf16(v1[0], v1[1]); w.w = cvt_pk_bf16(v1[2], v1[3]);
                    *(PG8_GAS u32x4*)(rowp + bj * HALF) = w; } }
    }
};
struct EpiQKV {
    static constexpr bool PERM = false, AFTER_DRAIN = false, KSCALE = false, I8 = true;
    bf16_t* O; const float* ga; const float* gb; const float* gc; const PG8_LAS float* rope; const u64_t* rowsq; const float* xsc; const float* wsc;
    __device__ __forceinline__ void operator()(const f32x4 (&acc)[2][2][4][2], const Unit& u, int wr, int wc, int fr, int fq) const {
        const int hg = u.pn * 4 + wc;
        const float* g = nullptr; bool isq = false, dorope = false;
        if (hg < 12) { g = ga; isq = true; } else if (hg < 16) { g = ga + 64; } else if (hg < 20) { }
        else if (hg < 28) { g = gb; isq = true; } else if (hg < 36) { g = gb + 64; } else if (hg < 44) { }
        else if (hg < 56) { g = gc; isq = true; dorope = true; } else if (hg < 60) { g = gc + 64; dorope = true; }
        const float qs = isq ? 0.18033688011112042f : 1.0f;
        float rsxa[2][4]; f32x4 wv[2][2], gv[2][2];
#pragma unroll
        for (int ai = 0; ai < 2; ++ai)
#pragma unroll
            for (int m = 0; m < 4; ++m) { const int row = u.pm * BM + ai * HALF + wr * 64 + m * 16 + fr; rsxa[ai][m] = *(const PG8_GAS float*)(xsc + row); }
#pragma unroll
        for (int bj = 0; bj < 2; ++bj)
#pragma unroll
            for (int n = 0; n < 2; ++n) { wv[bj][n] = *(const PG8_GAS f32x4*)(wsc + hg * 64 + 32 * bj + 16 * n + 4 * fq); gv[bj][n] = g ? *(const PG8_GAS f32x4*)(g + 32 * bj + 16 * n + 4 * fq) : (f32x4){1.f, 1.f, 1.f, 1.f}; }
        __builtin_amdgcn_sched_barrier(0);
#pragma unroll
        for (int ai = 0; ai < 2; ++ai)
#pragma unroll
            for (int m = 0; m < 4; ++m) {
                const int row = u.pm * BM + ai * HALF + wr * 64 + m * 16 + fr;
                f32x4 v[2][2];
                const float rsx = rsxa[ai][m];
#pragma unroll
                for (int bj = 0; bj < 2; ++bj)
#pragma unroll
                    for (int n = 0; n < 2; ++n) { const i32x4 ia = __builtin_bit_cast(i32x4, acc[ai][bj][m][n]);
                        v[bj][n] = (f32x4){(float)ia[0], (float)ia[1], (float)ia[2], (float)ia[3]} * wv[bj][n] * rsx; }
                if (g) {
                    float ss = 0.f;
#pragma unroll
                    for (int bj = 0; bj < 2; ++bj)
#pragma unroll
                        for (int n = 0; n < 2; ++n) { const f32x4 x = v[bj][n]; ss += (x[0] * x[0] + x[1] * x[1]) + (x[2] * x[2] + x[3] * x[3]); }
                    ss += shx(ss, 16, fr + 16 * fq); ss += shx(ss, 32, fr + 16 * fq);
                    const float r = qs / sqrtf(ss * (1.0f / 64.0f) + 1e-6f);
#pragma unroll
                    for (int bj = 0; bj < 2; ++bj)
#pragma unroll
                        for (int n = 0; n < 2; ++n) v[bj][n] = v[bj][n] * gv[bj][n] * r;
                }
                if (dorope) {
                    const int t = row & 2047, pr = t >> 6, pc = t & 63;
#pragma unroll
                    for (int bj = 0; bj < 2; ++bj) {
                        const int pos = bj ? pc : pr;
                        const PG8_LAS float* rp = rope + (pos * 16 + 4 * fq) * 2;
                        const f32x4 c01 = *(const PG8_LAS f32x4*)rp, c23 = *(const PG8_LAS f32x4*)(rp + 4);
                        const f32x4 cs = (f32x4){c01[0], c01[2], c23[0], c23[2]}, sn = (f32x4){c01[1], c01[3], c23[1], c23[3]};
                        const f32x4 x1 = v[bj][0], x2 = v[bj][1];
                        v[bj][0] = x1 * cs - x2 * sn; v[bj][1] = x1 * sn + x2 * cs;
                    }
                }
                bf16_t* rowp = O + (size_t)row * 4096 + hg * 64 + ((fq & 1) ? 16 + 4 * (fq - 1) : 4 * fq);
#pragma unroll
                for (int bj = 0; bj < 2; ++bj) {
                    const unsigned ax = cvt_pk_bf16(v[bj][0][0], v[bj][0][1]), ay = cvt_pk_bf16(v[bj][0][2], v[bj][0][3]), bx = cvt_pk_bf16(v[bj][1][0], v[bj][1][1]), by = cvt_pk_bf16(v[bj][1][2], v[bj][1][3]);
                    const auto sx = __builtin_amdgcn_permlane16_swap(ax, bx, false, false), sy = __builtin_amdgcn_permlane16_swap(ay, by, false, false);
                    *(PG8_GAS u32x4*)(rowp + 32 * bj) = (u32x4){sx[0], sy[0], sx[1], sy[1]}; }
                asm volatile("" ::: "memory");
            }
    }
};
template <bool I8> __device__ __forceinline__ f32x4 mma16(const bf16x8 b, const bf16x8 a, const f32x4 c) {
    if constexpr (I8) return __builtin_bit_cast(f32x4, __builtin_amdgcn_mfma_i32_16x16x64_i8(__builtin_bit_cast(i32x4, b), __builtin_bit_cast(i32x4, a), __builtin_bit_cast(i32x4, c), 0, 0, 0));
    else return __builtin_amdgcn_mfma_f32_16x16x32_bf16(b, a, c, 0, 0, 0);
}
template <class Epi, class Sched, bool ALIGN_EPI = false, bool SP2 = false>
__device__ __forceinline__ void gemm_phase(PG8_LAS unsigned char* lds, const Gemm g, const Sched& S, const Epi& E, const int tid) {
    const int wid = __builtin_amdgcn_readfirstlane(tid >> 6), lane = tid & 63, wr = wid >> 2, wc = wid & 3, fr = lane & 15, fq = lane >> 4;
    const int K = g.K, nt = K / BK;
    unsigned voffA[2], voffB[2];
#pragma unroll
    for (int i = 0; i < 2; ++i) { int R, C; stage_rc(tid * 16 + i * 8192, R, C); const int Rb = Epi::PERM ? ((R & ~31) + perm32(R & 31)) : R;
        voffA[i] = (unsigned)(R * K + C) * 2u; voffB[i] = (unsigned)(Rb * K + C) * 2u; }
    const size_t kstep = (size_t)(BK * 2);
    const size_t hstep = (size_t)HALF * K * 2;
    const size_t tstep = 2 * hstep;
    const unsigned ldsw = (unsigned)wid * 1024u;
    const int aoff = lds_byte(wr * 64 + fr, fq * 8), boff = lds_byte(wc * 32 + fr, fq * 8);
#define PG8_SA(b, h) (((b) * 2 + (h)) * HTB)
#define PG8_SB(b, h) ((4 + (b) * 2 + (h)) * HTB)
#define PG8_STAGE(bufoff, gbase, voff) do { _Pragma("unroll") for (int _i = 0; _i < 2; ++_i) \
        __builtin_amdgcn_global_load_lds((const unsigned*)((const char*)(gbase) + (voff)[_i]), (PG8_LAS unsigned*)(lds + (bufoff) + ldsw + _i * 8192), 16, 0, 0); } while (0)
#define PG8_LDA(dst, b, h) do { _Pragma("unroll") for (int m = 0; m < 4; ++m) _Pragma("unroll") for (int k = 0; k < 2; ++k) dst[m][k] = *(const PG8_LAS bf16x8*)(lds + PG8_SA(b, h) + aoff + m * 2048 + k * 1024); } while (0)
#define PG8_LDB(dst, b, h) do { _Pragma("unroll") for (int n = 0; n < 2; ++n) _Pragma("unroll") for (int k = 0; k < 2; ++k) dst[n][k] = *(const PG8_LAS bf16x8*)(lds + PG8_SB(b, h) + boff + n * 2048 + k * 1024); } while (0)
#define PG8_MMA(ai, bj, At, Bt) do { __builtin_amdgcn_s_setprio(1); _Pragma("unroll") for (int m = 0; m < 4; ++m) _Pragma("unroll") for (int n = 0; n < 2; ++n) _Pragma("unroll") for (int k = 0; k < 2; ++k) \
        acc[ai][bj][m][n] = mma16<Epi::I8>(Bt[n][k], At[m][k], acc[ai][bj][m][n]); __builtin_amdgcn_s_setprio(0); } while (0)
#define PG8_WAIT_V(n) asm volatile("s_waitcnt vmcnt(" #n ")" ::: "memory")
#define PG8_WAIT_L(n) asm volatile("s_waitcnt lgkmcnt(" #n ")" ::: "memory")
#define PG8_BAR __builtin_amdgcn_s_barrier()
#define PG8_SCHED __builtin_amdgcn_sched_barrier(0)
    Unit cur, nxt; int ui = 0;
    if (!S.next(0, cur)) return;
    f32x4 acc[2][2][4][2];
#pragma unroll
    for (int a = 0; a < 2; ++a)
#pragma unroll
        for (int b = 0; b < 2; ++b)
#pragma unroll
            for (int m = 0; m < 4; ++m)
#pragma unroll
                for (int n = 0; n < 2; ++n) acc[a][b][m][n] = (f32x4){0.f, 0.f, 0.f, 0.f};
    bf16x8 At[4][2], B0[2][2], B1[2][2];
    const char* cA = (const char*)g.A + (size_t)cur.pm * tstep; const char* cB = (const char*)g.Bt + (size_t)cur.pn * tstep;
    S.a_ready(cur);
    if constexpr (SP2) {
        PG8_STAGE(PG8_SB(0, 0), cB, voffB); PG8_STAGE(PG8_SB(0, 1), cB + hstep, voffB); PG8_STAGE(PG8_SA(0, 0), cA, voffA); PG8_STAGE(PG8_SA(0, 1), cA + hstep, voffA);
        if (wr == 1) PG8_BAR;
        PG8_WAIT_V(2); PG8_BAR;
        PG8_STAGE(PG8_SB(1, 0), cB + kstep, voffB); PG8_STAGE(PG8_SA(1, 0), cA + kstep, voffA); PG8_STAGE(PG8_SB(1, 1), cB + hstep + kstep, voffB);
        PG8_WAIT_V(6); PG8_BAR;
    } else {
        PG8_STAGE(PG8_SB(0, 0), cB, voffB); PG8_STAGE(PG8_SA(0, 0), cA, voffA); PG8_STAGE(PG8_SB(0, 1), cB + hstep, voffB); PG8_STAGE(PG8_SA(0, 1), cA + hstep, voffA);
        if (wr == 1) PG8_BAR;
        PG8_WAIT_V(4); PG8_BAR;
        PG8_STAGE(PG8_SB(1, 0), cB + kstep, voffB); PG8_STAGE(PG8_SA(1, 0), cA + kstep, voffA); PG8_STAGE(PG8_SB(1, 1), cB + hstep + kstep, voffB);
        PG8_WAIT_V(6); PG8_BAR;
    }
    for (;;) {
        const bool has_next = S.next(ui + 1, nxt);
        const char* nA = has_next ? (const char*)g.A + (size_t)nxt.pm * tstep : cA; const char* nB = has_next ? (const char*)g.Bt + (size_t)nxt.pn * tstep : cB;
        for (int t = 0; t < nt; t += 2) {
            if constexpr (Epi::KSCALE) { if (t == Epi::KS0 || t == Epi::KS1) E.kscale(acc, cur, t == Epi::KS1 ? 1 : 0, wr, fr); }
            const bool last = (t == nt - 2);
            const char* a1 = cA + (size_t)(t + 1) * kstep;
            const char* a2 = last ? nA : cA + (size_t)(t + 2) * kstep; const char* b2 = last ? nB : cB + (size_t)(t + 2) * kstep;
            const char* a3 = a2 + kstep; const char* b3 = b2 + kstep;
            if (last && has_next) S.a_ready(nxt);
            if constexpr (SP2) {
            PG8_LDB(B0, 0, 0); PG8_LDB(B1, 0, 1); PG8_SCHED; PG8_LDA(At, 0, 0); PG8_STAGE(PG8_SA(1, 1), a1 + hstep, voffA);
            PG8_WAIT_V(8); PG8_WAIT_L(0); PG8_BAR; PG8_MMA(0, 0, At, B0); PG8_MMA(0, 1, At, B1); PG8_BAR; PG8_SCHED;
            PG8_LDA(At, 0, 1); PG8_STAGE(PG8_SB(0, 0), b2, voffB); PG8_STAGE(PG8_SB(0, 1), b2 + hstep, voffB); PG8_STAGE(PG8_SA(0, 0), a2, voffA);
            PG8_WAIT_V(8); PG8_WAIT_L(0); PG8_BAR; PG8_MMA(1, 0, At, B0); PG8_MMA(1, 1, At, B1); PG8_BAR; PG8_SCHED;
            PG8_LDB(B0, 1, 0); PG8_LDB(B1, 1, 1); PG8_SCHED; PG8_LDA(At, 1, 0); PG8_STAGE(PG8_SA(0, 1), a2 + hstep, voffA);
            PG8_WAIT_V(8); PG8_WAIT_L(0); PG8_BAR; PG8_MMA(0, 0, At, B0); PG8_MMA(0, 1, At, B1); PG8_BAR; PG8_SCHED;
            PG8_LDA(At, 1, 1); PG8_STAGE(PG8_SB(1, 0), b3, voffB); PG8_STAGE(PG8_SB(1, 1), b3 + hstep, voffB); PG8_STAGE(PG8_SA(1, 0), a3, voffA);
            PG8_WAIT_V(8); PG8_WAIT_L(0); PG8_BAR; PG8_MMA(1, 0, At, B0); PG8_MMA(1, 1, At, B1); PG8_BAR; PG8_SCHED;
            } else {
            PG8_LDB(B0, 0, 0); PG8_SCHED; PG8_LDA(At, 0, 0); PG8_STAGE(PG8_SA(1, 1), a1 + hstep, voffA);
            PG8_WAIT_L(8); PG8_BAR; PG8_WAIT_L(0); PG8_MMA(0, 0, At, B0); PG8_BAR; PG8_SCHED;
            PG8_LDB(B1, 0, 1); PG8_STAGE(PG8_SB(0, 0), b2, voffB);
            PG8_BAR; PG8_WAIT_L(0); PG8_MMA(0, 1, At, B1); PG8_BAR;
            PG8_LDA(At, 0, 1); PG8_STAGE(PG8_SA(0, 0), a2, voffA);
            PG8_BAR; PG8_WAIT_L(0); PG8_MMA(1, 0, At, B0); PG8_BAR; PG8_SCHED;
            PG8_STAGE(PG8_SB(0, 1), b2 + hstep, voffB);
            PG8_WAIT_V(6); PG8_BAR; PG8_MMA(1, 1, At, B1); PG8_BAR;
            PG8_LDB(B0, 1, 0); PG8_SCHED; PG8_LDA(At, 1, 0); PG8_STAGE(PG8_SA(0, 1), a2 + hstep, voffA);
            PG8_WAIT_L(8); PG8_BAR; PG8_WAIT_L(0); PG8_MMA(0, 0, At, B0); PG8_BAR; PG8_SCHED;
            PG8_LDB(B1, 1, 1); PG8_STAGE(PG8_SB(1, 0), b3, voffB);
            PG8_BAR; PG8_WAIT_L(0); PG8_MMA(0, 1, At, B1); PG8_BAR;
            PG8_LDA(At, 1, 1); PG8_STAGE(PG8_SA(1, 0), a3, voffA);
            PG8_BAR; PG8_WAIT_L(0); PG8_MMA(1, 0, At, B0); PG8_BAR; PG8_SCHED;
            PG8_STAGE(PG8_SB(1, 1), b3 + hstep, voffB);
            PG8_WAIT_V(6); PG8_BAR; PG8_MMA(1, 1, At, B1); PG8_BAR;
            }
        }
        if constexpr (ALIGN_EPI) { if (wr == 0) PG8_BAR; }
        if constexpr (!Epi::AFTER_DRAIN) { E(acc, cur, wr, wc, fr, fq); S.done(cur); }
        if (!has_next) break;
#pragma unroll
        for (int a = 0; a < 2; ++a)
#pragma unroll
            for (int b = 0; b < 2; ++b)
#pragma unroll
                for (int m = 0; m < 4; ++m)
#pragma unroll
                    for (int n = 0; n < 2; ++n) acc[a][b][m][n] = (f32x4){0.f, 0.f, 0.f, 0.f};
        cur = nxt; cA = nA; cB = nB; ++ui;
        if constexpr (ALIGN_EPI) { if (wr == 1) PG8_BAR; }
    }
    PG8_WAIT_V(0);
    if constexpr (!ALIGN_EPI) { if (wr == 0) PG8_BAR; }
    PG8_BAR;
    if constexpr (Epi::AFTER_DRAIN) { E.fused(acc, cur, wr, wc, fr, fq, lds, wid, lane); S.done(cur); }
#undef PG8_SA
#undef PG8_SB
#undef PG8_STAGE
#undef PG8_LDA
#undef PG8_LDB
#undef PG8_MMA
#undef PG8_WAIT_V
#undef PG8_WAIT_L
#undef PG8_BAR
#undef PG8_SCHED
}
}

constexpr int BATCH = 16, SEQ = 2048, DM = 2048, T = BATCH * SEQ, DEPTH = 2;
constexpr int NMEM = 256, DIN = 4096, MEMW = 512;
constexpr int PEER_H = 8, PEER_N = 16384;
constexpr int NWAVES = 8, NTHREADS = NWAVES * 64;
constexpr float EPS = 1e-6f;
constexpr int QA = 0, KA = 768, VA = 1024, QB = 1280, KB = 1792, VB = 2304, QC = 2816, KC = 3584, VC = 3840;
constexpr int OA = 0, OB = 768, OC = 1280;

constexpr size_t MiB = 1u << 20;
constexpr size_t WS_CTL = 0, CTL_ZERO_BYTES = 2 * MiB;
constexpr size_t WS_ROWSQ = 256 * 1024;
constexpr size_t WS_ROPE = 83 * MiB, WS_BIASA = 83 * MiB + 16384;
constexpr size_t WS_WIN = 2 * MiB, WS_WOUT = 34 * MiB, WS_WMQ = 50 * MiB, WS_WMKV = 54 * MiB, WS_WMO = 62 * MiB, WS_WPQ = 66 * MiB, WS_PKEYS = 82 * MiB;
constexpr size_t WS_MEMN = 84 * MiB, WS_KVM = 116 * MiB, WS_PU = 132 * MiB, WS_PV = 260 * MiB, WS_XN = 388 * MiB, WS_QKV = 516 * MiB, WS_ATT = 772 * MiB;
constexpr size_t WS_QM = 900 * MiB, WS_OM = 932 * MiB, WS_MIXSQ = 964 * MiB, MIXSQ_BYTES = 2 * MiB, WS_WIN8 = 966 * MiB, WS_WSC = 982 * MiB, WS_XSC = 982 * MiB + 65536, WS_XSC2 = 982 * MiB + 196608, WS_WSCO = 982 * MiB + 327680, WS_WSCP = 982 * MiB + 344064, WS_WSCM = 982 * MiB + 360448,
                 WS_WOUT8 = 984 * MiB, WS_WPQ8 = 992 * MiB, WS_WMQ8 = 1000 * MiB, WS_END = 1002 * MiB;
constexpr size_t WS_QP = WS_QKV, WS_PIDX = WS_QKV + 128 * MiB, WS_PGATE = WS_QKV + 144 * MiB, WS_PARTI = WS_QKV + 160 * MiB;
constexpr size_t WS_XQH = 836 * MiB, WS_XQL = 868 * MiB;
constexpr size_t WS_XQH_OLD = 900 * MiB, WS_XQL_OLD = 932 * MiB;
constexpr size_t WS_ATT8 = 900 * MiB;
constexpr size_t WS_WSCKV = 982 * MiB + 368640, WS_MEMS = 982 * MiB + 376832;
constexpr size_t WS_X8 = 772 * MiB;
constexpr size_t WS_XN8 = 836 * MiB;
constexpr int CW_BAR = 4096;

constexpr int RING_OFF = 0, RING_BYTES = 131072;
constexpr int LDSCTL_OFF = RING_BYTES, MISC_OFF = LDSCTL_OFF + 320;
constexpr int LDS_BYTES = 147456;

#define GAS __attribute__((address_space(1)))
#define LAS __attribute__((address_space(3)))
typedef unsigned short bf16;
typedef unsigned v4u __attribute__((ext_vector_type(4)));
typedef unsigned v2u __attribute__((ext_vector_type(2)));
typedef float f32x4 __attribute__((ext_vector_type(4)));
typedef float f32x16 __attribute__((ext_vector_type(16)));
typedef short bf16x8 __attribute__((ext_vector_type(8)));
typedef GAS unsigned gu32;
#define LDS_WAIT() asm volatile("s_waitcnt lgkmcnt(0)" ::: "memory")
#define VM_WAIT() asm volatile("s_waitcnt vmcnt(0)" ::: "memory")
__device__ __forceinline__ unsigned f2bf(float f) { unsigned u = __builtin_bit_cast(unsigned, f); return (u + 0x7fffu + ((u >> 16) & 1u)) >> 16; }
__device__ __forceinline__ unsigned pk2(float lo, float hi) { return f2bf(lo) | (f2bf(hi) << 16); }
__device__ __forceinline__ float bflo(unsigned w) { return __builtin_bit_cast(float, w << 16); }
__device__ __forceinline__ float bfhi(unsigned w) { return __builtin_bit_cast(float, w & 0xffff0000u); }

__device__ __forceinline__ float shx(float v, int k, int lane) { return __builtin_bit_cast(float, __builtin_amdgcn_ds_bpermute((lane ^ k) << 2, __builtin_bit_cast(int, v))); }
#define XB_TMO      128
#define XB_XCNT(j)  (256  + 64 * (j))
#define XB_XSUB(j)  (1280 + 64 * (j))
#define XB_XGEN(j)  (2304 + 64 * (j))
#define XB_TOP      3328
#define XB_TOPGEN   3392
#define XCD_BAR_WORDS 3456
#define XB_SPIN_CAP (1u << 18)

__device__ __forceinline__ unsigned xb_ld(unsigned* p)              { return __hip_atomic_load(p, __ATOMIC_RELAXED, __HIP_MEMORY_SCOPE_AGENT); }
__device__ __forceinline__ unsigned xb_add(unsigned* p, unsigned v) { return __hip_atomic_fetch_add(p, v, __ATOMIC_RELAXED, __HIP_MEMORY_SCOPE_AGENT); }
__device__ __forceinline__ unsigned xb_xcc_id() { return (unsigned)__builtin_amdgcn_s_getreg((3 << 11) | 20) & 0xFu; }
#define XB_SPIN(cond, bar) do { unsigned _sp = 0; while (cond) { __builtin_amdgcn_s_sleep(1); \
    if ((++_sp & 255u) == 0u) { if (xb_ld(&(bar)[XB_TMO])) break; if (_sp > XB_SPIN_CAP) { atomicAdd(&(bar)[XB_TMO], 1u); break; } } } } while (0)

struct XcdBarrier {
    unsigned* bar; unsigned x;
    volatile LAS unsigned* st;
};

__device__ __forceinline__ XcdBarrier xcd_barrier_post(unsigned* bar, volatile LAS unsigned* st) {
    XcdBarrier b; b.bar = bar; b.x = xb_xcc_id(); b.st = st;
    if (threadIdx.x == 0) (void)xb_add(&bar[XB_XCNT(b.x)], 1u);
    return b;
}
__device__ __forceinline__ void xcd_barrier_complete(unsigned* bar, unsigned x, unsigned& nloc, unsigned& nx) {
    const unsigned G = gridDim.x * gridDim.y * gridDim.z;
    unsigned sum, cnt, mine, sp = 0u;
    for (;;) {
        sum = 0u; cnt = 0u; mine = 0u;
#pragma unroll
        for (unsigned j = 0; j < 16; ++j) { const unsigned c = xb_ld(&bar[XB_XCNT(j)]); sum += c; cnt += (c > 0u) ? 1u : 0u; mine = (j == x) ? c : mine; }
        if (sum == G) break;
        __builtin_amdgcn_s_sleep(1);
        if ((++sp & 255u) == 0u) { if (xb_ld(&bar[XB_TMO])) break; if (sp > XB_SPIN_CAP) { atomicAdd(&bar[XB_TMO], 1u); break; } }
    }
    nloc = mine > 0u ? mine : 1u; nx = cnt > 0u ? cnt : 1u;
}

__device__ __forceinline__ void xcd_barrier(const XcdBarrier& b) {
    asm volatile("s_waitcnt vmcnt(0)" ::: "memory");
    __syncthreads();
    if (threadIdx.x == 0) {
        unsigned* bar = b.bar;
        __builtin_amdgcn_s_waitcnt(0);
        unsigned nloc = b.st[0], nx = b.st[1];
        if (nloc == 0u) { xcd_barrier_complete(bar, b.x, nloc, nx); b.st[0] = nloc; b.st[1] = nx; }
        const unsigned old = xb_add(&bar[XB_XSUB(b.x)], 1u);
        const unsigned gen = old / nloc;
        if (old + 1u == (gen + 1u) * nloc) {
            __builtin_amdgcn_fence(__ATOMIC_RELEASE, "agent");
            asm volatile("s_waitcnt vmcnt(0)" ::: "memory");
            const unsigned og = xb_add(&bar[XB_TOP], 1u);
            const unsigned tg = og / nx;
            if (og + 1u == (tg + 1u) * nx) xb_add(&bar[XB_TOPGEN], 1u);
            else XB_SPIN(xb_ld(&bar[XB_TOPGEN]) == tg, bar);
            __builtin_amdgcn_fence(__ATOMIC_ACQUIRE, "agent");
            xb_add(&bar[XB_XGEN(b.x)], 1u);
            asm volatile("s_waitcnt vmcnt(0)" ::: "memory");
        } else {
            XB_SPIN(xb_ld(&bar[XB_XGEN(b.x)]) == gen, bar);
            __builtin_amdgcn_fence(__ATOMIC_ACQUIRE, "agent");
            asm volatile("s_waitcnt vmcnt(0)" ::: "memory");
        }
    }
    __syncthreads();
}

__device__ __forceinline__ float wave_sum(float v, int lane) {
#pragma unroll
    for (int o = 1; o < 64; o <<= 1) v += shx(v, o, lane);
    return v;
}
__device__ __forceinline__ void* ldptr(LAS unsigned char* lds, int i) {
    const unsigned long long v = ((const LAS unsigned long long*)(lds + LDSCTL_OFF + 1024))[i];
    const unsigned lo = __builtin_amdgcn_readfirstlane((unsigned)v), hi = __builtin_amdgcn_readfirstlane((unsigned)(v >> 32));
    return (void*)(((unsigned long long)hi << 32) | lo);
}
struct OffsetOrder {
    pg8::StaticOrder S;
    __device__ __forceinline__ void init(int M, int N, int G, int c, int off) { S.init(M, N, G, (c + G - off % G) % G); }
    __device__ __forceinline__ bool next(int i, pg8::Unit& u) const { return S.next(i, u); }
    __device__ __forceinline__ void a_ready(const pg8::Unit&) const {}
    __device__ __forceinline__ void done(const pg8::Unit&) const {}
};

template <bool PERMQKV>
__device__ __forceinline__ void transpose_item(const float* W, int K, int N, bf16* WT, LAS float* scr, int item, int lane, const float* gk = nullptr) {
    const int nblk = N / 32, kb = item / nblk, nb = item % nblk, k0 = 64 * kb, n0 = 32 * nb;
    int d0 = n0;
    if (PERMQKV) { const int within = n0 & 255; d0 = (n0 & ~255) + 128 * ((within >> 5) & 1) + 32 * (within >> 6); }
#pragma unroll
    for (int i = 0; i < 8; ++i) { const int kk = 8 * i + (lane >> 3), nn = 4 * (lane & 7);
        const f32x4 w4 = *(const GAS f32x4*)(W + (size_t)(k0 + kk) * N + n0 + nn) * (gk ? gk[k0 + kk] : 1.f);
        scr[kk * 33 + nn] = w4[0]; scr[kk * 33 + nn + 1] = w4[1]; scr[kk * 33 + nn + 2] = w4[2]; scr[kk * 33 + nn + 3] = w4[3]; }
    LDS_WAIT(); asm volatile("" ::: "memory");
    const int c = lane & 7;
#pragma unroll
    for (int j = 0; j < 4; ++j) { const int n = (lane >> 3) + 8 * j; const LAS float* s = scr + (8 * c) * 33 + n;
        v4u o; o.x = pk2(s[0 * 33], s[1 * 33]); o.y = pk2(s[2 * 33], s[3 * 33]); o.z = pk2(s[4 * 33], s[5 * 33]); o.w = pk2(s[6 * 33], s[7 * 33]);
        *(GAS v4u*)(WT + (size_t)(d0 + n) * K + k0 + 8 * c) = o; }
    LDS_WAIT(); asm volatile("" ::: "memory");
}
__device__ __forceinline__ void convert_bf16(const float* src, bf16* dst, size_t n, size_t gtid, size_t nthreads) {
    for (size_t i = gtid * 8; i < n; i += nthreads * 8) {
        const f32x4 a = *(const GAS f32x4*)(src + i), b = *(const GAS f32x4*)(src + i + 4);
        v4u o; o.x = pk2(a[0], a[1]); o.y = pk2(a[2], a[3]); o.z = pk2(b[0], b[1]); o.w = pk2(b[2], b[3]);
        *(GAS v4u*)(dst + i) = o;
    }
}
__device__ __forceinline__ int t5_bucket(int rel) {
    const int n = rel < 0 ? -rel : rel;
    const int b = n < 8 ? n : n < 12 ? 8 : n < 16 ? 9 : n < 23 ? 10 : n < 32 ? 11 : n < 46 ? 12 : n < 64 ? 13 : n < 91 ? 14 : 15;
    return b + (rel > 0 ? 16 : 0);
}
__constant__ float ROPE_INV[16] = {1.000000000e+00f, 5.623413324e-01f, 3.162277639e-01f, 1.778279394e-01f, 1.000000015e-01f, 5.623413250e-02f, 3.162277490e-02f, 1.778279431e-02f,
                                   9.999999776e-03f, 5.623413250e-03f, 3.162277630e-03f, 1.778279431e-03f, 1.000000047e-03f, 5.623413017e-04f, 3.162277571e-04f, 1.778279402e-04f};

__device__ __forceinline__ void rms_row_to_bf16(const float* xrow, const float* g0, bf16* o0, const float* g1, bf16* o1, int lane) {
    const GAS f32x4* xr = (const GAS f32x4*)xrow + lane;
    f32x4 v[8]; float s = 0.f;
#pragma unroll
    for (int j = 0; j < 8; ++j) { v[j] = xr[64 * j]; s += (v[j].x * v[j].x + v[j].y * v[j].y) + (v[j].z * v[j].z + v[j].w * v[j].w); }
    const float rstd = 1.f / sqrtf(wave_sum(s, lane) * (1.f / DM) + EPS);
    {   const GAS f32x4* gr = (const GAS f32x4*)g0 + lane; GAS v2u* o8 = (GAS v2u*)o0 + lane; f32x4 gg[8];
#pragma unroll
        for (int j = 0; j < 8; ++j) gg[j] = gr[64 * j];
#pragma unroll
        for (int j = 0; j < 8; ++j) { v2u w; w.x = pk2(v[j].x * rstd * gg[j].x, v[j].y * rstd * gg[j].y); w.y = pk2(v[j].z * rstd * gg[j].z, v[j].w * rstd * gg[j].w); o8[64 * j] = w; } }
    if (g1) { const GAS f32x4* gr = (const GAS f32x4*)g1 + lane; GAS v2u* o8 = (GAS v2u*)o1 + lane; f32x4 gg[8];
#pragma unroll
        for (int j = 0; j < 8; ++j) gg[j] = gr[64 * j];
#pragma unroll
        for (int j = 0; j < 8; ++j) { v2u w; w.x = pk2(v[j].x * rstd * gg[j].x, v[j].y * rstd * gg[j].y); w.y = pk2(v[j].z * rstd * gg[j].z, v[j].w * rstd * gg[j].w); o8[64 * j] = w; } }
}
__device__ __forceinline__ float wave_max(float v, int lane) {
#pragma unroll
    for (int o = 1; o < 64; o <<= 1) v = fmaxf(v, shx(v, o, lane));
    return v;
}
__device__ __forceinline__ unsigned q8x4(const f32x4 v, const float inv) {
    unsigned w = 0;
    w = __builtin_amdgcn_cvt_pk_u8_f32(__builtin_rintf(__builtin_fmaf(v[0], inv, 128.f)), 0, w); w = __builtin_amdgcn_cvt_pk_u8_f32(__builtin_rintf(__builtin_fmaf(v[1], inv, 128.f)), 1, w);
    w = __builtin_amdgcn_cvt_pk_u8_f32(__builtin_rintf(__builtin_fmaf(v[2], inv, 128.f)), 2, w); w = __builtin_amdgcn_cvt_pk_u8_f32(__builtin_rintf(__builtin_fmaf(v[3], inv, 128.f)), 3, w);
    return w ^ 0x80808080u;
}
__device__ __forceinline__ float amax4(const f32x4 v) { return fmaxf(fmaxf(fabsf(v[0]), fabsf(v[1])), fmaxf(fabsf(v[2]), fabsf(v[3]))); }
__device__ __forceinline__ void quant_wrow(const bf16* src, unsigned char* dst, float* step, int lane) {
    v4u w[4]; float am = 0.f;
#pragma unroll
    for (int j = 0; j < 4; ++j) w[j] = *(const GAS v4u*)(src + 8 * lane + 512 * j);
    f32x4 lo[4], hi[4];
#pragma unroll
    for (int j = 0; j < 4; ++j) { lo[j] = (f32x4){bflo(w[j].x), bfhi(w[j].x), bflo(w[j].y), bfhi(w[j].y)}; hi[j] = (f32x4){bflo(w[j].z), bfhi(w[j].z), bflo(w[j].w), bfhi(w[j].w)}; am = fmaxf(am, fmaxf(amax4(lo[j]), amax4(hi[j]))); }
    am = fmaxf(wave_max(am, lane), 1e-30f);
    const float inv = 127.f / am;
#pragma unroll
    for (int j = 0; j < 4; ++j) *(GAS v2u*)(dst + 8 * lane + 512 * j) = (v2u){q8x4(lo[j], inv), q8x4(hi[j], inv)};
    if (lane == 0) *step = am * (1.f / 127.f);
}
template <int R>
__device__ __forceinline__ void att_quant_rows(const bf16* ATT, const u64_t* mixsq, unsigned char* Q, float* step, int row0, int lane) {
    v4u w[R][4];
#pragma unroll
    for (int q = 0; q < R; ++q)
#pragma unroll
        for (int j = 0; j < 4; ++j) w[q][j] = *(const GAS v4u*)(ATT + (size_t)(row0 + q) * DM + 8 * lane + 512 * j);
    unsigned zv = 0u; asm volatile("" : "+v"(zv));
    u64_t msq[R][3];
#pragma unroll
    for (int q = 0; q < R; ++q)
#pragma unroll
        for (int g = 0; g < 3; ++g) msq[q][g] = *(const GAS u64_t*)((const char*)(mixsq + (size_t)g * T + row0 + q) + zv);
    __builtin_amdgcn_sched_barrier(0);
#pragma unroll
    for (int q = 0; q < R; ++q) { const int row = row0 + q;
        const float ra = 1.0f / sqrtf((float)msq[q][0] * (5.9604644775390625e-08f / 768.0f) + EPS), rb = 1.0f / sqrtf((float)msq[q][1] * (5.9604644775390625e-08f / 512.0f) + EPS),
                    rc = 1.0f / sqrtf((float)msq[q][2] * (5.9604644775390625e-08f / 768.0f) + EPS);
        const float rj[4] = {ra, lane < 32 ? ra : rb, lane < 32 ? rb : rc, rc};
        f32x4 lo[4], hi[4]; float am = 0.f;
#pragma unroll
        for (int j = 0; j < 4; ++j) { lo[j] = (f32x4){bflo(w[q][j].x), bfhi(w[q][j].x), bflo(w[q][j].y), bfhi(w[q][j].y)} * rj[j]; hi[j] = (f32x4){bflo(w[q][j].z), bfhi(w[q][j].z), bflo(w[q][j].w), bfhi(w[q][j].w)} * rj[j]; am = fmaxf(am, fmaxf(amax4(lo[j]), amax4(hi[j]))); }
        am = fmaxf(wave_max(am, lane), 1e-30f);
        const float inv = 127.f / am;
#pragma unroll
        for (int j = 0; j < 4; ++j) *(GAS v2u*)(Q + (size_t)row * DM + 8 * lane + 512 * j) = (v2u){q8x4(lo[j], inv), q8x4(hi[j], inv)};
        if (lane == 0) step[row] = am * (1.f / 127.f); }
}
template <bool PERMQKV>
__device__ __forceinline__ void wq_item(const float* W, int N, int n0, const float* gk, unsigned char* WT8, float* wsc, LAS unsigned char* ring, LAS float* red, int tid) {
    const int cg = tid & 7, kl = tid >> 3;
    f32x4 am = {0.f, 0.f, 0.f, 0.f};
#pragma unroll 1
    for (int i0 = 0; i0 < 32; i0 += 16) {
        f32x4 w[16]; float g[16];
#pragma unroll
        for (int i = 0; i < 16; ++i) { const int k = kl + 64 * (i0 + i); w[i] = *(const GAS f32x4*)(W + (size_t)k * N + n0 + 4 * cg); g[i] = gk ? gk[k] : 1.f; }
#pragma unroll
        for (int i = 0; i < 16; ++i) { const int k = kl + 64 * (i0 + i); const f32x4 v = w[i] * g[i];
            am = (f32x4){fmaxf(am[0], fabsf(v[0])), fmaxf(am[1], fabsf(v[1])), fmaxf(am[2], fabsf(v[2])), fmaxf(am[3], fabsf(v[3]))};
            const int kr = (k + 8 * cg) & 2047;
#pragma unroll
            for (int e = 0; e < 4; ++e) *(LAS unsigned short*)(ring + (4 * cg + e) * 4096 + 2 * kr) = (unsigned short)f2bf(v[e]); }
    }
    *(LAS f32x4*)(red + 4 * tid) = am;
    __syncthreads();
    if (tid < 32) { float m = 0.f;
        for (int j = 0; j < 64; ++j) m = fmaxf(m, red[4 * (8 * j + (tid >> 2)) + (tid & 3)]);
        m = fmaxf(m, 1e-30f); wsc[n0 + tid] = m * (1.f / 127.f); red[2048 + tid] = 127.f / m; }
    __syncthreads();
#pragma unroll 1
    for (int j = 0; j < 8; ++j) { const int p = tid + 512 * j, n = p >> 7, kc = p & 127;
        const int ro = 8 * (n >> 2);
        const v4u a = *(const LAS v4u*)(ring + n * 4096 + 2 * ((16 * kc + ro) & 2047)), b2 = *(const LAS v4u*)(ring + n * 4096 + 2 * ((16 * kc + 8 + ro) & 2047)); const float inv = red[2048 + n];
        v4u o; o.x = q8x4((f32x4){bflo(a.x), bfhi(a.x), bflo(a.y), bfhi(a.y)}, inv); o.y = q8x4((f32x4){bflo(a.z), bfhi(a.z), bflo(a.w), bfhi(a.w)}, inv);
        o.z = q8x4((f32x4){bflo(b2.x), bfhi(b2.x), bflo(b2.y), bfhi(b2.y)}, inv); o.w = q8x4((f32x4){bflo(b2.z), bfhi(b2.z), bflo(b2.w), bfhi(b2.w)}, inv);
        int dn = n0 + n; if (PERMQKV) { const int within = dn & 255; dn = (dn & ~255) + 128 * ((within >> 5) & 1) + 32 * (within >> 6) + (within & 31); }
        *(GAS v4u*)(WT8 + (size_t)dn * 2048 + 16 * kc) = o; }
    __syncthreads();
}
__device__ __forceinline__ void rms_row_to_i8(const f32x4 (&v)[8], float rstd, const float* g, unsigned char* q, float* step, int lane) {
    const GAS f32x4* gr = (const GAS f32x4*)g + lane; f32x4 gg[8], y[8]; float am = 0.f;
#pragma unroll
    for (int j = 0; j < 8; ++j) gg[j] = gr[64 * j];
#pragma unroll
    for (int j = 0; j < 8; ++j) { y[j] = v[j] * gg[j] * rstd; am = fmaxf(am, amax4(y[j])); }
    am = fmaxf(wave_max(am, lane), 1e-30f);
    const float inv = 127.f / am;
#pragma unroll
    for (int j = 0; j < 8; ++j) *(GAS unsigned*)(q + 4 * lane + 256 * j) = q8x4(y[j], inv);
    if (lane == 0) *step = am * (1.f / 127.f);
}
__device__ __forceinline__ void prep_rows2(const float* x0, bf16* o0, u64_t* sq, unsigned char* q0, float* qstep, int lane) {
    f32x4 v[2][8];
#pragma unroll
    for (int q = 0; q < 2; ++q) { const GAS f32x4* xr = (const GAS f32x4*)(x0 + (size_t)q * DM) + lane;
#pragma unroll
        for (int j = 0; j < 8; ++j) v[q][j] = xr[64 * j]; }
#pragma unroll
    for (int q = 0; q < 2; ++q) { GAS v2u* o8 = (GAS v2u*)(o0 + (size_t)q * DM) + lane; float s = 0.f;
#pragma unroll
        for (int j = 0; j < 8; ++j) { const f32x4 a = v[q][j]; s += (a.x * a.x + a.y * a.y) + (a.z * a.z + a.w * a.w); v2u w; w.x = pk2(a.x, a.y); w.y = pk2(a.z, a.w); o8[64 * j] = w; }
        s = wave_sum(s, lane);
        float am = 0.f;
#pragma unroll
        for (int j = 0; j < 8; ++j) am = fmaxf(am, amax4(v[q][j]));
        am = fmaxf(wave_max(am, lane), 1e-30f);
        const float inv = 127.f / am;
#pragma unroll
        for (int j = 0; j < 8; ++j) *(GAS unsigned*)(q0 + (size_t)q * DM + 4 * lane + 256 * j) = q8x4(v[q][j], inv);
        if (lane == 0) { sq[q] = rowsq_fx(s); qstep[q] = am * (1.f / 127.f) / sqrtf(s * (1.f / DM) + 1e-6f); } }
}
__device__ __forceinline__ void norm_rows(const float* X, const float* g, bf16* XN, int gw, int NGW, int lane) {
    for (int m = gw; m < T; m += NGW) rms_row_to_bf16(X + (size_t)m * DM, g, XN + (size_t)m * DM, nullptr, nullptr, lane);
}

template <int TYPE>
__device__ __forceinline__ void naive_attn_item(const bf16* QKV, bf16* ATT, int b, int grow, int head, int lane, const float* biasA, const float* sink, const float* rpb) {
    const int tpos = grow * 64 + lane; const size_t trow = (size_t)b * SEQ + tpos;
    int qcol, kcol, vcol, ocol;
    if (TYPE == 0) { qcol = QA + head * 64; kcol = KA + (head / 3) * 64; vcol = VA + (head / 3) * 64; ocol = OA + head * 64; }
    else if (TYPE == 1) { qcol = QB + head * 64; kcol = KB + head * 64; vcol = VB + head * 64; ocol = OB + head * 64; }
    else { qcol = QC + head * 64; kcol = KC + (head / 3) * 64; vcol = VC + (head / 3) * 64; ocol = OC + head * 64; }
    float q[64], o[64];
#pragma unroll
    for (int c = 0; c < 8; ++c) { const v4u w = *(const GAS v4u*)(QKV + trow * DIN + qcol + 8 * c);
        q[8 * c + 0] = bflo(w.x); q[8 * c + 1] = bfhi(w.x); q[8 * c + 2] = bflo(w.y); q[8 * c + 3] = bfhi(w.y); q[8 * c + 4] = bflo(w.z); q[8 * c + 5] = bfhi(w.z); q[8 * c + 6] = bflo(w.w); q[8 * c + 7] = bfhi(w.w); }
#pragma unroll
    for (int d = 0; d < 64; ++d) o[d] = 0.f;
    float m = -1e30f, l = 0.f;
    int j0, j1;
    if (TYPE == 0) { j0 = grow * 64 - 128; if (j0 < 0) j0 = 0; j1 = grow * 64 + 63 + 128; if (j1 > SEQ - 1) j1 = SEQ - 1; }
    else if (TYPE == 1) { int r0 = grow - 4; r0 = r0 < 0 ? 0 : (r0 > 24 ? 24 : r0); j0 = r0 * 64; j1 = j0 + 511; }
    else { j0 = 0; j1 = SEQ - 1; }
    int c0 = lane - 8; c0 = c0 < 0 ? 0 : (c0 > 48 ? 48 : c0);
#pragma unroll 1
    for (int j = j0; j <= j1; ++j) {
        const bf16* krow = QKV + ((size_t)b * SEQ + j) * DIN;
        float s = 0.f;
#pragma unroll
        for (int c = 0; c < 8; ++c) { const v4u w = *(const GAS v4u*)(krow + kcol + 8 * c);
            s += q[8 * c + 0] * bflo(w.x) + q[8 * c + 1] * bfhi(w.x) + q[8 * c + 2] * bflo(w.y) + q[8 * c + 3] * bfhi(w.y) + q[8 * c + 4] * bflo(w.z) + q[8 * c + 5] * bfhi(w.z) + q[8 * c + 6] * bflo(w.w) + q[8 * c + 7] * bfhi(w.w); }
        bool valid = true;
        if (TYPE == 0) { const int rel = j - tpos; valid = (rel >= -128 && rel <= 128); if (valid) s += biasA[head * 257 + rel + 128]; }
        if (TYPE == 1) { const int kr = j >> 6, kc = j & 63; valid = (kc >= c0 && kc < c0 + 16); if (valid) s += rpb[(head * 15 + (kr - grow + 7)) * 31 + (kc - lane + 15)]; }
        const float mn = valid ? fmaxf(m, s) : m;
        const float a = __expf(m - mn);
        const float p = valid ? __expf(s - mn) : 0.f;
        l = l * a + p; m = mn;
#pragma unroll
        for (int c = 0; c < 8; ++c) { const v4u w = *(const GAS v4u*)(krow + vcol + 8 * c);
            o[8 * c + 0] = o[8 * c + 0] * a + p * bflo(w.x); o[8 * c + 1] = o[8 * c + 1] * a + p * bfhi(w.x); o[8 * c + 2] = o[8 * c + 2] * a + p * bflo(w.y); o[8 * c + 3] = o[8 * c + 3] * a + p * bfhi(w.y);
            o[8 * c + 4] = o[8 * c + 4] * a + p * bflo(w.z); o[8 * c + 5] = o[8 * c + 5] * a + p * bfhi(w.z); o[8 * c + 6] = o[8 * c + 6] * a + p * bflo(w.w); o[8 * c + 7] = o[8 * c + 7] * a + p * bfhi(w.w); }
    }
    if (TYPE == 0) l += __expf(sink[head] - m);
    const float inv = 1.f / l;
#pragma unroll
    for (int c = 0; c < 8; ++c) { v4u w; w.x = pk2(o[8 * c + 0] * inv, o[8 * c + 1] * inv); w.y = pk2(o[8 * c + 2] * inv, o[8 * c + 3] * inv); w.z = pk2(o[8 * c + 4] * inv, o[8 * c + 5] * inv); w.w = pk2(o[8 * c + 6] * inv, o[8 * c + 7] * inv);
        *(GAS v4u*)(ATT + trow * DM + ocol + 8 * c) = w; }
}
__device__ __forceinline__ float rdl(float v, int l) { return __builtin_bit_cast(float, __builtin_amdgcn_readlane(__builtin_bit_cast(int, v), l)); }
__device__ __forceinline__ void naive_mem_item(const bf16* QM, const bf16* KVM, bf16* OM, const float* gq, size_t trow, int b, int head, int lane) {
    const unsigned qw = *(const GAS unsigned*)(QM + trow * MEMW + head * 128 + 2 * lane);
    float q0 = bflo(qw), q1 = bfhi(qw);
    const float ss = wave_sum(q0 * q0 + q1 * q1, lane);
    const float r = 0.08838834764831845f / sqrtf(ss * (1.f / 128.f) + EPS);
    q0 *= r * gq[2 * lane]; q1 *= r * gq[2 * lane + 1];
    const bf16* kbase = KVM + ((size_t)b * NMEM + lane) * 1024 + head * 128;
    float s[4] = {0.f, 0.f, 0.f, 0.f};
#pragma unroll 1
    for (int c = 0; c < 16; ++c) {
        float qa[8];
#pragma unroll
        for (int e = 0; e < 4; ++e) { qa[2 * e] = rdl(q0, 4 * c + e); qa[2 * e + 1] = rdl(q1, 4 * c + e); }
#pragma unroll
        for (int i = 0; i < 4; ++i) { const v4u w = *(const GAS v4u*)(kbase + (size_t)i * 64 * 1024 + 8 * c);
            s[i] += qa[0] * bflo(w.x) + qa[1] * bfhi(w.x) + qa[2] * bflo(w.y) + qa[3] * bfhi(w.y) + qa[4] * bflo(w.z) + qa[5] * bfhi(w.z) + qa[6] * bflo(w.w) + qa[7] * bfhi(w.w); }
    }
    float m = fmaxf(fmaxf(s[0], s[1]), fmaxf(s[2], s[3]));
#pragma unroll
    for (int o = 1; o < 64; o <<= 1) m = fmaxf(m, shx(m, o, lane));
    float p[4]; float l = 0.f;
#pragma unroll
    for (int i = 0; i < 4; ++i) { p[i] = __expf(s[i] - m); l += p[i]; }
    l = wave_sum(l, lane);
    const bf16* vbase = KVM + ((size_t)b * NMEM) * 1024 + 512 + head * 128 + 2 * lane;
    float o0 = 0.f, o1 = 0.f;
#pragma unroll
    for (int i = 0; i < 4; ++i) {
#pragma unroll 4
        for (int jj = 0; jj < 64; ++jj) { const float pj = rdl(p[i], jj); const unsigned w = *(const GAS unsigned*)(vbase + (size_t)(64 * i + jj) * 1024); o0 += pj * bflo(w); o1 += pj * bfhi(w); }
    }
    const float inv = 1.f / l;
    *(GAS unsigned*)(OM + trow * MEMW + head * 128 + 2 * lane) = pk2(o0 * inv, o1 * inv);
}
__device__ __forceinline__ void mixnorm_rows(bf16* ATT, const float* g, int gw, int NGW, int lane) {
    for (int m = gw; m < T; m += NGW) {
        GAS v4u* p = (GAS v4u*)(ATT + (size_t)m * DM + 32 * lane);
        v4u w[4]; float f[32]; float ss = 0.f;
#pragma unroll
        for (int c = 0; c < 4; ++c) { w[c] = p[c];
            f[8 * c + 0] = bflo(w[c].x); f[8 * c + 1] = bfhi(w[c].x); f[8 * c + 2] = bflo(w[c].y); f[8 * c + 3] = bfhi(w[c].y); f[8 * c + 4] = bflo(w[c].z); f[8 * c + 5] = bfhi(w[c].z); f[8 * c + 6] = bflo(w[c].w); f[8 * c + 7] = bfhi(w[c].w); }
#pragma unroll
        for (int i = 0; i < 32; ++i) ss += f[i] * f[i];
        const int grp = lane < 24 ? 0 : (lane < 40 ? 1 : 2);
        const float sa = wave_sum(grp == 0 ? ss : 0.f, lane), sb = wave_sum(grp == 1 ? ss : 0.f, lane), sc = wave_sum(grp == 2 ? ss : 0.f, lane);
        const float r = grp == 0 ? 1.f / sqrtf(sa * (1.f / 768.f) + EPS) : (grp == 1 ? 1.f / sqrtf(sb * (1.f / 512.f) + EPS) : 1.f / sqrtf(sc * (1.f / 768.f) + EPS));
        const float* gg = g + 32 * lane;
#pragma unroll
        for (int c = 0; c < 4; ++c) { const f32x4 g0 = *(const GAS f32x4*)(gg + 8 * c), g1 = *(const GAS f32x4*)(gg + 8 * c + 4);
            v4u o; o.x = pk2(f[8 * c + 0] * r * g0[0], f[8 * c + 1] * r * g0[1]); o.y = pk2(f[8 * c + 2] * r * g0[2], f[8 * c + 3] * r * g0[3]);
            o.z = pk2(f[8 * c + 4] * r * g1[0], f[8 * c + 5] * r * g1[1]); o.w = pk2(f[8 * c + 6] * r * g1[2], f[8 * c + 7] * r * g1[3]); p[c] = o; }
    }
}

#ifndef PEER_HD
#define PEER_HD __device__ __forceinline__
#define PEER_EXP(x) __expf(x)
#endif
template <int N> PEER_HD void bitonic_sort_desc(float* v) {
#pragma unroll
    for (int k = 2; k <= N; k <<= 1)
#pragma unroll
        for (int j = k >> 1; j > 0; j >>= 1)
#pragma unroll
            for (int i = 0; i < N; ++i) { const int l = i ^ j; if (l > i) { const bool desc = ((i & k) == 0); const float a = v[i], b = v[l]; const float hi = fmaxf(a, b), lo = fminf(a, b);
                v[i] = desc ? hi : lo; v[l] = desc ? lo : hi; } }
}
#define PEER_CE(i, j) do { const float x_ = v[i], y_ = v[j]; v[i] = fmaxf(x_, y_); v[j] = fminf(x_, y_); } while (0)
PEER_HD void sort16_desc(float* v) {
    PEER_CE(0,13); PEER_CE(1,12); PEER_CE(2,15); PEER_CE(3,14); PEER_CE(4,8); PEER_CE(5,6); PEER_CE(7,11); PEER_CE(9,10);
    PEER_CE(0,5); PEER_CE(1,7); PEER_CE(2,9); PEER_CE(3,4); PEER_CE(6,13); PEER_CE(8,14); PEER_CE(10,15); PEER_CE(11,12);
    PEER_CE(0,1); PEER_CE(2,3); PEER_CE(4,5); PEER_CE(6,8); PEER_CE(7,9); PEER_CE(10,11); PEER_CE(12,13); PEER_CE(14,15);
    PEER_CE(0,2); PEER_CE(1,3); PEER_CE(4,10); PEER_CE(5,11); PEER_CE(6,7); PEER_CE(8,9); PEER_CE(12,14); PEER_CE(13,15);
    PEER_CE(1,2); PEER_CE(3,12); PEER_CE(4,6); PEER_CE(5,7); PEER_CE(8,10); PEER_CE(9,11); PEER_CE(13,14);
    PEER_CE(1,4); PEER_CE(2,6); PEER_CE(5,8); PEER_CE(7,10); PEER_CE(9,13); PEER_CE(11,14);
    PEER_CE(2,4); PEER_CE(3,6); PEER_CE(9,12); PEER_CE(11,13);
    PEER_CE(3,5); PEER_CE(6,8); PEER_CE(7,9); PEER_CE(10,12);
    PEER_CE(3,4); PEER_CE(5,6); PEER_CE(7,8); PEER_CE(9,10); PEER_CE(11,12);
    PEER_CE(6,7); PEER_CE(8,9);
}
PEER_HD void sort6_desc(float* v) {
    PEER_CE(0,5); PEER_CE(1,3); PEER_CE(2,4); PEER_CE(1,2); PEER_CE(3,4); PEER_CE(0,3); PEER_CE(2,5); PEER_CE(0,1); PEER_CE(2,3); PEER_CE(4,5); PEER_CE(1,2); PEER_CE(3,4);
}
PEER_HD void merge_top16(float* a, const float* b) {
    float c[16];
#pragma unroll
    for (int i = 0; i < 16; ++i) c[i] = fmaxf(a[i], b[15 - i]);
#pragma unroll
    for (int j = 8; j > 0; j >>= 1)
#pragma unroll
        for (int i = 0; i < 16; ++i) { const int l = i ^ j; if (l > i) { const float x = c[i], y = c[l]; c[i] = fmaxf(x, y); c[l] = fminf(x, y); } }
#pragma unroll
    for (int i = 0; i < 16; ++i) a[i] = c[i];
}
PEER_HD void top16_of_64(float (&v)[64]) {
    sort16_desc(&v[0]); sort16_desc(&v[16]); sort16_desc(&v[32]); sort16_desc(&v[48]);
    merge_top16(&v[0], &v[16]); merge_top16(&v[32], &v[48]); merge_top16(&v[0], &v[32]);
}
PEER_HD float pack_idx(float s, unsigned idx, unsigned mask) { return __builtin_bit_cast(float, (__builtin_bit_cast(unsigned, s) & ~mask) | idx); }
PEER_HD unsigned low_bits(float s, unsigned mask) { return __builtin_bit_cast(unsigned, s) & mask; }
PEER_HD unsigned pick16(const float* a, unsigned i, unsigned mask) {
    unsigned r = 0;
#pragma unroll
    for (unsigned k = 0; k < 16; ++k) r = (i == k) ? low_bits(a[k], mask) : r;
    return r;
}
PEER_HD void peer_candidates(const float* a, const float* b, int* e, float* gate) {
    const float NEG = -3.0e38f;
#define PEER_S(i, j) pack_idx(a[i] + b[j], (unsigned)((i) * 16 + (j)), 0xffu)
    float r0[16], r1[16], c0[16], c1[16], z[16];
#pragma unroll
    for (int j = 0; j < 16; ++j) { r0[j] = PEER_S(0, j); r1[j] = j < 8 ? PEER_S(1, j) : NEG; c0[j] = j < 14 ? PEER_S(j + 2 < 16 ? j + 2 : 15, 0) : NEG; c1[j] = j < 6 ? PEER_S(j + 2 < 16 ? j + 2 : 15, 1) : NEG; z[j] = NEG; }
    z[0] = PEER_S(2, 2); z[1] = PEER_S(2, 3); z[2] = PEER_S(2, 4); z[3] = PEER_S(3, 2); z[4] = PEER_S(3, 3); z[5] = PEER_S(4, 2);
#undef PEER_S
    sort6_desc(z);
    merge_top16(c1, z); merge_top16(c0, c1); merge_top16(r0, r1);
    float c[16];
#pragma unroll
    for (int i = 0; i < 16; ++i) c[i] = fmaxf(r0[i], c0[15 - i]);
    float mx = c[0], den = 0.f;
#pragma unroll
    for (int k = 0; k < 16; ++k) { const unsigned id = low_bits(c[k], 0xffu); const unsigned n0 = pick16(a, id >> 4, 0x7fu), n1 = pick16(b, id & 15u, 0x7fu);
        e[k] = (int)(n0 * 128u + n1); gate[k] = PEER_EXP(c[k] - mx); den += gate[k]; }
    const float inv = 1.f / den;
#pragma unroll
    for (int k = 0; k < 16; ++k) gate[k] *= inv;
}

__device__ __forceinline__ void peer_select_unit(const bf16* QP, const bf16* PK, int* PIDX, float* PGATE, int tb, int h, int wave, int lane, LAS unsigned char* lds) {
    const int hh = lane >> 5, tl = lane & 31; const size_t t = (size_t)tb * 256 + wave * 32 + tl;
    __syncthreads();
    {   const int tid = wave * 64 + lane; const bf16* src = PK + (size_t)h * 256 * 128;
#pragma unroll 1
        for (int i0 = 0; i0 < 8; i0 += 4) { v4u st[4];
#pragma unroll
            for (int i = 0; i < 4; ++i) st[i] = *(const GAS v4u*)(src + (size_t)(tid + 512 * (i0 + i)) * 8);
#pragma unroll
            for (int i = 0; i < 4; ++i) { const int c = tid + 512 * (i0 + i), row = c >> 4, ch = c & 15; *(LAS v4u*)(lds + row * 256 + ((ch ^ (row & 15)) * 16)) = st[i]; } } }
    __syncthreads();
    float ab[2][16];
#pragma unroll
    for (int p = 0; p < 2; ++p) {
        bf16x8 bq[8];
#pragma unroll
        for (int s = 0; s < 8; ++s) bq[s] = *(const GAS bf16x8*)(QP + t * DM + 256 * h + 128 * p + 16 * s + 8 * hh);
        float v[64];
#pragma unroll
        for (int nb = 0; nb < 4; ++nb) {
            f32x16 acc;
#pragma unroll
            for (int r = 0; r < 16; ++r) acc[r] = 0.f;
            const int krow = p * 128 + 32 * nb + tl;
            bf16x8 ak[8];
#pragma unroll
            for (int s = 0; s < 8; ++s) ak[s] = *(const LAS bf16x8*)(lds + krow * 256 + (((2 * s + hh) ^ (krow & 15)) * 16));
#pragma unroll
            for (int s = 0; s < 8; ++s) acc = __builtin_amdgcn_mfma_f32_32x32x16_bf16(ak[s], bq[s], acc, 0, 0, 0);
#pragma unroll
            for (int r = 0; r < 16; ++r) v[16 * nb + r] = pack_idx(acc[r], (unsigned)(32 * nb + 8 * (r >> 2) + 4 * hh + (r & 3)), 0x7fu);
        }
        top16_of_64(v);
        float pv[16];
#pragma unroll
        for (int i = 0; i < 16; ++i) pv[i] = shx(v[i], 32, lane);
        merge_top16(&v[0], pv);
#pragma unroll
        for (int i = 0; i < 16; ++i) ab[p][i] = v[i];
    }
    int e[16]; float gate[16];
    peer_candidates(ab[0], ab[1], e, gate);
    if (hh == 0) { GAS v4u* o = (GAS v4u*)(PIDX + t * 128 + h * 16);
#pragma unroll
        for (int c = 0; c < 4; ++c) o[c] = (v4u){(unsigned)e[4 * c], (unsigned)e[4 * c + 1], (unsigned)e[4 * c + 2], (unsigned)e[4 * c + 3]}; }
    else { GAS f32x4* o = (GAS f32x4*)(PGATE + t * 128 + h * 16);
#pragma unroll
        for (int c = 0; c < 4; ++c) o[c] = (f32x4){gate[4 * c], gate[4 * c + 1], gate[4 * c + 2], gate[4 * c + 3]}; }
}

typedef float f32x2 __attribute__((ext_vector_type(2)));
typedef unsigned v6u __attribute__((ext_vector_type(6)));
typedef float v32f __attribute__((ext_vector_type(32)));
typedef v4u __attribute__((aligned(8))) v4u_a8;
constexpr float PU_SCALE6 = 90.0f, PV_SCALE6 = 5.65f;
__device__ __forceinline__ unsigned enc_e2m3(float v) {
    const float a = fminf(fabsf(v), 7.5f);
    unsigned code;
    if (a < 1.0f) code = (unsigned)__builtin_rintf(a * 8.f);
    else { const unsigned b = __builtin_bit_cast(unsigned, a) - 0x3F800000u; code = ((b + 0x7FFFFu + ((b >> 20) & 1u)) >> 20) + 8u; }
    return code | (v < 0.f ? 32u : 0u);
}
__device__ __forceinline__ void convert_fp6_rows(const float* src, unsigned char* dst, int nrows, float scale, const float* gain, int gw, int NGW, int lane) {
    for (int r = gw; r < nrows; r += NGW) {
        const float* sp = src + (size_t)r * DM + 4 * lane; const float* gp = gain ? gain + (size_t)(r / PEER_N) * DM + 4 * lane : nullptr;
        unsigned w[6] = {0u, 0u, 0u, 0u, 0u, 0u};
#pragma unroll
        for (int j = 0; j < 8; ++j) { f32x4 a = *(const GAS f32x4*)(sp + 256 * j) * scale; if (gp) a = a * *(const GAS f32x4*)(gp + 256 * j);
#pragma unroll
            for (int e = 0; e < 4; ++e) { const unsigned code = enc_e2m3(a[e]); const int bp = 6 * (4 * j + e), wi = bp >> 5, sh = bp & 31;
                w[wi] |= code << sh; if (sh > 26) w[wi + 1] |= code >> (32 - sh); } }
        unsigned char* dp = dst + (size_t)r * 1536 + 24 * lane;
        *(GAS v4u_a8*)dp = (v4u){w[0], w[1], w[2], w[3]}; *(GAS v2u*)(dp + 16) = (v2u){w[4], w[5]};
    }
}
constexpr float PV_SCALE4 = 5.65f, PU_SCALE4 = 90.0f;
__device__ __forceinline__ unsigned enc_e2m1(float v) {
    const float a = fabsf(v);
    const unsigned code = a < 0.25f ? 0u : a < 0.75f ? 1u : a < 1.25f ? 2u : a < 1.75f ? 3u : a < 2.5f ? 4u : a < 3.5f ? 5u : a < 5.0f ? 6u : 7u;
    return code | (v < 0.f ? 8u : 0u);
}
__device__ __forceinline__ void convert_fp4_rows(const float* src, unsigned char* dst, int nrows, float scale, const float* gain, int gw, int NGW, int lane) {
    for (int r0 = 2 * gw; r0 < nrows; r0 += 2 * NGW) {
        f32x4 a[2][8];
#pragma unroll
        for (int q = 0; q < 2; ++q) { const float* sp = src + (size_t)(r0 + q) * DM + 4 * lane;
#pragma unroll
            for (int j = 0; j < 8; ++j) a[q][j] = *(const GAS f32x4*)(sp + 256 * j); }
#pragma unroll
        for (int q = 0; q < 2; ++q) { const int r = r0 + q; const float* gp = gain ? gain + (size_t)(r / PEER_N) * DM + 4 * lane : nullptr;
            unsigned w[4] = {0u, 0u, 0u, 0u};
#pragma unroll
            for (int j = 0; j < 8; ++j) { f32x4 v = a[q][j] * scale; if (gp) v = v * *(const GAS f32x4*)(gp + 256 * j);
#pragma unroll
                for (int e = 0; e < 4; ++e) { const int i = 4 * j + e; w[i >> 3] |= enc_e2m1(v[e]) << (4 * (i & 7)); } }
            *(GAS v4u*)(dst + (size_t)r * 1024 + 16 * lane) = (v4u){w[0], w[1], w[2], w[3]}; }
    }
}
#define PG4_LOAD(buf, tab, idlo, idhi, g) do { _Pragma("unroll") for (int i_ = 0; i_ < PG6_R; ++i_) { const int k_ = (g) * PG6_R + i_; \
        const int e_ = __builtin_amdgcn_readlane(k_ < 64 ? idlo : idhi, k_ & 63); buf[i_] = __builtin_amdgcn_raw_buffer_load_b128(tab, (int)voff4, e_ * 1024, 0); } } while (0)
#define PG4_DOT1(buf, i_, dst) do { f32x2 a_ = {0.f, 0.f}; _Pragma("unroll") for (int c_ = 0; c_ < 4; ++c_) { const unsigned u_ = buf[i_][c_]; \
        a_ += __builtin_amdgcn_cvt_scalef32_pk_f32_fp4(u_, 1.0f, 0) * x[4 * c_ + 0]; a_ += __builtin_amdgcn_cvt_scalef32_pk_f32_fp4(u_, 1.0f, 1) * x[4 * c_ + 1]; \
        a_ += __builtin_amdgcn_cvt_scalef32_pk_f32_fp4(u_, 1.0f, 2) * x[4 * c_ + 2]; a_ += __builtin_amdgcn_cvt_scalef32_pk_f32_fp4(u_, 1.0f, 3) * x[4 * c_ + 3]; } dst = a_.x + a_.y; __builtin_amdgcn_sched_barrier(0); } while (0)
#define PG4_DOT(buf, g) do { float p_[8]; _Pragma("unroll") for (int i_ = 0; i_ < 8; ++i_) PG4_DOT1(buf, i_, p_[i_]); \
        float q_[4]; _Pragma("unroll") for (int i_ = 0; i_ < 4; ++i_) { const float keep_ = b5 ? p_[i_ + 4] : p_[i_], send_ = b5 ? p_[i_] : p_[i_ + 4]; q_[i_] = keep_ + shx(send_, 32, lane); } \
        float r_[2]; _Pragma("unroll") for (int i_ = 0; i_ < 2; ++i_) { const float keep_ = b4 ? q_[i_ + 2] : q_[i_], send_ = b4 ? q_[i_] : q_[i_ + 2]; r_[i_] = keep_ + shx(send_, 16, lane); } \
        float s_; { const float keep_ = b3 ? r_[1] : r_[0], send_ = b3 ? r_[0] : r_[1]; s_ = keep_ + shx(send_, 8, lane); } \
        s_ += shx(s_, 4, lane); s_ += shx(s_, 2, lane); s_ += shx(s_, 1, lane); \
        if ((lane & 7) == 0) wl[(g) * 8 + (lane >> 3)] = s_; } while (0)
#define PG4_AXPY(buf, g) do { _Pragma("unroll") for (int i_ = 0; i_ < PG6_R; ++i_) { const float w_ = wl[(g) * PG6_R + i_]; const f32x2 wv_ = {w_, w_}; \
        _Pragma("unroll") for (int c_ = 0; c_ < 4; ++c_) { const unsigned u_ = buf[i_][c_]; \
            y[4 * c_ + 0] += __builtin_amdgcn_cvt_scalef32_pk_f32_fp4(u_, 1.0f, 0) * wv_; y[4 * c_ + 1] += __builtin_amdgcn_cvt_scalef32_pk_f32_fp4(u_, 1.0f, 1) * wv_; \
            y[4 * c_ + 2] += __builtin_amdgcn_cvt_scalef32_pk_f32_fp4(u_, 1.0f, 2) * wv_; y[4 * c_ + 3] += __builtin_amdgcn_cvt_scalef32_pk_f32_fp4(u_, 1.0f, 3) * wv_; } \
        __builtin_amdgcn_sched_barrier(0); } } while (0)
#ifndef PG6_R
#define PG6_R 8
#endif
#define PG6_LOAD(buf, tab, idlo, idhi, g) do { _Pragma("unroll") for (int i_ = 0; i_ < PG6_R; ++i_) { const int k_ = (g) * PG6_R + i_; \
        const int e_ = __builtin_amdgcn_readlane(k_ < 64 ? idlo : idhi, k_ & 63); const unsigned char* rp_ = (tab) + (size_t)(unsigned)e_ * 1536u; \
        const v4u a_ = *(const GAS v4u_a8*)(rp_ + voff); const v2u b_ = *(const GAS v2u*)(rp_ + voff + 16); buf[i_] = (v6u){a_.x, a_.y, a_.z, a_.w, b_.x, b_.y}; } } while (0)
#define PG6_DOT1(buf, i_, dst) do { const v32f f_ = __builtin_amdgcn_cvt_scalef32_pk32_f32_fp6(buf[i_], 1.0f); f32x2 a_ = {0.f, 0.f}; \
        _Pragma("unroll") for (int c_ = 0; c_ < 16; ++c_) a_ += (f32x2){f_[2 * c_], f_[2 * c_ + 1]} * x[c_]; dst = a_.x + a_.y; __builtin_amdgcn_sched_barrier(0); } while (0)
#if PG6_R == 8
#define PG6_DOT(buf, g) do { float p_[8]; _Pragma("unroll") for (int i_ = 0; i_ < 8; ++i_) PG6_DOT1(buf, i_, p_[i_]); \
        float q_[4]; _Pragma("unroll") for (int i_ = 0; i_ < 4; ++i_) { const float keep_ = b5 ? p_[i_ + 4] : p_[i_], send_ = b5 ? p_[i_] : p_[i_ + 4]; q_[i_] = keep_ + shx(send_, 32, lane); } \
        float r_[2]; _Pragma("unroll") for (int i_ = 0; i_ < 2; ++i_) { const float keep_ = b4 ? q_[i_ + 2] : q_[i_], send_ = b4 ? q_[i_] : q_[i_ + 2]; r_[i_] = keep_ + shx(send_, 16, lane); } \
        float s_; { const float keep_ = b3 ? r_[1] : r_[0], send_ = b3 ? r_[0] : r_[1]; s_ = keep_ + shx(send_, 8, lane); } \
        s_ += shx(s_, 4, lane); s_ += shx(s_, 2, lane); s_ += shx(s_, 1, lane); \
        if ((lane & 7) == 0) wl[(g) * 8 + (lane >> 3)] = s_; } while (0)
#else
#define PG6_DOT(buf, g) do { float p_[4]; _Pragma("unroll") for (int i_ = 0; i_ < 4; ++i_) PG6_DOT1(buf, i_, p_[i_]); \
        float r_[2]; _Pragma("unroll") for (int i_ = 0; i_ < 2; ++i_) { const float keep_ = b5 ? p_[i_ + 2] : p_[i_], send_ = b5 ? p_[i_] : p_[i_ + 2]; r_[i_] = keep_ + shx(send_, 32, lane); } \
        float s_; { const float keep_ = b4 ? r_[1] : r_[0], send_ = b4 ? r_[0] : r_[1]; s_ = keep_ + shx(send_, 16, lane); } \
        s_ += shx(s_, 8, lane); s_ += shx(s_, 4, lane); s_ += shx(s_, 2, lane); s_ += shx(s_, 1, lane); \
        if ((lane & 15) == 0) wl[(g) * 4 + (lane >> 4)] = s_; } while (0)
#endif
#define PG6_AXPY(buf, g) do { _Pragma("unroll") for (int i_ = 0; i_ < PG6_R; ++i_) { const float w_ = wl[(g) * PG6_R + i_]; const f32x2 wv_ = {w_, w_}; \
        const v32f f_ = __builtin_amdgcn_cvt_scalef32_pk32_f32_fp6(buf[i_], 1.0f); _Pragma("unroll") for (int c_ = 0; c_ < 16; ++c_) y[c_] += (f32x2){f_[2 * c_], f_[2 * c_ + 1]} * wv_; __builtin_amdgcn_sched_barrier(0); } } while (0)
__device__ __forceinline__ unsigned shxu(unsigned v, int k, int lane) { return (unsigned)__builtin_amdgcn_ds_bpermute((lane ^ k) << 2, (int)v); }
__device__ __forceinline__ void wave_sort128(unsigned& a, unsigned& b, int lane) {
#pragma unroll
    for (int k = 2; k <= 128; k <<= 1) {
#pragma unroll
        for (int j = k >> 1; j > 0; j >>= 1) {
            if (j == 64) { const unsigned lo = a < b ? a : b, hi = a < b ? b : a; a = lo; b = hi; }
            else {
                const unsigned pa = shxu(a, j, lane), pb = shxu(b, j, lane);
                const bool lower = (lane & j) == 0;
                const bool asc_a = (lane & k) == 0, asc_b = ((lane + 64) & k) == 0;
                const bool take_min_a = (lower == asc_a), take_min_b = (lower == asc_b);
                a = take_min_a ? (a < pa ? a : pa) : (a < pa ? pa : a);
                b = take_min_b ? (b < pb ? b : pb) : (b < pb ? pb : b);
            }
        }
    }
}
#ifndef PEER_U_FP4
#define PEER_U_FP4 1
#endif
#if PEER_U_FP4
typedef v4u urow_t;
#define PGU_LOAD PG4_LOAD
#define PGU_DOT PG4_DOT
constexpr float PU_SCALE = PU_SCALE4; constexpr int PU_STRIDE = 1024;
#else
typedef v6u urow_t;
#define PGU_LOAD PG6_LOAD
#define PGU_DOT PG6_DOT
constexpr float PU_SCALE = PU_SCALE6; constexpr int PU_STRIDE = 1536;
#endif
constexpr float PU_SCALEI = 135.0f, PX_SCALEI = 20.0f;
__device__ __forceinline__ void peer_v_pass(bf16* XN, const unsigned char* PV6, const int* PIDX, const float* PGATE, const int* PARTI, float* X, u64_t* rowsq_out, unsigned char* XN8, float* xsc, const u64_t* rowsq1, const u64_t* rowsq2, LAS float* wl, int gw, int NGW, int lane) {
    const unsigned voff4 = 16u * (unsigned)lane, l4 = 4u * (unsigned)lane, l8 = 8u * (unsigned)lane, l16 = 16u * (unsigned)lane;
    constexpr int NG = 128 / PG6_R;
    const __amdgpu_buffer_rsrc_t PVr = __builtin_amdgcn_make_buffer_rsrc((void*)PV6, 0, PEER_N * 1024, 0x00020000);
    int pid0 = 0, pid1 = 0, pp[16]; float pg0 = 0.f, pg1 = 0.f; u64_t prq1 = 0, prq2 = 0; unsigned zv_ = 0u; asm volatile("" : "+v"(zv_));
#pragma unroll
    for (int i = 0; i < 16; ++i) pp[i] = 0;
#define VP_PREF(tt_) do { const char* pi_ = (const char*)(PIDX + (size_t)(tt_) * 128); const char* pg_ = (const char*)(PGATE + (size_t)(tt_) * 128); \
        pid0 = *(const GAS int*)(pi_ + l4); pid1 = *(const GAS int*)(pi_ + l4 + 256); pg0 = *(const GAS float*)(pg_ + l4); pg1 = *(const GAS float*)(pg_ + l4 + 256); \
        _Pragma("unroll") for (int sp = 0; sp < 8; ++sp) { const char* q_ = (const char*)(PARTI + ((size_t)sp * T + (tt_)) * 128); pp[2 * sp] = *(const GAS int*)(q_ + l4); pp[2 * sp + 1] = *(const GAS int*)(q_ + l4 + 256); } \
        prq1 = *(const GAS u64_t*)((const char*)(rowsq1 + (tt_)) + zv_); prq2 = *(const GAS u64_t*)((const char*)(rowsq2 + (tt_)) + zv_); } while (0)
    v4u AV[PG6_R], BV[PG6_R];
    if (gw < T) { int t0 = gw; asm volatile("" : "+s"(t0)); VP_PREF(t0); PG4_LOAD(AV, PVr, pid0, pid1, 0); }
    for (int t_ = gw; t_ < T; t_ += NGW) {
        int t = t_; asm volatile("" : "+s"(t));
        const int idlo = pid0, idhi = pid1;
        {
            const int s0 = ((pp[0] + pp[2]) + (pp[4] + pp[6])) + ((pp[8] + pp[10]) + (pp[12] + pp[14])), s1 = ((pp[1] + pp[3]) + (pp[5] + pp[7])) + ((pp[9] + pp[11]) + (pp[13] + pp[15]));
            const float rs1 = 1.0f / sqrtf((float)prq1 * (5.9604644775390625e-08f / 2048.0f) + 1e-6f), rs2 = 1.0f / sqrtf((float)prq2 * (5.9604644775390625e-08f / 2048.0f) + 1e-6f);
            const float sct = (6.0f / 127.0f / PU_SCALEI) * rs2 / rs1;
            const float d0 = (float)s0 * sct, d1 = (float)s1 * sct;
            const float w0 = pg0 * 0.5f * d0 * (1.f + erff(d0 * 0.70710678118654752f)) * (1.f / PV_SCALE4), w1 = pg1 * 0.5f * d1 * (1.f + erff(d1 * 0.70710678118654752f)) * (1.f / PV_SCALE4);
            wl[lane] = w0; wl[64 + lane] = w1;
            LDS_WAIT(); asm volatile("" ::: "memory");
        }
        f32x2 y[16];
#pragma unroll
        for (int i = 0; i < 16; ++i) y[i] = (f32x2){0.f, 0.f};
        v2u xr[8];
        PG4_LOAD(BV, PVr, idlo, idhi, 1);
        PG4_AXPY(AV, 0);
        {   int tn = (t_ + NGW < T) ? t_ + NGW : t_; asm volatile("" : "+s"(tn)); VP_PREF(tn);
            const char* xb_ = (const char*)(XN + (size_t)t * DM);
#pragma unroll
            for (int j = 0; j < 8; ++j) xr[j] = *(const GAS v2u*)(xb_ + l8 + 512 * j); }
        PG4_LOAD(AV, PVr, idlo, idhi, 2);
        PG4_AXPY(BV, 1);
#pragma unroll 1
        for (int g = 2; g < NG - 2; g += 2) {
            PG4_LOAD(BV, PVr, idlo, idhi, g + 1);
            PG4_AXPY(AV, g);
            PG4_LOAD(AV, PVr, idlo, idhi, g + 2);
            PG4_AXPY(BV, g + 1);
        }
        PG4_LOAD(BV, PVr, idlo, idhi, NG - 1);
        PG4_AXPY(AV, NG - 2);
        PG4_LOAD(AV, PVr, pid0, pid1, 0);
        PG4_AXPY(BV, NG - 1);
        {   char* xo = (char*)(X + (size_t)t * DM);
            char* xbo = (char*)(XN + (size_t)t * DM); float ss = 0.f;
#pragma unroll
            for (int j = 0; j < 8; ++j) { const v2u a = xr[j]; f32x4 v = (f32x4){bflo(a.x), bfhi(a.x), bflo(a.y), bfhi(a.y)}; v += (f32x4){y[2 * j].x, y[2 * j].y, y[2 * j + 1].x, y[2 * j + 1].y};
                if (X) *(GAS f32x4*)(xo + l16 + 1024 * j) = v;
                y[2 * j] = (f32x2){v[0], v[1]}; y[2 * j + 1] = (f32x2){v[2], v[3]};
                ss += (v[0] * v[0] + v[1] * v[1]) + (v[2] * v[2] + v[3] * v[3]); if (!X) *(GAS v2u*)(xbo + l8 + 512 * j) = (v2u){pk2(v[0], v[1]), pk2(v[2], v[3])}; }
            if (rowsq_out) { ss = wave_sum(ss, lane); if (lane == 0) rowsq_out[t] = rowsq_fx(ss); }
            if (XN8) {
                float am = 0.f;
#pragma unroll
                for (int j = 0; j < 16; ++j) am = fmaxf(am, fmaxf(fabsf(y[j].x), fabsf(y[j].y)));
                am = fmaxf(wave_max(am, lane), 1e-30f);
                const float inv = 127.f / am; char* qo = (char*)(XN8 + (size_t)t * DM);
#pragma unroll
                for (int j = 0; j < 8; ++j) *(GAS unsigned*)(qo + l4 + 256 * j) = q8x4((f32x4){y[2 * j].x, y[2 * j].y, y[2 * j + 1].x, y[2 * j + 1].y}, inv);
                if (lane == 0) xsc[t] = am * (1.f / 127.f) / sqrtf(ss * (1.f / DM) + 1e-6f); } }
        LDS_WAIT(); asm volatile("" ::: "memory");
    }
}


__device__ __forceinline__ unsigned enc_i4(float v) { int q = (int)__builtin_rintf(v); q = q < -7 ? -7 : (q > 7 ? 7 : q); return (unsigned)q & 15u; }
__device__ __forceinline__ void convert_int4_plain(const float* src, unsigned char* dst, int nrows, float scale, const float* gain, int gw, int NGW, int lane) {
    for (int l = 0; l < nrows / PEER_N; ++l) {
        f32x4 g[8];
#pragma unroll
        for (int j = 0; j < 8; ++j) g[j] = *(const GAS f32x4*)(gain + (size_t)l * DM + 4 * lane + 256 * j) * scale;
        for (int r0 = 2 * gw; r0 < PEER_N; r0 += 2 * NGW) {
            f32x4 a[2][8];
#pragma unroll
            for (int q = 0; q < 2; ++q) { const float* sp = src + ((size_t)l * PEER_N + r0 + q) * DM + 4 * lane;
#pragma unroll
                for (int j = 0; j < 8; ++j) a[q][j] = *(const GAS f32x4*)(sp + 256 * j); }
#pragma unroll
            for (int q = 0; q < 2; ++q) { const size_t r = (size_t)l * PEER_N + r0 + q;
#pragma unroll
                for (int j = 0; j < 8; ++j) { const f32x4 v = a[q][j] * g[j];
                    const unsigned w = enc_i4(v[0]) | (enc_i4(v[1]) << 4) | (enc_i4(v[2]) << 8) | (enc_i4(v[3]) << 12);
                    *(GAS unsigned short*)(dst + r * 1024 + 128 * j + 2 * lane) = (unsigned short)w; } }
        }
    }
}
__device__ __forceinline__ void peer_xquant_unit(const bf16* XN, const u64_t* rowsq, unsigned* XQH, unsigned* XQL, int tb, int sl, int tid) {
    for (int it = tid; it < 256 * 32; it += NTHREADS) {
        const int t = tb * 256 + (it >> 5), c8 = it & 31;
        const float xs = PX_SCALEI * rowsq_rs(rowsq, t);
        const v4u w = *(const GAS v4u*)(XN + (size_t)t * DM + 256 * sl + 8 * c8);
        const float f[8] = {bflo(w.x), bfhi(w.x), bflo(w.y), bfhi(w.y), bflo(w.z), bfhi(w.z), bflo(w.w), bfhi(w.w)};
        unsigned hi = 0u, lo = 0u;
#pragma unroll
        for (int j = 0; j < 8; ++j) { int q = (int)__builtin_rintf(f[j] * xs); q = q < -119 ? -119 : (q > 119 ? 119 : q);
            const int xl = ((q + 8) & 15) - 8, xh = (q - xl) >> 4;
            hi |= ((unsigned)xh & 15u) << (4 * j); lo |= ((unsigned)xl & 15u) << (4 * j); }
        XQH[(size_t)t * 256 + 32 * sl + c8] = hi; XQL[(size_t)t * 256 + 32 * sl + c8] = lo;
    }
}
#define PI_LOADROWS(buf, tab, ids, i0) do { _Pragma("unroll") for (int i_ = 0; i_ < 8; ++i_) buf[i_] = __builtin_amdgcn_raw_buffer_load_b128(tab, ids[(i0) + i_] * 1024 + (int)soff, 0, 0); } while (0)
#define PI_LOADIDS(ids, t) do { const char* ip_ = (const char*)PIDX + ((size_t)(t) * 128 + 16 * g) * 4; _Pragma("unroll") for (int c_ = 0; c_ < 4; ++c_) { const v4u q_ = *(const GAS v4u*)(ip_ + 16 * c_); \
        ids[4 * c_] = (int)q_.x; ids[4 * c_ + 1] = (int)q_.y; ids[4 * c_ + 2] = (int)q_.z; ids[4 * c_ + 3] = (int)q_.w; } } while (0)
#define PI_UGROUP(buf, i0) do { _Pragma("unroll") for (int i_ = 0; i_ < 8; ++i_) { int ah_ = 0, al_ = 0; \
        _Pragma("unroll") for (int c_ = 0; c_ < 4; ++c_) { ah_ = __builtin_amdgcn_sdot8((int)buf[i_][c_], (int)xh[c_], ah_, false); al_ = __builtin_amdgcn_sdot8((int)buf[i_][c_], (int)xl[c_], al_, false); } \
        int p_ = 16 * ah_ + al_; p_ += __builtin_amdgcn_ds_bpermute((lane ^ 1) << 2, p_); p_ += __builtin_amdgcn_ds_bpermute((lane ^ 2) << 2, p_); p_ += __builtin_amdgcn_ds_bpermute((lane ^ 4) << 2, p_); \
        if (m == (((i0) + i_) >> 1)) { if (((i0) + i_) & 1) keep1 = p_; else keep0 = p_; } } } while (0)
#define PI_LOADROWS16(buf, tab, ids) do { _Pragma("unroll") for (int i_ = 0; i_ < 16; ++i_) buf[i_] = __builtin_amdgcn_raw_buffer_load_b128(tab, ids[i_] * 1024 + (int)soff, 0, 0); } while (0)
#define PI_LOADX(xh_, xl_, t) do { xh_ = *(const GAS v4u*)((const char*)XQH + (size_t)(t) * 1024 + soff); xl_ = *(const GAS v4u*)((const char*)XQL + (size_t)(t) * 1024 + soff); } while (0)
#define PI_HM_ADD(dst, src, bm) asm volatile("s_nop 1\n\tv_add_u32_dpp %0, %1, %1 row_half_mirror row_mask:0xf bank_mask:" bm : "+v"(dst) : "v"(src))
#define PI_COMPUTE16(buf, xh_, xl_, t) do { int p_[16]; \
        _Pragma("unroll") for (int i_ = 0; i_ < 16; ++i_) { int ah_ = 0, al_ = 0; \
            _Pragma("unroll") for (int c_ = 0; c_ < 4; ++c_) { ah_ = __builtin_amdgcn_sdot8((int)buf[i_][c_], (int)xh_[c_], ah_, false); al_ = __builtin_amdgcn_sdot8((int)buf[i_][c_], (int)xl_[c_], al_, false); } \
            p_[i_] = 16 * ah_ + al_; } \
        int q_[8]; \
        _Pragma("unroll") for (int j_ = 0; j_ < 8; ++j_) { q_[j_] = 0; PI_HM_ADD(q_[j_], p_[j_], "0x5"); PI_HM_ADD(q_[j_], p_[j_ + 8], "0xa"); }     \
        int r_[4]; \
        _Pragma("unroll") for (int j_ = 0; j_ < 4; ++j_) { const int keep_ = b1 ? q_[j_ + 4] : q_[j_], send_ = b1 ? q_[j_] : q_[j_ + 4]; r_[j_] = keep_ + __builtin_amdgcn_update_dpp(0, send_, 0x4E, 0xf, 0xf, true); } \
        int s_[2]; \
        _Pragma("unroll") for (int j_ = 0; j_ < 2; ++j_) { const int keep_ = b0 ? r_[j_ + 2] : r_[j_], send_ = b0 ? r_[j_] : r_[j_ + 2]; s_[j_] = keep_ + __builtin_amdgcn_update_dpp(0, send_, 0xB1, 0xf, 0xf, true); } \
        if ((t) < T) *(GAS v2u*)(PARTI + ((size_t)s * T + (t)) * 128 + 2 * lane) = (v2u){(unsigned)s_[0], (unsigned)s_[1]}; } while (0)
__device__ __forceinline__ void peer_u_phase_i4(const unsigned* XQH, const unsigned* XQL, const unsigned char* PU, const int* PIDX, int* PARTI, int bid, int G, int wave, int lane) {
    const int s = bid & 7, nr = (G - s + 7) >> 3, q = (bid >> 3) * NWAVES + wave, stride = nr * NWAVES, g = lane >> 3, m = lane & 7;
    const unsigned soff = 128u * (unsigned)s + 16u * (unsigned)m;
    const bool b0 = (lane & 1) != 0, b1 = (lane & 2) != 0;
    if (q >= T) return;
    const __amdgpu_buffer_rsrc_t PUr = __builtin_amdgcn_make_buffer_rsrc((void*)PU, 0, PEER_N * 1024, 0x00020000);
#define PI_CL(t) ((t) < T ? (t) : T - 1)
    int I1[16], I2[16]; v4u xh0, xl0, xh1, xl1, xh2, xl2, RA[16], RB[16];
    PI_LOADIDS(I1, q); PI_LOADX(xh0, xl0, q);
    PI_LOADROWS16(RA, PUr, I1);
    PI_LOADIDS(I1, PI_CL(q + stride)); PI_LOADX(xh1, xl1, PI_CL(q + stride));
    for (int t = q; t < T; t += 2 * stride) {
        PI_LOADROWS16(RB, PUr, I1);
        PI_LOADIDS(I2, PI_CL(t + 2 * stride)); PI_LOADX(xh2, xl2, PI_CL(t + 2 * stride));
        PI_COMPUTE16(RA, xh0, xl0, t);
        PI_LOADROWS16(RA, PUr, I2);
        PI_LOADIDS(I1, PI_CL(t + 3 * stride)); PI_LOADX(xh0, xl0, PI_CL(t + 3 * stride));
        PI_COMPUTE16(RB, xh1, xl1, t + stride);
        xh1 = xh0; xl1 = xl0; xh0 = xh2; xl0 = xl2;
    }
#undef PI_CL
}


constexpr float PV_SCALE4S = 5.65f;
__device__ __forceinline__ unsigned enc_e2m1s(float v) {
    const float a = fabsf(v);
    const unsigned code = a < 0.25f ? 0u : a < 0.75f ? 1u : a < 1.25f ? 2u : a < 1.75f ? 3u : a < 2.5f ? 4u : a < 3.5f ? 5u : a < 5.0f ? 6u : 7u;
    return code | (v < 0.f ? 8u : 0u);
}
__device__ __forceinline__ void convert_fp4_plain(const float* src, unsigned char* dst, int nrows, float scale, const float* gain, int gw, int NGW, int lane) {
    for (int r0 = 2 * gw; r0 < nrows; r0 += 2 * NGW) {
        f32x4 a[2][8];
#pragma unroll
        for (int q = 0; q < 2; ++q) { const float* sp = src + (size_t)(r0 + q) * DM + 4 * lane;
#pragma unroll
            for (int j = 0; j < 8; ++j) a[q][j] = *(const GAS f32x4*)(sp + 256 * j); }
#pragma unroll
        for (int q = 0; q < 2; ++q) { const int r = r0 + q; const float* gp = gain ? gain + (size_t)(r / PEER_N) * DM + 4 * lane : nullptr;
#pragma unroll
            for (int j = 0; j < 8; ++j) { f32x4 v = a[q][j] * scale; if (gp) v = v * *(const GAS f32x4*)(gp + 256 * j);
                const unsigned w = enc_e2m1s(v[0]) | (enc_e2m1s(v[1]) << 4) | (enc_e2m1s(v[2]) << 8) | (enc_e2m1s(v[3]) << 12);
                *(GAS unsigned short*)(dst + (size_t)r * 1024 + 128 * j + 2 * lane) = (unsigned short)w; } }
    }
}
#define PVS_LOADMETA(ids, pp, gg, t) do { PI_LOADIDS(ids, t); _Pragma("unroll") for (int sp_ = 0; sp_ < 8; ++sp_) pp[sp_] = *(const GAS v2u*)(PARTI + ((size_t)sp_ * T + (t)) * 128 + 2 * lane); \
        gg = *(const GAS f32x2*)(PGATE + (size_t)(t) * 128 + 2 * lane); } while (0)
#define PVS_COMPUTE16(buf, pp, gg, t) do { float w0, w1; { int s0_ = 0, s1_ = 0; _Pragma("unroll") for (int sp_ = 0; sp_ < 8; ++sp_) { s0_ += (int)pp[sp_].x; s1_ += (int)pp[sp_].y; } \
            const float d0_ = (float)s0_ * (1.f / (PX_SCALEI * PU_SCALEI)), d1_ = (float)s1_ * (1.f / (PX_SCALEI * PU_SCALEI)); \
            w0 = gg.x * 0.5f * d0_ * (1.f + erff(d0_ * 0.70710678118654752f)) * (1.f / PV_SCALE4S); w1 = gg.y * 0.5f * d1_ * (1.f + erff(d1_ * 0.70710678118654752f)) * (1.f / PV_SCALE4S); } \
        f32x2 y[16]; _Pragma("unroll") for (int i_ = 0; i_ < 16; ++i_) y[i_] = (f32x2){0.f, 0.f}; \
        _Pragma("unroll") for (int i_ = 0; i_ < 16; ++i_) { \
            const float w_ = __builtin_bit_cast(float, __builtin_amdgcn_ds_bpermute(((lane & 56) | (i_ >> 1)) << 2, __builtin_bit_cast(int, (i_ & 1) ? w1 : w0))); const f32x2 wv_ = {w_, w_}; \
            _Pragma("unroll") for (int c_ = 0; c_ < 4; ++c_) { const unsigned u_ = buf[i_][c_]; \
                y[4 * c_ + 0] += __builtin_amdgcn_cvt_scalef32_pk_f32_fp4(u_, 1.0f, 0) * wv_; y[4 * c_ + 1] += __builtin_amdgcn_cvt_scalef32_pk_f32_fp4(u_, 1.0f, 1) * wv_; \
                y[4 * c_ + 2] += __builtin_amdgcn_cvt_scalef32_pk_f32_fp4(u_, 1.0f, 2) * wv_; y[4 * c_ + 3] += __builtin_amdgcn_cvt_scalef32_pk_f32_fp4(u_, 1.0f, 3) * wv_; } } \
        {   LAS float* wp_ = yl + g * 288 + m * 36; \
            _Pragma("unroll") for (int c_ = 0; c_ < 8; ++c_) *(LAS f32x4*)(wp_ + 4 * c_) = (f32x4){y[2 * c_].x, y[2 * c_].y, y[2 * c_ + 1].x, y[2 * c_ + 1].y}; \
            LDS_WAIT(); asm volatile("" ::: "memory"); \
            f32x4 acc_ = {0.f, 0.f, 0.f, 0.f}; const LAS float* rp_ = yl + (lane >> 3) * 36 + 4 * (lane & 7); \
            _Pragma("unroll") for (int gg_ = 0; gg_ < 8; ++gg_) acc_ += *(const LAS f32x4*)(rp_ + gg_ * 288); \
            LDS_WAIT(); asm volatile("" ::: "memory"); \
            if ((t) < T) { bf16* xp_ = XN + (size_t)(t) * DM + 256 * s + 4 * lane; const v2u a_ = *(const GAS v2u*)xp_; \
                const f32x4 v_ = (f32x4){bflo(a_.x), bfhi(a_.x), bflo(a_.y), bfhi(a_.y)} + acc_; \
                *(GAS v2u*)xp_ = (v2u){pk2(v_[0], v_[1]), pk2(v_[2], v_[3])}; \
                if (Xout) *(GAS f32x4*)(Xout + (size_t)(t) * DM + 256 * s + 4 * lane) = v_; \
                if (rowsq_out) { const float ss_ = wave_sum((v_[0] * v_[0] + v_[1] * v_[1]) + (v_[2] * v_[2] + v_[3] * v_[3]), lane); if (lane == 0) atomicAdd(rowsq_out + (t), rowsq_fx(ss_)); } } } } while (0)
__device__ __forceinline__ void peer_v_phase_s(bf16* XN, const unsigned char* PV, const int* PIDX, const float* PGATE, const int* PARTI, float* Xout, u64_t* rowsq_out, LAS float* yl, int bid, int G, int wave, int lane) {
    const int s = bid & 7, nr = (G - s + 7) >> 3, q = (bid >> 3) * NWAVES + wave, stride = nr * NWAVES, g = lane >> 3, m = lane & 7;
    const unsigned soff = 128u * (unsigned)s + 16u * (unsigned)m;
    const bool b0 = (lane & 1) != 0, b1 = (lane & 2) != 0;
    if (q >= T) return;
    const __amdgpu_buffer_rsrc_t PVr = __builtin_amdgcn_make_buffer_rsrc((void*)PV, 0, PEER_N * 1024, 0x00020000);
#define PVS_CL(t) ((t) < T ? (t) : T - 1)
    int I0[16], I1[16]; v2u P0[8], P1[8]; f32x2 G0, G1; v4u RA[16], RB[16];
#define PVS_LOADPG(pp, gg, t) do { _Pragma("unroll") for (int sp_ = 0; sp_ < 8; ++sp_) pp[sp_] = *(const GAS v2u*)(PARTI + ((size_t)sp_ * T + (t)) * 128 + 2 * lane); gg = *(const GAS f32x2*)(PGATE + (size_t)(t) * 128 + 2 * lane); } while (0)
    PI_LOADIDS(I0, q); PVS_LOADPG(P0, G0, q);
    PI_LOADROWS16(RA, PVr, I0);
    PI_LOADIDS(I1, PVS_CL(q + stride)); PVS_LOADPG(P1, G1, PVS_CL(q + stride));
    for (int t = q; t < T; t += 2 * stride) {
        PI_LOADROWS16(RB, PVr, I1);
        PI_LOADIDS(I0, PVS_CL(t + 2 * stride));
        PVS_COMPUTE16(RA, P0, G0, t);
        PVS_LOADPG(P0, G0, PVS_CL(t + 2 * stride));
        PI_LOADROWS16(RA, PVr, I0);
        PI_LOADIDS(I1, PVS_CL(t + 3 * stride));
        PVS_COMPUTE16(RB, P1, G1, t + stride);
        PVS_LOADPG(P1, G1, PVS_CL(t + 3 * stride));
    }
#undef PVS_LOADPG
#undef PVS_CL
}

typedef short s16x4 __attribute__((ext_vector_type(4)));
typedef __attribute__((address_space(3))) const char* lds_cptr;
__device__ __forceinline__ s16x4 vtr(lds_cptr p) { return __builtin_bit_cast(s16x4, __builtin_amdgcn_ds_read_tr16_b64_v4i16((__attribute__((address_space(3))) s16x4*)p)); }
__device__ __forceinline__ unsigned cvtpk(float lo, float hi) { unsigned r; asm("v_cvt_pk_bf16_f32 %0, %1, %2" : "=v"(r) : "v"(lo), "v"(hi)); return r; }
constexpr int AS_STAGE = 65536, AS_V = 32768, AT_TAB = LDSCTL_OFF + 2048;
constexpr float LOG2E = 1.4426950408889634f;
__device__ __forceinline__ void at_dma16(const char* sbase, unsigned voff, unsigned ldsaddr) {
    asm volatile("s_mov_b32 m0, %2\n\ts_nop 0\n\tglobal_load_lds_dwordx4 %0, %1" :: "v"(voff), "s"(sbase), "s"(ldsaddr) : "memory");
}
__device__ __forceinline__ void store_o_block32(bf16* base16, const f32x16& O, float inv, int hh) {
    char* bp = (char*)base16 + (hh ? 16 : 0);
#pragma unroll
    for (int p = 0; p < 2; ++p) {
        unsigned ax = cvtpk(O[8 * p] * inv, O[8 * p + 1] * inv), ay = cvtpk(O[8 * p + 2] * inv, O[8 * p + 3] * inv);
        unsigned bx = cvtpk(O[8 * p + 4] * inv, O[8 * p + 5] * inv), by = cvtpk(O[8 * p + 6] * inv, O[8 * p + 7] * inv);
        const auto rx = __builtin_amdgcn_permlane32_swap(ax, bx, false, false), ry = __builtin_amdgcn_permlane32_swap(ay, by, false, false);
        *(GAS v4u*)(bp + 32 * p) = (v4u){rx[0], ry[0], rx[1], ry[1]};
    }
}
template <int TYPE>
__device__ __forceinline__ void attn_unit(LAS unsigned char* lds, const bf16* QKV, bf16* ATT, u64_t* mixsq, int b, int head, int qb, const float* tabsrc, float Cl2, float sinkl2, int tid) {
    const int lane = tid & 63, w = __builtin_amdgcn_readfirstlane(tid >> 6), hh = lane >> 5, l31 = lane & 31;
    int qcol, kcol, vcol, ocol;
    if (TYPE == 0) { qcol = QA + head * 64; kcol = KA + (head / 3) * 64; vcol = VA + (head / 3) * 64; ocol = OA + head * 64; }
    else if (TYPE == 1) { qcol = QB + head * 64; kcol = KB + head * 64; vcol = VB + head * 64; ocol = OB + head * 64; }
    else { qcol = QC + head * 64; kcol = KC + (head / 3) * 64; vcol = VC + (head / 3) * 64; ocol = OC + head * 64; }
    const int q0 = 256 * qb + 32 * w, qpos = q0 + l31;
    int t_begin, t_end;
    if (TYPE == 0) { t_begin = 4 * qb - 2; if (t_begin < 0) t_begin = 0; t_end = 4 * qb + 6; if (t_end > 32) t_end = 32; }
    else if (TYPE == 1) { int a = 4 * qb - 4; a = a < 0 ? 0 : (a > 24 ? 24 : a); int e = 4 * qb - 1; e = e < 0 ? 0 : (e > 24 ? 24 : e); t_begin = a; t_end = e + 8; }
    else { t_begin = 0; t_end = 32; }
    LAS float* tab = (LAS float*)(lds + AT_TAB);
    bf16x8 qf[4];
    {   const bf16* qp = QKV + ((size_t)b * SEQ + qpos) * DIN + qcol + 8 * hh;
#pragma unroll
        for (int s = 0; s < 4; ++s) qf[s] = *(const GAS bf16x8*)(qp + 16 * s); }
    const int drow = 8 * w + (lane >> 3), dsl = lane & 7;
    const unsigned koff = (unsigned)((drow * DIN + kcol + ((dsl ^ ((drow >> 1) & 7)) * 8)) * 2);
    const unsigned voff = (unsigned)((drow * DIN + vcol + (((((dsl >> 2) ^ ((drow >> 1) & 1)) << 2) | (dsl & 3)) * 8)) * 2);
    const char* gbp = (const char*)(QKV + (size_t)b * SEQ * DIN);
    const unsigned ldsb = (unsigned)(size_t)lds + (unsigned)w * 1024u;
#define AT_STAGE(sbuf, t0_) do { _Pragma("unroll") for (int i_ = 0; i_ < 4; ++i_) { const int tl_ = (t0_) + i_; if (tl_ < t_end) { \
        at_dma16(gbp + (size_t)tl_ * (64 * DIN * 2), koff, ldsb + (sbuf) * AS_STAGE + i_ * 8192); at_dma16(gbp + (size_t)tl_ * (64 * DIN * 2), voff, ldsb + (sbuf) * AS_STAGE + AS_V + i_ * 8192); } } } while (0)
    int kread[4], vread[2];
#pragma unroll
    for (int s = 0; s < 4; ++s) kread[s] = l31 * 128 + (((2 * s + hh) ^ ((lane >> 1) & 7)) * 16);
#pragma unroll
    for (int db = 0; db < 2; ++db) vread[db] = (4 * hh + ((lane >> 2) & 3)) * 128 + ((db ^ ((lane >> 3) & 1)) * 64) + 32 * ((lane >> 4) & 1) + 8 * (lane & 3);
    f32x16 O0, O1;
#pragma unroll
    for (int r = 0; r < 16; ++r) { O0[r] = 0.f; O1[r] = 0.f; }
    float lsum = 0.f;
    const int rw = 4 * qb + (w >> 1), cq = 32 * (w & 1) + l31;
    int r0w = rw - 4; r0w = r0w < 0 ? 0 : (r0w > 24 ? 24 : r0w);
    int c0 = cq - 8; c0 = c0 < 0 ? 0 : (c0 > 48 ? 48 : c0);
    const int nst = (t_end - t_begin + 3) >> 2;
    AT_STAGE(0, t_begin);
    if (TYPE == 0) { for (int i = tid; i < 1024; i += NTHREADS) { const int rel = i - 448; tab[i] = (rel >= -128 && rel <= 128) ? tabsrc[head * 257 + rel + 128] * LOG2E - Cl2 : -1e30f; } }
    if (TYPE == 1) { for (int i = tid; i < 15 * 31; i += NTHREADS) tab[i] = tabsrc[head * 465 + i] * LOG2E - Cl2; }
#pragma unroll
    for (int s = 0; s < 4; ++s) asm volatile("" : "+v"(qf[s]));
    VM_WAIT(); __syncthreads();
    bf16x8 kf[8];
#pragma unroll 1
    for (int st = 0; st < nst; ++st) {
        const int t0 = t_begin + 4 * st;
        if (st + 1 < nst) AT_STAGE((st + 1) & 1, t0 + 4);
        bool havek = false;
#pragma unroll 1
      for (int ti = 0; ti < 4; ++ti) {
        const int t = t0 + ti; if (t >= t_end) break;
        bool need = true;
        if (TYPE == 0) need = (64 * t <= q0 + 31 + 128) && (64 * t + 63 >= q0 - 128);
        if (TYPE == 1) need = (t >= r0w) && (t < r0w + 8);
        if (need) {
            const lds_cptr kb_ = (lds_cptr)(lds + (st & 1) * AS_STAGE + ti * 8192), vb_ = (lds_cptr)(lds + (st & 1) * AS_STAGE + AS_V + ti * 8192);
            if (!havek) {
#pragma unroll
                for (int s = 0; s < 4; ++s) { kf[2 * s] = *(const LAS bf16x8*)(kb_ + kread[s]); kf[2 * s + 1] = *(const LAS bf16x8*)(kb_ + kread[s] + 4096); } }
            f32x16 S0, S1;
            if (TYPE == 2) {
#pragma unroll
                for (int r = 0; r < 16; ++r) { S0[r] = -Cl2; S1[r] = -Cl2; }
            } else if (TYPE == 0) {
                const LAS float* tb = tab + (64 * t - qpos + 448 + 4 * hh);
#pragma unroll
                for (int r = 0; r < 16; ++r) { S0[r] = tb[8 * (r >> 2) + (r & 3)]; S1[r] = tb[32 + 8 * (r >> 2) + (r & 3)]; }
            } else {
                const LAS float* tb = tab + ((t - rw + 7) * 31 - cq + 15 + 4 * hh);
                const int kc0 = 4 * hh - c0;
#pragma unroll
                for (int r = 0; r < 16; ++r) { const int ka = 8 * (r >> 2) + (r & 3), kb2 = 32 + ka;
                    const float t0_ = tb[ka], t1_ = tb[kb2];
                    S0[r] = ((unsigned)(ka + kc0) < 16u) ? t0_ : -1e30f; S1[r] = ((unsigned)(kb2 + kc0) < 16u) ? t1_ : -1e30f; }
            }
            __builtin_amdgcn_sched_barrier(0);
#define AT_SB __builtin_amdgcn_sched_barrier(0)
#define AT_SOFTH(SX, base, pa, j0) do { _Pragma("unroll") for (int r = (base); r < (base) + 4; ++r) SX[r] = __builtin_amdgcn_exp2f(SX[r]); \
            lsum += (SX[(base)] + SX[(base) + 1]) + (SX[(base) + 2] + SX[(base) + 3]); \
            pa[(j0)] = cvtpk(SX[(base)], SX[(base) + 1]); pa[(j0) + 1] = cvtpk(SX[(base) + 2], SX[(base) + 3]); } while (0)
#define AT_QK1(i) S1 = __builtin_amdgcn_mfma_f32_32x32x16_bf16(kf[2 * (i) + 1], qf[i], S1, 0, 0, 0)
#pragma unroll
            for (int s = 0; s < 4; ++s) S0 = __builtin_amdgcn_mfma_f32_32x32x16_bf16(kf[2 * s], qf[s], S0, 0, 0, 0);
            s16x4 vf[4][2][2];
#pragma unroll
            for (int ks = 0; ks < 2; ++ks)
#pragma unroll
                for (int db = 0; db < 2; ++db) { vf[ks][db][0] = vtr(vb_ + vread[db] + (16 * ks) * 128); vf[ks][db][1] = vtr(vb_ + vread[db] + (16 * ks + 8) * 128); }
            v4u pa0, pa1, pa2, pa3;
            AT_QK1(0); AT_SB; AT_SOFTH(S0, 0, pa0, 0); AT_SB;
            AT_QK1(1); AT_SB; AT_SOFTH(S0, 4, pa0, 2); AT_SB;
            AT_QK1(2); AT_SB; AT_SOFTH(S0, 8, pa1, 0); AT_SB;
            AT_QK1(3); AT_SB; AT_SOFTH(S0, 12, pa1, 2); AT_SB;
            asm volatile("s_waitcnt lgkmcnt(7)" ::: "memory");
#pragma unroll
            for (int ks = 2; ks < 4; ++ks)
#pragma unroll
                for (int db = 0; db < 2; ++db) { vf[ks][db][0] = vtr(vb_ + vread[db] + (16 * ks) * 128); vf[ks][db][1] = vtr(vb_ + vread[db] + (16 * ks + 8) * 128); }
            AT_SB;
#define AT_PVA(ks, pa) O0 = __builtin_amdgcn_mfma_f32_32x32x16_bf16(__builtin_shufflevector(vf[ks][0][0], vf[ks][0][1], 0, 1, 2, 3, 4, 5, 6, 7), __builtin_bit_cast(bf16x8, pa), O0, 0, 0, 0)
#define AT_PVB(ks, pa) O1 = __builtin_amdgcn_mfma_f32_32x32x16_bf16(__builtin_shufflevector(vf[ks][1][0], vf[ks][1][1], 0, 1, 2, 3, 4, 5, 6, 7), __builtin_bit_cast(bf16x8, pa), O1, 0, 0, 0)
            AT_PVA(0, pa0); AT_SB; AT_SOFTH(S1, 0, pa2, 0); AT_SB;
            AT_PVB(0, pa0); AT_SB; AT_SOFTH(S1, 4, pa2, 2); AT_SB;
            AT_PVA(1, pa1); AT_SB; AT_SOFTH(S1, 8, pa3, 0); AT_SB;
            AT_PVB(1, pa1); AT_SB; AT_SOFTH(S1, 12, pa3, 2); AT_SB;
            havek = (ti < 3) && (t + 1 < t_end);
            if (havek) { asm volatile("s_waitcnt lgkmcnt(7)" ::: "memory");
#pragma unroll
                for (int s = 0; s < 4; ++s) { kf[2 * s] = *(const LAS bf16x8*)(kb_ + 8192 + kread[s]); kf[2 * s + 1] = *(const LAS bf16x8*)(kb_ + 8192 + kread[s] + 4096); } }
            AT_SB;
            AT_PVA(2, pa2); AT_PVB(2, pa2); AT_PVA(3, pa3); AT_PVB(3, pa3);
#undef AT_PVA
#undef AT_PVB
#undef AT_QK1
#undef AT_SOFTH
#undef AT_SB
        } else havek = false;
      }
        VM_WAIT(); __syncthreads();
    }
    lsum += shx(lsum, 32, lane);
    if (TYPE == 0) lsum += __builtin_amdgcn_exp2f(sinkl2 - Cl2);
    const float inv = 1.f / lsum;
    {   float ss = 0.f;
#pragma unroll
        for (int r = 0; r < 16; ++r) { const float a = O0[r] * inv, c = O1[r] * inv; ss += a * a + c * c; }
        ss += shx(ss, 32, lane);
        if (hh == 0) (void)__hip_atomic_fetch_add((GAS u64_t*)(mixsq + (size_t)b * SEQ + qpos), rowsq_fx(ss), __ATOMIC_RELAXED, __HIP_MEMORY_SCOPE_AGENT); }
    bf16* op = ATT + ((size_t)b * SEQ + qpos) * DM + ocol;
    store_o_block32(op, O0, inv, hh); store_o_block32(op + 32, O1, inv, hh);
}


constexpr int MA_K0 = 0, MA_V0 = 32768;
template <int MODE = 0>
__device__ __forceinline__ void mem_unit(LAS unsigned char* lds, const bf16* QM, const bf16* KVM, bf16* OM, const float* gq, int tb, int head, float Cl2, int tid) {
    const int lane = tid & 63, w = __builtin_amdgcn_readfirstlane(tid >> 6), hh = lane >> 5, l31 = lane & 31;
    const size_t trow = (size_t)tb * 256 + 32 * w + l31; const int b = tb >> 3;
    __syncthreads();
    bf16x8 qf[8];
    {   const bf16* qp = QM + trow * MEMW + head * 128 + 8 * hh; const bf16* src = KVM + (size_t)b * NMEM * 1024 + head * 128;
        {   v4u stK[8];
#pragma unroll
            for (int s = 0; s < 8; ++s) qf[s] = *(const GAS bf16x8*)(qp + 16 * s);
            if (MODE != 1) {
#pragma unroll
                for (int i = 0; i < 8; ++i) { const int c = tid + 512 * i, row = c >> 4, ch = c & 15; stK[i] = *(const GAS v4u*)(src + (size_t)row * 1024 + ch * 8); }
#pragma unroll
                for (int i = 0; i < 8; ++i) { const int c = tid + 512 * i, row = c >> 4, ch = c & 15; *(LAS v4u*)(lds + row * 256 + ((ch ^ (row & 15)) * 16)) = stK[i]; } }
        }
        __builtin_amdgcn_sched_barrier(0);
        f32x4 gg[16]; v4u stV[8];
#pragma unroll
        for (int s = 0; s < 8; ++s) { gg[2 * s] = *(const GAS f32x4*)(gq + 16 * s + 8 * hh); gg[2 * s + 1] = *(const GAS f32x4*)(gq + 16 * s + 8 * hh + 4); }
        if (MODE != 1) {
#pragma unroll
            for (int i = 0; i < 8; ++i) { const int c = tid + 512 * i, row = c >> 4, ch = c & 15; stV[i] = *(const GAS v4u*)(src + (size_t)row * 1024 + 512 + ch * 8); } }
        __builtin_amdgcn_sched_barrier(0);
        float ss = 0.f;
#pragma unroll
        for (int s = 0; s < 8; ++s)
#pragma unroll
            for (int j = 0; j < 8; ++j) { const float f = __builtin_bit_cast(float, (unsigned)(unsigned short)qf[s][j] << 16); ss += f * f; }
        ss += shx(ss, 32, lane);
        const float r = 0.12751743074602468f / sqrtf(ss * (1.f / 128.f) + EPS);
#pragma unroll
        for (int s = 0; s < 8; ++s) { const f32x4 g0 = gg[2 * s], g1 = gg[2 * s + 1];
            v4u o;
#pragma unroll
            for (int j = 0; j < 4; ++j) { const float f0 = __builtin_bit_cast(float, (unsigned)(unsigned short)qf[s][2 * j] << 16), f1 = __builtin_bit_cast(float, (unsigned)(unsigned short)qf[s][2 * j + 1] << 16);
                const float ga = (2 * j < 4) ? g0[2 * j] : g1[2 * j - 4], gb2 = (2 * j + 1 < 4) ? g0[2 * j + 1] : g1[2 * j + 1 - 4];
                o[j] = cvtpk(f0 * r * ga, f1 * r * gb2); }
            qf[s] = __builtin_bit_cast(bf16x8, o); }
        if (MODE != 1) {
#pragma unroll
            for (int i = 0; i < 8; ++i) { const int c = tid + 512 * i, row = c >> 4, ch = c & 15; *(LAS v4u*)(lds + 65536 + row * 256 + (((ch >> 2) ^ (row & 3)) * 64) + (ch & 3) * 16) = stV[i]; } }
        __builtin_amdgcn_sched_barrier(0);
    }
    int kread[8], vread[4];
#pragma unroll
    for (int s = 0; s < 8; ++s) kread[s] = l31 * 256 + (((2 * s + hh) ^ (l31 & 15)) * 16);
#pragma unroll
    for (int db = 0; db < 4; ++db) vread[db] = 65536 + (4 * hh + ((lane >> 2) & 3)) * 256 + ((db ^ ((lane >> 2) & 3)) * 64) + 32 * ((lane >> 4) & 1) + 8 * (lane & 3);
    f32x16 O[4];
#pragma unroll
    for (int db = 0; db < 4; ++db)
#pragma unroll
        for (int r = 0; r < 16; ++r) O[db][r] = 0.f;
    float lsum = 0.f;
    __syncthreads();
#define MA_SB __builtin_amdgcn_sched_barrier(0)
#define MA_LW(n) asm volatile("s_waitcnt lgkmcnt(" #n ")" ::: "memory")
#pragma unroll 1
    for (int t = 0; t < (MODE ? 0 : 4); ++t) {
        const lds_cptr kb_ = (lds_cptr)(lds + t * 16384), vb_ = (lds_cptr)(lds + t * 16384);
        f32x16 S0, S1;
#pragma unroll
        for (int r = 0; r < 16; ++r) { S0[r] = -Cl2; S1[r] = -Cl2; }
        bf16x8 a0[8], a1[4];
#pragma unroll
        for (int s = 0; s < 8; ++s) a0[s] = *(const LAS bf16x8*)(kb_ + kread[s]);
        MA_SB;
#pragma unroll
        for (int s = 0; s < 4; ++s) S0 = __builtin_amdgcn_mfma_f32_32x32x16_bf16(a0[s], qf[s], S0, 0, 0, 0);
        MA_SB;
#pragma unroll
        for (int s = 0; s < 4; ++s) a1[s] = *(const LAS bf16x8*)(kb_ + kread[s] + 8192);
        MA_SB;
#pragma unroll
        for (int s = 4; s < 8; ++s) S0 = __builtin_amdgcn_mfma_f32_32x32x16_bf16(a0[s], qf[s], S0, 0, 0, 0);
        MA_SB;
#pragma unroll
        for (int s = 0; s < 4; ++s) a0[s] = *(const LAS bf16x8*)(kb_ + kread[4 + s] + 8192);
        MA_SB;
#pragma unroll
        for (int s = 0; s < 4; ++s) S1 = __builtin_amdgcn_mfma_f32_32x32x16_bf16(a1[s], qf[s], S1, 0, 0, 0);
#pragma unroll
        for (int s = 0; s < 4; ++s) S1 = __builtin_amdgcn_mfma_f32_32x32x16_bf16(a0[s], qf[4 + s], S1, 0, 0, 0);
        MA_SB;
        s16x4 vf[2][4][2];
#define MA_VRD(ks) do { _Pragma("unroll") for (int db = 0; db < 4; ++db) { vf[(ks) & 1][db][0] = vtr(vb_ + vread[db] + (16 * (ks)) * 256); vf[(ks) & 1][db][1] = vtr(vb_ + vread[db] + (16 * (ks) + 8) * 256); } } while (0)
#define MA_PV(ks) do { _Pragma("unroll") for (int db = 0; db < 4; ++db) { const bf16x8 va = __builtin_shufflevector(vf[(ks) & 1][db][0], vf[(ks) & 1][db][1], 0, 1, 2, 3, 4, 5, 6, 7); \
            O[db] = __builtin_amdgcn_mfma_f32_32x32x16_bf16(va, pb[ks], O[db], 0, 0, 0); } } while (0)
        MA_VRD(0);
        MA_SB;
#pragma unroll
        for (int r = 0; r < 16; ++r) { S0[r] = __builtin_amdgcn_exp2f(S0[r]); S1[r] = __builtin_amdgcn_exp2f(S1[r]); lsum += S0[r] + S1[r]; }
        bf16x8 pb[4];
#pragma unroll
        for (int hf = 0; hf < 2; ++hf) {
            v4u a, c;
#pragma unroll
            for (int j = 0; j < 4; ++j) { a[j] = cvtpk(S0[8 * hf + 2 * j], S0[8 * hf + 2 * j + 1]); c[j] = cvtpk(S1[8 * hf + 2 * j], S1[8 * hf + 2 * j + 1]); }
            pb[hf] = __builtin_bit_cast(bf16x8, a); pb[2 + hf] = __builtin_bit_cast(bf16x8, c);
        }
        MA_SB;
        MA_LW(7); MA_VRD(1); MA_SB; MA_PV(0); MA_SB;
        MA_LW(7); MA_VRD(2); MA_SB; MA_PV(1); MA_SB;
        MA_LW(7); MA_VRD(3); MA_SB; MA_PV(2); MA_SB;
        MA_PV(3);
        MA_SB;
    }
#undef MA_VRD
#undef MA_PV
#undef MA_SB
#undef MA_LW
    lsum += shx(lsum, 32, lane);
    const float inv = MODE ? 1.f : 1.f / lsum;
    bf16* op = OM + trow * MEMW + head * 128;
#pragma unroll
    for (int db = 0; db < 4; ++db) store_o_block32(op + 32 * db, O[db], inv, hh);
}

struct Args { const float* in[23]; float* out; unsigned char* ws; int ph_lo, ph_hi, use_bar, pad; };
#ifndef MK_OFF
#define MK_OFF 0u
#endif
#ifndef REP_ATT
#define REP_ATT 1
#endif
#ifndef REP_P0
#define REP_P0 1
#endif
#ifndef REP_U
#define REP_U 1
#endif
#ifndef REP_GEMM
#define REP_GEMM 1
#endif
#ifndef REP_NORM
#define REP_NORM 1
#endif
#ifndef REP_SEL
#define REP_SEL 1
#endif
#ifndef REP_MEM
#define REP_MEM 1
#endif
#define PHON(k) (!((MK_OFF >> (k)) & 1u))
#ifndef MK_REP
#define MK_REP 0
#endif
constexpr int PH_PER_LAYER = 9, PH_BASE = 2, N_PHASES = PH_BASE + DEPTH * PH_PER_LAYER;
constexpr int PTAB_OFF = LDSCTL_OFF + 1024;

__global__ void __launch_bounds__(NTHREADS, 2) mega(Args a) {
    extern __shared__ __attribute__((aligned(16))) unsigned char lds_raw[];
    LAS unsigned char* lds = (LAS unsigned char*)lds_raw;
    const int wave0_ = __builtin_amdgcn_readfirstlane((int)threadIdx.x >> 6);
    {   const int tid0 = threadIdx.x;
        for (int u = tid0; u < (LDS_BYTES - LDSCTL_OFF) / 4; u += NTHREADS) ((LAS unsigned*)(lds + LDSCTL_OFF))[u] = 0u;
        __syncthreads();
        if (tid0 < 23) ((LAS unsigned long long*)(lds + PTAB_OFF))[tid0] = (unsigned long long)a.in[tid0];
        if (tid0 == 23) ((LAS unsigned long long*)(lds + PTAB_OFF))[23] = (unsigned long long)a.out;
        if (tid0 == 24) ((LAS unsigned long long*)(lds + PTAB_OFF))[24] = (unsigned long long)a.ws;
        __syncthreads();
    }
    volatile LAS unsigned* MISC = (volatile LAS unsigned*)(lds + MISC_OFF);
    const int G = gridDim.x, bid = blockIdx.x, NGW = G * NWAVES;
    const int use_bar = a.use_bar;
    XcdBarrier bar; bar.bar = (unsigned*)(a.ws + WS_CTL) + CW_BAR; bar.x = 0; bar.st = MISC + 8;
    if (use_bar) bar = xcd_barrier_post((unsigned*)(a.ws + WS_CTL) + CW_BAR, MISC + 8);
    const int lo = a.ph_lo, hi = a.ph_hi;
#define IN(k) (lo <= (k) && (k) < hi)
#define SEAM(k) do { if (use_bar && IN(k) && IN((k) + 1)) xcd_barrier(bar); } while (0)
#define PHL() unsigned z0_ = 0u; asm volatile("" : "+v"(z0_)); int tid_ = wave0_ * 64 + (int)__builtin_amdgcn_mbcnt_hi(~0u, __builtin_amdgcn_mbcnt_lo(~0u, z0_)); asm volatile("" : "+v"(tid_));     const int lane_ = tid_ & 63, wave_ = __builtin_amdgcn_readfirstlane(tid_ >> 6), gw_ = bid * NWAVES + wave_; (void)lane_; (void)gw_; \
              int pz_ = 0; asm volatile("" : "+s"(pz_))
#define PTR(i) ((const float*)ldptr(lds, (i) + pz_))
#define WSP() ((unsigned char*)ldptr(lds, 24 + pz_))
#define OUTP() ((float*)ldptr(lds, 23 + pz_))

    if (IN(0) && PHON(0)) {
        PHL(); unsigned char* ws = WSP();
        {
            LAS float* red = (LAS float*)(lds + LDSCTL_OFF + 2048);
            constexpr int Q_IN = DIN / 32, Q_OUT = DM / 32, Q_PQ = DM / 32, Q_MQ = MEMW / 32, Q_KV = 1024 / 32, Q_L = Q_IN + Q_OUT + Q_PQ + Q_MQ + Q_KV;
#pragma unroll 1
            for (int it = bid; it < DEPTH * Q_L; it += G) { const int l = it / Q_L; int r = it % Q_L;
                if (r < Q_IN) { wq_item<true>(PTR(4) + (size_t)l * DM * DIN, DIN, 32 * r, PTR(3) + (size_t)l * DM, ws + WS_WIN8 + (size_t)l * DIN * DM, (float*)(ws + WS_WSC) + (size_t)l * DIN, lds + RING_OFF, red, tid_); continue; } r -= Q_IN;
                if (r < Q_OUT) { wq_item<false>(PTR(11) + (size_t)l * DM * DM, DM, 32 * r, PTR(10) + (size_t)l * DM, ws + WS_WOUT8 + (size_t)l * DM * DM, (float*)(ws + WS_WSCO) + (size_t)l * DM, lds + RING_OFF, red, tid_); continue; } r -= Q_OUT;
                if (r < Q_PQ) { wq_item<false>(PTR(19) + (size_t)l * DM * DM, DM, 32 * r, PTR(18) + (size_t)l * DM, ws + WS_WPQ8 + (size_t)l * DM * DM, (float*)(ws + WS_WSCP) + (size_t)l * DM, lds + RING_OFF, red, tid_); continue; } r -= Q_PQ;
                if (r < Q_MQ) { wq_item<false>(PTR(14) + (size_t)l * DM * MEMW, MEMW, 32 * r, PTR(12) + (size_t)l * DM, ws + WS_WMQ8 + (size_t)l * MEMW * DM, (float*)(ws + WS_WSCM) + (size_t)l * MEMW, lds + RING_OFF, red, tid_); continue; } r -= Q_MQ;
                wq_item<false>(PTR(15) + (size_t)l * DM * 1024, 1024, 32 * r, nullptr, ws + WS_WMKV + (size_t)l * 1024 * DM, (float*)(ws + WS_WSCKV) + (size_t)l * 1024, lds + RING_OFF, red, tid_); }
        }
        LAS float* scr = (LAS float*)(lds + RING_OFF + wave_ * 16384);
        constexpr int I_MO = 8 * 64, I_L = I_MO;
        for (int it = gw_; it < DEPTH * I_L; it += NGW) {
            const int l = it / I_L; int r = it % I_L;
            transpose_item<false>(PTR(17) + (size_t)l * MEMW * DM, MEMW, DM, (bf16*)(ws + WS_WMO) + (size_t)l * DM * MEMW, scr, r, lane_);
        }
        const size_t gtid = (size_t)bid * NTHREADS + tid_, nth = (size_t)G * NTHREADS;
        {
            GAS v4u* z0 = (GAS v4u*)(ws + WS_MIXSQ); const v4u zz = {0u, 0u, 0u, 0u};
            for (size_t i = gtid; i < (size_t)DEPTH * 3 * T / 2; i += nth) z0[i] = zz;
            for (int l = 0; l < DEPTH; ++l) { GAS v4u* z1 = (GAS v4u*)((u64_t*)(ws + WS_ROWSQ) + (size_t)(l * 3 + 1) * T); for (size_t i = gtid; i < (size_t)2 * T / 2; i += nth) z1[i] = zz; } }
        convert_bf16(PTR(20), (bf16*)(ws + WS_PKEYS), (size_t)DEPTH * 8 * 2 * 128 * 128, gtid, nth);
        convert_int4_plain(PTR(21), ws + WS_PU, DEPTH * PEER_N, PU_SCALEI, PTR(18), gw_, NGW, lane_);
        convert_fp4_rows(PTR(22), ws + WS_PV, PEER_N, PV_SCALE4, nullptr, gw_, NGW, lane_);
        {   const float* x0 = PTR(0); bf16* XN = (bf16*)(ws + WS_XN); u64_t* rsq = (u64_t*)(ws + WS_ROWSQ);
            for (int m = 2 * gw_; m < T; m += 2 * NGW) prep_rows2(x0 + (size_t)m * DM, XN + (size_t)m * DM, rsq + m, ws + WS_XN8 + (size_t)m * DM, (float*)(ws + WS_XSC) + m, lane_); }
        {   const float* mem = PTR(1); const float* gkv = PTR(13);
            for (int m = gw_; m < BATCH * NMEM; m += NGW) {
                const GAS f32x4* xr = (const GAS f32x4*)(mem + (size_t)m * DM) + lane_;
                f32x4 v[8]; float s = 0.f;
#pragma unroll
                for (int j = 0; j < 8; ++j) { v[j] = xr[64 * j]; s += (v[j].x * v[j].x + v[j].y * v[j].y) + (v[j].z * v[j].z + v[j].w * v[j].w); }
                const float rstd = 1.f / sqrtf(wave_sum(s, lane_) * (1.f / DM) + EPS);
#pragma unroll 1
                for (int l = 0; l < DEPTH; ++l) rms_row_to_i8(v, rstd, gkv + (size_t)l * DM, ws + WS_MEMN + ((size_t)l * BATCH * NMEM + m) * DM, (float*)(ws + WS_MEMS) + l * BATCH * NMEM + m, lane_); } }
        float* rope = (float*)(ws + WS_ROPE); float* biasA = (float*)(ws + WS_BIASA);
        if (gtid < 64 * 16) { const int pos = (int)gtid >> 4, i = (int)gtid & 15; const float ang = (float)pos * ROPE_INV[i]; rope[gtid * 2] = cosf(ang); rope[gtid * 2 + 1] = sinf(ang); }
        if (gtid < 12 * 257) { const int h = (int)gtid / 257, rel = (int)gtid % 257 - 128; biasA[gtid] = PTR(2)[t5_bucket(rel) * 12 + h]; }
    }
    SEAM(0);
    if (IN(1) && PHON(1)) {
#pragma unroll 1
        for (int l = 0; l < DEPTH; ++l) {
            PHL(); unsigned char* ws = WSP();
            pg8::Gemm g{(bf16*)(ws + WS_MEMN + (size_t)l * BATCH * NMEM * DM), (bf16*)(ws + WS_WMKV + (size_t)l * 1024 * DM), BATCH * NMEM, 1024, DM / 2};
            OffsetOrder S; S.init(BATCH * NMEM, 1024, G, bid, 64 * l);
            bf16* KVMl = (bf16*)(ws + WS_KVM) + (size_t)l * BATCH * NMEM * 1024;
            pg8::EpiBf16Q8 E{KVMl, 1024, (const float*)(ws + WS_MEMS) + (size_t)l * BATCH * NMEM, (const float*)(ws + WS_WSCKV) + (size_t)l * 1024};
            pg8::gemm_phase<pg8::EpiBf16Q8, OffsetOrder, true, true>(lds + RING_OFF, g, S, E, tid_);
            VM_WAIT(); __syncthreads();
            const float* gk = PTR(16) + (size_t)l * 256 + 128;
#pragma unroll 1
            for (int i = 0; i < 4; ++i) { pg8::Unit uu; uu.pm = 0; uu.pn = 0; if (!S.next(i, uu)) break;
                if (uu.pn < 2) {
                    for (int r2 = wave_; r2 < 128; r2 += NWAVES) { const int row = uu.pm * 256 + 2 * r2 + (lane_ >> 5), cl = lane_ & 31;
                        GAS v4u* p = (GAS v4u*)(KVMl + (size_t)row * 1024 + 256 * uu.pn + 8 * cl);
                        const v4u w = *p;
                        float f[8] = {bflo(w.x), bfhi(w.x), bflo(w.y), bfhi(w.y), bflo(w.z), bfhi(w.z), bflo(w.w), bfhi(w.w)};
                        float ss = 0.f;
#pragma unroll
                        for (int e = 0; e < 8; ++e) ss += f[e] * f[e];
                        ss += shx(ss, 1, lane_); ss += shx(ss, 2, lane_); ss += shx(ss, 4, lane_); ss += shx(ss, 8, lane_);
                        const float r = 1.f / sqrtf(ss * (1.f / 128.f) + EPS);
                        const float* gg = gk + 8 * (cl & 15);
                        v4u o; o.x = pk2(f[0] * r * gg[0], f[1] * r * gg[1]); o.y = pk2(f[2] * r * gg[2], f[3] * r * gg[3]); o.z = pk2(f[4] * r * gg[4], f[5] * r * gg[5]); o.w = pk2(f[6] * r * gg[6], f[7] * r * gg[7]);
                        *p = o; } } }
            __syncthreads();
        }
        if (G >= 256 && bid >= 128) { PHL(); unsigned char* ws = WSP();
            convert_fp4_rows(PTR(22) + (size_t)PEER_N * DM, ws + WS_PV + (size_t)PEER_N * 1024, PEER_N, PV_SCALE4, nullptr, (bid - 128) * NWAVES + wave_, (G - 128) * NWAVES, lane_); }
        else if (G < 256) { PHL(); unsigned char* ws = WSP(); convert_fp4_rows(PTR(22) + (size_t)PEER_N * DM, ws + WS_PV + (size_t)PEER_N * 1024, PEER_N, PV_SCALE4, nullptr, gw_, NGW, lane_); }
    }
    SEAM(1);

#pragma unroll 1
    for (int l = 0; l < DEPTH; ++l) {
        const int pb = PH_BASE + PH_PER_LAYER * l;
        if (IN(pb + 0) && PHON(3)) { PHL(); unsigned char* ws = WSP();
            pg8::Gemm g{(bf16*)(ws + WS_XN8), (bf16*)(ws + WS_WIN8 + (size_t)l * DIN * DM), T, DIN, DM / 2}; pg8::StaticOrder S; S.init(T, DIN, G, bid);
            LAS float* ropel = (LAS float*)(lds + LDSCTL_OFF + 2048);
            for (int i = tid_; i < 64 * 16 * 2; i += NTHREADS) ropel[i] = ((const float*)(ws + WS_ROPE))[i];
            __syncthreads();
            pg8::EpiQKV E{(bf16*)(ws + WS_QKV), PTR(5) + (size_t)l * 128, PTR(7) + (size_t)l * 128, PTR(9) + (size_t)l * 128, ropel, (const u64_t*)(ws + WS_ROWSQ) + (size_t)(l * 3 + 0) * T, (const float*)(ws + WS_XSC), (const float*)(ws + WS_WSC) + (size_t)l * DIN};
            pg8::gemm_phase<pg8::EpiQKV, pg8::StaticOrder, true, true>(lds + RING_OFF, g, S, E, tid_);
        }
        SEAM(pb + 0);
        if (IN(pb + 1) && PHON(4)) { PHL(); unsigned char* ws = WSP();
            const float* sink = PTR(6) + (size_t)l * 12; const float* rpb = PTR(8) + (size_t)l * 8 * 15 * 31; const float* biasA = (const float*)(ws + WS_BIASA);
            const bf16* QKV = (const bf16*)(ws + WS_QKV); bf16* ATT = (bf16*)(ws + WS_ATT);
            const float* ga = PTR(5) + (size_t)l * 128; const float* gb = PTR(7) + (size_t)l * 128; const float* gc = PTR(9) + (size_t)l * 128;
            const float CaL2 = 8.f * wave_max(fabsf(ga[lane_]), lane_) * wave_max(fabsf(ga[64 + lane_]), lane_) * LOG2E;
            const float CbL2 = 8.f * wave_max(fabsf(gb[lane_]), lane_) * wave_max(fabsf(gb[64 + lane_]), lane_) * LOG2E;
            const float CcL2 = 8.f * wave_max(fabsf(gc[lane_]), lane_) * wave_max(fabsf(gc[64 + lane_]), lane_) * LOG2E;
            const int vc = (G % 8 == 0) ? (bid % 8) * (G / 8) + bid / 8 : bid;
            u64_t* mixsq = (u64_t*)(ws + WS_MIXSQ) + (size_t)l * 3 * T;
            for (int u = vc; u < BATCH * 12 * 8; u += G) attn_unit<2>(lds, QKV, ATT, mixsq + 2 * (size_t)T, u / 96, (u >> 3) % 12, u & 7, nullptr, CcL2, 0.f, tid_);
            for (int u = vc; u < BATCH * 8 * 8; u += G) attn_unit<1>(lds, QKV, ATT, mixsq + (size_t)T, u >> 6, (u >> 3) & 7, u & 7, rpb, CbL2, 0.f, tid_);
            for (int u = vc; u < BATCH * 12 * 8; u += G) { const int head = (u >> 3) % 12; attn_unit<0>(lds, QKV, ATT, mixsq, u / 96, head, u & 7, biasA, CaL2, sink[head] * LOG2E, tid_); }
        }
        SEAM(pb + 1);
        if (IN(pb + 2) && PHON(5)) { PHL(); unsigned char* ws = WSP();
            const u64_t* mixsq = (const u64_t*)(ws + WS_MIXSQ) + (size_t)l * 3 * T;
            for (int r = 4 * gw_; r < T; r += 4 * NGW) att_quant_rows<4>((const bf16*)(ws + WS_ATT), mixsq, ws + WS_ATT8, (float*)(ws + WS_XSC2), r, lane_);
        }
        SEAM(pb + 2);
        if (IN(pb + 3) && PHON(5)) { PHL(); unsigned char* ws = WSP();
            pg8::Gemm g{(bf16*)(ws + WS_ATT8), (bf16*)(ws + WS_WOUT8 + (size_t)l * DM * DM), T, DM, DM / 2}; pg8::StaticOrder S; S.init(T, DM, G, bid);
            typedef pg8::EpiResidT<true, 10> EpiX1;
            EpiX1 E{(bf16*)(ws + WS_XN), DM, (u64_t*)(ws + WS_ROWSQ) + (size_t)(l * 3 + 1) * T, (const float*)(ws + WS_XSC2), (const float*)(ws + WS_WSCO) + (size_t)l * DM, ws + WS_X8, (const u64_t*)(ws + WS_ROWSQ) + (size_t)(l * 3 + 0) * T, nullptr, nullptr, (LAS float*)(lds + LDSCTL_OFF + 2048)};
            pg8::gemm_phase<EpiX1, pg8::StaticOrder, true, true>(lds + RING_OFF, g, S, E, tid_);
        }
        SEAM(pb + 3);
        if (IN(pb + 4) && PHON(6)) { PHL(); unsigned char* ws = WSP();
            pg8::Gemm g{(bf16*)(ws + WS_X8), (bf16*)(ws + WS_WMQ8 + (size_t)l * MEMW * DM), T, MEMW, DM / 2}; pg8::StaticOrder S; S.init(T, MEMW, G, bid);
            pg8::EpiBf16Row8<10> E{(bf16*)(ws + WS_QM), MEMW, (const u64_t*)(ws + WS_ROWSQ) + (size_t)(l * 3 + 1) * T, (const u64_t*)(ws + WS_ROWSQ) + (size_t)(l * 3 + 0) * T, (const float*)(ws + WS_WSCM) + (size_t)l * MEMW};
            pg8::gemm_phase<pg8::EpiBf16Row8<10>, pg8::StaticOrder, true, true>(lds + RING_OFF, g, S, E, tid_);
            VM_WAIT(); __syncthreads();
            const bf16* kvm = (const bf16*)(ws + WS_KVM) + (size_t)l * BATCH * NMEM * 1024; const float* gq = PTR(16) + (size_t)l * 256;
            const float CmL2 = 11.313708498984761f * wave_max(fmaxf(fabsf(gq[lane_]), fabsf(gq[64 + lane_])), lane_) * wave_max(fmaxf(fabsf(gq[128 + lane_]), fabsf(gq[192 + lane_])), lane_) * LOG2E;
#pragma unroll 1
            for (int i = 0; i < 4; ++i) { pg8::Unit uu; uu.pm = 0; uu.pn = 0; if (!S.next(i, uu)) break;
                int nrep_ = (MK_REP == 1) ? 4 : 2; asm volatile("" : "+s"(nrep_));
#pragma unroll 1
                for (int hr = 0; hr < nrep_; ++hr) mem_unit(lds, (const bf16*)(ws + WS_QM), kvm, (bf16*)(ws + WS_OM), gq, uu.pm, 2 * uu.pn + (hr & 1), CmL2, tid_);
#if MK_REP == 4 || MK_REP == 5
                mem_unit<MK_REP - 3>(lds, (const bf16*)(ws + WS_QM), kvm, (bf16*)(ws + WS_QKV), gq, uu.pm, 2 * uu.pn, CmL2, tid_); mem_unit<MK_REP - 3>(lds, (const bf16*)(ws + WS_QM), kvm, (bf16*)(ws + WS_QKV), gq, uu.pm, 2 * uu.pn + 1, CmL2, tid_);
#endif
            }
        }
        SEAM(pb + 4);
        if (IN(pb + 5) && PHON(7)) { PHL(); unsigned char* ws = WSP();
            pg8::Gemm g{(bf16*)(ws + WS_OM), (bf16*)(ws + WS_WMO) + (size_t)l * DM * MEMW, T, DM, MEMW}; pg8::StaticOrder S; S.init(T, DM, G, bid);
            typedef pg8::EpiResidT<false, 6, true> EpiX2;
            EpiX2 E{(bf16*)(ws + WS_XN), DM, (u64_t*)(ws + WS_ROWSQ) + (size_t)(l * 3 + 2) * T, nullptr, nullptr, ws + WS_X8, (const u64_t*)(ws + WS_ROWSQ) + (size_t)(l * 3 + 1) * T, ws + WS_XQH, ws + WS_XQL, (LAS float*)(lds + LDSCTL_OFF + 2048)};
            pg8::gemm_phase<EpiX2, pg8::StaticOrder, true, true>(lds + RING_OFF, g, S, E, tid_);
        }
        SEAM(pb + 5);
        if (IN(pb + 6) && PHON(8)) { PHL(); unsigned char* ws = WSP();
            pg8::Gemm g{(bf16*)(ws + WS_X8), (bf16*)(ws + WS_WPQ8 + (size_t)l * DM * DM), T, DM, DM / 2}; pg8::StaticOrder S; S.init(T, DM, G, bid);
            pg8::EpiBf16Row8<6> E{(bf16*)(ws + WS_QP), DM, (const u64_t*)(ws + WS_ROWSQ) + (size_t)(l * 3 + 2) * T, (const u64_t*)(ws + WS_ROWSQ) + (size_t)(l * 3 + 1) * T, (const float*)(ws + WS_WSCP) + (size_t)l * DM};
            pg8::gemm_phase<pg8::EpiBf16Row8<6>, pg8::StaticOrder, true, true>(lds + RING_OFF, g, S, E, tid_);
            VM_WAIT(); __syncthreads();
            const bf16* pk = (const bf16*)(ws + WS_PKEYS) + (size_t)l * 8 * 2 * 128 * 128;
#pragma unroll 1
            for (int i = 0; i < 8; ++i) { pg8::Unit uu; uu.pm = 0; uu.pn = 0; if (!S.next(i, uu)) break;
                peer_select_unit((const bf16*)(ws + WS_QP), pk, (int*)(ws + WS_PIDX), (float*)(ws + WS_PGATE), uu.pm, uu.pn, wave_, lane_, lds + RING_OFF);
#if MK_REP == 2
                peer_select_unit((const bf16*)(ws + WS_QP), pk, (int*)(ws + WS_PIDX), (float*)(ws + WS_PGATE), uu.pm, uu.pn, wave_, lane_, lds + RING_OFF);
#endif
#if MK_REP == 3
#endif
            }
        }
        SEAM(pb + 6);
        if (IN(pb + 7) && PHON(9)) { PHL(); unsigned char* ws = WSP();
            peer_u_phase_i4((const unsigned*)(ws + WS_XQH), (const unsigned*)(ws + WS_XQL), ws + WS_PU + (size_t)l * PEER_N * 1024, (const int*)(ws + WS_PIDX), (int*)(ws + WS_PARTI), bid, G, wave_, lane_); }
        SEAM(pb + 7);
        if (IN(pb + 8) && PHON(10)) { PHL(); unsigned char* ws = WSP();
            peer_v_pass((bf16*)(ws + WS_XN), ws + WS_PV + (size_t)l * PEER_N * 1024, (const int*)(ws + WS_PIDX), (const float*)(ws + WS_PGATE), (const int*)(ws + WS_PARTI), (l + 1 == DEPTH) ? OUTP() : (float*)nullptr,
                        (l + 1 < DEPTH) ? (u64_t*)(ws + WS_ROWSQ) + (size_t)((l + 1) * 3 + 0) * T : (u64_t*)nullptr, (l + 1 < DEPTH) ? ws + WS_XN8 : (unsigned char*)nullptr, (float*)(ws + WS_XSC), (const u64_t*)(ws + WS_ROWSQ) + (size_t)(l * 3 + 1) * T, (const u64_t*)(ws + WS_ROWSQ) + (size_t)(l * 3 + 2) * T, (LAS float*)(lds + RING_OFF + wave_ * 1024), gw_, NGW, lane_); }
        SEAM(pb + 8);
    }
#undef IN
#undef SEAM
}

#ifndef MK_MULTI_LAUNCH
#define MK_MULTI_LAUNCH 0
#endif
extern "C" void kernel_launch(void* const* d_in, const int* in_sizes, int n_in, void* d_out, int out_size, void* d_ws, size_t ws_size, hipStream_t stream) {
    static int grid = 0;
    if (grid == 0) {
        if (n_in != 23 || out_size != T * DM || ws_size < WS_END) { fprintf(stderr, "kernel_launch: unexpected shapes (n_in %d, out %d, ws %zu)\n", n_in, out_size, ws_size); grid = -1; return; }
        int dev = 0, cus = 0, per_cu = 0;
        if (hipGetDevice(&dev) != hipSuccess || hipDeviceGetAttribute(&cus, hipDeviceAttributeMultiprocessorCount, dev) != hipSuccess) { grid = -1; return; }
        if (hipFuncSetAttribute((const void*)mega, hipFuncAttributeMaxDynamicSharedMemorySize, LDS_BYTES) != hipSuccess) { fprintf(stderr, "kernel_launch: hipFuncSetAttribute failed\n"); grid = -1; return; }
        if (hipOccupancyMaxActiveBlocksPerMultiprocessor(&per_cu, (const void*)mega, NTHREADS, LDS_BYTES) != hipSuccess || per_cu < 1) { fprintf(stderr, "kernel_launch: occupancy query says %d\n", per_cu); }
        (void)hipGetLastError();
        grid = cus;
    }
    if (grid < 0) return;
    (void)hipMemsetAsync((char*)d_ws + WS_CTL, 0, 65536, stream);
    Args a{};
    for (int i = 0; i < 23; ++i) a.in[i] = (const float*)d_in[i];
    a.out = (float*)d_out; a.ws = (unsigned char*)d_ws;
#if MK_MULTI_LAUNCH
    for (int p = 0; p < N_PHASES; ++p) { a.ph_lo = p; a.ph_hi = p + 1; a.use_bar = 0; a.pad = 0; hipLaunchKernelGGL(mega, dim3(grid), dim3(NTHREADS), LDS_BYTES, stream, a); }
#else
    a.ph_lo = 0; a.ph_hi = N_PHASES; a.use_bar = 1; a.pad = 0;
    hipLaunchKernelGGL(mega, dim3(grid), dim3(NTHREADS), LDS_BYTES, stream, a);
#endif
    const hipError_t le = hipPeekAtLastError();
    if (le != hipSuccess) fprintf(stderr, "kernel_launch: launch failed: %s\n", hipGetErrorName(le));
}
```

```cpp
#include <hip/hip_runtime.h>
#include <cstdio>
#include <cstdint>
#include <cmath>
__device__ __forceinline__ float shx(float v, int k, int lane);
typedef unsigned long long u64_t;
__device__ __forceinline__ float rowsq_rs(const u64_t* rowsq, int row) { return 1.0f / sqrtf((float)*(const __attribute__((address_space(1))) u64_t*)(rowsq + row) * (5.9604644775390625e-08f / 2048.0f) + 1e-6f); }
__device__ __forceinline__ u64_t rowsq_fx(float ss) { return (u64_t)(ss * 16777216.0f + 0.5f); }
template <int HI = 255>
__device__ __forceinline__ unsigned q8x4c(float a, float b, float c, float d, float inv) {
    unsigned w = 0;
    w = __builtin_amdgcn_cvt_pk_u8_f32(__builtin_rintf(__builtin_amdgcn_fmed3f(__builtin_fmaf(a, inv, 128.f), 1.f, (float)HI)), 0, w); w = __builtin_amdgcn_cvt_pk_u8_f32(__builtin_rintf(__builtin_amdgcn_fmed3f(__builtin_fmaf(b, inv, 128.f), 1.f, (float)HI)), 1, w);
    w = __builtin_amdgcn_cvt_pk_u8_f32(__builtin_rintf(__builtin_amdgcn_fmed3f(__builtin_fmaf(c, inv, 128.f), 1.f, (float)HI)), 2, w); w = __builtin_amdgcn_cvt_pk_u8_f32(__builtin_rintf(__builtin_amdgcn_fmed3f(__builtin_fmaf(d, inv, 128.f), 1.f, (float)HI)), 3, w);
    return w ^ 0x80808080u;
}
__device__ __forceinline__ unsigned dig_lo4(unsigned d) { return d & 0x0f0f0f0fu; }
__device__ __forceinline__ unsigned dig_hi4(unsigned d) { const unsigned t = ((d & 0x7f7f7f7fu) + 0x08080808u) ^ (d & 0x80808080u); return (t >> 4) & 0x0f0f0f0fu; }
__device__ __forceinline__ unsigned nib_pack8(unsigned a, unsigned b) { a = (a | (a >> 4)) & 0x00ff00ffu; a = (a | (a >> 8)) & 0xffffu; b = (b | (b >> 4)) & 0x00ff00ffu; b = (b | (b >> 8)) & 0xffffu; return a | (b << 16); }
namespace pg8 {
#define PG8_LAS __attribute__((address_space(3)))
#define PG8_GAS __attribute__((address_space(1)))
typedef unsigned short bf16_t;
typedef short bf16x8 __attribute__((ext_vector_type(8)));
typedef float f32x4 __attribute__((ext_vector_type(4)));
typedef unsigned u32x4 __attribute__((ext_vector_type(4)));
constexpr int BM = 256, BK = 64, HALF = 128, HTB = HALF * BK * 2  , STAGE_BYTES = 8 * HTB, NXCD = 8, WGM = 8;

__host__ __device__ __forceinline__ int lds_byte(int r, int c) { const int st = (r >> 4) * 2 + (c >> 5), rr = r & 15, cc = c & 31, ob = rr * 64 + cc * 2; return st * 1024 + (ob ^ (((ob >> 9) & 1) << 5)); }
__host__ __device__ __forceinline__ void stage_rc(int b, int& R, int& C) { const int st = b / 1024, sb = b % 1024, swz = sb ^ (((sb >> 9) & 1) << 5); R = (st >> 1) * 16 + swz / 64; C = (st & 1) * 32 + (swz % 64) / 2; }
__host__ __device__ __forceinline__ int perm32(int rho) { const int n = rho >> 4, i = rho & 15; return 8 * (i >> 2) + 4 * n + (i & 3); }

struct Unit { int pm, pn; };
struct Gemm { const bf16_t* A; const bf16_t* Bt; int M, N, K; };

struct StaticOrder {
    int nM, nN, nwg, G, c;
    __host__ __device__ __forceinline__ void init(int M, int N, int G_, int c_) { nM = M / BM; nN = N / BM; nwg = nM * nN; G = G_; c = c_; }
    __host__ __device__ __forceinline__ bool next(int i, Unit& u) const {
        const long L = (long)i * G + c; if (L >= nwg) return false;
        int wgid = (int)L; { const int q = nwg / NXCD, r = nwg % NXCD, xcd = wgid % NXCD, off = wgid / NXCD; wgid = (xcd < r ? xcd * (q + 1) : r * (q + 1) + (xcd - r) * q) + off; }
        const int nig = WGM * nN, gid = wgid / nig, fm = gid * WGM, gsz = (nM - fm) < WGM ? (nM - fm) : WGM;
        u.pm = fm + ((wgid % nig) % gsz); u.pn = (wgid % nig) / gsz; return true;
    }
    __device__ __forceinline__ void a_ready(const Unit&) const {}
    __device__ __forceinline__ void done(const Unit&) const {}
};

__device__ __forceinline__ unsigned cvt_pk_bf16(float lo, float hi) { unsigned r; asm volatile("v_cvt_pk_bf16_f32 %0, %1, %2" : "=v"(r) : "v"(lo), "v"(hi)); return r; }
typedef float f32x2 __attribute__((ext_vector_type(2)));
__device__ __forceinline__ f32x2 gelu_pk(f32x2 v) {
    const f32x2 av = __builtin_elementwise_abs(v), d = av * 0.2316418882f + 1.0f;
    f32x2 t; t.x = __builtin_amdgcn_rcpf(d.x); t.y = __builtin_amdgcn_rcpf(d.y);
    f32x2 q = t * 0.5307027145f + (-0.7265760135f); q = q * t + 0.7107068705f; q = q * t + (-0.142248368f); q = q * t + 0.127414796f; q = q * t;
    const f32x2 s = (v * v) * (-0.72134752044f);
    f32x2 e; e.x = __builtin_amdgcn_exp2f(s.x); e.y = __builtin_amdgcn_exp2f(s.y);
    const f32x2 m = v * (q * e), r = v - m;
    f32x2 o; o.x = v.x < 0.f ? m.x : r.x; o.y = v.y < 0.f ? m.y : r.y; return o;
}

template <int ACT  > struct EpiBf16 {
    static constexpr bool PERM = true, AFTER_DRAIN = false, KSCALE = false, I8 = false; static_assert(ACT == 0 || ACT == 1, "EpiBf16: ACT is 0 (none) or 1 (gelu_pk)");
    bf16_t* O; int ldc; const float* bias; int split_cols; size_t split_stride; float scale0;
    __device__ __forceinline__ void operator()(const f32x4 (&acc)[2][2][4][2], const Unit& u, int wr, int wc, int fr, int fq) const {
        const int row0 = u.pm * BM + wr * 64 + fr; int colt = u.pn * BM; bf16_t* base = O;
        float sc = 1.f; if (split_cols) { const int t = colt / split_cols; base += (size_t)t * split_stride; colt -= t * split_cols; if (t == 0) sc = scale0; }
        const int col0 = colt + wc * 32 + 8 * fq, bcol0 = u.pn * BM + wc * 32 + 8 * fq;
        f32x4 bv[2][2];
#pragma unroll
        for (int bj = 0; bj < 2; ++bj)
#pragma unroll
            for (int n = 0; n < 2; ++n) bv[bj][n] = bias ? *(const PG8_GAS f32x4*)(bias + bcol0 + bj * HALF + 4 * n) : (f32x4){0.f, 0.f, 0.f, 0.f};
#pragma unroll
        for (int ai = 0; ai < 2; ++ai)
#pragma unroll
            for (int m = 0; m < 4; ++m) { bf16_t* rowp = base + (size_t)(row0 + ai * HALF + m * 16) * ldc + col0;
#pragma unroll
                for (int bj = 0; bj < 2; ++bj) { f32x4 v0 = acc[ai][bj][m][0] + bv[bj][0], v1 = acc[ai][bj][m][1] + bv[bj][1];
                    if (ACT == 1) { f32x2 a = gelu_pk((f32x2){v0[0], v0[1]}), b = gelu_pk((f32x2){v0[2], v0[3]}), c = gelu_pk((f32x2){v1[0], v1[1]}), d = gelu_pk((f32x2){v1[2], v1[3]});
                        v0 = (f32x4){a.x, a.y, b.x, b.y}; v1 = (f32x4){c.x, c.y, d.x, d.y}; }
                    v0 = v0 * sc; v1 = v1 * sc; u32x4 w; w.x = cvt_pk_bf16(v0[0], v0[1]); w.y = cvt_pk_bf16(v0[2], v0[3]); w.z = cvt_pk_bf16(v1[0], v1[1]); w.w = cvt_pk_bf16(v1[2], v1[3]);
                    *(PG8_GAS u32x4*)(rowp + bj * HALF) = w; } }
    }
};

typedef unsigned u32x2 __attribute__((ext_vector_type(2)));
typedef int i32x4 __attribute__((ext_vector_type(4)));
struct EpiResid {
    static constexpr bool PERM = false, AFTER_DRAIN = false, KSCALE = false, I8 = false;
    bf16_t* s; int ldc; u64_t* rowsq;
    __device__ __forceinline__ void operator()(const f32x4 (&acc)[2][2][4][2], const Unit& u, int wr, int wc, int fr, int fq) const {
        const int col0 = u.pn * BM + wc * 32 + 4 * fq;
#pragma unroll
        for (int ai = 0; ai < 2; ++ai)
#pragma unroll
            for (int m = 0; m < 4; ++m) { const int row = u.pm * BM + ai * HALF + wr * 64 + m * 16 + fr; bf16_t* sp = s + (size_t)row * ldc + col0; float ss = 0.f;
                u32x2 in[2][2];
#pragma unroll
                for (int bj = 0; bj < 2; ++bj)
#pragma unroll
                    for (int n = 0; n < 2; ++n) in[bj][n] = *(const PG8_GAS u32x2*)(sp + bj * HALF + n * 16);
#pragma unroll
                for (int bj = 0; bj < 2; ++bj)
#pragma unroll
                    for (int n = 0; n < 2; ++n) { const u32x2 w0 = in[bj][n];
                        const f32x4 bs = (f32x4){__builtin_bit_cast(float, w0.x << 16), __builtin_bit_cast(float, w0.x & 0xffff0000u), __builtin_bit_cast(float, w0.y << 16), __builtin_bit_cast(float, w0.y & 0xffff0000u)};
                        const f32x4 o = bs + acc[ai][bj][m][n]; ss += (o[0] * o[0] + o[1] * o[1]) + (o[2] * o[2] + o[3] * o[3]);
                        u32x2 w; w.x = cvt_pk_bf16(o[0], o[1]); w.y = cvt_pk_bf16(o[2], o[3]); *(PG8_GAS u32x2*)(sp + bj * HALF + n * 16) = w; }
                ss += shx(ss, 16, fr + 16 * fq); ss += shx(ss, 32, fr + 16 * fq);
                if (fq == 0) (void)__hip_atomic_fetch_add((PG8_GAS u64_t*)(rowsq + row), rowsq_fx(ss), __ATOMIC_RELAXED, __HIP_MEMORY_SCOPE_AGENT); }
    }
};
struct EpiResid8 {
    static constexpr bool PERM = false, AFTER_DRAIN = false, KSCALE = false, I8 = true;
    bf16_t* s; int ldc; u64_t* rowsq; const float* xsc; const float* wsc;
    __device__ __forceinline__ void operator()(const f32x4 (&acc)[2][2][4][2], const Unit& u, int wr, int wc, int fr, int fq) const {
        const int col0 = u.pn * BM + wc * 32 + 4 * fq;
#pragma unroll
        for (int ai = 0; ai < 2; ++ai)
#pragma unroll
            for (int m = 0; m < 4; ++m) { const int row = u.pm * BM + ai * HALF + wr * 64 + m * 16 + fr; bf16_t* sp = s + (size_t)row * ldc + col0; float ss = 0.f; const float xs = *(const PG8_GAS float*)(xsc + row);
                u32x2 in[2][2];
#pragma unroll
                for (int bj = 0; bj < 2; ++bj)
#pragma unroll
                    for (int n = 0; n < 2; ++n) in[bj][n] = *(const PG8_GAS u32x2*)(sp + bj * HALF + n * 16);
#pragma unroll
                for (int bj = 0; bj < 2; ++bj)
#pragma unroll
                    for (int n = 0; n < 2; ++n) { const u32x2 w0 = in[bj][n]; const i32x4 ia = __builtin_bit_cast(i32x4, acc[ai][bj][m][n]);
                        const f32x4 bs = (f32x4){__builtin_bit_cast(float, w0.x << 16), __builtin_bit_cast(float, w0.x & 0xffff0000u), __builtin_bit_cast(float, w0.y << 16), __builtin_bit_cast(float, w0.y & 0xffff0000u)};
                        const f32x4 o = bs + (f32x4){(float)ia[0], (float)ia[1], (float)ia[2], (float)ia[3]} * *(const PG8_GAS f32x4*)(wsc + col0 + bj * HALF + n * 16) * xs; ss += (o[0] * o[0] + o[1] * o[1]) + (o[2] * o[2] + o[3] * o[3]);
                        u32x2 w; w.x = cvt_pk_bf16(o[0], o[1]); w.y = cvt_pk_bf16(o[2], o[3]); *(PG8_GAS u32x2*)(sp + bj * HALF + n * 16) = w; }
                ss += shx(ss, 16, fr + 16 * fq); ss += shx(ss, 32, fr + 16 * fq);
                if (fq == 0) (void)__hip_atomic_fetch_add((PG8_GAS u64_t*)(rowsq + row), rowsq_fx(ss), __ATOMIC_RELAXED, __HIP_MEMORY_SCOPE_AGENT); }
    }
};
template <bool I8IN, int QOUT, bool DIG = false>
struct EpiResidT {
    static constexpr bool PERM = true, AFTER_DRAIN = false, KSCALE = false, I8 = I8IN;
    bf16_t* s; int ldc; u64_t* rowsq; const float* xsc; const float* wsc; unsigned char* q8; const u64_t* rowsq_prev; unsigned char* dgh; unsigned char* dgl;
    __device__ __forceinline__ void operator()(const f32x4 (&acc)[2][2][4][2], const Unit& u, int wr, int wc, int fr, int fq) const {
        const int col0 = u.pn * BM + wc * 32 + 8 * fq, colw = u.pn * BM + wc * 32, rowb = u.pm * BM + wr * 64 + fr;
        f32x4 wv[2][2];
        if constexpr (I8IN) {
#pragma unroll
            for (int bj = 0; bj < 2; ++bj) { wv[bj][0] = *(const PG8_GAS f32x4*)(wsc + col0 + bj * HALF); wv[bj][1] = *(const PG8_GAS f32x4*)(wsc + col0 + bj * HALF + 4); } }
#pragma unroll
        for (int ai = 0; ai < 2; ++ai) {
            u32x4 in[4][2]; float xs[4], qv[4];
#pragma unroll
            for (int m = 0; m < 4; ++m) { const int row = rowb + ai * HALF + m * 16; const bf16_t* sp = s + (size_t)row * ldc + col0;
#pragma unroll
                for (int bj = 0; bj < 2; ++bj) in[m][bj] = *(const PG8_GAS u32x4*)(sp + bj * HALF);
                if constexpr (I8IN) xs[m] = *(const PG8_GAS float*)(xsc + row); else xs[m] = 1.f;
                if constexpr (QOUT > 0) qv[m] = (127.0f / QOUT) * rowsq_rs(rowsq_prev, row); else qv[m] = 0.f; }
            __builtin_amdgcn_sched_barrier(0);
#pragma unroll
            for (int m = 0; m < 4; ++m) { const int row = rowb + ai * HALF + m * 16; bf16_t* sp = s + (size_t)row * ldc + col0; float ss = 0.f; u32x2 qq[2] = {{0u, 0u}, {0u, 0u}};
#pragma unroll
                for (int bj = 0; bj < 2; ++bj) { const u32x4 w0 = in[m][bj]; f32x4 a0 = acc[ai][bj][m][0], a1 = acc[ai][bj][m][1];
                    if constexpr (I8IN) { const i32x4 i0 = __builtin_bit_cast(i32x4, a0), i1 = __builtin_bit_cast(i32x4, a1);
                        a0 = (f32x4){(float)i0[0], (float)i0[1], (float)i0[2], (float)i0[3]} * wv[bj][0] * xs[m];
                        a1 = (f32x4){(float)i1[0], (float)i1[1], (float)i1[2], (float)i1[3]} * wv[bj][1] * xs[m]; }
                    const f32x4 o0 = (f32x4){__builtin_bit_cast(float, w0.x << 16), __builtin_bit_cast(float, w0.x & 0xffff0000u), __builtin_bit_cast(float, w0.y << 16), __builtin_bit_cast(float, w0.y & 0xffff0000u)} + a0;
                    const f32x4 o1 = (f32x4){__builtin_bit_cast(float, w0.z << 16), __builtin_bit_cast(float, w0.z & 0xffff0000u), __builtin_bit_cast(float, w0.w << 16), __builtin_bit_cast(float, w0.w & 0xffff0000u)} + a1;
                    ss += ((o0[0] * o0[0] + o0[1] * o0[1]) + (o0[2] * o0[2] + o0[3] * o0[3])) + ((o1[0] * o1[0] + o1[1] * o1[1]) + (o1[2] * o1[2] + o1[3] * o1[3]));
                    u32x4 w; w.x = cvt_pk_bf16(o0[0], o0[1]); w.y = cvt_pk_bf16(o0[2], o0[3]); w.z = cvt_pk_bf16(o1[0], o1[1]); w.w = cvt_pk_bf16(o1[2], o1[3]); *(PG8_GAS u32x4*)(sp + bj * HALF) = w;
                    if constexpr (QOUT > 0) { qq[bj].x = q8x4c<DIG ? 247 : 255>(o0[0], o0[1], o0[2], o0[3], qv[m]); qq[bj].y = q8x4c<DIG ? 247 : 255>(o1[0], o1[1], o1[2], o1[3], qv[m]); } }
                if constexpr (QOUT > 0) {
                    const auto sx = __builtin_amdgcn_permlane16_swap(qq[0].x, qq[1].x, false, false), sy = __builtin_amdgcn_permlane16_swap(qq[0].y, qq[1].y, false, false);
                    *(PG8_GAS u32x4*)(q8 + (size_t)row * ldc + colw + ((fq & 1) ? HALF + 8 * (fq - 1) : 8 * fq)) = (u32x4){sx[0], sy[0], sx[1], sy[1]};
                    if constexpr (DIG) {
                        unsigned r0 = nib_pack8(dig_lo4(qq[0].x), dig_lo4(qq[0].y)), r1 = nib_pack8(dig_hi4(qq[0].x), dig_hi4(qq[0].y)), r2 = nib_pack8(dig_lo4(qq[1].x), dig_lo4(qq[1].y)), r3 = nib_pack8(dig_hi4(qq[1].x), dig_hi4(qq[1].y));
                        const auto t01 = __builtin_amdgcn_permlane16_swap(r0, r1, false, false), t23 = __builtin_amdgcn_permlane16_swap(r2, r3, false, false);
                        const auto u02 = __builtin_amdgcn_permlane32_swap(t01[0], t23[0], false, false), u13 = __builtin_amdgcn_permlane32_swap(t01[1], t23[1], false, false);
                        unsigned char* pl = (fq & 1) ? dgh : dgl;
                        *(PG8_GAS u32x4*)(pl + (size_t)row * 1024 + (colw >> 1) + (fq >> 1) * (HALF / 2)) = (u32x4){u02[0], u13[0], u02[1], u13[1]}; } }
                ss += shx(ss, 16, fr + 16 * fq); ss += shx(ss, 32, fr + 16 * fq);
                if (fq == 0) (void)__hip_atomic_fetch_add((PG8_GAS u64_t*)(rowsq + row), rowsq_fx(ss), __ATOMIC_RELAXED, __HIP_MEMORY_SCOPE_AGENT); }
            __builtin_amdgcn_sched_barrier(0);
        }
    }
};
template <int QIN>
struct EpiBf16Row8 {
    static constexpr bool PERM = true, AFTER_DRAIN = false, KSCALE = false, I8 = true;
    bf16_t* O; int ldc; const u64_t* rowsq; const u64_t* rowsq_prev; const float* wsc;
    __device__ __forceinline__ void operator()(const f32x4 (&acc)[2][2][4][2], const Unit& u, int wr, int wc, int fr, int fq) const {
        const int row0 = u.pm * BM + wr * 64 + fr, col0 = u.pn * BM + wc * 32 + 8 * fq;
        float rs[2][4]; f32x4 wv[2][2];
        {   u64_t qa[2][4], qb[2][4];
#pragma unroll
            for (int ai = 0; ai < 2; ++ai)
#pragma unroll
                for (int m = 0; m < 4; ++m) { const int row = row0 + ai * HALF + m * 16; qa[ai][m] = *(const PG8_GAS u64_t*)(rowsq + row); qb[ai][m] = *(const PG8_GAS u64_t*)(rowsq_prev + row); }
            __builtin_amdgcn_sched_barrier(0);
#pragma unroll
            for (int ai = 0; ai < 2; ++ai)
#pragma unroll
                for (int m = 0; m < 4; ++m) rs[ai][m] = (QIN / 127.0f) * sqrtf((float)qb[ai][m] * (5.9604644775390625e-08f / 2048.0f) + 1e-6f) / sqrtf((float)qa[ai][m] * (5.9604644775390625e-08f / 2048.0f) + 1e-6f); }
#pragma unroll
        for (int bj = 0; bj < 2; ++bj) { wv[bj][0] = *(const PG8_GAS f32x4*)(wsc + col0 + bj * HALF); wv[bj][1] = *(const PG8_GAS f32x4*)(wsc + col0 + bj * HALF + 4); }
        __builtin_amdgcn_sched_barrier(0);
#pragma unroll
        for (int ai = 0; ai < 2; ++ai)
#pragma unroll
            for (int m = 0; m < 4; ++m) { const int row = row0 + ai * HALF + m * 16; bf16_t* rowp = O + (size_t)row * ldc + col0;
#pragma unroll
                for (int bj = 0; bj < 2; ++bj) { const i32x4 i0 = __builtin_bit_cast(i32x4, acc[ai][bj][m][0]), i1 = __builtin_bit_cast(i32x4, acc[ai][bj][m][1]);
                    const f32x4 v0 = (f32x4){(float)i0[0], (float)i0[1], (float)i0[2], (float)i0[3]} * wv[bj][0] * rs[ai][m], v1 = (f32x4){(float)i1[0], (float)i1[1], (float)i1[2], (float)i1[3]} * wv[bj][1] * rs[ai][m];
                    u32x4 w; w.x = cvt_pk_bf16(v0[0], v0[1]); w.y = cvt_pk_bf16(v0[2], v0[3]); w.z = cvt_pk_bf16(v1[0], v1[1]); w.w = cvt_pk_bf16(v1[2], v1[3]);
                    *(PG8_GAS u32x4*)(rowp + bj * HALF) = w; } }
    }
};
struct EpiBf16Q8 {
    static constexpr bool PERM = true, AFTER_DRAIN = false, KSCALE = false, I8 = true;
    bf16_t* O; int ldc; const float* xs; const float* wsc;
    __device__ __forceinline__ void operator()(const f32x4 (&acc)[2][2][4][2], const Unit& u, int wr, int wc, int fr, int fq) const {
        const int row0 = u.pm * BM + wr * 64 + fr, col0 = u.pn * BM + wc * 32 + 8 * fq;
        float rs[2][4]; f32x4 wv[2][2];
#pragma unroll
        for (int ai = 0; ai < 2; ++ai)
#pragma unroll
            for (int m = 0; m < 4; ++m) rs[ai][m] = *(const PG8_GAS float*)(xs + row0 + ai * HALF + m * 16);
#pragma unroll
        for (int bj = 0; bj < 2; ++bj) { wv[bj][0] = *(const PG8_GAS f32x4*)(wsc + col0 + bj * HALF); wv[bj][1] = *(const PG8_GAS f32x4*)(wsc + col0 + bj * HALF + 4); }
        __builtin_amdgcn_sched_barrier(0);
#pragma unroll
        for (int ai = 0; ai < 2; ++ai)
#pragma unroll
            for (int m = 0; m < 4; ++m) { const int row = row0 + ai * HALF + m * 16; bf16_t* rowp = O + (size_t)row * ldc + col0;
#pragma unroll
                for (int bj = 0; bj < 2; ++bj) { const i32x4 i0 = __builtin_bit_cast(i32x4, acc[ai][bj][m][0]), i1 = __builtin_bit_cast(i32x4, acc[ai][bj][m][1]);
                    const f32x4 v0 = (f32x4){(float)i0[0], (float)i0[1], (float)i0[2], (float)i0[3]} * wv[bj][0] * rs[ai][m], v1 = (f32x4){(float)i1[0], (float)i1[1], (float)i1[2], (float)i1[3]} * wv[bj][1] * rs[ai][m];
                    u32x4 w; w.x = cvt_pk_bf16(v0[0], v0[1]); w.y = cvt_pk_bf16(v0[2], v0[3]); w.z = cvt_pk_bf16(v1[0], v1[1]); w.w = cvt_pk_bf16(v1[2], v1[3]);
                    *(PG8_GAS u32x4*)(rowp + bj * HALF) = w; } }
    }
};
struct EpiResidMix {
    static constexpr bool PERM = false, AFTER_DRAIN = false, KSCALE = true, I8 = false; static constexpr int KS0 = 12, KS1 = 20;
    bf16_t* s; int ldc; u64_t* rowsq; const PG8_LAS float* ftab; const PG8_LAS int* pmtab;
    __device__ __forceinline__ int slot(int pm) const { return pmtab[0] == pm ? 0 : (pmtab[1] == pm ? 1 : (pmtab[2] == pm ? 2 : 3)); }
    __device__ __forceinline__ void kscale(f32x4 (&acc)[2][2][4][2], const Unit& u, int which, int wr, int fr) const {
        const PG8_LAS float* ft = ftab + which * 1024 + slot(u.pm) * 256;
#pragma unroll
        for (int ai = 0; ai < 2; ++ai)
#pragma unroll
            for (int m = 0; m < 4; ++m) { const float f = ft[ai * HALF + wr * 64 + m * 16 + fr];
#pragma unroll
                for (int bj = 0; bj < 2; ++bj)
#pragma unroll
                    for (int n = 0; n < 2; ++n) acc[ai][bj][m][n] = acc[ai][bj][m][n] * f; }
    }
    __device__ __forceinline__ void operator()(const f32x4 (&acc)[2][2][4][2], const Unit& u, int wr, int wc, int fr, int fq) const {
        const int col0 = u.pn * BM + wc * 32 + 4 * fq;
#pragma unroll
        for (int ai = 0; ai < 2; ++ai)
#pragma unroll
            for (int m = 0; m < 4; ++m) { const int row = u.pm * BM + ai * HALF + wr * 64 + m * 16 + fr; bf16_t* sp = s + (size_t)row * ldc + col0; float ss = 0.f; const float rc = ftab[2048 + slot(u.pm) * 256 + ai * HALF + wr * 64 + m * 16 + fr];
                u32x2 in[2][2];
#pragma unroll
                for (int bj = 0; bj < 2; ++bj)
#pragma unroll
                    for (int n = 0; n < 2; ++n) in[bj][n] = *(const PG8_GAS u32x2*)(sp + bj * HALF + n * 16);
#pragma unroll
                for (int bj = 0; bj < 2; ++bj)
#pragma unroll
                    for (int n = 0; n < 2; ++n) { const u32x2 w0 = in[bj][n];
                        const f32x4 bs = (f32x4){__builtin_bit_cast(float, w0.x << 16), __builtin_bit_cast(float, w0.x & 0xffff0000u), __builtin_bit_cast(float, w0.y << 16), __builtin_bit_cast(float, w0.y & 0xffff0000u)};
                        const f32x4 o = bs + acc[ai][bj][m][n] * rc; ss += (o[0] * o[0] + o[1] * o[1]) + (o[2] * o[2] + o[3] * o[3]);
                        u32x2 w; w.x = cvt_pk_bf16(o[0], o[1]); w.y = cvt_pk_bf16(o[2], o[3]); *(PG8_GAS u32x2*)(sp + bj * HALF + n * 16) = w; }
                ss += shx(ss, 16, fr + 16 * fq); ss += shx(ss, 32, fr + 16 * fq);
                if (fq == 0) (void)__hip_atomic_fetch_add((PG8_GAS u64_t*)(rowsq + row), rowsq_fx(ss), __ATOMIC_RELAXED, __HIP_MEMORY_SCOPE_AGENT); }
    }
};
struct EpiBf16Row {
    static constexpr bool PERM = true, AFTER_DRAIN = false, KSCALE = false, I8 = false;
    bf16_t* O; int ldc; const u64_t* rowsq;
    __device__ __forceinline__ void operator()(const f32x4 (&acc)[2][2][4][2], const Unit& u, int wr, int wc, int fr, int fq) const {
        const int row0 = u.pm * BM + wr * 64 + fr, col0 = u.pn * BM + wc * 32 + 8 * fq;
#pragma unroll
        for (int ai = 0; ai < 2; ++ai)
#pragma unroll
            for (int m = 0; m < 4; ++m) { const int row = row0 + ai * HALF + m * 16; const float rs = rowsq_rs(rowsq, row); bf16_t* rowp = O + (size_t)row * ldc + col0;
#pragma unroll
                for (int bj = 0; bj < 2; ++bj) { const f32x4 v0 = acc[ai][bj][m][0] * rs, v1 = acc[ai][bj][m][1] * rs; u32x4 w; w.x = cvt_pk_bf16(v0[0], v0[1]); w.y = cvt_pk_bf16(v0[2], v0[3]); w.z = cvt_pk_bf16(v1[0], v1[1]); w.w = cvt_pk_bf16(v1[2], v1[3]);
                    *(PG8_GAS u32x4*)(rowp + bj * HALF) = w; } }
    }
};
struct EpiQKV {
    static constexpr bool PERM = false, AFTER_DRAIN = false, KSCALE = false, I8 = true;
    bf16_t* O; const float* ga; const float* gb; const float* gc; const PG8_LAS float* rope; const u64_t* rowsq; const float* xsc; const float* wsc;
    __device__ __forceinline__ void operator()(const f32x4 (&acc)[2][2][4][2], const Unit& u, int wr, int wc, int fr, int fq) const {
        const int hg = u.pn * 4 + wc;
        const float* g = nullptr; bool isq = false, dorope = false;
        if (hg < 12) { g = ga; isq = true; } else if (hg < 16) { g = ga + 64; } else if (hg < 20) { }
        else if (hg < 28) { g = gb; isq = true; } else if (hg < 36) { g = gb + 64; } else if (hg < 44) { }
        else if (hg < 56) { g = gc; isq = true; dorope = true; } else if (hg < 60) { g = gc + 64; dorope = true; }
        const float qs = isq ? 0.18033688011112042f : 1.0f;
        float rsxa[2][4]; f32x4 wv[2][2], gv[2][2];
#pragma unroll
        for (int ai = 0; ai < 2; ++ai)
#pragma unroll
            for (int m = 0; m < 4; ++m) { const int row = u.pm * BM + ai * HALF + wr * 64 + m * 16 + fr; rsxa[ai][m] = *(const PG8_GAS float*)(xsc + row); }
#pragma unroll
        for (int bj = 0; bj < 2; ++bj)
#pragma unroll
            for (int n = 0; n < 2; ++n) { wv[bj][n] = *(const PG8_GAS f32x4*)(wsc + hg * 64 + 32 * bj + 16 * n + 4 * fq); gv[bj][n] = g ? *(const PG8_GAS f32x4*)(g + 32 * bj + 16 * n + 4 * fq) : (f32x4){1.f, 1.f, 1.f, 1.f}; }
        __builtin_amdgcn_sched_barrier(0);
#pragma unroll
        for (int ai = 0; ai < 2; ++ai)
#pragma unroll
            for (int m = 0; m < 4; ++m) {
                const int row = u.pm * BM + ai * HALF + wr * 64 + m * 16 + fr;
                f32x4 v[2][2];
                const float rsx = rsxa[ai][m];
#pragma unroll
                for (int bj = 0; bj < 2; ++bj)
#pragma unroll
                    for (int n = 0; n < 2; ++n) { const i32x4 ia = __builtin_bit_cast(i32x4, acc[ai][bj][m][n]);
                        v[bj][n] = (f32x4){(float)ia[0], (float)ia[1], (float)ia[2], (float)ia[3]} * wv[bj][n] * rsx; }
                if (g) {
                    float ss = 0.f;
#pragma unroll
                    for (int bj = 0; bj < 2; ++bj)
#pragma unroll
                        for (int n = 0; n < 2; ++n) { const f32x4 x = v[bj][n]; ss += (x[0] * x[0] + x[1] * x[1]) + (x[2] * x[2] + x[3] * x[3]); }
                    ss += shx(ss, 16, fr + 16 * fq); ss += shx(ss, 32, fr + 16 * fq);
                    const float r = qs / sqrtf(ss * (1.0f / 64.0f) + 1e-6f);
#pragma unroll
                    for (int bj = 0; bj < 2; ++bj)
#pragma unroll
                        for (int n = 0; n < 2; ++n) v[bj][n] = v[bj][n] * gv[bj][n] * r;
                }
                if (dorope) {
                    const int t = row & 2047, pr = t >> 6, pc = t & 63;
#pragma unroll
                    for (int bj = 0; bj < 2; ++bj) {
                        const int pos = bj ? pc : pr;
                        const PG8_LAS float* rp = rope + (pos * 16 + 4 * fq) * 2;
                        const f32x4 c01 = *(const PG8_LAS f32x4*)rp, c23 = *(const PG8_LAS f32x4*)(rp + 4);
                        const f32x4 cs = (f32x4){c01[0], c01[2], c23[0], c23[2]}, sn = (f32x4){c01[1], c01[3], c23[1], c23[3]};
                        const f32x4 x1 = v[bj][0], x2 = v[bj][1];
                        v[bj][0] = x1 * cs - x2 * sn; v[bj][1] = x1 * sn + x2 * cs;
                    }
                }
                bf16_t* rowp = O + (size_t)row * 4096 + hg * 64 + ((fq & 1) ? 16 + 4 * (fq - 1) : 4 * fq);
#pragma unroll
                for (int bj = 0; bj < 2; ++bj) {
                    const unsigned ax = cvt_pk_bf16(v[bj][0][0], v[bj][0][1]), ay = cvt_pk_bf16(v[bj][0][2], v[bj][0][3]), bx = cvt_pk_bf16(v[bj][1][0], v[bj][1][1]), by = cvt_pk_bf16(v[bj][1][2], v[bj][1][3]);
                    const auto sx = __builtin_amdgcn_permlane16_swap(ax, bx, false, false), sy = __builtin_amdgcn_permlane16_swap(ay, by, false, false);
                    *(PG8_GAS u32x4*)(rowp + 32 * bj) = (u32x4){sx[0], sy[0], sx[1], sy[1]}; }
                asm volatile("" ::: "memory");
            }
    }
};
template <bool I8> __device__ __forceinline__ f32x4 mma16(const bf16x8 b, const bf16x8 a, const f32x4 c) {
    if constexpr (I8) return __builtin_bit_cast(f32x4, __builtin_amdgcn_mfma_i32_16x16x64_i8(__builtin_bit_cast(i32x4, b), __builtin_bit_cast(i32x4, a), __builtin_bit_cast(i32x4, c), 0, 0, 0));
    else return __builtin_amdgcn_mfma_f32_16x16x32_bf16(b, a, c, 0, 0, 0);
}
template <class Epi, class Sched, bool ALIGN_EPI = false, bool SP2 = false>
__device__ __forceinline__ void gemm_phase(PG8_LAS unsigned char* lds, const Gemm g, const Sched& S, const Epi& E, const int tid) {
    const int wid = __builtin_amdgcn_readfirstlane(tid >> 6), lane = tid & 63, wr = wid >> 2, wc = wid & 3, fr = lane & 15, fq = lane >> 4;
    const int K = g.K, nt = K / BK;
    unsigned voffA[2], voffB[2];
#pragma unroll
    for (int i = 0; i < 2; ++i) { int R, C; stage_rc(tid * 16 + i * 8192, R, C); const int Rb = Epi::PERM ? ((R & ~31) + perm32(R & 31)) : R;
        voffA[i] = (unsigned)(R * K + C) * 2u; voffB[i] = (unsigned)(Rb * K + C) * 2u; }
    const size_t kstep = (size_t)(BK * 2);
    const size_t hstep = (size_t)HALF * K * 2;
    const size_t tstep = 2 * hstep;
    const unsigned ldsw = (unsigned)wid * 1024u;
    const int aoff = lds_byte(wr * 64 + fr, fq * 8), boff = lds_byte(wc * 32 + fr, fq * 8);
#define PG8_SA(b, h) (((b) * 2 + (h)) * HTB)
#define PG8_SB(b, h) ((4 + (b) * 2 + (h)) * HTB)
#define PG8_STAGE(bufoff, gbase, voff) do { _Pragma("unroll") for (int _i = 0; _i < 2; ++_i) \
        __builtin_amdgcn_global_load_lds((const unsigned*)((const char*)(gbase) + (voff)[_i]), (PG8_LAS unsigned*)(lds + (bufoff) + ldsw + _i * 8192), 16, 0, 0); } while (0)
#define PG8_LDA(dst, b, h) do { _Pragma("unroll") for (int m = 0; m < 4; ++m) _Pragma("unroll") for (int k = 0; k < 2; ++k) dst[m][k] = *(const PG8_LAS bf16x8*)(lds + PG8_SA(b, h) + aoff + m * 2048 + k * 1024); } while (0)
#define PG8_LDB(dst, b, h) do { _Pragma("unroll") for (int n = 0; n < 2; ++n) _Pragma("unroll") for (int k = 0; k < 2; ++k) dst[n][k] = *(const PG8_LAS bf16x8*)(lds + PG8_SB(b, h) + boff + n * 2048 + k * 1024); } while (0)
#define PG8_MMA(ai, bj, At, Bt) do { __builtin_amdgcn_s_setprio(1); _Pragma("unroll") for (int m = 0; m < 4; ++m) _Pragma("unroll") for (int n = 0; n < 2; ++n) _Pragma("unroll") for (int k = 0; k < 2; ++k) \
        acc[ai][bj][m][n] = mma16<Epi::I8>(Bt[n][k], At[m][k], acc[ai][bj][m][n]); __builtin_amdgcn_s_setprio(0); } while (0)
#define PG8_WAIT_V(n) asm volatile("s_waitcnt vmcnt(" #n ")" ::: "memory")
#define PG8_WAIT_L(n) asm volatile("s_waitcnt lgkmcnt(" #n ")" ::: "memory")
#define PG8_BAR __builtin_amdgcn_s_barrier()
#define PG8_SCHED __builtin_amdgcn_sched_barrier(0)
    Unit cur, nxt; int ui = 0;
    if (!S.next(0, cur)) return;
    f32x4 acc[2][2][4][2];
#pragma unroll
    for (int a = 0; a < 2; ++a)
#pragma unroll
        for (int b = 0; b < 2; ++b)
#pragma unroll
            for (int m = 0; m < 4; ++m)
#pragma unroll
                for (int n = 0; n < 2; ++n) acc[a][b][m][n] = (f32x4){0.f, 0.f, 0.f, 0.f};
    bf16x8 At[4][2], B0[2][2], B1[2][2];
    const char* cA = (const char*)g.A + (size_t)cur.pm * tstep; const char* cB = (const char*)g.Bt + (size_t)cur.pn * tstep;
    S.a_ready(cur);
    if constexpr (SP2) {
        PG8_STAGE(PG8_SB(0, 0), cB, voffB); PG8_STAGE(PG8_SB(0, 1), cB + hstep, voffB); PG8_STAGE(PG8_SA(0, 0), cA, voffA); PG8_STAGE(PG8_SA(0, 1), cA + hstep, voffA);
        if (wr == 1) PG8_BAR;
        PG8_WAIT_V(2); PG8_BAR;
        PG8_STAGE(PG8_SB(1, 0), cB + kstep, voffB); PG8_STAGE(PG8_SA(1, 0), cA + kstep, voffA); PG8_STAGE(PG8_SB(1, 1), cB + hstep + kstep, voffB);
        PG8_WAIT_V(6); PG8_BAR;
    } else {
        PG8_STAGE(PG8_SB(0, 0), cB, voffB); PG8_STAGE(PG8_SA(0, 0), cA, voffA); PG8_STAGE(PG8_SB(0, 1), cB + hstep, voffB); PG8_STAGE(PG8_SA(0, 1), cA + hstep, voffA);
        if (wr == 1) PG8_BAR;
        PG8_WAIT_V(4); PG8_BAR;
        PG8_STAGE(PG8_SB(1, 0), cB + kstep, voffB); PG8_STAGE(PG8_SA(1, 0), cA + kstep, voffA); PG8_STAGE(PG8_SB(1, 1), cB + hstep + kstep, voffB);
        PG8_WAIT_V(6); PG8_BAR;
    }
    for (;;) {
        const bool has_next = S.next(ui + 1, nxt);
        const char* nA = has_next ? (const char*)g.A + (size_t)nxt.pm * tstep : cA; const char* nB = has_next ? (const char*)g.Bt + (size_t)nxt.pn * tstep : cB;
        for (int t = 0; t < nt; t += 2) {
            if constexpr (Epi::KSCALE) { if (t == Epi::KS0 || t == Epi::KS1) E.kscale(acc, cur, t == Epi::KS1 ? 1 : 0, wr, fr); }
            const bool last = (t == nt - 2);
            const char* a1 = cA + (size_t)(t + 1) * kstep;
            const char* a2 = last ? nA : cA + (size_t)(t + 2) * kstep; const char* b2 = last ? nB : cB + (size_t)(t + 2) * kstep;
            const char* a3 = a2 + kstep; const char* b3 = b2 + kstep;
            if (last && has_next) S.a_ready(nxt);
            if constexpr (SP2) {
            PG8_LDB(B0, 0, 0); PG8_LDB(B1, 0, 1); PG8_SCHED; PG8_LDA(At, 0, 0); PG8_STAGE(PG8_SA(1, 1), a1 + hstep, voffA);
            PG8_WAIT_V(8); PG8_WAIT_L(0); PG8_BAR; PG8_MMA(0, 0, At, B0); PG8_MMA(0, 1, At, B1); PG8_BAR; PG8_SCHED;
            PG8_LDA(At, 0, 1); PG8_STAGE(PG8_SB(0, 0), b2, voffB); PG8_STAGE(PG8_SB(0, 1), b2 + hstep, voffB); PG8_STAGE(PG8_SA(0, 0), a2, voffA);
            PG8_WAIT_V(8); PG8_WAIT_L(0); PG8_BAR; PG8_MMA(1, 0, At, B0); PG8_MMA(1, 1, At, B1); PG8_BAR; PG8_SCHED;
            PG8_LDB(B0, 1, 0); PG8_LDB(B1, 1, 1); PG8_SCHED; PG8_LDA(At, 1, 0); PG8_STAGE(PG8_SA(0, 1), a2 + hstep, voffA);
            PG8_WAIT_V(8); PG8_WAIT_L(0); PG8_BAR; PG8_MMA(0, 0, At, B0); PG8_MMA(0, 1, At, B1); PG8_BAR; PG8_SCHED;
            PG8_LDA(At, 1, 1); PG8_STAGE(PG8_SB(1, 0), b3, voffB); PG8_STAGE(PG8_SB(1, 1), b3 + hstep, voffB); PG8_STAGE(PG8_SA(1, 0), a3, voffA);
            PG8_WAIT_V(8); PG8_WAIT_L(0); PG8_BAR; PG8_MMA(1, 0, At, B0); PG8_MMA(1, 1, At, B1); PG8_BAR; PG8_SCHED;
            } else {
            PG8_LDB(B0, 0, 0); PG8_SCHED; PG8_LDA(At, 0, 0); PG8_STAGE(PG8_SA(1, 1), a1 + hstep, voffA);
            PG8_WAIT_L(8); PG8_BAR; PG8_WAIT_L(0); PG8_MMA(0, 0, At, B0); PG8_BAR; PG8_SCHED;
            PG8_LDB(B1, 0, 1); PG8_STAGE(PG8_SB(0, 0), b2, voffB);
            PG8_BAR; PG8_WAIT_L(0); PG8_MMA(0, 1, At, B1); PG8_BAR;
            PG8_LDA(At, 0, 1); PG8_STAGE(PG8_SA(0, 0), a2, voffA);
            PG8_BAR; PG8_WAIT_L(0); PG8_MMA(1, 0, At, B0); PG8_BAR; PG8_SCHED;
            PG8_STAGE(PG8_SB(0, 1), b2 + hstep, voffB);
            PG8_WAIT_V(6); PG8_BAR; PG8_MMA(1, 1, At, B1); PG8_BAR;
            PG8_LDB(B0, 1, 0); PG8_SCHED; PG8_LDA(At, 1, 0); PG8_STAGE(PG8_SA(0, 1), a2 + hstep, voffA);
            PG8_WAIT_L(8); PG8_BAR; PG8_WAIT_L(0); PG8_MMA(0, 0, At, B0); PG8_BAR; PG8_SCHED;
            PG8_LDB(B1, 1, 1); PG8_STAGE(PG8_SB(1, 0), b3, voffB);
            PG8_BAR; PG8_WAIT_L(0); PG8_MMA(0, 1, At, B1); PG8_BAR;
            PG8_LDA(At, 1, 1); PG8_STAGE(PG8_SA(1, 0), a3, voffA);
            PG8_BAR; PG8_WAIT_L(0); PG8_MMA(1, 0, At, B0); PG8_BAR; PG8_SCHED;
            PG8_STAGE(PG8_SB(1, 1), b3 + hstep, voffB);
            PG8_WAIT_V(6); PG8_BAR; PG8_MMA(1, 1, At, B1); PG8_BAR;
            }
        }
        if constexpr (ALIGN_EPI) { if (wr == 0) PG8_BAR; }
        if constexpr (!Epi::AFTER_DRAIN) { E(acc, cur, wr, wc, fr, fq); S.done(cur); }
        if (!has_next) break;
#pragma unroll
        for (int a = 0; a < 2; ++a)
#pragma unroll
            for (int b = 0; b < 2; ++b)
#pragma unroll
                for (int m = 0; m < 4; ++m)
#pragma unroll
                    for (int n = 0; n < 2; ++n) acc[a][b][m][n] = (f32x4){0.f, 0.f, 0.f, 0.f};
        cur = nxt; cA = nA; cB = nB; ++ui;
        if constexpr (ALIGN_EPI) { if (wr == 1) PG8_BAR; }
    }
    PG8_WAIT_V(0);
    if constexpr (!ALIGN_EPI) { if (wr == 0) PG8_BAR; }
    PG8_BAR;
    if constexpr (Epi::AFTER_DRAIN) { E.fused(acc, cur, wr, wc, fr, fq, lds, wid, lane); S.done(cur); }
#undef PG8_SA
#undef PG8_SB
#undef PG8_STAGE
#undef PG8_LDA
#undef PG8_LDB
#undef PG8_MMA
#undef PG8_WAIT_V
#undef PG8_WAIT_L
#undef PG8_BAR
#undef PG8_SCHED
}
}

constexpr int BATCH = 16, SEQ = 2048, DM = 2048, T = BATCH * SEQ, DEPTH = 2;
constexpr int NMEM = 256, DIN = 4096, MEMW = 512;
constexpr int PEER_H = 8, PEER_N = 16384;
constexpr int NWAVES = 8, NTHREADS = NWAVES * 64;
constexpr float EPS = 1e-6f;
constexpr int QA = 0, KA = 768, VA = 1024, QB = 1280, KB = 1792, VB = 2304, QC = 2816, KC = 3584, VC = 3840;
constexpr int OA = 0, OB = 768, OC = 1280;

constexpr size_t MiB = 1u << 20;
constexpr size_t WS_CTL = 0, CTL_ZERO_BYTES = 2 * MiB;
constexpr size_t WS_ROWSQ = 256 * 1024;
constexpr size_t WS_ROPE = 83 * MiB, WS_BIASA = 83 * MiB + 16384;
constexpr size_t WS_WIN = 2 * MiB, WS_WOUT = 34 * MiB, WS_WMQ = 50 * MiB, WS_WMKV = 54 * MiB, WS_WMO = 62 * MiB, WS_WPQ = 66 * MiB, WS_PKEYS = 82 * MiB;
constexpr size_t WS_MEMN = 84 * MiB, WS_KVM = 116 * MiB, WS_PU = 132 * MiB, WS_PV = 260 * MiB, WS_XN = 388 * MiB, WS_QKV = 516 * MiB, WS_ATT = 772 * MiB;
constexpr size_t WS_QM = 900 * MiB, WS_OM = 932 * MiB, WS_MIXSQ = 964 * MiB, MIXSQ_BYTES = 2 * MiB, WS_WIN8 = 966 * MiB, WS_WSC = 982 * MiB, WS_XSC = 982 * MiB + 65536, WS_XSC2 = 982 * MiB + 196608, WS_WSCO = 982 * MiB + 327680, WS_WSCP = 982 * MiB + 344064, WS_WSCM = 982 * MiB + 360448,
                 WS_WOUT8 = 984 * MiB, WS_WPQ8 = 992 * MiB, WS_WMQ8 = 1000 * MiB, WS_END = 1002 * MiB;
constexpr size_t WS_QP = WS_QKV, WS_PIDX = WS_QKV + 128 * MiB, WS_PGATE = WS_QKV + 144 * MiB, WS_PARTI = WS_QKV + 160 * MiB;
constexpr size_t WS_XQH = 836 * MiB, WS_XQL = 868 * MiB;
constexpr size_t WS_XQH_OLD = 900 * MiB, WS_XQL_OLD = 932 * MiB;
constexpr size_t WS_ATT8 = 900 * MiB;
constexpr size_t WS_WSCKV = 982 * MiB + 368640, WS_MEMS = 982 * MiB + 376832;
constexpr size_t WS_X8 = 772 * MiB;
constexpr size_t WS_XN8 = 836 * MiB;
constexpr int CW_BAR = 4096;

constexpr int RING_OFF = 0, RING_BYTES = 131072;
constexpr int LDSCTL_OFF = RING_BYTES, MISC_OFF = LDSCTL_OFF + 320;
constexpr int LDS_BYTES = 147456;

#define GAS __attribute__((address_space(1)))
#define LAS __attribute__((address_space(3)))
typedef unsigned short bf16;
typedef unsigned v4u __attribute__((ext_vector_type(4)));
typedef unsigned v2u __attribute__((ext_vector_type(2)));
typedef float f32x4 __attribute__((ext_vector_type(4)));
typedef float f32x16 __attribute__((ext_vector_type(16)));
typedef short bf16x8 __attribute__((ext_vector_type(8)));
typedef GAS unsigned gu32;
#define LDS_WAIT() asm volatile("s_waitcnt lgkmcnt(0)" ::: "memory")
#define VM_WAIT() asm volatile("s_waitcnt vmcnt(0)" ::: "memory")
__device__ __forceinline__ unsigned f2bf(float f) { unsigned u = __builtin_bit_cast(unsigned, f); return (u + 0x7fffu + ((u >> 16) & 1u)) >> 16; }
__device__ __forceinline__ unsigned pk2(float lo, float hi) { return f2bf(lo) | (f2bf(hi) << 16); }
__device__ __forceinline__ float bflo(unsigned w) { return __builtin_bit_cast(float, w << 16); }
__device__ __forceinline__ float bfhi(unsigned w) { return __builtin_bit_cast(float, w & 0xffff0000u); }

__device__ __forceinline__ float shx(float v, int k, int lane) { return __builtin_bit_cast(float, __builtin_amdgcn_ds_bpermute((lane ^ k) << 2, __builtin_bit_cast(int, v))); }
#define XB_TMO      128
#define XB_XCNT(j)  (256  + 64 * (j))
#define XB_XSUB(j)  (1280 + 64 * (j))
#define XB_XGEN(j)  (2304 + 64 * (j))
#define XB_TOP      3328
#define XB_TOPGEN   3392
#define XCD_BAR_WORDS 3456
#define XB_SPIN_CAP (1u << 18)

__device__ __forceinline__ unsigned xb_ld(unsigned* p)              { return __hip_atomic_load(p, __ATOMIC_RELAXED, __HIP_MEMORY_SCOPE_AGENT); }
__device__ __forceinline__ unsigned xb_add(unsigned* p, unsigned v) { return __hip_atomic_fetch_add(p, v, __ATOMIC_RELAXED, __HIP_MEMORY_SCOPE_AGENT); }
__device__ __forceinline__ unsigned xb_xcc_id() { return (unsigned)__builtin_amdgcn_s_getreg((3 << 11) | 20) & 0xFu; }
#define XB_SPIN(cond, bar) do { unsigned _sp = 0; while (cond) { __builtin_amdgcn_s_sleep(1); \
    if ((++_sp & 255u) == 0u) { if (xb_ld(&(bar)[XB_TMO])) break; if (_sp > XB_SPIN_CAP) { atomicAdd(&(bar)[XB_TMO], 1u); break; } } } } while (0)

struct XcdBarrier {
    unsigned* bar; unsigned x;
    volatile LAS unsigned* st;
};

__device__ __forceinline__ XcdBarrier xcd_barrier_post(unsigned* bar, volatile LAS unsigned* st) {
    XcdBarrier b; b.bar = bar; b.x = xb_xcc_id(); b.st = st;
    if (threadIdx.x == 0) (void)xb_add(&bar[XB_XCNT(b.x)], 1u);
    return b;
}
__device__ __forceinline__ void xcd_barrier_complete(unsigned* bar, unsigned x, unsigned& nloc, unsigned& nx) {
    const unsigned G = gridDim.x * gridDim.y * gridDim.z;
    unsigned sum, cnt, mine, sp = 0u;
    for (;;) {
        sum = 0u; cnt = 0u; mine = 0u;
#pragma unroll
        for (unsigned j = 0; j < 16; ++j) { const unsigned c = xb_ld(&bar[XB_XCNT(j)]); sum += c; cnt += (c > 0u) ? 1u : 0u; mine = (j == x) ? c : mine; }
        if (sum == G) break;
        __builtin_amdgcn_s_sleep(1);
        if ((++sp & 255u) == 0u) { if (xb_ld(&bar[XB_TMO])) break; if (sp > XB_SPIN_CAP) { atomicAdd(&bar[XB_TMO], 1u); break; } }
    }
    nloc = mine > 0u ? mine : 1u; nx = cnt > 0u ? cnt : 1u;
}

__device__ __forceinline__ void xcd_barrier(const XcdBarrier& b) {
    asm volatile("s_waitcnt vmcnt(0)" ::: "memory");
    __syncthreads();
    if (threadIdx.x == 0) {
        unsigned* bar = b.bar;
        __builtin_amdgcn_s_waitcnt(0);
        unsigned nloc = b.st[0], nx = b.st[1];
        if (nloc == 0u) { xcd_barrier_complete(bar, b.x, nloc, nx); b.st[0] = nloc; b.st[1] = nx; }
        const unsigned old = xb_add(&bar[XB_XSUB(b.x)], 1u);
        const unsigned gen = old / nloc;
        if (old + 1u == (gen + 1u) * nloc) {
            __builtin_amdgcn_fence(__ATOMIC_RELEASE, "agent");
            asm volatile("s_waitcnt vmcnt(0)" ::: "memory");
            const unsigned og = xb_add(&bar[XB_TOP], 1u);
            const unsigned tg = og / nx;
            if (og + 1u == (tg + 1u) * nx) xb_add(&bar[XB_TOPGEN], 1u);
            else XB_SPIN(xb_ld(&bar[XB_TOPGEN]) == tg, bar);
            __builtin_amdgcn_fence(__ATOMIC_ACQUIRE, "agent");
            xb_add(&bar[XB_XGEN(b.x)], 1u);
            asm volatile("s_waitcnt vmcnt(0)" ::: "memory");
        } else {
            XB_SPIN(xb_ld(&bar[XB_XGEN(b.x)]) == gen, bar);
            __builtin_amdgcn_fence(__ATOMIC_ACQUIRE, "agent");
            asm volatile("s_waitcnt vmcnt(0)" ::: "memory");
        }
    }
    __syncthreads();
}

__device__ __forceinline__ float wave_sum(float v, int lane) {
#pragma unroll
    for (int o = 1; o < 64; o <<= 1) v += shx(v, o, lane);
    return v;
}
__device__ __forceinline__ void* ldptr(LAS unsigned char* lds, int i) {
    const unsigned long long v = ((const LAS unsigned long long*)(lds + LDSCTL_OFF + 1024))[i];
    const unsigned lo = __builtin_amdgcn_readfirstlane((unsigned)v), hi = __builtin_amdgcn_readfirstlane((unsigned)(v >> 32));
    return (void*)(((unsigned long long)hi << 32) | lo);
}
struct OffsetOrder {
    pg8::StaticOrder S;
    __device__ __forceinline__ void init(int M, int N, int G, int c, int off) { S.init(M, N, G, (c + G - off % G) % G); }
    __device__ __forceinline__ bool next(int i, pg8::Unit& u) const { return S.next(i, u); }
    __device__ __forceinline__ void a_ready(const pg8::Unit&) const {}
    __device__ __forceinline__ void done(const pg8::Unit&) const {}
};

template <bool PERMQKV>
__device__ __forceinline__ void transpose_item(const float* W, int K, int N, bf16* WT, LAS float* scr, int item, int lane, const float* gk = nullptr) {
    const int nblk = N / 32, kb = item / nblk, nb = item % nblk, k0 = 64 * kb, n0 = 32 * nb;
    int d0 = n0;
    if (PERMQKV) { const int within = n0 & 255; d0 = (n0 & ~255) + 128 * ((within >> 5) & 1) + 32 * (within >> 6); }
#pragma unroll
    for (int i = 0; i < 8; ++i) { const int kk = 8 * i + (lane >> 3), nn = 4 * (lane & 7);
        const f32x4 w4 = *(const GAS f32x4*)(W + (size_t)(k0 + kk) * N + n0 + nn) * (gk ? gk[k0 + kk] : 1.f);
        scr[kk * 33 + nn] = w4[0]; scr[kk * 33 + nn + 1] = w4[1]; scr[kk * 33 + nn + 2] = w4[2]; scr[kk * 33 + nn + 3] = w4[3]; }
    LDS_WAIT(); asm volatile("" ::: "memory");
    const int c = lane & 7;
#pragma unroll
    for (int j = 0; j < 4; ++j) { const int n = (lane >> 3) + 8 * j; const LAS float* s = scr + (8 * c) * 33 + n;
        v4u o; o.x = pk2(s[0 * 33], s[1 * 33]); o.y = pk2(s[2 * 33], s[3 * 33]); o.z = pk2(s[4 * 33], s[5 * 33]); o.w = pk2(s[6 * 33], s[7 * 33]);
        *(GAS v4u*)(WT + (size_t)(d0 + n) * K + k0 + 8 * c) = o; }
    LDS_WAIT(); asm volatile("" ::: "memory");
}
__device__ __forceinline__ void convert_bf16(const float* src, bf16* dst, size_t n, size_t gtid, size_t nthreads) {
    for (size_t i = gtid * 8; i < n; i += nthreads * 8) {
        const f32x4 a = *(const GAS f32x4*)(src + i), b = *(const GAS f32x4*)(src + i + 4);
        v4u o; o.x = pk2(a[0], a[1]); o.y = pk2(a[2], a[3]); o.z = pk2(b[0], b[1]); o.w = pk2(b[2], b[3]);
        *(GAS v4u*)(dst + i) = o;
    }
}
__device__ __forceinline__ int t5_bucket(int rel) {
    const int n = rel < 0 ? -rel : rel;
    const int b = n < 8 ? n : n < 12 ? 8 : n < 16 ? 9 : n < 23 ? 10 : n < 32 ? 11 : n < 46 ? 12 : n < 64 ? 13 : n < 91 ? 14 : 15;
    return b + (rel > 0 ? 16 : 0);
}
__constant__ float ROPE_INV[16] = {1.000000000e+00f, 5.623413324e-01f, 3.162277639e-01f, 1.778279394e-01f, 1.000000015e-01f, 5.623413250e-02f, 3.162277490e-02f, 1.778279431e-02f,
                                   9.999999776e-03f, 5.623413250e-03f, 3.162277630e-03f, 1.778279431e-03f, 1.000000047e-03f, 5.623413017e-04f, 3.162277571e-04f, 1.778279402e-04f};

__device__ __forceinline__ void rms_row_to_bf16(const float* xrow, const float* g0, bf16* o0, const float* g1, bf16* o1, int lane) {
    const GAS f32x4* xr = (const GAS f32x4*)xrow + lane;
    f32x4 v[8]; float s = 0.f;
#pragma unroll
    for (int j = 0; j < 8; ++j) { v[j] = xr[64 * j]; s += (v[j].x * v[j].x + v[j].y * v[j].y) + (v[j].z * v[j].z + v[j].w * v[j].w); }
    const float rstd = 1.f / sqrtf(wave_sum(s, lane) * (1.f / DM) + EPS);
    {   const GAS f32x4* gr = (const GAS f32x4*)g0 + lane; GAS v2u* o8 = (GAS v2u*)o0 + lane; f32x4 gg[8];
#pragma unroll
        for (int j = 0; j < 8; ++j) gg[j] = gr[64 * j];
#pragma unroll
        for (int j = 0; j < 8; ++j) { v2u w; w.x = pk2(v[j].x * rstd * gg[j].x, v[j].y * rstd * gg[j].y); w.y = pk2(v[j].z * rstd * gg[j].z, v[j].w * rstd * gg[j].w); o8[64 * j] = w; } }
    if (g1) { const GAS f32x4* gr = (const GAS f32x4*)g1 + lane; GAS v2u* o8 = (GAS v2u*)o1 + lane; f32x4 gg[8];
#pragma unroll
        for (int j = 0; j < 8; ++j) gg[j] = gr[64 * j];
#pragma unroll
        for (int j = 0; j < 8; ++j) { v2u w; w.x = pk2(v[j].x * rstd * gg[j].x, v[j].y * rstd * gg[j].y); w.y = pk2(v[j].z * rstd * gg[j].z, v[j].w * rstd * gg[j].w); o8[64 * j] = w; } }
}
__device__ __forceinline__ float wave_max(float v, int lane) {
#pragma unroll
    for (int o = 1; o < 64; o <<= 1) v = fmaxf(v, shx(v, o, lane));
    return v;
}
__device__ __forceinline__ unsigned q8x4(const f32x4 v, const float inv) {
    unsigned w = 0;
    w = __builtin_amdgcn_cvt_pk_u8_f32(__builtin_rintf(__builtin_fmaf(v[0], inv, 128.f)), 0, w); w = __builtin_amdgcn_cvt_pk_u8_f32(__builtin_rintf(__builtin_fmaf(v[1], inv, 128.f)), 1, w);
    w = __builtin_amdgcn_cvt_pk_u8_f32(__builtin_rintf(__builtin_fmaf(v[2], inv, 128.f)), 2, w); w = __builtin_amdgcn_cvt_pk_u8_f32(__builtin_rintf(__builtin_fmaf(v[3], inv, 128.f)), 3, w);
    return w ^ 0x80808080u;
}
__device__ __forceinline__ float amax4(const f32x4 v) { return fmaxf(fmaxf(fabsf(v[0]), fabsf(v[1])), fmaxf(fabsf(v[2]), fabsf(v[3]))); }
__device__ __forceinline__ void quant_wrow(const bf16* src, unsigned char* dst, float* step, int lane) {
    v4u w[4]; float am = 0.f;
#pragma unroll
    for (int j = 0; j < 4; ++j) w[j] = *(const GAS v4u*)(src + 8 * lane + 512 * j);
    f32x4 lo[4], hi[4];
#pragma unroll
    for (int j = 0; j < 4; ++j) { lo[j] = (f32x4){bflo(w[j].x), bfhi(w[j].x), bflo(w[j].y), bfhi(w[j].y)}; hi[j] = (f32x4){bflo(w[j].z), bfhi(w[j].z), bflo(w[j].w), bfhi(w[j].w)}; am = fmaxf(am, fmaxf(amax4(lo[j]), amax4(hi[j]))); }
    am = fmaxf(wave_max(am, lane), 1e-30f);
    const float inv = 127.f / am;
#pragma unroll
    for (int j = 0; j < 4; ++j) *(GAS v2u*)(dst + 8 * lane + 512 * j) = (v2u){q8x4(lo[j], inv), q8x4(hi[j], inv)};
    if (lane == 0) *step = am * (1.f / 127.f);
}
template <int R>
__device__ __forceinline__ void att_quant_rows(const bf16* ATT, const u64_t* mixsq, unsigned char* Q, float* step, int row0, int lane) {
    v4u w[R][4];
#pragma unroll
    for (int q = 0; q < R; ++q)
#pragma unroll
        for (int j = 0; j < 4; ++j) w[q][j] = *(const GAS v4u*)(ATT + (size_t)(row0 + q) * DM + 8 * lane + 512 * j);
    unsigned zv = 0u; asm volatile("" : "+v"(zv));
    u64_t msq[R][3];
#pragma unroll
    for (int q = 0; q < R; ++q)
#pragma unroll
        for (int g = 0; g < 3; ++g) msq[q][g] = *(const GAS u64_t*)((const char*)(mixsq + (size_t)g * T + row0 + q) + zv);
    __builtin_amdgcn_sched_barrier(0);
#pragma unroll
    for (int q = 0; q < R; ++q) { const int row = row0 + q;
        const float ra = 1.0f / sqrtf((float)msq[q][0] * (5.9604644775390625e-08f / 768.0f) + EPS), rb = 1.0f / sqrtf((float)msq[q][1] * (5.9604644775390625e-08f / 512.0f) + EPS),
                    rc = 1.0f / sqrtf((float)msq[q][2] * (5.9604644775390625e-08f / 768.0f) + EPS);
        const float rj[4] = {ra, lane < 32 ? ra : rb, lane < 32 ? rb : rc, rc};
        f32x4 lo[4], hi[4]; float am = 0.f;
#pragma unroll
        for (int j = 0; j < 4; ++j) { lo[j] = (f32x4){bflo(w[q][j].x), bfhi(w[q][j].x), bflo(w[q][j].y), bfhi(w[q][j].y)} * rj[j]; hi[j] = (f32x4){bflo(w[q][j].z), bfhi(w[q][j].z), bflo(w[q][j].w), bfhi(w[q][j].w)} * rj[j]; am = fmaxf(am, fmaxf(amax4(lo[j]), amax4(hi[j]))); }
        am = fmaxf(wave_max(am, lane), 1e-30f);
        const float inv = 127.f / am;
#pragma unroll
        for (int j = 0; j < 4; ++j) *(GAS v2u*)(Q + (size_t)row * DM + 8 * lane + 512 * j) = (v2u){q8x4(lo[j], inv), q8x4(hi[j], inv)};
        if (lane == 0) step[row] = am * (1.f / 127.f); }
}
template <bool PERMQKV>
__device__ __forceinline__ void wq_item(const float* W, int N, int n0, const float* gk, unsigned char* WT8, float* wsc, LAS unsigned char* ring, LAS float* red, int tid) {
    const int cg = tid & 7, kl = tid >> 3;
    f32x4 am = {0.f, 0.f, 0.f, 0.f};
#pragma unroll 1
    for (int i0 = 0; i0 < 32; i0 += 16) {
        f32x4 w[16]; float g[16];
#pragma unroll
        for (int i = 0; i < 16; ++i) { const int k = kl + 64 * (i0 + i); w[i] = *(const GAS f32x4*)(W + (size_t)k * N + n0 + 4 * cg); g[i] = gk ? gk[k] : 1.f; }
#pragma unroll
        for (int i = 0; i < 16; ++i) { const int k = kl + 64 * (i0 + i); const f32x4 v = w[i] * g[i];
            am = (f32x4){fmaxf(am[0], fabsf(v[0])), fmaxf(am[1], fabsf(v[1])), fmaxf(am[2], fabsf(v[2])), fmaxf(am[3], fabsf(v[3]))};
            const int kr = (k + 8 * cg) & 2047;
#pragma unroll
            for (int e = 0; e < 4; ++e) *(LAS unsigned short*)(ring + (4 * cg + e) * 4096 + 2 * kr) = (unsigned short)f2bf(v[e]); }
    }
    *(LAS f32x4*)(red + 4 * tid) = am;
    __syncthreads();
    if (tid < 32) { float m = 0.f;
        for (int j = 0; j < 64; ++j) m = fmaxf(m, red[4 * (8 * j + (tid >> 2)) + (tid & 3)]);
        m = fmaxf(m, 1e-30f); wsc[n0 + tid] = m * (1.f / 127.f); red[2048 + tid] = 127.f / m; }
    __syncthreads();
#pragma unroll 1
    for (int j = 0; j < 8; ++j) { const int p = tid + 512 * j, n = p >> 7, kc = p & 127;
        const int ro = 8 * (n >> 2);
        const v4u a = *(const LAS v4u*)(ring + n * 4096 + 2 * ((16 * kc + ro) & 2047)), b2 = *(const LAS v4u*)(ring + n * 4096 + 2 * ((16 * kc + 8 + ro) & 2047)); const float inv = red[2048 + n];
        v4u o; o.x = q8x4((f32x4){bflo(a.x), bfhi(a.x), bflo(a.y), bfhi(a.y)}, inv); o.y = q8x4((f32x4){bflo(a.z), bfhi(a.z), bflo(a.w), bfhi(a.w)}, inv);
        o.z = q8x4((f32x4){bflo(b2.x), bfhi(b2.x), bflo(b2.y), bfhi(b2.y)}, inv); o.w = q8x4((f32x4){bflo(b2.z), bfhi(b2.z), bflo(b2.w), bfhi(b2.w)}, inv);
        int dn = n0 + n; if (PERMQKV) { const int within = dn & 255; dn = (dn & ~255) + 128 * ((within >> 5) & 1) + 32 * (within >> 6) + (within & 31); }
        *(GAS v4u*)(WT8 + (size_t)dn * 2048 + 16 * kc) = o; }
    __syncthreads();
}
__device__ __forceinline__ void rms_row_to_i8(const f32x4 (&v)[8], float rstd, const float* g, unsigned char* q, float* step, int lane) {
    const GAS f32x4* gr = (const GAS f32x4*)g + lane; f32x4 gg[8], y[8]; float am = 0.f;
#pragma unroll
    for (int j = 0; j < 8; ++j) gg[j] = gr[64 * j];
#pragma unroll
    for (int j = 0; j < 8; ++j) { y[j] = v[j] * gg[j] * rstd; am = fmaxf(am, amax4(y[j])); }
    am = fmaxf(wave_max(am, lane), 1e-30f);
    const float inv = 127.f / am;
#pragma unroll
    for (int j = 0; j < 8; ++j) *(GAS unsigned*)(q + 4 * lane + 256 * j) = q8x4(y[j], inv);
    if (lane == 0) *step = am * (1.f / 127.f);
}
__device__ __forceinline__ void prep_rows2(const float* x0, bf16* o0, u64_t* sq, unsigned char* q0, float* qstep, int lane) {
    f32x4 v[2][8];
#pragma unroll
    for (int q = 0; q < 2; ++q) { const GAS f32x4* xr = (const GAS f32x4*)(x0 + (size_t)q * DM) + lane;
#pragma unroll
        for (int j = 0; j < 8; ++j) v[q][j] = xr[64 * j]; }
#pragma unroll
    for (int q = 0; q < 2; ++q) { GAS v2u* o8 = (GAS v2u*)(o0 + (size_t)q * DM) + lane; float s = 0.f;
#pragma unroll
        for (int j = 0; j < 8; ++j) { const f32x4 a = v[q][j]; s += (a.x * a.x + a.y * a.y) + (a.z * a.z + a.w * a.w); v2u w; w.x = pk2(a.x, a.y); w.y = pk2(a.z, a.w); o8[64 * j] = w; }
        s = wave_sum(s, lane);
        float am = 0.f;
#pragma unroll
        for (int j = 0; j < 8; ++j) am = fmaxf(am, amax4(v[q][j]));
        am = fmaxf(wave_max(am, lane), 1e-30f);
        const float inv = 127.f / am;
#pragma unroll
        for (int j = 0; j < 8; ++j) *(GAS unsigned*)(q0 + (size_t)q * DM + 4 * lane + 256 * j) = q8x4(v[q][j], inv);
        if (lane == 0) { sq[q] = rowsq_fx(s); qstep[q] = am * (1.f / 127.f) / sqrtf(s * (1.f / DM) + 1e-6f); } }
}
__device__ __forceinline__ void norm_rows(const float* X, const float* g, bf16* XN, int gw, int NGW, int lane) {
    for (int m = gw; m < T; m += NGW) rms_row_to_bf16(X + (size_t)m * DM, g, XN + (size_t)m * DM, nullptr, nullptr, lane);
}

template <int TYPE>
__device__ __forceinline__ void naive_attn_item(const bf16* QKV, bf16* ATT, int b, int grow, int head, int lane, const float* biasA, const float* sink, const float* rpb) {
    const int tpos = grow * 64 + lane; const size_t trow = (size_t)b * SEQ + tpos;
    int qcol, kcol, vcol, ocol;
    if (TYPE == 0) { qcol = QA + head * 64; kcol = KA + (head / 3) * 64; vcol = VA + (head / 3) * 64; ocol = OA + head * 64; }
    else if (TYPE == 1) { qcol = QB + head * 64; kcol = KB + head * 64; vcol = VB + head * 64; ocol = OB + head * 64; }
    else { qcol = QC + head * 64; kcol = KC + (head / 3) * 64; vcol = VC + (head / 3) * 64; ocol = OC + head * 64; }
    float q[64], o[64];
#pragma unroll
    for (int c = 0; c < 8; ++c) { const v4u w = *(const GAS v4u*)(QKV + trow * DIN + qcol + 8 * c);
        q[8 * c + 0] = bflo(w.x); q[8 * c + 1] = bfhi(w.x); q[8 * c + 2] = bflo(w.y); q[8 * c + 3] = bfhi(w.y); q[8 * c + 4] = bflo(w.z); q[8 * c + 5] = bfhi(w.z); q[8 * c + 6] = bflo(w.w); q[8 * c + 7] = bfhi(w.w); }
#pragma unroll
    for (int d = 0; d < 64; ++d) o[d] = 0.f;
    float m = -1e30f, l = 0.f;
    int j0, j1;
    if (TYPE == 0) { j0 = grow * 64 - 128; if (j0 < 0) j0 = 0; j1 = grow * 64 + 63 + 128; if (j1 > SEQ - 1) j1 = SEQ - 1; }
    else if (TYPE == 1) { int r0 = grow - 4; r0 = r0 < 0 ? 0 : (r0 > 24 ? 24 : r0); j0 = r0 * 64; j1 = j0 + 511; }
    else { j0 = 0; j1 = SEQ - 1; }
    int c0 = lane - 8; c0 = c0 < 0 ? 0 : (c0 > 48 ? 48 : c0);
#pragma unroll 1
    for (int j = j0; j <= j1; ++j) {
        const bf16* krow = QKV + ((size_t)b * SEQ + j) * DIN;
        float s = 0.f;
#pragma unroll
        for (int c = 0; c < 8; ++c) { const v4u w = *(const GAS v4u*)(krow + kcol + 8 * c);
            s += q[8 * c + 0] * bflo(w.x) + q[8 * c + 1] * bfhi(w.x) + q[8 * c + 2] * bflo(w.y) + q[8 * c + 3] * bfhi(w.y) + q[8 * c + 4] * bflo(w.z) + q[8 * c + 5] * bfhi(w.z) + q[8 * c + 6] * bflo(w.w) + q[8 * c + 7] * bfhi(w.w); }
        bool valid = true;
        if (TYPE == 0) { const int rel = j - tpos; valid = (rel >= -128 && rel <= 128); if (valid) s += biasA[head * 257 + rel + 128]; }
        if (TYPE == 1) { const int kr = j >> 6, kc = j & 63; valid = (kc >= c0 && kc < c0 + 16); if (valid) s += rpb[(head * 15 + (kr - grow + 7)) * 31 + (kc - lane + 15)]; }
        const float mn = valid ? fmaxf(m, s) : m;
        const float a = __expf(m - mn);
        const float p = valid ? __expf(s - mn) : 0.f;
        l = l * a + p; m = mn;
#pragma unroll
        for (int c = 0; c < 8; ++c) { const v4u w = *(const GAS v4u*)(krow + vcol + 8 * c);
            o[8 * c + 0] = o[8 * c + 0] * a + p * bflo(w.x); o[8 * c + 1] = o[8 * c + 1] * a + p * bfhi(w.x); o[8 * c + 2] = o[8 * c + 2] * a + p * bflo(w.y); o[8 * c + 3] = o[8 * c + 3] * a + p * bfhi(w.y);
            o[8 * c + 4] = o[8 * c + 4] * a + p * bflo(w.z); o[8 * c + 5] = o[8 * c + 5] * a + p * bfhi(w.z); o[8 * c + 6] = o[8 * c + 6] * a + p * bflo(w.w); o[8 * c + 7] = o[8 * c + 7] * a + p * bfhi(w.w); }
    }
    if (TYPE == 0) l += __expf(sink[head] - m);
    const float inv = 1.f / l;
#pragma unroll
    for (int c = 0; c < 8; ++c) { v4u w; w.x = pk2(o[8 * c + 0] * inv, o[8 * c + 1] * inv); w.y = pk2(o[8 * c + 2] * inv, o[8 * c + 3] * inv); w.z = pk2(o[8 * c + 4] * inv, o[8 * c + 5] * inv); w.w = pk2(o[8 * c + 6] * inv, o[8 * c + 7] * inv);
        *(GAS v4u*)(ATT + trow * DM + ocol + 8 * c) = w; }
}
__device__ __forceinline__ float rdl(float v, int l) { return __builtin_bit_cast(float, __builtin_amdgcn_readlane(__builtin_bit_cast(int, v), l)); }
__device__ __forceinline__ void naive_mem_item(const bf16* QM, const bf16* KVM, bf16* OM, const float* gq, size_t trow, int b, int head, int lane) {
    const unsigned qw = *(const GAS unsigned*)(QM + trow * MEMW + head * 128 + 2 * lane);
    float q0 = bflo(qw), q1 = bfhi(qw);
    const float ss = wave_sum(q0 * q0 + q1 * q1, lane);
    const float r = 0.08838834764831845f / sqrtf(ss * (1.f / 128.f) + EPS);
    q0 *= r * gq[2 * lane]; q1 *= r * gq[2 * lane + 1];
    const bf16* kbase = KVM + ((size_t)b * NMEM + lane) * 1024 + head * 128;
    float s[4] = {0.f, 0.f, 0.f, 0.f};
#pragma unroll 1
    for (int c = 0; c < 16; ++c) {
        float qa[8];
#pragma unroll
        for (int e = 0; e < 4; ++e) { qa[2 * e] = rdl(q0, 4 * c + e); qa[2 * e + 1] = rdl(q1, 4 * c + e); }
#pragma unroll
        for (int i = 0; i < 4; ++i) { const v4u w = *(const GAS v4u*)(kbase + (size_t)i * 64 * 1024 + 8 * c);
            s[i] += qa[0] * bflo(w.x) + qa[1] * bfhi(w.x) + qa[2] * bflo(w.y) + qa[3] * bfhi(w.y) + qa[4] * bflo(w.z) + qa[5] * bfhi(w.z) + qa[6] * bflo(w.w) + qa[7] * bfhi(w.w); }
    }
    float m = fmaxf(fmaxf(s[0], s[1]), fmaxf(s[2], s[3]));
#pragma unroll
    for (int o = 1; o < 64; o <<= 1) m = fmaxf(m, shx(m, o, lane));
    float p[4]; float l = 0.f;
#pragma unroll
    for (int i = 0; i < 4; ++i) { p[i] = __expf(s[i] - m); l += p[i]; }
    l = wave_sum(l, lane);
    const bf16* vbase = KVM + ((size_t)b * NMEM) * 1024 + 512 + head * 128 + 2 * lane;
    float o0 = 0.f, o1 = 0.f;
#pragma unroll
    for (int i = 0; i < 4; ++i) {
#pragma unroll 4
        for (int jj = 0; jj < 64; ++jj) { const float pj = rdl(p[i], jj); const unsigned w = *(const GAS unsigned*)(vbase + (size_t)(64 * i + jj) * 1024); o0 += pj * bflo(w); o1 += pj * bfhi(w); }
    }
    const float inv = 1.f / l;
    *(GAS unsigned*)(OM + trow * MEMW + head * 128 + 2 * lane) = pk2(o0 * inv, o1 * inv);
}
__device__ __forceinline__ void mixnorm_rows(bf16* ATT, const float* g, int gw, int NGW, int lane) {
    for (int m = gw; m < T; m += NGW) {
        GAS v4u* p = (GAS v4u*)(ATT + (size_t)m * DM + 32 * lane);
        v4u w[4]; float f[32]; float ss = 0.f;
#pragma unroll
        for (int c = 0; c < 4; ++c) { w[c] = p[c];
            f[8 * c + 0] = bflo(w[c].x); f[8 * c + 1] = bfhi(w[c].x); f[8 * c + 2] = bflo(w[c].y); f[8 * c + 3] = bfhi(w[c].y); f[8 * c + 4] = bflo(w[c].z); f[8 * c + 5] = bfhi(w[c].z); f[8 * c + 6] = bflo(w[c].w); f[8 * c + 7] = bfhi(w[c].w); }
#pragma unroll
        for (int i = 0; i < 32; ++i) ss += f[i] * f[i];
        const int grp = lane < 24 ? 0 : (lane < 40 ? 1 : 2);
        const float sa = wave_sum(grp == 0 ? ss : 0.f, lane), sb = wave_sum(grp == 1 ? ss : 0.f, lane), sc = wave_sum(grp == 2 ? ss : 0.f, lane);
        const float r = grp == 0 ? 1.f / sqrtf(sa * (1.f / 768.f) + EPS) : (grp == 1 ? 1.f / sqrtf(sb * (1.f / 512.f) + EPS) : 1.f / sqrtf(sc * (1.f / 768.f) + EPS));
        const float* gg = g + 32 * lane;
#pragma unroll
        for (int c = 0; c < 4; ++c) { const f32x4 g0 = *(const GAS f32x4*)(gg + 8 * c), g1 = *(const GAS f32x4*)(gg + 8 * c + 4);
            v4u o; o.x = pk2(f[8 * c + 0] * r * g0[0], f[8 * c + 1] * r * g0[1]); o.y = pk2(f[8 * c + 2] * r * g0[2], f[8 * c + 3] * r * g0[3]);
            o.z = pk2(f[8 * c + 4] * r * g1[0], f[8 * c + 5] * r * g1[1]); o.w = pk2(f[8 * c + 6] * r * g1[2], f[8 * c + 7] * r * g1[3]); p[c] = o; }
    }
}

#ifndef PEER_HD
#define PEER_HD __device__ __forceinline__
#define PEER_EXP(x) __expf(x)
#endif
template <int N> PEER_HD void bitonic_sort_desc(float* v) {
#pragma unroll
    for (int k = 2; k <= N; k <<= 1)
#pragma unroll
        for (int j = k >> 1; j > 0; j >>= 1)
#pragma unroll
            for (int i = 0; i < N; ++i) { const int l = i ^ j; if (l > i) { const bool desc = ((i & k) == 0); const float a = v[i], b = v[l]; const float hi = fmaxf(a, b), lo = fminf(a, b);
                v[i] = desc ? hi : lo; v[l] = desc ? lo : hi; } }
}
#define PEER_CE(i, j) do { const float x_ = v[i], y_ = v[j]; v[i] = fmaxf(x_, y_); v[j] = fminf(x_, y_); } while (0)
PEER_HD void sort16_desc(float* v) {
    PEER_CE(0,13); PEER_CE(1,12); PEER_CE(2,15); PEER_CE(3,14); PEER_CE(4,8); PEER_CE(5,6); PEER_CE(7,11); PEER_CE(9,10);
    PEER_CE(0,5); PEER_CE(1,7); PEER_CE(2,9); PEER_CE(3,4); PEER_CE(6,13); PEER_CE(8,14); PEER_CE(10,15); PEER_CE(11,12);
    PEER_CE(0,1); PEER_CE(2,3); PEER_CE(4,5); PEER_CE(6,8); PEER_CE(7,9); PEER_CE(10,11); PEER_CE(12,13); PEER_CE(14,15);
    PEER_CE(0,2); PEER_CE(1,3); PEER_CE(4,10); PEER_CE(5,11); PEER_CE(6,7); PEER_CE(8,9); PEER_CE(12,14); PEER_CE(13,15);
    PEER_CE(1,2); PEER_CE(3,12); PEER_CE(4,6); PEER_CE(5,7); PEER_CE(8,10); PEER_CE(9,11); PEER_CE(13,14);
    PEER_CE(1,4); PEER_CE(2,6); PEER_CE(5,8); PEER_CE(7,10); PEER_CE(9,13); PEER_CE(11,14);
    PEER_CE(2,4); PEER_CE(3,6); PEER_CE(9,12); PEER_CE(11,13);
    PEER_CE(3,5); PEER_CE(6,8); PEER_CE(7,9); PEER_CE(10,12);
    PEER_CE(3,4); PEER_CE(5,6); PEER_CE(7,8); PEER_CE(9,10); PEER_CE(11,12);
    PEER_CE(6,7); PEER_CE(8,9);
}
PEER_HD void sort6_desc(float* v) {
    PEER_CE(0,5); PEER_CE(1,3); PEER_CE(2,4); PEER_CE(1,2); PEER_CE(3,4); PEER_CE(0,3); PEER_CE(2,5); PEER_CE(0,1); PEER_CE(2,3); PEER_CE(4,5); PEER_CE(1,2); PEER_CE(3,4);
}
PEER_HD void merge_top16(float* a, const float* b) {
    float c[16];
#pragma unroll
    for (int i = 0; i < 16; ++i) c[i] = fmaxf(a[i], b[15 - i]);
#pragma unroll
    for (int j = 8; j > 0; j >>= 1)
#pragma unroll
        for (int i = 0; i < 16; ++i) { const int l = i ^ j; if (l > i) { const float x = c[i], y = c[l]; c[i] = fmaxf(x, y); c[l] = fminf(x, y); } }
#pragma unroll
    for (int i = 0; i < 16; ++i) a[i] = c[i];
}
PEER_HD void top16_of_64(float (&v)[64]) {
    sort16_desc(&v[0]); sort16_desc(&v[16]); sort16_desc(&v[32]); sort16_desc(&v[48]);
    merge_top16(&v[0], &v[16]); merge_top16(&v[32], &v[48]); merge_top16(&v[0], &v[32]);
}
PEER_HD float pack_idx(float s, unsigned idx, unsigned mask) { return __builtin_bit_cast(float, (__builtin_bit_cast(unsigned, s) & ~mask) | idx); }
PEER_HD unsigned low_bits(float s, unsigned mask) { return __builtin_bit_cast(unsigned, s) & mask; }
PEER_HD unsigned pick16(const float* a, unsigned i, unsigned mask) {
    unsigned r = 0;
#pragma unroll
    for (unsigned k = 0; k < 16; ++k) r = (i == k) ? low_bits(a[k], mask) : r;
    return r;
}
PEER_HD void peer_candidates(const float* a, const float* b, int* e, float* gate) {
    const float NEG = -3.0e38f;
#define PEER_S(i, j) pack_idx(a[i] + b[j], (unsigned)((i) * 16 + (j)), 0xffu)
    float r0[16], r1[16], c0[16], c1[16], z[16];
#pragma unroll
    for (int j = 0; j < 16; ++j) { r0[j] = PEER_S(0, j); r1[j] = j < 8 ? PEER_S(1, j) : NEG; c0[j] = j < 14 ? PEER_S(j + 2 < 16 ? j + 2 : 15, 0) : NEG; c1[j] = j < 6 ? PEER_S(j + 2 < 16 ? j + 2 : 15, 1) : NEG; z[j] = NEG; }
    z[0] = PEER_S(2, 2); z[1] = PEER_S(2, 3); z[2] = PEER_S(2, 4); z[3] = PEER_S(3, 2); z[4] = PEER_S(3, 3); z[5] = PEER_S(4, 2);
#undef PEER_S
    sort6_desc(z);
    merge_top16(c1, z); merge_top16(c0, c1); merge_top16(r0, r1);
    float c[16];
#pragma unroll
    for (int i = 0; i < 16; ++i) c[i] = fmaxf(r0[i], c0[15 - i]);
    float mx = c[0], den = 0.f;
#pragma unroll
    for (int k = 0; k < 16; ++k) { const unsigned id = low_bits(c[k], 0xffu); const unsigned n0 = pick16(a, id >> 4, 0x7fu), n1 = pick16(b, id & 15u, 0x7fu);
        e[k] = (int)(n0 * 128u + n1); gate[k] = PEER_EXP(c[k] - mx); den += gate[k]; }
    const float inv = 1.f / den;
#pragma unroll
    for (int k = 0; k < 16; ++k) gate[k] *= inv;
}

__device__ __forceinline__ void peer_select_unit(const bf16* QP, const bf16* PK, int* PIDX, float* PGATE, int tb, int h, int wave, int lane, LAS unsigned char* lds) {
    const int hh = lane >> 5, tl = lane & 31; const size_t t = (size_t)tb * 256 + wave * 32 + tl;
    __syncthreads();
    {   const int tid = wave * 64 + lane; const bf16* src = PK + (size_t)h * 256 * 128;
#pragma unroll 1
        for (int i0 = 0; i0 < 8; i0 += 4) { v4u st[4];
#pragma unroll
            for (int i = 0; i < 4; ++i) st[i] = *(const GAS v4u*)(src + (size_t)(tid + 512 * (i0 + i)) * 8);
#pragma unroll
            for (int i = 0; i < 4; ++i) { const int c = tid + 512 * (i0 + i), row = c >> 4, ch = c & 15; *(LAS v4u*)(lds + row * 256 + ((ch ^ (row & 15)) * 16)) = st[i]; } } }
    __syncthreads();
    float ab[2][16];
#pragma unroll
    for (int p = 0; p < 2; ++p) {
        bf16x8 bq[8];
#pragma unroll
        for (int s = 0; s < 8; ++s) bq[s] = *(const GAS bf16x8*)(QP + t * DM + 256 * h + 128 * p + 16 * s + 8 * hh);
        float v[64];
#pragma unroll
        for (int nb = 0; nb < 4; ++nb) {
            f32x16 acc;
#pragma unroll
            for (int r = 0; r < 16; ++r) acc[r] = 0.f;
            const int krow = p * 128 + 32 * nb + tl;
            bf16x8 ak[8];
#pragma unroll
            for (int s = 0; s < 8; ++s) ak[s] = *(const LAS bf16x8*)(lds + krow * 256 + (((2 * s + hh) ^ (krow & 15)) * 16));
#pragma unroll
            for (int s = 0; s < 8; ++s) acc = __builtin_amdgcn_mfma_f32_32x32x16_bf16(ak[s], bq[s], acc, 0, 0, 0);
#pragma unroll
            for (int r = 0; r < 16; ++r) v[16 * nb + r] = pack_idx(acc[r], (unsigned)(32 * nb + 8 * (r >> 2) + 4 * hh + (r & 3)), 0x7fu);
        }
        top16_of_64(v);
        float pv[16];
#pragma unroll
        for (int i = 0; i < 16; ++i) pv[i] = shx(v[i], 32, lane);
        merge_top16(&v[0], pv);
#pragma unroll
        for (int i = 0; i < 16; ++i) ab[p][i] = v[i];
    }
    int e[16]; float gate[16];
    peer_candidates(ab[0], ab[1], e, gate);
    if (hh == 0) { GAS v4u* o = (GAS v4u*)(PIDX + t * 128 + h * 16);
#pragma unroll
        for (int c = 0; c < 4; ++c) o[c] = (v4u){(unsigned)e[4 * c], (unsigned)e[4 * c + 1], (unsigned)e[4 * c + 2], (unsigned)e[4 * c + 3]}; }
    else { GAS f32x4* o = (GAS f32x4*)(PGATE + t * 128 + h * 16);
#pragma unroll
        for (int c = 0; c < 4; ++c) o[c] = (f32x4){gate[4 * c], gate[4 * c + 1], gate[4 * c + 2], gate[4 * c + 3]}; }
}

typedef float f32x2 __attribute__((ext_vector_type(2)));
typedef unsigned v6u __attribute__((ext_vector_type(6)));
typedef float v32f __attribute__((ext_vector_type(32)));
typedef v4u __attribute__((aligned(8))) v4u_a8;
constexpr float PU_SCALE6 = 90.0f, PV_SCALE6 = 5.65f;
__device__ __forceinline__ unsigned enc_e2m3(float v) {
    const float a = fminf(fabsf(v), 7.5f);
    unsigned code;
    if (a < 1.0f) code = (unsigned)__builtin_rintf(a * 8.f);
    else { const unsigned b = __builtin_bit_cast(unsigned, a) - 0x3F800000u; code = ((b + 0x7FFFFu + ((b >> 20) & 1u)) >> 20) + 8u; }
    return code | (v < 0.f ? 32u : 0u);
}
__device__ __forceinline__ void convert_fp6_rows(const float* src, unsigned char* dst, int nrows, float scale, const float* gain, int gw, int NGW, int lane) {
    for (int r = gw; r < nrows; r += NGW) {
        const float* sp = src + (size_t)r * DM + 4 * lane; const float* gp = gain ? gain + (size_t)(r / PEER_N) * DM + 4 * lane : nullptr;
        unsigned w[6] = {0u, 0u, 0u, 0u, 0u, 0u};
#pragma unroll
        for (int j = 0; j < 8; ++j) { f32x4 a = *(const GAS f32x4*)(sp + 256 * j) * scale; if (gp) a = a * *(const GAS f32x4*)(gp + 256 * j);
#pragma unroll
            for (int e = 0; e < 4; ++e) { const unsigned code = enc_e2m3(a[e]); const int bp = 6 * (4 * j + e), wi = bp >> 5, sh = bp & 31;
                w[wi] |= code << sh; if (sh > 26) w[wi + 1] |= code >> (32 - sh); } }
        unsigned char* dp = dst + (size_t)r * 1536 + 24 * lane;
        *(GAS v4u_a8*)dp = (v4u){w[0], w[1], w[2], w[3]}; *(GAS v2u*)(dp + 16) = (v2u){w[4], w[5]};
    }
}
constexpr float PV_SCALE4 = 5.65f, PU_SCALE4 = 90.0f;
__device__ __forceinline__ unsigned enc_e2m1(float v) {
    const float a = fabsf(v);
    const unsigned code = a < 0.25f ? 0u : a < 0.75f ? 1u : a < 1.25f ? 2u : a < 1.75f ? 3u : a < 2.5f ? 4u : a < 3.5f ? 5u : a < 5.0f ? 6u : 7u;
    return code | (v < 0.f ? 8u : 0u);
}
__device__ __forceinline__ void convert_fp4_rows(const float* src, unsigned char* dst, int nrows, float scale, const float* gain, int gw, int NGW, int lane) {
    for (int r0 = 2 * gw; r0 < nrows; r0 += 2 * NGW) {
        f32x4 a[2][8];
#pragma unroll
        for (int q = 0; q < 2; ++q) { const float* sp = src + (size_t)(r0 + q) * DM + 4 * lane;
#pragma unroll
            for (int j = 0; j < 8; ++j) a[q][j] = *(const GAS f32x4*)(sp + 256 * j); }
#pragma unroll
        for (int q = 0; q < 2; ++q) { const int r = r0 + q; const float* gp = gain ? gain + (size_t)(r / PEER_N) * DM + 4 * lane : nullptr;
            unsigned w[4] = {0u, 0u, 0u, 0u};
#pragma unroll
            for (int j = 0; j < 8; ++j) { f32x4 v = a[q][j] * scale; if (gp) v = v * *(const GAS f32x4*)(gp + 256 * j);
#pragma unroll
                for (int e = 0; e < 4; ++e) { const int i = 4 * j + e; w[i >> 3] |= enc_e2m1(v[e]) << (4 * (i & 7)); } }
            *(GAS v4u*)(dst + (size_t)r * 1024 + 16 * lane) = (v4u){w[0], w[1], w[2], w[3]}; }
    }
}
#define PG4_LOAD(buf, tab, idlo, idhi, g) do { _Pragma("unroll") for (int i_ = 0; i_ < PG6_R; ++i_) { const int k_ = (g) * PG6_R + i_; \
        const int e_ = __builtin_amdgcn_readlane(k_ < 64 ? idlo : idhi, k_ & 63); buf[i_] = __builtin_amdgcn_raw_buffer_load_b128(tab, (int)voff4, e_ * 1024, 0); } } while (0)
typedef int v8i_ __attribute__((ext_vector_type(8)));
#define PG4_SL(idn, base, g) do { const int so_ = (g) * 32; asm volatile("s_load_dwordx8 %0, %1, %2" : "=s"(idn) : "s"(base), "s"(so_)); } while (0)
#define PG4_LOADS(buf, tab, idn) do { asm volatile("s_waitcnt lgkmcnt(0)" : "+s"(idn)); _Pragma("unroll") for (int i_ = 0; i_ < PG6_R; ++i_) buf[i_] = __builtin_amdgcn_raw_buffer_load_b128(tab, (int)voff4, idn[i_] * 1024, 0); } while (0)
#define PG4_DOT1(buf, i_, dst) do { f32x2 a_ = {0.f, 0.f}; _Pragma("unroll") for (int c_ = 0; c_ < 4; ++c_) { const unsigned u_ = buf[i_][c_]; \
        a_ += __builtin_amdgcn_cvt_scalef32_pk_f32_fp4(u_, 1.0f, 0) * x[4 * c_ + 0]; a_ += __builtin_amdgcn_cvt_scalef32_pk_f32_fp4(u_, 1.0f, 1) * x[4 * c_ + 1]; \
        a_ += __builtin_amdgcn_cvt_scalef32_pk_f32_fp4(u_, 1.0f, 2) * x[4 * c_ + 2]; a_ += __builtin_amdgcn_cvt_scalef32_pk_f32_fp4(u_, 1.0f, 3) * x[4 * c_ + 3]; } dst = a_.x + a_.y; __builtin_amdgcn_sched_barrier(0); } while (0)
#define PG4_DOT(buf, g) do { float p_[8]; _Pragma("unroll") for (int i_ = 0; i_ < 8; ++i_) PG4_DOT1(buf, i_, p_[i_]); \
        float q_[4]; _Pragma("unroll") for (int i_ = 0; i_ < 4; ++i_) { const float keep_ = b5 ? p_[i_ + 4] : p_[i_], send_ = b5 ? p_[i_] : p_[i_ + 4]; q_[i_] = keep_ + shx(send_, 32, lane); } \
        float r_[2]; _Pragma("unroll") for (int i_ = 0; i_ < 2; ++i_) { const float keep_ = b4 ? q_[i_ + 2] : q_[i_], send_ = b4 ? q_[i_] : q_[i_ + 2]; r_[i_] = keep_ + shx(send_, 16, lane); } \
        float s_; { const float keep_ = b3 ? r_[1] : r_[0], send_ = b3 ? r_[0] : r_[1]; s_ = keep_ + shx(send_, 8, lane); } \
        s_ += shx(s_, 4, lane); s_ += shx(s_, 2, lane); s_ += shx(s_, 1, lane); \
        if ((lane & 7) == 0) wl[(g) * 8 + (lane >> 3)] = s_; } while (0)
#define PG4_AXPY(buf, g) do { const LAS float* wg_ = wl + (g) * PG6_R; asm volatile("" : "+v"(wg_));     \
        _Pragma("unroll") for (int i_ = 0; i_ < PG6_R; ++i_) { const float w_ = wg_[i_]; const f32x2 wv_ = {w_, w_}; \
        _Pragma("unroll") for (int c_ = 0; c_ < 4; ++c_) { const unsigned u_ = buf[i_][c_]; \
            y[4 * c_ + 0] += __builtin_amdgcn_cvt_scalef32_pk_f32_fp4(u_, 1.0f, 0) * wv_; y[4 * c_ + 1] += __builtin_amdgcn_cvt_scalef32_pk_f32_fp4(u_, 1.0f, 1) * wv_; \
            y[4 * c_ + 2] += __builtin_amdgcn_cvt_scalef32_pk_f32_fp4(u_, 1.0f, 2) * wv_; y[4 * c_ + 3] += __builtin_amdgcn_cvt_scalef32_pk_f32_fp4(u_, 1.0f, 3) * wv_; } \
        __builtin_amdgcn_sched_barrier(0); } } while (0)
#ifndef PG6_R
#define PG6_R 8
#endif
#define PG6_LOAD(buf, tab, idlo, idhi, g) do { _Pragma("unroll") for (int i_ = 0; i_ < PG6_R; ++i_) { const int k_ = (g) * PG6_R + i_; \
        const int e_ = __builtin_amdgcn_readlane(k_ < 64 ? idlo : idhi, k_ & 63); const unsigned char* rp_ = (tab) + (size_t)(unsigned)e_ * 1536u; \
        const v4u a_ = *(const GAS v4u_a8*)(rp_ + voff); const v2u b_ = *(const GAS v2u*)(rp_ + voff + 16); buf[i_] = (v6u){a_.x, a_.y, a_.z, a_.w, b_.x, b_.y}; } } while (0)
#define PG6_DOT1(buf, i_, dst) do { const v32f f_ = __builtin_amdgcn_cvt_scalef32_pk32_f32_fp6(buf[i_], 1.0f); f32x2 a_ = {0.f, 0.f}; \
        _Pragma("unroll") for (int c_ = 0; c_ < 16; ++c_) a_ += (f32x2){f_[2 * c_], f_[2 * c_ + 1]} * x[c_]; dst = a_.x + a_.y; __builtin_amdgcn_sched_barrier(0); } while (0)
#if PG6_R == 8
#define PG6_DOT(buf, g) do { float p_[8]; _Pragma("unroll") for (int i_ = 0; i_ < 8; ++i_) PG6_DOT1(buf, i_, p_[i_]); \
        float q_[4]; _Pragma("unroll") for (int i_ = 0; i_ < 4; ++i_) { const float keep_ = b5 ? p_[i_ + 4] : p_[i_], send_ = b5 ? p_[i_] : p_[i_ + 4]; q_[i_] = keep_ + shx(send_, 32, lane); } \
        float r_[2]; _Pragma("unroll") for (int i_ = 0; i_ < 2; ++i_) { const float keep_ = b4 ? q_[i_ + 2] : q_[i_], send_ = b4 ? q_[i_] : q_[i_ + 2]; r_[i_] = keep_ + shx(send_, 16, lane); } \
        float s_; { const float keep_ = b3 ? r_[1] : r_[0], send_ = b3 ? r_[0] : r_[1]; s_ = keep_ + shx(send_, 8, lane); } \
        s_ += shx(s_, 4, lane); s_ += shx(s_, 2, lane); s_ += shx(s_, 1, lane); \
        if ((lane & 7) == 0) wl[(g) * 8 + (lane >> 3)] = s_; } while (0)
#else
#define PG6_DOT(buf, g) do { float p_[4]; _Pragma("unroll") for (int i_ = 0; i_ < 4; ++i_) PG6_DOT1(buf, i_, p_[i_]); \
        float r_[2]; _Pragma("unroll") for (int i_ = 0; i_ < 2; ++i_) { const float keep_ = b5 ? p_[i_ + 2] : p_[i_], send_ = b5 ? p_[i_] : p_[i_ + 2]; r_[i_] = keep_ + shx(send_, 32, lane); } \
        float s_; { const float keep_ = b4 ? r_[1] : r_[0], send_ = b4 ? r_[0] : r_[1]; s_ = keep_ + shx(send_, 16, lane); } \
        s_ += shx(s_, 8, lane); s_ += shx(s_, 4, lane); s_ += shx(s_, 2, lane); s_ += shx(s_, 1, lane); \
        if ((lane & 15) == 0) wl[(g) * 4 + (lane >> 4)] = s_; } while (0)
#endif
#define PG6_AXPY(buf, g) do { _Pragma("unroll") for (int i_ = 0; i_ < PG6_R; ++i_) { const float w_ = wl[(g) * PG6_R + i_]; const f32x2 wv_ = {w_, w_}; \
        const v32f f_ = __builtin_amdgcn_cvt_scalef32_pk32_f32_fp6(buf[i_], 1.0f); _Pragma("unroll") for (int c_ = 0; c_ < 16; ++c_) y[c_] += (f32x2){f_[2 * c_], f_[2 * c_ + 1]} * wv_; __builtin_amdgcn_sched_barrier(0); } } while (0)
__device__ __forceinline__ unsigned shxu(unsigned v, int k, int lane) { return (unsigned)__builtin_amdgcn_ds_bpermute((lane ^ k) << 2, (int)v); }
__device__ __forceinline__ void wave_sort128(unsigned& a, unsigned& b, int lane) {
#pragma unroll
    for (int k = 2; k <= 128; k <<= 1) {
#pragma unroll
        for (int j = k >> 1; j > 0; j >>= 1) {
            if (j == 64) { const unsigned lo = a < b ? a : b, hi = a < b ? b : a; a = lo; b = hi; }
            else {
                const unsigned pa = shxu(a, j, lane), pb = shxu(b, j, lane);
                const bool lower = (lane & j) == 0;
                const bool asc_a = (lane & k) == 0, asc_b = ((lane + 64) & k) == 0;
                const bool take_min_a = (lower == asc_a), take_min_b = (lower == asc_b);
                a = take_min_a ? (a < pa ? a : pa) : (a < pa ? pa : a);
                b = take_min_b ? (b < pb ? b : pb) : (b < pb ? pb : b);
            }
        }
    }
}
#ifndef PEER_U_FP4
#define PEER_U_FP4 1
#endif
#if PEER_U_FP4
typedef v4u urow_t;
#define PGU_LOAD PG4_LOAD
#define PGU_DOT PG4_DOT
constexpr float PU_SCALE = PU_SCALE4; constexpr int PU_STRIDE = 1024;
#else
typedef v6u urow_t;
#define PGU_LOAD PG6_LOAD
#define PGU_DOT PG6_DOT
constexpr float PU_SCALE = PU_SCALE6; constexpr int PU_STRIDE = 1536;
#endif
constexpr float PU_SCALEI = 135.0f, PX_SCALEI = 20.0f;
__device__ __forceinline__ void peer_v_pass(bf16* XN, const unsigned char* PV6, const int* PIDX, const float* PGATE, const int* PARTI, float* X, u64_t* rowsq_out, unsigned char* XN8, float* xsc, const u64_t* rowsq1, const u64_t* rowsq2, LAS float* wl, int gw, int NGW, int lane) {
    const unsigned voff4 = 16u * (unsigned)lane, l4 = 4u * (unsigned)lane, l8 = 8u * (unsigned)lane, l16 = 16u * (unsigned)lane;
    constexpr int NG = 128 / PG6_R;
    const __amdgpu_buffer_rsrc_t PVr = __builtin_amdgcn_make_buffer_rsrc((void*)PV6, 0, PEER_N * 1024, 0x00020000);
    int pid0 = 0, pid1 = 0, pp[16]; float pg0 = 0.f, pg1 = 0.f; u64_t prq1 = 0, prq2 = 0; unsigned zv_ = 0u; asm volatile("" : "+v"(zv_));
#pragma unroll
    for (int i = 0; i < 16; ++i) pp[i] = 0;
#define VP_PREF(tt_) do { const char* pi_ = (const char*)(PIDX + (size_t)(tt_) * 128); const char* pg_ = (const char*)(PGATE + (size_t)(tt_) * 128); \
        pid0 = *(const GAS int*)(pi_ + l4); pid1 = *(const GAS int*)(pi_ + l4 + 256); pg0 = *(const GAS float*)(pg_ + l4); pg1 = *(const GAS float*)(pg_ + l4 + 256); \
        _Pragma("unroll") for (int sp = 0; sp < 8; ++sp) { const char* q_ = (const char*)(PARTI + ((size_t)sp * T + (tt_)) * 128); pp[2 * sp] = *(const GAS int*)(q_ + l4); pp[2 * sp + 1] = *(const GAS int*)(q_ + l4 + 256); } \
        prq1 = *(const GAS u64_t*)((const char*)(rowsq1 + (tt_)) + zv_); prq2 = *(const GAS u64_t*)((const char*)(rowsq2 + (tt_)) + zv_); } while (0)
    v4u AV[PG6_R], BV[PG6_R];
    if (gw < T) { int t0 = gw; asm volatile("" : "+s"(t0)); VP_PREF(t0); PG4_LOAD(AV, PVr, pid0, pid1, 0); }
    for (int t_ = gw; t_ < T; t_ += NGW) {
        int t = t_; asm volatile("" : "+s"(t));
        const char* idb_ = (const char*)(PIDX + (size_t)t * 128); v8i_ idn;
        PG4_SL(idn, idb_, 1);
        {
            const int s0 = ((pp[0] + pp[2]) + (pp[4] + pp[6])) + ((pp[8] + pp[10]) + (pp[12] + pp[14])), s1 = ((pp[1] + pp[3]) + (pp[5] + pp[7])) + ((pp[9] + pp[11]) + (pp[13] + pp[15]));
            const float rs1 = 1.0f / sqrtf((float)prq1 * (5.9604644775390625e-08f / 2048.0f) + 1e-6f), rs2 = 1.0f / sqrtf((float)prq2 * (5.9604644775390625e-08f / 2048.0f) + 1e-6f);
            const float sct = (6.0f / 127.0f / PU_SCALEI) * rs2 / rs1;
            const float d0 = (float)s0 * sct, d1 = (float)s1 * sct;
            const float w0 = pg0 * 0.5f * d0 * (1.f + erff(d0 * 0.70710678118654752f)) * (1.f / PV_SCALE4), w1 = pg1 * 0.5f * d1 * (1.f + erff(d1 * 0.70710678118654752f)) * (1.f / PV_SCALE4);
            wl[lane] = w0; wl[64 + lane] = w1;
            LDS_WAIT(); asm volatile("" ::: "memory");
        }
        f32x2 y[16];
#pragma unroll
        for (int i = 0; i < 16; ++i) y[i] = (f32x2){0.f, 0.f};
        v2u xr[8];
        PG4_LOADS(BV, PVr, idn); PG4_SL(idn, idb_, 2);
        PG4_AXPY(AV, 0);
        {   int tn = (t_ + NGW < T) ? t_ + NGW : t_; asm volatile("" : "+s"(tn)); VP_PREF(tn);
            const char* xb_ = (const char*)(XN + (size_t)t * DM);
#pragma unroll
            for (int j = 0; j < 8; ++j) xr[j] = *(const GAS v2u*)(xb_ + l8 + 512 * j); }
        PG4_LOADS(AV, PVr, idn); PG4_SL(idn, idb_, 3);
        PG4_AXPY(BV, 1);
#pragma unroll 1
        for (int g = 2; g < NG - 2; g += 2) {
            PG4_LOADS(BV, PVr, idn); PG4_SL(idn, idb_, g + 2);
            PG4_AXPY(AV, g);
            PG4_LOADS(AV, PVr, idn); PG4_SL(idn, idb_, g + 3);
            PG4_AXPY(BV, g + 1);
        }
        PG4_LOADS(BV, PVr, idn);
        PG4_AXPY(AV, NG - 2);
        PG4_LOAD(AV, PVr, pid0, pid1, 0);
        PG4_AXPY(BV, NG - 1);
        {   char* xo = (char*)(X + (size_t)t * DM);
            char* xbo = (char*)(XN + (size_t)t * DM); float ss = 0.f;
#pragma unroll
            for (int j = 0; j < 8; ++j) { const v2u a = xr[j]; f32x4 v = (f32x4){bflo(a.x), bfhi(a.x), bflo(a.y), bfhi(a.y)}; v += (f32x4){y[2 * j].x, y[2 * j].y, y[2 * j + 1].x, y[2 * j + 1].y};
                if (X) *(GAS f32x4*)(xo + l16 + 1024 * j) = v;
                y[2 * j] = (f32x2){v[0], v[1]}; y[2 * j + 1] = (f32x2){v[2], v[3]};
                ss += (v[0] * v[0] + v[1] * v[1]) + (v[2] * v[2] + v[3] * v[3]); if (!X) *(GAS v2u*)(xbo + l8 + 512 * j) = (v2u){pk2(v[0], v[1]), pk2(v[2], v[3])}; }
            if (rowsq_out) { ss = wave_sum(ss, lane); if (lane == 0) rowsq_out[t] = rowsq_fx(ss); }
            if (XN8) {
                float am = 0.f;
#pragma unroll
                for (int j = 0; j < 16; ++j) am = fmaxf(am, fmaxf(fabsf(y[j].x), fabsf(y[j].y)));
                am = fmaxf(wave_max(am, lane), 1e-30f);
                const float inv = 127.f / am; char* qo = (char*)(XN8 + (size_t)t * DM);
#pragma unroll
                for (int j = 0; j < 8; ++j) *(GAS unsigned*)(qo + l4 + 256 * j) = q8x4((f32x4){y[2 * j].x, y[2 * j].y, y[2 * j + 1].x, y[2 * j + 1].y}, inv);
                if (lane == 0) xsc[t] = am * (1.f / 127.f) / sqrtf(ss * (1.f / DM) + 1e-6f); } }
        LDS_WAIT(); asm volatile("" ::: "memory");
    }
}


__device__ __forceinline__ unsigned enc_i4(float v) { int q = (int)__builtin_rintf(v); q = q < -7 ? -7 : (q > 7 ? 7 : q); return (unsigned)q & 15u; }
__device__ __forceinline__ void convert_int4_plain(const float* src, unsigned char* dst, int nrows, float scale, const float* gain, int gw, int NGW, int lane) {
    for (int l = 0; l < nrows / PEER_N; ++l) {
        f32x4 g[8];
#pragma unroll
        for (int j = 0; j < 8; ++j) g[j] = *(const GAS f32x4*)(gain + (size_t)l * DM + 4 * lane + 256 * j) * scale;
        for (int r0 = 2 * gw; r0 < PEER_N; r0 += 2 * NGW) {
            f32x4 a[2][8];
#pragma unroll
            for (int q = 0; q < 2; ++q) { const float* sp = src + ((size_t)l * PEER_N + r0 + q) * DM + 4 * lane;
#pragma unroll
                for (int j = 0; j < 8; ++j) a[q][j] = *(const GAS f32x4*)(sp + 256 * j); }
#pragma unroll
            for (int q = 0; q < 2; ++q) { const size_t r = (size_t)l * PEER_N + r0 + q;
#pragma unroll
                for (int j = 0; j < 8; ++j) { const f32x4 v = a[q][j] * g[j];
                    const unsigned w = enc_i4(v[0]) | (enc_i4(v[1]) << 4) | (enc_i4(v[2]) << 8) | (enc_i4(v[3]) << 12);
                    *(GAS unsigned short*)(dst + r * 1024 + 128 * j + 2 * lane) = (unsigned short)w; } }
        }
    }
}
__device__ __forceinline__ void peer_xquant_unit(const bf16* XN, const u64_t* rowsq, unsigned* XQH, unsigned* XQL, int tb, int sl, int tid) {
    for (int it = tid; it < 256 * 32; it += NTHREADS) {
        const int t = tb * 256 + (it >> 5), c8 = it & 31;
        const float xs = PX_SCALEI * rowsq_rs(rowsq, t);
        const v4u w = *(const GAS v4u*)(XN + (size_t)t * DM + 256 * sl + 8 * c8);
        const float f[8] = {bflo(w.x), bfhi(w.x), bflo(w.y), bfhi(w.y), bflo(w.z), bfhi(w.z), bflo(w.w), bfhi(w.w)};
        unsigned hi = 0u, lo = 0u;
#pragma unroll
        for (int j = 0; j < 8; ++j) { int q = (int)__builtin_rintf(f[j] * xs); q = q < -119 ? -119 : (q > 119 ? 119 : q);
            const int xl = ((q + 8) & 15) - 8, xh = (q - xl) >> 4;
            hi |= ((unsigned)xh & 15u) << (4 * j); lo |= ((unsigned)xl & 15u) << (4 * j); }
        XQH[(size_t)t * 256 + 32 * sl + c8] = hi; XQL[(size_t)t * 256 + 32 * sl + c8] = lo;
    }
}
#define PI_LOADROWS(buf, tab, ids, i0) do { _Pragma("unroll") for (int i_ = 0; i_ < 8; ++i_) buf[i_] = __builtin_amdgcn_raw_buffer_load_b128(tab, ids[(i0) + i_] * 1024 + (int)soff, 0, 0); } while (0)
#define PI_LOADIDS(ids, t) do { const char* ip_ = (const char*)PIDX + ((size_t)(t) * 128 + 16 * g) * 4; _Pragma("unroll") for (int c_ = 0; c_ < 4; ++c_) { const v4u q_ = *(const GAS v4u*)(ip_ + 16 * c_); \
        ids[4 * c_] = (int)q_.x; ids[4 * c_ + 1] = (int)q_.y; ids[4 * c_ + 2] = (int)q_.z; ids[4 * c_ + 3] = (int)q_.w; } } while (0)
#define PI_UGROUP(buf, i0) do { _Pragma("unroll") for (int i_ = 0; i_ < 8; ++i_) { int ah_ = 0, al_ = 0; \
        _Pragma("unroll") for (int c_ = 0; c_ < 4; ++c_) { ah_ = __builtin_amdgcn_sdot8((int)buf[i_][c_], (int)xh[c_], ah_, false); al_ = __builtin_amdgcn_sdot8((int)buf[i_][c_], (int)xl[c_], al_, false); } \
        int p_ = 16 * ah_ + al_; p_ += __builtin_amdgcn_ds_bpermute((lane ^ 1) << 2, p_); p_ += __builtin_amdgcn_ds_bpermute((lane ^ 2) << 2, p_); p_ += __builtin_amdgcn_ds_bpermute((lane ^ 4) << 2, p_); \
        if (m == (((i0) + i_) >> 1)) { if (((i0) + i_) & 1) keep1 = p_; else keep0 = p_; } } } while (0)
#define PI_LOADROWS16(buf, tab, ids) do { _Pragma("unroll") for (int i_ = 0; i_ < 16; ++i_) buf[i_] = __builtin_amdgcn_raw_buffer_load_b128(tab, ids[i_] * 1024 + (int)soff, 0, 0); } while (0)
#define PI_LOADX(xh_, xl_, t) do { xh_ = *(const GAS v4u*)((const char*)XQH + (size_t)(t) * 1024 + soff); xl_ = *(const GAS v4u*)((const char*)XQL + (size_t)(t) * 1024 + soff); } while (0)
#define PI_HM_ADD(dst, src, bm) asm volatile("s_nop 1\n\tv_add_u32_dpp %0, %1, %1 row_half_mirror row_mask:0xf bank_mask:" bm : "+v"(dst) : "v"(src))
#define PI_COMPUTE16(buf, xh_, xl_, t) do { int p_[16]; \
        _Pragma("unroll") for (int i_ = 0; i_ < 16; ++i_) { int ah_ = 0, al_ = 0; \
            _Pragma("unroll") for (int c_ = 0; c_ < 4; ++c_) { ah_ = __builtin_amdgcn_sdot8((int)buf[i_][c_], (int)xh_[c_], ah_, false); al_ = __builtin_amdgcn_sdot8((int)buf[i_][c_], (int)xl_[c_], al_, false); } \
            p_[i_] = 16 * ah_ + al_; } \
        int q_[8]; \
        _Pragma("unroll") for (int j_ = 0; j_ < 8; ++j_) { q_[j_] = 0; PI_HM_ADD(q_[j_], p_[j_], "0x5"); PI_HM_ADD(q_[j_], p_[j_ + 8], "0xa"); }     \
        int r_[4]; \
        _Pragma("unroll") for (int j_ = 0; j_ < 4; ++j_) { const int keep_ = b1 ? q_[j_ + 4] : q_[j_], send_ = b1 ? q_[j_] : q_[j_ + 4]; r_[j_] = keep_ + __builtin_amdgcn_update_dpp(0, send_, 0x4E, 0xf, 0xf, true); } \
        int s_[2]; \
        _Pragma("unroll") for (int j_ = 0; j_ < 2; ++j_) { const int keep_ = b0 ? r_[j_ + 2] : r_[j_], send_ = b0 ? r_[j_] : r_[j_ + 2]; s_[j_] = keep_ + __builtin_amdgcn_update_dpp(0, send_, 0xB1, 0xf, 0xf, true); } \
        if ((t) < T) *(GAS v2u*)(PARTI + ((size_t)s * T + (t)) * 128 + 2 * lane) = (v2u){(unsigned)s_[0], (unsigned)s_[1]}; } while (0)
__device__ __forceinline__ void peer_u_phase_i4(const unsigned* XQH, const unsigned* XQL, const unsigned char* PU, const int* PIDX, int* PARTI, int bid, int G, int wave, int lane) {
    const int s = bid & 7, nr = (G - s + 7) >> 3, q = (bid >> 3) * NWAVES + wave, stride = nr * NWAVES, g = lane >> 3, m = lane & 7;
    const unsigned soff = 128u * (unsigned)s + 16u * (unsigned)m;
    const bool b0 = (lane & 1) != 0, b1 = (lane & 2) != 0;
    if (q >= T) return;
    const __amdgpu_buffer_rsrc_t PUr = __builtin_amdgcn_make_buffer_rsrc((void*)PU, 0, PEER_N * 1024, 0x00020000);
#define PI_CL(t) ((t) < T ? (t) : T - 1)
    int I1[16], I2[16]; v4u xh0, xl0, xh1, xl1, xh2, xl2, RA[16], RB[16];
    PI_LOADIDS(I1, q); PI_LOADX(xh0, xl0, q);
    PI_LOADROWS16(RA, PUr, I1);
    PI_LOADIDS(I1, PI_CL(q + stride)); PI_LOADX(xh1, xl1, PI_CL(q + stride));
    for (int t = q; t < T; t += 2 * stride) {
        PI_LOADROWS16(RB, PUr, I1);
        PI_LOADIDS(I2, PI_CL(t + 2 * stride)); PI_LOADX(xh2, xl2, PI_CL(t + 2 * stride));
        PI_COMPUTE16(RA, xh0, xl0, t);
        PI_LOADROWS16(RA, PUr, I2);
        PI_LOADIDS(I1, PI_CL(t + 3 * stride)); PI_LOADX(xh0, xl0, PI_CL(t + 3 * stride));
        PI_COMPUTE16(RB, xh1, xl1, t + stride);
        xh1 = xh0; xl1 = xl0; xh0 = xh2; xl0 = xl2;
    }
#undef PI_CL
}


constexpr float PV_SCALE4S = 5.65f;
__device__ __forceinline__ unsigned enc_e2m1s(float v) {
    const float a = fabsf(v);
    const unsigned code = a < 0.25f ? 0u : a < 0.75f ? 1u : a < 1.25f ? 2u : a < 1.75f ? 3u : a < 2.5f ? 4u : a < 3.5f ? 5u : a < 5.0f ? 6u : 7u;
    return code | (v < 0.f ? 8u : 0u);
}
__device__ __forceinline__ void convert_fp4_plain(const float* src, unsigned char* dst, int nrows, float scale, const float* gain, int gw, int NGW, int lane) {
    for (int r0 = 2 * gw; r0 < nrows; r0 += 2 * NGW) {
        f32x4 a[2][8];
#pragma unroll
        for (int q = 0; q < 2; ++q) { const float* sp = src + (size_t)(r0 + q) * DM + 4 * lane;
#pragma unroll
            for (int j = 0; j < 8; ++j) a[q][j] = *(const GAS f32x4*)(sp + 256 * j); }
#pragma unroll
        for (int q = 0; q < 2; ++q) { const int r = r0 + q; const float* gp = gain ? gain + (size_t)(r / PEER_N) * DM + 4 * lane : nullptr;
#pragma unroll
            for (int j = 0; j < 8; ++j) { f32x4 v = a[q][j] * scale; if (gp) v = v * *(const GAS f32x4*)(gp + 256 * j);
                const unsigned w = enc_e2m1s(v[0]) | (enc_e2m1s(v[1]) << 4) | (enc_e2m1s(v[2]) << 8) | (enc_e2m1s(v[3]) << 12);
                *(GAS unsigned short*)(dst + (size_t)r * 1024 + 128 * j + 2 * lane) = (unsigned short)w; } }
    }
}
#define PVS_LOADMETA(ids, pp, gg, t) do { PI_LOADIDS(ids, t); _Pragma("unroll") for (int sp_ = 0; sp_ < 8; ++sp_) pp[sp_] = *(const GAS v2u*)(PARTI + ((size_t)sp_ * T + (t)) * 128 + 2 * lane); \
        gg = *(const GAS f32x2*)(PGATE + (size_t)(t) * 128 + 2 * lane); } while (0)
#define PVS_COMPUTE16(buf, pp, gg, t) do { float w0, w1; { int s0_ = 0, s1_ = 0; _Pragma("unroll") for (int sp_ = 0; sp_ < 8; ++sp_) { s0_ += (int)pp[sp_].x; s1_ += (int)pp[sp_].y; } \
            const float d0_ = (float)s0_ * (1.f / (PX_SCALEI * PU_SCALEI)), d1_ = (float)s1_ * (1.f / (PX_SCALEI * PU_SCALEI)); \
            w0 = gg.x * 0.5f * d0_ * (1.f + erff(d0_ * 0.70710678118654752f)) * (1.f / PV_SCALE4S); w1 = gg.y * 0.5f * d1_ * (1.f + erff(d1_ * 0.70710678118654752f)) * (1.f / PV_SCALE4S); } \
        f32x2 y[16]; _Pragma("unroll") for (int i_ = 0; i_ < 16; ++i_) y[i_] = (f32x2){0.f, 0.f}; \
        _Pragma("unroll") for (int i_ = 0; i_ < 16; ++i_) { \
            const float w_ = __builtin_bit_cast(float, __builtin_amdgcn_ds_bpermute(((lane & 56) | (i_ >> 1)) << 2, __builtin_bit_cast(int, (i_ & 1) ? w1 : w0))); const f32x2 wv_ = {w_, w_}; \
            _Pragma("unroll") for (int c_ = 0; c_ < 4; ++c_) { const unsigned u_ = buf[i_][c_]; \
                y[4 * c_ + 0] += __builtin_amdgcn_cvt_scalef32_pk_f32_fp4(u_, 1.0f, 0) * wv_; y[4 * c_ + 1] += __builtin_amdgcn_cvt_scalef32_pk_f32_fp4(u_, 1.0f, 1) * wv_; \
                y[4 * c_ + 2] += __builtin_amdgcn_cvt_scalef32_pk_f32_fp4(u_, 1.0f, 2) * wv_; y[4 * c_ + 3] += __builtin_amdgcn_cvt_scalef32_pk_f32_fp4(u_, 1.0f, 3) * wv_; } } \
        {   LAS float* wp_ = yl + g * 288 + m * 36; \
            _Pragma("unroll") for (int c_ = 0; c_ < 8; ++c_) *(LAS f32x4*)(wp_ + 4 * c_) = (f32x4){y[2 * c_].x, y[2 * c_].y, y[2 * c_ + 1].x, y[2 * c_ + 1].y}; \
            LDS_WAIT(); asm volatile("" ::: "memory"); \
            f32x4 acc_ = {0.f, 0.f, 0.f, 0.f}; const LAS float* rp_ = yl + (lane >> 3) * 36 + 4 * (lane & 7); \
            _Pragma("unroll") for (int gg_ = 0; gg_ < 8; ++gg_) acc_ += *(const LAS f32x4*)(rp_ + gg_ * 288); \
            LDS_WAIT(); asm volatile("" ::: "memory"); \
            if ((t) < T) { bf16* xp_ = XN + (size_t)(t) * DM + 256 * s + 4 * lane; const v2u a_ = *(const GAS v2u*)xp_; \
                const f32x4 v_ = (f32x4){bflo(a_.x), bfhi(a_.x), bflo(a_.y), bfhi(a_.y)} + acc_; \
                *(GAS v2u*)xp_ = (v2u){pk2(v_[0], v_[1]), pk2(v_[2], v_[3])}; \
                if (Xout) *(GAS f32x4*)(Xout + (size_t)(t) * DM + 256 * s + 4 * lane) = v_; \
                if (rowsq_out) { const float ss_ = wave_sum((v_[0] * v_[0] + v_[1] * v_[1]) + (v_[2] * v_[2] + v_[3] * v_[3]), lane); if (lane == 0) atomicAdd(rowsq_out + (t), rowsq_fx(ss_)); } } } } while (0)
__device__ __forceinline__ void peer_v_phase_s(bf16* XN, const unsigned char* PV, const int* PIDX, const float* PGATE, const int* PARTI, float* Xout, u64_t* rowsq_out, LAS float* yl, int bid, int G, int wave, int lane) {
    const int s = bid & 7, nr = (G - s + 7) >> 3, q = (bid >> 3) * NWAVES + wave, stride = nr * NWAVES, g = lane >> 3, m = lane & 7;
    const unsigned soff = 128u * (unsigned)s + 16u * (unsigned)m;
    const bool b0 = (lane & 1) != 0, b1 = (lane & 2) != 0;
    if (q >= T) return;
    const __amdgpu_buffer_rsrc_t PVr = __builtin_amdgcn_make_buffer_rsrc((void*)PV, 0, PEER_N * 1024, 0x00020000);
#define PVS_CL(t) ((t) < T ? (t) : T - 1)
    int I0[16], I1[16]; v2u P0[8], P1[8]; f32x2 G0, G1; v4u RA[16], RB[16];
#define PVS_LOADPG(pp, gg, t) do { _Pragma("unroll") for (int sp_ = 0; sp_ < 8; ++sp_) pp[sp_] = *(const GAS v2u*)(PARTI + ((size_t)sp_ * T + (t)) * 128 + 2 * lane); gg = *(const GAS f32x2*)(PGATE + (size_t)(t) * 128 + 2 * lane); } while (0)
    PI_LOADIDS(I0, q); PVS_LOADPG(P0, G0, q);
    PI_LOADROWS16(RA, PVr, I0);
    PI_LOADIDS(I1, PVS_CL(q + stride)); PVS_LOADPG(P1, G1, PVS_CL(q + stride));
    for (int t = q; t < T; t += 2 * stride) {
        PI_LOADROWS16(RB, PVr, I1);
        PI_LOADIDS(I0, PVS_CL(t + 2 * stride));
        PVS_COMPUTE16(RA, P0, G0, t);
        PVS_LOADPG(P0, G0, PVS_CL(t + 2 * stride));
        PI_LOADROWS16(RA, PVr, I0);
        PI_LOADIDS(I1, PVS_CL(t + 3 * stride));
        PVS_COMPUTE16(RB, P1, G1, t + stride);
        PVS_LOADPG(P1, G1, PVS_CL(t + 3 * stride));
    }
#undef PVS_LOADPG
#undef PVS_CL
}

typedef short s16x4 __attribute__((ext_vector_type(4)));
typedef __attribute__((address_space(3))) const char* lds_cptr;
__device__ __forceinline__ s16x4 vtr(lds_cptr p) { return __builtin_bit_cast(s16x4, __builtin_amdgcn_ds_read_tr16_b64_v4i16((__attribute__((address_space(3))) s16x4*)p)); }
__device__ __forceinline__ unsigned cvtpk(float lo, float hi) { unsigned r; asm("v_cvt_pk_bf16_f32 %0, %1, %2" : "=v"(r) : "v"(lo), "v"(hi)); return r; }
constexpr int AS_STAGE = 65536, AS_V = 32768, AT_TAB = LDSCTL_OFF + 2048;
constexpr float LOG2E = 1.4426950408889634f;
__device__ __forceinline__ void at_dma16(const char* sbase, unsigned voff, unsigned ldsaddr) {
    asm volatile("s_mov_b32 m0, %2\n\ts_nop 0\n\tglobal_load_lds_dwordx4 %0, %1" :: "v"(voff), "s"(sbase), "s"(ldsaddr) : "memory");
}
__device__ __forceinline__ void store_o_block32(bf16* base16, const f32x16& O, float inv, int hh) {
    char* bp = (char*)base16 + (hh ? 16 : 0);
#pragma unroll
    for (int p = 0; p < 2; ++p) {
        unsigned ax = cvtpk(O[8 * p] * inv, O[8 * p + 1] * inv), ay = cvtpk(O[8 * p + 2] * inv, O[8 * p + 3] * inv);
        unsigned bx = cvtpk(O[8 * p + 4] * inv, O[8 * p + 5] * inv), by = cvtpk(O[8 * p + 6] * inv, O[8 * p + 7] * inv);
        const auto rx = __builtin_amdgcn_permlane32_swap(ax, bx, false, false), ry = __builtin_amdgcn_permlane32_swap(ay, by, false, false);
        *(GAS v4u*)(bp + 32 * p) = (v4u){rx[0], ry[0], rx[1], ry[1]};
    }
}
template <int TYPE>
__device__ __forceinline__ void attn_unit(LAS unsigned char* lds, const bf16* QKV, bf16* ATT, u64_t* mixsq, int b, int head, int qb, const float* tabsrc, float Cl2, float sinkl2, int tid) {
    const int lane = tid & 63, w = __builtin_amdgcn_readfirstlane(tid >> 6), hh = lane >> 5, l31 = lane & 31;
    int qcol, kcol, vcol, ocol;
    if (TYPE == 0) { qcol = QA + head * 64; kcol = KA + (head / 3) * 64; vcol = VA + (head / 3) * 64; ocol = OA + head * 64; }
    else if (TYPE == 1) { qcol = QB + head * 64; kcol = KB + head * 64; vcol = VB + head * 64; ocol = OB + head * 64; }
    else { qcol = QC + head * 64; kcol = KC + (head / 3) * 64; vcol = VC + (head / 3) * 64; ocol = OC + head * 64; }
    const int q0 = 256 * qb + 32 * w, qpos = q0 + l31;
    int t_begin, t_end;
    if (TYPE == 0) { t_begin = 4 * qb - 2; if (t_begin < 0) t_begin = 0; t_end = 4 * qb + 6; if (t_end > 32) t_end = 32; }
    else if (TYPE == 1) { int a = 4 * qb - 4; a = a < 0 ? 0 : (a > 24 ? 24 : a); int e = 4 * qb - 1; e = e < 0 ? 0 : (e > 24 ? 24 : e); t_begin = a; t_end = e + 8; }
    else { t_begin = 0; t_end = 32; }
    LAS float* tab = (LAS float*)(lds + AT_TAB);
    bf16x8 qf[4];
    {   const bf16* qp = QKV + ((size_t)b * SEQ + qpos) * DIN + qcol + 8 * hh;
#pragma unroll
        for (int s = 0; s < 4; ++s) qf[s] = *(const GAS bf16x8*)(qp + 16 * s); }
    const int drow = 8 * w + (lane >> 3), dsl = lane & 7;
    const unsigned koff = (unsigned)((drow * DIN + kcol + ((dsl ^ ((drow >> 1) & 7)) * 8)) * 2);
    const unsigned voff = (unsigned)((drow * DIN + vcol + (((((dsl >> 2) ^ ((drow >> 1) & 1)) << 2) | (dsl & 3)) * 8)) * 2);
    const char* gbp = (const char*)(QKV + (size_t)b * SEQ * DIN);
    const unsigned ldsb = (unsigned)(size_t)lds + (unsigned)w * 1024u;
#define AT_STAGE(sbuf, t0_) do { _Pragma("unroll") for (int i_ = 0; i_ < 4; ++i_) { const int tl_ = (t0_) + i_; if (tl_ < t_end) { \
        at_dma16(gbp + (size_t)tl_ * (64 * DIN * 2), koff, ldsb + (sbuf) * AS_STAGE + i_ * 8192); at_dma16(gbp + (size_t)tl_ * (64 * DIN * 2), voff, ldsb + (sbuf) * AS_STAGE + AS_V + i_ * 8192); } } } while (0)
    int kread[4], vread[2];
#pragma unroll
    for (int s = 0; s < 4; ++s) kread[s] = l31 * 128 + (((2 * s + hh) ^ ((lane >> 1) & 7)) * 16);
#pragma unroll
    for (int db = 0; db < 2; ++db) vread[db] = (4 * hh + ((lane >> 2) & 3)) * 128 + ((db ^ ((lane >> 3) & 1)) * 64) + 32 * ((lane >> 4) & 1) + 8 * (lane & 3);
    f32x16 O0, O1;
#pragma unroll
    for (int r = 0; r < 16; ++r) { O0[r] = 0.f; O1[r] = 0.f; }
    float lsum = 0.f;
    const int rw = 4 * qb + (w >> 1), cq = 32 * (w & 1) + l31;
    int r0w = rw - 4; r0w = r0w < 0 ? 0 : (r0w > 24 ? 24 : r0w);
    int c0 = cq - 8; c0 = c0 < 0 ? 0 : (c0 > 48 ? 48 : c0);
    const int nst = (t_end - t_begin + 3) >> 2;
    AT_STAGE(0, t_begin);
    if (TYPE == 0) { for (int i = tid; i < 1024; i += NTHREADS) { const int rel = i - 448; tab[i] = (rel >= -128 && rel <= 128) ? tabsrc[head * 257 + rel + 128] * LOG2E - Cl2 : -1e30f; } }
    if (TYPE == 1) { for (int i = tid; i < 15 * 31; i += NTHREADS) tab[i] = tabsrc[head * 465 + i] * LOG2E - Cl2; }
#pragma unroll
    for (int s = 0; s < 4; ++s) asm volatile("" : "+v"(qf[s]));
    VM_WAIT(); __syncthreads();
    bf16x8 kf[8];
#pragma unroll 1
    for (int st = 0; st < nst; ++st) {
        const int t0 = t_begin + 4 * st;
        if (st + 1 < nst) AT_STAGE((st + 1) & 1, t0 + 4);
        bool havek = false;
#pragma unroll 1
      for (int ti = 0; ti < 4; ++ti) {
        const int t = t0 + ti; if (t >= t_end) break;
        bool need = true;
        if (TYPE == 0) need = (64 * t <= q0 + 31 + 128) && (64 * t + 63 >= q0 - 128);
        if (TYPE == 1) need = (t >= r0w) && (t < r0w + 8);
        if (need) {
            const lds_cptr kb_ = (lds_cptr)(lds + (st & 1) * AS_STAGE + ti * 8192), vb_ = (lds_cptr)(lds + (st & 1) * AS_STAGE + AS_V + ti * 8192);
            if (!havek) {
#pragma unroll
                for (int s = 0; s < 4; ++s) { kf[2 * s] = *(const LAS bf16x8*)(kb_ + kread[s]); kf[2 * s + 1] = *(const LAS bf16x8*)(kb_ + kread[s] + 4096); } }
            f32x16 S0, S1;
            if (TYPE == 2) {
#pragma unroll
                for (int r = 0; r < 16; ++r) { S0[r] = -Cl2; S1[r] = -Cl2; }
            } else if (TYPE == 0) {
                const LAS float* tb = tab + (64 * t - qpos + 448 + 4 * hh);
#pragma unroll
                for (int r = 0; r < 16; ++r) { S0[r] = tb[8 * (r >> 2) + (r & 3)]; S1[r] = tb[32 + 8 * (r >> 2) + (r & 3)]; }
            } else {
                const LAS float* tb = tab + ((t - rw + 7) * 31 - cq + 15 + 4 * hh);
                const int kc0 = 4 * hh - c0;
#pragma unroll
                for (int r = 0; r < 16; ++r) { const int ka = 8 * (r >> 2) + (r & 3), kb2 = 32 + ka;
                    const float t0_ = tb[ka], t1_ = tb[kb2];
                    S0[r] = ((unsigned)(ka + kc0) < 16u) ? t0_ : -1e30f; S1[r] = ((unsigned)(kb2 + kc0) < 16u) ? t1_ : -1e30f; }
            }
            __builtin_amdgcn_sched_barrier(0);
#define AT_SB __builtin_amdgcn_sched_barrier(0)
#define AT_SOFTH(SX, base, pa, j0) do { _Pragma("unroll") for (int r = (base); r < (base) + 4; ++r) SX[r] = __builtin_amdgcn_exp2f(SX[r]); \
            lsum += (SX[(base)] + SX[(base) + 1]) + (SX[(base) + 2] + SX[(base) + 3]); \
            pa[(j0)] = cvtpk(SX[(base)], SX[(base) + 1]); pa[(j0) + 1] = cvtpk(SX[(base) + 2], SX[(base) + 3]); } while (0)
#define AT_QK1(i) S1 = __builtin_amdgcn_mfma_f32_32x32x16_bf16(kf[2 * (i) + 1], qf[i], S1, 0, 0, 0)
#pragma unroll
            for (int s = 0; s < 4; ++s) S0 = __builtin_amdgcn_mfma_f32_32x32x16_bf16(kf[2 * s], qf[s], S0, 0, 0, 0);
            s16x4 vf[4][2][2];
#pragma unroll
            for (int ks = 0; ks < 2; ++ks)
#pragma unroll
                for (int db = 0; db < 2; ++db) { vf[ks][db][0] = vtr(vb_ + vread[db] + (16 * ks) * 128); vf[ks][db][1] = vtr(vb_ + vread[db] + (16 * ks + 8) * 128); }
            v4u pa0, pa1, pa2, pa3;
            AT_QK1(0); AT_SB; AT_SOFTH(S0, 0, pa0, 0); AT_SB;
            AT_QK1(1); AT_SB; AT_SOFTH(S0, 4, pa0, 2); AT_SB;
            AT_QK1(2); AT_SB; AT_SOFTH(S0, 8, pa1, 0); AT_SB;
            AT_QK1(3); AT_SB; AT_SOFTH(S0, 12, pa1, 2); AT_SB;
            asm volatile("s_waitcnt lgkmcnt(7)" ::: "memory");
#pragma unroll
            for (int ks = 2; ks < 4; ++ks)
#pragma unroll
                for (int db = 0; db < 2; ++db) { vf[ks][db][0] = vtr(vb_ + vread[db] + (16 * ks) * 128); vf[ks][db][1] = vtr(vb_ + vread[db] + (16 * ks + 8) * 128); }
            AT_SB;
#define AT_PVA(ks, pa) O0 = __builtin_amdgcn_mfma_f32_32x32x16_bf16(__builtin_shufflevector(vf[ks][0][0], vf[ks][0][1], 0, 1, 2, 3, 4, 5, 6, 7), __builtin_bit_cast(bf16x8, pa), O0, 0, 0, 0)
#define AT_PVB(ks, pa) O1 = __builtin_amdgcn_mfma_f32_32x32x16_bf16(__builtin_shufflevector(vf[ks][1][0], vf[ks][1][1], 0, 1, 2, 3, 4, 5, 6, 7), __builtin_bit_cast(bf16x8, pa), O1, 0, 0, 0)
            AT_PVA(0, pa0); AT_SB; AT_SOFTH(S1, 0, pa2, 0); AT_SB;
            AT_PVB(0, pa0); AT_SB; AT_SOFTH(S1, 4, pa2, 2); AT_SB;
            AT_PVA(1, pa1); AT_SB; AT_SOFTH(S1, 8, pa3, 0); AT_SB;
            AT_PVB(1, pa1); AT_SB; AT_SOFTH(S1, 12, pa3, 2); AT_SB;
            havek = (ti < 3) && (t + 1 < t_end);
            if (havek) { asm volatile("s_waitcnt lgkmcnt(7)" ::: "memory");
#pragma unroll
                for (int s = 0; s < 4; ++s) { kf[2 * s] = *(const LAS bf16x8*)(kb_ + 8192 + kread[s]); kf[2 * s + 1] = *(const LAS bf16x8*)(kb_ + 8192 + kread[s] + 4096); } }
            AT_SB;
            AT_PVA(2, pa2); AT_PVB(2, pa2); AT_PVA(3, pa3); AT_PVB(3, pa3);
#undef AT_PVA
#undef AT_PVB
#undef AT_QK1
#undef AT_SOFTH
#undef AT_SB
        } else havek = false;
      }
        VM_WAIT(); __syncthreads();
    }
    lsum += shx(lsum, 32, lane);
    if (TYPE == 0) lsum += __builtin_amdgcn_exp2f(sinkl2 - Cl2);
    const float inv = 1.f / lsum;
    {   float ss = 0.f;
#pragma unroll
        for (int r = 0; r < 16; ++r) { const float a = O0[r] * inv, c = O1[r] * inv; ss += a * a + c * c; }
        ss += shx(ss, 32, lane);
        if (hh == 0) (void)__hip_atomic_fetch_add((GAS u64_t*)(mixsq + (size_t)b * SEQ + qpos), rowsq_fx(ss), __ATOMIC_RELAXED, __HIP_MEMORY_SCOPE_AGENT); }
    bf16* op = ATT + ((size_t)b * SEQ + qpos) * DM + ocol;
    store_o_block32(op, O0, inv, hh); store_o_block32(op + 32, O1, inv, hh);
}


constexpr int MA_K0 = 0, MA_V0 = 32768;
template <int MODE = 0>
__device__ __forceinline__ void mem_unit(LAS unsigned char* lds, const bf16* QM, const bf16* KVM, bf16* OM, const float* gq, int tb, int head, float Cl2, int tid) {
    const int lane = tid & 63, w = __builtin_amdgcn_readfirstlane(tid >> 6), hh = lane >> 5, l31 = lane & 31;
    const size_t trow = (size_t)tb * 256 + 32 * w + l31; const int b = tb >> 3;
    __syncthreads();
    bf16x8 qf[8];
    {   const bf16* qp = QM + trow * MEMW + head * 128 + 8 * hh; const bf16* src = KVM + (size_t)b * NMEM * 1024 + head * 128;
        {   v4u stK[8];
#pragma unroll
            for (int s = 0; s < 8; ++s) qf[s] = *(const GAS bf16x8*)(qp + 16 * s);
            if (MODE != 1) {
#pragma unroll
                for (int i = 0; i < 8; ++i) { const int c = tid + 512 * i, row = c >> 4, ch = c & 15; stK[i] = *(const GAS v4u*)(src + (size_t)row * 1024 + ch * 8); }
#pragma unroll
                for (int i = 0; i < 8; ++i) { const int c = tid + 512 * i, row = c >> 4, ch = c & 15; *(LAS v4u*)(lds + row * 256 + ((ch ^ (row & 15)) * 16)) = stK[i]; } }
        }
        __builtin_amdgcn_sched_barrier(0);
        f32x4 gg[16]; v4u stV[8];
#pragma unroll
        for (int s = 0; s < 8; ++s) { gg[2 * s] = *(const GAS f32x4*)(gq + 16 * s + 8 * hh); gg[2 * s + 1] = *(const GAS f32x4*)(gq + 16 * s + 8 * hh + 4); }
        if (MODE != 1) {
#pragma unroll
            for (int i = 0; i < 8; ++i) { const int c = tid + 512 * i, row = c >> 4, ch = c & 15; stV[i] = *(const GAS v4u*)(src + (size_t)row * 1024 + 512 + ch * 8); } }
        __builtin_amdgcn_sched_barrier(0);
        float ss = 0.f;
#pragma unroll
        for (int s = 0; s < 8; ++s)
#pragma unroll
            for (int j = 0; j < 8; ++j) { const float f = __builtin_bit_cast(float, (unsigned)(unsigned short)qf[s][j] << 16); ss += f * f; }
        ss += shx(ss, 32, lane);
        const float r = 0.12751743074602468f / sqrtf(ss * (1.f / 128.f) + EPS);
#pragma unroll
        for (int s = 0; s < 8; ++s) { const f32x4 g0 = gg[2 * s], g1 = gg[2 * s + 1];
            v4u o;
#pragma unroll
            for (int j = 0; j < 4; ++j) { const float f0 = __builtin_bit_cast(float, (unsigned)(unsigned short)qf[s][2 * j] << 16), f1 = __builtin_bit_cast(float, (unsigned)(unsigned short)qf[s][2 * j + 1] << 16);
                const float ga = (2 * j < 4) ? g0[2 * j] : g1[2 * j - 4], gb2 = (2 * j + 1 < 4) ? g0[2 * j + 1] : g1[2 * j + 1 - 4];
                o[j] = cvtpk(f0 * r * ga, f1 * r * gb2); }
            qf[s] = __builtin_bit_cast(bf16x8, o); }
        if (MODE != 1) {
#pragma unroll
            for (int i = 0; i < 8; ++i) { const int c = tid + 512 * i, row = c >> 4, ch = c & 15; *(LAS v4u*)(lds + 65536 + row * 256 + (((ch >> 2) ^ (row & 3)) * 64) + (ch & 3) * 16) = stV[i]; } }
        __builtin_amdgcn_sched_barrier(0);
    }
    int kread[8], vread[4];
#pragma unroll
    for (int s = 0; s < 8; ++s) kread[s] = l31 * 256 + (((2 * s + hh) ^ (l31 & 15)) * 16);
#pragma unroll
    for (int db = 0; db < 4; ++db) vread[db] = 65536 + (4 * hh + ((lane >> 2) & 3)) * 256 + ((db ^ ((lane >> 2) & 3)) * 64) + 32 * ((lane >> 4) & 1) + 8 * (lane & 3);
    f32x16 O[4];
#pragma unroll
    for (int db = 0; db < 4; ++db)
#pragma unroll
        for (int r = 0; r < 16; ++r) O[db][r] = 0.f;
    float lsum = 0.f;
    __syncthreads();
#define MA_SB __builtin_amdgcn_sched_barrier(0)
#define MA_LW(n) asm volatile("s_waitcnt lgkmcnt(" #n ")" ::: "memory")
#pragma unroll 1
    for (int t = 0; t < (MODE ? 0 : 4); ++t) {
        const lds_cptr kb_ = (lds_cptr)(lds + t * 16384), vb_ = (lds_cptr)(lds + t * 16384);
        f32x16 S0, S1;
#pragma unroll
        for (int r = 0; r < 16; ++r) { S0[r] = -Cl2; S1[r] = -Cl2; }
        bf16x8 a0[8], a1[4];
#pragma unroll
        for (int s = 0; s < 8; ++s) a0[s] = *(const LAS bf16x8*)(kb_ + kread[s]);
        MA_SB;
#pragma unroll
        for (int s = 0; s < 4; ++s) S0 = __builtin_amdgcn_mfma_f32_32x32x16_bf16(a0[s], qf[s], S0, 0, 0, 0);
        MA_SB;
#pragma unroll
        for (int s = 0; s < 4; ++s) a1[s] = *(const LAS bf16x8*)(kb_ + kread[s] + 8192);
        MA_SB;
#pragma unroll
        for (int s = 4; s < 8; ++s) S0 = __builtin_amdgcn_mfma_f32_32x32x16_bf16(a0[s], qf[s], S0, 0, 0, 0);
        MA_SB;
#pragma unroll
        for (int s = 0; s < 4; ++s) a0[s] = *(const LAS bf16x8*)(kb_ + kread[4 + s] + 8192);
        MA_SB;
#pragma unroll
        for (int s = 0; s < 4; ++s) S1 = __builtin_amdgcn_mfma_f32_32x32x16_bf16(a1[s], qf[s], S1, 0, 0, 0);
#pragma unroll
        for (int s = 0; s < 4; ++s) S1 = __builtin_amdgcn_mfma_f32_32x32x16_bf16(a0[s], qf[4 + s], S1, 0, 0, 0);
        MA_SB;
        s16x4 vf[2][4][2];
#define MA_VRD(ks) do { _Pragma("unroll") for (int db = 0; db < 4; ++db) { vf[(ks) & 1][db][0] = vtr(vb_ + vread[db] + (16 * (ks)) * 256); vf[(ks) & 1][db][1] = vtr(vb_ + vread[db] + (16 * (ks) + 8) * 256); } } while (0)
#define MA_PV(ks) do { _Pragma("unroll") for (int db = 0; db < 4; ++db) { const bf16x8 va = __builtin_shufflevector(vf[(ks) & 1][db][0], vf[(ks) & 1][db][1], 0, 1, 2, 3, 4, 5, 6, 7); \
            O[db] = __builtin_amdgcn_mfma_f32_32x32x16_bf16(va, pb[ks], O[db], 0, 0, 0); } } while (0)
        MA_VRD(0);
        MA_SB;
#pragma unroll
        for (int r = 0; r < 16; ++r) { S0[r] = __builtin_amdgcn_exp2f(S0[r]); S1[r] = __builtin_amdgcn_exp2f(S1[r]); lsum += S0[r] + S1[r]; }
        bf16x8 pb[4];
#pragma unroll
        for (int hf = 0; hf < 2; ++hf) {
            v4u a, c;
#pragma unroll
            for (int j = 0; j < 4; ++j) { a[j] = cvtpk(S0[8 * hf + 2 * j], S0[8 * hf + 2 * j + 1]); c[j] = cvtpk(S1[8 * hf + 2 * j], S1[8 * hf + 2 * j + 1]); }
            pb[hf] = __builtin_bit_cast(bf16x8, a); pb[2 + hf] = __builtin_bit_cast(bf16x8, c);
        }
        MA_SB;
        MA_LW(7); MA_VRD(1); MA_SB; MA_PV(0); MA_SB;
        MA_LW(7); MA_VRD(2); MA_SB; MA_PV(1); MA_SB;
        MA_LW(7); MA_VRD(3); MA_SB; MA_PV(2); MA_SB;
        MA_PV(3);
        MA_SB;
    }
#undef MA_VRD
#undef MA_PV
#undef MA_SB
#undef MA_LW
    lsum += shx(lsum, 32, lane);
    const float inv = MODE ? 1.f : 1.f / lsum;
    bf16* op = OM + trow * MEMW + head * 128;
#pragma unroll
    for (int db = 0; db < 4; ++db) store_o_block32(op + 32 * db, O[db], inv, hh);
}

struct Args { const float* in[23]; float* out; unsigned char* ws; int ph_lo, ph_hi, use_bar, pad; };
#ifndef MK_OFF
#define MK_OFF 0u
#endif
#ifndef REP_ATT
#define REP_ATT 1
#endif
#ifndef REP_P0
#define REP_P0 1
#endif
#ifndef REP_U
#define REP_U 1
#endif
#ifndef REP_GEMM
#define REP_GEMM 1
#endif
#ifndef REP_NORM
#define REP_NORM 1
#endif
#ifndef REP_SEL
#define REP_SEL 1
#endif
#ifndef REP_MEM
#define REP_MEM 1
#endif
#define PHON(k) (!((MK_OFF >> (k)) & 1u))
#ifndef MK_REP
#define MK_REP 0
#endif
constexpr int PH_PER_LAYER = 9, PH_BASE = 2, N_PHASES = PH_BASE + DEPTH * PH_PER_LAYER;
constexpr int PTAB_OFF = LDSCTL_OFF + 1024;

__global__ void __launch_bounds__(NTHREADS, 2) mega(Args a) {
    extern __shared__ __attribute__((aligned(16))) unsigned char lds_raw[];
    LAS unsigned char* lds = (LAS unsigned char*)lds_raw;
    const int wave0_ = __builtin_amdgcn_readfirstlane((int)threadIdx.x >> 6);
    {   const int tid0 = threadIdx.x;
        for (int u = tid0; u < (LDS_BYTES - LDSCTL_OFF) / 4; u += NTHREADS) ((LAS unsigned*)(lds + LDSCTL_OFF))[u] = 0u;
        __syncthreads();
        if (tid0 < 23) ((LAS unsigned long long*)(lds + PTAB_OFF))[tid0] = (unsigned long long)a.in[tid0];
        if (tid0 == 23) ((LAS unsigned long long*)(lds + PTAB_OFF))[23] = (unsigned long long)a.out;
        if (tid0 == 24) ((LAS unsigned long long*)(lds + PTAB_OFF))[24] = (unsigned long long)a.ws;
        __syncthreads();
    }
    volatile LAS unsigned* MISC = (volatile LAS unsigned*)(lds + MISC_OFF);
    const int G = gridDim.x, bid = blockIdx.x, NGW = G * NWAVES;
    const int use_bar = a.use_bar;
    XcdBarrier bar; bar.bar = (unsigned*)(a.ws + WS_CTL) + CW_BAR; bar.x = 0; bar.st = MISC + 8;
    if (use_bar) bar = xcd_barrier_post((unsigned*)(a.ws + WS_CTL) + CW_BAR, MISC + 8);
    const int lo = a.ph_lo, hi = a.ph_hi;
#define IN(k) (lo <= (k) && (k) < hi)
#define SEAM(k) do { if (use_bar && IN(k) && IN((k) + 1)) xcd_barrier(bar); } while (0)
#define PHL() unsigned z0_ = 0u; asm volatile("" : "+v"(z0_)); int tid_ = wave0_ * 64 + (int)__builtin_amdgcn_mbcnt_hi(~0u, __builtin_amdgcn_mbcnt_lo(~0u, z0_)); asm volatile("" : "+v"(tid_));     const int lane_ = tid_ & 63, wave_ = __builtin_amdgcn_readfirstlane(tid_ >> 6), gw_ = bid * NWAVES + wave_; (void)lane_; (void)gw_; \
              int pz_ = 0; asm volatile("" : "+s"(pz_))
#define PTR(i) ((const float*)ldptr(lds, (i) + pz_))
#define WSP() ((unsigned char*)ldptr(lds, 24 + pz_))
#define OUTP() ((float*)ldptr(lds, 23 + pz_))

    if (IN(0) && PHON(0)) {
        PHL(); unsigned char* ws = WSP();
        {
            LAS float* red = (LAS float*)(lds + LDSCTL_OFF + 2048);
            constexpr int Q_IN = DIN / 32, Q_OUT = DM / 32, Q_PQ = DM / 32, Q_MQ = MEMW / 32, Q_KV = 1024 / 32, Q_L = Q_IN + Q_OUT + Q_PQ + Q_MQ + Q_KV;
#pragma unroll 1
            for (int it = bid; it < DEPTH * Q_L; it += G) { const int l = it / Q_L; int r = it % Q_L;
                if (r < Q_IN) { wq_item<true>(PTR(4) + (size_t)l * DM * DIN, DIN, 32 * r, PTR(3) + (size_t)l * DM, ws + WS_WIN8 + (size_t)l * DIN * DM, (float*)(ws + WS_WSC) + (size_t)l * DIN, lds + RING_OFF, red, tid_); continue; } r -= Q_IN;
                if (r < Q_OUT) { wq_item<false>(PTR(11) + (size_t)l * DM * DM, DM, 32 * r, PTR(10) + (size_t)l * DM, ws + WS_WOUT8 + (size_t)l * DM * DM, (float*)(ws + WS_WSCO) + (size_t)l * DM, lds + RING_OFF, red, tid_); continue; } r -= Q_OUT;
                if (r < Q_PQ) { wq_item<false>(PTR(19) + (size_t)l * DM * DM, DM, 32 * r, PTR(18) + (size_t)l * DM, ws + WS_WPQ8 + (size_t)l * DM * DM, (float*)(ws + WS_WSCP) + (size_t)l * DM, lds + RING_OFF, red, tid_); continue; } r -= Q_PQ;
                if (r < Q_MQ) { wq_item<false>(PTR(14) + (size_t)l * DM * MEMW, MEMW, 32 * r, PTR(12) + (size_t)l * DM, ws + WS_WMQ8 + (size_t)l * MEMW * DM, (float*)(ws + WS_WSCM) + (size_t)l * MEMW, lds + RING_OFF, red, tid_); continue; } r -= Q_MQ;
                wq_item<false>(PTR(15) + (size_t)l * DM * 1024, 1024, 32 * r, nullptr, ws + WS_WMKV + (size_t)l * 1024 * DM, (float*)(ws + WS_WSCKV) + (size_t)l * 1024, lds + RING_OFF, red, tid_); }
        }
        LAS float* scr = (LAS float*)(lds + RING_OFF + wave_ * 16384);
        constexpr int I_MO = 8 * 64, I_L = I_MO;
        for (int it = gw_; it < DEPTH * I_L; it += NGW) {
            const int l = it / I_L; int r = it % I_L;
            transpose_item<false>(PTR(17) + (size_t)l * MEMW * DM, MEMW, DM, (bf16*)(ws + WS_WMO) + (size_t)l * DM * MEMW, scr, r, lane_);
        }
        const size_t gtid = (size_t)bid * NTHREADS + tid_, nth = (size_t)G * NTHREADS;
        {
            GAS v4u* z0 = (GAS v4u*)(ws + WS_MIXSQ); const v4u zz = {0u, 0u, 0u, 0u};
            for (size_t i = gtid; i < (size_t)DEPTH * 3 * T / 2; i += nth) z0[i] = zz;
            for (int l = 0; l < DEPTH; ++l) { GAS v4u* z1 = (GAS v4u*)((u64_t*)(ws + WS_ROWSQ) + (size_t)(l * 3 + 1) * T); for (size_t i = gtid; i < (size_t)2 * T / 2; i += nth) z1[i] = zz; } }
        convert_bf16(PTR(20), (bf16*)(ws + WS_PKEYS), (size_t)DEPTH * 8 * 2 * 128 * 128, gtid, nth);
        convert_int4_plain(PTR(21), ws + WS_PU, DEPTH * PEER_N, PU_SCALEI, PTR(18), gw_, NGW, lane_);
        convert_fp4_rows(PTR(22), ws + WS_PV, PEER_N, PV_SCALE4, nullptr, gw_, NGW, lane_);
        {   const float* x0 = PTR(0); bf16* XN = (bf16*)(ws + WS_XN); u64_t* rsq = (u64_t*)(ws + WS_ROWSQ);
            for (int m = 2 * gw_; m < T; m += 2 * NGW) prep_rows2(x0 + (size_t)m * DM, XN + (size_t)m * DM, rsq + m, ws + WS_XN8 + (size_t)m * DM, (float*)(ws + WS_XSC) + m, lane_); }
        {   const float* mem = PTR(1); const float* gkv = PTR(13);
            for (int m = gw_; m < BATCH * NMEM; m += NGW) {
                const GAS f32x4* xr = (const GAS f32x4*)(mem + (size_t)m * DM) + lane_;
                f32x4 v[8]; float s = 0.f;
#pragma unroll
                for (int j = 0; j < 8; ++j) { v[j] = xr[64 * j]; s += (v[j].x * v[j].x + v[j].y * v[j].y) + (v[j].z * v[j].z + v[j].w * v[j].w); }
                const float rstd = 1.f / sqrtf(wave_sum(s, lane_) * (1.f / DM) + EPS);
#pragma unroll 1
                for (int l = 0; l < DEPTH; ++l) rms_row_to_i8(v, rstd, gkv + (size_t)l * DM, ws + WS_MEMN + ((size_t)l * BATCH * NMEM + m) * DM, (float*)(ws + WS_MEMS) + l * BATCH * NMEM + m, lane_); } }
        float* rope = (float*)(ws + WS_ROPE); float* biasA = (float*)(ws + WS_BIASA);
        if (gtid < 64 * 16) { const int pos = (int)gtid >> 4, i = (int)gtid & 15; const float ang = (float)pos * ROPE_INV[i]; rope[gtid * 2] = cosf(ang); rope[gtid * 2 + 1] = sinf(ang); }
        if (gtid < 12 * 257) { const int h = (int)gtid / 257, rel = (int)gtid % 257 - 128; biasA[gtid] = PTR(2)[t5_bucket(rel) * 12 + h]; }
    }
    SEAM(0);
    if (IN(1) && PHON(1)) {
#pragma unroll 1
        for (int l = 0; l < DEPTH; ++l) {
            PHL(); unsigned char* ws = WSP();
            pg8::Gemm g{(bf16*)(ws + WS_MEMN + (size_t)l * BATCH * NMEM * DM), (bf16*)(ws + WS_WMKV + (size_t)l * 1024 * DM), BATCH * NMEM, 1024, DM / 2};
            OffsetOrder S; S.init(BATCH * NMEM, 1024, G, bid, 64 * l);
            bf16* KVMl = (bf16*)(ws + WS_KVM) + (size_t)l * BATCH * NMEM * 1024;
            pg8::EpiBf16Q8 E{KVMl, 1024, (const float*)(ws + WS_MEMS) + (size_t)l * BATCH * NMEM, (const float*)(ws + WS_WSCKV) + (size_t)l * 1024};
            pg8::gemm_phase<pg8::EpiBf16Q8, OffsetOrder, true, true>(lds + RING_OFF, g, S, E, tid_);
            VM_WAIT(); __syncthreads();
            const float* gk = PTR(16) + (size_t)l * 256 + 128;
#pragma unroll 1
            for (int i = 0; i < 4; ++i) { pg8::Unit uu; uu.pm = 0; uu.pn = 0; if (!S.next(i, uu)) break;
                if (uu.pn < 2) {
                    for (int r2 = wave_; r2 < 128; r2 += NWAVES) { const int row = uu.pm * 256 + 2 * r2 + (lane_ >> 5), cl = lane_ & 31;
                        GAS v4u* p = (GAS v4u*)(KVMl + (size_t)row * 1024 + 256 * uu.pn + 8 * cl);
                        const v4u w = *p;
                        float f[8] = {bflo(w.x), bfhi(w.x), bflo(w.y), bfhi(w.y), bflo(w.z), bfhi(w.z), bflo(w.w), bfhi(w.w)};
                        float ss = 0.f;
#pragma unroll
                        for (int e = 0; e < 8; ++e) ss += f[e] * f[e];
                        ss += shx(ss, 1, lane_); ss += shx(ss, 2, lane_); ss += shx(ss, 4, lane_); ss += shx(ss, 8, lane_);
                        const float r = 1.f / sqrtf(ss * (1.f / 128.f) + EPS);
                        const float* gg = gk + 8 * (cl & 15);
                        v4u o; o.x = pk2(f[0] * r * gg[0], f[1] * r * gg[1]); o.y = pk2(f[2] * r * gg[2], f[3] * r * gg[3]); o.z = pk2(f[4] * r * gg[4], f[5] * r * gg[5]); o.w = pk2(f[6] * r * gg[6], f[7] * r * gg[7]);
                        *p = o; } } }
            __syncthreads();
        }
        if (G >= 256 && bid >= 128) { PHL(); unsigned char* ws = WSP();
            convert_fp4_rows(PTR(22) + (size_t)PEER_N * DM, ws + WS_PV + (size_t)PEER_N * 1024, PEER_N, PV_SCALE4, nullptr, (bid - 128) * NWAVES + wave_, (G - 128) * NWAVES, lane_); }
        else if (G < 256) { PHL(); unsigned char* ws = WSP(); convert_fp4_rows(PTR(22) + (size_t)PEER_N * DM, ws + WS_PV + (size_t)PEER_N * 1024, PEER_N, PV_SCALE4, nullptr, gw_, NGW, lane_); }
    }
    SEAM(1);

#pragma unroll 1
    for (int l = 0; l < DEPTH; ++l) {
        const int pb = PH_BASE + PH_PER_LAYER * l;
        static_assert(DEPTH <= 2, "one id buffer per layer");
        const size_t pidx_off = (l & 1) ? WS_QM : WS_PIDX;
        if (IN(pb + 0) && PHON(3)) { PHL(); unsigned char* ws = WSP();
            pg8::Gemm g{(bf16*)(ws + WS_XN8), (bf16*)(ws + WS_WIN8 + (size_t)l * DIN * DM), T, DIN, DM / 2}; pg8::StaticOrder S; S.init(T, DIN, G, bid);
            LAS float* ropel = (LAS float*)(lds + LDSCTL_OFF + 2048);
            for (int i = tid_; i < 64 * 16 * 2; i += NTHREADS) ropel[i] = ((const float*)(ws + WS_ROPE))[i];
            __syncthreads();
            pg8::EpiQKV E{(bf16*)(ws + WS_QKV), PTR(5) + (size_t)l * 128, PTR(7) + (size_t)l * 128, PTR(9) + (size_t)l * 128, ropel, (const u64_t*)(ws + WS_ROWSQ) + (size_t)(l * 3 + 0) * T, (const float*)(ws + WS_XSC), (const float*)(ws + WS_WSC) + (size_t)l * DIN};
            pg8::gemm_phase<pg8::EpiQKV, pg8::StaticOrder, true, true>(lds + RING_OFF, g, S, E, tid_);
        }
        SEAM(pb + 0);
        if (IN(pb + 1) && PHON(4)) { PHL(); unsigned char* ws = WSP();
            const float* sink = PTR(6) + (size_t)l * 12; const float* rpb = PTR(8) + (size_t)l * 8 * 15 * 31; const float* biasA = (const float*)(ws + WS_BIASA);
            const bf16* QKV = (const bf16*)(ws + WS_QKV); bf16* ATT = (bf16*)(ws + WS_ATT);
            const float* ga = PTR(5) + (size_t)l * 128; const float* gb = PTR(7) + (size_t)l * 128; const float* gc = PTR(9) + (size_t)l * 128;
            const float CaL2 = 8.f * wave_max(fabsf(ga[lane_]), lane_) * wave_max(fabsf(ga[64 + lane_]), lane_) * LOG2E;
            const float CbL2 = 8.f * wave_max(fabsf(gb[lane_]), lane_) * wave_max(fabsf(gb[64 + lane_]), lane_) * LOG2E;
            const float CcL2 = 8.f * wave_max(fabsf(gc[lane_]), lane_) * wave_max(fabsf(gc[64 + lane_]), lane_) * LOG2E;
            const int vc = (G % 8 == 0) ? (bid % 8) * (G / 8) + bid / 8 : bid;
            u64_t* mixsq = (u64_t*)(ws + WS_MIXSQ) + (size_t)l * 3 * T;
            for (int u = vc; u < BATCH * 12 * 8; u += G) attn_unit<2>(lds, QKV, ATT, mixsq + 2 * (size_t)T, u / 96, (u >> 3) % 12, u & 7, nullptr, CcL2, 0.f, tid_);
            for (int u = vc; u < BATCH * 8 * 8; u += G) attn_unit<1>(lds, QKV, ATT, mixsq + (size_t)T, u >> 6, (u >> 3) & 7, u & 7, rpb, CbL2, 0.f, tid_);
            for (int u = vc; u < BATCH * 12 * 8; u += G) { const int head = (u >> 3) % 12; attn_unit<0>(lds, QKV, ATT, mixsq, u / 96, head, u & 7, biasA, CaL2, sink[head] * LOG2E, tid_); }
        }
        SEAM(pb + 1);
        if (IN(pb + 2) && PHON(5)) { PHL(); unsigned char* ws = WSP();
            const u64_t* mixsq = (const u64_t*)(ws + WS_MIXSQ) + (size_t)l * 3 * T;
            for (int r = 4 * gw_; r < T; r += 4 * NGW) att_quant_rows<4>((const bf16*)(ws + WS_ATT), mixsq, ws + WS_ATT8, (float*)(ws + WS_XSC2), r, lane_);
        }
        SEAM(pb + 2);
        if (IN(pb + 3) && PHON(5)) { PHL(); unsigned char* ws = WSP();
            pg8::Gemm g{(bf16*)(ws + WS_ATT8), (bf16*)(ws + WS_WOUT8 + (size_t)l * DM * DM), T, DM, DM / 2}; pg8::StaticOrder S; S.init(T, DM, G, bid);
            typedef pg8::EpiResidT<true, 10> EpiX1;
            EpiX1 E{(bf16*)(ws + WS_XN), DM, (u64_t*)(ws + WS_ROWSQ) + (size_t)(l * 3 + 1) * T, (const float*)(ws + WS_XSC2), (const float*)(ws + WS_WSCO) + (size_t)l * DM, ws + WS_X8, (const u64_t*)(ws + WS_ROWSQ) + (size_t)(l * 3 + 0) * T, nullptr, nullptr};
            pg8::gemm_phase<EpiX1, pg8::StaticOrder, true, true>(lds + RING_OFF, g, S, E, tid_);
        }
        SEAM(pb + 3);
        if (IN(pb + 4) && PHON(6)) { PHL(); unsigned char* ws = WSP();
            pg8::Gemm g{(bf16*)(ws + WS_X8), (bf16*)(ws + WS_WMQ8 + (size_t)l * MEMW * DM), T, MEMW, DM / 2}; pg8::StaticOrder S; S.init(T, MEMW, G, bid);
            pg8::EpiBf16Row8<10> E{(bf16*)(ws + WS_QM), MEMW, (const u64_t*)(ws + WS_ROWSQ) + (size_t)(l * 3 + 1) * T, (const u64_t*)(ws + WS_ROWSQ) + (size_t)(l * 3 + 0) * T, (const float*)(ws + WS_WSCM) + (size_t)l * MEMW};
            pg8::gemm_phase<pg8::EpiBf16Row8<10>, pg8::StaticOrder, true, true>(lds + RING_OFF, g, S, E, tid_);
            VM_WAIT(); __syncthreads();
            const bf16* kvm = (const bf16*)(ws + WS_KVM) + (size_t)l * BATCH * NMEM * 1024; const float* gq = PTR(16) + (size_t)l * 256;
            const float CmL2 = 11.313708498984761f * wave_max(fmaxf(fabsf(gq[lane_]), fabsf(gq[64 + lane_])), lane_) * wave_max(fmaxf(fabsf(gq[128 + lane_]), fabsf(gq[192 + lane_])), lane_) * LOG2E;
#pragma unroll 1
            for (int i = 0; i < 4; ++i) { pg8::Unit uu; uu.pm = 0; uu.pn = 0; if (!S.next(i, uu)) break;
                int nrep_ = (MK_REP == 1) ? 4 : 2; asm volatile("" : "+s"(nrep_));
#pragma unroll 1
                for (int hr = 0; hr < nrep_; ++hr) mem_unit(lds, (const bf16*)(ws + WS_QM), kvm, (bf16*)(ws + WS_OM), gq, uu.pm, 2 * uu.pn + (hr & 1), CmL2, tid_);
#if MK_REP == 4 || MK_REP == 5
                mem_unit<MK_REP - 3>(lds, (const bf16*)(ws + WS_QM), kvm, (bf16*)(ws + WS_QKV), gq, uu.pm, 2 * uu.pn, CmL2, tid_); mem_unit<MK_REP - 3>(lds, (const bf16*)(ws + WS_QM), kvm, (bf16*)(ws + WS_QKV), gq, uu.pm, 2 * uu.pn + 1, CmL2, tid_);
#endif
            }
        }
        SEAM(pb + 4);
        if (IN(pb + 5) && PHON(7)) { PHL(); unsigned char* ws = WSP();
            pg8::Gemm g{(bf16*)(ws + WS_OM), (bf16*)(ws + WS_WMO) + (size_t)l * DM * MEMW, T, DM, MEMW}; pg8::StaticOrder S; S.init(T, DM, G, bid);
            typedef pg8::EpiResidT<false, 6, true> EpiX2;
            EpiX2 E{(bf16*)(ws + WS_XN), DM, (u64_t*)(ws + WS_ROWSQ) + (size_t)(l * 3 + 2) * T, nullptr, nullptr, ws + WS_X8, (const u64_t*)(ws + WS_ROWSQ) + (size_t)(l * 3 + 1) * T, ws + WS_XQH, ws + WS_XQL};
            pg8::gemm_phase<EpiX2, pg8::StaticOrder, true, true>(lds + RING_OFF, g, S, E, tid_);
        }
        SEAM(pb + 5);
        if (IN(pb + 6) && PHON(8)) { PHL(); unsigned char* ws = WSP();
            pg8::Gemm g{(bf16*)(ws + WS_X8), (bf16*)(ws + WS_WPQ8 + (size_t)l * DM * DM), T, DM, DM / 2}; pg8::StaticOrder S; S.init(T, DM, G, bid);
            pg8::EpiBf16Row8<6> E{(bf16*)(ws + WS_QP), DM, (const u64_t*)(ws + WS_ROWSQ) + (size_t)(l * 3 + 2) * T, (const u64_t*)(ws + WS_ROWSQ) + (size_t)(l * 3 + 1) * T, (const float*)(ws + WS_WSCP) + (size_t)l * DM};
            pg8::gemm_phase<pg8::EpiBf16Row8<6>, pg8::StaticOrder, true, true>(lds + RING_OFF, g, S, E, tid_);
            VM_WAIT(); __syncthreads();
            const bf16* pk = (const bf16*)(ws + WS_PKEYS) + (size_t)l * 8 * 2 * 128 * 128;
#pragma unroll 1
            for (int i = 0; i < 8; ++i) { pg8::Unit uu; uu.pm = 0; uu.pn = 0; if (!S.next(i, uu)) break;
                peer_select_unit((const bf16*)(ws + WS_QP), pk, (int*)(ws + pidx_off), (float*)(ws + WS_PGATE), uu.pm, uu.pn, wave_, lane_, lds + RING_OFF);
#if MK_REP == 2
                peer_select_unit((const bf16*)(ws + WS_QP), pk, (int*)(ws + pidx_off), (float*)(ws + WS_PGATE), uu.pm, uu.pn, wave_, lane_, lds + RING_OFF);
#endif
#if MK_REP == 3
#endif
            }
        }
        SEAM(pb + 6);
        if (IN(pb + 7) && PHON(9)) { PHL(); unsigned char* ws = WSP();
            peer_u_phase_i4((const unsigned*)(ws + WS_XQH), (const unsigned*)(ws + WS_XQL), ws + WS_PU + (size_t)l * PEER_N * 1024, (const int*)(ws + pidx_off), (int*)(ws + WS_PARTI), bid, G, wave_, lane_); }
        SEAM(pb + 7);
        if (IN(pb + 8) && PHON(10)) { PHL(); unsigned char* ws = WSP();
            peer_v_pass((bf16*)(ws + WS_XN), ws + WS_PV + (size_t)l * PEER_N * 1024, (const int*)(ws + pidx_off), (const float*)(ws + WS_PGATE), (const int*)(ws + WS_PARTI), (l + 1 == DEPTH) ? OUTP() : (float*)nullptr,
                        (l + 1 < DEPTH) ? (u64_t*)(ws + WS_ROWSQ) + (size_t)((l + 1) * 3 + 0) * T : (u64_t*)nullptr, (l + 1 < DEPTH) ? ws + WS_XN8 : (unsigned char*)nullptr, (float*)(ws + WS_XSC), (const u64_t*)(ws + WS_ROWSQ) + (size_t)(l * 3 + 1) * T, (const u64_t*)(ws + WS_ROWSQ) + (size_t)(l * 3 + 2) * T, (LAS float*)(lds + RING_OFF + wave_ * 1024), gw_, NGW, lane_); }
        SEAM(pb + 8);
    }
#undef IN
#undef SEAM
}

#ifndef MK_MULTI_LAUNCH
#define MK_MULTI_LAUNCH 0
#endif
extern "C" void kernel_launch(void* const* d_in, const int* in_sizes, int n_in, void* d_out, int out_size, void* d_ws, size_t ws_size, hipStream_t stream) {
    static int grid = 0;
    if (grid == 0) {
        if (n_in != 23 || out_size != T * DM || ws_size < WS_END) { fprintf(stderr, "kernel_launch: unexpected shapes (n_in %d, out %d, ws %zu)\n", n_in, out_size, ws_size); grid = -1; return; }
        int dev = 0, cus = 0, per_cu = 0;
        if (hipGetDevice(&dev) != hipSuccess || hipDeviceGetAttribute(&cus, hipDeviceAttributeMultiprocessorCount, dev) != hipSuccess) { grid = -1; return; }
        if (hipFuncSetAttribute((const void*)mega, hipFuncAttributeMaxDynamicSharedMemorySize, LDS_BYTES) != hipSuccess) { fprintf(stderr, "kernel_launch: hipFuncSetAttribute failed\n"); grid = -1; return; }
        if (hipOccupancyMaxActiveBlocksPerMultiprocessor(&per_cu, (const void*)mega, NTHREADS, LDS_BYTES) != hipSuccess || per_cu < 1) { fprintf(stderr, "kernel_launch: occupancy query says %d\n", per_cu); }
        (void)hipGetLastError();
        grid = cus;
    }
    if (grid < 0) return;
    (void)hipMemsetAsync((char*)d_ws + WS_CTL, 0, 65536, stream);
    Args a{};
    for (int i = 0; i < 23; ++i) a.in[i] = (const float*)d_in[i];
    a.out = (float*)d_out; a.ws = (unsigned char*)d_ws;
#if MK_MULTI_LAUNCH
    for (int p = 0; p < N_PHASES; ++p) { a.ph_lo = p; a.ph_hi = p + 1; a.use_bar = 0; a.pad = 0; hipLaunchKernelGGL(mega, dim3(grid), dim3(NTHREADS), LDS_BYTES, stream, a); }
#else
    a.ph_lo = 0; a.ph_hi = N_PHASES; a.use_bar = 1; a.pad = 0;
    hipLaunchKernelGGL(mega, dim3(grid), dim3(NTHREADS), LDS_BYTES, stream, a);
#endif
    const hipError_t le = hipPeekAtLastError();
    if (le != hipSuccess) fprintf(stderr, "kernel_launch: launch failed: %s\n", hipGetErrorName(le));
}
```
